# Optimizing an MI355X kernel written in HIP

```python
import jax, jax.numpy as jnp
from jax import lax
import numpy as np

D_MODEL = 1024
BATCH = 4
SEQ = 4096
DEPTH = 4

D_MIX = D_MODEL
HEAD_DIM = 64
G_WIDTH = D_MIX // 4
R_WIDTH = 3 * D_MIX // 8
M_WIDTH = D_MIX - G_WIDTH - R_WIDTH
G_HEADS = G_WIDTH // HEAD_DIM
R_HEADS = R_WIDTH // HEAD_DIM
M_HEADS = M_WIDTH // HEAD_DIM
CHUNK = 128
W_LORA = 64
A_LORA = 64
G_LORA = 128
CONV_K = 3
G_PROJ = 2 * G_WIDTH
R_PROJ = 3 * R_WIDTH + W_LORA + A_LORA + G_LORA
M_PROJ = 4 * M_WIDTH + 4 * M_HEADS
P_IN = G_PROJ + R_PROJ + M_PROJ
N_EXPERTS = 32
TOP_K = 4
D_FF = D_MODEL
SWIGLU_LIMIT = 7.0
SWIGLU_ALPHA = 1.702
MOE_BLOCK = 256
LN_EPS = 1e-5
RWKV_GN_EPS = 64e-5
DEEPNORM_ALPHA = (2 * DEPTH) ** 0.25
DEEPNORM_BETA = (8 * DEPTH) ** -0.25

kernel_name = 'hybrid_gmlp_rwkv7_mlstm_moe_encoder'


def _head_norm(t, eps):
    t = t.astype(jnp.float32)
    mu = jnp.mean(t, -1, keepdims=True)
    var = jnp.mean(jnp.square(t - mu), -1, keepdims=True)
    return (t - mu) * lax.rsqrt(var + eps)


def _layer_norm(x, g, b):
    return (_head_norm(x, LN_EPS) * g + b).astype(x.dtype)


def _bidir(t):
    return jnp.stack([t, jnp.flip(t, axis=1)])


def _flip_bwd(t):
    return jnp.stack([t[0], jnp.flip(t[1], axis=1)])


def _merge_dirs(t):
    return t[0] + jnp.flip(t[1], axis=1)


def _centred_dwconv(x, w, b):
    r = w.shape[0] // 2
    sn = x.shape[1]
    xp = jnp.pad(x, ((0, 0), (r, r), (0, 0)))
    y = b
    for j in range(w.shape[0]):
        y = y + xp[:, j:j + sn] * w[j]
    return y


def gmlp_mixer(p, ln_g, ln_b, ws, bs):
    bn, sn, _ = p.shape
    p = jax.nn.gelu(p.astype(jnp.float32), approximate=False)
    u, v = p[..., :G_WIDTH], p[..., G_WIDTH:]
    v = _head_norm(v, LN_EPS) * ln_g + ln_b
    vc = v.reshape(bn, sn // CHUNK, CHUNK, G_HEADS, HEAD_DIM)
    y = jnp.einsum('hpq,bcqhe->bcphe', ws, vc) + jnp.transpose(bs)[None, None, :, :, None]
    return u * y.reshape(bn, sn, G_WIDTH)


def _wkv7_step(state, inp):
    r, w, k, v, a, b = inp
    sa = jnp.einsum('phvk,phk->phv', state, a)
    state = state * w[:, :, None, :] + sa[..., None] * b[:, :, None, :] + v[..., None] * k[:, :, None, :]
    return state, jnp.einsum('phvk,phk->phv', state, r)


def rwkv7_mixer(p, mu, w0, w2, a0, a2, g2, k_k, k_a, r_k, ln_g, ln_b):
    bn, sn, _ = p.shape
    pf = p.astype(jnp.float32)
    p_prev = jnp.pad(pf, ((0, 0), (1, 0), (0, 0)))[:, :-1]
    p_next = jnp.pad(pf, ((0, 0), (0, 1), (0, 0)))[:, 1:]
    pf = pf + mu[0] * (p_prev - pf) + mu[1] * (p_next - pf)
    o3 = 3 * R_WIDTH
    r, k, v, wd, ad, gd = jnp.split(pf, [R_WIDTH, 2 * R_WIDTH, o3, o3 + W_LORA, o3 + W_LORA + A_LORA], axis=-1)
    w_log = -jax.nn.softplus(-(w0[:, None, None] + jnp.einsum('bsr,drc->dbsc', jnp.tanh(wd), w2))) - 0.5
    decay = jnp.exp(-jnp.exp(w_log))
    iclr = jax.nn.sigmoid(a0[:, None, None] + jnp.einsum('bsr,drc->dbsc', ad, a2))
    gate = jax.nn.sigmoid(gd) @ g2
    hs = lambda t: t.reshape(t.shape[:-1] + (R_HEADS, HEAD_DIM))
    kk = hs(k * k_k)
    kk = kk / jnp.maximum(jnp.sqrt(jnp.sum(kk * kk, -1, keepdims=True)), 1e-12)
    k_dir = hs(k * (1.0 + (iclr - 1.0) * k_a))
    r_h, v_h = hs(r), hs(v)
    kk2 = _bidir(kk)
    tm = lambda t: jnp.moveaxis(t, 2, 0).reshape(sn, 2 * bn, R_HEADS, HEAD_DIM)
    xs = (tm(_bidir(r_h)), tm(_flip_bwd(hs(decay))), tm(_flip_bwd(k_dir)), tm(_bidir(v_h)),
          tm(-kk2), tm(kk2 * _flip_bwd(hs(iclr))))
    state0 = jnp.zeros((2 * bn, R_HEADS, HEAD_DIM, HEAD_DIM), jnp.float32)
    _, out = lax.scan(_wkv7_step, state0, xs)
    out = _merge_dirs(jnp.moveaxis(out.reshape(sn, 2, bn, R_HEADS, HEAD_DIM), 0, 2))
    out = _head_norm(out, RWKV_GN_EPS).reshape(bn, sn, R_WIDTH) * ln_g + ln_b
    bonus = jnp.sum(jnp.sum(r_h * k_dir * r_k, -1, keepdims=True), 0) * v_h
    return (out + bonus.reshape(bn, sn, R_WIDTH)) * gate


def mlstm_mixer(p, conv_w, conv_b, gate_b, ln_g):
    bn, sn, _ = p.shape
    nc = sn // CHUNK
    pf = p.astype(jnp.float32)
    qk, v, o, gates = jnp.split(pf, [2 * M_WIDTH, 3 * M_WIDTH, 4 * M_WIDTH], axis=-1)
    qk = jax.nn.silu(_centred_dwconv(qk, conv_w, conv_b))
    hs = lambda t: t.reshape(t.shape[:-1] + (M_HEADS, HEAD_DIM))
    q = hs(qk[..., :M_WIDTH])
    k = hs(qk[..., M_WIDTH:]) * HEAD_DIM ** -0.5
    v = hs(v)
    gates = (gates + gate_b).reshape(bn, sn, 2, 2, M_HEADS)
    ig = _flip_bwd(jnp.moveaxis(gates[:, :, 0], 2, 0))
    lf = _flip_bwd(jnp.moveaxis(jax.nn.log_sigmoid(gates[:, :, 1]), 2, 0))
    ch = lambda t: t.reshape(2 * bn, nc, CHUNK, M_HEADS, HEAD_DIM).transpose(1, 0, 3, 2, 4)
    chg = lambda t: t.reshape(2 * bn, nc, CHUNK, M_HEADS).transpose(1, 0, 3, 2)
    xs = (ch(_bidir(q)), ch(_bidir(k)), ch(_bidir(v)), chg(ig), chg(lf))
    tril = jnp.tril(jnp.ones((CHUNK, CHUNK), dtype=bool))

    def chunk_step(carry, inp):
        c_st, n_st, m_st = carry
        qc, kc, vc, igc, lfc = inp
        bcum = jnp.cumsum(lfc, axis=-1)
        dmat = jnp.where(tril, bcum[..., :, None] - bcum[..., None, :] + igc[..., None, :], -jnp.inf)
        inter = bcum + m_st[..., None]
        m_t = jnp.maximum(jnp.max(dmat, -1), inter)
        sc = jnp.einsum('phtd,phsd->phts', qc, kc) * jnp.exp(dmat - m_t[..., None])
        w_inter = jnp.exp(inter - m_t)
        num = jnp.einsum('phts,phsd->phtd', sc, vc) + w_inter[..., None] * jnp.einsum('phtd,phde->phte', qc, c_st)
        den = jnp.sum(sc, -1) + w_inter * jnp.einsum('phtd,phd->pht', qc, n_st)
        h = num / jnp.maximum(jnp.abs(den), jnp.exp(-m_t))[..., None]
        b_last = bcum[..., -1]
        lw = b_last[..., None] - bcum + igc
        m_new = jnp.maximum(b_last + m_st, jnp.max(lw, -1))
        wts = jnp.exp(lw - m_new[..., None])
        dec = jnp.exp(b_last + m_st - m_new)
        c_st = dec[..., None, None] * c_st + jnp.einsum('phs,phsd,phse->phde', wts, kc, vc)
        n_st = dec[..., None] * n_st + jnp.einsum('phs,phsd->phd', wts, kc)
        return (c_st, n_st, m_new), h

    carry0 = (jnp.zeros((2 * bn, M_HEADS, HEAD_DIM, HEAD_DIM), jnp.float32),
              jnp.zeros((2 * bn, M_HEADS, HEAD_DIM), jnp.float32),
              jnp.zeros((2 * bn, M_HEADS), jnp.float32))
    _, hseq = lax.scan(chunk_step, carry0, xs)
    hseq = hseq.transpose(1, 0, 3, 2, 4).reshape(2, bn, sn, M_HEADS, HEAD_DIM)
    h = _head_norm(_merge_dirs(hseq), LN_EPS).reshape(bn, sn, M_WIDTH) * ln_g
    return jax.nn.sigmoid(o) * h


def _moe(x, router_w, router_b, w1, b1, w2, b2):
    bn, sn, d = x.shape
    t = bn * sn
    xf = x.reshape(t, d)
    logits = (xf @ router_w).astype(jnp.float32) + router_b
    top_v, top_i = lax.top_k(logits, TOP_K)
    gate = jax.nn.softmax(top_v, axis=-1)
    na = t * TOP_K
    flat_e = top_i.reshape(na)
    flat_t = jnp.arange(na, dtype=jnp.int32) // TOP_K
    flat_g = gate.reshape(na)
    order = jnp.argsort(flat_e)
    se, st, sg = flat_e[order], flat_t[order], flat_g[order]
    counts = jnp.bincount(flat_e, length=N_EXPERTS)
    start = jnp.cumsum(counts) - counts
    pcounts = (counts + MOE_BLOCK - 1) // MOE_BLOCK * MOE_BLOCK
    pend = jnp.cumsum(pcounts)
    pstart = pend - pcounts
    dest = pstart[se] + jnp.arange(na, dtype=jnp.int32) - start[se]
    nb = -(-na // MOE_BLOCK) + N_EXPERTS
    row_t = jnp.zeros((nb * MOE_BLOCK,), jnp.int32).at[dest].set(st)
    row_g = jnp.zeros((nb * MOE_BLOCK,), jnp.float32).at[dest].set(sg)
    block_e = jnp.minimum(jnp.searchsorted(pend, jnp.arange(nb, dtype=jnp.int32) * MOE_BLOCK, side='right'), N_EXPERTS - 1)
    xs = xf[row_t].reshape(nb, MOE_BLOCK, d)

    def expert_block(args):
        xb, e = args
        hdn = xb @ w1[e] + b1[e]
        g_, u_ = hdn[:, :D_FF], hdn[:, D_FF:]
        g_ = jnp.minimum(g_, SWIGLU_LIMIT)
        u_ = jnp.clip(u_, -SWIGLU_LIMIT, SWIGLU_LIMIT)
        return ((u_ + 1.0) * (g_ * jax.nn.sigmoid(g_ * SWIGLU_ALPHA))) @ w2[e] + b2[e]

    ys = lax.map(expert_block, (xs, block_e)).reshape(nb * MOE_BLOCK, d)
    y = jnp.zeros((t, d), x.dtype).at[row_t].add((ys * row_g[:, None]).astype(x.dtype))
    return y.reshape(bn, sn, d)


def setup_inputs(seed: int = 0) -> dict:
    key = jax.random.key(seed)
    ks = iter(jax.random.split(key, 48))
    L = DEPTH
    nrm = lambda shape, s: jax.random.normal(next(ks), shape, jnp.float32) * s
    gain = lambda shape: 1.0 + nrm(shape, 0.1)
    x = nrm((BATCH, SEQ, D_MODEL), 1.0)
    w_in = nrm((L, D_MODEL, P_IN), D_MODEL ** -0.5)
    gmlp_ln_g = gain((L, G_WIDTH))
    gmlp_ln_b = nrm((L, G_WIDTH), 0.02)
    gmlp_ws = nrm((L, G_HEADS, CHUNK, CHUNK), CHUNK ** -0.5)
    gmlp_bs = gain((L, G_HEADS, CHUNK))
    rwkv_mu = jax.random.uniform(next(ks), (L, 2, R_PROJ), jnp.float32, 0.0, 0.5)
    rwkv_w0 = jax.random.uniform(next(ks), (L, 2, R_WIDTH), jnp.float32, -6.0, 1.0)
    rwkv_w2 = nrm((L, 2, W_LORA, R_WIDTH), 0.5 * W_LORA ** -0.5)
    rwkv_a0 = nrm((L, 2, R_WIDTH), 0.1)
    rwkv_a2 = nrm((L, 2, A_LORA, R_WIDTH), A_LORA ** -0.5)
    rwkv_g2 = nrm((L, G_LORA, R_WIDTH), G_LORA ** -0.5)
    rwkv_k_k = 0.85 + nrm((L, R_WIDTH), 0.1)
    rwkv_k_a = gain((L, R_WIDTH))
    rwkv_r_k = nrm((L, R_HEADS, HEAD_DIM), 0.1)
    rwkv_ln_g = gain((L, R_WIDTH))
    rwkv_ln_b = nrm((L, R_WIDTH), 0.02)
    mlstm_conv_w = nrm((L, CONV_K, 2 * M_WIDTH), CONV_K ** -0.5)
    mlstm_conv_b = nrm((L, 2 * M_WIDTH), 0.02)
    ib = nrm((L, 2, M_HEADS), 0.1)
    fb = jnp.linspace(3.0, 6.0, M_HEADS, dtype=jnp.float32) + nrm((L, 2, M_HEADS), 0.1)
    mlstm_gate_b = jnp.stack([ib, fb], axis=1).reshape(L, 4 * M_HEADS)
    mlstm_ln_g = gain((L, M_WIDTH))
    w_out = nrm((L, D_MIX, D_MODEL), DEEPNORM_BETA * D_MIX ** -0.5)
    ln1_g = gain((L, D_MODEL))
    ln1_b = nrm((L, D_MODEL), 0.02)
    router_w = nrm((L, D_MODEL, N_EXPERTS), D_MODEL ** -0.5)
    router_b = nrm((L, N_EXPERTS), 0.01)
    exp_w1 = nrm((L, N_EXPERTS, D_MODEL, 2 * D_FF), D_MODEL ** -0.5)
    exp_b1 = nrm((L, N_EXPERTS, 2 * D_FF), 0.02)
    exp_w2 = nrm((L, N_EXPERTS, D_FF, D_MODEL), DEEPNORM_BETA * D_FF ** -0.5)
    exp_b2 = nrm((L, N_EXPERTS, D_MODEL), 0.02)
    ln2_g = gain((L, D_MODEL))
    ln2_b = nrm((L, D_MODEL), 0.02)
    return {'x': x, 'w_in': w_in, 'gmlp_ln_g': gmlp_ln_g, 'gmlp_ln_b': gmlp_ln_b, 'gmlp_ws': gmlp_ws,
            'gmlp_bs': gmlp_bs, 'rwkv_mu': rwkv_mu, 'rwkv_w0': rwkv_w0, 'rwkv_w2': rwkv_w2,
            'rwkv_a0': rwkv_a0, 'rwkv_a2': rwkv_a2, 'rwkv_g2': rwkv_g2, 'rwkv_k_k': rwkv_k_k,
            'rwkv_k_a': rwkv_k_a, 'rwkv_r_k': rwkv_r_k, 'rwkv_ln_g': rwkv_ln_g, 'rwkv_ln_b': rwkv_ln_b,
            'mlstm_conv_w': mlstm_conv_w, 'mlstm_conv_b': mlstm_conv_b, 'mlstm_gate_b': mlstm_gate_b,
            'mlstm_ln_g': mlstm_ln_g, 'w_out': w_out, 'ln1_g': ln1_g, 'ln1_b': ln1_b,
            'router_w': router_w, 'router_b': router_b, 'exp_w1': exp_w1, 'exp_b1': exp_b1,
            'exp_w2': exp_w2, 'exp_b2': exp_b2, 'ln2_g': ln2_g, 'ln2_b': ln2_b}


def reference(x, w_in, gmlp_ln_g, gmlp_ln_b, gmlp_ws, gmlp_bs, rwkv_mu, rwkv_w0, rwkv_w2, rwkv_a0,
              rwkv_a2, rwkv_g2, rwkv_k_k, rwkv_k_a, rwkv_r_k, rwkv_ln_g, rwkv_ln_b, mlstm_conv_w,
              mlstm_conv_b, mlstm_gate_b, mlstm_ln_g, w_out, ln1_g, ln1_b, router_w, router_b,
              exp_w1, exp_b1, exp_w2, exp_b2, ln2_g, ln2_b):
    for l in range(DEPTH):
        proj = jnp.einsum('bsd,dp->bsp', x, w_in[l])
        pg, pr, pm = jnp.split(proj, [G_PROJ, G_PROJ + R_PROJ], axis=-1)
        y_g = gmlp_mixer(pg, gmlp_ln_g[l], gmlp_ln_b[l], gmlp_ws[l], gmlp_bs[l])
        y_r = rwkv7_mixer(pr, rwkv_mu[l], rwkv_w0[l], rwkv_w2[l], rwkv_a0[l], rwkv_a2[l], rwkv_g2[l],
                          rwkv_k_k[l], rwkv_k_a[l], rwkv_r_k[l], rwkv_ln_g[l], rwkv_ln_b[l])
        y_m = mlstm_mixer(pm, mlstm_conv_w[l], mlstm_conv_b[l], mlstm_gate_b[l], mlstm_ln_g[l])
        groups = jnp.concatenate([y_g.astype(x.dtype), y_r.astype(x.dtype), y_m.astype(x.dtype)], axis=-1)
        mix = jnp.einsum('bsc,cd->bsd', groups, w_out[l])
        x = _layer_norm(DEEPNORM_ALPHA * x + mix, ln1_g[l], ln1_b[l])
        ffn = _moe(x, router_w[l], router_b[l], exp_w1[l], exp_b1[l], exp_w2[l], exp_b2[l])
        x = _layer_norm(DEEPNORM_ALPHA * x + ffn, ln2_g[l], ln2_b[l])
    return x
```

```cpp
#ifndef EMU
#include <hip/hip_runtime.h>
#endif
#include <cstdio>
#include <cstdint>
#include <cmath>

#ifndef CFG_BATCH
#define CFG_BATCH 4
#endif
#ifndef CFG_SEQ
#define CFG_SEQ 4096
#endif
#ifndef CFG_LAYERS
#define CFG_LAYERS 4
#endif
#ifndef MK_ONE_LAUNCH
#define MK_ONE_LAUNCH 0
#endif

namespace mk {
constexpr int NB = CFG_BATCH, S = CFG_SEQ, T = NB * S, NL = CFG_LAYERS, D = 1024;
constexpr int GW = 256, RW = 384, MW = 384, HD = 64, GH = 4, RH = 6, MH = 6, CH = 128, NCH = S / CH;
constexpr int PIN = 3480, RPROJ = 1408;
constexpr int C_RW = 512, C_MW = 1920;
constexpr int NE = 32, TOPK = 4, DFF = 1024, MOEB = 256;
constexpr int NROWS = (T * TOPK / MOEB + NE) * MOEB;
constexpr float LN_EPS = 1e-5f, GN_EPS = 64e-5f;
constexpr float ALPHA = 1.6817928305074290f;
constexpr int NTHREADS = 512, NWAVES = 8;
constexpr int LDS_BYTES = 160 * 1024;
constexpr int NPH = 12;

typedef float f32x4 __attribute__((ext_vector_type(4)));

constexpr size_t al(size_t x) { return (x + 255) & ~(size_t)255; }
constexpr size_t CTL_BYTES = 1u << 20;
constexpr size_t O_XA = CTL_BYTES;
constexpr size_t O_X1 = O_XA + al((size_t)T * D * 4);
constexpr size_t O_PROJ = O_X1 + al((size_t)T * D * 4);
constexpr size_t O_MIX = O_PROJ + al((size_t)T * PIN * 4);
constexpr size_t O_GRP = O_MIX + al((size_t)T * D * 4);
constexpr size_t O_UG = O_GRP + al((size_t)T * D * 4);
constexpr size_t O_VN = O_UG + al((size_t)T * GW * 4);
constexpr size_t O_RR = O_VN + al((size_t)T * GW * 4);
constexpr size_t O_VV = O_RR + al((size_t)T * RW * 4);
constexpr size_t O_KK = O_VV + al((size_t)T * RW * 4);
constexpr size_t O_DEC = O_KK + al((size_t)T * RW * 4);
constexpr size_t O_KD = O_DEC + al((size_t)2 * T * RW * 4);
constexpr size_t O_ICLR = O_KD + al((size_t)2 * T * RW * 4);
constexpr size_t O_GATE = O_ICLR + al((size_t)2 * T * RW * 4);
constexpr size_t O_BONUS = O_GATE + al((size_t)T * RW * 4);
constexpr size_t O_SCAN = O_BONUS + al((size_t)T * RH * 4);
constexpr size_t O_MQ = O_SCAN + al((size_t)2 * T * RW * 4);
constexpr size_t O_MK = O_MQ + al((size_t)T * MW * 4);
constexpr size_t O_IG = O_MK + al((size_t)T * MW * 4);
constexpr size_t O_LF = O_IG + al((size_t)2 * T * MH * 4);
constexpr size_t O_CL = O_LF + al((size_t)2 * T * MH * 4);
constexpr size_t O_NL = O_CL + al((size_t)2 * NB * MH * NCH * 4096 * 4);
constexpr size_t O_ML = O_NL + al((size_t)2 * NB * MH * NCH * 64 * 4);
constexpr size_t O_BL = O_ML + al((size_t)2 * NB * MH * NCH * 4);
constexpr size_t O_MIN = O_BL + al((size_t)2 * NB * MH * NCH * 4);
constexpr size_t O_TOPI = O_MIN + al((size_t)2 * NB * MH * NCH * 4);
constexpr size_t O_TOPG = O_TOPI + al((size_t)T * 4 * 4);
constexpr size_t O_RANK = O_TOPG + al((size_t)T * 4 * 4);
constexpr size_t O_SLOT = O_RANK + al((size_t)T * 4 * 4);
constexpr size_t O_ROWT = O_SLOT + al((size_t)T * 4 * 4);
constexpr size_t O_HID = O_ROWT + al((size_t)NROWS * 4);
constexpr size_t O_ACT = O_HID + al((size_t)NROWS * 2 * DFF * 4);
constexpr size_t O_YS = O_ACT + al((size_t)NROWS * DFF * 4);
constexpr size_t WS_END = O_YS + al((size_t)NROWS * D * 4);

constexpr int CW_BAR = 4096;
constexpr int CW_CNT = 16384;

struct Params { const float* in[32]; float* out; unsigned char* ws; int ph_lo, ph_hi; };

#ifdef EMU
#define WAVE_SYNC() emu_wave_barrier()
#define PIN_V(x) do {} while (0)
#define PIN_S(x) do {} while (0)
#else
#define WAVE_SYNC() __builtin_amdgcn_wave_barrier()
#define PIN_V(x) asm volatile("" : "+v"(x))
#define PIN_S(x) asm volatile("" : "+s"(x))
#endif
__device__ __forceinline__ int phase_tid() { int t = threadIdx.x; PIN_V(t); return t; }

__device__ __forceinline__ float wave_sum(float v) {
#pragma unroll
    for (int o = 32; o >= 1; o >>= 1) v += __shfl_xor(v, o);
    return v;
}
__device__ __forceinline__ float sigmoidf_(float x) { return 1.0f / (1.0f + expf(-x)); }
__device__ __forceinline__ float softplusf_(float x) { return fmaxf(x, 0.f) + log1pf(expf(-fabsf(x))); }
__device__ __forceinline__ float geluf_(float x) { return 0.5f * x * (1.0f + erff(x * 0.70710678118654752f)); }

__device__ __forceinline__ void gemm_tile_f32(float* sm, const float* A, int lda, const int* rowidx, int m0, int Mtot,
                                              const float* Bm, int ldb, int n0, int Ntot, int K, const float* bias, float* C, int ldc, int tid) {
    float* As = sm;
    float* Bs = sm + 16 * 132;
    const int ty = tid >> 4, tx = tid & 15;
    float acc[4][8];
#pragma unroll
    for (int i = 0; i < 4; ++i)
#pragma unroll
        for (int j = 0; j < 8; ++j) acc[i][j] = 0.f;
    const int ar = tid >> 2, ak = (tid & 3) * 4;
    const int bk = tid >> 5, bn = (tid & 31) * 4;
    const int grow = m0 + ar;
    const float* arow = nullptr;
    if (grow < Mtot) { const int src = rowidx ? rowidx[grow] : grow; arow = A + (size_t)src * lda; }
    const bool bvalid = (n0 + bn) < Ntot;
    for (int k0 = 0; k0 < K; k0 += 16) {
        f32x4 av = (f32x4){0.f, 0.f, 0.f, 0.f}, bv = (f32x4){0.f, 0.f, 0.f, 0.f};
        if (arow) av = *(const f32x4*)(arow + k0 + ak);
        if (bvalid) bv = *(const f32x4*)(Bm + (size_t)(k0 + bk) * ldb + n0 + bn);
        __syncthreads();
        As[(ak + 0) * 132 + ar] = av.x; As[(ak + 1) * 132 + ar] = av.y; As[(ak + 2) * 132 + ar] = av.z; As[(ak + 3) * 132 + ar] = av.w;
        *(f32x4*)&Bs[bk * 132 + bn] = bv;
        __syncthreads();
#pragma unroll
        for (int kk = 0; kk < 16; ++kk) {
            const f32x4 a4 = *(const f32x4*)&As[kk * 132 + ty * 4];
            const f32x4 b0 = *(const f32x4*)&Bs[kk * 132 + tx * 8], b1 = *(const f32x4*)&Bs[kk * 132 + tx * 8 + 4];
            const float a[4] = {a4.x, a4.y, a4.z, a4.w};
            const float b[8] = {b0.x, b0.y, b0.z, b0.w, b1.x, b1.y, b1.z, b1.w};
#pragma unroll
            for (int i = 0; i < 4; ++i)
#pragma unroll
                for (int j = 0; j < 8; ++j) acc[i][j] += a[i] * b[j];
        }
    }
#pragma unroll
    for (int i = 0; i < 4; ++i) {
        const int r = m0 + ty * 4 + i;
        if (r < Mtot) {
#pragma unroll
            for (int j = 0; j < 8; ++j) { const int c = n0 + tx * 8 + j; if (c < Ntot) C[(size_t)r * ldc + c] = acc[i][j] + (bias ? bias[c] : 0.f); }
        }
    }
    __syncthreads();
}

__device__ __forceinline__ void phase_gemm_dense(unsigned char* smem, const float* A, int lda, const float* Bm, int ldb, float* C, int ldc, int M, int N, int K) {
    const int tid = phase_tid();
    const int nmt = (M + 127) / 128, nnt = (N + 127) / 128;
    for (int u = blockIdx.x; u < nmt * nnt; u += gridDim.x) {
        const int mt = u / nnt, nt = u % nnt;
        gemm_tile_f32((float*)smem, A, lda, nullptr, mt * 128, M, Bm, ldb, nt * 128, N, K, nullptr, C, ldc, tid);
    }
}

__device__ __forceinline__ float tshift(const float* P, int t, int s, int col, const float* mu0, const float* mu1, int rc) {
    const float cur = P[(size_t)t * PIN + col];
    const float prv = s > 0 ? P[(size_t)(t - 1) * PIN + col] : 0.f;
    const float nxt = s < S - 1 ? P[(size_t)(t + 1) * PIN + col] : 0.f;
    return cur + mu0[rc] * (prv - cur) + mu1[rc] * (nxt - cur);
}

__device__ __forceinline__ void phase_prep(const Params& P, int l, unsigned char* smem) {
    unsigned char* ws = P.ws; PIN_S(ws);
    const float* proj = (const float*)(ws + O_PROJ);
    float* UG = (float*)(ws + O_UG); float* VN = (float*)(ws + O_VN);
    float* RR = (float*)(ws + O_RR); float* VV = (float*)(ws + O_VV); float* KK = (float*)(ws + O_KK);
    float* DEC = (float*)(ws + O_DEC); float* KD = (float*)(ws + O_KD); float* ICLR = (float*)(ws + O_ICLR);
    float* GATE = (float*)(ws + O_GATE); float* BONUS = (float*)(ws + O_BONUS);
    float* MQ = (float*)(ws + O_MQ); float* MKb = (float*)(ws + O_MK); float* IG = (float*)(ws + O_IG); float* LF = (float*)(ws + O_LF);
    const float* gln_g = P.in[2] + (size_t)l * GW; const float* gln_b = P.in[3] + (size_t)l * GW;
    const float* mu0 = P.in[6] + (size_t)l * 2 * RPROJ; const float* mu1 = mu0 + RPROJ;
    const float* w0 = P.in[7] + (size_t)l * 2 * RW; const float* w2 = P.in[8] + (size_t)l * 2 * 64 * RW;
    const float* a0 = P.in[9] + (size_t)l * 2 * RW; const float* a2 = P.in[10] + (size_t)l * 2 * 64 * RW;
    const float* g2 = P.in[11] + (size_t)l * 128 * RW;
    const float* k_k = P.in[12] + (size_t)l * RW; const float* k_a = P.in[13] + (size_t)l * RW; const float* r_k = P.in[14] + (size_t)l * RW;
    const float* conv_w = P.in[17] + (size_t)l * 3 * 768; const float* conv_b = P.in[18] + (size_t)l * 768; const float* gate_b = P.in[19] + (size_t)l * 24;
    float* lora = (float*)smem;
    const int tid = phase_tid(), lane = tid & 63, wave = tid >> 6;
    for (int u = blockIdx.x; u < T / 16; u += gridDim.x) {
        const int t0 = u * 16, s0 = t0 % S;
        {
            const int i = tid >> 5, l32 = tid & 31, t = t0 + i;
            float v[8]; float sum = 0.f;
#pragma unroll
            for (int j = 0; j < 8; ++j) {
                const int c = j * 32 + l32;
                UG[(size_t)t * GW + c] = geluf_(proj[(size_t)t * PIN + c]);
                v[j] = geluf_(proj[(size_t)t * PIN + GW + c]); sum += v[j];
            }
#pragma unroll
            for (int o = 16; o >= 1; o >>= 1) sum += __shfl_xor(sum, o);
            const float mean = sum * (1.0f / GW); float q = 0.f;
#pragma unroll
            for (int j = 0; j < 8; ++j) { const float d = v[j] - mean; q += d * d; }
#pragma unroll
            for (int o = 16; o >= 1; o >>= 1) q += __shfl_xor(q, o);
            const float rstd = 1.0f / sqrtf(q * (1.0f / GW) + LN_EPS);
#pragma unroll
            for (int j = 0; j < 8; ++j) { const int c = j * 32 + l32; VN[(size_t)t * GW + c] = (v[j] - mean) * rstd * gln_g[c] + gln_b[c]; }
        }
        __syncthreads();
        for (int idx = tid; idx < 16 * 256; idx += NTHREADS) {
            const int i = idx >> 8, j = idx & 255, rc = 1152 + j;
            const float x = tshift(proj, t0 + i, s0 + i, C_RW + rc, mu0, mu1, rc);
            lora[idx] = j < 64 ? tanhf(x) : (j < 128 ? x : sigmoidf_(x));
        }
        __syncthreads();
        if (wave < 6) {
            const int c = tid, h = wave;
            {
                float aw0[16], aw1[16];
#pragma unroll
                for (int i = 0; i < 16; ++i) { aw0[i] = w0[c]; aw1[i] = w0[RW + c]; }
                for (int j = 0; j < 64; ++j) {
                    const float w20 = w2[(size_t)j * RW + c], w21 = w2[(size_t)(64 + j) * RW + c];
#pragma unroll
                    for (int i = 0; i < 16; ++i) { const float lw = lora[i * 256 + j]; aw0[i] += lw * w20; aw1[i] += lw * w21; }
                }
#pragma unroll
                for (int i = 0; i < 16; ++i) {
                    const size_t o = (size_t)(t0 + i) * RW + c;
                    DEC[o] = expf(-expf(-softplusf_(-aw0[i]) - 0.5f)); DEC[(size_t)T * RW + o] = expf(-expf(-softplusf_(-aw1[i]) - 0.5f));
                }
            }
            {
                float aa0[16], aa1[16];
#pragma unroll
                for (int i = 0; i < 16; ++i) { aa0[i] = a0[c]; aa1[i] = a0[RW + c]; }
                for (int j = 0; j < 64; ++j) {
                    const float a20 = a2[(size_t)j * RW + c], a21 = a2[(size_t)(64 + j) * RW + c];
#pragma unroll
                    for (int i = 0; i < 16; ++i) { const float la = lora[i * 256 + 64 + j]; aa0[i] += la * a20; aa1[i] += la * a21; }
                }
#pragma unroll
                for (int i = 0; i < 16; ++i) {
                    const size_t o = (size_t)(t0 + i) * RW + c;
                    ICLR[o] = sigmoidf_(aa0[i]); ICLR[(size_t)T * RW + o] = sigmoidf_(aa1[i]);
                }
            }
            {
                float ag[16];
#pragma unroll
                for (int i = 0; i < 16; ++i) ag[i] = 0.f;
                for (int j = 0; j < 128; ++j) {
                    const float g = g2[(size_t)j * RW + c];
#pragma unroll
                    for (int i = 0; i < 16; ++i) ag[i] += lora[i * 256 + 128 + j] * g;
                }
#pragma unroll
                for (int i = 0; i < 16; ++i) GATE[(size_t)(t0 + i) * RW + c] = ag[i];
            }
            const float kkc = k_k[c], kac = k_a[c], rkc = r_k[c];
#pragma unroll
            for (int i = 0; i < 16; ++i) {
                const int t = t0 + i, s = s0 + i;
                const float r = tshift(proj, t, s, C_RW + c, mu0, mu1, c);
                const float k = tshift(proj, t, s, C_RW + RW + c, mu0, mu1, RW + c);
                const float v = tshift(proj, t, s, C_RW + 2 * RW + c, mu0, mu1, 2 * RW + c);
                const size_t o = (size_t)t * RW + c;
                const float ic0 = ICLR[o], ic1 = ICLR[(size_t)T * RW + o];
                const float kq = k * kkc;
                const float n2 = wave_sum(kq * kq);
                const float kk = kq / fmaxf(sqrtf(n2), 1e-12f);
                const float kd0 = k * (1.0f + (ic0 - 1.0f) * kac), kd1 = k * (1.0f + (ic1 - 1.0f) * kac);
                const float bon = wave_sum(r * (kd0 + kd1) * rkc);
                RR[o] = r; VV[o] = v; KK[o] = kk;
                KD[o] = kd0; KD[(size_t)T * RW + o] = kd1;
                if (lane == 0) BONUS[(size_t)t * RH + h] = bon;
            }
        }
        for (int idx = tid; idx < 16 * 768; idx += NTHREADS) {
            const int i = idx / 768, c = idx % 768, t = t0 + i, s = s0 + i, col = C_MW + c;
            const float xm = s > 0 ? proj[(size_t)(t - 1) * PIN + col] : 0.f;
            const float x0 = proj[(size_t)t * PIN + col];
            const float xp = s < S - 1 ? proj[(size_t)(t + 1) * PIN + col] : 0.f;
            float y = conv_b[c] + xm * conv_w[c] + x0 * conv_w[768 + c] + xp * conv_w[2 * 768 + c];
            y = y * sigmoidf_(y);
            if (c < MW) MQ[(size_t)t * MW + c] = y; else MKb[(size_t)t * MW + (c - MW)] = y * 0.125f;
        }
        for (int idx = tid; idx < 16 * 24; idx += NTHREADS) {
            const int i = idx / 24, gi = idx % 24, t = t0 + i;
            const int isf = gi / 12, dir = (gi / 6) & 1, h = gi % 6;
            const float g = proj[(size_t)t * PIN + 3456 + gi] + gate_b[gi];
            if (isf) LF[((size_t)dir * T + t) * MH + h] = -softplusf_(-g); else IG[((size_t)dir * T + t) * MH + h] = g;
        }
        __syncthreads();
    }
}

__device__ __forceinline__ void phase_gmlp_mix(const Params& P, int l, unsigned char* smem) {
    unsigned char* ws = P.ws; PIN_S(ws);
    const float* UG = (const float*)(ws + O_UG); const float* VN = (const float*)(ws + O_VN); float* GRP = (float*)(ws + O_GRP);
    const float* gws = P.in[4] + (size_t)l * GH * CH * CH; const float* gbs = P.in[5] + (size_t)l * GH * CH;
    float* vs = (float*)smem;
    float* wsm = vs + 128 * 64;
    const int tid = phase_tid();
    for (int u = blockIdx.x; u < NB * NCH * GH; u += gridDim.x) {
        const int h = u % GH, c = (u / GH) % NCH, b = u / (GH * NCH);
        const int tok0 = b * S + c * CH;
        __syncthreads();
        for (int idx = tid; idx < 128 * 64; idx += NTHREADS) { const int q = idx >> 6, e = idx & 63; vs[idx] = VN[(size_t)(tok0 + q) * GW + h * 64 + e]; }
        for (int idx = tid; idx < 128 * 128; idx += NTHREADS) wsm[idx] = gws[(size_t)h * CH * CH + idx];
        __syncthreads();
        const int p = tid >> 2, eg = (tid & 3) * 16;
        float acc[16];
#pragma unroll
        for (int e = 0; e < 16; ++e) acc[e] = 0.f;
        for (int q = 0; q < 128; ++q) {
            const float w = wsm[p * 128 + q];
#pragma unroll
            for (int e = 0; e < 16; ++e) acc[e] += w * vs[q * 64 + eg + e];
        }
        const float bsv = gbs[h * CH + p];
#pragma unroll
        for (int e = 0; e < 16; ++e) {
            const size_t t = (size_t)(tok0 + p);
            GRP[t * D + h * 64 + eg + e] = UG[t * GW + h * 64 + eg + e] * (acc[e] + bsv);
        }
    }
    __syncthreads();
}

__device__ __forceinline__ void phase_rwkv_scan(const Params& P, int l, unsigned char* smem) {
    unsigned char* ws = P.ws; PIN_S(ws);
    const float* RR = (const float*)(ws + O_RR); const float* VV = (const float*)(ws + O_VV); const float* KK = (const float*)(ws + O_KK);
    const float* DEC = (const float*)(ws + O_DEC); const float* KD = (const float*)(ws + O_KD); const float* ICLR = (const float*)(ws + O_ICLR);
    float* SCAN = (float*)(ws + O_SCAN);
    const int tid = phase_tid(), lane = tid & 63, wave = tid >> 6;
    float* vec = (float*)smem + wave * 320;
    const int gw = wave * (int)gridDim.x + (int)blockIdx.x, ngw = NWAVES * (int)gridDim.x;
    for (int u = gw; u < 2 * NB * RH; u += ngw) {
        const int h = u % RH, b = (u / RH) % NB, d = u / (RH * NB);
        float st[64];
#pragma unroll
        for (int k = 0; k < 64; ++k) st[k] = 0.f;
        const size_t doff = (size_t)d * T * RW;
        for (int tau = 0; tau < S; ++tau) {
            const int s = d ? S - 1 - tau : tau;
            const size_t idx = (size_t)(b * S + s) * RW + h * 64 + lane;
            const float w = DEC[doff + idx], kkv = KK[idx], ic = ICLR[doff + idx], kd = KD[doff + idx], r = RR[idx], v = VV[idx];
            vec[lane] = w; vec[64 + lane] = -kkv; vec[128 + lane] = kkv * ic; vec[192 + lane] = kd; vec[256 + lane] = r;
            WAVE_SYNC();
            float sa = 0.f;
#pragma unroll
            for (int k = 0; k < 64; ++k) sa += st[k] * vec[64 + k];
            float out = 0.f;
#pragma unroll
            for (int k = 0; k < 64; ++k) { st[k] = st[k] * vec[k] + sa * vec[128 + k] + v * vec[192 + k]; out += st[k] * vec[256 + k]; }
            SCAN[doff + idx] = out;
            WAVE_SYNC();
        }
    }
}

__device__ __forceinline__ void phase_mlstm_local(const Params& P, int l, unsigned char* smem) {
    unsigned char* ws = P.ws; PIN_S(ws);
    const float* proj = (const float*)(ws + O_PROJ); const float* MKb = (const float*)(ws + O_MK);
    const float* IG = (const float*)(ws + O_IG); const float* LF = (const float*)(ws + O_LF);
    float* CL = (float*)(ws + O_CL); float* NLb = (float*)(ws + O_NL); float* ML = (float*)(ws + O_ML); float* BL = (float*)(ws + O_BL);
    float* ks = (float*)smem;
    float* vs = ks + 128 * 64;
    float* wts = vs + 128 * 64;
    float* lfv = wts + 128; float* igv = lfv + 128;
    int* tok = (int*)(igv + 128);
    const int tid = phase_tid();
    for (int u = blockIdx.x; u < 2 * NB * MH * NCH; u += gridDim.x) {
        const int c = u % NCH, h = (u / NCH) % MH, p = u / (NCH * MH), d = p / NB, b = p % NB;
        __syncthreads();
        if (tid < 128) {
            const int tau = c * CH + tid, s = d ? S - 1 - tau : tau, t = b * S + s;
            tok[tid] = t; lfv[tid] = LF[((size_t)d * T + t) * MH + h]; igv[tid] = IG[((size_t)d * T + t) * MH + h];
        }
        __syncthreads();
        for (int idx = tid; idx < 128 * 64; idx += NTHREADS) {
            const int j = idx >> 6, e = idx & 63; const size_t t = (size_t)tok[j];
            ks[idx] = MKb[t * MW + h * 64 + e]; vs[idx] = proj[t * PIN + C_MW + 2 * MW + h * 64 + e];
        }
        if (tid == 0) {
            float bc = 0.f;
            for (int j = 0; j < 128; ++j) { bc += lfv[j]; wts[j] = bc; }
            const float blast = bc; float m = -INFINITY;
            for (int j = 0; j < 128; ++j) { const float lw = blast - wts[j] + igv[j]; wts[j] = lw; m = fmaxf(m, lw); }
            for (int j = 0; j < 128; ++j) wts[j] = expf(wts[j] - m);
            ML[u] = m; BL[u] = blast;
        }
        __syncthreads();
        const int dk = tid >> 3, dv = (tid & 7) * 8;
        float acc[8]; float nacc = 0.f;
#pragma unroll
        for (int e = 0; e < 8; ++e) acc[e] = 0.f;
        for (int j = 0; j < 128; ++j) {
            const float kw = wts[j] * ks[j * 64 + dk];
            nacc += kw;
#pragma unroll
            for (int e = 0; e < 8; ++e) acc[e] += kw * vs[j * 64 + dv + e];
        }
#pragma unroll
        for (int e = 0; e < 8; ++e) CL[(size_t)u * 4096 + dk * 64 + dv + e] = acc[e];
        if (dv == 0) NLb[(size_t)u * 64 + dk] = nacc;
    }
    __syncthreads();
}

__device__ __forceinline__ void phase_mlstm_carry(const Params& P, int l, unsigned char* smem) {
    unsigned char* ws = P.ws; PIN_S(ws);
    float* CL = (float*)(ws + O_CL); float* NLb = (float*)(ws + O_NL); const float* ML = (const float*)(ws + O_ML); const float* BL = (const float*)(ws + O_BL);
    float* MIN = (float*)(ws + O_MIN);
    const int total = 2 * NB * MH * 4160;
    const int tid = phase_tid();
    for (int g = blockIdx.x * NTHREADS + tid; g < total; g += gridDim.x * NTHREADS) {
        const int ph = g / 4160, e = g % 4160;
        float m = 0.f, val = 0.f;
        for (int c = 0; c < NCH; ++c) {
            const int base = ph * NCH + c;
            float* ptr = e < 4096 ? CL + (size_t)base * 4096 + e : NLb + (size_t)base * 64 + (e - 4096);
            const float loc = *ptr;
            *ptr = val;
            if (e == 0) MIN[base] = m;
            const float bl = BL[base], ml = ML[base];
            const float mn = fmaxf(bl + m, ml);
            val = expf(bl + m - mn) * val + expf(ml - mn) * loc;
            m = mn;
        }
    }
}

__device__ __forceinline__ void phase_mlstm_out(const Params& P, int l, unsigned char* smem) {
    unsigned char* ws = P.ws; PIN_S(ws);
    const float* proj = (const float*)(ws + O_PROJ); const float* MQ = (const float*)(ws + O_MQ); const float* MKb = (const float*)(ws + O_MK);
    const float* IG = (const float*)(ws + O_IG); const float* LF = (const float*)(ws + O_LF);
    const float* CL = (const float*)(ws + O_CL); const float* NLb = (const float*)(ws + O_NL); const float* MIN = (const float*)(ws + O_MIN);
    float* GRP = (float*)(ws + O_GRP);
    const float* mln_g = P.in[20] + (size_t)l * MW;
    float* qs = (float*)smem; float* ks = qs + 128 * 64; float* vs = ks + 128 * 64;
    float* Cs = vs + 128 * 64;
    float* ns = Cs + 4096;
    float* bcv = ns + 64; float* gv = bcv + 128; float* pmx = gv + 128;
    const int tid = phase_tid();
    for (int u = blockIdx.x; u < NB * MH * NCH; u += gridDim.x) {
        const int tc = u % NCH, h = (u / NCH) % MH, b = u / (NCH * MH);
        const int tok0 = b * S + tc * CH;
        __syncthreads();
        for (int idx = tid; idx < 128 * 64; idx += NTHREADS) {
            const int i = idx >> 6, e = idx & 63; const size_t t = (size_t)(tok0 + i);
            qs[idx] = MQ[t * MW + h * 64 + e]; ks[idx] = MKb[t * MW + h * 64 + e]; vs[idx] = proj[t * PIN + C_MW + 2 * MW + h * 64 + e];
        }
        const int itok = tid >> 2, eg = (tid & 3) * 16;
        float hsum[16];
#pragma unroll
        for (int e = 0; e < 16; ++e) hsum[e] = 0.f;
        for (int d = 0; d < 2; ++d) {
            const int cd = d ? NCH - 1 - tc : tc;
            const int su = ((d * NB + b) * MH + h) * NCH + cd;
            __syncthreads();
            if (tid == 0) {
                float bc = 0.f, pm = -INFINITY;
                for (int j = 0; j < 128; ++j) {
                    const int i = d ? 127 - j : j; const size_t t = (size_t)(tok0 + i);
                    bc += LF[((size_t)d * T + t) * MH + h];
                    const float g = IG[((size_t)d * T + t) * MH + h] - bc;
                    pm = fmaxf(pm, g);
                    bcv[j] = bc; gv[j] = g; pmx[j] = pm;
                }
            }
            for (int idx = tid; idx < 4096; idx += NTHREADS) Cs[idx] = CL[(size_t)su * 4096 + idx];
            if (tid < 64) ns[tid] = NLb[(size_t)su * 64 + tid];
            const float mst = MIN[su];
            __syncthreads();
            const int j = d ? 127 - itok : itok;
            const float mx = fmaxf(pmx[j], mst), mt = bcv[j] + mx;
            float qrow[64];
#pragma unroll
            for (int k = 0; k < 64; ++k) qrow[k] = qs[itok * 64 + k];
            float acc[16]; float den = 0.f;
#pragma unroll
            for (int e = 0; e < 16; ++e) acc[e] = 0.f;
            for (int jj = 0; jj <= j; ++jj) {
                const int i2 = d ? 127 - jj : jj;
                float dot = 0.f;
#pragma unroll
                for (int k = 0; k < 64; ++k) dot += qrow[k] * ks[i2 * 64 + k];
                const float sw = dot * expf(gv[jj] - mx);
                den += sw;
#pragma unroll
                for (int e = 0; e < 16; ++e) acc[e] += sw * vs[i2 * 64 + eg + e];
            }
            const float wint = expf(mst - mx);
            float qn = 0.f; float qc[16];
#pragma unroll
            for (int e = 0; e < 16; ++e) qc[e] = 0.f;
#pragma unroll
            for (int k = 0; k < 64; ++k) {
                qn += qrow[k] * ns[k];
#pragma unroll
                for (int e = 0; e < 16; ++e) qc[e] += qrow[k] * Cs[k * 64 + eg + e];
            }
            den += wint * qn;
            const float dd = fmaxf(fabsf(den), expf(-mt));
#pragma unroll
            for (int e = 0; e < 16; ++e) hsum[e] += (acc[e] + wint * qc[e]) / dd;
        }
        float sm = 0.f;
#pragma unroll
        for (int e = 0; e < 16; ++e) sm += hsum[e];
        sm += __shfl_xor(sm, 1); sm += __shfl_xor(sm, 2);
        const float mean = sm * (1.0f / 64.0f); float q = 0.f;
#pragma unroll
        for (int e = 0; e < 16; ++e) { const float dlt = hsum[e] - mean; q += dlt * dlt; }
        q += __shfl_xor(q, 1); q += __shfl_xor(q, 2);
        const float rstd = 1.0f / sqrtf(q * (1.0f / 64.0f) + LN_EPS);
        const size_t t = (size_t)(tok0 + itok);
#pragma unroll
        for (int e = 0; e < 16; ++e) {
            const int c = h * 64 + eg + e;
            const float o = proj[t * PIN + C_MW + 3 * MW + c];
            GRP[t * D + GW + RW + c] = sigmoidf_(o) * ((hsum[e] - mean) * rstd * mln_g[c]);
        }
    }
    __syncthreads();
}

__device__ __forceinline__ void phase_rwkv_post(const Params& P, int l, unsigned char* smem) {
    unsigned char* ws = P.ws; PIN_S(ws);
    const float* SCAN = (const float*)(ws + O_SCAN); const float* VV = (const float*)(ws + O_VV); const float* GATE = (const float*)(ws + O_GATE);
    const float* BONUS = (const float*)(ws + O_BONUS); float* GRP = (float*)(ws + O_GRP);
    const float* rln_g = P.in[15] + (size_t)l * RW; const float* rln_b = P.in[16] + (size_t)l * RW;
    const int tid = phase_tid(), lane = tid & 63, wave = tid >> 6;
    const int gw = (int)blockIdx.x * NWAVES + wave, ngw = NWAVES * (int)gridDim.x;
    for (int it = gw; it < T * RH; it += ngw) {
        const int t = it / RH, h = it % RH, c = h * 64 + lane;
        const size_t o = (size_t)t * RW + c;
        const float x = SCAN[o] + SCAN[(size_t)T * RW + o];
        const float mean = wave_sum(x) * (1.0f / 64.0f);
        const float dl = x - mean;
        const float var = wave_sum(dl * dl) * (1.0f / 64.0f);
        float y = dl / sqrtf(var + GN_EPS) * rln_g[c] + rln_b[c];
        y += BONUS[(size_t)t * RH + h] * VV[o];
        GRP[(size_t)t * D + GW + c] = y * GATE[o];
    }
}

__device__ __forceinline__ void phase_ln1_router(const Params& P, int l, unsigned char* smem) {
    unsigned char* ws = P.ws; PIN_S(ws);
    const float* xin = l == 0 ? P.in[0] : (const float*)(ws + O_XA);
    const float* MIX = (const float*)(ws + O_MIX); float* X1 = (float*)(ws + O_X1);
    int* TOPI = (int*)(ws + O_TOPI); float* TOPG = (float*)(ws + O_TOPG); int* RANK = (int*)(ws + O_RANK); int* ROWT = (int*)(ws + O_ROWT);
    unsigned* CNT = (unsigned*)ws + CW_CNT + 64 * l;
    const float* g1 = P.in[22] + (size_t)l * D; const float* b1 = P.in[23] + (size_t)l * D;
    const float* rw = P.in[24] + (size_t)l * D * NE; const float* rb = P.in[25] + (size_t)l * NE;
    const int tid = phase_tid(), lane = tid & 63, wave = tid >> 6;
    float* xrow = (float*)smem + wave * D;
    const int gw = (int)blockIdx.x * NWAVES + wave, ngw = NWAVES * (int)gridDim.x;
    for (int i = (int)blockIdx.x * NTHREADS + tid; i < NROWS; i += (int)gridDim.x * NTHREADS) ROWT[i] = 0;
    for (int t = gw; t < T; t += ngw) {
        float v[16]; float sm = 0.f;
#pragma unroll
        for (int j = 0; j < 4; ++j) {
            const int c = j * 256 + lane * 4;
            const f32x4 a = *(const f32x4*)(xin + (size_t)t * D + c), m = *(const f32x4*)(MIX + (size_t)t * D + c);
            v[j * 4 + 0] = ALPHA * a.x + m.x; v[j * 4 + 1] = ALPHA * a.y + m.y; v[j * 4 + 2] = ALPHA * a.z + m.z; v[j * 4 + 3] = ALPHA * a.w + m.w;
            sm += (v[j * 4] + v[j * 4 + 1]) + (v[j * 4 + 2] + v[j * 4 + 3]);
        }
        const float mean = wave_sum(sm) * (1.0f / D); float q = 0.f;
#pragma unroll
        for (int j = 0; j < 16; ++j) { const float dl = v[j] - mean; q += dl * dl; }
        const float rstd = 1.0f / sqrtf(wave_sum(q) * (1.0f / D) + LN_EPS);
        WAVE_SYNC();
#pragma unroll
        for (int j = 0; j < 4; ++j) {
            const int c = j * 256 + lane * 4;
            f32x4 o;
            o.x = (v[j * 4 + 0] - mean) * rstd * g1[c + 0] + b1[c + 0]; o.y = (v[j * 4 + 1] - mean) * rstd * g1[c + 1] + b1[c + 1];
            o.z = (v[j * 4 + 2] - mean) * rstd * g1[c + 2] + b1[c + 2]; o.w = (v[j * 4 + 3] - mean) * rstd * g1[c + 3] + b1[c + 3];
            *(f32x4*)(X1 + (size_t)t * D + c) = o;
            *(f32x4*)(xrow + c) = o;
        }
        WAVE_SYNC();
        const int e = lane & 31, half = lane >> 5;
        float lg = 0.f;
        for (int c = half * 512; c < half * 512 + 512; ++c) lg += xrow[c] * rw[(size_t)c * NE + e];
        lg += __shfl_xor(lg, 32);
        lg += rb[e];
        float cur = lg; float tv[4]; int ti[4];
#pragma unroll
        for (int k = 0; k < 4; ++k) {
            float bv = cur; int bi = e;
#pragma unroll
            for (int o = 16; o >= 1; o >>= 1) {
                const float ov = __shfl_xor(bv, o); const int oi = __shfl_xor(bi, o);
                if (ov > bv || (ov == bv && oi < bi)) { bv = ov; bi = oi; }
            }
            tv[k] = bv; ti[k] = bi;
            if (e == bi) cur = -INFINITY;
        }
        const float e1 = expf(tv[1] - tv[0]), e2 = expf(tv[2] - tv[0]), e3 = expf(tv[3] - tv[0]);
        const float inv = 1.0f / (1.0f + e1 + e2 + e3);
        if (lane < 4) {
            const int myi = lane == 0 ? ti[0] : (lane == 1 ? ti[1] : (lane == 2 ? ti[2] : ti[3]));
            const float myg = (lane == 0 ? 1.0f : (lane == 1 ? e1 : (lane == 2 ? e2 : e3))) * inv;
            TOPI[(size_t)t * 4 + lane] = myi; TOPG[(size_t)t * 4 + lane] = myg;
            RANK[(size_t)t * 4 + lane] = (int)atomicAdd(CNT + myi, 1u);
        }
    }
}

__device__ __forceinline__ void moe_offsets(int* sh, const unsigned* CNT, int tid) {
    if (tid == 0) {
        int acc = 0;
        for (int e = 0; e < NE; ++e) { const int c = (int)CNT[e]; sh[e] = c; sh[32 + e] = acc; acc += (c + MOEB - 1) / MOEB * MOEB; sh[64 + e] = acc; }
    }
    __syncthreads();
}
__device__ __forceinline__ int moe_expert_of_row(const int* sh, int r) {
    int e = -1;
    for (int i = 0; i < NE; ++i) if (r >= sh[32 + i] && r < sh[64 + i]) e = i;
    return e;
}

__device__ __forceinline__ void phase_scatter(const Params& P, int l, unsigned char* smem) {
    unsigned char* ws = P.ws; PIN_S(ws);
    const int tid = phase_tid();
    const int* TOPI = (const int*)(ws + O_TOPI); const int* RANK = (const int*)(ws + O_RANK); int* SLOT = (int*)(ws + O_SLOT); int* ROWT = (int*)(ws + O_ROWT);
    const unsigned* CNT = (const unsigned*)ws + CW_CNT + 64 * l;
    int* sh = (int*)smem;
    moe_offsets(sh, CNT, tid);
    for (int a = (int)blockIdx.x * NTHREADS + tid; a < T * 4; a += (int)gridDim.x * NTHREADS) {
        const int e = TOPI[a], dest = sh[32 + e] + RANK[a];
        ROWT[dest] = a >> 2; SLOT[a] = dest;
    }
    __syncthreads();
}

template <int WHICH>
__device__ __forceinline__ void phase_moe_gemm(const Params& P, int l, unsigned char* smem) {
    unsigned char* ws = P.ws; PIN_S(ws);
    const int tid = phase_tid();
    const unsigned* CNT = (const unsigned*)ws + CW_CNT + 64 * l;
    int* sh = (int*)(smem + 32768);
    moe_offsets(sh, CNT, tid);
    const int N = WHICH == 1 ? 2 * DFF : D;
    const int nnt = N / 128, nmt = NROWS / 128;
    const float* A = WHICH == 1 ? (const float*)(ws + O_X1) : (const float*)(ws + O_ACT);
    const int* rowidx = WHICH == 1 ? (const int*)(ws + O_ROWT) : nullptr;
    float* C = WHICH == 1 ? (float*)(ws + O_HID) : (float*)(ws + O_YS);
    const float* W = WHICH == 1 ? P.in[26] + (size_t)l * NE * D * 2 * DFF : P.in[28] + (size_t)l * NE * DFF * D;
    const float* Bi = WHICH == 1 ? P.in[27] + (size_t)l * NE * 2 * DFF : P.in[29] + (size_t)l * NE * D;
    for (int u = blockIdx.x; u < nmt * nnt; u += gridDim.x) {
        const int mt = u / nnt, nt = u % nnt, r0 = mt * 128;
        const int e = moe_expert_of_row(sh, r0);
        if (e < 0 || r0 >= sh[32 + e] + sh[e]) continue;
        gemm_tile_f32((float*)smem, A, WHICH == 1 ? D : DFF, rowidx, r0, NROWS, W + (size_t)e * 1024 * N, N, nt * 128, N, 1024, Bi + (size_t)e * N, C, N, tid);
    }
    __syncthreads();
}

__device__ __forceinline__ void phase_moe_act(const Params& P, int l, unsigned char* smem) {
    unsigned char* ws = P.ws; PIN_S(ws);
    const int tid = phase_tid();
    const unsigned* CNT = (const unsigned*)ws + CW_CNT + 64 * l;
    int* sh = (int*)smem;
    moe_offsets(sh, CNT, tid);
    const float* HID = (const float*)(ws + O_HID); float* ACT = (float*)(ws + O_ACT);
    for (int mt = blockIdx.x; mt < NROWS / 128; mt += gridDim.x) {
        const int r0 = mt * 128, e = moe_expert_of_row(sh, r0);
        if (e < 0 || r0 >= sh[32 + e] + sh[e]) continue;
        for (int idx = tid; idx < 128 * DFF; idx += NTHREADS) {
            const int r = r0 + idx / DFF, c = idx % DFF;
            float g = HID[(size_t)r * 2 * DFF + c], uu = HID[(size_t)r * 2 * DFF + DFF + c];
            g = fminf(g, 7.0f); uu = fminf(fmaxf(uu, -7.0f), 7.0f);
            ACT[(size_t)r * DFF + c] = (uu + 1.0f) * (g * sigmoidf_(g * 1.702f));
        }
    }
    __syncthreads();
}

__device__ __forceinline__ void phase_combine_ln2(const Params& P, int l, unsigned char* smem) {
    unsigned char* ws = P.ws; PIN_S(ws);
    const float* X1 = (const float*)(ws + O_X1); const float* YS = (const float*)(ws + O_YS);
    const int* SLOT = (const int*)(ws + O_SLOT); const float* TOPG = (const float*)(ws + O_TOPG);
    float* xo = l == NL - 1 ? P.out : (float*)(ws + O_XA);
    const float* g2 = P.in[30] + (size_t)l * D; const float* b2 = P.in[31] + (size_t)l * D;
    const int tid = phase_tid(), lane = tid & 63, wave = tid >> 6;
    const int gw = (int)blockIdx.x * NWAVES + wave, ngw = NWAVES * (int)gridDim.x;
    for (int t = gw; t < T; t += ngw) {
        int sl[4]; float gg[4];
#pragma unroll
        for (int k = 0; k < 4; ++k) { sl[k] = SLOT[(size_t)t * 4 + k]; gg[k] = TOPG[(size_t)t * 4 + k]; }
        float v[16]; float sm = 0.f;
#pragma unroll
        for (int j = 0; j < 4; ++j) {
            const int c = j * 256 + lane * 4;
            const f32x4 a = *(const f32x4*)(X1 + (size_t)t * D + c);
            f32x4 y = (f32x4){0.f, 0.f, 0.f, 0.f};
#pragma unroll
            for (int k = 0; k < 4; ++k) { const f32x4 yk = *(const f32x4*)(YS + (size_t)sl[k] * D + c); y.x += gg[k] * yk.x; y.y += gg[k] * yk.y; y.z += gg[k] * yk.z; y.w += gg[k] * yk.w; }
            v[j * 4 + 0] = ALPHA * a.x + y.x; v[j * 4 + 1] = ALPHA * a.y + y.y; v[j * 4 + 2] = ALPHA * a.z + y.z; v[j * 4 + 3] = ALPHA * a.w + y.w;
            sm += (v[j * 4] + v[j * 4 + 1]) + (v[j * 4 + 2] + v[j * 4 + 3]);
        }
        const float mean = wave_sum(sm) * (1.0f / D); float q = 0.f;
#pragma unroll
        for (int j = 0; j < 16; ++j) { const float dl = v[j] - mean; q += dl * dl; }
        const float rstd = 1.0f / sqrtf(wave_sum(q) * (1.0f / D) + LN_EPS);
#pragma unroll
        for (int j = 0; j < 4; ++j) {
            const int c = j * 256 + lane * 4;
            f32x4 o;
            o.x = (v[j * 4 + 0] - mean) * rstd * g2[c + 0] + b2[c + 0]; o.y = (v[j * 4 + 1] - mean) * rstd * g2[c + 1] + b2[c + 1];
            o.z = (v[j * 4 + 2] - mean) * rstd * g2[c + 2] + b2[c + 2]; o.w = (v[j * 4 + 3] - mean) * rstd * g2[c + 3] + b2[c + 3];
            *(f32x4*)(xo + (size_t)t * D + c) = o;
        }
    }
}

#ifndef EMU
#define XB_TMO      128
#define XB_XCNT(j)  (256  + 64 * (j))
#define XB_XSUB(j)  (1280 + 64 * (j))
#define XB_XGEN(j)  (2304 + 64 * (j))
#define XB_TOP      3328
#define XB_TOPGEN   3392
#define XCD_BAR_WORDS 3456
#define XB_SPIN_CAP (1u << 25)
#define LAS __attribute__((address_space(3)))
__device__ __forceinline__ unsigned xb_ld(unsigned* p)              { return __hip_atomic_load(p, __ATOMIC_RELAXED, __HIP_MEMORY_SCOPE_AGENT); }
__device__ __forceinline__ unsigned xb_add(unsigned* p, unsigned v) { return __hip_atomic_fetch_add(p, v, __ATOMIC_RELAXED, __HIP_MEMORY_SCOPE_AGENT); }
__device__ __forceinline__ unsigned xb_xcc_id() { return (unsigned)__builtin_amdgcn_s_getreg((3 << 11) | 20) & 0xFu; }
#define XB_SPIN(cond, bar) do { unsigned _sp = 0; while (cond) { __builtin_amdgcn_s_sleep(1); \
    if ((++_sp & 255u) == 0u) { if (xb_ld(&(bar)[XB_TMO])) break; if (_sp > XB_SPIN_CAP) { atomicAdd(&(bar)[XB_TMO], 1u); break; } } } } while (0)
struct XcdBarrier { unsigned* bar; unsigned x; volatile LAS unsigned* st; };
__device__ __forceinline__ XcdBarrier xcd_barrier_post(unsigned* bar, volatile LAS unsigned* st) {
    XcdBarrier b; b.bar = bar; b.x = xb_xcc_id(); b.st = st;
    if (threadIdx.x == 0) (void)xb_add(&bar[XB_XCNT(b.x)], 1u);
    return b;
}
__device__ __forceinline__ void xcd_barrier_complete(unsigned* bar, unsigned x, unsigned& nloc, unsigned& nx) {
    const unsigned G = gridDim.x * gridDim.y * gridDim.z;
    unsigned sum, cnt, mine, sp = 0u;
    for (;;) {
        sum = 0u; cnt = 0u; mine = 0u;
#pragma unroll
        for (unsigned j = 0; j < 16; ++j) { const unsigned c = xb_ld(&bar[XB_XCNT(j)]); sum += c; cnt += (c > 0u) ? 1u : 0u; mine = (j == x) ? c : mine; }
        if (sum == G) break;
        __builtin_amdgcn_s_sleep(1);
        if ((++sp & 255u) == 0u) { if (xb_ld(&bar[XB_TMO])) break; if (sp > XB_SPIN_CAP) { atomicAdd(&bar[XB_TMO], 1u); break; } }
    }
    nloc = mine > 0u ? mine : 1u; nx = cnt > 0u ? cnt : 1u;
}
__device__ __forceinline__ void xcd_barrier(const XcdBarrier& b) {
    asm volatile("s_waitcnt vmcnt(0)" ::: "memory");
    __syncthreads();
    if (threadIdx.x == 0) {
        unsigned* bar = b.bar;
        __builtin_amdgcn_s_waitcnt(0);
        unsigned nloc = b.st[0], nx = b.st[1];
        if (nloc == 0u) { xcd_barrier_complete(bar, b.x, nloc, nx); b.st[0] = nloc; b.st[1] = nx; }
        const unsigned old = xb_add(&bar[XB_XSUB(b.x)], 1u);
        const unsigned gen = old / nloc;
        if (old + 1u == (gen + 1u) * nloc) {
            __builtin_amdgcn_fence(__ATOMIC_RELEASE, "agent");
            asm volatile("s_waitcnt vmcnt(0)" ::: "memory");
            const unsigned og = xb_add(&bar[XB_TOP], 1u);
            const unsigned tg = og / nx;
            if (og + 1u == (tg + 1u) * nx) xb_add(&bar[XB_TOPGEN], 1u);
            else XB_SPIN(xb_ld(&bar[XB_TOPGEN]) == tg, bar);
            __builtin_amdgcn_fence(__ATOMIC_ACQUIRE, "agent");
            xb_add(&bar[XB_XGEN(b.x)], 1u);
            asm volatile("s_waitcnt vmcnt(0)" ::: "memory");
        } else {
            XB_SPIN(xb_ld(&bar[XB_XGEN(b.x)]) == gen, bar);
            __builtin_amdgcn_fence(__ATOMIC_ACQUIRE, "agent");
            asm volatile("s_waitcnt vmcnt(0)" ::: "memory");
        }
    }
    __syncthreads();
}
#endif

__global__ void __launch_bounds__(512, 2) mk_fwd(Params P) {
#ifdef EMU
    unsigned char* smem = g_blk->lds;
#else
    extern __shared__ __attribute__((aligned(16))) unsigned char smem[];
    volatile LAS unsigned* bst = (volatile LAS unsigned*)(smem + LDS_BYTES - 16);
    if (threadIdx.x == 0) { bst[0] = 0u; bst[1] = 0u; bst[2] = 0u; bst[3] = 0u; }
    __syncthreads();
    XcdBarrier bar; bar.bar = (unsigned*)P.ws + CW_BAR; bar.x = 0; bar.st = bst;
    if (P.ph_hi - P.ph_lo > 1) bar = xcd_barrier_post((unsigned*)P.ws + CW_BAR, bst);
#endif
    unsigned char* ws = P.ws;
    const int lo = P.ph_lo, hi = P.ph_hi;
#ifdef EMU
#define SEAM(id) do {} while (0)
#else
#define SEAM(id) do { if ((id) + 1 < hi) xcd_barrier(bar); } while (0)
#endif
#ifndef MK_ONLY_PHASE
#define MK_ONLY_PHASE -1
#endif
#define PH(k, body) do { if (MK_ONLY_PHASE < 0 || MK_ONLY_PHASE == (k)) { const int id_ = l * NPH + (k); if (id_ >= lo && id_ < hi) { body; SEAM(id_); } } } while (0)
    for (int l = 0; l < NL; ++l) {
        const float* xin = l == 0 ? P.in[0] : (const float*)(ws + O_XA);
        PH(0, phase_gemm_dense(smem, xin, D, P.in[1] + (size_t)l * D * PIN, PIN, (float*)(ws + O_PROJ), PIN, T, PIN, D));
        PH(1, phase_prep(P, l, smem));
        PH(2, { phase_gmlp_mix(P, l, smem); phase_mlstm_local(P, l, smem); phase_rwkv_scan(P, l, smem); });
        PH(3, phase_mlstm_carry(P, l, smem));
        PH(4, { phase_mlstm_out(P, l, smem); phase_rwkv_post(P, l, smem); });
        PH(5, phase_gemm_dense(smem, (const float*)(ws + O_GRP), D, P.in[21] + (size_t)l * D * D, D, (float*)(ws + O_MIX), D, T, D, D));
        PH(6, phase_ln1_router(P, l, smem));
        PH(7, phase_scatter(P, l, smem));
        PH(8, phase_moe_gemm<1>(P, l, smem));
        PH(9, phase_moe_act(P, l, smem));
        PH(10, phase_moe_gemm<2>(P, l, smem));
        PH(11, phase_combine_ln2(P, l, smem));
    }
#undef PH
#undef SEAM
}

}

#ifndef EMU
extern "C" void kernel_launch(void* const* d_in, const int* in_sizes, int n_in, void* d_out, int out_size, void* d_ws, size_t ws_size, hipStream_t stream) {
    using namespace mk;
    static int grid = 0;
    if (grid == 0) {
        if (n_in != 32 || out_size != T * D || ws_size < WS_END) { fprintf(stderr, "kernel_launch: unexpected shapes (n_in %d out %d ws %zu need %zu)\n", n_in, out_size, ws_size, (size_t)WS_END); grid = -1; return; }
        int dev = 0, cus = 0;
        if (hipGetDevice(&dev) != hipSuccess || hipDeviceGetAttribute(&cus, hipDeviceAttributeMultiprocessorCount, dev) != hipSuccess) { grid = -1; return; }
        if (hipFuncSetAttribute((const void*)mk_fwd, hipFuncAttributeMaxDynamicSharedMemorySize, LDS_BYTES) != hipSuccess) { fprintf(stderr, "kernel_launch: hipFuncSetAttribute failed\n"); grid = -1; return; }
        int per_cu = 0;
        (void)hipOccupancyMaxActiveBlocksPerMultiprocessor(&per_cu, (const void*)mk_fwd, NTHREADS, LDS_BYTES);
        (void)hipGetLastError();
        grid = cus;
    }
    if (grid < 0) return;
    (void)hipMemsetAsync(d_ws, 0, CTL_BYTES, stream);
    Params p{};
    for (int i = 0; i < 32; ++i) p.in[i] = (const float*)d_in[i];
    p.out = (float*)d_out; p.ws = (unsigned char*)d_ws;
#if MK_ONE_LAUNCH
    p.ph_lo = 0; p.ph_hi = NL * NPH;
    hipLaunchKernelGGL(mk_fwd, dim3(grid), dim3(NTHREADS), LDS_BYTES, stream, p);
#else
    for (int id = 0; id < NL * NPH; ++id) {
        p.ph_lo = id; p.ph_hi = id + 1;
        hipLaunchKernelGGL(mk_fwd, dim3(grid), dim3(NTHREADS), LDS_BYTES, stream, p);
    }
#endif
}
#endif
```

```cpp
#ifndef EMU
#include <hip/hip_runtime.h>
#endif
#include <cstdio>
#include <cstdint>
#include <cmath>

#ifndef CFG_BATCH
#define CFG_BATCH 4
#endif
#ifndef CFG_SEQ
#define CFG_SEQ 4096
#endif
#ifndef CFG_LAYERS
#define CFG_LAYERS 4
#endif
#ifndef MK_ONE_LAUNCH
#define MK_ONE_LAUNCH 1
#endif

namespace mk {
constexpr int NB = CFG_BATCH, S = CFG_SEQ, T = NB * S, NL = CFG_LAYERS, D = 1024;
constexpr int GW = 256, RW = 384, MW = 384, HD = 64, GH = 4, RH = 6, MH = 6, CH = 128, NCH = S / CH;
constexpr int PIN = 3480, RPROJ = 1408;
constexpr int C_RW = 512, C_MW = 1920;
constexpr int NE = 32, TOPK = 4, DFF = 1024, MOEB = 256;
constexpr int NROWS = (T * TOPK / MOEB + NE) * MOEB;
constexpr float LN_EPS = 1e-5f, GN_EPS = 64e-5f;
constexpr float ALPHA = 1.6817928305074290f;
constexpr int NTHREADS = 512, NWAVES = 8;
constexpr int LDS_BYTES = 160 * 1024;
constexpr int NPH = 12;

typedef float f32x4 __attribute__((ext_vector_type(4)));

constexpr size_t al(size_t x) { return (x + 255) & ~(size_t)255; }
constexpr size_t CTL_BYTES = 1u << 20;
constexpr size_t O_XA = CTL_BYTES;
constexpr size_t O_X1 = O_XA + al((size_t)T * D * 4);
constexpr size_t O_PROJ = O_X1 + al((size_t)T * D * 4);
constexpr size_t O_MIX = O_PROJ + al((size_t)T * PIN * 4);
constexpr size_t O_GRP = O_MIX + al((size_t)T * D * 4);
constexpr size_t O_UG = O_GRP + al((size_t)T * D * 4);
constexpr size_t O_VN = O_UG + al((size_t)T * GW * 4);
constexpr size_t O_RR = O_VN + al((size_t)T * GW * 4);
constexpr size_t O_VV = O_RR + al((size_t)T * RW * 4);
constexpr size_t O_KK = O_VV + al((size_t)T * RW * 4);
constexpr size_t O_DEC = O_KK + al((size_t)T * RW * 4);
constexpr size_t O_KD = O_DEC + al((size_t)2 * T * RW * 4);
constexpr size_t O_ICLR = O_KD + al((size_t)2 * T * RW * 4);
constexpr size_t O_GATE = O_ICLR + al((size_t)2 * T * RW * 4);
constexpr size_t O_BONUS = O_GATE + al((size_t)T * RW * 4);
constexpr size_t O_SCAN = O_BONUS + al((size_t)T * RH * 4);
constexpr size_t O_MQ = O_SCAN + al((size_t)2 * T * RW * 4);
constexpr size_t O_MK = O_MQ + al((size_t)T * MW * 4);
constexpr size_t O_IG = O_MK + al((size_t)T * MW * 4);
constexpr size_t O_LF = O_IG + al((size_t)2 * T * MH * 4);
constexpr size_t O_CL = O_LF + al((size_t)2 * T * MH * 4);
constexpr size_t O_NL = O_CL + al((size_t)2 * NB * MH * NCH * 4096 * 4);
constexpr size_t O_ML = O_NL + al((size_t)2 * NB * MH * NCH * 64 * 4);
constexpr size_t O_BL = O_ML + al((size_t)2 * NB * MH * NCH * 4);
constexpr size_t O_MIN = O_BL + al((size_t)2 * NB * MH * NCH * 4);
constexpr size_t O_TOPI = O_MIN + al((size_t)2 * NB * MH * NCH * 4);
constexpr size_t O_TOPG = O_TOPI + al((size_t)T * 4 * 4);
constexpr size_t O_RANK = O_TOPG + al((size_t)T * 4 * 4);
constexpr size_t O_SLOT = O_RANK + al((size_t)T * 4 * 4);
constexpr size_t O_ROWT = O_SLOT + al((size_t)T * 4 * 4);
constexpr size_t O_HID = O_ROWT + al((size_t)NROWS * 4);
constexpr size_t O_ACT = O_HID + al((size_t)NROWS * 2 * DFF * 4);
constexpr size_t O_YS = O_ACT + al((size_t)NROWS * DFF * 4);
constexpr size_t WS_END = O_YS + al((size_t)NROWS * D * 4);

constexpr int CW_BAR = 4096;
constexpr int CW_CNT = 16384;

struct Params { const float* in[32]; float* out; unsigned char* ws; int ph_lo, ph_hi; };

#ifdef EMU
#define WAVE_SYNC() emu_wave_barrier()
#define PIN_V(x) do {} while (0)
#define PIN_S(x) do {} while (0)
#else
#define WAVE_SYNC() __builtin_amdgcn_wave_barrier()
#define PIN_V(x) asm volatile("" : "+v"(x))
#define PIN_S(x) asm volatile("" : "+s"(x))
#endif
__device__ __forceinline__ int phase_tid() { int t = threadIdx.x; PIN_V(t); return t; }

__device__ __forceinline__ float wave_sum(float v) {
#pragma unroll
    for (int o = 32; o >= 1; o >>= 1) v += __shfl_xor(v, o);
    return v;
}
__device__ __forceinline__ float sigmoidf_(float x) { return 1.0f / (1.0f + expf(-x)); }
__device__ __forceinline__ float softplusf_(float x) { return fmaxf(x, 0.f) + log1pf(expf(-fabsf(x))); }
__device__ __forceinline__ float geluf_(float x) { return 0.5f * x * (1.0f + erff(x * 0.70710678118654752f)); }

__device__ __forceinline__ void gemm_tile_f32(float* sm, const float* A, int lda, const int* rowidx, int m0, int Mtot,
                                              const float* Bm, int ldb, int n0, int Ntot, int K, const float* bias, float* C, int ldc, int tid) {
    float* As = sm;
    float* Bs = sm + 16 * 132;
    const int ty = tid >> 4, tx = tid & 15;
    float acc[4][8];
#pragma unroll
    for (int i = 0; i < 4; ++i)
#pragma unroll
        for (int j = 0; j < 8; ++j) acc[i][j] = 0.f;
    const int ar = tid >> 2, ak = (tid & 3) * 4;
    const int bk = tid >> 5, bn = (tid & 31) * 4;
    const int grow = m0 + ar;
    const float* arow = nullptr;
    if (grow < Mtot) { const int src = rowidx ? rowidx[grow] : grow; arow = A + (size_t)src * lda; }
    const bool bvalid = (n0 + bn) < Ntot;
    for (int k0 = 0; k0 < K; k0 += 16) {
        f32x4 av = (f32x4){0.f, 0.f, 0.f, 0.f}, bv = (f32x4){0.f, 0.f, 0.f, 0.f};
        if (arow) av = *(const f32x4*)(arow + k0 + ak);
        if (bvalid) bv = *(const f32x4*)(Bm + (size_t)(k0 + bk) * ldb + n0 + bn);
        __syncthreads();
        As[(ak + 0) * 132 + ar] = av.x; As[(ak + 1) * 132 + ar] = av.y; As[(ak + 2) * 132 + ar] = av.z; As[(ak + 3) * 132 + ar] = av.w;
        *(f32x4*)&Bs[bk * 132 + bn] = bv;
        __syncthreads();
#pragma unroll
        for (int kk = 0; kk < 16; ++kk) {
            const f32x4 a4 = *(const f32x4*)&As[kk * 132 + ty * 4];
            const f32x4 b0 = *(const f32x4*)&Bs[kk * 132 + tx * 8], b1 = *(const f32x4*)&Bs[kk * 132 + tx * 8 + 4];
            const float a[4] = {a4.x, a4.y, a4.z, a4.w};
            const float b[8] = {b0.x, b0.y, b0.z, b0.w, b1.x, b1.y, b1.z, b1.w};
#pragma unroll
            for (int i = 0; i < 4; ++i)
#pragma unroll
                for (int j = 0; j < 8; ++j) acc[i][j] += a[i] * b[j];
        }
    }
#pragma unroll
    for (int i = 0; i < 4; ++i) {
        const int r = m0 + ty * 4 + i;
        if (r < Mtot) {
#pragma unroll
            for (int j = 0; j < 8; ++j) { const int c = n0 + tx * 8 + j; if (c < Ntot) C[(size_t)r * ldc + c] = acc[i][j] + (bias ? bias[c] : 0.f); }
        }
    }
    __syncthreads();
}

__device__ __forceinline__ void phase_gemm_dense(unsigned char* smem, const float* A, int lda, const float* Bm, int ldb, float* C, int ldc, int M, int N, int K) {
    const int tid = phase_tid();
    const int nmt = (M + 127) / 128, nnt = (N + 127) / 128;
    for (int u = blockIdx.x; u < nmt * nnt; u += gridDim.x) {
        const int mt = u / nnt, nt = u % nnt;
        gemm_tile_f32((float*)smem, A, lda, nullptr, mt * 128, M, Bm, ldb, nt * 128, N, K, nullptr, C, ldc, tid);
    }
}

__device__ __forceinline__ float tshift(const float* P, int t, int s, int col, const float* mu0, const float* mu1, int rc) {
    const float cur = P[(size_t)t * PIN + col];
    const float prv = s > 0 ? P[(size_t)(t - 1) * PIN + col] : 0.f;
    const float nxt = s < S - 1 ? P[(size_t)(t + 1) * PIN + col] : 0.f;
    return cur + mu0[rc] * (prv - cur) + mu1[rc] * (nxt - cur);
}

__device__ __forceinline__ void phase_prep(const Params& P, int l, unsigned char* smem) {
    unsigned char* ws = P.ws; PIN_S(ws);
    const float* proj = (const float*)(ws + O_PROJ);
    float* UG = (float*)(ws + O_UG); float* VN = (float*)(ws + O_VN);
    float* RR = (float*)(ws + O_RR); float* VV = (float*)(ws + O_VV); float* KK = (float*)(ws + O_KK);
    float* DEC = (float*)(ws + O_DEC); float* KD = (float*)(ws + O_KD); float* ICLR = (float*)(ws + O_ICLR);
    float* GATE = (float*)(ws + O_GATE); float* BONUS = (float*)(ws + O_BONUS);
    float* MQ = (float*)(ws + O_MQ); float* MKb = (float*)(ws + O_MK); float* IG = (float*)(ws + O_IG); float* LF = (float*)(ws + O_LF);
    const float* gln_g = P.in[2] + (size_t)l * GW; const float* gln_b = P.in[3] + (size_t)l * GW;
    const float* mu0 = P.in[6] + (size_t)l * 2 * RPROJ; const float* mu1 = mu0 + RPROJ;
    const float* w0 = P.in[7] + (size_t)l * 2 * RW; const float* w2 = P.in[8] + (size_t)l * 2 * 64 * RW;
    const float* a0 = P.in[9] + (size_t)l * 2 * RW; const float* a2 = P.in[10] + (size_t)l * 2 * 64 * RW;
    const float* g2 = P.in[11] + (size_t)l * 128 * RW;
    const float* k_k = P.in[12] + (size_t)l * RW; const float* k_a = P.in[13] + (size_t)l * RW; const float* r_k = P.in[14] + (size_t)l * RW;
    const float* conv_w = P.in[17] + (size_t)l * 3 * 768; const float* conv_b = P.in[18] + (size_t)l * 768; const float* gate_b = P.in[19] + (size_t)l * 24;
    float* lora = (float*)smem;
    const int tid = phase_tid(), lane = tid & 63, wave = tid >> 6;
    for (int u = blockIdx.x; u < T / 16; u += gridDim.x) {
        const int t0 = u * 16, s0 = t0 % S;
        {
            const int i = tid >> 5, l32 = tid & 31, t = t0 + i;
            float v[8]; float sum = 0.f;
#pragma unroll
            for (int j = 0; j < 8; ++j) {
                const int c = j * 32 + l32;
                UG[(size_t)t * GW + c] = geluf_(proj[(size_t)t * PIN + c]);
                v[j] = geluf_(proj[(size_t)t * PIN + GW + c]); sum += v[j];
            }
#pragma unroll
            for (int o = 16; o >= 1; o >>= 1) sum += __shfl_xor(sum, o);
            const float mean = sum * (1.0f / GW); float q = 0.f;
#pragma unroll
            for (int j = 0; j < 8; ++j) { const float d = v[j] - mean; q += d * d; }
#pragma unroll
            for (int o = 16; o >= 1; o >>= 1) q += __shfl_xor(q, o);
            const float rstd = 1.0f / sqrtf(q * (1.0f / GW) + LN_EPS);
#pragma unroll
            for (int j = 0; j < 8; ++j) { const int c = j * 32 + l32; VN[(size_t)t * GW + c] = (v[j] - mean) * rstd * gln_g[c] + gln_b[c]; }
        }
        __syncthreads();
        for (int idx = tid; idx < 16 * 256; idx += NTHREADS) {
            const int i = idx >> 8, j = idx & 255, rc = 1152 + j;
            const float x = tshift(proj, t0 + i, s0 + i, C_RW + rc, mu0, mu1, rc);
            lora[idx] = j < 64 ? tanhf(x) : (j < 128 ? x : sigmoidf_(x));
        }
        __syncthreads();
        if (wave < 6) {
            const int c = tid, h = wave;
            {
                float aw0[16], aw1[16];
#pragma unroll
                for (int i = 0; i < 16; ++i) { aw0[i] = w0[c]; aw1[i] = w0[RW + c]; }
                for (int j = 0; j < 64; ++j) {
                    const float w20 = w2[(size_t)j * RW + c], w21 = w2[(size_t)(64 + j) * RW + c];
#pragma unroll
                    for (int i = 0; i < 16; ++i) { const float lw = lora[i * 256 + j]; aw0[i] += lw * w20; aw1[i] += lw * w21; }
                }
#pragma unroll
                for (int i = 0; i < 16; ++i) {
                    const size_t o = (size_t)(t0 + i) * RW + c;
                    DEC[o] = expf(-expf(-softplusf_(-aw0[i]) - 0.5f)); DEC[(size_t)T * RW + o] = expf(-expf(-softplusf_(-aw1[i]) - 0.5f));
                }
            }
            {
                float aa0[16], aa1[16];
#pragma unroll
                for (int i = 0; i < 16; ++i) { aa0[i] = a0[c]; aa1[i] = a0[RW + c]; }
                for (int j = 0; j < 64; ++j) {
                    const float a20 = a2[(size_t)j * RW + c], a21 = a2[(size_t)(64 + j) * RW + c];
#pragma unroll
                    for (int i = 0; i < 16; ++i) { const float la = lora[i * 256 + 64 + j]; aa0[i] += la * a20; aa1[i] += la * a21; }
                }
#pragma unroll
                for (int i = 0; i < 16; ++i) {
                    const size_t o = (size_t)(t0 + i) * RW + c;
                    ICLR[o] = sigmoidf_(aa0[i]); ICLR[(size_t)T * RW + o] = sigmoidf_(aa1[i]);
                }
            }
            {
                float ag[16];
#pragma unroll
                for (int i = 0; i < 16; ++i) ag[i] = 0.f;
                for (int j = 0; j < 128; ++j) {
                    const float g = g2[(size_t)j * RW + c];
#pragma unroll
                    for (int i = 0; i < 16; ++i) ag[i] += lora[i * 256 + 128 + j] * g;
                }
#pragma unroll
                for (int i = 0; i < 16; ++i) GATE[(size_t)(t0 + i) * RW + c] = ag[i];
            }
            const float kkc = k_k[c], kac = k_a[c], rkc = r_k[c];
#pragma unroll
            for (int i = 0; i < 16; ++i) {
                const int t = t0 + i, s = s0 + i;
                const float r = tshift(proj, t, s, C_RW + c, mu0, mu1, c);
                const float k = tshift(proj, t, s, C_RW + RW + c, mu0, mu1, RW + c);
                const float v = tshift(proj, t, s, C_RW + 2 * RW + c, mu0, mu1, 2 * RW + c);
                const size_t o = (size_t)t * RW + c;
                const float ic0 = ICLR[o], ic1 = ICLR[(size_t)T * RW + o];
                const float kq = k * kkc;
                const float n2 = wave_sum(kq * kq);
                const float kk = kq / fmaxf(sqrtf(n2), 1e-12f);
                const float kd0 = k * (1.0f + (ic0 - 1.0f) * kac), kd1 = k * (1.0f + (ic1 - 1.0f) * kac);
                const float bon = wave_sum(r * (kd0 + kd1) * rkc);
                RR[o] = r; VV[o] = v; KK[o] = kk;
                KD[o] = kd0; KD[(size_t)T * RW + o] = kd1;
                if (lane == 0) BONUS[(size_t)t * RH + h] = bon;
            }
        }
        for (int idx = tid; idx < 16 * 768; idx += NTHREADS) {
            const int i = idx / 768, c = idx % 768, t = t0 + i, s = s0 + i, col = C_MW + c;
            const float xm = s > 0 ? proj[(size_t)(t - 1) * PIN + col] : 0.f;
            const float x0 = proj[(size_t)t * PIN + col];
            const float xp = s < S - 1 ? proj[(size_t)(t + 1) * PIN + col] : 0.f;
            float y = conv_b[c] + xm * conv_w[c] + x0 * conv_w[768 + c] + xp * conv_w[2 * 768 + c];
            y = y * sigmoidf_(y);
            if (c < MW) MQ[(size_t)t * MW + c] = y; else MKb[(size_t)t * MW + (c - MW)] = y * 0.125f;
        }
        for (int idx = tid; idx < 16 * 24; idx += NTHREADS) {
            const int i = idx / 24, gi = idx % 24, t = t0 + i;
            const int isf = gi / 12, dir = (gi / 6) & 1, h = gi % 6;
            const float g = proj[(size_t)t * PIN + 3456 + gi] + gate_b[gi];
            if (isf) LF[((size_t)dir * T + t) * MH + h] = -softplusf_(-g); else IG[((size_t)dir * T + t) * MH + h] = g;
        }
        __syncthreads();
    }
}

__device__ __forceinline__ void phase_gmlp_mix(const Params& P, int l, unsigned char* smem) {
    unsigned char* ws = P.ws; PIN_S(ws);
    const float* UG = (const float*)(ws + O_UG); const float* VN = (const float*)(ws + O_VN); float* GRP = (float*)(ws + O_GRP);
    const float* gws = P.in[4] + (size_t)l * GH * CH * CH; const float* gbs = P.in[5] + (size_t)l * GH * CH;
    float* vs = (float*)smem;
    float* wsm = vs + 128 * 64;
    const int tid = phase_tid();
    for (int u = blockIdx.x; u < NB * NCH * GH; u += gridDim.x) {
        const int h = u % GH, c = (u / GH) % NCH, b = u / (GH * NCH);
        const int tok0 = b * S + c * CH;
        __syncthreads();
        for (int idx = tid; idx < 128 * 64; idx += NTHREADS) { const int q = idx >> 6, e = idx & 63; vs[idx] = VN[(size_t)(tok0 + q) * GW + h * 64 + e]; }
        for (int idx = tid; idx < 128 * 128; idx += NTHREADS) wsm[idx] = gws[(size_t)h * CH * CH + idx];
        __syncthreads();
        const int p = tid >> 2, eg = (tid & 3) * 16;
        float acc[16];
#pragma unroll
        for (int e = 0; e < 16; ++e) acc[e] = 0.f;
        for (int q = 0; q < 128; ++q) {
            const float w = wsm[p * 128 + q];
#pragma unroll
            for (int e = 0; e < 16; ++e) acc[e] += w * vs[q * 64 + eg + e];
        }
        const float bsv = gbs[h * CH + p];
#pragma unroll
        for (int e = 0; e < 16; ++e) {
            const size_t t = (size_t)(tok0 + p);
            GRP[t * D + h * 64 + eg + e] = UG[t * GW + h * 64 + eg + e] * (acc[e] + bsv);
        }
    }
    __syncthreads();
}

__device__ __forceinline__ void phase_rwkv_scan(const Params& P, int l, unsigned char* smem) {
    unsigned char* ws = P.ws; PIN_S(ws);
    const float* RR = (const float*)(ws + O_RR); const float* VV = (const float*)(ws + O_VV); const float* KK = (const float*)(ws + O_KK);
    const float* DEC = (const float*)(ws + O_DEC); const float* KD = (const float*)(ws + O_KD); const float* ICLR = (const float*)(ws + O_ICLR);
    float* SCAN = (float*)(ws + O_SCAN);
    const int tid = phase_tid(), lane = tid & 63, wave = tid >> 6;
    float* vec = (float*)smem + wave * 320;
    const int gw = wave * (int)gridDim.x + (int)blockIdx.x, ngw = NWAVES * (int)gridDim.x;
    for (int u = gw; u < 2 * NB * RH; u += ngw) {
        const int h = u % RH, b = (u / RH) % NB, d = u / (RH * NB);
        float st[64];
#pragma unroll
        for (int k = 0; k < 64; ++k) st[k] = 0.f;
        const size_t doff = (size_t)d * T * RW;
        for (int tau = 0; tau < S; ++tau) {
            const int s = d ? S - 1 - tau : tau;
            const size_t idx = (size_t)(b * S + s) * RW + h * 64 + lane;
            const float w = DEC[doff + idx], kkv = KK[idx], ic = ICLR[doff + idx], kd = KD[doff + idx], r = RR[idx], v = VV[idx];
            vec[lane] = w; vec[64 + lane] = -kkv; vec[128 + lane] = kkv * ic; vec[192 + lane] = kd; vec[256 + lane] = r;
            WAVE_SYNC();
            float sa = 0.f;
#pragma unroll
            for (int k = 0; k < 64; ++k) sa += st[k] * vec[64 + k];
            float out = 0.f;
#pragma unroll
            for (int k = 0; k < 64; ++k) { st[k] = st[k] * vec[k] + sa * vec[128 + k] + v * vec[192 + k]; out += st[k] * vec[256 + k]; }
            SCAN[doff + idx] = out;
            WAVE_SYNC();
        }
    }
}

__device__ __forceinline__ void phase_mlstm_local(const Params& P, int l, unsigned char* smem) {
    unsigned char* ws = P.ws; PIN_S(ws);
    const float* proj = (const float*)(ws + O_PROJ); const float* MKb = (const float*)(ws + O_MK);
    const float* IG = (const float*)(ws + O_IG); const float* LF = (const float*)(ws + O_LF);
    float* CL = (float*)(ws + O_CL); float* NLb = (float*)(ws + O_NL); float* ML = (float*)(ws + O_ML); float* BL = (float*)(ws + O_BL);
    float* ks = (float*)smem;
    float* vs = ks + 128 * 64;
    float* wts = vs + 128 * 64;
    float* lfv = wts + 128; float* igv = lfv + 128;
    int* tok = (int*)(igv + 128);
    const int tid = phase_tid();
    for (int u = blockIdx.x; u < 2 * NB * MH * NCH; u += gridDim.x) {
        const int c = u % NCH, h = (u / NCH) % MH, p = u / (NCH * MH), d = p / NB, b = p % NB;
        __syncthreads();
        if (tid < 128) {
            const int tau = c * CH + tid, s = d ? S - 1 - tau : tau, t = b * S + s;
            tok[tid] = t; lfv[tid] = LF[((size_t)d * T + t) * MH + h]; igv[tid] = IG[((size_t)d * T + t) * MH + h];
        }
        __syncthreads();
        for (int idx = tid; idx < 128 * 64; idx += NTHREADS) {
            const int j = idx >> 6, e = idx & 63; const size_t t = (size_t)tok[j];
            ks[idx] = MKb[t * MW + h * 64 + e]; vs[idx] = proj[t * PIN + C_MW + 2 * MW + h * 64 + e];
        }
        if (tid == 0) {
            float bc = 0.f;
            for (int j = 0; j < 128; ++j) { bc += lfv[j]; wts[j] = bc; }
            const float blast = bc; float m = -INFINITY;
            for (int j = 0; j < 128; ++j) { const float lw = blast - wts[j] + igv[j]; wts[j] = lw; m = fmaxf(m, lw); }
            for (int j = 0; j < 128; ++j) wts[j] = expf(wts[j] - m);
            ML[u] = m; BL[u] = blast;
        }
        __syncthreads();
        const int dk = tid >> 3, dv = (tid & 7) * 8;
        float acc[8]; float nacc = 0.f;
#pragma unroll
        for (int e = 0; e < 8; ++e) acc[e] = 0.f;
        for (int j = 0; j < 128; ++j) {
            const float kw = wts[j] * ks[j * 64 + dk];
            nacc += kw;
#pragma unroll
            for (int e = 0; e < 8; ++e) acc[e] += kw * vs[j * 64 + dv + e];
        }
#pragma unroll
        for (int e = 0; e < 8; ++e) CL[(size_t)u * 4096 + dk * 64 + dv + e] = acc[e];
        if (dv == 0) NLb[(size_t)u * 64 + dk] = nacc;
    }
    __syncthreads();
}

__device__ __forceinline__ void phase_mlstm_carry(const Params& P, int l, unsigned char* smem) {
    unsigned char* ws = P.ws; PIN_S(ws);
    float* CL = (float*)(ws + O_CL); float* NLb = (float*)(ws + O_NL); const float* ML = (const float*)(ws + O_ML); const float* BL = (const float*)(ws + O_BL);
    float* MIN = (float*)(ws + O_MIN);
    const int total = 2 * NB * MH * 4160;
    const int tid = phase_tid();
    for (int g = blockIdx.x * NTHREADS + tid; g < total; g += gridDim.x * NTHREADS) {
        const int ph = g / 4160, e = g % 4160;
        float m = 0.f, val = 0.f;
        for (int c = 0; c < NCH; ++c) {
            const int base = ph * NCH + c;
            float* ptr = e < 4096 ? CL + (size_t)base * 4096 + e : NLb + (size_t)base * 64 + (e - 4096);
            const float loc = *ptr;
            *ptr = val;
            if (e == 0) MIN[base] = m;
            const float bl = BL[base], ml = ML[base];
            const float mn = fmaxf(bl + m, ml);
            val = expf(bl + m - mn) * val + expf(ml - mn) * loc;
            m = mn;
        }
    }
}

__device__ __forceinline__ void phase_mlstm_out(const Params& P, int l, unsigned char* smem) {
    unsigned char* ws = P.ws; PIN_S(ws);
    const float* proj = (const float*)(ws + O_PROJ); const float* MQ = (const float*)(ws + O_MQ); const float* MKb = (const float*)(ws + O_MK);
    const float* IG = (const float*)(ws + O_IG); const float* LF = (const float*)(ws + O_LF);
    const float* CL = (const float*)(ws + O_CL); const float* NLb = (const float*)(ws + O_NL); const float* MIN = (const float*)(ws + O_MIN);
    float* GRP = (float*)(ws + O_GRP);
    const float* mln_g = P.in[20] + (size_t)l * MW;
    float* qs = (float*)smem; float* ks = qs + 128 * 64; float* vs = ks + 128 * 64;
    float* Cs = vs + 128 * 64;
    float* ns = Cs + 4096;
    float* bcv = ns + 64; float* gv = bcv + 128; float* pmx = gv + 128;
    const int tid = phase_tid();
    for (int u = blockIdx.x; u < NB * MH * NCH; u += gridDim.x) {
        const int tc = u % NCH, h = (u / NCH) % MH, b = u / (NCH * MH);
        const int tok0 = b * S + tc * CH;
        __syncthreads();
        for (int idx = tid; idx < 128 * 64; idx += NTHREADS) {
            const int i = idx >> 6, e = idx & 63; const size_t t = (size_t)(tok0 + i);
            qs[idx] = MQ[t * MW + h * 64 + e]; ks[idx] = MKb[t * MW + h * 64 + e]; vs[idx] = proj[t * PIN + C_MW + 2 * MW + h * 64 + e];
        }
        const int itok = tid >> 2, eg = (tid & 3) * 16;
        float hsum[16];
#pragma unroll
        for (int e = 0; e < 16; ++e) hsum[e] = 0.f;
        for (int d = 0; d < 2; ++d) {
            const int cd = d ? NCH - 1 - tc : tc;
            const int su = ((d * NB + b) * MH + h) * NCH + cd;
            __syncthreads();
            if (tid == 0) {
                float bc = 0.f, pm = -INFINITY;
                for (int j = 0; j < 128; ++j) {
                    const int i = d ? 127 - j : j; const size_t t = (size_t)(tok0 + i);
                    bc += LF[((size_t)d * T + t) * MH + h];
                    const float g = IG[((size_t)d * T + t) * MH + h] - bc;
                    pm = fmaxf(pm, g);
                    bcv[j] = bc; gv[j] = g; pmx[j] = pm;
                }
            }
            for (int idx = tid; idx < 4096; idx += NTHREADS) Cs[idx] = CL[(size_t)su * 4096 + idx];
            if (tid < 64) ns[tid] = NLb[(size_t)su * 64 + tid];
            const float mst = MIN[su];
            __syncthreads();
            const int j = d ? 127 - itok : itok;
            const float mx = fmaxf(pmx[j], mst), mt = bcv[j] + mx;
            float qrow[64];
#pragma unroll
            for (int k = 0; k < 64; ++k) qrow[k] = qs[itok * 64 + k];
            float acc[16]; float den = 0.f;
#pragma unroll
            for (int e = 0; e < 16; ++e) acc[e] = 0.f;
            for (int jj = 0; jj <= j; ++jj) {
                const int i2 = d ? 127 - jj : jj;
                float dot = 0.f;
#pragma unroll
                for (int k = 0; k < 64; ++k) dot += qrow[k] * ks[i2 * 64 + k];
                const float sw = dot * expf(gv[jj] - mx);
                den += sw;
#pragma unroll
                for (int e = 0; e < 16; ++e) acc[e] += sw * vs[i2 * 64 + eg + e];
            }
            const float wint = expf(mst - mx);
            float qn = 0.f; float qc[16];
#pragma unroll
            for (int e = 0; e < 16; ++e) qc[e] = 0.f;
#pragma unroll
            for (int k = 0; k < 64; ++k) {
                qn += qrow[k] * ns[k];
#pragma unroll
                for (int e = 0; e < 16; ++e) qc[e] += qrow[k] * Cs[k * 64 + eg + e];
            }
            den += wint * qn;
            const float dd = fmaxf(fabsf(den), expf(-mt));
#pragma unroll
            for (int e = 0; e < 16; ++e) hsum[e] += (acc[e] + wint * qc[e]) / dd;
        }
        float sm = 0.f;
#pragma unroll
        for (int e = 0; e < 16; ++e) sm += hsum[e];
        sm += __shfl_xor(sm, 1); sm += __shfl_xor(sm, 2);
        const float mean = sm * (1.0f / 64.0f); float q = 0.f;
#pragma unroll
        for (int e = 0; e < 16; ++e) { const float dlt = hsum[e] - mean; q += dlt * dlt; }
        q += __shfl_xor(q, 1); q += __shfl_xor(q, 2);
        const float rstd = 1.0f / sqrtf(q * (1.0f / 64.0f) + LN_EPS);
        const size_t t = (size_t)(tok0 + itok);
#pragma unroll
        for (int e = 0; e < 16; ++e) {
            const int c = h * 64 + eg + e;
            const float o = proj[t * PIN + C_MW + 3 * MW + c];
            GRP[t * D + GW + RW + c] = sigmoidf_(o) * ((hsum[e] - mean) * rstd * mln_g[c]);
        }
    }
    __syncthreads();
}

__device__ __forceinline__ void phase_rwkv_post(const Params& P, int l, unsigned char* smem) {
    unsigned char* ws = P.ws; PIN_S(ws);
    const float* SCAN = (const float*)(ws + O_SCAN); const float* VV = (const float*)(ws + O_VV); const float* GATE = (const float*)(ws + O_GATE);
    const float* BONUS = (const float*)(ws + O_BONUS); float* GRP = (float*)(ws + O_GRP);
    const float* rln_g = P.in[15] + (size_t)l * RW; const float* rln_b = P.in[16] + (size_t)l * RW;
    const int tid = phase_tid(), lane = tid & 63, wave = tid >> 6;
    const int gw = (int)blockIdx.x * NWAVES + wave, ngw = NWAVES * (int)gridDim.x;
    for (int it = gw; it < T * RH; it += ngw) {
        const int t = it / RH, h = it % RH, c = h * 64 + lane;
        const size_t o = (size_t)t * RW + c;
        const float x = SCAN[o] + SCAN[(size_t)T * RW + o];
        const float mean = wave_sum(x) * (1.0f / 64.0f);
        const float dl = x - mean;
        const float var = wave_sum(dl * dl) * (1.0f / 64.0f);
        float y = dl / sqrtf(var + GN_EPS) * rln_g[c] + rln_b[c];
        y += BONUS[(size_t)t * RH + h] * VV[o];
        GRP[(size_t)t * D + GW + c] = y * GATE[o];
    }
}

__device__ __forceinline__ void phase_ln1_router(const Params& P, int l, unsigned char* smem) {
    unsigned char* ws = P.ws; PIN_S(ws);
    const float* xin = l == 0 ? P.in[0] : (const float*)(ws + O_XA);
    const float* MIX = (const float*)(ws + O_MIX); float* X1 = (float*)(ws + O_X1);
    int* TOPI = (int*)(ws + O_TOPI); float* TOPG = (float*)(ws + O_TOPG); int* RANK = (int*)(ws + O_RANK); int* ROWT = (int*)(ws + O_ROWT);
    unsigned* CNT = (unsigned*)ws + CW_CNT + 64 * l;
    const float* g1 = P.in[22] + (size_t)l * D; const float* b1 = P.in[23] + (size_t)l * D;
    const float* rw = P.in[24] + (size_t)l * D * NE; const float* rb = P.in[25] + (size_t)l * NE;
    const int tid = phase_tid(), lane = tid & 63, wave = tid >> 6;
    float* xrow = (float*)smem + wave * D;
    const int gw = (int)blockIdx.x * NWAVES + wave, ngw = NWAVES * (int)gridDim.x;
    for (int i = (int)blockIdx.x * NTHREADS + tid; i < NROWS; i += (int)gridDim.x * NTHREADS) ROWT[i] = 0;
    for (int t = gw; t < T; t += ngw) {
        float v[16]; float sm = 0.f;
#pragma unroll
        for (int j = 0; j < 4; ++j) {
            const int c = j * 256 + lane * 4;
            const f32x4 a = *(const f32x4*)(xin + (size_t)t * D + c), m = *(const f32x4*)(MIX + (size_t)t * D + c);
            v[j * 4 + 0] = ALPHA * a.x + m.x; v[j * 4 + 1] = ALPHA * a.y + m.y; v[j * 4 + 2] = ALPHA * a.z + m.z; v[j * 4 + 3] = ALPHA * a.w + m.w;
            sm += (v[j * 4] + v[j * 4 + 1]) + (v[j * 4 + 2] + v[j * 4 + 3]);
        }
        const float mean = wave_sum(sm) * (1.0f / D); float q = 0.f;
#pragma unroll
        for (int j = 0; j < 16; ++j) { const float dl = v[j] - mean; q += dl * dl; }
        const float rstd = 1.0f / sqrtf(wave_sum(q) * (1.0f / D) + LN_EPS);
        WAVE_SYNC();
#pragma unroll
        for (int j = 0; j < 4; ++j) {
            const int c = j * 256 + lane * 4;
            f32x4 o;
            o.x = (v[j * 4 + 0] - mean) * rstd * g1[c + 0] + b1[c + 0]; o.y = (v[j * 4 + 1] - mean) * rstd * g1[c + 1] + b1[c + 1];
            o.z = (v[j * 4 + 2] - mean) * rstd * g1[c + 2] + b1[c + 2]; o.w = (v[j * 4 + 3] - mean) * rstd * g1[c + 3] + b1[c + 3];
            *(f32x4*)(X1 + (size_t)t * D + c) = o;
            *(f32x4*)(xrow + c) = o;
        }
        WAVE_SYNC();
        const int e = lane & 31, half = lane >> 5;
        float lg = 0.f;
        for (int c = half * 512; c < half * 512 + 512; ++c) lg += xrow[c] * rw[(size_t)c * NE + e];
        lg += __shfl_xor(lg, 32);
        lg += rb[e];
        float cur = lg; float tv[4]; int ti[4];
#pragma unroll
        for (int k = 0; k < 4; ++k) {
            float bv = cur; int bi = e;
#pragma unroll
            for (int o = 16; o >= 1; o >>= 1) {
                const float ov = __shfl_xor(bv, o); const int oi = __shfl_xor(bi, o);
                if (ov > bv || (ov == bv && oi < bi)) { bv = ov; bi = oi; }
            }
            tv[k] = bv; ti[k] = bi;
            if (e == bi) cur = -INFINITY;
        }
        const float e1 = expf(tv[1] - tv[0]), e2 = expf(tv[2] - tv[0]), e3 = expf(tv[3] - tv[0]);
        const float inv = 1.0f / (1.0f + e1 + e2 + e3);
        if (lane < 4) {
            const int myi = lane == 0 ? ti[0] : (lane == 1 ? ti[1] : (lane == 2 ? ti[2] : ti[3]));
            const float myg = (lane == 0 ? 1.0f : (lane == 1 ? e1 : (lane == 2 ? e2 : e3))) * inv;
            TOPI[(size_t)t * 4 + lane] = myi; TOPG[(size_t)t * 4 + lane] = myg;
            RANK[(size_t)t * 4 + lane] = (int)atomicAdd(CNT + myi, 1u);
        }
    }
}

__device__ __forceinline__ void moe_offsets(int* sh, const unsigned* CNT, int tid) {
    if (tid == 0) {
        int acc = 0;
        for (int e = 0; e < NE; ++e) { const int c = (int)CNT[e]; sh[e] = c; sh[32 + e] = acc; acc += (c + MOEB - 1) / MOEB * MOEB; sh[64 + e] = acc; }
    }
    __syncthreads();
}
__device__ __forceinline__ int moe_expert_of_row(const int* sh, int r) {
    int e = -1;
    for (int i = 0; i < NE; ++i) if (r >= sh[32 + i] && r < sh[64 + i]) e = i;
    return e;
}

__device__ __forceinline__ void phase_scatter(const Params& P, int l, unsigned char* smem) {
    unsigned char* ws = P.ws; PIN_S(ws);
    const int tid = phase_tid();
    const int* TOPI = (const int*)(ws + O_TOPI); const int* RANK = (const int*)(ws + O_RANK); int* SLOT = (int*)(ws + O_SLOT); int* ROWT = (int*)(ws + O_ROWT);
    const unsigned* CNT = (const unsigned*)ws + CW_CNT + 64 * l;
    int* sh = (int*)smem;
    moe_offsets(sh, CNT, tid);
    for (int a = (int)blockIdx.x * NTHREADS + tid; a < T * 4; a += (int)gridDim.x * NTHREADS) {
        const int e = TOPI[a], dest = sh[32 + e] + RANK[a];
        ROWT[dest] = a >> 2; SLOT[a] = dest;
    }
    __syncthreads();
}

template <int WHICH>
__device__ __forceinline__ void phase_moe_gemm(const Params& P, int l, unsigned char* smem) {
    unsigned char* ws = P.ws; PIN_S(ws);
    const int tid = phase_tid();
    const unsigned* CNT = (const unsigned*)ws + CW_CNT + 64 * l;
    int* sh = (int*)(smem + 32768);
    moe_offsets(sh, CNT, tid);
    const int N = WHICH == 1 ? 2 * DFF : D;
    const int nnt = N / 128, nmt = NROWS / 128;
    const float* A = WHICH == 1 ? (const float*)(ws + O_X1) : (const float*)(ws + O_ACT);
    const int* rowidx = WHICH == 1 ? (const int*)(ws + O_ROWT) : nullptr;
    float* C = WHICH == 1 ? (float*)(ws + O_HID) : (float*)(ws + O_YS);
    const float* W = WHICH == 1 ? P.in[26] + (size_t)l * NE * D * 2 * DFF : P.in[28] + (size_t)l * NE * DFF * D;
    const float* Bi = WHICH == 1 ? P.in[27] + (size_t)l * NE * 2 * DFF : P.in[29] + (size_t)l * NE * D;
    for (int u = blockIdx.x; u < nmt * nnt; u += gridDim.x) {
        const int mt = u / nnt, nt = u % nnt, r0 = mt * 128;
        const int e = moe_expert_of_row(sh, r0);
        if (e < 0 || r0 >= sh[32 + e] + sh[e]) continue;
        gemm_tile_f32((float*)smem, A, WHICH == 1 ? D : DFF, rowidx, r0, NROWS, W + (size_t)e * 1024 * N, N, nt * 128, N, 1024, Bi + (size_t)e * N, C, N, tid);
    }
    __syncthreads();
}

__device__ __forceinline__ void phase_moe_act(const Params& P, int l, unsigned char* smem) {
    unsigned char* ws = P.ws; PIN_S(ws);
    const int tid = phase_tid();
    const unsigned* CNT = (const unsigned*)ws + CW_CNT + 64 * l;
    int* sh = (int*)smem;
    moe_offsets(sh, CNT, tid);
    const float* HID = (const float*)(ws + O_HID); float* ACT = (float*)(ws + O_ACT);
    for (int mt = blockIdx.x; mt < NROWS / 128; mt += gridDim.x) {
        const int r0 = mt * 128, e = moe_expert_of_row(sh, r0);
        if (e < 0 || r0 >= sh[32 + e] + sh[e]) continue;
        for (int idx = tid; idx < 128 * DFF; idx += NTHREADS) {
            const int r = r0 + idx / DFF, c = idx % DFF;
            float g = HID[(size_t)r * 2 * DFF + c], uu = HID[(size_t)r * 2 * DFF + DFF + c];
            g = fminf(g, 7.0f); uu = fminf(fmaxf(uu, -7.0f), 7.0f);
            ACT[(size_t)r * DFF + c] = (uu + 1.0f) * (g * sigmoidf_(g * 1.702f));
        }
    }
    __syncthreads();
}

__device__ __forceinline__ void phase_combine_ln2(const Params& P, int l, unsigned char* smem) {
    unsigned char* ws = P.ws; PIN_S(ws);
    const float* X1 = (const float*)(ws + O_X1); const float* YS = (const float*)(ws + O_YS);
    const int* SLOT = (const int*)(ws + O_SLOT); const float* TOPG = (const float*)(ws + O_TOPG);
    float* xo = l == NL - 1 ? P.out : (float*)(ws + O_XA);
    const float* g2 = P.in[30] + (size_t)l * D; const float* b2 = P.in[31] + (size_t)l * D;
    const int tid = phase_tid(), lane = tid & 63, wave = tid >> 6;
    const int gw = (int)blockIdx.x * NWAVES + wave, ngw = NWAVES * (int)gridDim.x;
    for (int t = gw; t < T; t += ngw) {
        int sl[4]; float gg[4];
#pragma unroll
        for (int k = 0; k < 4; ++k) { sl[k] = SLOT[(size_t)t * 4 + k]; gg[k] = TOPG[(size_t)t * 4 + k]; }
        float v[16]; float sm = 0.f;
#pragma unroll
        for (int j = 0; j < 4; ++j) {
            const int c = j * 256 + lane * 4;
            const f32x4 a = *(const f32x4*)(X1 + (size_t)t * D + c);
            f32x4 y = (f32x4){0.f, 0.f, 0.f, 0.f};
#pragma unroll
            for (int k = 0; k < 4; ++k) { const f32x4 yk = *(const f32x4*)(YS + (size_t)sl[k] * D + c); y.x += gg[k] * yk.x; y.y += gg[k] * yk.y; y.z += gg[k] * yk.z; y.w += gg[k] * yk.w; }
            v[j * 4 + 0] = ALPHA * a.x + y.x; v[j * 4 + 1] = ALPHA * a.y + y.y; v[j * 4 + 2] = ALPHA * a.z + y.z; v[j * 4 + 3] = ALPHA * a.w + y.w;
            sm += (v[j * 4] + v[j * 4 + 1]) + (v[j * 4 + 2] + v[j * 4 + 3]);
        }
        const float mean = wave_sum(sm) * (1.0f / D); float q = 0.f;
#pragma unroll
        for (int j = 0; j < 16; ++j) { const float dl = v[j] - mean; q += dl * dl; }
        const float rstd = 1.0f / sqrtf(wave_sum(q) * (1.0f / D) + LN_EPS);
#pragma unroll
        for (int j = 0; j < 4; ++j) {
            const int c = j * 256 + lane * 4;
            f32x4 o;
            o.x = (v[j * 4 + 0] - mean) * rstd * g2[c + 0] + b2[c + 0]; o.y = (v[j * 4 + 1] - mean) * rstd * g2[c + 1] + b2[c + 1];
            o.z = (v[j * 4 + 2] - mean) * rstd * g2[c + 2] + b2[c + 2]; o.w = (v[j * 4 + 3] - mean) * rstd * g2[c + 3] + b2[c + 3];
            *(f32x4*)(xo + (size_t)t * D + c) = o;
        }
    }
}

#ifndef EMU
#define XB_TMO      128
#define XB_XCNT(j)  (256  + 64 * (j))
#define XB_XSUB(j)  (1280 + 64 * (j))
#define XB_XGEN(j)  (2304 + 64 * (j))
#define XB_TOP      3328
#define XB_TOPGEN   3392
#define XCD_BAR_WORDS 3456
#define XB_SPIN_CAP (1u << 25)
#define LAS __attribute__((address_space(3)))
__device__ __forceinline__ unsigned xb_ld(unsigned* p)              { return __hip_atomic_load(p, __ATOMIC_RELAXED, __HIP_MEMORY_SCOPE_AGENT); }
__device__ __forceinline__ unsigned xb_add(unsigned* p, unsigned v) { return __hip_atomic_fetch_add(p, v, __ATOMIC_RELAXED, __HIP_MEMORY_SCOPE_AGENT); }
__device__ __forceinline__ unsigned xb_xcc_id() { return (unsigned)__builtin_amdgcn_s_getreg((3 << 11) | 20) & 0xFu; }
#define XB_SPIN(cond, bar) do { unsigned _sp = 0; while (cond) { __builtin_amdgcn_s_sleep(1); \
    if ((++_sp & 255u) == 0u) { if (xb_ld(&(bar)[XB_TMO])) break; if (_sp > XB_SPIN_CAP) { atomicAdd(&(bar)[XB_TMO], 1u); break; } } } } while (0)
struct XcdBarrier { unsigned* bar; unsigned x; volatile LAS unsigned* st; };
__device__ __forceinline__ XcdBarrier xcd_barrier_post(unsigned* bar, volatile LAS unsigned* st) {
    XcdBarrier b; b.bar = bar; b.x = xb_xcc_id(); b.st = st;
    if (threadIdx.x == 0) (void)xb_add(&bar[XB_XCNT(b.x)], 1u);
    return b;
}
__device__ __forceinline__ void xcd_barrier_complete(unsigned* bar, unsigned x, unsigned& nloc, unsigned& nx) {
    const unsigned G = gridDim.x * gridDim.y * gridDim.z;
    unsigned sum, cnt, mine, sp = 0u;
    for (;;) {
        sum = 0u; cnt = 0u; mine = 0u;
#pragma unroll
        for (unsigned j = 0; j < 16; ++j) { const unsigned c = xb_ld(&bar[XB_XCNT(j)]); sum += c; cnt += (c > 0u) ? 1u : 0u; mine = (j == x) ? c : mine; }
        if (sum == G) break;
        __builtin_amdgcn_s_sleep(1);
        if ((++sp & 255u) == 0u) { if (xb_ld(&bar[XB_TMO])) break; if (sp > XB_SPIN_CAP) { atomicAdd(&bar[XB_TMO], 1u); break; } }
    }
    nloc = mine > 0u ? mine : 1u; nx = cnt > 0u ? cnt : 1u;
}
__device__ __forceinline__ void xcd_barrier(const XcdBarrier& b) {
    asm volatile("s_waitcnt vmcnt(0)" ::: "memory");
    __syncthreads();
    if (threadIdx.x == 0) {
        unsigned* bar = b.bar;
        __builtin_amdgcn_s_waitcnt(0);
        unsigned nloc = b.st[0], nx = b.st[1];
        if (nloc == 0u) { xcd_barrier_complete(bar, b.x, nloc, nx); b.st[0] = nloc; b.st[1] = nx; }
        const unsigned old = xb_add(&bar[XB_XSUB(b.x)], 1u);
        const unsigned gen = old / nloc;
        if (old + 1u == (gen + 1u) * nloc) {
            __builtin_amdgcn_fence(__ATOMIC_RELEASE, "agent");
            asm volatile("s_waitcnt vmcnt(0)" ::: "memory");
            const unsigned og = xb_add(&bar[XB_TOP], 1u);
            const unsigned tg = og / nx;
            if (og + 1u == (tg + 1u) * nx) xb_add(&bar[XB_TOPGEN], 1u);
            else XB_SPIN(xb_ld(&bar[XB_TOPGEN]) == tg, bar);
            __builtin_amdgcn_fence(__ATOMIC_ACQUIRE, "agent");
            xb_add(&bar[XB_XGEN(b.x)], 1u);
            asm volatile("s_waitcnt vmcnt(0)" ::: "memory");
        } else {
            XB_SPIN(xb_ld(&bar[XB_XGEN(b.x)]) == gen, bar);
            __builtin_amdgcn_fence(__ATOMIC_ACQUIRE, "agent");
            asm volatile("s_waitcnt vmcnt(0)" ::: "memory");
        }
    }
    __syncthreads();
}
#endif

__global__ void __launch_bounds__(512, 2) mk_fwd(Params P) {
#ifdef EMU
    unsigned char* smem = g_blk->lds;
#else
    extern __shared__ __attribute__((aligned(16))) unsigned char smem[];
    volatile LAS unsigned* bst = (volatile LAS unsigned*)(smem + LDS_BYTES - 16);
    if (threadIdx.x == 0) { bst[0] = 0u; bst[1] = 0u; bst[2] = 0u; bst[3] = 0u; }
    __syncthreads();
    XcdBarrier bar; bar.bar = (unsigned*)P.ws + CW_BAR; bar.x = 0; bar.st = bst;
    if (P.ph_hi - P.ph_lo > 1) bar = xcd_barrier_post((unsigned*)P.ws + CW_BAR, bst);
#endif
    unsigned char* ws = P.ws;
    const int lo = P.ph_lo, hi = P.ph_hi;
#ifdef EMU
#define SEAM(id) do {} while (0)
#else
#define SEAM(id) do { if ((id) + 1 < hi) xcd_barrier(bar); } while (0)
#endif
#ifndef MK_ONLY_PHASE
#define MK_ONLY_PHASE -1
#endif
#define PH(k, body) do { if (MK_ONLY_PHASE < 0 || MK_ONLY_PHASE == (k)) { const int id_ = l * NPH + (k); if (id_ >= lo && id_ < hi) { body; SEAM(id_); } } } while (0)
    for (int l = 0; l < NL; ++l) {
        const float* xin = l == 0 ? P.in[0] : (const float*)(ws + O_XA);
        PH(0, phase_gemm_dense(smem, xin, D, P.in[1] + (size_t)l * D * PIN, PIN, (float*)(ws + O_PROJ), PIN, T, PIN, D));
        PH(1, phase_prep(P, l, smem));
        PH(2, { phase_gmlp_mix(P, l, smem); phase_mlstm_local(P, l, smem); phase_rwkv_scan(P, l, smem); });
        PH(3, phase_mlstm_carry(P, l, smem));
        PH(4, { phase_mlstm_out(P, l, smem); phase_rwkv_post(P, l, smem); });
        PH(5, phase_gemm_dense(smem, (const float*)(ws + O_GRP), D, P.in[21] + (size_t)l * D * D, D, (float*)(ws + O_MIX), D, T, D, D));
        PH(6, phase_ln1_router(P, l, smem));
        PH(7, phase_scatter(P, l, smem));
        PH(8, phase_moe_gemm<1>(P, l, smem));
        PH(9, phase_moe_act(P, l, smem));
        PH(10, phase_moe_gemm<2>(P, l, smem));
        PH(11, phase_combine_ln2(P, l, smem));
    }
#undef PH
#undef SEAM
}

}

#ifndef EMU
extern "C" void kernel_launch(void* const* d_in, const int* in_sizes, int n_in, void* d_out, int out_size, void* d_ws, size_t ws_size, hipStream_t stream) {
    using namespace mk;
    static int grid = 0;
    if (grid == 0) {
        if (n_in != 32 || out_size != T * D || ws_size < WS_END) { fprintf(stderr, "kernel_launch: unexpected shapes (n_in %d out %d ws %zu need %zu)\n", n_in, out_size, ws_size, (size_t)WS_END); grid = -1; return; }
        int dev = 0, cus = 0;
        if (hipGetDevice(&dev) != hipSuccess || hipDeviceGetAttribute(&cus, hipDeviceAttributeMultiprocessorCount, dev) != hipSuccess) { grid = -1; return; }
        if (hipFuncSetAttribute((const void*)mk_fwd, hipFuncAttributeMaxDynamicSharedMemorySize, LDS_BYTES) != hipSuccess) { fprintf(stderr, "kernel_launch: hipFuncSetAttribute failed\n"); grid = -1; return; }
        int per_cu = 0;
        (void)hipOccupancyMaxActiveBlocksPerMultiprocessor(&per_cu, (const void*)mk_fwd, NTHREADS, LDS_BYTES);
        (void)hipGetLastError();
        grid = cus;
    }
    if (grid < 0) return;
    (void)hipMemsetAsync(d_ws, 0, CTL_BYTES, stream);
    Params p{};
    for (int i = 0; i < 32; ++i) p.in[i] = (const float*)d_in[i];
    p.out = (float*)d_out; p.ws = (unsigned char*)d_ws;
#if MK_ONE_LAUNCH
    p.ph_lo = 0; p.ph_hi = NL * NPH;
    hipLaunchKernelGGL(mk_fwd, dim3(grid), dim3(NTHREADS), LDS_BYTES, stream, p);
#else
    for (int id = 0; id < NL * NPH; ++id) {
        p.ph_lo = id; p.ph_hi = id + 1;
        hipLaunchKernelGGL(mk_fwd, dim3(grid), dim3(NTHREADS), LDS_BYTES, stream, p);
    }
#endif
}
#endif
```

```cpp
#ifndef EMU
#include <hip/hip_runtime.h>
#endif
#include <cstdio>
#include <cstdint>
#include <cmath>

#ifndef CFG_BATCH
#define CFG_BATCH 4
#endif
#ifndef CFG_SEQ
#define CFG_SEQ 4096
#endif
#ifndef CFG_LAYERS
#define CFG_LAYERS 4
#endif
#ifndef MK_ONE_LAUNCH
#define MK_ONE_LAUNCH 1
#endif

namespace mk {
constexpr int NB = CFG_BATCH, S = CFG_SEQ, T = NB * S, NL = CFG_LAYERS, D = 1024;
constexpr int GW = 256, RW = 384, MW = 384, HD = 64, GH = 4, RH = 6, MH = 6, CH = 128, NCH = S / CH;
constexpr int PIN = 3480, PLD = 3584, RPROJ = 1408;
constexpr int C_RW = 512, C_MW = 1920;
constexpr int NE = 32, TOPK = 4, DFF = 1024, MOEB = 256;
constexpr int NROWS = (T * TOPK / MOEB + NE) * MOEB;
constexpr float LN_EPS = 1e-5f, GN_EPS = 64e-5f;
constexpr float ALPHA = 1.6817928305074290f;
constexpr int NTHREADS = 512, NWAVES = 8;
constexpr int LDS_BYTES = 160 * 1024;
constexpr int NPH = 11;

typedef float f32x4 __attribute__((ext_vector_type(4)));
typedef unsigned u32x4 __attribute__((ext_vector_type(4)));
typedef unsigned u32x2 __attribute__((ext_vector_type(2)));
typedef short bf16x8 __attribute__((ext_vector_type(8)));
typedef unsigned short bf16_t;

constexpr size_t al(size_t x) { return (x + 255) & ~(size_t)255; }
constexpr size_t CTL_BYTES = 1u << 20;
constexpr size_t O_XA = CTL_BYTES;
constexpr size_t O_XB = O_XA + al((size_t)T * D * 4);
constexpr size_t O_X1 = O_XB + al((size_t)T * D * 2);
constexpr size_t O_X1B = O_X1 + al((size_t)T * D * 4);
constexpr size_t O_PROJ = O_X1B + al((size_t)T * D * 2);
constexpr size_t O_MIX = O_PROJ + al((size_t)T * PLD * 4);
constexpr size_t O_GRP = O_MIX + al((size_t)T * D * 4);
constexpr size_t O_UG = O_GRP + al((size_t)T * D * 2);
constexpr size_t O_VN = O_UG + al((size_t)T * GW * 4);
constexpr size_t O_RR = O_VN + al((size_t)T * GW * 4);
constexpr size_t O_VV = O_RR + al((size_t)T * RW * 4);
constexpr size_t O_KK = O_VV + al((size_t)T * RW * 4);
constexpr size_t O_DEC = O_KK + al((size_t)T * RW * 4);
constexpr size_t O_KD = O_DEC + al((size_t)2 * T * RW * 4);
constexpr size_t O_ICLR = O_KD + al((size_t)2 * T * RW * 4);
constexpr size_t O_GATE = O_ICLR + al((size_t)2 * T * RW * 4);
constexpr size_t O_BONUS = O_GATE + al((size_t)T * RW * 4);
constexpr size_t O_SCAN = O_BONUS + al((size_t)T * RH * 4);
constexpr size_t O_MQ = O_SCAN + al((size_t)2 * T * RW * 4);
constexpr size_t O_MK = O_MQ + al((size_t)T * MW * 4);
constexpr size_t O_IG = O_MK + al((size_t)T * MW * 4);
constexpr size_t O_LF = O_IG + al((size_t)2 * T * MH * 4);
constexpr size_t O_CL = O_LF + al((size_t)2 * T * MH * 4);
constexpr size_t O_NL = O_CL + al((size_t)2 * NB * MH * NCH * 4096 * 4);
constexpr size_t O_ML = O_NL + al((size_t)2 * NB * MH * NCH * 64 * 4);
constexpr size_t O_BL = O_ML + al((size_t)2 * NB * MH * NCH * 4);
constexpr size_t O_MIN = O_BL + al((size_t)2 * NB * MH * NCH * 4);
constexpr size_t O_TOPI = O_MIN + al((size_t)2 * NB * MH * NCH * 4);
constexpr size_t O_TOPG = O_TOPI + al((size_t)T * 4 * 4);
constexpr size_t O_RANK = O_TOPG + al((size_t)T * 4 * 4);
constexpr size_t O_SLOT = O_RANK + al((size_t)T * 4 * 4);
constexpr size_t O_XS = O_SLOT + al((size_t)T * 4 * 4);
constexpr size_t O_ACT = O_XS + al((size_t)NROWS * D * 2);
constexpr size_t O_YS = O_ACT + al((size_t)NROWS * DFF * 2);
constexpr size_t O_WIN = O_YS + al((size_t)NROWS * D * 2);
constexpr size_t O_WOUT = O_WIN + al((size_t)NL * PLD * D * 2);
constexpr size_t O_W1 = O_WOUT + al((size_t)NL * D * D * 2);
constexpr size_t O_W2 = O_W1 + al((size_t)NL * NE * 2 * DFF * D * 2);
constexpr size_t WS_END = O_W2 + al((size_t)NL * NE * D * DFF * 2);

constexpr int CW_BAR = 4096;
constexpr int CW_CNT = 16384;

struct Params { const float* in[32]; float* out; unsigned char* ws; int ph_lo, ph_hi; };

#ifdef EMU
#define WAVE_SYNC() emu_wave_barrier()
#define PIN_V(x) do {} while (0)
#define PIN_S(x) do {} while (0)
#else
#define WAVE_SYNC() __builtin_amdgcn_wave_barrier()
#define PIN_V(x) asm volatile("" : "+v"(x))
#define PIN_S(x) asm volatile("" : "+s"(x))
#endif
__device__ __forceinline__ int phase_tid() { int t = threadIdx.x; PIN_V(t); return t; }

__device__ __forceinline__ float wave_sum(float v) {
#pragma unroll
    for (int o = 32; o >= 1; o >>= 1) v += __shfl_xor(v, o);
    return v;
}
__device__ __forceinline__ float sigmoidf_(float x) { return 1.0f / (1.0f + expf(-x)); }
__device__ __forceinline__ float softplusf_(float x) { return fmaxf(x, 0.f) + log1pf(expf(-fabsf(x))); }
__device__ __forceinline__ float geluf_(float x) { return 0.5f * x * (1.0f + erff(x * 0.70710678118654752f)); }

#ifdef EMU
#define LAS
#define WAIT_V(n) do {} while (0)
#define WAIT_L(n) do {} while (0)
#define S_BARRIER() __syncthreads()
#define SETPRIO(x) do {} while (0)
#define SCHED_BAR() do {} while (0)
#define RFL(x) (x)
static inline void emu_glds16(const void* g, void* l) { memcpy((char*)l + (g_blk->cur & 63) * 16, g, 16); }
#define GLDS16(gptr, ldsptr) emu_glds16((const void*)(gptr), (void*)(ldsptr))
static inline float emu_bf2f(unsigned short b) { unsigned u = (unsigned)b << 16; float f; memcpy(&f, &u, 4); return f; }
static inline f32x4 emu_mfma16(bf16x8 a, bf16x8 b, f32x4 c) {
    EmuBlock* blk = g_blk; const int cur = blk->cur, lane = cur & 63, wbase = cur & ~63;
    static thread_local unsigned short Ash[32][64][8], Bsh[32][64][8];
    const int w = cur >> 6;
    for (int j = 0; j < 8; ++j) { Ash[w][lane][j] = (unsigned short)a[j]; Bsh[w][lane][j] = (unsigned short)b[j]; }
    emu_wave_barrier();
    const int col = lane & 15;
    for (int r = 0; r < 4; ++r) { const int row = 4 * (lane >> 4) + r; float sum = c[r];
        for (int k = 0; k < 32; ++k) sum += emu_bf2f(Ash[w][row + 16 * (k >> 3)][k & 7]) * emu_bf2f(Bsh[w][col + 16 * (k >> 3)][k & 7]);
        c[r] = sum; }
    emu_wave_barrier(); (void)wbase;
    return c;
}
#define MFMA16(a, b, c) emu_mfma16(a, b, c)
#else
#define LAS __attribute__((address_space(3)))
#define WAIT_V(n) asm volatile("s_waitcnt vmcnt(" #n ")" ::: "memory")
#define WAIT_L(n) asm volatile("s_waitcnt lgkmcnt(" #n ")" ::: "memory")
#define S_BARRIER() __builtin_amdgcn_s_barrier()
#define SETPRIO(x) __builtin_amdgcn_s_setprio(x)
#define SCHED_BAR() __builtin_amdgcn_sched_barrier(0)
#define RFL(x) __builtin_amdgcn_readfirstlane(x)
#define GLDS16(gptr, ldsptr) __builtin_amdgcn_global_load_lds((const unsigned*)(gptr), (LAS unsigned*)(ldsptr), 16, 0, 0)
#define MFMA16(a, b, c) __builtin_amdgcn_mfma_f32_16x16x32_bf16(a, b, c, 0, 0, 0)
#endif

__device__ __forceinline__ unsigned f2bf(float f) { unsigned u = __builtin_bit_cast(unsigned, f); return (u + 0x7fffu + ((u >> 16) & 1u)) >> 16; }
__device__ __forceinline__ unsigned pk2(float lo, float hi) { return f2bf(lo) | (f2bf(hi) << 16); }

namespace pg8 {
constexpr int BM = 256, BK = 64, HALF = 128, HTB = HALF * BK * 2, STAGE_BYTES = 8 * HTB, NXCD = 8, WGM = 8;
__host__ __device__ __forceinline__ int lds_byte(int r, int c) { const int st = (r >> 4) * 2 + (c >> 5), rr = r & 15, cc = c & 31, ob = rr * 64 + cc * 2; return st * 1024 + (ob ^ (((ob >> 9) & 1) << 5)); }
__host__ __device__ __forceinline__ void stage_rc(int b, int& R, int& C) { const int st = b / 1024, sb = b % 1024, swz = sb ^ (((sb >> 9) & 1) << 5); R = (st >> 1) * 16 + swz / 64; C = (st & 1) * 32 + (swz % 64) / 2; }
__host__ __device__ __forceinline__ int perm32(int rho) { const int n = rho >> 4, i = rho & 15; return 8 * (i >> 2) + 4 * n + (i & 3); }
struct Unit { int pm, pn, e; };

struct DenseOrder {
    const char* A; const char* Bt; int K; int nM, nN, nwg, G, c;
    __device__ __forceinline__ void init(const void* A_, const void* Bt_, int M, int N, int K_, int G_, int c_) { A = (const char*)A_; Bt = (const char*)Bt_; K = K_; nM = M / BM; nN = N / BM; nwg = nM * nN; G = G_; c = c_; }
    __device__ __forceinline__ bool next(int i, Unit& u) const {
        const long L = (long)i * G + c; if (L >= nwg) return false;
        int wgid = (int)L; { const int q = nwg / NXCD, r = nwg % NXCD, xcd = wgid % NXCD, off = wgid / NXCD; wgid = (xcd < r ? xcd * (q + 1) : r * (q + 1) + (xcd - r) * q) + off; }
        const int nig = WGM * nN, gid = wgid / nig, fm = gid * WGM, gsz = (nM - fm) < WGM ? (nM - fm) : WGM;
        u.pm = fm + ((wgid % nig) % gsz); u.pn = (wgid % nig) / gsz; u.e = 0; return true;
    }
    __device__ __forceinline__ const char* abase(const Unit& u) const { return A + (size_t)u.pm * BM * K * 2; }
    __device__ __forceinline__ const char* bbase(const Unit& u) const { return Bt + (size_t)u.pn * BM * K * 2; }
};
struct MoeOrder {
    const char* A; const char* Wt; int K; int nN, nwg, G, c; size_t estride; const int* rbe;
    __device__ __forceinline__ bool next(int i, Unit& u) const {
        const long L = (long)i * G + c; if (L >= nwg) return false;
        u.pm = (int)(L / nN); u.pn = (int)(L % nN); u.e = rbe[u.pm]; return true;
    }
    __device__ __forceinline__ const char* abase(const Unit& u) const { return A + (size_t)u.pm * BM * K * 2; }
    __device__ __forceinline__ const char* bbase(const Unit& u) const { return Wt + (size_t)u.e * estride + (size_t)u.pn * BM * K * 2; }
};

struct EpiF32 {
    static constexpr bool PERM = false;
    float* C; int ldc;
    __device__ __forceinline__ void operator()(const f32x4 (&acc)[2][2][4][2], const Unit& u, int wr, int wc, int fr, int fq) const {
        const int row0 = u.pm * BM + wr * 64 + fr, col0 = u.pn * BM + wc * 32 + 4 * fq;
#pragma unroll
        for (int ai = 0; ai < 2; ++ai)
#pragma unroll
            for (int m = 0; m < 4; ++m) { float* rowp = C + (size_t)(row0 + ai * HALF + m * 16) * ldc + col0;
#pragma unroll
                for (int bj = 0; bj < 2; ++bj)
#pragma unroll
                    for (int n = 0; n < 2; ++n) *(f32x4*)(rowp + bj * HALF + n * 16) = acc[ai][bj][m][n]; }
    }
};
struct EpiBf16Bias {
    static constexpr bool PERM = true;
    bf16_t* O; int ldc; const float* bias; int bias_estride;
    __device__ __forceinline__ void operator()(const f32x4 (&acc)[2][2][4][2], const Unit& u, int wr, int wc, int fr, int fq) const {
        const int row0 = u.pm * BM + wr * 64 + fr, col0 = u.pn * BM + wc * 32 + 8 * fq;
        const float* bp = bias + (size_t)u.e * bias_estride + col0;
        f32x4 bv[2][2];
#pragma unroll
        for (int bj = 0; bj < 2; ++bj)
#pragma unroll
            for (int n = 0; n < 2; ++n) bv[bj][n] = *(const f32x4*)(bp + bj * HALF + 4 * n);
#pragma unroll
        for (int ai = 0; ai < 2; ++ai)
#pragma unroll
            for (int m = 0; m < 4; ++m) { bf16_t* rowp = O + (size_t)(row0 + ai * HALF + m * 16) * ldc + col0;
#pragma unroll
                for (int bj = 0; bj < 2; ++bj) { const f32x4 v0 = acc[ai][bj][m][0] + bv[bj][0], v1 = acc[ai][bj][m][1] + bv[bj][1];
                    u32x4 w; w.x = pk2(v0[0], v0[1]); w.y = pk2(v0[2], v0[3]); w.z = pk2(v1[0], v1[1]); w.w = pk2(v1[2], v1[3]);
                    *(u32x4*)(rowp + bj * HALF) = w; } }
    }
};
__device__ __forceinline__ float swiglu1(float g, float uu) { g = fminf(g, 7.0f); uu = fminf(fmaxf(uu, -7.0f), 7.0f); return (uu + 1.0f) * (g / (1.0f + expf(-1.702f * g))); }
struct EpiSwiglu {
    static constexpr bool PERM = true;
    bf16_t* O; const float* b1;
    __device__ __forceinline__ void operator()(const f32x4 (&acc)[2][2][4][2], const Unit& u, int wr, int wc, int fr, int fq) const {
        const int row0 = u.pm * BM + wr * 64 + fr, j0 = u.pn * HALF + wc * 32 + 8 * fq;
        const float* bg = b1 + (size_t)u.e * 2 * DFF + j0; const float* bu = bg + DFF;
        f32x4 g4[2], u4[2];
#pragma unroll
        for (int n = 0; n < 2; ++n) { g4[n] = *(const f32x4*)(bg + 4 * n); u4[n] = *(const f32x4*)(bu + 4 * n); }
#pragma unroll
        for (int ai = 0; ai < 2; ++ai)
#pragma unroll
            for (int m = 0; m < 4; ++m) {
                float o[8];
#pragma unroll
                for (int n = 0; n < 2; ++n)
#pragma unroll
                    for (int q = 0; q < 4; ++q) o[n * 4 + q] = swiglu1(acc[ai][0][m][n][q] + g4[n][q], acc[ai][1][m][n][q] + u4[n][q]);
                u32x4 w; w.x = pk2(o[0], o[1]); w.y = pk2(o[2], o[3]); w.z = pk2(o[4], o[5]); w.w = pk2(o[6], o[7]);
                *(u32x4*)(O + (size_t)(row0 + ai * HALF + m * 16) * DFF + j0) = w;
            }
    }
};

template <class Epi, class Sched>
__device__ __forceinline__ void gemm_phase(LAS unsigned char* lds, const int K, const Sched& S, const Epi& E, const int tid) {
    const int wid = RFL(tid >> 6), lane = tid & 63, wr = wid >> 2, wc = wid & 3, fr = lane & 15, fq = lane >> 4;
    const int nt = K / BK;
    unsigned voffA[2], voffB[2];
#pragma unroll
    for (int i = 0; i < 2; ++i) { int R, C; stage_rc(tid * 16 + i * 8192, R, C); const int Rb = Epi::PERM ? ((R & ~31) + perm32(R & 31)) : R;
        voffA[i] = (unsigned)(R * K + C) * 2u; voffB[i] = (unsigned)(Rb * K + C) * 2u; }
    const size_t kstep = (size_t)(BK * 2);
    const size_t hstep = (size_t)HALF * K * 2;
    const unsigned ldsw = (unsigned)wid * 1024u;
    const int aoff = lds_byte(wr * 64 + fr, fq * 8), boff = lds_byte(wc * 32 + fr, fq * 8);
#define PG8_SA(b, h) (((b) * 2 + (h)) * HTB)
#define PG8_SB(b, h) ((4 + (b) * 2 + (h)) * HTB)
#define PG8_STAGE(bufoff, gbase, voff) do { _Pragma("unroll") for (int _i = 0; _i < 2; ++_i) \
        GLDS16((const char*)(gbase) + (voff)[_i], lds + (bufoff) + ldsw + _i * 8192); } while (0)
#define PG8_LDA(dst, b, h) do { _Pragma("unroll") for (int m = 0; m < 4; ++m) _Pragma("unroll") for (int k = 0; k < 2; ++k) dst[m][k] = *(const LAS bf16x8*)(lds + PG8_SA(b, h) + aoff + m * 2048 + k * 1024); } while (0)
#define PG8_LDB(dst, b, h) do { _Pragma("unroll") for (int n = 0; n < 2; ++n) _Pragma("unroll") for (int k = 0; k < 2; ++k) dst[n][k] = *(const LAS bf16x8*)(lds + PG8_SB(b, h) + boff + n * 2048 + k * 1024); } while (0)
#define PG8_MMA(ai, bj, At, Bt) do { SETPRIO(1); _Pragma("unroll") for (int m = 0; m < 4; ++m) _Pragma("unroll") for (int n = 0; n < 2; ++n) _Pragma("unroll") for (int k = 0; k < 2; ++k) \
        acc[ai][bj][m][n] = MFMA16(Bt[n][k], At[m][k], acc[ai][bj][m][n]); SETPRIO(0); } while (0)
    Unit cur, nxt; int ui = 0;
    if (!S.next(0, cur)) return;
    f32x4 acc[2][2][4][2];
#pragma unroll
    for (int a = 0; a < 2; ++a)
#pragma unroll
        for (int b = 0; b < 2; ++b)
#pragma unroll
            for (int m = 0; m < 4; ++m)
#pragma unroll
                for (int n = 0; n < 2; ++n) acc[a][b][m][n] = (f32x4){0.f, 0.f, 0.f, 0.f};
    bf16x8 At[4][2], B0[2][2], B1[2][2];
    const char* cA = S.abase(cur); const char* cB = S.bbase(cur);
    PG8_STAGE(PG8_SB(0, 0), cB, voffB); PG8_STAGE(PG8_SA(0, 0), cA, voffA); PG8_STAGE(PG8_SB(0, 1), cB + hstep, voffB); PG8_STAGE(PG8_SA(0, 1), cA + hstep, voffA);
    if (wr == 1) S_BARRIER();
    WAIT_V(4); S_BARRIER();
    PG8_STAGE(PG8_SB(1, 0), cB + kstep, voffB); PG8_STAGE(PG8_SA(1, 0), cA + kstep, voffA); PG8_STAGE(PG8_SB(1, 1), cB + hstep + kstep, voffB);
    WAIT_V(6); S_BARRIER();
    for (;;) {
        const bool has_next = S.next(ui + 1, nxt);
        const char* nA = has_next ? S.abase(nxt) : cA; const char* nB = has_next ? S.bbase(nxt) : cB;
        for (int t = 0; t < nt; t += 2) {
            const bool last = (t == nt - 2);
            const char* a1 = cA + (size_t)(t + 1) * kstep;
            const char* a2 = last ? nA : cA + (size_t)(t + 2) * kstep; const char* b2 = last ? nB : cB + (size_t)(t + 2) * kstep;
            const char* a3 = a2 + kstep; const char* b3 = b2 + kstep;
            PG8_LDB(B0, 0, 0); SCHED_BAR(); PG8_LDA(At, 0, 0); PG8_STAGE(PG8_SA(1, 1), a1 + hstep, voffA);
            WAIT_L(8); S_BARRIER(); WAIT_L(0); PG8_MMA(0, 0, At, B0); S_BARRIER(); SCHED_BAR();
            PG8_LDB(B1, 0, 1); PG8_STAGE(PG8_SB(0, 0), b2, voffB);
            S_BARRIER(); WAIT_L(0); PG8_MMA(0, 1, At, B1); S_BARRIER();
            PG8_LDA(At, 0, 1); PG8_STAGE(PG8_SA(0, 0), a2, voffA);
            S_BARRIER(); WAIT_L(0); PG8_MMA(1, 0, At, B0); S_BARRIER(); SCHED_BAR();
            PG8_STAGE(PG8_SB(0, 1), b2 + hstep, voffB);
            WAIT_V(6); S_BARRIER(); PG8_MMA(1, 1, At, B1); S_BARRIER();
            PG8_LDB(B0, 1, 0); SCHED_BAR(); PG8_LDA(At, 1, 0); PG8_STAGE(PG8_SA(0, 1), a2 + hstep, voffA);
            WAIT_L(8); S_BARRIER(); WAIT_L(0); PG8_MMA(0, 0, At, B0); S_BARRIER(); SCHED_BAR();
            PG8_LDB(B1, 1, 1); PG8_STAGE(PG8_SB(1, 0), b3, voffB);
            S_BARRIER(); WAIT_L(0); PG8_MMA(0, 1, At, B1); S_BARRIER();
            PG8_LDA(At, 1, 1); PG8_STAGE(PG8_SA(1, 0), a3, voffA);
            S_BARRIER(); WAIT_L(0); PG8_MMA(1, 0, At, B0); S_BARRIER(); SCHED_BAR();
            PG8_STAGE(PG8_SB(1, 1), b3 + hstep, voffB);
            WAIT_V(6); S_BARRIER(); PG8_MMA(1, 1, At, B1); S_BARRIER();
        }
        E(acc, cur, wr, wc, fr, fq);
        if (!has_next) break;
#pragma unroll
        for (int a = 0; a < 2; ++a)
#pragma unroll
            for (int b = 0; b < 2; ++b)
#pragma unroll
                for (int m = 0; m < 4; ++m)
#pragma unroll
                    for (int n = 0; n < 2; ++n) acc[a][b][m][n] = (f32x4){0.f, 0.f, 0.f, 0.f};
        cur = nxt; cA = nA; cB = nB; ++ui;
    }
    WAIT_V(0);
    if (wr == 0) S_BARRIER();
    S_BARRIER();
#undef PG8_SA
#undef PG8_SB
#undef PG8_STAGE
#undef PG8_LDA
#undef PG8_LDB
#undef PG8_MMA
}
}

__device__ __forceinline__ void transpose_item(const float* W, int K, int N, bf16_t* WT, int k0, int n0, int dst_row0, float* scr, int lane) {
#pragma unroll 8
    for (int i = 0; i < 32; ++i) { const int kk = 2 * i + (lane >> 5), n = n0 + (lane & 31); scr[kk * 33 + (lane & 31)] = n < N ? W[(size_t)(k0 + kk) * N + n] : 0.f; }
    WAVE_SYNC();
    const int c = lane & 7;
#pragma unroll
    for (int j = 0; j < 4; ++j) { const int n = (lane >> 3) + 8 * j; const float* sp = scr + (8 * c) * 33 + n;
        u32x4 o; o.x = pk2(sp[0 * 33], sp[1 * 33]); o.y = pk2(sp[2 * 33], sp[3 * 33]); o.z = pk2(sp[4 * 33], sp[5 * 33]); o.w = pk2(sp[6 * 33], sp[7 * 33]);
        *(u32x4*)(WT + (size_t)(dst_row0 + n) * K + k0 + 8 * c) = o; }
    WAVE_SYNC();
}
__device__ __forceinline__ void phase_prologue(const Params& P, unsigned char* smem) {
    unsigned char* ws = P.ws; PIN_S(ws);
    const int tid = phase_tid(), lane = tid & 63, wave = tid >> 6;
    float* scr = (float*)smem + wave * (64 * 33);
    const int gw = (int)blockIdx.x * NWAVES + wave, ngw = NWAVES * (int)gridDim.x;
    constexpr int I_IN = 16 * (PLD / 32), I_OUT = 16 * 32, I_W1 = NE * 16 * 64, I_W2 = NE * 16 * 32, I_L = I_IN + I_OUT + I_W1 + I_W2;
    for (int it = gw; it < NL * I_L; it += ngw) {
        const int l = it / I_L; int r = it % I_L;
        if (r < I_IN) { const int kb = r / (PLD / 32), nb = r % (PLD / 32);
            transpose_item(P.in[1] + (size_t)l * D * PIN, D, PIN, (bf16_t*)(ws + O_WIN) + (size_t)l * PLD * D, kb * 64, nb * 32, nb * 32, scr, lane); continue; }
        r -= I_IN;
        if (r < I_OUT) { const int kb = r / 32, nb = r % 32;
            transpose_item(P.in[21] + (size_t)l * D * D, D, D, (bf16_t*)(ws + O_WOUT) + (size_t)l * D * D, kb * 64, nb * 32, nb * 32, scr, lane); continue; }
        r -= I_OUT;
        if (r < I_W1) { const int e = r / (16 * 64), q = r % (16 * 64), kb = q / 64, nb = q % 64, n0 = nb * 32;
            const int dst = n0 < DFF ? (n0 / 128) * 256 + (n0 % 128) : ((n0 - DFF) / 128) * 256 + 128 + ((n0 - DFF) % 128);
            transpose_item(P.in[26] + ((size_t)l * NE + e) * D * 2 * DFF, D, 2 * DFF, (bf16_t*)(ws + O_W1) + ((size_t)l * NE + e) * 2 * DFF * D, kb * 64, n0, dst, scr, lane); continue; }
        r -= I_W1;
        { const int e = r / (16 * 32), q = r % (16 * 32), kb = q / 32, nb = q % 32;
            transpose_item(P.in[28] + ((size_t)l * NE + e) * DFF * D, DFF, D, (bf16_t*)(ws + O_W2) + ((size_t)l * NE + e) * D * DFF, kb * 64, nb * 32, nb * 32, scr, lane); }
    }
    const float* x = P.in[0]; bf16_t* XB = (bf16_t*)(ws + O_XB);
    for (size_t i = ((size_t)blockIdx.x * NTHREADS + tid) * 4; i < (size_t)T * D; i += (size_t)gridDim.x * NTHREADS * 4) {
        const f32x4 v = *(const f32x4*)(x + i); u32x2 o; o.x = pk2(v.x, v.y); o.y = pk2(v.z, v.w); *(u32x2*)(XB + i) = o;
    }
}

__device__ __forceinline__ float tshift(const float* P, int t, int s, int col, const float* mu0, const float* mu1, int rc) {
    const float cur = P[(size_t)t * PLD + col];
    const float prv = s > 0 ? P[(size_t)(t - 1) * PLD + col] : 0.f;
    const float nxt = s < S - 1 ? P[(size_t)(t + 1) * PLD + col] : 0.f;
    return cur + mu0[rc] * (prv - cur) + mu1[rc] * (nxt - cur);
}

__device__ __forceinline__ void phase_prep(const Params& P, int l, unsigned char* smem) {
    unsigned char* ws = P.ws; PIN_S(ws);
    const float* proj = (const float*)(ws + O_PROJ);
    float* UG = (float*)(ws + O_UG); float* VN = (float*)(ws + O_VN);
    float* RR = (float*)(ws + O_RR); float* VV = (float*)(ws + O_VV); float* KK = (float*)(ws + O_KK);
    float* DEC = (float*)(ws + O_DEC); float* KD = (float*)(ws + O_KD); float* ICLR = (float*)(ws + O_ICLR);
    float* GATE = (float*)(ws + O_GATE); float* BONUS = (float*)(ws + O_BONUS);
    float* MQ = (float*)(ws + O_MQ); float* MKb = (float*)(ws + O_MK); float* IG = (float*)(ws + O_IG); float* LF = (float*)(ws + O_LF);
    const float* gln_g = P.in[2] + (size_t)l * GW; const float* gln_b = P.in[3] + (size_t)l * GW;
    const float* mu0 = P.in[6] + (size_t)l * 2 * RPROJ; const float* mu1 = mu0 + RPROJ;
    const float* w0 = P.in[7] + (size_t)l * 2 * RW; const float* w2 = P.in[8] + (size_t)l * 2 * 64 * RW;
    const float* a0 = P.in[9] + (size_t)l * 2 * RW; const float* a2 = P.in[10] + (size_t)l * 2 * 64 * RW;
    const float* g2 = P.in[11] + (size_t)l * 128 * RW;
    const float* k_k = P.in[12] + (size_t)l * RW; const float* k_a = P.in[13] + (size_t)l * RW; const float* r_k = P.in[14] + (size_t)l * RW;
    const float* conv_w = P.in[17] + (size_t)l * 3 * 768; const float* conv_b = P.in[18] + (size_t)l * 768; const float* gate_b = P.in[19] + (size_t)l * 24;
    float* lora = (float*)smem;
    const int tid = phase_tid(), lane = tid & 63, wave = tid >> 6;
    for (int u = blockIdx.x; u < T / 16; u += gridDim.x) {
        const int t0 = u * 16, s0 = t0 % S;
        {
            const int i = tid >> 5, l32 = tid & 31, t = t0 + i;
            float v[8]; float sum = 0.f;
#pragma unroll
            for (int j = 0; j < 8; ++j) {
                const int c = j * 32 + l32;
                UG[(size_t)t * GW + c] = geluf_(proj[(size_t)t * PLD + c]);
                v[j] = geluf_(proj[(size_t)t * PLD + GW + c]); sum += v[j];
            }
#pragma unroll
            for (int o = 16; o >= 1; o >>= 1) sum += __shfl_xor(sum, o);
            const float mean = sum * (1.0f / GW); float q = 0.f;
#pragma unroll
            for (int j = 0; j < 8; ++j) { const float d = v[j] - mean; q += d * d; }
#pragma unroll
            for (int o = 16; o >= 1; o >>= 1) q += __shfl_xor(q, o);
            const float rstd = 1.0f / sqrtf(q * (1.0f / GW) + LN_EPS);
#pragma unroll
            for (int j = 0; j < 8; ++j) { const int c = j * 32 + l32; VN[(size_t)t * GW + c] = (v[j] - mean) * rstd * gln_g[c] + gln_b[c]; }
        }
        __syncthreads();
        for (int idx = tid; idx < 16 * 256; idx += NTHREADS) {
            const int i = idx >> 8, j = idx & 255, rc = 1152 + j;
            const float x = tshift(proj, t0 + i, s0 + i, C_RW + rc, mu0, mu1, rc);
            lora[idx] = j < 64 ? tanhf(x) : (j < 128 ? x : sigmoidf_(x));
        }
        __syncthreads();
        if (wave < 6) {
            const int c = tid, h = wave;
            {
                float aw0[16], aw1[16];
#pragma unroll
                for (int i = 0; i < 16; ++i) { aw0[i] = w0[c]; aw1[i] = w0[RW + c]; }
                for (int j = 0; j < 64; ++j) {
                    const float w20 = w2[(size_t)j * RW + c], w21 = w2[(size_t)(64 + j) * RW + c];
#pragma unroll
                    for (int i = 0; i < 16; ++i) { const float lw = lora[i * 256 + j]; aw0[i] += lw * w20; aw1[i] += lw * w21; }
                }
#pragma unroll
                for (int i = 0; i < 16; ++i) {
                    const size_t o = (size_t)(t0 + i) * RW + c;
                    DEC[o] = expf(-expf(-softplusf_(-aw0[i]) - 0.5f)); DEC[(size_t)T * RW + o] = expf(-expf(-softplusf_(-aw1[i]) - 0.5f));
                }
            }
            {
                float aa0[16], aa1[16];
#pragma unroll
                for (int i = 0; i < 16; ++i) { aa0[i] = a0[c]; aa1[i] = a0[RW + c]; }
                for (int j = 0; j < 64; ++j) {
                    const float a20 = a2[(size_t)j * RW + c], a21 = a2[(size_t)(64 + j) * RW + c];
#pragma unroll
                    for (int i = 0; i < 16; ++i) { const float la = lora[i * 256 + 64 + j]; aa0[i] += la * a20; aa1[i] += la * a21; }
                }
#pragma unroll
                for (int i = 0; i < 16; ++i) {
                    const size_t o = (size_t)(t0 + i) * RW + c;
                    ICLR[o] = sigmoidf_(aa0[i]); ICLR[(size_t)T * RW + o] = sigmoidf_(aa1[i]);
                }
            }
            {
                float ag[16];
#pragma unroll
                for (int i = 0; i < 16; ++i) ag[i] = 0.f;
                for (int j = 0; j < 128; ++j) {
                    const float g = g2[(size_t)j * RW + c];
#pragma unroll
                    for (int i = 0; i < 16; ++i) ag[i] += lora[i * 256 + 128 + j] * g;
                }
#pragma unroll
                for (int i = 0; i < 16; ++i) GATE[(size_t)(t0 + i) * RW + c] = ag[i];
            }
            const float kkc = k_k[c], kac = k_a[c], rkc = r_k[c];
#pragma unroll
            for (int i = 0; i < 16; ++i) {
                const int t = t0 + i, s = s0 + i;
                const float r = tshift(proj, t, s, C_RW + c, mu0, mu1, c);
                const float k = tshift(proj, t, s, C_RW + RW + c, mu0, mu1, RW + c);
                const float v = tshift(proj, t, s, C_RW + 2 * RW + c, mu0, mu1, 2 * RW + c);
                const size_t o = (size_t)t * RW + c;
                const float ic0 = ICLR[o], ic1 = ICLR[(size_t)T * RW + o];
                const float kq = k * kkc;
                const float n2 = wave_sum(kq * kq);
                const float kk = kq / fmaxf(sqrtf(n2), 1e-12f);
                const float kd0 = k * (1.0f + (ic0 - 1.0f) * kac), kd1 = k * (1.0f + (ic1 - 1.0f) * kac);
                const float bon = wave_sum(r * (kd0 + kd1) * rkc);
                RR[o] = r; VV[o] = v; KK[o] = kk;
                KD[o] = kd0; KD[(size_t)T * RW + o] = kd1;
                if (lane == 0) BONUS[(size_t)t * RH + h] = bon;
            }
        }
        for (int idx = tid; idx < 16 * 768; idx += NTHREADS) {
            const int i = idx / 768, c = idx % 768, t = t0 + i, s = s0 + i, col = C_MW + c;
            const float xm = s > 0 ? proj[(size_t)(t - 1) * PLD + col] : 0.f;
            const float x0 = proj[(size_t)t * PLD + col];
            const float xp = s < S - 1 ? proj[(size_t)(t + 1) * PLD + col] : 0.f;
            float y = conv_b[c] + xm * conv_w[c] + x0 * conv_w[768 + c] + xp * conv_w[2 * 768 + c];
            y = y * sigmoidf_(y);
            if (c < MW) MQ[(size_t)t * MW + c] = y; else MKb[(size_t)t * MW + (c - MW)] = y * 0.125f;
        }
        for (int idx = tid; idx < 16 * 24; idx += NTHREADS) {
            const int i = idx / 24, gi = idx % 24, t = t0 + i;
            const int isf = gi / 12, dir = (gi / 6) & 1, h = gi % 6;
            const float g = proj[(size_t)t * PLD + 3456 + gi] + gate_b[gi];
            if (isf) LF[((size_t)dir * T + t) * MH + h] = -softplusf_(-g); else IG[((size_t)dir * T + t) * MH + h] = g;
        }
        __syncthreads();
    }
}

__device__ __forceinline__ void phase_gmlp_mix(const Params& P, int l, unsigned char* smem) {
    unsigned char* ws = P.ws; PIN_S(ws);
    const float* UG = (const float*)(ws + O_UG); const float* VN = (const float*)(ws + O_VN); bf16_t* GRP = (bf16_t*)(ws + O_GRP);
    const float* gws = P.in[4] + (size_t)l * GH * CH * CH; const float* gbs = P.in[5] + (size_t)l * GH * CH;
    float* vs = (float*)smem;
    float* wsm = vs + 128 * 64;
    const int tid = phase_tid();
    for (int u = blockIdx.x; u < NB * NCH * GH; u += gridDim.x) {
        const int h = u % GH, c = (u / GH) % NCH, b = u / (GH * NCH);
        const int tok0 = b * S + c * CH;
        __syncthreads();
        for (int idx = tid; idx < 128 * 64; idx += NTHREADS) { const int q = idx >> 6, e = idx & 63; vs[idx] = VN[(size_t)(tok0 + q) * GW + h * 64 + e]; }
        for (int idx = tid; idx < 128 * 128; idx += NTHREADS) wsm[idx] = gws[(size_t)h * CH * CH + idx];
        __syncthreads();
        const int p = tid >> 2, eg = (tid & 3) * 16;
        float acc[16];
#pragma unroll
        for (int e = 0; e < 16; ++e) acc[e] = 0.f;
        for (int q = 0; q < 128; ++q) {
            const float w = wsm[p * 128 + q];
#pragma unroll
            for (int e = 0; e < 16; ++e) acc[e] += w * vs[q * 64 + eg + e];
        }
        const float bsv = gbs[h * CH + p];
#pragma unroll
        for (int e = 0; e < 16; ++e) {
            const size_t t = (size_t)(tok0 + p);
            GRP[t * D + h * 64 + eg + e] = (bf16_t)f2bf(UG[t * GW + h * 64 + eg + e] * (acc[e] + bsv));
        }
    }
    __syncthreads();
}

__device__ __forceinline__ void phase_rwkv_scan(const Params& P, int l, unsigned char* smem) {
    unsigned char* ws = P.ws; PIN_S(ws);
    const float* RR = (const float*)(ws + O_RR); const float* VV = (const float*)(ws + O_VV); const float* KK = (const float*)(ws + O_KK);
    const float* DEC = (const float*)(ws + O_DEC); const float* KD = (const float*)(ws + O_KD); const float* ICLR = (const float*)(ws + O_ICLR);
    float* SCAN = (float*)(ws + O_SCAN);
    const int tid = phase_tid(), lane = tid & 63, wave = tid >> 6;
    float* vec = (float*)smem + wave * 320;
    const int gw = wave * (int)gridDim.x + (int)blockIdx.x, ngw = NWAVES * (int)gridDim.x;
    for (int u = gw; u < 2 * NB * RH; u += ngw) {
        const int h = u % RH, b = (u / RH) % NB, d = u / (RH * NB);
        float st[64];
#pragma unroll
        for (int k = 0; k < 64; ++k) st[k] = 0.f;
        const size_t doff = (size_t)d * T * RW;
        for (int tau = 0; tau < S; ++tau) {
            const int s = d ? S - 1 - tau : tau;
            const size_t idx = (size_t)(b * S + s) * RW + h * 64 + lane;
            const float w = DEC[doff + idx], kkv = KK[idx], ic = ICLR[doff + idx], kd = KD[doff + idx], r = RR[idx], v = VV[idx];
            vec[lane] = w; vec[64 + lane] = -kkv; vec[128 + lane] = kkv * ic; vec[192 + lane] = kd; vec[256 + lane] = r;
            WAVE_SYNC();
            float sa = 0.f;
#pragma unroll
            for (int k = 0; k < 64; ++k) sa += st[k] * vec[64 + k];
            float out = 0.f;
#pragma unroll
            for (int k = 0; k < 64; ++k) { st[k] = st[k] * vec[k] + sa * vec[128 + k] + v * vec[192 + k]; out += st[k] * vec[256 + k]; }
            SCAN[doff + idx] = out;
            WAVE_SYNC();
        }
    }
}

__device__ __forceinline__ void phase_mlstm_local(const Params& P, int l, unsigned char* smem) {
    unsigned char* ws = P.ws; PIN_S(ws);
    const float* proj = (const float*)(ws + O_PROJ); const float* MKb = (const float*)(ws + O_MK);
    const float* IG = (const float*)(ws + O_IG); const float* LF = (const float*)(ws + O_LF);
    float* CL = (float*)(ws + O_CL); float* NLb = (float*)(ws + O_NL); float* ML = (float*)(ws + O_ML); float* BL = (float*)(ws + O_BL);
    float* ks = (float*)smem;
    float* vs = ks + 128 * 64;
    float* wts = vs + 128 * 64;
    float* lfv = wts + 128; float* igv = lfv + 128;
    int* tok = (int*)(igv + 128);
    const int tid = phase_tid();
    for (int u = blockIdx.x; u < 2 * NB * MH * NCH; u += gridDim.x) {
        const int c = u % NCH, h = (u / NCH) % MH, p = u / (NCH * MH), d = p / NB, b = p % NB;
        __syncthreads();
        if (tid < 128) {
            const int tau = c * CH + tid, s = d ? S - 1 - tau : tau, t = b * S + s;
            tok[tid] = t; lfv[tid] = LF[((size_t)d * T + t) * MH + h]; igv[tid] = IG[((size_t)d * T + t) * MH + h];
        }
        __syncthreads();
        for (int idx = tid; idx < 128 * 64; idx += NTHREADS) {
            const int j = idx >> 6, e = idx & 63; const size_t t = (size_t)tok[j];
            ks[idx] = MKb[t * MW + h * 64 + e]; vs[idx] = proj[t * PLD + C_MW + 2 * MW + h * 64 + e];
        }
        if (tid == 0) {
            float bc = 0.f;
            for (int j = 0; j < 128; ++j) { bc += lfv[j]; wts[j] = bc; }
            const float blast = bc; float m = -INFINITY;
            for (int j = 0; j < 128; ++j) { const float lw = blast - wts[j] + igv[j]; wts[j] = lw; m = fmaxf(m, lw); }
            for (int j = 0; j < 128; ++j) wts[j] = expf(wts[j] - m);
            ML[u] = m; BL[u] = blast;
        }
        __syncthreads();
        const int dk = tid >> 3, dv = (tid & 7) * 8;
        float acc[8]; float nacc = 0.f;
#pragma unroll
        for (int e = 0; e < 8; ++e) acc[e] = 0.f;
        for (int j = 0; j < 128; ++j) {
            const float kw = wts[j] * ks[j * 64 + dk];
            nacc += kw;
#pragma unroll
            for (int e = 0; e < 8; ++e) acc[e] += kw * vs[j * 64 + dv + e];
        }
#pragma unroll
        for (int e = 0; e < 8; ++e) CL[(size_t)u * 4096 + dk * 64 + dv + e] = acc[e];
        if (dv == 0) NLb[(size_t)u * 64 + dk] = nacc;
    }
    __syncthreads();
}

__device__ __forceinline__ void phase_mlstm_carry(const Params& P, int l, unsigned char* smem) {
    unsigned char* ws = P.ws; PIN_S(ws);
    float* CL = (float*)(ws + O_CL); float* NLb = (float*)(ws + O_NL); const float* ML = (const float*)(ws + O_ML); const float* BL = (const float*)(ws + O_BL);
    float* MIN = (float*)(ws + O_MIN);
    const int total = 2 * NB * MH * 4160;
    const int tid = phase_tid();
    for (int g = blockIdx.x * NTHREADS + tid; g < total; g += gridDim.x * NTHREADS) {
        const int ph = g / 4160, e = g % 4160;
        float m = 0.f, val = 0.f;
        for (int c = 0; c < NCH; ++c) {
            const int base = ph * NCH + c;
            float* ptr = e < 4096 ? CL + (size_t)base * 4096 + e : NLb + (size_t)base * 64 + (e - 4096);
            const float loc = *ptr;
            *ptr = val;
            if (e == 0) MIN[base] = m;
            const float bl = BL[base], ml = ML[base];
            const float mn = fmaxf(bl + m, ml);
            val = expf(bl + m - mn) * val + expf(ml - mn) * loc;
            m = mn;
        }
    }
}

__device__ __forceinline__ void phase_mlstm_out(const Params& P, int l, unsigned char* smem) {
    unsigned char* ws = P.ws; PIN_S(ws);
    const float* proj = (const float*)(ws + O_PROJ); const float* MQ = (const float*)(ws + O_MQ); const float* MKb = (const float*)(ws + O_MK);
    const float* IG = (const float*)(ws + O_IG); const float* LF = (const float*)(ws + O_LF);
    const float* CL = (const float*)(ws + O_CL); const float* NLb = (const float*)(ws + O_NL); const float* MIN = (const float*)(ws + O_MIN);
    bf16_t* GRP = (bf16_t*)(ws + O_GRP);
    const float* mln_g = P.in[20] + (size_t)l * MW;
    float* qs = (float*)smem; float* ks = qs + 128 * 64; float* vs = ks + 128 * 64;
    float* Cs = vs + 128 * 64;
    float* ns = Cs + 4096;
    float* bcv = ns + 64; float* gv = bcv + 128; float* pmx = gv + 128;
    const int tid = phase_tid();
    for (int u = blockIdx.x; u < NB * MH * NCH; u += gridDim.x) {
        const int tc = u % NCH, h = (u / NCH) % MH, b = u / (NCH * MH);
        const int tok0 = b * S + tc * CH;
        __syncthreads();
        for (int idx = tid; idx < 128 * 64; idx += NTHREADS) {
            const int i = idx >> 6, e = idx & 63; const size_t t = (size_t)(tok0 + i);
            qs[idx] = MQ[t * MW + h * 64 + e]; ks[idx] = MKb[t * MW + h * 64 + e]; vs[idx] = proj[t * PLD + C_MW + 2 * MW + h * 64 + e];
        }
        const int itok = tid >> 2, eg = (tid & 3) * 16;
        float hsum[16];
#pragma unroll
        for (int e = 0; e < 16; ++e) hsum[e] = 0.f;
        for (int d = 0; d < 2; ++d) {
            const int cd = d ? NCH - 1 - tc : tc;
            const int su = ((d * NB + b) * MH + h) * NCH + cd;
            __syncthreads();
            if (tid == 0) {
                float bc = 0.f, pm = -INFINITY;
                for (int j = 0; j < 128; ++j) {
                    const int i = d ? 127 - j : j; const size_t t = (size_t)(tok0 + i);
                    bc += LF[((size_t)d * T + t) * MH + h];
                    const float g = IG[((size_t)d * T + t) * MH + h] - bc;
                    pm = fmaxf(pm, g);
                    bcv[j] = bc; gv[j] = g; pmx[j] = pm;
                }
            }
            for (int idx = tid; idx < 4096; idx += NTHREADS) Cs[idx] = CL[(size_t)su * 4096 + idx];
            if (tid < 64) ns[tid] = NLb[(size_t)su * 64 + tid];
            const float mst = MIN[su];
            __syncthreads();
            const int j = d ? 127 - itok : itok;
            const float mx = fmaxf(pmx[j], mst), mt = bcv[j] + mx;
            float qrow[64];
#pragma unroll
            for (int k = 0; k < 64; ++k) qrow[k] = qs[itok * 64 + k];
            float acc[16]; float den = 0.f;
#pragma unroll
            for (int e = 0; e < 16; ++e) acc[e] = 0.f;
            for (int jj = 0; jj <= j; ++jj) {
                const int i2 = d ? 127 - jj : jj;
                float dot = 0.f;
#pragma unroll
                for (int k = 0; k < 64; ++k) dot += qrow[k] * ks[i2 * 64 + k];
                const float sw = dot * expf(gv[jj] - mx);
                den += sw;
#pragma unroll
                for (int e = 0; e < 16; ++e) acc[e] += sw * vs[i2 * 64 + eg + e];
            }
            const float wint = expf(mst - mx);
            float qn = 0.f; float qc[16];
#pragma unroll
            for (int e = 0; e < 16; ++e) qc[e] = 0.f;
#pragma unroll
            for (int k = 0; k < 64; ++k) {
                qn += qrow[k] * ns[k];
#pragma unroll
                for (int e = 0; e < 16; ++e) qc[e] += qrow[k] * Cs[k * 64 + eg + e];
            }
            den += wint * qn;
            const float dd = fmaxf(fabsf(den), expf(-mt));
#pragma unroll
            for (int e = 0; e < 16; ++e) hsum[e] += (acc[e] + wint * qc[e]) / dd;
        }
        float sm = 0.f;
#pragma unroll
        for (int e = 0; e < 16; ++e) sm += hsum[e];
        sm += __shfl_xor(sm, 1); sm += __shfl_xor(sm, 2);
        const float mean = sm * (1.0f / 64.0f); float q = 0.f;
#pragma unroll
        for (int e = 0; e < 16; ++e) { const float dlt = hsum[e] - mean; q += dlt * dlt; }
        q += __shfl_xor(q, 1); q += __shfl_xor(q, 2);
        const float rstd = 1.0f / sqrtf(q * (1.0f / 64.0f) + LN_EPS);
        const size_t t = (size_t)(tok0 + itok);
#pragma unroll
        for (int e = 0; e < 16; ++e) {
            const int c = h * 64 + eg + e;
            const float o = proj[t * PLD + C_MW + 3 * MW + c];
            GRP[t * D + GW + RW + c] = (bf16_t)f2bf(sigmoidf_(o) * ((hsum[e] - mean) * rstd * mln_g[c]));
        }
    }
    __syncthreads();
}

__device__ __forceinline__ void phase_rwkv_post(const Params& P, int l, unsigned char* smem) {
    unsigned char* ws = P.ws; PIN_S(ws);
    const float* SCAN = (const float*)(ws + O_SCAN); const float* VV = (const float*)(ws + O_VV); const float* GATE = (const float*)(ws + O_GATE);
    const float* BONUS = (const float*)(ws + O_BONUS); bf16_t* GRP = (bf16_t*)(ws + O_GRP);
    const float* rln_g = P.in[15] + (size_t)l * RW; const float* rln_b = P.in[16] + (size_t)l * RW;
    const int tid = phase_tid(), lane = tid & 63, wave = tid >> 6;
    const int gw = (int)blockIdx.x * NWAVES + wave, ngw = NWAVES * (int)gridDim.x;
    for (int it = gw; it < T * RH; it += ngw) {
        const int t = it / RH, h = it % RH, c = h * 64 + lane;
        const size_t o = (size_t)t * RW + c;
        const float x = SCAN[o] + SCAN[(size_t)T * RW + o];
        const float mean = wave_sum(x) * (1.0f / 64.0f);
        const float dl = x - mean;
        const float var = wave_sum(dl * dl) * (1.0f / 64.0f);
        float y = dl / sqrtf(var + GN_EPS) * rln_g[c] + rln_b[c];
        y += BONUS[(size_t)t * RH + h] * VV[o];
        GRP[(size_t)t * D + GW + c] = (bf16_t)f2bf(y * GATE[o]);
    }
}

__device__ __forceinline__ void phase_ln1_router(const Params& P, int l, unsigned char* smem) {
    unsigned char* ws = P.ws; PIN_S(ws);
    const float* xin = l == 0 ? P.in[0] : (const float*)(ws + O_XA);
    const float* MIX = (const float*)(ws + O_MIX); float* X1 = (float*)(ws + O_X1);
    int* TOPI = (int*)(ws + O_TOPI); float* TOPG = (float*)(ws + O_TOPG); int* RANK = (int*)(ws + O_RANK); bf16_t* X1B = (bf16_t*)(ws + O_X1B);
    unsigned* CNT = (unsigned*)ws + CW_CNT + 64 * l;
    const float* g1 = P.in[22] + (size_t)l * D; const float* b1 = P.in[23] + (size_t)l * D;
    const float* rw = P.in[24] + (size_t)l * D * NE; const float* rb = P.in[25] + (size_t)l * NE;
    const int tid = phase_tid(), lane = tid & 63, wave = tid >> 6;
    float* xrow = (float*)smem + wave * D;
    const int gw = (int)blockIdx.x * NWAVES + wave, ngw = NWAVES * (int)gridDim.x;
    for (int t = gw; t < T; t += ngw) {
        float v[16]; float sm = 0.f;
#pragma unroll
        for (int j = 0; j < 4; ++j) {
            const int c = j * 256 + lane * 4;
            const f32x4 a = *(const f32x4*)(xin + (size_t)t * D + c), m = *(const f32x4*)(MIX + (size_t)t * D + c);
            v[j * 4 + 0] = ALPHA * a.x + m.x; v[j * 4 + 1] = ALPHA * a.y + m.y; v[j * 4 + 2] = ALPHA * a.z + m.z; v[j * 4 + 3] = ALPHA * a.w + m.w;
            sm += (v[j * 4] + v[j * 4 + 1]) + (v[j * 4 + 2] + v[j * 4 + 3]);
        }
        const float mean = wave_sum(sm) * (1.0f / D); float q = 0.f;
#pragma unroll
        for (int j = 0; j < 16; ++j) { const float dl = v[j] - mean; q += dl * dl; }
        const float rstd = 1.0f / sqrtf(wave_sum(q) * (1.0f / D) + LN_EPS);
        WAVE_SYNC();
#pragma unroll
        for (int j = 0; j < 4; ++j) {
            const int c = j * 256 + lane * 4;
            f32x4 o;
            o.x = (v[j * 4 + 0] - mean) * rstd * g1[c + 0] + b1[c + 0]; o.y = (v[j * 4 + 1] - mean) * rstd * g1[c + 1] + b1[c + 1];
            o.z = (v[j * 4 + 2] - mean) * rstd * g1[c + 2] + b1[c + 2]; o.w = (v[j * 4 + 3] - mean) * rstd * g1[c + 3] + b1[c + 3];
            *(f32x4*)(X1 + (size_t)t * D + c) = o;
            *(f32x4*)(xrow + c) = o;
            u32x2 ob; ob.x = pk2(o.x, o.y); ob.y = pk2(o.z, o.w); *(u32x2*)(X1B + (size_t)t * D + c) = ob;
        }
        WAVE_SYNC();
        const int e = lane & 31, half = lane >> 5;
        float lg = 0.f;
        for (int c = half * 512; c < half * 512 + 512; ++c) lg += xrow[c] * rw[(size_t)c * NE + e];
        lg += __shfl_xor(lg, 32);
        lg += rb[e];
        float cur = lg; float tv[4]; int ti[4];
#pragma unroll
        for (int k = 0; k < 4; ++k) {
            float bv = cur; int bi = e;
#pragma unroll
            for (int o = 16; o >= 1; o >>= 1) {
                const float ov = __shfl_xor(bv, o); const int oi = __shfl_xor(bi, o);
                if (ov > bv || (ov == bv && oi < bi)) { bv = ov; bi = oi; }
            }
            tv[k] = bv; ti[k] = bi;
            if (e == bi) cur = -INFINITY;
        }
        const float e1 = expf(tv[1] - tv[0]), e2 = expf(tv[2] - tv[0]), e3 = expf(tv[3] - tv[0]);
        const float inv = 1.0f / (1.0f + e1 + e2 + e3);
        if (lane < 4) {
            const int myi = lane == 0 ? ti[0] : (lane == 1 ? ti[1] : (lane == 2 ? ti[2] : ti[3]));
            const float myg = (lane == 0 ? 1.0f : (lane == 1 ? e1 : (lane == 2 ? e2 : e3))) * inv;
            TOPI[(size_t)t * 4 + lane] = myi; TOPG[(size_t)t * 4 + lane] = myg;
            RANK[(size_t)t * 4 + lane] = (int)atomicAdd(CNT + myi, 1u);
        }
    }
}

__device__ __forceinline__ void moe_offsets(int* sh, const unsigned* CNT, int tid) {
    if (tid == 0) {
        int acc = 0;
        for (int e = 0; e < NE; ++e) { const int c = (int)CNT[e]; sh[e] = c; sh[32 + e] = acc; acc += (c + MOEB - 1) / MOEB * MOEB; sh[64 + e] = acc; }
    }
    __syncthreads();
}
__device__ __forceinline__ int moe_expert_of_row(const int* sh, int r) {
    int e = -1;
    for (int i = 0; i < NE; ++i) if (r >= sh[32 + i] && r < sh[64 + i]) e = i;
    return e;
}

__device__ __forceinline__ void phase_scatter(const Params& P, int l, unsigned char* smem) {
    unsigned char* ws = P.ws; PIN_S(ws);
    const int tid = phase_tid(), lane = tid & 63, wave = tid >> 6;
    const int* TOPI = (const int*)(ws + O_TOPI); const int* RANK = (const int*)(ws + O_RANK); int* SLOT = (int*)(ws + O_SLOT);
    const bf16_t* X1B = (const bf16_t*)(ws + O_X1B); bf16_t* XS = (bf16_t*)(ws + O_XS);
    const unsigned* CNT = (const unsigned*)ws + CW_CNT + 64 * l;
    int* sh = (int*)smem;
    moe_offsets(sh, CNT, tid);
    const int gw = (int)blockIdx.x * NWAVES + wave, ngw = NWAVES * (int)gridDim.x;
    for (int a = gw; a < T * 4; a += ngw) {
        const int e = TOPI[a], dest = sh[32 + e] + RANK[a], t = a >> 2;
        if (lane == 0) SLOT[a] = dest;
        const u32x4* src = (const u32x4*)(X1B + (size_t)t * D); u32x4* dst = (u32x4*)(XS + (size_t)dest * D);
        dst[lane] = src[lane]; dst[64 + lane] = src[64 + lane];
    }
    __syncthreads();
}

template <int WHICH>
__device__ __forceinline__ void phase_moe_gemm(const Params& P, int l, unsigned char* smem) {
    unsigned char* ws = P.ws; PIN_S(ws);
    const int tid = phase_tid();
    const unsigned* CNT = (const unsigned*)ws + CW_CNT + 64 * l;
    int* sh = (int*)(smem + 131072);
    int* rbe = sh + 96;
    moe_offsets(sh, CNT, tid);
    const int nrb = sh[64 + NE - 1] / MOEB;
    for (int rb = tid; rb < nrb; rb += NTHREADS) rbe[rb] = moe_expert_of_row(sh, rb * MOEB);
    __syncthreads();
    pg8::MoeOrder S;
    S.K = 1024; S.G = (int)gridDim.x; S.c = (int)blockIdx.x; S.rbe = rbe;
    if (WHICH == 1) {
        S.A = (const char*)(ws + O_XS); S.Wt = (const char*)(ws + O_W1) + (size_t)l * NE * 2 * DFF * D * 2; S.estride = (size_t)2 * DFF * D * 2; S.nN = 2 * DFF / 256; S.nwg = nrb * S.nN;
        pg8::EpiSwiglu E{(bf16_t*)(ws + O_ACT), P.in[27] + (size_t)l * NE * 2 * DFF};
        pg8::gemm_phase<pg8::EpiSwiglu, pg8::MoeOrder>((LAS unsigned char*)smem, 1024, S, E, tid);
    } else {
        S.A = (const char*)(ws + O_ACT); S.Wt = (const char*)(ws + O_W2) + (size_t)l * NE * D * DFF * 2; S.estride = (size_t)D * DFF * 2; S.nN = D / 256; S.nwg = nrb * S.nN;
        pg8::EpiBf16Bias E{(bf16_t*)(ws + O_YS), D, P.in[29] + (size_t)l * NE * D, D};
        pg8::gemm_phase<pg8::EpiBf16Bias, pg8::MoeOrder>((LAS unsigned char*)smem, 1024, S, E, tid);
    }
    __syncthreads();
}

__device__ __forceinline__ void phase_combine_ln2(const Params& P, int l, unsigned char* smem) {
    unsigned char* ws = P.ws; PIN_S(ws);
    const float* X1 = (const float*)(ws + O_X1); const bf16_t* YS = (const bf16_t*)(ws + O_YS); bf16_t* XB = (bf16_t*)(ws + O_XB);
    const int* SLOT = (const int*)(ws + O_SLOT); const float* TOPG = (const float*)(ws + O_TOPG);
    float* xo = l == NL - 1 ? P.out : (float*)(ws + O_XA);
    const float* g2 = P.in[30] + (size_t)l * D; const float* b2 = P.in[31] + (size_t)l * D;
    const int tid = phase_tid(), lane = tid & 63, wave = tid >> 6;
    const int gw = (int)blockIdx.x * NWAVES + wave, ngw = NWAVES * (int)gridDim.x;
    for (int t = gw; t < T; t += ngw) {
        int sl[4]; float gg[4];
#pragma unroll
        for (int k = 0; k < 4; ++k) { sl[k] = SLOT[(size_t)t * 4 + k]; gg[k] = TOPG[(size_t)t * 4 + k]; }
        float v[16]; float sm = 0.f;
#pragma unroll
        for (int j = 0; j < 4; ++j) {
            const int c = j * 256 + lane * 4;
            const f32x4 a = *(const f32x4*)(X1 + (size_t)t * D + c);
            f32x4 y = (f32x4){0.f, 0.f, 0.f, 0.f};
#pragma unroll
            for (int k = 0; k < 4; ++k) { const u32x2 yk = *(const u32x2*)(YS + (size_t)sl[k] * D + c);
                y.x += gg[k] * __builtin_bit_cast(float, yk.x << 16); y.y += gg[k] * __builtin_bit_cast(float, yk.x & 0xffff0000u); y.z += gg[k] * __builtin_bit_cast(float, yk.y << 16); y.w += gg[k] * __builtin_bit_cast(float, yk.y & 0xffff0000u); }
            v[j * 4 + 0] = ALPHA * a.x + y.x; v[j * 4 + 1] = ALPHA * a.y + y.y; v[j * 4 + 2] = ALPHA * a.z + y.z; v[j * 4 + 3] = ALPHA * a.w + y.w;
            sm += (v[j * 4] + v[j * 4 + 1]) + (v[j * 4 + 2] + v[j * 4 + 3]);
        }
        const float mean = wave_sum(sm) * (1.0f / D); float q = 0.f;
#pragma unroll
        for (int j = 0; j < 16; ++j) { const float dl = v[j] - mean; q += dl * dl; }
        const float rstd = 1.0f / sqrtf(wave_sum(q) * (1.0f / D) + LN_EPS);
#pragma unroll
        for (int j = 0; j < 4; ++j) {
            const int c = j * 256 + lane * 4;
            f32x4 o;
            o.x = (v[j * 4 + 0] - mean) * rstd * g2[c + 0] + b2[c + 0]; o.y = (v[j * 4 + 1] - mean) * rstd * g2[c + 1] + b2[c + 1];
            o.z = (v[j * 4 + 2] - mean) * rstd * g2[c + 2] + b2[c + 2]; o.w = (v[j * 4 + 3] - mean) * rstd * g2[c + 3] + b2[c + 3];
            *(f32x4*)(xo + (size_t)t * D + c) = o;
            if (l != NL - 1) { u32x2 ob; ob.x = pk2(o.x, o.y); ob.y = pk2(o.z, o.w); *(u32x2*)(XB + (size_t)t * D + c) = ob; }
        }
    }
}

__device__ __forceinline__ void phase_inproj(const Params& P, int l, unsigned char* smem) {
    unsigned char* ws = P.ws; PIN_S(ws);
    const int tid = phase_tid();
    pg8::DenseOrder S; S.init(ws + O_XB, (const bf16_t*)(ws + O_WIN) + (size_t)l * PLD * D, T, PLD, D, (int)gridDim.x, (int)blockIdx.x);
    pg8::EpiF32 E{(float*)(ws + O_PROJ), PLD};
    pg8::gemm_phase<pg8::EpiF32, pg8::DenseOrder>((LAS unsigned char*)smem, D, S, E, tid);
    __syncthreads();
}
__device__ __forceinline__ void phase_outproj(const Params& P, int l, unsigned char* smem) {
    unsigned char* ws = P.ws; PIN_S(ws);
    const int tid = phase_tid();
    pg8::DenseOrder S; S.init(ws + O_GRP, (const bf16_t*)(ws + O_WOUT) + (size_t)l * D * D, T, D, D, (int)gridDim.x, (int)blockIdx.x);
    pg8::EpiF32 E{(float*)(ws + O_MIX), D};
    pg8::gemm_phase<pg8::EpiF32, pg8::DenseOrder>((LAS unsigned char*)smem, D, S, E, tid);
    __syncthreads();
}

#ifndef EMU
#define XB_TMO      128
#define XB_XCNT(j)  (256  + 64 * (j))
#define XB_XSUB(j)  (1280 + 64 * (j))
#define XB_XGEN(j)  (2304 + 64 * (j))
#define XB_TOP      3328
#define XB_TOPGEN   3392
#define XCD_BAR_WORDS 3456
#define XB_SPIN_CAP (1u << 25)
__device__ __forceinline__ unsigned xb_ld(unsigned* p)              { return __hip_atomic_load(p, __ATOMIC_RELAXED, __HIP_MEMORY_SCOPE_AGENT); }
__device__ __forceinline__ unsigned xb_add(unsigned* p, unsigned v) { return __hip_atomic_fetch_add(p, v, __ATOMIC_RELAXED, __HIP_MEMORY_SCOPE_AGENT); }
__device__ __forceinline__ unsigned xb_xcc_id() { return (unsigned)__builtin_amdgcn_s_getreg((3 << 11) | 20) & 0xFu; }
#define XB_SPIN(cond, bar) do { unsigned _sp = 0; while (cond) { __builtin_amdgcn_s_sleep(1); \
    if ((++_sp & 255u) == 0u) { if (xb_ld(&(bar)[XB_TMO])) break; if (_sp > XB_SPIN_CAP) { atomicAdd(&(bar)[XB_TMO], 1u); break; } } } } while (0)
struct XcdBarrier { unsigned* bar; unsigned x; volatile LAS unsigned* st; };
__device__ __forceinline__ XcdBarrier xcd_barrier_post(unsigned* bar, volatile LAS unsigned* st) {
    XcdBarrier b; b.bar = bar; b.x = xb_xcc_id(); b.st = st;
    if (threadIdx.x == 0) (void)xb_add(&bar[XB_XCNT(b.x)], 1u);
    return b;
}
__device__ __forceinline__ void xcd_barrier_complete(unsigned* bar, unsigned x, unsigned& nloc, unsigned& nx) {
    const unsigned G = gridDim.x * gridDim.y * gridDim.z;
    unsigned sum, cnt, mine, sp = 0u;
    for (;;) {
        sum = 0u; cnt = 0u; mine = 0u;
#pragma unroll
        for (unsigned j = 0; j < 16; ++j) { const unsigned c = xb_ld(&bar[XB_XCNT(j)]); sum += c; cnt += (c > 0u) ? 1u : 0u; mine = (j == x) ? c : mine; }
        if (sum == G) break;
        __builtin_amdgcn_s_sleep(1);
        if ((++sp & 255u) == 0u) { if (xb_ld(&bar[XB_TMO])) break; if (sp > XB_SPIN_CAP) { atomicAdd(&bar[XB_TMO], 1u); break; } }
    }
    nloc = mine > 0u ? mine : 1u; nx = cnt > 0u ? cnt : 1u;
}
__device__ __forceinline__ void xcd_barrier(const XcdBarrier& b) {
    asm volatile("s_waitcnt vmcnt(0)" ::: "memory");
    __syncthreads();
    if (threadIdx.x == 0) {
        unsigned* bar = b.bar;
        __builtin_amdgcn_s_waitcnt(0);
        unsigned nloc = b.st[0], nx = b.st[1];
        if (nloc == 0u) { xcd_barrier_complete(bar, b.x, nloc, nx); b.st[0] = nloc; b.st[1] = nx; }
        const unsigned old = xb_add(&bar[XB_XSUB(b.x)], 1u);
        const unsigned gen = old / nloc;
        if (old + 1u == (gen + 1u) * nloc) {
            __builtin_amdgcn_fence(__ATOMIC_RELEASE, "agent");
            asm volatile("s_waitcnt vmcnt(0)" ::: "memory");
            const unsigned og = xb_add(&bar[XB_TOP], 1u);
            const unsigned tg = og / nx;
            if (og + 1u == (tg + 1u) * nx) xb_add(&bar[XB_TOPGEN], 1u);
            else XB_SPIN(xb_ld(&bar[XB_TOPGEN]) == tg, bar);
            __builtin_amdgcn_fence(__ATOMIC_ACQUIRE, "agent");
            xb_add(&bar[XB_XGEN(b.x)], 1u);
            asm volatile("s_waitcnt vmcnt(0)" ::: "memory");
        } else {
            XB_SPIN(xb_ld(&bar[XB_XGEN(b.x)]) == gen, bar);
            __builtin_amdgcn_fence(__ATOMIC_ACQUIRE, "agent");
            asm volatile("s_waitcnt vmcnt(0)" ::: "memory");
        }
    }
    __syncthreads();
}
#endif

__global__ void __launch_bounds__(512, 2) mk_fwd(Params P) {
#ifdef EMU
    unsigned char* smem = g_blk->lds;
#else
    extern __shared__ __attribute__((aligned(16))) unsigned char smem[];
    volatile LAS unsigned* bst = (volatile LAS unsigned*)(smem + LDS_BYTES - 16);
    if (threadIdx.x == 0) { bst[0] = 0u; bst[1] = 0u; bst[2] = 0u; bst[3] = 0u; }
    __syncthreads();
    XcdBarrier bar; bar.bar = (unsigned*)P.ws + CW_BAR; bar.x = 0; bar.st = bst;
    if (P.ph_hi - P.ph_lo > 1) bar = xcd_barrier_post((unsigned*)P.ws + CW_BAR, bst);
#endif
    const int lo = P.ph_lo, hi = P.ph_hi;
#ifdef EMU
#define SEAM(id) do {} while (0)
#else
#define SEAM(id) do { if ((id) + 1 < hi) xcd_barrier(bar); } while (0)
#endif
#ifndef MK_ONLY_PHASE
#define MK_ONLY_PHASE -1
#endif
#define PHG(kc, id, body) do { if (MK_ONLY_PHASE < 0 || MK_ONLY_PHASE == (kc)) { const int id_ = (id); if (id_ >= lo && id_ < hi) { body; SEAM(id_); } } } while (0)
#define PH(k, body) PHG(1 + (k), 1 + l * NPH + (k), body)
    PHG(0, 0, phase_prologue(P, smem));
    for (int l = 0; l < NL; ++l) {
        PH(0, phase_inproj(P, l, smem));
        PH(1, phase_prep(P, l, smem));
        PH(2, { phase_gmlp_mix(P, l, smem); phase_mlstm_local(P, l, smem); phase_rwkv_scan(P, l, smem); });
        PH(3, phase_mlstm_carry(P, l, smem));
        PH(4, { phase_mlstm_out(P, l, smem); phase_rwkv_post(P, l, smem); });
        PH(5, phase_outproj(P, l, smem));
        PH(6, phase_ln1_router(P, l, smem));
        PH(7, phase_scatter(P, l, smem));
        PH(8, phase_moe_gemm<1>(P, l, smem));
        PH(9, phase_moe_gemm<2>(P, l, smem));
        PH(10, phase_combine_ln2(P, l, smem));
    }
#undef PHG
#undef PH
#undef SEAM
}

}

#ifndef EMU
extern "C" void kernel_launch(void* const* d_in, const int* in_sizes, int n_in, void* d_out, int out_size, void* d_ws, size_t ws_size, hipStream_t stream) {
    using namespace mk;
    static int grid = 0;
    if (grid == 0) {
        if (n_in != 32 || out_size != T * D || ws_size < WS_END) { fprintf(stderr, "kernel_launch: unexpected shapes (n_in %d out %d ws %zu need %zu)\n", n_in, out_size, ws_size, (size_t)WS_END); grid = -1; return; }
        int dev = 0, cus = 0;
        if (hipGetDevice(&dev) != hipSuccess || hipDeviceGetAttribute(&cus, hipDeviceAttributeMultiprocessorCount, dev) != hipSuccess) { grid = -1; return; }
        if (hipFuncSetAttribute((const void*)mk_fwd, hipFuncAttributeMaxDynamicSharedMemorySize, LDS_BYTES) != hipSuccess) { fprintf(stderr, "kernel_launch: hipFuncSetAttribute failed\n"); grid = -1; return; }
        int per_cu = 0;
        (void)hipOccupancyMaxActiveBlocksPerMultiprocessor(&per_cu, (const void*)mk_fwd, NTHREADS, LDS_BYTES);
        (void)hipGetLastError();
        grid = cus;
    }
    if (grid < 0) return;
    (void)hipMemsetAsync(d_ws, 0, CTL_BYTES, stream);
    Params p{};
    for (int i = 0; i < 32; ++i) p.in[i] = (const float*)d_in[i];
    p.out = (float*)d_out; p.ws = (unsigned char*)d_ws;
#if MK_ONE_LAUNCH
    p.ph_lo = 0; p.ph_hi = 1 + NL * NPH;
    hipLaunchKernelGGL(mk_fwd, dim3(grid), dim3(NTHREADS), LDS_BYTES, stream, p);
#else
    for (int id = 0; id < 1 + NL * NPH; ++id) {
        p.ph_lo = id; p.ph_hi = id + 1;
        hipLaunchKernelGGL(mk_fwd, dim3(grid), dim3(NTHREADS), LDS_BYTES, stream, p);
    }
#endif
}
#endif
```

```cpp
#ifndef EMU
#include <hip/hip_runtime.h>
#endif
#include <cstdio>
#include <cstdint>
#include <cmath>

#ifndef CFG_BATCH
#define CFG_BATCH 4
#endif
#ifndef CFG_SEQ
#define CFG_SEQ 4096
#endif
#ifndef CFG_LAYERS
#define CFG_LAYERS 4
#endif
#ifndef MK_ONE_LAUNCH
#define MK_ONE_LAUNCH 1
#endif

namespace mk {
constexpr int NB = CFG_BATCH, S = CFG_SEQ, T = NB * S, NL = CFG_LAYERS, D = 1024;
constexpr int GW = 256, RW = 384, MW = 384, HD = 64, GH = 4, RH = 6, MH = 6, CH = 128, NCH = S / CH;
constexpr int PIN = 3480, PLD = 3584, RPROJ = 1408;
constexpr int C_RW = 512, C_MW = 1920;
constexpr int NE = 32, TOPK = 4, DFF = 1024, MOEB = 256;
constexpr int NROWS = (T * TOPK / MOEB + NE) * MOEB;
constexpr float LN_EPS = 1e-5f, GN_EPS = 64e-5f;
constexpr float ALPHA = 1.6817928305074290f;
constexpr int NTHREADS = 512, NWAVES = 8;
constexpr int LDS_BYTES = 160 * 1024;
constexpr int NPH = 11;

typedef float f32x4 __attribute__((ext_vector_type(4)));
typedef unsigned u32x4 __attribute__((ext_vector_type(4)));
typedef unsigned u32x2 __attribute__((ext_vector_type(2)));
typedef short bf16x8 __attribute__((ext_vector_type(8)));
typedef unsigned short bf16_t;

constexpr size_t al(size_t x) { return (x + 255) & ~(size_t)255; }
constexpr size_t CTL_BYTES = 1u << 20;
constexpr size_t O_XA = CTL_BYTES;
constexpr size_t O_XB = O_XA + al((size_t)T * D * 4);
constexpr size_t O_X1 = O_XB + al((size_t)T * D * 2);
constexpr size_t O_X1B = O_X1 + al((size_t)T * D * 4);
constexpr size_t O_PROJ = O_X1B + al((size_t)T * D * 2);
constexpr size_t O_MIX = O_PROJ + al((size_t)T * PLD * 4);
constexpr size_t O_GRP = O_MIX + al((size_t)T * D * 4);
constexpr size_t O_UG = O_GRP + al((size_t)T * D * 2);
constexpr size_t O_VN = O_UG + al((size_t)T * GW * 4);
constexpr size_t O_RR = O_VN + al((size_t)T * GW * 4);
constexpr size_t O_VV = O_RR + al((size_t)T * RW * 4);
constexpr size_t O_KK = O_VV + al((size_t)T * RW * 4);
constexpr size_t O_DEC = O_KK + al((size_t)T * RW * 4);
constexpr size_t O_KD = O_DEC + al((size_t)2 * T * RW * 4);
constexpr size_t O_ICLR = O_KD + al((size_t)2 * T * RW * 4);
constexpr size_t O_GATE = O_ICLR + al((size_t)2 * T * RW * 4);
constexpr size_t O_BONUS = O_GATE + al((size_t)T * RW * 4);
constexpr size_t O_SCAN = O_BONUS + al((size_t)T * RH * 4);
constexpr size_t O_MQ = O_SCAN + al((size_t)2 * T * RW * 4);
constexpr size_t O_MK = O_MQ + al((size_t)T * MW * 4);
constexpr size_t O_IG = O_MK + al((size_t)T * MW * 4);
constexpr size_t O_LF = O_IG + al((size_t)2 * T * MH * 4);
constexpr size_t O_CL = O_LF + al((size_t)2 * T * MH * 4);
constexpr size_t O_NL = O_CL + al((size_t)2 * NB * MH * NCH * 4096 * 4);
constexpr size_t O_ML = O_NL + al((size_t)2 * NB * MH * NCH * 64 * 4);
constexpr size_t O_BL = O_ML + al((size_t)2 * NB * MH * NCH * 4);
constexpr size_t O_MIN = O_BL + al((size_t)2 * NB * MH * NCH * 4);
constexpr size_t O_TOPI = O_MIN + al((size_t)2 * NB * MH * NCH * 4);
constexpr size_t O_TOPG = O_TOPI + al((size_t)T * 4 * 4);
constexpr size_t O_RANK = O_TOPG + al((size_t)T * 4 * 4);
constexpr size_t O_SLOT = O_RANK + al((size_t)T * 4 * 4);
constexpr size_t O_BRKR = O_SLOT + al((size_t)T * 4 * 4);
constexpr size_t O_BCNT = O_BRKR + al((size_t)2 * T * RH * 2 * 4);
constexpr size_t O_CNTF = O_BCNT + al((size_t)(T / 64) * NE * 4);
constexpr size_t O_XS = O_CNTF + al((size_t)NE * 4);
constexpr size_t O_ACT = O_XS + al((size_t)NROWS * D * 2);
constexpr size_t O_YS = O_ACT + al((size_t)NROWS * DFF * 2);
constexpr size_t O_WIN = O_YS + al((size_t)NROWS * D * 2);
constexpr size_t O_WOUT = O_WIN + al((size_t)NL * PLD * D * 2);
constexpr size_t O_W1 = O_WOUT + al((size_t)NL * D * D * 2);
constexpr size_t O_W2 = O_W1 + al((size_t)NL * NE * 2 * DFF * D * 2);
constexpr size_t WS_END = O_W2 + al((size_t)NL * NE * D * DFF * 2);

constexpr int CW_BAR = 4096;
constexpr int CW_CNT = 16384;

struct Params { const float* in[32]; float* out; unsigned char* ws; int ph_lo, ph_hi; };
#ifdef EMU
typedef const Params* ParamsPtr;
#define PARAMS_PTR(P) (&(P))
#else
typedef const __attribute__((address_space(4))) Params* ParamsPtr;
#define PARAMS_PTR(P) ((ParamsPtr)__builtin_amdgcn_kernarg_segment_ptr())
#endif

#ifdef EMU
#define WAVE_SYNC() emu_wave_barrier()
#define PIN_V(x) do {} while (0)
#define PIN_S(x) do {} while (0)
#else
#define WAVE_SYNC() __builtin_amdgcn_wave_barrier()
#define PIN_V(x) asm volatile("" : "+v"(x))
#define PIN_S(x) asm volatile("" : "+s"(x))
#endif
#ifdef EMU
__device__ __forceinline__ int phase_tid(int wv) { (void)wv; return threadIdx.x; }
#else
__device__ __forceinline__ int phase_tid(int wv) { int t; asm volatile("v_mbcnt_lo_u32_b32 %0, -1, 0\n\tv_mbcnt_hi_u32_b32 %0, -1, %0" : "=v"(t)); return (wv << 6) + t; }
#endif

#ifdef EMU
#define SHX(v, m, lane) __shfl_xor(v, m)
#else
__device__ __forceinline__ float shx_(float v, int m, int lane) { return __builtin_bit_cast(float, __builtin_amdgcn_ds_bpermute((lane ^ m) << 2, __builtin_bit_cast(int, v))); }
__device__ __forceinline__ int shx_(int v, int m, int lane) { return __builtin_amdgcn_ds_bpermute((lane ^ m) << 2, v); }
#define SHX(v, m, lane) shx_(v, m, lane)
#endif
__device__ __forceinline__ float wave_sum(float v, int lane) {
#pragma unroll
    for (int o = 32; o >= 1; o >>= 1) v += SHX(v, o, lane);
    return v;
}
__device__ __forceinline__ float sigmoidf_(float x) { return 1.0f / (1.0f + expf(-x)); }
__device__ __forceinline__ float softplusf_(float x) { return fmaxf(x, 0.f) + log1pf(expf(-fabsf(x))); }
__device__ __forceinline__ float geluf_(float x) { return 0.5f * x * (1.0f + erff(x * 0.70710678118654752f)); }

#ifdef EMU
#define LAS
#define WAIT_V(n) do {} while (0)
#define WAIT_L(n) do {} while (0)
#define S_BARRIER() __syncthreads()
#define SETPRIO(x) do {} while (0)
#define SCHED_BAR() do {} while (0)
#define RFL(x) (x)
static inline void emu_glds16(const void* g, void* l) { memcpy((char*)l + (g_blk->cur & 63) * 16, g, 16); }
#define GLDS16(gptr, ldsptr) emu_glds16((const void*)(gptr), (void*)(ldsptr))
static inline float emu_bf2f(unsigned short b) { unsigned u = (unsigned)b << 16; float f; memcpy(&f, &u, 4); return f; }
static inline f32x4 emu_mfma16(bf16x8 a, bf16x8 b, f32x4 c) {
    EmuBlock* blk = g_blk; const int cur = blk->cur, lane = cur & 63, wbase = cur & ~63;
    static thread_local unsigned short Ash[32][64][8], Bsh[32][64][8];
    const int w = cur >> 6;
    for (int j = 0; j < 8; ++j) { Ash[w][lane][j] = (unsigned short)a[j]; Bsh[w][lane][j] = (unsigned short)b[j]; }
    emu_wave_barrier();
    const int col = lane & 15;
    for (int r = 0; r < 4; ++r) { const int row = 4 * (lane >> 4) + r; float sum = c[r];
        for (int k = 0; k < 32; ++k) sum += emu_bf2f(Ash[w][row + 16 * (k >> 3)][k & 7]) * emu_bf2f(Bsh[w][col + 16 * (k >> 3)][k & 7]);
        c[r] = sum; }
    emu_wave_barrier(); (void)wbase;
    return c;
}
#define MFMA16(a, b, c) emu_mfma16(a, b, c)
#else
#define LAS __attribute__((address_space(3)))
#define WAIT_V(n) asm volatile("s_waitcnt vmcnt(" #n ")" ::: "memory")
#define WAIT_L(n) asm volatile("s_waitcnt lgkmcnt(" #n ")" ::: "memory")
#define S_BARRIER() __builtin_amdgcn_s_barrier()
#define SETPRIO(x) __builtin_amdgcn_s_setprio(x)
#define SCHED_BAR() __builtin_amdgcn_sched_barrier(0)
#define RFL(x) __builtin_amdgcn_readfirstlane(x)
#define GLDS16(gptr, ldsptr) __builtin_amdgcn_global_load_lds((const unsigned*)(gptr), (LAS unsigned*)(ldsptr), 16, 0, 0)
#define MFMA16(a, b, c) __builtin_amdgcn_mfma_f32_16x16x32_bf16(a, b, c, 0, 0, 0)
#endif

__device__ __forceinline__ unsigned f2bf(float f) { unsigned u = __builtin_bit_cast(unsigned, f); return (u + 0x7fffu + ((u >> 16) & 1u)) >> 16; }
__device__ __forceinline__ unsigned pk2(float lo, float hi) { return f2bf(lo) | (f2bf(hi) << 16); }

namespace pg8 {
constexpr int BM = 256, BK = 64, HALF = 128, HTB = HALF * BK * 2, STAGE_BYTES = 8 * HTB, NXCD = 8, WGM = 8;
__host__ __device__ __forceinline__ int lds_byte(int r, int c) { const int st = (r >> 4) * 2 + (c >> 5), rr = r & 15, cc = c & 31, ob = rr * 64 + cc * 2; return st * 1024 + (ob ^ (((ob >> 9) & 1) << 5)); }
__host__ __device__ __forceinline__ void stage_rc(int b, int& R, int& C) { const int st = b / 1024, sb = b % 1024, swz = sb ^ (((sb >> 9) & 1) << 5); R = (st >> 1) * 16 + swz / 64; C = (st & 1) * 32 + (swz % 64) / 2; }
__host__ __device__ __forceinline__ int perm32(int rho) { const int n = rho >> 4, i = rho & 15; return 8 * (i >> 2) + 4 * n + (i & 3); }
struct Unit { int pm, pn, e; };

struct DenseOrder {
    const char* A; const char* Bt; int K; int nM, nN, nwg, G, c;
    __device__ __forceinline__ void init(const void* A_, const void* Bt_, int M, int N, int K_, int G_, int c_) { A = (const char*)A_; Bt = (const char*)Bt_; K = K_; nM = M / BM; nN = N / BM; nwg = nM * nN; G = G_; c = c_; }
    __device__ __forceinline__ bool next(int i, Unit& u) const {
        const long L = (long)i * G + c; if (L >= nwg) return false;
        int wgid = (int)L; { const int q = nwg / NXCD, r = nwg % NXCD, xcd = wgid % NXCD, off = wgid / NXCD; wgid = (xcd < r ? xcd * (q + 1) : r * (q + 1) + (xcd - r) * q) + off; }
        const int nig = WGM * nN, gid = wgid / nig, fm = gid * WGM, gsz = (nM - fm) < WGM ? (nM - fm) : WGM;
        u.pm = fm + ((wgid % nig) % gsz); u.pn = (wgid % nig) / gsz; u.e = 0; return true;
    }
    __device__ __forceinline__ const char* abase(const Unit& u) const { return A + (size_t)u.pm * BM * K * 2; }
    __device__ __forceinline__ const char* bbase(const Unit& u) const { return Bt + (size_t)u.pn * BM * K * 2; }
};
struct MoeOrder {
    const char* A; const char* Wt; int K; int nN, nwg, G, c; size_t estride; const int* rbe;
    __device__ __forceinline__ bool next(int i, Unit& u) const {
        const long L = (long)i * G + c; if (L >= nwg) return false;
        u.pm = (int)(L / nN); u.pn = (int)(L % nN); u.e = rbe[u.pm]; return true;
    }
    __device__ __forceinline__ const char* abase(const Unit& u) const { return A + (size_t)u.pm * BM * K * 2; }
    __device__ __forceinline__ const char* bbase(const Unit& u) const { return Wt + (size_t)u.e * estride + (size_t)u.pn * BM * K * 2; }
};

struct EpiF32 {
    static constexpr bool PERM = false;
    float* C; int ldc;
    __device__ __forceinline__ void operator()(const f32x4 (&acc)[2][2][4][2], const Unit& u, int wr, int wc, int fr, int fq) const {
        const int row0 = u.pm * BM + wr * 64 + fr, col0 = u.pn * BM + wc * 32 + 4 * fq;
#pragma unroll
        for (int ai = 0; ai < 2; ++ai)
#pragma unroll
            for (int m = 0; m < 4; ++m) { float* rowp = C + (size_t)(row0 + ai * HALF + m * 16) * ldc + col0;
#pragma unroll
                for (int bj = 0; bj < 2; ++bj)
#pragma unroll
                    for (int n = 0; n < 2; ++n) *(f32x4*)(rowp + bj * HALF + n * 16) = acc[ai][bj][m][n]; }
    }
};
struct EpiBf16Bias {
    static constexpr bool PERM = true;
    bf16_t* O; int ldc; const float* bias; int bias_estride;
    __device__ __forceinline__ void operator()(const f32x4 (&acc)[2][2][4][2], const Unit& u, int wr, int wc, int fr, int fq) const {
        const int row0 = u.pm * BM + wr * 64 + fr, col0 = u.pn * BM + wc * 32 + 8 * fq;
        const float* bp = bias + (size_t)u.e * bias_estride + col0;
        f32x4 bv[2][2];
#pragma unroll
        for (int bj = 0; bj < 2; ++bj)
#pragma unroll
            for (int n = 0; n < 2; ++n) bv[bj][n] = *(const f32x4*)(bp + bj * HALF + 4 * n);
#pragma unroll
        for (int ai = 0; ai < 2; ++ai)
#pragma unroll
            for (int m = 0; m < 4; ++m) { bf16_t* rowp = O + (size_t)(row0 + ai * HALF + m * 16) * ldc + col0;
#pragma unroll
                for (int bj = 0; bj < 2; ++bj) { const f32x4 v0 = acc[ai][bj][m][0] + bv[bj][0], v1 = acc[ai][bj][m][1] + bv[bj][1];
                    u32x4 w; w.x = pk2(v0[0], v0[1]); w.y = pk2(v0[2], v0[3]); w.z = pk2(v1[0], v1[1]); w.w = pk2(v1[2], v1[3]);
                    *(u32x4*)(rowp + bj * HALF) = w; } }
    }
};
__device__ __forceinline__ float swiglu1(float g, float uu) { g = fminf(g, 7.0f); uu = fminf(fmaxf(uu, -7.0f), 7.0f); return (uu + 1.0f) * (g / (1.0f + expf(-1.702f * g))); }
struct EpiSwiglu {
    static constexpr bool PERM = true;
    bf16_t* O; const float* b1;
    __device__ __forceinline__ void operator()(const f32x4 (&acc)[2][2][4][2], const Unit& u, int wr, int wc, int fr, int fq) const {
        const int row0 = u.pm * BM + wr * 64 + fr, j0 = u.pn * HALF + wc * 32 + 8 * fq;
        const float* bg = b1 + (size_t)u.e * 2 * DFF + j0; const float* bu = bg + DFF;
        f32x4 g4[2], u4[2];
#pragma unroll
        for (int n = 0; n < 2; ++n) { g4[n] = *(const f32x4*)(bg + 4 * n); u4[n] = *(const f32x4*)(bu + 4 * n); }
#pragma unroll
        for (int ai = 0; ai < 2; ++ai)
#pragma unroll
            for (int m = 0; m < 4; ++m) {
                float o[8];
#pragma unroll
                for (int n = 0; n < 2; ++n)
#pragma unroll
                    for (int q = 0; q < 4; ++q) o[n * 4 + q] = swiglu1(acc[ai][0][m][n][q] + g4[n][q], acc[ai][1][m][n][q] + u4[n][q]);
                u32x4 w; w.x = pk2(o[0], o[1]); w.y = pk2(o[2], o[3]); w.z = pk2(o[4], o[5]); w.w = pk2(o[6], o[7]);
                *(u32x4*)(O + (size_t)(row0 + ai * HALF + m * 16) * DFF + j0) = w;
            }
    }
};

template <class Epi, class Sched>
__device__ __forceinline__ void gemm_phase(LAS unsigned char* lds, const int K, const Sched& S, const Epi& E, const int tid) {
    const int wid = RFL(tid >> 6), lane = tid & 63, wr = wid >> 2, wc = wid & 3, fr = lane & 15, fq = lane >> 4;
    const int nt = K / BK;
    unsigned voffA[2], voffB[2];
#pragma unroll
    for (int i = 0; i < 2; ++i) { int R, C; stage_rc(tid * 16 + i * 8192, R, C); const int Rb = Epi::PERM ? ((R & ~31) + perm32(R & 31)) : R;
        voffA[i] = (unsigned)(R * K + C) * 2u; voffB[i] = (unsigned)(Rb * K + C) * 2u; }
    const size_t kstep = (size_t)(BK * 2);
    const size_t hstep = (size_t)HALF * K * 2;
    const unsigned ldsw = (unsigned)wid * 1024u;
    const int aoff = lds_byte(wr * 64 + fr, fq * 8), boff = lds_byte(wc * 32 + fr, fq * 8);
#define PG8_SA(b, h) (((b) * 2 + (h)) * HTB)
#define PG8_SB(b, h) ((4 + (b) * 2 + (h)) * HTB)
#define PG8_STAGE(bufoff, gbase, voff) do { _Pragma("unroll") for (int _i = 0; _i < 2; ++_i) \
        GLDS16((const char*)(gbase) + (voff)[_i], lds + (bufoff) + ldsw + _i * 8192); } while (0)
#define PG8_LDA(dst, b, h) do { _Pragma("unroll") for (int m = 0; m < 4; ++m) _Pragma("unroll") for (int k = 0; k < 2; ++k) dst[m][k] = *(const LAS bf16x8*)(lds + PG8_SA(b, h) + aoff + m * 2048 + k * 1024); } while (0)
#define PG8_LDB(dst, b, h) do { _Pragma("unroll") for (int n = 0; n < 2; ++n) _Pragma("unroll") for (int k = 0; k < 2; ++k) dst[n][k] = *(const LAS bf16x8*)(lds + PG8_SB(b, h) + boff + n * 2048 + k * 1024); } while (0)
#define PG8_MMA(ai, bj, At, Bt) do { SETPRIO(1); _Pragma("unroll") for (int m = 0; m < 4; ++m) _Pragma("unroll") for (int n = 0; n < 2; ++n) _Pragma("unroll") for (int k = 0; k < 2; ++k) \
        acc[ai][bj][m][n] = MFMA16(Bt[n][k], At[m][k], acc[ai][bj][m][n]); SETPRIO(0); } while (0)
    Unit cur, nxt; int ui = 0;
    if (!S.next(0, cur)) return;
    f32x4 acc[2][2][4][2];
#pragma unroll
    for (int a = 0; a < 2; ++a)
#pragma unroll
        for (int b = 0; b < 2; ++b)
#pragma unroll
            for (int m = 0; m < 4; ++m)
#pragma unroll
                for (int n = 0; n < 2; ++n) acc[a][b][m][n] = (f32x4){0.f, 0.f, 0.f, 0.f};
    bf16x8 At[4][2], B0[2][2], B1[2][2];
    const char* cA = S.abase(cur); const char* cB = S.bbase(cur);
    PG8_STAGE(PG8_SB(0, 0), cB, voffB); PG8_STAGE(PG8_SA(0, 0), cA, voffA); PG8_STAGE(PG8_SB(0, 1), cB + hstep, voffB); PG8_STAGE(PG8_SA(0, 1), cA + hstep, voffA);
    if (wr == 1) S_BARRIER();
    WAIT_V(4); S_BARRIER();
    PG8_STAGE(PG8_SB(1, 0), cB + kstep, voffB); PG8_STAGE(PG8_SA(1, 0), cA + kstep, voffA); PG8_STAGE(PG8_SB(1, 1), cB + hstep + kstep, voffB);
    WAIT_V(6); S_BARRIER();
    for (;;) {
        const bool has_next = S.next(ui + 1, nxt);
        const char* nA = has_next ? S.abase(nxt) : cA; const char* nB = has_next ? S.bbase(nxt) : cB;
        for (int t = 0; t < nt; t += 2) {
            const bool last = (t == nt - 2);
            const char* a1 = cA + (size_t)(t + 1) * kstep;
            const char* a2 = last ? nA : cA + (size_t)(t + 2) * kstep; const char* b2 = last ? nB : cB + (size_t)(t + 2) * kstep;
            const char* a3 = a2 + kstep; const char* b3 = b2 + kstep;
            PG8_LDB(B0, 0, 0); SCHED_BAR(); PG8_LDA(At, 0, 0); PG8_STAGE(PG8_SA(1, 1), a1 + hstep, voffA);
            WAIT_L(8); S_BARRIER(); WAIT_L(0); PG8_MMA(0, 0, At, B0); S_BARRIER(); SCHED_BAR();
            PG8_LDB(B1, 0, 1); PG8_STAGE(PG8_SB(0, 0), b2, voffB);
            S_BARRIER(); WAIT_L(0); PG8_MMA(0, 1, At, B1); S_BARRIER();
            PG8_LDA(At, 0, 1); PG8_STAGE(PG8_SA(0, 0), a2, voffA);
            S_BARRIER(); WAIT_L(0); PG8_MMA(1, 0, At, B0); S_BARRIER(); SCHED_BAR();
            PG8_STAGE(PG8_SB(0, 1), b2 + hstep, voffB);
            WAIT_V(6); S_BARRIER(); PG8_MMA(1, 1, At, B1); S_BARRIER();
            PG8_LDB(B0, 1, 0); SCHED_BAR(); PG8_LDA(At, 1, 0); PG8_STAGE(PG8_SA(0, 1), a2 + hstep, voffA);
            WAIT_L(8); S_BARRIER(); WAIT_L(0); PG8_MMA(0, 0, At, B0); S_BARRIER(); SCHED_BAR();
            PG8_LDB(B1, 1, 1); PG8_STAGE(PG8_SB(1, 0), b3, voffB);
            S_BARRIER(); WAIT_L(0); PG8_MMA(0, 1, At, B1); S_BARRIER();
            PG8_LDA(At, 1, 1); PG8_STAGE(PG8_SA(1, 0), a3, voffA);
            S_BARRIER(); WAIT_L(0); PG8_MMA(1, 0, At, B0); S_BARRIER(); SCHED_BAR();
            PG8_STAGE(PG8_SB(1, 1), b3 + hstep, voffB);
            WAIT_V(6); S_BARRIER(); PG8_MMA(1, 1, At, B1); S_BARRIER();
        }
        E(acc, cur, wr, wc, fr, fq);
        if (!has_next) break;
#pragma unroll
        for (int a = 0; a < 2; ++a)
#pragma unroll
            for (int b = 0; b < 2; ++b)
#pragma unroll
                for (int m = 0; m < 4; ++m)
#pragma unroll
                    for (int n = 0; n < 2; ++n) acc[a][b][m][n] = (f32x4){0.f, 0.f, 0.f, 0.f};
        cur = nxt; cA = nA; cB = nB; ++ui;
    }
    WAIT_V(0);
    if (wr == 0) S_BARRIER();
    S_BARRIER();
#undef PG8_SA
#undef PG8_SB
#undef PG8_STAGE
#undef PG8_LDA
#undef PG8_LDB
#undef PG8_MMA
}
}

__device__ __forceinline__ void transpose_item(const float* W, int K, int N, bf16_t* WT, int k0, int n0, int dst_row0, float* scr, int lane) {
#pragma unroll 8
    for (int i = 0; i < 32; ++i) { const int kk = 2 * i + (lane >> 5), n = n0 + (lane & 31); scr[kk * 33 + (lane & 31)] = n < N ? W[(size_t)(k0 + kk) * N + n] : 0.f; }
    WAVE_SYNC();
    const int c = lane & 7;
#pragma unroll
    for (int j = 0; j < 4; ++j) { const int n = (lane >> 3) + 8 * j; const float* sp = scr + (8 * c) * 33 + n;
        u32x4 o; o.x = pk2(sp[0 * 33], sp[1 * 33]); o.y = pk2(sp[2 * 33], sp[3 * 33]); o.z = pk2(sp[4 * 33], sp[5 * 33]); o.w = pk2(sp[6 * 33], sp[7 * 33]);
        *(u32x4*)(WT + (size_t)(dst_row0 + n) * K + k0 + 8 * c) = o; }
    WAVE_SYNC();
}
__device__ __forceinline__ void phase_prologue(const Params& P, unsigned char* smem, int wv) {
    ParamsPtr pp = PARAMS_PTR(P); PIN_S(pp); unsigned char* ws = pp->ws; int bidx = (int)blockIdx.x, gdim = (int)gridDim.x; PIN_S(bidx); PIN_S(gdim);
    const int tid = phase_tid(wv), lane = tid & 63, wave = tid >> 6;
    float* scr = (float*)smem + wave * (64 * 33);
    const int gw = bidx * NWAVES + wave, ngw = NWAVES * gdim;
    constexpr int I_IN = 16 * (PLD / 32), I_OUT = 16 * 32, I_W1 = NE * 16 * 64, I_W2 = NE * 16 * 32, I_L = I_IN + I_OUT + I_W1 + I_W2;
    for (int it = gw; it < NL * I_L; it += ngw) {
        const int l = it / I_L; int r = it % I_L;
        if (r < I_IN) { const int kb = r / (PLD / 32), nb = r % (PLD / 32);
            transpose_item(pp->in[1] + (size_t)l * D * PIN, D, PIN, (bf16_t*)(ws + O_WIN) + (size_t)l * PLD * D, kb * 64, nb * 32, nb * 32, scr, lane); continue; }
        r -= I_IN;
        if (r < I_OUT) { const int kb = r / 32, nb = r % 32;
            transpose_item(pp->in[21] + (size_t)l * D * D, D, D, (bf16_t*)(ws + O_WOUT) + (size_t)l * D * D, kb * 64, nb * 32, nb * 32, scr, lane); continue; }
        r -= I_OUT;
        if (r < I_W1) { const int e = r / (16 * 64), q = r % (16 * 64), kb = q / 64, nb = q % 64, n0 = nb * 32;
            const int dst = n0 < DFF ? (n0 / 128) * 256 + (n0 % 128) : ((n0 - DFF) / 128) * 256 + 128 + ((n0 - DFF) % 128);
            transpose_item(pp->in[26] + ((size_t)l * NE + e) * D * 2 * DFF, D, 2 * DFF, (bf16_t*)(ws + O_W1) + ((size_t)l * NE + e) * 2 * DFF * D, kb * 64, n0, dst, scr, lane); continue; }
        r -= I_W1;
        { const int e = r / (16 * 32), q = r % (16 * 32), kb = q / 32, nb = q % 32;
            transpose_item(pp->in[28] + ((size_t)l * NE + e) * DFF * D, DFF, D, (bf16_t*)(ws + O_W2) + ((size_t)l * NE + e) * D * DFF, kb * 64, nb * 32, nb * 32, scr, lane); }
    }
    const float* x = pp->in[0]; bf16_t* XB = (bf16_t*)(ws + O_XB);
    for (size_t i = ((size_t)bidx * NTHREADS + tid) * 4; i < (size_t)T * D; i += (size_t)gdim * NTHREADS * 4) {
        const f32x4 v = *(const f32x4*)(x + i); u32x2 o; o.x = pk2(v.x, v.y); o.y = pk2(v.z, v.w); *(u32x2*)(XB + i) = o;
    }
}

__device__ __forceinline__ float tshift(const float* P, int t, int s, int col, const float* mu0, const float* mu1, int rc) {
    const float cur = P[(size_t)t * PLD + col];
    const float prv = s > 0 ? P[(size_t)(t - 1) * PLD + col] : 0.f;
    const float nxt = s < S - 1 ? P[(size_t)(t + 1) * PLD + col] : 0.f;
    return cur + mu0[rc] * (prv - cur) + mu1[rc] * (nxt - cur);
}

__device__ __forceinline__ void phase_prep(const Params& P, int l, unsigned char* smem, int wv) {
    ParamsPtr pp = PARAMS_PTR(P); PIN_S(pp); unsigned char* ws = pp->ws; int bidx = (int)blockIdx.x, gdim = (int)gridDim.x; PIN_S(bidx); PIN_S(gdim);
    const float* proj = (const float*)(ws + O_PROJ);
    float* UG = (float*)(ws + O_UG); float* VN = (float*)(ws + O_VN);
    float* RR = (float*)(ws + O_RR); float* VV = (float*)(ws + O_VV); float* KK = (float*)(ws + O_KK);
    float* DEC = (float*)(ws + O_DEC); float* KD = (float*)(ws + O_KD); float* ICLR = (float*)(ws + O_ICLR);
    float* GATE = (float*)(ws + O_GATE); float* BONUS = (float*)(ws + O_BONUS); float* BRKR = (float*)(ws + O_BRKR);
    float* MQ = (float*)(ws + O_MQ); float* MKb = (float*)(ws + O_MK); float* IG = (float*)(ws + O_IG); float* LF = (float*)(ws + O_LF);
    const float* gln_g = pp->in[2] + (size_t)l * GW; const float* gln_b = pp->in[3] + (size_t)l * GW;
    const float* mu0 = pp->in[6] + (size_t)l * 2 * RPROJ; const float* mu1 = mu0 + RPROJ;
    const float* w0 = pp->in[7] + (size_t)l * 2 * RW; const float* w2 = pp->in[8] + (size_t)l * 2 * 64 * RW;
    const float* a0 = pp->in[9] + (size_t)l * 2 * RW; const float* a2 = pp->in[10] + (size_t)l * 2 * 64 * RW;
    const float* g2 = pp->in[11] + (size_t)l * 128 * RW;
    const float* k_k = pp->in[12] + (size_t)l * RW; const float* k_a = pp->in[13] + (size_t)l * RW; const float* r_k = pp->in[14] + (size_t)l * RW;
    const float* conv_w = pp->in[17] + (size_t)l * 3 * 768; const float* conv_b = pp->in[18] + (size_t)l * 768; const float* gate_b = pp->in[19] + (size_t)l * 24;
    float* lora = (float*)smem;
    const int tid = phase_tid(wv), lane = tid & 63, wave = tid >> 6;
    for (int u = bidx; u < T / 16; u += gdim) {
        const int t0 = u * 16, s0 = t0 % S;
        {
            const int i = tid >> 5, l32 = tid & 31, t = t0 + i;
            float v[8]; float sum = 0.f;
#pragma unroll
            for (int j = 0; j < 8; ++j) {
                const int c = j * 32 + l32;
                UG[(size_t)t * GW + c] = geluf_(proj[(size_t)t * PLD + c]);
                v[j] = geluf_(proj[(size_t)t * PLD + GW + c]); sum += v[j];
            }
#pragma unroll
            for (int o = 16; o >= 1; o >>= 1) sum += SHX(sum, o, lane);
            const float mean = sum * (1.0f / GW); float q = 0.f;
#pragma unroll
            for (int j = 0; j < 8; ++j) { const float d = v[j] - mean; q += d * d; }
#pragma unroll
            for (int o = 16; o >= 1; o >>= 1) q += SHX(q, o, lane);
            const float rstd = 1.0f / sqrtf(q * (1.0f / GW) + LN_EPS);
#pragma unroll
            for (int j = 0; j < 8; ++j) { const int c = j * 32 + l32; VN[(size_t)t * GW + c] = (v[j] - mean) * rstd * gln_g[c] + gln_b[c]; }
        }
        __syncthreads();
        for (int idx = tid; idx < 16 * 256; idx += NTHREADS) {
            const int i = idx >> 8, j = idx & 255, rc = 1152 + j;
            const float x = tshift(proj, t0 + i, s0 + i, C_RW + rc, mu0, mu1, rc);
            lora[idx] = j < 64 ? tanhf(x) : (j < 128 ? x : sigmoidf_(x));
        }
        __syncthreads();
        if (wave < 6) {
            const int c = tid, h = wave;
            {
                float aw0[16], aw1[16];
#pragma unroll
                for (int i = 0; i < 16; ++i) { aw0[i] = w0[c]; aw1[i] = w0[RW + c]; }
                for (int j = 0; j < 64; ++j) {
                    const float w20 = w2[(size_t)j * RW + c], w21 = w2[(size_t)(64 + j) * RW + c];
#pragma unroll
                    for (int i = 0; i < 16; ++i) { const float lw = lora[i * 256 + j]; aw0[i] += lw * w20; aw1[i] += lw * w21; }
                }
#pragma unroll
                for (int i = 0; i < 16; ++i) {
                    const size_t o = (size_t)(t0 + i) * RW + c;
                    DEC[o] = expf(-expf(-softplusf_(-aw0[i]) - 0.5f)); DEC[(size_t)T * RW + o] = expf(-expf(-softplusf_(-aw1[i]) - 0.5f));
                }
            }
            {
                float aa0[16], aa1[16];
#pragma unroll
                for (int i = 0; i < 16; ++i) { aa0[i] = a0[c]; aa1[i] = a0[RW + c]; }
                for (int j = 0; j < 64; ++j) {
                    const float a20 = a2[(size_t)j * RW + c], a21 = a2[(size_t)(64 + j) * RW + c];
#pragma unroll
                    for (int i = 0; i < 16; ++i) { const float la = lora[i * 256 + 64 + j]; aa0[i] += la * a20; aa1[i] += la * a21; }
                }
#pragma unroll
                for (int i = 0; i < 16; ++i) {
                    const size_t o = (size_t)(t0 + i) * RW + c;
                    ICLR[o] = sigmoidf_(aa0[i]); ICLR[(size_t)T * RW + o] = sigmoidf_(aa1[i]);
                }
            }
            {
                float ag[16];
#pragma unroll
                for (int i = 0; i < 16; ++i) ag[i] = 0.f;
                for (int j = 0; j < 128; ++j) {
                    const float g = g2[(size_t)j * RW + c];
#pragma unroll
                    for (int i = 0; i < 16; ++i) ag[i] += lora[i * 256 + 128 + j] * g;
                }
#pragma unroll
                for (int i = 0; i < 16; ++i) GATE[(size_t)(t0 + i) * RW + c] = ag[i];
            }
            const float kkc = k_k[c], kac = k_a[c], rkc = r_k[c];
#pragma unroll
            for (int i = 0; i < 16; ++i) {
                const int t = t0 + i, s = s0 + i;
                const float r = tshift(proj, t, s, C_RW + c, mu0, mu1, c);
                const float k = tshift(proj, t, s, C_RW + RW + c, mu0, mu1, RW + c);
                const float v = tshift(proj, t, s, C_RW + 2 * RW + c, mu0, mu1, 2 * RW + c);
                const size_t o = (size_t)t * RW + c;
                const float ic0 = ICLR[o], ic1 = ICLR[(size_t)T * RW + o];
                const float kq = k * kkc;
                const float n2 = wave_sum(kq * kq, lane);
                const float kk = kq / fmaxf(sqrtf(n2), 1e-12f);
                const float kd0 = k * (1.0f + (ic0 - 1.0f) * kac), kd1 = k * (1.0f + (ic1 - 1.0f) * kac);
                const float bon = wave_sum(r * (kd0 + kd1) * rkc, lane);
                const float br0 = wave_sum(kk * ic0 * r, lane), br1 = wave_sum(kk * ic1 * r, lane), kr0 = wave_sum(kd0 * r, lane), kr1 = wave_sum(kd1 * r, lane);
                RR[o] = r; VV[o] = v; KK[o] = kk;
                KD[o] = kd0; KD[(size_t)T * RW + o] = kd1;
                if (lane == 0) { BONUS[(size_t)t * RH + h] = bon;
                    BRKR[((size_t)t * RH + h) * 2] = br0; BRKR[((size_t)t * RH + h) * 2 + 1] = kr0;
                    BRKR[((size_t)(T + t) * RH + h) * 2] = br1; BRKR[((size_t)(T + t) * RH + h) * 2 + 1] = kr1; }
            }
        }
        for (int idx = tid; idx < 16 * 768; idx += NTHREADS) {
            const int i = idx / 768, c = idx % 768, t = t0 + i, s = s0 + i, col = C_MW + c;
            const float xm = s > 0 ? proj[(size_t)(t - 1) * PLD + col] : 0.f;
            const float x0 = proj[(size_t)t * PLD + col];
            const float xp = s < S - 1 ? proj[(size_t)(t + 1) * PLD + col] : 0.f;
            float y = conv_b[c] + xm * conv_w[c] + x0 * conv_w[768 + c] + xp * conv_w[2 * 768 + c];
            y = y * sigmoidf_(y);
            if (c < MW) MQ[(size_t)t * MW + c] = y; else MKb[(size_t)t * MW + (c - MW)] = y * 0.125f;
        }
        for (int idx = tid; idx < 16 * 24; idx += NTHREADS) {
            const int i = idx / 24, gi = idx % 24, t = t0 + i;
            const int isf = gi / 12, dir = (gi / 6) & 1, h = gi % 6;
            const float g = proj[(size_t)t * PLD + 3456 + gi] + gate_b[gi];
            if (isf) LF[((size_t)dir * T + t) * MH + h] = -softplusf_(-g); else IG[((size_t)dir * T + t) * MH + h] = g;
        }
        __syncthreads();
    }
}

__device__ __forceinline__ void phase_gmlp_mix(const Params& P, int l, unsigned char* smem, int wv, int bid, int nb) {
    PIN_S(bid); PIN_S(nb);
    ParamsPtr pp = PARAMS_PTR(P); PIN_S(pp); unsigned char* ws = pp->ws; int bidx = (int)blockIdx.x, gdim = (int)gridDim.x; PIN_S(bidx); PIN_S(gdim);
    const float* UG = (const float*)(ws + O_UG); const float* VN = (const float*)(ws + O_VN); bf16_t* GRP = (bf16_t*)(ws + O_GRP);
    const float* gws = pp->in[4] + (size_t)l * GH * CH * CH; const float* gbs = pp->in[5] + (size_t)l * GH * CH;
    float* vs = (float*)smem;
    float* wsm = vs + 128 * 64;
    const int tid = phase_tid(wv);
    for (int u = bid; u < NB * NCH * GH; u += nb) {
        const int h = u % GH, c = (u / GH) % NCH, b = u / (GH * NCH);
        const int tok0 = b * S + c * CH;
        __syncthreads();
        for (int idx = tid; idx < 128 * 64; idx += NTHREADS) { const int q = idx >> 6, e = idx & 63; vs[idx] = VN[(size_t)(tok0 + q) * GW + h * 64 + e]; }
        for (int idx = tid; idx < 128 * 128; idx += NTHREADS) wsm[idx] = gws[(size_t)h * CH * CH + idx];
        __syncthreads();
        const int p = tid >> 2, eg = (tid & 3) * 16;
        float acc[16];
#pragma unroll
        for (int e = 0; e < 16; ++e) acc[e] = 0.f;
        for (int q = 0; q < 128; ++q) {
            const float w = wsm[p * 128 + q];
#pragma unroll
            for (int e = 0; e < 16; ++e) acc[e] += w * vs[q * 64 + eg + e];
        }
        const float bsv = gbs[h * CH + p];
#pragma unroll
        for (int e = 0; e < 16; ++e) {
            const size_t t = (size_t)(tok0 + p);
            GRP[t * D + h * 64 + eg + e] = (bf16_t)f2bf(UG[t * GW + h * 64 + eg + e] * (acc[e] + bsv));
        }
    }
    __syncthreads();
}

__device__ __forceinline__ float row16_sum(float x) {
#ifdef EMU
    x += __shfl_xor(x, 1); x += __shfl_xor(x, 2); x += __shfl_xor(x, 4); x += __shfl_xor(x, 8); return x;
#else
#define DPPF(v, ctrl) __builtin_bit_cast(float, __builtin_amdgcn_update_dpp(0, __builtin_bit_cast(int, (v)), (ctrl), 0xF, 0xF, false))
    x += DPPF(x, 0xB1); x += DPPF(x, 0x4E); x += DPPF(x, 0x141); x += DPPF(x, 0x140); return x;
#undef DPPF
#endif
}
constexpr int SC_STEPS = 16;
constexpr int SC_BUF = SC_STEPS * 6 * 64;
__device__ __forceinline__ void phase_rwkv_scan(const Params& P, int l, unsigned char* smem, int wv, int bid, int nb) {
    PIN_S(bid); PIN_S(nb);
    ParamsPtr pp = PARAMS_PTR(P); PIN_S(pp); unsigned char* ws = pp->ws; int bidx = (int)blockIdx.x, gdim = (int)gridDim.x; PIN_S(bidx); PIN_S(gdim);
    const float* RR = (const float*)(ws + O_RR); const float* VV = (const float*)(ws + O_VV); const float* KK = (const float*)(ws + O_KK);
    const float* DEC = (const float*)(ws + O_DEC); const float* KD = (const float*)(ws + O_KD); const float* ICLR = (const float*)(ws + O_ICLR);
    float* SCAN = (float*)(ws + O_SCAN); const float* BRKR = (const float*)(ws + O_BRKR);
    const int tid = phase_tid(wv), lane = tid & 63, wave = tid >> 6, rl = lane >> 4, kq = lane & 15;
    float* buf = (float*)smem;
    float* scal = buf + 2 * SC_BUF;
    float* outb = scal + 2 * SC_STEPS * 2;
    for (int u = bid; u < 2 * NB * RH * 2; u += nb) {
        const int half = u & 1, h = (u >> 1) % RH, b = (u / (2 * RH)) % NB, d = u / (2 * RH * NB);
        const size_t doff = (size_t)d * T * RW;
        float s0 = 0.f, s1 = 0.f, s2 = 0.f, s3 = 0.f;
        float pw[2], pa[2], pb[2], pk[2], pr[2], pv[2], psc = 0.f;
#define SC_LOAD(c) do { _Pragma("unroll") for (int i = 0; i < 2; ++i) { const int idx = tid + NTHREADS * i, st = idx >> 6, k = idx & 63; const int tau = (c) * SC_STEPS + st, sq = d ? S - 1 - tau : tau; \
            const size_t o = (size_t)(b * S + sq) * RW + h * 64 + k; const float w_ = DEC[doff + o], kk_ = KK[o], ic_ = ICLR[doff + o]; \
            pw[i] = w_; pa[i] = -kk_; pb[i] = kk_ * ic_; pk[i] = KD[doff + o]; pr[i] = RR[o]; pv[i] = VV[o]; } \
            if (tid < 2 * SC_STEPS) { const int tau = (c) * SC_STEPS + (tid >> 1), sq = d ? S - 1 - tau : tau; psc = BRKR[((size_t)(d * T + b * S + sq) * RH + h) * 2 + (tid & 1)]; } } while (0)
#define SC_WRITE(c) do { float* B_ = buf + ((c) & 1) * SC_BUF; _Pragma("unroll") for (int i = 0; i < 2; ++i) { const int idx = tid + NTHREADS * i, st = idx >> 6, k = idx & 63; \
            float* q_ = B_ + st * 384 + k; q_[0] = pw[i]; q_[64] = pa[i]; q_[128] = pb[i]; q_[192] = pk[i]; q_[256] = pw[i] * pr[i]; q_[320] = pv[i]; } \
            if (tid < 2 * SC_STEPS) scal[((c) & 1) * SC_STEPS * 2 + tid] = psc; } while (0)
        __syncthreads();
        SC_LOAD(0); SC_WRITE(0);
        __syncthreads();
        const int row = half * 32 + wave * 4 + rl;
        for (int c = 0; c < S / SC_STEPS; ++c) {
            const bool more = (c + 1) < S / SC_STEPS;
            if (more) SC_LOAD(c + 1);
            const float* B = buf + (c & 1) * SC_BUF; const float* sc = scal + (c & 1) * SC_STEPS * 2; float* ob = outb + (c & 1) * SC_STEPS * 32;
            float outs[SC_STEPS];
            f32x4 w4 = *(const f32x4*)(B + 4 * kq), a4 = *(const f32x4*)(B + 64 + 4 * kq), b4 = *(const f32x4*)(B + 128 + 4 * kq);
            f32x4 k4 = *(const f32x4*)(B + 192 + 4 * kq), wr4 = *(const f32x4*)(B + 256 + 4 * kq);
            float v = B[320 + row]; float br = sc[0], kr = sc[1];
#pragma unroll
            for (int st = 0; st < SC_STEPS; ++st) {
                const int sn = st + 1 < SC_STEPS ? st + 1 : st;
                const float* q = B + sn * 384;
                const f32x4 nw4 = *(const f32x4*)(q + 4 * kq), na4 = *(const f32x4*)(q + 64 + 4 * kq), nb4 = *(const f32x4*)(q + 128 + 4 * kq);
                const f32x4 nk4 = *(const f32x4*)(q + 192 + 4 * kq), nwr4 = *(const f32x4*)(q + 256 + 4 * kq);
                const float nv = q[320 + row], nbr = sc[sn * 2], nkr = sc[sn * 2 + 1];
                SCHED_BAR();
                float sa = (s0 * a4.x + s1 * a4.y) + (s2 * a4.z + s3 * a4.w);
                float po = (s0 * wr4.x + s1 * wr4.y) + (s2 * wr4.z + s3 * wr4.w);
                sa = row16_sum(sa); po = row16_sum(po);
                outs[st] = po + sa * br + v * kr;
                s0 = s0 * w4.x + (sa * b4.x + v * k4.x); s1 = s1 * w4.y + (sa * b4.y + v * k4.y);
                s2 = s2 * w4.z + (sa * b4.z + v * k4.z); s3 = s3 * w4.w + (sa * b4.w + v * k4.w);
                SCHED_BAR();
                w4 = nw4; a4 = na4; b4 = nb4; k4 = nk4; wr4 = nwr4; v = nv; br = nbr; kr = nkr;
            }
            if (kq == 0) {
#pragma unroll
                for (int st = 0; st < SC_STEPS; ++st) ob[st * 32 + wave * 4 + rl] = outs[st];
            }
            if (more) SC_WRITE(c + 1);
            __syncthreads();
            {
                const int st = tid >> 5, r = tid & 31, tau = c * SC_STEPS + st, sq = d ? S - 1 - tau : tau;
                SCAN[doff + (size_t)(b * S + sq) * RW + h * 64 + half * 32 + r] = ob[st * 32 + r];
            }
        }
#undef SC_LOAD
#undef SC_WRITE
    }
    __syncthreads();
}

__device__ __forceinline__ void phase_mlstm_local(const Params& P, int l, unsigned char* smem, int wv, int bid, int nb) {
    PIN_S(bid); PIN_S(nb);
    ParamsPtr pp = PARAMS_PTR(P); PIN_S(pp); unsigned char* ws = pp->ws; int bidx = (int)blockIdx.x, gdim = (int)gridDim.x; PIN_S(bidx); PIN_S(gdim);
    const float* proj = (const float*)(ws + O_PROJ); const float* MKb = (const float*)(ws + O_MK);
    const float* IG = (const float*)(ws + O_IG); const float* LF = (const float*)(ws + O_LF);
    float* CL = (float*)(ws + O_CL); float* NLb = (float*)(ws + O_NL); float* ML = (float*)(ws + O_ML); float* BL = (float*)(ws + O_BL);
    float* ks = (float*)smem;
    float* vs = ks + 128 * 64;
    float* wts = vs + 128 * 64;
    float* lfv = wts + 128; float* igv = lfv + 128;
    int* tok = (int*)(igv + 128);
    const int tid = phase_tid(wv);
    for (int u = bid; u < 2 * NB * MH * NCH; u += nb) {
        const int c = u % NCH, h = (u / NCH) % MH, p = u / (NCH * MH), d = p / NB, b = p % NB;
        __syncthreads();
        if (tid < 128) {
            const int tau = c * CH + tid, s = d ? S - 1 - tau : tau, t = b * S + s;
            tok[tid] = t; lfv[tid] = LF[((size_t)d * T + t) * MH + h]; igv[tid] = IG[((size_t)d * T + t) * MH + h];
        }
        __syncthreads();
        for (int idx = tid; idx < 128 * 64; idx += NTHREADS) {
            const int j = idx >> 6, e = idx & 63; const size_t t = (size_t)tok[j];
            ks[idx] = MKb[t * MW + h * 64 + e]; vs[idx] = proj[t * PLD + C_MW + 2 * MW + h * 64 + e];
        }
        if (tid == 0) {
            float bc = 0.f;
            for (int j = 0; j < 128; ++j) { bc += lfv[j]; wts[j] = bc; }
            const float blast = bc; float m = -INFINITY;
            for (int j = 0; j < 128; ++j) { const float lw = blast - wts[j] + igv[j]; wts[j] = lw; m = fmaxf(m, lw); }
            for (int j = 0; j < 128; ++j) wts[j] = expf(wts[j] - m);
            ML[u] = m; BL[u] = blast;
        }
        __syncthreads();
        const int dk = tid >> 3, dv = (tid & 7) * 8;
        float acc[8]; float nacc = 0.f;
#pragma unroll
        for (int e = 0; e < 8; ++e) acc[e] = 0.f;
        for (int j = 0; j < 128; ++j) {
            const float kw = wts[j] * ks[j * 64 + dk];
            nacc += kw;
#pragma unroll
            for (int e = 0; e < 8; ++e) acc[e] += kw * vs[j * 64 + dv + e];
        }
#pragma unroll
        for (int e = 0; e < 8; ++e) CL[(size_t)u * 4096 + dk * 64 + dv + e] = acc[e];
        if (dv == 0) NLb[(size_t)u * 64 + dk] = nacc;
    }
    __syncthreads();
}

__device__ __forceinline__ void phase_mlstm_carry(const Params& P, int l, unsigned char* smem, int wv) {
    ParamsPtr pp = PARAMS_PTR(P); PIN_S(pp); unsigned char* ws = pp->ws; int bidx = (int)blockIdx.x, gdim = (int)gridDim.x; PIN_S(bidx); PIN_S(gdim);
    float* CL = (float*)(ws + O_CL); float* NLb = (float*)(ws + O_NL); const float* ML = (const float*)(ws + O_ML); const float* BL = (const float*)(ws + O_BL);
    float* MIN = (float*)(ws + O_MIN);
    const int total = 2 * NB * MH * 4160;
    const int tid = phase_tid(wv);
    for (int g = bidx * NTHREADS + tid; g < total; g += gdim * NTHREADS) {
        const int ph = g / 4160, e = g % 4160;
        float m = 0.f, val = 0.f;
        for (int c = 0; c < NCH; ++c) {
            const int base = ph * NCH + c;
            float* ptr = e < 4096 ? CL + (size_t)base * 4096 + e : NLb + (size_t)base * 64 + (e - 4096);
            const float loc = *ptr;
            *ptr = val;
            if (e == 0) MIN[base] = m;
            const float bl = BL[base], ml = ML[base];
            const float mn = fmaxf(bl + m, ml);
            val = expf(bl + m - mn) * val + expf(ml - mn) * loc;
            m = mn;
        }
    }
}

__device__ __forceinline__ void phase_mlstm_out(const Params& P, int l, unsigned char* smem, int wv) {
    ParamsPtr pp = PARAMS_PTR(P); PIN_S(pp); unsigned char* ws = pp->ws; int bidx = (int)blockIdx.x, gdim = (int)gridDim.x; PIN_S(bidx); PIN_S(gdim);
    const float* proj = (const float*)(ws + O_PROJ); const float* MQ = (const float*)(ws + O_MQ); const float* MKb = (const float*)(ws + O_MK);
    const float* IG = (const float*)(ws + O_IG); const float* LF = (const float*)(ws + O_LF);
    const float* CL = (const float*)(ws + O_CL); const float* NLb = (const float*)(ws + O_NL); const float* MIN = (const float*)(ws + O_MIN);
    bf16_t* GRP = (bf16_t*)(ws + O_GRP);
    const float* mln_g = pp->in[20] + (size_t)l * MW;
    float* qs = (float*)smem; float* ks = qs + 128 * 64; float* vs = ks + 128 * 64;
    float* Cs = vs + 128 * 64;
    float* ns = Cs + 4096;
    float* bcv = ns + 64; float* gv = bcv + 128; float* pmx = gv + 128;
    const int tid = phase_tid(wv), lane = tid & 63;
    for (int u = bidx; u < NB * MH * NCH; u += gdim) {
        const int tc = u % NCH, h = (u / NCH) % MH, b = u / (NCH * MH);
        const int tok0 = b * S + tc * CH;
        __syncthreads();
        for (int idx = tid; idx < 128 * 64; idx += NTHREADS) {
            const int i = idx >> 6, e = idx & 63; const size_t t = (size_t)(tok0 + i);
            qs[idx] = MQ[t * MW + h * 64 + e]; ks[idx] = MKb[t * MW + h * 64 + e]; vs[idx] = proj[t * PLD + C_MW + 2 * MW + h * 64 + e];
        }
        const int itok = tid >> 2, eg = (tid & 3) * 16;
        float hsum[16];
#pragma unroll
        for (int e = 0; e < 16; ++e) hsum[e] = 0.f;
        for (int d = 0; d < 2; ++d) {
            const int cd = d ? NCH - 1 - tc : tc;
            const int su = ((d * NB + b) * MH + h) * NCH + cd;
            __syncthreads();
            if (tid == 0) {
                float bc = 0.f, pm = -INFINITY;
                for (int j = 0; j < 128; ++j) {
                    const int i = d ? 127 - j : j; const size_t t = (size_t)(tok0 + i);
                    bc += LF[((size_t)d * T + t) * MH + h];
                    const float g = IG[((size_t)d * T + t) * MH + h] - bc;
                    pm = fmaxf(pm, g);
                    bcv[j] = bc; gv[j] = g; pmx[j] = pm;
                }
            }
            for (int idx = tid; idx < 4096; idx += NTHREADS) Cs[idx] = CL[(size_t)su * 4096 + idx];
            if (tid < 64) ns[tid] = NLb[(size_t)su * 64 + tid];
            const float mst = MIN[su];
            __syncthreads();
            const int j = d ? 127 - itok : itok;
            const float mx = fmaxf(pmx[j], mst), mt = bcv[j] + mx;
            float qrow[64];
#pragma unroll
            for (int k = 0; k < 64; ++k) qrow[k] = qs[itok * 64 + k];
            float acc[16]; float den = 0.f;
#pragma unroll
            for (int e = 0; e < 16; ++e) acc[e] = 0.f;
            for (int jj = 0; jj <= j; ++jj) {
                const int i2 = d ? 127 - jj : jj;
                float dot = 0.f;
#pragma unroll
                for (int k = 0; k < 64; ++k) dot += qrow[k] * ks[i2 * 64 + k];
                const float sw = dot * expf(gv[jj] - mx);
                den += sw;
#pragma unroll
                for (int e = 0; e < 16; ++e) acc[e] += sw * vs[i2 * 64 + eg + e];
            }
            const float wint = expf(mst - mx);
            float qn = 0.f; float qc[16];
#pragma unroll
            for (int e = 0; e < 16; ++e) qc[e] = 0.f;
#pragma unroll
            for (int k = 0; k < 64; ++k) {
                qn += qrow[k] * ns[k];
#pragma unroll
                for (int e = 0; e < 16; ++e) qc[e] += qrow[k] * Cs[k * 64 + eg + e];
            }
            den += wint * qn;
            const float dd = fmaxf(fabsf(den), expf(-mt));
#pragma unroll
            for (int e = 0; e < 16; ++e) hsum[e] += (acc[e] + wint * qc[e]) / dd;
        }
        float sm = 0.f;
#pragma unroll
        for (int e = 0; e < 16; ++e) sm += hsum[e];
        sm += SHX(sm, 1, lane); sm += SHX(sm, 2, lane);
        const float mean = sm * (1.0f / 64.0f); float q = 0.f;
#pragma unroll
        for (int e = 0; e < 16; ++e) { const float dlt = hsum[e] - mean; q += dlt * dlt; }
        q += SHX(q, 1, lane); q += SHX(q, 2, lane);
        const float rstd = 1.0f / sqrtf(q * (1.0f / 64.0f) + LN_EPS);
        const size_t t = (size_t)(tok0 + itok);
#pragma unroll
        for (int e = 0; e < 16; ++e) {
            const int c = h * 64 + eg + e;
            const float o = proj[t * PLD + C_MW + 3 * MW + c];
            GRP[t * D + GW + RW + c] = (bf16_t)f2bf(sigmoidf_(o) * ((hsum[e] - mean) * rstd * mln_g[c]));
        }
    }
    __syncthreads();
}

__device__ __forceinline__ void phase_rwkv_post(const Params& P, int l, unsigned char* smem, int wv) {
    ParamsPtr pp = PARAMS_PTR(P); PIN_S(pp); unsigned char* ws = pp->ws; int bidx = (int)blockIdx.x, gdim = (int)gridDim.x; PIN_S(bidx); PIN_S(gdim);
    const float* SCAN = (const float*)(ws + O_SCAN); const float* VV = (const float*)(ws + O_VV); const float* GATE = (const float*)(ws + O_GATE);
    const float* BONUS = (const float*)(ws + O_BONUS); bf16_t* GRP = (bf16_t*)(ws + O_GRP);
    const float* rln_g = pp->in[15] + (size_t)l * RW; const float* rln_b = pp->in[16] + (size_t)l * RW;
    const int tid = phase_tid(wv), lane = tid & 63, wave = tid >> 6;
    const int gw = bidx * NWAVES + wave, ngw = NWAVES * gdim;
    for (int it = gw; it < T * RH; it += ngw) {
        const int t = it / RH, h = it % RH, c = h * 64 + lane;
        const size_t o = (size_t)t * RW + c;
        const float x = SCAN[o] + SCAN[(size_t)T * RW + o];
        const float mean = wave_sum(x, lane) * (1.0f / 64.0f);
        const float dl = x - mean;
        const float var = wave_sum(dl * dl, lane) * (1.0f / 64.0f);
        float y = dl / sqrtf(var + GN_EPS) * rln_g[c] + rln_b[c];
        y += BONUS[(size_t)t * RH + h] * VV[o];
        GRP[(size_t)t * D + GW + c] = (bf16_t)f2bf(y * GATE[o]);
    }
}

__device__ __forceinline__ void phase_ln1_router(const Params& P, int l, unsigned char* smem, int wv) {
    ParamsPtr pp = PARAMS_PTR(P); PIN_S(pp); unsigned char* ws = pp->ws; int bidx = (int)blockIdx.x, gdim = (int)gridDim.x; PIN_S(bidx); PIN_S(gdim);
    const float* xin = l == 0 ? pp->in[0] : (const float*)(ws + O_XA);
    const float* MIX = (const float*)(ws + O_MIX); float* X1 = (float*)(ws + O_X1);
    int* TOPI = (int*)(ws + O_TOPI); float* TOPG = (float*)(ws + O_TOPG); int* RANK = (int*)(ws + O_RANK); bf16_t* X1B = (bf16_t*)(ws + O_X1B);
    int* BCNT = (int*)(ws + O_BCNT);
    const float* g1 = pp->in[22] + (size_t)l * D; const float* b1 = pp->in[23] + (size_t)l * D;
    const float* rw = pp->in[24] + (size_t)l * D * NE; const float* rb = pp->in[25] + (size_t)l * NE;
    const int tid = phase_tid(wv), lane = tid & 63, wave = tid >> 6;
    float* Wl = (float*)smem;
    float* lgs = (float*)(smem + 131072);
    int* stopi = (int*)(smem + 131072 + 8192);
    __syncthreads();
    for (int i = tid; i < D * NE / 4; i += NTHREADS) ((f32x4*)Wl)[i] = ((const f32x4*)rw)[i];
    for (int tile = bidx; tile < T / 64; tile += gdim) {
        __syncthreads();
        for (int ti8 = 0; ti8 < 8; ++ti8) {
            const int t = tile * 64 + wave * 8 + ti8;
            float v[16]; float sm = 0.f;
#pragma unroll
            for (int j = 0; j < 4; ++j) {
                const int c = j * 256 + lane * 4;
                const f32x4 a = *(const f32x4*)(xin + (size_t)t * D + c), m = *(const f32x4*)(MIX + (size_t)t * D + c);
                v[j * 4 + 0] = ALPHA * a.x + m.x; v[j * 4 + 1] = ALPHA * a.y + m.y; v[j * 4 + 2] = ALPHA * a.z + m.z; v[j * 4 + 3] = ALPHA * a.w + m.w;
                sm += (v[j * 4] + v[j * 4 + 1]) + (v[j * 4 + 2] + v[j * 4 + 3]);
            }
            const float mean = wave_sum(sm, lane) * (1.0f / D); float q = 0.f;
#pragma unroll
            for (int j = 0; j < 16; ++j) { const float dl = v[j] - mean; q += dl * dl; }
            const float rstd = 1.0f / sqrtf(wave_sum(q, lane) * (1.0f / D) + LN_EPS);
#pragma unroll
            for (int j = 0; j < 4; ++j) {
                const int c = j * 256 + lane * 4;
                const f32x4 gg = *(const f32x4*)(g1 + c), bb = *(const f32x4*)(b1 + c);
                f32x4 o;
                o.x = (v[j * 4 + 0] - mean) * rstd * gg.x + bb.x; o.y = (v[j * 4 + 1] - mean) * rstd * gg.y + bb.y;
                o.z = (v[j * 4 + 2] - mean) * rstd * gg.z + bb.z; o.w = (v[j * 4 + 3] - mean) * rstd * gg.w + bb.w;
                *(f32x4*)(X1 + (size_t)t * D + c) = o;
                u32x2 ob; ob.x = pk2(o.x, o.y); ob.y = pk2(o.z, o.w); *(u32x2*)(X1B + (size_t)t * D + c) = ob;
            }
        }
        __syncthreads();
        {
            const int tq = tid >> 3, eg = (tid & 7) * 4;
            const float* xr = X1 + (size_t)(tile * 64 + tq) * D;
            f32x4 acc = *(const f32x4*)(rb + eg);
#pragma unroll 4
            for (int c = 0; c < D; c += 4) {
                const f32x4 x4 = *(const f32x4*)(xr + c);
                acc += x4.x * *(const f32x4*)(Wl + (c + 0) * NE + eg); acc += x4.y * *(const f32x4*)(Wl + (c + 1) * NE + eg);
                acc += x4.z * *(const f32x4*)(Wl + (c + 2) * NE + eg); acc += x4.w * *(const f32x4*)(Wl + (c + 3) * NE + eg);
            }
            *(f32x4*)(lgs + tq * NE + eg) = acc;
        }
        __syncthreads();
        if (tid < 64) {
            const float* lp = lgs + tid * NE; const int t = tile * 64 + tid;
            float tv[4]; int ti[4];
#pragma unroll
            for (int k = 0; k < 4; ++k) { tv[k] = -INFINITY; ti[k] = 0; }
            for (int e = 0; e < NE; ++e) {
                const float x = lp[e];
                if (x > tv[3]) {
                    if (x > tv[0]) { tv[3] = tv[2]; ti[3] = ti[2]; tv[2] = tv[1]; ti[2] = ti[1]; tv[1] = tv[0]; ti[1] = ti[0]; tv[0] = x; ti[0] = e; }
                    else if (x > tv[1]) { tv[3] = tv[2]; ti[3] = ti[2]; tv[2] = tv[1]; ti[2] = ti[1]; tv[1] = x; ti[1] = e; }
                    else if (x > tv[2]) { tv[3] = tv[2]; ti[3] = ti[2]; tv[2] = x; ti[2] = e; }
                    else { tv[3] = x; ti[3] = e; }
                }
            }
            const float e1 = expf(tv[1] - tv[0]), e2 = expf(tv[2] - tv[0]), e3 = expf(tv[3] - tv[0]);
            const float inv = 1.0f / (1.0f + e1 + e2 + e3);
            *(f32x4*)(TOPG + (size_t)t * 4) = (f32x4){inv, e1 * inv, e2 * inv, e3 * inv};
#pragma unroll
            for (int k = 0; k < 4; ++k) { TOPI[(size_t)t * 4 + k] = ti[k]; stopi[tid * 4 + k] = ti[k]; }
        }
        __syncthreads();
        if (tid < 256) { const int e = stopi[tid]; int r = 0; for (int a2 = 0; a2 < tid; ++a2) r += (stopi[a2] == e) ? 1 : 0; RANK[(size_t)tile * 256 + tid] = r; }
        else if (tid < 256 + NE) { const int e = tid - 256; int cnt = 0; for (int a2 = 0; a2 < 256; ++a2) cnt += (stopi[a2] == e) ? 1 : 0; BCNT[tile * NE + e] = cnt; }
    }
    __syncthreads();
}

__device__ __forceinline__ void moe_offsets(int* sh, const int* CNT, int tid) {
    if (tid == 0) {
        int acc = 0;
        for (int e = 0; e < NE; ++e) { const int c = (int)CNT[e]; sh[e] = c; sh[32 + e] = acc; acc += (c + MOEB - 1) / MOEB * MOEB; sh[64 + e] = acc; }
    }
    __syncthreads();
}
__device__ __forceinline__ int moe_expert_of_row(const int* sh, int r) {
    int e = -1;
    for (int i = 0; i < NE; ++i) if (r >= sh[32 + i] && r < sh[64 + i]) e = i;
    return e;
}

__device__ __forceinline__ void phase_scatter(const Params& P, int l, unsigned char* smem, int wv) {
    ParamsPtr pp = PARAMS_PTR(P); PIN_S(pp); unsigned char* ws = pp->ws; int bidx = (int)blockIdx.x, gdim = (int)gridDim.x; PIN_S(bidx); PIN_S(gdim);
    const int tid = phase_tid(wv), lane = tid & 63, wave = tid >> 6;
    const int* TOPI = (const int*)(ws + O_TOPI); const int* RANK = (const int*)(ws + O_RANK); int* SLOT = (int*)(ws + O_SLOT);
    const int* BCNT = (const int*)(ws + O_BCNT); int* CNTF = (int*)(ws + O_CNTF);
    const bf16_t* X1B = (const bf16_t*)(ws + O_X1B); bf16_t* XS = (bf16_t*)(ws + O_XS);
    int* sh = (int*)smem;
    int* part = sh + 96;
    int* tot = part + 512;
    int* base = tot + 32;
    constexpr int NT = T / 64;
    const int e = tid & 31, pt = tid >> 5;
    { int sacc = 0; for (int tl = pt; tl < NT; tl += 16) sacc += BCNT[tl * NE + e]; part[pt * 32 + e] = sacc; }
    __syncthreads();
    if (tid < 32) { int sacc = 0; for (int q = 0; q < 16; ++q) sacc += part[q * 32 + tid]; tot[tid] = sacc; if (bidx == 0) CNTF[tid] = sacc; }
    __syncthreads();
    moe_offsets(sh, tot, tid);
    for (int tile = bidx; tile < NT; tile += gdim) {
        __syncthreads();
        { int sacc = 0; for (int tl = pt; tl < tile; tl += 16) sacc += BCNT[tl * NE + e]; part[pt * 32 + e] = sacc; }
        __syncthreads();
        if (tid < 32) { int sacc = sh[32 + tid]; for (int q = 0; q < 16; ++q) sacc += part[q * 32 + tid]; base[tid] = sacc; }
        __syncthreads();
        for (int al = wave; al < 256; al += NWAVES) {
            const int a = tile * 256 + al, dest = base[TOPI[a]] + RANK[a], t = a >> 2;
            if (lane == 0) SLOT[a] = dest;
            const u32x4* src = (const u32x4*)(X1B + (size_t)t * D); u32x4* dst = (u32x4*)(XS + (size_t)dest * D);
            dst[lane] = src[lane]; dst[64 + lane] = src[64 + lane];
        }
    }
    __syncthreads();
}

template <int WHICH>
__device__ __forceinline__ void phase_moe_gemm(const Params& P, int l, unsigned char* smem, int wv) {
    ParamsPtr pp = PARAMS_PTR(P); PIN_S(pp); unsigned char* ws = pp->ws; int bidx = (int)blockIdx.x, gdim = (int)gridDim.x; PIN_S(bidx); PIN_S(gdim);
    const int tid = phase_tid(wv);
    const int* CNT = (const int*)(ws + O_CNTF);
    int* sh = (int*)(smem + 131072);
    int* rbe = sh + 96;
    moe_offsets(sh, CNT, tid);
    const int nrb = sh[64 + NE - 1] / MOEB;
    for (int rb = tid; rb < nrb; rb += NTHREADS) rbe[rb] = moe_expert_of_row(sh, rb * MOEB);
    __syncthreads();
    pg8::MoeOrder S;
    S.K = 1024; S.G = gdim; S.c = bidx; S.rbe = rbe;
    if (WHICH == 1) {
        S.A = (const char*)(ws + O_XS); S.Wt = (const char*)(ws + O_W1) + (size_t)l * NE * 2 * DFF * D * 2; S.estride = (size_t)2 * DFF * D * 2; S.nN = 2 * DFF / 256; S.nwg = nrb * S.nN;
        pg8::EpiSwiglu E{(bf16_t*)(ws + O_ACT), pp->in[27] + (size_t)l * NE * 2 * DFF};
        pg8::gemm_phase<pg8::EpiSwiglu, pg8::MoeOrder>((LAS unsigned char*)smem, 1024, S, E, tid);
    } else {
        S.A = (const char*)(ws + O_ACT); S.Wt = (const char*)(ws + O_W2) + (size_t)l * NE * D * DFF * 2; S.estride = (size_t)D * DFF * 2; S.nN = D / 256; S.nwg = nrb * S.nN;
        pg8::EpiBf16Bias E{(bf16_t*)(ws + O_YS), D, pp->in[29] + (size_t)l * NE * D, D};
        pg8::gemm_phase<pg8::EpiBf16Bias, pg8::MoeOrder>((LAS unsigned char*)smem, 1024, S, E, tid);
    }
    __syncthreads();
}

__device__ __forceinline__ void phase_combine_ln2(const Params& P, int l, unsigned char* smem, int wv) {
    ParamsPtr pp = PARAMS_PTR(P); PIN_S(pp); unsigned char* ws = pp->ws; int bidx = (int)blockIdx.x, gdim = (int)gridDim.x; PIN_S(bidx); PIN_S(gdim);
    const float* X1 = (const float*)(ws + O_X1); const bf16_t* YS = (const bf16_t*)(ws + O_YS); bf16_t* XB = (bf16_t*)(ws + O_XB);
    const int* SLOT = (const int*)(ws + O_SLOT); const float* TOPG = (const float*)(ws + O_TOPG);
    float* xo = l == NL - 1 ? pp->out : (float*)(ws + O_XA);
    const float* g2 = pp->in[30] + (size_t)l * D; const float* b2 = pp->in[31] + (size_t)l * D;
    const int tid = phase_tid(wv), lane = tid & 63, wave = tid >> 6;
    const int gw = bidx * NWAVES + wave, ngw = NWAVES * gdim;
    for (int t = gw; t < T; t += ngw) {
        int sl[4]; float gg[4];
#pragma unroll
        for (int k = 0; k < 4; ++k) { sl[k] = SLOT[(size_t)t * 4 + k]; gg[k] = TOPG[(size_t)t * 4 + k]; }
        float v[16]; float sm = 0.f;
#pragma unroll
        for (int j = 0; j < 4; ++j) {
            const int c = j * 256 + lane * 4;
            const f32x4 a = *(const f32x4*)(X1 + (size_t)t * D + c);
            f32x4 y = (f32x4){0.f, 0.f, 0.f, 0.f};
#pragma unroll
            for (int k = 0; k < 4; ++k) { const u32x2 yk = *(const u32x2*)(YS + (size_t)sl[k] * D + c);
                y.x += gg[k] * __builtin_bit_cast(float, yk.x << 16); y.y += gg[k] * __builtin_bit_cast(float, yk.x & 0xffff0000u); y.z += gg[k] * __builtin_bit_cast(float, yk.y << 16); y.w += gg[k] * __builtin_bit_cast(float, yk.y & 0xffff0000u); }
            v[j * 4 + 0] = ALPHA * a.x + y.x; v[j * 4 + 1] = ALPHA * a.y + y.y; v[j * 4 + 2] = ALPHA * a.z + y.z; v[j * 4 + 3] = ALPHA * a.w + y.w;
            sm += (v[j * 4] + v[j * 4 + 1]) + (v[j * 4 + 2] + v[j * 4 + 3]);
        }
        const float mean = wave_sum(sm, lane) * (1.0f / D); float q = 0.f;
#pragma unroll
        for (int j = 0; j < 16; ++j) { const float dl = v[j] - mean; q += dl * dl; }
        const float rstd = 1.0f / sqrtf(wave_sum(q, lane) * (1.0f / D) + LN_EPS);
#pragma unroll
        for (int j = 0; j < 4; ++j) {
            const int c = j * 256 + lane * 4;
            f32x4 o;
            o.x = (v[j * 4 + 0] - mean) * rstd * g2[c + 0] + b2[c + 0]; o.y = (v[j * 4 + 1] - mean) * rstd * g2[c + 1] + b2[c + 1];
            o.z = (v[j * 4 + 2] - mean) * rstd * g2[c + 2] + b2[c + 2]; o.w = (v[j * 4 + 3] - mean) * rstd * g2[c + 3] + b2[c + 3];
            *(f32x4*)(xo + (size_t)t * D + c) = o;
            if (l != NL - 1) { u32x2 ob; ob.x = pk2(o.x, o.y); ob.y = pk2(o.z, o.w); *(u32x2*)(XB + (size_t)t * D + c) = ob; }
        }
    }
}

__device__ __forceinline__ void phase_inproj(const Params& P, int l, unsigned char* smem, int wv) {
    ParamsPtr pp = PARAMS_PTR(P); PIN_S(pp); unsigned char* ws = pp->ws; int bidx = (int)blockIdx.x, gdim = (int)gridDim.x; PIN_S(bidx); PIN_S(gdim);
    const int tid = phase_tid(wv);
    pg8::DenseOrder S; S.init(ws + O_XB, (const bf16_t*)(ws + O_WIN) + (size_t)l * PLD * D, T, PLD, D, gdim, bidx);
    pg8::EpiF32 E{(float*)(ws + O_PROJ), PLD};
    pg8::gemm_phase<pg8::EpiF32, pg8::DenseOrder>((LAS unsigned char*)smem, D, S, E, tid);
    __syncthreads();
}
__device__ __forceinline__ void phase_outproj(const Params& P, int l, unsigned char* smem, int wv) {
    ParamsPtr pp = PARAMS_PTR(P); PIN_S(pp); unsigned char* ws = pp->ws; int bidx = (int)blockIdx.x, gdim = (int)gridDim.x; PIN_S(bidx); PIN_S(gdim);
    const int tid = phase_tid(wv);
    pg8::DenseOrder S; S.init(ws + O_GRP, (const bf16_t*)(ws + O_WOUT) + (size_t)l * D * D, T, D, D, gdim, bidx);
    pg8::EpiF32 E{(float*)(ws + O_MIX), D};
    pg8::gemm_phase<pg8::EpiF32, pg8::DenseOrder>((LAS unsigned char*)smem, D, S, E, tid);
    __syncthreads();
}

#ifndef EMU
#define XB_TMO      128
#define XB_XCNT(j)  (256  + 64 * (j))
#define XB_XSUB(j)  (1280 + 64 * (j))
#define XB_XGEN(j)  (2304 + 64 * (j))
#define XB_TOP      3328
#define XB_TOPGEN   3392
#define XCD_BAR_WORDS 3456
#define XB_SPIN_CAP (1u << 25)
__device__ __forceinline__ unsigned xb_ld(unsigned* p)              { return __hip_atomic_load(p, __ATOMIC_RELAXED, __HIP_MEMORY_SCOPE_AGENT); }
__device__ __forceinline__ unsigned xb_add(unsigned* p, unsigned v) { return __hip_atomic_fetch_add(p, v, __ATOMIC_RELAXED, __HIP_MEMORY_SCOPE_AGENT); }
__device__ __forceinline__ unsigned xb_xcc_id() { return (unsigned)__builtin_amdgcn_s_getreg((3 << 11) | 20) & 0xFu; }
#define XB_SPIN(cond, bar) do { unsigned _sp = 0; while (cond) { __builtin_amdgcn_s_sleep(1); \
    if ((++_sp & 255u) == 0u) { if (xb_ld(&(bar)[XB_TMO])) break; if (_sp > XB_SPIN_CAP) { atomicAdd(&(bar)[XB_TMO], 1u); break; } } } } while (0)
struct XcdBarrier { unsigned* bar; unsigned x; volatile LAS unsigned* st; };
__device__ __forceinline__ XcdBarrier xcd_barrier_post(unsigned* bar, volatile LAS unsigned* st) {
    XcdBarrier b; b.bar = bar; b.x = xb_xcc_id(); b.st = st;
    if (threadIdx.x == 0) (void)xb_add(&bar[XB_XCNT(b.x)], 1u);
    return b;
}
__device__ __forceinline__ void xcd_barrier_complete(unsigned* bar, unsigned x, unsigned& nloc, unsigned& nx) {
    const unsigned G = gridDim.x * gridDim.y * gridDim.z;
    unsigned sum, cnt, mine, sp = 0u;
    for (;;) {
        sum = 0u; cnt = 0u; mine = 0u;
#pragma unroll
        for (unsigned j = 0; j < 16; ++j) { const unsigned c = xb_ld(&bar[XB_XCNT(j)]); sum += c; cnt += (c > 0u) ? 1u : 0u; mine = (j == x) ? c : mine; }
        if (sum == G) break;
        __builtin_amdgcn_s_sleep(1);
        if ((++sp & 255u) == 0u) { if (xb_ld(&bar[XB_TMO])) break; if (sp > XB_SPIN_CAP) { atomicAdd(&bar[XB_TMO], 1u); break; } }
    }
    nloc = mine > 0u ? mine : 1u; nx = cnt > 0u ? cnt : 1u;
}
__device__ __forceinline__ void xcd_barrier(const XcdBarrier& b) {
    asm volatile("s_waitcnt vmcnt(0)" ::: "memory");
    __syncthreads();
    if (threadIdx.x == 0) {
        unsigned* bar = b.bar;
        __builtin_amdgcn_s_waitcnt(0);
        unsigned nloc = b.st[0], nx = b.st[1];
        if (nloc == 0u) { xcd_barrier_complete(bar, b.x, nloc, nx); b.st[0] = nloc; b.st[1] = nx; }
        const unsigned old = xb_add(&bar[XB_XSUB(b.x)], 1u);
        const unsigned gen = old / nloc;
        if (old + 1u == (gen + 1u) * nloc) {
            __builtin_amdgcn_fence(__ATOMIC_RELEASE, "agent");
            asm volatile("s_waitcnt vmcnt(0)" ::: "memory");
            const unsigned og = xb_add(&bar[XB_TOP], 1u);
            const unsigned tg = og / nx;
            if (og + 1u == (tg + 1u) * nx) xb_add(&bar[XB_TOPGEN], 1u);
            else XB_SPIN(xb_ld(&bar[XB_TOPGEN]) == tg, bar);
            __builtin_amdgcn_fence(__ATOMIC_ACQUIRE, "agent");
            xb_add(&bar[XB_XGEN(b.x)], 1u);
            asm volatile("s_waitcnt vmcnt(0)" ::: "memory");
        } else {
            XB_SPIN(xb_ld(&bar[XB_XGEN(b.x)]) == gen, bar);
            __builtin_amdgcn_fence(__ATOMIC_ACQUIRE, "agent");
            asm volatile("s_waitcnt vmcnt(0)" ::: "memory");
        }
    }
    __syncthreads();
}
#endif

__global__ void __launch_bounds__(512, 2) mk_fwd(Params P) {
#ifdef EMU
    unsigned char* smem = g_blk->lds;
#else
    extern __shared__ __attribute__((aligned(16))) unsigned char smem[];
    volatile LAS unsigned* bst = (volatile LAS unsigned*)(smem + LDS_BYTES - 16);
    if (threadIdx.x == 0) { bst[0] = 0u; bst[1] = 0u; bst[2] = 0u; bst[3] = 0u; }
    __syncthreads();
    XcdBarrier bar; bar.bar = (unsigned*)P.ws + CW_BAR; bar.x = 0; bar.st = bst;
    if (P.ph_hi - P.ph_lo > 1) bar = xcd_barrier_post((unsigned*)P.ws + CW_BAR, bst);
#endif
    const int lo = P.ph_lo, hi = P.ph_hi;
#ifdef EMU
    const int wv = (int)threadIdx.x >> 6;
#else
    const int wv = RFL((int)threadIdx.x >> 6);
#endif
#ifdef EMU
#define SEAM(id) do {} while (0)
#else
#define SEAM(id) do { if ((id) + 1 < hi) xcd_barrier(bar); } while (0)
#endif
#ifndef MK_ONLY_PHASE
#define MK_ONLY_PHASE -1
#endif
#ifndef MK_DUP_MASK
#define MK_DUP_MASK 0
#endif
#define PHG(kc, id, ...) do { if (MK_ONLY_PHASE < 0 || MK_ONLY_PHASE == (kc)) { const int id_ = (id); if (id_ >= lo && id_ < hi) { if ((MK_DUP_MASK >> (kc)) & 1) { __VA_ARGS__; SEAM(id_ - 1); } __VA_ARGS__; SEAM(id_); } } } while (0)
#define PH(k, ...) PHG(1 + (k), 1 + l * NPH + (k), __VA_ARGS__)
    PHG(0, 0, phase_prologue(P, smem, wv));
    for (int l = 0; l < NL; ++l) {
        PH(0, phase_inproj(P, l, smem, wv));
        PH(1, phase_prep(P, l, smem, wv));
        PH(2, { const int G_ = (int)gridDim.x, NSC = 2 * NB * RH * 2;
                if (G_ >= NSC + 64) { if ((int)blockIdx.x < NSC) phase_rwkv_scan(P, l, smem, wv, (int)blockIdx.x, NSC);
                                      else { phase_gmlp_mix(P, l, smem, wv, (int)blockIdx.x - NSC, G_ - NSC); phase_mlstm_local(P, l, smem, wv, (int)blockIdx.x - NSC, G_ - NSC); } }
                else { phase_rwkv_scan(P, l, smem, wv, (int)blockIdx.x, G_); phase_gmlp_mix(P, l, smem, wv, (int)blockIdx.x, G_); phase_mlstm_local(P, l, smem, wv, (int)blockIdx.x, G_); } });
        PH(3, phase_mlstm_carry(P, l, smem, wv));
        PH(4, { phase_mlstm_out(P, l, smem, wv); phase_rwkv_post(P, l, smem, wv); });
        PH(5, phase_outproj(P, l, smem, wv));
        PH(6, phase_ln1_router(P, l, smem, wv));
        PH(7, phase_scatter(P, l, smem, wv));
        PH(8, phase_moe_gemm<1>(P, l, smem, wv));
        PH(9, phase_moe_gemm<2>(P, l, smem, wv));
        PH(10, phase_combine_ln2(P, l, smem, wv));
    }
#undef PHG
#undef PH
#undef SEAM
}

}

#ifndef EMU
extern "C" void kernel_launch(void* const* d_in, const int* in_sizes, int n_in, void* d_out, int out_size, void* d_ws, size_t ws_size, hipStream_t stream) {
    using namespace mk;
    static int grid = 0;
    if (grid == 0) {
        if (n_in != 32 || out_size != T * D || ws_size < WS_END) { fprintf(stderr, "kernel_launch: unexpected shapes (n_in %d out %d ws %zu need %zu)\n", n_in, out_size, ws_size, (size_t)WS_END); grid = -1; return; }
        int dev = 0, cus = 0;
        if (hipGetDevice(&dev) != hipSuccess || hipDeviceGetAttribute(&cus, hipDeviceAttributeMultiprocessorCount, dev) != hipSuccess) { grid = -1; return; }
        if (hipFuncSetAttribute((const void*)mk_fwd, hipFuncAttributeMaxDynamicSharedMemorySize, LDS_BYTES) != hipSuccess) { fprintf(stderr, "kernel_launch: hipFuncSetAttribute failed\n"); grid = -1; return; }
        int per_cu = 0;
        (void)hipOccupancyMaxActiveBlocksPerMultiprocessor(&per_cu, (const void*)mk_fwd, NTHREADS, LDS_BYTES);
        (void)hipGetLastError();
        grid = cus;
    }
    if (grid < 0) return;
    (void)hipMemsetAsync(d_ws, 0, CTL_BYTES, stream);
    Params p{};
    for (int i = 0; i < 32; ++i) p.in[i] = (const float*)d_in[i];
    p.out = (float*)d_out; p.ws = (unsigned char*)d_ws;
#if MK_ONE_LAUNCH
    p.ph_lo = 0; p.ph_hi = 1 + NL * NPH;
    hipLaunchKernelGGL(mk_fwd, dim3(grid), dim3(NTHREADS), LDS_BYTES, stream, p);
#else
    for (int id = 0; id < 1 + NL * NPH; ++id) {
        p.ph_lo = id; p.ph_hi = id + 1;
        hipLaunchKernelGGL(mk_fwd, dim3(grid), dim3(NTHREADS), LDS_BYTES, stream, p);
    }
#endif
}
#endif
```

```cpp
#ifndef EMU
#include <hip/hip_runtime.h>
#endif
#include <cstdio>
#include <cstdint>
#include <cmath>

#ifndef CFG_BATCH
#define CFG_BATCH 4
#endif
#ifndef CFG_SEQ
#define CFG_SEQ 4096
#endif
#ifndef CFG_LAYERS
#define CFG_LAYERS 4
#endif
#ifndef MK_ONE_LAUNCH
#define MK_ONE_LAUNCH 1
#endif

namespace mk {
constexpr int NB = CFG_BATCH, S = CFG_SEQ, T = NB * S, NL = CFG_LAYERS, D = 1024;
constexpr int GW = 256, RW = 384, MW = 384, HD = 64, GH = 4, RH = 6, MH = 6, CH = 128, NCH = S / CH;
constexpr int PIN = 3480, PLD = 3584, RPROJ = 1408;
constexpr int C_RW = 512, C_MW = 1920;
constexpr int NE = 32, TOPK = 4, DFF = 1024, MOEB = 256;
constexpr int NROWS = (T * TOPK / MOEB + NE) * MOEB;
constexpr float LN_EPS = 1e-5f, GN_EPS = 64e-5f;
constexpr float ALPHA = 1.6817928305074290f;
constexpr int NTHREADS = 512, NWAVES = 8;
constexpr int LDS_BYTES = 160 * 1024;
constexpr int NPH = 11;

typedef float f32x4 __attribute__((ext_vector_type(4)));
typedef unsigned u32x4 __attribute__((ext_vector_type(4)));
typedef unsigned u32x2 __attribute__((ext_vector_type(2)));
typedef short bf16x8 __attribute__((ext_vector_type(8)));
typedef unsigned short bf16_t;

constexpr size_t al(size_t x) { return (x + 255) & ~(size_t)255; }
constexpr size_t CTL_BYTES = 1u << 20;
constexpr size_t O_XA = CTL_BYTES;
constexpr size_t O_XB = O_XA + al((size_t)T * D * 4);
constexpr size_t O_X1 = O_XB + al((size_t)T * D * 2);
constexpr size_t O_X1B = O_X1 + al((size_t)T * D * 4);
constexpr size_t O_PROJ = O_X1B + al((size_t)T * D * 2);
constexpr size_t O_MIX = O_PROJ + al((size_t)T * PLD * 4);
constexpr size_t O_GRP = O_MIX + al((size_t)T * D * 4);
constexpr size_t O_UG = O_GRP + al((size_t)T * D * 2);
constexpr size_t O_VN = O_UG + al((size_t)T * GW * 4);
constexpr size_t O_RR = O_VN + al((size_t)T * GW * 4);
constexpr size_t O_VV = O_RR + al((size_t)T * RW * 4);
constexpr size_t O_KK = O_VV + al((size_t)T * RW * 4);
constexpr size_t O_DEC = O_KK + al((size_t)T * RW * 4);
constexpr size_t O_KD = O_DEC + al((size_t)2 * T * RW * 4);
constexpr size_t O_ICLR = O_KD + al((size_t)2 * T * RW * 4);
constexpr size_t O_GATE = O_ICLR + al((size_t)2 * T * RW * 4);
constexpr size_t O_BONUS = O_GATE + al((size_t)T * RW * 4);
constexpr size_t O_SCAN = O_BONUS + al((size_t)T * RH * 4);
constexpr size_t O_MQ = O_SCAN + al((size_t)2 * T * RW * 4);
constexpr size_t O_MK = O_MQ + al((size_t)T * MW * 4);
constexpr size_t O_IG = O_MK + al((size_t)T * MW * 4);
constexpr size_t O_LF = O_IG + al((size_t)2 * T * MH * 4);
constexpr size_t O_CL = O_LF + al((size_t)2 * T * MH * 4);
constexpr size_t O_NL = O_CL + al((size_t)2 * NB * MH * NCH * 4096 * 4);
constexpr size_t O_ML = O_NL + al((size_t)2 * NB * MH * NCH * 64 * 4);
constexpr size_t O_BL = O_ML + al((size_t)2 * NB * MH * NCH * 4);
constexpr size_t O_MIN = O_BL + al((size_t)2 * NB * MH * NCH * 4);
constexpr size_t O_TOPI = O_MIN + al((size_t)2 * NB * MH * NCH * 4);
constexpr size_t O_TOPG = O_TOPI + al((size_t)T * 4 * 4);
constexpr size_t O_RANK = O_TOPG + al((size_t)T * 4 * 4);
constexpr size_t O_SLOT = O_RANK + al((size_t)T * 4 * 4);
constexpr size_t O_MQB = O_SLOT + al((size_t)T * 4 * 4);
constexpr size_t O_MKB = O_MQB + al((size_t)T * MW * 2);
constexpr size_t O_KT = O_MKB + al((size_t)T * MW * 2);
constexpr size_t O_VT = O_KT + al((size_t)T * MW * 2);
constexpr size_t O_GVT = O_VT + al((size_t)T * MW * 2);
constexpr size_t O_PMX = O_GVT + al((size_t)2 * T * MH * 4);
constexpr size_t O_BCT = O_PMX + al((size_t)2 * T * MH * 4);
constexpr size_t O_BRKR = O_BCT + al((size_t)2 * T * MH * 4);
constexpr size_t O_BCNT = O_BRKR + al((size_t)2 * T * RH * 2 * 4);
constexpr size_t O_CNTF = O_BCNT + al((size_t)(T / 64) * NE * 4);
constexpr size_t O_XS = O_CNTF + al((size_t)NE * 4);
constexpr size_t O_ACT = O_XS + al((size_t)NROWS * D * 2);
constexpr size_t O_YS = O_ACT + al((size_t)NROWS * DFF * 2);
constexpr size_t O_WIN = O_YS + al((size_t)NROWS * D * 2);
constexpr size_t O_WOUT = O_WIN + al((size_t)NL * PLD * D * 2);
constexpr size_t O_W1 = O_WOUT + al((size_t)NL * D * D * 2);
constexpr size_t O_W2 = O_W1 + al((size_t)NL * NE * 2 * DFF * D * 2);
constexpr size_t WS_END = O_W2 + al((size_t)NL * NE * D * DFF * 2);

constexpr int CW_BAR = 4096;
constexpr int CW_CNT = 16384;

struct Params { const float* in[32]; float* out; unsigned char* ws; int ph_lo, ph_hi; };
#ifdef EMU
typedef const Params* ParamsPtr;
#define PARAMS_PTR(P) (&(P))
#else
typedef const __attribute__((address_space(4))) Params* ParamsPtr;
#define PARAMS_PTR(P) ((ParamsPtr)__builtin_amdgcn_kernarg_segment_ptr())
#endif

#ifdef EMU
#define WAVE_SYNC() emu_wave_barrier()
#define PIN_V(x) do {} while (0)
#define PIN_S(x) do {} while (0)
#else
#define WAVE_SYNC() __builtin_amdgcn_wave_barrier()
#define PIN_V(x) asm volatile("" : "+v"(x))
#define PIN_S(x) asm volatile("" : "+s"(x))
#endif
#ifdef EMU
__device__ __forceinline__ int phase_tid(int wv) { (void)wv; return threadIdx.x; }
#else
__device__ __forceinline__ int phase_tid(int wv) { int t; asm volatile("v_mbcnt_lo_u32_b32 %0, -1, 0\n\tv_mbcnt_hi_u32_b32 %0, -1, %0" : "=v"(t)); return (wv << 6) + t; }
#endif

#ifdef EMU
#define SHX(v, m, lane) __shfl_xor(v, m)
#else
__device__ __forceinline__ float shx_(float v, int m, int lane) { return __builtin_bit_cast(float, __builtin_amdgcn_ds_bpermute((lane ^ m) << 2, __builtin_bit_cast(int, v))); }
__device__ __forceinline__ int shx_(int v, int m, int lane) { return __builtin_amdgcn_ds_bpermute((lane ^ m) << 2, v); }
#define SHX(v, m, lane) shx_(v, m, lane)
#endif
#ifdef EMU
#define SHUP(v, o, lane) __shfl(v, ((lane) - (o)) & 63)
#define RDL(v, src) __shfl(v, src)
#else
#define SHUP(v, o, lane) __builtin_bit_cast(float, __builtin_amdgcn_ds_bpermute((((lane) - (o)) & 63) << 2, __builtin_bit_cast(int, (float)(v))))
#define RDL(v, src) __builtin_bit_cast(float, __builtin_amdgcn_readlane(__builtin_bit_cast(int, (float)(v)), src))
#endif
__device__ __forceinline__ float wave_sum(float v, int lane) {
#pragma unroll
    for (int o = 32; o >= 1; o >>= 1) v += SHX(v, o, lane);
    return v;
}
__device__ __forceinline__ float sigmoidf_(float x) { return 1.0f / (1.0f + expf(-x)); }
__device__ __forceinline__ float softplusf_(float x) { return fmaxf(x, 0.f) + log1pf(expf(-fabsf(x))); }
__device__ __forceinline__ float geluf_(float x) { return 0.5f * x * (1.0f + erff(x * 0.70710678118654752f)); }

#ifdef EMU
#define LAS
#define WAIT_V(n) do {} while (0)
#define WAIT_L(n) do {} while (0)
#define S_BARRIER() __syncthreads()
#define SETPRIO(x) do {} while (0)
#define SCHED_BAR() do {} while (0)
#define RFL(x) (x)
static inline void emu_glds16(const void* g, void* l) { memcpy((char*)l + (g_blk->cur & 63) * 16, g, 16); }
#define GLDS16(gptr, ldsptr) emu_glds16((const void*)(gptr), (void*)(ldsptr))
static inline float emu_bf2f(unsigned short b) { unsigned u = (unsigned)b << 16; float f; memcpy(&f, &u, 4); return f; }
static inline f32x4 emu_mfma16(bf16x8 a, bf16x8 b, f32x4 c) {
    EmuBlock* blk = g_blk; const int cur = blk->cur, lane = cur & 63, wbase = cur & ~63;
    static thread_local unsigned short Ash[32][64][8], Bsh[32][64][8];
    const int w = cur >> 6;
    for (int j = 0; j < 8; ++j) { Ash[w][lane][j] = (unsigned short)a[j]; Bsh[w][lane][j] = (unsigned short)b[j]; }
    emu_wave_barrier();
    const int col = lane & 15;
    for (int r = 0; r < 4; ++r) { const int row = 4 * (lane >> 4) + r; float sum = c[r];
        for (int k = 0; k < 32; ++k) sum += emu_bf2f(Ash[w][row + 16 * (k >> 3)][k & 7]) * emu_bf2f(Bsh[w][col + 16 * (k >> 3)][k & 7]);
        c[r] = sum; }
    emu_wave_barrier(); (void)wbase;
    return c;
}
#define MFMA16(a, b, c) emu_mfma16(a, b, c)
#else
#define LAS __attribute__((address_space(3)))
#define WAIT_V(n) asm volatile("s_waitcnt vmcnt(" #n ")" ::: "memory")
#define WAIT_L(n) asm volatile("s_waitcnt lgkmcnt(" #n ")" ::: "memory")
#define S_BARRIER() __builtin_amdgcn_s_barrier()
#define SETPRIO(x) __builtin_amdgcn_s_setprio(x)
#define SCHED_BAR() __builtin_amdgcn_sched_barrier(0)
#define RFL(x) __builtin_amdgcn_readfirstlane(x)
#define GLDS16(gptr, ldsptr) __builtin_amdgcn_global_load_lds((const unsigned*)(gptr), (LAS unsigned*)(ldsptr), 16, 0, 0)
#define MFMA16(a, b, c) __builtin_amdgcn_mfma_f32_16x16x32_bf16(a, b, c, 0, 0, 0)
#endif

__device__ __forceinline__ unsigned f2bf(float f) { unsigned u = __builtin_bit_cast(unsigned, f); return (u + 0x7fffu + ((u >> 16) & 1u)) >> 16; }
__device__ __forceinline__ unsigned pk2(float lo, float hi) { return f2bf(lo) | (f2bf(hi) << 16); }

namespace pg8 {
constexpr int BM = 256, BK = 64, HALF = 128, HTB = HALF * BK * 2, STAGE_BYTES = 8 * HTB, NXCD = 8, WGM = 8;
__host__ __device__ __forceinline__ int lds_byte(int r, int c) { const int st = (r >> 4) * 2 + (c >> 5), rr = r & 15, cc = c & 31, ob = rr * 64 + cc * 2; return st * 1024 + (ob ^ (((ob >> 9) & 1) << 5)); }
__host__ __device__ __forceinline__ void stage_rc(int b, int& R, int& C) { const int st = b / 1024, sb = b % 1024, swz = sb ^ (((sb >> 9) & 1) << 5); R = (st >> 1) * 16 + swz / 64; C = (st & 1) * 32 + (swz % 64) / 2; }
__host__ __device__ __forceinline__ int perm32(int rho) { const int n = rho >> 4, i = rho & 15; return 8 * (i >> 2) + 4 * n + (i & 3); }
struct Unit { int pm, pn, e; };

struct DenseOrder {
    const char* A; const char* Bt; int K; int nM, nN, nwg, G, c;
    __device__ __forceinline__ void init(const void* A_, const void* Bt_, int M, int N, int K_, int G_, int c_) { A = (const char*)A_; Bt = (const char*)Bt_; K = K_; nM = M / BM; nN = N / BM; nwg = nM * nN; G = G_; c = c_; }
    __device__ __forceinline__ bool next(int i, Unit& u) const {
        const long L = (long)i * G + c; if (L >= nwg) return false;
        int wgid = (int)L; { const int q = nwg / NXCD, r = nwg % NXCD, xcd = wgid % NXCD, off = wgid / NXCD; wgid = (xcd < r ? xcd * (q + 1) : r * (q + 1) + (xcd - r) * q) + off; }
        const int nig = WGM * nN, gid = wgid / nig, fm = gid * WGM, gsz = (nM - fm) < WGM ? (nM - fm) : WGM;
        u.pm = fm + ((wgid % nig) % gsz); u.pn = (wgid % nig) / gsz; u.e = 0; return true;
    }
    __device__ __forceinline__ const char* abase(const Unit& u) const { return A + (size_t)u.pm * BM * K * 2; }
    __device__ __forceinline__ const char* bbase(const Unit& u) const { return Bt + (size_t)u.pn * BM * K * 2; }
};
struct MoeOrder {
    const char* A; const char* Wt; int K; int nN, nwg, G, c; size_t estride; const int* rbe;
    __device__ __forceinline__ bool next(int i, Unit& u) const {
        const long L = (long)i * G + c; if (L >= nwg) return false;
        u.pm = (int)(L / nN); u.pn = (int)(L % nN); u.e = rbe[u.pm]; return true;
    }
    __device__ __forceinline__ const char* abase(const Unit& u) const { return A + (size_t)u.pm * BM * K * 2; }
    __device__ __forceinline__ const char* bbase(const Unit& u) const { return Wt + (size_t)u.e * estride + (size_t)u.pn * BM * K * 2; }
};

struct EpiF32 {
    static constexpr bool PERM = false;
    float* C; int ldc;
    __device__ __forceinline__ void operator()(const f32x4 (&acc)[2][2][4][2], const Unit& u, int wr, int wc, int fr, int fq) const {
        const int row0 = u.pm * BM + wr * 64 + fr, col0 = u.pn * BM + wc * 32 + 4 * fq;
#pragma unroll
        for (int ai = 0; ai < 2; ++ai)
#pragma unroll
            for (int m = 0; m < 4; ++m) { float* rowp = C + (size_t)(row0 + ai * HALF + m * 16) * ldc + col0;
#pragma unroll
                for (int bj = 0; bj < 2; ++bj)
#pragma unroll
                    for (int n = 0; n < 2; ++n) *(f32x4*)(rowp + bj * HALF + n * 16) = acc[ai][bj][m][n]; }
    }
};
struct EpiBf16Bias {
    static constexpr bool PERM = true;
    bf16_t* O; int ldc; const float* bias; int bias_estride;
    __device__ __forceinline__ void operator()(const f32x4 (&acc)[2][2][4][2], const Unit& u, int wr, int wc, int fr, int fq) const {
        const int row0 = u.pm * BM + wr * 64 + fr, col0 = u.pn * BM + wc * 32 + 8 * fq;
        const float* bp = bias + (size_t)u.e * bias_estride + col0;
        f32x4 bv[2][2];
#pragma unroll
        for (int bj = 0; bj < 2; ++bj)
#pragma unroll
            for (int n = 0; n < 2; ++n) bv[bj][n] = *(const f32x4*)(bp + bj * HALF + 4 * n);
#pragma unroll
        for (int ai = 0; ai < 2; ++ai)
#pragma unroll
            for (int m = 0; m < 4; ++m) { bf16_t* rowp = O + (size_t)(row0 + ai * HALF + m * 16) * ldc + col0;
#pragma unroll
                for (int bj = 0; bj < 2; ++bj) { const f32x4 v0 = acc[ai][bj][m][0] + bv[bj][0], v1 = acc[ai][bj][m][1] + bv[bj][1];
                    u32x4 w; w.x = pk2(v0[0], v0[1]); w.y = pk2(v0[2], v0[3]); w.z = pk2(v1[0], v1[1]); w.w = pk2(v1[2], v1[3]);
                    *(u32x4*)(rowp + bj * HALF) = w; } }
    }
};
__device__ __forceinline__ float swiglu1(float g, float uu) { g = fminf(g, 7.0f); uu = fminf(fmaxf(uu, -7.0f), 7.0f); return (uu + 1.0f) * (g / (1.0f + expf(-1.702f * g))); }
struct EpiSwiglu {
    static constexpr bool PERM = true;
    bf16_t* O; const float* b1;
    __device__ __forceinline__ void operator()(const f32x4 (&acc)[2][2][4][2], const Unit& u, int wr, int wc, int fr, int fq) const {
        const int row0 = u.pm * BM + wr * 64 + fr, j0 = u.pn * HALF + wc * 32 + 8 * fq;
        const float* bg = b1 + (size_t)u.e * 2 * DFF + j0; const float* bu = bg + DFF;
        f32x4 g4[2], u4[2];
#pragma unroll
        for (int n = 0; n < 2; ++n) { g4[n] = *(const f32x4*)(bg + 4 * n); u4[n] = *(const f32x4*)(bu + 4 * n); }
#pragma unroll
        for (int ai = 0; ai < 2; ++ai)
#pragma unroll
            for (int m = 0; m < 4; ++m) {
                float o[8];
#pragma unroll
                for (int n = 0; n < 2; ++n)
#pragma unroll
                    for (int q = 0; q < 4; ++q) o[n * 4 + q] = swiglu1(acc[ai][0][m][n][q] + g4[n][q], acc[ai][1][m][n][q] + u4[n][q]);
                u32x4 w; w.x = pk2(o[0], o[1]); w.y = pk2(o[2], o[3]); w.z = pk2(o[4], o[5]); w.w = pk2(o[6], o[7]);
                *(u32x4*)(O + (size_t)(row0 + ai * HALF + m * 16) * DFF + j0) = w;
            }
    }
};

template <class Epi, class Sched>
__device__ __forceinline__ void gemm_phase(LAS unsigned char* lds, const int K, const Sched& S, const Epi& E, const int tid) {
    const int wid = RFL(tid >> 6), lane = tid & 63, wr = wid >> 2, wc = wid & 3, fr = lane & 15, fq = lane >> 4;
    const int nt = K / BK;
    unsigned voffA[2], voffB[2];
#pragma unroll
    for (int i = 0; i < 2; ++i) { int R, C; stage_rc(tid * 16 + i * 8192, R, C); const int Rb = Epi::PERM ? ((R & ~31) + perm32(R & 31)) : R;
        voffA[i] = (unsigned)(R * K + C) * 2u; voffB[i] = (unsigned)(Rb * K + C) * 2u; }
    const size_t kstep = (size_t)(BK * 2);
    const size_t hstep = (size_t)HALF * K * 2;
    const unsigned ldsw = (unsigned)wid * 1024u;
    const int aoff = lds_byte(wr * 64 + fr, fq * 8), boff = lds_byte(wc * 32 + fr, fq * 8);
#define PG8_SA(b, h) (((b) * 2 + (h)) * HTB)
#define PG8_SB(b, h) ((4 + (b) * 2 + (h)) * HTB)
#define PG8_STAGE(bufoff, gbase, voff) do { _Pragma("unroll") for (int _i = 0; _i < 2; ++_i) \
        GLDS16((const char*)(gbase) + (voff)[_i], lds + (bufoff) + ldsw + _i * 8192); } while (0)
#define PG8_LDA(dst, b, h) do { _Pragma("unroll") for (int m = 0; m < 4; ++m) _Pragma("unroll") for (int k = 0; k < 2; ++k) dst[m][k] = *(const LAS bf16x8*)(lds + PG8_SA(b, h) + aoff + m * 2048 + k * 1024); } while (0)
#define PG8_LDB(dst, b, h) do { _Pragma("unroll") for (int n = 0; n < 2; ++n) _Pragma("unroll") for (int k = 0; k < 2; ++k) dst[n][k] = *(const LAS bf16x8*)(lds + PG8_SB(b, h) + boff + n * 2048 + k * 1024); } while (0)
#define PG8_MMA(ai, bj, At, Bt) do { SETPRIO(1); _Pragma("unroll") for (int m = 0; m < 4; ++m) _Pragma("unroll") for (int n = 0; n < 2; ++n) _Pragma("unroll") for (int k = 0; k < 2; ++k) \
        acc[ai][bj][m][n] = MFMA16(Bt[n][k], At[m][k], acc[ai][bj][m][n]); SETPRIO(0); } while (0)
    Unit cur, nxt; int ui = 0;
    if (!S.next(0, cur)) return;
    f32x4 acc[2][2][4][2];
#pragma unroll
    for (int a = 0; a < 2; ++a)
#pragma unroll
        for (int b = 0; b < 2; ++b)
#pragma unroll
            for (int m = 0; m < 4; ++m)
#pragma unroll
                for (int n = 0; n < 2; ++n) acc[a][b][m][n] = (f32x4){0.f, 0.f, 0.f, 0.f};
    bf16x8 At[4][2], B0[2][2], B1[2][2];
    const char* cA = S.abase(cur); const char* cB = S.bbase(cur);
    PG8_STAGE(PG8_SB(0, 0), cB, voffB); PG8_STAGE(PG8_SA(0, 0), cA, voffA); PG8_STAGE(PG8_SB(0, 1), cB + hstep, voffB); PG8_STAGE(PG8_SA(0, 1), cA + hstep, voffA);
    if (wr == 1) S_BARRIER();
    WAIT_V(4); S_BARRIER();
    PG8_STAGE(PG8_SB(1, 0), cB + kstep, voffB); PG8_STAGE(PG8_SA(1, 0), cA + kstep, voffA); PG8_STAGE(PG8_SB(1, 1), cB + hstep + kstep, voffB);
    WAIT_V(6); S_BARRIER();
    for (;;) {
        const bool has_next = S.next(ui + 1, nxt);
        const char* nA = has_next ? S.abase(nxt) : cA; const char* nB = has_next ? S.bbase(nxt) : cB;
        for (int t = 0; t < nt; t += 2) {
            const bool last = (t == nt - 2);
            const char* a1 = cA + (size_t)(t + 1) * kstep;
            const char* a2 = last ? nA : cA + (size_t)(t + 2) * kstep; const char* b2 = last ? nB : cB + (size_t)(t + 2) * kstep;
            const char* a3 = a2 + kstep; const char* b3 = b2 + kstep;
            PG8_LDB(B0, 0, 0); SCHED_BAR(); PG8_LDA(At, 0, 0); PG8_STAGE(PG8_SA(1, 1), a1 + hstep, voffA);
            WAIT_L(8); S_BARRIER(); WAIT_L(0); PG8_MMA(0, 0, At, B0); S_BARRIER(); SCHED_BAR();
            PG8_LDB(B1, 0, 1); PG8_STAGE(PG8_SB(0, 0), b2, voffB);
            S_BARRIER(); WAIT_L(0); PG8_MMA(0, 1, At, B1); S_BARRIER();
            PG8_LDA(At, 0, 1); PG8_STAGE(PG8_SA(0, 0), a2, voffA);
            S_BARRIER(); WAIT_L(0); PG8_MMA(1, 0, At, B0); S_BARRIER(); SCHED_BAR();
            PG8_STAGE(PG8_SB(0, 1), b2 + hstep, voffB);
            WAIT_V(6); S_BARRIER(); PG8_MMA(1, 1, At, B1); S_BARRIER();
            PG8_LDB(B0, 1, 0); SCHED_BAR(); PG8_LDA(At, 1, 0); PG8_STAGE(PG8_SA(0, 1), a2 + hstep, voffA);
            WAIT_L(8); S_BARRIER(); WAIT_L(0); PG8_MMA(0, 0, At, B0); S_BARRIER(); SCHED_BAR();
            PG8_LDB(B1, 1, 1); PG8_STAGE(PG8_SB(1, 0), b3, voffB);
            S_BARRIER(); WAIT_L(0); PG8_MMA(0, 1, At, B1); S_BARRIER();
            PG8_LDA(At, 1, 1); PG8_STAGE(PG8_SA(1, 0), a3, voffA);
            S_BARRIER(); WAIT_L(0); PG8_MMA(1, 0, At, B0); S_BARRIER(); SCHED_BAR();
            PG8_STAGE(PG8_SB(1, 1), b3 + hstep, voffB);
            WAIT_V(6); S_BARRIER(); PG8_MMA(1, 1, At, B1); S_BARRIER();
        }
        E(acc, cur, wr, wc, fr, fq);
        if (!has_next) break;
#pragma unroll
        for (int a = 0; a < 2; ++a)
#pragma unroll
            for (int b = 0; b < 2; ++b)
#pragma unroll
                for (int m = 0; m < 4; ++m)
#pragma unroll
                    for (int n = 0; n < 2; ++n) acc[a][b][m][n] = (f32x4){0.f, 0.f, 0.f, 0.f};
        cur = nxt; cA = nA; cB = nB; ++ui;
    }
    WAIT_V(0);
    if (wr == 0) S_BARRIER();
    S_BARRIER();
#undef PG8_SA
#undef PG8_SB
#undef PG8_STAGE
#undef PG8_LDA
#undef PG8_LDB
#undef PG8_MMA
}
}

__device__ __forceinline__ void transpose_item(const float* W, int K, int N, bf16_t* WT, int k0, int n0, int dst_row0, float* scr, int lane) {
#pragma unroll 8
    for (int i = 0; i < 32; ++i) { const int kk = 2 * i + (lane >> 5), n = n0 + (lane & 31); scr[kk * 33 + (lane & 31)] = n < N ? W[(size_t)(k0 + kk) * N + n] : 0.f; }
    WAVE_SYNC();
    const int c = lane & 7;
#pragma unroll
    for (int j = 0; j < 4; ++j) { const int n = (lane >> 3) + 8 * j; const float* sp = scr + (8 * c) * 33 + n;
        u32x4 o; o.x = pk2(sp[0 * 33], sp[1 * 33]); o.y = pk2(sp[2 * 33], sp[3 * 33]); o.z = pk2(sp[4 * 33], sp[5 * 33]); o.w = pk2(sp[6 * 33], sp[7 * 33]);
        *(u32x4*)(WT + (size_t)(dst_row0 + n) * K + k0 + 8 * c) = o; }
    WAVE_SYNC();
}
__device__ __forceinline__ void phase_prologue(const Params& P, unsigned char* smem, int wv) {
    ParamsPtr pp = PARAMS_PTR(P); PIN_S(pp); unsigned char* ws = pp->ws; int bidx = (int)blockIdx.x, gdim = (int)gridDim.x; PIN_S(bidx); PIN_S(gdim);
    const int tid = phase_tid(wv), lane = tid & 63, wave = tid >> 6;
    float* scr = (float*)smem + wave * (64 * 33);
    const int gw = bidx * NWAVES + wave, ngw = NWAVES * gdim;
    constexpr int I_IN = 16 * (PLD / 32), I_OUT = 16 * 32, I_W1 = NE * 16 * 64, I_W2 = NE * 16 * 32, I_L = I_IN + I_OUT + I_W1 + I_W2;
    for (int it = gw; it < NL * I_L; it += ngw) {
        const int l = it / I_L; int r = it % I_L;
        if (r < I_IN) { const int kb = r / (PLD / 32), nb = r % (PLD / 32);
            transpose_item(pp->in[1] + (size_t)l * D * PIN, D, PIN, (bf16_t*)(ws + O_WIN) + (size_t)l * PLD * D, kb * 64, nb * 32, nb * 32, scr, lane); continue; }
        r -= I_IN;
        if (r < I_OUT) { const int kb = r / 32, nb = r % 32;
            transpose_item(pp->in[21] + (size_t)l * D * D, D, D, (bf16_t*)(ws + O_WOUT) + (size_t)l * D * D, kb * 64, nb * 32, nb * 32, scr, lane); continue; }
        r -= I_OUT;
        if (r < I_W1) { const int e = r / (16 * 64), q = r % (16 * 64), kb = q / 64, nb = q % 64, n0 = nb * 32;
            const int dst = n0 < DFF ? (n0 / 128) * 256 + (n0 % 128) : ((n0 - DFF) / 128) * 256 + 128 + ((n0 - DFF) % 128);
            transpose_item(pp->in[26] + ((size_t)l * NE + e) * D * 2 * DFF, D, 2 * DFF, (bf16_t*)(ws + O_W1) + ((size_t)l * NE + e) * 2 * DFF * D, kb * 64, n0, dst, scr, lane); continue; }
        r -= I_W1;
        { const int e = r / (16 * 32), q = r % (16 * 32), kb = q / 32, nb = q % 32;
            transpose_item(pp->in[28] + ((size_t)l * NE + e) * DFF * D, DFF, D, (bf16_t*)(ws + O_W2) + ((size_t)l * NE + e) * D * DFF, kb * 64, nb * 32, nb * 32, scr, lane); }
    }
    const float* x = pp->in[0]; bf16_t* XB = (bf16_t*)(ws + O_XB);
    for (size_t i = ((size_t)bidx * NTHREADS + tid) * 4; i < (size_t)T * D; i += (size_t)gdim * NTHREADS * 4) {
        const f32x4 v = *(const f32x4*)(x + i); u32x2 o; o.x = pk2(v.x, v.y); o.y = pk2(v.z, v.w); *(u32x2*)(XB + i) = o;
    }
}

__device__ __forceinline__ float tshift(const float* P, int t, int s, int col, const float* mu0, const float* mu1, int rc) {
    const float cur = P[(size_t)t * PLD + col];
    const float prv = s > 0 ? P[(size_t)(t - 1) * PLD + col] : 0.f;
    const float nxt = s < S - 1 ? P[(size_t)(t + 1) * PLD + col] : 0.f;
    return cur + mu0[rc] * (prv - cur) + mu1[rc] * (nxt - cur);
}

__device__ __forceinline__ void phase_prep(const Params& P, int l, unsigned char* smem, int wv) {
    ParamsPtr pp = PARAMS_PTR(P); PIN_S(pp); unsigned char* ws = pp->ws; int bidx = (int)blockIdx.x, gdim = (int)gridDim.x; PIN_S(bidx); PIN_S(gdim);
    const float* proj = (const float*)(ws + O_PROJ);
    float* UG = (float*)(ws + O_UG); float* VN = (float*)(ws + O_VN);
    float* RR = (float*)(ws + O_RR); float* VV = (float*)(ws + O_VV); float* KK = (float*)(ws + O_KK);
    float* DEC = (float*)(ws + O_DEC); float* KD = (float*)(ws + O_KD); float* ICLR = (float*)(ws + O_ICLR);
    float* GATE = (float*)(ws + O_GATE); float* BONUS = (float*)(ws + O_BONUS); float* BRKR = (float*)(ws + O_BRKR);
    bf16_t* MQB = (bf16_t*)(ws + O_MQB); bf16_t* MKB = (bf16_t*)(ws + O_MKB); bf16_t* KT = (bf16_t*)(ws + O_KT); bf16_t* VT = (bf16_t*)(ws + O_VT);
    float* IG = (float*)(ws + O_IG); float* LF = (float*)(ws + O_LF);
    const float* gln_g = pp->in[2] + (size_t)l * GW; const float* gln_b = pp->in[3] + (size_t)l * GW;
    const float* mu0 = pp->in[6] + (size_t)l * 2 * RPROJ; const float* mu1 = mu0 + RPROJ;
    const float* w0 = pp->in[7] + (size_t)l * 2 * RW; const float* w2 = pp->in[8] + (size_t)l * 2 * 64 * RW;
    const float* a0 = pp->in[9] + (size_t)l * 2 * RW; const float* a2 = pp->in[10] + (size_t)l * 2 * 64 * RW;
    const float* g2 = pp->in[11] + (size_t)l * 128 * RW;
    const float* k_k = pp->in[12] + (size_t)l * RW; const float* k_a = pp->in[13] + (size_t)l * RW; const float* r_k = pp->in[14] + (size_t)l * RW;
    const float* conv_w = pp->in[17] + (size_t)l * 3 * 768; const float* conv_b = pp->in[18] + (size_t)l * 768; const float* gate_b = pp->in[19] + (size_t)l * 24;
    float* lora = (float*)smem;
    const int tid = phase_tid(wv), lane = tid & 63, wave = tid >> 6;
    for (int u = bidx; u < T / 16; u += gdim) {
        const int t0 = u * 16, s0 = t0 % S;
        {
            const int i = tid >> 5, l32 = tid & 31, t = t0 + i;
            float v[8]; float sum = 0.f;
#pragma unroll
            for (int j = 0; j < 8; ++j) {
                const int c = j * 32 + l32;
                UG[(size_t)t * GW + c] = geluf_(proj[(size_t)t * PLD + c]);
                v[j] = geluf_(proj[(size_t)t * PLD + GW + c]); sum += v[j];
            }
#pragma unroll
            for (int o = 16; o >= 1; o >>= 1) sum += SHX(sum, o, lane);
            const float mean = sum * (1.0f / GW); float q = 0.f;
#pragma unroll
            for (int j = 0; j < 8; ++j) { const float d = v[j] - mean; q += d * d; }
#pragma unroll
            for (int o = 16; o >= 1; o >>= 1) q += SHX(q, o, lane);
            const float rstd = 1.0f / sqrtf(q * (1.0f / GW) + LN_EPS);
#pragma unroll
            for (int j = 0; j < 8; ++j) { const int c = j * 32 + l32; VN[(size_t)t * GW + c] = (v[j] - mean) * rstd * gln_g[c] + gln_b[c]; }
        }
        __syncthreads();
        for (int idx = tid; idx < 16 * 256; idx += NTHREADS) {
            const int i = idx >> 8, j = idx & 255, rc = 1152 + j;
            const float x = tshift(proj, t0 + i, s0 + i, C_RW + rc, mu0, mu1, rc);
            lora[idx] = j < 64 ? tanhf(x) : (j < 128 ? x : sigmoidf_(x));
        }
        __syncthreads();
        if (wave < 6) {
            const int c = tid, h = wave;
            {
                float aw0[16], aw1[16];
#pragma unroll
                for (int i = 0; i < 16; ++i) { aw0[i] = w0[c]; aw1[i] = w0[RW + c]; }
                for (int j0 = 0; j0 < 64; j0 += 8) {
                    float wa[8], wb[8];
#pragma unroll
                    for (int jj = 0; jj < 8; ++jj) { wa[jj] = w2[(size_t)(j0 + jj) * RW + c]; wb[jj] = w2[(size_t)(64 + j0 + jj) * RW + c]; }
#pragma unroll
                    for (int jj = 0; jj < 8; ++jj)
#pragma unroll
                        for (int i = 0; i < 16; ++i) { const float lw = lora[i * 256 + j0 + jj]; aw0[i] += lw * wa[jj]; aw1[i] += lw * wb[jj]; }
                }
#pragma unroll
                for (int i = 0; i < 16; ++i) {
                    const size_t o = (size_t)(t0 + i) * RW + c;
                    DEC[o] = expf(-expf(-softplusf_(-aw0[i]) - 0.5f)); DEC[(size_t)T * RW + o] = expf(-expf(-softplusf_(-aw1[i]) - 0.5f));
                }
            }
            {
                float aa0[16], aa1[16];
#pragma unroll
                for (int i = 0; i < 16; ++i) { aa0[i] = a0[c]; aa1[i] = a0[RW + c]; }
                for (int j0 = 0; j0 < 64; j0 += 8) {
                    float wa[8], wb[8];
#pragma unroll
                    for (int jj = 0; jj < 8; ++jj) { wa[jj] = a2[(size_t)(j0 + jj) * RW + c]; wb[jj] = a2[(size_t)(64 + j0 + jj) * RW + c]; }
#pragma unroll
                    for (int jj = 0; jj < 8; ++jj)
#pragma unroll
                        for (int i = 0; i < 16; ++i) { const float la = lora[i * 256 + 64 + j0 + jj]; aa0[i] += la * wa[jj]; aa1[i] += la * wb[jj]; }
                }
#pragma unroll
                for (int i = 0; i < 16; ++i) {
                    const size_t o = (size_t)(t0 + i) * RW + c;
                    ICLR[o] = sigmoidf_(aa0[i]); ICLR[(size_t)T * RW + o] = sigmoidf_(aa1[i]);
                }
            }
            {
                float ag[16];
#pragma unroll
                for (int i = 0; i < 16; ++i) ag[i] = 0.f;
                for (int j0 = 0; j0 < 128; j0 += 16) {
                    float wa[16];
#pragma unroll
                    for (int jj = 0; jj < 16; ++jj) wa[jj] = g2[(size_t)(j0 + jj) * RW + c];
#pragma unroll
                    for (int jj = 0; jj < 16; ++jj)
#pragma unroll
                        for (int i = 0; i < 16; ++i) ag[i] += lora[i * 256 + 128 + j0 + jj] * wa[jj];
                }
#pragma unroll
                for (int i = 0; i < 16; ++i) GATE[(size_t)(t0 + i) * RW + c] = ag[i];
            }
            const float kkc = k_k[c], kac = k_a[c], rkc = r_k[c];
            float rr_[16], kq_[16], vv_[16];
            {
                float pr_[18], pk_[18], pv_[18];
#pragma unroll
                for (int i = 0; i < 18; ++i) {
                    const int s = s0 - 1 + i; const bool ok = s >= 0 && s < S; const size_t ro = (size_t)(t0 - 1 + i) * PLD + C_RW + c;
                    pr_[i] = ok ? proj[ro] : 0.f; pk_[i] = ok ? proj[ro + RW] : 0.f; pv_[i] = ok ? proj[ro + 2 * RW] : 0.f;
                }
                const float m0r = mu0[c], m1r = mu1[c], m0k = mu0[RW + c], m1k = mu1[RW + c], m0v = mu0[2 * RW + c], m1v = mu1[2 * RW + c];
#pragma unroll
                for (int i = 0; i < 16; ++i) {
                    rr_[i] = pr_[i + 1] + m0r * (pr_[i] - pr_[i + 1]) + m1r * (pr_[i + 2] - pr_[i + 1]);
                    kq_[i] = pk_[i + 1] + m0k * (pk_[i] - pk_[i + 1]) + m1k * (pk_[i + 2] - pk_[i + 1]);
                    vv_[i] = pv_[i + 1] + m0v * (pv_[i] - pv_[i + 1]) + m1v * (pv_[i + 2] - pv_[i + 1]);
                }
            }
#pragma unroll
            for (int i = 0; i < 16; ++i) {
                const int t = t0 + i;
                const float r = rr_[i], k = kq_[i], v = vv_[i];
                const size_t o = (size_t)t * RW + c;
                const float ic0 = ICLR[o], ic1 = ICLR[(size_t)T * RW + o];
                const float kq = k * kkc;
                const float n2 = wave_sum(kq * kq, lane);
                const float kk = kq / fmaxf(sqrtf(n2), 1e-12f);
                const float kd0 = k * (1.0f + (ic0 - 1.0f) * kac), kd1 = k * (1.0f + (ic1 - 1.0f) * kac);
                const float bon = wave_sum(r * (kd0 + kd1) * rkc, lane);
                const float br0 = wave_sum(kk * ic0 * r, lane), br1 = wave_sum(kk * ic1 * r, lane), kr0 = wave_sum(kd0 * r, lane), kr1 = wave_sum(kd1 * r, lane);
                RR[o] = r; VV[o] = v; KK[o] = kk;
                KD[o] = kd0; KD[(size_t)T * RW + o] = kd1;
                if (lane == 0) { BONUS[(size_t)t * RH + h] = bon;
                    BRKR[((size_t)t * RH + h) * 2] = br0; BRKR[((size_t)t * RH + h) * 2 + 1] = kr0;
                    BRKR[((size_t)(T + t) * RH + h) * 2] = br1; BRKR[((size_t)(T + t) * RH + h) * 2 + 1] = kr1; }
            }
        }
        {
            bf16_t* tk = (bf16_t*)(smem + 16384);
            bf16_t* tv = tk + 384 * 16;
            for (int idx = tid; idx < 16 * 768; idx += NTHREADS) {
                const int i = idx / 768, c = idx % 768, t = t0 + i, s = s0 + i, col = C_MW + c;
                const float xm = s > 0 ? proj[(size_t)(t - 1) * PLD + col] : 0.f;
                const float x0 = proj[(size_t)t * PLD + col];
                const float xp = s < S - 1 ? proj[(size_t)(t + 1) * PLD + col] : 0.f;
                float y = conv_b[c] + xm * conv_w[c] + x0 * conv_w[768 + c] + xp * conv_w[2 * 768 + c];
                y = y * sigmoidf_(y);
                if (c < MW) MQB[(size_t)t * MW + c] = (bf16_t)f2bf(y);
                else { const bf16_t kb = (bf16_t)f2bf(y * 0.125f); MKB[(size_t)t * MW + (c - MW)] = kb; tk[(c - MW) * 16 + i] = kb; }
            }
            for (int idx = tid; idx < 16 * MW; idx += NTHREADS) {
                const int i = idx / MW, c = idx % MW;
                tv[c * 16 + i] = (bf16_t)f2bf(proj[(size_t)(t0 + i) * PLD + C_MW + 2 * MW + c]);
            }
            __syncthreads();
            const int bb = t0 / S;
            for (int idx = tid; idx < 2 * MW * 2; idx += NTHREADS) {
                const int hf = idx & 1, c = (idx >> 1) % MW, which = idx / (2 * MW);
                const u32x4 val = *(const u32x4*)((which ? tv : tk) + c * 16 + hf * 8);
                bf16_t* dst = (which ? VT : KT) + ((size_t)(bb * MH) * 64 + c) * S + s0 + hf * 8;
                *(u32x4*)dst = val;
            }
        }
        for (int idx = tid; idx < 16 * 24; idx += NTHREADS) {
            const int i = idx / 24, gi = idx % 24, t = t0 + i;
            const int isf = gi / 12, dir = (gi / 6) & 1, h = gi % 6;
            const float g = proj[(size_t)t * PLD + 3456 + gi] + gate_b[gi];
            if (isf) LF[((size_t)dir * T + t) * MH + h] = -softplusf_(-g); else IG[((size_t)dir * T + t) * MH + h] = g;
        }
        __syncthreads();
    }
}

__device__ __forceinline__ void phase_gmlp_mix(const Params& P, int l, unsigned char* smem, int wv, int bid, int nb) {
    PIN_S(bid); PIN_S(nb);
    ParamsPtr pp = PARAMS_PTR(P); PIN_S(pp); unsigned char* ws = pp->ws; int bidx = (int)blockIdx.x, gdim = (int)gridDim.x; PIN_S(bidx); PIN_S(gdim);
    const float* UG = (const float*)(ws + O_UG); const float* VN = (const float*)(ws + O_VN); bf16_t* GRP = (bf16_t*)(ws + O_GRP);
    const float* gws = pp->in[4] + (size_t)l * GH * CH * CH; const float* gbs = pp->in[5] + (size_t)l * GH * CH;
    float* vs = (float*)smem;
    float* wsm = vs + 128 * 64;
    const int tid = phase_tid(wv);
    for (int u = bid; u < NB * NCH * GH; u += nb) {
        const int h = u % GH, c = (u / GH) % NCH, b = u / (GH * NCH);
        const int tok0 = b * S + c * CH;
        __syncthreads();
        for (int idx = tid; idx < 128 * 64; idx += NTHREADS) { const int q = idx >> 6, e = idx & 63; vs[idx] = VN[(size_t)(tok0 + q) * GW + h * 64 + e]; }
        for (int idx = tid; idx < 128 * 128; idx += NTHREADS) wsm[idx] = gws[(size_t)h * CH * CH + idx];
        __syncthreads();
        const int p = tid >> 2, eg = (tid & 3) * 16;
        float acc[16];
#pragma unroll
        for (int e = 0; e < 16; ++e) acc[e] = 0.f;
        for (int q = 0; q < 128; ++q) {
            const float w = wsm[p * 128 + q];
#pragma unroll
            for (int e = 0; e < 16; ++e) acc[e] += w * vs[q * 64 + eg + e];
        }
        const float bsv = gbs[h * CH + p];
#pragma unroll
        for (int e = 0; e < 16; ++e) {
            const size_t t = (size_t)(tok0 + p);
            GRP[t * D + h * 64 + eg + e] = (bf16_t)f2bf(UG[t * GW + h * 64 + eg + e] * (acc[e] + bsv));
        }
    }
    __syncthreads();
}

__device__ __forceinline__ float row16_sum(float x) {
#ifdef EMU
    x += __shfl_xor(x, 1); x += __shfl_xor(x, 2); x += __shfl_xor(x, 4); x += __shfl_xor(x, 8); return x;
#else
#define DPPF(v, ctrl) __builtin_bit_cast(float, __builtin_amdgcn_update_dpp(0, __builtin_bit_cast(int, (v)), (ctrl), 0xF, 0xF, false))
    x += DPPF(x, 0xB1); x += DPPF(x, 0x4E); x += DPPF(x, 0x141); x += DPPF(x, 0x140); return x;
#undef DPPF
#endif
}
constexpr int SC_STEPS = 16;
constexpr int SC_BUF = SC_STEPS * 6 * 64;
__device__ __forceinline__ float row32_sum(float x) {
    x = row16_sum(x);
#ifdef EMU
    x += __shfl_xor(x, 32); return x;
#else
    float a = x, b = x;
    asm volatile("s_nop 1\n\tv_permlane32_swap_b32 %0, %1" : "+v"(a), "+v"(b));
    return a + b;
#endif
}
__device__ __forceinline__ void phase_rwkv_scan(const Params& P, int l, unsigned char* smem, int wv, int bid, int nb) {
    PIN_S(bid); PIN_S(nb);
    ParamsPtr pp = PARAMS_PTR(P); PIN_S(pp); unsigned char* ws = pp->ws;
    const float* RR = (const float*)(ws + O_RR); const float* VV = (const float*)(ws + O_VV); const float* KK = (const float*)(ws + O_KK);
    const float* DEC = (const float*)(ws + O_DEC); const float* KD = (const float*)(ws + O_KD); const float* ICLR = (const float*)(ws + O_ICLR);
    float* SCAN = (float*)(ws + O_SCAN); const float* BRKR = (const float*)(ws + O_BRKR);
    const int tid = phase_tid(wv), lane = tid & 63, wave = tid >> 6, rl = (lane >> 4) & 1, kq = (lane & 15) | ((lane >> 5) << 4);
    float* buf = (float*)smem;
    float* scal = buf + 2 * SC_BUF;
    float* outb = scal + 2 * SC_STEPS * 2;
    typedef float f32x2 __attribute__((ext_vector_type(2)));
    for (int u = bid; u < 2 * NB * RH * 4; u += nb) {
        const int qt = u & 3, h = (u >> 2) % RH, b = (u / (4 * RH)) % NB, d = u / (4 * RH * NB);
        const size_t doff = (size_t)d * T * RW;
        float s0 = 0.f, s1 = 0.f;
        float pw[2], pa[2], pb[2], pk[2], pr[2], pv[2], psc = 0.f;
#define SC_LOAD(c) do { _Pragma("unroll") for (int i = 0; i < 2; ++i) { const int idx = tid + NTHREADS * i, st = idx >> 6, k = idx & 63; const int tau = (c) * SC_STEPS + st, sq = d ? S - 1 - tau : tau; \
            const size_t o = (size_t)(b * S + sq) * RW + h * 64 + k; \
            pw[i] = DEC[doff + o]; pa[i] = KK[o]; pb[i] = ICLR[doff + o]; pk[i] = KD[doff + o]; pr[i] = RR[o]; pv[i] = VV[o]; }     \
            if (tid < 2 * SC_STEPS) { const int tau = (c) * SC_STEPS + (tid >> 1), sq = d ? S - 1 - tau : tau; psc = BRKR[((size_t)(d * T + b * S + sq) * RH + h) * 2 + (tid & 1)]; } } while (0)
#define SC_WRITE(c) do { float* B_ = buf + ((c) & 1) * SC_BUF; _Pragma("unroll") for (int i = 0; i < 2; ++i) { const int idx = tid + NTHREADS * i, st = idx >> 6, k = idx & 63; \
            float* q_ = B_ + st * 384 + k; q_[0] = pw[i]; q_[64] = -pa[i]; q_[128] = pa[i] * pb[i]; q_[192] = pk[i]; q_[256] = pw[i] * pr[i]; q_[320] = pv[i]; } \
            if (tid < 2 * SC_STEPS) scal[((c) & 1) * SC_STEPS * 2 + tid] = psc; } while (0)
        __syncthreads();
        SC_LOAD(0); SC_WRITE(0);
        __syncthreads();
        const int row = qt * 16 + wave * 2 + rl;
        for (int c = 0; c < S / SC_STEPS; ++c) {
            const bool more = (c + 1) < S / SC_STEPS;
            if (more) SC_LOAD(c + 1);
            const float* B = buf + (c & 1) * SC_BUF; const float* sc = scal + (c & 1) * SC_STEPS * 2; float* ob = outb + (c & 1) * SC_STEPS * 16;
            float outs[SC_STEPS];
            f32x2 w2 = *(const f32x2*)(B + 2 * kq), a2 = *(const f32x2*)(B + 64 + 2 * kq), b2 = *(const f32x2*)(B + 128 + 2 * kq);
            f32x2 k2 = *(const f32x2*)(B + 192 + 2 * kq), wr2 = *(const f32x2*)(B + 256 + 2 * kq);
            float v = B[320 + row]; float br = sc[0], kr = sc[1];
#pragma unroll
            for (int st = 0; st < SC_STEPS; ++st) {
                const int sn = st + 1 < SC_STEPS ? st + 1 : st;
                const float* q = B + sn * 384;
                const f32x2 nw2 = *(const f32x2*)(q + 2 * kq), na2 = *(const f32x2*)(q + 64 + 2 * kq), nb2 = *(const f32x2*)(q + 128 + 2 * kq);
                const f32x2 nk2 = *(const f32x2*)(q + 192 + 2 * kq), nwr2 = *(const f32x2*)(q + 256 + 2 * kq);
                const float nv = q[320 + row], nbr = sc[sn * 2], nkr = sc[sn * 2 + 1];
                SCHED_BAR();
                float sa = s0 * a2.x + s1 * a2.y;
                float po = s0 * wr2.x + s1 * wr2.y;
                sa = row32_sum(sa); po = row32_sum(po);
                outs[st] = po + sa * br + v * kr;
                s0 = s0 * w2.x + (sa * b2.x + v * k2.x); s1 = s1 * w2.y + (sa * b2.y + v * k2.y);
                SCHED_BAR();
                w2 = nw2; a2 = na2; b2 = nb2; k2 = nk2; wr2 = nwr2; v = nv; br = nbr; kr = nkr;
            }
            if (kq == 0) {
#pragma unroll
                for (int st = 0; st < SC_STEPS; ++st) ob[st * 16 + wave * 2 + rl] = outs[st];
            }
            if (more) SC_WRITE(c + 1);
            __syncthreads();
            if (tid < 16 * SC_STEPS) {
                const int st = tid >> 4, r = tid & 15, tau = c * SC_STEPS + st, sq = d ? S - 1 - tau : tau;
                SCAN[doff + (size_t)(b * S + sq) * RW + h * 64 + qt * 16 + r] = ob[st * 16 + r];
            }
        }
#undef SC_LOAD
#undef SC_WRITE
    }
    __syncthreads();
}

__device__ __forceinline__ bf16x8 cvt8(const f32x4 a, const f32x4 b) {
    u32x4 w; w.x = pk2(a.x, a.y); w.y = pk2(a.z, a.w); w.z = pk2(b.x, b.y); w.w = pk2(b.z, b.w); return __builtin_bit_cast(bf16x8, w);
}
__device__ __forceinline__ float bf_lo(unsigned u) { return __builtin_bit_cast(float, u << 16); }
__device__ __forceinline__ float bf_hi(unsigned u) { return __builtin_bit_cast(float, u & 0xffff0000u); }
__device__ __forceinline__ void phase_mlstm_local(const Params& P, int l, unsigned char* smem, int wv, int bid, int nb) {
    PIN_S(bid); PIN_S(nb);
    ParamsPtr pp = PARAMS_PTR(P); PIN_S(pp); unsigned char* ws = pp->ws;
    const bf16_t* KT = (const bf16_t*)(ws + O_KT); const bf16_t* VT = (const bf16_t*)(ws + O_VT);
    const float* IG = (const float*)(ws + O_IG); const float* LF = (const float*)(ws + O_LF);
    float* CL = (float*)(ws + O_CL); float* NLb = (float*)(ws + O_NL); float* ML = (float*)(ws + O_ML); float* BL = (float*)(ws + O_BL);
    float* GVT = (float*)(ws + O_GVT); float* PMX = (float*)(ws + O_PMX); float* BCT = (float*)(ws + O_BCT);
    const int tid = phase_tid(wv), lane = tid & 63, wave = tid >> 6, col = lane & 15, g = lane >> 4;
    float* wts = (float*)smem + wave * 128;
    for (int u = bid * NWAVES + wave; u < 2 * NB * MH * NCH; u += nb * NWAVES) {
        const int c = u % NCH, h = (u / NCH) % MH, p = u / (NCH * MH), d = p / NB, b = p % NB;
        const int tc = d ? NCH - 1 - c : c, tok0 = b * S + tc * CH;
        const int i0 = d ? 127 - 2 * lane : 2 * lane, i1 = d ? i0 - 1 : i0 + 1;
        const size_t g0 = ((size_t)d * T + tok0 + i0) * MH + h, g1 = ((size_t)d * T + tok0 + i1) * MH + h;
        const float lf0 = LF[g0], lf1 = LF[g1], ig0 = IG[g0], ig1 = IG[g1];
        const float c1 = lf0 + lf1;
        float incl = c1;
#pragma unroll
        for (int o = 1; o < 64; o <<= 1) { const float tq = SHUP(incl, o, lane); if (lane >= o) incl += tq; }
        const float excl = incl - c1, bc0 = excl + lf0, bc1 = incl;
        const float blast = RDL(incl, 63);
        const float gv0 = ig0 - bc0, gv1 = ig1 - bc1, pl1 = fmaxf(gv0, gv1);
        float mincl = pl1;
#pragma unroll
        for (int o = 1; o < 64; o <<= 1) { const float tq = SHUP(mincl, o, lane); if (lane >= o) mincl = fmaxf(mincl, tq); }
        float mexcl = SHUP(mincl, 1, lane); if (lane == 0) mexcl = -INFINITY;
        const float pm0 = fmaxf(mexcl, gv0), pm1 = mincl;
        const float mloc = blast + RDL(mincl, 63);
        WAVE_SYNC();
        wts[i0] = expf(blast + gv0 - mloc); wts[i1] = expf(blast + gv1 - mloc);
        GVT[g0] = gv0; GVT[g1] = gv1; PMX[g0] = pm0; PMX[g1] = pm1; BCT[g0] = bc0; BCT[g1] = bc1;
        if (lane == 0) { ML[u] = mloc; BL[u] = blast; }
        WAVE_SYNC();
        const bf16_t* vbase = VT + ((size_t)(b * MH + h) * 64) * S + (size_t)tc * CH;
        const bf16_t* kbase = KT + ((size_t)(b * MH + h) * 64) * S + (size_t)tc * CH;
        const unsigned loff = (unsigned)(col * S + 8 * g);
        f32x4 acc[4][4];
#pragma unroll
        for (int a_ = 0; a_ < 4; ++a_)
#pragma unroll
            for (int b_ = 0; b_ < 4; ++b_) acc[a_][b_] = (f32x4){0.f, 0.f, 0.f, 0.f};
        float nsum[4] = {0.f, 0.f, 0.f, 0.f};
#pragma unroll 1
        for (int ks = 0; ks < 4; ++ks) {
            const int ii = ks * 32 + 8 * g;
            const f32x4 w0 = *(const f32x4*)(wts + ii), w1 = *(const f32x4*)(wts + ii + 4);
            bf16x8 af[4], bfk[4];
#pragma unroll
            for (int q = 0; q < 4; ++q) af[q] = *(const bf16x8*)(vbase + ((size_t)q * 16 * S + ks * 32) + loff);
#pragma unroll
            for (int q = 0; q < 4; ++q) {
                const u32x4 kr = *(const u32x4*)(kbase + ((size_t)q * 16 * S + ks * 32) + loff);
                f32x4 k0, k1;
                k0.x = bf_lo(kr.x) * w0.x; k0.y = bf_hi(kr.x) * w0.y; k0.z = bf_lo(kr.y) * w0.z; k0.w = bf_hi(kr.y) * w0.w;
                k1.x = bf_lo(kr.z) * w1.x; k1.y = bf_hi(kr.z) * w1.y; k1.z = bf_lo(kr.w) * w1.z; k1.w = bf_hi(kr.w) * w1.w;
                nsum[q] += (k0.x + k0.y) + (k0.z + k0.w) + (k1.x + k1.y) + (k1.z + k1.w);
                bfk[q] = cvt8(k0, k1);
            }
#pragma unroll
            for (int a_ = 0; a_ < 4; ++a_)
#pragma unroll
                for (int b_ = 0; b_ < 4; ++b_) acc[a_][b_] = MFMA16(af[a_], bfk[b_], acc[a_][b_]);
        }
        float* cbase = CL + (size_t)u * 4096;
        const unsigned coff = (unsigned)(4 * g * 64 + col);
#pragma unroll
        for (int b_ = 0; b_ < 4; ++b_) {
#pragma unroll
            for (int a_ = 0; a_ < 4; ++a_)
#pragma unroll
                for (int r = 0; r < 4; ++r) cbase[(a_ * 16 * 64 + r * 64 + b_ * 16) + coff] = acc[a_][b_][r];
            float ns = nsum[b_]; ns += SHX(ns, 16, lane); ns += SHX(ns, 32, lane);
            if (g == 0) NLb[(size_t)u * 64 + b_ * 16 + col] = ns;
        }
    }
    __syncthreads();
}

__device__ __forceinline__ void phase_mlstm_carry(const Params& P, int l, unsigned char* smem, int wv) {
    ParamsPtr pp = PARAMS_PTR(P); PIN_S(pp); unsigned char* ws = pp->ws; int bidx = (int)blockIdx.x, gdim = (int)gridDim.x; PIN_S(bidx); PIN_S(gdim);
    float* CL = (float*)(ws + O_CL); float* NLb = (float*)(ws + O_NL); const float* ML = (const float*)(ws + O_ML); const float* BL = (const float*)(ws + O_BL);
    float* MIN = (float*)(ws + O_MIN);
    const int total = 2 * NB * MH * 4160;
    const int tid = phase_tid(wv);
    for (int g = bidx * NTHREADS + tid; g < total; g += gdim * NTHREADS) {
        const int ph = g / 4160, e = g % 4160;
        float m = 0.f, val = 0.f;
        for (int c = 0; c < NCH; ++c) {
            const int base = ph * NCH + c;
            float* ptr = e < 4096 ? CL + (size_t)base * 4096 + e : NLb + (size_t)base * 64 + (e - 4096);
            const float loc = *ptr;
            *ptr = val;
            if (e == 0) MIN[base] = m;
            const float bl = BL[base], ml = ML[base];
            const float mn = fmaxf(bl + m, ml);
            val = expf(bl + m - mn) * val + expf(ml - mn) * loc;
            m = mn;
        }
    }
}

__device__ __forceinline__ void phase_mlstm_out(const Params& P, int l, unsigned char* smem, int wv) {
    ParamsPtr pp = PARAMS_PTR(P); PIN_S(pp); unsigned char* ws = pp->ws; int bidx = (int)blockIdx.x, gdim = (int)gridDim.x; PIN_S(bidx); PIN_S(gdim);
    const float* proj = (const float*)(ws + O_PROJ);
    const bf16_t* MQB = (const bf16_t*)(ws + O_MQB); const bf16_t* MKB = (const bf16_t*)(ws + O_MKB); const bf16_t* VT = (const bf16_t*)(ws + O_VT);
    const float* GVT = (const float*)(ws + O_GVT); const float* PMX = (const float*)(ws + O_PMX); const float* BCT = (const float*)(ws + O_BCT);
    const float* CL = (const float*)(ws + O_CL); const float* NLb = (const float*)(ws + O_NL); const float* MIN = (const float*)(ws + O_MIN);
    bf16_t* GRP = (bf16_t*)(ws + O_GRP);
    const float* mln_g = pp->in[20] + (size_t)l * MW;
    const int tid = phase_tid(wv), lane = tid & 63, wave = tid >> 6, col = lane & 15, g = lane >> 4;
    for (int u = bidx; u < NB * MH * NCH; u += gdim) {
        const int tc = u % NCH, h = (u / NCH) % MH, b = u / (NCH * MH);
        const int tok0 = b * S + tc * CH, it = wave * 16 + col;
        const size_t trow = (size_t)(tok0 + it);
        bf16x8 bq[2];
#pragma unroll
        for (int ks = 0; ks < 2; ++ks) bq[ks] = *(const bf16x8*)(MQB + trow * MW + h * 64 + ks * 32 + 8 * g);
        const size_t vrow = ((size_t)(b * MH + h) * 64) * S + (size_t)tc * CH;
        f32x4 hs[4];
#pragma unroll
        for (int et = 0; et < 4; ++et) hs[et] = (f32x4){0.f, 0.f, 0.f, 0.f};
#pragma unroll
        for (int d = 0; d < 2; ++d) {
            const int cd = d ? NCH - 1 - tc : tc;
            const int su = ((d * NB + b) * MH + h) * NCH + cd;
            const size_t gt = ((size_t)d * T + trow) * MH + h;
            const float mst = MIN[su];
            const float mxt = fmaxf(PMX[gt], mst), mt = BCT[gt] + mxt, wint = expf(mst - mxt);
            f32x4 num[4];
#pragma unroll
            for (int et = 0; et < 4; ++et) num[et] = (f32x4){0.f, 0.f, 0.f, 0.f};
            float den = 0.f;
            for (int sp = 0; sp < 4; ++sp) {
                if (d == 0 ? (2 * sp > wave) : (2 * sp + 1 < wave)) continue;
                float pw[8];
#pragma unroll
                for (int hf = 0; hf < 2; ++hf) {
                    const int st = 2 * sp + hf;
                    f32x4 sacc = (f32x4){0.f, 0.f, 0.f, 0.f};
#pragma unroll
                    for (int ks = 0; ks < 2; ++ks) {
                        const bf16x8 kf = *(const bf16x8*)(MKB + (size_t)(tok0 + st * 16 + col) * MW + h * 64 + ks * 32 + 8 * g);
                        sacc = MFMA16(kf, bq[ks], sacc);
                    }
#pragma unroll
                    for (int r = 0; r < 4; ++r) {
                        const int is = st * 16 + 4 * g + r;
                        const bool ok = d == 0 ? (is <= it) : (is >= it);
                        const float gvs = GVT[((size_t)d * T + tok0 + is) * MH + h];
                        const float pr = ok ? sacc[r] * expf(gvs - mxt) : 0.f;
                        den += pr; pw[hf * 4 + r] = pr;
                    }
                }
                u32x4 pb; pb.x = pk2(pw[0], pw[1]); pb.y = pk2(pw[2], pw[3]); pb.z = pk2(pw[4], pw[5]); pb.w = pk2(pw[6], pw[7]);
                const bf16x8 bp = __builtin_bit_cast(bf16x8, pb);
#pragma unroll
                for (int et = 0; et < 4; ++et) {
                    const bf16_t* vp = VT + vrow + (size_t)(et * 16 + col) * S + sp * 32 + 4 * g;
                    const u32x2 v0 = *(const u32x2*)vp, v1 = *(const u32x2*)(vp + 16);
                    u32x4 va; va.x = v0.x; va.y = v0.y; va.z = v1.x; va.w = v1.y;
                    num[et] = MFMA16(__builtin_bit_cast(bf16x8, va), bp, num[et]);
                }
            }
            den += SHX(den, 16, lane); den += SHX(den, 32, lane);
            f32x4 qc[4]; float qn = 0.f;
#pragma unroll
            for (int ks = 0; ks < 2; ++ks) {
                const float* np = NLb + (size_t)su * 64 + ks * 32 + 8 * g;
                const f32x4 n0 = *(const f32x4*)np, n1 = *(const f32x4*)(np + 4);
                const u32x4 qb = __builtin_bit_cast(u32x4, bq[ks]);
                qn += (bf_lo(qb.x) * n0.x + bf_hi(qb.x) * n0.y) + (bf_lo(qb.y) * n0.z + bf_hi(qb.y) * n0.w) + (bf_lo(qb.z) * n1.x + bf_hi(qb.z) * n1.y) + (bf_lo(qb.w) * n1.z + bf_hi(qb.w) * n1.w);
            }
            qn += SHX(qn, 16, lane); qn += SHX(qn, 32, lane);
#pragma unroll
            for (int et = 0; et < 4; ++et) {
                qc[et] = (f32x4){0.f, 0.f, 0.f, 0.f};
#pragma unroll
                for (int ks = 0; ks < 2; ++ks) {
                    const float* cp = CL + (size_t)su * 4096 + (size_t)(et * 16 + col) * 64 + ks * 32 + 8 * g;
                    qc[et] = MFMA16(cvt8(*(const f32x4*)cp, *(const f32x4*)(cp + 4)), bq[ks], qc[et]);
                }
            }
            const float dd = 1.0f / fmaxf(fabsf(den + wint * qn), expf(-mt));
#pragma unroll
            for (int et = 0; et < 4; ++et) hs[et] += (num[et] + wint * qc[et]) * dd;
        }
        float sm = 0.f;
#pragma unroll
        for (int et = 0; et < 4; ++et) sm += (hs[et].x + hs[et].y) + (hs[et].z + hs[et].w);
        sm += SHX(sm, 16, lane); sm += SHX(sm, 32, lane);
        const float mean = sm * (1.0f / 64.0f); float q = 0.f;
#pragma unroll
        for (int et = 0; et < 4; ++et) { const f32x4 dl = hs[et] - mean; q += (dl.x * dl.x + dl.y * dl.y) + (dl.z * dl.z + dl.w * dl.w); }
        q += SHX(q, 16, lane); q += SHX(q, 32, lane);
        const float rstd = 1.0f / sqrtf(q * (1.0f / 64.0f) + LN_EPS);
#pragma unroll
        for (int et = 0; et < 4; ++et) {
            const int c = h * 64 + et * 16 + 4 * g;
            const f32x4 o4 = *(const f32x4*)(proj + trow * PLD + C_MW + 3 * MW + c), g4 = *(const f32x4*)(mln_g + c);
            const f32x4 y = (hs[et] - mean) * rstd * g4;
            u32x2 ob; ob.x = pk2(sigmoidf_(o4.x) * y.x, sigmoidf_(o4.y) * y.y); ob.y = pk2(sigmoidf_(o4.z) * y.z, sigmoidf_(o4.w) * y.w);
            *(u32x2*)(GRP + trow * D + GW + RW + c) = ob;
        }
    }
}

__device__ __forceinline__ void phase_rwkv_post(const Params& P, int l, unsigned char* smem, int wv) {
    ParamsPtr pp = PARAMS_PTR(P); PIN_S(pp); unsigned char* ws = pp->ws; int bidx = (int)blockIdx.x, gdim = (int)gridDim.x; PIN_S(bidx); PIN_S(gdim);
    const float* SCAN = (const float*)(ws + O_SCAN); const float* VV = (const float*)(ws + O_VV); const float* GATE = (const float*)(ws + O_GATE);
    const float* BONUS = (const float*)(ws + O_BONUS); bf16_t* GRP = (bf16_t*)(ws + O_GRP);
    const float* rln_g = pp->in[15] + (size_t)l * RW; const float* rln_b = pp->in[16] + (size_t)l * RW;
    const int tid = phase_tid(wv), lane = tid & 63, wave = tid >> 6;
    const int gw = bidx * NWAVES + wave, ngw = NWAVES * gdim;
    for (int it = gw; it < T * RH; it += ngw) {
        const int t = it / RH, h = it % RH, c = h * 64 + lane;
        const size_t o = (size_t)t * RW + c;
        const float x = SCAN[o] + SCAN[(size_t)T * RW + o];
        const float mean = wave_sum(x, lane) * (1.0f / 64.0f);
        const float dl = x - mean;
        const float var = wave_sum(dl * dl, lane) * (1.0f / 64.0f);
        float y = dl / sqrtf(var + GN_EPS) * rln_g[c] + rln_b[c];
        y += BONUS[(size_t)t * RH + h] * VV[o];
        GRP[(size_t)t * D + GW + c] = (bf16_t)f2bf(y * GATE[o]);
    }
}

__device__ __forceinline__ void phase_ln1_router(const Params& P, int l, unsigned char* smem, int wv) {
    ParamsPtr pp = PARAMS_PTR(P); PIN_S(pp); unsigned char* ws = pp->ws; int bidx = (int)blockIdx.x, gdim = (int)gridDim.x; PIN_S(bidx); PIN_S(gdim);
    const float* xin = l == 0 ? pp->in[0] : (const float*)(ws + O_XA);
    const float* MIX = (const float*)(ws + O_MIX); float* X1 = (float*)(ws + O_X1);
    int* TOPI = (int*)(ws + O_TOPI); float* TOPG = (float*)(ws + O_TOPG); int* RANK = (int*)(ws + O_RANK); bf16_t* X1B = (bf16_t*)(ws + O_X1B);
    int* BCNT = (int*)(ws + O_BCNT);
    const float* g1 = pp->in[22] + (size_t)l * D; const float* b1 = pp->in[23] + (size_t)l * D;
    const float* rw = pp->in[24] + (size_t)l * D * NE; const float* rb = pp->in[25] + (size_t)l * NE;
    const int tid = phase_tid(wv), lane = tid & 63, wave = tid >> 6;
    float* Wl = (float*)smem;
    float* lgs = (float*)(smem + 131072);
    int* stopi = (int*)(smem + 131072 + 8192);
    __syncthreads();
    for (int i = tid; i < D * NE / 4; i += NTHREADS) ((f32x4*)Wl)[i] = ((const f32x4*)rw)[i];
    for (int tile = bidx; tile < T / 64; tile += gdim) {
        __syncthreads();
        for (int ti8 = 0; ti8 < 8; ++ti8) {
            const int t = tile * 64 + wave * 8 + ti8;
            float v[16]; float sm = 0.f;
#pragma unroll
            for (int j = 0; j < 4; ++j) {
                const int c = j * 256 + lane * 4;
                const f32x4 a = *(const f32x4*)(xin + (size_t)t * D + c), m = *(const f32x4*)(MIX + (size_t)t * D + c);
                v[j * 4 + 0] = ALPHA * a.x + m.x; v[j * 4 + 1] = ALPHA * a.y + m.y; v[j * 4 + 2] = ALPHA * a.z + m.z; v[j * 4 + 3] = ALPHA * a.w + m.w;
                sm += (v[j * 4] + v[j * 4 + 1]) + (v[j * 4 + 2] + v[j * 4 + 3]);
            }
            const float mean = wave_sum(sm, lane) * (1.0f / D); float q = 0.f;
#pragma unroll
            for (int j = 0; j < 16; ++j) { const float dl = v[j] - mean; q += dl * dl; }
            const float rstd = 1.0f / sqrtf(wave_sum(q, lane) * (1.0f / D) + LN_EPS);
#pragma unroll
            for (int j = 0; j < 4; ++j) {
                const int c = j * 256 + lane * 4;
                const f32x4 gg = *(const f32x4*)(g1 + c), bb = *(const f32x4*)(b1 + c);
                f32x4 o;
                o.x = (v[j * 4 + 0] - mean) * rstd * gg.x + bb.x; o.y = (v[j * 4 + 1] - mean) * rstd * gg.y + bb.y;
                o.z = (v[j * 4 + 2] - mean) * rstd * gg.z + bb.z; o.w = (v[j * 4 + 3] - mean) * rstd * gg.w + bb.w;
                *(f32x4*)(X1 + (size_t)t * D + c) = o;
                u32x2 ob; ob.x = pk2(o.x, o.y); ob.y = pk2(o.z, o.w); *(u32x2*)(X1B + (size_t)t * D + c) = ob;
            }
        }
        __syncthreads();
        {
            const int tq = tid >> 3, eg = (tid & 7) * 4;
            const float* xr = X1 + (size_t)(tile * 64 + tq) * D;
            f32x4 acc = *(const f32x4*)(rb + eg);
#pragma unroll 4
            for (int c = 0; c < D; c += 4) {
                const f32x4 x4 = *(const f32x4*)(xr + c);
                acc += x4.x * *(const f32x4*)(Wl + (c + 0) * NE + eg); acc += x4.y * *(const f32x4*)(Wl + (c + 1) * NE + eg);
                acc += x4.z * *(const f32x4*)(Wl + (c + 2) * NE + eg); acc += x4.w * *(const f32x4*)(Wl + (c + 3) * NE + eg);
            }
            *(f32x4*)(lgs + tq * NE + eg) = acc;
        }
        __syncthreads();
        if (tid < 64) {
            const float* lp = lgs + tid * NE; const int t = tile * 64 + tid;
            float tv[4]; int ti[4];
#pragma unroll
            for (int k = 0; k < 4; ++k) { tv[k] = -INFINITY; ti[k] = 0; }
            for (int e = 0; e < NE; ++e) {
                const float x = lp[e];
                if (x > tv[3]) {
                    if (x > tv[0]) { tv[3] = tv[2]; ti[3] = ti[2]; tv[2] = tv[1]; ti[2] = ti[1]; tv[1] = tv[0]; ti[1] = ti[0]; tv[0] = x; ti[0] = e; }
                    else if (x > tv[1]) { tv[3] = tv[2]; ti[3] = ti[2]; tv[2] = tv[1]; ti[2] = ti[1]; tv[1] = x; ti[1] = e; }
                    else if (x > tv[2]) { tv[3] = tv[2]; ti[3] = ti[2]; tv[2] = x; ti[2] = e; }
                    else { tv[3] = x; ti[3] = e; }
                }
            }
            const float e1 = expf(tv[1] - tv[0]), e2 = expf(tv[2] - tv[0]), e3 = expf(tv[3] - tv[0]);
            const float inv = 1.0f / (1.0f + e1 + e2 + e3);
            *(f32x4*)(TOPG + (size_t)t * 4) = (f32x4){inv, e1 * inv, e2 * inv, e3 * inv};
#pragma unroll
            for (int k = 0; k < 4; ++k) { TOPI[(size_t)t * 4 + k] = ti[k]; stopi[tid * 4 + k] = ti[k]; }
        }
        __syncthreads();
        if (tid < 256) { const int e = stopi[tid]; int r = 0; for (int a2 = 0; a2 < tid; ++a2) r += (stopi[a2] == e) ? 1 : 0; RANK[(size_t)tile * 256 + tid] = r; }
        else if (tid < 256 + NE) { const int e = tid - 256; int cnt = 0; for (int a2 = 0; a2 < 256; ++a2) cnt += (stopi[a2] == e) ? 1 : 0; BCNT[tile * NE + e] = cnt; }
    }
    __syncthreads();
}

__device__ __forceinline__ void moe_offsets(int* sh, const int* CNT, int tid) {
    if (tid == 0) {
        int acc = 0;
        for (int e = 0; e < NE; ++e) { const int c = (int)CNT[e]; sh[e] = c; sh[32 + e] = acc; acc += (c + MOEB - 1) / MOEB * MOEB; sh[64 + e] = acc; }
    }
    __syncthreads();
}
__device__ __forceinline__ int moe_expert_of_row(const int* sh, int r) {
    int e = -1;
    for (int i = 0; i < NE; ++i) if (r >= sh[32 + i] && r < sh[64 + i]) e = i;
    return e;
}

__device__ __forceinline__ void phase_scatter(const Params& P, int l, unsigned char* smem, int wv) {
    ParamsPtr pp = PARAMS_PTR(P); PIN_S(pp); unsigned char* ws = pp->ws; int bidx = (int)blockIdx.x, gdim = (int)gridDim.x; PIN_S(bidx); PIN_S(gdim);
    const int tid = phase_tid(wv), lane = tid & 63, wave = tid >> 6;
    const int* TOPI = (const int*)(ws + O_TOPI); const int* RANK = (const int*)(ws + O_RANK); int* SLOT = (int*)(ws + O_SLOT);
    const int* BCNT = (const int*)(ws + O_BCNT); int* CNTF = (int*)(ws + O_CNTF);
    const bf16_t* X1B = (const bf16_t*)(ws + O_X1B); bf16_t* XS = (bf16_t*)(ws + O_XS);
    int* sh = (int*)smem;
    int* part = sh + 96;
    int* tot = part + 512;
    int* base = tot + 32;
    constexpr int NT = T / 64;
    const int e = tid & 31, pt = tid >> 5;
    { int sacc = 0; for (int tl = pt; tl < NT; tl += 16) sacc += BCNT[tl * NE + e]; part[pt * 32 + e] = sacc; }
    __syncthreads();
    if (tid < 32) { int sacc = 0; for (int q = 0; q < 16; ++q) sacc += part[q * 32 + tid]; tot[tid] = sacc; if (bidx == 0) CNTF[tid] = sacc; }
    __syncthreads();
    moe_offsets(sh, tot, tid);
    for (int tile = bidx; tile < NT; tile += gdim) {
        __syncthreads();
        { int sacc = 0; for (int tl = pt; tl < tile; tl += 16) sacc += BCNT[tl * NE + e]; part[pt * 32 + e] = sacc; }
        __syncthreads();
        if (tid < 32) { int sacc = sh[32 + tid]; for (int q = 0; q < 16; ++q) sacc += part[q * 32 + tid]; base[tid] = sacc; }
        __syncthreads();
        for (int al = wave; al < 256; al += NWAVES) {
            const int a = tile * 256 + al, dest = base[TOPI[a]] + RANK[a], t = a >> 2;
            if (lane == 0) SLOT[a] = dest;
            const u32x4* src = (const u32x4*)(X1B + (size_t)t * D); u32x4* dst = (u32x4*)(XS + (size_t)dest * D);
            dst[lane] = src[lane]; dst[64 + lane] = src[64 + lane];
        }
    }
    __syncthreads();
}

template <int WHICH>
__device__ __forceinline__ void phase_moe_gemm(const Params& P, int l, unsigned char* smem, int wv) {
    ParamsPtr pp = PARAMS_PTR(P); PIN_S(pp); unsigned char* ws = pp->ws; int bidx = (int)blockIdx.x, gdim = (int)gridDim.x; PIN_S(bidx); PIN_S(gdim);
    const int tid = phase_tid(wv);
    const int* CNT = (const int*)(ws + O_CNTF);
    int* sh = (int*)(smem + 131072);
    int* rbe = sh + 96;
    moe_offsets(sh, CNT, tid);
    const int nrb = sh[64 + NE - 1] / MOEB;
    for (int rb = tid; rb < nrb; rb += NTHREADS) rbe[rb] = moe_expert_of_row(sh, rb * MOEB);
    __syncthreads();
    pg8::MoeOrder S;
    S.K = 1024; S.G = gdim; S.c = bidx; S.rbe = rbe;
    if (WHICH == 1) {
        S.A = (const char*)(ws + O_XS); S.Wt = (const char*)(ws + O_W1) + (size_t)l * NE * 2 * DFF * D * 2; S.estride = (size_t)2 * DFF * D * 2; S.nN = 2 * DFF / 256; S.nwg = nrb * S.nN;
        pg8::EpiSwiglu E{(bf16_t*)(ws + O_ACT), pp->in[27] + (size_t)l * NE * 2 * DFF};
        pg8::gemm_phase<pg8::EpiSwiglu, pg8::MoeOrder>((LAS unsigned char*)smem, 1024, S, E, tid);
    } else {
        S.A = (const char*)(ws + O_ACT); S.Wt = (const char*)(ws + O_W2) + (size_t)l * NE * D * DFF * 2; S.estride = (size_t)D * DFF * 2; S.nN = D / 256; S.nwg = nrb * S.nN;
        pg8::EpiBf16Bias E{(bf16_t*)(ws + O_YS), D, pp->in[29] + (size_t)l * NE * D, D};
        pg8::gemm_phase<pg8::EpiBf16Bias, pg8::MoeOrder>((LAS unsigned char*)smem, 1024, S, E, tid);
    }
    __syncthreads();
}

__device__ __forceinline__ void phase_combine_ln2(const Params& P, int l, unsigned char* smem, int wv) {
    ParamsPtr pp = PARAMS_PTR(P); PIN_S(pp); unsigned char* ws = pp->ws; int bidx = (int)blockIdx.x, gdim = (int)gridDim.x; PIN_S(bidx); PIN_S(gdim);
    const float* X1 = (const float*)(ws + O_X1); const bf16_t* YS = (const bf16_t*)(ws + O_YS); bf16_t* XB = (bf16_t*)(ws + O_XB);
    const int* SLOT = (const int*)(ws + O_SLOT); const float* TOPG = (const float*)(ws + O_TOPG);
    float* xo = l == NL - 1 ? pp->out : (float*)(ws + O_XA);
    const float* g2 = pp->in[30] + (size_t)l * D; const float* b2 = pp->in[31] + (size_t)l * D;
    const int tid = phase_tid(wv), lane = tid & 63, wave = tid >> 6;
    const int gw = bidx * NWAVES + wave, ngw = NWAVES * gdim;
    for (int t = gw; t < T; t += ngw) {
        int sl[4]; float gg[4];
#pragma unroll
        for (int k = 0; k < 4; ++k) { sl[k] = SLOT[(size_t)t * 4 + k]; gg[k] = TOPG[(size_t)t * 4 + k]; }
        float v[16]; float sm = 0.f;
#pragma unroll
        for (int j = 0; j < 4; ++j) {
            const int c = j * 256 + lane * 4;
            const f32x4 a = *(const f32x4*)(X1 + (size_t)t * D + c);
            f32x4 y = (f32x4){0.f, 0.f, 0.f, 0.f};
#pragma unroll
            for (int k = 0; k < 4; ++k) { const u32x2 yk = *(const u32x2*)(YS + (size_t)sl[k] * D + c);
                y.x += gg[k] * __builtin_bit_cast(float, yk.x << 16); y.y += gg[k] * __builtin_bit_cast(float, yk.x & 0xffff0000u); y.z += gg[k] * __builtin_bit_cast(float, yk.y << 16); y.w += gg[k] * __builtin_bit_cast(float, yk.y & 0xffff0000u); }
            v[j * 4 + 0] = ALPHA * a.x + y.x; v[j * 4 + 1] = ALPHA * a.y + y.y; v[j * 4 + 2] = ALPHA * a.z + y.z; v[j * 4 + 3] = ALPHA * a.w + y.w;
            sm += (v[j * 4] + v[j * 4 + 1]) + (v[j * 4 + 2] + v[j * 4 + 3]);
        }
        const float mean = wave_sum(sm, lane) * (1.0f / D); float q = 0.f;
#pragma unroll
        for (int j = 0; j < 16; ++j) { const float dl = v[j] - mean; q += dl * dl; }
        const float rstd = 1.0f / sqrtf(wave_sum(q, lane) * (1.0f / D) + LN_EPS);
#pragma unroll
        for (int j = 0; j < 4; ++j) {
            const int c = j * 256 + lane * 4;
            f32x4 o;
            o.x = (v[j * 4 + 0] - mean) * rstd * g2[c + 0] + b2[c + 0]; o.y = (v[j * 4 + 1] - mean) * rstd * g2[c + 1] + b2[c + 1];
            o.z = (v[j * 4 + 2] - mean) * rstd * g2[c + 2] + b2[c + 2]; o.w = (v[j * 4 + 3] - mean) * rstd * g2[c + 3] + b2[c + 3];
            *(f32x4*)(xo + (size_t)t * D + c) = o;
            if (l != NL - 1) { u32x2 ob; ob.x = pk2(o.x, o.y); ob.y = pk2(o.z, o.w); *(u32x2*)(XB + (size_t)t * D + c) = ob; }
        }
    }
}

__device__ __forceinline__ void phase_inproj(const Params& P, int l, unsigned char* smem, int wv) {
    ParamsPtr pp = PARAMS_PTR(P); PIN_S(pp); unsigned char* ws = pp->ws; int bidx = (int)blockIdx.x, gdim = (int)gridDim.x; PIN_S(bidx); PIN_S(gdim);
    const int tid = phase_tid(wv);
    pg8::DenseOrder S; S.init(ws + O_XB, (const bf16_t*)(ws + O_WIN) + (size_t)l * PLD * D, T, PLD, D, gdim, bidx);
    pg8::EpiF32 E{(float*)(ws + O_PROJ), PLD};
    pg8::gemm_phase<pg8::EpiF32, pg8::DenseOrder>((LAS unsigned char*)smem, D, S, E, tid);
    __syncthreads();
}
__device__ __forceinline__ void phase_outproj(const Params& P, int l, unsigned char* smem, int wv) {
    ParamsPtr pp = PARAMS_PTR(P); PIN_S(pp); unsigned char* ws = pp->ws; int bidx = (int)blockIdx.x, gdim = (int)gridDim.x; PIN_S(bidx); PIN_S(gdim);
    const int tid = phase_tid(wv);
    pg8::DenseOrder S; S.init(ws + O_GRP, (const bf16_t*)(ws + O_WOUT) + (size_t)l * D * D, T, D, D, gdim, bidx);
    pg8::EpiF32 E{(float*)(ws + O_MIX), D};
    pg8::gemm_phase<pg8::EpiF32, pg8::DenseOrder>((LAS unsigned char*)smem, D, S, E, tid);
    __syncthreads();
}

#ifndef EMU
#define XB_TMO      128
#define XB_XCNT(j)  (256  + 64 * (j))
#define XB_XSUB(j)  (1280 + 64 * (j))
#define XB_XGEN(j)  (2304 + 64 * (j))
#define XB_TOP      3328
#define XB_TOPGEN   3392
#define XCD_BAR_WORDS 3456
#define XB_SPIN_CAP (1u << 25)
__device__ __forceinline__ unsigned xb_ld(unsigned* p)              { return __hip_atomic_load(p, __ATOMIC_RELAXED, __HIP_MEMORY_SCOPE_AGENT); }
__device__ __forceinline__ unsigned xb_add(unsigned* p, unsigned v) { return __hip_atomic_fetch_add(p, v, __ATOMIC_RELAXED, __HIP_MEMORY_SCOPE_AGENT); }
__device__ __forceinline__ unsigned xb_xcc_id() { return (unsigned)__builtin_amdgcn_s_getreg((3 << 11) | 20) & 0xFu; }
#define XB_SPIN(cond, bar) do { unsigned _sp = 0; while (cond) { __builtin_amdgcn_s_sleep(1); \
    if ((++_sp & 255u) == 0u) { if (xb_ld(&(bar)[XB_TMO])) break; if (_sp > XB_SPIN_CAP) { atomicAdd(&(bar)[XB_TMO], 1u); break; } } } } while (0)
struct XcdBarrier { unsigned* bar; unsigned x; volatile LAS unsigned* st; };
__device__ __forceinline__ XcdBarrier xcd_barrier_post(unsigned* bar, volatile LAS unsigned* st) {
    XcdBarrier b; b.bar = bar; b.x = xb_xcc_id(); b.st = st;
    if (threadIdx.x == 0) (void)xb_add(&bar[XB_XCNT(b.x)], 1u);
    return b;
}
__device__ __forceinline__ void xcd_barrier_complete(unsigned* bar, unsigned x, unsigned& nloc, unsigned& nx) {
    const unsigned G = gridDim.x * gridDim.y * gridDim.z;
    unsigned sum, cnt, mine, sp = 0u;
    for (;;) {
        sum = 0u; cnt = 0u; mine = 0u;
#pragma unroll
        for (unsigned j = 0; j < 16; ++j) { const unsigned c = xb_ld(&bar[XB_XCNT(j)]); sum += c; cnt += (c > 0u) ? 1u : 0u; mine = (j == x) ? c : mine; }
        if (sum == G) break;
        __builtin_amdgcn_s_sleep(1);
        if ((++sp & 255u) == 0u) { if (xb_ld(&bar[XB_TMO])) break; if (sp > XB_SPIN_CAP) { atomicAdd(&bar[XB_TMO], 1u); break; } }
    }
    nloc = mine > 0u ? mine : 1u; nx = cnt > 0u ? cnt : 1u;
}
__device__ __forceinline__ void xcd_barrier(const XcdBarrier& b) {
    asm volatile("s_waitcnt vmcnt(0)" ::: "memory");
    __syncthreads();
    if (threadIdx.x == 0) {
        unsigned* bar = b.bar;
        __builtin_amdgcn_s_waitcnt(0);
        unsigned nloc = b.st[0], nx = b.st[1];
        if (nloc == 0u) { xcd_barrier_complete(bar, b.x, nloc, nx); b.st[0] = nloc; b.st[1] = nx; }
        const unsigned old = xb_add(&bar[XB_XSUB(b.x)], 1u);
        const unsigned gen = old / nloc;
        if (old + 1u == (gen + 1u) * nloc) {
            __builtin_amdgcn_fence(__ATOMIC_RELEASE, "agent");
            asm volatile("s_waitcnt vmcnt(0)" ::: "memory");
            const unsigned og = xb_add(&bar[XB_TOP], 1u);
            const unsigned tg = og / nx;
            if (og + 1u == (tg + 1u) * nx) xb_add(&bar[XB_TOPGEN], 1u);
            else XB_SPIN(xb_ld(&bar[XB_TOPGEN]) == tg, bar);
            __builtin_amdgcn_fence(__ATOMIC_ACQUIRE, "agent");
            xb_add(&bar[XB_XGEN(b.x)], 1u);
            asm volatile("s_waitcnt vmcnt(0)" ::: "memory");
        } else {
            XB_SPIN(xb_ld(&bar[XB_XGEN(b.x)]) == gen, bar);
            __builtin_amdgcn_fence(__ATOMIC_ACQUIRE, "agent");
            asm volatile("s_waitcnt vmcnt(0)" ::: "memory");
        }
    }
    __syncthreads();
}
#endif

__global__ void __launch_bounds__(512, 2) mk_fwd(Params P) {
#ifdef EMU
    unsigned char* smem = g_blk->lds;
#else
    extern __shared__ __attribute__((aligned(16))) unsigned char smem[];
    volatile LAS unsigned* bst = (volatile LAS unsigned*)(smem + LDS_BYTES - 16);
    if (threadIdx.x == 0) { bst[0] = 0u; bst[1] = 0u; bst[2] = 0u; bst[3] = 0u; }
    __syncthreads();
    XcdBarrier bar; bar.bar = (unsigned*)P.ws + CW_BAR; bar.x = 0; bar.st = bst;
    if (P.ph_hi - P.ph_lo > 1) bar = xcd_barrier_post((unsigned*)P.ws + CW_BAR, bst);
#endif
    const int lo = P.ph_lo, hi = P.ph_hi;
#ifdef EMU
    const int wv = (int)threadIdx.x >> 6;
#else
    const int wv = RFL((int)threadIdx.x >> 6);
#endif
#ifdef EMU
#define SEAM(id) do {} while (0)
#else
#define SEAM(id) do { if ((id) + 1 < hi) xcd_barrier(bar); } while (0)
#endif
#ifndef MK_ONLY_PHASE
#define MK_ONLY_PHASE -1
#endif
#ifndef MK_DUP_MASK
#define MK_DUP_MASK 0
#endif
#define PHG(kc, id, ...) do { if (MK_ONLY_PHASE < 0 || MK_ONLY_PHASE == (kc)) { const int id_ = (id); if (id_ >= lo && id_ < hi) { if ((MK_DUP_MASK >> (kc)) & 1) { __VA_ARGS__; SEAM(id_ - 1); } __VA_ARGS__; SEAM(id_); } } } while (0)
#define PH(k, ...) PHG(1 + (k), 1 + l * NPH + (k), __VA_ARGS__)
    PHG(0, 0, phase_prologue(P, smem, wv));
    for (int l = 0; l < NL; ++l) {
        PH(0, phase_inproj(P, l, smem, wv));
        PH(1, phase_prep(P, l, smem, wv));
        PH(2, { const int G_ = (int)gridDim.x, NSC = 2 * NB * RH * 4;
                if (G_ >= NSC + 32) { if ((int)blockIdx.x < NSC) phase_rwkv_scan(P, l, smem, wv, (int)blockIdx.x, NSC);
                                      else phase_mlstm_local(P, l, smem, wv, (int)blockIdx.x - NSC, G_ - NSC); }
                else { phase_rwkv_scan(P, l, smem, wv, (int)blockIdx.x, G_); phase_mlstm_local(P, l, smem, wv, (int)blockIdx.x, G_); } });
        PH(3, phase_mlstm_carry(P, l, smem, wv));
        PH(4, { phase_mlstm_out(P, l, smem, wv); phase_gmlp_mix(P, l, smem, wv, (int)blockIdx.x, (int)gridDim.x); phase_rwkv_post(P, l, smem, wv); });
        PH(5, phase_outproj(P, l, smem, wv));
        PH(6, phase_ln1_router(P, l, smem, wv));
        PH(7, phase_scatter(P, l, smem, wv));
        PH(8, phase_moe_gemm<1>(P, l, smem, wv));
        PH(9, phase_moe_gemm<2>(P, l, smem, wv));
        PH(10, phase_combine_ln2(P, l, smem, wv));
    }
#undef PHG
#undef PH
#undef SEAM
}

}

#ifndef EMU
extern "C" void kernel_launch(void* const* d_in, const int* in_sizes, int n_in, void* d_out, int out_size, void* d_ws, size_t ws_size, hipStream_t stream) {
    using namespace mk;
    static int grid = 0;
    if (grid == 0) {
        if (n_in != 32 || out_size != T * D || ws_size < WS_END) { fprintf(stderr, "kernel_launch: unexpected shapes (n_in %d out %d ws %zu need %zu)\n", n_in, out_size, ws_size, (size_t)WS_END); grid = -1; return; }
        int dev = 0, cus = 0;
        if (hipGetDevice(&dev) != hipSuccess || hipDeviceGetAttribute(&cus, hipDeviceAttributeMultiprocessorCount, dev) != hipSuccess) { grid = -1; return; }
        if (hipFuncSetAttribute((const void*)mk_fwd, hipFuncAttributeMaxDynamicSharedMemorySize, LDS_BYTES) != hipSuccess) { fprintf(stderr, "kernel_launch: hipFuncSetAttribute failed\n"); grid = -1; return; }
        int per_cu = 0;
        (void)hipOccupancyMaxActiveBlocksPerMultiprocessor(&per_cu, (const void*)mk_fwd, NTHREADS, LDS_BYTES);
        (void)hipGetLastError();
        grid = cus;
    }
    if (grid < 0) return;
    (void)hipMemsetAsync(d_ws, 0, CTL_BYTES, stream);
    Params p{};
    for (int i = 0; i < 32; ++i) p.in[i] = (const float*)d_in[i];
    p.out = (float*)d_out; p.ws = (unsigned char*)d_ws;
#if MK_ONE_LAUNCH
    p.ph_lo = 0; p.ph_hi = 1 + NL * NPH;
    hipLaunchKernelGGL(mk_fwd, dim3(grid), dim3(NTHREADS), LDS_BYTES, stream, p);
#else
    for (int id = 0; id < 1 + NL * NPH; ++id) {
        p.ph_lo = id; p.ph_hi = id + 1;
        hipLaunchKernelGGL(mk_fwd, dim3(grid), dim3(NTHREADS), LDS_BYTES, stream, p);
    }
#endif
}
#endif
```

```cpp
#ifndef EMU
#include <hip/hip_runtime.h>
#endif
#include <cstdio>
#include <cstdint>
#include <cmath>

#ifndef CFG_BATCH
#define CFG_BATCH 4
#endif
#ifndef CFG_SEQ
#define CFG_SEQ 4096
#endif
#ifndef CFG_LAYERS
#define CFG_LAYERS 4
#endif
#ifndef MK_RWKV_CHUNKED
#define MK_RWKV_CHUNKED 1
#endif
#ifndef MK_ONE_LAUNCH
#define MK_ONE_LAUNCH 1
#endif

namespace mk {
constexpr int NB = CFG_BATCH, S = CFG_SEQ, T = NB * S, NL = CFG_LAYERS, D = 1024;
constexpr int GW = 256, RW = 384, MW = 384, HD = 64, GH = 4, RH = 6, MH = 6, CH = 128, NCH = S / CH;
constexpr int PIN = 3480, PLD = 3584, RPROJ = 1408;
constexpr int C_RW = 512, C_MW = 1920;
constexpr int NE = 32, TOPK = 4, DFF = 1024, MOEB = 256;
constexpr int NROWS = (T * TOPK / MOEB + NE) * MOEB;
constexpr float LN_EPS = 1e-5f, GN_EPS = 64e-5f;
constexpr float ALPHA = 1.6817928305074290f;
constexpr int NTHREADS = 512, NWAVES = 8;
constexpr int LDS_BYTES = 160 * 1024;
constexpr int NPH = 11;

typedef float f32x4 __attribute__((ext_vector_type(4)));
typedef unsigned u32x4 __attribute__((ext_vector_type(4)));
typedef unsigned u32x2 __attribute__((ext_vector_type(2)));
typedef short bf16x8 __attribute__((ext_vector_type(8)));
typedef unsigned short bf16_t;

constexpr size_t al(size_t x) { return (x + 255) & ~(size_t)255; }
constexpr size_t CTL_BYTES = 1u << 20;
constexpr size_t O_XA = CTL_BYTES;
constexpr size_t O_XB = O_XA + al((size_t)T * D * 4);
constexpr size_t O_X1 = O_XB + al((size_t)T * D * 2);
constexpr size_t O_X1B = O_X1 + al((size_t)T * D * 4);
constexpr size_t O_PROJ = O_X1B + al((size_t)T * D * 2);
constexpr size_t O_MIX = O_PROJ + al((size_t)T * PLD * 4);
constexpr size_t O_GRP = O_MIX + al((size_t)T * D * 4);
constexpr size_t O_UG = O_GRP + al((size_t)T * D * 2);
constexpr size_t O_VN = O_UG + al((size_t)T * GW * 4);
constexpr size_t O_RR = O_VN + al((size_t)T * GW * 4);
constexpr size_t O_VV = O_RR + al((size_t)T * RW * 4);
constexpr size_t O_KK = O_VV + al((size_t)T * RW * 4);
constexpr size_t O_DEC = O_KK + al((size_t)T * RW * 4);
constexpr size_t O_KD = O_DEC + al((size_t)2 * T * RW * 4);
constexpr size_t O_ICLR = O_KD + al((size_t)2 * T * RW * 4);
constexpr size_t O_GATE = O_ICLR + al((size_t)2 * T * RW * 4);
constexpr size_t O_BONUS = O_GATE + al((size_t)T * RW * 4);
constexpr size_t O_SCAN = O_BONUS + al((size_t)T * RH * 4);
constexpr size_t O_MQ = O_SCAN + al((size_t)2 * T * RW * 4);
constexpr size_t O_MK = O_MQ + al((size_t)T * MW * 4);
constexpr size_t O_IG = O_MK + al((size_t)T * MW * 4);
constexpr size_t O_LF = O_IG + al((size_t)2 * T * MH * 4);
constexpr size_t O_CL = O_LF + al((size_t)2 * T * MH * 4);
constexpr size_t O_NL = O_CL + al((size_t)2 * NB * MH * NCH * 4096 * 4);
constexpr size_t O_ML = O_NL + al((size_t)2 * NB * MH * NCH * 64 * 4);
constexpr size_t O_BL = O_ML + al((size_t)2 * NB * MH * NCH * 4);
constexpr size_t O_MIN = O_BL + al((size_t)2 * NB * MH * NCH * 4);
constexpr size_t O_TOPI = O_MIN + al((size_t)2 * NB * MH * NCH * 4);
constexpr size_t O_TOPG = O_TOPI + al((size_t)T * 4 * 4);
constexpr size_t O_RANK = O_TOPG + al((size_t)T * 4 * 4);
constexpr size_t O_SLOT = O_RANK + al((size_t)T * 4 * 4);
constexpr size_t O_MQB = O_SLOT + al((size_t)T * 4 * 4);
constexpr size_t O_MKB = O_MQB + al((size_t)T * MW * 2);
constexpr size_t O_KT = O_MKB + al((size_t)T * MW * 2);
constexpr size_t O_VT = O_KT + al((size_t)T * MW * 2);
constexpr size_t O_GVT = O_VT + al((size_t)T * MW * 2);
constexpr size_t O_PMX = O_GVT + al((size_t)2 * T * MH * 4);
constexpr size_t O_BCT = O_PMX + al((size_t)2 * T * MH * 4);
constexpr size_t O_BRKR = O_BCT + al((size_t)2 * T * MH * 4);
constexpr int RC = 64, RNC = S / RC, RUN = 2 * NB * RH * RNC;
constexpr size_t O_LW = O_BRKR + al((size_t)2 * T * RH * 2 * 4);
constexpr size_t O_RQ = O_LW + al((size_t)2 * T * RW * 4);
constexpr size_t O_RA = O_RQ + al((size_t)RUN * 4096 * 2);
constexpr size_t O_RS = O_RA + al((size_t)RUN * 4096 * 2);
constexpr size_t O_RH = O_RS + al((size_t)RUN * 4096 * 2);
constexpr size_t O_RG = O_RH + al((size_t)RUN * 4096 * 4);
constexpr size_t O_BCNT = O_RG + al((size_t)RUN * 4096 * 4);
constexpr size_t O_CNTF = O_BCNT + al((size_t)(T / 64) * NE * 4);
constexpr size_t O_XS = O_CNTF + al((size_t)NE * 4);
constexpr size_t O_ACT = O_XS + al((size_t)NROWS * D * 2);
constexpr size_t O_YS = O_ACT + al((size_t)NROWS * DFF * 2);
constexpr size_t O_WIN = O_YS + al((size_t)NROWS * D * 2);
constexpr size_t O_WOUT = O_WIN + al((size_t)NL * PLD * D * 2);
constexpr size_t O_W1 = O_WOUT + al((size_t)NL * D * D * 2);
constexpr size_t O_W2 = O_W1 + al((size_t)NL * NE * 2 * DFF * D * 2);
constexpr size_t WS_END = O_W2 + al((size_t)NL * NE * D * DFF * 2);

constexpr int CW_BAR = 4096;
constexpr int CW_CNT = 16384;

struct Params { const float* in[32]; float* out; unsigned char* ws; int ph_lo, ph_hi; };
#ifdef EMU
typedef const Params* ParamsPtr;
#define PARAMS_PTR(P) (&(P))
#else
typedef const __attribute__((address_space(4))) Params* ParamsPtr;
#define PARAMS_PTR(P) ((ParamsPtr)__builtin_amdgcn_kernarg_segment_ptr())
#endif

#ifdef EMU
#define WAVE_SYNC() emu_wave_barrier()
#define PIN_V(x) do {} while (0)
#define PIN_S(x) do {} while (0)
#else
#define WAVE_SYNC() __builtin_amdgcn_wave_barrier()
#define PIN_V(x) asm volatile("" : "+v"(x))
#define PIN_S(x) asm volatile("" : "+s"(x))
#endif
#ifdef EMU
__device__ __forceinline__ int phase_tid(int wv) { (void)wv; return threadIdx.x; }
#else
__device__ __forceinline__ int phase_tid(int wv) { int t; asm volatile("v_mbcnt_lo_u32_b32 %0, -1, 0\n\tv_mbcnt_hi_u32_b32 %0, -1, %0" : "=v"(t)); return (wv << 6) + t; }
#endif

#ifdef EMU
#define SHX(v, m, lane) __shfl_xor(v, m)
#else
__device__ __forceinline__ float shx_(float v, int m, int lane) { return __builtin_bit_cast(float, __builtin_amdgcn_ds_bpermute((lane ^ m) << 2, __builtin_bit_cast(int, v))); }
__device__ __forceinline__ int shx_(int v, int m, int lane) { return __builtin_amdgcn_ds_bpermute((lane ^ m) << 2, v); }
#define SHX(v, m, lane) shx_(v, m, lane)
#endif
#ifdef EMU
#define SHUP(v, o, lane) __shfl(v, ((lane) - (o)) & 63)
#define RDL(v, src) __shfl(v, src)
#define SHL(v, src) __shfl(v, src)
#else
#define SHL(v, src) __builtin_bit_cast(float, __builtin_amdgcn_ds_bpermute((src) << 2, __builtin_bit_cast(int, (float)(v))))
#define SHUP(v, o, lane) __builtin_bit_cast(float, __builtin_amdgcn_ds_bpermute((((lane) - (o)) & 63) << 2, __builtin_bit_cast(int, (float)(v))))
#define RDL(v, src) __builtin_bit_cast(float, __builtin_amdgcn_readlane(__builtin_bit_cast(int, (float)(v)), src))
#endif
__device__ __forceinline__ float wave_sum(float v, int lane) {
#pragma unroll
    for (int o = 32; o >= 1; o >>= 1) v += SHX(v, o, lane);
    return v;
}
__device__ __forceinline__ float sigmoidf_(float x) { return 1.0f / (1.0f + expf(-x)); }
__device__ __forceinline__ float softplusf_(float x) { return fmaxf(x, 0.f) + log1pf(expf(-fabsf(x))); }
__device__ __forceinline__ float geluf_(float x) { return 0.5f * x * (1.0f + erff(x * 0.70710678118654752f)); }

#ifdef EMU
#define LAS
#define WAIT_V(n) do {} while (0)
#define WAIT_L(n) do {} while (0)
#define S_BARRIER() __syncthreads()
#define SETPRIO(x) do {} while (0)
#define SCHED_BAR() do {} while (0)
#define RFL(x) (x)
static inline void emu_glds16(const void* g, void* l) { memcpy((char*)l + (g_blk->cur & 63) * 16, g, 16); }
#define GLDS16(gptr, ldsptr) emu_glds16((const void*)(gptr), (void*)(ldsptr))
static inline float emu_bf2f(unsigned short b) { unsigned u = (unsigned)b << 16; float f; memcpy(&f, &u, 4); return f; }
static inline f32x4 emu_mfma16(bf16x8 a, bf16x8 b, f32x4 c) {
    EmuBlock* blk = g_blk; const int cur = blk->cur, lane = cur & 63, wbase = cur & ~63;
    static thread_local unsigned short Ash[32][64][8], Bsh[32][64][8];
    const int w = cur >> 6;
    for (int j = 0; j < 8; ++j) { Ash[w][lane][j] = (unsigned short)a[j]; Bsh[w][lane][j] = (unsigned short)b[j]; }
    emu_wave_barrier();
    const int col = lane & 15;
    for (int r = 0; r < 4; ++r) { const int row = 4 * (lane >> 4) + r; float sum = c[r];
        for (int k = 0; k < 32; ++k) sum += emu_bf2f(Ash[w][row + 16 * (k >> 3)][k & 7]) * emu_bf2f(Bsh[w][col + 16 * (k >> 3)][k & 7]);
        c[r] = sum; }
    emu_wave_barrier(); (void)wbase;
    return c;
}
#define MFMA16(a, b, c) emu_mfma16(a, b, c)
#else
#define LAS __attribute__((address_space(3)))
#define WAIT_V(n) asm volatile("s_waitcnt vmcnt(" #n ")" ::: "memory")
#define WAIT_L(n) asm volatile("s_waitcnt lgkmcnt(" #n ")" ::: "memory")
#define S_BARRIER() __builtin_amdgcn_s_barrier()
#define SETPRIO(x) __builtin_amdgcn_s_setprio(x)
#define SCHED_BAR() __builtin_amdgcn_sched_barrier(0)
#define RFL(x) __builtin_amdgcn_readfirstlane(x)
#define GLDS16(gptr, ldsptr) __builtin_amdgcn_global_load_lds((const unsigned*)(gptr), (LAS unsigned*)(ldsptr), 16, 0, 0)
#define MFMA16(a, b, c) __builtin_amdgcn_mfma_f32_16x16x32_bf16(a, b, c, 0, 0, 0)
#endif

__device__ __forceinline__ unsigned f2bf(float f) { unsigned u = __builtin_bit_cast(unsigned, f); return (u + 0x7fffu + ((u >> 16) & 1u)) >> 16; }
__device__ __forceinline__ unsigned pk2(float lo, float hi) { return f2bf(lo) | (f2bf(hi) << 16); }
__device__ __forceinline__ bf16x8 cvt8(const f32x4 a, const f32x4 b) {
    u32x4 w; w.x = pk2(a.x, a.y); w.y = pk2(a.z, a.w); w.z = pk2(b.x, b.y); w.w = pk2(b.z, b.w); return __builtin_bit_cast(bf16x8, w);
}
__device__ __forceinline__ float bf_lo(unsigned u) { return __builtin_bit_cast(float, u << 16); }
__device__ __forceinline__ float bf_hi(unsigned u) { return __builtin_bit_cast(float, u & 0xffff0000u); }

namespace pg8 {
constexpr int BM = 256, BK = 64, HALF = 128, HTB = HALF * BK * 2, STAGE_BYTES = 8 * HTB, NXCD = 8, WGM = 8;
__host__ __device__ __forceinline__ int lds_byte(int r, int c) { const int st = (r >> 4) * 2 + (c >> 5), rr = r & 15, cc = c & 31, ob = rr * 64 + cc * 2; return st * 1024 + (ob ^ (((ob >> 9) & 1) << 5)); }
__host__ __device__ __forceinline__ void stage_rc(int b, int& R, int& C) { const int st = b / 1024, sb = b % 1024, swz = sb ^ (((sb >> 9) & 1) << 5); R = (st >> 1) * 16 + swz / 64; C = (st & 1) * 32 + (swz % 64) / 2; }
__host__ __device__ __forceinline__ int perm32(int rho) { const int n = rho >> 4, i = rho & 15; return 8 * (i >> 2) + 4 * n + (i & 3); }
struct Unit { int pm, pn, e; };

struct DenseOrder {
    const char* A; const char* Bt; int K; int nM, nN, nwg, G, c;
    __device__ __forceinline__ void init(const void* A_, const void* Bt_, int M, int N, int K_, int G_, int c_) { A = (const char*)A_; Bt = (const char*)Bt_; K = K_; nM = M / BM; nN = N / BM; nwg = nM * nN; G = G_; c = c_; }
    __device__ __forceinline__ bool next(int i, Unit& u) const {
        const long L = (long)i * G + c; if (L >= nwg) return false;
        int wgid = (int)L; { const int q = nwg / NXCD, r = nwg % NXCD, xcd = wgid % NXCD, off = wgid / NXCD; wgid = (xcd < r ? xcd * (q + 1) : r * (q + 1) + (xcd - r) * q) + off; }
        const int nig = WGM * nN, gid = wgid / nig, fm = gid * WGM, gsz = (nM - fm) < WGM ? (nM - fm) : WGM;
        u.pm = fm + ((wgid % nig) % gsz); u.pn = (wgid % nig) / gsz; u.e = 0; return true;
    }
    __device__ __forceinline__ const char* abase(const Unit& u) const { return A + (size_t)u.pm * BM * K * 2; }
    __device__ __forceinline__ const char* bbase(const Unit& u) const { return Bt + (size_t)u.pn * BM * K * 2; }
};
struct MoeOrder {
    const char* A; const char* Wt; int K; int nN, nwg, G, c; size_t estride; const int* rbe;
    __device__ __forceinline__ bool next(int i, Unit& u) const {
        const long L = (long)i * G + c; if (L >= nwg) return false;
        u.pm = (int)(L / nN); u.pn = (int)(L % nN); u.e = rbe[u.pm]; return true;
    }
    __device__ __forceinline__ const char* abase(const Unit& u) const { return A + (size_t)u.pm * BM * K * 2; }
    __device__ __forceinline__ const char* bbase(const Unit& u) const { return Wt + (size_t)u.e * estride + (size_t)u.pn * BM * K * 2; }
};

struct EpiF32 {
    static constexpr bool PERM = false;
    float* C; int ldc;
    __device__ __forceinline__ void operator()(const f32x4 (&acc)[2][2][4][2], const Unit& u, int wr, int wc, int fr, int fq) const {
        const int row0 = u.pm * BM + wr * 64 + fr, col0 = u.pn * BM + wc * 32 + 4 * fq;
#pragma unroll
        for (int ai = 0; ai < 2; ++ai)
#pragma unroll
            for (int m = 0; m < 4; ++m) { float* rowp = C + (size_t)(row0 + ai * HALF + m * 16) * ldc + col0;
#pragma unroll
                for (int bj = 0; bj < 2; ++bj)
#pragma unroll
                    for (int n = 0; n < 2; ++n) *(f32x4*)(rowp + bj * HALF + n * 16) = acc[ai][bj][m][n]; }
    }
};
struct EpiBf16Bias {
    static constexpr bool PERM = true;
    bf16_t* O; int ldc; const float* bias; int bias_estride;
    __device__ __forceinline__ void operator()(const f32x4 (&acc)[2][2][4][2], const Unit& u, int wr, int wc, int fr, int fq) const {
        const int row0 = u.pm * BM + wr * 64 + fr, col0 = u.pn * BM + wc * 32 + 8 * fq;
        const float* bp = bias + (size_t)u.e * bias_estride + col0;
        f32x4 bv[2][2];
#pragma unroll
        for (int bj = 0; bj < 2; ++bj)
#pragma unroll
            for (int n = 0; n < 2; ++n) bv[bj][n] = *(const f32x4*)(bp + bj * HALF + 4 * n);
#pragma unroll
        for (int ai = 0; ai < 2; ++ai)
#pragma unroll
            for (int m = 0; m < 4; ++m) { bf16_t* rowp = O + (size_t)(row0 + ai * HALF + m * 16) * ldc + col0;
#pragma unroll
                for (int bj = 0; bj < 2; ++bj) { const f32x4 v0 = acc[ai][bj][m][0] + bv[bj][0], v1 = acc[ai][bj][m][1] + bv[bj][1];
                    u32x4 w; w.x = pk2(v0[0], v0[1]); w.y = pk2(v0[2], v0[3]); w.z = pk2(v1[0], v1[1]); w.w = pk2(v1[2], v1[3]);
                    *(u32x4*)(rowp + bj * HALF) = w; } }
    }
};
__device__ __forceinline__ float swiglu1(float g, float uu) { g = fminf(g, 7.0f); uu = fminf(fmaxf(uu, -7.0f), 7.0f); return (uu + 1.0f) * (g / (1.0f + expf(-1.702f * g))); }
struct EpiSwiglu {
    static constexpr bool PERM = true;
    bf16_t* O; const float* b1;
    __device__ __forceinline__ void operator()(const f32x4 (&acc)[2][2][4][2], const Unit& u, int wr, int wc, int fr, int fq) const {
        const int row0 = u.pm * BM + wr * 64 + fr, j0 = u.pn * HALF + wc * 32 + 8 * fq;
        const float* bg = b1 + (size_t)u.e * 2 * DFF + j0; const float* bu = bg + DFF;
        f32x4 g4[2], u4[2];
#pragma unroll
        for (int n = 0; n < 2; ++n) { g4[n] = *(const f32x4*)(bg + 4 * n); u4[n] = *(const f32x4*)(bu + 4 * n); }
#pragma unroll
        for (int ai = 0; ai < 2; ++ai)
#pragma unroll
            for (int m = 0; m < 4; ++m) {
                float o[8];
#pragma unroll
                for (int n = 0; n < 2; ++n)
#pragma unroll
                    for (int q = 0; q < 4; ++q) o[n * 4 + q] = swiglu1(acc[ai][0][m][n][q] + g4[n][q], acc[ai][1][m][n][q] + u4[n][q]);
                u32x4 w; w.x = pk2(o[0], o[1]); w.y = pk2(o[2], o[3]); w.z = pk2(o[4], o[5]); w.w = pk2(o[6], o[7]);
                *(u32x4*)(O + (size_t)(row0 + ai * HALF + m * 16) * DFF + j0) = w;
            }
    }
};

template <class Epi, class Sched>
__device__ __forceinline__ void gemm_phase(LAS unsigned char* lds, const int K, const Sched& S, const Epi& E, const int tid) {
    const int wid = RFL(tid >> 6), lane = tid & 63, wr = wid >> 2, wc = wid & 3, fr = lane & 15, fq = lane >> 4;
    const int nt = K / BK;
    unsigned voffA[2], voffB[2];
#pragma unroll
    for (int i = 0; i < 2; ++i) { int R, C; stage_rc(tid * 16 + i * 8192, R, C); const int Rb = Epi::PERM ? ((R & ~31) + perm32(R & 31)) : R;
        voffA[i] = (unsigned)(R * K + C) * 2u; voffB[i] = (unsigned)(Rb * K + C) * 2u; }
    const size_t kstep = (size_t)(BK * 2);
    const size_t hstep = (size_t)HALF * K * 2;
    const unsigned ldsw = (unsigned)wid * 1024u;
    const int aoff = lds_byte(wr * 64 + fr, fq * 8), boff = lds_byte(wc * 32 + fr, fq * 8);
#define PG8_SA(b, h) (((b) * 2 + (h)) * HTB)
#define PG8_SB(b, h) ((4 + (b) * 2 + (h)) * HTB)
#define PG8_STAGE(bufoff, gbase, voff) do { _Pragma("unroll") for (int _i = 0; _i < 2; ++_i) \
        GLDS16((const char*)(gbase) + (voff)[_i], lds + (bufoff) + ldsw + _i * 8192); } while (0)
#define PG8_LDA(dst, b, h) do { _Pragma("unroll") for (int m = 0; m < 4; ++m) _Pragma("unroll") for (int k = 0; k < 2; ++k) dst[m][k] = *(const LAS bf16x8*)(lds + PG8_SA(b, h) + aoff + m * 2048 + k * 1024); } while (0)
#define PG8_LDB(dst, b, h) do { _Pragma("unroll") for (int n = 0; n < 2; ++n) _Pragma("unroll") for (int k = 0; k < 2; ++k) dst[n][k] = *(const LAS bf16x8*)(lds + PG8_SB(b, h) + boff + n * 2048 + k * 1024); } while (0)
#define PG8_MMA(ai, bj, At, Bt) do { SETPRIO(1); _Pragma("unroll") for (int m = 0; m < 4; ++m) _Pragma("unroll") for (int n = 0; n < 2; ++n) _Pragma("unroll") for (int k = 0; k < 2; ++k) \
        acc[ai][bj][m][n] = MFMA16(Bt[n][k], At[m][k], acc[ai][bj][m][n]); SETPRIO(0); } while (0)
    Unit cur, nxt; int ui = 0;
    if (!S.next(0, cur)) return;
    f32x4 acc[2][2][4][2];
#pragma unroll
    for (int a = 0; a < 2; ++a)
#pragma unroll
        for (int b = 0; b < 2; ++b)
#pragma unroll
            for (int m = 0; m < 4; ++m)
#pragma unroll
                for (int n = 0; n < 2; ++n) acc[a][b][m][n] = (f32x4){0.f, 0.f, 0.f, 0.f};
    bf16x8 At[4][2], B0[2][2], B1[2][2];
    const char* cA = S.abase(cur); const char* cB = S.bbase(cur);
    PG8_STAGE(PG8_SB(0, 0), cB, voffB); PG8_STAGE(PG8_SA(0, 0), cA, voffA); PG8_STAGE(PG8_SB(0, 1), cB + hstep, voffB); PG8_STAGE(PG8_SA(0, 1), cA + hstep, voffA);
    if (wr == 1) S_BARRIER();
    WAIT_V(4); S_BARRIER();
    PG8_STAGE(PG8_SB(1, 0), cB + kstep, voffB); PG8_STAGE(PG8_SA(1, 0), cA + kstep, voffA); PG8_STAGE(PG8_SB(1, 1), cB + hstep + kstep, voffB);
    WAIT_V(6); S_BARRIER();
    for (;;) {
        const bool has_next = S.next(ui + 1, nxt);
        const char* nA = has_next ? S.abase(nxt) : cA; const char* nB = has_next ? S.bbase(nxt) : cB;
        for (int t = 0; t < nt; t += 2) {
            const bool last = (t == nt - 2);
            const char* a1 = cA + (size_t)(t + 1) * kstep;
            const char* a2 = last ? nA : cA + (size_t)(t + 2) * kstep; const char* b2 = last ? nB : cB + (size_t)(t + 2) * kstep;
            const char* a3 = a2 + kstep; const char* b3 = b2 + kstep;
            PG8_LDB(B0, 0, 0); SCHED_BAR(); PG8_LDA(At, 0, 0); PG8_STAGE(PG8_SA(1, 1), a1 + hstep, voffA);
            WAIT_L(8); S_BARRIER(); WAIT_L(0); PG8_MMA(0, 0, At, B0); S_BARRIER(); SCHED_BAR();
            PG8_LDB(B1, 0, 1); PG8_STAGE(PG8_SB(0, 0), b2, voffB);
            S_BARRIER(); WAIT_L(0); PG8_MMA(0, 1, At, B1); S_BARRIER();
            PG8_LDA(At, 0, 1); PG8_STAGE(PG8_SA(0, 0), a2, voffA);
            S_BARRIER(); WAIT_L(0); PG8_MMA(1, 0, At, B0); S_BARRIER(); SCHED_BAR();
            PG8_STAGE(PG8_SB(0, 1), b2 + hstep, voffB);
            WAIT_V(6); S_BARRIER(); PG8_MMA(1, 1, At, B1); S_BARRIER();
            PG8_LDB(B0, 1, 0); SCHED_BAR(); PG8_LDA(At, 1, 0); PG8_STAGE(PG8_SA(0, 1), a2 + hstep, voffA);
            WAIT_L(8); S_BARRIER(); WAIT_L(0); PG8_MMA(0, 0, At, B0); S_BARRIER(); SCHED_BAR();
            PG8_LDB(B1, 1, 1); PG8_STAGE(PG8_SB(1, 0), b3, voffB);
            S_BARRIER(); WAIT_L(0); PG8_MMA(0, 1, At, B1); S_BARRIER();
            PG8_LDA(At, 1, 1); PG8_STAGE(PG8_SA(1, 0), a3, voffA);
            S_BARRIER(); WAIT_L(0); PG8_MMA(1, 0, At, B0); S_BARRIER(); SCHED_BAR();
            PG8_STAGE(PG8_SB(1, 1), b3 + hstep, voffB);
            WAIT_V(6); S_BARRIER(); PG8_MMA(1, 1, At, B1); S_BARRIER();
        }
        E(acc, cur, wr, wc, fr, fq);
        if (!has_next) break;
#pragma unroll
        for (int a = 0; a < 2; ++a)
#pragma unroll
            for (int b = 0; b < 2; ++b)
#pragma unroll
                for (int m = 0; m < 4; ++m)
#pragma unroll
                    for (int n = 0; n < 2; ++n) acc[a][b][m][n] = (f32x4){0.f, 0.f, 0.f, 0.f};
        cur = nxt; cA = nA; cB = nB; ++ui;
    }
    WAIT_V(0);
    if (wr == 0) S_BARRIER();
    S_BARRIER();
#undef PG8_SA
#undef PG8_SB
#undef PG8_STAGE
#undef PG8_LDA
#undef PG8_LDB
#undef PG8_MMA
}
}

__device__ __forceinline__ void transpose_item(const float* W, int K, int N, bf16_t* WT, int k0, int n0, int dst_row0, float* scr, int lane) {
#pragma unroll 8
    for (int i = 0; i < 32; ++i) { const int kk = 2 * i + (lane >> 5), n = n0 + (lane & 31); scr[kk * 33 + (lane & 31)] = n < N ? W[(size_t)(k0 + kk) * N + n] : 0.f; }
    WAVE_SYNC();
    const int c = lane & 7;
#pragma unroll
    for (int j = 0; j < 4; ++j) { const int n = (lane >> 3) + 8 * j; const float* sp = scr + (8 * c) * 33 + n;
        u32x4 o; o.x = pk2(sp[0 * 33], sp[1 * 33]); o.y = pk2(sp[2 * 33], sp[3 * 33]); o.z = pk2(sp[4 * 33], sp[5 * 33]); o.w = pk2(sp[6 * 33], sp[7 * 33]);
        *(u32x4*)(WT + (size_t)(dst_row0 + n) * K + k0 + 8 * c) = o; }
    WAVE_SYNC();
}
__device__ __forceinline__ void phase_prologue(const Params& P, unsigned char* smem, int wv) {
    ParamsPtr pp = PARAMS_PTR(P); PIN_S(pp); unsigned char* ws = pp->ws; int bidx = (int)blockIdx.x, gdim = (int)gridDim.x; PIN_S(bidx); PIN_S(gdim);
    const int tid = phase_tid(wv), lane = tid & 63, wave = tid >> 6;
    float* scr = (float*)smem + wave * (64 * 33);
    const int gw = bidx * NWAVES + wave, ngw = NWAVES * gdim;
    constexpr int I_IN = 16 * (PLD / 32), I_OUT = 16 * 32, I_W1 = NE * 16 * 64, I_W2 = NE * 16 * 32, I_L = I_IN + I_OUT + I_W1 + I_W2;
    for (int it = gw; it < NL * I_L; it += ngw) {
        const int l = it / I_L; int r = it % I_L;
        if (r < I_IN) { const int kb = r / (PLD / 32), nb = r % (PLD / 32);
            transpose_item(pp->in[1] + (size_t)l * D * PIN, D, PIN, (bf16_t*)(ws + O_WIN) + (size_t)l * PLD * D, kb * 64, nb * 32, nb * 32, scr, lane); continue; }
        r -= I_IN;
        if (r < I_OUT) { const int kb = r / 32, nb = r % 32;
            transpose_item(pp->in[21] + (size_t)l * D * D, D, D, (bf16_t*)(ws + O_WOUT) + (size_t)l * D * D, kb * 64, nb * 32, nb * 32, scr, lane); continue; }
        r -= I_OUT;
        if (r < I_W1) { const int e = r / (16 * 64), q = r % (16 * 64), kb = q / 64, nb = q % 64, n0 = nb * 32;
            const int dst = n0 < DFF ? (n0 / 128) * 256 + (n0 % 128) : ((n0 - DFF) / 128) * 256 + 128 + ((n0 - DFF) % 128);
            transpose_item(pp->in[26] + ((size_t)l * NE + e) * D * 2 * DFF, D, 2 * DFF, (bf16_t*)(ws + O_W1) + ((size_t)l * NE + e) * 2 * DFF * D, kb * 64, n0, dst, scr, lane); continue; }
        r -= I_W1;
        { const int e = r / (16 * 32), q = r % (16 * 32), kb = q / 32, nb = q % 32;
            transpose_item(pp->in[28] + ((size_t)l * NE + e) * DFF * D, DFF, D, (bf16_t*)(ws + O_W2) + ((size_t)l * NE + e) * D * DFF, kb * 64, nb * 32, nb * 32, scr, lane); }
    }
    const float* x = pp->in[0]; bf16_t* XB = (bf16_t*)(ws + O_XB);
    for (size_t i = ((size_t)bidx * NTHREADS + tid) * 4; i < (size_t)T * D; i += (size_t)gdim * NTHREADS * 4) {
        const f32x4 v = *(const f32x4*)(x + i); u32x2 o; o.x = pk2(v.x, v.y); o.y = pk2(v.z, v.w); *(u32x2*)(XB + i) = o;
    }
}

__device__ __forceinline__ float tshift(const float* P, int t, int s, int col, const float* mu0, const float* mu1, int rc) {
    const float cur = P[(size_t)t * PLD + col];
    const float prv = s > 0 ? P[(size_t)(t - 1) * PLD + col] : 0.f;
    const float nxt = s < S - 1 ? P[(size_t)(t + 1) * PLD + col] : 0.f;
    return cur + mu0[rc] * (prv - cur) + mu1[rc] * (nxt - cur);
}

__device__ __forceinline__ void phase_prep(const Params& P, int l, unsigned char* smem, int wv) {
    ParamsPtr pp = PARAMS_PTR(P); PIN_S(pp); unsigned char* ws = pp->ws; int bidx = (int)blockIdx.x, gdim = (int)gridDim.x; PIN_S(bidx); PIN_S(gdim);
    const float* proj = (const float*)(ws + O_PROJ);
    float* UG = (float*)(ws + O_UG); float* VN = (float*)(ws + O_VN);
    float* RR = (float*)(ws + O_RR); float* VV = (float*)(ws + O_VV); float* KK = (float*)(ws + O_KK);
    float* DEC = (float*)(ws + O_DEC); float* KD = (float*)(ws + O_KD); float* ICLR = (float*)(ws + O_ICLR);
    float* GATE = (float*)(ws + O_GATE); float* BONUS = (float*)(ws + O_BONUS); float* BRKR = (float*)(ws + O_BRKR); float* LWG = (float*)(ws + O_LW);
    bf16_t* MQB = (bf16_t*)(ws + O_MQB); bf16_t* MKB = (bf16_t*)(ws + O_MKB); bf16_t* KT = (bf16_t*)(ws + O_KT); bf16_t* VT = (bf16_t*)(ws + O_VT);
    float* IG = (float*)(ws + O_IG); float* LF = (float*)(ws + O_LF);
    const float* gln_g = pp->in[2] + (size_t)l * GW; const float* gln_b = pp->in[3] + (size_t)l * GW;
    const float* mu0 = pp->in[6] + (size_t)l * 2 * RPROJ; const float* mu1 = mu0 + RPROJ;
    const float* w0 = pp->in[7] + (size_t)l * 2 * RW; const float* w2 = pp->in[8] + (size_t)l * 2 * 64 * RW;
    const float* a0 = pp->in[9] + (size_t)l * 2 * RW; const float* a2 = pp->in[10] + (size_t)l * 2 * 64 * RW;
    const float* g2 = pp->in[11] + (size_t)l * 128 * RW;
    const float* k_k = pp->in[12] + (size_t)l * RW; const float* k_a = pp->in[13] + (size_t)l * RW; const float* r_k = pp->in[14] + (size_t)l * RW;
    const float* conv_w = pp->in[17] + (size_t)l * 3 * 768; const float* conv_b = pp->in[18] + (size_t)l * 768; const float* gate_b = pp->in[19] + (size_t)l * 24;
    float* lora = (float*)smem;
    const int tid = phase_tid(wv), lane = tid & 63, wave = tid >> 6;
    for (int u = bidx; u < T / 16; u += gdim) {
        const int t0 = u * 16, s0 = t0 % S;
        {
            const int i = tid >> 5, l32 = tid & 31, t = t0 + i;
            float v[8]; float sum = 0.f;
#pragma unroll
            for (int j = 0; j < 8; ++j) {
                const int c = j * 32 + l32;
                UG[(size_t)t * GW + c] = geluf_(proj[(size_t)t * PLD + c]);
                v[j] = geluf_(proj[(size_t)t * PLD + GW + c]); sum += v[j];
            }
#pragma unroll
            for (int o = 16; o >= 1; o >>= 1) sum += SHX(sum, o, lane);
            const float mean = sum * (1.0f / GW); float q = 0.f;
#pragma unroll
            for (int j = 0; j < 8; ++j) { const float d = v[j] - mean; q += d * d; }
#pragma unroll
            for (int o = 16; o >= 1; o >>= 1) q += SHX(q, o, lane);
            const float rstd = 1.0f / sqrtf(q * (1.0f / GW) + LN_EPS);
#pragma unroll
            for (int j = 0; j < 8; ++j) { const int c = j * 32 + l32; VN[(size_t)t * GW + c] = (v[j] - mean) * rstd * gln_g[c] + gln_b[c]; }
        }
        __syncthreads();
        for (int idx = tid; idx < 16 * 256; idx += NTHREADS) {
            const int i = idx >> 8, j = idx & 255, rc = 1152 + j;
            const float x = tshift(proj, t0 + i, s0 + i, C_RW + rc, mu0, mu1, rc);
            lora[idx] = j < 64 ? tanhf(x) : (j < 128 ? x : sigmoidf_(x));
        }
        __syncthreads();
        if (wave < 6) {
            const int c = tid, h = wave;
            {
                float aw0[16], aw1[16];
#pragma unroll
                for (int i = 0; i < 16; ++i) { aw0[i] = w0[c]; aw1[i] = w0[RW + c]; }
                for (int j0 = 0; j0 < 64; j0 += 8) {
                    float wa[8], wb[8];
#pragma unroll
                    for (int jj = 0; jj < 8; ++jj) { wa[jj] = w2[(size_t)(j0 + jj) * RW + c]; wb[jj] = w2[(size_t)(64 + j0 + jj) * RW + c]; }
#pragma unroll
                    for (int jj = 0; jj < 8; ++jj)
#pragma unroll
                        for (int i = 0; i < 16; ++i) { const float lw = lora[i * 256 + j0 + jj]; aw0[i] += lw * wa[jj]; aw1[i] += lw * wb[jj]; }
                }
#pragma unroll
                for (int i = 0; i < 16; ++i) {
                    const size_t o = (size_t)(t0 + i) * RW + c;
                    const float lw0 = -expf(-softplusf_(-aw0[i]) - 0.5f), lw1 = -expf(-softplusf_(-aw1[i]) - 0.5f);
                    LWG[o] = lw0; LWG[(size_t)T * RW + o] = lw1;
                    DEC[o] = expf(lw0); DEC[(size_t)T * RW + o] = expf(lw1);
                }
            }
            {
                float aa0[16], aa1[16];
#pragma unroll
                for (int i = 0; i < 16; ++i) { aa0[i] = a0[c]; aa1[i] = a0[RW + c]; }
                for (int j0 = 0; j0 < 64; j0 += 8) {
                    float wa[8], wb[8];
#pragma unroll
                    for (int jj = 0; jj < 8; ++jj) { wa[jj] = a2[(size_t)(j0 + jj) * RW + c]; wb[jj] = a2[(size_t)(64 + j0 + jj) * RW + c]; }
#pragma unroll
                    for (int jj = 0; jj < 8; ++jj)
#pragma unroll
                        for (int i = 0; i < 16; ++i) { const float la = lora[i * 256 + 64 + j0 + jj]; aa0[i] += la * wa[jj]; aa1[i] += la * wb[jj]; }
                }
#pragma unroll
                for (int i = 0; i < 16; ++i) {
                    const size_t o = (size_t)(t0 + i) * RW + c;
                    ICLR[o] = sigmoidf_(aa0[i]); ICLR[(size_t)T * RW + o] = sigmoidf_(aa1[i]);
                }
            }
            {
                float ag[16];
#pragma unroll
                for (int i = 0; i < 16; ++i) ag[i] = 0.f;
                for (int j0 = 0; j0 < 128; j0 += 16) {
                    float wa[16];
#pragma unroll
                    for (int jj = 0; jj < 16; ++jj) wa[jj] = g2[(size_t)(j0 + jj) * RW + c];
#pragma unroll
                    for (int jj = 0; jj < 16; ++jj)
#pragma unroll
                        for (int i = 0; i < 16; ++i) ag[i] += lora[i * 256 + 128 + j0 + jj] * wa[jj];
                }
#pragma unroll
                for (int i = 0; i < 16; ++i) GATE[(size_t)(t0 + i) * RW + c] = ag[i];
            }
            const float kkc = k_k[c], kac = k_a[c], rkc = r_k[c];
            float rr_[16], kq_[16], vv_[16];
            {
                float pr_[18], pk_[18], pv_[18];
#pragma unroll
                for (int i = 0; i < 18; ++i) {
                    const int s = s0 - 1 + i; const bool ok = s >= 0 && s < S; const size_t ro = (size_t)(t0 - 1 + i) * PLD + C_RW + c;
                    pr_[i] = ok ? proj[ro] : 0.f; pk_[i] = ok ? proj[ro + RW] : 0.f; pv_[i] = ok ? proj[ro + 2 * RW] : 0.f;
                }
                const float m0r = mu0[c], m1r = mu1[c], m0k = mu0[RW + c], m1k = mu1[RW + c], m0v = mu0[2 * RW + c], m1v = mu1[2 * RW + c];
#pragma unroll
                for (int i = 0; i < 16; ++i) {
                    rr_[i] = pr_[i + 1] + m0r * (pr_[i] - pr_[i + 1]) + m1r * (pr_[i + 2] - pr_[i + 1]);
                    kq_[i] = pk_[i + 1] + m0k * (pk_[i] - pk_[i + 1]) + m1k * (pk_[i + 2] - pk_[i + 1]);
                    vv_[i] = pv_[i + 1] + m0v * (pv_[i] - pv_[i + 1]) + m1v * (pv_[i + 2] - pv_[i + 1]);
                }
            }
#pragma unroll
            for (int i = 0; i < 16; ++i) {
                const int t = t0 + i;
                const float r = rr_[i], k = kq_[i], v = vv_[i];
                const size_t o = (size_t)t * RW + c;
                const float ic0 = ICLR[o], ic1 = ICLR[(size_t)T * RW + o];
                const float kq = k * kkc;
                const float n2 = wave_sum(kq * kq, lane);
                const float kk = kq / fmaxf(sqrtf(n2), 1e-12f);
                const float kd0 = k * (1.0f + (ic0 - 1.0f) * kac), kd1 = k * (1.0f + (ic1 - 1.0f) * kac);
                const float bon = wave_sum(r * (kd0 + kd1) * rkc, lane);
                const float br0 = wave_sum(kk * ic0 * r, lane), br1 = wave_sum(kk * ic1 * r, lane), kr0 = wave_sum(kd0 * r, lane), kr1 = wave_sum(kd1 * r, lane);
                RR[o] = r; VV[o] = v; KK[o] = kk;
                KD[o] = kd0; KD[(size_t)T * RW + o] = kd1;
                if (lane == 0) { BONUS[(size_t)t * RH + h] = bon;
                    BRKR[((size_t)t * RH + h) * 2] = br0; BRKR[((size_t)t * RH + h) * 2 + 1] = kr0;
                    BRKR[((size_t)(T + t) * RH + h) * 2] = br1; BRKR[((size_t)(T + t) * RH + h) * 2 + 1] = kr1; }
            }
        }
        {
            bf16_t* tk = (bf16_t*)(smem + 16384);
            bf16_t* tv = tk + 384 * 16;
            for (int idx = tid; idx < 16 * 768; idx += NTHREADS) {
                const int i = idx / 768, c = idx % 768, t = t0 + i, s = s0 + i, col = C_MW + c;
                const float xm = s > 0 ? proj[(size_t)(t - 1) * PLD + col] : 0.f;
                const float x0 = proj[(size_t)t * PLD + col];
                const float xp = s < S - 1 ? proj[(size_t)(t + 1) * PLD + col] : 0.f;
                float y = conv_b[c] + xm * conv_w[c] + x0 * conv_w[768 + c] + xp * conv_w[2 * 768 + c];
                y = y * sigmoidf_(y);
                if (c < MW) MQB[(size_t)t * MW + c] = (bf16_t)f2bf(y);
                else { const bf16_t kb = (bf16_t)f2bf(y * 0.125f); MKB[(size_t)t * MW + (c - MW)] = kb; tk[(c - MW) * 16 + i] = kb; }
            }
            for (int idx = tid; idx < 16 * MW; idx += NTHREADS) {
                const int i = idx / MW, c = idx % MW;
                tv[c * 16 + i] = (bf16_t)f2bf(proj[(size_t)(t0 + i) * PLD + C_MW + 2 * MW + c]);
            }
            __syncthreads();
            const int bb = t0 / S;
            for (int idx = tid; idx < 2 * MW * 2; idx += NTHREADS) {
                const int hf = idx & 1, c = (idx >> 1) % MW, which = idx / (2 * MW);
                const u32x4 val = *(const u32x4*)((which ? tv : tk) + c * 16 + hf * 8);
                bf16_t* dst = (which ? VT : KT) + ((size_t)(bb * MH) * 64 + c) * S + s0 + hf * 8;
                *(u32x4*)dst = val;
            }
        }
        for (int idx = tid; idx < 16 * 24; idx += NTHREADS) {
            const int i = idx / 24, gi = idx % 24, t = t0 + i;
            const int isf = gi / 12, dir = (gi / 6) & 1, h = gi % 6;
            const float g = proj[(size_t)t * PLD + 3456 + gi] + gate_b[gi];
            if (isf) LF[((size_t)dir * T + t) * MH + h] = -softplusf_(-g); else IG[((size_t)dir * T + t) * MH + h] = g;
        }
        __syncthreads();
    }
}

__device__ __forceinline__ void phase_gmlp_mix(const Params& P, int l, unsigned char* smem, int wv, int bid, int nb) {
    PIN_S(bid); PIN_S(nb);
    ParamsPtr pp = PARAMS_PTR(P); PIN_S(pp); unsigned char* ws = pp->ws; int bidx = (int)blockIdx.x, gdim = (int)gridDim.x; PIN_S(bidx); PIN_S(gdim);
    const float* UG = (const float*)(ws + O_UG); const float* VN = (const float*)(ws + O_VN); bf16_t* GRP = (bf16_t*)(ws + O_GRP);
    const float* gws = pp->in[4] + (size_t)l * GH * CH * CH; const float* gbs = pp->in[5] + (size_t)l * GH * CH;
    float* vs = (float*)smem;
    float* wsm = vs + 128 * 64;
    const int tid = phase_tid(wv);
    for (int u = bid; u < NB * NCH * GH; u += nb) {
        const int h = u % GH, c = (u / GH) % NCH, b = u / (GH * NCH);
        const int tok0 = b * S + c * CH;
        __syncthreads();
        for (int idx = tid; idx < 128 * 64; idx += NTHREADS) { const int q = idx >> 6, e = idx & 63; vs[idx] = VN[(size_t)(tok0 + q) * GW + h * 64 + e]; }
        for (int idx = tid; idx < 128 * 128; idx += NTHREADS) wsm[idx] = gws[(size_t)h * CH * CH + idx];
        __syncthreads();
        const int p = tid >> 2, eg = (tid & 3) * 16;
        float acc[16];
#pragma unroll
        for (int e = 0; e < 16; ++e) acc[e] = 0.f;
        for (int q = 0; q < 128; ++q) {
            const float w = wsm[p * 128 + q];
#pragma unroll
            for (int e = 0; e < 16; ++e) acc[e] += w * vs[q * 64 + eg + e];
        }
        const float bsv = gbs[h * CH + p];
#pragma unroll
        for (int e = 0; e < 16; ++e) {
            const size_t t = (size_t)(tok0 + p);
            GRP[t * D + h * 64 + eg + e] = (bf16_t)f2bf(UG[t * GW + h * 64 + eg + e] * (acc[e] + bsv));
        }
    }
    __syncthreads();
}

__device__ __forceinline__ float row16_sum(float x) {
#ifdef EMU
    x += __shfl_xor(x, 1); x += __shfl_xor(x, 2); x += __shfl_xor(x, 4); x += __shfl_xor(x, 8); return x;
#else
#define DPPF(v, ctrl) __builtin_bit_cast(float, __builtin_amdgcn_update_dpp(0, __builtin_bit_cast(int, (v)), (ctrl), 0xF, 0xF, false))
    x += DPPF(x, 0xB1); x += DPPF(x, 0x4E); x += DPPF(x, 0x141); x += DPPF(x, 0x140); return x;
#undef DPPF
#endif
}
constexpr int SC_STEPS = 16;
constexpr int SC_BUF = SC_STEPS * 6 * 64;
__device__ __forceinline__ float row32_sum(float x) {
    x = row16_sum(x);
#ifdef EMU
    x += __shfl_xor(x, 32); return x;
#else
    float a = x, b = x;
    asm volatile("s_nop 1\n\tv_permlane32_swap_b32 %0, %1" : "+v"(a), "+v"(b));
    return a + b;
#endif
}
__device__ __forceinline__ void phase_rwkv_scan(const Params& P, int l, unsigned char* smem, int wv, int bid, int nb) {
    PIN_S(bid); PIN_S(nb);
    ParamsPtr pp = PARAMS_PTR(P); PIN_S(pp); unsigned char* ws = pp->ws;
    const float* RR = (const float*)(ws + O_RR); const float* VV = (const float*)(ws + O_VV); const float* KK = (const float*)(ws + O_KK);
    const float* DEC = (const float*)(ws + O_DEC); const float* KD = (const float*)(ws + O_KD); const float* ICLR = (const float*)(ws + O_ICLR);
    float* SCAN = (float*)(ws + O_SCAN); const float* BRKR = (const float*)(ws + O_BRKR);
    const int tid = phase_tid(wv), lane = tid & 63, wave = tid >> 6, rl = (lane >> 4) & 1, kq = (lane & 15) | ((lane >> 5) << 4);
    float* buf = (float*)smem;
    float* scal = buf + 2 * SC_BUF;
    float* outb = scal + 2 * SC_STEPS * 2;
    typedef float f32x2 __attribute__((ext_vector_type(2)));
    for (int u = bid; u < 2 * NB * RH * 4; u += nb) {
        const int qt = u & 3, h = (u >> 2) % RH, b = (u / (4 * RH)) % NB, d = u / (4 * RH * NB);
        const size_t doff = (size_t)d * T * RW;
        float s0 = 0.f, s1 = 0.f;
        float pw[2], pa[2], pb[2], pk[2], pr[2], pv[2], psc = 0.f;
#define SC_LOAD(c) do { _Pragma("unroll") for (int i = 0; i < 2; ++i) { const int idx = tid + NTHREADS * i, st = idx >> 6, k = idx & 63; const int tau = (c) * SC_STEPS + st, sq = d ? S - 1 - tau : tau; \
            const size_t o = (size_t)(b * S + sq) * RW + h * 64 + k; \
            pw[i] = DEC[doff + o]; pa[i] = KK[o]; pb[i] = ICLR[doff + o]; pk[i] = KD[doff + o]; pr[i] = RR[o]; pv[i] = VV[o]; }     \
            if (tid < 2 * SC_STEPS) { const int tau = (c) * SC_STEPS + (tid >> 1), sq = d ? S - 1 - tau : tau; psc = BRKR[((size_t)(d * T + b * S + sq) * RH + h) * 2 + (tid & 1)]; } } while (0)
#define SC_WRITE(c) do { float* B_ = buf + ((c) & 1) * SC_BUF; _Pragma("unroll") for (int i = 0; i < 2; ++i) { const int idx = tid + NTHREADS * i, st = idx >> 6, k = idx & 63; \
            float* q_ = B_ + st * 384 + k; q_[0] = pw[i]; q_[64] = -pa[i]; q_[128] = pa[i] * pb[i]; q_[192] = pk[i]; q_[256] = pw[i] * pr[i]; q_[320] = pv[i]; } \
            if (tid < 2 * SC_STEPS) scal[((c) & 1) * SC_STEPS * 2 + tid] = psc; } while (0)
        __syncthreads();
        SC_LOAD(0); SC_WRITE(0);
        __syncthreads();
        const int row = qt * 16 + wave * 2 + rl;
        for (int c = 0; c < S / SC_STEPS; ++c) {
            const bool more = (c + 1) < S / SC_STEPS;
            if (more) SC_LOAD(c + 1);
            const float* B = buf + (c & 1) * SC_BUF; const float* sc = scal + (c & 1) * SC_STEPS * 2; float* ob = outb + (c & 1) * SC_STEPS * 16;
            float outs[SC_STEPS];
            f32x2 w2 = *(const f32x2*)(B + 2 * kq), a2 = *(const f32x2*)(B + 64 + 2 * kq), b2 = *(const f32x2*)(B + 128 + 2 * kq);
            f32x2 k2 = *(const f32x2*)(B + 192 + 2 * kq), wr2 = *(const f32x2*)(B + 256 + 2 * kq);
            float v = B[320 + row]; float br = sc[0], kr = sc[1];
#pragma unroll
            for (int st = 0; st < SC_STEPS; ++st) {
                const int sn = st + 1 < SC_STEPS ? st + 1 : st;
                const float* q = B + sn * 384;
                const f32x2 nw2 = *(const f32x2*)(q + 2 * kq), na2 = *(const f32x2*)(q + 64 + 2 * kq), nb2 = *(const f32x2*)(q + 128 + 2 * kq);
                const f32x2 nk2 = *(const f32x2*)(q + 192 + 2 * kq), nwr2 = *(const f32x2*)(q + 256 + 2 * kq);
                const float nv = q[320 + row], nbr = sc[sn * 2], nkr = sc[sn * 2 + 1];
                SCHED_BAR();
                float sa = s0 * a2.x + s1 * a2.y;
                float po = s0 * wr2.x + s1 * wr2.y;
                sa = row32_sum(sa); po = row32_sum(po);
                outs[st] = po + sa * br + v * kr;
                s0 = s0 * w2.x + (sa * b2.x + v * k2.x); s1 = s1 * w2.y + (sa * b2.y + v * k2.y);
                SCHED_BAR();
                w2 = nw2; a2 = na2; b2 = nb2; k2 = nk2; wr2 = nwr2; v = nv; br = nbr; kr = nkr;
            }
            if (kq == 0) {
#pragma unroll
                for (int st = 0; st < SC_STEPS; ++st) ob[st * 16 + wave * 2 + rl] = outs[st];
            }
            if (more) SC_WRITE(c + 1);
            __syncthreads();
            if (tid < 16 * SC_STEPS) {
                const int st = tid >> 4, r = tid & 15, tau = c * SC_STEPS + st, sq = d ? S - 1 - tau : tau;
                SCAN[doff + (size_t)(b * S + sq) * RW + h * 64 + qt * 16 + r] = ob[st * 16 + r];
            }
        }
#undef SC_LOAD
#undef SC_WRITE
    }
    __syncthreads();
}

constexpr int RST = 72;
constexpr int RARR = 64 * RST;
__device__ __forceinline__ f32x4 tile_nt(const bf16_t* Aa, int ta, const bf16_t* Ba, int tb, f32x4 acc, int col, int g) {
#pragma unroll
    for (int ks = 0; ks < 2; ++ks) {
        const bf16x8 af = *(const bf16x8*)(Aa + (ta * 16 + col) * RST + ks * 32 + 8 * g);
        const bf16x8 bfr = *(const bf16x8*)(Ba + (tb * 16 + col) * RST + ks * 32 + 8 * g);
        acc = MFMA16(af, bfr, acc);
    }
    return acc;
}
__device__ __forceinline__ void phase_rwkv_pre(const Params& P, int l, unsigned char* smem, int wv) {
    ParamsPtr pp = PARAMS_PTR(P); PIN_S(pp); unsigned char* ws = pp->ws; int bidx = (int)blockIdx.x, gdim = (int)gridDim.x; PIN_S(bidx); PIN_S(gdim);
    const float* RR = (const float*)(ws + O_RR); const float* VV = (const float*)(ws + O_VV); const float* KK = (const float*)(ws + O_KK);
    const float* LWG = (const float*)(ws + O_LW); const float* KD = (const float*)(ws + O_KD); const float* ICLR = (const float*)(ws + O_ICLR);
    bf16_t* Qg = (bf16_t*)(ws + O_RQ); bf16_t* Ag = (bf16_t*)(ws + O_RA); float* Hg = (float*)(ws + O_RH); float* Gg = (float*)(ws + O_RG);
    const int tid0 = phase_tid(wv);
#define RW_STAGE_VARS int tid = tid0; PIN_V(tid); const int lane = tid & 63, wave = tid >> 6, col = lane & 15, g = lane >> 4; (void)lane; (void)wave; (void)col; (void)g;
    bf16_t* At = (bf16_t*)smem; bf16_t* Bt = At + RARR; bf16_t* Kt = Bt + RARR; bf16_t* Rt = Kt + RARR;
    bf16_t* BtT = Rt + RARR; bf16_t* KtT = BtT + RARR; bf16_t* VT = KtT + RARR;
    bf16_t* Lak = VT + RARR; bf16_t* Mrb = Lak + RARR; bf16_t* Mrk = Mrb + RARR; bf16_t* YT = Mrk + RARR; bf16_t* W2T = YT + RARR;
    float* LabT = (float*)(W2T + RARR);
    float* ZsB = LabT + 4096;
    float* segs = ZsB + 8192;
    float* PC = segs + 512;
    for (int u = bidx; u < RUN; u += gdim) {
        const int c = u % RNC, h = (u / RNC) % RH, b = (u / (RNC * RH)) % NB, d = u / (RNC * RH * NB);
        const size_t doff = (size_t)d * T * RW;
        __syncthreads();
        {
            RW_STAGE_VARS
            const int ch = tid & 63, sg = tid >> 6;
            float lw[8], kk[8], ic[8], kd[8], rr[8], vv[8];
#pragma unroll
            for (int j = 0; j < 8; ++j) {
                const int tau = c * RC + sg * 8 + j, sq = d ? S - 1 - tau : tau; const size_t o = (size_t)(b * S + sq) * RW + h * 64 + ch;
                lw[j] = LWG[doff + o]; kk[j] = KK[o]; ic[j] = ICLR[doff + o]; kd[j] = KD[doff + o]; rr[j] = RR[o]; vv[j] = VV[o];
            }
            float run = 0.f;
#pragma unroll
            for (int j = 0; j < 8; ++j) { run += lw[j]; lw[j] = run; }
            segs[sg * 64 + ch] = run;
            __syncthreads();
            float off = 0.f;
            for (int q = 0; q < sg; ++q) off += segs[q * 64 + ch];
            u32x4 pbt, pkt, pvt; unsigned tb[8], tk[8], tvv[8];
            float prev = off;
#pragma unroll
            for (int j = 0; j < 8; ++j) {
                const int t = sg * 8 + j; const float cl = off + lw[j];
                const float ep = expf(prev), en = expf(-cl), epc = expf(cl);
                const unsigned a_ = f2bf(-kk[j] * ep), b_ = f2bf(kk[j] * ic[j] * en), k_ = f2bf(kd[j] * en), r_ = f2bf(rr[j] * epc), v_ = f2bf(vv[j]);
                At[t * RST + ch] = (bf16_t)a_; Bt[t * RST + ch] = (bf16_t)b_; Kt[t * RST + ch] = (bf16_t)k_; Rt[t * RST + ch] = (bf16_t)r_;
                tb[j] = b_; tk[j] = k_; tvv[j] = v_;
                prev = cl;
            }
            if (sg == 7) PC[ch] = expf(prev);
            pbt.x = tb[0] | (tb[1] << 16); pbt.y = tb[2] | (tb[3] << 16); pbt.z = tb[4] | (tb[5] << 16); pbt.w = tb[6] | (tb[7] << 16);
            pkt.x = tk[0] | (tk[1] << 16); pkt.y = tk[2] | (tk[3] << 16); pkt.z = tk[4] | (tk[5] << 16); pkt.w = tk[6] | (tk[7] << 16);
            pvt.x = tvv[0] | (tvv[1] << 16); pvt.y = tvv[2] | (tvv[3] << 16); pvt.z = tvv[4] | (tvv[5] << 16); pvt.w = tvv[6] | (tvv[7] << 16);
            *(u32x4*)(BtT + ch * RST + sg * 8) = pbt; *(u32x4*)(KtT + ch * RST + sg * 8) = pkt; *(u32x4*)(VT + ch * RST + sg * 8) = pvt;
        }
        __syncthreads();
        {
            RW_STAGE_VARS
            const int m = wave >> 1;
            const bf16_t* Ym = (m == 0 || m == 2) ? Bt : Kt; const bf16_t* Xm = (m < 2) ? At : Rt;
#pragma unroll 1
            for (int q = 0; q < 8; ++q) {
                const int tix = (wave & 1) * 8 + q, it = tix >> 2, tt = tix & 3;
                f32x4 acc = (f32x4){0.f, 0.f, 0.f, 0.f};
                if (it <= tt) acc = tile_nt(Ym, it, Xm, tt, acc, col, g);
                const int t = tt * 16 + col, i0 = it * 16 + 4 * g;
                float o4[4];
#pragma unroll
                for (int r = 0; r < 4; ++r) { const int i = i0 + r; const bool ok = m < 2 ? (i < t) : (i <= t); o4[r] = ok ? acc[r] : 0.f; }
                if (m == 0) {
#pragma unroll
                    for (int r = 0; r < 4; ++r) LabT[(i0 + r) * 64 + t] = o4[r];
                }
                else { bf16_t* dst = (m == 1 ? Lak : (m == 2 ? Mrb : Mrk)) + t * RST + i0; u32x2 w2; w2.x = pk2(o4[0], o4[1]); w2.y = pk2(o4[2], o4[3]); *(u32x2*)dst = w2; }
            }
        }
        __syncthreads();
        {
            RW_STAGE_VARS
#pragma unroll
            for (int q = 0; q < 2; ++q) {
                const int tix = wave * 2 + q, tt = tix >> 2, et = tix & 3;
                f32x4 acc = (f32x4){0.f, 0.f, 0.f, 0.f};
                acc = tile_nt(Lak, tt, VT, et, acc, col, g);
#pragma unroll
                for (int r = 0; r < 4; ++r) ZsB[4096 + (tt * 16 + 4 * g + r) * 64 + et * 16 + col] = acc[r];
            }
#pragma unroll
            for (int q = 0; q < 8; ++q) { const int idx = tid + NTHREADS * q; ZsB[idx] = bf_lo((unsigned)At[(idx >> 6) * RST + (idx & 63)]); }
        }
        __syncthreads();
        {
            RW_STAGE_VARS
            if (wave < 2) {
                float* Zs = ZsB + wave * 4096 + lane;
                bf16_t* dst = (wave == 0 ? YT : W2T) + lane * RST;
#pragma unroll 1
                for (int bb = 0; bb < 4; ++bb) {
                    float acc[16];
#pragma unroll
                    for (int r = 0; r < 16; ++r) acc[r] = Zs[(16 * bb + r) * 64];
#pragma unroll 2
                    for (int i = 0; i < 16 * bb; ++i) {
                        const float z = Zs[i * 64];
                        const float* lp = LabT + i * 64 + 16 * bb;
                        const f32x4 l0 = *(const f32x4*)lp, l1 = *(const f32x4*)(lp + 4), l2 = *(const f32x4*)(lp + 8), l3 = *(const f32x4*)(lp + 12);
                        acc[0] += l0.x * z; acc[1] += l0.y * z; acc[2] += l0.z * z; acc[3] += l0.w * z;
                        acc[4] += l1.x * z; acc[5] += l1.y * z; acc[6] += l1.z * z; acc[7] += l1.w * z;
                        acc[8] += l2.x * z; acc[9] += l2.y * z; acc[10] += l2.z * z; acc[11] += l2.w * z;
                        acc[12] += l3.x * z; acc[13] += l3.y * z; acc[14] += l3.z * z; acc[15] += l3.w * z;
                    }
                    const float* dp = LabT + (16 * bb) * 64 + 16 * bb;
#pragma unroll
                    for (int r = 1; r < 16; ++r)
#pragma unroll
                        for (int r2 = 0; r2 < r; ++r2) acc[r] += dp[r2 * 64 + r] * acc[r2];
#pragma unroll
                    for (int r = 0; r < 16; ++r) Zs[(16 * bb + r) * 64] = acc[r];
                    u32x4 w0, w1;
                    w0.x = pk2(acc[0], acc[1]); w0.y = pk2(acc[2], acc[3]); w0.z = pk2(acc[4], acc[5]); w0.w = pk2(acc[6], acc[7]);
                    w1.x = pk2(acc[8], acc[9]); w1.y = pk2(acc[10], acc[11]); w1.z = pk2(acc[12], acc[13]); w1.w = pk2(acc[14], acc[15]);
                    *(u32x4*)(dst + 16 * bb) = w0; *(u32x4*)(dst + 16 * bb + 8) = w1;
                }
            }
        }
        __syncthreads();
        {
            RW_STAGE_VARS
            const int ty = wave >> 1;
#pragma unroll 1
            for (int q = 0; q < 8; ++q) {
                const int tix = (wave & 1) * 8 + q, ra = tix >> 2, cb = tix & 3;
                f32x4 acc = (f32x4){0.f, 0.f, 0.f, 0.f};
                if (ty == 0) {
                    acc = tile_nt(Mrb, ra, YT, cb, acc, col, g);
#pragma unroll
                    for (int r = 0; r < 4; ++r) { const int t = ra * 16 + 4 * g + r, k = cb * 16 + col; Qg[(size_t)u * 4096 + t * 64 + k] = (bf16_t)f2bf(acc[r] + bf_lo((unsigned)Rt[t * RST + k])); }
                } else if (ty == 1) {
                    acc = tile_nt(Mrb, ra, W2T, cb, acc, col, g); acc = tile_nt(Mrk, ra, VT, cb, acc, col, g);
                    *(f32x4*)(Hg + (size_t)u * 4096 + (tix * 64 + lane) * 4) = acc;
                } else if (ty == 2) {
                    acc = tile_nt(BtT, ra, YT, cb, acc, col, g);
#pragma unroll
                    for (int r = 0; r < 4; ++r) { const int k1 = ra * 16 + 4 * g + r, k = cb * 16 + col; Ag[(size_t)u * 4096 + k1 * 64 + k] = (bf16_t)f2bf(PC[k1] * (acc[r] + (k1 == k ? 1.0f : 0.f))); }
                } else {
                    acc = tile_nt(BtT, ra, W2T, cb, acc, col, g); acc = tile_nt(KtT, ra, VT, cb, acc, col, g);
#pragma unroll
                    for (int r = 0; r < 4; ++r) acc[r] *= PC[ra * 16 + 4 * g + r];
                    *(f32x4*)(Gg + (size_t)u * 4096 + (tix * 64 + lane) * 4) = acc;
                }
            }
        }
    }
    __syncthreads();
#undef RW_STAGE_VARS
}
__device__ __forceinline__ void phase_rwkv_seq(const Params& P, int l, unsigned char* smem, int wv) {
    ParamsPtr pp = PARAMS_PTR(P); PIN_S(pp); unsigned char* ws = pp->ws; int bidx = (int)blockIdx.x, gdim = (int)gridDim.x; PIN_S(bidx); PIN_S(gdim);
    const bf16_t* Ag = (const bf16_t*)(ws + O_RA); const float* Gg = (const float*)(ws + O_RG); bf16_t* Sg = (bf16_t*)(ws + O_RS);
    const int tid = phase_tid(wv), lane = tid & 63, wave = tid >> 6, col = lane & 15, g = lane >> 4;
    const int gw = wave * gdim + bidx, ngw = NWAVES * gdim;
    for (int un = gw; un < 2 * NB * RH * 2; un += ngw) {
        const int ch = un >> 1, eh = un & 1;
        f32x4 acc[4][2];
#pragma unroll
        for (int a_ = 0; a_ < 4; ++a_)
#pragma unroll
            for (int b_ = 0; b_ < 2; ++b_) acc[a_][b_] = (f32x4){0.f, 0.f, 0.f, 0.f};
        u32x2 alo[4][2], ahi[4][2]; f32x4 gq[4][2];
        const unsigned aoff = (unsigned)(col * 64 + 4 * g), goff = (unsigned)(lane * 4);
#define RS_LOAD(cc) do { const bf16_t* ab_ = Ag + (size_t)(ch * RNC + (cc)) * 4096; const float* gb_ = Gg + (size_t)(ch * RNC + (cc)) * 4096 + eh * 512; \
            _Pragma("unroll") for (int ra = 0; ra < 4; ++ra) _Pragma("unroll") for (int p = 0; p < 2; ++p) { alo[ra][p] = *(const u32x2*)(ab_ + (ra * 1024 + p * 32) + aoff); ahi[ra][p] = *(const u32x2*)(ab_ + (ra * 1024 + p * 32 + 16) + aoff); } \
            _Pragma("unroll") for (int ra = 0; ra < 4; ++ra) _Pragma("unroll") for (int cb = 0; cb < 2; ++cb) gq[ra][cb] = *(const f32x4*)(gb_ + ((ra * 4 + cb) * 256) + goff); } while (0)
        RS_LOAD(0);
#pragma unroll 1
        for (int c = 0; c < RNC; ++c) {
            bf16_t* sb_ = Sg + (size_t)(ch * RNC + c) * 4096 + eh * 2048;
            bf16x8 bq[2][2];
#pragma unroll
            for (int cb = 0; cb < 2; ++cb) {
#pragma unroll
                for (int ra = 0; ra < 4; ++ra) {
                    u32x2 w2; w2.x = pk2(acc[ra][cb][0], acc[ra][cb][1]); w2.y = pk2(acc[ra][cb][2], acc[ra][cb][3]);
                    *(u32x2*)(sb_ + (cb * 1024 + ra * 16) + aoff) = w2;
                }
#pragma unroll
                for (int p = 0; p < 2; ++p) bq[p][cb] = cvt8(acc[2 * p][cb], acc[2 * p + 1][cb]);
            }
            u32x4 af[4][2];
#pragma unroll
            for (int ra = 0; ra < 4; ++ra) {
#pragma unroll
                for (int p = 0; p < 2; ++p) af[ra][p] = (u32x4){alo[ra][p].x, alo[ra][p].y, ahi[ra][p].x, ahi[ra][p].y};
#pragma unroll
                for (int cb = 0; cb < 2; ++cb) acc[ra][cb] = gq[ra][cb];
            }
            if (c + 1 < RNC) RS_LOAD(c + 1);
#pragma unroll
            for (int ra = 0; ra < 4; ++ra)
#pragma unroll
                for (int cb = 0; cb < 2; ++cb)
#pragma unroll
                    for (int p = 0; p < 2; ++p) acc[ra][cb] = MFMA16(__builtin_bit_cast(bf16x8, af[ra][p]), bq[p][cb], acc[ra][cb]);
        }
#undef RS_LOAD
    }
}
__device__ __forceinline__ void phase_rwkv_out(const Params& P, int l, unsigned char* smem, int wv) {
    ParamsPtr pp = PARAMS_PTR(P); PIN_S(pp); unsigned char* ws = pp->ws; int bidx = (int)blockIdx.x, gdim = (int)gridDim.x; PIN_S(bidx); PIN_S(gdim);
    const bf16_t* Qg = (const bf16_t*)(ws + O_RQ); const bf16_t* Sg = (const bf16_t*)(ws + O_RS); const float* Hg = (const float*)(ws + O_RH);
    const float* VV = (const float*)(ws + O_VV); const float* GATE = (const float*)(ws + O_GATE); const float* BONUS = (const float*)(ws + O_BONUS);
    bf16_t* GRP = (bf16_t*)(ws + O_GRP);
    const float* rln_g = pp->in[15] + (size_t)l * RW; const float* rln_b = pp->in[16] + (size_t)l * RW;
    const int tid = phase_tid(wv), lane = tid & 63, wave = tid >> 6, col = lane & 15, g = lane >> 4;
    for (int pu = bidx * NWAVES + wave; pu < NB * RH * RNC; pu += gdim * NWAVES) {
        const int c = pu % RNC, h = (pu / RNC) % RH, b = pu / (RNC * RH);
        f32x4 o[2][4][4];
#pragma unroll
        for (int d = 0; d < 2; ++d) {
            const int u = ((d * NB + b) * RH + h) * RNC + (d ? RNC - 1 - c : c);
            const size_t ub = (size_t)u * 4096;
            bf16x8 qa[4][2], sb[4][2];
#pragma unroll
            for (int q = 0; q < 4; ++q)
#pragma unroll
                for (int ks = 0; ks < 2; ++ks) { qa[q][ks] = *(const bf16x8*)(Qg + ub + (q * 16 + col) * 64 + ks * 32 + 8 * g); sb[q][ks] = *(const bf16x8*)(Sg + ub + (q * 16 + col) * 64 + ks * 32 + 8 * g); }
#pragma unroll
            for (int tt = 0; tt < 4; ++tt)
#pragma unroll
                for (int et = 0; et < 4; ++et) {
                    f32x4 acc = *(const f32x4*)(Hg + ub + ((tt * 4 + et) * 64 + lane) * 4);
#pragma unroll
                    for (int ks = 0; ks < 2; ++ks) acc = MFMA16(qa[tt][ks], sb[et][ks], acc);
                    o[d][tt][et] = acc;
                }
        }
        const int src = (3 - g) * 16 + col;
#pragma unroll
        for (int tt = 0; tt < 4; ++tt)
#pragma unroll
            for (int et = 0; et < 4; ++et)
#pragma unroll
                for (int r = 0; r < 4; ++r) o[0][tt][et][r] += SHL(o[1][3 - tt][et][3 - r], src);
#pragma unroll
        for (int tt = 0; tt < 4; ++tt)
#pragma unroll
            for (int r = 0; r < 4; ++r) {
                float sm = (o[0][tt][0][r] + o[0][tt][1][r]) + (o[0][tt][2][r] + o[0][tt][3][r]);
                sm = row16_sum(sm);
                const float mean = sm * (1.0f / 64.0f);
                float q = 0.f;
#pragma unroll
                for (int et = 0; et < 4; ++et) { const float dl = o[0][tt][et][r] - mean; q += dl * dl; }
                q = row16_sum(q);
                const float rstd = 1.0f / sqrtf(q * (1.0f / 64.0f) + GN_EPS);
                const size_t t = (size_t)(b * S + c * RC + tt * 16 + 4 * g + r);
                const float bon = BONUS[t * RH + h];
#pragma unroll
                for (int et = 0; et < 4; ++et) {
                    const int ch = h * 64 + et * 16 + col;
                    float y = (o[0][tt][et][r] - mean) * rstd * rln_g[ch] + rln_b[ch];
                    y += bon * VV[t * RW + ch];
                    GRP[t * D + GW + ch] = (bf16_t)f2bf(y * GATE[t * RW + ch]);
                }
            }
    }
}

__device__ __forceinline__ void phase_mlstm_local(const Params& P, int l, unsigned char* smem, int wv, int bid, int nb) {
    PIN_S(bid); PIN_S(nb);
    ParamsPtr pp = PARAMS_PTR(P); PIN_S(pp); unsigned char* ws = pp->ws;
    const bf16_t* KT = (const bf16_t*)(ws + O_KT); const bf16_t* VT = (const bf16_t*)(ws + O_VT);
    const float* IG = (const float*)(ws + O_IG); const float* LF = (const float*)(ws + O_LF);
    float* CL = (float*)(ws + O_CL); float* NLb = (float*)(ws + O_NL); float* ML = (float*)(ws + O_ML); float* BL = (float*)(ws + O_BL);
    float* GVT = (float*)(ws + O_GVT); float* PMX = (float*)(ws + O_PMX); float* BCT = (float*)(ws + O_BCT);
    const int tid = phase_tid(wv), lane = tid & 63, wave = tid >> 6, col = lane & 15, g = lane >> 4;
    float* wts = (float*)smem + wave * 128;
    for (int u = bid * NWAVES + wave; u < 2 * NB * MH * NCH; u += nb * NWAVES) {
        const int c = u % NCH, h = (u / NCH) % MH, p = u / (NCH * MH), d = p / NB, b = p % NB;
        const int tc = d ? NCH - 1 - c : c, tok0 = b * S + tc * CH;
        const int i0 = d ? 127 - 2 * lane : 2 * lane, i1 = d ? i0 - 1 : i0 + 1;
        const size_t g0 = ((size_t)d * T + tok0 + i0) * MH + h, g1 = ((size_t)d * T + tok0 + i1) * MH + h;
        const float lf0 = LF[g0], lf1 = LF[g1], ig0 = IG[g0], ig1 = IG[g1];
        const float c1 = lf0 + lf1;
        float incl = c1;
#pragma unroll
        for (int o = 1; o < 64; o <<= 1) { const float tq = SHUP(incl, o, lane); if (lane >= o) incl += tq; }
        const float excl = incl - c1, bc0 = excl + lf0, bc1 = incl;
        const float blast = RDL(incl, 63);
        const float gv0 = ig0 - bc0, gv1 = ig1 - bc1, pl1 = fmaxf(gv0, gv1);
        float mincl = pl1;
#pragma unroll
        for (int o = 1; o < 64; o <<= 1) { const float tq = SHUP(mincl, o, lane); if (lane >= o) mincl = fmaxf(mincl, tq); }
        float mexcl = SHUP(mincl, 1, lane); if (lane == 0) mexcl = -INFINITY;
        const float pm0 = fmaxf(mexcl, gv0), pm1 = mincl;
        const float mloc = blast + RDL(mincl, 63);
        WAVE_SYNC();
        wts[i0] = expf(blast + gv0 - mloc); wts[i1] = expf(blast + gv1 - mloc);
        GVT[g0] = gv0; GVT[g1] = gv1; PMX[g0] = pm0; PMX[g1] = pm1; BCT[g0] = bc0; BCT[g1] = bc1;
        if (lane == 0) { ML[u] = mloc; BL[u] = blast; }
        WAVE_SYNC();
        const bf16_t* vbase = VT + ((size_t)(b * MH + h) * 64) * S + (size_t)tc * CH;
        const bf16_t* kbase = KT + ((size_t)(b * MH + h) * 64) * S + (size_t)tc * CH;
        const unsigned loff = (unsigned)(col * S + 8 * g);
        f32x4 acc[4][4];
#pragma unroll
        for (int a_ = 0; a_ < 4; ++a_)
#pragma unroll
            for (int b_ = 0; b_ < 4; ++b_) acc[a_][b_] = (f32x4){0.f, 0.f, 0.f, 0.f};
        float nsum[4] = {0.f, 0.f, 0.f, 0.f};
#pragma unroll 1
        for (int ks = 0; ks < 4; ++ks) {
            const int ii = ks * 32 + 8 * g;
            const f32x4 w0 = *(const f32x4*)(wts + ii), w1 = *(const f32x4*)(wts + ii + 4);
            bf16x8 af[4], bfk[4];
#pragma unroll
            for (int q = 0; q < 4; ++q) af[q] = *(const bf16x8*)(vbase + ((size_t)q * 16 * S + ks * 32) + loff);
#pragma unroll
            for (int q = 0; q < 4; ++q) {
                const u32x4 kr = *(const u32x4*)(kbase + ((size_t)q * 16 * S + ks * 32) + loff);
                f32x4 k0, k1;
                k0.x = bf_lo(kr.x) * w0.x; k0.y = bf_hi(kr.x) * w0.y; k0.z = bf_lo(kr.y) * w0.z; k0.w = bf_hi(kr.y) * w0.w;
                k1.x = bf_lo(kr.z) * w1.x; k1.y = bf_hi(kr.z) * w1.y; k1.z = bf_lo(kr.w) * w1.z; k1.w = bf_hi(kr.w) * w1.w;
                nsum[q] += (k0.x + k0.y) + (k0.z + k0.w) + (k1.x + k1.y) + (k1.z + k1.w);
                bfk[q] = cvt8(k0, k1);
            }
#pragma unroll
            for (int a_ = 0; a_ < 4; ++a_)
#pragma unroll
                for (int b_ = 0; b_ < 4; ++b_) acc[a_][b_] = MFMA16(af[a_], bfk[b_], acc[a_][b_]);
        }
        float* cbase = CL + (size_t)u * 4096;
        const unsigned coff = (unsigned)(4 * g * 64 + col);
#pragma unroll
        for (int b_ = 0; b_ < 4; ++b_) {
#pragma unroll
            for (int a_ = 0; a_ < 4; ++a_)
#pragma unroll
                for (int r = 0; r < 4; ++r) cbase[(a_ * 16 * 64 + r * 64 + b_ * 16) + coff] = acc[a_][b_][r];
            float ns = nsum[b_]; ns += SHX(ns, 16, lane); ns += SHX(ns, 32, lane);
            if (g == 0) NLb[(size_t)u * 64 + b_ * 16 + col] = ns;
        }
    }
    __syncthreads();
}

__device__ __forceinline__ void phase_mlstm_carry(const Params& P, int l, unsigned char* smem, int wv) {
    ParamsPtr pp = PARAMS_PTR(P); PIN_S(pp); unsigned char* ws = pp->ws; int bidx = (int)blockIdx.x, gdim = (int)gridDim.x; PIN_S(bidx); PIN_S(gdim);
    float* CL = (float*)(ws + O_CL); float* NLb = (float*)(ws + O_NL); const float* ML = (const float*)(ws + O_ML); const float* BL = (const float*)(ws + O_BL);
    float* MIN = (float*)(ws + O_MIN);
    const int total = 2 * NB * MH * 4160;
    const int tid = phase_tid(wv);
    for (int g = bidx * NTHREADS + tid; g < total; g += gdim * NTHREADS) {
        const int ph = g / 4160, e = g % 4160;
        float m = 0.f, val = 0.f;
        for (int c = 0; c < NCH; ++c) {
            const int base = ph * NCH + c;
            float* ptr = e < 4096 ? CL + (size_t)base * 4096 + e : NLb + (size_t)base * 64 + (e - 4096);
            const float loc = *ptr;
            *ptr = val;
            if (e == 0) MIN[base] = m;
            const float bl = BL[base], ml = ML[base];
            const float mn = fmaxf(bl + m, ml);
            val = expf(bl + m - mn) * val + expf(ml - mn) * loc;
            m = mn;
        }
    }
}

__device__ __forceinline__ void phase_mlstm_out(const Params& P, int l, unsigned char* smem, int wv) {
    ParamsPtr pp = PARAMS_PTR(P); PIN_S(pp); unsigned char* ws = pp->ws; int bidx = (int)blockIdx.x, gdim = (int)gridDim.x; PIN_S(bidx); PIN_S(gdim);
    const float* proj = (const float*)(ws + O_PROJ);
    const bf16_t* MQB = (const bf16_t*)(ws + O_MQB); const bf16_t* MKB = (const bf16_t*)(ws + O_MKB); const bf16_t* VT = (const bf16_t*)(ws + O_VT);
    const float* GVT = (const float*)(ws + O_GVT); const float* PMX = (const float*)(ws + O_PMX); const float* BCT = (const float*)(ws + O_BCT);
    const float* CL = (const float*)(ws + O_CL); const float* NLb = (const float*)(ws + O_NL); const float* MIN = (const float*)(ws + O_MIN);
    bf16_t* GRP = (bf16_t*)(ws + O_GRP);
    const float* mln_g = pp->in[20] + (size_t)l * MW;
    const int tid = phase_tid(wv), lane = tid & 63, wave = tid >> 6, col = lane & 15, g = lane >> 4;
    for (int u = bidx; u < NB * MH * NCH; u += gdim) {
        const int tc = u % NCH, h = (u / NCH) % MH, b = u / (NCH * MH);
        const int tok0 = b * S + tc * CH, it = wave * 16 + col;
        const size_t trow = (size_t)(tok0 + it);
        bf16x8 bq[2];
#pragma unroll
        for (int ks = 0; ks < 2; ++ks) bq[ks] = *(const bf16x8*)(MQB + trow * MW + h * 64 + ks * 32 + 8 * g);
        const size_t vrow = ((size_t)(b * MH + h) * 64) * S + (size_t)tc * CH;
        f32x4 hs[4];
#pragma unroll
        for (int et = 0; et < 4; ++et) hs[et] = (f32x4){0.f, 0.f, 0.f, 0.f};
#pragma unroll
        for (int d = 0; d < 2; ++d) {
            const int cd = d ? NCH - 1 - tc : tc;
            const int su = ((d * NB + b) * MH + h) * NCH + cd;
            const size_t gt = ((size_t)d * T + trow) * MH + h;
            const float mst = MIN[su];
            const float mxt = fmaxf(PMX[gt], mst), mt = BCT[gt] + mxt, wint = expf(mst - mxt);
            f32x4 num[4];
#pragma unroll
            for (int et = 0; et < 4; ++et) num[et] = (f32x4){0.f, 0.f, 0.f, 0.f};
            float den = 0.f;
            for (int sp = 0; sp < 4; ++sp) {
                if (d == 0 ? (2 * sp > wave) : (2 * sp + 1 < wave)) continue;
                float pw[8];
#pragma unroll
                for (int hf = 0; hf < 2; ++hf) {
                    const int st = 2 * sp + hf;
                    f32x4 sacc = (f32x4){0.f, 0.f, 0.f, 0.f};
#pragma unroll
                    for (int ks = 0; ks < 2; ++ks) {
                        const bf16x8 kf = *(const bf16x8*)(MKB + (size_t)(tok0 + st * 16 + col) * MW + h * 64 + ks * 32 + 8 * g);
                        sacc = MFMA16(kf, bq[ks], sacc);
                    }
#pragma unroll
                    for (int r = 0; r < 4; ++r) {
                        const int is = st * 16 + 4 * g + r;
                        const bool ok = d == 0 ? (is <= it) : (is >= it);
                        const float gvs = GVT[((size_t)d * T + tok0 + is) * MH + h];
                        const float pr = ok ? sacc[r] * expf(gvs - mxt) : 0.f;
                        den += pr; pw[hf * 4 + r] = pr;
                    }
                }
                u32x4 pb; pb.x = pk2(pw[0], pw[1]); pb.y = pk2(pw[2], pw[3]); pb.z = pk2(pw[4], pw[5]); pb.w = pk2(pw[6], pw[7]);
                const bf16x8 bp = __builtin_bit_cast(bf16x8, pb);
#pragma unroll
                for (int et = 0; et < 4; ++et) {
                    const bf16_t* vp = VT + vrow + (size_t)(et * 16 + col) * S + sp * 32 + 4 * g;
                    const u32x2 v0 = *(const u32x2*)vp, v1 = *(const u32x2*)(vp + 16);
                    u32x4 va; va.x = v0.x; va.y = v0.y; va.z = v1.x; va.w = v1.y;
                    num[et] = MFMA16(__builtin_bit_cast(bf16x8, va), bp, num[et]);
                }
            }
            den += SHX(den, 16, lane); den += SHX(den, 32, lane);
            f32x4 qc[4]; float qn = 0.f;
#pragma unroll
            for (int ks = 0; ks < 2; ++ks) {
                const float* np = NLb + (size_t)su * 64 + ks * 32 + 8 * g;
                const f32x4 n0 = *(const f32x4*)np, n1 = *(const f32x4*)(np + 4);
                const u32x4 qb = __builtin_bit_cast(u32x4, bq[ks]);
                qn += (bf_lo(qb.x) * n0.x + bf_hi(qb.x) * n0.y) + (bf_lo(qb.y) * n0.z + bf_hi(qb.y) * n0.w) + (bf_lo(qb.z) * n1.x + bf_hi(qb.z) * n1.y) + (bf_lo(qb.w) * n1.z + bf_hi(qb.w) * n1.w);
            }
            qn += SHX(qn, 16, lane); qn += SHX(qn, 32, lane);
#pragma unroll
            for (int et = 0; et < 4; ++et) {
                qc[et] = (f32x4){0.f, 0.f, 0.f, 0.f};
#pragma unroll
                for (int ks = 0; ks < 2; ++ks) {
                    const float* cp = CL + (size_t)su * 4096 + (size_t)(et * 16 + col) * 64 + ks * 32 + 8 * g;
                    qc[et] = MFMA16(cvt8(*(const f32x4*)cp, *(const f32x4*)(cp + 4)), bq[ks], qc[et]);
                }
            }
            const float dd = 1.0f / fmaxf(fabsf(den + wint * qn), expf(-mt));
#pragma unroll
            for (int et = 0; et < 4; ++et) hs[et] += (num[et] + wint * qc[et]) * dd;
        }
        float sm = 0.f;
#pragma unroll
        for (int et = 0; et < 4; ++et) sm += (hs[et].x + hs[et].y) + (hs[et].z + hs[et].w);
        sm += SHX(sm, 16, lane); sm += SHX(sm, 32, lane);
        const float mean = sm * (1.0f / 64.0f); float q = 0.f;
#pragma unroll
        for (int et = 0; et < 4; ++et) { const f32x4 dl = hs[et] - mean; q += (dl.x * dl.x + dl.y * dl.y) + (dl.z * dl.z + dl.w * dl.w); }
        q += SHX(q, 16, lane); q += SHX(q, 32, lane);
        const float rstd = 1.0f / sqrtf(q * (1.0f / 64.0f) + LN_EPS);
#pragma unroll
        for (int et = 0; et < 4; ++et) {
            const int c = h * 64 + et * 16 + 4 * g;
            const f32x4 o4 = *(const f32x4*)(proj + trow * PLD + C_MW + 3 * MW + c), g4 = *(const f32x4*)(mln_g + c);
            const f32x4 y = (hs[et] - mean) * rstd * g4;
            u32x2 ob; ob.x = pk2(sigmoidf_(o4.x) * y.x, sigmoidf_(o4.y) * y.y); ob.y = pk2(sigmoidf_(o4.z) * y.z, sigmoidf_(o4.w) * y.w);
            *(u32x2*)(GRP + trow * D + GW + RW + c) = ob;
        }
    }
}

__device__ __forceinline__ void phase_rwkv_post(const Params& P, int l, unsigned char* smem, int wv) {
    ParamsPtr pp = PARAMS_PTR(P); PIN_S(pp); unsigned char* ws = pp->ws; int bidx = (int)blockIdx.x, gdim = (int)gridDim.x; PIN_S(bidx); PIN_S(gdim);
    const float* SCAN = (const float*)(ws + O_SCAN); const float* VV = (const float*)(ws + O_VV); const float* GATE = (const float*)(ws + O_GATE);
    const float* BONUS = (const float*)(ws + O_BONUS); bf16_t* GRP = (bf16_t*)(ws + O_GRP);
    const float* rln_g = pp->in[15] + (size_t)l * RW; const float* rln_b = pp->in[16] + (size_t)l * RW;
    const int tid = phase_tid(wv), lane = tid & 63, wave = tid >> 6;
    const int gw = bidx * NWAVES + wave, ngw = NWAVES * gdim;
    for (int it = gw; it < T * RH; it += ngw) {
        const int t = it / RH, h = it % RH, c = h * 64 + lane;
        const size_t o = (size_t)t * RW + c;
        const float x = SCAN[o] + SCAN[(size_t)T * RW + o];
        const float mean = wave_sum(x, lane) * (1.0f / 64.0f);
        const float dl = x - mean;
        const float var = wave_sum(dl * dl, lane) * (1.0f / 64.0f);
        float y = dl / sqrtf(var + GN_EPS) * rln_g[c] + rln_b[c];
        y += BONUS[(size_t)t * RH + h] * VV[o];
        GRP[(size_t)t * D + GW + c] = (bf16_t)f2bf(y * GATE[o]);
    }
}

__device__ __forceinline__ void phase_ln1_router(const Params& P, int l, unsigned char* smem, int wv) {
    ParamsPtr pp = PARAMS_PTR(P); PIN_S(pp); unsigned char* ws = pp->ws; int bidx = (int)blockIdx.x, gdim = (int)gridDim.x; PIN_S(bidx); PIN_S(gdim);
    const float* xin = l == 0 ? pp->in[0] : (const float*)(ws + O_XA);
    const float* MIX = (const float*)(ws + O_MIX); float* X1 = (float*)(ws + O_X1);
    int* TOPI = (int*)(ws + O_TOPI); float* TOPG = (float*)(ws + O_TOPG); int* RANK = (int*)(ws + O_RANK); bf16_t* X1B = (bf16_t*)(ws + O_X1B);
    int* BCNT = (int*)(ws + O_BCNT);
    const float* g1 = pp->in[22] + (size_t)l * D; const float* b1 = pp->in[23] + (size_t)l * D;
    const float* rw = pp->in[24] + (size_t)l * D * NE; const float* rb = pp->in[25] + (size_t)l * NE;
    const int tid = phase_tid(wv), lane = tid & 63, wave = tid >> 6;
    float* Wl = (float*)smem;
    float* lgs = (float*)(smem + 131072);
    int* stopi = (int*)(smem + 131072 + 8192);
    __syncthreads();
    for (int i = tid; i < D * NE / 4; i += NTHREADS) ((f32x4*)Wl)[i] = ((const f32x4*)rw)[i];
    for (int tile = bidx; tile < T / 64; tile += gdim) {
        __syncthreads();
        for (int ti8 = 0; ti8 < 8; ++ti8) {
            const int t = tile * 64 + wave * 8 + ti8;
            float v[16]; float sm = 0.f;
#pragma unroll
            for (int j = 0; j < 4; ++j) {
                const int c = j * 256 + lane * 4;
                const f32x4 a = *(const f32x4*)(xin + (size_t)t * D + c), m = *(const f32x4*)(MIX + (size_t)t * D + c);
                v[j * 4 + 0] = ALPHA * a.x + m.x; v[j * 4 + 1] = ALPHA * a.y + m.y; v[j * 4 + 2] = ALPHA * a.z + m.z; v[j * 4 + 3] = ALPHA * a.w + m.w;
                sm += (v[j * 4] + v[j * 4 + 1]) + (v[j * 4 + 2] + v[j * 4 + 3]);
            }
            const float mean = wave_sum(sm, lane) * (1.0f / D); float q = 0.f;
#pragma unroll
            for (int j = 0; j < 16; ++j) { const float dl = v[j] - mean; q += dl * dl; }
            const float rstd = 1.0f / sqrtf(wave_sum(q, lane) * (1.0f / D) + LN_EPS);
#pragma unroll
            for (int j = 0; j < 4; ++j) {
                const int c = j * 256 + lane * 4;
                const f32x4 gg = *(const f32x4*)(g1 + c), bb = *(const f32x4*)(b1 + c);
                f32x4 o;
                o.x = (v[j * 4 + 0] - mean) * rstd * gg.x + bb.x; o.y = (v[j * 4 + 1] - mean) * rstd * gg.y + bb.y;
                o.z = (v[j * 4 + 2] - mean) * rstd * gg.z + bb.z; o.w = (v[j * 4 + 3] - mean) * rstd * gg.w + bb.w;
                *(f32x4*)(X1 + (size_t)t * D + c) = o;
                u32x2 ob; ob.x = pk2(o.x, o.y); ob.y = pk2(o.z, o.w); *(u32x2*)(X1B + (size_t)t * D + c) = ob;
            }
        }
        __syncthreads();
        {
            const int tq = tid >> 3, eg = (tid & 7) * 4;
            const float* xr = X1 + (size_t)(tile * 64 + tq) * D;
            f32x4 acc = *(const f32x4*)(rb + eg);
#pragma unroll 4
            for (int c = 0; c < D; c += 4) {
                const f32x4 x4 = *(const f32x4*)(xr + c);
                acc += x4.x * *(const f32x4*)(Wl + (c + 0) * NE + eg); acc += x4.y * *(const f32x4*)(Wl + (c + 1) * NE + eg);
                acc += x4.z * *(const f32x4*)(Wl + (c + 2) * NE + eg); acc += x4.w * *(const f32x4*)(Wl + (c + 3) * NE + eg);
            }
            *(f32x4*)(lgs + tq * NE + eg) = acc;
        }
        __syncthreads();
        if (tid < 64) {
            const float* lp = lgs + tid * NE; const int t = tile * 64 + tid;
            float tv[4]; int ti[4];
#pragma unroll
            for (int k = 0; k < 4; ++k) { tv[k] = -INFINITY; ti[k] = 0; }
            for (int e = 0; e < NE; ++e) {
                const float x = lp[e];
                if (x > tv[3]) {
                    if (x > tv[0]) { tv[3] = tv[2]; ti[3] = ti[2]; tv[2] = tv[1]; ti[2] = ti[1]; tv[1] = tv[0]; ti[1] = ti[0]; tv[0] = x; ti[0] = e; }
                    else if (x > tv[1]) { tv[3] = tv[2]; ti[3] = ti[2]; tv[2] = tv[1]; ti[2] = ti[1]; tv[1] = x; ti[1] = e; }
                    else if (x > tv[2]) { tv[3] = tv[2]; ti[3] = ti[2]; tv[2] = x; ti[2] = e; }
                    else { tv[3] = x; ti[3] = e; }
                }
            }
            const float e1 = expf(tv[1] - tv[0]), e2 = expf(tv[2] - tv[0]), e3 = expf(tv[3] - tv[0]);
            const float inv = 1.0f / (1.0f + e1 + e2 + e3);
            *(f32x4*)(TOPG + (size_t)t * 4) = (f32x4){inv, e1 * inv, e2 * inv, e3 * inv};
#pragma unroll
            for (int k = 0; k < 4; ++k) { TOPI[(size_t)t * 4 + k] = ti[k]; stopi[tid * 4 + k] = ti[k]; }
        }
        __syncthreads();
        if (tid < 256) { const int e = stopi[tid]; int r = 0; for (int a2 = 0; a2 < tid; ++a2) r += (stopi[a2] == e) ? 1 : 0; RANK[(size_t)tile * 256 + tid] = r; }
        else if (tid < 256 + NE) { const int e = tid - 256; int cnt = 0; for (int a2 = 0; a2 < 256; ++a2) cnt += (stopi[a2] == e) ? 1 : 0; BCNT[tile * NE + e] = cnt; }
    }
    __syncthreads();
}

__device__ __forceinline__ void moe_offsets(int* sh, const int* CNT, int tid) {
    if (tid == 0) {
        int acc = 0;
        for (int e = 0; e < NE; ++e) { const int c = (int)CNT[e]; sh[e] = c; sh[32 + e] = acc; acc += (c + MOEB - 1) / MOEB * MOEB; sh[64 + e] = acc; }
    }
    __syncthreads();
}
__device__ __forceinline__ int moe_expert_of_row(const int* sh, int r) {
    int e = -1;
    for (int i = 0; i < NE; ++i) if (r >= sh[32 + i] && r < sh[64 + i]) e = i;
    return e;
}

__device__ __forceinline__ void phase_scatter(const Params& P, int l, unsigned char* smem, int wv) {
    ParamsPtr pp = PARAMS_PTR(P); PIN_S(pp); unsigned char* ws = pp->ws; int bidx = (int)blockIdx.x, gdim = (int)gridDim.x; PIN_S(bidx); PIN_S(gdim);
    const int tid = phase_tid(wv), lane = tid & 63, wave = tid >> 6;
    const int* TOPI = (const int*)(ws + O_TOPI); const int* RANK = (const int*)(ws + O_RANK); int* SLOT = (int*)(ws + O_SLOT);
    const int* BCNT = (const int*)(ws + O_BCNT); int* CNTF = (int*)(ws + O_CNTF);
    const bf16_t* X1B = (const bf16_t*)(ws + O_X1B); bf16_t* XS = (bf16_t*)(ws + O_XS);
    int* sh = (int*)smem;
    int* part = sh + 96;
    int* tot = part + 512;
    int* base = tot + 32;
    constexpr int NT = T / 64;
    const int e = tid & 31, pt = tid >> 5;
    { int sacc = 0; for (int tl = pt; tl < NT; tl += 16) sacc += BCNT[tl * NE + e]; part[pt * 32 + e] = sacc; }
    __syncthreads();
    if (tid < 32) { int sacc = 0; for (int q = 0; q < 16; ++q) sacc += part[q * 32 + tid]; tot[tid] = sacc; if (bidx == 0) CNTF[tid] = sacc; }
    __syncthreads();
    moe_offsets(sh, tot, tid);
    for (int tile = bidx; tile < NT; tile += gdim) {
        __syncthreads();
        { int sacc = 0; for (int tl = pt; tl < tile; tl += 16) sacc += BCNT[tl * NE + e]; part[pt * 32 + e] = sacc; }
        __syncthreads();
        if (tid < 32) { int sacc = sh[32 + tid]; for (int q = 0; q < 16; ++q) sacc += part[q * 32 + tid]; base[tid] = sacc; }
        __syncthreads();
        for (int al = wave; al < 256; al += NWAVES) {
            const int a = tile * 256 + al, dest = base[TOPI[a]] + RANK[a], t = a >> 2;
            if (lane == 0) SLOT[a] = dest;
            const u32x4* src = (const u32x4*)(X1B + (size_t)t * D); u32x4* dst = (u32x4*)(XS + (size_t)dest * D);
            dst[lane] = src[lane]; dst[64 + lane] = src[64 + lane];
        }
    }
    __syncthreads();
}

template <int WHICH>
__device__ __forceinline__ void phase_moe_gemm(const Params& P, int l, unsigned char* smem, int wv) {
    ParamsPtr pp = PARAMS_PTR(P); PIN_S(pp); unsigned char* ws = pp->ws; int bidx = (int)blockIdx.x, gdim = (int)gridDim.x; PIN_S(bidx); PIN_S(gdim);
    const int tid = phase_tid(wv);
    const int* CNT = (const int*)(ws + O_CNTF);
    int* sh = (int*)(smem + 131072);
    int* rbe = sh + 96;
    moe_offsets(sh, CNT, tid);
    const int nrb = sh[64 + NE - 1] / MOEB;
    for (int rb = tid; rb < nrb; rb += NTHREADS) rbe[rb] = moe_expert_of_row(sh, rb * MOEB);
    __syncthreads();
    pg8::MoeOrder S;
    S.K = 1024; S.G = gdim; S.c = bidx; S.rbe = rbe;
    if (WHICH == 1) {
        S.A = (const char*)(ws + O_XS); S.Wt = (const char*)(ws + O_W1) + (size_t)l * NE * 2 * DFF * D * 2; S.estride = (size_t)2 * DFF * D * 2; S.nN = 2 * DFF / 256; S.nwg = nrb * S.nN;
        pg8::EpiSwiglu E{(bf16_t*)(ws + O_ACT), pp->in[27] + (size_t)l * NE * 2 * DFF};
        pg8::gemm_phase<pg8::EpiSwiglu, pg8::MoeOrder>((LAS unsigned char*)smem, 1024, S, E, tid);
    } else {
        S.A = (const char*)(ws + O_ACT); S.Wt = (const char*)(ws + O_W2) + (size_t)l * NE * D * DFF * 2; S.estride = (size_t)D * DFF * 2; S.nN = D / 256; S.nwg = nrb * S.nN;
        pg8::EpiBf16Bias E{(bf16_t*)(ws + O_YS), D, pp->in[29] + (size_t)l * NE * D, D};
        pg8::gemm_phase<pg8::EpiBf16Bias, pg8::MoeOrder>((LAS unsigned char*)smem, 1024, S, E, tid);
    }
    __syncthreads();
}

__device__ __forceinline__ void phase_combine_ln2(const Params& P, int l, unsigned char* smem, int wv) {
    ParamsPtr pp = PARAMS_PTR(P); PIN_S(pp); unsigned char* ws = pp->ws; int bidx = (int)blockIdx.x, gdim = (int)gridDim.x; PIN_S(bidx); PIN_S(gdim);
    const float* X1 = (const float*)(ws + O_X1); const bf16_t* YS = (const bf16_t*)(ws + O_YS); bf16_t* XB = (bf16_t*)(ws + O_XB);
    const int* SLOT = (const int*)(ws + O_SLOT); const float* TOPG = (const float*)(ws + O_TOPG);
    float* xo = l == NL - 1 ? pp->out : (float*)(ws + O_XA);
    const float* g2 = pp->in[30] + (size_t)l * D; const float* b2 = pp->in[31] + (size_t)l * D;
    const int tid = phase_tid(wv), lane = tid & 63, wave = tid >> 6;
    const int gw = bidx * NWAVES + wave, ngw = NWAVES * gdim;
    for (int t = gw; t < T; t += ngw) {
        int sl[4]; float gg[4];
#pragma unroll
        for (int k = 0; k < 4; ++k) { sl[k] = SLOT[(size_t)t * 4 + k]; gg[k] = TOPG[(size_t)t * 4 + k]; }
        float v[16]; float sm = 0.f;
#pragma unroll
        for (int j = 0; j < 4; ++j) {
            const int c = j * 256 + lane * 4;
            const f32x4 a = *(const f32x4*)(X1 + (size_t)t * D + c);
            f32x4 y = (f32x4){0.f, 0.f, 0.f, 0.f};
#pragma unroll
            for (int k = 0; k < 4; ++k) { const u32x2 yk = *(const u32x2*)(YS + (size_t)sl[k] * D + c);
                y.x += gg[k] * __builtin_bit_cast(float, yk.x << 16); y.y += gg[k] * __builtin_bit_cast(float, yk.x & 0xffff0000u); y.z += gg[k] * __builtin_bit_cast(float, yk.y << 16); y.w += gg[k] * __builtin_bit_cast(float, yk.y & 0xffff0000u); }
            v[j * 4 + 0] = ALPHA * a.x + y.x; v[j * 4 + 1] = ALPHA * a.y + y.y; v[j * 4 + 2] = ALPHA * a.z + y.z; v[j * 4 + 3] = ALPHA * a.w + y.w;
            sm += (v[j * 4] + v[j * 4 + 1]) + (v[j * 4 + 2] + v[j * 4 + 3]);
        }
        const float mean = wave_sum(sm, lane) * (1.0f / D); float q = 0.f;
#pragma unroll
        for (int j = 0; j < 16; ++j) { const float dl = v[j] - mean; q += dl * dl; }
        const float rstd = 1.0f / sqrtf(wave_sum(q, lane) * (1.0f / D) + LN_EPS);
#pragma unroll
        for (int j = 0; j < 4; ++j) {
            const int c = j * 256 + lane * 4;
            f32x4 o;
            o.x = (v[j * 4 + 0] - mean) * rstd * g2[c + 0] + b2[c + 0]; o.y = (v[j * 4 + 1] - mean) * rstd * g2[c + 1] + b2[c + 1];
            o.z = (v[j * 4 + 2] - mean) * rstd * g2[c + 2] + b2[c + 2]; o.w = (v[j * 4 + 3] - mean) * rstd * g2[c + 3] + b2[c + 3];
            *(f32x4*)(xo + (size_t)t * D + c) = o;
            if (l != NL - 1) { u32x2 ob; ob.x = pk2(o.x, o.y); ob.y = pk2(o.z, o.w); *(u32x2*)(XB + (size_t)t * D + c) = ob; }
        }
    }
}

__device__ __forceinline__ void phase_inproj(const Params& P, int l, unsigned char* smem, int wv) {
    ParamsPtr pp = PARAMS_PTR(P); PIN_S(pp); unsigned char* ws = pp->ws; int bidx = (int)blockIdx.x, gdim = (int)gridDim.x; PIN_S(bidx); PIN_S(gdim);
    const int tid = phase_tid(wv);
    pg8::DenseOrder S; S.init(ws + O_XB, (const bf16_t*)(ws + O_WIN) + (size_t)l * PLD * D, T, PLD, D, gdim, bidx);
    pg8::EpiF32 E{(float*)(ws + O_PROJ), PLD};
    pg8::gemm_phase<pg8::EpiF32, pg8::DenseOrder>((LAS unsigned char*)smem, D, S, E, tid);
    __syncthreads();
}
__device__ __forceinline__ void phase_outproj(const Params& P, int l, unsigned char* smem, int wv) {
    ParamsPtr pp = PARAMS_PTR(P); PIN_S(pp); unsigned char* ws = pp->ws; int bidx = (int)blockIdx.x, gdim = (int)gridDim.x; PIN_S(bidx); PIN_S(gdim);
    const int tid = phase_tid(wv);
    pg8::DenseOrder S; S.init(ws + O_GRP, (const bf16_t*)(ws + O_WOUT) + (size_t)l * D * D, T, D, D, gdim, bidx);
    pg8::EpiF32 E{(float*)(ws + O_MIX), D};
    pg8::gemm_phase<pg8::EpiF32, pg8::DenseOrder>((LAS unsigned char*)smem, D, S, E, tid);
    __syncthreads();
}

#ifndef EMU
#define XB_TMO      128
#define XB_XCNT(j)  (256  + 64 * (j))
#define XB_XSUB(j)  (1280 + 64 * (j))
#define XB_XGEN(j)  (2304 + 64 * (j))
#define XB_TOP      3328
#define XB_TOPGEN   3392
#define XCD_BAR_WORDS 3456
#define XB_SPIN_CAP (1u << 25)
__device__ __forceinline__ unsigned xb_ld(unsigned* p)              { return __hip_atomic_load(p, __ATOMIC_RELAXED, __HIP_MEMORY_SCOPE_AGENT); }
__device__ __forceinline__ unsigned xb_add(unsigned* p, unsigned v) { return __hip_atomic_fetch_add(p, v, __ATOMIC_RELAXED, __HIP_MEMORY_SCOPE_AGENT); }
__device__ __forceinline__ unsigned xb_xcc_id() { return (unsigned)__builtin_amdgcn_s_getreg((3 << 11) | 20) & 0xFu; }
#define XB_SPIN(cond, bar) do { unsigned _sp = 0; while (cond) { __builtin_amdgcn_s_sleep(1); \
    if ((++_sp & 255u) == 0u) { if (xb_ld(&(bar)[XB_TMO])) break; if (_sp > XB_SPIN_CAP) { atomicAdd(&(bar)[XB_TMO], 1u); break; } } } } while (0)
struct XcdBarrier { unsigned* bar; unsigned x; volatile LAS unsigned* st; };
__device__ __forceinline__ XcdBarrier xcd_barrier_post(unsigned* bar, volatile LAS unsigned* st) {
    XcdBarrier b; b.bar = bar; b.x = xb_xcc_id(); b.st = st;
    if (threadIdx.x == 0) (void)xb_add(&bar[XB_XCNT(b.x)], 1u);
    return b;
}
__device__ __forceinline__ void xcd_barrier_complete(unsigned* bar, unsigned x, unsigned& nloc, unsigned& nx) {
    const unsigned G = gridDim.x * gridDim.y * gridDim.z;
    unsigned sum, cnt, mine, sp = 0u;
    for (;;) {
        sum = 0u; cnt = 0u; mine = 0u;
#pragma unroll
        for (unsigned j = 0; j < 16; ++j) { const unsigned c = xb_ld(&bar[XB_XCNT(j)]); sum += c; cnt += (c > 0u) ? 1u : 0u; mine = (j == x) ? c : mine; }
        if (sum == G) break;
        __builtin_amdgcn_s_sleep(1);
        if ((++sp & 255u) == 0u) { if (xb_ld(&bar[XB_TMO])) break; if (sp > XB_SPIN_CAP) { atomicAdd(&bar[XB_TMO], 1u); break; } }
    }
    nloc = mine > 0u ? mine : 1u; nx = cnt > 0u ? cnt : 1u;
}
__device__ __forceinline__ void xcd_barrier(const XcdBarrier& b) {
    asm volatile("s_waitcnt vmcnt(0)" ::: "memory");
    __syncthreads();
    if (threadIdx.x == 0) {
        unsigned* bar = b.bar;
        __builtin_amdgcn_s_waitcnt(0);
        unsigned nloc = b.st[0], nx = b.st[1];
        if (nloc == 0u) { xcd_barrier_complete(bar, b.x, nloc, nx); b.st[0] = nloc; b.st[1] = nx; }
        const unsigned old = xb_add(&bar[XB_XSUB(b.x)], 1u);
        const unsigned gen = old / nloc;
        if (old + 1u == (gen + 1u) * nloc) {
            __builtin_amdgcn_fence(__ATOMIC_RELEASE, "agent");
            asm volatile("s_waitcnt vmcnt(0)" ::: "memory");
            const unsigned og = xb_add(&bar[XB_TOP], 1u);
            const unsigned tg = og / nx;
            if (og + 1u == (tg + 1u) * nx) xb_add(&bar[XB_TOPGEN], 1u);
            else XB_SPIN(xb_ld(&bar[XB_TOPGEN]) == tg, bar);
            __builtin_amdgcn_fence(__ATOMIC_ACQUIRE, "agent");
            xb_add(&bar[XB_XGEN(b.x)], 1u);
            asm volatile("s_waitcnt vmcnt(0)" ::: "memory");
        } else {
            XB_SPIN(xb_ld(&bar[XB_XGEN(b.x)]) == gen, bar);
            __builtin_amdgcn_fence(__ATOMIC_ACQUIRE, "agent");
            asm volatile("s_waitcnt vmcnt(0)" ::: "memory");
        }
    }
    __syncthreads();
}
#endif

__global__ void __launch_bounds__(512, 2) mk_fwd(Params P) {
#ifdef EMU
    unsigned char* smem = g_blk->lds;
#else
    extern __shared__ __attribute__((aligned(16))) unsigned char smem[];
    volatile LAS unsigned* bst = (volatile LAS unsigned*)(smem + LDS_BYTES - 16);
    if (threadIdx.x == 0) { bst[0] = 0u; bst[1] = 0u; bst[2] = 0u; bst[3] = 0u; }
    __syncthreads();
    XcdBarrier bar; bar.bar = (unsigned*)P.ws + CW_BAR; bar.x = 0; bar.st = bst;
    if (P.ph_hi - P.ph_lo > 1) bar = xcd_barrier_post((unsigned*)P.ws + CW_BAR, bst);
#endif
    const int lo = P.ph_lo, hi = P.ph_hi;
#ifdef EMU
    const int wv = (int)threadIdx.x >> 6;
#else
    const int wv = RFL((int)threadIdx.x >> 6);
#endif
#ifdef EMU
#define SEAM(id) do {} while (0)
#else
#define SEAM(id) do { if ((id) + 1 < hi) xcd_barrier(bar); } while (0)
#endif
#ifndef MK_ONLY_PHASE
#define MK_ONLY_PHASE -1
#endif
#ifndef MK_DUP_MASK
#define MK_DUP_MASK 0
#endif
#define PHG(kc, id, ...) do { if (MK_ONLY_PHASE < 0 || MK_ONLY_PHASE == (kc)) { const int id_ = (id); if (id_ >= lo && id_ < hi) { if ((MK_DUP_MASK >> (kc)) & 1) { __VA_ARGS__; SEAM(id_ - 1); } __VA_ARGS__; SEAM(id_); } } } while (0)
#define PH(k, ...) PHG(1 + (k), 1 + l * NPH + (k), __VA_ARGS__)
    PHG(0, 0, phase_prologue(P, smem, wv));
    for (int l = 0; l < NL; ++l) {
        PH(0, phase_inproj(P, l, smem, wv));
        PH(1, phase_prep(P, l, smem, wv));
#if MK_RWKV_CHUNKED
        PH(2, { phase_rwkv_pre(P, l, smem, wv); phase_mlstm_local(P, l, smem, wv, (int)blockIdx.x, (int)gridDim.x); });
        PH(3, { phase_rwkv_seq(P, l, smem, wv); phase_mlstm_carry(P, l, smem, wv); });
        PH(4, { phase_rwkv_out(P, l, smem, wv); phase_mlstm_out(P, l, smem, wv); phase_gmlp_mix(P, l, smem, wv, (int)blockIdx.x, (int)gridDim.x); });
#else
        PH(2, { const int G_ = (int)gridDim.x, NSC = 2 * NB * RH * 4;
                if (G_ >= NSC + 32) { if ((int)blockIdx.x < NSC) phase_rwkv_scan(P, l, smem, wv, (int)blockIdx.x, NSC);
                                      else phase_mlstm_local(P, l, smem, wv, (int)blockIdx.x - NSC, G_ - NSC); }
                else { phase_rwkv_scan(P, l, smem, wv, (int)blockIdx.x, G_); phase_mlstm_local(P, l, smem, wv, (int)blockIdx.x, G_); } });
        PH(3, phase_mlstm_carry(P, l, smem, wv));
        PH(4, { phase_mlstm_out(P, l, smem, wv); phase_gmlp_mix(P, l, smem, wv, (int)blockIdx.x, (int)gridDim.x); phase_rwkv_post(P, l, smem, wv); });
#endif
        PH(5, phase_outproj(P, l, smem, wv));
        PH(6, phase_ln1_router(P, l, smem, wv));
        PH(7, phase_scatter(P, l, smem, wv));
        PH(8, phase_moe_gemm<1>(P, l, smem, wv));
        PH(9, phase_moe_gemm<2>(P, l, smem, wv));
        PH(10, phase_combine_ln2(P, l, smem, wv));
    }
#undef PHG
#undef PH
#undef SEAM
}

}

#ifndef EMU
extern "C" void kernel_launch(void* const* d_in, const int* in_sizes, int n_in, void* d_out, int out_size, void* d_ws, size_t ws_size, hipStream_t stream) {
    using namespace mk;
    static int grid = 0;
    if (grid == 0) {
        if (n_in != 32 || out_size != T * D || ws_size < WS_END) { fprintf(stderr, "kernel_launch: unexpected shapes (n_in %d out %d ws %zu need %zu)\n", n_in, out_size, ws_size, (size_t)WS_END); grid = -1; return; }
        int dev = 0, cus = 0;
        if (hipGetDevice(&dev) != hipSuccess || hipDeviceGetAttribute(&cus, hipDeviceAttributeMultiprocessorCount, dev) != hipSuccess) { grid = -1; return; }
        if (hipFuncSetAttribute((const void*)mk_fwd, hipFuncAttributeMaxDynamicSharedMemorySize, LDS_BYTES) != hipSuccess) { fprintf(stderr, "kernel_launch: hipFuncSetAttribute failed\n"); grid = -1; return; }
        int per_cu = 0;
        (void)hipOccupancyMaxActiveBlocksPerMultiprocessor(&per_cu, (const void*)mk_fwd, NTHREADS, LDS_BYTES);
        (void)hipGetLastError();
        grid = cus;
    }
    if (grid < 0) return;
    (void)hipMemsetAsync(d_ws, 0, CTL_BYTES, stream);
    Params p{};
    for (int i = 0; i < 32; ++i) p.in[i] = (const float*)d_in[i];
    p.out = (float*)d_out; p.ws = (unsigned char*)d_ws;
#if MK_ONE_LAUNCH
    p.ph_lo = 0; p.ph_hi = 1 + NL * NPH;
    hipLaunchKernelGGL(mk_fwd, dim3(grid), dim3(NTHREADS), LDS_BYTES, stream, p);
#else
    for (int id = 0; id < 1 + NL * NPH; ++id) {
        p.ph_lo = id; p.ph_hi = id + 1;
        hipLaunchKernelGGL(mk_fwd, dim3(grid), dim3(NTHREADS), LDS_BYTES, stream, p);
    }
#endif
}
#endif
```

```cpp
#ifndef EMU
#include <hip/hip_runtime.h>
#endif
#include <cstdio>
#include <cstdint>
#include <cmath>

#ifndef CFG_BATCH
#define CFG_BATCH 4
#endif
#ifndef CFG_SEQ
#define CFG_SEQ 4096
#endif
#ifndef CFG_LAYERS
#define CFG_LAYERS 4
#endif
#ifndef MK_RWKV_CHUNKED
#define MK_RWKV_CHUNKED 1
#endif
#ifndef MK_ONE_LAUNCH
#define MK_ONE_LAUNCH 1
#endif

namespace mk {
constexpr int NB = CFG_BATCH, S = CFG_SEQ, T = NB * S, NL = CFG_LAYERS, D = 1024;
constexpr int GW = 256, RW = 384, MW = 384, HD = 64, GH = 4, RH = 6, MH = 6, CH = 128, NCH = S / CH;
constexpr int PIN = 3480, PLD = 3584, RPROJ = 1408;
constexpr int C_RW = 512, C_MW = 1920;
constexpr int NE = 32, TOPK = 4, DFF = 1024, MOEB = 256;
constexpr int NROWS = (T * TOPK / MOEB + NE) * MOEB;
constexpr float LN_EPS = 1e-5f, GN_EPS = 64e-5f;
constexpr float ALPHA = 1.6817928305074290f;
constexpr int NTHREADS = 512, NWAVES = 8;
constexpr int LDS_BYTES = 160 * 1024;
constexpr int NPH = 11;

typedef float f32x4 __attribute__((ext_vector_type(4)));
typedef unsigned u32x4 __attribute__((ext_vector_type(4)));
typedef unsigned u32x2 __attribute__((ext_vector_type(2)));
typedef short bf16x8 __attribute__((ext_vector_type(8)));
typedef unsigned short bf16_t;

constexpr size_t al(size_t x) { return (x + 255) & ~(size_t)255; }
constexpr size_t CTL_BYTES = 1u << 20;
constexpr size_t O_XA = CTL_BYTES;
constexpr size_t O_XB = O_XA + al((size_t)T * D * 4);
constexpr size_t O_X1 = O_XB + al((size_t)T * D * 2);
constexpr size_t O_X1B = O_X1 + al((size_t)T * D * 4);
constexpr size_t O_PROJ = O_X1B + al((size_t)T * D * 2);
constexpr size_t O_MIX = O_PROJ + al((size_t)T * PLD * 4);
constexpr size_t O_GRP = O_MIX + al((size_t)T * D * 4);
constexpr size_t O_UG = O_GRP + al((size_t)T * D * 2);
constexpr size_t O_VN = O_UG + al((size_t)T * GW * 4);
constexpr size_t O_RR = O_VN + al((size_t)T * GW * 4);
constexpr size_t O_VV = O_RR + al((size_t)T * RW * 4);
constexpr size_t O_KK = O_VV + al((size_t)T * RW * 4);
constexpr size_t O_DEC = O_KK + al((size_t)T * RW * 4);
constexpr size_t O_KD = O_DEC + al((size_t)2 * T * RW * 4);
constexpr size_t O_ICLR = O_KD + al((size_t)2 * T * RW * 4);
constexpr size_t O_GATE = O_ICLR + al((size_t)2 * T * RW * 4);
constexpr size_t O_BONUS = O_GATE + al((size_t)T * RW * 4);
constexpr size_t O_SCAN = O_BONUS + al((size_t)T * RH * 4);
constexpr size_t O_MQ = O_SCAN + al((size_t)2 * T * RW * 4);
constexpr size_t O_MK = O_MQ + al((size_t)T * MW * 4);
constexpr size_t O_IG = O_MK + al((size_t)T * MW * 4);
constexpr size_t O_LF = O_IG + al((size_t)2 * T * MH * 4);
constexpr size_t O_CL = O_LF + al((size_t)2 * T * MH * 4);
constexpr size_t O_NL = O_CL + al((size_t)2 * NB * MH * NCH * 4096 * 4);
constexpr size_t O_ML = O_NL + al((size_t)2 * NB * MH * NCH * 64 * 4);
constexpr size_t O_BL = O_ML + al((size_t)2 * NB * MH * NCH * 4);
constexpr size_t O_MIN = O_BL + al((size_t)2 * NB * MH * NCH * 4);
constexpr size_t O_TOPI = O_MIN + al((size_t)2 * NB * MH * NCH * 4);
constexpr size_t O_TOPG = O_TOPI + al((size_t)T * 4 * 4);
constexpr size_t O_RANK = O_TOPG + al((size_t)T * 4 * 4);
constexpr size_t O_SLOT = O_RANK + al((size_t)T * 4 * 4);
constexpr size_t O_MQB = O_SLOT + al((size_t)T * 4 * 4);
constexpr size_t O_MKB = O_MQB + al((size_t)T * MW * 2);
constexpr size_t O_KT = O_MKB + al((size_t)T * MW * 2);
constexpr size_t O_VT = O_KT + al((size_t)T * MW * 2);
constexpr size_t O_GVT = O_VT + al((size_t)T * MW * 2);
constexpr size_t O_PMX = O_GVT + al((size_t)2 * T * MH * 4);
constexpr size_t O_BCT = O_PMX + al((size_t)2 * T * MH * 4);
constexpr size_t O_BRKR = O_BCT + al((size_t)2 * T * MH * 4);
constexpr int RC = 64, RNC = S / RC, RUN = 2 * NB * RH * RNC;
constexpr size_t O_LW = O_BRKR + al((size_t)2 * T * RH * 2 * 4);
constexpr size_t O_RQ = O_LW + al((size_t)2 * T * RW * 4);
constexpr size_t O_RA = O_RQ + al((size_t)RUN * 4096 * 2);
constexpr size_t O_RS = O_RA + al((size_t)RUN * 4096 * 2);
constexpr size_t O_RH = O_RS + al((size_t)RUN * 4096 * 2);
constexpr size_t O_RG = O_RH + al((size_t)RUN * 4096 * 4);
constexpr size_t O_VNT = O_RG + al((size_t)RUN * 4096 * 4);
constexpr size_t O_WSB = O_VNT + al((size_t)T * GW * 2);
constexpr size_t O_LWT = O_WSB + al((size_t)NL * GH * CH * CH * 2);
constexpr size_t O_BCNT = O_LWT + al((size_t)NL * 1920 * 128 * 2);
constexpr size_t O_CNTF = O_BCNT + al((size_t)(T / 64) * NE * 4);
constexpr size_t O_XS = O_CNTF + al((size_t)NE * 4);
constexpr size_t O_ACT = O_XS + al((size_t)NROWS * D * 2);
constexpr size_t O_YS = O_ACT + al((size_t)NROWS * DFF * 2);
constexpr size_t O_WIN = O_YS + al((size_t)NROWS * D * 2);
constexpr size_t O_WOUT = O_WIN + al((size_t)NL * PLD * D * 2);
constexpr size_t O_W1 = O_WOUT + al((size_t)NL * D * D * 2);
constexpr size_t O_W2 = O_W1 + al((size_t)NL * NE * 2 * DFF * D * 2);
constexpr size_t WS_END = O_W2 + al((size_t)NL * NE * D * DFF * 2);

constexpr int CW_BAR = 4096;
constexpr int CW_CNT = 16384;

struct Params { const float* in[32]; float* out; unsigned char* ws; int ph_lo, ph_hi; };
#ifdef EMU
typedef const Params* ParamsPtr;
#define PARAMS_PTR(P) (&(P))
#else
typedef const __attribute__((address_space(4))) Params* ParamsPtr;
#define PARAMS_PTR(P) ((ParamsPtr)__builtin_amdgcn_kernarg_segment_ptr())
#endif

#ifdef EMU
#define WAVE_SYNC() emu_wave_barrier()
#define PIN_V(x) do {} while (0)
#define PIN_S(x) do {} while (0)
#else
#define WAVE_SYNC() __builtin_amdgcn_wave_barrier()
#define PIN_V(x) asm volatile("" : "+v"(x))
#define PIN_S(x) asm volatile("" : "+s"(x))
#endif
#ifdef EMU
__device__ __forceinline__ int phase_tid(int wv) { (void)wv; return threadIdx.x; }
#else
__device__ __forceinline__ int phase_tid(int wv) { int t; asm volatile("v_mbcnt_lo_u32_b32 %0, -1, 0\n\tv_mbcnt_hi_u32_b32 %0, -1, %0" : "=v"(t)); return (wv << 6) + t; }
#endif

#ifdef EMU
#define SHX(v, m, lane) __shfl_xor(v, m)
#else
__device__ __forceinline__ float shx_(float v, int m, int lane) { return __builtin_bit_cast(float, __builtin_amdgcn_ds_bpermute((lane ^ m) << 2, __builtin_bit_cast(int, v))); }
__device__ __forceinline__ int shx_(int v, int m, int lane) { return __builtin_amdgcn_ds_bpermute((lane ^ m) << 2, v); }
#define SHX(v, m, lane) shx_(v, m, lane)
#endif
#ifdef EMU
#define SHUP(v, o, lane) __shfl(v, ((lane) - (o)) & 63)
#define RDL(v, src) __shfl(v, src)
#define SHL(v, src) __shfl(v, src)
#else
#define SHL(v, src) __builtin_bit_cast(float, __builtin_amdgcn_ds_bpermute((src) << 2, __builtin_bit_cast(int, (float)(v))))
#define SHUP(v, o, lane) __builtin_bit_cast(float, __builtin_amdgcn_ds_bpermute((((lane) - (o)) & 63) << 2, __builtin_bit_cast(int, (float)(v))))
#define RDL(v, src) __builtin_bit_cast(float, __builtin_amdgcn_readlane(__builtin_bit_cast(int, (float)(v)), src))
#endif
__device__ __forceinline__ float wave_sum(float v, int lane) {
#pragma unroll
    for (int o = 32; o >= 1; o >>= 1) v += SHX(v, o, lane);
    return v;
}
#ifdef EMU
__device__ __forceinline__ float fexp(float x) { return expf(x); }
__device__ __forceinline__ float flog(float x) { return logf(x); }
__device__ __forceinline__ float frcp(float x) { return 1.0f / x; }
#else
__device__ __forceinline__ float fexp(float x) { return __builtin_amdgcn_exp2f(x * 1.4426950408889634f); }
__device__ __forceinline__ float flog(float x) { return __builtin_amdgcn_logf(x) * 0.6931471805599453f; }
__device__ __forceinline__ float frcp(float x) { return __builtin_amdgcn_rcpf(x); }
#endif
__device__ __forceinline__ float sigmoidf_(float x) { return frcp(1.0f + fexp(-x)); }
__device__ __forceinline__ float softplusf_(float x) { return fmaxf(x, 0.f) + flog(1.0f + fexp(-fabsf(x))); }
__device__ __forceinline__ float ftanh(float x) { return 1.0f - 2.0f * frcp(1.0f + fexp(2.0f * x)); }
__device__ __forceinline__ float geluf_(float v) {
    const float av = fabsf(v), t = frcp(1.0f + 0.2316418882f * av);
    float q = t * 0.5307027145f + (-0.7265760135f); q = q * t + 0.7107068705f; q = q * t + (-0.142248368f); q = q * t + 0.127414796f; q = q * t;
    const float m = v * (q * fexp(-0.5f * v * v));
    return v < 0.f ? m : v - m;
}

#ifdef EMU
#define LAS
#define WAIT_V(n) do {} while (0)
#define WAIT_L(n) do {} while (0)
#define S_BARRIER() __syncthreads()
#define SETPRIO(x) do {} while (0)
#define SCHED_BAR() do {} while (0)
#define RFL(x) (x)
static inline void emu_glds16(const void* g, void* l) { memcpy((char*)l + (g_blk->cur & 63) * 16, g, 16); }
#define GLDS16(gptr, ldsptr) emu_glds16((const void*)(gptr), (void*)(ldsptr))
static inline float emu_bf2f(unsigned short b) { unsigned u = (unsigned)b << 16; float f; memcpy(&f, &u, 4); return f; }
static inline f32x4 emu_mfma16(bf16x8 a, bf16x8 b, f32x4 c) {
    EmuBlock* blk = g_blk; const int cur = blk->cur, lane = cur & 63, wbase = cur & ~63;
    static thread_local unsigned short Ash[32][64][8], Bsh[32][64][8];
    const int w = cur >> 6;
    for (int j = 0; j < 8; ++j) { Ash[w][lane][j] = (unsigned short)a[j]; Bsh[w][lane][j] = (unsigned short)b[j]; }
    emu_wave_barrier();
    const int col = lane & 15;
    for (int r = 0; r < 4; ++r) { const int row = 4 * (lane >> 4) + r; float sum = c[r];
        for (int k = 0; k < 32; ++k) sum += emu_bf2f(Ash[w][row + 16 * (k >> 3)][k & 7]) * emu_bf2f(Bsh[w][col + 16 * (k >> 3)][k & 7]);
        c[r] = sum; }
    emu_wave_barrier(); (void)wbase;
    return c;
}
#define MFMA16(a, b, c) emu_mfma16(a, b, c)
#else
#define LAS __attribute__((address_space(3)))
#define WAIT_V(n) asm volatile("s_waitcnt vmcnt(" #n ")" ::: "memory")
#define WAIT_L(n) asm volatile("s_waitcnt lgkmcnt(" #n ")" ::: "memory")
#define S_BARRIER() __builtin_amdgcn_s_barrier()
#define SETPRIO(x) __builtin_amdgcn_s_setprio(x)
#define SCHED_BAR() __builtin_amdgcn_sched_barrier(0)
#define RFL(x) __builtin_amdgcn_readfirstlane(x)
#define GLDS16(gptr, ldsptr) __builtin_amdgcn_global_load_lds((const unsigned*)(gptr), (LAS unsigned*)(ldsptr), 16, 0, 0)
#define MFMA16(a, b, c) __builtin_amdgcn_mfma_f32_16x16x32_bf16(a, b, c, 0, 0, 0)
#endif

__device__ __forceinline__ unsigned f2bf(float f) { unsigned u = __builtin_bit_cast(unsigned, f); return (u + 0x7fffu + ((u >> 16) & 1u)) >> 16; }
__device__ __forceinline__ unsigned pk2(float lo, float hi) { return f2bf(lo) | (f2bf(hi) << 16); }
__device__ __forceinline__ bf16x8 cvt8(const f32x4 a, const f32x4 b) {
    u32x4 w; w.x = pk2(a.x, a.y); w.y = pk2(a.z, a.w); w.z = pk2(b.x, b.y); w.w = pk2(b.z, b.w); return __builtin_bit_cast(bf16x8, w);
}
__device__ __forceinline__ float bf_lo(unsigned u) { return __builtin_bit_cast(float, u << 16); }
__device__ __forceinline__ float bf_hi(unsigned u) { return __builtin_bit_cast(float, u & 0xffff0000u); }

namespace pg8 {
constexpr int BM = 256, BK = 64, HALF = 128, HTB = HALF * BK * 2, STAGE_BYTES = 8 * HTB, NXCD = 8, WGM = 8;
__host__ __device__ __forceinline__ int lds_byte(int r, int c) { const int st = (r >> 4) * 2 + (c >> 5), rr = r & 15, cc = c & 31, ob = rr * 64 + cc * 2; return st * 1024 + (ob ^ (((ob >> 9) & 1) << 5)); }
__host__ __device__ __forceinline__ void stage_rc(int b, int& R, int& C) { const int st = b / 1024, sb = b % 1024, swz = sb ^ (((sb >> 9) & 1) << 5); R = (st >> 1) * 16 + swz / 64; C = (st & 1) * 32 + (swz % 64) / 2; }
__host__ __device__ __forceinline__ int perm32(int rho) { const int n = rho >> 4, i = rho & 15; return 8 * (i >> 2) + 4 * n + (i & 3); }
struct Unit { int pm, pn, e; };

struct DenseOrder {
    const char* A; const char* Bt; int K; int nM, nN, nwg, G, c;
    __device__ __forceinline__ void init(const void* A_, const void* Bt_, int M, int N, int K_, int G_, int c_) { A = (const char*)A_; Bt = (const char*)Bt_; K = K_; nM = M / BM; nN = N / BM; nwg = nM * nN; G = G_; c = c_; }
    __device__ __forceinline__ bool next(int i, Unit& u) const {
        const long L = (long)i * G + c; if (L >= nwg) return false;
        int wgid = (int)L; { const int q = nwg / NXCD, r = nwg % NXCD, xcd = wgid % NXCD, off = wgid / NXCD; wgid = (xcd < r ? xcd * (q + 1) : r * (q + 1) + (xcd - r) * q) + off; }
        const int nig = WGM * nN, gid = wgid / nig, fm = gid * WGM, gsz = (nM - fm) < WGM ? (nM - fm) : WGM;
        u.pm = fm + ((wgid % nig) % gsz); u.pn = (wgid % nig) / gsz; u.e = 0; return true;
    }
    __device__ __forceinline__ const char* abase(const Unit& u) const { return A + (size_t)u.pm * BM * K * 2; }
    __device__ __forceinline__ const char* bbase(const Unit& u) const { return Bt + (size_t)u.pn * BM * K * 2; }
};
struct MoeOrder {
    const char* A; const char* Wt; int K; int nN, nwg, G, c; size_t estride; const int* rbe;
    __device__ __forceinline__ bool next(int i, Unit& u) const {
        const long L = (long)i * G + c; if (L >= nwg) return false;
        u.pm = (int)(L / nN); u.pn = (int)(L % nN); u.e = rbe[u.pm]; return true;
    }
    __device__ __forceinline__ const char* abase(const Unit& u) const { return A + (size_t)u.pm * BM * K * 2; }
    __device__ __forceinline__ const char* bbase(const Unit& u) const { return Wt + (size_t)u.e * estride + (size_t)u.pn * BM * K * 2; }
};

struct EpiF32 {
    static constexpr bool PERM = false;
    float* C; int ldc;
    __device__ __forceinline__ void operator()(const f32x4 (&acc)[2][2][4][2], const Unit& u, int wr, int wc, int fr, int fq) const {
        const int row0 = u.pm * BM + wr * 64 + fr, col0 = u.pn * BM + wc * 32 + 4 * fq;
#pragma unroll
        for (int ai = 0; ai < 2; ++ai)
#pragma unroll
            for (int m = 0; m < 4; ++m) { float* rowp = C + (size_t)(row0 + ai * HALF + m * 16) * ldc + col0;
#pragma unroll
                for (int bj = 0; bj < 2; ++bj)
#pragma unroll
                    for (int n = 0; n < 2; ++n) *(f32x4*)(rowp + bj * HALF + n * 16) = acc[ai][bj][m][n]; }
    }
};
struct EpiBf16Bias {
    static constexpr bool PERM = true;
    bf16_t* O; int ldc; const float* bias; int bias_estride;
    __device__ __forceinline__ void operator()(const f32x4 (&acc)[2][2][4][2], const Unit& u, int wr, int wc, int fr, int fq) const {
        const int row0 = u.pm * BM + wr * 64 + fr, col0 = u.pn * BM + wc * 32 + 8 * fq;
        const float* bp = bias + (size_t)u.e * bias_estride + col0;
        f32x4 bv[2][2];
#pragma unroll
        for (int bj = 0; bj < 2; ++bj)
#pragma unroll
            for (int n = 0; n < 2; ++n) bv[bj][n] = *(const f32x4*)(bp + bj * HALF + 4 * n);
#pragma unroll
        for (int ai = 0; ai < 2; ++ai)
#pragma unroll
            for (int m = 0; m < 4; ++m) { bf16_t* rowp = O + (size_t)(row0 + ai * HALF + m * 16) * ldc + col0;
#pragma unroll
                for (int bj = 0; bj < 2; ++bj) { const f32x4 v0 = acc[ai][bj][m][0] + bv[bj][0], v1 = acc[ai][bj][m][1] + bv[bj][1];
                    u32x4 w; w.x = pk2(v0[0], v0[1]); w.y = pk2(v0[2], v0[3]); w.z = pk2(v1[0], v1[1]); w.w = pk2(v1[2], v1[3]);
                    *(u32x4*)(rowp + bj * HALF) = w; } }
    }
};
__device__ __forceinline__ float swiglu1(float g, float uu) { g = fminf(g, 7.0f); uu = fminf(fmaxf(uu, -7.0f), 7.0f); return (uu + 1.0f) * (g * frcp(1.0f + fexp(-1.702f * g))); }
struct EpiSwiglu {
    static constexpr bool PERM = true;
    bf16_t* O; const float* b1;
    __device__ __forceinline__ void operator()(const f32x4 (&acc)[2][2][4][2], const Unit& u, int wr, int wc, int fr, int fq) const {
        const int row0 = u.pm * BM + wr * 64 + fr, j0 = u.pn * HALF + wc * 32 + 8 * fq;
        const float* bg = b1 + (size_t)u.e * 2 * DFF + j0; const float* bu = bg + DFF;
        f32x4 g4[2], u4[2];
#pragma unroll
        for (int n = 0; n < 2; ++n) { g4[n] = *(const f32x4*)(bg + 4 * n); u4[n] = *(const f32x4*)(bu + 4 * n); }
#pragma unroll
        for (int ai = 0; ai < 2; ++ai)
#pragma unroll
            for (int m = 0; m < 4; ++m) {
                float o[8];
#pragma unroll
                for (int n = 0; n < 2; ++n)
#pragma unroll
                    for (int q = 0; q < 4; ++q) o[n * 4 + q] = swiglu1(acc[ai][0][m][n][q] + g4[n][q], acc[ai][1][m][n][q] + u4[n][q]);
                u32x4 w; w.x = pk2(o[0], o[1]); w.y = pk2(o[2], o[3]); w.z = pk2(o[4], o[5]); w.w = pk2(o[6], o[7]);
                *(u32x4*)(O + (size_t)(row0 + ai * HALF + m * 16) * DFF + j0) = w;
            }
    }
};

template <class Epi, class Sched>
__device__ __forceinline__ void gemm_phase(LAS unsigned char* lds, const int K, const Sched& S, const Epi& E, const int tid) {
    const int wid = RFL(tid >> 6), lane = tid & 63, wr = wid >> 2, wc = wid & 3, fr = lane & 15, fq = lane >> 4;
    const int nt = K / BK;
    unsigned voffA[2], voffB[2];
#pragma unroll
    for (int i = 0; i < 2; ++i) { int R, C; stage_rc(tid * 16 + i * 8192, R, C); const int Rb = Epi::PERM ? ((R & ~31) + perm32(R & 31)) : R;
        voffA[i] = (unsigned)(R * K + C) * 2u; voffB[i] = (unsigned)(Rb * K + C) * 2u; }
    const size_t kstep = (size_t)(BK * 2);
    const size_t hstep = (size_t)HALF * K * 2;
    const unsigned ldsw = (unsigned)wid * 1024u;
    const int aoff = lds_byte(wr * 64 + fr, fq * 8), boff = lds_byte(wc * 32 + fr, fq * 8);
#define PG8_SA(b, h) (((b) * 2 + (h)) * HTB)
#define PG8_SB(b, h) ((4 + (b) * 2 + (h)) * HTB)
#define PG8_STAGE(bufoff, gbase, voff) do { _Pragma("unroll") for (int _i = 0; _i < 2; ++_i) \
        GLDS16((const char*)(gbase) + (voff)[_i], lds + (bufoff) + ldsw + _i * 8192); } while (0)
#define PG8_LDA(dst, b, h) do { _Pragma("unroll") for (int m = 0; m < 4; ++m) _Pragma("unroll") for (int k = 0; k < 2; ++k) dst[m][k] = *(const LAS bf16x8*)(lds + PG8_SA(b, h) + aoff + m * 2048 + k * 1024); } while (0)
#define PG8_LDB(dst, b, h) do { _Pragma("unroll") for (int n = 0; n < 2; ++n) _Pragma("unroll") for (int k = 0; k < 2; ++k) dst[n][k] = *(const LAS bf16x8*)(lds + PG8_SB(b, h) + boff + n * 2048 + k * 1024); } while (0)
#define PG8_MMA(ai, bj, At, Bt) do { SETPRIO(1); _Pragma("unroll") for (int m = 0; m < 4; ++m) _Pragma("unroll") for (int n = 0; n < 2; ++n) _Pragma("unroll") for (int k = 0; k < 2; ++k) \
        acc[ai][bj][m][n] = MFMA16(Bt[n][k], At[m][k], acc[ai][bj][m][n]); SETPRIO(0); } while (0)
    Unit cur, nxt; int ui = 0;
    if (!S.next(0, cur)) return;
    f32x4 acc[2][2][4][2];
#pragma unroll
    for (int a = 0; a < 2; ++a)
#pragma unroll
        for (int b = 0; b < 2; ++b)
#pragma unroll
            for (int m = 0; m < 4; ++m)
#pragma unroll
                for (int n = 0; n < 2; ++n) acc[a][b][m][n] = (f32x4){0.f, 0.f, 0.f, 0.f};
    bf16x8 At[4][2], B0[2][2], B1[2][2];
    const char* cA = S.abase(cur); const char* cB = S.bbase(cur);
    PG8_STAGE(PG8_SB(0, 0), cB, voffB); PG8_STAGE(PG8_SA(0, 0), cA, voffA); PG8_STAGE(PG8_SB(0, 1), cB + hstep, voffB); PG8_STAGE(PG8_SA(0, 1), cA + hstep, voffA);
    if (wr == 1) S_BARRIER();
    WAIT_V(4); S_BARRIER();
    PG8_STAGE(PG8_SB(1, 0), cB + kstep, voffB); PG8_STAGE(PG8_SA(1, 0), cA + kstep, voffA); PG8_STAGE(PG8_SB(1, 1), cB + hstep + kstep, voffB);
    WAIT_V(6); S_BARRIER();
    for (;;) {
        const bool has_next = S.next(ui + 1, nxt);
        const char* nA = has_next ? S.abase(nxt) : cA; const char* nB = has_next ? S.bbase(nxt) : cB;
        for (int t = 0; t < nt; t += 2) {
            const bool last = (t == nt - 2);
            const char* a1 = cA + (size_t)(t + 1) * kstep;
            const char* a2 = last ? nA : cA + (size_t)(t + 2) * kstep; const char* b2 = last ? nB : cB + (size_t)(t + 2) * kstep;
            const char* a3 = a2 + kstep; const char* b3 = b2 + kstep;
            PG8_LDB(B0, 0, 0); SCHED_BAR(); PG8_LDA(At, 0, 0); PG8_STAGE(PG8_SA(1, 1), a1 + hstep, voffA);
            WAIT_L(8); S_BARRIER(); WAIT_L(0); PG8_MMA(0, 0, At, B0); S_BARRIER(); SCHED_BAR();
            PG8_LDB(B1, 0, 1); PG8_STAGE(PG8_SB(0, 0), b2, voffB);
            S_BARRIER(); WAIT_L(0); PG8_MMA(0, 1, At, B1); S_BARRIER();
            PG8_LDA(At, 0, 1); PG8_STAGE(PG8_SA(0, 0), a2, voffA);
            S_BARRIER(); WAIT_L(0); PG8_MMA(1, 0, At, B0); S_BARRIER(); SCHED_BAR();
            PG8_STAGE(PG8_SB(0, 1), b2 + hstep, voffB);
            WAIT_V(6); S_BARRIER(); PG8_MMA(1, 1, At, B1); S_BARRIER();
            PG8_LDB(B0, 1, 0); SCHED_BAR(); PG8_LDA(At, 1, 0); PG8_STAGE(PG8_SA(0, 1), a2 + hstep, voffA);
            WAIT_L(8); S_BARRIER(); WAIT_L(0); PG8_MMA(0, 0, At, B0); S_BARRIER(); SCHED_BAR();
            PG8_LDB(B1, 1, 1); PG8_STAGE(PG8_SB(1, 0), b3, voffB);
            S_BARRIER(); WAIT_L(0); PG8_MMA(0, 1, At, B1); S_BARRIER();
            PG8_LDA(At, 1, 1); PG8_STAGE(PG8_SA(1, 0), a3, voffA);
            S_BARRIER(); WAIT_L(0); PG8_MMA(1, 0, At, B0); S_BARRIER(); SCHED_BAR();
            PG8_STAGE(PG8_SB(1, 1), b3 + hstep, voffB);
            WAIT_V(6); S_BARRIER(); PG8_MMA(1, 1, At, B1); S_BARRIER();
        }
        E(acc, cur, wr, wc, fr, fq);
        if (!has_next) break;
#pragma unroll
        for (int a = 0; a < 2; ++a)
#pragma unroll
            for (int b = 0; b < 2; ++b)
#pragma unroll
                for (int m = 0; m < 4; ++m)
#pragma unroll
                    for (int n = 0; n < 2; ++n) acc[a][b][m][n] = (f32x4){0.f, 0.f, 0.f, 0.f};
        cur = nxt; cA = nA; cB = nB; ++ui;
    }
    WAIT_V(0);
    if (wr == 0) S_BARRIER();
    S_BARRIER();
#undef PG8_SA
#undef PG8_SB
#undef PG8_STAGE
#undef PG8_LDA
#undef PG8_LDB
#undef PG8_MMA
}
}

__device__ __forceinline__ void transpose_item(const float* W, int K, int N, bf16_t* WT, int k0, int n0, int dst_row0, float* scr, int lane) {
    const int n4 = (lane & 15) * 4, kr = lane >> 4;
#pragma unroll 8
    for (int i = 0; i < 16; ++i) {
        const int kk = 4 * i + kr;
        f32x4 v = (f32x4){0.f, 0.f, 0.f, 0.f};
        if (n0 + n4 < N) v = *(const f32x4*)(W + (size_t)(k0 + kk) * N + n0 + n4);
        float* d = scr + kk * 65 + n4; d[0] = v.x; d[1] = v.y; d[2] = v.z; d[3] = v.w;
    }
    WAVE_SYNC();
    const int c = lane & 7;
#pragma unroll
    for (int j = 0; j < 8; ++j) { const int n = (lane >> 3) + 8 * j; const float* sp = scr + (8 * c) * 65 + n;
        u32x4 o; o.x = pk2(sp[0 * 65], sp[1 * 65]); o.y = pk2(sp[2 * 65], sp[3 * 65]); o.z = pk2(sp[4 * 65], sp[5 * 65]); o.w = pk2(sp[6 * 65], sp[7 * 65]);
        *(u32x4*)(WT + (size_t)(dst_row0 + n) * K + k0 + 8 * c) = o; }
    WAVE_SYNC();
}
__device__ __forceinline__ void phase_prologue(const Params& P, unsigned char* smem, int wv) {
    ParamsPtr pp = PARAMS_PTR(P); PIN_S(pp); unsigned char* ws = pp->ws; int bidx = (int)blockIdx.x, gdim = (int)gridDim.x; PIN_S(bidx); PIN_S(gdim);
    const int tid = phase_tid(wv), lane = tid & 63, wave = tid >> 6;
    float* scr = (float*)smem + wave * (64 * 65);
    const int gw = bidx * NWAVES + wave, ngw = NWAVES * gdim;
    constexpr int I_IN = 16 * (PLD / 64), I_OUT = 16 * 16, I_W1 = NE * 16 * 32, I_W2 = NE * 16 * 16, I_L = I_IN + I_OUT + I_W1 + I_W2;
    for (int it = gw; it < NL * I_L; it += ngw) {
        const int l = it / I_L; int r = it % I_L;
        if (r < I_IN) { const int kb = r / (PLD / 64), nb = r % (PLD / 64);
            transpose_item(pp->in[1] + (size_t)l * D * PIN, D, PIN, (bf16_t*)(ws + O_WIN) + (size_t)l * PLD * D, kb * 64, nb * 64, nb * 64, scr, lane); continue; }
        r -= I_IN;
        if (r < I_OUT) { const int kb = r / 16, nb = r % 16;
            transpose_item(pp->in[21] + (size_t)l * D * D, D, D, (bf16_t*)(ws + O_WOUT) + (size_t)l * D * D, kb * 64, nb * 64, nb * 64, scr, lane); continue; }
        r -= I_OUT;
        if (r < I_W1) { const int e = r / (16 * 32), q = r % (16 * 32), kb = q / 32, nb = q % 32, n0 = nb * 64;
            const int dst = n0 < DFF ? (n0 / 128) * 256 + (n0 % 128) : ((n0 - DFF) / 128) * 256 + 128 + ((n0 - DFF) % 128);
            transpose_item(pp->in[26] + ((size_t)l * NE + e) * D * 2 * DFF, D, 2 * DFF, (bf16_t*)(ws + O_W1) + ((size_t)l * NE + e) * 2 * DFF * D, kb * 64, n0, dst, scr, lane); continue; }
        r -= I_W1;
        { const int e = r / (16 * 16), q = r % (16 * 16), kb = q / 16, nb = q % 16;
            transpose_item(pp->in[28] + ((size_t)l * NE + e) * DFF * D, DFF, D, (bf16_t*)(ws + O_W2) + ((size_t)l * NE + e) * D * DFF, kb * 64, nb * 64, nb * 64, scr, lane); }
    }
    {
        const float* gw_ = pp->in[4]; bf16_t* WSB = (bf16_t*)(ws + O_WSB);
        for (size_t i = ((size_t)bidx * NTHREADS + tid) * 4; i < (size_t)NL * GH * CH * CH; i += (size_t)gdim * NTHREADS * 4) {
            const f32x4 v = *(const f32x4*)(gw_ + i); u32x2 o; o.x = pk2(v.x, v.y); o.y = pk2(v.z, v.w); *(u32x2*)(WSB + i) = o;
        }
    }
    {
        bf16_t* LWT = (bf16_t*)(ws + O_LWT);
        for (int i = bidx * NTHREADS + tid; i < NL * 1920 * 128; i += gdim * NTHREADS) {
            const int k = i & 127, n = (i >> 7) % 1920, ll = i / (1920 * 128);
            float v = 0.f;
            if (n < 1536) { if (k < 64) { const int grp = n / 768, d = (n / 384) & 1, c = n % 384; v = (grp == 0 ? pp->in[8] : pp->in[10])[(((size_t)ll * 2 + d) * 64 + k) * RW + c]; } }
            else v = pp->in[11][((size_t)ll * 128 + k) * RW + (n - 1536)];
            LWT[i] = (bf16_t)f2bf(v);
        }
    }
    const float* x = pp->in[0]; bf16_t* XB = (bf16_t*)(ws + O_XB);
    for (size_t i = ((size_t)bidx * NTHREADS + tid) * 4; i < (size_t)T * D; i += (size_t)gdim * NTHREADS * 4) {
        const f32x4 v = *(const f32x4*)(x + i); u32x2 o; o.x = pk2(v.x, v.y); o.y = pk2(v.z, v.w); *(u32x2*)(XB + i) = o;
    }
}

__device__ __forceinline__ float tshift(const float* P, int t, int s, int col, const float* mu0, const float* mu1, int rc) {
    const float cur = P[(size_t)t * PLD + col];
    const float prv = s > 0 ? P[(size_t)(t - 1) * PLD + col] : 0.f;
    const float nxt = s < S - 1 ? P[(size_t)(t + 1) * PLD + col] : 0.f;
    return cur + mu0[rc] * (prv - cur) + mu1[rc] * (nxt - cur);
}

__device__ __forceinline__ void phase_prep(const Params& P, int l, unsigned char* smem, int wv) {
    ParamsPtr pp = PARAMS_PTR(P); PIN_S(pp); unsigned char* ws = pp->ws; int bidx = (int)blockIdx.x, gdim = (int)gridDim.x; PIN_S(bidx); PIN_S(gdim);
    const float* proj = (const float*)(ws + O_PROJ);
    float* UG = (float*)(ws + O_UG); bf16_t* VNT = (bf16_t*)(ws + O_VNT);
    float* RR = (float*)(ws + O_RR); float* VV = (float*)(ws + O_VV); float* KK = (float*)(ws + O_KK);
    float* KD = (float*)(ws + O_KD); float* ICLR = (float*)(ws + O_ICLR);
    float* GATE = (float*)(ws + O_GATE); float* BONUS = (float*)(ws + O_BONUS); float* LWG = (float*)(ws + O_LW);
#if !MK_RWKV_CHUNKED
    float* DEC = (float*)(ws + O_DEC); float* BRKR = (float*)(ws + O_BRKR);
#endif
    bf16_t* MQB = (bf16_t*)(ws + O_MQB); bf16_t* MKB = (bf16_t*)(ws + O_MKB); bf16_t* KT = (bf16_t*)(ws + O_KT); bf16_t* VT = (bf16_t*)(ws + O_VT);
    float* IG = (float*)(ws + O_IG); float* LF = (float*)(ws + O_LF);
    const bf16_t* LWT = (const bf16_t*)(ws + O_LWT) + (size_t)l * 1920 * 128;
    const float* gln_g = pp->in[2] + (size_t)l * GW; const float* gln_b = pp->in[3] + (size_t)l * GW;
    const float* mu0 = pp->in[6] + (size_t)l * 2 * RPROJ; const float* mu1 = mu0 + RPROJ;
    const float* w0 = pp->in[7] + (size_t)l * 2 * RW; const float* a0 = pp->in[9] + (size_t)l * 2 * RW;
    const float* k_k = pp->in[12] + (size_t)l * RW; const float* k_a = pp->in[13] + (size_t)l * RW; const float* r_k = pp->in[14] + (size_t)l * RW;
    const float* conv_w = pp->in[17] + (size_t)l * 3 * 768; const float* conv_b = pp->in[18] + (size_t)l * 768; const float* gate_b = pp->in[19] + (size_t)l * 24;
    float* win = (float*)smem;
    bf16_t* lin = (bf16_t*)(smem + 101376);
    bf16_t* tvn = (bf16_t*)(smem + 110592);
    bf16_t* tk = (bf16_t*)(smem + 118784);
    bf16_t* tv = (bf16_t*)(smem + 131072);
    constexpr int LIN = 264;
    const int tid = phase_tid(wv), lane = tid & 63, wave = tid >> 6, col = lane & 15, g = lane >> 4;
    for (int u = bidx; u < T / 16; u += gdim) {
        const int t0 = u * 16, s0 = t0 % S, bb = t0 / S;
        __syncthreads();
        for (int idx = tid; idx < 18 * 352; idx += NTHREADS) {
            const int row = idx / 352, c4 = idx % 352, sq = s0 - 1 + row;
            f32x4 v = (f32x4){0.f, 0.f, 0.f, 0.f};
            if (sq >= 0 && sq < S) v = *(const f32x4*)(proj + (size_t)(t0 - 1 + row) * PLD + C_RW + c4 * 4);
            *(f32x4*)(win + row * RPROJ + c4 * 4) = v;
        }
        {
            const int i = tid >> 5, l32 = tid & 31, t = t0 + i;
            float v[8], ug[8]; float sum = 0.f;
#pragma unroll
            for (int j = 0; j < 8; ++j) { const int c = j * 32 + l32; ug[j] = proj[(size_t)t * PLD + c]; v[j] = proj[(size_t)t * PLD + GW + c]; }
#pragma unroll
            for (int j = 0; j < 8; ++j) { const int c = j * 32 + l32; UG[(size_t)t * GW + c] = geluf_(ug[j]); v[j] = geluf_(v[j]); sum += v[j]; }
#pragma unroll
            for (int o = 16; o >= 1; o >>= 1) sum += SHX(sum, o, lane);
            const float mean = sum * (1.0f / GW); float q = 0.f;
#pragma unroll
            for (int j = 0; j < 8; ++j) { const float d = v[j] - mean; q += d * d; }
#pragma unroll
            for (int o = 16; o >= 1; o >>= 1) q += SHX(q, o, lane);
            const float rstd = 1.0f / sqrtf(q * (1.0f / GW) + LN_EPS);
#pragma unroll
            for (int j = 0; j < 8; ++j) { const int c = j * 32 + l32; tvn[c * 16 + i] = (bf16_t)f2bf((v[j] - mean) * rstd * gln_g[c] + gln_b[c]); }
        }
        __syncthreads();
        {
            const int hf = tid & 1, c = tid >> 1;
            *(u32x4*)(VNT + ((size_t)bb * GW + c) * S + s0 + hf * 8) = *(const u32x4*)(tvn + c * 16 + hf * 8);
        }
        for (int idx = tid; idx < 16 * 256; idx += NTHREADS) {
            const int i = idx >> 8, j = idx & 255, rc = 1152 + j;
            const float pv = win[i * RPROJ + rc], cv = win[(i + 1) * RPROJ + rc], nv = win[(i + 2) * RPROJ + rc];
            const float x = cv + mu0[rc] * (pv - cv) + mu1[rc] * (nv - cv);
            lin[i * LIN + j] = (bf16_t)f2bf(j < 64 ? ftanh(x) : (j < 128 ? x : sigmoidf_(x)));
        }
        __syncthreads();
        {
            bf16x8 bnx[4];
            const bf16_t* bw0 = LWT + (size_t)(wave * 15 * 16 + col) * 128 + 8 * g;
#pragma unroll
            for (int ks = 0; ks < 4; ++ks) bnx[ks] = *(const bf16x8*)(bw0 + ks * 32);
#pragma unroll 1
            for (int q = 0; q < 15; ++q) {
                const int nt = wave * 15 + q, grp = nt / 24, ct = nt % 24, c = ct * 16 + col;
                const int kcol = grp < 2 ? 0 : (grp < 4 ? 64 : 128);
                bf16x8 bcur[4];
#pragma unroll
                for (int ks = 0; ks < 4; ++ks) bcur[ks] = bnx[ks];
                if (q + 1 < 15) {
                    const bf16_t* bw = LWT + (size_t)((nt + 1) * 16 + col) * 128 + 8 * g;
#pragma unroll
                    for (int ks = 0; ks < 4; ++ks) bnx[ks] = *(const bf16x8*)(bw + ks * 32);
                }
                f32x4 acc = (f32x4){0.f, 0.f, 0.f, 0.f};
#pragma unroll
                for (int ks = 0; ks < 2; ++ks) acc = MFMA16(*(const bf16x8*)(lin + col * LIN + kcol + ks * 32 + 8 * g), bcur[ks], acc);
                if (grp == 4) {
#pragma unroll
                    for (int ks = 2; ks < 4; ++ks) acc = MFMA16(*(const bf16x8*)(lin + col * LIN + kcol + ks * 32 + 8 * g), bcur[ks], acc);
                }
                if (grp < 2) {
                    const float w0c = w0[grp * RW + c];
#pragma unroll
                    for (int r = 0; r < 4; ++r) { const float lw = -fexp(-softplusf_(-(acc[r] + w0c)) - 0.5f); const size_t o = (size_t)grp * T * RW + (size_t)(t0 + 4 * g + r) * RW + c; LWG[o] = lw;
#if !MK_RWKV_CHUNKED
                        DEC[o] = expf(lw);
#endif
                    }
                } else if (grp < 4) {
                    const float a0c = a0[(grp - 2) * RW + c];
#pragma unroll
                    for (int r = 0; r < 4; ++r) ICLR[(size_t)(grp - 2) * T * RW + (size_t)(t0 + 4 * g + r) * RW + c] = sigmoidf_(acc[r] + a0c);
                } else {
#pragma unroll
                    for (int r = 0; r < 4; ++r) GATE[(size_t)(t0 + 4 * g + r) * RW + c] = acc[r];
                }
            }
        }
        __syncthreads();
        if (wave < 6) {
            const int c = tid, h = wave;
            const float kkc = k_k[c], kac = k_a[c], rkc = r_k[c];
            const float m0r = mu0[c], m1r = mu1[c], m0k = mu0[RW + c], m1k = mu1[RW + c], m0v = mu0[2 * RW + c], m1v = mu1[2 * RW + c];
            float ic0[16], ic1[16];
#pragma unroll
            for (int i = 0; i < 16; ++i) { const size_t o = (size_t)(t0 + i) * RW + c; ic0[i] = ICLR[o]; ic1[i] = ICLR[(size_t)T * RW + o]; }
#pragma unroll
            for (int i = 0; i < 16; ++i) {
                const int t = t0 + i;
                const float* w_ = win + i * RPROJ + c;
                const float rp = w_[0], rc_ = w_[RPROJ], rn = w_[2 * RPROJ];
                const float kp = w_[RW], kc_ = w_[RPROJ + RW], kn = w_[2 * RPROJ + RW];
                const float vp = w_[2 * RW], vc_ = w_[RPROJ + 2 * RW], vn = w_[2 * RPROJ + 2 * RW];
                const float r = rc_ + m0r * (rp - rc_) + m1r * (rn - rc_);
                const float k = kc_ + m0k * (kp - kc_) + m1k * (kn - kc_);
                const float v = vc_ + m0v * (vp - vc_) + m1v * (vn - vc_);
                const size_t o = (size_t)t * RW + c;
                const float kq = k * kkc;
                const float n2 = wave_sum(kq * kq, lane);
                const float kk = kq / fmaxf(sqrtf(n2), 1e-12f);
                const float kd0 = k * (1.0f + (ic0[i] - 1.0f) * kac), kd1 = k * (1.0f + (ic1[i] - 1.0f) * kac);
                const float bon = wave_sum(r * (kd0 + kd1) * rkc, lane);
                RR[o] = r; VV[o] = v; KK[o] = kk;
                KD[o] = kd0; KD[(size_t)T * RW + o] = kd1;
                if (lane == 0) BONUS[(size_t)t * RH + h] = bon;
#if !MK_RWKV_CHUNKED
                { const float br0 = wave_sum(kk * ic0[i] * r, lane), br1 = wave_sum(kk * ic1[i] * r, lane), kr0 = wave_sum(kd0 * r, lane), kr1 = wave_sum(kd1 * r, lane);
                  if (lane == 0) { BRKR[((size_t)t * RH + h) * 2] = br0; BRKR[((size_t)t * RH + h) * 2 + 1] = kr0; BRKR[((size_t)(T + t) * RH + h) * 2] = br1; BRKR[((size_t)(T + t) * RH + h) * 2 + 1] = kr1; } }
#endif
            }
        }
        __syncthreads();
        for (int idx = tid; idx < 18 * 192; idx += NTHREADS) {
            const int row = idx / 192, c4 = idx % 192, sq = s0 - 1 + row;
            f32x4 v = (f32x4){0.f, 0.f, 0.f, 0.f};
            if (sq >= 0 && sq < S) v = *(const f32x4*)(proj + (size_t)(t0 - 1 + row) * PLD + C_MW + c4 * 4);
            *(f32x4*)(win + row * 768 + c4 * 4) = v;
        }
        for (int idx = tid; idx < 16 * 96; idx += NTHREADS) {
            const int i = idx / 96, c4 = (idx % 96) * 4;
            const f32x4 v = *(const f32x4*)(proj + (size_t)(t0 + i) * PLD + C_MW + 2 * MW + c4);
            tv[(c4 + 0) * 16 + i] = (bf16_t)f2bf(v.x); tv[(c4 + 1) * 16 + i] = (bf16_t)f2bf(v.y); tv[(c4 + 2) * 16 + i] = (bf16_t)f2bf(v.z); tv[(c4 + 3) * 16 + i] = (bf16_t)f2bf(v.w);
        }
        for (int idx = tid; idx < 16 * 24; idx += NTHREADS) {
            const int i = idx / 24, gi = idx % 24, t = t0 + i;
            const int isf = gi / 12, dir = (gi / 6) & 1, h = gi % 6;
            const float gg = proj[(size_t)t * PLD + 3456 + gi] + gate_b[gi];
            if (isf) LF[((size_t)dir * T + t) * MH + h] = -softplusf_(-gg); else IG[((size_t)dir * T + t) * MH + h] = gg;
        }
        __syncthreads();
        for (int idx = tid; idx < 16 * 768; idx += NTHREADS) {
            const int i = idx / 768, c = idx % 768, t = t0 + i;
            const float* w_ = win + i * 768 + c;
            float y = conv_b[c] + w_[0] * conv_w[c] + w_[768] * conv_w[768 + c] + w_[1536] * conv_w[2 * 768 + c];
            y = y * sigmoidf_(y);
            if (c < MW) MQB[(size_t)t * MW + c] = (bf16_t)f2bf(y);
            else { const bf16_t kb = (bf16_t)f2bf(y * 0.125f); MKB[(size_t)t * MW + (c - MW)] = kb; tk[(c - MW) * 16 + i] = kb; }
        }
        __syncthreads();
        for (int idx = tid; idx < 2 * MW * 2; idx += NTHREADS) {
            const int hf = idx & 1, c = (idx >> 1) % MW, which = idx / (2 * MW);
            const u32x4 val = *(const u32x4*)((which ? tv : tk) + c * 16 + hf * 8);
            bf16_t* dst = (which ? VT : KT) + ((size_t)(bb * MH) * 64 + c) * S + s0 + hf * 8;
            *(u32x4*)dst = val;
        }
    }
    __syncthreads();
}

__device__ __forceinline__ void phase_gmlp_mix(const Params& P, int l, unsigned char* smem, int wv, int bid, int nb) {
    PIN_S(bid); PIN_S(nb);
    ParamsPtr pp = PARAMS_PTR(P); PIN_S(pp); unsigned char* ws = pp->ws;
    const float* UG = (const float*)(ws + O_UG); const bf16_t* VNT = (const bf16_t*)(ws + O_VNT); bf16_t* GRP = (bf16_t*)(ws + O_GRP);
    const bf16_t* WSB = (const bf16_t*)(ws + O_WSB) + (size_t)l * GH * CH * CH; const float* gbs = pp->in[5] + (size_t)l * GH * CH;
    const int tid = phase_tid(wv), lane = tid & 63, wave = tid >> 6, col = lane & 15, g = lane >> 4;
    for (int u = bid; u < NB * NCH * GH; u += nb) {
        const int h = u % GH, c = (u / GH) % NCH, b = u / (GH * NCH);
        const int tok0 = b * S + c * CH;
        const bf16_t* wb = WSB + (size_t)h * CH * CH + (size_t)(wave * 16 + col) * CH + 8 * g;
        const bf16_t* vb = VNT + ((size_t)b * GW + h * 64 + col) * S + (size_t)c * CH + 8 * g;
        f32x4 acc[4];
#pragma unroll
        for (int et = 0; et < 4; ++et) acc[et] = (f32x4){0.f, 0.f, 0.f, 0.f};
#pragma unroll
        for (int ks = 0; ks < 4; ++ks) {
            const bf16x8 af = *(const bf16x8*)(wb + ks * 32);
#pragma unroll
            for (int et = 0; et < 4; ++et) acc[et] = MFMA16(af, *(const bf16x8*)(vb + (size_t)et * 16 * S + ks * 32), acc[et]);
        }
#pragma unroll
        for (int r = 0; r < 4; ++r) {
            const int p = wave * 16 + 4 * g + r; const size_t t = (size_t)(tok0 + p); const float bsv = gbs[h * CH + p];
#pragma unroll
            for (int et = 0; et < 4; ++et) { const int ch = h * 64 + et * 16 + col; GRP[t * D + ch] = (bf16_t)f2bf(UG[t * GW + ch] * (acc[et][r] + bsv)); }
        }
    }
}

__device__ __forceinline__ float row16_sum(float x) {
#ifdef EMU
    x += __shfl_xor(x, 1); x += __shfl_xor(x, 2); x += __shfl_xor(x, 4); x += __shfl_xor(x, 8); return x;
#else
#define DPPF(v, ctrl) __builtin_bit_cast(float, __builtin_amdgcn_update_dpp(0, __builtin_bit_cast(int, (v)), (ctrl), 0xF, 0xF, false))
    x += DPPF(x, 0xB1); x += DPPF(x, 0x4E); x += DPPF(x, 0x141); x += DPPF(x, 0x140); return x;
#undef DPPF
#endif
}
constexpr int SC_STEPS = 16;
constexpr int SC_BUF = SC_STEPS * 6 * 64;
__device__ __forceinline__ float row32_sum(float x) {
    x = row16_sum(x);
#ifdef EMU
    x += __shfl_xor(x, 32); return x;
#else
    float a = x, b = x;
    asm volatile("s_nop 1\n\tv_permlane32_swap_b32 %0, %1" : "+v"(a), "+v"(b));
    return a + b;
#endif
}
__device__ __forceinline__ void phase_rwkv_scan(const Params& P, int l, unsigned char* smem, int wv, int bid, int nb) {
    PIN_S(bid); PIN_S(nb);
    ParamsPtr pp = PARAMS_PTR(P); PIN_S(pp); unsigned char* ws = pp->ws;
    const float* RR = (const float*)(ws + O_RR); const float* VV = (const float*)(ws + O_VV); const float* KK = (const float*)(ws + O_KK);
    const float* DEC = (const float*)(ws + O_DEC); const float* KD = (const float*)(ws + O_KD); const float* ICLR = (const float*)(ws + O_ICLR);
    float* SCAN = (float*)(ws + O_SCAN); const float* BRKR = (const float*)(ws + O_BRKR);
    const int tid = phase_tid(wv), lane = tid & 63, wave = tid >> 6, rl = (lane >> 4) & 1, kq = (lane & 15) | ((lane >> 5) << 4);
    float* buf = (float*)smem;
    float* scal = buf + 2 * SC_BUF;
    float* outb = scal + 2 * SC_STEPS * 2;
    typedef float f32x2 __attribute__((ext_vector_type(2)));
    for (int u = bid; u < 2 * NB * RH * 4; u += nb) {
        const int qt = u & 3, h = (u >> 2) % RH, b = (u / (4 * RH)) % NB, d = u / (4 * RH * NB);
        const size_t doff = (size_t)d * T * RW;
        float s0 = 0.f, s1 = 0.f;
        float pw[2], pa[2], pb[2], pk[2], pr[2], pv[2], psc = 0.f;
#define SC_LOAD(c) do { _Pragma("unroll") for (int i = 0; i < 2; ++i) { const int idx = tid + NTHREADS * i, st = idx >> 6, k = idx & 63; const int tau = (c) * SC_STEPS + st, sq = d ? S - 1 - tau : tau; \
            const size_t o = (size_t)(b * S + sq) * RW + h * 64 + k; \
            pw[i] = DEC[doff + o]; pa[i] = KK[o]; pb[i] = ICLR[doff + o]; pk[i] = KD[doff + o]; pr[i] = RR[o]; pv[i] = VV[o]; }     \
            if (tid < 2 * SC_STEPS) { const int tau = (c) * SC_STEPS + (tid >> 1), sq = d ? S - 1 - tau : tau; psc = BRKR[((size_t)(d * T + b * S + sq) * RH + h) * 2 + (tid & 1)]; } } while (0)
#define SC_WRITE(c) do { float* B_ = buf + ((c) & 1) * SC_BUF; _Pragma("unroll") for (int i = 0; i < 2; ++i) { const int idx = tid + NTHREADS * i, st = idx >> 6, k = idx & 63; \
            float* q_ = B_ + st * 384 + k; q_[0] = pw[i]; q_[64] = -pa[i]; q_[128] = pa[i] * pb[i]; q_[192] = pk[i]; q_[256] = pw[i] * pr[i]; q_[320] = pv[i]; } \
            if (tid < 2 * SC_STEPS) scal[((c) & 1) * SC_STEPS * 2 + tid] = psc; } while (0)
        __syncthreads();
        SC_LOAD(0); SC_WRITE(0);
        __syncthreads();
        const int row = qt * 16 + wave * 2 + rl;
        for (int c = 0; c < S / SC_STEPS; ++c) {
            const bool more = (c + 1) < S / SC_STEPS;
            if (more) SC_LOAD(c + 1);
            const float* B = buf + (c & 1) * SC_BUF; const float* sc = scal + (c & 1) * SC_STEPS * 2; float* ob = outb + (c & 1) * SC_STEPS * 16;
            float outs[SC_STEPS];
            f32x2 w2 = *(const f32x2*)(B + 2 * kq), a2 = *(const f32x2*)(B + 64 + 2 * kq), b2 = *(const f32x2*)(B + 128 + 2 * kq);
            f32x2 k2 = *(const f32x2*)(B + 192 + 2 * kq), wr2 = *(const f32x2*)(B + 256 + 2 * kq);
            float v = B[320 + row]; float br = sc[0], kr = sc[1];
#pragma unroll
            for (int st = 0; st < SC_STEPS; ++st) {
                const int sn = st + 1 < SC_STEPS ? st + 1 : st;
                const float* q = B + sn * 384;
                const f32x2 nw2 = *(const f32x2*)(q + 2 * kq), na2 = *(const f32x2*)(q + 64 + 2 * kq), nb2 = *(const f32x2*)(q + 128 + 2 * kq);
                const f32x2 nk2 = *(const f32x2*)(q + 192 + 2 * kq), nwr2 = *(const f32x2*)(q + 256 + 2 * kq);
                const float nv = q[320 + row], nbr = sc[sn * 2], nkr = sc[sn * 2 + 1];
                SCHED_BAR();
                float sa = s0 * a2.x + s1 * a2.y;
                float po = s0 * wr2.x + s1 * wr2.y;
                sa = row32_sum(sa); po = row32_sum(po);
                outs[st] = po + sa * br + v * kr;
                s0 = s0 * w2.x + (sa * b2.x + v * k2.x); s1 = s1 * w2.y + (sa * b2.y + v * k2.y);
                SCHED_BAR();
                w2 = nw2; a2 = na2; b2 = nb2; k2 = nk2; wr2 = nwr2; v = nv; br = nbr; kr = nkr;
            }
            if (kq == 0) {
#pragma unroll
                for (int st = 0; st < SC_STEPS; ++st) ob[st * 16 + wave * 2 + rl] = outs[st];
            }
            if (more) SC_WRITE(c + 1);
            __syncthreads();
            if (tid < 16 * SC_STEPS) {
                const int st = tid >> 4, r = tid & 15, tau = c * SC_STEPS + st, sq = d ? S - 1 - tau : tau;
                SCAN[doff + (size_t)(b * S + sq) * RW + h * 64 + qt * 16 + r] = ob[st * 16 + r];
            }
        }
#undef SC_LOAD
#undef SC_WRITE
    }
    __syncthreads();
}

constexpr int RST = 72;
constexpr int RARR = 64 * RST;
__device__ __forceinline__ f32x4 tile_nt(const bf16_t* Aa, int ta, const bf16_t* Ba, int tb, f32x4 acc, int col, int g) {
#pragma unroll
    for (int ks = 0; ks < 2; ++ks) {
        const bf16x8 af = *(const bf16x8*)(Aa + (ta * 16 + col) * RST + ks * 32 + 8 * g);
        const bf16x8 bfr = *(const bf16x8*)(Ba + (tb * 16 + col) * RST + ks * 32 + 8 * g);
        acc = MFMA16(af, bfr, acc);
    }
    return acc;
}
__device__ __forceinline__ void phase_rwkv_pre(const Params& P, int l, unsigned char* smem, int wv) {
    ParamsPtr pp = PARAMS_PTR(P); PIN_S(pp); unsigned char* ws = pp->ws; int bidx = (int)blockIdx.x, gdim = (int)gridDim.x; PIN_S(bidx); PIN_S(gdim);
    const float* RR = (const float*)(ws + O_RR); const float* VV = (const float*)(ws + O_VV); const float* KK = (const float*)(ws + O_KK);
    const float* LWG = (const float*)(ws + O_LW); const float* KD = (const float*)(ws + O_KD); const float* ICLR = (const float*)(ws + O_ICLR);
    bf16_t* Qg = (bf16_t*)(ws + O_RQ); bf16_t* Ag = (bf16_t*)(ws + O_RA); float* Hg = (float*)(ws + O_RH); float* Gg = (float*)(ws + O_RG);
    const int tid0 = phase_tid(wv);
#define RW_STAGE_VARS int tid = tid0; PIN_V(tid); const int lane = tid & 63, wave = tid >> 6, col = lane & 15, g = lane >> 4; (void)lane; (void)wave; (void)col; (void)g;
    bf16_t* At = (bf16_t*)smem; bf16_t* Bt = At + RARR; bf16_t* Kt = Bt + RARR; bf16_t* Rt = Kt + RARR;
    bf16_t* BtT = Rt + RARR; bf16_t* KtT = BtT + RARR; bf16_t* VT = KtT + RARR;
    bf16_t* Lak = VT + RARR; bf16_t* Mrb = Lak + RARR; bf16_t* Mrk = Mrb + RARR; bf16_t* YT = Mrk + RARR; bf16_t* W2T = YT + RARR;
    float* LabT = (float*)(W2T + RARR);
    float* ZsB = LabT + 4096;
    float* segs = ZsB + 8192;
    float* PC = segs + 512;
    for (int u = bidx; u < RUN; u += gdim) {
        const int c = u % RNC, h = (u / RNC) % RH, b = (u / (RNC * RH)) % NB, d = u / (RNC * RH * NB);
        const size_t doff = (size_t)d * T * RW;
        __syncthreads();
        {
            RW_STAGE_VARS
            const int ch = tid & 63, sg = tid >> 6;
            float lw[8], kk[8], ic[8], kd[8], rr[8], vv[8];
#pragma unroll
            for (int j = 0; j < 8; ++j) {
                const int tau = c * RC + sg * 8 + j, sq = d ? S - 1 - tau : tau; const size_t o = (size_t)(b * S + sq) * RW + h * 64 + ch;
                lw[j] = LWG[doff + o]; kk[j] = KK[o]; ic[j] = ICLR[doff + o]; kd[j] = KD[doff + o]; rr[j] = RR[o]; vv[j] = VV[o];
            }
            float run = 0.f;
#pragma unroll
            for (int j = 0; j < 8; ++j) { run += lw[j]; lw[j] = run; }
            segs[sg * 64 + ch] = run;
            __syncthreads();
            float off = 0.f;
            for (int q = 0; q < sg; ++q) off += segs[q * 64 + ch];
            u32x4 pbt, pkt, pvt; unsigned tb[8], tk[8], tvv[8];
            float prev = off;
#pragma unroll
            for (int j = 0; j < 8; ++j) {
                const int t = sg * 8 + j; const float cl = off + lw[j];
                const float ep = fexp(prev), en = fexp(-cl), epc = fexp(cl);
                const unsigned a_ = f2bf(-kk[j] * ep), b_ = f2bf(kk[j] * ic[j] * en), k_ = f2bf(kd[j] * en), r_ = f2bf(rr[j] * epc), v_ = f2bf(vv[j]);
                At[t * RST + ch] = (bf16_t)a_; Bt[t * RST + ch] = (bf16_t)b_; Kt[t * RST + ch] = (bf16_t)k_; Rt[t * RST + ch] = (bf16_t)r_;
                tb[j] = b_; tk[j] = k_; tvv[j] = v_;
                prev = cl;
            }
            if (sg == 7) PC[ch] = fexp(prev);
            pbt.x = tb[0] | (tb[1] << 16); pbt.y = tb[2] | (tb[3] << 16); pbt.z = tb[4] | (tb[5] << 16); pbt.w = tb[6] | (tb[7] << 16);
            pkt.x = tk[0] | (tk[1] << 16); pkt.y = tk[2] | (tk[3] << 16); pkt.z = tk[4] | (tk[5] << 16); pkt.w = tk[6] | (tk[7] << 16);
            pvt.x = tvv[0] | (tvv[1] << 16); pvt.y = tvv[2] | (tvv[3] << 16); pvt.z = tvv[4] | (tvv[5] << 16); pvt.w = tvv[6] | (tvv[7] << 16);
            *(u32x4*)(BtT + ch * RST + sg * 8) = pbt; *(u32x4*)(KtT + ch * RST + sg * 8) = pkt; *(u32x4*)(VT + ch * RST + sg * 8) = pvt;
        }
        __syncthreads();
        {
            RW_STAGE_VARS
            const int m = wave >> 1;
            const bf16_t* Ym = (m == 0 || m == 2) ? Bt : Kt; const bf16_t* Xm = (m < 2) ? At : Rt;
#pragma unroll 1
            for (int q = 0; q < 8; ++q) {
                const int tix = (wave & 1) * 8 + q, it = tix >> 2, tt = tix & 3;
                f32x4 acc = (f32x4){0.f, 0.f, 0.f, 0.f};
                if (it <= tt) acc = tile_nt(Ym, it, Xm, tt, acc, col, g);
                const int t = tt * 16 + col, i0 = it * 16 + 4 * g;
                float o4[4];
#pragma unroll
                for (int r = 0; r < 4; ++r) { const int i = i0 + r; const bool ok = m < 2 ? (i < t) : (i <= t); o4[r] = ok ? acc[r] : 0.f; }
                if (m == 0) {
#pragma unroll
                    for (int r = 0; r < 4; ++r) LabT[(i0 + r) * 64 + t] = o4[r];
                }
                else { bf16_t* dst = (m == 1 ? Lak : (m == 2 ? Mrb : Mrk)) + t * RST + i0; u32x2 w2; w2.x = pk2(o4[0], o4[1]); w2.y = pk2(o4[2], o4[3]); *(u32x2*)dst = w2; }
            }
        }
        __syncthreads();
        {
            RW_STAGE_VARS
#pragma unroll
            for (int q = 0; q < 2; ++q) {
                const int tix = wave * 2 + q, tt = tix >> 2, et = tix & 3;
                f32x4 acc = (f32x4){0.f, 0.f, 0.f, 0.f};
                acc = tile_nt(Lak, tt, VT, et, acc, col, g);
#pragma unroll
                for (int r = 0; r < 4; ++r) ZsB[4096 + (tt * 16 + 4 * g + r) * 64 + et * 16 + col] = acc[r];
            }
#pragma unroll
            for (int q = 0; q < 8; ++q) { const int idx = tid + NTHREADS * q; ZsB[idx] = bf_lo((unsigned)At[(idx >> 6) * RST + (idx & 63)]); }
        }
        __syncthreads();
        {
            RW_STAGE_VARS
            if (wave < 2) {
                float* Zs = ZsB + wave * 4096 + lane;
                bf16_t* dst = (wave == 0 ? YT : W2T) + lane * RST;
#pragma unroll 1
                for (int bb = 0; bb < 4; ++bb) {
                    float acc[16];
#pragma unroll
                    for (int r = 0; r < 16; ++r) acc[r] = Zs[(16 * bb + r) * 64];
#pragma unroll 2
                    for (int i = 0; i < 16 * bb; ++i) {
                        const float z = Zs[i * 64];
                        const float* lp = LabT + i * 64 + 16 * bb;
                        const f32x4 l0 = *(const f32x4*)lp, l1 = *(const f32x4*)(lp + 4), l2 = *(const f32x4*)(lp + 8), l3 = *(const f32x4*)(lp + 12);
                        acc[0] += l0.x * z; acc[1] += l0.y * z; acc[2] += l0.z * z; acc[3] += l0.w * z;
                        acc[4] += l1.x * z; acc[5] += l1.y * z; acc[6] += l1.z * z; acc[7] += l1.w * z;
                        acc[8] += l2.x * z; acc[9] += l2.y * z; acc[10] += l2.z * z; acc[11] += l2.w * z;
                        acc[12] += l3.x * z; acc[13] += l3.y * z; acc[14] += l3.z * z; acc[15] += l3.w * z;
                    }
                    const float* dp = LabT + (16 * bb) * 64 + 16 * bb;
#pragma unroll
                    for (int r = 1; r < 16; ++r)
#pragma unroll
                        for (int r2 = 0; r2 < r; ++r2) acc[r] += dp[r2 * 64 + r] * acc[r2];
#pragma unroll
                    for (int r = 0; r < 16; ++r) Zs[(16 * bb + r) * 64] = acc[r];
                    u32x4 w0, w1;
                    w0.x = pk2(acc[0], acc[1]); w0.y = pk2(acc[2], acc[3]); w0.z = pk2(acc[4], acc[5]); w0.w = pk2(acc[6], acc[7]);
                    w1.x = pk2(acc[8], acc[9]); w1.y = pk2(acc[10], acc[11]); w1.z = pk2(acc[12], acc[13]); w1.w = pk2(acc[14], acc[15]);
                    *(u32x4*)(dst + 16 * bb) = w0; *(u32x4*)(dst + 16 * bb + 8) = w1;
                }
            }
        }
        __syncthreads();
        {
            RW_STAGE_VARS
            const int ty = wave >> 1;
#pragma unroll 1
            for (int q = 0; q < 8; ++q) {
                const int tix = (wave & 1) * 8 + q, ra = tix >> 2, cb = tix & 3;
                f32x4 acc = (f32x4){0.f, 0.f, 0.f, 0.f};
                if (ty == 0) {
                    acc = tile_nt(Mrb, ra, YT, cb, acc, col, g);
#pragma unroll
                    for (int r = 0; r < 4; ++r) { const int t = ra * 16 + 4 * g + r, k = cb * 16 + col; Qg[(size_t)u * 4096 + t * 64 + k] = (bf16_t)f2bf(acc[r] + bf_lo((unsigned)Rt[t * RST + k])); }
                } else if (ty == 1) {
                    acc = tile_nt(Mrb, ra, W2T, cb, acc, col, g); acc = tile_nt(Mrk, ra, VT, cb, acc, col, g);
                    *(f32x4*)(Hg + (size_t)u * 4096 + (tix * 64 + lane) * 4) = acc;
                } else if (ty == 2) {
                    acc = tile_nt(BtT, ra, YT, cb, acc, col, g);
#pragma unroll
                    for (int r = 0; r < 4; ++r) { const int k1 = ra * 16 + 4 * g + r, k = cb * 16 + col; Ag[(size_t)u * 4096 + k1 * 64 + k] = (bf16_t)f2bf(PC[k1] * (acc[r] + (k1 == k ? 1.0f : 0.f))); }
                } else {
                    acc = tile_nt(BtT, ra, W2T, cb, acc, col, g); acc = tile_nt(KtT, ra, VT, cb, acc, col, g);
#pragma unroll
                    for (int r = 0; r < 4; ++r) acc[r] *= PC[ra * 16 + 4 * g + r];
                    *(f32x4*)(Gg + (size_t)u * 4096 + (tix * 64 + lane) * 4) = acc;
                }
            }
        }
    }
    __syncthreads();
#undef RW_STAGE_VARS
}
__device__ __forceinline__ void phase_rwkv_seq(const Params& P, int l, unsigned char* smem, int wv) {
    ParamsPtr pp = PARAMS_PTR(P); PIN_S(pp); unsigned char* ws = pp->ws; int bidx = (int)blockIdx.x, gdim = (int)gridDim.x; PIN_S(bidx); PIN_S(gdim);
    const bf16_t* Ag = (const bf16_t*)(ws + O_RA); const float* Gg = (const float*)(ws + O_RG); bf16_t* Sg = (bf16_t*)(ws + O_RS);
    const int tid = phase_tid(wv), lane = tid & 63, wave = tid >> 6, col = lane & 15, g = lane >> 4;
    const int gw = wave * gdim + bidx, ngw = NWAVES * gdim;
    for (int un = gw; un < 2 * NB * RH * 2; un += ngw) {
        const int ch = un >> 1, eh = un & 1;
        f32x4 acc[4][2];
#pragma unroll
        for (int a_ = 0; a_ < 4; ++a_)
#pragma unroll
            for (int b_ = 0; b_ < 2; ++b_) acc[a_][b_] = (f32x4){0.f, 0.f, 0.f, 0.f};
        u32x2 alo[4][2], ahi[4][2]; f32x4 gq[4][2];
        const unsigned aoff = (unsigned)(col * 64 + 4 * g), goff = (unsigned)(lane * 4);
#define RS_LOAD(cc) do { const bf16_t* ab_ = Ag + (size_t)(ch * RNC + (cc)) * 4096; const float* gb_ = Gg + (size_t)(ch * RNC + (cc)) * 4096 + eh * 512; \
            _Pragma("unroll") for (int ra = 0; ra < 4; ++ra) _Pragma("unroll") for (int p = 0; p < 2; ++p) { alo[ra][p] = *(const u32x2*)(ab_ + (ra * 1024 + p * 32) + aoff); ahi[ra][p] = *(const u32x2*)(ab_ + (ra * 1024 + p * 32 + 16) + aoff); } \
            _Pragma("unroll") for (int ra = 0; ra < 4; ++ra) _Pragma("unroll") for (int cb = 0; cb < 2; ++cb) gq[ra][cb] = *(const f32x4*)(gb_ + ((ra * 4 + cb) * 256) + goff); } while (0)
        RS_LOAD(0);
#pragma unroll 1
        for (int c = 0; c < RNC; ++c) {
            bf16_t* sb_ = Sg + (size_t)(ch * RNC + c) * 4096 + eh * 2048;
            bf16x8 bq[2][2];
#pragma unroll
            for (int cb = 0; cb < 2; ++cb) {
#pragma unroll
                for (int ra = 0; ra < 4; ++ra) {
                    u32x2 w2; w2.x = pk2(acc[ra][cb][0], acc[ra][cb][1]); w2.y = pk2(acc[ra][cb][2], acc[ra][cb][3]);
                    *(u32x2*)(sb_ + (cb * 1024 + ra * 16) + aoff) = w2;
                }
#pragma unroll
                for (int p = 0; p < 2; ++p) bq[p][cb] = cvt8(acc[2 * p][cb], acc[2 * p + 1][cb]);
            }
            u32x4 af[4][2];
#pragma unroll
            for (int ra = 0; ra < 4; ++ra) {
#pragma unroll
                for (int p = 0; p < 2; ++p) af[ra][p] = (u32x4){alo[ra][p].x, alo[ra][p].y, ahi[ra][p].x, ahi[ra][p].y};
#pragma unroll
                for (int cb = 0; cb < 2; ++cb) acc[ra][cb] = gq[ra][cb];
            }
            if (c + 1 < RNC) RS_LOAD(c + 1);
#pragma unroll
            for (int ra = 0; ra < 4; ++ra)
#pragma unroll
                for (int cb = 0; cb < 2; ++cb)
#pragma unroll
                    for (int p = 0; p < 2; ++p) acc[ra][cb] = MFMA16(__builtin_bit_cast(bf16x8, af[ra][p]), bq[p][cb], acc[ra][cb]);
        }
#undef RS_LOAD
    }
}
__device__ __forceinline__ void phase_rwkv_out(const Params& P, int l, unsigned char* smem, int wv) {
    ParamsPtr pp = PARAMS_PTR(P); PIN_S(pp); unsigned char* ws = pp->ws; int bidx = (int)blockIdx.x, gdim = (int)gridDim.x; PIN_S(bidx); PIN_S(gdim);
    const bf16_t* Qg = (const bf16_t*)(ws + O_RQ); const bf16_t* Sg = (const bf16_t*)(ws + O_RS); const float* Hg = (const float*)(ws + O_RH);
    const float* VV = (const float*)(ws + O_VV); const float* GATE = (const float*)(ws + O_GATE); const float* BONUS = (const float*)(ws + O_BONUS);
    bf16_t* GRP = (bf16_t*)(ws + O_GRP);
    const float* rln_g = pp->in[15] + (size_t)l * RW; const float* rln_b = pp->in[16] + (size_t)l * RW;
    const int tid = phase_tid(wv), lane = tid & 63, wave = tid >> 6, col = lane & 15, g = lane >> 4;
    for (int pu = bidx * NWAVES + wave; pu < NB * RH * RNC; pu += gdim * NWAVES) {
        const int c = pu % RNC, h = (pu / RNC) % RH, b = pu / (RNC * RH);
        f32x4 o[2][4][4];
#pragma unroll
        for (int d = 0; d < 2; ++d) {
            const int u = ((d * NB + b) * RH + h) * RNC + (d ? RNC - 1 - c : c);
            const size_t ub = (size_t)u * 4096;
            bf16x8 qa[4][2], sb[4][2];
#pragma unroll
            for (int q = 0; q < 4; ++q)
#pragma unroll
                for (int ks = 0; ks < 2; ++ks) { qa[q][ks] = *(const bf16x8*)(Qg + ub + (q * 16 + col) * 64 + ks * 32 + 8 * g); sb[q][ks] = *(const bf16x8*)(Sg + ub + (q * 16 + col) * 64 + ks * 32 + 8 * g); }
#pragma unroll
            for (int tt = 0; tt < 4; ++tt)
#pragma unroll
                for (int et = 0; et < 4; ++et) {
                    f32x4 acc = *(const f32x4*)(Hg + ub + ((tt * 4 + et) * 64 + lane) * 4);
#pragma unroll
                    for (int ks = 0; ks < 2; ++ks) acc = MFMA16(qa[tt][ks], sb[et][ks], acc);
                    o[d][tt][et] = acc;
                }
        }
        const int src = (3 - g) * 16 + col;
#pragma unroll
        for (int tt = 0; tt < 4; ++tt)
#pragma unroll
            for (int et = 0; et < 4; ++et)
#pragma unroll
                for (int r = 0; r < 4; ++r) o[0][tt][et][r] += SHL(o[1][3 - tt][et][3 - r], src);
#pragma unroll
        for (int tt = 0; tt < 4; ++tt)
#pragma unroll
            for (int r = 0; r < 4; ++r) {
                float sm = (o[0][tt][0][r] + o[0][tt][1][r]) + (o[0][tt][2][r] + o[0][tt][3][r]);
                sm = row16_sum(sm);
                const float mean = sm * (1.0f / 64.0f);
                float q = 0.f;
#pragma unroll
                for (int et = 0; et < 4; ++et) { const float dl = o[0][tt][et][r] - mean; q += dl * dl; }
                q = row16_sum(q);
                const float rstd = 1.0f / sqrtf(q * (1.0f / 64.0f) + GN_EPS);
                const size_t t = (size_t)(b * S + c * RC + tt * 16 + 4 * g + r);
                const float bon = BONUS[t * RH + h];
#pragma unroll
                for (int et = 0; et < 4; ++et) {
                    const int ch = h * 64 + et * 16 + col;
                    float y = (o[0][tt][et][r] - mean) * rstd * rln_g[ch] + rln_b[ch];
                    y += bon * VV[t * RW + ch];
                    GRP[t * D + GW + ch] = (bf16_t)f2bf(y * GATE[t * RW + ch]);
                }
            }
    }
}

__device__ __forceinline__ void phase_mlstm_local(const Params& P, int l, unsigned char* smem, int wv, int bid, int nb) {
    PIN_S(bid); PIN_S(nb);
    ParamsPtr pp = PARAMS_PTR(P); PIN_S(pp); unsigned char* ws = pp->ws;
    const bf16_t* KT = (const bf16_t*)(ws + O_KT); const bf16_t* VT = (const bf16_t*)(ws + O_VT);
    const float* IG = (const float*)(ws + O_IG); const float* LF = (const float*)(ws + O_LF);
    float* CL = (float*)(ws + O_CL); float* NLb = (float*)(ws + O_NL); float* ML = (float*)(ws + O_ML); float* BL = (float*)(ws + O_BL);
    float* GVT = (float*)(ws + O_GVT); float* PMX = (float*)(ws + O_PMX); float* BCT = (float*)(ws + O_BCT);
    const int tid = phase_tid(wv), lane = tid & 63, wave = tid >> 6, col = lane & 15, g = lane >> 4;
    float* wts = (float*)smem + wave * 128;
    for (int u = bid * NWAVES + wave; u < 2 * NB * MH * NCH; u += nb * NWAVES) {
        const int c = u % NCH, h = (u / NCH) % MH, p = u / (NCH * MH), d = p / NB, b = p % NB;
        const int tc = d ? NCH - 1 - c : c, tok0 = b * S + tc * CH;
        const int i0 = d ? 127 - 2 * lane : 2 * lane, i1 = d ? i0 - 1 : i0 + 1;
        const size_t g0 = ((size_t)d * T + tok0 + i0) * MH + h, g1 = ((size_t)d * T + tok0 + i1) * MH + h;
        const float lf0 = LF[g0], lf1 = LF[g1], ig0 = IG[g0], ig1 = IG[g1];
        const float c1 = lf0 + lf1;
        float incl = c1;
#pragma unroll
        for (int o = 1; o < 64; o <<= 1) { const float tq = SHUP(incl, o, lane); if (lane >= o) incl += tq; }
        const float excl = incl - c1, bc0 = excl + lf0, bc1 = incl;
        const float blast = RDL(incl, 63);
        const float gv0 = ig0 - bc0, gv1 = ig1 - bc1, pl1 = fmaxf(gv0, gv1);
        float mincl = pl1;
#pragma unroll
        for (int o = 1; o < 64; o <<= 1) { const float tq = SHUP(mincl, o, lane); if (lane >= o) mincl = fmaxf(mincl, tq); }
        float mexcl = SHUP(mincl, 1, lane); if (lane == 0) mexcl = -INFINITY;
        const float pm0 = fmaxf(mexcl, gv0), pm1 = mincl;
        const float mloc = blast + RDL(mincl, 63);
        WAVE_SYNC();
        wts[i0] = fexp(blast + gv0 - mloc); wts[i1] = fexp(blast + gv1 - mloc);
        GVT[g0] = gv0; GVT[g1] = gv1; PMX[g0] = pm0; PMX[g1] = pm1; BCT[g0] = bc0; BCT[g1] = bc1;
        if (lane == 0) { ML[u] = mloc; BL[u] = blast; }
        WAVE_SYNC();
        const bf16_t* vbase = VT + ((size_t)(b * MH + h) * 64) * S + (size_t)tc * CH;
        const bf16_t* kbase = KT + ((size_t)(b * MH + h) * 64) * S + (size_t)tc * CH;
        const unsigned loff = (unsigned)(col * S + 8 * g);
        f32x4 acc[4][4];
#pragma unroll
        for (int a_ = 0; a_ < 4; ++a_)
#pragma unroll
            for (int b_ = 0; b_ < 4; ++b_) acc[a_][b_] = (f32x4){0.f, 0.f, 0.f, 0.f};
        float nsum[4] = {0.f, 0.f, 0.f, 0.f};
#pragma unroll 1
        for (int ks = 0; ks < 4; ++ks) {
            const int ii = ks * 32 + 8 * g;
            const f32x4 w0 = *(const f32x4*)(wts + ii), w1 = *(const f32x4*)(wts + ii + 4);
            bf16x8 af[4], bfk[4];
#pragma unroll
            for (int q = 0; q < 4; ++q) af[q] = *(const bf16x8*)(vbase + ((size_t)q * 16 * S + ks * 32) + loff);
#pragma unroll
            for (int q = 0; q < 4; ++q) {
                const u32x4 kr = *(const u32x4*)(kbase + ((size_t)q * 16 * S + ks * 32) + loff);
                f32x4 k0, k1;
                k0.x = bf_lo(kr.x) * w0.x; k0.y = bf_hi(kr.x) * w0.y; k0.z = bf_lo(kr.y) * w0.z; k0.w = bf_hi(kr.y) * w0.w;
                k1.x = bf_lo(kr.z) * w1.x; k1.y = bf_hi(kr.z) * w1.y; k1.z = bf_lo(kr.w) * w1.z; k1.w = bf_hi(kr.w) * w1.w;
                nsum[q] += (k0.x + k0.y) + (k0.z + k0.w) + (k1.x + k1.y) + (k1.z + k1.w);
                bfk[q] = cvt8(k0, k1);
            }
#pragma unroll
            for (int a_ = 0; a_ < 4; ++a_)
#pragma unroll
                for (int b_ = 0; b_ < 4; ++b_) acc[a_][b_] = MFMA16(af[a_], bfk[b_], acc[a_][b_]);
        }
        float* cbase = CL + (size_t)u * 4096;
        const unsigned coff = (unsigned)(4 * g * 64 + col);
#pragma unroll
        for (int b_ = 0; b_ < 4; ++b_) {
#pragma unroll
            for (int a_ = 0; a_ < 4; ++a_)
#pragma unroll
                for (int r = 0; r < 4; ++r) cbase[(a_ * 16 * 64 + r * 64 + b_ * 16) + coff] = acc[a_][b_][r];
            float ns = nsum[b_]; ns += SHX(ns, 16, lane); ns += SHX(ns, 32, lane);
            if (g == 0) NLb[(size_t)u * 64 + b_ * 16 + col] = ns;
        }
    }
    __syncthreads();
}

__device__ __forceinline__ void phase_mlstm_carry(const Params& P, int l, unsigned char* smem, int wv) {
    ParamsPtr pp = PARAMS_PTR(P); PIN_S(pp); unsigned char* ws = pp->ws; int bidx = (int)blockIdx.x, gdim = (int)gridDim.x; PIN_S(bidx); PIN_S(gdim);
    float* CL = (float*)(ws + O_CL); float* NLb = (float*)(ws + O_NL); const float* ML = (const float*)(ws + O_ML); const float* BL = (const float*)(ws + O_BL);
    float* MIN = (float*)(ws + O_MIN);
    const int total = 2 * NB * MH * 4160;
    const int tid = phase_tid(wv);
    for (int g = bidx * NTHREADS + tid; g < total; g += gdim * NTHREADS) {
        const int ph = g / 4160, e = g % 4160;
        float m = 0.f, val = 0.f;
        for (int c = 0; c < NCH; ++c) {
            const int base = ph * NCH + c;
            float* ptr = e < 4096 ? CL + (size_t)base * 4096 + e : NLb + (size_t)base * 64 + (e - 4096);
            const float loc = *ptr;
            *ptr = val;
            if (e == 0) MIN[base] = m;
            const float bl = BL[base], ml = ML[base];
            const float mn = fmaxf(bl + m, ml);
            val = expf(bl + m - mn) * val + expf(ml - mn) * loc;
            m = mn;
        }
    }
}

__device__ __forceinline__ void phase_mlstm_out(const Params& P, int l, unsigned char* smem, int wv) {
    ParamsPtr pp = PARAMS_PTR(P); PIN_S(pp); unsigned char* ws = pp->ws; int bidx = (int)blockIdx.x, gdim = (int)gridDim.x; PIN_S(bidx); PIN_S(gdim);
    const float* proj = (const float*)(ws + O_PROJ);
    const bf16_t* MQB = (const bf16_t*)(ws + O_MQB); const bf16_t* MKB = (const bf16_t*)(ws + O_MKB); const bf16_t* VT = (const bf16_t*)(ws + O_VT);
    const float* GVT = (const float*)(ws + O_GVT); const float* PMX = (const float*)(ws + O_PMX); const float* BCT = (const float*)(ws + O_BCT);
    const float* CL = (const float*)(ws + O_CL); const float* NLb = (const float*)(ws + O_NL); const float* MIN = (const float*)(ws + O_MIN);
    bf16_t* GRP = (bf16_t*)(ws + O_GRP);
    const float* mln_g = pp->in[20] + (size_t)l * MW;
    const int tid = phase_tid(wv), lane = tid & 63, wave = tid >> 6, col = lane & 15, g = lane >> 4;
    for (int u = bidx; u < NB * MH * NCH; u += gdim) {
        const int tc = u % NCH, h = (u / NCH) % MH, b = u / (NCH * MH);
        const int tok0 = b * S + tc * CH, it = wave * 16 + col;
        const size_t trow = (size_t)(tok0 + it);
        bf16x8 bq[2];
#pragma unroll
        for (int ks = 0; ks < 2; ++ks) bq[ks] = *(const bf16x8*)(MQB + trow * MW + h * 64 + ks * 32 + 8 * g);
        const size_t vrow = ((size_t)(b * MH + h) * 64) * S + (size_t)tc * CH;
        f32x4 hs[4];
#pragma unroll
        for (int et = 0; et < 4; ++et) hs[et] = (f32x4){0.f, 0.f, 0.f, 0.f};
#pragma unroll
        for (int d = 0; d < 2; ++d) {
            const int cd = d ? NCH - 1 - tc : tc;
            const int su = ((d * NB + b) * MH + h) * NCH + cd;
            const size_t gt = ((size_t)d * T + trow) * MH + h;
            const float mst = MIN[su];
            const float mxt = fmaxf(PMX[gt], mst), mt = BCT[gt] + mxt, wint = fexp(mst - mxt);
            f32x4 num[4];
#pragma unroll
            for (int et = 0; et < 4; ++et) num[et] = (f32x4){0.f, 0.f, 0.f, 0.f};
            float den = 0.f;
            for (int sp = 0; sp < 4; ++sp) {
                if (d == 0 ? (2 * sp > wave) : (2 * sp + 1 < wave)) continue;
                float pw[8];
#pragma unroll
                for (int hf = 0; hf < 2; ++hf) {
                    const int st = 2 * sp + hf;
                    f32x4 sacc = (f32x4){0.f, 0.f, 0.f, 0.f};
#pragma unroll
                    for (int ks = 0; ks < 2; ++ks) {
                        const bf16x8 kf = *(const bf16x8*)(MKB + (size_t)(tok0 + st * 16 + col) * MW + h * 64 + ks * 32 + 8 * g);
                        sacc = MFMA16(kf, bq[ks], sacc);
                    }
#pragma unroll
                    for (int r = 0; r < 4; ++r) {
                        const int is = st * 16 + 4 * g + r;
                        const bool ok = d == 0 ? (is <= it) : (is >= it);
                        const float gvs = GVT[((size_t)d * T + tok0 + is) * MH + h];
                        const float pr = ok ? sacc[r] * fexp(gvs - mxt) : 0.f;
                        den += pr; pw[hf * 4 + r] = pr;
                    }
                }
                u32x4 pb; pb.x = pk2(pw[0], pw[1]); pb.y = pk2(pw[2], pw[3]); pb.z = pk2(pw[4], pw[5]); pb.w = pk2(pw[6], pw[7]);
                const bf16x8 bp = __builtin_bit_cast(bf16x8, pb);
#pragma unroll
                for (int et = 0; et < 4; ++et) {
                    const bf16_t* vp = VT + vrow + (size_t)(et * 16 + col) * S + sp * 32 + 4 * g;
                    const u32x2 v0 = *(const u32x2*)vp, v1 = *(const u32x2*)(vp + 16);
                    u32x4 va; va.x = v0.x; va.y = v0.y; va.z = v1.x; va.w = v1.y;
                    num[et] = MFMA16(__builtin_bit_cast(bf16x8, va), bp, num[et]);
                }
            }
            den += SHX(den, 16, lane); den += SHX(den, 32, lane);
            f32x4 qc[4]; float qn = 0.f;
#pragma unroll
            for (int ks = 0; ks < 2; ++ks) {
                const float* np = NLb + (size_t)su * 64 + ks * 32 + 8 * g;
                const f32x4 n0 = *(const f32x4*)np, n1 = *(const f32x4*)(np + 4);
                const u32x4 qb = __builtin_bit_cast(u32x4, bq[ks]);
                qn += (bf_lo(qb.x) * n0.x + bf_hi(qb.x) * n0.y) + (bf_lo(qb.y) * n0.z + bf_hi(qb.y) * n0.w) + (bf_lo(qb.z) * n1.x + bf_hi(qb.z) * n1.y) + (bf_lo(qb.w) * n1.z + bf_hi(qb.w) * n1.w);
            }
            qn += SHX(qn, 16, lane); qn += SHX(qn, 32, lane);
#pragma unroll
            for (int et = 0; et < 4; ++et) {
                qc[et] = (f32x4){0.f, 0.f, 0.f, 0.f};
#pragma unroll
                for (int ks = 0; ks < 2; ++ks) {
                    const float* cp = CL + (size_t)su * 4096 + (size_t)(et * 16 + col) * 64 + ks * 32 + 8 * g;
                    qc[et] = MFMA16(cvt8(*(const f32x4*)cp, *(const f32x4*)(cp + 4)), bq[ks], qc[et]);
                }
            }
            const float dd = frcp(fmaxf(fabsf(den + wint * qn), fexp(-mt)));
#pragma unroll
            for (int et = 0; et < 4; ++et) hs[et] += (num[et] + wint * qc[et]) * dd;
        }
        float sm = 0.f;
#pragma unroll
        for (int et = 0; et < 4; ++et) sm += (hs[et].x + hs[et].y) + (hs[et].z + hs[et].w);
        sm += SHX(sm, 16, lane); sm += SHX(sm, 32, lane);
        const float mean = sm * (1.0f / 64.0f); float q = 0.f;
#pragma unroll
        for (int et = 0; et < 4; ++et) { const f32x4 dl = hs[et] - mean; q += (dl.x * dl.x + dl.y * dl.y) + (dl.z * dl.z + dl.w * dl.w); }
        q += SHX(q, 16, lane); q += SHX(q, 32, lane);
        const float rstd = 1.0f / sqrtf(q * (1.0f / 64.0f) + LN_EPS);
#pragma unroll
        for (int et = 0; et < 4; ++et) {
            const int c = h * 64 + et * 16 + 4 * g;
            const f32x4 o4 = *(const f32x4*)(proj + trow * PLD + C_MW + 3 * MW + c), g4 = *(const f32x4*)(mln_g + c);
            const f32x4 y = (hs[et] - mean) * rstd * g4;
            u32x2 ob; ob.x = pk2(sigmoidf_(o4.x) * y.x, sigmoidf_(o4.y) * y.y); ob.y = pk2(sigmoidf_(o4.z) * y.z, sigmoidf_(o4.w) * y.w);
            *(u32x2*)(GRP + trow * D + GW + RW + c) = ob;
        }
    }
}

__device__ __forceinline__ void phase_rwkv_post(const Params& P, int l, unsigned char* smem, int wv) {
    ParamsPtr pp = PARAMS_PTR(P); PIN_S(pp); unsigned char* ws = pp->ws; int bidx = (int)blockIdx.x, gdim = (int)gridDim.x; PIN_S(bidx); PIN_S(gdim);
    const float* SCAN = (const float*)(ws + O_SCAN); const float* VV = (const float*)(ws + O_VV); const float* GATE = (const float*)(ws + O_GATE);
    const float* BONUS = (const float*)(ws + O_BONUS); bf16_t* GRP = (bf16_t*)(ws + O_GRP);
    const float* rln_g = pp->in[15] + (size_t)l * RW; const float* rln_b = pp->in[16] + (size_t)l * RW;
    const int tid = phase_tid(wv), lane = tid & 63, wave = tid >> 6;
    const int gw = bidx * NWAVES + wave, ngw = NWAVES * gdim;
    for (int it = gw; it < T * RH; it += ngw) {
        const int t = it / RH, h = it % RH, c = h * 64 + lane;
        const size_t o = (size_t)t * RW + c;
        const float x = SCAN[o] + SCAN[(size_t)T * RW + o];
        const float mean = wave_sum(x, lane) * (1.0f / 64.0f);
        const float dl = x - mean;
        const float var = wave_sum(dl * dl, lane) * (1.0f / 64.0f);
        float y = dl / sqrtf(var + GN_EPS) * rln_g[c] + rln_b[c];
        y += BONUS[(size_t)t * RH + h] * VV[o];
        GRP[(size_t)t * D + GW + c] = (bf16_t)f2bf(y * GATE[o]);
    }
}

__device__ __forceinline__ void phase_ln1_router(const Params& P, int l, unsigned char* smem, int wv) {
    ParamsPtr pp = PARAMS_PTR(P); PIN_S(pp); unsigned char* ws = pp->ws; int bidx = (int)blockIdx.x, gdim = (int)gridDim.x; PIN_S(bidx); PIN_S(gdim);
    const float* xin = l == 0 ? pp->in[0] : (const float*)(ws + O_XA);
    const float* MIX = (const float*)(ws + O_MIX); float* X1 = (float*)(ws + O_X1);
    int* TOPI = (int*)(ws + O_TOPI); float* TOPG = (float*)(ws + O_TOPG); int* RANK = (int*)(ws + O_RANK); bf16_t* X1B = (bf16_t*)(ws + O_X1B);
    int* BCNT = (int*)(ws + O_BCNT);
    const float* g1 = pp->in[22] + (size_t)l * D; const float* b1 = pp->in[23] + (size_t)l * D;
    const float* rw = pp->in[24] + (size_t)l * D * NE; const float* rb = pp->in[25] + (size_t)l * NE;
    const int tid = phase_tid(wv), lane = tid & 63, wave = tid >> 6;
    float* Wl = (float*)smem;
    float* lgs = (float*)(smem + 131072);
    int* stopi = (int*)(smem + 131072 + 8192);
    __syncthreads();
    for (int i = tid; i < D * NE / 4; i += NTHREADS) ((f32x4*)Wl)[i] = ((const f32x4*)rw)[i];
    for (int tile = bidx; tile < T / 64; tile += gdim) {
        __syncthreads();
        for (int ti8 = 0; ti8 < 8; ++ti8) {
            const int t = tile * 64 + wave * 8 + ti8;
            float v[16]; float sm = 0.f;
#pragma unroll
            for (int j = 0; j < 4; ++j) {
                const int c = j * 256 + lane * 4;
                const f32x4 a = *(const f32x4*)(xin + (size_t)t * D + c), m = *(const f32x4*)(MIX + (size_t)t * D + c);
                v[j * 4 + 0] = ALPHA * a.x + m.x; v[j * 4 + 1] = ALPHA * a.y + m.y; v[j * 4 + 2] = ALPHA * a.z + m.z; v[j * 4 + 3] = ALPHA * a.w + m.w;
                sm += (v[j * 4] + v[j * 4 + 1]) + (v[j * 4 + 2] + v[j * 4 + 3]);
            }
            const float mean = wave_sum(sm, lane) * (1.0f / D); float q = 0.f;
#pragma unroll
            for (int j = 0; j < 16; ++j) { const float dl = v[j] - mean; q += dl * dl; }
            const float rstd = 1.0f / sqrtf(wave_sum(q, lane) * (1.0f / D) + LN_EPS);
#pragma unroll
            for (int j = 0; j < 4; ++j) {
                const int c = j * 256 + lane * 4;
                const f32x4 gg = *(const f32x4*)(g1 + c), bb = *(const f32x4*)(b1 + c);
                f32x4 o;
                o.x = (v[j * 4 + 0] - mean) * rstd * gg.x + bb.x; o.y = (v[j * 4 + 1] - mean) * rstd * gg.y + bb.y;
                o.z = (v[j * 4 + 2] - mean) * rstd * gg.z + bb.z; o.w = (v[j * 4 + 3] - mean) * rstd * gg.w + bb.w;
                *(f32x4*)(X1 + (size_t)t * D + c) = o;
                u32x2 ob; ob.x = pk2(o.x, o.y); ob.y = pk2(o.z, o.w); *(u32x2*)(X1B + (size_t)t * D + c) = ob;
            }
        }
        __syncthreads();
        {
            const int tq = tid >> 3, eg = (tid & 7) * 4;
            const float* xr = X1 + (size_t)(tile * 64 + tq) * D;
            f32x4 acc = *(const f32x4*)(rb + eg);
#pragma unroll 4
            for (int c = 0; c < D; c += 4) {
                const f32x4 x4 = *(const f32x4*)(xr + c);
                acc += x4.x * *(const f32x4*)(Wl + (c + 0) * NE + eg); acc += x4.y * *(const f32x4*)(Wl + (c + 1) * NE + eg);
                acc += x4.z * *(const f32x4*)(Wl + (c + 2) * NE + eg); acc += x4.w * *(const f32x4*)(Wl + (c + 3) * NE + eg);
            }
            *(f32x4*)(lgs + tq * NE + eg) = acc;
        }
        __syncthreads();
        if (tid < 64) {
            const float* lp = lgs + tid * NE; const int t = tile * 64 + tid;
            float tv[4]; int ti[4];
#pragma unroll
            for (int k = 0; k < 4; ++k) { tv[k] = -INFINITY; ti[k] = 0; }
            for (int e = 0; e < NE; ++e) {
                const float x = lp[e];
                if (x > tv[3]) {
                    if (x > tv[0]) { tv[3] = tv[2]; ti[3] = ti[2]; tv[2] = tv[1]; ti[2] = ti[1]; tv[1] = tv[0]; ti[1] = ti[0]; tv[0] = x; ti[0] = e; }
                    else if (x > tv[1]) { tv[3] = tv[2]; ti[3] = ti[2]; tv[2] = tv[1]; ti[2] = ti[1]; tv[1] = x; ti[1] = e; }
                    else if (x > tv[2]) { tv[3] = tv[2]; ti[3] = ti[2]; tv[2] = x; ti[2] = e; }
                    else { tv[3] = x; ti[3] = e; }
                }
            }
            const float e1 = expf(tv[1] - tv[0]), e2 = expf(tv[2] - tv[0]), e3 = expf(tv[3] - tv[0]);
            const float inv = 1.0f / (1.0f + e1 + e2 + e3);
            *(f32x4*)(TOPG + (size_t)t * 4) = (f32x4){inv, e1 * inv, e2 * inv, e3 * inv};
#pragma unroll
            for (int k = 0; k < 4; ++k) { TOPI[(size_t)t * 4 + k] = ti[k]; stopi[tid * 4 + k] = ti[k]; }
        }
        __syncthreads();
        if (tid < 256) { const int e = stopi[tid]; int r = 0; for (int a2 = 0; a2 < tid; ++a2) r += (stopi[a2] == e) ? 1 : 0; RANK[(size_t)tile * 256 + tid] = r; }
        else if (tid < 256 + NE) { const int e = tid - 256; int cnt = 0; for (int a2 = 0; a2 < 256; ++a2) cnt += (stopi[a2] == e) ? 1 : 0; BCNT[tile * NE + e] = cnt; }
    }
    __syncthreads();
}

__device__ __forceinline__ void moe_offsets(int* sh, const int* CNT, int tid) {
    if (tid == 0) {
        int acc = 0;
        for (int e = 0; e < NE; ++e) { const int c = (int)CNT[e]; sh[e] = c; sh[32 + e] = acc; acc += (c + MOEB - 1) / MOEB * MOEB; sh[64 + e] = acc; }
    }
    __syncthreads();
}
__device__ __forceinline__ int moe_expert_of_row(const int* sh, int r) {
    int e = -1;
    for (int i = 0; i < NE; ++i) if (r >= sh[32 + i] && r < sh[64 + i]) e = i;
    return e;
}

__device__ __forceinline__ void phase_scatter(const Params& P, int l, unsigned char* smem, int wv) {
    ParamsPtr pp = PARAMS_PTR(P); PIN_S(pp); unsigned char* ws = pp->ws; int bidx = (int)blockIdx.x, gdim = (int)gridDim.x; PIN_S(bidx); PIN_S(gdim);
    const int tid = phase_tid(wv), lane = tid & 63, wave = tid >> 6;
    const int* TOPI = (const int*)(ws + O_TOPI); const int* RANK = (const int*)(ws + O_RANK); int* SLOT = (int*)(ws + O_SLOT);
    const int* BCNT = (const int*)(ws + O_BCNT); int* CNTF = (int*)(ws + O_CNTF);
    const bf16_t* X1B = (const bf16_t*)(ws + O_X1B); bf16_t* XS = (bf16_t*)(ws + O_XS);
    int* sh = (int*)smem;
    int* part = sh + 96;
    int* tot = part + 512;
    int* base = tot + 32;
    constexpr int NT = T / 64;
    const int e = tid & 31, pt = tid >> 5;
    { int sacc = 0; for (int tl = pt; tl < NT; tl += 16) sacc += BCNT[tl * NE + e]; part[pt * 32 + e] = sacc; }
    __syncthreads();
    if (tid < 32) { int sacc = 0; for (int q = 0; q < 16; ++q) sacc += part[q * 32 + tid]; tot[tid] = sacc; if (bidx == 0) CNTF[tid] = sacc; }
    __syncthreads();
    moe_offsets(sh, tot, tid);
    for (int tile = bidx; tile < NT; tile += gdim) {
        __syncthreads();
        { int sacc = 0; for (int tl = pt; tl < tile; tl += 16) sacc += BCNT[tl * NE + e]; part[pt * 32 + e] = sacc; }
        __syncthreads();
        if (tid < 32) { int sacc = sh[32 + tid]; for (int q = 0; q < 16; ++q) sacc += part[q * 32 + tid]; base[tid] = sacc; }
        __syncthreads();
        for (int al = wave; al < 256; al += NWAVES) {
            const int a = tile * 256 + al, dest = base[TOPI[a]] + RANK[a], t = a >> 2;
            if (lane == 0) SLOT[a] = dest;
            const u32x4* src = (const u32x4*)(X1B + (size_t)t * D); u32x4* dst = (u32x4*)(XS + (size_t)dest * D);
            dst[lane] = src[lane]; dst[64 + lane] = src[64 + lane];
        }
    }
    __syncthreads();
}

template <int WHICH>
__device__ __forceinline__ void phase_moe_gemm(const Params& P, int l, unsigned char* smem, int wv) {
    ParamsPtr pp = PARAMS_PTR(P); PIN_S(pp); unsigned char* ws = pp->ws; int bidx = (int)blockIdx.x, gdim = (int)gridDim.x; PIN_S(bidx); PIN_S(gdim);
    const int tid = phase_tid(wv);
    const int* CNT = (const int*)(ws + O_CNTF);
    int* sh = (int*)(smem + 131072);
    int* rbe = sh + 96;
    moe_offsets(sh, CNT, tid);
    const int nrb = sh[64 + NE - 1] / MOEB;
    for (int rb = tid; rb < nrb; rb += NTHREADS) rbe[rb] = moe_expert_of_row(sh, rb * MOEB);
    __syncthreads();
    pg8::MoeOrder S;
    S.K = 1024; S.G = gdim; S.c = bidx; S.rbe = rbe;
    if (WHICH == 1) {
        S.A = (const char*)(ws + O_XS); S.Wt = (const char*)(ws + O_W1) + (size_t)l * NE * 2 * DFF * D * 2; S.estride = (size_t)2 * DFF * D * 2; S.nN = 2 * DFF / 256; S.nwg = nrb * S.nN;
        pg8::EpiSwiglu E{(bf16_t*)(ws + O_ACT), pp->in[27] + (size_t)l * NE * 2 * DFF};
        pg8::gemm_phase<pg8::EpiSwiglu, pg8::MoeOrder>((LAS unsigned char*)smem, 1024, S, E, tid);
    } else {
        S.A = (const char*)(ws + O_ACT); S.Wt = (const char*)(ws + O_W2) + (size_t)l * NE * D * DFF * 2; S.estride = (size_t)D * DFF * 2; S.nN = D / 256; S.nwg = nrb * S.nN;
        pg8::EpiBf16Bias E{(bf16_t*)(ws + O_YS), D, pp->in[29] + (size_t)l * NE * D, D};
        pg8::gemm_phase<pg8::EpiBf16Bias, pg8::MoeOrder>((LAS unsigned char*)smem, 1024, S, E, tid);
    }
    __syncthreads();
}

__device__ __forceinline__ void phase_combine_ln2(const Params& P, int l, unsigned char* smem, int wv) {
    ParamsPtr pp = PARAMS_PTR(P); PIN_S(pp); unsigned char* ws = pp->ws; int bidx = (int)blockIdx.x, gdim = (int)gridDim.x; PIN_S(bidx); PIN_S(gdim);
    const float* X1 = (const float*)(ws + O_X1); const bf16_t* YS = (const bf16_t*)(ws + O_YS); bf16_t* XB = (bf16_t*)(ws + O_XB);
    const int* SLOT = (const int*)(ws + O_SLOT); const float* TOPG = (const float*)(ws + O_TOPG);
    float* xo = l == NL - 1 ? pp->out : (float*)(ws + O_XA);
    const float* g2 = pp->in[30] + (size_t)l * D; const float* b2 = pp->in[31] + (size_t)l * D;
    const int tid = phase_tid(wv), lane = tid & 63, wave = tid >> 6;
    const int gw = bidx * NWAVES + wave, ngw = NWAVES * gdim;
    for (int t = gw; t < T; t += ngw) {
        int sl[4]; float gg[4];
#pragma unroll
        for (int k = 0; k < 4; ++k) { sl[k] = SLOT[(size_t)t * 4 + k]; gg[k] = TOPG[(size_t)t * 4 + k]; }
        float v[16]; float sm = 0.f;
#pragma unroll
        for (int j = 0; j < 4; ++j) {
            const int c = j * 256 + lane * 4;
            const f32x4 a = *(const f32x4*)(X1 + (size_t)t * D + c);
            f32x4 y = (f32x4){0.f, 0.f, 0.f, 0.f};
#pragma unroll
            for (int k = 0; k < 4; ++k) { const u32x2 yk = *(const u32x2*)(YS + (size_t)sl[k] * D + c);
                y.x += gg[k] * __builtin_bit_cast(float, yk.x << 16); y.y += gg[k] * __builtin_bit_cast(float, yk.x & 0xffff0000u); y.z += gg[k] * __builtin_bit_cast(float, yk.y << 16); y.w += gg[k] * __builtin_bit_cast(float, yk.y & 0xffff0000u); }
            v[j * 4 + 0] = ALPHA * a.x + y.x; v[j * 4 + 1] = ALPHA * a.y + y.y; v[j * 4 + 2] = ALPHA * a.z + y.z; v[j * 4 + 3] = ALPHA * a.w + y.w;
            sm += (v[j * 4] + v[j * 4 + 1]) + (v[j * 4 + 2] + v[j * 4 + 3]);
        }
        const float mean = wave_sum(sm, lane) * (1.0f / D); float q = 0.f;
#pragma unroll
        for (int j = 0; j < 16; ++j) { const float dl = v[j] - mean; q += dl * dl; }
        const float rstd = 1.0f / sqrtf(wave_sum(q, lane) * (1.0f / D) + LN_EPS);
#pragma unroll
        for (int j = 0; j < 4; ++j) {
            const int c = j * 256 + lane * 4;
            f32x4 o;
            o.x = (v[j * 4 + 0] - mean) * rstd * g2[c + 0] + b2[c + 0]; o.y = (v[j * 4 + 1] - mean) * rstd * g2[c + 1] + b2[c + 1];
            o.z = (v[j * 4 + 2] - mean) * rstd * g2[c + 2] + b2[c + 2]; o.w = (v[j * 4 + 3] - mean) * rstd * g2[c + 3] + b2[c + 3];
            *(f32x4*)(xo + (size_t)t * D + c) = o;
            if (l != NL - 1) { u32x2 ob; ob.x = pk2(o.x, o.y); ob.y = pk2(o.z, o.w); *(u32x2*)(XB + (size_t)t * D + c) = ob; }
        }
    }
}

__device__ __forceinline__ void phase_inproj(const Params& P, int l, unsigned char* smem, int wv) {
    ParamsPtr pp = PARAMS_PTR(P); PIN_S(pp); unsigned char* ws = pp->ws; int bidx = (int)blockIdx.x, gdim = (int)gridDim.x; PIN_S(bidx); PIN_S(gdim);
    const int tid = phase_tid(wv);
    pg8::DenseOrder S; S.init(ws + O_XB, (const bf16_t*)(ws + O_WIN) + (size_t)l * PLD * D, T, PLD, D, gdim, bidx);
    pg8::EpiF32 E{(float*)(ws + O_PROJ), PLD};
    pg8::gemm_phase<pg8::EpiF32, pg8::DenseOrder>((LAS unsigned char*)smem, D, S, E, tid);
    __syncthreads();
}
__device__ __forceinline__ void phase_outproj(const Params& P, int l, unsigned char* smem, int wv) {
    ParamsPtr pp = PARAMS_PTR(P); PIN_S(pp); unsigned char* ws = pp->ws; int bidx = (int)blockIdx.x, gdim = (int)gridDim.x; PIN_S(bidx); PIN_S(gdim);
    const int tid = phase_tid(wv);
    pg8::DenseOrder S; S.init(ws + O_GRP, (const bf16_t*)(ws + O_WOUT) + (size_t)l * D * D, T, D, D, gdim, bidx);
    pg8::EpiF32 E{(float*)(ws + O_MIX), D};
    pg8::gemm_phase<pg8::EpiF32, pg8::DenseOrder>((LAS unsigned char*)smem, D, S, E, tid);
    __syncthreads();
}

#ifndef EMU
#define XB_TMO      128
#define XB_XCNT(j)  (256  + 64 * (j))
#define XB_XSUB(j)  (1280 + 64 * (j))
#define XB_XGEN(j)  (2304 + 64 * (j))
#define XB_TOP      3328
#define XB_TOPGEN   3392
#define XCD_BAR_WORDS 3456
#define XB_SPIN_CAP (1u << 25)
__device__ __forceinline__ unsigned xb_ld(unsigned* p)              { return __hip_atomic_load(p, __ATOMIC_RELAXED, __HIP_MEMORY_SCOPE_AGENT); }
__device__ __forceinline__ unsigned xb_add(unsigned* p, unsigned v) { return __hip_atomic_fetch_add(p, v, __ATOMIC_RELAXED, __HIP_MEMORY_SCOPE_AGENT); }
__device__ __forceinline__ unsigned xb_xcc_id() { return (unsigned)__builtin_amdgcn_s_getreg((3 << 11) | 20) & 0xFu; }
#define XB_SPIN(cond, bar) do { unsigned _sp = 0; while (cond) { __builtin_amdgcn_s_sleep(1); \
    if ((++_sp & 255u) == 0u) { if (xb_ld(&(bar)[XB_TMO])) break; if (_sp > XB_SPIN_CAP) { atomicAdd(&(bar)[XB_TMO], 1u); break; } } } } while (0)
struct XcdBarrier { unsigned* bar; unsigned x; volatile LAS unsigned* st; };
__device__ __forceinline__ XcdBarrier xcd_barrier_post(unsigned* bar, volatile LAS unsigned* st) {
    XcdBarrier b; b.bar = bar; b.x = xb_xcc_id(); b.st = st;
    if (threadIdx.x == 0) (void)xb_add(&bar[XB_XCNT(b.x)], 1u);
    return b;
}
__device__ __forceinline__ void xcd_barrier_complete(unsigned* bar, unsigned x, unsigned& nloc, unsigned& nx) {
    const unsigned G = gridDim.x * gridDim.y * gridDim.z;
    unsigned sum, cnt, mine, sp = 0u;
    for (;;) {
        sum = 0u; cnt = 0u; mine = 0u;
#pragma unroll
        for (unsigned j = 0; j < 16; ++j) { const unsigned c = xb_ld(&bar[XB_XCNT(j)]); sum += c; cnt += (c > 0u) ? 1u : 0u; mine = (j == x) ? c : mine; }
        if (sum == G) break;
        __builtin_amdgcn_s_sleep(1);
        if ((++sp & 255u) == 0u) { if (xb_ld(&bar[XB_TMO])) break; if (sp > XB_SPIN_CAP) { atomicAdd(&bar[XB_TMO], 1u); break; } }
    }
    nloc = mine > 0u ? mine : 1u; nx = cnt > 0u ? cnt : 1u;
}
__device__ __forceinline__ void xcd_barrier(const XcdBarrier& b) {
    asm volatile("s_waitcnt vmcnt(0)" ::: "memory");
    __syncthreads();
    if (threadIdx.x == 0) {
        unsigned* bar = b.bar;
        __builtin_amdgcn_s_waitcnt(0);
        unsigned nloc = b.st[0], nx = b.st[1];
        if (nloc == 0u) { xcd_barrier_complete(bar, b.x, nloc, nx); b.st[0] = nloc; b.st[1] = nx; }
        const unsigned old = xb_add(&bar[XB_XSUB(b.x)], 1u);
        const unsigned gen = old / nloc;
        if (old + 1u == (gen + 1u) * nloc) {
            __builtin_amdgcn_fence(__ATOMIC_RELEASE, "agent");
            asm volatile("s_waitcnt vmcnt(0)" ::: "memory");
            const unsigned og = xb_add(&bar[XB_TOP], 1u);
            const unsigned tg = og / nx;
            if (og + 1u == (tg + 1u) * nx) xb_add(&bar[XB_TOPGEN], 1u);
            else XB_SPIN(xb_ld(&bar[XB_TOPGEN]) == tg, bar);
            __builtin_amdgcn_fence(__ATOMIC_ACQUIRE, "agent");
            xb_add(&bar[XB_XGEN(b.x)], 1u);
            asm volatile("s_waitcnt vmcnt(0)" ::: "memory");
        } else {
            XB_SPIN(xb_ld(&bar[XB_XGEN(b.x)]) == gen, bar);
            __builtin_amdgcn_fence(__ATOMIC_ACQUIRE, "agent");
            asm volatile("s_waitcnt vmcnt(0)" ::: "memory");
        }
    }
    __syncthreads();
}
#endif

__global__ void __launch_bounds__(512, 2) mk_fwd(Params P) {
#ifdef EMU
    unsigned char* smem = g_blk->lds;
#else
    extern __shared__ __attribute__((aligned(16))) unsigned char smem[];
    volatile LAS unsigned* bst = (volatile LAS unsigned*)(smem + LDS_BYTES - 16);
    if (threadIdx.x == 0) { bst[0] = 0u; bst[1] = 0u; bst[2] = 0u; bst[3] = 0u; }
    __syncthreads();
    XcdBarrier bar; bar.bar = (unsigned*)P.ws + CW_BAR; bar.x = 0; bar.st = bst;
    if (P.ph_hi - P.ph_lo > 1) bar = xcd_barrier_post((unsigned*)P.ws + CW_BAR, bst);
#endif
    const int lo = P.ph_lo, hi = P.ph_hi;
#ifdef EMU
    const int wv = (int)threadIdx.x >> 6;
#else
    const int wv = RFL((int)threadIdx.x >> 6);
#endif
#ifdef EMU
#define SEAM(id) do {} while (0)
#else
#define SEAM(id) do { if ((id) + 1 < hi) xcd_barrier(bar); } while (0)
#endif
#ifndef MK_ONLY_PHASE
#define MK_ONLY_PHASE -1
#endif
#ifndef MK_DUP_MASK
#define MK_DUP_MASK 0
#endif
#define PHG(kc, id, ...) do { if (MK_ONLY_PHASE < 0 || MK_ONLY_PHASE == (kc)) { const int id_ = (id); if (id_ >= lo && id_ < hi) { if ((MK_DUP_MASK >> (kc)) & 1) { __VA_ARGS__; SEAM(id_ - 1); } __VA_ARGS__; SEAM(id_); } } } while (0)
#define PH(k, ...) PHG(1 + (k), 1 + l * NPH + (k), __VA_ARGS__)
    PHG(0, 0, phase_prologue(P, smem, wv));
    for (int l = 0; l < NL; ++l) {
        PH(0, phase_inproj(P, l, smem, wv));
        PH(1, phase_prep(P, l, smem, wv));
#if MK_RWKV_CHUNKED
        PH(2, { phase_rwkv_pre(P, l, smem, wv); phase_mlstm_local(P, l, smem, wv, (int)blockIdx.x, (int)gridDim.x); });
        PH(3, { phase_rwkv_seq(P, l, smem, wv); phase_mlstm_carry(P, l, smem, wv); });
        PH(4, { phase_rwkv_out(P, l, smem, wv); phase_mlstm_out(P, l, smem, wv); phase_gmlp_mix(P, l, smem, wv, (int)blockIdx.x, (int)gridDim.x); });
#else
        PH(2, { const int G_ = (int)gridDim.x, NSC = 2 * NB * RH * 4;
                if (G_ >= NSC + 32) { if ((int)blockIdx.x < NSC) phase_rwkv_scan(P, l, smem, wv, (int)blockIdx.x, NSC);
                                      else phase_mlstm_local(P, l, smem, wv, (int)blockIdx.x - NSC, G_ - NSC); }
                else { phase_rwkv_scan(P, l, smem, wv, (int)blockIdx.x, G_); phase_mlstm_local(P, l, smem, wv, (int)blockIdx.x, G_); } });
        PH(3, phase_mlstm_carry(P, l, smem, wv));
        PH(4, { phase_mlstm_out(P, l, smem, wv); phase_gmlp_mix(P, l, smem, wv, (int)blockIdx.x, (int)gridDim.x); phase_rwkv_post(P, l, smem, wv); });
#endif
        PH(5, phase_outproj(P, l, smem, wv));
        PH(6, phase_ln1_router(P, l, smem, wv));
        PH(7, phase_scatter(P, l, smem, wv));
        PH(8, phase_moe_gemm<1>(P, l, smem, wv));
        PH(9, phase_moe_gemm<2>(P, l, smem, wv));
        PH(10, phase_combine_ln2(P, l, smem, wv));
    }
#undef PHG
#undef PH
#undef SEAM
}

}

#ifndef EMU
extern "C" void kernel_launch(void* const* d_in, const int* in_sizes, int n_in, void* d_out, int out_size, void* d_ws, size_t ws_size, hipStream_t stream) {
    using namespace mk;
    static int grid = 0;
    if (grid == 0) {
        if (n_in != 32 || out_size != T * D || ws_size < WS_END) { fprintf(stderr, "kernel_launch: unexpected shapes (n_in %d out %d ws %zu need %zu)\n", n_in, out_size, ws_size, (size_t)WS_END); grid = -1; return; }
        int dev = 0, cus = 0;
        if (hipGetDevice(&dev) != hipSuccess || hipDeviceGetAttribute(&cus, hipDeviceAttributeMultiprocessorCount, dev) != hipSuccess) { grid = -1; return; }
        if (hipFuncSetAttribute((const void*)mk_fwd, hipFuncAttributeMaxDynamicSharedMemorySize, LDS_BYTES) != hipSuccess) { fprintf(stderr, "kernel_launch: hipFuncSetAttribute failed\n"); grid = -1; return; }
        int per_cu = 0;
        (void)hipOccupancyMaxActiveBlocksPerMultiprocessor(&per_cu, (const void*)mk_fwd, NTHREADS, LDS_BYTES);
        (void)hipGetLastError();
        grid = cus;
    }
    if (grid < 0) return;
    (void)hipMemsetAsync(d_ws, 0, CTL_BYTES, stream);
    Params p{};
    for (int i = 0; i < 32; ++i) p.in[i] = (const float*)d_in[i];
    p.out = (float*)d_out; p.ws = (unsigned char*)d_ws;
#if MK_ONE_LAUNCH
    p.ph_lo = 0; p.ph_hi = 1 + NL * NPH;
    hipLaunchKernelGGL(mk_fwd, dim3(grid), dim3(NTHREADS), LDS_BYTES, stream, p);
#else
    for (int id = 0; id < 1 + NL * NPH; ++id) {
        p.ph_lo = id; p.ph_hi = id + 1;
        hipLaunchKernelGGL(mk_fwd, dim3(grid), dim3(NTHREADS), LDS_BYTES, stream, p);
    }
#endif
}
#endif
```

```cpp
#ifndef EMU
#include <hip/hip_runtime.h>
#endif
#include <cstdio>
#include <cstdint>
#include <cmath>

#ifndef CFG_BATCH
#define CFG_BATCH 4
#endif
#ifndef CFG_SEQ
#define CFG_SEQ 4096
#endif
#ifndef CFG_LAYERS
#define CFG_LAYERS 4
#endif
#ifndef MK_RWKV_CHUNKED
#define MK_RWKV_CHUNKED 1
#endif
#ifndef MK_PROBE
#define MK_PROBE 0
#endif
#ifndef MK_ONE_LAUNCH
#define MK_ONE_LAUNCH 1
#endif

namespace mk {
constexpr int NB = CFG_BATCH, S = CFG_SEQ, T = NB * S, NL = CFG_LAYERS, D = 1024;
constexpr int GW = 256, RW = 384, MW = 384, HD = 64, GH = 4, RH = 6, MH = 6, CH = 128, NCH = S / CH;
constexpr int PIN = 3480, PLD = 3584, RPROJ = 1408;
constexpr int C_RW = 512, C_MW = 1920;
constexpr int NE = 32, TOPK = 4, DFF = 1024, MOEB = 256;
constexpr int NROWS = (T * TOPK / MOEB + NE) * MOEB;
constexpr float LN_EPS = 1e-5f, GN_EPS = 64e-5f;
constexpr float ALPHA = 1.6817928305074290f;
constexpr int NTHREADS = 512, NWAVES = 8;
constexpr int LDS_BYTES = 160 * 1024;
constexpr int NPH = 11;

typedef float f32x4 __attribute__((ext_vector_type(4)));
typedef unsigned u32x4 __attribute__((ext_vector_type(4)));
typedef unsigned u32x2 __attribute__((ext_vector_type(2)));
typedef short bf16x8 __attribute__((ext_vector_type(8)));
typedef unsigned short bf16_t;

constexpr size_t al(size_t x) { return (x + 255) & ~(size_t)255; }
constexpr size_t CTL_BYTES = 1u << 20;
constexpr size_t O_XA = CTL_BYTES;
constexpr size_t O_XB = O_XA + al((size_t)T * D * 4);
constexpr size_t O_X1 = O_XB + al((size_t)T * D * 2);
constexpr size_t O_X1B = O_X1 + al((size_t)T * D * 4);
constexpr size_t O_PROJ = O_X1B + al((size_t)T * D * 2);
constexpr size_t O_MIX = O_PROJ + al((size_t)T * PLD * 4);
constexpr size_t O_GRP = O_MIX + al((size_t)T * D * 4);
constexpr size_t O_UG = O_GRP + al((size_t)T * D * 2);
constexpr size_t O_VN = O_UG + al((size_t)T * GW * 4);
constexpr size_t O_RR = O_VN + al((size_t)T * GW * 4);
constexpr size_t O_VV = O_RR + al((size_t)T * RW * 4);
constexpr size_t O_KK = O_VV + al((size_t)T * RW * 4);
constexpr size_t O_DEC = O_KK + al((size_t)T * RW * 4);
constexpr size_t O_KD = O_DEC + al((size_t)2 * T * RW * 4);
constexpr size_t O_ICLR = O_KD + al((size_t)2 * T * RW * 4);
constexpr size_t O_GATE = O_ICLR + al((size_t)2 * T * RW * 4);
constexpr size_t O_BONUS = O_GATE + al((size_t)T * RW * 4);
constexpr size_t O_SCAN = O_BONUS + al((size_t)T * RH * 4);
constexpr size_t O_MQ = O_SCAN + al((size_t)2 * T * RW * 4);
constexpr size_t O_MK = O_MQ + al((size_t)T * MW * 4);
constexpr size_t O_IG = O_MK + al((size_t)T * MW * 4);
constexpr size_t O_LF = O_IG + al((size_t)2 * T * MH * 4);
constexpr size_t O_CL = O_LF + al((size_t)2 * T * MH * 4);
constexpr size_t O_NL = O_CL + al((size_t)2 * NB * MH * NCH * 4096 * 4);
constexpr size_t O_ML = O_NL + al((size_t)2 * NB * MH * NCH * 64 * 4);
constexpr size_t O_BL = O_ML + al((size_t)2 * NB * MH * NCH * 4);
constexpr size_t O_MIN = O_BL + al((size_t)2 * NB * MH * NCH * 4);
constexpr size_t O_TOPI = O_MIN + al((size_t)2 * NB * MH * NCH * 4);
constexpr size_t O_TOPG = O_TOPI + al((size_t)T * 4 * 4);
constexpr size_t O_RANK = O_TOPG + al((size_t)T * 4 * 4);
constexpr size_t O_SLOT = O_RANK + al((size_t)T * 4 * 4);
constexpr size_t O_MQB = O_SLOT + al((size_t)T * 4 * 4);
constexpr size_t O_MKB = O_MQB + al((size_t)T * MW * 2);
constexpr size_t O_KT = O_MKB + al((size_t)T * MW * 2);
constexpr size_t O_VT = O_KT + al((size_t)T * MW * 2);
constexpr size_t O_GVT = O_VT + al((size_t)T * MW * 2);
constexpr size_t O_PMX = O_GVT + al((size_t)2 * T * MH * 4);
constexpr size_t O_BCT = O_PMX + al((size_t)2 * T * MH * 4);
constexpr size_t O_BRKR = O_BCT + al((size_t)2 * T * MH * 4);
constexpr int RC = 64, RNC = S / RC, RUN = 2 * NB * RH * RNC;
constexpr size_t O_LW = O_BRKR + al((size_t)2 * T * RH * 2 * 4);
constexpr size_t O_RQ = O_LW + al((size_t)2 * T * RW * 4);
constexpr size_t O_RA = O_RQ + al((size_t)RUN * 4096 * 2);
constexpr size_t O_RS = O_RA + al((size_t)RUN * 4096 * 2);
constexpr size_t O_RH = O_RS + al((size_t)RUN * 4096 * 2);
constexpr size_t O_RG = O_RH + al((size_t)RUN * 4096 * 4);
constexpr size_t O_VNT = O_RG + al((size_t)RUN * 4096 * 4);
constexpr size_t O_WSB = O_VNT + al((size_t)T * GW * 2);
constexpr size_t O_LWT = O_WSB + al((size_t)NL * GH * CH * CH * 2);
constexpr size_t O_BCNT = O_LWT + al((size_t)NL * 1920 * 128 * 2);
constexpr size_t O_CNTF = O_BCNT + al((size_t)(T / 64) * NE * 4);
constexpr size_t O_XS = O_CNTF + al((size_t)NE * 4);
constexpr size_t O_ACT = O_XS + al((size_t)NROWS * D * 2);
constexpr size_t O_YS = O_ACT + al((size_t)NROWS * DFF * 2);
constexpr size_t O_WIN = O_YS + al((size_t)NROWS * D * 2);
constexpr size_t O_WOUT = O_WIN + al((size_t)NL * PLD * D * 2);
constexpr size_t O_W1 = O_WOUT + al((size_t)NL * D * D * 2);
constexpr size_t O_W2 = O_W1 + al((size_t)NL * NE * 2 * DFF * D * 2);
constexpr size_t WS_END = O_W2 + al((size_t)NL * NE * D * DFF * 2);

constexpr int CW_BAR = 4096;
constexpr int CW_CNT = 16384;

struct Params { const float* in[32]; float* out; unsigned char* ws; int ph_lo, ph_hi; };
#ifdef EMU
typedef const Params* ParamsPtr;
#define PARAMS_PTR(P) (&(P))
#else
typedef const __attribute__((address_space(4))) Params* ParamsPtr;
#define PARAMS_PTR(P) ((ParamsPtr)__builtin_amdgcn_kernarg_segment_ptr())
#endif

#ifdef EMU
#define WAVE_SYNC() emu_wave_barrier()
#define PIN_V(x) do {} while (0)
#define PIN_S(x) do {} while (0)
#else
#define WAVE_SYNC() __builtin_amdgcn_wave_barrier()
#define PIN_V(x) asm volatile("" : "+v"(x))
#define PIN_S(x) asm volatile("" : "+s"(x))
#endif
#ifdef EMU
__device__ __forceinline__ int phase_tid(int wv) { (void)wv; return threadIdx.x; }
#else
__device__ __forceinline__ int phase_tid(int wv) { int t; asm volatile("v_mbcnt_lo_u32_b32 %0, -1, 0\n\tv_mbcnt_hi_u32_b32 %0, -1, %0" : "=v"(t)); return (wv << 6) + t; }
#endif

#ifdef EMU
#define SHX(v, m, lane) __shfl_xor(v, m)
#else
__device__ __forceinline__ float shx_(float v, int m, int lane) { return __builtin_bit_cast(float, __builtin_amdgcn_ds_bpermute((lane ^ m) << 2, __builtin_bit_cast(int, v))); }
__device__ __forceinline__ int shx_(int v, int m, int lane) { return __builtin_amdgcn_ds_bpermute((lane ^ m) << 2, v); }
#define SHX(v, m, lane) shx_(v, m, lane)
#endif
#ifdef EMU
#define SHUP(v, o, lane) __shfl(v, ((lane) - (o)) & 63)
#define RDL(v, src) __shfl(v, src)
#define SHL(v, src) __shfl(v, src)
#else
#define SHL(v, src) __builtin_bit_cast(float, __builtin_amdgcn_ds_bpermute((src) << 2, __builtin_bit_cast(int, (float)(v))))
#define SHUP(v, o, lane) __builtin_bit_cast(float, __builtin_amdgcn_ds_bpermute((((lane) - (o)) & 63) << 2, __builtin_bit_cast(int, (float)(v))))
#define RDL(v, src) __builtin_bit_cast(float, __builtin_amdgcn_readlane(__builtin_bit_cast(int, (float)(v)), src))
#endif
__device__ __forceinline__ float wave_sum(float v, int lane) {
#pragma unroll
    for (int o = 32; o >= 1; o >>= 1) v += SHX(v, o, lane);
    return v;
}
#ifdef EMU
__device__ __forceinline__ float fexp(float x) { return expf(x); }
__device__ __forceinline__ float flog(float x) { return logf(x); }
__device__ __forceinline__ float frcp(float x) { return 1.0f / x; }
#else
__device__ __forceinline__ float fexp(float x) { return __builtin_amdgcn_exp2f(x * 1.4426950408889634f); }
__device__ __forceinline__ float flog(float x) { return __builtin_amdgcn_logf(x) * 0.6931471805599453f; }
__device__ __forceinline__ float frcp(float x) { return __builtin_amdgcn_rcpf(x); }
#endif
__device__ __forceinline__ float sigmoidf_(float x) { return frcp(1.0f + fexp(-x)); }
__device__ __forceinline__ float softplusf_(float x) { return fmaxf(x, 0.f) + flog(1.0f + fexp(-fabsf(x))); }
__device__ __forceinline__ float ftanh(float x) { return 1.0f - 2.0f * frcp(1.0f + fexp(2.0f * x)); }
__device__ __forceinline__ float geluf_(float v) {
    const float av = fabsf(v), t = frcp(1.0f + 0.2316418882f * av);
    float q = t * 0.5307027145f + (-0.7265760135f); q = q * t + 0.7107068705f; q = q * t + (-0.142248368f); q = q * t + 0.127414796f; q = q * t;
    const float m = v * (q * fexp(-0.5f * v * v));
    return v < 0.f ? m : v - m;
}

#ifdef EMU
#define LAS
#define WAIT_V(n) do {} while (0)
#define WAIT_L(n) do {} while (0)
#define S_BARRIER() __syncthreads()
#define SETPRIO(x) do {} while (0)
#define SCHED_BAR() do {} while (0)
#define RFL(x) (x)
static inline void emu_glds16(const void* g, void* l) { memcpy((char*)l + (g_blk->cur & 63) * 16, g, 16); }
#define GLDS16(gptr, ldsptr) emu_glds16((const void*)(gptr), (void*)(ldsptr))
static inline float emu_bf2f(unsigned short b) { unsigned u = (unsigned)b << 16; float f; memcpy(&f, &u, 4); return f; }
static inline f32x4 emu_mfma16(bf16x8 a, bf16x8 b, f32x4 c) {
    EmuBlock* blk = g_blk; const int cur = blk->cur, lane = cur & 63, wbase = cur & ~63;
    static thread_local unsigned short Ash[32][64][8], Bsh[32][64][8];
    const int w = cur >> 6;
    for (int j = 0; j < 8; ++j) { Ash[w][lane][j] = (unsigned short)a[j]; Bsh[w][lane][j] = (unsigned short)b[j]; }
    emu_wave_barrier();
    const int col = lane & 15;
    for (int r = 0; r < 4; ++r) { const int row = 4 * (lane >> 4) + r; float sum = c[r];
        for (int k = 0; k < 32; ++k) sum += emu_bf2f(Ash[w][row + 16 * (k >> 3)][k & 7]) * emu_bf2f(Bsh[w][col + 16 * (k >> 3)][k & 7]);
        c[r] = sum; }
    emu_wave_barrier(); (void)wbase;
    return c;
}
#define MFMA16(a, b, c) emu_mfma16(a, b, c)
#else
#define LAS __attribute__((address_space(3)))
#define WAIT_V(n) asm volatile("s_waitcnt vmcnt(" #n ")" ::: "memory")
#define WAIT_L(n) asm volatile("s_waitcnt lgkmcnt(" #n ")" ::: "memory")
#define S_BARRIER() __builtin_amdgcn_s_barrier()
#define SETPRIO(x) __builtin_amdgcn_s_setprio(x)
#define SCHED_BAR() __builtin_amdgcn_sched_barrier(0)
#define RFL(x) __builtin_amdgcn_readfirstlane(x)
#define GLDS16(gptr, ldsptr) __builtin_amdgcn_global_load_lds((const unsigned*)(gptr), (LAS unsigned*)(ldsptr), 16, 0, 0)
#define MFMA16(a, b, c) __builtin_amdgcn_mfma_f32_16x16x32_bf16(a, b, c, 0, 0, 0)
#endif

__device__ __forceinline__ unsigned f2bf(float f) { unsigned u = __builtin_bit_cast(unsigned, f); return (u + 0x7fffu + ((u >> 16) & 1u)) >> 16; }
__device__ __forceinline__ unsigned pk2(float lo, float hi) { return f2bf(lo) | (f2bf(hi) << 16); }
__device__ __forceinline__ bf16x8 cvt8(const f32x4 a, const f32x4 b) {
    u32x4 w; w.x = pk2(a.x, a.y); w.y = pk2(a.z, a.w); w.z = pk2(b.x, b.y); w.w = pk2(b.z, b.w); return __builtin_bit_cast(bf16x8, w);
}
__device__ __forceinline__ float bf_lo(unsigned u) { return __builtin_bit_cast(float, u << 16); }
__device__ __forceinline__ float bf_hi(unsigned u) { return __builtin_bit_cast(float, u & 0xffff0000u); }

namespace pg8 {
constexpr int BM = 256, BK = 64, HALF = 128, HTB = HALF * BK * 2, STAGE_BYTES = 8 * HTB, NXCD = 8, WGM = 8;
__host__ __device__ __forceinline__ int lds_byte(int r, int c) { const int st = (r >> 4) * 2 + (c >> 5), rr = r & 15, cc = c & 31, ob = rr * 64 + cc * 2; return st * 1024 + (ob ^ (((ob >> 9) & 1) << 5)); }
__host__ __device__ __forceinline__ void stage_rc(int b, int& R, int& C) { const int st = b / 1024, sb = b % 1024, swz = sb ^ (((sb >> 9) & 1) << 5); R = (st >> 1) * 16 + swz / 64; C = (st & 1) * 32 + (swz % 64) / 2; }
__host__ __device__ __forceinline__ int perm32(int rho) { const int n = rho >> 4, i = rho & 15; return 8 * (i >> 2) + 4 * n + (i & 3); }
struct Unit { int pm, pn, e; };

struct DenseOrder {
    const char* A; const char* Bt; int K; int nM, nN, nwg, G, c;
    __device__ __forceinline__ void init(const void* A_, const void* Bt_, int M, int N, int K_, int G_, int c_) { A = (const char*)A_; Bt = (const char*)Bt_; K = K_; nM = M / BM; nN = N / BM; nwg = nM * nN; G = G_; c = c_; }
    __device__ __forceinline__ bool next(int i, Unit& u) const {
        const long L = (long)i * G + c; if (L >= nwg) return false;
        int wgid = (int)L; { const int q = nwg / NXCD, r = nwg % NXCD, xcd = wgid % NXCD, off = wgid / NXCD; wgid = (xcd < r ? xcd * (q + 1) : r * (q + 1) + (xcd - r) * q) + off; }
        const int nig = WGM * nN, gid = wgid / nig, fm = gid * WGM, gsz = (nM - fm) < WGM ? (nM - fm) : WGM;
        u.pm = fm + ((wgid % nig) % gsz); u.pn = (wgid % nig) / gsz; u.e = 0; return true;
    }
    __device__ __forceinline__ const char* abase(const Unit& u) const { return A + (size_t)u.pm * BM * K * 2; }
    __device__ __forceinline__ const char* bbase(const Unit& u) const { return Bt + (size_t)u.pn * BM * K * 2; }
};
struct MoeOrder {
    const char* A; const char* Wt; int K; int nN, nwg, G, c; size_t estride; const int* rbe;
    __device__ __forceinline__ bool next(int i, Unit& u) const {
        const long L = (long)i * G + c; if (L >= nwg) return false;
        u.pm = (int)(L / nN); u.pn = (int)(L % nN); u.e = rbe[u.pm]; return true;
    }
    __device__ __forceinline__ const char* abase(const Unit& u) const { return A + (size_t)u.pm * BM * K * 2; }
    __device__ __forceinline__ const char* bbase(const Unit& u) const { return Wt + (size_t)u.e * estride + (size_t)u.pn * BM * K * 2; }
};

struct EpiF32 {
    static constexpr bool PERM = false;
    float* C; int ldc;
    __device__ __forceinline__ void operator()(const f32x4 (&acc)[2][2][4][2], const Unit& u, int wr, int wc, int fr, int fq) const {
        const int row0 = u.pm * BM + wr * 64 + fr, col0 = u.pn * BM + wc * 32 + 4 * fq;
#pragma unroll
        for (int ai = 0; ai < 2; ++ai)
#pragma unroll
            for (int m = 0; m < 4; ++m) { float* rowp = C + (size_t)(row0 + ai * HALF + m * 16) * ldc + col0;
#pragma unroll
                for (int bj = 0; bj < 2; ++bj)
#pragma unroll
                    for (int n = 0; n < 2; ++n) *(f32x4*)(rowp + bj * HALF + n * 16) = acc[ai][bj][m][n]; }
    }
};
struct EpiBf16Bias {
    static constexpr bool PERM = true;
    bf16_t* O; int ldc; const float* bias; int bias_estride;
    __device__ __forceinline__ void operator()(const f32x4 (&acc)[2][2][4][2], const Unit& u, int wr, int wc, int fr, int fq) const {
        const int row0 = u.pm * BM + wr * 64 + fr, col0 = u.pn * BM + wc * 32 + 8 * fq;
        const float* bp = bias + (size_t)u.e * bias_estride + col0;
        f32x4 bv[2][2];
#pragma unroll
        for (int bj = 0; bj < 2; ++bj)
#pragma unroll
            for (int n = 0; n < 2; ++n) bv[bj][n] = *(const f32x4*)(bp + bj * HALF + 4 * n);
#pragma unroll
        for (int ai = 0; ai < 2; ++ai)
#pragma unroll
            for (int m = 0; m < 4; ++m) { bf16_t* rowp = O + (size_t)(row0 + ai * HALF + m * 16) * ldc + col0;
#pragma unroll
                for (int bj = 0; bj < 2; ++bj) { const f32x4 v0 = acc[ai][bj][m][0] + bv[bj][0], v1 = acc[ai][bj][m][1] + bv[bj][1];
                    u32x4 w; w.x = pk2(v0[0], v0[1]); w.y = pk2(v0[2], v0[3]); w.z = pk2(v1[0], v1[1]); w.w = pk2(v1[2], v1[3]);
                    *(u32x4*)(rowp + bj * HALF) = w; } }
    }
};
__device__ __forceinline__ float swiglu1(float g, float uu) { g = fminf(g, 7.0f); uu = fminf(fmaxf(uu, -7.0f), 7.0f); return (uu + 1.0f) * (g * frcp(1.0f + fexp(-1.702f * g))); }
struct EpiSwiglu {
    static constexpr bool PERM = true;
    bf16_t* O; const float* b1;
    __device__ __forceinline__ void operator()(const f32x4 (&acc)[2][2][4][2], const Unit& u, int wr, int wc, int fr, int fq) const {
        const int row0 = u.pm * BM + wr * 64 + fr, j0 = u.pn * HALF + wc * 32 + 8 * fq;
        const float* bg = b1 + (size_t)u.e * 2 * DFF + j0; const float* bu = bg + DFF;
        f32x4 g4[2], u4[2];
#pragma unroll
        for (int n = 0; n < 2; ++n) { g4[n] = *(const f32x4*)(bg + 4 * n); u4[n] = *(const f32x4*)(bu + 4 * n); }
#pragma unroll
        for (int ai = 0; ai < 2; ++ai)
#pragma unroll
            for (int m = 0; m < 4; ++m) {
                float o[8];
#pragma unroll
                for (int n = 0; n < 2; ++n)
#pragma unroll
                    for (int q = 0; q < 4; ++q) o[n * 4 + q] = swiglu1(acc[ai][0][m][n][q] + g4[n][q], acc[ai][1][m][n][q] + u4[n][q]);
                u32x4 w; w.x = pk2(o[0], o[1]); w.y = pk2(o[2], o[3]); w.z = pk2(o[4], o[5]); w.w = pk2(o[6], o[7]);
                *(u32x4*)(O + (size_t)(row0 + ai * HALF + m * 16) * DFF + j0) = w;
            }
    }
};

template <class Epi, class Sched>
__device__ __forceinline__ void gemm_phase(LAS unsigned char* lds, const int K, const Sched& S, const Epi& E, const int tid) {
    const int wid = RFL(tid >> 6), lane = tid & 63, wr = wid >> 2, wc = wid & 3, fr = lane & 15, fq = lane >> 4;
    const int nt = K / BK;
    unsigned voffA[2], voffB[2];
#pragma unroll
    for (int i = 0; i < 2; ++i) { int R, C; stage_rc(tid * 16 + i * 8192, R, C); const int Rb = Epi::PERM ? ((R & ~31) + perm32(R & 31)) : R;
        voffA[i] = (unsigned)(R * K + C) * 2u; voffB[i] = (unsigned)(Rb * K + C) * 2u; }
    const size_t kstep = (size_t)(BK * 2);
    const size_t hstep = (size_t)HALF * K * 2;
    const unsigned ldsw = (unsigned)wid * 1024u;
    const int aoff = lds_byte(wr * 64 + fr, fq * 8), boff = lds_byte(wc * 32 + fr, fq * 8);
#define PG8_SA(b, h) (((b) * 2 + (h)) * HTB)
#define PG8_SB(b, h) ((4 + (b) * 2 + (h)) * HTB)
#define PG8_STAGE(bufoff, gbase, voff) do { _Pragma("unroll") for (int _i = 0; _i < 2; ++_i) \
        GLDS16((const char*)(gbase) + (voff)[_i], lds + (bufoff) + ldsw + _i * 8192); } while (0)
#define PG8_LDA(dst, b, h) do { _Pragma("unroll") for (int m = 0; m < 4; ++m) _Pragma("unroll") for (int k = 0; k < 2; ++k) dst[m][k] = *(const LAS bf16x8*)(lds + PG8_SA(b, h) + aoff + m * 2048 + k * 1024); } while (0)
#define PG8_LDB(dst, b, h) do { _Pragma("unroll") for (int n = 0; n < 2; ++n) _Pragma("unroll") for (int k = 0; k < 2; ++k) dst[n][k] = *(const LAS bf16x8*)(lds + PG8_SB(b, h) + boff + n * 2048 + k * 1024); } while (0)
#define PG8_MMA(ai, bj, At, Bt) do { SETPRIO(1); _Pragma("unroll") for (int m = 0; m < 4; ++m) _Pragma("unroll") for (int n = 0; n < 2; ++n) _Pragma("unroll") for (int k = 0; k < 2; ++k) \
        acc[ai][bj][m][n] = MFMA16(Bt[n][k], At[m][k], acc[ai][bj][m][n]); SETPRIO(0); } while (0)
    Unit cur, nxt; int ui = 0;
    if (!S.next(0, cur)) return;
    f32x4 acc[2][2][4][2];
#pragma unroll
    for (int a = 0; a < 2; ++a)
#pragma unroll
        for (int b = 0; b < 2; ++b)
#pragma unroll
            for (int m = 0; m < 4; ++m)
#pragma unroll
                for (int n = 0; n < 2; ++n) acc[a][b][m][n] = (f32x4){0.f, 0.f, 0.f, 0.f};
    bf16x8 At[4][2], B0[2][2], B1[2][2];
    const char* cA = S.abase(cur); const char* cB = S.bbase(cur);
    PG8_STAGE(PG8_SB(0, 0), cB, voffB); PG8_STAGE(PG8_SA(0, 0), cA, voffA); PG8_STAGE(PG8_SB(0, 1), cB + hstep, voffB); PG8_STAGE(PG8_SA(0, 1), cA + hstep, voffA);
    if (wr == 1) S_BARRIER();
    WAIT_V(4); S_BARRIER();
    PG8_STAGE(PG8_SB(1, 0), cB + kstep, voffB); PG8_STAGE(PG8_SA(1, 0), cA + kstep, voffA); PG8_STAGE(PG8_SB(1, 1), cB + hstep + kstep, voffB);
    WAIT_V(6); S_BARRIER();
    for (;;) {
        const bool has_next = S.next(ui + 1, nxt);
        const char* nA = has_next ? S.abase(nxt) : cA; const char* nB = has_next ? S.bbase(nxt) : cB;
        for (int t = 0; t < nt; t += 2) {
            const bool last = (t == nt - 2);
            const char* a1 = cA + (size_t)(t + 1) * kstep;
            const char* a2 = last ? nA : cA + (size_t)(t + 2) * kstep; const char* b2 = last ? nB : cB + (size_t)(t + 2) * kstep;
            const char* a3 = a2 + kstep; const char* b3 = b2 + kstep;
            PG8_LDB(B0, 0, 0); SCHED_BAR(); PG8_LDA(At, 0, 0); PG8_STAGE(PG8_SA(1, 1), a1 + hstep, voffA);
            WAIT_L(8); S_BARRIER(); WAIT_L(0); PG8_MMA(0, 0, At, B0); S_BARRIER(); SCHED_BAR();
            PG8_LDB(B1, 0, 1); PG8_STAGE(PG8_SB(0, 0), b2, voffB);
            S_BARRIER(); WAIT_L(0); PG8_MMA(0, 1, At, B1); S_BARRIER();
            PG8_LDA(At, 0, 1); PG8_STAGE(PG8_SA(0, 0), a2, voffA);
            S_BARRIER(); WAIT_L(0); PG8_MMA(1, 0, At, B0); S_BARRIER(); SCHED_BAR();
            PG8_STAGE(PG8_SB(0, 1), b2 + hstep, voffB);
            WAIT_V(6); S_BARRIER(); PG8_MMA(1, 1, At, B1); S_BARRIER();
            PG8_LDB(B0, 1, 0); SCHED_BAR(); PG8_LDA(At, 1, 0); PG8_STAGE(PG8_SA(0, 1), a2 + hstep, voffA);
            WAIT_L(8); S_BARRIER(); WAIT_L(0); PG8_MMA(0, 0, At, B0); S_BARRIER(); SCHED_BAR();
            PG8_LDB(B1, 1, 1); PG8_STAGE(PG8_SB(1, 0), b3, voffB);
            S_BARRIER(); WAIT_L(0); PG8_MMA(0, 1, At, B1); S_BARRIER();
            PG8_LDA(At, 1, 1); PG8_STAGE(PG8_SA(1, 0), a3, voffA);
            S_BARRIER(); WAIT_L(0); PG8_MMA(1, 0, At, B0); S_BARRIER(); SCHED_BAR();
            PG8_STAGE(PG8_SB(1, 1), b3 + hstep, voffB);
            WAIT_V(6); S_BARRIER(); PG8_MMA(1, 1, At, B1); S_BARRIER();
        }
        E(acc, cur, wr, wc, fr, fq);
        if (!has_next) break;
#pragma unroll
        for (int a = 0; a < 2; ++a)
#pragma unroll
            for (int b = 0; b < 2; ++b)
#pragma unroll
                for (int m = 0; m < 4; ++m)
#pragma unroll
                    for (int n = 0; n < 2; ++n) acc[a][b][m][n] = (f32x4){0.f, 0.f, 0.f, 0.f};
        cur = nxt; cA = nA; cB = nB; ++ui;
    }
    WAIT_V(0);
    if (wr == 0) S_BARRIER();
    S_BARRIER();
#undef PG8_SA
#undef PG8_SB
#undef PG8_STAGE
#undef PG8_LDA
#undef PG8_LDB
#undef PG8_MMA
}
}

__device__ __forceinline__ float row16_sum(float x) {
#ifdef EMU
    x += __shfl_xor(x, 1); x += __shfl_xor(x, 2); x += __shfl_xor(x, 4); x += __shfl_xor(x, 8); return x;
#else
#define DPPF(v, ctrl) __builtin_bit_cast(float, __builtin_amdgcn_update_dpp(0, __builtin_bit_cast(int, (v)), (ctrl), 0xF, 0xF, false))
    x += DPPF(x, 0xB1); x += DPPF(x, 0x4E); x += DPPF(x, 0x141); x += DPPF(x, 0x140); return x;
#undef DPPF
#endif
}
__device__ __forceinline__ float row32_sum(float x) {
    x = row16_sum(x);
#ifdef EMU
    x += __shfl_xor(x, 32); return x;
#else
    float a = x, b = x;
    asm volatile("s_nop 1\n\tv_permlane32_swap_b32 %0, %1" : "+v"(a), "+v"(b));
    return a + b;
#endif
}
__device__ __forceinline__ float wave_sum_fast(float x, int lane) {
    x = row32_sum(x);
    x += SHX(x, 16, lane);
    return x;
}
__device__ __forceinline__ void transpose_item(const float* W, int K, int N, bf16_t* WT, int k0, int n0, int dst_row0, float* scr, int lane) {
    const int n4 = (lane & 15) * 4, kr = lane >> 4;
#pragma unroll 8
    for (int i = 0; i < 16; ++i) {
        const int kk = 4 * i + kr;
        f32x4 v = (f32x4){0.f, 0.f, 0.f, 0.f};
        if (n0 + n4 < N) v = *(const f32x4*)(W + (size_t)(k0 + kk) * N + n0 + n4);
        float* d = scr + kk * 65 + n4; d[0] = v.x; d[1] = v.y; d[2] = v.z; d[3] = v.w;
    }
    WAVE_SYNC();
    const int c = lane & 7;
#pragma unroll
    for (int j = 0; j < 8; ++j) { const int n = (lane >> 3) + 8 * j; const float* sp = scr + (8 * c) * 65 + n;
        u32x4 o; o.x = pk2(sp[0 * 65], sp[1 * 65]); o.y = pk2(sp[2 * 65], sp[3 * 65]); o.z = pk2(sp[4 * 65], sp[5 * 65]); o.w = pk2(sp[6 * 65], sp[7 * 65]);
        *(u32x4*)(WT + (size_t)(dst_row0 + n) * K + k0 + 8 * c) = o; }
    WAVE_SYNC();
}
__device__ __forceinline__ void phase_prologue(const Params& P, unsigned char* smem, int wv) {
    ParamsPtr pp = PARAMS_PTR(P); PIN_S(pp); unsigned char* ws = pp->ws; int bidx = (int)blockIdx.x, gdim = (int)gridDim.x; PIN_S(bidx); PIN_S(gdim);
    const int tid = phase_tid(wv), lane = tid & 63, wave = tid >> 6;
    float* scr = (float*)smem + wave * (64 * 65);
    const int gw = bidx * NWAVES + wave, ngw = NWAVES * gdim;
    constexpr int I_IN = 16 * (PLD / 64), I_OUT = 16 * 16, I_W1 = NE * 16 * 32, I_W2 = NE * 16 * 16, I_L = I_IN + I_OUT + I_W1 + I_W2;
    for (int it = gw; it < NL * I_L; it += ngw) {
        const int l = it / I_L; int r = it % I_L;
        if (r < I_IN) { const int kb = r / (PLD / 64), nb = r % (PLD / 64);
            transpose_item(pp->in[1] + (size_t)l * D * PIN, D, PIN, (bf16_t*)(ws + O_WIN) + (size_t)l * PLD * D, kb * 64, nb * 64, nb * 64, scr, lane); continue; }
        r -= I_IN;
        if (r < I_OUT) { const int kb = r / 16, nb = r % 16;
            transpose_item(pp->in[21] + (size_t)l * D * D, D, D, (bf16_t*)(ws + O_WOUT) + (size_t)l * D * D, kb * 64, nb * 64, nb * 64, scr, lane); continue; }
        r -= I_OUT;
        if (r < I_W1) { const int e = r / (16 * 32), q = r % (16 * 32), kb = q / 32, nb = q % 32, n0 = nb * 64;
            const int dst = n0 < DFF ? (n0 / 128) * 256 + (n0 % 128) : ((n0 - DFF) / 128) * 256 + 128 + ((n0 - DFF) % 128);
            transpose_item(pp->in[26] + ((size_t)l * NE + e) * D * 2 * DFF, D, 2 * DFF, (bf16_t*)(ws + O_W1) + ((size_t)l * NE + e) * 2 * DFF * D, kb * 64, n0, dst, scr, lane); continue; }
        r -= I_W1;
        { const int e = r / (16 * 16), q = r % (16 * 16), kb = q / 16, nb = q % 16;
            transpose_item(pp->in[28] + ((size_t)l * NE + e) * DFF * D, DFF, D, (bf16_t*)(ws + O_W2) + ((size_t)l * NE + e) * D * DFF, kb * 64, nb * 64, nb * 64, scr, lane); }
    }
    {
        const float* gw_ = pp->in[4]; bf16_t* WSB = (bf16_t*)(ws + O_WSB);
        for (size_t i = ((size_t)bidx * NTHREADS + tid) * 4; i < (size_t)NL * GH * CH * CH; i += (size_t)gdim * NTHREADS * 4) {
            const f32x4 v = *(const f32x4*)(gw_ + i); u32x2 o; o.x = pk2(v.x, v.y); o.y = pk2(v.z, v.w); *(u32x2*)(WSB + i) = o;
        }
    }
    {
        bf16_t* LWT = (bf16_t*)(ws + O_LWT);
        for (int i = bidx * NTHREADS + tid; i < NL * 1920 * 128; i += gdim * NTHREADS) {
            const int k = i & 127, n = (i >> 7) % 1920, ll = i / (1920 * 128);
            float v = 0.f;
            if (n < 1536) { if (k < 64) { const int grp = n / 768, d = (n / 384) & 1, c = n % 384; v = (grp == 0 ? pp->in[8] : pp->in[10])[(((size_t)ll * 2 + d) * 64 + k) * RW + c]; } }
            else v = pp->in[11][((size_t)ll * 128 + k) * RW + (n - 1536)];
            LWT[i] = (bf16_t)f2bf(v);
        }
    }
    const float* x = pp->in[0]; bf16_t* XB = (bf16_t*)(ws + O_XB);
    for (size_t i = ((size_t)bidx * NTHREADS + tid) * 4; i < (size_t)T * D; i += (size_t)gdim * NTHREADS * 4) {
        const f32x4 v = *(const f32x4*)(x + i); u32x2 o; o.x = pk2(v.x, v.y); o.y = pk2(v.z, v.w); *(u32x2*)(XB + i) = o;
    }
}

__device__ __forceinline__ float tshift(const float* P, int t, int s, int col, const float* mu0, const float* mu1, int rc) {
    const float cur = P[(size_t)t * PLD + col];
    const float prv = s > 0 ? P[(size_t)(t - 1) * PLD + col] : 0.f;
    const float nxt = s < S - 1 ? P[(size_t)(t + 1) * PLD + col] : 0.f;
    return cur + mu0[rc] * (prv - cur) + mu1[rc] * (nxt - cur);
}

__device__ __forceinline__ void phase_prep(const Params& P, int l, unsigned char* smem, int wv) {
    ParamsPtr pp = PARAMS_PTR(P); PIN_S(pp); unsigned char* ws = pp->ws; int bidx = (int)blockIdx.x, gdim = (int)gridDim.x; PIN_S(bidx); PIN_S(gdim);
    const float* proj = (const float*)(ws + O_PROJ);
    float* UG = (float*)(ws + O_UG); bf16_t* VNT = (bf16_t*)(ws + O_VNT);
    float* RR = (float*)(ws + O_RR); float* VV = (float*)(ws + O_VV); float* KK = (float*)(ws + O_KK);
    float* KD = (float*)(ws + O_KD); float* ICLR = (float*)(ws + O_ICLR);
    float* GATE = (float*)(ws + O_GATE); float* BONUS = (float*)(ws + O_BONUS); float* LWG = (float*)(ws + O_LW);
#if !MK_RWKV_CHUNKED
    float* DEC = (float*)(ws + O_DEC); float* BRKR = (float*)(ws + O_BRKR);
#endif
    bf16_t* MQB = (bf16_t*)(ws + O_MQB); bf16_t* MKB = (bf16_t*)(ws + O_MKB); bf16_t* KT = (bf16_t*)(ws + O_KT); bf16_t* VT = (bf16_t*)(ws + O_VT);
    float* IG = (float*)(ws + O_IG); float* LF = (float*)(ws + O_LF);
    const bf16_t* LWT = (const bf16_t*)(ws + O_LWT) + (size_t)l * 1920 * 128;
    const float* gln_g = pp->in[2] + (size_t)l * GW; const float* gln_b = pp->in[3] + (size_t)l * GW;
    const float* mu0 = pp->in[6] + (size_t)l * 2 * RPROJ; const float* mu1 = mu0 + RPROJ;
    const float* w0 = pp->in[7] + (size_t)l * 2 * RW; const float* a0 = pp->in[9] + (size_t)l * 2 * RW;
    const float* k_k = pp->in[12] + (size_t)l * RW; const float* k_a = pp->in[13] + (size_t)l * RW; const float* r_k = pp->in[14] + (size_t)l * RW;
    const float* conv_w = pp->in[17] + (size_t)l * 3 * 768; const float* conv_b = pp->in[18] + (size_t)l * 768; const float* gate_b = pp->in[19] + (size_t)l * 24;
    float* win = (float*)smem;
    bf16_t* lin = (bf16_t*)(smem + 101376);
    bf16_t* tvn = (bf16_t*)(smem + 110592);
    bf16_t* tk = (bf16_t*)(smem + 118784);
    bf16_t* tv = (bf16_t*)(smem + 131072);
    constexpr int LIN = 264;
    const int tid = phase_tid(wv), lane = tid & 63, wave = tid >> 6, col = lane & 15, g = lane >> 4;
    for (int u = bidx; u < T / 16; u += gdim) {
        const int t0 = u * 16, s0 = t0 % S, bb = t0 / S;
        __syncthreads();
        {
            f32x4 wb[18];
#pragma unroll
            for (int row = 0; row < 18; ++row) {
                const int sq = s0 - 1 + row;
                wb[row] = (f32x4){0.f, 0.f, 0.f, 0.f};
                if (sq >= 0 && sq < S && tid < 352) wb[row] = *(const f32x4*)(proj + (size_t)(t0 - 1 + row) * PLD + C_RW + tid * 4);
            }
            if (tid < 352) {
#pragma unroll
                for (int row = 0; row < 18; ++row) *(f32x4*)(win + row * RPROJ + tid * 4) = wb[row];
            }
        }
        for (int rep_ = 0; rep_ < (MK_PROBE == 3 ? 2 : 1); ++rep_) {
            const int i = tid >> 5, l32 = tid & 31, t = t0 + i;
            float v[8], ug[8]; float sum = 0.f;
#pragma unroll
            for (int j = 0; j < 8; ++j) { const int c = j * 32 + l32; ug[j] = proj[(size_t)t * PLD + c]; v[j] = proj[(size_t)t * PLD + GW + c]; }
#pragma unroll
            for (int j = 0; j < 8; ++j) { const int c = j * 32 + l32; UG[(size_t)t * GW + c] = geluf_(ug[j]); v[j] = geluf_(v[j]); sum += v[j]; }
#pragma unroll
            for (int o = 16; o >= 1; o >>= 1) sum += SHX(sum, o, lane);
            const float mean = sum * (1.0f / GW); float q = 0.f;
#pragma unroll
            for (int j = 0; j < 8; ++j) { const float d = v[j] - mean; q += d * d; }
#pragma unroll
            for (int o = 16; o >= 1; o >>= 1) q += SHX(q, o, lane);
            const float rstd = 1.0f / sqrtf(q * (1.0f / GW) + LN_EPS);
#pragma unroll
            for (int j = 0; j < 8; ++j) { const int c = j * 32 + l32; tvn[c * 16 + i] = (bf16_t)f2bf((v[j] - mean) * rstd * gln_g[c] + gln_b[c]); }
        }
        __syncthreads();
        {
            const int hf = tid & 1, c = tid >> 1;
            *(u32x4*)(VNT + ((size_t)bb * GW + c) * S + s0 + hf * 8) = *(const u32x4*)(tvn + c * 16 + hf * 8);
        }
        for (int idx = tid; idx < 16 * 256; idx += NTHREADS) {
            const int i = idx >> 8, j = idx & 255, rc = 1152 + j;
            const float pv = win[i * RPROJ + rc], cv = win[(i + 1) * RPROJ + rc], nv = win[(i + 2) * RPROJ + rc];
            const float x = cv + mu0[rc] * (pv - cv) + mu1[rc] * (nv - cv);
            lin[i * LIN + j] = (bf16_t)f2bf(j < 64 ? ftanh(x) : (j < 128 ? x : sigmoidf_(x)));
        }
        __syncthreads();
        for (int rep_ = 0; rep_ < (MK_PROBE == 1 ? 2 : 1); ++rep_) {
#pragma unroll 1
            for (int qg = 0; qg < 3; ++qg) {
                bf16x8 bw_[5][4]; float bias_[5];
#pragma unroll
                for (int q5 = 0; q5 < 5; ++q5) {
                    const int nt = wave * 15 + qg * 5 + q5, grp = nt / 24, c = (nt % 24) * 16 + col;
                    const bf16_t* bw = LWT + (size_t)(nt * 16 + col) * 128 + 8 * g;
#pragma unroll
                    for (int ks = 0; ks < 4; ++ks) bw_[q5][ks] = *(const bf16x8*)(bw + ks * 32);
                    bias_[q5] = grp < 2 ? w0[grp * RW + c] : (grp < 4 ? a0[(grp - 2) * RW + c] : 0.f);
                }
#pragma unroll
                for (int q5 = 0; q5 < 5; ++q5) {
                    const int nt = wave * 15 + qg * 5 + q5, grp = nt / 24, c = (nt % 24) * 16 + col;
                    const int kcol = grp < 2 ? 0 : (grp < 4 ? 64 : 128);
                    f32x4 acc = (f32x4){0.f, 0.f, 0.f, 0.f};
#pragma unroll
                    for (int ks = 0; ks < 2; ++ks) acc = MFMA16(*(const bf16x8*)(lin + col * LIN + kcol + ks * 32 + 8 * g), bw_[q5][ks], acc);
                    if (grp == 4) {
#pragma unroll
                        for (int ks = 2; ks < 4; ++ks) acc = MFMA16(*(const bf16x8*)(lin + col * LIN + kcol + ks * 32 + 8 * g), bw_[q5][ks], acc);
                    }
                    if (grp < 2) {
#pragma unroll
                        for (int r = 0; r < 4; ++r) { const float lw = -fexp(-softplusf_(-(acc[r] + bias_[q5])) - 0.5f); const size_t o = (size_t)grp * T * RW + (size_t)(t0 + 4 * g + r) * RW + c; LWG[o] = lw;
#if !MK_RWKV_CHUNKED
                            DEC[o] = expf(lw);
#endif
                        }
                    } else if (grp < 4) {
#pragma unroll
                        for (int r = 0; r < 4; ++r) ICLR[(size_t)(grp - 2) * T * RW + (size_t)(t0 + 4 * g + r) * RW + c] = sigmoidf_(acc[r] + bias_[q5]);
                    } else {
#pragma unroll
                        for (int r = 0; r < 4; ++r) GATE[(size_t)(t0 + 4 * g + r) * RW + c] = acc[r];
                    }
                }
            }
        }
        __syncthreads();
        for (int rep_ = 0; rep_ < (MK_PROBE == 2 ? 2 : 1); ++rep_) if (wave < 6) {
            const int c = tid, h = wave;
            const float kkc = k_k[c], kac = k_a[c], rkc = r_k[c];
            const float m0r = mu0[c], m1r = mu1[c], m0k = mu0[RW + c], m1k = mu1[RW + c], m0v = mu0[2 * RW + c], m1v = mu1[2 * RW + c];
            float ic0[16], ic1[16];
#pragma unroll
            for (int i = 0; i < 16; ++i) { const size_t o = (size_t)(t0 + i) * RW + c; ic0[i] = ICLR[o]; ic1[i] = ICLR[(size_t)T * RW + o]; }
#pragma unroll
            for (int i = 0; i < 16; ++i) {
                const int t = t0 + i;
                const float* w_ = win + i * RPROJ + c;
                const float rp = w_[0], rc_ = w_[RPROJ], rn = w_[2 * RPROJ];
                const float kp = w_[RW], kc_ = w_[RPROJ + RW], kn = w_[2 * RPROJ + RW];
                const float vp = w_[2 * RW], vc_ = w_[RPROJ + 2 * RW], vn = w_[2 * RPROJ + 2 * RW];
                const float r = rc_ + m0r * (rp - rc_) + m1r * (rn - rc_);
                const float k = kc_ + m0k * (kp - kc_) + m1k * (kn - kc_);
                const float v = vc_ + m0v * (vp - vc_) + m1v * (vn - vc_);
                const size_t o = (size_t)t * RW + c;
                const float kq = k * kkc;
                const float n2 = wave_sum_fast(kq * kq, lane);
                const float kk = kq / fmaxf(sqrtf(n2), 1e-12f);
                const float kd0 = k * (1.0f + (ic0[i] - 1.0f) * kac), kd1 = k * (1.0f + (ic1[i] - 1.0f) * kac);
                const float bon = wave_sum_fast(r * (kd0 + kd1) * rkc, lane);
                RR[o] = r; VV[o] = v; KK[o] = kk;
                KD[o] = kd0; KD[(size_t)T * RW + o] = kd1;
                if (lane == 0) BONUS[(size_t)t * RH + h] = bon;
#if !MK_RWKV_CHUNKED
                { const float br0 = wave_sum(kk * ic0[i] * r, lane), br1 = wave_sum(kk * ic1[i] * r, lane), kr0 = wave_sum(kd0 * r, lane), kr1 = wave_sum(kd1 * r, lane);
                  if (lane == 0) { BRKR[((size_t)t * RH + h) * 2] = br0; BRKR[((size_t)t * RH + h) * 2 + 1] = kr0; BRKR[((size_t)(T + t) * RH + h) * 2] = br1; BRKR[((size_t)(T + t) * RH + h) * 2 + 1] = kr1; } }
#endif
            }
        }
        __syncthreads();
        {
            f32x4 wb[9], vb[3];
            const int rsel = tid >= 192 ? 1 : 0, c4 = tid - rsel * 192;
#pragma unroll
            for (int it = 0; it < 9; ++it) {
                const int row = 2 * it + rsel, sq = s0 - 1 + row;
                wb[it] = (f32x4){0.f, 0.f, 0.f, 0.f};
                if (tid < 384 && sq >= 0 && sq < S) wb[it] = *(const f32x4*)(proj + (size_t)(t0 - 1 + row) * PLD + C_MW + c4 * 4);
            }
#pragma unroll
            for (int it = 0; it < 3; ++it) { const int idx = tid + it * NTHREADS, i = idx / 96, cc = (idx % 96) * 4; vb[it] = *(const f32x4*)(proj + (size_t)(t0 + i) * PLD + C_MW + 2 * MW + cc); }
            if (tid < 384) {
#pragma unroll
                for (int it = 0; it < 9; ++it) *(f32x4*)(win + (2 * it + rsel) * 768 + c4 * 4) = wb[it];
            }
#pragma unroll
            for (int it = 0; it < 3; ++it) { const int idx = tid + it * NTHREADS, i = idx / 96, cc = (idx % 96) * 4; const f32x4 v = vb[it];
                tv[(cc + 0) * 16 + i] = (bf16_t)f2bf(v.x); tv[(cc + 1) * 16 + i] = (bf16_t)f2bf(v.y); tv[(cc + 2) * 16 + i] = (bf16_t)f2bf(v.z); tv[(cc + 3) * 16 + i] = (bf16_t)f2bf(v.w); }
        }
        for (int idx = tid; idx < 16 * 24; idx += NTHREADS) {
            const int i = idx / 24, gi = idx % 24, t = t0 + i;
            const int isf = gi / 12, dir = (gi / 6) & 1, h = gi % 6;
            const float gg = proj[(size_t)t * PLD + 3456 + gi] + gate_b[gi];
            if (isf) LF[((size_t)dir * T + t) * MH + h] = -softplusf_(-gg); else IG[((size_t)dir * T + t) * MH + h] = gg;
        }
        __syncthreads();
        for (int rep_ = 0; rep_ < (MK_PROBE == 4 ? 2 : 1); ++rep_)
        for (int idx = tid; idx < 16 * 768; idx += NTHREADS) {
            const int i = idx / 768, c = idx % 768, t = t0 + i;
            const float* w_ = win + i * 768 + c;
            float y = conv_b[c] + w_[0] * conv_w[c] + w_[768] * conv_w[768 + c] + w_[1536] * conv_w[2 * 768 + c];
            y = y * sigmoidf_(y);
            if (c < MW) MQB[(size_t)t * MW + c] = (bf16_t)f2bf(y);
            else { const bf16_t kb = (bf16_t)f2bf(y * 0.125f); MKB[(size_t)t * MW + (c - MW)] = kb; tk[(c - MW) * 16 + i] = kb; }
        }
        __syncthreads();
        for (int idx = tid; idx < 2 * MW * 2; idx += NTHREADS) {
            const int hf = idx & 1, c = (idx >> 1) % MW, which = idx / (2 * MW);
            const u32x4 val = *(const u32x4*)((which ? tv : tk) + c * 16 + hf * 8);
            bf16_t* dst = (which ? VT : KT) + ((size_t)(bb * MH) * 64 + c) * S + s0 + hf * 8;
            *(u32x4*)dst = val;
        }
    }
    __syncthreads();
}

__device__ __forceinline__ void phase_gmlp_mix(const Params& P, int l, unsigned char* smem, int wv, int bid, int nb) {
    PIN_S(bid); PIN_S(nb);
    ParamsPtr pp = PARAMS_PTR(P); PIN_S(pp); unsigned char* ws = pp->ws;
    const float* UG = (const float*)(ws + O_UG); const bf16_t* VNT = (const bf16_t*)(ws + O_VNT); bf16_t* GRP = (bf16_t*)(ws + O_GRP);
    const bf16_t* WSB = (const bf16_t*)(ws + O_WSB) + (size_t)l * GH * CH * CH; const float* gbs = pp->in[5] + (size_t)l * GH * CH;
    const int tid = phase_tid(wv), lane = tid & 63, wave = tid >> 6, col = lane & 15, g = lane >> 4;
    for (int u = bid; u < NB * NCH * GH; u += nb) {
        const int h = u % GH, c = (u / GH) % NCH, b = u / (GH * NCH);
        const int tok0 = b * S + c * CH;
        const bf16_t* wb = WSB + (size_t)h * CH * CH + (size_t)(wave * 16 + col) * CH + 8 * g;
        const bf16_t* vb = VNT + ((size_t)b * GW + h * 64 + col) * S + (size_t)c * CH + 8 * g;
        f32x4 acc[4];
#pragma unroll
        for (int et = 0; et < 4; ++et) acc[et] = (f32x4){0.f, 0.f, 0.f, 0.f};
#pragma unroll
        for (int ks = 0; ks < 4; ++ks) {
            const bf16x8 af = *(const bf16x8*)(wb + ks * 32);
#pragma unroll
            for (int et = 0; et < 4; ++et) acc[et] = MFMA16(af, *(const bf16x8*)(vb + (size_t)et * 16 * S + ks * 32), acc[et]);
        }
#pragma unroll
        for (int r = 0; r < 4; ++r) {
            const int p = wave * 16 + 4 * g + r; const size_t t = (size_t)(tok0 + p); const float bsv = gbs[h * CH + p];
#pragma unroll
            for (int et = 0; et < 4; ++et) { const int ch = h * 64 + et * 16 + col; GRP[t * D + ch] = (bf16_t)f2bf(UG[t * GW + ch] * (acc[et][r] + bsv)); }
        }
    }
}

constexpr int SC_STEPS = 16;
constexpr int SC_BUF = SC_STEPS * 6 * 64;
__device__ __forceinline__ void phase_rwkv_scan(const Params& P, int l, unsigned char* smem, int wv, int bid, int nb) {
    PIN_S(bid); PIN_S(nb);
    ParamsPtr pp = PARAMS_PTR(P); PIN_S(pp); unsigned char* ws = pp->ws;
    const float* RR = (const float*)(ws + O_RR); const float* VV = (const float*)(ws + O_VV); const float* KK = (const float*)(ws + O_KK);
    const float* DEC = (const float*)(ws + O_DEC); const float* KD = (const float*)(ws + O_KD); const float* ICLR = (const float*)(ws + O_ICLR);
    float* SCAN = (float*)(ws + O_SCAN); const float* BRKR = (const float*)(ws + O_BRKR);
    const int tid = phase_tid(wv), lane = tid & 63, wave = tid >> 6, rl = (lane >> 4) & 1, kq = (lane & 15) | ((lane >> 5) << 4);
    float* buf = (float*)smem;
    float* scal = buf + 2 * SC_BUF;
    float* outb = scal + 2 * SC_STEPS * 2;
    typedef float f32x2 __attribute__((ext_vector_type(2)));
    for (int u = bid; u < 2 * NB * RH * 4; u += nb) {
        const int qt = u & 3, h = (u >> 2) % RH, b = (u / (4 * RH)) % NB, d = u / (4 * RH * NB);
        const size_t doff = (size_t)d * T * RW;
        float s0 = 0.f, s1 = 0.f;
        float pw[2], pa[2], pb[2], pk[2], pr[2], pv[2], psc = 0.f;
#define SC_LOAD(c) do { _Pragma("unroll") for (int i = 0; i < 2; ++i) { const int idx = tid + NTHREADS * i, st = idx >> 6, k = idx & 63; const int tau = (c) * SC_STEPS + st, sq = d ? S - 1 - tau : tau; \
            const size_t o = (size_t)(b * S + sq) * RW + h * 64 + k; \
            pw[i] = DEC[doff + o]; pa[i] = KK[o]; pb[i] = ICLR[doff + o]; pk[i] = KD[doff + o]; pr[i] = RR[o]; pv[i] = VV[o]; }     \
            if (tid < 2 * SC_STEPS) { const int tau = (c) * SC_STEPS + (tid >> 1), sq = d ? S - 1 - tau : tau; psc = BRKR[((size_t)(d * T + b * S + sq) * RH + h) * 2 + (tid & 1)]; } } while (0)
#define SC_WRITE(c) do { float* B_ = buf + ((c) & 1) * SC_BUF; _Pragma("unroll") for (int i = 0; i < 2; ++i) { const int idx = tid + NTHREADS * i, st = idx >> 6, k = idx & 63; \
            float* q_ = B_ + st * 384 + k; q_[0] = pw[i]; q_[64] = -pa[i]; q_[128] = pa[i] * pb[i]; q_[192] = pk[i]; q_[256] = pw[i] * pr[i]; q_[320] = pv[i]; } \
            if (tid < 2 * SC_STEPS) scal[((c) & 1) * SC_STEPS * 2 + tid] = psc; } while (0)
        __syncthreads();
        SC_LOAD(0); SC_WRITE(0);
        __syncthreads();
        const int row = qt * 16 + wave * 2 + rl;
        for (int c = 0; c < S / SC_STEPS; ++c) {
            const bool more = (c + 1) < S / SC_STEPS;
            if (more) SC_LOAD(c + 1);
            const float* B = buf + (c & 1) * SC_BUF; const float* sc = scal + (c & 1) * SC_STEPS * 2; float* ob = outb + (c & 1) * SC_STEPS * 16;
            float outs[SC_STEPS];
            f32x2 w2 = *(const f32x2*)(B + 2 * kq), a2 = *(const f32x2*)(B + 64 + 2 * kq), b2 = *(const f32x2*)(B + 128 + 2 * kq);
            f32x2 k2 = *(const f32x2*)(B + 192 + 2 * kq), wr2 = *(const f32x2*)(B + 256 + 2 * kq);
            float v = B[320 + row]; float br = sc[0], kr = sc[1];
#pragma unroll
            for (int st = 0; st < SC_STEPS; ++st) {
                const int sn = st + 1 < SC_STEPS ? st + 1 : st;
                const float* q = B + sn * 384;
                const f32x2 nw2 = *(const f32x2*)(q + 2 * kq), na2 = *(const f32x2*)(q + 64 + 2 * kq), nb2 = *(const f32x2*)(q + 128 + 2 * kq);
                const f32x2 nk2 = *(const f32x2*)(q + 192 + 2 * kq), nwr2 = *(const f32x2*)(q + 256 + 2 * kq);
                const float nv = q[320 + row], nbr = sc[sn * 2], nkr = sc[sn * 2 + 1];
                SCHED_BAR();
                float sa = s0 * a2.x + s1 * a2.y;
                float po = s0 * wr2.x + s1 * wr2.y;
                sa = row32_sum(sa); po = row32_sum(po);
                outs[st] = po + sa * br + v * kr;
                s0 = s0 * w2.x + (sa * b2.x + v * k2.x); s1 = s1 * w2.y + (sa * b2.y + v * k2.y);
                SCHED_BAR();
                w2 = nw2; a2 = na2; b2 = nb2; k2 = nk2; wr2 = nwr2; v = nv; br = nbr; kr = nkr;
            }
            if (kq == 0) {
#pragma unroll
                for (int st = 0; st < SC_STEPS; ++st) ob[st * 16 + wave * 2 + rl] = outs[st];
            }
            if (more) SC_WRITE(c + 1);
            __syncthreads();
            if (tid < 16 * SC_STEPS) {
                const int st = tid >> 4, r = tid & 15, tau = c * SC_STEPS + st, sq = d ? S - 1 - tau : tau;
                SCAN[doff + (size_t)(b * S + sq) * RW + h * 64 + qt * 16 + r] = ob[st * 16 + r];
            }
        }
#undef SC_LOAD
#undef SC_WRITE
    }
    __syncthreads();
}

constexpr int RST = 72;
constexpr int RARR = 64 * RST;
__device__ __forceinline__ f32x4 tile_nt(const bf16_t* Aa, int ta, const bf16_t* Ba, int tb, f32x4 acc, int col, int g) {
#pragma unroll
    for (int ks = 0; ks < 2; ++ks) {
        const bf16x8 af = *(const bf16x8*)(Aa + (ta * 16 + col) * RST + ks * 32 + 8 * g);
        const bf16x8 bfr = *(const bf16x8*)(Ba + (tb * 16 + col) * RST + ks * 32 + 8 * g);
        acc = MFMA16(af, bfr, acc);
    }
    return acc;
}
__device__ __forceinline__ void phase_rwkv_pre(const Params& P, int l, unsigned char* smem, int wv) {
    ParamsPtr pp = PARAMS_PTR(P); PIN_S(pp); unsigned char* ws = pp->ws; int bidx = (int)blockIdx.x, gdim = (int)gridDim.x; PIN_S(bidx); PIN_S(gdim);
    const float* RR = (const float*)(ws + O_RR); const float* VV = (const float*)(ws + O_VV); const float* KK = (const float*)(ws + O_KK);
    const float* LWG = (const float*)(ws + O_LW); const float* KD = (const float*)(ws + O_KD); const float* ICLR = (const float*)(ws + O_ICLR);
    bf16_t* Qg = (bf16_t*)(ws + O_RQ); bf16_t* Ag = (bf16_t*)(ws + O_RA); float* Hg = (float*)(ws + O_RH); float* Gg = (float*)(ws + O_RG);
    const int tid0 = phase_tid(wv);
#define RW_STAGE_VARS int tid = tid0; PIN_V(tid); const int lane = tid & 63, wave = tid >> 6, col = lane & 15, g = lane >> 4; (void)lane; (void)wave; (void)col; (void)g;
    bf16_t* At = (bf16_t*)smem; bf16_t* Bt = At + RARR; bf16_t* Kt = Bt + RARR; bf16_t* Rt = Kt + RARR;
    bf16_t* BtT = Rt + RARR; bf16_t* KtT = BtT + RARR; bf16_t* VT = KtT + RARR;
    bf16_t* Lak = VT + RARR; bf16_t* Mrb = Lak + RARR; bf16_t* Mrk = Mrb + RARR; bf16_t* YT = Mrk + RARR; bf16_t* W2T = YT + RARR;
    float* LabT = (float*)(W2T + RARR);
    float* ZsB = LabT + 4096;
    float* segs = ZsB + 8192;
    float* PC = segs + 512;
    for (int u = bidx; u < RUN; u += gdim) {
        const int c = u % RNC, h = (u / RNC) % RH, b = (u / (RNC * RH)) % NB, d = u / (RNC * RH * NB);
        const size_t doff = (size_t)d * T * RW;
        __syncthreads();
        {
            RW_STAGE_VARS
            const int ch = tid & 63, sg = tid >> 6;
            float lw[8], kk[8], ic[8], kd[8], rr[8], vv[8];
#pragma unroll
            for (int j = 0; j < 8; ++j) {
                const int tau = c * RC + sg * 8 + j, sq = d ? S - 1 - tau : tau; const size_t o = (size_t)(b * S + sq) * RW + h * 64 + ch;
                lw[j] = LWG[doff + o]; kk[j] = KK[o]; ic[j] = ICLR[doff + o]; kd[j] = KD[doff + o]; rr[j] = RR[o]; vv[j] = VV[o];
            }
            float run = 0.f;
#pragma unroll
            for (int j = 0; j < 8; ++j) { run += lw[j]; lw[j] = run; }
            segs[sg * 64 + ch] = run;
            __syncthreads();
            float off = 0.f;
            for (int q = 0; q < sg; ++q) off += segs[q * 64 + ch];
            u32x4 pbt, pkt, pvt; unsigned tb[8], tk[8], tvv[8];
            float prev = off;
#pragma unroll
            for (int j = 0; j < 8; ++j) {
                const int t = sg * 8 + j; const float cl = off + lw[j];
                const float ep = fexp(prev), en = fexp(-cl), epc = fexp(cl);
                const unsigned a_ = f2bf(-kk[j] * ep), b_ = f2bf(kk[j] * ic[j] * en), k_ = f2bf(kd[j] * en), r_ = f2bf(rr[j] * epc), v_ = f2bf(vv[j]);
                At[t * RST + ch] = (bf16_t)a_; Bt[t * RST + ch] = (bf16_t)b_; Kt[t * RST + ch] = (bf16_t)k_; Rt[t * RST + ch] = (bf16_t)r_;
                tb[j] = b_; tk[j] = k_; tvv[j] = v_;
                prev = cl;
            }
            if (sg == 7) PC[ch] = fexp(prev);
            pbt.x = tb[0] | (tb[1] << 16); pbt.y = tb[2] | (tb[3] << 16); pbt.z = tb[4] | (tb[5] << 16); pbt.w = tb[6] | (tb[7] << 16);
            pkt.x = tk[0] | (tk[1] << 16); pkt.y = tk[2] | (tk[3] << 16); pkt.z = tk[4] | (tk[5] << 16); pkt.w = tk[6] | (tk[7] << 16);
            pvt.x = tvv[0] | (tvv[1] << 16); pvt.y = tvv[2] | (tvv[3] << 16); pvt.z = tvv[4] | (tvv[5] << 16); pvt.w = tvv[6] | (tvv[7] << 16);
            *(u32x4*)(BtT + ch * RST + sg * 8) = pbt; *(u32x4*)(KtT + ch * RST + sg * 8) = pkt; *(u32x4*)(VT + ch * RST + sg * 8) = pvt;
        }
        __syncthreads();
        {
            RW_STAGE_VARS
            const int m = wave >> 1;
            const bf16_t* Ym = (m == 0 || m == 2) ? Bt : Kt; const bf16_t* Xm = (m < 2) ? At : Rt;
#pragma unroll 1
            for (int q = 0; q < 8; ++q) {
                const int tix = (wave & 1) * 8 + q, it = tix >> 2, tt = tix & 3;
                f32x4 acc = (f32x4){0.f, 0.f, 0.f, 0.f};
                if (it <= tt) acc = tile_nt(Ym, it, Xm, tt, acc, col, g);
                const int t = tt * 16 + col, i0 = it * 16 + 4 * g;
                float o4[4];
#pragma unroll
                for (int r = 0; r < 4; ++r) { const int i = i0 + r; const bool ok = m < 2 ? (i < t) : (i <= t); o4[r] = ok ? acc[r] : 0.f; }
                if (m == 0) {
#pragma unroll
                    for (int r = 0; r < 4; ++r) LabT[(i0 + r) * 64 + t] = o4[r];
                }
                else { bf16_t* dst = (m == 1 ? Lak : (m == 2 ? Mrb : Mrk)) + t * RST + i0; u32x2 w2; w2.x = pk2(o4[0], o4[1]); w2.y = pk2(o4[2], o4[3]); *(u32x2*)dst = w2; }
            }
        }
        __syncthreads();
        {
            RW_STAGE_VARS
#pragma unroll
            for (int q = 0; q < 2; ++q) {
                const int tix = wave * 2 + q, tt = tix >> 2, et = tix & 3;
                f32x4 acc = (f32x4){0.f, 0.f, 0.f, 0.f};
                acc = tile_nt(Lak, tt, VT, et, acc, col, g);
#pragma unroll
                for (int r = 0; r < 4; ++r) ZsB[4096 + (tt * 16 + 4 * g + r) * 64 + et * 16 + col] = acc[r];
            }
#pragma unroll
            for (int q = 0; q < 8; ++q) { const int idx = tid + NTHREADS * q; ZsB[idx] = bf_lo((unsigned)At[(idx >> 6) * RST + (idx & 63)]); }
        }
        __syncthreads();
        {
            RW_STAGE_VARS
            if (wave < 2) {
                float* Zs = ZsB + wave * 4096 + lane;
                bf16_t* dst = (wave == 0 ? YT : W2T) + lane * RST;
#pragma unroll 1
                for (int bb = 0; bb < 4; ++bb) {
                    float acc[16];
#pragma unroll
                    for (int r = 0; r < 16; ++r) acc[r] = Zs[(16 * bb + r) * 64];
#pragma unroll 2
                    for (int i = 0; i < 16 * bb; ++i) {
                        const float z = Zs[i * 64];
                        const float* lp = LabT + i * 64 + 16 * bb;
                        const f32x4 l0 = *(const f32x4*)lp, l1 = *(const f32x4*)(lp + 4), l2 = *(const f32x4*)(lp + 8), l3 = *(const f32x4*)(lp + 12);
                        acc[0] += l0.x * z; acc[1] += l0.y * z; acc[2] += l0.z * z; acc[3] += l0.w * z;
                        acc[4] += l1.x * z; acc[5] += l1.y * z; acc[6] += l1.z * z; acc[7] += l1.w * z;
                        acc[8] += l2.x * z; acc[9] += l2.y * z; acc[10] += l2.z * z; acc[11] += l2.w * z;
                        acc[12] += l3.x * z; acc[13] += l3.y * z; acc[14] += l3.z * z; acc[15] += l3.w * z;
                    }
                    const float* dp = LabT + (16 * bb) * 64 + 16 * bb;
#pragma unroll
                    for (int r = 1; r < 16; ++r)
#pragma unroll
                        for (int r2 = 0; r2 < r; ++r2) acc[r] += dp[r2 * 64 + r] * acc[r2];
#pragma unroll
                    for (int r = 0; r < 16; ++r) Zs[(16 * bb + r) * 64] = acc[r];
                    u32x4 w0, w1;
                    w0.x = pk2(acc[0], acc[1]); w0.y = pk2(acc[2], acc[3]); w0.z = pk2(acc[4], acc[5]); w0.w = pk2(acc[6], acc[7]);
                    w1.x = pk2(acc[8], acc[9]); w1.y = pk2(acc[10], acc[11]); w1.z = pk2(acc[12], acc[13]); w1.w = pk2(acc[14], acc[15]);
                    *(u32x4*)(dst + 16 * bb) = w0; *(u32x4*)(dst + 16 * bb + 8) = w1;
                }
            }
        }
        __syncthreads();
        {
            RW_STAGE_VARS
            const int ty = wave >> 1;
#pragma unroll 1
            for (int q = 0; q < 8; ++q) {
                const int tix = (wave & 1) * 8 + q, ra = tix >> 2, cb = tix & 3;
                f32x4 acc = (f32x4){0.f, 0.f, 0.f, 0.f};
                if (ty == 0) {
                    acc = tile_nt(Mrb, ra, YT, cb, acc, col, g);
#pragma unroll
                    for (int r = 0; r < 4; ++r) { const int t = ra * 16 + 4 * g + r, k = cb * 16 + col; Qg[(size_t)u * 4096 + t * 64 + k] = (bf16_t)f2bf(acc[r] + bf_lo((unsigned)Rt[t * RST + k])); }
                } else if (ty == 1) {
                    acc = tile_nt(Mrb, ra, W2T, cb, acc, col, g); acc = tile_nt(Mrk, ra, VT, cb, acc, col, g);
                    *(f32x4*)(Hg + (size_t)u * 4096 + (tix * 64 + lane) * 4) = acc;
                } else if (ty == 2) {
                    acc = tile_nt(BtT, ra, YT, cb, acc, col, g);
#pragma unroll
                    for (int r = 0; r < 4; ++r) { const int k1 = ra * 16 + 4 * g + r, k = cb * 16 + col; Ag[(size_t)u * 4096 + k1 * 64 + k] = (bf16_t)f2bf(PC[k1] * (acc[r] + (k1 == k ? 1.0f : 0.f))); }
                } else {
                    acc = tile_nt(BtT, ra, W2T, cb, acc, col, g); acc = tile_nt(KtT, ra, VT, cb, acc, col, g);
#pragma unroll
                    for (int r = 0; r < 4; ++r) acc[r] *= PC[ra * 16 + 4 * g + r];
                    *(f32x4*)(Gg + (size_t)u * 4096 + (tix * 64 + lane) * 4) = acc;
                }
            }
        }
    }
    __syncthreads();
#undef RW_STAGE_VARS
}
__device__ __forceinline__ void phase_rwkv_seq(const Params& P, int l, unsigned char* smem, int wv) {
    ParamsPtr pp = PARAMS_PTR(P); PIN_S(pp); unsigned char* ws = pp->ws; int bidx = (int)blockIdx.x, gdim = (int)gridDim.x; PIN_S(bidx); PIN_S(gdim);
    const bf16_t* Ag = (const bf16_t*)(ws + O_RA); const float* Gg = (const float*)(ws + O_RG); bf16_t* Sg = (bf16_t*)(ws + O_RS);
    const int tid = phase_tid(wv), lane = tid & 63, wave = tid >> 6, col = lane & 15, g = lane >> 4;
    const int gw = wave * gdim + bidx, ngw = NWAVES * gdim;
    for (int un = gw; un < 2 * NB * RH * 2; un += ngw) {
        const int ch = un >> 1, eh = un & 1;
        f32x4 acc[4][2];
#pragma unroll
        for (int a_ = 0; a_ < 4; ++a_)
#pragma unroll
            for (int b_ = 0; b_ < 2; ++b_) acc[a_][b_] = (f32x4){0.f, 0.f, 0.f, 0.f};
        u32x2 alo[4][2], ahi[4][2]; f32x4 gq[4][2];
        const unsigned aoff = (unsigned)(col * 64 + 4 * g), goff = (unsigned)(lane * 4);
#define RS_LOAD(cc) do { const bf16_t* ab_ = Ag + (size_t)(ch * RNC + (cc)) * 4096; const float* gb_ = Gg + (size_t)(ch * RNC + (cc)) * 4096 + eh * 512; \
            _Pragma("unroll") for (int ra = 0; ra < 4; ++ra) _Pragma("unroll") for (int p = 0; p < 2; ++p) { alo[ra][p] = *(const u32x2*)(ab_ + (ra * 1024 + p * 32) + aoff); ahi[ra][p] = *(const u32x2*)(ab_ + (ra * 1024 + p * 32 + 16) + aoff); } \
            _Pragma("unroll") for (int ra = 0; ra < 4; ++ra) _Pragma("unroll") for (int cb = 0; cb < 2; ++cb) gq[ra][cb] = *(const f32x4*)(gb_ + ((ra * 4 + cb) * 256) + goff); } while (0)
        RS_LOAD(0);
#pragma unroll 1
        for (int c = 0; c < RNC; ++c) {
            bf16_t* sb_ = Sg + (size_t)(ch * RNC + c) * 4096 + eh * 2048;
            bf16x8 bq[2][2];
#pragma unroll
            for (int cb = 0; cb < 2; ++cb) {
#pragma unroll
                for (int ra = 0; ra < 4; ++ra) {
                    u32x2 w2; w2.x = pk2(acc[ra][cb][0], acc[ra][cb][1]); w2.y = pk2(acc[ra][cb][2], acc[ra][cb][3]);
                    *(u32x2*)(sb_ + (cb * 1024 + ra * 16) + aoff) = w2;
                }
#pragma unroll
                for (int p = 0; p < 2; ++p) bq[p][cb] = cvt8(acc[2 * p][cb], acc[2 * p + 1][cb]);
            }
            u32x4 af[4][2];
#pragma unroll
            for (int ra = 0; ra < 4; ++ra) {
#pragma unroll
                for (int p = 0; p < 2; ++p) af[ra][p] = (u32x4){alo[ra][p].x, alo[ra][p].y, ahi[ra][p].x, ahi[ra][p].y};
#pragma unroll
                for (int cb = 0; cb < 2; ++cb) acc[ra][cb] = gq[ra][cb];
            }
            if (c + 1 < RNC) RS_LOAD(c + 1);
#pragma unroll
            for (int ra = 0; ra < 4; ++ra)
#pragma unroll
                for (int cb = 0; cb < 2; ++cb)
#pragma unroll
                    for (int p = 0; p < 2; ++p) acc[ra][cb] = MFMA16(__builtin_bit_cast(bf16x8, af[ra][p]), bq[p][cb], acc[ra][cb]);
        }
#undef RS_LOAD
    }
}
__device__ __forceinline__ void phase_rwkv_out(const Params& P, int l, unsigned char* smem, int wv) {
    ParamsPtr pp = PARAMS_PTR(P); PIN_S(pp); unsigned char* ws = pp->ws; int bidx = (int)blockIdx.x, gdim = (int)gridDim.x; PIN_S(bidx); PIN_S(gdim);
    const bf16_t* Qg = (const bf16_t*)(ws + O_RQ); const bf16_t* Sg = (const bf16_t*)(ws + O_RS); const float* Hg = (const float*)(ws + O_RH);
    const float* VV = (const float*)(ws + O_VV); const float* GATE = (const float*)(ws + O_GATE); const float* BONUS = (const float*)(ws + O_BONUS);
    bf16_t* GRP = (bf16_t*)(ws + O_GRP);
    const float* rln_g = pp->in[15] + (size_t)l * RW; const float* rln_b = pp->in[16] + (size_t)l * RW;
    const int tid = phase_tid(wv), lane = tid & 63, wave = tid >> 6, col = lane & 15, g = lane >> 4;
    for (int pu = bidx * NWAVES + wave; pu < NB * RH * RNC; pu += gdim * NWAVES) {
        const int c = pu % RNC, h = (pu / RNC) % RH, b = pu / (RNC * RH);
        f32x4 o[2][4][4];
#pragma unroll
        for (int d = 0; d < 2; ++d) {
            const int u = ((d * NB + b) * RH + h) * RNC + (d ? RNC - 1 - c : c);
            const size_t ub = (size_t)u * 4096;
            bf16x8 qa[4][2], sb[4][2];
#pragma unroll
            for (int q = 0; q < 4; ++q)
#pragma unroll
                for (int ks = 0; ks < 2; ++ks) { qa[q][ks] = *(const bf16x8*)(Qg + ub + (q * 16 + col) * 64 + ks * 32 + 8 * g); sb[q][ks] = *(const bf16x8*)(Sg + ub + (q * 16 + col) * 64 + ks * 32 + 8 * g); }
#pragma unroll
            for (int tt = 0; tt < 4; ++tt)
#pragma unroll
                for (int et = 0; et < 4; ++et) {
                    f32x4 acc = *(const f32x4*)(Hg + ub + ((tt * 4 + et) * 64 + lane) * 4);
#pragma unroll
                    for (int ks = 0; ks < 2; ++ks) acc = MFMA16(qa[tt][ks], sb[et][ks], acc);
                    o[d][tt][et] = acc;
                }
        }
        const int src = (3 - g) * 16 + col;
#pragma unroll
        for (int tt = 0; tt < 4; ++tt)
#pragma unroll
            for (int et = 0; et < 4; ++et)
#pragma unroll
                for (int r = 0; r < 4; ++r) o[0][tt][et][r] += SHL(o[1][3 - tt][et][3 - r], src);
#pragma unroll
        for (int tt = 0; tt < 4; ++tt)
#pragma unroll
            for (int r = 0; r < 4; ++r) {
                float sm = (o[0][tt][0][r] + o[0][tt][1][r]) + (o[0][tt][2][r] + o[0][tt][3][r]);
                sm = row16_sum(sm);
                const float mean = sm * (1.0f / 64.0f);
                float q = 0.f;
#pragma unroll
                for (int et = 0; et < 4; ++et) { const float dl = o[0][tt][et][r] - mean; q += dl * dl; }
                q = row16_sum(q);
                const float rstd = 1.0f / sqrtf(q * (1.0f / 64.0f) + GN_EPS);
                const size_t t = (size_t)(b * S + c * RC + tt * 16 + 4 * g + r);
                const float bon = BONUS[t * RH + h];
#pragma unroll
                for (int et = 0; et < 4; ++et) {
                    const int ch = h * 64 + et * 16 + col;
                    float y = (o[0][tt][et][r] - mean) * rstd * rln_g[ch] + rln_b[ch];
                    y += bon * VV[t * RW + ch];
                    GRP[t * D + GW + ch] = (bf16_t)f2bf(y * GATE[t * RW + ch]);
                }
            }
    }
}

__device__ __forceinline__ void phase_mlstm_local(const Params& P, int l, unsigned char* smem, int wv, int bid, int nb) {
    PIN_S(bid); PIN_S(nb);
    ParamsPtr pp = PARAMS_PTR(P); PIN_S(pp); unsigned char* ws = pp->ws;
    const bf16_t* KT = (const bf16_t*)(ws + O_KT); const bf16_t* VT = (const bf16_t*)(ws + O_VT);
    const float* IG = (const float*)(ws + O_IG); const float* LF = (const float*)(ws + O_LF);
    float* CL = (float*)(ws + O_CL); float* NLb = (float*)(ws + O_NL); float* ML = (float*)(ws + O_ML); float* BL = (float*)(ws + O_BL);
    float* GVT = (float*)(ws + O_GVT); float* PMX = (float*)(ws + O_PMX); float* BCT = (float*)(ws + O_BCT);
    const int tid = phase_tid(wv), lane = tid & 63, wave = tid >> 6, col = lane & 15, g = lane >> 4;
    float* wts = (float*)smem + wave * 128;
    for (int u = bid * NWAVES + wave; u < 2 * NB * MH * NCH; u += nb * NWAVES) {
        const int c = u % NCH, h = (u / NCH) % MH, p = u / (NCH * MH), d = p / NB, b = p % NB;
        const int tc = d ? NCH - 1 - c : c, tok0 = b * S + tc * CH;
        const int i0 = d ? 127 - 2 * lane : 2 * lane, i1 = d ? i0 - 1 : i0 + 1;
        const size_t g0 = ((size_t)d * T + tok0 + i0) * MH + h, g1 = ((size_t)d * T + tok0 + i1) * MH + h;
        const float lf0 = LF[g0], lf1 = LF[g1], ig0 = IG[g0], ig1 = IG[g1];
        const float c1 = lf0 + lf1;
        float incl = c1;
#pragma unroll
        for (int o = 1; o < 64; o <<= 1) { const float tq = SHUP(incl, o, lane); if (lane >= o) incl += tq; }
        const float excl = incl - c1, bc0 = excl + lf0, bc1 = incl;
        const float blast = RDL(incl, 63);
        const float gv0 = ig0 - bc0, gv1 = ig1 - bc1, pl1 = fmaxf(gv0, gv1);
        float mincl = pl1;
#pragma unroll
        for (int o = 1; o < 64; o <<= 1) { const float tq = SHUP(mincl, o, lane); if (lane >= o) mincl = fmaxf(mincl, tq); }
        float mexcl = SHUP(mincl, 1, lane); if (lane == 0) mexcl = -INFINITY;
        const float pm0 = fmaxf(mexcl, gv0), pm1 = mincl;
        const float mloc = blast + RDL(mincl, 63);
        WAVE_SYNC();
        wts[i0] = fexp(blast + gv0 - mloc); wts[i1] = fexp(blast + gv1 - mloc);
        GVT[g0] = gv0; GVT[g1] = gv1; PMX[g0] = pm0; PMX[g1] = pm1; BCT[g0] = bc0; BCT[g1] = bc1;
        if (lane == 0) { ML[u] = mloc; BL[u] = blast; }
        WAVE_SYNC();
        const bf16_t* vbase = VT + ((size_t)(b * MH + h) * 64) * S + (size_t)tc * CH;
        const bf16_t* kbase = KT + ((size_t)(b * MH + h) * 64) * S + (size_t)tc * CH;
        const unsigned loff = (unsigned)(col * S + 8 * g);
        f32x4 acc[4][4];
#pragma unroll
        for (int a_ = 0; a_ < 4; ++a_)
#pragma unroll
            for (int b_ = 0; b_ < 4; ++b_) acc[a_][b_] = (f32x4){0.f, 0.f, 0.f, 0.f};
        float nsum[4] = {0.f, 0.f, 0.f, 0.f};
#pragma unroll 1
        for (int ks = 0; ks < 4; ++ks) {
            const int ii = ks * 32 + 8 * g;
            const f32x4 w0 = *(const f32x4*)(wts + ii), w1 = *(const f32x4*)(wts + ii + 4);
            bf16x8 af[4], bfk[4];
#pragma unroll
            for (int q = 0; q < 4; ++q) af[q] = *(const bf16x8*)(vbase + ((size_t)q * 16 * S + ks * 32) + loff);
#pragma unroll
            for (int q = 0; q < 4; ++q) {
                const u32x4 kr = *(const u32x4*)(kbase + ((size_t)q * 16 * S + ks * 32) + loff);
                f32x4 k0, k1;
                k0.x = bf_lo(kr.x) * w0.x; k0.y = bf_hi(kr.x) * w0.y; k0.z = bf_lo(kr.y) * w0.z; k0.w = bf_hi(kr.y) * w0.w;
                k1.x = bf_lo(kr.z) * w1.x; k1.y = bf_hi(kr.z) * w1.y; k1.z = bf_lo(kr.w) * w1.z; k1.w = bf_hi(kr.w) * w1.w;
                nsum[q] += (k0.x + k0.y) + (k0.z + k0.w) + (k1.x + k1.y) + (k1.z + k1.w);
                bfk[q] = cvt8(k0, k1);
            }
#pragma unroll
            for (int a_ = 0; a_ < 4; ++a_)
#pragma unroll
                for (int b_ = 0; b_ < 4; ++b_) acc[a_][b_] = MFMA16(af[a_], bfk[b_], acc[a_][b_]);
        }
        float* cbase = CL + (size_t)u * 4096;
        const unsigned coff = (unsigned)(4 * g * 64 + col);
#pragma unroll
        for (int b_ = 0; b_ < 4; ++b_) {
#pragma unroll
            for (int a_ = 0; a_ < 4; ++a_)
#pragma unroll
                for (int r = 0; r < 4; ++r) cbase[(a_ * 16 * 64 + r * 64 + b_ * 16) + coff] = acc[a_][b_][r];
            float ns = nsum[b_]; ns += SHX(ns, 16, lane); ns += SHX(ns, 32, lane);
            if (g == 0) NLb[(size_t)u * 64 + b_ * 16 + col] = ns;
        }
    }
    __syncthreads();
}

__device__ __forceinline__ void phase_mlstm_carry(const Params& P, int l, unsigned char* smem, int wv) {
    ParamsPtr pp = PARAMS_PTR(P); PIN_S(pp); unsigned char* ws = pp->ws; int bidx = (int)blockIdx.x, gdim = (int)gridDim.x; PIN_S(bidx); PIN_S(gdim);
    float* CL = (float*)(ws + O_CL); float* NLb = (float*)(ws + O_NL); const float* ML = (const float*)(ws + O_ML); const float* BL = (const float*)(ws + O_BL);
    float* MIN = (float*)(ws + O_MIN);
    const int total = 2 * NB * MH * 4160;
    const int tid = phase_tid(wv);
    for (int g = bidx * NTHREADS + tid; g < total; g += gdim * NTHREADS) {
        const int ph = g / 4160, e = g % 4160;
        float m = 0.f, val = 0.f;
        for (int c = 0; c < NCH; ++c) {
            const int base = ph * NCH + c;
            float* ptr = e < 4096 ? CL + (size_t)base * 4096 + e : NLb + (size_t)base * 64 + (e - 4096);
            const float loc = *ptr;
            *ptr = val;
            if (e == 0) MIN[base] = m;
            const float bl = BL[base], ml = ML[base];
            const float mn = fmaxf(bl + m, ml);
            val = expf(bl + m - mn) * val + expf(ml - mn) * loc;
            m = mn;
        }
    }
}

__device__ __forceinline__ void phase_mlstm_out(const Params& P, int l, unsigned char* smem, int wv) {
    ParamsPtr pp = PARAMS_PTR(P); PIN_S(pp); unsigned char* ws = pp->ws; int bidx = (int)blockIdx.x, gdim = (int)gridDim.x; PIN_S(bidx); PIN_S(gdim);
    const float* proj = (const float*)(ws + O_PROJ);
    const bf16_t* MQB = (const bf16_t*)(ws + O_MQB); const bf16_t* MKB = (const bf16_t*)(ws + O_MKB); const bf16_t* VT = (const bf16_t*)(ws + O_VT);
    const float* GVT = (const float*)(ws + O_GVT); const float* PMX = (const float*)(ws + O_PMX); const float* BCT = (const float*)(ws + O_BCT);
    const float* CL = (const float*)(ws + O_CL); const float* NLb = (const float*)(ws + O_NL); const float* MIN = (const float*)(ws + O_MIN);
    bf16_t* GRP = (bf16_t*)(ws + O_GRP);
    const float* mln_g = pp->in[20] + (size_t)l * MW;
    const int tid = phase_tid(wv), lane = tid & 63, wave = tid >> 6, col = lane & 15, g = lane >> 4;
    for (int u = bidx; u < NB * MH * NCH; u += gdim) {
        const int tc = u % NCH, h = (u / NCH) % MH, b = u / (NCH * MH);
        const int tok0 = b * S + tc * CH, it = wave * 16 + col;
        const size_t trow = (size_t)(tok0 + it);
        bf16x8 bq[2];
#pragma unroll
        for (int ks = 0; ks < 2; ++ks) bq[ks] = *(const bf16x8*)(MQB + trow * MW + h * 64 + ks * 32 + 8 * g);
        const size_t vrow = ((size_t)(b * MH + h) * 64) * S + (size_t)tc * CH;
        f32x4 hs[4];
#pragma unroll
        for (int et = 0; et < 4; ++et) hs[et] = (f32x4){0.f, 0.f, 0.f, 0.f};
#pragma unroll
        for (int d = 0; d < 2; ++d) {
            const int cd = d ? NCH - 1 - tc : tc;
            const int su = ((d * NB + b) * MH + h) * NCH + cd;
            const size_t gt = ((size_t)d * T + trow) * MH + h;
            const float mst = MIN[su];
            const float mxt = fmaxf(PMX[gt], mst), mt = BCT[gt] + mxt, wint = fexp(mst - mxt);
            f32x4 num[4];
#pragma unroll
            for (int et = 0; et < 4; ++et) num[et] = (f32x4){0.f, 0.f, 0.f, 0.f};
            float den = 0.f;
            for (int sp = 0; sp < 4; ++sp) {
                if (d == 0 ? (2 * sp > wave) : (2 * sp + 1 < wave)) continue;
                float pw[8];
#pragma unroll
                for (int hf = 0; hf < 2; ++hf) {
                    const int st = 2 * sp + hf;
                    f32x4 sacc = (f32x4){0.f, 0.f, 0.f, 0.f};
#pragma unroll
                    for (int ks = 0; ks < 2; ++ks) {
                        const bf16x8 kf = *(const bf16x8*)(MKB + (size_t)(tok0 + st * 16 + col) * MW + h * 64 + ks * 32 + 8 * g);
                        sacc = MFMA16(kf, bq[ks], sacc);
                    }
#pragma unroll
                    for (int r = 0; r < 4; ++r) {
                        const int is = st * 16 + 4 * g + r;
                        const bool ok = d == 0 ? (is <= it) : (is >= it);
                        const float gvs = GVT[((size_t)d * T + tok0 + is) * MH + h];
                        const float pr = ok ? sacc[r] * fexp(gvs - mxt) : 0.f;
                        den += pr; pw[hf * 4 + r] = pr;
                    }
                }
                u32x4 pb; pb.x = pk2(pw[0], pw[1]); pb.y = pk2(pw[2], pw[3]); pb.z = pk2(pw[4], pw[5]); pb.w = pk2(pw[6], pw[7]);
                const bf16x8 bp = __builtin_bit_cast(bf16x8, pb);
#pragma unroll
                for (int et = 0; et < 4; ++et) {
                    const bf16_t* vp = VT + vrow + (size_t)(et * 16 + col) * S + sp * 32 + 4 * g;
                    const u32x2 v0 = *(const u32x2*)vp, v1 = *(const u32x2*)(vp + 16);
                    u32x4 va; va.x = v0.x; va.y = v0.y; va.z = v1.x; va.w = v1.y;
                    num[et] = MFMA16(__builtin_bit_cast(bf16x8, va), bp, num[et]);
                }
            }
            den += SHX(den, 16, lane); den += SHX(den, 32, lane);
            f32x4 qc[4]; float qn = 0.f;
#pragma unroll
            for (int ks = 0; ks < 2; ++ks) {
                const float* np = NLb + (size_t)su * 64 + ks * 32 + 8 * g;
                const f32x4 n0 = *(const f32x4*)np, n1 = *(const f32x4*)(np + 4);
                const u32x4 qb = __builtin_bit_cast(u32x4, bq[ks]);
                qn += (bf_lo(qb.x) * n0.x + bf_hi(qb.x) * n0.y) + (bf_lo(qb.y) * n0.z + bf_hi(qb.y) * n0.w) + (bf_lo(qb.z) * n1.x + bf_hi(qb.z) * n1.y) + (bf_lo(qb.w) * n1.z + bf_hi(qb.w) * n1.w);
            }
            qn += SHX(qn, 16, lane); qn += SHX(qn, 32, lane);
#pragma unroll
            for (int et = 0; et < 4; ++et) {
                qc[et] = (f32x4){0.f, 0.f, 0.f, 0.f};
#pragma unroll
                for (int ks = 0; ks < 2; ++ks) {
                    const float* cp = CL + (size_t)su * 4096 + (size_t)(et * 16 + col) * 64 + ks * 32 + 8 * g;
                    qc[et] = MFMA16(cvt8(*(const f32x4*)cp, *(const f32x4*)(cp + 4)), bq[ks], qc[et]);
                }
            }
            const float dd = frcp(fmaxf(fabsf(den + wint * qn), fexp(-mt)));
#pragma unroll
            for (int et = 0; et < 4; ++et) hs[et] += (num[et] + wint * qc[et]) * dd;
        }
        float sm = 0.f;
#pragma unroll
        for (int et = 0; et < 4; ++et) sm += (hs[et].x + hs[et].y) + (hs[et].z + hs[et].w);
        sm += SHX(sm, 16, lane); sm += SHX(sm, 32, lane);
        const float mean = sm * (1.0f / 64.0f); float q = 0.f;
#pragma unroll
        for (int et = 0; et < 4; ++et) { const f32x4 dl = hs[et] - mean; q += (dl.x * dl.x + dl.y * dl.y) + (dl.z * dl.z + dl.w * dl.w); }
        q += SHX(q, 16, lane); q += SHX(q, 32, lane);
        const float rstd = 1.0f / sqrtf(q * (1.0f / 64.0f) + LN_EPS);
#pragma unroll
        for (int et = 0; et < 4; ++et) {
            const int c = h * 64 + et * 16 + 4 * g;
            const f32x4 o4 = *(const f32x4*)(proj + trow * PLD + C_MW + 3 * MW + c), g4 = *(const f32x4*)(mln_g + c);
            const f32x4 y = (hs[et] - mean) * rstd * g4;
            u32x2 ob; ob.x = pk2(sigmoidf_(o4.x) * y.x, sigmoidf_(o4.y) * y.y); ob.y = pk2(sigmoidf_(o4.z) * y.z, sigmoidf_(o4.w) * y.w);
            *(u32x2*)(GRP + trow * D + GW + RW + c) = ob;
        }
    }
}

__device__ __forceinline__ void phase_rwkv_post(const Params& P, int l, unsigned char* smem, int wv) {
    ParamsPtr pp = PARAMS_PTR(P); PIN_S(pp); unsigned char* ws = pp->ws; int bidx = (int)blockIdx.x, gdim = (int)gridDim.x; PIN_S(bidx); PIN_S(gdim);
    const float* SCAN = (const float*)(ws + O_SCAN); const float* VV = (const float*)(ws + O_VV); const float* GATE = (const float*)(ws + O_GATE);
    const float* BONUS = (const float*)(ws + O_BONUS); bf16_t* GRP = (bf16_t*)(ws + O_GRP);
    const float* rln_g = pp->in[15] + (size_t)l * RW; const float* rln_b = pp->in[16] + (size_t)l * RW;
    const int tid = phase_tid(wv), lane = tid & 63, wave = tid >> 6;
    const int gw = bidx * NWAVES + wave, ngw = NWAVES * gdim;
    for (int it = gw; it < T * RH; it += ngw) {
        const int t = it / RH, h = it % RH, c = h * 64 + lane;
        const size_t o = (size_t)t * RW + c;
        const float x = SCAN[o] + SCAN[(size_t)T * RW + o];
        const float mean = wave_sum(x, lane) * (1.0f / 64.0f);
        const float dl = x - mean;
        const float var = wave_sum(dl * dl, lane) * (1.0f / 64.0f);
        float y = dl / sqrtf(var + GN_EPS) * rln_g[c] + rln_b[c];
        y += BONUS[(size_t)t * RH + h] * VV[o];
        GRP[(size_t)t * D + GW + c] = (bf16_t)f2bf(y * GATE[o]);
    }
}

__device__ __forceinline__ void phase_ln1_router(const Params& P, int l, unsigned char* smem, int wv) {
    ParamsPtr pp = PARAMS_PTR(P); PIN_S(pp); unsigned char* ws = pp->ws; int bidx = (int)blockIdx.x, gdim = (int)gridDim.x; PIN_S(bidx); PIN_S(gdim);
    const float* xin = l == 0 ? pp->in[0] : (const float*)(ws + O_XA);
    const float* MIX = (const float*)(ws + O_MIX); float* X1 = (float*)(ws + O_X1);
    int* TOPI = (int*)(ws + O_TOPI); float* TOPG = (float*)(ws + O_TOPG); int* RANK = (int*)(ws + O_RANK); bf16_t* X1B = (bf16_t*)(ws + O_X1B);
    int* BCNT = (int*)(ws + O_BCNT);
    const float* g1 = pp->in[22] + (size_t)l * D; const float* b1 = pp->in[23] + (size_t)l * D;
    const float* rw = pp->in[24] + (size_t)l * D * NE; const float* rb = pp->in[25] + (size_t)l * NE;
    const int tid = phase_tid(wv), lane = tid & 63, wave = tid >> 6;
    float* Wl = (float*)smem;
    float* lgs = (float*)(smem + 131072);
    int* stopi = (int*)(smem + 131072 + 8192);
    __syncthreads();
    {
        f32x4 wb[16];
#pragma unroll
        for (int it = 0; it < 16; ++it) wb[it] = ((const f32x4*)rw)[tid + it * NTHREADS];
#pragma unroll
        for (int it = 0; it < 16; ++it) ((f32x4*)Wl)[tid + it * NTHREADS] = wb[it];
    }
    for (int tile = bidx; tile < T / 64; tile += gdim) {
        __syncthreads();
        for (int ti8 = 0; ti8 < 8; ++ti8) {
            const int t = tile * 64 + wave * 8 + ti8;
            float v[16]; float sm = 0.f;
#pragma unroll
            for (int j = 0; j < 4; ++j) {
                const int c = j * 256 + lane * 4;
                const f32x4 a = *(const f32x4*)(xin + (size_t)t * D + c), m = *(const f32x4*)(MIX + (size_t)t * D + c);
                v[j * 4 + 0] = ALPHA * a.x + m.x; v[j * 4 + 1] = ALPHA * a.y + m.y; v[j * 4 + 2] = ALPHA * a.z + m.z; v[j * 4 + 3] = ALPHA * a.w + m.w;
                sm += (v[j * 4] + v[j * 4 + 1]) + (v[j * 4 + 2] + v[j * 4 + 3]);
            }
            const float mean = wave_sum(sm, lane) * (1.0f / D); float q = 0.f;
#pragma unroll
            for (int j = 0; j < 16; ++j) { const float dl = v[j] - mean; q += dl * dl; }
            const float rstd = 1.0f / sqrtf(wave_sum(q, lane) * (1.0f / D) + LN_EPS);
#pragma unroll
            for (int j = 0; j < 4; ++j) {
                const int c = j * 256 + lane * 4;
                const f32x4 gg = *(const f32x4*)(g1 + c), bb = *(const f32x4*)(b1 + c);
                f32x4 o;
                o.x = (v[j * 4 + 0] - mean) * rstd * gg.x + bb.x; o.y = (v[j * 4 + 1] - mean) * rstd * gg.y + bb.y;
                o.z = (v[j * 4 + 2] - mean) * rstd * gg.z + bb.z; o.w = (v[j * 4 + 3] - mean) * rstd * gg.w + bb.w;
                *(f32x4*)(X1 + (size_t)t * D + c) = o;
                u32x2 ob; ob.x = pk2(o.x, o.y); ob.y = pk2(o.z, o.w); *(u32x2*)(X1B + (size_t)t * D + c) = ob;
            }
        }
        __syncthreads();
        {
            const int tq = tid >> 3, eg = (tid & 7) * 4;
            const float* xr = X1 + (size_t)(tile * 64 + tq) * D;
            f32x4 acc = *(const f32x4*)(rb + eg);
#pragma unroll 4
            for (int c = 0; c < D; c += 4) {
                const f32x4 x4 = *(const f32x4*)(xr + c);
                acc += x4.x * *(const f32x4*)(Wl + (c + 0) * NE + eg); acc += x4.y * *(const f32x4*)(Wl + (c + 1) * NE + eg);
                acc += x4.z * *(const f32x4*)(Wl + (c + 2) * NE + eg); acc += x4.w * *(const f32x4*)(Wl + (c + 3) * NE + eg);
            }
            *(f32x4*)(lgs + tq * NE + eg) = acc;
        }
        __syncthreads();
        if (tid < 64) {
            const float* lp = lgs + tid * NE; const int t = tile * 64 + tid;
            float tv[4]; int ti[4];
#pragma unroll
            for (int k = 0; k < 4; ++k) { tv[k] = -INFINITY; ti[k] = 0; }
            for (int e = 0; e < NE; ++e) {
                const float x = lp[e];
                if (x > tv[3]) {
                    if (x > tv[0]) { tv[3] = tv[2]; ti[3] = ti[2]; tv[2] = tv[1]; ti[2] = ti[1]; tv[1] = tv[0]; ti[1] = ti[0]; tv[0] = x; ti[0] = e; }
                    else if (x > tv[1]) { tv[3] = tv[2]; ti[3] = ti[2]; tv[2] = tv[1]; ti[2] = ti[1]; tv[1] = x; ti[1] = e; }
                    else if (x > tv[2]) { tv[3] = tv[2]; ti[3] = ti[2]; tv[2] = x; ti[2] = e; }
                    else { tv[3] = x; ti[3] = e; }
                }
            }
            const float e1 = expf(tv[1] - tv[0]), e2 = expf(tv[2] - tv[0]), e3 = expf(tv[3] - tv[0]);
            const float inv = 1.0f / (1.0f + e1 + e2 + e3);
            *(f32x4*)(TOPG + (size_t)t * 4) = (f32x4){inv, e1 * inv, e2 * inv, e3 * inv};
#pragma unroll
            for (int k = 0; k < 4; ++k) { TOPI[(size_t)t * 4 + k] = ti[k]; stopi[tid * 4 + k] = ti[k]; }
        }
        __syncthreads();
        if (tid < 256) { const int e = stopi[tid]; int r = 0; for (int a2 = 0; a2 < tid; ++a2) r += (stopi[a2] == e) ? 1 : 0; RANK[(size_t)tile * 256 + tid] = r; }
        else if (tid < 256 + NE) { const int e = tid - 256; int cnt = 0; for (int a2 = 0; a2 < 256; ++a2) cnt += (stopi[a2] == e) ? 1 : 0; BCNT[tile * NE + e] = cnt; }
    }
    __syncthreads();
}

__device__ __forceinline__ void moe_offsets(int* sh, const int* CNT, int tid) {
    if (tid == 0) {
        int acc = 0;
        for (int e = 0; e < NE; ++e) { const int c = (int)CNT[e]; sh[e] = c; sh[32 + e] = acc; acc += (c + MOEB - 1) / MOEB * MOEB; sh[64 + e] = acc; }
    }
    __syncthreads();
}
__device__ __forceinline__ int moe_expert_of_row(const int* sh, int r) {
    int e = -1;
    for (int i = 0; i < NE; ++i) if (r >= sh[32 + i] && r < sh[64 + i]) e = i;
    return e;
}

__device__ __forceinline__ void phase_scatter(const Params& P, int l, unsigned char* smem, int wv) {
    ParamsPtr pp = PARAMS_PTR(P); PIN_S(pp); unsigned char* ws = pp->ws; int bidx = (int)blockIdx.x, gdim = (int)gridDim.x; PIN_S(bidx); PIN_S(gdim);
    const int tid = phase_tid(wv), lane = tid & 63, wave = tid >> 6;
    const int* TOPI = (const int*)(ws + O_TOPI); const int* RANK = (const int*)(ws + O_RANK); int* SLOT = (int*)(ws + O_SLOT);
    const int* BCNT = (const int*)(ws + O_BCNT); int* CNTF = (int*)(ws + O_CNTF);
    const bf16_t* X1B = (const bf16_t*)(ws + O_X1B); bf16_t* XS = (bf16_t*)(ws + O_XS);
    int* sh = (int*)smem;
    int* part = sh + 96;
    int* tot = part + 512;
    int* base = tot + 32;
    constexpr int NT = T / 64;
    const int e = tid & 31, pt = tid >> 5;
    { int sacc = 0; for (int tl = pt; tl < NT; tl += 16) sacc += BCNT[tl * NE + e]; part[pt * 32 + e] = sacc; }
    __syncthreads();
    if (tid < 32) { int sacc = 0; for (int q = 0; q < 16; ++q) sacc += part[q * 32 + tid]; tot[tid] = sacc; if (bidx == 0) CNTF[tid] = sacc; }
    __syncthreads();
    moe_offsets(sh, tot, tid);
    for (int tile = bidx; tile < NT; tile += gdim) {
        __syncthreads();
        { int sacc = 0; for (int tl = pt; tl < tile; tl += 16) sacc += BCNT[tl * NE + e]; part[pt * 32 + e] = sacc; }
        __syncthreads();
        if (tid < 32) { int sacc = sh[32 + tid]; for (int q = 0; q < 16; ++q) sacc += part[q * 32 + tid]; base[tid] = sacc; }
        __syncthreads();
        for (int al = wave; al < 256; al += NWAVES) {
            const int a = tile * 256 + al, dest = base[TOPI[a]] + RANK[a], t = a >> 2;
            if (lane == 0) SLOT[a] = dest;
            const u32x4* src = (const u32x4*)(X1B + (size_t)t * D); u32x4* dst = (u32x4*)(XS + (size_t)dest * D);
            dst[lane] = src[lane]; dst[64 + lane] = src[64 + lane];
        }
    }
    __syncthreads();
}

template <int WHICH>
__device__ __forceinline__ void phase_moe_gemm(const Params& P, int l, unsigned char* smem, int wv) {
    ParamsPtr pp = PARAMS_PTR(P); PIN_S(pp); unsigned char* ws = pp->ws; int bidx = (int)blockIdx.x, gdim = (int)gridDim.x; PIN_S(bidx); PIN_S(gdim);
    const int tid = phase_tid(wv);
    const int* CNT = (const int*)(ws + O_CNTF);
    int* sh = (int*)(smem + 131072);
    int* rbe = sh + 96;
    moe_offsets(sh, CNT, tid);
    const int nrb = sh[64 + NE - 1] / MOEB;
    for (int rb = tid; rb < nrb; rb += NTHREADS) rbe[rb] = moe_expert_of_row(sh, rb * MOEB);
    __syncthreads();
    pg8::MoeOrder S;
    S.K = 1024; S.G = gdim; S.c = bidx; S.rbe = rbe;
    if (WHICH == 1) {
        S.A = (const char*)(ws + O_XS); S.Wt = (const char*)(ws + O_W1) + (size_t)l * NE * 2 * DFF * D * 2; S.estride = (size_t)2 * DFF * D * 2; S.nN = 2 * DFF / 256; S.nwg = nrb * S.nN;
        pg8::EpiSwiglu E{(bf16_t*)(ws + O_ACT), pp->in[27] + (size_t)l * NE * 2 * DFF};
        pg8::gemm_phase<pg8::EpiSwiglu, pg8::MoeOrder>((LAS unsigned char*)smem, 1024, S, E, tid);
    } else {
        S.A = (const char*)(ws + O_ACT); S.Wt = (const char*)(ws + O_W2) + (size_t)l * NE * D * DFF * 2; S.estride = (size_t)D * DFF * 2; S.nN = D / 256; S.nwg = nrb * S.nN;
        pg8::EpiBf16Bias E{(bf16_t*)(ws + O_YS), D, pp->in[29] + (size_t)l * NE * D, D};
        pg8::gemm_phase<pg8::EpiBf16Bias, pg8::MoeOrder>((LAS unsigned char*)smem, 1024, S, E, tid);
    }
    __syncthreads();
}

__device__ __forceinline__ void phase_combine_ln2(const Params& P, int l, unsigned char* smem, int wv) {
    ParamsPtr pp = PARAMS_PTR(P); PIN_S(pp); unsigned char* ws = pp->ws; int bidx = (int)blockIdx.x, gdim = (int)gridDim.x; PIN_S(bidx); PIN_S(gdim);
    const float* X1 = (const float*)(ws + O_X1); const bf16_t* YS = (const bf16_t*)(ws + O_YS); bf16_t* XB = (bf16_t*)(ws + O_XB);
    const int* SLOT = (const int*)(ws + O_SLOT); const float* TOPG = (const float*)(ws + O_TOPG);
    float* xo = l == NL - 1 ? pp->out : (float*)(ws + O_XA);
    const float* g2 = pp->in[30] + (size_t)l * D; const float* b2 = pp->in[31] + (size_t)l * D;
    const int tid = phase_tid(wv), lane = tid & 63, wave = tid >> 6;
    const int gw = bidx * NWAVES + wave, ngw = NWAVES * gdim;
    for (int t = gw; t < T; t += ngw) {
        int sl[4]; float gg[4];
#pragma unroll
        for (int k = 0; k < 4; ++k) { sl[k] = SLOT[(size_t)t * 4 + k]; gg[k] = TOPG[(size_t)t * 4 + k]; }
        float v[16]; float sm = 0.f;
#pragma unroll
        for (int j = 0; j < 4; ++j) {
            const int c = j * 256 + lane * 4;
            const f32x4 a = *(const f32x4*)(X1 + (size_t)t * D + c);
            f32x4 y = (f32x4){0.f, 0.f, 0.f, 0.f};
#pragma unroll
            for (int k = 0; k < 4; ++k) { const u32x2 yk = *(const u32x2*)(YS + (size_t)sl[k] * D + c);
                y.x += gg[k] * __builtin_bit_cast(float, yk.x << 16); y.y += gg[k] * __builtin_bit_cast(float, yk.x & 0xffff0000u); y.z += gg[k] * __builtin_bit_cast(float, yk.y << 16); y.w += gg[k] * __builtin_bit_cast(float, yk.y & 0xffff0000u); }
            v[j * 4 + 0] = ALPHA * a.x + y.x; v[j * 4 + 1] = ALPHA * a.y + y.y; v[j * 4 + 2] = ALPHA * a.z + y.z; v[j * 4 + 3] = ALPHA * a.w + y.w;
            sm += (v[j * 4] + v[j * 4 + 1]) + (v[j * 4 + 2] + v[j * 4 + 3]);
        }
        const float mean = wave_sum(sm, lane) * (1.0f / D); float q = 0.f;
#pragma unroll
        for (int j = 0; j < 16; ++j) { const float dl = v[j] - mean; q += dl * dl; }
        const float rstd = 1.0f / sqrtf(wave_sum(q, lane) * (1.0f / D) + LN_EPS);
#pragma unroll
        for (int j = 0; j < 4; ++j) {
            const int c = j * 256 + lane * 4;
            f32x4 o;
            o.x = (v[j * 4 + 0] - mean) * rstd * g2[c + 0] + b2[c + 0]; o.y = (v[j * 4 + 1] - mean) * rstd * g2[c + 1] + b2[c + 1];
            o.z = (v[j * 4 + 2] - mean) * rstd * g2[c + 2] + b2[c + 2]; o.w = (v[j * 4 + 3] - mean) * rstd * g2[c + 3] + b2[c + 3];
            *(f32x4*)(xo + (size_t)t * D + c) = o;
            if (l != NL - 1) { u32x2 ob; ob.x = pk2(o.x, o.y); ob.y = pk2(o.z, o.w); *(u32x2*)(XB + (size_t)t * D + c) = ob; }
        }
    }
}

__device__ __forceinline__ void phase_inproj(const Params& P, int l, unsigned char* smem, int wv) {
    ParamsPtr pp = PARAMS_PTR(P); PIN_S(pp); unsigned char* ws = pp->ws; int bidx = (int)blockIdx.x, gdim = (int)gridDim.x; PIN_S(bidx); PIN_S(gdim);
    const int tid = phase_tid(wv);
    pg8::DenseOrder S; S.init(ws + O_XB, (const bf16_t*)(ws + O_WIN) + (size_t)l * PLD * D, T, PLD, D, gdim, bidx);
    pg8::EpiF32 E{(float*)(ws + O_PROJ), PLD};
    pg8::gemm_phase<pg8::EpiF32, pg8::DenseOrder>((LAS unsigned char*)smem, D, S, E, tid);
    __syncthreads();
}
__device__ __forceinline__ void phase_outproj(const Params& P, int l, unsigned char* smem, int wv) {
    ParamsPtr pp = PARAMS_PTR(P); PIN_S(pp); unsigned char* ws = pp->ws; int bidx = (int)blockIdx.x, gdim = (int)gridDim.x; PIN_S(bidx); PIN_S(gdim);
    const int tid = phase_tid(wv);
    pg8::DenseOrder S; S.init(ws + O_GRP, (const bf16_t*)(ws + O_WOUT) + (size_t)l * D * D, T, D, D, gdim, bidx);
    pg8::EpiF32 E{(float*)(ws + O_MIX), D};
    pg8::gemm_phase<pg8::EpiF32, pg8::DenseOrder>((LAS unsigned char*)smem, D, S, E, tid);
    __syncthreads();
}

#ifndef EMU
#define XB_TMO      128
#define XB_XCNT(j)  (256  + 64 * (j))
#define XB_XSUB(j)  (1280 + 64 * (j))
#define XB_XGEN(j)  (2304 + 64 * (j))
#define XB_TOP      3328
#define XB_TOPGEN   3392
#define XCD_BAR_WORDS 3456
#define XB_SPIN_CAP (1u << 25)
__device__ __forceinline__ unsigned xb_ld(unsigned* p)              { return __hip_atomic_load(p, __ATOMIC_RELAXED, __HIP_MEMORY_SCOPE_AGENT); }
__device__ __forceinline__ unsigned xb_add(unsigned* p, unsigned v) { return __hip_atomic_fetch_add(p, v, __ATOMIC_RELAXED, __HIP_MEMORY_SCOPE_AGENT); }
__device__ __forceinline__ unsigned xb_xcc_id() { return (unsigned)__builtin_amdgcn_s_getreg((3 << 11) | 20) & 0xFu; }
#define XB_SPIN(cond, bar) do { unsigned _sp = 0; while (cond) { __builtin_amdgcn_s_sleep(1); \
    if ((++_sp & 255u) == 0u) { if (xb_ld(&(bar)[XB_TMO])) break; if (_sp > XB_SPIN_CAP) { atomicAdd(&(bar)[XB_TMO], 1u); break; } } } } while (0)
struct XcdBarrier { unsigned* bar; unsigned x; volatile LAS unsigned* st; };
__device__ __forceinline__ XcdBarrier xcd_barrier_post(unsigned* bar, volatile LAS unsigned* st) {
    XcdBarrier b; b.bar = bar; b.x = xb_xcc_id(); b.st = st;
    if (threadIdx.x == 0) (void)xb_add(&bar[XB_XCNT(b.x)], 1u);
    return b;
}
__device__ __forceinline__ void xcd_barrier_complete(unsigned* bar, unsigned x, unsigned& nloc, unsigned& nx) {
    const unsigned G = gridDim.x * gridDim.y * gridDim.z;
    unsigned sum, cnt, mine, sp = 0u;
    for (;;) {
        sum = 0u; cnt = 0u; mine = 0u;
#pragma unroll
        for (unsigned j = 0; j < 16; ++j) { const unsigned c = xb_ld(&bar[XB_XCNT(j)]); sum += c; cnt += (c > 0u) ? 1u : 0u; mine = (j == x) ? c : mine; }
        if (sum == G) break;
        __builtin_amdgcn_s_sleep(1);
        if ((++sp & 255u) == 0u) { if (xb_ld(&bar[XB_TMO])) break; if (sp > XB_SPIN_CAP) { atomicAdd(&bar[XB_TMO], 1u); break; } }
    }
    nloc = mine > 0u ? mine : 1u; nx = cnt > 0u ? cnt : 1u;
}
__device__ __forceinline__ void xcd_barrier(const XcdBarrier& b) {
    asm volatile("s_waitcnt vmcnt(0)" ::: "memory");
    __syncthreads();
    if (threadIdx.x == 0) {
        unsigned* bar = b.bar;
        __builtin_amdgcn_s_waitcnt(0);
        unsigned nloc = b.st[0], nx = b.st[1];
        if (nloc == 0u) { xcd_barrier_complete(bar, b.x, nloc, nx); b.st[0] = nloc; b.st[1] = nx; }
        const unsigned old = xb_add(&bar[XB_XSUB(b.x)], 1u);
        const unsigned gen = old / nloc;
        if (old + 1u == (gen + 1u) * nloc) {
            __builtin_amdgcn_fence(__ATOMIC_RELEASE, "agent");
            asm volatile("s_waitcnt vmcnt(0)" ::: "memory");
            const unsigned og = xb_add(&bar[XB_TOP], 1u);
            const unsigned tg = og / nx;
            if (og + 1u == (tg + 1u) * nx) xb_add(&bar[XB_TOPGEN], 1u);
            else XB_SPIN(xb_ld(&bar[XB_TOPGEN]) == tg, bar);
            __builtin_amdgcn_fence(__ATOMIC_ACQUIRE, "agent");
            xb_add(&bar[XB_XGEN(b.x)], 1u);
            asm volatile("s_waitcnt vmcnt(0)" ::: "memory");
        } else {
            XB_SPIN(xb_ld(&bar[XB_XGEN(b.x)]) == gen, bar);
            __builtin_amdgcn_fence(__ATOMIC_ACQUIRE, "agent");
            asm volatile("s_waitcnt vmcnt(0)" ::: "memory");
        }
    }
    __syncthreads();
}
#endif

__global__ void __launch_bounds__(512, 2) mk_fwd(Params P) {
#ifdef EMU
    unsigned char* smem = g_blk->lds;
#else
    extern __shared__ __attribute__((aligned(16))) unsigned char smem[];
    volatile LAS unsigned* bst = (volatile LAS unsigned*)(smem + LDS_BYTES - 16);
    if (threadIdx.x == 0) { bst[0] = 0u; bst[1] = 0u; bst[2] = 0u; bst[3] = 0u; }
    __syncthreads();
    XcdBarrier bar; bar.bar = (unsigned*)P.ws + CW_BAR; bar.x = 0; bar.st = bst;
    if (P.ph_hi - P.ph_lo > 1) bar = xcd_barrier_post((unsigned*)P.ws + CW_BAR, bst);
#endif
    const int lo = P.ph_lo, hi = P.ph_hi;
#ifdef EMU
    const int wv = (int)threadIdx.x >> 6;
#else
    const int wv = RFL((int)threadIdx.x >> 6);
#endif
#ifdef EMU
#define SEAM(id) do {} while (0)
#else
#define SEAM(id) do { if ((id) + 1 < hi) xcd_barrier(bar); } while (0)
#endif
#ifndef MK_ONLY_PHASE
#define MK_ONLY_PHASE -1
#endif
#ifndef MK_DUP_MASK
#define MK_DUP_MASK 0
#endif
#define PHG(kc, id, ...) do { if (MK_ONLY_PHASE < 0 || MK_ONLY_PHASE == (kc)) { const int id_ = (id); if (id_ >= lo && id_ < hi) { if ((MK_DUP_MASK >> (kc)) & 1) { __VA_ARGS__; SEAM(id_ - 1); } __VA_ARGS__; SEAM(id_); } } } while (0)
#define PH(k, ...) PHG(1 + (k), 1 + l * NPH + (k), __VA_ARGS__)
    PHG(0, 0, phase_prologue(P, smem, wv));
    for (int l = 0; l < NL; ++l) {
        PH(0, phase_inproj(P, l, smem, wv));
        PH(1, phase_prep(P, l, smem, wv));
#if MK_RWKV_CHUNKED
        PH(2, { phase_rwkv_pre(P, l, smem, wv); phase_mlstm_local(P, l, smem, wv, (int)blockIdx.x, (int)gridDim.x); });
        PH(3, { phase_rwkv_seq(P, l, smem, wv); phase_mlstm_carry(P, l, smem, wv); });
        PH(4, { phase_rwkv_out(P, l, smem, wv); phase_mlstm_out(P, l, smem, wv); phase_gmlp_mix(P, l, smem, wv, (int)blockIdx.x, (int)gridDim.x); });
#else
        PH(2, { const int G_ = (int)gridDim.x, NSC = 2 * NB * RH * 4;
                if (G_ >= NSC + 32) { if ((int)blockIdx.x < NSC) phase_rwkv_scan(P, l, smem, wv, (int)blockIdx.x, NSC);
                                      else phase_mlstm_local(P, l, smem, wv, (int)blockIdx.x - NSC, G_ - NSC); }
                else { phase_rwkv_scan(P, l, smem, wv, (int)blockIdx.x, G_); phase_mlstm_local(P, l, smem, wv, (int)blockIdx.x, G_); } });
        PH(3, phase_mlstm_carry(P, l, smem, wv));
        PH(4, { phase_mlstm_out(P, l, smem, wv); phase_gmlp_mix(P, l, smem, wv, (int)blockIdx.x, (int)gridDim.x); phase_rwkv_post(P, l, smem, wv); });
#endif
        PH(5, phase_outproj(P, l, smem, wv));
        PH(6, phase_ln1_router(P, l, smem, wv));
        PH(7, phase_scatter(P, l, smem, wv));
        PH(8, phase_moe_gemm<1>(P, l, smem, wv));
        PH(9, phase_moe_gemm<2>(P, l, smem, wv));
        PH(10, phase_combine_ln2(P, l, smem, wv));
    }
#undef PHG
#undef PH
#undef SEAM
}

}

#ifndef EMU
extern "C" void kernel_launch(void* const* d_in, const int* in_sizes, int n_in, void* d_out, int out_size, void* d_ws, size_t ws_size, hipStream_t stream) {
    using namespace mk;
    static int grid = 0;
    if (grid == 0) {
        if (n_in != 32 || out_size != T * D || ws_size < WS_END) { fprintf(stderr, "kernel_launch: unexpected shapes (n_in %d out %d ws %zu need %zu)\n", n_in, out_size, ws_size, (size_t)WS_END); grid = -1; return; }
        int dev = 0, cus = 0;
        if (hipGetDevice(&dev) != hipSuccess || hipDeviceGetAttribute(&cus, hipDeviceAttributeMultiprocessorCount, dev) != hipSuccess) { grid = -1; return; }
        if (hipFuncSetAttribute((const void*)mk_fwd, hipFuncAttributeMaxDynamicSharedMemorySize, LDS_BYTES) != hipSuccess) { fprintf(stderr, "kernel_launch: hipFuncSetAttribute failed\n"); grid = -1; return; }
        int per_cu = 0;
        (void)hipOccupancyMaxActiveBlocksPerMultiprocessor(&per_cu, (const void*)mk_fwd, NTHREADS, LDS_BYTES);
        (void)hipGetLastError();
        grid = cus;
    }
    if (grid < 0) return;
    (void)hipMemsetAsync(d_ws, 0, CTL_BYTES, stream);
    Params p{};
    for (int i = 0; i < 32; ++i) p.in[i] = (const float*)d_in[i];
    p.out = (float*)d_out; p.ws = (unsigned char*)d_ws;
#if MK_ONE_LAUNCH
    p.ph_lo = 0; p.ph_hi = 1 + NL * NPH;
    hipLaunchKernelGGL(mk_fwd, dim3(grid), dim3(NTHREADS), LDS_BYTES, stream, p);
#else
    for (int id = 0; id < 1 + NL * NPH; ++id) {
        p.ph_lo = id; p.ph_hi = id + 1;
        hipLaunchKernelGGL(mk_fwd, dim3(grid), dim3(NTHREADS), LDS_BYTES, stream, p);
    }
#endif
}
#endif
```

```cpp
#ifndef EMU
#include <hip/hip_runtime.h>
#endif
#include <cstdio>
#include <cstdint>
#include <cmath>

#ifndef CFG_BATCH
#define CFG_BATCH 4
#endif
#ifndef CFG_SEQ
#define CFG_SEQ 4096
#endif
#ifndef CFG_LAYERS
#define CFG_LAYERS 4
#endif
#ifndef MK_RWKV_CHUNKED
#define MK_RWKV_CHUNKED 1
#endif
#ifndef MK_PROBE
#define MK_PROBE 0
#endif
#ifndef MK_ONE_LAUNCH
#define MK_ONE_LAUNCH 1
#endif

namespace mk {
constexpr int NB = CFG_BATCH, S = CFG_SEQ, T = NB * S, NL = CFG_LAYERS, D = 1024;
constexpr int GW = 256, RW = 384, MW = 384, HD = 64, GH = 4, RH = 6, MH = 6, CH = 128, NCH = S / CH;
constexpr int PIN = 3480, PLD = 3584, RPROJ = 1408;
constexpr int C_RW = 512, C_MW = 1920;
constexpr int NE = 32, TOPK = 4, DFF = 1024, MOEB = 256;
constexpr int NROWS = (T * TOPK / MOEB + NE) * MOEB;
constexpr float LN_EPS = 1e-5f, GN_EPS = 64e-5f;
constexpr float ALPHA = 1.6817928305074290f;
constexpr int NTHREADS = 512, NWAVES = 8;
constexpr int LDS_BYTES = 160 * 1024;
constexpr int NPH = 11;

typedef float f32x4 __attribute__((ext_vector_type(4)));
typedef unsigned u32x4 __attribute__((ext_vector_type(4)));
typedef unsigned u32x2 __attribute__((ext_vector_type(2)));
typedef short bf16x8 __attribute__((ext_vector_type(8)));
typedef unsigned short bf16_t;

constexpr size_t al(size_t x) { return (x + 255) & ~(size_t)255; }
constexpr size_t CTL_BYTES = 1u << 20;
constexpr size_t O_XA = CTL_BYTES;
constexpr size_t O_XB = O_XA + al((size_t)T * D * 4);
constexpr size_t O_X1 = O_XB + al((size_t)T * D * 2);
constexpr size_t O_X1B = O_X1 + al((size_t)T * D * 4);
constexpr size_t O_PROJ = O_X1B + al((size_t)T * D * 2);
constexpr size_t O_MIX = O_PROJ + al((size_t)T * PLD * 4);
constexpr size_t O_GRP = O_MIX + al((size_t)T * D * 4);
constexpr size_t O_UG = O_GRP + al((size_t)T * D * 2);
constexpr size_t O_VN = O_UG + al((size_t)T * GW * 4);
constexpr size_t O_RR = O_VN + al((size_t)T * GW * 4);
constexpr size_t O_VV = O_RR + al((size_t)T * RW * 4);
constexpr size_t O_KK = O_VV + al((size_t)T * RW * 4);
constexpr size_t O_DEC = O_KK + al((size_t)T * RW * 4);
constexpr size_t O_KD = O_DEC + al((size_t)2 * T * RW * 4);
constexpr size_t O_ICLR = O_KD + al((size_t)2 * T * RW * 4);
constexpr size_t O_GATE = O_ICLR + al((size_t)2 * T * RW * 4);
constexpr size_t O_BONUS = O_GATE + al((size_t)T * RW * 4);
constexpr size_t O_SCAN = O_BONUS + al((size_t)T * RH * 4);
constexpr size_t O_MQ = O_SCAN + al((size_t)2 * T * RW * 4);
constexpr size_t O_MK = O_MQ + al((size_t)T * MW * 4);
constexpr size_t O_IG = O_MK + al((size_t)T * MW * 4);
constexpr size_t O_LF = O_IG + al((size_t)2 * T * MH * 4);
constexpr size_t O_CL = O_LF + al((size_t)2 * T * MH * 4);
constexpr size_t O_NL = O_CL + al((size_t)2 * NB * MH * NCH * 4096 * 4);
constexpr size_t O_ML = O_NL + al((size_t)2 * NB * MH * NCH * 64 * 4);
constexpr size_t O_BL = O_ML + al((size_t)2 * NB * MH * NCH * 4);
constexpr size_t O_MIN = O_BL + al((size_t)2 * NB * MH * NCH * 4);
constexpr size_t O_TOPI = O_MIN + al((size_t)2 * NB * MH * NCH * 4);
constexpr size_t O_TOPG = O_TOPI + al((size_t)T * 4 * 4);
constexpr size_t O_RANK = O_TOPG + al((size_t)T * 4 * 4);
constexpr size_t O_SLOT = O_RANK + al((size_t)T * 4 * 4);
constexpr size_t O_MQB = O_SLOT + al((size_t)T * 4 * 4);
constexpr size_t O_MKB = O_MQB + al((size_t)T * MW * 2);
constexpr size_t O_KT = O_MKB + al((size_t)T * MW * 2);
constexpr size_t O_VT = O_KT + al((size_t)T * MW * 2);
constexpr size_t O_GVT = O_VT + al((size_t)T * MW * 2);
constexpr size_t O_PMX = O_GVT + al((size_t)2 * T * MH * 4);
constexpr size_t O_BCT = O_PMX + al((size_t)2 * T * MH * 4);
constexpr size_t O_BRKR = O_BCT + al((size_t)2 * T * MH * 4);
constexpr int RC = 64, RNC = S / RC, RUN = 2 * NB * RH * RNC;
constexpr size_t O_LW = O_BRKR + al((size_t)2 * T * RH * 2 * 4);
constexpr size_t O_RQ = O_LW + al((size_t)2 * T * RW * 4);
constexpr size_t O_RA = O_RQ + al((size_t)RUN * 4096 * 2);
constexpr size_t O_RS = O_RA + al((size_t)RUN * 4096 * 2);
constexpr size_t O_RH = O_RS + al((size_t)RUN * 4096 * 2);
constexpr size_t O_RG = O_RH + al((size_t)RUN * 4096 * 4);
constexpr size_t O_VNT = O_RG + al((size_t)RUN * 4096 * 4);
constexpr size_t O_WSB = O_VNT + al((size_t)T * GW * 2);
constexpr size_t O_LWT = O_WSB + al((size_t)NL * GH * CH * CH * 2);
constexpr size_t O_BCNT = O_LWT + al((size_t)NL * 1920 * 128 * 2);
constexpr size_t O_CNTF = O_BCNT + al((size_t)(T / 64) * NE * 4);
constexpr size_t O_ROWT = O_CNTF + al((size_t)NE * 4);
constexpr size_t O_XS = O_ROWT + al((size_t)NROWS * 4);
constexpr size_t O_ACT = O_XS + al((size_t)NROWS * D * 2);
constexpr size_t O_YS = O_ACT + al((size_t)NROWS * DFF * 2);
constexpr size_t O_WIN = O_YS + al((size_t)NROWS * D * 2);
constexpr size_t O_WOUT = O_WIN + al((size_t)NL * PLD * D * 2);
constexpr size_t O_W1 = O_WOUT + al((size_t)NL * D * D * 2);
constexpr size_t O_W2 = O_W1 + al((size_t)NL * NE * 2 * DFF * D * 2);
constexpr size_t WS_END = O_W2 + al((size_t)NL * NE * D * DFF * 2);

constexpr int CW_BAR = 4096;
constexpr int CW_CNT = 16384;

struct Params { const float* in[32]; float* out; unsigned char* ws; int ph_lo, ph_hi; };
#ifdef EMU
typedef const Params* ParamsPtr;
#define PARAMS_PTR(P) (&(P))
#else
typedef const __attribute__((address_space(4))) Params* ParamsPtr;
#define PARAMS_PTR(P) ((ParamsPtr)__builtin_amdgcn_kernarg_segment_ptr())
#endif

#ifdef EMU
#define WAVE_SYNC() emu_wave_barrier()
#define PIN_V(x) do {} while (0)
#define PIN_S(x) do {} while (0)
#else
#define WAVE_SYNC() __builtin_amdgcn_wave_barrier()
#define PIN_V(x) asm volatile("" : "+v"(x))
#define PIN_S(x) asm volatile("" : "+s"(x))
#endif
#ifdef EMU
__device__ __forceinline__ int phase_tid(int wv) { (void)wv; return threadIdx.x; }
#else
__device__ __forceinline__ int phase_tid(int wv) { int t; asm volatile("v_mbcnt_lo_u32_b32 %0, -1, 0\n\tv_mbcnt_hi_u32_b32 %0, -1, %0" : "=v"(t)); return (wv << 6) + t; }
#endif

#ifdef EMU
#define SHX(v, m, lane) __shfl_xor(v, m)
#else
__device__ __forceinline__ float shx_(float v, int m, int lane) { return __builtin_bit_cast(float, __builtin_amdgcn_ds_bpermute((lane ^ m) << 2, __builtin_bit_cast(int, v))); }
__device__ __forceinline__ int shx_(int v, int m, int lane) { return __builtin_amdgcn_ds_bpermute((lane ^ m) << 2, v); }
#define SHX(v, m, lane) shx_(v, m, lane)
#endif
#ifdef EMU
#define SHUP(v, o, lane) __shfl(v, ((lane) - (o)) & 63)
#define RDL(v, src) __shfl(v, src)
#define SHL(v, src) __shfl(v, src)
#else
#define SHL(v, src) __builtin_bit_cast(float, __builtin_amdgcn_ds_bpermute((src) << 2, __builtin_bit_cast(int, (float)(v))))
#define SHUP(v, o, lane) __builtin_bit_cast(float, __builtin_amdgcn_ds_bpermute((((lane) - (o)) & 63) << 2, __builtin_bit_cast(int, (float)(v))))
#define RDL(v, src) __builtin_bit_cast(float, __builtin_amdgcn_readlane(__builtin_bit_cast(int, (float)(v)), src))
#endif
__device__ __forceinline__ float wave_sum(float v, int lane) {
#pragma unroll
    for (int o = 32; o >= 1; o >>= 1) v += SHX(v, o, lane);
    return v;
}
#ifdef EMU
__device__ __forceinline__ float fexp(float x) { return expf(x); }
__device__ __forceinline__ float flog(float x) { return logf(x); }
__device__ __forceinline__ float frcp(float x) { return 1.0f / x; }
#else
__device__ __forceinline__ float fexp(float x) { return __builtin_amdgcn_exp2f(x * 1.4426950408889634f); }
__device__ __forceinline__ float flog(float x) { return __builtin_amdgcn_logf(x) * 0.6931471805599453f; }
__device__ __forceinline__ float frcp(float x) { return __builtin_amdgcn_rcpf(x); }
#endif
__device__ __forceinline__ float sigmoidf_(float x) { return frcp(1.0f + fexp(-x)); }
__device__ __forceinline__ float softplusf_(float x) { return fmaxf(x, 0.f) + flog(1.0f + fexp(-fabsf(x))); }
__device__ __forceinline__ float ftanh(float x) { return 1.0f - 2.0f * frcp(1.0f + fexp(2.0f * x)); }
__device__ __forceinline__ float geluf_(float v) {
    const float av = fabsf(v), t = frcp(1.0f + 0.2316418882f * av);
    float q = t * 0.5307027145f + (-0.7265760135f); q = q * t + 0.7107068705f; q = q * t + (-0.142248368f); q = q * t + 0.127414796f; q = q * t;
    const float m = v * (q * fexp(-0.5f * v * v));
    return v < 0.f ? m : v - m;
}

#ifdef EMU
#define LAS
#define WAIT_V(n) do {} while (0)
#define WAIT_L(n) do {} while (0)
#define S_BARRIER() __syncthreads()
#define SETPRIO(x) do {} while (0)
#define SCHED_BAR() do {} while (0)
#define RFL(x) (x)
static inline void emu_glds16(const void* g, void* l) { memcpy((char*)l + (g_blk->cur & 63) * 16, g, 16); }
#define GLDS16(gptr, ldsptr) emu_glds16((const void*)(gptr), (void*)(ldsptr))
static inline float emu_bf2f(unsigned short b) { unsigned u = (unsigned)b << 16; float f; memcpy(&f, &u, 4); return f; }
static inline f32x4 emu_mfma16(bf16x8 a, bf16x8 b, f32x4 c) {
    EmuBlock* blk = g_blk; const int cur = blk->cur, lane = cur & 63, wbase = cur & ~63;
    static thread_local unsigned short Ash[32][64][8], Bsh[32][64][8];
    const int w = cur >> 6;
    for (int j = 0; j < 8; ++j) { Ash[w][lane][j] = (unsigned short)a[j]; Bsh[w][lane][j] = (unsigned short)b[j]; }
    emu_wave_barrier();
    const int col = lane & 15;
    for (int r = 0; r < 4; ++r) { const int row = 4 * (lane >> 4) + r; float sum = c[r];
        for (int k = 0; k < 32; ++k) sum += emu_bf2f(Ash[w][row + 16 * (k >> 3)][k & 7]) * emu_bf2f(Bsh[w][col + 16 * (k >> 3)][k & 7]);
        c[r] = sum; }
    emu_wave_barrier(); (void)wbase;
    return c;
}
#define MFMA16(a, b, c) emu_mfma16(a, b, c)
#else
#define LAS __attribute__((address_space(3)))
#define WAIT_V(n) asm volatile("s_waitcnt vmcnt(" #n ")" ::: "memory")
#define WAIT_L(n) asm volatile("s_waitcnt lgkmcnt(" #n ")" ::: "memory")
#define S_BARRIER() __builtin_amdgcn_s_barrier()
#define SETPRIO(x) __builtin_amdgcn_s_setprio(x)
#define SCHED_BAR() __builtin_amdgcn_sched_barrier(0)
#define RFL(x) __builtin_amdgcn_readfirstlane(x)
#define GLDS16(gptr, ldsptr) __builtin_amdgcn_global_load_lds((const unsigned*)(gptr), (LAS unsigned*)(ldsptr), 16, 0, 0)
#define MFMA16(a, b, c) __builtin_amdgcn_mfma_f32_16x16x32_bf16(a, b, c, 0, 0, 0)
#endif

__device__ __forceinline__ unsigned f2bf(float f) { unsigned u = __builtin_bit_cast(unsigned, f); return (u + 0x7fffu + ((u >> 16) & 1u)) >> 16; }
__device__ __forceinline__ unsigned pk2(float lo, float hi) { return f2bf(lo) | (f2bf(hi) << 16); }
__device__ __forceinline__ bf16x8 cvt8(const f32x4 a, const f32x4 b) {
    u32x4 w; w.x = pk2(a.x, a.y); w.y = pk2(a.z, a.w); w.z = pk2(b.x, b.y); w.w = pk2(b.z, b.w); return __builtin_bit_cast(bf16x8, w);
}
__device__ __forceinline__ float bf_lo(unsigned u) { return __builtin_bit_cast(float, u << 16); }
__device__ __forceinline__ float bf_hi(unsigned u) { return __builtin_bit_cast(float, u & 0xffff0000u); }

namespace pg8 {
constexpr int BM = 256, BK = 64, HALF = 128, HTB = HALF * BK * 2, STAGE_BYTES = 8 * HTB, NXCD = 8, WGM = 8;
__host__ __device__ __forceinline__ int lds_byte(int r, int c) { const int st = (r >> 4) * 2 + (c >> 5), rr = r & 15, cc = c & 31, ob = rr * 64 + cc * 2; return st * 1024 + (ob ^ (((ob >> 9) & 1) << 5)); }
__host__ __device__ __forceinline__ void stage_rc(int b, int& R, int& C) { const int st = b / 1024, sb = b % 1024, swz = sb ^ (((sb >> 9) & 1) << 5); R = (st >> 1) * 16 + swz / 64; C = (st & 1) * 32 + (swz % 64) / 2; }
__host__ __device__ __forceinline__ int perm32(int rho) { const int n = rho >> 4, i = rho & 15; return 8 * (i >> 2) + 4 * n + (i & 3); }
struct Unit { int pm, pn, e; };

struct DenseOrder {
    static constexpr bool GATHER = false;
    const char* A; const char* Bt; int K; int nM, nN, nwg, G, c;
    __device__ __forceinline__ void init(const void* A_, const void* Bt_, int M, int N, int K_, int G_, int c_) { A = (const char*)A_; Bt = (const char*)Bt_; K = K_; nM = M / BM; nN = N / BM; nwg = nM * nN; G = G_; c = c_; }
    __device__ __forceinline__ bool next(int i, Unit& u) const {
        const long L = (long)i * G + c; if (L >= nwg) return false;
        int wgid = (int)L; { const int q = nwg / NXCD, r = nwg % NXCD, xcd = wgid % NXCD, off = wgid / NXCD; wgid = (xcd < r ? xcd * (q + 1) : r * (q + 1) + (xcd - r) * q) + off; }
        const int nig = WGM * nN, gid = wgid / nig, fm = gid * WGM, gsz = (nM - fm) < WGM ? (nM - fm) : WGM;
        u.pm = fm + ((wgid % nig) % gsz); u.pn = (wgid % nig) / gsz; u.e = 0; return true;
    }
    __device__ __forceinline__ const char* abase(const Unit& u) const { return A + (size_t)u.pm * BM * K * 2; }
    __device__ __forceinline__ const char* bbase(const Unit& u) const { return Bt + (size_t)u.pn * BM * K * 2; }
};
template <bool G>
struct MoeOrderT {
    static constexpr bool GATHER = G;
    const char* A; const char* Wt; int K; int nN, nwg, G_, c; size_t estride; const int* rbe; const int* rowmap;
    __device__ __forceinline__ bool next(int i, Unit& u) const {
        const long L = (long)i * G_ + c; if (L >= nwg) return false;
        u.pm = (int)(L / nN); u.pn = (int)(L % nN); u.e = rbe[u.pm]; return true;
    }
    __device__ __forceinline__ const char* abase(const Unit& u) const { return G ? A : A + (size_t)u.pm * BM * K * 2; }
    __device__ __forceinline__ const char* bbase(const Unit& u) const { return Wt + (size_t)u.e * estride + (size_t)u.pn * BM * K * 2; }
};
struct EpiF32 {
    static constexpr bool PERM = false;
    float* C; int ldc;
    __device__ __forceinline__ void operator()(const f32x4 (&acc)[2][2][4][2], const Unit& u, int wr, int wc, int fr, int fq) const {
        const int row0 = u.pm * BM + wr * 64 + fr, col0 = u.pn * BM + wc * 32 + 4 * fq;
#pragma unroll
        for (int ai = 0; ai < 2; ++ai)
#pragma unroll
            for (int m = 0; m < 4; ++m) { float* rowp = C + (size_t)(row0 + ai * HALF + m * 16) * ldc + col0;
#pragma unroll
                for (int bj = 0; bj < 2; ++bj)
#pragma unroll
                    for (int n = 0; n < 2; ++n) *(f32x4*)(rowp + bj * HALF + n * 16) = acc[ai][bj][m][n]; }
    }
};
struct EpiBf16Bias {
    static constexpr bool PERM = true;
    bf16_t* O; int ldc; const float* bias; int bias_estride;
    __device__ __forceinline__ void operator()(const f32x4 (&acc)[2][2][4][2], const Unit& u, int wr, int wc, int fr, int fq) const {
        const int row0 = u.pm * BM + wr * 64 + fr, col0 = u.pn * BM + wc * 32 + 8 * fq;
        const float* bp = bias + (size_t)u.e * bias_estride + col0;
        f32x4 bv[2][2];
#pragma unroll
        for (int bj = 0; bj < 2; ++bj)
#pragma unroll
            for (int n = 0; n < 2; ++n) bv[bj][n] = *(const f32x4*)(bp + bj * HALF + 4 * n);
#pragma unroll
        for (int ai = 0; ai < 2; ++ai)
#pragma unroll
            for (int m = 0; m < 4; ++m) { bf16_t* rowp = O + (size_t)(row0 + ai * HALF + m * 16) * ldc + col0;
#pragma unroll
                for (int bj = 0; bj < 2; ++bj) { const f32x4 v0 = acc[ai][bj][m][0] + bv[bj][0], v1 = acc[ai][bj][m][1] + bv[bj][1];
                    u32x4 w; w.x = pk2(v0[0], v0[1]); w.y = pk2(v0[2], v0[3]); w.z = pk2(v1[0], v1[1]); w.w = pk2(v1[2], v1[3]);
                    *(u32x4*)(rowp + bj * HALF) = w; } }
    }
};
__device__ __forceinline__ float swiglu1(float g, float uu) { g = fminf(g, 7.0f); uu = fminf(fmaxf(uu, -7.0f), 7.0f); return (uu + 1.0f) * (g * frcp(1.0f + fexp(-1.702f * g))); }
struct EpiSwiglu {
    static constexpr bool PERM = true;
    bf16_t* O; const float* b1;
    __device__ __forceinline__ void operator()(const f32x4 (&acc)[2][2][4][2], const Unit& u, int wr, int wc, int fr, int fq) const {
        const int row0 = u.pm * BM + wr * 64 + fr, j0 = u.pn * HALF + wc * 32 + 8 * fq;
        const float* bg = b1 + (size_t)u.e * 2 * DFF + j0; const float* bu = bg + DFF;
        f32x4 g4[2], u4[2];
#pragma unroll
        for (int n = 0; n < 2; ++n) { g4[n] = *(const f32x4*)(bg + 4 * n); u4[n] = *(const f32x4*)(bu + 4 * n); }
#pragma unroll
        for (int ai = 0; ai < 2; ++ai)
#pragma unroll
            for (int m = 0; m < 4; ++m) {
                float o[8];
#pragma unroll
                for (int n = 0; n < 2; ++n)
#pragma unroll
                    for (int q = 0; q < 4; ++q) o[n * 4 + q] = swiglu1(acc[ai][0][m][n][q] + g4[n][q], acc[ai][1][m][n][q] + u4[n][q]);
                u32x4 w; w.x = pk2(o[0], o[1]); w.y = pk2(o[2], o[3]); w.z = pk2(o[4], o[5]); w.w = pk2(o[6], o[7]);
                *(u32x4*)(O + (size_t)(row0 + ai * HALF + m * 16) * DFF + j0) = w;
            }
    }
};

template <class Epi, class Sched>
__device__ __forceinline__ void gemm_phase(LAS unsigned char* lds, const int K, const Sched& S, const Epi& E, const int tid) {
    const int wid = RFL(tid >> 6), lane = tid & 63, wr = wid >> 2, wc = wid & 3, fr = lane & 15, fq = lane >> 4;
    const int nt = K / BK;
    unsigned voffA[2], voffB[2]; int gR[2]; unsigned gC[2];
#pragma unroll
    for (int i = 0; i < 2; ++i) { int R, C; stage_rc(tid * 16 + i * 8192, R, C); const int Rb = Epi::PERM ? ((R & ~31) + perm32(R & 31)) : R;
        voffA[i] = (unsigned)(R * K + C) * 2u; voffB[i] = (unsigned)(Rb * K + C) * 2u; gR[i] = R; gC[i] = (unsigned)C * 2u; }
    unsigned va[2][2], vn[2][2];
#define PG8_GOFF(dst, unit) do { if constexpr (Sched::GATHER) { _Pragma("unroll") for (int h_ = 0; h_ < 2; ++h_) _Pragma("unroll") for (int i_ = 0; i_ < 2; ++i_) \
        dst[h_][i_] = (unsigned)S.rowmap[(unit).pm * BM + h_ * HALF + gR[i_]] * (unsigned)(K * 2) + gC[i_]; } } while (0)
#define PG8_STAGE_A(bufoff, bp, kb, h, nx) do { if constexpr (Sched::GATHER) { const char* gb_ = S.A + (kb); _Pragma("unroll") for (int _i = 0; _i < 2; ++_i) \
        GLDS16(gb_ + ((nx) ? vn[h][_i] : va[h][_i]), lds + (bufoff) + ldsw + _i * 8192); } else { PG8_STAGE(bufoff, bp, voffA); } } while (0)
    const size_t kstep = (size_t)(BK * 2);
    const size_t hstep = (size_t)HALF * K * 2;
    const unsigned ldsw = (unsigned)wid * 1024u;
    const int aoff = lds_byte(wr * 64 + fr, fq * 8), boff = lds_byte(wc * 32 + fr, fq * 8);
#define PG8_SA(b, h) (((b) * 2 + (h)) * HTB)
#define PG8_SB(b, h) ((4 + (b) * 2 + (h)) * HTB)
#define PG8_STAGE(bufoff, gbase, voff) do { _Pragma("unroll") for (int _i = 0; _i < 2; ++_i) \
        GLDS16((const char*)(gbase) + (voff)[_i], lds + (bufoff) + ldsw + _i * 8192); } while (0)
#define PG8_LDA(dst, b, h) do { _Pragma("unroll") for (int m = 0; m < 4; ++m) _Pragma("unroll") for (int k = 0; k < 2; ++k) dst[m][k] = *(const LAS bf16x8*)(lds + PG8_SA(b, h) + aoff + m * 2048 + k * 1024); } while (0)
#define PG8_LDB(dst, b, h) do { _Pragma("unroll") for (int n = 0; n < 2; ++n) _Pragma("unroll") for (int k = 0; k < 2; ++k) dst[n][k] = *(const LAS bf16x8*)(lds + PG8_SB(b, h) + boff + n * 2048 + k * 1024); } while (0)
#define PG8_MMA(ai, bj, At, Bt) do { SETPRIO(1); _Pragma("unroll") for (int m = 0; m < 4; ++m) _Pragma("unroll") for (int n = 0; n < 2; ++n) _Pragma("unroll") for (int k = 0; k < 2; ++k) \
        acc[ai][bj][m][n] = MFMA16(Bt[n][k], At[m][k], acc[ai][bj][m][n]); SETPRIO(0); } while (0)
    Unit cur, nxt; int ui = 0;
    if (!S.next(0, cur)) return;
    f32x4 acc[2][2][4][2];
#pragma unroll
    for (int a = 0; a < 2; ++a)
#pragma unroll
        for (int b = 0; b < 2; ++b)
#pragma unroll
            for (int m = 0; m < 4; ++m)
#pragma unroll
                for (int n = 0; n < 2; ++n) acc[a][b][m][n] = (f32x4){0.f, 0.f, 0.f, 0.f};
    bf16x8 At[4][2], B0[2][2], B1[2][2];
    const char* cA = S.abase(cur); const char* cB = S.bbase(cur);
    PG8_GOFF(va, cur);
    PG8_STAGE(PG8_SB(0, 0), cB, voffB); PG8_STAGE_A(PG8_SA(0, 0), cA, 0, 0, false); PG8_STAGE(PG8_SB(0, 1), cB + hstep, voffB); PG8_STAGE_A(PG8_SA(0, 1), cA + hstep, 0, 1, false);
    if (wr == 1) S_BARRIER();
    WAIT_V(4); S_BARRIER();
    PG8_STAGE(PG8_SB(1, 0), cB + kstep, voffB); PG8_STAGE_A(PG8_SA(1, 0), cA + kstep, kstep, 0, false); PG8_STAGE(PG8_SB(1, 1), cB + hstep + kstep, voffB);
    WAIT_V(6); S_BARRIER();
    for (;;) {
        const bool has_next = S.next(ui + 1, nxt);
        const char* nA = has_next ? S.abase(nxt) : cA; const char* nB = has_next ? S.bbase(nxt) : cB;
        if constexpr (Sched::GATHER) { if (has_next) { PG8_GOFF(vn, nxt); } else {
#pragma unroll
            for (int h_ = 0; h_ < 2; ++h_) { vn[h_][0] = va[h_][0]; vn[h_][1] = va[h_][1]; } } }
        for (int t = 0; t < nt; t += 2) {
            const bool last = (t == nt - 2);
            const char* a1 = cA + (size_t)(t + 1) * kstep;
            const char* a2 = last ? nA : cA + (size_t)(t + 2) * kstep; const char* b2 = last ? nB : cB + (size_t)(t + 2) * kstep;
            const char* a3 = a2 + kstep; const char* b3 = b2 + kstep;
            PG8_LDB(B0, 0, 0); SCHED_BAR(); PG8_LDA(At, 0, 0); PG8_STAGE_A(PG8_SA(1, 1), a1 + hstep, (size_t)(t + 1) * kstep, 1, false);
            WAIT_L(8); S_BARRIER(); WAIT_L(0); PG8_MMA(0, 0, At, B0); S_BARRIER(); SCHED_BAR();
            PG8_LDB(B1, 0, 1); PG8_STAGE(PG8_SB(0, 0), b2, voffB);
            S_BARRIER(); WAIT_L(0); PG8_MMA(0, 1, At, B1); S_BARRIER();
            PG8_LDA(At, 0, 1); PG8_STAGE_A(PG8_SA(0, 0), a2, (last ? (size_t)0 : (size_t)(t + 2) * kstep), 0, last);
            S_BARRIER(); WAIT_L(0); PG8_MMA(1, 0, At, B0); S_BARRIER(); SCHED_BAR();
            PG8_STAGE(PG8_SB(0, 1), b2 + hstep, voffB);
            WAIT_V(6); S_BARRIER(); PG8_MMA(1, 1, At, B1); S_BARRIER();
            PG8_LDB(B0, 1, 0); SCHED_BAR(); PG8_LDA(At, 1, 0); PG8_STAGE_A(PG8_SA(0, 1), a2 + hstep, (last ? (size_t)0 : (size_t)(t + 2) * kstep), 1, last);
            WAIT_L(8); S_BARRIER(); WAIT_L(0); PG8_MMA(0, 0, At, B0); S_BARRIER(); SCHED_BAR();
            PG8_LDB(B1, 1, 1); PG8_STAGE(PG8_SB(1, 0), b3, voffB);
            S_BARRIER(); WAIT_L(0); PG8_MMA(0, 1, At, B1); S_BARRIER();
            PG8_LDA(At, 1, 1); PG8_STAGE_A(PG8_SA(1, 0), a3, (last ? kstep : (size_t)(t + 3) * kstep), 0, last);
            S_BARRIER(); WAIT_L(0); PG8_MMA(1, 0, At, B0); S_BARRIER(); SCHED_BAR();
            PG8_STAGE(PG8_SB(1, 1), b3 + hstep, voffB);
            WAIT_V(6); S_BARRIER(); PG8_MMA(1, 1, At, B1); S_BARRIER();
        }
        E(acc, cur, wr, wc, fr, fq);
        if (!has_next) break;
#pragma unroll
        for (int a = 0; a < 2; ++a)
#pragma unroll
            for (int b = 0; b < 2; ++b)
#pragma unroll
                for (int m = 0; m < 4; ++m)
#pragma unroll
                    for (int n = 0; n < 2; ++n) acc[a][b][m][n] = (f32x4){0.f, 0.f, 0.f, 0.f};
        cur = nxt; cA = nA; cB = nB; ++ui;
        if constexpr (Sched::GATHER) {
#pragma unroll
            for (int h_ = 0; h_ < 2; ++h_) { va[h_][0] = vn[h_][0]; va[h_][1] = vn[h_][1]; } }
    }
    WAIT_V(0);
    if (wr == 0) S_BARRIER();
    S_BARRIER();
#undef PG8_SA
#undef PG8_SB
#undef PG8_STAGE
#undef PG8_STAGE_A
#undef PG8_GOFF
#undef PG8_LDA
#undef PG8_LDB
#undef PG8_MMA
}
}

__device__ __forceinline__ float row16_sum(float x) {
#ifdef EMU
    x += __shfl_xor(x, 1); x += __shfl_xor(x, 2); x += __shfl_xor(x, 4); x += __shfl_xor(x, 8); return x;
#else
#define DPPF(v, ctrl) __builtin_bit_cast(float, __builtin_amdgcn_update_dpp(0, __builtin_bit_cast(int, (v)), (ctrl), 0xF, 0xF, false))
    x += DPPF(x, 0xB1); x += DPPF(x, 0x4E); x += DPPF(x, 0x141); x += DPPF(x, 0x140); return x;
#undef DPPF
#endif
}
__device__ __forceinline__ float row32_sum(float x) {
    x = row16_sum(x);
#ifdef EMU
    x += __shfl_xor(x, 32); return x;
#else
    float a = x, b = x;
    asm volatile("s_nop 1\n\tv_permlane32_swap_b32 %0, %1" : "+v"(a), "+v"(b));
    return a + b;
#endif
}
__device__ __forceinline__ float wave_sum_fast(float x, int lane) {
    x = row32_sum(x);
    x += SHX(x, 16, lane);
    return x;
}
__device__ __forceinline__ void transpose_item(const float* W, int K, int N, bf16_t* WT, int k0, int n0, int dst_row0, float* scr, int lane) {
    const int n4 = (lane & 15) * 4, kr = lane >> 4;
#pragma unroll 8
    for (int i = 0; i < 16; ++i) {
        const int kk = 4 * i + kr;
        f32x4 v = (f32x4){0.f, 0.f, 0.f, 0.f};
        if (n0 + n4 < N) v = *(const f32x4*)(W + (size_t)(k0 + kk) * N + n0 + n4);
        float* d = scr + kk * 65 + n4; d[0] = v.x; d[1] = v.y; d[2] = v.z; d[3] = v.w;
    }
    WAVE_SYNC();
    const int c = lane & 7;
#pragma unroll
    for (int j = 0; j < 8; ++j) { const int n = (lane >> 3) + 8 * j; const float* sp = scr + (8 * c) * 65 + n;
        u32x4 o; o.x = pk2(sp[0 * 65], sp[1 * 65]); o.y = pk2(sp[2 * 65], sp[3 * 65]); o.z = pk2(sp[4 * 65], sp[5 * 65]); o.w = pk2(sp[6 * 65], sp[7 * 65]);
        *(u32x4*)(WT + (size_t)(dst_row0 + n) * K + k0 + 8 * c) = o; }
    WAVE_SYNC();
}
__device__ __forceinline__ void phase_prologue(const Params& P, unsigned char* smem, int wv) {
    ParamsPtr pp = PARAMS_PTR(P); PIN_S(pp); unsigned char* ws = pp->ws; int bidx = (int)blockIdx.x, gdim = (int)gridDim.x; PIN_S(bidx); PIN_S(gdim);
    const int tid = phase_tid(wv), lane = tid & 63, wave = tid >> 6;
    float* scr = (float*)smem + wave * (64 * 65);
    const int gw = bidx * NWAVES + wave, ngw = NWAVES * gdim;
    constexpr int I_IN = 16 * (PLD / 64), I_OUT = 16 * 16, I_W1 = NE * 16 * 32, I_W2 = NE * 16 * 16, I_L = I_IN + I_OUT + I_W1 + I_W2;
    for (int it = gw; it < NL * I_L; it += ngw) {
        const int l = it / I_L; int r = it % I_L;
        if (r < I_IN) { const int kb = r / (PLD / 64), nb = r % (PLD / 64);
            transpose_item(pp->in[1] + (size_t)l * D * PIN, D, PIN, (bf16_t*)(ws + O_WIN) + (size_t)l * PLD * D, kb * 64, nb * 64, nb * 64, scr, lane); continue; }
        r -= I_IN;
        if (r < I_OUT) { const int kb = r / 16, nb = r % 16;
            transpose_item(pp->in[21] + (size_t)l * D * D, D, D, (bf16_t*)(ws + O_WOUT) + (size_t)l * D * D, kb * 64, nb * 64, nb * 64, scr, lane); continue; }
        r -= I_OUT;
        if (r < I_W1) { const int e = r / (16 * 32), q = r % (16 * 32), kb = q / 32, nb = q % 32, n0 = nb * 64;
            const int dst = n0 < DFF ? (n0 / 128) * 256 + (n0 % 128) : ((n0 - DFF) / 128) * 256 + 128 + ((n0 - DFF) % 128);
            transpose_item(pp->in[26] + ((size_t)l * NE + e) * D * 2 * DFF, D, 2 * DFF, (bf16_t*)(ws + O_W1) + ((size_t)l * NE + e) * 2 * DFF * D, kb * 64, n0, dst, scr, lane); continue; }
        r -= I_W1;
        { const int e = r / (16 * 16), q = r % (16 * 16), kb = q / 16, nb = q % 16;
            transpose_item(pp->in[28] + ((size_t)l * NE + e) * DFF * D, DFF, D, (bf16_t*)(ws + O_W2) + ((size_t)l * NE + e) * D * DFF, kb * 64, nb * 64, nb * 64, scr, lane); }
    }
    {
        const float* gw_ = pp->in[4]; bf16_t* WSB = (bf16_t*)(ws + O_WSB);
        for (size_t i = ((size_t)bidx * NTHREADS + tid) * 4; i < (size_t)NL * GH * CH * CH; i += (size_t)gdim * NTHREADS * 4) {
            const f32x4 v = *(const f32x4*)(gw_ + i); u32x2 o; o.x = pk2(v.x, v.y); o.y = pk2(v.z, v.w); *(u32x2*)(WSB + i) = o;
        }
    }
    {
        bf16_t* LWT = (bf16_t*)(ws + O_LWT);
        for (int i = bidx * NTHREADS + tid; i < NL * 1920 * 128; i += gdim * NTHREADS) {
            const int k = i & 127, n = (i >> 7) % 1920, ll = i / (1920 * 128);
            float v = 0.f;
            if (n < 1536) { if (k < 64) { const int grp = n / 768, d = (n / 384) & 1, c = n % 384; v = (grp == 0 ? pp->in[8] : pp->in[10])[(((size_t)ll * 2 + d) * 64 + k) * RW + c]; } }
            else v = pp->in[11][((size_t)ll * 128 + k) * RW + (n - 1536)];
            LWT[i] = (bf16_t)f2bf(v);
        }
    }
    const float* x = pp->in[0]; bf16_t* XB = (bf16_t*)(ws + O_XB);
    for (size_t i = ((size_t)bidx * NTHREADS + tid) * 4; i < (size_t)T * D; i += (size_t)gdim * NTHREADS * 4) {
        const f32x4 v = *(const f32x4*)(x + i); u32x2 o; o.x = pk2(v.x, v.y); o.y = pk2(v.z, v.w); *(u32x2*)(XB + i) = o;
    }
}

__device__ __forceinline__ float tshift(const float* P, int t, int s, int col, const float* mu0, const float* mu1, int rc) {
    const float cur = P[(size_t)t * PLD + col];
    const float prv = s > 0 ? P[(size_t)(t - 1) * PLD + col] : 0.f;
    const float nxt = s < S - 1 ? P[(size_t)(t + 1) * PLD + col] : 0.f;
    return cur + mu0[rc] * (prv - cur) + mu1[rc] * (nxt - cur);
}

__device__ __forceinline__ void phase_prep(const Params& P, int l, unsigned char* smem, int wv) {
    ParamsPtr pp = PARAMS_PTR(P); PIN_S(pp); unsigned char* ws = pp->ws; int bidx = (int)blockIdx.x, gdim = (int)gridDim.x; PIN_S(bidx); PIN_S(gdim);
    const float* proj = (const float*)(ws + O_PROJ);
    float* UG = (float*)(ws + O_UG); bf16_t* VNT = (bf16_t*)(ws + O_VNT);
    float* RR = (float*)(ws + O_RR); float* VV = (float*)(ws + O_VV); float* KK = (float*)(ws + O_KK);
    float* KD = (float*)(ws + O_KD); float* ICLR = (float*)(ws + O_ICLR);
    float* GATE = (float*)(ws + O_GATE); float* BONUS = (float*)(ws + O_BONUS); float* LWG = (float*)(ws + O_LW);
#if !MK_RWKV_CHUNKED
    float* DEC = (float*)(ws + O_DEC); float* BRKR = (float*)(ws + O_BRKR);
#endif
    bf16_t* MQB = (bf16_t*)(ws + O_MQB); bf16_t* MKB = (bf16_t*)(ws + O_MKB); bf16_t* KT = (bf16_t*)(ws + O_KT); bf16_t* VT = (bf16_t*)(ws + O_VT);
    float* IG = (float*)(ws + O_IG); float* LF = (float*)(ws + O_LF);
    const bf16_t* LWT = (const bf16_t*)(ws + O_LWT) + (size_t)l * 1920 * 128;
    const float* gln_g = pp->in[2] + (size_t)l * GW; const float* gln_b = pp->in[3] + (size_t)l * GW;
    const float* mu0 = pp->in[6] + (size_t)l * 2 * RPROJ; const float* mu1 = mu0 + RPROJ;
    const float* w0 = pp->in[7] + (size_t)l * 2 * RW; const float* a0 = pp->in[9] + (size_t)l * 2 * RW;
    const float* k_k = pp->in[12] + (size_t)l * RW; const float* k_a = pp->in[13] + (size_t)l * RW; const float* r_k = pp->in[14] + (size_t)l * RW;
    const float* conv_w = pp->in[17] + (size_t)l * 3 * 768; const float* conv_b = pp->in[18] + (size_t)l * 768; const float* gate_b = pp->in[19] + (size_t)l * 24;
    float* win = (float*)smem;
    bf16_t* lin = (bf16_t*)(smem + 101376);
    bf16_t* tvn = (bf16_t*)(smem + 110592);
    bf16_t* tk = (bf16_t*)(smem + 118784);
    bf16_t* tv = (bf16_t*)(smem + 131072);
    constexpr int LIN = 264;
    const int tid = phase_tid(wv), lane = tid & 63, wave = tid >> 6, col = lane & 15, g = lane >> 4;
    for (int u = bidx; u < T / 16; u += gdim) {
        const int t0 = u * 16, s0 = t0 % S, bb = t0 / S;
        __syncthreads();
        {
            f32x4 wb[18];
#pragma unroll
            for (int row = 0; row < 18; ++row) {
                const int sq = s0 - 1 + row;
                wb[row] = (f32x4){0.f, 0.f, 0.f, 0.f};
                if (sq >= 0 && sq < S && tid < 352) wb[row] = *(const f32x4*)(proj + (size_t)(t0 - 1 + row) * PLD + C_RW + tid * 4);
            }
            if (tid < 352) {
#pragma unroll
                for (int row = 0; row < 18; ++row) *(f32x4*)(win + row * RPROJ + tid * 4) = wb[row];
            }
        }
        for (int rep_ = 0; rep_ < (MK_PROBE == 3 ? 2 : 1); ++rep_) {
            const int i = tid >> 5, l32 = tid & 31, t = t0 + i;
            float v[8], ug[8]; float sum = 0.f;
#pragma unroll
            for (int j = 0; j < 8; ++j) { const int c = j * 32 + l32; ug[j] = proj[(size_t)t * PLD + c]; v[j] = proj[(size_t)t * PLD + GW + c]; }
#pragma unroll
            for (int j = 0; j < 8; ++j) { const int c = j * 32 + l32; UG[(size_t)t * GW + c] = geluf_(ug[j]); v[j] = geluf_(v[j]); sum += v[j]; }
#pragma unroll
            for (int o = 16; o >= 1; o >>= 1) sum += SHX(sum, o, lane);
            const float mean = sum * (1.0f / GW); float q = 0.f;
#pragma unroll
            for (int j = 0; j < 8; ++j) { const float d = v[j] - mean; q += d * d; }
#pragma unroll
            for (int o = 16; o >= 1; o >>= 1) q += SHX(q, o, lane);
            const float rstd = 1.0f / sqrtf(q * (1.0f / GW) + LN_EPS);
#pragma unroll
            for (int j = 0; j < 8; ++j) { const int c = j * 32 + l32; tvn[c * 16 + i] = (bf16_t)f2bf((v[j] - mean) * rstd * gln_g[c] + gln_b[c]); }
        }
        __syncthreads();
        {
            const int hf = tid & 1, c = tid >> 1;
            *(u32x4*)(VNT + ((size_t)bb * GW + c) * S + s0 + hf * 8) = *(const u32x4*)(tvn + c * 16 + hf * 8);
        }
        for (int idx = tid; idx < 16 * 256; idx += NTHREADS) {
            const int i = idx >> 8, j = idx & 255, rc = 1152 + j;
            const float pv = win[i * RPROJ + rc], cv = win[(i + 1) * RPROJ + rc], nv = win[(i + 2) * RPROJ + rc];
            const float x = cv + mu0[rc] * (pv - cv) + mu1[rc] * (nv - cv);
            lin[i * LIN + j] = (bf16_t)f2bf(j < 64 ? ftanh(x) : (j < 128 ? x : sigmoidf_(x)));
        }
        __syncthreads();
        for (int rep_ = 0; rep_ < (MK_PROBE == 1 ? 2 : 1); ++rep_) {
#pragma unroll 1
            for (int qg = 0; qg < 3; ++qg) {
                bf16x8 bw_[5][4]; float bias_[5];
#pragma unroll
                for (int q5 = 0; q5 < 5; ++q5) {
                    const int nt = wave * 15 + qg * 5 + q5, grp = nt / 24, c = (nt % 24) * 16 + col;
                    const bf16_t* bw = LWT + (size_t)(nt * 16 + col) * 128 + 8 * g;
#pragma unroll
                    for (int ks = 0; ks < 4; ++ks) bw_[q5][ks] = *(const bf16x8*)(bw + ks * 32);
                    bias_[q5] = grp < 2 ? w0[grp * RW + c] : (grp < 4 ? a0[(grp - 2) * RW + c] : 0.f);
                }
#pragma unroll
                for (int q5 = 0; q5 < 5; ++q5) {
                    const int nt = wave * 15 + qg * 5 + q5, grp = nt / 24, c = (nt % 24) * 16 + col;
                    const int kcol = grp < 2 ? 0 : (grp < 4 ? 64 : 128);
                    f32x4 acc = (f32x4){0.f, 0.f, 0.f, 0.f};
#pragma unroll
                    for (int ks = 0; ks < 2; ++ks) acc = MFMA16(*(const bf16x8*)(lin + col * LIN + kcol + ks * 32 + 8 * g), bw_[q5][ks], acc);
                    if (grp == 4) {
#pragma unroll
                        for (int ks = 2; ks < 4; ++ks) acc = MFMA16(*(const bf16x8*)(lin + col * LIN + kcol + ks * 32 + 8 * g), bw_[q5][ks], acc);
                    }
                    if (grp < 2) {
#pragma unroll
                        for (int r = 0; r < 4; ++r) { const float lw = -fexp(-softplusf_(-(acc[r] + bias_[q5])) - 0.5f); const size_t o = (size_t)grp * T * RW + (size_t)(t0 + 4 * g + r) * RW + c; LWG[o] = lw;
#if !MK_RWKV_CHUNKED
                            DEC[o] = expf(lw);
#endif
                        }
                    } else if (grp < 4) {
#pragma unroll
                        for (int r = 0; r < 4; ++r) ICLR[(size_t)(grp - 2) * T * RW + (size_t)(t0 + 4 * g + r) * RW + c] = sigmoidf_(acc[r] + bias_[q5]);
                    } else {
#pragma unroll
                        for (int r = 0; r < 4; ++r) GATE[(size_t)(t0 + 4 * g + r) * RW + c] = acc[r];
                    }
                }
            }
        }
        __syncthreads();
        for (int rep_ = 0; rep_ < (MK_PROBE == 2 ? 2 : 1); ++rep_) if (wave < 6) {
            const int c = tid, h = wave;
            const float kkc = k_k[c], kac = k_a[c], rkc = r_k[c];
            const float m0r = mu0[c], m1r = mu1[c], m0k = mu0[RW + c], m1k = mu1[RW + c], m0v = mu0[2 * RW + c], m1v = mu1[2 * RW + c];
            float ic0[16], ic1[16];
#pragma unroll
            for (int i = 0; i < 16; ++i) { const size_t o = (size_t)(t0 + i) * RW + c; ic0[i] = ICLR[o]; ic1[i] = ICLR[(size_t)T * RW + o]; }
#pragma unroll
            for (int i = 0; i < 16; ++i) {
                const int t = t0 + i;
                const float* w_ = win + i * RPROJ + c;
                const float rp = w_[0], rc_ = w_[RPROJ], rn = w_[2 * RPROJ];
                const float kp = w_[RW], kc_ = w_[RPROJ + RW], kn = w_[2 * RPROJ + RW];
                const float vp = w_[2 * RW], vc_ = w_[RPROJ + 2 * RW], vn = w_[2 * RPROJ + 2 * RW];
                const float r = rc_ + m0r * (rp - rc_) + m1r * (rn - rc_);
                const float k = kc_ + m0k * (kp - kc_) + m1k * (kn - kc_);
                const float v = vc_ + m0v * (vp - vc_) + m1v * (vn - vc_);
                const size_t o = (size_t)t * RW + c;
                const float kq = k * kkc;
                const float n2 = wave_sum_fast(kq * kq, lane);
                const float kk = kq / fmaxf(sqrtf(n2), 1e-12f);
                const float kd0 = k * (1.0f + (ic0[i] - 1.0f) * kac), kd1 = k * (1.0f + (ic1[i] - 1.0f) * kac);
                const float bon = wave_sum_fast(r * (kd0 + kd1) * rkc, lane);
                RR[o] = r; VV[o] = v; KK[o] = kk;
                KD[o] = kd0; KD[(size_t)T * RW + o] = kd1;
                if (lane == 0) BONUS[(size_t)t * RH + h] = bon;
#if !MK_RWKV_CHUNKED
                { const float br0 = wave_sum(kk * ic0[i] * r, lane), br1 = wave_sum(kk * ic1[i] * r, lane), kr0 = wave_sum(kd0 * r, lane), kr1 = wave_sum(kd1 * r, lane);
                  if (lane == 0) { BRKR[((size_t)t * RH + h) * 2] = br0; BRKR[((size_t)t * RH + h) * 2 + 1] = kr0; BRKR[((size_t)(T + t) * RH + h) * 2] = br1; BRKR[((size_t)(T + t) * RH + h) * 2 + 1] = kr1; } }
#endif
            }
        }
        __syncthreads();
        {
            f32x4 wb[9], vb[3];
            const int rsel = tid >= 192 ? 1 : 0, c4 = tid - rsel * 192;
#pragma unroll
            for (int it = 0; it < 9; ++it) {
                const int row = 2 * it + rsel, sq = s0 - 1 + row;
                wb[it] = (f32x4){0.f, 0.f, 0.f, 0.f};
                if (tid < 384 && sq >= 0 && sq < S) wb[it] = *(const f32x4*)(proj + (size_t)(t0 - 1 + row) * PLD + C_MW + c4 * 4);
            }
#pragma unroll
            for (int it = 0; it < 3; ++it) { const int idx = tid + it * NTHREADS, i = idx / 96, cc = (idx % 96) * 4; vb[it] = *(const f32x4*)(proj + (size_t)(t0 + i) * PLD + C_MW + 2 * MW + cc); }
            if (tid < 384) {
#pragma unroll
                for (int it = 0; it < 9; ++it) *(f32x4*)(win + (2 * it + rsel) * 768 + c4 * 4) = wb[it];
            }
#pragma unroll
            for (int it = 0; it < 3; ++it) { const int idx = tid + it * NTHREADS, i = idx / 96, cc = (idx % 96) * 4; const f32x4 v = vb[it];
                tv[(cc + 0) * 16 + i] = (bf16_t)f2bf(v.x); tv[(cc + 1) * 16 + i] = (bf16_t)f2bf(v.y); tv[(cc + 2) * 16 + i] = (bf16_t)f2bf(v.z); tv[(cc + 3) * 16 + i] = (bf16_t)f2bf(v.w); }
        }
        for (int idx = tid; idx < 16 * 24; idx += NTHREADS) {
            const int i = idx / 24, gi = idx % 24, t = t0 + i;
            const int isf = gi / 12, dir = (gi / 6) & 1, h = gi % 6;
            const float gg = proj[(size_t)t * PLD + 3456 + gi] + gate_b[gi];
            if (isf) LF[((size_t)dir * T + t) * MH + h] = -softplusf_(-gg); else IG[((size_t)dir * T + t) * MH + h] = gg;
        }
        __syncthreads();
        for (int rep_ = 0; rep_ < (MK_PROBE == 4 ? 2 : 1); ++rep_)
        for (int idx = tid; idx < 16 * 768; idx += NTHREADS) {
            const int i = idx / 768, c = idx % 768, t = t0 + i;
            const float* w_ = win + i * 768 + c;
            float y = conv_b[c] + w_[0] * conv_w[c] + w_[768] * conv_w[768 + c] + w_[1536] * conv_w[2 * 768 + c];
            y = y * sigmoidf_(y);
            if (c < MW) MQB[(size_t)t * MW + c] = (bf16_t)f2bf(y);
            else { const bf16_t kb = (bf16_t)f2bf(y * 0.125f); MKB[(size_t)t * MW + (c - MW)] = kb; tk[(c - MW) * 16 + i] = kb; }
        }
        __syncthreads();
        for (int idx = tid; idx < 2 * MW * 2; idx += NTHREADS) {
            const int hf = idx & 1, c = (idx >> 1) % MW, which = idx / (2 * MW);
            const u32x4 val = *(const u32x4*)((which ? tv : tk) + c * 16 + hf * 8);
            bf16_t* dst = (which ? VT : KT) + ((size_t)(bb * MH) * 64 + c) * S + s0 + hf * 8;
            *(u32x4*)dst = val;
        }
    }
    __syncthreads();
}

__device__ __forceinline__ void phase_gmlp_mix(const Params& P, int l, unsigned char* smem, int wv, int bid, int nb) {
    PIN_S(bid); PIN_S(nb);
    ParamsPtr pp = PARAMS_PTR(P); PIN_S(pp); unsigned char* ws = pp->ws;
    const float* UG = (const float*)(ws + O_UG); const bf16_t* VNT = (const bf16_t*)(ws + O_VNT); bf16_t* GRP = (bf16_t*)(ws + O_GRP);
    const bf16_t* WSB = (const bf16_t*)(ws + O_WSB) + (size_t)l * GH * CH * CH; const float* gbs = pp->in[5] + (size_t)l * GH * CH;
    const int tid = phase_tid(wv), lane = tid & 63, wave = tid >> 6, col = lane & 15, g = lane >> 4;
    for (int u = bid; u < NB * NCH * GH; u += nb) {
        const int h = u % GH, c = (u / GH) % NCH, b = u / (GH * NCH);
        const int tok0 = b * S + c * CH;
        const bf16_t* wb = WSB + (size_t)h * CH * CH + (size_t)(wave * 16 + col) * CH + 8 * g;
        const bf16_t* vb = VNT + ((size_t)b * GW + h * 64 + col) * S + (size_t)c * CH + 8 * g;
        f32x4 acc[4];
#pragma unroll
        for (int et = 0; et < 4; ++et) acc[et] = (f32x4){0.f, 0.f, 0.f, 0.f};
#pragma unroll
        for (int ks = 0; ks < 4; ++ks) {
            const bf16x8 af = *(const bf16x8*)(wb + ks * 32);
#pragma unroll
            for (int et = 0; et < 4; ++et) acc[et] = MFMA16(af, *(const bf16x8*)(vb + (size_t)et * 16 * S + ks * 32), acc[et]);
        }
#pragma unroll
        for (int r = 0; r < 4; ++r) {
            const int p = wave * 16 + 4 * g + r; const size_t t = (size_t)(tok0 + p); const float bsv = gbs[h * CH + p];
#pragma unroll
            for (int et = 0; et < 4; ++et) { const int ch = h * 64 + et * 16 + col; GRP[t * D + ch] = (bf16_t)f2bf(UG[t * GW + ch] * (acc[et][r] + bsv)); }
        }
    }
}

constexpr int SC_STEPS = 16;
constexpr int SC_BUF = SC_STEPS * 6 * 64;
__device__ __forceinline__ void phase_rwkv_scan(const Params& P, int l, unsigned char* smem, int wv, int bid, int nb) {
    PIN_S(bid); PIN_S(nb);
    ParamsPtr pp = PARAMS_PTR(P); PIN_S(pp); unsigned char* ws = pp->ws;
    const float* RR = (const float*)(ws + O_RR); const float* VV = (const float*)(ws + O_VV); const float* KK = (const float*)(ws + O_KK);
    const float* DEC = (const float*)(ws + O_DEC); const float* KD = (const float*)(ws + O_KD); const float* ICLR = (const float*)(ws + O_ICLR);
    float* SCAN = (float*)(ws + O_SCAN); const float* BRKR = (const float*)(ws + O_BRKR);
    const int tid = phase_tid(wv), lane = tid & 63, wave = tid >> 6, rl = (lane >> 4) & 1, kq = (lane & 15) | ((lane >> 5) << 4);
    float* buf = (float*)smem;
    float* scal = buf + 2 * SC_BUF;
    float* outb = scal + 2 * SC_STEPS * 2;
    typedef float f32x2 __attribute__((ext_vector_type(2)));
    for (int u = bid; u < 2 * NB * RH * 4; u += nb) {
        const int qt = u & 3, h = (u >> 2) % RH, b = (u / (4 * RH)) % NB, d = u / (4 * RH * NB);
        const size_t doff = (size_t)d * T * RW;
        float s0 = 0.f, s1 = 0.f;
        float pw[2], pa[2], pb[2], pk[2], pr[2], pv[2], psc = 0.f;
#define SC_LOAD(c) do { _Pragma("unroll") for (int i = 0; i < 2; ++i) { const int idx = tid + NTHREADS * i, st = idx >> 6, k = idx & 63; const int tau = (c) * SC_STEPS + st, sq = d ? S - 1 - tau : tau; \
            const size_t o = (size_t)(b * S + sq) * RW + h * 64 + k; \
            pw[i] = DEC[doff + o]; pa[i] = KK[o]; pb[i] = ICLR[doff + o]; pk[i] = KD[doff + o]; pr[i] = RR[o]; pv[i] = VV[o]; }     \
            if (tid < 2 * SC_STEPS) { const int tau = (c) * SC_STEPS + (tid >> 1), sq = d ? S - 1 - tau : tau; psc = BRKR[((size_t)(d * T + b * S + sq) * RH + h) * 2 + (tid & 1)]; } } while (0)
#define SC_WRITE(c) do { float* B_ = buf + ((c) & 1) * SC_BUF; _Pragma("unroll") for (int i = 0; i < 2; ++i) { const int idx = tid + NTHREADS * i, st = idx >> 6, k = idx & 63; \
            float* q_ = B_ + st * 384 + k; q_[0] = pw[i]; q_[64] = -pa[i]; q_[128] = pa[i] * pb[i]; q_[192] = pk[i]; q_[256] = pw[i] * pr[i]; q_[320] = pv[i]; } \
            if (tid < 2 * SC_STEPS) scal[((c) & 1) * SC_STEPS * 2 + tid] = psc; } while (0)
        __syncthreads();
        SC_LOAD(0); SC_WRITE(0);
        __syncthreads();
        const int row = qt * 16 + wave * 2 + rl;
        for (int c = 0; c < S / SC_STEPS; ++c) {
            const bool more = (c + 1) < S / SC_STEPS;
            if (more) SC_LOAD(c + 1);
            const float* B = buf + (c & 1) * SC_BUF; const float* sc = scal + (c & 1) * SC_STEPS * 2; float* ob = outb + (c & 1) * SC_STEPS * 16;
            float outs[SC_STEPS];
            f32x2 w2 = *(const f32x2*)(B + 2 * kq), a2 = *(const f32x2*)(B + 64 + 2 * kq), b2 = *(const f32x2*)(B + 128 + 2 * kq);
            f32x2 k2 = *(const f32x2*)(B + 192 + 2 * kq), wr2 = *(const f32x2*)(B + 256 + 2 * kq);
            float v = B[320 + row]; float br = sc[0], kr = sc[1];
#pragma unroll
            for (int st = 0; st < SC_STEPS; ++st) {
                const int sn = st + 1 < SC_STEPS ? st + 1 : st;
                const float* q = B + sn * 384;
                const f32x2 nw2 = *(const f32x2*)(q + 2 * kq), na2 = *(const f32x2*)(q + 64 + 2 * kq), nb2 = *(const f32x2*)(q + 128 + 2 * kq);
                const f32x2 nk2 = *(const f32x2*)(q + 192 + 2 * kq), nwr2 = *(const f32x2*)(q + 256 + 2 * kq);
                const float nv = q[320 + row], nbr = sc[sn * 2], nkr = sc[sn * 2 + 1];
                SCHED_BAR();
                float sa = s0 * a2.x + s1 * a2.y;
                float po = s0 * wr2.x + s1 * wr2.y;
                sa = row32_sum(sa); po = row32_sum(po);
                outs[st] = po + sa * br + v * kr;
                s0 = s0 * w2.x + (sa * b2.x + v * k2.x); s1 = s1 * w2.y + (sa * b2.y + v * k2.y);
                SCHED_BAR();
                w2 = nw2; a2 = na2; b2 = nb2; k2 = nk2; wr2 = nwr2; v = nv; br = nbr; kr = nkr;
            }
            if (kq == 0) {
#pragma unroll
                for (int st = 0; st < SC_STEPS; ++st) ob[st * 16 + wave * 2 + rl] = outs[st];
            }
            if (more) SC_WRITE(c + 1);
            __syncthreads();
            if (tid < 16 * SC_STEPS) {
                const int st = tid >> 4, r = tid & 15, tau = c * SC_STEPS + st, sq = d ? S - 1 - tau : tau;
                SCAN[doff + (size_t)(b * S + sq) * RW + h * 64 + qt * 16 + r] = ob[st * 16 + r];
            }
        }
#undef SC_LOAD
#undef SC_WRITE
    }
    __syncthreads();
}

constexpr int RST = 72;
constexpr int RARR = 64 * RST;
__device__ __forceinline__ f32x4 tile_nt(const bf16_t* Aa, int ta, const bf16_t* Ba, int tb, f32x4 acc, int col, int g) {
#pragma unroll
    for (int ks = 0; ks < 2; ++ks) {
        const bf16x8 af = *(const bf16x8*)(Aa + (ta * 16 + col) * RST + ks * 32 + 8 * g);
        const bf16x8 bfr = *(const bf16x8*)(Ba + (tb * 16 + col) * RST + ks * 32 + 8 * g);
        acc = MFMA16(af, bfr, acc);
    }
    return acc;
}
__device__ __forceinline__ void phase_rwkv_pre(const Params& P, int l, unsigned char* smem, int wv) {
    ParamsPtr pp = PARAMS_PTR(P); PIN_S(pp); unsigned char* ws = pp->ws; int bidx = (int)blockIdx.x, gdim = (int)gridDim.x; PIN_S(bidx); PIN_S(gdim);
    const float* RR = (const float*)(ws + O_RR); const float* VV = (const float*)(ws + O_VV); const float* KK = (const float*)(ws + O_KK);
    const float* LWG = (const float*)(ws + O_LW); const float* KD = (const float*)(ws + O_KD); const float* ICLR = (const float*)(ws + O_ICLR);
    bf16_t* Qg = (bf16_t*)(ws + O_RQ); bf16_t* Ag = (bf16_t*)(ws + O_RA); float* Hg = (float*)(ws + O_RH); float* Gg = (float*)(ws + O_RG);
    const int tid0 = phase_tid(wv);
#define RW_STAGE_VARS int tid = tid0; PIN_V(tid); const int lane = tid & 63, wave = tid >> 6, col = lane & 15, g = lane >> 4; (void)lane; (void)wave; (void)col; (void)g;
    bf16_t* At = (bf16_t*)smem; bf16_t* Bt = At + RARR; bf16_t* Kt = Bt + RARR; bf16_t* Rt = Kt + RARR;
    bf16_t* BtT = Rt + RARR; bf16_t* KtT = BtT + RARR; bf16_t* VT = KtT + RARR;
    bf16_t* Lak = VT + RARR; bf16_t* Mrb = Lak + RARR; bf16_t* Mrk = Mrb + RARR; bf16_t* YT = Mrk + RARR; bf16_t* W2T = YT + RARR;
    float* LabT = (float*)(W2T + RARR);
    float* ZsB = LabT + 4096;
    float* segs = ZsB + 8192;
    float* PC = segs + 512;
    for (int u = bidx; u < RUN; u += gdim) {
        const int c = u % RNC, h = (u / RNC) % RH, b = (u / (RNC * RH)) % NB, d = u / (RNC * RH * NB);
        const size_t doff = (size_t)d * T * RW;
        __syncthreads();
        {
            RW_STAGE_VARS
            const int ch = tid & 63, sg = tid >> 6;
            float lw[8], kk[8], ic[8], kd[8], rr[8], vv[8];
#pragma unroll
            for (int j = 0; j < 8; ++j) {
                const int tau = c * RC + sg * 8 + j, sq = d ? S - 1 - tau : tau; const size_t o = (size_t)(b * S + sq) * RW + h * 64 + ch;
                lw[j] = LWG[doff + o]; kk[j] = KK[o]; ic[j] = ICLR[doff + o]; kd[j] = KD[doff + o]; rr[j] = RR[o]; vv[j] = VV[o];
            }
            float run = 0.f;
#pragma unroll
            for (int j = 0; j < 8; ++j) { run += lw[j]; lw[j] = run; }
            segs[sg * 64 + ch] = run;
            __syncthreads();
            float off = 0.f;
            for (int q = 0; q < sg; ++q) off += segs[q * 64 + ch];
            u32x4 pbt, pkt, pvt; unsigned tb[8], tk[8], tvv[8];
            float prev = off;
#pragma unroll
            for (int j = 0; j < 8; ++j) {
                const int t = sg * 8 + j; const float cl = off + lw[j];
                const float ep = fexp(prev), en = fexp(-cl), epc = fexp(cl);
                const unsigned a_ = f2bf(-kk[j] * ep), b_ = f2bf(kk[j] * ic[j] * en), k_ = f2bf(kd[j] * en), r_ = f2bf(rr[j] * epc), v_ = f2bf(vv[j]);
                At[t * RST + ch] = (bf16_t)a_; Bt[t * RST + ch] = (bf16_t)b_; Kt[t * RST + ch] = (bf16_t)k_; Rt[t * RST + ch] = (bf16_t)r_;
                tb[j] = b_; tk[j] = k_; tvv[j] = v_;
                prev = cl;
            }
            if (sg == 7) PC[ch] = fexp(prev);
            pbt.x = tb[0] | (tb[1] << 16); pbt.y = tb[2] | (tb[3] << 16); pbt.z = tb[4] | (tb[5] << 16); pbt.w = tb[6] | (tb[7] << 16);
            pkt.x = tk[0] | (tk[1] << 16); pkt.y = tk[2] | (tk[3] << 16); pkt.z = tk[4] | (tk[5] << 16); pkt.w = tk[6] | (tk[7] << 16);
            pvt.x = tvv[0] | (tvv[1] << 16); pvt.y = tvv[2] | (tvv[3] << 16); pvt.z = tvv[4] | (tvv[5] << 16); pvt.w = tvv[6] | (tvv[7] << 16);
            *(u32x4*)(BtT + ch * RST + sg * 8) = pbt; *(u32x4*)(KtT + ch * RST + sg * 8) = pkt; *(u32x4*)(VT + ch * RST + sg * 8) = pvt;
        }
        __syncthreads();
        {
            RW_STAGE_VARS
            const int m = wave >> 1;
            const bf16_t* Ym = (m == 0 || m == 2) ? Bt : Kt; const bf16_t* Xm = (m < 2) ? At : Rt;
#pragma unroll 1
            for (int q = 0; q < 8; ++q) {
                const int tix = (wave & 1) * 8 + q, it = tix >> 2, tt = tix & 3;
                f32x4 acc = (f32x4){0.f, 0.f, 0.f, 0.f};
                if (it <= tt) acc = tile_nt(Ym, it, Xm, tt, acc, col, g);
                const int t = tt * 16 + col, i0 = it * 16 + 4 * g;
                float o4[4];
#pragma unroll
                for (int r = 0; r < 4; ++r) { const int i = i0 + r; const bool ok = m < 2 ? (i < t) : (i <= t); o4[r] = ok ? acc[r] : 0.f; }
                if (m == 0) {
#pragma unroll
                    for (int r = 0; r < 4; ++r) LabT[(i0 + r) * 64 + t] = o4[r];
                }
                else { bf16_t* dst = (m == 1 ? Lak : (m == 2 ? Mrb : Mrk)) + t * RST + i0; u32x2 w2; w2.x = pk2(o4[0], o4[1]); w2.y = pk2(o4[2], o4[3]); *(u32x2*)dst = w2; }
            }
        }
        __syncthreads();
        {
            RW_STAGE_VARS
#pragma unroll
            for (int q = 0; q < 2; ++q) {
                const int tix = wave * 2 + q, tt = tix >> 2, et = tix & 3;
                f32x4 acc = (f32x4){0.f, 0.f, 0.f, 0.f};
                acc = tile_nt(Lak, tt, VT, et, acc, col, g);
#pragma unroll
                for (int r = 0; r < 4; ++r) ZsB[4096 + (tt * 16 + 4 * g + r) * 64 + et * 16 + col] = acc[r];
            }
#pragma unroll
            for (int q = 0; q < 8; ++q) { const int idx = tid + NTHREADS * q; ZsB[idx] = bf_lo((unsigned)At[(idx >> 6) * RST + (idx & 63)]); }
        }
        __syncthreads();
        {
            RW_STAGE_VARS
            if (wave < 2) {
                float* Zs = ZsB + wave * 4096 + lane;
                bf16_t* dst = (wave == 0 ? YT : W2T) + lane * RST;
#pragma unroll 1
                for (int bb = 0; bb < 4; ++bb) {
                    float acc[16];
#pragma unroll
                    for (int r = 0; r < 16; ++r) acc[r] = Zs[(16 * bb + r) * 64];
#pragma unroll 2
                    for (int i = 0; i < 16 * bb; ++i) {
                        const float z = Zs[i * 64];
                        const float* lp = LabT + i * 64 + 16 * bb;
                        const f32x4 l0 = *(const f32x4*)lp, l1 = *(const f32x4*)(lp + 4), l2 = *(const f32x4*)(lp + 8), l3 = *(const f32x4*)(lp + 12);
                        acc[0] += l0.x * z; acc[1] += l0.y * z; acc[2] += l0.z * z; acc[3] += l0.w * z;
                        acc[4] += l1.x * z; acc[5] += l1.y * z; acc[6] += l1.z * z; acc[7] += l1.w * z;
                        acc[8] += l2.x * z; acc[9] += l2.y * z; acc[10] += l2.z * z; acc[11] += l2.w * z;
                        acc[12] += l3.x * z; acc[13] += l3.y * z; acc[14] += l3.z * z; acc[15] += l3.w * z;
                    }
                    const float* dp = LabT + (16 * bb) * 64 + 16 * bb;
#pragma unroll
                    for (int r = 1; r < 16; ++r)
#pragma unroll
                        for (int r2 = 0; r2 < r; ++r2) acc[r] += dp[r2 * 64 + r] * acc[r2];
#pragma unroll
                    for (int r = 0; r < 16; ++r) Zs[(16 * bb + r) * 64] = acc[r];
                    u32x4 w0, w1;
                    w0.x = pk2(acc[0], acc[1]); w0.y = pk2(acc[2], acc[3]); w0.z = pk2(acc[4], acc[5]); w0.w = pk2(acc[6], acc[7]);
                    w1.x = pk2(acc[8], acc[9]); w1.y = pk2(acc[10], acc[11]); w1.z = pk2(acc[12], acc[13]); w1.w = pk2(acc[14], acc[15]);
                    *(u32x4*)(dst + 16 * bb) = w0; *(u32x4*)(dst + 16 * bb + 8) = w1;
                }
            }
        }
        __syncthreads();
        {
            RW_STAGE_VARS
            const int ty = wave >> 1;
#pragma unroll 1
            for (int q = 0; q < 8; ++q) {
                const int tix = (wave & 1) * 8 + q, ra = tix >> 2, cb = tix & 3;
                f32x4 acc = (f32x4){0.f, 0.f, 0.f, 0.f};
                if (ty == 0) {
                    acc = tile_nt(Mrb, ra, YT, cb, acc, col, g);
#pragma unroll
                    for (int r = 0; r < 4; ++r) { const int t = ra * 16 + 4 * g + r, k = cb * 16 + col; Qg[(size_t)u * 4096 + t * 64 + k] = (bf16_t)f2bf(acc[r] + bf_lo((unsigned)Rt[t * RST + k])); }
                } else if (ty == 1) {
                    acc = tile_nt(Mrb, ra, W2T, cb, acc, col, g); acc = tile_nt(Mrk, ra, VT, cb, acc, col, g);
                    *(f32x4*)(Hg + (size_t)u * 4096 + (tix * 64 + lane) * 4) = acc;
                } else if (ty == 2) {
                    acc = tile_nt(BtT, ra, YT, cb, acc, col, g);
#pragma unroll
                    for (int r = 0; r < 4; ++r) { const int k1 = ra * 16 + 4 * g + r, k = cb * 16 + col; Ag[(size_t)u * 4096 + k1 * 64 + k] = (bf16_t)f2bf(PC[k1] * (acc[r] + (k1 == k ? 1.0f : 0.f))); }
                } else {
                    acc = tile_nt(BtT, ra, W2T, cb, acc, col, g); acc = tile_nt(KtT, ra, VT, cb, acc, col, g);
#pragma unroll
                    for (int r = 0; r < 4; ++r) acc[r] *= PC[ra * 16 + 4 * g + r];
                    *(f32x4*)(Gg + (size_t)u * 4096 + (tix * 64 + lane) * 4) = acc;
                }
            }
        }
    }
    __syncthreads();
#undef RW_STAGE_VARS
}
__device__ __forceinline__ void phase_rwkv_seq(const Params& P, int l, unsigned char* smem, int wv) {
    ParamsPtr pp = PARAMS_PTR(P); PIN_S(pp); unsigned char* ws = pp->ws; int bidx = (int)blockIdx.x, gdim = (int)gridDim.x; PIN_S(bidx); PIN_S(gdim);
    const bf16_t* Ag = (const bf16_t*)(ws + O_RA); const float* Gg = (const float*)(ws + O_RG); bf16_t* Sg = (bf16_t*)(ws + O_RS);
    const int tid = phase_tid(wv), lane = tid & 63, wave = tid >> 6, col = lane & 15, g = lane >> 4;
    const int gw = wave * gdim + bidx, ngw = NWAVES * gdim;
    for (int un = gw; un < 2 * NB * RH * 2; un += ngw) {
        const int ch = un >> 1, eh = un & 1;
        f32x4 acc[4][2];
#pragma unroll
        for (int a_ = 0; a_ < 4; ++a_)
#pragma unroll
            for (int b_ = 0; b_ < 2; ++b_) acc[a_][b_] = (f32x4){0.f, 0.f, 0.f, 0.f};
        u32x2 alo[4][2], ahi[4][2]; f32x4 gq[4][2];
        const unsigned aoff = (unsigned)(col * 64 + 4 * g), goff = (unsigned)(lane * 4);
#define RS_LOAD(cc) do { const bf16_t* ab_ = Ag + (size_t)(ch * RNC + (cc)) * 4096; const float* gb_ = Gg + (size_t)(ch * RNC + (cc)) * 4096 + eh * 512; \
            _Pragma("unroll") for (int ra = 0; ra < 4; ++ra) _Pragma("unroll") for (int p = 0; p < 2; ++p) { alo[ra][p] = *(const u32x2*)(ab_ + (ra * 1024 + p * 32) + aoff); ahi[ra][p] = *(const u32x2*)(ab_ + (ra * 1024 + p * 32 + 16) + aoff); } \
            _Pragma("unroll") for (int ra = 0; ra < 4; ++ra) _Pragma("unroll") for (int cb = 0; cb < 2; ++cb) gq[ra][cb] = *(const f32x4*)(gb_ + ((ra * 4 + cb) * 256) + goff); } while (0)
        RS_LOAD(0);
#pragma unroll 1
        for (int c = 0; c < RNC; ++c) {
            bf16_t* sb_ = Sg + (size_t)(ch * RNC + c) * 4096 + eh * 2048;
            bf16x8 bq[2][2];
#pragma unroll
            for (int cb = 0; cb < 2; ++cb) {
#pragma unroll
                for (int ra = 0; ra < 4; ++ra) {
                    u32x2 w2; w2.x = pk2(acc[ra][cb][0], acc[ra][cb][1]); w2.y = pk2(acc[ra][cb][2], acc[ra][cb][3]);
                    *(u32x2*)(sb_ + (cb * 1024 + ra * 16) + aoff) = w2;
                }
#pragma unroll
                for (int p = 0; p < 2; ++p) bq[p][cb] = cvt8(acc[2 * p][cb], acc[2 * p + 1][cb]);
            }
            u32x4 af[4][2];
#pragma unroll
            for (int ra = 0; ra < 4; ++ra) {
#pragma unroll
                for (int p = 0; p < 2; ++p) af[ra][p] = (u32x4){alo[ra][p].x, alo[ra][p].y, ahi[ra][p].x, ahi[ra][p].y};
#pragma unroll
                for (int cb = 0; cb < 2; ++cb) acc[ra][cb] = gq[ra][cb];
            }
            if (c + 1 < RNC) RS_LOAD(c + 1);
#pragma unroll
            for (int ra = 0; ra < 4; ++ra)
#pragma unroll
                for (int cb = 0; cb < 2; ++cb)
#pragma unroll
                    for (int p = 0; p < 2; ++p) acc[ra][cb] = MFMA16(__builtin_bit_cast(bf16x8, af[ra][p]), bq[p][cb], acc[ra][cb]);
        }
#undef RS_LOAD
    }
}
__device__ __forceinline__ void phase_rwkv_out(const Params& P, int l, unsigned char* smem, int wv) {
    ParamsPtr pp = PARAMS_PTR(P); PIN_S(pp); unsigned char* ws = pp->ws; int bidx = (int)blockIdx.x, gdim = (int)gridDim.x; PIN_S(bidx); PIN_S(gdim);
    const bf16_t* Qg = (const bf16_t*)(ws + O_RQ); const bf16_t* Sg = (const bf16_t*)(ws + O_RS); const float* Hg = (const float*)(ws + O_RH);
    const float* VV = (const float*)(ws + O_VV); const float* GATE = (const float*)(ws + O_GATE); const float* BONUS = (const float*)(ws + O_BONUS);
    bf16_t* GRP = (bf16_t*)(ws + O_GRP);
    const float* rln_g = pp->in[15] + (size_t)l * RW; const float* rln_b = pp->in[16] + (size_t)l * RW;
    const int tid = phase_tid(wv), lane = tid & 63, wave = tid >> 6, col = lane & 15, g = lane >> 4;
    for (int pu = bidx * NWAVES + wave; pu < NB * RH * RNC; pu += gdim * NWAVES) {
        const int c = pu % RNC, h = (pu / RNC) % RH, b = pu / (RNC * RH);
        f32x4 o[2][4][4];
#pragma unroll
        for (int d = 0; d < 2; ++d) {
            const int u = ((d * NB + b) * RH + h) * RNC + (d ? RNC - 1 - c : c);
            const size_t ub = (size_t)u * 4096;
            bf16x8 qa[4][2], sb[4][2];
#pragma unroll
            for (int q = 0; q < 4; ++q)
#pragma unroll
                for (int ks = 0; ks < 2; ++ks) { qa[q][ks] = *(const bf16x8*)(Qg + ub + (q * 16 + col) * 64 + ks * 32 + 8 * g); sb[q][ks] = *(const bf16x8*)(Sg + ub + (q * 16 + col) * 64 + ks * 32 + 8 * g); }
#pragma unroll
            for (int tt = 0; tt < 4; ++tt)
#pragma unroll
                for (int et = 0; et < 4; ++et) {
                    f32x4 acc = *(const f32x4*)(Hg + ub + ((tt * 4 + et) * 64 + lane) * 4);
#pragma unroll
                    for (int ks = 0; ks < 2; ++ks) acc = MFMA16(qa[tt][ks], sb[et][ks], acc);
                    o[d][tt][et] = acc;
                }
        }
        const int src = (3 - g) * 16 + col;
#pragma unroll
        for (int tt = 0; tt < 4; ++tt)
#pragma unroll
            for (int et = 0; et < 4; ++et)
#pragma unroll
                for (int r = 0; r < 4; ++r) o[0][tt][et][r] += SHL(o[1][3 - tt][et][3 - r], src);
#pragma unroll
        for (int tt = 0; tt < 4; ++tt)
#pragma unroll
            for (int r = 0; r < 4; ++r) {
                float sm = (o[0][tt][0][r] + o[0][tt][1][r]) + (o[0][tt][2][r] + o[0][tt][3][r]);
                sm = row16_sum(sm);
                const float mean = sm * (1.0f / 64.0f);
                float q = 0.f;
#pragma unroll
                for (int et = 0; et < 4; ++et) { const float dl = o[0][tt][et][r] - mean; q += dl * dl; }
                q = row16_sum(q);
                const float rstd = 1.0f / sqrtf(q * (1.0f / 64.0f) + GN_EPS);
                const size_t t = (size_t)(b * S + c * RC + tt * 16 + 4 * g + r);
                const float bon = BONUS[t * RH + h];
#pragma unroll
                for (int et = 0; et < 4; ++et) {
                    const int ch = h * 64 + et * 16 + col;
                    float y = (o[0][tt][et][r] - mean) * rstd * rln_g[ch] + rln_b[ch];
                    y += bon * VV[t * RW + ch];
                    GRP[t * D + GW + ch] = (bf16_t)f2bf(y * GATE[t * RW + ch]);
                }
            }
    }
}

__device__ __forceinline__ void phase_mlstm_local(const Params& P, int l, unsigned char* smem, int wv, int bid, int nb) {
    PIN_S(bid); PIN_S(nb);
    ParamsPtr pp = PARAMS_PTR(P); PIN_S(pp); unsigned char* ws = pp->ws;
    const bf16_t* KT = (const bf16_t*)(ws + O_KT); const bf16_t* VT = (const bf16_t*)(ws + O_VT);
    const float* IG = (const float*)(ws + O_IG); const float* LF = (const float*)(ws + O_LF);
    float* CL = (float*)(ws + O_CL); float* NLb = (float*)(ws + O_NL); float* ML = (float*)(ws + O_ML); float* BL = (float*)(ws + O_BL);
    float* GVT = (float*)(ws + O_GVT); float* PMX = (float*)(ws + O_PMX); float* BCT = (float*)(ws + O_BCT);
    const int tid = phase_tid(wv), lane = tid & 63, wave = tid >> 6, col = lane & 15, g = lane >> 4;
    float* wts = (float*)smem + wave * 128;
    for (int u = bid * NWAVES + wave; u < 2 * NB * MH * NCH; u += nb * NWAVES) {
        const int c = u % NCH, h = (u / NCH) % MH, p = u / (NCH * MH), d = p / NB, b = p % NB;
        const int tc = d ? NCH - 1 - c : c, tok0 = b * S + tc * CH;
        const int i0 = d ? 127 - 2 * lane : 2 * lane, i1 = d ? i0 - 1 : i0 + 1;
        const size_t g0 = ((size_t)d * T + tok0 + i0) * MH + h, g1 = ((size_t)d * T + tok0 + i1) * MH + h;
        const float lf0 = LF[g0], lf1 = LF[g1], ig0 = IG[g0], ig1 = IG[g1];
        const float c1 = lf0 + lf1;
        float incl = c1;
#pragma unroll
        for (int o = 1; o < 64; o <<= 1) { const float tq = SHUP(incl, o, lane); if (lane >= o) incl += tq; }
        const float excl = incl - c1, bc0 = excl + lf0, bc1 = incl;
        const float blast = RDL(incl, 63);
        const float gv0 = ig0 - bc0, gv1 = ig1 - bc1, pl1 = fmaxf(gv0, gv1);
        float mincl = pl1;
#pragma unroll
        for (int o = 1; o < 64; o <<= 1) { const float tq = SHUP(mincl, o, lane); if (lane >= o) mincl = fmaxf(mincl, tq); }
        float mexcl = SHUP(mincl, 1, lane); if (lane == 0) mexcl = -INFINITY;
        const float pm0 = fmaxf(mexcl, gv0), pm1 = mincl;
        const float mloc = blast + RDL(mincl, 63);
        WAVE_SYNC();
        wts[i0] = fexp(blast + gv0 - mloc); wts[i1] = fexp(blast + gv1 - mloc);
        GVT[g0] = gv0; GVT[g1] = gv1; PMX[g0] = pm0; PMX[g1] = pm1; BCT[g0] = bc0; BCT[g1] = bc1;
        if (lane == 0) { ML[u] = mloc; BL[u] = blast; }
        WAVE_SYNC();
        const bf16_t* vbase = VT + ((size_t)(b * MH + h) * 64) * S + (size_t)tc * CH;
        const bf16_t* kbase = KT + ((size_t)(b * MH + h) * 64) * S + (size_t)tc * CH;
        const unsigned loff = (unsigned)(col * S + 8 * g);
        f32x4 acc[4][4];
#pragma unroll
        for (int a_ = 0; a_ < 4; ++a_)
#pragma unroll
            for (int b_ = 0; b_ < 4; ++b_) acc[a_][b_] = (f32x4){0.f, 0.f, 0.f, 0.f};
        float nsum[4] = {0.f, 0.f, 0.f, 0.f};
#pragma unroll 1
        for (int ks = 0; ks < 4; ++ks) {
            const int ii = ks * 32 + 8 * g;
            const f32x4 w0 = *(const f32x4*)(wts + ii), w1 = *(const f32x4*)(wts + ii + 4);
            bf16x8 af[4], bfk[4];
#pragma unroll
            for (int q = 0; q < 4; ++q) af[q] = *(const bf16x8*)(vbase + ((size_t)q * 16 * S + ks * 32) + loff);
#pragma unroll
            for (int q = 0; q < 4; ++q) {
                const u32x4 kr = *(const u32x4*)(kbase + ((size_t)q * 16 * S + ks * 32) + loff);
                f32x4 k0, k1;
                k0.x = bf_lo(kr.x) * w0.x; k0.y = bf_hi(kr.x) * w0.y; k0.z = bf_lo(kr.y) * w0.z; k0.w = bf_hi(kr.y) * w0.w;
                k1.x = bf_lo(kr.z) * w1.x; k1.y = bf_hi(kr.z) * w1.y; k1.z = bf_lo(kr.w) * w1.z; k1.w = bf_hi(kr.w) * w1.w;
                nsum[q] += (k0.x + k0.y) + (k0.z + k0.w) + (k1.x + k1.y) + (k1.z + k1.w);
                bfk[q] = cvt8(k0, k1);
            }
#pragma unroll
            for (int a_ = 0; a_ < 4; ++a_)
#pragma unroll
                for (int b_ = 0; b_ < 4; ++b_) acc[a_][b_] = MFMA16(af[a_], bfk[b_], acc[a_][b_]);
        }
        float* cbase = CL + (size_t)u * 4096;
        const unsigned coff = (unsigned)(4 * g * 64 + col);
#pragma unroll
        for (int b_ = 0; b_ < 4; ++b_) {
#pragma unroll
            for (int a_ = 0; a_ < 4; ++a_)
#pragma unroll
                for (int r = 0; r < 4; ++r) cbase[(a_ * 16 * 64 + r * 64 + b_ * 16) + coff] = acc[a_][b_][r];
            float ns = nsum[b_]; ns += SHX(ns, 16, lane); ns += SHX(ns, 32, lane);
            if (g == 0) NLb[(size_t)u * 64 + b_ * 16 + col] = ns;
        }
    }
    __syncthreads();
}

__device__ __forceinline__ void phase_mlstm_carry(const Params& P, int l, unsigned char* smem, int wv) {
    ParamsPtr pp = PARAMS_PTR(P); PIN_S(pp); unsigned char* ws = pp->ws; int bidx = (int)blockIdx.x, gdim = (int)gridDim.x; PIN_S(bidx); PIN_S(gdim);
    float* CL = (float*)(ws + O_CL); float* NLb = (float*)(ws + O_NL); const float* ML = (const float*)(ws + O_ML); const float* BL = (const float*)(ws + O_BL);
    float* MIN = (float*)(ws + O_MIN);
    const int total = 2 * NB * MH * 4160;
    const int tid = phase_tid(wv);
    for (int g = bidx * NTHREADS + tid; g < total; g += gdim * NTHREADS) {
        const int ph = g / 4160, e = g % 4160;
        float m = 0.f, val = 0.f;
        for (int c = 0; c < NCH; ++c) {
            const int base = ph * NCH + c;
            float* ptr = e < 4096 ? CL + (size_t)base * 4096 + e : NLb + (size_t)base * 64 + (e - 4096);
            const float loc = *ptr;
            *ptr = val;
            if (e == 0) MIN[base] = m;
            const float bl = BL[base], ml = ML[base];
            const float mn = fmaxf(bl + m, ml);
            val = expf(bl + m - mn) * val + expf(ml - mn) * loc;
            m = mn;
        }
    }
}

__device__ __forceinline__ void phase_mlstm_out(const Params& P, int l, unsigned char* smem, int wv) {
    ParamsPtr pp = PARAMS_PTR(P); PIN_S(pp); unsigned char* ws = pp->ws; int bidx = (int)blockIdx.x, gdim = (int)gridDim.x; PIN_S(bidx); PIN_S(gdim);
    const float* proj = (const float*)(ws + O_PROJ);
    const bf16_t* MQB = (const bf16_t*)(ws + O_MQB); const bf16_t* MKB = (const bf16_t*)(ws + O_MKB); const bf16_t* VT = (const bf16_t*)(ws + O_VT);
    const float* GVT = (const float*)(ws + O_GVT); const float* PMX = (const float*)(ws + O_PMX); const float* BCT = (const float*)(ws + O_BCT);
    const float* CL = (const float*)(ws + O_CL); const float* NLb = (const float*)(ws + O_NL); const float* MIN = (const float*)(ws + O_MIN);
    bf16_t* GRP = (bf16_t*)(ws + O_GRP);
    const float* mln_g = pp->in[20] + (size_t)l * MW;
    const int tid = phase_tid(wv), lane = tid & 63, wave = tid >> 6, col = lane & 15, g = lane >> 4;
    for (int u = bidx; u < NB * MH * NCH; u += gdim) {
        const int tc = u % NCH, h = (u / NCH) % MH, b = u / (NCH * MH);
        const int tok0 = b * S + tc * CH, it = wave * 16 + col;
        const size_t trow = (size_t)(tok0 + it);
        bf16x8 bq[2];
#pragma unroll
        for (int ks = 0; ks < 2; ++ks) bq[ks] = *(const bf16x8*)(MQB + trow * MW + h * 64 + ks * 32 + 8 * g);
        const size_t vrow = ((size_t)(b * MH + h) * 64) * S + (size_t)tc * CH;
        f32x4 hs[4];
#pragma unroll
        for (int et = 0; et < 4; ++et) hs[et] = (f32x4){0.f, 0.f, 0.f, 0.f};
#pragma unroll
        for (int d = 0; d < 2; ++d) {
            const int cd = d ? NCH - 1 - tc : tc;
            const int su = ((d * NB + b) * MH + h) * NCH + cd;
            const size_t gt = ((size_t)d * T + trow) * MH + h;
            const float mst = MIN[su];
            const float mxt = fmaxf(PMX[gt], mst), mt = BCT[gt] + mxt, wint = fexp(mst - mxt);
            f32x4 num[4];
#pragma unroll
            for (int et = 0; et < 4; ++et) num[et] = (f32x4){0.f, 0.f, 0.f, 0.f};
            float den = 0.f;
            for (int sp = 0; sp < 4; ++sp) {
                if (d == 0 ? (2 * sp > wave) : (2 * sp + 1 < wave)) continue;
                float pw[8];
#pragma unroll
                for (int hf = 0; hf < 2; ++hf) {
                    const int st = 2 * sp + hf;
                    f32x4 sacc = (f32x4){0.f, 0.f, 0.f, 0.f};
#pragma unroll
                    for (int ks = 0; ks < 2; ++ks) {
                        const bf16x8 kf = *(const bf16x8*)(MKB + (size_t)(tok0 + st * 16 + col) * MW + h * 64 + ks * 32 + 8 * g);
                        sacc = MFMA16(kf, bq[ks], sacc);
                    }
#pragma unroll
                    for (int r = 0; r < 4; ++r) {
                        const int is = st * 16 + 4 * g + r;
                        const bool ok = d == 0 ? (is <= it) : (is >= it);
                        const float gvs = GVT[((size_t)d * T + tok0 + is) * MH + h];
                        const float pr = ok ? sacc[r] * fexp(gvs - mxt) : 0.f;
                        den += pr; pw[hf * 4 + r] = pr;
                    }
                }
                u32x4 pb; pb.x = pk2(pw[0], pw[1]); pb.y = pk2(pw[2], pw[3]); pb.z = pk2(pw[4], pw[5]); pb.w = pk2(pw[6], pw[7]);
                const bf16x8 bp = __builtin_bit_cast(bf16x8, pb);
#pragma unroll
                for (int et = 0; et < 4; ++et) {
                    const bf16_t* vp = VT + vrow + (size_t)(et * 16 + col) * S + sp * 32 + 4 * g;
                    const u32x2 v0 = *(const u32x2*)vp, v1 = *(const u32x2*)(vp + 16);
                    u32x4 va; va.x = v0.x; va.y = v0.y; va.z = v1.x; va.w = v1.y;
                    num[et] = MFMA16(__builtin_bit_cast(bf16x8, va), bp, num[et]);
                }
            }
            den += SHX(den, 16, lane); den += SHX(den, 32, lane);
            f32x4 qc[4]; float qn = 0.f;
#pragma unroll
            for (int ks = 0; ks < 2; ++ks) {
                const float* np = NLb + (size_t)su * 64 + ks * 32 + 8 * g;
                const f32x4 n0 = *(const f32x4*)np, n1 = *(const f32x4*)(np + 4);
                const u32x4 qb = __builtin_bit_cast(u32x4, bq[ks]);
                qn += (bf_lo(qb.x) * n0.x + bf_hi(qb.x) * n0.y) + (bf_lo(qb.y) * n0.z + bf_hi(qb.y) * n0.w) + (bf_lo(qb.z) * n1.x + bf_hi(qb.z) * n1.y) + (bf_lo(qb.w) * n1.z + bf_hi(qb.w) * n1.w);
            }
            qn += SHX(qn, 16, lane); qn += SHX(qn, 32, lane);
#pragma unroll
            for (int et = 0; et < 4; ++et) {
                qc[et] = (f32x4){0.f, 0.f, 0.f, 0.f};
#pragma unroll
                for (int ks = 0; ks < 2; ++ks) {
                    const float* cp = CL + (size_t)su * 4096 + (size_t)(et * 16 + col) * 64 + ks * 32 + 8 * g;
                    qc[et] = MFMA16(cvt8(*(const f32x4*)cp, *(const f32x4*)(cp + 4)), bq[ks], qc[et]);
                }
            }
            const float dd = frcp(fmaxf(fabsf(den + wint * qn), fexp(-mt)));
#pragma unroll
            for (int et = 0; et < 4; ++et) hs[et] += (num[et] + wint * qc[et]) * dd;
        }
        float sm = 0.f;
#pragma unroll
        for (int et = 0; et < 4; ++et) sm += (hs[et].x + hs[et].y) + (hs[et].z + hs[et].w);
        sm += SHX(sm, 16, lane); sm += SHX(sm, 32, lane);
        const float mean = sm * (1.0f / 64.0f); float q = 0.f;
#pragma unroll
        for (int et = 0; et < 4; ++et) { const f32x4 dl = hs[et] - mean; q += (dl.x * dl.x + dl.y * dl.y) + (dl.z * dl.z + dl.w * dl.w); }
        q += SHX(q, 16, lane); q += SHX(q, 32, lane);
        const float rstd = 1.0f / sqrtf(q * (1.0f / 64.0f) + LN_EPS);
#pragma unroll
        for (int et = 0; et < 4; ++et) {
            const int c = h * 64 + et * 16 + 4 * g;
            const f32x4 o4 = *(const f32x4*)(proj + trow * PLD + C_MW + 3 * MW + c), g4 = *(const f32x4*)(mln_g + c);
            const f32x4 y = (hs[et] - mean) * rstd * g4;
            u32x2 ob; ob.x = pk2(sigmoidf_(o4.x) * y.x, sigmoidf_(o4.y) * y.y); ob.y = pk2(sigmoidf_(o4.z) * y.z, sigmoidf_(o4.w) * y.w);
            *(u32x2*)(GRP + trow * D + GW + RW + c) = ob;
        }
    }
}

__device__ __forceinline__ void phase_rwkv_post(const Params& P, int l, unsigned char* smem, int wv) {
    ParamsPtr pp = PARAMS_PTR(P); PIN_S(pp); unsigned char* ws = pp->ws; int bidx = (int)blockIdx.x, gdim = (int)gridDim.x; PIN_S(bidx); PIN_S(gdim);
    const float* SCAN = (const float*)(ws + O_SCAN); const float* VV = (const float*)(ws + O_VV); const float* GATE = (const float*)(ws + O_GATE);
    const float* BONUS = (const float*)(ws + O_BONUS); bf16_t* GRP = (bf16_t*)(ws + O_GRP);
    const float* rln_g = pp->in[15] + (size_t)l * RW; const float* rln_b = pp->in[16] + (size_t)l * RW;
    const int tid = phase_tid(wv), lane = tid & 63, wave = tid >> 6;
    const int gw = bidx * NWAVES + wave, ngw = NWAVES * gdim;
    for (int it = gw; it < T * RH; it += ngw) {
        const int t = it / RH, h = it % RH, c = h * 64 + lane;
        const size_t o = (size_t)t * RW + c;
        const float x = SCAN[o] + SCAN[(size_t)T * RW + o];
        const float mean = wave_sum(x, lane) * (1.0f / 64.0f);
        const float dl = x - mean;
        const float var = wave_sum(dl * dl, lane) * (1.0f / 64.0f);
        float y = dl / sqrtf(var + GN_EPS) * rln_g[c] + rln_b[c];
        y += BONUS[(size_t)t * RH + h] * VV[o];
        GRP[(size_t)t * D + GW + c] = (bf16_t)f2bf(y * GATE[o]);
    }
}

__device__ __forceinline__ void phase_ln1_router(const Params& P, int l, unsigned char* smem, int wv) {
    ParamsPtr pp = PARAMS_PTR(P); PIN_S(pp); unsigned char* ws = pp->ws; int bidx = (int)blockIdx.x, gdim = (int)gridDim.x; PIN_S(bidx); PIN_S(gdim);
    const float* xin = l == 0 ? pp->in[0] : (const float*)(ws + O_XA);
    const float* MIX = (const float*)(ws + O_MIX); float* X1 = (float*)(ws + O_X1);
    int* TOPI = (int*)(ws + O_TOPI); float* TOPG = (float*)(ws + O_TOPG); int* RANK = (int*)(ws + O_RANK); bf16_t* X1B = (bf16_t*)(ws + O_X1B);
    int* BCNT = (int*)(ws + O_BCNT);
    const float* g1 = pp->in[22] + (size_t)l * D; const float* b1 = pp->in[23] + (size_t)l * D;
    const float* rw = pp->in[24] + (size_t)l * D * NE; const float* rb = pp->in[25] + (size_t)l * NE;
    const int tid = phase_tid(wv), lane = tid & 63, wave = tid >> 6;
    float* Wl = (float*)smem;
    float* lgs = (float*)(smem + 131072);
    int* stopi = (int*)(smem + 131072 + 8192);
    __syncthreads();
    {
        f32x4 wb[16];
#pragma unroll
        for (int it = 0; it < 16; ++it) wb[it] = ((const f32x4*)rw)[tid + it * NTHREADS];
#pragma unroll
        for (int it = 0; it < 16; ++it) ((f32x4*)Wl)[tid + it * NTHREADS] = wb[it];
    }
    for (int tile = bidx; tile < T / 64; tile += gdim) {
        __syncthreads();
        for (int ti8 = 0; ti8 < 8; ++ti8) {
            const int t = tile * 64 + wave * 8 + ti8;
            float v[16]; float sm = 0.f;
#pragma unroll
            for (int j = 0; j < 4; ++j) {
                const int c = j * 256 + lane * 4;
                const f32x4 a = *(const f32x4*)(xin + (size_t)t * D + c), m = *(const f32x4*)(MIX + (size_t)t * D + c);
                v[j * 4 + 0] = ALPHA * a.x + m.x; v[j * 4 + 1] = ALPHA * a.y + m.y; v[j * 4 + 2] = ALPHA * a.z + m.z; v[j * 4 + 3] = ALPHA * a.w + m.w;
                sm += (v[j * 4] + v[j * 4 + 1]) + (v[j * 4 + 2] + v[j * 4 + 3]);
            }
            const float mean = wave_sum(sm, lane) * (1.0f / D); float q = 0.f;
#pragma unroll
            for (int j = 0; j < 16; ++j) { const float dl = v[j] - mean; q += dl * dl; }
            const float rstd = 1.0f / sqrtf(wave_sum(q, lane) * (1.0f / D) + LN_EPS);
#pragma unroll
            for (int j = 0; j < 4; ++j) {
                const int c = j * 256 + lane * 4;
                const f32x4 gg = *(const f32x4*)(g1 + c), bb = *(const f32x4*)(b1 + c);
                f32x4 o;
                o.x = (v[j * 4 + 0] - mean) * rstd * gg.x + bb.x; o.y = (v[j * 4 + 1] - mean) * rstd * gg.y + bb.y;
                o.z = (v[j * 4 + 2] - mean) * rstd * gg.z + bb.z; o.w = (v[j * 4 + 3] - mean) * rstd * gg.w + bb.w;
                *(f32x4*)(X1 + (size_t)t * D + c) = o;
                u32x2 ob; ob.x = pk2(o.x, o.y); ob.y = pk2(o.z, o.w); *(u32x2*)(X1B + (size_t)t * D + c) = ob;
            }
        }
        __syncthreads();
        {
            const int tq = tid >> 3, eg = (tid & 7) * 4;
            const float* xr = X1 + (size_t)(tile * 64 + tq) * D;
            f32x4 acc = *(const f32x4*)(rb + eg);
#pragma unroll 4
            for (int c = 0; c < D; c += 4) {
                const f32x4 x4 = *(const f32x4*)(xr + c);
                acc += x4.x * *(const f32x4*)(Wl + (c + 0) * NE + eg); acc += x4.y * *(const f32x4*)(Wl + (c + 1) * NE + eg);
                acc += x4.z * *(const f32x4*)(Wl + (c + 2) * NE + eg); acc += x4.w * *(const f32x4*)(Wl + (c + 3) * NE + eg);
            }
            *(f32x4*)(lgs + tq * NE + eg) = acc;
        }
        __syncthreads();
        if (tid < 64) {
            const float* lp = lgs + tid * NE; const int t = tile * 64 + tid;
            float tv[4]; int ti[4];
#pragma unroll
            for (int k = 0; k < 4; ++k) { tv[k] = -INFINITY; ti[k] = 0; }
            for (int e = 0; e < NE; ++e) {
                const float x = lp[e];
                if (x > tv[3]) {
                    if (x > tv[0]) { tv[3] = tv[2]; ti[3] = ti[2]; tv[2] = tv[1]; ti[2] = ti[1]; tv[1] = tv[0]; ti[1] = ti[0]; tv[0] = x; ti[0] = e; }
                    else if (x > tv[1]) { tv[3] = tv[2]; ti[3] = ti[2]; tv[2] = tv[1]; ti[2] = ti[1]; tv[1] = x; ti[1] = e; }
                    else if (x > tv[2]) { tv[3] = tv[2]; ti[3] = ti[2]; tv[2] = x; ti[2] = e; }
                    else { tv[3] = x; ti[3] = e; }
                }
            }
            const float e1 = expf(tv[1] - tv[0]), e2 = expf(tv[2] - tv[0]), e3 = expf(tv[3] - tv[0]);
            const float inv = 1.0f / (1.0f + e1 + e2 + e3);
            *(f32x4*)(TOPG + (size_t)t * 4) = (f32x4){inv, e1 * inv, e2 * inv, e3 * inv};
#pragma unroll
            for (int k = 0; k < 4; ++k) { TOPI[(size_t)t * 4 + k] = ti[k]; stopi[tid * 4 + k] = ti[k]; }
        }
        __syncthreads();
        if (tid < 256) { const int e = stopi[tid]; int r = 0; for (int a2 = 0; a2 < tid; ++a2) r += (stopi[a2] == e) ? 1 : 0; RANK[(size_t)tile * 256 + tid] = r; }
        else if (tid < 256 + NE) { const int e = tid - 256; int cnt = 0; for (int a2 = 0; a2 < 256; ++a2) cnt += (stopi[a2] == e) ? 1 : 0; BCNT[tile * NE + e] = cnt; }
    }
    __syncthreads();
}

__device__ __forceinline__ void moe_offsets(int* sh, const int* CNT, int tid) {
    if (tid == 0) {
        int acc = 0;
        for (int e = 0; e < NE; ++e) { const int c = (int)CNT[e]; sh[e] = c; sh[32 + e] = acc; acc += (c + MOEB - 1) / MOEB * MOEB; sh[64 + e] = acc; }
    }
    __syncthreads();
}
__device__ __forceinline__ int moe_expert_of_row(const int* sh, int r) {
    int e = -1;
    for (int i = 0; i < NE; ++i) if (r >= sh[32 + i] && r < sh[64 + i]) e = i;
    return e;
}

__device__ __forceinline__ void phase_scatter(const Params& P, int l, unsigned char* smem, int wv) {
    ParamsPtr pp = PARAMS_PTR(P); PIN_S(pp); unsigned char* ws = pp->ws; int bidx = (int)blockIdx.x, gdim = (int)gridDim.x; PIN_S(bidx); PIN_S(gdim);
    const int tid = phase_tid(wv);
    const int* TOPI = (const int*)(ws + O_TOPI); const int* RANK = (const int*)(ws + O_RANK); int* SLOT = (int*)(ws + O_SLOT); int* ROWT = (int*)(ws + O_ROWT);
    const int* BCNT = (const int*)(ws + O_BCNT); int* CNTF = (int*)(ws + O_CNTF);
    int* sh = (int*)smem;
    int* part = sh + 96;
    int* tot = part + 512;
    int* base = tot + 32;
    constexpr int NT = T / 64;
    const int e = tid & 31, pt = tid >> 5;
    { int sacc = 0; for (int tl = pt; tl < NT; tl += 16) sacc += BCNT[tl * NE + e]; part[pt * 32 + e] = sacc; }
    __syncthreads();
    if (tid < 32) { int sacc = 0; for (int q = 0; q < 16; ++q) sacc += part[q * 32 + tid]; tot[tid] = sacc; if (bidx == 0) CNTF[tid] = sacc; }
    __syncthreads();
    moe_offsets(sh, tot, tid);
    for (int ee = bidx; ee < NE; ee += gdim)
        for (int r = sh[32 + ee] + sh[ee] + tid; r < sh[64 + ee]; r += NTHREADS) ROWT[r] = 0;
    for (int tile = bidx; tile < NT; tile += gdim) {
        __syncthreads();
        { int sacc = 0; for (int tl = pt; tl < tile; tl += 16) sacc += BCNT[tl * NE + e]; part[pt * 32 + e] = sacc; }
        __syncthreads();
        if (tid < 32) { int sacc = sh[32 + tid]; for (int q = 0; q < 16; ++q) sacc += part[q * 32 + tid]; base[tid] = sacc; }
        __syncthreads();
        if (tid < 256) { const int a = tile * 256 + tid, dest = base[TOPI[a]] + RANK[a]; SLOT[a] = dest; ROWT[dest] = a >> 2; }
    }
    __syncthreads();
}

template <int WHICH>
__device__ __forceinline__ void phase_moe_gemm(const Params& P, int l, unsigned char* smem, int wv) {
    ParamsPtr pp = PARAMS_PTR(P); PIN_S(pp); unsigned char* ws = pp->ws; int bidx = (int)blockIdx.x, gdim = (int)gridDim.x; PIN_S(bidx); PIN_S(gdim);
    const int tid = phase_tid(wv);
    const int* CNT = (const int*)(ws + O_CNTF);
    int* sh = (int*)(smem + 131072);
    int* rbe = sh + 96;
    moe_offsets(sh, CNT, tid);
    const int nrb = sh[64 + NE - 1] / MOEB;
    for (int rb = tid; rb < nrb; rb += NTHREADS) rbe[rb] = moe_expert_of_row(sh, rb * MOEB);
    __syncthreads();
    pg8::MoeOrderT<WHICH == 1> S;
    S.K = 1024; S.G_ = gdim; S.c = bidx; S.rbe = rbe; S.rowmap = (const int*)(ws + O_ROWT);
    if (WHICH == 1) {
        S.A = (const char*)(ws + O_X1B); S.Wt = (const char*)(ws + O_W1) + (size_t)l * NE * 2 * DFF * D * 2; S.estride = (size_t)2 * DFF * D * 2; S.nN = 2 * DFF / 256; S.nwg = nrb * S.nN;
        pg8::EpiSwiglu E{(bf16_t*)(ws + O_ACT), pp->in[27] + (size_t)l * NE * 2 * DFF};
        pg8::gemm_phase<pg8::EpiSwiglu, pg8::MoeOrderT<WHICH == 1>>((LAS unsigned char*)smem, 1024, S, E, tid);
    } else {
        S.A = (const char*)(ws + O_ACT); S.Wt = (const char*)(ws + O_W2) + (size_t)l * NE * D * DFF * 2; S.estride = (size_t)D * DFF * 2; S.nN = D / 256; S.nwg = nrb * S.nN;
        pg8::EpiBf16Bias E{(bf16_t*)(ws + O_YS), D, pp->in[29] + (size_t)l * NE * D, D};
        pg8::gemm_phase<pg8::EpiBf16Bias, pg8::MoeOrderT<WHICH == 1>>((LAS unsigned char*)smem, 1024, S, E, tid);
    }
    __syncthreads();
}

__device__ __forceinline__ void phase_combine_ln2(const Params& P, int l, unsigned char* smem, int wv) {
    ParamsPtr pp = PARAMS_PTR(P); PIN_S(pp); unsigned char* ws = pp->ws; int bidx = (int)blockIdx.x, gdim = (int)gridDim.x; PIN_S(bidx); PIN_S(gdim);
    const float* X1 = (const float*)(ws + O_X1); const bf16_t* YS = (const bf16_t*)(ws + O_YS); bf16_t* XB = (bf16_t*)(ws + O_XB);
    const int* SLOT = (const int*)(ws + O_SLOT); const float* TOPG = (const float*)(ws + O_TOPG);
    float* xo = l == NL - 1 ? pp->out : (float*)(ws + O_XA);
    const float* g2 = pp->in[30] + (size_t)l * D; const float* b2 = pp->in[31] + (size_t)l * D;
    const int tid = phase_tid(wv), lane = tid & 63, wave = tid >> 6;
    const int gw = bidx * NWAVES + wave, ngw = NWAVES * gdim;
    for (int t = gw; t < T; t += ngw) {
        int sl[4]; float gg[4];
#pragma unroll
        for (int k = 0; k < 4; ++k) { sl[k] = SLOT[(size_t)t * 4 + k]; gg[k] = TOPG[(size_t)t * 4 + k]; }
        float v[16]; float sm = 0.f;
#pragma unroll
        for (int j = 0; j < 4; ++j) {
            const int c = j * 256 + lane * 4;
            const f32x4 a = *(const f32x4*)(X1 + (size_t)t * D + c);
            f32x4 y = (f32x4){0.f, 0.f, 0.f, 0.f};
#pragma unroll
            for (int k = 0; k < 4; ++k) { const u32x2 yk = *(const u32x2*)(YS + (size_t)sl[k] * D + c);
                y.x += gg[k] * __builtin_bit_cast(float, yk.x << 16); y.y += gg[k] * __builtin_bit_cast(float, yk.x & 0xffff0000u); y.z += gg[k] * __builtin_bit_cast(float, yk.y << 16); y.w += gg[k] * __builtin_bit_cast(float, yk.y & 0xffff0000u); }
            v[j * 4 + 0] = ALPHA * a.x + y.x; v[j * 4 + 1] = ALPHA * a.y + y.y; v[j * 4 + 2] = ALPHA * a.z + y.z; v[j * 4 + 3] = ALPHA * a.w + y.w;
            sm += (v[j * 4] + v[j * 4 + 1]) + (v[j * 4 + 2] + v[j * 4 + 3]);
        }
        const float mean = wave_sum(sm, lane) * (1.0f / D); float q = 0.f;
#pragma unroll
        for (int j = 0; j < 16; ++j) { const float dl = v[j] - mean; q += dl * dl; }
        const float rstd = 1.0f / sqrtf(wave_sum(q, lane) * (1.0f / D) + LN_EPS);
#pragma unroll
        for (int j = 0; j < 4; ++j) {
            const int c = j * 256 + lane * 4;
            f32x4 o;
            o.x = (v[j * 4 + 0] - mean) * rstd * g2[c + 0] + b2[c + 0]; o.y = (v[j * 4 + 1] - mean) * rstd * g2[c + 1] + b2[c + 1];
            o.z = (v[j * 4 + 2] - mean) * rstd * g2[c + 2] + b2[c + 2]; o.w = (v[j * 4 + 3] - mean) * rstd * g2[c + 3] + b2[c + 3];
            *(f32x4*)(xo + (size_t)t * D + c) = o;
            if (l != NL - 1) { u32x2 ob; ob.x = pk2(o.x, o.y); ob.y = pk2(o.z, o.w); *(u32x2*)(XB + (size_t)t * D + c) = ob; }
        }
    }
}

__device__ __forceinline__ void phase_inproj(const Params& P, int l, unsigned char* smem, int wv) {
    ParamsPtr pp = PARAMS_PTR(P); PIN_S(pp); unsigned char* ws = pp->ws; int bidx = (int)blockIdx.x, gdim = (int)gridDim.x; PIN_S(bidx); PIN_S(gdim);
    const int tid = phase_tid(wv);
    pg8::DenseOrder S; S.init(ws + O_XB, (const bf16_t*)(ws + O_WIN) + (size_t)l * PLD * D, T, PLD, D, gdim, bidx);
    pg8::EpiF32 E{(float*)(ws + O_PROJ), PLD};
    pg8::gemm_phase<pg8::EpiF32, pg8::DenseOrder>((LAS unsigned char*)smem, D, S, E, tid);
    __syncthreads();
}
__device__ __forceinline__ void phase_outproj(const Params& P, int l, unsigned char* smem, int wv) {
    ParamsPtr pp = PARAMS_PTR(P); PIN_S(pp); unsigned char* ws = pp->ws; int bidx = (int)blockIdx.x, gdim = (int)gridDim.x; PIN_S(bidx); PIN_S(gdim);
    const int tid = phase_tid(wv);
    pg8::DenseOrder S; S.init(ws + O_GRP, (const bf16_t*)(ws + O_WOUT) + (size_t)l * D * D, T, D, D, gdim, bidx);
    pg8::EpiF32 E{(float*)(ws + O_MIX), D};
    pg8::gemm_phase<pg8::EpiF32, pg8::DenseOrder>((LAS unsigned char*)smem, D, S, E, tid);
    __syncthreads();
}

#ifndef EMU
#define XB_TMO      128
#define XB_XCNT(j)  (256  + 64 * (j))
#define XB_XSUB(j)  (1280 + 64 * (j))
#define XB_XGEN(j)  (2304 + 64 * (j))
#define XB_TOP      3328
#define XB_TOPGEN   3392
#define XCD_BAR_WORDS 3456
#define XB_SPIN_CAP (1u << 25)
__device__ __forceinline__ unsigned xb_ld(unsigned* p)              { return __hip_atomic_load(p, __ATOMIC_RELAXED, __HIP_MEMORY_SCOPE_AGENT); }
__device__ __forceinline__ unsigned xb_add(unsigned* p, unsigned v) { return __hip_atomic_fetch_add(p, v, __ATOMIC_RELAXED, __HIP_MEMORY_SCOPE_AGENT); }
__device__ __forceinline__ unsigned xb_xcc_id() { return (unsigned)__builtin_amdgcn_s_getreg((3 << 11) | 20) & 0xFu; }
#define XB_SPIN(cond, bar) do { unsigned _sp = 0; while (cond) { __builtin_amdgcn_s_sleep(1); \
    if ((++_sp & 255u) == 0u) { if (xb_ld(&(bar)[XB_TMO])) break; if (_sp > XB_SPIN_CAP) { atomicAdd(&(bar)[XB_TMO], 1u); break; } } } } while (0)
struct XcdBarrier { unsigned* bar; unsigned x; volatile LAS unsigned* st; };
__device__ __forceinline__ XcdBarrier xcd_barrier_post(unsigned* bar, volatile LAS unsigned* st) {
    XcdBarrier b; b.bar = bar; b.x = xb_xcc_id(); b.st = st;
    if (threadIdx.x == 0) (void)xb_add(&bar[XB_XCNT(b.x)], 1u);
    return b;
}
__device__ __forceinline__ void xcd_barrier_complete(unsigned* bar, unsigned x, unsigned& nloc, unsigned& nx) {
    const unsigned G = gridDim.x * gridDim.y * gridDim.z;
    unsigned sum, cnt, mine, sp = 0u;
    for (;;) {
        sum = 0u; cnt = 0u; mine = 0u;
#pragma unroll
        for (unsigned j = 0; j < 16; ++j) { const unsigned c = xb_ld(&bar[XB_XCNT(j)]); sum += c; cnt += (c > 0u) ? 1u : 0u; mine = (j == x) ? c : mine; }
        if (sum == G) break;
        __builtin_amdgcn_s_sleep(1);
        if ((++sp & 255u) == 0u) { if (xb_ld(&bar[XB_TMO])) break; if (sp > XB_SPIN_CAP) { atomicAdd(&bar[XB_TMO], 1u); break; } }
    }
    nloc = mine > 0u ? mine : 1u; nx = cnt > 0u ? cnt : 1u;
}
__device__ __forceinline__ void xcd_barrier(const XcdBarrier& b) {
    asm volatile("s_waitcnt vmcnt(0)" ::: "memory");
    __syncthreads();
    if (threadIdx.x == 0) {
        unsigned* bar = b.bar;
        __builtin_amdgcn_s_waitcnt(0);
        unsigned nloc = b.st[0], nx = b.st[1];
        if (nloc == 0u) { xcd_barrier_complete(bar, b.x, nloc, nx); b.st[0] = nloc; b.st[1] = nx; }
        const unsigned old = xb_add(&bar[XB_XSUB(b.x)], 1u);
        const unsigned gen = old / nloc;
        if (old + 1u == (gen + 1u) * nloc) {
            __builtin_amdgcn_fence(__ATOMIC_RELEASE, "agent");
            asm volatile("s_waitcnt vmcnt(0)" ::: "memory");
            const unsigned og = xb_add(&bar[XB_TOP], 1u);
            const unsigned tg = og / nx;
            if (og + 1u == (tg + 1u) * nx) xb_add(&bar[XB_TOPGEN], 1u);
            else XB_SPIN(xb_ld(&bar[XB_TOPGEN]) == tg, bar);
            __builtin_amdgcn_fence(__ATOMIC_ACQUIRE, "agent");
            xb_add(&bar[XB_XGEN(b.x)], 1u);
            asm volatile("s_waitcnt vmcnt(0)" ::: "memory");
        } else {
            XB_SPIN(xb_ld(&bar[XB_XGEN(b.x)]) == gen, bar);
            __builtin_amdgcn_fence(__ATOMIC_ACQUIRE, "agent");
            asm volatile("s_waitcnt vmcnt(0)" ::: "memory");
        }
    }
    __syncthreads();
}
#endif

__global__ void __launch_bounds__(512, 2) mk_fwd(Params P) {
#ifdef EMU
    unsigned char* smem = g_blk->lds;
#else
    extern __shared__ __attribute__((aligned(16))) unsigned char smem[];
    volatile LAS unsigned* bst = (volatile LAS unsigned*)(smem + LDS_BYTES - 16);
    if (threadIdx.x == 0) { bst[0] = 0u; bst[1] = 0u; bst[2] = 0u; bst[3] = 0u; }
    __syncthreads();
    XcdBarrier bar; bar.bar = (unsigned*)P.ws + CW_BAR; bar.x = 0; bar.st = bst;
    if (P.ph_hi - P.ph_lo > 1) bar = xcd_barrier_post((unsigned*)P.ws + CW_BAR, bst);
#endif
    const int lo = P.ph_lo, hi = P.ph_hi;
#ifdef EMU
    const int wv = (int)threadIdx.x >> 6;
#else
    const int wv = RFL((int)threadIdx.x >> 6);
#endif
#ifdef EMU
#define SEAM(id) do {} while (0)
#else
#define SEAM(id) do { if ((id) + 1 < hi) xcd_barrier(bar); } while (0)
#endif
#ifndef MK_ONLY_PHASE
#define MK_ONLY_PHASE -1
#endif
#ifndef MK_DUP_MASK
#define MK_DUP_MASK 0
#endif
#define PHG(kc, id, ...) do { if (MK_ONLY_PHASE < 0 || MK_ONLY_PHASE == (kc)) { const int id_ = (id); if (id_ >= lo && id_ < hi) { if ((MK_DUP_MASK >> (kc)) & 1) { __VA_ARGS__; SEAM(id_ - 1); } __VA_ARGS__; SEAM(id_); } } } while (0)
#define PH(k, ...) PHG(1 + (k), 1 + l * NPH + (k), __VA_ARGS__)
    PHG(0, 0, phase_prologue(P, smem, wv));
    for (int l = 0; l < NL; ++l) {
        PH(0, phase_inproj(P, l, smem, wv));
        PH(1, phase_prep(P, l, smem, wv));
#if MK_RWKV_CHUNKED
        PH(2, { phase_rwkv_pre(P, l, smem, wv); phase_mlstm_local(P, l, smem, wv, (int)blockIdx.x, (int)gridDim.x); });
        PH(3, { phase_rwkv_seq(P, l, smem, wv); phase_mlstm_carry(P, l, smem, wv); });
        PH(4, { phase_rwkv_out(P, l, smem, wv); phase_mlstm_out(P, l, smem, wv); phase_gmlp_mix(P, l, smem, wv, (int)blockIdx.x, (int)gridDim.x); });
#else
        PH(2, { const int G_ = (int)gridDim.x, NSC = 2 * NB * RH * 4;
                if (G_ >= NSC + 32) { if ((int)blockIdx.x < NSC) phase_rwkv_scan(P, l, smem, wv, (int)blockIdx.x, NSC);
                                      else phase_mlstm_local(P, l, smem, wv, (int)blockIdx.x - NSC, G_ - NSC); }
                else { phase_rwkv_scan(P, l, smem, wv, (int)blockIdx.x, G_); phase_mlstm_local(P, l, smem, wv, (int)blockIdx.x, G_); } });
        PH(3, phase_mlstm_carry(P, l, smem, wv));
        PH(4, { phase_mlstm_out(P, l, smem, wv); phase_gmlp_mix(P, l, smem, wv, (int)blockIdx.x, (int)gridDim.x); phase_rwkv_post(P, l, smem, wv); });
#endif
        PH(5, phase_outproj(P, l, smem, wv));
        PH(6, phase_ln1_router(P, l, smem, wv));
        PH(7, phase_scatter(P, l, smem, wv));
        PH(8, phase_moe_gemm<1>(P, l, smem, wv));
        PH(9, phase_moe_gemm<2>(P, l, smem, wv));
        PH(10, phase_combine_ln2(P, l, smem, wv));
    }
#undef PHG
#undef PH
#undef SEAM
}

}

#ifndef EMU
extern "C" void kernel_launch(void* const* d_in, const int* in_sizes, int n_in, void* d_out, int out_size, void* d_ws, size_t ws_size, hipStream_t stream) {
    using namespace mk;
    static int grid = 0;
    if (grid == 0) {
        if (n_in != 32 || out_size != T * D || ws_size < WS_END) { fprintf(stderr, "kernel_launch: unexpected shapes (n_in %d out %d ws %zu need %zu)\n", n_in, out_size, ws_size, (size_t)WS_END); grid = -1; return; }
        int dev = 0, cus = 0;
        if (hipGetDevice(&dev) != hipSuccess || hipDeviceGetAttribute(&cus, hipDeviceAttributeMultiprocessorCount, dev) != hipSuccess) { grid = -1; return; }
        if (hipFuncSetAttribute((const void*)mk_fwd, hipFuncAttributeMaxDynamicSharedMemorySize, LDS_BYTES) != hipSuccess) { fprintf(stderr, "kernel_launch: hipFuncSetAttribute failed\n"); grid = -1; return; }
        int per_cu = 0;
        (void)hipOccupancyMaxActiveBlocksPerMultiprocessor(&per_cu, (const void*)mk_fwd, NTHREADS, LDS_BYTES);
        (void)hipGetLastError();
        grid = cus;
    }
    if (grid < 0) return;
    (void)hipMemsetAsync(d_ws, 0, CTL_BYTES, stream);
    Params p{};
    for (int i = 0; i < 32; ++i) p.in[i] = (const float*)d_in[i];
    p.out = (float*)d_out; p.ws = (unsigned char*)d_ws;
#if MK_ONE_LAUNCH
    p.ph_lo = 0; p.ph_hi = 1 + NL * NPH;
    hipLaunchKernelGGL(mk_fwd, dim3(grid), dim3(NTHREADS), LDS_BYTES, stream, p);
#else
    for (int id = 0; id < 1 + NL * NPH; ++id) {
        p.ph_lo = id; p.ph_hi = id + 1;
        hipLaunchKernelGGL(mk_fwd, dim3(grid), dim3(NTHREADS), LDS_BYTES, stream, p);
    }
#endif
}
#endif
```

```cpp
#ifndef EMU
#include <hip/hip_runtime.h>
#endif
#include <cstdio>
#include <cstdint>
#include <cmath>

#ifndef CFG_BATCH
#define CFG_BATCH 4
#endif
#ifndef CFG_SEQ
#define CFG_SEQ 4096
#endif
#ifndef CFG_LAYERS
#define CFG_LAYERS 4
#endif
#ifndef MK_RWKV_CHUNKED
#define MK_RWKV_CHUNKED 1
#endif
#ifndef MK_PROBE
#define MK_PROBE 0
#endif
#ifndef MK_ONE_LAUNCH
#define MK_ONE_LAUNCH 1
#endif

namespace mk {
constexpr int NB = CFG_BATCH, S = CFG_SEQ, T = NB * S, NL = CFG_LAYERS, D = 1024;
constexpr int GW = 256, RW = 384, MW = 384, HD = 64, GH = 4, RH = 6, MH = 6, CH = 128, NCH = S / CH;
constexpr int PIN = 3480, PLD = 3584, RPROJ = 1408;
constexpr int C_RW = 512, C_MW = 1920;
constexpr int NE = 32, TOPK = 4, DFF = 1024, MOEB = 256;
constexpr int NROWS = (T * TOPK / MOEB + NE) * MOEB;
constexpr float LN_EPS = 1e-5f, GN_EPS = 64e-5f;
constexpr float ALPHA = 1.6817928305074290f;
constexpr int NTHREADS = 512, NWAVES = 8;
constexpr int LDS_BYTES = 160 * 1024;
constexpr int NPH = 11;

typedef float f32x4 __attribute__((ext_vector_type(4)));
typedef unsigned u32x4 __attribute__((ext_vector_type(4)));
typedef unsigned u32x2 __attribute__((ext_vector_type(2)));
typedef short bf16x8 __attribute__((ext_vector_type(8)));
typedef unsigned short bf16_t;

constexpr size_t al(size_t x) { return (x + 255) & ~(size_t)255; }
constexpr size_t CTL_BYTES = 1u << 20;
constexpr size_t O_XA = CTL_BYTES;
constexpr size_t O_XB = O_XA + al((size_t)T * D * 4);
constexpr size_t O_X1 = O_XB + al((size_t)T * D * 2);
constexpr size_t O_X1B = O_X1 + al((size_t)T * D * 4);
constexpr size_t O_PROJ = O_X1B + al((size_t)T * D * 2);
constexpr size_t O_MIX = O_PROJ + al((size_t)T * PLD * 4);
constexpr size_t O_GRP = O_MIX + al((size_t)T * D * 4);
constexpr size_t O_UG = O_GRP + al((size_t)T * D * 2);
constexpr size_t O_VN = O_UG + al((size_t)T * GW * 4);
constexpr size_t O_RR = O_VN + al((size_t)T * GW * 4);
constexpr size_t O_VV = O_RR + al((size_t)T * RW * 4);
constexpr size_t O_KK = O_VV + al((size_t)T * RW * 4);
constexpr size_t O_DEC = O_KK + al((size_t)T * RW * 4);
constexpr size_t O_KD = O_DEC + al((size_t)2 * T * RW * 4);
constexpr size_t O_ICLR = O_KD + al((size_t)2 * T * RW * 4);
constexpr size_t O_GATE = O_ICLR + al((size_t)2 * T * RW * 4);
constexpr size_t O_BONUS = O_GATE + al((size_t)T * RW * 4);
constexpr size_t O_SCAN = O_BONUS + al((size_t)T * RH * 4);
constexpr size_t O_MQ = O_SCAN + al((size_t)2 * T * RW * 4);
constexpr size_t O_MK = O_MQ + al((size_t)T * MW * 4);
constexpr size_t O_IG = O_MK + al((size_t)T * MW * 4);
constexpr size_t O_LF = O_IG + al((size_t)2 * T * MH * 4);
constexpr size_t O_CL = O_LF + al((size_t)2 * T * MH * 4);
constexpr size_t O_NL = O_CL + al((size_t)2 * NB * MH * NCH * 4096 * 4);
constexpr size_t O_ML = O_NL + al((size_t)2 * NB * MH * NCH * 64 * 4);
constexpr size_t O_BL = O_ML + al((size_t)2 * NB * MH * NCH * 4);
constexpr size_t O_MIN = O_BL + al((size_t)2 * NB * MH * NCH * 4);
constexpr size_t O_TOPI = O_MIN + al((size_t)2 * NB * MH * NCH * 4);
constexpr size_t O_TOPG = O_TOPI + al((size_t)T * 4 * 4);
constexpr size_t O_RANK = O_TOPG + al((size_t)T * 4 * 4);
constexpr size_t O_SLOT = O_RANK + al((size_t)T * 4 * 4);
constexpr size_t O_MQB = O_SLOT + al((size_t)T * 4 * 4);
constexpr size_t O_MKB = O_MQB + al((size_t)T * MW * 2);
constexpr size_t O_KT = O_MKB + al((size_t)T * MW * 2);
constexpr size_t O_VT = O_KT + al((size_t)T * MW * 2);
constexpr size_t O_GVT = O_VT + al((size_t)T * MW * 2);
constexpr size_t O_PMX = O_GVT + al((size_t)2 * T * MH * 4);
constexpr size_t O_BCT = O_PMX + al((size_t)2 * T * MH * 4);
constexpr size_t O_BRKR = O_BCT + al((size_t)2 * T * MH * 4);
constexpr int RC = 64, RNC = S / RC, RUN = 2 * NB * RH * RNC;
constexpr size_t O_LW = O_BRKR + al((size_t)2 * T * RH * 2 * 4);
constexpr size_t O_RQ = O_LW + al((size_t)2 * T * RW * 4);
constexpr size_t O_RA = O_RQ + al((size_t)RUN * 4096 * 2);
constexpr size_t O_RS = O_RA + al((size_t)RUN * 4096 * 2);
constexpr size_t O_RH = O_RS + al((size_t)RUN * 4096 * 2);
constexpr size_t O_RG = O_RH + al((size_t)RUN * 4096 * 4);
constexpr size_t O_RB = O_RG + al((size_t)RUN * 4096 * 4);
constexpr size_t O_VB = O_RB + al((size_t)T * RW * 2);
constexpr size_t O_KKB = O_VB + al((size_t)T * RW * 2);
constexpr size_t O_BBB = O_KKB + al((size_t)T * RW * 2);
constexpr size_t O_KDB = O_BBB + al((size_t)2 * T * RW * 2);
constexpr size_t O_VNT = O_KDB + al((size_t)2 * T * RW * 2);
constexpr size_t O_WSB = O_VNT + al((size_t)T * GW * 2);
constexpr size_t O_LWT = O_WSB + al((size_t)NL * GH * CH * CH * 2);
constexpr size_t O_BCNT = O_LWT + al((size_t)NL * 1920 * 128 * 2);
constexpr size_t O_CNTF = O_BCNT + al((size_t)(T / 64) * NE * 4);
constexpr size_t O_ROWT = O_CNTF + al((size_t)NE * 4);
constexpr size_t O_XS = O_ROWT + al((size_t)NROWS * 4);
constexpr size_t O_ACT = O_XS + al((size_t)NROWS * D * 2);
constexpr size_t O_YS = O_ACT + al((size_t)NROWS * DFF * 2);
constexpr size_t O_WIN = O_YS + al((size_t)NROWS * D * 2);
constexpr size_t O_WOUT = O_WIN + al((size_t)NL * PLD * D * 2);
constexpr size_t O_W1 = O_WOUT + al((size_t)NL * D * D * 2);
constexpr size_t O_W2 = O_W1 + al((size_t)NL * NE * 2 * DFF * D * 2);
constexpr size_t WS_END = O_W2 + al((size_t)NL * NE * D * DFF * 2);

constexpr int CW_BAR = 4096;
constexpr int CW_CNT = 16384;

struct Params { const float* in[32]; float* out; unsigned char* ws; int ph_lo, ph_hi; };
#ifdef EMU
typedef const Params* ParamsPtr;
#define PARAMS_PTR(P) (&(P))
#else
typedef const __attribute__((address_space(4))) Params* ParamsPtr;
#define PARAMS_PTR(P) ((ParamsPtr)__builtin_amdgcn_kernarg_segment_ptr())
#endif

#ifdef EMU
#define WAVE_SYNC() emu_wave_barrier()
#define PIN_V(x) do {} while (0)
#define PIN_S(x) do {} while (0)
#else
#define WAVE_SYNC() __builtin_amdgcn_wave_barrier()
#define PIN_V(x) asm volatile("" : "+v"(x))
#define PIN_S(x) asm volatile("" : "+s"(x))
#endif
#ifdef EMU
__device__ __forceinline__ int phase_tid(int wv) { (void)wv; return threadIdx.x; }
#else
__device__ __forceinline__ int phase_tid(int wv) { int t; asm volatile("v_mbcnt_lo_u32_b32 %0, -1, 0\n\tv_mbcnt_hi_u32_b32 %0, -1, %0" : "=v"(t)); return (wv << 6) + t; }
#endif

#ifdef EMU
#define SHX(v, m, lane) __shfl_xor(v, m)
#else
__device__ __forceinline__ float shx_(float v, int m, int lane) { return __builtin_bit_cast(float, __builtin_amdgcn_ds_bpermute((lane ^ m) << 2, __builtin_bit_cast(int, v))); }
__device__ __forceinline__ int shx_(int v, int m, int lane) { return __builtin_amdgcn_ds_bpermute((lane ^ m) << 2, v); }
#define SHX(v, m, lane) shx_(v, m, lane)
#endif
#ifdef EMU
#define SHUP(v, o, lane) __shfl(v, ((lane) - (o)) & 63)
#define RDL(v, src) __shfl(v, src)
#define SHL(v, src) __shfl(v, src)
#else
#define SHL(v, src) __builtin_bit_cast(float, __builtin_amdgcn_ds_bpermute((src) << 2, __builtin_bit_cast(int, (float)(v))))
#define SHUP(v, o, lane) __builtin_bit_cast(float, __builtin_amdgcn_ds_bpermute((((lane) - (o)) & 63) << 2, __builtin_bit_cast(int, (float)(v))))
#define RDL(v, src) __builtin_bit_cast(float, __builtin_amdgcn_readlane(__builtin_bit_cast(int, (float)(v)), src))
#endif
__device__ __forceinline__ float wave_sum(float v, int lane) {
#pragma unroll
    for (int o = 32; o >= 1; o >>= 1) v += SHX(v, o, lane);
    return v;
}
#ifdef EMU
__device__ __forceinline__ float fexp(float x) { return expf(x); }
__device__ __forceinline__ float flog(float x) { return logf(x); }
__device__ __forceinline__ float frcp(float x) { return 1.0f / x; }
#else
__device__ __forceinline__ float fexp(float x) { return __builtin_amdgcn_exp2f(x * 1.4426950408889634f); }
__device__ __forceinline__ float flog(float x) { return __builtin_amdgcn_logf(x) * 0.6931471805599453f; }
__device__ __forceinline__ float frcp(float x) { return __builtin_amdgcn_rcpf(x); }
#endif
__device__ __forceinline__ float sigmoidf_(float x) { return frcp(1.0f + fexp(-x)); }
__device__ __forceinline__ float softplusf_(float x) { return fmaxf(x, 0.f) + flog(1.0f + fexp(-fabsf(x))); }
__device__ __forceinline__ float ftanh(float x) { return 1.0f - 2.0f * frcp(1.0f + fexp(2.0f * x)); }
__device__ __forceinline__ float geluf_(float v) {
    const float av = fabsf(v), t = frcp(1.0f + 0.2316418882f * av);
    float q = t * 0.5307027145f + (-0.7265760135f); q = q * t + 0.7107068705f; q = q * t + (-0.142248368f); q = q * t + 0.127414796f; q = q * t;
    const float m = v * (q * fexp(-0.5f * v * v));
    return v < 0.f ? m : v - m;
}

#ifdef EMU
#define LAS
#define WAIT_V(n) do {} while (0)
#define WAIT_L(n) do {} while (0)
#define S_BARRIER() __syncthreads()
#define SETPRIO(x) do {} while (0)
#define SCHED_BAR() do {} while (0)
#define RFL(x) (x)
static inline void emu_glds16(const void* g, void* l) { memcpy((char*)l + (g_blk->cur & 63) * 16, g, 16); }
#define GLDS16(gptr, ldsptr) emu_glds16((const void*)(gptr), (void*)(ldsptr))
static inline float emu_bf2f(unsigned short b) { unsigned u = (unsigned)b << 16; float f; memcpy(&f, &u, 4); return f; }
static inline f32x4 emu_mfma16(bf16x8 a, bf16x8 b, f32x4 c) {
    EmuBlock* blk = g_blk; const int cur = blk->cur, lane = cur & 63, wbase = cur & ~63;
    static thread_local unsigned short Ash[32][64][8], Bsh[32][64][8];
    const int w = cur >> 6;
    for (int j = 0; j < 8; ++j) { Ash[w][lane][j] = (unsigned short)a[j]; Bsh[w][lane][j] = (unsigned short)b[j]; }
    emu_wave_barrier();
    const int col = lane & 15;
    for (int r = 0; r < 4; ++r) { const int row = 4 * (lane >> 4) + r; float sum = c[r];
        for (int k = 0; k < 32; ++k) sum += emu_bf2f(Ash[w][row + 16 * (k >> 3)][k & 7]) * emu_bf2f(Bsh[w][col + 16 * (k >> 3)][k & 7]);
        c[r] = sum; }
    emu_wave_barrier(); (void)wbase;
    return c;
}
#define MFMA16(a, b, c) emu_mfma16(a, b, c)
#else
#define LAS __attribute__((address_space(3)))
#define WAIT_V(n) asm volatile("s_waitcnt vmcnt(" #n ")" ::: "memory")
#define WAIT_L(n) asm volatile("s_waitcnt lgkmcnt(" #n ")" ::: "memory")
#define S_BARRIER() __builtin_amdgcn_s_barrier()
#define SETPRIO(x) __builtin_amdgcn_s_setprio(x)
#define SCHED_BAR() __builtin_amdgcn_sched_barrier(0)
#define RFL(x) __builtin_amdgcn_readfirstlane(x)
#define GLDS16(gptr, ldsptr) __builtin_amdgcn_global_load_lds((const unsigned*)(gptr), (LAS unsigned*)(ldsptr), 16, 0, 0)
#define MFMA16(a, b, c) __builtin_amdgcn_mfma_f32_16x16x32_bf16(a, b, c, 0, 0, 0)
#endif

__device__ __forceinline__ unsigned f2bf(float f) { unsigned u = __builtin_bit_cast(unsigned, f); return (u + 0x7fffu + ((u >> 16) & 1u)) >> 16; }
__device__ __forceinline__ unsigned pk2(float lo, float hi) { return f2bf(lo) | (f2bf(hi) << 16); }
__device__ __forceinline__ bf16x8 cvt8(const f32x4 a, const f32x4 b) {
    u32x4 w; w.x = pk2(a.x, a.y); w.y = pk2(a.z, a.w); w.z = pk2(b.x, b.y); w.w = pk2(b.z, b.w); return __builtin_bit_cast(bf16x8, w);
}
__device__ __forceinline__ float bf_lo(unsigned u) { return __builtin_bit_cast(float, u << 16); }
__device__ __forceinline__ float bf_hi(unsigned u) { return __builtin_bit_cast(float, u & 0xffff0000u); }

namespace pg8 {
constexpr int BM = 256, BK = 64, HALF = 128, HTB = HALF * BK * 2, STAGE_BYTES = 8 * HTB, NXCD = 8, WGM = 8;
__host__ __device__ __forceinline__ int lds_byte(int r, int c) { const int st = (r >> 4) * 2 + (c >> 5), rr = r & 15, cc = c & 31, ob = rr * 64 + cc * 2; return st * 1024 + (ob ^ (((ob >> 9) & 1) << 5)); }
__host__ __device__ __forceinline__ void stage_rc(int b, int& R, int& C) { const int st = b / 1024, sb = b % 1024, swz = sb ^ (((sb >> 9) & 1) << 5); R = (st >> 1) * 16 + swz / 64; C = (st & 1) * 32 + (swz % 64) / 2; }
__host__ __device__ __forceinline__ int perm32(int rho) { const int n = rho >> 4, i = rho & 15; return 8 * (i >> 2) + 4 * n + (i & 3); }
struct Unit { int pm, pn, e; };

struct DenseOrder {
    static constexpr bool GATHER = false;
    const char* A; const char* Bt; int K; int nM, nN, nwg, G, c;
    __device__ __forceinline__ void init(const void* A_, const void* Bt_, int M, int N, int K_, int G_, int c_) { A = (const char*)A_; Bt = (const char*)Bt_; K = K_; nM = M / BM; nN = N / BM; nwg = nM * nN; G = G_; c = c_; }
    __device__ __forceinline__ bool next(int i, Unit& u) const {
        const long L = (long)i * G + c; if (L >= nwg) return false;
        int wgid = (int)L; { const int q = nwg / NXCD, r = nwg % NXCD, xcd = wgid % NXCD, off = wgid / NXCD; wgid = (xcd < r ? xcd * (q + 1) : r * (q + 1) + (xcd - r) * q) + off; }
        const int nig = WGM * nN, gid = wgid / nig, fm = gid * WGM, gsz = (nM - fm) < WGM ? (nM - fm) : WGM;
        u.pm = fm + ((wgid % nig) % gsz); u.pn = (wgid % nig) / gsz; u.e = 0; return true;
    }
    __device__ __forceinline__ const char* abase(const Unit& u) const { return A + (size_t)u.pm * BM * K * 2; }
    __device__ __forceinline__ const char* bbase(const Unit& u) const { return Bt + (size_t)u.pn * BM * K * 2; }
};
template <bool G>
struct MoeOrderT {
    static constexpr bool GATHER = G;
    const char* A; const char* Wt; int K; int nN, nwg, G_, c; size_t estride; const int* rbe; const int* rowmap;
    __device__ __forceinline__ bool next(int i, Unit& u) const {
        const long L = (long)i * G_ + c; if (L >= nwg) return false;
        u.pm = (int)(L / nN); u.pn = (int)(L % nN); u.e = rbe[u.pm]; return true;
    }
    __device__ __forceinline__ const char* abase(const Unit& u) const { return G ? A : A + (size_t)u.pm * BM * K * 2; }
    __device__ __forceinline__ const char* bbase(const Unit& u) const { return Wt + (size_t)u.e * estride + (size_t)u.pn * BM * K * 2; }
};
struct EpiF32 {
    static constexpr bool PERM = false;
    float* C; int ldc;
    __device__ __forceinline__ void operator()(const f32x4 (&acc)[2][2][4][2], const Unit& u, int wr, int wc, int fr, int fq) const {
        const int row0 = u.pm * BM + wr * 64 + fr, col0 = u.pn * BM + wc * 32 + 4 * fq;
#pragma unroll
        for (int ai = 0; ai < 2; ++ai)
#pragma unroll
            for (int m = 0; m < 4; ++m) { float* rowp = C + (size_t)(row0 + ai * HALF + m * 16) * ldc + col0;
#pragma unroll
                for (int bj = 0; bj < 2; ++bj)
#pragma unroll
                    for (int n = 0; n < 2; ++n) *(f32x4*)(rowp + bj * HALF + n * 16) = acc[ai][bj][m][n]; }
    }
};
struct EpiBf16Bias {
    static constexpr bool PERM = true;
    bf16_t* O; int ldc; const float* bias; int bias_estride;
    __device__ __forceinline__ void operator()(const f32x4 (&acc)[2][2][4][2], const Unit& u, int wr, int wc, int fr, int fq) const {
        const int row0 = u.pm * BM + wr * 64 + fr, col0 = u.pn * BM + wc * 32 + 8 * fq;
        const float* bp = bias + (size_t)u.e * bias_estride + col0;
        f32x4 bv[2][2];
#pragma unroll
        for (int bj = 0; bj < 2; ++bj)
#pragma unroll
            for (int n = 0; n < 2; ++n) bv[bj][n] = *(const f32x4*)(bp + bj * HALF + 4 * n);
#pragma unroll
        for (int ai = 0; ai < 2; ++ai)
#pragma unroll
            for (int m = 0; m < 4; ++m) { bf16_t* rowp = O + (size_t)(row0 + ai * HALF + m * 16) * ldc + col0;
#pragma unroll
                for (int bj = 0; bj < 2; ++bj) { const f32x4 v0 = acc[ai][bj][m][0] + bv[bj][0], v1 = acc[ai][bj][m][1] + bv[bj][1];
                    u32x4 w; w.x = pk2(v0[0], v0[1]); w.y = pk2(v0[2], v0[3]); w.z = pk2(v1[0], v1[1]); w.w = pk2(v1[2], v1[3]);
                    *(u32x4*)(rowp + bj * HALF) = w; } }
    }
};
__device__ __forceinline__ float swiglu1(float g, float uu) { g = fminf(g, 7.0f); uu = fminf(fmaxf(uu, -7.0f), 7.0f); return (uu + 1.0f) * (g * frcp(1.0f + fexp(-1.702f * g))); }
struct EpiSwiglu {
    static constexpr bool PERM = true;
    bf16_t* O; const float* b1;
    __device__ __forceinline__ void operator()(const f32x4 (&acc)[2][2][4][2], const Unit& u, int wr, int wc, int fr, int fq) const {
        const int row0 = u.pm * BM + wr * 64 + fr, j0 = u.pn * HALF + wc * 32 + 8 * fq;
        const float* bg = b1 + (size_t)u.e * 2 * DFF + j0; const float* bu = bg + DFF;
        f32x4 g4[2], u4[2];
#pragma unroll
        for (int n = 0; n < 2; ++n) { g4[n] = *(const f32x4*)(bg + 4 * n); u4[n] = *(const f32x4*)(bu + 4 * n); }
#pragma unroll
        for (int ai = 0; ai < 2; ++ai)
#pragma unroll
            for (int m = 0; m < 4; ++m) {
                float o[8];
#pragma unroll
                for (int n = 0; n < 2; ++n)
#pragma unroll
                    for (int q = 0; q < 4; ++q) o[n * 4 + q] = swiglu1(acc[ai][0][m][n][q] + g4[n][q], acc[ai][1][m][n][q] + u4[n][q]);
                u32x4 w; w.x = pk2(o[0], o[1]); w.y = pk2(o[2], o[3]); w.z = pk2(o[4], o[5]); w.w = pk2(o[6], o[7]);
                *(u32x4*)(O + (size_t)(row0 + ai * HALF + m * 16) * DFF + j0) = w;
            }
    }
};

template <class Epi, class Sched>
__device__ __forceinline__ void gemm_phase(LAS unsigned char* lds, const int K, const Sched& S, const Epi& E, const int tid) {
    const int wid = RFL(tid >> 6), lane = tid & 63, wr = wid >> 2, wc = wid & 3, fr = lane & 15, fq = lane >> 4;
    const int nt = K / BK;
    unsigned voffA[2], voffB[2]; int gR[2]; unsigned gC[2];
#pragma unroll
    for (int i = 0; i < 2; ++i) { int R, C; stage_rc(tid * 16 + i * 8192, R, C); const int Rb = Epi::PERM ? ((R & ~31) + perm32(R & 31)) : R;
        voffA[i] = (unsigned)(R * K + C) * 2u; voffB[i] = (unsigned)(Rb * K + C) * 2u; gR[i] = R; gC[i] = (unsigned)C * 2u; }
    unsigned va[2][2], vn[2][2];
#define PG8_GOFF(dst, unit) do { if constexpr (Sched::GATHER) { _Pragma("unroll") for (int h_ = 0; h_ < 2; ++h_) _Pragma("unroll") for (int i_ = 0; i_ < 2; ++i_) \
        dst[h_][i_] = (unsigned)S.rowmap[(unit).pm * BM + h_ * HALF + gR[i_]] * (unsigned)(K * 2) + gC[i_]; } } while (0)
#define PG8_STAGE_A(bufoff, bp, kb, h, nx) do { if constexpr (Sched::GATHER) { const char* gb_ = S.A + (kb); _Pragma("unroll") for (int _i = 0; _i < 2; ++_i) \
        GLDS16(gb_ + ((nx) ? vn[h][_i] : va[h][_i]), lds + (bufoff) + ldsw + _i * 8192); } else { PG8_STAGE(bufoff, bp, voffA); } } while (0)
    const size_t kstep = (size_t)(BK * 2);
    const size_t hstep = (size_t)HALF * K * 2;
    const unsigned ldsw = (unsigned)wid * 1024u;
    const int aoff = lds_byte(wr * 64 + fr, fq * 8), boff = lds_byte(wc * 32 + fr, fq * 8);
#define PG8_SA(b, h) (((b) * 2 + (h)) * HTB)
#define PG8_SB(b, h) ((4 + (b) * 2 + (h)) * HTB)
#define PG8_STAGE(bufoff, gbase, voff) do { _Pragma("unroll") for (int _i = 0; _i < 2; ++_i) \
        GLDS16((const char*)(gbase) + (voff)[_i], lds + (bufoff) + ldsw + _i * 8192); } while (0)
#define PG8_LDA(dst, b, h) do { _Pragma("unroll") for (int m = 0; m < 4; ++m) _Pragma("unroll") for (int k = 0; k < 2; ++k) dst[m][k] = *(const LAS bf16x8*)(lds + PG8_SA(b, h) + aoff + m * 2048 + k * 1024); } while (0)
#define PG8_LDB(dst, b, h) do { _Pragma("unroll") for (int n = 0; n < 2; ++n) _Pragma("unroll") for (int k = 0; k < 2; ++k) dst[n][k] = *(const LAS bf16x8*)(lds + PG8_SB(b, h) + boff + n * 2048 + k * 1024); } while (0)
#define PG8_MMA(ai, bj, At, Bt) do { SETPRIO(1); _Pragma("unroll") for (int m = 0; m < 4; ++m) _Pragma("unroll") for (int n = 0; n < 2; ++n) _Pragma("unroll") for (int k = 0; k < 2; ++k) \
        acc[ai][bj][m][n] = MFMA16(Bt[n][k], At[m][k], acc[ai][bj][m][n]); SETPRIO(0); } while (0)
    Unit cur, nxt; int ui = 0;
    if (!S.next(0, cur)) return;
    f32x4 acc[2][2][4][2];
#pragma unroll
    for (int a = 0; a < 2; ++a)
#pragma unroll
        for (int b = 0; b < 2; ++b)
#pragma unroll
            for (int m = 0; m < 4; ++m)
#pragma unroll
                for (int n = 0; n < 2; ++n) acc[a][b][m][n] = (f32x4){0.f, 0.f, 0.f, 0.f};
    bf16x8 At[4][2], B0[2][2], B1[2][2];
    const char* cA = S.abase(cur); const char* cB = S.bbase(cur);
    PG8_GOFF(va, cur);
    PG8_STAGE(PG8_SB(0, 0), cB, voffB); PG8_STAGE_A(PG8_SA(0, 0), cA, 0, 0, false); PG8_STAGE(PG8_SB(0, 1), cB + hstep, voffB); PG8_STAGE_A(PG8_SA(0, 1), cA + hstep, 0, 1, false);
    if (wr == 1) S_BARRIER();
    WAIT_V(4); S_BARRIER();
    PG8_STAGE(PG8_SB(1, 0), cB + kstep, voffB); PG8_STAGE_A(PG8_SA(1, 0), cA + kstep, kstep, 0, false); PG8_STAGE(PG8_SB(1, 1), cB + hstep + kstep, voffB);
    WAIT_V(6); S_BARRIER();
    for (;;) {
        const bool has_next = S.next(ui + 1, nxt);
        const char* nA = has_next ? S.abase(nxt) : cA; const char* nB = has_next ? S.bbase(nxt) : cB;
        if constexpr (Sched::GATHER) { if (has_next) { PG8_GOFF(vn, nxt); } else {
#pragma unroll
            for (int h_ = 0; h_ < 2; ++h_) { vn[h_][0] = va[h_][0]; vn[h_][1] = va[h_][1]; } } }
        for (int t = 0; t < nt; t += 2) {
            const bool last = (t == nt - 2);
            const char* a1 = cA + (size_t)(t + 1) * kstep;
            const char* a2 = last ? nA : cA + (size_t)(t + 2) * kstep; const char* b2 = last ? nB : cB + (size_t)(t + 2) * kstep;
            const char* a3 = a2 + kstep; const char* b3 = b2 + kstep;
            PG8_LDB(B0, 0, 0); SCHED_BAR(); PG8_LDA(At, 0, 0); PG8_STAGE_A(PG8_SA(1, 1), a1 + hstep, (size_t)(t + 1) * kstep, 1, false);
            WAIT_L(8); S_BARRIER(); WAIT_L(0); PG8_MMA(0, 0, At, B0); S_BARRIER(); SCHED_BAR();
            PG8_LDB(B1, 0, 1); PG8_STAGE(PG8_SB(0, 0), b2, voffB);
            S_BARRIER(); WAIT_L(0); PG8_MMA(0, 1, At, B1); S_BARRIER();
            PG8_LDA(At, 0, 1); PG8_STAGE_A(PG8_SA(0, 0), a2, (last ? (size_t)0 : (size_t)(t + 2) * kstep), 0, last);
            S_BARRIER(); WAIT_L(0); PG8_MMA(1, 0, At, B0); S_BARRIER(); SCHED_BAR();
            PG8_STAGE(PG8_SB(0, 1), b2 + hstep, voffB);
            WAIT_V(6); S_BARRIER(); PG8_MMA(1, 1, At, B1); S_BARRIER();
            PG8_LDB(B0, 1, 0); SCHED_BAR(); PG8_LDA(At, 1, 0); PG8_STAGE_A(PG8_SA(0, 1), a2 + hstep, (last ? (size_t)0 : (size_t)(t + 2) * kstep), 1, last);
            WAIT_L(8); S_BARRIER(); WAIT_L(0); PG8_MMA(0, 0, At, B0); S_BARRIER(); SCHED_BAR();
            PG8_LDB(B1, 1, 1); PG8_STAGE(PG8_SB(1, 0), b3, voffB);
            S_BARRIER(); WAIT_L(0); PG8_MMA(0, 1, At, B1); S_BARRIER();
            PG8_LDA(At, 1, 1); PG8_STAGE_A(PG8_SA(1, 0), a3, (last ? kstep : (size_t)(t + 3) * kstep), 0, last);
            S_BARRIER(); WAIT_L(0); PG8_MMA(1, 0, At, B0); S_BARRIER(); SCHED_BAR();
            PG8_STAGE(PG8_SB(1, 1), b3 + hstep, voffB);
            WAIT_V(6); S_BARRIER(); PG8_MMA(1, 1, At, B1); S_BARRIER();
        }
        E(acc, cur, wr, wc, fr, fq);
        if (!has_next) break;
#pragma unroll
        for (int a = 0; a < 2; ++a)
#pragma unroll
            for (int b = 0; b < 2; ++b)
#pragma unroll
                for (int m = 0; m < 4; ++m)
#pragma unroll
                    for (int n = 0; n < 2; ++n) acc[a][b][m][n] = (f32x4){0.f, 0.f, 0.f, 0.f};
        cur = nxt; cA = nA; cB = nB; ++ui;
        if constexpr (Sched::GATHER) {
#pragma unroll
            for (int h_ = 0; h_ < 2; ++h_) { va[h_][0] = vn[h_][0]; va[h_][1] = vn[h_][1]; } }
    }
    WAIT_V(0);
    if (wr == 0) S_BARRIER();
    S_BARRIER();
#undef PG8_SA
#undef PG8_SB
#undef PG8_STAGE
#undef PG8_STAGE_A
#undef PG8_GOFF
#undef PG8_LDA
#undef PG8_LDB
#undef PG8_MMA
}
}

__device__ __forceinline__ float row16_sum(float x) {
#ifdef EMU
    x += __shfl_xor(x, 1); x += __shfl_xor(x, 2); x += __shfl_xor(x, 4); x += __shfl_xor(x, 8); return x;
#else
#define DPPF(v, ctrl) __builtin_bit_cast(float, __builtin_amdgcn_update_dpp(0, __builtin_bit_cast(int, (v)), (ctrl), 0xF, 0xF, false))
    x += DPPF(x, 0xB1); x += DPPF(x, 0x4E); x += DPPF(x, 0x141); x += DPPF(x, 0x140); return x;
#undef DPPF
#endif
}
__device__ __forceinline__ float row32_sum(float x) {
    x = row16_sum(x);
#ifdef EMU
    x += __shfl_xor(x, 32); return x;
#else
    float a = x, b = x;
    asm volatile("s_nop 1\n\tv_permlane32_swap_b32 %0, %1" : "+v"(a), "+v"(b));
    return a + b;
#endif
}
__device__ __forceinline__ float wave_sum_fast(float x, int lane) {
    x = row32_sum(x);
    x += SHX(x, 16, lane);
    return x;
}
__device__ __forceinline__ void transpose_item(const float* W, int K, int N, bf16_t* WT, int k0, int n0, int dst_row0, float* scr, int lane) {
    const int n4 = (lane & 15) * 4, kr = lane >> 4;
#pragma unroll 8
    for (int i = 0; i < 16; ++i) {
        const int kk = 4 * i + kr;
        f32x4 v = (f32x4){0.f, 0.f, 0.f, 0.f};
        if (n0 + n4 < N) v = *(const f32x4*)(W + (size_t)(k0 + kk) * N + n0 + n4);
        float* d = scr + kk * 65 + n4; d[0] = v.x; d[1] = v.y; d[2] = v.z; d[3] = v.w;
    }
    WAVE_SYNC();
    const int c = lane & 7;
#pragma unroll
    for (int j = 0; j < 8; ++j) { const int n = (lane >> 3) + 8 * j; const float* sp = scr + (8 * c) * 65 + n;
        u32x4 o; o.x = pk2(sp[0 * 65], sp[1 * 65]); o.y = pk2(sp[2 * 65], sp[3 * 65]); o.z = pk2(sp[4 * 65], sp[5 * 65]); o.w = pk2(sp[6 * 65], sp[7 * 65]);
        *(u32x4*)(WT + (size_t)(dst_row0 + n) * K + k0 + 8 * c) = o; }
    WAVE_SYNC();
}
__device__ __forceinline__ void phase_prologue(const Params& P, unsigned char* smem, int wv) {
    ParamsPtr pp = PARAMS_PTR(P); PIN_S(pp); unsigned char* ws = pp->ws; int bidx = (int)blockIdx.x, gdim = (int)gridDim.x; PIN_S(bidx); PIN_S(gdim);
    const int tid = phase_tid(wv), lane = tid & 63, wave = tid >> 6;
    float* scr = (float*)smem + wave * (64 * 65);
    const int gw = bidx * NWAVES + wave, ngw = NWAVES * gdim;
    constexpr int I_IN = 16 * (PLD / 64), I_OUT = 16 * 16, I_W1 = NE * 16 * 32, I_W2 = NE * 16 * 16, I_L = I_IN + I_OUT + I_W1 + I_W2;
    for (int it = gw; it < NL * I_L; it += ngw) {
        const int l = it / I_L; int r = it % I_L;
        if (r < I_IN) { const int kb = r / (PLD / 64), nb = r % (PLD / 64);
            transpose_item(pp->in[1] + (size_t)l * D * PIN, D, PIN, (bf16_t*)(ws + O_WIN) + (size_t)l * PLD * D, kb * 64, nb * 64, nb * 64, scr, lane); continue; }
        r -= I_IN;
        if (r < I_OUT) { const int kb = r / 16, nb = r % 16;
            transpose_item(pp->in[21] + (size_t)l * D * D, D, D, (bf16_t*)(ws + O_WOUT) + (size_t)l * D * D, kb * 64, nb * 64, nb * 64, scr, lane); continue; }
        r -= I_OUT;
        if (r < I_W1) { const int e = r / (16 * 32), q = r % (16 * 32), kb = q / 32, nb = q % 32, n0 = nb * 64;
            const int dst = n0 < DFF ? (n0 / 128) * 256 + (n0 % 128) : ((n0 - DFF) / 128) * 256 + 128 + ((n0 - DFF) % 128);
            transpose_item(pp->in[26] + ((size_t)l * NE + e) * D * 2 * DFF, D, 2 * DFF, (bf16_t*)(ws + O_W1) + ((size_t)l * NE + e) * 2 * DFF * D, kb * 64, n0, dst, scr, lane); continue; }
        r -= I_W1;
        { const int e = r / (16 * 16), q = r % (16 * 16), kb = q / 16, nb = q % 16;
            transpose_item(pp->in[28] + ((size_t)l * NE + e) * DFF * D, DFF, D, (bf16_t*)(ws + O_W2) + ((size_t)l * NE + e) * D * DFF, kb * 64, nb * 64, nb * 64, scr, lane); }
    }
    {
        const float* gw_ = pp->in[4]; bf16_t* WSB = (bf16_t*)(ws + O_WSB);
        for (size_t i = ((size_t)bidx * NTHREADS + tid) * 4; i < (size_t)NL * GH * CH * CH; i += (size_t)gdim * NTHREADS * 4) {
            const f32x4 v = *(const f32x4*)(gw_ + i); u32x2 o; o.x = pk2(v.x, v.y); o.y = pk2(v.z, v.w); *(u32x2*)(WSB + i) = o;
        }
    }
    {
        bf16_t* LWT = (bf16_t*)(ws + O_LWT);
        for (int i = bidx * NTHREADS + tid; i < NL * 1920 * 128; i += gdim * NTHREADS) {
            const int k = i & 127, n = (i >> 7) % 1920, ll = i / (1920 * 128);
            float v = 0.f;
            if (n < 1536) { if (k < 64) { const int grp = n / 768, d = (n / 384) & 1, c = n % 384; v = (grp == 0 ? pp->in[8] : pp->in[10])[(((size_t)ll * 2 + d) * 64 + k) * RW + c]; } }
            else v = pp->in[11][((size_t)ll * 128 + k) * RW + (n - 1536)];
            LWT[i] = (bf16_t)f2bf(v);
        }
    }
    const float* x = pp->in[0]; bf16_t* XB = (bf16_t*)(ws + O_XB);
    for (size_t i = ((size_t)bidx * NTHREADS + tid) * 4; i < (size_t)T * D; i += (size_t)gdim * NTHREADS * 4) {
        const f32x4 v = *(const f32x4*)(x + i); u32x2 o; o.x = pk2(v.x, v.y); o.y = pk2(v.z, v.w); *(u32x2*)(XB + i) = o;
    }
}

__device__ __forceinline__ float tshift(const float* P, int t, int s, int col, const float* mu0, const float* mu1, int rc) {
    const float cur = P[(size_t)t * PLD + col];
    const float prv = s > 0 ? P[(size_t)(t - 1) * PLD + col] : 0.f;
    const float nxt = s < S - 1 ? P[(size_t)(t + 1) * PLD + col] : 0.f;
    return cur + mu0[rc] * (prv - cur) + mu1[rc] * (nxt - cur);
}

__device__ __forceinline__ void phase_prep(const Params& P, int l, unsigned char* smem, int wv) {
    ParamsPtr pp = PARAMS_PTR(P); PIN_S(pp); unsigned char* ws = pp->ws; int bidx = (int)blockIdx.x, gdim = (int)gridDim.x; PIN_S(bidx); PIN_S(gdim);
    const float* proj = (const float*)(ws + O_PROJ);
    float* UG = (float*)(ws + O_UG); bf16_t* VNT = (bf16_t*)(ws + O_VNT);
    float* RR = (float*)(ws + O_RR); float* VV = (float*)(ws + O_VV); float* KK = (float*)(ws + O_KK);
    float* KD = (float*)(ws + O_KD); float* ICLR = (float*)(ws + O_ICLR);
    float* GATE = (float*)(ws + O_GATE); float* BONUS = (float*)(ws + O_BONUS); float* LWG = (float*)(ws + O_LW);
    bf16_t* RB = (bf16_t*)(ws + O_RB); bf16_t* VB = (bf16_t*)(ws + O_VB); bf16_t* KKB = (bf16_t*)(ws + O_KKB); bf16_t* BBB = (bf16_t*)(ws + O_BBB); bf16_t* KDB = (bf16_t*)(ws + O_KDB);
#if !MK_RWKV_CHUNKED
    float* DEC = (float*)(ws + O_DEC); float* BRKR = (float*)(ws + O_BRKR);
#endif
    bf16_t* MQB = (bf16_t*)(ws + O_MQB); bf16_t* MKB = (bf16_t*)(ws + O_MKB); bf16_t* KT = (bf16_t*)(ws + O_KT); bf16_t* VT = (bf16_t*)(ws + O_VT);
    float* IG = (float*)(ws + O_IG); float* LF = (float*)(ws + O_LF);
    const bf16_t* LWT = (const bf16_t*)(ws + O_LWT) + (size_t)l * 1920 * 128;
    const float* gln_g = pp->in[2] + (size_t)l * GW; const float* gln_b = pp->in[3] + (size_t)l * GW;
    const float* mu0 = pp->in[6] + (size_t)l * 2 * RPROJ; const float* mu1 = mu0 + RPROJ;
    const float* w0 = pp->in[7] + (size_t)l * 2 * RW; const float* a0 = pp->in[9] + (size_t)l * 2 * RW;
    const float* k_k = pp->in[12] + (size_t)l * RW; const float* k_a = pp->in[13] + (size_t)l * RW; const float* r_k = pp->in[14] + (size_t)l * RW;
    const float* conv_w = pp->in[17] + (size_t)l * 3 * 768; const float* conv_b = pp->in[18] + (size_t)l * 768; const float* gate_b = pp->in[19] + (size_t)l * 24;
    float* win = (float*)smem;
    bf16_t* lin = (bf16_t*)(smem + 101376);
    bf16_t* tvn = (bf16_t*)(smem + 110592);
    bf16_t* tk = (bf16_t*)(smem + 118784);
    bf16_t* tv = (bf16_t*)(smem + 131072);
    constexpr int LIN = 264;
    const int tid = phase_tid(wv), lane = tid & 63, wave = tid >> 6, col = lane & 15, g = lane >> 4;
    for (int u = bidx; u < T / 16; u += gdim) {
        const int t0 = u * 16, s0 = t0 % S, bb = t0 / S;
        __syncthreads();
        {
            f32x4 wb[18];
#pragma unroll
            for (int row = 0; row < 18; ++row) {
                const int sq = s0 - 1 + row;
                wb[row] = (f32x4){0.f, 0.f, 0.f, 0.f};
                if (sq >= 0 && sq < S && tid < 352) wb[row] = *(const f32x4*)(proj + (size_t)(t0 - 1 + row) * PLD + C_RW + tid * 4);
            }
            if (tid < 352) {
#pragma unroll
                for (int row = 0; row < 18; ++row) *(f32x4*)(win + row * RPROJ + tid * 4) = wb[row];
            }
        }
        for (int rep_ = 0; rep_ < (MK_PROBE == 3 ? 2 : 1); ++rep_) {
            const int i = tid >> 5, l32 = tid & 31, t = t0 + i;
            float v[8], ug[8]; float sum = 0.f;
#pragma unroll
            for (int j = 0; j < 8; ++j) { const int c = j * 32 + l32; ug[j] = proj[(size_t)t * PLD + c]; v[j] = proj[(size_t)t * PLD + GW + c]; }
#pragma unroll
            for (int j = 0; j < 8; ++j) { const int c = j * 32 + l32; UG[(size_t)t * GW + c] = geluf_(ug[j]); v[j] = geluf_(v[j]); sum += v[j]; }
#pragma unroll
            for (int o = 16; o >= 1; o >>= 1) sum += SHX(sum, o, lane);
            const float mean = sum * (1.0f / GW); float q = 0.f;
#pragma unroll
            for (int j = 0; j < 8; ++j) { const float d = v[j] - mean; q += d * d; }
#pragma unroll
            for (int o = 16; o >= 1; o >>= 1) q += SHX(q, o, lane);
            const float rstd = 1.0f / sqrtf(q * (1.0f / GW) + LN_EPS);
#pragma unroll
            for (int j = 0; j < 8; ++j) { const int c = j * 32 + l32; tvn[c * 16 + i] = (bf16_t)f2bf((v[j] - mean) * rstd * gln_g[c] + gln_b[c]); }
        }
        __syncthreads();
        {
            const int hf = tid & 1, c = tid >> 1;
            *(u32x4*)(VNT + ((size_t)bb * GW + c) * S + s0 + hf * 8) = *(const u32x4*)(tvn + c * 16 + hf * 8);
        }
        for (int idx = tid; idx < 16 * 256; idx += NTHREADS) {
            const int i = idx >> 8, j = idx & 255, rc = 1152 + j;
            const float pv = win[i * RPROJ + rc], cv = win[(i + 1) * RPROJ + rc], nv = win[(i + 2) * RPROJ + rc];
            const float x = cv + mu0[rc] * (pv - cv) + mu1[rc] * (nv - cv);
            lin[i * LIN + j] = (bf16_t)f2bf(j < 64 ? ftanh(x) : (j < 128 ? x : sigmoidf_(x)));
        }
        __syncthreads();
        for (int rep_ = 0; rep_ < (MK_PROBE == 1 ? 2 : 1); ++rep_) {
#pragma unroll 1
            for (int qg = 0; qg < 3; ++qg) {
                bf16x8 bw_[5][4]; float bias_[5];
#pragma unroll
                for (int q5 = 0; q5 < 5; ++q5) {
                    const int nt = wave * 15 + qg * 5 + q5, grp = nt / 24, c = (nt % 24) * 16 + col;
                    const bf16_t* bw = LWT + (size_t)(nt * 16 + col) * 128 + 8 * g;
#pragma unroll
                    for (int ks = 0; ks < 4; ++ks) bw_[q5][ks] = *(const bf16x8*)(bw + ks * 32);
                    bias_[q5] = grp < 2 ? w0[grp * RW + c] : (grp < 4 ? a0[(grp - 2) * RW + c] : 0.f);
                }
#pragma unroll
                for (int q5 = 0; q5 < 5; ++q5) {
                    const int nt = wave * 15 + qg * 5 + q5, grp = nt / 24, c = (nt % 24) * 16 + col;
                    const int kcol = grp < 2 ? 0 : (grp < 4 ? 64 : 128);
                    f32x4 acc = (f32x4){0.f, 0.f, 0.f, 0.f};
#pragma unroll
                    for (int ks = 0; ks < 2; ++ks) acc = MFMA16(*(const bf16x8*)(lin + col * LIN + kcol + ks * 32 + 8 * g), bw_[q5][ks], acc);
                    if (grp == 4) {
#pragma unroll
                        for (int ks = 2; ks < 4; ++ks) acc = MFMA16(*(const bf16x8*)(lin + col * LIN + kcol + ks * 32 + 8 * g), bw_[q5][ks], acc);
                    }
                    if (grp < 2) {
#pragma unroll
                        for (int r = 0; r < 4; ++r) { const float lw = -fexp(-softplusf_(-(acc[r] + bias_[q5])) - 0.5f); const size_t o = (size_t)grp * T * RW + (size_t)(t0 + 4 * g + r) * RW + c; LWG[o] = lw;
#if !MK_RWKV_CHUNKED
                            DEC[o] = expf(lw);
#endif
                        }
                    } else if (grp < 4) {
#pragma unroll
                        for (int r = 0; r < 4; ++r) ICLR[(size_t)(grp - 2) * T * RW + (size_t)(t0 + 4 * g + r) * RW + c] = sigmoidf_(acc[r] + bias_[q5]);
                    } else {
#pragma unroll
                        for (int r = 0; r < 4; ++r) GATE[(size_t)(t0 + 4 * g + r) * RW + c] = acc[r];
                    }
                }
            }
        }
        __syncthreads();
        for (int rep_ = 0; rep_ < (MK_PROBE == 2 ? 2 : 1); ++rep_) if (wave < 6) {
            const int c = tid, h = wave;
            const float kkc = k_k[c], kac = k_a[c], rkc = r_k[c];
            const float m0r = mu0[c], m1r = mu1[c], m0k = mu0[RW + c], m1k = mu1[RW + c], m0v = mu0[2 * RW + c], m1v = mu1[2 * RW + c];
            float ic0[16], ic1[16];
#pragma unroll
            for (int i = 0; i < 16; ++i) { const size_t o = (size_t)(t0 + i) * RW + c; ic0[i] = ICLR[o]; ic1[i] = ICLR[(size_t)T * RW + o]; }
#pragma unroll
            for (int i = 0; i < 16; ++i) {
                const int t = t0 + i;
                const float* w_ = win + i * RPROJ + c;
                const float rp = w_[0], rc_ = w_[RPROJ], rn = w_[2 * RPROJ];
                const float kp = w_[RW], kc_ = w_[RPROJ + RW], kn = w_[2 * RPROJ + RW];
                const float vp = w_[2 * RW], vc_ = w_[RPROJ + 2 * RW], vn = w_[2 * RPROJ + 2 * RW];
                const float r = rc_ + m0r * (rp - rc_) + m1r * (rn - rc_);
                const float k = kc_ + m0k * (kp - kc_) + m1k * (kn - kc_);
                const float v = vc_ + m0v * (vp - vc_) + m1v * (vn - vc_);
                const size_t o = (size_t)t * RW + c;
                const float kq = k * kkc;
                const float n2 = wave_sum_fast(kq * kq, lane);
                const float kk = kq / fmaxf(sqrtf(n2), 1e-12f);
                const float kd0 = k * (1.0f + (ic0[i] - 1.0f) * kac), kd1 = k * (1.0f + (ic1[i] - 1.0f) * kac);
                const float bon = wave_sum_fast(r * (kd0 + kd1) * rkc, lane);
#if MK_RWKV_CHUNKED
                RB[o] = (bf16_t)f2bf(r); VB[o] = (bf16_t)f2bf(v); KKB[o] = (bf16_t)f2bf(kk);
                BBB[o] = (bf16_t)f2bf(kk * ic0[i]); BBB[(size_t)T * RW + o] = (bf16_t)f2bf(kk * ic1[i]);
                KDB[o] = (bf16_t)f2bf(kd0); KDB[(size_t)T * RW + o] = (bf16_t)f2bf(kd1);
#else
                RR[o] = r; VV[o] = v; KK[o] = kk;
                KD[o] = kd0; KD[(size_t)T * RW + o] = kd1;
#endif
                if (lane == 0) BONUS[(size_t)t * RH + h] = bon;
#if !MK_RWKV_CHUNKED
                { const float br0 = wave_sum(kk * ic0[i] * r, lane), br1 = wave_sum(kk * ic1[i] * r, lane), kr0 = wave_sum(kd0 * r, lane), kr1 = wave_sum(kd1 * r, lane);
                  if (lane == 0) { BRKR[((size_t)t * RH + h) * 2] = br0; BRKR[((size_t)t * RH + h) * 2 + 1] = kr0; BRKR[((size_t)(T + t) * RH + h) * 2] = br1; BRKR[((size_t)(T + t) * RH + h) * 2 + 1] = kr1; } }
#endif
            }
        }
        __syncthreads();
        {
            f32x4 wb[9], vb[3];
            const int rsel = tid >= 192 ? 1 : 0, c4 = tid - rsel * 192;
#pragma unroll
            for (int it = 0; it < 9; ++it) {
                const int row = 2 * it + rsel, sq = s0 - 1 + row;
                wb[it] = (f32x4){0.f, 0.f, 0.f, 0.f};
                if (tid < 384 && sq >= 0 && sq < S) wb[it] = *(const f32x4*)(proj + (size_t)(t0 - 1 + row) * PLD + C_MW + c4 * 4);
            }
#pragma unroll
            for (int it = 0; it < 3; ++it) { const int idx = tid + it * NTHREADS, i = idx / 96, cc = (idx % 96) * 4; vb[it] = *(const f32x4*)(proj + (size_t)(t0 + i) * PLD + C_MW + 2 * MW + cc); }
            if (tid < 384) {
#pragma unroll
                for (int it = 0; it < 9; ++it) *(f32x4*)(win + (2 * it + rsel) * 768 + c4 * 4) = wb[it];
            }
#pragma unroll
            for (int it = 0; it < 3; ++it) { const int idx = tid + it * NTHREADS, i = idx / 96, cc = (idx % 96) * 4; const f32x4 v = vb[it];
                tv[(cc + 0) * 16 + i] = (bf16_t)f2bf(v.x); tv[(cc + 1) * 16 + i] = (bf16_t)f2bf(v.y); tv[(cc + 2) * 16 + i] = (bf16_t)f2bf(v.z); tv[(cc + 3) * 16 + i] = (bf16_t)f2bf(v.w); }
        }
        for (int idx = tid; idx < 16 * 24; idx += NTHREADS) {
            const int i = idx / 24, gi = idx % 24, t = t0 + i;
            const int isf = gi / 12, dir = (gi / 6) & 1, h = gi % 6;
            const float gg = proj[(size_t)t * PLD + 3456 + gi] + gate_b[gi];
            if (isf) LF[((size_t)dir * T + t) * MH + h] = -softplusf_(-gg); else IG[((size_t)dir * T + t) * MH + h] = gg;
        }
        __syncthreads();
        for (int rep_ = 0; rep_ < (MK_PROBE == 4 ? 2 : 1); ++rep_)
        for (int idx = tid; idx < 16 * 768; idx += NTHREADS) {
            const int i = idx / 768, c = idx % 768, t = t0 + i;
            const float* w_ = win + i * 768 + c;
            float y = conv_b[c] + w_[0] * conv_w[c] + w_[768] * conv_w[768 + c] + w_[1536] * conv_w[2 * 768 + c];
            y = y * sigmoidf_(y);
            if (c < MW) MQB[(size_t)t * MW + c] = (bf16_t)f2bf(y);
            else { const bf16_t kb = (bf16_t)f2bf(y * 0.125f); MKB[(size_t)t * MW + (c - MW)] = kb; tk[(c - MW) * 16 + i] = kb; }
        }
        __syncthreads();
        for (int idx = tid; idx < 2 * MW * 2; idx += NTHREADS) {
            const int hf = idx & 1, c = (idx >> 1) % MW, which = idx / (2 * MW);
            const u32x4 val = *(const u32x4*)((which ? tv : tk) + c * 16 + hf * 8);
            bf16_t* dst = (which ? VT : KT) + ((size_t)(bb * MH) * 64 + c) * S + s0 + hf * 8;
            *(u32x4*)dst = val;
        }
    }
    __syncthreads();
}

__device__ __forceinline__ void phase_gmlp_mix(const Params& P, int l, unsigned char* smem, int wv, int bid, int nb) {
    PIN_S(bid); PIN_S(nb);
    ParamsPtr pp = PARAMS_PTR(P); PIN_S(pp); unsigned char* ws = pp->ws;
    const float* UG = (const float*)(ws + O_UG); const bf16_t* VNT = (const bf16_t*)(ws + O_VNT); bf16_t* GRP = (bf16_t*)(ws + O_GRP);
    const bf16_t* WSB = (const bf16_t*)(ws + O_WSB) + (size_t)l * GH * CH * CH; const float* gbs = pp->in[5] + (size_t)l * GH * CH;
    const int tid = phase_tid(wv), lane = tid & 63, wave = tid >> 6, col = lane & 15, g = lane >> 4;
    for (int u = bid; u < NB * NCH * GH; u += nb) {
        const int h = u % GH, c = (u / GH) % NCH, b = u / (GH * NCH);
        const int tok0 = b * S + c * CH;
        const bf16_t* wb = WSB + (size_t)h * CH * CH + (size_t)(wave * 16 + col) * CH + 8 * g;
        const bf16_t* vb = VNT + ((size_t)b * GW + h * 64 + col) * S + (size_t)c * CH + 8 * g;
        f32x4 acc[4];
#pragma unroll
        for (int et = 0; et < 4; ++et) acc[et] = (f32x4){0.f, 0.f, 0.f, 0.f};
#pragma unroll
        for (int ks = 0; ks < 4; ++ks) {
            const bf16x8 af = *(const bf16x8*)(wb + ks * 32);
#pragma unroll
            for (int et = 0; et < 4; ++et) acc[et] = MFMA16(af, *(const bf16x8*)(vb + (size_t)et * 16 * S + ks * 32), acc[et]);
        }
#pragma unroll
        for (int r = 0; r < 4; ++r) {
            const int p = wave * 16 + 4 * g + r; const size_t t = (size_t)(tok0 + p); const float bsv = gbs[h * CH + p];
#pragma unroll
            for (int et = 0; et < 4; ++et) { const int ch = h * 64 + et * 16 + col; GRP[t * D + ch] = (bf16_t)f2bf(UG[t * GW + ch] * (acc[et][r] + bsv)); }
        }
    }
}

constexpr int SC_STEPS = 16;
constexpr int SC_BUF = SC_STEPS * 6 * 64;
__device__ __forceinline__ void phase_rwkv_scan(const Params& P, int l, unsigned char* smem, int wv, int bid, int nb) {
    PIN_S(bid); PIN_S(nb);
    ParamsPtr pp = PARAMS_PTR(P); PIN_S(pp); unsigned char* ws = pp->ws;
    const float* RR = (const float*)(ws + O_RR); const float* VV = (const float*)(ws + O_VV); const float* KK = (const float*)(ws + O_KK);
    const float* DEC = (const float*)(ws + O_DEC); const float* KD = (const float*)(ws + O_KD); const float* ICLR = (const float*)(ws + O_ICLR);
    float* SCAN = (float*)(ws + O_SCAN); const float* BRKR = (const float*)(ws + O_BRKR);
    const int tid = phase_tid(wv), lane = tid & 63, wave = tid >> 6, rl = (lane >> 4) & 1, kq = (lane & 15) | ((lane >> 5) << 4);
    float* buf = (float*)smem;
    float* scal = buf + 2 * SC_BUF;
    float* outb = scal + 2 * SC_STEPS * 2;
    typedef float f32x2 __attribute__((ext_vector_type(2)));
    for (int u = bid; u < 2 * NB * RH * 4; u += nb) {
        const int qt = u & 3, h = (u >> 2) % RH, b = (u / (4 * RH)) % NB, d = u / (4 * RH * NB);
        const size_t doff = (size_t)d * T * RW;
        float s0 = 0.f, s1 = 0.f;
        float pw[2], pa[2], pb[2], pk[2], pr[2], pv[2], psc = 0.f;
#define SC_LOAD(c) do { _Pragma("unroll") for (int i = 0; i < 2; ++i) { const int idx = tid + NTHREADS * i, st = idx >> 6, k = idx & 63; const int tau = (c) * SC_STEPS + st, sq = d ? S - 1 - tau : tau; \
            const size_t o = (size_t)(b * S + sq) * RW + h * 64 + k; \
            pw[i] = DEC[doff + o]; pa[i] = KK[o]; pb[i] = ICLR[doff + o]; pk[i] = KD[doff + o]; pr[i] = RR[o]; pv[i] = VV[o]; }     \
            if (tid < 2 * SC_STEPS) { const int tau = (c) * SC_STEPS + (tid >> 1), sq = d ? S - 1 - tau : tau; psc = BRKR[((size_t)(d * T + b * S + sq) * RH + h) * 2 + (tid & 1)]; } } while (0)
#define SC_WRITE(c) do { float* B_ = buf + ((c) & 1) * SC_BUF; _Pragma("unroll") for (int i = 0; i < 2; ++i) { const int idx = tid + NTHREADS * i, st = idx >> 6, k = idx & 63; \
            float* q_ = B_ + st * 384 + k; q_[0] = pw[i]; q_[64] = -pa[i]; q_[128] = pa[i] * pb[i]; q_[192] = pk[i]; q_[256] = pw[i] * pr[i]; q_[320] = pv[i]; } \
            if (tid < 2 * SC_STEPS) scal[((c) & 1) * SC_STEPS * 2 + tid] = psc; } while (0)
        __syncthreads();
        SC_LOAD(0); SC_WRITE(0);
        __syncthreads();
        const int row = qt * 16 + wave * 2 + rl;
        for (int c = 0; c < S / SC_STEPS; ++c) {
            const bool more = (c + 1) < S / SC_STEPS;
            if (more) SC_LOAD(c + 1);
            const float* B = buf + (c & 1) * SC_BUF; const float* sc = scal + (c & 1) * SC_STEPS * 2; float* ob = outb + (c & 1) * SC_STEPS * 16;
            float outs[SC_STEPS];
            f32x2 w2 = *(const f32x2*)(B + 2 * kq), a2 = *(const f32x2*)(B + 64 + 2 * kq), b2 = *(const f32x2*)(B + 128 + 2 * kq);
            f32x2 k2 = *(const f32x2*)(B + 192 + 2 * kq), wr2 = *(const f32x2*)(B + 256 + 2 * kq);
            float v = B[320 + row]; float br = sc[0], kr = sc[1];
#pragma unroll
            for (int st = 0; st < SC_STEPS; ++st) {
                const int sn = st + 1 < SC_STEPS ? st + 1 : st;
                const float* q = B + sn * 384;
                const f32x2 nw2 = *(const f32x2*)(q + 2 * kq), na2 = *(const f32x2*)(q + 64 + 2 * kq), nb2 = *(const f32x2*)(q + 128 + 2 * kq);
                const f32x2 nk2 = *(const f32x2*)(q + 192 + 2 * kq), nwr2 = *(const f32x2*)(q + 256 + 2 * kq);
                const float nv = q[320 + row], nbr = sc[sn * 2], nkr = sc[sn * 2 + 1];
                SCHED_BAR();
                float sa = s0 * a2.x + s1 * a2.y;
                float po = s0 * wr2.x + s1 * wr2.y;
                sa = row32_sum(sa); po = row32_sum(po);
                outs[st] = po + sa * br + v * kr;
                s0 = s0 * w2.x + (sa * b2.x + v * k2.x); s1 = s1 * w2.y + (sa * b2.y + v * k2.y);
                SCHED_BAR();
                w2 = nw2; a2 = na2; b2 = nb2; k2 = nk2; wr2 = nwr2; v = nv; br = nbr; kr = nkr;
            }
            if (kq == 0) {
#pragma unroll
                for (int st = 0; st < SC_STEPS; ++st) ob[st * 16 + wave * 2 + rl] = outs[st];
            }
            if (more) SC_WRITE(c + 1);
            __syncthreads();
            if (tid < 16 * SC_STEPS) {
                const int st = tid >> 4, r = tid & 15, tau = c * SC_STEPS + st, sq = d ? S - 1 - tau : tau;
                SCAN[doff + (size_t)(b * S + sq) * RW + h * 64 + qt * 16 + r] = ob[st * 16 + r];
            }
        }
#undef SC_LOAD
#undef SC_WRITE
    }
    __syncthreads();
}

constexpr int RST = 72;
constexpr int RARR = 64 * RST;
__device__ __forceinline__ f32x4 tile_nt(const bf16_t* Aa, int ta, const bf16_t* Ba, int tb, f32x4 acc, int col, int g) {
#pragma unroll
    for (int ks = 0; ks < 2; ++ks) {
        const bf16x8 af = *(const bf16x8*)(Aa + (ta * 16 + col) * RST + ks * 32 + 8 * g);
        const bf16x8 bfr = *(const bf16x8*)(Ba + (tb * 16 + col) * RST + ks * 32 + 8 * g);
        acc = MFMA16(af, bfr, acc);
    }
    return acc;
}
__device__ __forceinline__ void phase_rwkv_pre(const Params& P, int l, unsigned char* smem, int wv) {
    ParamsPtr pp = PARAMS_PTR(P); PIN_S(pp); unsigned char* ws = pp->ws; int bidx = (int)blockIdx.x, gdim = (int)gridDim.x; PIN_S(bidx); PIN_S(gdim);
    const bf16_t* RB = (const bf16_t*)(ws + O_RB); const bf16_t* VB = (const bf16_t*)(ws + O_VB); const bf16_t* KKB = (const bf16_t*)(ws + O_KKB);
    const float* LWG = (const float*)(ws + O_LW); const bf16_t* KDB = (const bf16_t*)(ws + O_KDB); const bf16_t* BBB = (const bf16_t*)(ws + O_BBB);
    bf16_t* Qg = (bf16_t*)(ws + O_RQ); bf16_t* Ag = (bf16_t*)(ws + O_RA); bf16_t* Hg = (bf16_t*)(ws + O_RH); bf16_t* Gg = (bf16_t*)(ws + O_RG);
    const int tid0 = phase_tid(wv);
#define RW_STAGE_VARS int tid = tid0; PIN_V(tid); const int lane = tid & 63, wave = tid >> 6, col = lane & 15, g = lane >> 4; (void)lane; (void)wave; (void)col; (void)g;
    bf16_t* At = (bf16_t*)smem; bf16_t* Bt = At + RARR; bf16_t* Kt = Bt + RARR; bf16_t* Rt = Kt + RARR;
    bf16_t* BtT = Rt + RARR; bf16_t* KtT = BtT + RARR; bf16_t* VT = KtT + RARR;
    bf16_t* Lak = VT + RARR; bf16_t* Mrb = Lak + RARR; bf16_t* Mrk = Mrb + RARR; bf16_t* YT = Mrk + RARR; bf16_t* W2T = YT + RARR;
    bf16_t* Lbo = W2T + RARR;
    float* LabT = (float*)(Lbo + RARR);
    float* Xs = LabT + 4096;
    float* Pb = Xs + 4096;
    float* segs = Pb + 2048;
    float* PC = segs + 512;
    float plw[8]; unsigned pkk[8], pbq[8], pkd[8], prr[8], pvv[8];
#define RW_LOAD(uu) do { const int c_ = (uu) % RNC, h_ = ((uu) / RNC) % RH, b_ = ((uu) / (RNC * RH)) % NB, d_ = (uu) / (RNC * RH * NB); const size_t doff_ = (size_t)d_ * T * RW; \
        const int ch_ = tid0 & 63, sg_ = tid0 >> 6; _Pragma("unroll") for (int j = 0; j < 8; ++j) { const int tau = c_ * RC + sg_ * 8 + j, sq = d_ ? S - 1 - tau : tau; const size_t o = (size_t)(b_ * S + sq) * RW + h_ * 64 + ch_; \
        plw[j] = LWG[doff_ + o]; pkk[j] = KKB[o]; pbq[j] = BBB[doff_ + o]; pkd[j] = KDB[doff_ + o]; prr[j] = RB[o]; pvv[j] = VB[o]; } } while (0)
    if (bidx < RUN) RW_LOAD(bidx);
    for (int u = bidx; u < RUN; u += gdim) {
        const int c = u % RNC, h = (u / RNC) % RH, b = (u / (RNC * RH)) % NB, d = u / (RNC * RH * NB);
        (void)c; (void)h; (void)b; (void)d;
        __syncthreads();
        {
            RW_STAGE_VARS
            const int ch = tid & 63, sg = tid >> 6;
            float lw[8]; unsigned kk[8], bq_[8], kd[8], rr[8], vv[8];
#pragma unroll
            for (int j = 0; j < 8; ++j) { lw[j] = plw[j]; kk[j] = pkk[j]; bq_[j] = pbq[j]; kd[j] = pkd[j]; rr[j] = prr[j]; vv[j] = pvv[j]; }
            if (u + gdim < RUN) RW_LOAD(u + gdim);
            float run = 0.f;
#pragma unroll
            for (int j = 0; j < 8; ++j) { run += lw[j]; lw[j] = run; }
            segs[sg * 64 + ch] = run;
            __syncthreads();
            float off = 0.f;
            for (int q = 0; q < sg; ++q) off += segs[q * 64 + ch];
            u32x4 pbt, pkt, pvt; unsigned tb[8], tk[8], tvv[8];
            float prev = off;
#pragma unroll
            for (int j = 0; j < 8; ++j) {
                const int t = sg * 8 + j; const float cl = off + lw[j];
                const float ep = fexp(prev), en = fexp(-cl), epc = fexp(cl);
                const unsigned a_ = f2bf(-bf_lo(kk[j]) * ep), b_ = f2bf(bf_lo(bq_[j]) * en), k_ = f2bf(bf_lo(kd[j]) * en), r_ = f2bf(bf_lo(rr[j]) * epc), v_ = vv[j];
                At[t * RST + ch] = (bf16_t)a_; Bt[t * RST + ch] = (bf16_t)b_; Kt[t * RST + ch] = (bf16_t)k_; Rt[t * RST + ch] = (bf16_t)r_;
                tb[j] = b_; tk[j] = k_; tvv[j] = v_;
                prev = cl;
            }
            if (sg == 7) PC[ch] = fexp(prev);
            pbt.x = tb[0] | (tb[1] << 16); pbt.y = tb[2] | (tb[3] << 16); pbt.z = tb[4] | (tb[5] << 16); pbt.w = tb[6] | (tb[7] << 16);
            pkt.x = tk[0] | (tk[1] << 16); pkt.y = tk[2] | (tk[3] << 16); pkt.z = tk[4] | (tk[5] << 16); pkt.w = tk[6] | (tk[7] << 16);
            pvt.x = tvv[0] | (tvv[1] << 16); pvt.y = tvv[2] | (tvv[3] << 16); pvt.z = tvv[4] | (tvv[5] << 16); pvt.w = tvv[6] | (tvv[7] << 16);
            *(u32x4*)(BtT + ch * RST + sg * 8) = pbt; *(u32x4*)(KtT + ch * RST + sg * 8) = pkt; *(u32x4*)(VT + ch * RST + sg * 8) = pvt;
            for (int z_ = tid; z_ < 2 * RARR / 8; z_ += NTHREADS) ((u32x4*)YT)[z_] = (u32x4){0u, 0u, 0u, 0u};
        }
        __syncthreads();
        {
            RW_STAGE_VARS
            const int m = wave >> 1;
            const bf16_t* Ym = (m == 0 || m == 2) ? Bt : Kt; const bf16_t* Xm = (m < 2) ? At : Rt;
#pragma unroll 1
            for (int q = 0; q < 8; ++q) {
                const int tix = (wave & 1) * 8 + q, it = tix >> 2, tt = tix & 3;
                f32x4 acc = (f32x4){0.f, 0.f, 0.f, 0.f};
                if (it <= tt) acc = tile_nt(Ym, it, Xm, tt, acc, col, g);
                const int t = tt * 16 + col, i0 = it * 16 + 4 * g;
                float o4[4];
#pragma unroll
                for (int r = 0; r < 4; ++r) { const int i = i0 + r; const bool ok = m < 2 ? (i < t) : (i <= t); o4[r] = ok ? acc[r] : 0.f; }
                if (m == 0) {
#pragma unroll
                    for (int r = 0; r < 4; ++r) LabT[(i0 + r) * 64 + t] = o4[r];
                    const bool offd = it < tt;
                    u32x2 w2; w2.x = offd ? pk2(o4[0], o4[1]) : 0u; w2.y = offd ? pk2(o4[2], o4[3]) : 0u; *(u32x2*)(Lbo + t * RST + i0) = w2;
                }
                else { bf16_t* dst = (m == 1 ? Lak : (m == 2 ? Mrb : Mrk)) + t * RST + i0; u32x2 w2; w2.x = pk2(o4[0], o4[1]); w2.y = pk2(o4[2], o4[3]); *(u32x2*)dst = w2; }
            }
        }
        __syncthreads();
        {
            RW_STAGE_VARS
#pragma unroll
            for (int q = 0; q < 2; ++q) {
                const int tix = wave * 2 + q, tt = tix >> 2, et = tix & 3;
                f32x4 acc = (f32x4){0.f, 0.f, 0.f, 0.f};
                acc = tile_nt(Lak, tt, VT, et, acc, col, g);
#pragma unroll
                for (int r = 0; r < 4; ++r) Xs[(tt * 16 + 4 * g + r) * 64 + et * 16 + col] = acc[r];
            }
        }
        __syncthreads();
        {
            RW_STAGE_VARS
#pragma unroll 1
            for (int bb = 0; bb < 4; ++bb) {
                if (bb > 0) {
                    const bf16_t* Zt = (wave < 4 ? YT : W2T) + ((wave & 3) * 16 + col) * RST + 8 * g;
                    const bf16_t* La = Lbo + (16 * bb + col) * RST + 8 * g;
                    f32x4 acc = (f32x4){0.f, 0.f, 0.f, 0.f};
                    acc = MFMA16(*(const bf16x8*)La, *(const bf16x8*)Zt, acc);
                    if (bb > 2) acc = MFMA16(*(const bf16x8*)(La + 32), *(const bf16x8*)(Zt + 32), acc);
#pragma unroll
                    for (int r = 0; r < 4; ++r) Pb[(4 * g + r) * 128 + wave * 16 + col] = acc[r];
                }
                __syncthreads();
                if (wave < 2) {
                    float acc[16];
                    if (wave == 0) {
#pragma unroll
                        for (int r = 0; r < 16; ++r) acc[r] = bf_lo((unsigned)At[(16 * bb + r) * RST + lane]);
                    } else {
#pragma unroll
                        for (int r = 0; r < 16; ++r) acc[r] = Xs[(16 * bb + r) * 64 + lane];
                    }
                    if (bb > 0) {
#pragma unroll
                        for (int r = 0; r < 16; ++r) acc[r] += Pb[r * 128 + wave * 64 + lane];
                    }
                    const float* dp = LabT + (16 * bb) * 64 + 16 * bb;
#pragma unroll
                    for (int r = 1; r < 16; ++r)
#pragma unroll
                        for (int r2 = 0; r2 < r; ++r2) acc[r] += dp[r2 * 64 + r] * acc[r2];
                    bf16_t* dst = (wave == 0 ? YT : W2T) + lane * RST;
                    u32x4 w0, w1;
                    w0.x = pk2(acc[0], acc[1]); w0.y = pk2(acc[2], acc[3]); w0.z = pk2(acc[4], acc[5]); w0.w = pk2(acc[6], acc[7]);
                    w1.x = pk2(acc[8], acc[9]); w1.y = pk2(acc[10], acc[11]); w1.z = pk2(acc[12], acc[13]); w1.w = pk2(acc[14], acc[15]);
                    *(u32x4*)(dst + 16 * bb) = w0; *(u32x4*)(dst + 16 * bb + 8) = w1;
                }
                __syncthreads();
            }
        }
        __syncthreads();
        {
            RW_STAGE_VARS
            const int ty = wave >> 1;
#pragma unroll 1
            for (int q = 0; q < 8; ++q) {
                const int tix = (wave & 1) * 8 + q, ra = tix >> 2, cb = tix & 3;
                f32x4 acc = (f32x4){0.f, 0.f, 0.f, 0.f};
                if (ty == 0) {
                    acc = tile_nt(Mrb, ra, YT, cb, acc, col, g);
#pragma unroll
                    for (int r = 0; r < 4; ++r) { const int t = ra * 16 + 4 * g + r, k = cb * 16 + col; Qg[(size_t)u * 4096 + t * 64 + k] = (bf16_t)f2bf(acc[r] + bf_lo((unsigned)Rt[t * RST + k])); }
                } else if (ty == 1) {
                    acc = tile_nt(Mrb, ra, W2T, cb, acc, col, g); acc = tile_nt(Mrk, ra, VT, cb, acc, col, g);
                    { u32x2 hb; hb.x = pk2(acc[0], acc[1]); hb.y = pk2(acc[2], acc[3]); *(u32x2*)(Hg + (size_t)u * 4096 + (tix * 64 + lane) * 4) = hb; }
                } else if (ty == 2) {
                    acc = tile_nt(BtT, ra, YT, cb, acc, col, g);
#pragma unroll
                    for (int r = 0; r < 4; ++r) { const int k1 = ra * 16 + 4 * g + r, k = cb * 16 + col; Ag[(size_t)u * 4096 + k1 * 64 + k] = (bf16_t)f2bf(PC[k1] * (acc[r] + (k1 == k ? 1.0f : 0.f))); }
                } else {
                    acc = tile_nt(BtT, ra, W2T, cb, acc, col, g); acc = tile_nt(KtT, ra, VT, cb, acc, col, g);
#pragma unroll
                    for (int r = 0; r < 4; ++r) acc[r] *= PC[ra * 16 + 4 * g + r];
                    { u32x2 gb2; gb2.x = pk2(acc[0], acc[1]); gb2.y = pk2(acc[2], acc[3]); *(u32x2*)(Gg + (size_t)u * 4096 + (tix * 64 + lane) * 4) = gb2; }
                }
            }
        }
    }
    __syncthreads();
#undef RW_STAGE_VARS
#undef RW_LOAD
}
__device__ __forceinline__ void phase_rwkv_seq(const Params& P, int l, unsigned char* smem, int wv) {
    ParamsPtr pp = PARAMS_PTR(P); PIN_S(pp); unsigned char* ws = pp->ws; int bidx = (int)blockIdx.x, gdim = (int)gridDim.x; PIN_S(bidx); PIN_S(gdim);
    const bf16_t* Ag = (const bf16_t*)(ws + O_RA); const bf16_t* Gg = (const bf16_t*)(ws + O_RG); bf16_t* Sg = (bf16_t*)(ws + O_RS);
    const int tid = phase_tid(wv), lane = tid & 63, wave = tid >> 6, col = lane & 15, g = lane >> 4;
    const int gw = wave * gdim + bidx, ngw = NWAVES * gdim;
    for (int un = gw; un < 2 * NB * RH * 2; un += ngw) {
        const int ch = un >> 1, eh = un & 1;
        f32x4 acc[4][2];
#pragma unroll
        for (int a_ = 0; a_ < 4; ++a_)
#pragma unroll
            for (int b_ = 0; b_ < 2; ++b_) acc[a_][b_] = (f32x4){0.f, 0.f, 0.f, 0.f};
        u32x2 alo[4][2], ahi[4][2]; u32x2 gq[4][2];
        const unsigned aoff = (unsigned)(col * 64 + 4 * g), goff = (unsigned)(lane * 4);
#define RS_LOAD(cc) do { const bf16_t* ab_ = Ag + (size_t)(ch * RNC + (cc)) * 4096; const bf16_t* gb_ = Gg + (size_t)(ch * RNC + (cc)) * 4096 + eh * 512; \
            _Pragma("unroll") for (int ra = 0; ra < 4; ++ra) _Pragma("unroll") for (int p = 0; p < 2; ++p) { alo[ra][p] = *(const u32x2*)(ab_ + (ra * 1024 + p * 32) + aoff); ahi[ra][p] = *(const u32x2*)(ab_ + (ra * 1024 + p * 32 + 16) + aoff); } \
            _Pragma("unroll") for (int ra = 0; ra < 4; ++ra) _Pragma("unroll") for (int cb = 0; cb < 2; ++cb) gq[ra][cb] = *(const u32x2*)(gb_ + ((ra * 4 + cb) * 256) + goff); } while (0)
        RS_LOAD(0);
#pragma unroll 1
        for (int c = 0; c < RNC; ++c) {
            bf16_t* sb_ = Sg + (size_t)(ch * RNC + c) * 4096 + eh * 2048;
            bf16x8 bq[2][2];
#pragma unroll
            for (int cb = 0; cb < 2; ++cb) {
#pragma unroll
                for (int ra = 0; ra < 4; ++ra) {
                    u32x2 w2; w2.x = pk2(acc[ra][cb][0], acc[ra][cb][1]); w2.y = pk2(acc[ra][cb][2], acc[ra][cb][3]);
                    *(u32x2*)(sb_ + (cb * 1024 + ra * 16) + aoff) = w2;
                }
#pragma unroll
                for (int p = 0; p < 2; ++p) bq[p][cb] = cvt8(acc[2 * p][cb], acc[2 * p + 1][cb]);
            }
            u32x4 af[4][2];
#pragma unroll
            for (int ra = 0; ra < 4; ++ra) {
#pragma unroll
                for (int p = 0; p < 2; ++p) af[ra][p] = (u32x4){alo[ra][p].x, alo[ra][p].y, ahi[ra][p].x, ahi[ra][p].y};
#pragma unroll
                for (int cb = 0; cb < 2; ++cb) acc[ra][cb] = (f32x4){bf_lo(gq[ra][cb].x), bf_hi(gq[ra][cb].x), bf_lo(gq[ra][cb].y), bf_hi(gq[ra][cb].y)};
            }
            if (c + 1 < RNC) RS_LOAD(c + 1);
#pragma unroll
            for (int ra = 0; ra < 4; ++ra)
#pragma unroll
                for (int cb = 0; cb < 2; ++cb)
#pragma unroll
                    for (int p = 0; p < 2; ++p) acc[ra][cb] = MFMA16(__builtin_bit_cast(bf16x8, af[ra][p]), bq[p][cb], acc[ra][cb]);
        }
#undef RS_LOAD
    }
}
__device__ __forceinline__ void phase_rwkv_out(const Params& P, int l, unsigned char* smem, int wv) {
    ParamsPtr pp = PARAMS_PTR(P); PIN_S(pp); unsigned char* ws = pp->ws; int bidx = (int)blockIdx.x, gdim = (int)gridDim.x; PIN_S(bidx); PIN_S(gdim);
    const bf16_t* Qg = (const bf16_t*)(ws + O_RQ); const bf16_t* Sg = (const bf16_t*)(ws + O_RS); const bf16_t* Hg = (const bf16_t*)(ws + O_RH);
    const bf16_t* VB = (const bf16_t*)(ws + O_VB); const float* GATE = (const float*)(ws + O_GATE); const float* BONUS = (const float*)(ws + O_BONUS);
    bf16_t* GRP = (bf16_t*)(ws + O_GRP);
    const float* rln_g = pp->in[15] + (size_t)l * RW; const float* rln_b = pp->in[16] + (size_t)l * RW;
    const int tid = phase_tid(wv), lane = tid & 63, wave = tid >> 6, col = lane & 15, g = lane >> 4;
    for (int pu = bidx * NWAVES + wave; pu < NB * RH * RNC; pu += gdim * NWAVES) {
        const int c = pu % RNC, h = (pu / RNC) % RH, b = pu / (RNC * RH);
        f32x4 o[2][4][4];
#pragma unroll
        for (int d = 0; d < 2; ++d) {
            const int u = ((d * NB + b) * RH + h) * RNC + (d ? RNC - 1 - c : c);
            const size_t ub = (size_t)u * 4096;
            bf16x8 qa[4][2], sb[4][2];
#pragma unroll
            for (int q = 0; q < 4; ++q)
#pragma unroll
                for (int ks = 0; ks < 2; ++ks) { qa[q][ks] = *(const bf16x8*)(Qg + ub + (q * 16 + col) * 64 + ks * 32 + 8 * g); sb[q][ks] = *(const bf16x8*)(Sg + ub + (q * 16 + col) * 64 + ks * 32 + 8 * g); }
#pragma unroll
            for (int tt = 0; tt < 4; ++tt)
#pragma unroll
                for (int et = 0; et < 4; ++et) {
                    const u32x2 hb = *(const u32x2*)(Hg + ub + ((tt * 4 + et) * 64 + lane) * 4);
                    f32x4 acc = (f32x4){bf_lo(hb.x), bf_hi(hb.x), bf_lo(hb.y), bf_hi(hb.y)};
#pragma unroll
                    for (int ks = 0; ks < 2; ++ks) acc = MFMA16(qa[tt][ks], sb[et][ks], acc);
                    o[d][tt][et] = acc;
                }
        }
        const int src = (3 - g) * 16 + col;
#pragma unroll
        for (int tt = 0; tt < 4; ++tt)
#pragma unroll
            for (int et = 0; et < 4; ++et)
#pragma unroll
                for (int r = 0; r < 4; ++r) o[0][tt][et][r] += SHL(o[1][3 - tt][et][3 - r], src);
#pragma unroll
        for (int tt = 0; tt < 4; ++tt)
#pragma unroll
            for (int r = 0; r < 4; ++r) {
                float sm = (o[0][tt][0][r] + o[0][tt][1][r]) + (o[0][tt][2][r] + o[0][tt][3][r]);
                sm = row16_sum(sm);
                const float mean = sm * (1.0f / 64.0f);
                float q = 0.f;
#pragma unroll
                for (int et = 0; et < 4; ++et) { const float dl = o[0][tt][et][r] - mean; q += dl * dl; }
                q = row16_sum(q);
                const float rstd = 1.0f / sqrtf(q * (1.0f / 64.0f) + GN_EPS);
                const size_t t = (size_t)(b * S + c * RC + tt * 16 + 4 * g + r);
                const float bon = BONUS[t * RH + h];
#pragma unroll
                for (int et = 0; et < 4; ++et) {
                    const int ch = h * 64 + et * 16 + col;
                    float y = (o[0][tt][et][r] - mean) * rstd * rln_g[ch] + rln_b[ch];
                    y += bon * bf_lo((unsigned)VB[t * RW + ch]);
                    GRP[t * D + GW + ch] = (bf16_t)f2bf(y * GATE[t * RW + ch]);
                }
            }
    }
}

__device__ __forceinline__ void phase_mlstm_local(const Params& P, int l, unsigned char* smem, int wv, int bid, int nb) {
    PIN_S(bid); PIN_S(nb);
    ParamsPtr pp = PARAMS_PTR(P); PIN_S(pp); unsigned char* ws = pp->ws;
    const bf16_t* KT = (const bf16_t*)(ws + O_KT); const bf16_t* VT = (const bf16_t*)(ws + O_VT);
    const float* IG = (const float*)(ws + O_IG); const float* LF = (const float*)(ws + O_LF);
    float* CL = (float*)(ws + O_CL); float* NLb = (float*)(ws + O_NL); float* ML = (float*)(ws + O_ML); float* BL = (float*)(ws + O_BL);
    float* GVT = (float*)(ws + O_GVT); float* PMX = (float*)(ws + O_PMX); float* BCT = (float*)(ws + O_BCT);
    const int tid = phase_tid(wv), lane = tid & 63, wave = tid >> 6, col = lane & 15, g = lane >> 4;
    float* wts = (float*)smem + wave * 128;
    for (int u = bid * NWAVES + wave; u < 2 * NB * MH * NCH; u += nb * NWAVES) {
        const int c = u % NCH, h = (u / NCH) % MH, p = u / (NCH * MH), d = p / NB, b = p % NB;
        const int tc = d ? NCH - 1 - c : c, tok0 = b * S + tc * CH;
        const int i0 = d ? 127 - 2 * lane : 2 * lane, i1 = d ? i0 - 1 : i0 + 1;
        const size_t g0 = ((size_t)d * T + tok0 + i0) * MH + h, g1 = ((size_t)d * T + tok0 + i1) * MH + h;
        const float lf0 = LF[g0], lf1 = LF[g1], ig0 = IG[g0], ig1 = IG[g1];
        const float c1 = lf0 + lf1;
        float incl = c1;
#pragma unroll
        for (int o = 1; o < 64; o <<= 1) { const float tq = SHUP(incl, o, lane); if (lane >= o) incl += tq; }
        const float excl = incl - c1, bc0 = excl + lf0, bc1 = incl;
        const float blast = RDL(incl, 63);
        const float gv0 = ig0 - bc0, gv1 = ig1 - bc1, pl1 = fmaxf(gv0, gv1);
        float mincl = pl1;
#pragma unroll
        for (int o = 1; o < 64; o <<= 1) { const float tq = SHUP(mincl, o, lane); if (lane >= o) mincl = fmaxf(mincl, tq); }
        float mexcl = SHUP(mincl, 1, lane); if (lane == 0) mexcl = -INFINITY;
        const float pm0 = fmaxf(mexcl, gv0), pm1 = mincl;
        const float mloc = blast + RDL(mincl, 63);
        WAVE_SYNC();
        wts[i0] = fexp(blast + gv0 - mloc); wts[i1] = fexp(blast + gv1 - mloc);
        GVT[g0] = gv0; GVT[g1] = gv1; PMX[g0] = pm0; PMX[g1] = pm1; BCT[g0] = bc0; BCT[g1] = bc1;
        if (lane == 0) { ML[u] = mloc; BL[u] = blast; }
        WAVE_SYNC();
        const bf16_t* vbase = VT + ((size_t)(b * MH + h) * 64) * S + (size_t)tc * CH;
        const bf16_t* kbase = KT + ((size_t)(b * MH + h) * 64) * S + (size_t)tc * CH;
        const unsigned loff = (unsigned)(col * S + 8 * g);
        f32x4 acc[4][4];
#pragma unroll
        for (int a_ = 0; a_ < 4; ++a_)
#pragma unroll
            for (int b_ = 0; b_ < 4; ++b_) acc[a_][b_] = (f32x4){0.f, 0.f, 0.f, 0.f};
        float nsum[4] = {0.f, 0.f, 0.f, 0.f};
#pragma unroll 1
        for (int ks = 0; ks < 4; ++ks) {
            const int ii = ks * 32 + 8 * g;
            const f32x4 w0 = *(const f32x4*)(wts + ii), w1 = *(const f32x4*)(wts + ii + 4);
            bf16x8 af[4], bfk[4];
#pragma unroll
            for (int q = 0; q < 4; ++q) af[q] = *(const bf16x8*)(vbase + ((size_t)q * 16 * S + ks * 32) + loff);
#pragma unroll
            for (int q = 0; q < 4; ++q) {
                const u32x4 kr = *(const u32x4*)(kbase + ((size_t)q * 16 * S + ks * 32) + loff);
                f32x4 k0, k1;
                k0.x = bf_lo(kr.x) * w0.x; k0.y = bf_hi(kr.x) * w0.y; k0.z = bf_lo(kr.y) * w0.z; k0.w = bf_hi(kr.y) * w0.w;
                k1.x = bf_lo(kr.z) * w1.x; k1.y = bf_hi(kr.z) * w1.y; k1.z = bf_lo(kr.w) * w1.z; k1.w = bf_hi(kr.w) * w1.w;
                nsum[q] += (k0.x + k0.y) + (k0.z + k0.w) + (k1.x + k1.y) + (k1.z + k1.w);
                bfk[q] = cvt8(k0, k1);
            }
#pragma unroll
            for (int a_ = 0; a_ < 4; ++a_)
#pragma unroll
                for (int b_ = 0; b_ < 4; ++b_) acc[a_][b_] = MFMA16(af[a_], bfk[b_], acc[a_][b_]);
        }
        float* cbase = CL + (size_t)u * 4096;
        const unsigned coff = (unsigned)(4 * g * 64 + col);
#pragma unroll
        for (int b_ = 0; b_ < 4; ++b_) {
#pragma unroll
            for (int a_ = 0; a_ < 4; ++a_)
#pragma unroll
                for (int r = 0; r < 4; ++r) cbase[(a_ * 16 * 64 + r * 64 + b_ * 16) + coff] = acc[a_][b_][r];
            float ns = nsum[b_]; ns += SHX(ns, 16, lane); ns += SHX(ns, 32, lane);
            if (g == 0) NLb[(size_t)u * 64 + b_ * 16 + col] = ns;
        }
    }
    __syncthreads();
}

__device__ __forceinline__ void phase_mlstm_carry(const Params& P, int l, unsigned char* smem, int wv) {
    ParamsPtr pp = PARAMS_PTR(P); PIN_S(pp); unsigned char* ws = pp->ws; int bidx = (int)blockIdx.x, gdim = (int)gridDim.x; PIN_S(bidx); PIN_S(gdim);
    float* CL = (float*)(ws + O_CL); float* NLb = (float*)(ws + O_NL); const float* ML = (const float*)(ws + O_ML); const float* BL = (const float*)(ws + O_BL);
    float* MIN = (float*)(ws + O_MIN);
    const int total = 2 * NB * MH * 4160;
    const int tid = phase_tid(wv);
    for (int g = bidx * NTHREADS + tid; g < total; g += gdim * NTHREADS) {
        const int ph = g / 4160, e = g % 4160;
        float m = 0.f, val = 0.f;
        for (int c = 0; c < NCH; ++c) {
            const int base = ph * NCH + c;
            float* ptr = e < 4096 ? CL + (size_t)base * 4096 + e : NLb + (size_t)base * 64 + (e - 4096);
            const float loc = *ptr;
            *ptr = val;
            if (e == 0) MIN[base] = m;
            const float bl = BL[base], ml = ML[base];
            const float mn = fmaxf(bl + m, ml);
            val = expf(bl + m - mn) * val + expf(ml - mn) * loc;
            m = mn;
        }
    }
}

__device__ __forceinline__ void phase_mlstm_out(const Params& P, int l, unsigned char* smem, int wv) {
    ParamsPtr pp = PARAMS_PTR(P); PIN_S(pp); unsigned char* ws = pp->ws; int bidx = (int)blockIdx.x, gdim = (int)gridDim.x; PIN_S(bidx); PIN_S(gdim);
    const float* proj = (const float*)(ws + O_PROJ);
    const bf16_t* MQB = (const bf16_t*)(ws + O_MQB); const bf16_t* MKB = (const bf16_t*)(ws + O_MKB); const bf16_t* VT = (const bf16_t*)(ws + O_VT);
    const float* GVT = (const float*)(ws + O_GVT); const float* PMX = (const float*)(ws + O_PMX); const float* BCT = (const float*)(ws + O_BCT);
    const float* CL = (const float*)(ws + O_CL); const float* NLb = (const float*)(ws + O_NL); const float* MIN = (const float*)(ws + O_MIN);
    bf16_t* GRP = (bf16_t*)(ws + O_GRP);
    const float* mln_g = pp->in[20] + (size_t)l * MW;
    const int tid = phase_tid(wv), lane = tid & 63, wave = tid >> 6, col = lane & 15, g = lane >> 4;
    for (int u = bidx; u < NB * MH * NCH; u += gdim) {
        const int tc = u % NCH, h = (u / NCH) % MH, b = u / (NCH * MH);
        const int tok0 = b * S + tc * CH, it = wave * 16 + col;
        const size_t trow = (size_t)(tok0 + it);
        bf16x8 bq[2];
#pragma unroll
        for (int ks = 0; ks < 2; ++ks) bq[ks] = *(const bf16x8*)(MQB + trow * MW + h * 64 + ks * 32 + 8 * g);
        const size_t vrow = ((size_t)(b * MH + h) * 64) * S + (size_t)tc * CH;
        f32x4 hs[4];
#pragma unroll
        for (int et = 0; et < 4; ++et) hs[et] = (f32x4){0.f, 0.f, 0.f, 0.f};
#pragma unroll
        for (int d = 0; d < 2; ++d) {
            const int cd = d ? NCH - 1 - tc : tc;
            const int su = ((d * NB + b) * MH + h) * NCH + cd;
            const size_t gt = ((size_t)d * T + trow) * MH + h;
            const float mst = MIN[su];
            const float mxt = fmaxf(PMX[gt], mst), mt = BCT[gt] + mxt, wint = fexp(mst - mxt);
            f32x4 num[4];
#pragma unroll
            for (int et = 0; et < 4; ++et) num[et] = (f32x4){0.f, 0.f, 0.f, 0.f};
            float den = 0.f;
            for (int sp = 0; sp < 4; ++sp) {
                if (d == 0 ? (2 * sp > wave) : (2 * sp + 1 < wave)) continue;
                float pw[8];
#pragma unroll
                for (int hf = 0; hf < 2; ++hf) {
                    const int st = 2 * sp + hf;
                    f32x4 sacc = (f32x4){0.f, 0.f, 0.f, 0.f};
#pragma unroll
                    for (int ks = 0; ks < 2; ++ks) {
                        const bf16x8 kf = *(const bf16x8*)(MKB + (size_t)(tok0 + st * 16 + col) * MW + h * 64 + ks * 32 + 8 * g);
                        sacc = MFMA16(kf, bq[ks], sacc);
                    }
#pragma unroll
                    for (int r = 0; r < 4; ++r) {
                        const int is = st * 16 + 4 * g + r;
                        const bool ok = d == 0 ? (is <= it) : (is >= it);
                        const float gvs = GVT[((size_t)d * T + tok0 + is) * MH + h];
                        const float pr = ok ? sacc[r] * fexp(gvs - mxt) : 0.f;
                        den += pr; pw[hf * 4 + r] = pr;
                    }
                }
                u32x4 pb; pb.x = pk2(pw[0], pw[1]); pb.y = pk2(pw[2], pw[3]); pb.z = pk2(pw[4], pw[5]); pb.w = pk2(pw[6], pw[7]);
                const bf16x8 bp = __builtin_bit_cast(bf16x8, pb);
#pragma unroll
                for (int et = 0; et < 4; ++et) {
                    const bf16_t* vp = VT + vrow + (size_t)(et * 16 + col) * S + sp * 32 + 4 * g;
                    const u32x2 v0 = *(const u32x2*)vp, v1 = *(const u32x2*)(vp + 16);
                    u32x4 va; va.x = v0.x; va.y = v0.y; va.z = v1.x; va.w = v1.y;
                    num[et] = MFMA16(__builtin_bit_cast(bf16x8, va), bp, num[et]);
                }
            }
            den += SHX(den, 16, lane); den += SHX(den, 32, lane);
            f32x4 qc[4]; float qn = 0.f;
#pragma unroll
            for (int ks = 0; ks < 2; ++ks) {
                const float* np = NLb + (size_t)su * 64 + ks * 32 + 8 * g;
                const f32x4 n0 = *(const f32x4*)np, n1 = *(const f32x4*)(np + 4);
                const u32x4 qb = __builtin_bit_cast(u32x4, bq[ks]);
                qn += (bf_lo(qb.x) * n0.x + bf_hi(qb.x) * n0.y) + (bf_lo(qb.y) * n0.z + bf_hi(qb.y) * n0.w) + (bf_lo(qb.z) * n1.x + bf_hi(qb.z) * n1.y) + (bf_lo(qb.w) * n1.z + bf_hi(qb.w) * n1.w);
            }
            qn += SHX(qn, 16, lane); qn += SHX(qn, 32, lane);
#pragma unroll
            for (int et = 0; et < 4; ++et) {
                qc[et] = (f32x4){0.f, 0.f, 0.f, 0.f};
#pragma unroll
                for (int ks = 0; ks < 2; ++ks) {
                    const float* cp = CL + (size_t)su * 4096 + (size_t)(et * 16 + col) * 64 + ks * 32 + 8 * g;
                    qc[et] = MFMA16(cvt8(*(const f32x4*)cp, *(const f32x4*)(cp + 4)), bq[ks], qc[et]);
                }
            }
            const float dd = frcp(fmaxf(fabsf(den + wint * qn), fexp(-mt)));
#pragma unroll
            for (int et = 0; et < 4; ++et) hs[et] += (num[et] + wint * qc[et]) * dd;
        }
        float sm = 0.f;
#pragma unroll
        for (int et = 0; et < 4; ++et) sm += (hs[et].x + hs[et].y) + (hs[et].z + hs[et].w);
        sm += SHX(sm, 16, lane); sm += SHX(sm, 32, lane);
        const float mean = sm * (1.0f / 64.0f); float q = 0.f;
#pragma unroll
        for (int et = 0; et < 4; ++et) { const f32x4 dl = hs[et] - mean; q += (dl.x * dl.x + dl.y * dl.y) + (dl.z * dl.z + dl.w * dl.w); }
        q += SHX(q, 16, lane); q += SHX(q, 32, lane);
        const float rstd = 1.0f / sqrtf(q * (1.0f / 64.0f) + LN_EPS);
#pragma unroll
        for (int et = 0; et < 4; ++et) {
            const int c = h * 64 + et * 16 + 4 * g;
            const f32x4 o4 = *(const f32x4*)(proj + trow * PLD + C_MW + 3 * MW + c), g4 = *(const f32x4*)(mln_g + c);
            const f32x4 y = (hs[et] - mean) * rstd * g4;
            u32x2 ob; ob.x = pk2(sigmoidf_(o4.x) * y.x, sigmoidf_(o4.y) * y.y); ob.y = pk2(sigmoidf_(o4.z) * y.z, sigmoidf_(o4.w) * y.w);
            *(u32x2*)(GRP + trow * D + GW + RW + c) = ob;
        }
    }
}

__device__ __forceinline__ void phase_rwkv_post(const Params& P, int l, unsigned char* smem, int wv) {
    ParamsPtr pp = PARAMS_PTR(P); PIN_S(pp); unsigned char* ws = pp->ws; int bidx = (int)blockIdx.x, gdim = (int)gridDim.x; PIN_S(bidx); PIN_S(gdim);
    const float* SCAN = (const float*)(ws + O_SCAN); const float* VV = (const float*)(ws + O_VV); const float* GATE = (const float*)(ws + O_GATE);
    const float* BONUS = (const float*)(ws + O_BONUS); bf16_t* GRP = (bf16_t*)(ws + O_GRP);
    const float* rln_g = pp->in[15] + (size_t)l * RW; const float* rln_b = pp->in[16] + (size_t)l * RW;
    const int tid = phase_tid(wv), lane = tid & 63, wave = tid >> 6;
    const int gw = bidx * NWAVES + wave, ngw = NWAVES * gdim;
    for (int it = gw; it < T * RH; it += ngw) {
        const int t = it / RH, h = it % RH, c = h * 64 + lane;
        const size_t o = (size_t)t * RW + c;
        const float x = SCAN[o] + SCAN[(size_t)T * RW + o];
        const float mean = wave_sum(x, lane) * (1.0f / 64.0f);
        const float dl = x - mean;
        const float var = wave_sum(dl * dl, lane) * (1.0f / 64.0f);
        float y = dl / sqrtf(var + GN_EPS) * rln_g[c] + rln_b[c];
        y += BONUS[(size_t)t * RH + h] * VV[o];
        GRP[(size_t)t * D + GW + c] = (bf16_t)f2bf(y * GATE[o]);
    }
}

__device__ __forceinline__ void phase_ln1_router(const Params& P, int l, unsigned char* smem, int wv) {
    ParamsPtr pp = PARAMS_PTR(P); PIN_S(pp); unsigned char* ws = pp->ws; int bidx = (int)blockIdx.x, gdim = (int)gridDim.x; PIN_S(bidx); PIN_S(gdim);
    const float* xin = l == 0 ? pp->in[0] : (const float*)(ws + O_XA);
    const float* MIX = (const float*)(ws + O_MIX); float* X1 = (float*)(ws + O_X1);
    int* TOPI = (int*)(ws + O_TOPI); float* TOPG = (float*)(ws + O_TOPG); int* RANK = (int*)(ws + O_RANK); bf16_t* X1B = (bf16_t*)(ws + O_X1B);
    int* BCNT = (int*)(ws + O_BCNT);
    const float* g1 = pp->in[22] + (size_t)l * D; const float* b1 = pp->in[23] + (size_t)l * D;
    const float* rw = pp->in[24] + (size_t)l * D * NE; const float* rb = pp->in[25] + (size_t)l * NE;
    const int tid = phase_tid(wv), lane = tid & 63, wave = tid >> 6;
    float* Wl = (float*)smem;
    float* lgs = (float*)(smem + 131072);
    int* stopi = (int*)(smem + 131072 + 8192);
    __syncthreads();
    {
        f32x4 wb[16];
#pragma unroll
        for (int it = 0; it < 16; ++it) wb[it] = ((const f32x4*)rw)[tid + it * NTHREADS];
#pragma unroll
        for (int it = 0; it < 16; ++it) ((f32x4*)Wl)[tid + it * NTHREADS] = wb[it];
    }
    for (int tile = bidx; tile < T / 64; tile += gdim) {
        __syncthreads();
        for (int ti8 = 0; ti8 < 8; ++ti8) {
            const int t = tile * 64 + wave * 8 + ti8;
            float v[16]; float sm = 0.f;
#pragma unroll
            for (int j = 0; j < 4; ++j) {
                const int c = j * 256 + lane * 4;
                const f32x4 a = *(const f32x4*)(xin + (size_t)t * D + c), m = *(const f32x4*)(MIX + (size_t)t * D + c);
                v[j * 4 + 0] = ALPHA * a.x + m.x; v[j * 4 + 1] = ALPHA * a.y + m.y; v[j * 4 + 2] = ALPHA * a.z + m.z; v[j * 4 + 3] = ALPHA * a.w + m.w;
                sm += (v[j * 4] + v[j * 4 + 1]) + (v[j * 4 + 2] + v[j * 4 + 3]);
            }
            const float mean = wave_sum(sm, lane) * (1.0f / D); float q = 0.f;
#pragma unroll
            for (int j = 0; j < 16; ++j) { const float dl = v[j] - mean; q += dl * dl; }
            const float rstd = 1.0f / sqrtf(wave_sum(q, lane) * (1.0f / D) + LN_EPS);
#pragma unroll
            for (int j = 0; j < 4; ++j) {
                const int c = j * 256 + lane * 4;
                const f32x4 gg = *(const f32x4*)(g1 + c), bb = *(const f32x4*)(b1 + c);
                f32x4 o;
                o.x = (v[j * 4 + 0] - mean) * rstd * gg.x + bb.x; o.y = (v[j * 4 + 1] - mean) * rstd * gg.y + bb.y;
                o.z = (v[j * 4 + 2] - mean) * rstd * gg.z + bb.z; o.w = (v[j * 4 + 3] - mean) * rstd * gg.w + bb.w;
                *(f32x4*)(X1 + (size_t)t * D + c) = o;
                u32x2 ob; ob.x = pk2(o.x, o.y); ob.y = pk2(o.z, o.w); *(u32x2*)(X1B + (size_t)t * D + c) = ob;
            }
        }
        __syncthreads();
        {
            const int tq = tid >> 3, eg = (tid & 7) * 4;
            const float* xr = X1 + (size_t)(tile * 64 + tq) * D;
            f32x4 acc = *(const f32x4*)(rb + eg);
#pragma unroll 4
            for (int c = 0; c < D; c += 4) {
                const f32x4 x4 = *(const f32x4*)(xr + c);
                acc += x4.x * *(const f32x4*)(Wl + (c + 0) * NE + eg); acc += x4.y * *(const f32x4*)(Wl + (c + 1) * NE + eg);
                acc += x4.z * *(const f32x4*)(Wl + (c + 2) * NE + eg); acc += x4.w * *(const f32x4*)(Wl + (c + 3) * NE + eg);
            }
            *(f32x4*)(lgs + tq * NE + eg) = acc;
        }
        __syncthreads();
        if (tid < 64) {
            const float* lp = lgs + tid * NE; const int t = tile * 64 + tid;
            float tv[4]; int ti[4];
#pragma unroll
            for (int k = 0; k < 4; ++k) { tv[k] = -INFINITY; ti[k] = 0; }
            for (int e = 0; e < NE; ++e) {
                const float x = lp[e];
                if (x > tv[3]) {
                    if (x > tv[0]) { tv[3] = tv[2]; ti[3] = ti[2]; tv[2] = tv[1]; ti[2] = ti[1]; tv[1] = tv[0]; ti[1] = ti[0]; tv[0] = x; ti[0] = e; }
                    else if (x > tv[1]) { tv[3] = tv[2]; ti[3] = ti[2]; tv[2] = tv[1]; ti[2] = ti[1]; tv[1] = x; ti[1] = e; }
                    else if (x > tv[2]) { tv[3] = tv[2]; ti[3] = ti[2]; tv[2] = x; ti[2] = e; }
                    else { tv[3] = x; ti[3] = e; }
                }
            }
            const float e1 = expf(tv[1] - tv[0]), e2 = expf(tv[2] - tv[0]), e3 = expf(tv[3] - tv[0]);
            const float inv = 1.0f / (1.0f + e1 + e2 + e3);
            *(f32x4*)(TOPG + (size_t)t * 4) = (f32x4){inv, e1 * inv, e2 * inv, e3 * inv};
#pragma unroll
            for (int k = 0; k < 4; ++k) { TOPI[(size_t)t * 4 + k] = ti[k]; stopi[tid * 4 + k] = ti[k]; }
        }
        __syncthreads();
        if (tid < 256) { const int e = stopi[tid]; int r = 0; for (int a2 = 0; a2 < tid; ++a2) r += (stopi[a2] == e) ? 1 : 0; RANK[(size_t)tile * 256 + tid] = r; }
        else if (tid < 256 + NE) { const int e = tid - 256; int cnt = 0; for (int a2 = 0; a2 < 256; ++a2) cnt += (stopi[a2] == e) ? 1 : 0; BCNT[tile * NE + e] = cnt; }
    }
    __syncthreads();
}

__device__ __forceinline__ void moe_offsets(int* sh, const int* CNT, int tid) {
    if (tid == 0) {
        int acc = 0;
        for (int e = 0; e < NE; ++e) { const int c = (int)CNT[e]; sh[e] = c; sh[32 + e] = acc; acc += (c + MOEB - 1) / MOEB * MOEB; sh[64 + e] = acc; }
    }
    __syncthreads();
}
__device__ __forceinline__ int moe_expert_of_row(const int* sh, int r) {
    int e = -1;
    for (int i = 0; i < NE; ++i) if (r >= sh[32 + i] && r < sh[64 + i]) e = i;
    return e;
}

__device__ __forceinline__ void phase_scatter(const Params& P, int l, unsigned char* smem, int wv) {
    ParamsPtr pp = PARAMS_PTR(P); PIN_S(pp); unsigned char* ws = pp->ws; int bidx = (int)blockIdx.x, gdim = (int)gridDim.x; PIN_S(bidx); PIN_S(gdim);
    const int tid = phase_tid(wv);
    const int* TOPI = (const int*)(ws + O_TOPI); const int* RANK = (const int*)(ws + O_RANK); int* SLOT = (int*)(ws + O_SLOT); int* ROWT = (int*)(ws + O_ROWT);
    const int* BCNT = (const int*)(ws + O_BCNT); int* CNTF = (int*)(ws + O_CNTF);
    int* sh = (int*)smem;
    int* part = sh + 96;
    int* tot = part + 512;
    int* base = tot + 32;
    constexpr int NT = T / 64;
    const int e = tid & 31, pt = tid >> 5;
    { int sacc = 0; for (int tl = pt; tl < NT; tl += 16) sacc += BCNT[tl * NE + e]; part[pt * 32 + e] = sacc; }
    __syncthreads();
    if (tid < 32) { int sacc = 0; for (int q = 0; q < 16; ++q) sacc += part[q * 32 + tid]; tot[tid] = sacc; if (bidx == 0) CNTF[tid] = sacc; }
    __syncthreads();
    moe_offsets(sh, tot, tid);
    for (int ee = bidx; ee < NE; ee += gdim)
        for (int r = sh[32 + ee] + sh[ee] + tid; r < sh[64 + ee]; r += NTHREADS) ROWT[r] = 0;
    for (int tile = bidx; tile < NT; tile += gdim) {
        __syncthreads();
        { int sacc = 0; for (int tl = pt; tl < tile; tl += 16) sacc += BCNT[tl * NE + e]; part[pt * 32 + e] = sacc; }
        __syncthreads();
        if (tid < 32) { int sacc = sh[32 + tid]; for (int q = 0; q < 16; ++q) sacc += part[q * 32 + tid]; base[tid] = sacc; }
        __syncthreads();
        if (tid < 256) { const int a = tile * 256 + tid, dest = base[TOPI[a]] + RANK[a]; SLOT[a] = dest; ROWT[dest] = a >> 2; }
    }
    __syncthreads();
}

template <int WHICH>
__device__ __forceinline__ void phase_moe_gemm(const Params& P, int l, unsigned char* smem, int wv) {
    ParamsPtr pp = PARAMS_PTR(P); PIN_S(pp); unsigned char* ws = pp->ws; int bidx = (int)blockIdx.x, gdim = (int)gridDim.x; PIN_S(bidx); PIN_S(gdim);
    const int tid = phase_tid(wv);
    const int* CNT = (const int*)(ws + O_CNTF);
    int* sh = (int*)(smem + 131072);
    int* rbe = sh + 96;
    moe_offsets(sh, CNT, tid);
    const int nrb = sh[64 + NE - 1] / MOEB;
    for (int rb = tid; rb < nrb; rb += NTHREADS) rbe[rb] = moe_expert_of_row(sh, rb * MOEB);
    __syncthreads();
    pg8::MoeOrderT<WHICH == 1> S;
    S.K = 1024; S.G_ = gdim; S.c = bidx; S.rbe = rbe; S.rowmap = (const int*)(ws + O_ROWT);
    if (WHICH == 1) {
        S.A = (const char*)(ws + O_X1B); S.Wt = (const char*)(ws + O_W1) + (size_t)l * NE * 2 * DFF * D * 2; S.estride = (size_t)2 * DFF * D * 2; S.nN = 2 * DFF / 256; S.nwg = nrb * S.nN;
        pg8::EpiSwiglu E{(bf16_t*)(ws + O_ACT), pp->in[27] + (size_t)l * NE * 2 * DFF};
        pg8::gemm_phase<pg8::EpiSwiglu, pg8::MoeOrderT<WHICH == 1>>((LAS unsigned char*)smem, 1024, S, E, tid);
    } else {
        S.A = (const char*)(ws + O_ACT); S.Wt = (const char*)(ws + O_W2) + (size_t)l * NE * D * DFF * 2; S.estride = (size_t)D * DFF * 2; S.nN = D / 256; S.nwg = nrb * S.nN;
        pg8::EpiBf16Bias E{(bf16_t*)(ws + O_YS), D, pp->in[29] + (size_t)l * NE * D, D};
        pg8::gemm_phase<pg8::EpiBf16Bias, pg8::MoeOrderT<WHICH == 1>>((LAS unsigned char*)smem, 1024, S, E, tid);
    }
    __syncthreads();
}

__device__ __forceinline__ void phase_combine_ln2(const Params& P, int l, unsigned char* smem, int wv) {
    ParamsPtr pp = PARAMS_PTR(P); PIN_S(pp); unsigned char* ws = pp->ws; int bidx = (int)blockIdx.x, gdim = (int)gridDim.x; PIN_S(bidx); PIN_S(gdim);
    const float* X1 = (const float*)(ws + O_X1); const bf16_t* YS = (const bf16_t*)(ws + O_YS); bf16_t* XB = (bf16_t*)(ws + O_XB);
    const int* SLOT = (const int*)(ws + O_SLOT); const float* TOPG = (const float*)(ws + O_TOPG);
    float* xo = l == NL - 1 ? pp->out : (float*)(ws + O_XA);
    const float* g2 = pp->in[30] + (size_t)l * D; const float* b2 = pp->in[31] + (size_t)l * D;
    const int tid = phase_tid(wv), lane = tid & 63, wave = tid >> 6;
    const int gw = bidx * NWAVES + wave, ngw = NWAVES * gdim;
    for (int t = gw; t < T; t += ngw) {
        int sl[4]; float gg[4];
#pragma unroll
        for (int k = 0; k < 4; ++k) { sl[k] = SLOT[(size_t)t * 4 + k]; gg[k] = TOPG[(size_t)t * 4 + k]; }
        float v[16]; float sm = 0.f;
#pragma unroll
        for (int j = 0; j < 4; ++j) {
            const int c = j * 256 + lane * 4;
            const f32x4 a = *(const f32x4*)(X1 + (size_t)t * D + c);
            f32x4 y = (f32x4){0.f, 0.f, 0.f, 0.f};
#pragma unroll
            for (int k = 0; k < 4; ++k) { const u32x2 yk = *(const u32x2*)(YS + (size_t)sl[k] * D + c);
                y.x += gg[k] * __builtin_bit_cast(float, yk.x << 16); y.y += gg[k] * __builtin_bit_cast(float, yk.x & 0xffff0000u); y.z += gg[k] * __builtin_bit_cast(float, yk.y << 16); y.w += gg[k] * __builtin_bit_cast(float, yk.y & 0xffff0000u); }
            v[j * 4 + 0] = ALPHA * a.x + y.x; v[j * 4 + 1] = ALPHA * a.y + y.y; v[j * 4 + 2] = ALPHA * a.z + y.z; v[j * 4 + 3] = ALPHA * a.w + y.w;
            sm += (v[j * 4] + v[j * 4 + 1]) + (v[j * 4 + 2] + v[j * 4 + 3]);
        }
        const float mean = wave_sum(sm, lane) * (1.0f / D); float q = 0.f;
#pragma unroll
        for (int j = 0; j < 16; ++j) { const float dl = v[j] - mean; q += dl * dl; }
        const float rstd = 1.0f / sqrtf(wave_sum(q, lane) * (1.0f / D) + LN_EPS);
#pragma unroll
        for (int j = 0; j < 4; ++j) {
            const int c = j * 256 + lane * 4;
            f32x4 o;
            o.x = (v[j * 4 + 0] - mean) * rstd * g2[c + 0] + b2[c + 0]; o.y = (v[j * 4 + 1] - mean) * rstd * g2[c + 1] + b2[c + 1];
            o.z = (v[j * 4 + 2] - mean) * rstd * g2[c + 2] + b2[c + 2]; o.w = (v[j * 4 + 3] - mean) * rstd * g2[c + 3] + b2[c + 3];
            *(f32x4*)(xo + (size_t)t * D + c) = o;
            if (l != NL - 1) { u32x2 ob; ob.x = pk2(o.x, o.y); ob.y = pk2(o.z, o.w); *(u32x2*)(XB + (size_t)t * D + c) = ob; }
        }
    }
}

__device__ __forceinline__ void phase_inproj(const Params& P, int l, unsigned char* smem, int wv) {
    ParamsPtr pp = PARAMS_PTR(P); PIN_S(pp); unsigned char* ws = pp->ws; int bidx = (int)blockIdx.x, gdim = (int)gridDim.x; PIN_S(bidx); PIN_S(gdim);
    const int tid = phase_tid(wv);
    pg8::DenseOrder S; S.init(ws + O_XB, (const bf16_t*)(ws + O_WIN) + (size_t)l * PLD * D, T, PLD, D, gdim, bidx);
    pg8::EpiF32 E{(float*)(ws + O_PROJ), PLD};
    pg8::gemm_phase<pg8::EpiF32, pg8::DenseOrder>((LAS unsigned char*)smem, D, S, E, tid);
    __syncthreads();
}
__device__ __forceinline__ void phase_outproj(const Params& P, int l, unsigned char* smem, int wv) {
    ParamsPtr pp = PARAMS_PTR(P); PIN_S(pp); unsigned char* ws = pp->ws; int bidx = (int)blockIdx.x, gdim = (int)gridDim.x; PIN_S(bidx); PIN_S(gdim);
    const int tid = phase_tid(wv);
    pg8::DenseOrder S; S.init(ws + O_GRP, (const bf16_t*)(ws + O_WOUT) + (size_t)l * D * D, T, D, D, gdim, bidx);
    pg8::EpiF32 E{(float*)(ws + O_MIX), D};
    pg8::gemm_phase<pg8::EpiF32, pg8::DenseOrder>((LAS unsigned char*)smem, D, S, E, tid);
    __syncthreads();
}

#ifndef EMU
#define XB_TMO      128
#define XB_XCNT(j)  (256  + 64 * (j))
#define XB_XSUB(j)  (1280 + 64 * (j))
#define XB_XGEN(j)  (2304 + 64 * (j))
#define XB_TOP      3328
#define XB_TOPGEN   3392
#define XCD_BAR_WORDS 3456
#define XB_SPIN_CAP (1u << 25)
__device__ __forceinline__ unsigned xb_ld(unsigned* p)              { return __hip_atomic_load(p, __ATOMIC_RELAXED, __HIP_MEMORY_SCOPE_AGENT); }
__device__ __forceinline__ unsigned xb_add(unsigned* p, unsigned v) { return __hip_atomic_fetch_add(p, v, __ATOMIC_RELAXED, __HIP_MEMORY_SCOPE_AGENT); }
__device__ __forceinline__ unsigned xb_xcc_id() { return (unsigned)__builtin_amdgcn_s_getreg((3 << 11) | 20) & 0xFu; }
#define XB_SPIN(cond, bar) do { unsigned _sp = 0; while (cond) { __builtin_amdgcn_s_sleep(1); \
    if ((++_sp & 255u) == 0u) { if (xb_ld(&(bar)[XB_TMO])) break; if (_sp > XB_SPIN_CAP) { atomicAdd(&(bar)[XB_TMO], 1u); break; } } } } while (0)
struct XcdBarrier { unsigned* bar; unsigned x; volatile LAS unsigned* st; };
__device__ __forceinline__ XcdBarrier xcd_barrier_post(unsigned* bar, volatile LAS unsigned* st) {
    XcdBarrier b; b.bar = bar; b.x = xb_xcc_id(); b.st = st;
    if (threadIdx.x == 0) (void)xb_add(&bar[XB_XCNT(b.x)], 1u);
    return b;
}
__device__ __forceinline__ void xcd_barrier_complete(unsigned* bar, unsigned x, unsigned& nloc, unsigned& nx) {
    const unsigned G = gridDim.x * gridDim.y * gridDim.z;
    unsigned sum, cnt, mine, sp = 0u;
    for (;;) {
        sum = 0u; cnt = 0u; mine = 0u;
#pragma unroll
        for (unsigned j = 0; j < 16; ++j) { const unsigned c = xb_ld(&bar[XB_XCNT(j)]); sum += c; cnt += (c > 0u) ? 1u : 0u; mine = (j == x) ? c : mine; }
        if (sum == G) break;
        __builtin_amdgcn_s_sleep(1);
        if ((++sp & 255u) == 0u) { if (xb_ld(&bar[XB_TMO])) break; if (sp > XB_SPIN_CAP) { atomicAdd(&bar[XB_TMO], 1u); break; } }
    }
    nloc = mine > 0u ? mine : 1u; nx = cnt > 0u ? cnt : 1u;
}
__device__ __forceinline__ void xcd_barrier(const XcdBarrier& b) {
    asm volatile("s_waitcnt vmcnt(0)" ::: "memory");
    __syncthreads();
    if (threadIdx.x == 0) {
        unsigned* bar = b.bar;
        __builtin_amdgcn_s_waitcnt(0);
        unsigned nloc = b.st[0], nx = b.st[1];
        if (nloc == 0u) { xcd_barrier_complete(bar, b.x, nloc, nx); b.st[0] = nloc; b.st[1] = nx; }
        const unsigned old = xb_add(&bar[XB_XSUB(b.x)], 1u);
        const unsigned gen = old / nloc;
        if (old + 1u == (gen + 1u) * nloc) {
            __builtin_amdgcn_fence(__ATOMIC_RELEASE, "agent");
            asm volatile("s_waitcnt vmcnt(0)" ::: "memory");
            const unsigned og = xb_add(&bar[XB_TOP], 1u);
            const unsigned tg = og / nx;
            if (og + 1u == (tg + 1u) * nx) xb_add(&bar[XB_TOPGEN], 1u);
            else XB_SPIN(xb_ld(&bar[XB_TOPGEN]) == tg, bar);
            __builtin_amdgcn_fence(__ATOMIC_ACQUIRE, "agent");
            xb_add(&bar[XB_XGEN(b.x)], 1u);
            asm volatile("s_waitcnt vmcnt(0)" ::: "memory");
        } else {
            XB_SPIN(xb_ld(&bar[XB_XGEN(b.x)]) == gen, bar);
            __builtin_amdgcn_fence(__ATOMIC_ACQUIRE, "agent");
            asm volatile("s_waitcnt vmcnt(0)" ::: "memory");
        }
    }
    __syncthreads();
}
#endif

__global__ void __launch_bounds__(512, 2) mk_fwd(Params P) {
#ifdef EMU
    unsigned char* smem = g_blk->lds;
#else
    extern __shared__ __attribute__((aligned(16))) unsigned char smem[];
    volatile LAS unsigned* bst = (volatile LAS unsigned*)(smem + LDS_BYTES - 16);
    if (threadIdx.x == 0) { bst[0] = 0u; bst[1] = 0u; bst[2] = 0u; bst[3] = 0u; }
    __syncthreads();
    XcdBarrier bar; bar.bar = (unsigned*)P.ws + CW_BAR; bar.x = 0; bar.st = bst;
    if (P.ph_hi - P.ph_lo > 1) bar = xcd_barrier_post((unsigned*)P.ws + CW_BAR, bst);
#endif
    const int lo = P.ph_lo, hi = P.ph_hi;
#ifdef EMU
    const int wv = (int)threadIdx.x >> 6;
#else
    const int wv = RFL((int)threadIdx.x >> 6);
#endif
#ifdef EMU
#define SEAM(id) do {} while (0)
#else
#define SEAM(id) do { if ((id) + 1 < hi) xcd_barrier(bar); } while (0)
#endif
#ifndef MK_ONLY_PHASE
#define MK_ONLY_PHASE -1
#endif
#ifndef MK_DUP_MASK
#define MK_DUP_MASK 0
#endif
#define PHG(kc, id, ...) do { if (MK_ONLY_PHASE < 0 || MK_ONLY_PHASE == (kc)) { const int id_ = (id); if (id_ >= lo && id_ < hi) { if ((MK_DUP_MASK >> (kc)) & 1) { __VA_ARGS__; SEAM(id_ - 1); } __VA_ARGS__; SEAM(id_); } } } while (0)
#define PH(k, ...) PHG(1 + (k), 1 + l * NPH + (k), __VA_ARGS__)
    PHG(0, 0, phase_prologue(P, smem, wv));
    for (int l = 0; l < NL; ++l) {
        PH(0, phase_inproj(P, l, smem, wv));
        PH(1, phase_prep(P, l, smem, wv));
#if MK_RWKV_CHUNKED
        PH(2, { phase_rwkv_pre(P, l, smem, wv); phase_mlstm_local(P, l, smem, wv, (int)blockIdx.x, (int)gridDim.x); });
        PH(3, { phase_rwkv_seq(P, l, smem, wv); phase_mlstm_carry(P, l, smem, wv); });
        PH(4, { phase_rwkv_out(P, l, smem, wv); phase_mlstm_out(P, l, smem, wv); phase_gmlp_mix(P, l, smem, wv, (int)blockIdx.x, (int)gridDim.x); });
#else
        PH(2, { const int G_ = (int)gridDim.x, NSC = 2 * NB * RH * 4;
                if (G_ >= NSC + 32) { if ((int)blockIdx.x < NSC) phase_rwkv_scan(P, l, smem, wv, (int)blockIdx.x, NSC);
                                      else phase_mlstm_local(P, l, smem, wv, (int)blockIdx.x - NSC, G_ - NSC); }
                else { phase_rwkv_scan(P, l, smem, wv, (int)blockIdx.x, G_); phase_mlstm_local(P, l, smem, wv, (int)blockIdx.x, G_); } });
        PH(3, phase_mlstm_carry(P, l, smem, wv));
        PH(4, { phase_mlstm_out(P, l, smem, wv); phase_gmlp_mix(P, l, smem, wv, (int)blockIdx.x, (int)gridDim.x); phase_rwkv_post(P, l, smem, wv); });
#endif
        PH(5, phase_outproj(P, l, smem, wv));
        PH(6, phase_ln1_router(P, l, smem, wv));
        PH(7, phase_scatter(P, l, smem, wv));
        PH(8, phase_moe_gemm<1>(P, l, smem, wv));
        PH(9, phase_moe_gemm<2>(P, l, smem, wv));
        PH(10, phase_combine_ln2(P, l, smem, wv));
    }
#undef PHG
#undef PH
#undef SEAM
}

}

#ifndef EMU
extern "C" void kernel_launch(void* const* d_in, const int* in_sizes, int n_in, void* d_out, int out_size, void* d_ws, size_t ws_size, hipStream_t stream) {
    using namespace mk;
    static int grid = 0;
    if (grid == 0) {
        if (n_in != 32 || out_size != T * D || ws_size < WS_END) { fprintf(stderr, "kernel_launch: unexpected shapes (n_in %d out %d ws %zu need %zu)\n", n_in, out_size, ws_size, (size_t)WS_END); grid = -1; return; }
        int dev = 0, cus = 0;
        if (hipGetDevice(&dev) != hipSuccess || hipDeviceGetAttribute(&cus, hipDeviceAttributeMultiprocessorCount, dev) != hipSuccess) { grid = -1; return; }
        if (hipFuncSetAttribute((const void*)mk_fwd, hipFuncAttributeMaxDynamicSharedMemorySize, LDS_BYTES) != hipSuccess) { fprintf(stderr, "kernel_launch: hipFuncSetAttribute failed\n"); grid = -1; return; }
        int per_cu = 0;
        (void)hipOccupancyMaxActiveBlocksPerMultiprocessor(&per_cu, (const void*)mk_fwd, NTHREADS, LDS_BYTES);
        (void)hipGetLastError();
        grid = cus;
    }
    if (grid < 0) return;
    (void)hipMemsetAsync(d_ws, 0, CTL_BYTES, stream);
    Params p{};
    for (int i = 0; i < 32; ++i) p.in[i] = (const float*)d_in[i];
    p.out = (float*)d_out; p.ws = (unsigned char*)d_ws;
#if MK_ONE_LAUNCH
    p.ph_lo = 0; p.ph_hi = 1 + NL * NPH;
    hipLaunchKernelGGL(mk_fwd, dim3(grid), dim3(NTHREADS), LDS_BYTES, stream, p);
#else
    for (int id = 0; id < 1 + NL * NPH; ++id) {
        p.ph_lo = id; p.ph_hi = id + 1;
        hipLaunchKernelGGL(mk_fwd, dim3(grid), dim3(NTHREADS), LDS_BYTES, stream, p);
    }
#endif
}
#endif
```

```cpp
#ifndef EMU
#include <hip/hip_runtime.h>
#endif
#include <cstdio>
#include <cstdint>
#include <cmath>

#ifndef CFG_BATCH
#define CFG_BATCH 4
#endif
#ifndef CFG_SEQ
#define CFG_SEQ 4096
#endif
#ifndef CFG_LAYERS
#define CFG_LAYERS 4
#endif
#ifndef MK_RWKV_CHUNKED
#define MK_RWKV_CHUNKED 1
#endif
#ifndef MK_PROBE
#define MK_PROBE 0
#endif
#ifndef MK_ONE_LAUNCH
#define MK_ONE_LAUNCH 1
#endif

namespace mk {
constexpr int NB = CFG_BATCH, S = CFG_SEQ, T = NB * S, NL = CFG_LAYERS, D = 1024;
constexpr int GW = 256, RW = 384, MW = 384, HD = 64, GH = 4, RH = 6, MH = 6, CH = 128, NCH = S / CH;
constexpr int PIN = 3480, PLD = 3584, RPROJ = 1408;
constexpr int C_RW = 512, C_MW = 1920;
constexpr int NE = 32, TOPK = 4, DFF = 1024, MOEB = 256;
constexpr int NROWS = (T * TOPK / MOEB + NE) * MOEB;
constexpr float LN_EPS = 1e-5f, GN_EPS = 64e-5f;
constexpr float ALPHA = 1.6817928305074290f;
constexpr int NTHREADS = 512, NWAVES = 8;
constexpr int LDS_BYTES = 160 * 1024;
constexpr int NPH = 11;

typedef float f32x4 __attribute__((ext_vector_type(4)));
typedef unsigned u32x4 __attribute__((ext_vector_type(4)));
typedef unsigned u32x2 __attribute__((ext_vector_type(2)));
typedef short bf16x8 __attribute__((ext_vector_type(8)));
typedef unsigned short bf16_t;

constexpr size_t al(size_t x) { return (x + 255) & ~(size_t)255; }
constexpr size_t CTL_BYTES = 1u << 20;
constexpr size_t O_XA = CTL_BYTES;
constexpr size_t O_XB = O_XA + al((size_t)T * D * 4);
constexpr size_t O_X1 = O_XB + al((size_t)T * D * 2);
constexpr size_t O_X1B = O_X1 + al((size_t)T * D * 4);
constexpr size_t O_PROJ = O_X1B + al((size_t)T * D * 2);
constexpr size_t O_MIX = O_PROJ + al((size_t)T * PLD * 4);
constexpr size_t O_GRP = O_MIX + al((size_t)T * D * 4);
constexpr size_t O_UG = O_GRP + al((size_t)T * D * 2);
constexpr size_t O_VN = O_UG + al((size_t)T * GW * 4);
constexpr size_t O_RR = O_VN + al((size_t)T * GW * 4);
constexpr size_t O_VV = O_RR + al((size_t)T * RW * 4);
constexpr size_t O_KK = O_VV + al((size_t)T * RW * 4);
constexpr size_t O_DEC = O_KK + al((size_t)T * RW * 4);
constexpr size_t O_KD = O_DEC + al((size_t)2 * T * RW * 4);
constexpr size_t O_ICLR = O_KD + al((size_t)2 * T * RW * 4);
constexpr size_t O_GATE = O_ICLR + al((size_t)2 * T * RW * 4);
constexpr size_t O_BONUS = O_GATE + al((size_t)T * RW * 4);
constexpr size_t O_SCAN = O_BONUS + al((size_t)T * RH * 4);
constexpr size_t O_MQ = O_SCAN + al((size_t)2 * T * RW * 4);
constexpr size_t O_MK = O_MQ + al((size_t)T * MW * 4);
constexpr size_t O_IG = O_MK + al((size_t)T * MW * 4);
constexpr size_t O_LF = O_IG + al((size_t)2 * T * MH * 4);
constexpr size_t O_CL = O_LF + al((size_t)2 * T * MH * 4);
constexpr size_t O_NL = O_CL + al((size_t)2 * NB * MH * NCH * 4096 * 4);
constexpr size_t O_ML = O_NL + al((size_t)2 * NB * MH * NCH * 64 * 4);
constexpr size_t O_BL = O_ML + al((size_t)2 * NB * MH * NCH * 4);
constexpr size_t O_MIN = O_BL + al((size_t)2 * NB * MH * NCH * 4);
constexpr size_t O_TOPI = O_MIN + al((size_t)2 * NB * MH * NCH * 4);
constexpr size_t O_TOPG = O_TOPI + al((size_t)T * 4 * 4);
constexpr size_t O_RANK = O_TOPG + al((size_t)T * 4 * 4);
constexpr size_t O_SLOT = O_RANK + al((size_t)T * 4 * 4);
constexpr size_t O_MQB = O_SLOT + al((size_t)T * 4 * 4);
constexpr size_t O_MKB = O_MQB + al((size_t)T * MW * 2);
constexpr size_t O_KT = O_MKB + al((size_t)T * MW * 2);
constexpr size_t O_VT = O_KT + al((size_t)T * MW * 2);
constexpr size_t O_GVT = O_VT + al((size_t)T * MW * 2);
constexpr size_t O_PMX = O_GVT + al((size_t)2 * T * MH * 4);
constexpr size_t O_BCT = O_PMX + al((size_t)2 * T * MH * 4);
constexpr size_t O_BRKR = O_BCT + al((size_t)2 * T * MH * 4);
constexpr int RC = 64, RNC = S / RC, RUN = 2 * NB * RH * RNC;
constexpr size_t O_LW = O_BRKR + al((size_t)2 * T * RH * 2 * 4);
constexpr size_t O_RQ = O_LW + al((size_t)2 * T * RW * 4);
constexpr size_t O_RA = O_RQ + al((size_t)RUN * 4096 * 2);
constexpr size_t O_RS = O_RA + al((size_t)RUN * 4096 * 2);
constexpr size_t O_RH = O_RS + al((size_t)RUN * 4096 * 2);
constexpr size_t O_RG = O_RH + al((size_t)RUN * 4096 * 4);
constexpr size_t O_RB = O_RG + al((size_t)RUN * 4096 * 4);
constexpr size_t O_VB = O_RB + al((size_t)T * RW * 2);
constexpr size_t O_KKB = O_VB + al((size_t)T * RW * 2);
constexpr size_t O_BBB = O_KKB + al((size_t)T * RW * 2);
constexpr size_t O_KDB = O_BBB + al((size_t)2 * T * RW * 2);
constexpr size_t O_VNT = O_KDB + al((size_t)2 * T * RW * 2);
constexpr size_t O_WSB = O_VNT + al((size_t)T * GW * 2);
constexpr size_t O_LWT = O_WSB + al((size_t)NL * GH * CH * CH * 2);
constexpr size_t O_RWT = O_LWT + al((size_t)NL * 1920 * 128 * 2);
constexpr size_t O_BCNT = O_RWT + al((size_t)NL * 2 * NE * D * 2);
constexpr size_t O_CNTF = O_BCNT + al((size_t)(T / 64) * NE * 4);
constexpr size_t O_ROWT = O_CNTF + al((size_t)NE * 4);
constexpr size_t O_XS = O_ROWT + al((size_t)NROWS * 4);
constexpr size_t O_ACT = O_XS + al((size_t)NROWS * D * 2);
constexpr size_t O_YS = O_ACT + al((size_t)NROWS * DFF * 2);
constexpr size_t O_WIN = O_YS + al((size_t)NROWS * D * 2);
constexpr size_t O_WOUT = O_WIN + al((size_t)NL * PLD * D * 2);
constexpr size_t O_W1 = O_WOUT + al((size_t)NL * D * D * 2);
constexpr size_t O_W2 = O_W1 + al((size_t)NL * NE * 2 * DFF * D * 2);
constexpr size_t WS_END = O_W2 + al((size_t)NL * NE * D * DFF * 2);

constexpr int CW_BAR = 4096;
constexpr int CW_CNT = 16384;

struct Params { const float* in[32]; float* out; unsigned char* ws; int ph_lo, ph_hi; };
#ifdef EMU
typedef const Params* ParamsPtr;
#define PARAMS_PTR(P) (&(P))
#else
typedef const __attribute__((address_space(4))) Params* ParamsPtr;
#define PARAMS_PTR(P) ((ParamsPtr)__builtin_amdgcn_kernarg_segment_ptr())
#endif

#ifdef EMU
#define WAVE_SYNC() emu_wave_barrier()
#define PIN_V(x) do {} while (0)
#define PIN_S(x) do {} while (0)
#else
#define WAVE_SYNC() __builtin_amdgcn_wave_barrier()
#define PIN_V(x) asm volatile("" : "+v"(x))
#define PIN_S(x) asm volatile("" : "+s"(x))
#endif
#ifdef EMU
__device__ __forceinline__ int phase_tid(int wv) { (void)wv; return threadIdx.x; }
#else
__device__ __forceinline__ int phase_tid(int wv) { int t; asm volatile("v_mbcnt_lo_u32_b32 %0, -1, 0\n\tv_mbcnt_hi_u32_b32 %0, -1, %0" : "=v"(t)); return (wv << 6) + t; }
#endif

#ifdef EMU
#define SHX(v, m, lane) __shfl_xor(v, m)
#else
__device__ __forceinline__ float shx_(float v, int m, int lane) { return __builtin_bit_cast(float, __builtin_amdgcn_ds_bpermute((lane ^ m) << 2, __builtin_bit_cast(int, v))); }
__device__ __forceinline__ int shx_(int v, int m, int lane) { return __builtin_amdgcn_ds_bpermute((lane ^ m) << 2, v); }
#define SHX(v, m, lane) shx_(v, m, lane)
#endif
#ifdef EMU
#define SHUP(v, o, lane) __shfl(v, ((lane) - (o)) & 63)
#define RDL(v, src) __shfl(v, src)
#define SHL(v, src) __shfl(v, src)
#else
#define SHL(v, src) __builtin_bit_cast(float, __builtin_amdgcn_ds_bpermute((src) << 2, __builtin_bit_cast(int, (float)(v))))
#define SHUP(v, o, lane) __builtin_bit_cast(float, __builtin_amdgcn_ds_bpermute((((lane) - (o)) & 63) << 2, __builtin_bit_cast(int, (float)(v))))
#define RDL(v, src) __builtin_bit_cast(float, __builtin_amdgcn_readlane(__builtin_bit_cast(int, (float)(v)), src))
#endif
__device__ __forceinline__ float wave_sum(float v, int lane) {
#pragma unroll
    for (int o = 32; o >= 1; o >>= 1) v += SHX(v, o, lane);
    return v;
}
#ifdef EMU
__device__ __forceinline__ float fexp(float x) { return expf(x); }
__device__ __forceinline__ float flog(float x) { return logf(x); }
__device__ __forceinline__ float frcp(float x) { return 1.0f / x; }
#else
__device__ __forceinline__ float fexp(float x) { return __builtin_amdgcn_exp2f(x * 1.4426950408889634f); }
__device__ __forceinline__ float flog(float x) { return __builtin_amdgcn_logf(x) * 0.6931471805599453f; }
__device__ __forceinline__ float frcp(float x) { return __builtin_amdgcn_rcpf(x); }
#endif
__device__ __forceinline__ float sigmoidf_(float x) { return frcp(1.0f + fexp(-x)); }
__device__ __forceinline__ float softplusf_(float x) { return fmaxf(x, 0.f) + flog(1.0f + fexp(-fabsf(x))); }
__device__ __forceinline__ float ftanh(float x) { return 1.0f - 2.0f * frcp(1.0f + fexp(2.0f * x)); }
__device__ __forceinline__ float geluf_(float v) {
    const float av = fabsf(v), t = frcp(1.0f + 0.2316418882f * av);
    float q = t * 0.5307027145f + (-0.7265760135f); q = q * t + 0.7107068705f; q = q * t + (-0.142248368f); q = q * t + 0.127414796f; q = q * t;
    const float m = v * (q * fexp(-0.5f * v * v));
    return v < 0.f ? m : v - m;
}

#ifdef EMU
#define LAS
#define WAIT_V(n) do {} while (0)
#define WAIT_L(n) do {} while (0)
#define S_BARRIER() __syncthreads()
#define SETPRIO(x) do {} while (0)
#define SCHED_BAR() do {} while (0)
#define RFL(x) (x)
static inline void emu_glds16(const void* g, void* l) { memcpy((char*)l + (g_blk->cur & 63) * 16, g, 16); }
#define GLDS16(gptr, ldsptr) emu_glds16((const void*)(gptr), (void*)(ldsptr))
static inline float emu_bf2f(unsigned short b) { unsigned u = (unsigned)b << 16; float f; memcpy(&f, &u, 4); return f; }
static inline f32x4 emu_mfma16(bf16x8 a, bf16x8 b, f32x4 c) {
    EmuBlock* blk = g_blk; const int cur = blk->cur, lane = cur & 63, wbase = cur & ~63;
    static thread_local unsigned short Ash[32][64][8], Bsh[32][64][8];
    const int w = cur >> 6;
    for (int j = 0; j < 8; ++j) { Ash[w][lane][j] = (unsigned short)a[j]; Bsh[w][lane][j] = (unsigned short)b[j]; }
    emu_wave_barrier();
    const int col = lane & 15;
    for (int r = 0; r < 4; ++r) { const int row = 4 * (lane >> 4) + r; float sum = c[r];
        for (int k = 0; k < 32; ++k) sum += emu_bf2f(Ash[w][row + 16 * (k >> 3)][k & 7]) * emu_bf2f(Bsh[w][col + 16 * (k >> 3)][k & 7]);
        c[r] = sum; }
    emu_wave_barrier(); (void)wbase;
    return c;
}
#define MFMA16(a, b, c) emu_mfma16(a, b, c)
#else
#define LAS __attribute__((address_space(3)))
#define WAIT_V(n) asm volatile("s_waitcnt vmcnt(" #n ")" ::: "memory")
#define WAIT_L(n) asm volatile("s_waitcnt lgkmcnt(" #n ")" ::: "memory")
#define S_BARRIER() __builtin_amdgcn_s_barrier()
#define SETPRIO(x) __builtin_amdgcn_s_setprio(x)
#define SCHED_BAR() __builtin_amdgcn_sched_barrier(0)
#define RFL(x) __builtin_amdgcn_readfirstlane(x)
#define GLDS16(gptr, ldsptr) __builtin_amdgcn_global_load_lds((const unsigned*)(gptr), (LAS unsigned*)(ldsptr), 16, 0, 0)
#define MFMA16(a, b, c) __builtin_amdgcn_mfma_f32_16x16x32_bf16(a, b, c, 0, 0, 0)
#endif

__device__ __forceinline__ unsigned f2bf(float f) { unsigned u = __builtin_bit_cast(unsigned, f); return (u + 0x7fffu + ((u >> 16) & 1u)) >> 16; }
__device__ __forceinline__ unsigned pk2(float lo, float hi) { return f2bf(lo) | (f2bf(hi) << 16); }
__device__ __forceinline__ bf16x8 cvt8(const f32x4 a, const f32x4 b) {
    u32x4 w; w.x = pk2(a.x, a.y); w.y = pk2(a.z, a.w); w.z = pk2(b.x, b.y); w.w = pk2(b.z, b.w); return __builtin_bit_cast(bf16x8, w);
}
__device__ __forceinline__ float bf_lo(unsigned u) { return __builtin_bit_cast(float, u << 16); }
__device__ __forceinline__ float bf_hi(unsigned u) { return __builtin_bit_cast(float, u & 0xffff0000u); }

namespace pg8 {
constexpr int BM = 256, BK = 64, HALF = 128, HTB = HALF * BK * 2, STAGE_BYTES = 8 * HTB, NXCD = 8, WGM = 8;
__host__ __device__ __forceinline__ int lds_byte(int r, int c) { const int st = (r >> 4) * 2 + (c >> 5), rr = r & 15, cc = c & 31, ob = rr * 64 + cc * 2; return st * 1024 + (ob ^ (((ob >> 9) & 1) << 5)); }
__host__ __device__ __forceinline__ void stage_rc(int b, int& R, int& C) { const int st = b / 1024, sb = b % 1024, swz = sb ^ (((sb >> 9) & 1) << 5); R = (st >> 1) * 16 + swz / 64; C = (st & 1) * 32 + (swz % 64) / 2; }
__host__ __device__ __forceinline__ int perm32(int rho) { const int n = rho >> 4, i = rho & 15; return 8 * (i >> 2) + 4 * n + (i & 3); }
struct Unit { int pm, pn, e; };

struct DenseOrder {
    static constexpr bool GATHER = false;
    const char* A; const char* Bt; int K; int nM, nN, nwg, G, c;
    __device__ __forceinline__ void init(const void* A_, const void* Bt_, int M, int N, int K_, int G_, int c_) { A = (const char*)A_; Bt = (const char*)Bt_; K = K_; nM = M / BM; nN = N / BM; nwg = nM * nN; G = G_; c = c_; }
    __device__ __forceinline__ bool next(int i, Unit& u) const {
        const long L = (long)i * G + c; if (L >= nwg) return false;
        int wgid = (int)L; { const int q = nwg / NXCD, r = nwg % NXCD, xcd = wgid % NXCD, off = wgid / NXCD; wgid = (xcd < r ? xcd * (q + 1) : r * (q + 1) + (xcd - r) * q) + off; }
        const int nig = WGM * nN, gid = wgid / nig, fm = gid * WGM, gsz = (nM - fm) < WGM ? (nM - fm) : WGM;
        u.pm = fm + ((wgid % nig) % gsz); u.pn = (wgid % nig) / gsz; u.e = 0; return true;
    }
    __device__ __forceinline__ const char* abase(const Unit& u) const { return A + (size_t)u.pm * BM * K * 2; }
    __device__ __forceinline__ const char* bbase(const Unit& u) const { return Bt + (size_t)u.pn * BM * K * 2; }
};
template <bool G>
struct MoeOrderT {
    static constexpr bool GATHER = G;
    const char* A; const char* Wt; int K; int nN, nwg, G_, c; size_t estride; const int* rbe; const int* rowmap;
    __device__ __forceinline__ bool next(int i, Unit& u) const {
        const long L = (long)i * G_ + c; if (L >= nwg) return false;
        u.pm = (int)(L / nN); u.pn = (int)(L % nN); u.e = rbe[u.pm]; return true;
    }
    __device__ __forceinline__ const char* abase(const Unit& u) const { return G ? A : A + (size_t)u.pm * BM * K * 2; }
    __device__ __forceinline__ const char* bbase(const Unit& u) const { return Wt + (size_t)u.e * estride + (size_t)u.pn * BM * K * 2; }
};
struct EpiF32 {
    static constexpr bool PERM = false;
    float* C; int ldc;
    __device__ __forceinline__ void operator()(const f32x4 (&acc)[2][2][4][2], const Unit& u, int wr, int wc, int fr, int fq) const {
        const int row0 = u.pm * BM + wr * 64 + fr, col0 = u.pn * BM + wc * 32 + 4 * fq;
#pragma unroll
        for (int ai = 0; ai < 2; ++ai)
#pragma unroll
            for (int m = 0; m < 4; ++m) { float* rowp = C + (size_t)(row0 + ai * HALF + m * 16) * ldc + col0;
#pragma unroll
                for (int bj = 0; bj < 2; ++bj)
#pragma unroll
                    for (int n = 0; n < 2; ++n) *(f32x4*)(rowp + bj * HALF + n * 16) = acc[ai][bj][m][n]; }
    }
};
struct EpiBf16Bias {
    static constexpr bool PERM = true;
    bf16_t* O; int ldc; const float* bias; int bias_estride;
    __device__ __forceinline__ void operator()(const f32x4 (&acc)[2][2][4][2], const Unit& u, int wr, int wc, int fr, int fq) const {
        const int row0 = u.pm * BM + wr * 64 + fr, col0 = u.pn * BM + wc * 32 + 8 * fq;
        const float* bp = bias + (size_t)u.e * bias_estride + col0;
        f32x4 bv[2][2];
#pragma unroll
        for (int bj = 0; bj < 2; ++bj)
#pragma unroll
            for (int n = 0; n < 2; ++n) bv[bj][n] = *(const f32x4*)(bp + bj * HALF + 4 * n);
#pragma unroll
        for (int ai = 0; ai < 2; ++ai)
#pragma unroll
            for (int m = 0; m < 4; ++m) { bf16_t* rowp = O + (size_t)(row0 + ai * HALF + m * 16) * ldc + col0;
#pragma unroll
                for (int bj = 0; bj < 2; ++bj) { const f32x4 v0 = acc[ai][bj][m][0] + bv[bj][0], v1 = acc[ai][bj][m][1] + bv[bj][1];
                    u32x4 w; w.x = pk2(v0[0], v0[1]); w.y = pk2(v0[2], v0[3]); w.z = pk2(v1[0], v1[1]); w.w = pk2(v1[2], v1[3]);
                    *(u32x4*)(rowp + bj * HALF) = w; } }
    }
};
__device__ __forceinline__ float swiglu1(float g, float uu) { g = fminf(g, 7.0f); uu = fminf(fmaxf(uu, -7.0f), 7.0f); return (uu + 1.0f) * (g * frcp(1.0f + fexp(-1.702f * g))); }
struct EpiSwiglu {
    static constexpr bool PERM = true;
    bf16_t* O; const float* b1;
    __device__ __forceinline__ void operator()(const f32x4 (&acc)[2][2][4][2], const Unit& u, int wr, int wc, int fr, int fq) const {
        const int row0 = u.pm * BM + wr * 64 + fr, j0 = u.pn * HALF + wc * 32 + 8 * fq;
        const float* bg = b1 + (size_t)u.e * 2 * DFF + j0; const float* bu = bg + DFF;
        f32x4 g4[2], u4[2];
#pragma unroll
        for (int n = 0; n < 2; ++n) { g4[n] = *(const f32x4*)(bg + 4 * n); u4[n] = *(const f32x4*)(bu + 4 * n); }
#pragma unroll
        for (int ai = 0; ai < 2; ++ai)
#pragma unroll
            for (int m = 0; m < 4; ++m) {
                float o[8];
#pragma unroll
                for (int n = 0; n < 2; ++n)
#pragma unroll
                    for (int q = 0; q < 4; ++q) o[n * 4 + q] = swiglu1(acc[ai][0][m][n][q] + g4[n][q], acc[ai][1][m][n][q] + u4[n][q]);
                u32x4 w; w.x = pk2(o[0], o[1]); w.y = pk2(o[2], o[3]); w.z = pk2(o[4], o[5]); w.w = pk2(o[6], o[7]);
                *(u32x4*)(O + (size_t)(row0 + ai * HALF + m * 16) * DFF + j0) = w;
            }
    }
};

template <class Epi, class Sched>
__device__ __forceinline__ void gemm_phase(LAS unsigned char* lds, const int K, const Sched& S, const Epi& E, const int tid) {
    const int wid = RFL(tid >> 6), lane = tid & 63, wr = wid >> 2, wc = wid & 3, fr = lane & 15, fq = lane >> 4;
    const int nt = K / BK;
    unsigned voffA[2], voffB[2]; int gR[2]; unsigned gC[2];
#pragma unroll
    for (int i = 0; i < 2; ++i) { int R, C; stage_rc(tid * 16 + i * 8192, R, C); const int Rb = Epi::PERM ? ((R & ~31) + perm32(R & 31)) : R;
        voffA[i] = (unsigned)(R * K + C) * 2u; voffB[i] = (unsigned)(Rb * K + C) * 2u; gR[i] = R; gC[i] = (unsigned)C * 2u; }
    unsigned va[2][2], vn[2][2];
#define PG8_GOFF(dst, unit) do { if constexpr (Sched::GATHER) { _Pragma("unroll") for (int h_ = 0; h_ < 2; ++h_) _Pragma("unroll") for (int i_ = 0; i_ < 2; ++i_) \
        dst[h_][i_] = (unsigned)S.rowmap[(unit).pm * BM + h_ * HALF + gR[i_]] * (unsigned)(K * 2) + gC[i_]; } } while (0)
#define PG8_STAGE_A(bufoff, bp, kb, h, nx) do { if constexpr (Sched::GATHER) { const char* gb_ = S.A + (kb); _Pragma("unroll") for (int _i = 0; _i < 2; ++_i) \
        GLDS16(gb_ + ((nx) ? vn[h][_i] : va[h][_i]), lds + (bufoff) + ldsw + _i * 8192); } else { PG8_STAGE(bufoff, bp, voffA); } } while (0)
    const size_t kstep = (size_t)(BK * 2);
    const size_t hstep = (size_t)HALF * K * 2;
    const unsigned ldsw = (unsigned)wid * 1024u;
    const int aoff = lds_byte(wr * 64 + fr, fq * 8), boff = lds_byte(wc * 32 + fr, fq * 8);
#define PG8_SA(b, h) (((b) * 2 + (h)) * HTB)
#define PG8_SB(b, h) ((4 + (b) * 2 + (h)) * HTB)
#define PG8_STAGE(bufoff, gbase, voff) do { _Pragma("unroll") for (int _i = 0; _i < 2; ++_i) \
        GLDS16((const char*)(gbase) + (voff)[_i], lds + (bufoff) + ldsw + _i * 8192); } while (0)
#define PG8_LDA(dst, b, h) do { _Pragma("unroll") for (int m = 0; m < 4; ++m) _Pragma("unroll") for (int k = 0; k < 2; ++k) dst[m][k] = *(const LAS bf16x8*)(lds + PG8_SA(b, h) + aoff + m * 2048 + k * 1024); } while (0)
#define PG8_LDB(dst, b, h) do { _Pragma("unroll") for (int n = 0; n < 2; ++n) _Pragma("unroll") for (int k = 0; k < 2; ++k) dst[n][k] = *(const LAS bf16x8*)(lds + PG8_SB(b, h) + boff + n * 2048 + k * 1024); } while (0)
#define PG8_MMA(ai, bj, At, Bt) do { SETPRIO(1); _Pragma("unroll") for (int m = 0; m < 4; ++m) _Pragma("unroll") for (int n = 0; n < 2; ++n) _Pragma("unroll") for (int k = 0; k < 2; ++k) \
        acc[ai][bj][m][n] = MFMA16(Bt[n][k], At[m][k], acc[ai][bj][m][n]); SETPRIO(0); } while (0)
    Unit cur, nxt; int ui = 0;
    if (!S.next(0, cur)) return;
    f32x4 acc[2][2][4][2];
#pragma unroll
    for (int a = 0; a < 2; ++a)
#pragma unroll
        for (int b = 0; b < 2; ++b)
#pragma unroll
            for (int m = 0; m < 4; ++m)
#pragma unroll
                for (int n = 0; n < 2; ++n) acc[a][b][m][n] = (f32x4){0.f, 0.f, 0.f, 0.f};
    bf16x8 At[4][2], B0[2][2], B1[2][2];
    const char* cA = S.abase(cur); const char* cB = S.bbase(cur);
    PG8_GOFF(va, cur);
    PG8_STAGE(PG8_SB(0, 0), cB, voffB); PG8_STAGE_A(PG8_SA(0, 0), cA, 0, 0, false); PG8_STAGE(PG8_SB(0, 1), cB + hstep, voffB); PG8_STAGE_A(PG8_SA(0, 1), cA + hstep, 0, 1, false);
    if (wr == 1) S_BARRIER();
    WAIT_V(4); S_BARRIER();
    PG8_STAGE(PG8_SB(1, 0), cB + kstep, voffB); PG8_STAGE_A(PG8_SA(1, 0), cA + kstep, kstep, 0, false); PG8_STAGE(PG8_SB(1, 1), cB + hstep + kstep, voffB);
    WAIT_V(6); S_BARRIER();
    for (;;) {
        const bool has_next = S.next(ui + 1, nxt);
        const char* nA = has_next ? S.abase(nxt) : cA; const char* nB = has_next ? S.bbase(nxt) : cB;
        if constexpr (Sched::GATHER) { if (has_next) { PG8_GOFF(vn, nxt); } else {
#pragma unroll
            for (int h_ = 0; h_ < 2; ++h_) { vn[h_][0] = va[h_][0]; vn[h_][1] = va[h_][1]; } } }
        for (int t = 0; t < nt; t += 2) {
            const bool last = (t == nt - 2);
            const char* a1 = cA + (size_t)(t + 1) * kstep;
            const char* a2 = last ? nA : cA + (size_t)(t + 2) * kstep; const char* b2 = last ? nB : cB + (size_t)(t + 2) * kstep;
            const char* a3 = a2 + kstep; const char* b3 = b2 + kstep;
            PG8_LDB(B0, 0, 0); SCHED_BAR(); PG8_LDA(At, 0, 0); PG8_STAGE_A(PG8_SA(1, 1), a1 + hstep, (size_t)(t + 1) * kstep, 1, false);
            WAIT_L(8); S_BARRIER(); WAIT_L(0); PG8_MMA(0, 0, At, B0); S_BARRIER(); SCHED_BAR();
            PG8_LDB(B1, 0, 1); PG8_STAGE(PG8_SB(0, 0), b2, voffB);
            S_BARRIER(); WAIT_L(0); PG8_MMA(0, 1, At, B1); S_BARRIER();
            PG8_LDA(At, 0, 1); PG8_STAGE_A(PG8_SA(0, 0), a2, (last ? (size_t)0 : (size_t)(t + 2) * kstep), 0, last);
            S_BARRIER(); WAIT_L(0); PG8_MMA(1, 0, At, B0); S_BARRIER(); SCHED_BAR();
            PG8_STAGE(PG8_SB(0, 1), b2 + hstep, voffB);
            WAIT_V(6); S_BARRIER(); PG8_MMA(1, 1, At, B1); S_BARRIER();
            PG8_LDB(B0, 1, 0); SCHED_BAR(); PG8_LDA(At, 1, 0); PG8_STAGE_A(PG8_SA(0, 1), a2 + hstep, (last ? (size_t)0 : (size_t)(t + 2) * kstep), 1, last);
            WAIT_L(8); S_BARRIER(); WAIT_L(0); PG8_MMA(0, 0, At, B0); S_BARRIER(); SCHED_BAR();
            PG8_LDB(B1, 1, 1); PG8_STAGE(PG8_SB(1, 0), b3, voffB);
            S_BARRIER(); WAIT_L(0); PG8_MMA(0, 1, At, B1); S_BARRIER();
            PG8_LDA(At, 1, 1); PG8_STAGE_A(PG8_SA(1, 0), a3, (last ? kstep : (size_t)(t + 3) * kstep), 0, last);
            S_BARRIER(); WAIT_L(0); PG8_MMA(1, 0, At, B0); S_BARRIER(); SCHED_BAR();
            PG8_STAGE(PG8_SB(1, 1), b3 + hstep, voffB);
            WAIT_V(6); S_BARRIER(); PG8_MMA(1, 1, At, B1); S_BARRIER();
        }
        E(acc, cur, wr, wc, fr, fq);
        if (!has_next) break;
#pragma unroll
        for (int a = 0; a < 2; ++a)
#pragma unroll
            for (int b = 0; b < 2; ++b)
#pragma unroll
                for (int m = 0; m < 4; ++m)
#pragma unroll
                    for (int n = 0; n < 2; ++n) acc[a][b][m][n] = (f32x4){0.f, 0.f, 0.f, 0.f};
        cur = nxt; cA = nA; cB = nB; ++ui;
        if constexpr (Sched::GATHER) {
#pragma unroll
            for (int h_ = 0; h_ < 2; ++h_) { va[h_][0] = vn[h_][0]; va[h_][1] = vn[h_][1]; } }
    }
    WAIT_V(0);
    if (wr == 0) S_BARRIER();
    S_BARRIER();
#undef PG8_SA
#undef PG8_SB
#undef PG8_STAGE
#undef PG8_STAGE_A
#undef PG8_GOFF
#undef PG8_LDA
#undef PG8_LDB
#undef PG8_MMA
}
}

__device__ __forceinline__ float row16_sum(float x) {
#ifdef EMU
    x += __shfl_xor(x, 1); x += __shfl_xor(x, 2); x += __shfl_xor(x, 4); x += __shfl_xor(x, 8); return x;
#else
#define DPPF(v, ctrl) __builtin_bit_cast(float, __builtin_amdgcn_update_dpp(0, __builtin_bit_cast(int, (v)), (ctrl), 0xF, 0xF, false))
    x += DPPF(x, 0xB1); x += DPPF(x, 0x4E); x += DPPF(x, 0x141); x += DPPF(x, 0x140); return x;
#undef DPPF
#endif
}
__device__ __forceinline__ float row32_sum(float x) {
    x = row16_sum(x);
#ifdef EMU
    x += __shfl_xor(x, 32); return x;
#else
    float a = x, b = x;
    asm volatile("s_nop 1\n\tv_permlane32_swap_b32 %0, %1" : "+v"(a), "+v"(b));
    return a + b;
#endif
}
__device__ __forceinline__ float wave_sum_fast(float x, int lane) {
    x = row32_sum(x);
    x += SHX(x, 16, lane);
    return x;
}
__device__ __forceinline__ void transpose_item(const float* W, int K, int N, bf16_t* WT, int k0, int n0, int dst_row0, float* scr, int lane) {
    const int n4 = (lane & 15) * 4, kr = lane >> 4;
#pragma unroll 8
    for (int i = 0; i < 16; ++i) {
        const int kk = 4 * i + kr;
        f32x4 v = (f32x4){0.f, 0.f, 0.f, 0.f};
        if (n0 + n4 < N) v = *(const f32x4*)(W + (size_t)(k0 + kk) * N + n0 + n4);
        float* d = scr + kk * 65 + n4; d[0] = v.x; d[1] = v.y; d[2] = v.z; d[3] = v.w;
    }
    WAVE_SYNC();
    const int c = lane & 7;
#pragma unroll
    for (int j = 0; j < 8; ++j) { const int n = (lane >> 3) + 8 * j; const float* sp = scr + (8 * c) * 65 + n;
        u32x4 o; o.x = pk2(sp[0 * 65], sp[1 * 65]); o.y = pk2(sp[2 * 65], sp[3 * 65]); o.z = pk2(sp[4 * 65], sp[5 * 65]); o.w = pk2(sp[6 * 65], sp[7 * 65]);
        *(u32x4*)(WT + (size_t)(dst_row0 + n) * K + k0 + 8 * c) = o; }
    WAVE_SYNC();
}
__device__ __forceinline__ void phase_prologue(const Params& P, unsigned char* smem, int wv) {
    ParamsPtr pp = PARAMS_PTR(P); PIN_S(pp); unsigned char* ws = pp->ws; int bidx = (int)blockIdx.x, gdim = (int)gridDim.x; PIN_S(bidx); PIN_S(gdim);
    const int tid = phase_tid(wv), lane = tid & 63, wave = tid >> 6;
    float* scr = (float*)smem + wave * (64 * 65);
    const int gw = bidx * NWAVES + wave, ngw = NWAVES * gdim;
    constexpr int I_IN = 16 * (PLD / 64), I_OUT = 16 * 16, I_W1 = NE * 16 * 32, I_W2 = NE * 16 * 16, I_L = I_IN + I_OUT + I_W1 + I_W2;
    for (int it = gw; it < NL * I_L; it += ngw) {
        const int l = it / I_L; int r = it % I_L;
        if (r < I_IN) { const int kb = r / (PLD / 64), nb = r % (PLD / 64);
            transpose_item(pp->in[1] + (size_t)l * D * PIN, D, PIN, (bf16_t*)(ws + O_WIN) + (size_t)l * PLD * D, kb * 64, nb * 64, nb * 64, scr, lane); continue; }
        r -= I_IN;
        if (r < I_OUT) { const int kb = r / 16, nb = r % 16;
            transpose_item(pp->in[21] + (size_t)l * D * D, D, D, (bf16_t*)(ws + O_WOUT) + (size_t)l * D * D, kb * 64, nb * 64, nb * 64, scr, lane); continue; }
        r -= I_OUT;
        if (r < I_W1) { const int e = r / (16 * 32), q = r % (16 * 32), kb = q / 32, nb = q % 32, n0 = nb * 64;
            const int dst = n0 < DFF ? (n0 / 128) * 256 + (n0 % 128) : ((n0 - DFF) / 128) * 256 + 128 + ((n0 - DFF) % 128);
            transpose_item(pp->in[26] + ((size_t)l * NE + e) * D * 2 * DFF, D, 2 * DFF, (bf16_t*)(ws + O_W1) + ((size_t)l * NE + e) * 2 * DFF * D, kb * 64, n0, dst, scr, lane); continue; }
        r -= I_W1;
        { const int e = r / (16 * 16), q = r % (16 * 16), kb = q / 16, nb = q % 16;
            transpose_item(pp->in[28] + ((size_t)l * NE + e) * DFF * D, DFF, D, (bf16_t*)(ws + O_W2) + ((size_t)l * NE + e) * D * DFF, kb * 64, nb * 64, nb * 64, scr, lane); }
    }
    {
        const float* gw_ = pp->in[4]; bf16_t* WSB = (bf16_t*)(ws + O_WSB);
        for (size_t i = ((size_t)bidx * NTHREADS + tid) * 4; i < (size_t)NL * GH * CH * CH; i += (size_t)gdim * NTHREADS * 4) {
            const f32x4 v = *(const f32x4*)(gw_ + i); u32x2 o; o.x = pk2(v.x, v.y); o.y = pk2(v.z, v.w); *(u32x2*)(WSB + i) = o;
        }
    }
    {
        bf16_t* LWT = (bf16_t*)(ws + O_LWT);
        for (int i = bidx * NTHREADS + tid; i < NL * 1920 * 128; i += gdim * NTHREADS) {
            const int k = i & 127, n = (i >> 7) % 1920, ll = i / (1920 * 128);
            float v = 0.f;
            if (n < 1536) { if (k < 64) { const int grp = n / 768, d = (n / 384) & 1, c = n % 384; v = (grp == 0 ? pp->in[8] : pp->in[10])[(((size_t)ll * 2 + d) * 64 + k) * RW + c]; } }
            else v = pp->in[11][((size_t)ll * 128 + k) * RW + (n - 1536)];
            LWT[i] = (bf16_t)f2bf(v);
        }
    }
    {
        bf16_t* RWT = (bf16_t*)(ws + O_RWT);
        for (int i = bidx * NTHREADS + tid; i < NL * NE * D; i += gdim * NTHREADS) {
            const int k = i % D, e = (i / D) % NE, ll = i / (D * NE);
            const float v = pp->in[24][((size_t)ll * D + k) * NE + e];
            const unsigned hi = f2bf(v); const float lo = v - bf_lo(hi);
            RWT[((size_t)(ll * 2 + 0) * NE + e) * D + k] = (bf16_t)hi; RWT[((size_t)(ll * 2 + 1) * NE + e) * D + k] = (bf16_t)f2bf(lo);
        }
    }
    const float* x = pp->in[0]; bf16_t* XB = (bf16_t*)(ws + O_XB);
    for (size_t i = ((size_t)bidx * NTHREADS + tid) * 4; i < (size_t)T * D; i += (size_t)gdim * NTHREADS * 4) {
        const f32x4 v = *(const f32x4*)(x + i); u32x2 o; o.x = pk2(v.x, v.y); o.y = pk2(v.z, v.w); *(u32x2*)(XB + i) = o;
    }
}

__device__ __forceinline__ float tshift(const float* P, int t, int s, int col, const float* mu0, const float* mu1, int rc) {
    const float cur = P[(size_t)t * PLD + col];
    const float prv = s > 0 ? P[(size_t)(t - 1) * PLD + col] : 0.f;
    const float nxt = s < S - 1 ? P[(size_t)(t + 1) * PLD + col] : 0.f;
    return cur + mu0[rc] * (prv - cur) + mu1[rc] * (nxt - cur);
}

__device__ __forceinline__ void phase_prep(const Params& P, int l, unsigned char* smem, int wv) {
    ParamsPtr pp = PARAMS_PTR(P); PIN_S(pp); unsigned char* ws = pp->ws; int bidx = (int)blockIdx.x, gdim = (int)gridDim.x; PIN_S(bidx); PIN_S(gdim);
    const float* proj = (const float*)(ws + O_PROJ);
    float* UG = (float*)(ws + O_UG); bf16_t* VNT = (bf16_t*)(ws + O_VNT);
    float* RR = (float*)(ws + O_RR); float* VV = (float*)(ws + O_VV); float* KK = (float*)(ws + O_KK);
    float* KD = (float*)(ws + O_KD); float* ICLR = (float*)(ws + O_ICLR);
    float* GATE = (float*)(ws + O_GATE); float* BONUS = (float*)(ws + O_BONUS); float* LWG = (float*)(ws + O_LW);
    bf16_t* RB = (bf16_t*)(ws + O_RB); bf16_t* VB = (bf16_t*)(ws + O_VB); bf16_t* KKB = (bf16_t*)(ws + O_KKB); bf16_t* BBB = (bf16_t*)(ws + O_BBB); bf16_t* KDB = (bf16_t*)(ws + O_KDB);
#if !MK_RWKV_CHUNKED
    float* DEC = (float*)(ws + O_DEC); float* BRKR = (float*)(ws + O_BRKR);
#endif
    bf16_t* MQB = (bf16_t*)(ws + O_MQB); bf16_t* MKB = (bf16_t*)(ws + O_MKB); bf16_t* KT = (bf16_t*)(ws + O_KT); bf16_t* VT = (bf16_t*)(ws + O_VT);
    float* IG = (float*)(ws + O_IG); float* LF = (float*)(ws + O_LF);
    const bf16_t* LWT = (const bf16_t*)(ws + O_LWT) + (size_t)l * 1920 * 128;
    const float* gln_g = pp->in[2] + (size_t)l * GW; const float* gln_b = pp->in[3] + (size_t)l * GW;
    const float* mu0 = pp->in[6] + (size_t)l * 2 * RPROJ; const float* mu1 = mu0 + RPROJ;
    const float* w0 = pp->in[7] + (size_t)l * 2 * RW; const float* a0 = pp->in[9] + (size_t)l * 2 * RW;
    const float* k_k = pp->in[12] + (size_t)l * RW; const float* k_a = pp->in[13] + (size_t)l * RW; const float* r_k = pp->in[14] + (size_t)l * RW;
    const float* conv_w = pp->in[17] + (size_t)l * 3 * 768; const float* conv_b = pp->in[18] + (size_t)l * 768; const float* gate_b = pp->in[19] + (size_t)l * 24;
    float* win = (float*)smem;
    bf16_t* lin = (bf16_t*)(smem + 101376);
    bf16_t* tvn = (bf16_t*)(smem + 110592);
    bf16_t* tk = (bf16_t*)(smem + 118784);
    bf16_t* tv = (bf16_t*)(smem + 131072);
    constexpr int LIN = 264;
    const int tid = phase_tid(wv), lane = tid & 63, wave = tid >> 6, col = lane & 15, g = lane >> 4;
    for (int u = bidx; u < T / 16; u += gdim) {
        const int t0 = u * 16, s0 = t0 % S, bb = t0 / S;
        __syncthreads();
        {
            f32x4 wb[18];
#pragma unroll
            for (int row = 0; row < 18; ++row) {
                const int sq = s0 - 1 + row;
                wb[row] = (f32x4){0.f, 0.f, 0.f, 0.f};
                if (sq >= 0 && sq < S && tid < 352) wb[row] = *(const f32x4*)(proj + (size_t)(t0 - 1 + row) * PLD + C_RW + tid * 4);
            }
            if (tid < 352) {
#pragma unroll
                for (int row = 0; row < 18; ++row) *(f32x4*)(win + row * RPROJ + tid * 4) = wb[row];
            }
        }
        for (int rep_ = 0; rep_ < (MK_PROBE == 3 ? 2 : 1); ++rep_) {
            const int i = tid >> 5, l32 = tid & 31, t = t0 + i;
            float v[8], ug[8]; float sum = 0.f;
#pragma unroll
            for (int j = 0; j < 8; ++j) { const int c = j * 32 + l32; ug[j] = proj[(size_t)t * PLD + c]; v[j] = proj[(size_t)t * PLD + GW + c]; }
#pragma unroll
            for (int j = 0; j < 8; ++j) { const int c = j * 32 + l32; UG[(size_t)t * GW + c] = geluf_(ug[j]); v[j] = geluf_(v[j]); sum += v[j]; }
#pragma unroll
            for (int o = 16; o >= 1; o >>= 1) sum += SHX(sum, o, lane);
            const float mean = sum * (1.0f / GW); float q = 0.f;
#pragma unroll
            for (int j = 0; j < 8; ++j) { const float d = v[j] - mean; q += d * d; }
#pragma unroll
            for (int o = 16; o >= 1; o >>= 1) q += SHX(q, o, lane);
            const float rstd = 1.0f / sqrtf(q * (1.0f / GW) + LN_EPS);
#pragma unroll
            for (int j = 0; j < 8; ++j) { const int c = j * 32 + l32; tvn[c * 16 + i] = (bf16_t)f2bf((v[j] - mean) * rstd * gln_g[c] + gln_b[c]); }
        }
        __syncthreads();
        {
            const int hf = tid & 1, c = tid >> 1;
            *(u32x4*)(VNT + ((size_t)bb * GW + c) * S + s0 + hf * 8) = *(const u32x4*)(tvn + c * 16 + hf * 8);
        }
        for (int idx = tid; idx < 16 * 256; idx += NTHREADS) {
            const int i = idx >> 8, j = idx & 255, rc = 1152 + j;
            const float pv = win[i * RPROJ + rc], cv = win[(i + 1) * RPROJ + rc], nv = win[(i + 2) * RPROJ + rc];
            const float x = cv + mu0[rc] * (pv - cv) + mu1[rc] * (nv - cv);
            lin[i * LIN + j] = (bf16_t)f2bf(j < 64 ? ftanh(x) : (j < 128 ? x : sigmoidf_(x)));
        }
        __syncthreads();
        for (int rep_ = 0; rep_ < (MK_PROBE == 1 ? 2 : 1); ++rep_) {
#pragma unroll 1
            for (int qg = 0; qg < 3; ++qg) {
                bf16x8 bw_[5][4]; float bias_[5];
#pragma unroll
                for (int q5 = 0; q5 < 5; ++q5) {
                    const int nt = wave * 15 + qg * 5 + q5, grp = nt / 24, c = (nt % 24) * 16 + col;
                    const bf16_t* bw = LWT + (size_t)(nt * 16 + col) * 128 + 8 * g;
#pragma unroll
                    for (int ks = 0; ks < 4; ++ks) bw_[q5][ks] = *(const bf16x8*)(bw + ks * 32);
                    bias_[q5] = grp < 2 ? w0[grp * RW + c] : (grp < 4 ? a0[(grp - 2) * RW + c] : 0.f);
                }
#pragma unroll
                for (int q5 = 0; q5 < 5; ++q5) {
                    const int nt = wave * 15 + qg * 5 + q5, grp = nt / 24, c = (nt % 24) * 16 + col;
                    const int kcol = grp < 2 ? 0 : (grp < 4 ? 64 : 128);
                    f32x4 acc = (f32x4){0.f, 0.f, 0.f, 0.f};
#pragma unroll
                    for (int ks = 0; ks < 2; ++ks) acc = MFMA16(*(const bf16x8*)(lin + col * LIN + kcol + ks * 32 + 8 * g), bw_[q5][ks], acc);
                    if (grp == 4) {
#pragma unroll
                        for (int ks = 2; ks < 4; ++ks) acc = MFMA16(*(const bf16x8*)(lin + col * LIN + kcol + ks * 32 + 8 * g), bw_[q5][ks], acc);
                    }
                    if (grp < 2) {
#pragma unroll
                        for (int r = 0; r < 4; ++r) { const float lw = -fexp(-softplusf_(-(acc[r] + bias_[q5])) - 0.5f); const size_t o = (size_t)grp * T * RW + (size_t)(t0 + 4 * g + r) * RW + c; LWG[o] = lw;
#if !MK_RWKV_CHUNKED
                            DEC[o] = expf(lw);
#endif
                        }
                    } else if (grp < 4) {
#pragma unroll
                        for (int r = 0; r < 4; ++r) ICLR[(size_t)(grp - 2) * T * RW + (size_t)(t0 + 4 * g + r) * RW + c] = sigmoidf_(acc[r] + bias_[q5]);
                    } else {
#pragma unroll
                        for (int r = 0; r < 4; ++r) GATE[(size_t)(t0 + 4 * g + r) * RW + c] = acc[r];
                    }
                }
            }
        }
        __syncthreads();
        for (int rep_ = 0; rep_ < (MK_PROBE == 2 ? 2 : 1); ++rep_) if (wave < 6) {
            const int c = tid, h = wave;
            const float kkc = k_k[c], kac = k_a[c], rkc = r_k[c];
            const float m0r = mu0[c], m1r = mu1[c], m0k = mu0[RW + c], m1k = mu1[RW + c], m0v = mu0[2 * RW + c], m1v = mu1[2 * RW + c];
            float ic0[16], ic1[16];
#pragma unroll
            for (int i = 0; i < 16; ++i) { const size_t o = (size_t)(t0 + i) * RW + c; ic0[i] = ICLR[o]; ic1[i] = ICLR[(size_t)T * RW + o]; }
#pragma unroll
            for (int i = 0; i < 16; ++i) {
                const int t = t0 + i;
                const float* w_ = win + i * RPROJ + c;
                const float rp = w_[0], rc_ = w_[RPROJ], rn = w_[2 * RPROJ];
                const float kp = w_[RW], kc_ = w_[RPROJ + RW], kn = w_[2 * RPROJ + RW];
                const float vp = w_[2 * RW], vc_ = w_[RPROJ + 2 * RW], vn = w_[2 * RPROJ + 2 * RW];
                const float r = rc_ + m0r * (rp - rc_) + m1r * (rn - rc_);
                const float k = kc_ + m0k * (kp - kc_) + m1k * (kn - kc_);
                const float v = vc_ + m0v * (vp - vc_) + m1v * (vn - vc_);
                const size_t o = (size_t)t * RW + c;
                const float kq = k * kkc;
                const float n2 = wave_sum_fast(kq * kq, lane);
                const float kk = kq / fmaxf(sqrtf(n2), 1e-12f);
                const float kd0 = k * (1.0f + (ic0[i] - 1.0f) * kac), kd1 = k * (1.0f + (ic1[i] - 1.0f) * kac);
                const float bon = wave_sum_fast(r * (kd0 + kd1) * rkc, lane);
#if MK_RWKV_CHUNKED
                RB[o] = (bf16_t)f2bf(r); VB[o] = (bf16_t)f2bf(v); KKB[o] = (bf16_t)f2bf(kk);
                BBB[o] = (bf16_t)f2bf(kk * ic0[i]); BBB[(size_t)T * RW + o] = (bf16_t)f2bf(kk * ic1[i]);
                KDB[o] = (bf16_t)f2bf(kd0); KDB[(size_t)T * RW + o] = (bf16_t)f2bf(kd1);
#else
                RR[o] = r; VV[o] = v; KK[o] = kk;
                KD[o] = kd0; KD[(size_t)T * RW + o] = kd1;
#endif
                if (lane == 0) BONUS[(size_t)t * RH + h] = bon;
#if !MK_RWKV_CHUNKED
                { const float br0 = wave_sum(kk * ic0[i] * r, lane), br1 = wave_sum(kk * ic1[i] * r, lane), kr0 = wave_sum(kd0 * r, lane), kr1 = wave_sum(kd1 * r, lane);
                  if (lane == 0) { BRKR[((size_t)t * RH + h) * 2] = br0; BRKR[((size_t)t * RH + h) * 2 + 1] = kr0; BRKR[((size_t)(T + t) * RH + h) * 2] = br1; BRKR[((size_t)(T + t) * RH + h) * 2 + 1] = kr1; } }
#endif
            }
        }
        __syncthreads();
        {
            f32x4 wb[9], vb[3];
            const int rsel = tid >= 192 ? 1 : 0, c4 = tid - rsel * 192;
#pragma unroll
            for (int it = 0; it < 9; ++it) {
                const int row = 2 * it + rsel, sq = s0 - 1 + row;
                wb[it] = (f32x4){0.f, 0.f, 0.f, 0.f};
                if (tid < 384 && sq >= 0 && sq < S) wb[it] = *(const f32x4*)(proj + (size_t)(t0 - 1 + row) * PLD + C_MW + c4 * 4);
            }
#pragma unroll
            for (int it = 0; it < 3; ++it) { const int idx = tid + it * NTHREADS, i = idx / 96, cc = (idx % 96) * 4; vb[it] = *(const f32x4*)(proj + (size_t)(t0 + i) * PLD + C_MW + 2 * MW + cc); }
            if (tid < 384) {
#pragma unroll
                for (int it = 0; it < 9; ++it) *(f32x4*)(win + (2 * it + rsel) * 768 + c4 * 4) = wb[it];
            }
#pragma unroll
            for (int it = 0; it < 3; ++it) { const int idx = tid + it * NTHREADS, i = idx / 96, cc = (idx % 96) * 4; const f32x4 v = vb[it];
                tv[(cc + 0) * 16 + i] = (bf16_t)f2bf(v.x); tv[(cc + 1) * 16 + i] = (bf16_t)f2bf(v.y); tv[(cc + 2) * 16 + i] = (bf16_t)f2bf(v.z); tv[(cc + 3) * 16 + i] = (bf16_t)f2bf(v.w); }
        }
        for (int idx = tid; idx < 16 * 24; idx += NTHREADS) {
            const int i = idx / 24, gi = idx % 24, t = t0 + i;
            const int isf = gi / 12, dir = (gi / 6) & 1, h = gi % 6;
            const float gg = proj[(size_t)t * PLD + 3456 + gi] + gate_b[gi];
            if (isf) LF[((size_t)dir * T + t) * MH + h] = -softplusf_(-gg); else IG[((size_t)dir * T + t) * MH + h] = gg;
        }
        __syncthreads();
        for (int rep_ = 0; rep_ < (MK_PROBE == 4 ? 2 : 1); ++rep_)
        for (int idx = tid; idx < 16 * 768; idx += NTHREADS) {
            const int i = idx / 768, c = idx % 768, t = t0 + i;
            const float* w_ = win + i * 768 + c;
            float y = conv_b[c] + w_[0] * conv_w[c] + w_[768] * conv_w[768 + c] + w_[1536] * conv_w[2 * 768 + c];
            y = y * sigmoidf_(y);
            if (c < MW) MQB[(size_t)t * MW + c] = (bf16_t)f2bf(y);
            else { const bf16_t kb = (bf16_t)f2bf(y * 0.125f); MKB[(size_t)t * MW + (c - MW)] = kb; tk[(c - MW) * 16 + i] = kb; }
        }
        __syncthreads();
        for (int idx = tid; idx < 2 * MW * 2; idx += NTHREADS) {
            const int hf = idx & 1, c = (idx >> 1) % MW, which = idx / (2 * MW);
            const u32x4 val = *(const u32x4*)((which ? tv : tk) + c * 16 + hf * 8);
            bf16_t* dst = (which ? VT : KT) + ((size_t)(bb * MH) * 64 + c) * S + s0 + hf * 8;
            *(u32x4*)dst = val;
        }
    }
    __syncthreads();
}

__device__ __forceinline__ void phase_gmlp_mix(const Params& P, int l, unsigned char* smem, int wv, int bid, int nb) {
    PIN_S(bid); PIN_S(nb);
    ParamsPtr pp = PARAMS_PTR(P); PIN_S(pp); unsigned char* ws = pp->ws;
    const float* UG = (const float*)(ws + O_UG); const bf16_t* VNT = (const bf16_t*)(ws + O_VNT); bf16_t* GRP = (bf16_t*)(ws + O_GRP);
    const bf16_t* WSB = (const bf16_t*)(ws + O_WSB) + (size_t)l * GH * CH * CH; const float* gbs = pp->in[5] + (size_t)l * GH * CH;
    const int tid = phase_tid(wv), lane = tid & 63, wave = tid >> 6, col = lane & 15, g = lane >> 4;
    for (int u = bid; u < NB * NCH * GH; u += nb) {
        const int h = u % GH, c = (u / GH) % NCH, b = u / (GH * NCH);
        const int tok0 = b * S + c * CH;
        const bf16_t* wb = WSB + (size_t)h * CH * CH + (size_t)(wave * 16 + col) * CH + 8 * g;
        const bf16_t* vb = VNT + ((size_t)b * GW + h * 64 + col) * S + (size_t)c * CH + 8 * g;
        f32x4 acc[4];
#pragma unroll
        for (int et = 0; et < 4; ++et) acc[et] = (f32x4){0.f, 0.f, 0.f, 0.f};
#pragma unroll
        for (int ks = 0; ks < 4; ++ks) {
            const bf16x8 af = *(const bf16x8*)(wb + ks * 32);
#pragma unroll
            for (int et = 0; et < 4; ++et) acc[et] = MFMA16(af, *(const bf16x8*)(vb + (size_t)et * 16 * S + ks * 32), acc[et]);
        }
#pragma unroll
        for (int r = 0; r < 4; ++r) {
            const int p = wave * 16 + 4 * g + r; const size_t t = (size_t)(tok0 + p); const float bsv = gbs[h * CH + p];
#pragma unroll
            for (int et = 0; et < 4; ++et) { const int ch = h * 64 + et * 16 + col; GRP[t * D + ch] = (bf16_t)f2bf(UG[t * GW + ch] * (acc[et][r] + bsv)); }
        }
    }
}

constexpr int SC_STEPS = 16;
constexpr int SC_BUF = SC_STEPS * 6 * 64;
__device__ __forceinline__ void phase_rwkv_scan(const Params& P, int l, unsigned char* smem, int wv, int bid, int nb) {
    PIN_S(bid); PIN_S(nb);
    ParamsPtr pp = PARAMS_PTR(P); PIN_S(pp); unsigned char* ws = pp->ws;
    const float* RR = (const float*)(ws + O_RR); const float* VV = (const float*)(ws + O_VV); const float* KK = (const float*)(ws + O_KK);
    const float* DEC = (const float*)(ws + O_DEC); const float* KD = (const float*)(ws + O_KD); const float* ICLR = (const float*)(ws + O_ICLR);
    float* SCAN = (float*)(ws + O_SCAN); const float* BRKR = (const float*)(ws + O_BRKR);
    const int tid = phase_tid(wv), lane = tid & 63, wave = tid >> 6, rl = (lane >> 4) & 1, kq = (lane & 15) | ((lane >> 5) << 4);
    float* buf = (float*)smem;
    float* scal = buf + 2 * SC_BUF;
    float* outb = scal + 2 * SC_STEPS * 2;
    typedef float f32x2 __attribute__((ext_vector_type(2)));
    for (int u = bid; u < 2 * NB * RH * 4; u += nb) {
        const int qt = u & 3, h = (u >> 2) % RH, b = (u / (4 * RH)) % NB, d = u / (4 * RH * NB);
        const size_t doff = (size_t)d * T * RW;
        float s0 = 0.f, s1 = 0.f;
        float pw[2], pa[2], pb[2], pk[2], pr[2], pv[2], psc = 0.f;
#define SC_LOAD(c) do { _Pragma("unroll") for (int i = 0; i < 2; ++i) { const int idx = tid + NTHREADS * i, st = idx >> 6, k = idx & 63; const int tau = (c) * SC_STEPS + st, sq = d ? S - 1 - tau : tau; \
            const size_t o = (size_t)(b * S + sq) * RW + h * 64 + k; \
            pw[i] = DEC[doff + o]; pa[i] = KK[o]; pb[i] = ICLR[doff + o]; pk[i] = KD[doff + o]; pr[i] = RR[o]; pv[i] = VV[o]; }     \
            if (tid < 2 * SC_STEPS) { const int tau = (c) * SC_STEPS + (tid >> 1), sq = d ? S - 1 - tau : tau; psc = BRKR[((size_t)(d * T + b * S + sq) * RH + h) * 2 + (tid & 1)]; } } while (0)
#define SC_WRITE(c) do { float* B_ = buf + ((c) & 1) * SC_BUF; _Pragma("unroll") for (int i = 0; i < 2; ++i) { const int idx = tid + NTHREADS * i, st = idx >> 6, k = idx & 63; \
            float* q_ = B_ + st * 384 + k; q_[0] = pw[i]; q_[64] = -pa[i]; q_[128] = pa[i] * pb[i]; q_[192] = pk[i]; q_[256] = pw[i] * pr[i]; q_[320] = pv[i]; } \
            if (tid < 2 * SC_STEPS) scal[((c) & 1) * SC_STEPS * 2 + tid] = psc; } while (0)
        __syncthreads();
        SC_LOAD(0); SC_WRITE(0);
        __syncthreads();
        const int row = qt * 16 + wave * 2 + rl;
        for (int c = 0; c < S / SC_STEPS; ++c) {
            const bool more = (c + 1) < S / SC_STEPS;
            if (more) SC_LOAD(c + 1);
            const float* B = buf + (c & 1) * SC_BUF; const float* sc = scal + (c & 1) * SC_STEPS * 2; float* ob = outb + (c & 1) * SC_STEPS * 16;
            float outs[SC_STEPS];
            f32x2 w2 = *(const f32x2*)(B + 2 * kq), a2 = *(const f32x2*)(B + 64 + 2 * kq), b2 = *(const f32x2*)(B + 128 + 2 * kq);
            f32x2 k2 = *(const f32x2*)(B + 192 + 2 * kq), wr2 = *(const f32x2*)(B + 256 + 2 * kq);
            float v = B[320 + row]; float br = sc[0], kr = sc[1];
#pragma unroll
            for (int st = 0; st < SC_STEPS; ++st) {
                const int sn = st + 1 < SC_STEPS ? st + 1 : st;
                const float* q = B + sn * 384;
                const f32x2 nw2 = *(const f32x2*)(q + 2 * kq), na2 = *(const f32x2*)(q + 64 + 2 * kq), nb2 = *(const f32x2*)(q + 128 + 2 * kq);
                const f32x2 nk2 = *(const f32x2*)(q + 192 + 2 * kq), nwr2 = *(const f32x2*)(q + 256 + 2 * kq);
                const float nv = q[320 + row], nbr = sc[sn * 2], nkr = sc[sn * 2 + 1];
                SCHED_BAR();
                float sa = s0 * a2.x + s1 * a2.y;
                float po = s0 * wr2.x + s1 * wr2.y;
                sa = row32_sum(sa); po = row32_sum(po);
                outs[st] = po + sa * br + v * kr;
                s0 = s0 * w2.x + (sa * b2.x + v * k2.x); s1 = s1 * w2.y + (sa * b2.y + v * k2.y);
                SCHED_BAR();
                w2 = nw2; a2 = na2; b2 = nb2; k2 = nk2; wr2 = nwr2; v = nv; br = nbr; kr = nkr;
            }
            if (kq == 0) {
#pragma unroll
                for (int st = 0; st < SC_STEPS; ++st) ob[st * 16 + wave * 2 + rl] = outs[st];
            }
            if (more) SC_WRITE(c + 1);
            __syncthreads();
            if (tid < 16 * SC_STEPS) {
                const int st = tid >> 4, r = tid & 15, tau = c * SC_STEPS + st, sq = d ? S - 1 - tau : tau;
                SCAN[doff + (size_t)(b * S + sq) * RW + h * 64 + qt * 16 + r] = ob[st * 16 + r];
            }
        }
#undef SC_LOAD
#undef SC_WRITE
    }
    __syncthreads();
}

constexpr int RST = 72;
constexpr int RARR = 64 * RST;
__device__ __forceinline__ f32x4 tile_nt(const bf16_t* Aa, int ta, const bf16_t* Ba, int tb, f32x4 acc, int col, int g) {
#pragma unroll
    for (int ks = 0; ks < 2; ++ks) {
        const bf16x8 af = *(const bf16x8*)(Aa + (ta * 16 + col) * RST + ks * 32 + 8 * g);
        const bf16x8 bfr = *(const bf16x8*)(Ba + (tb * 16 + col) * RST + ks * 32 + 8 * g);
        acc = MFMA16(af, bfr, acc);
    }
    return acc;
}
__device__ __forceinline__ void phase_rwkv_pre(const Params& P, int l, unsigned char* smem, int wv) {
    ParamsPtr pp = PARAMS_PTR(P); PIN_S(pp); unsigned char* ws = pp->ws; int bidx = (int)blockIdx.x, gdim = (int)gridDim.x; PIN_S(bidx); PIN_S(gdim);
    const bf16_t* RB = (const bf16_t*)(ws + O_RB); const bf16_t* VB = (const bf16_t*)(ws + O_VB); const bf16_t* KKB = (const bf16_t*)(ws + O_KKB);
    const float* LWG = (const float*)(ws + O_LW); const bf16_t* KDB = (const bf16_t*)(ws + O_KDB); const bf16_t* BBB = (const bf16_t*)(ws + O_BBB);
    bf16_t* Qg = (bf16_t*)(ws + O_RQ); bf16_t* Ag = (bf16_t*)(ws + O_RA); bf16_t* Hg = (bf16_t*)(ws + O_RH); bf16_t* Gg = (bf16_t*)(ws + O_RG);
    const int tid0 = phase_tid(wv);
#define RW_STAGE_VARS int tid = tid0; PIN_V(tid); const int lane = tid & 63, wave = tid >> 6, col = lane & 15, g = lane >> 4; (void)lane; (void)wave; (void)col; (void)g;
    bf16_t* At = (bf16_t*)smem; bf16_t* Bt = At + RARR; bf16_t* Kt = Bt + RARR; bf16_t* Rt = Kt + RARR;
    bf16_t* BtT = Rt + RARR; bf16_t* KtT = BtT + RARR; bf16_t* VT = KtT + RARR;
    bf16_t* Lak = VT + RARR; bf16_t* Mrb = Lak + RARR; bf16_t* Mrk = Mrb + RARR; bf16_t* YT = Mrk + RARR; bf16_t* W2T = YT + RARR;
    bf16_t* Lbo = W2T + RARR;
    float* LabT = (float*)(Lbo + RARR);
    float* Xs = LabT + 4096;
    float* Pb = Xs + 4096;
    float* segs = Pb + 2048;
    float* PC = segs + 512;
    float plw[8]; unsigned pkk[8], pbq[8], pkd[8], prr[8], pvv[8];
#define RW_LOAD(uu) do { const int c_ = (uu) % RNC, h_ = ((uu) / RNC) % RH, b_ = ((uu) / (RNC * RH)) % NB, d_ = (uu) / (RNC * RH * NB); const size_t doff_ = (size_t)d_ * T * RW; \
        const int ch_ = tid0 & 63, sg_ = tid0 >> 6; _Pragma("unroll") for (int j = 0; j < 8; ++j) { const int tau = c_ * RC + sg_ * 8 + j, sq = d_ ? S - 1 - tau : tau; const size_t o = (size_t)(b_ * S + sq) * RW + h_ * 64 + ch_; \
        plw[j] = LWG[doff_ + o]; pkk[j] = KKB[o]; pbq[j] = BBB[doff_ + o]; pkd[j] = KDB[doff_ + o]; prr[j] = RB[o]; pvv[j] = VB[o]; } } while (0)
    if (bidx < RUN) RW_LOAD(bidx);
    for (int u = bidx; u < RUN; u += gdim) {
        const int c = u % RNC, h = (u / RNC) % RH, b = (u / (RNC * RH)) % NB, d = u / (RNC * RH * NB);
        (void)c; (void)h; (void)b; (void)d;
        __syncthreads();
        {
            RW_STAGE_VARS
            const int ch = tid & 63, sg = tid >> 6;
            float lw[8]; unsigned kk[8], bq_[8], kd[8], rr[8], vv[8];
#pragma unroll
            for (int j = 0; j < 8; ++j) { lw[j] = plw[j]; kk[j] = pkk[j]; bq_[j] = pbq[j]; kd[j] = pkd[j]; rr[j] = prr[j]; vv[j] = pvv[j]; }
            if (u + gdim < RUN) RW_LOAD(u + gdim);
            float run = 0.f;
#pragma unroll
            for (int j = 0; j < 8; ++j) { run += lw[j]; lw[j] = run; }
            segs[sg * 64 + ch] = run;
            __syncthreads();
            float off = 0.f;
            for (int q = 0; q < sg; ++q) off += segs[q * 64 + ch];
            u32x4 pbt, pkt, pvt; unsigned tb[8], tk[8], tvv[8];
            float prev = off;
#pragma unroll
            for (int j = 0; j < 8; ++j) {
                const int t = sg * 8 + j; const float cl = off + lw[j];
                const float ep = fexp(prev), en = fexp(-cl), epc = fexp(cl);
                const unsigned a_ = f2bf(-bf_lo(kk[j]) * ep), b_ = f2bf(bf_lo(bq_[j]) * en), k_ = f2bf(bf_lo(kd[j]) * en), r_ = f2bf(bf_lo(rr[j]) * epc), v_ = vv[j];
                At[t * RST + ch] = (bf16_t)a_; Bt[t * RST + ch] = (bf16_t)b_; Kt[t * RST + ch] = (bf16_t)k_; Rt[t * RST + ch] = (bf16_t)r_;
                tb[j] = b_; tk[j] = k_; tvv[j] = v_;
                prev = cl;
            }
            if (sg == 7) PC[ch] = fexp(prev);
            pbt.x = tb[0] | (tb[1] << 16); pbt.y = tb[2] | (tb[3] << 16); pbt.z = tb[4] | (tb[5] << 16); pbt.w = tb[6] | (tb[7] << 16);
            pkt.x = tk[0] | (tk[1] << 16); pkt.y = tk[2] | (tk[3] << 16); pkt.z = tk[4] | (tk[5] << 16); pkt.w = tk[6] | (tk[7] << 16);
            pvt.x = tvv[0] | (tvv[1] << 16); pvt.y = tvv[2] | (tvv[3] << 16); pvt.z = tvv[4] | (tvv[5] << 16); pvt.w = tvv[6] | (tvv[7] << 16);
            *(u32x4*)(BtT + ch * RST + sg * 8) = pbt; *(u32x4*)(KtT + ch * RST + sg * 8) = pkt; *(u32x4*)(VT + ch * RST + sg * 8) = pvt;
            for (int z_ = tid; z_ < 2 * RARR / 8; z_ += NTHREADS) ((u32x4*)YT)[z_] = (u32x4){0u, 0u, 0u, 0u};
        }
        __syncthreads();
        {
            RW_STAGE_VARS
            const int m = wave >> 1;
            const bf16_t* Ym = (m == 0 || m == 2) ? Bt : Kt; const bf16_t* Xm = (m < 2) ? At : Rt;
#pragma unroll 1
            for (int q = 0; q < 8; ++q) {
                const int tix = (wave & 1) * 8 + q, it = tix >> 2, tt = tix & 3;
                f32x4 acc = (f32x4){0.f, 0.f, 0.f, 0.f};
                if (it <= tt) acc = tile_nt(Ym, it, Xm, tt, acc, col, g);
                const int t = tt * 16 + col, i0 = it * 16 + 4 * g;
                float o4[4];
#pragma unroll
                for (int r = 0; r < 4; ++r) { const int i = i0 + r; const bool ok = m < 2 ? (i < t) : (i <= t); o4[r] = ok ? acc[r] : 0.f; }
                if (m == 0) {
#pragma unroll
                    for (int r = 0; r < 4; ++r) LabT[(i0 + r) * 64 + t] = o4[r];
                    const bool offd = it < tt;
                    u32x2 w2; w2.x = offd ? pk2(o4[0], o4[1]) : 0u; w2.y = offd ? pk2(o4[2], o4[3]) : 0u; *(u32x2*)(Lbo + t * RST + i0) = w2;
                }
                else { bf16_t* dst = (m == 1 ? Lak : (m == 2 ? Mrb : Mrk)) + t * RST + i0; u32x2 w2; w2.x = pk2(o4[0], o4[1]); w2.y = pk2(o4[2], o4[3]); *(u32x2*)dst = w2; }
            }
        }
        __syncthreads();
        {
            RW_STAGE_VARS
#pragma unroll
            for (int q = 0; q < 2; ++q) {
                const int tix = wave * 2 + q, tt = tix >> 2, et = tix & 3;
                f32x4 acc = (f32x4){0.f, 0.f, 0.f, 0.f};
                acc = tile_nt(Lak, tt, VT, et, acc, col, g);
#pragma unroll
                for (int r = 0; r < 4; ++r) Xs[(tt * 16 + 4 * g + r) * 64 + et * 16 + col] = acc[r];
            }
        }
        __syncthreads();
        {
            RW_STAGE_VARS
#pragma unroll 1
            for (int bb = 0; bb < 4; ++bb) {
                if (bb > 0) {
                    const bf16_t* Zt = (wave < 4 ? YT : W2T) + ((wave & 3) * 16 + col) * RST + 8 * g;
                    const bf16_t* La = Lbo + (16 * bb + col) * RST + 8 * g;
                    f32x4 acc = (f32x4){0.f, 0.f, 0.f, 0.f};
                    acc = MFMA16(*(const bf16x8*)La, *(const bf16x8*)Zt, acc);
                    if (bb > 2) acc = MFMA16(*(const bf16x8*)(La + 32), *(const bf16x8*)(Zt + 32), acc);
#pragma unroll
                    for (int r = 0; r < 4; ++r) Pb[(4 * g + r) * 128 + wave * 16 + col] = acc[r];
                }
                __syncthreads();
                if (wave < 2) {
                    float acc[16];
                    if (wave == 0) {
#pragma unroll
                        for (int r = 0; r < 16; ++r) acc[r] = bf_lo((unsigned)At[(16 * bb + r) * RST + lane]);
                    } else {
#pragma unroll
                        for (int r = 0; r < 16; ++r) acc[r] = Xs[(16 * bb + r) * 64 + lane];
                    }
                    if (bb > 0) {
#pragma unroll
                        for (int r = 0; r < 16; ++r) acc[r] += Pb[r * 128 + wave * 64 + lane];
                    }
                    const float* dp = LabT + (16 * bb) * 64 + 16 * bb;
#pragma unroll
                    for (int r = 1; r < 16; ++r)
#pragma unroll
                        for (int r2 = 0; r2 < r; ++r2) acc[r] += dp[r2 * 64 + r] * acc[r2];
                    bf16_t* dst = (wave == 0 ? YT : W2T) + lane * RST;
                    u32x4 w0, w1;
                    w0.x = pk2(acc[0], acc[1]); w0.y = pk2(acc[2], acc[3]); w0.z = pk2(acc[4], acc[5]); w0.w = pk2(acc[6], acc[7]);
                    w1.x = pk2(acc[8], acc[9]); w1.y = pk2(acc[10], acc[11]); w1.z = pk2(acc[12], acc[13]); w1.w = pk2(acc[14], acc[15]);
                    *(u32x4*)(dst + 16 * bb) = w0; *(u32x4*)(dst + 16 * bb + 8) = w1;
                }
                __syncthreads();
            }
        }
        __syncthreads();
        {
            RW_STAGE_VARS
            const int ty = wave >> 1;
#pragma unroll 1
            for (int q = 0; q < 8; ++q) {
                const int tix = (wave & 1) * 8 + q, ra = tix >> 2, cb = tix & 3;
                f32x4 acc = (f32x4){0.f, 0.f, 0.f, 0.f};
                if (ty == 0) {
                    acc = tile_nt(Mrb, ra, YT, cb, acc, col, g);
#pragma unroll
                    for (int r = 0; r < 4; ++r) { const int t = ra * 16 + 4 * g + r, k = cb * 16 + col; Qg[(size_t)u * 4096 + t * 64 + k] = (bf16_t)f2bf(acc[r] + bf_lo((unsigned)Rt[t * RST + k])); }
                } else if (ty == 1) {
                    acc = tile_nt(Mrb, ra, W2T, cb, acc, col, g); acc = tile_nt(Mrk, ra, VT, cb, acc, col, g);
                    { u32x2 hb; hb.x = pk2(acc[0], acc[1]); hb.y = pk2(acc[2], acc[3]); *(u32x2*)(Hg + (size_t)u * 4096 + (tix * 64 + lane) * 4) = hb; }
                } else if (ty == 2) {
                    acc = tile_nt(BtT, ra, YT, cb, acc, col, g);
#pragma unroll
                    for (int r = 0; r < 4; ++r) { const int k1 = ra * 16 + 4 * g + r, k = cb * 16 + col; Ag[(size_t)u * 4096 + k1 * 64 + k] = (bf16_t)f2bf(PC[k1] * (acc[r] + (k1 == k ? 1.0f : 0.f))); }
                } else {
                    acc = tile_nt(BtT, ra, W2T, cb, acc, col, g); acc = tile_nt(KtT, ra, VT, cb, acc, col, g);
#pragma unroll
                    for (int r = 0; r < 4; ++r) acc[r] *= PC[ra * 16 + 4 * g + r];
                    { u32x2 gb2; gb2.x = pk2(acc[0], acc[1]); gb2.y = pk2(acc[2], acc[3]); *(u32x2*)(Gg + (size_t)u * 4096 + (tix * 64 + lane) * 4) = gb2; }
                }
            }
        }
    }
    __syncthreads();
#undef RW_STAGE_VARS
#undef RW_LOAD
}
__device__ __forceinline__ void phase_rwkv_seq(const Params& P, int l, unsigned char* smem, int wv) {
    ParamsPtr pp = PARAMS_PTR(P); PIN_S(pp); unsigned char* ws = pp->ws; int bidx = (int)blockIdx.x, gdim = (int)gridDim.x; PIN_S(bidx); PIN_S(gdim);
    const bf16_t* Ag = (const bf16_t*)(ws + O_RA); const bf16_t* Gg = (const bf16_t*)(ws + O_RG); bf16_t* Sg = (bf16_t*)(ws + O_RS);
    const int tid = phase_tid(wv), lane = tid & 63, wave = tid >> 6, col = lane & 15, g = lane >> 4;
    const int gw = wave * gdim + bidx, ngw = NWAVES * gdim;
    for (int un = gw; un < 2 * NB * RH * 2; un += ngw) {
        const int ch = un >> 1, eh = un & 1;
        f32x4 acc[4][2];
#pragma unroll
        for (int a_ = 0; a_ < 4; ++a_)
#pragma unroll
            for (int b_ = 0; b_ < 2; ++b_) acc[a_][b_] = (f32x4){0.f, 0.f, 0.f, 0.f};
        u32x2 alo[4][2], ahi[4][2]; u32x2 gq[4][2];
        const unsigned aoff = (unsigned)(col * 64 + 4 * g), goff = (unsigned)(lane * 4);
#define RS_LOAD(cc) do { const bf16_t* ab_ = Ag + (size_t)(ch * RNC + (cc)) * 4096; const bf16_t* gb_ = Gg + (size_t)(ch * RNC + (cc)) * 4096 + eh * 512; \
            _Pragma("unroll") for (int ra = 0; ra < 4; ++ra) _Pragma("unroll") for (int p = 0; p < 2; ++p) { alo[ra][p] = *(const u32x2*)(ab_ + (ra * 1024 + p * 32) + aoff); ahi[ra][p] = *(const u32x2*)(ab_ + (ra * 1024 + p * 32 + 16) + aoff); } \
            _Pragma("unroll") for (int ra = 0; ra < 4; ++ra) _Pragma("unroll") for (int cb = 0; cb < 2; ++cb) gq[ra][cb] = *(const u32x2*)(gb_ + ((ra * 4 + cb) * 256) + goff); } while (0)
        RS_LOAD(0);
#pragma unroll 1
        for (int c = 0; c < RNC; ++c) {
            bf16_t* sb_ = Sg + (size_t)(ch * RNC + c) * 4096 + eh * 2048;
            bf16x8 bq[2][2];
#pragma unroll
            for (int cb = 0; cb < 2; ++cb) {
#pragma unroll
                for (int ra = 0; ra < 4; ++ra) {
                    u32x2 w2; w2.x = pk2(acc[ra][cb][0], acc[ra][cb][1]); w2.y = pk2(acc[ra][cb][2], acc[ra][cb][3]);
                    *(u32x2*)(sb_ + (cb * 1024 + ra * 16) + aoff) = w2;
                }
#pragma unroll
                for (int p = 0; p < 2; ++p) bq[p][cb] = cvt8(acc[2 * p][cb], acc[2 * p + 1][cb]);
            }
            u32x4 af[4][2];
#pragma unroll
            for (int ra = 0; ra < 4; ++ra) {
#pragma unroll
                for (int p = 0; p < 2; ++p) af[ra][p] = (u32x4){alo[ra][p].x, alo[ra][p].y, ahi[ra][p].x, ahi[ra][p].y};
#pragma unroll
                for (int cb = 0; cb < 2; ++cb) acc[ra][cb] = (f32x4){bf_lo(gq[ra][cb].x), bf_hi(gq[ra][cb].x), bf_lo(gq[ra][cb].y), bf_hi(gq[ra][cb].y)};
            }
            if (c + 1 < RNC) RS_LOAD(c + 1);
#pragma unroll
            for (int ra = 0; ra < 4; ++ra)
#pragma unroll
                for (int cb = 0; cb < 2; ++cb)
#pragma unroll
                    for (int p = 0; p < 2; ++p) acc[ra][cb] = MFMA16(__builtin_bit_cast(bf16x8, af[ra][p]), bq[p][cb], acc[ra][cb]);
        }
#undef RS_LOAD
    }
}
__device__ __forceinline__ void phase_rwkv_out(const Params& P, int l, unsigned char* smem, int wv) {
    ParamsPtr pp = PARAMS_PTR(P); PIN_S(pp); unsigned char* ws = pp->ws; int bidx = (int)blockIdx.x, gdim = (int)gridDim.x; PIN_S(bidx); PIN_S(gdim);
    const bf16_t* Qg = (const bf16_t*)(ws + O_RQ); const bf16_t* Sg = (const bf16_t*)(ws + O_RS); const bf16_t* Hg = (const bf16_t*)(ws + O_RH);
    const bf16_t* VB = (const bf16_t*)(ws + O_VB); const float* GATE = (const float*)(ws + O_GATE); const float* BONUS = (const float*)(ws + O_BONUS);
    bf16_t* GRP = (bf16_t*)(ws + O_GRP);
    const float* rln_g = pp->in[15] + (size_t)l * RW; const float* rln_b = pp->in[16] + (size_t)l * RW;
    const int tid = phase_tid(wv), lane = tid & 63, wave = tid >> 6, col = lane & 15, g = lane >> 4;
    for (int pu = bidx * NWAVES + wave; pu < NB * RH * RNC; pu += gdim * NWAVES) {
        const int c = pu % RNC, h = (pu / RNC) % RH, b = pu / (RNC * RH);
        f32x4 o[2][4][4];
#pragma unroll
        for (int d = 0; d < 2; ++d) {
            const int u = ((d * NB + b) * RH + h) * RNC + (d ? RNC - 1 - c : c);
            const size_t ub = (size_t)u * 4096;
            bf16x8 qa[4][2], sb[4][2];
#pragma unroll
            for (int q = 0; q < 4; ++q)
#pragma unroll
                for (int ks = 0; ks < 2; ++ks) { qa[q][ks] = *(const bf16x8*)(Qg + ub + (q * 16 + col) * 64 + ks * 32 + 8 * g); sb[q][ks] = *(const bf16x8*)(Sg + ub + (q * 16 + col) * 64 + ks * 32 + 8 * g); }
#pragma unroll
            for (int tt = 0; tt < 4; ++tt)
#pragma unroll
                for (int et = 0; et < 4; ++et) {
                    const u32x2 hb = *(const u32x2*)(Hg + ub + ((tt * 4 + et) * 64 + lane) * 4);
                    f32x4 acc = (f32x4){bf_lo(hb.x), bf_hi(hb.x), bf_lo(hb.y), bf_hi(hb.y)};
#pragma unroll
                    for (int ks = 0; ks < 2; ++ks) acc = MFMA16(qa[tt][ks], sb[et][ks], acc);
                    o[d][tt][et] = acc;
                }
        }
        const int src = (3 - g) * 16 + col;
#pragma unroll
        for (int tt = 0; tt < 4; ++tt)
#pragma unroll
            for (int et = 0; et < 4; ++et)
#pragma unroll
                for (int r = 0; r < 4; ++r) o[0][tt][et][r] += SHL(o[1][3 - tt][et][3 - r], src);
        float* tile = (float*)smem + wave * (64 * 68);
        WAVE_SYNC();
#pragma unroll
        for (int tt = 0; tt < 4; ++tt)
#pragma unroll
            for (int et = 0; et < 4; ++et)
#pragma unroll
                for (int r = 0; r < 4; ++r) tile[(tt * 16 + 4 * g + r) * 68 + et * 16 + col] = o[0][tt][et][r];
        WAVE_SYNC();
        {
            const int c4 = (lane & 15) * 4, ch = h * 64 + c4;
            const f32x4 lg = *(const f32x4*)(rln_g + ch), lb = *(const f32x4*)(rln_b + ch);
#pragma unroll 1
            for (int qb = 0; qb < 2; ++qb) {
                f32x4 gt_[8]; u32x2 vb_[8]; float bo_[8];
#pragma unroll
                for (int q8 = 0; q8 < 8; ++q8) {
                    const size_t t = (size_t)(b * S + c * RC + (qb * 8 + q8) * 4 + (lane >> 4));
                    gt_[q8] = *(const f32x4*)(GATE + t * RW + ch); vb_[q8] = *(const u32x2*)(VB + t * RW + ch); bo_[q8] = BONUS[t * RH + h];
                }
#pragma unroll
                for (int q8 = 0; q8 < 8; ++q8) {
                    const int tl = (qb * 8 + q8) * 4 + (lane >> 4);
                    const size_t t = (size_t)(b * S + c * RC + tl);
                    const f32x4 x = *(const f32x4*)(tile + tl * 68 + c4);
                    const float mean = row16_sum((x.x + x.y) + (x.z + x.w)) * (1.0f / 64.0f);
                    const f32x4 dl = x - mean;
                    const float var = row16_sum((dl.x * dl.x + dl.y * dl.y) + (dl.z * dl.z + dl.w * dl.w)) * (1.0f / 64.0f);
                    const float rstd = 1.0f / sqrtf(var + GN_EPS);
                    f32x4 y = dl * rstd * lg + lb;
                    y.x += bo_[q8] * bf_lo(vb_[q8].x); y.y += bo_[q8] * bf_hi(vb_[q8].x); y.z += bo_[q8] * bf_lo(vb_[q8].y); y.w += bo_[q8] * bf_hi(vb_[q8].y);
                    y = y * gt_[q8];
                    u32x2 ob; ob.x = pk2(y.x, y.y); ob.y = pk2(y.z, y.w);
                    *(u32x2*)(GRP + t * D + GW + ch) = ob;
                }
            }
        }
    }
    __syncthreads();
}

__device__ __forceinline__ void phase_mlstm_local(const Params& P, int l, unsigned char* smem, int wv, int bid, int nb) {
    PIN_S(bid); PIN_S(nb);
    ParamsPtr pp = PARAMS_PTR(P); PIN_S(pp); unsigned char* ws = pp->ws;
    const bf16_t* KT = (const bf16_t*)(ws + O_KT); const bf16_t* VT = (const bf16_t*)(ws + O_VT);
    const float* IG = (const float*)(ws + O_IG); const float* LF = (const float*)(ws + O_LF);
    float* CL = (float*)(ws + O_CL); float* NLb = (float*)(ws + O_NL); float* ML = (float*)(ws + O_ML); float* BL = (float*)(ws + O_BL);
    float* GVT = (float*)(ws + O_GVT); float* PMX = (float*)(ws + O_PMX); float* BCT = (float*)(ws + O_BCT);
    const int tid = phase_tid(wv), lane = tid & 63, wave = tid >> 6, col = lane & 15, g = lane >> 4;
    float* wts = (float*)smem + wave * 128;
    for (int u = bid * NWAVES + wave; u < 2 * NB * MH * NCH; u += nb * NWAVES) {
        const int c = u % NCH, h = (u / NCH) % MH, p = u / (NCH * MH), d = p / NB, b = p % NB;
        const int tc = d ? NCH - 1 - c : c, tok0 = b * S + tc * CH;
        const int i0 = d ? 127 - 2 * lane : 2 * lane, i1 = d ? i0 - 1 : i0 + 1;
        const size_t g0 = ((size_t)d * T + tok0 + i0) * MH + h, g1 = ((size_t)d * T + tok0 + i1) * MH + h;
        const float lf0 = LF[g0], lf1 = LF[g1], ig0 = IG[g0], ig1 = IG[g1];
        const float c1 = lf0 + lf1;
        float incl = c1;
#pragma unroll
        for (int o = 1; o < 64; o <<= 1) { const float tq = SHUP(incl, o, lane); if (lane >= o) incl += tq; }
        const float excl = incl - c1, bc0 = excl + lf0, bc1 = incl;
        const float blast = RDL(incl, 63);
        const float gv0 = ig0 - bc0, gv1 = ig1 - bc1, pl1 = fmaxf(gv0, gv1);
        float mincl = pl1;
#pragma unroll
        for (int o = 1; o < 64; o <<= 1) { const float tq = SHUP(mincl, o, lane); if (lane >= o) mincl = fmaxf(mincl, tq); }
        float mexcl = SHUP(mincl, 1, lane); if (lane == 0) mexcl = -INFINITY;
        const float pm0 = fmaxf(mexcl, gv0), pm1 = mincl;
        const float mloc = blast + RDL(mincl, 63);
        WAVE_SYNC();
        wts[i0] = fexp(blast + gv0 - mloc); wts[i1] = fexp(blast + gv1 - mloc);
        GVT[g0] = gv0; GVT[g1] = gv1; PMX[g0] = pm0; PMX[g1] = pm1; BCT[g0] = bc0; BCT[g1] = bc1;
        if (lane == 0) { ML[u] = mloc; BL[u] = blast; }
        WAVE_SYNC();
        const bf16_t* vbase = VT + ((size_t)(b * MH + h) * 64) * S + (size_t)tc * CH;
        const bf16_t* kbase = KT + ((size_t)(b * MH + h) * 64) * S + (size_t)tc * CH;
        const unsigned loff = (unsigned)(col * S + 8 * g);
        f32x4 acc[4][4];
#pragma unroll
        for (int a_ = 0; a_ < 4; ++a_)
#pragma unroll
            for (int b_ = 0; b_ < 4; ++b_) acc[a_][b_] = (f32x4){0.f, 0.f, 0.f, 0.f};
        float nsum[4] = {0.f, 0.f, 0.f, 0.f};
#pragma unroll 1
        for (int ks = 0; ks < 4; ++ks) {
            const int ii = ks * 32 + 8 * g;
            const f32x4 w0 = *(const f32x4*)(wts + ii), w1 = *(const f32x4*)(wts + ii + 4);
            bf16x8 af[4], bfk[4];
#pragma unroll
            for (int q = 0; q < 4; ++q) af[q] = *(const bf16x8*)(vbase + ((size_t)q * 16 * S + ks * 32) + loff);
#pragma unroll
            for (int q = 0; q < 4; ++q) {
                const u32x4 kr = *(const u32x4*)(kbase + ((size_t)q * 16 * S + ks * 32) + loff);
                f32x4 k0, k1;
                k0.x = bf_lo(kr.x) * w0.x; k0.y = bf_hi(kr.x) * w0.y; k0.z = bf_lo(kr.y) * w0.z; k0.w = bf_hi(kr.y) * w0.w;
                k1.x = bf_lo(kr.z) * w1.x; k1.y = bf_hi(kr.z) * w1.y; k1.z = bf_lo(kr.w) * w1.z; k1.w = bf_hi(kr.w) * w1.w;
                nsum[q] += (k0.x + k0.y) + (k0.z + k0.w) + (k1.x + k1.y) + (k1.z + k1.w);
                bfk[q] = cvt8(k0, k1);
            }
#pragma unroll
            for (int a_ = 0; a_ < 4; ++a_)
#pragma unroll
                for (int b_ = 0; b_ < 4; ++b_) acc[a_][b_] = MFMA16(af[a_], bfk[b_], acc[a_][b_]);
        }
        float* cbase = CL + (size_t)u * 4096;
        const unsigned coff = (unsigned)(4 * g * 64 + col);
#pragma unroll
        for (int b_ = 0; b_ < 4; ++b_) {
#pragma unroll
            for (int a_ = 0; a_ < 4; ++a_)
#pragma unroll
                for (int r = 0; r < 4; ++r) cbase[(a_ * 16 * 64 + r * 64 + b_ * 16) + coff] = acc[a_][b_][r];
            float ns = nsum[b_]; ns += SHX(ns, 16, lane); ns += SHX(ns, 32, lane);
            if (g == 0) NLb[(size_t)u * 64 + b_ * 16 + col] = ns;
        }
    }
    __syncthreads();
}

__device__ __forceinline__ void phase_mlstm_carry(const Params& P, int l, unsigned char* smem, int wv) {
    ParamsPtr pp = PARAMS_PTR(P); PIN_S(pp); unsigned char* ws = pp->ws; int bidx = (int)blockIdx.x, gdim = (int)gridDim.x; PIN_S(bidx); PIN_S(gdim);
    float* CL = (float*)(ws + O_CL); float* NLb = (float*)(ws + O_NL); const float* ML = (const float*)(ws + O_ML); const float* BL = (const float*)(ws + O_BL);
    float* MIN = (float*)(ws + O_MIN);
    const int total = 2 * NB * MH * 4160;
    const int tid = phase_tid(wv);
    for (int g = bidx * NTHREADS + tid; g < total; g += gdim * NTHREADS) {
        const int ph = g / 4160, e = g % 4160;
        float m = 0.f, val = 0.f;
        for (int c = 0; c < NCH; ++c) {
            const int base = ph * NCH + c;
            float* ptr = e < 4096 ? CL + (size_t)base * 4096 + e : NLb + (size_t)base * 64 + (e - 4096);
            const float loc = *ptr;
            *ptr = val;
            if (e == 0) MIN[base] = m;
            const float bl = BL[base], ml = ML[base];
            const float mn = fmaxf(bl + m, ml);
            val = expf(bl + m - mn) * val + expf(ml - mn) * loc;
            m = mn;
        }
    }
}

__device__ __forceinline__ void phase_mlstm_out(const Params& P, int l, unsigned char* smem, int wv) {
    ParamsPtr pp = PARAMS_PTR(P); PIN_S(pp); unsigned char* ws = pp->ws; int bidx = (int)blockIdx.x, gdim = (int)gridDim.x; PIN_S(bidx); PIN_S(gdim);
    const float* proj = (const float*)(ws + O_PROJ);
    const bf16_t* MQB = (const bf16_t*)(ws + O_MQB); const bf16_t* MKB = (const bf16_t*)(ws + O_MKB); const bf16_t* VT = (const bf16_t*)(ws + O_VT);
    const float* GVT = (const float*)(ws + O_GVT); const float* PMX = (const float*)(ws + O_PMX); const float* BCT = (const float*)(ws + O_BCT);
    const float* CL = (const float*)(ws + O_CL); const float* NLb = (const float*)(ws + O_NL); const float* MIN = (const float*)(ws + O_MIN);
    bf16_t* GRP = (bf16_t*)(ws + O_GRP);
    const float* mln_g = pp->in[20] + (size_t)l * MW;
    const int tid = phase_tid(wv), lane = tid & 63, wave = tid >> 6, col = lane & 15, g = lane >> 4;
    constexpr int KP = 72, VP = 136;
    bf16_t* Ks = (bf16_t*)smem;
    bf16_t* Vs = Ks + 128 * KP;
    float* gvs_ = (float*)(Vs + 64 * VP);
    for (int u = bidx; u < NB * MH * NCH; u += gdim) {
        const int tc = u % NCH, h = (u / NCH) % MH, b = u / (NCH * MH);
        const int tok0 = b * S + tc * CH, it = wave * 16 + col;
        __syncthreads();
        {
            u32x4 kb_[2], vb_[2];
#pragma unroll
            for (int q = 0; q < 2; ++q) {
                const int idx = tid + q * NTHREADS;
                kb_[q] = *(const u32x4*)(MKB + (size_t)(tok0 + (idx >> 3)) * MW + h * 64 + (idx & 7) * 8);
                vb_[q] = *(const u32x4*)(VT + ((size_t)(b * MH + h) * 64 + (idx >> 4)) * S + (size_t)tc * CH + (idx & 15) * 8);
            }
            float gq_ = 0.f;
            if (tid < 256) gq_ = GVT[((size_t)(tid >> 7) * T + tok0 + (tid & 127)) * MH + h];
#pragma unroll
            for (int q = 0; q < 2; ++q) {
                const int idx = tid + q * NTHREADS;
                *(u32x4*)(Ks + (idx >> 3) * KP + (idx & 7) * 8) = kb_[q];
                *(u32x4*)(Vs + (idx >> 4) * VP + (idx & 15) * 8) = vb_[q];
            }
            if (tid < 256) gvs_[tid] = gq_;
        }
        __syncthreads();
        const size_t trow = (size_t)(tok0 + it);
        bf16x8 bq[2];
#pragma unroll
        for (int ks = 0; ks < 2; ++ks) bq[ks] = *(const bf16x8*)(MQB + trow * MW + h * 64 + ks * 32 + 8 * g);
        f32x4 hs[4];
#pragma unroll
        for (int et = 0; et < 4; ++et) hs[et] = (f32x4){0.f, 0.f, 0.f, 0.f};
#pragma unroll
        for (int d = 0; d < 2; ++d) {
            const int cd = d ? NCH - 1 - tc : tc;
            const int su = ((d * NB + b) * MH + h) * NCH + cd;
            const size_t gt = ((size_t)d * T + trow) * MH + h;
            const float mst = MIN[su];
            const float mxt = fmaxf(PMX[gt], mst), mt = BCT[gt] + mxt, wint = fexp(mst - mxt);
            f32x4 num[4];
#pragma unroll
            for (int et = 0; et < 4; ++et) num[et] = (f32x4){0.f, 0.f, 0.f, 0.f};
            float den = 0.f;
            for (int sp = 0; sp < 4; ++sp) {
                if (d == 0 ? (2 * sp > wave) : (2 * sp + 1 < wave)) continue;
                float pw[8];
#pragma unroll
                for (int hf = 0; hf < 2; ++hf) {
                    const int st = 2 * sp + hf;
                    f32x4 sacc = (f32x4){0.f, 0.f, 0.f, 0.f};
#pragma unroll
                    for (int ks = 0; ks < 2; ++ks) sacc = MFMA16(*(const bf16x8*)(Ks + (st * 16 + col) * KP + ks * 32 + 8 * g), bq[ks], sacc);
                    const f32x4 g4 = *(const f32x4*)(gvs_ + d * 128 + st * 16 + 4 * g);
#pragma unroll
                    for (int r = 0; r < 4; ++r) {
                        const int is = st * 16 + 4 * g + r;
                        const bool ok = d == 0 ? (is <= it) : (is >= it);
                        const float pr = ok ? sacc[r] * fexp(g4[r] - mxt) : 0.f;
                        den += pr; pw[hf * 4 + r] = pr;
                    }
                }
                u32x4 pb; pb.x = pk2(pw[0], pw[1]); pb.y = pk2(pw[2], pw[3]); pb.z = pk2(pw[4], pw[5]); pb.w = pk2(pw[6], pw[7]);
                const bf16x8 bp = __builtin_bit_cast(bf16x8, pb);
#pragma unroll
                for (int et = 0; et < 4; ++et) {
                    const bf16_t* vp = Vs + (et * 16 + col) * VP + sp * 32 + 4 * g;
                    const u32x2 v0 = *(const u32x2*)vp, v1 = *(const u32x2*)(vp + 16);
                    u32x4 va; va.x = v0.x; va.y = v0.y; va.z = v1.x; va.w = v1.y;
                    num[et] = MFMA16(__builtin_bit_cast(bf16x8, va), bp, num[et]);
                }
            }
            den += SHX(den, 16, lane); den += SHX(den, 32, lane);
            f32x4 qc[4]; float qn = 0.f;
#pragma unroll
            for (int ks = 0; ks < 2; ++ks) {
                const float* np = NLb + (size_t)su * 64 + ks * 32 + 8 * g;
                const f32x4 n0 = *(const f32x4*)np, n1 = *(const f32x4*)(np + 4);
                const u32x4 qb = __builtin_bit_cast(u32x4, bq[ks]);
                qn += (bf_lo(qb.x) * n0.x + bf_hi(qb.x) * n0.y) + (bf_lo(qb.y) * n0.z + bf_hi(qb.y) * n0.w) + (bf_lo(qb.z) * n1.x + bf_hi(qb.z) * n1.y) + (bf_lo(qb.w) * n1.z + bf_hi(qb.w) * n1.w);
            }
            qn += SHX(qn, 16, lane); qn += SHX(qn, 32, lane);
#pragma unroll
            for (int et = 0; et < 4; ++et) {
                qc[et] = (f32x4){0.f, 0.f, 0.f, 0.f};
#pragma unroll
                for (int ks = 0; ks < 2; ++ks) {
                    const float* cp = CL + (size_t)su * 4096 + (size_t)(et * 16 + col) * 64 + ks * 32 + 8 * g;
                    qc[et] = MFMA16(cvt8(*(const f32x4*)cp, *(const f32x4*)(cp + 4)), bq[ks], qc[et]);
                }
            }
            const float dd = frcp(fmaxf(fabsf(den + wint * qn), fexp(-mt)));
#pragma unroll
            for (int et = 0; et < 4; ++et) hs[et] += (num[et] + wint * qc[et]) * dd;
        }
        float sm = 0.f;
#pragma unroll
        for (int et = 0; et < 4; ++et) sm += (hs[et].x + hs[et].y) + (hs[et].z + hs[et].w);
        sm += SHX(sm, 16, lane); sm += SHX(sm, 32, lane);
        const float mean = sm * (1.0f / 64.0f); float q = 0.f;
#pragma unroll
        for (int et = 0; et < 4; ++et) { const f32x4 dl = hs[et] - mean; q += (dl.x * dl.x + dl.y * dl.y) + (dl.z * dl.z + dl.w * dl.w); }
        q += SHX(q, 16, lane); q += SHX(q, 32, lane);
        const float rstd = 1.0f / sqrtf(q * (1.0f / 64.0f) + LN_EPS);
#pragma unroll
        for (int et = 0; et < 4; ++et) {
            const int c = h * 64 + et * 16 + 4 * g;
            const f32x4 o4 = *(const f32x4*)(proj + trow * PLD + C_MW + 3 * MW + c), g4 = *(const f32x4*)(mln_g + c);
            const f32x4 y = (hs[et] - mean) * rstd * g4;
            u32x2 ob; ob.x = pk2(sigmoidf_(o4.x) * y.x, sigmoidf_(o4.y) * y.y); ob.y = pk2(sigmoidf_(o4.z) * y.z, sigmoidf_(o4.w) * y.w);
            *(u32x2*)(GRP + trow * D + GW + RW + c) = ob;
        }
    }
    __syncthreads();
}

__device__ __forceinline__ void phase_rwkv_post(const Params& P, int l, unsigned char* smem, int wv) {
    ParamsPtr pp = PARAMS_PTR(P); PIN_S(pp); unsigned char* ws = pp->ws; int bidx = (int)blockIdx.x, gdim = (int)gridDim.x; PIN_S(bidx); PIN_S(gdim);
    const float* SCAN = (const float*)(ws + O_SCAN); const float* VV = (const float*)(ws + O_VV); const float* GATE = (const float*)(ws + O_GATE);
    const float* BONUS = (const float*)(ws + O_BONUS); bf16_t* GRP = (bf16_t*)(ws + O_GRP);
    const float* rln_g = pp->in[15] + (size_t)l * RW; const float* rln_b = pp->in[16] + (size_t)l * RW;
    const int tid = phase_tid(wv), lane = tid & 63, wave = tid >> 6;
    const int gw = bidx * NWAVES + wave, ngw = NWAVES * gdim;
    for (int it = gw; it < T * RH; it += ngw) {
        const int t = it / RH, h = it % RH, c = h * 64 + lane;
        const size_t o = (size_t)t * RW + c;
        const float x = SCAN[o] + SCAN[(size_t)T * RW + o];
        const float mean = wave_sum(x, lane) * (1.0f / 64.0f);
        const float dl = x - mean;
        const float var = wave_sum(dl * dl, lane) * (1.0f / 64.0f);
        float y = dl / sqrtf(var + GN_EPS) * rln_g[c] + rln_b[c];
        y += BONUS[(size_t)t * RH + h] * VV[o];
        GRP[(size_t)t * D + GW + c] = (bf16_t)f2bf(y * GATE[o]);
    }
}

__device__ __forceinline__ void phase_ln1_router(const Params& P, int l, unsigned char* smem, int wv) {
    ParamsPtr pp = PARAMS_PTR(P); PIN_S(pp); unsigned char* ws = pp->ws; int bidx = (int)blockIdx.x, gdim = (int)gridDim.x; PIN_S(bidx); PIN_S(gdim);
    const float* xin = l == 0 ? pp->in[0] : (const float*)(ws + O_XA);
    const float* MIX = (const float*)(ws + O_MIX); float* X1 = (float*)(ws + O_X1);
    int* TOPI = (int*)(ws + O_TOPI); float* TOPG = (float*)(ws + O_TOPG); int* RANK = (int*)(ws + O_RANK); bf16_t* X1B = (bf16_t*)(ws + O_X1B);
    int* BCNT = (int*)(ws + O_BCNT);
    const float* g1 = pp->in[22] + (size_t)l * D; const float* b1 = pp->in[23] + (size_t)l * D;
    const float* rw = pp->in[24] + (size_t)l * D * NE; const float* rb = pp->in[25] + (size_t)l * NE;
    const bf16_t* RWT = (const bf16_t*)(ws + O_RWT) + (size_t)l * 2 * NE * D;
    const int tid = phase_tid(wv), lane = tid & 63, wave = tid >> 6, col = lane & 15, g = lane >> 4;
    float* lgs = (float*)smem;
    int* stopi = (int*)(smem + 8192);
    for (int tile = bidx; tile < T / 64; tile += gdim) {
        __syncthreads();
        {
            f32x4 xa[4], xm[4];
#define LN1_LOAD(tt_) do { _Pragma("unroll") for (int j = 0; j < 4; ++j) { const int c = j * 256 + lane * 4; xa[j] = *(const f32x4*)(xin + (size_t)(tt_) * D + c); xm[j] = *(const f32x4*)(MIX + (size_t)(tt_) * D + c); } } while (0)
            LN1_LOAD(tile * 64 + wave * 8);
#pragma unroll 1
            for (int ti8 = 0; ti8 < 8; ++ti8) {
                const int t = tile * 64 + wave * 8 + ti8;
                float v[16]; float sm = 0.f;
#pragma unroll
                for (int j = 0; j < 4; ++j) {
                    v[j * 4 + 0] = ALPHA * xa[j].x + xm[j].x; v[j * 4 + 1] = ALPHA * xa[j].y + xm[j].y; v[j * 4 + 2] = ALPHA * xa[j].z + xm[j].z; v[j * 4 + 3] = ALPHA * xa[j].w + xm[j].w;
                    sm += (v[j * 4] + v[j * 4 + 1]) + (v[j * 4 + 2] + v[j * 4 + 3]);
                }
                if (ti8 < 7) LN1_LOAD(t + 1);
                const float mean = wave_sum_fast(sm, lane) * (1.0f / D); float q = 0.f;
#pragma unroll
                for (int j = 0; j < 16; ++j) { const float dl = v[j] - mean; q += dl * dl; }
                const float rstd = 1.0f / sqrtf(wave_sum_fast(q, lane) * (1.0f / D) + LN_EPS);
#pragma unroll
                for (int j = 0; j < 4; ++j) {
                    const int c = j * 256 + lane * 4;
                    const f32x4 gg = *(const f32x4*)(g1 + c), bb = *(const f32x4*)(b1 + c);
                    f32x4 o;
                    o.x = (v[j * 4 + 0] - mean) * rstd * gg.x + bb.x; o.y = (v[j * 4 + 1] - mean) * rstd * gg.y + bb.y;
                    o.z = (v[j * 4 + 2] - mean) * rstd * gg.z + bb.z; o.w = (v[j * 4 + 3] - mean) * rstd * gg.w + bb.w;
                    *(f32x4*)(X1 + (size_t)t * D + c) = o;
                    u32x2 ob; ob.x = pk2(o.x, o.y); ob.y = pk2(o.z, o.w); *(u32x2*)(X1B + (size_t)t * D + c) = ob;
                }
            }
#undef LN1_LOAD
        }
        __syncthreads();
        {
            const float* xr = X1 + (size_t)(tile * 64 + (wave >> 1) * 16 + col) * D + 8 * g;
            const bf16_t* wh = RWT + (size_t)((wave & 1) * 16 + col) * D + 8 * g; const bf16_t* wl = wh + (size_t)NE * D;
            f32x4 acc = (f32x4){0.f, 0.f, 0.f, 0.f};
#pragma unroll 4
            for (int ks = 0; ks < 32; ++ks) {
                const f32x4 x0 = *(const f32x4*)(xr + ks * 32), x1 = *(const f32x4*)(xr + ks * 32 + 4);
                const bf16x8 bh = *(const bf16x8*)(wh + ks * 32), bl = *(const bf16x8*)(wl + ks * 32);
                const bf16x8 ah = cvt8(x0, x1);
                const u32x4 ahu = __builtin_bit_cast(u32x4, ah);
                f32x4 r0, r1;
                r0.x = x0.x - bf_lo(ahu.x); r0.y = x0.y - bf_hi(ahu.x); r0.z = x0.z - bf_lo(ahu.y); r0.w = x0.w - bf_hi(ahu.y);
                r1.x = x1.x - bf_lo(ahu.z); r1.y = x1.y - bf_hi(ahu.z); r1.z = x1.z - bf_lo(ahu.w); r1.w = x1.w - bf_hi(ahu.w);
                const bf16x8 al = cvt8(r0, r1);
                acc = MFMA16(ah, bh, acc); acc = MFMA16(ah, bl, acc); acc = MFMA16(al, bh, acc);
            }
            const float rbv = rb[(wave & 1) * 16 + col];
#pragma unroll
            for (int r = 0; r < 4; ++r) lgs[((wave >> 1) * 16 + 4 * g + r) * NE + (wave & 1) * 16 + col] = acc[r] + rbv;
        }
        __syncthreads();
        if (tid < 64) {
            const float* lp = lgs + tid * NE; const int t = tile * 64 + tid;
            float tv[4]; int ti[4];
#pragma unroll
            for (int k = 0; k < 4; ++k) { tv[k] = -INFINITY; ti[k] = 0; }
            for (int e = 0; e < NE; ++e) {
                const float x = lp[e];
                if (x > tv[3]) {
                    if (x > tv[0]) { tv[3] = tv[2]; ti[3] = ti[2]; tv[2] = tv[1]; ti[2] = ti[1]; tv[1] = tv[0]; ti[1] = ti[0]; tv[0] = x; ti[0] = e; }
                    else if (x > tv[1]) { tv[3] = tv[2]; ti[3] = ti[2]; tv[2] = tv[1]; ti[2] = ti[1]; tv[1] = x; ti[1] = e; }
                    else if (x > tv[2]) { tv[3] = tv[2]; ti[3] = ti[2]; tv[2] = x; ti[2] = e; }
                    else { tv[3] = x; ti[3] = e; }
                }
            }
            const float e1 = expf(tv[1] - tv[0]), e2 = expf(tv[2] - tv[0]), e3 = expf(tv[3] - tv[0]);
            const float inv = 1.0f / (1.0f + e1 + e2 + e3);
            *(f32x4*)(TOPG + (size_t)t * 4) = (f32x4){inv, e1 * inv, e2 * inv, e3 * inv};
#pragma unroll
            for (int k = 0; k < 4; ++k) { TOPI[(size_t)t * 4 + k] = ti[k]; stopi[tid * 4 + k] = ti[k]; }
        }
        __syncthreads();
        if (tid < 256) { const int e = stopi[tid]; int r = 0; for (int a2 = 0; a2 < tid; ++a2) r += (stopi[a2] == e) ? 1 : 0; RANK[(size_t)tile * 256 + tid] = r; }
        else if (tid < 256 + NE) { const int e = tid - 256; int cnt = 0; for (int a2 = 0; a2 < 256; ++a2) cnt += (stopi[a2] == e) ? 1 : 0; BCNT[tile * NE + e] = cnt; }
    }
    __syncthreads();
}

__device__ __forceinline__ void moe_offsets(int* sh, const int* CNT, int tid) {
    if (tid == 0) {
        int acc = 0;
        for (int e = 0; e < NE; ++e) { const int c = (int)CNT[e]; sh[e] = c; sh[32 + e] = acc; acc += (c + MOEB - 1) / MOEB * MOEB; sh[64 + e] = acc; }
    }
    __syncthreads();
}
__device__ __forceinline__ int moe_expert_of_row(const int* sh, int r) {
    int e = -1;
    for (int i = 0; i < NE; ++i) if (r >= sh[32 + i] && r < sh[64 + i]) e = i;
    return e;
}

__device__ __forceinline__ void phase_scatter(const Params& P, int l, unsigned char* smem, int wv) {
    ParamsPtr pp = PARAMS_PTR(P); PIN_S(pp); unsigned char* ws = pp->ws; int bidx = (int)blockIdx.x, gdim = (int)gridDim.x; PIN_S(bidx); PIN_S(gdim);
    const int tid = phase_tid(wv);
    const int* TOPI = (const int*)(ws + O_TOPI); const int* RANK = (const int*)(ws + O_RANK); int* SLOT = (int*)(ws + O_SLOT); int* ROWT = (int*)(ws + O_ROWT);
    const int* BCNT = (const int*)(ws + O_BCNT); int* CNTF = (int*)(ws + O_CNTF);
    int* sh = (int*)smem;
    int* part = sh + 96;
    int* tot = part + 512;
    int* base = tot + 32;
    constexpr int NT = T / 64;
    const int e = tid & 31, pt = tid >> 5;
    { int sacc = 0; for (int tl = pt; tl < NT; tl += 16) sacc += BCNT[tl * NE + e]; part[pt * 32 + e] = sacc; }
    __syncthreads();
    if (tid < 32) { int sacc = 0; for (int q = 0; q < 16; ++q) sacc += part[q * 32 + tid]; tot[tid] = sacc; if (bidx == 0) CNTF[tid] = sacc; }
    __syncthreads();
    moe_offsets(sh, tot, tid);
    for (int ee = bidx; ee < NE; ee += gdim)
        for (int r = sh[32 + ee] + sh[ee] + tid; r < sh[64 + ee]; r += NTHREADS) ROWT[r] = 0;
    for (int tile = bidx; tile < NT; tile += gdim) {
        __syncthreads();
        { int sacc = 0; for (int tl = pt; tl < tile; tl += 16) sacc += BCNT[tl * NE + e]; part[pt * 32 + e] = sacc; }
        __syncthreads();
        if (tid < 32) { int sacc = sh[32 + tid]; for (int q = 0; q < 16; ++q) sacc += part[q * 32 + tid]; base[tid] = sacc; }
        __syncthreads();
        if (tid < 256) { const int a = tile * 256 + tid, dest = base[TOPI[a]] + RANK[a]; SLOT[a] = dest; ROWT[dest] = a >> 2; }
    }
    __syncthreads();
}

template <int WHICH>
__device__ __forceinline__ void phase_moe_gemm(const Params& P, int l, unsigned char* smem, int wv) {
    ParamsPtr pp = PARAMS_PTR(P); PIN_S(pp); unsigned char* ws = pp->ws; int bidx = (int)blockIdx.x, gdim = (int)gridDim.x; PIN_S(bidx); PIN_S(gdim);
    const int tid = phase_tid(wv);
    const int* CNT = (const int*)(ws + O_CNTF);
    int* sh = (int*)(smem + 131072);
    int* rbe = sh + 96;
    moe_offsets(sh, CNT, tid);
    const int nrb = sh[64 + NE - 1] / MOEB;
    for (int rb = tid; rb < nrb; rb += NTHREADS) rbe[rb] = moe_expert_of_row(sh, rb * MOEB);
    __syncthreads();
    pg8::MoeOrderT<WHICH == 1> S;
    S.K = 1024; S.G_ = gdim; S.c = bidx; S.rbe = rbe; S.rowmap = (const int*)(ws + O_ROWT);
    if (WHICH == 1) {
        S.A = (const char*)(ws + O_X1B); S.Wt = (const char*)(ws + O_W1) + (size_t)l * NE * 2 * DFF * D * 2; S.estride = (size_t)2 * DFF * D * 2; S.nN = 2 * DFF / 256; S.nwg = nrb * S.nN;
        pg8::EpiSwiglu E{(bf16_t*)(ws + O_ACT), pp->in[27] + (size_t)l * NE * 2 * DFF};
        pg8::gemm_phase<pg8::EpiSwiglu, pg8::MoeOrderT<WHICH == 1>>((LAS unsigned char*)smem, 1024, S, E, tid);
    } else {
        S.A = (const char*)(ws + O_ACT); S.Wt = (const char*)(ws + O_W2) + (size_t)l * NE * D * DFF * 2; S.estride = (size_t)D * DFF * 2; S.nN = D / 256; S.nwg = nrb * S.nN;
        pg8::EpiBf16Bias E{(bf16_t*)(ws + O_YS), D, pp->in[29] + (size_t)l * NE * D, D};
        pg8::gemm_phase<pg8::EpiBf16Bias, pg8::MoeOrderT<WHICH == 1>>((LAS unsigned char*)smem, 1024, S, E, tid);
    }
    __syncthreads();
}

__device__ __forceinline__ void phase_combine_ln2(const Params& P, int l, unsigned char* smem, int wv) {
    ParamsPtr pp = PARAMS_PTR(P); PIN_S(pp); unsigned char* ws = pp->ws; int bidx = (int)blockIdx.x, gdim = (int)gridDim.x; PIN_S(bidx); PIN_S(gdim);
    const float* X1 = (const float*)(ws + O_X1); const bf16_t* YS = (const bf16_t*)(ws + O_YS); bf16_t* XB = (bf16_t*)(ws + O_XB);
    const int* SLOT = (const int*)(ws + O_SLOT); const float* TOPG = (const float*)(ws + O_TOPG);
    float* xo = l == NL - 1 ? pp->out : (float*)(ws + O_XA);
    const float* g2 = pp->in[30] + (size_t)l * D; const float* b2 = pp->in[31] + (size_t)l * D;
    const int tid = phase_tid(wv), lane = tid & 63, wave = tid >> 6;
    const int gw = bidx * NWAVES + wave, ngw = NWAVES * gdim;
    u32x4 sl_n = (u32x4){0u, 0u, 0u, 0u}; f32x4 gg_n = (f32x4){0.f, 0.f, 0.f, 0.f};
    f32x4 xa_n[4]; u32x2 ys_n[4][4]; f32x4 gg_c = (f32x4){0.f, 0.f, 0.f, 0.f};
    const f32x4 lg[4] = {*(const f32x4*)(g2 + lane * 4), *(const f32x4*)(g2 + 256 + lane * 4), *(const f32x4*)(g2 + 512 + lane * 4), *(const f32x4*)(g2 + 768 + lane * 4)};
    const f32x4 lb[4] = {*(const f32x4*)(b2 + lane * 4), *(const f32x4*)(b2 + 256 + lane * 4), *(const f32x4*)(b2 + 512 + lane * 4), *(const f32x4*)(b2 + 768 + lane * 4)};
#define CB_META(tt_) do { sl_n = *(const u32x4*)(SLOT + (size_t)(tt_) * 4); gg_n = *(const f32x4*)(TOPG + (size_t)(tt_) * 4); } while (0)
#define CB_ROWS(tt_) do { _Pragma("unroll") for (int j = 0; j < 4; ++j) { const int c = j * 256 + lane * 4; xa_n[j] = *(const f32x4*)(X1 + (size_t)(tt_) * D + c); \
        ys_n[0][j] = *(const u32x2*)(YS + (size_t)sl_n.x * D + c); ys_n[1][j] = *(const u32x2*)(YS + (size_t)sl_n.y * D + c); ys_n[2][j] = *(const u32x2*)(YS + (size_t)sl_n.z * D + c); ys_n[3][j] = *(const u32x2*)(YS + (size_t)sl_n.w * D + c); } gg_c = gg_n; } while (0)
    if (gw < T) { CB_META(gw); CB_ROWS(gw); if (gw + ngw < T) CB_META(gw + ngw); }
    for (int t = gw; t < T; t += ngw) {
        float v[16]; float sm = 0.f;
        const float gk[4] = {gg_c.x, gg_c.y, gg_c.z, gg_c.w};
#pragma unroll
        for (int j = 0; j < 4; ++j) {
            const f32x4 a = xa_n[j];
            f32x4 y = (f32x4){0.f, 0.f, 0.f, 0.f};
#pragma unroll
            for (int k = 0; k < 4; ++k) { const u32x2 yk = ys_n[k][j]; y.x += gk[k] * bf_lo(yk.x); y.y += gk[k] * bf_hi(yk.x); y.z += gk[k] * bf_lo(yk.y); y.w += gk[k] * bf_hi(yk.y); }
            v[j * 4 + 0] = ALPHA * a.x + y.x; v[j * 4 + 1] = ALPHA * a.y + y.y; v[j * 4 + 2] = ALPHA * a.z + y.z; v[j * 4 + 3] = ALPHA * a.w + y.w;
            sm += (v[j * 4] + v[j * 4 + 1]) + (v[j * 4 + 2] + v[j * 4 + 3]);
        }
        if (t + ngw < T) { CB_ROWS(t + ngw); if (t + 2 * ngw < T) CB_META(t + 2 * ngw); }
        const float mean = wave_sum_fast(sm, lane) * (1.0f / D); float q = 0.f;
#pragma unroll
        for (int j = 0; j < 16; ++j) { const float dl = v[j] - mean; q += dl * dl; }
        const float rstd = 1.0f / sqrtf(wave_sum_fast(q, lane) * (1.0f / D) + LN_EPS);
#pragma unroll
        for (int j = 0; j < 4; ++j) {
            const int c = j * 256 + lane * 4;
            f32x4 o;
            o.x = (v[j * 4 + 0] - mean) * rstd * lg[j].x + lb[j].x; o.y = (v[j * 4 + 1] - mean) * rstd * lg[j].y + lb[j].y;
            o.z = (v[j * 4 + 2] - mean) * rstd * lg[j].z + lb[j].z; o.w = (v[j * 4 + 3] - mean) * rstd * lg[j].w + lb[j].w;
            *(f32x4*)(xo + (size_t)t * D + c) = o;
            if (l != NL - 1) { u32x2 ob; ob.x = pk2(o.x, o.y); ob.y = pk2(o.z, o.w); *(u32x2*)(XB + (size_t)t * D + c) = ob; }
        }
    }
#undef CB_META
#undef CB_ROWS
}

__device__ __forceinline__ void phase_inproj(const Params& P, int l, unsigned char* smem, int wv) {
    ParamsPtr pp = PARAMS_PTR(P); PIN_S(pp); unsigned char* ws = pp->ws; int bidx = (int)blockIdx.x, gdim = (int)gridDim.x; PIN_S(bidx); PIN_S(gdim);
    const int tid = phase_tid(wv);
    pg8::DenseOrder S; S.init(ws + O_XB, (const bf16_t*)(ws + O_WIN) + (size_t)l * PLD * D, T, PLD, D, gdim, bidx);
    pg8::EpiF32 E{(float*)(ws + O_PROJ), PLD};
    pg8::gemm_phase<pg8::EpiF32, pg8::DenseOrder>((LAS unsigned char*)smem, D, S, E, tid);
    __syncthreads();
}
__device__ __forceinline__ void phase_outproj(const Params& P, int l, unsigned char* smem, int wv) {
    ParamsPtr pp = PARAMS_PTR(P); PIN_S(pp); unsigned char* ws = pp->ws; int bidx = (int)blockIdx.x, gdim = (int)gridDim.x; PIN_S(bidx); PIN_S(gdim);
    const int tid = phase_tid(wv);
    pg8::DenseOrder S; S.init(ws + O_GRP, (const bf16_t*)(ws + O_WOUT) + (size_t)l * D * D, T, D, D, gdim, bidx);
    pg8::EpiF32 E{(float*)(ws + O_MIX), D};
    pg8::gemm_phase<pg8::EpiF32, pg8::DenseOrder>((LAS unsigned char*)smem, D, S, E, tid);
    __syncthreads();
}

#ifndef EMU
#define XB_TMO      128
#define XB_XCNT(j)  (256  + 64 * (j))
#define XB_XSUB(j)  (1280 + 64 * (j))
#define XB_XGEN(j)  (2304 + 64 * (j))
#define XB_TOP      3328
#define XB_TOPGEN   3392
#define XCD_BAR_WORDS 3456
#define XB_SPIN_CAP (1u << 25)
__device__ __forceinline__ unsigned xb_ld(unsigned* p)              { return __hip_atomic_load(p, __ATOMIC_RELAXED, __HIP_MEMORY_SCOPE_AGENT); }
__device__ __forceinline__ unsigned xb_add(unsigned* p, unsigned v) { return __hip_atomic_fetch_add(p, v, __ATOMIC_RELAXED, __HIP_MEMORY_SCOPE_AGENT); }
__device__ __forceinline__ unsigned xb_xcc_id() { return (unsigned)__builtin_amdgcn_s_getreg((3 << 11) | 20) & 0xFu; }
#define XB_SPIN(cond, bar) do { unsigned _sp = 0; while (cond) { __builtin_amdgcn_s_sleep(1); \
    if ((++_sp & 255u) == 0u) { if (xb_ld(&(bar)[XB_TMO])) break; if (_sp > XB_SPIN_CAP) { atomicAdd(&(bar)[XB_TMO], 1u); break; } } } } while (0)
struct XcdBarrier { unsigned* bar; unsigned x; volatile LAS unsigned* st; };
__device__ __forceinline__ XcdBarrier xcd_barrier_post(unsigned* bar, volatile LAS unsigned* st) {
    XcdBarrier b; b.bar = bar; b.x = xb_xcc_id(); b.st = st;
    if (threadIdx.x == 0) (void)xb_add(&bar[XB_XCNT(b.x)], 1u);
    return b;
}
__device__ __forceinline__ void xcd_barrier_complete(unsigned* bar, unsigned x, unsigned& nloc, unsigned& nx) {
    const unsigned G = gridDim.x * gridDim.y * gridDim.z;
    unsigned sum, cnt, mine, sp = 0u;
    for (;;) {
        sum = 0u; cnt = 0u; mine = 0u;
#pragma unroll
        for (unsigned j = 0; j < 16; ++j) { const unsigned c = xb_ld(&bar[XB_XCNT(j)]); sum += c; cnt += (c > 0u) ? 1u : 0u; mine = (j == x) ? c : mine; }
        if (sum == G) break;
        __builtin_amdgcn_s_sleep(1);
        if ((++sp & 255u) == 0u) { if (xb_ld(&bar[XB_TMO])) break; if (sp > XB_SPIN_CAP) { atomicAdd(&bar[XB_TMO], 1u); break; } }
    }
    nloc = mine > 0u ? mine : 1u; nx = cnt > 0u ? cnt : 1u;
}
__device__ __forceinline__ void xcd_barrier(const XcdBarrier& b) {
    asm volatile("s_waitcnt vmcnt(0)" ::: "memory");
    __syncthreads();
    if (threadIdx.x == 0) {
        unsigned* bar = b.bar;
        __builtin_amdgcn_s_waitcnt(0);
        unsigned nloc = b.st[0], nx = b.st[1];
        if (nloc == 0u) { xcd_barrier_complete(bar, b.x, nloc, nx); b.st[0] = nloc; b.st[1] = nx; }
        const unsigned old = xb_add(&bar[XB_XSUB(b.x)], 1u);
        const unsigned gen = old / nloc;
        if (old + 1u == (gen + 1u) * nloc) {
            __builtin_amdgcn_fence(__ATOMIC_RELEASE, "agent");
            asm volatile("s_waitcnt vmcnt(0)" ::: "memory");
            const unsigned og = xb_add(&bar[XB_TOP], 1u);
            const unsigned tg = og / nx;
            if (og + 1u == (tg + 1u) * nx) xb_add(&bar[XB_TOPGEN], 1u);
            else XB_SPIN(xb_ld(&bar[XB_TOPGEN]) == tg, bar);
            __builtin_amdgcn_fence(__ATOMIC_ACQUIRE, "agent");
            xb_add(&bar[XB_XGEN(b.x)], 1u);
            asm volatile("s_waitcnt vmcnt(0)" ::: "memory");
        } else {
            XB_SPIN(xb_ld(&bar[XB_XGEN(b.x)]) == gen, bar);
            __builtin_amdgcn_fence(__ATOMIC_ACQUIRE, "agent");
            asm volatile("s_waitcnt vmcnt(0)" ::: "memory");
        }
    }
    __syncthreads();
}
#endif

__global__ void __launch_bounds__(512, 2) mk_fwd(Params P) {
#ifdef EMU
    unsigned char* smem = g_blk->lds;
#else
    extern __shared__ __attribute__((aligned(16))) unsigned char smem[];
    volatile LAS unsigned* bst = (volatile LAS unsigned*)(smem + LDS_BYTES - 16);
    if (threadIdx.x == 0) { bst[0] = 0u; bst[1] = 0u; bst[2] = 0u; bst[3] = 0u; }
    __syncthreads();
    XcdBarrier bar; bar.bar = (unsigned*)P.ws + CW_BAR; bar.x = 0; bar.st = bst;
    if (P.ph_hi - P.ph_lo > 1) bar = xcd_barrier_post((unsigned*)P.ws + CW_BAR, bst);
#endif
    const int lo = P.ph_lo, hi = P.ph_hi;
#ifdef EMU
    const int wv = (int)threadIdx.x >> 6;
#else
    const int wv = RFL((int)threadIdx.x >> 6);
#endif
#ifdef EMU
#define SEAM(id) do {} while (0)
#else
#define SEAM(id) do { if ((id) + 1 < hi) xcd_barrier(bar); } while (0)
#endif
#ifndef MK_ONLY_PHASE
#define MK_ONLY_PHASE -1
#endif
#ifndef MK_DUP_MASK
#define MK_DUP_MASK 0
#endif
#define PHG(kc, id, ...) do { if (MK_ONLY_PHASE < 0 || MK_ONLY_PHASE == (kc)) { const int id_ = (id); if (id_ >= lo && id_ < hi) { if ((MK_DUP_MASK >> (kc)) & 1) { __VA_ARGS__; SEAM(id_ - 1); } __VA_ARGS__; SEAM(id_); } } } while (0)
#define PH(k, ...) PHG(1 + (k), 1 + l * NPH + (k), __VA_ARGS__)
    PHG(0, 0, phase_prologue(P, smem, wv));
    for (int l = 0; l < NL; ++l) {
        PH(0, phase_inproj(P, l, smem, wv));
        PH(1, phase_prep(P, l, smem, wv));
#if MK_RWKV_CHUNKED
        PH(2, { phase_rwkv_pre(P, l, smem, wv); phase_mlstm_local(P, l, smem, wv, (int)blockIdx.x, (int)gridDim.x); });
        PH(3, { phase_rwkv_seq(P, l, smem, wv); phase_mlstm_carry(P, l, smem, wv); });
        PH(4, { phase_rwkv_out(P, l, smem, wv); phase_mlstm_out(P, l, smem, wv); phase_gmlp_mix(P, l, smem, wv, (int)blockIdx.x, (int)gridDim.x); });
#else
        PH(2, { const int G_ = (int)gridDim.x, NSC = 2 * NB * RH * 4;
                if (G_ >= NSC + 32) { if ((int)blockIdx.x < NSC) phase_rwkv_scan(P, l, smem, wv, (int)blockIdx.x, NSC);
                                      else phase_mlstm_local(P, l, smem, wv, (int)blockIdx.x - NSC, G_ - NSC); }
                else { phase_rwkv_scan(P, l, smem, wv, (int)blockIdx.x, G_); phase_mlstm_local(P, l, smem, wv, (int)blockIdx.x, G_); } });
        PH(3, phase_mlstm_carry(P, l, smem, wv));
        PH(4, { phase_mlstm_out(P, l, smem, wv); phase_gmlp_mix(P, l, smem, wv, (int)blockIdx.x, (int)gridDim.x); phase_rwkv_post(P, l, smem, wv); });
#endif
        PH(5, phase_outproj(P, l, smem, wv));
        PH(6, phase_ln1_router(P, l, smem, wv));
        PH(7, phase_scatter(P, l, smem, wv));
        PH(8, phase_moe_gemm<1>(P, l, smem, wv));
        PH(9, phase_moe_gemm<2>(P, l, smem, wv));
        PH(10, phase_combine_ln2(P, l, smem, wv));
    }
#undef PHG
#undef PH
#undef SEAM
}

}

#ifndef EMU
extern "C" void kernel_launch(void* const* d_in, const int* in_sizes, int n_in, void* d_out, int out_size, void* d_ws, size_t ws_size, hipStream_t stream) {
    using namespace mk;
    static int grid = 0;
    if (grid == 0) {
        if (n_in != 32 || out_size != T * D || ws_size < WS_END) { fprintf(stderr, "kernel_launch: unexpected shapes (n_in %d out %d ws %zu need %zu)\n", n_in, out_size, ws_size, (size_t)WS_END); grid = -1; return; }
        int dev = 0, cus = 0;
        if (hipGetDevice(&dev) != hipSuccess || hipDeviceGetAttribute(&cus, hipDeviceAttributeMultiprocessorCount, dev) != hipSuccess) { grid = -1; return; }
        if (hipFuncSetAttribute((const void*)mk_fwd, hipFuncAttributeMaxDynamicSharedMemorySize, LDS_BYTES) != hipSuccess) { fprintf(stderr, "kernel_launch: hipFuncSetAttribute failed\n"); grid = -1; return; }
        int per_cu = 0;
        (void)hipOccupancyMaxActiveBlocksPerMultiprocessor(&per_cu, (const void*)mk_fwd, NTHREADS, LDS_BYTES);
        (void)hipGetLastError();
        grid = cus;
    }
    if (grid < 0) return;
    (void)hipMemsetAsync(d_ws, 0, CTL_BYTES, stream);
    Params p{};
    for (int i = 0; i < 32; ++i) p.in[i] = (const float*)d_in[i];
    p.out = (float*)d_out; p.ws = (unsigned char*)d_ws;
#if MK_ONE_LAUNCH
    p.ph_lo = 0; p.ph_hi = 1 + NL * NPH;
    hipLaunchKernelGGL(mk_fwd, dim3(grid), dim3(NTHREADS), LDS_BYTES, stream, p);
#else
    for (int id = 0; id < 1 + NL * NPH; ++id) {
        p.ph_lo = id; p.ph_hi = id + 1;
        hipLaunchKernelGGL(mk_fwd, dim3(grid), dim3(NTHREADS), LDS_BYTES, stream, p);
    }
#endif
}
#endif
```

```cpp
#ifndef EMU
#include <hip/hip_runtime.h>
#endif
#include <cstdio>
#include <cstdint>
#include <cmath>

#ifndef CFG_BATCH
#define CFG_BATCH 4
#endif
#ifndef CFG_SEQ
#define CFG_SEQ 4096
#endif
#ifndef CFG_LAYERS
#define CFG_LAYERS 4
#endif
#ifndef MK_RWKV_CHUNKED
#define MK_RWKV_CHUNKED 1
#endif
#ifndef MK_PROBE
#define MK_PROBE 0
#endif
#ifndef MK_ONE_LAUNCH
#define MK_ONE_LAUNCH 1
#endif

namespace mk {
constexpr int NB = CFG_BATCH, S = CFG_SEQ, T = NB * S, NL = CFG_LAYERS, D = 1024;
constexpr int GW = 256, RW = 384, MW = 384, HD = 64, GH = 4, RH = 6, MH = 6, CH = 128, NCH = S / CH;
constexpr int PIN = 3480, PLD = 3584, RPROJ = 1408;
constexpr int C_RW = 512, C_MW = 1920;
constexpr int NE = 32, TOPK = 4, DFF = 1024, MOEB = 256;
constexpr int NROWS = (T * TOPK / MOEB + NE) * MOEB;
constexpr float LN_EPS = 1e-5f, GN_EPS = 64e-5f;
constexpr float ALPHA = 1.6817928305074290f;
constexpr int NTHREADS = 512, NWAVES = 8;
constexpr int LDS_BYTES = 160 * 1024;
constexpr int NPH = 11;

typedef float f32x4 __attribute__((ext_vector_type(4)));
typedef unsigned u32x4 __attribute__((ext_vector_type(4)));
typedef unsigned u32x2 __attribute__((ext_vector_type(2)));
typedef short bf16x8 __attribute__((ext_vector_type(8)));
typedef unsigned short bf16_t;

constexpr size_t al(size_t x) { return (x + 255) & ~(size_t)255; }
constexpr size_t CTL_BYTES = 1u << 20;
constexpr size_t O_XA = CTL_BYTES;
constexpr size_t O_XB = O_XA + al((size_t)T * D * 4);
constexpr size_t O_X1 = O_XB + al((size_t)T * D * 2);
constexpr size_t O_X1B = O_X1 + al((size_t)T * D * 4);
constexpr size_t O_PROJ = O_X1B + al((size_t)T * D * 2);
constexpr size_t O_PROJG = O_PROJ + al((size_t)T * PLD * 2);
constexpr size_t O_MIX = O_PROJ + al((size_t)T * PLD * 4);
constexpr size_t O_GRP = O_MIX + al((size_t)T * D * 4);
constexpr size_t O_UG = O_GRP + al((size_t)T * D * 2);
constexpr size_t O_VN = O_UG + al((size_t)T * GW * 4);
constexpr size_t O_RR = O_VN + al((size_t)T * GW * 4);
constexpr size_t O_VV = O_RR + al((size_t)T * RW * 4);
constexpr size_t O_KK = O_VV + al((size_t)T * RW * 4);
constexpr size_t O_DEC = O_KK + al((size_t)T * RW * 4);
constexpr size_t O_KD = O_DEC + al((size_t)2 * T * RW * 4);
constexpr size_t O_ICLR = O_KD + al((size_t)2 * T * RW * 4);
constexpr size_t O_GATE = O_ICLR + al((size_t)2 * T * RW * 4);
constexpr size_t O_BONUS = O_GATE + al((size_t)T * RW * 4);
constexpr size_t O_SCAN = O_BONUS + al((size_t)T * RH * 4);
constexpr size_t O_MQ = O_SCAN + al((size_t)2 * T * RW * 4);
constexpr size_t O_MK = O_MQ + al((size_t)T * MW * 4);
constexpr size_t O_IG = O_MK + al((size_t)T * MW * 4);
constexpr size_t O_LF = O_IG + al((size_t)2 * T * MH * 4);
constexpr size_t O_CL = O_LF + al((size_t)2 * T * MH * 4);
constexpr size_t O_NL = O_CL + al((size_t)2 * NB * MH * NCH * 4096 * 4);
constexpr size_t O_ML = O_NL + al((size_t)2 * NB * MH * NCH * 64 * 4);
constexpr size_t O_BL = O_ML + al((size_t)2 * NB * MH * NCH * 4);
constexpr size_t O_MIN = O_BL + al((size_t)2 * NB * MH * NCH * 4);
constexpr size_t O_TOPI = O_MIN + al((size_t)2 * NB * MH * NCH * 4);
constexpr size_t O_TOPG = O_TOPI + al((size_t)T * 4 * 4);
constexpr size_t O_RANK = O_TOPG + al((size_t)T * 4 * 4);
constexpr size_t O_SLOT = O_RANK + al((size_t)T * 4 * 4);
constexpr size_t O_MQB = O_SLOT + al((size_t)T * 4 * 4);
constexpr size_t O_MKB = O_MQB + al((size_t)T * MW * 2);
constexpr size_t O_KT = O_MKB + al((size_t)T * MW * 2);
constexpr size_t O_VT = O_KT + al((size_t)T * MW * 2);
constexpr size_t O_GVT = O_VT + al((size_t)T * MW * 2);
constexpr size_t O_PMX = O_GVT + al((size_t)2 * T * MH * 4);
constexpr size_t O_BCT = O_PMX + al((size_t)2 * T * MH * 4);
constexpr size_t O_BRKR = O_BCT + al((size_t)2 * T * MH * 4);
constexpr int RC = 64, RNC = S / RC, RUN = 2 * NB * RH * RNC;
constexpr size_t O_LW = O_BRKR + al((size_t)2 * T * RH * 2 * 4);
constexpr size_t O_RQ = O_LW + al((size_t)2 * T * RW * 4);
constexpr size_t O_RA = O_RQ + al((size_t)RUN * 4096 * 2);
constexpr size_t O_RS = O_RA + al((size_t)RUN * 4096 * 2);
constexpr size_t O_RH = O_RS + al((size_t)RUN * 4096 * 2);
constexpr size_t O_RG = O_RH + al((size_t)RUN * 4096 * 4);
constexpr size_t O_RB = O_RG + al((size_t)RUN * 4096 * 4);
constexpr size_t O_VB = O_RB + al((size_t)T * RW * 2);
constexpr size_t O_KKB = O_VB + al((size_t)T * RW * 2);
constexpr size_t O_BBB = O_KKB + al((size_t)T * RW * 2);
constexpr size_t O_KDB = O_BBB + al((size_t)2 * T * RW * 2);
constexpr size_t O_VNT = O_KDB + al((size_t)2 * T * RW * 2);
constexpr size_t O_WSB = O_VNT + al((size_t)T * GW * 2);
constexpr size_t O_LWT = O_WSB + al((size_t)NL * GH * CH * CH * 2);
constexpr size_t O_RWT = O_LWT + al((size_t)NL * 1920 * 128 * 2);
constexpr size_t O_BCNT = O_RWT + al((size_t)NL * 2 * NE * D * 2);
constexpr size_t O_CNTF = O_BCNT + al((size_t)(T / 64) * NE * 4);
constexpr size_t O_ROWT = O_CNTF + al((size_t)NE * 4);
constexpr size_t O_XS = O_ROWT + al((size_t)NROWS * 4);
constexpr size_t O_ACT = O_XS + al((size_t)NROWS * D * 2);
constexpr size_t O_YS = O_ACT + al((size_t)NROWS * DFF * 2);
constexpr size_t O_WIN = O_YS + al((size_t)NROWS * D * 2);
constexpr size_t O_WOUT = O_WIN + al((size_t)NL * PLD * D * 2);
constexpr size_t O_W1 = O_WOUT + al((size_t)NL * D * D * 2);
constexpr size_t O_W2 = O_W1 + al((size_t)NL * NE * 2 * DFF * D * 2);
constexpr size_t WS_END = O_W2 + al((size_t)NL * NE * D * DFF * 2);

constexpr int CW_BAR = 4096;
constexpr int CW_CNT = 16384;

struct Params { const float* in[32]; float* out; unsigned char* ws; int ph_lo, ph_hi; };
#ifdef EMU
typedef const Params* ParamsPtr;
#define PARAMS_PTR(P) (&(P))
#else
typedef const __attribute__((address_space(4))) Params* ParamsPtr;
#define PARAMS_PTR(P) ((ParamsPtr)__builtin_amdgcn_kernarg_segment_ptr())
#endif

#ifdef EMU
#define WAVE_SYNC() emu_wave_barrier()
#define PIN_V(x) do {} while (0)
#define PIN_S(x) do {} while (0)
#else
#define WAVE_SYNC() __builtin_amdgcn_wave_barrier()
#define PIN_V(x) asm volatile("" : "+v"(x))
#define PIN_S(x) asm volatile("" : "+s"(x))
#endif
#ifdef EMU
__device__ __forceinline__ int phase_tid(int wv) { (void)wv; return threadIdx.x; }
#else
__device__ __forceinline__ int phase_tid(int wv) { int t; asm volatile("v_mbcnt_lo_u32_b32 %0, -1, 0\n\tv_mbcnt_hi_u32_b32 %0, -1, %0" : "=v"(t)); return (wv << 6) + t; }
#endif

#ifdef EMU
#define SHX(v, m, lane) __shfl_xor(v, m)
#else
__device__ __forceinline__ float shx_(float v, int m, int lane) { return __builtin_bit_cast(float, __builtin_amdgcn_ds_bpermute((lane ^ m) << 2, __builtin_bit_cast(int, v))); }
__device__ __forceinline__ int shx_(int v, int m, int lane) { return __builtin_amdgcn_ds_bpermute((lane ^ m) << 2, v); }
#define SHX(v, m, lane) shx_(v, m, lane)
#endif
#ifdef EMU
#define SHUP(v, o, lane) __shfl(v, ((lane) - (o)) & 63)
#define RDL(v, src) __shfl(v, src)
#define SHL(v, src) __shfl(v, src)
#else
#define SHL(v, src) __builtin_bit_cast(float, __builtin_amdgcn_ds_bpermute((src) << 2, __builtin_bit_cast(int, (float)(v))))
#define SHUP(v, o, lane) __builtin_bit_cast(float, __builtin_amdgcn_ds_bpermute((((lane) - (o)) & 63) << 2, __builtin_bit_cast(int, (float)(v))))
#define RDL(v, src) __builtin_bit_cast(float, __builtin_amdgcn_readlane(__builtin_bit_cast(int, (float)(v)), src))
#endif
__device__ __forceinline__ float wave_sum(float v, int lane) {
#pragma unroll
    for (int o = 32; o >= 1; o >>= 1) v += SHX(v, o, lane);
    return v;
}
#ifdef EMU
__device__ __forceinline__ float fexp(float x) { return expf(x); }
__device__ __forceinline__ float flog(float x) { return logf(x); }
__device__ __forceinline__ float frcp(float x) { return 1.0f / x; }
#else
__device__ __forceinline__ float fexp(float x) { return __builtin_amdgcn_exp2f(x * 1.4426950408889634f); }
__device__ __forceinline__ float flog(float x) { return __builtin_amdgcn_logf(x) * 0.6931471805599453f; }
__device__ __forceinline__ float frcp(float x) { return __builtin_amdgcn_rcpf(x); }
#endif
__device__ __forceinline__ float sigmoidf_(float x) { return frcp(1.0f + fexp(-x)); }
__device__ __forceinline__ float softplusf_(float x) { return fmaxf(x, 0.f) + flog(1.0f + fexp(-fabsf(x))); }
__device__ __forceinline__ float ftanh(float x) { return 1.0f - 2.0f * frcp(1.0f + fexp(2.0f * x)); }
__device__ __forceinline__ float geluf_(float v) {
    const float av = fabsf(v), t = frcp(1.0f + 0.2316418882f * av);
    float q = t * 0.5307027145f + (-0.7265760135f); q = q * t + 0.7107068705f; q = q * t + (-0.142248368f); q = q * t + 0.127414796f; q = q * t;
    const float m = v * (q * fexp(-0.5f * v * v));
    return v < 0.f ? m : v - m;
}

#ifdef EMU
#define LAS
#define WAIT_V(n) do {} while (0)
#define WAIT_L(n) do {} while (0)
#define S_BARRIER() __syncthreads()
#define SETPRIO(x) do {} while (0)
#define SCHED_BAR() do {} while (0)
#define RFL(x) (x)
static inline void emu_glds16(const void* g, void* l) { memcpy((char*)l + (g_blk->cur & 63) * 16, g, 16); }
#define GLDS16(gptr, ldsptr) emu_glds16((const void*)(gptr), (void*)(ldsptr))
static inline float emu_bf2f(unsigned short b) { unsigned u = (unsigned)b << 16; float f; memcpy(&f, &u, 4); return f; }
static inline f32x4 emu_mfma16(bf16x8 a, bf16x8 b, f32x4 c) {
    EmuBlock* blk = g_blk; const int cur = blk->cur, lane = cur & 63, wbase = cur & ~63;
    static thread_local unsigned short Ash[32][64][8], Bsh[32][64][8];
    const int w = cur >> 6;
    for (int j = 0; j < 8; ++j) { Ash[w][lane][j] = (unsigned short)a[j]; Bsh[w][lane][j] = (unsigned short)b[j]; }
    emu_wave_barrier();
    const int col = lane & 15;
    for (int r = 0; r < 4; ++r) { const int row = 4 * (lane >> 4) + r; float sum = c[r];
        for (int k = 0; k < 32; ++k) sum += emu_bf2f(Ash[w][row + 16 * (k >> 3)][k & 7]) * emu_bf2f(Bsh[w][col + 16 * (k >> 3)][k & 7]);
        c[r] = sum; }
    emu_wave_barrier(); (void)wbase;
    return c;
}
#define MFMA16(a, b, c) emu_mfma16(a, b, c)
#else
#define LAS __attribute__((address_space(3)))
#define WAIT_V(n) asm volatile("s_waitcnt vmcnt(" #n ")" ::: "memory")
#define WAIT_L(n) asm volatile("s_waitcnt lgkmcnt(" #n ")" ::: "memory")
#define S_BARRIER() __builtin_amdgcn_s_barrier()
#define SETPRIO(x) __builtin_amdgcn_s_setprio(x)
#define SCHED_BAR() __builtin_amdgcn_sched_barrier(0)
#define RFL(x) __builtin_amdgcn_readfirstlane(x)
#define GLDS16(gptr, ldsptr) __builtin_amdgcn_global_load_lds((const unsigned*)(gptr), (LAS unsigned*)(ldsptr), 16, 0, 0)
#define MFMA16(a, b, c) __builtin_amdgcn_mfma_f32_16x16x32_bf16(a, b, c, 0, 0, 0)
#endif

__device__ __forceinline__ unsigned f2bf(float f) { unsigned u = __builtin_bit_cast(unsigned, f); return (u + 0x7fffu + ((u >> 16) & 1u)) >> 16; }
__device__ __forceinline__ unsigned pk2(float lo, float hi) { return f2bf(lo) | (f2bf(hi) << 16); }
__device__ __forceinline__ bf16x8 cvt8(const f32x4 a, const f32x4 b) {
    u32x4 w; w.x = pk2(a.x, a.y); w.y = pk2(a.z, a.w); w.z = pk2(b.x, b.y); w.w = pk2(b.z, b.w); return __builtin_bit_cast(bf16x8, w);
}
__device__ __forceinline__ float bf_lo(unsigned u) { return __builtin_bit_cast(float, u << 16); }
__device__ __forceinline__ float bf_hi(unsigned u) { return __builtin_bit_cast(float, u & 0xffff0000u); }

namespace pg8 {
constexpr int BM = 256, BK = 64, HALF = 128, HTB = HALF * BK * 2, STAGE_BYTES = 8 * HTB, NXCD = 8, WGM = 8;
__host__ __device__ __forceinline__ int lds_byte(int r, int c) { const int st = (r >> 4) * 2 + (c >> 5), rr = r & 15, cc = c & 31, ob = rr * 64 + cc * 2; return st * 1024 + (ob ^ (((ob >> 9) & 1) << 5)); }
__host__ __device__ __forceinline__ void stage_rc(int b, int& R, int& C) { const int st = b / 1024, sb = b % 1024, swz = sb ^ (((sb >> 9) & 1) << 5); R = (st >> 1) * 16 + swz / 64; C = (st & 1) * 32 + (swz % 64) / 2; }
__host__ __device__ __forceinline__ int perm32(int rho) { const int n = rho >> 4, i = rho & 15; return 8 * (i >> 2) + 4 * n + (i & 3); }
struct Unit { int pm, pn, e; };

struct DenseOrder {
    static constexpr bool GATHER = false;
    const char* A; const char* Bt; int K; int nM, nN, nwg, G, c;
    __device__ __forceinline__ void init(const void* A_, const void* Bt_, int M, int N, int K_, int G_, int c_) { A = (const char*)A_; Bt = (const char*)Bt_; K = K_; nM = M / BM; nN = N / BM; nwg = nM * nN; G = G_; c = c_; }
    __device__ __forceinline__ bool next(int i, Unit& u) const {
        const long L = (long)i * G + c; if (L >= nwg) return false;
        int wgid = (int)L; { const int q = nwg / NXCD, r = nwg % NXCD, xcd = wgid % NXCD, off = wgid / NXCD; wgid = (xcd < r ? xcd * (q + 1) : r * (q + 1) + (xcd - r) * q) + off; }
        const int nig = WGM * nN, gid = wgid / nig, fm = gid * WGM, gsz = (nM - fm) < WGM ? (nM - fm) : WGM;
        u.pm = fm + ((wgid % nig) % gsz); u.pn = (wgid % nig) / gsz; u.e = 0; return true;
    }
    __device__ __forceinline__ const char* abase(const Unit& u) const { return A + (size_t)u.pm * BM * K * 2; }
    __device__ __forceinline__ const char* bbase(const Unit& u) const { return Bt + (size_t)u.pn * BM * K * 2; }
};
template <bool G>
struct MoeOrderT {
    static constexpr bool GATHER = G;
    const char* A; const char* Wt; int K; int nN, nwg, G_, c; size_t estride; const int* rbe; const int* rowmap;
    __device__ __forceinline__ bool next(int i, Unit& u) const {
        const long L = (long)i * G_ + c; if (L >= nwg) return false;
        u.pm = (int)(L / nN); u.pn = (int)(L % nN); u.e = rbe[u.pm]; return true;
    }
    __device__ __forceinline__ const char* abase(const Unit& u) const { return G ? A : A + (size_t)u.pm * BM * K * 2; }
    __device__ __forceinline__ const char* bbase(const Unit& u) const { return Wt + (size_t)u.e * estride + (size_t)u.pn * BM * K * 2; }
};
struct EpiF32 {
    static constexpr bool PERM = false;
    float* C; int ldc;
    __device__ __forceinline__ void operator()(const f32x4 (&acc)[2][2][4][2], const Unit& u, int wr, int wc, int fr, int fq) const {
        const int row0 = u.pm * BM + wr * 64 + fr, col0 = u.pn * BM + wc * 32 + 4 * fq;
#pragma unroll
        for (int ai = 0; ai < 2; ++ai)
#pragma unroll
            for (int m = 0; m < 4; ++m) { float* rowp = C + (size_t)(row0 + ai * HALF + m * 16) * ldc + col0;
#pragma unroll
                for (int bj = 0; bj < 2; ++bj)
#pragma unroll
                    for (int n = 0; n < 2; ++n) *(f32x4*)(rowp + bj * HALF + n * 16) = acc[ai][bj][m][n]; }
    }
};
struct EpiProj {
    static constexpr bool PERM = true;
    bf16_t* O; int ldc; float* G; int lastt;
    __device__ __forceinline__ void operator()(const f32x4 (&acc)[2][2][4][2], const Unit& u, int wr, int wc, int fr, int fq) const {
        const int row0 = u.pm * BM + wr * 64 + fr, col0 = u.pn * BM + wc * 32 + 8 * fq;
#pragma unroll
        for (int ai = 0; ai < 2; ++ai)
#pragma unroll
            for (int m = 0; m < 4; ++m) { bf16_t* rowp = O + (size_t)(row0 + ai * HALF + m * 16) * ldc + col0;
#pragma unroll
                for (int bj = 0; bj < 2; ++bj) { const f32x4 v0 = acc[ai][bj][m][0], v1 = acc[ai][bj][m][1];
                    u32x4 w; w.x = pk2(v0[0], v0[1]); w.y = pk2(v0[2], v0[3]); w.z = pk2(v1[0], v1[1]); w.w = pk2(v1[2], v1[3]);
                    *(u32x4*)(rowp + bj * HALF) = w; } }
        if (u.pn == lastt) {
#pragma unroll
            for (int ai = 0; ai < 2; ++ai)
#pragma unroll
                for (int m = 0; m < 4; ++m) { float* rowp = G + (size_t)(row0 + ai * HALF + m * 16) * BM + wc * 32 + 8 * fq;
#pragma unroll
                    for (int bj = 0; bj < 2; ++bj) { *(f32x4*)(rowp + bj * HALF) = acc[ai][bj][m][0]; *(f32x4*)(rowp + bj * HALF + 4) = acc[ai][bj][m][1]; } }
        }
    }
};
struct EpiBf16Bias {
    static constexpr bool PERM = true;
    bf16_t* O; int ldc; const float* bias; int bias_estride;
    __device__ __forceinline__ void operator()(const f32x4 (&acc)[2][2][4][2], const Unit& u, int wr, int wc, int fr, int fq) const {
        const int row0 = u.pm * BM + wr * 64 + fr, col0 = u.pn * BM + wc * 32 + 8 * fq;
        const float* bp = bias + (size_t)u.e * bias_estride + col0;
        f32x4 bv[2][2];
#pragma unroll
        for (int bj = 0; bj < 2; ++bj)
#pragma unroll
            for (int n = 0; n < 2; ++n) bv[bj][n] = *(const f32x4*)(bp + bj * HALF + 4 * n);
#pragma unroll
        for (int ai = 0; ai < 2; ++ai)
#pragma unroll
            for (int m = 0; m < 4; ++m) { bf16_t* rowp = O + (size_t)(row0 + ai * HALF + m * 16) * ldc + col0;
#pragma unroll
                for (int bj = 0; bj < 2; ++bj) { const f32x4 v0 = acc[ai][bj][m][0] + bv[bj][0], v1 = acc[ai][bj][m][1] + bv[bj][1];
                    u32x4 w; w.x = pk2(v0[0], v0[1]); w.y = pk2(v0[2], v0[3]); w.z = pk2(v1[0], v1[1]); w.w = pk2(v1[2], v1[3]);
                    *(u32x4*)(rowp + bj * HALF) = w; } }
    }
};
__device__ __forceinline__ float swiglu1(float g, float uu) { g = fminf(g, 7.0f); uu = fminf(fmaxf(uu, -7.0f), 7.0f); return (uu + 1.0f) * (g * frcp(1.0f + fexp(-1.702f * g))); }
struct EpiSwiglu {
    static constexpr bool PERM = true;
    bf16_t* O; const float* b1;
    __device__ __forceinline__ void operator()(const f32x4 (&acc)[2][2][4][2], const Unit& u, int wr, int wc, int fr, int fq) const {
        const int row0 = u.pm * BM + wr * 64 + fr, j0 = u.pn * HALF + wc * 32 + 8 * fq;
        const float* bg = b1 + (size_t)u.e * 2 * DFF + j0; const float* bu = bg + DFF;
        f32x4 g4[2], u4[2];
#pragma unroll
        for (int n = 0; n < 2; ++n) { g4[n] = *(const f32x4*)(bg + 4 * n); u4[n] = *(const f32x4*)(bu + 4 * n); }
#pragma unroll
        for (int ai = 0; ai < 2; ++ai)
#pragma unroll
            for (int m = 0; m < 4; ++m) {
                float o[8];
#pragma unroll
                for (int n = 0; n < 2; ++n)
#pragma unroll
                    for (int q = 0; q < 4; ++q) o[n * 4 + q] = swiglu1(acc[ai][0][m][n][q] + g4[n][q], acc[ai][1][m][n][q] + u4[n][q]);
                u32x4 w; w.x = pk2(o[0], o[1]); w.y = pk2(o[2], o[3]); w.z = pk2(o[4], o[5]); w.w = pk2(o[6], o[7]);
                *(u32x4*)(O + (size_t)(row0 + ai * HALF + m * 16) * DFF + j0) = w;
            }
    }
};

template <class Epi, class Sched>
__device__ __forceinline__ void gemm_phase(LAS unsigned char* lds, const int K, const Sched& S, const Epi& E, const int tid) {
    const int wid = RFL(tid >> 6), lane = tid & 63, wr = wid >> 2, wc = wid & 3, fr = lane & 15, fq = lane >> 4;
    const int nt = K / BK;
    unsigned voffA[2], voffB[2]; int gR[2]; unsigned gC[2];
#pragma unroll
    for (int i = 0; i < 2; ++i) { int R, C; stage_rc(tid * 16 + i * 8192, R, C); const int Rb = Epi::PERM ? ((R & ~31) + perm32(R & 31)) : R;
        voffA[i] = (unsigned)(R * K + C) * 2u; voffB[i] = (unsigned)(Rb * K + C) * 2u; gR[i] = R; gC[i] = (unsigned)C * 2u; }
    unsigned va[2][2], vn[2][2];
#define PG8_GOFF(dst, unit) do { if constexpr (Sched::GATHER) { _Pragma("unroll") for (int h_ = 0; h_ < 2; ++h_) _Pragma("unroll") for (int i_ = 0; i_ < 2; ++i_) \
        dst[h_][i_] = (unsigned)S.rowmap[(unit).pm * BM + h_ * HALF + gR[i_]] * (unsigned)(K * 2) + gC[i_]; } } while (0)
#define PG8_STAGE_A(bufoff, bp, kb, h, nx) do { if constexpr (Sched::GATHER) { const char* gb_ = S.A + (kb); _Pragma("unroll") for (int _i = 0; _i < 2; ++_i) \
        GLDS16(gb_ + ((nx) ? vn[h][_i] : va[h][_i]), lds + (bufoff) + ldsw + _i * 8192); } else { PG8_STAGE(bufoff, bp, voffA); } } while (0)
    const size_t kstep = (size_t)(BK * 2);
    const size_t hstep = (size_t)HALF * K * 2;
    const unsigned ldsw = (unsigned)wid * 1024u;
    const int aoff = lds_byte(wr * 64 + fr, fq * 8), boff = lds_byte(wc * 32 + fr, fq * 8);
#define PG8_SA(b, h) (((b) * 2 + (h)) * HTB)
#define PG8_SB(b, h) ((4 + (b) * 2 + (h)) * HTB)
#define PG8_STAGE(bufoff, gbase, voff) do { _Pragma("unroll") for (int _i = 0; _i < 2; ++_i) \
        GLDS16((const char*)(gbase) + (voff)[_i], lds + (bufoff) + ldsw + _i * 8192); } while (0)
#define PG8_LDA(dst, b, h) do { _Pragma("unroll") for (int m = 0; m < 4; ++m) _Pragma("unroll") for (int k = 0; k < 2; ++k) dst[m][k] = *(const LAS bf16x8*)(lds + PG8_SA(b, h) + aoff + m * 2048 + k * 1024); } while (0)
#define PG8_LDB(dst, b, h) do { _Pragma("unroll") for (int n = 0; n < 2; ++n) _Pragma("unroll") for (int k = 0; k < 2; ++k) dst[n][k] = *(const LAS bf16x8*)(lds + PG8_SB(b, h) + boff + n * 2048 + k * 1024); } while (0)
#define PG8_MMA(ai, bj, At, Bt) do { SETPRIO(1); _Pragma("unroll") for (int m = 0; m < 4; ++m) _Pragma("unroll") for (int n = 0; n < 2; ++n) _Pragma("unroll") for (int k = 0; k < 2; ++k) \
        acc[ai][bj][m][n] = MFMA16(Bt[n][k], At[m][k], acc[ai][bj][m][n]); SETPRIO(0); } while (0)
    Unit cur, nxt; int ui = 0;
    if (!S.next(0, cur)) return;
    f32x4 acc[2][2][4][2];
#pragma unroll
    for (int a = 0; a < 2; ++a)
#pragma unroll
        for (int b = 0; b < 2; ++b)
#pragma unroll
            for (int m = 0; m < 4; ++m)
#pragma unroll
                for (int n = 0; n < 2; ++n) acc[a][b][m][n] = (f32x4){0.f, 0.f, 0.f, 0.f};
    bf16x8 At[4][2], B0[2][2], B1[2][2];
    const char* cA = S.abase(cur); const char* cB = S.bbase(cur);
    PG8_GOFF(va, cur);
    PG8_STAGE(PG8_SB(0, 0), cB, voffB); PG8_STAGE_A(PG8_SA(0, 0), cA, 0, 0, false); PG8_STAGE(PG8_SB(0, 1), cB + hstep, voffB); PG8_STAGE_A(PG8_SA(0, 1), cA + hstep, 0, 1, false);
    if (wr == 1) S_BARRIER();
    WAIT_V(4); S_BARRIER();
    PG8_STAGE(PG8_SB(1, 0), cB + kstep, voffB); PG8_STAGE_A(PG8_SA(1, 0), cA + kstep, kstep, 0, false); PG8_STAGE(PG8_SB(1, 1), cB + hstep + kstep, voffB);
    WAIT_V(6); S_BARRIER();
    for (;;) {
        const bool has_next = S.next(ui + 1, nxt);
        const char* nA = has_next ? S.abase(nxt) : cA; const char* nB = has_next ? S.bbase(nxt) : cB;
        if constexpr (Sched::GATHER) { if (has_next) { PG8_GOFF(vn, nxt); } else {
#pragma unroll
            for (int h_ = 0; h_ < 2; ++h_) { vn[h_][0] = va[h_][0]; vn[h_][1] = va[h_][1]; } } }
        for (int t = 0; t < nt; t += 2) {
            const bool last = (t == nt - 2);
            const char* a1 = cA + (size_t)(t + 1) * kstep;
            const char* a2 = last ? nA : cA + (size_t)(t + 2) * kstep; const char* b2 = last ? nB : cB + (size_t)(t + 2) * kstep;
            const char* a3 = a2 + kstep; const char* b3 = b2 + kstep;
            PG8_LDB(B0, 0, 0); SCHED_BAR(); PG8_LDA(At, 0, 0); PG8_STAGE_A(PG8_SA(1, 1), a1 + hstep, (size_t)(t + 1) * kstep, 1, false);
            WAIT_L(8); S_BARRIER(); WAIT_L(0); PG8_MMA(0, 0, At, B0); S_BARRIER(); SCHED_BAR();
            PG8_LDB(B1, 0, 1); PG8_STAGE(PG8_SB(0, 0), b2, voffB);
            S_BARRIER(); WAIT_L(0); PG8_MMA(0, 1, At, B1); S_BARRIER();
            PG8_LDA(At, 0, 1); PG8_STAGE_A(PG8_SA(0, 0), a2, (last ? (size_t)0 : (size_t)(t + 2) * kstep), 0, last);
            S_BARRIER(); WAIT_L(0); PG8_MMA(1, 0, At, B0); S_BARRIER(); SCHED_BAR();
            PG8_STAGE(PG8_SB(0, 1), b2 + hstep, voffB);
            WAIT_V(6); S_BARRIER(); PG8_MMA(1, 1, At, B1); S_BARRIER();
            PG8_LDB(B0, 1, 0); SCHED_BAR(); PG8_LDA(At, 1, 0); PG8_STAGE_A(PG8_SA(0, 1), a2 + hstep, (last ? (size_t)0 : (size_t)(t + 2) * kstep), 1, last);
            WAIT_L(8); S_BARRIER(); WAIT_L(0); PG8_MMA(0, 0, At, B0); S_BARRIER(); SCHED_BAR();
            PG8_LDB(B1, 1, 1); PG8_STAGE(PG8_SB(1, 0), b3, voffB);
            S_BARRIER(); WAIT_L(0); PG8_MMA(0, 1, At, B1); S_BARRIER();
            PG8_LDA(At, 1, 1); PG8_STAGE_A(PG8_SA(1, 0), a3, (last ? kstep : (size_t)(t + 3) * kstep), 0, last);
            S_BARRIER(); WAIT_L(0); PG8_MMA(1, 0, At, B0); S_BARRIER(); SCHED_BAR();
            PG8_STAGE(PG8_SB(1, 1), b3 + hstep, voffB);
            WAIT_V(6); S_BARRIER(); PG8_MMA(1, 1, At, B1); S_BARRIER();
        }
        E(acc, cur, wr, wc, fr, fq);
        if (!has_next) break;
#pragma unroll
        for (int a = 0; a < 2; ++a)
#pragma unroll
            for (int b = 0; b < 2; ++b)
#pragma unroll
                for (int m = 0; m < 4; ++m)
#pragma unroll
                    for (int n = 0; n < 2; ++n) acc[a][b][m][n] = (f32x4){0.f, 0.f, 0.f, 0.f};
        cur = nxt; cA = nA; cB = nB; ++ui;
        if constexpr (Sched::GATHER) {
#pragma unroll
            for (int h_ = 0; h_ < 2; ++h_) { va[h_][0] = vn[h_][0]; va[h_][1] = vn[h_][1]; } }
    }
    WAIT_V(0);
    if (wr == 0) S_BARRIER();
    S_BARRIER();
#undef PG8_SA
#undef PG8_SB
#undef PG8_STAGE
#undef PG8_STAGE_A
#undef PG8_GOFF
#undef PG8_LDA
#undef PG8_LDB
#undef PG8_MMA
}
}

__device__ __forceinline__ float row16_sum(float x) {
#ifdef EMU
    x += __shfl_xor(x, 1); x += __shfl_xor(x, 2); x += __shfl_xor(x, 4); x += __shfl_xor(x, 8); return x;
#else
#define DPPF(v, ctrl) __builtin_bit_cast(float, __builtin_amdgcn_update_dpp(0, __builtin_bit_cast(int, (v)), (ctrl), 0xF, 0xF, false))
    x += DPPF(x, 0xB1); x += DPPF(x, 0x4E); x += DPPF(x, 0x141); x += DPPF(x, 0x140); return x;
#undef DPPF
#endif
}
__device__ __forceinline__ float row32_sum(float x) {
    x = row16_sum(x);
#ifdef EMU
    x += __shfl_xor(x, 32); return x;
#else
    float a = x, b = x;
    asm volatile("s_nop 1\n\tv_permlane32_swap_b32 %0, %1" : "+v"(a), "+v"(b));
    return a + b;
#endif
}
__device__ __forceinline__ float wave_sum_fast(float x, int lane) {
    x = row32_sum(x);
    x += SHX(x, 16, lane);
    return x;
}
__device__ __forceinline__ void transpose_item(const float* W, int K, int N, bf16_t* WT, int k0, int n0, int dst_row0, float* scr, int lane) {
    const int n4 = (lane & 15) * 4, kr = lane >> 4;
#pragma unroll 8
    for (int i = 0; i < 16; ++i) {
        const int kk = 4 * i + kr;
        f32x4 v = (f32x4){0.f, 0.f, 0.f, 0.f};
        if (n0 + n4 < N) v = *(const f32x4*)(W + (size_t)(k0 + kk) * N + n0 + n4);
        float* d = scr + kk * 65 + n4; d[0] = v.x; d[1] = v.y; d[2] = v.z; d[3] = v.w;
    }
    WAVE_SYNC();
    const int c = lane & 7;
#pragma unroll
    for (int j = 0; j < 8; ++j) { const int n = (lane >> 3) + 8 * j; const float* sp = scr + (8 * c) * 65 + n;
        u32x4 o; o.x = pk2(sp[0 * 65], sp[1 * 65]); o.y = pk2(sp[2 * 65], sp[3 * 65]); o.z = pk2(sp[4 * 65], sp[5 * 65]); o.w = pk2(sp[6 * 65], sp[7 * 65]);
        *(u32x4*)(WT + (size_t)(dst_row0 + n) * K + k0 + 8 * c) = o; }
    WAVE_SYNC();
}
__device__ __forceinline__ void phase_prologue(const Params& P, unsigned char* smem, int wv) {
    ParamsPtr pp = PARAMS_PTR(P); PIN_S(pp); unsigned char* ws = pp->ws; int bidx = (int)blockIdx.x, gdim = (int)gridDim.x; PIN_S(bidx); PIN_S(gdim);
    const int tid = phase_tid(wv), lane = tid & 63, wave = tid >> 6;
    float* scr = (float*)smem + wave * (64 * 65);
    const int gw = bidx * NWAVES + wave, ngw = NWAVES * gdim;
    constexpr int I_IN = 16 * (PLD / 64), I_OUT = 16 * 16, I_W1 = NE * 16 * 32, I_W2 = NE * 16 * 16, I_L = I_IN + I_OUT + I_W1 + I_W2;
    for (int it = gw; it < NL * I_L; it += ngw) {
        const int l = it / I_L; int r = it % I_L;
        if (r < I_IN) { const int kb = r / (PLD / 64), nb = r % (PLD / 64);
            transpose_item(pp->in[1] + (size_t)l * D * PIN, D, PIN, (bf16_t*)(ws + O_WIN) + (size_t)l * PLD * D, kb * 64, nb * 64, nb * 64, scr, lane); continue; }
        r -= I_IN;
        if (r < I_OUT) { const int kb = r / 16, nb = r % 16;
            transpose_item(pp->in[21] + (size_t)l * D * D, D, D, (bf16_t*)(ws + O_WOUT) + (size_t)l * D * D, kb * 64, nb * 64, nb * 64, scr, lane); continue; }
        r -= I_OUT;
        if (r < I_W1) { const int e = r / (16 * 32), q = r % (16 * 32), kb = q / 32, nb = q % 32, n0 = nb * 64;
            const int dst = n0 < DFF ? (n0 / 128) * 256 + (n0 % 128) : ((n0 - DFF) / 128) * 256 + 128 + ((n0 - DFF) % 128);
            transpose_item(pp->in[26] + ((size_t)l * NE + e) * D * 2 * DFF, D, 2 * DFF, (bf16_t*)(ws + O_W1) + ((size_t)l * NE + e) * 2 * DFF * D, kb * 64, n0, dst, scr, lane); continue; }
        r -= I_W1;
        { const int e = r / (16 * 16), q = r % (16 * 16), kb = q / 16, nb = q % 16;
            transpose_item(pp->in[28] + ((size_t)l * NE + e) * DFF * D, DFF, D, (bf16_t*)(ws + O_W2) + ((size_t)l * NE + e) * D * DFF, kb * 64, nb * 64, nb * 64, scr, lane); }
    }
    {
        const float* gw_ = pp->in[4]; bf16_t* WSB = (bf16_t*)(ws + O_WSB);
        for (size_t i = ((size_t)bidx * NTHREADS + tid) * 4; i < (size_t)NL * GH * CH * CH; i += (size_t)gdim * NTHREADS * 4) {
            const f32x4 v = *(const f32x4*)(gw_ + i); u32x2 o; o.x = pk2(v.x, v.y); o.y = pk2(v.z, v.w); *(u32x2*)(WSB + i) = o;
        }
    }
    {
        bf16_t* LWT = (bf16_t*)(ws + O_LWT);
        for (int i = bidx * NTHREADS + tid; i < NL * 1920 * 128; i += gdim * NTHREADS) {
            const int k = i & 127, n = (i >> 7) % 1920, ll = i / (1920 * 128);
            float v = 0.f;
            if (n < 1536) { if (k < 64) { const int grp = n / 768, d = (n / 384) & 1, c = n % 384; v = (grp == 0 ? pp->in[8] : pp->in[10])[(((size_t)ll * 2 + d) * 64 + k) * RW + c]; } }
            else v = pp->in[11][((size_t)ll * 128 + k) * RW + (n - 1536)];
            LWT[i] = (bf16_t)f2bf(v);
        }
    }
    {
        bf16_t* RWT = (bf16_t*)(ws + O_RWT);
        for (int i = bidx * NTHREADS + tid; i < NL * NE * D; i += gdim * NTHREADS) {
            const int k = i % D, e = (i / D) % NE, ll = i / (D * NE);
            const float v = pp->in[24][((size_t)ll * D + k) * NE + e];
            const unsigned hi = f2bf(v); const float lo = v - bf_lo(hi);
            RWT[((size_t)(ll * 2 + 0) * NE + e) * D + k] = (bf16_t)hi; RWT[((size_t)(ll * 2 + 1) * NE + e) * D + k] = (bf16_t)f2bf(lo);
        }
    }
    const float* x = pp->in[0]; bf16_t* XB = (bf16_t*)(ws + O_XB);
    for (size_t i = ((size_t)bidx * NTHREADS + tid) * 4; i < (size_t)T * D; i += (size_t)gdim * NTHREADS * 4) {
        const f32x4 v = *(const f32x4*)(x + i); u32x2 o; o.x = pk2(v.x, v.y); o.y = pk2(v.z, v.w); *(u32x2*)(XB + i) = o;
    }
}

__device__ __forceinline__ float tshift(const float* P, int t, int s, int col, const float* mu0, const float* mu1, int rc) {
    const float cur = P[(size_t)t * PLD + col];
    const float prv = s > 0 ? P[(size_t)(t - 1) * PLD + col] : 0.f;
    const float nxt = s < S - 1 ? P[(size_t)(t + 1) * PLD + col] : 0.f;
    return cur + mu0[rc] * (prv - cur) + mu1[rc] * (nxt - cur);
}

__device__ __forceinline__ void phase_prep(const Params& P, int l, unsigned char* smem, int wv) {
    ParamsPtr pp = PARAMS_PTR(P); PIN_S(pp); unsigned char* ws = pp->ws; int bidx = (int)blockIdx.x, gdim = (int)gridDim.x; PIN_S(bidx); PIN_S(gdim);
    const bf16_t* proj = (const bf16_t*)(ws + O_PROJ); const float* projg = (const float*)(ws + O_PROJG);
    float* UG = (float*)(ws + O_UG); bf16_t* VNT = (bf16_t*)(ws + O_VNT);
    float* RR = (float*)(ws + O_RR); float* VV = (float*)(ws + O_VV); float* KK = (float*)(ws + O_KK);
    float* KD = (float*)(ws + O_KD); float* ICLR = (float*)(ws + O_ICLR);
    float* GATE = (float*)(ws + O_GATE); float* BONUS = (float*)(ws + O_BONUS); float* LWG = (float*)(ws + O_LW);
    bf16_t* RB = (bf16_t*)(ws + O_RB); bf16_t* VB = (bf16_t*)(ws + O_VB); bf16_t* KKB = (bf16_t*)(ws + O_KKB); bf16_t* BBB = (bf16_t*)(ws + O_BBB); bf16_t* KDB = (bf16_t*)(ws + O_KDB);
#if !MK_RWKV_CHUNKED
    float* DEC = (float*)(ws + O_DEC); float* BRKR = (float*)(ws + O_BRKR);
#endif
    bf16_t* MQB = (bf16_t*)(ws + O_MQB); bf16_t* MKB = (bf16_t*)(ws + O_MKB); bf16_t* KT = (bf16_t*)(ws + O_KT); bf16_t* VT = (bf16_t*)(ws + O_VT);
    float* IG = (float*)(ws + O_IG); float* LF = (float*)(ws + O_LF);
    const bf16_t* LWT = (const bf16_t*)(ws + O_LWT) + (size_t)l * 1920 * 128;
    const float* gln_g = pp->in[2] + (size_t)l * GW; const float* gln_b = pp->in[3] + (size_t)l * GW;
    const float* mu0 = pp->in[6] + (size_t)l * 2 * RPROJ; const float* mu1 = mu0 + RPROJ;
    const float* w0 = pp->in[7] + (size_t)l * 2 * RW; const float* a0 = pp->in[9] + (size_t)l * 2 * RW;
    const float* k_k = pp->in[12] + (size_t)l * RW; const float* k_a = pp->in[13] + (size_t)l * RW; const float* r_k = pp->in[14] + (size_t)l * RW;
    const float* conv_w = pp->in[17] + (size_t)l * 3 * 768; const float* conv_b = pp->in[18] + (size_t)l * 768; const float* gate_b = pp->in[19] + (size_t)l * 24;
    float* win = (float*)smem;
    bf16_t* lin = (bf16_t*)(smem + 101376);
    bf16_t* tvn = (bf16_t*)(smem + 110592);
    bf16_t* tk = (bf16_t*)(smem + 118784);
    bf16_t* tv = (bf16_t*)(smem + 131072);
    constexpr int LIN = 264;
    const int tid = phase_tid(wv), lane = tid & 63, wave = tid >> 6, col = lane & 15, g = lane >> 4;
    for (int u = bidx; u < T / 16; u += gdim) {
        const int t0 = u * 16, s0 = t0 % S, bb = t0 / S;
        __syncthreads();
        {
            u32x2 wb[18];
#pragma unroll
            for (int row = 0; row < 18; ++row) {
                const int sq = s0 - 1 + row;
                wb[row] = (u32x2){0u, 0u};
                if (sq >= 0 && sq < S && tid < 352) wb[row] = *(const u32x2*)(proj + (size_t)(t0 - 1 + row) * PLD + C_RW + tid * 4);
            }
            if (tid < 352) {
#pragma unroll
                for (int row = 0; row < 18; ++row) *(f32x4*)(win + row * RPROJ + tid * 4) = (f32x4){bf_lo(wb[row].x), bf_hi(wb[row].x), bf_lo(wb[row].y), bf_hi(wb[row].y)};
            }
        }
        for (int rep_ = 0; rep_ < (MK_PROBE == 3 ? 2 : 1); ++rep_) {
            const int i = tid >> 5, l32 = tid & 31, t = t0 + i;
            float v[8], ug[8]; float sum = 0.f;
#pragma unroll
            for (int j = 0; j < 8; ++j) { const int c = j * 32 + l32; ug[j] = bf_lo((unsigned)proj[(size_t)t * PLD + c]); v[j] = bf_lo((unsigned)proj[(size_t)t * PLD + GW + c]); }
#pragma unroll
            for (int j = 0; j < 8; ++j) { const int c = j * 32 + l32; UG[(size_t)t * GW + c] = geluf_(ug[j]); v[j] = geluf_(v[j]); sum += v[j]; }
#pragma unroll
            for (int o = 16; o >= 1; o >>= 1) sum += SHX(sum, o, lane);
            const float mean = sum * (1.0f / GW); float q = 0.f;
#pragma unroll
            for (int j = 0; j < 8; ++j) { const float d = v[j] - mean; q += d * d; }
#pragma unroll
            for (int o = 16; o >= 1; o >>= 1) q += SHX(q, o, lane);
            const float rstd = 1.0f / sqrtf(q * (1.0f / GW) + LN_EPS);
#pragma unroll
            for (int j = 0; j < 8; ++j) { const int c = j * 32 + l32; tvn[c * 16 + i] = (bf16_t)f2bf((v[j] - mean) * rstd * gln_g[c] + gln_b[c]); }
        }
        __syncthreads();
        {
            const int hf = tid & 1, c = tid >> 1;
            *(u32x4*)(VNT + ((size_t)bb * GW + c) * S + s0 + hf * 8) = *(const u32x4*)(tvn + c * 16 + hf * 8);
        }
        for (int idx = tid; idx < 16 * 256; idx += NTHREADS) {
            const int i = idx >> 8, j = idx & 255, rc = 1152 + j;
            const float pv = win[i * RPROJ + rc], cv = win[(i + 1) * RPROJ + rc], nv = win[(i + 2) * RPROJ + rc];
            const float x = cv + mu0[rc] * (pv - cv) + mu1[rc] * (nv - cv);
            lin[i * LIN + j] = (bf16_t)f2bf(j < 64 ? ftanh(x) : (j < 128 ? x : sigmoidf_(x)));
        }
        __syncthreads();
        for (int rep_ = 0; rep_ < (MK_PROBE == 1 ? 2 : 1); ++rep_) {
#pragma unroll 1
            for (int qg = 0; qg < 3; ++qg) {
                bf16x8 bw_[5][4]; float bias_[5];
#pragma unroll
                for (int q5 = 0; q5 < 5; ++q5) {
                    const int nt = wave * 15 + qg * 5 + q5, grp = nt / 24, c = (nt % 24) * 16 + col;
                    const bf16_t* bw = LWT + (size_t)(nt * 16 + col) * 128 + 8 * g;
#pragma unroll
                    for (int ks = 0; ks < 4; ++ks) bw_[q5][ks] = *(const bf16x8*)(bw + ks * 32);
                    bias_[q5] = grp < 2 ? w0[grp * RW + c] : (grp < 4 ? a0[(grp - 2) * RW + c] : 0.f);
                }
#pragma unroll
                for (int q5 = 0; q5 < 5; ++q5) {
                    const int nt = wave * 15 + qg * 5 + q5, grp = nt / 24, c = (nt % 24) * 16 + col;
                    const int kcol = grp < 2 ? 0 : (grp < 4 ? 64 : 128);
                    f32x4 acc = (f32x4){0.f, 0.f, 0.f, 0.f};
#pragma unroll
                    for (int ks = 0; ks < 2; ++ks) acc = MFMA16(*(const bf16x8*)(lin + col * LIN + kcol + ks * 32 + 8 * g), bw_[q5][ks], acc);
                    if (grp == 4) {
#pragma unroll
                        for (int ks = 2; ks < 4; ++ks) acc = MFMA16(*(const bf16x8*)(lin + col * LIN + kcol + ks * 32 + 8 * g), bw_[q5][ks], acc);
                    }
                    if (grp < 2) {
#pragma unroll
                        for (int r = 0; r < 4; ++r) { const float lw = -fexp(-softplusf_(-(acc[r] + bias_[q5])) - 0.5f); const size_t o = (size_t)grp * T * RW + (size_t)(t0 + 4 * g + r) * RW + c; LWG[o] = lw;
#if !MK_RWKV_CHUNKED
                            DEC[o] = expf(lw);
#endif
                        }
                    } else if (grp < 4) {
#pragma unroll
                        for (int r = 0; r < 4; ++r) ICLR[(size_t)(grp - 2) * T * RW + (size_t)(t0 + 4 * g + r) * RW + c] = sigmoidf_(acc[r] + bias_[q5]);
                    } else {
#pragma unroll
                        for (int r = 0; r < 4; ++r) GATE[(size_t)(t0 + 4 * g + r) * RW + c] = acc[r];
                    }
                }
            }
        }
        __syncthreads();
        for (int rep_ = 0; rep_ < (MK_PROBE == 2 ? 2 : 1); ++rep_) if (wave < 6) {
            const int c = tid, h = wave;
            const float kkc = k_k[c], kac = k_a[c], rkc = r_k[c];
            const float m0r = mu0[c], m1r = mu1[c], m0k = mu0[RW + c], m1k = mu1[RW + c], m0v = mu0[2 * RW + c], m1v = mu1[2 * RW + c];
            float ic0[16], ic1[16];
#pragma unroll
            for (int i = 0; i < 16; ++i) { const size_t o = (size_t)(t0 + i) * RW + c; ic0[i] = ICLR[o]; ic1[i] = ICLR[(size_t)T * RW + o]; }
#pragma unroll
            for (int i = 0; i < 16; ++i) {
                const int t = t0 + i;
                const float* w_ = win + i * RPROJ + c;
                const float rp = w_[0], rc_ = w_[RPROJ], rn = w_[2 * RPROJ];
                const float kp = w_[RW], kc_ = w_[RPROJ + RW], kn = w_[2 * RPROJ + RW];
                const float vp = w_[2 * RW], vc_ = w_[RPROJ + 2 * RW], vn = w_[2 * RPROJ + 2 * RW];
                const float r = rc_ + m0r * (rp - rc_) + m1r * (rn - rc_);
                const float k = kc_ + m0k * (kp - kc_) + m1k * (kn - kc_);
                const float v = vc_ + m0v * (vp - vc_) + m1v * (vn - vc_);
                const size_t o = (size_t)t * RW + c;
                const float kq = k * kkc;
                const float n2 = wave_sum_fast(kq * kq, lane);
                const float kk = kq / fmaxf(sqrtf(n2), 1e-12f);
                const float kd0 = k * (1.0f + (ic0[i] - 1.0f) * kac), kd1 = k * (1.0f + (ic1[i] - 1.0f) * kac);
                const float bon = wave_sum_fast(r * (kd0 + kd1) * rkc, lane);
#if MK_RWKV_CHUNKED
                RB[o] = (bf16_t)f2bf(r); VB[o] = (bf16_t)f2bf(v); KKB[o] = (bf16_t)f2bf(kk);
                BBB[o] = (bf16_t)f2bf(kk * ic0[i]); BBB[(size_t)T * RW + o] = (bf16_t)f2bf(kk * ic1[i]);
                KDB[o] = (bf16_t)f2bf(kd0); KDB[(size_t)T * RW + o] = (bf16_t)f2bf(kd1);
#else
                RR[o] = r; VV[o] = v; KK[o] = kk;
                KD[o] = kd0; KD[(size_t)T * RW + o] = kd1;
#endif
                if (lane == 0) BONUS[(size_t)t * RH + h] = bon;
#if !MK_RWKV_CHUNKED
                { const float br0 = wave_sum(kk * ic0[i] * r, lane), br1 = wave_sum(kk * ic1[i] * r, lane), kr0 = wave_sum(kd0 * r, lane), kr1 = wave_sum(kd1 * r, lane);
                  if (lane == 0) { BRKR[((size_t)t * RH + h) * 2] = br0; BRKR[((size_t)t * RH + h) * 2 + 1] = kr0; BRKR[((size_t)(T + t) * RH + h) * 2] = br1; BRKR[((size_t)(T + t) * RH + h) * 2 + 1] = kr1; } }
#endif
            }
        }
        __syncthreads();
        {
            u32x2 wb[9], vb[3];
            const int rsel = tid >= 192 ? 1 : 0, c4 = tid - rsel * 192;
#pragma unroll
            for (int it = 0; it < 9; ++it) {
                const int row = 2 * it + rsel, sq = s0 - 1 + row;
                wb[it] = (u32x2){0u, 0u};
                if (tid < 384 && sq >= 0 && sq < S) wb[it] = *(const u32x2*)(proj + (size_t)(t0 - 1 + row) * PLD + C_MW + c4 * 4);
            }
#pragma unroll
            for (int it = 0; it < 3; ++it) { const int idx = tid + it * NTHREADS, i = idx / 96, cc = (idx % 96) * 4; vb[it] = *(const u32x2*)(proj + (size_t)(t0 + i) * PLD + C_MW + 2 * MW + cc); }
            if (tid < 384) {
#pragma unroll
                for (int it = 0; it < 9; ++it) *(f32x4*)(win + (2 * it + rsel) * 768 + c4 * 4) = (f32x4){bf_lo(wb[it].x), bf_hi(wb[it].x), bf_lo(wb[it].y), bf_hi(wb[it].y)};
            }
#pragma unroll
            for (int it = 0; it < 3; ++it) { const int idx = tid + it * NTHREADS, i = idx / 96, cc = (idx % 96) * 4; const u32x2 v = vb[it];
                tv[(cc + 0) * 16 + i] = (bf16_t)(v.x & 0xffffu); tv[(cc + 1) * 16 + i] = (bf16_t)(v.x >> 16); tv[(cc + 2) * 16 + i] = (bf16_t)(v.y & 0xffffu); tv[(cc + 3) * 16 + i] = (bf16_t)(v.y >> 16); }
        }
        for (int idx = tid; idx < 16 * 24; idx += NTHREADS) {
            const int i = idx / 24, gi = idx % 24, t = t0 + i;
            const int isf = gi / 12, dir = (gi / 6) & 1, h = gi % 6;
            const float gg = projg[(size_t)t * 256 + (3456 - (PLD - 256)) + gi] + gate_b[gi];
            if (isf) LF[((size_t)dir * T + t) * MH + h] = -softplusf_(-gg); else IG[((size_t)dir * T + t) * MH + h] = gg;
        }
        __syncthreads();
        for (int rep_ = 0; rep_ < (MK_PROBE == 4 ? 2 : 1); ++rep_)
        for (int idx = tid; idx < 16 * 768; idx += NTHREADS) {
            const int i = idx / 768, c = idx % 768, t = t0 + i;
            const float* w_ = win + i * 768 + c;
            float y = conv_b[c] + w_[0] * conv_w[c] + w_[768] * conv_w[768 + c] + w_[1536] * conv_w[2 * 768 + c];
            y = y * sigmoidf_(y);
            if (c < MW) MQB[(size_t)t * MW + c] = (bf16_t)f2bf(y);
            else { const bf16_t kb = (bf16_t)f2bf(y * 0.125f); MKB[(size_t)t * MW + (c - MW)] = kb; tk[(c - MW) * 16 + i] = kb; }
        }
        __syncthreads();
        for (int idx = tid; idx < 2 * MW * 2; idx += NTHREADS) {
            const int hf = idx & 1, c = (idx >> 1) % MW, which = idx / (2 * MW);
            const u32x4 val = *(const u32x4*)((which ? tv : tk) + c * 16 + hf * 8);
            bf16_t* dst = (which ? VT : KT) + ((size_t)(bb * MH) * 64 + c) * S + s0 + hf * 8;
            *(u32x4*)dst = val;
        }
    }
    __syncthreads();
}

__device__ __forceinline__ void phase_gmlp_mix(const Params& P, int l, unsigned char* smem, int wv, int bid, int nb) {
    PIN_S(bid); PIN_S(nb);
    ParamsPtr pp = PARAMS_PTR(P); PIN_S(pp); unsigned char* ws = pp->ws;
    const float* UG = (const float*)(ws + O_UG); const bf16_t* VNT = (const bf16_t*)(ws + O_VNT); bf16_t* GRP = (bf16_t*)(ws + O_GRP);
    const bf16_t* WSB = (const bf16_t*)(ws + O_WSB) + (size_t)l * GH * CH * CH; const float* gbs = pp->in[5] + (size_t)l * GH * CH;
    const int tid = phase_tid(wv), lane = tid & 63, wave = tid >> 6, col = lane & 15, g = lane >> 4;
    for (int u = bid; u < NB * NCH * GH; u += nb) {
        const int h = u % GH, c = (u / GH) % NCH, b = u / (GH * NCH);
        const int tok0 = b * S + c * CH;
        const bf16_t* wb = WSB + (size_t)h * CH * CH + (size_t)(wave * 16 + col) * CH + 8 * g;
        const bf16_t* vb = VNT + ((size_t)b * GW + h * 64 + col) * S + (size_t)c * CH + 8 * g;
        f32x4 acc[4];
#pragma unroll
        for (int et = 0; et < 4; ++et) acc[et] = (f32x4){0.f, 0.f, 0.f, 0.f};
#pragma unroll
        for (int ks = 0; ks < 4; ++ks) {
            const bf16x8 af = *(const bf16x8*)(wb + ks * 32);
#pragma unroll
            for (int et = 0; et < 4; ++et) acc[et] = MFMA16(af, *(const bf16x8*)(vb + (size_t)et * 16 * S + ks * 32), acc[et]);
        }
#pragma unroll
        for (int r = 0; r < 4; ++r) {
            const int p = wave * 16 + 4 * g + r; const size_t t = (size_t)(tok0 + p); const float bsv = gbs[h * CH + p];
#pragma unroll
            for (int et = 0; et < 4; ++et) { const int ch = h * 64 + et * 16 + col; GRP[t * D + ch] = (bf16_t)f2bf(UG[t * GW + ch] * (acc[et][r] + bsv)); }
        }
    }
}

constexpr int SC_STEPS = 16;
constexpr int SC_BUF = SC_STEPS * 6 * 64;
__device__ __forceinline__ void phase_rwkv_scan(const Params& P, int l, unsigned char* smem, int wv, int bid, int nb) {
    PIN_S(bid); PIN_S(nb);
    ParamsPtr pp = PARAMS_PTR(P); PIN_S(pp); unsigned char* ws = pp->ws;
    const float* RR = (const float*)(ws + O_RR); const float* VV = (const float*)(ws + O_VV); const float* KK = (const float*)(ws + O_KK);
    const float* DEC = (const float*)(ws + O_DEC); const float* KD = (const float*)(ws + O_KD); const float* ICLR = (const float*)(ws + O_ICLR);
    float* SCAN = (float*)(ws + O_SCAN); const float* BRKR = (const float*)(ws + O_BRKR);
    const int tid = phase_tid(wv), lane = tid & 63, wave = tid >> 6, rl = (lane >> 4) & 1, kq = (lane & 15) | ((lane >> 5) << 4);
    float* buf = (float*)smem;
    float* scal = buf + 2 * SC_BUF;
    float* outb = scal + 2 * SC_STEPS * 2;
    typedef float f32x2 __attribute__((ext_vector_type(2)));
    for (int u = bid; u < 2 * NB * RH * 4; u += nb) {
        const int qt = u & 3, h = (u >> 2) % RH, b = (u / (4 * RH)) % NB, d = u / (4 * RH * NB);
        const size_t doff = (size_t)d * T * RW;
        float s0 = 0.f, s1 = 0.f;
        float pw[2], pa[2], pb[2], pk[2], pr[2], pv[2], psc = 0.f;
#define SC_LOAD(c) do { _Pragma("unroll") for (int i = 0; i < 2; ++i) { const int idx = tid + NTHREADS * i, st = idx >> 6, k = idx & 63; const int tau = (c) * SC_STEPS + st, sq = d ? S - 1 - tau : tau; \
            const size_t o = (size_t)(b * S + sq) * RW + h * 64 + k; \
            pw[i] = DEC[doff + o]; pa[i] = KK[o]; pb[i] = ICLR[doff + o]; pk[i] = KD[doff + o]; pr[i] = RR[o]; pv[i] = VV[o]; }     \
            if (tid < 2 * SC_STEPS) { const int tau = (c) * SC_STEPS + (tid >> 1), sq = d ? S - 1 - tau : tau; psc = BRKR[((size_t)(d * T + b * S + sq) * RH + h) * 2 + (tid & 1)]; } } while (0)
#define SC_WRITE(c) do { float* B_ = buf + ((c) & 1) * SC_BUF; _Pragma("unroll") for (int i = 0; i < 2; ++i) { const int idx = tid + NTHREADS * i, st = idx >> 6, k = idx & 63; \
            float* q_ = B_ + st * 384 + k; q_[0] = pw[i]; q_[64] = -pa[i]; q_[128] = pa[i] * pb[i]; q_[192] = pk[i]; q_[256] = pw[i] * pr[i]; q_[320] = pv[i]; } \
            if (tid < 2 * SC_STEPS) scal[((c) & 1) * SC_STEPS * 2 + tid] = psc; } while (0)
        __syncthreads();
        SC_LOAD(0); SC_WRITE(0);
        __syncthreads();
        const int row = qt * 16 + wave * 2 + rl;
        for (int c = 0; c < S / SC_STEPS; ++c) {
            const bool more = (c + 1) < S / SC_STEPS;
            if (more) SC_LOAD(c + 1);
            const float* B = buf + (c & 1) * SC_BUF; const float* sc = scal + (c & 1) * SC_STEPS * 2; float* ob = outb + (c & 1) * SC_STEPS * 16;
            float outs[SC_STEPS];
            f32x2 w2 = *(const f32x2*)(B + 2 * kq), a2 = *(const f32x2*)(B + 64 + 2 * kq), b2 = *(const f32x2*)(B + 128 + 2 * kq);
            f32x2 k2 = *(const f32x2*)(B + 192 + 2 * kq), wr2 = *(const f32x2*)(B + 256 + 2 * kq);
            float v = B[320 + row]; float br = sc[0], kr = sc[1];
#pragma unroll
            for (int st = 0; st < SC_STEPS; ++st) {
                const int sn = st + 1 < SC_STEPS ? st + 1 : st;
                const float* q = B + sn * 384;
                const f32x2 nw2 = *(const f32x2*)(q + 2 * kq), na2 = *(const f32x2*)(q + 64 + 2 * kq), nb2 = *(const f32x2*)(q + 128 + 2 * kq);
                const f32x2 nk2 = *(const f32x2*)(q + 192 + 2 * kq), nwr2 = *(const f32x2*)(q + 256 + 2 * kq);
                const float nv = q[320 + row], nbr = sc[sn * 2], nkr = sc[sn * 2 + 1];
                SCHED_BAR();
                float sa = s0 * a2.x + s1 * a2.y;
                float po = s0 * wr2.x + s1 * wr2.y;
                sa = row32_sum(sa); po = row32_sum(po);
                outs[st] = po + sa * br + v * kr;
                s0 = s0 * w2.x + (sa * b2.x + v * k2.x); s1 = s1 * w2.y + (sa * b2.y + v * k2.y);
                SCHED_BAR();
                w2 = nw2; a2 = na2; b2 = nb2; k2 = nk2; wr2 = nwr2; v = nv; br = nbr; kr = nkr;
            }
            if (kq == 0) {
#pragma unroll
                for (int st = 0; st < SC_STEPS; ++st) ob[st * 16 + wave * 2 + rl] = outs[st];
            }
            if (more) SC_WRITE(c + 1);
            __syncthreads();
            if (tid < 16 * SC_STEPS) {
                const int st = tid >> 4, r = tid & 15, tau = c * SC_STEPS + st, sq = d ? S - 1 - tau : tau;
                SCAN[doff + (size_t)(b * S + sq) * RW + h * 64 + qt * 16 + r] = ob[st * 16 + r];
            }
        }
#undef SC_LOAD
#undef SC_WRITE
    }
    __syncthreads();
}

constexpr int RST = 72;
constexpr int RARR = 64 * RST;
__device__ __forceinline__ f32x4 tile_nt(const bf16_t* Aa, int ta, const bf16_t* Ba, int tb, f32x4 acc, int col, int g) {
#pragma unroll
    for (int ks = 0; ks < 2; ++ks) {
        const bf16x8 af = *(const bf16x8*)(Aa + (ta * 16 + col) * RST + ks * 32 + 8 * g);
        const bf16x8 bfr = *(const bf16x8*)(Ba + (tb * 16 + col) * RST + ks * 32 + 8 * g);
        acc = MFMA16(af, bfr, acc);
    }
    return acc;
}
__device__ __forceinline__ void phase_rwkv_pre(const Params& P, int l, unsigned char* smem, int wv) {
    ParamsPtr pp = PARAMS_PTR(P); PIN_S(pp); unsigned char* ws = pp->ws; int bidx = (int)blockIdx.x, gdim = (int)gridDim.x; PIN_S(bidx); PIN_S(gdim);
    const bf16_t* RB = (const bf16_t*)(ws + O_RB); const bf16_t* VB = (const bf16_t*)(ws + O_VB); const bf16_t* KKB = (const bf16_t*)(ws + O_KKB);
    const float* LWG = (const float*)(ws + O_LW); const bf16_t* KDB = (const bf16_t*)(ws + O_KDB); const bf16_t* BBB = (const bf16_t*)(ws + O_BBB);
    bf16_t* Qg = (bf16_t*)(ws + O_RQ); bf16_t* Ag = (bf16_t*)(ws + O_RA); bf16_t* Hg = (bf16_t*)(ws + O_RH); bf16_t* Gg = (bf16_t*)(ws + O_RG);
    const int tid0 = phase_tid(wv);
#define RW_STAGE_VARS int tid = tid0; PIN_V(tid); const int lane = tid & 63, wave = tid >> 6, col = lane & 15, g = lane >> 4; (void)lane; (void)wave; (void)col; (void)g;
    bf16_t* At = (bf16_t*)smem; bf16_t* Bt = At + RARR; bf16_t* Kt = Bt + RARR; bf16_t* Rt = Kt + RARR;
    bf16_t* BtT = Rt + RARR; bf16_t* KtT = BtT + RARR; bf16_t* VT = KtT + RARR;
    bf16_t* Lak = VT + RARR; bf16_t* Mrb = Lak + RARR; bf16_t* Mrk = Mrb + RARR; bf16_t* YT = Mrk + RARR; bf16_t* W2T = YT + RARR;
    bf16_t* Lbo = W2T + RARR;
    float* LabT = (float*)(Lbo + RARR);
    float* Xs = LabT + 4096;
    float* Pb = Xs + 4096;
    float* segs = Pb + 2048;
    float* PC = segs + 512;
    float plw[8]; unsigned pkk[8], pbq[8], pkd[8], prr[8], pvv[8];
#define RW_LOAD(uu) do { const int c_ = (uu) % RNC, h_ = ((uu) / RNC) % RH, b_ = ((uu) / (RNC * RH)) % NB, d_ = (uu) / (RNC * RH * NB); const size_t doff_ = (size_t)d_ * T * RW; \
        const int ch_ = tid0 & 63, sg_ = tid0 >> 6; _Pragma("unroll") for (int j = 0; j < 8; ++j) { const int tau = c_ * RC + sg_ * 8 + j, sq = d_ ? S - 1 - tau : tau; const size_t o = (size_t)(b_ * S + sq) * RW + h_ * 64 + ch_; \
        plw[j] = LWG[doff_ + o]; pkk[j] = KKB[o]; pbq[j] = BBB[doff_ + o]; pkd[j] = KDB[doff_ + o]; prr[j] = RB[o]; pvv[j] = VB[o]; } } while (0)
    if (bidx < RUN) RW_LOAD(bidx);
    for (int u = bidx; u < RUN; u += gdim) {
        const int c = u % RNC, h = (u / RNC) % RH, b = (u / (RNC * RH)) % NB, d = u / (RNC * RH * NB);
        (void)c; (void)h; (void)b; (void)d;
        __syncthreads();
        {
            RW_STAGE_VARS
            const int ch = tid & 63, sg = tid >> 6;
            float lw[8]; unsigned kk[8], bq_[8], kd[8], rr[8], vv[8];
#pragma unroll
            for (int j = 0; j < 8; ++j) { lw[j] = plw[j]; kk[j] = pkk[j]; bq_[j] = pbq[j]; kd[j] = pkd[j]; rr[j] = prr[j]; vv[j] = pvv[j]; }
            if (u + gdim < RUN) RW_LOAD(u + gdim);
            float run = 0.f;
#pragma unroll
            for (int j = 0; j < 8; ++j) { run += lw[j]; lw[j] = run; }
            segs[sg * 64 + ch] = run;
            __syncthreads();
            float off = 0.f;
            for (int q = 0; q < sg; ++q) off += segs[q * 64 + ch];
            u32x4 pbt, pkt, pvt; unsigned tb[8], tk[8], tvv[8];
            float prev = off;
#pragma unroll
            for (int j = 0; j < 8; ++j) {
                const int t = sg * 8 + j; const float cl = off + lw[j];
                const float ep = fexp(prev), en = fexp(-cl), epc = fexp(cl);
                const unsigned a_ = f2bf(-bf_lo(kk[j]) * ep), b_ = f2bf(bf_lo(bq_[j]) * en), k_ = f2bf(bf_lo(kd[j]) * en), r_ = f2bf(bf_lo(rr[j]) * epc), v_ = vv[j];
                At[t * RST + ch] = (bf16_t)a_; Bt[t * RST + ch] = (bf16_t)b_; Kt[t * RST + ch] = (bf16_t)k_; Rt[t * RST + ch] = (bf16_t)r_;
                tb[j] = b_; tk[j] = k_; tvv[j] = v_;
                prev = cl;
            }
            if (sg == 7) PC[ch] = fexp(prev);
            pbt.x = tb[0] | (tb[1] << 16); pbt.y = tb[2] | (tb[3] << 16); pbt.z = tb[4] | (tb[5] << 16); pbt.w = tb[6] | (tb[7] << 16);
            pkt.x = tk[0] | (tk[1] << 16); pkt.y = tk[2] | (tk[3] << 16); pkt.z = tk[4] | (tk[5] << 16); pkt.w = tk[6] | (tk[7] << 16);
            pvt.x = tvv[0] | (tvv[1] << 16); pvt.y = tvv[2] | (tvv[3] << 16); pvt.z = tvv[4] | (tvv[5] << 16); pvt.w = tvv[6] | (tvv[7] << 16);
            *(u32x4*)(BtT + ch * RST + sg * 8) = pbt; *(u32x4*)(KtT + ch * RST + sg * 8) = pkt; *(u32x4*)(VT + ch * RST + sg * 8) = pvt;
            for (int z_ = tid; z_ < 2 * RARR / 8; z_ += NTHREADS) ((u32x4*)YT)[z_] = (u32x4){0u, 0u, 0u, 0u};
        }
        __syncthreads();
        {
            RW_STAGE_VARS
            const int m = wave >> 1;
            const bf16_t* Ym = (m == 0 || m == 2) ? Bt : Kt; const bf16_t* Xm = (m < 2) ? At : Rt;
#pragma unroll 1
            for (int q = 0; q < 8; ++q) {
                const int tix = (wave & 1) * 8 + q, it = tix >> 2, tt = tix & 3;
                f32x4 acc = (f32x4){0.f, 0.f, 0.f, 0.f};
                if (it <= tt) acc = tile_nt(Ym, it, Xm, tt, acc, col, g);
                const int t = tt * 16 + col, i0 = it * 16 + 4 * g;
                float o4[4];
#pragma unroll
                for (int r = 0; r < 4; ++r) { const int i = i0 + r; const bool ok = m < 2 ? (i < t) : (i <= t); o4[r] = ok ? acc[r] : 0.f; }
                if (m == 0) {
#pragma unroll
                    for (int r = 0; r < 4; ++r) LabT[(i0 + r) * 64 + t] = o4[r];
                    const bool offd = it < tt;
                    u32x2 w2; w2.x = offd ? pk2(o4[0], o4[1]) : 0u; w2.y = offd ? pk2(o4[2], o4[3]) : 0u; *(u32x2*)(Lbo + t * RST + i0) = w2;
                }
                else { bf16_t* dst = (m == 1 ? Lak : (m == 2 ? Mrb : Mrk)) + t * RST + i0; u32x2 w2; w2.x = pk2(o4[0], o4[1]); w2.y = pk2(o4[2], o4[3]); *(u32x2*)dst = w2; }
            }
        }
        __syncthreads();
        {
            RW_STAGE_VARS
#pragma unroll
            for (int q = 0; q < 2; ++q) {
                const int tix = wave * 2 + q, tt = tix >> 2, et = tix & 3;
                f32x4 acc = (f32x4){0.f, 0.f, 0.f, 0.f};
                acc = tile_nt(Lak, tt, VT, et, acc, col, g);
#pragma unroll
                for (int r = 0; r < 4; ++r) Xs[(tt * 16 + 4 * g + r) * 64 + et * 16 + col] = acc[r];
            }
        }
        __syncthreads();
        {
            RW_STAGE_VARS
#pragma unroll 1
            for (int bb = 0; bb < 4; ++bb) {
                if (bb > 0) {
                    const bf16_t* Zt = (wave < 4 ? YT : W2T) + ((wave & 3) * 16 + col) * RST + 8 * g;
                    const bf16_t* La = Lbo + (16 * bb + col) * RST + 8 * g;
                    f32x4 acc = (f32x4){0.f, 0.f, 0.f, 0.f};
                    acc = MFMA16(*(const bf16x8*)La, *(const bf16x8*)Zt, acc);
                    if (bb > 2) acc = MFMA16(*(const bf16x8*)(La + 32), *(const bf16x8*)(Zt + 32), acc);
#pragma unroll
                    for (int r = 0; r < 4; ++r) Pb[(4 * g + r) * 128 + wave * 16 + col] = acc[r];
                }
                __syncthreads();
                if (wave < 2) {
                    float acc[16];
                    if (wave == 0) {
#pragma unroll
                        for (int r = 0; r < 16; ++r) acc[r] = bf_lo((unsigned)At[(16 * bb + r) * RST + lane]);
                    } else {
#pragma unroll
                        for (int r = 0; r < 16; ++r) acc[r] = Xs[(16 * bb + r) * 64 + lane];
                    }
                    if (bb > 0) {
#pragma unroll
                        for (int r = 0; r < 16; ++r) acc[r] += Pb[r * 128 + wave * 64 + lane];
                    }
                    const float* dp = LabT + (16 * bb) * 64 + 16 * bb;
#pragma unroll
                    for (int r = 1; r < 16; ++r)
#pragma unroll
                        for (int r2 = 0; r2 < r; ++r2) acc[r] += dp[r2 * 64 + r] * acc[r2];
                    bf16_t* dst = (wave == 0 ? YT : W2T) + lane * RST;
                    u32x4 w0, w1;
                    w0.x = pk2(acc[0], acc[1]); w0.y = pk2(acc[2], acc[3]); w0.z = pk2(acc[4], acc[5]); w0.w = pk2(acc[6], acc[7]);
                    w1.x = pk2(acc[8], acc[9]); w1.y = pk2(acc[10], acc[11]); w1.z = pk2(acc[12], acc[13]); w1.w = pk2(acc[14], acc[15]);
                    *(u32x4*)(dst + 16 * bb) = w0; *(u32x4*)(dst + 16 * bb + 8) = w1;
                }
                __syncthreads();
            }
        }
        __syncthreads();
        {
            RW_STAGE_VARS
            const int ty = wave >> 1;
#pragma unroll 1
            for (int q = 0; q < 8; ++q) {
                const int tix = (wave & 1) * 8 + q, ra = tix >> 2, cb = tix & 3;
                f32x4 acc = (f32x4){0.f, 0.f, 0.f, 0.f};
                if (ty == 0) {
                    acc = tile_nt(Mrb, ra, YT, cb, acc, col, g);
#pragma unroll
                    for (int r = 0; r < 4; ++r) { const int t = ra * 16 + 4 * g + r, k = cb * 16 + col; Qg[(size_t)u * 4096 + t * 64 + k] = (bf16_t)f2bf(acc[r] + bf_lo((unsigned)Rt[t * RST + k])); }
                } else if (ty == 1) {
                    acc = tile_nt(Mrb, ra, W2T, cb, acc, col, g); acc = tile_nt(Mrk, ra, VT, cb, acc, col, g);
                    { u32x2 hb; hb.x = pk2(acc[0], acc[1]); hb.y = pk2(acc[2], acc[3]); *(u32x2*)(Hg + (size_t)u * 4096 + (tix * 64 + lane) * 4) = hb; }
                } else if (ty == 2) {
                    acc = tile_nt(BtT, ra, YT, cb, acc, col, g);
#pragma unroll
                    for (int r = 0; r < 4; ++r) { const int k1 = ra * 16 + 4 * g + r, k = cb * 16 + col; Ag[(size_t)u * 4096 + k1 * 64 + k] = (bf16_t)f2bf(PC[k1] * (acc[r] + (k1 == k ? 1.0f : 0.f))); }
                } else {
                    acc = tile_nt(BtT, ra, W2T, cb, acc, col, g); acc = tile_nt(KtT, ra, VT, cb, acc, col, g);
#pragma unroll
                    for (int r = 0; r < 4; ++r) acc[r] *= PC[ra * 16 + 4 * g + r];
                    { u32x2 gb2; gb2.x = pk2(acc[0], acc[1]); gb2.y = pk2(acc[2], acc[3]); *(u32x2*)(Gg + (size_t)u * 4096 + (tix * 64 + lane) * 4) = gb2; }
                }
            }
        }
    }
    __syncthreads();
#undef RW_STAGE_VARS
#undef RW_LOAD
}
__device__ __forceinline__ void phase_rwkv_seq(const Params& P, int l, unsigned char* smem, int wv) {
    ParamsPtr pp = PARAMS_PTR(P); PIN_S(pp); unsigned char* ws = pp->ws; int bidx = (int)blockIdx.x, gdim = (int)gridDim.x; PIN_S(bidx); PIN_S(gdim);
    const bf16_t* Ag = (const bf16_t*)(ws + O_RA); const bf16_t* Gg = (const bf16_t*)(ws + O_RG); bf16_t* Sg = (bf16_t*)(ws + O_RS);
    const int tid = phase_tid(wv), lane = tid & 63, wave = tid >> 6, col = lane & 15, g = lane >> 4;
    const int gw = wave * gdim + bidx, ngw = NWAVES * gdim;
    for (int un = gw; un < 2 * NB * RH * 2; un += ngw) {
        const int ch = un >> 1, eh = un & 1;
        f32x4 acc[4][2];
#pragma unroll
        for (int a_ = 0; a_ < 4; ++a_)
#pragma unroll
            for (int b_ = 0; b_ < 2; ++b_) acc[a_][b_] = (f32x4){0.f, 0.f, 0.f, 0.f};
        u32x2 alo[4][2], ahi[4][2]; u32x2 gq[4][2];
        const unsigned aoff = (unsigned)(col * 64 + 4 * g), goff = (unsigned)(lane * 4);
#define RS_LOAD(cc) do { const bf16_t* ab_ = Ag + (size_t)(ch * RNC + (cc)) * 4096; const bf16_t* gb_ = Gg + (size_t)(ch * RNC + (cc)) * 4096 + eh * 512; \
            _Pragma("unroll") for (int ra = 0; ra < 4; ++ra) _Pragma("unroll") for (int p = 0; p < 2; ++p) { alo[ra][p] = *(const u32x2*)(ab_ + (ra * 1024 + p * 32) + aoff); ahi[ra][p] = *(const u32x2*)(ab_ + (ra * 1024 + p * 32 + 16) + aoff); } \
            _Pragma("unroll") for (int ra = 0; ra < 4; ++ra) _Pragma("unroll") for (int cb = 0; cb < 2; ++cb) gq[ra][cb] = *(const u32x2*)(gb_ + ((ra * 4 + cb) * 256) + goff); } while (0)
        RS_LOAD(0);
#pragma unroll 1
        for (int c = 0; c < RNC; ++c) {
            bf16_t* sb_ = Sg + (size_t)(ch * RNC + c) * 4096 + eh * 2048;
            bf16x8 bq[2][2];
#pragma unroll
            for (int cb = 0; cb < 2; ++cb) {
#pragma unroll
                for (int ra = 0; ra < 4; ++ra) {
                    u32x2 w2; w2.x = pk2(acc[ra][cb][0], acc[ra][cb][1]); w2.y = pk2(acc[ra][cb][2], acc[ra][cb][3]);
                    *(u32x2*)(sb_ + (cb * 1024 + ra * 16) + aoff) = w2;
                }
#pragma unroll
                for (int p = 0; p < 2; ++p) bq[p][cb] = cvt8(acc[2 * p][cb], acc[2 * p + 1][cb]);
            }
            u32x4 af[4][2];
#pragma unroll
            for (int ra = 0; ra < 4; ++ra) {
#pragma unroll
                for (int p = 0; p < 2; ++p) af[ra][p] = (u32x4){alo[ra][p].x, alo[ra][p].y, ahi[ra][p].x, ahi[ra][p].y};
#pragma unroll
                for (int cb = 0; cb < 2; ++cb) acc[ra][cb] = (f32x4){bf_lo(gq[ra][cb].x), bf_hi(gq[ra][cb].x), bf_lo(gq[ra][cb].y), bf_hi(gq[ra][cb].y)};
            }
            if (c + 1 < RNC) RS_LOAD(c + 1);
#pragma unroll
            for (int ra = 0; ra < 4; ++ra)
#pragma unroll
                for (int cb = 0; cb < 2; ++cb)
#pragma unroll
                    for (int p = 0; p < 2; ++p) acc[ra][cb] = MFMA16(__builtin_bit_cast(bf16x8, af[ra][p]), bq[p][cb], acc[ra][cb]);
        }
#undef RS_LOAD
    }
}
__device__ __forceinline__ void phase_rwkv_out(const Params& P, int l, unsigned char* smem, int wv) {
    ParamsPtr pp = PARAMS_PTR(P); PIN_S(pp); unsigned char* ws = pp->ws; int bidx = (int)blockIdx.x, gdim = (int)gridDim.x; PIN_S(bidx); PIN_S(gdim);
    const bf16_t* Qg = (const bf16_t*)(ws + O_RQ); const bf16_t* Sg = (const bf16_t*)(ws + O_RS); const bf16_t* Hg = (const bf16_t*)(ws + O_RH);
    const bf16_t* VB = (const bf16_t*)(ws + O_VB); const float* GATE = (const float*)(ws + O_GATE); const float* BONUS = (const float*)(ws + O_BONUS);
    bf16_t* GRP = (bf16_t*)(ws + O_GRP);
    const float* rln_g = pp->in[15] + (size_t)l * RW; const float* rln_b = pp->in[16] + (size_t)l * RW;
    const int tid = phase_tid(wv), lane = tid & 63, wave = tid >> 6, col = lane & 15, g = lane >> 4;
    for (int pu = bidx * NWAVES + wave; pu < NB * RH * RNC; pu += gdim * NWAVES) {
        const int c = pu % RNC, h = (pu / RNC) % RH, b = pu / (RNC * RH);
        f32x4 o[2][4][4];
#pragma unroll
        for (int d = 0; d < 2; ++d) {
            const int u = ((d * NB + b) * RH + h) * RNC + (d ? RNC - 1 - c : c);
            const size_t ub = (size_t)u * 4096;
            bf16x8 qa[4][2], sb[4][2];
#pragma unroll
            for (int q = 0; q < 4; ++q)
#pragma unroll
                for (int ks = 0; ks < 2; ++ks) { qa[q][ks] = *(const bf16x8*)(Qg + ub + (q * 16 + col) * 64 + ks * 32 + 8 * g); sb[q][ks] = *(const bf16x8*)(Sg + ub + (q * 16 + col) * 64 + ks * 32 + 8 * g); }
#pragma unroll
            for (int tt = 0; tt < 4; ++tt)
#pragma unroll
                for (int et = 0; et < 4; ++et) {
                    const u32x2 hb = *(const u32x2*)(Hg + ub + ((tt * 4 + et) * 64 + lane) * 4);
                    f32x4 acc = (f32x4){bf_lo(hb.x), bf_hi(hb.x), bf_lo(hb.y), bf_hi(hb.y)};
#pragma unroll
                    for (int ks = 0; ks < 2; ++ks) acc = MFMA16(qa[tt][ks], sb[et][ks], acc);
                    o[d][tt][et] = acc;
                }
        }
        const int src = (3 - g) * 16 + col;
#pragma unroll
        for (int tt = 0; tt < 4; ++tt)
#pragma unroll
            for (int et = 0; et < 4; ++et)
#pragma unroll
                for (int r = 0; r < 4; ++r) o[0][tt][et][r] += SHL(o[1][3 - tt][et][3 - r], src);
        float* tile = (float*)smem + wave * (64 * 68);
        WAVE_SYNC();
#pragma unroll
        for (int tt = 0; tt < 4; ++tt)
#pragma unroll
            for (int et = 0; et < 4; ++et)
#pragma unroll
                for (int r = 0; r < 4; ++r) tile[(tt * 16 + 4 * g + r) * 68 + et * 16 + col] = o[0][tt][et][r];
        WAVE_SYNC();
        {
            const int c4 = (lane & 15) * 4, ch = h * 64 + c4;
            const f32x4 lg = *(const f32x4*)(rln_g + ch), lb = *(const f32x4*)(rln_b + ch);
#pragma unroll 1
            for (int qb = 0; qb < 2; ++qb) {
                f32x4 gt_[8]; u32x2 vb_[8]; float bo_[8];
#pragma unroll
                for (int q8 = 0; q8 < 8; ++q8) {
                    const size_t t = (size_t)(b * S + c * RC + (qb * 8 + q8) * 4 + (lane >> 4));
                    gt_[q8] = *(const f32x4*)(GATE + t * RW + ch); vb_[q8] = *(const u32x2*)(VB + t * RW + ch); bo_[q8] = BONUS[t * RH + h];
                }
#pragma unroll
                for (int q8 = 0; q8 < 8; ++q8) {
                    const int tl = (qb * 8 + q8) * 4 + (lane >> 4);
                    const size_t t = (size_t)(b * S + c * RC + tl);
                    const f32x4 x = *(const f32x4*)(tile + tl * 68 + c4);
                    const float mean = row16_sum((x.x + x.y) + (x.z + x.w)) * (1.0f / 64.0f);
                    const f32x4 dl = x - mean;
                    const float var = row16_sum((dl.x * dl.x + dl.y * dl.y) + (dl.z * dl.z + dl.w * dl.w)) * (1.0f / 64.0f);
                    const float rstd = 1.0f / sqrtf(var + GN_EPS);
                    f32x4 y = dl * rstd * lg + lb;
                    y.x += bo_[q8] * bf_lo(vb_[q8].x); y.y += bo_[q8] * bf_hi(vb_[q8].x); y.z += bo_[q8] * bf_lo(vb_[q8].y); y.w += bo_[q8] * bf_hi(vb_[q8].y);
                    y = y * gt_[q8];
                    u32x2 ob; ob.x = pk2(y.x, y.y); ob.y = pk2(y.z, y.w);
                    *(u32x2*)(GRP + t * D + GW + ch) = ob;
                }
            }
        }
    }
    __syncthreads();
}

__device__ __forceinline__ void phase_mlstm_local(const Params& P, int l, unsigned char* smem, int wv, int bid, int nb) {
    PIN_S(bid); PIN_S(nb);
    ParamsPtr pp = PARAMS_PTR(P); PIN_S(pp); unsigned char* ws = pp->ws;
    const bf16_t* KT = (const bf16_t*)(ws + O_KT); const bf16_t* VT = (const bf16_t*)(ws + O_VT);
    const float* IG = (const float*)(ws + O_IG); const float* LF = (const float*)(ws + O_LF);
    float* CL = (float*)(ws + O_CL); float* NLb = (float*)(ws + O_NL); float* ML = (float*)(ws + O_ML); float* BL = (float*)(ws + O_BL);
    float* GVT = (float*)(ws + O_GVT); float* PMX = (float*)(ws + O_PMX); float* BCT = (float*)(ws + O_BCT);
    const int tid = phase_tid(wv), lane = tid & 63, wave = tid >> 6, col = lane & 15, g = lane >> 4;
    float* wts = (float*)smem + wave * 128;
    for (int u = bid * NWAVES + wave; u < 2 * NB * MH * NCH; u += nb * NWAVES) {
        const int c = u % NCH, h = (u / NCH) % MH, p = u / (NCH * MH), d = p / NB, b = p % NB;
        const int tc = d ? NCH - 1 - c : c, tok0 = b * S + tc * CH;
        const int i0 = d ? 127 - 2 * lane : 2 * lane, i1 = d ? i0 - 1 : i0 + 1;
        const size_t g0 = ((size_t)d * T + tok0 + i0) * MH + h, g1 = ((size_t)d * T + tok0 + i1) * MH + h;
        const float lf0 = LF[g0], lf1 = LF[g1], ig0 = IG[g0], ig1 = IG[g1];
        const float c1 = lf0 + lf1;
        float incl = c1;
#pragma unroll
        for (int o = 1; o < 64; o <<= 1) { const float tq = SHUP(incl, o, lane); if (lane >= o) incl += tq; }
        const float excl = incl - c1, bc0 = excl + lf0, bc1 = incl;
        const float blast = RDL(incl, 63);
        const float gv0 = ig0 - bc0, gv1 = ig1 - bc1, pl1 = fmaxf(gv0, gv1);
        float mincl = pl1;
#pragma unroll
        for (int o = 1; o < 64; o <<= 1) { const float tq = SHUP(mincl, o, lane); if (lane >= o) mincl = fmaxf(mincl, tq); }
        float mexcl = SHUP(mincl, 1, lane); if (lane == 0) mexcl = -INFINITY;
        const float pm0 = fmaxf(mexcl, gv0), pm1 = mincl;
        const float mloc = blast + RDL(mincl, 63);
        WAVE_SYNC();
        wts[i0] = fexp(blast + gv0 - mloc); wts[i1] = fexp(blast + gv1 - mloc);
        GVT[g0] = gv0; GVT[g1] = gv1; PMX[g0] = pm0; PMX[g1] = pm1; BCT[g0] = bc0; BCT[g1] = bc1;
        if (lane == 0) { ML[u] = mloc; BL[u] = blast; }
        WAVE_SYNC();
        const bf16_t* vbase = VT + ((size_t)(b * MH + h) * 64) * S + (size_t)tc * CH;
        const bf16_t* kbase = KT + ((size_t)(b * MH + h) * 64) * S + (size_t)tc * CH;
        const unsigned loff = (unsigned)(col * S + 8 * g);
        f32x4 acc[4][4];
#pragma unroll
        for (int a_ = 0; a_ < 4; ++a_)
#pragma unroll
            for (int b_ = 0; b_ < 4; ++b_) acc[a_][b_] = (f32x4){0.f, 0.f, 0.f, 0.f};
        float nsum[4] = {0.f, 0.f, 0.f, 0.f};
#pragma unroll 1
        for (int ks = 0; ks < 4; ++ks) {
            const int ii = ks * 32 + 8 * g;
            const f32x4 w0 = *(const f32x4*)(wts + ii), w1 = *(const f32x4*)(wts + ii + 4);
            bf16x8 af[4], bfk[4];
#pragma unroll
            for (int q = 0; q < 4; ++q) af[q] = *(const bf16x8*)(vbase + ((size_t)q * 16 * S + ks * 32) + loff);
#pragma unroll
            for (int q = 0; q < 4; ++q) {
                const u32x4 kr = *(const u32x4*)(kbase + ((size_t)q * 16 * S + ks * 32) + loff);
                f32x4 k0, k1;
                k0.x = bf_lo(kr.x) * w0.x; k0.y = bf_hi(kr.x) * w0.y; k0.z = bf_lo(kr.y) * w0.z; k0.w = bf_hi(kr.y) * w0.w;
                k1.x = bf_lo(kr.z) * w1.x; k1.y = bf_hi(kr.z) * w1.y; k1.z = bf_lo(kr.w) * w1.z; k1.w = bf_hi(kr.w) * w1.w;
                nsum[q] += (k0.x + k0.y) + (k0.z + k0.w) + (k1.x + k1.y) + (k1.z + k1.w);
                bfk[q] = cvt8(k0, k1);
            }
#pragma unroll
            for (int a_ = 0; a_ < 4; ++a_)
#pragma unroll
                for (int b_ = 0; b_ < 4; ++b_) acc[a_][b_] = MFMA16(af[a_], bfk[b_], acc[a_][b_]);
        }
        float* cbase = CL + (size_t)u * 4096;
        const unsigned coff = (unsigned)(4 * g * 64 + col);
#pragma unroll
        for (int b_ = 0; b_ < 4; ++b_) {
#pragma unroll
            for (int a_ = 0; a_ < 4; ++a_)
#pragma unroll
                for (int r = 0; r < 4; ++r) cbase[(a_ * 16 * 64 + r * 64 + b_ * 16) + coff] = acc[a_][b_][r];
            float ns = nsum[b_]; ns += SHX(ns, 16, lane); ns += SHX(ns, 32, lane);
            if (g == 0) NLb[(size_t)u * 64 + b_ * 16 + col] = ns;
        }
    }
    __syncthreads();
}

__device__ __forceinline__ void phase_mlstm_carry(const Params& P, int l, unsigned char* smem, int wv) {
    ParamsPtr pp = PARAMS_PTR(P); PIN_S(pp); unsigned char* ws = pp->ws; int bidx = (int)blockIdx.x, gdim = (int)gridDim.x; PIN_S(bidx); PIN_S(gdim);
    float* CL = (float*)(ws + O_CL); float* NLb = (float*)(ws + O_NL); const float* ML = (const float*)(ws + O_ML); const float* BL = (const float*)(ws + O_BL);
    float* MIN = (float*)(ws + O_MIN);
    const int total = 2 * NB * MH * 4160;
    const int tid = phase_tid(wv);
    for (int g = bidx * NTHREADS + tid; g < total; g += gdim * NTHREADS) {
        const int ph = g / 4160, e = g % 4160;
        float m = 0.f, val = 0.f;
        for (int c = 0; c < NCH; ++c) {
            const int base = ph * NCH + c;
            float* ptr = e < 4096 ? CL + (size_t)base * 4096 + e : NLb + (size_t)base * 64 + (e - 4096);
            const float loc = *ptr;
            *ptr = val;
            if (e == 0) MIN[base] = m;
            const float bl = BL[base], ml = ML[base];
            const float mn = fmaxf(bl + m, ml);
            val = expf(bl + m - mn) * val + expf(ml - mn) * loc;
            m = mn;
        }
    }
}

__device__ __forceinline__ void phase_mlstm_out(const Params& P, int l, unsigned char* smem, int wv) {
    ParamsPtr pp = PARAMS_PTR(P); PIN_S(pp); unsigned char* ws = pp->ws; int bidx = (int)blockIdx.x, gdim = (int)gridDim.x; PIN_S(bidx); PIN_S(gdim);
    const bf16_t* proj = (const bf16_t*)(ws + O_PROJ);
    const bf16_t* MQB = (const bf16_t*)(ws + O_MQB); const bf16_t* MKB = (const bf16_t*)(ws + O_MKB); const bf16_t* VT = (const bf16_t*)(ws + O_VT);
    const float* GVT = (const float*)(ws + O_GVT); const float* PMX = (const float*)(ws + O_PMX); const float* BCT = (const float*)(ws + O_BCT);
    const float* CL = (const float*)(ws + O_CL); const float* NLb = (const float*)(ws + O_NL); const float* MIN = (const float*)(ws + O_MIN);
    bf16_t* GRP = (bf16_t*)(ws + O_GRP);
    const float* mln_g = pp->in[20] + (size_t)l * MW;
    const int tid = phase_tid(wv), lane = tid & 63, wave = tid >> 6, col = lane & 15, g = lane >> 4;
    constexpr int KP = 72, VP = 136;
    bf16_t* Ks = (bf16_t*)smem;
    bf16_t* Vs = Ks + 128 * KP;
    float* gvs_ = (float*)(Vs + 64 * VP);
    for (int u = bidx; u < NB * MH * NCH; u += gdim) {
        const int tc = u % NCH, h = (u / NCH) % MH, b = u / (NCH * MH);
        const int tok0 = b * S + tc * CH, it = wave * 16 + col;
        __syncthreads();
        {
            u32x4 kb_[2], vb_[2];
#pragma unroll
            for (int q = 0; q < 2; ++q) {
                const int idx = tid + q * NTHREADS;
                kb_[q] = *(const u32x4*)(MKB + (size_t)(tok0 + (idx >> 3)) * MW + h * 64 + (idx & 7) * 8);
                vb_[q] = *(const u32x4*)(VT + ((size_t)(b * MH + h) * 64 + (idx >> 4)) * S + (size_t)tc * CH + (idx & 15) * 8);
            }
            float gq_ = 0.f;
            if (tid < 256) gq_ = GVT[((size_t)(tid >> 7) * T + tok0 + (tid & 127)) * MH + h];
#pragma unroll
            for (int q = 0; q < 2; ++q) {
                const int idx = tid + q * NTHREADS;
                *(u32x4*)(Ks + (idx >> 3) * KP + (idx & 7) * 8) = kb_[q];
                *(u32x4*)(Vs + (idx >> 4) * VP + (idx & 15) * 8) = vb_[q];
            }
            if (tid < 256) gvs_[tid] = gq_;
        }
        __syncthreads();
        const size_t trow = (size_t)(tok0 + it);
        bf16x8 bq[2];
#pragma unroll
        for (int ks = 0; ks < 2; ++ks) bq[ks] = *(const bf16x8*)(MQB + trow * MW + h * 64 + ks * 32 + 8 * g);
        f32x4 hs[4];
#pragma unroll
        for (int et = 0; et < 4; ++et) hs[et] = (f32x4){0.f, 0.f, 0.f, 0.f};
#pragma unroll
        for (int d = 0; d < 2; ++d) {
            const int cd = d ? NCH - 1 - tc : tc;
            const int su = ((d * NB + b) * MH + h) * NCH + cd;
            const size_t gt = ((size_t)d * T + trow) * MH + h;
            const float mst = MIN[su];
            const float mxt = fmaxf(PMX[gt], mst), mt = BCT[gt] + mxt, wint = fexp(mst - mxt);
            f32x4 num[4];
#pragma unroll
            for (int et = 0; et < 4; ++et) num[et] = (f32x4){0.f, 0.f, 0.f, 0.f};
            float den = 0.f;
            for (int sp = 0; sp < 4; ++sp) {
                if (d == 0 ? (2 * sp > wave) : (2 * sp + 1 < wave)) continue;
                float pw[8];
#pragma unroll
                for (int hf = 0; hf < 2; ++hf) {
                    const int st = 2 * sp + hf;
                    f32x4 sacc = (f32x4){0.f, 0.f, 0.f, 0.f};
#pragma unroll
                    for (int ks = 0; ks < 2; ++ks) sacc = MFMA16(*(const bf16x8*)(Ks + (st * 16 + col) * KP + ks * 32 + 8 * g), bq[ks], sacc);
                    const f32x4 g4 = *(const f32x4*)(gvs_ + d * 128 + st * 16 + 4 * g);
#pragma unroll
                    for (int r = 0; r < 4; ++r) {
                        const int is = st * 16 + 4 * g + r;
                        const bool ok = d == 0 ? (is <= it) : (is >= it);
                        const float pr = ok ? sacc[r] * fexp(g4[r] - mxt) : 0.f;
                        den += pr; pw[hf * 4 + r] = pr;
                    }
                }
                u32x4 pb; pb.x = pk2(pw[0], pw[1]); pb.y = pk2(pw[2], pw[3]); pb.z = pk2(pw[4], pw[5]); pb.w = pk2(pw[6], pw[7]);
                const bf16x8 bp = __builtin_bit_cast(bf16x8, pb);
#pragma unroll
                for (int et = 0; et < 4; ++et) {
                    const bf16_t* vp = Vs + (et * 16 + col) * VP + sp * 32 + 4 * g;
                    const u32x2 v0 = *(const u32x2*)vp, v1 = *(const u32x2*)(vp + 16);
                    u32x4 va; va.x = v0.x; va.y = v0.y; va.z = v1.x; va.w = v1.y;
                    num[et] = MFMA16(__builtin_bit_cast(bf16x8, va), bp, num[et]);
                }
            }
            den += SHX(den, 16, lane); den += SHX(den, 32, lane);
            f32x4 qc[4]; float qn = 0.f;
#pragma unroll
            for (int ks = 0; ks < 2; ++ks) {
                const float* np = NLb + (size_t)su * 64 + ks * 32 + 8 * g;
                const f32x4 n0 = *(const f32x4*)np, n1 = *(const f32x4*)(np + 4);
                const u32x4 qb = __builtin_bit_cast(u32x4, bq[ks]);
                qn += (bf_lo(qb.x) * n0.x + bf_hi(qb.x) * n0.y) + (bf_lo(qb.y) * n0.z + bf_hi(qb.y) * n0.w) + (bf_lo(qb.z) * n1.x + bf_hi(qb.z) * n1.y) + (bf_lo(qb.w) * n1.z + bf_hi(qb.w) * n1.w);
            }
            qn += SHX(qn, 16, lane); qn += SHX(qn, 32, lane);
#pragma unroll
            for (int et = 0; et < 4; ++et) {
                qc[et] = (f32x4){0.f, 0.f, 0.f, 0.f};
#pragma unroll
                for (int ks = 0; ks < 2; ++ks) {
                    const float* cp = CL + (size_t)su * 4096 + (size_t)(et * 16 + col) * 64 + ks * 32 + 8 * g;
                    qc[et] = MFMA16(cvt8(*(const f32x4*)cp, *(const f32x4*)(cp + 4)), bq[ks], qc[et]);
                }
            }
            const float dd = frcp(fmaxf(fabsf(den + wint * qn), fexp(-mt)));
#pragma unroll
            for (int et = 0; et < 4; ++et) hs[et] += (num[et] + wint * qc[et]) * dd;
        }
        float sm = 0.f;
#pragma unroll
        for (int et = 0; et < 4; ++et) sm += (hs[et].x + hs[et].y) + (hs[et].z + hs[et].w);
        sm += SHX(sm, 16, lane); sm += SHX(sm, 32, lane);
        const float mean = sm * (1.0f / 64.0f); float q = 0.f;
#pragma unroll
        for (int et = 0; et < 4; ++et) { const f32x4 dl = hs[et] - mean; q += (dl.x * dl.x + dl.y * dl.y) + (dl.z * dl.z + dl.w * dl.w); }
        q += SHX(q, 16, lane); q += SHX(q, 32, lane);
        const float rstd = 1.0f / sqrtf(q * (1.0f / 64.0f) + LN_EPS);
#pragma unroll
        for (int et = 0; et < 4; ++et) {
            const int c = h * 64 + et * 16 + 4 * g;
            const u32x2 ob_ = *(const u32x2*)(proj + trow * PLD + C_MW + 3 * MW + c); const f32x4 o4 = (f32x4){bf_lo(ob_.x), bf_hi(ob_.x), bf_lo(ob_.y), bf_hi(ob_.y)}, g4 = *(const f32x4*)(mln_g + c);
            const f32x4 y = (hs[et] - mean) * rstd * g4;
            u32x2 ob; ob.x = pk2(sigmoidf_(o4.x) * y.x, sigmoidf_(o4.y) * y.y); ob.y = pk2(sigmoidf_(o4.z) * y.z, sigmoidf_(o4.w) * y.w);
            *(u32x2*)(GRP + trow * D + GW + RW + c) = ob;
        }
    }
    __syncthreads();
}

__device__ __forceinline__ void phase_rwkv_post(const Params& P, int l, unsigned char* smem, int wv) {
    ParamsPtr pp = PARAMS_PTR(P); PIN_S(pp); unsigned char* ws = pp->ws; int bidx = (int)blockIdx.x, gdim = (int)gridDim.x; PIN_S(bidx); PIN_S(gdim);
    const float* SCAN = (const float*)(ws + O_SCAN); const float* VV = (const float*)(ws + O_VV); const float* GATE = (const float*)(ws + O_GATE);
    const float* BONUS = (const float*)(ws + O_BONUS); bf16_t* GRP = (bf16_t*)(ws + O_GRP);
    const float* rln_g = pp->in[15] + (size_t)l * RW; const float* rln_b = pp->in[16] + (size_t)l * RW;
    const int tid = phase_tid(wv), lane = tid & 63, wave = tid >> 6;
    const int gw = bidx * NWAVES + wave, ngw = NWAVES * gdim;
    for (int it = gw; it < T * RH; it += ngw) {
        const int t = it / RH, h = it % RH, c = h * 64 + lane;
        const size_t o = (size_t)t * RW + c;
        const float x = SCAN[o] + SCAN[(size_t)T * RW + o];
        const float mean = wave_sum(x, lane) * (1.0f / 64.0f);
        const float dl = x - mean;
        const float var = wave_sum(dl * dl, lane) * (1.0f / 64.0f);
        float y = dl / sqrtf(var + GN_EPS) * rln_g[c] + rln_b[c];
        y += BONUS[(size_t)t * RH + h] * VV[o];
        GRP[(size_t)t * D + GW + c] = (bf16_t)f2bf(y * GATE[o]);
    }
}

__device__ __forceinline__ void phase_ln1_router(const Params& P, int l, unsigned char* smem, int wv) {
    ParamsPtr pp = PARAMS_PTR(P); PIN_S(pp); unsigned char* ws = pp->ws; int bidx = (int)blockIdx.x, gdim = (int)gridDim.x; PIN_S(bidx); PIN_S(gdim);
    const float* xin = l == 0 ? pp->in[0] : (const float*)(ws + O_XA);
    const float* MIX = (const float*)(ws + O_MIX); float* X1 = (float*)(ws + O_X1);
    int* TOPI = (int*)(ws + O_TOPI); float* TOPG = (float*)(ws + O_TOPG); int* RANK = (int*)(ws + O_RANK); bf16_t* X1B = (bf16_t*)(ws + O_X1B);
    int* BCNT = (int*)(ws + O_BCNT);
    const float* g1 = pp->in[22] + (size_t)l * D; const float* b1 = pp->in[23] + (size_t)l * D;
    const float* rw = pp->in[24] + (size_t)l * D * NE; const float* rb = pp->in[25] + (size_t)l * NE;
    const bf16_t* RWT = (const bf16_t*)(ws + O_RWT) + (size_t)l * 2 * NE * D;
    const int tid = phase_tid(wv), lane = tid & 63, wave = tid >> 6, col = lane & 15, g = lane >> 4;
    float* lgs = (float*)smem;
    int* stopi = (int*)(smem + 8192);
    for (int tile = bidx; tile < T / 64; tile += gdim) {
        __syncthreads();
        {
            f32x4 xa[4], xm[4];
#define LN1_LOAD(tt_) do { _Pragma("unroll") for (int j = 0; j < 4; ++j) { const int c = j * 256 + lane * 4; xa[j] = *(const f32x4*)(xin + (size_t)(tt_) * D + c); xm[j] = *(const f32x4*)(MIX + (size_t)(tt_) * D + c); } } while (0)
            LN1_LOAD(tile * 64 + wave * 8);
#pragma unroll 1
            for (int ti8 = 0; ti8 < 8; ++ti8) {
                const int t = tile * 64 + wave * 8 + ti8;
                float v[16]; float sm = 0.f;
#pragma unroll
                for (int j = 0; j < 4; ++j) {
                    v[j * 4 + 0] = ALPHA * xa[j].x + xm[j].x; v[j * 4 + 1] = ALPHA * xa[j].y + xm[j].y; v[j * 4 + 2] = ALPHA * xa[j].z + xm[j].z; v[j * 4 + 3] = ALPHA * xa[j].w + xm[j].w;
                    sm += (v[j * 4] + v[j * 4 + 1]) + (v[j * 4 + 2] + v[j * 4 + 3]);
                }
                if (ti8 < 7) LN1_LOAD(t + 1);
                const float mean = wave_sum_fast(sm, lane) * (1.0f / D); float q = 0.f;
#pragma unroll
                for (int j = 0; j < 16; ++j) { const float dl = v[j] - mean; q += dl * dl; }
                const float rstd = 1.0f / sqrtf(wave_sum_fast(q, lane) * (1.0f / D) + LN_EPS);
#pragma unroll
                for (int j = 0; j < 4; ++j) {
                    const int c = j * 256 + lane * 4;
                    const f32x4 gg = *(const f32x4*)(g1 + c), bb = *(const f32x4*)(b1 + c);
                    f32x4 o;
                    o.x = (v[j * 4 + 0] - mean) * rstd * gg.x + bb.x; o.y = (v[j * 4 + 1] - mean) * rstd * gg.y + bb.y;
                    o.z = (v[j * 4 + 2] - mean) * rstd * gg.z + bb.z; o.w = (v[j * 4 + 3] - mean) * rstd * gg.w + bb.w;
                    *(f32x4*)(X1 + (size_t)t * D + c) = o;
                    u32x2 ob; ob.x = pk2(o.x, o.y); ob.y = pk2(o.z, o.w); *(u32x2*)(X1B + (size_t)t * D + c) = ob;
                }
            }
#undef LN1_LOAD
        }
        __syncthreads();
        {
            const float* xr = X1 + (size_t)(tile * 64 + (wave >> 1) * 16 + col) * D + 8 * g;
            const bf16_t* wh = RWT + (size_t)((wave & 1) * 16 + col) * D + 8 * g; const bf16_t* wl = wh + (size_t)NE * D;
            f32x4 acc = (f32x4){0.f, 0.f, 0.f, 0.f};
#pragma unroll 4
            for (int ks = 0; ks < 32; ++ks) {
                const f32x4 x0 = *(const f32x4*)(xr + ks * 32), x1 = *(const f32x4*)(xr + ks * 32 + 4);
                const bf16x8 bh = *(const bf16x8*)(wh + ks * 32), bl = *(const bf16x8*)(wl + ks * 32);
                const bf16x8 ah = cvt8(x0, x1);
                const u32x4 ahu = __builtin_bit_cast(u32x4, ah);
                f32x4 r0, r1;
                r0.x = x0.x - bf_lo(ahu.x); r0.y = x0.y - bf_hi(ahu.x); r0.z = x0.z - bf_lo(ahu.y); r0.w = x0.w - bf_hi(ahu.y);
                r1.x = x1.x - bf_lo(ahu.z); r1.y = x1.y - bf_hi(ahu.z); r1.z = x1.z - bf_lo(ahu.w); r1.w = x1.w - bf_hi(ahu.w);
                const bf16x8 al = cvt8(r0, r1);
                acc = MFMA16(ah, bh, acc); acc = MFMA16(ah, bl, acc); acc = MFMA16(al, bh, acc);
            }
            const float rbv = rb[(wave & 1) * 16 + col];
#pragma unroll
            for (int r = 0; r < 4; ++r) lgs[((wave >> 1) * 16 + 4 * g + r) * NE + (wave & 1) * 16 + col] = acc[r] + rbv;
        }
        __syncthreads();
        if (tid < 64) {
            const float* lp = lgs + tid * NE; const int t = tile * 64 + tid;
            float tv[4]; int ti[4];
#pragma unroll
            for (int k = 0; k < 4; ++k) { tv[k] = -INFINITY; ti[k] = 0; }
            for (int e = 0; e < NE; ++e) {
                const float x = lp[e];
                if (x > tv[3]) {
                    if (x > tv[0]) { tv[3] = tv[2]; ti[3] = ti[2]; tv[2] = tv[1]; ti[2] = ti[1]; tv[1] = tv[0]; ti[1] = ti[0]; tv[0] = x; ti[0] = e; }
                    else if (x > tv[1]) { tv[3] = tv[2]; ti[3] = ti[2]; tv[2] = tv[1]; ti[2] = ti[1]; tv[1] = x; ti[1] = e; }
                    else if (x > tv[2]) { tv[3] = tv[2]; ti[3] = ti[2]; tv[2] = x; ti[2] = e; }
                    else { tv[3] = x; ti[3] = e; }
                }
            }
            const float e1 = expf(tv[1] - tv[0]), e2 = expf(tv[2] - tv[0]), e3 = expf(tv[3] - tv[0]);
            const float inv = 1.0f / (1.0f + e1 + e2 + e3);
            *(f32x4*)(TOPG + (size_t)t * 4) = (f32x4){inv, e1 * inv, e2 * inv, e3 * inv};
#pragma unroll
            for (int k = 0; k < 4; ++k) { TOPI[(size_t)t * 4 + k] = ti[k]; stopi[tid * 4 + k] = ti[k]; }
        }
        __syncthreads();
        if (tid < 256) { const int e = stopi[tid]; int r = 0; for (int a2 = 0; a2 < tid; ++a2) r += (stopi[a2] == e) ? 1 : 0; RANK[(size_t)tile * 256 + tid] = r; }
        else if (tid < 256 + NE) { const int e = tid - 256; int cnt = 0; for (int a2 = 0; a2 < 256; ++a2) cnt += (stopi[a2] == e) ? 1 : 0; BCNT[tile * NE + e] = cnt; }
    }
    __syncthreads();
}

__device__ __forceinline__ void moe_offsets(int* sh, const int* CNT, int tid) {
    if (tid == 0) {
        int acc = 0;
        for (int e = 0; e < NE; ++e) { const int c = (int)CNT[e]; sh[e] = c; sh[32 + e] = acc; acc += (c + MOEB - 1) / MOEB * MOEB; sh[64 + e] = acc; }
    }
    __syncthreads();
}
__device__ __forceinline__ int moe_expert_of_row(const int* sh, int r) {
    int e = -1;
    for (int i = 0; i < NE; ++i) if (r >= sh[32 + i] && r < sh[64 + i]) e = i;
    return e;
}

__device__ __forceinline__ void phase_scatter(const Params& P, int l, unsigned char* smem, int wv) {
    ParamsPtr pp = PARAMS_PTR(P); PIN_S(pp); unsigned char* ws = pp->ws; int bidx = (int)blockIdx.x, gdim = (int)gridDim.x; PIN_S(bidx); PIN_S(gdim);
    const int tid = phase_tid(wv);
    const int* TOPI = (const int*)(ws + O_TOPI); const int* RANK = (const int*)(ws + O_RANK); int* SLOT = (int*)(ws + O_SLOT); int* ROWT = (int*)(ws + O_ROWT);
    const int* BCNT = (const int*)(ws + O_BCNT); int* CNTF = (int*)(ws + O_CNTF);
    int* sh = (int*)smem;
    int* part = sh + 96;
    int* tot = part + 512;
    int* base = tot + 32;
    constexpr int NT = T / 64;
    const int e = tid & 31, pt = tid >> 5;
    { int sacc = 0; for (int tl = pt; tl < NT; tl += 16) sacc += BCNT[tl * NE + e]; part[pt * 32 + e] = sacc; }
    __syncthreads();
    if (tid < 32) { int sacc = 0; for (int q = 0; q < 16; ++q) sacc += part[q * 32 + tid]; tot[tid] = sacc; if (bidx == 0) CNTF[tid] = sacc; }
    __syncthreads();
    moe_offsets(sh, tot, tid);
    for (int ee = bidx; ee < NE; ee += gdim)
        for (int r = sh[32 + ee] + sh[ee] + tid; r < sh[64 + ee]; r += NTHREADS) ROWT[r] = 0;
    for (int tile = bidx; tile < NT; tile += gdim) {
        __syncthreads();
        { int sacc = 0; for (int tl = pt; tl < tile; tl += 16) sacc += BCNT[tl * NE + e]; part[pt * 32 + e] = sacc; }
        __syncthreads();
        if (tid < 32) { int sacc = sh[32 + tid]; for (int q = 0; q < 16; ++q) sacc += part[q * 32 + tid]; base[tid] = sacc; }
        __syncthreads();
        if (tid < 256) { const int a = tile * 256 + tid, dest = base[TOPI[a]] + RANK[a]; SLOT[a] = dest; ROWT[dest] = a >> 2; }
    }
    __syncthreads();
}

template <int WHICH>
__device__ __forceinline__ void phase_moe_gemm(const Params& P, int l, unsigned char* smem, int wv) {
    ParamsPtr pp = PARAMS_PTR(P); PIN_S(pp); unsigned char* ws = pp->ws; int bidx = (int)blockIdx.x, gdim = (int)gridDim.x; PIN_S(bidx); PIN_S(gdim);
    const int tid = phase_tid(wv);
    const int* CNT = (const int*)(ws + O_CNTF);
    int* sh = (int*)(smem + 131072);
    int* rbe = sh + 96;
    moe_offsets(sh, CNT, tid);
    const int nrb = sh[64 + NE - 1] / MOEB;
    for (int rb = tid; rb < nrb; rb += NTHREADS) rbe[rb] = moe_expert_of_row(sh, rb * MOEB);
    __syncthreads();
    pg8::MoeOrderT<WHICH == 1> S;
    S.K = 1024; S.G_ = gdim; S.c = bidx; S.rbe = rbe; S.rowmap = (const int*)(ws + O_ROWT);
    if (WHICH == 1) {
        S.A = (const char*)(ws + O_X1B); S.Wt = (const char*)(ws + O_W1) + (size_t)l * NE * 2 * DFF * D * 2; S.estride = (size_t)2 * DFF * D * 2; S.nN = 2 * DFF / 256; S.nwg = nrb * S.nN;
        pg8::EpiSwiglu E{(bf16_t*)(ws + O_ACT), pp->in[27] + (size_t)l * NE * 2 * DFF};
        pg8::gemm_phase<pg8::EpiSwiglu, pg8::MoeOrderT<WHICH == 1>>((LAS unsigned char*)smem, 1024, S, E, tid);
    } else {
        S.A = (const char*)(ws + O_ACT); S.Wt = (const char*)(ws + O_W2) + (size_t)l * NE * D * DFF * 2; S.estride = (size_t)D * DFF * 2; S.nN = D / 256; S.nwg = nrb * S.nN;
        pg8::EpiBf16Bias E{(bf16_t*)(ws + O_YS), D, pp->in[29] + (size_t)l * NE * D, D};
        pg8::gemm_phase<pg8::EpiBf16Bias, pg8::MoeOrderT<WHICH == 1>>((LAS unsigned char*)smem, 1024, S, E, tid);
    }
    __syncthreads();
}

__device__ __forceinline__ void phase_combine_ln2(const Params& P, int l, unsigned char* smem, int wv) {
    ParamsPtr pp = PARAMS_PTR(P); PIN_S(pp); unsigned char* ws = pp->ws; int bidx = (int)blockIdx.x, gdim = (int)gridDim.x; PIN_S(bidx); PIN_S(gdim);
    const float* X1 = (const float*)(ws + O_X1); const bf16_t* YS = (const bf16_t*)(ws + O_YS); bf16_t* XB = (bf16_t*)(ws + O_XB);
    const int* SLOT = (const int*)(ws + O_SLOT); const float* TOPG = (const float*)(ws + O_TOPG);
    float* xo = l == NL - 1 ? pp->out : (float*)(ws + O_XA);
    const float* g2 = pp->in[30] + (size_t)l * D; const float* b2 = pp->in[31] + (size_t)l * D;
    const int tid = phase_tid(wv), lane = tid & 63, wave = tid >> 6;
    const int gw = bidx * NWAVES + wave, ngw = NWAVES * gdim;
    u32x4 sl_n = (u32x4){0u, 0u, 0u, 0u}; f32x4 gg_n = (f32x4){0.f, 0.f, 0.f, 0.f};
    f32x4 xa_n[4]; u32x2 ys_n[4][4]; f32x4 gg_c = (f32x4){0.f, 0.f, 0.f, 0.f};
    const f32x4 lg[4] = {*(const f32x4*)(g2 + lane * 4), *(const f32x4*)(g2 + 256 + lane * 4), *(const f32x4*)(g2 + 512 + lane * 4), *(const f32x4*)(g2 + 768 + lane * 4)};
    const f32x4 lb[4] = {*(const f32x4*)(b2 + lane * 4), *(const f32x4*)(b2 + 256 + lane * 4), *(const f32x4*)(b2 + 512 + lane * 4), *(const f32x4*)(b2 + 768 + lane * 4)};
#define CB_META(tt_) do { sl_n = *(const u32x4*)(SLOT + (size_t)(tt_) * 4); gg_n = *(const f32x4*)(TOPG + (size_t)(tt_) * 4); } while (0)
#define CB_ROWS(tt_) do { _Pragma("unroll") for (int j = 0; j < 4; ++j) { const int c = j * 256 + lane * 4; xa_n[j] = *(const f32x4*)(X1 + (size_t)(tt_) * D + c); \
        ys_n[0][j] = *(const u32x2*)(YS + (size_t)sl_n.x * D + c); ys_n[1][j] = *(const u32x2*)(YS + (size_t)sl_n.y * D + c); ys_n[2][j] = *(const u32x2*)(YS + (size_t)sl_n.z * D + c); ys_n[3][j] = *(const u32x2*)(YS + (size_t)sl_n.w * D + c); } gg_c = gg_n; } while (0)
    if (gw < T) { CB_META(gw); CB_ROWS(gw); if (gw + ngw < T) CB_META(gw + ngw); }
    for (int t = gw; t < T; t += ngw) {
        float v[16]; float sm = 0.f;
        const float gk[4] = {gg_c.x, gg_c.y, gg_c.z, gg_c.w};
#pragma unroll
        for (int j = 0; j < 4; ++j) {
            const f32x4 a = xa_n[j];
            f32x4 y = (f32x4){0.f, 0.f, 0.f, 0.f};
#pragma unroll
            for (int k = 0; k < 4; ++k) { const u32x2 yk = ys_n[k][j]; y.x += gk[k] * bf_lo(yk.x); y.y += gk[k] * bf_hi(yk.x); y.z += gk[k] * bf_lo(yk.y); y.w += gk[k] * bf_hi(yk.y); }
            v[j * 4 + 0] = ALPHA * a.x + y.x; v[j * 4 + 1] = ALPHA * a.y + y.y; v[j * 4 + 2] = ALPHA * a.z + y.z; v[j * 4 + 3] = ALPHA * a.w + y.w;
            sm += (v[j * 4] + v[j * 4 + 1]) + (v[j * 4 + 2] + v[j * 4 + 3]);
        }
        if (t + ngw < T) { CB_ROWS(t + ngw); if (t + 2 * ngw < T) CB_META(t + 2 * ngw); }
        const float mean = wave_sum_fast(sm, lane) * (1.0f / D); float q = 0.f;
#pragma unroll
        for (int j = 0; j < 16; ++j) { const float dl = v[j] - mean; q += dl * dl; }
        const float rstd = 1.0f / sqrtf(wave_sum_fast(q, lane) * (1.0f / D) + LN_EPS);
#pragma unroll
        for (int j = 0; j < 4; ++j) {
            const int c = j * 256 + lane * 4;
            f32x4 o;
            o.x = (v[j * 4 + 0] - mean) * rstd * lg[j].x + lb[j].x; o.y = (v[j * 4 + 1] - mean) * rstd * lg[j].y + lb[j].y;
            o.z = (v[j * 4 + 2] - mean) * rstd * lg[j].z + lb[j].z; o.w = (v[j * 4 + 3] - mean) * rstd * lg[j].w + lb[j].w;
            *(f32x4*)(xo + (size_t)t * D + c) = o;
            if (l != NL - 1) { u32x2 ob; ob.x = pk2(o.x, o.y); ob.y = pk2(o.z, o.w); *(u32x2*)(XB + (size_t)t * D + c) = ob; }
        }
    }
#undef CB_META
#undef CB_ROWS
}

__device__ __forceinline__ void phase_inproj(const Params& P, int l, unsigned char* smem, int wv) {
    ParamsPtr pp = PARAMS_PTR(P); PIN_S(pp); unsigned char* ws = pp->ws; int bidx = (int)blockIdx.x, gdim = (int)gridDim.x; PIN_S(bidx); PIN_S(gdim);
    const int tid = phase_tid(wv);
    pg8::DenseOrder S; S.init(ws + O_XB, (const bf16_t*)(ws + O_WIN) + (size_t)l * PLD * D, T, PLD, D, gdim, bidx);
    pg8::EpiProj E{(bf16_t*)(ws + O_PROJ), PLD, (float*)(ws + O_PROJG), PLD / 256 - 1};
    pg8::gemm_phase<pg8::EpiProj, pg8::DenseOrder>((LAS unsigned char*)smem, D, S, E, tid);
    __syncthreads();
}
__device__ __forceinline__ void phase_outproj(const Params& P, int l, unsigned char* smem, int wv) {
    ParamsPtr pp = PARAMS_PTR(P); PIN_S(pp); unsigned char* ws = pp->ws; int bidx = (int)blockIdx.x, gdim = (int)gridDim.x; PIN_S(bidx); PIN_S(gdim);
    const int tid = phase_tid(wv);
    pg8::DenseOrder S; S.init(ws + O_GRP, (const bf16_t*)(ws + O_WOUT) + (size_t)l * D * D, T, D, D, gdim, bidx);
    pg8::EpiF32 E{(float*)(ws + O_MIX), D};
    pg8::gemm_phase<pg8::EpiF32, pg8::DenseOrder>((LAS unsigned char*)smem, D, S, E, tid);
    __syncthreads();
}

#ifndef EMU
#define XB_TMO      128
#define XB_XCNT(j)  (256  + 64 * (j))
#define XB_XSUB(j)  (1280 + 64 * (j))
#define XB_XGEN(j)  (2304 + 64 * (j))
#define XB_TOP      3328
#define XB_TOPGEN   3392
#define XCD_BAR_WORDS 3456
#define XB_SPIN_CAP (1u << 25)
__device__ __forceinline__ unsigned xb_ld(unsigned* p)              { return __hip_atomic_load(p, __ATOMIC_RELAXED, __HIP_MEMORY_SCOPE_AGENT); }
__device__ __forceinline__ unsigned xb_add(unsigned* p, unsigned v) { return __hip_atomic_fetch_add(p, v, __ATOMIC_RELAXED, __HIP_MEMORY_SCOPE_AGENT); }
__device__ __forceinline__ unsigned xb_xcc_id() { return (unsigned)__builtin_amdgcn_s_getreg((3 << 11) | 20) & 0xFu; }
#define XB_SPIN(cond, bar) do { unsigned _sp = 0; while (cond) { __builtin_amdgcn_s_sleep(1); \
    if ((++_sp & 255u) == 0u) { if (xb_ld(&(bar)[XB_TMO])) break; if (_sp > XB_SPIN_CAP) { atomicAdd(&(bar)[XB_TMO], 1u); break; } } } } while (0)
struct XcdBarrier { unsigned* bar; unsigned x; volatile LAS unsigned* st; };
__device__ __forceinline__ XcdBarrier xcd_barrier_post(unsigned* bar, volatile LAS unsigned* st) {
    XcdBarrier b; b.bar = bar; b.x = xb_xcc_id(); b.st = st;
    if (threadIdx.x == 0) (void)xb_add(&bar[XB_XCNT(b.x)], 1u);
    return b;
}
__device__ __forceinline__ void xcd_barrier_complete(unsigned* bar, unsigned x, unsigned& nloc, unsigned& nx) {
    const unsigned G = gridDim.x * gridDim.y * gridDim.z;
    unsigned sum, cnt, mine, sp = 0u;
    for (;;) {
        sum = 0u; cnt = 0u; mine = 0u;
#pragma unroll
        for (unsigned j = 0; j < 16; ++j) { const unsigned c = xb_ld(&bar[XB_XCNT(j)]); sum += c; cnt += (c > 0u) ? 1u : 0u; mine = (j == x) ? c : mine; }
        if (sum == G) break;
        __builtin_amdgcn_s_sleep(1);
        if ((++sp & 255u) == 0u) { if (xb_ld(&bar[XB_TMO])) break; if (sp > XB_SPIN_CAP) { atomicAdd(&bar[XB_TMO], 1u); break; } }
    }
    nloc = mine > 0u ? mine : 1u; nx = cnt > 0u ? cnt : 1u;
}
__device__ __forceinline__ void xcd_barrier(const XcdBarrier& b) {
    asm volatile("s_waitcnt vmcnt(0)" ::: "memory");
    __syncthreads();
    if (threadIdx.x == 0) {
        unsigned* bar = b.bar;
        __builtin_amdgcn_s_waitcnt(0);
        unsigned nloc = b.st[0], nx = b.st[1];
        if (nloc == 0u) { xcd_barrier_complete(bar, b.x, nloc, nx); b.st[0] = nloc; b.st[1] = nx; }
        const unsigned old = xb_add(&bar[XB_XSUB(b.x)], 1u);
        const unsigned gen = old / nloc;
        if (old + 1u == (gen + 1u) * nloc) {
            __builtin_amdgcn_fence(__ATOMIC_RELEASE, "agent");
            asm volatile("s_waitcnt vmcnt(0)" ::: "memory");
            const unsigned og = xb_add(&bar[XB_TOP], 1u);
            const unsigned tg = og / nx;
            if (og + 1u == (tg + 1u) * nx) xb_add(&bar[XB_TOPGEN], 1u);
            else XB_SPIN(xb_ld(&bar[XB_TOPGEN]) == tg, bar);
            __builtin_amdgcn_fence(__ATOMIC_ACQUIRE, "agent");
            xb_add(&bar[XB_XGEN(b.x)], 1u);
            asm volatile("s_waitcnt vmcnt(0)" ::: "memory");
        } else {
            XB_SPIN(xb_ld(&bar[XB_XGEN(b.x)]) == gen, bar);
            __builtin_amdgcn_fence(__ATOMIC_ACQUIRE, "agent");
            asm volatile("s_waitcnt vmcnt(0)" ::: "memory");
        }
    }
    __syncthreads();
}
#endif

__global__ void __launch_bounds__(512, 2) mk_fwd(Params P) {
#ifdef EMU
    unsigned char* smem = g_blk->lds;
#else
    extern __shared__ __attribute__((aligned(16))) unsigned char smem[];
    volatile LAS unsigned* bst = (volatile LAS unsigned*)(smem + LDS_BYTES - 16);
    if (threadIdx.x == 0) { bst[0] = 0u; bst[1] = 0u; bst[2] = 0u; bst[3] = 0u; }
    __syncthreads();
    XcdBarrier bar; bar.bar = (unsigned*)P.ws + CW_BAR; bar.x = 0; bar.st = bst;
    if (P.ph_hi - P.ph_lo > 1) bar = xcd_barrier_post((unsigned*)P.ws + CW_BAR, bst);
#endif
    const int lo = P.ph_lo, hi = P.ph_hi;
#ifdef EMU
    const int wv = (int)threadIdx.x >> 6;
#else
    const int wv = RFL((int)threadIdx.x >> 6);
#endif
#ifdef EMU
#define SEAM(id) do {} while (0)
#else
#define SEAM(id) do { if ((id) + 1 < hi) xcd_barrier(bar); } while (0)
#endif
#ifndef MK_ONLY_PHASE
#define MK_ONLY_PHASE -1
#endif
#ifndef MK_DUP_MASK
#define MK_DUP_MASK 0
#endif
#define PHG(kc, id, ...) do { if (MK_ONLY_PHASE < 0 || MK_ONLY_PHASE == (kc)) { const int id_ = (id); if (id_ >= lo && id_ < hi) { if ((MK_DUP_MASK >> (kc)) & 1) { __VA_ARGS__; SEAM(id_ - 1); } __VA_ARGS__; SEAM(id_); } } } while (0)
#define PH(k, ...) PHG(1 + (k), 1 + l * NPH + (k), __VA_ARGS__)
    PHG(0, 0, phase_prologue(P, smem, wv));
    for (int l = 0; l < NL; ++l) {
        PH(0, phase_inproj(P, l, smem, wv));
        PH(1, phase_prep(P, l, smem, wv));
#if MK_RWKV_CHUNKED
        PH(2, { phase_rwkv_pre(P, l, smem, wv); phase_mlstm_local(P, l, smem, wv, (int)blockIdx.x, (int)gridDim.x); });
        PH(3, { phase_rwkv_seq(P, l, smem, wv); phase_mlstm_carry(P, l, smem, wv); });
        PH(4, { phase_rwkv_out(P, l, smem, wv); phase_mlstm_out(P, l, smem, wv); phase_gmlp_mix(P, l, smem, wv, (int)blockIdx.x, (int)gridDim.x); });
#else
        PH(2, { const int G_ = (int)gridDim.x, NSC = 2 * NB * RH * 4;
                if (G_ >= NSC + 32) { if ((int)blockIdx.x < NSC) phase_rwkv_scan(P, l, smem, wv, (int)blockIdx.x, NSC);
                                      else phase_mlstm_local(P, l, smem, wv, (int)blockIdx.x - NSC, G_ - NSC); }
                else { phase_rwkv_scan(P, l, smem, wv, (int)blockIdx.x, G_); phase_mlstm_local(P, l, smem, wv, (int)blockIdx.x, G_); } });
        PH(3, phase_mlstm_carry(P, l, smem, wv));
        PH(4, { phase_mlstm_out(P, l, smem, wv); phase_gmlp_mix(P, l, smem, wv, (int)blockIdx.x, (int)gridDim.x); phase_rwkv_post(P, l, smem, wv); });
#endif
        PH(5, phase_outproj(P, l, smem, wv));
        PH(6, phase_ln1_router(P, l, smem, wv));
        PH(7, phase_scatter(P, l, smem, wv));
        PH(8, phase_moe_gemm<1>(P, l, smem, wv));
        PH(9, phase_moe_gemm<2>(P, l, smem, wv));
        PH(10, phase_combine_ln2(P, l, smem, wv));
    }
#undef PHG
#undef PH
#undef SEAM
}

}

#ifndef EMU
extern "C" void kernel_launch(void* const* d_in, const int* in_sizes, int n_in, void* d_out, int out_size, void* d_ws, size_t ws_size, hipStream_t stream) {
    using namespace mk;
    static int grid = 0;
    if (grid == 0) {
        if (n_in != 32 || out_size != T * D || ws_size < WS_END) { fprintf(stderr, "kernel_launch: unexpected shapes (n_in %d out %d ws %zu need %zu)\n", n_in, out_size, ws_size, (size_t)WS_END); grid = -1; return; }
        int dev = 0, cus = 0;
        if (hipGetDevice(&dev) != hipSuccess || hipDeviceGetAttribute(&cus, hipDeviceAttributeMultiprocessorCount, dev) != hipSuccess) { grid = -1; return; }
        if (hipFuncSetAttribute((const void*)mk_fwd, hipFuncAttributeMaxDynamicSharedMemorySize, LDS_BYTES) != hipSuccess) { fprintf(stderr, "kernel_launch: hipFuncSetAttribute failed\n"); grid = -1; return; }
        int per_cu = 0;
        (void)hipOccupancyMaxActiveBlocksPerMultiprocessor(&per_cu, (const void*)mk_fwd, NTHREADS, LDS_BYTES);
        (void)hipGetLastError();
        grid = cus;
    }
    if (grid < 0) return;
    (void)hipMemsetAsync(d_ws, 0, CTL_BYTES, stream);
    Params p{};
    for (int i = 0; i < 32; ++i) p.in[i] = (const float*)d_in[i];
    p.out = (float*)d_out; p.ws = (unsigned char*)d_ws;
#if MK_ONE_LAUNCH
    p.ph_lo = 0; p.ph_hi = 1 + NL * NPH;
    hipLaunchKernelGGL(mk_fwd, dim3(grid), dim3(NTHREADS), LDS_BYTES, stream, p);
#else
    for (int id = 0; id < 1 + NL * NPH; ++id) {
        p.ph_lo = id; p.ph_hi = id + 1;
        hipLaunchKernelGGL(mk_fwd, dim3(grid), dim3(NTHREADS), LDS_BYTES, stream, p);
    }
#endif
}
#endif
```

```cpp
#ifndef EMU
#include <hip/hip_runtime.h>
#endif
#include <cstdio>
#include <cstdint>
#include <cmath>

#ifndef CFG_BATCH
#define CFG_BATCH 4
#endif
#ifndef CFG_SEQ
#define CFG_SEQ 4096
#endif
#ifndef CFG_LAYERS
#define CFG_LAYERS 4
#endif
#ifndef MK_RWKV_CHUNKED
#define MK_RWKV_CHUNKED 1
#endif
#ifndef MK_PROBE
#define MK_PROBE 0
#endif
#ifndef MK_ONE_LAUNCH
#define MK_ONE_LAUNCH 1
#endif

namespace mk {
constexpr int NB = CFG_BATCH, S = CFG_SEQ, T = NB * S, NL = CFG_LAYERS, D = 1024;
constexpr int GW = 256, RW = 384, MW = 384, HD = 64, GH = 4, RH = 6, MH = 6, CH = 128, NCH = S / CH;
constexpr int PIN = 3480, PLD = 3584, RPROJ = 1408;
constexpr int C_RW = 512, C_MW = 1920;
constexpr int NE = 32, TOPK = 4, DFF = 1024, MOEB = 256;
constexpr int NROWS = (T * TOPK / MOEB + NE) * MOEB;
constexpr float LN_EPS = 1e-5f, GN_EPS = 64e-5f;
constexpr float ALPHA = 1.6817928305074290f;
constexpr int NTHREADS = 512, NWAVES = 8;
constexpr int LDS_BYTES = 160 * 1024;
constexpr int NPH = 11;

typedef float f32x4 __attribute__((ext_vector_type(4)));
typedef unsigned u32x4 __attribute__((ext_vector_type(4)));
typedef unsigned u32x2 __attribute__((ext_vector_type(2)));
typedef short bf16x8 __attribute__((ext_vector_type(8)));
typedef unsigned short bf16_t;

constexpr size_t al(size_t x) { return (x + 255) & ~(size_t)255; }
constexpr size_t CTL_BYTES = 1u << 20;
constexpr size_t O_XA = CTL_BYTES;
constexpr size_t O_XB = O_XA + al((size_t)T * D * 4);
constexpr size_t O_X1 = O_XB + al((size_t)T * D * 2);
constexpr size_t O_X1B = O_X1 + al((size_t)T * D * 4);
constexpr size_t O_PROJ = O_X1B + al((size_t)T * D * 2);
constexpr size_t O_PROJG = O_PROJ + al((size_t)T * PLD * 2);
constexpr size_t O_MIX = O_PROJ + al((size_t)T * PLD * 4);
constexpr size_t O_GRP = O_MIX + al((size_t)T * D * 4);
constexpr size_t O_UG = O_GRP + al((size_t)T * D * 2);
constexpr size_t O_VN = O_UG + al((size_t)T * GW * 4);
constexpr size_t O_RR = O_VN + al((size_t)T * GW * 4);
constexpr size_t O_VV = O_RR + al((size_t)T * RW * 4);
constexpr size_t O_KK = O_VV + al((size_t)T * RW * 4);
constexpr size_t O_DEC = O_KK + al((size_t)T * RW * 4);
constexpr size_t O_KD = O_DEC + al((size_t)2 * T * RW * 4);
constexpr size_t O_ICLR = O_KD + al((size_t)2 * T * RW * 4);
constexpr size_t O_GATE = O_ICLR + al((size_t)2 * T * RW * 4);
constexpr size_t O_BONUS = O_GATE + al((size_t)T * RW * 4);
constexpr size_t O_SCAN = O_BONUS + al((size_t)T * RH * 4);
constexpr size_t O_MQ = O_SCAN + al((size_t)2 * T * RW * 4);
constexpr size_t O_MK = O_MQ + al((size_t)T * MW * 4);
constexpr size_t O_IG = O_MK + al((size_t)T * MW * 4);
constexpr size_t O_LF = O_IG + al((size_t)2 * T * MH * 4);
constexpr size_t O_CL = O_LF + al((size_t)2 * T * MH * 4);
constexpr size_t O_NL = O_CL + al((size_t)2 * NB * MH * NCH * 4096 * 4);
constexpr size_t O_ML = O_NL + al((size_t)2 * NB * MH * NCH * 64 * 4);
constexpr size_t O_BL = O_ML + al((size_t)2 * NB * MH * NCH * 4);
constexpr size_t O_MIN = O_BL + al((size_t)2 * NB * MH * NCH * 4);
constexpr size_t O_TOPI = O_MIN + al((size_t)2 * NB * MH * NCH * 4);
constexpr size_t O_TOPG = O_TOPI + al((size_t)T * 4 * 4);
constexpr size_t O_RANK = O_TOPG + al((size_t)T * 4 * 4);
constexpr size_t O_SLOT = O_RANK + al((size_t)T * 4 * 4);
constexpr size_t O_MQB = O_SLOT + al((size_t)T * 4 * 4);
constexpr size_t O_MKB = O_MQB + al((size_t)T * MW * 2);
constexpr size_t O_KT = O_MKB + al((size_t)T * MW * 2);
constexpr size_t O_VT = O_KT + al((size_t)T * MW * 2);
constexpr size_t O_GVT = O_VT + al((size_t)T * MW * 2);
constexpr size_t O_PMX = O_GVT + al((size_t)2 * T * MH * 4);
constexpr size_t O_BCT = O_PMX + al((size_t)2 * T * MH * 4);
constexpr size_t O_BRKR = O_BCT + al((size_t)2 * T * MH * 4);
constexpr int RC = 64, RNC = S / RC, RUN = 2 * NB * RH * RNC;
constexpr size_t O_LW = O_BRKR + al((size_t)2 * T * RH * 2 * 4);
constexpr size_t O_RQ = O_LW + al((size_t)2 * T * RW * 4);
constexpr size_t O_RA = O_RQ + al((size_t)RUN * 4096 * 2);
constexpr size_t O_RS = O_RA + al((size_t)RUN * 4096 * 2);
constexpr size_t O_RH = O_RS + al((size_t)RUN * 4096 * 2);
constexpr size_t O_RG = O_RH + al((size_t)RUN * 4096 * 4);
constexpr size_t O_RB = O_RG + al((size_t)RUN * 4096 * 4);
constexpr size_t O_VB = O_RB + al((size_t)T * RW * 2);
constexpr size_t O_KKB = O_VB + al((size_t)T * RW * 2);
constexpr size_t O_BBB = O_KKB + al((size_t)T * RW * 2);
constexpr size_t O_KDB = O_BBB + al((size_t)2 * T * RW * 2);
constexpr size_t O_VNT = O_KDB + al((size_t)2 * T * RW * 2);
constexpr size_t O_WSB = O_VNT + al((size_t)T * GW * 2);
constexpr size_t O_LWT = O_WSB + al((size_t)NL * GH * CH * CH * 2);
constexpr size_t O_RWT = O_LWT + al((size_t)NL * 1920 * 128 * 2);
constexpr size_t O_BCNT = O_RWT + al((size_t)NL * 2 * NE * D * 2);
constexpr size_t O_CNTF = O_BCNT + al((size_t)(T / 64) * NE * 4);
constexpr size_t O_ROWT = O_CNTF + al((size_t)NE * 4);
constexpr size_t O_XS = O_ROWT + al((size_t)NROWS * 4);
constexpr size_t O_ACT = O_XS + al((size_t)NROWS * D * 2);
constexpr size_t O_YS = O_ACT + al((size_t)NROWS * DFF * 2);
constexpr size_t O_WIN = O_YS + al((size_t)NROWS * D * 2);
constexpr size_t O_WOUT = O_WIN + al((size_t)NL * PLD * D * 2);
constexpr size_t O_W1 = O_WOUT + al((size_t)NL * D * D * 2);
constexpr size_t O_W2 = O_W1 + al((size_t)NL * NE * 2 * DFF * D * 2);
constexpr size_t WS_END = O_W2 + al((size_t)NL * NE * D * DFF * 2);

constexpr int CW_BAR = 4096;
constexpr int CW_CNT = 16384;

struct Params { const float* in[32]; float* out; unsigned char* ws; int ph_lo, ph_hi; };
#ifdef EMU
typedef const Params* ParamsPtr;
#define PARAMS_PTR(P) (&(P))
#else
typedef const __attribute__((address_space(4))) Params* ParamsPtr;
#define PARAMS_PTR(P) ((ParamsPtr)__builtin_amdgcn_kernarg_segment_ptr())
#endif

#ifdef EMU
#define WAVE_SYNC() emu_wave_barrier()
#define PIN_V(x) do {} while (0)
#define PIN_S(x) do {} while (0)
#else
#define WAVE_SYNC() __builtin_amdgcn_wave_barrier()
#define PIN_V(x) asm volatile("" : "+v"(x))
#define PIN_S(x) asm volatile("" : "+s"(x))
#endif
#ifdef EMU
__device__ __forceinline__ int phase_tid(int wv) { (void)wv; return threadIdx.x; }
#else
__device__ __forceinline__ int phase_tid(int wv) { int t; asm volatile("v_mbcnt_lo_u32_b32 %0, -1, 0\n\tv_mbcnt_hi_u32_b32 %0, -1, %0" : "=v"(t)); return (wv << 6) + t; }
#endif

#ifdef EMU
#define SHX(v, m, lane) __shfl_xor(v, m)
#else
__device__ __forceinline__ float shx_(float v, int m, int lane) { return __builtin_bit_cast(float, __builtin_amdgcn_ds_bpermute((lane ^ m) << 2, __builtin_bit_cast(int, v))); }
__device__ __forceinline__ int shx_(int v, int m, int lane) { return __builtin_amdgcn_ds_bpermute((lane ^ m) << 2, v); }
#define SHX(v, m, lane) shx_(v, m, lane)
#endif
#ifdef EMU
#define SHUP(v, o, lane) __shfl(v, ((lane) - (o)) & 63)
#define RDL(v, src) __shfl(v, src)
#define SHL(v, src) __shfl(v, src)
#else
#define SHL(v, src) __builtin_bit_cast(float, __builtin_amdgcn_ds_bpermute((src) << 2, __builtin_bit_cast(int, (float)(v))))
#define SHUP(v, o, lane) __builtin_bit_cast(float, __builtin_amdgcn_ds_bpermute((((lane) - (o)) & 63) << 2, __builtin_bit_cast(int, (float)(v))))
#define RDL(v, src) __builtin_bit_cast(float, __builtin_amdgcn_readlane(__builtin_bit_cast(int, (float)(v)), src))
#endif
__device__ __forceinline__ float wave_sum(float v, int lane) {
#pragma unroll
    for (int o = 32; o >= 1; o >>= 1) v += SHX(v, o, lane);
    return v;
}
#ifdef EMU
__device__ __forceinline__ float fexp(float x) { return expf(x); }
__device__ __forceinline__ float flog(float x) { return logf(x); }
__device__ __forceinline__ float frcp(float x) { return 1.0f / x; }
#else
__device__ __forceinline__ float fexp(float x) { return __builtin_amdgcn_exp2f(x * 1.4426950408889634f); }
__device__ __forceinline__ float flog(float x) { return __builtin_amdgcn_logf(x) * 0.6931471805599453f; }
__device__ __forceinline__ float frcp(float x) { return __builtin_amdgcn_rcpf(x); }
#endif
__device__ __forceinline__ float sigmoidf_(float x) { return frcp(1.0f + fexp(-x)); }
__device__ __forceinline__ float softplusf_(float x) { return fmaxf(x, 0.f) + flog(1.0f + fexp(-fabsf(x))); }
__device__ __forceinline__ float ftanh(float x) { return 1.0f - 2.0f * frcp(1.0f + fexp(2.0f * x)); }
__device__ __forceinline__ float geluf_(float v) {
    const float av = fabsf(v), t = frcp(1.0f + 0.2316418882f * av);
    float q = t * 0.5307027145f + (-0.7265760135f); q = q * t + 0.7107068705f; q = q * t + (-0.142248368f); q = q * t + 0.127414796f; q = q * t;
    const float m = v * (q * fexp(-0.5f * v * v));
    return v < 0.f ? m : v - m;
}

#ifdef EMU
#define LAS
#define WAIT_V(n) do {} while (0)
#define WAIT_L(n) do {} while (0)
#define S_BARRIER() __syncthreads()
#define SETPRIO(x) do {} while (0)
#define SCHED_BAR() do {} while (0)
#define RFL(x) (x)
static inline void emu_glds16(const void* g, void* l) { memcpy((char*)l + (g_blk->cur & 63) * 16, g, 16); }
#define GLDS16(gptr, ldsptr) emu_glds16((const void*)(gptr), (void*)(ldsptr))
static inline float emu_bf2f(unsigned short b) { unsigned u = (unsigned)b << 16; float f; memcpy(&f, &u, 4); return f; }
static inline f32x4 emu_mfma16(bf16x8 a, bf16x8 b, f32x4 c) {
    EmuBlock* blk = g_blk; const int cur = blk->cur, lane = cur & 63, wbase = cur & ~63;
    static thread_local unsigned short Ash[32][64][8], Bsh[32][64][8];
    const int w = cur >> 6;
    for (int j = 0; j < 8; ++j) { Ash[w][lane][j] = (unsigned short)a[j]; Bsh[w][lane][j] = (unsigned short)b[j]; }
    emu_wave_barrier();
    const int col = lane & 15;
    for (int r = 0; r < 4; ++r) { const int row = 4 * (lane >> 4) + r; float sum = c[r];
        for (int k = 0; k < 32; ++k) sum += emu_bf2f(Ash[w][row + 16 * (k >> 3)][k & 7]) * emu_bf2f(Bsh[w][col + 16 * (k >> 3)][k & 7]);
        c[r] = sum; }
    emu_wave_barrier(); (void)wbase;
    return c;
}
#define MFMA16(a, b, c) emu_mfma16(a, b, c)
#else
#define LAS __attribute__((address_space(3)))
#define WAIT_V(n) asm volatile("s_waitcnt vmcnt(" #n ")" ::: "memory")
#define WAIT_L(n) asm volatile("s_waitcnt lgkmcnt(" #n ")" ::: "memory")
#define S_BARRIER() __builtin_amdgcn_s_barrier()
#define SETPRIO(x) __builtin_amdgcn_s_setprio(x)
#define SCHED_BAR() __builtin_amdgcn_sched_barrier(0)
#define RFL(x) __builtin_amdgcn_readfirstlane(x)
#define GLDS16(gptr, ldsptr) __builtin_amdgcn_global_load_lds((const unsigned*)(gptr), (LAS unsigned*)(ldsptr), 16, 0, 0)
#define MFMA16(a, b, c) __builtin_amdgcn_mfma_f32_16x16x32_bf16(a, b, c, 0, 0, 0)
#endif

__device__ __forceinline__ unsigned f2bf(float f) { unsigned u = __builtin_bit_cast(unsigned, f); return (u + 0x7fffu + ((u >> 16) & 1u)) >> 16; }
__device__ __forceinline__ unsigned pk2(float lo, float hi) { return f2bf(lo) | (f2bf(hi) << 16); }
__device__ __forceinline__ bf16x8 cvt8(const f32x4 a, const f32x4 b) {
    u32x4 w; w.x = pk2(a.x, a.y); w.y = pk2(a.z, a.w); w.z = pk2(b.x, b.y); w.w = pk2(b.z, b.w); return __builtin_bit_cast(bf16x8, w);
}
__device__ __forceinline__ float bf_lo(unsigned u) { return __builtin_bit_cast(float, u << 16); }
__device__ __forceinline__ float bf_hi(unsigned u) { return __builtin_bit_cast(float, u & 0xffff0000u); }

namespace pg8 {
constexpr int BM = 256, BK = 64, HALF = 128, HTB = HALF * BK * 2, STAGE_BYTES = 8 * HTB, NXCD = 8, WGM = 8;
__host__ __device__ __forceinline__ int lds_byte(int r, int c) { const int st = (r >> 4) * 2 + (c >> 5), rr = r & 15, cc = c & 31, ob = rr * 64 + cc * 2; return st * 1024 + (ob ^ (((ob >> 9) & 1) << 5)); }
__host__ __device__ __forceinline__ void stage_rc(int b, int& R, int& C) { const int st = b / 1024, sb = b % 1024, swz = sb ^ (((sb >> 9) & 1) << 5); R = (st >> 1) * 16 + swz / 64; C = (st & 1) * 32 + (swz % 64) / 2; }
__host__ __device__ __forceinline__ int perm32(int rho) { const int n = rho >> 4, i = rho & 15; return 8 * (i >> 2) + 4 * n + (i & 3); }
struct Unit { int pm, pn, e; };

struct DenseOrder {
    static constexpr bool GATHER = false;
    const char* A; const char* Bt; int K; int nM, nN, nwg, G, c;
    __device__ __forceinline__ void init(const void* A_, const void* Bt_, int M, int N, int K_, int G_, int c_) { A = (const char*)A_; Bt = (const char*)Bt_; K = K_; nM = M / BM; nN = N / BM; nwg = nM * nN; G = G_; c = c_; }
    __device__ __forceinline__ bool next(int i, Unit& u) const {
        const long L = (long)i * G + c; if (L >= nwg) return false;
        int wgid = (int)L; { const int q = nwg / NXCD, r = nwg % NXCD, xcd = wgid % NXCD, off = wgid / NXCD; wgid = (xcd < r ? xcd * (q + 1) : r * (q + 1) + (xcd - r) * q) + off; }
        const int nig = WGM * nN, gid = wgid / nig, fm = gid * WGM, gsz = (nM - fm) < WGM ? (nM - fm) : WGM;
        u.pm = fm + ((wgid % nig) % gsz); u.pn = (wgid % nig) / gsz; u.e = 0; return true;
    }
    __device__ __forceinline__ const char* abase(const Unit& u) const { return A + (size_t)u.pm * BM * K * 2; }
    __device__ __forceinline__ const char* bbase(const Unit& u) const { return Bt + (size_t)u.pn * BM * K * 2; }
};
template <bool G>
struct MoeOrderT {
    static constexpr bool GATHER = G;
    const char* A; const char* Wt; int K; int nN, nwg, G_, c; size_t estride; const int* rbe; const int* rowmap;
    __device__ __forceinline__ bool next(int i, Unit& u) const {
        const long L = (long)i * G_ + c; if (L >= nwg) return false;
        u.pm = (int)(L / nN); u.pn = (int)(L % nN); u.e = rbe[u.pm]; return true;
    }
    __device__ __forceinline__ const char* abase(const Unit& u) const { return G ? A : A + (size_t)u.pm * BM * K * 2; }
    __device__ __forceinline__ const char* bbase(const Unit& u) const { return Wt + (size_t)u.e * estride + (size_t)u.pn * BM * K * 2; }
};
struct EpiF32 {
    static constexpr bool PERM = false;
    float* C; int ldc;
    __device__ __forceinline__ void operator()(const f32x4 (&acc)[2][2][4][2], const Unit& u, int wr, int wc, int fr, int fq) const {
        const int row0 = u.pm * BM + wr * 64 + fr, col0 = u.pn * BM + wc * 32 + 4 * fq;
#pragma unroll
        for (int ai = 0; ai < 2; ++ai)
#pragma unroll
            for (int m = 0; m < 4; ++m) { float* rowp = C + (size_t)(row0 + ai * HALF + m * 16) * ldc + col0;
#pragma unroll
                for (int bj = 0; bj < 2; ++bj)
#pragma unroll
                    for (int n = 0; n < 2; ++n) *(f32x4*)(rowp + bj * HALF + n * 16) = acc[ai][bj][m][n]; }
    }
};
struct EpiProj {
    static constexpr bool PERM = true;
    bf16_t* O; int ldc; float* G; int lastt;
    __device__ __forceinline__ void operator()(const f32x4 (&acc)[2][2][4][2], const Unit& u, int wr, int wc, int fr, int fq) const {
        const int row0 = u.pm * BM + wr * 64 + fr, col0 = u.pn * BM + wc * 32 + 8 * fq;
#pragma unroll
        for (int ai = 0; ai < 2; ++ai)
#pragma unroll
            for (int m = 0; m < 4; ++m) { bf16_t* rowp = O + (size_t)(row0 + ai * HALF + m * 16) * ldc + col0;
#pragma unroll
                for (int bj = 0; bj < 2; ++bj) { const f32x4 v0 = acc[ai][bj][m][0], v1 = acc[ai][bj][m][1];
                    u32x4 w; w.x = pk2(v0[0], v0[1]); w.y = pk2(v0[2], v0[3]); w.z = pk2(v1[0], v1[1]); w.w = pk2(v1[2], v1[3]);
                    *(u32x4*)(rowp + bj * HALF) = w; } }
        if (u.pn == lastt) {
#pragma unroll
            for (int ai = 0; ai < 2; ++ai)
#pragma unroll
                for (int m = 0; m < 4; ++m) { float* rowp = G + (size_t)(row0 + ai * HALF + m * 16) * BM + wc * 32 + 8 * fq;
#pragma unroll
                    for (int bj = 0; bj < 2; ++bj) { *(f32x4*)(rowp + bj * HALF) = acc[ai][bj][m][0]; *(f32x4*)(rowp + bj * HALF + 4) = acc[ai][bj][m][1]; } }
        }
    }
};
struct EpiBf16Bias {
    static constexpr bool PERM = true;
    bf16_t* O; int ldc; const float* bias; int bias_estride;
    __device__ __forceinline__ void operator()(const f32x4 (&acc)[2][2][4][2], const Unit& u, int wr, int wc, int fr, int fq) const {
        const int row0 = u.pm * BM + wr * 64 + fr, col0 = u.pn * BM + wc * 32 + 8 * fq;
        const float* bp = bias + (size_t)u.e * bias_estride + col0;
        f32x4 bv[2][2];
#pragma unroll
        for (int bj = 0; bj < 2; ++bj)
#pragma unroll
            for (int n = 0; n < 2; ++n) bv[bj][n] = *(const f32x4*)(bp + bj * HALF + 4 * n);
#pragma unroll
        for (int ai = 0; ai < 2; ++ai)
#pragma unroll
            for (int m = 0; m < 4; ++m) { bf16_t* rowp = O + (size_t)(row0 + ai * HALF + m * 16) * ldc + col0;
#pragma unroll
                for (int bj = 0; bj < 2; ++bj) { const f32x4 v0 = acc[ai][bj][m][0] + bv[bj][0], v1 = acc[ai][bj][m][1] + bv[bj][1];
                    u32x4 w; w.x = pk2(v0[0], v0[1]); w.y = pk2(v0[2], v0[3]); w.z = pk2(v1[0], v1[1]); w.w = pk2(v1[2], v1[3]);
                    *(u32x4*)(rowp + bj * HALF) = w; } }
    }
};
__device__ __forceinline__ float swiglu1(float g, float uu) { g = fminf(g, 7.0f); uu = fminf(fmaxf(uu, -7.0f), 7.0f); return (uu + 1.0f) * (g * frcp(1.0f + fexp(-1.702f * g))); }
struct EpiSwiglu {
    static constexpr bool PERM = true;
    bf16_t* O; const float* b1;
    __device__ __forceinline__ void operator()(const f32x4 (&acc)[2][2][4][2], const Unit& u, int wr, int wc, int fr, int fq) const {
        const int row0 = u.pm * BM + wr * 64 + fr, j0 = u.pn * HALF + wc * 32 + 8 * fq;
        const float* bg = b1 + (size_t)u.e * 2 * DFF + j0; const float* bu = bg + DFF;
        f32x4 g4[2], u4[2];
#pragma unroll
        for (int n = 0; n < 2; ++n) { g4[n] = *(const f32x4*)(bg + 4 * n); u4[n] = *(const f32x4*)(bu + 4 * n); }
#pragma unroll
        for (int ai = 0; ai < 2; ++ai)
#pragma unroll
            for (int m = 0; m < 4; ++m) {
                float o[8];
#pragma unroll
                for (int n = 0; n < 2; ++n)
#pragma unroll
                    for (int q = 0; q < 4; ++q) o[n * 4 + q] = swiglu1(acc[ai][0][m][n][q] + g4[n][q], acc[ai][1][m][n][q] + u4[n][q]);
                u32x4 w; w.x = pk2(o[0], o[1]); w.y = pk2(o[2], o[3]); w.z = pk2(o[4], o[5]); w.w = pk2(o[6], o[7]);
                *(u32x4*)(O + (size_t)(row0 + ai * HALF + m * 16) * DFF + j0) = w;
            }
    }
};

template <class Epi, class Sched>
__device__ __forceinline__ void gemm_phase(LAS unsigned char* lds, const int K, const Sched& S, const Epi& E, const int tid) {
    const int wid = RFL(tid >> 6), lane = tid & 63, wr = wid >> 2, wc = wid & 3, fr = lane & 15, fq = lane >> 4;
    const int nt = K / BK;
    unsigned voffA[2], voffB[2]; int gR[2]; unsigned gC[2];
#pragma unroll
    for (int i = 0; i < 2; ++i) { int R, C; stage_rc(tid * 16 + i * 8192, R, C); const int Rb = Epi::PERM ? ((R & ~31) + perm32(R & 31)) : R;
        voffA[i] = (unsigned)(R * K + C) * 2u; voffB[i] = (unsigned)(Rb * K + C) * 2u; gR[i] = R; gC[i] = (unsigned)C * 2u; }
    unsigned va[2][2], vn[2][2];
#define PG8_GOFF(dst, unit) do { if constexpr (Sched::GATHER) { _Pragma("unroll") for (int h_ = 0; h_ < 2; ++h_) _Pragma("unroll") for (int i_ = 0; i_ < 2; ++i_) \
        dst[h_][i_] = (unsigned)S.rowmap[(unit).pm * BM + h_ * HALF + gR[i_]] * (unsigned)(K * 2) + gC[i_]; } } while (0)
#define PG8_STAGE_A(bufoff, bp, kb, h, nx) do { if constexpr (Sched::GATHER) { const char* gb_ = S.A + (kb); _Pragma("unroll") for (int _i = 0; _i < 2; ++_i) \
        GLDS16(gb_ + ((nx) ? vn[h][_i] : va[h][_i]), lds + (bufoff) + ldsw + _i * 8192); } else { PG8_STAGE(bufoff, bp, voffA); } } while (0)
    const size_t kstep = (size_t)(BK * 2);
    const size_t hstep = (size_t)HALF * K * 2;
    const unsigned ldsw = (unsigned)wid * 1024u;
    const int aoff = lds_byte(wr * 64 + fr, fq * 8), boff = lds_byte(wc * 32 + fr, fq * 8);
#define PG8_SA(b, h) (((b) * 2 + (h)) * HTB)
#define PG8_SB(b, h) ((4 + (b) * 2 + (h)) * HTB)
#define PG8_STAGE(bufoff, gbase, voff) do { _Pragma("unroll") for (int _i = 0; _i < 2; ++_i) \
        GLDS16((const char*)(gbase) + (voff)[_i], lds + (bufoff) + ldsw + _i * 8192); } while (0)
#define PG8_LDA(dst, b, h) do { _Pragma("unroll") for (int m = 0; m < 4; ++m) _Pragma("unroll") for (int k = 0; k < 2; ++k) dst[m][k] = *(const LAS bf16x8*)(lds + PG8_SA(b, h) + aoff + m * 2048 + k * 1024); } while (0)
#define PG8_LDB(dst, b, h) do { _Pragma("unroll") for (int n = 0; n < 2; ++n) _Pragma("unroll") for (int k = 0; k < 2; ++k) dst[n][k] = *(const LAS bf16x8*)(lds + PG8_SB(b, h) + boff + n * 2048 + k * 1024); } while (0)
#define PG8_MMA(ai, bj, At, Bt) do { SETPRIO(1); _Pragma("unroll") for (int m = 0; m < 4; ++m) _Pragma("unroll") for (int n = 0; n < 2; ++n) _Pragma("unroll") for (int k = 0; k < 2; ++k) \
        acc[ai][bj][m][n] = MFMA16(Bt[n][k], At[m][k], acc[ai][bj][m][n]); SETPRIO(0); } while (0)
    Unit cur, nxt; int ui = 0;
    if (!S.next(0, cur)) return;
    f32x4 acc[2][2][4][2];
#pragma unroll
    for (int a = 0; a < 2; ++a)
#pragma unroll
        for (int b = 0; b < 2; ++b)
#pragma unroll
            for (int m = 0; m < 4; ++m)
#pragma unroll
                for (int n = 0; n < 2; ++n) acc[a][b][m][n] = (f32x4){0.f, 0.f, 0.f, 0.f};
    bf16x8 At[4][2], B0[2][2], B1[2][2];
    const char* cA = S.abase(cur); const char* cB = S.bbase(cur);
    PG8_GOFF(va, cur);
    PG8_STAGE(PG8_SB(0, 0), cB, voffB); PG8_STAGE_A(PG8_SA(0, 0), cA, 0, 0, false); PG8_STAGE(PG8_SB(0, 1), cB + hstep, voffB); PG8_STAGE_A(PG8_SA(0, 1), cA + hstep, 0, 1, false);
    if (wr == 1) S_BARRIER();
    WAIT_V(4); S_BARRIER();
    PG8_STAGE(PG8_SB(1, 0), cB + kstep, voffB); PG8_STAGE_A(PG8_SA(1, 0), cA + kstep, kstep, 0, false); PG8_STAGE(PG8_SB(1, 1), cB + hstep + kstep, voffB);
    WAIT_V(6); S_BARRIER();
    for (;;) {
        const bool has_next = S.next(ui + 1, nxt);
        const char* nA = has_next ? S.abase(nxt) : cA; const char* nB = has_next ? S.bbase(nxt) : cB;
        if constexpr (Sched::GATHER) { if (has_next) { PG8_GOFF(vn, nxt); } else {
#pragma unroll
            for (int h_ = 0; h_ < 2; ++h_) { vn[h_][0] = va[h_][0]; vn[h_][1] = va[h_][1]; } } }
        for (int t = 0; t < nt; t += 2) {
            const bool last = (t == nt - 2);
            const char* a1 = cA + (size_t)(t + 1) * kstep;
            const char* a2 = last ? nA : cA + (size_t)(t + 2) * kstep; const char* b2 = last ? nB : cB + (size_t)(t + 2) * kstep;
            const char* a3 = a2 + kstep; const char* b3 = b2 + kstep;
            PG8_LDB(B0, 0, 0); SCHED_BAR(); PG8_LDA(At, 0, 0); PG8_STAGE_A(PG8_SA(1, 1), a1 + hstep, (size_t)(t + 1) * kstep, 1, false);
            WAIT_L(8); S_BARRIER(); WAIT_L(0); PG8_MMA(0, 0, At, B0); S_BARRIER(); SCHED_BAR();
            PG8_LDB(B1, 0, 1); PG8_STAGE(PG8_SB(0, 0), b2, voffB);
            S_BARRIER(); WAIT_L(0); PG8_MMA(0, 1, At, B1); S_BARRIER();
            PG8_LDA(At, 0, 1); PG8_STAGE_A(PG8_SA(0, 0), a2, (last ? (size_t)0 : (size_t)(t + 2) * kstep), 0, last);
            S_BARRIER(); WAIT_L(0); PG8_MMA(1, 0, At, B0); S_BARRIER(); SCHED_BAR();
            PG8_STAGE(PG8_SB(0, 1), b2 + hstep, voffB);
            WAIT_V(6); S_BARRIER(); PG8_MMA(1, 1, At, B1); S_BARRIER();
            PG8_LDB(B0, 1, 0); SCHED_BAR(); PG8_LDA(At, 1, 0); PG8_STAGE_A(PG8_SA(0, 1), a2 + hstep, (last ? (size_t)0 : (size_t)(t + 2) * kstep), 1, last);
            WAIT_L(8); S_BARRIER(); WAIT_L(0); PG8_MMA(0, 0, At, B0); S_BARRIER(); SCHED_BAR();
            PG8_LDB(B1, 1, 1); PG8_STAGE(PG8_SB(1, 0), b3, voffB);
            S_BARRIER(); WAIT_L(0); PG8_MMA(0, 1, At, B1); S_BARRIER();
            PG8_LDA(At, 1, 1); PG8_STAGE_A(PG8_SA(1, 0), a3, (last ? kstep : (size_t)(t + 3) * kstep), 0, last);
            S_BARRIER(); WAIT_L(0); PG8_MMA(1, 0, At, B0); S_BARRIER(); SCHED_BAR();
            PG8_STAGE(PG8_SB(1, 1), b3 + hstep, voffB);
            WAIT_V(6); S_BARRIER(); PG8_MMA(1, 1, At, B1); S_BARRIER();
        }
        E(acc, cur, wr, wc, fr, fq);
        if (!has_next) break;
#pragma unroll
        for (int a = 0; a < 2; ++a)
#pragma unroll
            for (int b = 0; b < 2; ++b)
#pragma unroll
                for (int m = 0; m < 4; ++m)
#pragma unroll
                    for (int n = 0; n < 2; ++n) acc[a][b][m][n] = (f32x4){0.f, 0.f, 0.f, 0.f};
        cur = nxt; cA = nA; cB = nB; ++ui;
        if constexpr (Sched::GATHER) {
#pragma unroll
            for (int h_ = 0; h_ < 2; ++h_) { va[h_][0] = vn[h_][0]; va[h_][1] = vn[h_][1]; } }
    }
    WAIT_V(0);
    if (wr == 0) S_BARRIER();
    S_BARRIER();
#undef PG8_SA
#undef PG8_SB
#undef PG8_STAGE
#undef PG8_STAGE_A
#undef PG8_GOFF
#undef PG8_LDA
#undef PG8_LDB
#undef PG8_MMA
}
}

__device__ __forceinline__ float row16_sum(float x) {
#ifdef EMU
    x += __shfl_xor(x, 1); x += __shfl_xor(x, 2); x += __shfl_xor(x, 4); x += __shfl_xor(x, 8); return x;
#else
#define DPPF(v, ctrl) __builtin_bit_cast(float, __builtin_amdgcn_update_dpp(0, __builtin_bit_cast(int, (v)), (ctrl), 0xF, 0xF, false))
    x += DPPF(x, 0xB1); x += DPPF(x, 0x4E); x += DPPF(x, 0x141); x += DPPF(x, 0x140); return x;
#undef DPPF
#endif
}
__device__ __forceinline__ float row32_sum(float x) {
    x = row16_sum(x);
#ifdef EMU
    x += __shfl_xor(x, 32); return x;
#else
    float a = x, b = x;
    asm volatile("s_nop 1\n\tv_permlane32_swap_b32 %0, %1" : "+v"(a), "+v"(b));
    return a + b;
#endif
}
__device__ __forceinline__ float wave_sum_fast(float x, int lane) {
    x = row32_sum(x);
    x += SHX(x, 16, lane);
    return x;
}
__device__ __forceinline__ void transpose_item(const float* W, int K, int N, bf16_t* WT, int k0, int n0, int dst_row0, float* scr, int lane) {
    const int n4 = (lane & 15) * 4, kr = lane >> 4;
#pragma unroll 8
    for (int i = 0; i < 16; ++i) {
        const int kk = 4 * i + kr;
        f32x4 v = (f32x4){0.f, 0.f, 0.f, 0.f};
        if (n0 + n4 < N) v = *(const f32x4*)(W + (size_t)(k0 + kk) * N + n0 + n4);
        float* d = scr + kk * 65 + n4; d[0] = v.x; d[1] = v.y; d[2] = v.z; d[3] = v.w;
    }
    WAVE_SYNC();
    const int c = lane & 7;
#pragma unroll
    for (int j = 0; j < 8; ++j) { const int n = (lane >> 3) + 8 * j; const float* sp = scr + (8 * c) * 65 + n;
        u32x4 o; o.x = pk2(sp[0 * 65], sp[1 * 65]); o.y = pk2(sp[2 * 65], sp[3 * 65]); o.z = pk2(sp[4 * 65], sp[5 * 65]); o.w = pk2(sp[6 * 65], sp[7 * 65]);
        *(u32x4*)(WT + (size_t)(dst_row0 + n) * K + k0 + 8 * c) = o; }
    WAVE_SYNC();
}
__device__ __forceinline__ void phase_prologue(const Params& P, unsigned char* smem, int wv) {
    ParamsPtr pp = PARAMS_PTR(P); PIN_S(pp); unsigned char* ws = pp->ws; int bidx = (int)blockIdx.x, gdim = (int)gridDim.x; PIN_S(bidx); PIN_S(gdim);
    const int tid = phase_tid(wv), lane = tid & 63, wave = tid >> 6;
    float* scr = (float*)smem + wave * (64 * 65);
    const int gw = bidx * NWAVES + wave, ngw = NWAVES * gdim;
    constexpr int I_IN = 16 * (PLD / 64), I_OUT = 16 * 16, I_W1 = NE * 16 * 32, I_W2 = NE * 16 * 16, I_L = I_IN + I_OUT + I_W1 + I_W2;
    for (int it = gw; it < NL * I_L; it += ngw) {
        const int l = it / I_L; int r = it % I_L;
        if (r < I_IN) { const int kb = r / (PLD / 64), nb = r % (PLD / 64);
            transpose_item(pp->in[1] + (size_t)l * D * PIN, D, PIN, (bf16_t*)(ws + O_WIN) + (size_t)l * PLD * D, kb * 64, nb * 64, nb * 64, scr, lane); continue; }
        r -= I_IN;
        if (r < I_OUT) { const int kb = r / 16, nb = r % 16;
            transpose_item(pp->in[21] + (size_t)l * D * D, D, D, (bf16_t*)(ws + O_WOUT) + (size_t)l * D * D, kb * 64, nb * 64, nb * 64, scr, lane); continue; }
        r -= I_OUT;
        if (r < I_W1) { const int e = r / (16 * 32), q = r % (16 * 32), kb = q / 32, nb = q % 32, n0 = nb * 64;
            const int dst = n0 < DFF ? (n0 / 128) * 256 + (n0 % 128) : ((n0 - DFF) / 128) * 256 + 128 + ((n0 - DFF) % 128);
            transpose_item(pp->in[26] + ((size_t)l * NE + e) * D * 2 * DFF, D, 2 * DFF, (bf16_t*)(ws + O_W1) + ((size_t)l * NE + e) * 2 * DFF * D, kb * 64, n0, dst, scr, lane); continue; }
        r -= I_W1;
        { const int e = r / (16 * 16), q = r % (16 * 16), kb = q / 16, nb = q % 16;
            transpose_item(pp->in[28] + ((size_t)l * NE + e) * DFF * D, DFF, D, (bf16_t*)(ws + O_W2) + ((size_t)l * NE + e) * D * DFF, kb * 64, nb * 64, nb * 64, scr, lane); }
    }
    {
        const float* gw_ = pp->in[4]; bf16_t* WSB = (bf16_t*)(ws + O_WSB);
        for (size_t i = ((size_t)bidx * NTHREADS + tid) * 4; i < (size_t)NL * GH * CH * CH; i += (size_t)gdim * NTHREADS * 4) {
            const f32x4 v = *(const f32x4*)(gw_ + i); u32x2 o; o.x = pk2(v.x, v.y); o.y = pk2(v.z, v.w); *(u32x2*)(WSB + i) = o;
        }
    }
    {
        bf16_t* LWT = (bf16_t*)(ws + O_LWT);
        for (int i = bidx * NTHREADS + tid; i < NL * 1920 * 128; i += gdim * NTHREADS) {
            const int k = i & 127, n = (i >> 7) % 1920, ll = i / (1920 * 128);
            float v = 0.f;
            if (n < 1536) { if (k < 64) { const int grp = n / 768, d = (n / 384) & 1, c = n % 384; v = (grp == 0 ? pp->in[8] : pp->in[10])[(((size_t)ll * 2 + d) * 64 + k) * RW + c]; } }
            else v = pp->in[11][((size_t)ll * 128 + k) * RW + (n - 1536)];
            LWT[i] = (bf16_t)f2bf(v);
        }
    }
    {
        bf16_t* RWT = (bf16_t*)(ws + O_RWT);
        for (int i = bidx * NTHREADS + tid; i < NL * NE * D; i += gdim * NTHREADS) {
            const int k = i % D, e = (i / D) % NE, ll = i / (D * NE);
            const float v = pp->in[24][((size_t)ll * D + k) * NE + e];
            const unsigned hi = f2bf(v); const float lo = v - bf_lo(hi);
            RWT[((size_t)(ll * 2 + 0) * NE + e) * D + k] = (bf16_t)hi; RWT[((size_t)(ll * 2 + 1) * NE + e) * D + k] = (bf16_t)f2bf(lo);
        }
    }
    const float* x = pp->in[0]; bf16_t* XB = (bf16_t*)(ws + O_XB);
    for (size_t i = ((size_t)bidx * NTHREADS + tid) * 4; i < (size_t)T * D; i += (size_t)gdim * NTHREADS * 4) {
        const f32x4 v = *(const f32x4*)(x + i); u32x2 o; o.x = pk2(v.x, v.y); o.y = pk2(v.z, v.w); *(u32x2*)(XB + i) = o;
    }
}

__device__ __forceinline__ float tshift(const float* P, int t, int s, int col, const float* mu0, const float* mu1, int rc) {
    const float cur = P[(size_t)t * PLD + col];
    const float prv = s > 0 ? P[(size_t)(t - 1) * PLD + col] : 0.f;
    const float nxt = s < S - 1 ? P[(size_t)(t + 1) * PLD + col] : 0.f;
    return cur + mu0[rc] * (prv - cur) + mu1[rc] * (nxt - cur);
}

__device__ __forceinline__ void phase_prep(const Params& P, int l, unsigned char* smem, int wv) {
    ParamsPtr pp = PARAMS_PTR(P); PIN_S(pp); unsigned char* ws = pp->ws; int bidx = (int)blockIdx.x, gdim = (int)gridDim.x; PIN_S(bidx); PIN_S(gdim);
    const bf16_t* proj = (const bf16_t*)(ws + O_PROJ); const float* projg = (const float*)(ws + O_PROJG);
    float* UG = (float*)(ws + O_UG); bf16_t* VNT = (bf16_t*)(ws + O_VNT);
    float* RR = (float*)(ws + O_RR); float* VV = (float*)(ws + O_VV); float* KK = (float*)(ws + O_KK);
    float* KD = (float*)(ws + O_KD); float* ICLR = (float*)(ws + O_ICLR);
    float* GATE = (float*)(ws + O_GATE); float* BONUS = (float*)(ws + O_BONUS); float* LWG = (float*)(ws + O_LW);
    bf16_t* RB = (bf16_t*)(ws + O_RB); bf16_t* VB = (bf16_t*)(ws + O_VB); bf16_t* KKB = (bf16_t*)(ws + O_KKB); bf16_t* BBB = (bf16_t*)(ws + O_BBB); bf16_t* KDB = (bf16_t*)(ws + O_KDB);
#if !MK_RWKV_CHUNKED
    float* DEC = (float*)(ws + O_DEC); float* BRKR = (float*)(ws + O_BRKR);
#endif
    bf16_t* MQB = (bf16_t*)(ws + O_MQB); bf16_t* MKB = (bf16_t*)(ws + O_MKB); bf16_t* KT = (bf16_t*)(ws + O_KT); bf16_t* VT = (bf16_t*)(ws + O_VT);
    float* IG = (float*)(ws + O_IG); float* LF = (float*)(ws + O_LF);
    const bf16_t* LWT = (const bf16_t*)(ws + O_LWT) + (size_t)l * 1920 * 128;
    const float* gln_g = pp->in[2] + (size_t)l * GW; const float* gln_b = pp->in[3] + (size_t)l * GW;
    const float* mu0 = pp->in[6] + (size_t)l * 2 * RPROJ; const float* mu1 = mu0 + RPROJ;
    const float* w0 = pp->in[7] + (size_t)l * 2 * RW; const float* a0 = pp->in[9] + (size_t)l * 2 * RW;
    const float* k_k = pp->in[12] + (size_t)l * RW; const float* k_a = pp->in[13] + (size_t)l * RW; const float* r_k = pp->in[14] + (size_t)l * RW;
    const float* conv_w = pp->in[17] + (size_t)l * 3 * 768; const float* conv_b = pp->in[18] + (size_t)l * 768; const float* gate_b = pp->in[19] + (size_t)l * 24;
    float* win = (float*)smem;
    bf16_t* lin = (bf16_t*)(smem + 101376);
    bf16_t* tvn = (bf16_t*)(smem + 110592);
    bf16_t* tk = (bf16_t*)(smem + 118784);
    bf16_t* tv = (bf16_t*)(smem + 131072);
    constexpr int LIN = 264;
    const int tid = phase_tid(wv), lane = tid & 63, wave = tid >> 6, col = lane & 15, g = lane >> 4;
    for (int u = bidx; u < T / 16; u += gdim) {
        const int t0 = u * 16, s0 = t0 % S, bb = t0 / S;
        __syncthreads();
        {
            u32x2 wb[18];
#pragma unroll
            for (int row = 0; row < 18; ++row) {
                const int sq = s0 - 1 + row;
                wb[row] = (u32x2){0u, 0u};
                if (sq >= 0 && sq < S && tid < 352) wb[row] = *(const u32x2*)(proj + (size_t)(t0 - 1 + row) * PLD + C_RW + tid * 4);
            }
            if (tid < 352) {
#pragma unroll
                for (int row = 0; row < 18; ++row) *(f32x4*)(win + row * RPROJ + tid * 4) = (f32x4){bf_lo(wb[row].x), bf_hi(wb[row].x), bf_lo(wb[row].y), bf_hi(wb[row].y)};
            }
        }
        for (int rep_ = 0; rep_ < (MK_PROBE == 3 ? 2 : 1); ++rep_) {
            const int i = tid >> 5, l32 = tid & 31, t = t0 + i;
            float v[8], ug[8]; float sum = 0.f;
#pragma unroll
            for (int j = 0; j < 8; ++j) { const int c = j * 32 + l32; ug[j] = bf_lo((unsigned)proj[(size_t)t * PLD + c]); v[j] = bf_lo((unsigned)proj[(size_t)t * PLD + GW + c]); }
#pragma unroll
            for (int j = 0; j < 8; ++j) { const int c = j * 32 + l32; UG[(size_t)t * GW + c] = geluf_(ug[j]); v[j] = geluf_(v[j]); sum += v[j]; }
#pragma unroll
            for (int o = 16; o >= 1; o >>= 1) sum += SHX(sum, o, lane);
            const float mean = sum * (1.0f / GW); float q = 0.f;
#pragma unroll
            for (int j = 0; j < 8; ++j) { const float d = v[j] - mean; q += d * d; }
#pragma unroll
            for (int o = 16; o >= 1; o >>= 1) q += SHX(q, o, lane);
            const float rstd = 1.0f / sqrtf(q * (1.0f / GW) + LN_EPS);
#pragma unroll
            for (int j = 0; j < 8; ++j) { const int c = j * 32 + l32; tvn[c * 16 + i] = (bf16_t)f2bf((v[j] - mean) * rstd * gln_g[c] + gln_b[c]); }
        }
        __syncthreads();
        {
            const int hf = tid & 1, c = tid >> 1;
            *(u32x4*)(VNT + ((size_t)bb * GW + c) * S + s0 + hf * 8) = *(const u32x4*)(tvn + c * 16 + hf * 8);
        }
        for (int idx = tid; idx < 16 * 256; idx += NTHREADS) {
            const int i = idx >> 8, j = idx & 255, rc = 1152 + j;
            const float pv = win[i * RPROJ + rc], cv = win[(i + 1) * RPROJ + rc], nv = win[(i + 2) * RPROJ + rc];
            const float x = cv + mu0[rc] * (pv - cv) + mu1[rc] * (nv - cv);
            lin[i * LIN + j] = (bf16_t)f2bf(j < 64 ? ftanh(x) : (j < 128 ? x : sigmoidf_(x)));
        }
        __syncthreads();
        for (int rep_ = 0; rep_ < (MK_PROBE == 1 ? 2 : 1); ++rep_) {
#pragma unroll 1
            for (int qg = 0; qg < 3; ++qg) {
                bf16x8 bw_[5][4]; float bias_[5];
#pragma unroll
                for (int q5 = 0; q5 < 5; ++q5) {
                    const int nt = wave * 15 + qg * 5 + q5, grp = nt / 24, c = (nt % 24) * 16 + col;
                    const bf16_t* bw = LWT + (size_t)(nt * 16 + col) * 128 + 8 * g;
#pragma unroll
                    for (int ks = 0; ks < 4; ++ks) bw_[q5][ks] = *(const bf16x8*)(bw + ks * 32);
                    bias_[q5] = grp < 2 ? w0[grp * RW + c] : (grp < 4 ? a0[(grp - 2) * RW + c] : 0.f);
                }
#pragma unroll
                for (int q5 = 0; q5 < 5; ++q5) {
                    const int nt = wave * 15 + qg * 5 + q5, grp = nt / 24, c = (nt % 24) * 16 + col;
                    const int kcol = grp < 2 ? 0 : (grp < 4 ? 64 : 128);
                    f32x4 acc = (f32x4){0.f, 0.f, 0.f, 0.f};
#pragma unroll
                    for (int ks = 0; ks < 2; ++ks) acc = MFMA16(*(const bf16x8*)(lin + col * LIN + kcol + ks * 32 + 8 * g), bw_[q5][ks], acc);
                    if (grp == 4) {
#pragma unroll
                        for (int ks = 2; ks < 4; ++ks) acc = MFMA16(*(const bf16x8*)(lin + col * LIN + kcol + ks * 32 + 8 * g), bw_[q5][ks], acc);
                    }
                    if (grp < 2) {
#pragma unroll
                        for (int r = 0; r < 4; ++r) { const float lw = -fexp(-softplusf_(-(acc[r] + bias_[q5])) - 0.5f); const size_t o = (size_t)grp * T * RW + (size_t)(t0 + 4 * g + r) * RW + c; LWG[o] = lw;
#if !MK_RWKV_CHUNKED
                            DEC[o] = expf(lw);
#endif
                        }
                    } else if (grp < 4) {
#pragma unroll
                        for (int r = 0; r < 4; ++r) ICLR[(size_t)(grp - 2) * T * RW + (size_t)(t0 + 4 * g + r) * RW + c] = sigmoidf_(acc[r] + bias_[q5]);
                    } else {
#pragma unroll
                        for (int r = 0; r < 4; ++r) GATE[(size_t)(t0 + 4 * g + r) * RW + c] = acc[r];
                    }
                }
            }
        }
        __syncthreads();
        for (int rep_ = 0; rep_ < (MK_PROBE == 2 ? 2 : 1); ++rep_) if (wave < 6) {
            const int c = tid, h = wave;
            const float kkc = k_k[c], kac = k_a[c], rkc = r_k[c];
            const float m0r = mu0[c], m1r = mu1[c], m0k = mu0[RW + c], m1k = mu1[RW + c], m0v = mu0[2 * RW + c], m1v = mu1[2 * RW + c];
            float ic0[16], ic1[16];
#pragma unroll
            for (int i = 0; i < 16; ++i) { const size_t o = (size_t)(t0 + i) * RW + c; ic0[i] = ICLR[o]; ic1[i] = ICLR[(size_t)T * RW + o]; }
#pragma unroll
            for (int i = 0; i < 16; ++i) {
                const int t = t0 + i;
                const float* w_ = win + i * RPROJ + c;
                const float rp = w_[0], rc_ = w_[RPROJ], rn = w_[2 * RPROJ];
                const float kp = w_[RW], kc_ = w_[RPROJ + RW], kn = w_[2 * RPROJ + RW];
                const float vp = w_[2 * RW], vc_ = w_[RPROJ + 2 * RW], vn = w_[2 * RPROJ + 2 * RW];
                const float r = rc_ + m0r * (rp - rc_) + m1r * (rn - rc_);
                const float k = kc_ + m0k * (kp - kc_) + m1k * (kn - kc_);
                const float v = vc_ + m0v * (vp - vc_) + m1v * (vn - vc_);
                const size_t o = (size_t)t * RW + c;
                const float kq = k * kkc;
                const float n2 = wave_sum_fast(kq * kq, lane);
                const float kk = kq / fmaxf(sqrtf(n2), 1e-12f);
                const float kd0 = k * (1.0f + (ic0[i] - 1.0f) * kac), kd1 = k * (1.0f + (ic1[i] - 1.0f) * kac);
                const float bon = wave_sum_fast(r * (kd0 + kd1) * rkc, lane);
#if MK_RWKV_CHUNKED
                RB[o] = (bf16_t)f2bf(r); VB[o] = (bf16_t)f2bf(v); KKB[o] = (bf16_t)f2bf(kk);
                BBB[o] = (bf16_t)f2bf(kk * ic0[i]); BBB[(size_t)T * RW + o] = (bf16_t)f2bf(kk * ic1[i]);
                KDB[o] = (bf16_t)f2bf(kd0); KDB[(size_t)T * RW + o] = (bf16_t)f2bf(kd1);
#else
                RR[o] = r; VV[o] = v; KK[o] = kk;
                KD[o] = kd0; KD[(size_t)T * RW + o] = kd1;
#endif
                if (lane == 0) BONUS[(size_t)t * RH + h] = bon;
#if !MK_RWKV_CHUNKED
                { const float br0 = wave_sum(kk * ic0[i] * r, lane), br1 = wave_sum(kk * ic1[i] * r, lane), kr0 = wave_sum(kd0 * r, lane), kr1 = wave_sum(kd1 * r, lane);
                  if (lane == 0) { BRKR[((size_t)t * RH + h) * 2] = br0; BRKR[((size_t)t * RH + h) * 2 + 1] = kr0; BRKR[((size_t)(T + t) * RH + h) * 2] = br1; BRKR[((size_t)(T + t) * RH + h) * 2 + 1] = kr1; } }
#endif
            }
        }
        __syncthreads();
        {
            u32x2 wb[9], vb[3];
            const int rsel = tid >= 192 ? 1 : 0, c4 = tid - rsel * 192;
#pragma unroll
            for (int it = 0; it < 9; ++it) {
                const int row = 2 * it + rsel, sq = s0 - 1 + row;
                wb[it] = (u32x2){0u, 0u};
                if (tid < 384 && sq >= 0 && sq < S) wb[it] = *(const u32x2*)(proj + (size_t)(t0 - 1 + row) * PLD + C_MW + c4 * 4);
            }
#pragma unroll
            for (int it = 0; it < 3; ++it) { const int idx = tid + it * NTHREADS, i = idx / 96, cc = (idx % 96) * 4; vb[it] = *(const u32x2*)(proj + (size_t)(t0 + i) * PLD + C_MW + 2 * MW + cc); }
            if (tid < 384) {
#pragma unroll
                for (int it = 0; it < 9; ++it) *(f32x4*)(win + (2 * it + rsel) * 768 + c4 * 4) = (f32x4){bf_lo(wb[it].x), bf_hi(wb[it].x), bf_lo(wb[it].y), bf_hi(wb[it].y)};
            }
#pragma unroll
            for (int it = 0; it < 3; ++it) { const int idx = tid + it * NTHREADS, i = idx / 96, cc = (idx % 96) * 4; const u32x2 v = vb[it];
                tv[(cc + 0) * 16 + i] = (bf16_t)(v.x & 0xffffu); tv[(cc + 1) * 16 + i] = (bf16_t)(v.x >> 16); tv[(cc + 2) * 16 + i] = (bf16_t)(v.y & 0xffffu); tv[(cc + 3) * 16 + i] = (bf16_t)(v.y >> 16); }
        }
        for (int idx = tid; idx < 16 * 24; idx += NTHREADS) {
            const int i = idx / 24, gi = idx % 24, t = t0 + i;
            const int isf = gi / 12, dir = (gi / 6) & 1, h = gi % 6;
            const float gg = projg[(size_t)t * 256 + (3456 - (PLD - 256)) + gi] + gate_b[gi];
            if (isf) LF[((size_t)dir * T + t) * MH + h] = -softplusf_(-gg); else IG[((size_t)dir * T + t) * MH + h] = gg;
        }
        __syncthreads();
        for (int rep_ = 0; rep_ < (MK_PROBE == 4 ? 2 : 1); ++rep_)
        for (int idx = tid; idx < 16 * 768; idx += NTHREADS) {
            const int i = idx / 768, c = idx % 768, t = t0 + i;
            const float* w_ = win + i * 768 + c;
            float y = conv_b[c] + w_[0] * conv_w[c] + w_[768] * conv_w[768 + c] + w_[1536] * conv_w[2 * 768 + c];
            y = y * sigmoidf_(y);
            if (c < MW) MQB[(size_t)t * MW + c] = (bf16_t)f2bf(y);
            else { const bf16_t kb = (bf16_t)f2bf(y * 0.125f); MKB[(size_t)t * MW + (c - MW)] = kb; tk[(c - MW) * 16 + i] = kb; }
        }
        __syncthreads();
        for (int idx = tid; idx < 2 * MW * 2; idx += NTHREADS) {
            const int hf = idx & 1, c = (idx >> 1) % MW, which = idx / (2 * MW);
            const u32x4 val = *(const u32x4*)((which ? tv : tk) + c * 16 + hf * 8);
            bf16_t* dst = (which ? VT : KT) + ((size_t)(bb * MH) * 64 + c) * S + s0 + hf * 8;
            *(u32x4*)dst = val;
        }
    }
    __syncthreads();
}

__device__ __forceinline__ void phase_gmlp_mix(const Params& P, int l, unsigned char* smem, int wv, int bid, int nb) {
    PIN_S(bid); PIN_S(nb);
    ParamsPtr pp = PARAMS_PTR(P); PIN_S(pp); unsigned char* ws = pp->ws;
    const float* UG = (const float*)(ws + O_UG); const bf16_t* VNT = (const bf16_t*)(ws + O_VNT); bf16_t* GRP = (bf16_t*)(ws + O_GRP);
    const bf16_t* WSB = (const bf16_t*)(ws + O_WSB) + (size_t)l * GH * CH * CH; const float* gbs = pp->in[5] + (size_t)l * GH * CH;
    const int tid = phase_tid(wv), lane = tid & 63, wave = tid >> 6, col = lane & 15, g = lane >> 4;
    for (int u = bid; u < NB * NCH * GH; u += nb) {
        const int h = u % GH, c = (u / GH) % NCH, b = u / (GH * NCH);
        const int tok0 = b * S + c * CH;
        const bf16_t* wb = WSB + (size_t)h * CH * CH + (size_t)(wave * 16 + col) * CH + 8 * g;
        const bf16_t* vb = VNT + ((size_t)b * GW + h * 64 + col) * S + (size_t)c * CH + 8 * g;
        f32x4 acc[4];
#pragma unroll
        for (int et = 0; et < 4; ++et) acc[et] = (f32x4){0.f, 0.f, 0.f, 0.f};
#pragma unroll
        for (int ks = 0; ks < 4; ++ks) {
            const bf16x8 af = *(const bf16x8*)(wb + ks * 32);
#pragma unroll
            for (int et = 0; et < 4; ++et) acc[et] = MFMA16(af, *(const bf16x8*)(vb + (size_t)et * 16 * S + ks * 32), acc[et]);
        }
#pragma unroll
        for (int r = 0; r < 4; ++r) {
            const int p = wave * 16 + 4 * g + r; const size_t t = (size_t)(tok0 + p); const float bsv = gbs[h * CH + p];
#pragma unroll
            for (int et = 0; et < 4; ++et) { const int ch = h * 64 + et * 16 + col; GRP[t * D + ch] = (bf16_t)f2bf(UG[t * GW + ch] * (acc[et][r] + bsv)); }
        }
    }
}

constexpr int SC_STEPS = 16;
constexpr int SC_BUF = SC_STEPS * 6 * 64;
__device__ __forceinline__ void phase_rwkv_scan(const Params& P, int l, unsigned char* smem, int wv, int bid, int nb) {
    PIN_S(bid); PIN_S(nb);
    ParamsPtr pp = PARAMS_PTR(P); PIN_S(pp); unsigned char* ws = pp->ws;
    const float* RR = (const float*)(ws + O_RR); const float* VV = (const float*)(ws + O_VV); const float* KK = (const float*)(ws + O_KK);
    const float* DEC = (const float*)(ws + O_DEC); const float* KD = (const float*)(ws + O_KD); const float* ICLR = (const float*)(ws + O_ICLR);
    float* SCAN = (float*)(ws + O_SCAN); const float* BRKR = (const float*)(ws + O_BRKR);
    const int tid = phase_tid(wv), lane = tid & 63, wave = tid >> 6, rl = (lane >> 4) & 1, kq = (lane & 15) | ((lane >> 5) << 4);
    float* buf = (float*)smem;
    float* scal = buf + 2 * SC_BUF;
    float* outb = scal + 2 * SC_STEPS * 2;
    typedef float f32x2 __attribute__((ext_vector_type(2)));
    for (int u = bid; u < 2 * NB * RH * 4; u += nb) {
        const int qt = u & 3, h = (u >> 2) % RH, b = (u / (4 * RH)) % NB, d = u / (4 * RH * NB);
        const size_t doff = (size_t)d * T * RW;
        float s0 = 0.f, s1 = 0.f;
        float pw[2], pa[2], pb[2], pk[2], pr[2], pv[2], psc = 0.f;
#define SC_LOAD(c) do { _Pragma("unroll") for (int i = 0; i < 2; ++i) { const int idx = tid + NTHREADS * i, st = idx >> 6, k = idx & 63; const int tau = (c) * SC_STEPS + st, sq = d ? S - 1 - tau : tau; \
            const size_t o = (size_t)(b * S + sq) * RW + h * 64 + k; \
            pw[i] = DEC[doff + o]; pa[i] = KK[o]; pb[i] = ICLR[doff + o]; pk[i] = KD[doff + o]; pr[i] = RR[o]; pv[i] = VV[o]; }     \
            if (tid < 2 * SC_STEPS) { const int tau = (c) * SC_STEPS + (tid >> 1), sq = d ? S - 1 - tau : tau; psc = BRKR[((size_t)(d * T + b * S + sq) * RH + h) * 2 + (tid & 1)]; } } while (0)
#define SC_WRITE(c) do { float* B_ = buf + ((c) & 1) * SC_BUF; _Pragma("unroll") for (int i = 0; i < 2; ++i) { const int idx = tid + NTHREADS * i, st = idx >> 6, k = idx & 63; \
            float* q_ = B_ + st * 384 + k; q_[0] = pw[i]; q_[64] = -pa[i]; q_[128] = pa[i] * pb[i]; q_[192] = pk[i]; q_[256] = pw[i] * pr[i]; q_[320] = pv[i]; } \
            if (tid < 2 * SC_STEPS) scal[((c) & 1) * SC_STEPS * 2 + tid] = psc; } while (0)
        __syncthreads();
        SC_LOAD(0); SC_WRITE(0);
        __syncthreads();
        const int row = qt * 16 + wave * 2 + rl;
        for (int c = 0; c < S / SC_STEPS; ++c) {
            const bool more = (c + 1) < S / SC_STEPS;
            if (more) SC_LOAD(c + 1);
            const float* B = buf + (c & 1) * SC_BUF; const float* sc = scal + (c & 1) * SC_STEPS * 2; float* ob = outb + (c & 1) * SC_STEPS * 16;
            float outs[SC_STEPS];
            f32x2 w2 = *(const f32x2*)(B + 2 * kq), a2 = *(const f32x2*)(B + 64 + 2 * kq), b2 = *(const f32x2*)(B + 128 + 2 * kq);
            f32x2 k2 = *(const f32x2*)(B + 192 + 2 * kq), wr2 = *(const f32x2*)(B + 256 + 2 * kq);
            float v = B[320 + row]; float br = sc[0], kr = sc[1];
#pragma unroll
            for (int st = 0; st < SC_STEPS; ++st) {
                const int sn = st + 1 < SC_STEPS ? st + 1 : st;
                const float* q = B + sn * 384;
                const f32x2 nw2 = *(const f32x2*)(q + 2 * kq), na2 = *(const f32x2*)(q + 64 + 2 * kq), nb2 = *(const f32x2*)(q + 128 + 2 * kq);
                const f32x2 nk2 = *(const f32x2*)(q + 192 + 2 * kq), nwr2 = *(const f32x2*)(q + 256 + 2 * kq);
                const float nv = q[320 + row], nbr = sc[sn * 2], nkr = sc[sn * 2 + 1];
                SCHED_BAR();
                float sa = s0 * a2.x + s1 * a2.y;
                float po = s0 * wr2.x + s1 * wr2.y;
                sa = row32_sum(sa); po = row32_sum(po);
                outs[st] = po + sa * br + v * kr;
                s0 = s0 * w2.x + (sa * b2.x + v * k2.x); s1 = s1 * w2.y + (sa * b2.y + v * k2.y);
                SCHED_BAR();
                w2 = nw2; a2 = na2; b2 = nb2; k2 = nk2; wr2 = nwr2; v = nv; br = nbr; kr = nkr;
            }
            if (kq == 0) {
#pragma unroll
                for (int st = 0; st < SC_STEPS; ++st) ob[st * 16 + wave * 2 + rl] = outs[st];
            }
            if (more) SC_WRITE(c + 1);
            __syncthreads();
            if (tid < 16 * SC_STEPS) {
                const int st = tid >> 4, r = tid & 15, tau = c * SC_STEPS + st, sq = d ? S - 1 - tau : tau;
                SCAN[doff + (size_t)(b * S + sq) * RW + h * 64 + qt * 16 + r] = ob[st * 16 + r];
            }
        }
#undef SC_LOAD
#undef SC_WRITE
    }
    __syncthreads();
}

constexpr int RST = 72;
constexpr int RARR = 64 * RST;
__device__ __forceinline__ f32x4 tile_nt(const bf16_t* Aa, int ta, const bf16_t* Ba, int tb, f32x4 acc, int col, int g) {
#pragma unroll
    for (int ks = 0; ks < 2; ++ks) {
        const bf16x8 af = *(const bf16x8*)(Aa + (ta * 16 + col) * RST + ks * 32 + 8 * g);
        const bf16x8 bfr = *(const bf16x8*)(Ba + (tb * 16 + col) * RST + ks * 32 + 8 * g);
        acc = MFMA16(af, bfr, acc);
    }
    return acc;
}
__device__ __forceinline__ void phase_rwkv_pre(const Params& P, int l, unsigned char* smem, int wv) {
    ParamsPtr pp = PARAMS_PTR(P); PIN_S(pp); unsigned char* ws = pp->ws; int bidx = (int)blockIdx.x, gdim = (int)gridDim.x; PIN_S(bidx); PIN_S(gdim);
    const bf16_t* RB = (const bf16_t*)(ws + O_RB); const bf16_t* VB = (const bf16_t*)(ws + O_VB); const bf16_t* KKB = (const bf16_t*)(ws + O_KKB);
    const float* LWG = (const float*)(ws + O_LW); const bf16_t* KDB = (const bf16_t*)(ws + O_KDB); const bf16_t* BBB = (const bf16_t*)(ws + O_BBB);
    bf16_t* Qg = (bf16_t*)(ws + O_RQ); bf16_t* Ag = (bf16_t*)(ws + O_RA); bf16_t* Hg = (bf16_t*)(ws + O_RH); bf16_t* Gg = (bf16_t*)(ws + O_RG);
    const int tid0 = phase_tid(wv);
#define RW_STAGE_VARS int tid = tid0; PIN_V(tid); const int lane = tid & 63, wave = tid >> 6, col = lane & 15, g = lane >> 4; (void)lane; (void)wave; (void)col; (void)g;
    bf16_t* At = (bf16_t*)smem; bf16_t* Bt = At + RARR; bf16_t* Kt = Bt + RARR; bf16_t* Rt = Kt + RARR;
    bf16_t* BtT = Rt + RARR; bf16_t* KtT = BtT + RARR; bf16_t* VT = KtT + RARR;
    bf16_t* Lak = VT + RARR; bf16_t* Mrb = Lak + RARR; bf16_t* Mrk = Mrb + RARR; bf16_t* YT = Mrk + RARR; bf16_t* W2T = YT + RARR;
    bf16_t* Lbo = W2T + RARR;
    float* LabT = (float*)(Lbo + RARR);
    float* Xs = LabT + 4096;
    float* Pb = Xs + 4096;
    float* segs = Pb + 2048;
    float* PC = segs + 512;
    float plw[8]; unsigned pkk[8], pbq[8], pkd[8], prr[8], pvv[8];
#define RW_LOAD(uu) do { const int c_ = (uu) % RNC, h_ = ((uu) / RNC) % RH, b_ = ((uu) / (RNC * RH)) % NB, d_ = (uu) / (RNC * RH * NB); const size_t doff_ = (size_t)d_ * T * RW; \
        const int ch_ = tid0 & 63, sg_ = tid0 >> 6; _Pragma("unroll") for (int j = 0; j < 8; ++j) { const int tau = c_ * RC + sg_ * 8 + j, sq = d_ ? S - 1 - tau : tau; const size_t o = (size_t)(b_ * S + sq) * RW + h_ * 64 + ch_; \
        plw[j] = LWG[doff_ + o]; pkk[j] = KKB[o]; pbq[j] = BBB[doff_ + o]; pkd[j] = KDB[doff_ + o]; prr[j] = RB[o]; pvv[j] = VB[o]; } } while (0)
    if (bidx < RUN) RW_LOAD(bidx);
    for (int u = bidx; u < RUN; u += gdim) {
        const int c = u % RNC, h = (u / RNC) % RH, b = (u / (RNC * RH)) % NB, d = u / (RNC * RH * NB);
        (void)c; (void)h; (void)b; (void)d;
        __syncthreads();
        {
            RW_STAGE_VARS
            const int ch = tid & 63, sg = tid >> 6;
            float lw[8]; unsigned kk[8], bq_[8], kd[8], rr[8], vv[8];
#pragma unroll
            for (int j = 0; j < 8; ++j) { lw[j] = plw[j]; kk[j] = pkk[j]; bq_[j] = pbq[j]; kd[j] = pkd[j]; rr[j] = prr[j]; vv[j] = pvv[j]; }
            if (u + gdim < RUN) RW_LOAD(u + gdim);
            float run = 0.f;
#pragma unroll
            for (int j = 0; j < 8; ++j) { run += lw[j]; lw[j] = run; }
            segs[sg * 64 + ch] = run;
            __syncthreads();
            float off = 0.f;
            for (int q = 0; q < sg; ++q) off += segs[q * 64 + ch];
            u32x4 pbt, pkt, pvt; unsigned tb[8], tk[8], tvv[8];
            float prev = off;
#pragma unroll
            for (int j = 0; j < 8; ++j) {
                const int t = sg * 8 + j; const float cl = off + lw[j];
                const float ep = fexp(prev), en = fexp(-cl), epc = fexp(cl);
                const unsigned a_ = f2bf(-bf_lo(kk[j]) * ep), b_ = f2bf(bf_lo(bq_[j]) * en), k_ = f2bf(bf_lo(kd[j]) * en), r_ = f2bf(bf_lo(rr[j]) * epc), v_ = vv[j];
                At[t * RST + ch] = (bf16_t)a_; Bt[t * RST + ch] = (bf16_t)b_; Kt[t * RST + ch] = (bf16_t)k_; Rt[t * RST + ch] = (bf16_t)r_;
                tb[j] = b_; tk[j] = k_; tvv[j] = v_;
                prev = cl;
            }
            if (sg == 7) PC[ch] = fexp(prev);
            pbt.x = tb[0] | (tb[1] << 16); pbt.y = tb[2] | (tb[3] << 16); pbt.z = tb[4] | (tb[5] << 16); pbt.w = tb[6] | (tb[7] << 16);
            pkt.x = tk[0] | (tk[1] << 16); pkt.y = tk[2] | (tk[3] << 16); pkt.z = tk[4] | (tk[5] << 16); pkt.w = tk[6] | (tk[7] << 16);
            pvt.x = tvv[0] | (tvv[1] << 16); pvt.y = tvv[2] | (tvv[3] << 16); pvt.z = tvv[4] | (tvv[5] << 16); pvt.w = tvv[6] | (tvv[7] << 16);
            *(u32x4*)(BtT + ch * RST + sg * 8) = pbt; *(u32x4*)(KtT + ch * RST + sg * 8) = pkt; *(u32x4*)(VT + ch * RST + sg * 8) = pvt;
            for (int z_ = tid; z_ < 2 * RARR / 8; z_ += NTHREADS) ((u32x4*)YT)[z_] = (u32x4){0u, 0u, 0u, 0u};
        }
        __syncthreads();
        {
            RW_STAGE_VARS
            const int m = wave >> 1;
            const bf16_t* Ym = (m == 0 || m == 2) ? Bt : Kt; const bf16_t* Xm = (m < 2) ? At : Rt;
#pragma unroll 1
            for (int q = 0; q < 8; ++q) {
                const int tix = (wave & 1) * 8 + q, it = tix >> 2, tt = tix & 3;
                f32x4 acc = (f32x4){0.f, 0.f, 0.f, 0.f};
                if (it <= tt) acc = tile_nt(Ym, it, Xm, tt, acc, col, g);
                const int t = tt * 16 + col, i0 = it * 16 + 4 * g;
                float o4[4];
#pragma unroll
                for (int r = 0; r < 4; ++r) { const int i = i0 + r; const bool ok = m < 2 ? (i < t) : (i <= t); o4[r] = ok ? acc[r] : 0.f; }
                if (m == 0) {
#pragma unroll
                    for (int r = 0; r < 4; ++r) LabT[(i0 + r) * 64 + t] = o4[r];
                    const bool offd = it < tt;
                    u32x2 w2; w2.x = offd ? pk2(o4[0], o4[1]) : 0u; w2.y = offd ? pk2(o4[2], o4[3]) : 0u; *(u32x2*)(Lbo + t * RST + i0) = w2;
                }
                else { bf16_t* dst = (m == 1 ? Lak : (m == 2 ? Mrb : Mrk)) + t * RST + i0; u32x2 w2; w2.x = pk2(o4[0], o4[1]); w2.y = pk2(o4[2], o4[3]); *(u32x2*)dst = w2; }
            }
        }
        __syncthreads();
        {
            RW_STAGE_VARS
#pragma unroll
            for (int q = 0; q < 2; ++q) {
                const int tix = wave * 2 + q, tt = tix >> 2, et = tix & 3;
                f32x4 acc = (f32x4){0.f, 0.f, 0.f, 0.f};
                acc = tile_nt(Lak, tt, VT, et, acc, col, g);
#pragma unroll
                for (int r = 0; r < 4; ++r) Xs[(tt * 16 + 4 * g + r) * 64 + et * 16 + col] = acc[r];
            }
        }
        __syncthreads();
        {
            RW_STAGE_VARS
#pragma unroll 1
            for (int bb = 0; bb < 4; ++bb) {
                if (bb > 0) {
                    const bf16_t* Zt = (wave < 4 ? YT : W2T) + ((wave & 3) * 16 + col) * RST + 8 * g;
                    const bf16_t* La = Lbo + (16 * bb + col) * RST + 8 * g;
                    f32x4 acc = (f32x4){0.f, 0.f, 0.f, 0.f};
                    acc = MFMA16(*(const bf16x8*)La, *(const bf16x8*)Zt, acc);
                    if (bb > 2) acc = MFMA16(*(const bf16x8*)(La + 32), *(const bf16x8*)(Zt + 32), acc);
#pragma unroll
                    for (int r = 0; r < 4; ++r) Pb[(4 * g + r) * 128 + wave * 16 + col] = acc[r];
                }
                __syncthreads();
                if (wave < 2) {
                    float acc[16];
                    if (wave == 0) {
#pragma unroll
                        for (int r = 0; r < 16; ++r) acc[r] = bf_lo((unsigned)At[(16 * bb + r) * RST + lane]);
                    } else {
#pragma unroll
                        for (int r = 0; r < 16; ++r) acc[r] = Xs[(16 * bb + r) * 64 + lane];
                    }
                    if (bb > 0) {
#pragma unroll
                        for (int r = 0; r < 16; ++r) acc[r] += Pb[r * 128 + wave * 64 + lane];
                    }
                    const float* dp = LabT + (16 * bb) * 64 + 16 * bb;
#pragma unroll
                    for (int r = 1; r < 16; ++r)
#pragma unroll
                        for (int r2 = 0; r2 < r; ++r2) acc[r] += dp[r2 * 64 + r] * acc[r2];
                    bf16_t* dst = (wave == 0 ? YT : W2T) + lane * RST;
                    u32x4 w0, w1;
                    w0.x = pk2(acc[0], acc[1]); w0.y = pk2(acc[2], acc[3]); w0.z = pk2(acc[4], acc[5]); w0.w = pk2(acc[6], acc[7]);
                    w1.x = pk2(acc[8], acc[9]); w1.y = pk2(acc[10], acc[11]); w1.z = pk2(acc[12], acc[13]); w1.w = pk2(acc[14], acc[15]);
                    *(u32x4*)(dst + 16 * bb) = w0; *(u32x4*)(dst + 16 * bb + 8) = w1;
                }
                __syncthreads();
            }
        }
        __syncthreads();
        {
            RW_STAGE_VARS
            const int ty = wave >> 1;
#pragma unroll 1
            for (int q = 0; q < 8; ++q) {
                const int tix = (wave & 1) * 8 + q, ra = tix >> 2, cb = tix & 3;
                f32x4 acc = (f32x4){0.f, 0.f, 0.f, 0.f};
                if (ty == 0) {
                    acc = tile_nt(YT, ra, Mrb, cb, acc, col, g);
                    const u32x2 rt2 = *(const u32x2*)(Rt + (cb * 16 + col) * RST + ra * 16 + 4 * g);
                    u32x2 qb2; qb2.x = pk2(acc[0] + bf_lo(rt2.x), acc[1] + bf_hi(rt2.x)); qb2.y = pk2(acc[2] + bf_lo(rt2.y), acc[3] + bf_hi(rt2.y));
                    *(u32x2*)(Qg + (size_t)u * 4096 + (tix * 64 + lane) * 4) = qb2;
                } else if (ty == 1) {
                    acc = tile_nt(Mrb, ra, W2T, cb, acc, col, g); acc = tile_nt(Mrk, ra, VT, cb, acc, col, g);
                    { u32x2 hb; hb.x = pk2(acc[0], acc[1]); hb.y = pk2(acc[2], acc[3]); *(u32x2*)(Hg + (size_t)u * 4096 + (tix * 64 + lane) * 4) = hb; }
                } else if (ty == 2) {
                    acc = tile_nt(YT, ra, BtT, cb, acc, col, g);
                    const float pc = PC[cb * 16 + col]; const int k1 = cb * 16 + col;
                    float a4[4];
#pragma unroll
                    for (int r = 0; r < 4; ++r) a4[r] = pc * (acc[r] + ((ra * 16 + 4 * g + r) == k1 ? 1.0f : 0.f));
                    u32x2 ab2; ab2.x = pk2(a4[0], a4[1]); ab2.y = pk2(a4[2], a4[3]);
                    *(u32x2*)(Ag + (size_t)u * 4096 + (tix * 64 + lane) * 4) = ab2;
                } else {
                    acc = tile_nt(BtT, ra, W2T, cb, acc, col, g); acc = tile_nt(KtT, ra, VT, cb, acc, col, g);
#pragma unroll
                    for (int r = 0; r < 4; ++r) acc[r] *= PC[ra * 16 + 4 * g + r];
                    { u32x2 gb2; gb2.x = pk2(acc[0], acc[1]); gb2.y = pk2(acc[2], acc[3]); *(u32x2*)(Gg + (size_t)u * 4096 + (tix * 64 + lane) * 4) = gb2; }
                }
            }
        }
    }
    __syncthreads();
#undef RW_STAGE_VARS
#undef RW_LOAD
}
__device__ __forceinline__ void phase_rwkv_seq(const Params& P, int l, unsigned char* smem, int wv) {
    ParamsPtr pp = PARAMS_PTR(P); PIN_S(pp); unsigned char* ws = pp->ws; int bidx = (int)blockIdx.x, gdim = (int)gridDim.x; PIN_S(bidx); PIN_S(gdim);
    const bf16_t* Ag = (const bf16_t*)(ws + O_RA); const bf16_t* Gg = (const bf16_t*)(ws + O_RG); bf16_t* Sg = (bf16_t*)(ws + O_RS);
    const int tid = phase_tid(wv), lane = tid & 63, wave = tid >> 6, col = lane & 15, g = lane >> 4;
    const int gw = wave * gdim + bidx, ngw = NWAVES * gdim;
    for (int un = gw; un < 2 * NB * RH * 2; un += ngw) {
        const int ch = un >> 1, eh = un & 1;
        f32x4 acc[4][2];
#pragma unroll
        for (int a_ = 0; a_ < 4; ++a_)
#pragma unroll
            for (int b_ = 0; b_ < 2; ++b_) acc[a_][b_] = (f32x4){0.f, 0.f, 0.f, 0.f};
        u32x2 alo[4][2], ahi[4][2]; u32x2 gq[4][2];
        const unsigned aoff = (unsigned)(col * 64 + 4 * g), goff = (unsigned)(lane * 4);
#define RS_LOAD(cc) do { const bf16_t* ab_ = Ag + (size_t)(ch * RNC + (cc)) * 4096; const bf16_t* gb_ = Gg + (size_t)(ch * RNC + (cc)) * 4096 + eh * 512; \
            _Pragma("unroll") for (int ra = 0; ra < 4; ++ra) _Pragma("unroll") for (int p = 0; p < 2; ++p) { alo[ra][p] = *(const u32x2*)(ab_ + ((2 * p * 4 + ra) * 256) + goff); ahi[ra][p] = *(const u32x2*)(ab_ + (((2 * p + 1) * 4 + ra) * 256) + goff); } \
            _Pragma("unroll") for (int ra = 0; ra < 4; ++ra) _Pragma("unroll") for (int cb = 0; cb < 2; ++cb) gq[ra][cb] = *(const u32x2*)(gb_ + ((ra * 4 + cb) * 256) + goff); } while (0)
        RS_LOAD(0);
#pragma unroll 1
        for (int c = 0; c < RNC; ++c) {
            bf16_t* sb_ = Sg + (size_t)(ch * RNC + c) * 4096 + eh * 2048;
            bf16x8 bq[2][2];
#pragma unroll
            for (int cb = 0; cb < 2; ++cb) {
#pragma unroll
                for (int ra = 0; ra < 4; ++ra) {
                    u32x2 w2; w2.x = pk2(acc[ra][cb][0], acc[ra][cb][1]); w2.y = pk2(acc[ra][cb][2], acc[ra][cb][3]);
                    *(u32x2*)(sb_ + (cb * 1024 + ra * 16) + aoff) = w2;
                }
#pragma unroll
                for (int p = 0; p < 2; ++p) bq[p][cb] = cvt8(acc[2 * p][cb], acc[2 * p + 1][cb]);
            }
            u32x4 af[4][2];
#pragma unroll
            for (int ra = 0; ra < 4; ++ra) {
#pragma unroll
                for (int p = 0; p < 2; ++p) af[ra][p] = (u32x4){alo[ra][p].x, alo[ra][p].y, ahi[ra][p].x, ahi[ra][p].y};
#pragma unroll
                for (int cb = 0; cb < 2; ++cb) acc[ra][cb] = (f32x4){bf_lo(gq[ra][cb].x), bf_hi(gq[ra][cb].x), bf_lo(gq[ra][cb].y), bf_hi(gq[ra][cb].y)};
            }
            if (c + 1 < RNC) RS_LOAD(c + 1);
#pragma unroll
            for (int ra = 0; ra < 4; ++ra)
#pragma unroll
                for (int cb = 0; cb < 2; ++cb)
#pragma unroll
                    for (int p = 0; p < 2; ++p) acc[ra][cb] = MFMA16(__builtin_bit_cast(bf16x8, af[ra][p]), bq[p][cb], acc[ra][cb]);
        }
#undef RS_LOAD
    }
}
__device__ __forceinline__ void phase_rwkv_out(const Params& P, int l, unsigned char* smem, int wv) {
    ParamsPtr pp = PARAMS_PTR(P); PIN_S(pp); unsigned char* ws = pp->ws; int bidx = (int)blockIdx.x, gdim = (int)gridDim.x; PIN_S(bidx); PIN_S(gdim);
    const bf16_t* Qg = (const bf16_t*)(ws + O_RQ); const bf16_t* Sg = (const bf16_t*)(ws + O_RS); const bf16_t* Hg = (const bf16_t*)(ws + O_RH);
    const bf16_t* VB = (const bf16_t*)(ws + O_VB); const float* GATE = (const float*)(ws + O_GATE); const float* BONUS = (const float*)(ws + O_BONUS);
    bf16_t* GRP = (bf16_t*)(ws + O_GRP);
    const float* rln_g = pp->in[15] + (size_t)l * RW; const float* rln_b = pp->in[16] + (size_t)l * RW;
    const int tid = phase_tid(wv), lane = tid & 63, wave = tid >> 6, col = lane & 15, g = lane >> 4;
    for (int pu = bidx * NWAVES + wave; pu < NB * RH * RNC; pu += gdim * NWAVES) {
        const int c = pu % RNC, h = (pu / RNC) % RH, b = pu / (RNC * RH);
        f32x4 o[2][4][4];
#pragma unroll
        for (int d = 0; d < 2; ++d) {
            const int u = ((d * NB + b) * RH + h) * RNC + (d ? RNC - 1 - c : c);
            const size_t ub = (size_t)u * 4096;
            bf16x8 qa[4][2], sb[4][2];
#pragma unroll
            for (int q = 0; q < 4; ++q)
#pragma unroll
                for (int ks = 0; ks < 2; ++ks) {
                    const u32x2 q0 = *(const u32x2*)(Qg + ub + ((2 * ks * 4 + q) * 64 + lane) * 4), q1 = *(const u32x2*)(Qg + ub + (((2 * ks + 1) * 4 + q) * 64 + lane) * 4);
                    qa[q][ks] = __builtin_bit_cast(bf16x8, (u32x4){q0.x, q0.y, q1.x, q1.y});
                    const bf16_t* sp_ = Sg + ub + (q * 16 + col) * 64 + ks * 32 + 4 * g;
                    const u32x2 s0_ = *(const u32x2*)sp_, s1_ = *(const u32x2*)(sp_ + 16);
                    sb[q][ks] = __builtin_bit_cast(bf16x8, (u32x4){s0_.x, s0_.y, s1_.x, s1_.y});
                }
#pragma unroll
            for (int tt = 0; tt < 4; ++tt)
#pragma unroll
                for (int et = 0; et < 4; ++et) {
                    const u32x2 hb = *(const u32x2*)(Hg + ub + ((tt * 4 + et) * 64 + lane) * 4);
                    f32x4 acc = (f32x4){bf_lo(hb.x), bf_hi(hb.x), bf_lo(hb.y), bf_hi(hb.y)};
#pragma unroll
                    for (int ks = 0; ks < 2; ++ks) acc = MFMA16(qa[tt][ks], sb[et][ks], acc);
                    o[d][tt][et] = acc;
                }
        }
        const int src = (3 - g) * 16 + col;
#pragma unroll
        for (int tt = 0; tt < 4; ++tt)
#pragma unroll
            for (int et = 0; et < 4; ++et)
#pragma unroll
                for (int r = 0; r < 4; ++r) o[0][tt][et][r] += SHL(o[1][3 - tt][et][3 - r], src);
        float* tile = (float*)smem + wave * (64 * 68);
        WAVE_SYNC();
#pragma unroll
        for (int tt = 0; tt < 4; ++tt)
#pragma unroll
            for (int et = 0; et < 4; ++et)
#pragma unroll
                for (int r = 0; r < 4; ++r) tile[(tt * 16 + 4 * g + r) * 68 + et * 16 + col] = o[0][tt][et][r];
        WAVE_SYNC();
        {
            const int c4 = (lane & 15) * 4, ch = h * 64 + c4;
            const f32x4 lg = *(const f32x4*)(rln_g + ch), lb = *(const f32x4*)(rln_b + ch);
#pragma unroll 1
            for (int qb = 0; qb < 2; ++qb) {
                f32x4 gt_[8]; u32x2 vb_[8]; float bo_[8];
#pragma unroll
                for (int q8 = 0; q8 < 8; ++q8) {
                    const size_t t = (size_t)(b * S + c * RC + (qb * 8 + q8) * 4 + (lane >> 4));
                    gt_[q8] = *(const f32x4*)(GATE + t * RW + ch); vb_[q8] = *(const u32x2*)(VB + t * RW + ch); bo_[q8] = BONUS[t * RH + h];
                }
#pragma unroll
                for (int q8 = 0; q8 < 8; ++q8) {
                    const int tl = (qb * 8 + q8) * 4 + (lane >> 4);
                    const size_t t = (size_t)(b * S + c * RC + tl);
                    const f32x4 x = *(const f32x4*)(tile + tl * 68 + c4);
                    const float mean = row16_sum((x.x + x.y) + (x.z + x.w)) * (1.0f / 64.0f);
                    const f32x4 dl = x - mean;
                    const float var = row16_sum((dl.x * dl.x + dl.y * dl.y) + (dl.z * dl.z + dl.w * dl.w)) * (1.0f / 64.0f);
                    const float rstd = 1.0f / sqrtf(var + GN_EPS);
                    f32x4 y = dl * rstd * lg + lb;
                    y.x += bo_[q8] * bf_lo(vb_[q8].x); y.y += bo_[q8] * bf_hi(vb_[q8].x); y.z += bo_[q8] * bf_lo(vb_[q8].y); y.w += bo_[q8] * bf_hi(vb_[q8].y);
                    y = y * gt_[q8];
                    u32x2 ob; ob.x = pk2(y.x, y.y); ob.y = pk2(y.z, y.w);
                    *(u32x2*)(GRP + t * D + GW + ch) = ob;
                }
            }
        }
    }
    __syncthreads();
}

__device__ __forceinline__ void phase_mlstm_local(const Params& P, int l, unsigned char* smem, int wv, int bid, int nb) {
    PIN_S(bid); PIN_S(nb);
    ParamsPtr pp = PARAMS_PTR(P); PIN_S(pp); unsigned char* ws = pp->ws;
    const bf16_t* KT = (const bf16_t*)(ws + O_KT); const bf16_t* VT = (const bf16_t*)(ws + O_VT);
    const float* IG = (const float*)(ws + O_IG); const float* LF = (const float*)(ws + O_LF);
    float* CL = (float*)(ws + O_CL); float* NLb = (float*)(ws + O_NL); float* ML = (float*)(ws + O_ML); float* BL = (float*)(ws + O_BL);
    float* GVT = (float*)(ws + O_GVT); float* PMX = (float*)(ws + O_PMX); float* BCT = (float*)(ws + O_BCT);
    const int tid = phase_tid(wv), lane = tid & 63, wave = tid >> 6, col = lane & 15, g = lane >> 4;
    float* wts = (float*)smem + wave * 128;
    for (int u = bid * NWAVES + wave; u < 2 * NB * MH * NCH; u += nb * NWAVES) {
        const int c = u % NCH, h = (u / NCH) % MH, p = u / (NCH * MH), d = p / NB, b = p % NB;
        const int tc = d ? NCH - 1 - c : c, tok0 = b * S + tc * CH;
        const int i0 = d ? 127 - 2 * lane : 2 * lane, i1 = d ? i0 - 1 : i0 + 1;
        const size_t g0 = ((size_t)d * T + tok0 + i0) * MH + h, g1 = ((size_t)d * T + tok0 + i1) * MH + h;
        const float lf0 = LF[g0], lf1 = LF[g1], ig0 = IG[g0], ig1 = IG[g1];
        const float c1 = lf0 + lf1;
        float incl = c1;
#pragma unroll
        for (int o = 1; o < 64; o <<= 1) { const float tq = SHUP(incl, o, lane); if (lane >= o) incl += tq; }
        const float excl = incl - c1, bc0 = excl + lf0, bc1 = incl;
        const float blast = RDL(incl, 63);
        const float gv0 = ig0 - bc0, gv1 = ig1 - bc1, pl1 = fmaxf(gv0, gv1);
        float mincl = pl1;
#pragma unroll
        for (int o = 1; o < 64; o <<= 1) { const float tq = SHUP(mincl, o, lane); if (lane >= o) mincl = fmaxf(mincl, tq); }
        float mexcl = SHUP(mincl, 1, lane); if (lane == 0) mexcl = -INFINITY;
        const float pm0 = fmaxf(mexcl, gv0), pm1 = mincl;
        const float mloc = blast + RDL(mincl, 63);
        WAVE_SYNC();
        wts[i0] = fexp(blast + gv0 - mloc); wts[i1] = fexp(blast + gv1 - mloc);
        GVT[g0] = gv0; GVT[g1] = gv1; PMX[g0] = pm0; PMX[g1] = pm1; BCT[g0] = bc0; BCT[g1] = bc1;
        if (lane == 0) { ML[u] = mloc; BL[u] = blast; }
        WAVE_SYNC();
        const bf16_t* vbase = VT + ((size_t)(b * MH + h) * 64) * S + (size_t)tc * CH;
        const bf16_t* kbase = KT + ((size_t)(b * MH + h) * 64) * S + (size_t)tc * CH;
        const unsigned loff = (unsigned)(col * S + 8 * g);
        f32x4 acc[4][4];
#pragma unroll
        for (int a_ = 0; a_ < 4; ++a_)
#pragma unroll
            for (int b_ = 0; b_ < 4; ++b_) acc[a_][b_] = (f32x4){0.f, 0.f, 0.f, 0.f};
        float nsum[4] = {0.f, 0.f, 0.f, 0.f};
#pragma unroll 1
        for (int ks = 0; ks < 4; ++ks) {
            const int ii = ks * 32 + 8 * g;
            const f32x4 w0 = *(const f32x4*)(wts + ii), w1 = *(const f32x4*)(wts + ii + 4);
            bf16x8 af[4], bfk[4];
#pragma unroll
            for (int q = 0; q < 4; ++q) af[q] = *(const bf16x8*)(vbase + ((size_t)q * 16 * S + ks * 32) + loff);
#pragma unroll
            for (int q = 0; q < 4; ++q) {
                const u32x4 kr = *(const u32x4*)(kbase + ((size_t)q * 16 * S + ks * 32) + loff);
                f32x4 k0, k1;
                k0.x = bf_lo(kr.x) * w0.x; k0.y = bf_hi(kr.x) * w0.y; k0.z = bf_lo(kr.y) * w0.z; k0.w = bf_hi(kr.y) * w0.w;
                k1.x = bf_lo(kr.z) * w1.x; k1.y = bf_hi(kr.z) * w1.y; k1.z = bf_lo(kr.w) * w1.z; k1.w = bf_hi(kr.w) * w1.w;
                nsum[q] += (k0.x + k0.y) + (k0.z + k0.w) + (k1.x + k1.y) + (k1.z + k1.w);
                bfk[q] = cvt8(k0, k1);
            }
#pragma unroll
            for (int a_ = 0; a_ < 4; ++a_)
#pragma unroll
                for (int b_ = 0; b_ < 4; ++b_) acc[a_][b_] = MFMA16(af[a_], bfk[b_], acc[a_][b_]);
        }
        float* cbase = CL + (size_t)u * 4096;
        const unsigned coff = (unsigned)(4 * g * 64 + col);
#pragma unroll
        for (int b_ = 0; b_ < 4; ++b_) {
#pragma unroll
            for (int a_ = 0; a_ < 4; ++a_)
#pragma unroll
                for (int r = 0; r < 4; ++r) cbase[(a_ * 16 * 64 + r * 64 + b_ * 16) + coff] = acc[a_][b_][r];
            float ns = nsum[b_]; ns += SHX(ns, 16, lane); ns += SHX(ns, 32, lane);
            if (g == 0) NLb[(size_t)u * 64 + b_ * 16 + col] = ns;
        }
    }
    __syncthreads();
}

__device__ __forceinline__ void phase_mlstm_carry(const Params& P, int l, unsigned char* smem, int wv) {
    ParamsPtr pp = PARAMS_PTR(P); PIN_S(pp); unsigned char* ws = pp->ws; int bidx = (int)blockIdx.x, gdim = (int)gridDim.x; PIN_S(bidx); PIN_S(gdim);
    float* CL = (float*)(ws + O_CL); float* NLb = (float*)(ws + O_NL); const float* ML = (const float*)(ws + O_ML); const float* BL = (const float*)(ws + O_BL);
    float* MIN = (float*)(ws + O_MIN);
    const int total = 2 * NB * MH * 4160;
    const int tid = phase_tid(wv);
    for (int gi = bidx * NTHREADS + tid; gi < total; gi += gdim * NTHREADS) {
        const int ph = gi / 4160, e = gi % 4160;
        float* base_ = e < 4096 ? CL + (size_t)ph * NCH * 4096 + e : NLb + (size_t)ph * NCH * 64 + (e - 4096);
        const int stride = e < 4096 ? 4096 : 64;
        static_assert(NCH <= 32, "carry scan keeps one chunk value per register");
        float loc[NCH], bl[NCH], ml[NCH];
#pragma unroll
        for (int c = 0; c < NCH; ++c) { loc[c] = base_[(size_t)c * stride]; bl[c] = BL[ph * NCH + c]; ml[c] = ML[ph * NCH + c]; }
        float m = 0.f, val = 0.f;
#pragma unroll
        for (int c = 0; c < NCH; ++c) {
            base_[(size_t)c * stride] = val;
            if (e == 0) MIN[ph * NCH + c] = m;
            const float mn = fmaxf(bl[c] + m, ml[c]);
            val = fexp(bl[c] + m - mn) * val + fexp(ml[c] - mn) * loc[c];
            m = mn;
        }
    }
}

__device__ __forceinline__ void phase_mlstm_out(const Params& P, int l, unsigned char* smem, int wv) {
    ParamsPtr pp = PARAMS_PTR(P); PIN_S(pp); unsigned char* ws = pp->ws; int bidx = (int)blockIdx.x, gdim = (int)gridDim.x; PIN_S(bidx); PIN_S(gdim);
    const bf16_t* proj = (const bf16_t*)(ws + O_PROJ);
    const bf16_t* MQB = (const bf16_t*)(ws + O_MQB); const bf16_t* MKB = (const bf16_t*)(ws + O_MKB); const bf16_t* VT = (const bf16_t*)(ws + O_VT);
    const float* GVT = (const float*)(ws + O_GVT); const float* PMX = (const float*)(ws + O_PMX); const float* BCT = (const float*)(ws + O_BCT);
    const float* CL = (const float*)(ws + O_CL); const float* NLb = (const float*)(ws + O_NL); const float* MIN = (const float*)(ws + O_MIN);
    bf16_t* GRP = (bf16_t*)(ws + O_GRP);
    const float* mln_g = pp->in[20] + (size_t)l * MW;
    const int tid = phase_tid(wv), lane = tid & 63, wave = tid >> 6, col = lane & 15, g = lane >> 4;
    constexpr int KP = 72, VP = 136;
    bf16_t* Ks = (bf16_t*)smem;
    bf16_t* Vs = Ks + 128 * KP;
    float* gvs_ = (float*)(Vs + 64 * VP);
    for (int u = bidx; u < NB * MH * NCH; u += gdim) {
        const int tc = u % NCH, h = (u / NCH) % MH, b = u / (NCH * MH);
        const int tok0 = b * S + tc * CH, it = wave * 16 + col;
        __syncthreads();
        {
            u32x4 kb_[2], vb_[2];
#pragma unroll
            for (int q = 0; q < 2; ++q) {
                const int idx = tid + q * NTHREADS;
                kb_[q] = *(const u32x4*)(MKB + (size_t)(tok0 + (idx >> 3)) * MW + h * 64 + (idx & 7) * 8);
                vb_[q] = *(const u32x4*)(VT + ((size_t)(b * MH + h) * 64 + (idx >> 4)) * S + (size_t)tc * CH + (idx & 15) * 8);
            }
            float gq_ = 0.f;
            if (tid < 256) gq_ = GVT[((size_t)(tid >> 7) * T + tok0 + (tid & 127)) * MH + h];
#pragma unroll
            for (int q = 0; q < 2; ++q) {
                const int idx = tid + q * NTHREADS;
                *(u32x4*)(Ks + (idx >> 3) * KP + (idx & 7) * 8) = kb_[q];
                *(u32x4*)(Vs + (idx >> 4) * VP + (idx & 15) * 8) = vb_[q];
            }
            if (tid < 256) gvs_[tid] = gq_;
        }
        __syncthreads();
        const size_t trow = (size_t)(tok0 + it);
        bf16x8 bq[2];
#pragma unroll
        for (int ks = 0; ks < 2; ++ks) bq[ks] = *(const bf16x8*)(MQB + trow * MW + h * 64 + ks * 32 + 8 * g);
        f32x4 hs[4];
#pragma unroll
        for (int et = 0; et < 4; ++et) hs[et] = (f32x4){0.f, 0.f, 0.f, 0.f};
#pragma unroll
        for (int d = 0; d < 2; ++d) {
            const int cd = d ? NCH - 1 - tc : tc;
            const int su = ((d * NB + b) * MH + h) * NCH + cd;
            const size_t gt = ((size_t)d * T + trow) * MH + h;
            const float mst = MIN[su];
            const float mxt = fmaxf(PMX[gt], mst), mt = BCT[gt] + mxt, wint = fexp(mst - mxt);
            f32x4 num[4];
#pragma unroll
            for (int et = 0; et < 4; ++et) num[et] = (f32x4){0.f, 0.f, 0.f, 0.f};
            float den = 0.f;
            for (int sp = 0; sp < 4; ++sp) {
                if (d == 0 ? (2 * sp > wave) : (2 * sp + 1 < wave)) continue;
                float pw[8];
#pragma unroll
                for (int hf = 0; hf < 2; ++hf) {
                    const int st = 2 * sp + hf;
                    f32x4 sacc = (f32x4){0.f, 0.f, 0.f, 0.f};
#pragma unroll
                    for (int ks = 0; ks < 2; ++ks) sacc = MFMA16(*(const bf16x8*)(Ks + (st * 16 + col) * KP + ks * 32 + 8 * g), bq[ks], sacc);
                    const f32x4 g4 = *(const f32x4*)(gvs_ + d * 128 + st * 16 + 4 * g);
#pragma unroll
                    for (int r = 0; r < 4; ++r) {
                        const int is = st * 16 + 4 * g + r;
                        const bool ok = d == 0 ? (is <= it) : (is >= it);
                        const float pr = ok ? sacc[r] * fexp(g4[r] - mxt) : 0.f;
                        den += pr; pw[hf * 4 + r] = pr;
                    }
                }
                u32x4 pb; pb.x = pk2(pw[0], pw[1]); pb.y = pk2(pw[2], pw[3]); pb.z = pk2(pw[4], pw[5]); pb.w = pk2(pw[6], pw[7]);
                const bf16x8 bp = __builtin_bit_cast(bf16x8, pb);
#pragma unroll
                for (int et = 0; et < 4; ++et) {
                    const bf16_t* vp = Vs + (et * 16 + col) * VP + sp * 32 + 4 * g;
                    const u32x2 v0 = *(const u32x2*)vp, v1 = *(const u32x2*)(vp + 16);
                    u32x4 va; va.x = v0.x; va.y = v0.y; va.z = v1.x; va.w = v1.y;
                    num[et] = MFMA16(__builtin_bit_cast(bf16x8, va), bp, num[et]);
                }
            }
            den += SHX(den, 16, lane); den += SHX(den, 32, lane);
            f32x4 qc[4]; float qn = 0.f;
#pragma unroll
            for (int ks = 0; ks < 2; ++ks) {
                const float* np = NLb + (size_t)su * 64 + ks * 32 + 8 * g;
                const f32x4 n0 = *(const f32x4*)np, n1 = *(const f32x4*)(np + 4);
                const u32x4 qb = __builtin_bit_cast(u32x4, bq[ks]);
                qn += (bf_lo(qb.x) * n0.x + bf_hi(qb.x) * n0.y) + (bf_lo(qb.y) * n0.z + bf_hi(qb.y) * n0.w) + (bf_lo(qb.z) * n1.x + bf_hi(qb.z) * n1.y) + (bf_lo(qb.w) * n1.z + bf_hi(qb.w) * n1.w);
            }
            qn += SHX(qn, 16, lane); qn += SHX(qn, 32, lane);
#pragma unroll
            for (int et = 0; et < 4; ++et) {
                qc[et] = (f32x4){0.f, 0.f, 0.f, 0.f};
#pragma unroll
                for (int ks = 0; ks < 2; ++ks) {
                    const float* cp = CL + (size_t)su * 4096 + (size_t)(et * 16 + col) * 64 + ks * 32 + 8 * g;
                    qc[et] = MFMA16(cvt8(*(const f32x4*)cp, *(const f32x4*)(cp + 4)), bq[ks], qc[et]);
                }
            }
            const float dd = frcp(fmaxf(fabsf(den + wint * qn), fexp(-mt)));
#pragma unroll
            for (int et = 0; et < 4; ++et) hs[et] += (num[et] + wint * qc[et]) * dd;
        }
        float sm = 0.f;
#pragma unroll
        for (int et = 0; et < 4; ++et) sm += (hs[et].x + hs[et].y) + (hs[et].z + hs[et].w);
        sm += SHX(sm, 16, lane); sm += SHX(sm, 32, lane);
        const float mean = sm * (1.0f / 64.0f); float q = 0.f;
#pragma unroll
        for (int et = 0; et < 4; ++et) { const f32x4 dl = hs[et] - mean; q += (dl.x * dl.x + dl.y * dl.y) + (dl.z * dl.z + dl.w * dl.w); }
        q += SHX(q, 16, lane); q += SHX(q, 32, lane);
        const float rstd = 1.0f / sqrtf(q * (1.0f / 64.0f) + LN_EPS);
#pragma unroll
        for (int et = 0; et < 4; ++et) {
            const int c = h * 64 + et * 16 + 4 * g;
            const u32x2 ob_ = *(const u32x2*)(proj + trow * PLD + C_MW + 3 * MW + c); const f32x4 o4 = (f32x4){bf_lo(ob_.x), bf_hi(ob_.x), bf_lo(ob_.y), bf_hi(ob_.y)}, g4 = *(const f32x4*)(mln_g + c);
            const f32x4 y = (hs[et] - mean) * rstd * g4;
            u32x2 ob; ob.x = pk2(sigmoidf_(o4.x) * y.x, sigmoidf_(o4.y) * y.y); ob.y = pk2(sigmoidf_(o4.z) * y.z, sigmoidf_(o4.w) * y.w);
            *(u32x2*)(GRP + trow * D + GW + RW + c) = ob;
        }
    }
    __syncthreads();
}

__device__ __forceinline__ void phase_rwkv_post(const Params& P, int l, unsigned char* smem, int wv) {
    ParamsPtr pp = PARAMS_PTR(P); PIN_S(pp); unsigned char* ws = pp->ws; int bidx = (int)blockIdx.x, gdim = (int)gridDim.x; PIN_S(bidx); PIN_S(gdim);
    const float* SCAN = (const float*)(ws + O_SCAN); const float* VV = (const float*)(ws + O_VV); const float* GATE = (const float*)(ws + O_GATE);
    const float* BONUS = (const float*)(ws + O_BONUS); bf16_t* GRP = (bf16_t*)(ws + O_GRP);
    const float* rln_g = pp->in[15] + (size_t)l * RW; const float* rln_b = pp->in[16] + (size_t)l * RW;
    const int tid = phase_tid(wv), lane = tid & 63, wave = tid >> 6;
    const int gw = bidx * NWAVES + wave, ngw = NWAVES * gdim;
    for (int it = gw; it < T * RH; it += ngw) {
        const int t = it / RH, h = it % RH, c = h * 64 + lane;
        const size_t o = (size_t)t * RW + c;
        const float x = SCAN[o] + SCAN[(size_t)T * RW + o];
        const float mean = wave_sum(x, lane) * (1.0f / 64.0f);
        const float dl = x - mean;
        const float var = wave_sum(dl * dl, lane) * (1.0f / 64.0f);
        float y = dl / sqrtf(var + GN_EPS) * rln_g[c] + rln_b[c];
        y += BONUS[(size_t)t * RH + h] * VV[o];
        GRP[(size_t)t * D + GW + c] = (bf16_t)f2bf(y * GATE[o]);
    }
}

__device__ __forceinline__ void phase_ln1_router(const Params& P, int l, unsigned char* smem, int wv) {
    ParamsPtr pp = PARAMS_PTR(P); PIN_S(pp); unsigned char* ws = pp->ws; int bidx = (int)blockIdx.x, gdim = (int)gridDim.x; PIN_S(bidx); PIN_S(gdim);
    const float* xin = l == 0 ? pp->in[0] : (const float*)(ws + O_XA);
    const bf16_t* MIX = (const bf16_t*)(ws + O_MIX); float* X1 = (float*)(ws + O_X1);
    int* TOPI = (int*)(ws + O_TOPI); float* TOPG = (float*)(ws + O_TOPG); int* RANK = (int*)(ws + O_RANK); bf16_t* X1B = (bf16_t*)(ws + O_X1B);
    int* BCNT = (int*)(ws + O_BCNT);
    const float* g1 = pp->in[22] + (size_t)l * D; const float* b1 = pp->in[23] + (size_t)l * D;
    const float* rw = pp->in[24] + (size_t)l * D * NE; const float* rb = pp->in[25] + (size_t)l * NE;
    const bf16_t* RWT = (const bf16_t*)(ws + O_RWT) + (size_t)l * 2 * NE * D;
    const int tid = phase_tid(wv), lane = tid & 63, wave = tid >> 6, col = lane & 15, g = lane >> 4;
    float* lgs = (float*)smem;
    int* stopi = (int*)(smem + 8192);
    for (int tile = bidx; tile < T / 64; tile += gdim) {
        __syncthreads();
        {
            f32x4 xa[4]; u32x2 xm[4];
#define LN1_LOAD(tt_) do { _Pragma("unroll") for (int j = 0; j < 4; ++j) { const int c = j * 256 + lane * 4; xa[j] = *(const f32x4*)(xin + (size_t)(tt_) * D + c); xm[j] = *(const u32x2*)(MIX + (size_t)(tt_) * D + c); } } while (0)
            LN1_LOAD(tile * 64 + wave * 8);
#pragma unroll 1
            for (int ti8 = 0; ti8 < 8; ++ti8) {
                const int t = tile * 64 + wave * 8 + ti8;
                float v[16]; float sm = 0.f;
#pragma unroll
                for (int j = 0; j < 4; ++j) {
                    v[j * 4 + 0] = ALPHA * xa[j].x + bf_lo(xm[j].x); v[j * 4 + 1] = ALPHA * xa[j].y + bf_hi(xm[j].x); v[j * 4 + 2] = ALPHA * xa[j].z + bf_lo(xm[j].y); v[j * 4 + 3] = ALPHA * xa[j].w + bf_hi(xm[j].y);
                    sm += (v[j * 4] + v[j * 4 + 1]) + (v[j * 4 + 2] + v[j * 4 + 3]);
                }
                if (ti8 < 7) LN1_LOAD(t + 1);
                const float mean = wave_sum_fast(sm, lane) * (1.0f / D); float q = 0.f;
#pragma unroll
                for (int j = 0; j < 16; ++j) { const float dl = v[j] - mean; q += dl * dl; }
                const float rstd = 1.0f / sqrtf(wave_sum_fast(q, lane) * (1.0f / D) + LN_EPS);
#pragma unroll
                for (int j = 0; j < 4; ++j) {
                    const int c = j * 256 + lane * 4;
                    const f32x4 gg = *(const f32x4*)(g1 + c), bb = *(const f32x4*)(b1 + c);
                    f32x4 o;
                    o.x = (v[j * 4 + 0] - mean) * rstd * gg.x + bb.x; o.y = (v[j * 4 + 1] - mean) * rstd * gg.y + bb.y;
                    o.z = (v[j * 4 + 2] - mean) * rstd * gg.z + bb.z; o.w = (v[j * 4 + 3] - mean) * rstd * gg.w + bb.w;
                    *(f32x4*)(X1 + (size_t)t * D + c) = o;
                    u32x2 ob; ob.x = pk2(o.x, o.y); ob.y = pk2(o.z, o.w); *(u32x2*)(X1B + (size_t)t * D + c) = ob;
                }
            }
#undef LN1_LOAD
        }
        __syncthreads();
        {
            const float* xr = X1 + (size_t)(tile * 64 + (wave >> 1) * 16 + col) * D + 8 * g;
            const bf16_t* wh = RWT + (size_t)((wave & 1) * 16 + col) * D + 8 * g; const bf16_t* wl = wh + (size_t)NE * D;
            f32x4 acc = (f32x4){0.f, 0.f, 0.f, 0.f};
#pragma unroll 4
            for (int ks = 0; ks < 32; ++ks) {
                const f32x4 x0 = *(const f32x4*)(xr + ks * 32), x1 = *(const f32x4*)(xr + ks * 32 + 4);
                const bf16x8 bh = *(const bf16x8*)(wh + ks * 32), bl = *(const bf16x8*)(wl + ks * 32);
                const bf16x8 ah = cvt8(x0, x1);
                const u32x4 ahu = __builtin_bit_cast(u32x4, ah);
                f32x4 r0, r1;
                r0.x = x0.x - bf_lo(ahu.x); r0.y = x0.y - bf_hi(ahu.x); r0.z = x0.z - bf_lo(ahu.y); r0.w = x0.w - bf_hi(ahu.y);
                r1.x = x1.x - bf_lo(ahu.z); r1.y = x1.y - bf_hi(ahu.z); r1.z = x1.z - bf_lo(ahu.w); r1.w = x1.w - bf_hi(ahu.w);
                const bf16x8 al = cvt8(r0, r1);
                acc = MFMA16(ah, bh, acc); acc = MFMA16(ah, bl, acc); acc = MFMA16(al, bh, acc);
            }
            const float rbv = rb[(wave & 1) * 16 + col];
#pragma unroll
            for (int r = 0; r < 4; ++r) lgs[((wave >> 1) * 16 + 4 * g + r) * NE + (wave & 1) * 16 + col] = acc[r] + rbv;
        }
        __syncthreads();
        if (tid < 64) {
            const float* lp = lgs + tid * NE; const int t = tile * 64 + tid;
            float tv[4]; int ti[4];
#pragma unroll
            for (int k = 0; k < 4; ++k) { tv[k] = -INFINITY; ti[k] = 0; }
            for (int e = 0; e < NE; ++e) {
                const float x = lp[e];
                if (x > tv[3]) {
                    if (x > tv[0]) { tv[3] = tv[2]; ti[3] = ti[2]; tv[2] = tv[1]; ti[2] = ti[1]; tv[1] = tv[0]; ti[1] = ti[0]; tv[0] = x; ti[0] = e; }
                    else if (x > tv[1]) { tv[3] = tv[2]; ti[3] = ti[2]; tv[2] = tv[1]; ti[2] = ti[1]; tv[1] = x; ti[1] = e; }
                    else if (x > tv[2]) { tv[3] = tv[2]; ti[3] = ti[2]; tv[2] = x; ti[2] = e; }
                    else { tv[3] = x; ti[3] = e; }
                }
            }
            const float e1 = expf(tv[1] - tv[0]), e2 = expf(tv[2] - tv[0]), e3 = expf(tv[3] - tv[0]);
            const float inv = 1.0f / (1.0f + e1 + e2 + e3);
            *(f32x4*)(TOPG + (size_t)t * 4) = (f32x4){inv, e1 * inv, e2 * inv, e3 * inv};
#pragma unroll
            for (int k = 0; k < 4; ++k) { TOPI[(size_t)t * 4 + k] = ti[k]; stopi[tid * 4 + k] = ti[k]; }
        }
        __syncthreads();
        if (tid < 256) { const int e = stopi[tid]; int r = 0; for (int a2 = 0; a2 < tid; ++a2) r += (stopi[a2] == e) ? 1 : 0; RANK[(size_t)tile * 256 + tid] = r; }
        else if (tid < 256 + NE) { const int e = tid - 256; int cnt = 0; for (int a2 = 0; a2 < 256; ++a2) cnt += (stopi[a2] == e) ? 1 : 0; BCNT[tile * NE + e] = cnt; }
    }
    __syncthreads();
}

__device__ __forceinline__ void moe_offsets(int* sh, const int* CNT, int tid) {
    if (tid == 0) {
        int acc = 0;
        for (int e = 0; e < NE; ++e) { const int c = (int)CNT[e]; sh[e] = c; sh[32 + e] = acc; acc += (c + MOEB - 1) / MOEB * MOEB; sh[64 + e] = acc; }
    }
    __syncthreads();
}
__device__ __forceinline__ int moe_expert_of_row(const int* sh, int r) {
    int e = -1;
    for (int i = 0; i < NE; ++i) if (r >= sh[32 + i] && r < sh[64 + i]) e = i;
    return e;
}

__device__ __forceinline__ void phase_scatter(const Params& P, int l, unsigned char* smem, int wv) {
    ParamsPtr pp = PARAMS_PTR(P); PIN_S(pp); unsigned char* ws = pp->ws; int bidx = (int)blockIdx.x, gdim = (int)gridDim.x; PIN_S(bidx); PIN_S(gdim);
    const int tid = phase_tid(wv);
    const int* TOPI = (const int*)(ws + O_TOPI); const int* RANK = (const int*)(ws + O_RANK); int* SLOT = (int*)(ws + O_SLOT); int* ROWT = (int*)(ws + O_ROWT);
    const int* BCNT = (const int*)(ws + O_BCNT); int* CNTF = (int*)(ws + O_CNTF);
    int* sh = (int*)smem;
    int* part = sh + 96;
    int* tot = part + 512;
    int* base = tot + 32;
    constexpr int NT = T / 64;
    const int e = tid & 31, pt = tid >> 5;
    { int sacc = 0; for (int tl = pt; tl < NT; tl += 16) sacc += BCNT[tl * NE + e]; part[pt * 32 + e] = sacc; }
    __syncthreads();
    if (tid < 32) { int sacc = 0; for (int q = 0; q < 16; ++q) sacc += part[q * 32 + tid]; tot[tid] = sacc; if (bidx == 0) CNTF[tid] = sacc; }
    __syncthreads();
    moe_offsets(sh, tot, tid);
    for (int ee = bidx; ee < NE; ee += gdim)
        for (int r = sh[32 + ee] + sh[ee] + tid; r < sh[64 + ee]; r += NTHREADS) ROWT[r] = 0;
    for (int tile = bidx; tile < NT; tile += gdim) {
        __syncthreads();
        { int sacc = 0; for (int tl = pt; tl < tile; tl += 16) sacc += BCNT[tl * NE + e]; part[pt * 32 + e] = sacc; }
        __syncthreads();
        if (tid < 32) { int sacc = sh[32 + tid]; for (int q = 0; q < 16; ++q) sacc += part[q * 32 + tid]; base[tid] = sacc; }
        __syncthreads();
        if (tid < 256) { const int a = tile * 256 + tid, dest = base[TOPI[a]] + RANK[a]; SLOT[a] = dest; ROWT[dest] = a >> 2; }
    }
    __syncthreads();
}

template <int WHICH>
__device__ __forceinline__ void phase_moe_gemm(const Params& P, int l, unsigned char* smem, int wv) {
    ParamsPtr pp = PARAMS_PTR(P); PIN_S(pp); unsigned char* ws = pp->ws; int bidx = (int)blockIdx.x, gdim = (int)gridDim.x; PIN_S(bidx); PIN_S(gdim);
    const int tid = phase_tid(wv);
    const int* CNT = (const int*)(ws + O_CNTF);
    int* sh = (int*)(smem + 131072);
    int* rbe = sh + 96;
    moe_offsets(sh, CNT, tid);
    const int nrb = sh[64 + NE - 1] / MOEB;
    for (int rb = tid; rb < nrb; rb += NTHREADS) rbe[rb] = moe_expert_of_row(sh, rb * MOEB);
    __syncthreads();
    pg8::MoeOrderT<WHICH == 1> S;
    S.K = 1024; S.G_ = gdim; S.c = bidx; S.rbe = rbe; S.rowmap = (const int*)(ws + O_ROWT);
    if (WHICH == 1) {
        S.A = (const char*)(ws + O_X1B); S.Wt = (const char*)(ws + O_W1) + (size_t)l * NE * 2 * DFF * D * 2; S.estride = (size_t)2 * DFF * D * 2; S.nN = 2 * DFF / 256; S.nwg = nrb * S.nN;
        pg8::EpiSwiglu E{(bf16_t*)(ws + O_ACT), pp->in[27] + (size_t)l * NE * 2 * DFF};
        pg8::gemm_phase<pg8::EpiSwiglu, pg8::MoeOrderT<WHICH == 1>>((LAS unsigned char*)smem, 1024, S, E, tid);
    } else {
        S.A = (const char*)(ws + O_ACT); S.Wt = (const char*)(ws + O_W2) + (size_t)l * NE * D * DFF * 2; S.estride = (size_t)D * DFF * 2; S.nN = D / 256; S.nwg = nrb * S.nN;
        pg8::EpiBf16Bias E{(bf16_t*)(ws + O_YS), D, pp->in[29] + (size_t)l * NE * D, D};
        pg8::gemm_phase<pg8::EpiBf16Bias, pg8::MoeOrderT<WHICH == 1>>((LAS unsigned char*)smem, 1024, S, E, tid);
    }
    __syncthreads();
}

__device__ __forceinline__ void phase_combine_ln2(const Params& P, int l, unsigned char* smem, int wv) {
    ParamsPtr pp = PARAMS_PTR(P); PIN_S(pp); unsigned char* ws = pp->ws; int bidx = (int)blockIdx.x, gdim = (int)gridDim.x; PIN_S(bidx); PIN_S(gdim);
    const float* X1 = (const float*)(ws + O_X1); const bf16_t* YS = (const bf16_t*)(ws + O_YS); bf16_t* XB = (bf16_t*)(ws + O_XB);
    const int* SLOT = (const int*)(ws + O_SLOT); const float* TOPG = (const float*)(ws + O_TOPG);
    float* xo = l == NL - 1 ? pp->out : (float*)(ws + O_XA);
    const float* g2 = pp->in[30] + (size_t)l * D; const float* b2 = pp->in[31] + (size_t)l * D;
    const int tid = phase_tid(wv), lane = tid & 63, wave = tid >> 6;
    const int gw = bidx * NWAVES + wave, ngw = NWAVES * gdim;
    u32x4 sl_n = (u32x4){0u, 0u, 0u, 0u}; f32x4 gg_n = (f32x4){0.f, 0.f, 0.f, 0.f};
    f32x4 xa_n[4]; u32x2 ys_n[4][4]; f32x4 gg_c = (f32x4){0.f, 0.f, 0.f, 0.f};
    const f32x4 lg[4] = {*(const f32x4*)(g2 + lane * 4), *(const f32x4*)(g2 + 256 + lane * 4), *(const f32x4*)(g2 + 512 + lane * 4), *(const f32x4*)(g2 + 768 + lane * 4)};
    const f32x4 lb[4] = {*(const f32x4*)(b2 + lane * 4), *(const f32x4*)(b2 + 256 + lane * 4), *(const f32x4*)(b2 + 512 + lane * 4), *(const f32x4*)(b2 + 768 + lane * 4)};
#define CB_META(tt_) do { sl_n = *(const u32x4*)(SLOT + (size_t)(tt_) * 4); gg_n = *(const f32x4*)(TOPG + (size_t)(tt_) * 4); } while (0)
#define CB_ROWS(tt_) do { _Pragma("unroll") for (int j = 0; j < 4; ++j) { const int c = j * 256 + lane * 4; xa_n[j] = *(const f32x4*)(X1 + (size_t)(tt_) * D + c); \
        ys_n[0][j] = *(const u32x2*)(YS + (size_t)sl_n.x * D + c); ys_n[1][j] = *(const u32x2*)(YS + (size_t)sl_n.y * D + c); ys_n[2][j] = *(const u32x2*)(YS + (size_t)sl_n.z * D + c); ys_n[3][j] = *(const u32x2*)(YS + (size_t)sl_n.w * D + c); } gg_c = gg_n; } while (0)
    if (gw < T) { CB_META(gw); CB_ROWS(gw); if (gw + ngw < T) CB_META(gw + ngw); }
    for (int t = gw; t < T; t += ngw) {
        float v[16]; float sm = 0.f;
        const float gk[4] = {gg_c.x, gg_c.y, gg_c.z, gg_c.w};
#pragma unroll
        for (int j = 0; j < 4; ++j) {
            const f32x4 a = xa_n[j];
            f32x4 y = (f32x4){0.f, 0.f, 0.f, 0.f};
#pragma unroll
            for (int k = 0; k < 4; ++k) { const u32x2 yk = ys_n[k][j]; y.x += gk[k] * bf_lo(yk.x); y.y += gk[k] * bf_hi(yk.x); y.z += gk[k] * bf_lo(yk.y); y.w += gk[k] * bf_hi(yk.y); }
            v[j * 4 + 0] = ALPHA * a.x + y.x; v[j * 4 + 1] = ALPHA * a.y + y.y; v[j * 4 + 2] = ALPHA * a.z + y.z; v[j * 4 + 3] = ALPHA * a.w + y.w;
            sm += (v[j * 4] + v[j * 4 + 1]) + (v[j * 4 + 2] + v[j * 4 + 3]);
        }
        if (t + ngw < T) { CB_ROWS(t + ngw); if (t + 2 * ngw < T) CB_META(t + 2 * ngw); }
        const float mean = wave_sum_fast(sm, lane) * (1.0f / D); float q = 0.f;
#pragma unroll
        for (int j = 0; j < 16; ++j) { const float dl = v[j] - mean; q += dl * dl; }
        const float rstd = 1.0f / sqrtf(wave_sum_fast(q, lane) * (1.0f / D) + LN_EPS);
#pragma unroll
        for (int j = 0; j < 4; ++j) {
            const int c = j * 256 + lane * 4;
            f32x4 o;
            o.x = (v[j * 4 + 0] - mean) * rstd * lg[j].x + lb[j].x; o.y = (v[j * 4 + 1] - mean) * rstd * lg[j].y + lb[j].y;
            o.z = (v[j * 4 + 2] - mean) * rstd * lg[j].z + lb[j].z; o.w = (v[j * 4 + 3] - mean) * rstd * lg[j].w + lb[j].w;
            *(f32x4*)(xo + (size_t)t * D + c) = o;
            if (l != NL - 1) { u32x2 ob; ob.x = pk2(o.x, o.y); ob.y = pk2(o.z, o.w); *(u32x2*)(XB + (size_t)t * D + c) = ob; }
        }
    }
#undef CB_META
#undef CB_ROWS
}

__device__ __forceinline__ void phase_inproj(const Params& P, int l, unsigned char* smem, int wv) {
    ParamsPtr pp = PARAMS_PTR(P); PIN_S(pp); unsigned char* ws = pp->ws; int bidx = (int)blockIdx.x, gdim = (int)gridDim.x; PIN_S(bidx); PIN_S(gdim);
    const int tid = phase_tid(wv);
    pg8::DenseOrder S; S.init(ws + O_XB, (const bf16_t*)(ws + O_WIN) + (size_t)l * PLD * D, T, PLD, D, gdim, bidx);
    pg8::EpiProj E{(bf16_t*)(ws + O_PROJ), PLD, (float*)(ws + O_PROJG), PLD / 256 - 1};
    pg8::gemm_phase<pg8::EpiProj, pg8::DenseOrder>((LAS unsigned char*)smem, D, S, E, tid);
    __syncthreads();
}
__device__ __forceinline__ void phase_outproj(const Params& P, int l, unsigned char* smem, int wv) {
    ParamsPtr pp = PARAMS_PTR(P); PIN_S(pp); unsigned char* ws = pp->ws; int bidx = (int)blockIdx.x, gdim = (int)gridDim.x; PIN_S(bidx); PIN_S(gdim);
    const int tid = phase_tid(wv);
    pg8::DenseOrder S; S.init(ws + O_GRP, (const bf16_t*)(ws + O_WOUT) + (size_t)l * D * D, T, D, D, gdim, bidx);
    pg8::EpiProj E{(bf16_t*)(ws + O_MIX), D, nullptr, -1};
    pg8::gemm_phase<pg8::EpiProj, pg8::DenseOrder>((LAS unsigned char*)smem, D, S, E, tid);
    __syncthreads();
}

#ifndef EMU
#define XB_TMO      128
#define XB_XCNT(j)  (256  + 64 * (j))
#define XB_XSUB(j)  (1280 + 64 * (j))
#define XB_XGEN(j)  (2304 + 64 * (j))
#define XB_TOP      3328
#define XB_TOPGEN   3392
#define XCD_BAR_WORDS 3456
#define XB_SPIN_CAP (1u << 25)
__device__ __forceinline__ unsigned xb_ld(unsigned* p)              { return __hip_atomic_load(p, __ATOMIC_RELAXED, __HIP_MEMORY_SCOPE_AGENT); }
__device__ __forceinline__ unsigned xb_add(unsigned* p, unsigned v) { return __hip_atomic_fetch_add(p, v, __ATOMIC_RELAXED, __HIP_MEMORY_SCOPE_AGENT); }
__device__ __forceinline__ unsigned xb_xcc_id() { return (unsigned)__builtin_amdgcn_s_getreg((3 << 11) | 20) & 0xFu; }
#define XB_SPIN(cond, bar) do { unsigned _sp = 0; while (cond) { __builtin_amdgcn_s_sleep(1); \
    if ((++_sp & 255u) == 0u) { if (xb_ld(&(bar)[XB_TMO])) break; if (_sp > XB_SPIN_CAP) { atomicAdd(&(bar)[XB_TMO], 1u); break; } } } } while (0)
struct XcdBarrier { unsigned* bar; unsigned x; volatile LAS unsigned* st; };
__device__ __forceinline__ XcdBarrier xcd_barrier_post(unsigned* bar, volatile LAS unsigned* st) {
    XcdBarrier b; b.bar = bar; b.x = xb_xcc_id(); b.st = st;
    if (threadIdx.x == 0) (void)xb_add(&bar[XB_XCNT(b.x)], 1u);
    return b;
}
__device__ __forceinline__ void xcd_barrier_complete(unsigned* bar, unsigned x, unsigned& nloc, unsigned& nx) {
    const unsigned G = gridDim.x * gridDim.y * gridDim.z;
    unsigned sum, cnt, mine, sp = 0u;
    for (;;) {
        sum = 0u; cnt = 0u; mine = 0u;
#pragma unroll
        for (unsigned j = 0; j < 16; ++j) { const unsigned c = xb_ld(&bar[XB_XCNT(j)]); sum += c; cnt += (c > 0u) ? 1u : 0u; mine = (j == x) ? c : mine; }
        if (sum == G) break;
        __builtin_amdgcn_s_sleep(1);
        if ((++sp & 255u) == 0u) { if (xb_ld(&bar[XB_TMO])) break; if (sp > XB_SPIN_CAP) { atomicAdd(&bar[XB_TMO], 1u); break; } }
    }
    nloc = mine > 0u ? mine : 1u; nx = cnt > 0u ? cnt : 1u;
}
__device__ __forceinline__ void xcd_barrier(const XcdBarrier& b) {
    asm volatile("s_waitcnt vmcnt(0)" ::: "memory");
    __syncthreads();
    if (threadIdx.x == 0) {
        unsigned* bar = b.bar;
        __builtin_amdgcn_s_waitcnt(0);
        unsigned nloc = b.st[0], nx = b.st[1];
        if (nloc == 0u) { xcd_barrier_complete(bar, b.x, nloc, nx); b.st[0] = nloc; b.st[1] = nx; }
        const unsigned old = xb_add(&bar[XB_XSUB(b.x)], 1u);
        const unsigned gen = old / nloc;
        if (old + 1u == (gen + 1u) * nloc) {
            __builtin_amdgcn_fence(__ATOMIC_RELEASE, "agent");
            asm volatile("s_waitcnt vmcnt(0)" ::: "memory");
            const unsigned og = xb_add(&bar[XB_TOP], 1u);
            const unsigned tg = og / nx;
            if (og + 1u == (tg + 1u) * nx) xb_add(&bar[XB_TOPGEN], 1u);
            else XB_SPIN(xb_ld(&bar[XB_TOPGEN]) == tg, bar);
            __builtin_amdgcn_fence(__ATOMIC_ACQUIRE, "agent");
            xb_add(&bar[XB_XGEN(b.x)], 1u);
            asm volatile("s_waitcnt vmcnt(0)" ::: "memory");
        } else {
            XB_SPIN(xb_ld(&bar[XB_XGEN(b.x)]) == gen, bar);
            __builtin_amdgcn_fence(__ATOMIC_ACQUIRE, "agent");
            asm volatile("s_waitcnt vmcnt(0)" ::: "memory");
        }
    }
    __syncthreads();
}
#endif

__global__ void __launch_bounds__(512, 2) mk_fwd(Params P) {
#ifdef EMU
    unsigned char* smem = g_blk->lds;
#else
    extern __shared__ __attribute__((aligned(16))) unsigned char smem[];
    volatile LAS unsigned* bst = (volatile LAS unsigned*)(smem + LDS_BYTES - 16);
    if (threadIdx.x == 0) { bst[0] = 0u; bst[1] = 0u; bst[2] = 0u; bst[3] = 0u; }
    __syncthreads();
    XcdBarrier bar; bar.bar = (unsigned*)P.ws + CW_BAR; bar.x = 0; bar.st = bst;
    if (P.ph_hi - P.ph_lo > 1) bar = xcd_barrier_post((unsigned*)P.ws + CW_BAR, bst);
#endif
    const int lo = P.ph_lo, hi = P.ph_hi;
#ifdef EMU
    const int wv = (int)threadIdx.x >> 6;
#else
    const int wv = RFL((int)threadIdx.x >> 6);
#endif
#ifdef EMU
#define SEAM(id) do {} while (0)
#else
#define SEAM(id) do { if ((id) + 1 < hi) xcd_barrier(bar); } while (0)
#endif
#ifndef MK_ONLY_PHASE
#define MK_ONLY_PHASE -1
#endif
#ifndef MK_DUP_MASK
#define MK_DUP_MASK 0
#endif
#define PHG(kc, id, ...) do { if (MK_ONLY_PHASE < 0 || MK_ONLY_PHASE == (kc)) { const int id_ = (id); if (id_ >= lo && id_ < hi) { if ((MK_DUP_MASK >> (kc)) & 1) { __VA_ARGS__; SEAM(id_ - 1); } __VA_ARGS__; SEAM(id_); } } } while (0)
#define PH(k, ...) PHG(1 + (k), 1 + l * NPH + (k), __VA_ARGS__)
    PHG(0, 0, phase_prologue(P, smem, wv));
    for (int l = 0; l < NL; ++l) {
        PH(0, phase_inproj(P, l, smem, wv));
        PH(1, phase_prep(P, l, smem, wv));
#if MK_RWKV_CHUNKED
        PH(2, { phase_rwkv_pre(P, l, smem, wv); phase_mlstm_local(P, l, smem, wv, (int)blockIdx.x, (int)gridDim.x); });
        PH(3, { phase_rwkv_seq(P, l, smem, wv); phase_mlstm_carry(P, l, smem, wv); });
        PH(4, { phase_rwkv_out(P, l, smem, wv); phase_mlstm_out(P, l, smem, wv); phase_gmlp_mix(P, l, smem, wv, (int)blockIdx.x, (int)gridDim.x); });
#else
        PH(2, { const int G_ = (int)gridDim.x, NSC = 2 * NB * RH * 4;
                if (G_ >= NSC + 32) { if ((int)blockIdx.x < NSC) phase_rwkv_scan(P, l, smem, wv, (int)blockIdx.x, NSC);
                                      else phase_mlstm_local(P, l, smem, wv, (int)blockIdx.x - NSC, G_ - NSC); }
                else { phase_rwkv_scan(P, l, smem, wv, (int)blockIdx.x, G_); phase_mlstm_local(P, l, smem, wv, (int)blockIdx.x, G_); } });
        PH(3, phase_mlstm_carry(P, l, smem, wv));
        PH(4, { phase_mlstm_out(P, l, smem, wv); phase_gmlp_mix(P, l, smem, wv, (int)blockIdx.x, (int)gridDim.x); phase_rwkv_post(P, l, smem, wv); });
#endif
        PH(5, phase_outproj(P, l, smem, wv));
        PH(6, phase_ln1_router(P, l, smem, wv));
        PH(7, phase_scatter(P, l, smem, wv));
        PH(8, phase_moe_gemm<1>(P, l, smem, wv));
        PH(9, phase_moe_gemm<2>(P, l, smem, wv));
        PH(10, phase_combine_ln2(P, l, smem, wv));
    }
#undef PHG
#undef PH
#undef SEAM
}

}

#ifndef EMU
extern "C" void kernel_launch(void* const* d_in, const int* in_sizes, int n_in, void* d_out, int out_size, void* d_ws, size_t ws_size, hipStream_t stream) {
    using namespace mk;
    static int grid = 0;
    if (grid == 0) {
        if (n_in != 32 || out_size != T * D || ws_size < WS_END) { fprintf(stderr, "kernel_launch: unexpected shapes (n_in %d out %d ws %zu need %zu)\n", n_in, out_size, ws_size, (size_t)WS_END); grid = -1; return; }
        int dev = 0, cus = 0;
        if (hipGetDevice(&dev) != hipSuccess || hipDeviceGetAttribute(&cus, hipDeviceAttributeMultiprocessorCount, dev) != hipSuccess) { grid = -1; return; }
        if (hipFuncSetAttribute((const void*)mk_fwd, hipFuncAttributeMaxDynamicSharedMemorySize, LDS_BYTES) != hipSuccess) { fprintf(stderr, "kernel_launch: hipFuncSetAttribute failed\n"); grid = -1; return; }
        int per_cu = 0;
        (void)hipOccupancyMaxActiveBlocksPerMultiprocessor(&per_cu, (const void*)mk_fwd, NTHREADS, LDS_BYTES);
        (void)hipGetLastError();
        grid = cus;
    }
    if (grid < 0) return;
    (void)hipMemsetAsync(d_ws, 0, CTL_BYTES, stream);
    Params p{};
    for (int i = 0; i < 32; ++i) p.in[i] = (const float*)d_in[i];
    p.out = (float*)d_out; p.ws = (unsigned char*)d_ws;
#if MK_ONE_LAUNCH
    p.ph_lo = 0; p.ph_hi = 1 + NL * NPH;
    hipLaunchKernelGGL(mk_fwd, dim3(grid), dim3(NTHREADS), LDS_BYTES, stream, p);
#else
    for (int id = 0; id < 1 + NL * NPH; ++id) {
        p.ph_lo = id; p.ph_hi = id + 1;
        hipLaunchKernelGGL(mk_fwd, dim3(grid), dim3(NTHREADS), LDS_BYTES, stream, p);
    }
#endif
}
#endif
```

```cpp
#ifndef EMU
#include <hip/hip_runtime.h>
#endif
#include <cstdio>
#include <cstdint>
#include <cmath>

#ifndef CFG_BATCH
#define CFG_BATCH 4
#endif
#ifndef CFG_SEQ
#define CFG_SEQ 4096
#endif
#ifndef CFG_LAYERS
#define CFG_LAYERS 4
#endif
#ifndef MK_RWKV_CHUNKED
#define MK_RWKV_CHUNKED 1
#endif
#ifndef MK_PROBE
#define MK_PROBE 0
#endif
#ifndef MK_ONE_LAUNCH
#define MK_ONE_LAUNCH 1
#endif

namespace mk {
constexpr int NB = CFG_BATCH, S = CFG_SEQ, T = NB * S, NL = CFG_LAYERS, D = 1024;
constexpr int GW = 256, RW = 384, MW = 384, HD = 64, GH = 4, RH = 6, MH = 6, CH = 128, NCH = S / CH;
constexpr int PIN = 3480, PLD = 3584, RPROJ = 1408;
constexpr int C_RW = 512, C_MW = 1920;
constexpr int NE = 32, TOPK = 4, DFF = 1024, MOEB = 256;
constexpr int NROWS = (T * TOPK / MOEB + NE) * MOEB;
constexpr float LN_EPS = 1e-5f, GN_EPS = 64e-5f;
constexpr float ALPHA = 1.6817928305074290f;
constexpr int NTHREADS = 512, NWAVES = 8;
constexpr int LDS_BYTES = 160 * 1024;
constexpr int NPH = 11;

typedef float f32x4 __attribute__((ext_vector_type(4)));
typedef unsigned u32x4 __attribute__((ext_vector_type(4)));
typedef unsigned u32x2 __attribute__((ext_vector_type(2)));
typedef short bf16x8 __attribute__((ext_vector_type(8)));
typedef unsigned short bf16_t;

constexpr size_t al(size_t x) { return (x + 255) & ~(size_t)255; }
constexpr size_t CTL_BYTES = 1u << 20;
constexpr size_t O_XA = CTL_BYTES;
constexpr size_t O_XB = O_XA + al((size_t)T * D * 4);
constexpr size_t O_X1 = O_XB + al((size_t)T * D * 2);
constexpr size_t O_X1B = O_X1 + al((size_t)T * D * 4);
constexpr size_t O_PROJ = O_X1B + al((size_t)T * D * 2);
constexpr size_t O_PROJG = O_PROJ + al((size_t)T * PLD * 2);
constexpr size_t O_MIX = O_PROJ + al((size_t)T * PLD * 4);
constexpr size_t O_GRP = O_MIX + al((size_t)T * D * 4);
constexpr size_t O_UG = O_GRP + al((size_t)T * D * 2);
constexpr size_t O_VN = O_UG + al((size_t)T * GW * 4);
constexpr size_t O_RR = O_VN + al((size_t)T * GW * 4);
constexpr size_t O_VV = O_RR + al((size_t)T * RW * 4);
constexpr size_t O_KK = O_VV + al((size_t)T * RW * 4);
constexpr size_t O_DEC = O_KK + al((size_t)T * RW * 4);
constexpr size_t O_KD = O_DEC + al((size_t)2 * T * RW * 4);
constexpr size_t O_ICLR = O_KD + al((size_t)2 * T * RW * 4);
constexpr size_t O_GATE = O_ICLR + al((size_t)2 * T * RW * 4);
constexpr size_t O_BONUS = O_GATE + al((size_t)T * RW * 4);
constexpr size_t O_SCAN = O_BONUS + al((size_t)T * RH * 4);
constexpr size_t O_MQ = O_SCAN + al((size_t)2 * T * RW * 4);
constexpr size_t O_MK = O_MQ + al((size_t)T * MW * 4);
constexpr size_t O_IG = O_MK + al((size_t)T * MW * 4);
constexpr size_t O_LF = O_IG + al((size_t)2 * T * MH * 4);
constexpr size_t O_CL = O_LF + al((size_t)2 * T * MH * 4);
constexpr size_t O_NL = O_CL + al((size_t)2 * NB * MH * NCH * 4096 * 4);
constexpr size_t O_ML = O_NL + al((size_t)2 * NB * MH * NCH * 64 * 4);
constexpr size_t O_BL = O_ML + al((size_t)2 * NB * MH * NCH * 4);
constexpr size_t O_MIN = O_BL + al((size_t)2 * NB * MH * NCH * 4);
constexpr size_t O_TOPI = O_MIN + al((size_t)2 * NB * MH * NCH * 4);
constexpr size_t O_TOPG = O_TOPI + al((size_t)T * 4 * 4);
constexpr size_t O_RANK = O_TOPG + al((size_t)T * 4 * 4);
constexpr size_t O_SLOT = O_RANK + al((size_t)T * 4 * 4);
constexpr size_t O_MQB = O_SLOT + al((size_t)T * 4 * 4);
constexpr size_t O_MKB = O_MQB + al((size_t)T * MW * 2);
constexpr size_t O_KT = O_MKB + al((size_t)T * MW * 2);
constexpr size_t O_VT = O_KT + al((size_t)T * MW * 2);
constexpr size_t O_GVT = O_VT + al((size_t)T * MW * 2);
constexpr size_t O_PMX = O_GVT + al((size_t)2 * T * MH * 4);
constexpr size_t O_BCT = O_PMX + al((size_t)2 * T * MH * 4);
constexpr size_t O_BRKR = O_BCT + al((size_t)2 * T * MH * 4);
constexpr int RC = 64, RNC = S / RC, RUN = 2 * NB * RH * RNC;
constexpr size_t O_LW = O_BRKR + al((size_t)2 * T * RH * 2 * 4);
constexpr size_t O_RQ = O_LW + al((size_t)2 * T * RW * 4);
constexpr size_t O_RA = O_RQ + al((size_t)RUN * 4096 * 2);
constexpr size_t O_RS = O_RA + al((size_t)RUN * 4096 * 2);
constexpr size_t O_RH = O_RS + al((size_t)RUN * 4096 * 2);
constexpr size_t O_RG = O_RH + al((size_t)RUN * 4096 * 4);
constexpr size_t O_RB = O_RG + al((size_t)RUN * 4096 * 4);
constexpr size_t O_VB = O_RB + al((size_t)T * RW * 2);
constexpr size_t O_KKB = O_VB + al((size_t)T * RW * 2);
constexpr size_t O_BBB = O_KKB + al((size_t)T * RW * 2);
constexpr size_t O_KDB = O_BBB + al((size_t)2 * T * RW * 2);
constexpr size_t O_VNT = O_KDB + al((size_t)2 * T * RW * 2);
constexpr size_t O_WSB = O_VNT + al((size_t)T * GW * 2);
constexpr size_t O_LWT = O_WSB + al((size_t)NL * GH * CH * CH * 2);
constexpr size_t O_RWT = O_LWT + al((size_t)NL * 1920 * 128 * 2);
constexpr size_t O_BCNT = O_RWT + al((size_t)NL * 2 * NE * D * 2);
constexpr size_t O_CNTF = O_BCNT + al((size_t)(T / 64) * NE * 4);
constexpr size_t O_ROWT = O_CNTF + al((size_t)NE * 4);
constexpr size_t O_XS = O_ROWT + al((size_t)NROWS * 4);
constexpr size_t O_ACT = O_XS + al((size_t)NROWS * D * 2);
constexpr size_t O_YS = O_ACT + al((size_t)NROWS * DFF * 2);
constexpr size_t O_WIN = O_YS + al((size_t)NROWS * D * 2);
constexpr size_t O_WOUT = O_WIN + al((size_t)NL * PLD * D * 2);
constexpr size_t O_W1 = O_WOUT + al((size_t)NL * D * D * 2);
constexpr size_t O_W2 = O_W1 + al((size_t)NL * NE * 2 * DFF * D * 2);
constexpr size_t WS_END = O_W2 + al((size_t)NL * NE * D * DFF * 2);

constexpr int CW_BAR = 4096;
constexpr int CW_CNT = 16384;

struct Params { const float* in[32]; float* out; unsigned char* ws; int ph_lo, ph_hi; };
#ifdef EMU
typedef const Params* ParamsPtr;
#define PARAMS_PTR(P) (&(P))
#else
typedef const __attribute__((address_space(4))) Params* ParamsPtr;
#define PARAMS_PTR(P) ((ParamsPtr)__builtin_amdgcn_kernarg_segment_ptr())
#endif

#ifdef EMU
#define WAVE_SYNC() emu_wave_barrier()
#define PIN_V(x) do {} while (0)
#define PIN_S(x) do {} while (0)
#else
#define WAVE_SYNC() __builtin_amdgcn_wave_barrier()
#define PIN_V(x) asm volatile("" : "+v"(x))
#define PIN_S(x) asm volatile("" : "+s"(x))
#endif
#ifdef EMU
__device__ __forceinline__ int phase_tid(int wv) { (void)wv; return threadIdx.x; }
#else
__device__ __forceinline__ int phase_tid(int wv) { int t; asm volatile("v_mbcnt_lo_u32_b32 %0, -1, 0\n\tv_mbcnt_hi_u32_b32 %0, -1, %0" : "=v"(t)); return (wv << 6) + t; }
#endif

#ifdef EMU
#define SHX(v, m, lane) __shfl_xor(v, m)
#else
__device__ __forceinline__ float shx_(float v, int m, int lane) { return __builtin_bit_cast(float, __builtin_amdgcn_ds_bpermute((lane ^ m) << 2, __builtin_bit_cast(int, v))); }
__device__ __forceinline__ int shx_(int v, int m, int lane) { return __builtin_amdgcn_ds_bpermute((lane ^ m) << 2, v); }
#define SHX(v, m, lane) shx_(v, m, lane)
#endif
#ifdef EMU
#define SHUP(v, o, lane) __shfl(v, ((lane) - (o)) & 63)
#define RDL(v, src) __shfl(v, src)
#define SHL(v, src) __shfl(v, src)
#else
#define SHL(v, src) __builtin_bit_cast(float, __builtin_amdgcn_ds_bpermute((src) << 2, __builtin_bit_cast(int, (float)(v))))
#define SHUP(v, o, lane) __builtin_bit_cast(float, __builtin_amdgcn_ds_bpermute((((lane) - (o)) & 63) << 2, __builtin_bit_cast(int, (float)(v))))
#define RDL(v, src) __builtin_bit_cast(float, __builtin_amdgcn_readlane(__builtin_bit_cast(int, (float)(v)), src))
#endif
__device__ __forceinline__ float wave_sum(float v, int lane) {
#pragma unroll
    for (int o = 32; o >= 1; o >>= 1) v += SHX(v, o, lane);
    return v;
}
#ifdef EMU
__device__ __forceinline__ float fexp(float x) { return expf(x); }
__device__ __forceinline__ float flog(float x) { return logf(x); }
__device__ __forceinline__ float frcp(float x) { return 1.0f / x; }
#else
__device__ __forceinline__ float fexp(float x) { return __builtin_amdgcn_exp2f(x * 1.4426950408889634f); }
__device__ __forceinline__ float flog(float x) { return __builtin_amdgcn_logf(x) * 0.6931471805599453f; }
__device__ __forceinline__ float frcp(float x) { return __builtin_amdgcn_rcpf(x); }
#endif
__device__ __forceinline__ float sigmoidf_(float x) { return frcp(1.0f + fexp(-x)); }
__device__ __forceinline__ float softplusf_(float x) { return fmaxf(x, 0.f) + flog(1.0f + fexp(-fabsf(x))); }
__device__ __forceinline__ float ftanh(float x) { return 1.0f - 2.0f * frcp(1.0f + fexp(2.0f * x)); }
__device__ __forceinline__ float geluf_(float v) {
    const float av = fabsf(v), t = frcp(1.0f + 0.2316418882f * av);
    float q = t * 0.5307027145f + (-0.7265760135f); q = q * t + 0.7107068705f; q = q * t + (-0.142248368f); q = q * t + 0.127414796f; q = q * t;
    const float m = v * (q * fexp(-0.5f * v * v));
    return v < 0.f ? m : v - m;
}

#ifdef EMU
#define LAS
#define WAIT_V(n) do {} while (0)
#define WAIT_L(n) do {} while (0)
#define S_BARRIER() __syncthreads()
#define SETPRIO(x) do {} while (0)
#define SCHED_BAR() do {} while (0)
#define RFL(x) (x)
static inline void emu_glds16(const void* g, void* l) { memcpy((char*)l + (g_blk->cur & 63) * 16, g, 16); }
#define GLDS16(gptr, ldsptr) emu_glds16((const void*)(gptr), (void*)(ldsptr))
static inline float emu_bf2f(unsigned short b) { unsigned u = (unsigned)b << 16; float f; memcpy(&f, &u, 4); return f; }
static inline f32x4 emu_mfma16(bf16x8 a, bf16x8 b, f32x4 c) {
    EmuBlock* blk = g_blk; const int cur = blk->cur, lane = cur & 63, wbase = cur & ~63;
    static thread_local unsigned short Ash[32][64][8], Bsh[32][64][8];
    const int w = cur >> 6;
    for (int j = 0; j < 8; ++j) { Ash[w][lane][j] = (unsigned short)a[j]; Bsh[w][lane][j] = (unsigned short)b[j]; }
    emu_wave_barrier();
    const int col = lane & 15;
    for (int r = 0; r < 4; ++r) { const int row = 4 * (lane >> 4) + r; float sum = c[r];
        for (int k = 0; k < 32; ++k) sum += emu_bf2f(Ash[w][row + 16 * (k >> 3)][k & 7]) * emu_bf2f(Bsh[w][col + 16 * (k >> 3)][k & 7]);
        c[r] = sum; }
    emu_wave_barrier(); (void)wbase;
    return c;
}
#define MFMA16(a, b, c) emu_mfma16(a, b, c)
#else
#define LAS __attribute__((address_space(3)))
#define WAIT_V(n) asm volatile("s_waitcnt vmcnt(" #n ")" ::: "memory")
#define WAIT_L(n) asm volatile("s_waitcnt lgkmcnt(" #n ")" ::: "memory")
#define S_BARRIER() __builtin_amdgcn_s_barrier()
#define SETPRIO(x) __builtin_amdgcn_s_setprio(x)
#define SCHED_BAR() __builtin_amdgcn_sched_barrier(0)
#define RFL(x) __builtin_amdgcn_readfirstlane(x)
#define GLDS16(gptr, ldsptr) __builtin_amdgcn_global_load_lds((const unsigned*)(gptr), (LAS unsigned*)(ldsptr), 16, 0, 0)
#define MFMA16(a, b, c) __builtin_amdgcn_mfma_f32_16x16x32_bf16(a, b, c, 0, 0, 0)
#endif

#ifdef EMU
__device__ __forceinline__ unsigned f2bf(float f) { unsigned u = __builtin_bit_cast(unsigned, f); return (u + 0x7fffu + ((u >> 16) & 1u)) >> 16; }
#else
__device__ __forceinline__ unsigned f2bf(float f) { return (unsigned)__builtin_bit_cast(unsigned short, (__bf16)f); }
#endif
#ifdef EMU
__device__ __forceinline__ unsigned pk2(float lo, float hi) { return f2bf(lo) | (f2bf(hi) << 16); }
#else
typedef float f32x2c __attribute__((ext_vector_type(2)));
typedef __bf16 bf16x2c __attribute__((ext_vector_type(2)));
__device__ __forceinline__ unsigned pk2(float lo, float hi) { const f32x2c v = {lo, hi}; return __builtin_bit_cast(unsigned, __builtin_convertvector(v, bf16x2c)); }
#endif
__device__ __forceinline__ bf16x8 cvt8(const f32x4 a, const f32x4 b) {
    u32x4 w; w.x = pk2(a.x, a.y); w.y = pk2(a.z, a.w); w.z = pk2(b.x, b.y); w.w = pk2(b.z, b.w); return __builtin_bit_cast(bf16x8, w);
}
__device__ __forceinline__ float bf_lo(unsigned u) { return __builtin_bit_cast(float, u << 16); }
__device__ __forceinline__ float bf_hi(unsigned u) { return __builtin_bit_cast(float, u & 0xffff0000u); }

namespace pg8 {
constexpr int BM = 256, BK = 64, HALF = 128, HTB = HALF * BK * 2, STAGE_BYTES = 8 * HTB, NXCD = 8, WGM = 8;
__host__ __device__ __forceinline__ int lds_byte(int r, int c) { const int st = (r >> 4) * 2 + (c >> 5), rr = r & 15, cc = c & 31, ob = rr * 64 + cc * 2; return st * 1024 + (ob ^ (((ob >> 9) & 1) << 5)); }
__host__ __device__ __forceinline__ void stage_rc(int b, int& R, int& C) { const int st = b / 1024, sb = b % 1024, swz = sb ^ (((sb >> 9) & 1) << 5); R = (st >> 1) * 16 + swz / 64; C = (st & 1) * 32 + (swz % 64) / 2; }
__host__ __device__ __forceinline__ int perm32(int rho) { const int n = rho >> 4, i = rho & 15; return 8 * (i >> 2) + 4 * n + (i & 3); }
struct Unit { int pm, pn, e; };

struct DenseOrder {
    static constexpr bool GATHER = false;
    const char* A; const char* Bt; int K; int nM, nN, nwg, G, c;
    __device__ __forceinline__ void init(const void* A_, const void* Bt_, int M, int N, int K_, int G_, int c_) { A = (const char*)A_; Bt = (const char*)Bt_; K = K_; nM = M / BM; nN = N / BM; nwg = nM * nN; G = G_; c = c_; }
    __device__ __forceinline__ bool next(int i, Unit& u) const {
        const long L = (long)i * G + c; if (L >= nwg) return false;
        int wgid = (int)L; { const int q = nwg / NXCD, r = nwg % NXCD, xcd = wgid % NXCD, off = wgid / NXCD; wgid = (xcd < r ? xcd * (q + 1) : r * (q + 1) + (xcd - r) * q) + off; }
        const int nig = WGM * nN, gid = wgid / nig, fm = gid * WGM, gsz = (nM - fm) < WGM ? (nM - fm) : WGM;
        u.pm = fm + ((wgid % nig) % gsz); u.pn = (wgid % nig) / gsz; u.e = 0; return true;
    }
    __device__ __forceinline__ const char* abase(const Unit& u) const { return A + (size_t)u.pm * BM * K * 2; }
    __device__ __forceinline__ const char* bbase(const Unit& u) const { return Bt + (size_t)u.pn * BM * K * 2; }
};
template <bool G>
struct MoeOrderT {
    static constexpr bool GATHER = G;
    const char* A; const char* Wt; int K; int nN, nwg, G_, c; size_t estride; const int* rbe; const int* rowmap;
    __device__ __forceinline__ bool next(int i, Unit& u) const {
        const long L = (long)i * G_ + c; if (L >= nwg) return false;
        u.pm = (int)(L / nN); u.pn = (int)(L % nN); u.e = rbe[u.pm]; return true;
    }
    __device__ __forceinline__ const char* abase(const Unit& u) const { return G ? A : A + (size_t)u.pm * BM * K * 2; }
    __device__ __forceinline__ const char* bbase(const Unit& u) const { return Wt + (size_t)u.e * estride + (size_t)u.pn * BM * K * 2; }
};
struct EpiF32 {
    static constexpr bool PERM = false;
    float* C; int ldc;
    __device__ __forceinline__ void operator()(const f32x4 (&acc)[2][2][4][2], const Unit& u, int wr, int wc, int fr, int fq) const {
        const int row0 = u.pm * BM + wr * 64 + fr, col0 = u.pn * BM + wc * 32 + 4 * fq;
#pragma unroll
        for (int ai = 0; ai < 2; ++ai)
#pragma unroll
            for (int m = 0; m < 4; ++m) { float* rowp = C + (size_t)(row0 + ai * HALF + m * 16) * ldc + col0;
#pragma unroll
                for (int bj = 0; bj < 2; ++bj)
#pragma unroll
                    for (int n = 0; n < 2; ++n) *(f32x4*)(rowp + bj * HALF + n * 16) = acc[ai][bj][m][n]; }
    }
};
struct EpiProj {
    static constexpr bool PERM = true;
    bf16_t* O; int ldc; float* G; int lastt;
    __device__ __forceinline__ void operator()(const f32x4 (&acc)[2][2][4][2], const Unit& u, int wr, int wc, int fr, int fq) const {
        const int row0 = u.pm * BM + wr * 64 + fr, col0 = u.pn * BM + wc * 32 + 8 * fq;
#pragma unroll
        for (int ai = 0; ai < 2; ++ai)
#pragma unroll
            for (int m = 0; m < 4; ++m) { bf16_t* rowp = O + (size_t)(row0 + ai * HALF + m * 16) * ldc + col0;
#pragma unroll
                for (int bj = 0; bj < 2; ++bj) { const f32x4 v0 = acc[ai][bj][m][0], v1 = acc[ai][bj][m][1];
                    u32x4 w; w.x = pk2(v0[0], v0[1]); w.y = pk2(v0[2], v0[3]); w.z = pk2(v1[0], v1[1]); w.w = pk2(v1[2], v1[3]);
                    *(u32x4*)(rowp + bj * HALF) = w; } }
        if (u.pn == lastt) {
#pragma unroll
            for (int ai = 0; ai < 2; ++ai)
#pragma unroll
                for (int m = 0; m < 4; ++m) { float* rowp = G + (size_t)(row0 + ai * HALF + m * 16) * BM + wc * 32 + 8 * fq;
#pragma unroll
                    for (int bj = 0; bj < 2; ++bj) { *(f32x4*)(rowp + bj * HALF) = acc[ai][bj][m][0]; *(f32x4*)(rowp + bj * HALF + 4) = acc[ai][bj][m][1]; } }
        }
    }
};
struct EpiBf16Bias {
    static constexpr bool PERM = true;
    bf16_t* O; int ldc; const float* bias; int bias_estride;
    __device__ __forceinline__ void operator()(const f32x4 (&acc)[2][2][4][2], const Unit& u, int wr, int wc, int fr, int fq) const {
        const int row0 = u.pm * BM + wr * 64 + fr, col0 = u.pn * BM + wc * 32 + 8 * fq;
        const float* bp = bias + (size_t)u.e * bias_estride + col0;
        f32x4 bv[2][2];
#pragma unroll
        for (int bj = 0; bj < 2; ++bj)
#pragma unroll
            for (int n = 0; n < 2; ++n) bv[bj][n] = *(const f32x4*)(bp + bj * HALF + 4 * n);
#pragma unroll
        for (int ai = 0; ai < 2; ++ai)
#pragma unroll
            for (int m = 0; m < 4; ++m) { bf16_t* rowp = O + (size_t)(row0 + ai * HALF + m * 16) * ldc + col0;
#pragma unroll
                for (int bj = 0; bj < 2; ++bj) { const f32x4 v0 = acc[ai][bj][m][0] + bv[bj][0], v1 = acc[ai][bj][m][1] + bv[bj][1];
                    u32x4 w; w.x = pk2(v0[0], v0[1]); w.y = pk2(v0[2], v0[3]); w.z = pk2(v1[0], v1[1]); w.w = pk2(v1[2], v1[3]);
                    *(u32x4*)(rowp + bj * HALF) = w; } }
    }
};
__device__ __forceinline__ float swiglu1(float g, float uu) { g = fminf(g, 7.0f); uu = fminf(fmaxf(uu, -7.0f), 7.0f); return (uu + 1.0f) * (g * frcp(1.0f + fexp(-1.702f * g))); }
struct EpiSwiglu {
    static constexpr bool PERM = true;
    bf16_t* O; const float* b1;
    __device__ __forceinline__ void operator()(const f32x4 (&acc)[2][2][4][2], const Unit& u, int wr, int wc, int fr, int fq) const {
        const int row0 = u.pm * BM + wr * 64 + fr, j0 = u.pn * HALF + wc * 32 + 8 * fq;
        const float* bg = b1 + (size_t)u.e * 2 * DFF + j0; const float* bu = bg + DFF;
        f32x4 g4[2], u4[2];
#pragma unroll
        for (int n = 0; n < 2; ++n) { g4[n] = *(const f32x4*)(bg + 4 * n); u4[n] = *(const f32x4*)(bu + 4 * n); }
#pragma unroll
        for (int ai = 0; ai < 2; ++ai)
#pragma unroll
            for (int m = 0; m < 4; ++m) {
                float o[8];
#pragma unroll
                for (int n = 0; n < 2; ++n)
#pragma unroll
                    for (int q = 0; q < 4; ++q) o[n * 4 + q] = swiglu1(acc[ai][0][m][n][q] + g4[n][q], acc[ai][1][m][n][q] + u4[n][q]);
                u32x4 w; w.x = pk2(o[0], o[1]); w.y = pk2(o[2], o[3]); w.z = pk2(o[4], o[5]); w.w = pk2(o[6], o[7]);
                *(u32x4*)(O + (size_t)(row0 + ai * HALF + m * 16) * DFF + j0) = w;
            }
    }
};

template <class Epi, class Sched>
__device__ __forceinline__ void gemm_phase(LAS unsigned char* lds, const int K, const Sched& S, const Epi& E, const int tid) {
    const int wid = RFL(tid >> 6), lane = tid & 63, wr = wid >> 2, wc = wid & 3, fr = lane & 15, fq = lane >> 4;
    const int nt = K / BK;
    unsigned voffA[2], voffB[2]; int gR[2]; unsigned gC[2];
#pragma unroll
    for (int i = 0; i < 2; ++i) { int R, C; stage_rc(tid * 16 + i * 8192, R, C); const int Rb = Epi::PERM ? ((R & ~31) + perm32(R & 31)) : R;
        voffA[i] = (unsigned)(R * K + C) * 2u; voffB[i] = (unsigned)(Rb * K + C) * 2u; gR[i] = R; gC[i] = (unsigned)C * 2u; }
    unsigned va[2][2], vn[2][2];
#define PG8_GOFF(dst, unit) do { if constexpr (Sched::GATHER) { _Pragma("unroll") for (int h_ = 0; h_ < 2; ++h_) _Pragma("unroll") for (int i_ = 0; i_ < 2; ++i_) \
        dst[h_][i_] = (unsigned)S.rowmap[(unit).pm * BM + h_ * HALF + gR[i_]] * (unsigned)(K * 2) + gC[i_]; } } while (0)
#define PG8_STAGE_A(bufoff, bp, kb, h, nx) do { if constexpr (Sched::GATHER) { const char* gb_ = S.A + (kb); _Pragma("unroll") for (int _i = 0; _i < 2; ++_i) \
        GLDS16(gb_ + ((nx) ? vn[h][_i] : va[h][_i]), lds + (bufoff) + ldsw + _i * 8192); } else { PG8_STAGE(bufoff, bp, voffA); } } while (0)
    const size_t kstep = (size_t)(BK * 2);
    const size_t hstep = (size_t)HALF * K * 2;
    const unsigned ldsw = (unsigned)wid * 1024u;
    const int aoff = lds_byte(wr * 64 + fr, fq * 8), boff = lds_byte(wc * 32 + fr, fq * 8);
#define PG8_SA(b, h) (((b) * 2 + (h)) * HTB)
#define PG8_SB(b, h) ((4 + (b) * 2 + (h)) * HTB)
#define PG8_STAGE(bufoff, gbase, voff) do { _Pragma("unroll") for (int _i = 0; _i < 2; ++_i) \
        GLDS16((const char*)(gbase) + (voff)[_i], lds + (bufoff) + ldsw + _i * 8192); } while (0)
#define PG8_LDA(dst, b, h) do { _Pragma("unroll") for (int m = 0; m < 4; ++m) _Pragma("unroll") for (int k = 0; k < 2; ++k) dst[m][k] = *(const LAS bf16x8*)(lds + PG8_SA(b, h) + aoff + m * 2048 + k * 1024); } while (0)
#define PG8_LDB(dst, b, h) do { _Pragma("unroll") for (int n = 0; n < 2; ++n) _Pragma("unroll") for (int k = 0; k < 2; ++k) dst[n][k] = *(const LAS bf16x8*)(lds + PG8_SB(b, h) + boff + n * 2048 + k * 1024); } while (0)
#define PG8_MMA(ai, bj, At, Bt) do { SETPRIO(1); _Pragma("unroll") for (int m = 0; m < 4; ++m) _Pragma("unroll") for (int n = 0; n < 2; ++n) _Pragma("unroll") for (int k = 0; k < 2; ++k) \
        acc[ai][bj][m][n] = MFMA16(Bt[n][k], At[m][k], acc[ai][bj][m][n]); SETPRIO(0); } while (0)
    Unit cur, nxt; int ui = 0;
    if (!S.next(0, cur)) return;
    f32x4 acc[2][2][4][2];
#pragma unroll
    for (int a = 0; a < 2; ++a)
#pragma unroll
        for (int b = 0; b < 2; ++b)
#pragma unroll
            for (int m = 0; m < 4; ++m)
#pragma unroll
                for (int n = 0; n < 2; ++n) acc[a][b][m][n] = (f32x4){0.f, 0.f, 0.f, 0.f};
    bf16x8 At[4][2], B0[2][2], B1[2][2];
    const char* cA = S.abase(cur); const char* cB = S.bbase(cur);
    PG8_GOFF(va, cur);
    PG8_STAGE(PG8_SB(0, 0), cB, voffB); PG8_STAGE_A(PG8_SA(0, 0), cA, 0, 0, false); PG8_STAGE(PG8_SB(0, 1), cB + hstep, voffB); PG8_STAGE_A(PG8_SA(0, 1), cA + hstep, 0, 1, false);
    if (wr == 1) S_BARRIER();
    WAIT_V(4); S_BARRIER();
    PG8_STAGE(PG8_SB(1, 0), cB + kstep, voffB); PG8_STAGE_A(PG8_SA(1, 0), cA + kstep, kstep, 0, false); PG8_STAGE(PG8_SB(1, 1), cB + hstep + kstep, voffB);
    WAIT_V(6); S_BARRIER();
    for (;;) {
        const bool has_next = S.next(ui + 1, nxt);
        const char* nA = has_next ? S.abase(nxt) : cA; const char* nB = has_next ? S.bbase(nxt) : cB;
        if constexpr (Sched::GATHER) { if (has_next) { PG8_GOFF(vn, nxt); } else {
#pragma unroll
            for (int h_ = 0; h_ < 2; ++h_) { vn[h_][0] = va[h_][0]; vn[h_][1] = va[h_][1]; } } }
        for (int t = 0; t < nt; t += 2) {
            const bool last = (t == nt - 2);
            const char* a1 = cA + (size_t)(t + 1) * kstep;
            const char* a2 = last ? nA : cA + (size_t)(t + 2) * kstep; const char* b2 = last ? nB : cB + (size_t)(t + 2) * kstep;
            const char* a3 = a2 + kstep; const char* b3 = b2 + kstep;
            PG8_LDB(B0, 0, 0); SCHED_BAR(); PG8_LDA(At, 0, 0); PG8_STAGE_A(PG8_SA(1, 1), a1 + hstep, (size_t)(t + 1) * kstep, 1, false);
            WAIT_L(8); S_BARRIER(); WAIT_L(0); PG8_MMA(0, 0, At, B0); S_BARRIER(); SCHED_BAR();
            PG8_LDB(B1, 0, 1); PG8_STAGE(PG8_SB(0, 0), b2, voffB);
            S_BARRIER(); WAIT_L(0); PG8_MMA(0, 1, At, B1); S_BARRIER();
            PG8_LDA(At, 0, 1); PG8_STAGE_A(PG8_SA(0, 0), a2, (last ? (size_t)0 : (size_t)(t + 2) * kstep), 0, last);
            S_BARRIER(); WAIT_L(0); PG8_MMA(1, 0, At, B0); S_BARRIER(); SCHED_BAR();
            PG8_STAGE(PG8_SB(0, 1), b2 + hstep, voffB);
            WAIT_V(6); S_BARRIER(); PG8_MMA(1, 1, At, B1); S_BARRIER();
            PG8_LDB(B0, 1, 0); SCHED_BAR(); PG8_LDA(At, 1, 0); PG8_STAGE_A(PG8_SA(0, 1), a2 + hstep, (last ? (size_t)0 : (size_t)(t + 2) * kstep), 1, last);
            WAIT_L(8); S_BARRIER(); WAIT_L(0); PG8_MMA(0, 0, At, B0); S_BARRIER(); SCHED_BAR();
            PG8_LDB(B1, 1, 1); PG8_STAGE(PG8_SB(1, 0), b3, voffB);
            S_BARRIER(); WAIT_L(0); PG8_MMA(0, 1, At, B1); S_BARRIER();
            PG8_LDA(At, 1, 1); PG8_STAGE_A(PG8_SA(1, 0), a3, (last ? kstep : (size_t)(t + 3) * kstep), 0, last);
            S_BARRIER(); WAIT_L(0); PG8_MMA(1, 0, At, B0); S_BARRIER(); SCHED_BAR();
            PG8_STAGE(PG8_SB(1, 1), b3 + hstep, voffB);
            WAIT_V(6); S_BARRIER(); PG8_MMA(1, 1, At, B1); S_BARRIER();
        }
        E(acc, cur, wr, wc, fr, fq);
        if (!has_next) break;
#pragma unroll
        for (int a = 0; a < 2; ++a)
#pragma unroll
            for (int b = 0; b < 2; ++b)
#pragma unroll
                for (int m = 0; m < 4; ++m)
#pragma unroll
                    for (int n = 0; n < 2; ++n) acc[a][b][m][n] = (f32x4){0.f, 0.f, 0.f, 0.f};
        cur = nxt; cA = nA; cB = nB; ++ui;
        if constexpr (Sched::GATHER) {
#pragma unroll
            for (int h_ = 0; h_ < 2; ++h_) { va[h_][0] = vn[h_][0]; va[h_][1] = vn[h_][1]; } }
    }
    WAIT_V(0);
    if (wr == 0) S_BARRIER();
    S_BARRIER();
#undef PG8_SA
#undef PG8_SB
#undef PG8_STAGE
#undef PG8_STAGE_A
#undef PG8_GOFF
#undef PG8_LDA
#undef PG8_LDB
#undef PG8_MMA
}
}

__device__ __forceinline__ float row16_sum(float x) {
#ifdef EMU
    x += __shfl_xor(x, 1); x += __shfl_xor(x, 2); x += __shfl_xor(x, 4); x += __shfl_xor(x, 8); return x;
#else
#define DPPF(v, ctrl) __builtin_bit_cast(float, __builtin_amdgcn_update_dpp(0, __builtin_bit_cast(int, (v)), (ctrl), 0xF, 0xF, false))
    x += DPPF(x, 0xB1); x += DPPF(x, 0x4E); x += DPPF(x, 0x141); x += DPPF(x, 0x140); return x;
#undef DPPF
#endif
}
__device__ __forceinline__ float row32_sum(float x) {
    x = row16_sum(x);
#ifdef EMU
    x += __shfl_xor(x, 32); return x;
#else
    float a = x, b = x;
    asm volatile("s_nop 1\n\tv_permlane32_swap_b32 %0, %1" : "+v"(a), "+v"(b));
    return a + b;
#endif
}
__device__ __forceinline__ float wave_sum_fast(float x, int lane) {
    x = row32_sum(x);
    x += SHX(x, 16, lane);
    return x;
}
__device__ __forceinline__ void transpose_item(const float* W, int K, int N, bf16_t* WT, int k0, int n0, int dst_row0, float* scr, int lane) {
    const int n4 = (lane & 15) * 4, kr = lane >> 4;
#pragma unroll 8
    for (int i = 0; i < 16; ++i) {
        const int kk = 4 * i + kr;
        f32x4 v = (f32x4){0.f, 0.f, 0.f, 0.f};
        if (n0 + n4 < N) v = *(const f32x4*)(W + (size_t)(k0 + kk) * N + n0 + n4);
        float* d = scr + kk * 65 + n4; d[0] = v.x; d[1] = v.y; d[2] = v.z; d[3] = v.w;
    }
    WAVE_SYNC();
    const int c = lane & 7;
#pragma unroll
    for (int j = 0; j < 8; ++j) { const int n = (lane >> 3) + 8 * j; const float* sp = scr + (8 * c) * 65 + n;
        u32x4 o; o.x = pk2(sp[0 * 65], sp[1 * 65]); o.y = pk2(sp[2 * 65], sp[3 * 65]); o.z = pk2(sp[4 * 65], sp[5 * 65]); o.w = pk2(sp[6 * 65], sp[7 * 65]);
        *(u32x4*)(WT + (size_t)(dst_row0 + n) * K + k0 + 8 * c) = o; }
    WAVE_SYNC();
}
__device__ __forceinline__ void phase_prologue(const Params& P, unsigned char* smem, int wv) {
    ParamsPtr pp = PARAMS_PTR(P); PIN_S(pp); unsigned char* ws = pp->ws; int bidx = (int)blockIdx.x, gdim = (int)gridDim.x; PIN_S(bidx); PIN_S(gdim);
    const int tid = phase_tid(wv), lane = tid & 63, wave = tid >> 6;
    float* scr = (float*)smem + wave * (64 * 65);
    const int gw = bidx * NWAVES + wave, ngw = NWAVES * gdim;
    constexpr int I_IN = 16 * (PLD / 64), I_OUT = 16 * 16, I_W1 = NE * 16 * 32, I_W2 = NE * 16 * 16, I_L = I_IN + I_OUT + I_W1 + I_W2;
    for (int it = gw; it < NL * I_L; it += ngw) {
        const int l = it / I_L; int r = it % I_L;
        if (r < I_IN) { const int kb = r / (PLD / 64), nb = r % (PLD / 64);
            transpose_item(pp->in[1] + (size_t)l * D * PIN, D, PIN, (bf16_t*)(ws + O_WIN) + (size_t)l * PLD * D, kb * 64, nb * 64, nb * 64, scr, lane); continue; }
        r -= I_IN;
        if (r < I_OUT) { const int kb = r / 16, nb = r % 16;
            transpose_item(pp->in[21] + (size_t)l * D * D, D, D, (bf16_t*)(ws + O_WOUT) + (size_t)l * D * D, kb * 64, nb * 64, nb * 64, scr, lane); continue; }
        r -= I_OUT;
        if (r < I_W1) { const int e = r / (16 * 32), q = r % (16 * 32), kb = q / 32, nb = q % 32, n0 = nb * 64;
            const int dst = n0 < DFF ? (n0 / 128) * 256 + (n0 % 128) : ((n0 - DFF) / 128) * 256 + 128 + ((n0 - DFF) % 128);
            transpose_item(pp->in[26] + ((size_t)l * NE + e) * D * 2 * DFF, D, 2 * DFF, (bf16_t*)(ws + O_W1) + ((size_t)l * NE + e) * 2 * DFF * D, kb * 64, n0, dst, scr, lane); continue; }
        r -= I_W1;
        { const int e = r / (16 * 16), q = r % (16 * 16), kb = q / 16, nb = q % 16;
            transpose_item(pp->in[28] + ((size_t)l * NE + e) * DFF * D, DFF, D, (bf16_t*)(ws + O_W2) + ((size_t)l * NE + e) * D * DFF, kb * 64, nb * 64, nb * 64, scr, lane); }
    }
    {
        const float* gw_ = pp->in[4]; bf16_t* WSB = (bf16_t*)(ws + O_WSB);
        for (size_t i = ((size_t)bidx * NTHREADS + tid) * 4; i < (size_t)NL * GH * CH * CH; i += (size_t)gdim * NTHREADS * 4) {
            const f32x4 v = *(const f32x4*)(gw_ + i); u32x2 o; o.x = pk2(v.x, v.y); o.y = pk2(v.z, v.w); *(u32x2*)(WSB + i) = o;
        }
    }
    {
        bf16_t* LWT = (bf16_t*)(ws + O_LWT);
        for (int i = bidx * NTHREADS + tid; i < NL * 1920 * 128; i += gdim * NTHREADS) {
            const int k = i & 127, n = (i >> 7) % 1920, ll = i / (1920 * 128);
            float v = 0.f;
            if (n < 1536) { if (k < 64) { const int grp = n / 768, d = (n / 384) & 1, c = n % 384; v = (grp == 0 ? pp->in[8] : pp->in[10])[(((size_t)ll * 2 + d) * 64 + k) * RW + c]; } }
            else v = pp->in[11][((size_t)ll * 128 + k) * RW + (n - 1536)];
            LWT[i] = (bf16_t)f2bf(v);
        }
    }
    {
        bf16_t* RWT = (bf16_t*)(ws + O_RWT);
        for (int i = bidx * NTHREADS + tid; i < NL * NE * D; i += gdim * NTHREADS) {
            const int k = i % D, e = (i / D) % NE, ll = i / (D * NE);
            const float v = pp->in[24][((size_t)ll * D + k) * NE + e];
            const unsigned hi = f2bf(v); const float lo = v - bf_lo(hi);
            RWT[((size_t)(ll * 2 + 0) * NE + e) * D + k] = (bf16_t)hi; RWT[((size_t)(ll * 2 + 1) * NE + e) * D + k] = (bf16_t)f2bf(lo);
        }
    }
    const float* x = pp->in[0]; bf16_t* XB = (bf16_t*)(ws + O_XB);
    for (size_t i = ((size_t)bidx * NTHREADS + tid) * 4; i < (size_t)T * D; i += (size_t)gdim * NTHREADS * 4) {
        const f32x4 v = *(const f32x4*)(x + i); u32x2 o; o.x = pk2(v.x, v.y); o.y = pk2(v.z, v.w); *(u32x2*)(XB + i) = o;
    }
}

__device__ __forceinline__ float tshift(const float* P, int t, int s, int col, const float* mu0, const float* mu1, int rc) {
    const float cur = P[(size_t)t * PLD + col];
    const float prv = s > 0 ? P[(size_t)(t - 1) * PLD + col] : 0.f;
    const float nxt = s < S - 1 ? P[(size_t)(t + 1) * PLD + col] : 0.f;
    return cur + mu0[rc] * (prv - cur) + mu1[rc] * (nxt - cur);
}

__device__ __forceinline__ void phase_prep(const Params& P, int l, unsigned char* smem, int wv) {
    ParamsPtr pp = PARAMS_PTR(P); PIN_S(pp); unsigned char* ws = pp->ws; int bidx = (int)blockIdx.x, gdim = (int)gridDim.x; PIN_S(bidx); PIN_S(gdim);
    const bf16_t* proj = (const bf16_t*)(ws + O_PROJ); const float* projg = (const float*)(ws + O_PROJG);
    float* UG = (float*)(ws + O_UG); bf16_t* VNT = (bf16_t*)(ws + O_VNT);
    float* RR = (float*)(ws + O_RR); float* VV = (float*)(ws + O_VV); float* KK = (float*)(ws + O_KK);
    float* KD = (float*)(ws + O_KD); float* ICLR = (float*)(ws + O_ICLR);
    float* GATE = (float*)(ws + O_GATE); float* BONUS = (float*)(ws + O_BONUS); float* LWG = (float*)(ws + O_LW);
    bf16_t* RB = (bf16_t*)(ws + O_RB); bf16_t* VB = (bf16_t*)(ws + O_VB); bf16_t* KKB = (bf16_t*)(ws + O_KKB); bf16_t* BBB = (bf16_t*)(ws + O_BBB); bf16_t* KDB = (bf16_t*)(ws + O_KDB);
#if !MK_RWKV_CHUNKED
    float* DEC = (float*)(ws + O_DEC); float* BRKR = (float*)(ws + O_BRKR);
#endif
    bf16_t* MQB = (bf16_t*)(ws + O_MQB); bf16_t* MKB = (bf16_t*)(ws + O_MKB); bf16_t* KT = (bf16_t*)(ws + O_KT); bf16_t* VT = (bf16_t*)(ws + O_VT);
    float* IG = (float*)(ws + O_IG); float* LF = (float*)(ws + O_LF);
    const bf16_t* LWT = (const bf16_t*)(ws + O_LWT) + (size_t)l * 1920 * 128;
    const float* gln_g = pp->in[2] + (size_t)l * GW; const float* gln_b = pp->in[3] + (size_t)l * GW;
    const float* mu0 = pp->in[6] + (size_t)l * 2 * RPROJ; const float* mu1 = mu0 + RPROJ;
    const float* w0 = pp->in[7] + (size_t)l * 2 * RW; const float* a0 = pp->in[9] + (size_t)l * 2 * RW;
    const float* k_k = pp->in[12] + (size_t)l * RW; const float* k_a = pp->in[13] + (size_t)l * RW; const float* r_k = pp->in[14] + (size_t)l * RW;
    const float* conv_w = pp->in[17] + (size_t)l * 3 * 768; const float* conv_b = pp->in[18] + (size_t)l * 768; const float* gate_b = pp->in[19] + (size_t)l * 24;
    float* win = (float*)smem;
    bf16_t* lin = (bf16_t*)(smem + 101376);
    bf16_t* tvn = (bf16_t*)(smem + 110592);
    bf16_t* tk = (bf16_t*)(smem + 118784);
    bf16_t* tv = (bf16_t*)(smem + 131072);
    constexpr int LIN = 264;
    const int tid = phase_tid(wv), lane = tid & 63, wave = tid >> 6, col = lane & 15, g = lane >> 4;
    for (int u = bidx; u < T / 16; u += gdim) {
        const int t0 = u * 16, s0 = t0 % S, bb = t0 / S;
        __syncthreads();
        {
            u32x2 wb[18];
#pragma unroll
            for (int row = 0; row < 18; ++row) {
                const int sq = s0 - 1 + row;
                wb[row] = (u32x2){0u, 0u};
                if (sq >= 0 && sq < S && tid < 352) wb[row] = *(const u32x2*)(proj + (size_t)(t0 - 1 + row) * PLD + C_RW + tid * 4);
            }
            if (tid < 352) {
#pragma unroll
                for (int row = 0; row < 18; ++row) *(f32x4*)(win + row * RPROJ + tid * 4) = (f32x4){bf_lo(wb[row].x), bf_hi(wb[row].x), bf_lo(wb[row].y), bf_hi(wb[row].y)};
            }
        }
        for (int rep_ = 0; rep_ < (MK_PROBE == 3 ? 2 : 1); ++rep_) {
            const int i = tid >> 5, l32 = tid & 31, t = t0 + i;
            float v[8], ug[8]; float sum = 0.f;
#pragma unroll
            for (int j = 0; j < 8; ++j) { const int c = j * 32 + l32; ug[j] = bf_lo((unsigned)proj[(size_t)t * PLD + c]); v[j] = bf_lo((unsigned)proj[(size_t)t * PLD + GW + c]); }
#pragma unroll
            for (int j = 0; j < 8; ++j) { const int c = j * 32 + l32; UG[(size_t)t * GW + c] = geluf_(ug[j]); v[j] = geluf_(v[j]); sum += v[j]; }
#pragma unroll
            for (int o = 16; o >= 1; o >>= 1) sum += SHX(sum, o, lane);
            const float mean = sum * (1.0f / GW); float q = 0.f;
#pragma unroll
            for (int j = 0; j < 8; ++j) { const float d = v[j] - mean; q += d * d; }
#pragma unroll
            for (int o = 16; o >= 1; o >>= 1) q += SHX(q, o, lane);
            const float rstd = 1.0f / sqrtf(q * (1.0f / GW) + LN_EPS);
#pragma unroll
            for (int j = 0; j < 8; ++j) { const int c = j * 32 + l32; tvn[c * 16 + i] = (bf16_t)f2bf((v[j] - mean) * rstd * gln_g[c] + gln_b[c]); }
        }
        __syncthreads();
        {
            const int hf = tid & 1, c = tid >> 1;
            *(u32x4*)(VNT + ((size_t)bb * GW + c) * S + s0 + hf * 8) = *(const u32x4*)(tvn + c * 16 + hf * 8);
        }
        for (int idx = tid; idx < 16 * 256; idx += NTHREADS) {
            const int i = idx >> 8, j = idx & 255, rc = 1152 + j;
            const float pv = win[i * RPROJ + rc], cv = win[(i + 1) * RPROJ + rc], nv = win[(i + 2) * RPROJ + rc];
            const float x = cv + mu0[rc] * (pv - cv) + mu1[rc] * (nv - cv);
            lin[i * LIN + j] = (bf16_t)f2bf(j < 64 ? ftanh(x) : (j < 128 ? x : sigmoidf_(x)));
        }
        __syncthreads();
        for (int rep_ = 0; rep_ < (MK_PROBE == 1 ? 2 : 1); ++rep_) {
#pragma unroll 1
            for (int qg = 0; qg < 3; ++qg) {
                bf16x8 bw_[5][4]; float bias_[5];
#pragma unroll
                for (int q5 = 0; q5 < 5; ++q5) {
                    const int nt = wave * 15 + qg * 5 + q5, grp = nt / 24, c = (nt % 24) * 16 + col;
                    const bf16_t* bw = LWT + (size_t)(nt * 16 + col) * 128 + 8 * g;
#pragma unroll
                    for (int ks = 0; ks < 4; ++ks) bw_[q5][ks] = *(const bf16x8*)(bw + ks * 32);
                    bias_[q5] = grp < 2 ? w0[grp * RW + c] : (grp < 4 ? a0[(grp - 2) * RW + c] : 0.f);
                }
#pragma unroll
                for (int q5 = 0; q5 < 5; ++q5) {
                    const int nt = wave * 15 + qg * 5 + q5, grp = nt / 24, c = (nt % 24) * 16 + col;
                    const int kcol = grp < 2 ? 0 : (grp < 4 ? 64 : 128);
                    f32x4 acc = (f32x4){0.f, 0.f, 0.f, 0.f};
#pragma unroll
                    for (int ks = 0; ks < 2; ++ks) acc = MFMA16(*(const bf16x8*)(lin + col * LIN + kcol + ks * 32 + 8 * g), bw_[q5][ks], acc);
                    if (grp == 4) {
#pragma unroll
                        for (int ks = 2; ks < 4; ++ks) acc = MFMA16(*(const bf16x8*)(lin + col * LIN + kcol + ks * 32 + 8 * g), bw_[q5][ks], acc);
                    }
                    if (grp < 2) {
#pragma unroll
                        for (int r = 0; r < 4; ++r) { const float lw = -fexp(-softplusf_(-(acc[r] + bias_[q5])) - 0.5f); const size_t o = (size_t)grp * T * RW + (size_t)(t0 + 4 * g + r) * RW + c; LWG[o] = lw;
#if !MK_RWKV_CHUNKED
                            DEC[o] = expf(lw);
#endif
                        }
                    } else if (grp < 4) {
#pragma unroll
                        for (int r = 0; r < 4; ++r) ICLR[(size_t)(grp - 2) * T * RW + (size_t)(t0 + 4 * g + r) * RW + c] = sigmoidf_(acc[r] + bias_[q5]);
                    } else {
#pragma unroll
                        for (int r = 0; r < 4; ++r) GATE[(size_t)(t0 + 4 * g + r) * RW + c] = acc[r];
                    }
                }
            }
        }
        __syncthreads();
        for (int rep_ = 0; rep_ < (MK_PROBE == 2 ? 2 : 1); ++rep_) if (wave < 6) {
            const int c = tid, h = wave;
            const float kkc = k_k[c], kac = k_a[c], rkc = r_k[c];
            const float m0r = mu0[c], m1r = mu1[c], m0k = mu0[RW + c], m1k = mu1[RW + c], m0v = mu0[2 * RW + c], m1v = mu1[2 * RW + c];
            float ic0[16], ic1[16];
#pragma unroll
            for (int i = 0; i < 16; ++i) { const size_t o = (size_t)(t0 + i) * RW + c; ic0[i] = ICLR[o]; ic1[i] = ICLR[(size_t)T * RW + o]; }
#pragma unroll
            for (int i = 0; i < 16; ++i) {
                const int t = t0 + i;
                const float* w_ = win + i * RPROJ + c;
                const float rp = w_[0], rc_ = w_[RPROJ], rn = w_[2 * RPROJ];
                const float kp = w_[RW], kc_ = w_[RPROJ + RW], kn = w_[2 * RPROJ + RW];
                const float vp = w_[2 * RW], vc_ = w_[RPROJ + 2 * RW], vn = w_[2 * RPROJ + 2 * RW];
                const float r = rc_ + m0r * (rp - rc_) + m1r * (rn - rc_);
                const float k = kc_ + m0k * (kp - kc_) + m1k * (kn - kc_);
                const float v = vc_ + m0v * (vp - vc_) + m1v * (vn - vc_);
                const size_t o = (size_t)t * RW + c;
                const float kq = k * kkc;
                const float n2 = wave_sum_fast(kq * kq, lane);
                const float kk = kq / fmaxf(sqrtf(n2), 1e-12f);
                const float kd0 = k * (1.0f + (ic0[i] - 1.0f) * kac), kd1 = k * (1.0f + (ic1[i] - 1.0f) * kac);
                const float bon = wave_sum_fast(r * (kd0 + kd1) * rkc, lane);
#if MK_RWKV_CHUNKED
                RB[o] = (bf16_t)f2bf(r); VB[o] = (bf16_t)f2bf(v); KKB[o] = (bf16_t)f2bf(kk);
                BBB[o] = (bf16_t)f2bf(kk * ic0[i]); BBB[(size_t)T * RW + o] = (bf16_t)f2bf(kk * ic1[i]);
                KDB[o] = (bf16_t)f2bf(kd0); KDB[(size_t)T * RW + o] = (bf16_t)f2bf(kd1);
#else
                RR[o] = r; VV[o] = v; KK[o] = kk;
                KD[o] = kd0; KD[(size_t)T * RW + o] = kd1;
#endif
                if (lane == 0) BONUS[(size_t)t * RH + h] = bon;
#if !MK_RWKV_CHUNKED
                { const float br0 = wave_sum(kk * ic0[i] * r, lane), br1 = wave_sum(kk * ic1[i] * r, lane), kr0 = wave_sum(kd0 * r, lane), kr1 = wave_sum(kd1 * r, lane);
                  if (lane == 0) { BRKR[((size_t)t * RH + h) * 2] = br0; BRKR[((size_t)t * RH + h) * 2 + 1] = kr0; BRKR[((size_t)(T + t) * RH + h) * 2] = br1; BRKR[((size_t)(T + t) * RH + h) * 2 + 1] = kr1; } }
#endif
            }
        }
        __syncthreads();
        {
            u32x2 wb[9], vb[3];
            const int rsel = tid >= 192 ? 1 : 0, c4 = tid - rsel * 192;
#pragma unroll
            for (int it = 0; it < 9; ++it) {
                const int row = 2 * it + rsel, sq = s0 - 1 + row;
                wb[it] = (u32x2){0u, 0u};
                if (tid < 384 && sq >= 0 && sq < S) wb[it] = *(const u32x2*)(proj + (size_t)(t0 - 1 + row) * PLD + C_MW + c4 * 4);
            }
#pragma unroll
            for (int it = 0; it < 3; ++it) { const int idx = tid + it * NTHREADS, i = idx / 96, cc = (idx % 96) * 4; vb[it] = *(const u32x2*)(proj + (size_t)(t0 + i) * PLD + C_MW + 2 * MW + cc); }
            if (tid < 384) {
#pragma unroll
                for (int it = 0; it < 9; ++it) *(f32x4*)(win + (2 * it + rsel) * 768 + c4 * 4) = (f32x4){bf_lo(wb[it].x), bf_hi(wb[it].x), bf_lo(wb[it].y), bf_hi(wb[it].y)};
            }
#pragma unroll
            for (int it = 0; it < 3; ++it) { const int idx = tid + it * NTHREADS, i = idx / 96, cc = (idx % 96) * 4; const u32x2 v = vb[it];
                tv[(cc + 0) * 16 + i] = (bf16_t)(v.x & 0xffffu); tv[(cc + 1) * 16 + i] = (bf16_t)(v.x >> 16); tv[(cc + 2) * 16 + i] = (bf16_t)(v.y & 0xffffu); tv[(cc + 3) * 16 + i] = (bf16_t)(v.y >> 16); }
        }
        for (int idx = tid; idx < 16 * 24; idx += NTHREADS) {
            const int i = idx / 24, gi = idx % 24, t = t0 + i;
            const int isf = gi / 12, dir = (gi / 6) & 1, h = gi % 6;
            const float gg = projg[(size_t)t * 256 + (3456 - (PLD - 256)) + gi] + gate_b[gi];
            if (isf) LF[((size_t)dir * T + t) * MH + h] = -softplusf_(-gg); else IG[((size_t)dir * T + t) * MH + h] = gg;
        }
        __syncthreads();
        for (int rep_ = 0; rep_ < (MK_PROBE == 4 ? 2 : 1); ++rep_)
        for (int idx = tid; idx < 16 * 768; idx += NTHREADS) {
            const int i = idx / 768, c = idx % 768, t = t0 + i;
            const float* w_ = win + i * 768 + c;
            float y = conv_b[c] + w_[0] * conv_w[c] + w_[768] * conv_w[768 + c] + w_[1536] * conv_w[2 * 768 + c];
            y = y * sigmoidf_(y);
            if (c < MW) MQB[(size_t)t * MW + c] = (bf16_t)f2bf(y);
            else { const bf16_t kb = (bf16_t)f2bf(y * 0.125f); MKB[(size_t)t * MW + (c - MW)] = kb; tk[(c - MW) * 16 + i] = kb; }
        }
        __syncthreads();
        for (int idx = tid; idx < 2 * MW * 2; idx += NTHREADS) {
            const int hf = idx & 1, c = (idx >> 1) % MW, which = idx / (2 * MW);
            const u32x4 val = *(const u32x4*)((which ? tv : tk) + c * 16 + hf * 8);
            bf16_t* dst = (which ? VT : KT) + ((size_t)(bb * MH) * 64 + c) * S + s0 + hf * 8;
            *(u32x4*)dst = val;
        }
    }
    __syncthreads();
}

__device__ __forceinline__ void phase_gmlp_mix(const Params& P, int l, unsigned char* smem, int wv, int bid, int nb) {
    PIN_S(bid); PIN_S(nb);
    ParamsPtr pp = PARAMS_PTR(P); PIN_S(pp); unsigned char* ws = pp->ws;
    const float* UG = (const float*)(ws + O_UG); const bf16_t* VNT = (const bf16_t*)(ws + O_VNT); bf16_t* GRP = (bf16_t*)(ws + O_GRP);
    const bf16_t* WSB = (const bf16_t*)(ws + O_WSB) + (size_t)l * GH * CH * CH; const float* gbs = pp->in[5] + (size_t)l * GH * CH;
    const int tid = phase_tid(wv), lane = tid & 63, wave = tid >> 6, col = lane & 15, g = lane >> 4;
    for (int u = bid; u < NB * NCH * GH; u += nb) {
        const int h = u % GH, c = (u / GH) % NCH, b = u / (GH * NCH);
        const int tok0 = b * S + c * CH;
        const bf16_t* wb = WSB + (size_t)h * CH * CH + (size_t)(wave * 16 + col) * CH + 8 * g;
        const bf16_t* vb = VNT + ((size_t)b * GW + h * 64 + col) * S + (size_t)c * CH + 8 * g;
        f32x4 acc[4];
#pragma unroll
        for (int et = 0; et < 4; ++et) acc[et] = (f32x4){0.f, 0.f, 0.f, 0.f};
#pragma unroll
        for (int ks = 0; ks < 4; ++ks) {
            const bf16x8 af = *(const bf16x8*)(wb + ks * 32);
#pragma unroll
            for (int et = 0; et < 4; ++et) acc[et] = MFMA16(af, *(const bf16x8*)(vb + (size_t)et * 16 * S + ks * 32), acc[et]);
        }
#pragma unroll
        for (int r = 0; r < 4; ++r) {
            const int p = wave * 16 + 4 * g + r; const size_t t = (size_t)(tok0 + p); const float bsv = gbs[h * CH + p];
#pragma unroll
            for (int et = 0; et < 4; ++et) { const int ch = h * 64 + et * 16 + col; GRP[t * D + ch] = (bf16_t)f2bf(UG[t * GW + ch] * (acc[et][r] + bsv)); }
        }
    }
}

constexpr int SC_STEPS = 16;
constexpr int SC_BUF = SC_STEPS * 6 * 64;
__device__ __forceinline__ void phase_rwkv_scan(const Params& P, int l, unsigned char* smem, int wv, int bid, int nb) {
    PIN_S(bid); PIN_S(nb);
    ParamsPtr pp = PARAMS_PTR(P); PIN_S(pp); unsigned char* ws = pp->ws;
    const float* RR = (const float*)(ws + O_RR); const float* VV = (const float*)(ws + O_VV); const float* KK = (const float*)(ws + O_KK);
    const float* DEC = (const float*)(ws + O_DEC); const float* KD = (const float*)(ws + O_KD); const float* ICLR = (const float*)(ws + O_ICLR);
    float* SCAN = (float*)(ws + O_SCAN); const float* BRKR = (const float*)(ws + O_BRKR);
    const int tid = phase_tid(wv), lane = tid & 63, wave = tid >> 6, rl = (lane >> 4) & 1, kq = (lane & 15) | ((lane >> 5) << 4);
    float* buf = (float*)smem;
    float* scal = buf + 2 * SC_BUF;
    float* outb = scal + 2 * SC_STEPS * 2;
    typedef float f32x2 __attribute__((ext_vector_type(2)));
    for (int u = bid; u < 2 * NB * RH * 4; u += nb) {
        const int qt = u & 3, h = (u >> 2) % RH, b = (u / (4 * RH)) % NB, d = u / (4 * RH * NB);
        const size_t doff = (size_t)d * T * RW;
        float s0 = 0.f, s1 = 0.f;
        float pw[2], pa[2], pb[2], pk[2], pr[2], pv[2], psc = 0.f;
#define SC_LOAD(c) do { _Pragma("unroll") for (int i = 0; i < 2; ++i) { const int idx = tid + NTHREADS * i, st = idx >> 6, k = idx & 63; const int tau = (c) * SC_STEPS + st, sq = d ? S - 1 - tau : tau; \
            const size_t o = (size_t)(b * S + sq) * RW + h * 64 + k; \
            pw[i] = DEC[doff + o]; pa[i] = KK[o]; pb[i] = ICLR[doff + o]; pk[i] = KD[doff + o]; pr[i] = RR[o]; pv[i] = VV[o]; }     \
            if (tid < 2 * SC_STEPS) { const int tau = (c) * SC_STEPS + (tid >> 1), sq = d ? S - 1 - tau : tau; psc = BRKR[((size_t)(d * T + b * S + sq) * RH + h) * 2 + (tid & 1)]; } } while (0)
#define SC_WRITE(c) do { float* B_ = buf + ((c) & 1) * SC_BUF; _Pragma("unroll") for (int i = 0; i < 2; ++i) { const int idx = tid + NTHREADS * i, st = idx >> 6, k = idx & 63; \
            float* q_ = B_ + st * 384 + k; q_[0] = pw[i]; q_[64] = -pa[i]; q_[128] = pa[i] * pb[i]; q_[192] = pk[i]; q_[256] = pw[i] * pr[i]; q_[320] = pv[i]; } \
            if (tid < 2 * SC_STEPS) scal[((c) & 1) * SC_STEPS * 2 + tid] = psc; } while (0)
        __syncthreads();
        SC_LOAD(0); SC_WRITE(0);
        __syncthreads();
        const int row = qt * 16 + wave * 2 + rl;
        for (int c = 0; c < S / SC_STEPS; ++c) {
            const bool more = (c + 1) < S / SC_STEPS;
            if (more) SC_LOAD(c + 1);
            const float* B = buf + (c & 1) * SC_BUF; const float* sc = scal + (c & 1) * SC_STEPS * 2; float* ob = outb + (c & 1) * SC_STEPS * 16;
            float outs[SC_STEPS];
            f32x2 w2 = *(const f32x2*)(B + 2 * kq), a2 = *(const f32x2*)(B + 64 + 2 * kq), b2 = *(const f32x2*)(B + 128 + 2 * kq);
            f32x2 k2 = *(const f32x2*)(B + 192 + 2 * kq), wr2 = *(const f32x2*)(B + 256 + 2 * kq);
            float v = B[320 + row]; float br = sc[0], kr = sc[1];
#pragma unroll
            for (int st = 0; st < SC_STEPS; ++st) {
                const int sn = st + 1 < SC_STEPS ? st + 1 : st;
                const float* q = B + sn * 384;
                const f32x2 nw2 = *(const f32x2*)(q + 2 * kq), na2 = *(const f32x2*)(q + 64 + 2 * kq), nb2 = *(const f32x2*)(q + 128 + 2 * kq);
                const f32x2 nk2 = *(const f32x2*)(q + 192 + 2 * kq), nwr2 = *(const f32x2*)(q + 256 + 2 * kq);
                const float nv = q[320 + row], nbr = sc[sn * 2], nkr = sc[sn * 2 + 1];
                SCHED_BAR();
                float sa = s0 * a2.x + s1 * a2.y;
                float po = s0 * wr2.x + s1 * wr2.y;
                sa = row32_sum(sa); po = row32_sum(po);
                outs[st] = po + sa * br + v * kr;
                s0 = s0 * w2.x + (sa * b2.x + v * k2.x); s1 = s1 * w2.y + (sa * b2.y + v * k2.y);
                SCHED_BAR();
                w2 = nw2; a2 = na2; b2 = nb2; k2 = nk2; wr2 = nwr2; v = nv; br = nbr; kr = nkr;
            }
            if (kq == 0) {
#pragma unroll
                for (int st = 0; st < SC_STEPS; ++st) ob[st * 16 + wave * 2 + rl] = outs[st];
            }
            if (more) SC_WRITE(c + 1);
            __syncthreads();
            if (tid < 16 * SC_STEPS) {
                const int st = tid >> 4, r = tid & 15, tau = c * SC_STEPS + st, sq = d ? S - 1 - tau : tau;
                SCAN[doff + (size_t)(b * S + sq) * RW + h * 64 + qt * 16 + r] = ob[st * 16 + r];
            }
        }
#undef SC_LOAD
#undef SC_WRITE
    }
    __syncthreads();
}

constexpr int RST = 72;
constexpr int RARR = 64 * RST;
__device__ __forceinline__ f32x4 tile_nt(const bf16_t* Aa, int ta, const bf16_t* Ba, int tb, f32x4 acc, int col, int g) {
#pragma unroll
    for (int ks = 0; ks < 2; ++ks) {
        const bf16x8 af = *(const bf16x8*)(Aa + (ta * 16 + col) * RST + ks * 32 + 8 * g);
        const bf16x8 bfr = *(const bf16x8*)(Ba + (tb * 16 + col) * RST + ks * 32 + 8 * g);
        acc = MFMA16(af, bfr, acc);
    }
    return acc;
}
__device__ __forceinline__ void phase_rwkv_pre(const Params& P, int l, unsigned char* smem, int wv) {
    ParamsPtr pp = PARAMS_PTR(P); PIN_S(pp); unsigned char* ws = pp->ws; int bidx = (int)blockIdx.x, gdim = (int)gridDim.x; PIN_S(bidx); PIN_S(gdim);
    const bf16_t* RB = (const bf16_t*)(ws + O_RB); const bf16_t* VB = (const bf16_t*)(ws + O_VB); const bf16_t* KKB = (const bf16_t*)(ws + O_KKB);
    const float* LWG = (const float*)(ws + O_LW); const bf16_t* KDB = (const bf16_t*)(ws + O_KDB); const bf16_t* BBB = (const bf16_t*)(ws + O_BBB);
    bf16_t* Qg = (bf16_t*)(ws + O_RQ); bf16_t* Ag = (bf16_t*)(ws + O_RA); bf16_t* Hg = (bf16_t*)(ws + O_RH); bf16_t* Gg = (bf16_t*)(ws + O_RG);
    const int tid0 = phase_tid(wv);
#define RW_STAGE_VARS int tid = tid0; PIN_V(tid); const int lane = tid & 63, wave = tid >> 6, col = lane & 15, g = lane >> 4; (void)lane; (void)wave; (void)col; (void)g;
    bf16_t* At = (bf16_t*)smem; bf16_t* Bt = At + RARR; bf16_t* Kt = Bt + RARR; bf16_t* Rt = Kt + RARR;
    bf16_t* BtT = Rt + RARR; bf16_t* KtT = BtT + RARR; bf16_t* VT = KtT + RARR;
    bf16_t* Lak = VT + RARR; bf16_t* Mrb = Lak + RARR; bf16_t* Mrk = Mrb + RARR; bf16_t* YT = Mrk + RARR; bf16_t* W2T = YT + RARR;
    bf16_t* Lbo = W2T + RARR;
    float* LabT = (float*)(Lbo + RARR);
    float* Xs = LabT + 4096;
    float* Pb = Xs + 4096;
    float* segs = Pb + 2048;
    float* PC = segs + 512;
    float plw[8]; unsigned pkk[8], pbq[8], pkd[8], prr[8], pvv[8];
#define RW_LOAD(uu) do { const int c_ = (uu) % RNC, h_ = ((uu) / RNC) % RH, b_ = ((uu) / (RNC * RH)) % NB, d_ = (uu) / (RNC * RH * NB); const size_t doff_ = (size_t)d_ * T * RW; \
        const int ch_ = tid0 & 63, sg_ = tid0 >> 6; _Pragma("unroll") for (int j = 0; j < 8; ++j) { const int tau = c_ * RC + sg_ * 8 + j, sq = d_ ? S - 1 - tau : tau; const size_t o = (size_t)(b_ * S + sq) * RW + h_ * 64 + ch_; \
        plw[j] = LWG[doff_ + o]; pkk[j] = KKB[o]; pbq[j] = BBB[doff_ + o]; pkd[j] = KDB[doff_ + o]; prr[j] = RB[o]; pvv[j] = VB[o]; } } while (0)
    if (bidx < RUN) RW_LOAD(bidx);
    for (int u = bidx; u < RUN; u += gdim) {
        const int c = u % RNC, h = (u / RNC) % RH, b = (u / (RNC * RH)) % NB, d = u / (RNC * RH * NB);
        (void)c; (void)h; (void)b; (void)d;
        __syncthreads();
        {
            RW_STAGE_VARS
            const int ch = tid & 63, sg = tid >> 6;
            float lw[8]; unsigned kk[8], bq_[8], kd[8], rr[8], vv[8];
#pragma unroll
            for (int j = 0; j < 8; ++j) { lw[j] = plw[j]; kk[j] = pkk[j]; bq_[j] = pbq[j]; kd[j] = pkd[j]; rr[j] = prr[j]; vv[j] = pvv[j]; }
            if (u + gdim < RUN) RW_LOAD(u + gdim);
            float run = 0.f;
#pragma unroll
            for (int j = 0; j < 8; ++j) { run += lw[j]; lw[j] = run; }
            segs[sg * 64 + ch] = run;
            __syncthreads();
            float off = 0.f;
            for (int q = 0; q < sg; ++q) off += segs[q * 64 + ch];
            u32x4 pbt, pkt, pvt; unsigned tb[8], tk[8], tvv[8];
            float prev = off;
#pragma unroll
            for (int j = 0; j < 8; ++j) {
                const int t = sg * 8 + j; const float cl = off + lw[j];
                const float ep = fexp(prev), en = fexp(-cl), epc = fexp(cl);
                const unsigned a_ = f2bf(-bf_lo(kk[j]) * ep), b_ = f2bf(bf_lo(bq_[j]) * en), k_ = f2bf(bf_lo(kd[j]) * en), r_ = f2bf(bf_lo(rr[j]) * epc), v_ = vv[j];
                At[t * RST + ch] = (bf16_t)a_; Bt[t * RST + ch] = (bf16_t)b_; Kt[t * RST + ch] = (bf16_t)k_; Rt[t * RST + ch] = (bf16_t)r_;
                tb[j] = b_; tk[j] = k_; tvv[j] = v_;
                prev = cl;
            }
            if (sg == 7) PC[ch] = fexp(prev);
            pbt.x = tb[0] | (tb[1] << 16); pbt.y = tb[2] | (tb[3] << 16); pbt.z = tb[4] | (tb[5] << 16); pbt.w = tb[6] | (tb[7] << 16);
            pkt.x = tk[0] | (tk[1] << 16); pkt.y = tk[2] | (tk[3] << 16); pkt.z = tk[4] | (tk[5] << 16); pkt.w = tk[6] | (tk[7] << 16);
            pvt.x = tvv[0] | (tvv[1] << 16); pvt.y = tvv[2] | (tvv[3] << 16); pvt.z = tvv[4] | (tvv[5] << 16); pvt.w = tvv[6] | (tvv[7] << 16);
            *(u32x4*)(BtT + ch * RST + sg * 8) = pbt; *(u32x4*)(KtT + ch * RST + sg * 8) = pkt; *(u32x4*)(VT + ch * RST + sg * 8) = pvt;
            for (int z_ = tid; z_ < 2 * RARR / 8; z_ += NTHREADS) ((u32x4*)YT)[z_] = (u32x4){0u, 0u, 0u, 0u};
        }
        __syncthreads();
        {
            RW_STAGE_VARS
            const int m = wave >> 1;
            const bf16_t* Ym = (m == 0 || m == 2) ? Bt : Kt; const bf16_t* Xm = (m < 2) ? At : Rt;
#pragma unroll 1
            for (int q = 0; q < 8; ++q) {
                const int tix = (wave & 1) * 8 + q, it = tix >> 2, tt = tix & 3;
                f32x4 acc = (f32x4){0.f, 0.f, 0.f, 0.f};
                if (it <= tt) acc = tile_nt(Ym, it, Xm, tt, acc, col, g);
                const int t = tt * 16 + col, i0 = it * 16 + 4 * g;
                float o4[4];
#pragma unroll
                for (int r = 0; r < 4; ++r) { const int i = i0 + r; const bool ok = m < 2 ? (i < t) : (i <= t); o4[r] = ok ? acc[r] : 0.f; }
                if (m == 0) {
#pragma unroll
                    for (int r = 0; r < 4; ++r) LabT[(i0 + r) * 64 + t] = o4[r];
                    const bool offd = it < tt;
                    u32x2 w2; w2.x = offd ? pk2(o4[0], o4[1]) : 0u; w2.y = offd ? pk2(o4[2], o4[3]) : 0u; *(u32x2*)(Lbo + t * RST + i0) = w2;
                }
                else { bf16_t* dst = (m == 1 ? Lak : (m == 2 ? Mrb : Mrk)) + t * RST + i0; u32x2 w2; w2.x = pk2(o4[0], o4[1]); w2.y = pk2(o4[2], o4[3]); *(u32x2*)dst = w2; }
            }
        }
        __syncthreads();
        {
            RW_STAGE_VARS
#pragma unroll
            for (int q = 0; q < 2; ++q) {
                const int tix = wave * 2 + q, tt = tix >> 2, et = tix & 3;
                f32x4 acc = (f32x4){0.f, 0.f, 0.f, 0.f};
                acc = tile_nt(Lak, tt, VT, et, acc, col, g);
#pragma unroll
                for (int r = 0; r < 4; ++r) Xs[(tt * 16 + 4 * g + r) * 64 + et * 16 + col] = acc[r];
            }
        }
        __syncthreads();
        {
            RW_STAGE_VARS
#pragma unroll 1
            for (int bb = 0; bb < 4; ++bb) {
                if (bb > 0) {
                    const bf16_t* Zt = (wave < 4 ? YT : W2T) + ((wave & 3) * 16 + col) * RST + 8 * g;
                    const bf16_t* La = Lbo + (16 * bb + col) * RST + 8 * g;
                    f32x4 acc = (f32x4){0.f, 0.f, 0.f, 0.f};
                    acc = MFMA16(*(const bf16x8*)La, *(const bf16x8*)Zt, acc);
                    if (bb > 2) acc = MFMA16(*(const bf16x8*)(La + 32), *(const bf16x8*)(Zt + 32), acc);
#pragma unroll
                    for (int r = 0; r < 4; ++r) Pb[(4 * g + r) * 128 + wave * 16 + col] = acc[r];
                }
                __syncthreads();
                if (wave < 2) {
                    float acc[16];
                    if (wave == 0) {
#pragma unroll
                        for (int r = 0; r < 16; ++r) acc[r] = bf_lo((unsigned)At[(16 * bb + r) * RST + lane]);
                    } else {
#pragma unroll
                        for (int r = 0; r < 16; ++r) acc[r] = Xs[(16 * bb + r) * 64 + lane];
                    }
                    if (bb > 0) {
#pragma unroll
                        for (int r = 0; r < 16; ++r) acc[r] += Pb[r * 128 + wave * 64 + lane];
                    }
                    const float* dp = LabT + (16 * bb) * 64 + 16 * bb;
#pragma unroll
                    for (int r = 1; r < 16; ++r)
#pragma unroll
                        for (int r2 = 0; r2 < r; ++r2) acc[r] += dp[r2 * 64 + r] * acc[r2];
                    bf16_t* dst = (wave == 0 ? YT : W2T) + lane * RST;
                    u32x4 w0, w1;
                    w0.x = pk2(acc[0], acc[1]); w0.y = pk2(acc[2], acc[3]); w0.z = pk2(acc[4], acc[5]); w0.w = pk2(acc[6], acc[7]);
                    w1.x = pk2(acc[8], acc[9]); w1.y = pk2(acc[10], acc[11]); w1.z = pk2(acc[12], acc[13]); w1.w = pk2(acc[14], acc[15]);
                    *(u32x4*)(dst + 16 * bb) = w0; *(u32x4*)(dst + 16 * bb + 8) = w1;
                }
                __syncthreads();
            }
        }
        __syncthreads();
        {
            RW_STAGE_VARS
            const int ty = wave >> 1;
#pragma unroll 1
            for (int q = 0; q < 8; ++q) {
                const int tix = (wave & 1) * 8 + q, ra = tix >> 2, cb = tix & 3;
                f32x4 acc = (f32x4){0.f, 0.f, 0.f, 0.f};
                if (ty == 0) {
                    acc = tile_nt(YT, ra, Mrb, cb, acc, col, g);
                    const u32x2 rt2 = *(const u32x2*)(Rt + (cb * 16 + col) * RST + ra * 16 + 4 * g);
                    u32x2 qb2; qb2.x = pk2(acc[0] + bf_lo(rt2.x), acc[1] + bf_hi(rt2.x)); qb2.y = pk2(acc[2] + bf_lo(rt2.y), acc[3] + bf_hi(rt2.y));
                    *(u32x2*)(Qg + (size_t)u * 4096 + (tix * 64 + lane) * 4) = qb2;
                } else if (ty == 1) {
                    acc = tile_nt(Mrb, ra, W2T, cb, acc, col, g); acc = tile_nt(Mrk, ra, VT, cb, acc, col, g);
                    { u32x2 hb; hb.x = pk2(acc[0], acc[1]); hb.y = pk2(acc[2], acc[3]); *(u32x2*)(Hg + (size_t)u * 4096 + (tix * 64 + lane) * 4) = hb; }
                } else if (ty == 2) {
                    acc = tile_nt(YT, ra, BtT, cb, acc, col, g);
                    const float pc = PC[cb * 16 + col]; const int k1 = cb * 16 + col;
                    float a4[4];
#pragma unroll
                    for (int r = 0; r < 4; ++r) a4[r] = pc * (acc[r] + ((ra * 16 + 4 * g + r) == k1 ? 1.0f : 0.f));
                    u32x2 ab2; ab2.x = pk2(a4[0], a4[1]); ab2.y = pk2(a4[2], a4[3]);
                    *(u32x2*)(Ag + (size_t)u * 4096 + (tix * 64 + lane) * 4) = ab2;
                } else {
                    acc = tile_nt(BtT, ra, W2T, cb, acc, col, g); acc = tile_nt(KtT, ra, VT, cb, acc, col, g);
#pragma unroll
                    for (int r = 0; r < 4; ++r) acc[r] *= PC[ra * 16 + 4 * g + r];
                    { u32x2 gb2; gb2.x = pk2(acc[0], acc[1]); gb2.y = pk2(acc[2], acc[3]); *(u32x2*)(Gg + (size_t)u * 4096 + (tix * 64 + lane) * 4) = gb2; }
                }
            }
        }
    }
    __syncthreads();
#undef RW_STAGE_VARS
#undef RW_LOAD
}
__device__ __forceinline__ void phase_rwkv_seq(const Params& P, int l, unsigned char* smem, int wv) {
    ParamsPtr pp = PARAMS_PTR(P); PIN_S(pp); unsigned char* ws = pp->ws; int bidx = (int)blockIdx.x, gdim = (int)gridDim.x; PIN_S(bidx); PIN_S(gdim);
    const bf16_t* Ag = (const bf16_t*)(ws + O_RA); const bf16_t* Gg = (const bf16_t*)(ws + O_RG); bf16_t* Sg = (bf16_t*)(ws + O_RS);
    const int tid = phase_tid(wv), lane = tid & 63, wave = tid >> 6, col = lane & 15, g = lane >> 4;
    const int gw = wave * gdim + bidx, ngw = NWAVES * gdim;
    for (int un = gw; un < 2 * NB * RH * 2; un += ngw) {
        const int ch = un >> 1, eh = un & 1;
        f32x4 acc[4][2];
#pragma unroll
        for (int a_ = 0; a_ < 4; ++a_)
#pragma unroll
            for (int b_ = 0; b_ < 2; ++b_) acc[a_][b_] = (f32x4){0.f, 0.f, 0.f, 0.f};
        u32x2 alo[4][2], ahi[4][2]; u32x2 gq[4][2];
        const unsigned aoff = (unsigned)(col * 64 + 4 * g), goff = (unsigned)(lane * 4);
#define RS_LOAD(cc) do { const bf16_t* ab_ = Ag + (size_t)(ch * RNC + (cc)) * 4096; const bf16_t* gb_ = Gg + (size_t)(ch * RNC + (cc)) * 4096 + eh * 512; \
            _Pragma("unroll") for (int ra = 0; ra < 4; ++ra) _Pragma("unroll") for (int p = 0; p < 2; ++p) { alo[ra][p] = *(const u32x2*)(ab_ + ((2 * p * 4 + ra) * 256) + goff); ahi[ra][p] = *(const u32x2*)(ab_ + (((2 * p + 1) * 4 + ra) * 256) + goff); } \
            _Pragma("unroll") for (int ra = 0; ra < 4; ++ra) _Pragma("unroll") for (int cb = 0; cb < 2; ++cb) gq[ra][cb] = *(const u32x2*)(gb_ + ((ra * 4 + cb) * 256) + goff); } while (0)
        RS_LOAD(0);
#pragma unroll 1
        for (int c = 0; c < RNC; ++c) {
            bf16_t* sb_ = Sg + (size_t)(ch * RNC + c) * 4096 + eh * 2048;
            bf16x8 bq[2][2];
#pragma unroll
            for (int cb = 0; cb < 2; ++cb) {
#pragma unroll
                for (int ra = 0; ra < 4; ++ra) {
                    u32x2 w2; w2.x = pk2(acc[ra][cb][0], acc[ra][cb][1]); w2.y = pk2(acc[ra][cb][2], acc[ra][cb][3]);
                    *(u32x2*)(sb_ + (cb * 1024 + ra * 16) + aoff) = w2;
                }
#pragma unroll
                for (int p = 0; p < 2; ++p) bq[p][cb] = cvt8(acc[2 * p][cb], acc[2 * p + 1][cb]);
            }
            u32x4 af[4][2];
#pragma unroll
            for (int ra = 0; ra < 4; ++ra) {
#pragma unroll
                for (int p = 0; p < 2; ++p) af[ra][p] = (u32x4){alo[ra][p].x, alo[ra][p].y, ahi[ra][p].x, ahi[ra][p].y};
#pragma unroll
                for (int cb = 0; cb < 2; ++cb) acc[ra][cb] = (f32x4){bf_lo(gq[ra][cb].x), bf_hi(gq[ra][cb].x), bf_lo(gq[ra][cb].y), bf_hi(gq[ra][cb].y)};
            }
            if (c + 1 < RNC) RS_LOAD(c + 1);
#pragma unroll
            for (int ra = 0; ra < 4; ++ra)
#pragma unroll
                for (int cb = 0; cb < 2; ++cb)
#pragma unroll
                    for (int p = 0; p < 2; ++p) acc[ra][cb] = MFMA16(__builtin_bit_cast(bf16x8, af[ra][p]), bq[p][cb], acc[ra][cb]);
        }
#undef RS_LOAD
    }
}
__device__ __forceinline__ void phase_rwkv_out(const Params& P, int l, unsigned char* smem, int wv) {
    ParamsPtr pp = PARAMS_PTR(P); PIN_S(pp); unsigned char* ws = pp->ws; int bidx = (int)blockIdx.x, gdim = (int)gridDim.x; PIN_S(bidx); PIN_S(gdim);
    const bf16_t* Qg = (const bf16_t*)(ws + O_RQ); const bf16_t* Sg = (const bf16_t*)(ws + O_RS); const bf16_t* Hg = (const bf16_t*)(ws + O_RH);
    const bf16_t* VB = (const bf16_t*)(ws + O_VB); const float* GATE = (const float*)(ws + O_GATE); const float* BONUS = (const float*)(ws + O_BONUS);
    bf16_t* GRP = (bf16_t*)(ws + O_GRP);
    const float* rln_g = pp->in[15] + (size_t)l * RW; const float* rln_b = pp->in[16] + (size_t)l * RW;
    const int tid = phase_tid(wv), lane = tid & 63, wave = tid >> 6, col = lane & 15, g = lane >> 4;
    for (int pu = bidx * NWAVES + wave; pu < NB * RH * RNC; pu += gdim * NWAVES) {
        const int c = pu % RNC, h = (pu / RNC) % RH, b = pu / (RNC * RH);
        f32x4 o[2][4][4];
#pragma unroll
        for (int d = 0; d < 2; ++d) {
            const int u = ((d * NB + b) * RH + h) * RNC + (d ? RNC - 1 - c : c);
            const size_t ub = (size_t)u * 4096;
            bf16x8 qa[4][2], sb[4][2];
#pragma unroll
            for (int q = 0; q < 4; ++q)
#pragma unroll
                for (int ks = 0; ks < 2; ++ks) {
                    const u32x2 q0 = *(const u32x2*)(Qg + ub + ((2 * ks * 4 + q) * 64 + lane) * 4), q1 = *(const u32x2*)(Qg + ub + (((2 * ks + 1) * 4 + q) * 64 + lane) * 4);
                    qa[q][ks] = __builtin_bit_cast(bf16x8, (u32x4){q0.x, q0.y, q1.x, q1.y});
                    const bf16_t* sp_ = Sg + ub + (q * 16 + col) * 64 + ks * 32 + 4 * g;
                    const u32x2 s0_ = *(const u32x2*)sp_, s1_ = *(const u32x2*)(sp_ + 16);
                    sb[q][ks] = __builtin_bit_cast(bf16x8, (u32x4){s0_.x, s0_.y, s1_.x, s1_.y});
                }
#pragma unroll
            for (int tt = 0; tt < 4; ++tt)
#pragma unroll
                for (int et = 0; et < 4; ++et) {
                    const u32x2 hb = *(const u32x2*)(Hg + ub + ((tt * 4 + et) * 64 + lane) * 4);
                    f32x4 acc = (f32x4){bf_lo(hb.x), bf_hi(hb.x), bf_lo(hb.y), bf_hi(hb.y)};
#pragma unroll
                    for (int ks = 0; ks < 2; ++ks) acc = MFMA16(qa[tt][ks], sb[et][ks], acc);
                    o[d][tt][et] = acc;
                }
        }
        const int src = (3 - g) * 16 + col;
#pragma unroll
        for (int tt = 0; tt < 4; ++tt)
#pragma unroll
            for (int et = 0; et < 4; ++et)
#pragma unroll
                for (int r = 0; r < 4; ++r) o[0][tt][et][r] += SHL(o[1][3 - tt][et][3 - r], src);
        float* tile = (float*)smem + wave * (64 * 68);
        WAVE_SYNC();
#pragma unroll
        for (int tt = 0; tt < 4; ++tt)
#pragma unroll
            for (int et = 0; et < 4; ++et)
#pragma unroll
                for (int r = 0; r < 4; ++r) tile[(tt * 16 + 4 * g + r) * 68 + et * 16 + col] = o[0][tt][et][r];
        WAVE_SYNC();
        {
            const int c4 = (lane & 15) * 4, ch = h * 64 + c4;
            const f32x4 lg = *(const f32x4*)(rln_g + ch), lb = *(const f32x4*)(rln_b + ch);
#pragma unroll 1
            for (int qb = 0; qb < 2; ++qb) {
                f32x4 gt_[8]; u32x2 vb_[8]; float bo_[8];
#pragma unroll
                for (int q8 = 0; q8 < 8; ++q8) {
                    const size_t t = (size_t)(b * S + c * RC + (qb * 8 + q8) * 4 + (lane >> 4));
                    gt_[q8] = *(const f32x4*)(GATE + t * RW + ch); vb_[q8] = *(const u32x2*)(VB + t * RW + ch); bo_[q8] = BONUS[t * RH + h];
                }
#pragma unroll
                for (int q8 = 0; q8 < 8; ++q8) {
                    const int tl = (qb * 8 + q8) * 4 + (lane >> 4);
                    const size_t t = (size_t)(b * S + c * RC + tl);
                    const f32x4 x = *(const f32x4*)(tile + tl * 68 + c4);
                    const float mean = row16_sum((x.x + x.y) + (x.z + x.w)) * (1.0f / 64.0f);
                    const f32x4 dl = x - mean;
                    const float var = row16_sum((dl.x * dl.x + dl.y * dl.y) + (dl.z * dl.z + dl.w * dl.w)) * (1.0f / 64.0f);
                    const float rstd = 1.0f / sqrtf(var + GN_EPS);
                    f32x4 y = dl * rstd * lg + lb;
                    y.x += bo_[q8] * bf_lo(vb_[q8].x); y.y += bo_[q8] * bf_hi(vb_[q8].x); y.z += bo_[q8] * bf_lo(vb_[q8].y); y.w += bo_[q8] * bf_hi(vb_[q8].y);
                    y = y * gt_[q8];
                    u32x2 ob; ob.x = pk2(y.x, y.y); ob.y = pk2(y.z, y.w);
                    *(u32x2*)(GRP + t * D + GW + ch) = ob;
                }
            }
        }
    }
    __syncthreads();
}

__device__ __forceinline__ void phase_mlstm_local(const Params& P, int l, unsigned char* smem, int wv, int bid, int nb) {
    PIN_S(bid); PIN_S(nb);
    ParamsPtr pp = PARAMS_PTR(P); PIN_S(pp); unsigned char* ws = pp->ws;
    const bf16_t* KT = (const bf16_t*)(ws + O_KT); const bf16_t* VT = (const bf16_t*)(ws + O_VT);
    const float* IG = (const float*)(ws + O_IG); const float* LF = (const float*)(ws + O_LF);
    float* CL = (float*)(ws + O_CL); float* NLb = (float*)(ws + O_NL); float* ML = (float*)(ws + O_ML); float* BL = (float*)(ws + O_BL);
    float* GVT = (float*)(ws + O_GVT); float* PMX = (float*)(ws + O_PMX); float* BCT = (float*)(ws + O_BCT);
    const int tid = phase_tid(wv), lane = tid & 63, wave = tid >> 6, col = lane & 15, g = lane >> 4;
    float* wts = (float*)smem + wave * 128;
    for (int u = bid * NWAVES + wave; u < 2 * NB * MH * NCH; u += nb * NWAVES) {
        const int c = u % NCH, h = (u / NCH) % MH, p = u / (NCH * MH), d = p / NB, b = p % NB;
        const int tc = d ? NCH - 1 - c : c, tok0 = b * S + tc * CH;
        const int i0 = d ? 127 - 2 * lane : 2 * lane, i1 = d ? i0 - 1 : i0 + 1;
        const size_t g0 = ((size_t)d * T + tok0 + i0) * MH + h, g1 = ((size_t)d * T + tok0 + i1) * MH + h;
        const float lf0 = LF[g0], lf1 = LF[g1], ig0 = IG[g0], ig1 = IG[g1];
        const float c1 = lf0 + lf1;
        float incl = c1;
#pragma unroll
        for (int o = 1; o < 64; o <<= 1) { const float tq = SHUP(incl, o, lane); if (lane >= o) incl += tq; }
        const float excl = incl - c1, bc0 = excl + lf0, bc1 = incl;
        const float blast = RDL(incl, 63);
        const float gv0 = ig0 - bc0, gv1 = ig1 - bc1, pl1 = fmaxf(gv0, gv1);
        float mincl = pl1;
#pragma unroll
        for (int o = 1; o < 64; o <<= 1) { const float tq = SHUP(mincl, o, lane); if (lane >= o) mincl = fmaxf(mincl, tq); }
        float mexcl = SHUP(mincl, 1, lane); if (lane == 0) mexcl = -INFINITY;
        const float pm0 = fmaxf(mexcl, gv0), pm1 = mincl;
        const float mloc = blast + RDL(mincl, 63);
        WAVE_SYNC();
        wts[i0] = fexp(blast + gv0 - mloc); wts[i1] = fexp(blast + gv1 - mloc);
        GVT[g0] = gv0; GVT[g1] = gv1; PMX[g0] = pm0; PMX[g1] = pm1; BCT[g0] = bc0; BCT[g1] = bc1;
        if (lane == 0) { ML[u] = mloc; BL[u] = blast; }
        WAVE_SYNC();
        const bf16_t* vbase = VT + ((size_t)(b * MH + h) * 64) * S + (size_t)tc * CH;
        const bf16_t* kbase = KT + ((size_t)(b * MH + h) * 64) * S + (size_t)tc * CH;
        const unsigned loff = (unsigned)(col * S + 8 * g);
        f32x4 acc[4][4];
#pragma unroll
        for (int a_ = 0; a_ < 4; ++a_)
#pragma unroll
            for (int b_ = 0; b_ < 4; ++b_) acc[a_][b_] = (f32x4){0.f, 0.f, 0.f, 0.f};
        float nsum[4] = {0.f, 0.f, 0.f, 0.f};
#pragma unroll 1
        for (int ks = 0; ks < 4; ++ks) {
            const int ii = ks * 32 + 8 * g;
            const f32x4 w0 = *(const f32x4*)(wts + ii), w1 = *(const f32x4*)(wts + ii + 4);
            bf16x8 af[4], bfk[4];
#pragma unroll
            for (int q = 0; q < 4; ++q) af[q] = *(const bf16x8*)(vbase + ((size_t)q * 16 * S + ks * 32) + loff);
#pragma unroll
            for (int q = 0; q < 4; ++q) {
                const u32x4 kr = *(const u32x4*)(kbase + ((size_t)q * 16 * S + ks * 32) + loff);
                f32x4 k0, k1;
                k0.x = bf_lo(kr.x) * w0.x; k0.y = bf_hi(kr.x) * w0.y; k0.z = bf_lo(kr.y) * w0.z; k0.w = bf_hi(kr.y) * w0.w;
                k1.x = bf_lo(kr.z) * w1.x; k1.y = bf_hi(kr.z) * w1.y; k1.z = bf_lo(kr.w) * w1.z; k1.w = bf_hi(kr.w) * w1.w;
                nsum[q] += (k0.x + k0.y) + (k0.z + k0.w) + (k1.x + k1.y) + (k1.z + k1.w);
                bfk[q] = cvt8(k0, k1);
            }
#pragma unroll
            for (int a_ = 0; a_ < 4; ++a_)
#pragma unroll
                for (int b_ = 0; b_ < 4; ++b_) acc[a_][b_] = MFMA16(af[a_], bfk[b_], acc[a_][b_]);
        }
        float* cbase = CL + (size_t)u * 4096;
        const unsigned coff = (unsigned)(4 * g * 64 + col);
#pragma unroll
        for (int b_ = 0; b_ < 4; ++b_) {
#pragma unroll
            for (int a_ = 0; a_ < 4; ++a_)
#pragma unroll
                for (int r = 0; r < 4; ++r) cbase[(a_ * 16 * 64 + r * 64 + b_ * 16) + coff] = acc[a_][b_][r];
            float ns = nsum[b_]; ns += SHX(ns, 16, lane); ns += SHX(ns, 32, lane);
            if (g == 0) NLb[(size_t)u * 64 + b_ * 16 + col] = ns;
        }
    }
    __syncthreads();
}

__device__ __forceinline__ void phase_mlstm_carry(const Params& P, int l, unsigned char* smem, int wv) {
    ParamsPtr pp = PARAMS_PTR(P); PIN_S(pp); unsigned char* ws = pp->ws; int bidx = (int)blockIdx.x, gdim = (int)gridDim.x; PIN_S(bidx); PIN_S(gdim);
    float* CL = (float*)(ws + O_CL); float* NLb = (float*)(ws + O_NL); const float* ML = (const float*)(ws + O_ML); const float* BL = (const float*)(ws + O_BL);
    float* MIN = (float*)(ws + O_MIN);
    const int total = 2 * NB * MH * 4160;
    const int tid = phase_tid(wv);
    for (int gi = bidx * NTHREADS + tid; gi < total; gi += gdim * NTHREADS) {
        const int ph = gi / 4160, e = gi % 4160;
        float* base_ = e < 4096 ? CL + (size_t)ph * NCH * 4096 + e : NLb + (size_t)ph * NCH * 64 + (e - 4096);
        const int stride = e < 4096 ? 4096 : 64;
        static_assert(NCH <= 32, "carry scan keeps one chunk value per register");
        float loc[NCH], bl[NCH], ml[NCH];
#pragma unroll
        for (int c = 0; c < NCH; ++c) { loc[c] = base_[(size_t)c * stride]; bl[c] = BL[ph * NCH + c]; ml[c] = ML[ph * NCH + c]; }
        float m = 0.f, val = 0.f;
#pragma unroll
        for (int c = 0; c < NCH; ++c) {
            base_[(size_t)c * stride] = val;
            if (e == 0) MIN[ph * NCH + c] = m;
            const float mn = fmaxf(bl[c] + m, ml[c]);
            val = fexp(bl[c] + m - mn) * val + fexp(ml[c] - mn) * loc[c];
            m = mn;
        }
    }
}

__device__ __forceinline__ void phase_mlstm_out(const Params& P, int l, unsigned char* smem, int wv) {
    ParamsPtr pp = PARAMS_PTR(P); PIN_S(pp); unsigned char* ws = pp->ws; int bidx = (int)blockIdx.x, gdim = (int)gridDim.x; PIN_S(bidx); PIN_S(gdim);
    const bf16_t* proj = (const bf16_t*)(ws + O_PROJ);
    const bf16_t* MQB = (const bf16_t*)(ws + O_MQB); const bf16_t* MKB = (const bf16_t*)(ws + O_MKB); const bf16_t* VT = (const bf16_t*)(ws + O_VT);
    const float* GVT = (const float*)(ws + O_GVT); const float* PMX = (const float*)(ws + O_PMX); const float* BCT = (const float*)(ws + O_BCT);
    const float* CL = (const float*)(ws + O_CL); const float* NLb = (const float*)(ws + O_NL); const float* MIN = (const float*)(ws + O_MIN);
    bf16_t* GRP = (bf16_t*)(ws + O_GRP);
    const float* mln_g = pp->in[20] + (size_t)l * MW;
    const int tid = phase_tid(wv), lane = tid & 63, wave = tid >> 6, col = lane & 15, g = lane >> 4;
    constexpr int KP = 72, VP = 136;
    bf16_t* Ks = (bf16_t*)smem;
    bf16_t* Vs = Ks + 128 * KP;
    float* gvs_ = (float*)(Vs + 64 * VP);
    for (int u = bidx; u < NB * MH * NCH; u += gdim) {
        const int tc = u % NCH, h = (u / NCH) % MH, b = u / (NCH * MH);
        const int tok0 = b * S + tc * CH, it = wave * 16 + col;
        __syncthreads();
        {
            u32x4 kb_[2], vb_[2];
#pragma unroll
            for (int q = 0; q < 2; ++q) {
                const int idx = tid + q * NTHREADS;
                kb_[q] = *(const u32x4*)(MKB + (size_t)(tok0 + (idx >> 3)) * MW + h * 64 + (idx & 7) * 8);
                vb_[q] = *(const u32x4*)(VT + ((size_t)(b * MH + h) * 64 + (idx >> 4)) * S + (size_t)tc * CH + (idx & 15) * 8);
            }
            float gq_ = 0.f;
            if (tid < 256) gq_ = GVT[((size_t)(tid >> 7) * T + tok0 + (tid & 127)) * MH + h];
#pragma unroll
            for (int q = 0; q < 2; ++q) {
                const int idx = tid + q * NTHREADS;
                *(u32x4*)(Ks + (idx >> 3) * KP + (idx & 7) * 8) = kb_[q];
                *(u32x4*)(Vs + (idx >> 4) * VP + (idx & 15) * 8) = vb_[q];
            }
            if (tid < 256) gvs_[tid] = gq_;
        }
        __syncthreads();
        const size_t trow = (size_t)(tok0 + it);
        bf16x8 bq[2];
#pragma unroll
        for (int ks = 0; ks < 2; ++ks) bq[ks] = *(const bf16x8*)(MQB + trow * MW + h * 64 + ks * 32 + 8 * g);
        f32x4 hs[4];
#pragma unroll
        for (int et = 0; et < 4; ++et) hs[et] = (f32x4){0.f, 0.f, 0.f, 0.f};
#pragma unroll
        for (int d = 0; d < 2; ++d) {
            const int cd = d ? NCH - 1 - tc : tc;
            const int su = ((d * NB + b) * MH + h) * NCH + cd;
            const size_t gt = ((size_t)d * T + trow) * MH + h;
            const float mst = MIN[su];
            const float mxt = fmaxf(PMX[gt], mst), mt = BCT[gt] + mxt, wint = fexp(mst - mxt);
            f32x4 num[4];
#pragma unroll
            for (int et = 0; et < 4; ++et) num[et] = (f32x4){0.f, 0.f, 0.f, 0.f};
            float den = 0.f;
            for (int sp = 0; sp < 4; ++sp) {
                if (d == 0 ? (2 * sp > wave) : (2 * sp + 1 < wave)) continue;
                float pw[8];
#pragma unroll
                for (int hf = 0; hf < 2; ++hf) {
                    const int st = 2 * sp + hf;
                    f32x4 sacc = (f32x4){0.f, 0.f, 0.f, 0.f};
#pragma unroll
                    for (int ks = 0; ks < 2; ++ks) sacc = MFMA16(*(const bf16x8*)(Ks + (st * 16 + col) * KP + ks * 32 + 8 * g), bq[ks], sacc);
                    const f32x4 g4 = *(const f32x4*)(gvs_ + d * 128 + st * 16 + 4 * g);
#pragma unroll
                    for (int r = 0; r < 4; ++r) {
                        const int is = st * 16 + 4 * g + r;
                        const bool ok = d == 0 ? (is <= it) : (is >= it);
                        const float pr = ok ? sacc[r] * fexp(g4[r] - mxt) : 0.f;
                        den += pr; pw[hf * 4 + r] = pr;
                    }
                }
                u32x4 pb; pb.x = pk2(pw[0], pw[1]); pb.y = pk2(pw[2], pw[3]); pb.z = pk2(pw[4], pw[5]); pb.w = pk2(pw[6], pw[7]);
                const bf16x8 bp = __builtin_bit_cast(bf16x8, pb);
#pragma unroll
                for (int et = 0; et < 4; ++et) {
                    const bf16_t* vp = Vs + (et * 16 + col) * VP + sp * 32 + 4 * g;
                    const u32x2 v0 = *(const u32x2*)vp, v1 = *(const u32x2*)(vp + 16);
                    u32x4 va; va.x = v0.x; va.y = v0.y; va.z = v1.x; va.w = v1.y;
                    num[et] = MFMA16(__builtin_bit_cast(bf16x8, va), bp, num[et]);
                }
            }
            den += SHX(den, 16, lane); den += SHX(den, 32, lane);
            f32x4 qc[4]; float qn = 0.f;
#pragma unroll
            for (int ks = 0; ks < 2; ++ks) {
                const float* np = NLb + (size_t)su * 64 + ks * 32 + 8 * g;
                const f32x4 n0 = *(const f32x4*)np, n1 = *(const f32x4*)(np + 4);
                const u32x4 qb = __builtin_bit_cast(u32x4, bq[ks]);
                qn += (bf_lo(qb.x) * n0.x + bf_hi(qb.x) * n0.y) + (bf_lo(qb.y) * n0.z + bf_hi(qb.y) * n0.w) + (bf_lo(qb.z) * n1.x + bf_hi(qb.z) * n1.y) + (bf_lo(qb.w) * n1.z + bf_hi(qb.w) * n1.w);
            }
            qn += SHX(qn, 16, lane); qn += SHX(qn, 32, lane);
#pragma unroll
            for (int et = 0; et < 4; ++et) {
                qc[et] = (f32x4){0.f, 0.f, 0.f, 0.f};
#pragma unroll
                for (int ks = 0; ks < 2; ++ks) {
                    const float* cp = CL + (size_t)su * 4096 + (size_t)(et * 16 + col) * 64 + ks * 32 + 8 * g;
                    qc[et] = MFMA16(cvt8(*(const f32x4*)cp, *(const f32x4*)(cp + 4)), bq[ks], qc[et]);
                }
            }
            const float dd = frcp(fmaxf(fabsf(den + wint * qn), fexp(-mt)));
#pragma unroll
            for (int et = 0; et < 4; ++et) hs[et] += (num[et] + wint * qc[et]) * dd;
        }
        float sm = 0.f;
#pragma unroll
        for (int et = 0; et < 4; ++et) sm += (hs[et].x + hs[et].y) + (hs[et].z + hs[et].w);
        sm += SHX(sm, 16, lane); sm += SHX(sm, 32, lane);
        const float mean = sm * (1.0f / 64.0f); float q = 0.f;
#pragma unroll
        for (int et = 0; et < 4; ++et) { const f32x4 dl = hs[et] - mean; q += (dl.x * dl.x + dl.y * dl.y) + (dl.z * dl.z + dl.w * dl.w); }
        q += SHX(q, 16, lane); q += SHX(q, 32, lane);
        const float rstd = 1.0f / sqrtf(q * (1.0f / 64.0f) + LN_EPS);
#pragma unroll
        for (int et = 0; et < 4; ++et) {
            const int c = h * 64 + et * 16 + 4 * g;
            const u32x2 ob_ = *(const u32x2*)(proj + trow * PLD + C_MW + 3 * MW + c); const f32x4 o4 = (f32x4){bf_lo(ob_.x), bf_hi(ob_.x), bf_lo(ob_.y), bf_hi(ob_.y)}, g4 = *(const f32x4*)(mln_g + c);
            const f32x4 y = (hs[et] - mean) * rstd * g4;
            u32x2 ob; ob.x = pk2(sigmoidf_(o4.x) * y.x, sigmoidf_(o4.y) * y.y); ob.y = pk2(sigmoidf_(o4.z) * y.z, sigmoidf_(o4.w) * y.w);
            *(u32x2*)(GRP + trow * D + GW + RW + c) = ob;
        }
    }
    __syncthreads();
}

__device__ __forceinline__ void phase_rwkv_post(const Params& P, int l, unsigned char* smem, int wv) {
    ParamsPtr pp = PARAMS_PTR(P); PIN_S(pp); unsigned char* ws = pp->ws; int bidx = (int)blockIdx.x, gdim = (int)gridDim.x; PIN_S(bidx); PIN_S(gdim);
    const float* SCAN = (const float*)(ws + O_SCAN); const float* VV = (const float*)(ws + O_VV); const float* GATE = (const float*)(ws + O_GATE);
    const float* BONUS = (const float*)(ws + O_BONUS); bf16_t* GRP = (bf16_t*)(ws + O_GRP);
    const float* rln_g = pp->in[15] + (size_t)l * RW; const float* rln_b = pp->in[16] + (size_t)l * RW;
    const int tid = phase_tid(wv), lane = tid & 63, wave = tid >> 6;
    const int gw = bidx * NWAVES + wave, ngw = NWAVES * gdim;
    for (int it = gw; it < T * RH; it += ngw) {
        const int t = it / RH, h = it % RH, c = h * 64 + lane;
        const size_t o = (size_t)t * RW + c;
        const float x = SCAN[o] + SCAN[(size_t)T * RW + o];
        const float mean = wave_sum(x, lane) * (1.0f / 64.0f);
        const float dl = x - mean;
        const float var = wave_sum(dl * dl, lane) * (1.0f / 64.0f);
        float y = dl / sqrtf(var + GN_EPS) * rln_g[c] + rln_b[c];
        y += BONUS[(size_t)t * RH + h] * VV[o];
        GRP[(size_t)t * D + GW + c] = (bf16_t)f2bf(y * GATE[o]);
    }
}

__device__ __forceinline__ void phase_ln1_router(const Params& P, int l, unsigned char* smem, int wv) {
    ParamsPtr pp = PARAMS_PTR(P); PIN_S(pp); unsigned char* ws = pp->ws; int bidx = (int)blockIdx.x, gdim = (int)gridDim.x; PIN_S(bidx); PIN_S(gdim);
    const float* xin = l == 0 ? pp->in[0] : (const float*)(ws + O_XA);
    const bf16_t* MIX = (const bf16_t*)(ws + O_MIX); float* X1 = (float*)(ws + O_X1);
    int* TOPI = (int*)(ws + O_TOPI); float* TOPG = (float*)(ws + O_TOPG); int* RANK = (int*)(ws + O_RANK); bf16_t* X1B = (bf16_t*)(ws + O_X1B);
    int* BCNT = (int*)(ws + O_BCNT);
    const float* g1 = pp->in[22] + (size_t)l * D; const float* b1 = pp->in[23] + (size_t)l * D;
    const float* rw = pp->in[24] + (size_t)l * D * NE; const float* rb = pp->in[25] + (size_t)l * NE;
    const bf16_t* RWT = (const bf16_t*)(ws + O_RWT) + (size_t)l * 2 * NE * D;
    const int tid = phase_tid(wv), lane = tid & 63, wave = tid >> 6, col = lane & 15, g = lane >> 4;
    float* lgs = (float*)smem;
    int* stopi = (int*)(smem + 8192);
    for (int tile = bidx; tile < T / 64; tile += gdim) {
        __syncthreads();
        {
            f32x4 xa[4]; u32x2 xm[4];
#define LN1_LOAD(tt_) do { _Pragma("unroll") for (int j = 0; j < 4; ++j) { const int c = j * 256 + lane * 4; xa[j] = *(const f32x4*)(xin + (size_t)(tt_) * D + c); xm[j] = *(const u32x2*)(MIX + (size_t)(tt_) * D + c); } } while (0)
            LN1_LOAD(tile * 64 + wave * 8);
#pragma unroll 1
            for (int ti8 = 0; ti8 < 8; ++ti8) {
                const int t = tile * 64 + wave * 8 + ti8;
                float v[16]; float sm = 0.f;
#pragma unroll
                for (int j = 0; j < 4; ++j) {
                    v[j * 4 + 0] = ALPHA * xa[j].x + bf_lo(xm[j].x); v[j * 4 + 1] = ALPHA * xa[j].y + bf_hi(xm[j].x); v[j * 4 + 2] = ALPHA * xa[j].z + bf_lo(xm[j].y); v[j * 4 + 3] = ALPHA * xa[j].w + bf_hi(xm[j].y);
                    sm += (v[j * 4] + v[j * 4 + 1]) + (v[j * 4 + 2] + v[j * 4 + 3]);
                }
                if (ti8 < 7) LN1_LOAD(t + 1);
                const float mean = wave_sum_fast(sm, lane) * (1.0f / D); float q = 0.f;
#pragma unroll
                for (int j = 0; j < 16; ++j) { const float dl = v[j] - mean; q += dl * dl; }
                const float rstd = 1.0f / sqrtf(wave_sum_fast(q, lane) * (1.0f / D) + LN_EPS);
#pragma unroll
                for (int j = 0; j < 4; ++j) {
                    const int c = j * 256 + lane * 4;
                    const f32x4 gg = *(const f32x4*)(g1 + c), bb = *(const f32x4*)(b1 + c);
                    f32x4 o;
                    o.x = (v[j * 4 + 0] - mean) * rstd * gg.x + bb.x; o.y = (v[j * 4 + 1] - mean) * rstd * gg.y + bb.y;
                    o.z = (v[j * 4 + 2] - mean) * rstd * gg.z + bb.z; o.w = (v[j * 4 + 3] - mean) * rstd * gg.w + bb.w;
                    *(f32x4*)(X1 + (size_t)t * D + c) = o;
                    u32x2 ob; ob.x = pk2(o.x, o.y); ob.y = pk2(o.z, o.w); *(u32x2*)(X1B + (size_t)t * D + c) = ob;
                }
            }
#undef LN1_LOAD
        }
        __syncthreads();
        {
            const float* xr = X1 + (size_t)(tile * 64 + (wave >> 1) * 16 + col) * D + 8 * g;
            const bf16_t* wh = RWT + (size_t)((wave & 1) * 16 + col) * D + 8 * g; const bf16_t* wl = wh + (size_t)NE * D;
            f32x4 acc = (f32x4){0.f, 0.f, 0.f, 0.f};
#pragma unroll 4
            for (int ks = 0; ks < 32; ++ks) {
                const f32x4 x0 = *(const f32x4*)(xr + ks * 32), x1 = *(const f32x4*)(xr + ks * 32 + 4);
                const bf16x8 bh = *(const bf16x8*)(wh + ks * 32), bl = *(const bf16x8*)(wl + ks * 32);
                const bf16x8 ah = cvt8(x0, x1);
                const u32x4 ahu = __builtin_bit_cast(u32x4, ah);
                f32x4 r0, r1;
                r0.x = x0.x - bf_lo(ahu.x); r0.y = x0.y - bf_hi(ahu.x); r0.z = x0.z - bf_lo(ahu.y); r0.w = x0.w - bf_hi(ahu.y);
                r1.x = x1.x - bf_lo(ahu.z); r1.y = x1.y - bf_hi(ahu.z); r1.z = x1.z - bf_lo(ahu.w); r1.w = x1.w - bf_hi(ahu.w);
                const bf16x8 al = cvt8(r0, r1);
                acc = MFMA16(ah, bh, acc); acc = MFMA16(ah, bl, acc); acc = MFMA16(al, bh, acc);
            }
            const float rbv = rb[(wave & 1) * 16 + col];
#pragma unroll
            for (int r = 0; r < 4; ++r) lgs[((wave >> 1) * 16 + 4 * g + r) * NE + (wave & 1) * 16 + col] = acc[r] + rbv;
        }
        __syncthreads();
        if (tid < 64) {
            const float* lp = lgs + tid * NE; const int t = tile * 64 + tid;
            float tv[4]; int ti[4];
#pragma unroll
            for (int k = 0; k < 4; ++k) { tv[k] = -INFINITY; ti[k] = 0; }
            for (int e = 0; e < NE; ++e) {
                const float x = lp[e];
                if (x > tv[3]) {
                    if (x > tv[0]) { tv[3] = tv[2]; ti[3] = ti[2]; tv[2] = tv[1]; ti[2] = ti[1]; tv[1] = tv[0]; ti[1] = ti[0]; tv[0] = x; ti[0] = e; }
                    else if (x > tv[1]) { tv[3] = tv[2]; ti[3] = ti[2]; tv[2] = tv[1]; ti[2] = ti[1]; tv[1] = x; ti[1] = e; }
                    else if (x > tv[2]) { tv[3] = tv[2]; ti[3] = ti[2]; tv[2] = x; ti[2] = e; }
                    else { tv[3] = x; ti[3] = e; }
                }
            }
            const float e1 = expf(tv[1] - tv[0]), e2 = expf(tv[2] - tv[0]), e3 = expf(tv[3] - tv[0]);
            const float inv = 1.0f / (1.0f + e1 + e2 + e3);
            *(f32x4*)(TOPG + (size_t)t * 4) = (f32x4){inv, e1 * inv, e2 * inv, e3 * inv};
#pragma unroll
            for (int k = 0; k < 4; ++k) { TOPI[(size_t)t * 4 + k] = ti[k]; stopi[tid * 4 + k] = ti[k]; }
        }
        __syncthreads();
        if (tid < 256) { const int e = stopi[tid]; int r = 0; for (int a2 = 0; a2 < tid; ++a2) r += (stopi[a2] == e) ? 1 : 0; RANK[(size_t)tile * 256 + tid] = r; }
        else if (tid < 256 + NE) { const int e = tid - 256; int cnt = 0; for (int a2 = 0; a2 < 256; ++a2) cnt += (stopi[a2] == e) ? 1 : 0; BCNT[tile * NE + e] = cnt; }
    }
    __syncthreads();
}

__device__ __forceinline__ void moe_offsets(int* sh, const int* CNT, int tid) {
    if (tid == 0) {
        int acc = 0;
        for (int e = 0; e < NE; ++e) { const int c = (int)CNT[e]; sh[e] = c; sh[32 + e] = acc; acc += (c + MOEB - 1) / MOEB * MOEB; sh[64 + e] = acc; }
    }
    __syncthreads();
}
__device__ __forceinline__ int moe_expert_of_row(const int* sh, int r) {
    int e = -1;
    for (int i = 0; i < NE; ++i) if (r >= sh[32 + i] && r < sh[64 + i]) e = i;
    return e;
}

__device__ __forceinline__ void phase_scatter(const Params& P, int l, unsigned char* smem, int wv) {
    ParamsPtr pp = PARAMS_PTR(P); PIN_S(pp); unsigned char* ws = pp->ws; int bidx = (int)blockIdx.x, gdim = (int)gridDim.x; PIN_S(bidx); PIN_S(gdim);
    const int tid = phase_tid(wv);
    const int* TOPI = (const int*)(ws + O_TOPI); const int* RANK = (const int*)(ws + O_RANK); int* SLOT = (int*)(ws + O_SLOT); int* ROWT = (int*)(ws + O_ROWT);
    const int* BCNT = (const int*)(ws + O_BCNT); int* CNTF = (int*)(ws + O_CNTF);
    int* sh = (int*)smem;
    int* part = sh + 96;
    int* tot = part + 512;
    int* base = tot + 32;
    constexpr int NT = T / 64;
    const int e = tid & 31, pt = tid >> 5;
    { int sacc = 0; for (int tl = pt; tl < NT; tl += 16) sacc += BCNT[tl * NE + e]; part[pt * 32 + e] = sacc; }
    __syncthreads();
    if (tid < 32) { int sacc = 0; for (int q = 0; q < 16; ++q) sacc += part[q * 32 + tid]; tot[tid] = sacc; if (bidx == 0) CNTF[tid] = sacc; }
    __syncthreads();
    moe_offsets(sh, tot, tid);
    for (int ee = bidx; ee < NE; ee += gdim)
        for (int r = sh[32 + ee] + sh[ee] + tid; r < sh[64 + ee]; r += NTHREADS) ROWT[r] = 0;
    for (int tile = bidx; tile < NT; tile += gdim) {
        __syncthreads();
        { int sacc = 0; for (int tl = pt; tl < tile; tl += 16) sacc += BCNT[tl * NE + e]; part[pt * 32 + e] = sacc; }
        __syncthreads();
        if (tid < 32) { int sacc = sh[32 + tid]; for (int q = 0; q < 16; ++q) sacc += part[q * 32 + tid]; base[tid] = sacc; }
        __syncthreads();
        if (tid < 256) { const int a = tile * 256 + tid, dest = base[TOPI[a]] + RANK[a]; SLOT[a] = dest; ROWT[dest] = a >> 2; }
    }
    __syncthreads();
}

template <int WHICH>
__device__ __forceinline__ void phase_moe_gemm(const Params& P, int l, unsigned char* smem, int wv) {
    ParamsPtr pp = PARAMS_PTR(P); PIN_S(pp); unsigned char* ws = pp->ws; int bidx = (int)blockIdx.x, gdim = (int)gridDim.x; PIN_S(bidx); PIN_S(gdim);
    const int tid = phase_tid(wv);
    const int* CNT = (const int*)(ws + O_CNTF);
    int* sh = (int*)(smem + 131072);
    int* rbe = sh + 96;
    moe_offsets(sh, CNT, tid);
    const int nrb = sh[64 + NE - 1] / MOEB;
    for (int rb = tid; rb < nrb; rb += NTHREADS) rbe[rb] = moe_expert_of_row(sh, rb * MOEB);
    __syncthreads();
    pg8::MoeOrderT<WHICH == 1> S;
    S.K = 1024; S.G_ = gdim; S.c = bidx; S.rbe = rbe; S.rowmap = (const int*)(ws + O_ROWT);
    if (WHICH == 1) {
        S.A = (const char*)(ws + O_X1B); S.Wt = (const char*)(ws + O_W1) + (size_t)l * NE * 2 * DFF * D * 2; S.estride = (size_t)2 * DFF * D * 2; S.nN = 2 * DFF / 256; S.nwg = nrb * S.nN;
        pg8::EpiSwiglu E{(bf16_t*)(ws + O_ACT), pp->in[27] + (size_t)l * NE * 2 * DFF};
        pg8::gemm_phase<pg8::EpiSwiglu, pg8::MoeOrderT<WHICH == 1>>((LAS unsigned char*)smem, 1024, S, E, tid);
    } else {
        S.A = (const char*)(ws + O_ACT); S.Wt = (const char*)(ws + O_W2) + (size_t)l * NE * D * DFF * 2; S.estride = (size_t)D * DFF * 2; S.nN = D / 256; S.nwg = nrb * S.nN;
        pg8::EpiBf16Bias E{(bf16_t*)(ws + O_YS), D, pp->in[29] + (size_t)l * NE * D, D};
        pg8::gemm_phase<pg8::EpiBf16Bias, pg8::MoeOrderT<WHICH == 1>>((LAS unsigned char*)smem, 1024, S, E, tid);
    }
    __syncthreads();
}

__device__ __forceinline__ void phase_combine_ln2(const Params& P, int l, unsigned char* smem, int wv) {
    ParamsPtr pp = PARAMS_PTR(P); PIN_S(pp); unsigned char* ws = pp->ws; int bidx = (int)blockIdx.x, gdim = (int)gridDim.x; PIN_S(bidx); PIN_S(gdim);
    const float* X1 = (const float*)(ws + O_X1); const bf16_t* YS = (const bf16_t*)(ws + O_YS); bf16_t* XB = (bf16_t*)(ws + O_XB);
    const int* SLOT = (const int*)(ws + O_SLOT); const float* TOPG = (const float*)(ws + O_TOPG);
    float* xo = l == NL - 1 ? pp->out : (float*)(ws + O_XA);
    const float* g2 = pp->in[30] + (size_t)l * D; const float* b2 = pp->in[31] + (size_t)l * D;
    const int tid = phase_tid(wv), lane = tid & 63, wave = tid >> 6;
    const int gw = bidx * NWAVES + wave, ngw = NWAVES * gdim;
    u32x4 sl_n = (u32x4){0u, 0u, 0u, 0u}; f32x4 gg_n = (f32x4){0.f, 0.f, 0.f, 0.f};
    f32x4 xa_n[4]; u32x2 ys_n[4][4]; f32x4 gg_c = (f32x4){0.f, 0.f, 0.f, 0.f};
    const f32x4 lg[4] = {*(const f32x4*)(g2 + lane * 4), *(const f32x4*)(g2 + 256 + lane * 4), *(const f32x4*)(g2 + 512 + lane * 4), *(const f32x4*)(g2 + 768 + lane * 4)};
    const f32x4 lb[4] = {*(const f32x4*)(b2 + lane * 4), *(const f32x4*)(b2 + 256 + lane * 4), *(const f32x4*)(b2 + 512 + lane * 4), *(const f32x4*)(b2 + 768 + lane * 4)};
#define CB_META(tt_) do { sl_n = *(const u32x4*)(SLOT + (size_t)(tt_) * 4); gg_n = *(const f32x4*)(TOPG + (size_t)(tt_) * 4); } while (0)
#define CB_ROWS(tt_) do { _Pragma("unroll") for (int j = 0; j < 4; ++j) { const int c = j * 256 + lane * 4; xa_n[j] = *(const f32x4*)(X1 + (size_t)(tt_) * D + c); \
        ys_n[0][j] = *(const u32x2*)(YS + (size_t)sl_n.x * D + c); ys_n[1][j] = *(const u32x2*)(YS + (size_t)sl_n.y * D + c); ys_n[2][j] = *(const u32x2*)(YS + (size_t)sl_n.z * D + c); ys_n[3][j] = *(const u32x2*)(YS + (size_t)sl_n.w * D + c); } gg_c = gg_n; } while (0)
    if (gw < T) { CB_META(gw); CB_ROWS(gw); if (gw + ngw < T) CB_META(gw + ngw); }
    for (int t = gw; t < T; t += ngw) {
        float v[16]; float sm = 0.f;
        const float gk[4] = {gg_c.x, gg_c.y, gg_c.z, gg_c.w};
#pragma unroll
        for (int j = 0; j < 4; ++j) {
            const f32x4 a = xa_n[j];
            f32x4 y = (f32x4){0.f, 0.f, 0.f, 0.f};
#pragma unroll
            for (int k = 0; k < 4; ++k) { const u32x2 yk = ys_n[k][j]; y.x += gk[k] * bf_lo(yk.x); y.y += gk[k] * bf_hi(yk.x); y.z += gk[k] * bf_lo(yk.y); y.w += gk[k] * bf_hi(yk.y); }
            v[j * 4 + 0] = ALPHA * a.x + y.x; v[j * 4 + 1] = ALPHA * a.y + y.y; v[j * 4 + 2] = ALPHA * a.z + y.z; v[j * 4 + 3] = ALPHA * a.w + y.w;
            sm += (v[j * 4] + v[j * 4 + 1]) + (v[j * 4 + 2] + v[j * 4 + 3]);
        }
        if (t + ngw < T) { CB_ROWS(t + ngw); if (t + 2 * ngw < T) CB_META(t + 2 * ngw); }
        const float mean = wave_sum_fast(sm, lane) * (1.0f / D); float q = 0.f;
#pragma unroll
        for (int j = 0; j < 16; ++j) { const float dl = v[j] - mean; q += dl * dl; }
        const float rstd = 1.0f / sqrtf(wave_sum_fast(q, lane) * (1.0f / D) + LN_EPS);
#pragma unroll
        for (int j = 0; j < 4; ++j) {
            const int c = j * 256 + lane * 4;
            f32x4 o;
            o.x = (v[j * 4 + 0] - mean) * rstd * lg[j].x + lb[j].x; o.y = (v[j * 4 + 1] - mean) * rstd * lg[j].y + lb[j].y;
            o.z = (v[j * 4 + 2] - mean) * rstd * lg[j].z + lb[j].z; o.w = (v[j * 4 + 3] - mean) * rstd * lg[j].w + lb[j].w;
            *(f32x4*)(xo + (size_t)t * D + c) = o;
            if (l != NL - 1) { u32x2 ob; ob.x = pk2(o.x, o.y); ob.y = pk2(o.z, o.w); *(u32x2*)(XB + (size_t)t * D + c) = ob; }
        }
    }
#undef CB_META
#undef CB_ROWS
}

__device__ __forceinline__ void phase_inproj(const Params& P, int l, unsigned char* smem, int wv) {
    ParamsPtr pp = PARAMS_PTR(P); PIN_S(pp); unsigned char* ws = pp->ws; int bidx = (int)blockIdx.x, gdim = (int)gridDim.x; PIN_S(bidx); PIN_S(gdim);
    const int tid = phase_tid(wv);
    pg8::DenseOrder S; S.init(ws + O_XB, (const bf16_t*)(ws + O_WIN) + (size_t)l * PLD * D, T, PLD, D, gdim, bidx);
    pg8::EpiProj E{(bf16_t*)(ws + O_PROJ), PLD, (float*)(ws + O_PROJG), PLD / 256 - 1};
    pg8::gemm_phase<pg8::EpiProj, pg8::DenseOrder>((LAS unsigned char*)smem, D, S, E, tid);
    __syncthreads();
}
__device__ __forceinline__ void phase_outproj(const Params& P, int l, unsigned char* smem, int wv) {
    ParamsPtr pp = PARAMS_PTR(P); PIN_S(pp); unsigned char* ws = pp->ws; int bidx = (int)blockIdx.x, gdim = (int)gridDim.x; PIN_S(bidx); PIN_S(gdim);
    const int tid = phase_tid(wv);
    pg8::DenseOrder S; S.init(ws + O_GRP, (const bf16_t*)(ws + O_WOUT) + (size_t)l * D * D, T, D, D, gdim, bidx);
    pg8::EpiProj E{(bf16_t*)(ws + O_MIX), D, nullptr, -1};
    pg8::gemm_phase<pg8::EpiProj, pg8::DenseOrder>((LAS unsigned char*)smem, D, S, E, tid);
    __syncthreads();
}

#ifndef EMU
#define XB_TMO      128
#define XB_XCNT(j)  (256  + 64 * (j))
#define XB_XSUB(j)  (1280 + 64 * (j))
#define XB_XGEN(j)  (2304 + 64 * (j))
#define XB_TOP      3328
#define XB_TOPGEN   3392
#define XCD_BAR_WORDS 3456
#define XB_SPIN_CAP (1u << 25)
__device__ __forceinline__ unsigned xb_ld(unsigned* p)              { return __hip_atomic_load(p, __ATOMIC_RELAXED, __HIP_MEMORY_SCOPE_AGENT); }
__device__ __forceinline__ unsigned xb_add(unsigned* p, unsigned v) { return __hip_atomic_fetch_add(p, v, __ATOMIC_RELAXED, __HIP_MEMORY_SCOPE_AGENT); }
__device__ __forceinline__ unsigned xb_xcc_id() { return (unsigned)__builtin_amdgcn_s_getreg((3 << 11) | 20) & 0xFu; }
#define XB_SPIN(cond, bar) do { unsigned _sp = 0; while (cond) { __builtin_amdgcn_s_sleep(1); \
    if ((++_sp & 255u) == 0u) { if (xb_ld(&(bar)[XB_TMO])) break; if (_sp > XB_SPIN_CAP) { atomicAdd(&(bar)[XB_TMO], 1u); break; } } } } while (0)
struct XcdBarrier { unsigned* bar; unsigned x; volatile LAS unsigned* st; };
__device__ __forceinline__ XcdBarrier xcd_barrier_post(unsigned* bar, volatile LAS unsigned* st) {
    XcdBarrier b; b.bar = bar; b.x = xb_xcc_id(); b.st = st;
    if (threadIdx.x == 0) (void)xb_add(&bar[XB_XCNT(b.x)], 1u);
    return b;
}
__device__ __forceinline__ void xcd_barrier_complete(unsigned* bar, unsigned x, unsigned& nloc, unsigned& nx) {
    const unsigned G = gridDim.x * gridDim.y * gridDim.z;
    unsigned sum, cnt, mine, sp = 0u;
    for (;;) {
        sum = 0u; cnt = 0u; mine = 0u;
#pragma unroll
        for (unsigned j = 0; j < 16; ++j) { const unsigned c = xb_ld(&bar[XB_XCNT(j)]); sum += c; cnt += (c > 0u) ? 1u : 0u; mine = (j == x) ? c : mine; }
        if (sum == G) break;
        __builtin_amdgcn_s_sleep(1);
        if ((++sp & 255u) == 0u) { if (xb_ld(&bar[XB_TMO])) break; if (sp > XB_SPIN_CAP) { atomicAdd(&bar[XB_TMO], 1u); break; } }
    }
    nloc = mine > 0u ? mine : 1u; nx = cnt > 0u ? cnt : 1u;
}
__device__ __forceinline__ void xcd_barrier(const XcdBarrier& b) {
    asm volatile("s_waitcnt vmcnt(0)" ::: "memory");
    __syncthreads();
    if (threadIdx.x == 0) {
        unsigned* bar = b.bar;
        __builtin_amdgcn_s_waitcnt(0);
        unsigned nloc = b.st[0], nx = b.st[1];
        if (nloc == 0u) { xcd_barrier_complete(bar, b.x, nloc, nx); b.st[0] = nloc; b.st[1] = nx; }
        const unsigned old = xb_add(&bar[XB_XSUB(b.x)], 1u);
        const unsigned gen = old / nloc;
        if (old + 1u == (gen + 1u) * nloc) {
            __builtin_amdgcn_fence(__ATOMIC_RELEASE, "agent");
            asm volatile("s_waitcnt vmcnt(0)" ::: "memory");
            const unsigned og = xb_add(&bar[XB_TOP], 1u);
            const unsigned tg = og / nx;
            if (og + 1u == (tg + 1u) * nx) xb_add(&bar[XB_TOPGEN], 1u);
            else XB_SPIN(xb_ld(&bar[XB_TOPGEN]) == tg, bar);
            __builtin_amdgcn_fence(__ATOMIC_ACQUIRE, "agent");
            xb_add(&bar[XB_XGEN(b.x)], 1u);
            asm volatile("s_waitcnt vmcnt(0)" ::: "memory");
        } else {
            XB_SPIN(xb_ld(&bar[XB_XGEN(b.x)]) == gen, bar);
            __builtin_amdgcn_fence(__ATOMIC_ACQUIRE, "agent");
            asm volatile("s_waitcnt vmcnt(0)" ::: "memory");
        }
    }
    __syncthreads();
}
#endif

__global__ void __launch_bounds__(512, 2) mk_fwd(Params P) {
#ifdef EMU
    unsigned char* smem = g_blk->lds;
#else
    extern __shared__ __attribute__((aligned(16))) unsigned char smem[];
    volatile LAS unsigned* bst = (volatile LAS unsigned*)(smem + LDS_BYTES - 16);
    if (threadIdx.x == 0) { bst[0] = 0u; bst[1] = 0u; bst[2] = 0u; bst[3] = 0u; }
    __syncthreads();
    XcdBarrier bar; bar.bar = (unsigned*)P.ws + CW_BAR; bar.x = 0; bar.st = bst;
    if (P.ph_hi - P.ph_lo > 1) bar = xcd_barrier_post((unsigned*)P.ws + CW_BAR, bst);
#endif
    const int lo = P.ph_lo, hi = P.ph_hi;
#ifdef EMU
    const int wv = (int)threadIdx.x >> 6;
#else
    const int wv = RFL((int)threadIdx.x >> 6);
#endif
#ifdef EMU
#define SEAM(id) do {} while (0)
#else
#define SEAM(id) do { if ((id) + 1 < hi) xcd_barrier(bar); } while (0)
#endif
#ifndef MK_ONLY_PHASE
#define MK_ONLY_PHASE -1
#endif
#ifndef MK_DUP_MASK
#define MK_DUP_MASK 0
#endif
#define PHG(kc, id, ...) do { if (MK_ONLY_PHASE < 0 || MK_ONLY_PHASE == (kc)) { const int id_ = (id); if (id_ >= lo && id_ < hi) { if ((MK_DUP_MASK >> (kc)) & 1) { __VA_ARGS__; SEAM(id_ - 1); } __VA_ARGS__; SEAM(id_); } } } while (0)
#define PH(k, ...) PHG(1 + (k), 1 + l * NPH + (k), __VA_ARGS__)
    PHG(0, 0, phase_prologue(P, smem, wv));
    for (int l = 0; l < NL; ++l) {
        PH(0, phase_inproj(P, l, smem, wv));
        PH(1, phase_prep(P, l, smem, wv));
#if MK_RWKV_CHUNKED
        PH(2, { phase_rwkv_pre(P, l, smem, wv); phase_mlstm_local(P, l, smem, wv, (int)blockIdx.x, (int)gridDim.x); });
        PH(3, { phase_rwkv_seq(P, l, smem, wv); phase_mlstm_carry(P, l, smem, wv); });
        PH(4, { phase_rwkv_out(P, l, smem, wv); phase_mlstm_out(P, l, smem, wv); phase_gmlp_mix(P, l, smem, wv, (int)blockIdx.x, (int)gridDim.x); });
#else
        PH(2, { const int G_ = (int)gridDim.x, NSC = 2 * NB * RH * 4;
                if (G_ >= NSC + 32) { if ((int)blockIdx.x < NSC) phase_rwkv_scan(P, l, smem, wv, (int)blockIdx.x, NSC);
                                      else phase_mlstm_local(P, l, smem, wv, (int)blockIdx.x - NSC, G_ - NSC); }
                else { phase_rwkv_scan(P, l, smem, wv, (int)blockIdx.x, G_); phase_mlstm_local(P, l, smem, wv, (int)blockIdx.x, G_); } });
        PH(3, phase_mlstm_carry(P, l, smem, wv));
        PH(4, { phase_mlstm_out(P, l, smem, wv); phase_gmlp_mix(P, l, smem, wv, (int)blockIdx.x, (int)gridDim.x); phase_rwkv_post(P, l, smem, wv); });
#endif
        PH(5, phase_outproj(P, l, smem, wv));
        PH(6, phase_ln1_router(P, l, smem, wv));
        PH(7, phase_scatter(P, l, smem, wv));
        PH(8, phase_moe_gemm<1>(P, l, smem, wv));
        PH(9, phase_moe_gemm<2>(P, l, smem, wv));
        PH(10, phase_combine_ln2(P, l, smem, wv));
    }
#undef PHG
#undef PH
#undef SEAM
}

}

#ifndef EMU
extern "C" void kernel_launch(void* const* d_in, const int* in_sizes, int n_in, void* d_out, int out_size, void* d_ws, size_t ws_size, hipStream_t stream) {
    using namespace mk;
    static int grid = 0;
    if (grid == 0) {
        if (n_in != 32 || out_size != T * D || ws_size < WS_END) { fprintf(stderr, "kernel_launch: unexpected shapes (n_in %d out %d ws %zu need %zu)\n", n_in, out_size, ws_size, (size_t)WS_END); grid = -1; return; }
        int dev = 0, cus = 0;
        if (hipGetDevice(&dev) != hipSuccess || hipDeviceGetAttribute(&cus, hipDeviceAttributeMultiprocessorCount, dev) != hipSuccess) { grid = -1; return; }
        if (hipFuncSetAttribute((const void*)mk_fwd, hipFuncAttributeMaxDynamicSharedMemorySize, LDS_BYTES) != hipSuccess) { fprintf(stderr, "kernel_launch: hipFuncSetAttribute failed\n"); grid = -1; return; }
        int per_cu = 0;
        (void)hipOccupancyMaxActiveBlocksPerMultiprocessor(&per_cu, (const void*)mk_fwd, NTHREADS, LDS_BYTES);
        (void)hipGetLastError();
        grid = cus;
    }
    if (grid < 0) return;
    (void)hipMemsetAsync(d_ws, 0, CTL_BYTES, stream);
    Params p{};
    for (int i = 0; i < 32; ++i) p.in[i] = (const float*)d_in[i];
    p.out = (float*)d_out; p.ws = (unsigned char*)d_ws;
#if MK_ONE_LAUNCH
    p.ph_lo = 0; p.ph_hi = 1 + NL * NPH;
    hipLaunchKernelGGL(mk_fwd, dim3(grid), dim3(NTHREADS), LDS_BYTES, stream, p);
#else
    for (int id = 0; id < 1 + NL * NPH; ++id) {
        p.ph_lo = id; p.ph_hi = id + 1;
        hipLaunchKernelGGL(mk_fwd, dim3(grid), dim3(NTHREADS), LDS_BYTES, stream, p);
    }
#endif
}
#endif
```

```cpp
#ifndef EMU
#include <hip/hip_runtime.h>
#endif
#include <cstdio>
#include <cstdint>
#include <cmath>

#ifndef CFG_BATCH
#define CFG_BATCH 4
#endif
#ifndef CFG_SEQ
#define CFG_SEQ 4096
#endif
#ifndef CFG_LAYERS
#define CFG_LAYERS 4
#endif
#ifndef MK_RWKV_CHUNKED
#define MK_RWKV_CHUNKED 1
#endif
#ifndef MK_PROBE
#define MK_PROBE 0
#endif
#ifndef MK_ONE_LAUNCH
#define MK_ONE_LAUNCH 1
#endif

namespace mk {
constexpr int NB = CFG_BATCH, S = CFG_SEQ, T = NB * S, NL = CFG_LAYERS, D = 1024;
constexpr int GW = 256, RW = 384, MW = 384, HD = 64, GH = 4, RH = 6, MH = 6, CH = 128, NCH = S / CH;
constexpr int PIN = 3480, PLD = 3584, RPROJ = 1408;
constexpr int C_RW = 512, C_MW = 1920;
constexpr int NE = 32, TOPK = 4, DFF = 1024, MOEB = 256;
constexpr int NROWS = (T * TOPK / MOEB + NE) * MOEB;
constexpr float LN_EPS = 1e-5f, GN_EPS = 64e-5f;
constexpr float ALPHA = 1.6817928305074290f;
constexpr int NTHREADS = 512, NWAVES = 8;
constexpr int LDS_BYTES = 160 * 1024;
constexpr int NPH = 11;

typedef float f32x4 __attribute__((ext_vector_type(4)));
typedef unsigned u32x4 __attribute__((ext_vector_type(4)));
typedef unsigned u32x2 __attribute__((ext_vector_type(2)));
typedef short bf16x8 __attribute__((ext_vector_type(8)));
typedef unsigned short bf16_t;

constexpr size_t al(size_t x) { return (x + 255) & ~(size_t)255; }
constexpr size_t CTL_BYTES = 1u << 20;
constexpr size_t O_XA = CTL_BYTES;
constexpr size_t O_XB = O_XA + al((size_t)T * D * 4);
constexpr size_t O_X1 = O_XB + al((size_t)T * D * 2);
constexpr size_t O_X1B = O_X1 + al((size_t)T * D * 4);
constexpr size_t O_PROJ = O_X1B + al((size_t)T * D * 2);
constexpr size_t O_PROJG = O_PROJ + al((size_t)T * PLD * 2);
constexpr size_t O_MIX = O_PROJ + al((size_t)T * PLD * 4);
constexpr size_t O_GRP = O_MIX + al((size_t)T * D * 4);
constexpr size_t O_UG = O_GRP + al((size_t)T * D * 2);
constexpr size_t O_VN = O_UG + al((size_t)T * GW * 4);
constexpr size_t O_RR = O_VN + al((size_t)T * GW * 4);
constexpr size_t O_VV = O_RR + al((size_t)T * RW * 4);
constexpr size_t O_KK = O_VV + al((size_t)T * RW * 4);
constexpr size_t O_DEC = O_KK + al((size_t)T * RW * 4);
constexpr size_t O_KD = O_DEC + al((size_t)2 * T * RW * 4);
constexpr size_t O_ICLR = O_KD + al((size_t)2 * T * RW * 4);
constexpr size_t O_GATE = O_ICLR + al((size_t)2 * T * RW * 4);
constexpr size_t O_BONUS = O_GATE + al((size_t)T * RW * 4);
constexpr size_t O_SCAN = O_BONUS + al((size_t)T * RH * 4);
constexpr size_t O_MQ = O_SCAN + al((size_t)2 * T * RW * 4);
constexpr size_t O_MK = O_MQ + al((size_t)T * MW * 4);
constexpr size_t O_IG = O_MK + al((size_t)T * MW * 4);
constexpr size_t O_LF = O_IG + al((size_t)2 * T * MH * 4);
constexpr size_t O_CL = O_LF + al((size_t)2 * T * MH * 4);
constexpr size_t O_NL = O_CL + al((size_t)2 * NB * MH * NCH * 4096 * 4);
constexpr size_t O_ML = O_NL + al((size_t)2 * NB * MH * NCH * 64 * 4);
constexpr size_t O_BL = O_ML + al((size_t)2 * NB * MH * NCH * 4);
constexpr size_t O_MIN = O_BL + al((size_t)2 * NB * MH * NCH * 4);
constexpr size_t O_TOPI = O_MIN + al((size_t)2 * NB * MH * NCH * 4);
constexpr size_t O_TOPG = O_TOPI + al((size_t)T * 4 * 4);
constexpr size_t O_RANK = O_TOPG + al((size_t)T * 4 * 4);
constexpr size_t O_SLOT = O_RANK + al((size_t)T * 4 * 4);
constexpr size_t O_MQB = O_SLOT + al((size_t)T * 4 * 4);
constexpr size_t O_MKB = O_MQB + al((size_t)T * MW * 2);
constexpr size_t O_KT = O_MKB + al((size_t)T * MW * 2);
constexpr size_t O_VT = O_KT + al((size_t)T * MW * 2);
constexpr size_t O_GVT = O_VT + al((size_t)T * MW * 2);
constexpr size_t O_PMX = O_GVT + al((size_t)2 * T * MH * 4);
constexpr size_t O_BCT = O_PMX + al((size_t)2 * T * MH * 4);
constexpr size_t O_BRKR = O_BCT + al((size_t)2 * T * MH * 4);
constexpr int RC = 64, RNC = S / RC, RUN = 2 * NB * RH * RNC;
constexpr size_t O_LW = O_BRKR + al((size_t)2 * T * RH * 2 * 4);
constexpr size_t O_RQ = O_LW + al((size_t)2 * T * RW * 4);
constexpr size_t O_RA = O_RQ + al((size_t)RUN * 4096 * 2);
constexpr size_t O_RS = O_RA + al((size_t)RUN * 4096 * 2);
constexpr size_t O_RH = O_RS + al((size_t)RUN * 4096 * 2);
constexpr size_t O_RG = O_RH + al((size_t)RUN * 4096 * 4);
constexpr size_t O_RB = O_RG + al((size_t)RUN * 4096 * 4);
constexpr size_t O_VB = O_RB + al((size_t)T * RW * 2);
constexpr size_t O_KKB = O_VB + al((size_t)T * RW * 2);
constexpr size_t O_BBB = O_KKB + al((size_t)T * RW * 2);
constexpr size_t O_KDB = O_BBB + al((size_t)2 * T * RW * 2);
constexpr size_t O_VNT = O_KDB + al((size_t)2 * T * RW * 2);
constexpr size_t O_WSB = O_VNT + al((size_t)T * GW * 2);
constexpr size_t O_LWT = O_WSB + al((size_t)NL * GH * CH * CH * 2);
constexpr size_t O_RWT = O_LWT + al((size_t)NL * 1920 * 128 * 2);
constexpr size_t O_BCNT = O_RWT + al((size_t)NL * 2 * NE * D * 2);
constexpr size_t O_CNTF = O_BCNT + al((size_t)(T / 64) * NE * 4);
constexpr size_t O_ROWT = O_CNTF + al((size_t)NE * 4);
constexpr size_t O_XS = O_ROWT + al((size_t)NROWS * 4);
constexpr size_t O_ACT = O_XS + al((size_t)NROWS * D * 2);
constexpr size_t O_YS = O_ACT + al((size_t)NROWS * DFF * 2);
constexpr size_t O_WIN = O_YS + al((size_t)NROWS * D * 2);
constexpr size_t O_WOUT = O_WIN + al((size_t)NL * PLD * D * 2);
constexpr size_t O_W1 = O_WOUT + al((size_t)NL * D * D * 2);
constexpr size_t O_W2 = O_W1 + al((size_t)NL * NE * 2 * DFF * D * 2);
constexpr size_t WS_END = O_W2 + al((size_t)NL * NE * D * DFF * 2);

constexpr int CW_BAR = 4096;
constexpr int CW_CNT = 16384;

struct Params { const float* in[32]; float* out; unsigned char* ws; int ph_lo, ph_hi; };
#ifdef EMU
typedef const Params* ParamsPtr;
#define PARAMS_PTR(P) (&(P))
#else
typedef const __attribute__((address_space(4))) Params* ParamsPtr;
#define PARAMS_PTR(P) ((ParamsPtr)__builtin_amdgcn_kernarg_segment_ptr())
#endif

#ifdef EMU
#define WAVE_SYNC() emu_wave_barrier()
#define PIN_V(x) do {} while (0)
#define PIN_S(x) do {} while (0)
#else
#define WAVE_SYNC() __builtin_amdgcn_wave_barrier()
#define PIN_V(x) asm volatile("" : "+v"(x))
#define PIN_S(x) asm volatile("" : "+s"(x))
#endif
#ifdef EMU
__device__ __forceinline__ int phase_tid(int wv) { (void)wv; return threadIdx.x; }
#else
__device__ __forceinline__ int phase_tid(int wv) { int t; asm volatile("v_mbcnt_lo_u32_b32 %0, -1, 0\n\tv_mbcnt_hi_u32_b32 %0, -1, %0" : "=v"(t)); return (wv << 6) + t; }
#endif

#ifdef EMU
#define SHX(v, m, lane) __shfl_xor(v, m)
#else
__device__ __forceinline__ float shx_(float v, int m, int lane) { return __builtin_bit_cast(float, __builtin_amdgcn_ds_bpermute((lane ^ m) << 2, __builtin_bit_cast(int, v))); }
__device__ __forceinline__ int shx_(int v, int m, int lane) { return __builtin_amdgcn_ds_bpermute((lane ^ m) << 2, v); }
#define SHX(v, m, lane) shx_(v, m, lane)
#endif
#ifdef EMU
#define SHUP(v, o, lane) __shfl(v, ((lane) - (o)) & 63)
#define RDL(v, src) __shfl(v, src)
#define SHL(v, src) __shfl(v, src)
#else
#define SHL(v, src) __builtin_bit_cast(float, __builtin_amdgcn_ds_bpermute((src) << 2, __builtin_bit_cast(int, (float)(v))))
#define SHUP(v, o, lane) __builtin_bit_cast(float, __builtin_amdgcn_ds_bpermute((((lane) - (o)) & 63) << 2, __builtin_bit_cast(int, (float)(v))))
#define RDL(v, src) __builtin_bit_cast(float, __builtin_amdgcn_readlane(__builtin_bit_cast(int, (float)(v)), src))
#endif
__device__ __forceinline__ float wave_sum(float v, int lane) {
#pragma unroll
    for (int o = 32; o >= 1; o >>= 1) v += SHX(v, o, lane);
    return v;
}
#ifdef EMU
__device__ __forceinline__ float fexp(float x) { return expf(x); }
__device__ __forceinline__ float flog(float x) { return logf(x); }
__device__ __forceinline__ float frcp(float x) { return 1.0f / x; }
#else
__device__ __forceinline__ float fexp(float x) { return __builtin_amdgcn_exp2f(x * 1.4426950408889634f); }
__device__ __forceinline__ float flog(float x) { return __builtin_amdgcn_logf(x) * 0.6931471805599453f; }
__device__ __forceinline__ float frcp(float x) { return __builtin_amdgcn_rcpf(x); }
#endif
__device__ __forceinline__ float sigmoidf_(float x) { return frcp(1.0f + fexp(-x)); }
__device__ __forceinline__ float softplusf_(float x) { return fmaxf(x, 0.f) + flog(1.0f + fexp(-fabsf(x))); }
__device__ __forceinline__ float ftanh(float x) { return 1.0f - 2.0f * frcp(1.0f + fexp(2.0f * x)); }
__device__ __forceinline__ float geluf_(float v) {
    const float av = fabsf(v), t = frcp(1.0f + 0.2316418882f * av);
    float q = t * 0.5307027145f + (-0.7265760135f); q = q * t + 0.7107068705f; q = q * t + (-0.142248368f); q = q * t + 0.127414796f; q = q * t;
    const float m = v * (q * fexp(-0.5f * v * v));
    return v < 0.f ? m : v - m;
}

#ifdef EMU
#define LAS
#define WAIT_V(n) do {} while (0)
#define WAIT_L(n) do {} while (0)
#define S_BARRIER() __syncthreads()
#define SETPRIO(x) do {} while (0)
#define SCHED_BAR() do {} while (0)
#define RFL(x) (x)
static inline void emu_glds16(const void* g, void* l) { memcpy((char*)l + (g_blk->cur & 63) * 16, g, 16); }
#define GLDS16(gptr, ldsptr) emu_glds16((const void*)(gptr), (void*)(ldsptr))
static inline float emu_bf2f(unsigned short b) { unsigned u = (unsigned)b << 16; float f; memcpy(&f, &u, 4); return f; }
static inline f32x4 emu_mfma16(bf16x8 a, bf16x8 b, f32x4 c) {
    EmuBlock* blk = g_blk; const int cur = blk->cur, lane = cur & 63, wbase = cur & ~63;
    static thread_local unsigned short Ash[32][64][8], Bsh[32][64][8];
    const int w = cur >> 6;
    for (int j = 0; j < 8; ++j) { Ash[w][lane][j] = (unsigned short)a[j]; Bsh[w][lane][j] = (unsigned short)b[j]; }
    emu_wave_barrier();
    const int col = lane & 15;
    for (int r = 0; r < 4; ++r) { const int row = 4 * (lane >> 4) + r; float sum = c[r];
        for (int k = 0; k < 32; ++k) sum += emu_bf2f(Ash[w][row + 16 * (k >> 3)][k & 7]) * emu_bf2f(Bsh[w][col + 16 * (k >> 3)][k & 7]);
        c[r] = sum; }
    emu_wave_barrier(); (void)wbase;
    return c;
}
#define MFMA16(a, b, c) emu_mfma16(a, b, c)
#else
#define LAS __attribute__((address_space(3)))
#define WAIT_V(n) asm volatile("s_waitcnt vmcnt(" #n ")" ::: "memory")
#define WAIT_L(n) asm volatile("s_waitcnt lgkmcnt(" #n ")" ::: "memory")
#define S_BARRIER() __builtin_amdgcn_s_barrier()
#define SETPRIO(x) __builtin_amdgcn_s_setprio(x)
#define SCHED_BAR() __builtin_amdgcn_sched_barrier(0)
#define RFL(x) __builtin_amdgcn_readfirstlane(x)
#define GLDS16(gptr, ldsptr) __builtin_amdgcn_global_load_lds((const unsigned*)(gptr), (LAS unsigned*)(ldsptr), 16, 0, 0)
#define MFMA16(a, b, c) __builtin_amdgcn_mfma_f32_16x16x32_bf16(a, b, c, 0, 0, 0)
#endif

#ifdef EMU
__device__ __forceinline__ unsigned f2bf(float f) { unsigned u = __builtin_bit_cast(unsigned, f); return (u + 0x7fffu + ((u >> 16) & 1u)) >> 16; }
#else
__device__ __forceinline__ unsigned f2bf(float f) { return (unsigned)__builtin_bit_cast(unsigned short, (__bf16)f); }
#endif
#ifdef EMU
__device__ __forceinline__ unsigned pk2(float lo, float hi) { return f2bf(lo) | (f2bf(hi) << 16); }
#else
typedef float f32x2c __attribute__((ext_vector_type(2)));
typedef __bf16 bf16x2c __attribute__((ext_vector_type(2)));
__device__ __forceinline__ unsigned pk2(float lo, float hi) { const f32x2c v = {lo, hi}; return __builtin_bit_cast(unsigned, __builtin_convertvector(v, bf16x2c)); }
#endif
__device__ __forceinline__ bf16x8 cvt8(const f32x4 a, const f32x4 b) {
    u32x4 w; w.x = pk2(a.x, a.y); w.y = pk2(a.z, a.w); w.z = pk2(b.x, b.y); w.w = pk2(b.z, b.w); return __builtin_bit_cast(bf16x8, w);
}
__device__ __forceinline__ float bf_lo(unsigned u) { return __builtin_bit_cast(float, u << 16); }
__device__ __forceinline__ float bf_hi(unsigned u) { return __builtin_bit_cast(float, u & 0xffff0000u); }

namespace pg8 {
constexpr int BM = 256, BK = 64, HALF = 128, HTB = HALF * BK * 2, STAGE_BYTES = 8 * HTB, NXCD = 8, WGM = 8;
__host__ __device__ __forceinline__ int lds_byte(int r, int c) { const int st = (r >> 4) * 2 + (c >> 5), rr = r & 15, cc = c & 31, ob = rr * 64 + cc * 2; return st * 1024 + (ob ^ (((ob >> 9) & 1) << 5)); }
__host__ __device__ __forceinline__ void stage_rc(int b, int& R, int& C) { const int st = b / 1024, sb = b % 1024, swz = sb ^ (((sb >> 9) & 1) << 5); R = (st >> 1) * 16 + swz / 64; C = (st & 1) * 32 + (swz % 64) / 2; }
__host__ __device__ __forceinline__ int perm32(int rho) { const int n = rho >> 4, i = rho & 15; return 8 * (i >> 2) + 4 * n + (i & 3); }
struct Unit { int pm, pn, e; };

struct DenseOrder {
    static constexpr bool GATHER = false;
    const char* A; const char* Bt; int K; int nM, nN, nwg, G, c;
    __device__ __forceinline__ void init(const void* A_, const void* Bt_, int M, int N, int K_, int G_, int c_) { A = (const char*)A_; Bt = (const char*)Bt_; K = K_; nM = M / BM; nN = N / BM; nwg = nM * nN; G = G_; c = c_; }
    __device__ __forceinline__ bool next(int i, Unit& u) const {
        const long L = (long)i * G + c; if (L >= nwg) return false;
        int wgid = (int)L; { const int q = nwg / NXCD, r = nwg % NXCD, xcd = wgid % NXCD, off = wgid / NXCD; wgid = (xcd < r ? xcd * (q + 1) : r * (q + 1) + (xcd - r) * q) + off; }
        const int nig = WGM * nN, gid = wgid / nig, fm = gid * WGM, gsz = (nM - fm) < WGM ? (nM - fm) : WGM;
        u.pm = fm + ((wgid % nig) % gsz); u.pn = (wgid % nig) / gsz; u.e = 0; return true;
    }
    __device__ __forceinline__ const char* abase(const Unit& u) const { return A + (size_t)u.pm * BM * K * 2; }
    __device__ __forceinline__ const char* bbase(const Unit& u) const { return Bt + (size_t)u.pn * BM * K * 2; }
};
template <bool G>
struct MoeOrderT {
    static constexpr bool GATHER = G;
    const char* A; const char* Wt; int K; int nN, nwg, G_, c; size_t estride; const int* rbe; const int* rowmap;
    __device__ __forceinline__ bool next(int i, Unit& u) const {
        const long L = (long)i * G_ + c; if (L >= nwg) return false;
        u.pm = (int)(L / nN); u.pn = (int)(L % nN); u.e = rbe[u.pm]; return true;
    }
    __device__ __forceinline__ const char* abase(const Unit& u) const { return G ? A : A + (size_t)u.pm * BM * K * 2; }
    __device__ __forceinline__ const char* bbase(const Unit& u) const { return Wt + (size_t)u.e * estride + (size_t)u.pn * BM * K * 2; }
};
struct EpiF32 {
    static constexpr bool PERM = false;
    float* C; int ldc;
    __device__ __forceinline__ void operator()(const f32x4 (&acc)[2][2][4][2], const Unit& u, int wr, int wc, int fr, int fq) const {
        const int row0 = u.pm * BM + wr * 64 + fr, col0 = u.pn * BM + wc * 32 + 4 * fq;
#pragma unroll
        for (int ai = 0; ai < 2; ++ai)
#pragma unroll
            for (int m = 0; m < 4; ++m) { float* rowp = C + (size_t)(row0 + ai * HALF + m * 16) * ldc + col0;
#pragma unroll
                for (int bj = 0; bj < 2; ++bj)
#pragma unroll
                    for (int n = 0; n < 2; ++n) *(f32x4*)(rowp + bj * HALF + n * 16) = acc[ai][bj][m][n]; }
    }
};
struct EpiProj {
    static constexpr bool PERM = true;
    bf16_t* O; int ldc; float* G; int lastt;
    __device__ __forceinline__ void operator()(const f32x4 (&acc)[2][2][4][2], const Unit& u, int wr, int wc, int fr, int fq) const {
        const int row0 = u.pm * BM + wr * 64 + fr, col0 = u.pn * BM + wc * 32 + 8 * fq;
#pragma unroll
        for (int ai = 0; ai < 2; ++ai)
#pragma unroll
            for (int m = 0; m < 4; ++m) { bf16_t* rowp = O + (size_t)(row0 + ai * HALF + m * 16) * ldc + col0;
#pragma unroll
                for (int bj = 0; bj < 2; ++bj) { const f32x4 v0 = acc[ai][bj][m][0], v1 = acc[ai][bj][m][1];
                    u32x4 w; w.x = pk2(v0[0], v0[1]); w.y = pk2(v0[2], v0[3]); w.z = pk2(v1[0], v1[1]); w.w = pk2(v1[2], v1[3]);
                    *(u32x4*)(rowp + bj * HALF) = w; } }
        if (u.pn == lastt) {
#pragma unroll
            for (int ai = 0; ai < 2; ++ai)
#pragma unroll
                for (int m = 0; m < 4; ++m) { float* rowp = G + (size_t)(row0 + ai * HALF + m * 16) * BM + wc * 32 + 8 * fq;
#pragma unroll
                    for (int bj = 0; bj < 2; ++bj) { *(f32x4*)(rowp + bj * HALF) = acc[ai][bj][m][0]; *(f32x4*)(rowp + bj * HALF + 4) = acc[ai][bj][m][1]; } }
        }
    }
};
struct EpiBf16Bias {
    static constexpr bool PERM = true;
    bf16_t* O; int ldc; const float* bias; int bias_estride;
    __device__ __forceinline__ void operator()(const f32x4 (&acc)[2][2][4][2], const Unit& u, int wr, int wc, int fr, int fq) const {
        const int row0 = u.pm * BM + wr * 64 + fr, col0 = u.pn * BM + wc * 32 + 8 * fq;
        const float* bp = bias + (size_t)u.e * bias_estride + col0;
        f32x4 bv[2][2];
#pragma unroll
        for (int bj = 0; bj < 2; ++bj)
#pragma unroll
            for (int n = 0; n < 2; ++n) bv[bj][n] = *(const f32x4*)(bp + bj * HALF + 4 * n);
#pragma unroll
        for (int ai = 0; ai < 2; ++ai)
#pragma unroll
            for (int m = 0; m < 4; ++m) { bf16_t* rowp = O + (size_t)(row0 + ai * HALF + m * 16) * ldc + col0;
#pragma unroll
                for (int bj = 0; bj < 2; ++bj) { const f32x4 v0 = acc[ai][bj][m][0] + bv[bj][0], v1 = acc[ai][bj][m][1] + bv[bj][1];
                    u32x4 w; w.x = pk2(v0[0], v0[1]); w.y = pk2(v0[2], v0[3]); w.z = pk2(v1[0], v1[1]); w.w = pk2(v1[2], v1[3]);
                    *(u32x4*)(rowp + bj * HALF) = w; } }
    }
};
__device__ __forceinline__ float swiglu1(float g, float uu) { g = fminf(g, 7.0f); uu = fminf(fmaxf(uu, -7.0f), 7.0f); return (uu + 1.0f) * (g * frcp(1.0f + fexp(-1.702f * g))); }
struct EpiSwiglu {
    static constexpr bool PERM = true;
    bf16_t* O; const float* b1;
    __device__ __forceinline__ void operator()(const f32x4 (&acc)[2][2][4][2], const Unit& u, int wr, int wc, int fr, int fq) const {
        const int row0 = u.pm * BM + wr * 64 + fr, j0 = u.pn * HALF + wc * 32 + 8 * fq;
        const float* bg = b1 + (size_t)u.e * 2 * DFF + j0; const float* bu = bg + DFF;
        f32x4 g4[2], u4[2];
#pragma unroll
        for (int n = 0; n < 2; ++n) { g4[n] = *(const f32x4*)(bg + 4 * n); u4[n] = *(const f32x4*)(bu + 4 * n); }
#pragma unroll
        for (int ai = 0; ai < 2; ++ai)
#pragma unroll
            for (int m = 0; m < 4; ++m) {
                float o[8];
#pragma unroll
                for (int n = 0; n < 2; ++n)
#pragma unroll
                    for (int q = 0; q < 4; ++q) o[n * 4 + q] = swiglu1(acc[ai][0][m][n][q] + g4[n][q], acc[ai][1][m][n][q] + u4[n][q]);
                u32x4 w; w.x = pk2(o[0], o[1]); w.y = pk2(o[2], o[3]); w.z = pk2(o[4], o[5]); w.w = pk2(o[6], o[7]);
                *(u32x4*)(O + (size_t)(row0 + ai * HALF + m * 16) * DFF + j0) = w;
            }
    }
};

template <class Epi, class Sched>
__device__ __forceinline__ void gemm_phase(LAS unsigned char* lds, const int K, const Sched& S, const Epi& E, const int tid) {
    const int wid = RFL(tid >> 6), lane = tid & 63, wr = wid >> 2, wc = wid & 3, fr = lane & 15, fq = lane >> 4;
    const int nt = K / BK;
    unsigned voffA[2], voffB[2]; int gR[2]; unsigned gC[2];
#pragma unroll
    for (int i = 0; i < 2; ++i) { int R, C; stage_rc(tid * 16 + i * 8192, R, C); const int Rb = Epi::PERM ? ((R & ~31) + perm32(R & 31)) : R;
        voffA[i] = (unsigned)(R * K + C) * 2u; voffB[i] = (unsigned)(Rb * K + C) * 2u; gR[i] = R; gC[i] = (unsigned)C * 2u; }
    unsigned va[2][2], vn[2][2];
#define PG8_GOFF(dst, unit) do { if constexpr (Sched::GATHER) { _Pragma("unroll") for (int h_ = 0; h_ < 2; ++h_) _Pragma("unroll") for (int i_ = 0; i_ < 2; ++i_) \
        dst[h_][i_] = (unsigned)S.rowmap[(unit).pm * BM + h_ * HALF + gR[i_]] * (unsigned)(K * 2) + gC[i_]; } } while (0)
#define PG8_STAGE_A(bufoff, bp, kb, h, nx) do { if constexpr (Sched::GATHER) { const char* gb_ = S.A + (kb); _Pragma("unroll") for (int _i = 0; _i < 2; ++_i) \
        GLDS16(gb_ + ((nx) ? vn[h][_i] : va[h][_i]), lds + (bufoff) + ldsw + _i * 8192); } else { PG8_STAGE(bufoff, bp, voffA); } } while (0)
    const size_t kstep = (size_t)(BK * 2);
    const size_t hstep = (size_t)HALF * K * 2;
    const unsigned ldsw = (unsigned)wid * 1024u;
    const int aoff = lds_byte(wr * 64 + fr, fq * 8), boff = lds_byte(wc * 32 + fr, fq * 8);
#define PG8_SA(b, h) (((b) * 2 + (h)) * HTB)
#define PG8_SB(b, h) ((4 + (b) * 2 + (h)) * HTB)
#define PG8_STAGE(bufoff, gbase, voff) do { _Pragma("unroll") for (int _i = 0; _i < 2; ++_i) \
        GLDS16((const char*)(gbase) + (voff)[_i], lds + (bufoff) + ldsw + _i * 8192); } while (0)
#define PG8_LDA(dst, b, h) do { _Pragma("unroll") for (int m = 0; m < 4; ++m) _Pragma("unroll") for (int k = 0; k < 2; ++k) dst[m][k] = *(const LAS bf16x8*)(lds + PG8_SA(b, h) + aoff + m * 2048 + k * 1024); } while (0)
#define PG8_LDB(dst, b, h) do { _Pragma("unroll") for (int n = 0; n < 2; ++n) _Pragma("unroll") for (int k = 0; k < 2; ++k) dst[n][k] = *(const LAS bf16x8*)(lds + PG8_SB(b, h) + boff + n * 2048 + k * 1024); } while (0)
#define PG8_MMA(ai, bj, At, Bt) do { SETPRIO(1); _Pragma("unroll") for (int m = 0; m < 4; ++m) _Pragma("unroll") for (int n = 0; n < 2; ++n) _Pragma("unroll") for (int k = 0; k < 2; ++k) \
        acc[ai][bj][m][n] = MFMA16(Bt[n][k], At[m][k], acc[ai][bj][m][n]); SETPRIO(0); } while (0)
    Unit cur, nxt; int ui = 0;
    if (!S.next(0, cur)) return;
    f32x4 acc[2][2][4][2];
#pragma unroll
    for (int a = 0; a < 2; ++a)
#pragma unroll
        for (int b = 0; b < 2; ++b)
#pragma unroll
            for (int m = 0; m < 4; ++m)
#pragma unroll
                for (int n = 0; n < 2; ++n) acc[a][b][m][n] = (f32x4){0.f, 0.f, 0.f, 0.f};
    bf16x8 At[4][2], B0[2][2], B1[2][2];
    const char* cA = S.abase(cur); const char* cB = S.bbase(cur);
    PG8_GOFF(va, cur);
    PG8_STAGE(PG8_SB(0, 0), cB, voffB); PG8_STAGE_A(PG8_SA(0, 0), cA, 0, 0, false); PG8_STAGE(PG8_SB(0, 1), cB + hstep, voffB); PG8_STAGE_A(PG8_SA(0, 1), cA + hstep, 0, 1, false);
    if (wr == 1) S_BARRIER();
    WAIT_V(4); S_BARRIER();
    PG8_STAGE(PG8_SB(1, 0), cB + kstep, voffB); PG8_STAGE_A(PG8_SA(1, 0), cA + kstep, kstep, 0, false); PG8_STAGE(PG8_SB(1, 1), cB + hstep + kstep, voffB);
    WAIT_V(6); S_BARRIER();
    for (;;) {
        const bool has_next = S.next(ui + 1, nxt);
        const char* nA = has_next ? S.abase(nxt) : cA; const char* nB = has_next ? S.bbase(nxt) : cB;
        if constexpr (Sched::GATHER) { if (has_next) { PG8_GOFF(vn, nxt); } else {
#pragma unroll
            for (int h_ = 0; h_ < 2; ++h_) { vn[h_][0] = va[h_][0]; vn[h_][1] = va[h_][1]; } } }
        for (int t = 0; t < nt; t += 2) {
            const bool last = (t == nt - 2);
            const char* a1 = cA + (size_t)(t + 1) * kstep;
            const char* a2 = last ? nA : cA + (size_t)(t + 2) * kstep; const char* b2 = last ? nB : cB + (size_t)(t + 2) * kstep;
            const char* a3 = a2 + kstep; const char* b3 = b2 + kstep;
            PG8_LDB(B0, 0, 0); SCHED_BAR(); PG8_LDA(At, 0, 0); PG8_STAGE_A(PG8_SA(1, 1), a1 + hstep, (size_t)(t + 1) * kstep, 1, false);
            WAIT_L(8); S_BARRIER(); WAIT_L(0); PG8_MMA(0, 0, At, B0); S_BARRIER(); SCHED_BAR();
            PG8_LDB(B1, 0, 1); PG8_STAGE(PG8_SB(0, 0), b2, voffB);
            S_BARRIER(); WAIT_L(0); PG8_MMA(0, 1, At, B1); S_BARRIER();
            PG8_LDA(At, 0, 1); PG8_STAGE_A(PG8_SA(0, 0), a2, (last ? (size_t)0 : (size_t)(t + 2) * kstep), 0, last);
            S_BARRIER(); WAIT_L(0); PG8_MMA(1, 0, At, B0); S_BARRIER(); SCHED_BAR();
            PG8_STAGE(PG8_SB(0, 1), b2 + hstep, voffB);
            WAIT_V(6); S_BARRIER(); PG8_MMA(1, 1, At, B1); S_BARRIER();
            PG8_LDB(B0, 1, 0); SCHED_BAR(); PG8_LDA(At, 1, 0); PG8_STAGE_A(PG8_SA(0, 1), a2 + hstep, (last ? (size_t)0 : (size_t)(t + 2) * kstep), 1, last);
            WAIT_L(8); S_BARRIER(); WAIT_L(0); PG8_MMA(0, 0, At, B0); S_BARRIER(); SCHED_BAR();
            PG8_LDB(B1, 1, 1); PG8_STAGE(PG8_SB(1, 0), b3, voffB);
            S_BARRIER(); WAIT_L(0); PG8_MMA(0, 1, At, B1); S_BARRIER();
            PG8_LDA(At, 1, 1); PG8_STAGE_A(PG8_SA(1, 0), a3, (last ? kstep : (size_t)(t + 3) * kstep), 0, last);
            S_BARRIER(); WAIT_L(0); PG8_MMA(1, 0, At, B0); S_BARRIER(); SCHED_BAR();
            PG8_STAGE(PG8_SB(1, 1), b3 + hstep, voffB);
            WAIT_V(6); S_BARRIER(); PG8_MMA(1, 1, At, B1); S_BARRIER();
        }
        E(acc, cur, wr, wc, fr, fq);
        if (!has_next) break;
#pragma unroll
        for (int a = 0; a < 2; ++a)
#pragma unroll
            for (int b = 0; b < 2; ++b)
#pragma unroll
                for (int m = 0; m < 4; ++m)
#pragma unroll
                    for (int n = 0; n < 2; ++n) acc[a][b][m][n] = (f32x4){0.f, 0.f, 0.f, 0.f};
        cur = nxt; cA = nA; cB = nB; ++ui;
        if constexpr (Sched::GATHER) {
#pragma unroll
            for (int h_ = 0; h_ < 2; ++h_) { va[h_][0] = vn[h_][0]; va[h_][1] = vn[h_][1]; } }
    }
    WAIT_V(0);
    if (wr == 0) S_BARRIER();
    S_BARRIER();
#undef PG8_SA
#undef PG8_SB
#undef PG8_STAGE
#undef PG8_STAGE_A
#undef PG8_GOFF
#undef PG8_LDA
#undef PG8_LDB
#undef PG8_MMA
}
}

__device__ __forceinline__ float row16_sum(float x) {
#ifdef EMU
    x += __shfl_xor(x, 1); x += __shfl_xor(x, 2); x += __shfl_xor(x, 4); x += __shfl_xor(x, 8); return x;
#else
#define DPPF(v, ctrl) __builtin_bit_cast(float, __builtin_amdgcn_update_dpp(0, __builtin_bit_cast(int, (v)), (ctrl), 0xF, 0xF, false))
    x += DPPF(x, 0xB1); x += DPPF(x, 0x4E); x += DPPF(x, 0x141); x += DPPF(x, 0x140); return x;
#undef DPPF
#endif
}
__device__ __forceinline__ float row32_sum(float x) {
    x = row16_sum(x);
#ifdef EMU
    x += __shfl_xor(x, 32); return x;
#else
    float a = x, b = x;
    asm volatile("s_nop 1\n\tv_permlane32_swap_b32 %0, %1" : "+v"(a), "+v"(b));
    return a + b;
#endif
}
__device__ __forceinline__ float wave_sum_fast(float x, int lane) {
    x = row32_sum(x);
    x += SHX(x, 16, lane);
    return x;
}
__device__ __forceinline__ void transpose_item(const float* W, int K, int N, bf16_t* WT, int k0, int n0, int dst_row0, float* scr, int lane) {
    const int n4 = (lane & 15) * 4, kr = lane >> 4;
#pragma unroll 8
    for (int i = 0; i < 16; ++i) {
        const int kk = 4 * i + kr;
        f32x4 v = (f32x4){0.f, 0.f, 0.f, 0.f};
        if (n0 + n4 < N) v = *(const f32x4*)(W + (size_t)(k0 + kk) * N + n0 + n4);
        float* d = scr + kk * 65 + n4; d[0] = v.x; d[1] = v.y; d[2] = v.z; d[3] = v.w;
    }
    WAVE_SYNC();
    const int c = lane & 7;
#pragma unroll
    for (int j = 0; j < 8; ++j) { const int n = (lane >> 3) + 8 * j; const float* sp = scr + (8 * c) * 65 + n;
        u32x4 o; o.x = pk2(sp[0 * 65], sp[1 * 65]); o.y = pk2(sp[2 * 65], sp[3 * 65]); o.z = pk2(sp[4 * 65], sp[5 * 65]); o.w = pk2(sp[6 * 65], sp[7 * 65]);
        *(u32x4*)(WT + (size_t)(dst_row0 + n) * K + k0 + 8 * c) = o; }
    WAVE_SYNC();
}
__device__ __forceinline__ void phase_prologue(const Params& P, unsigned char* smem, int wv) {
    ParamsPtr pp = PARAMS_PTR(P); PIN_S(pp); unsigned char* ws = pp->ws; int bidx = (int)blockIdx.x, gdim = (int)gridDim.x; PIN_S(bidx); PIN_S(gdim);
    const int tid = phase_tid(wv), lane = tid & 63, wave = tid >> 6;
    float* scr = (float*)smem + wave * (64 * 65);
    const int gw = bidx * NWAVES + wave, ngw = NWAVES * gdim;
    constexpr int I_IN = 16 * (PLD / 64), I_OUT = 16 * 16, I_W1 = NE * 16 * 32, I_W2 = NE * 16 * 16, I_L = I_IN + I_OUT + I_W1 + I_W2;
    for (int it = gw; it < NL * I_L; it += ngw) {
        const int l = it / I_L; int r = it % I_L;
        if (r < I_IN) { const int kb = r / (PLD / 64), nb = r % (PLD / 64);
            transpose_item(pp->in[1] + (size_t)l * D * PIN, D, PIN, (bf16_t*)(ws + O_WIN) + (size_t)l * PLD * D, kb * 64, nb * 64, nb * 64, scr, lane); continue; }
        r -= I_IN;
        if (r < I_OUT) { const int kb = r / 16, nb = r % 16;
            transpose_item(pp->in[21] + (size_t)l * D * D, D, D, (bf16_t*)(ws + O_WOUT) + (size_t)l * D * D, kb * 64, nb * 64, nb * 64, scr, lane); continue; }
        r -= I_OUT;
        if (r < I_W1) { const int e = r / (16 * 32), q = r % (16 * 32), kb = q / 32, nb = q % 32, n0 = nb * 64;
            const int dst = n0 < DFF ? (n0 / 128) * 256 + (n0 % 128) : ((n0 - DFF) / 128) * 256 + 128 + ((n0 - DFF) % 128);
            transpose_item(pp->in[26] + ((size_t)l * NE + e) * D * 2 * DFF, D, 2 * DFF, (bf16_t*)(ws + O_W1) + ((size_t)l * NE + e) * 2 * DFF * D, kb * 64, n0, dst, scr, lane); continue; }
        r -= I_W1;
        { const int e = r / (16 * 16), q = r % (16 * 16), kb = q / 16, nb = q % 16;
            transpose_item(pp->in[28] + ((size_t)l * NE + e) * DFF * D, DFF, D, (bf16_t*)(ws + O_W2) + ((size_t)l * NE + e) * D * DFF, kb * 64, nb * 64, nb * 64, scr, lane); }
    }
    {
        const float* gw_ = pp->in[4]; bf16_t* WSB = (bf16_t*)(ws + O_WSB);
        for (size_t i = ((size_t)bidx * NTHREADS + tid) * 4; i < (size_t)NL * GH * CH * CH; i += (size_t)gdim * NTHREADS * 4) {
            const f32x4 v = *(const f32x4*)(gw_ + i); u32x2 o; o.x = pk2(v.x, v.y); o.y = pk2(v.z, v.w); *(u32x2*)(WSB + i) = o;
        }
    }
    {
        bf16_t* LWT = (bf16_t*)(ws + O_LWT);
        for (int i = bidx * NTHREADS + tid; i < NL * 1920 * 128; i += gdim * NTHREADS) {
            const int k = i & 127, n = (i >> 7) % 1920, ll = i / (1920 * 128);
            float v = 0.f;
            if (n < 1536) { if (k < 64) { const int grp = n / 768, d = (n / 384) & 1, c = n % 384; v = (grp == 0 ? pp->in[8] : pp->in[10])[(((size_t)ll * 2 + d) * 64 + k) * RW + c]; } }
            else v = pp->in[11][((size_t)ll * 128 + k) * RW + (n - 1536)];
            LWT[i] = (bf16_t)f2bf(v);
        }
    }
    {
        bf16_t* RWT = (bf16_t*)(ws + O_RWT);
        for (int i = bidx * NTHREADS + tid; i < NL * NE * D; i += gdim * NTHREADS) {
            const int k = i % D, e = (i / D) % NE, ll = i / (D * NE);
            const float v = pp->in[24][((size_t)ll * D + k) * NE + e];
            const unsigned hi = f2bf(v); const float lo = v - bf_lo(hi);
            RWT[((size_t)(ll * 2 + 0) * NE + e) * D + k] = (bf16_t)hi; RWT[((size_t)(ll * 2 + 1) * NE + e) * D + k] = (bf16_t)f2bf(lo);
        }
    }
    const float* x = pp->in[0]; bf16_t* XB = (bf16_t*)(ws + O_XB);
    for (size_t i = ((size_t)bidx * NTHREADS + tid) * 4; i < (size_t)T * D; i += (size_t)gdim * NTHREADS * 4) {
        const f32x4 v = *(const f32x4*)(x + i); u32x2 o; o.x = pk2(v.x, v.y); o.y = pk2(v.z, v.w); *(u32x2*)(XB + i) = o;
    }
}

__device__ __forceinline__ float tshift(const float* P, int t, int s, int col, const float* mu0, const float* mu1, int rc) {
    const float cur = P[(size_t)t * PLD + col];
    const float prv = s > 0 ? P[(size_t)(t - 1) * PLD + col] : 0.f;
    const float nxt = s < S - 1 ? P[(size_t)(t + 1) * PLD + col] : 0.f;
    return cur + mu0[rc] * (prv - cur) + mu1[rc] * (nxt - cur);
}

__device__ __forceinline__ void phase_prep(const Params& P, int l, unsigned char* smem, int wv) {
    ParamsPtr pp = PARAMS_PTR(P); PIN_S(pp); unsigned char* ws = pp->ws; int bidx = (int)blockIdx.x, gdim = (int)gridDim.x; PIN_S(bidx); PIN_S(gdim);
    const bf16_t* proj = (const bf16_t*)(ws + O_PROJ); const float* projg = (const float*)(ws + O_PROJG);
    float* UG = (float*)(ws + O_UG); bf16_t* VNT = (bf16_t*)(ws + O_VNT);
    float* RR = (float*)(ws + O_RR); float* VV = (float*)(ws + O_VV); float* KK = (float*)(ws + O_KK);
    float* KD = (float*)(ws + O_KD); float* ICLR = (float*)(ws + O_ICLR);
    float* GATE = (float*)(ws + O_GATE); float* BONUS = (float*)(ws + O_BONUS); float* LWG = (float*)(ws + O_LW);
    bf16_t* RB = (bf16_t*)(ws + O_RB); bf16_t* VB = (bf16_t*)(ws + O_VB); bf16_t* KKB = (bf16_t*)(ws + O_KKB); bf16_t* BBB = (bf16_t*)(ws + O_BBB); bf16_t* KDB = (bf16_t*)(ws + O_KDB);
#if !MK_RWKV_CHUNKED
    float* DEC = (float*)(ws + O_DEC); float* BRKR = (float*)(ws + O_BRKR);
#endif
    bf16_t* MQB = (bf16_t*)(ws + O_MQB); bf16_t* MKB = (bf16_t*)(ws + O_MKB); bf16_t* KT = (bf16_t*)(ws + O_KT); bf16_t* VT = (bf16_t*)(ws + O_VT);
    float* IG = (float*)(ws + O_IG); float* LF = (float*)(ws + O_LF);
    const bf16_t* LWT = (const bf16_t*)(ws + O_LWT) + (size_t)l * 1920 * 128;
    const float* gln_g = pp->in[2] + (size_t)l * GW; const float* gln_b = pp->in[3] + (size_t)l * GW;
    const float* mu0 = pp->in[6] + (size_t)l * 2 * RPROJ; const float* mu1 = mu0 + RPROJ;
    const float* w0 = pp->in[7] + (size_t)l * 2 * RW; const float* a0 = pp->in[9] + (size_t)l * 2 * RW;
    const float* k_k = pp->in[12] + (size_t)l * RW; const float* k_a = pp->in[13] + (size_t)l * RW; const float* r_k = pp->in[14] + (size_t)l * RW;
    const float* conv_w = pp->in[17] + (size_t)l * 3 * 768; const float* conv_b = pp->in[18] + (size_t)l * 768; const float* gate_b = pp->in[19] + (size_t)l * 24;
    float* win = (float*)smem;
    bf16_t* lin = (bf16_t*)(smem + 101376);
    bf16_t* tvn = (bf16_t*)(smem + 110592);
    bf16_t* tk = (bf16_t*)(smem + 118784);
    bf16_t* tv = (bf16_t*)(smem + 131072);
    constexpr int LIN = 264;
    const int tid = phase_tid(wv), lane = tid & 63, wave = tid >> 6, col = lane & 15, g = lane >> 4;
    for (int u = bidx; u < T / 16; u += gdim) {
        const int t0 = u * 16, s0 = t0 % S, bb = t0 / S;
        __syncthreads();
        {
            u32x2 wb[18];
#pragma unroll
            for (int row = 0; row < 18; ++row) {
                const int sq = s0 - 1 + row;
                wb[row] = (u32x2){0u, 0u};
                if (sq >= 0 && sq < S && tid < 352) wb[row] = *(const u32x2*)(proj + (size_t)(t0 - 1 + row) * PLD + C_RW + tid * 4);
            }
            if (tid < 352) {
#pragma unroll
                for (int row = 0; row < 18; ++row) *(f32x4*)(win + row * RPROJ + tid * 4) = (f32x4){bf_lo(wb[row].x), bf_hi(wb[row].x), bf_lo(wb[row].y), bf_hi(wb[row].y)};
            }
        }
        for (int rep_ = 0; rep_ < (MK_PROBE == 3 ? 2 : 1); ++rep_) {
            const int i = tid >> 5, l32 = tid & 31, t = t0 + i;
            float v[8], ug[8]; float sum = 0.f;
#pragma unroll
            for (int j = 0; j < 8; ++j) { const int c = j * 32 + l32; ug[j] = bf_lo((unsigned)proj[(size_t)t * PLD + c]); v[j] = bf_lo((unsigned)proj[(size_t)t * PLD + GW + c]); }
#pragma unroll
            for (int j = 0; j < 8; ++j) { const int c = j * 32 + l32; UG[(size_t)t * GW + c] = geluf_(ug[j]); v[j] = geluf_(v[j]); sum += v[j]; }
#pragma unroll
            for (int o = 16; o >= 1; o >>= 1) sum += SHX(sum, o, lane);
            const float mean = sum * (1.0f / GW); float q = 0.f;
#pragma unroll
            for (int j = 0; j < 8; ++j) { const float d = v[j] - mean; q += d * d; }
#pragma unroll
            for (int o = 16; o >= 1; o >>= 1) q += SHX(q, o, lane);
            const float rstd = 1.0f / sqrtf(q * (1.0f / GW) + LN_EPS);
#pragma unroll
            for (int j = 0; j < 8; ++j) { const int c = j * 32 + l32; tvn[c * 16 + i] = (bf16_t)f2bf((v[j] - mean) * rstd * gln_g[c] + gln_b[c]); }
        }
        __syncthreads();
        {
            const int hf = tid & 1, c = tid >> 1;
            *(u32x4*)(VNT + ((size_t)bb * GW + c) * S + s0 + hf * 8) = *(const u32x4*)(tvn + c * 16 + hf * 8);
        }
        for (int idx = tid; idx < 16 * 256; idx += NTHREADS) {
            const int i = idx >> 8, j = idx & 255, rc = 1152 + j;
            const float pv = win[i * RPROJ + rc], cv = win[(i + 1) * RPROJ + rc], nv = win[(i + 2) * RPROJ + rc];
            const float x = cv + mu0[rc] * (pv - cv) + mu1[rc] * (nv - cv);
            lin[i * LIN + j] = (bf16_t)f2bf(j < 64 ? ftanh(x) : (j < 128 ? x : sigmoidf_(x)));
        }
        __syncthreads();
        for (int rep_ = 0; rep_ < (MK_PROBE == 1 ? 2 : 1); ++rep_) {
#pragma unroll 1
            for (int qg = 0; qg < 3; ++qg) {
                bf16x8 bw_[5][4]; float bias_[5];
#pragma unroll
                for (int q5 = 0; q5 < 5; ++q5) {
                    const int nt = wave * 15 + qg * 5 + q5, grp = nt / 24, c = (nt % 24) * 16 + col;
                    const bf16_t* bw = LWT + (size_t)(nt * 16 + col) * 128 + 8 * g;
#pragma unroll
                    for (int ks = 0; ks < 2; ++ks) bw_[q5][ks] = *(const bf16x8*)(bw + ks * 32);
                    if (grp == 4) {
#pragma unroll
                        for (int ks = 2; ks < 4; ++ks) bw_[q5][ks] = *(const bf16x8*)(bw + ks * 32);
                    }
                    bias_[q5] = grp < 2 ? w0[grp * RW + c] : (grp < 4 ? a0[(grp - 2) * RW + c] : 0.f);
                }
#pragma unroll
                for (int q5 = 0; q5 < 5; ++q5) {
                    const int nt = wave * 15 + qg * 5 + q5, grp = nt / 24, c = (nt % 24) * 16 + col;
                    const int kcol = grp < 2 ? 0 : (grp < 4 ? 64 : 128);
                    f32x4 acc = (f32x4){0.f, 0.f, 0.f, 0.f};
#pragma unroll
                    for (int ks = 0; ks < 2; ++ks) acc = MFMA16(*(const bf16x8*)(lin + col * LIN + kcol + ks * 32 + 8 * g), bw_[q5][ks], acc);
                    if (grp == 4) {
#pragma unroll
                        for (int ks = 2; ks < 4; ++ks) acc = MFMA16(*(const bf16x8*)(lin + col * LIN + kcol + ks * 32 + 8 * g), bw_[q5][ks], acc);
                    }
                    if (grp < 2) {
#pragma unroll
                        for (int r = 0; r < 4; ++r) { const float lw = -fexp(-softplusf_(-(acc[r] + bias_[q5])) - 0.5f); const size_t o = (size_t)grp * T * RW + (size_t)(t0 + 4 * g + r) * RW + c; LWG[o] = lw;
#if !MK_RWKV_CHUNKED
                            DEC[o] = expf(lw);
#endif
                        }
                    } else if (grp < 4) {
#pragma unroll
                        for (int r = 0; r < 4; ++r) ICLR[(size_t)(grp - 2) * T * RW + (size_t)(t0 + 4 * g + r) * RW + c] = sigmoidf_(acc[r] + bias_[q5]);
                    } else {
#pragma unroll
                        for (int r = 0; r < 4; ++r) GATE[(size_t)(t0 + 4 * g + r) * RW + c] = acc[r];
                    }
                }
            }
        }
        __syncthreads();
        for (int rep_ = 0; rep_ < (MK_PROBE == 2 ? 2 : 1); ++rep_) if (wave < 6) {
            const int c = tid, h = wave;
            const float kkc = k_k[c], kac = k_a[c], rkc = r_k[c];
            const float m0r = mu0[c], m1r = mu1[c], m0k = mu0[RW + c], m1k = mu1[RW + c], m0v = mu0[2 * RW + c], m1v = mu1[2 * RW + c];
            float ic0[16], ic1[16];
#pragma unroll
            for (int i = 0; i < 16; ++i) { const size_t o = (size_t)(t0 + i) * RW + c; ic0[i] = ICLR[o]; ic1[i] = ICLR[(size_t)T * RW + o]; }
#pragma unroll
            for (int i = 0; i < 16; ++i) {
                const int t = t0 + i;
                const float* w_ = win + i * RPROJ + c;
                const float rp = w_[0], rc_ = w_[RPROJ], rn = w_[2 * RPROJ];
                const float kp = w_[RW], kc_ = w_[RPROJ + RW], kn = w_[2 * RPROJ + RW];
                const float vp = w_[2 * RW], vc_ = w_[RPROJ + 2 * RW], vn = w_[2 * RPROJ + 2 * RW];
                const float r = rc_ + m0r * (rp - rc_) + m1r * (rn - rc_);
                const float k = kc_ + m0k * (kp - kc_) + m1k * (kn - kc_);
                const float v = vc_ + m0v * (vp - vc_) + m1v * (vn - vc_);
                const size_t o = (size_t)t * RW + c;
                const float kq = k * kkc;
                const float n2 = wave_sum_fast(kq * kq, lane);
                const float kk = kq / fmaxf(sqrtf(n2), 1e-12f);
                const float kd0 = k * (1.0f + (ic0[i] - 1.0f) * kac), kd1 = k * (1.0f + (ic1[i] - 1.0f) * kac);
                const float bon = wave_sum_fast(r * (kd0 + kd1) * rkc, lane);
#if MK_RWKV_CHUNKED
                RB[o] = (bf16_t)f2bf(r); VB[o] = (bf16_t)f2bf(v); KKB[o] = (bf16_t)f2bf(kk);
                BBB[o] = (bf16_t)f2bf(kk * ic0[i]); BBB[(size_t)T * RW + o] = (bf16_t)f2bf(kk * ic1[i]);
                KDB[o] = (bf16_t)f2bf(kd0); KDB[(size_t)T * RW + o] = (bf16_t)f2bf(kd1);
#else
                RR[o] = r; VV[o] = v; KK[o] = kk;
                KD[o] = kd0; KD[(size_t)T * RW + o] = kd1;
#endif
                if (lane == 0) BONUS[(size_t)t * RH + h] = bon;
#if !MK_RWKV_CHUNKED
                { const float br0 = wave_sum(kk * ic0[i] * r, lane), br1 = wave_sum(kk * ic1[i] * r, lane), kr0 = wave_sum(kd0 * r, lane), kr1 = wave_sum(kd1 * r, lane);
                  if (lane == 0) { BRKR[((size_t)t * RH + h) * 2] = br0; BRKR[((size_t)t * RH + h) * 2 + 1] = kr0; BRKR[((size_t)(T + t) * RH + h) * 2] = br1; BRKR[((size_t)(T + t) * RH + h) * 2 + 1] = kr1; } }
#endif
            }
        }
        __syncthreads();
        {
            u32x2 wb[9], vb[3];
            const int rsel = tid >= 192 ? 1 : 0, c4 = tid - rsel * 192;
#pragma unroll
            for (int it = 0; it < 9; ++it) {
                const int row = 2 * it + rsel, sq = s0 - 1 + row;
                wb[it] = (u32x2){0u, 0u};
                if (tid < 384 && sq >= 0 && sq < S) wb[it] = *(const u32x2*)(proj + (size_t)(t0 - 1 + row) * PLD + C_MW + c4 * 4);
            }
#pragma unroll
            for (int it = 0; it < 3; ++it) { const int idx = tid + it * NTHREADS, i = idx / 96, cc = (idx % 96) * 4; vb[it] = *(const u32x2*)(proj + (size_t)(t0 + i) * PLD + C_MW + 2 * MW + cc); }
            if (tid < 384) {
#pragma unroll
                for (int it = 0; it < 9; ++it) *(f32x4*)(win + (2 * it + rsel) * 768 + c4 * 4) = (f32x4){bf_lo(wb[it].x), bf_hi(wb[it].x), bf_lo(wb[it].y), bf_hi(wb[it].y)};
            }
#pragma unroll
            for (int it = 0; it < 3; ++it) { const int idx = tid + it * NTHREADS, i = idx / 96, cc = (idx % 96) * 4; const u32x2 v = vb[it];
                tv[(cc + 0) * 16 + i] = (bf16_t)(v.x & 0xffffu); tv[(cc + 1) * 16 + i] = (bf16_t)(v.x >> 16); tv[(cc + 2) * 16 + i] = (bf16_t)(v.y & 0xffffu); tv[(cc + 3) * 16 + i] = (bf16_t)(v.y >> 16); }
        }
        for (int idx = tid; idx < 16 * 24; idx += NTHREADS) {
            const int i = idx / 24, gi = idx % 24, t = t0 + i;
            const int isf = gi / 12, dir = (gi / 6) & 1, h = gi % 6;
            const float gg = projg[(size_t)t * 256 + (3456 - (PLD - 256)) + gi] + gate_b[gi];
            if (isf) LF[((size_t)dir * T + t) * MH + h] = -softplusf_(-gg); else IG[((size_t)dir * T + t) * MH + h] = gg;
        }
        __syncthreads();
        for (int rep_ = 0; rep_ < (MK_PROBE == 4 ? 2 : 1); ++rep_)
        for (int idx = tid; idx < 16 * 768; idx += NTHREADS) {
            const int i = idx / 768, c = idx % 768, t = t0 + i;
            const float* w_ = win + i * 768 + c;
            float y = conv_b[c] + w_[0] * conv_w[c] + w_[768] * conv_w[768 + c] + w_[1536] * conv_w[2 * 768 + c];
            y = y * sigmoidf_(y);
            if (c < MW) MQB[(size_t)t * MW + c] = (bf16_t)f2bf(y);
            else { const bf16_t kb = (bf16_t)f2bf(y * 0.125f); MKB[(size_t)t * MW + (c - MW)] = kb; tk[(c - MW) * 16 + i] = kb; }
        }
        __syncthreads();
        for (int idx = tid; idx < 2 * MW * 2; idx += NTHREADS) {
            const int hf = idx & 1, c = (idx >> 1) % MW, which = idx / (2 * MW);
            const u32x4 val = *(const u32x4*)((which ? tv : tk) + c * 16 + hf * 8);
            bf16_t* dst = (which ? VT : KT) + ((size_t)(bb * MH) * 64 + c) * S + s0 + hf * 8;
            *(u32x4*)dst = val;
        }
    }
    __syncthreads();
}

__device__ __forceinline__ void phase_gmlp_mix(const Params& P, int l, unsigned char* smem, int wv, int bid, int nb) {
    PIN_S(bid); PIN_S(nb);
    ParamsPtr pp = PARAMS_PTR(P); PIN_S(pp); unsigned char* ws = pp->ws;
    const float* UG = (const float*)(ws + O_UG); const bf16_t* VNT = (const bf16_t*)(ws + O_VNT); bf16_t* GRP = (bf16_t*)(ws + O_GRP);
    const bf16_t* WSB = (const bf16_t*)(ws + O_WSB) + (size_t)l * GH * CH * CH; const float* gbs = pp->in[5] + (size_t)l * GH * CH;
    const int tid = phase_tid(wv), lane = tid & 63, wave = tid >> 6, col = lane & 15, g = lane >> 4;
    for (int u = bid; u < NB * NCH * GH; u += nb) {
        const int h = u % GH, c = (u / GH) % NCH, b = u / (GH * NCH);
        const int tok0 = b * S + c * CH;
        const bf16_t* wb = WSB + (size_t)h * CH * CH + (size_t)(wave * 16 + col) * CH + 8 * g;
        const bf16_t* vb = VNT + ((size_t)b * GW + h * 64 + col) * S + (size_t)c * CH + 8 * g;
        f32x4 acc[4];
#pragma unroll
        for (int et = 0; et < 4; ++et) acc[et] = (f32x4){0.f, 0.f, 0.f, 0.f};
#pragma unroll
        for (int ks = 0; ks < 4; ++ks) {
            const bf16x8 af = *(const bf16x8*)(wb + ks * 32);
#pragma unroll
            for (int et = 0; et < 4; ++et) acc[et] = MFMA16(af, *(const bf16x8*)(vb + (size_t)et * 16 * S + ks * 32), acc[et]);
        }
#pragma unroll
        for (int r = 0; r < 4; ++r) {
            const int p = wave * 16 + 4 * g + r; const size_t t = (size_t)(tok0 + p); const float bsv = gbs[h * CH + p];
#pragma unroll
            for (int et = 0; et < 4; ++et) { const int ch = h * 64 + et * 16 + col; GRP[t * D + ch] = (bf16_t)f2bf(UG[t * GW + ch] * (acc[et][r] + bsv)); }
        }
    }
}

constexpr int SC_STEPS = 16;
constexpr int SC_BUF = SC_STEPS * 6 * 64;
__device__ __forceinline__ void phase_rwkv_scan(const Params& P, int l, unsigned char* smem, int wv, int bid, int nb) {
    PIN_S(bid); PIN_S(nb);
    ParamsPtr pp = PARAMS_PTR(P); PIN_S(pp); unsigned char* ws = pp->ws;
    const float* RR = (const float*)(ws + O_RR); const float* VV = (const float*)(ws + O_VV); const float* KK = (const float*)(ws + O_KK);
    const float* DEC = (const float*)(ws + O_DEC); const float* KD = (const float*)(ws + O_KD); const float* ICLR = (const float*)(ws + O_ICLR);
    float* SCAN = (float*)(ws + O_SCAN); const float* BRKR = (const float*)(ws + O_BRKR);
    const int tid = phase_tid(wv), lane = tid & 63, wave = tid >> 6, rl = (lane >> 4) & 1, kq = (lane & 15) | ((lane >> 5) << 4);
    float* buf = (float*)smem;
    float* scal = buf + 2 * SC_BUF;
    float* outb = scal + 2 * SC_STEPS * 2;
    typedef float f32x2 __attribute__((ext_vector_type(2)));
    for (int u = bid; u < 2 * NB * RH * 4; u += nb) {
        const int qt = u & 3, h = (u >> 2) % RH, b = (u / (4 * RH)) % NB, d = u / (4 * RH * NB);
        const size_t doff = (size_t)d * T * RW;
        float s0 = 0.f, s1 = 0.f;
        float pw[2], pa[2], pb[2], pk[2], pr[2], pv[2], psc = 0.f;
#define SC_LOAD(c) do { _Pragma("unroll") for (int i = 0; i < 2; ++i) { const int idx = tid + NTHREADS * i, st = idx >> 6, k = idx & 63; const int tau = (c) * SC_STEPS + st, sq = d ? S - 1 - tau : tau; \
            const size_t o = (size_t)(b * S + sq) * RW + h * 64 + k; \
            pw[i] = DEC[doff + o]; pa[i] = KK[o]; pb[i] = ICLR[doff + o]; pk[i] = KD[doff + o]; pr[i] = RR[o]; pv[i] = VV[o]; }     \
            if (tid < 2 * SC_STEPS) { const int tau = (c) * SC_STEPS + (tid >> 1), sq = d ? S - 1 - tau : tau; psc = BRKR[((size_t)(d * T + b * S + sq) * RH + h) * 2 + (tid & 1)]; } } while (0)
#define SC_WRITE(c) do { float* B_ = buf + ((c) & 1) * SC_BUF; _Pragma("unroll") for (int i = 0; i < 2; ++i) { const int idx = tid + NTHREADS * i, st = idx >> 6, k = idx & 63; \
            float* q_ = B_ + st * 384 + k; q_[0] = pw[i]; q_[64] = -pa[i]; q_[128] = pa[i] * pb[i]; q_[192] = pk[i]; q_[256] = pw[i] * pr[i]; q_[320] = pv[i]; } \
            if (tid < 2 * SC_STEPS) scal[((c) & 1) * SC_STEPS * 2 + tid] = psc; } while (0)
        __syncthreads();
        SC_LOAD(0); SC_WRITE(0);
        __syncthreads();
        const int row = qt * 16 + wave * 2 + rl;
        for (int c = 0; c < S / SC_STEPS; ++c) {
            const bool more = (c + 1) < S / SC_STEPS;
            if (more) SC_LOAD(c + 1);
            const float* B = buf + (c & 1) * SC_BUF; const float* sc = scal + (c & 1) * SC_STEPS * 2; float* ob = outb + (c & 1) * SC_STEPS * 16;
            float outs[SC_STEPS];
            f32x2 w2 = *(const f32x2*)(B + 2 * kq), a2 = *(const f32x2*)(B + 64 + 2 * kq), b2 = *(const f32x2*)(B + 128 + 2 * kq);
            f32x2 k2 = *(const f32x2*)(B + 192 + 2 * kq), wr2 = *(const f32x2*)(B + 256 + 2 * kq);
            float v = B[320 + row]; float br = sc[0], kr = sc[1];
#pragma unroll
            for (int st = 0; st < SC_STEPS; ++st) {
                const int sn = st + 1 < SC_STEPS ? st + 1 : st;
                const float* q = B + sn * 384;
                const f32x2 nw2 = *(const f32x2*)(q + 2 * kq), na2 = *(const f32x2*)(q + 64 + 2 * kq), nb2 = *(const f32x2*)(q + 128 + 2 * kq);
                const f32x2 nk2 = *(const f32x2*)(q + 192 + 2 * kq), nwr2 = *(const f32x2*)(q + 256 + 2 * kq);
                const float nv = q[320 + row], nbr = sc[sn * 2], nkr = sc[sn * 2 + 1];
                SCHED_BAR();
                float sa = s0 * a2.x + s1 * a2.y;
                float po = s0 * wr2.x + s1 * wr2.y;
                sa = row32_sum(sa); po = row32_sum(po);
                outs[st] = po + sa * br + v * kr;
                s0 = s0 * w2.x + (sa * b2.x + v * k2.x); s1 = s1 * w2.y + (sa * b2.y + v * k2.y);
                SCHED_BAR();
                w2 = nw2; a2 = na2; b2 = nb2; k2 = nk2; wr2 = nwr2; v = nv; br = nbr; kr = nkr;
            }
            if (kq == 0) {
#pragma unroll
                for (int st = 0; st < SC_STEPS; ++st) ob[st * 16 + wave * 2 + rl] = outs[st];
            }
            if (more) SC_WRITE(c + 1);
            __syncthreads();
            if (tid < 16 * SC_STEPS) {
                const int st = tid >> 4, r = tid & 15, tau = c * SC_STEPS + st, sq = d ? S - 1 - tau : tau;
                SCAN[doff + (size_t)(b * S + sq) * RW + h * 64 + qt * 16 + r] = ob[st * 16 + r];
            }
        }
#undef SC_LOAD
#undef SC_WRITE
    }
    __syncthreads();
}

constexpr int RST = 72;
constexpr int RARR = 64 * RST;
__device__ __forceinline__ f32x4 tile_nt(const bf16_t* Aa, int ta, const bf16_t* Ba, int tb, f32x4 acc, int col, int g) {
#pragma unroll
    for (int ks = 0; ks < 2; ++ks) {
        const bf16x8 af = *(const bf16x8*)(Aa + (ta * 16 + col) * RST + ks * 32 + 8 * g);
        const bf16x8 bfr = *(const bf16x8*)(Ba + (tb * 16 + col) * RST + ks * 32 + 8 * g);
        acc = MFMA16(af, bfr, acc);
    }
    return acc;
}
__device__ __forceinline__ void phase_rwkv_pre(const Params& P, int l, unsigned char* smem, int wv) {
    ParamsPtr pp = PARAMS_PTR(P); PIN_S(pp); unsigned char* ws = pp->ws; int bidx = (int)blockIdx.x, gdim = (int)gridDim.x; PIN_S(bidx); PIN_S(gdim);
    const bf16_t* RB = (const bf16_t*)(ws + O_RB); const bf16_t* VB = (const bf16_t*)(ws + O_VB); const bf16_t* KKB = (const bf16_t*)(ws + O_KKB);
    const float* LWG = (const float*)(ws + O_LW); const bf16_t* KDB = (const bf16_t*)(ws + O_KDB); const bf16_t* BBB = (const bf16_t*)(ws + O_BBB);
    bf16_t* Qg = (bf16_t*)(ws + O_RQ); bf16_t* Ag = (bf16_t*)(ws + O_RA); bf16_t* Hg = (bf16_t*)(ws + O_RH); bf16_t* Gg = (bf16_t*)(ws + O_RG);
    const int tid0 = phase_tid(wv);
#define RW_STAGE_VARS int tid = tid0; PIN_V(tid); const int lane = tid & 63, wave = tid >> 6, col = lane & 15, g = lane >> 4; (void)lane; (void)wave; (void)col; (void)g;
    bf16_t* At = (bf16_t*)smem; bf16_t* Bt = At + RARR; bf16_t* Kt = Bt + RARR; bf16_t* Rt = Kt + RARR;
    bf16_t* BtT = Rt + RARR; bf16_t* KtT = BtT + RARR; bf16_t* VT = KtT + RARR;
    bf16_t* Lak = VT + RARR; bf16_t* Mrb = Lak + RARR; bf16_t* Mrk = Mrb + RARR; bf16_t* YT = Mrk + RARR; bf16_t* W2T = YT + RARR;
    bf16_t* Lbo = W2T + RARR;
    float* LabT = (float*)(Lbo + RARR);
    float* Xs = LabT + 4096;
    float* Pb = Xs + 4096;
    float* segs = Pb + 2048;
    float* PC = segs + 512;
    float plw[8]; unsigned pkk[8], pbq[8], pkd[8], prr[8], pvv[8];
#define RW_LOAD(uu) do { const int c_ = (uu) % RNC, h_ = ((uu) / RNC) % RH, b_ = ((uu) / (RNC * RH)) % NB, d_ = (uu) / (RNC * RH * NB); const size_t doff_ = (size_t)d_ * T * RW; \
        const int ch_ = tid0 & 63, sg_ = tid0 >> 6; _Pragma("unroll") for (int j = 0; j < 8; ++j) { const int tau = c_ * RC + sg_ * 8 + j, sq = d_ ? S - 1 - tau : tau; const size_t o = (size_t)(b_ * S + sq) * RW + h_ * 64 + ch_; \
        plw[j] = LWG[doff_ + o]; pkk[j] = KKB[o]; pbq[j] = BBB[doff_ + o]; pkd[j] = KDB[doff_ + o]; prr[j] = RB[o]; pvv[j] = VB[o]; } } while (0)
    if (bidx < RUN) RW_LOAD(bidx);
    for (int u = bidx; u < RUN; u += gdim) {
        const int c = u % RNC, h = (u / RNC) % RH, b = (u / (RNC * RH)) % NB, d = u / (RNC * RH * NB);
        (void)c; (void)h; (void)b; (void)d;
        __syncthreads();
        {
            RW_STAGE_VARS
            const int ch = tid & 63, sg = tid >> 6;
            float lw[8]; unsigned kk[8], bq_[8], kd[8], rr[8], vv[8];
#pragma unroll
            for (int j = 0; j < 8; ++j) { lw[j] = plw[j]; kk[j] = pkk[j]; bq_[j] = pbq[j]; kd[j] = pkd[j]; rr[j] = prr[j]; vv[j] = pvv[j]; }
            if (u + gdim < RUN) RW_LOAD(u + gdim);
            float run = 0.f;
#pragma unroll
            for (int j = 0; j < 8; ++j) { run += lw[j]; lw[j] = run; }
            segs[sg * 64 + ch] = run;
            __syncthreads();
            float off = 0.f;
            for (int q = 0; q < sg; ++q) off += segs[q * 64 + ch];
            u32x4 pbt, pkt, pvt; unsigned tb[8], tk[8], tvv[8];
            float prev = off;
#pragma unroll
            for (int j = 0; j < 8; ++j) {
                const int t = sg * 8 + j; const float cl = off + lw[j];
                const float ep = fexp(prev), en = fexp(-cl), epc = fexp(cl);
                const unsigned a_ = f2bf(-bf_lo(kk[j]) * ep), b_ = f2bf(bf_lo(bq_[j]) * en), k_ = f2bf(bf_lo(kd[j]) * en), r_ = f2bf(bf_lo(rr[j]) * epc), v_ = vv[j];
                At[t * RST + ch] = (bf16_t)a_; Bt[t * RST + ch] = (bf16_t)b_; Kt[t * RST + ch] = (bf16_t)k_; Rt[t * RST + ch] = (bf16_t)r_;
                tb[j] = b_; tk[j] = k_; tvv[j] = v_;
                prev = cl;
            }
            if (sg == 7) PC[ch] = fexp(prev);
            pbt.x = tb[0] | (tb[1] << 16); pbt.y = tb[2] | (tb[3] << 16); pbt.z = tb[4] | (tb[5] << 16); pbt.w = tb[6] | (tb[7] << 16);
            pkt.x = tk[0] | (tk[1] << 16); pkt.y = tk[2] | (tk[3] << 16); pkt.z = tk[4] | (tk[5] << 16); pkt.w = tk[6] | (tk[7] << 16);
            pvt.x = tvv[0] | (tvv[1] << 16); pvt.y = tvv[2] | (tvv[3] << 16); pvt.z = tvv[4] | (tvv[5] << 16); pvt.w = tvv[6] | (tvv[7] << 16);
            *(u32x4*)(BtT + ch * RST + sg * 8) = pbt; *(u32x4*)(KtT + ch * RST + sg * 8) = pkt; *(u32x4*)(VT + ch * RST + sg * 8) = pvt;
            for (int z_ = tid; z_ < 2 * RARR / 8; z_ += NTHREADS) ((u32x4*)YT)[z_] = (u32x4){0u, 0u, 0u, 0u};
        }
        __syncthreads();
        {
            RW_STAGE_VARS
            const int m = wave >> 1;
            const bf16_t* Ym = (m == 0 || m == 2) ? Bt : Kt; const bf16_t* Xm = (m < 2) ? At : Rt;
#pragma unroll 1
            for (int q = 0; q < 8; ++q) {
                const int tix = (wave & 1) * 8 + q, it = tix >> 2, tt = tix & 3;
                f32x4 acc = (f32x4){0.f, 0.f, 0.f, 0.f};
                if (it <= tt) acc = tile_nt(Ym, it, Xm, tt, acc, col, g);
                const int t = tt * 16 + col, i0 = it * 16 + 4 * g;
                float o4[4];
#pragma unroll
                for (int r = 0; r < 4; ++r) { const int i = i0 + r; const bool ok = m < 2 ? (i < t) : (i <= t); o4[r] = ok ? acc[r] : 0.f; }
                if (m == 0) {
#pragma unroll
                    for (int r = 0; r < 4; ++r) LabT[(i0 + r) * 64 + t] = o4[r];
                    const bool offd = it < tt;
                    u32x2 w2; w2.x = offd ? pk2(o4[0], o4[1]) : 0u; w2.y = offd ? pk2(o4[2], o4[3]) : 0u; *(u32x2*)(Lbo + t * RST + i0) = w2;
                }
                else { bf16_t* dst = (m == 1 ? Lak : (m == 2 ? Mrb : Mrk)) + t * RST + i0; u32x2 w2; w2.x = pk2(o4[0], o4[1]); w2.y = pk2(o4[2], o4[3]); *(u32x2*)dst = w2; }
            }
        }
        __syncthreads();
        {
            RW_STAGE_VARS
#pragma unroll
            for (int q = 0; q < 2; ++q) {
                const int tix = wave * 2 + q, tt = tix >> 2, et = tix & 3;
                f32x4 acc = (f32x4){0.f, 0.f, 0.f, 0.f};
                acc = tile_nt(Lak, tt, VT, et, acc, col, g);
#pragma unroll
                for (int r = 0; r < 4; ++r) Xs[(tt * 16 + 4 * g + r) * 64 + et * 16 + col] = acc[r];
            }
        }
        __syncthreads();
        {
            RW_STAGE_VARS
#pragma unroll 1
            for (int bb = 0; bb < 4; ++bb) {
                if (bb > 0) {
                    const bf16_t* Zt = (wave < 4 ? YT : W2T) + ((wave & 3) * 16 + col) * RST + 8 * g;
                    const bf16_t* La = Lbo + (16 * bb + col) * RST + 8 * g;
                    f32x4 acc = (f32x4){0.f, 0.f, 0.f, 0.f};
                    acc = MFMA16(*(const bf16x8*)La, *(const bf16x8*)Zt, acc);
                    if (bb > 2) acc = MFMA16(*(const bf16x8*)(La + 32), *(const bf16x8*)(Zt + 32), acc);
#pragma unroll
                    for (int r = 0; r < 4; ++r) Pb[(4 * g + r) * 128 + wave * 16 + col] = acc[r];
                }
                __syncthreads();
                if (wave < 2) {
                    float acc[16];
                    if (wave == 0) {
#pragma unroll
                        for (int r = 0; r < 16; ++r) acc[r] = bf_lo((unsigned)At[(16 * bb + r) * RST + lane]);
                    } else {
#pragma unroll
                        for (int r = 0; r < 16; ++r) acc[r] = Xs[(16 * bb + r) * 64 + lane];
                    }
                    if (bb > 0) {
#pragma unroll
                        for (int r = 0; r < 16; ++r) acc[r] += Pb[r * 128 + wave * 64 + lane];
                    }
                    const float* dp = LabT + (16 * bb) * 64 + 16 * bb;
#pragma unroll
                    for (int r = 1; r < 16; ++r)
#pragma unroll
                        for (int r2 = 0; r2 < r; ++r2) acc[r] += dp[r2 * 64 + r] * acc[r2];
                    bf16_t* dst = (wave == 0 ? YT : W2T) + lane * RST;
                    u32x4 w0, w1;
                    w0.x = pk2(acc[0], acc[1]); w0.y = pk2(acc[2], acc[3]); w0.z = pk2(acc[4], acc[5]); w0.w = pk2(acc[6], acc[7]);
                    w1.x = pk2(acc[8], acc[9]); w1.y = pk2(acc[10], acc[11]); w1.z = pk2(acc[12], acc[13]); w1.w = pk2(acc[14], acc[15]);
                    *(u32x4*)(dst + 16 * bb) = w0; *(u32x4*)(dst + 16 * bb + 8) = w1;
                }
                __syncthreads();
            }
        }
        __syncthreads();
        {
            RW_STAGE_VARS
            const int ty = wave >> 1;
#pragma unroll 1
            for (int q = 0; q < 8; ++q) {
                const int tix = (wave & 1) * 8 + q, ra = tix >> 2, cb = tix & 3;
                f32x4 acc = (f32x4){0.f, 0.f, 0.f, 0.f};
                if (ty == 0) {
                    acc = tile_nt(YT, ra, Mrb, cb, acc, col, g);
                    const u32x2 rt2 = *(const u32x2*)(Rt + (cb * 16 + col) * RST + ra * 16 + 4 * g);
                    u32x2 qb2; qb2.x = pk2(acc[0] + bf_lo(rt2.x), acc[1] + bf_hi(rt2.x)); qb2.y = pk2(acc[2] + bf_lo(rt2.y), acc[3] + bf_hi(rt2.y));
                    *(u32x2*)(Qg + (size_t)u * 4096 + (tix * 64 + lane) * 4) = qb2;
                } else if (ty == 1) {
                    acc = tile_nt(Mrb, ra, W2T, cb, acc, col, g); acc = tile_nt(Mrk, ra, VT, cb, acc, col, g);
                    { u32x2 hb; hb.x = pk2(acc[0], acc[1]); hb.y = pk2(acc[2], acc[3]); *(u32x2*)(Hg + (size_t)u * 4096 + (tix * 64 + lane) * 4) = hb; }
                } else if (ty == 2) {
                    acc = tile_nt(YT, ra, BtT, cb, acc, col, g);
                    const float pc = PC[cb * 16 + col]; const int k1 = cb * 16 + col;
                    float a4[4];
#pragma unroll
                    for (int r = 0; r < 4; ++r) a4[r] = pc * (acc[r] + ((ra * 16 + 4 * g + r) == k1 ? 1.0f : 0.f));
                    u32x2 ab2; ab2.x = pk2(a4[0], a4[1]); ab2.y = pk2(a4[2], a4[3]);
                    *(u32x2*)(Ag + (size_t)u * 4096 + (tix * 64 + lane) * 4) = ab2;
                } else {
                    acc = tile_nt(BtT, ra, W2T, cb, acc, col, g); acc = tile_nt(KtT, ra, VT, cb, acc, col, g);
#pragma unroll
                    for (int r = 0; r < 4; ++r) acc[r] *= PC[ra * 16 + 4 * g + r];
                    { u32x2 gb2; gb2.x = pk2(acc[0], acc[1]); gb2.y = pk2(acc[2], acc[3]); *(u32x2*)(Gg + (size_t)u * 4096 + (tix * 64 + lane) * 4) = gb2; }
                }
            }
        }
    }
    __syncthreads();
#undef RW_STAGE_VARS
#undef RW_LOAD
}
__device__ __forceinline__ void phase_rwkv_seq(const Params& P, int l, unsigned char* smem, int wv) {
    ParamsPtr pp = PARAMS_PTR(P); PIN_S(pp); unsigned char* ws = pp->ws; int bidx = (int)blockIdx.x, gdim = (int)gridDim.x; PIN_S(bidx); PIN_S(gdim);
    const bf16_t* Ag = (const bf16_t*)(ws + O_RA); const bf16_t* Gg = (const bf16_t*)(ws + O_RG); bf16_t* Sg = (bf16_t*)(ws + O_RS);
    const int tid = phase_tid(wv), lane = tid & 63, wave = tid >> 6, col = lane & 15, g = lane >> 4;
    const int gw = wave * gdim + bidx, ngw = NWAVES * gdim;
    for (int un = gw; un < 2 * NB * RH * 2; un += ngw) {
        const int ch = un >> 1, eh = un & 1;
        f32x4 acc[4][2];
#pragma unroll
        for (int a_ = 0; a_ < 4; ++a_)
#pragma unroll
            for (int b_ = 0; b_ < 2; ++b_) acc[a_][b_] = (f32x4){0.f, 0.f, 0.f, 0.f};
        u32x2 alo[4][2], ahi[4][2]; u32x2 gq[4][2];
        const unsigned aoff = (unsigned)(col * 64 + 4 * g), goff = (unsigned)(lane * 4);
#define RS_LOAD(cc) do { const bf16_t* ab_ = Ag + (size_t)(ch * RNC + (cc)) * 4096; const bf16_t* gb_ = Gg + (size_t)(ch * RNC + (cc)) * 4096 + eh * 512; \
            _Pragma("unroll") for (int ra = 0; ra < 4; ++ra) _Pragma("unroll") for (int p = 0; p < 2; ++p) { alo[ra][p] = *(const u32x2*)(ab_ + ((2 * p * 4 + ra) * 256) + goff); ahi[ra][p] = *(const u32x2*)(ab_ + (((2 * p + 1) * 4 + ra) * 256) + goff); } \
            _Pragma("unroll") for (int ra = 0; ra < 4; ++ra) _Pragma("unroll") for (int cb = 0; cb < 2; ++cb) gq[ra][cb] = *(const u32x2*)(gb_ + ((ra * 4 + cb) * 256) + goff); } while (0)
        RS_LOAD(0);
#pragma unroll 1
        for (int c = 0; c < RNC; ++c) {
            bf16_t* sb_ = Sg + (size_t)(ch * RNC + c) * 4096 + eh * 2048;
            bf16x8 bq[2][2];
#pragma unroll
            for (int cb = 0; cb < 2; ++cb) {
#pragma unroll
                for (int ra = 0; ra < 4; ++ra) {
                    u32x2 w2; w2.x = pk2(acc[ra][cb][0], acc[ra][cb][1]); w2.y = pk2(acc[ra][cb][2], acc[ra][cb][3]);
                    *(u32x2*)(sb_ + (cb * 1024 + ra * 16) + aoff) = w2;
                }
#pragma unroll
                for (int p = 0; p < 2; ++p) bq[p][cb] = cvt8(acc[2 * p][cb], acc[2 * p + 1][cb]);
            }
            u32x4 af[4][2];
#pragma unroll
            for (int ra = 0; ra < 4; ++ra) {
#pragma unroll
                for (int p = 0; p < 2; ++p) af[ra][p] = (u32x4){alo[ra][p].x, alo[ra][p].y, ahi[ra][p].x, ahi[ra][p].y};
#pragma unroll
                for (int cb = 0; cb < 2; ++cb) acc[ra][cb] = (f32x4){bf_lo(gq[ra][cb].x), bf_hi(gq[ra][cb].x), bf_lo(gq[ra][cb].y), bf_hi(gq[ra][cb].y)};
            }
            if (c + 1 < RNC) RS_LOAD(c + 1);
#pragma unroll
            for (int ra = 0; ra < 4; ++ra)
#pragma unroll
                for (int cb = 0; cb < 2; ++cb)
#pragma unroll
                    for (int p = 0; p < 2; ++p) acc[ra][cb] = MFMA16(__builtin_bit_cast(bf16x8, af[ra][p]), bq[p][cb], acc[ra][cb]);
        }
#undef RS_LOAD
    }
}
__device__ __forceinline__ void phase_rwkv_out(const Params& P, int l, unsigned char* smem, int wv) {
    ParamsPtr pp = PARAMS_PTR(P); PIN_S(pp); unsigned char* ws = pp->ws; int bidx = (int)blockIdx.x, gdim = (int)gridDim.x; PIN_S(bidx); PIN_S(gdim);
    const bf16_t* Qg = (const bf16_t*)(ws + O_RQ); const bf16_t* Sg = (const bf16_t*)(ws + O_RS); const bf16_t* Hg = (const bf16_t*)(ws + O_RH);
    const bf16_t* VB = (const bf16_t*)(ws + O_VB); const float* GATE = (const float*)(ws + O_GATE); const float* BONUS = (const float*)(ws + O_BONUS);
    bf16_t* GRP = (bf16_t*)(ws + O_GRP);
    const float* rln_g = pp->in[15] + (size_t)l * RW; const float* rln_b = pp->in[16] + (size_t)l * RW;
    const int tid = phase_tid(wv), lane = tid & 63, wave = tid >> 6, col = lane & 15, g = lane >> 4;
    for (int pu = bidx * NWAVES + wave; pu < NB * RH * RNC; pu += gdim * NWAVES) {
        const int c = pu % RNC, h = (pu / RNC) % RH, b = pu / (RNC * RH);
        f32x4 o[2][4][4];
#pragma unroll
        for (int d = 0; d < 2; ++d) {
            const int u = ((d * NB + b) * RH + h) * RNC + (d ? RNC - 1 - c : c);
            const size_t ub = (size_t)u * 4096;
            bf16x8 qa[4][2], sb[4][2];
#pragma unroll
            for (int q = 0; q < 4; ++q)
#pragma unroll
                for (int ks = 0; ks < 2; ++ks) {
                    const u32x2 q0 = *(const u32x2*)(Qg + ub + ((2 * ks * 4 + q) * 64 + lane) * 4), q1 = *(const u32x2*)(Qg + ub + (((2 * ks + 1) * 4 + q) * 64 + lane) * 4);
                    qa[q][ks] = __builtin_bit_cast(bf16x8, (u32x4){q0.x, q0.y, q1.x, q1.y});
                    const bf16_t* sp_ = Sg + ub + (q * 16 + col) * 64 + ks * 32 + 4 * g;
                    const u32x2 s0_ = *(const u32x2*)sp_, s1_ = *(const u32x2*)(sp_ + 16);
                    sb[q][ks] = __builtin_bit_cast(bf16x8, (u32x4){s0_.x, s0_.y, s1_.x, s1_.y});
                }
#pragma unroll
            for (int tt = 0; tt < 4; ++tt)
#pragma unroll
                for (int et = 0; et < 4; ++et) {
                    const u32x2 hb = *(const u32x2*)(Hg + ub + ((tt * 4 + et) * 64 + lane) * 4);
                    f32x4 acc = (f32x4){bf_lo(hb.x), bf_hi(hb.x), bf_lo(hb.y), bf_hi(hb.y)};
#pragma unroll
                    for (int ks = 0; ks < 2; ++ks) acc = MFMA16(qa[tt][ks], sb[et][ks], acc);
                    o[d][tt][et] = acc;
                }
        }
        const int src = (3 - g) * 16 + col;
#pragma unroll
        for (int tt = 0; tt < 4; ++tt)
#pragma unroll
            for (int et = 0; et < 4; ++et)
#pragma unroll
                for (int r = 0; r < 4; ++r) o[0][tt][et][r] += SHL(o[1][3 - tt][et][3 - r], src);
        float* tile = (float*)smem + wave * (64 * 68);
        WAVE_SYNC();
#pragma unroll
        for (int tt = 0; tt < 4; ++tt)
#pragma unroll
            for (int et = 0; et < 4; ++et)
#pragma unroll
                for (int r = 0; r < 4; ++r) tile[(tt * 16 + 4 * g + r) * 68 + et * 16 + col] = o[0][tt][et][r];
        WAVE_SYNC();
        {
            const int c4 = (lane & 15) * 4, ch = h * 64 + c4;
            const f32x4 lg = *(const f32x4*)(rln_g + ch), lb = *(const f32x4*)(rln_b + ch);
#pragma unroll 1
            for (int qb = 0; qb < 2; ++qb) {
                f32x4 gt_[8]; u32x2 vb_[8]; float bo_[8];
#pragma unroll
                for (int q8 = 0; q8 < 8; ++q8) {
                    const size_t t = (size_t)(b * S + c * RC + (qb * 8 + q8) * 4 + (lane >> 4));
                    gt_[q8] = *(const f32x4*)(GATE + t * RW + ch); vb_[q8] = *(const u32x2*)(VB + t * RW + ch); bo_[q8] = BONUS[t * RH + h];
                }
#pragma unroll
                for (int q8 = 0; q8 < 8; ++q8) {
                    const int tl = (qb * 8 + q8) * 4 + (lane >> 4);
                    const size_t t = (size_t)(b * S + c * RC + tl);
                    const f32x4 x = *(const f32x4*)(tile + tl * 68 + c4);
                    const float mean = row16_sum((x.x + x.y) + (x.z + x.w)) * (1.0f / 64.0f);
                    const f32x4 dl = x - mean;
                    const float var = row16_sum((dl.x * dl.x + dl.y * dl.y) + (dl.z * dl.z + dl.w * dl.w)) * (1.0f / 64.0f);
                    const float rstd = 1.0f / sqrtf(var + GN_EPS);
                    f32x4 y = dl * rstd * lg + lb;
                    y.x += bo_[q8] * bf_lo(vb_[q8].x); y.y += bo_[q8] * bf_hi(vb_[q8].x); y.z += bo_[q8] * bf_lo(vb_[q8].y); y.w += bo_[q8] * bf_hi(vb_[q8].y);
                    y = y * gt_[q8];
                    u32x2 ob; ob.x = pk2(y.x, y.y); ob.y = pk2(y.z, y.w);
                    *(u32x2*)(GRP + t * D + GW + ch) = ob;
                }
            }
        }
    }
    __syncthreads();
}

__device__ __forceinline__ void phase_mlstm_local(const Params& P, int l, unsigned char* smem, int wv, int bid, int nb) {
    PIN_S(bid); PIN_S(nb);
    ParamsPtr pp = PARAMS_PTR(P); PIN_S(pp); unsigned char* ws = pp->ws;
    const bf16_t* KT = (const bf16_t*)(ws + O_KT); const bf16_t* VT = (const bf16_t*)(ws + O_VT);
    const float* IG = (const float*)(ws + O_IG); const float* LF = (const float*)(ws + O_LF);
    float* CL = (float*)(ws + O_CL); float* NLb = (float*)(ws + O_NL); float* ML = (float*)(ws + O_ML); float* BL = (float*)(ws + O_BL);
    float* GVT = (float*)(ws + O_GVT); float* PMX = (float*)(ws + O_PMX); float* BCT = (float*)(ws + O_BCT);
    const int tid = phase_tid(wv), lane = tid & 63, wave = tid >> 6, col = lane & 15, g = lane >> 4;
    float* wts = (float*)smem + wave * 128;
    for (int u = bid * NWAVES + wave; u < 2 * NB * MH * NCH; u += nb * NWAVES) {
        const int c = u % NCH, h = (u / NCH) % MH, p = u / (NCH * MH), d = p / NB, b = p % NB;
        const int tc = d ? NCH - 1 - c : c, tok0 = b * S + tc * CH;
        const int i0 = d ? 127 - 2 * lane : 2 * lane, i1 = d ? i0 - 1 : i0 + 1;
        const size_t g0 = ((size_t)d * T + tok0 + i0) * MH + h, g1 = ((size_t)d * T + tok0 + i1) * MH + h;
        const float lf0 = LF[g0], lf1 = LF[g1], ig0 = IG[g0], ig1 = IG[g1];
        const float c1 = lf0 + lf1;
        float incl = c1;
#pragma unroll
        for (int o = 1; o < 64; o <<= 1) { const float tq = SHUP(incl, o, lane); if (lane >= o) incl += tq; }
        const float excl = incl - c1, bc0 = excl + lf0, bc1 = incl;
        const float blast = RDL(incl, 63);
        const float gv0 = ig0 - bc0, gv1 = ig1 - bc1, pl1 = fmaxf(gv0, gv1);
        float mincl = pl1;
#pragma unroll
        for (int o = 1; o < 64; o <<= 1) { const float tq = SHUP(mincl, o, lane); if (lane >= o) mincl = fmaxf(mincl, tq); }
        float mexcl = SHUP(mincl, 1, lane); if (lane == 0) mexcl = -INFINITY;
        const float pm0 = fmaxf(mexcl, gv0), pm1 = mincl;
        const float mloc = blast + RDL(mincl, 63);
        WAVE_SYNC();
        wts[i0] = fexp(blast + gv0 - mloc); wts[i1] = fexp(blast + gv1 - mloc);
        GVT[g0] = gv0; GVT[g1] = gv1; PMX[g0] = pm0; PMX[g1] = pm1; BCT[g0] = bc0; BCT[g1] = bc1;
        if (lane == 0) { ML[u] = mloc; BL[u] = blast; }
        WAVE_SYNC();
        const bf16_t* vbase = VT + ((size_t)(b * MH + h) * 64) * S + (size_t)tc * CH;
        const bf16_t* kbase = KT + ((size_t)(b * MH + h) * 64) * S + (size_t)tc * CH;
        const unsigned loff = (unsigned)(col * S + 8 * g);
        f32x4 acc[4][4];
#pragma unroll
        for (int a_ = 0; a_ < 4; ++a_)
#pragma unroll
            for (int b_ = 0; b_ < 4; ++b_) acc[a_][b_] = (f32x4){0.f, 0.f, 0.f, 0.f};
        float nsum[4] = {0.f, 0.f, 0.f, 0.f};
#pragma unroll 1
        for (int ks = 0; ks < 4; ++ks) {
            const int ii = ks * 32 + 8 * g;
            const f32x4 w0 = *(const f32x4*)(wts + ii), w1 = *(const f32x4*)(wts + ii + 4);
            bf16x8 af[4], bfk[4];
#pragma unroll
            for (int q = 0; q < 4; ++q) af[q] = *(const bf16x8*)(vbase + ((size_t)q * 16 * S + ks * 32) + loff);
#pragma unroll
            for (int q = 0; q < 4; ++q) {
                const u32x4 kr = *(const u32x4*)(kbase + ((size_t)q * 16 * S + ks * 32) + loff);
                f32x4 k0, k1;
                k0.x = bf_lo(kr.x) * w0.x; k0.y = bf_hi(kr.x) * w0.y; k0.z = bf_lo(kr.y) * w0.z; k0.w = bf_hi(kr.y) * w0.w;
                k1.x = bf_lo(kr.z) * w1.x; k1.y = bf_hi(kr.z) * w1.y; k1.z = bf_lo(kr.w) * w1.z; k1.w = bf_hi(kr.w) * w1.w;
                nsum[q] += (k0.x + k0.y) + (k0.z + k0.w) + (k1.x + k1.y) + (k1.z + k1.w);
                bfk[q] = cvt8(k0, k1);
            }
#pragma unroll
            for (int a_ = 0; a_ < 4; ++a_)
#pragma unroll
                for (int b_ = 0; b_ < 4; ++b_) acc[a_][b_] = MFMA16(af[a_], bfk[b_], acc[a_][b_]);
        }
        float* cbase = CL + (size_t)u * 4096;
        const unsigned coff = (unsigned)(4 * g * 64 + col);
#pragma unroll
        for (int b_ = 0; b_ < 4; ++b_) {
#pragma unroll
            for (int a_ = 0; a_ < 4; ++a_)
#pragma unroll
                for (int r = 0; r < 4; ++r) cbase[(a_ * 16 * 64 + r * 64 + b_ * 16) + coff] = acc[a_][b_][r];
            float ns = nsum[b_]; ns += SHX(ns, 16, lane); ns += SHX(ns, 32, lane);
            if (g == 0) NLb[(size_t)u * 64 + b_ * 16 + col] = ns;
        }
    }
    __syncthreads();
}

__device__ __forceinline__ void phase_mlstm_carry(const Params& P, int l, unsigned char* smem, int wv) {
    ParamsPtr pp = PARAMS_PTR(P); PIN_S(pp); unsigned char* ws = pp->ws; int bidx = (int)blockIdx.x, gdim = (int)gridDim.x; PIN_S(bidx); PIN_S(gdim);
    float* CL = (float*)(ws + O_CL); float* NLb = (float*)(ws + O_NL); const float* ML = (const float*)(ws + O_ML); const float* BL = (const float*)(ws + O_BL);
    float* MIN = (float*)(ws + O_MIN);
    const int total = 2 * NB * MH * 4160;
    const int tid = phase_tid(wv);
    for (int gi = bidx * NTHREADS + tid; gi < total; gi += gdim * NTHREADS) {
        const int ph = gi / 4160, e = gi % 4160;
        float* base_ = e < 4096 ? CL + (size_t)ph * NCH * 4096 + e : NLb + (size_t)ph * NCH * 64 + (e - 4096);
        const int stride = e < 4096 ? 4096 : 64;
        static_assert(NCH <= 32, "carry scan keeps one chunk value per register");
        float loc[NCH], bl[NCH], ml[NCH];
#pragma unroll
        for (int c = 0; c < NCH; ++c) { loc[c] = base_[(size_t)c * stride]; bl[c] = BL[ph * NCH + c]; ml[c] = ML[ph * NCH + c]; }
        float m = 0.f, val = 0.f;
#pragma unroll
        for (int c = 0; c < NCH; ++c) {
            base_[(size_t)c * stride] = val;
            if (e == 0) MIN[ph * NCH + c] = m;
            const float mn = fmaxf(bl[c] + m, ml[c]);
            val = fexp(bl[c] + m - mn) * val + fexp(ml[c] - mn) * loc[c];
            m = mn;
        }
    }
}

__device__ __forceinline__ void phase_mlstm_out(const Params& P, int l, unsigned char* smem, int wv) {
    ParamsPtr pp = PARAMS_PTR(P); PIN_S(pp); unsigned char* ws = pp->ws; int bidx = (int)blockIdx.x, gdim = (int)gridDim.x; PIN_S(bidx); PIN_S(gdim);
    const bf16_t* proj = (const bf16_t*)(ws + O_PROJ);
    const bf16_t* MQB = (const bf16_t*)(ws + O_MQB); const bf16_t* MKB = (const bf16_t*)(ws + O_MKB); const bf16_t* VT = (const bf16_t*)(ws + O_VT);
    const float* GVT = (const float*)(ws + O_GVT); const float* PMX = (const float*)(ws + O_PMX); const float* BCT = (const float*)(ws + O_BCT);
    const float* CL = (const float*)(ws + O_CL); const float* NLb = (const float*)(ws + O_NL); const float* MIN = (const float*)(ws + O_MIN);
    bf16_t* GRP = (bf16_t*)(ws + O_GRP);
    const float* mln_g = pp->in[20] + (size_t)l * MW;
    const int tid = phase_tid(wv), lane = tid & 63, wave = tid >> 6, col = lane & 15, g = lane >> 4;
    constexpr int KP = 72, VP = 136;
    bf16_t* Ks = (bf16_t*)smem;
    bf16_t* Vs = Ks + 128 * KP;
    float* gvs_ = (float*)(Vs + 64 * VP);
    for (int u = bidx; u < NB * MH * NCH; u += gdim) {
        const int tc = u % NCH, h = (u / NCH) % MH, b = u / (NCH * MH);
        const int tok0 = b * S + tc * CH, it = wave * 16 + col;
        __syncthreads();
        {
            u32x4 kb_[2], vb_[2];
#pragma unroll
            for (int q = 0; q < 2; ++q) {
                const int idx = tid + q * NTHREADS;
                kb_[q] = *(const u32x4*)(MKB + (size_t)(tok0 + (idx >> 3)) * MW + h * 64 + (idx & 7) * 8);
                vb_[q] = *(const u32x4*)(VT + ((size_t)(b * MH + h) * 64 + (idx >> 4)) * S + (size_t)tc * CH + (idx & 15) * 8);
            }
            float gq_ = 0.f;
            if (tid < 256) gq_ = GVT[((size_t)(tid >> 7) * T + tok0 + (tid & 127)) * MH + h];
#pragma unroll
            for (int q = 0; q < 2; ++q) {
                const int idx = tid + q * NTHREADS;
                *(u32x4*)(Ks + (idx >> 3) * KP + (idx & 7) * 8) = kb_[q];
                *(u32x4*)(Vs + (idx >> 4) * VP + (idx & 15) * 8) = vb_[q];
            }
            if (tid < 256) gvs_[tid] = gq_;
        }
        __syncthreads();
        const size_t trow = (size_t)(tok0 + it);
        bf16x8 bq[2];
#pragma unroll
        for (int ks = 0; ks < 2; ++ks) bq[ks] = *(const bf16x8*)(MQB + trow * MW + h * 64 + ks * 32 + 8 * g);
        f32x4 hs[4];
#pragma unroll
        for (int et = 0; et < 4; ++et) hs[et] = (f32x4){0.f, 0.f, 0.f, 0.f};
#pragma unroll
        for (int d = 0; d < 2; ++d) {
            const int cd = d ? NCH - 1 - tc : tc;
            const int su = ((d * NB + b) * MH + h) * NCH + cd;
            const size_t gt = ((size_t)d * T + trow) * MH + h;
            const float mst = MIN[su];
            const float mxt = fmaxf(PMX[gt], mst), mt = BCT[gt] + mxt, wint = fexp(mst - mxt);
            f32x4 num[4];
#pragma unroll
            for (int et = 0; et < 4; ++et) num[et] = (f32x4){0.f, 0.f, 0.f, 0.f};
            float den = 0.f;
            for (int sp = 0; sp < 4; ++sp) {
                if (d == 0 ? (2 * sp > wave) : (2 * sp + 1 < wave)) continue;
                float pw[8];
#pragma unroll
                for (int hf = 0; hf < 2; ++hf) {
                    const int st = 2 * sp + hf;
                    f32x4 sacc = (f32x4){0.f, 0.f, 0.f, 0.f};
#pragma unroll
                    for (int ks = 0; ks < 2; ++ks) sacc = MFMA16(*(const bf16x8*)(Ks + (st * 16 + col) * KP + ks * 32 + 8 * g), bq[ks], sacc);
                    const f32x4 g4 = *(const f32x4*)(gvs_ + d * 128 + st * 16 + 4 * g);
#pragma unroll
                    for (int r = 0; r < 4; ++r) {
                        const int is = st * 16 + 4 * g + r;
                        const bool ok = d == 0 ? (is <= it) : (is >= it);
                        const float pr = ok ? sacc[r] * fexp(g4[r] - mxt) : 0.f;
                        den += pr; pw[hf * 4 + r] = pr;
                    }
                }
                u32x4 pb; pb.x = pk2(pw[0], pw[1]); pb.y = pk2(pw[2], pw[3]); pb.z = pk2(pw[4], pw[5]); pb.w = pk2(pw[6], pw[7]);
                const bf16x8 bp = __builtin_bit_cast(bf16x8, pb);
#pragma unroll
                for (int et = 0; et < 4; ++et) {
                    const bf16_t* vp = Vs + (et * 16 + col) * VP + sp * 32 + 4 * g;
                    const u32x2 v0 = *(const u32x2*)vp, v1 = *(const u32x2*)(vp + 16);
                    u32x4 va; va.x = v0.x; va.y = v0.y; va.z = v1.x; va.w = v1.y;
                    num[et] = MFMA16(__builtin_bit_cast(bf16x8, va), bp, num[et]);
                }
            }
            den += SHX(den, 16, lane); den += SHX(den, 32, lane);
            f32x4 qc[4]; float qn = 0.f;
#pragma unroll
            for (int ks = 0; ks < 2; ++ks) {
                const float* np = NLb + (size_t)su * 64 + ks * 32 + 8 * g;
                const f32x4 n0 = *(const f32x4*)np, n1 = *(const f32x4*)(np + 4);
                const u32x4 qb = __builtin_bit_cast(u32x4, bq[ks]);
                qn += (bf_lo(qb.x) * n0.x + bf_hi(qb.x) * n0.y) + (bf_lo(qb.y) * n0.z + bf_hi(qb.y) * n0.w) + (bf_lo(qb.z) * n1.x + bf_hi(qb.z) * n1.y) + (bf_lo(qb.w) * n1.z + bf_hi(qb.w) * n1.w);
            }
            qn += SHX(qn, 16, lane); qn += SHX(qn, 32, lane);
#pragma unroll
            for (int et = 0; et < 4; ++et) {
                qc[et] = (f32x4){0.f, 0.f, 0.f, 0.f};
#pragma unroll
                for (int ks = 0; ks < 2; ++ks) {
                    const float* cp = CL + (size_t)su * 4096 + (size_t)(et * 16 + col) * 64 + ks * 32 + 8 * g;
                    qc[et] = MFMA16(cvt8(*(const f32x4*)cp, *(const f32x4*)(cp + 4)), bq[ks], qc[et]);
                }
            }
            const float dd = frcp(fmaxf(fabsf(den + wint * qn), fexp(-mt)));
#pragma unroll
            for (int et = 0; et < 4; ++et) hs[et] += (num[et] + wint * qc[et]) * dd;
        }
        float sm = 0.f;
#pragma unroll
        for (int et = 0; et < 4; ++et) sm += (hs[et].x + hs[et].y) + (hs[et].z + hs[et].w);
        sm += SHX(sm, 16, lane); sm += SHX(sm, 32, lane);
        const float mean = sm * (1.0f / 64.0f); float q = 0.f;
#pragma unroll
        for (int et = 0; et < 4; ++et) { const f32x4 dl = hs[et] - mean; q += (dl.x * dl.x + dl.y * dl.y) + (dl.z * dl.z + dl.w * dl.w); }
        q += SHX(q, 16, lane); q += SHX(q, 32, lane);
        const float rstd = 1.0f / sqrtf(q * (1.0f / 64.0f) + LN_EPS);
#pragma unroll
        for (int et = 0; et < 4; ++et) {
            const int c = h * 64 + et * 16 + 4 * g;
            const u32x2 ob_ = *(const u32x2*)(proj + trow * PLD + C_MW + 3 * MW + c); const f32x4 o4 = (f32x4){bf_lo(ob_.x), bf_hi(ob_.x), bf_lo(ob_.y), bf_hi(ob_.y)}, g4 = *(const f32x4*)(mln_g + c);
            const f32x4 y = (hs[et] - mean) * rstd * g4;
            u32x2 ob; ob.x = pk2(sigmoidf_(o4.x) * y.x, sigmoidf_(o4.y) * y.y); ob.y = pk2(sigmoidf_(o4.z) * y.z, sigmoidf_(o4.w) * y.w);
            *(u32x2*)(GRP + trow * D + GW + RW + c) = ob;
        }
    }
    __syncthreads();
}

__device__ __forceinline__ void phase_rwkv_post(const Params& P, int l, unsigned char* smem, int wv) {
    ParamsPtr pp = PARAMS_PTR(P); PIN_S(pp); unsigned char* ws = pp->ws; int bidx = (int)blockIdx.x, gdim = (int)gridDim.x; PIN_S(bidx); PIN_S(gdim);
    const float* SCAN = (const float*)(ws + O_SCAN); const float* VV = (const float*)(ws + O_VV); const float* GATE = (const float*)(ws + O_GATE);
    const float* BONUS = (const float*)(ws + O_BONUS); bf16_t* GRP = (bf16_t*)(ws + O_GRP);
    const float* rln_g = pp->in[15] + (size_t)l * RW; const float* rln_b = pp->in[16] + (size_t)l * RW;
    const int tid = phase_tid(wv), lane = tid & 63, wave = tid >> 6;
    const int gw = bidx * NWAVES + wave, ngw = NWAVES * gdim;
    for (int it = gw; it < T * RH; it += ngw) {
        const int t = it / RH, h = it % RH, c = h * 64 + lane;
        const size_t o = (size_t)t * RW + c;
        const float x = SCAN[o] + SCAN[(size_t)T * RW + o];
        const float mean = wave_sum(x, lane) * (1.0f / 64.0f);
        const float dl = x - mean;
        const float var = wave_sum(dl * dl, lane) * (1.0f / 64.0f);
        float y = dl / sqrtf(var + GN_EPS) * rln_g[c] + rln_b[c];
        y += BONUS[(size_t)t * RH + h] * VV[o];
        GRP[(size_t)t * D + GW + c] = (bf16_t)f2bf(y * GATE[o]);
    }
}

__device__ __forceinline__ void phase_ln1_router(const Params& P, int l, unsigned char* smem, int wv) {
    ParamsPtr pp = PARAMS_PTR(P); PIN_S(pp); unsigned char* ws = pp->ws; int bidx = (int)blockIdx.x, gdim = (int)gridDim.x; PIN_S(bidx); PIN_S(gdim);
    const float* xin = l == 0 ? pp->in[0] : (const float*)(ws + O_XA);
    const bf16_t* MIX = (const bf16_t*)(ws + O_MIX); float* X1 = (float*)(ws + O_X1);
    int* TOPI = (int*)(ws + O_TOPI); float* TOPG = (float*)(ws + O_TOPG); int* RANK = (int*)(ws + O_RANK); bf16_t* X1B = (bf16_t*)(ws + O_X1B);
    int* BCNT = (int*)(ws + O_BCNT);
    const float* g1 = pp->in[22] + (size_t)l * D; const float* b1 = pp->in[23] + (size_t)l * D;
    const float* rw = pp->in[24] + (size_t)l * D * NE; const float* rb = pp->in[25] + (size_t)l * NE;
    const bf16_t* RWT = (const bf16_t*)(ws + O_RWT) + (size_t)l * 2 * NE * D;
    const int tid = phase_tid(wv), lane = tid & 63, wave = tid >> 6, col = lane & 15, g = lane >> 4;
    float* lgs = (float*)smem;
    int* stopi = (int*)(smem + 8192);
    for (int tile = bidx; tile < T / 64; tile += gdim) {
        __syncthreads();
        {
            f32x4 xa[4]; u32x2 xm[4];
#define LN1_LOAD(tt_) do { _Pragma("unroll") for (int j = 0; j < 4; ++j) { const int c = j * 256 + lane * 4; xa[j] = *(const f32x4*)(xin + (size_t)(tt_) * D + c); xm[j] = *(const u32x2*)(MIX + (size_t)(tt_) * D + c); } } while (0)
            LN1_LOAD(tile * 64 + wave * 8);
#pragma unroll 1
            for (int ti8 = 0; ti8 < 8; ++ti8) {
                const int t = tile * 64 + wave * 8 + ti8;
                float v[16]; float sm = 0.f;
#pragma unroll
                for (int j = 0; j < 4; ++j) {
                    v[j * 4 + 0] = ALPHA * xa[j].x + bf_lo(xm[j].x); v[j * 4 + 1] = ALPHA * xa[j].y + bf_hi(xm[j].x); v[j * 4 + 2] = ALPHA * xa[j].z + bf_lo(xm[j].y); v[j * 4 + 3] = ALPHA * xa[j].w + bf_hi(xm[j].y);
                    sm += (v[j * 4] + v[j * 4 + 1]) + (v[j * 4 + 2] + v[j * 4 + 3]);
                }
                if (ti8 < 7) LN1_LOAD(t + 1);
                const float mean = wave_sum_fast(sm, lane) * (1.0f / D); float q = 0.f;
#pragma unroll
                for (int j = 0; j < 16; ++j) { const float dl = v[j] - mean; q += dl * dl; }
                const float rstd = 1.0f / sqrtf(wave_sum_fast(q, lane) * (1.0f / D) + LN_EPS);
#pragma unroll
                for (int j = 0; j < 4; ++j) {
                    const int c = j * 256 + lane * 4;
                    const f32x4 gg = *(const f32x4*)(g1 + c), bb = *(const f32x4*)(b1 + c);
                    f32x4 o;
                    o.x = (v[j * 4 + 0] - mean) * rstd * gg.x + bb.x; o.y = (v[j * 4 + 1] - mean) * rstd * gg.y + bb.y;
                    o.z = (v[j * 4 + 2] - mean) * rstd * gg.z + bb.z; o.w = (v[j * 4 + 3] - mean) * rstd * gg.w + bb.w;
                    *(f32x4*)(X1 + (size_t)t * D + c) = o;
                    u32x2 ob; ob.x = pk2(o.x, o.y); ob.y = pk2(o.z, o.w); *(u32x2*)(X1B + (size_t)t * D + c) = ob;
                }
            }
#undef LN1_LOAD
        }
        __syncthreads();
        {
            const float* xr = X1 + (size_t)(tile * 64 + (wave >> 1) * 16 + col) * D + 8 * g;
            const bf16_t* wh = RWT + (size_t)((wave & 1) * 16 + col) * D + 8 * g; const bf16_t* wl = wh + (size_t)NE * D;
            f32x4 acc = (f32x4){0.f, 0.f, 0.f, 0.f};
#pragma unroll 4
            for (int ks = 0; ks < 32; ++ks) {
                const f32x4 x0 = *(const f32x4*)(xr + ks * 32), x1 = *(const f32x4*)(xr + ks * 32 + 4);
                const bf16x8 bh = *(const bf16x8*)(wh + ks * 32), bl = *(const bf16x8*)(wl + ks * 32);
                const bf16x8 ah = cvt8(x0, x1);
                const u32x4 ahu = __builtin_bit_cast(u32x4, ah);
                f32x4 r0, r1;
                r0.x = x0.x - bf_lo(ahu.x); r0.y = x0.y - bf_hi(ahu.x); r0.z = x0.z - bf_lo(ahu.y); r0.w = x0.w - bf_hi(ahu.y);
                r1.x = x1.x - bf_lo(ahu.z); r1.y = x1.y - bf_hi(ahu.z); r1.z = x1.z - bf_lo(ahu.w); r1.w = x1.w - bf_hi(ahu.w);
                const bf16x8 al = cvt8(r0, r1);
                acc = MFMA16(ah, bh, acc); acc = MFMA16(ah, bl, acc); acc = MFMA16(al, bh, acc);
            }
            const float rbv = rb[(wave & 1) * 16 + col];
#pragma unroll
            for (int r = 0; r < 4; ++r) lgs[((wave >> 1) * 16 + 4 * g + r) * NE + (wave & 1) * 16 + col] = acc[r] + rbv;
        }
        __syncthreads();
        if (tid < 64) {
            const float* lp = lgs + tid * NE; const int t = tile * 64 + tid;
            float tv[4]; int ti[4];
#pragma unroll
            for (int k = 0; k < 4; ++k) { tv[k] = -INFINITY; ti[k] = 0; }
            for (int e = 0; e < NE; ++e) {
                const float x = lp[e];
                if (x > tv[3]) {
                    if (x > tv[0]) { tv[3] = tv[2]; ti[3] = ti[2]; tv[2] = tv[1]; ti[2] = ti[1]; tv[1] = tv[0]; ti[1] = ti[0]; tv[0] = x; ti[0] = e; }
                    else if (x > tv[1]) { tv[3] = tv[2]; ti[3] = ti[2]; tv[2] = tv[1]; ti[2] = ti[1]; tv[1] = x; ti[1] = e; }
                    else if (x > tv[2]) { tv[3] = tv[2]; ti[3] = ti[2]; tv[2] = x; ti[2] = e; }
                    else { tv[3] = x; ti[3] = e; }
                }
            }
            const float e1 = expf(tv[1] - tv[0]), e2 = expf(tv[2] - tv[0]), e3 = expf(tv[3] - tv[0]);
            const float inv = 1.0f / (1.0f + e1 + e2 + e3);
            *(f32x4*)(TOPG + (size_t)t * 4) = (f32x4){inv, e1 * inv, e2 * inv, e3 * inv};
#pragma unroll
            for (int k = 0; k < 4; ++k) { TOPI[(size_t)t * 4 + k] = ti[k]; stopi[tid * 4 + k] = ti[k]; }
        }
        __syncthreads();
        if (tid < 256) { const int e = stopi[tid]; int r = 0; for (int a2 = 0; a2 < tid; ++a2) r += (stopi[a2] == e) ? 1 : 0; RANK[(size_t)tile * 256 + tid] = r; }
        else if (tid < 256 + NE) { const int e = tid - 256; int cnt = 0; for (int a2 = 0; a2 < 256; ++a2) cnt += (stopi[a2] == e) ? 1 : 0; BCNT[tile * NE + e] = cnt; }
    }
    __syncthreads();
}

__device__ __forceinline__ void moe_offsets(int* sh, const int* CNT, int tid) {
    if (tid == 0) {
        int acc = 0;
        for (int e = 0; e < NE; ++e) { const int c = (int)CNT[e]; sh[e] = c; sh[32 + e] = acc; acc += (c + MOEB - 1) / MOEB * MOEB; sh[64 + e] = acc; }
    }
    __syncthreads();
}
__device__ __forceinline__ int moe_expert_of_row(const int* sh, int r) {
    int e = -1;
    for (int i = 0; i < NE; ++i) if (r >= sh[32 + i] && r < sh[64 + i]) e = i;
    return e;
}

__device__ __forceinline__ void phase_scatter(const Params& P, int l, unsigned char* smem, int wv) {
    ParamsPtr pp = PARAMS_PTR(P); PIN_S(pp); unsigned char* ws = pp->ws; int bidx = (int)blockIdx.x, gdim = (int)gridDim.x; PIN_S(bidx); PIN_S(gdim);
    const int tid = phase_tid(wv);
    const int* TOPI = (const int*)(ws + O_TOPI); const int* RANK = (const int*)(ws + O_RANK); int* SLOT = (int*)(ws + O_SLOT); int* ROWT = (int*)(ws + O_ROWT);
    const int* BCNT = (const int*)(ws + O_BCNT); int* CNTF = (int*)(ws + O_CNTF);
    int* sh = (int*)smem;
    int* part = sh + 96;
    int* tot = part + 512;
    int* base = tot + 32;
    constexpr int NT = T / 64;
    const int e = tid & 31, pt = tid >> 5;
    { int sacc = 0; for (int tl = pt; tl < NT; tl += 16) sacc += BCNT[tl * NE + e]; part[pt * 32 + e] = sacc; }
    __syncthreads();
    if (tid < 32) { int sacc = 0; for (int q = 0; q < 16; ++q) sacc += part[q * 32 + tid]; tot[tid] = sacc; if (bidx == 0) CNTF[tid] = sacc; }
    __syncthreads();
    moe_offsets(sh, tot, tid);
    for (int ee = bidx; ee < NE; ee += gdim)
        for (int r = sh[32 + ee] + sh[ee] + tid; r < sh[64 + ee]; r += NTHREADS) ROWT[r] = 0;
    for (int tile = bidx; tile < NT; tile += gdim) {
        __syncthreads();
        { int sacc = 0; for (int tl = pt; tl < tile; tl += 16) sacc += BCNT[tl * NE + e]; part[pt * 32 + e] = sacc; }
        __syncthreads();
        if (tid < 32) { int sacc = sh[32 + tid]; for (int q = 0; q < 16; ++q) sacc += part[q * 32 + tid]; base[tid] = sacc; }
        __syncthreads();
        if (tid < 256) { const int a = tile * 256 + tid, dest = base[TOPI[a]] + RANK[a]; SLOT[a] = dest; ROWT[dest] = a >> 2; }
    }
    __syncthreads();
}

template <int WHICH>
__device__ __forceinline__ void phase_moe_gemm(const Params& P, int l, unsigned char* smem, int wv) {
    ParamsPtr pp = PARAMS_PTR(P); PIN_S(pp); unsigned char* ws = pp->ws; int bidx = (int)blockIdx.x, gdim = (int)gridDim.x; PIN_S(bidx); PIN_S(gdim);
    const int tid = phase_tid(wv);
    const int* CNT = (const int*)(ws + O_CNTF);
    int* sh = (int*)(smem + 131072);
    int* rbe = sh + 96;
    moe_offsets(sh, CNT, tid);
    const int nrb = sh[64 + NE - 1] / MOEB;
    for (int rb = tid; rb < nrb; rb += NTHREADS) rbe[rb] = moe_expert_of_row(sh, rb * MOEB);
    __syncthreads();
    pg8::MoeOrderT<WHICH == 1> S;
    S.K = 1024; S.G_ = gdim; S.c = bidx; S.rbe = rbe; S.rowmap = (const int*)(ws + O_ROWT);
    if (WHICH == 1) {
        S.A = (const char*)(ws + O_X1B); S.Wt = (const char*)(ws + O_W1) + (size_t)l * NE * 2 * DFF * D * 2; S.estride = (size_t)2 * DFF * D * 2; S.nN = 2 * DFF / 256; S.nwg = nrb * S.nN;
        pg8::EpiSwiglu E{(bf16_t*)(ws + O_ACT), pp->in[27] + (size_t)l * NE * 2 * DFF};
        pg8::gemm_phase<pg8::EpiSwiglu, pg8::MoeOrderT<WHICH == 1>>((LAS unsigned char*)smem, 1024, S, E, tid);
    } else {
        S.A = (const char*)(ws + O_ACT); S.Wt = (const char*)(ws + O_W2) + (size_t)l * NE * D * DFF * 2; S.estride = (size_t)D * DFF * 2; S.nN = D / 256; S.nwg = nrb * S.nN;
        pg8::EpiBf16Bias E{(bf16_t*)(ws + O_YS), D, pp->in[29] + (size_t)l * NE * D, D};
        pg8::gemm_phase<pg8::EpiBf16Bias, pg8::MoeOrderT<WHICH == 1>>((LAS unsigned char*)smem, 1024, S, E, tid);
    }
    __syncthreads();
}

__device__ __forceinline__ void phase_combine_ln2(const Params& P, int l, unsigned char* smem, int wv) {
    ParamsPtr pp = PARAMS_PTR(P); PIN_S(pp); unsigned char* ws = pp->ws; int bidx = (int)blockIdx.x, gdim = (int)gridDim.x; PIN_S(bidx); PIN_S(gdim);
    const float* X1 = (const float*)(ws + O_X1); const bf16_t* YS = (const bf16_t*)(ws + O_YS); bf16_t* XB = (bf16_t*)(ws + O_XB);
    const int* SLOT = (const int*)(ws + O_SLOT); const float* TOPG = (const float*)(ws + O_TOPG);
    float* xo = l == NL - 1 ? pp->out : (float*)(ws + O_XA);
    const float* g2 = pp->in[30] + (size_t)l * D; const float* b2 = pp->in[31] + (size_t)l * D;
    const int tid = phase_tid(wv), lane = tid & 63, wave = tid >> 6;
    const int gw = bidx * NWAVES + wave, ngw = NWAVES * gdim;
    u32x4 sl_n = (u32x4){0u, 0u, 0u, 0u}; f32x4 gg_n = (f32x4){0.f, 0.f, 0.f, 0.f};
    f32x4 xa_n[4]; u32x2 ys_n[4][4]; f32x4 gg_c = (f32x4){0.f, 0.f, 0.f, 0.f};
    const f32x4 lg[4] = {*(const f32x4*)(g2 + lane * 4), *(const f32x4*)(g2 + 256 + lane * 4), *(const f32x4*)(g2 + 512 + lane * 4), *(const f32x4*)(g2 + 768 + lane * 4)};
    const f32x4 lb[4] = {*(const f32x4*)(b2 + lane * 4), *(const f32x4*)(b2 + 256 + lane * 4), *(const f32x4*)(b2 + 512 + lane * 4), *(const f32x4*)(b2 + 768 + lane * 4)};
#define CB_META(tt_) do { sl_n = *(const u32x4*)(SLOT + (size_t)(tt_) * 4); gg_n = *(const f32x4*)(TOPG + (size_t)(tt_) * 4); } while (0)
#define CB_ROWS(tt_) do { _Pragma("unroll") for (int j = 0; j < 4; ++j) { const int c = j * 256 + lane * 4; xa_n[j] = *(const f32x4*)(X1 + (size_t)(tt_) * D + c); \
        ys_n[0][j] = *(const u32x2*)(YS + (size_t)sl_n.x * D + c); ys_n[1][j] = *(const u32x2*)(YS + (size_t)sl_n.y * D + c); ys_n[2][j] = *(const u32x2*)(YS + (size_t)sl_n.z * D + c); ys_n[3][j] = *(const u32x2*)(YS + (size_t)sl_n.w * D + c); } gg_c = gg_n; } while (0)
    if (gw < T) { CB_META(gw); CB_ROWS(gw); if (gw + ngw < T) CB_META(gw + ngw); }
    for (int t = gw; t < T; t += ngw) {
        float v[16]; float sm = 0.f;
        const float gk[4] = {gg_c.x, gg_c.y, gg_c.z, gg_c.w};
#pragma unroll
        for (int j = 0; j < 4; ++j) {
            const f32x4 a = xa_n[j];
            f32x4 y = (f32x4){0.f, 0.f, 0.f, 0.f};
#pragma unroll
            for (int k = 0; k < 4; ++k) { const u32x2 yk = ys_n[k][j]; y.x += gk[k] * bf_lo(yk.x); y.y += gk[k] * bf_hi(yk.x); y.z += gk[k] * bf_lo(yk.y); y.w += gk[k] * bf_hi(yk.y); }
            v[j * 4 + 0] = ALPHA * a.x + y.x; v[j * 4 + 1] = ALPHA * a.y + y.y; v[j * 4 + 2] = ALPHA * a.z + y.z; v[j * 4 + 3] = ALPHA * a.w + y.w;
            sm += (v[j * 4] + v[j * 4 + 1]) + (v[j * 4 + 2] + v[j * 4 + 3]);
        }
        if (t + ngw < T) { CB_ROWS(t + ngw); if (t + 2 * ngw < T) CB_META(t + 2 * ngw); }
        const float mean = wave_sum_fast(sm, lane) * (1.0f / D); float q = 0.f;
#pragma unroll
        for (int j = 0; j < 16; ++j) { const float dl = v[j] - mean; q += dl * dl; }
        const float rstd = 1.0f / sqrtf(wave_sum_fast(q, lane) * (1.0f / D) + LN_EPS);
#pragma unroll
        for (int j = 0; j < 4; ++j) {
            const int c = j * 256 + lane * 4;
            f32x4 o;
            o.x = (v[j * 4 + 0] - mean) * rstd * lg[j].x + lb[j].x; o.y = (v[j * 4 + 1] - mean) * rstd * lg[j].y + lb[j].y;
            o.z = (v[j * 4 + 2] - mean) * rstd * lg[j].z + lb[j].z; o.w = (v[j * 4 + 3] - mean) * rstd * lg[j].w + lb[j].w;
            *(f32x4*)(xo + (size_t)t * D + c) = o;
            if (l != NL - 1) { u32x2 ob; ob.x = pk2(o.x, o.y); ob.y = pk2(o.z, o.w); *(u32x2*)(XB + (size_t)t * D + c) = ob; }
        }
    }
#undef CB_META
#undef CB_ROWS
}

__device__ __forceinline__ void phase_inproj(const Params& P, int l, unsigned char* smem, int wv) {
    ParamsPtr pp = PARAMS_PTR(P); PIN_S(pp); unsigned char* ws = pp->ws; int bidx = (int)blockIdx.x, gdim = (int)gridDim.x; PIN_S(bidx); PIN_S(gdim);
    const int tid = phase_tid(wv);
    pg8::DenseOrder S; S.init(ws + O_XB, (const bf16_t*)(ws + O_WIN) + (size_t)l * PLD * D, T, PLD, D, gdim, bidx);
    pg8::EpiProj E{(bf16_t*)(ws + O_PROJ), PLD, (float*)(ws + O_PROJG), PLD / 256 - 1};
    pg8::gemm_phase<pg8::EpiProj, pg8::DenseOrder>((LAS unsigned char*)smem, D, S, E, tid);
    __syncthreads();
}
__device__ __forceinline__ void phase_outproj(const Params& P, int l, unsigned char* smem, int wv) {
    ParamsPtr pp = PARAMS_PTR(P); PIN_S(pp); unsigned char* ws = pp->ws; int bidx = (int)blockIdx.x, gdim = (int)gridDim.x; PIN_S(bidx); PIN_S(gdim);
    const int tid = phase_tid(wv);
    pg8::DenseOrder S; S.init(ws + O_GRP, (const bf16_t*)(ws + O_WOUT) + (size_t)l * D * D, T, D, D, gdim, bidx);
    pg8::EpiProj E{(bf16_t*)(ws + O_MIX), D, nullptr, -1};
    pg8::gemm_phase<pg8::EpiProj, pg8::DenseOrder>((LAS unsigned char*)smem, D, S, E, tid);
    __syncthreads();
}

#ifndef EMU
#define XB_TMO      128
#define XB_XCNT(j)  (256  + 64 * (j))
#define XB_XSUB(j)  (1280 + 64 * (j))
#define XB_XGEN(j)  (2304 + 64 * (j))
#define XB_TOP      3328
#define XB_TOPGEN   3392
#define XCD_BAR_WORDS 3456
#define XB_SPIN_CAP (1u << 25)
__device__ __forceinline__ unsigned xb_ld(unsigned* p)              { return __hip_atomic_load(p, __ATOMIC_RELAXED, __HIP_MEMORY_SCOPE_AGENT); }
__device__ __forceinline__ unsigned xb_add(unsigned* p, unsigned v) { return __hip_atomic_fetch_add(p, v, __ATOMIC_RELAXED, __HIP_MEMORY_SCOPE_AGENT); }
__device__ __forceinline__ unsigned xb_xcc_id() { return (unsigned)__builtin_amdgcn_s_getreg((3 << 11) | 20) & 0xFu; }
#define XB_SPIN(cond, bar) do { unsigned _sp = 0; while (cond) { __builtin_amdgcn_s_sleep(1); \
    if ((++_sp & 255u) == 0u) { if (xb_ld(&(bar)[XB_TMO])) break; if (_sp > XB_SPIN_CAP) { atomicAdd(&(bar)[XB_TMO], 1u); break; } } } } while (0)
struct XcdBarrier { unsigned* bar; unsigned x; volatile LAS unsigned* st; };
__device__ __forceinline__ XcdBarrier xcd_barrier_post(unsigned* bar, volatile LAS unsigned* st) {
    XcdBarrier b; b.bar = bar; b.x = xb_xcc_id(); b.st = st;
    if (threadIdx.x == 0) (void)xb_add(&bar[XB_XCNT(b.x)], 1u);
    return b;
}
__device__ __forceinline__ void xcd_barrier_complete(unsigned* bar, unsigned x, unsigned& nloc, unsigned& nx) {
    const unsigned G = gridDim.x * gridDim.y * gridDim.z;
    unsigned sum, cnt, mine, sp = 0u;
    for (;;) {
        sum = 0u; cnt = 0u; mine = 0u;
#pragma unroll
        for (unsigned j = 0; j < 16; ++j) { const unsigned c = xb_ld(&bar[XB_XCNT(j)]); sum += c; cnt += (c > 0u) ? 1u : 0u; mine = (j == x) ? c : mine; }
        if (sum == G) break;
        __builtin_amdgcn_s_sleep(1);
        if ((++sp & 255u) == 0u) { if (xb_ld(&bar[XB_TMO])) break; if (sp > XB_SPIN_CAP) { atomicAdd(&bar[XB_TMO], 1u); break; } }
    }
    nloc = mine > 0u ? mine : 1u; nx = cnt > 0u ? cnt : 1u;
}
__device__ __forceinline__ void xcd_barrier(const XcdBarrier& b) {
    asm volatile("s_waitcnt vmcnt(0)" ::: "memory");
    __syncthreads();
    if (threadIdx.x == 0) {
        unsigned* bar = b.bar;
        __builtin_amdgcn_s_waitcnt(0);
        unsigned nloc = b.st[0], nx = b.st[1];
        if (nloc == 0u) { xcd_barrier_complete(bar, b.x, nloc, nx); b.st[0] = nloc; b.st[1] = nx; }
        const unsigned old = xb_add(&bar[XB_XSUB(b.x)], 1u);
        const unsigned gen = old / nloc;
        if (old + 1u == (gen + 1u) * nloc) {
            __builtin_amdgcn_fence(__ATOMIC_RELEASE, "agent");
            asm volatile("s_waitcnt vmcnt(0)" ::: "memory");
            const unsigned og = xb_add(&bar[XB_TOP], 1u);
            const unsigned tg = og / nx;
            if (og + 1u == (tg + 1u) * nx) xb_add(&bar[XB_TOPGEN], 1u);
            else XB_SPIN(xb_ld(&bar[XB_TOPGEN]) == tg, bar);
            __builtin_amdgcn_fence(__ATOMIC_ACQUIRE, "agent");
            xb_add(&bar[XB_XGEN(b.x)], 1u);
            asm volatile("s_waitcnt vmcnt(0)" ::: "memory");
        } else {
            XB_SPIN(xb_ld(&bar[XB_XGEN(b.x)]) == gen, bar);
            __builtin_amdgcn_fence(__ATOMIC_ACQUIRE, "agent");
            asm volatile("s_waitcnt vmcnt(0)" ::: "memory");
        }
    }
    __syncthreads();
}
#endif

__global__ void __launch_bounds__(512, 2) mk_fwd(Params P) {
#ifdef EMU
    unsigned char* smem = g_blk->lds;
#else
    extern __shared__ __attribute__((aligned(16))) unsigned char smem[];
    volatile LAS unsigned* bst = (volatile LAS unsigned*)(smem + LDS_BYTES - 16);
    if (threadIdx.x == 0) { bst[0] = 0u; bst[1] = 0u; bst[2] = 0u; bst[3] = 0u; }
    __syncthreads();
    XcdBarrier bar; bar.bar = (unsigned*)P.ws + CW_BAR; bar.x = 0; bar.st = bst;
    if (P.ph_hi - P.ph_lo > 1) bar = xcd_barrier_post((unsigned*)P.ws + CW_BAR, bst);
#endif
    const int lo = P.ph_lo, hi = P.ph_hi;
#ifdef EMU
    const int wv = (int)threadIdx.x >> 6;
#else
    const int wv = RFL((int)threadIdx.x >> 6);
#endif
#ifdef EMU
#define SEAM(id) do {} while (0)
#else
#define SEAM(id) do { if ((id) + 1 < hi) xcd_barrier(bar); } while (0)
#endif
#ifndef MK_ONLY_PHASE
#define MK_ONLY_PHASE -1
#endif
#ifndef MK_DUP_MASK
#define MK_DUP_MASK 0
#endif
#define PHG(kc, id, ...) do { if (MK_ONLY_PHASE < 0 || MK_ONLY_PHASE == (kc)) { const int id_ = (id); if (id_ >= lo && id_ < hi) { if ((MK_DUP_MASK >> (kc)) & 1) { __VA_ARGS__; SEAM(id_ - 1); } __VA_ARGS__; SEAM(id_); } } } while (0)
#define PH(k, ...) PHG(1 + (k), 1 + l * NPH + (k), __VA_ARGS__)
    PHG(0, 0, phase_prologue(P, smem, wv));
    for (int l = 0; l < NL; ++l) {
        PH(0, phase_inproj(P, l, smem, wv));
        PH(1, phase_prep(P, l, smem, wv));
#if MK_RWKV_CHUNKED
        PH(2, { phase_rwkv_pre(P, l, smem, wv); phase_mlstm_local(P, l, smem, wv, (int)blockIdx.x, (int)gridDim.x); });
        PH(3, { phase_rwkv_seq(P, l, smem, wv); phase_mlstm_carry(P, l, smem, wv); });
        PH(4, { phase_rwkv_out(P, l, smem, wv); phase_mlstm_out(P, l, smem, wv); phase_gmlp_mix(P, l, smem, wv, (int)blockIdx.x, (int)gridDim.x); });
#else
        PH(2, { const int G_ = (int)gridDim.x, NSC = 2 * NB * RH * 4;
                if (G_ >= NSC + 32) { if ((int)blockIdx.x < NSC) phase_rwkv_scan(P, l, smem, wv, (int)blockIdx.x, NSC);
                                      else phase_mlstm_local(P, l, smem, wv, (int)blockIdx.x - NSC, G_ - NSC); }
                else { phase_rwkv_scan(P, l, smem, wv, (int)blockIdx.x, G_); phase_mlstm_local(P, l, smem, wv, (int)blockIdx.x, G_); } });
        PH(3, phase_mlstm_carry(P, l, smem, wv));
        PH(4, { phase_mlstm_out(P, l, smem, wv); phase_gmlp_mix(P, l, smem, wv, (int)blockIdx.x, (int)gridDim.x); phase_rwkv_post(P, l, smem, wv); });
#endif
        PH(5, phase_outproj(P, l, smem, wv));
        PH(6, phase_ln1_router(P, l, smem, wv));
        PH(7, phase_scatter(P, l, smem, wv));
        PH(8, phase_moe_gemm<1>(P, l, smem, wv));
        PH(9, phase_moe_gemm<2>(P, l, smem, wv));
        PH(10, phase_combine_ln2(P, l, smem, wv));
    }
#undef PHG
#undef PH
#undef SEAM
}

}

#ifndef EMU
extern "C" void kernel_launch(void* const* d_in, const int* in_sizes, int n_in, void* d_out, int out_size, void* d_ws, size_t ws_size, hipStream_t stream) {
    using namespace mk;
    static int grid = 0;
    if (grid == 0) {
        if (n_in != 32 || out_size != T * D || ws_size < WS_END) { fprintf(stderr, "kernel_launch: unexpected shapes (n_in %d out %d ws %zu need %zu)\n", n_in, out_size, ws_size, (size_t)WS_END); grid = -1; return; }
        int dev = 0, cus = 0;
        if (hipGetDevice(&dev) != hipSuccess || hipDeviceGetAttribute(&cus, hipDeviceAttributeMultiprocessorCount, dev) != hipSuccess) { grid = -1; return; }
        if (hipFuncSetAttribute((const void*)mk_fwd, hipFuncAttributeMaxDynamicSharedMemorySize, LDS_BYTES) != hipSuccess) { fprintf(stderr, "kernel_launch: hipFuncSetAttribute failed\n"); grid = -1; return; }
        int per_cu = 0;
        (void)hipOccupancyMaxActiveBlocksPerMultiprocessor(&per_cu, (const void*)mk_fwd, NTHREADS, LDS_BYTES);
        (void)hipGetLastError();
        grid = cus;
    }
    if (grid < 0) return;
    (void)hipMemsetAsync(d_ws, 0, CTL_BYTES, stream);
    Params p{};
    for (int i = 0; i < 32; ++i) p.in[i] = (const float*)d_in[i];
    p.out = (float*)d_out; p.ws = (unsigned char*)d_ws;
#if MK_ONE_LAUNCH
    p.ph_lo = 0; p.ph_hi = 1 + NL * NPH;
    hipLaunchKernelGGL(mk_fwd, dim3(grid), dim3(NTHREADS), LDS_BYTES, stream, p);
#else
    for (int id = 0; id < 1 + NL * NPH; ++id) {
        p.ph_lo = id; p.ph_hi = id + 1;
        hipLaunchKernelGGL(mk_fwd, dim3(grid), dim3(NTHREADS), LDS_BYTES, stream, p);
    }
#endif
}
#endif
```

```cpp
#ifndef EMU
#include <hip/hip_runtime.h>
#endif
#include <cstdio>
#include <cstdint>
#include <cmath>

#ifndef CFG_BATCH
#define CFG_BATCH 4
#endif
#ifndef CFG_SEQ
#define CFG_SEQ 4096
#endif
#ifndef CFG_LAYERS
#define CFG_LAYERS 4
#endif
#ifndef MK_RWKV_CHUNKED
#define MK_RWKV_CHUNKED 1
#endif
#ifndef MK_PROBE
#define MK_PROBE 0
#endif
#ifndef MK_ONE_LAUNCH
#define MK_ONE_LAUNCH 1
#endif

namespace mk {
constexpr int NB = CFG_BATCH, S = CFG_SEQ, T = NB * S, NL = CFG_LAYERS, D = 1024;
constexpr int GW = 256, RW = 384, MW = 384, HD = 64, GH = 4, RH = 6, MH = 6, CH = 128, NCH = S / CH;
constexpr int PIN = 3480, PLD = 3584, RPROJ = 1408;
constexpr int C_RW = 512, C_MW = 1920;
constexpr int NE = 32, TOPK = 4, DFF = 1024, MOEB = 256;
constexpr int NROWS = (T * TOPK / MOEB + NE) * MOEB;
constexpr float LN_EPS = 1e-5f, GN_EPS = 64e-5f;
constexpr float ALPHA = 1.6817928305074290f;
constexpr int NTHREADS = 512, NWAVES = 8;
constexpr int LDS_BYTES = 160 * 1024;
constexpr int NPH = 11;

typedef float f32x4 __attribute__((ext_vector_type(4)));
typedef unsigned u32x4 __attribute__((ext_vector_type(4)));
typedef unsigned u32x2 __attribute__((ext_vector_type(2)));
typedef short bf16x8 __attribute__((ext_vector_type(8)));
typedef unsigned short bf16_t;

constexpr size_t al(size_t x) { return (x + 255) & ~(size_t)255; }
constexpr size_t CTL_BYTES = 1u << 20;
constexpr size_t O_XA = CTL_BYTES;
constexpr size_t O_XB = O_XA + al((size_t)T * D * 4);
constexpr size_t O_X1 = O_XB + al((size_t)T * D * 2);
constexpr size_t O_X1B = O_X1 + al((size_t)T * D * 4);
constexpr size_t O_PROJ = O_X1B + al((size_t)T * D * 2);
constexpr size_t O_PROJG = O_PROJ + al((size_t)T * PLD * 2);
constexpr size_t O_MIX = O_PROJ + al((size_t)T * PLD * 4);
constexpr size_t O_GRP = O_MIX + al((size_t)T * D * 4);
constexpr size_t O_UG = O_GRP + al((size_t)T * D * 2);
constexpr size_t O_VN = O_UG + al((size_t)T * GW * 4);
constexpr size_t O_RR = O_VN + al((size_t)T * GW * 4);
constexpr size_t O_VV = O_RR + al((size_t)T * RW * 4);
constexpr size_t O_KK = O_VV + al((size_t)T * RW * 4);
constexpr size_t O_DEC = O_KK + al((size_t)T * RW * 4);
constexpr size_t O_KD = O_DEC + al((size_t)2 * T * RW * 4);
constexpr size_t O_ICLR = O_KD + al((size_t)2 * T * RW * 4);
constexpr size_t O_GATE = O_ICLR + al((size_t)2 * T * RW * 4);
constexpr size_t O_BONUS = O_GATE + al((size_t)T * RW * 4);
constexpr size_t O_SCAN = O_BONUS + al((size_t)T * RH * 4);
constexpr size_t O_MQ = O_SCAN + al((size_t)2 * T * RW * 4);
constexpr size_t O_MK = O_MQ + al((size_t)T * MW * 4);
constexpr size_t O_IG = O_MK + al((size_t)T * MW * 4);
constexpr size_t O_LF = O_IG + al((size_t)2 * T * MH * 4);
constexpr size_t O_CL = O_LF + al((size_t)2 * T * MH * 4);
constexpr size_t O_NL = O_CL + al((size_t)2 * NB * MH * NCH * 4096 * 4);
constexpr size_t O_ML = O_NL + al((size_t)2 * NB * MH * NCH * 64 * 4);
constexpr size_t O_BL = O_ML + al((size_t)2 * NB * MH * NCH * 4);
constexpr size_t O_MIN = O_BL + al((size_t)2 * NB * MH * NCH * 4);
constexpr size_t O_TOPI = O_MIN + al((size_t)2 * NB * MH * NCH * 4);
constexpr size_t O_TOPG = O_TOPI + al((size_t)T * 4 * 4);
constexpr size_t O_RANK = O_TOPG + al((size_t)T * 4 * 4);
constexpr size_t O_SLOT = O_RANK + al((size_t)T * 4 * 4);
constexpr size_t O_MQB = O_SLOT + al((size_t)T * 4 * 4);
constexpr size_t O_MKB = O_MQB + al((size_t)T * MW * 2);
constexpr size_t O_KT = O_MKB + al((size_t)T * MW * 2);
constexpr size_t O_VT = O_KT + al((size_t)T * MW * 2);
constexpr size_t O_GVT = O_VT + al((size_t)T * MW * 2);
constexpr size_t O_PMX = O_GVT + al((size_t)2 * T * MH * 4);
constexpr size_t O_BCT = O_PMX + al((size_t)2 * T * MH * 4);
constexpr size_t O_BRKR = O_BCT + al((size_t)2 * T * MH * 4);
constexpr int RC = 64, RNC = S / RC, RUN = 2 * NB * RH * RNC;
constexpr size_t O_LW = O_BRKR + al((size_t)2 * T * RH * 2 * 4);
constexpr size_t O_RQ = O_LW + al((size_t)2 * T * RW * 4);
constexpr size_t O_RA = O_RQ + al((size_t)RUN * 4096 * 2);
constexpr size_t O_RS = O_RA + al((size_t)RUN * 4096 * 2);
constexpr size_t O_RH = O_RS + al((size_t)RUN * 4096 * 2);
constexpr size_t O_RG = O_RH + al((size_t)RUN * 4096 * 4);
constexpr size_t O_RB = O_RG + al((size_t)RUN * 4096 * 4);
constexpr size_t O_VB = O_RB + al((size_t)T * RW * 2);
constexpr size_t O_KKB = O_VB + al((size_t)T * RW * 2);
constexpr size_t O_BBB = O_KKB + al((size_t)T * RW * 2);
constexpr size_t O_KDB = O_BBB + al((size_t)2 * T * RW * 2);
constexpr size_t O_VNT = O_KDB + al((size_t)2 * T * RW * 2);
constexpr size_t O_WSB = O_VNT + al((size_t)T * GW * 2);
constexpr size_t O_LWT = O_WSB + al((size_t)NL * GH * CH * CH * 2);
constexpr size_t O_RWT = O_LWT + al((size_t)NL * 1920 * 128 * 2);
constexpr size_t O_BCNT = O_RWT + al((size_t)NL * 2 * NE * D * 2);
constexpr size_t O_CNTF = O_BCNT + al((size_t)(T / 64) * NE * 4);
constexpr size_t O_ROWT = O_CNTF + al((size_t)NE * 4);
constexpr size_t O_XS = O_ROWT + al((size_t)NROWS * 4);
constexpr size_t O_ACT = O_XS + al((size_t)NROWS * D * 2);
constexpr size_t O_YS = O_ACT + al((size_t)NROWS * DFF * 2);
constexpr size_t O_WIN = O_YS + al((size_t)NROWS * D * 2);
constexpr size_t O_WOUT = O_WIN + al((size_t)NL * PLD * D * 2);
constexpr size_t O_W1 = O_WOUT + al((size_t)NL * D * D * 2);
constexpr size_t O_W2 = O_W1 + al((size_t)NL * NE * 2 * DFF * D * 2);
constexpr size_t WS_END = O_W2 + al((size_t)NL * NE * D * DFF * 2);

constexpr int CW_BAR = 4096;
constexpr int CW_CNT = 16384;

struct Params { const float* in[32]; float* out; unsigned char* ws; int ph_lo, ph_hi; };
#ifdef EMU
typedef const Params* ParamsPtr;
#define PARAMS_PTR(P) (&(P))
#else
typedef const __attribute__((address_space(4))) Params* ParamsPtr;
#define PARAMS_PTR(P) ((ParamsPtr)__builtin_amdgcn_kernarg_segment_ptr())
#endif

#ifdef EMU
#define WAVE_SYNC() emu_wave_barrier()
#define PIN_V(x) do {} while (0)
#define PIN_S(x) do {} while (0)
#else
#define WAVE_SYNC() __builtin_amdgcn_wave_barrier()
#define PIN_V(x) asm volatile("" : "+v"(x))
#define PIN_S(x) asm volatile("" : "+s"(x))
#endif
#ifdef EMU
__device__ __forceinline__ int phase_tid(int wv) { (void)wv; return threadIdx.x; }
#else
__device__ __forceinline__ int phase_tid(int wv) { int t; asm volatile("v_mbcnt_lo_u32_b32 %0, -1, 0\n\tv_mbcnt_hi_u32_b32 %0, -1, %0" : "=v"(t)); return (wv << 6) + t; }
#endif

#ifdef EMU
#define SHX(v, m, lane) __shfl_xor(v, m)
#else
__device__ __forceinline__ float shx_(float v, int m, int lane) { return __builtin_bit_cast(float, __builtin_amdgcn_ds_bpermute((lane ^ m) << 2, __builtin_bit_cast(int, v))); }
__device__ __forceinline__ int shx_(int v, int m, int lane) { return __builtin_amdgcn_ds_bpermute((lane ^ m) << 2, v); }
#define SHX(v, m, lane) shx_(v, m, lane)
#endif
#ifdef EMU
#define SHUP(v, o, lane) __shfl(v, ((lane) - (o)) & 63)
#define RDL(v, src) __shfl(v, src)
#define SHL(v, src) __shfl(v, src)
#else
#define SHL(v, src) __builtin_bit_cast(float, __builtin_amdgcn_ds_bpermute((src) << 2, __builtin_bit_cast(int, (float)(v))))
#define SHUP(v, o, lane) __builtin_bit_cast(float, __builtin_amdgcn_ds_bpermute((((lane) - (o)) & 63) << 2, __builtin_bit_cast(int, (float)(v))))
#define RDL(v, src) __builtin_bit_cast(float, __builtin_amdgcn_readlane(__builtin_bit_cast(int, (float)(v)), src))
#endif
__device__ __forceinline__ float wave_sum(float v, int lane) {
#pragma unroll
    for (int o = 32; o >= 1; o >>= 1) v += SHX(v, o, lane);
    return v;
}
#ifdef EMU
__device__ __forceinline__ float fexp(float x) { return expf(x); }
__device__ __forceinline__ float flog(float x) { return logf(x); }
__device__ __forceinline__ float frcp(float x) { return 1.0f / x; }
#else
__device__ __forceinline__ float fexp(float x) { return __builtin_amdgcn_exp2f(x * 1.4426950408889634f); }
__device__ __forceinline__ float flog(float x) { return __builtin_amdgcn_logf(x) * 0.6931471805599453f; }
__device__ __forceinline__ float frcp(float x) { return __builtin_amdgcn_rcpf(x); }
#endif
__device__ __forceinline__ float sigmoidf_(float x) { return frcp(1.0f + fexp(-x)); }
__device__ __forceinline__ float softplusf_(float x) { return fmaxf(x, 0.f) + flog(1.0f + fexp(-fabsf(x))); }
__device__ __forceinline__ float ftanh(float x) { return 1.0f - 2.0f * frcp(1.0f + fexp(2.0f * x)); }
__device__ __forceinline__ float geluf_(float v) {
    const float av = fabsf(v), t = frcp(1.0f + 0.2316418882f * av);
    float q = t * 0.5307027145f + (-0.7265760135f); q = q * t + 0.7107068705f; q = q * t + (-0.142248368f); q = q * t + 0.127414796f; q = q * t;
    const float m = v * (q * fexp(-0.5f * v * v));
    return v < 0.f ? m : v - m;
}

#ifdef EMU
#define LAS
#define WAIT_V(n) do {} while (0)
#define WAIT_L(n) do {} while (0)
#define S_BARRIER() __syncthreads()
#define SETPRIO(x) do {} while (0)
#define SCHED_BAR() do {} while (0)
#define RFL(x) (x)
static inline void emu_glds16(const void* g, void* l) { memcpy((char*)l + (g_blk->cur & 63) * 16, g, 16); }
#define GLDS16(gptr, ldsptr) emu_glds16((const void*)(gptr), (void*)(ldsptr))
static inline float emu_bf2f(unsigned short b) { unsigned u = (unsigned)b << 16; float f; memcpy(&f, &u, 4); return f; }
static inline f32x4 emu_mfma16(bf16x8 a, bf16x8 b, f32x4 c) {
    EmuBlock* blk = g_blk; const int cur = blk->cur, lane = cur & 63, wbase = cur & ~63;
    static thread_local unsigned short Ash[32][64][8], Bsh[32][64][8];
    const int w = cur >> 6;
    for (int j = 0; j < 8; ++j) { Ash[w][lane][j] = (unsigned short)a[j]; Bsh[w][lane][j] = (unsigned short)b[j]; }
    emu_wave_barrier();
    const int col = lane & 15;
    for (int r = 0; r < 4; ++r) { const int row = 4 * (lane >> 4) + r; float sum = c[r];
        for (int k = 0; k < 32; ++k) sum += emu_bf2f(Ash[w][row + 16 * (k >> 3)][k & 7]) * emu_bf2f(Bsh[w][col + 16 * (k >> 3)][k & 7]);
        c[r] = sum; }
    emu_wave_barrier(); (void)wbase;
    return c;
}
#define MFMA16(a, b, c) emu_mfma16(a, b, c)
#else
#define LAS __attribute__((address_space(3)))
#define WAIT_V(n) asm volatile("s_waitcnt vmcnt(" #n ")" ::: "memory")
#define WAIT_L(n) asm volatile("s_waitcnt lgkmcnt(" #n ")" ::: "memory")
#define S_BARRIER() __builtin_amdgcn_s_barrier()
#define SETPRIO(x) __builtin_amdgcn_s_setprio(x)
#define SCHED_BAR() __builtin_amdgcn_sched_barrier(0)
#define RFL(x) __builtin_amdgcn_readfirstlane(x)
#define GLDS16(gptr, ldsptr) __builtin_amdgcn_global_load_lds((const unsigned*)(gptr), (LAS unsigned*)(ldsptr), 16, 0, 0)
#define MFMA16(a, b, c) __builtin_amdgcn_mfma_f32_16x16x32_bf16(a, b, c, 0, 0, 0)
#endif

#ifdef EMU
__device__ __forceinline__ unsigned f2bf(float f) { unsigned u = __builtin_bit_cast(unsigned, f); return (u + 0x7fffu + ((u >> 16) & 1u)) >> 16; }
#else
__device__ __forceinline__ unsigned f2bf(float f) { return (unsigned)__builtin_bit_cast(unsigned short, (__bf16)f); }
#endif
#ifdef EMU
__device__ __forceinline__ unsigned pk2(float lo, float hi) { return f2bf(lo) | (f2bf(hi) << 16); }
#else
typedef float f32x2c __attribute__((ext_vector_type(2)));
typedef __bf16 bf16x2c __attribute__((ext_vector_type(2)));
__device__ __forceinline__ unsigned pk2(float lo, float hi) { const f32x2c v = {lo, hi}; return __builtin_bit_cast(unsigned, __builtin_convertvector(v, bf16x2c)); }
#endif
__device__ __forceinline__ bf16x8 cvt8(const f32x4 a, const f32x4 b) {
    u32x4 w; w.x = pk2(a.x, a.y); w.y = pk2(a.z, a.w); w.z = pk2(b.x, b.y); w.w = pk2(b.z, b.w); return __builtin_bit_cast(bf16x8, w);
}
__device__ __forceinline__ float bf_lo(unsigned u) { return __builtin_bit_cast(float, u << 16); }
__device__ __forceinline__ float bf_hi(unsigned u) { return __builtin_bit_cast(float, u & 0xffff0000u); }

namespace pg8 {
constexpr int BM = 256, BK = 64, HALF = 128, HTB = HALF * BK * 2, STAGE_BYTES = 8 * HTB, NXCD = 8, WGM = 8;
__host__ __device__ __forceinline__ int lds_byte(int r, int c) { const int st = (r >> 4) * 2 + (c >> 5), rr = r & 15, cc = c & 31, ob = rr * 64 + cc * 2; return st * 1024 + (ob ^ (((ob >> 9) & 1) << 5)); }
__host__ __device__ __forceinline__ void stage_rc(int b, int& R, int& C) { const int st = b / 1024, sb = b % 1024, swz = sb ^ (((sb >> 9) & 1) << 5); R = (st >> 1) * 16 + swz / 64; C = (st & 1) * 32 + (swz % 64) / 2; }
__host__ __device__ __forceinline__ int perm32(int rho) { const int n = rho >> 4, i = rho & 15; return 8 * (i >> 2) + 4 * n + (i & 3); }
struct Unit { int pm, pn, e; };

struct DenseOrder {
    static constexpr bool GATHER = false;
    const char* A; const char* Bt; int K; int nM, nN, nwg, G, c;
    __device__ __forceinline__ void init(const void* A_, const void* Bt_, int M, int N, int K_, int G_, int c_) { A = (const char*)A_; Bt = (const char*)Bt_; K = K_; nM = M / BM; nN = N / BM; nwg = nM * nN; G = G_; c = c_; }
    __device__ __forceinline__ bool next(int i, Unit& u) const {
        const long L = (long)i * G + c; if (L >= nwg) return false;
        int wgid = (int)L; { const int q = nwg / NXCD, r = nwg % NXCD, xcd = wgid % NXCD, off = wgid / NXCD; wgid = (xcd < r ? xcd * (q + 1) : r * (q + 1) + (xcd - r) * q) + off; }
        const int nig = WGM * nN, gid = wgid / nig, fm = gid * WGM, gsz = (nM - fm) < WGM ? (nM - fm) : WGM;
        u.pm = fm + ((wgid % nig) % gsz); u.pn = (wgid % nig) / gsz; u.e = 0; return true;
    }
    __device__ __forceinline__ const char* abase(const Unit& u) const { return A + (size_t)u.pm * BM * K * 2; }
    __device__ __forceinline__ const char* bbase(const Unit& u) const { return Bt + (size_t)u.pn * BM * K * 2; }
};
template <bool G>
struct MoeOrderT {
    static constexpr bool GATHER = G;
    const char* A; const char* Wt; int K; int nN, nwg, G_, c; size_t estride; const int* rbe; const int* rowmap;
    __device__ __forceinline__ bool next(int i, Unit& u) const {
        const long L = (long)i * G_ + c; if (L >= nwg) return false;
        u.pm = (int)(L / nN); u.pn = (int)(L % nN); u.e = rbe[u.pm]; return true;
    }
    __device__ __forceinline__ const char* abase(const Unit& u) const { return G ? A : A + (size_t)u.pm * BM * K * 2; }
    __device__ __forceinline__ const char* bbase(const Unit& u) const { return Wt + (size_t)u.e * estride + (size_t)u.pn * BM * K * 2; }
};
struct EpiF32 {
    static constexpr bool PERM = false;
    float* C; int ldc;
    __device__ __forceinline__ void operator()(const f32x4 (&acc)[2][2][4][2], const Unit& u, int wr, int wc, int fr, int fq) const {
        const int row0 = u.pm * BM + wr * 64 + fr, col0 = u.pn * BM + wc * 32 + 4 * fq;
#pragma unroll
        for (int ai = 0; ai < 2; ++ai)
#pragma unroll
            for (int m = 0; m < 4; ++m) { float* rowp = C + (size_t)(row0 + ai * HALF + m * 16) * ldc + col0;
#pragma unroll
                for (int bj = 0; bj < 2; ++bj)
#pragma unroll
                    for (int n = 0; n < 2; ++n) *(f32x4*)(rowp + bj * HALF + n * 16) = acc[ai][bj][m][n]; }
    }
};
struct EpiProj {
    static constexpr bool PERM = true;
    bf16_t* O; int ldc; float* G; int lastt;
    __device__ __forceinline__ void operator()(const f32x4 (&acc)[2][2][4][2], const Unit& u, int wr, int wc, int fr, int fq) const {
        const int row0 = u.pm * BM + wr * 64 + fr, col0 = u.pn * BM + wc * 32 + 8 * fq;
#pragma unroll
        for (int ai = 0; ai < 2; ++ai)
#pragma unroll
            for (int m = 0; m < 4; ++m) { bf16_t* rowp = O + (size_t)(row0 + ai * HALF + m * 16) * ldc + col0;
#pragma unroll
                for (int bj = 0; bj < 2; ++bj) { const f32x4 v0 = acc[ai][bj][m][0], v1 = acc[ai][bj][m][1];
                    u32x4 w; w.x = pk2(v0[0], v0[1]); w.y = pk2(v0[2], v0[3]); w.z = pk2(v1[0], v1[1]); w.w = pk2(v1[2], v1[3]);
                    *(u32x4*)(rowp + bj * HALF) = w; } }
        if (u.pn == lastt) {
#pragma unroll
            for (int ai = 0; ai < 2; ++ai)
#pragma unroll
                for (int m = 0; m < 4; ++m) { float* rowp = G + (size_t)(row0 + ai * HALF + m * 16) * BM + wc * 32 + 8 * fq;
#pragma unroll
                    for (int bj = 0; bj < 2; ++bj) { *(f32x4*)(rowp + bj * HALF) = acc[ai][bj][m][0]; *(f32x4*)(rowp + bj * HALF + 4) = acc[ai][bj][m][1]; } }
        }
    }
};
struct EpiBf16Bias {
    static constexpr bool PERM = true;
    bf16_t* O; int ldc; const float* bias; int bias_estride;
    __device__ __forceinline__ void operator()(const f32x4 (&acc)[2][2][4][2], const Unit& u, int wr, int wc, int fr, int fq) const {
        const int row0 = u.pm * BM + wr * 64 + fr, col0 = u.pn * BM + wc * 32 + 8 * fq;
        const float* bp = bias + (size_t)u.e * bias_estride + col0;
        f32x4 bv[2][2];
#pragma unroll
        for (int bj = 0; bj < 2; ++bj)
#pragma unroll
            for (int n = 0; n < 2; ++n) bv[bj][n] = *(const f32x4*)(bp + bj * HALF + 4 * n);
#pragma unroll
        for (int ai = 0; ai < 2; ++ai)
#pragma unroll
            for (int m = 0; m < 4; ++m) { bf16_t* rowp = O + (size_t)(row0 + ai * HALF + m * 16) * ldc + col0;
#pragma unroll
                for (int bj = 0; bj < 2; ++bj) { const f32x4 v0 = acc[ai][bj][m][0] + bv[bj][0], v1 = acc[ai][bj][m][1] + bv[bj][1];
                    u32x4 w; w.x = pk2(v0[0], v0[1]); w.y = pk2(v0[2], v0[3]); w.z = pk2(v1[0], v1[1]); w.w = pk2(v1[2], v1[3]);
                    *(u32x4*)(rowp + bj * HALF) = w; } }
    }
};
__device__ __forceinline__ float swiglu1(float g, float uu) { g = fminf(g, 7.0f); uu = fminf(fmaxf(uu, -7.0f), 7.0f); return (uu + 1.0f) * (g * frcp(1.0f + fexp(-1.702f * g))); }
struct EpiSwiglu {
    static constexpr bool PERM = true;
    bf16_t* O; const float* b1;
    __device__ __forceinline__ void operator()(const f32x4 (&acc)[2][2][4][2], const Unit& u, int wr, int wc, int fr, int fq) const {
        const int row0 = u.pm * BM + wr * 64 + fr, j0 = u.pn * HALF + wc * 32 + 8 * fq;
        const float* bg = b1 + (size_t)u.e * 2 * DFF + j0; const float* bu = bg + DFF;
        f32x4 g4[2], u4[2];
#pragma unroll
        for (int n = 0; n < 2; ++n) { g4[n] = *(const f32x4*)(bg + 4 * n); u4[n] = *(const f32x4*)(bu + 4 * n); }
#pragma unroll
        for (int ai = 0; ai < 2; ++ai)
#pragma unroll
            for (int m = 0; m < 4; ++m) {
                float o[8];
#pragma unroll
                for (int n = 0; n < 2; ++n)
#pragma unroll
                    for (int q = 0; q < 4; ++q) o[n * 4 + q] = swiglu1(acc[ai][0][m][n][q] + g4[n][q], acc[ai][1][m][n][q] + u4[n][q]);
                u32x4 w; w.x = pk2(o[0], o[1]); w.y = pk2(o[2], o[3]); w.z = pk2(o[4], o[5]); w.w = pk2(o[6], o[7]);
                *(u32x4*)(O + (size_t)(row0 + ai * HALF + m * 16) * DFF + j0) = w;
            }
    }
};

template <class Epi, class Sched>
__device__ __forceinline__ void gemm_phase(LAS unsigned char* lds, const int K, const Sched& S, const Epi& E, const int tid) {
    const int wid = RFL(tid >> 6), lane = tid & 63, wr = wid >> 2, wc = wid & 3, fr = lane & 15, fq = lane >> 4;
    const int nt = K / BK;
    unsigned voffA[2], voffB[2]; int gR[2]; unsigned gC[2];
#pragma unroll
    for (int i = 0; i < 2; ++i) { int R, C; stage_rc(tid * 16 + i * 8192, R, C); const int Rb = Epi::PERM ? ((R & ~31) + perm32(R & 31)) : R;
        voffA[i] = (unsigned)(R * K + C) * 2u; voffB[i] = (unsigned)(Rb * K + C) * 2u; gR[i] = R; gC[i] = (unsigned)C * 2u; }
    unsigned va[2][2], vn[2][2];
#define PG8_GOFF(dst, unit) do { if constexpr (Sched::GATHER) { _Pragma("unroll") for (int h_ = 0; h_ < 2; ++h_) _Pragma("unroll") for (int i_ = 0; i_ < 2; ++i_) \
        dst[h_][i_] = (unsigned)S.rowmap[(unit).pm * BM + h_ * HALF + gR[i_]] * (unsigned)(K * 2) + gC[i_]; } } while (0)
#define PG8_STAGE_A(bufoff, bp, kb, h, nx) do { if constexpr (Sched::GATHER) { const char* gb_ = S.A + (kb); _Pragma("unroll") for (int _i = 0; _i < 2; ++_i) \
        GLDS16(gb_ + ((nx) ? vn[h][_i] : va[h][_i]), lds + (bufoff) + ldsw + _i * 8192); } else { PG8_STAGE(bufoff, bp, voffA); } } while (0)
    const size_t kstep = (size_t)(BK * 2);
    const size_t hstep = (size_t)HALF * K * 2;
    const unsigned ldsw = (unsigned)wid * 1024u;
    const int aoff = lds_byte(wr * 64 + fr, fq * 8), boff = lds_byte(wc * 32 + fr, fq * 8);
#define PG8_SA(b, h) (((b) * 2 + (h)) * HTB)
#define PG8_SB(b, h) ((4 + (b) * 2 + (h)) * HTB)
#define PG8_STAGE(bufoff, gbase, voff) do { _Pragma("unroll") for (int _i = 0; _i < 2; ++_i) \
        GLDS16((const char*)(gbase) + (voff)[_i], lds + (bufoff) + ldsw + _i * 8192); } while (0)
#define PG8_LDA(dst, b, h) do { _Pragma("unroll") for (int m = 0; m < 4; ++m) _Pragma("unroll") for (int k = 0; k < 2; ++k) dst[m][k] = *(const LAS bf16x8*)(lds + PG8_SA(b, h) + aoff + m * 2048 + k * 1024); } while (0)
#define PG8_LDB(dst, b, h) do { _Pragma("unroll") for (int n = 0; n < 2; ++n) _Pragma("unroll") for (int k = 0; k < 2; ++k) dst[n][k] = *(const LAS bf16x8*)(lds + PG8_SB(b, h) + boff + n * 2048 + k * 1024); } while (0)
#define PG8_MMA(ai, bj, At, Bt) do { SETPRIO(1); _Pragma("unroll") for (int m = 0; m < 4; ++m) _Pragma("unroll") for (int n = 0; n < 2; ++n) _Pragma("unroll") for (int k = 0; k < 2; ++k) \
        acc[ai][bj][m][n] = MFMA16(Bt[n][k], At[m][k], acc[ai][bj][m][n]); SETPRIO(0); } while (0)
    Unit cur, nxt; int ui = 0;
    if (!S.next(0, cur)) return;
    f32x4 acc[2][2][4][2];
#pragma unroll
    for (int a = 0; a < 2; ++a)
#pragma unroll
        for (int b = 0; b < 2; ++b)
#pragma unroll
            for (int m = 0; m < 4; ++m)
#pragma unroll
                for (int n = 0; n < 2; ++n) acc[a][b][m][n] = (f32x4){0.f, 0.f, 0.f, 0.f};
    bf16x8 At[4][2], B0[2][2], B1[2][2];
    const char* cA = S.abase(cur); const char* cB = S.bbase(cur);
    PG8_GOFF(va, cur);
    PG8_STAGE(PG8_SB(0, 0), cB, voffB); PG8_STAGE_A(PG8_SA(0, 0), cA, 0, 0, false); PG8_STAGE(PG8_SB(0, 1), cB + hstep, voffB); PG8_STAGE_A(PG8_SA(0, 1), cA + hstep, 0, 1, false);
    if (wr == 1) S_BARRIER();
    WAIT_V(4); S_BARRIER();
    PG8_STAGE(PG8_SB(1, 0), cB + kstep, voffB); PG8_STAGE_A(PG8_SA(1, 0), cA + kstep, kstep, 0, false); PG8_STAGE(PG8_SB(1, 1), cB + hstep + kstep, voffB);
    WAIT_V(6); S_BARRIER();
    for (;;) {
        const bool has_next = S.next(ui + 1, nxt);
        const char* nA = has_next ? S.abase(nxt) : cA; const char* nB = has_next ? S.bbase(nxt) : cB;
        if constexpr (Sched::GATHER) { if (has_next) { PG8_GOFF(vn, nxt); } else {
#pragma unroll
            for (int h_ = 0; h_ < 2; ++h_) { vn[h_][0] = va[h_][0]; vn[h_][1] = va[h_][1]; } } }
        for (int t = 0; t < nt; t += 2) {
            const bool last = (t == nt - 2);
            const char* a1 = cA + (size_t)(t + 1) * kstep;
            const char* a2 = last ? nA : cA + (size_t)(t + 2) * kstep; const char* b2 = last ? nB : cB + (size_t)(t + 2) * kstep;
            const char* a3 = a2 + kstep; const char* b3 = b2 + kstep;
            PG8_LDB(B0, 0, 0); SCHED_BAR(); PG8_LDA(At, 0, 0); PG8_STAGE_A(PG8_SA(1, 1), a1 + hstep, (size_t)(t + 1) * kstep, 1, false);
            WAIT_L(8); S_BARRIER(); WAIT_L(0); PG8_MMA(0, 0, At, B0); S_BARRIER(); SCHED_BAR();
            PG8_LDB(B1, 0, 1); PG8_STAGE(PG8_SB(0, 0), b2, voffB);
            S_BARRIER(); WAIT_L(0); PG8_MMA(0, 1, At, B1); S_BARRIER();
            PG8_LDA(At, 0, 1); PG8_STAGE_A(PG8_SA(0, 0), a2, (last ? (size_t)0 : (size_t)(t + 2) * kstep), 0, last);
            S_BARRIER(); WAIT_L(0); PG8_MMA(1, 0, At, B0); S_BARRIER(); SCHED_BAR();
            PG8_STAGE(PG8_SB(0, 1), b2 + hstep, voffB);
            WAIT_V(6); S_BARRIER(); PG8_MMA(1, 1, At, B1); S_BARRIER();
            PG8_LDB(B0, 1, 0); SCHED_BAR(); PG8_LDA(At, 1, 0); PG8_STAGE_A(PG8_SA(0, 1), a2 + hstep, (last ? (size_t)0 : (size_t)(t + 2) * kstep), 1, last);
            WAIT_L(8); S_BARRIER(); WAIT_L(0); PG8_MMA(0, 0, At, B0); S_BARRIER(); SCHED_BAR();
            PG8_LDB(B1, 1, 1); PG8_STAGE(PG8_SB(1, 0), b3, voffB);
            S_BARRIER(); WAIT_L(0); PG8_MMA(0, 1, At, B1); S_BARRIER();
            PG8_LDA(At, 1, 1); PG8_STAGE_A(PG8_SA(1, 0), a3, (last ? kstep : (size_t)(t + 3) * kstep), 0, last);
            S_BARRIER(); WAIT_L(0); PG8_MMA(1, 0, At, B0); S_BARRIER(); SCHED_BAR();
            PG8_STAGE(PG8_SB(1, 1), b3 + hstep, voffB);
            WAIT_V(6); S_BARRIER(); PG8_MMA(1, 1, At, B1); S_BARRIER();
        }
        if (wr == 0) S_BARRIER();
        E(acc, cur, wr, wc, fr, fq);
        if (!has_next) break;
#pragma unroll
        for (int a = 0; a < 2; ++a)
#pragma unroll
            for (int b = 0; b < 2; ++b)
#pragma unroll
                for (int m = 0; m < 4; ++m)
#pragma unroll
                    for (int n = 0; n < 2; ++n) acc[a][b][m][n] = (f32x4){0.f, 0.f, 0.f, 0.f};
        cur = nxt; cA = nA; cB = nB; ++ui;
        if constexpr (Sched::GATHER) {
#pragma unroll
            for (int h_ = 0; h_ < 2; ++h_) { va[h_][0] = vn[h_][0]; va[h_][1] = vn[h_][1]; } }
        if (wr == 1) S_BARRIER();
    }
    WAIT_V(0);
    S_BARRIER();
#undef PG8_SA
#undef PG8_SB
#undef PG8_STAGE
#undef PG8_STAGE_A
#undef PG8_GOFF
#undef PG8_LDA
#undef PG8_LDB
#undef PG8_MMA
}
}

__device__ __forceinline__ float row16_sum(float x) {
#ifdef EMU
    x += __shfl_xor(x, 1); x += __shfl_xor(x, 2); x += __shfl_xor(x, 4); x += __shfl_xor(x, 8); return x;
#else
#define DPPF(v, ctrl) __builtin_bit_cast(float, __builtin_amdgcn_update_dpp(0, __builtin_bit_cast(int, (v)), (ctrl), 0xF, 0xF, false))
    x += DPPF(x, 0xB1); x += DPPF(x, 0x4E); x += DPPF(x, 0x141); x += DPPF(x, 0x140); return x;
#undef DPPF
#endif
}
__device__ __forceinline__ float row32_sum(float x) {
    x = row16_sum(x);
#ifdef EMU
    x += __shfl_xor(x, 32); return x;
#else
    float a = x, b = x;
    asm volatile("s_nop 1\n\tv_permlane32_swap_b32 %0, %1" : "+v"(a), "+v"(b));
    return a + b;
#endif
}
__device__ __forceinline__ float wave_sum_fast(float x, int lane) {
    x = row32_sum(x);
    x += SHX(x, 16, lane);
    return x;
}
__device__ __forceinline__ void transpose_item(const float* W, int K, int N, bf16_t* WT, int k0, int n0, int dst_row0, float* scr, int lane) {
    const int n4 = (lane & 15) * 4, kr = lane >> 4;
#pragma unroll 8
    for (int i = 0; i < 16; ++i) {
        const int kk = 4 * i + kr;
        f32x4 v = (f32x4){0.f, 0.f, 0.f, 0.f};
        if (n0 + n4 < N) v = *(const f32x4*)(W + (size_t)(k0 + kk) * N + n0 + n4);
        float* d = scr + kk * 65 + n4; d[0] = v.x; d[1] = v.y; d[2] = v.z; d[3] = v.w;
    }
    WAVE_SYNC();
    const int c = lane & 7;
#pragma unroll
    for (int j = 0; j < 8; ++j) { const int n = (lane >> 3) + 8 * j; const float* sp = scr + (8 * c) * 65 + n;
        u32x4 o; o.x = pk2(sp[0 * 65], sp[1 * 65]); o.y = pk2(sp[2 * 65], sp[3 * 65]); o.z = pk2(sp[4 * 65], sp[5 * 65]); o.w = pk2(sp[6 * 65], sp[7 * 65]);
        *(u32x4*)(WT + (size_t)(dst_row0 + n) * K + k0 + 8 * c) = o; }
    WAVE_SYNC();
}
__device__ __forceinline__ void phase_prologue(const Params& P, unsigned char* smem, int wv) {
    ParamsPtr pp = PARAMS_PTR(P); PIN_S(pp); unsigned char* ws = pp->ws; int bidx = (int)blockIdx.x, gdim = (int)gridDim.x; PIN_S(bidx); PIN_S(gdim);
    const int tid = phase_tid(wv), lane = tid & 63, wave = tid >> 6;
    float* scr = (float*)smem + wave * (64 * 65);
    const int gw = bidx * NWAVES + wave, ngw = NWAVES * gdim;
    constexpr int I_IN = 16 * (PLD / 64), I_OUT = 16 * 16, I_W1 = NE * 16 * 32, I_W2 = NE * 16 * 16, I_L = I_IN + I_OUT + I_W1 + I_W2;
    for (int it = gw; it < NL * I_L; it += ngw) {
        const int l = it / I_L; int r = it % I_L;
        if (r < I_IN) { const int kb = r / (PLD / 64), nb = r % (PLD / 64);
            transpose_item(pp->in[1] + (size_t)l * D * PIN, D, PIN, (bf16_t*)(ws + O_WIN) + (size_t)l * PLD * D, kb * 64, nb * 64, nb * 64, scr, lane); continue; }
        r -= I_IN;
        if (r < I_OUT) { const int kb = r / 16, nb = r % 16;
            transpose_item(pp->in[21] + (size_t)l * D * D, D, D, (bf16_t*)(ws + O_WOUT) + (size_t)l * D * D, kb * 64, nb * 64, nb * 64, scr, lane); continue; }
        r -= I_OUT;
        if (r < I_W1) { const int e = r / (16 * 32), q = r % (16 * 32), kb = q / 32, nb = q % 32, n0 = nb * 64;
            const int dst = n0 < DFF ? (n0 / 128) * 256 + (n0 % 128) : ((n0 - DFF) / 128) * 256 + 128 + ((n0 - DFF) % 128);
            transpose_item(pp->in[26] + ((size_t)l * NE + e) * D * 2 * DFF, D, 2 * DFF, (bf16_t*)(ws + O_W1) + ((size_t)l * NE + e) * 2 * DFF * D, kb * 64, n0, dst, scr, lane); continue; }
        r -= I_W1;
        { const int e = r / (16 * 16), q = r % (16 * 16), kb = q / 16, nb = q % 16;
            transpose_item(pp->in[28] + ((size_t)l * NE + e) * DFF * D, DFF, D, (bf16_t*)(ws + O_W2) + ((size_t)l * NE + e) * D * DFF, kb * 64, nb * 64, nb * 64, scr, lane); }
    }
    {
        const float* gw_ = pp->in[4]; bf16_t* WSB = (bf16_t*)(ws + O_WSB);
        for (size_t i = ((size_t)bidx * NTHREADS + tid) * 4; i < (size_t)NL * GH * CH * CH; i += (size_t)gdim * NTHREADS * 4) {
            const f32x4 v = *(const f32x4*)(gw_ + i); u32x2 o; o.x = pk2(v.x, v.y); o.y = pk2(v.z, v.w); *(u32x2*)(WSB + i) = o;
        }
    }
    {
        bf16_t* LWT = (bf16_t*)(ws + O_LWT);
        for (int i = bidx * NTHREADS + tid; i < NL * 1920 * 128; i += gdim * NTHREADS) {
            const int k = i & 127, n = (i >> 7) % 1920, ll = i / (1920 * 128);
            float v = 0.f;
            if (n < 1536) { if (k < 64) { const int grp = n / 768, d = (n / 384) & 1, c = n % 384; v = (grp == 0 ? pp->in[8] : pp->in[10])[(((size_t)ll * 2 + d) * 64 + k) * RW + c]; } }
            else v = pp->in[11][((size_t)ll * 128 + k) * RW + (n - 1536)];
            LWT[i] = (bf16_t)f2bf(v);
        }
    }
    {
        bf16_t* RWT = (bf16_t*)(ws + O_RWT);
        for (int i = bidx * NTHREADS + tid; i < NL * NE * D; i += gdim * NTHREADS) {
            const int k = i % D, e = (i / D) % NE, ll = i / (D * NE);
            const float v = pp->in[24][((size_t)ll * D + k) * NE + e];
            const unsigned hi = f2bf(v); const float lo = v - bf_lo(hi);
            RWT[((size_t)(ll * 2 + 0) * NE + e) * D + k] = (bf16_t)hi; RWT[((size_t)(ll * 2 + 1) * NE + e) * D + k] = (bf16_t)f2bf(lo);
        }
    }
    const float* x = pp->in[0]; bf16_t* XB = (bf16_t*)(ws + O_XB);
    for (size_t i = ((size_t)bidx * NTHREADS + tid) * 4; i < (size_t)T * D; i += (size_t)gdim * NTHREADS * 4) {
        const f32x4 v = *(const f32x4*)(x + i); u32x2 o; o.x = pk2(v.x, v.y); o.y = pk2(v.z, v.w); *(u32x2*)(XB + i) = o;
    }
}

__device__ __forceinline__ float tshift(const float* P, int t, int s, int col, const float* mu0, const float* mu1, int rc) {
    const float cur = P[(size_t)t * PLD + col];
    const float prv = s > 0 ? P[(size_t)(t - 1) * PLD + col] : 0.f;
    const float nxt = s < S - 1 ? P[(size_t)(t + 1) * PLD + col] : 0.f;
    return cur + mu0[rc] * (prv - cur) + mu1[rc] * (nxt - cur);
}

__device__ __forceinline__ void phase_prep(const Params& P, int l, unsigned char* smem, int wv) {
    ParamsPtr pp = PARAMS_PTR(P); PIN_S(pp); unsigned char* ws = pp->ws; int bidx = (int)blockIdx.x, gdim = (int)gridDim.x; PIN_S(bidx); PIN_S(gdim);
    const bf16_t* proj = (const bf16_t*)(ws + O_PROJ); const float* projg = (const float*)(ws + O_PROJG);
    float* UG = (float*)(ws + O_UG); bf16_t* VNT = (bf16_t*)(ws + O_VNT);
    float* RR = (float*)(ws + O_RR); float* VV = (float*)(ws + O_VV); float* KK = (float*)(ws + O_KK);
    float* KD = (float*)(ws + O_KD); float* ICLR = (float*)(ws + O_ICLR);
    float* GATE = (float*)(ws + O_GATE); float* BONUS = (float*)(ws + O_BONUS); float* LWG = (float*)(ws + O_LW);
    bf16_t* RB = (bf16_t*)(ws + O_RB); bf16_t* VB = (bf16_t*)(ws + O_VB); bf16_t* KKB = (bf16_t*)(ws + O_KKB); bf16_t* BBB = (bf16_t*)(ws + O_BBB); bf16_t* KDB = (bf16_t*)(ws + O_KDB);
#if !MK_RWKV_CHUNKED
    float* DEC = (float*)(ws + O_DEC); float* BRKR = (float*)(ws + O_BRKR);
#endif
    bf16_t* MQB = (bf16_t*)(ws + O_MQB); bf16_t* MKB = (bf16_t*)(ws + O_MKB); bf16_t* KT = (bf16_t*)(ws + O_KT); bf16_t* VT = (bf16_t*)(ws + O_VT);
    float* IG = (float*)(ws + O_IG); float* LF = (float*)(ws + O_LF);
    const bf16_t* LWT = (const bf16_t*)(ws + O_LWT) + (size_t)l * 1920 * 128;
    const float* gln_g = pp->in[2] + (size_t)l * GW; const float* gln_b = pp->in[3] + (size_t)l * GW;
    const float* mu0 = pp->in[6] + (size_t)l * 2 * RPROJ; const float* mu1 = mu0 + RPROJ;
    const float* w0 = pp->in[7] + (size_t)l * 2 * RW; const float* a0 = pp->in[9] + (size_t)l * 2 * RW;
    const float* k_k = pp->in[12] + (size_t)l * RW; const float* k_a = pp->in[13] + (size_t)l * RW; const float* r_k = pp->in[14] + (size_t)l * RW;
    const float* conv_w = pp->in[17] + (size_t)l * 3 * 768; const float* conv_b = pp->in[18] + (size_t)l * 768; const float* gate_b = pp->in[19] + (size_t)l * 24;
    float* win = (float*)smem;
    bf16_t* lin = (bf16_t*)(smem + 101376);
    bf16_t* tvn = (bf16_t*)(smem + 110592);
    bf16_t* tk = (bf16_t*)(smem + 118784);
    bf16_t* tv = (bf16_t*)(smem + 131072);
    constexpr int LIN = 264;
    const int tid = phase_tid(wv), lane = tid & 63, wave = tid >> 6, col = lane & 15, g = lane >> 4;
    for (int u = bidx; u < T / 16; u += gdim) {
        const int t0 = u * 16, s0 = t0 % S, bb = t0 / S;
        __syncthreads();
        {
            u32x2 wb[18];
#pragma unroll
            for (int row = 0; row < 18; ++row) {
                const int sq = s0 - 1 + row;
                wb[row] = (u32x2){0u, 0u};
                if (sq >= 0 && sq < S && tid < 352) wb[row] = *(const u32x2*)(proj + (size_t)(t0 - 1 + row) * PLD + C_RW + tid * 4);
            }
            if (tid < 352) {
#pragma unroll
                for (int row = 0; row < 18; ++row) *(f32x4*)(win + row * RPROJ + tid * 4) = (f32x4){bf_lo(wb[row].x), bf_hi(wb[row].x), bf_lo(wb[row].y), bf_hi(wb[row].y)};
            }
        }
        for (int rep_ = 0; rep_ < (MK_PROBE == 3 ? 2 : 1); ++rep_) {
            const int i = tid >> 5, l32 = tid & 31, t = t0 + i;
            float v[8], ug[8]; float sum = 0.f;
#pragma unroll
            for (int j = 0; j < 8; ++j) { const int c = j * 32 + l32; ug[j] = bf_lo((unsigned)proj[(size_t)t * PLD + c]); v[j] = bf_lo((unsigned)proj[(size_t)t * PLD + GW + c]); }
#pragma unroll
            for (int j = 0; j < 8; ++j) { const int c = j * 32 + l32; UG[(size_t)t * GW + c] = geluf_(ug[j]); v[j] = geluf_(v[j]); sum += v[j]; }
#pragma unroll
            for (int o = 16; o >= 1; o >>= 1) sum += SHX(sum, o, lane);
            const float mean = sum * (1.0f / GW); float q = 0.f;
#pragma unroll
            for (int j = 0; j < 8; ++j) { const float d = v[j] - mean; q += d * d; }
#pragma unroll
            for (int o = 16; o >= 1; o >>= 1) q += SHX(q, o, lane);
            const float rstd = 1.0f / sqrtf(q * (1.0f / GW) + LN_EPS);
#pragma unroll
            for (int j = 0; j < 8; ++j) { const int c = j * 32 + l32; tvn[c * 16 + i] = (bf16_t)f2bf((v[j] - mean) * rstd * gln_g[c] + gln_b[c]); }
        }
        __syncthreads();
        {
            const int hf = tid & 1, c = tid >> 1;
            *(u32x4*)(VNT + ((size_t)bb * GW + c) * S + s0 + hf * 8) = *(const u32x4*)(tvn + c * 16 + hf * 8);
        }
        for (int idx = tid; idx < 16 * 256; idx += NTHREADS) {
            const int i = idx >> 8, j = idx & 255, rc = 1152 + j;
            const float pv = win[i * RPROJ + rc], cv = win[(i + 1) * RPROJ + rc], nv = win[(i + 2) * RPROJ + rc];
            const float x = cv + mu0[rc] * (pv - cv) + mu1[rc] * (nv - cv);
            lin[i * LIN + j] = (bf16_t)f2bf(j < 64 ? ftanh(x) : (j < 128 ? x : sigmoidf_(x)));
        }
        __syncthreads();
        for (int rep_ = 0; rep_ < (MK_PROBE == 1 ? 2 : 1); ++rep_) {
#pragma unroll 1
            for (int qg = 0; qg < 3; ++qg) {
                bf16x8 bw_[5][4]; float bias_[5];
#pragma unroll
                for (int q5 = 0; q5 < 5; ++q5) {
                    const int nt = wave * 15 + qg * 5 + q5, grp = nt / 24, c = (nt % 24) * 16 + col;
                    const bf16_t* bw = LWT + (size_t)(nt * 16 + col) * 128 + 8 * g;
#pragma unroll
                    for (int ks = 0; ks < 2; ++ks) bw_[q5][ks] = *(const bf16x8*)(bw + ks * 32);
                    if (grp == 4) {
#pragma unroll
                        for (int ks = 2; ks < 4; ++ks) bw_[q5][ks] = *(const bf16x8*)(bw + ks * 32);
                    }
                    bias_[q5] = grp < 2 ? w0[grp * RW + c] : (grp < 4 ? a0[(grp - 2) * RW + c] : 0.f);
                }
#pragma unroll
                for (int q5 = 0; q5 < 5; ++q5) {
                    const int nt = wave * 15 + qg * 5 + q5, grp = nt / 24, c = (nt % 24) * 16 + col;
                    const int kcol = grp < 2 ? 0 : (grp < 4 ? 64 : 128);
                    f32x4 acc = (f32x4){0.f, 0.f, 0.f, 0.f};
#pragma unroll
                    for (int ks = 0; ks < 2; ++ks) acc = MFMA16(*(const bf16x8*)(lin + col * LIN + kcol + ks * 32 + 8 * g), bw_[q5][ks], acc);
                    if (grp == 4) {
#pragma unroll
                        for (int ks = 2; ks < 4; ++ks) acc = MFMA16(*(const bf16x8*)(lin + col * LIN + kcol + ks * 32 + 8 * g), bw_[q5][ks], acc);
                    }
                    if (grp < 2) {
#pragma unroll
                        for (int r = 0; r < 4; ++r) { const float lw = -fexp(-softplusf_(-(acc[r] + bias_[q5])) - 0.5f); const size_t o = (size_t)grp * T * RW + (size_t)(t0 + 4 * g + r) * RW + c; LWG[o] = lw;
#if !MK_RWKV_CHUNKED
                            DEC[o] = expf(lw);
#endif
                        }
                    } else if (grp < 4) {
#pragma unroll
                        for (int r = 0; r < 4; ++r) ICLR[(size_t)(grp - 2) * T * RW + (size_t)(t0 + 4 * g + r) * RW + c] = sigmoidf_(acc[r] + bias_[q5]);
                    } else {
#pragma unroll
                        for (int r = 0; r < 4; ++r) GATE[(size_t)(t0 + 4 * g + r) * RW + c] = acc[r];
                    }
                }
            }
        }
        __syncthreads();
        for (int rep_ = 0; rep_ < (MK_PROBE == 2 ? 2 : 1); ++rep_) if (wave < 6) {
            const int c = tid, h = wave;
            const float kkc = k_k[c], kac = k_a[c], rkc = r_k[c];
            const float m0r = mu0[c], m1r = mu1[c], m0k = mu0[RW + c], m1k = mu1[RW + c], m0v = mu0[2 * RW + c], m1v = mu1[2 * RW + c];
            float ic0[16], ic1[16];
#pragma unroll
            for (int i = 0; i < 16; ++i) { const size_t o = (size_t)(t0 + i) * RW + c; ic0[i] = ICLR[o]; ic1[i] = ICLR[(size_t)T * RW + o]; }
#pragma unroll
            for (int i = 0; i < 16; ++i) {
                const int t = t0 + i;
                const float* w_ = win + i * RPROJ + c;
                const float rp = w_[0], rc_ = w_[RPROJ], rn = w_[2 * RPROJ];
                const float kp = w_[RW], kc_ = w_[RPROJ + RW], kn = w_[2 * RPROJ + RW];
                const float vp = w_[2 * RW], vc_ = w_[RPROJ + 2 * RW], vn = w_[2 * RPROJ + 2 * RW];
                const float r = rc_ + m0r * (rp - rc_) + m1r * (rn - rc_);
                const float k = kc_ + m0k * (kp - kc_) + m1k * (kn - kc_);
                const float v = vc_ + m0v * (vp - vc_) + m1v * (vn - vc_);
                const size_t o = (size_t)t * RW + c;
                const float kq = k * kkc;
                const float n2 = wave_sum_fast(kq * kq, lane);
                const float kk = kq / fmaxf(sqrtf(n2), 1e-12f);
                const float kd0 = k * (1.0f + (ic0[i] - 1.0f) * kac), kd1 = k * (1.0f + (ic1[i] - 1.0f) * kac);
                const float bon = wave_sum_fast(r * (kd0 + kd1) * rkc, lane);
#if MK_RWKV_CHUNKED
                RB[o] = (bf16_t)f2bf(r); VB[o] = (bf16_t)f2bf(v); KKB[o] = (bf16_t)f2bf(kk);
                BBB[o] = (bf16_t)f2bf(kk * ic0[i]); BBB[(size_t)T * RW + o] = (bf16_t)f2bf(kk * ic1[i]);
                KDB[o] = (bf16_t)f2bf(kd0); KDB[(size_t)T * RW + o] = (bf16_t)f2bf(kd1);
#else
                RR[o] = r; VV[o] = v; KK[o] = kk;
                KD[o] = kd0; KD[(size_t)T * RW + o] = kd1;
#endif
                if (lane == 0) BONUS[(size_t)t * RH + h] = bon;
#if !MK_RWKV_CHUNKED
                { const float br0 = wave_sum(kk * ic0[i] * r, lane), br1 = wave_sum(kk * ic1[i] * r, lane), kr0 = wave_sum(kd0 * r, lane), kr1 = wave_sum(kd1 * r, lane);
                  if (lane == 0) { BRKR[((size_t)t * RH + h) * 2] = br0; BRKR[((size_t)t * RH + h) * 2 + 1] = kr0; BRKR[((size_t)(T + t) * RH + h) * 2] = br1; BRKR[((size_t)(T + t) * RH + h) * 2 + 1] = kr1; } }
#endif
            }
        }
        __syncthreads();
        {
            u32x2 wb[9], vb[3];
            const int rsel = tid >= 192 ? 1 : 0, c4 = tid - rsel * 192;
#pragma unroll
            for (int it = 0; it < 9; ++it) {
                const int row = 2 * it + rsel, sq = s0 - 1 + row;
                wb[it] = (u32x2){0u, 0u};
                if (tid < 384 && sq >= 0 && sq < S) wb[it] = *(const u32x2*)(proj + (size_t)(t0 - 1 + row) * PLD + C_MW + c4 * 4);
            }
#pragma unroll
            for (int it = 0; it < 3; ++it) { const int idx = tid + it * NTHREADS, i = idx / 96, cc = (idx % 96) * 4; vb[it] = *(const u32x2*)(proj + (size_t)(t0 + i) * PLD + C_MW + 2 * MW + cc); }
            if (tid < 384) {
#pragma unroll
                for (int it = 0; it < 9; ++it) *(f32x4*)(win + (2 * it + rsel) * 768 + c4 * 4) = (f32x4){bf_lo(wb[it].x), bf_hi(wb[it].x), bf_lo(wb[it].y), bf_hi(wb[it].y)};
            }
#pragma unroll
            for (int it = 0; it < 3; ++it) { const int idx = tid + it * NTHREADS, i = idx / 96, cc = (idx % 96) * 4; const u32x2 v = vb[it];
                tv[(cc + 0) * 16 + i] = (bf16_t)(v.x & 0xffffu); tv[(cc + 1) * 16 + i] = (bf16_t)(v.x >> 16); tv[(cc + 2) * 16 + i] = (bf16_t)(v.y & 0xffffu); tv[(cc + 3) * 16 + i] = (bf16_t)(v.y >> 16); }
        }
        for (int idx = tid; idx < 16 * 24; idx += NTHREADS) {
            const int i = idx / 24, gi = idx % 24, t = t0 + i;
            const int isf = gi / 12, dir = (gi / 6) & 1, h = gi % 6;
            const float gg = projg[(size_t)t * 256 + (3456 - (PLD - 256)) + gi] + gate_b[gi];
            if (isf) LF[((size_t)dir * T + t) * MH + h] = -softplusf_(-gg); else IG[((size_t)dir * T + t) * MH + h] = gg;
        }
        __syncthreads();
        for (int rep_ = 0; rep_ < (MK_PROBE == 4 ? 2 : 1); ++rep_)
        for (int idx = tid; idx < 16 * 768; idx += NTHREADS) {
            const int i = idx / 768, c = idx % 768, t = t0 + i;
            const float* w_ = win + i * 768 + c;
            float y = conv_b[c] + w_[0] * conv_w[c] + w_[768] * conv_w[768 + c] + w_[1536] * conv_w[2 * 768 + c];
            y = y * sigmoidf_(y);
            if (c < MW) MQB[(size_t)t * MW + c] = (bf16_t)f2bf(y);
            else { const bf16_t kb = (bf16_t)f2bf(y * 0.125f); MKB[(size_t)t * MW + (c - MW)] = kb; tk[(c - MW) * 16 + i] = kb; }
        }
        __syncthreads();
        for (int idx = tid; idx < 2 * MW * 2; idx += NTHREADS) {
            const int hf = idx & 1, c = (idx >> 1) % MW, which = idx / (2 * MW);
            const u32x4 val = *(const u32x4*)((which ? tv : tk) + c * 16 + hf * 8);
            bf16_t* dst = (which ? VT : KT) + ((size_t)(bb * MH) * 64 + c) * S + s0 + hf * 8;
            *(u32x4*)dst = val;
        }
    }
    __syncthreads();
}

__device__ __forceinline__ void phase_gmlp_mix(const Params& P, int l, unsigned char* smem, int wv, int bid, int nb) {
    PIN_S(bid); PIN_S(nb);
    ParamsPtr pp = PARAMS_PTR(P); PIN_S(pp); unsigned char* ws = pp->ws;
    const float* UG = (const float*)(ws + O_UG); const bf16_t* VNT = (const bf16_t*)(ws + O_VNT); bf16_t* GRP = (bf16_t*)(ws + O_GRP);
    const bf16_t* WSB = (const bf16_t*)(ws + O_WSB) + (size_t)l * GH * CH * CH; const float* gbs = pp->in[5] + (size_t)l * GH * CH;
    const int tid = phase_tid(wv), lane = tid & 63, wave = tid >> 6, col = lane & 15, g = lane >> 4;
    for (int u = bid; u < NB * NCH * GH; u += nb) {
        const int h = u % GH, c = (u / GH) % NCH, b = u / (GH * NCH);
        const int tok0 = b * S + c * CH;
        const bf16_t* wb = WSB + (size_t)h * CH * CH + (size_t)(wave * 16 + col) * CH + 8 * g;
        const bf16_t* vb = VNT + ((size_t)b * GW + h * 64 + col) * S + (size_t)c * CH + 8 * g;
        f32x4 acc[4];
#pragma unroll
        for (int et = 0; et < 4; ++et) acc[et] = (f32x4){0.f, 0.f, 0.f, 0.f};
#pragma unroll
        for (int ks = 0; ks < 4; ++ks) {
            const bf16x8 af = *(const bf16x8*)(wb + ks * 32);
#pragma unroll
            for (int et = 0; et < 4; ++et) acc[et] = MFMA16(af, *(const bf16x8*)(vb + (size_t)et * 16 * S + ks * 32), acc[et]);
        }
#pragma unroll
        for (int r = 0; r < 4; ++r) {
            const int p = wave * 16 + 4 * g + r; const size_t t = (size_t)(tok0 + p); const float bsv = gbs[h * CH + p];
#pragma unroll
            for (int et = 0; et < 4; ++et) { const int ch = h * 64 + et * 16 + col; GRP[t * D + ch] = (bf16_t)f2bf(UG[t * GW + ch] * (acc[et][r] + bsv)); }
        }
    }
}

constexpr int SC_STEPS = 16;
constexpr int SC_BUF = SC_STEPS * 6 * 64;
__device__ __forceinline__ void phase_rwkv_scan(const Params& P, int l, unsigned char* smem, int wv, int bid, int nb) {
    PIN_S(bid); PIN_S(nb);
    ParamsPtr pp = PARAMS_PTR(P); PIN_S(pp); unsigned char* ws = pp->ws;
    const float* RR = (const float*)(ws + O_RR); const float* VV = (const float*)(ws + O_VV); const float* KK = (const float*)(ws + O_KK);
    const float* DEC = (const float*)(ws + O_DEC); const float* KD = (const float*)(ws + O_KD); const float* ICLR = (const float*)(ws + O_ICLR);
    float* SCAN = (float*)(ws + O_SCAN); const float* BRKR = (const float*)(ws + O_BRKR);
    const int tid = phase_tid(wv), lane = tid & 63, wave = tid >> 6, rl = (lane >> 4) & 1, kq = (lane & 15) | ((lane >> 5) << 4);
    float* buf = (float*)smem;
    float* scal = buf + 2 * SC_BUF;
    float* outb = scal + 2 * SC_STEPS * 2;
    typedef float f32x2 __attribute__((ext_vector_type(2)));
    for (int u = bid; u < 2 * NB * RH * 4; u += nb) {
        const int qt = u & 3, h = (u >> 2) % RH, b = (u / (4 * RH)) % NB, d = u / (4 * RH * NB);
        const size_t doff = (size_t)d * T * RW;
        float s0 = 0.f, s1 = 0.f;
        float pw[2], pa[2], pb[2], pk[2], pr[2], pv[2], psc = 0.f;
#define SC_LOAD(c) do { _Pragma("unroll") for (int i = 0; i < 2; ++i) { const int idx = tid + NTHREADS * i, st = idx >> 6, k = idx & 63; const int tau = (c) * SC_STEPS + st, sq = d ? S - 1 - tau : tau; \
            const size_t o = (size_t)(b * S + sq) * RW + h * 64 + k; \
            pw[i] = DEC[doff + o]; pa[i] = KK[o]; pb[i] = ICLR[doff + o]; pk[i] = KD[doff + o]; pr[i] = RR[o]; pv[i] = VV[o]; }     \
            if (tid < 2 * SC_STEPS) { const int tau = (c) * SC_STEPS + (tid >> 1), sq = d ? S - 1 - tau : tau; psc = BRKR[((size_t)(d * T + b * S + sq) * RH + h) * 2 + (tid & 1)]; } } while (0)
#define SC_WRITE(c) do { float* B_ = buf + ((c) & 1) * SC_BUF; _Pragma("unroll") for (int i = 0; i < 2; ++i) { const int idx = tid + NTHREADS * i, st = idx >> 6, k = idx & 63; \
            float* q_ = B_ + st * 384 + k; q_[0] = pw[i]; q_[64] = -pa[i]; q_[128] = pa[i] * pb[i]; q_[192] = pk[i]; q_[256] = pw[i] * pr[i]; q_[320] = pv[i]; } \
            if (tid < 2 * SC_STEPS) scal[((c) & 1) * SC_STEPS * 2 + tid] = psc; } while (0)
        __syncthreads();
        SC_LOAD(0); SC_WRITE(0);
        __syncthreads();
        const int row = qt * 16 + wave * 2 + rl;
        for (int c = 0; c < S / SC_STEPS; ++c) {
            const bool more = (c + 1) < S / SC_STEPS;
            if (more) SC_LOAD(c + 1);
            const float* B = buf + (c & 1) * SC_BUF; const float* sc = scal + (c & 1) * SC_STEPS * 2; float* ob = outb + (c & 1) * SC_STEPS * 16;
            float outs[SC_STEPS];
            f32x2 w2 = *(const f32x2*)(B + 2 * kq), a2 = *(const f32x2*)(B + 64 + 2 * kq), b2 = *(const f32x2*)(B + 128 + 2 * kq);
            f32x2 k2 = *(const f32x2*)(B + 192 + 2 * kq), wr2 = *(const f32x2*)(B + 256 + 2 * kq);
            float v = B[320 + row]; float br = sc[0], kr = sc[1];
#pragma unroll
            for (int st = 0; st < SC_STEPS; ++st) {
                const int sn = st + 1 < SC_STEPS ? st + 1 : st;
                const float* q = B + sn * 384;
                const f32x2 nw2 = *(const f32x2*)(q + 2 * kq), na2 = *(const f32x2*)(q + 64 + 2 * kq), nb2 = *(const f32x2*)(q + 128 + 2 * kq);
                const f32x2 nk2 = *(const f32x2*)(q + 192 + 2 * kq), nwr2 = *(const f32x2*)(q + 256 + 2 * kq);
                const float nv = q[320 + row], nbr = sc[sn * 2], nkr = sc[sn * 2 + 1];
                SCHED_BAR();
                float sa = s0 * a2.x + s1 * a2.y;
                float po = s0 * wr2.x + s1 * wr2.y;
                sa = row32_sum(sa); po = row32_sum(po);
                outs[st] = po + sa * br + v * kr;
                s0 = s0 * w2.x + (sa * b2.x + v * k2.x); s1 = s1 * w2.y + (sa * b2.y + v * k2.y);
                SCHED_BAR();
                w2 = nw2; a2 = na2; b2 = nb2; k2 = nk2; wr2 = nwr2; v = nv; br = nbr; kr = nkr;
            }
            if (kq == 0) {
#pragma unroll
                for (int st = 0; st < SC_STEPS; ++st) ob[st * 16 + wave * 2 + rl] = outs[st];
            }
            if (more) SC_WRITE(c + 1);
            __syncthreads();
            if (tid < 16 * SC_STEPS) {
                const int st = tid >> 4, r = tid & 15, tau = c * SC_STEPS + st, sq = d ? S - 1 - tau : tau;
                SCAN[doff + (size_t)(b * S + sq) * RW + h * 64 + qt * 16 + r] = ob[st * 16 + r];
            }
        }
#undef SC_LOAD
#undef SC_WRITE
    }
    __syncthreads();
}

constexpr int RST = 72;
constexpr int RARR = 64 * RST;
__device__ __forceinline__ f32x4 tile_nt(const bf16_t* Aa, int ta, const bf16_t* Ba, int tb, f32x4 acc, int col, int g) {
#pragma unroll
    for (int ks = 0; ks < 2; ++ks) {
        const bf16x8 af = *(const bf16x8*)(Aa + (ta * 16 + col) * RST + ks * 32 + 8 * g);
        const bf16x8 bfr = *(const bf16x8*)(Ba + (tb * 16 + col) * RST + ks * 32 + 8 * g);
        acc = MFMA16(af, bfr, acc);
    }
    return acc;
}
__device__ __forceinline__ void phase_rwkv_pre(const Params& P, int l, unsigned char* smem, int wv) {
    ParamsPtr pp = PARAMS_PTR(P); PIN_S(pp); unsigned char* ws = pp->ws; int bidx = (int)blockIdx.x, gdim = (int)gridDim.x; PIN_S(bidx); PIN_S(gdim);
    const bf16_t* RB = (const bf16_t*)(ws + O_RB); const bf16_t* VB = (const bf16_t*)(ws + O_VB); const bf16_t* KKB = (const bf16_t*)(ws + O_KKB);
    const float* LWG = (const float*)(ws + O_LW); const bf16_t* KDB = (const bf16_t*)(ws + O_KDB); const bf16_t* BBB = (const bf16_t*)(ws + O_BBB);
    bf16_t* Qg = (bf16_t*)(ws + O_RQ); bf16_t* Ag = (bf16_t*)(ws + O_RA); bf16_t* Hg = (bf16_t*)(ws + O_RH); bf16_t* Gg = (bf16_t*)(ws + O_RG);
    const int tid0 = phase_tid(wv);
#define RW_STAGE_VARS int tid = tid0; PIN_V(tid); const int lane = tid & 63, wave = tid >> 6, col = lane & 15, g = lane >> 4; (void)lane; (void)wave; (void)col; (void)g;
    bf16_t* At = (bf16_t*)smem; bf16_t* Bt = At + RARR; bf16_t* Kt = Bt + RARR; bf16_t* Rt = Kt + RARR;
    bf16_t* BtT = Rt + RARR; bf16_t* KtT = BtT + RARR; bf16_t* VT = KtT + RARR;
    bf16_t* Lak = VT + RARR; bf16_t* Mrb = Lak + RARR; bf16_t* Mrk = Mrb + RARR; bf16_t* YT = Mrk + RARR; bf16_t* W2T = YT + RARR;
    bf16_t* Lbo = W2T + RARR;
    float* LabT = (float*)(Lbo + RARR);
    float* Xs = LabT + 4096;
    float* Pb = Xs + 4096;
    float* segs = Pb + 2048;
    float* PC = segs + 512;
    float plw[8]; unsigned pkk[8], pbq[8], pkd[8], prr[8], pvv[8];
#define RW_LOAD(uu) do { const int c_ = (uu) % RNC, h_ = ((uu) / RNC) % RH, b_ = ((uu) / (RNC * RH)) % NB, d_ = (uu) / (RNC * RH * NB); const size_t doff_ = (size_t)d_ * T * RW; \
        const int ch_ = tid0 & 63, sg_ = tid0 >> 6; _Pragma("unroll") for (int j = 0; j < 8; ++j) { const int tau = c_ * RC + sg_ * 8 + j, sq = d_ ? S - 1 - tau : tau; const size_t o = (size_t)(b_ * S + sq) * RW + h_ * 64 + ch_; \
        plw[j] = LWG[doff_ + o]; pkk[j] = KKB[o]; pbq[j] = BBB[doff_ + o]; pkd[j] = KDB[doff_ + o]; prr[j] = RB[o]; pvv[j] = VB[o]; } } while (0)
    if (bidx < RUN) RW_LOAD(bidx);
    for (int u = bidx; u < RUN; u += gdim) {
        const int c = u % RNC, h = (u / RNC) % RH, b = (u / (RNC * RH)) % NB, d = u / (RNC * RH * NB);
        (void)c; (void)h; (void)b; (void)d;
        __syncthreads();
        {
            RW_STAGE_VARS
            const int ch = tid & 63, sg = tid >> 6;
            float lw[8]; unsigned kk[8], bq_[8], kd[8], rr[8], vv[8];
#pragma unroll
            for (int j = 0; j < 8; ++j) { lw[j] = plw[j]; kk[j] = pkk[j]; bq_[j] = pbq[j]; kd[j] = pkd[j]; rr[j] = prr[j]; vv[j] = pvv[j]; }
            if (u + gdim < RUN) RW_LOAD(u + gdim);
            float run = 0.f;
#pragma unroll
            for (int j = 0; j < 8; ++j) { run += lw[j]; lw[j] = run; }
            segs[sg * 64 + ch] = run;
            __syncthreads();
            float off = 0.f;
            for (int q = 0; q < sg; ++q) off += segs[q * 64 + ch];
            u32x4 pbt, pkt, pvt; unsigned tb[8], tk[8], tvv[8];
            float prev = off;
#pragma unroll
            for (int j = 0; j < 8; ++j) {
                const int t = sg * 8 + j; const float cl = off + lw[j];
                const float ep = fexp(prev), en = fexp(-cl), epc = fexp(cl);
                const unsigned a_ = f2bf(-bf_lo(kk[j]) * ep), b_ = f2bf(bf_lo(bq_[j]) * en), k_ = f2bf(bf_lo(kd[j]) * en), r_ = f2bf(bf_lo(rr[j]) * epc), v_ = vv[j];
                At[t * RST + ch] = (bf16_t)a_; Bt[t * RST + ch] = (bf16_t)b_; Kt[t * RST + ch] = (bf16_t)k_; Rt[t * RST + ch] = (bf16_t)r_;
                tb[j] = b_; tk[j] = k_; tvv[j] = v_;
                prev = cl;
            }
            if (sg == 7) PC[ch] = fexp(prev);
            pbt.x = tb[0] | (tb[1] << 16); pbt.y = tb[2] | (tb[3] << 16); pbt.z = tb[4] | (tb[5] << 16); pbt.w = tb[6] | (tb[7] << 16);
            pkt.x = tk[0] | (tk[1] << 16); pkt.y = tk[2] | (tk[3] << 16); pkt.z = tk[4] | (tk[5] << 16); pkt.w = tk[6] | (tk[7] << 16);
            pvt.x = tvv[0] | (tvv[1] << 16); pvt.y = tvv[2] | (tvv[3] << 16); pvt.z = tvv[4] | (tvv[5] << 16); pvt.w = tvv[6] | (tvv[7] << 16);
            *(u32x4*)(BtT + ch * RST + sg * 8) = pbt; *(u32x4*)(KtT + ch * RST + sg * 8) = pkt; *(u32x4*)(VT + ch * RST + sg * 8) = pvt;
            for (int z_ = tid; z_ < 2 * RARR / 8; z_ += NTHREADS) ((u32x4*)YT)[z_] = (u32x4){0u, 0u, 0u, 0u};
        }
        __syncthreads();
        {
            RW_STAGE_VARS
            const int m = wave >> 1;
            const bf16_t* Ym = (m == 0 || m == 2) ? Bt : Kt; const bf16_t* Xm = (m < 2) ? At : Rt;
#pragma unroll 1
            for (int q = 0; q < 8; ++q) {
                const int tix = (wave & 1) * 8 + q, it = tix >> 2, tt = tix & 3;
                f32x4 acc = (f32x4){0.f, 0.f, 0.f, 0.f};
                if (it <= tt) acc = tile_nt(Ym, it, Xm, tt, acc, col, g);
                const int t = tt * 16 + col, i0 = it * 16 + 4 * g;
                float o4[4];
#pragma unroll
                for (int r = 0; r < 4; ++r) { const int i = i0 + r; const bool ok = m < 2 ? (i < t) : (i <= t); o4[r] = ok ? acc[r] : 0.f; }
                if (m == 0) {
#pragma unroll
                    for (int r = 0; r < 4; ++r) LabT[(i0 + r) * 64 + t] = o4[r];
                    const bool offd = it < tt;
                    u32x2 w2; w2.x = offd ? pk2(o4[0], o4[1]) : 0u; w2.y = offd ? pk2(o4[2], o4[3]) : 0u; *(u32x2*)(Lbo + t * RST + i0) = w2;
                }
                else { bf16_t* dst = (m == 1 ? Lak : (m == 2 ? Mrb : Mrk)) + t * RST + i0; u32x2 w2; w2.x = pk2(o4[0], o4[1]); w2.y = pk2(o4[2], o4[3]); *(u32x2*)dst = w2; }
            }
        }
        __syncthreads();
        {
            RW_STAGE_VARS
#pragma unroll
            for (int q = 0; q < 2; ++q) {
                const int tix = wave * 2 + q, tt = tix >> 2, et = tix & 3;
                f32x4 acc = (f32x4){0.f, 0.f, 0.f, 0.f};
                acc = tile_nt(Lak, tt, VT, et, acc, col, g);
#pragma unroll
                for (int r = 0; r < 4; ++r) Xs[(tt * 16 + 4 * g + r) * 64 + et * 16 + col] = acc[r];
            }
        }
        __syncthreads();
        {
            RW_STAGE_VARS
#pragma unroll 1
            for (int bb = 0; bb < 4; ++bb) {
                if (bb > 0) {
                    const bf16_t* Zt = (wave < 4 ? YT : W2T) + ((wave & 3) * 16 + col) * RST + 8 * g;
                    const bf16_t* La = Lbo + (16 * bb + col) * RST + 8 * g;
                    f32x4 acc = (f32x4){0.f, 0.f, 0.f, 0.f};
                    acc = MFMA16(*(const bf16x8*)La, *(const bf16x8*)Zt, acc);
                    if (bb > 2) acc = MFMA16(*(const bf16x8*)(La + 32), *(const bf16x8*)(Zt + 32), acc);
#pragma unroll
                    for (int r = 0; r < 4; ++r) Pb[(4 * g + r) * 128 + wave * 16 + col] = acc[r];
                }
                __syncthreads();
                if (wave < 2) {
                    float acc[16];
                    if (wave == 0) {
#pragma unroll
                        for (int r = 0; r < 16; ++r) acc[r] = bf_lo((unsigned)At[(16 * bb + r) * RST + lane]);
                    } else {
#pragma unroll
                        for (int r = 0; r < 16; ++r) acc[r] = Xs[(16 * bb + r) * 64 + lane];
                    }
                    if (bb > 0) {
#pragma unroll
                        for (int r = 0; r < 16; ++r) acc[r] += Pb[r * 128 + wave * 64 + lane];
                    }
                    const float* dp = LabT + (16 * bb) * 64 + 16 * bb;
#pragma unroll
                    for (int r = 1; r < 16; ++r)
#pragma unroll
                        for (int r2 = 0; r2 < r; ++r2) acc[r] += dp[r2 * 64 + r] * acc[r2];
                    bf16_t* dst = (wave == 0 ? YT : W2T) + lane * RST;
                    u32x4 w0, w1;
                    w0.x = pk2(acc[0], acc[1]); w0.y = pk2(acc[2], acc[3]); w0.z = pk2(acc[4], acc[5]); w0.w = pk2(acc[6], acc[7]);
                    w1.x = pk2(acc[8], acc[9]); w1.y = pk2(acc[10], acc[11]); w1.z = pk2(acc[12], acc[13]); w1.w = pk2(acc[14], acc[15]);
                    *(u32x4*)(dst + 16 * bb) = w0; *(u32x4*)(dst + 16 * bb + 8) = w1;
                }
                __syncthreads();
            }
        }
        __syncthreads();
        {
            RW_STAGE_VARS
            const int ty = wave >> 1;
#pragma unroll 1
            for (int q = 0; q < 8; ++q) {
                const int tix = (wave & 1) * 8 + q, ra = tix >> 2, cb = tix & 3;
                f32x4 acc = (f32x4){0.f, 0.f, 0.f, 0.f};
                if (ty == 0) {
                    acc = tile_nt(YT, ra, Mrb, cb, acc, col, g);
                    const u32x2 rt2 = *(const u32x2*)(Rt + (cb * 16 + col) * RST + ra * 16 + 4 * g);
                    u32x2 qb2; qb2.x = pk2(acc[0] + bf_lo(rt2.x), acc[1] + bf_hi(rt2.x)); qb2.y = pk2(acc[2] + bf_lo(rt2.y), acc[3] + bf_hi(rt2.y));
                    *(u32x2*)(Qg + (size_t)u * 4096 + (tix * 64 + lane) * 4) = qb2;
                } else if (ty == 1) {
                    acc = tile_nt(Mrb, ra, W2T, cb, acc, col, g); acc = tile_nt(Mrk, ra, VT, cb, acc, col, g);
                    { u32x2 hb; hb.x = pk2(acc[0], acc[1]); hb.y = pk2(acc[2], acc[3]); *(u32x2*)(Hg + (size_t)u * 4096 + (tix * 64 + lane) * 4) = hb; }
                } else if (ty == 2) {
                    acc = tile_nt(YT, ra, BtT, cb, acc, col, g);
                    const float pc = PC[cb * 16 + col]; const int k1 = cb * 16 + col;
                    float a4[4];
#pragma unroll
                    for (int r = 0; r < 4; ++r) a4[r] = pc * (acc[r] + ((ra * 16 + 4 * g + r) == k1 ? 1.0f : 0.f));
                    u32x2 ab2; ab2.x = pk2(a4[0], a4[1]); ab2.y = pk2(a4[2], a4[3]);
                    *(u32x2*)(Ag + (size_t)u * 4096 + (tix * 64 + lane) * 4) = ab2;
                } else {
                    acc = tile_nt(BtT, ra, W2T, cb, acc, col, g); acc = tile_nt(KtT, ra, VT, cb, acc, col, g);
#pragma unroll
                    for (int r = 0; r < 4; ++r) acc[r] *= PC[ra * 16 + 4 * g + r];
                    { u32x2 gb2; gb2.x = pk2(acc[0], acc[1]); gb2.y = pk2(acc[2], acc[3]); *(u32x2*)(Gg + (size_t)u * 4096 + (tix * 64 + lane) * 4) = gb2; }
                }
            }
        }
    }
    __syncthreads();
#undef RW_STAGE_VARS
#undef RW_LOAD
}
__device__ __forceinline__ void phase_rwkv_seq(const Params& P, int l, unsigned char* smem, int wv) {
    ParamsPtr pp = PARAMS_PTR(P); PIN_S(pp); unsigned char* ws = pp->ws; int bidx = (int)blockIdx.x, gdim = (int)gridDim.x; PIN_S(bidx); PIN_S(gdim);
    const bf16_t* Ag = (const bf16_t*)(ws + O_RA); const bf16_t* Gg = (const bf16_t*)(ws + O_RG); bf16_t* Sg = (bf16_t*)(ws + O_RS);
    const int tid = phase_tid(wv), lane = tid & 63, wave = tid >> 6, col = lane & 15, g = lane >> 4;
    const int gw = wave * gdim + bidx, ngw = NWAVES * gdim;
    for (int un = gw; un < 2 * NB * RH * 2; un += ngw) {
        const int ch = un >> 1, eh = un & 1;
        f32x4 acc[4][2];
#pragma unroll
        for (int a_ = 0; a_ < 4; ++a_)
#pragma unroll
            for (int b_ = 0; b_ < 2; ++b_) acc[a_][b_] = (f32x4){0.f, 0.f, 0.f, 0.f};
        u32x2 alo[4][2], ahi[4][2]; u32x2 gq[4][2];
        const unsigned aoff = (unsigned)(col * 64 + 4 * g), goff = (unsigned)(lane * 4);
#define RS_LOAD(cc) do { const bf16_t* ab_ = Ag + (size_t)(ch * RNC + (cc)) * 4096; const bf16_t* gb_ = Gg + (size_t)(ch * RNC + (cc)) * 4096 + eh * 512; \
            _Pragma("unroll") for (int ra = 0; ra < 4; ++ra) _Pragma("unroll") for (int p = 0; p < 2; ++p) { alo[ra][p] = *(const u32x2*)(ab_ + ((2 * p * 4 + ra) * 256) + goff); ahi[ra][p] = *(const u32x2*)(ab_ + (((2 * p + 1) * 4 + ra) * 256) + goff); } \
            _Pragma("unroll") for (int ra = 0; ra < 4; ++ra) _Pragma("unroll") for (int cb = 0; cb < 2; ++cb) gq[ra][cb] = *(const u32x2*)(gb_ + ((ra * 4 + cb) * 256) + goff); } while (0)
        RS_LOAD(0);
#pragma unroll 1
        for (int c = 0; c < RNC; ++c) {
            bf16_t* sb_ = Sg + (size_t)(ch * RNC + c) * 4096 + eh * 2048;
            bf16x8 bq[2][2];
#pragma unroll
            for (int cb = 0; cb < 2; ++cb) {
#pragma unroll
                for (int ra = 0; ra < 4; ++ra) {
                    u32x2 w2; w2.x = pk2(acc[ra][cb][0], acc[ra][cb][1]); w2.y = pk2(acc[ra][cb][2], acc[ra][cb][3]);
                    *(u32x2*)(sb_ + (cb * 1024 + ra * 16) + aoff) = w2;
                }
#pragma unroll
                for (int p = 0; p < 2; ++p) bq[p][cb] = cvt8(acc[2 * p][cb], acc[2 * p + 1][cb]);
            }
            u32x4 af[4][2];
#pragma unroll
            for (int ra = 0; ra < 4; ++ra) {
#pragma unroll
                for (int p = 0; p < 2; ++p) af[ra][p] = (u32x4){alo[ra][p].x, alo[ra][p].y, ahi[ra][p].x, ahi[ra][p].y};
#pragma unroll
                for (int cb = 0; cb < 2; ++cb) acc[ra][cb] = (f32x4){bf_lo(gq[ra][cb].x), bf_hi(gq[ra][cb].x), bf_lo(gq[ra][cb].y), bf_hi(gq[ra][cb].y)};
            }
            if (c + 1 < RNC) RS_LOAD(c + 1);
#pragma unroll
            for (int ra = 0; ra < 4; ++ra)
#pragma unroll
                for (int cb = 0; cb < 2; ++cb)
#pragma unroll
                    for (int p = 0; p < 2; ++p) acc[ra][cb] = MFMA16(__builtin_bit_cast(bf16x8, af[ra][p]), bq[p][cb], acc[ra][cb]);
        }
#undef RS_LOAD
    }
}
__device__ __forceinline__ void phase_rwkv_out(const Params& P, int l, unsigned char* smem, int wv) {
    ParamsPtr pp = PARAMS_PTR(P); PIN_S(pp); unsigned char* ws = pp->ws; int bidx = (int)blockIdx.x, gdim = (int)gridDim.x; PIN_S(bidx); PIN_S(gdim);
    const bf16_t* Qg = (const bf16_t*)(ws + O_RQ); const bf16_t* Sg = (const bf16_t*)(ws + O_RS); const bf16_t* Hg = (const bf16_t*)(ws + O_RH);
    const bf16_t* VB = (const bf16_t*)(ws + O_VB); const float* GATE = (const float*)(ws + O_GATE); const float* BONUS = (const float*)(ws + O_BONUS);
    bf16_t* GRP = (bf16_t*)(ws + O_GRP);
    const float* rln_g = pp->in[15] + (size_t)l * RW; const float* rln_b = pp->in[16] + (size_t)l * RW;
    const int tid = phase_tid(wv), lane = tid & 63, wave = tid >> 6, col = lane & 15, g = lane >> 4;
    for (int pu = bidx * NWAVES + wave; pu < NB * RH * RNC; pu += gdim * NWAVES) {
        const int c = pu % RNC, h = (pu / RNC) % RH, b = pu / (RNC * RH);
        f32x4 o[2][4][4];
#pragma unroll
        for (int d = 0; d < 2; ++d) {
            const int u = ((d * NB + b) * RH + h) * RNC + (d ? RNC - 1 - c : c);
            const size_t ub = (size_t)u * 4096;
            bf16x8 qa[4][2], sb[4][2];
#pragma unroll
            for (int q = 0; q < 4; ++q)
#pragma unroll
                for (int ks = 0; ks < 2; ++ks) {
                    const u32x2 q0 = *(const u32x2*)(Qg + ub + ((2 * ks * 4 + q) * 64 + lane) * 4), q1 = *(const u32x2*)(Qg + ub + (((2 * ks + 1) * 4 + q) * 64 + lane) * 4);
                    qa[q][ks] = __builtin_bit_cast(bf16x8, (u32x4){q0.x, q0.y, q1.x, q1.y});
                    const bf16_t* sp_ = Sg + ub + (q * 16 + col) * 64 + ks * 32 + 4 * g;
                    const u32x2 s0_ = *(const u32x2*)sp_, s1_ = *(const u32x2*)(sp_ + 16);
                    sb[q][ks] = __builtin_bit_cast(bf16x8, (u32x4){s0_.x, s0_.y, s1_.x, s1_.y});
                }
#pragma unroll
            for (int tt = 0; tt < 4; ++tt)
#pragma unroll
                for (int et = 0; et < 4; ++et) {
                    const u32x2 hb = *(const u32x2*)(Hg + ub + ((tt * 4 + et) * 64 + lane) * 4);
                    f32x4 acc = (f32x4){bf_lo(hb.x), bf_hi(hb.x), bf_lo(hb.y), bf_hi(hb.y)};
#pragma unroll
                    for (int ks = 0; ks < 2; ++ks) acc = MFMA16(qa[tt][ks], sb[et][ks], acc);
                    o[d][tt][et] = acc;
                }
        }
        const int src = (3 - g) * 16 + col;
#pragma unroll
        for (int tt = 0; tt < 4; ++tt)
#pragma unroll
            for (int et = 0; et < 4; ++et)
#pragma unroll
                for (int r = 0; r < 4; ++r) o[0][tt][et][r] += SHL(o[1][3 - tt][et][3 - r], src);
        float* tile = (float*)smem + wave * (64 * 68);
        WAVE_SYNC();
#pragma unroll
        for (int tt = 0; tt < 4; ++tt)
#pragma unroll
            for (int et = 0; et < 4; ++et)
#pragma unroll
                for (int r = 0; r < 4; ++r) tile[(tt * 16 + 4 * g + r) * 68 + et * 16 + col] = o[0][tt][et][r];
        WAVE_SYNC();
        {
            const int c4 = (lane & 15) * 4, ch = h * 64 + c4;
            const f32x4 lg = *(const f32x4*)(rln_g + ch), lb = *(const f32x4*)(rln_b + ch);
#pragma unroll 1
            for (int qb = 0; qb < 2; ++qb) {
                f32x4 gt_[8]; u32x2 vb_[8]; float bo_[8];
#pragma unroll
                for (int q8 = 0; q8 < 8; ++q8) {
                    const size_t t = (size_t)(b * S + c * RC + (qb * 8 + q8) * 4 + (lane >> 4));
                    gt_[q8] = *(const f32x4*)(GATE + t * RW + ch); vb_[q8] = *(const u32x2*)(VB + t * RW + ch); bo_[q8] = BONUS[t * RH + h];
                }
#pragma unroll
                for (int q8 = 0; q8 < 8; ++q8) {
                    const int tl = (qb * 8 + q8) * 4 + (lane >> 4);
                    const size_t t = (size_t)(b * S + c * RC + tl);
                    const f32x4 x = *(const f32x4*)(tile + tl * 68 + c4);
                    const float mean = row16_sum((x.x + x.y) + (x.z + x.w)) * (1.0f / 64.0f);
                    const f32x4 dl = x - mean;
                    const float var = row16_sum((dl.x * dl.x + dl.y * dl.y) + (dl.z * dl.z + dl.w * dl.w)) * (1.0f / 64.0f);
                    const float rstd = 1.0f / sqrtf(var + GN_EPS);
                    f32x4 y = dl * rstd * lg + lb;
                    y.x += bo_[q8] * bf_lo(vb_[q8].x); y.y += bo_[q8] * bf_hi(vb_[q8].x); y.z += bo_[q8] * bf_lo(vb_[q8].y); y.w += bo_[q8] * bf_hi(vb_[q8].y);
                    y = y * gt_[q8];
                    u32x2 ob; ob.x = pk2(y.x, y.y); ob.y = pk2(y.z, y.w);
                    *(u32x2*)(GRP + t * D + GW + ch) = ob;
                }
            }
        }
    }
    __syncthreads();
}

__device__ __forceinline__ void phase_mlstm_local(const Params& P, int l, unsigned char* smem, int wv, int bid, int nb) {
    PIN_S(bid); PIN_S(nb);
    ParamsPtr pp = PARAMS_PTR(P); PIN_S(pp); unsigned char* ws = pp->ws;
    const bf16_t* KT = (const bf16_t*)(ws + O_KT); const bf16_t* VT = (const bf16_t*)(ws + O_VT);
    const float* IG = (const float*)(ws + O_IG); const float* LF = (const float*)(ws + O_LF);
    float* CL = (float*)(ws + O_CL); float* NLb = (float*)(ws + O_NL); float* ML = (float*)(ws + O_ML); float* BL = (float*)(ws + O_BL);
    float* GVT = (float*)(ws + O_GVT); float* PMX = (float*)(ws + O_PMX); float* BCT = (float*)(ws + O_BCT);
    const int tid = phase_tid(wv), lane = tid & 63, wave = tid >> 6, col = lane & 15, g = lane >> 4;
    float* wts = (float*)smem + wave * 128;
    for (int u = bid * NWAVES + wave; u < 2 * NB * MH * NCH; u += nb * NWAVES) {
        const int c = u % NCH, h = (u / NCH) % MH, p = u / (NCH * MH), d = p / NB, b = p % NB;
        const int tc = d ? NCH - 1 - c : c, tok0 = b * S + tc * CH;
        const int i0 = d ? 127 - 2 * lane : 2 * lane, i1 = d ? i0 - 1 : i0 + 1;
        const size_t g0 = ((size_t)d * T + tok0 + i0) * MH + h, g1 = ((size_t)d * T + tok0 + i1) * MH + h;
        const float lf0 = LF[g0], lf1 = LF[g1], ig0 = IG[g0], ig1 = IG[g1];
        const float c1 = lf0 + lf1;
        float incl = c1;
#pragma unroll
        for (int o = 1; o < 64; o <<= 1) { const float tq = SHUP(incl, o, lane); if (lane >= o) incl += tq; }
        const float excl = incl - c1, bc0 = excl + lf0, bc1 = incl;
        const float blast = RDL(incl, 63);
        const float gv0 = ig0 - bc0, gv1 = ig1 - bc1, pl1 = fmaxf(gv0, gv1);
        float mincl = pl1;
#pragma unroll
        for (int o = 1; o < 64; o <<= 1) { const float tq = SHUP(mincl, o, lane); if (lane >= o) mincl = fmaxf(mincl, tq); }
        float mexcl = SHUP(mincl, 1, lane); if (lane == 0) mexcl = -INFINITY;
        const float pm0 = fmaxf(mexcl, gv0), pm1 = mincl;
        const float mloc = blast + RDL(mincl, 63);
        WAVE_SYNC();
        wts[i0] = fexp(blast + gv0 - mloc); wts[i1] = fexp(blast + gv1 - mloc);
        GVT[g0] = gv0; GVT[g1] = gv1; PMX[g0] = pm0; PMX[g1] = pm1; BCT[g0] = bc0; BCT[g1] = bc1;
        if (lane == 0) { ML[u] = mloc; BL[u] = blast; }
        WAVE_SYNC();
        const bf16_t* vbase = VT + ((size_t)(b * MH + h) * 64) * S + (size_t)tc * CH;
        const bf16_t* kbase = KT + ((size_t)(b * MH + h) * 64) * S + (size_t)tc * CH;
        const unsigned loff = (unsigned)(col * S + 8 * g);
        f32x4 acc[4][4];
#pragma unroll
        for (int a_ = 0; a_ < 4; ++a_)
#pragma unroll
            for (int b_ = 0; b_ < 4; ++b_) acc[a_][b_] = (f32x4){0.f, 0.f, 0.f, 0.f};
        float nsum[4] = {0.f, 0.f, 0.f, 0.f};
#pragma unroll 1
        for (int ks = 0; ks < 4; ++ks) {
            const int ii = ks * 32 + 8 * g;
            const f32x4 w0 = *(const f32x4*)(wts + ii), w1 = *(const f32x4*)(wts + ii + 4);
            bf16x8 af[4], bfk[4];
#pragma unroll
            for (int q = 0; q < 4; ++q) af[q] = *(const bf16x8*)(vbase + ((size_t)q * 16 * S + ks * 32) + loff);
#pragma unroll
            for (int q = 0; q < 4; ++q) {
                const u32x4 kr = *(const u32x4*)(kbase + ((size_t)q * 16 * S + ks * 32) + loff);
                f32x4 k0, k1;
                k0.x = bf_lo(kr.x) * w0.x; k0.y = bf_hi(kr.x) * w0.y; k0.z = bf_lo(kr.y) * w0.z; k0.w = bf_hi(kr.y) * w0.w;
                k1.x = bf_lo(kr.z) * w1.x; k1.y = bf_hi(kr.z) * w1.y; k1.z = bf_lo(kr.w) * w1.z; k1.w = bf_hi(kr.w) * w1.w;
                nsum[q] += (k0.x + k0.y) + (k0.z + k0.w) + (k1.x + k1.y) + (k1.z + k1.w);
                bfk[q] = cvt8(k0, k1);
            }
#pragma unroll
            for (int a_ = 0; a_ < 4; ++a_)
#pragma unroll
                for (int b_ = 0; b_ < 4; ++b_) acc[a_][b_] = MFMA16(af[a_], bfk[b_], acc[a_][b_]);
        }
        float* cbase = CL + (size_t)u * 4096;
        const unsigned coff = (unsigned)(4 * g * 64 + col);
#pragma unroll
        for (int b_ = 0; b_ < 4; ++b_) {
#pragma unroll
            for (int a_ = 0; a_ < 4; ++a_)
#pragma unroll
                for (int r = 0; r < 4; ++r) cbase[(a_ * 16 * 64 + r * 64 + b_ * 16) + coff] = acc[a_][b_][r];
            float ns = nsum[b_]; ns += SHX(ns, 16, lane); ns += SHX(ns, 32, lane);
            if (g == 0) NLb[(size_t)u * 64 + b_ * 16 + col] = ns;
        }
    }
    __syncthreads();
}

__device__ __forceinline__ void phase_mlstm_carry(const Params& P, int l, unsigned char* smem, int wv) {
    ParamsPtr pp = PARAMS_PTR(P); PIN_S(pp); unsigned char* ws = pp->ws; int bidx = (int)blockIdx.x, gdim = (int)gridDim.x; PIN_S(bidx); PIN_S(gdim);
    float* CL = (float*)(ws + O_CL); float* NLb = (float*)(ws + O_NL); const float* ML = (const float*)(ws + O_ML); const float* BL = (const float*)(ws + O_BL);
    float* MIN = (float*)(ws + O_MIN);
    const int total = 2 * NB * MH * 4160;
    const int tid = phase_tid(wv);
    for (int gi = bidx * NTHREADS + tid; gi < total; gi += gdim * NTHREADS) {
        const int ph = gi / 4160, e = gi % 4160;
        float* base_ = e < 4096 ? CL + (size_t)ph * NCH * 4096 + e : NLb + (size_t)ph * NCH * 64 + (e - 4096);
        const int stride = e < 4096 ? 4096 : 64;
        static_assert(NCH <= 32, "carry scan keeps one chunk value per register");
        float loc[NCH], bl[NCH], ml[NCH];
#pragma unroll
        for (int c = 0; c < NCH; ++c) { loc[c] = base_[(size_t)c * stride]; bl[c] = BL[ph * NCH + c]; ml[c] = ML[ph * NCH + c]; }
        float m = 0.f, val = 0.f;
#pragma unroll
        for (int c = 0; c < NCH; ++c) {
            base_[(size_t)c * stride] = val;
            if (e == 0) MIN[ph * NCH + c] = m;
            const float mn = fmaxf(bl[c] + m, ml[c]);
            val = fexp(bl[c] + m - mn) * val + fexp(ml[c] - mn) * loc[c];
            m = mn;
        }
    }
}

__device__ __forceinline__ void phase_mlstm_out(const Params& P, int l, unsigned char* smem, int wv) {
    ParamsPtr pp = PARAMS_PTR(P); PIN_S(pp); unsigned char* ws = pp->ws; int bidx = (int)blockIdx.x, gdim = (int)gridDim.x; PIN_S(bidx); PIN_S(gdim);
    const bf16_t* proj = (const bf16_t*)(ws + O_PROJ);
    const bf16_t* MQB = (const bf16_t*)(ws + O_MQB); const bf16_t* MKB = (const bf16_t*)(ws + O_MKB); const bf16_t* VT = (const bf16_t*)(ws + O_VT);
    const float* GVT = (const float*)(ws + O_GVT); const float* PMX = (const float*)(ws + O_PMX); const float* BCT = (const float*)(ws + O_BCT);
    const float* CL = (const float*)(ws + O_CL); const float* NLb = (const float*)(ws + O_NL); const float* MIN = (const float*)(ws + O_MIN);
    bf16_t* GRP = (bf16_t*)(ws + O_GRP);
    const float* mln_g = pp->in[20] + (size_t)l * MW;
    const int tid = phase_tid(wv), lane = tid & 63, wave = tid >> 6, col = lane & 15, g = lane >> 4;
    constexpr int KP = 72, VP = 136;
    bf16_t* Ks = (bf16_t*)smem;
    bf16_t* Vs = Ks + 128 * KP;
    float* gvs_ = (float*)(Vs + 64 * VP);
    for (int u = bidx; u < NB * MH * NCH; u += gdim) {
        const int tc = u % NCH, h = (u / NCH) % MH, b = u / (NCH * MH);
        const int tok0 = b * S + tc * CH, it = wave * 16 + col;
        __syncthreads();
        {
            u32x4 kb_[2], vb_[2];
#pragma unroll
            for (int q = 0; q < 2; ++q) {
                const int idx = tid + q * NTHREADS;
                kb_[q] = *(const u32x4*)(MKB + (size_t)(tok0 + (idx >> 3)) * MW + h * 64 + (idx & 7) * 8);
                vb_[q] = *(const u32x4*)(VT + ((size_t)(b * MH + h) * 64 + (idx >> 4)) * S + (size_t)tc * CH + (idx & 15) * 8);
            }
            float gq_ = 0.f;
            if (tid < 256) gq_ = GVT[((size_t)(tid >> 7) * T + tok0 + (tid & 127)) * MH + h];
#pragma unroll
            for (int q = 0; q < 2; ++q) {
                const int idx = tid + q * NTHREADS;
                *(u32x4*)(Ks + (idx >> 3) * KP + (idx & 7) * 8) = kb_[q];
                *(u32x4*)(Vs + (idx >> 4) * VP + (idx & 15) * 8) = vb_[q];
            }
            if (tid < 256) gvs_[tid] = gq_;
        }
        __syncthreads();
        const size_t trow = (size_t)(tok0 + it);
        bf16x8 bq[2];
#pragma unroll
        for (int ks = 0; ks < 2; ++ks) bq[ks] = *(const bf16x8*)(MQB + trow * MW + h * 64 + ks * 32 + 8 * g);
        f32x4 hs[4];
#pragma unroll
        for (int et = 0; et < 4; ++et) hs[et] = (f32x4){0.f, 0.f, 0.f, 0.f};
#pragma unroll
        for (int d = 0; d < 2; ++d) {
            const int cd = d ? NCH - 1 - tc : tc;
            const int su = ((d * NB + b) * MH + h) * NCH + cd;
            const size_t gt = ((size_t)d * T + trow) * MH + h;
            const float mst = MIN[su];
            const float mxt = fmaxf(PMX[gt], mst), mt = BCT[gt] + mxt, wint = fexp(mst - mxt);
            f32x4 num[4];
#pragma unroll
            for (int et = 0; et < 4; ++et) num[et] = (f32x4){0.f, 0.f, 0.f, 0.f};
            float den = 0.f;
            for (int sp = 0; sp < 4; ++sp) {
                if (d == 0 ? (2 * sp > wave) : (2 * sp + 1 < wave)) continue;
                float pw[8];
#pragma unroll
                for (int hf = 0; hf < 2; ++hf) {
                    const int st = 2 * sp + hf;
                    f32x4 sacc = (f32x4){0.f, 0.f, 0.f, 0.f};
#pragma unroll
                    for (int ks = 0; ks < 2; ++ks) sacc = MFMA16(*(const bf16x8*)(Ks + (st * 16 + col) * KP + ks * 32 + 8 * g), bq[ks], sacc);
                    const f32x4 g4 = *(const f32x4*)(gvs_ + d * 128 + st * 16 + 4 * g);
#pragma unroll
                    for (int r = 0; r < 4; ++r) {
                        const int is = st * 16 + 4 * g + r;
                        const bool ok = d == 0 ? (is <= it) : (is >= it);
                        const float pr = ok ? sacc[r] * fexp(g4[r] - mxt) : 0.f;
                        den += pr; pw[hf * 4 + r] = pr;
                    }
                }
                u32x4 pb; pb.x = pk2(pw[0], pw[1]); pb.y = pk2(pw[2], pw[3]); pb.z = pk2(pw[4], pw[5]); pb.w = pk2(pw[6], pw[7]);
                const bf16x8 bp = __builtin_bit_cast(bf16x8, pb);
#pragma unroll
                for (int et = 0; et < 4; ++et) {
                    const bf16_t* vp = Vs + (et * 16 + col) * VP + sp * 32 + 4 * g;
                    const u32x2 v0 = *(const u32x2*)vp, v1 = *(const u32x2*)(vp + 16);
                    u32x4 va; va.x = v0.x; va.y = v0.y; va.z = v1.x; va.w = v1.y;
                    num[et] = MFMA16(__builtin_bit_cast(bf16x8, va), bp, num[et]);
                }
            }
            den += SHX(den, 16, lane); den += SHX(den, 32, lane);
            f32x4 qc[4]; float qn = 0.f;
#pragma unroll
            for (int ks = 0; ks < 2; ++ks) {
                const float* np = NLb + (size_t)su * 64 + ks * 32 + 8 * g;
                const f32x4 n0 = *(const f32x4*)np, n1 = *(const f32x4*)(np + 4);
                const u32x4 qb = __builtin_bit_cast(u32x4, bq[ks]);
                qn += (bf_lo(qb.x) * n0.x + bf_hi(qb.x) * n0.y) + (bf_lo(qb.y) * n0.z + bf_hi(qb.y) * n0.w) + (bf_lo(qb.z) * n1.x + bf_hi(qb.z) * n1.y) + (bf_lo(qb.w) * n1.z + bf_hi(qb.w) * n1.w);
            }
            qn += SHX(qn, 16, lane); qn += SHX(qn, 32, lane);
#pragma unroll
            for (int et = 0; et < 4; ++et) {
                qc[et] = (f32x4){0.f, 0.f, 0.f, 0.f};
#pragma unroll
                for (int ks = 0; ks < 2; ++ks) {
                    const float* cp = CL + (size_t)su * 4096 + (size_t)(et * 16 + col) * 64 + ks * 32 + 8 * g;
                    qc[et] = MFMA16(cvt8(*(const f32x4*)cp, *(const f32x4*)(cp + 4)), bq[ks], qc[et]);
                }
            }
            const float dd = frcp(fmaxf(fabsf(den + wint * qn), fexp(-mt)));
#pragma unroll
            for (int et = 0; et < 4; ++et) hs[et] += (num[et] + wint * qc[et]) * dd;
        }
        float sm = 0.f;
#pragma unroll
        for (int et = 0; et < 4; ++et) sm += (hs[et].x + hs[et].y) + (hs[et].z + hs[et].w);
        sm += SHX(sm, 16, lane); sm += SHX(sm, 32, lane);
        const float mean = sm * (1.0f / 64.0f); float q = 0.f;
#pragma unroll
        for (int et = 0; et < 4; ++et) { const f32x4 dl = hs[et] - mean; q += (dl.x * dl.x + dl.y * dl.y) + (dl.z * dl.z + dl.w * dl.w); }
        q += SHX(q, 16, lane); q += SHX(q, 32, lane);
        const float rstd = 1.0f / sqrtf(q * (1.0f / 64.0f) + LN_EPS);
#pragma unroll
        for (int et = 0; et < 4; ++et) {
            const int c = h * 64 + et * 16 + 4 * g;
            const u32x2 ob_ = *(const u32x2*)(proj + trow * PLD + C_MW + 3 * MW + c); const f32x4 o4 = (f32x4){bf_lo(ob_.x), bf_hi(ob_.x), bf_lo(ob_.y), bf_hi(ob_.y)}, g4 = *(const f32x4*)(mln_g + c);
            const f32x4 y = (hs[et] - mean) * rstd * g4;
            u32x2 ob; ob.x = pk2(sigmoidf_(o4.x) * y.x, sigmoidf_(o4.y) * y.y); ob.y = pk2(sigmoidf_(o4.z) * y.z, sigmoidf_(o4.w) * y.w);
            *(u32x2*)(GRP + trow * D + GW + RW + c) = ob;
        }
    }
    __syncthreads();
}

__device__ __forceinline__ void phase_rwkv_post(const Params& P, int l, unsigned char* smem, int wv) {
    ParamsPtr pp = PARAMS_PTR(P); PIN_S(pp); unsigned char* ws = pp->ws; int bidx = (int)blockIdx.x, gdim = (int)gridDim.x; PIN_S(bidx); PIN_S(gdim);
    const float* SCAN = (const float*)(ws + O_SCAN); const float* VV = (const float*)(ws + O_VV); const float* GATE = (const float*)(ws + O_GATE);
    const float* BONUS = (const float*)(ws + O_BONUS); bf16_t* GRP = (bf16_t*)(ws + O_GRP);
    const float* rln_g = pp->in[15] + (size_t)l * RW; const float* rln_b = pp->in[16] + (size_t)l * RW;
    const int tid = phase_tid(wv), lane = tid & 63, wave = tid >> 6;
    const int gw = bidx * NWAVES + wave, ngw = NWAVES * gdim;
    for (int it = gw; it < T * RH; it += ngw) {
        const int t = it / RH, h = it % RH, c = h * 64 + lane;
        const size_t o = (size_t)t * RW + c;
        const float x = SCAN[o] + SCAN[(size_t)T * RW + o];
        const float mean = wave_sum(x, lane) * (1.0f / 64.0f);
        const float dl = x - mean;
        const float var = wave_sum(dl * dl, lane) * (1.0f / 64.0f);
        float y = dl / sqrtf(var + GN_EPS) * rln_g[c] + rln_b[c];
        y += BONUS[(size_t)t * RH + h] * VV[o];
        GRP[(size_t)t * D + GW + c] = (bf16_t)f2bf(y * GATE[o]);
    }
}

__device__ __forceinline__ void phase_ln1_router(const Params& P, int l, unsigned char* smem, int wv) {
    ParamsPtr pp = PARAMS_PTR(P); PIN_S(pp); unsigned char* ws = pp->ws; int bidx = (int)blockIdx.x, gdim = (int)gridDim.x; PIN_S(bidx); PIN_S(gdim);
    const float* xin = l == 0 ? pp->in[0] : (const float*)(ws + O_XA);
    const bf16_t* MIX = (const bf16_t*)(ws + O_MIX); float* X1 = (float*)(ws + O_X1);
    int* TOPI = (int*)(ws + O_TOPI); float* TOPG = (float*)(ws + O_TOPG); int* RANK = (int*)(ws + O_RANK); bf16_t* X1B = (bf16_t*)(ws + O_X1B);
    int* BCNT = (int*)(ws + O_BCNT);
    const float* g1 = pp->in[22] + (size_t)l * D; const float* b1 = pp->in[23] + (size_t)l * D;
    const float* rw = pp->in[24] + (size_t)l * D * NE; const float* rb = pp->in[25] + (size_t)l * NE;
    const bf16_t* RWT = (const bf16_t*)(ws + O_RWT) + (size_t)l * 2 * NE * D;
    const int tid = phase_tid(wv), lane = tid & 63, wave = tid >> 6, col = lane & 15, g = lane >> 4;
    float* lgs = (float*)smem;
    int* stopi = (int*)(smem + 8192);
    for (int tile = bidx; tile < T / 64; tile += gdim) {
        __syncthreads();
        {
            f32x4 xa[4]; u32x2 xm[4];
#define LN1_LOAD(tt_) do { _Pragma("unroll") for (int j = 0; j < 4; ++j) { const int c = j * 256 + lane * 4; xa[j] = *(const f32x4*)(xin + (size_t)(tt_) * D + c); xm[j] = *(const u32x2*)(MIX + (size_t)(tt_) * D + c); } } while (0)
            LN1_LOAD(tile * 64 + wave * 8);
#pragma unroll 1
            for (int ti8 = 0; ti8 < 8; ++ti8) {
                const int t = tile * 64 + wave * 8 + ti8;
                float v[16]; float sm = 0.f;
#pragma unroll
                for (int j = 0; j < 4; ++j) {
                    v[j * 4 + 0] = ALPHA * xa[j].x + bf_lo(xm[j].x); v[j * 4 + 1] = ALPHA * xa[j].y + bf_hi(xm[j].x); v[j * 4 + 2] = ALPHA * xa[j].z + bf_lo(xm[j].y); v[j * 4 + 3] = ALPHA * xa[j].w + bf_hi(xm[j].y);
                    sm += (v[j * 4] + v[j * 4 + 1]) + (v[j * 4 + 2] + v[j * 4 + 3]);
                }
                if (ti8 < 7) LN1_LOAD(t + 1);
                const float mean = wave_sum_fast(sm, lane) * (1.0f / D); float q = 0.f;
#pragma unroll
                for (int j = 0; j < 16; ++j) { const float dl = v[j] - mean; q += dl * dl; }
                const float rstd = 1.0f / sqrtf(wave_sum_fast(q, lane) * (1.0f / D) + LN_EPS);
#pragma unroll
                for (int j = 0; j < 4; ++j) {
                    const int c = j * 256 + lane * 4;
                    const f32x4 gg = *(const f32x4*)(g1 + c), bb = *(const f32x4*)(b1 + c);
                    f32x4 o;
                    o.x = (v[j * 4 + 0] - mean) * rstd * gg.x + bb.x; o.y = (v[j * 4 + 1] - mean) * rstd * gg.y + bb.y;
                    o.z = (v[j * 4 + 2] - mean) * rstd * gg.z + bb.z; o.w = (v[j * 4 + 3] - mean) * rstd * gg.w + bb.w;
                    *(f32x4*)(X1 + (size_t)t * D + c) = o;
                    u32x2 ob; ob.x = pk2(o.x, o.y); ob.y = pk2(o.z, o.w); *(u32x2*)(X1B + (size_t)t * D + c) = ob;
                }
            }
#undef LN1_LOAD
        }
        __syncthreads();
        {
            const float* xr = X1 + (size_t)(tile * 64 + (wave >> 1) * 16 + col) * D + 8 * g;
            const bf16_t* wh = RWT + (size_t)((wave & 1) * 16 + col) * D + 8 * g; const bf16_t* wl = wh + (size_t)NE * D;
            f32x4 acc = (f32x4){0.f, 0.f, 0.f, 0.f};
#pragma unroll 4
            for (int ks = 0; ks < 32; ++ks) {
                const f32x4 x0 = *(const f32x4*)(xr + ks * 32), x1 = *(const f32x4*)(xr + ks * 32 + 4);
                const bf16x8 bh = *(const bf16x8*)(wh + ks * 32), bl = *(const bf16x8*)(wl + ks * 32);
                const bf16x8 ah = cvt8(x0, x1);
                const u32x4 ahu = __builtin_bit_cast(u32x4, ah);
                f32x4 r0, r1;
                r0.x = x0.x - bf_lo(ahu.x); r0.y = x0.y - bf_hi(ahu.x); r0.z = x0.z - bf_lo(ahu.y); r0.w = x0.w - bf_hi(ahu.y);
                r1.x = x1.x - bf_lo(ahu.z); r1.y = x1.y - bf_hi(ahu.z); r1.z = x1.z - bf_lo(ahu.w); r1.w = x1.w - bf_hi(ahu.w);
                const bf16x8 al = cvt8(r0, r1);
                acc = MFMA16(ah, bh, acc); acc = MFMA16(ah, bl, acc); acc = MFMA16(al, bh, acc);
            }
            const float rbv = rb[(wave & 1) * 16 + col];
#pragma unroll
            for (int r = 0; r < 4; ++r) lgs[((wave >> 1) * 16 + 4 * g + r) * NE + (wave & 1) * 16 + col] = acc[r] + rbv;
        }
        __syncthreads();
        if (tid < 64) {
            const float* lp = lgs + tid * NE; const int t = tile * 64 + tid;
            float tv[4]; int ti[4];
#pragma unroll
            for (int k = 0; k < 4; ++k) { tv[k] = -INFINITY; ti[k] = 0; }
            for (int e = 0; e < NE; ++e) {
                const float x = lp[e];
                if (x > tv[3]) {
                    if (x > tv[0]) { tv[3] = tv[2]; ti[3] = ti[2]; tv[2] = tv[1]; ti[2] = ti[1]; tv[1] = tv[0]; ti[1] = ti[0]; tv[0] = x; ti[0] = e; }
                    else if (x > tv[1]) { tv[3] = tv[2]; ti[3] = ti[2]; tv[2] = tv[1]; ti[2] = ti[1]; tv[1] = x; ti[1] = e; }
                    else if (x > tv[2]) { tv[3] = tv[2]; ti[3] = ti[2]; tv[2] = x; ti[2] = e; }
                    else { tv[3] = x; ti[3] = e; }
                }
            }
            const float e1 = expf(tv[1] - tv[0]), e2 = expf(tv[2] - tv[0]), e3 = expf(tv[3] - tv[0]);
            const float inv = 1.0f / (1.0f + e1 + e2 + e3);
            *(f32x4*)(TOPG + (size_t)t * 4) = (f32x4){inv, e1 * inv, e2 * inv, e3 * inv};
#pragma unroll
            for (int k = 0; k < 4; ++k) { TOPI[(size_t)t * 4 + k] = ti[k]; stopi[tid * 4 + k] = ti[k]; }
        }
        __syncthreads();
        if (tid < 256) { const int e = stopi[tid]; int r = 0; for (int a2 = 0; a2 < tid; ++a2) r += (stopi[a2] == e) ? 1 : 0; RANK[(size_t)tile * 256 + tid] = r; }
        else if (tid < 256 + NE) { const int e = tid - 256; int cnt = 0; for (int a2 = 0; a2 < 256; ++a2) cnt += (stopi[a2] == e) ? 1 : 0; BCNT[tile * NE + e] = cnt; }
    }
    __syncthreads();
}

__device__ __forceinline__ void moe_offsets(int* sh, const int* CNT, int tid) {
    if (tid == 0) {
        int acc = 0;
        for (int e = 0; e < NE; ++e) { const int c = (int)CNT[e]; sh[e] = c; sh[32 + e] = acc; acc += (c + MOEB - 1) / MOEB * MOEB; sh[64 + e] = acc; }
    }
    __syncthreads();
}
__device__ __forceinline__ int moe_expert_of_row(const int* sh, int r) {
    int e = -1;
    for (int i = 0; i < NE; ++i) if (r >= sh[32 + i] && r < sh[64 + i]) e = i;
    return e;
}

__device__ __forceinline__ void phase_scatter(const Params& P, int l, unsigned char* smem, int wv) {
    ParamsPtr pp = PARAMS_PTR(P); PIN_S(pp); unsigned char* ws = pp->ws; int bidx = (int)blockIdx.x, gdim = (int)gridDim.x; PIN_S(bidx); PIN_S(gdim);
    const int tid = phase_tid(wv);
    const int* TOPI = (const int*)(ws + O_TOPI); const int* RANK = (const int*)(ws + O_RANK); int* SLOT = (int*)(ws + O_SLOT); int* ROWT = (int*)(ws + O_ROWT);
    const int* BCNT = (const int*)(ws + O_BCNT); int* CNTF = (int*)(ws + O_CNTF);
    int* sh = (int*)smem;
    int* part = sh + 96;
    int* tot = part + 512;
    int* base = tot + 32;
    constexpr int NT = T / 64;
    const int e = tid & 31, pt = tid >> 5;
    { int sacc = 0; for (int tl = pt; tl < NT; tl += 16) sacc += BCNT[tl * NE + e]; part[pt * 32 + e] = sacc; }
    __syncthreads();
    if (tid < 32) { int sacc = 0; for (int q = 0; q < 16; ++q) sacc += part[q * 32 + tid]; tot[tid] = sacc; if (bidx == 0) CNTF[tid] = sacc; }
    __syncthreads();
    moe_offsets(sh, tot, tid);
    for (int ee = bidx; ee < NE; ee += gdim)
        for (int r = sh[32 + ee] + sh[ee] + tid; r < sh[64 + ee]; r += NTHREADS) ROWT[r] = 0;
    for (int tile = bidx; tile < NT; tile += gdim) {
        __syncthreads();
        { int sacc = 0; for (int tl = pt; tl < tile; tl += 16) sacc += BCNT[tl * NE + e]; part[pt * 32 + e] = sacc; }
        __syncthreads();
        if (tid < 32) { int sacc = sh[32 + tid]; for (int q = 0; q < 16; ++q) sacc += part[q * 32 + tid]; base[tid] = sacc; }
        __syncthreads();
        if (tid < 256) { const int a = tile * 256 + tid, dest = base[TOPI[a]] + RANK[a]; SLOT[a] = dest; ROWT[dest] = a >> 2; }
    }
    __syncthreads();
}

template <int WHICH>
__device__ __forceinline__ void phase_moe_gemm(const Params& P, int l, unsigned char* smem, int wv) {
    ParamsPtr pp = PARAMS_PTR(P); PIN_S(pp); unsigned char* ws = pp->ws; int bidx = (int)blockIdx.x, gdim = (int)gridDim.x; PIN_S(bidx); PIN_S(gdim);
    const int tid = phase_tid(wv);
    const int* CNT = (const int*)(ws + O_CNTF);
    int* sh = (int*)(smem + 131072);
    int* rbe = sh + 96;
    moe_offsets(sh, CNT, tid);
    const int nrb = sh[64 + NE - 1] / MOEB;
    for (int rb = tid; rb < nrb; rb += NTHREADS) rbe[rb] = moe_expert_of_row(sh, rb * MOEB);
    __syncthreads();
    pg8::MoeOrderT<WHICH == 1> S;
    S.K = 1024; S.G_ = gdim; S.c = bidx; S.rbe = rbe; S.rowmap = (const int*)(ws + O_ROWT);
    if (WHICH == 1) {
        S.A = (const char*)(ws + O_X1B); S.Wt = (const char*)(ws + O_W1) + (size_t)l * NE * 2 * DFF * D * 2; S.estride = (size_t)2 * DFF * D * 2; S.nN = 2 * DFF / 256; S.nwg = nrb * S.nN;
        pg8::EpiSwiglu E{(bf16_t*)(ws + O_ACT), pp->in[27] + (size_t)l * NE * 2 * DFF};
        pg8::gemm_phase<pg8::EpiSwiglu, pg8::MoeOrderT<WHICH == 1>>((LAS unsigned char*)smem, 1024, S, E, tid);
    } else {
        S.A = (const char*)(ws + O_ACT); S.Wt = (const char*)(ws + O_W2) + (size_t)l * NE * D * DFF * 2; S.estride = (size_t)D * DFF * 2; S.nN = D / 256; S.nwg = nrb * S.nN;
        pg8::EpiBf16Bias E{(bf16_t*)(ws + O_YS), D, pp->in[29] + (size_t)l * NE * D, D};
        pg8::gemm_phase<pg8::EpiBf16Bias, pg8::MoeOrderT<WHICH == 1>>((LAS unsigned char*)smem, 1024, S, E, tid);
    }
    __syncthreads();
}

__device__ __forceinline__ void phase_combine_ln2(const Params& P, int l, unsigned char* smem, int wv) {
    ParamsPtr pp = PARAMS_PTR(P); PIN_S(pp); unsigned char* ws = pp->ws; int bidx = (int)blockIdx.x, gdim = (int)gridDim.x; PIN_S(bidx); PIN_S(gdim);
    const float* X1 = (const float*)(ws + O_X1); const bf16_t* YS = (const bf16_t*)(ws + O_YS); bf16_t* XB = (bf16_t*)(ws + O_XB);
    const int* SLOT = (const int*)(ws + O_SLOT); const float* TOPG = (const float*)(ws + O_TOPG);
    float* xo = l == NL - 1 ? pp->out : (float*)(ws + O_XA);
    const float* g2 = pp->in[30] + (size_t)l * D; const float* b2 = pp->in[31] + (size_t)l * D;
    const int tid = phase_tid(wv), lane = tid & 63, wave = tid >> 6;
    const int gw = bidx * NWAVES + wave, ngw = NWAVES * gdim;
    u32x4 sl_n = (u32x4){0u, 0u, 0u, 0u}; f32x4 gg_n = (f32x4){0.f, 0.f, 0.f, 0.f};
    f32x4 xa_n[4]; u32x2 ys_n[4][4]; f32x4 gg_c = (f32x4){0.f, 0.f, 0.f, 0.f};
    const f32x4 lg[4] = {*(const f32x4*)(g2 + lane * 4), *(const f32x4*)(g2 + 256 + lane * 4), *(const f32x4*)(g2 + 512 + lane * 4), *(const f32x4*)(g2 + 768 + lane * 4)};
    const f32x4 lb[4] = {*(const f32x4*)(b2 + lane * 4), *(const f32x4*)(b2 + 256 + lane * 4), *(const f32x4*)(b2 + 512 + lane * 4), *(const f32x4*)(b2 + 768 + lane * 4)};
#define CB_META(tt_) do { sl_n = *(const u32x4*)(SLOT + (size_t)(tt_) * 4); gg_n = *(const f32x4*)(TOPG + (size_t)(tt_) * 4); } while (0)
#define CB_ROWS(tt_) do { _Pragma("unroll") for (int j = 0; j < 4; ++j) { const int c = j * 256 + lane * 4; xa_n[j] = *(const f32x4*)(X1 + (size_t)(tt_) * D + c); \
        ys_n[0][j] = *(const u32x2*)(YS + (size_t)sl_n.x * D + c); ys_n[1][j] = *(const u32x2*)(YS + (size_t)sl_n.y * D + c); ys_n[2][j] = *(const u32x2*)(YS + (size_t)sl_n.z * D + c); ys_n[3][j] = *(const u32x2*)(YS + (size_t)sl_n.w * D + c); } gg_c = gg_n; } while (0)
    if (gw < T) { CB_META(gw); CB_ROWS(gw); if (gw + ngw < T) CB_META(gw + ngw); }
    for (int t = gw; t < T; t += ngw) {
        float v[16]; float sm = 0.f;
        const float gk[4] = {gg_c.x, gg_c.y, gg_c.z, gg_c.w};
#pragma unroll
        for (int j = 0; j < 4; ++j) {
            const f32x4 a = xa_n[j];
            f32x4 y = (f32x4){0.f, 0.f, 0.f, 0.f};
#pragma unroll
            for (int k = 0; k < 4; ++k) { const u32x2 yk = ys_n[k][j]; y.x += gk[k] * bf_lo(yk.x); y.y += gk[k] * bf_hi(yk.x); y.z += gk[k] * bf_lo(yk.y); y.w += gk[k] * bf_hi(yk.y); }
            v[j * 4 + 0] = ALPHA * a.x + y.x; v[j * 4 + 1] = ALPHA * a.y + y.y; v[j * 4 + 2] = ALPHA * a.z + y.z; v[j * 4 + 3] = ALPHA * a.w + y.w;
            sm += (v[j * 4] + v[j * 4 + 1]) + (v[j * 4 + 2] + v[j * 4 + 3]);
        }
        if (t + ngw < T) { CB_ROWS(t + ngw); if (t + 2 * ngw < T) CB_META(t + 2 * ngw); }
        const float mean = wave_sum_fast(sm, lane) * (1.0f / D); float q = 0.f;
#pragma unroll
        for (int j = 0; j < 16; ++j) { const float dl = v[j] - mean; q += dl * dl; }
        const float rstd = 1.0f / sqrtf(wave_sum_fast(q, lane) * (1.0f / D) + LN_EPS);
#pragma unroll
        for (int j = 0; j < 4; ++j) {
            const int c = j * 256 + lane * 4;
            f32x4 o;
            o.x = (v[j * 4 + 0] - mean) * rstd * lg[j].x + lb[j].x; o.y = (v[j * 4 + 1] - mean) * rstd * lg[j].y + lb[j].y;
            o.z = (v[j * 4 + 2] - mean) * rstd * lg[j].z + lb[j].z; o.w = (v[j * 4 + 3] - mean) * rstd * lg[j].w + lb[j].w;
            *(f32x4*)(xo + (size_t)t * D + c) = o;
            if (l != NL - 1) { u32x2 ob; ob.x = pk2(o.x, o.y); ob.y = pk2(o.z, o.w); *(u32x2*)(XB + (size_t)t * D + c) = ob; }
        }
    }
#undef CB_META
#undef CB_ROWS
}

__device__ __forceinline__ void phase_inproj(const Params& P, int l, unsigned char* smem, int wv) {
    ParamsPtr pp = PARAMS_PTR(P); PIN_S(pp); unsigned char* ws = pp->ws; int bidx = (int)blockIdx.x, gdim = (int)gridDim.x; PIN_S(bidx); PIN_S(gdim);
    const int tid = phase_tid(wv);
    pg8::DenseOrder S; S.init(ws + O_XB, (const bf16_t*)(ws + O_WIN) + (size_t)l * PLD * D, T, PLD, D, gdim, bidx);
    pg8::EpiProj E{(bf16_t*)(ws + O_PROJ), PLD, (float*)(ws + O_PROJG), PLD / 256 - 1};
    pg8::gemm_phase<pg8::EpiProj, pg8::DenseOrder>((LAS unsigned char*)smem, D, S, E, tid);
    __syncthreads();
}
__device__ __forceinline__ void phase_outproj(const Params& P, int l, unsigned char* smem, int wv) {
    ParamsPtr pp = PARAMS_PTR(P); PIN_S(pp); unsigned char* ws = pp->ws; int bidx = (int)blockIdx.x, gdim = (int)gridDim.x; PIN_S(bidx); PIN_S(gdim);
    const int tid = phase_tid(wv);
    pg8::DenseOrder S; S.init(ws + O_GRP, (const bf16_t*)(ws + O_WOUT) + (size_t)l * D * D, T, D, D, gdim, bidx);
    pg8::EpiProj E{(bf16_t*)(ws + O_MIX), D, nullptr, -1};
    pg8::gemm_phase<pg8::EpiProj, pg8::DenseOrder>((LAS unsigned char*)smem, D, S, E, tid);
    __syncthreads();
}

#ifndef EMU
#define XB_TMO      128
#define XB_XCNT(j)  (256  + 64 * (j))
#define XB_XSUB(j)  (1280 + 64 * (j))
#define XB_XGEN(j)  (2304 + 64 * (j))
#define XB_TOP      3328
#define XB_TOPGEN   3392
#define XCD_BAR_WORDS 3456
#define XB_SPIN_CAP (1u << 25)
__device__ __forceinline__ unsigned xb_ld(unsigned* p)              { return __hip_atomic_load(p, __ATOMIC_RELAXED, __HIP_MEMORY_SCOPE_AGENT); }
__device__ __forceinline__ unsigned xb_add(unsigned* p, unsigned v) { return __hip_atomic_fetch_add(p, v, __ATOMIC_RELAXED, __HIP_MEMORY_SCOPE_AGENT); }
__device__ __forceinline__ unsigned xb_xcc_id() { return (unsigned)__builtin_amdgcn_s_getreg((3 << 11) | 20) & 0xFu; }
#define XB_SPIN(cond, bar) do { unsigned _sp = 0; while (cond) { __builtin_amdgcn_s_sleep(1); \
    if ((++_sp & 255u) == 0u) { if (xb_ld(&(bar)[XB_TMO])) break; if (_sp > XB_SPIN_CAP) { atomicAdd(&(bar)[XB_TMO], 1u); break; } } } } while (0)
struct XcdBarrier { unsigned* bar; unsigned x; volatile LAS unsigned* st; };
__device__ __forceinline__ XcdBarrier xcd_barrier_post(unsigned* bar, volatile LAS unsigned* st) {
    XcdBarrier b; b.bar = bar; b.x = xb_xcc_id(); b.st = st;
    if (threadIdx.x == 0) (void)xb_add(&bar[XB_XCNT(b.x)], 1u);
    return b;
}
__device__ __forceinline__ void xcd_barrier_complete(unsigned* bar, unsigned x, unsigned& nloc, unsigned& nx) {
    const unsigned G = gridDim.x * gridDim.y * gridDim.z;
    unsigned sum, cnt, mine, sp = 0u;
    for (;;) {
        sum = 0u; cnt = 0u; mine = 0u;
#pragma unroll
        for (unsigned j = 0; j < 16; ++j) { const unsigned c = xb_ld(&bar[XB_XCNT(j)]); sum += c; cnt += (c > 0u) ? 1u : 0u; mine = (j == x) ? c : mine; }
        if (sum == G) break;
        __builtin_amdgcn_s_sleep(1);
        if ((++sp & 255u) == 0u) { if (xb_ld(&bar[XB_TMO])) break; if (sp > XB_SPIN_CAP) { atomicAdd(&bar[XB_TMO], 1u); break; } }
    }
    nloc = mine > 0u ? mine : 1u; nx = cnt > 0u ? cnt : 1u;
}
__device__ __forceinline__ void xcd_barrier(const XcdBarrier& b) {
    asm volatile("s_waitcnt vmcnt(0)" ::: "memory");
    __syncthreads();
    if (threadIdx.x == 0) {
        unsigned* bar = b.bar;
        __builtin_amdgcn_s_waitcnt(0);
        unsigned nloc = b.st[0], nx = b.st[1];
        if (nloc == 0u) { xcd_barrier_complete(bar, b.x, nloc, nx); b.st[0] = nloc; b.st[1] = nx; }
        const unsigned old = xb_add(&bar[XB_XSUB(b.x)], 1u);
        const unsigned gen = old / nloc;
        if (old + 1u == (gen + 1u) * nloc) {
            __builtin_amdgcn_fence(__ATOMIC_RELEASE, "agent");
            asm volatile("s_waitcnt vmcnt(0)" ::: "memory");
            const unsigned og = xb_add(&bar[XB_TOP], 1u);
            const unsigned tg = og / nx;
            if (og + 1u == (tg + 1u) * nx) xb_add(&bar[XB_TOPGEN], 1u);
            else XB_SPIN(xb_ld(&bar[XB_TOPGEN]) == tg, bar);
            __builtin_amdgcn_fence(__ATOMIC_ACQUIRE, "agent");
            xb_add(&bar[XB_XGEN(b.x)], 1u);
            asm volatile("s_waitcnt vmcnt(0)" ::: "memory");
        } else {
            XB_SPIN(xb_ld(&bar[XB_XGEN(b.x)]) == gen, bar);
            __builtin_amdgcn_fence(__ATOMIC_ACQUIRE, "agent");
            asm volatile("s_waitcnt vmcnt(0)" ::: "memory");
        }
    }
    __syncthreads();
}
#endif

__global__ void __launch_bounds__(512, 2) mk_fwd(Params P) {
#ifdef EMU
    unsigned char* smem = g_blk->lds;
#else
    extern __shared__ __attribute__((aligned(16))) unsigned char smem[];
    volatile LAS unsigned* bst = (volatile LAS unsigned*)(smem + LDS_BYTES - 16);
    if (threadIdx.x == 0) { bst[0] = 0u; bst[1] = 0u; bst[2] = 0u; bst[3] = 0u; }
    __syncthreads();
    XcdBarrier bar; bar.bar = (unsigned*)P.ws + CW_BAR; bar.x = 0; bar.st = bst;
    if (P.ph_hi - P.ph_lo > 1) bar = xcd_barrier_post((unsigned*)P.ws + CW_BAR, bst);
#endif
    const int lo = P.ph_lo, hi = P.ph_hi;
#ifdef EMU
    const int wv = (int)threadIdx.x >> 6;
#else
    const int wv = RFL((int)threadIdx.x >> 6);
#endif
#ifdef EMU
#define SEAM(id) do {} while (0)
#else
#define SEAM(id) do { if ((id) + 1 < hi) xcd_barrier(bar); } while (0)
#endif
#ifndef MK_ONLY_PHASE
#define MK_ONLY_PHASE -1
#endif
#ifndef MK_DUP_MASK
#define MK_DUP_MASK 0
#endif
#define PHG(kc, id, ...) do { if (MK_ONLY_PHASE < 0 || MK_ONLY_PHASE == (kc)) { const int id_ = (id); if (id_ >= lo && id_ < hi) { if ((MK_DUP_MASK >> (kc)) & 1) { __VA_ARGS__; SEAM(id_ - 1); } __VA_ARGS__; SEAM(id_); } } } while (0)
#define PH(k, ...) PHG(1 + (k), 1 + l * NPH + (k), __VA_ARGS__)
    PHG(0, 0, phase_prologue(P, smem, wv));
    for (int l = 0; l < NL; ++l) {
        PH(0, phase_inproj(P, l, smem, wv));
        PH(1, phase_prep(P, l, smem, wv));
#if MK_RWKV_CHUNKED
        PH(2, { phase_rwkv_pre(P, l, smem, wv); phase_mlstm_local(P, l, smem, wv, (int)blockIdx.x, (int)gridDim.x); });
        PH(3, { phase_rwkv_seq(P, l, smem, wv); phase_mlstm_carry(P, l, smem, wv); });
        PH(4, { phase_rwkv_out(P, l, smem, wv); phase_mlstm_out(P, l, smem, wv); phase_gmlp_mix(P, l, smem, wv, (int)blockIdx.x, (int)gridDim.x); });
#else
        PH(2, { const int G_ = (int)gridDim.x, NSC = 2 * NB * RH * 4;
                if (G_ >= NSC + 32) { if ((int)blockIdx.x < NSC) phase_rwkv_scan(P, l, smem, wv, (int)blockIdx.x, NSC);
                                      else phase_mlstm_local(P, l, smem, wv, (int)blockIdx.x - NSC, G_ - NSC); }
                else { phase_rwkv_scan(P, l, smem, wv, (int)blockIdx.x, G_); phase_mlstm_local(P, l, smem, wv, (int)blockIdx.x, G_); } });
        PH(3, phase_mlstm_carry(P, l, smem, wv));
        PH(4, { phase_mlstm_out(P, l, smem, wv); phase_gmlp_mix(P, l, smem, wv, (int)blockIdx.x, (int)gridDim.x); phase_rwkv_post(P, l, smem, wv); });
#endif
        PH(5, phase_outproj(P, l, smem, wv));
        PH(6, phase_ln1_router(P, l, smem, wv));
        PH(7, phase_scatter(P, l, smem, wv));
        PH(8, phase_moe_gemm<1>(P, l, smem, wv));
        PH(9, phase_moe_gemm<2>(P, l, smem, wv));
        PH(10, phase_combine_ln2(P, l, smem, wv));
    }
#undef PHG
#undef PH
#undef SEAM
}

}

#ifndef EMU
extern "C" void kernel_launch(void* const* d_in, const int* in_sizes, int n_in, void* d_out, int out_size, void* d_ws, size_t ws_size, hipStream_t stream) {
    using namespace mk;
    static int grid = 0;
    if (grid == 0) {
        if (n_in != 32 || out_size != T * D || ws_size < WS_END) { fprintf(stderr, "kernel_launch: unexpected shapes (n_in %d out %d ws %zu need %zu)\n", n_in, out_size, ws_size, (size_t)WS_END); grid = -1; return; }
        int dev = 0, cus = 0;
        if (hipGetDevice(&dev) != hipSuccess || hipDeviceGetAttribute(&cus, hipDeviceAttributeMultiprocessorCount, dev) != hipSuccess) { grid = -1; return; }
        if (hipFuncSetAttribute((const void*)mk_fwd, hipFuncAttributeMaxDynamicSharedMemorySize, LDS_BYTES) != hipSuccess) { fprintf(stderr, "kernel_launch: hipFuncSetAttribute failed\n"); grid = -1; return; }
        int per_cu = 0;
        (void)hipOccupancyMaxActiveBlocksPerMultiprocessor(&per_cu, (const void*)mk_fwd, NTHREADS, LDS_BYTES);
        (void)hipGetLastError();
        grid = cus;
    }
    if (grid < 0) return;
    (void)hipMemsetAsync(d_ws, 0, CTL_BYTES, stream);
    Params p{};
    for (int i = 0; i < 32; ++i) p.in[i] = (const float*)d_in[i];
    p.out = (float*)d_out; p.ws = (unsigned char*)d_ws;
#if MK_ONE_LAUNCH
    p.ph_lo = 0; p.ph_hi = 1 + NL * NPH;
    hipLaunchKernelGGL(mk_fwd, dim3(grid), dim3(NTHREADS), LDS_BYTES, stream, p);
#else
    for (int id = 0; id < 1 + NL * NPH; ++id) {
        p.ph_lo = id; p.ph_hi = id + 1;
        hipLaunchKernelGGL(mk_fwd, dim3(grid), dim3(NTHREADS), LDS_BYTES, stream, p);
    }
#endif
}
#endif
```

```cpp
#ifndef EMU
#include <hip/hip_runtime.h>
#endif
#include <cstdio>
#include <cstdint>
#include <cmath>

#ifndef CFG_BATCH
#define CFG_BATCH 4
#endif
#ifndef CFG_SEQ
#define CFG_SEQ 4096
#endif
#ifndef CFG_LAYERS
#define CFG_LAYERS 4
#endif
#ifndef MK_RWKV_CHUNKED
#define MK_RWKV_CHUNKED 1
#endif
#ifndef MK_PROBE
#define MK_PROBE 0
#endif
#ifndef MK_ONE_LAUNCH
#define MK_ONE_LAUNCH 1
#endif

namespace mk {
constexpr int NB = CFG_BATCH, S = CFG_SEQ, T = NB * S, NL = CFG_LAYERS, D = 1024;
constexpr int GW = 256, RW = 384, MW = 384, HD = 64, GH = 4, RH = 6, MH = 6, CH = 128, NCH = S / CH;
constexpr int PIN = 3480, PLD = 3584, RPROJ = 1408;
constexpr int C_RW = 512, C_MW = 1920;
constexpr int NE = 32, TOPK = 4, DFF = 1024, MOEB = 256;
constexpr int NROWS = (T * TOPK / MOEB + NE) * MOEB;
constexpr float LN_EPS = 1e-5f, GN_EPS = 64e-5f;
constexpr float ALPHA = 1.6817928305074290f;
constexpr int NTHREADS = 512, NWAVES = 8;
constexpr int LDS_BYTES = 160 * 1024;
constexpr int NPH = 11;

typedef float f32x4 __attribute__((ext_vector_type(4)));
typedef unsigned u32x4 __attribute__((ext_vector_type(4)));
typedef unsigned u32x2 __attribute__((ext_vector_type(2)));
typedef short bf16x8 __attribute__((ext_vector_type(8)));
typedef unsigned short bf16_t;

constexpr size_t al(size_t x) { return (x + 255) & ~(size_t)255; }
constexpr size_t CTL_BYTES = 1u << 20;
constexpr size_t O_XA = CTL_BYTES;
constexpr size_t O_XB = O_XA + al((size_t)T * D * 4);
constexpr size_t O_X1 = O_XB + al((size_t)T * D * 2);
constexpr size_t O_X1B = O_X1 + al((size_t)T * D * 4);
constexpr size_t O_PROJ = O_X1B + al((size_t)T * D * 2);
constexpr size_t O_PROJG = O_PROJ + al((size_t)T * PLD * 2);
constexpr size_t O_MIX = O_PROJ + al((size_t)T * PLD * 4);
constexpr size_t O_GRP = O_MIX + al((size_t)T * D * 4);
constexpr size_t O_UG = O_GRP + al((size_t)T * D * 2);
constexpr size_t O_VN = O_UG + al((size_t)T * GW * 4);
constexpr size_t O_RR = O_VN + al((size_t)T * GW * 4);
constexpr size_t O_VV = O_RR + al((size_t)T * RW * 4);
constexpr size_t O_KK = O_VV + al((size_t)T * RW * 4);
constexpr size_t O_DEC = O_KK + al((size_t)T * RW * 4);
constexpr size_t O_KD = O_DEC + al((size_t)2 * T * RW * 4);
constexpr size_t O_ICLR = O_KD + al((size_t)2 * T * RW * 4);
constexpr size_t O_GATE = O_ICLR + al((size_t)2 * T * RW * 4);
constexpr size_t O_BONUS = O_GATE + al((size_t)T * RW * 4);
constexpr size_t O_SCAN = O_BONUS + al((size_t)T * RH * 4);
constexpr size_t O_MQ = O_SCAN + al((size_t)2 * T * RW * 4);
constexpr size_t O_MK = O_MQ + al((size_t)T * MW * 4);
constexpr size_t O_IG = O_MK + al((size_t)T * MW * 4);
constexpr size_t O_LF = O_IG + al((size_t)2 * T * MH * 4);
constexpr size_t O_CL = O_LF + al((size_t)2 * T * MH * 4);
constexpr size_t O_NL = O_CL + al((size_t)2 * NB * MH * NCH * 4096 * 4);
constexpr size_t O_ML = O_NL + al((size_t)2 * NB * MH * NCH * 64 * 4);
constexpr size_t O_BL = O_ML + al((size_t)2 * NB * MH * NCH * 4);
constexpr size_t O_MIN = O_BL + al((size_t)2 * NB * MH * NCH * 4);
constexpr size_t O_TOPI = O_MIN + al((size_t)2 * NB * MH * NCH * 4);
constexpr size_t O_TOPG = O_TOPI + al((size_t)T * 4 * 4);
constexpr size_t O_RANK = O_TOPG + al((size_t)T * 4 * 4);
constexpr size_t O_SLOT = O_RANK + al((size_t)T * 4 * 4);
constexpr size_t O_MQB = O_SLOT + al((size_t)T * 4 * 4);
constexpr size_t O_MKB = O_MQB + al((size_t)T * MW * 2);
constexpr size_t O_KT = O_MKB + al((size_t)T * MW * 2);
constexpr size_t O_VT = O_KT + al((size_t)T * MW * 2);
constexpr size_t O_GVT = O_VT + al((size_t)T * MW * 2);
constexpr size_t O_PMX = O_GVT + al((size_t)2 * T * MH * 4);
constexpr size_t O_BCT = O_PMX + al((size_t)2 * T * MH * 4);
constexpr size_t O_BRKR = O_BCT + al((size_t)2 * T * MH * 4);
constexpr int RC = 64, RNC = S / RC, RUN = 2 * NB * RH * RNC;
constexpr size_t O_LW = O_BRKR + al((size_t)2 * T * RH * 2 * 4);
constexpr size_t O_RQ = O_LW + al((size_t)2 * T * RW * 4);
constexpr size_t O_RA = O_RQ + al((size_t)RUN * 4096 * 2);
constexpr size_t O_RS = O_RA + al((size_t)RUN * 4096 * 2);
constexpr size_t O_RH = O_RS + al((size_t)RUN * 4096 * 2);
constexpr size_t O_RG = O_RH + al((size_t)RUN * 4096 * 4);
constexpr size_t O_RB = O_RG + al((size_t)RUN * 4096 * 4);
constexpr size_t O_VB = O_RB + al((size_t)T * RW * 2);
constexpr size_t O_KKB = O_VB + al((size_t)T * RW * 2);
constexpr size_t O_BBB = O_KKB + al((size_t)T * RW * 2);
constexpr size_t O_KDB = O_BBB + al((size_t)2 * T * RW * 2);
constexpr size_t O_RK7 = O_KDB + al((size_t)2 * T * RW * 2);
constexpr size_t O_VNT = O_RK7 + al((size_t)T * RW * 16);
constexpr size_t O_WSB = O_VNT + al((size_t)T * GW * 2);
constexpr size_t O_LWT = O_WSB + al((size_t)NL * GH * CH * CH * 2);
constexpr size_t O_RWT = O_LWT + al((size_t)NL * 1920 * 128 * 2);
constexpr size_t O_BCNT = O_RWT + al((size_t)NL * 2 * NE * D * 2);
constexpr size_t O_CNTF = O_BCNT + al((size_t)(T / 64) * NE * 4);
constexpr size_t O_ROWT = O_CNTF + al((size_t)NE * 4);
constexpr size_t O_XS = O_ROWT + al((size_t)NROWS * 4);
constexpr size_t O_ACT = O_XS + al((size_t)NROWS * D * 2);
constexpr size_t O_YS = O_ACT + al((size_t)NROWS * DFF * 2);
constexpr size_t O_WIN = O_YS + al((size_t)NROWS * D * 2);
constexpr size_t O_WOUT = O_WIN + al((size_t)NL * PLD * D * 2);
constexpr size_t O_W1 = O_WOUT + al((size_t)NL * D * D * 2);
constexpr size_t O_W2 = O_W1 + al((size_t)NL * NE * 2 * DFF * D * 2);
constexpr size_t WS_END = O_W2 + al((size_t)NL * NE * D * DFF * 2);

constexpr int CW_BAR = 4096;
constexpr int CW_CNT = 16384;

struct Params { const float* in[32]; float* out; unsigned char* ws; int ph_lo, ph_hi; };
#ifdef EMU
typedef const Params* ParamsPtr;
#define PARAMS_PTR(P) (&(P))
#else
typedef const __attribute__((address_space(4))) Params* ParamsPtr;
#define PARAMS_PTR(P) ((ParamsPtr)__builtin_amdgcn_kernarg_segment_ptr())
#endif

#ifdef EMU
#define WAVE_SYNC() emu_wave_barrier()
#define PIN_V(x) do {} while (0)
#define PIN_S(x) do {} while (0)
#else
#define WAVE_SYNC() __builtin_amdgcn_wave_barrier()
#define PIN_V(x) asm volatile("" : "+v"(x))
#define PIN_S(x) asm volatile("" : "+s"(x))
#endif
#ifdef EMU
__device__ __forceinline__ int phase_tid(int wv) { (void)wv; return threadIdx.x; }
#else
__device__ __forceinline__ int phase_tid(int wv) { int t; asm volatile("v_mbcnt_lo_u32_b32 %0, -1, 0\n\tv_mbcnt_hi_u32_b32 %0, -1, %0" : "=v"(t)); return (wv << 6) + t; }
#endif

#ifdef EMU
#define SHX(v, m, lane) __shfl_xor(v, m)
#else
__device__ __forceinline__ float shx_(float v, int m, int lane) { return __builtin_bit_cast(float, __builtin_amdgcn_ds_bpermute((lane ^ m) << 2, __builtin_bit_cast(int, v))); }
__device__ __forceinline__ int shx_(int v, int m, int lane) { return __builtin_amdgcn_ds_bpermute((lane ^ m) << 2, v); }
#define SHX(v, m, lane) shx_(v, m, lane)
#endif
#ifdef EMU
#define SHUP(v, o, lane) __shfl(v, ((lane) - (o)) & 63)
#define RDL(v, src) __shfl(v, src)
#define SHL(v, src) __shfl(v, src)
#else
#define SHL(v, src) __builtin_bit_cast(float, __builtin_amdgcn_ds_bpermute((src) << 2, __builtin_bit_cast(int, (float)(v))))
#define SHUP(v, o, lane) __builtin_bit_cast(float, __builtin_amdgcn_ds_bpermute((((lane) - (o)) & 63) << 2, __builtin_bit_cast(int, (float)(v))))
#define RDL(v, src) __builtin_bit_cast(float, __builtin_amdgcn_readlane(__builtin_bit_cast(int, (float)(v)), src))
#endif
__device__ __forceinline__ float wave_sum(float v, int lane) {
#pragma unroll
    for (int o = 32; o >= 1; o >>= 1) v += SHX(v, o, lane);
    return v;
}
#ifdef EMU
__device__ __forceinline__ float fexp(float x) { return expf(x); }
__device__ __forceinline__ float flog(float x) { return logf(x); }
__device__ __forceinline__ float frcp(float x) { return 1.0f / x; }
#else
__device__ __forceinline__ float fexp(float x) { return __builtin_amdgcn_exp2f(x * 1.4426950408889634f); }
__device__ __forceinline__ float flog(float x) { return __builtin_amdgcn_logf(x) * 0.6931471805599453f; }
__device__ __forceinline__ float frcp(float x) { return __builtin_amdgcn_rcpf(x); }
#endif
__device__ __forceinline__ float sigmoidf_(float x) { return frcp(1.0f + fexp(-x)); }
__device__ __forceinline__ float softplusf_(float x) { return fmaxf(x, 0.f) + flog(1.0f + fexp(-fabsf(x))); }
__device__ __forceinline__ float ftanh(float x) { return 1.0f - 2.0f * frcp(1.0f + fexp(2.0f * x)); }
__device__ __forceinline__ float geluf_(float v) {
    const float av = fabsf(v), t = frcp(1.0f + 0.2316418882f * av);
    float q = t * 0.5307027145f + (-0.7265760135f); q = q * t + 0.7107068705f; q = q * t + (-0.142248368f); q = q * t + 0.127414796f; q = q * t;
    const float m = v * (q * fexp(-0.5f * v * v));
    return v < 0.f ? m : v - m;
}

#ifdef EMU
#define LAS
#define WAIT_V(n) do {} while (0)
#define WAIT_L(n) do {} while (0)
#define S_BARRIER() __syncthreads()
#define SETPRIO(x) do {} while (0)
#define SCHED_BAR() do {} while (0)
#define RFL(x) (x)
static inline void emu_glds16(const void* g, void* l) { memcpy((char*)l + (g_blk->cur & 63) * 16, g, 16); }
#define GLDS16(gptr, ldsptr) emu_glds16((const void*)(gptr), (void*)(ldsptr))
static inline float emu_bf2f(unsigned short b) { unsigned u = (unsigned)b << 16; float f; memcpy(&f, &u, 4); return f; }
static inline f32x4 emu_mfma16(bf16x8 a, bf16x8 b, f32x4 c) {
    EmuBlock* blk = g_blk; const int cur = blk->cur, lane = cur & 63, wbase = cur & ~63;
    static thread_local unsigned short Ash[32][64][8], Bsh[32][64][8];
    const int w = cur >> 6;
    for (int j = 0; j < 8; ++j) { Ash[w][lane][j] = (unsigned short)a[j]; Bsh[w][lane][j] = (unsigned short)b[j]; }
    emu_wave_barrier();
    const int col = lane & 15;
    for (int r = 0; r < 4; ++r) { const int row = 4 * (lane >> 4) + r; float sum = c[r];
        for (int k = 0; k < 32; ++k) sum += emu_bf2f(Ash[w][row + 16 * (k >> 3)][k & 7]) * emu_bf2f(Bsh[w][col + 16 * (k >> 3)][k & 7]);
        c[r] = sum; }
    emu_wave_barrier(); (void)wbase;
    return c;
}
#define MFMA16(a, b, c) emu_mfma16(a, b, c)
#else
#define LAS __attribute__((address_space(3)))
#define WAIT_V(n) asm volatile("s_waitcnt vmcnt(" #n ")" ::: "memory")
#define WAIT_L(n) asm volatile("s_waitcnt lgkmcnt(" #n ")" ::: "memory")
#define S_BARRIER() __builtin_amdgcn_s_barrier()
#define SETPRIO(x) __builtin_amdgcn_s_setprio(x)
#define SCHED_BAR() __builtin_amdgcn_sched_barrier(0)
#define RFL(x) __builtin_amdgcn_readfirstlane(x)
#define GLDS16(gptr, ldsptr) __builtin_amdgcn_global_load_lds((const unsigned*)(gptr), (LAS unsigned*)(ldsptr), 16, 0, 0)
#define MFMA16(a, b, c) __builtin_amdgcn_mfma_f32_16x16x32_bf16(a, b, c, 0, 0, 0)
#endif

#ifdef EMU
__device__ __forceinline__ unsigned f2bf(float f) { unsigned u = __builtin_bit_cast(unsigned, f); return (u + 0x7fffu + ((u >> 16) & 1u)) >> 16; }
#else
__device__ __forceinline__ unsigned f2bf(float f) { return (unsigned)__builtin_bit_cast(unsigned short, (__bf16)f); }
#endif
#ifdef EMU
__device__ __forceinline__ unsigned pk2(float lo, float hi) { return f2bf(lo) | (f2bf(hi) << 16); }
#else
typedef float f32x2c __attribute__((ext_vector_type(2)));
typedef __bf16 bf16x2c __attribute__((ext_vector_type(2)));
__device__ __forceinline__ unsigned pk2(float lo, float hi) { const f32x2c v = {lo, hi}; return __builtin_bit_cast(unsigned, __builtin_convertvector(v, bf16x2c)); }
#endif
__device__ __forceinline__ bf16x8 cvt8(const f32x4 a, const f32x4 b) {
    u32x4 w; w.x = pk2(a.x, a.y); w.y = pk2(a.z, a.w); w.z = pk2(b.x, b.y); w.w = pk2(b.z, b.w); return __builtin_bit_cast(bf16x8, w);
}
__device__ __forceinline__ float bf_lo(unsigned u) { return __builtin_bit_cast(float, u << 16); }
__device__ __forceinline__ float bf_hi(unsigned u) { return __builtin_bit_cast(float, u & 0xffff0000u); }

namespace pg8 {
constexpr int BM = 256, BK = 64, HALF = 128, HTB = HALF * BK * 2, STAGE_BYTES = 8 * HTB, NXCD = 8, WGM = 8;
__host__ __device__ __forceinline__ int lds_byte(int r, int c) { const int st = (r >> 4) * 2 + (c >> 5), rr = r & 15, cc = c & 31, ob = rr * 64 + cc * 2; return st * 1024 + (ob ^ (((ob >> 9) & 1) << 5)); }
__host__ __device__ __forceinline__ void stage_rc(int b, int& R, int& C) { const int st = b / 1024, sb = b % 1024, swz = sb ^ (((sb >> 9) & 1) << 5); R = (st >> 1) * 16 + swz / 64; C = (st & 1) * 32 + (swz % 64) / 2; }
__host__ __device__ __forceinline__ int perm32(int rho) { const int n = rho >> 4, i = rho & 15; return 8 * (i >> 2) + 4 * n + (i & 3); }
struct Unit { int pm, pn, e; };

struct DenseOrder {
    static constexpr bool GATHER = false;
    const char* A; const char* Bt; int K; int nM, nN, nwg, G, c;
    __device__ __forceinline__ void init(const void* A_, const void* Bt_, int M, int N, int K_, int G_, int c_) { A = (const char*)A_; Bt = (const char*)Bt_; K = K_; nM = M / BM; nN = N / BM; nwg = nM * nN; G = G_; c = c_; }
    __device__ __forceinline__ bool next(int i, Unit& u) const {
        const long L = (long)i * G + c; if (L >= nwg) return false;
        int wgid = (int)L; { const int q = nwg / NXCD, r = nwg % NXCD, xcd = wgid % NXCD, off = wgid / NXCD; wgid = (xcd < r ? xcd * (q + 1) : r * (q + 1) + (xcd - r) * q) + off; }
        const int nig = WGM * nN, gid = wgid / nig, fm = gid * WGM, gsz = (nM - fm) < WGM ? (nM - fm) : WGM;
        u.pm = fm + ((wgid % nig) % gsz); u.pn = (wgid % nig) / gsz; u.e = 0; return true;
    }
    __device__ __forceinline__ const char* abase(const Unit& u) const { return A + (size_t)u.pm * BM * K * 2; }
    __device__ __forceinline__ const char* bbase(const Unit& u) const { return Bt + (size_t)u.pn * BM * K * 2; }
};
template <bool G>
struct MoeOrderT {
    static constexpr bool GATHER = G;
    const char* A; const char* Wt; int K; int nN, nwg, G_, c; size_t estride; const int* rbe; const int* rowmap;
    __device__ __forceinline__ bool next(int i, Unit& u) const {
        const long L = (long)i * G_ + c; if (L >= nwg) return false;
        u.pm = (int)(L / nN); u.pn = (int)(L % nN); u.e = rbe[u.pm]; return true;
    }
    __device__ __forceinline__ const char* abase(const Unit& u) const { return G ? A : A + (size_t)u.pm * BM * K * 2; }
    __device__ __forceinline__ const char* bbase(const Unit& u) const { return Wt + (size_t)u.e * estride + (size_t)u.pn * BM * K * 2; }
};
struct EpiF32 {
    static constexpr bool PERM = false;
    float* C; int ldc;
    __device__ __forceinline__ void operator()(const f32x4 (&acc)[2][2][4][2], const Unit& u, int wr, int wc, int fr, int fq) const {
        const int row0 = u.pm * BM + wr * 64 + fr, col0 = u.pn * BM + wc * 32 + 4 * fq;
#pragma unroll
        for (int ai = 0; ai < 2; ++ai)
#pragma unroll
            for (int m = 0; m < 4; ++m) { float* rowp = C + (size_t)(row0 + ai * HALF + m * 16) * ldc + col0;
#pragma unroll
                for (int bj = 0; bj < 2; ++bj)
#pragma unroll
                    for (int n = 0; n < 2; ++n) *(f32x4*)(rowp + bj * HALF + n * 16) = acc[ai][bj][m][n]; }
    }
};
struct EpiProj {
    static constexpr bool PERM = true;
    bf16_t* O; int ldc; float* G; int lastt;
    __device__ __forceinline__ void operator()(const f32x4 (&acc)[2][2][4][2], const Unit& u, int wr, int wc, int fr, int fq) const {
        const int row0 = u.pm * BM + wr * 64 + fr, col0 = u.pn * BM + wc * 32 + 8 * fq;
#pragma unroll
        for (int ai = 0; ai < 2; ++ai)
#pragma unroll
            for (int m = 0; m < 4; ++m) { bf16_t* rowp = O + (size_t)(row0 + ai * HALF + m * 16) * ldc + col0;
#pragma unroll
                for (int bj = 0; bj < 2; ++bj) { const f32x4 v0 = acc[ai][bj][m][0], v1 = acc[ai][bj][m][1];
                    u32x4 w; w.x = pk2(v0[0], v0[1]); w.y = pk2(v0[2], v0[3]); w.z = pk2(v1[0], v1[1]); w.w = pk2(v1[2], v1[3]);
                    *(u32x4*)(rowp + bj * HALF) = w; } }
        if (u.pn == lastt) {
#pragma unroll
            for (int ai = 0; ai < 2; ++ai)
#pragma unroll
                for (int m = 0; m < 4; ++m) { float* rowp = G + (size_t)(row0 + ai * HALF + m * 16) * BM + wc * 32 + 8 * fq;
#pragma unroll
                    for (int bj = 0; bj < 2; ++bj) { *(f32x4*)(rowp + bj * HALF) = acc[ai][bj][m][0]; *(f32x4*)(rowp + bj * HALF + 4) = acc[ai][bj][m][1]; } }
        }
    }
};
struct EpiBf16Bias {
    static constexpr bool PERM = true;
    bf16_t* O; int ldc; const float* bias; int bias_estride;
    __device__ __forceinline__ void operator()(const f32x4 (&acc)[2][2][4][2], const Unit& u, int wr, int wc, int fr, int fq) const {
        const int row0 = u.pm * BM + wr * 64 + fr, col0 = u.pn * BM + wc * 32 + 8 * fq;
        const float* bp = bias + (size_t)u.e * bias_estride + col0;
        f32x4 bv[2][2];
#pragma unroll
        for (int bj = 0; bj < 2; ++bj)
#pragma unroll
            for (int n = 0; n < 2; ++n) bv[bj][n] = *(const f32x4*)(bp + bj * HALF + 4 * n);
#pragma unroll
        for (int ai = 0; ai < 2; ++ai)
#pragma unroll
            for (int m = 0; m < 4; ++m) { bf16_t* rowp = O + (size_t)(row0 + ai * HALF + m * 16) * ldc + col0;
#pragma unroll
                for (int bj = 0; bj < 2; ++bj) { const f32x4 v0 = acc[ai][bj][m][0] + bv[bj][0], v1 = acc[ai][bj][m][1] + bv[bj][1];
                    u32x4 w; w.x = pk2(v0[0], v0[1]); w.y = pk2(v0[2], v0[3]); w.z = pk2(v1[0], v1[1]); w.w = pk2(v1[2], v1[3]);
                    *(u32x4*)(rowp + bj * HALF) = w; } }
    }
};
__device__ __forceinline__ float swiglu1(float g, float uu) { g = fminf(g, 7.0f); uu = fminf(fmaxf(uu, -7.0f), 7.0f); return (uu + 1.0f) * (g * frcp(1.0f + fexp(-1.702f * g))); }
struct EpiSwiglu {
    static constexpr bool PERM = true;
    bf16_t* O; const float* b1;
    __device__ __forceinline__ void operator()(const f32x4 (&acc)[2][2][4][2], const Unit& u, int wr, int wc, int fr, int fq) const {
        const int row0 = u.pm * BM + wr * 64 + fr, j0 = u.pn * HALF + wc * 32 + 8 * fq;
        const float* bg = b1 + (size_t)u.e * 2 * DFF + j0; const float* bu = bg + DFF;
        f32x4 g4[2], u4[2];
#pragma unroll
        for (int n = 0; n < 2; ++n) { g4[n] = *(const f32x4*)(bg + 4 * n); u4[n] = *(const f32x4*)(bu + 4 * n); }
#pragma unroll
        for (int ai = 0; ai < 2; ++ai)
#pragma unroll
            for (int m = 0; m < 4; ++m) {
                float o[8];
#pragma unroll
                for (int n = 0; n < 2; ++n)
#pragma unroll
                    for (int q = 0; q < 4; ++q) o[n * 4 + q] = swiglu1(acc[ai][0][m][n][q] + g4[n][q], acc[ai][1][m][n][q] + u4[n][q]);
                u32x4 w; w.x = pk2(o[0], o[1]); w.y = pk2(o[2], o[3]); w.z = pk2(o[4], o[5]); w.w = pk2(o[6], o[7]);
                *(u32x4*)(O + (size_t)(row0 + ai * HALF + m * 16) * DFF + j0) = w;
            }
    }
};

template <class Epi, class Sched>
__device__ __forceinline__ void gemm_phase(LAS unsigned char* lds, const int K, const Sched& S, const Epi& E, const int tid) {
    const int wid = RFL(tid >> 6), lane = tid & 63, wr = wid >> 2, wc = wid & 3, fr = lane & 15, fq = lane >> 4;
    const int nt = K / BK;
    unsigned voffA[2], voffB[2]; int gR[2]; unsigned gC[2];
#pragma unroll
    for (int i = 0; i < 2; ++i) { int R, C; stage_rc(tid * 16 + i * 8192, R, C); const int Rb = Epi::PERM ? ((R & ~31) + perm32(R & 31)) : R;
        voffA[i] = (unsigned)(R * K + C) * 2u; voffB[i] = (unsigned)(Rb * K + C) * 2u; gR[i] = R; gC[i] = (unsigned)C * 2u; }
    unsigned va[2][2], vn[2][2];
#define PG8_GOFF(dst, unit) do { if constexpr (Sched::GATHER) { _Pragma("unroll") for (int h_ = 0; h_ < 2; ++h_) _Pragma("unroll") for (int i_ = 0; i_ < 2; ++i_) \
        dst[h_][i_] = (unsigned)S.rowmap[(unit).pm * BM + h_ * HALF + gR[i_]] * (unsigned)(K * 2) + gC[i_]; } } while (0)
#define PG8_STAGE_A(bufoff, bp, kb, h, nx) do { if constexpr (Sched::GATHER) { const char* gb_ = S.A + (kb); _Pragma("unroll") for (int _i = 0; _i < 2; ++_i) \
        GLDS16(gb_ + ((nx) ? vn[h][_i] : va[h][_i]), lds + (bufoff) + ldsw + _i * 8192); } else { PG8_STAGE(bufoff, bp, voffA); } } while (0)
    const size_t kstep = (size_t)(BK * 2);
    const size_t hstep = (size_t)HALF * K * 2;
    const unsigned ldsw = (unsigned)wid * 1024u;
    const int aoff = lds_byte(wr * 64 + fr, fq * 8), boff = lds_byte(wc * 32 + fr, fq * 8);
#define PG8_SA(b, h) (((b) * 2 + (h)) * HTB)
#define PG8_SB(b, h) ((4 + (b) * 2 + (h)) * HTB)
#define PG8_STAGE(bufoff, gbase, voff) do { _Pragma("unroll") for (int _i = 0; _i < 2; ++_i) \
        GLDS16((const char*)(gbase) + (voff)[_i], lds + (bufoff) + ldsw + _i * 8192); } while (0)
#define PG8_LDA(dst, b, h) do { _Pragma("unroll") for (int m = 0; m < 4; ++m) _Pragma("unroll") for (int k = 0; k < 2; ++k) dst[m][k] = *(const LAS bf16x8*)(lds + PG8_SA(b, h) + aoff + m * 2048 + k * 1024); } while (0)
#define PG8_LDB(dst, b, h) do { _Pragma("unroll") for (int n = 0; n < 2; ++n) _Pragma("unroll") for (int k = 0; k < 2; ++k) dst[n][k] = *(const LAS bf16x8*)(lds + PG8_SB(b, h) + boff + n * 2048 + k * 1024); } while (0)
#define PG8_MMA(ai, bj, At, Bt) do { SETPRIO(1); _Pragma("unroll") for (int m = 0; m < 4; ++m) _Pragma("unroll") for (int n = 0; n < 2; ++n) _Pragma("unroll") for (int k = 0; k < 2; ++k) \
        acc[ai][bj][m][n] = MFMA16(Bt[n][k], At[m][k], acc[ai][bj][m][n]); SETPRIO(0); } while (0)
    Unit cur, nxt; int ui = 0;
    if (!S.next(0, cur)) return;
    f32x4 acc[2][2][4][2];
#pragma unroll
    for (int a = 0; a < 2; ++a)
#pragma unroll
        for (int b = 0; b < 2; ++b)
#pragma unroll
            for (int m = 0; m < 4; ++m)
#pragma unroll
                for (int n = 0; n < 2; ++n) acc[a][b][m][n] = (f32x4){0.f, 0.f, 0.f, 0.f};
    bf16x8 At[4][2], B0[2][2], B1[2][2];
    const char* cA = S.abase(cur); const char* cB = S.bbase(cur);
    PG8_GOFF(va, cur);
    PG8_STAGE(PG8_SB(0, 0), cB, voffB); PG8_STAGE_A(PG8_SA(0, 0), cA, 0, 0, false); PG8_STAGE(PG8_SB(0, 1), cB + hstep, voffB); PG8_STAGE_A(PG8_SA(0, 1), cA + hstep, 0, 1, false);
    if (wr == 1) S_BARRIER();
    WAIT_V(4); S_BARRIER();
    PG8_STAGE(PG8_SB(1, 0), cB + kstep, voffB); PG8_STAGE_A(PG8_SA(1, 0), cA + kstep, kstep, 0, false); PG8_STAGE(PG8_SB(1, 1), cB + hstep + kstep, voffB);
    WAIT_V(6); S_BARRIER();
    for (;;) {
        const bool has_next = S.next(ui + 1, nxt);
        const char* nA = has_next ? S.abase(nxt) : cA; const char* nB = has_next ? S.bbase(nxt) : cB;
        if constexpr (Sched::GATHER) { if (has_next) { PG8_GOFF(vn, nxt); } else {
#pragma unroll
            for (int h_ = 0; h_ < 2; ++h_) { vn[h_][0] = va[h_][0]; vn[h_][1] = va[h_][1]; } } }
        for (int t = 0; t < nt; t += 2) {
            const bool last = (t == nt - 2);
            const char* a1 = cA + (size_t)(t + 1) * kstep;
            const char* a2 = last ? nA : cA + (size_t)(t + 2) * kstep; const char* b2 = last ? nB : cB + (size_t)(t + 2) * kstep;
            const char* a3 = a2 + kstep; const char* b3 = b2 + kstep;
            PG8_LDB(B0, 0, 0); SCHED_BAR(); PG8_LDA(At, 0, 0); PG8_STAGE_A(PG8_SA(1, 1), a1 + hstep, (size_t)(t + 1) * kstep, 1, false);
            WAIT_L(8); S_BARRIER(); WAIT_L(0); PG8_MMA(0, 0, At, B0); S_BARRIER(); SCHED_BAR();
            PG8_LDB(B1, 0, 1); PG8_STAGE(PG8_SB(0, 0), b2, voffB);
            S_BARRIER(); WAIT_L(0); PG8_MMA(0, 1, At, B1); S_BARRIER();
            PG8_LDA(At, 0, 1); PG8_STAGE_A(PG8_SA(0, 0), a2, (last ? (size_t)0 : (size_t)(t + 2) * kstep), 0, last);
            S_BARRIER(); WAIT_L(0); PG8_MMA(1, 0, At, B0); S_BARRIER(); SCHED_BAR();
            PG8_STAGE(PG8_SB(0, 1), b2 + hstep, voffB);
            WAIT_V(6); S_BARRIER(); PG8_MMA(1, 1, At, B1); S_BARRIER();
            PG8_LDB(B0, 1, 0); SCHED_BAR(); PG8_LDA(At, 1, 0); PG8_STAGE_A(PG8_SA(0, 1), a2 + hstep, (last ? (size_t)0 : (size_t)(t + 2) * kstep), 1, last);
            WAIT_L(8); S_BARRIER(); WAIT_L(0); PG8_MMA(0, 0, At, B0); S_BARRIER(); SCHED_BAR();
            PG8_LDB(B1, 1, 1); PG8_STAGE(PG8_SB(1, 0), b3, voffB);
            S_BARRIER(); WAIT_L(0); PG8_MMA(0, 1, At, B1); S_BARRIER();
            PG8_LDA(At, 1, 1); PG8_STAGE_A(PG8_SA(1, 0), a3, (last ? kstep : (size_t)(t + 3) * kstep), 0, last);
            S_BARRIER(); WAIT_L(0); PG8_MMA(1, 0, At, B0); S_BARRIER(); SCHED_BAR();
            PG8_STAGE(PG8_SB(1, 1), b3 + hstep, voffB);
            WAIT_V(6); S_BARRIER(); PG8_MMA(1, 1, At, B1); S_BARRIER();
        }
        if (wr == 0) S_BARRIER();
        E(acc, cur, wr, wc, fr, fq);
        if (!has_next) break;
#pragma unroll
        for (int a = 0; a < 2; ++a)
#pragma unroll
            for (int b = 0; b < 2; ++b)
#pragma unroll
                for (int m = 0; m < 4; ++m)
#pragma unroll
                    for (int n = 0; n < 2; ++n) acc[a][b][m][n] = (f32x4){0.f, 0.f, 0.f, 0.f};
        cur = nxt; cA = nA; cB = nB; ++ui;
        if constexpr (Sched::GATHER) {
#pragma unroll
            for (int h_ = 0; h_ < 2; ++h_) { va[h_][0] = vn[h_][0]; va[h_][1] = vn[h_][1]; } }
        if (wr == 1) S_BARRIER();
    }
    WAIT_V(0);
    S_BARRIER();
#undef PG8_SA
#undef PG8_SB
#undef PG8_STAGE
#undef PG8_STAGE_A
#undef PG8_GOFF
#undef PG8_LDA
#undef PG8_LDB
#undef PG8_MMA
}
}

__device__ __forceinline__ float row16_sum(float x) {
#ifdef EMU
    x += __shfl_xor(x, 1); x += __shfl_xor(x, 2); x += __shfl_xor(x, 4); x += __shfl_xor(x, 8); return x;
#else
#define DPPF(v, ctrl) __builtin_bit_cast(float, __builtin_amdgcn_update_dpp(0, __builtin_bit_cast(int, (v)), (ctrl), 0xF, 0xF, false))
    x += DPPF(x, 0xB1); x += DPPF(x, 0x4E); x += DPPF(x, 0x141); x += DPPF(x, 0x140); return x;
#undef DPPF
#endif
}
__device__ __forceinline__ float row32_sum(float x) {
    x = row16_sum(x);
#ifdef EMU
    x += __shfl_xor(x, 32); return x;
#else
    float a = x, b = x;
    asm volatile("s_nop 1\n\tv_permlane32_swap_b32 %0, %1" : "+v"(a), "+v"(b));
    return a + b;
#endif
}
__device__ __forceinline__ float wave_sum_fast(float x, int lane) {
    x = row32_sum(x);
    x += SHX(x, 16, lane);
    return x;
}
__device__ __forceinline__ void transpose_item(const float* W, int K, int N, bf16_t* WT, int k0, int n0, int dst_row0, float* scr, int lane) {
    const int n4 = (lane & 15) * 4, kr = lane >> 4;
#pragma unroll 8
    for (int i = 0; i < 16; ++i) {
        const int kk = 4 * i + kr;
        f32x4 v = (f32x4){0.f, 0.f, 0.f, 0.f};
        if (n0 + n4 < N) v = *(const f32x4*)(W + (size_t)(k0 + kk) * N + n0 + n4);
        float* d = scr + kk * 65 + n4; d[0] = v.x; d[1] = v.y; d[2] = v.z; d[3] = v.w;
    }
    WAVE_SYNC();
    const int c = lane & 7;
#pragma unroll
    for (int j = 0; j < 8; ++j) { const int n = (lane >> 3) + 8 * j; const float* sp = scr + (8 * c) * 65 + n;
        u32x4 o; o.x = pk2(sp[0 * 65], sp[1 * 65]); o.y = pk2(sp[2 * 65], sp[3 * 65]); o.z = pk2(sp[4 * 65], sp[5 * 65]); o.w = pk2(sp[6 * 65], sp[7 * 65]);
        *(u32x4*)(WT + (size_t)(dst_row0 + n) * K + k0 + 8 * c) = o; }
    WAVE_SYNC();
}
__device__ __forceinline__ void phase_prologue(const Params& P, unsigned char* smem, int wv) {
    ParamsPtr pp = PARAMS_PTR(P); PIN_S(pp); unsigned char* ws = pp->ws; int bidx = (int)blockIdx.x, gdim = (int)gridDim.x; PIN_S(bidx); PIN_S(gdim);
    const int tid = phase_tid(wv), lane = tid & 63, wave = tid >> 6;
    float* scr = (float*)smem + wave * (64 * 65);
    const int gw = bidx * NWAVES + wave, ngw = NWAVES * gdim;
    constexpr int I_IN = 16 * (PLD / 64), I_OUT = 16 * 16, I_W1 = NE * 16 * 32, I_W2 = NE * 16 * 16, I_L = I_IN + I_OUT + I_W1 + I_W2;
    for (int it = gw; it < NL * I_L; it += ngw) {
        const int l = it / I_L; int r = it % I_L;
        if (r < I_IN) { const int kb = r / (PLD / 64), nb = r % (PLD / 64);
            transpose_item(pp->in[1] + (size_t)l * D * PIN, D, PIN, (bf16_t*)(ws + O_WIN) + (size_t)l * PLD * D, kb * 64, nb * 64, nb * 64, scr, lane); continue; }
        r -= I_IN;
        if (r < I_OUT) { const int kb = r / 16, nb = r % 16;
            transpose_item(pp->in[21] + (size_t)l * D * D, D, D, (bf16_t*)(ws + O_WOUT) + (size_t)l * D * D, kb * 64, nb * 64, nb * 64, scr, lane); continue; }
        r -= I_OUT;
        if (r < I_W1) { const int e = r / (16 * 32), q = r % (16 * 32), kb = q / 32, nb = q % 32, n0 = nb * 64;
            const int dst = n0 < DFF ? (n0 / 128) * 256 + (n0 % 128) : ((n0 - DFF) / 128) * 256 + 128 + ((n0 - DFF) % 128);
            transpose_item(pp->in[26] + ((size_t)l * NE + e) * D * 2 * DFF, D, 2 * DFF, (bf16_t*)(ws + O_W1) + ((size_t)l * NE + e) * 2 * DFF * D, kb * 64, n0, dst, scr, lane); continue; }
        r -= I_W1;
        { const int e = r / (16 * 16), q = r % (16 * 16), kb = q / 16, nb = q % 16;
            transpose_item(pp->in[28] + ((size_t)l * NE + e) * DFF * D, DFF, D, (bf16_t*)(ws + O_W2) + ((size_t)l * NE + e) * D * DFF, kb * 64, nb * 64, nb * 64, scr, lane); }
    }
    {
        const float* gw_ = pp->in[4]; bf16_t* WSB = (bf16_t*)(ws + O_WSB);
        for (size_t i = ((size_t)bidx * NTHREADS + tid) * 4; i < (size_t)NL * GH * CH * CH; i += (size_t)gdim * NTHREADS * 4) {
            const f32x4 v = *(const f32x4*)(gw_ + i); u32x2 o; o.x = pk2(v.x, v.y); o.y = pk2(v.z, v.w); *(u32x2*)(WSB + i) = o;
        }
    }
    {
        bf16_t* LWT = (bf16_t*)(ws + O_LWT);
        for (int i = bidx * NTHREADS + tid; i < NL * 1920 * 128; i += gdim * NTHREADS) {
            const int k = i & 127, n = (i >> 7) % 1920, ll = i / (1920 * 128);
            float v = 0.f;
            if (n < 1536) { if (k < 64) { const int grp = n / 768, d = (n / 384) & 1, c = n % 384; v = (grp == 0 ? pp->in[8] : pp->in[10])[(((size_t)ll * 2 + d) * 64 + k) * RW + c]; } }
            else v = pp->in[11][((size_t)ll * 128 + k) * RW + (n - 1536)];
            LWT[i] = (bf16_t)f2bf(v);
        }
    }
    {
        bf16_t* RWT = (bf16_t*)(ws + O_RWT);
        for (int i = bidx * NTHREADS + tid; i < NL * NE * D; i += gdim * NTHREADS) {
            const int k = i % D, e = (i / D) % NE, ll = i / (D * NE);
            const float v = pp->in[24][((size_t)ll * D + k) * NE + e];
            const unsigned hi = f2bf(v); const float lo = v - bf_lo(hi);
            RWT[((size_t)(ll * 2 + 0) * NE + e) * D + k] = (bf16_t)hi; RWT[((size_t)(ll * 2 + 1) * NE + e) * D + k] = (bf16_t)f2bf(lo);
        }
    }
    const float* x = pp->in[0]; bf16_t* XB = (bf16_t*)(ws + O_XB);
    for (size_t i = ((size_t)bidx * NTHREADS + tid) * 4; i < (size_t)T * D; i += (size_t)gdim * NTHREADS * 4) {
        const f32x4 v = *(const f32x4*)(x + i); u32x2 o; o.x = pk2(v.x, v.y); o.y = pk2(v.z, v.w); *(u32x2*)(XB + i) = o;
    }
}

__device__ __forceinline__ float tshift(const float* P, int t, int s, int col, const float* mu0, const float* mu1, int rc) {
    const float cur = P[(size_t)t * PLD + col];
    const float prv = s > 0 ? P[(size_t)(t - 1) * PLD + col] : 0.f;
    const float nxt = s < S - 1 ? P[(size_t)(t + 1) * PLD + col] : 0.f;
    return cur + mu0[rc] * (prv - cur) + mu1[rc] * (nxt - cur);
}

__device__ __forceinline__ void phase_prep(const Params& P, int l, unsigned char* smem, int wv) {
    ParamsPtr pp = PARAMS_PTR(P); PIN_S(pp); unsigned char* ws = pp->ws; int bidx = (int)blockIdx.x, gdim = (int)gridDim.x; PIN_S(bidx); PIN_S(gdim);
    const bf16_t* proj = (const bf16_t*)(ws + O_PROJ); const float* projg = (const float*)(ws + O_PROJG);
    float* UG = (float*)(ws + O_UG); bf16_t* VNT = (bf16_t*)(ws + O_VNT);
    float* RR = (float*)(ws + O_RR); float* VV = (float*)(ws + O_VV); float* KK = (float*)(ws + O_KK);
    float* KD = (float*)(ws + O_KD); float* ICLR = (float*)(ws + O_ICLR);
    float* GATE = (float*)(ws + O_GATE); float* BONUS = (float*)(ws + O_BONUS); float* LWG = (float*)(ws + O_LW);
    bf16_t* RB = (bf16_t*)(ws + O_RB); bf16_t* VB = (bf16_t*)(ws + O_VB); bf16_t* KKB = (bf16_t*)(ws + O_KKB); bf16_t* BBB = (bf16_t*)(ws + O_BBB); bf16_t* KDB = (bf16_t*)(ws + O_KDB);
#if !MK_RWKV_CHUNKED
    float* DEC = (float*)(ws + O_DEC); float* BRKR = (float*)(ws + O_BRKR);
#endif
    bf16_t* MQB = (bf16_t*)(ws + O_MQB); bf16_t* MKB = (bf16_t*)(ws + O_MKB); bf16_t* KT = (bf16_t*)(ws + O_KT); bf16_t* VT = (bf16_t*)(ws + O_VT);
    float* IG = (float*)(ws + O_IG); float* LF = (float*)(ws + O_LF);
    const bf16_t* LWT = (const bf16_t*)(ws + O_LWT) + (size_t)l * 1920 * 128;
    const float* gln_g = pp->in[2] + (size_t)l * GW; const float* gln_b = pp->in[3] + (size_t)l * GW;
    const float* mu0 = pp->in[6] + (size_t)l * 2 * RPROJ; const float* mu1 = mu0 + RPROJ;
    const float* w0 = pp->in[7] + (size_t)l * 2 * RW; const float* a0 = pp->in[9] + (size_t)l * 2 * RW;
    const float* k_k = pp->in[12] + (size_t)l * RW; const float* k_a = pp->in[13] + (size_t)l * RW; const float* r_k = pp->in[14] + (size_t)l * RW;
    const float* conv_w = pp->in[17] + (size_t)l * 3 * 768; const float* conv_b = pp->in[18] + (size_t)l * 768; const float* gate_b = pp->in[19] + (size_t)l * 24;
    float* win = (float*)smem;
    bf16_t* lin = (bf16_t*)(smem + 101376);
    bf16_t* tvn = (bf16_t*)(smem + 110592);
    bf16_t* tk = (bf16_t*)(smem + 118784);
    bf16_t* tv = (bf16_t*)(smem + 131072);
    constexpr int LIN = 264;
    const int tid = phase_tid(wv), lane = tid & 63, wave = tid >> 6, col = lane & 15, g = lane >> 4;
    for (int u = bidx; u < T / 16; u += gdim) {
        const int t0 = u * 16, s0 = t0 % S, bb = t0 / S;
        __syncthreads();
        {
            u32x2 wb[18];
#pragma unroll
            for (int row = 0; row < 18; ++row) {
                const int sq = s0 - 1 + row;
                wb[row] = (u32x2){0u, 0u};
                if (sq >= 0 && sq < S && tid < 352) wb[row] = *(const u32x2*)(proj + (size_t)(t0 - 1 + row) * PLD + C_RW + tid * 4);
            }
            if (tid < 352) {
#pragma unroll
                for (int row = 0; row < 18; ++row) *(f32x4*)(win + row * RPROJ + tid * 4) = (f32x4){bf_lo(wb[row].x), bf_hi(wb[row].x), bf_lo(wb[row].y), bf_hi(wb[row].y)};
            }
        }
        for (int rep_ = 0; rep_ < (MK_PROBE == 3 ? 2 : 1); ++rep_) {
            const int i = tid >> 5, l32 = tid & 31, t = t0 + i;
            float v[8], ug[8]; float sum = 0.f;
#pragma unroll
            for (int j = 0; j < 8; ++j) { const int c = j * 32 + l32; ug[j] = bf_lo((unsigned)proj[(size_t)t * PLD + c]); v[j] = bf_lo((unsigned)proj[(size_t)t * PLD + GW + c]); }
#pragma unroll
            for (int j = 0; j < 8; ++j) { const int c = j * 32 + l32; UG[(size_t)t * GW + c] = geluf_(ug[j]); v[j] = geluf_(v[j]); sum += v[j]; }
#pragma unroll
            for (int o = 16; o >= 1; o >>= 1) sum += SHX(sum, o, lane);
            const float mean = sum * (1.0f / GW); float q = 0.f;
#pragma unroll
            for (int j = 0; j < 8; ++j) { const float d = v[j] - mean; q += d * d; }
#pragma unroll
            for (int o = 16; o >= 1; o >>= 1) q += SHX(q, o, lane);
            const float rstd = 1.0f / sqrtf(q * (1.0f / GW) + LN_EPS);
#pragma unroll
            for (int j = 0; j < 8; ++j) { const int c = j * 32 + l32; tvn[c * 16 + i] = (bf16_t)f2bf((v[j] - mean) * rstd * gln_g[c] + gln_b[c]); }
        }
        __syncthreads();
        {
            const int hf = tid & 1, c = tid >> 1;
            *(u32x4*)(VNT + ((size_t)bb * GW + c) * S + s0 + hf * 8) = *(const u32x4*)(tvn + c * 16 + hf * 8);
        }
        for (int idx = tid; idx < 16 * 256; idx += NTHREADS) {
            const int i = idx >> 8, j = idx & 255, rc = 1152 + j;
            const float pv = win[i * RPROJ + rc], cv = win[(i + 1) * RPROJ + rc], nv = win[(i + 2) * RPROJ + rc];
            const float x = cv + mu0[rc] * (pv - cv) + mu1[rc] * (nv - cv);
            lin[i * LIN + j] = (bf16_t)f2bf(j < 64 ? ftanh(x) : (j < 128 ? x : sigmoidf_(x)));
        }
        __syncthreads();
        for (int rep_ = 0; rep_ < (MK_PROBE == 1 ? 2 : 1); ++rep_) {
#pragma unroll 1
            for (int qg = 0; qg < 3; ++qg) {
                bf16x8 bw_[5][4]; float bias_[5];
#pragma unroll
                for (int q5 = 0; q5 < 5; ++q5) {
                    const int nt = wave * 15 + qg * 5 + q5, grp = nt / 24, c = (nt % 24) * 16 + col;
                    const bf16_t* bw = LWT + (size_t)(nt * 16 + col) * 128 + 8 * g;
#pragma unroll
                    for (int ks = 0; ks < 2; ++ks) bw_[q5][ks] = *(const bf16x8*)(bw + ks * 32);
                    if (grp == 4) {
#pragma unroll
                        for (int ks = 2; ks < 4; ++ks) bw_[q5][ks] = *(const bf16x8*)(bw + ks * 32);
                    }
                    bias_[q5] = grp < 2 ? w0[grp * RW + c] : (grp < 4 ? a0[(grp - 2) * RW + c] : 0.f);
                }
#pragma unroll
                for (int q5 = 0; q5 < 5; ++q5) {
                    const int nt = wave * 15 + qg * 5 + q5, grp = nt / 24, c = (nt % 24) * 16 + col;
                    const int kcol = grp < 2 ? 0 : (grp < 4 ? 64 : 128);
                    f32x4 acc = (f32x4){0.f, 0.f, 0.f, 0.f};
#pragma unroll
                    for (int ks = 0; ks < 2; ++ks) acc = MFMA16(*(const bf16x8*)(lin + col * LIN + kcol + ks * 32 + 8 * g), bw_[q5][ks], acc);
                    if (grp == 4) {
#pragma unroll
                        for (int ks = 2; ks < 4; ++ks) acc = MFMA16(*(const bf16x8*)(lin + col * LIN + kcol + ks * 32 + 8 * g), bw_[q5][ks], acc);
                    }
                    if (grp < 2) {
#pragma unroll
                        for (int r = 0; r < 4; ++r) { const float lw = -fexp(-softplusf_(-(acc[r] + bias_[q5])) - 0.5f); const size_t o = (size_t)grp * T * RW + (size_t)(t0 + 4 * g + r) * RW + c; LWG[o] = lw;
#if !MK_RWKV_CHUNKED
                            DEC[o] = expf(lw);
#endif
                        }
                    } else if (grp < 4) {
#pragma unroll
                        for (int r = 0; r < 4; ++r) ICLR[(size_t)(grp - 2) * T * RW + (size_t)(t0 + 4 * g + r) * RW + c] = sigmoidf_(acc[r] + bias_[q5]);
                    } else {
#pragma unroll
                        for (int r = 0; r < 4; ++r) GATE[(size_t)(t0 + 4 * g + r) * RW + c] = acc[r];
                    }
                }
            }
        }
        __syncthreads();
        for (int rep_ = 0; rep_ < (MK_PROBE == 2 ? 2 : 1); ++rep_) if (wave < 6) {
            const int c = tid, h = wave;
            const float kkc = k_k[c], kac = k_a[c], rkc = r_k[c];
            const float m0r = mu0[c], m1r = mu1[c], m0k = mu0[RW + c], m1k = mu1[RW + c], m0v = mu0[2 * RW + c], m1v = mu1[2 * RW + c];
            float ic0[16], ic1[16];
#pragma unroll
            for (int i = 0; i < 16; ++i) { const size_t o = (size_t)(t0 + i) * RW + c; ic0[i] = ICLR[o]; ic1[i] = ICLR[(size_t)T * RW + o]; }
#pragma unroll
            for (int i = 0; i < 16; ++i) {
                const int t = t0 + i;
                const float* w_ = win + i * RPROJ + c;
                const float rp = w_[0], rc_ = w_[RPROJ], rn = w_[2 * RPROJ];
                const float kp = w_[RW], kc_ = w_[RPROJ + RW], kn = w_[2 * RPROJ + RW];
                const float vp = w_[2 * RW], vc_ = w_[RPROJ + 2 * RW], vn = w_[2 * RPROJ + 2 * RW];
                const float r = rc_ + m0r * (rp - rc_) + m1r * (rn - rc_);
                const float k = kc_ + m0k * (kp - kc_) + m1k * (kn - kc_);
                const float v = vc_ + m0v * (vp - vc_) + m1v * (vn - vc_);
                const size_t o = (size_t)t * RW + c;
                const float kq = k * kkc;
                const float n2 = wave_sum_fast(kq * kq, lane);
                const float kk = kq / fmaxf(sqrtf(n2), 1e-12f);
                const float kd0 = k * (1.0f + (ic0[i] - 1.0f) * kac), kd1 = k * (1.0f + (ic1[i] - 1.0f) * kac);
                const float bon = wave_sum_fast(r * (kd0 + kd1) * rkc, lane);
#if MK_RWKV_CHUNKED
                RB[o] = (bf16_t)f2bf(r); VB[o] = (bf16_t)f2bf(v); KKB[o] = (bf16_t)f2bf(kk);
                BBB[o] = (bf16_t)f2bf(kk * ic0[i]); BBB[(size_t)T * RW + o] = (bf16_t)f2bf(kk * ic1[i]);
                KDB[o] = (bf16_t)f2bf(kd0); KDB[(size_t)T * RW + o] = (bf16_t)f2bf(kd1);
#else
                RR[o] = r; VV[o] = v; KK[o] = kk;
                KD[o] = kd0; KD[(size_t)T * RW + o] = kd1;
#endif
                if (lane == 0) BONUS[(size_t)t * RH + h] = bon;
#if !MK_RWKV_CHUNKED
                { const float br0 = wave_sum(kk * ic0[i] * r, lane), br1 = wave_sum(kk * ic1[i] * r, lane), kr0 = wave_sum(kd0 * r, lane), kr1 = wave_sum(kd1 * r, lane);
                  if (lane == 0) { BRKR[((size_t)t * RH + h) * 2] = br0; BRKR[((size_t)t * RH + h) * 2 + 1] = kr0; BRKR[((size_t)(T + t) * RH + h) * 2] = br1; BRKR[((size_t)(T + t) * RH + h) * 2 + 1] = kr1; } }
#endif
            }
        }
        __syncthreads();
        {
            u32x2 wb[9], vb[3];
            const int rsel = tid >= 192 ? 1 : 0, c4 = tid - rsel * 192;
#pragma unroll
            for (int it = 0; it < 9; ++it) {
                const int row = 2 * it + rsel, sq = s0 - 1 + row;
                wb[it] = (u32x2){0u, 0u};
                if (tid < 384 && sq >= 0 && sq < S) wb[it] = *(const u32x2*)(proj + (size_t)(t0 - 1 + row) * PLD + C_MW + c4 * 4);
            }
#pragma unroll
            for (int it = 0; it < 3; ++it) { const int idx = tid + it * NTHREADS, i = idx / 96, cc = (idx % 96) * 4; vb[it] = *(const u32x2*)(proj + (size_t)(t0 + i) * PLD + C_MW + 2 * MW + cc); }
            if (tid < 384) {
#pragma unroll
                for (int it = 0; it < 9; ++it) *(f32x4*)(win + (2 * it + rsel) * 768 + c4 * 4) = (f32x4){bf_lo(wb[it].x), bf_hi(wb[it].x), bf_lo(wb[it].y), bf_hi(wb[it].y)};
            }
#pragma unroll
            for (int it = 0; it < 3; ++it) { const int idx = tid + it * NTHREADS, i = idx / 96, cc = (idx % 96) * 4; const u32x2 v = vb[it];
                tv[(cc + 0) * 16 + i] = (bf16_t)(v.x & 0xffffu); tv[(cc + 1) * 16 + i] = (bf16_t)(v.x >> 16); tv[(cc + 2) * 16 + i] = (bf16_t)(v.y & 0xffffu); tv[(cc + 3) * 16 + i] = (bf16_t)(v.y >> 16); }
        }
        for (int idx = tid; idx < 16 * 24; idx += NTHREADS) {
            const int i = idx / 24, gi = idx % 24, t = t0 + i;
            const int isf = gi / 12, dir = (gi / 6) & 1, h = gi % 6;
            const float gg = projg[(size_t)t * 256 + (3456 - (PLD - 256)) + gi] + gate_b[gi];
            if (isf) LF[((size_t)dir * T + t) * MH + h] = -softplusf_(-gg); else IG[((size_t)dir * T + t) * MH + h] = gg;
        }
        __syncthreads();
        for (int rep_ = 0; rep_ < (MK_PROBE == 4 ? 2 : 1); ++rep_)
        for (int idx = tid; idx < 16 * 768; idx += NTHREADS) {
            const int i = idx / 768, c = idx % 768, t = t0 + i;
            const float* w_ = win + i * 768 + c;
            float y = conv_b[c] + w_[0] * conv_w[c] + w_[768] * conv_w[768 + c] + w_[1536] * conv_w[2 * 768 + c];
            y = y * sigmoidf_(y);
            if (c < MW) MQB[(size_t)t * MW + c] = (bf16_t)f2bf(y);
            else { const bf16_t kb = (bf16_t)f2bf(y * 0.125f); MKB[(size_t)t * MW + (c - MW)] = kb; tk[(c - MW) * 16 + i] = kb; }
        }
        __syncthreads();
        for (int idx = tid; idx < 2 * MW * 2; idx += NTHREADS) {
            const int hf = idx & 1, c = (idx >> 1) % MW, which = idx / (2 * MW);
            const u32x4 val = *(const u32x4*)((which ? tv : tk) + c * 16 + hf * 8);
            bf16_t* dst = (which ? VT : KT) + ((size_t)(bb * MH) * 64 + c) * S + s0 + hf * 8;
            *(u32x4*)dst = val;
        }
    }
    __syncthreads();
}

__device__ __forceinline__ void phase_prep32(const Params& P, int l, unsigned char* smem, int wv) {
    ParamsPtr pp = PARAMS_PTR(P); PIN_S(pp); unsigned char* ws = pp->ws; int bidx = (int)blockIdx.x, gdim = (int)gridDim.x; PIN_S(bidx); PIN_S(gdim);
    const bf16_t* proj = (const bf16_t*)(ws + O_PROJ); const float* projg = (const float*)(ws + O_PROJG);
    float* UG = (float*)(ws + O_UG); bf16_t* VNT = (bf16_t*)(ws + O_VNT);
    u32x4* RK7 = (u32x4*)(ws + O_RK7);
    float* GATE = (float*)(ws + O_GATE); float* BONUS = (float*)(ws + O_BONUS); float* LWG = (float*)(ws + O_LW);
    bf16_t* VB = (bf16_t*)(ws + O_VB);
    bf16_t* MQB = (bf16_t*)(ws + O_MQB); bf16_t* MKB = (bf16_t*)(ws + O_MKB); bf16_t* KT = (bf16_t*)(ws + O_KT); bf16_t* VT = (bf16_t*)(ws + O_VT);
    float* IG = (float*)(ws + O_IG); float* LF = (float*)(ws + O_LF);
    const bf16_t* LWT = (const bf16_t*)(ws + O_LWT) + (size_t)l * 1920 * 128;
    const float* gln_g = pp->in[2] + (size_t)l * GW; const float* gln_b = pp->in[3] + (size_t)l * GW;
    const float* mu0 = pp->in[6] + (size_t)l * 2 * RPROJ; const float* mu1 = mu0 + RPROJ;
    const float* w0 = pp->in[7] + (size_t)l * 2 * RW; const float* a0 = pp->in[9] + (size_t)l * 2 * RW;
    const float* k_k = pp->in[12] + (size_t)l * RW; const float* k_a = pp->in[13] + (size_t)l * RW; const float* r_k = pp->in[14] + (size_t)l * RW;
    const float* conv_w = pp->in[17] + (size_t)l * 3 * 768; const float* conv_b = pp->in[18] + (size_t)l * 768; const float* gate_b = pp->in[19] + (size_t)l * 24;
    constexpr int TOK = 32, WR = TOK + 2, LIN = 264;
    bf16_t* winb = (bf16_t*)smem;
    bf16_t* lin = (bf16_t*)(smem + 95744);
    bf16_t* tk = (bf16_t*)(smem + 112640);
    bf16_t* tv = (bf16_t*)(smem + 137216);
    bf16_t* tvn = tk;
    bf16_t* icl = tk;
    const int tid = phase_tid(wv), lane = tid & 63, wave = tid >> 6, col = lane & 15, g = lane >> 4;
    for (int u = bidx; u < T / TOK; u += gdim) {
        const int t0 = u * TOK, s0 = t0 % S, bb = t0 / S;
        __syncthreads();
#pragma unroll 1
        for (int hb = 0; hb < 2; ++hb) {
            u32x2 wb[17];
#pragma unroll
            for (int q = 0; q < 17; ++q) {
                const int row = hb * 17 + q, sq = s0 - 1 + row;
                wb[q] = (u32x2){0u, 0u};
                if (sq >= 0 && sq < S && tid < 352) wb[q] = *(const u32x2*)(proj + (size_t)(t0 - 1 + row) * PLD + C_RW + tid * 4);
            }
            if (tid < 352) {
#pragma unroll
                for (int q = 0; q < 17; ++q) *(u32x2*)(winb + (hb * 17 + q) * RPROJ + tid * 4) = wb[q];
            }
        }
#pragma unroll 1
        for (int ps = 0; ps < 2; ++ps) {
            const int i = ps * 16 + (tid >> 5), l32 = tid & 31, t = t0 + i;
            float v[8], ug[8]; float sum = 0.f;
#pragma unroll
            for (int j = 0; j < 8; ++j) { const int c = j * 32 + l32; ug[j] = bf_lo((unsigned)proj[(size_t)t * PLD + c]); v[j] = bf_lo((unsigned)proj[(size_t)t * PLD + GW + c]); }
#pragma unroll
            for (int j = 0; j < 8; ++j) { const int c = j * 32 + l32; UG[(size_t)t * GW + c] = geluf_(ug[j]); v[j] = geluf_(v[j]); sum += v[j]; }
#pragma unroll
            for (int o = 16; o >= 1; o >>= 1) sum += SHX(sum, o, lane);
            const float mean = sum * (1.0f / GW); float q = 0.f;
#pragma unroll
            for (int j = 0; j < 8; ++j) { const float d = v[j] - mean; q += d * d; }
#pragma unroll
            for (int o = 16; o >= 1; o >>= 1) q += SHX(q, o, lane);
            const float rstd = 1.0f / sqrtf(q * (1.0f / GW) + LN_EPS);
#pragma unroll
            for (int j = 0; j < 8; ++j) { const int c = j * 32 + l32; tvn[c * TOK + i] = (bf16_t)f2bf((v[j] - mean) * rstd * gln_g[c] + gln_b[c]); }
        }
        __syncthreads();
#pragma unroll
        for (int q = 0; q < 2; ++q) {
            const int idx = tid + q * NTHREADS, c = idx >> 2, pc = idx & 3;
            *(u32x4*)(VNT + ((size_t)bb * GW + c) * S + s0 + pc * 8) = *(const u32x4*)(tvn + c * TOK + pc * 8);
        }
        int tb2 = tid; PIN_V(tb2);
#pragma unroll 4
        for (int q = 0; q < 16; ++q) {
            const int idx = tb2 + q * NTHREADS, i = idx >> 8, j = idx & 255, rc = 1152 + j;
            const float pv = bf_lo((unsigned)winb[i * RPROJ + rc]), cv = bf_lo((unsigned)winb[(i + 1) * RPROJ + rc]), nv = bf_lo((unsigned)winb[(i + 2) * RPROJ + rc]);
            const float x = cv + mu0[rc] * (pv - cv) + mu1[rc] * (nv - cv);
            lin[i * LIN + j] = (bf16_t)f2bf(j < 64 ? ftanh(x) : (j < 128 ? x : sigmoidf_(x)));
        }
        __syncthreads();
#pragma unroll 1
        for (int qg = 0; qg < 3; ++qg) {
            bf16x8 bw_[5][4]; float bias_[5];
#pragma unroll
            for (int q5 = 0; q5 < 5; ++q5) {
                const int nt = wave * 15 + qg * 5 + q5, grp = nt / 24, c = (nt % 24) * 16 + col;
                const bf16_t* bw = LWT + (size_t)(nt * 16 + col) * 128 + 8 * g;
#pragma unroll
                for (int ks = 0; ks < 2; ++ks) bw_[q5][ks] = *(const bf16x8*)(bw + ks * 32);
                if (grp == 4) {
#pragma unroll
                    for (int ks = 2; ks < 4; ++ks) bw_[q5][ks] = *(const bf16x8*)(bw + ks * 32);
                }
                bias_[q5] = grp < 2 ? w0[grp * RW + c] : (grp < 4 ? a0[(grp - 2) * RW + c] : 0.f);
            }
#pragma unroll
            for (int q5 = 0; q5 < 5; ++q5) {
                const int nt = wave * 15 + qg * 5 + q5, grp = nt / 24, c = (nt % 24) * 16 + col;
                const int kcol = grp < 2 ? 0 : (grp < 4 ? 64 : 128);
#pragma unroll
                for (int mt = 0; mt < 2; ++mt) {
                    f32x4 acc = (f32x4){0.f, 0.f, 0.f, 0.f};
                    const bf16_t* la = lin + (mt * 16 + col) * LIN + kcol + 8 * g;
#pragma unroll
                    for (int ks = 0; ks < 2; ++ks) acc = MFMA16(*(const bf16x8*)(la + ks * 32), bw_[q5][ks], acc);
                    if (grp == 4) {
#pragma unroll
                        for (int ks = 2; ks < 4; ++ks) acc = MFMA16(*(const bf16x8*)(la + ks * 32), bw_[q5][ks], acc);
                    }
                    const size_t tb = (size_t)(t0 + mt * 16 + 4 * g);
                    if (grp < 2) {
#pragma unroll
                        for (int r = 0; r < 4; ++r) LWG[(size_t)grp * T * RW + (tb + r) * RW + c] = -fexp(-softplusf_(-(acc[r] + bias_[q5])) - 0.5f);
                    } else if (grp < 4) {
#pragma unroll
                        for (int r = 0; r < 4; ++r) icl[((grp - 2) * TOK + mt * 16 + 4 * g + r) * RW + c] = (bf16_t)f2bf(sigmoidf_(acc[r] + bias_[q5]));
                    } else {
#pragma unroll
                        for (int r = 0; r < 4; ++r) GATE[(tb + r) * RW + c] = acc[r];
                    }
                }
            }
        }
        __syncthreads();
        if (wave < 6) {
            int c = tid; PIN_V(c); const int h = wave;
            const float kkc = k_k[c], kac = k_a[c], rkc = r_k[c];
            const float m0r = mu0[c], m1r = mu1[c], m0k = mu0[RW + c], m1k = mu1[RW + c], m0v = mu0[2 * RW + c], m1v = mu1[2 * RW + c];
#pragma unroll 1
            for (int hb = 0; hb < 2; ++hb) {
                float ic0[16], ic1[16];
#pragma unroll
                for (int i = 0; i < 16; ++i) { ic0[i] = bf_lo((unsigned)icl[(hb * 16 + i) * RW + c]); ic1[i] = bf_lo((unsigned)icl[(TOK + hb * 16 + i) * RW + c]); }
#pragma unroll
                for (int i = 0; i < 16; ++i) {
                    const int it = hb * 16 + i, t = t0 + it;
                    const bf16_t* w_ = winb + it * RPROJ + c;
                    const float rp = bf_lo((unsigned)w_[0]), rc_ = bf_lo((unsigned)w_[RPROJ]), rn = bf_lo((unsigned)w_[2 * RPROJ]);
                    const float kp = bf_lo((unsigned)w_[RW]), kc_ = bf_lo((unsigned)w_[RPROJ + RW]), kn = bf_lo((unsigned)w_[2 * RPROJ + RW]);
                    const float vp = bf_lo((unsigned)w_[2 * RW]), vc_ = bf_lo((unsigned)w_[RPROJ + 2 * RW]), vn = bf_lo((unsigned)w_[2 * RPROJ + 2 * RW]);
                    const float r = rc_ + m0r * (rp - rc_) + m1r * (rn - rc_);
                    const float k = kc_ + m0k * (kp - kc_) + m1k * (kn - kc_);
                    const float v = vc_ + m0v * (vp - vc_) + m1v * (vn - vc_);
                    const size_t o = (size_t)t * RW + c;
                    const float kq = k * kkc;
                    const float n2 = wave_sum_fast(kq * kq, lane);
                    const float kk = kq / fmaxf(sqrtf(n2), 1e-12f);
                    const float kd0 = k * (1.0f + (ic0[i] - 1.0f) * kac), kd1 = k * (1.0f + (ic1[i] - 1.0f) * kac);
                    const float bon = wave_sum_fast(r * (kd0 + kd1) * rkc, lane);
                    u32x4 rec; rec.x = pk2(r, v); rec.y = pk2(kk, 0.f); rec.z = pk2(kk * ic0[i], kk * ic1[i]); rec.w = pk2(kd0, kd1);
                    RK7[o] = rec;
                    VB[o] = (bf16_t)(rec.x >> 16);
                    if (lane == 0) BONUS[(size_t)t * RH + h] = bon;
                }
            }
        }
        __syncthreads();
        {
            u32x2 wb[17], vb[6];
            const int rsel = tid >= 192 ? 1 : 0, c4 = tid - rsel * 192;
#pragma unroll
            for (int q = 0; q < 17; ++q) {
                const int row = 2 * q + rsel, sq = s0 - 1 + row;
                wb[q] = (u32x2){0u, 0u};
                if (tid < 384 && sq >= 0 && sq < S) wb[q] = *(const u32x2*)(proj + (size_t)(t0 - 1 + row) * PLD + C_MW + c4 * 4);
            }
#pragma unroll
            for (int q = 0; q < 6; ++q) { const int idx = tid + q * NTHREADS, i = idx / 96, cc = (idx % 96) * 4; vb[q] = *(const u32x2*)(proj + (size_t)(t0 + i) * PLD + C_MW + 2 * MW + cc); }
            if (tid < 384) {
#pragma unroll
                for (int q = 0; q < 17; ++q) *(u32x2*)(winb + (2 * q + rsel) * 768 + c4 * 4) = wb[q];
            }
#pragma unroll
            for (int q = 0; q < 6; ++q) { const int idx = tid + q * NTHREADS, i = idx / 96, cc = (idx % 96) * 4; const u32x2 v = vb[q];
                tv[(cc + 0) * TOK + i] = (bf16_t)(v.x & 0xffffu); tv[(cc + 1) * TOK + i] = (bf16_t)(v.x >> 16); tv[(cc + 2) * TOK + i] = (bf16_t)(v.y & 0xffffu); tv[(cc + 3) * TOK + i] = (bf16_t)(v.y >> 16); }
        }
        for (int idx = tid; idx < TOK * 24; idx += NTHREADS) {
            const int i = idx / 24, gi = idx % 24, t = t0 + i;
            const int isf = gi / 12, dir = (gi / 6) & 1, h = gi % 6;
            const float gg = projg[(size_t)t * 256 + (3456 - (PLD - 256)) + gi] + gate_b[gi];
            if (isf) LF[((size_t)dir * T + t) * MH + h] = -softplusf_(-gg); else IG[((size_t)dir * T + t) * MH + h] = gg;
        }
        __syncthreads();
        int tcv = tid; PIN_V(tcv);
#pragma unroll 4
        for (int q = 0; q < 48; ++q) {
            const int idx = tcv + q * NTHREADS, i = idx / 768, c = idx % 768, t = t0 + i;
            const bf16_t* w_ = winb + i * 768 + c;
            float y = conv_b[c] + bf_lo((unsigned)w_[0]) * conv_w[c] + bf_lo((unsigned)w_[768]) * conv_w[768 + c] + bf_lo((unsigned)w_[1536]) * conv_w[2 * 768 + c];
            y = y * sigmoidf_(y);
            if (c < MW) MQB[(size_t)t * MW + c] = (bf16_t)f2bf(y);
            else { const bf16_t kb = (bf16_t)f2bf(y * 0.125f); MKB[(size_t)t * MW + (c - MW)] = kb; tk[(c - MW) * TOK + i] = kb; }
        }
        __syncthreads();
#pragma unroll
        for (int q = 0; q < 6; ++q) {
            const int idx = tid + q * NTHREADS, pc = idx & 3, c = (idx >> 2) % MW, which = idx / (4 * MW);
            const u32x4 val = *(const u32x4*)((which ? tv : tk) + c * TOK + pc * 8);
            bf16_t* dst = (which ? VT : KT) + ((size_t)(bb * MH) * 64 + c) * S + s0 + pc * 8;
            *(u32x4*)dst = val;
        }
    }
    __syncthreads();
}

__device__ __forceinline__ void phase_gmlp_mix(const Params& P, int l, unsigned char* smem, int wv, int bid, int nb) {
    PIN_S(bid); PIN_S(nb);
    ParamsPtr pp = PARAMS_PTR(P); PIN_S(pp); unsigned char* ws = pp->ws;
    const float* UG = (const float*)(ws + O_UG); const bf16_t* VNT = (const bf16_t*)(ws + O_VNT); bf16_t* GRP = (bf16_t*)(ws + O_GRP);
    const bf16_t* WSB = (const bf16_t*)(ws + O_WSB) + (size_t)l * GH * CH * CH; const float* gbs = pp->in[5] + (size_t)l * GH * CH;
    const int tid = phase_tid(wv), lane = tid & 63, wave = tid >> 6, col = lane & 15, g = lane >> 4;
    for (int u = bid; u < NB * NCH * GH; u += nb) {
        const int h = u % GH, c = (u / GH) % NCH, b = u / (GH * NCH);
        const int tok0 = b * S + c * CH;
        const bf16_t* wb = WSB + (size_t)h * CH * CH + (size_t)(wave * 16 + col) * CH + 8 * g;
        const bf16_t* vb = VNT + ((size_t)b * GW + h * 64 + col) * S + (size_t)c * CH + 8 * g;
        f32x4 acc[4];
#pragma unroll
        for (int et = 0; et < 4; ++et) acc[et] = (f32x4){0.f, 0.f, 0.f, 0.f};
#pragma unroll
        for (int ks = 0; ks < 4; ++ks) {
            const bf16x8 af = *(const bf16x8*)(wb + ks * 32);
#pragma unroll
            for (int et = 0; et < 4; ++et) acc[et] = MFMA16(af, *(const bf16x8*)(vb + (size_t)et * 16 * S + ks * 32), acc[et]);
        }
#pragma unroll
        for (int r = 0; r < 4; ++r) {
            const int p = wave * 16 + 4 * g + r; const size_t t = (size_t)(tok0 + p); const float bsv = gbs[h * CH + p];
#pragma unroll
            for (int et = 0; et < 4; ++et) { const int ch = h * 64 + et * 16 + col; GRP[t * D + ch] = (bf16_t)f2bf(UG[t * GW + ch] * (acc[et][r] + bsv)); }
        }
    }
}

constexpr int SC_STEPS = 16;
constexpr int SC_BUF = SC_STEPS * 6 * 64;
__device__ __forceinline__ void phase_rwkv_scan(const Params& P, int l, unsigned char* smem, int wv, int bid, int nb) {
    PIN_S(bid); PIN_S(nb);
    ParamsPtr pp = PARAMS_PTR(P); PIN_S(pp); unsigned char* ws = pp->ws;
    const float* RR = (const float*)(ws + O_RR); const float* VV = (const float*)(ws + O_VV); const float* KK = (const float*)(ws + O_KK);
    const float* DEC = (const float*)(ws + O_DEC); const float* KD = (const float*)(ws + O_KD); const float* ICLR = (const float*)(ws + O_ICLR);
    float* SCAN = (float*)(ws + O_SCAN); const float* BRKR = (const float*)(ws + O_BRKR);
    const int tid = phase_tid(wv), lane = tid & 63, wave = tid >> 6, rl = (lane >> 4) & 1, kq = (lane & 15) | ((lane >> 5) << 4);
    float* buf = (float*)smem;
    float* scal = buf + 2 * SC_BUF;
    float* outb = scal + 2 * SC_STEPS * 2;
    typedef float f32x2 __attribute__((ext_vector_type(2)));
    for (int u = bid; u < 2 * NB * RH * 4; u += nb) {
        const int qt = u & 3, h = (u >> 2) % RH, b = (u / (4 * RH)) % NB, d = u / (4 * RH * NB);
        const size_t doff = (size_t)d * T * RW;
        float s0 = 0.f, s1 = 0.f;
        float pw[2], pa[2], pb[2], pk[2], pr[2], pv[2], psc = 0.f;
#define SC_LOAD(c) do { _Pragma("unroll") for (int i = 0; i < 2; ++i) { const int idx = tid + NTHREADS * i, st = idx >> 6, k = idx & 63; const int tau = (c) * SC_STEPS + st, sq = d ? S - 1 - tau : tau; \
            const size_t o = (size_t)(b * S + sq) * RW + h * 64 + k; \
            pw[i] = DEC[doff + o]; pa[i] = KK[o]; pb[i] = ICLR[doff + o]; pk[i] = KD[doff + o]; pr[i] = RR[o]; pv[i] = VV[o]; }     \
            if (tid < 2 * SC_STEPS) { const int tau = (c) * SC_STEPS + (tid >> 1), sq = d ? S - 1 - tau : tau; psc = BRKR[((size_t)(d * T + b * S + sq) * RH + h) * 2 + (tid & 1)]; } } while (0)
#define SC_WRITE(c) do { float* B_ = buf + ((c) & 1) * SC_BUF; _Pragma("unroll") for (int i = 0; i < 2; ++i) { const int idx = tid + NTHREADS * i, st = idx >> 6, k = idx & 63; \
            float* q_ = B_ + st * 384 + k; q_[0] = pw[i]; q_[64] = -pa[i]; q_[128] = pa[i] * pb[i]; q_[192] = pk[i]; q_[256] = pw[i] * pr[i]; q_[320] = pv[i]; } \
            if (tid < 2 * SC_STEPS) scal[((c) & 1) * SC_STEPS * 2 + tid] = psc; } while (0)
        __syncthreads();
        SC_LOAD(0); SC_WRITE(0);
        __syncthreads();
        const int row = qt * 16 + wave * 2 + rl;
        for (int c = 0; c < S / SC_STEPS; ++c) {
            const bool more = (c + 1) < S / SC_STEPS;
            if (more) SC_LOAD(c + 1);
            const float* B = buf + (c & 1) * SC_BUF; const float* sc = scal + (c & 1) * SC_STEPS * 2; float* ob = outb + (c & 1) * SC_STEPS * 16;
            float outs[SC_STEPS];
            f32x2 w2 = *(const f32x2*)(B + 2 * kq), a2 = *(const f32x2*)(B + 64 + 2 * kq), b2 = *(const f32x2*)(B + 128 + 2 * kq);
            f32x2 k2 = *(const f32x2*)(B + 192 + 2 * kq), wr2 = *(const f32x2*)(B + 256 + 2 * kq);
            float v = B[320 + row]; float br = sc[0], kr = sc[1];
#pragma unroll
            for (int st = 0; st < SC_STEPS; ++st) {
                const int sn = st + 1 < SC_STEPS ? st + 1 : st;
                const float* q = B + sn * 384;
                const f32x2 nw2 = *(const f32x2*)(q + 2 * kq), na2 = *(const f32x2*)(q + 64 + 2 * kq), nb2 = *(const f32x2*)(q + 128 + 2 * kq);
                const f32x2 nk2 = *(const f32x2*)(q + 192 + 2 * kq), nwr2 = *(const f32x2*)(q + 256 + 2 * kq);
                const float nv = q[320 + row], nbr = sc[sn * 2], nkr = sc[sn * 2 + 1];
                SCHED_BAR();
                float sa = s0 * a2.x + s1 * a2.y;
                float po = s0 * wr2.x + s1 * wr2.y;
                sa = row32_sum(sa); po = row32_sum(po);
                outs[st] = po + sa * br + v * kr;
                s0 = s0 * w2.x + (sa * b2.x + v * k2.x); s1 = s1 * w2.y + (sa * b2.y + v * k2.y);
                SCHED_BAR();
                w2 = nw2; a2 = na2; b2 = nb2; k2 = nk2; wr2 = nwr2; v = nv; br = nbr; kr = nkr;
            }
            if (kq == 0) {
#pragma unroll
                for (int st = 0; st < SC_STEPS; ++st) ob[st * 16 + wave * 2 + rl] = outs[st];
            }
            if (more) SC_WRITE(c + 1);
            __syncthreads();
            if (tid < 16 * SC_STEPS) {
                const int st = tid >> 4, r = tid & 15, tau = c * SC_STEPS + st, sq = d ? S - 1 - tau : tau;
                SCAN[doff + (size_t)(b * S + sq) * RW + h * 64 + qt * 16 + r] = ob[st * 16 + r];
            }
        }
#undef SC_LOAD
#undef SC_WRITE
    }
    __syncthreads();
}

constexpr int RST = 72;
constexpr int RARR = 64 * RST;
__device__ __forceinline__ f32x4 tile_nt(const bf16_t* Aa, int ta, const bf16_t* Ba, int tb, f32x4 acc, int col, int g) {
#pragma unroll
    for (int ks = 0; ks < 2; ++ks) {
        const bf16x8 af = *(const bf16x8*)(Aa + (ta * 16 + col) * RST + ks * 32 + 8 * g);
        const bf16x8 bfr = *(const bf16x8*)(Ba + (tb * 16 + col) * RST + ks * 32 + 8 * g);
        acc = MFMA16(af, bfr, acc);
    }
    return acc;
}
__device__ __forceinline__ void phase_rwkv_pre(const Params& P, int l, unsigned char* smem, int wv) {
    ParamsPtr pp = PARAMS_PTR(P); PIN_S(pp); unsigned char* ws = pp->ws; int bidx = (int)blockIdx.x, gdim = (int)gridDim.x; PIN_S(bidx); PIN_S(gdim);
    const u32x4* RK7 = (const u32x4*)(ws + O_RK7);
    const float* LWG = (const float*)(ws + O_LW);
    bf16_t* Qg = (bf16_t*)(ws + O_RQ); bf16_t* Ag = (bf16_t*)(ws + O_RA); bf16_t* Hg = (bf16_t*)(ws + O_RH); bf16_t* Gg = (bf16_t*)(ws + O_RG);
    const int tid0 = phase_tid(wv);
#define RW_STAGE_VARS int tid = tid0; PIN_V(tid); const int lane = tid & 63, wave = tid >> 6, col = lane & 15, g = lane >> 4; (void)lane; (void)wave; (void)col; (void)g;
    bf16_t* At = (bf16_t*)smem; bf16_t* Bt = At + RARR; bf16_t* Kt = Bt + RARR; bf16_t* Rt = Kt + RARR;
    bf16_t* BtT = Rt + RARR; bf16_t* KtT = BtT + RARR; bf16_t* VT = KtT + RARR;
    bf16_t* Lak = VT + RARR; bf16_t* Mrb = Lak + RARR; bf16_t* Mrk = Mrb + RARR; bf16_t* YT = Mrk + RARR; bf16_t* W2T = YT + RARR;
    bf16_t* Lbo = W2T + RARR;
    float* LabT = (float*)(Lbo + RARR);
    float* Xs = LabT + 4096;
    float* Pb = Xs + 4096;
    float* segs = Pb + 2048;
    float* PC = segs + 512;
    float plw[8]; u32x4 prec[8];
#define RW_LOAD(uu) do { const int c_ = (uu) % RNC, h_ = ((uu) / RNC) % RH, b_ = ((uu) / (RNC * RH)) % NB, d_ = (uu) / (RNC * RH * NB); const size_t doff_ = (size_t)d_ * T * RW; \
        const int ch_ = tid0 & 63, sg_ = tid0 >> 6; _Pragma("unroll") for (int j = 0; j < 8; ++j) { const int tau = c_ * RC + sg_ * 8 + j, sq = d_ ? S - 1 - tau : tau; const size_t o = (size_t)(b_ * S + sq) * RW + h_ * 64 + ch_; \
        plw[j] = LWG[doff_ + o]; prec[j] = RK7[o]; } } while (0)
    if (bidx < RUN) RW_LOAD(bidx);
    for (int u = bidx; u < RUN; u += gdim) {
        const int c = u % RNC, h = (u / RNC) % RH, b = (u / (RNC * RH)) % NB, d = u / (RNC * RH * NB);
        (void)c; (void)h; (void)b; (void)d;
        __syncthreads();
        {
            RW_STAGE_VARS
            const int ch = tid & 63, sg = tid >> 6;
            float lw[8]; unsigned kk[8], bq_[8], kd[8], rr[8], vv[8];
#pragma unroll
            for (int j = 0; j < 8; ++j) { lw[j] = plw[j]; kk[j] = prec[j].y & 0xffffu; bq_[j] = d ? (prec[j].z >> 16) : (prec[j].z & 0xffffu); kd[j] = d ? (prec[j].w >> 16) : (prec[j].w & 0xffffu); rr[j] = prec[j].x & 0xffffu; vv[j] = prec[j].x >> 16; }
            if (u + gdim < RUN) RW_LOAD(u + gdim);
            float run = 0.f;
#pragma unroll
            for (int j = 0; j < 8; ++j) { run += lw[j]; lw[j] = run; }
            segs[sg * 64 + ch] = run;
            __syncthreads();
            float off = 0.f;
            for (int q = 0; q < sg; ++q) off += segs[q * 64 + ch];
            u32x4 pbt, pkt, pvt; unsigned tb[8], tk[8], tvv[8];
            float prev = off;
#pragma unroll
            for (int j = 0; j < 8; ++j) {
                const int t = sg * 8 + j; const float cl = off + lw[j];
                const float ep = fexp(prev), en = fexp(-cl), epc = fexp(cl);
                const unsigned a_ = f2bf(-bf_lo(kk[j]) * ep), b_ = f2bf(bf_lo(bq_[j]) * en), k_ = f2bf(bf_lo(kd[j]) * en), r_ = f2bf(bf_lo(rr[j]) * epc), v_ = vv[j];
                At[t * RST + ch] = (bf16_t)a_; Bt[t * RST + ch] = (bf16_t)b_; Kt[t * RST + ch] = (bf16_t)k_; Rt[t * RST + ch] = (bf16_t)r_;
                tb[j] = b_; tk[j] = k_; tvv[j] = v_;
                prev = cl;
            }
            if (sg == 7) PC[ch] = fexp(prev);
            pbt.x = tb[0] | (tb[1] << 16); pbt.y = tb[2] | (tb[3] << 16); pbt.z = tb[4] | (tb[5] << 16); pbt.w = tb[6] | (tb[7] << 16);
            pkt.x = tk[0] | (tk[1] << 16); pkt.y = tk[2] | (tk[3] << 16); pkt.z = tk[4] | (tk[5] << 16); pkt.w = tk[6] | (tk[7] << 16);
            pvt.x = tvv[0] | (tvv[1] << 16); pvt.y = tvv[2] | (tvv[3] << 16); pvt.z = tvv[4] | (tvv[5] << 16); pvt.w = tvv[6] | (tvv[7] << 16);
            *(u32x4*)(BtT + ch * RST + sg * 8) = pbt; *(u32x4*)(KtT + ch * RST + sg * 8) = pkt; *(u32x4*)(VT + ch * RST + sg * 8) = pvt;
            for (int z_ = tid; z_ < 2 * RARR / 8; z_ += NTHREADS) ((u32x4*)YT)[z_] = (u32x4){0u, 0u, 0u, 0u};
        }
        __syncthreads();
        {
            RW_STAGE_VARS
            const int m = wave >> 1;
            const bf16_t* Ym = (m == 0 || m == 2) ? Bt : Kt; const bf16_t* Xm = (m < 2) ? At : Rt;
#pragma unroll 1
            for (int q = 0; q < 8; ++q) {
                const int tix = (wave & 1) * 8 + q, it = tix >> 2, tt = tix & 3;
                f32x4 acc = (f32x4){0.f, 0.f, 0.f, 0.f};
                if (it <= tt) acc = tile_nt(Ym, it, Xm, tt, acc, col, g);
                const int t = tt * 16 + col, i0 = it * 16 + 4 * g;
                float o4[4];
#pragma unroll
                for (int r = 0; r < 4; ++r) { const int i = i0 + r; const bool ok = m < 2 ? (i < t) : (i <= t); o4[r] = ok ? acc[r] : 0.f; }
                if (m == 0) {
#pragma unroll
                    for (int r = 0; r < 4; ++r) LabT[(i0 + r) * 64 + t] = o4[r];
                    const bool offd = it < tt;
                    u32x2 w2; w2.x = offd ? pk2(o4[0], o4[1]) : 0u; w2.y = offd ? pk2(o4[2], o4[3]) : 0u; *(u32x2*)(Lbo + t * RST + i0) = w2;
                }
                else { bf16_t* dst = (m == 1 ? Lak : (m == 2 ? Mrb : Mrk)) + t * RST + i0; u32x2 w2; w2.x = pk2(o4[0], o4[1]); w2.y = pk2(o4[2], o4[3]); *(u32x2*)dst = w2; }
            }
        }
        __syncthreads();
        {
            RW_STAGE_VARS
#pragma unroll
            for (int q = 0; q < 2; ++q) {
                const int tix = wave * 2 + q, tt = tix >> 2, et = tix & 3;
                f32x4 acc = (f32x4){0.f, 0.f, 0.f, 0.f};
                acc = tile_nt(Lak, tt, VT, et, acc, col, g);
#pragma unroll
                for (int r = 0; r < 4; ++r) Xs[(tt * 16 + 4 * g + r) * 64 + et * 16 + col] = acc[r];
            }
        }
        __syncthreads();
        {
            RW_STAGE_VARS
#pragma unroll 1
            for (int bb = 0; bb < 4; ++bb) {
                if (bb > 0) {
                    const bf16_t* Zt = (wave < 4 ? YT : W2T) + ((wave & 3) * 16 + col) * RST + 8 * g;
                    const bf16_t* La = Lbo + (16 * bb + col) * RST + 8 * g;
                    f32x4 acc = (f32x4){0.f, 0.f, 0.f, 0.f};
                    acc = MFMA16(*(const bf16x8*)La, *(const bf16x8*)Zt, acc);
                    if (bb > 2) acc = MFMA16(*(const bf16x8*)(La + 32), *(const bf16x8*)(Zt + 32), acc);
#pragma unroll
                    for (int r = 0; r < 4; ++r) Pb[(4 * g + r) * 128 + wave * 16 + col] = acc[r];
                }
                __syncthreads();
                if (wave < 2) {
                    float acc[16];
                    if (wave == 0) {
#pragma unroll
                        for (int r = 0; r < 16; ++r) acc[r] = bf_lo((unsigned)At[(16 * bb + r) * RST + lane]);
                    } else {
#pragma unroll
                        for (int r = 0; r < 16; ++r) acc[r] = Xs[(16 * bb + r) * 64 + lane];
                    }
                    if (bb > 0) {
#pragma unroll
                        for (int r = 0; r < 16; ++r) acc[r] += Pb[r * 128 + wave * 64 + lane];
                    }
                    const float* dp = LabT + (16 * bb) * 64 + 16 * bb;
#pragma unroll
                    for (int r = 1; r < 16; ++r)
#pragma unroll
                        for (int r2 = 0; r2 < r; ++r2) acc[r] += dp[r2 * 64 + r] * acc[r2];
                    bf16_t* dst = (wave == 0 ? YT : W2T) + lane * RST;
                    u32x4 w0, w1;
                    w0.x = pk2(acc[0], acc[1]); w0.y = pk2(acc[2], acc[3]); w0.z = pk2(acc[4], acc[5]); w0.w = pk2(acc[6], acc[7]);
                    w1.x = pk2(acc[8], acc[9]); w1.y = pk2(acc[10], acc[11]); w1.z = pk2(acc[12], acc[13]); w1.w = pk2(acc[14], acc[15]);
                    *(u32x4*)(dst + 16 * bb) = w0; *(u32x4*)(dst + 16 * bb + 8) = w1;
                }
                __syncthreads();
            }
        }
        __syncthreads();
        {
            RW_STAGE_VARS
            const int ty = wave >> 1;
#pragma unroll 1
            for (int q = 0; q < 8; ++q) {
                const int tix = (wave & 1) * 8 + q, ra = tix >> 2, cb = tix & 3;
                f32x4 acc = (f32x4){0.f, 0.f, 0.f, 0.f};
                if (ty == 0) {
                    acc = tile_nt(YT, ra, Mrb, cb, acc, col, g);
                    const u32x2 rt2 = *(const u32x2*)(Rt + (cb * 16 + col) * RST + ra * 16 + 4 * g);
                    u32x2 qb2; qb2.x = pk2(acc[0] + bf_lo(rt2.x), acc[1] + bf_hi(rt2.x)); qb2.y = pk2(acc[2] + bf_lo(rt2.y), acc[3] + bf_hi(rt2.y));
                    *(u32x2*)(Qg + (size_t)u * 4096 + (tix * 64 + lane) * 4) = qb2;
                } else if (ty == 1) {
                    acc = tile_nt(Mrb, ra, W2T, cb, acc, col, g); acc = tile_nt(Mrk, ra, VT, cb, acc, col, g);
                    { u32x2 hb; hb.x = pk2(acc[0], acc[1]); hb.y = pk2(acc[2], acc[3]); *(u32x2*)(Hg + (size_t)u * 4096 + (tix * 64 + lane) * 4) = hb; }
                } else if (ty == 2) {
                    acc = tile_nt(YT, ra, BtT, cb, acc, col, g);
                    const float pc = PC[cb * 16 + col]; const int k1 = cb * 16 + col;
                    float a4[4];
#pragma unroll
                    for (int r = 0; r < 4; ++r) a4[r] = pc * (acc[r] + ((ra * 16 + 4 * g + r) == k1 ? 1.0f : 0.f));
                    u32x2 ab2; ab2.x = pk2(a4[0], a4[1]); ab2.y = pk2(a4[2], a4[3]);
                    *(u32x2*)(Ag + (size_t)u * 4096 + (tix * 64 + lane) * 4) = ab2;
                } else {
                    acc = tile_nt(BtT, ra, W2T, cb, acc, col, g); acc = tile_nt(KtT, ra, VT, cb, acc, col, g);
#pragma unroll
                    for (int r = 0; r < 4; ++r) acc[r] *= PC[ra * 16 + 4 * g + r];
                    { u32x2 gb2; gb2.x = pk2(acc[0], acc[1]); gb2.y = pk2(acc[2], acc[3]); *(u32x2*)(Gg + (size_t)u * 4096 + (tix * 64 + lane) * 4) = gb2; }
                }
            }
        }
    }
    __syncthreads();
#undef RW_STAGE_VARS
#undef RW_LOAD
}
__device__ __forceinline__ void phase_rwkv_seq(const Params& P, int l, unsigned char* smem, int wv) {
    ParamsPtr pp = PARAMS_PTR(P); PIN_S(pp); unsigned char* ws = pp->ws; int bidx = (int)blockIdx.x, gdim = (int)gridDim.x; PIN_S(bidx); PIN_S(gdim);
    const bf16_t* Ag = (const bf16_t*)(ws + O_RA); const bf16_t* Gg = (const bf16_t*)(ws + O_RG); bf16_t* Sg = (bf16_t*)(ws + O_RS);
    const int tid = phase_tid(wv), lane = tid & 63, wave = tid >> 6, col = lane & 15, g = lane >> 4;
    const int gw = wave * gdim + bidx, ngw = NWAVES * gdim;
    for (int un = gw; un < 2 * NB * RH * 2; un += ngw) {
        const int ch = un >> 1, eh = un & 1;
        f32x4 acc[4][2];
#pragma unroll
        for (int a_ = 0; a_ < 4; ++a_)
#pragma unroll
            for (int b_ = 0; b_ < 2; ++b_) acc[a_][b_] = (f32x4){0.f, 0.f, 0.f, 0.f};
        u32x2 alo[4][2], ahi[4][2]; u32x2 gq[4][2];
        const unsigned aoff = (unsigned)(col * 64 + 4 * g), goff = (unsigned)(lane * 4);
#define RS_LOAD(cc) do { const bf16_t* ab_ = Ag + (size_t)(ch * RNC + (cc)) * 4096; const bf16_t* gb_ = Gg + (size_t)(ch * RNC + (cc)) * 4096 + eh * 512; \
            _Pragma("unroll") for (int ra = 0; ra < 4; ++ra) _Pragma("unroll") for (int p = 0; p < 2; ++p) { alo[ra][p] = *(const u32x2*)(ab_ + ((2 * p * 4 + ra) * 256) + goff); ahi[ra][p] = *(const u32x2*)(ab_ + (((2 * p + 1) * 4 + ra) * 256) + goff); } \
            _Pragma("unroll") for (int ra = 0; ra < 4; ++ra) _Pragma("unroll") for (int cb = 0; cb < 2; ++cb) gq[ra][cb] = *(const u32x2*)(gb_ + ((ra * 4 + cb) * 256) + goff); } while (0)
        RS_LOAD(0);
#pragma unroll 1
        for (int c = 0; c < RNC; ++c) {
            bf16_t* sb_ = Sg + (size_t)(ch * RNC + c) * 4096 + eh * 2048;
            bf16x8 bq[2][2];
#pragma unroll
            for (int cb = 0; cb < 2; ++cb) {
#pragma unroll
                for (int ra = 0; ra < 4; ++ra) {
                    u32x2 w2; w2.x = pk2(acc[ra][cb][0], acc[ra][cb][1]); w2.y = pk2(acc[ra][cb][2], acc[ra][cb][3]);
                    *(u32x2*)(sb_ + (cb * 1024 + ra * 16) + aoff) = w2;
                }
#pragma unroll
                for (int p = 0; p < 2; ++p) bq[p][cb] = cvt8(acc[2 * p][cb], acc[2 * p + 1][cb]);
            }
            u32x4 af[4][2];
#pragma unroll
            for (int ra = 0; ra < 4; ++ra) {
#pragma unroll
                for (int p = 0; p < 2; ++p) af[ra][p] = (u32x4){alo[ra][p].x, alo[ra][p].y, ahi[ra][p].x, ahi[ra][p].y};
#pragma unroll
                for (int cb = 0; cb < 2; ++cb) acc[ra][cb] = (f32x4){bf_lo(gq[ra][cb].x), bf_hi(gq[ra][cb].x), bf_lo(gq[ra][cb].y), bf_hi(gq[ra][cb].y)};
            }
            if (c + 1 < RNC) RS_LOAD(c + 1);
#pragma unroll
            for (int ra = 0; ra < 4; ++ra)
#pragma unroll
                for (int cb = 0; cb < 2; ++cb)
#pragma unroll
                    for (int p = 0; p < 2; ++p) acc[ra][cb] = MFMA16(__builtin_bit_cast(bf16x8, af[ra][p]), bq[p][cb], acc[ra][cb]);
        }
#undef RS_LOAD
    }
}
__device__ __forceinline__ void phase_rwkv_out(const Params& P, int l, unsigned char* smem, int wv) {
    ParamsPtr pp = PARAMS_PTR(P); PIN_S(pp); unsigned char* ws = pp->ws; int bidx = (int)blockIdx.x, gdim = (int)gridDim.x; PIN_S(bidx); PIN_S(gdim);
    const bf16_t* Qg = (const bf16_t*)(ws + O_RQ); const bf16_t* Sg = (const bf16_t*)(ws + O_RS); const bf16_t* Hg = (const bf16_t*)(ws + O_RH);
    const bf16_t* VB = (const bf16_t*)(ws + O_VB); const float* GATE = (const float*)(ws + O_GATE); const float* BONUS = (const float*)(ws + O_BONUS);
    bf16_t* GRP = (bf16_t*)(ws + O_GRP);
    const float* rln_g = pp->in[15] + (size_t)l * RW; const float* rln_b = pp->in[16] + (size_t)l * RW;
    const int tid = phase_tid(wv), lane = tid & 63, wave = tid >> 6, col = lane & 15, g = lane >> 4;
    for (int pu = bidx * NWAVES + wave; pu < NB * RH * RNC; pu += gdim * NWAVES) {
        const int c = pu % RNC, h = (pu / RNC) % RH, b = pu / (RNC * RH);
        f32x4 o[2][4][4];
#pragma unroll
        for (int d = 0; d < 2; ++d) {
            const int u = ((d * NB + b) * RH + h) * RNC + (d ? RNC - 1 - c : c);
            const size_t ub = (size_t)u * 4096;
            bf16x8 qa[4][2], sb[4][2];
#pragma unroll
            for (int q = 0; q < 4; ++q)
#pragma unroll
                for (int ks = 0; ks < 2; ++ks) {
                    const u32x2 q0 = *(const u32x2*)(Qg + ub + ((2 * ks * 4 + q) * 64 + lane) * 4), q1 = *(const u32x2*)(Qg + ub + (((2 * ks + 1) * 4 + q) * 64 + lane) * 4);
                    qa[q][ks] = __builtin_bit_cast(bf16x8, (u32x4){q0.x, q0.y, q1.x, q1.y});
                    const bf16_t* sp_ = Sg + ub + (q * 16 + col) * 64 + ks * 32 + 4 * g;
                    const u32x2 s0_ = *(const u32x2*)sp_, s1_ = *(const u32x2*)(sp_ + 16);
                    sb[q][ks] = __builtin_bit_cast(bf16x8, (u32x4){s0_.x, s0_.y, s1_.x, s1_.y});
                }
#pragma unroll
            for (int tt = 0; tt < 4; ++tt)
#pragma unroll
                for (int et = 0; et < 4; ++et) {
                    const u32x2 hb = *(const u32x2*)(Hg + ub + ((tt * 4 + et) * 64 + lane) * 4);
                    f32x4 acc = (f32x4){bf_lo(hb.x), bf_hi(hb.x), bf_lo(hb.y), bf_hi(hb.y)};
#pragma unroll
                    for (int ks = 0; ks < 2; ++ks) acc = MFMA16(qa[tt][ks], sb[et][ks], acc);
                    o[d][tt][et] = acc;
                }
        }
        const int src = (3 - g) * 16 + col;
#pragma unroll
        for (int tt = 0; tt < 4; ++tt)
#pragma unroll
            for (int et = 0; et < 4; ++et)
#pragma unroll
                for (int r = 0; r < 4; ++r) o[0][tt][et][r] += SHL(o[1][3 - tt][et][3 - r], src);
        float* tile = (float*)smem + wave * (64 * 68);
        WAVE_SYNC();
#pragma unroll
        for (int tt = 0; tt < 4; ++tt)
#pragma unroll
            for (int et = 0; et < 4; ++et)
#pragma unroll
                for (int r = 0; r < 4; ++r) tile[(tt * 16 + 4 * g + r) * 68 + et * 16 + col] = o[0][tt][et][r];
        WAVE_SYNC();
        {
            const int c4 = (lane & 15) * 4, ch = h * 64 + c4;
            const f32x4 lg = *(const f32x4*)(rln_g + ch), lb = *(const f32x4*)(rln_b + ch);
#pragma unroll 1
            for (int qb = 0; qb < 2; ++qb) {
                f32x4 gt_[8]; u32x2 vb_[8]; float bo_[8];
#pragma unroll
                for (int q8 = 0; q8 < 8; ++q8) {
                    const size_t t = (size_t)(b * S + c * RC + (qb * 8 + q8) * 4 + (lane >> 4));
                    gt_[q8] = *(const f32x4*)(GATE + t * RW + ch); vb_[q8] = *(const u32x2*)(VB + t * RW + ch); bo_[q8] = BONUS[t * RH + h];
                }
#pragma unroll
                for (int q8 = 0; q8 < 8; ++q8) {
                    const int tl = (qb * 8 + q8) * 4 + (lane >> 4);
                    const size_t t = (size_t)(b * S + c * RC + tl);
                    const f32x4 x = *(const f32x4*)(tile + tl * 68 + c4);
                    const float mean = row16_sum((x.x + x.y) + (x.z + x.w)) * (1.0f / 64.0f);
                    const f32x4 dl = x - mean;
                    const float var = row16_sum((dl.x * dl.x + dl.y * dl.y) + (dl.z * dl.z + dl.w * dl.w)) * (1.0f / 64.0f);
                    const float rstd = 1.0f / sqrtf(var + GN_EPS);
                    f32x4 y = dl * rstd * lg + lb;
                    y.x += bo_[q8] * bf_lo(vb_[q8].x); y.y += bo_[q8] * bf_hi(vb_[q8].x); y.z += bo_[q8] * bf_lo(vb_[q8].y); y.w += bo_[q8] * bf_hi(vb_[q8].y);
                    y = y * gt_[q8];
                    u32x2 ob; ob.x = pk2(y.x, y.y); ob.y = pk2(y.z, y.w);
                    *(u32x2*)(GRP + t * D + GW + ch) = ob;
                }
            }
        }
    }
    __syncthreads();
}

__device__ __forceinline__ void phase_mlstm_local(const Params& P, int l, unsigned char* smem, int wv, int bid, int nb) {
    PIN_S(bid); PIN_S(nb);
    ParamsPtr pp = PARAMS_PTR(P); PIN_S(pp); unsigned char* ws = pp->ws;
    const bf16_t* KT = (const bf16_t*)(ws + O_KT); const bf16_t* VT = (const bf16_t*)(ws + O_VT);
    const float* IG = (const float*)(ws + O_IG); const float* LF = (const float*)(ws + O_LF);
    float* CL = (float*)(ws + O_CL); float* NLb = (float*)(ws + O_NL); float* ML = (float*)(ws + O_ML); float* BL = (float*)(ws + O_BL);
    float* GVT = (float*)(ws + O_GVT); float* PMX = (float*)(ws + O_PMX); float* BCT = (float*)(ws + O_BCT);
    const int tid = phase_tid(wv), lane = tid & 63, wave = tid >> 6, col = lane & 15, g = lane >> 4;
    float* wts = (float*)smem + wave * 128;
    for (int u = bid * NWAVES + wave; u < 2 * NB * MH * NCH; u += nb * NWAVES) {
        const int c = u % NCH, h = (u / NCH) % MH, p = u / (NCH * MH), d = p / NB, b = p % NB;
        const int tc = d ? NCH - 1 - c : c, tok0 = b * S + tc * CH;
        const int i0 = d ? 127 - 2 * lane : 2 * lane, i1 = d ? i0 - 1 : i0 + 1;
        const size_t g0 = ((size_t)d * T + tok0 + i0) * MH + h, g1 = ((size_t)d * T + tok0 + i1) * MH + h;
        const float lf0 = LF[g0], lf1 = LF[g1], ig0 = IG[g0], ig1 = IG[g1];
        const float c1 = lf0 + lf1;
        float incl = c1;
#pragma unroll
        for (int o = 1; o < 64; o <<= 1) { const float tq = SHUP(incl, o, lane); if (lane >= o) incl += tq; }
        const float excl = incl - c1, bc0 = excl + lf0, bc1 = incl;
        const float blast = RDL(incl, 63);
        const float gv0 = ig0 - bc0, gv1 = ig1 - bc1, pl1 = fmaxf(gv0, gv1);
        float mincl = pl1;
#pragma unroll
        for (int o = 1; o < 64; o <<= 1) { const float tq = SHUP(mincl, o, lane); if (lane >= o) mincl = fmaxf(mincl, tq); }
        float mexcl = SHUP(mincl, 1, lane); if (lane == 0) mexcl = -INFINITY;
        const float pm0 = fmaxf(mexcl, gv0), pm1 = mincl;
        const float mloc = blast + RDL(mincl, 63);
        WAVE_SYNC();
        wts[i0] = fexp(blast + gv0 - mloc); wts[i1] = fexp(blast + gv1 - mloc);
        GVT[g0] = gv0; GVT[g1] = gv1; PMX[g0] = pm0; PMX[g1] = pm1; BCT[g0] = bc0; BCT[g1] = bc1;
        if (lane == 0) { ML[u] = mloc; BL[u] = blast; }
        WAVE_SYNC();
        const bf16_t* vbase = VT + ((size_t)(b * MH + h) * 64) * S + (size_t)tc * CH;
        const bf16_t* kbase = KT + ((size_t)(b * MH + h) * 64) * S + (size_t)tc * CH;
        const unsigned loff = (unsigned)(col * S + 8 * g);
        f32x4 acc[4][4];
#pragma unroll
        for (int a_ = 0; a_ < 4; ++a_)
#pragma unroll
            for (int b_ = 0; b_ < 4; ++b_) acc[a_][b_] = (f32x4){0.f, 0.f, 0.f, 0.f};
        float nsum[4] = {0.f, 0.f, 0.f, 0.f};
#pragma unroll 1
        for (int ks = 0; ks < 4; ++ks) {
            const int ii = ks * 32 + 8 * g;
            const f32x4 w0 = *(const f32x4*)(wts + ii), w1 = *(const f32x4*)(wts + ii + 4);
            bf16x8 af[4], bfk[4];
#pragma unroll
            for (int q = 0; q < 4; ++q) af[q] = *(const bf16x8*)(vbase + ((size_t)q * 16 * S + ks * 32) + loff);
#pragma unroll
            for (int q = 0; q < 4; ++q) {
                const u32x4 kr = *(const u32x4*)(kbase + ((size_t)q * 16 * S + ks * 32) + loff);
                f32x4 k0, k1;
                k0.x = bf_lo(kr.x) * w0.x; k0.y = bf_hi(kr.x) * w0.y; k0.z = bf_lo(kr.y) * w0.z; k0.w = bf_hi(kr.y) * w0.w;
                k1.x = bf_lo(kr.z) * w1.x; k1.y = bf_hi(kr.z) * w1.y; k1.z = bf_lo(kr.w) * w1.z; k1.w = bf_hi(kr.w) * w1.w;
                nsum[q] += (k0.x + k0.y) + (k0.z + k0.w) + (k1.x + k1.y) + (k1.z + k1.w);
                bfk[q] = cvt8(k0, k1);
            }
#pragma unroll
            for (int a_ = 0; a_ < 4; ++a_)
#pragma unroll
                for (int b_ = 0; b_ < 4; ++b_) acc[a_][b_] = MFMA16(af[a_], bfk[b_], acc[a_][b_]);
        }
        float* cbase = CL + (size_t)u * 4096;
        const unsigned coff = (unsigned)(4 * g * 64 + col);
#pragma unroll
        for (int b_ = 0; b_ < 4; ++b_) {
#pragma unroll
            for (int a_ = 0; a_ < 4; ++a_)
#pragma unroll
                for (int r = 0; r < 4; ++r) cbase[(a_ * 16 * 64 + r * 64 + b_ * 16) + coff] = acc[a_][b_][r];
            float ns = nsum[b_]; ns += SHX(ns, 16, lane); ns += SHX(ns, 32, lane);
            if (g == 0) NLb[(size_t)u * 64 + b_ * 16 + col] = ns;
        }
    }
    __syncthreads();
}

__device__ __forceinline__ void phase_mlstm_carry(const Params& P, int l, unsigned char* smem, int wv) {
    ParamsPtr pp = PARAMS_PTR(P); PIN_S(pp); unsigned char* ws = pp->ws; int bidx = (int)blockIdx.x, gdim = (int)gridDim.x; PIN_S(bidx); PIN_S(gdim);
    float* CL = (float*)(ws + O_CL); float* NLb = (float*)(ws + O_NL); const float* ML = (const float*)(ws + O_ML); const float* BL = (const float*)(ws + O_BL);
    float* MIN = (float*)(ws + O_MIN);
    const int total = 2 * NB * MH * 4160;
    const int tid = phase_tid(wv);
    for (int gi = bidx * NTHREADS + tid; gi < total; gi += gdim * NTHREADS) {
        const int ph = gi / 4160, e = gi % 4160;
        float* base_ = e < 4096 ? CL + (size_t)ph * NCH * 4096 + e : NLb + (size_t)ph * NCH * 64 + (e - 4096);
        const int stride = e < 4096 ? 4096 : 64;
        static_assert(NCH <= 32, "carry scan keeps one chunk value per register");
        float loc[NCH], bl[NCH], ml[NCH];
#pragma unroll
        for (int c = 0; c < NCH; ++c) { loc[c] = base_[(size_t)c * stride]; bl[c] = BL[ph * NCH + c]; ml[c] = ML[ph * NCH + c]; }
        float m = 0.f, val = 0.f;
#pragma unroll
        for (int c = 0; c < NCH; ++c) {
            base_[(size_t)c * stride] = val;
            if (e == 0) MIN[ph * NCH + c] = m;
            const float mn = fmaxf(bl[c] + m, ml[c]);
            val = fexp(bl[c] + m - mn) * val + fexp(ml[c] - mn) * loc[c];
            m = mn;
        }
    }
}

__device__ __forceinline__ void phase_mlstm_out(const Params& P, int l, unsigned char* smem, int wv) {
    ParamsPtr pp = PARAMS_PTR(P); PIN_S(pp); unsigned char* ws = pp->ws; int bidx = (int)blockIdx.x, gdim = (int)gridDim.x; PIN_S(bidx); PIN_S(gdim);
    const bf16_t* proj = (const bf16_t*)(ws + O_PROJ);
    const bf16_t* MQB = (const bf16_t*)(ws + O_MQB); const bf16_t* MKB = (const bf16_t*)(ws + O_MKB); const bf16_t* VT = (const bf16_t*)(ws + O_VT);
    const float* GVT = (const float*)(ws + O_GVT); const float* PMX = (const float*)(ws + O_PMX); const float* BCT = (const float*)(ws + O_BCT);
    const float* CL = (const float*)(ws + O_CL); const float* NLb = (const float*)(ws + O_NL); const float* MIN = (const float*)(ws + O_MIN);
    bf16_t* GRP = (bf16_t*)(ws + O_GRP);
    const float* mln_g = pp->in[20] + (size_t)l * MW;
    const int tid = phase_tid(wv), lane = tid & 63, wave = tid >> 6, col = lane & 15, g = lane >> 4;
    constexpr int KP = 72, VP = 136;
    bf16_t* Ks = (bf16_t*)smem;
    bf16_t* Vs = Ks + 128 * KP;
    float* gvs_ = (float*)(Vs + 64 * VP);
    for (int u = bidx; u < NB * MH * NCH; u += gdim) {
        const int tc = u % NCH, h = (u / NCH) % MH, b = u / (NCH * MH);
        const int tok0 = b * S + tc * CH, it = wave * 16 + col;
        __syncthreads();
        {
            u32x4 kb_[2], vb_[2];
#pragma unroll
            for (int q = 0; q < 2; ++q) {
                const int idx = tid + q * NTHREADS;
                kb_[q] = *(const u32x4*)(MKB + (size_t)(tok0 + (idx >> 3)) * MW + h * 64 + (idx & 7) * 8);
                vb_[q] = *(const u32x4*)(VT + ((size_t)(b * MH + h) * 64 + (idx >> 4)) * S + (size_t)tc * CH + (idx & 15) * 8);
            }
            float gq_ = 0.f;
            if (tid < 256) gq_ = GVT[((size_t)(tid >> 7) * T + tok0 + (tid & 127)) * MH + h];
#pragma unroll
            for (int q = 0; q < 2; ++q) {
                const int idx = tid + q * NTHREADS;
                *(u32x4*)(Ks + (idx >> 3) * KP + (idx & 7) * 8) = kb_[q];
                *(u32x4*)(Vs + (idx >> 4) * VP + (idx & 15) * 8) = vb_[q];
            }
            if (tid < 256) gvs_[tid] = gq_;
        }
        __syncthreads();
        const size_t trow = (size_t)(tok0 + it);
        bf16x8 bq[2];
#pragma unroll
        for (int ks = 0; ks < 2; ++ks) bq[ks] = *(const bf16x8*)(MQB + trow * MW + h * 64 + ks * 32 + 8 * g);
        f32x4 hs[4];
#pragma unroll
        for (int et = 0; et < 4; ++et) hs[et] = (f32x4){0.f, 0.f, 0.f, 0.f};
#pragma unroll
        for (int d = 0; d < 2; ++d) {
            const int cd = d ? NCH - 1 - tc : tc;
            const int su = ((d * NB + b) * MH + h) * NCH + cd;
            const size_t gt = ((size_t)d * T + trow) * MH + h;
            const float mst = MIN[su];
            const float mxt = fmaxf(PMX[gt], mst), mt = BCT[gt] + mxt, wint = fexp(mst - mxt);
            f32x4 num[4];
#pragma unroll
            for (int et = 0; et < 4; ++et) num[et] = (f32x4){0.f, 0.f, 0.f, 0.f};
            float den = 0.f;
            for (int sp = 0; sp < 4; ++sp) {
                if (d == 0 ? (2 * sp > wave) : (2 * sp + 1 < wave)) continue;
                float pw[8];
#pragma unroll
                for (int hf = 0; hf < 2; ++hf) {
                    const int st = 2 * sp + hf;
                    f32x4 sacc = (f32x4){0.f, 0.f, 0.f, 0.f};
#pragma unroll
                    for (int ks = 0; ks < 2; ++ks) sacc = MFMA16(*(const bf16x8*)(Ks + (st * 16 + col) * KP + ks * 32 + 8 * g), bq[ks], sacc);
                    const f32x4 g4 = *(const f32x4*)(gvs_ + d * 128 + st * 16 + 4 * g);
#pragma unroll
                    for (int r = 0; r < 4; ++r) {
                        const int is = st * 16 + 4 * g + r;
                        const bool ok = d == 0 ? (is <= it) : (is >= it);
                        const float pr = ok ? sacc[r] * fexp(g4[r] - mxt) : 0.f;
                        den += pr; pw[hf * 4 + r] = pr;
                    }
                }
                u32x4 pb; pb.x = pk2(pw[0], pw[1]); pb.y = pk2(pw[2], pw[3]); pb.z = pk2(pw[4], pw[5]); pb.w = pk2(pw[6], pw[7]);
                const bf16x8 bp = __builtin_bit_cast(bf16x8, pb);
#pragma unroll
                for (int et = 0; et < 4; ++et) {
                    const bf16_t* vp = Vs + (et * 16 + col) * VP + sp * 32 + 4 * g;
                    const u32x2 v0 = *(const u32x2*)vp, v1 = *(const u32x2*)(vp + 16);
                    u32x4 va; va.x = v0.x; va.y = v0.y; va.z = v1.x; va.w = v1.y;
                    num[et] = MFMA16(__builtin_bit_cast(bf16x8, va), bp, num[et]);
                }
            }
            den += SHX(den, 16, lane); den += SHX(den, 32, lane);
            f32x4 qc[4]; float qn = 0.f;
#pragma unroll
            for (int ks = 0; ks < 2; ++ks) {
                const float* np = NLb + (size_t)su * 64 + ks * 32 + 8 * g;
                const f32x4 n0 = *(const f32x4*)np, n1 = *(const f32x4*)(np + 4);
                const u32x4 qb = __builtin_bit_cast(u32x4, bq[ks]);
                qn += (bf_lo(qb.x) * n0.x + bf_hi(qb.x) * n0.y) + (bf_lo(qb.y) * n0.z + bf_hi(qb.y) * n0.w) + (bf_lo(qb.z) * n1.x + bf_hi(qb.z) * n1.y) + (bf_lo(qb.w) * n1.z + bf_hi(qb.w) * n1.w);
            }
            qn += SHX(qn, 16, lane); qn += SHX(qn, 32, lane);
#pragma unroll
            for (int et = 0; et < 4; ++et) {
                qc[et] = (f32x4){0.f, 0.f, 0.f, 0.f};
#pragma unroll
                for (int ks = 0; ks < 2; ++ks) {
                    const float* cp = CL + (size_t)su * 4096 + (size_t)(et * 16 + col) * 64 + ks * 32 + 8 * g;
                    qc[et] = MFMA16(cvt8(*(const f32x4*)cp, *(const f32x4*)(cp + 4)), bq[ks], qc[et]);
                }
            }
            const float dd = frcp(fmaxf(fabsf(den + wint * qn), fexp(-mt)));
#pragma unroll
            for (int et = 0; et < 4; ++et) hs[et] += (num[et] + wint * qc[et]) * dd;
        }
        float sm = 0.f;
#pragma unroll
        for (int et = 0; et < 4; ++et) sm += (hs[et].x + hs[et].y) + (hs[et].z + hs[et].w);
        sm += SHX(sm, 16, lane); sm += SHX(sm, 32, lane);
        const float mean = sm * (1.0f / 64.0f); float q = 0.f;
#pragma unroll
        for (int et = 0; et < 4; ++et) { const f32x4 dl = hs[et] - mean; q += (dl.x * dl.x + dl.y * dl.y) + (dl.z * dl.z + dl.w * dl.w); }
        q += SHX(q, 16, lane); q += SHX(q, 32, lane);
        const float rstd = 1.0f / sqrtf(q * (1.0f / 64.0f) + LN_EPS);
#pragma unroll
        for (int et = 0; et < 4; ++et) {
            const int c = h * 64 + et * 16 + 4 * g;
            const u32x2 ob_ = *(const u32x2*)(proj + trow * PLD + C_MW + 3 * MW + c); const f32x4 o4 = (f32x4){bf_lo(ob_.x), bf_hi(ob_.x), bf_lo(ob_.y), bf_hi(ob_.y)}, g4 = *(const f32x4*)(mln_g + c);
            const f32x4 y = (hs[et] - mean) * rstd * g4;
            u32x2 ob; ob.x = pk2(sigmoidf_(o4.x) * y.x, sigmoidf_(o4.y) * y.y); ob.y = pk2(sigmoidf_(o4.z) * y.z, sigmoidf_(o4.w) * y.w);
            *(u32x2*)(GRP + trow * D + GW + RW + c) = ob;
        }
    }
    __syncthreads();
}

__device__ __forceinline__ void phase_rwkv_post(const Params& P, int l, unsigned char* smem, int wv) {
    ParamsPtr pp = PARAMS_PTR(P); PIN_S(pp); unsigned char* ws = pp->ws; int bidx = (int)blockIdx.x, gdim = (int)gridDim.x; PIN_S(bidx); PIN_S(gdim);
    const float* SCAN = (const float*)(ws + O_SCAN); const float* VV = (const float*)(ws + O_VV); const float* GATE = (const float*)(ws + O_GATE);
    const float* BONUS = (const float*)(ws + O_BONUS); bf16_t* GRP = (bf16_t*)(ws + O_GRP);
    const float* rln_g = pp->in[15] + (size_t)l * RW; const float* rln_b = pp->in[16] + (size_t)l * RW;
    const int tid = phase_tid(wv), lane = tid & 63, wave = tid >> 6;
    const int gw = bidx * NWAVES + wave, ngw = NWAVES * gdim;
    for (int it = gw; it < T * RH; it += ngw) {
        const int t = it / RH, h = it % RH, c = h * 64 + lane;
        const size_t o = (size_t)t * RW + c;
        const float x = SCAN[o] + SCAN[(size_t)T * RW + o];
        const float mean = wave_sum(x, lane) * (1.0f / 64.0f);
        const float dl = x - mean;
        const float var = wave_sum(dl * dl, lane) * (1.0f / 64.0f);
        float y = dl / sqrtf(var + GN_EPS) * rln_g[c] + rln_b[c];
        y += BONUS[(size_t)t * RH + h] * VV[o];
        GRP[(size_t)t * D + GW + c] = (bf16_t)f2bf(y * GATE[o]);
    }
}

__device__ __forceinline__ void phase_ln1_router(const Params& P, int l, unsigned char* smem, int wv) {
    ParamsPtr pp = PARAMS_PTR(P); PIN_S(pp); unsigned char* ws = pp->ws; int bidx = (int)blockIdx.x, gdim = (int)gridDim.x; PIN_S(bidx); PIN_S(gdim);
    const float* xin = l == 0 ? pp->in[0] : (const float*)(ws + O_XA);
    const bf16_t* MIX = (const bf16_t*)(ws + O_MIX); float* X1 = (float*)(ws + O_X1);
    int* TOPI = (int*)(ws + O_TOPI); float* TOPG = (float*)(ws + O_TOPG); int* RANK = (int*)(ws + O_RANK); bf16_t* X1B = (bf16_t*)(ws + O_X1B);
    int* BCNT = (int*)(ws + O_BCNT);
    const float* g1 = pp->in[22] + (size_t)l * D; const float* b1 = pp->in[23] + (size_t)l * D;
    const float* rw = pp->in[24] + (size_t)l * D * NE; const float* rb = pp->in[25] + (size_t)l * NE;
    const bf16_t* RWT = (const bf16_t*)(ws + O_RWT) + (size_t)l * 2 * NE * D;
    const int tid = phase_tid(wv), lane = tid & 63, wave = tid >> 6, col = lane & 15, g = lane >> 4;
    float* lgs = (float*)smem;
    int* stopi = (int*)(smem + 8192);
    for (int tile = bidx; tile < T / 64; tile += gdim) {
        __syncthreads();
        {
            f32x4 xa[4]; u32x2 xm[4];
#define LN1_LOAD(tt_) do { _Pragma("unroll") for (int j = 0; j < 4; ++j) { const int c = j * 256 + lane * 4; xa[j] = *(const f32x4*)(xin + (size_t)(tt_) * D + c); xm[j] = *(const u32x2*)(MIX + (size_t)(tt_) * D + c); } } while (0)
            LN1_LOAD(tile * 64 + wave * 8);
#pragma unroll 1
            for (int ti8 = 0; ti8 < 8; ++ti8) {
                const int t = tile * 64 + wave * 8 + ti8;
                float v[16]; float sm = 0.f;
#pragma unroll
                for (int j = 0; j < 4; ++j) {
                    v[j * 4 + 0] = ALPHA * xa[j].x + bf_lo(xm[j].x); v[j * 4 + 1] = ALPHA * xa[j].y + bf_hi(xm[j].x); v[j * 4 + 2] = ALPHA * xa[j].z + bf_lo(xm[j].y); v[j * 4 + 3] = ALPHA * xa[j].w + bf_hi(xm[j].y);
                    sm += (v[j * 4] + v[j * 4 + 1]) + (v[j * 4 + 2] + v[j * 4 + 3]);
                }
                if (ti8 < 7) LN1_LOAD(t + 1);
                const float mean = wave_sum_fast(sm, lane) * (1.0f / D); float q = 0.f;
#pragma unroll
                for (int j = 0; j < 16; ++j) { const float dl = v[j] - mean; q += dl * dl; }
                const float rstd = 1.0f / sqrtf(wave_sum_fast(q, lane) * (1.0f / D) + LN_EPS);
#pragma unroll
                for (int j = 0; j < 4; ++j) {
                    const int c = j * 256 + lane * 4;
                    const f32x4 gg = *(const f32x4*)(g1 + c), bb = *(const f32x4*)(b1 + c);
                    f32x4 o;
                    o.x = (v[j * 4 + 0] - mean) * rstd * gg.x + bb.x; o.y = (v[j * 4 + 1] - mean) * rstd * gg.y + bb.y;
                    o.z = (v[j * 4 + 2] - mean) * rstd * gg.z + bb.z; o.w = (v[j * 4 + 3] - mean) * rstd * gg.w + bb.w;
                    *(f32x4*)(X1 + (size_t)t * D + c) = o;
                    u32x2 ob; ob.x = pk2(o.x, o.y); ob.y = pk2(o.z, o.w); *(u32x2*)(X1B + (size_t)t * D + c) = ob;
                }
            }
#undef LN1_LOAD
        }
        __syncthreads();
        {
            const float* xr = X1 + (size_t)(tile * 64 + (wave >> 1) * 16 + col) * D + 8 * g;
            const bf16_t* wh = RWT + (size_t)((wave & 1) * 16 + col) * D + 8 * g; const bf16_t* wl = wh + (size_t)NE * D;
            f32x4 acc = (f32x4){0.f, 0.f, 0.f, 0.f};
#pragma unroll 4
            for (int ks = 0; ks < 32; ++ks) {
                const f32x4 x0 = *(const f32x4*)(xr + ks * 32), x1 = *(const f32x4*)(xr + ks * 32 + 4);
                const bf16x8 bh = *(const bf16x8*)(wh + ks * 32), bl = *(const bf16x8*)(wl + ks * 32);
                const bf16x8 ah = cvt8(x0, x1);
                const u32x4 ahu = __builtin_bit_cast(u32x4, ah);
                f32x4 r0, r1;
                r0.x = x0.x - bf_lo(ahu.x); r0.y = x0.y - bf_hi(ahu.x); r0.z = x0.z - bf_lo(ahu.y); r0.w = x0.w - bf_hi(ahu.y);
                r1.x = x1.x - bf_lo(ahu.z); r1.y = x1.y - bf_hi(ahu.z); r1.z = x1.z - bf_lo(ahu.w); r1.w = x1.w - bf_hi(ahu.w);
                const bf16x8 al = cvt8(r0, r1);
                acc = MFMA16(ah, bh, acc); acc = MFMA16(ah, bl, acc); acc = MFMA16(al, bh, acc);
            }
            const float rbv = rb[(wave & 1) * 16 + col];
#pragma unroll
            for (int r = 0; r < 4; ++r) lgs[((wave >> 1) * 16 + 4 * g + r) * NE + (wave & 1) * 16 + col] = acc[r] + rbv;
        }
        __syncthreads();
        if (tid < 64) {
            const float* lp = lgs + tid * NE; const int t = tile * 64 + tid;
            float tv[4]; int ti[4];
#pragma unroll
            for (int k = 0; k < 4; ++k) { tv[k] = -INFINITY; ti[k] = 0; }
            for (int e = 0; e < NE; ++e) {
                const float x = lp[e];
                if (x > tv[3]) {
                    if (x > tv[0]) { tv[3] = tv[2]; ti[3] = ti[2]; tv[2] = tv[1]; ti[2] = ti[1]; tv[1] = tv[0]; ti[1] = ti[0]; tv[0] = x; ti[0] = e; }
                    else if (x > tv[1]) { tv[3] = tv[2]; ti[3] = ti[2]; tv[2] = tv[1]; ti[2] = ti[1]; tv[1] = x; ti[1] = e; }
                    else if (x > tv[2]) { tv[3] = tv[2]; ti[3] = ti[2]; tv[2] = x; ti[2] = e; }
                    else { tv[3] = x; ti[3] = e; }
                }
            }
            const float e1 = expf(tv[1] - tv[0]), e2 = expf(tv[2] - tv[0]), e3 = expf(tv[3] - tv[0]);
            const float inv = 1.0f / (1.0f + e1 + e2 + e3);
            *(f32x4*)(TOPG + (size_t)t * 4) = (f32x4){inv, e1 * inv, e2 * inv, e3 * inv};
#pragma unroll
            for (int k = 0; k < 4; ++k) { TOPI[(size_t)t * 4 + k] = ti[k]; stopi[tid * 4 + k] = ti[k]; }
        }
        __syncthreads();
        if (tid < 256) { const int e = stopi[tid]; int r = 0; for (int a2 = 0; a2 < tid; ++a2) r += (stopi[a2] == e) ? 1 : 0; RANK[(size_t)tile * 256 + tid] = r; }
        else if (tid < 256 + NE) { const int e = tid - 256; int cnt = 0; for (int a2 = 0; a2 < 256; ++a2) cnt += (stopi[a2] == e) ? 1 : 0; BCNT[tile * NE + e] = cnt; }
    }
    __syncthreads();
}

__device__ __forceinline__ void moe_offsets(int* sh, const int* CNT, int tid) {
    if (tid == 0) {
        int acc = 0;
        for (int e = 0; e < NE; ++e) { const int c = (int)CNT[e]; sh[e] = c; sh[32 + e] = acc; acc += (c + MOEB - 1) / MOEB * MOEB; sh[64 + e] = acc; }
    }
    __syncthreads();
}
__device__ __forceinline__ int moe_expert_of_row(const int* sh, int r) {
    int e = -1;
    for (int i = 0; i < NE; ++i) if (r >= sh[32 + i] && r < sh[64 + i]) e = i;
    return e;
}

__device__ __forceinline__ void phase_scatter(const Params& P, int l, unsigned char* smem, int wv) {
    ParamsPtr pp = PARAMS_PTR(P); PIN_S(pp); unsigned char* ws = pp->ws; int bidx = (int)blockIdx.x, gdim = (int)gridDim.x; PIN_S(bidx); PIN_S(gdim);
    const int tid = phase_tid(wv);
    const int* TOPI = (const int*)(ws + O_TOPI); const int* RANK = (const int*)(ws + O_RANK); int* SLOT = (int*)(ws + O_SLOT); int* ROWT = (int*)(ws + O_ROWT);
    const int* BCNT = (const int*)(ws + O_BCNT); int* CNTF = (int*)(ws + O_CNTF);
    int* sh = (int*)smem;
    int* part = sh + 96;
    int* tot = part + 512;
    int* base = tot + 32;
    constexpr int NT = T / 64;
    const int e = tid & 31, pt = tid >> 5;
    { int sacc = 0; for (int tl = pt; tl < NT; tl += 16) sacc += BCNT[tl * NE + e]; part[pt * 32 + e] = sacc; }
    __syncthreads();
    if (tid < 32) { int sacc = 0; for (int q = 0; q < 16; ++q) sacc += part[q * 32 + tid]; tot[tid] = sacc; if (bidx == 0) CNTF[tid] = sacc; }
    __syncthreads();
    moe_offsets(sh, tot, tid);
    for (int ee = bidx; ee < NE; ee += gdim)
        for (int r = sh[32 + ee] + sh[ee] + tid; r < sh[64 + ee]; r += NTHREADS) ROWT[r] = 0;
    for (int tile = bidx; tile < NT; tile += gdim) {
        __syncthreads();
        { int sacc = 0; for (int tl = pt; tl < tile; tl += 16) sacc += BCNT[tl * NE + e]; part[pt * 32 + e] = sacc; }
        __syncthreads();
        if (tid < 32) { int sacc = sh[32 + tid]; for (int q = 0; q < 16; ++q) sacc += part[q * 32 + tid]; base[tid] = sacc; }
        __syncthreads();
        if (tid < 256) { const int a = tile * 256 + tid, dest = base[TOPI[a]] + RANK[a]; SLOT[a] = dest; ROWT[dest] = a >> 2; }
    }
    __syncthreads();
}

template <int WHICH>
__device__ __forceinline__ void phase_moe_gemm(const Params& P, int l, unsigned char* smem, int wv) {
    ParamsPtr pp = PARAMS_PTR(P); PIN_S(pp); unsigned char* ws = pp->ws; int bidx = (int)blockIdx.x, gdim = (int)gridDim.x; PIN_S(bidx); PIN_S(gdim);
    const int tid = phase_tid(wv);
    const int* CNT = (const int*)(ws + O_CNTF);
    int* sh = (int*)(smem + 131072);
    int* rbe = sh + 96;
    moe_offsets(sh, CNT, tid);
    const int nrb = sh[64 + NE - 1] / MOEB;
    for (int rb = tid; rb < nrb; rb += NTHREADS) rbe[rb] = moe_expert_of_row(sh, rb * MOEB);
    __syncthreads();
    pg8::MoeOrderT<WHICH == 1> S;
    S.K = 1024; S.G_ = gdim; S.c = bidx; S.rbe = rbe; S.rowmap = (const int*)(ws + O_ROWT);
    if (WHICH == 1) {
        S.A = (const char*)(ws + O_X1B); S.Wt = (const char*)(ws + O_W1) + (size_t)l * NE * 2 * DFF * D * 2; S.estride = (size_t)2 * DFF * D * 2; S.nN = 2 * DFF / 256; S.nwg = nrb * S.nN;
        pg8::EpiSwiglu E{(bf16_t*)(ws + O_ACT), pp->in[27] + (size_t)l * NE * 2 * DFF};
        pg8::gemm_phase<pg8::EpiSwiglu, pg8::MoeOrderT<WHICH == 1>>((LAS unsigned char*)smem, 1024, S, E, tid);
    } else {
        S.A = (const char*)(ws + O_ACT); S.Wt = (const char*)(ws + O_W2) + (size_t)l * NE * D * DFF * 2; S.estride = (size_t)D * DFF * 2; S.nN = D / 256; S.nwg = nrb * S.nN;
        pg8::EpiBf16Bias E{(bf16_t*)(ws + O_YS), D, pp->in[29] + (size_t)l * NE * D, D};
        pg8::gemm_phase<pg8::EpiBf16Bias, pg8::MoeOrderT<WHICH == 1>>((LAS unsigned char*)smem, 1024, S, E, tid);
    }
    __syncthreads();
}

__device__ __forceinline__ void phase_combine_ln2(const Params& P, int l, unsigned char* smem, int wv) {
    ParamsPtr pp = PARAMS_PTR(P); PIN_S(pp); unsigned char* ws = pp->ws; int bidx = (int)blockIdx.x, gdim = (int)gridDim.x; PIN_S(bidx); PIN_S(gdim);
    const float* X1 = (const float*)(ws + O_X1); const bf16_t* YS = (const bf16_t*)(ws + O_YS); bf16_t* XB = (bf16_t*)(ws + O_XB);
    const int* SLOT = (const int*)(ws + O_SLOT); const float* TOPG = (const float*)(ws + O_TOPG);
    float* xo = l == NL - 1 ? pp->out : (float*)(ws + O_XA);
    const float* g2 = pp->in[30] + (size_t)l * D; const float* b2 = pp->in[31] + (size_t)l * D;
    const int tid = phase_tid(wv), lane = tid & 63, wave = tid >> 6;
    const int gw = bidx * NWAVES + wave, ngw = NWAVES * gdim;
    u32x4 sl_n = (u32x4){0u, 0u, 0u, 0u}; f32x4 gg_n = (f32x4){0.f, 0.f, 0.f, 0.f};
    f32x4 xa_n[4]; u32x2 ys_n[4][4]; f32x4 gg_c = (f32x4){0.f, 0.f, 0.f, 0.f};
    const f32x4 lg[4] = {*(const f32x4*)(g2 + lane * 4), *(const f32x4*)(g2 + 256 + lane * 4), *(const f32x4*)(g2 + 512 + lane * 4), *(const f32x4*)(g2 + 768 + lane * 4)};
    const f32x4 lb[4] = {*(const f32x4*)(b2 + lane * 4), *(const f32x4*)(b2 + 256 + lane * 4), *(const f32x4*)(b2 + 512 + lane * 4), *(const f32x4*)(b2 + 768 + lane * 4)};
#define CB_META(tt_) do { sl_n = *(const u32x4*)(SLOT + (size_t)(tt_) * 4); gg_n = *(const f32x4*)(TOPG + (size_t)(tt_) * 4); } while (0)
#define CB_ROWS(tt_) do { _Pragma("unroll") for (int j = 0; j < 4; ++j) { const int c = j * 256 + lane * 4; xa_n[j] = *(const f32x4*)(X1 + (size_t)(tt_) * D + c); \
        ys_n[0][j] = *(const u32x2*)(YS + (size_t)sl_n.x * D + c); ys_n[1][j] = *(const u32x2*)(YS + (size_t)sl_n.y * D + c); ys_n[2][j] = *(const u32x2*)(YS + (size_t)sl_n.z * D + c); ys_n[3][j] = *(const u32x2*)(YS + (size_t)sl_n.w * D + c); } gg_c = gg_n; } while (0)
    if (gw < T) { CB_META(gw); CB_ROWS(gw); if (gw + ngw < T) CB_META(gw + ngw); }
    for (int t = gw; t < T; t += ngw) {
        float v[16]; float sm = 0.f;
        const float gk[4] = {gg_c.x, gg_c.y, gg_c.z, gg_c.w};
#pragma unroll
        for (int j = 0; j < 4; ++j) {
            const f32x4 a = xa_n[j];
            f32x4 y = (f32x4){0.f, 0.f, 0.f, 0.f};
#pragma unroll
            for (int k = 0; k < 4; ++k) { const u32x2 yk = ys_n[k][j]; y.x += gk[k] * bf_lo(yk.x); y.y += gk[k] * bf_hi(yk.x); y.z += gk[k] * bf_lo(yk.y); y.w += gk[k] * bf_hi(yk.y); }
            v[j * 4 + 0] = ALPHA * a.x + y.x; v[j * 4 + 1] = ALPHA * a.y + y.y; v[j * 4 + 2] = ALPHA * a.z + y.z; v[j * 4 + 3] = ALPHA * a.w + y.w;
            sm += (v[j * 4] + v[j * 4 + 1]) + (v[j * 4 + 2] + v[j * 4 + 3]);
        }
        if (t + ngw < T) { CB_ROWS(t + ngw); if (t + 2 * ngw < T) CB_META(t + 2 * ngw); }
        const float mean = wave_sum_fast(sm, lane) * (1.0f / D); float q = 0.f;
#pragma unroll
        for (int j = 0; j < 16; ++j) { const float dl = v[j] - mean; q += dl * dl; }
        const float rstd = 1.0f / sqrtf(wave_sum_fast(q, lane) * (1.0f / D) + LN_EPS);
#pragma unroll
        for (int j = 0; j < 4; ++j) {
            const int c = j * 256 + lane * 4;
            f32x4 o;
            o.x = (v[j * 4 + 0] - mean) * rstd * lg[j].x + lb[j].x; o.y = (v[j * 4 + 1] - mean) * rstd * lg[j].y + lb[j].y;
            o.z = (v[j * 4 + 2] - mean) * rstd * lg[j].z + lb[j].z; o.w = (v[j * 4 + 3] - mean) * rstd * lg[j].w + lb[j].w;
            *(f32x4*)(xo + (size_t)t * D + c) = o;
            if (l != NL - 1) { u32x2 ob; ob.x = pk2(o.x, o.y); ob.y = pk2(o.z, o.w); *(u32x2*)(XB + (size_t)t * D + c) = ob; }
        }
    }
#undef CB_META
#undef CB_ROWS
}

__device__ __forceinline__ void phase_inproj(const Params& P, int l, unsigned char* smem, int wv) {
    ParamsPtr pp = PARAMS_PTR(P); PIN_S(pp); unsigned char* ws = pp->ws; int bidx = (int)blockIdx.x, gdim = (int)gridDim.x; PIN_S(bidx); PIN_S(gdim);
    const int tid = phase_tid(wv);
    pg8::DenseOrder S; S.init(ws + O_XB, (const bf16_t*)(ws + O_WIN) + (size_t)l * PLD * D, T, PLD, D, gdim, bidx);
    pg8::EpiProj E{(bf16_t*)(ws + O_PROJ), PLD, (float*)(ws + O_PROJG), PLD / 256 - 1};
    pg8::gemm_phase<pg8::EpiProj, pg8::DenseOrder>((LAS unsigned char*)smem, D, S, E, tid);
    __syncthreads();
}
__device__ __forceinline__ void phase_outproj(const Params& P, int l, unsigned char* smem, int wv) {
    ParamsPtr pp = PARAMS_PTR(P); PIN_S(pp); unsigned char* ws = pp->ws; int bidx = (int)blockIdx.x, gdim = (int)gridDim.x; PIN_S(bidx); PIN_S(gdim);
    const int tid = phase_tid(wv);
    pg8::DenseOrder S; S.init(ws + O_GRP, (const bf16_t*)(ws + O_WOUT) + (size_t)l * D * D, T, D, D, gdim, bidx);
    pg8::EpiProj E{(bf16_t*)(ws + O_MIX), D, nullptr, -1};
    pg8::gemm_phase<pg8::EpiProj, pg8::DenseOrder>((LAS unsigned char*)smem, D, S, E, tid);
    __syncthreads();
}

#ifndef EMU
#define XB_TMO      128
#define XB_XCNT(j)  (256  + 64 * (j))
#define XB_XSUB(j)  (1280 + 64 * (j))
#define XB_XGEN(j)  (2304 + 64 * (j))
#define XB_TOP      3328
#define XB_TOPGEN   3392
#define XCD_BAR_WORDS 3456
#define XB_SPIN_CAP (1u << 25)
__device__ __forceinline__ unsigned xb_ld(unsigned* p)              { return __hip_atomic_load(p, __ATOMIC_RELAXED, __HIP_MEMORY_SCOPE_AGENT); }
__device__ __forceinline__ unsigned xb_add(unsigned* p, unsigned v) { return __hip_atomic_fetch_add(p, v, __ATOMIC_RELAXED, __HIP_MEMORY_SCOPE_AGENT); }
__device__ __forceinline__ unsigned xb_xcc_id() { return (unsigned)__builtin_amdgcn_s_getreg((3 << 11) | 20) & 0xFu; }
#define XB_SPIN(cond, bar) do { unsigned _sp = 0; while (cond) { __builtin_amdgcn_s_sleep(1); \
    if ((++_sp & 255u) == 0u) { if (xb_ld(&(bar)[XB_TMO])) break; if (_sp > XB_SPIN_CAP) { atomicAdd(&(bar)[XB_TMO], 1u); break; } } } } while (0)
struct XcdBarrier { unsigned* bar; unsigned x; volatile LAS unsigned* st; };
__device__ __forceinline__ XcdBarrier xcd_barrier_post(unsigned* bar, volatile LAS unsigned* st) {
    XcdBarrier b; b.bar = bar; b.x = xb_xcc_id(); b.st = st;
    if (threadIdx.x == 0) (void)xb_add(&bar[XB_XCNT(b.x)], 1u);
    return b;
}
__device__ __forceinline__ void xcd_barrier_complete(unsigned* bar, unsigned x, unsigned& nloc, unsigned& nx) {
    const unsigned G = gridDim.x * gridDim.y * gridDim.z;
    unsigned sum, cnt, mine, sp = 0u;
    for (;;) {
        sum = 0u; cnt = 0u; mine = 0u;
#pragma unroll
        for (unsigned j = 0; j < 16; ++j) { const unsigned c = xb_ld(&bar[XB_XCNT(j)]); sum += c; cnt += (c > 0u) ? 1u : 0u; mine = (j == x) ? c : mine; }
        if (sum == G) break;
        __builtin_amdgcn_s_sleep(1);
        if ((++sp & 255u) == 0u) { if (xb_ld(&bar[XB_TMO])) break; if (sp > XB_SPIN_CAP) { atomicAdd(&bar[XB_TMO], 1u); break; } }
    }
    nloc = mine > 0u ? mine : 1u; nx = cnt > 0u ? cnt : 1u;
}
__device__ __forceinline__ void xcd_barrier(const XcdBarrier& b) {
    asm volatile("s_waitcnt vmcnt(0)" ::: "memory");
    __syncthreads();
    if (threadIdx.x == 0) {
        unsigned* bar = b.bar;
        __builtin_amdgcn_s_waitcnt(0);
        unsigned nloc = b.st[0], nx = b.st[1];
        if (nloc == 0u) { xcd_barrier_complete(bar, b.x, nloc, nx); b.st[0] = nloc; b.st[1] = nx; }
        const unsigned old = xb_add(&bar[XB_XSUB(b.x)], 1u);
        const unsigned gen = old / nloc;
        if (old + 1u == (gen + 1u) * nloc) {
            __builtin_amdgcn_fence(__ATOMIC_RELEASE, "agent");
            asm volatile("s_waitcnt vmcnt(0)" ::: "memory");
            const unsigned og = xb_add(&bar[XB_TOP], 1u);
            const unsigned tg = og / nx;
            if (og + 1u == (tg + 1u) * nx) xb_add(&bar[XB_TOPGEN], 1u);
            else XB_SPIN(xb_ld(&bar[XB_TOPGEN]) == tg, bar);
            __builtin_amdgcn_fence(__ATOMIC_ACQUIRE, "agent");
            xb_add(&bar[XB_XGEN(b.x)], 1u);
            asm volatile("s_waitcnt vmcnt(0)" ::: "memory");
        } else {
            XB_SPIN(xb_ld(&bar[XB_XGEN(b.x)]) == gen, bar);
            __builtin_amdgcn_fence(__ATOMIC_ACQUIRE, "agent");
            asm volatile("s_waitcnt vmcnt(0)" ::: "memory");
        }
    }
    __syncthreads();
}
#endif

__global__ void __launch_bounds__(512, 2) mk_fwd(Params P) {
#ifdef EMU
    unsigned char* smem = g_blk->lds;
#else
    extern __shared__ __attribute__((aligned(16))) unsigned char smem[];
    volatile LAS unsigned* bst = (volatile LAS unsigned*)(smem + LDS_BYTES - 16);
    if (threadIdx.x == 0) { bst[0] = 0u; bst[1] = 0u; bst[2] = 0u; bst[3] = 0u; }
    __syncthreads();
    XcdBarrier bar; bar.bar = (unsigned*)P.ws + CW_BAR; bar.x = 0; bar.st = bst;
    if (P.ph_hi - P.ph_lo > 1) bar = xcd_barrier_post((unsigned*)P.ws + CW_BAR, bst);
#endif
    const int lo = P.ph_lo, hi = P.ph_hi;
#ifdef EMU
    const int wv = (int)threadIdx.x >> 6;
#else
    const int wv = RFL((int)threadIdx.x >> 6);
#endif
#ifdef EMU
#define SEAM(id) do {} while (0)
#else
#define SEAM(id) do { if ((id) + 1 < hi) xcd_barrier(bar); } while (0)
#endif
#ifndef MK_ONLY_PHASE
#define MK_ONLY_PHASE -1
#endif
#ifndef MK_DUP_MASK
#define MK_DUP_MASK 0
#endif
#define PHG(kc, id, ...) do { if (MK_ONLY_PHASE < 0 || MK_ONLY_PHASE == (kc)) { const int id_ = (id); if (id_ >= lo && id_ < hi) { if ((MK_DUP_MASK >> (kc)) & 1) { __VA_ARGS__; SEAM(id_ - 1); } __VA_ARGS__; SEAM(id_); } } } while (0)
#define PH(k, ...) PHG(1 + (k), 1 + l * NPH + (k), __VA_ARGS__)
    PHG(0, 0, phase_prologue(P, smem, wv));
    for (int l = 0; l < NL; ++l) {
        PH(0, phase_inproj(P, l, smem, wv));
#if MK_RWKV_CHUNKED
        PH(1, phase_prep32(P, l, smem, wv));
#else
        PH(1, phase_prep(P, l, smem, wv));
#endif
#if MK_RWKV_CHUNKED
        PH(2, { phase_rwkv_pre(P, l, smem, wv); phase_mlstm_local(P, l, smem, wv, (int)blockIdx.x, (int)gridDim.x); });
        PH(3, { phase_rwkv_seq(P, l, smem, wv); phase_mlstm_carry(P, l, smem, wv); });
        PH(4, { phase_rwkv_out(P, l, smem, wv); phase_mlstm_out(P, l, smem, wv); phase_gmlp_mix(P, l, smem, wv, (int)blockIdx.x, (int)gridDim.x); });
#else
        PH(2, { const int G_ = (int)gridDim.x, NSC = 2 * NB * RH * 4;
                if (G_ >= NSC + 32) { if ((int)blockIdx.x < NSC) phase_rwkv_scan(P, l, smem, wv, (int)blockIdx.x, NSC);
                                      else phase_mlstm_local(P, l, smem, wv, (int)blockIdx.x - NSC, G_ - NSC); }
                else { phase_rwkv_scan(P, l, smem, wv, (int)blockIdx.x, G_); phase_mlstm_local(P, l, smem, wv, (int)blockIdx.x, G_); } });
        PH(3, phase_mlstm_carry(P, l, smem, wv));
        PH(4, { phase_mlstm_out(P, l, smem, wv); phase_gmlp_mix(P, l, smem, wv, (int)blockIdx.x, (int)gridDim.x); phase_rwkv_post(P, l, smem, wv); });
#endif
        PH(5, phase_outproj(P, l, smem, wv));
        PH(6, phase_ln1_router(P, l, smem, wv));
        PH(7, phase_scatter(P, l, smem, wv));
        PH(8, phase_moe_gemm<1>(P, l, smem, wv));
        PH(9, phase_moe_gemm<2>(P, l, smem, wv));
        PH(10, phase_combine_ln2(P, l, smem, wv));
    }
#undef PHG
#undef PH
#undef SEAM
}

}

#ifndef EMU
extern "C" void kernel_launch(void* const* d_in, const int* in_sizes, int n_in, void* d_out, int out_size, void* d_ws, size_t ws_size, hipStream_t stream) {
    using namespace mk;
    static int grid = 0;
    if (grid == 0) {
        if (n_in != 32 || out_size != T * D || ws_size < WS_END) { fprintf(stderr, "kernel_launch: unexpected shapes (n_in %d out %d ws %zu need %zu)\n", n_in, out_size, ws_size, (size_t)WS_END); grid = -1; return; }
        int dev = 0, cus = 0;
        if (hipGetDevice(&dev) != hipSuccess || hipDeviceGetAttribute(&cus, hipDeviceAttributeMultiprocessorCount, dev) != hipSuccess) { grid = -1; return; }
        if (hipFuncSetAttribute((const void*)mk_fwd, hipFuncAttributeMaxDynamicSharedMemorySize, LDS_BYTES) != hipSuccess) { fprintf(stderr, "kernel_launch: hipFuncSetAttribute failed\n"); grid = -1; return; }
        int per_cu = 0;
        (void)hipOccupancyMaxActiveBlocksPerMultiprocessor(&per_cu, (const void*)mk_fwd, NTHREADS, LDS_BYTES);
        (void)hipGetLastError();
        grid = cus;
    }
    if (grid < 0) return;
    (void)hipMemsetAsync(d_ws, 0, CTL_BYTES, stream);
    Params p{};
    for (int i = 0; i < 32; ++i) p.in[i] = (const float*)d_in[i];
    p.out = (float*)d_out; p.ws = (unsigned char*)d_ws;
#if MK_ONE_LAUNCH
    p.ph_lo = 0; p.ph_hi = 1 + NL * NPH;
    hipLaunchKernelGGL(mk_fwd, dim3(grid), dim3(NTHREADS), LDS_BYTES, stream, p);
#else
    for (int id = 0; id < 1 + NL * NPH; ++id) {
        p.ph_lo = id; p.ph_hi = id + 1;
        hipLaunchKernelGGL(mk_fwd, dim3(grid), dim3(NTHREADS), LDS_BYTES, stream, p);
    }
#endif
}
#endif
```

```cpp
#ifndef EMU
#include <hip/hip_runtime.h>
#endif
#include <cstdio>
#include <cstdint>
#include <cmath>

#ifndef CFG_BATCH
#define CFG_BATCH 4
#endif
#ifndef CFG_SEQ
#define CFG_SEQ 4096
#endif
#ifndef CFG_LAYERS
#define CFG_LAYERS 4
#endif
#ifndef MK_RWKV_CHUNKED
#define MK_RWKV_CHUNKED 1
#endif
#ifndef MK_PROBE
#define MK_PROBE 0
#endif
#ifndef MK_ONE_LAUNCH
#define MK_ONE_LAUNCH 1
#endif

namespace mk {
constexpr int NB = CFG_BATCH, S = CFG_SEQ, T = NB * S, NL = CFG_LAYERS, D = 1024;
constexpr int GW = 256, RW = 384, MW = 384, HD = 64, GH = 4, RH = 6, MH = 6, CH = 128, NCH = S / CH;
constexpr int PIN = 3480, PLD = 3584, RPROJ = 1408;
constexpr int C_RW = 512, C_MW = 1920;
constexpr int NE = 32, TOPK = 4, DFF = 1024, MOEB = 256;
constexpr int NROWS = (T * TOPK / MOEB + NE) * MOEB;
constexpr float LN_EPS = 1e-5f, GN_EPS = 64e-5f;
constexpr float ALPHA = 1.6817928305074290f;
constexpr int NTHREADS = 512, NWAVES = 8;
constexpr int LDS_BYTES = 160 * 1024;
constexpr int NPH = 11;

typedef float f32x4 __attribute__((ext_vector_type(4)));
typedef unsigned u32x4 __attribute__((ext_vector_type(4)));
typedef unsigned u32x2 __attribute__((ext_vector_type(2)));
typedef short bf16x8 __attribute__((ext_vector_type(8)));
typedef unsigned short bf16_t;

constexpr size_t al(size_t x) { return (x + 255) & ~(size_t)255; }
constexpr size_t CTL_BYTES = 1u << 20;
constexpr size_t O_XA = CTL_BYTES;
constexpr size_t O_XB = O_XA + al((size_t)T * D * 4);
constexpr size_t O_X1 = O_XB + al((size_t)T * D * 2);
constexpr size_t O_X1B = O_X1 + al((size_t)T * D * 4);
constexpr size_t O_PROJ = O_X1B + al((size_t)T * D * 2);
constexpr size_t O_PROJG = O_PROJ + al((size_t)T * PLD * 2);
constexpr size_t O_MIX = O_PROJ + al((size_t)T * PLD * 4);
constexpr size_t O_GRP = O_MIX + al((size_t)T * D * 4);
constexpr size_t O_UG = O_GRP + al((size_t)T * D * 2);
constexpr size_t O_VN = O_UG + al((size_t)T * GW * 4);
constexpr size_t O_RR = O_VN + al((size_t)T * GW * 4);
constexpr size_t O_VV = O_RR + al((size_t)T * RW * 4);
constexpr size_t O_KK = O_VV + al((size_t)T * RW * 4);
constexpr size_t O_DEC = O_KK + al((size_t)T * RW * 4);
constexpr size_t O_KD = O_DEC + al((size_t)2 * T * RW * 4);
constexpr size_t O_ICLR = O_KD + al((size_t)2 * T * RW * 4);
constexpr size_t O_GATE = O_ICLR + al((size_t)2 * T * RW * 4);
constexpr size_t O_BONUS = O_GATE + al((size_t)T * RW * 4);
constexpr size_t O_SCAN = O_BONUS + al((size_t)T * RH * 4);
constexpr size_t O_MQ = O_SCAN + al((size_t)2 * T * RW * 4);
constexpr size_t O_MK = O_MQ + al((size_t)T * MW * 4);
constexpr size_t O_IG = O_MK + al((size_t)T * MW * 4);
constexpr size_t O_LF = O_IG + al((size_t)2 * T * MH * 4);
constexpr size_t O_CL = O_LF + al((size_t)2 * T * MH * 4);
constexpr size_t O_NL = O_CL + al((size_t)2 * NB * MH * NCH * 4096 * 4);
constexpr size_t O_ML = O_NL + al((size_t)2 * NB * MH * NCH * 64 * 4);
constexpr size_t O_BL = O_ML + al((size_t)2 * NB * MH * NCH * 4);
constexpr size_t O_MIN = O_BL + al((size_t)2 * NB * MH * NCH * 4);
constexpr size_t O_TOPI = O_MIN + al((size_t)2 * NB * MH * NCH * 4);
constexpr size_t O_TOPG = O_TOPI + al((size_t)T * 4 * 4);
constexpr size_t O_RANK = O_TOPG + al((size_t)T * 4 * 4);
constexpr size_t O_SLOT = O_RANK + al((size_t)T * 4 * 4);
constexpr size_t O_MQB = O_SLOT + al((size_t)T * 4 * 4);
constexpr size_t O_MKB = O_MQB + al((size_t)T * MW * 2);
constexpr size_t O_KT = O_MKB + al((size_t)T * MW * 2);
constexpr size_t O_VT = O_KT + al((size_t)T * MW * 2);
constexpr size_t O_GVT = O_VT + al((size_t)T * MW * 2);
constexpr size_t O_PMX = O_GVT + al((size_t)2 * T * MH * 4);
constexpr size_t O_BCT = O_PMX + al((size_t)2 * T * MH * 4);
constexpr size_t O_BRKR = O_BCT + al((size_t)2 * T * MH * 4);
constexpr int RC = 64, RNC = S / RC, RUN = 2 * NB * RH * RNC;
constexpr size_t O_LW = O_BRKR + al((size_t)2 * T * RH * 2 * 4);
constexpr size_t O_RQ = O_LW + al((size_t)2 * T * RW * 4);
constexpr size_t O_RA = O_RQ + al((size_t)RUN * 4096 * 2);
constexpr size_t O_RS = O_RA + al((size_t)RUN * 4096 * 2);
constexpr size_t O_RH = O_RS + al((size_t)RUN * 4096 * 2);
constexpr size_t O_RG = O_RH + al((size_t)RUN * 4096 * 4);
constexpr size_t O_RB = O_RG + al((size_t)RUN * 4096 * 4);
constexpr size_t O_VB = O_RB + al((size_t)T * RW * 2);
constexpr size_t O_KKB = O_VB + al((size_t)T * RW * 2);
constexpr size_t O_BBB = O_KKB + al((size_t)T * RW * 2);
constexpr size_t O_KDB = O_BBB + al((size_t)2 * T * RW * 2);
constexpr size_t O_RK7 = O_KDB + al((size_t)2 * T * RW * 2);
constexpr size_t O_VNT = O_RK7 + al((size_t)T * RW * 16);
constexpr size_t O_WSB = O_VNT + al((size_t)T * GW * 2);
constexpr size_t O_LWT = O_WSB + al((size_t)NL * GH * CH * CH * 2);
constexpr size_t O_RWT = O_LWT + al((size_t)NL * 1920 * 128 * 2);
constexpr size_t O_BCNT = O_RWT + al((size_t)NL * 2 * NE * D * 2);
constexpr size_t O_CNTF = O_BCNT + al((size_t)(T / 64) * NE * 4);
constexpr size_t O_ROWT = O_CNTF + al((size_t)NE * 4);
constexpr size_t O_XS = O_ROWT + al((size_t)NROWS * 4);
constexpr size_t O_ACT = O_XS + al((size_t)NROWS * D * 2);
constexpr size_t O_YS = O_ACT + al((size_t)NROWS * DFF * 2);
constexpr size_t O_WIN = O_YS + al((size_t)NROWS * D * 2);
constexpr size_t O_WOUT = O_WIN + al((size_t)NL * PLD * D * 2);
constexpr size_t O_W1 = O_WOUT + al((size_t)NL * D * D * 2);
constexpr size_t O_W2 = O_W1 + al((size_t)NL * NE * 2 * DFF * D * 2);
constexpr size_t WS_END = O_W2 + al((size_t)NL * NE * D * DFF * 2);

constexpr int CW_BAR = 4096;
constexpr int CW_CNT = 16384;

struct Params { const float* in[32]; float* out; unsigned char* ws; int ph_lo, ph_hi; };
#ifdef EMU
typedef const Params* ParamsPtr;
#define PARAMS_PTR(P) (&(P))
#else
typedef const __attribute__((address_space(4))) Params* ParamsPtr;
#define PARAMS_PTR(P) ((ParamsPtr)__builtin_amdgcn_kernarg_segment_ptr())
#endif

#ifdef EMU
#define WAVE_SYNC() emu_wave_barrier()
#define PIN_V(x) do {} while (0)
#define PIN_S(x) do {} while (0)
#else
#define WAVE_SYNC() __builtin_amdgcn_wave_barrier()
#define PIN_V(x) asm volatile("" : "+v"(x))
#define PIN_S(x) asm volatile("" : "+s"(x))
#endif
#ifdef EMU
__device__ __forceinline__ int phase_tid(int wv) { (void)wv; return threadIdx.x; }
#else
__device__ __forceinline__ int phase_tid(int wv) { int t; asm volatile("v_mbcnt_lo_u32_b32 %0, -1, 0\n\tv_mbcnt_hi_u32_b32 %0, -1, %0" : "=v"(t)); return (wv << 6) + t; }
#endif

#ifdef EMU
#define SHX(v, m, lane) __shfl_xor(v, m)
#else
__device__ __forceinline__ float shx_(float v, int m, int lane) { return __builtin_bit_cast(float, __builtin_amdgcn_ds_bpermute((lane ^ m) << 2, __builtin_bit_cast(int, v))); }
__device__ __forceinline__ int shx_(int v, int m, int lane) { return __builtin_amdgcn_ds_bpermute((lane ^ m) << 2, v); }
#define SHX(v, m, lane) shx_(v, m, lane)
#endif
#ifdef EMU
#define SHUP(v, o, lane) __shfl(v, ((lane) - (o)) & 63)
#define RDL(v, src) __shfl(v, src)
#define SHL(v, src) __shfl(v, src)
#else
#define SHL(v, src) __builtin_bit_cast(float, __builtin_amdgcn_ds_bpermute((src) << 2, __builtin_bit_cast(int, (float)(v))))
#define SHUP(v, o, lane) __builtin_bit_cast(float, __builtin_amdgcn_ds_bpermute((((lane) - (o)) & 63) << 2, __builtin_bit_cast(int, (float)(v))))
#define RDL(v, src) __builtin_bit_cast(float, __builtin_amdgcn_readlane(__builtin_bit_cast(int, (float)(v)), src))
#endif
__device__ __forceinline__ float wave_sum(float v, int lane) {
#pragma unroll
    for (int o = 32; o >= 1; o >>= 1) v += SHX(v, o, lane);
    return v;
}
#ifdef EMU
__device__ __forceinline__ float fexp(float x) { return expf(x); }
__device__ __forceinline__ float flog(float x) { return logf(x); }
__device__ __forceinline__ float frcp(float x) { return 1.0f / x; }
#else
__device__ __forceinline__ float fexp(float x) { return __builtin_amdgcn_exp2f(x * 1.4426950408889634f); }
__device__ __forceinline__ float flog(float x) { return __builtin_amdgcn_logf(x) * 0.6931471805599453f; }
__device__ __forceinline__ float frcp(float x) { return __builtin_amdgcn_rcpf(x); }
#endif
__device__ __forceinline__ float sigmoidf_(float x) { return frcp(1.0f + fexp(-x)); }
__device__ __forceinline__ float softplusf_(float x) { return fmaxf(x, 0.f) + flog(1.0f + fexp(-fabsf(x))); }
__device__ __forceinline__ float ftanh(float x) { return 1.0f - 2.0f * frcp(1.0f + fexp(2.0f * x)); }
__device__ __forceinline__ float geluf_(float v) {
    const float av = fabsf(v), t = frcp(1.0f + 0.2316418882f * av);
    float q = t * 0.5307027145f + (-0.7265760135f); q = q * t + 0.7107068705f; q = q * t + (-0.142248368f); q = q * t + 0.127414796f; q = q * t;
    const float m = v * (q * fexp(-0.5f * v * v));
    return v < 0.f ? m : v - m;
}

#ifdef EMU
#define LAS
#define WAIT_V(n) do {} while (0)
#define WAIT_L(n) do {} while (0)
#define S_BARRIER() __syncthreads()
#define SETPRIO(x) do {} while (0)
#define SCHED_BAR() do {} while (0)
#define RFL(x) (x)
static inline void emu_glds16(const void* g, void* l) { memcpy((char*)l + (g_blk->cur & 63) * 16, g, 16); }
#define GLDS16(gptr, ldsptr) emu_glds16((const void*)(gptr), (void*)(ldsptr))
static inline float emu_bf2f(unsigned short b) { unsigned u = (unsigned)b << 16; float f; memcpy(&f, &u, 4); return f; }
static inline f32x4 emu_mfma16(bf16x8 a, bf16x8 b, f32x4 c) {
    EmuBlock* blk = g_blk; const int cur = blk->cur, lane = cur & 63, wbase = cur & ~63;
    static thread_local unsigned short Ash[32][64][8], Bsh[32][64][8];
    const int w = cur >> 6;
    for (int j = 0; j < 8; ++j) { Ash[w][lane][j] = (unsigned short)a[j]; Bsh[w][lane][j] = (unsigned short)b[j]; }
    emu_wave_barrier();
    const int col = lane & 15;
    for (int r = 0; r < 4; ++r) { const int row = 4 * (lane >> 4) + r; float sum = c[r];
        for (int k = 0; k < 32; ++k) sum += emu_bf2f(Ash[w][row + 16 * (k >> 3)][k & 7]) * emu_bf2f(Bsh[w][col + 16 * (k >> 3)][k & 7]);
        c[r] = sum; }
    emu_wave_barrier(); (void)wbase;
    return c;
}
#define MFMA16(a, b, c) emu_mfma16(a, b, c)
#else
#define LAS __attribute__((address_space(3)))
#define WAIT_V(n) asm volatile("s_waitcnt vmcnt(" #n ")" ::: "memory")
#define WAIT_L(n) asm volatile("s_waitcnt lgkmcnt(" #n ")" ::: "memory")
#define S_BARRIER() __builtin_amdgcn_s_barrier()
#define SETPRIO(x) __builtin_amdgcn_s_setprio(x)
#define SCHED_BAR() __builtin_amdgcn_sched_barrier(0)
#define RFL(x) __builtin_amdgcn_readfirstlane(x)
#define GLDS16(gptr, ldsptr) __builtin_amdgcn_global_load_lds((const unsigned*)(gptr), (LAS unsigned*)(ldsptr), 16, 0, 0)
#define MFMA16(a, b, c) __builtin_amdgcn_mfma_f32_16x16x32_bf16(a, b, c, 0, 0, 0)
#endif

#ifdef EMU
__device__ __forceinline__ unsigned f2bf(float f) { unsigned u = __builtin_bit_cast(unsigned, f); return (u + 0x7fffu + ((u >> 16) & 1u)) >> 16; }
#else
__device__ __forceinline__ unsigned f2bf(float f) { return (unsigned)__builtin_bit_cast(unsigned short, (__bf16)f); }
#endif
#ifdef EMU
__device__ __forceinline__ unsigned pk2(float lo, float hi) { return f2bf(lo) | (f2bf(hi) << 16); }
#else
typedef float f32x2c __attribute__((ext_vector_type(2)));
typedef __bf16 bf16x2c __attribute__((ext_vector_type(2)));
__device__ __forceinline__ unsigned pk2(float lo, float hi) { const f32x2c v = {lo, hi}; return __builtin_bit_cast(unsigned, __builtin_convertvector(v, bf16x2c)); }
#endif
__device__ __forceinline__ bf16x8 cvt8(const f32x4 a, const f32x4 b) {
    u32x4 w; w.x = pk2(a.x, a.y); w.y = pk2(a.z, a.w); w.z = pk2(b.x, b.y); w.w = pk2(b.z, b.w); return __builtin_bit_cast(bf16x8, w);
}
__device__ __forceinline__ float bf_lo(unsigned u) { return __builtin_bit_cast(float, u << 16); }
__device__ __forceinline__ float bf_hi(unsigned u) { return __builtin_bit_cast(float, u & 0xffff0000u); }

namespace pg8 {
constexpr int BM = 256, BK = 64, HALF = 128, HTB = HALF * BK * 2, STAGE_BYTES = 8 * HTB, NXCD = 8, WGM = 8;
__host__ __device__ __forceinline__ int lds_byte(int r, int c) { const int st = (r >> 4) * 2 + (c >> 5), rr = r & 15, cc = c & 31, ob = rr * 64 + cc * 2; return st * 1024 + (ob ^ (((ob >> 9) & 1) << 5)); }
__host__ __device__ __forceinline__ void stage_rc(int b, int& R, int& C) { const int st = b / 1024, sb = b % 1024, swz = sb ^ (((sb >> 9) & 1) << 5); R = (st >> 1) * 16 + swz / 64; C = (st & 1) * 32 + (swz % 64) / 2; }
__host__ __device__ __forceinline__ int perm32(int rho) { const int n = rho >> 4, i = rho & 15; return 8 * (i >> 2) + 4 * n + (i & 3); }
struct Unit { int pm, pn, e; };

struct DenseOrder {
    static constexpr bool GATHER = false;
    const char* A; const char* Bt; int K; int nM, nN, nwg, G, c;
    __device__ __forceinline__ void init(const void* A_, const void* Bt_, int M, int N, int K_, int G_, int c_) { A = (const char*)A_; Bt = (const char*)Bt_; K = K_; nM = M / BM; nN = N / BM; nwg = nM * nN; G = G_; c = c_; }
    __device__ __forceinline__ bool next(int i, Unit& u) const {
        const long L = (long)i * G + c; if (L >= nwg) return false;
        int wgid = (int)L; { const int q = nwg / NXCD, r = nwg % NXCD, xcd = wgid % NXCD, off = wgid / NXCD; wgid = (xcd < r ? xcd * (q + 1) : r * (q + 1) + (xcd - r) * q) + off; }
        const int nig = WGM * nN, gid = wgid / nig, fm = gid * WGM, gsz = (nM - fm) < WGM ? (nM - fm) : WGM;
        u.pm = fm + ((wgid % nig) % gsz); u.pn = (wgid % nig) / gsz; u.e = 0; return true;
    }
    __device__ __forceinline__ const char* abase(const Unit& u) const { return A + (size_t)u.pm * BM * K * 2; }
    __device__ __forceinline__ const char* bbase(const Unit& u) const { return Bt + (size_t)u.pn * BM * K * 2; }
};
template <bool G>
struct MoeOrderT {
    static constexpr bool GATHER = G;
    const char* A; const char* Wt; int K; int nN, nwg, G_, c; size_t estride; const int* rbe; const int* rowmap;
    __device__ __forceinline__ bool next(int i, Unit& u) const {
        const long L = (long)i * G_ + c; if (L >= nwg) return false;
        u.pm = (int)(L / nN); u.pn = (int)(L % nN); u.e = rbe[u.pm]; return true;
    }
    __device__ __forceinline__ const char* abase(const Unit& u) const { return G ? A : A + (size_t)u.pm * BM * K * 2; }
    __device__ __forceinline__ const char* bbase(const Unit& u) const { return Wt + (size_t)u.e * estride + (size_t)u.pn * BM * K * 2; }
};
struct EpiF32 {
    static constexpr bool PERM = false;
    float* C; int ldc;
    __device__ __forceinline__ void operator()(const f32x4 (&acc)[2][2][4][2], const Unit& u, int wr, int wc, int fr, int fq) const {
        const int row0 = u.pm * BM + wr * 64 + fr, col0 = u.pn * BM + wc * 32 + 4 * fq;
#pragma unroll
        for (int ai = 0; ai < 2; ++ai)
#pragma unroll
            for (int m = 0; m < 4; ++m) { float* rowp = C + (size_t)(row0 + ai * HALF + m * 16) * ldc + col0;
#pragma unroll
                for (int bj = 0; bj < 2; ++bj)
#pragma unroll
                    for (int n = 0; n < 2; ++n) *(f32x4*)(rowp + bj * HALF + n * 16) = acc[ai][bj][m][n]; }
    }
};
struct EpiProj {
    static constexpr bool PERM = true;
    bf16_t* O; int ldc; float* G; int lastt;
    __device__ __forceinline__ void operator()(const f32x4 (&acc)[2][2][4][2], const Unit& u, int wr, int wc, int fr, int fq) const {
        const int row0 = u.pm * BM + wr * 64 + fr, col0 = u.pn * BM + wc * 32 + 8 * fq;
#pragma unroll
        for (int ai = 0; ai < 2; ++ai)
#pragma unroll
            for (int m = 0; m < 4; ++m) { bf16_t* rowp = O + (size_t)(row0 + ai * HALF + m * 16) * ldc + col0;
#pragma unroll
                for (int bj = 0; bj < 2; ++bj) { const f32x4 v0 = acc[ai][bj][m][0], v1 = acc[ai][bj][m][1];
                    u32x4 w; w.x = pk2(v0[0], v0[1]); w.y = pk2(v0[2], v0[3]); w.z = pk2(v1[0], v1[1]); w.w = pk2(v1[2], v1[3]);
                    *(u32x4*)(rowp + bj * HALF) = w; } }
        if (u.pn == lastt) {
#pragma unroll
            for (int ai = 0; ai < 2; ++ai)
#pragma unroll
                for (int m = 0; m < 4; ++m) { float* rowp = G + (size_t)(row0 + ai * HALF + m * 16) * BM + wc * 32 + 8 * fq;
#pragma unroll
                    for (int bj = 0; bj < 2; ++bj) { *(f32x4*)(rowp + bj * HALF) = acc[ai][bj][m][0]; *(f32x4*)(rowp + bj * HALF + 4) = acc[ai][bj][m][1]; } }
        }
    }
};
struct EpiBf16Bias {
    static constexpr bool PERM = true;
    bf16_t* O; int ldc; const float* bias; int bias_estride;
    __device__ __forceinline__ void operator()(const f32x4 (&acc)[2][2][4][2], const Unit& u, int wr, int wc, int fr, int fq) const {
        const int row0 = u.pm * BM + wr * 64 + fr, col0 = u.pn * BM + wc * 32 + 8 * fq;
        const float* bp = bias + (size_t)u.e * bias_estride + col0;
        f32x4 bv[2][2];
#pragma unroll
        for (int bj = 0; bj < 2; ++bj)
#pragma unroll
            for (int n = 0; n < 2; ++n) bv[bj][n] = *(const f32x4*)(bp + bj * HALF + 4 * n);
#pragma unroll
        for (int ai = 0; ai < 2; ++ai)
#pragma unroll
            for (int m = 0; m < 4; ++m) { bf16_t* rowp = O + (size_t)(row0 + ai * HALF + m * 16) * ldc + col0;
#pragma unroll
                for (int bj = 0; bj < 2; ++bj) { const f32x4 v0 = acc[ai][bj][m][0] + bv[bj][0], v1 = acc[ai][bj][m][1] + bv[bj][1];
                    u32x4 w; w.x = pk2(v0[0], v0[1]); w.y = pk2(v0[2], v0[3]); w.z = pk2(v1[0], v1[1]); w.w = pk2(v1[2], v1[3]);
                    *(u32x4*)(rowp + bj * HALF) = w; } }
    }
};
__device__ __forceinline__ float swiglu1(float g, float uu) { g = fminf(g, 7.0f); uu = fminf(fmaxf(uu, -7.0f), 7.0f); return (uu + 1.0f) * (g * frcp(1.0f + fexp(-1.702f * g))); }
struct EpiSwiglu {
    static constexpr bool PERM = true;
    bf16_t* O; const float* b1;
    __device__ __forceinline__ void operator()(const f32x4 (&acc)[2][2][4][2], const Unit& u, int wr, int wc, int fr, int fq) const {
        const int row0 = u.pm * BM + wr * 64 + fr, j0 = u.pn * HALF + wc * 32 + 8 * fq;
        const float* bg = b1 + (size_t)u.e * 2 * DFF + j0; const float* bu = bg + DFF;
        f32x4 g4[2], u4[2];
#pragma unroll
        for (int n = 0; n < 2; ++n) { g4[n] = *(const f32x4*)(bg + 4 * n); u4[n] = *(const f32x4*)(bu + 4 * n); }
#pragma unroll
        for (int ai = 0; ai < 2; ++ai)
#pragma unroll
            for (int m = 0; m < 4; ++m) {
                float o[8];
#pragma unroll
                for (int n = 0; n < 2; ++n)
#pragma unroll
                    for (int q = 0; q < 4; ++q) o[n * 4 + q] = swiglu1(acc[ai][0][m][n][q] + g4[n][q], acc[ai][1][m][n][q] + u4[n][q]);
                u32x4 w; w.x = pk2(o[0], o[1]); w.y = pk2(o[2], o[3]); w.z = pk2(o[4], o[5]); w.w = pk2(o[6], o[7]);
                *(u32x4*)(O + (size_t)(row0 + ai * HALF + m * 16) * DFF + j0) = w;
            }
    }
};

template <class Epi, class Sched>
__device__ __forceinline__ void gemm_phase(LAS unsigned char* lds, const int K, const Sched& S, const Epi& E, const int tid) {
    const int wid = RFL(tid >> 6), lane = tid & 63, wr = wid >> 2, wc = wid & 3, fr = lane & 15, fq = lane >> 4;
    const int nt = K / BK;
    unsigned voffA[2], voffB[2]; int gR[2]; unsigned gC[2];
#pragma unroll
    for (int i = 0; i < 2; ++i) { int R, C; stage_rc(tid * 16 + i * 8192, R, C); const int Rb = Epi::PERM ? ((R & ~31) + perm32(R & 31)) : R;
        voffA[i] = (unsigned)(R * K + C) * 2u; voffB[i] = (unsigned)(Rb * K + C) * 2u; gR[i] = R; gC[i] = (unsigned)C * 2u; }
    unsigned va[2][2], vn[2][2];
#define PG8_GOFF(dst, unit) do { if constexpr (Sched::GATHER) { _Pragma("unroll") for (int h_ = 0; h_ < 2; ++h_) _Pragma("unroll") for (int i_ = 0; i_ < 2; ++i_) \
        dst[h_][i_] = (unsigned)S.rowmap[(unit).pm * BM + h_ * HALF + gR[i_]] * (unsigned)(K * 2) + gC[i_]; } } while (0)
#define PG8_STAGE_A(bufoff, bp, kb, h, nx) do { if constexpr (Sched::GATHER) { const char* gb_ = S.A + (kb); _Pragma("unroll") for (int _i = 0; _i < 2; ++_i) \
        GLDS16(gb_ + ((nx) ? vn[h][_i] : va[h][_i]), lds + (bufoff) + ldsw + _i * 8192); } else { PG8_STAGE(bufoff, bp, voffA); } } while (0)
    const size_t kstep = (size_t)(BK * 2);
    const size_t hstep = (size_t)HALF * K * 2;
    const unsigned ldsw = (unsigned)wid * 1024u;
    const int aoff = lds_byte(wr * 64 + fr, fq * 8), boff = lds_byte(wc * 32 + fr, fq * 8);
#define PG8_SA(b, h) (((b) * 2 + (h)) * HTB)
#define PG8_SB(b, h) ((4 + (b) * 2 + (h)) * HTB)
#define PG8_STAGE(bufoff, gbase, voff) do { _Pragma("unroll") for (int _i = 0; _i < 2; ++_i) \
        GLDS16((const char*)(gbase) + (voff)[_i], lds + (bufoff) + ldsw + _i * 8192); } while (0)
#define PG8_LDA(dst, b, h) do { _Pragma("unroll") for (int m = 0; m < 4; ++m) _Pragma("unroll") for (int k = 0; k < 2; ++k) dst[m][k] = *(const LAS bf16x8*)(lds + PG8_SA(b, h) + aoff + m * 2048 + k * 1024); } while (0)
#define PG8_LDB(dst, b, h) do { _Pragma("unroll") for (int n = 0; n < 2; ++n) _Pragma("unroll") for (int k = 0; k < 2; ++k) dst[n][k] = *(const LAS bf16x8*)(lds + PG8_SB(b, h) + boff + n * 2048 + k * 1024); } while (0)
#define PG8_MMA(ai, bj, At, Bt) do { SETPRIO(1); _Pragma("unroll") for (int m = 0; m < 4; ++m) _Pragma("unroll") for (int n = 0; n < 2; ++n) _Pragma("unroll") for (int k = 0; k < 2; ++k) \
        acc[ai][bj][m][n] = MFMA16(Bt[n][k], At[m][k], acc[ai][bj][m][n]); SETPRIO(0); } while (0)
    Unit cur, nxt; int ui = 0;
    if (!S.next(0, cur)) return;
    f32x4 acc[2][2][4][2];
#pragma unroll
    for (int a = 0; a < 2; ++a)
#pragma unroll
        for (int b = 0; b < 2; ++b)
#pragma unroll
            for (int m = 0; m < 4; ++m)
#pragma unroll
                for (int n = 0; n < 2; ++n) acc[a][b][m][n] = (f32x4){0.f, 0.f, 0.f, 0.f};
    bf16x8 At[4][2], B0[2][2], B1[2][2];
    const char* cA = S.abase(cur); const char* cB = S.bbase(cur);
    PG8_GOFF(va, cur);
    PG8_STAGE(PG8_SB(0, 0), cB, voffB); PG8_STAGE_A(PG8_SA(0, 0), cA, 0, 0, false); PG8_STAGE(PG8_SB(0, 1), cB + hstep, voffB); PG8_STAGE_A(PG8_SA(0, 1), cA + hstep, 0, 1, false);
    if (wr == 1) S_BARRIER();
    WAIT_V(4); S_BARRIER();
    PG8_STAGE(PG8_SB(1, 0), cB + kstep, voffB); PG8_STAGE_A(PG8_SA(1, 0), cA + kstep, kstep, 0, false); PG8_STAGE(PG8_SB(1, 1), cB + hstep + kstep, voffB);
    WAIT_V(6); S_BARRIER();
    for (;;) {
        const bool has_next = S.next(ui + 1, nxt);
        const char* nA = has_next ? S.abase(nxt) : cA; const char* nB = has_next ? S.bbase(nxt) : cB;
        if constexpr (Sched::GATHER) { if (has_next) { PG8_GOFF(vn, nxt); } else {
#pragma unroll
            for (int h_ = 0; h_ < 2; ++h_) { vn[h_][0] = va[h_][0]; vn[h_][1] = va[h_][1]; } } }
        for (int t = 0; t < nt; t += 2) {
            const bool last = (t == nt - 2);
            const char* a1 = cA + (size_t)(t + 1) * kstep;
            const char* a2 = last ? nA : cA + (size_t)(t + 2) * kstep; const char* b2 = last ? nB : cB + (size_t)(t + 2) * kstep;
            const char* a3 = a2 + kstep; const char* b3 = b2 + kstep;
            PG8_LDB(B0, 0, 0); SCHED_BAR(); PG8_LDA(At, 0, 0); PG8_STAGE_A(PG8_SA(1, 1), a1 + hstep, (size_t)(t + 1) * kstep, 1, false);
            WAIT_L(8); S_BARRIER(); WAIT_L(0); PG8_MMA(0, 0, At, B0); S_BARRIER(); SCHED_BAR();
            PG8_LDB(B1, 0, 1); PG8_STAGE(PG8_SB(0, 0), b2, voffB);
            S_BARRIER(); WAIT_L(0); PG8_MMA(0, 1, At, B1); S_BARRIER();
            PG8_LDA(At, 0, 1); PG8_STAGE_A(PG8_SA(0, 0), a2, (last ? (size_t)0 : (size_t)(t + 2) * kstep), 0, last);
            S_BARRIER(); WAIT_L(0); PG8_MMA(1, 0, At, B0); S_BARRIER(); SCHED_BAR();
            PG8_STAGE(PG8_SB(0, 1), b2 + hstep, voffB);
            WAIT_V(6); S_BARRIER(); PG8_MMA(1, 1, At, B1); S_BARRIER();
            PG8_LDB(B0, 1, 0); SCHED_BAR(); PG8_LDA(At, 1, 0); PG8_STAGE_A(PG8_SA(0, 1), a2 + hstep, (last ? (size_t)0 : (size_t)(t + 2) * kstep), 1, last);
            WAIT_L(8); S_BARRIER(); WAIT_L(0); PG8_MMA(0, 0, At, B0); S_BARRIER(); SCHED_BAR();
            PG8_LDB(B1, 1, 1); PG8_STAGE(PG8_SB(1, 0), b3, voffB);
            S_BARRIER(); WAIT_L(0); PG8_MMA(0, 1, At, B1); S_BARRIER();
            PG8_LDA(At, 1, 1); PG8_STAGE_A(PG8_SA(1, 0), a3, (last ? kstep : (size_t)(t + 3) * kstep), 0, last);
            S_BARRIER(); WAIT_L(0); PG8_MMA(1, 0, At, B0); S_BARRIER(); SCHED_BAR();
            PG8_STAGE(PG8_SB(1, 1), b3 + hstep, voffB);
            WAIT_V(6); S_BARRIER(); PG8_MMA(1, 1, At, B1); S_BARRIER();
        }
        if (wr == 0) S_BARRIER();
        E(acc, cur, wr, wc, fr, fq);
        if (!has_next) break;
#pragma unroll
        for (int a = 0; a < 2; ++a)
#pragma unroll
            for (int b = 0; b < 2; ++b)
#pragma unroll
                for (int m = 0; m < 4; ++m)
#pragma unroll
                    for (int n = 0; n < 2; ++n) acc[a][b][m][n] = (f32x4){0.f, 0.f, 0.f, 0.f};
        cur = nxt; cA = nA; cB = nB; ++ui;
        if constexpr (Sched::GATHER) {
#pragma unroll
            for (int h_ = 0; h_ < 2; ++h_) { va[h_][0] = vn[h_][0]; va[h_][1] = vn[h_][1]; } }
        if (wr == 1) S_BARRIER();
    }
    WAIT_V(0);
    S_BARRIER();
#undef PG8_SA
#undef PG8_SB
#undef PG8_STAGE
#undef PG8_STAGE_A
#undef PG8_GOFF
#undef PG8_LDA
#undef PG8_LDB
#undef PG8_MMA
}
}

__device__ __forceinline__ float row16_sum(float x) {
#ifdef EMU
    x += __shfl_xor(x, 1); x += __shfl_xor(x, 2); x += __shfl_xor(x, 4); x += __shfl_xor(x, 8); return x;
#else
#define DPPF(v, ctrl) __builtin_bit_cast(float, __builtin_amdgcn_update_dpp(0, __builtin_bit_cast(int, (v)), (ctrl), 0xF, 0xF, false))
    x += DPPF(x, 0xB1); x += DPPF(x, 0x4E); x += DPPF(x, 0x141); x += DPPF(x, 0x140); return x;
#undef DPPF
#endif
}
__device__ __forceinline__ float row32_sum(float x) {
    x = row16_sum(x);
#ifdef EMU
    x += __shfl_xor(x, 32); return x;
#else
    float a = x, b = x;
    asm volatile("s_nop 1\n\tv_permlane32_swap_b32 %0, %1" : "+v"(a), "+v"(b));
    return a + b;
#endif
}
__device__ __forceinline__ float wave_sum_fast(float x, int lane) {
    x = row32_sum(x);
    x += SHX(x, 16, lane);
    return x;
}
__device__ __forceinline__ void transpose_item(const float* W, int K, int N, bf16_t* WT, int k0, int n0, int dst_row0, float* scr, int lane) {
    const int n4 = (lane & 15) * 4, kr = lane >> 4;
#pragma unroll 8
    for (int i = 0; i < 16; ++i) {
        const int kk = 4 * i + kr;
        f32x4 v = (f32x4){0.f, 0.f, 0.f, 0.f};
        if (n0 + n4 < N) v = *(const f32x4*)(W + (size_t)(k0 + kk) * N + n0 + n4);
        float* d = scr + kk * 65 + n4; d[0] = v.x; d[1] = v.y; d[2] = v.z; d[3] = v.w;
    }
    WAVE_SYNC();
    const int c = lane & 7;
#pragma unroll
    for (int j = 0; j < 8; ++j) { const int n = (lane >> 3) + 8 * j; const float* sp = scr + (8 * c) * 65 + n;
        u32x4 o; o.x = pk2(sp[0 * 65], sp[1 * 65]); o.y = pk2(sp[2 * 65], sp[3 * 65]); o.z = pk2(sp[4 * 65], sp[5 * 65]); o.w = pk2(sp[6 * 65], sp[7 * 65]);
        *(u32x4*)(WT + (size_t)(dst_row0 + n) * K + k0 + 8 * c) = o; }
    WAVE_SYNC();
}
__device__ __forceinline__ void phase_prologue(const Params& P, unsigned char* smem, int wv) {
    ParamsPtr pp = PARAMS_PTR(P); PIN_S(pp); unsigned char* ws = pp->ws; int bidx = (int)blockIdx.x, gdim = (int)gridDim.x; PIN_S(bidx); PIN_S(gdim);
    const int tid = phase_tid(wv), lane = tid & 63, wave = tid >> 6;
    float* scr = (float*)smem + wave * (64 * 65);
    const int gw = bidx * NWAVES + wave, ngw = NWAVES * gdim;
    constexpr int I_IN = 16 * (PLD / 64), I_OUT = 16 * 16, I_W1 = NE * 16 * 32, I_W2 = NE * 16 * 16, I_L = I_IN + I_OUT + I_W1 + I_W2;
    for (int it = gw; it < NL * I_L; it += ngw) {
        const int l = it / I_L; int r = it % I_L;
        if (r < I_IN) { const int kb = r / (PLD / 64), nb = r % (PLD / 64);
            transpose_item(pp->in[1] + (size_t)l * D * PIN, D, PIN, (bf16_t*)(ws + O_WIN) + (size_t)l * PLD * D, kb * 64, nb * 64, nb * 64, scr, lane); continue; }
        r -= I_IN;
        if (r < I_OUT) { const int kb = r / 16, nb = r % 16;
            transpose_item(pp->in[21] + (size_t)l * D * D, D, D, (bf16_t*)(ws + O_WOUT) + (size_t)l * D * D, kb * 64, nb * 64, nb * 64, scr, lane); continue; }
        r -= I_OUT;
        if (r < I_W1) { const int e = r / (16 * 32), q = r % (16 * 32), kb = q / 32, nb = q % 32, n0 = nb * 64;
            const int dst = n0 < DFF ? (n0 / 128) * 256 + (n0 % 128) : ((n0 - DFF) / 128) * 256 + 128 + ((n0 - DFF) % 128);
            transpose_item(pp->in[26] + ((size_t)l * NE + e) * D * 2 * DFF, D, 2 * DFF, (bf16_t*)(ws + O_W1) + ((size_t)l * NE + e) * 2 * DFF * D, kb * 64, n0, dst, scr, lane); continue; }
        r -= I_W1;
        { const int e = r / (16 * 16), q = r % (16 * 16), kb = q / 16, nb = q % 16;
            transpose_item(pp->in[28] + ((size_t)l * NE + e) * DFF * D, DFF, D, (bf16_t*)(ws + O_W2) + ((size_t)l * NE + e) * D * DFF, kb * 64, nb * 64, nb * 64, scr, lane); }
    }
    {
        const float* gw_ = pp->in[4]; bf16_t* WSB = (bf16_t*)(ws + O_WSB);
        for (size_t i = ((size_t)bidx * NTHREADS + tid) * 4; i < (size_t)NL * GH * CH * CH; i += (size_t)gdim * NTHREADS * 4) {
            const f32x4 v = *(const f32x4*)(gw_ + i); u32x2 o; o.x = pk2(v.x, v.y); o.y = pk2(v.z, v.w); *(u32x2*)(WSB + i) = o;
        }
    }
    {
        bf16_t* LWT = (bf16_t*)(ws + O_LWT);
        for (int i = bidx * NTHREADS + tid; i < NL * 1920 * 128; i += gdim * NTHREADS) {
            const int k = i & 127, n = (i >> 7) % 1920, ll = i / (1920 * 128);
            float v = 0.f;
            if (n < 1536) { if (k < 64) { const int grp = n / 768, d = (n / 384) & 1, c = n % 384; v = (grp == 0 ? pp->in[8] : pp->in[10])[(((size_t)ll * 2 + d) * 64 + k) * RW + c]; } }
            else v = pp->in[11][((size_t)ll * 128 + k) * RW + (n - 1536)];
            LWT[i] = (bf16_t)f2bf(v);
        }
    }
    {
        bf16_t* RWT = (bf16_t*)(ws + O_RWT);
        for (int i = bidx * NTHREADS + tid; i < NL * NE * D; i += gdim * NTHREADS) {
            const int k = i % D, e = (i / D) % NE, ll = i / (D * NE);
            const float v = pp->in[24][((size_t)ll * D + k) * NE + e];
            const unsigned hi = f2bf(v); const float lo = v - bf_lo(hi);
            RWT[((size_t)(ll * 2 + 0) * NE + e) * D + k] = (bf16_t)hi; RWT[((size_t)(ll * 2 + 1) * NE + e) * D + k] = (bf16_t)f2bf(lo);
        }
    }
    const float* x = pp->in[0]; bf16_t* XB = (bf16_t*)(ws + O_XB);
    for (size_t i = ((size_t)bidx * NTHREADS + tid) * 4; i < (size_t)T * D; i += (size_t)gdim * NTHREADS * 4) {
        const f32x4 v = *(const f32x4*)(x + i); u32x2 o; o.x = pk2(v.x, v.y); o.y = pk2(v.z, v.w); *(u32x2*)(XB + i) = o;
    }
}

__device__ __forceinline__ float tshift(const float* P, int t, int s, int col, const float* mu0, const float* mu1, int rc) {
    const float cur = P[(size_t)t * PLD + col];
    const float prv = s > 0 ? P[(size_t)(t - 1) * PLD + col] : 0.f;
    const float nxt = s < S - 1 ? P[(size_t)(t + 1) * PLD + col] : 0.f;
    return cur + mu0[rc] * (prv - cur) + mu1[rc] * (nxt - cur);
}

__device__ __forceinline__ void phase_prep(const Params& P, int l, unsigned char* smem, int wv) {
    ParamsPtr pp = PARAMS_PTR(P); PIN_S(pp); unsigned char* ws = pp->ws; int bidx = (int)blockIdx.x, gdim = (int)gridDim.x; PIN_S(bidx); PIN_S(gdim);
    const bf16_t* proj = (const bf16_t*)(ws + O_PROJ); const float* projg = (const float*)(ws + O_PROJG);
    float* UG = (float*)(ws + O_UG); bf16_t* VNT = (bf16_t*)(ws + O_VNT);
    float* RR = (float*)(ws + O_RR); float* VV = (float*)(ws + O_VV); float* KK = (float*)(ws + O_KK);
    float* KD = (float*)(ws + O_KD); float* ICLR = (float*)(ws + O_ICLR);
    float* GATE = (float*)(ws + O_GATE); float* BONUS = (float*)(ws + O_BONUS); float* LWG = (float*)(ws + O_LW);
    bf16_t* RB = (bf16_t*)(ws + O_RB); bf16_t* VB = (bf16_t*)(ws + O_VB); bf16_t* KKB = (bf16_t*)(ws + O_KKB); bf16_t* BBB = (bf16_t*)(ws + O_BBB); bf16_t* KDB = (bf16_t*)(ws + O_KDB);
#if !MK_RWKV_CHUNKED
    float* DEC = (float*)(ws + O_DEC); float* BRKR = (float*)(ws + O_BRKR);
#endif
    bf16_t* MQB = (bf16_t*)(ws + O_MQB); bf16_t* MKB = (bf16_t*)(ws + O_MKB); bf16_t* KT = (bf16_t*)(ws + O_KT); bf16_t* VT = (bf16_t*)(ws + O_VT);
    float* IG = (float*)(ws + O_IG); float* LF = (float*)(ws + O_LF);
    const bf16_t* LWT = (const bf16_t*)(ws + O_LWT) + (size_t)l * 1920 * 128;
    const float* gln_g = pp->in[2] + (size_t)l * GW; const float* gln_b = pp->in[3] + (size_t)l * GW;
    const float* mu0 = pp->in[6] + (size_t)l * 2 * RPROJ; const float* mu1 = mu0 + RPROJ;
    const float* w0 = pp->in[7] + (size_t)l * 2 * RW; const float* a0 = pp->in[9] + (size_t)l * 2 * RW;
    const float* k_k = pp->in[12] + (size_t)l * RW; const float* k_a = pp->in[13] + (size_t)l * RW; const float* r_k = pp->in[14] + (size_t)l * RW;
    const float* conv_w = pp->in[17] + (size_t)l * 3 * 768; const float* conv_b = pp->in[18] + (size_t)l * 768; const float* gate_b = pp->in[19] + (size_t)l * 24;
    float* win = (float*)smem;
    bf16_t* lin = (bf16_t*)(smem + 101376);
    bf16_t* tvn = (bf16_t*)(smem + 110592);
    bf16_t* tk = (bf16_t*)(smem + 118784);
    bf16_t* tv = (bf16_t*)(smem + 131072);
    constexpr int LIN = 264;
    const int tid = phase_tid(wv), lane = tid & 63, wave = tid >> 6, col = lane & 15, g = lane >> 4;
    for (int u = bidx; u < T / 16; u += gdim) {
        const int t0 = u * 16, s0 = t0 % S, bb = t0 / S;
        __syncthreads();
        {
            u32x2 wb[18];
#pragma unroll
            for (int row = 0; row < 18; ++row) {
                const int sq = s0 - 1 + row;
                wb[row] = (u32x2){0u, 0u};
                if (sq >= 0 && sq < S && tid < 352) wb[row] = *(const u32x2*)(proj + (size_t)(t0 - 1 + row) * PLD + C_RW + tid * 4);
            }
            if (tid < 352) {
#pragma unroll
                for (int row = 0; row < 18; ++row) *(f32x4*)(win + row * RPROJ + tid * 4) = (f32x4){bf_lo(wb[row].x), bf_hi(wb[row].x), bf_lo(wb[row].y), bf_hi(wb[row].y)};
            }
        }
        for (int rep_ = 0; rep_ < (MK_PROBE == 3 ? 2 : 1); ++rep_) {
            const int i = tid >> 5, l32 = tid & 31, t = t0 + i;
            float v[8], ug[8]; float sum = 0.f;
#pragma unroll
            for (int j = 0; j < 8; ++j) { const int c = j * 32 + l32; ug[j] = bf_lo((unsigned)proj[(size_t)t * PLD + c]); v[j] = bf_lo((unsigned)proj[(size_t)t * PLD + GW + c]); }
#pragma unroll
            for (int j = 0; j < 8; ++j) { const int c = j * 32 + l32; UG[(size_t)t * GW + c] = geluf_(ug[j]); v[j] = geluf_(v[j]); sum += v[j]; }
#pragma unroll
            for (int o = 16; o >= 1; o >>= 1) sum += SHX(sum, o, lane);
            const float mean = sum * (1.0f / GW); float q = 0.f;
#pragma unroll
            for (int j = 0; j < 8; ++j) { const float d = v[j] - mean; q += d * d; }
#pragma unroll
            for (int o = 16; o >= 1; o >>= 1) q += SHX(q, o, lane);
            const float rstd = 1.0f / sqrtf(q * (1.0f / GW) + LN_EPS);
#pragma unroll
            for (int j = 0; j < 8; ++j) { const int c = j * 32 + l32; tvn[c * 16 + i] = (bf16_t)f2bf((v[j] - mean) * rstd * gln_g[c] + gln_b[c]); }
        }
        __syncthreads();
        {
            const int hf = tid & 1, c = tid >> 1;
            *(u32x4*)(VNT + ((size_t)bb * GW + c) * S + s0 + hf * 8) = *(const u32x4*)(tvn + c * 16 + hf * 8);
        }
        for (int idx = tid; idx < 16 * 256; idx += NTHREADS) {
            const int i = idx >> 8, j = idx & 255, rc = 1152 + j;
            const float pv = win[i * RPROJ + rc], cv = win[(i + 1) * RPROJ + rc], nv = win[(i + 2) * RPROJ + rc];
            const float x = cv + mu0[rc] * (pv - cv) + mu1[rc] * (nv - cv);
            lin[i * LIN + j] = (bf16_t)f2bf(j < 64 ? ftanh(x) : (j < 128 ? x : sigmoidf_(x)));
        }
        __syncthreads();
        for (int rep_ = 0; rep_ < (MK_PROBE == 1 ? 2 : 1); ++rep_) {
#pragma unroll 1
            for (int qg = 0; qg < 3; ++qg) {
                bf16x8 bw_[5][4]; float bias_[5];
#pragma unroll
                for (int q5 = 0; q5 < 5; ++q5) {
                    const int nt = wave * 15 + qg * 5 + q5, grp = nt / 24, c = (nt % 24) * 16 + col;
                    const bf16_t* bw = LWT + (size_t)(nt * 16 + col) * 128 + 8 * g;
#pragma unroll
                    for (int ks = 0; ks < 2; ++ks) bw_[q5][ks] = *(const bf16x8*)(bw + ks * 32);
                    if (grp == 4) {
#pragma unroll
                        for (int ks = 2; ks < 4; ++ks) bw_[q5][ks] = *(const bf16x8*)(bw + ks * 32);
                    }
                    bias_[q5] = grp < 2 ? w0[grp * RW + c] : (grp < 4 ? a0[(grp - 2) * RW + c] : 0.f);
                }
#pragma unroll
                for (int q5 = 0; q5 < 5; ++q5) {
                    const int nt = wave * 15 + qg * 5 + q5, grp = nt / 24, c = (nt % 24) * 16 + col;
                    const int kcol = grp < 2 ? 0 : (grp < 4 ? 64 : 128);
                    f32x4 acc = (f32x4){0.f, 0.f, 0.f, 0.f};
#pragma unroll
                    for (int ks = 0; ks < 2; ++ks) acc = MFMA16(*(const bf16x8*)(lin + col * LIN + kcol + ks * 32 + 8 * g), bw_[q5][ks], acc);
                    if (grp == 4) {
#pragma unroll
                        for (int ks = 2; ks < 4; ++ks) acc = MFMA16(*(const bf16x8*)(lin + col * LIN + kcol + ks * 32 + 8 * g), bw_[q5][ks], acc);
                    }
                    if (grp < 2) {
#pragma unroll
                        for (int r = 0; r < 4; ++r) { const float lw = -fexp(-softplusf_(-(acc[r] + bias_[q5])) - 0.5f); const size_t o = (size_t)grp * T * RW + (size_t)(t0 + 4 * g + r) * RW + c; LWG[o] = lw;
#if !MK_RWKV_CHUNKED
                            DEC[o] = expf(lw);
#endif
                        }
                    } else if (grp < 4) {
#pragma unroll
                        for (int r = 0; r < 4; ++r) ICLR[(size_t)(grp - 2) * T * RW + (size_t)(t0 + 4 * g + r) * RW + c] = sigmoidf_(acc[r] + bias_[q5]);
                    } else {
#pragma unroll
                        for (int r = 0; r < 4; ++r) GATE[(size_t)(t0 + 4 * g + r) * RW + c] = acc[r];
                    }
                }
            }
        }
        __syncthreads();
        for (int rep_ = 0; rep_ < (MK_PROBE == 2 ? 2 : 1); ++rep_) if (wave < 6) {
            const int c = tid, h = wave;
            const float kkc = k_k[c], kac = k_a[c], rkc = r_k[c];
            const float m0r = mu0[c], m1r = mu1[c], m0k = mu0[RW + c], m1k = mu1[RW + c], m0v = mu0[2 * RW + c], m1v = mu1[2 * RW + c];
            float ic0[16], ic1[16];
#pragma unroll
            for (int i = 0; i < 16; ++i) { const size_t o = (size_t)(t0 + i) * RW + c; ic0[i] = ICLR[o]; ic1[i] = ICLR[(size_t)T * RW + o]; }
#pragma unroll
            for (int i = 0; i < 16; ++i) {
                const int t = t0 + i;
                const float* w_ = win + i * RPROJ + c;
                const float rp = w_[0], rc_ = w_[RPROJ], rn = w_[2 * RPROJ];
                const float kp = w_[RW], kc_ = w_[RPROJ + RW], kn = w_[2 * RPROJ + RW];
                const float vp = w_[2 * RW], vc_ = w_[RPROJ + 2 * RW], vn = w_[2 * RPROJ + 2 * RW];
                const float r = rc_ + m0r * (rp - rc_) + m1r * (rn - rc_);
                const float k = kc_ + m0k * (kp - kc_) + m1k * (kn - kc_);
                const float v = vc_ + m0v * (vp - vc_) + m1v * (vn - vc_);
                const size_t o = (size_t)t * RW + c;
                const float kq = k * kkc;
                const float n2 = wave_sum_fast(kq * kq, lane);
                const float kk = kq / fmaxf(sqrtf(n2), 1e-12f);
                const float kd0 = k * (1.0f + (ic0[i] - 1.0f) * kac), kd1 = k * (1.0f + (ic1[i] - 1.0f) * kac);
                const float bon = wave_sum_fast(r * (kd0 + kd1) * rkc, lane);
#if MK_RWKV_CHUNKED
                RB[o] = (bf16_t)f2bf(r); VB[o] = (bf16_t)f2bf(v); KKB[o] = (bf16_t)f2bf(kk);
                BBB[o] = (bf16_t)f2bf(kk * ic0[i]); BBB[(size_t)T * RW + o] = (bf16_t)f2bf(kk * ic1[i]);
                KDB[o] = (bf16_t)f2bf(kd0); KDB[(size_t)T * RW + o] = (bf16_t)f2bf(kd1);
#else
                RR[o] = r; VV[o] = v; KK[o] = kk;
                KD[o] = kd0; KD[(size_t)T * RW + o] = kd1;
#endif
                if (lane == 0) BONUS[(size_t)t * RH + h] = bon;
#if !MK_RWKV_CHUNKED
                { const float br0 = wave_sum(kk * ic0[i] * r, lane), br1 = wave_sum(kk * ic1[i] * r, lane), kr0 = wave_sum(kd0 * r, lane), kr1 = wave_sum(kd1 * r, lane);
                  if (lane == 0) { BRKR[((size_t)t * RH + h) * 2] = br0; BRKR[((size_t)t * RH + h) * 2 + 1] = kr0; BRKR[((size_t)(T + t) * RH + h) * 2] = br1; BRKR[((size_t)(T + t) * RH + h) * 2 + 1] = kr1; } }
#endif
            }
        }
        __syncthreads();
        {
            u32x2 wb[9], vb[3];
            const int rsel = tid >= 192 ? 1 : 0, c4 = tid - rsel * 192;
#pragma unroll
            for (int it = 0; it < 9; ++it) {
                const int row = 2 * it + rsel, sq = s0 - 1 + row;
                wb[it] = (u32x2){0u, 0u};
                if (tid < 384 && sq >= 0 && sq < S) wb[it] = *(const u32x2*)(proj + (size_t)(t0 - 1 + row) * PLD + C_MW + c4 * 4);
            }
#pragma unroll
            for (int it = 0; it < 3; ++it) { const int idx = tid + it * NTHREADS, i = idx / 96, cc = (idx % 96) * 4; vb[it] = *(const u32x2*)(proj + (size_t)(t0 + i) * PLD + C_MW + 2 * MW + cc); }
            if (tid < 384) {
#pragma unroll
                for (int it = 0; it < 9; ++it) *(f32x4*)(win + (2 * it + rsel) * 768 + c4 * 4) = (f32x4){bf_lo(wb[it].x), bf_hi(wb[it].x), bf_lo(wb[it].y), bf_hi(wb[it].y)};
            }
#pragma unroll
            for (int it = 0; it < 3; ++it) { const int idx = tid + it * NTHREADS, i = idx / 96, cc = (idx % 96) * 4; const u32x2 v = vb[it];
                tv[(cc + 0) * 16 + i] = (bf16_t)(v.x & 0xffffu); tv[(cc + 1) * 16 + i] = (bf16_t)(v.x >> 16); tv[(cc + 2) * 16 + i] = (bf16_t)(v.y & 0xffffu); tv[(cc + 3) * 16 + i] = (bf16_t)(v.y >> 16); }
        }
        for (int idx = tid; idx < 16 * 24; idx += NTHREADS) {
            const int i = idx / 24, gi = idx % 24, t = t0 + i;
            const int isf = gi / 12, dir = (gi / 6) & 1, h = gi % 6;
            const float gg = projg[(size_t)t * 256 + (3456 - (PLD - 256)) + gi] + gate_b[gi];
            if (isf) LF[((size_t)dir * T + t) * MH + h] = -softplusf_(-gg); else IG[((size_t)dir * T + t) * MH + h] = gg;
        }
        __syncthreads();
        for (int rep_ = 0; rep_ < (MK_PROBE == 4 ? 2 : 1); ++rep_)
        for (int idx = tid; idx < 16 * 768; idx += NTHREADS) {
            const int i = idx / 768, c = idx % 768, t = t0 + i;
            const float* w_ = win + i * 768 + c;
            float y = conv_b[c] + w_[0] * conv_w[c] + w_[768] * conv_w[768 + c] + w_[1536] * conv_w[2 * 768 + c];
            y = y * sigmoidf_(y);
            if (c < MW) MQB[(size_t)t * MW + c] = (bf16_t)f2bf(y);
            else { const bf16_t kb = (bf16_t)f2bf(y * 0.125f); MKB[(size_t)t * MW + (c - MW)] = kb; tk[(c - MW) * 16 + i] = kb; }
        }
        __syncthreads();
        for (int idx = tid; idx < 2 * MW * 2; idx += NTHREADS) {
            const int hf = idx & 1, c = (idx >> 1) % MW, which = idx / (2 * MW);
            const u32x4 val = *(const u32x4*)((which ? tv : tk) + c * 16 + hf * 8);
            bf16_t* dst = (which ? VT : KT) + ((size_t)(bb * MH) * 64 + c) * S + s0 + hf * 8;
            *(u32x4*)dst = val;
        }
    }
    __syncthreads();
}

__device__ __forceinline__ void phase_prep32(const Params& P, int l, unsigned char* smem, int wv) {
    ParamsPtr pp = PARAMS_PTR(P); PIN_S(pp); unsigned char* ws = pp->ws; int bidx = (int)blockIdx.x, gdim = (int)gridDim.x; PIN_S(bidx); PIN_S(gdim);
    const bf16_t* proj = (const bf16_t*)(ws + O_PROJ); const float* projg = (const float*)(ws + O_PROJG);
    float* UG = (float*)(ws + O_UG); bf16_t* VNT = (bf16_t*)(ws + O_VNT);
    u32x4* RK7 = (u32x4*)(ws + O_RK7);
    float* GATE = (float*)(ws + O_GATE); float* BONUS = (float*)(ws + O_BONUS); float* LWG = (float*)(ws + O_LW);
    bf16_t* VB = (bf16_t*)(ws + O_VB);
    bf16_t* MQB = (bf16_t*)(ws + O_MQB); bf16_t* MKB = (bf16_t*)(ws + O_MKB); bf16_t* KT = (bf16_t*)(ws + O_KT); bf16_t* VT = (bf16_t*)(ws + O_VT);
    float* IG = (float*)(ws + O_IG); float* LF = (float*)(ws + O_LF);
    const bf16_t* LWT = (const bf16_t*)(ws + O_LWT) + (size_t)l * 1920 * 128;
    const float* gln_g = pp->in[2] + (size_t)l * GW; const float* gln_b = pp->in[3] + (size_t)l * GW;
    const float* mu0 = pp->in[6] + (size_t)l * 2 * RPROJ; const float* mu1 = mu0 + RPROJ;
    const float* w0 = pp->in[7] + (size_t)l * 2 * RW; const float* a0 = pp->in[9] + (size_t)l * 2 * RW;
    const float* k_k = pp->in[12] + (size_t)l * RW; const float* k_a = pp->in[13] + (size_t)l * RW; const float* r_k = pp->in[14] + (size_t)l * RW;
    const float* conv_w = pp->in[17] + (size_t)l * 3 * 768; const float* conv_b = pp->in[18] + (size_t)l * 768; const float* gate_b = pp->in[19] + (size_t)l * 24;
    constexpr int TOK = 32, WR = TOK + 2, LIN = 264;
    bf16_t* winb = (bf16_t*)smem;
    bf16_t* lin = (bf16_t*)(smem + 95744);
    bf16_t* tk = (bf16_t*)(smem + 112640);
    bf16_t* tv = (bf16_t*)(smem + 137216);
    bf16_t* tvn = tk;
    bf16_t* icl = tk;
    const int tid = phase_tid(wv), lane = tid & 63, wave = tid >> 6, col = lane & 15, g = lane >> 4;
    for (int u = bidx; u < T / TOK; u += gdim) {
        const int t0 = u * TOK, s0 = t0 % S, bb = t0 / S;
        __syncthreads();
#pragma unroll 1
        for (int hb = 0; hb < 2; ++hb) {
            u32x2 wb[17];
#pragma unroll
            for (int q = 0; q < 17; ++q) {
                const int row = hb * 17 + q, sq = s0 - 1 + row;
                wb[q] = (u32x2){0u, 0u};
                if (sq >= 0 && sq < S && tid < 352) wb[q] = *(const u32x2*)(proj + (size_t)(t0 - 1 + row) * PLD + C_RW + tid * 4);
            }
            if (tid < 352) {
#pragma unroll
                for (int q = 0; q < 17; ++q) *(u32x2*)(winb + (hb * 17 + q) * RPROJ + tid * 4) = wb[q];
            }
        }
#pragma unroll 1
        for (int ps = 0; ps < 2; ++ps) {
            const int i = ps * 16 + (tid >> 5), l32 = tid & 31, t = t0 + i;
            float v[8], ug[8]; float sum = 0.f;
#pragma unroll
            for (int j = 0; j < 8; ++j) { const int c = j * 32 + l32; ug[j] = bf_lo((unsigned)proj[(size_t)t * PLD + c]); v[j] = bf_lo((unsigned)proj[(size_t)t * PLD + GW + c]); }
#pragma unroll
            for (int j = 0; j < 8; ++j) { const int c = j * 32 + l32; UG[(size_t)t * GW + c] = geluf_(ug[j]); v[j] = geluf_(v[j]); sum += v[j]; }
#pragma unroll
            for (int o = 16; o >= 1; o >>= 1) sum += SHX(sum, o, lane);
            const float mean = sum * (1.0f / GW); float q = 0.f;
#pragma unroll
            for (int j = 0; j < 8; ++j) { const float d = v[j] - mean; q += d * d; }
#pragma unroll
            for (int o = 16; o >= 1; o >>= 1) q += SHX(q, o, lane);
            const float rstd = 1.0f / sqrtf(q * (1.0f / GW) + LN_EPS);
#pragma unroll
            for (int j = 0; j < 8; ++j) { const int c = j * 32 + l32; tvn[c * TOK + i] = (bf16_t)f2bf((v[j] - mean) * rstd * gln_g[c] + gln_b[c]); }
        }
        __syncthreads();
#pragma unroll
        for (int q = 0; q < 2; ++q) {
            const int idx = tid + q * NTHREADS, c = idx >> 2, pc = idx & 3;
            *(u32x4*)(VNT + ((size_t)bb * GW + c) * S + s0 + pc * 8) = *(const u32x4*)(tvn + c * TOK + pc * 8);
        }
        int tb2 = tid; PIN_V(tb2);
#pragma unroll 4
        for (int q = 0; q < 16; ++q) {
            const int idx = tb2 + q * NTHREADS, i = idx >> 8, j = idx & 255, rc = 1152 + j;
            const float pv = bf_lo((unsigned)winb[i * RPROJ + rc]), cv = bf_lo((unsigned)winb[(i + 1) * RPROJ + rc]), nv = bf_lo((unsigned)winb[(i + 2) * RPROJ + rc]);
            const float x = cv + mu0[rc] * (pv - cv) + mu1[rc] * (nv - cv);
            lin[i * LIN + j] = (bf16_t)f2bf(j < 64 ? ftanh(x) : (j < 128 ? x : sigmoidf_(x)));
        }
        __syncthreads();
#pragma unroll 1
        for (int qg = 0; qg < 3; ++qg) {
            bf16x8 bw_[5][4]; float bias_[5];
#pragma unroll
            for (int q5 = 0; q5 < 5; ++q5) {
                const int nt = wave * 15 + qg * 5 + q5, grp = nt / 24, c = (nt % 24) * 16 + col;
                const bf16_t* bw = LWT + (size_t)(nt * 16 + col) * 128 + 8 * g;
#pragma unroll
                for (int ks = 0; ks < 2; ++ks) bw_[q5][ks] = *(const bf16x8*)(bw + ks * 32);
                if (grp == 4) {
#pragma unroll
                    for (int ks = 2; ks < 4; ++ks) bw_[q5][ks] = *(const bf16x8*)(bw + ks * 32);
                }
                bias_[q5] = grp < 2 ? w0[grp * RW + c] : (grp < 4 ? a0[(grp - 2) * RW + c] : 0.f);
            }
#pragma unroll
            for (int q5 = 0; q5 < 5; ++q5) {
                const int nt = wave * 15 + qg * 5 + q5, grp = nt / 24, c = (nt % 24) * 16 + col;
                const int kcol = grp < 2 ? 0 : (grp < 4 ? 64 : 128);
#pragma unroll
                for (int mt = 0; mt < 2; ++mt) {
                    f32x4 acc = (f32x4){0.f, 0.f, 0.f, 0.f};
                    const bf16_t* la = lin + (mt * 16 + col) * LIN + kcol + 8 * g;
#pragma unroll
                    for (int ks = 0; ks < 2; ++ks) acc = MFMA16(*(const bf16x8*)(la + ks * 32), bw_[q5][ks], acc);
                    if (grp == 4) {
#pragma unroll
                        for (int ks = 2; ks < 4; ++ks) acc = MFMA16(*(const bf16x8*)(la + ks * 32), bw_[q5][ks], acc);
                    }
                    const size_t tb = (size_t)(t0 + mt * 16 + 4 * g);
                    if (grp < 2) {
#pragma unroll
                        for (int r = 0; r < 4; ++r) acc[r] = -fexp(-softplusf_(-(acc[r] + bias_[q5])) - 0.5f);
                        *(f32x4*)(LWG + (size_t)grp * T * RW + ((tb >> 2) * RW + c) * 4) = acc;
                    } else if (grp < 4) {
#pragma unroll
                        for (int r = 0; r < 4; ++r) icl[((grp - 2) * TOK + mt * 16 + 4 * g + r) * RW + c] = (bf16_t)f2bf(sigmoidf_(acc[r] + bias_[q5]));
                    } else {
#pragma unroll
                        for (int r = 0; r < 4; ++r) GATE[(tb + r) * RW + c] = acc[r];
                    }
                }
            }
        }
        __syncthreads();
        if (wave < 6) {
            int c = tid; PIN_V(c); const int h = wave;
            const float kkc = k_k[c], kac = k_a[c], rkc = r_k[c];
            const float m0r = mu0[c], m1r = mu1[c], m0k = mu0[RW + c], m1k = mu1[RW + c], m0v = mu0[2 * RW + c], m1v = mu1[2 * RW + c];
#pragma unroll 1
            for (int hb = 0; hb < 2; ++hb) {
                float ic0[16], ic1[16];
#pragma unroll
                for (int i = 0; i < 16; ++i) { ic0[i] = bf_lo((unsigned)icl[(hb * 16 + i) * RW + c]); ic1[i] = bf_lo((unsigned)icl[(TOK + hb * 16 + i) * RW + c]); }
#pragma unroll
                for (int i = 0; i < 16; ++i) {
                    const int it = hb * 16 + i, t = t0 + it;
                    const bf16_t* w_ = winb + it * RPROJ + c;
                    const float rp = bf_lo((unsigned)w_[0]), rc_ = bf_lo((unsigned)w_[RPROJ]), rn = bf_lo((unsigned)w_[2 * RPROJ]);
                    const float kp = bf_lo((unsigned)w_[RW]), kc_ = bf_lo((unsigned)w_[RPROJ + RW]), kn = bf_lo((unsigned)w_[2 * RPROJ + RW]);
                    const float vp = bf_lo((unsigned)w_[2 * RW]), vc_ = bf_lo((unsigned)w_[RPROJ + 2 * RW]), vn = bf_lo((unsigned)w_[2 * RPROJ + 2 * RW]);
                    const float r = rc_ + m0r * (rp - rc_) + m1r * (rn - rc_);
                    const float k = kc_ + m0k * (kp - kc_) + m1k * (kn - kc_);
                    const float v = vc_ + m0v * (vp - vc_) + m1v * (vn - vc_);
                    const size_t o = (size_t)t * RW + c;
                    const float kq = k * kkc;
                    const float n2 = wave_sum_fast(kq * kq, lane);
                    const float kk = kq / fmaxf(sqrtf(n2), 1e-12f);
                    const float kd0 = k * (1.0f + (ic0[i] - 1.0f) * kac), kd1 = k * (1.0f + (ic1[i] - 1.0f) * kac);
                    const float bon = wave_sum_fast(r * (kd0 + kd1) * rkc, lane);
                    u32x4 rec; rec.x = pk2(r, v); rec.y = pk2(kk, 0.f); rec.z = pk2(kk * ic0[i], kk * ic1[i]); rec.w = pk2(kd0, kd1);
                    RK7[o] = rec;
                    VB[o] = (bf16_t)(rec.x >> 16);
                    if (lane == 0) BONUS[(size_t)t * RH + h] = bon;
                }
            }
        }
        __syncthreads();
        {
            u32x2 wb[17], vb[6];
            const int rsel = tid >= 192 ? 1 : 0, c4 = tid - rsel * 192;
#pragma unroll
            for (int q = 0; q < 17; ++q) {
                const int row = 2 * q + rsel, sq = s0 - 1 + row;
                wb[q] = (u32x2){0u, 0u};
                if (tid < 384 && sq >= 0 && sq < S) wb[q] = *(const u32x2*)(proj + (size_t)(t0 - 1 + row) * PLD + C_MW + c4 * 4);
            }
#pragma unroll
            for (int q = 0; q < 6; ++q) { const int idx = tid + q * NTHREADS, i = idx / 96, cc = (idx % 96) * 4; vb[q] = *(const u32x2*)(proj + (size_t)(t0 + i) * PLD + C_MW + 2 * MW + cc); }
            if (tid < 384) {
#pragma unroll
                for (int q = 0; q < 17; ++q) *(u32x2*)(winb + (2 * q + rsel) * 768 + c4 * 4) = wb[q];
            }
#pragma unroll
            for (int q = 0; q < 6; ++q) { const int idx = tid + q * NTHREADS, i = idx / 96, cc = (idx % 96) * 4; const u32x2 v = vb[q];
                tv[(cc + 0) * TOK + i] = (bf16_t)(v.x & 0xffffu); tv[(cc + 1) * TOK + i] = (bf16_t)(v.x >> 16); tv[(cc + 2) * TOK + i] = (bf16_t)(v.y & 0xffffu); tv[(cc + 3) * TOK + i] = (bf16_t)(v.y >> 16); }
        }
        for (int idx = tid; idx < TOK * 24; idx += NTHREADS) {
            const int i = idx / 24, gi = idx % 24, t = t0 + i;
            const int isf = gi / 12, dir = (gi / 6) & 1, h = gi % 6;
            const float gg = projg[(size_t)t * 256 + (3456 - (PLD - 256)) + gi] + gate_b[gi];
            if (isf) LF[((size_t)dir * T + t) * MH + h] = -softplusf_(-gg); else IG[((size_t)dir * T + t) * MH + h] = gg;
        }
        __syncthreads();
        int tcv = tid; PIN_V(tcv);
#pragma unroll 4
        for (int q = 0; q < 24; ++q) {
            const int idx = tcv + q * NTHREADS, i = idx / 384, c = (idx % 384) * 2, t = t0 + i;
            const bf16_t* w_ = winb + i * 768 + c;
            const unsigned x0 = *(const unsigned*)w_, x1 = *(const unsigned*)(w_ + 768), x2 = *(const unsigned*)(w_ + 1536);
            float ya = conv_b[c] + bf_lo(x0) * conv_w[c] + bf_lo(x1) * conv_w[768 + c] + bf_lo(x2) * conv_w[2 * 768 + c];
            float yb = conv_b[c + 1] + bf_hi(x0) * conv_w[c + 1] + bf_hi(x1) * conv_w[768 + c + 1] + bf_hi(x2) * conv_w[2 * 768 + c + 1];
            ya = ya * sigmoidf_(ya); yb = yb * sigmoidf_(yb);
            if (c < MW) *(unsigned*)(MQB + (size_t)t * MW + c) = pk2(ya, yb);
            else { const unsigned kb2 = pk2(ya * 0.125f, yb * 0.125f); *(unsigned*)(MKB + (size_t)t * MW + (c - MW)) = kb2; tk[(c - MW) * TOK + i] = (bf16_t)(kb2 & 0xffffu); tk[(c - MW + 1) * TOK + i] = (bf16_t)(kb2 >> 16); }
        }
        __syncthreads();
#pragma unroll
        for (int q = 0; q < 6; ++q) {
            const int idx = tid + q * NTHREADS, pc = idx & 3, c = (idx >> 2) % MW, which = idx / (4 * MW);
            const u32x4 val = *(const u32x4*)((which ? tv : tk) + c * TOK + pc * 8);
            bf16_t* dst = (which ? VT : KT) + ((size_t)(bb * MH) * 64 + c) * S + s0 + pc * 8;
            *(u32x4*)dst = val;
        }
    }
    __syncthreads();
}

__device__ __forceinline__ void phase_gmlp_mix(const Params& P, int l, unsigned char* smem, int wv, int bid, int nb) {
    PIN_S(bid); PIN_S(nb);
    ParamsPtr pp = PARAMS_PTR(P); PIN_S(pp); unsigned char* ws = pp->ws;
    const float* UG = (const float*)(ws + O_UG); const bf16_t* VNT = (const bf16_t*)(ws + O_VNT); bf16_t* GRP = (bf16_t*)(ws + O_GRP);
    const bf16_t* WSB = (const bf16_t*)(ws + O_WSB) + (size_t)l * GH * CH * CH; const float* gbs = pp->in[5] + (size_t)l * GH * CH;
    const int tid = phase_tid(wv), lane = tid & 63, wave = tid >> 6, col = lane & 15, g = lane >> 4;
    for (int u = bid; u < NB * NCH * GH; u += nb) {
        const int h = u % GH, c = (u / GH) % NCH, b = u / (GH * NCH);
        const int tok0 = b * S + c * CH;
        const bf16_t* wb = WSB + (size_t)h * CH * CH + (size_t)(wave * 16 + col) * CH + 8 * g;
        const bf16_t* vb = VNT + ((size_t)b * GW + h * 64 + col) * S + (size_t)c * CH + 8 * g;
        f32x4 acc[4];
#pragma unroll
        for (int et = 0; et < 4; ++et) acc[et] = (f32x4){0.f, 0.f, 0.f, 0.f};
#pragma unroll
        for (int ks = 0; ks < 4; ++ks) {
            const bf16x8 af = *(const bf16x8*)(wb + ks * 32);
#pragma unroll
            for (int et = 0; et < 4; ++et) acc[et] = MFMA16(af, *(const bf16x8*)(vb + (size_t)et * 16 * S + ks * 32), acc[et]);
        }
#pragma unroll
        for (int r = 0; r < 4; ++r) {
            const int p = wave * 16 + 4 * g + r; const size_t t = (size_t)(tok0 + p); const float bsv = gbs[h * CH + p];
#pragma unroll
            for (int et = 0; et < 4; ++et) { const int ch = h * 64 + et * 16 + col; GRP[t * D + ch] = (bf16_t)f2bf(UG[t * GW + ch] * (acc[et][r] + bsv)); }
        }
    }
}

constexpr int SC_STEPS = 16;
constexpr int SC_BUF = SC_STEPS * 6 * 64;
__device__ __forceinline__ void phase_rwkv_scan(const Params& P, int l, unsigned char* smem, int wv, int bid, int nb) {
    PIN_S(bid); PIN_S(nb);
    ParamsPtr pp = PARAMS_PTR(P); PIN_S(pp); unsigned char* ws = pp->ws;
    const float* RR = (const float*)(ws + O_RR); const float* VV = (const float*)(ws + O_VV); const float* KK = (const float*)(ws + O_KK);
    const float* DEC = (const float*)(ws + O_DEC); const float* KD = (const float*)(ws + O_KD); const float* ICLR = (const float*)(ws + O_ICLR);
    float* SCAN = (float*)(ws + O_SCAN); const float* BRKR = (const float*)(ws + O_BRKR);
    const int tid = phase_tid(wv), lane = tid & 63, wave = tid >> 6, rl = (lane >> 4) & 1, kq = (lane & 15) | ((lane >> 5) << 4);
    float* buf = (float*)smem;
    float* scal = buf + 2 * SC_BUF;
    float* outb = scal + 2 * SC_STEPS * 2;
    typedef float f32x2 __attribute__((ext_vector_type(2)));
    for (int u = bid; u < 2 * NB * RH * 4; u += nb) {
        const int qt = u & 3, h = (u >> 2) % RH, b = (u / (4 * RH)) % NB, d = u / (4 * RH * NB);
        const size_t doff = (size_t)d * T * RW;
        float s0 = 0.f, s1 = 0.f;
        float pw[2], pa[2], pb[2], pk[2], pr[2], pv[2], psc = 0.f;
#define SC_LOAD(c) do { _Pragma("unroll") for (int i = 0; i < 2; ++i) { const int idx = tid + NTHREADS * i, st = idx >> 6, k = idx & 63; const int tau = (c) * SC_STEPS + st, sq = d ? S - 1 - tau : tau; \
            const size_t o = (size_t)(b * S + sq) * RW + h * 64 + k; \
            pw[i] = DEC[doff + o]; pa[i] = KK[o]; pb[i] = ICLR[doff + o]; pk[i] = KD[doff + o]; pr[i] = RR[o]; pv[i] = VV[o]; }     \
            if (tid < 2 * SC_STEPS) { const int tau = (c) * SC_STEPS + (tid >> 1), sq = d ? S - 1 - tau : tau; psc = BRKR[((size_t)(d * T + b * S + sq) * RH + h) * 2 + (tid & 1)]; } } while (0)
#define SC_WRITE(c) do { float* B_ = buf + ((c) & 1) * SC_BUF; _Pragma("unroll") for (int i = 0; i < 2; ++i) { const int idx = tid + NTHREADS * i, st = idx >> 6, k = idx & 63; \
            float* q_ = B_ + st * 384 + k; q_[0] = pw[i]; q_[64] = -pa[i]; q_[128] = pa[i] * pb[i]; q_[192] = pk[i]; q_[256] = pw[i] * pr[i]; q_[320] = pv[i]; } \
            if (tid < 2 * SC_STEPS) scal[((c) & 1) * SC_STEPS * 2 + tid] = psc; } while (0)
        __syncthreads();
        SC_LOAD(0); SC_WRITE(0);
        __syncthreads();
        const int row = qt * 16 + wave * 2 + rl;
        for (int c = 0; c < S / SC_STEPS; ++c) {
            const bool more = (c + 1) < S / SC_STEPS;
            if (more) SC_LOAD(c + 1);
            const float* B = buf + (c & 1) * SC_BUF; const float* sc = scal + (c & 1) * SC_STEPS * 2; float* ob = outb + (c & 1) * SC_STEPS * 16;
            float outs[SC_STEPS];
            f32x2 w2 = *(const f32x2*)(B + 2 * kq), a2 = *(const f32x2*)(B + 64 + 2 * kq), b2 = *(const f32x2*)(B + 128 + 2 * kq);
            f32x2 k2 = *(const f32x2*)(B + 192 + 2 * kq), wr2 = *(const f32x2*)(B + 256 + 2 * kq);
            float v = B[320 + row]; float br = sc[0], kr = sc[1];
#pragma unroll
            for (int st = 0; st < SC_STEPS; ++st) {
                const int sn = st + 1 < SC_STEPS ? st + 1 : st;
                const float* q = B + sn * 384;
                const f32x2 nw2 = *(const f32x2*)(q + 2 * kq), na2 = *(const f32x2*)(q + 64 + 2 * kq), nb2 = *(const f32x2*)(q + 128 + 2 * kq);
                const f32x2 nk2 = *(const f32x2*)(q + 192 + 2 * kq), nwr2 = *(const f32x2*)(q + 256 + 2 * kq);
                const float nv = q[320 + row], nbr = sc[sn * 2], nkr = sc[sn * 2 + 1];
                SCHED_BAR();
                float sa = s0 * a2.x + s1 * a2.y;
                float po = s0 * wr2.x + s1 * wr2.y;
                sa = row32_sum(sa); po = row32_sum(po);
                outs[st] = po + sa * br + v * kr;
                s0 = s0 * w2.x + (sa * b2.x + v * k2.x); s1 = s1 * w2.y + (sa * b2.y + v * k2.y);
                SCHED_BAR();
                w2 = nw2; a2 = na2; b2 = nb2; k2 = nk2; wr2 = nwr2; v = nv; br = nbr; kr = nkr;
            }
            if (kq == 0) {
#pragma unroll
                for (int st = 0; st < SC_STEPS; ++st) ob[st * 16 + wave * 2 + rl] = outs[st];
            }
            if (more) SC_WRITE(c + 1);
            __syncthreads();
            if (tid < 16 * SC_STEPS) {
                const int st = tid >> 4, r = tid & 15, tau = c * SC_STEPS + st, sq = d ? S - 1 - tau : tau;
                SCAN[doff + (size_t)(b * S + sq) * RW + h * 64 + qt * 16 + r] = ob[st * 16 + r];
            }
        }
#undef SC_LOAD
#undef SC_WRITE
    }
    __syncthreads();
}

constexpr int RST = 72;
constexpr int RARR = 64 * RST;
__device__ __forceinline__ f32x4 tile_nt(const bf16_t* Aa, int ta, const bf16_t* Ba, int tb, f32x4 acc, int col, int g) {
#pragma unroll
    for (int ks = 0; ks < 2; ++ks) {
        const bf16x8 af = *(const bf16x8*)(Aa + (ta * 16 + col) * RST + ks * 32 + 8 * g);
        const bf16x8 bfr = *(const bf16x8*)(Ba + (tb * 16 + col) * RST + ks * 32 + 8 * g);
        acc = MFMA16(af, bfr, acc);
    }
    return acc;
}
__device__ __forceinline__ void phase_rwkv_pre(const Params& P, int l, unsigned char* smem, int wv) {
    ParamsPtr pp = PARAMS_PTR(P); PIN_S(pp); unsigned char* ws = pp->ws; int bidx = (int)blockIdx.x, gdim = (int)gridDim.x; PIN_S(bidx); PIN_S(gdim);
    const u32x4* RK7 = (const u32x4*)(ws + O_RK7);
    const float* LWG = (const float*)(ws + O_LW);
    bf16_t* Qg = (bf16_t*)(ws + O_RQ); bf16_t* Ag = (bf16_t*)(ws + O_RA); bf16_t* Hg = (bf16_t*)(ws + O_RH); bf16_t* Gg = (bf16_t*)(ws + O_RG);
    const int tid0 = phase_tid(wv);
#define RW_STAGE_VARS int tid = tid0; PIN_V(tid); const int lane = tid & 63, wave = tid >> 6, col = lane & 15, g = lane >> 4; (void)lane; (void)wave; (void)col; (void)g;
    bf16_t* At = (bf16_t*)smem; bf16_t* Bt = At + RARR; bf16_t* Kt = Bt + RARR; bf16_t* Rt = Kt + RARR;
    bf16_t* BtT = Rt + RARR; bf16_t* KtT = BtT + RARR; bf16_t* VT = KtT + RARR;
    bf16_t* Lak = VT + RARR; bf16_t* Mrb = Lak + RARR; bf16_t* Mrk = Mrb + RARR; bf16_t* YT = Mrk + RARR; bf16_t* W2T = YT + RARR;
    bf16_t* Lbo = W2T + RARR;
    float* LabT = (float*)(Lbo + RARR);
    float* Xs = LabT + 4096;
    float* Pb = Xs + 4096;
    float* segs = Pb + 2048;
    float* PC = segs + 512;
    float plw[8]; u32x4 prec[8];
#define RW_LOAD(uu) do { const int c_ = (uu) % RNC, h_ = ((uu) / RNC) % RH, b_ = ((uu) / (RNC * RH)) % NB, d_ = (uu) / (RNC * RH * NB); const size_t doff_ = (size_t)d_ * T * RW; \
        const int ch_ = tid0 & 63, sg_ = tid0 >> 6; _Pragma("unroll") for (int j = 0; j < 8; ++j) { const int tau = c_ * RC + sg_ * 8 + j, sq = d_ ? S - 1 - tau : tau; const size_t o = (size_t)(b_ * S + sq) * RW + h_ * 64 + ch_; \
        prec[j] = RK7[o]; } \
        { const int tauA = c_ * RC + sg_ * 8, tokA = b_ * S + (d_ ? S - 1 - tauA - 7 : tauA);        \
          const f32x4 l0 = *(const f32x4*)(LWG + doff_ + ((size_t)(tokA >> 2) * RW + h_ * 64 + ch_) * 4), l1 = *(const f32x4*)(LWG + doff_ + ((size_t)((tokA >> 2) + 1) * RW + h_ * 64 + ch_) * 4); \
          if (d_) { plw[0] = l1.w; plw[1] = l1.z; plw[2] = l1.y; plw[3] = l1.x; plw[4] = l0.w; plw[5] = l0.z; plw[6] = l0.y; plw[7] = l0.x; } \
          else { plw[0] = l0.x; plw[1] = l0.y; plw[2] = l0.z; plw[3] = l0.w; plw[4] = l1.x; plw[5] = l1.y; plw[6] = l1.z; plw[7] = l1.w; } } } while (0)
    if (bidx < RUN) RW_LOAD(bidx);
    for (int u = bidx; u < RUN; u += gdim) {
        const int c = u % RNC, h = (u / RNC) % RH, b = (u / (RNC * RH)) % NB, d = u / (RNC * RH * NB);
        (void)c; (void)h; (void)b; (void)d;
        __syncthreads();
        {
            RW_STAGE_VARS
            const int ch = tid & 63, sg = tid >> 6;
            float lw[8]; unsigned kk[8], bq_[8], kd[8], rr[8], vv[8];
#pragma unroll
            for (int j = 0; j < 8; ++j) { lw[j] = plw[j]; kk[j] = prec[j].y & 0xffffu; bq_[j] = d ? (prec[j].z >> 16) : (prec[j].z & 0xffffu); kd[j] = d ? (prec[j].w >> 16) : (prec[j].w & 0xffffu); rr[j] = prec[j].x & 0xffffu; vv[j] = prec[j].x >> 16; }
            if (u + gdim < RUN) RW_LOAD(u + gdim);
            float run = 0.f;
#pragma unroll
            for (int j = 0; j < 8; ++j) { run += lw[j]; lw[j] = run; }
            segs[sg * 64 + ch] = run;
            __syncthreads();
            float off = 0.f;
            for (int q = 0; q < sg; ++q) off += segs[q * 64 + ch];
            u32x4 pbt, pkt, pvt; unsigned tb[8], tk[8], tvv[8];
            float prev = off;
#pragma unroll
            for (int j = 0; j < 8; ++j) {
                const int t = sg * 8 + j; const float cl = off + lw[j];
                const float ep = fexp(prev), en = fexp(-cl), epc = fexp(cl);
                const unsigned a_ = f2bf(-bf_lo(kk[j]) * ep), b_ = f2bf(bf_lo(bq_[j]) * en), k_ = f2bf(bf_lo(kd[j]) * en), r_ = f2bf(bf_lo(rr[j]) * epc), v_ = vv[j];
                At[t * RST + ch] = (bf16_t)a_; Bt[t * RST + ch] = (bf16_t)b_; Kt[t * RST + ch] = (bf16_t)k_; Rt[t * RST + ch] = (bf16_t)r_;
                tb[j] = b_; tk[j] = k_; tvv[j] = v_;
                prev = cl;
            }
            if (sg == 7) PC[ch] = fexp(prev);
            pbt.x = tb[0] | (tb[1] << 16); pbt.y = tb[2] | (tb[3] << 16); pbt.z = tb[4] | (tb[5] << 16); pbt.w = tb[6] | (tb[7] << 16);
            pkt.x = tk[0] | (tk[1] << 16); pkt.y = tk[2] | (tk[3] << 16); pkt.z = tk[4] | (tk[5] << 16); pkt.w = tk[6] | (tk[7] << 16);
            pvt.x = tvv[0] | (tvv[1] << 16); pvt.y = tvv[2] | (tvv[3] << 16); pvt.z = tvv[4] | (tvv[5] << 16); pvt.w = tvv[6] | (tvv[7] << 16);
            *(u32x4*)(BtT + ch * RST + sg * 8) = pbt; *(u32x4*)(KtT + ch * RST + sg * 8) = pkt; *(u32x4*)(VT + ch * RST + sg * 8) = pvt;
            for (int z_ = tid; z_ < 2 * RARR / 8; z_ += NTHREADS) ((u32x4*)YT)[z_] = (u32x4){0u, 0u, 0u, 0u};
        }
        __syncthreads();
        {
            RW_STAGE_VARS
            const int m = wave >> 1;
            const bf16_t* Ym = (m == 0 || m == 2) ? Bt : Kt; const bf16_t* Xm = (m < 2) ? At : Rt;
#pragma unroll 1
            for (int q = 0; q < 8; ++q) {
                const int tix = (wave & 1) * 8 + q, it = tix >> 2, tt = tix & 3;
                f32x4 acc = (f32x4){0.f, 0.f, 0.f, 0.f};
                if (it <= tt) acc = tile_nt(Ym, it, Xm, tt, acc, col, g);
                const int t = tt * 16 + col, i0 = it * 16 + 4 * g;
                float o4[4];
#pragma unroll
                for (int r = 0; r < 4; ++r) { const int i = i0 + r; const bool ok = m < 2 ? (i < t) : (i <= t); o4[r] = ok ? acc[r] : 0.f; }
                if (m == 0) {
#pragma unroll
                    for (int r = 0; r < 4; ++r) LabT[(i0 + r) * 64 + t] = o4[r];
                    const bool offd = it < tt;
                    u32x2 w2; w2.x = offd ? pk2(o4[0], o4[1]) : 0u; w2.y = offd ? pk2(o4[2], o4[3]) : 0u; *(u32x2*)(Lbo + t * RST + i0) = w2;
                }
                else { bf16_t* dst = (m == 1 ? Lak : (m == 2 ? Mrb : Mrk)) + t * RST + i0; u32x2 w2; w2.x = pk2(o4[0], o4[1]); w2.y = pk2(o4[2], o4[3]); *(u32x2*)dst = w2; }
            }
        }
        __syncthreads();
        {
            RW_STAGE_VARS
#pragma unroll
            for (int q = 0; q < 2; ++q) {
                const int tix = wave * 2 + q, tt = tix >> 2, et = tix & 3;
                f32x4 acc = (f32x4){0.f, 0.f, 0.f, 0.f};
                acc = tile_nt(Lak, tt, VT, et, acc, col, g);
#pragma unroll
                for (int r = 0; r < 4; ++r) Xs[(tt * 16 + 4 * g + r) * 64 + et * 16 + col] = acc[r];
            }
        }
        __syncthreads();
        {
            RW_STAGE_VARS
#pragma unroll 1
            for (int bb = 0; bb < 4; ++bb) {
                if (bb > 0) {
                    const bf16_t* Zt = (wave < 4 ? YT : W2T) + ((wave & 3) * 16 + col) * RST + 8 * g;
                    const bf16_t* La = Lbo + (16 * bb + col) * RST + 8 * g;
                    f32x4 acc = (f32x4){0.f, 0.f, 0.f, 0.f};
                    acc = MFMA16(*(const bf16x8*)La, *(const bf16x8*)Zt, acc);
                    if (bb > 2) acc = MFMA16(*(const bf16x8*)(La + 32), *(const bf16x8*)(Zt + 32), acc);
#pragma unroll
                    for (int r = 0; r < 4; ++r) Pb[(4 * g + r) * 128 + wave * 16 + col] = acc[r];
                }
                __syncthreads();
                if (wave < 2) {
                    float acc[16];
                    if (wave == 0) {
#pragma unroll
                        for (int r = 0; r < 16; ++r) acc[r] = bf_lo((unsigned)At[(16 * bb + r) * RST + lane]);
                    } else {
#pragma unroll
                        for (int r = 0; r < 16; ++r) acc[r] = Xs[(16 * bb + r) * 64 + lane];
                    }
                    if (bb > 0) {
#pragma unroll
                        for (int r = 0; r < 16; ++r) acc[r] += Pb[r * 128 + wave * 64 + lane];
                    }
                    const float* dp = LabT + (16 * bb) * 64 + 16 * bb;
#pragma unroll
                    for (int r = 1; r < 16; ++r)
#pragma unroll
                        for (int r2 = 0; r2 < r; ++r2) acc[r] += dp[r2 * 64 + r] * acc[r2];
                    bf16_t* dst = (wave == 0 ? YT : W2T) + lane * RST;
                    u32x4 w0, w1;
                    w0.x = pk2(acc[0], acc[1]); w0.y = pk2(acc[2], acc[3]); w0.z = pk2(acc[4], acc[5]); w0.w = pk2(acc[6], acc[7]);
                    w1.x = pk2(acc[8], acc[9]); w1.y = pk2(acc[10], acc[11]); w1.z = pk2(acc[12], acc[13]); w1.w = pk2(acc[14], acc[15]);
                    *(u32x4*)(dst + 16 * bb) = w0; *(u32x4*)(dst + 16 * bb + 8) = w1;
                }
                __syncthreads();
            }
        }
        __syncthreads();
        {
            RW_STAGE_VARS
            const int ty = wave >> 1;
#pragma unroll 1
            for (int q = 0; q < 8; ++q) {
                const int tix = (wave & 1) * 8 + q, ra = tix >> 2, cb = tix & 3;
                f32x4 acc = (f32x4){0.f, 0.f, 0.f, 0.f};
                if (ty == 0) {
                    acc = tile_nt(YT, ra, Mrb, cb, acc, col, g);
                    const u32x2 rt2 = *(const u32x2*)(Rt + (cb * 16 + col) * RST + ra * 16 + 4 * g);
                    u32x2 qb2; qb2.x = pk2(acc[0] + bf_lo(rt2.x), acc[1] + bf_hi(rt2.x)); qb2.y = pk2(acc[2] + bf_lo(rt2.y), acc[3] + bf_hi(rt2.y));
                    *(u32x2*)(Qg + (size_t)u * 4096 + (tix * 64 + lane) * 4) = qb2;
                } else if (ty == 1) {
                    acc = tile_nt(Mrb, ra, W2T, cb, acc, col, g); acc = tile_nt(Mrk, ra, VT, cb, acc, col, g);
                    { u32x2 hb; hb.x = pk2(acc[0], acc[1]); hb.y = pk2(acc[2], acc[3]); *(u32x2*)(Hg + (size_t)u * 4096 + (tix * 64 + lane) * 4) = hb; }
                } else if (ty == 2) {
                    acc = tile_nt(YT, ra, BtT, cb, acc, col, g);
                    const float pc = PC[cb * 16 + col]; const int k1 = cb * 16 + col;
                    float a4[4];
#pragma unroll
                    for (int r = 0; r < 4; ++r) a4[r] = pc * (acc[r] + ((ra * 16 + 4 * g + r) == k1 ? 1.0f : 0.f));
                    u32x2 ab2; ab2.x = pk2(a4[0], a4[1]); ab2.y = pk2(a4[2], a4[3]);
                    *(u32x2*)(Ag + (size_t)u * 4096 + (tix * 64 + lane) * 4) = ab2;
                } else {
                    acc = tile_nt(BtT, ra, W2T, cb, acc, col, g); acc = tile_nt(KtT, ra, VT, cb, acc, col, g);
#pragma unroll
                    for (int r = 0; r < 4; ++r) acc[r] *= PC[ra * 16 + 4 * g + r];
                    { u32x2 gb2; gb2.x = pk2(acc[0], acc[1]); gb2.y = pk2(acc[2], acc[3]); *(u32x2*)(Gg + (size_t)u * 4096 + (tix * 64 + lane) * 4) = gb2; }
                }
            }
        }
    }
    __syncthreads();
#undef RW_STAGE_VARS
#undef RW_LOAD
}
__device__ __forceinline__ void phase_rwkv_seq(const Params& P, int l, unsigned char* smem, int wv) {
    ParamsPtr pp = PARAMS_PTR(P); PIN_S(pp); unsigned char* ws = pp->ws; int bidx = (int)blockIdx.x, gdim = (int)gridDim.x; PIN_S(bidx); PIN_S(gdim);
    const bf16_t* Ag = (const bf16_t*)(ws + O_RA); const bf16_t* Gg = (const bf16_t*)(ws + O_RG); bf16_t* Sg = (bf16_t*)(ws + O_RS);
    const int tid = phase_tid(wv), lane = tid & 63, wave = tid >> 6, col = lane & 15, g = lane >> 4;
    const int gw = wave * gdim + bidx, ngw = NWAVES * gdim;
    for (int un = gw; un < 2 * NB * RH * 2; un += ngw) {
        const int ch = un >> 1, eh = un & 1;
        f32x4 acc[4][2];
#pragma unroll
        for (int a_ = 0; a_ < 4; ++a_)
#pragma unroll
            for (int b_ = 0; b_ < 2; ++b_) acc[a_][b_] = (f32x4){0.f, 0.f, 0.f, 0.f};
        u32x2 alo[4][2], ahi[4][2]; u32x2 gq[4][2];
        const unsigned aoff = (unsigned)(col * 64 + 4 * g), goff = (unsigned)(lane * 4);
#define RS_LOAD(cc) do { const bf16_t* ab_ = Ag + (size_t)(ch * RNC + (cc)) * 4096; const bf16_t* gb_ = Gg + (size_t)(ch * RNC + (cc)) * 4096 + eh * 512; \
            _Pragma("unroll") for (int ra = 0; ra < 4; ++ra) _Pragma("unroll") for (int p = 0; p < 2; ++p) { alo[ra][p] = *(const u32x2*)(ab_ + ((2 * p * 4 + ra) * 256) + goff); ahi[ra][p] = *(const u32x2*)(ab_ + (((2 * p + 1) * 4 + ra) * 256) + goff); } \
            _Pragma("unroll") for (int ra = 0; ra < 4; ++ra) _Pragma("unroll") for (int cb = 0; cb < 2; ++cb) gq[ra][cb] = *(const u32x2*)(gb_ + ((ra * 4 + cb) * 256) + goff); } while (0)
        RS_LOAD(0);
#pragma unroll 1
        for (int c = 0; c < RNC; ++c) {
            bf16_t* sb_ = Sg + (size_t)(ch * RNC + c) * 4096 + eh * 2048;
            bf16x8 bq[2][2];
#pragma unroll
            for (int cb = 0; cb < 2; ++cb) {
#pragma unroll
                for (int ra = 0; ra < 4; ++ra) {
                    u32x2 w2; w2.x = pk2(acc[ra][cb][0], acc[ra][cb][1]); w2.y = pk2(acc[ra][cb][2], acc[ra][cb][3]);
                    *(u32x2*)(sb_ + (cb * 1024 + ra * 16) + aoff) = w2;
                }
#pragma unroll
                for (int p = 0; p < 2; ++p) bq[p][cb] = cvt8(acc[2 * p][cb], acc[2 * p + 1][cb]);
            }
            u32x4 af[4][2];
#pragma unroll
            for (int ra = 0; ra < 4; ++ra) {
#pragma unroll
                for (int p = 0; p < 2; ++p) af[ra][p] = (u32x4){alo[ra][p].x, alo[ra][p].y, ahi[ra][p].x, ahi[ra][p].y};
#pragma unroll
                for (int cb = 0; cb < 2; ++cb) acc[ra][cb] = (f32x4){bf_lo(gq[ra][cb].x), bf_hi(gq[ra][cb].x), bf_lo(gq[ra][cb].y), bf_hi(gq[ra][cb].y)};
            }
            if (c + 1 < RNC) RS_LOAD(c + 1);
#pragma unroll
            for (int ra = 0; ra < 4; ++ra)
#pragma unroll
                for (int cb = 0; cb < 2; ++cb)
#pragma unroll
                    for (int p = 0; p < 2; ++p) acc[ra][cb] = MFMA16(__builtin_bit_cast(bf16x8, af[ra][p]), bq[p][cb], acc[ra][cb]);
        }
#undef RS_LOAD
    }
}
__device__ __forceinline__ void phase_rwkv_out(const Params& P, int l, unsigned char* smem, int wv) {
    ParamsPtr pp = PARAMS_PTR(P); PIN_S(pp); unsigned char* ws = pp->ws; int bidx = (int)blockIdx.x, gdim = (int)gridDim.x; PIN_S(bidx); PIN_S(gdim);
    const bf16_t* Qg = (const bf16_t*)(ws + O_RQ); const bf16_t* Sg = (const bf16_t*)(ws + O_RS); const bf16_t* Hg = (const bf16_t*)(ws + O_RH);
    const bf16_t* VB = (const bf16_t*)(ws + O_VB); const float* GATE = (const float*)(ws + O_GATE); const float* BONUS = (const float*)(ws + O_BONUS);
    bf16_t* GRP = (bf16_t*)(ws + O_GRP);
    const float* rln_g = pp->in[15] + (size_t)l * RW; const float* rln_b = pp->in[16] + (size_t)l * RW;
    const int tid = phase_tid(wv), lane = tid & 63, wave = tid >> 6, col = lane & 15, g = lane >> 4;
    for (int pu = bidx * NWAVES + wave; pu < NB * RH * RNC; pu += gdim * NWAVES) {
        const int c = pu % RNC, h = (pu / RNC) % RH, b = pu / (RNC * RH);
        f32x4 o[2][4][4];
#pragma unroll
        for (int d = 0; d < 2; ++d) {
            const int u = ((d * NB + b) * RH + h) * RNC + (d ? RNC - 1 - c : c);
            const size_t ub = (size_t)u * 4096;
            bf16x8 qa[4][2], sb[4][2];
#pragma unroll
            for (int q = 0; q < 4; ++q)
#pragma unroll
                for (int ks = 0; ks < 2; ++ks) {
                    const u32x2 q0 = *(const u32x2*)(Qg + ub + ((2 * ks * 4 + q) * 64 + lane) * 4), q1 = *(const u32x2*)(Qg + ub + (((2 * ks + 1) * 4 + q) * 64 + lane) * 4);
                    qa[q][ks] = __builtin_bit_cast(bf16x8, (u32x4){q0.x, q0.y, q1.x, q1.y});
                    const bf16_t* sp_ = Sg + ub + (q * 16 + col) * 64 + ks * 32 + 4 * g;
                    const u32x2 s0_ = *(const u32x2*)sp_, s1_ = *(const u32x2*)(sp_ + 16);
                    sb[q][ks] = __builtin_bit_cast(bf16x8, (u32x4){s0_.x, s0_.y, s1_.x, s1_.y});
                }
#pragma unroll
            for (int tt = 0; tt < 4; ++tt)
#pragma unroll
                for (int et = 0; et < 4; ++et) {
                    const u32x2 hb = *(const u32x2*)(Hg + ub + ((tt * 4 + et) * 64 + lane) * 4);
                    f32x4 acc = (f32x4){bf_lo(hb.x), bf_hi(hb.x), bf_lo(hb.y), bf_hi(hb.y)};
#pragma unroll
                    for (int ks = 0; ks < 2; ++ks) acc = MFMA16(qa[tt][ks], sb[et][ks], acc);
                    o[d][tt][et] = acc;
                }
        }
        const int src = (3 - g) * 16 + col;
#pragma unroll
        for (int tt = 0; tt < 4; ++tt)
#pragma unroll
            for (int et = 0; et < 4; ++et)
#pragma unroll
                for (int r = 0; r < 4; ++r) o[0][tt][et][r] += SHL(o[1][3 - tt][et][3 - r], src);
        float* tile = (float*)smem + wave * (64 * 68);
        WAVE_SYNC();
#pragma unroll
        for (int tt = 0; tt < 4; ++tt)
#pragma unroll
            for (int et = 0; et < 4; ++et)
#pragma unroll
                for (int r = 0; r < 4; ++r) tile[(tt * 16 + 4 * g + r) * 68 + et * 16 + col] = o[0][tt][et][r];
        WAVE_SYNC();
        {
            const int c4 = (lane & 15) * 4, ch = h * 64 + c4;
            const f32x4 lg = *(const f32x4*)(rln_g + ch), lb = *(const f32x4*)(rln_b + ch);
#pragma unroll 1
            for (int qb = 0; qb < 2; ++qb) {
                f32x4 gt_[8]; u32x2 vb_[8]; float bo_[8];
#pragma unroll
                for (int q8 = 0; q8 < 8; ++q8) {
                    const size_t t = (size_t)(b * S + c * RC + (qb * 8 + q8) * 4 + (lane >> 4));
                    gt_[q8] = *(const f32x4*)(GATE + t * RW + ch); vb_[q8] = *(const u32x2*)(VB + t * RW + ch); bo_[q8] = BONUS[t * RH + h];
                }
#pragma unroll
                for (int q8 = 0; q8 < 8; ++q8) {
                    const int tl = (qb * 8 + q8) * 4 + (lane >> 4);
                    const size_t t = (size_t)(b * S + c * RC + tl);
                    const f32x4 x = *(const f32x4*)(tile + tl * 68 + c4);
                    const float mean = row16_sum((x.x + x.y) + (x.z + x.w)) * (1.0f / 64.0f);
                    const f32x4 dl = x - mean;
                    const float var = row16_sum((dl.x * dl.x + dl.y * dl.y) + (dl.z * dl.z + dl.w * dl.w)) * (1.0f / 64.0f);
                    const float rstd = 1.0f / sqrtf(var + GN_EPS);
                    f32x4 y = dl * rstd * lg + lb;
                    y.x += bo_[q8] * bf_lo(vb_[q8].x); y.y += bo_[q8] * bf_hi(vb_[q8].x); y.z += bo_[q8] * bf_lo(vb_[q8].y); y.w += bo_[q8] * bf_hi(vb_[q8].y);
                    y = y * gt_[q8];
                    u32x2 ob; ob.x = pk2(y.x, y.y); ob.y = pk2(y.z, y.w);
                    *(u32x2*)(GRP + t * D + GW + ch) = ob;
                }
            }
        }
    }
    __syncthreads();
}

__device__ __forceinline__ void phase_mlstm_local(const Params& P, int l, unsigned char* smem, int wv, int bid, int nb) {
    PIN_S(bid); PIN_S(nb);
    ParamsPtr pp = PARAMS_PTR(P); PIN_S(pp); unsigned char* ws = pp->ws;
    const bf16_t* KT = (const bf16_t*)(ws + O_KT); const bf16_t* VT = (const bf16_t*)(ws + O_VT);
    const float* IG = (const float*)(ws + O_IG); const float* LF = (const float*)(ws + O_LF);
    float* CL = (float*)(ws + O_CL); float* NLb = (float*)(ws + O_NL); float* ML = (float*)(ws + O_ML); float* BL = (float*)(ws + O_BL);
    float* GVT = (float*)(ws + O_GVT); float* PMX = (float*)(ws + O_PMX); float* BCT = (float*)(ws + O_BCT);
    const int tid = phase_tid(wv), lane = tid & 63, wave = tid >> 6, col = lane & 15, g = lane >> 4;
    float* wts = (float*)smem + wave * 128;
    for (int u = bid * NWAVES + wave; u < 2 * NB * MH * NCH; u += nb * NWAVES) {
        const int c = u % NCH, h = (u / NCH) % MH, p = u / (NCH * MH), d = p / NB, b = p % NB;
        const int tc = d ? NCH - 1 - c : c, tok0 = b * S + tc * CH;
        const int i0 = d ? 127 - 2 * lane : 2 * lane, i1 = d ? i0 - 1 : i0 + 1;
        const size_t g0 = ((size_t)d * T + tok0 + i0) * MH + h, g1 = ((size_t)d * T + tok0 + i1) * MH + h;
        const float lf0 = LF[g0], lf1 = LF[g1], ig0 = IG[g0], ig1 = IG[g1];
        const float c1 = lf0 + lf1;
        float incl = c1;
#pragma unroll
        for (int o = 1; o < 64; o <<= 1) { const float tq = SHUP(incl, o, lane); if (lane >= o) incl += tq; }
        const float excl = incl - c1, bc0 = excl + lf0, bc1 = incl;
        const float blast = RDL(incl, 63);
        const float gv0 = ig0 - bc0, gv1 = ig1 - bc1, pl1 = fmaxf(gv0, gv1);
        float mincl = pl1;
#pragma unroll
        for (int o = 1; o < 64; o <<= 1) { const float tq = SHUP(mincl, o, lane); if (lane >= o) mincl = fmaxf(mincl, tq); }
        float mexcl = SHUP(mincl, 1, lane); if (lane == 0) mexcl = -INFINITY;
        const float pm0 = fmaxf(mexcl, gv0), pm1 = mincl;
        const float mloc = blast + RDL(mincl, 63);
        WAVE_SYNC();
        wts[i0] = fexp(blast + gv0 - mloc); wts[i1] = fexp(blast + gv1 - mloc);
        GVT[g0] = gv0; GVT[g1] = gv1; PMX[g0] = pm0; PMX[g1] = pm1; BCT[g0] = bc0; BCT[g1] = bc1;
        if (lane == 0) { ML[u] = mloc; BL[u] = blast; }
        WAVE_SYNC();
        const bf16_t* vbase = VT + ((size_t)(b * MH + h) * 64) * S + (size_t)tc * CH;
        const bf16_t* kbase = KT + ((size_t)(b * MH + h) * 64) * S + (size_t)tc * CH;
        const unsigned loff = (unsigned)(col * S + 8 * g);
        f32x4 acc[4][4];
#pragma unroll
        for (int a_ = 0; a_ < 4; ++a_)
#pragma unroll
            for (int b_ = 0; b_ < 4; ++b_) acc[a_][b_] = (f32x4){0.f, 0.f, 0.f, 0.f};
        float nsum[4] = {0.f, 0.f, 0.f, 0.f};
#pragma unroll 1
        for (int ks = 0; ks < 4; ++ks) {
            const int ii = ks * 32 + 8 * g;
            const f32x4 w0 = *(const f32x4*)(wts + ii), w1 = *(const f32x4*)(wts + ii + 4);
            bf16x8 af[4], bfk[4];
#pragma unroll
            for (int q = 0; q < 4; ++q) af[q] = *(const bf16x8*)(vbase + ((size_t)q * 16 * S + ks * 32) + loff);
#pragma unroll
            for (int q = 0; q < 4; ++q) {
                const u32x4 kr = *(const u32x4*)(kbase + ((size_t)q * 16 * S + ks * 32) + loff);
                f32x4 k0, k1;
                k0.x = bf_lo(kr.x) * w0.x; k0.y = bf_hi(kr.x) * w0.y; k0.z = bf_lo(kr.y) * w0.z; k0.w = bf_hi(kr.y) * w0.w;
                k1.x = bf_lo(kr.z) * w1.x; k1.y = bf_hi(kr.z) * w1.y; k1.z = bf_lo(kr.w) * w1.z; k1.w = bf_hi(kr.w) * w1.w;
                nsum[q] += (k0.x + k0.y) + (k0.z + k0.w) + (k1.x + k1.y) + (k1.z + k1.w);
                bfk[q] = cvt8(k0, k1);
            }
#pragma unroll
            for (int a_ = 0; a_ < 4; ++a_)
#pragma unroll
                for (int b_ = 0; b_ < 4; ++b_) acc[a_][b_] = MFMA16(af[a_], bfk[b_], acc[a_][b_]);
        }
        float* cbase = CL + (size_t)u * 4096;
        const unsigned coff = (unsigned)(4 * g * 64 + col);
#pragma unroll
        for (int b_ = 0; b_ < 4; ++b_) {
#pragma unroll
            for (int a_ = 0; a_ < 4; ++a_)
#pragma unroll
                for (int r = 0; r < 4; ++r) cbase[(a_ * 16 * 64 + r * 64 + b_ * 16) + coff] = acc[a_][b_][r];
            float ns = nsum[b_]; ns += SHX(ns, 16, lane); ns += SHX(ns, 32, lane);
            if (g == 0) NLb[(size_t)u * 64 + b_ * 16 + col] = ns;
        }
    }
    __syncthreads();
}

__device__ __forceinline__ void phase_mlstm_carry(const Params& P, int l, unsigned char* smem, int wv) {
    ParamsPtr pp = PARAMS_PTR(P); PIN_S(pp); unsigned char* ws = pp->ws; int bidx = (int)blockIdx.x, gdim = (int)gridDim.x; PIN_S(bidx); PIN_S(gdim);
    float* CL = (float*)(ws + O_CL); float* NLb = (float*)(ws + O_NL); const float* ML = (const float*)(ws + O_ML); const float* BL = (const float*)(ws + O_BL);
    float* MIN = (float*)(ws + O_MIN);
    const int total = 2 * NB * MH * 4160;
    const int tid = phase_tid(wv);
    for (int gi = bidx * NTHREADS + tid; gi < total; gi += gdim * NTHREADS) {
        const int ph = gi / 4160, e = gi % 4160;
        float* base_ = e < 4096 ? CL + (size_t)ph * NCH * 4096 + e : NLb + (size_t)ph * NCH * 64 + (e - 4096);
        const int stride = e < 4096 ? 4096 : 64;
        static_assert(NCH <= 32, "carry scan keeps one chunk value per register");
        float loc[NCH], bl[NCH], ml[NCH];
#pragma unroll
        for (int c = 0; c < NCH; ++c) { loc[c] = base_[(size_t)c * stride]; bl[c] = BL[ph * NCH + c]; ml[c] = ML[ph * NCH + c]; }
        float m = 0.f, val = 0.f;
#pragma unroll
        for (int c = 0; c < NCH; ++c) {
            base_[(size_t)c * stride] = val;
            if (e == 0) MIN[ph * NCH + c] = m;
            const float mn = fmaxf(bl[c] + m, ml[c]);
            val = fexp(bl[c] + m - mn) * val + fexp(ml[c] - mn) * loc[c];
            m = mn;
        }
    }
}

__device__ __forceinline__ void phase_mlstm_out(const Params& P, int l, unsigned char* smem, int wv) {
    ParamsPtr pp = PARAMS_PTR(P); PIN_S(pp); unsigned char* ws = pp->ws; int bidx = (int)blockIdx.x, gdim = (int)gridDim.x; PIN_S(bidx); PIN_S(gdim);
    const bf16_t* proj = (const bf16_t*)(ws + O_PROJ);
    const bf16_t* MQB = (const bf16_t*)(ws + O_MQB); const bf16_t* MKB = (const bf16_t*)(ws + O_MKB); const bf16_t* VT = (const bf16_t*)(ws + O_VT);
    const float* GVT = (const float*)(ws + O_GVT); const float* PMX = (const float*)(ws + O_PMX); const float* BCT = (const float*)(ws + O_BCT);
    const float* CL = (const float*)(ws + O_CL); const float* NLb = (const float*)(ws + O_NL); const float* MIN = (const float*)(ws + O_MIN);
    bf16_t* GRP = (bf16_t*)(ws + O_GRP);
    const float* mln_g = pp->in[20] + (size_t)l * MW;
    const int tid = phase_tid(wv), lane = tid & 63, wave = tid >> 6, col = lane & 15, g = lane >> 4;
    constexpr int KP = 72, VP = 136;
    bf16_t* Ks = (bf16_t*)smem;
    bf16_t* Vs = Ks + 128 * KP;
    float* gvs_ = (float*)(Vs + 64 * VP);
    for (int u = bidx; u < NB * MH * NCH; u += gdim) {
        const int tc = u % NCH, h = (u / NCH) % MH, b = u / (NCH * MH);
        const int tok0 = b * S + tc * CH, it = wave * 16 + col;
        __syncthreads();
        {
            u32x4 kb_[2], vb_[2];
#pragma unroll
            for (int q = 0; q < 2; ++q) {
                const int idx = tid + q * NTHREADS;
                kb_[q] = *(const u32x4*)(MKB + (size_t)(tok0 + (idx >> 3)) * MW + h * 64 + (idx & 7) * 8);
                vb_[q] = *(const u32x4*)(VT + ((size_t)(b * MH + h) * 64 + (idx >> 4)) * S + (size_t)tc * CH + (idx & 15) * 8);
            }
            float gq_ = 0.f;
            if (tid < 256) gq_ = GVT[((size_t)(tid >> 7) * T + tok0 + (tid & 127)) * MH + h];
#pragma unroll
            for (int q = 0; q < 2; ++q) {
                const int idx = tid + q * NTHREADS;
                *(u32x4*)(Ks + (idx >> 3) * KP + (idx & 7) * 8) = kb_[q];
                *(u32x4*)(Vs + (idx >> 4) * VP + (idx & 15) * 8) = vb_[q];
            }
            if (tid < 256) gvs_[tid] = gq_;
        }
        __syncthreads();
        const size_t trow = (size_t)(tok0 + it);
        bf16x8 bq[2];
#pragma unroll
        for (int ks = 0; ks < 2; ++ks) bq[ks] = *(const bf16x8*)(MQB + trow * MW + h * 64 + ks * 32 + 8 * g);
        f32x4 hs[4];
#pragma unroll
        for (int et = 0; et < 4; ++et) hs[et] = (f32x4){0.f, 0.f, 0.f, 0.f};
#pragma unroll
        for (int d = 0; d < 2; ++d) {
            const int cd = d ? NCH - 1 - tc : tc;
            const int su = ((d * NB + b) * MH + h) * NCH + cd;
            const size_t gt = ((size_t)d * T + trow) * MH + h;
            const float mst = MIN[su];
            const float mxt = fmaxf(PMX[gt], mst), mt = BCT[gt] + mxt, wint = fexp(mst - mxt);
            f32x4 num[4];
#pragma unroll
            for (int et = 0; et < 4; ++et) num[et] = (f32x4){0.f, 0.f, 0.f, 0.f};
            float den = 0.f;
            for (int sp = 0; sp < 4; ++sp) {
                if (d == 0 ? (2 * sp > wave) : (2 * sp + 1 < wave)) continue;
                float pw[8];
#pragma unroll
                for (int hf = 0; hf < 2; ++hf) {
                    const int st = 2 * sp + hf;
                    f32x4 sacc = (f32x4){0.f, 0.f, 0.f, 0.f};
#pragma unroll
                    for (int ks = 0; ks < 2; ++ks) sacc = MFMA16(*(const bf16x8*)(Ks + (st * 16 + col) * KP + ks * 32 + 8 * g), bq[ks], sacc);
                    const f32x4 g4 = *(const f32x4*)(gvs_ + d * 128 + st * 16 + 4 * g);
#pragma unroll
                    for (int r = 0; r < 4; ++r) {
                        const int is = st * 16 + 4 * g + r;
                        const bool ok = d == 0 ? (is <= it) : (is >= it);
                        const float pr = ok ? sacc[r] * fexp(g4[r] - mxt) : 0.f;
                        den += pr; pw[hf * 4 + r] = pr;
                    }
                }
                u32x4 pb; pb.x = pk2(pw[0], pw[1]); pb.y = pk2(pw[2], pw[3]); pb.z = pk2(pw[4], pw[5]); pb.w = pk2(pw[6], pw[7]);
                const bf16x8 bp = __builtin_bit_cast(bf16x8, pb);
#pragma unroll
                for (int et = 0; et < 4; ++et) {
                    const bf16_t* vp = Vs + (et * 16 + col) * VP + sp * 32 + 4 * g;
                    const u32x2 v0 = *(const u32x2*)vp, v1 = *(const u32x2*)(vp + 16);
                    u32x4 va; va.x = v0.x; va.y = v0.y; va.z = v1.x; va.w = v1.y;
                    num[et] = MFMA16(__builtin_bit_cast(bf16x8, va), bp, num[et]);
                }
            }
            den += SHX(den, 16, lane); den += SHX(den, 32, lane);
            f32x4 qc[4]; float qn = 0.f;
#pragma unroll
            for (int ks = 0; ks < 2; ++ks) {
                const float* np = NLb + (size_t)su * 64 + ks * 32 + 8 * g;
                const f32x4 n0 = *(const f32x4*)np, n1 = *(const f32x4*)(np + 4);
                const u32x4 qb = __builtin_bit_cast(u32x4, bq[ks]);
                qn += (bf_lo(qb.x) * n0.x + bf_hi(qb.x) * n0.y) + (bf_lo(qb.y) * n0.z + bf_hi(qb.y) * n0.w) + (bf_lo(qb.z) * n1.x + bf_hi(qb.z) * n1.y) + (bf_lo(qb.w) * n1.z + bf_hi(qb.w) * n1.w);
            }
            qn += SHX(qn, 16, lane); qn += SHX(qn, 32, lane);
#pragma unroll
            for (int et = 0; et < 4; ++et) {
                qc[et] = (f32x4){0.f, 0.f, 0.f, 0.f};
#pragma unroll
                for (int ks = 0; ks < 2; ++ks) {
                    const float* cp = CL + (size_t)su * 4096 + (size_t)(et * 16 + col) * 64 + ks * 32 + 8 * g;
                    qc[et] = MFMA16(cvt8(*(const f32x4*)cp, *(const f32x4*)(cp + 4)), bq[ks], qc[et]);
                }
            }
            const float dd = frcp(fmaxf(fabsf(den + wint * qn), fexp(-mt)));
#pragma unroll
            for (int et = 0; et < 4; ++et) hs[et] += (num[et] + wint * qc[et]) * dd;
        }
        float sm = 0.f;
#pragma unroll
        for (int et = 0; et < 4; ++et) sm += (hs[et].x + hs[et].y) + (hs[et].z + hs[et].w);
        sm += SHX(sm, 16, lane); sm += SHX(sm, 32, lane);
        const float mean = sm * (1.0f / 64.0f); float q = 0.f;
#pragma unroll
        for (int et = 0; et < 4; ++et) { const f32x4 dl = hs[et] - mean; q += (dl.x * dl.x + dl.y * dl.y) + (dl.z * dl.z + dl.w * dl.w); }
        q += SHX(q, 16, lane); q += SHX(q, 32, lane);
        const float rstd = 1.0f / sqrtf(q * (1.0f / 64.0f) + LN_EPS);
#pragma unroll
        for (int et = 0; et < 4; ++et) {
            const int c = h * 64 + et * 16 + 4 * g;
            const u32x2 ob_ = *(const u32x2*)(proj + trow * PLD + C_MW + 3 * MW + c); const f32x4 o4 = (f32x4){bf_lo(ob_.x), bf_hi(ob_.x), bf_lo(ob_.y), bf_hi(ob_.y)}, g4 = *(const f32x4*)(mln_g + c);
            const f32x4 y = (hs[et] - mean) * rstd * g4;
            u32x2 ob; ob.x = pk2(sigmoidf_(o4.x) * y.x, sigmoidf_(o4.y) * y.y); ob.y = pk2(sigmoidf_(o4.z) * y.z, sigmoidf_(o4.w) * y.w);
            *(u32x2*)(GRP + trow * D + GW + RW + c) = ob;
        }
    }
    __syncthreads();
}

__device__ __forceinline__ void phase_rwkv_post(const Params& P, int l, unsigned char* smem, int wv) {
    ParamsPtr pp = PARAMS_PTR(P); PIN_S(pp); unsigned char* ws = pp->ws; int bidx = (int)blockIdx.x, gdim = (int)gridDim.x; PIN_S(bidx); PIN_S(gdim);
    const float* SCAN = (const float*)(ws + O_SCAN); const float* VV = (const float*)(ws + O_VV); const float* GATE = (const float*)(ws + O_GATE);
    const float* BONUS = (const float*)(ws + O_BONUS); bf16_t* GRP = (bf16_t*)(ws + O_GRP);
    const float* rln_g = pp->in[15] + (size_t)l * RW; const float* rln_b = pp->in[16] + (size_t)l * RW;
    const int tid = phase_tid(wv), lane = tid & 63, wave = tid >> 6;
    const int gw = bidx * NWAVES + wave, ngw = NWAVES * gdim;
    for (int it = gw; it < T * RH; it += ngw) {
        const int t = it / RH, h = it % RH, c = h * 64 + lane;
        const size_t o = (size_t)t * RW + c;
        const float x = SCAN[o] + SCAN[(size_t)T * RW + o];
        const float mean = wave_sum(x, lane) * (1.0f / 64.0f);
        const float dl = x - mean;
        const float var = wave_sum(dl * dl, lane) * (1.0f / 64.0f);
        float y = dl / sqrtf(var + GN_EPS) * rln_g[c] + rln_b[c];
        y += BONUS[(size_t)t * RH + h] * VV[o];
        GRP[(size_t)t * D + GW + c] = (bf16_t)f2bf(y * GATE[o]);
    }
}

__device__ __forceinline__ void phase_ln1_router(const Params& P, int l, unsigned char* smem, int wv) {
    ParamsPtr pp = PARAMS_PTR(P); PIN_S(pp); unsigned char* ws = pp->ws; int bidx = (int)blockIdx.x, gdim = (int)gridDim.x; PIN_S(bidx); PIN_S(gdim);
    const float* xin = l == 0 ? pp->in[0] : (const float*)(ws + O_XA);
    const bf16_t* MIX = (const bf16_t*)(ws + O_MIX); float* X1 = (float*)(ws + O_X1);
    int* TOPI = (int*)(ws + O_TOPI); float* TOPG = (float*)(ws + O_TOPG); int* RANK = (int*)(ws + O_RANK); bf16_t* X1B = (bf16_t*)(ws + O_X1B);
    int* BCNT = (int*)(ws + O_BCNT);
    const float* g1 = pp->in[22] + (size_t)l * D; const float* b1 = pp->in[23] + (size_t)l * D;
    const float* rw = pp->in[24] + (size_t)l * D * NE; const float* rb = pp->in[25] + (size_t)l * NE;
    const bf16_t* RWT = (const bf16_t*)(ws + O_RWT) + (size_t)l * 2 * NE * D;
    const int tid = phase_tid(wv), lane = tid & 63, wave = tid >> 6, col = lane & 15, g = lane >> 4;
    float* lgs = (float*)smem;
    int* stopi = (int*)(smem + 8192);
    for (int tile = bidx; tile < T / 64; tile += gdim) {
        __syncthreads();
        {
            f32x4 xa[4]; u32x2 xm[4];
#define LN1_LOAD(tt_) do { _Pragma("unroll") for (int j = 0; j < 4; ++j) { const int c = j * 256 + lane * 4; xa[j] = *(const f32x4*)(xin + (size_t)(tt_) * D + c); xm[j] = *(const u32x2*)(MIX + (size_t)(tt_) * D + c); } } while (0)
            LN1_LOAD(tile * 64 + wave * 8);
#pragma unroll 1
            for (int ti8 = 0; ti8 < 8; ++ti8) {
                const int t = tile * 64 + wave * 8 + ti8;
                float v[16]; float sm = 0.f;
#pragma unroll
                for (int j = 0; j < 4; ++j) {
                    v[j * 4 + 0] = ALPHA * xa[j].x + bf_lo(xm[j].x); v[j * 4 + 1] = ALPHA * xa[j].y + bf_hi(xm[j].x); v[j * 4 + 2] = ALPHA * xa[j].z + bf_lo(xm[j].y); v[j * 4 + 3] = ALPHA * xa[j].w + bf_hi(xm[j].y);
                    sm += (v[j * 4] + v[j * 4 + 1]) + (v[j * 4 + 2] + v[j * 4 + 3]);
                }
                if (ti8 < 7) LN1_LOAD(t + 1);
                const float mean = wave_sum_fast(sm, lane) * (1.0f / D); float q = 0.f;
#pragma unroll
                for (int j = 0; j < 16; ++j) { const float dl = v[j] - mean; q += dl * dl; }
                const float rstd = 1.0f / sqrtf(wave_sum_fast(q, lane) * (1.0f / D) + LN_EPS);
#pragma unroll
                for (int j = 0; j < 4; ++j) {
                    const int c = j * 256 + lane * 4;
                    const f32x4 gg = *(const f32x4*)(g1 + c), bb = *(const f32x4*)(b1 + c);
                    f32x4 o;
                    o.x = (v[j * 4 + 0] - mean) * rstd * gg.x + bb.x; o.y = (v[j * 4 + 1] - mean) * rstd * gg.y + bb.y;
                    o.z = (v[j * 4 + 2] - mean) * rstd * gg.z + bb.z; o.w = (v[j * 4 + 3] - mean) * rstd * gg.w + bb.w;
                    *(f32x4*)(X1 + (size_t)t * D + c) = o;
                    u32x2 ob; ob.x = pk2(o.x, o.y); ob.y = pk2(o.z, o.w); *(u32x2*)(X1B + (size_t)t * D + c) = ob;
                }
            }
#undef LN1_LOAD
        }
        __syncthreads();
        {
            const float* xr = X1 + (size_t)(tile * 64 + (wave >> 1) * 16 + col) * D + 8 * g;
            const bf16_t* wh = RWT + (size_t)((wave & 1) * 16 + col) * D + 8 * g; const bf16_t* wl = wh + (size_t)NE * D;
            f32x4 acc = (f32x4){0.f, 0.f, 0.f, 0.f};
#pragma unroll 4
            for (int ks = 0; ks < 32; ++ks) {
                const f32x4 x0 = *(const f32x4*)(xr + ks * 32), x1 = *(const f32x4*)(xr + ks * 32 + 4);
                const bf16x8 bh = *(const bf16x8*)(wh + ks * 32), bl = *(const bf16x8*)(wl + ks * 32);
                const bf16x8 ah = cvt8(x0, x1);
                const u32x4 ahu = __builtin_bit_cast(u32x4, ah);
                f32x4 r0, r1;
                r0.x = x0.x - bf_lo(ahu.x); r0.y = x0.y - bf_hi(ahu.x); r0.z = x0.z - bf_lo(ahu.y); r0.w = x0.w - bf_hi(ahu.y);
                r1.x = x1.x - bf_lo(ahu.z); r1.y = x1.y - bf_hi(ahu.z); r1.z = x1.z - bf_lo(ahu.w); r1.w = x1.w - bf_hi(ahu.w);
                const bf16x8 al = cvt8(r0, r1);
                acc = MFMA16(ah, bh, acc); acc = MFMA16(ah, bl, acc); acc = MFMA16(al, bh, acc);
            }
            const float rbv = rb[(wave & 1) * 16 + col];
#pragma unroll
            for (int r = 0; r < 4; ++r) lgs[((wave >> 1) * 16 + 4 * g + r) * NE + (wave & 1) * 16 + col] = acc[r] + rbv;
        }
        __syncthreads();
        if (tid < 64) {
            const float* lp = lgs + tid * NE; const int t = tile * 64 + tid;
            float tv[4]; int ti[4];
#pragma unroll
            for (int k = 0; k < 4; ++k) { tv[k] = -INFINITY; ti[k] = 0; }
            for (int e = 0; e < NE; ++e) {
                const float x = lp[e];
                if (x > tv[3]) {
                    if (x > tv[0]) { tv[3] = tv[2]; ti[3] = ti[2]; tv[2] = tv[1]; ti[2] = ti[1]; tv[1] = tv[0]; ti[1] = ti[0]; tv[0] = x; ti[0] = e; }
                    else if (x > tv[1]) { tv[3] = tv[2]; ti[3] = ti[2]; tv[2] = tv[1]; ti[2] = ti[1]; tv[1] = x; ti[1] = e; }
                    else if (x > tv[2]) { tv[3] = tv[2]; ti[3] = ti[2]; tv[2] = x; ti[2] = e; }
                    else { tv[3] = x; ti[3] = e; }
                }
            }
            const float e1 = expf(tv[1] - tv[0]), e2 = expf(tv[2] - tv[0]), e3 = expf(tv[3] - tv[0]);
            const float inv = 1.0f / (1.0f + e1 + e2 + e3);
            *(f32x4*)(TOPG + (size_t)t * 4) = (f32x4){inv, e1 * inv, e2 * inv, e3 * inv};
#pragma unroll
            for (int k = 0; k < 4; ++k) { TOPI[(size_t)t * 4 + k] = ti[k]; stopi[tid * 4 + k] = ti[k]; }
        }
        __syncthreads();
        if (tid < 256) { const int e = stopi[tid]; int r = 0; for (int a2 = 0; a2 < tid; ++a2) r += (stopi[a2] == e) ? 1 : 0; RANK[(size_t)tile * 256 + tid] = r; }
        else if (tid < 256 + NE) { const int e = tid - 256; int cnt = 0; for (int a2 = 0; a2 < 256; ++a2) cnt += (stopi[a2] == e) ? 1 : 0; BCNT[tile * NE + e] = cnt; }
    }
    __syncthreads();
}

__device__ __forceinline__ void moe_offsets(int* sh, const int* CNT, int tid) {
    if (tid == 0) {
        int acc = 0;
        for (int e = 0; e < NE; ++e) { const int c = (int)CNT[e]; sh[e] = c; sh[32 + e] = acc; acc += (c + MOEB - 1) / MOEB * MOEB; sh[64 + e] = acc; }
    }
    __syncthreads();
}
__device__ __forceinline__ int moe_expert_of_row(const int* sh, int r) {
    int e = -1;
    for (int i = 0; i < NE; ++i) if (r >= sh[32 + i] && r < sh[64 + i]) e = i;
    return e;
}

__device__ __forceinline__ void phase_scatter(const Params& P, int l, unsigned char* smem, int wv) {
    ParamsPtr pp = PARAMS_PTR(P); PIN_S(pp); unsigned char* ws = pp->ws; int bidx = (int)blockIdx.x, gdim = (int)gridDim.x; PIN_S(bidx); PIN_S(gdim);
    const int tid = phase_tid(wv);
    const int* TOPI = (const int*)(ws + O_TOPI); const int* RANK = (const int*)(ws + O_RANK); int* SLOT = (int*)(ws + O_SLOT); int* ROWT = (int*)(ws + O_ROWT);
    const int* BCNT = (const int*)(ws + O_BCNT); int* CNTF = (int*)(ws + O_CNTF);
    int* sh = (int*)smem;
    int* part = sh + 96;
    int* tot = part + 512;
    int* base = tot + 32;
    constexpr int NT = T / 64;
    const int e = tid & 31, pt = tid >> 5;
    { int sacc = 0; for (int tl = pt; tl < NT; tl += 16) sacc += BCNT[tl * NE + e]; part[pt * 32 + e] = sacc; }
    __syncthreads();
    if (tid < 32) { int sacc = 0; for (int q = 0; q < 16; ++q) sacc += part[q * 32 + tid]; tot[tid] = sacc; if (bidx == 0) CNTF[tid] = sacc; }
    __syncthreads();
    moe_offsets(sh, tot, tid);
    for (int ee = bidx; ee < NE; ee += gdim)
        for (int r = sh[32 + ee] + sh[ee] + tid; r < sh[64 + ee]; r += NTHREADS) ROWT[r] = 0;
    for (int tile = bidx; tile < NT; tile += gdim) {
        __syncthreads();
        { int sacc = 0; for (int tl = pt; tl < tile; tl += 16) sacc += BCNT[tl * NE + e]; part[pt * 32 + e] = sacc; }
        __syncthreads();
        if (tid < 32) { int sacc = sh[32 + tid]; for (int q = 0; q < 16; ++q) sacc += part[q * 32 + tid]; base[tid] = sacc; }
        __syncthreads();
        if (tid < 256) { const int a = tile * 256 + tid, dest = base[TOPI[a]] + RANK[a]; SLOT[a] = dest; ROWT[dest] = a >> 2; }
    }
    __syncthreads();
}

template <int WHICH>
__device__ __forceinline__ void phase_moe_gemm(const Params& P, int l, unsigned char* smem, int wv) {
    ParamsPtr pp = PARAMS_PTR(P); PIN_S(pp); unsigned char* ws = pp->ws; int bidx = (int)blockIdx.x, gdim = (int)gridDim.x; PIN_S(bidx); PIN_S(gdim);
    const int tid = phase_tid(wv);
    const int* CNT = (const int*)(ws + O_CNTF);
    int* sh = (int*)(smem + 131072);
    int* rbe = sh + 96;
    moe_offsets(sh, CNT, tid);
    const int nrb = sh[64 + NE - 1] / MOEB;
    for (int rb = tid; rb < nrb; rb += NTHREADS) rbe[rb] = moe_expert_of_row(sh, rb * MOEB);
    __syncthreads();
    pg8::MoeOrderT<WHICH == 1> S;
    S.K = 1024; S.G_ = gdim; S.c = bidx; S.rbe = rbe; S.rowmap = (const int*)(ws + O_ROWT);
    if (WHICH == 1) {
        S.A = (const char*)(ws + O_X1B); S.Wt = (const char*)(ws + O_W1) + (size_t)l * NE * 2 * DFF * D * 2; S.estride = (size_t)2 * DFF * D * 2; S.nN = 2 * DFF / 256; S.nwg = nrb * S.nN;
        pg8::EpiSwiglu E{(bf16_t*)(ws + O_ACT), pp->in[27] + (size_t)l * NE * 2 * DFF};
        pg8::gemm_phase<pg8::EpiSwiglu, pg8::MoeOrderT<WHICH == 1>>((LAS unsigned char*)smem, 1024, S, E, tid);
    } else {
        S.A = (const char*)(ws + O_ACT); S.Wt = (const char*)(ws + O_W2) + (size_t)l * NE * D * DFF * 2; S.estride = (size_t)D * DFF * 2; S.nN = D / 256; S.nwg = nrb * S.nN;
        pg8::EpiBf16Bias E{(bf16_t*)(ws + O_YS), D, pp->in[29] + (size_t)l * NE * D, D};
        pg8::gemm_phase<pg8::EpiBf16Bias, pg8::MoeOrderT<WHICH == 1>>((LAS unsigned char*)smem, 1024, S, E, tid);
    }
    __syncthreads();
}

__device__ __forceinline__ void phase_combine_ln2(const Params& P, int l, unsigned char* smem, int wv) {
    ParamsPtr pp = PARAMS_PTR(P); PIN_S(pp); unsigned char* ws = pp->ws; int bidx = (int)blockIdx.x, gdim = (int)gridDim.x; PIN_S(bidx); PIN_S(gdim);
    const float* X1 = (const float*)(ws + O_X1); const bf16_t* YS = (const bf16_t*)(ws + O_YS); bf16_t* XB = (bf16_t*)(ws + O_XB);
    const int* SLOT = (const int*)(ws + O_SLOT); const float* TOPG = (const float*)(ws + O_TOPG);
    float* xo = l == NL - 1 ? pp->out : (float*)(ws + O_XA);
    const float* g2 = pp->in[30] + (size_t)l * D; const float* b2 = pp->in[31] + (size_t)l * D;
    const int tid = phase_tid(wv), lane = tid & 63, wave = tid >> 6;
    const int gw = bidx * NWAVES + wave, ngw = NWAVES * gdim;
    u32x4 sl_n = (u32x4){0u, 0u, 0u, 0u}; f32x4 gg_n = (f32x4){0.f, 0.f, 0.f, 0.f};
    f32x4 xa_n[4]; u32x2 ys_n[4][4]; f32x4 gg_c = (f32x4){0.f, 0.f, 0.f, 0.f};
    const f32x4 lg[4] = {*(const f32x4*)(g2 + lane * 4), *(const f32x4*)(g2 + 256 + lane * 4), *(const f32x4*)(g2 + 512 + lane * 4), *(const f32x4*)(g2 + 768 + lane * 4)};
    const f32x4 lb[4] = {*(const f32x4*)(b2 + lane * 4), *(const f32x4*)(b2 + 256 + lane * 4), *(const f32x4*)(b2 + 512 + lane * 4), *(const f32x4*)(b2 + 768 + lane * 4)};
#define CB_META(tt_) do { sl_n = *(const u32x4*)(SLOT + (size_t)(tt_) * 4); gg_n = *(const f32x4*)(TOPG + (size_t)(tt_) * 4); } while (0)
#define CB_ROWS(tt_) do { _Pragma("unroll") for (int j = 0; j < 4; ++j) { const int c = j * 256 + lane * 4; xa_n[j] = *(const f32x4*)(X1 + (size_t)(tt_) * D + c); \
        ys_n[0][j] = *(const u32x2*)(YS + (size_t)sl_n.x * D + c); ys_n[1][j] = *(const u32x2*)(YS + (size_t)sl_n.y * D + c); ys_n[2][j] = *(const u32x2*)(YS + (size_t)sl_n.z * D + c); ys_n[3][j] = *(const u32x2*)(YS + (size_t)sl_n.w * D + c); } gg_c = gg_n; } while (0)
    if (gw < T) { CB_META(gw); CB_ROWS(gw); if (gw + ngw < T) CB_META(gw + ngw); }
    for (int t = gw; t < T; t += ngw) {
        float v[16]; float sm = 0.f;
        const float gk[4] = {gg_c.x, gg_c.y, gg_c.z, gg_c.w};
#pragma unroll
        for (int j = 0; j < 4; ++j) {
            const f32x4 a = xa_n[j];
            f32x4 y = (f32x4){0.f, 0.f, 0.f, 0.f};
#pragma unroll
            for (int k = 0; k < 4; ++k) { const u32x2 yk = ys_n[k][j]; y.x += gk[k] * bf_lo(yk.x); y.y += gk[k] * bf_hi(yk.x); y.z += gk[k] * bf_lo(yk.y); y.w += gk[k] * bf_hi(yk.y); }
            v[j * 4 + 0] = ALPHA * a.x + y.x; v[j * 4 + 1] = ALPHA * a.y + y.y; v[j * 4 + 2] = ALPHA * a.z + y.z; v[j * 4 + 3] = ALPHA * a.w + y.w;
            sm += (v[j * 4] + v[j * 4 + 1]) + (v[j * 4 + 2] + v[j * 4 + 3]);
        }
        if (t + ngw < T) { CB_ROWS(t + ngw); if (t + 2 * ngw < T) CB_META(t + 2 * ngw); }
        const float mean = wave_sum_fast(sm, lane) * (1.0f / D); float q = 0.f;
#pragma unroll
        for (int j = 0; j < 16; ++j) { const float dl = v[j] - mean; q += dl * dl; }
        const float rstd = 1.0f / sqrtf(wave_sum_fast(q, lane) * (1.0f / D) + LN_EPS);
#pragma unroll
        for (int j = 0; j < 4; ++j) {
            const int c = j * 256 + lane * 4;
            f32x4 o;
            o.x = (v[j * 4 + 0] - mean) * rstd * lg[j].x + lb[j].x; o.y = (v[j * 4 + 1] - mean) * rstd * lg[j].y + lb[j].y;
            o.z = (v[j * 4 + 2] - mean) * rstd * lg[j].z + lb[j].z; o.w = (v[j * 4 + 3] - mean) * rstd * lg[j].w + lb[j].w;
            *(f32x4*)(xo + (size_t)t * D + c) = o;
            if (l != NL - 1) { u32x2 ob; ob.x = pk2(o.x, o.y); ob.y = pk2(o.z, o.w); *(u32x2*)(XB + (size_t)t * D + c) = ob; }
        }
    }
#undef CB_META
#undef CB_ROWS
}

__device__ __forceinline__ void phase_inproj(const Params& P, int l, unsigned char* smem, int wv) {
    ParamsPtr pp = PARAMS_PTR(P); PIN_S(pp); unsigned char* ws = pp->ws; int bidx = (int)blockIdx.x, gdim = (int)gridDim.x; PIN_S(bidx); PIN_S(gdim);
    const int tid = phase_tid(wv);
    pg8::DenseOrder S; S.init(ws + O_XB, (const bf16_t*)(ws + O_WIN) + (size_t)l * PLD * D, T, PLD, D, gdim, bidx);
    pg8::EpiProj E{(bf16_t*)(ws + O_PROJ), PLD, (float*)(ws + O_PROJG), PLD / 256 - 1};
    pg8::gemm_phase<pg8::EpiProj, pg8::DenseOrder>((LAS unsigned char*)smem, D, S, E, tid);
    __syncthreads();
}
__device__ __forceinline__ void phase_outproj(const Params& P, int l, unsigned char* smem, int wv) {
    ParamsPtr pp = PARAMS_PTR(P); PIN_S(pp); unsigned char* ws = pp->ws; int bidx = (int)blockIdx.x, gdim = (int)gridDim.x; PIN_S(bidx); PIN_S(gdim);
    const int tid = phase_tid(wv);
    pg8::DenseOrder S; S.init(ws + O_GRP, (const bf16_t*)(ws + O_WOUT) + (size_t)l * D * D, T, D, D, gdim, bidx);
    pg8::EpiProj E{(bf16_t*)(ws + O_MIX), D, nullptr, -1};
    pg8::gemm_phase<pg8::EpiProj, pg8::DenseOrder>((LAS unsigned char*)smem, D, S, E, tid);
    __syncthreads();
}

#ifndef EMU
#define XB_TMO      128
#define XB_XCNT(j)  (256  + 64 * (j))
#define XB_XSUB(j)  (1280 + 64 * (j))
#define XB_XGEN(j)  (2304 + 64 * (j))
#define XB_TOP      3328
#define XB_TOPGEN   3392
#define XCD_BAR_WORDS 3456
#define XB_SPIN_CAP (1u << 25)
__device__ __forceinline__ unsigned xb_ld(unsigned* p)              { return __hip_atomic_load(p, __ATOMIC_RELAXED, __HIP_MEMORY_SCOPE_AGENT); }
__device__ __forceinline__ unsigned xb_add(unsigned* p, unsigned v) { return __hip_atomic_fetch_add(p, v, __ATOMIC_RELAXED, __HIP_MEMORY_SCOPE_AGENT); }
__device__ __forceinline__ unsigned xb_xcc_id() { return (unsigned)__builtin_amdgcn_s_getreg((3 << 11) | 20) & 0xFu; }
#define XB_SPIN(cond, bar) do { unsigned _sp = 0; while (cond) { __builtin_amdgcn_s_sleep(1); \
    if ((++_sp & 255u) == 0u) { if (xb_ld(&(bar)[XB_TMO])) break; if (_sp > XB_SPIN_CAP) { atomicAdd(&(bar)[XB_TMO], 1u); break; } } } } while (0)
struct XcdBarrier { unsigned* bar; unsigned x; volatile LAS unsigned* st; };
__device__ __forceinline__ XcdBarrier xcd_barrier_post(unsigned* bar, volatile LAS unsigned* st) {
    XcdBarrier b; b.bar = bar; b.x = xb_xcc_id(); b.st = st;
    if (threadIdx.x == 0) (void)xb_add(&bar[XB_XCNT(b.x)], 1u);
    return b;
}
__device__ __forceinline__ void xcd_barrier_complete(unsigned* bar, unsigned x, unsigned& nloc, unsigned& nx) {
    const unsigned G = gridDim.x * gridDim.y * gridDim.z;
    unsigned sum, cnt, mine, sp = 0u;
    for (;;) {
        sum = 0u; cnt = 0u; mine = 0u;
#pragma unroll
        for (unsigned j = 0; j < 16; ++j) { const unsigned c = xb_ld(&bar[XB_XCNT(j)]); sum += c; cnt += (c > 0u) ? 1u : 0u; mine = (j == x) ? c : mine; }
        if (sum == G) break;
        __builtin_amdgcn_s_sleep(1);
        if ((++sp & 255u) == 0u) { if (xb_ld(&bar[XB_TMO])) break; if (sp > XB_SPIN_CAP) { atomicAdd(&bar[XB_TMO], 1u); break; } }
    }
    nloc = mine > 0u ? mine : 1u; nx = cnt > 0u ? cnt : 1u;
}
__device__ __forceinline__ void xcd_barrier(const XcdBarrier& b) {
    asm volatile("s_waitcnt vmcnt(0)" ::: "memory");
    __syncthreads();
    if (threadIdx.x == 0) {
        unsigned* bar = b.bar;
        __builtin_amdgcn_s_waitcnt(0);
        unsigned nloc = b.st[0], nx = b.st[1];
        if (nloc == 0u) { xcd_barrier_complete(bar, b.x, nloc, nx); b.st[0] = nloc; b.st[1] = nx; }
        const unsigned old = xb_add(&bar[XB_XSUB(b.x)], 1u);
        const unsigned gen = old / nloc;
        if (old + 1u == (gen + 1u) * nloc) {
            __builtin_amdgcn_fence(__ATOMIC_RELEASE, "agent");
            asm volatile("s_waitcnt vmcnt(0)" ::: "memory");
            const unsigned og = xb_add(&bar[XB_TOP], 1u);
            const unsigned tg = og / nx;
            if (og + 1u == (tg + 1u) * nx) xb_add(&bar[XB_TOPGEN], 1u);
            else XB_SPIN(xb_ld(&bar[XB_TOPGEN]) == tg, bar);
            __builtin_amdgcn_fence(__ATOMIC_ACQUIRE, "agent");
            xb_add(&bar[XB_XGEN(b.x)], 1u);
            asm volatile("s_waitcnt vmcnt(0)" ::: "memory");
        } else {
            XB_SPIN(xb_ld(&bar[XB_XGEN(b.x)]) == gen, bar);
            __builtin_amdgcn_fence(__ATOMIC_ACQUIRE, "agent");
            asm volatile("s_waitcnt vmcnt(0)" ::: "memory");
        }
    }
    __syncthreads();
}
#endif

__global__ void __launch_bounds__(512, 2) mk_fwd(Params P) {
#ifdef EMU
    unsigned char* smem = g_blk->lds;
#else
    extern __shared__ __attribute__((aligned(16))) unsigned char smem[];
    volatile LAS unsigned* bst = (volatile LAS unsigned*)(smem + LDS_BYTES - 16);
    if (threadIdx.x == 0) { bst[0] = 0u; bst[1] = 0u; bst[2] = 0u; bst[3] = 0u; }
    __syncthreads();
    XcdBarrier bar; bar.bar = (unsigned*)P.ws + CW_BAR; bar.x = 0; bar.st = bst;
    if (P.ph_hi - P.ph_lo > 1) bar = xcd_barrier_post((unsigned*)P.ws + CW_BAR, bst);
#endif
    const int lo = P.ph_lo, hi = P.ph_hi;
#ifdef EMU
    const int wv = (int)threadIdx.x >> 6;
#else
    const int wv = RFL((int)threadIdx.x >> 6);
#endif
#ifdef EMU
#define SEAM(id) do {} while (0)
#else
#define SEAM(id) do { if ((id) + 1 < hi) xcd_barrier(bar); } while (0)
#endif
#ifndef MK_ONLY_PHASE
#define MK_ONLY_PHASE -1
#endif
#ifndef MK_DUP_MASK
#define MK_DUP_MASK 0
#endif
#define PHG(kc, id, ...) do { if (MK_ONLY_PHASE < 0 || MK_ONLY_PHASE == (kc)) { const int id_ = (id); if (id_ >= lo && id_ < hi) { if ((MK_DUP_MASK >> (kc)) & 1) { __VA_ARGS__; SEAM(id_ - 1); } __VA_ARGS__; SEAM(id_); } } } while (0)
#define PH(k, ...) PHG(1 + (k), 1 + l * NPH + (k), __VA_ARGS__)
    PHG(0, 0, phase_prologue(P, smem, wv));
    for (int l = 0; l < NL; ++l) {
        PH(0, phase_inproj(P, l, smem, wv));
#if MK_RWKV_CHUNKED
        PH(1, phase_prep32(P, l, smem, wv));
#else
        PH(1, phase_prep(P, l, smem, wv));
#endif
#if MK_RWKV_CHUNKED
        PH(2, { phase_rwkv_pre(P, l, smem, wv); phase_mlstm_local(P, l, smem, wv, (int)blockIdx.x, (int)gridDim.x); });
        PH(3, { phase_rwkv_seq(P, l, smem, wv); phase_mlstm_carry(P, l, smem, wv); });
        PH(4, { phase_rwkv_out(P, l, smem, wv); phase_mlstm_out(P, l, smem, wv); phase_gmlp_mix(P, l, smem, wv, (int)blockIdx.x, (int)gridDim.x); });
#else
        PH(2, { const int G_ = (int)gridDim.x, NSC = 2 * NB * RH * 4;
                if (G_ >= NSC + 32) { if ((int)blockIdx.x < NSC) phase_rwkv_scan(P, l, smem, wv, (int)blockIdx.x, NSC);
                                      else phase_mlstm_local(P, l, smem, wv, (int)blockIdx.x - NSC, G_ - NSC); }
                else { phase_rwkv_scan(P, l, smem, wv, (int)blockIdx.x, G_); phase_mlstm_local(P, l, smem, wv, (int)blockIdx.x, G_); } });
        PH(3, phase_mlstm_carry(P, l, smem, wv));
        PH(4, { phase_mlstm_out(P, l, smem, wv); phase_gmlp_mix(P, l, smem, wv, (int)blockIdx.x, (int)gridDim.x); phase_rwkv_post(P, l, smem, wv); });
#endif
        PH(5, phase_outproj(P, l, smem, wv));
        PH(6, phase_ln1_router(P, l, smem, wv));
        PH(7, phase_scatter(P, l, smem, wv));
        PH(8, phase_moe_gemm<1>(P, l, smem, wv));
        PH(9, phase_moe_gemm<2>(P, l, smem, wv));
        PH(10, phase_combine_ln2(P, l, smem, wv));
    }
#undef PHG
#undef PH
#undef SEAM
}

}

#ifndef EMU
extern "C" void kernel_launch(void* const* d_in, const int* in_sizes, int n_in, void* d_out, int out_size, void* d_ws, size_t ws_size, hipStream_t stream) {
    using namespace mk;
    static int grid = 0;
    if (grid == 0) {
        if (n_in != 32 || out_size != T * D || ws_size < WS_END) { fprintf(stderr, "kernel_launch: unexpected shapes (n_in %d out %d ws %zu need %zu)\n", n_in, out_size, ws_size, (size_t)WS_END); grid = -1; return; }
        int dev = 0, cus = 0;
        if (hipGetDevice(&dev) != hipSuccess || hipDeviceGetAttribute(&cus, hipDeviceAttributeMultiprocessorCount, dev) != hipSuccess) { grid = -1; return; }
        if (hipFuncSetAttribute((const void*)mk_fwd, hipFuncAttributeMaxDynamicSharedMemorySize, LDS_BYTES) != hipSuccess) { fprintf(stderr, "kernel_launch: hipFuncSetAttribute failed\n"); grid = -1; return; }
        int per_cu = 0;
        (void)hipOccupancyMaxActiveBlocksPerMultiprocessor(&per_cu, (const void*)mk_fwd, NTHREADS, LDS_BYTES);
        (void)hipGetLastError();
        grid = cus;
    }
    if (grid < 0) return;
    (void)hipMemsetAsync(d_ws, 0, CTL_BYTES, stream);
    Params p{};
    for (int i = 0; i < 32; ++i) p.in[i] = (const float*)d_in[i];
    p.out = (float*)d_out; p.ws = (unsigned char*)d_ws;
#if MK_ONE_LAUNCH
    p.ph_lo = 0; p.ph_hi = 1 + NL * NPH;
    hipLaunchKernelGGL(mk_fwd, dim3(grid), dim3(NTHREADS), LDS_BYTES, stream, p);
#else
    for (int id = 0; id < 1 + NL * NPH; ++id) {
        p.ph_lo = id; p.ph_hi = id + 1;
        hipLaunchKernelGGL(mk_fwd, dim3(grid), dim3(NTHREADS), LDS_BYTES, stream, p);
    }
#endif
}
#endif
```

```cpp
#ifndef EMU
#include <hip/hip_runtime.h>
#endif
#include <cstdio>
#include <cstdint>
#include <cmath>

#ifndef CFG_BATCH
#define CFG_BATCH 4
#endif
#ifndef CFG_SEQ
#define CFG_SEQ 4096
#endif
#ifndef CFG_LAYERS
#define CFG_LAYERS 4
#endif
#ifndef MK_RWKV_CHUNKED
#define MK_RWKV_CHUNKED 1
#endif
#ifndef MK_PROBE
#define MK_PROBE 0
#endif
#ifndef MK_SP2
#define MK_SP2 1
#endif
#ifndef MK_ONE_LAUNCH
#define MK_ONE_LAUNCH 1
#endif

namespace mk {
constexpr int NB = CFG_BATCH, S = CFG_SEQ, T = NB * S, NL = CFG_LAYERS, D = 1024;
constexpr int GW = 256, RW = 384, MW = 384, HD = 64, GH = 4, RH = 6, MH = 6, CH = 128, NCH = S / CH;
constexpr int PIN = 3480, PLD = 3584, RPROJ = 1408;
constexpr int C_RW = 512, C_MW = 1920;
constexpr int NE = 32, TOPK = 4, DFF = 1024, MOEB = 256;
constexpr int NROWS = (T * TOPK / MOEB + NE) * MOEB;
constexpr float LN_EPS = 1e-5f, GN_EPS = 64e-5f;
constexpr float ALPHA = 1.6817928305074290f;
constexpr int NTHREADS = 512, NWAVES = 8;
constexpr int LDS_BYTES = 160 * 1024;
constexpr int NPH = 11;

typedef float f32x4 __attribute__((ext_vector_type(4)));
typedef unsigned u32x4 __attribute__((ext_vector_type(4)));
typedef unsigned u32x2 __attribute__((ext_vector_type(2)));
typedef short bf16x8 __attribute__((ext_vector_type(8)));
typedef unsigned short bf16_t;

constexpr size_t al(size_t x) { return (x + 255) & ~(size_t)255; }
constexpr size_t CTL_BYTES = 1u << 20;
constexpr size_t O_XA = CTL_BYTES;
constexpr size_t O_XB = O_XA + al((size_t)T * D * 4);
constexpr size_t O_X1 = O_XB + al((size_t)T * D * 2);
constexpr size_t O_X1B = O_X1 + al((size_t)T * D * 4);
constexpr size_t O_PROJ = O_X1B + al((size_t)T * D * 2);
constexpr size_t O_PROJG = O_PROJ + al((size_t)T * PLD * 2);
constexpr size_t O_MIX = O_PROJ + al((size_t)T * PLD * 4);
constexpr size_t O_GRP = O_MIX + al((size_t)T * D * 4);
constexpr size_t O_UG = O_GRP + al((size_t)T * D * 2);
constexpr size_t O_VN = O_UG + al((size_t)T * GW * 4);
constexpr size_t O_RR = O_VN + al((size_t)T * GW * 4);
constexpr size_t O_VV = O_RR + al((size_t)T * RW * 4);
constexpr size_t O_KK = O_VV + al((size_t)T * RW * 4);
constexpr size_t O_DEC = O_KK + al((size_t)T * RW * 4);
constexpr size_t O_KD = O_DEC + al((size_t)2 * T * RW * 4);
constexpr size_t O_ICLR = O_KD + al((size_t)2 * T * RW * 4);
constexpr size_t O_GATE = O_ICLR + al((size_t)2 * T * RW * 4);
constexpr size_t O_BONUS = O_GATE + al((size_t)T * RW * 4);
constexpr size_t O_SCAN = O_BONUS + al((size_t)T * RH * 4);
constexpr size_t O_MQ = O_SCAN + al((size_t)2 * T * RW * 4);
constexpr size_t O_MK = O_MQ + al((size_t)T * MW * 4);
constexpr size_t O_IG = O_MK + al((size_t)T * MW * 4);
constexpr size_t O_LF = O_IG + al((size_t)2 * T * MH * 4);
constexpr size_t O_CL = O_LF + al((size_t)2 * T * MH * 4);
constexpr size_t O_NL = O_CL + al((size_t)2 * NB * MH * NCH * 4096 * 4);
constexpr size_t O_ML = O_NL + al((size_t)2 * NB * MH * NCH * 64 * 4);
constexpr size_t O_BL = O_ML + al((size_t)2 * NB * MH * NCH * 4);
constexpr size_t O_MIN = O_BL + al((size_t)2 * NB * MH * NCH * 4);
constexpr size_t O_TOPI = O_MIN + al((size_t)2 * NB * MH * NCH * 4);
constexpr size_t O_TOPG = O_TOPI + al((size_t)T * 4 * 4);
constexpr size_t O_RANK = O_TOPG + al((size_t)T * 4 * 4);
constexpr size_t O_SLOT = O_RANK + al((size_t)T * 4 * 4);
constexpr size_t O_MQB = O_SLOT + al((size_t)T * 4 * 4);
constexpr size_t O_MKB = O_MQB + al((size_t)T * MW * 2);
constexpr size_t O_KT = O_MKB + al((size_t)T * MW * 2);
constexpr size_t O_VT = O_KT + al((size_t)T * MW * 2);
constexpr size_t O_GVT = O_VT + al((size_t)T * MW * 2);
constexpr size_t O_PMX = O_GVT + al((size_t)2 * T * MH * 4);
constexpr size_t O_BCT = O_PMX + al((size_t)2 * T * MH * 4);
constexpr size_t O_BRKR = O_BCT + al((size_t)2 * T * MH * 4);
constexpr int RC = 64, RNC = S / RC, RUN = 2 * NB * RH * RNC;
constexpr size_t O_LW = O_BRKR + al((size_t)2 * T * RH * 2 * 4);
constexpr size_t O_RQ = O_LW + al((size_t)2 * T * RW * 4);
constexpr size_t O_RA = O_RQ + al((size_t)RUN * 4096 * 2);
constexpr size_t O_RS = O_RA + al((size_t)RUN * 4096 * 2);
constexpr size_t O_RH = O_RS + al((size_t)RUN * 4096 * 2);
constexpr size_t O_RG = O_RH + al((size_t)RUN * 4096 * 4);
constexpr size_t O_RB = O_RG + al((size_t)RUN * 4096 * 4);
constexpr size_t O_VB = O_RB + al((size_t)T * RW * 2);
constexpr size_t O_KKB = O_VB + al((size_t)T * RW * 2);
constexpr size_t O_BBB = O_KKB + al((size_t)T * RW * 2);
constexpr size_t O_KDB = O_BBB + al((size_t)2 * T * RW * 2);
constexpr size_t O_RK7 = O_KDB + al((size_t)2 * T * RW * 2);
constexpr size_t O_VNT = O_RK7 + al((size_t)T * RW * 16);
constexpr size_t O_WSB = O_VNT + al((size_t)T * GW * 2);
constexpr size_t O_LWT = O_WSB + al((size_t)NL * GH * CH * CH * 2);
constexpr size_t O_RWT = O_LWT + al((size_t)NL * 1920 * 128 * 2);
constexpr size_t O_BCNT = O_RWT + al((size_t)NL * 2 * NE * D * 2);
constexpr size_t O_CNTF = O_BCNT + al((size_t)(T / 64) * NE * 4);
constexpr size_t O_ROWT = O_CNTF + al((size_t)NE * 4);
constexpr size_t O_XS = O_ROWT + al((size_t)NROWS * 4);
constexpr size_t O_ACT = O_XS + al((size_t)NROWS * D * 2);
constexpr size_t O_YS = O_ACT + al((size_t)NROWS * DFF * 2);
constexpr size_t O_WIN = O_YS + al((size_t)NROWS * D * 2);
constexpr size_t O_WOUT = O_WIN + al((size_t)NL * PLD * D * 2);
constexpr size_t O_W1 = O_WOUT + al((size_t)NL * D * D * 2);
constexpr size_t O_W2 = O_W1 + al((size_t)NL * NE * 2 * DFF * D * 2);
constexpr size_t WS_END = O_W2 + al((size_t)NL * NE * D * DFF * 2);

constexpr int CW_BAR = 4096;
constexpr int CW_CNT = 16384;

struct Params { const float* in[32]; float* out; unsigned char* ws; int ph_lo, ph_hi; };
#ifdef EMU
typedef const Params* ParamsPtr;
#define PARAMS_PTR(P) (&(P))
#else
typedef const __attribute__((address_space(4))) Params* ParamsPtr;
#define PARAMS_PTR(P) ((ParamsPtr)__builtin_amdgcn_kernarg_segment_ptr())
#endif

#ifdef EMU
#define WAVE_SYNC() emu_wave_barrier()
#define PIN_V(x) do {} while (0)
#define PIN_S(x) do {} while (0)
#else
#define WAVE_SYNC() __builtin_amdgcn_wave_barrier()
#define PIN_V(x) asm volatile("" : "+v"(x))
#define PIN_S(x) asm volatile("" : "+s"(x))
#endif
#ifdef EMU
__device__ __forceinline__ int phase_tid(int wv) { (void)wv; return threadIdx.x; }
#else
__device__ __forceinline__ int phase_tid(int wv) { int t; asm volatile("v_mbcnt_lo_u32_b32 %0, -1, 0\n\tv_mbcnt_hi_u32_b32 %0, -1, %0" : "=v"(t)); return (wv << 6) + t; }
#endif

#ifdef EMU
#define SHX(v, m, lane) __shfl_xor(v, m)
#else
__device__ __forceinline__ float shx_(float v, int m, int lane) { return __builtin_bit_cast(float, __builtin_amdgcn_ds_bpermute((lane ^ m) << 2, __builtin_bit_cast(int, v))); }
__device__ __forceinline__ int shx_(int v, int m, int lane) { return __builtin_amdgcn_ds_bpermute((lane ^ m) << 2, v); }
#define SHX(v, m, lane) shx_(v, m, lane)
#endif
#ifdef EMU
#define SHUP(v, o, lane) __shfl(v, ((lane) - (o)) & 63)
#define RDL(v, src) __shfl(v, src)
#define SHL(v, src) __shfl(v, src)
#else
#define SHL(v, src) __builtin_bit_cast(float, __builtin_amdgcn_ds_bpermute((src) << 2, __builtin_bit_cast(int, (float)(v))))
#define SHUP(v, o, lane) __builtin_bit_cast(float, __builtin_amdgcn_ds_bpermute((((lane) - (o)) & 63) << 2, __builtin_bit_cast(int, (float)(v))))
#define RDL(v, src) __builtin_bit_cast(float, __builtin_amdgcn_readlane(__builtin_bit_cast(int, (float)(v)), src))
#endif
__device__ __forceinline__ float wave_sum(float v, int lane) {
#pragma unroll
    for (int o = 32; o >= 1; o >>= 1) v += SHX(v, o, lane);
    return v;
}
#ifdef EMU
__device__ __forceinline__ float fexp(float x) { return expf(x); }
__device__ __forceinline__ float flog(float x) { return logf(x); }
__device__ __forceinline__ float frcp(float x) { return 1.0f / x; }
#else
__device__ __forceinline__ float fexp(float x) { return __builtin_amdgcn_exp2f(x * 1.4426950408889634f); }
__device__ __forceinline__ float flog(float x) { return __builtin_amdgcn_logf(x) * 0.6931471805599453f; }
__device__ __forceinline__ float frcp(float x) { return __builtin_amdgcn_rcpf(x); }
#endif
__device__ __forceinline__ float sigmoidf_(float x) { return frcp(1.0f + fexp(-x)); }
__device__ __forceinline__ float softplusf_(float x) { return fmaxf(x, 0.f) + flog(1.0f + fexp(-fabsf(x))); }
__device__ __forceinline__ float ftanh(float x) { return 1.0f - 2.0f * frcp(1.0f + fexp(2.0f * x)); }
__device__ __forceinline__ float geluf_(float v) {
    const float av = fabsf(v), t = frcp(1.0f + 0.2316418882f * av);
    float q = t * 0.5307027145f + (-0.7265760135f); q = q * t + 0.7107068705f; q = q * t + (-0.142248368f); q = q * t + 0.127414796f; q = q * t;
    const float m = v * (q * fexp(-0.5f * v * v));
    return v < 0.f ? m : v - m;
}

#ifdef EMU
#define LAS
#define WAIT_V(n) do {} while (0)
#define WAIT_L(n) do {} while (0)
#define S_BARRIER() __syncthreads()
#define SETPRIO(x) do {} while (0)
#define SCHED_BAR() do {} while (0)
#define RFL(x) (x)
static inline void emu_glds16(const void* g, void* l) { memcpy((char*)l + (g_blk->cur & 63) * 16, g, 16); }
#define GLDS16(gptr, ldsptr) emu_glds16((const void*)(gptr), (void*)(ldsptr))
static inline float emu_bf2f(unsigned short b) { unsigned u = (unsigned)b << 16; float f; memcpy(&f, &u, 4); return f; }
static inline f32x4 emu_mfma16(bf16x8 a, bf16x8 b, f32x4 c) {
    EmuBlock* blk = g_blk; const int cur = blk->cur, lane = cur & 63, wbase = cur & ~63;
    static thread_local unsigned short Ash[32][64][8], Bsh[32][64][8];
    const int w = cur >> 6;
    for (int j = 0; j < 8; ++j) { Ash[w][lane][j] = (unsigned short)a[j]; Bsh[w][lane][j] = (unsigned short)b[j]; }
    emu_wave_barrier();
    const int col = lane & 15;
    for (int r = 0; r < 4; ++r) { const int row = 4 * (lane >> 4) + r; float sum = c[r];
        for (int k = 0; k < 32; ++k) sum += emu_bf2f(Ash[w][row + 16 * (k >> 3)][k & 7]) * emu_bf2f(Bsh[w][col + 16 * (k >> 3)][k & 7]);
        c[r] = sum; }
    emu_wave_barrier(); (void)wbase;
    return c;
}
#define MFMA16(a, b, c) emu_mfma16(a, b, c)
#else
#define LAS __attribute__((address_space(3)))
#define WAIT_V(n) asm volatile("s_waitcnt vmcnt(" #n ")" ::: "memory")
#define WAIT_L(n) asm volatile("s_waitcnt lgkmcnt(" #n ")" ::: "memory")
#define S_BARRIER() __builtin_amdgcn_s_barrier()
#define SETPRIO(x) __builtin_amdgcn_s_setprio(x)
#define SCHED_BAR() __builtin_amdgcn_sched_barrier(0)
#define RFL(x) __builtin_amdgcn_readfirstlane(x)
#define GLDS16(gptr, ldsptr) __builtin_amdgcn_global_load_lds((const unsigned*)(gptr), (LAS unsigned*)(ldsptr), 16, 0, 0)
#define MFMA16(a, b, c) __builtin_amdgcn_mfma_f32_16x16x32_bf16(a, b, c, 0, 0, 0)
#endif

#ifdef EMU
__device__ __forceinline__ unsigned f2bf(float f) { unsigned u = __builtin_bit_cast(unsigned, f); return (u + 0x7fffu + ((u >> 16) & 1u)) >> 16; }
#else
__device__ __forceinline__ unsigned f2bf(float f) { return (unsigned)__builtin_bit_cast(unsigned short, (__bf16)f); }
#endif
#ifdef EMU
__device__ __forceinline__ unsigned pk2(float lo, float hi) { return f2bf(lo) | (f2bf(hi) << 16); }
#else
typedef float f32x2c __attribute__((ext_vector_type(2)));
typedef __bf16 bf16x2c __attribute__((ext_vector_type(2)));
__device__ __forceinline__ unsigned pk2(float lo, float hi) { const f32x2c v = {lo, hi}; return __builtin_bit_cast(unsigned, __builtin_convertvector(v, bf16x2c)); }
#endif
__device__ __forceinline__ bf16x8 cvt8(const f32x4 a, const f32x4 b) {
    u32x4 w; w.x = pk2(a.x, a.y); w.y = pk2(a.z, a.w); w.z = pk2(b.x, b.y); w.w = pk2(b.z, b.w); return __builtin_bit_cast(bf16x8, w);
}
__device__ __forceinline__ float bf_lo(unsigned u) { return __builtin_bit_cast(float, u << 16); }
__device__ __forceinline__ float bf_hi(unsigned u) { return __builtin_bit_cast(float, u & 0xffff0000u); }

namespace pg8 {
constexpr int BM = 256, BK = 64, HALF = 128, HTB = HALF * BK * 2, STAGE_BYTES = 8 * HTB, NXCD = 8, WGM = 8;
__host__ __device__ __forceinline__ int lds_byte(int r, int c) { const int st = (r >> 4) * 2 + (c >> 5), rr = r & 15, cc = c & 31, ob = rr * 64 + cc * 2; return st * 1024 + (ob ^ (((ob >> 9) & 1) << 5)); }
__host__ __device__ __forceinline__ void stage_rc(int b, int& R, int& C) { const int st = b / 1024, sb = b % 1024, swz = sb ^ (((sb >> 9) & 1) << 5); R = (st >> 1) * 16 + swz / 64; C = (st & 1) * 32 + (swz % 64) / 2; }
__host__ __device__ __forceinline__ int perm32(int rho) { const int n = rho >> 4, i = rho & 15; return 8 * (i >> 2) + 4 * n + (i & 3); }
struct Unit { int pm, pn, e; };

struct DenseOrder {
    static constexpr bool GATHER = false;
    const char* A; const char* Bt; int K; int nM, nN, nwg, G, c;
    __device__ __forceinline__ void init(const void* A_, const void* Bt_, int M, int N, int K_, int G_, int c_) { A = (const char*)A_; Bt = (const char*)Bt_; K = K_; nM = M / BM; nN = N / BM; nwg = nM * nN; G = G_; c = c_; }
    __device__ __forceinline__ bool next(int i, Unit& u) const {
        const long L = (long)i * G + c; if (L >= nwg) return false;
        int wgid = (int)L; { const int q = nwg / NXCD, r = nwg % NXCD, xcd = wgid % NXCD, off = wgid / NXCD; wgid = (xcd < r ? xcd * (q + 1) : r * (q + 1) + (xcd - r) * q) + off; }
        const int nig = WGM * nN, gid = wgid / nig, fm = gid * WGM, gsz = (nM - fm) < WGM ? (nM - fm) : WGM;
        u.pm = fm + ((wgid % nig) % gsz); u.pn = (wgid % nig) / gsz; u.e = 0; return true;
    }
    __device__ __forceinline__ const char* abase(const Unit& u) const { return A + (size_t)u.pm * BM * K * 2; }
    __device__ __forceinline__ const char* bbase(const Unit& u) const { return Bt + (size_t)u.pn * BM * K * 2; }
};
template <bool G>
struct MoeOrderT {
    static constexpr bool GATHER = G;
    const char* A; const char* Wt; int K; int nN, nwg, G_, c; size_t estride; const int* rbe; const int* rowmap;
    __device__ __forceinline__ bool next(int i, Unit& u) const {
        const long L = (long)i * G_ + c; if (L >= nwg) return false;
        u.pm = (int)(L / nN); u.pn = (int)(L % nN); u.e = rbe[u.pm]; return true;
    }
    __device__ __forceinline__ const char* abase(const Unit& u) const { return G ? A : A + (size_t)u.pm * BM * K * 2; }
    __device__ __forceinline__ const char* bbase(const Unit& u) const { return Wt + (size_t)u.e * estride + (size_t)u.pn * BM * K * 2; }
};
struct EpiF32 {
    static constexpr bool PERM = false;
    float* C; int ldc;
    __device__ __forceinline__ void operator()(const f32x4 (&acc)[2][2][4][2], const Unit& u, int wr, int wc, int fr, int fq) const {
        const int row0 = u.pm * BM + wr * 64 + fr, col0 = u.pn * BM + wc * 32 + 4 * fq;
#pragma unroll
        for (int ai = 0; ai < 2; ++ai)
#pragma unroll
            for (int m = 0; m < 4; ++m) { float* rowp = C + (size_t)(row0 + ai * HALF + m * 16) * ldc + col0;
#pragma unroll
                for (int bj = 0; bj < 2; ++bj)
#pragma unroll
                    for (int n = 0; n < 2; ++n) *(f32x4*)(rowp + bj * HALF + n * 16) = acc[ai][bj][m][n]; }
    }
};
struct EpiProj {
    static constexpr bool PERM = true;
    bf16_t* O; int ldc; float* G; int lastt;
    __device__ __forceinline__ void operator()(const f32x4 (&acc)[2][2][4][2], const Unit& u, int wr, int wc, int fr, int fq) const {
        const int row0 = u.pm * BM + wr * 64 + fr, col0 = u.pn * BM + wc * 32 + 8 * fq;
#pragma unroll
        for (int ai = 0; ai < 2; ++ai)
#pragma unroll
            for (int m = 0; m < 4; ++m) { bf16_t* rowp = O + (size_t)(row0 + ai * HALF + m * 16) * ldc + col0;
#pragma unroll
                for (int bj = 0; bj < 2; ++bj) { const f32x4 v0 = acc[ai][bj][m][0], v1 = acc[ai][bj][m][1];
                    u32x4 w; w.x = pk2(v0[0], v0[1]); w.y = pk2(v0[2], v0[3]); w.z = pk2(v1[0], v1[1]); w.w = pk2(v1[2], v1[3]);
                    *(u32x4*)(rowp + bj * HALF) = w; } }
        if (u.pn == lastt) {
#pragma unroll
            for (int ai = 0; ai < 2; ++ai)
#pragma unroll
                for (int m = 0; m < 4; ++m) { float* rowp = G + (size_t)(row0 + ai * HALF + m * 16) * BM + wc * 32 + 8 * fq;
#pragma unroll
                    for (int bj = 0; bj < 2; ++bj) { *(f32x4*)(rowp + bj * HALF) = acc[ai][bj][m][0]; *(f32x4*)(rowp + bj * HALF + 4) = acc[ai][bj][m][1]; } }
        }
    }
};
struct EpiBf16Bias {
    static constexpr bool PERM = true;
    bf16_t* O; int ldc; const float* bias; int bias_estride;
    __device__ __forceinline__ void operator()(const f32x4 (&acc)[2][2][4][2], const Unit& u, int wr, int wc, int fr, int fq) const {
        const int row0 = u.pm * BM + wr * 64 + fr, col0 = u.pn * BM + wc * 32 + 8 * fq;
        const float* bp = bias + (size_t)u.e * bias_estride + col0;
        f32x4 bv[2][2];
#pragma unroll
        for (int bj = 0; bj < 2; ++bj)
#pragma unroll
            for (int n = 0; n < 2; ++n) bv[bj][n] = *(const f32x4*)(bp + bj * HALF + 4 * n);
#pragma unroll
        for (int ai = 0; ai < 2; ++ai)
#pragma unroll
            for (int m = 0; m < 4; ++m) { bf16_t* rowp = O + (size_t)(row0 + ai * HALF + m * 16) * ldc + col0;
#pragma unroll
                for (int bj = 0; bj < 2; ++bj) { const f32x4 v0 = acc[ai][bj][m][0] + bv[bj][0], v1 = acc[ai][bj][m][1] + bv[bj][1];
                    u32x4 w; w.x = pk2(v0[0], v0[1]); w.y = pk2(v0[2], v0[3]); w.z = pk2(v1[0], v1[1]); w.w = pk2(v1[2], v1[3]);
                    *(u32x4*)(rowp + bj * HALF) = w; } }
    }
};
__device__ __forceinline__ float swiglu1(float g, float uu) { g = fminf(g, 7.0f); uu = fminf(fmaxf(uu, -7.0f), 7.0f); return (uu + 1.0f) * (g * frcp(1.0f + fexp(-1.702f * g))); }
struct EpiSwiglu {
    static constexpr bool PERM = true;
    bf16_t* O; const float* b1;
    __device__ __forceinline__ void operator()(const f32x4 (&acc)[2][2][4][2], const Unit& u, int wr, int wc, int fr, int fq) const {
        const int row0 = u.pm * BM + wr * 64 + fr, j0 = u.pn * HALF + wc * 32 + 8 * fq;
        const float* bg = b1 + (size_t)u.e * 2 * DFF + j0; const float* bu = bg + DFF;
        f32x4 g4[2], u4[2];
#pragma unroll
        for (int n = 0; n < 2; ++n) { g4[n] = *(const f32x4*)(bg + 4 * n); u4[n] = *(const f32x4*)(bu + 4 * n); }
#pragma unroll
        for (int ai = 0; ai < 2; ++ai)
#pragma unroll
            for (int m = 0; m < 4; ++m) {
                float o[8];
#pragma unroll
                for (int n = 0; n < 2; ++n)
#pragma unroll
                    for (int q = 0; q < 4; ++q) o[n * 4 + q] = swiglu1(acc[ai][0][m][n][q] + g4[n][q], acc[ai][1][m][n][q] + u4[n][q]);
                u32x4 w; w.x = pk2(o[0], o[1]); w.y = pk2(o[2], o[3]); w.z = pk2(o[4], o[5]); w.w = pk2(o[6], o[7]);
                *(u32x4*)(O + (size_t)(row0 + ai * HALF + m * 16) * DFF + j0) = w;
            }
    }
};

template <class Epi, class Sched, bool SP2 = (MK_SP2 != 0)>
__device__ __forceinline__ void gemm_phase(LAS unsigned char* lds, const int K, const Sched& S, const Epi& E, const int tid) {
    const int wid = RFL(tid >> 6), lane = tid & 63, wr = wid >> 2, wc = wid & 3, fr = lane & 15, fq = lane >> 4;
    const int nt = K / BK;
    unsigned voffA[2], voffB[2]; int gR[2]; unsigned gC[2];
#pragma unroll
    for (int i = 0; i < 2; ++i) { int R, C; stage_rc(tid * 16 + i * 8192, R, C); const int Rb = Epi::PERM ? ((R & ~31) + perm32(R & 31)) : R;
        voffA[i] = (unsigned)(R * K + C) * 2u; voffB[i] = (unsigned)(Rb * K + C) * 2u; gR[i] = R; gC[i] = (unsigned)C * 2u; }
    unsigned va[2][2], vn[2][2];
#define PG8_GOFF(dst, unit) do { if constexpr (Sched::GATHER) { _Pragma("unroll") for (int h_ = 0; h_ < 2; ++h_) _Pragma("unroll") for (int i_ = 0; i_ < 2; ++i_) \
        dst[h_][i_] = (unsigned)S.rowmap[(unit).pm * BM + h_ * HALF + gR[i_]] * (unsigned)(K * 2) + gC[i_]; } } while (0)
#define PG8_STAGE_A(bufoff, bp, kb, h, nx) do { if constexpr (Sched::GATHER) { const char* gb_ = S.A + (kb); _Pragma("unroll") for (int _i = 0; _i < 2; ++_i) \
        GLDS16(gb_ + ((nx) ? vn[h][_i] : va[h][_i]), lds + (bufoff) + ldsw + _i * 8192); } else { PG8_STAGE(bufoff, bp, voffA); } } while (0)
    const size_t kstep = (size_t)(BK * 2);
    const size_t hstep = (size_t)HALF * K * 2;
    const unsigned ldsw = (unsigned)wid * 1024u;
    const int aoff = lds_byte(wr * 64 + fr, fq * 8), boff = lds_byte(wc * 32 + fr, fq * 8);
#define PG8_SA(b, h) (((b) * 2 + (h)) * HTB)
#define PG8_SB(b, h) ((4 + (b) * 2 + (h)) * HTB)
#define PG8_STAGE(bufoff, gbase, voff) do { _Pragma("unroll") for (int _i = 0; _i < 2; ++_i) \
        GLDS16((const char*)(gbase) + (voff)[_i], lds + (bufoff) + ldsw + _i * 8192); } while (0)
#define PG8_LDA(dst, b, h) do { _Pragma("unroll") for (int m = 0; m < 4; ++m) _Pragma("unroll") for (int k = 0; k < 2; ++k) dst[m][k] = *(const LAS bf16x8*)(lds + PG8_SA(b, h) + aoff + m * 2048 + k * 1024); } while (0)
#define PG8_LDB(dst, b, h) do { _Pragma("unroll") for (int n = 0; n < 2; ++n) _Pragma("unroll") for (int k = 0; k < 2; ++k) dst[n][k] = *(const LAS bf16x8*)(lds + PG8_SB(b, h) + boff + n * 2048 + k * 1024); } while (0)
#define PG8_MMA(ai, bj, At, Bt) do { SETPRIO(1); _Pragma("unroll") for (int m = 0; m < 4; ++m) _Pragma("unroll") for (int n = 0; n < 2; ++n) _Pragma("unroll") for (int k = 0; k < 2; ++k) \
        acc[ai][bj][m][n] = MFMA16(Bt[n][k], At[m][k], acc[ai][bj][m][n]); SETPRIO(0); } while (0)
    Unit cur, nxt; int ui = 0;
    if (!S.next(0, cur)) return;
    f32x4 acc[2][2][4][2];
#pragma unroll
    for (int a = 0; a < 2; ++a)
#pragma unroll
        for (int b = 0; b < 2; ++b)
#pragma unroll
            for (int m = 0; m < 4; ++m)
#pragma unroll
                for (int n = 0; n < 2; ++n) acc[a][b][m][n] = (f32x4){0.f, 0.f, 0.f, 0.f};
    bf16x8 At[4][2], B0[2][2], B1[2][2];
    const char* cA = S.abase(cur); const char* cB = S.bbase(cur);
    PG8_GOFF(va, cur);
    if constexpr (SP2) {
        PG8_STAGE(PG8_SB(0, 0), cB, voffB); PG8_STAGE(PG8_SB(0, 1), cB + hstep, voffB); PG8_STAGE_A(PG8_SA(0, 0), cA, 0, 0, false); PG8_STAGE_A(PG8_SA(0, 1), cA + hstep, 0, 1, false);
        if (wr == 1) S_BARRIER();
        WAIT_V(2); S_BARRIER();
        PG8_STAGE(PG8_SB(1, 0), cB + kstep, voffB); PG8_STAGE_A(PG8_SA(1, 0), cA + kstep, kstep, 0, false); PG8_STAGE(PG8_SB(1, 1), cB + hstep + kstep, voffB);
        WAIT_V(6); S_BARRIER();
    } else {
    PG8_STAGE(PG8_SB(0, 0), cB, voffB); PG8_STAGE_A(PG8_SA(0, 0), cA, 0, 0, false); PG8_STAGE(PG8_SB(0, 1), cB + hstep, voffB); PG8_STAGE_A(PG8_SA(0, 1), cA + hstep, 0, 1, false);
    if (wr == 1) S_BARRIER();
    WAIT_V(4); S_BARRIER();
    PG8_STAGE(PG8_SB(1, 0), cB + kstep, voffB); PG8_STAGE_A(PG8_SA(1, 0), cA + kstep, kstep, 0, false); PG8_STAGE(PG8_SB(1, 1), cB + hstep + kstep, voffB);
    WAIT_V(6); S_BARRIER();
    }
    for (;;) {
        const bool has_next = S.next(ui + 1, nxt);
        const char* nA = has_next ? S.abase(nxt) : cA; const char* nB = has_next ? S.bbase(nxt) : cB;
        if constexpr (Sched::GATHER) { if (has_next) { PG8_GOFF(vn, nxt); } else {
#pragma unroll
            for (int h_ = 0; h_ < 2; ++h_) { vn[h_][0] = va[h_][0]; vn[h_][1] = va[h_][1]; } } }
        for (int t = 0; t < nt; t += 2) {
            const bool last = (t == nt - 2);
            const char* a1 = cA + (size_t)(t + 1) * kstep;
            const char* a2 = last ? nA : cA + (size_t)(t + 2) * kstep; const char* b2 = last ? nB : cB + (size_t)(t + 2) * kstep;
            const char* a3 = a2 + kstep; const char* b3 = b2 + kstep;
            if constexpr (SP2) {
            PG8_LDB(B0, 0, 0); PG8_LDB(B1, 0, 1); SCHED_BAR(); PG8_LDA(At, 0, 0); PG8_STAGE_A(PG8_SA(1, 1), a1 + hstep, (size_t)(t + 1) * kstep, 1, false);
            WAIT_V(8); WAIT_L(0); S_BARRIER(); PG8_MMA(0, 0, At, B0); PG8_MMA(0, 1, At, B1); S_BARRIER(); SCHED_BAR();
            PG8_LDA(At, 0, 1); PG8_STAGE(PG8_SB(0, 0), b2, voffB); PG8_STAGE(PG8_SB(0, 1), b2 + hstep, voffB); PG8_STAGE_A(PG8_SA(0, 0), a2, (last ? (size_t)0 : (size_t)(t + 2) * kstep), 0, last);
            WAIT_V(8); WAIT_L(0); S_BARRIER(); PG8_MMA(1, 0, At, B0); PG8_MMA(1, 1, At, B1); S_BARRIER(); SCHED_BAR();
            PG8_LDB(B0, 1, 0); PG8_LDB(B1, 1, 1); SCHED_BAR(); PG8_LDA(At, 1, 0); PG8_STAGE_A(PG8_SA(0, 1), a2 + hstep, (last ? (size_t)0 : (size_t)(t + 2) * kstep), 1, last);
            WAIT_V(8); WAIT_L(0); S_BARRIER(); PG8_MMA(0, 0, At, B0); PG8_MMA(0, 1, At, B1); S_BARRIER(); SCHED_BAR();
            PG8_LDA(At, 1, 1); PG8_STAGE(PG8_SB(1, 0), b3, voffB); PG8_STAGE(PG8_SB(1, 1), b3 + hstep, voffB); PG8_STAGE_A(PG8_SA(1, 0), a3, (last ? kstep : (size_t)(t + 3) * kstep), 0, last);
            WAIT_V(8); WAIT_L(0); S_BARRIER(); PG8_MMA(1, 0, At, B0); PG8_MMA(1, 1, At, B1); S_BARRIER(); SCHED_BAR();
            } else {
            PG8_LDB(B0, 0, 0); SCHED_BAR(); PG8_LDA(At, 0, 0); PG8_STAGE_A(PG8_SA(1, 1), a1 + hstep, (size_t)(t + 1) * kstep, 1, false);
            WAIT_L(8); S_BARRIER(); WAIT_L(0); PG8_MMA(0, 0, At, B0); S_BARRIER(); SCHED_BAR();
            PG8_LDB(B1, 0, 1); PG8_STAGE(PG8_SB(0, 0), b2, voffB);
            S_BARRIER(); WAIT_L(0); PG8_MMA(0, 1, At, B1); S_BARRIER();
            PG8_LDA(At, 0, 1); PG8_STAGE_A(PG8_SA(0, 0), a2, (last ? (size_t)0 : (size_t)(t + 2) * kstep), 0, last);
            S_BARRIER(); WAIT_L(0); PG8_MMA(1, 0, At, B0); S_BARRIER(); SCHED_BAR();
            PG8_STAGE(PG8_SB(0, 1), b2 + hstep, voffB);
            WAIT_V(6); S_BARRIER(); PG8_MMA(1, 1, At, B1); S_BARRIER();
            PG8_LDB(B0, 1, 0); SCHED_BAR(); PG8_LDA(At, 1, 0); PG8_STAGE_A(PG8_SA(0, 1), a2 + hstep, (last ? (size_t)0 : (size_t)(t + 2) * kstep), 1, last);
            WAIT_L(8); S_BARRIER(); WAIT_L(0); PG8_MMA(0, 0, At, B0); S_BARRIER(); SCHED_BAR();
            PG8_LDB(B1, 1, 1); PG8_STAGE(PG8_SB(1, 0), b3, voffB);
            S_BARRIER(); WAIT_L(0); PG8_MMA(0, 1, At, B1); S_BARRIER();
            PG8_LDA(At, 1, 1); PG8_STAGE_A(PG8_SA(1, 0), a3, (last ? kstep : (size_t)(t + 3) * kstep), 0, last);
            S_BARRIER(); WAIT_L(0); PG8_MMA(1, 0, At, B0); S_BARRIER(); SCHED_BAR();
            PG8_STAGE(PG8_SB(1, 1), b3 + hstep, voffB);
            WAIT_V(6); S_BARRIER(); PG8_MMA(1, 1, At, B1); S_BARRIER();
            }
        }
        if (wr == 0) S_BARRIER();
        E(acc, cur, wr, wc, fr, fq);
        if (!has_next) break;
#pragma unroll
        for (int a = 0; a < 2; ++a)
#pragma unroll
            for (int b = 0; b < 2; ++b)
#pragma unroll
                for (int m = 0; m < 4; ++m)
#pragma unroll
                    for (int n = 0; n < 2; ++n) acc[a][b][m][n] = (f32x4){0.f, 0.f, 0.f, 0.f};
        cur = nxt; cA = nA; cB = nB; ++ui;
        if constexpr (Sched::GATHER) {
#pragma unroll
            for (int h_ = 0; h_ < 2; ++h_) { va[h_][0] = vn[h_][0]; va[h_][1] = vn[h_][1]; } }
        if (wr == 1) S_BARRIER();
    }
    WAIT_V(0);
    S_BARRIER();
#undef PG8_SA
#undef PG8_SB
#undef PG8_STAGE
#undef PG8_STAGE_A
#undef PG8_GOFF
#undef PG8_LDA
#undef PG8_LDB
#undef PG8_MMA
}
}

__device__ __forceinline__ float row16_sum(float x) {
#ifdef EMU
    x += __shfl_xor(x, 1); x += __shfl_xor(x, 2); x += __shfl_xor(x, 4); x += __shfl_xor(x, 8); return x;
#else
#define DPPF(v, ctrl) __builtin_bit_cast(float, __builtin_amdgcn_update_dpp(0, __builtin_bit_cast(int, (v)), (ctrl), 0xF, 0xF, false))
    x += DPPF(x, 0xB1); x += DPPF(x, 0x4E); x += DPPF(x, 0x141); x += DPPF(x, 0x140); return x;
#undef DPPF
#endif
}
__device__ __forceinline__ float row32_sum(float x) {
    x = row16_sum(x);
#ifdef EMU
    x += __shfl_xor(x, 32); return x;
#else
    float a = x, b = x;
    asm volatile("s_nop 1\n\tv_permlane32_swap_b32 %0, %1" : "+v"(a), "+v"(b));
    return a + b;
#endif
}
__device__ __forceinline__ float wave_sum_fast(float x, int lane) {
    x = row32_sum(x);
    x += SHX(x, 16, lane);
    return x;
}
__device__ __forceinline__ void transpose_item(const float* W, int K, int N, bf16_t* WT, int k0, int n0, int dst_row0, float* scr, int lane) {
    const int n4 = (lane & 15) * 4, kr = lane >> 4;
#pragma unroll 8
    for (int i = 0; i < 16; ++i) {
        const int kk = 4 * i + kr;
        f32x4 v = (f32x4){0.f, 0.f, 0.f, 0.f};
        if (n0 + n4 < N) v = *(const f32x4*)(W + (size_t)(k0 + kk) * N + n0 + n4);
        float* d = scr + kk * 65 + n4; d[0] = v.x; d[1] = v.y; d[2] = v.z; d[3] = v.w;
    }
    WAVE_SYNC();
    const int c = lane & 7;
#pragma unroll
    for (int j = 0; j < 8; ++j) { const int n = (lane >> 3) + 8 * j; const float* sp = scr + (8 * c) * 65 + n;
        u32x4 o; o.x = pk2(sp[0 * 65], sp[1 * 65]); o.y = pk2(sp[2 * 65], sp[3 * 65]); o.z = pk2(sp[4 * 65], sp[5 * 65]); o.w = pk2(sp[6 * 65], sp[7 * 65]);
        *(u32x4*)(WT + (size_t)(dst_row0 + n) * K + k0 + 8 * c) = o; }
    WAVE_SYNC();
}
__device__ __forceinline__ void phase_prologue(const Params& P, unsigned char* smem, int wv) {
    ParamsPtr pp = PARAMS_PTR(P); PIN_S(pp); unsigned char* ws = pp->ws; int bidx = (int)blockIdx.x, gdim = (int)gridDim.x; PIN_S(bidx); PIN_S(gdim);
    const int tid = phase_tid(wv), lane = tid & 63, wave = tid >> 6;
    float* scr = (float*)smem + wave * (64 * 65);
    const int gw = bidx * NWAVES + wave, ngw = NWAVES * gdim;
    constexpr int I_IN = 16 * (PLD / 64), I_OUT = 16 * 16, I_W1 = NE * 16 * 32, I_W2 = NE * 16 * 16, I_L = I_IN + I_OUT + I_W1 + I_W2;
    for (int it = gw; it < NL * I_L; it += ngw) {
        const int l = it / I_L; int r = it % I_L;
        if (r < I_IN) { const int kb = r / (PLD / 64), nb = r % (PLD / 64);
            transpose_item(pp->in[1] + (size_t)l * D * PIN, D, PIN, (bf16_t*)(ws + O_WIN) + (size_t)l * PLD * D, kb * 64, nb * 64, nb * 64, scr, lane); continue; }
        r -= I_IN;
        if (r < I_OUT) { const int kb = r / 16, nb = r % 16;
            transpose_item(pp->in[21] + (size_t)l * D * D, D, D, (bf16_t*)(ws + O_WOUT) + (size_t)l * D * D, kb * 64, nb * 64, nb * 64, scr, lane); continue; }
        r -= I_OUT;
        if (r < I_W1) { const int e = r / (16 * 32), q = r % (16 * 32), kb = q / 32, nb = q % 32, n0 = nb * 64;
            const int dst = n0 < DFF ? (n0 / 128) * 256 + (n0 % 128) : ((n0 - DFF) / 128) * 256 + 128 + ((n0 - DFF) % 128);
            transpose_item(pp->in[26] + ((size_t)l * NE + e) * D * 2 * DFF, D, 2 * DFF, (bf16_t*)(ws + O_W1) + ((size_t)l * NE + e) * 2 * DFF * D, kb * 64, n0, dst, scr, lane); continue; }
        r -= I_W1;
        { const int e = r / (16 * 16), q = r % (16 * 16), kb = q / 16, nb = q % 16;
            transpose_item(pp->in[28] + ((size_t)l * NE + e) * DFF * D, DFF, D, (bf16_t*)(ws + O_W2) + ((size_t)l * NE + e) * D * DFF, kb * 64, nb * 64, nb * 64, scr, lane); }
    }
    {
        const float* gw_ = pp->in[4]; bf16_t* WSB = (bf16_t*)(ws + O_WSB);
        for (size_t i = ((size_t)bidx * NTHREADS + tid) * 4; i < (size_t)NL * GH * CH * CH; i += (size_t)gdim * NTHREADS * 4) {
            const f32x4 v = *(const f32x4*)(gw_ + i); u32x2 o; o.x = pk2(v.x, v.y); o.y = pk2(v.z, v.w); *(u32x2*)(WSB + i) = o;
        }
    }
    {
        bf16_t* LWT = (bf16_t*)(ws + O_LWT);
        for (int i = bidx * NTHREADS + tid; i < NL * 1920 * 128; i += gdim * NTHREADS) {
            const int k = i & 127, n = (i >> 7) % 1920, ll = i / (1920 * 128);
            float v = 0.f;
            if (n < 1536) { if (k < 64) { const int grp = n / 768, d = (n / 384) & 1, c = n % 384; v = (grp == 0 ? pp->in[8] : pp->in[10])[(((size_t)ll * 2 + d) * 64 + k) * RW + c]; } }
            else v = pp->in[11][((size_t)ll * 128 + k) * RW + (n - 1536)];
            LWT[i] = (bf16_t)f2bf(v);
        }
    }
    {
        bf16_t* RWT = (bf16_t*)(ws + O_RWT);
        for (int i = bidx * NTHREADS + tid; i < NL * NE * D; i += gdim * NTHREADS) {
            const int k = i % D, e = (i / D) % NE, ll = i / (D * NE);
            const float v = pp->in[24][((size_t)ll * D + k) * NE + e];
            const unsigned hi = f2bf(v); const float lo = v - bf_lo(hi);
            RWT[((size_t)(ll * 2 + 0) * NE + e) * D + k] = (bf16_t)hi; RWT[((size_t)(ll * 2 + 1) * NE + e) * D + k] = (bf16_t)f2bf(lo);
        }
    }
    const float* x = pp->in[0]; bf16_t* XB = (bf16_t*)(ws + O_XB);
    for (size_t i = ((size_t)bidx * NTHREADS + tid) * 4; i < (size_t)T * D; i += (size_t)gdim * NTHREADS * 4) {
        const f32x4 v = *(const f32x4*)(x + i); u32x2 o; o.x = pk2(v.x, v.y); o.y = pk2(v.z, v.w); *(u32x2*)(XB + i) = o;
    }
}

__device__ __forceinline__ float tshift(const float* P, int t, int s, int col, const float* mu0, const float* mu1, int rc) {
    const float cur = P[(size_t)t * PLD + col];
    const float prv = s > 0 ? P[(size_t)(t - 1) * PLD + col] : 0.f;
    const float nxt = s < S - 1 ? P[(size_t)(t + 1) * PLD + col] : 0.f;
    return cur + mu0[rc] * (prv - cur) + mu1[rc] * (nxt - cur);
}

__device__ __forceinline__ void phase_prep(const Params& P, int l, unsigned char* smem, int wv) {
    ParamsPtr pp = PARAMS_PTR(P); PIN_S(pp); unsigned char* ws = pp->ws; int bidx = (int)blockIdx.x, gdim = (int)gridDim.x; PIN_S(bidx); PIN_S(gdim);
    const bf16_t* proj = (const bf16_t*)(ws + O_PROJ); const float* projg = (const float*)(ws + O_PROJG);
    float* UG = (float*)(ws + O_UG); bf16_t* VNT = (bf16_t*)(ws + O_VNT);
    float* RR = (float*)(ws + O_RR); float* VV = (float*)(ws + O_VV); float* KK = (float*)(ws + O_KK);
    float* KD = (float*)(ws + O_KD); float* ICLR = (float*)(ws + O_ICLR);
    float* GATE = (float*)(ws + O_GATE); float* BONUS = (float*)(ws + O_BONUS); float* LWG = (float*)(ws + O_LW);
    bf16_t* RB = (bf16_t*)(ws + O_RB); bf16_t* VB = (bf16_t*)(ws + O_VB); bf16_t* KKB = (bf16_t*)(ws + O_KKB); bf16_t* BBB = (bf16_t*)(ws + O_BBB); bf16_t* KDB = (bf16_t*)(ws + O_KDB);
#if !MK_RWKV_CHUNKED
    float* DEC = (float*)(ws + O_DEC); float* BRKR = (float*)(ws + O_BRKR);
#endif
    bf16_t* MQB = (bf16_t*)(ws + O_MQB); bf16_t* MKB = (bf16_t*)(ws + O_MKB); bf16_t* KT = (bf16_t*)(ws + O_KT); bf16_t* VT = (bf16_t*)(ws + O_VT);
    float* IG = (float*)(ws + O_IG); float* LF = (float*)(ws + O_LF);
    const bf16_t* LWT = (const bf16_t*)(ws + O_LWT) + (size_t)l * 1920 * 128;
    const float* gln_g = pp->in[2] + (size_t)l * GW; const float* gln_b = pp->in[3] + (size_t)l * GW;
    const float* mu0 = pp->in[6] + (size_t)l * 2 * RPROJ; const float* mu1 = mu0 + RPROJ;
    const float* w0 = pp->in[7] + (size_t)l * 2 * RW; const float* a0 = pp->in[9] + (size_t)l * 2 * RW;
    const float* k_k = pp->in[12] + (size_t)l * RW; const float* k_a = pp->in[13] + (size_t)l * RW; const float* r_k = pp->in[14] + (size_t)l * RW;
    const float* conv_w = pp->in[17] + (size_t)l * 3 * 768; const float* conv_b = pp->in[18] + (size_t)l * 768; const float* gate_b = pp->in[19] + (size_t)l * 24;
    float* win = (float*)smem;
    bf16_t* lin = (bf16_t*)(smem + 101376);
    bf16_t* tvn = (bf16_t*)(smem + 110592);
    bf16_t* tk = (bf16_t*)(smem + 118784);
    bf16_t* tv = (bf16_t*)(smem + 131072);
    constexpr int LIN = 264;
    const int tid = phase_tid(wv), lane = tid & 63, wave = tid >> 6, col = lane & 15, g = lane >> 4;
    for (int u = bidx; u < T / 16; u += gdim) {
        const int t0 = u * 16, s0 = t0 % S, bb = t0 / S;
        __syncthreads();
        {
            u32x2 wb[18];
#pragma unroll
            for (int row = 0; row < 18; ++row) {
                const int sq = s0 - 1 + row;
                wb[row] = (u32x2){0u, 0u};
                if (sq >= 0 && sq < S && tid < 352) wb[row] = *(const u32x2*)(proj + (size_t)(t0 - 1 + row) * PLD + C_RW + tid * 4);
            }
            if (tid < 352) {
#pragma unroll
                for (int row = 0; row < 18; ++row) *(f32x4*)(win + row * RPROJ + tid * 4) = (f32x4){bf_lo(wb[row].x), bf_hi(wb[row].x), bf_lo(wb[row].y), bf_hi(wb[row].y)};
            }
        }
        for (int rep_ = 0; rep_ < (MK_PROBE == 3 ? 2 : 1); ++rep_) {
            const int i = tid >> 5, l32 = tid & 31, t = t0 + i;
            float v[8], ug[8]; float sum = 0.f;
#pragma unroll
            for (int j = 0; j < 8; ++j) { const int c = j * 32 + l32; ug[j] = bf_lo((unsigned)proj[(size_t)t * PLD + c]); v[j] = bf_lo((unsigned)proj[(size_t)t * PLD + GW + c]); }
#pragma unroll
            for (int j = 0; j < 8; ++j) { const int c = j * 32 + l32; UG[(size_t)t * GW + c] = geluf_(ug[j]); v[j] = geluf_(v[j]); sum += v[j]; }
#pragma unroll
            for (int o = 16; o >= 1; o >>= 1) sum += SHX(sum, o, lane);
            const float mean = sum * (1.0f / GW); float q = 0.f;
#pragma unroll
            for (int j = 0; j < 8; ++j) { const float d = v[j] - mean; q += d * d; }
#pragma unroll
            for (int o = 16; o >= 1; o >>= 1) q += SHX(q, o, lane);
            const float rstd = 1.0f / sqrtf(q * (1.0f / GW) + LN_EPS);
#pragma unroll
            for (int j = 0; j < 8; ++j) { const int c = j * 32 + l32; tvn[c * 16 + i] = (bf16_t)f2bf((v[j] - mean) * rstd * gln_g[c] + gln_b[c]); }
        }
        __syncthreads();
        {
            const int hf = tid & 1, c = tid >> 1;
            *(u32x4*)(VNT + ((size_t)bb * GW + c) * S + s0 + hf * 8) = *(const u32x4*)(tvn + c * 16 + hf * 8);
        }
        for (int idx = tid; idx < 16 * 256; idx += NTHREADS) {
            const int i = idx >> 8, j = idx & 255, rc = 1152 + j;
            const float pv = win[i * RPROJ + rc], cv = win[(i + 1) * RPROJ + rc], nv = win[(i + 2) * RPROJ + rc];
            const float x = cv + mu0[rc] * (pv - cv) + mu1[rc] * (nv - cv);
            lin[i * LIN + j] = (bf16_t)f2bf(j < 64 ? ftanh(x) : (j < 128 ? x : sigmoidf_(x)));
        }
        __syncthreads();
        for (int rep_ = 0; rep_ < (MK_PROBE == 1 ? 2 : 1); ++rep_) {
#pragma unroll 1
            for (int qg = 0; qg < 3; ++qg) {
                bf16x8 bw_[5][4]; float bias_[5];
#pragma unroll
                for (int q5 = 0; q5 < 5; ++q5) {
                    const int nt = wave * 15 + qg * 5 + q5, grp = nt / 24, c = (nt % 24) * 16 + col;
                    const bf16_t* bw = LWT + (size_t)(nt * 16 + col) * 128 + 8 * g;
#pragma unroll
                    for (int ks = 0; ks < 2; ++ks) bw_[q5][ks] = *(const bf16x8*)(bw + ks * 32);
                    if (grp == 4) {
#pragma unroll
                        for (int ks = 2; ks < 4; ++ks) bw_[q5][ks] = *(const bf16x8*)(bw + ks * 32);
                    }
                    bias_[q5] = grp < 2 ? w0[grp * RW + c] : (grp < 4 ? a0[(grp - 2) * RW + c] : 0.f);
                }
#pragma unroll
                for (int q5 = 0; q5 < 5; ++q5) {
                    const int nt = wave * 15 + qg * 5 + q5, grp = nt / 24, c = (nt % 24) * 16 + col;
                    const int kcol = grp < 2 ? 0 : (grp < 4 ? 64 : 128);
                    f32x4 acc = (f32x4){0.f, 0.f, 0.f, 0.f};
#pragma unroll
                    for (int ks = 0; ks < 2; ++ks) acc = MFMA16(*(const bf16x8*)(lin + col * LIN + kcol + ks * 32 + 8 * g), bw_[q5][ks], acc);
                    if (grp == 4) {
#pragma unroll
                        for (int ks = 2; ks < 4; ++ks) acc = MFMA16(*(const bf16x8*)(lin + col * LIN + kcol + ks * 32 + 8 * g), bw_[q5][ks], acc);
                    }
                    if (grp < 2) {
#pragma unroll
                        for (int r = 0; r < 4; ++r) { const float lw = -fexp(-softplusf_(-(acc[r] + bias_[q5])) - 0.5f); const size_t o = (size_t)grp * T * RW + (size_t)(t0 + 4 * g + r) * RW + c; LWG[o] = lw;
#if !MK_RWKV_CHUNKED
                            DEC[o] = expf(lw);
#endif
                        }
                    } else if (grp < 4) {
#pragma unroll
                        for (int r = 0; r < 4; ++r) ICLR[(size_t)(grp - 2) * T * RW + (size_t)(t0 + 4 * g + r) * RW + c] = sigmoidf_(acc[r] + bias_[q5]);
                    } else {
#pragma unroll
                        for (int r = 0; r < 4; ++r) GATE[(size_t)(t0 + 4 * g + r) * RW + c] = acc[r];
                    }
                }
            }
        }
        __syncthreads();
        for (int rep_ = 0; rep_ < (MK_PROBE == 2 ? 2 : 1); ++rep_) if (wave < 6) {
            const int c = tid, h = wave;
            const float kkc = k_k[c], kac = k_a[c], rkc = r_k[c];
            const float m0r = mu0[c], m1r = mu1[c], m0k = mu0[RW + c], m1k = mu1[RW + c], m0v = mu0[2 * RW + c], m1v = mu1[2 * RW + c];
            float ic0[16], ic1[16];
#pragma unroll
            for (int i = 0; i < 16; ++i) { const size_t o = (size_t)(t0 + i) * RW + c; ic0[i] = ICLR[o]; ic1[i] = ICLR[(size_t)T * RW + o]; }
#pragma unroll
            for (int i = 0; i < 16; ++i) {
                const int t = t0 + i;
                const float* w_ = win + i * RPROJ + c;
                const float rp = w_[0], rc_ = w_[RPROJ], rn = w_[2 * RPROJ];
                const float kp = w_[RW], kc_ = w_[RPROJ + RW], kn = w_[2 * RPROJ + RW];
                const float vp = w_[2 * RW], vc_ = w_[RPROJ + 2 * RW], vn = w_[2 * RPROJ + 2 * RW];
                const float r = rc_ + m0r * (rp - rc_) + m1r * (rn - rc_);
                const float k = kc_ + m0k * (kp - kc_) + m1k * (kn - kc_);
                const float v = vc_ + m0v * (vp - vc_) + m1v * (vn - vc_);
                const size_t o = (size_t)t * RW + c;
                const float kq = k * kkc;
                const float n2 = wave_sum_fast(kq * kq, lane);
                const float kk = kq / fmaxf(sqrtf(n2), 1e-12f);
                const float kd0 = k * (1.0f + (ic0[i] - 1.0f) * kac), kd1 = k * (1.0f + (ic1[i] - 1.0f) * kac);
                const float bon = wave_sum_fast(r * (kd0 + kd1) * rkc, lane);
#if MK_RWKV_CHUNKED
                RB[o] = (bf16_t)f2bf(r); VB[o] = (bf16_t)f2bf(v); KKB[o] = (bf16_t)f2bf(kk);
                BBB[o] = (bf16_t)f2bf(kk * ic0[i]); BBB[(size_t)T * RW + o] = (bf16_t)f2bf(kk * ic1[i]);
                KDB[o] = (bf16_t)f2bf(kd0); KDB[(size_t)T * RW + o] = (bf16_t)f2bf(kd1);
#else
                RR[o] = r; VV[o] = v; KK[o] = kk;
                KD[o] = kd0; KD[(size_t)T * RW + o] = kd1;
#endif
                if (lane == 0) BONUS[(size_t)t * RH + h] = bon;
#if !MK_RWKV_CHUNKED
                { const float br0 = wave_sum(kk * ic0[i] * r, lane), br1 = wave_sum(kk * ic1[i] * r, lane), kr0 = wave_sum(kd0 * r, lane), kr1 = wave_sum(kd1 * r, lane);
                  if (lane == 0) { BRKR[((size_t)t * RH + h) * 2] = br0; BRKR[((size_t)t * RH + h) * 2 + 1] = kr0; BRKR[((size_t)(T + t) * RH + h) * 2] = br1; BRKR[((size_t)(T + t) * RH + h) * 2 + 1] = kr1; } }
#endif
            }
        }
        __syncthreads();
        {
            u32x2 wb[9], vb[3];
            const int rsel = tid >= 192 ? 1 : 0, c4 = tid - rsel * 192;
#pragma unroll
            for (int it = 0; it < 9; ++it) {
                const int row = 2 * it + rsel, sq = s0 - 1 + row;
                wb[it] = (u32x2){0u, 0u};
                if (tid < 384 && sq >= 0 && sq < S) wb[it] = *(const u32x2*)(proj + (size_t)(t0 - 1 + row) * PLD + C_MW + c4 * 4);
            }
#pragma unroll
            for (int it = 0; it < 3; ++it) { const int idx = tid + it * NTHREADS, i = idx / 96, cc = (idx % 96) * 4; vb[it] = *(const u32x2*)(proj + (size_t)(t0 + i) * PLD + C_MW + 2 * MW + cc); }
            if (tid < 384) {
#pragma unroll
                for (int it = 0; it < 9; ++it) *(f32x4*)(win + (2 * it + rsel) * 768 + c4 * 4) = (f32x4){bf_lo(wb[it].x), bf_hi(wb[it].x), bf_lo(wb[it].y), bf_hi(wb[it].y)};
            }
#pragma unroll
            for (int it = 0; it < 3; ++it) { const int idx = tid + it * NTHREADS, i = idx / 96, cc = (idx % 96) * 4; const u32x2 v = vb[it];
                tv[(cc + 0) * 16 + i] = (bf16_t)(v.x & 0xffffu); tv[(cc + 1) * 16 + i] = (bf16_t)(v.x >> 16); tv[(cc + 2) * 16 + i] = (bf16_t)(v.y & 0xffffu); tv[(cc + 3) * 16 + i] = (bf16_t)(v.y >> 16); }
        }
        for (int idx = tid; idx < 16 * 24; idx += NTHREADS) {
            const int i = idx / 24, gi = idx % 24, t = t0 + i;
            const int isf = gi / 12, dir = (gi / 6) & 1, h = gi % 6;
            const float gg = projg[(size_t)t * 256 + (3456 - (PLD - 256)) + gi] + gate_b[gi];
            if (isf) LF[((size_t)dir * T + t) * MH + h] = -softplusf_(-gg); else IG[((size_t)dir * T + t) * MH + h] = gg;
        }
        __syncthreads();
        for (int rep_ = 0; rep_ < (MK_PROBE == 4 ? 2 : 1); ++rep_)
        for (int idx = tid; idx < 16 * 768; idx += NTHREADS) {
            const int i = idx / 768, c = idx % 768, t = t0 + i;
            const float* w_ = win + i * 768 + c;
            float y = conv_b[c] + w_[0] * conv_w[c] + w_[768] * conv_w[768 + c] + w_[1536] * conv_w[2 * 768 + c];
            y = y * sigmoidf_(y);
            if (c < MW) MQB[(size_t)t * MW + c] = (bf16_t)f2bf(y);
            else { const bf16_t kb = (bf16_t)f2bf(y * 0.125f); MKB[(size_t)t * MW + (c - MW)] = kb; tk[(c - MW) * 16 + i] = kb; }
        }
        __syncthreads();
        for (int idx = tid; idx < 2 * MW * 2; idx += NTHREADS) {
            const int hf = idx & 1, c = (idx >> 1) % MW, which = idx / (2 * MW);
            const u32x4 val = *(const u32x4*)((which ? tv : tk) + c * 16 + hf * 8);
            bf16_t* dst = (which ? VT : KT) + ((size_t)(bb * MH) * 64 + c) * S + s0 + hf * 8;
            *(u32x4*)dst = val;
        }
    }
    __syncthreads();
}

__device__ __forceinline__ void phase_prep32(const Params& P, int l, unsigned char* smem, int wv) {
    ParamsPtr pp = PARAMS_PTR(P); PIN_S(pp); unsigned char* ws = pp->ws; int bidx = (int)blockIdx.x, gdim = (int)gridDim.x; PIN_S(bidx); PIN_S(gdim);
    const bf16_t* proj = (const bf16_t*)(ws + O_PROJ); const float* projg = (const float*)(ws + O_PROJG);
    float* UG = (float*)(ws + O_UG); bf16_t* VNT = (bf16_t*)(ws + O_VNT);
    u32x4* RK7 = (u32x4*)(ws + O_RK7);
    float* GATE = (float*)(ws + O_GATE); float* BONUS = (float*)(ws + O_BONUS); float* LWG = (float*)(ws + O_LW);
    bf16_t* VB = (bf16_t*)(ws + O_VB);
    bf16_t* MQB = (bf16_t*)(ws + O_MQB); bf16_t* MKB = (bf16_t*)(ws + O_MKB); bf16_t* KT = (bf16_t*)(ws + O_KT); bf16_t* VT = (bf16_t*)(ws + O_VT);
    float* IG = (float*)(ws + O_IG); float* LF = (float*)(ws + O_LF);
    const bf16_t* LWT = (const bf16_t*)(ws + O_LWT) + (size_t)l * 1920 * 128;
    const float* gln_g = pp->in[2] + (size_t)l * GW; const float* gln_b = pp->in[3] + (size_t)l * GW;
    const float* mu0 = pp->in[6] + (size_t)l * 2 * RPROJ; const float* mu1 = mu0 + RPROJ;
    const float* w0 = pp->in[7] + (size_t)l * 2 * RW; const float* a0 = pp->in[9] + (size_t)l * 2 * RW;
    const float* k_k = pp->in[12] + (size_t)l * RW; const float* k_a = pp->in[13] + (size_t)l * RW; const float* r_k = pp->in[14] + (size_t)l * RW;
    const float* conv_w = pp->in[17] + (size_t)l * 3 * 768; const float* conv_b = pp->in[18] + (size_t)l * 768; const float* gate_b = pp->in[19] + (size_t)l * 24;
    constexpr int TOK = 32, WR = TOK + 2, LIN = 264;
    bf16_t* winb = (bf16_t*)smem;
    bf16_t* lin = (bf16_t*)(smem + 95744);
    bf16_t* tk = (bf16_t*)(smem + 112640);
    bf16_t* tv = (bf16_t*)(smem + 137216);
    bf16_t* tvn = tk;
    bf16_t* icl = tk;
    const int tid = phase_tid(wv), lane = tid & 63, wave = tid >> 6, col = lane & 15, g = lane >> 4;
    for (int u = bidx; u < T / TOK; u += gdim) {
        const int t0 = u * TOK, s0 = t0 % S, bb = t0 / S;
        __syncthreads();
#pragma unroll 1
        for (int hb = 0; hb < 2; ++hb) {
            u32x2 wb[17];
#pragma unroll
            for (int q = 0; q < 17; ++q) {
                const int row = hb * 17 + q, sq = s0 - 1 + row;
                wb[q] = (u32x2){0u, 0u};
                if (sq >= 0 && sq < S && tid < 352) wb[q] = *(const u32x2*)(proj + (size_t)(t0 - 1 + row) * PLD + C_RW + tid * 4);
            }
            if (tid < 352) {
#pragma unroll
                for (int q = 0; q < 17; ++q) *(u32x2*)(winb + (hb * 17 + q) * RPROJ + tid * 4) = wb[q];
            }
        }
#pragma unroll 1
        for (int ps = 0; ps < 2; ++ps) {
            const int i = ps * 16 + (tid >> 5), l32 = tid & 31, t = t0 + i;
            float v[8], ug[8]; float sum = 0.f;
#pragma unroll
            for (int j = 0; j < 8; ++j) { const int c = j * 32 + l32; ug[j] = bf_lo((unsigned)proj[(size_t)t * PLD + c]); v[j] = bf_lo((unsigned)proj[(size_t)t * PLD + GW + c]); }
#pragma unroll
            for (int j = 0; j < 8; ++j) { const int c = j * 32 + l32; UG[(size_t)t * GW + c] = geluf_(ug[j]); v[j] = geluf_(v[j]); sum += v[j]; }
#pragma unroll
            for (int o = 16; o >= 1; o >>= 1) sum += SHX(sum, o, lane);
            const float mean = sum * (1.0f / GW); float q = 0.f;
#pragma unroll
            for (int j = 0; j < 8; ++j) { const float d = v[j] - mean; q += d * d; }
#pragma unroll
            for (int o = 16; o >= 1; o >>= 1) q += SHX(q, o, lane);
            const float rstd = 1.0f / sqrtf(q * (1.0f / GW) + LN_EPS);
#pragma unroll
            for (int j = 0; j < 8; ++j) { const int c = j * 32 + l32; tvn[c * TOK + i] = (bf16_t)f2bf((v[j] - mean) * rstd * gln_g[c] + gln_b[c]); }
        }
        __syncthreads();
#pragma unroll
        for (int q = 0; q < 2; ++q) {
            const int idx = tid + q * NTHREADS, c = idx >> 2, pc = idx & 3;
            *(u32x4*)(VNT + ((size_t)bb * GW + c) * S + s0 + pc * 8) = *(const u32x4*)(tvn + c * TOK + pc * 8);
        }
        int tb2 = tid; PIN_V(tb2);
#pragma unroll 4
        for (int q = 0; q < 16; ++q) {
            const int idx = tb2 + q * NTHREADS, i = idx >> 8, j = idx & 255, rc = 1152 + j;
            const float pv = bf_lo((unsigned)winb[i * RPROJ + rc]), cv = bf_lo((unsigned)winb[(i + 1) * RPROJ + rc]), nv = bf_lo((unsigned)winb[(i + 2) * RPROJ + rc]);
            const float x = cv + mu0[rc] * (pv - cv) + mu1[rc] * (nv - cv);
            lin[i * LIN + j] = (bf16_t)f2bf(j < 64 ? ftanh(x) : (j < 128 ? x : sigmoidf_(x)));
        }
        __syncthreads();
#pragma unroll 1
        for (int qg = 0; qg < 3; ++qg) {
            bf16x8 bw_[5][4]; float bias_[5];
#pragma unroll
            for (int q5 = 0; q5 < 5; ++q5) {
                const int nt = wave * 15 + qg * 5 + q5, grp = nt / 24, c = (nt % 24) * 16 + col;
                const bf16_t* bw = LWT + (size_t)(nt * 16 + col) * 128 + 8 * g;
#pragma unroll
                for (int ks = 0; ks < 2; ++ks) bw_[q5][ks] = *(const bf16x8*)(bw + ks * 32);
                if (grp == 4) {
#pragma unroll
                    for (int ks = 2; ks < 4; ++ks) bw_[q5][ks] = *(const bf16x8*)(bw + ks * 32);
                }
                bias_[q5] = grp < 2 ? w0[grp * RW + c] : (grp < 4 ? a0[(grp - 2) * RW + c] : 0.f);
            }
#pragma unroll
            for (int q5 = 0; q5 < 5; ++q5) {
                const int nt = wave * 15 + qg * 5 + q5, grp = nt / 24, c = (nt % 24) * 16 + col;
                const int kcol = grp < 2 ? 0 : (grp < 4 ? 64 : 128);
#pragma unroll
                for (int mt = 0; mt < 2; ++mt) {
                    f32x4 acc = (f32x4){0.f, 0.f, 0.f, 0.f};
                    const bf16_t* la = lin + (mt * 16 + col) * LIN + kcol + 8 * g;
#pragma unroll
                    for (int ks = 0; ks < 2; ++ks) acc = MFMA16(*(const bf16x8*)(la + ks * 32), bw_[q5][ks], acc);
                    if (grp == 4) {
#pragma unroll
                        for (int ks = 2; ks < 4; ++ks) acc = MFMA16(*(const bf16x8*)(la + ks * 32), bw_[q5][ks], acc);
                    }
                    const size_t tb = (size_t)(t0 + mt * 16 + 4 * g);
                    if (grp < 2) {
#pragma unroll
                        for (int r = 0; r < 4; ++r) LWG[(size_t)grp * T * RW + (tb + r) * RW + c] = -fexp(-softplusf_(-(acc[r] + bias_[q5])) - 0.5f);
                    } else if (grp < 4) {
#pragma unroll
                        for (int r = 0; r < 4; ++r) icl[((grp - 2) * TOK + mt * 16 + 4 * g + r) * RW + c] = (bf16_t)f2bf(sigmoidf_(acc[r] + bias_[q5]));
                    } else {
#pragma unroll
                        for (int r = 0; r < 4; ++r) GATE[(tb + r) * RW + c] = acc[r];
                    }
                }
            }
        }
        __syncthreads();
        if (wave < 6) {
            int c = tid; PIN_V(c); const int h = wave;
            const float kkc = k_k[c], kac = k_a[c], rkc = r_k[c];
            const float m0r = mu0[c], m1r = mu1[c], m0k = mu0[RW + c], m1k = mu1[RW + c], m0v = mu0[2 * RW + c], m1v = mu1[2 * RW + c];
#pragma unroll 1
            for (int hb = 0; hb < 2; ++hb) {
                float ic0[16], ic1[16];
#pragma unroll
                for (int i = 0; i < 16; ++i) { ic0[i] = bf_lo((unsigned)icl[(hb * 16 + i) * RW + c]); ic1[i] = bf_lo((unsigned)icl[(TOK + hb * 16 + i) * RW + c]); }
#pragma unroll
                for (int i = 0; i < 16; ++i) {
                    const int it = hb * 16 + i, t = t0 + it;
                    const bf16_t* w_ = winb + it * RPROJ + c;
                    const float rp = bf_lo((unsigned)w_[0]), rc_ = bf_lo((unsigned)w_[RPROJ]), rn = bf_lo((unsigned)w_[2 * RPROJ]);
                    const float kp = bf_lo((unsigned)w_[RW]), kc_ = bf_lo((unsigned)w_[RPROJ + RW]), kn = bf_lo((unsigned)w_[2 * RPROJ + RW]);
                    const float vp = bf_lo((unsigned)w_[2 * RW]), vc_ = bf_lo((unsigned)w_[RPROJ + 2 * RW]), vn = bf_lo((unsigned)w_[2 * RPROJ + 2 * RW]);
                    const float r = rc_ + m0r * (rp - rc_) + m1r * (rn - rc_);
                    const float k = kc_ + m0k * (kp - kc_) + m1k * (kn - kc_);
                    const float v = vc_ + m0v * (vp - vc_) + m1v * (vn - vc_);
                    const size_t o = (size_t)t * RW + c;
                    const float kq = k * kkc;
                    const float n2 = wave_sum_fast(kq * kq, lane);
                    const float kk = kq / fmaxf(sqrtf(n2), 1e-12f);
                    const float kd0 = k * (1.0f + (ic0[i] - 1.0f) * kac), kd1 = k * (1.0f + (ic1[i] - 1.0f) * kac);
                    const float bon = wave_sum_fast(r * (kd0 + kd1) * rkc, lane);
                    u32x4 rec; rec.x = pk2(r, v); rec.y = pk2(kk, 0.f); rec.z = pk2(kk * ic0[i], kk * ic1[i]); rec.w = pk2(kd0, kd1);
                    RK7[o] = rec;
                    VB[o] = (bf16_t)(rec.x >> 16);
                    if (lane == 0) BONUS[(size_t)t * RH + h] = bon;
                }
            }
        }
        __syncthreads();
        {
            u32x2 wb[17], vb[6];
            const int rsel = tid >= 192 ? 1 : 0, c4 = tid - rsel * 192;
#pragma unroll
            for (int q = 0; q < 17; ++q) {
                const int row = 2 * q + rsel, sq = s0 - 1 + row;
                wb[q] = (u32x2){0u, 0u};
                if (tid < 384 && sq >= 0 && sq < S) wb[q] = *(const u32x2*)(proj + (size_t)(t0 - 1 + row) * PLD + C_MW + c4 * 4);
            }
#pragma unroll
            for (int q = 0; q < 6; ++q) { const int idx = tid + q * NTHREADS, i = idx / 96, cc = (idx % 96) * 4; vb[q] = *(const u32x2*)(proj + (size_t)(t0 + i) * PLD + C_MW + 2 * MW + cc); }
            if (tid < 384) {
#pragma unroll
                for (int q = 0; q < 17; ++q) *(u32x2*)(winb + (2 * q + rsel) * 768 + c4 * 4) = wb[q];
            }
#pragma unroll
            for (int q = 0; q < 6; ++q) { const int idx = tid + q * NTHREADS, i = idx / 96, cc = (idx % 96) * 4; const u32x2 v = vb[q];
                tv[(cc + 0) * TOK + i] = (bf16_t)(v.x & 0xffffu); tv[(cc + 1) * TOK + i] = (bf16_t)(v.x >> 16); tv[(cc + 2) * TOK + i] = (bf16_t)(v.y & 0xffffu); tv[(cc + 3) * TOK + i] = (bf16_t)(v.y >> 16); }
        }
        for (int idx = tid; idx < TOK * 24; idx += NTHREADS) {
            const int i = idx / 24, gi = idx % 24, t = t0 + i;
            const int isf = gi / 12, dir = (gi / 6) & 1, h = gi % 6;
            const float gg = projg[(size_t)t * 256 + (3456 - (PLD - 256)) + gi] + gate_b[gi];
            if (isf) LF[((size_t)dir * T + t) * MH + h] = -softplusf_(-gg); else IG[((size_t)dir * T + t) * MH + h] = gg;
        }
        __syncthreads();
        int tcv = tid; PIN_V(tcv);
#pragma unroll 4
        for (int q = 0; q < 48; ++q) {
            const int idx = tcv + q * NTHREADS, i = idx / 768, c = idx % 768, t = t0 + i;
            const bf16_t* w_ = winb + i * 768 + c;
            float y = conv_b[c] + bf_lo((unsigned)w_[0]) * conv_w[c] + bf_lo((unsigned)w_[768]) * conv_w[768 + c] + bf_lo((unsigned)w_[1536]) * conv_w[2 * 768 + c];
            y = y * sigmoidf_(y);
            if (c < MW) MQB[(size_t)t * MW + c] = (bf16_t)f2bf(y);
            else { const bf16_t kb = (bf16_t)f2bf(y * 0.125f); MKB[(size_t)t * MW + (c - MW)] = kb; tk[(c - MW) * TOK + i] = kb; }
        }
        __syncthreads();
#pragma unroll
        for (int q = 0; q < 6; ++q) {
            const int idx = tid + q * NTHREADS, pc = idx & 3, c = (idx >> 2) % MW, which = idx / (4 * MW);
            const u32x4 val = *(const u32x4*)((which ? tv : tk) + c * TOK + pc * 8);
            bf16_t* dst = (which ? VT : KT) + ((size_t)(bb * MH) * 64 + c) * S + s0 + pc * 8;
            *(u32x4*)dst = val;
        }
    }
    __syncthreads();
}

__device__ __forceinline__ void phase_gmlp_mix(const Params& P, int l, unsigned char* smem, int wv, int bid, int nb) {
    PIN_S(bid); PIN_S(nb);
    ParamsPtr pp = PARAMS_PTR(P); PIN_S(pp); unsigned char* ws = pp->ws;
    const float* UG = (const float*)(ws + O_UG); const bf16_t* VNT = (const bf16_t*)(ws + O_VNT); bf16_t* GRP = (bf16_t*)(ws + O_GRP);
    const bf16_t* WSB = (const bf16_t*)(ws + O_WSB) + (size_t)l * GH * CH * CH; const float* gbs = pp->in[5] + (size_t)l * GH * CH;
    const int tid = phase_tid(wv), lane = tid & 63, wave = tid >> 6, col = lane & 15, g = lane >> 4;
    for (int u = bid; u < NB * NCH * GH; u += nb) {
        const int h = u % GH, c = (u / GH) % NCH, b = u / (GH * NCH);
        const int tok0 = b * S + c * CH;
        const bf16_t* wb = WSB + (size_t)h * CH * CH + (size_t)(wave * 16 + col) * CH + 8 * g;
        const bf16_t* vb = VNT + ((size_t)b * GW + h * 64 + col) * S + (size_t)c * CH + 8 * g;
        f32x4 acc[4];
#pragma unroll
        for (int et = 0; et < 4; ++et) acc[et] = (f32x4){0.f, 0.f, 0.f, 0.f};
#pragma unroll
        for (int ks = 0; ks < 4; ++ks) {
            const bf16x8 af = *(const bf16x8*)(wb + ks * 32);
#pragma unroll
            for (int et = 0; et < 4; ++et) acc[et] = MFMA16(af, *(const bf16x8*)(vb + (size_t)et * 16 * S + ks * 32), acc[et]);
        }
#pragma unroll
        for (int r = 0; r < 4; ++r) {
            const int p = wave * 16 + 4 * g + r; const size_t t = (size_t)(tok0 + p); const float bsv = gbs[h * CH + p];
#pragma unroll
            for (int et = 0; et < 4; ++et) { const int ch = h * 64 + et * 16 + col; GRP[t * D + ch] = (bf16_t)f2bf(UG[t * GW + ch] * (acc[et][r] + bsv)); }
        }
    }
}

constexpr int SC_STEPS = 16;
constexpr int SC_BUF = SC_STEPS * 6 * 64;
__device__ __forceinline__ void phase_rwkv_scan(const Params& P, int l, unsigned char* smem, int wv, int bid, int nb) {
    PIN_S(bid); PIN_S(nb);
    ParamsPtr pp = PARAMS_PTR(P); PIN_S(pp); unsigned char* ws = pp->ws;
    const float* RR = (const float*)(ws + O_RR); const float* VV = (const float*)(ws + O_VV); const float* KK = (const float*)(ws + O_KK);
    const float* DEC = (const float*)(ws + O_DEC); const float* KD = (const float*)(ws + O_KD); const float* ICLR = (const float*)(ws + O_ICLR);
    float* SCAN = (float*)(ws + O_SCAN); const float* BRKR = (const float*)(ws + O_BRKR);
    const int tid = phase_tid(wv), lane = tid & 63, wave = tid >> 6, rl = (lane >> 4) & 1, kq = (lane & 15) | ((lane >> 5) << 4);
    float* buf = (float*)smem;
    float* scal = buf + 2 * SC_BUF;
    float* outb = scal + 2 * SC_STEPS * 2;
    typedef float f32x2 __attribute__((ext_vector_type(2)));
    for (int u = bid; u < 2 * NB * RH * 4; u += nb) {
        const int qt = u & 3, h = (u >> 2) % RH, b = (u / (4 * RH)) % NB, d = u / (4 * RH * NB);
        const size_t doff = (size_t)d * T * RW;
        float s0 = 0.f, s1 = 0.f;
        float pw[2], pa[2], pb[2], pk[2], pr[2], pv[2], psc = 0.f;
#define SC_LOAD(c) do { _Pragma("unroll") for (int i = 0; i < 2; ++i) { const int idx = tid + NTHREADS * i, st = idx >> 6, k = idx & 63; const int tau = (c) * SC_STEPS + st, sq = d ? S - 1 - tau : tau; \
            const size_t o = (size_t)(b * S + sq) * RW + h * 64 + k; \
            pw[i] = DEC[doff + o]; pa[i] = KK[o]; pb[i] = ICLR[doff + o]; pk[i] = KD[doff + o]; pr[i] = RR[o]; pv[i] = VV[o]; }     \
            if (tid < 2 * SC_STEPS) { const int tau = (c) * SC_STEPS + (tid >> 1), sq = d ? S - 1 - tau : tau; psc = BRKR[((size_t)(d * T + b * S + sq) * RH + h) * 2 + (tid & 1)]; } } while (0)
#define SC_WRITE(c) do { float* B_ = buf + ((c) & 1) * SC_BUF; _Pragma("unroll") for (int i = 0; i < 2; ++i) { const int idx = tid + NTHREADS * i, st = idx >> 6, k = idx & 63; \
            float* q_ = B_ + st * 384 + k; q_[0] = pw[i]; q_[64] = -pa[i]; q_[128] = pa[i] * pb[i]; q_[192] = pk[i]; q_[256] = pw[i] * pr[i]; q_[320] = pv[i]; } \
            if (tid < 2 * SC_STEPS) scal[((c) & 1) * SC_STEPS * 2 + tid] = psc; } while (0)
        __syncthreads();
        SC_LOAD(0); SC_WRITE(0);
        __syncthreads();
        const int row = qt * 16 + wave * 2 + rl;
        for (int c = 0; c < S / SC_STEPS; ++c) {
            const bool more = (c + 1) < S / SC_STEPS;
            if (more) SC_LOAD(c + 1);
            const float* B = buf + (c & 1) * SC_BUF; const float* sc = scal + (c & 1) * SC_STEPS * 2; float* ob = outb + (c & 1) * SC_STEPS * 16;
            float outs[SC_STEPS];
            f32x2 w2 = *(const f32x2*)(B + 2 * kq), a2 = *(const f32x2*)(B + 64 + 2 * kq), b2 = *(const f32x2*)(B + 128 + 2 * kq);
            f32x2 k2 = *(const f32x2*)(B + 192 + 2 * kq), wr2 = *(const f32x2*)(B + 256 + 2 * kq);
            float v = B[320 + row]; float br = sc[0], kr = sc[1];
#pragma unroll
            for (int st = 0; st < SC_STEPS; ++st) {
                const int sn = st + 1 < SC_STEPS ? st + 1 : st;
                const float* q = B + sn * 384;
                const f32x2 nw2 = *(const f32x2*)(q + 2 * kq), na2 = *(const f32x2*)(q + 64 + 2 * kq), nb2 = *(const f32x2*)(q + 128 + 2 * kq);
                const f32x2 nk2 = *(const f32x2*)(q + 192 + 2 * kq), nwr2 = *(const f32x2*)(q + 256 + 2 * kq);
                const float nv = q[320 + row], nbr = sc[sn * 2], nkr = sc[sn * 2 + 1];
                SCHED_BAR();
                float sa = s0 * a2.x + s1 * a2.y;
                float po = s0 * wr2.x + s1 * wr2.y;
                sa = row32_sum(sa); po = row32_sum(po);
                outs[st] = po + sa * br + v * kr;
                s0 = s0 * w2.x + (sa * b2.x + v * k2.x); s1 = s1 * w2.y + (sa * b2.y + v * k2.y);
                SCHED_BAR();
                w2 = nw2; a2 = na2; b2 = nb2; k2 = nk2; wr2 = nwr2; v = nv; br = nbr; kr = nkr;
            }
            if (kq == 0) {
#pragma unroll
                for (int st = 0; st < SC_STEPS; ++st) ob[st * 16 + wave * 2 + rl] = outs[st];
            }
            if (more) SC_WRITE(c + 1);
            __syncthreads();
            if (tid < 16 * SC_STEPS) {
                const int st = tid >> 4, r = tid & 15, tau = c * SC_STEPS + st, sq = d ? S - 1 - tau : tau;
                SCAN[doff + (size_t)(b * S + sq) * RW + h * 64 + qt * 16 + r] = ob[st * 16 + r];
            }
        }
#undef SC_LOAD
#undef SC_WRITE
    }
    __syncthreads();
}

constexpr int RST = 72;
constexpr int RARR = 64 * RST;
__device__ __forceinline__ f32x4 tile_nt(const bf16_t* Aa, int ta, const bf16_t* Ba, int tb, f32x4 acc, int col, int g) {
#pragma unroll
    for (int ks = 0; ks < 2; ++ks) {
        const bf16x8 af = *(const bf16x8*)(Aa + (ta * 16 + col) * RST + ks * 32 + 8 * g);
        const bf16x8 bfr = *(const bf16x8*)(Ba + (tb * 16 + col) * RST + ks * 32 + 8 * g);
        acc = MFMA16(af, bfr, acc);
    }
    return acc;
}
__device__ __forceinline__ void phase_rwkv_pre(const Params& P, int l, unsigned char* smem, int wv) {
    ParamsPtr pp = PARAMS_PTR(P); PIN_S(pp); unsigned char* ws = pp->ws; int bidx = (int)blockIdx.x, gdim = (int)gridDim.x; PIN_S(bidx); PIN_S(gdim);
    const u32x4* RK7 = (const u32x4*)(ws + O_RK7);
    const float* LWG = (const float*)(ws + O_LW);
    bf16_t* Qg = (bf16_t*)(ws + O_RQ); bf16_t* Ag = (bf16_t*)(ws + O_RA); bf16_t* Hg = (bf16_t*)(ws + O_RH); bf16_t* Gg = (bf16_t*)(ws + O_RG);
    const int tid0 = phase_tid(wv);
#define RW_STAGE_VARS int tid = tid0; PIN_V(tid); const int lane = tid & 63, wave = tid >> 6, col = lane & 15, g = lane >> 4; (void)lane; (void)wave; (void)col; (void)g;
    bf16_t* At = (bf16_t*)smem; bf16_t* Bt = At + RARR; bf16_t* Kt = Bt + RARR; bf16_t* Rt = Kt + RARR;
    bf16_t* BtT = Rt + RARR; bf16_t* KtT = BtT + RARR; bf16_t* VT = KtT + RARR;
    bf16_t* Lak = VT + RARR; bf16_t* Mrb = Lak + RARR; bf16_t* Mrk = Mrb + RARR; bf16_t* YT = Mrk + RARR; bf16_t* W2T = YT + RARR;
    bf16_t* Lbo = W2T + RARR;
    float* LabT = (float*)(Lbo + RARR);
    float* Xs = LabT + 4096;
    float* Pb = Xs + 4096;
    float* segs = Pb + 2048;
    float* PC = segs + 512;
    float plw[8]; u32x4 prec[8];
#define RW_LOAD(uu) do { const int c_ = (uu) % RNC, h_ = ((uu) / RNC) % RH, b_ = ((uu) / (RNC * RH)) % NB, d_ = (uu) / (RNC * RH * NB); const size_t doff_ = (size_t)d_ * T * RW; \
        const int ch_ = tid0 & 63, sg_ = tid0 >> 6; _Pragma("unroll") for (int j = 0; j < 8; ++j) { const int tau = c_ * RC + sg_ * 8 + j, sq = d_ ? S - 1 - tau : tau; const size_t o = (size_t)(b_ * S + sq) * RW + h_ * 64 + ch_; \
        plw[j] = LWG[doff_ + o]; prec[j] = RK7[o]; } } while (0)
    if (bidx < RUN) RW_LOAD(bidx);
    for (int u = bidx; u < RUN; u += gdim) {
        const int c = u % RNC, h = (u / RNC) % RH, b = (u / (RNC * RH)) % NB, d = u / (RNC * RH * NB);
        (void)c; (void)h; (void)b; (void)d;
        __syncthreads();
        {
            RW_STAGE_VARS
            const int ch = tid & 63, sg = tid >> 6;
            float lw[8]; unsigned kk[8], bq_[8], kd[8], rr[8], vv[8];
#pragma unroll
            for (int j = 0; j < 8; ++j) { lw[j] = plw[j]; kk[j] = prec[j].y & 0xffffu; bq_[j] = d ? (prec[j].z >> 16) : (prec[j].z & 0xffffu); kd[j] = d ? (prec[j].w >> 16) : (prec[j].w & 0xffffu); rr[j] = prec[j].x & 0xffffu; vv[j] = prec[j].x >> 16; }
            if (u + gdim < RUN) RW_LOAD(u + gdim);
            float run = 0.f;
#pragma unroll
            for (int j = 0; j < 8; ++j) { run += lw[j]; lw[j] = run; }
            segs[sg * 64 + ch] = run;
            __syncthreads();
            float off = 0.f;
            for (int q = 0; q < sg; ++q) off += segs[q * 64 + ch];
            u32x4 pbt, pkt, pvt; unsigned tb[8], tk[8], tvv[8];
            float prev = off;
#pragma unroll
            for (int j = 0; j < 8; ++j) {
                const int t = sg * 8 + j; const float cl = off + lw[j];
                const float ep = fexp(prev), en = fexp(-cl), epc = fexp(cl);
                const unsigned a_ = f2bf(-bf_lo(kk[j]) * ep), b_ = f2bf(bf_lo(bq_[j]) * en), k_ = f2bf(bf_lo(kd[j]) * en), r_ = f2bf(bf_lo(rr[j]) * epc), v_ = vv[j];
                At[t * RST + ch] = (bf16_t)a_; Bt[t * RST + ch] = (bf16_t)b_; Kt[t * RST + ch] = (bf16_t)k_; Rt[t * RST + ch] = (bf16_t)r_;
                tb[j] = b_; tk[j] = k_; tvv[j] = v_;
                prev = cl;
            }
            if (sg == 7) PC[ch] = fexp(prev);
            pbt.x = tb[0] | (tb[1] << 16); pbt.y = tb[2] | (tb[3] << 16); pbt.z = tb[4] | (tb[5] << 16); pbt.w = tb[6] | (tb[7] << 16);
            pkt.x = tk[0] | (tk[1] << 16); pkt.y = tk[2] | (tk[3] << 16); pkt.z = tk[4] | (tk[5] << 16); pkt.w = tk[6] | (tk[7] << 16);
            pvt.x = tvv[0] | (tvv[1] << 16); pvt.y = tvv[2] | (tvv[3] << 16); pvt.z = tvv[4] | (tvv[5] << 16); pvt.w = tvv[6] | (tvv[7] << 16);
            *(u32x4*)(BtT + ch * RST + sg * 8) = pbt; *(u32x4*)(KtT + ch * RST + sg * 8) = pkt; *(u32x4*)(VT + ch * RST + sg * 8) = pvt;
            for (int z_ = tid; z_ < 2 * RARR / 8; z_ += NTHREADS) ((u32x4*)YT)[z_] = (u32x4){0u, 0u, 0u, 0u};
        }
        __syncthreads();
        {
            RW_STAGE_VARS
            const int m = wave >> 1;
            const bf16_t* Ym = (m == 0 || m == 2) ? Bt : Kt; const bf16_t* Xm = (m < 2) ? At : Rt;
#pragma unroll 1
            for (int q = 0; q < 8; ++q) {
                const int tix = (wave & 1) * 8 + q, it = tix >> 2, tt = tix & 3;
                f32x4 acc = (f32x4){0.f, 0.f, 0.f, 0.f};
                if (it <= tt) acc = tile_nt(Ym, it, Xm, tt, acc, col, g);
                const int t = tt * 16 + col, i0 = it * 16 + 4 * g;
                float o4[4];
#pragma unroll
                for (int r = 0; r < 4; ++r) { const int i = i0 + r; const bool ok = m < 2 ? (i < t) : (i <= t); o4[r] = ok ? acc[r] : 0.f; }
                if (m == 0) {
#pragma unroll
                    for (int r = 0; r < 4; ++r) LabT[(i0 + r) * 64 + t] = o4[r];
                    const bool offd = it < tt;
                    u32x2 w2; w2.x = offd ? pk2(o4[0], o4[1]) : 0u; w2.y = offd ? pk2(o4[2], o4[3]) : 0u; *(u32x2*)(Lbo + t * RST + i0) = w2;
                }
                else { bf16_t* dst = (m == 1 ? Lak : (m == 2 ? Mrb : Mrk)) + t * RST + i0; u32x2 w2; w2.x = pk2(o4[0], o4[1]); w2.y = pk2(o4[2], o4[3]); *(u32x2*)dst = w2; }
            }
        }
        __syncthreads();
        {
            RW_STAGE_VARS
#pragma unroll
            for (int q = 0; q < 2; ++q) {
                const int tix = wave * 2 + q, tt = tix >> 2, et = tix & 3;
                f32x4 acc = (f32x4){0.f, 0.f, 0.f, 0.f};
                acc = tile_nt(Lak, tt, VT, et, acc, col, g);
#pragma unroll
                for (int r = 0; r < 4; ++r) Xs[(tt * 16 + 4 * g + r) * 64 + et * 16 + col] = acc[r];
            }
        }
        __syncthreads();
        {
            RW_STAGE_VARS
#pragma unroll 1
            for (int bb = 0; bb < 4; ++bb) {
                if (bb > 0) {
                    const bf16_t* Zt = (wave < 4 ? YT : W2T) + ((wave & 3) * 16 + col) * RST + 8 * g;
                    const bf16_t* La = Lbo + (16 * bb + col) * RST + 8 * g;
                    f32x4 acc = (f32x4){0.f, 0.f, 0.f, 0.f};
                    acc = MFMA16(*(const bf16x8*)La, *(const bf16x8*)Zt, acc);
                    if (bb > 2) acc = MFMA16(*(const bf16x8*)(La + 32), *(const bf16x8*)(Zt + 32), acc);
#pragma unroll
                    for (int r = 0; r < 4; ++r) Pb[(4 * g + r) * 128 + wave * 16 + col] = acc[r];
                }
                __syncthreads();
                if (wave < 2) {
                    float acc[16];
                    if (wave == 0) {
#pragma unroll
                        for (int r = 0; r < 16; ++r) acc[r] = bf_lo((unsigned)At[(16 * bb + r) * RST + lane]);
                    } else {
#pragma unroll
                        for (int r = 0; r < 16; ++r) acc[r] = Xs[(16 * bb + r) * 64 + lane];
                    }
                    if (bb > 0) {
#pragma unroll
                        for (int r = 0; r < 16; ++r) acc[r] += Pb[r * 128 + wave * 64 + lane];
                    }
                    const float* dp = LabT + (16 * bb) * 64 + 16 * bb;
#pragma unroll
                    for (int r = 1; r < 16; ++r)
#pragma unroll
                        for (int r2 = 0; r2 < r; ++r2) acc[r] += dp[r2 * 64 + r] * acc[r2];
                    bf16_t* dst = (wave == 0 ? YT : W2T) + lane * RST;
                    u32x4 w0, w1;
                    w0.x = pk2(acc[0], acc[1]); w0.y = pk2(acc[2], acc[3]); w0.z = pk2(acc[4], acc[5]); w0.w = pk2(acc[6], acc[7]);
                    w1.x = pk2(acc[8], acc[9]); w1.y = pk2(acc[10], acc[11]); w1.z = pk2(acc[12], acc[13]); w1.w = pk2(acc[14], acc[15]);
                    *(u32x4*)(dst + 16 * bb) = w0; *(u32x4*)(dst + 16 * bb + 8) = w1;
                }
                __syncthreads();
            }
        }
        __syncthreads();
        {
            RW_STAGE_VARS
            const int ty = wave >> 1;
#pragma unroll 1
            for (int q = 0; q < 8; ++q) {
                const int tix = (wave & 1) * 8 + q, ra = tix >> 2, cb = tix & 3;
                f32x4 acc = (f32x4){0.f, 0.f, 0.f, 0.f};
                if (ty == 0) {
                    acc = tile_nt(YT, ra, Mrb, cb, acc, col, g);
                    const u32x2 rt2 = *(const u32x2*)(Rt + (cb * 16 + col) * RST + ra * 16 + 4 * g);
                    u32x2 qb2; qb2.x = pk2(acc[0] + bf_lo(rt2.x), acc[1] + bf_hi(rt2.x)); qb2.y = pk2(acc[2] + bf_lo(rt2.y), acc[3] + bf_hi(rt2.y));
                    *(u32x2*)(Qg + (size_t)u * 4096 + (tix * 64 + lane) * 4) = qb2;
                } else if (ty == 1) {
                    acc = tile_nt(Mrb, ra, W2T, cb, acc, col, g); acc = tile_nt(Mrk, ra, VT, cb, acc, col, g);
                    { u32x2 hb; hb.x = pk2(acc[0], acc[1]); hb.y = pk2(acc[2], acc[3]); *(u32x2*)(Hg + (size_t)u * 4096 + (tix * 64 + lane) * 4) = hb; }
                } else if (ty == 2) {
                    acc = tile_nt(YT, ra, BtT, cb, acc, col, g);
                    const float pc = PC[cb * 16 + col]; const int k1 = cb * 16 + col;
                    float a4[4];
#pragma unroll
                    for (int r = 0; r < 4; ++r) a4[r] = pc * (acc[r] + ((ra * 16 + 4 * g + r) == k1 ? 1.0f : 0.f));
                    u32x2 ab2; ab2.x = pk2(a4[0], a4[1]); ab2.y = pk2(a4[2], a4[3]);
                    *(u32x2*)(Ag + (size_t)u * 4096 + (tix * 64 + lane) * 4) = ab2;
                } else {
                    acc = tile_nt(BtT, ra, W2T, cb, acc, col, g); acc = tile_nt(KtT, ra, VT, cb, acc, col, g);
#pragma unroll
                    for (int r = 0; r < 4; ++r) acc[r] *= PC[ra * 16 + 4 * g + r];
                    { u32x2 gb2; gb2.x = pk2(acc[0], acc[1]); gb2.y = pk2(acc[2], acc[3]); *(u32x2*)(Gg + (size_t)u * 4096 + (tix * 64 + lane) * 4) = gb2; }
                }
            }
        }
    }
    __syncthreads();
#undef RW_STAGE_VARS
#undef RW_LOAD
}
__device__ __forceinline__ void phase_rwkv_seq(const Params& P, int l, unsigned char* smem, int wv) {
    ParamsPtr pp = PARAMS_PTR(P); PIN_S(pp); unsigned char* ws = pp->ws; int bidx = (int)blockIdx.x, gdim = (int)gridDim.x; PIN_S(bidx); PIN_S(gdim);
    const bf16_t* Ag = (const bf16_t*)(ws + O_RA); const bf16_t* Gg = (const bf16_t*)(ws + O_RG); bf16_t* Sg = (bf16_t*)(ws + O_RS);
    const int tid = phase_tid(wv), lane = tid & 63, wave = tid >> 6, col = lane & 15, g = lane >> 4;
    const int gw = wave * gdim + bidx, ngw = NWAVES * gdim;
    for (int un = gw; un < 2 * NB * RH * 2; un += ngw) {
        const int ch = un >> 1, eh = un & 1;
        f32x4 acc[4][2];
#pragma unroll
        for (int a_ = 0; a_ < 4; ++a_)
#pragma unroll
            for (int b_ = 0; b_ < 2; ++b_) acc[a_][b_] = (f32x4){0.f, 0.f, 0.f, 0.f};
        u32x2 alo[4][2], ahi[4][2]; u32x2 gq[4][2];
        const unsigned aoff = (unsigned)(col * 64 + 4 * g), goff = (unsigned)(lane * 4);
#define RS_LOAD(cc) do { const bf16_t* ab_ = Ag + (size_t)(ch * RNC + (cc)) * 4096; const bf16_t* gb_ = Gg + (size_t)(ch * RNC + (cc)) * 4096 + eh * 512; \
            _Pragma("unroll") for (int ra = 0; ra < 4; ++ra) _Pragma("unroll") for (int p = 0; p < 2; ++p) { alo[ra][p] = *(const u32x2*)(ab_ + ((2 * p * 4 + ra) * 256) + goff); ahi[ra][p] = *(const u32x2*)(ab_ + (((2 * p + 1) * 4 + ra) * 256) + goff); } \
            _Pragma("unroll") for (int ra = 0; ra < 4; ++ra) _Pragma("unroll") for (int cb = 0; cb < 2; ++cb) gq[ra][cb] = *(const u32x2*)(gb_ + ((ra * 4 + cb) * 256) + goff); } while (0)
        RS_LOAD(0);
#pragma unroll 1
        for (int c = 0; c < RNC; ++c) {
            bf16_t* sb_ = Sg + (size_t)(ch * RNC + c) * 4096 + eh * 2048;
            bf16x8 bq[2][2];
#pragma unroll
            for (int cb = 0; cb < 2; ++cb) {
#pragma unroll
                for (int ra = 0; ra < 4; ++ra) {
                    u32x2 w2; w2.x = pk2(acc[ra][cb][0], acc[ra][cb][1]); w2.y = pk2(acc[ra][cb][2], acc[ra][cb][3]);
                    *(u32x2*)(sb_ + (cb * 1024 + ra * 16) + aoff) = w2;
                }
#pragma unroll
                for (int p = 0; p < 2; ++p) bq[p][cb] = cvt8(acc[2 * p][cb], acc[2 * p + 1][cb]);
            }
            u32x4 af[4][2];
#pragma unroll
            for (int ra = 0; ra < 4; ++ra) {
#pragma unroll
                for (int p = 0; p < 2; ++p) af[ra][p] = (u32x4){alo[ra][p].x, alo[ra][p].y, ahi[ra][p].x, ahi[ra][p].y};
#pragma unroll
                for (int cb = 0; cb < 2; ++cb) acc[ra][cb] = (f32x4){bf_lo(gq[ra][cb].x), bf_hi(gq[ra][cb].x), bf_lo(gq[ra][cb].y), bf_hi(gq[ra][cb].y)};
            }
            if (c + 1 < RNC) RS_LOAD(c + 1);
#pragma unroll
            for (int ra = 0; ra < 4; ++ra)
#pragma unroll
                for (int cb = 0; cb < 2; ++cb)
#pragma unroll
                    for (int p = 0; p < 2; ++p) acc[ra][cb] = MFMA16(__builtin_bit_cast(bf16x8, af[ra][p]), bq[p][cb], acc[ra][cb]);
        }
#undef RS_LOAD
    }
}
__device__ __forceinline__ void phase_rwkv_out(const Params& P, int l, unsigned char* smem, int wv) {
    ParamsPtr pp = PARAMS_PTR(P); PIN_S(pp); unsigned char* ws = pp->ws; int bidx = (int)blockIdx.x, gdim = (int)gridDim.x; PIN_S(bidx); PIN_S(gdim);
    const bf16_t* Qg = (const bf16_t*)(ws + O_RQ); const bf16_t* Sg = (const bf16_t*)(ws + O_RS); const bf16_t* Hg = (const bf16_t*)(ws + O_RH);
    const bf16_t* VB = (const bf16_t*)(ws + O_VB); const float* GATE = (const float*)(ws + O_GATE); const float* BONUS = (const float*)(ws + O_BONUS);
    bf16_t* GRP = (bf16_t*)(ws + O_GRP);
    const float* rln_g = pp->in[15] + (size_t)l * RW; const float* rln_b = pp->in[16] + (size_t)l * RW;
    const int tid = phase_tid(wv), lane = tid & 63, wave = tid >> 6, col = lane & 15, g = lane >> 4;
    for (int pu = bidx * NWAVES + wave; pu < NB * RH * RNC; pu += gdim * NWAVES) {
        const int c = pu % RNC, h = (pu / RNC) % RH, b = pu / (RNC * RH);
        f32x4 o[2][4][4];
#pragma unroll
        for (int d = 0; d < 2; ++d) {
            const int u = ((d * NB + b) * RH + h) * RNC + (d ? RNC - 1 - c : c);
            const size_t ub = (size_t)u * 4096;
            bf16x8 qa[4][2], sb[4][2];
#pragma unroll
            for (int q = 0; q < 4; ++q)
#pragma unroll
                for (int ks = 0; ks < 2; ++ks) {
                    const u32x2 q0 = *(const u32x2*)(Qg + ub + ((2 * ks * 4 + q) * 64 + lane) * 4), q1 = *(const u32x2*)(Qg + ub + (((2 * ks + 1) * 4 + q) * 64 + lane) * 4);
                    qa[q][ks] = __builtin_bit_cast(bf16x8, (u32x4){q0.x, q0.y, q1.x, q1.y});
                    const bf16_t* sp_ = Sg + ub + (q * 16 + col) * 64 + ks * 32 + 4 * g;
                    const u32x2 s0_ = *(const u32x2*)sp_, s1_ = *(const u32x2*)(sp_ + 16);
                    sb[q][ks] = __builtin_bit_cast(bf16x8, (u32x4){s0_.x, s0_.y, s1_.x, s1_.y});
                }
#pragma unroll
            for (int tt = 0; tt < 4; ++tt)
#pragma unroll
                for (int et = 0; et < 4; ++et) {
                    const u32x2 hb = *(const u32x2*)(Hg + ub + ((tt * 4 + et) * 64 + lane) * 4);
                    f32x4 acc = (f32x4){bf_lo(hb.x), bf_hi(hb.x), bf_lo(hb.y), bf_hi(hb.y)};
#pragma unroll
                    for (int ks = 0; ks < 2; ++ks) acc = MFMA16(qa[tt][ks], sb[et][ks], acc);
                    o[d][tt][et] = acc;
                }
        }
        const int src = (3 - g) * 16 + col;
#pragma unroll
        for (int tt = 0; tt < 4; ++tt)
#pragma unroll
            for (int et = 0; et < 4; ++et)
#pragma unroll
                for (int r = 0; r < 4; ++r) o[0][tt][et][r] += SHL(o[1][3 - tt][et][3 - r], src);
        float* tile = (float*)smem + wave * (64 * 68);
        WAVE_SYNC();
#pragma unroll
        for (int tt = 0; tt < 4; ++tt)
#pragma unroll
            for (int et = 0; et < 4; ++et)
#pragma unroll
                for (int r = 0; r < 4; ++r) tile[(tt * 16 + 4 * g + r) * 68 + et * 16 + col] = o[0][tt][et][r];
        WAVE_SYNC();
        {
            const int c4 = (lane & 15) * 4, ch = h * 64 + c4;
            const f32x4 lg = *(const f32x4*)(rln_g + ch), lb = *(const f32x4*)(rln_b + ch);
#pragma unroll 1
            for (int qb = 0; qb < 2; ++qb) {
                f32x4 gt_[8]; u32x2 vb_[8]; float bo_[8];
#pragma unroll
                for (int q8 = 0; q8 < 8; ++q8) {
                    const size_t t = (size_t)(b * S + c * RC + (qb * 8 + q8) * 4 + (lane >> 4));
                    gt_[q8] = *(const f32x4*)(GATE + t * RW + ch); vb_[q8] = *(const u32x2*)(VB + t * RW + ch); bo_[q8] = BONUS[t * RH + h];
                }
#pragma unroll
                for (int q8 = 0; q8 < 8; ++q8) {
                    const int tl = (qb * 8 + q8) * 4 + (lane >> 4);
                    const size_t t = (size_t)(b * S + c * RC + tl);
                    const f32x4 x = *(const f32x4*)(tile + tl * 68 + c4);
                    const float mean = row16_sum((x.x + x.y) + (x.z + x.w)) * (1.0f / 64.0f);
                    const f32x4 dl = x - mean;
                    const float var = row16_sum((dl.x * dl.x + dl.y * dl.y) + (dl.z * dl.z + dl.w * dl.w)) * (1.0f / 64.0f);
                    const float rstd = 1.0f / sqrtf(var + GN_EPS);
                    f32x4 y = dl * rstd * lg + lb;
                    y.x += bo_[q8] * bf_lo(vb_[q8].x); y.y += bo_[q8] * bf_hi(vb_[q8].x); y.z += bo_[q8] * bf_lo(vb_[q8].y); y.w += bo_[q8] * bf_hi(vb_[q8].y);
                    y = y * gt_[q8];
                    u32x2 ob; ob.x = pk2(y.x, y.y); ob.y = pk2(y.z, y.w);
                    *(u32x2*)(GRP + t * D + GW + ch) = ob;
                }
            }
        }
    }
    __syncthreads();
}

__device__ __forceinline__ void phase_mlstm_local(const Params& P, int l, unsigned char* smem, int wv, int bid, int nb) {
    PIN_S(bid); PIN_S(nb);
    ParamsPtr pp = PARAMS_PTR(P); PIN_S(pp); unsigned char* ws = pp->ws;
    const bf16_t* KT = (const bf16_t*)(ws + O_KT); const bf16_t* VT = (const bf16_t*)(ws + O_VT);
    const float* IG = (const float*)(ws + O_IG); const float* LF = (const float*)(ws + O_LF);
    float* CL = (float*)(ws + O_CL); float* NLb = (float*)(ws + O_NL); float* ML = (float*)(ws + O_ML); float* BL = (float*)(ws + O_BL);
    float* GVT = (float*)(ws + O_GVT); float* PMX = (float*)(ws + O_PMX); float* BCT = (float*)(ws + O_BCT);
    const int tid = phase_tid(wv), lane = tid & 63, wave = tid >> 6, col = lane & 15, g = lane >> 4;
    float* wts = (float*)smem + wave * 128;
    for (int u = bid * NWAVES + wave; u < 2 * NB * MH * NCH; u += nb * NWAVES) {
        const int c = u % NCH, h = (u / NCH) % MH, p = u / (NCH * MH), d = p / NB, b = p % NB;
        const int tc = d ? NCH - 1 - c : c, tok0 = b * S + tc * CH;
        const int i0 = d ? 127 - 2 * lane : 2 * lane, i1 = d ? i0 - 1 : i0 + 1;
        const size_t g0 = ((size_t)d * T + tok0 + i0) * MH + h, g1 = ((size_t)d * T + tok0 + i1) * MH + h;
        const float lf0 = LF[g0], lf1 = LF[g1], ig0 = IG[g0], ig1 = IG[g1];
        const float c1 = lf0 + lf1;
        float incl = c1;
#pragma unroll
        for (int o = 1; o < 64; o <<= 1) { const float tq = SHUP(incl, o, lane); if (lane >= o) incl += tq; }
        const float excl = incl - c1, bc0 = excl + lf0, bc1 = incl;
        const float blast = RDL(incl, 63);
        const float gv0 = ig0 - bc0, gv1 = ig1 - bc1, pl1 = fmaxf(gv0, gv1);
        float mincl = pl1;
#pragma unroll
        for (int o = 1; o < 64; o <<= 1) { const float tq = SHUP(mincl, o, lane); if (lane >= o) mincl = fmaxf(mincl, tq); }
        float mexcl = SHUP(mincl, 1, lane); if (lane == 0) mexcl = -INFINITY;
        const float pm0 = fmaxf(mexcl, gv0), pm1 = mincl;
        const float mloc = blast + RDL(mincl, 63);
        WAVE_SYNC();
        wts[i0] = fexp(blast + gv0 - mloc); wts[i1] = fexp(blast + gv1 - mloc);
        GVT[g0] = gv0; GVT[g1] = gv1; PMX[g0] = pm0; PMX[g1] = pm1; BCT[g0] = bc0; BCT[g1] = bc1;
        if (lane == 0) { ML[u] = mloc; BL[u] = blast; }
        WAVE_SYNC();
        const bf16_t* vbase = VT + ((size_t)(b * MH + h) * 64) * S + (size_t)tc * CH;
        const bf16_t* kbase = KT + ((size_t)(b * MH + h) * 64) * S + (size_t)tc * CH;
        const unsigned loff = (unsigned)(col * S + 8 * g);
        f32x4 acc[4][4];
#pragma unroll
        for (int a_ = 0; a_ < 4; ++a_)
#pragma unroll
            for (int b_ = 0; b_ < 4; ++b_) acc[a_][b_] = (f32x4){0.f, 0.f, 0.f, 0.f};
        float nsum[4] = {0.f, 0.f, 0.f, 0.f};
#pragma unroll 1
        for (int ks = 0; ks < 4; ++ks) {
            const int ii = ks * 32 + 8 * g;
            const f32x4 w0 = *(const f32x4*)(wts + ii), w1 = *(const f32x4*)(wts + ii + 4);
            bf16x8 af[4], bfk[4];
#pragma unroll
            for (int q = 0; q < 4; ++q) af[q] = *(const bf16x8*)(vbase + ((size_t)q * 16 * S + ks * 32) + loff);
#pragma unroll
            for (int q = 0; q < 4; ++q) {
                const u32x4 kr = *(const u32x4*)(kbase + ((size_t)q * 16 * S + ks * 32) + loff);
                f32x4 k0, k1;
                k0.x = bf_lo(kr.x) * w0.x; k0.y = bf_hi(kr.x) * w0.y; k0.z = bf_lo(kr.y) * w0.z; k0.w = bf_hi(kr.y) * w0.w;
                k1.x = bf_lo(kr.z) * w1.x; k1.y = bf_hi(kr.z) * w1.y; k1.z = bf_lo(kr.w) * w1.z; k1.w = bf_hi(kr.w) * w1.w;
                nsum[q] += (k0.x + k0.y) + (k0.z + k0.w) + (k1.x + k1.y) + (k1.z + k1.w);
                bfk[q] = cvt8(k0, k1);
            }
#pragma unroll
            for (int a_ = 0; a_ < 4; ++a_)
#pragma unroll
                for (int b_ = 0; b_ < 4; ++b_) acc[a_][b_] = MFMA16(af[a_], bfk[b_], acc[a_][b_]);
        }
        float* cbase = CL + (size_t)u * 4096;
        const unsigned coff = (unsigned)(4 * g * 64 + col);
#pragma unroll
        for (int b_ = 0; b_ < 4; ++b_) {
#pragma unroll
            for (int a_ = 0; a_ < 4; ++a_)
#pragma unroll
                for (int r = 0; r < 4; ++r) cbase[(a_ * 16 * 64 + r * 64 + b_ * 16) + coff] = acc[a_][b_][r];
            float ns = nsum[b_]; ns += SHX(ns, 16, lane); ns += SHX(ns, 32, lane);
            if (g == 0) NLb[(size_t)u * 64 + b_ * 16 + col] = ns;
        }
    }
    __syncthreads();
}

__device__ __forceinline__ void phase_mlstm_carry(const Params& P, int l, unsigned char* smem, int wv) {
    ParamsPtr pp = PARAMS_PTR(P); PIN_S(pp); unsigned char* ws = pp->ws; int bidx = (int)blockIdx.x, gdim = (int)gridDim.x; PIN_S(bidx); PIN_S(gdim);
    float* CL = (float*)(ws + O_CL); float* NLb = (float*)(ws + O_NL); const float* ML = (const float*)(ws + O_ML); const float* BL = (const float*)(ws + O_BL);
    float* MIN = (float*)(ws + O_MIN);
    const int total = 2 * NB * MH * 4160;
    const int tid = phase_tid(wv);
    for (int gi = bidx * NTHREADS + tid; gi < total; gi += gdim * NTHREADS) {
        const int ph = gi / 4160, e = gi % 4160;
        float* base_ = e < 4096 ? CL + (size_t)ph * NCH * 4096 + e : NLb + (size_t)ph * NCH * 64 + (e - 4096);
        const int stride = e < 4096 ? 4096 : 64;
        static_assert(NCH <= 32, "carry scan keeps one chunk value per register");
        float loc[NCH], bl[NCH], ml[NCH];
#pragma unroll
        for (int c = 0; c < NCH; ++c) { loc[c] = base_[(size_t)c * stride]; bl[c] = BL[ph * NCH + c]; ml[c] = ML[ph * NCH + c]; }
        float m = 0.f, val = 0.f;
#pragma unroll
        for (int c = 0; c < NCH; ++c) {
            base_[(size_t)c * stride] = val;
            if (e == 0) MIN[ph * NCH + c] = m;
            const float mn = fmaxf(bl[c] + m, ml[c]);
            val = fexp(bl[c] + m - mn) * val + fexp(ml[c] - mn) * loc[c];
            m = mn;
        }
    }
}

__device__ __forceinline__ void phase_mlstm_out(const Params& P, int l, unsigned char* smem, int wv) {
    ParamsPtr pp = PARAMS_PTR(P); PIN_S(pp); unsigned char* ws = pp->ws; int bidx = (int)blockIdx.x, gdim = (int)gridDim.x; PIN_S(bidx); PIN_S(gdim);
    const bf16_t* proj = (const bf16_t*)(ws + O_PROJ);
    const bf16_t* MQB = (const bf16_t*)(ws + O_MQB); const bf16_t* MKB = (const bf16_t*)(ws + O_MKB); const bf16_t* VT = (const bf16_t*)(ws + O_VT);
    const float* GVT = (const float*)(ws + O_GVT); const float* PMX = (const float*)(ws + O_PMX); const float* BCT = (const float*)(ws + O_BCT);
    const float* CL = (const float*)(ws + O_CL); const float* NLb = (const float*)(ws + O_NL); const float* MIN = (const float*)(ws + O_MIN);
    bf16_t* GRP = (bf16_t*)(ws + O_GRP);
    const float* mln_g = pp->in[20] + (size_t)l * MW;
    const int tid = phase_tid(wv), lane = tid & 63, wave = tid >> 6, col = lane & 15, g = lane >> 4;
    constexpr int KP = 72, VP = 136;
    bf16_t* Ks = (bf16_t*)smem;
    bf16_t* Vs = Ks + 128 * KP;
    float* gvs_ = (float*)(Vs + 64 * VP);
    for (int u = bidx; u < NB * MH * NCH; u += gdim) {
        const int tc = u % NCH, h = (u / NCH) % MH, b = u / (NCH * MH);
        const int tok0 = b * S + tc * CH, it = wave * 16 + col;
        __syncthreads();
        {
            u32x4 kb_[2], vb_[2];
#pragma unroll
            for (int q = 0; q < 2; ++q) {
                const int idx = tid + q * NTHREADS;
                kb_[q] = *(const u32x4*)(MKB + (size_t)(tok0 + (idx >> 3)) * MW + h * 64 + (idx & 7) * 8);
                vb_[q] = *(const u32x4*)(VT + ((size_t)(b * MH + h) * 64 + (idx >> 4)) * S + (size_t)tc * CH + (idx & 15) * 8);
            }
            float gq_ = 0.f;
            if (tid < 256) gq_ = GVT[((size_t)(tid >> 7) * T + tok0 + (tid & 127)) * MH + h];
#pragma unroll
            for (int q = 0; q < 2; ++q) {
                const int idx = tid + q * NTHREADS;
                *(u32x4*)(Ks + (idx >> 3) * KP + (idx & 7) * 8) = kb_[q];
                *(u32x4*)(Vs + (idx >> 4) * VP + (idx & 15) * 8) = vb_[q];
            }
            if (tid < 256) gvs_[tid] = gq_;
        }
        __syncthreads();
        const size_t trow = (size_t)(tok0 + it);
        bf16x8 bq[2];
#pragma unroll
        for (int ks = 0; ks < 2; ++ks) bq[ks] = *(const bf16x8*)(MQB + trow * MW + h * 64 + ks * 32 + 8 * g);
        f32x4 hs[4];
#pragma unroll
        for (int et = 0; et < 4; ++et) hs[et] = (f32x4){0.f, 0.f, 0.f, 0.f};
#pragma unroll
        for (int d = 0; d < 2; ++d) {
            const int cd = d ? NCH - 1 - tc : tc;
            const int su = ((d * NB + b) * MH + h) * NCH + cd;
            const size_t gt = ((size_t)d * T + trow) * MH + h;
            const float mst = MIN[su];
            const float mxt = fmaxf(PMX[gt], mst), mt = BCT[gt] + mxt, wint = fexp(mst - mxt);
            f32x4 num[4];
#pragma unroll
            for (int et = 0; et < 4; ++et) num[et] = (f32x4){0.f, 0.f, 0.f, 0.f};
            float den = 0.f;
            for (int sp = 0; sp < 4; ++sp) {
                if (d == 0 ? (2 * sp > wave) : (2 * sp + 1 < wave)) continue;
                float pw[8];
#pragma unroll
                for (int hf = 0; hf < 2; ++hf) {
                    const int st = 2 * sp + hf;
                    f32x4 sacc = (f32x4){0.f, 0.f, 0.f, 0.f};
#pragma unroll
                    for (int ks = 0; ks < 2; ++ks) sacc = MFMA16(*(const bf16x8*)(Ks + (st * 16 + col) * KP + ks * 32 + 8 * g), bq[ks], sacc);
                    const f32x4 g4 = *(const f32x4*)(gvs_ + d * 128 + st * 16 + 4 * g);
#pragma unroll
                    for (int r = 0; r < 4; ++r) {
                        const int is = st * 16 + 4 * g + r;
                        const bool ok = d == 0 ? (is <= it) : (is >= it);
                        const float pr = ok ? sacc[r] * fexp(g4[r] - mxt) : 0.f;
                        den += pr; pw[hf * 4 + r] = pr;
                    }
                }
                u32x4 pb; pb.x = pk2(pw[0], pw[1]); pb.y = pk2(pw[2], pw[3]); pb.z = pk2(pw[4], pw[5]); pb.w = pk2(pw[6], pw[7]);
                const bf16x8 bp = __builtin_bit_cast(bf16x8, pb);
#pragma unroll
                for (int et = 0; et < 4; ++et) {
                    const bf16_t* vp = Vs + (et * 16 + col) * VP + sp * 32 + 4 * g;
                    const u32x2 v0 = *(const u32x2*)vp, v1 = *(const u32x2*)(vp + 16);
                    u32x4 va; va.x = v0.x; va.y = v0.y; va.z = v1.x; va.w = v1.y;
                    num[et] = MFMA16(__builtin_bit_cast(bf16x8, va), bp, num[et]);
                }
            }
            den += SHX(den, 16, lane); den += SHX(den, 32, lane);
            f32x4 qc[4]; float qn = 0.f;
#pragma unroll
            for (int ks = 0; ks < 2; ++ks) {
                const float* np = NLb + (size_t)su * 64 + ks * 32 + 8 * g;
                const f32x4 n0 = *(const f32x4*)np, n1 = *(const f32x4*)(np + 4);
                const u32x4 qb = __builtin_bit_cast(u32x4, bq[ks]);
                qn += (bf_lo(qb.x) * n0.x + bf_hi(qb.x) * n0.y) + (bf_lo(qb.y) * n0.z + bf_hi(qb.y) * n0.w) + (bf_lo(qb.z) * n1.x + bf_hi(qb.z) * n1.y) + (bf_lo(qb.w) * n1.z + bf_hi(qb.w) * n1.w);
            }
            qn += SHX(qn, 16, lane); qn += SHX(qn, 32, lane);
#pragma unroll
            for (int et = 0; et < 4; ++et) {
                qc[et] = (f32x4){0.f, 0.f, 0.f, 0.f};
#pragma unroll
                for (int ks = 0; ks < 2; ++ks) {
                    const float* cp = CL + (size_t)su * 4096 + (size_t)(et * 16 + col) * 64 + ks * 32 + 8 * g;
                    qc[et] = MFMA16(cvt8(*(const f32x4*)cp, *(const f32x4*)(cp + 4)), bq[ks], qc[et]);
                }
            }
            const float dd = frcp(fmaxf(fabsf(den + wint * qn), fexp(-mt)));
#pragma unroll
            for (int et = 0; et < 4; ++et) hs[et] += (num[et] + wint * qc[et]) * dd;
        }
        float sm = 0.f;
#pragma unroll
        for (int et = 0; et < 4; ++et) sm += (hs[et].x + hs[et].y) + (hs[et].z + hs[et].w);
        sm += SHX(sm, 16, lane); sm += SHX(sm, 32, lane);
        const float mean = sm * (1.0f / 64.0f); float q = 0.f;
#pragma unroll
        for (int et = 0; et < 4; ++et) { const f32x4 dl = hs[et] - mean; q += (dl.x * dl.x + dl.y * dl.y) + (dl.z * dl.z + dl.w * dl.w); }
        q += SHX(q, 16, lane); q += SHX(q, 32, lane);
        const float rstd = 1.0f / sqrtf(q * (1.0f / 64.0f) + LN_EPS);
#pragma unroll
        for (int et = 0; et < 4; ++et) {
            const int c = h * 64 + et * 16 + 4 * g;
            const u32x2 ob_ = *(const u32x2*)(proj + trow * PLD + C_MW + 3 * MW + c); const f32x4 o4 = (f32x4){bf_lo(ob_.x), bf_hi(ob_.x), bf_lo(ob_.y), bf_hi(ob_.y)}, g4 = *(const f32x4*)(mln_g + c);
            const f32x4 y = (hs[et] - mean) * rstd * g4;
            u32x2 ob; ob.x = pk2(sigmoidf_(o4.x) * y.x, sigmoidf_(o4.y) * y.y); ob.y = pk2(sigmoidf_(o4.z) * y.z, sigmoidf_(o4.w) * y.w);
            *(u32x2*)(GRP + trow * D + GW + RW + c) = ob;
        }
    }
    __syncthreads();
}

__device__ __forceinline__ void phase_rwkv_post(const Params& P, int l, unsigned char* smem, int wv) {
    ParamsPtr pp = PARAMS_PTR(P); PIN_S(pp); unsigned char* ws = pp->ws; int bidx = (int)blockIdx.x, gdim = (int)gridDim.x; PIN_S(bidx); PIN_S(gdim);
    const float* SCAN = (const float*)(ws + O_SCAN); const float* VV = (const float*)(ws + O_VV); const float* GATE = (const float*)(ws + O_GATE);
    const float* BONUS = (const float*)(ws + O_BONUS); bf16_t* GRP = (bf16_t*)(ws + O_GRP);
    const float* rln_g = pp->in[15] + (size_t)l * RW; const float* rln_b = pp->in[16] + (size_t)l * RW;
    const int tid = phase_tid(wv), lane = tid & 63, wave = tid >> 6;
    const int gw = bidx * NWAVES + wave, ngw = NWAVES * gdim;
    for (int it = gw; it < T * RH; it += ngw) {
        const int t = it / RH, h = it % RH, c = h * 64 + lane;
        const size_t o = (size_t)t * RW + c;
        const float x = SCAN[o] + SCAN[(size_t)T * RW + o];
        const float mean = wave_sum(x, lane) * (1.0f / 64.0f);
        const float dl = x - mean;
        const float var = wave_sum(dl * dl, lane) * (1.0f / 64.0f);
        float y = dl / sqrtf(var + GN_EPS) * rln_g[c] + rln_b[c];
        y += BONUS[(size_t)t * RH + h] * VV[o];
        GRP[(size_t)t * D + GW + c] = (bf16_t)f2bf(y * GATE[o]);
    }
}

__device__ __forceinline__ void phase_ln1_router(const Params& P, int l, unsigned char* smem, int wv) {
    ParamsPtr pp = PARAMS_PTR(P); PIN_S(pp); unsigned char* ws = pp->ws; int bidx = (int)blockIdx.x, gdim = (int)gridDim.x; PIN_S(bidx); PIN_S(gdim);
    const float* xin = l == 0 ? pp->in[0] : (const float*)(ws + O_XA);
    const bf16_t* MIX = (const bf16_t*)(ws + O_MIX); float* X1 = (float*)(ws + O_X1);
    int* TOPI = (int*)(ws + O_TOPI); float* TOPG = (float*)(ws + O_TOPG); int* RANK = (int*)(ws + O_RANK); bf16_t* X1B = (bf16_t*)(ws + O_X1B);
    int* BCNT = (int*)(ws + O_BCNT);
    const float* g1 = pp->in[22] + (size_t)l * D; const float* b1 = pp->in[23] + (size_t)l * D;
    const float* rw = pp->in[24] + (size_t)l * D * NE; const float* rb = pp->in[25] + (size_t)l * NE;
    const bf16_t* RWT = (const bf16_t*)(ws + O_RWT) + (size_t)l * 2 * NE * D;
    const int tid = phase_tid(wv), lane = tid & 63, wave = tid >> 6, col = lane & 15, g = lane >> 4;
    float* lgs = (float*)smem;
    int* stopi = (int*)(smem + 8192);
    for (int tile = bidx; tile < T / 64; tile += gdim) {
        __syncthreads();
        {
            f32x4 xa[4]; u32x2 xm[4];
#define LN1_LOAD(tt_) do { _Pragma("unroll") for (int j = 0; j < 4; ++j) { const int c = j * 256 + lane * 4; xa[j] = *(const f32x4*)(xin + (size_t)(tt_) * D + c); xm[j] = *(const u32x2*)(MIX + (size_t)(tt_) * D + c); } } while (0)
            LN1_LOAD(tile * 64 + wave * 8);
#pragma unroll 1
            for (int ti8 = 0; ti8 < 8; ++ti8) {
                const int t = tile * 64 + wave * 8 + ti8;
                float v[16]; float sm = 0.f;
#pragma unroll
                for (int j = 0; j < 4; ++j) {
                    v[j * 4 + 0] = ALPHA * xa[j].x + bf_lo(xm[j].x); v[j * 4 + 1] = ALPHA * xa[j].y + bf_hi(xm[j].x); v[j * 4 + 2] = ALPHA * xa[j].z + bf_lo(xm[j].y); v[j * 4 + 3] = ALPHA * xa[j].w + bf_hi(xm[j].y);
                    sm += (v[j * 4] + v[j * 4 + 1]) + (v[j * 4 + 2] + v[j * 4 + 3]);
                }
                if (ti8 < 7) LN1_LOAD(t + 1);
                const float mean = wave_sum_fast(sm, lane) * (1.0f / D); float q = 0.f;
#pragma unroll
                for (int j = 0; j < 16; ++j) { const float dl = v[j] - mean; q += dl * dl; }
                const float rstd = 1.0f / sqrtf(wave_sum_fast(q, lane) * (1.0f / D) + LN_EPS);
#pragma unroll
                for (int j = 0; j < 4; ++j) {
                    const int c = j * 256 + lane * 4;
                    const f32x4 gg = *(const f32x4*)(g1 + c), bb = *(const f32x4*)(b1 + c);
                    f32x4 o;
                    o.x = (v[j * 4 + 0] - mean) * rstd * gg.x + bb.x; o.y = (v[j * 4 + 1] - mean) * rstd * gg.y + bb.y;
                    o.z = (v[j * 4 + 2] - mean) * rstd * gg.z + bb.z; o.w = (v[j * 4 + 3] - mean) * rstd * gg.w + bb.w;
                    *(f32x4*)(X1 + (size_t)t * D + c) = o;
                    u32x2 ob; ob.x = pk2(o.x, o.y); ob.y = pk2(o.z, o.w); *(u32x2*)(X1B + (size_t)t * D + c) = ob;
                }
            }
#undef LN1_LOAD
        }
        __syncthreads();
        {
            const float* xr = X1 + (size_t)(tile * 64 + (wave >> 1) * 16 + col) * D + 8 * g;
            const bf16_t* wh = RWT + (size_t)((wave & 1) * 16 + col) * D + 8 * g; const bf16_t* wl = wh + (size_t)NE * D;
            f32x4 acc = (f32x4){0.f, 0.f, 0.f, 0.f};
#pragma unroll 4
            for (int ks = 0; ks < 32; ++ks) {
                const f32x4 x0 = *(const f32x4*)(xr + ks * 32), x1 = *(const f32x4*)(xr + ks * 32 + 4);
                const bf16x8 bh = *(const bf16x8*)(wh + ks * 32), bl = *(const bf16x8*)(wl + ks * 32);
                const bf16x8 ah = cvt8(x0, x1);
                const u32x4 ahu = __builtin_bit_cast(u32x4, ah);
                f32x4 r0, r1;
                r0.x = x0.x - bf_lo(ahu.x); r0.y = x0.y - bf_hi(ahu.x); r0.z = x0.z - bf_lo(ahu.y); r0.w = x0.w - bf_hi(ahu.y);
                r1.x = x1.x - bf_lo(ahu.z); r1.y = x1.y - bf_hi(ahu.z); r1.z = x1.z - bf_lo(ahu.w); r1.w = x1.w - bf_hi(ahu.w);
                const bf16x8 al = cvt8(r0, r1);
                acc = MFMA16(ah, bh, acc); acc = MFMA16(ah, bl, acc); acc = MFMA16(al, bh, acc);
            }
            const float rbv = rb[(wave & 1) * 16 + col];
#pragma unroll
            for (int r = 0; r < 4; ++r) lgs[((wave >> 1) * 16 + 4 * g + r) * NE + (wave & 1) * 16 + col] = acc[r] + rbv;
        }
        __syncthreads();
        if (tid < 64) {
            const float* lp = lgs + tid * NE; const int t = tile * 64 + tid;
            float tv[4]; int ti[4];
#pragma unroll
            for (int k = 0; k < 4; ++k) { tv[k] = -INFINITY; ti[k] = 0; }
            for (int e = 0; e < NE; ++e) {
                const float x = lp[e];
                if (x > tv[3]) {
                    if (x > tv[0]) { tv[3] = tv[2]; ti[3] = ti[2]; tv[2] = tv[1]; ti[2] = ti[1]; tv[1] = tv[0]; ti[1] = ti[0]; tv[0] = x; ti[0] = e; }
                    else if (x > tv[1]) { tv[3] = tv[2]; ti[3] = ti[2]; tv[2] = tv[1]; ti[2] = ti[1]; tv[1] = x; ti[1] = e; }
                    else if (x > tv[2]) { tv[3] = tv[2]; ti[3] = ti[2]; tv[2] = x; ti[2] = e; }
                    else { tv[3] = x; ti[3] = e; }
                }
            }
            const float e1 = expf(tv[1] - tv[0]), e2 = expf(tv[2] - tv[0]), e3 = expf(tv[3] - tv[0]);
            const float inv = 1.0f / (1.0f + e1 + e2 + e3);
            *(f32x4*)(TOPG + (size_t)t * 4) = (f32x4){inv, e1 * inv, e2 * inv, e3 * inv};
#pragma unroll
            for (int k = 0; k < 4; ++k) { TOPI[(size_t)t * 4 + k] = ti[k]; stopi[tid * 4 + k] = ti[k]; }
        }
        __syncthreads();
        if (tid < 256) { const int e = stopi[tid]; int r = 0; for (int a2 = 0; a2 < tid; ++a2) r += (stopi[a2] == e) ? 1 : 0; RANK[(size_t)tile * 256 + tid] = r; }
        else if (tid < 256 + NE) { const int e = tid - 256; int cnt = 0; for (int a2 = 0; a2 < 256; ++a2) cnt += (stopi[a2] == e) ? 1 : 0; BCNT[tile * NE + e] = cnt; }
    }
    __syncthreads();
}

__device__ __forceinline__ void moe_offsets(int* sh, const int* CNT, int tid) {
    if (tid == 0) {
        int acc = 0;
        for (int e = 0; e < NE; ++e) { const int c = (int)CNT[e]; sh[e] = c; sh[32 + e] = acc; acc += (c + MOEB - 1) / MOEB * MOEB; sh[64 + e] = acc; }
    }
    __syncthreads();
}
__device__ __forceinline__ int moe_expert_of_row(const int* sh, int r) {
    int e = -1;
    for (int i = 0; i < NE; ++i) if (r >= sh[32 + i] && r < sh[64 + i]) e = i;
    return e;
}

__device__ __forceinline__ void phase_scatter(const Params& P, int l, unsigned char* smem, int wv) {
    ParamsPtr pp = PARAMS_PTR(P); PIN_S(pp); unsigned char* ws = pp->ws; int bidx = (int)blockIdx.x, gdim = (int)gridDim.x; PIN_S(bidx); PIN_S(gdim);
    const int tid = phase_tid(wv);
    const int* TOPI = (const int*)(ws + O_TOPI); const int* RANK = (const int*)(ws + O_RANK); int* SLOT = (int*)(ws + O_SLOT); int* ROWT = (int*)(ws + O_ROWT);
    const int* BCNT = (const int*)(ws + O_BCNT); int* CNTF = (int*)(ws + O_CNTF);
    int* sh = (int*)smem;
    int* part = sh + 96;
    int* tot = part + 512;
    int* base = tot + 32;
    constexpr int NT = T / 64;
    const int e = tid & 31, pt = tid >> 5;
    { int sacc = 0; for (int tl = pt; tl < NT; tl += 16) sacc += BCNT[tl * NE + e]; part[pt * 32 + e] = sacc; }
    __syncthreads();
    if (tid < 32) { int sacc = 0; for (int q = 0; q < 16; ++q) sacc += part[q * 32 + tid]; tot[tid] = sacc; if (bidx == 0) CNTF[tid] = sacc; }
    __syncthreads();
    moe_offsets(sh, tot, tid);
    for (int ee = bidx; ee < NE; ee += gdim)
        for (int r = sh[32 + ee] + sh[ee] + tid; r < sh[64 + ee]; r += NTHREADS) ROWT[r] = 0;
    for (int tile = bidx; tile < NT; tile += gdim) {
        __syncthreads();
        { int sacc = 0; for (int tl = pt; tl < tile; tl += 16) sacc += BCNT[tl * NE + e]; part[pt * 32 + e] = sacc; }
        __syncthreads();
        if (tid < 32) { int sacc = sh[32 + tid]; for (int q = 0; q < 16; ++q) sacc += part[q * 32 + tid]; base[tid] = sacc; }
        __syncthreads();
        if (tid < 256) { const int a = tile * 256 + tid, dest = base[TOPI[a]] + RANK[a]; SLOT[a] = dest; ROWT[dest] = a >> 2; }
    }
    __syncthreads();
}

template <int WHICH>
__device__ __forceinline__ void phase_moe_gemm(const Params& P, int l, unsigned char* smem, int wv) {
    ParamsPtr pp = PARAMS_PTR(P); PIN_S(pp); unsigned char* ws = pp->ws; int bidx = (int)blockIdx.x, gdim = (int)gridDim.x; PIN_S(bidx); PIN_S(gdim);
    const int tid = phase_tid(wv);
    const int* CNT = (const int*)(ws + O_CNTF);
    int* sh = (int*)(smem + 131072);
    int* rbe = sh + 96;
    moe_offsets(sh, CNT, tid);
    const int nrb = sh[64 + NE - 1] / MOEB;
    for (int rb = tid; rb < nrb; rb += NTHREADS) rbe[rb] = moe_expert_of_row(sh, rb * MOEB);
    __syncthreads();
    pg8::MoeOrderT<WHICH == 1> S;
    S.K = 1024; S.G_ = gdim; S.c = bidx; S.rbe = rbe; S.rowmap = (const int*)(ws + O_ROWT);
    if (WHICH == 1) {
        S.A = (const char*)(ws + O_X1B); S.Wt = (const char*)(ws + O_W1) + (size_t)l * NE * 2 * DFF * D * 2; S.estride = (size_t)2 * DFF * D * 2; S.nN = 2 * DFF / 256; S.nwg = nrb * S.nN;
        pg8::EpiSwiglu E{(bf16_t*)(ws + O_ACT), pp->in[27] + (size_t)l * NE * 2 * DFF};
        pg8::gemm_phase<pg8::EpiSwiglu, pg8::MoeOrderT<WHICH == 1>>((LAS unsigned char*)smem, 1024, S, E, tid);
    } else {
        S.A = (const char*)(ws + O_ACT); S.Wt = (const char*)(ws + O_W2) + (size_t)l * NE * D * DFF * 2; S.estride = (size_t)D * DFF * 2; S.nN = D / 256; S.nwg = nrb * S.nN;
        pg8::EpiBf16Bias E{(bf16_t*)(ws + O_YS), D, pp->in[29] + (size_t)l * NE * D, D};
        pg8::gemm_phase<pg8::EpiBf16Bias, pg8::MoeOrderT<WHICH == 1>>((LAS unsigned char*)smem, 1024, S, E, tid);
    }
    __syncthreads();
}

__device__ __forceinline__ void phase_combine_ln2(const Params& P, int l, unsigned char* smem, int wv) {
    ParamsPtr pp = PARAMS_PTR(P); PIN_S(pp); unsigned char* ws = pp->ws; int bidx = (int)blockIdx.x, gdim = (int)gridDim.x; PIN_S(bidx); PIN_S(gdim);
    const float* X1 = (const float*)(ws + O_X1); const bf16_t* YS = (const bf16_t*)(ws + O_YS); bf16_t* XB = (bf16_t*)(ws + O_XB);
    const int* SLOT = (const int*)(ws + O_SLOT); const float* TOPG = (const float*)(ws + O_TOPG);
    float* xo = l == NL - 1 ? pp->out : (float*)(ws + O_XA);
    const float* g2 = pp->in[30] + (size_t)l * D; const float* b2 = pp->in[31] + (size_t)l * D;
    const int tid = phase_tid(wv), lane = tid & 63, wave = tid >> 6;
    const int gw = bidx * NWAVES + wave, ngw = NWAVES * gdim;
    u32x4 sl_n = (u32x4){0u, 0u, 0u, 0u}; f32x4 gg_n = (f32x4){0.f, 0.f, 0.f, 0.f};
    f32x4 xa_n[4]; u32x2 ys_n[4][4]; f32x4 gg_c = (f32x4){0.f, 0.f, 0.f, 0.f};
    const f32x4 lg[4] = {*(const f32x4*)(g2 + lane * 4), *(const f32x4*)(g2 + 256 + lane * 4), *(const f32x4*)(g2 + 512 + lane * 4), *(const f32x4*)(g2 + 768 + lane * 4)};
    const f32x4 lb[4] = {*(const f32x4*)(b2 + lane * 4), *(const f32x4*)(b2 + 256 + lane * 4), *(const f32x4*)(b2 + 512 + lane * 4), *(const f32x4*)(b2 + 768 + lane * 4)};
#define CB_META(tt_) do { sl_n = *(const u32x4*)(SLOT + (size_t)(tt_) * 4); gg_n = *(const f32x4*)(TOPG + (size_t)(tt_) * 4); } while (0)
#define CB_ROWS(tt_) do { _Pragma("unroll") for (int j = 0; j < 4; ++j) { const int c = j * 256 + lane * 4; xa_n[j] = *(const f32x4*)(X1 + (size_t)(tt_) * D + c); \
        ys_n[0][j] = *(const u32x2*)(YS + (size_t)sl_n.x * D + c); ys_n[1][j] = *(const u32x2*)(YS + (size_t)sl_n.y * D + c); ys_n[2][j] = *(const u32x2*)(YS + (size_t)sl_n.z * D + c); ys_n[3][j] = *(const u32x2*)(YS + (size_t)sl_n.w * D + c); } gg_c = gg_n; } while (0)
    if (gw < T) { CB_META(gw); CB_ROWS(gw); if (gw + ngw < T) CB_META(gw + ngw); }
    for (int t = gw; t < T; t += ngw) {
        float v[16]; float sm = 0.f;
        const float gk[4] = {gg_c.x, gg_c.y, gg_c.z, gg_c.w};
#pragma unroll
        for (int j = 0; j < 4; ++j) {
            const f32x4 a = xa_n[j];
            f32x4 y = (f32x4){0.f, 0.f, 0.f, 0.f};
#pragma unroll
            for (int k = 0; k < 4; ++k) { const u32x2 yk = ys_n[k][j]; y.x += gk[k] * bf_lo(yk.x); y.y += gk[k] * bf_hi(yk.x); y.z += gk[k] * bf_lo(yk.y); y.w += gk[k] * bf_hi(yk.y); }
            v[j * 4 + 0] = ALPHA * a.x + y.x; v[j * 4 + 1] = ALPHA * a.y + y.y; v[j * 4 + 2] = ALPHA * a.z + y.z; v[j * 4 + 3] = ALPHA * a.w + y.w;
            sm += (v[j * 4] + v[j * 4 + 1]) + (v[j * 4 + 2] + v[j * 4 + 3]);
        }
        if (t + ngw < T) { CB_ROWS(t + ngw); if (t + 2 * ngw < T) CB_META(t + 2 * ngw); }
        const float mean = wave_sum_fast(sm, lane) * (1.0f / D); float q = 0.f;
#pragma unroll
        for (int j = 0; j < 16; ++j) { const float dl = v[j] - mean; q += dl * dl; }
        const float rstd = 1.0f / sqrtf(wave_sum_fast(q, lane) * (1.0f / D) + LN_EPS);
#pragma unroll
        for (int j = 0; j < 4; ++j) {
            const int c = j * 256 + lane * 4;
            f32x4 o;
            o.x = (v[j * 4 + 0] - mean) * rstd * lg[j].x + lb[j].x; o.y = (v[j * 4 + 1] - mean) * rstd * lg[j].y + lb[j].y;
            o.z = (v[j * 4 + 2] - mean) * rstd * lg[j].z + lb[j].z; o.w = (v[j * 4 + 3] - mean) * rstd * lg[j].w + lb[j].w;
            *(f32x4*)(xo + (size_t)t * D + c) = o;
            if (l != NL - 1) { u32x2 ob; ob.x = pk2(o.x, o.y); ob.y = pk2(o.z, o.w); *(u32x2*)(XB + (size_t)t * D + c) = ob; }
        }
    }
#undef CB_META
#undef CB_ROWS
}

__device__ __forceinline__ void phase_inproj(const Params& P, int l, unsigned char* smem, int wv) {
    ParamsPtr pp = PARAMS_PTR(P); PIN_S(pp); unsigned char* ws = pp->ws; int bidx = (int)blockIdx.x, gdim = (int)gridDim.x; PIN_S(bidx); PIN_S(gdim);
    const int tid = phase_tid(wv);
    pg8::DenseOrder S; S.init(ws + O_XB, (const bf16_t*)(ws + O_WIN) + (size_t)l * PLD * D, T, PLD, D, gdim, bidx);
    pg8::EpiProj E{(bf16_t*)(ws + O_PROJ), PLD, (float*)(ws + O_PROJG), PLD / 256 - 1};
    pg8::gemm_phase<pg8::EpiProj, pg8::DenseOrder>((LAS unsigned char*)smem, D, S, E, tid);
    __syncthreads();
}
__device__ __forceinline__ void phase_outproj(const Params& P, int l, unsigned char* smem, int wv) {
    ParamsPtr pp = PARAMS_PTR(P); PIN_S(pp); unsigned char* ws = pp->ws; int bidx = (int)blockIdx.x, gdim = (int)gridDim.x; PIN_S(bidx); PIN_S(gdim);
    const int tid = phase_tid(wv);
    pg8::DenseOrder S; S.init(ws + O_GRP, (const bf16_t*)(ws + O_WOUT) + (size_t)l * D * D, T, D, D, gdim, bidx);
    pg8::EpiProj E{(bf16_t*)(ws + O_MIX), D, nullptr, -1};
    pg8::gemm_phase<pg8::EpiProj, pg8::DenseOrder>((LAS unsigned char*)smem, D, S, E, tid);
    __syncthreads();
}

#ifndef EMU
#define XB_TMO      128
#define XB_XCNT(j)  (256  + 64 * (j))
#define XB_XSUB(j)  (1280 + 64 * (j))
#define XB_XGEN(j)  (2304 + 64 * (j))
#define XB_TOP      3328
#define XB_TOPGEN   3392
#define XCD_BAR_WORDS 3456
#define XB_SPIN_CAP (1u << 25)
__device__ __forceinline__ unsigned xb_ld(unsigned* p)              { return __hip_atomic_load(p, __ATOMIC_RELAXED, __HIP_MEMORY_SCOPE_AGENT); }
__device__ __forceinline__ unsigned xb_add(unsigned* p, unsigned v) { return __hip_atomic_fetch_add(p, v, __ATOMIC_RELAXED, __HIP_MEMORY_SCOPE_AGENT); }
__device__ __forceinline__ unsigned xb_xcc_id() { return (unsigned)__builtin_amdgcn_s_getreg((3 << 11) | 20) & 0xFu; }
#define XB_SPIN(cond, bar) do { unsigned _sp = 0; while (cond) { __builtin_amdgcn_s_sleep(1); \
    if ((++_sp & 255u) == 0u) { if (xb_ld(&(bar)[XB_TMO])) break; if (_sp > XB_SPIN_CAP) { atomicAdd(&(bar)[XB_TMO], 1u); break; } } } } while (0)
struct XcdBarrier { unsigned* bar; unsigned x; volatile LAS unsigned* st; };
__device__ __forceinline__ XcdBarrier xcd_barrier_post(unsigned* bar, volatile LAS unsigned* st) {
    XcdBarrier b; b.bar = bar; b.x = xb_xcc_id(); b.st = st;
    if (threadIdx.x == 0) (void)xb_add(&bar[XB_XCNT(b.x)], 1u);
    return b;
}
__device__ __forceinline__ void xcd_barrier_complete(unsigned* bar, unsigned x, unsigned& nloc, unsigned& nx) {
    const unsigned G = gridDim.x * gridDim.y * gridDim.z;
    unsigned sum, cnt, mine, sp = 0u;
    for (;;) {
        sum = 0u; cnt = 0u; mine = 0u;
#pragma unroll
        for (unsigned j = 0; j < 16; ++j) { const unsigned c = xb_ld(&bar[XB_XCNT(j)]); sum += c; cnt += (c > 0u) ? 1u : 0u; mine = (j == x) ? c : mine; }
        if (sum == G) break;
        __builtin_amdgcn_s_sleep(1);
        if ((++sp & 255u) == 0u) { if (xb_ld(&bar[XB_TMO])) break; if (sp > XB_SPIN_CAP) { atomicAdd(&bar[XB_TMO], 1u); break; } }
    }
    nloc = mine > 0u ? mine : 1u; nx = cnt > 0u ? cnt : 1u;
}
__device__ __forceinline__ void xcd_barrier(const XcdBarrier& b) {
    asm volatile("s_waitcnt vmcnt(0)" ::: "memory");
    __syncthreads();
    if (threadIdx.x == 0) {
        unsigned* bar = b.bar;
        __builtin_amdgcn_s_waitcnt(0);
        unsigned nloc = b.st[0], nx = b.st[1];
        if (nloc == 0u) { xcd_barrier_complete(bar, b.x, nloc, nx); b.st[0] = nloc; b.st[1] = nx; }
        const unsigned old = xb_add(&bar[XB_XSUB(b.x)], 1u);
        const unsigned gen = old / nloc;
        if (old + 1u == (gen + 1u) * nloc) {
            __builtin_amdgcn_fence(__ATOMIC_RELEASE, "agent");
            asm volatile("s_waitcnt vmcnt(0)" ::: "memory");
            const unsigned og = xb_add(&bar[XB_TOP], 1u);
            const unsigned tg = og / nx;
            if (og + 1u == (tg + 1u) * nx) xb_add(&bar[XB_TOPGEN], 1u);
            else XB_SPIN(xb_ld(&bar[XB_TOPGEN]) == tg, bar);
            __builtin_amdgcn_fence(__ATOMIC_ACQUIRE, "agent");
            xb_add(&bar[XB_XGEN(b.x)], 1u);
            asm volatile("s_waitcnt vmcnt(0)" ::: "memory");
        } else {
            XB_SPIN(xb_ld(&bar[XB_XGEN(b.x)]) == gen, bar);
            __builtin_amdgcn_fence(__ATOMIC_ACQUIRE, "agent");
            asm volatile("s_waitcnt vmcnt(0)" ::: "memory");
        }
    }
    __syncthreads();
}
#endif

__global__ void __launch_bounds__(512, 2) mk_fwd(Params P) {
#ifdef EMU
    unsigned char* smem = g_blk->lds;
#else
    extern __shared__ __attribute__((aligned(16))) unsigned char smem[];
    volatile LAS unsigned* bst = (volatile LAS unsigned*)(smem + LDS_BYTES - 16);
    if (threadIdx.x == 0) { bst[0] = 0u; bst[1] = 0u; bst[2] = 0u; bst[3] = 0u; }
    __syncthreads();
    XcdBarrier bar; bar.bar = (unsigned*)P.ws + CW_BAR; bar.x = 0; bar.st = bst;
    if (P.ph_hi - P.ph_lo > 1) bar = xcd_barrier_post((unsigned*)P.ws + CW_BAR, bst);
#endif
    const int lo = P.ph_lo, hi = P.ph_hi;
#ifdef EMU
    const int wv = (int)threadIdx.x >> 6;
#else
    const int wv = RFL((int)threadIdx.x >> 6);
#endif
#ifdef EMU
#define SEAM(id) do {} while (0)
#else
#define SEAM(id) do { if ((id) + 1 < hi) xcd_barrier(bar); } while (0)
#endif
#ifndef MK_ONLY_PHASE
#define MK_ONLY_PHASE -1
#endif
#ifndef MK_DUP_MASK
#define MK_DUP_MASK 0
#endif
#define PHG(kc, id, ...) do { if (MK_ONLY_PHASE < 0 || MK_ONLY_PHASE == (kc)) { const int id_ = (id); if (id_ >= lo && id_ < hi) { if ((MK_DUP_MASK >> (kc)) & 1) { __VA_ARGS__; SEAM(id_ - 1); } __VA_ARGS__; SEAM(id_); } } } while (0)
#define PH(k, ...) PHG(1 + (k), 1 + l * NPH + (k), __VA_ARGS__)
    PHG(0, 0, phase_prologue(P, smem, wv));
    for (int l = 0; l < NL; ++l) {
        PH(0, phase_inproj(P, l, smem, wv));
#if MK_RWKV_CHUNKED
        PH(1, phase_prep32(P, l, smem, wv));
#else
        PH(1, phase_prep(P, l, smem, wv));
#endif
#if MK_RWKV_CHUNKED
        PH(2, { phase_rwkv_pre(P, l, smem, wv); phase_mlstm_local(P, l, smem, wv, (int)blockIdx.x, (int)gridDim.x); });
        PH(3, { phase_rwkv_seq(P, l, smem, wv); phase_mlstm_carry(P, l, smem, wv); });
        PH(4, { phase_rwkv_out(P, l, smem, wv); phase_mlstm_out(P, l, smem, wv); phase_gmlp_mix(P, l, smem, wv, (int)blockIdx.x, (int)gridDim.x); });
#else
        PH(2, { const int G_ = (int)gridDim.x, NSC = 2 * NB * RH * 4;
                if (G_ >= NSC + 32) { if ((int)blockIdx.x < NSC) phase_rwkv_scan(P, l, smem, wv, (int)blockIdx.x, NSC);
                                      else phase_mlstm_local(P, l, smem, wv, (int)blockIdx.x - NSC, G_ - NSC); }
                else { phase_rwkv_scan(P, l, smem, wv, (int)blockIdx.x, G_); phase_mlstm_local(P, l, smem, wv, (int)blockIdx.x, G_); } });
        PH(3, phase_mlstm_carry(P, l, smem, wv));
        PH(4, { phase_mlstm_out(P, l, smem, wv); phase_gmlp_mix(P, l, smem, wv, (int)blockIdx.x, (int)gridDim.x); phase_rwkv_post(P, l, smem, wv); });
#endif
        PH(5, phase_outproj(P, l, smem, wv));
        PH(6, phase_ln1_router(P, l, smem, wv));
        PH(7, phase_scatter(P, l, smem, wv));
        PH(8, phase_moe_gemm<1>(P, l, smem, wv));
        PH(9, phase_moe_gemm<2>(P, l, smem, wv));
        PH(10, phase_combine_ln2(P, l, smem, wv));
    }
#undef PHG
#undef PH
#undef SEAM
}

}

#ifndef EMU
extern "C" void kernel_launch(void* const* d_in, const int* in_sizes, int n_in, void* d_out, int out_size, void* d_ws, size_t ws_size, hipStream_t stream) {
    using namespace mk;
    static int grid = 0;
    if (grid == 0) {
        if (n_in != 32 || out_size != T * D || ws_size < WS_END) { fprintf(stderr, "kernel_launch: unexpected shapes (n_in %d out %d ws %zu need %zu)\n", n_in, out_size, ws_size, (size_t)WS_END); grid = -1; return; }
        int dev = 0, cus = 0;
        if (hipGetDevice(&dev) != hipSuccess || hipDeviceGetAttribute(&cus, hipDeviceAttributeMultiprocessorCount, dev) != hipSuccess) { grid = -1; return; }
        if (hipFuncSetAttribute((const void*)mk_fwd, hipFuncAttributeMaxDynamicSharedMemorySize, LDS_BYTES) != hipSuccess) { fprintf(stderr, "kernel_launch: hipFuncSetAttribute failed\n"); grid = -1; return; }
        int per_cu = 0;
        (void)hipOccupancyMaxActiveBlocksPerMultiprocessor(&per_cu, (const void*)mk_fwd, NTHREADS, LDS_BYTES);
        (void)hipGetLastError();
        grid = cus;
    }
    if (grid < 0) return;
    (void)hipMemsetAsync(d_ws, 0, CTL_BYTES, stream);
    Params p{};
    for (int i = 0; i < 32; ++i) p.in[i] = (const float*)d_in[i];
    p.out = (float*)d_out; p.ws = (unsigned char*)d_ws;
#if MK_ONE_LAUNCH
    p.ph_lo = 0; p.ph_hi = 1 + NL * NPH;
    hipLaunchKernelGGL(mk_fwd, dim3(grid), dim3(NTHREADS), LDS_BYTES, stream, p);
#else
    for (int id = 0; id < 1 + NL * NPH; ++id) {
        p.ph_lo = id; p.ph_hi = id + 1;
        hipLaunchKernelGGL(mk_fwd, dim3(grid), dim3(NTHREADS), LDS_BYTES, stream, p);
    }
#endif
}
#endif
```

```cpp
#ifndef EMU
#include <hip/hip_runtime.h>
#endif
#include <cstdio>
#include <cstdint>
#include <cmath>

#ifndef CFG_BATCH
#define CFG_BATCH 4
#endif
#ifndef CFG_SEQ
#define CFG_SEQ 4096
#endif
#ifndef CFG_LAYERS
#define CFG_LAYERS 4
#endif
#ifndef MK_RWKV_CHUNKED
#define MK_RWKV_CHUNKED 1
#endif
#ifndef MK_PROBE
#define MK_PROBE 0
#endif
#ifndef MK_SP2
#define MK_SP2 1
#endif
#ifndef MK_ONE_LAUNCH
#define MK_ONE_LAUNCH 1
#endif

namespace mk {
constexpr int NB = CFG_BATCH, S = CFG_SEQ, T = NB * S, NL = CFG_LAYERS, D = 1024;
constexpr int GW = 256, RW = 384, MW = 384, HD = 64, GH = 4, RH = 6, MH = 6, CH = 128, NCH = S / CH;
constexpr int PIN = 3480, PLD = 3584, RPROJ = 1408;
constexpr int C_RW = 512, C_MW = 1920;
constexpr int NE = 32, TOPK = 4, DFF = 1024, MOEB = 256;
constexpr int NROWS = (T * TOPK / MOEB + NE) * MOEB;
constexpr float LN_EPS = 1e-5f, GN_EPS = 64e-5f;
constexpr float ALPHA = 1.6817928305074290f;
constexpr int NTHREADS = 512, NWAVES = 8;
constexpr int LDS_BYTES = 160 * 1024;
constexpr int NPH = 11;

typedef float f32x4 __attribute__((ext_vector_type(4)));
typedef unsigned u32x4 __attribute__((ext_vector_type(4)));
typedef unsigned u32x2 __attribute__((ext_vector_type(2)));
typedef short bf16x8 __attribute__((ext_vector_type(8)));
typedef unsigned short bf16_t;

constexpr size_t al(size_t x) { return (x + 255) & ~(size_t)255; }
constexpr size_t CTL_BYTES = 1u << 20;
constexpr size_t O_XA = CTL_BYTES;
constexpr size_t O_XB = O_XA + al((size_t)T * D * 4);
constexpr size_t O_X1 = O_XB + al((size_t)T * D * 2);
constexpr size_t O_X1B = O_X1 + al((size_t)T * D * 4);
constexpr size_t O_PROJ = O_X1B + al((size_t)T * D * 2);
constexpr size_t O_PROJG = O_PROJ + al((size_t)T * PLD * 2);
constexpr size_t O_MIX = O_PROJ + al((size_t)T * PLD * 4);
constexpr size_t O_GRP = O_MIX + al((size_t)T * D * 4);
constexpr size_t O_UG = O_GRP + al((size_t)T * D * 2);
constexpr size_t O_VN = O_UG + al((size_t)T * GW * 4);
constexpr size_t O_RR = O_VN + al((size_t)T * GW * 4);
constexpr size_t O_VV = O_RR + al((size_t)T * RW * 4);
constexpr size_t O_KK = O_VV + al((size_t)T * RW * 4);
constexpr size_t O_DEC = O_KK + al((size_t)T * RW * 4);
constexpr size_t O_KD = O_DEC + al((size_t)2 * T * RW * 4);
constexpr size_t O_ICLR = O_KD + al((size_t)2 * T * RW * 4);
constexpr size_t O_GATE = O_ICLR + al((size_t)2 * T * RW * 4);
constexpr size_t O_BONUS = O_GATE + al((size_t)T * RW * 4);
constexpr size_t O_SCAN = O_BONUS + al((size_t)T * RH * 4);
constexpr size_t O_MQ = O_SCAN + al((size_t)2 * T * RW * 4);
constexpr size_t O_MK = O_MQ + al((size_t)T * MW * 4);
constexpr size_t O_IG = O_MK + al((size_t)T * MW * 4);
constexpr size_t O_LF = O_IG + al((size_t)2 * T * MH * 4);
constexpr size_t O_CL = O_LF + al((size_t)2 * T * MH * 4);
constexpr size_t O_NL = O_CL + al((size_t)2 * NB * MH * NCH * 4096 * 4);
constexpr size_t O_ML = O_NL + al((size_t)2 * NB * MH * NCH * 64 * 4);
constexpr size_t O_BL = O_ML + al((size_t)2 * NB * MH * NCH * 4);
constexpr size_t O_MIN = O_BL + al((size_t)2 * NB * MH * NCH * 4);
constexpr size_t O_TOPI = O_MIN + al((size_t)2 * NB * MH * NCH * 4);
constexpr size_t O_TOPG = O_TOPI + al((size_t)T * 4 * 4);
constexpr size_t O_RANK = O_TOPG + al((size_t)T * 4 * 4);
constexpr size_t O_SLOT = O_RANK + al((size_t)T * 4 * 4);
constexpr size_t O_MQB = O_SLOT + al((size_t)T * 4 * 4);
constexpr size_t O_MKB = O_MQB + al((size_t)T * MW * 2);
constexpr size_t O_KT = O_MKB + al((size_t)T * MW * 2);
constexpr size_t O_VT = O_KT + al((size_t)T * MW * 2);
constexpr size_t O_GVT = O_VT + al((size_t)T * MW * 2);
constexpr size_t O_PMX = O_GVT + al((size_t)2 * T * MH * 4);
constexpr size_t O_BCT = O_PMX + al((size_t)2 * T * MH * 4);
constexpr size_t O_BRKR = O_BCT + al((size_t)2 * T * MH * 4);
constexpr int RC = 64, RNC = S / RC, RUN = 2 * NB * RH * RNC;
constexpr size_t O_LW = O_BRKR + al((size_t)2 * T * RH * 2 * 4);
constexpr size_t O_RQ = O_LW + al((size_t)2 * T * RW * 4);
constexpr size_t O_RA = O_RQ + al((size_t)RUN * 4096 * 2);
constexpr size_t O_RS = O_RA + al((size_t)RUN * 4096 * 2);
constexpr size_t O_RH = O_RS + al((size_t)RUN * 4096 * 2);
constexpr size_t O_RG = O_RH + al((size_t)RUN * 4096 * 4);
constexpr size_t O_RB = O_RG + al((size_t)RUN * 4096 * 4);
constexpr size_t O_VB = O_RB + al((size_t)T * RW * 2);
constexpr size_t O_KKB = O_VB + al((size_t)T * RW * 2);
constexpr size_t O_BBB = O_KKB + al((size_t)T * RW * 2);
constexpr size_t O_KDB = O_BBB + al((size_t)2 * T * RW * 2);
constexpr size_t O_RK7 = O_KDB + al((size_t)2 * T * RW * 2);
constexpr size_t O_VNT = O_RK7 + al((size_t)T * RW * 16);
constexpr size_t O_WSB = O_VNT + al((size_t)T * GW * 2);
constexpr size_t O_LWT = O_WSB + al((size_t)NL * GH * CH * CH * 2);
constexpr size_t O_RWT = O_LWT + al((size_t)NL * 1920 * 128 * 2);
constexpr size_t O_BCNT = O_RWT + al((size_t)NL * 2 * NE * D * 2);
constexpr size_t O_CNTF = O_BCNT + al((size_t)(T / 64) * NE * 4);
constexpr size_t O_ROWT = O_CNTF + al((size_t)NE * 4);
constexpr size_t O_XS = O_ROWT + al((size_t)NROWS * 4);
constexpr size_t O_ACT = O_XS + al((size_t)NROWS * D * 2);
constexpr size_t O_YS = O_ACT + al((size_t)NROWS * DFF * 2);
constexpr size_t O_WIN = O_YS + al((size_t)NROWS * D * 2);
constexpr size_t O_WOUT = O_WIN + al((size_t)NL * PLD * D * 2);
constexpr size_t O_W1 = O_WOUT + al((size_t)NL * D * D * 2);
constexpr size_t O_W2 = O_W1 + al((size_t)NL * NE * 2 * DFF * D * 2);
constexpr size_t WS_END = O_W2 + al((size_t)NL * NE * D * DFF * 2);

constexpr int CW_BAR = 4096;
constexpr int CW_CNT = 16384;

struct Params { const float* in[32]; float* out; unsigned char* ws; int ph_lo, ph_hi; };
#ifdef EMU
typedef const Params* ParamsPtr;
#define PARAMS_PTR(P) (&(P))
#else
typedef const __attribute__((address_space(4))) Params* ParamsPtr;
#define PARAMS_PTR(P) ((ParamsPtr)__builtin_amdgcn_kernarg_segment_ptr())
#endif

#ifdef EMU
#define WAVE_SYNC() emu_wave_barrier()
#define PIN_V(x) do {} while (0)
#define PIN_S(x) do {} while (0)
#else
#define WAVE_SYNC() __builtin_amdgcn_wave_barrier()
#define PIN_V(x) asm volatile("" : "+v"(x))
#define PIN_S(x) asm volatile("" : "+s"(x))
#endif
#ifdef EMU
__device__ __forceinline__ int phase_tid(int wv) { (void)wv; return threadIdx.x; }
#else
__device__ __forceinline__ int phase_tid(int wv) { int t; asm volatile("v_mbcnt_lo_u32_b32 %0, -1, 0\n\tv_mbcnt_hi_u32_b32 %0, -1, %0" : "=v"(t)); return (wv << 6) + t; }
#endif

#ifdef EMU
#define SHX(v, m, lane) __shfl_xor(v, m)
#else
__device__ __forceinline__ float shx_(float v, int m, int lane) { return __builtin_bit_cast(float, __builtin_amdgcn_ds_bpermute((lane ^ m) << 2, __builtin_bit_cast(int, v))); }
__device__ __forceinline__ int shx_(int v, int m, int lane) { return __builtin_amdgcn_ds_bpermute((lane ^ m) << 2, v); }
#define SHX(v, m, lane) shx_(v, m, lane)
#endif
#ifdef EMU
#define SHUP(v, o, lane) __shfl(v, ((lane) - (o)) & 63)
#define RDL(v, src) __shfl(v, src)
#define SHL(v, src) __shfl(v, src)
#else
#define SHL(v, src) __builtin_bit_cast(float, __builtin_amdgcn_ds_bpermute((src) << 2, __builtin_bit_cast(int, (float)(v))))
#define SHUP(v, o, lane) __builtin_bit_cast(float, __builtin_amdgcn_ds_bpermute((((lane) - (o)) & 63) << 2, __builtin_bit_cast(int, (float)(v))))
#define RDL(v, src) __builtin_bit_cast(float, __builtin_amdgcn_readlane(__builtin_bit_cast(int, (float)(v)), src))
#endif
__device__ __forceinline__ float wave_sum(float v, int lane) {
#pragma unroll
    for (int o = 32; o >= 1; o >>= 1) v += SHX(v, o, lane);
    return v;
}
#ifdef EMU
__device__ __forceinline__ float fexp(float x) { return expf(x); }
__device__ __forceinline__ float flog(float x) { return logf(x); }
__device__ __forceinline__ float frcp(float x) { return 1.0f / x; }
#else
__device__ __forceinline__ float fexp(float x) { return __builtin_amdgcn_exp2f(x * 1.4426950408889634f); }
__device__ __forceinline__ float flog(float x) { return __builtin_amdgcn_logf(x) * 0.6931471805599453f; }
__device__ __forceinline__ float frcp(float x) { return __builtin_amdgcn_rcpf(x); }
#endif
__device__ __forceinline__ float sigmoidf_(float x) { return frcp(1.0f + fexp(-x)); }
__device__ __forceinline__ float softplusf_(float x) { return fmaxf(x, 0.f) + flog(1.0f + fexp(-fabsf(x))); }
__device__ __forceinline__ float ftanh(float x) { return 1.0f - 2.0f * frcp(1.0f + fexp(2.0f * x)); }
__device__ __forceinline__ float geluf_(float v) {
    const float av = fabsf(v), t = frcp(1.0f + 0.2316418882f * av);
    float q = t * 0.5307027145f + (-0.7265760135f); q = q * t + 0.7107068705f; q = q * t + (-0.142248368f); q = q * t + 0.127414796f; q = q * t;
    const float m = v * (q * fexp(-0.5f * v * v));
    return v < 0.f ? m : v - m;
}

#ifdef EMU
#define LAS
#define WAIT_V(n) do {} while (0)
#define WAIT_L(n) do {} while (0)
#define S_BARRIER() __syncthreads()
#define SETPRIO(x) do {} while (0)
#define SCHED_BAR() do {} while (0)
#define RFL(x) (x)
static inline void emu_glds16(const void* g, void* l) { memcpy((char*)l + (g_blk->cur & 63) * 16, g, 16); }
#define GLDS16(gptr, ldsptr) emu_glds16((const void*)(gptr), (void*)(ldsptr))
static inline float emu_bf2f(unsigned short b) { unsigned u = (unsigned)b << 16; float f; memcpy(&f, &u, 4); return f; }
static inline f32x4 emu_mfma16(bf16x8 a, bf16x8 b, f32x4 c) {
    EmuBlock* blk = g_blk; const int cur = blk->cur, lane = cur & 63, wbase = cur & ~63;
    static thread_local unsigned short Ash[32][64][8], Bsh[32][64][8];
    const int w = cur >> 6;
    for (int j = 0; j < 8; ++j) { Ash[w][lane][j] = (unsigned short)a[j]; Bsh[w][lane][j] = (unsigned short)b[j]; }
    emu_wave_barrier();
    const int col = lane & 15;
    for (int r = 0; r < 4; ++r) { const int row = 4 * (lane >> 4) + r; float sum = c[r];
        for (int k = 0; k < 32; ++k) sum += emu_bf2f(Ash[w][row + 16 * (k >> 3)][k & 7]) * emu_bf2f(Bsh[w][col + 16 * (k >> 3)][k & 7]);
        c[r] = sum; }
    emu_wave_barrier(); (void)wbase;
    return c;
}
#define MFMA16(a, b, c) emu_mfma16(a, b, c)
#else
#define LAS __attribute__((address_space(3)))
#define WAIT_V(n) asm volatile("s_waitcnt vmcnt(" #n ")" ::: "memory")
#define WAIT_L(n) asm volatile("s_waitcnt lgkmcnt(" #n ")" ::: "memory")
#define S_BARRIER() __builtin_amdgcn_s_barrier()
#define SETPRIO(x) __builtin_amdgcn_s_setprio(x)
#define SCHED_BAR() __builtin_amdgcn_sched_barrier(0)
#define RFL(x) __builtin_amdgcn_readfirstlane(x)
#define GLDS16(gptr, ldsptr) __builtin_amdgcn_global_load_lds((const unsigned*)(gptr), (LAS unsigned*)(ldsptr), 16, 0, 0)
#define MFMA16(a, b, c) __builtin_amdgcn_mfma_f32_16x16x32_bf16(a, b, c, 0, 0, 0)
#endif

#ifdef EMU
__device__ __forceinline__ unsigned f2bf(float f) { unsigned u = __builtin_bit_cast(unsigned, f); return (u + 0x7fffu + ((u >> 16) & 1u)) >> 16; }
#else
__device__ __forceinline__ unsigned f2bf(float f) { return (unsigned)__builtin_bit_cast(unsigned short, (__bf16)f); }
#endif
#ifdef EMU
__device__ __forceinline__ unsigned pk2(float lo, float hi) { return f2bf(lo) | (f2bf(hi) << 16); }
#else
typedef float f32x2c __attribute__((ext_vector_type(2)));
typedef __bf16 bf16x2c __attribute__((ext_vector_type(2)));
__device__ __forceinline__ unsigned pk2(float lo, float hi) { const f32x2c v = {lo, hi}; return __builtin_bit_cast(unsigned, __builtin_convertvector(v, bf16x2c)); }
#endif
__device__ __forceinline__ bf16x8 cvt8(const f32x4 a, const f32x4 b) {
    u32x4 w; w.x = pk2(a.x, a.y); w.y = pk2(a.z, a.w); w.z = pk2(b.x, b.y); w.w = pk2(b.z, b.w); return __builtin_bit_cast(bf16x8, w);
}
__device__ __forceinline__ float bf_lo(unsigned u) { return __builtin_bit_cast(float, u << 16); }
__device__ __forceinline__ float bf_hi(unsigned u) { return __builtin_bit_cast(float, u & 0xffff0000u); }

namespace pg8 {
constexpr int BM = 256, BK = 64, HALF = 128, HTB = HALF * BK * 2, STAGE_BYTES = 8 * HTB, NXCD = 8, WGM = 8;
__host__ __device__ __forceinline__ int lds_byte(int r, int c) { const int st = (r >> 4) * 2 + (c >> 5), rr = r & 15, cc = c & 31, ob = rr * 64 + cc * 2; return st * 1024 + (ob ^ (((ob >> 9) & 1) << 5)); }
__host__ __device__ __forceinline__ void stage_rc(int b, int& R, int& C) { const int st = b / 1024, sb = b % 1024, swz = sb ^ (((sb >> 9) & 1) << 5); R = (st >> 1) * 16 + swz / 64; C = (st & 1) * 32 + (swz % 64) / 2; }
__host__ __device__ __forceinline__ int perm32(int rho) { const int n = rho >> 4, i = rho & 15; return 8 * (i >> 2) + 4 * n + (i & 3); }
struct Unit { int pm, pn, e; };

struct DenseOrder {
    static constexpr bool GATHER = false;
    const char* A; const char* Bt; int K; int nM, nN, nwg, G, c;
    __device__ __forceinline__ void init(const void* A_, const void* Bt_, int M, int N, int K_, int G_, int c_) { A = (const char*)A_; Bt = (const char*)Bt_; K = K_; nM = M / BM; nN = N / BM; nwg = nM * nN; G = G_; c = c_; }
    __device__ __forceinline__ bool next(int i, Unit& u) const {
        const long L = (long)i * G + c; if (L >= nwg) return false;
        int wgid = (int)L; { const int q = nwg / NXCD, r = nwg % NXCD, xcd = wgid % NXCD, off = wgid / NXCD; wgid = (xcd < r ? xcd * (q + 1) : r * (q + 1) + (xcd - r) * q) + off; }
        const int nig = WGM * nN, gid = wgid / nig, fm = gid * WGM, gsz = (nM - fm) < WGM ? (nM - fm) : WGM;
        u.pm = fm + ((wgid % nig) % gsz); u.pn = (wgid % nig) / gsz; u.e = 0; return true;
    }
    __device__ __forceinline__ const char* abase(const Unit& u) const { return A + (size_t)u.pm * BM * K * 2; }
    __device__ __forceinline__ const char* bbase(const Unit& u) const { return Bt + (size_t)u.pn * BM * K * 2; }
};
template <bool G>
struct MoeOrderT {
    static constexpr bool GATHER = G;
    const char* A; const char* Wt; int K; int nN, nwg, G_, c; size_t estride; const int* rbe; const int* rowmap;
    __device__ __forceinline__ bool next(int i, Unit& u) const {
        const long L = (long)i * G_ + c; if (L >= nwg) return false;
        u.pm = (int)(L / nN); u.pn = (int)(L % nN); u.e = rbe[u.pm]; return true;
    }
    __device__ __forceinline__ const char* abase(const Unit& u) const { return G ? A : A + (size_t)u.pm * BM * K * 2; }
    __device__ __forceinline__ const char* bbase(const Unit& u) const { return Wt + (size_t)u.e * estride + (size_t)u.pn * BM * K * 2; }
};
struct EpiF32 {
    static constexpr bool PERM = false;
    float* C; int ldc;
    __device__ __forceinline__ void operator()(const f32x4 (&acc)[2][2][4][2], const Unit& u, int wr, int wc, int fr, int fq) const {
        const int row0 = u.pm * BM + wr * 64 + fr, col0 = u.pn * BM + wc * 32 + 4 * fq;
#pragma unroll
        for (int ai = 0; ai < 2; ++ai)
#pragma unroll
            for (int m = 0; m < 4; ++m) { float* rowp = C + (size_t)(row0 + ai * HALF + m * 16) * ldc + col0;
#pragma unroll
                for (int bj = 0; bj < 2; ++bj)
#pragma unroll
                    for (int n = 0; n < 2; ++n) *(f32x4*)(rowp + bj * HALF + n * 16) = acc[ai][bj][m][n]; }
    }
};
struct EpiProj {
    static constexpr bool PERM = true;
    bf16_t* O; int ldc; float* G; int lastt;
    __device__ __forceinline__ void operator()(const f32x4 (&acc)[2][2][4][2], const Unit& u, int wr, int wc, int fr, int fq) const {
        const int row0 = u.pm * BM + wr * 64 + fr, col0 = u.pn * BM + wc * 32 + 8 * fq;
#pragma unroll
        for (int ai = 0; ai < 2; ++ai)
#pragma unroll
            for (int m = 0; m < 4; ++m) { bf16_t* rowp = O + (size_t)(row0 + ai * HALF + m * 16) * ldc + col0;
#pragma unroll
                for (int bj = 0; bj < 2; ++bj) { const f32x4 v0 = acc[ai][bj][m][0], v1 = acc[ai][bj][m][1];
                    u32x4 w; w.x = pk2(v0[0], v0[1]); w.y = pk2(v0[2], v0[3]); w.z = pk2(v1[0], v1[1]); w.w = pk2(v1[2], v1[3]);
                    *(u32x4*)(rowp + bj * HALF) = w; } }
        if (u.pn == lastt) {
#pragma unroll
            for (int ai = 0; ai < 2; ++ai)
#pragma unroll
                for (int m = 0; m < 4; ++m) { float* rowp = G + (size_t)(row0 + ai * HALF + m * 16) * BM + wc * 32 + 8 * fq;
#pragma unroll
                    for (int bj = 0; bj < 2; ++bj) { *(f32x4*)(rowp + bj * HALF) = acc[ai][bj][m][0]; *(f32x4*)(rowp + bj * HALF + 4) = acc[ai][bj][m][1]; } }
        }
    }
};
struct EpiBf16Bias {
    static constexpr bool PERM = true;
    bf16_t* O; int ldc; const float* bias; int bias_estride;
    __device__ __forceinline__ void operator()(const f32x4 (&acc)[2][2][4][2], const Unit& u, int wr, int wc, int fr, int fq) const {
        const int row0 = u.pm * BM + wr * 64 + fr, col0 = u.pn * BM + wc * 32 + 8 * fq;
        const float* bp = bias + (size_t)u.e * bias_estride + col0;
        f32x4 bv[2][2];
#pragma unroll
        for (int bj = 0; bj < 2; ++bj)
#pragma unroll
            for (int n = 0; n < 2; ++n) bv[bj][n] = *(const f32x4*)(bp + bj * HALF + 4 * n);
#pragma unroll
        for (int ai = 0; ai < 2; ++ai)
#pragma unroll
            for (int m = 0; m < 4; ++m) { bf16_t* rowp = O + (size_t)(row0 + ai * HALF + m * 16) * ldc + col0;
#pragma unroll
                for (int bj = 0; bj < 2; ++bj) { const f32x4 v0 = acc[ai][bj][m][0] + bv[bj][0], v1 = acc[ai][bj][m][1] + bv[bj][1];
                    u32x4 w; w.x = pk2(v0[0], v0[1]); w.y = pk2(v0[2], v0[3]); w.z = pk2(v1[0], v1[1]); w.w = pk2(v1[2], v1[3]);
                    *(u32x4*)(rowp + bj * HALF) = w; } }
    }
};
__device__ __forceinline__ float swiglu1(float g, float uu) { g = fminf(g, 7.0f); uu = fminf(fmaxf(uu, -7.0f), 7.0f); return (uu + 1.0f) * (g * frcp(1.0f + fexp(-1.702f * g))); }
struct EpiSwiglu {
    static constexpr bool PERM = true;
    bf16_t* O; const float* b1;
    __device__ __forceinline__ void operator()(const f32x4 (&acc)[2][2][4][2], const Unit& u, int wr, int wc, int fr, int fq) const {
        const int row0 = u.pm * BM + wr * 64 + fr, j0 = u.pn * HALF + wc * 32 + 8 * fq;
        const float* bg = b1 + (size_t)u.e * 2 * DFF + j0; const float* bu = bg + DFF;
        f32x4 g4[2], u4[2];
#pragma unroll
        for (int n = 0; n < 2; ++n) { g4[n] = *(const f32x4*)(bg + 4 * n); u4[n] = *(const f32x4*)(bu + 4 * n); }
#pragma unroll
        for (int ai = 0; ai < 2; ++ai)
#pragma unroll
            for (int m = 0; m < 4; ++m) {
                float o[8];
#pragma unroll
                for (int n = 0; n < 2; ++n)
#pragma unroll
                    for (int q = 0; q < 4; ++q) o[n * 4 + q] = swiglu1(acc[ai][0][m][n][q] + g4[n][q], acc[ai][1][m][n][q] + u4[n][q]);
                u32x4 w; w.x = pk2(o[0], o[1]); w.y = pk2(o[2], o[3]); w.z = pk2(o[4], o[5]); w.w = pk2(o[6], o[7]);
                *(u32x4*)(O + (size_t)(row0 + ai * HALF + m * 16) * DFF + j0) = w;
            }
    }
};

template <class Epi, class Sched, bool SP2 = (MK_SP2 != 0)>
__device__ __forceinline__ void gemm_phase(LAS unsigned char* lds, const int K, const Sched& S, const Epi& E, const int tid) {
    const int wid = RFL(tid >> 6), lane = tid & 63, wr = wid >> 2, wc = wid & 3, fr = lane & 15, fq = lane >> 4;
    const int nt = K / BK;
    unsigned voffA[2], voffB[2]; int gR[2]; unsigned gC[2];
#pragma unroll
    for (int i = 0; i < 2; ++i) { int R, C; stage_rc(tid * 16 + i * 8192, R, C); const int Rb = Epi::PERM ? ((R & ~31) + perm32(R & 31)) : R;
        voffA[i] = (unsigned)(R * K + C) * 2u; voffB[i] = (unsigned)(Rb * K + C) * 2u; gR[i] = R; gC[i] = (unsigned)C * 2u; }
    unsigned va[2][2], vn[2][2];
#define PG8_GOFF(dst, unit) do { if constexpr (Sched::GATHER) { _Pragma("unroll") for (int h_ = 0; h_ < 2; ++h_) _Pragma("unroll") for (int i_ = 0; i_ < 2; ++i_) \
        dst[h_][i_] = (unsigned)S.rowmap[(unit).pm * BM + h_ * HALF + gR[i_]] * (unsigned)(K * 2) + gC[i_]; } } while (0)
#define PG8_STAGE_A(bufoff, bp, kb, h, nx) do { if constexpr (Sched::GATHER) { const char* gb_ = S.A + (kb); _Pragma("unroll") for (int _i = 0; _i < 2; ++_i) \
        GLDS16(gb_ + ((nx) ? vn[h][_i] : va[h][_i]), lds + (bufoff) + ldsw + _i * 8192); } else { PG8_STAGE(bufoff, bp, voffA); } } while (0)
    const size_t kstep = (size_t)(BK * 2);
    const size_t hstep = (size_t)HALF * K * 2;
    const unsigned ldsw = (unsigned)wid * 1024u;
    const int aoff = lds_byte(wr * 64 + fr, fq * 8), boff = lds_byte(wc * 32 + fr, fq * 8);
#define PG8_SA(b, h) (((b) * 2 + (h)) * HTB)
#define PG8_SB(b, h) ((4 + (b) * 2 + (h)) * HTB)
#define PG8_STAGE(bufoff, gbase, voff) do { _Pragma("unroll") for (int _i = 0; _i < 2; ++_i) \
        GLDS16((const char*)(gbase) + (voff)[_i], lds + (bufoff) + ldsw + _i * 8192); } while (0)
#define PG8_LDA(dst, b, h) do { _Pragma("unroll") for (int m = 0; m < 4; ++m) _Pragma("unroll") for (int k = 0; k < 2; ++k) dst[m][k] = *(const LAS bf16x8*)(lds + PG8_SA(b, h) + aoff + m * 2048 + k * 1024); } while (0)
#define PG8_LDB(dst, b, h) do { _Pragma("unroll") for (int n = 0; n < 2; ++n) _Pragma("unroll") for (int k = 0; k < 2; ++k) dst[n][k] = *(const LAS bf16x8*)(lds + PG8_SB(b, h) + boff + n * 2048 + k * 1024); } while (0)
#define PG8_MMA(ai, bj, At, Bt) do { SETPRIO(1); _Pragma("unroll") for (int m = 0; m < 4; ++m) _Pragma("unroll") for (int n = 0; n < 2; ++n) _Pragma("unroll") for (int k = 0; k < 2; ++k) \
        acc[ai][bj][m][n] = MFMA16(Bt[n][k], At[m][k], acc[ai][bj][m][n]); SETPRIO(0); } while (0)
    Unit cur, nxt; int ui = 0;
    if (!S.next(0, cur)) return;
    f32x4 acc[2][2][4][2];
#pragma unroll
    for (int a = 0; a < 2; ++a)
#pragma unroll
        for (int b = 0; b < 2; ++b)
#pragma unroll
            for (int m = 0; m < 4; ++m)
#pragma unroll
                for (int n = 0; n < 2; ++n) acc[a][b][m][n] = (f32x4){0.f, 0.f, 0.f, 0.f};
    bf16x8 At[4][2], B0[2][2], B1[2][2];
    const char* cA = S.abase(cur); const char* cB = S.bbase(cur);
    PG8_GOFF(va, cur);
    if constexpr (SP2) {
        PG8_STAGE(PG8_SB(0, 0), cB, voffB); PG8_STAGE(PG8_SB(0, 1), cB + hstep, voffB); PG8_STAGE_A(PG8_SA(0, 0), cA, 0, 0, false); PG8_STAGE_A(PG8_SA(0, 1), cA + hstep, 0, 1, false);
        if (wr == 1) S_BARRIER();
        WAIT_V(2); S_BARRIER();
        PG8_STAGE(PG8_SB(1, 0), cB + kstep, voffB); PG8_STAGE_A(PG8_SA(1, 0), cA + kstep, kstep, 0, false); PG8_STAGE(PG8_SB(1, 1), cB + hstep + kstep, voffB);
        WAIT_V(6); S_BARRIER();
    } else {
    PG8_STAGE(PG8_SB(0, 0), cB, voffB); PG8_STAGE_A(PG8_SA(0, 0), cA, 0, 0, false); PG8_STAGE(PG8_SB(0, 1), cB + hstep, voffB); PG8_STAGE_A(PG8_SA(0, 1), cA + hstep, 0, 1, false);
    if (wr == 1) S_BARRIER();
    WAIT_V(4); S_BARRIER();
    PG8_STAGE(PG8_SB(1, 0), cB + kstep, voffB); PG8_STAGE_A(PG8_SA(1, 0), cA + kstep, kstep, 0, false); PG8_STAGE(PG8_SB(1, 1), cB + hstep + kstep, voffB);
    WAIT_V(6); S_BARRIER();
    }
    for (;;) {
        const bool has_next = S.next(ui + 1, nxt);
        const char* nA = has_next ? S.abase(nxt) : cA; const char* nB = has_next ? S.bbase(nxt) : cB;
        if constexpr (Sched::GATHER) { if (has_next) { PG8_GOFF(vn, nxt); } else {
#pragma unroll
            for (int h_ = 0; h_ < 2; ++h_) { vn[h_][0] = va[h_][0]; vn[h_][1] = va[h_][1]; } } }
        for (int t = 0; t < nt; t += 2) {
            const bool last = (t == nt - 2);
            const char* a1 = cA + (size_t)(t + 1) * kstep;
            const char* a2 = last ? nA : cA + (size_t)(t + 2) * kstep; const char* b2 = last ? nB : cB + (size_t)(t + 2) * kstep;
            const char* a3 = a2 + kstep; const char* b3 = b2 + kstep;
            if constexpr (SP2) {
            PG8_LDB(B0, 0, 0); PG8_LDB(B1, 0, 1); SCHED_BAR(); PG8_LDA(At, 0, 0); PG8_STAGE_A(PG8_SA(1, 1), a1 + hstep, (size_t)(t + 1) * kstep, 1, false);
            WAIT_V(8); WAIT_L(0); S_BARRIER(); PG8_MMA(0, 0, At, B0); PG8_MMA(0, 1, At, B1); S_BARRIER(); SCHED_BAR();
            PG8_LDA(At, 0, 1); PG8_STAGE(PG8_SB(0, 0), b2, voffB); PG8_STAGE(PG8_SB(0, 1), b2 + hstep, voffB); PG8_STAGE_A(PG8_SA(0, 0), a2, (last ? (size_t)0 : (size_t)(t + 2) * kstep), 0, last);
            WAIT_V(8); WAIT_L(0); S_BARRIER(); PG8_MMA(1, 0, At, B0); PG8_MMA(1, 1, At, B1); S_BARRIER(); SCHED_BAR();
            PG8_LDB(B0, 1, 0); PG8_LDB(B1, 1, 1); SCHED_BAR(); PG8_LDA(At, 1, 0); PG8_STAGE_A(PG8_SA(0, 1), a2 + hstep, (last ? (size_t)0 : (size_t)(t + 2) * kstep), 1, last);
            WAIT_V(8); WAIT_L(0); S_BARRIER(); PG8_MMA(0, 0, At, B0); PG8_MMA(0, 1, At, B1); S_BARRIER(); SCHED_BAR();
            PG8_LDA(At, 1, 1); PG8_STAGE(PG8_SB(1, 0), b3, voffB); PG8_STAGE(PG8_SB(1, 1), b3 + hstep, voffB); PG8_STAGE_A(PG8_SA(1, 0), a3, (last ? kstep : (size_t)(t + 3) * kstep), 0, last);
            WAIT_V(8); WAIT_L(0); S_BARRIER(); PG8_MMA(1, 0, At, B0); PG8_MMA(1, 1, At, B1); S_BARRIER(); SCHED_BAR();
            } else {
            PG8_LDB(B0, 0, 0); SCHED_BAR(); PG8_LDA(At, 0, 0); PG8_STAGE_A(PG8_SA(1, 1), a1 + hstep, (size_t)(t + 1) * kstep, 1, false);
            WAIT_L(8); S_BARRIER(); WAIT_L(0); PG8_MMA(0, 0, At, B0); S_BARRIER(); SCHED_BAR();
            PG8_LDB(B1, 0, 1); PG8_STAGE(PG8_SB(0, 0), b2, voffB);
            S_BARRIER(); WAIT_L(0); PG8_MMA(0, 1, At, B1); S_BARRIER();
            PG8_LDA(At, 0, 1); PG8_STAGE_A(PG8_SA(0, 0), a2, (last ? (size_t)0 : (size_t)(t + 2) * kstep), 0, last);
            S_BARRIER(); WAIT_L(0); PG8_MMA(1, 0, At, B0); S_BARRIER(); SCHED_BAR();
            PG8_STAGE(PG8_SB(0, 1), b2 + hstep, voffB);
            WAIT_V(6); S_BARRIER(); PG8_MMA(1, 1, At, B1); S_BARRIER();
            PG8_LDB(B0, 1, 0); SCHED_BAR(); PG8_LDA(At, 1, 0); PG8_STAGE_A(PG8_SA(0, 1), a2 + hstep, (last ? (size_t)0 : (size_t)(t + 2) * kstep), 1, last);
            WAIT_L(8); S_BARRIER(); WAIT_L(0); PG8_MMA(0, 0, At, B0); S_BARRIER(); SCHED_BAR();
            PG8_LDB(B1, 1, 1); PG8_STAGE(PG8_SB(1, 0), b3, voffB);
            S_BARRIER(); WAIT_L(0); PG8_MMA(0, 1, At, B1); S_BARRIER();
            PG8_LDA(At, 1, 1); PG8_STAGE_A(PG8_SA(1, 0), a3, (last ? kstep : (size_t)(t + 3) * kstep), 0, last);
            S_BARRIER(); WAIT_L(0); PG8_MMA(1, 0, At, B0); S_BARRIER(); SCHED_BAR();
            PG8_STAGE(PG8_SB(1, 1), b3 + hstep, voffB);
            WAIT_V(6); S_BARRIER(); PG8_MMA(1, 1, At, B1); S_BARRIER();
            }
        }
        if (wr == 0) S_BARRIER();
        E(acc, cur, wr, wc, fr, fq);
        if (!has_next) break;
#pragma unroll
        for (int a = 0; a < 2; ++a)
#pragma unroll
            for (int b = 0; b < 2; ++b)
#pragma unroll
                for (int m = 0; m < 4; ++m)
#pragma unroll
                    for (int n = 0; n < 2; ++n) acc[a][b][m][n] = (f32x4){0.f, 0.f, 0.f, 0.f};
        cur = nxt; cA = nA; cB = nB; ++ui;
        if constexpr (Sched::GATHER) {
#pragma unroll
            for (int h_ = 0; h_ < 2; ++h_) { va[h_][0] = vn[h_][0]; va[h_][1] = vn[h_][1]; } }
        if (wr == 1) S_BARRIER();
    }
    WAIT_V(0);
    S_BARRIER();
#undef PG8_SA
#undef PG8_SB
#undef PG8_STAGE
#undef PG8_STAGE_A
#undef PG8_GOFF
#undef PG8_LDA
#undef PG8_LDB
#undef PG8_MMA
}
}

__device__ __forceinline__ float row16_sum(float x) {
#ifdef EMU
    x += __shfl_xor(x, 1); x += __shfl_xor(x, 2); x += __shfl_xor(x, 4); x += __shfl_xor(x, 8); return x;
#else
#define DPPF(v, ctrl) __builtin_bit_cast(float, __builtin_amdgcn_update_dpp(0, __builtin_bit_cast(int, (v)), (ctrl), 0xF, 0xF, false))
    x += DPPF(x, 0xB1); x += DPPF(x, 0x4E); x += DPPF(x, 0x141); x += DPPF(x, 0x140); return x;
#undef DPPF
#endif
}
__device__ __forceinline__ float row32_sum(float x) {
    x = row16_sum(x);
#ifdef EMU
    x += __shfl_xor(x, 32); return x;
#else
    float a = x, b = x;
    asm volatile("s_nop 1\n\tv_permlane32_swap_b32 %0, %1" : "+v"(a), "+v"(b));
    return a + b;
#endif
}
__device__ __forceinline__ float wave_sum_fast(float x, int lane) {
    x = row32_sum(x);
    x += SHX(x, 16, lane);
    return x;
}
__device__ __forceinline__ void transpose_item(const float* W, int K, int N, bf16_t* WT, int k0, int n0, int dst_row0, float* scr, int lane) {
    const int n4 = (lane & 15) * 4, kr = lane >> 4;
#pragma unroll 8
    for (int i = 0; i < 16; ++i) {
        const int kk = 4 * i + kr;
        f32x4 v = (f32x4){0.f, 0.f, 0.f, 0.f};
        if (n0 + n4 < N) v = *(const f32x4*)(W + (size_t)(k0 + kk) * N + n0 + n4);
        float* d = scr + kk * 65 + n4; d[0] = v.x; d[1] = v.y; d[2] = v.z; d[3] = v.w;
    }
    WAVE_SYNC();
    const int c = lane & 7;
#pragma unroll
    for (int j = 0; j < 8; ++j) { const int n = (lane >> 3) + 8 * j; const float* sp = scr + (8 * c) * 65 + n;
        u32x4 o; o.x = pk2(sp[0 * 65], sp[1 * 65]); o.y = pk2(sp[2 * 65], sp[3 * 65]); o.z = pk2(sp[4 * 65], sp[5 * 65]); o.w = pk2(sp[6 * 65], sp[7 * 65]);
        *(u32x4*)(WT + (size_t)(dst_row0 + n) * K + k0 + 8 * c) = o; }
    WAVE_SYNC();
}
__device__ __forceinline__ void phase_prologue(const Params& P, unsigned char* smem, int wv) {
    ParamsPtr pp = PARAMS_PTR(P); PIN_S(pp); unsigned char* ws = pp->ws; int bidx = (int)blockIdx.x, gdim = (int)gridDim.x; PIN_S(bidx); PIN_S(gdim);
    const int tid = phase_tid(wv), lane = tid & 63, wave = tid >> 6;
    float* scr = (float*)smem + wave * (64 * 65);
    const int gw = bidx * NWAVES + wave, ngw = NWAVES * gdim;
    constexpr int I_IN = 16 * (PLD / 64), I_OUT = 16 * 16, I_W1 = NE * 16 * 32, I_W2 = NE * 16 * 16, I_L = I_IN + I_OUT + I_W1 + I_W2;
    for (int it = gw; it < NL * I_L; it += ngw) {
        const int l = it / I_L; int r = it % I_L;
        if (r < I_IN) { const int kb = r / (PLD / 64), nb = r % (PLD / 64);
            transpose_item(pp->in[1] + (size_t)l * D * PIN, D, PIN, (bf16_t*)(ws + O_WIN) + (size_t)l * PLD * D, kb * 64, nb * 64, nb * 64, scr, lane); continue; }
        r -= I_IN;
        if (r < I_OUT) { const int kb = r / 16, nb = r % 16;
            transpose_item(pp->in[21] + (size_t)l * D * D, D, D, (bf16_t*)(ws + O_WOUT) + (size_t)l * D * D, kb * 64, nb * 64, nb * 64, scr, lane); continue; }
        r -= I_OUT;
        if (r < I_W1) { const int e = r / (16 * 32), q = r % (16 * 32), kb = q / 32, nb = q % 32, n0 = nb * 64;
            const int dst = n0 < DFF ? (n0 / 128) * 256 + (n0 % 128) : ((n0 - DFF) / 128) * 256 + 128 + ((n0 - DFF) % 128);
            transpose_item(pp->in[26] + ((size_t)l * NE + e) * D * 2 * DFF, D, 2 * DFF, (bf16_t*)(ws + O_W1) + ((size_t)l * NE + e) * 2 * DFF * D, kb * 64, n0, dst, scr, lane); continue; }
        r -= I_W1;
        { const int e = r / (16 * 16), q = r % (16 * 16), kb = q / 16, nb = q % 16;
            transpose_item(pp->in[28] + ((size_t)l * NE + e) * DFF * D, DFF, D, (bf16_t*)(ws + O_W2) + ((size_t)l * NE + e) * D * DFF, kb * 64, nb * 64, nb * 64, scr, lane); }
    }
    {
        const float* gw_ = pp->in[4]; bf16_t* WSB = (bf16_t*)(ws + O_WSB);
        for (size_t i = ((size_t)bidx * NTHREADS + tid) * 4; i < (size_t)NL * GH * CH * CH; i += (size_t)gdim * NTHREADS * 4) {
            const f32x4 v = *(const f32x4*)(gw_ + i); u32x2 o; o.x = pk2(v.x, v.y); o.y = pk2(v.z, v.w); *(u32x2*)(WSB + i) = o;
        }
    }
    {
        bf16_t* LWT = (bf16_t*)(ws + O_LWT);
        for (int i = bidx * NTHREADS + tid; i < NL * 1920 * 128; i += gdim * NTHREADS) {
            const int k = i & 127, n = (i >> 7) % 1920, ll = i / (1920 * 128);
            float v = 0.f;
            if (n < 1536) { if (k < 64) { const int grp = n / 768, d = (n / 384) & 1, c = n % 384; v = (grp == 0 ? pp->in[8] : pp->in[10])[(((size_t)ll * 2 + d) * 64 + k) * RW + c]; } }
            else v = pp->in[11][((size_t)ll * 128 + k) * RW + (n - 1536)];
            LWT[i] = (bf16_t)f2bf(v);
        }
    }
    {
        bf16_t* RWT = (bf16_t*)(ws + O_RWT);
        for (int i = bidx * NTHREADS + tid; i < NL * NE * D; i += gdim * NTHREADS) {
            const int k = i % D, e = (i / D) % NE, ll = i / (D * NE);
            const float v = pp->in[24][((size_t)ll * D + k) * NE + e];
            const unsigned hi = f2bf(v); const float lo = v - bf_lo(hi);
            RWT[((size_t)(ll * 2 + 0) * NE + e) * D + k] = (bf16_t)hi; RWT[((size_t)(ll * 2 + 1) * NE + e) * D + k] = (bf16_t)f2bf(lo);
        }
    }
    const float* x = pp->in[0]; bf16_t* XB = (bf16_t*)(ws + O_XB);
    for (size_t i = ((size_t)bidx * NTHREADS + tid) * 4; i < (size_t)T * D; i += (size_t)gdim * NTHREADS * 4) {
        const f32x4 v = *(const f32x4*)(x + i); u32x2 o; o.x = pk2(v.x, v.y); o.y = pk2(v.z, v.w); *(u32x2*)(XB + i) = o;
    }
}

__device__ __forceinline__ float tshift(const float* P, int t, int s, int col, const float* mu0, const float* mu1, int rc) {
    const float cur = P[(size_t)t * PLD + col];
    const float prv = s > 0 ? P[(size_t)(t - 1) * PLD + col] : 0.f;
    const float nxt = s < S - 1 ? P[(size_t)(t + 1) * PLD + col] : 0.f;
    return cur + mu0[rc] * (prv - cur) + mu1[rc] * (nxt - cur);
}

__device__ __forceinline__ void phase_prep(const Params& P, int l, unsigned char* smem, int wv) {
    ParamsPtr pp = PARAMS_PTR(P); PIN_S(pp); unsigned char* ws = pp->ws; int bidx = (int)blockIdx.x, gdim = (int)gridDim.x; PIN_S(bidx); PIN_S(gdim);
    const bf16_t* proj = (const bf16_t*)(ws + O_PROJ); const float* projg = (const float*)(ws + O_PROJG);
    float* UG = (float*)(ws + O_UG); bf16_t* VNT = (bf16_t*)(ws + O_VNT);
    float* RR = (float*)(ws + O_RR); float* VV = (float*)(ws + O_VV); float* KK = (float*)(ws + O_KK);
    float* KD = (float*)(ws + O_KD); float* ICLR = (float*)(ws + O_ICLR);
    float* GATE = (float*)(ws + O_GATE); float* BONUS = (float*)(ws + O_BONUS); float* LWG = (float*)(ws + O_LW);
    bf16_t* RB = (bf16_t*)(ws + O_RB); bf16_t* VB = (bf16_t*)(ws + O_VB); bf16_t* KKB = (bf16_t*)(ws + O_KKB); bf16_t* BBB = (bf16_t*)(ws + O_BBB); bf16_t* KDB = (bf16_t*)(ws + O_KDB);
#if !MK_RWKV_CHUNKED
    float* DEC = (float*)(ws + O_DEC); float* BRKR = (float*)(ws + O_BRKR);
#endif
    bf16_t* MQB = (bf16_t*)(ws + O_MQB); bf16_t* MKB = (bf16_t*)(ws + O_MKB); bf16_t* KT = (bf16_t*)(ws + O_KT); bf16_t* VT = (bf16_t*)(ws + O_VT);
    float* IG = (float*)(ws + O_IG); float* LF = (float*)(ws + O_LF);
    const bf16_t* LWT = (const bf16_t*)(ws + O_LWT) + (size_t)l * 1920 * 128;
    const float* gln_g = pp->in[2] + (size_t)l * GW; const float* gln_b = pp->in[3] + (size_t)l * GW;
    const float* mu0 = pp->in[6] + (size_t)l * 2 * RPROJ; const float* mu1 = mu0 + RPROJ;
    const float* w0 = pp->in[7] + (size_t)l * 2 * RW; const float* a0 = pp->in[9] + (size_t)l * 2 * RW;
    const float* k_k = pp->in[12] + (size_t)l * RW; const float* k_a = pp->in[13] + (size_t)l * RW; const float* r_k = pp->in[14] + (size_t)l * RW;
    const float* conv_w = pp->in[17] + (size_t)l * 3 * 768; const float* conv_b = pp->in[18] + (size_t)l * 768; const float* gate_b = pp->in[19] + (size_t)l * 24;
    float* win = (float*)smem;
    bf16_t* lin = (bf16_t*)(smem + 101376);
    bf16_t* tvn = (bf16_t*)(smem + 110592);
    bf16_t* tk = (bf16_t*)(smem + 118784);
    bf16_t* tv = (bf16_t*)(smem + 131072);
    constexpr int LIN = 264;
    const int tid = phase_tid(wv), lane = tid & 63, wave = tid >> 6, col = lane & 15, g = lane >> 4;
    for (int u = bidx; u < T / 16; u += gdim) {
        const int t0 = u * 16, s0 = t0 % S, bb = t0 / S;
        __syncthreads();
        {
            u32x2 wb[18];
#pragma unroll
            for (int row = 0; row < 18; ++row) {
                const int sq = s0 - 1 + row;
                wb[row] = (u32x2){0u, 0u};
                if (sq >= 0 && sq < S && tid < 352) wb[row] = *(const u32x2*)(proj + (size_t)(t0 - 1 + row) * PLD + C_RW + tid * 4);
            }
            if (tid < 352) {
#pragma unroll
                for (int row = 0; row < 18; ++row) *(f32x4*)(win + row * RPROJ + tid * 4) = (f32x4){bf_lo(wb[row].x), bf_hi(wb[row].x), bf_lo(wb[row].y), bf_hi(wb[row].y)};
            }
        }
        for (int rep_ = 0; rep_ < (MK_PROBE == 3 ? 2 : 1); ++rep_) {
            const int i = tid >> 5, l32 = tid & 31, t = t0 + i;
            float v[8], ug[8]; float sum = 0.f;
#pragma unroll
            for (int j = 0; j < 8; ++j) { const int c = j * 32 + l32; ug[j] = bf_lo((unsigned)proj[(size_t)t * PLD + c]); v[j] = bf_lo((unsigned)proj[(size_t)t * PLD + GW + c]); }
#pragma unroll
            for (int j = 0; j < 8; ++j) { const int c = j * 32 + l32; UG[(size_t)t * GW + c] = geluf_(ug[j]); v[j] = geluf_(v[j]); sum += v[j]; }
#pragma unroll
            for (int o = 16; o >= 1; o >>= 1) sum += SHX(sum, o, lane);
            const float mean = sum * (1.0f / GW); float q = 0.f;
#pragma unroll
            for (int j = 0; j < 8; ++j) { const float d = v[j] - mean; q += d * d; }
#pragma unroll
            for (int o = 16; o >= 1; o >>= 1) q += SHX(q, o, lane);
            const float rstd = 1.0f / sqrtf(q * (1.0f / GW) + LN_EPS);
#pragma unroll
            for (int j = 0; j < 8; ++j) { const int c = j * 32 + l32; tvn[c * 16 + i] = (bf16_t)f2bf((v[j] - mean) * rstd * gln_g[c] + gln_b[c]); }
        }
        __syncthreads();
        {
            const int hf = tid & 1, c = tid >> 1;
            *(u32x4*)(VNT + ((size_t)bb * GW + c) * S + s0 + hf * 8) = *(const u32x4*)(tvn + c * 16 + hf * 8);
        }
        for (int idx = tid; idx < 16 * 256; idx += NTHREADS) {
            const int i = idx >> 8, j = idx & 255, rc = 1152 + j;
            const float pv = win[i * RPROJ + rc], cv = win[(i + 1) * RPROJ + rc], nv = win[(i + 2) * RPROJ + rc];
            const float x = cv + mu0[rc] * (pv - cv) + mu1[rc] * (nv - cv);
            lin[i * LIN + j] = (bf16_t)f2bf(j < 64 ? ftanh(x) : (j < 128 ? x : sigmoidf_(x)));
        }
        __syncthreads();
        for (int rep_ = 0; rep_ < (MK_PROBE == 1 ? 2 : 1); ++rep_) {
#pragma unroll 1
            for (int qg = 0; qg < 3; ++qg) {
                bf16x8 bw_[5][4]; float bias_[5];
#pragma unroll
                for (int q5 = 0; q5 < 5; ++q5) {
                    const int nt = wave * 15 + qg * 5 + q5, grp = nt / 24, c = (nt % 24) * 16 + col;
                    const bf16_t* bw = LWT + (size_t)(nt * 16 + col) * 128 + 8 * g;
#pragma unroll
                    for (int ks = 0; ks < 2; ++ks) bw_[q5][ks] = *(const bf16x8*)(bw + ks * 32);
                    if (grp == 4) {
#pragma unroll
                        for (int ks = 2; ks < 4; ++ks) bw_[q5][ks] = *(const bf16x8*)(bw + ks * 32);
                    }
                    bias_[q5] = grp < 2 ? w0[grp * RW + c] : (grp < 4 ? a0[(grp - 2) * RW + c] : 0.f);
                }
#pragma unroll
                for (int q5 = 0; q5 < 5; ++q5) {
                    const int nt = wave * 15 + qg * 5 + q5, grp = nt / 24, c = (nt % 24) * 16 + col;
                    const int kcol = grp < 2 ? 0 : (grp < 4 ? 64 : 128);
                    f32x4 acc = (f32x4){0.f, 0.f, 0.f, 0.f};
#pragma unroll
                    for (int ks = 0; ks < 2; ++ks) acc = MFMA16(*(const bf16x8*)(lin + col * LIN + kcol + ks * 32 + 8 * g), bw_[q5][ks], acc);
                    if (grp == 4) {
#pragma unroll
                        for (int ks = 2; ks < 4; ++ks) acc = MFMA16(*(const bf16x8*)(lin + col * LIN + kcol + ks * 32 + 8 * g), bw_[q5][ks], acc);
                    }
                    if (grp < 2) {
#pragma unroll
                        for (int r = 0; r < 4; ++r) { const float lw = -fexp(-softplusf_(-(acc[r] + bias_[q5])) - 0.5f); const size_t o = (size_t)grp * T * RW + (size_t)(t0 + 4 * g + r) * RW + c; LWG[o] = lw;
#if !MK_RWKV_CHUNKED
                            DEC[o] = expf(lw);
#endif
                        }
                    } else if (grp < 4) {
#pragma unroll
                        for (int r = 0; r < 4; ++r) ICLR[(size_t)(grp - 2) * T * RW + (size_t)(t0 + 4 * g + r) * RW + c] = sigmoidf_(acc[r] + bias_[q5]);
                    } else {
#pragma unroll
                        for (int r = 0; r < 4; ++r) GATE[(size_t)(t0 + 4 * g + r) * RW + c] = acc[r];
                    }
                }
            }
        }
        __syncthreads();
        for (int rep_ = 0; rep_ < (MK_PROBE == 2 ? 2 : 1); ++rep_) if (wave < 6) {
            const int c = tid, h = wave;
            const float kkc = k_k[c], kac = k_a[c], rkc = r_k[c];
            const float m0r = mu0[c], m1r = mu1[c], m0k = mu0[RW + c], m1k = mu1[RW + c], m0v = mu0[2 * RW + c], m1v = mu1[2 * RW + c];
            float ic0[16], ic1[16];
#pragma unroll
            for (int i = 0; i < 16; ++i) { const size_t o = (size_t)(t0 + i) * RW + c; ic0[i] = ICLR[o]; ic1[i] = ICLR[(size_t)T * RW + o]; }
#pragma unroll
            for (int i = 0; i < 16; ++i) {
                const int t = t0 + i;
                const float* w_ = win + i * RPROJ + c;
                const float rp = w_[0], rc_ = w_[RPROJ], rn = w_[2 * RPROJ];
                const float kp = w_[RW], kc_ = w_[RPROJ + RW], kn = w_[2 * RPROJ + RW];
                const float vp = w_[2 * RW], vc_ = w_[RPROJ + 2 * RW], vn = w_[2 * RPROJ + 2 * RW];
                const float r = rc_ + m0r * (rp - rc_) + m1r * (rn - rc_);
                const float k = kc_ + m0k * (kp - kc_) + m1k * (kn - kc_);
                const float v = vc_ + m0v * (vp - vc_) + m1v * (vn - vc_);
                const size_t o = (size_t)t * RW + c;
                const float kq = k * kkc;
                const float n2 = wave_sum_fast(kq * kq, lane);
                const float kk = kq / fmaxf(sqrtf(n2), 1e-12f);
                const float kd0 = k * (1.0f + (ic0[i] - 1.0f) * kac), kd1 = k * (1.0f + (ic1[i] - 1.0f) * kac);
                const float bon = wave_sum_fast(r * (kd0 + kd1) * rkc, lane);
#if MK_RWKV_CHUNKED
                RB[o] = (bf16_t)f2bf(r); VB[o] = (bf16_t)f2bf(v); KKB[o] = (bf16_t)f2bf(kk);
                BBB[o] = (bf16_t)f2bf(kk * ic0[i]); BBB[(size_t)T * RW + o] = (bf16_t)f2bf(kk * ic1[i]);
                KDB[o] = (bf16_t)f2bf(kd0); KDB[(size_t)T * RW + o] = (bf16_t)f2bf(kd1);
#else
                RR[o] = r; VV[o] = v; KK[o] = kk;
                KD[o] = kd0; KD[(size_t)T * RW + o] = kd1;
#endif
                if (lane == 0) BONUS[(size_t)t * RH + h] = bon;
#if !MK_RWKV_CHUNKED
                { const float br0 = wave_sum(kk * ic0[i] * r, lane), br1 = wave_sum(kk * ic1[i] * r, lane), kr0 = wave_sum(kd0 * r, lane), kr1 = wave_sum(kd1 * r, lane);
                  if (lane == 0) { BRKR[((size_t)t * RH + h) * 2] = br0; BRKR[((size_t)t * RH + h) * 2 + 1] = kr0; BRKR[((size_t)(T + t) * RH + h) * 2] = br1; BRKR[((size_t)(T + t) * RH + h) * 2 + 1] = kr1; } }
#endif
            }
        }
        __syncthreads();
        {
            u32x2 wb[9], vb[3];
            const int rsel = tid >= 192 ? 1 : 0, c4 = tid - rsel * 192;
#pragma unroll
            for (int it = 0; it < 9; ++it) {
                const int row = 2 * it + rsel, sq = s0 - 1 + row;
                wb[it] = (u32x2){0u, 0u};
                if (tid < 384 && sq >= 0 && sq < S) wb[it] = *(const u32x2*)(proj + (size_t)(t0 - 1 + row) * PLD + C_MW + c4 * 4);
            }
#pragma unroll
            for (int it = 0; it < 3; ++it) { const int idx = tid + it * NTHREADS, i = idx / 96, cc = (idx % 96) * 4; vb[it] = *(const u32x2*)(proj + (size_t)(t0 + i) * PLD + C_MW + 2 * MW + cc); }
            if (tid < 384) {
#pragma unroll
                for (int it = 0; it < 9; ++it) *(f32x4*)(win + (2 * it + rsel) * 768 + c4 * 4) = (f32x4){bf_lo(wb[it].x), bf_hi(wb[it].x), bf_lo(wb[it].y), bf_hi(wb[it].y)};
            }
#pragma unroll
            for (int it = 0; it < 3; ++it) { const int idx = tid + it * NTHREADS, i = idx / 96, cc = (idx % 96) * 4; const u32x2 v = vb[it];
                tv[(cc + 0) * 16 + i] = (bf16_t)(v.x & 0xffffu); tv[(cc + 1) * 16 + i] = (bf16_t)(v.x >> 16); tv[(cc + 2) * 16 + i] = (bf16_t)(v.y & 0xffffu); tv[(cc + 3) * 16 + i] = (bf16_t)(v.y >> 16); }
        }
        for (int idx = tid; idx < 16 * 24; idx += NTHREADS) {
            const int i = idx / 24, gi = idx % 24, t = t0 + i;
            const int isf = gi / 12, dir = (gi / 6) & 1, h = gi % 6;
            const float gg = projg[(size_t)t * 256 + (3456 - (PLD - 256)) + gi] + gate_b[gi];
            if (isf) LF[((size_t)dir * T + t) * MH + h] = -softplusf_(-gg); else IG[((size_t)dir * T + t) * MH + h] = gg;
        }
        __syncthreads();
        for (int rep_ = 0; rep_ < (MK_PROBE == 4 ? 2 : 1); ++rep_)
        for (int idx = tid; idx < 16 * 768; idx += NTHREADS) {
            const int i = idx / 768, c = idx % 768, t = t0 + i;
            const float* w_ = win + i * 768 + c;
            float y = conv_b[c] + w_[0] * conv_w[c] + w_[768] * conv_w[768 + c] + w_[1536] * conv_w[2 * 768 + c];
            y = y * sigmoidf_(y);
            if (c < MW) MQB[(size_t)t * MW + c] = (bf16_t)f2bf(y);
            else { const bf16_t kb = (bf16_t)f2bf(y * 0.125f); MKB[(size_t)t * MW + (c - MW)] = kb; tk[(c - MW) * 16 + i] = kb; }
        }
        __syncthreads();
        for (int idx = tid; idx < 2 * MW * 2; idx += NTHREADS) {
            const int hf = idx & 1, c = (idx >> 1) % MW, which = idx / (2 * MW);
            const u32x4 val = *(const u32x4*)((which ? tv : tk) + c * 16 + hf * 8);
            bf16_t* dst = (which ? VT : KT) + ((size_t)(bb * MH) * 64 + c) * S + s0 + hf * 8;
            *(u32x4*)dst = val;
        }
    }
    __syncthreads();
}

__device__ __forceinline__ void phase_prep32(const Params& P, int l, unsigned char* smem, int wv) {
    ParamsPtr pp = PARAMS_PTR(P); PIN_S(pp); unsigned char* ws = pp->ws; int bidx = (int)blockIdx.x, gdim = (int)gridDim.x; PIN_S(bidx); PIN_S(gdim);
    const bf16_t* proj = (const bf16_t*)(ws + O_PROJ); const float* projg = (const float*)(ws + O_PROJG);
    float* UG = (float*)(ws + O_UG); bf16_t* VNT = (bf16_t*)(ws + O_VNT);
    u32x4* RK7 = (u32x4*)(ws + O_RK7);
    float* GATE = (float*)(ws + O_GATE); float* BONUS = (float*)(ws + O_BONUS); float* LWG = (float*)(ws + O_LW);
    bf16_t* VB = (bf16_t*)(ws + O_VB);
    bf16_t* MQB = (bf16_t*)(ws + O_MQB); bf16_t* MKB = (bf16_t*)(ws + O_MKB); bf16_t* KT = (bf16_t*)(ws + O_KT); bf16_t* VT = (bf16_t*)(ws + O_VT);
    float* IG = (float*)(ws + O_IG); float* LF = (float*)(ws + O_LF);
    const bf16_t* LWT = (const bf16_t*)(ws + O_LWT) + (size_t)l * 1920 * 128;
    const float* gln_g = pp->in[2] + (size_t)l * GW; const float* gln_b = pp->in[3] + (size_t)l * GW;
    const float* mu0 = pp->in[6] + (size_t)l * 2 * RPROJ; const float* mu1 = mu0 + RPROJ;
    const float* w0 = pp->in[7] + (size_t)l * 2 * RW; const float* a0 = pp->in[9] + (size_t)l * 2 * RW;
    const float* k_k = pp->in[12] + (size_t)l * RW; const float* k_a = pp->in[13] + (size_t)l * RW; const float* r_k = pp->in[14] + (size_t)l * RW;
    const float* conv_w = pp->in[17] + (size_t)l * 3 * 768; const float* conv_b = pp->in[18] + (size_t)l * 768; const float* gate_b = pp->in[19] + (size_t)l * 24;
    constexpr int TOK = 32, WR = TOK + 2, LIN = 264;
    bf16_t* winb = (bf16_t*)smem;
    bf16_t* lin = (bf16_t*)(smem + 95744);
    bf16_t* tk = (bf16_t*)(smem + 112640);
    bf16_t* tv = (bf16_t*)(smem + 137216);
    bf16_t* tvn = tk;
    bf16_t* icl = tk;
    const int tid = phase_tid(wv), lane = tid & 63, wave = tid >> 6, col = lane & 15, g = lane >> 4;
    for (int u = bidx; u < T / TOK; u += gdim) {
        const int t0 = u * TOK, s0 = t0 % S, bb = t0 / S;
        __syncthreads();
#pragma unroll 1
        for (int hb = 0; hb < 2; ++hb) {
            u32x2 wb[17];
#pragma unroll
            for (int q = 0; q < 17; ++q) {
                const int row = hb * 17 + q, sq = s0 - 1 + row;
                wb[q] = (u32x2){0u, 0u};
                if (sq >= 0 && sq < S && tid < 352) wb[q] = *(const u32x2*)(proj + (size_t)(t0 - 1 + row) * PLD + C_RW + tid * 4);
            }
            if (tid < 352) {
#pragma unroll
                for (int q = 0; q < 17; ++q) *(u32x2*)(winb + (hb * 17 + q) * RPROJ + tid * 4) = wb[q];
            }
        }
#pragma unroll 1
        for (int ps = 0; ps < 2; ++ps) {
            const int i = ps * 16 + (tid >> 5), l32 = tid & 31, t = t0 + i;
            float v[8], ug[8]; float sum = 0.f;
#pragma unroll
            for (int j = 0; j < 8; ++j) { const int c = j * 32 + l32; ug[j] = bf_lo((unsigned)proj[(size_t)t * PLD + c]); v[j] = bf_lo((unsigned)proj[(size_t)t * PLD + GW + c]); }
#pragma unroll
            for (int j = 0; j < 8; ++j) { const int c = j * 32 + l32; UG[(size_t)t * GW + c] = geluf_(ug[j]); v[j] = geluf_(v[j]); sum += v[j]; }
#pragma unroll
            for (int o = 16; o >= 1; o >>= 1) sum += SHX(sum, o, lane);
            const float mean = sum * (1.0f / GW); float q = 0.f;
#pragma unroll
            for (int j = 0; j < 8; ++j) { const float d = v[j] - mean; q += d * d; }
#pragma unroll
            for (int o = 16; o >= 1; o >>= 1) q += SHX(q, o, lane);
            const float rstd = 1.0f / sqrtf(q * (1.0f / GW) + LN_EPS);
#pragma unroll
            for (int j = 0; j < 8; ++j) { const int c = j * 32 + l32; tvn[c * TOK + i] = (bf16_t)f2bf((v[j] - mean) * rstd * gln_g[c] + gln_b[c]); }
        }
        __syncthreads();
#pragma unroll
        for (int q = 0; q < 2; ++q) {
            const int idx = tid + q * NTHREADS, c = idx >> 2, pc = idx & 3;
            *(u32x4*)(VNT + ((size_t)bb * GW + c) * S + s0 + pc * 8) = *(const u32x4*)(tvn + c * TOK + pc * 8);
        }
        int tb2 = tid; PIN_V(tb2);
#pragma unroll 4
        for (int q = 0; q < 16; ++q) {
            const int idx = tb2 + q * NTHREADS, i = idx >> 8, j = idx & 255, rc = 1152 + j;
            const float pv = bf_lo((unsigned)winb[i * RPROJ + rc]), cv = bf_lo((unsigned)winb[(i + 1) * RPROJ + rc]), nv = bf_lo((unsigned)winb[(i + 2) * RPROJ + rc]);
            const float x = cv + mu0[rc] * (pv - cv) + mu1[rc] * (nv - cv);
            lin[i * LIN + j] = (bf16_t)f2bf(j < 64 ? ftanh(x) : (j < 128 ? x : sigmoidf_(x)));
        }
        __syncthreads();
#pragma unroll 1
        for (int qg = 0; qg < 3; ++qg) {
            bf16x8 bw_[5][4]; float bias_[5];
#pragma unroll
            for (int q5 = 0; q5 < 5; ++q5) {
                const int nt = wave * 15 + qg * 5 + q5, grp = nt / 24, c = (nt % 24) * 16 + col;
                const bf16_t* bw = LWT + (size_t)(nt * 16 + col) * 128 + 8 * g;
#pragma unroll
                for (int ks = 0; ks < 2; ++ks) bw_[q5][ks] = *(const bf16x8*)(bw + ks * 32);
                if (grp == 4) {
#pragma unroll
                    for (int ks = 2; ks < 4; ++ks) bw_[q5][ks] = *(const bf16x8*)(bw + ks * 32);
                }
                bias_[q5] = grp < 2 ? w0[grp * RW + c] : (grp < 4 ? a0[(grp - 2) * RW + c] : 0.f);
            }
#pragma unroll
            for (int q5 = 0; q5 < 5; ++q5) {
                const int nt = wave * 15 + qg * 5 + q5, grp = nt / 24, c = (nt % 24) * 16 + col;
                const int kcol = grp < 2 ? 0 : (grp < 4 ? 64 : 128);
#pragma unroll
                for (int mt = 0; mt < 2; ++mt) {
                    f32x4 acc = (f32x4){0.f, 0.f, 0.f, 0.f};
                    const bf16_t* la = lin + (mt * 16 + col) * LIN + kcol + 8 * g;
#pragma unroll
                    for (int ks = 0; ks < 2; ++ks) acc = MFMA16(*(const bf16x8*)(la + ks * 32), bw_[q5][ks], acc);
                    if (grp == 4) {
#pragma unroll
                        for (int ks = 2; ks < 4; ++ks) acc = MFMA16(*(const bf16x8*)(la + ks * 32), bw_[q5][ks], acc);
                    }
                    const size_t tb = (size_t)(t0 + mt * 16 + 4 * g);
                    if (grp < 2) {
#pragma unroll
                        for (int r = 0; r < 4; ++r) LWG[(size_t)grp * T * RW + (tb + r) * RW + c] = -fexp(-softplusf_(-(acc[r] + bias_[q5])) - 0.5f);
                    } else if (grp < 4) {
#pragma unroll
                        for (int r = 0; r < 4; ++r) icl[((grp - 2) * TOK + mt * 16 + 4 * g + r) * RW + c] = (bf16_t)f2bf(sigmoidf_(acc[r] + bias_[q5]));
                    } else {
#pragma unroll
                        for (int r = 0; r < 4; ++r) GATE[(tb + r) * RW + c] = acc[r];
                    }
                }
            }
        }
        __syncthreads();
        if (wave < 6) {
            int c = tid; PIN_V(c); const int h = wave;
            const float kkc = k_k[c], kac = k_a[c], rkc = r_k[c];
            const float m0r = mu0[c], m1r = mu1[c], m0k = mu0[RW + c], m1k = mu1[RW + c], m0v = mu0[2 * RW + c], m1v = mu1[2 * RW + c];
#pragma unroll 1
            for (int hb = 0; hb < 2; ++hb) {
                float ic0[16], ic1[16];
#pragma unroll
                for (int i = 0; i < 16; ++i) { ic0[i] = bf_lo((unsigned)icl[(hb * 16 + i) * RW + c]); ic1[i] = bf_lo((unsigned)icl[(TOK + hb * 16 + i) * RW + c]); }
#pragma unroll
                for (int i = 0; i < 16; ++i) {
                    const int it = hb * 16 + i, t = t0 + it;
                    const bf16_t* w_ = winb + it * RPROJ + c;
                    const float rp = bf_lo((unsigned)w_[0]), rc_ = bf_lo((unsigned)w_[RPROJ]), rn = bf_lo((unsigned)w_[2 * RPROJ]);
                    const float kp = bf_lo((unsigned)w_[RW]), kc_ = bf_lo((unsigned)w_[RPROJ + RW]), kn = bf_lo((unsigned)w_[2 * RPROJ + RW]);
                    const float vp = bf_lo((unsigned)w_[2 * RW]), vc_ = bf_lo((unsigned)w_[RPROJ + 2 * RW]), vn = bf_lo((unsigned)w_[2 * RPROJ + 2 * RW]);
                    const float r = rc_ + m0r * (rp - rc_) + m1r * (rn - rc_);
                    const float k = kc_ + m0k * (kp - kc_) + m1k * (kn - kc_);
                    const float v = vc_ + m0v * (vp - vc_) + m1v * (vn - vc_);
                    const size_t o = (size_t)t * RW + c;
                    const float kq = k * kkc;
                    const float n2 = wave_sum_fast(kq * kq, lane);
                    const float kk = kq / fmaxf(sqrtf(n2), 1e-12f);
                    const float kd0 = k * (1.0f + (ic0[i] - 1.0f) * kac), kd1 = k * (1.0f + (ic1[i] - 1.0f) * kac);
                    const float bon = wave_sum_fast(r * (kd0 + kd1) * rkc, lane);
                    u32x4 rec; rec.x = pk2(r, v); rec.y = pk2(kk, 0.f); rec.z = pk2(kk * ic0[i], kk * ic1[i]); rec.w = pk2(kd0, kd1);
                    RK7[o] = rec;
                    VB[o] = (bf16_t)(rec.x >> 16);
                    if (lane == 0) BONUS[(size_t)t * RH + h] = bon;
                }
            }
        }
        __syncthreads();
        {
            u32x2 wb[17], vb[6];
            const int rsel = tid >= 192 ? 1 : 0, c4 = tid - rsel * 192;
#pragma unroll
            for (int q = 0; q < 17; ++q) {
                const int row = 2 * q + rsel, sq = s0 - 1 + row;
                wb[q] = (u32x2){0u, 0u};
                if (tid < 384 && sq >= 0 && sq < S) wb[q] = *(const u32x2*)(proj + (size_t)(t0 - 1 + row) * PLD + C_MW + c4 * 4);
            }
#pragma unroll
            for (int q = 0; q < 6; ++q) { const int idx = tid + q * NTHREADS, i = idx / 96, cc = (idx % 96) * 4; vb[q] = *(const u32x2*)(proj + (size_t)(t0 + i) * PLD + C_MW + 2 * MW + cc); }
            if (tid < 384) {
#pragma unroll
                for (int q = 0; q < 17; ++q) *(u32x2*)(winb + (2 * q + rsel) * 768 + c4 * 4) = wb[q];
            }
#pragma unroll
            for (int q = 0; q < 6; ++q) { const int idx = tid + q * NTHREADS, i = idx / 96, cc = (idx % 96) * 4; const u32x2 v = vb[q];
                tv[(cc + 0) * TOK + i] = (bf16_t)(v.x & 0xffffu); tv[(cc + 1) * TOK + i] = (bf16_t)(v.x >> 16); tv[(cc + 2) * TOK + i] = (bf16_t)(v.y & 0xffffu); tv[(cc + 3) * TOK + i] = (bf16_t)(v.y >> 16); }
        }
        for (int idx = tid; idx < TOK * 24; idx += NTHREADS) {
            const int i = idx / 24, gi = idx % 24, t = t0 + i;
            const int isf = gi / 12, dir = (gi / 6) & 1, h = gi % 6;
            const float gg = projg[(size_t)t * 256 + (3456 - (PLD - 256)) + gi] + gate_b[gi];
            if (isf) LF[((size_t)dir * T + t) * MH + h] = -softplusf_(-gg); else IG[((size_t)dir * T + t) * MH + h] = gg;
        }
        __syncthreads();
        int tcv = tid; PIN_V(tcv);
#pragma unroll 4
        for (int q = 0; q < 48; ++q) {
            const int idx = tcv + q * NTHREADS, i = idx / 768, c = idx % 768, t = t0 + i;
            const bf16_t* w_ = winb + i * 768 + c;
            float y = conv_b[c] + bf_lo((unsigned)w_[0]) * conv_w[c] + bf_lo((unsigned)w_[768]) * conv_w[768 + c] + bf_lo((unsigned)w_[1536]) * conv_w[2 * 768 + c];
            y = y * sigmoidf_(y);
            if (c < MW) MQB[(size_t)t * MW + c] = (bf16_t)f2bf(y);
            else { const bf16_t kb = (bf16_t)f2bf(y * 0.125f); MKB[(size_t)t * MW + (c - MW)] = kb; tk[(c - MW) * TOK + i] = kb; }
        }
        __syncthreads();
#pragma unroll
        for (int q = 0; q < 6; ++q) {
            const int idx = tid + q * NTHREADS, pc = idx & 3, c = (idx >> 2) % MW, which = idx / (4 * MW);
            const u32x4 val = *(const u32x4*)((which ? tv : tk) + c * TOK + pc * 8);
            bf16_t* dst = (which ? VT : KT) + ((size_t)(bb * MH) * 64 + c) * S + s0 + pc * 8;
            *(u32x4*)dst = val;
        }
    }
    __syncthreads();
}

__device__ __forceinline__ void phase_gmlp_mix(const Params& P, int l, unsigned char* smem, int wv, int bid, int nb) {
    PIN_S(bid); PIN_S(nb);
    ParamsPtr pp = PARAMS_PTR(P); PIN_S(pp); unsigned char* ws = pp->ws;
    const float* UG = (const float*)(ws + O_UG); const bf16_t* VNT = (const bf16_t*)(ws + O_VNT); bf16_t* GRP = (bf16_t*)(ws + O_GRP);
    const bf16_t* WSB = (const bf16_t*)(ws + O_WSB) + (size_t)l * GH * CH * CH; const float* gbs = pp->in[5] + (size_t)l * GH * CH;
    const int tid = phase_tid(wv), lane = tid & 63, wave = tid >> 6, col = lane & 15, g = lane >> 4;
    for (int u = bid; u < NB * NCH * GH; u += nb) {
        const int h = u % GH, c = (u / GH) % NCH, b = u / (GH * NCH);
        const int tok0 = b * S + c * CH;
        const bf16_t* wb = WSB + (size_t)h * CH * CH + (size_t)(wave * 16 + col) * CH + 8 * g;
        const bf16_t* vb = VNT + ((size_t)b * GW + h * 64 + col) * S + (size_t)c * CH + 8 * g;
        f32x4 acc[4];
#pragma unroll
        for (int et = 0; et < 4; ++et) acc[et] = (f32x4){0.f, 0.f, 0.f, 0.f};
#pragma unroll
        for (int ks = 0; ks < 4; ++ks) {
            const bf16x8 af = *(const bf16x8*)(wb + ks * 32);
#pragma unroll
            for (int et = 0; et < 4; ++et) acc[et] = MFMA16(af, *(const bf16x8*)(vb + (size_t)et * 16 * S + ks * 32), acc[et]);
        }
#pragma unroll
        for (int r = 0; r < 4; ++r) {
            const int p = wave * 16 + 4 * g + r; const size_t t = (size_t)(tok0 + p); const float bsv = gbs[h * CH + p];
#pragma unroll
            for (int et = 0; et < 4; ++et) { const int ch = h * 64 + et * 16 + col; GRP[t * D + ch] = (bf16_t)f2bf(UG[t * GW + ch] * (acc[et][r] + bsv)); }
        }
    }
}

constexpr int SC_STEPS = 16;
constexpr int SC_BUF = SC_STEPS * 6 * 64;
__device__ __forceinline__ void phase_rwkv_scan(const Params& P, int l, unsigned char* smem, int wv, int bid, int nb) {
    PIN_S(bid); PIN_S(nb);
    ParamsPtr pp = PARAMS_PTR(P); PIN_S(pp); unsigned char* ws = pp->ws;
    const float* RR = (const float*)(ws + O_RR); const float* VV = (const float*)(ws + O_VV); const float* KK = (const float*)(ws + O_KK);
    const float* DEC = (const float*)(ws + O_DEC); const float* KD = (const float*)(ws + O_KD); const float* ICLR = (const float*)(ws + O_ICLR);
    float* SCAN = (float*)(ws + O_SCAN); const float* BRKR = (const float*)(ws + O_BRKR);
    const int tid = phase_tid(wv), lane = tid & 63, wave = tid >> 6, rl = (lane >> 4) & 1, kq = (lane & 15) | ((lane >> 5) << 4);
    float* buf = (float*)smem;
    float* scal = buf + 2 * SC_BUF;
    float* outb = scal + 2 * SC_STEPS * 2;
    typedef float f32x2 __attribute__((ext_vector_type(2)));
    for (int u = bid; u < 2 * NB * RH * 4; u += nb) {
        const int qt = u & 3, h = (u >> 2) % RH, b = (u / (4 * RH)) % NB, d = u / (4 * RH * NB);
        const size_t doff = (size_t)d * T * RW;
        float s0 = 0.f, s1 = 0.f;
        float pw[2], pa[2], pb[2], pk[2], pr[2], pv[2], psc = 0.f;
#define SC_LOAD(c) do { _Pragma("unroll") for (int i = 0; i < 2; ++i) { const int idx = tid + NTHREADS * i, st = idx >> 6, k = idx & 63; const int tau = (c) * SC_STEPS + st, sq = d ? S - 1 - tau : tau; \
            const size_t o = (size_t)(b * S + sq) * RW + h * 64 + k; \
            pw[i] = DEC[doff + o]; pa[i] = KK[o]; pb[i] = ICLR[doff + o]; pk[i] = KD[doff + o]; pr[i] = RR[o]; pv[i] = VV[o]; }     \
            if (tid < 2 * SC_STEPS) { const int tau = (c) * SC_STEPS + (tid >> 1), sq = d ? S - 1 - tau : tau; psc = BRKR[((size_t)(d * T + b * S + sq) * RH + h) * 2 + (tid & 1)]; } } while (0)
#define SC_WRITE(c) do { float* B_ = buf + ((c) & 1) * SC_BUF; _Pragma("unroll") for (int i = 0; i < 2; ++i) { const int idx = tid + NTHREADS * i, st = idx >> 6, k = idx & 63; \
            float* q_ = B_ + st * 384 + k; q_[0] = pw[i]; q_[64] = -pa[i]; q_[128] = pa[i] * pb[i]; q_[192] = pk[i]; q_[256] = pw[i] * pr[i]; q_[320] = pv[i]; } \
            if (tid < 2 * SC_STEPS) scal[((c) & 1) * SC_STEPS * 2 + tid] = psc; } while (0)
        __syncthreads();
        SC_LOAD(0); SC_WRITE(0);
        __syncthreads();
        const int row = qt * 16 + wave * 2 + rl;
        for (int c = 0; c < S / SC_STEPS; ++c) {
            const bool more = (c + 1) < S / SC_STEPS;
            if (more) SC_LOAD(c + 1);
            const float* B = buf + (c & 1) * SC_BUF; const float* sc = scal + (c & 1) * SC_STEPS * 2; float* ob = outb + (c & 1) * SC_STEPS * 16;
            float outs[SC_STEPS];
            f32x2 w2 = *(const f32x2*)(B + 2 * kq), a2 = *(const f32x2*)(B + 64 + 2 * kq), b2 = *(const f32x2*)(B + 128 + 2 * kq);
            f32x2 k2 = *(const f32x2*)(B + 192 + 2 * kq), wr2 = *(const f32x2*)(B + 256 + 2 * kq);
            float v = B[320 + row]; float br = sc[0], kr = sc[1];
#pragma unroll
            for (int st = 0; st < SC_STEPS; ++st) {
                const int sn = st + 1 < SC_STEPS ? st + 1 : st;
                const float* q = B + sn * 384;
                const f32x2 nw2 = *(const f32x2*)(q + 2 * kq), na2 = *(const f32x2*)(q + 64 + 2 * kq), nb2 = *(const f32x2*)(q + 128 + 2 * kq);
                const f32x2 nk2 = *(const f32x2*)(q + 192 + 2 * kq), nwr2 = *(const f32x2*)(q + 256 + 2 * kq);
                const float nv = q[320 + row], nbr = sc[sn * 2], nkr = sc[sn * 2 + 1];
                SCHED_BAR();
                float sa = s0 * a2.x + s1 * a2.y;
                float po = s0 * wr2.x + s1 * wr2.y;
                sa = row32_sum(sa); po = row32_sum(po);
                outs[st] = po + sa * br + v * kr;
                s0 = s0 * w2.x + (sa * b2.x + v * k2.x); s1 = s1 * w2.y + (sa * b2.y + v * k2.y);
                SCHED_BAR();
                w2 = nw2; a2 = na2; b2 = nb2; k2 = nk2; wr2 = nwr2; v = nv; br = nbr; kr = nkr;
            }
            if (kq == 0) {
#pragma unroll
                for (int st = 0; st < SC_STEPS; ++st) ob[st * 16 + wave * 2 + rl] = outs[st];
            }
            if (more) SC_WRITE(c + 1);
            __syncthreads();
            if (tid < 16 * SC_STEPS) {
                const int st = tid >> 4, r = tid & 15, tau = c * SC_STEPS + st, sq = d ? S - 1 - tau : tau;
                SCAN[doff + (size_t)(b * S + sq) * RW + h * 64 + qt * 16 + r] = ob[st * 16 + r];
            }
        }
#undef SC_LOAD
#undef SC_WRITE
    }
    __syncthreads();
}

constexpr int RST = 72;
constexpr int RARR = 64 * RST;
__device__ __forceinline__ f32x4 tile_nt(const bf16_t* Aa, int ta, const bf16_t* Ba, int tb, f32x4 acc, int col, int g) {
#pragma unroll
    for (int ks = 0; ks < 2; ++ks) {
        const bf16x8 af = *(const bf16x8*)(Aa + (ta * 16 + col) * RST + ks * 32 + 8 * g);
        const bf16x8 bfr = *(const bf16x8*)(Ba + (tb * 16 + col) * RST + ks * 32 + 8 * g);
        acc = MFMA16(af, bfr, acc);
    }
    return acc;
}
__device__ __forceinline__ void phase_rwkv_pre(const Params& P, int l, unsigned char* smem, int wv) {
    ParamsPtr pp = PARAMS_PTR(P); PIN_S(pp); unsigned char* ws = pp->ws; int bidx = (int)blockIdx.x, gdim = (int)gridDim.x; PIN_S(bidx); PIN_S(gdim);
    const u32x4* RK7 = (const u32x4*)(ws + O_RK7);
    const float* LWG = (const float*)(ws + O_LW);
    bf16_t* Qg = (bf16_t*)(ws + O_RQ); bf16_t* Ag = (bf16_t*)(ws + O_RA); bf16_t* Hg = (bf16_t*)(ws + O_RH); bf16_t* Gg = (bf16_t*)(ws + O_RG);
    const int tid0 = phase_tid(wv);
#define RW_STAGE_VARS int tid = tid0; PIN_V(tid); const int lane = tid & 63, wave = tid >> 6, col = lane & 15, g = lane >> 4; (void)lane; (void)wave; (void)col; (void)g;
    bf16_t* At = (bf16_t*)smem; bf16_t* Bt = At + RARR; bf16_t* Kt = Bt + RARR; bf16_t* Rt = Kt + RARR;
    bf16_t* BtT = Rt + RARR; bf16_t* KtT = BtT + RARR; bf16_t* VT = KtT + RARR;
    bf16_t* Lak = VT + RARR; bf16_t* Mrb = Lak + RARR; bf16_t* Mrk = Mrb + RARR; bf16_t* YT = Mrk + RARR; bf16_t* W2T = YT + RARR;
    bf16_t* Lbo = W2T + RARR;
    float* LabT = (float*)(Lbo + RARR);
    float* Xs = LabT + 4096;
    float* Pb = Xs + 4096;
    float* segs = Pb + 2048;
    float* PC = segs + 512;
    float plw[8]; u32x4 prec[8];
#define RW_LOAD(uu) do { const int c_ = (uu) % RNC, h_ = ((uu) / RNC) % RH, b_ = ((uu) / (RNC * RH)) % NB, d_ = (uu) / (RNC * RH * NB); const size_t doff_ = (size_t)d_ * T * RW; \
        const int ch_ = tid0 & 63, sg_ = tid0 >> 6; _Pragma("unroll") for (int j = 0; j < 8; ++j) { const int tau = c_ * RC + sg_ * 8 + j, sq = d_ ? S - 1 - tau : tau; const size_t o = (size_t)(b_ * S + sq) * RW + h_ * 64 + ch_; \
        plw[j] = LWG[doff_ + o]; prec[j] = RK7[o]; } } while (0)
    if (bidx < RUN) RW_LOAD(bidx);
    for (int u = bidx; u < RUN; u += gdim) {
        const int c = u % RNC, h = (u / RNC) % RH, b = (u / (RNC * RH)) % NB, d = u / (RNC * RH * NB);
        (void)c; (void)h; (void)b; (void)d;
        __syncthreads();
        {
            RW_STAGE_VARS
            const int ch = tid & 63, sg = tid >> 6;
            float lw[8]; unsigned kk[8], bq_[8], kd[8], rr[8], vv[8];
#pragma unroll
            for (int j = 0; j < 8; ++j) { lw[j] = plw[j]; kk[j] = prec[j].y & 0xffffu; bq_[j] = d ? (prec[j].z >> 16) : (prec[j].z & 0xffffu); kd[j] = d ? (prec[j].w >> 16) : (prec[j].w & 0xffffu); rr[j] = prec[j].x & 0xffffu; vv[j] = prec[j].x >> 16; }
            if (u + gdim < RUN) RW_LOAD(u + gdim);
            float run = 0.f;
#pragma unroll
            for (int j = 0; j < 8; ++j) { run += lw[j]; lw[j] = run; }
            segs[sg * 64 + ch] = run;
            __syncthreads();
            float off = 0.f;
            for (int q = 0; q < sg; ++q) off += segs[q * 64 + ch];
            u32x4 pbt, pkt, pvt; unsigned tb[8], tk[8], tvv[8];
            float prev = off;
#pragma unroll
            for (int j = 0; j < 8; ++j) {
                const int t = sg * 8 + j; const float cl = off + lw[j];
                const float ep = fexp(prev), en = fexp(-cl), epc = fexp(cl);
                const unsigned a_ = f2bf(-bf_lo(kk[j]) * ep), b_ = f2bf(bf_lo(bq_[j]) * en), k_ = f2bf(bf_lo(kd[j]) * en), r_ = f2bf(bf_lo(rr[j]) * epc), v_ = vv[j];
                At[t * RST + ch] = (bf16_t)a_; Bt[t * RST + ch] = (bf16_t)b_; Kt[t * RST + ch] = (bf16_t)k_; Rt[t * RST + ch] = (bf16_t)r_;
                tb[j] = b_; tk[j] = k_; tvv[j] = v_;
                prev = cl;
            }
            if (sg == 7) PC[ch] = fexp(prev);
            pbt.x = tb[0] | (tb[1] << 16); pbt.y = tb[2] | (tb[3] << 16); pbt.z = tb[4] | (tb[5] << 16); pbt.w = tb[6] | (tb[7] << 16);
            pkt.x = tk[0] | (tk[1] << 16); pkt.y = tk[2] | (tk[3] << 16); pkt.z = tk[4] | (tk[5] << 16); pkt.w = tk[6] | (tk[7] << 16);
            pvt.x = tvv[0] | (tvv[1] << 16); pvt.y = tvv[2] | (tvv[3] << 16); pvt.z = tvv[4] | (tvv[5] << 16); pvt.w = tvv[6] | (tvv[7] << 16);
            *(u32x4*)(BtT + ch * RST + sg * 8) = pbt; *(u32x4*)(KtT + ch * RST + sg * 8) = pkt; *(u32x4*)(VT + ch * RST + sg * 8) = pvt;
            for (int z_ = tid; z_ < 2 * RARR / 8; z_ += NTHREADS) ((u32x4*)YT)[z_] = (u32x4){0u, 0u, 0u, 0u};
        }
        __syncthreads();
        {
            RW_STAGE_VARS
            const int m = wave >> 1;
            const bf16_t* Ym = (m == 0 || m == 2) ? Bt : Kt; const bf16_t* Xm = (m < 2) ? At : Rt;
#pragma unroll 1
            for (int q = 0; q < 8; ++q) {
                const int tix = (wave & 1) * 8 + q, it = tix >> 2, tt = tix & 3;
                f32x4 acc = (f32x4){0.f, 0.f, 0.f, 0.f};
                if (it <= tt) acc = tile_nt(Ym, it, Xm, tt, acc, col, g);
                const int t = tt * 16 + col, i0 = it * 16 + 4 * g;
                float o4[4];
#pragma unroll
                for (int r = 0; r < 4; ++r) { const int i = i0 + r; const bool ok = m < 2 ? (i < t) : (i <= t); o4[r] = ok ? acc[r] : 0.f; }
                if (m == 0) {
#pragma unroll
                    for (int r = 0; r < 4; ++r) LabT[(i0 + r) * 64 + t] = o4[r];
                    const bool offd = it < tt;
                    u32x2 w2; w2.x = offd ? pk2(o4[0], o4[1]) : 0u; w2.y = offd ? pk2(o4[2], o4[3]) : 0u; *(u32x2*)(Lbo + t * RST + i0) = w2;
                }
                else { bf16_t* dst = (m == 1 ? Lak : (m == 2 ? Mrb : Mrk)) + t * RST + i0; u32x2 w2; w2.x = pk2(o4[0], o4[1]); w2.y = pk2(o4[2], o4[3]); *(u32x2*)dst = w2; }
            }
        }
        __syncthreads();
        {
            RW_STAGE_VARS
#pragma unroll
            for (int q = 0; q < 2; ++q) {
                const int tix = wave * 2 + q, tt = tix >> 2, et = tix & 3;
                f32x4 acc = (f32x4){0.f, 0.f, 0.f, 0.f};
                acc = tile_nt(Lak, tt, VT, et, acc, col, g);
#pragma unroll
                for (int r = 0; r < 4; ++r) Xs[(tt * 16 + 4 * g + r) * 64 + et * 16 + col] = acc[r];
            }
        }
        __syncthreads();
        {
            RW_STAGE_VARS
#pragma unroll 1
            for (int bb = 0; bb < 4; ++bb) {
                if (bb > 0) {
                    const bf16_t* Zt = (wave < 4 ? YT : W2T) + ((wave & 3) * 16 + col) * RST + 8 * g;
                    const bf16_t* La = Lbo + (16 * bb + col) * RST + 8 * g;
                    f32x4 acc = (f32x4){0.f, 0.f, 0.f, 0.f};
                    acc = MFMA16(*(const bf16x8*)La, *(const bf16x8*)Zt, acc);
                    if (bb > 2) acc = MFMA16(*(const bf16x8*)(La + 32), *(const bf16x8*)(Zt + 32), acc);
#pragma unroll
                    for (int r = 0; r < 4; ++r) Pb[(4 * g + r) * 128 + wave * 16 + col] = acc[r];
                }
                __syncthreads();
                if (wave < 2) {
                    float acc[16];
                    if (wave == 0) {
#pragma unroll
                        for (int r = 0; r < 16; ++r) acc[r] = bf_lo((unsigned)At[(16 * bb + r) * RST + lane]);
                    } else {
#pragma unroll
                        for (int r = 0; r < 16; ++r) acc[r] = Xs[(16 * bb + r) * 64 + lane];
                    }
                    if (bb > 0) {
#pragma unroll
                        for (int r = 0; r < 16; ++r) acc[r] += Pb[r * 128 + wave * 64 + lane];
                    }
                    const float* dp = LabT + (16 * bb) * 64 + 16 * bb;
#pragma unroll
                    for (int r = 1; r < 16; ++r)
#pragma unroll
                        for (int r2 = 0; r2 < r; ++r2) acc[r] += dp[r2 * 64 + r] * acc[r2];
                    bf16_t* dst = (wave == 0 ? YT : W2T) + lane * RST;
                    u32x4 w0, w1;
                    w0.x = pk2(acc[0], acc[1]); w0.y = pk2(acc[2], acc[3]); w0.z = pk2(acc[4], acc[5]); w0.w = pk2(acc[6], acc[7]);
                    w1.x = pk2(acc[8], acc[9]); w1.y = pk2(acc[10], acc[11]); w1.z = pk2(acc[12], acc[13]); w1.w = pk2(acc[14], acc[15]);
                    *(u32x4*)(dst + 16 * bb) = w0; *(u32x4*)(dst + 16 * bb + 8) = w1;
                }
                __syncthreads();
            }
        }
        __syncthreads();
        {
            RW_STAGE_VARS
            const int ty = wave >> 1;
#pragma unroll 1
            for (int q = 0; q < 8; ++q) {
                const int tix = (wave & 1) * 8 + q, ra = tix >> 2, cb = tix & 3;
                f32x4 acc = (f32x4){0.f, 0.f, 0.f, 0.f};
                if (ty == 0) {
                    acc = tile_nt(YT, ra, Mrb, cb, acc, col, g);
                    const u32x2 rt2 = *(const u32x2*)(Rt + (cb * 16 + col) * RST + ra * 16 + 4 * g);
                    u32x2 qb2; qb2.x = pk2(acc[0] + bf_lo(rt2.x), acc[1] + bf_hi(rt2.x)); qb2.y = pk2(acc[2] + bf_lo(rt2.y), acc[3] + bf_hi(rt2.y));
                    *(u32x2*)(Qg + (size_t)u * 4096 + (tix * 64 + lane) * 4) = qb2;
                } else if (ty == 1) {
                    acc = tile_nt(Mrb, ra, W2T, cb, acc, col, g); acc = tile_nt(Mrk, ra, VT, cb, acc, col, g);
                    { u32x2 hb; hb.x = pk2(acc[0], acc[1]); hb.y = pk2(acc[2], acc[3]); *(u32x2*)(Hg + (size_t)u * 4096 + (tix * 64 + lane) * 4) = hb; }
                } else if (ty == 2) {
                    acc = tile_nt(YT, ra, BtT, cb, acc, col, g);
                    const float pc = PC[cb * 16 + col]; const int k1 = cb * 16 + col;
                    float a4[4];
#pragma unroll
                    for (int r = 0; r < 4; ++r) a4[r] = pc * (acc[r] + ((ra * 16 + 4 * g + r) == k1 ? 1.0f : 0.f));
                    u32x2 ab2; ab2.x = pk2(a4[0], a4[1]); ab2.y = pk2(a4[2], a4[3]);
                    *(u32x2*)(Ag + (size_t)u * 4096 + ((((ra >> 1) * 4 + cb) * 64 + lane) * 8 + (ra & 1) * 4)) = ab2;
                } else {
                    acc = tile_nt(BtT, ra, W2T, cb, acc, col, g); acc = tile_nt(KtT, ra, VT, cb, acc, col, g);
#pragma unroll
                    for (int r = 0; r < 4; ++r) acc[r] *= PC[ra * 16 + 4 * g + r];
                    { u32x2 gb2; gb2.x = pk2(acc[0], acc[1]); gb2.y = pk2(acc[2], acc[3]); *(u32x2*)(Gg + (size_t)u * 4096 + (tix * 64 + lane) * 4) = gb2; }
                }
            }
        }
    }
    __syncthreads();
#undef RW_STAGE_VARS
#undef RW_LOAD
}
constexpr int RSEQ_WGS = 2 * NB * RH;
__device__ __forceinline__ void phase_rwkv_seq(const Params& P, int l, unsigned char* smem, int wv) {
    ParamsPtr pp = PARAMS_PTR(P); PIN_S(pp); unsigned char* ws = pp->ws; int bidx = (int)blockIdx.x, gdim = (int)gridDim.x; PIN_S(bidx); PIN_S(gdim);
    const bf16_t* Ag = (const bf16_t*)(ws + O_RA); const bf16_t* Gg = (const bf16_t*)(ws + O_RG); bf16_t* Sg = (bf16_t*)(ws + O_RS);
    const int tid = phase_tid(wv), lane = tid & 63, wave = tid >> 6, col = lane & 15, g = lane >> 4;
    if (wave >= 4) return;
    const int eq = wave;
    for (int ch = bidx; ch < RSEQ_WGS; ch += gdim) {
        f32x4 acc[4];
#pragma unroll
        for (int a_ = 0; a_ < 4; ++a_) acc[a_] = (f32x4){0.f, 0.f, 0.f, 0.f};
        u32x4 a0[4][2], a1[4][2], a2[4][2], a3[4][2]; u32x2 g0[4], g1[4], g2[4], g3[4];
        const unsigned aoff = (unsigned)(col * 64 + 4 * g), goff = (unsigned)(lane * 4), aoff8 = (unsigned)(lane * 8);
#define RS_LOAD(cc, AF, GQ) do { const int c_ = (cc) < RNC ? (cc) : RNC - 1; const bf16_t* ab_ = Ag + (size_t)(ch * RNC + c_) * 4096; const bf16_t* gb_ = Gg + (size_t)(ch * RNC + c_) * 4096 + eq * 256; \
            _Pragma("unroll") for (int ra = 0; ra < 4; ++ra) _Pragma("unroll") for (int p = 0; p < 2; ++p) AF[ra][p] = *(const u32x4*)(ab_ + ((p * 4 + ra) * 512) + aoff8); \
            _Pragma("unroll") for (int ra = 0; ra < 4; ++ra) GQ[ra] = *(const u32x2*)(gb_ + (ra * 1024) + goff); } while (0)
#define RS_STEP(c, AF, GQ) do { if (RNC % 4 == 0 || (c) < RNC) { bf16_t* sb_ = Sg + (size_t)(ch * RNC + (c)) * 4096 + eq * 1024; \
            _Pragma("unroll") for (int ra = 0; ra < 4; ++ra) { u32x2 w2; w2.x = pk2(acc[ra][0], acc[ra][1]); w2.y = pk2(acc[ra][2], acc[ra][3]); *(u32x2*)(sb_ + (ra * 16) + aoff) = w2; } \
            bf16x8 bq[2]; _Pragma("unroll") for (int p = 0; p < 2; ++p) bq[p] = cvt8(acc[2 * p], acc[2 * p + 1]); \
            _Pragma("unroll") for (int ra = 0; ra < 4; ++ra) acc[ra] = (f32x4){bf_lo(GQ[ra].x), bf_hi(GQ[ra].x), bf_lo(GQ[ra].y), bf_hi(GQ[ra].y)}; \
            _Pragma("unroll") for (int ra = 0; ra < 4; ++ra) _Pragma("unroll") for (int p = 0; p < 2; ++p) acc[ra] = MFMA16(__builtin_bit_cast(bf16x8, AF[ra][p]), bq[p], acc[ra]); \
            RS_LOAD((c) + 4, AF, GQ); } } while (0)
        RS_LOAD(0, a0, g0); RS_LOAD(1, a1, g1); RS_LOAD(2, a2, g2); RS_LOAD(3, a3, g3);
#pragma unroll 1
        for (int c = 0; c < RNC; c += 4) { RS_STEP(c, a0, g0); RS_STEP(c + 1, a1, g1); RS_STEP(c + 2, a2, g2); RS_STEP(c + 3, a3, g3); }
#undef RS_LOAD
#undef RS_STEP
    }
}
__device__ __forceinline__ void phase_rwkv_out(const Params& P, int l, unsigned char* smem, int wv) {
    ParamsPtr pp = PARAMS_PTR(P); PIN_S(pp); unsigned char* ws = pp->ws; int bidx = (int)blockIdx.x, gdim = (int)gridDim.x; PIN_S(bidx); PIN_S(gdim);
    const bf16_t* Qg = (const bf16_t*)(ws + O_RQ); const bf16_t* Sg = (const bf16_t*)(ws + O_RS); const bf16_t* Hg = (const bf16_t*)(ws + O_RH);
    const bf16_t* VB = (const bf16_t*)(ws + O_VB); const float* GATE = (const float*)(ws + O_GATE); const float* BONUS = (const float*)(ws + O_BONUS);
    bf16_t* GRP = (bf16_t*)(ws + O_GRP);
    const float* rln_g = pp->in[15] + (size_t)l * RW; const float* rln_b = pp->in[16] + (size_t)l * RW;
    const int tid = phase_tid(wv), lane = tid & 63, wave = tid >> 6, col = lane & 15, g = lane >> 4;
    for (int pu = bidx * NWAVES + wave; pu < NB * RH * RNC; pu += gdim * NWAVES) {
        const int c = pu % RNC, h = (pu / RNC) % RH, b = pu / (RNC * RH);
        f32x4 o[2][4][4];
#pragma unroll
        for (int d = 0; d < 2; ++d) {
            const int u = ((d * NB + b) * RH + h) * RNC + (d ? RNC - 1 - c : c);
            const size_t ub = (size_t)u * 4096;
            bf16x8 qa[4][2], sb[4][2];
#pragma unroll
            for (int q = 0; q < 4; ++q)
#pragma unroll
                for (int ks = 0; ks < 2; ++ks) {
                    const u32x2 q0 = *(const u32x2*)(Qg + ub + ((2 * ks * 4 + q) * 64 + lane) * 4), q1 = *(const u32x2*)(Qg + ub + (((2 * ks + 1) * 4 + q) * 64 + lane) * 4);
                    qa[q][ks] = __builtin_bit_cast(bf16x8, (u32x4){q0.x, q0.y, q1.x, q1.y});
                    const bf16_t* sp_ = Sg + ub + (q * 16 + col) * 64 + ks * 32 + 4 * g;
                    const u32x2 s0_ = *(const u32x2*)sp_, s1_ = *(const u32x2*)(sp_ + 16);
                    sb[q][ks] = __builtin_bit_cast(bf16x8, (u32x4){s0_.x, s0_.y, s1_.x, s1_.y});
                }
#pragma unroll
            for (int tt = 0; tt < 4; ++tt)
#pragma unroll
                for (int et = 0; et < 4; ++et) {
                    const u32x2 hb = *(const u32x2*)(Hg + ub + ((tt * 4 + et) * 64 + lane) * 4);
                    f32x4 acc = (f32x4){bf_lo(hb.x), bf_hi(hb.x), bf_lo(hb.y), bf_hi(hb.y)};
#pragma unroll
                    for (int ks = 0; ks < 2; ++ks) acc = MFMA16(qa[tt][ks], sb[et][ks], acc);
                    o[d][tt][et] = acc;
                }
        }
        const int src = (3 - g) * 16 + col;
#pragma unroll
        for (int tt = 0; tt < 4; ++tt)
#pragma unroll
            for (int et = 0; et < 4; ++et)
#pragma unroll
                for (int r = 0; r < 4; ++r) o[0][tt][et][r] += SHL(o[1][3 - tt][et][3 - r], src);
        float* tile = (float*)smem + wave * (64 * 68);
        WAVE_SYNC();
#pragma unroll
        for (int tt = 0; tt < 4; ++tt)
#pragma unroll
            for (int et = 0; et < 4; ++et)
#pragma unroll
                for (int r = 0; r < 4; ++r) tile[(tt * 16 + 4 * g + r) * 68 + et * 16 + col] = o[0][tt][et][r];
        WAVE_SYNC();
        {
            const int c4 = (lane & 15) * 4, ch = h * 64 + c4;
            const f32x4 lg = *(const f32x4*)(rln_g + ch), lb = *(const f32x4*)(rln_b + ch);
#pragma unroll 1
            for (int qb = 0; qb < 2; ++qb) {
                f32x4 gt_[8]; u32x2 vb_[8]; float bo_[8];
#pragma unroll
                for (int q8 = 0; q8 < 8; ++q8) {
                    const size_t t = (size_t)(b * S + c * RC + (qb * 8 + q8) * 4 + (lane >> 4));
                    gt_[q8] = *(const f32x4*)(GATE + t * RW + ch); vb_[q8] = *(const u32x2*)(VB + t * RW + ch); bo_[q8] = BONUS[t * RH + h];
                }
#pragma unroll
                for (int q8 = 0; q8 < 8; ++q8) {
                    const int tl = (qb * 8 + q8) * 4 + (lane >> 4);
                    const size_t t = (size_t)(b * S + c * RC + tl);
                    const f32x4 x = *(const f32x4*)(tile + tl * 68 + c4);
                    const float mean = row16_sum((x.x + x.y) + (x.z + x.w)) * (1.0f / 64.0f);
                    const f32x4 dl = x - mean;
                    const float var = row16_sum((dl.x * dl.x + dl.y * dl.y) + (dl.z * dl.z + dl.w * dl.w)) * (1.0f / 64.0f);
                    const float rstd = 1.0f / sqrtf(var + GN_EPS);
                    f32x4 y = dl * rstd * lg + lb;
                    y.x += bo_[q8] * bf_lo(vb_[q8].x); y.y += bo_[q8] * bf_hi(vb_[q8].x); y.z += bo_[q8] * bf_lo(vb_[q8].y); y.w += bo_[q8] * bf_hi(vb_[q8].y);
                    y = y * gt_[q8];
                    u32x2 ob; ob.x = pk2(y.x, y.y); ob.y = pk2(y.z, y.w);
                    *(u32x2*)(GRP + t * D + GW + ch) = ob;
                }
            }
        }
    }
    __syncthreads();
}

__device__ __forceinline__ void phase_mlstm_local(const Params& P, int l, unsigned char* smem, int wv, int bid, int nb) {
    PIN_S(bid); PIN_S(nb);
    ParamsPtr pp = PARAMS_PTR(P); PIN_S(pp); unsigned char* ws = pp->ws;
    const bf16_t* KT = (const bf16_t*)(ws + O_KT); const bf16_t* VT = (const bf16_t*)(ws + O_VT);
    const float* IG = (const float*)(ws + O_IG); const float* LF = (const float*)(ws + O_LF);
    float* CL = (float*)(ws + O_CL); float* NLb = (float*)(ws + O_NL); float* ML = (float*)(ws + O_ML); float* BL = (float*)(ws + O_BL);
    float* GVT = (float*)(ws + O_GVT); float* PMX = (float*)(ws + O_PMX); float* BCT = (float*)(ws + O_BCT);
    const int tid = phase_tid(wv), lane = tid & 63, wave = tid >> 6, col = lane & 15, g = lane >> 4;
    float* wts = (float*)smem + wave * 128;
    for (int u = bid * NWAVES + wave; u < 2 * NB * MH * NCH; u += nb * NWAVES) {
        const int c = u % NCH, h = (u / NCH) % MH, p = u / (NCH * MH), d = p / NB, b = p % NB;
        const int tc = d ? NCH - 1 - c : c, tok0 = b * S + tc * CH;
        const int i0 = d ? 127 - 2 * lane : 2 * lane, i1 = d ? i0 - 1 : i0 + 1;
        const size_t g0 = ((size_t)d * T + tok0 + i0) * MH + h, g1 = ((size_t)d * T + tok0 + i1) * MH + h;
        const float lf0 = LF[g0], lf1 = LF[g1], ig0 = IG[g0], ig1 = IG[g1];
        const float c1 = lf0 + lf1;
        float incl = c1;
#pragma unroll
        for (int o = 1; o < 64; o <<= 1) { const float tq = SHUP(incl, o, lane); if (lane >= o) incl += tq; }
        const float excl = incl - c1, bc0 = excl + lf0, bc1 = incl;
        const float blast = RDL(incl, 63);
        const float gv0 = ig0 - bc0, gv1 = ig1 - bc1, pl1 = fmaxf(gv0, gv1);
        float mincl = pl1;
#pragma unroll
        for (int o = 1; o < 64; o <<= 1) { const float tq = SHUP(mincl, o, lane); if (lane >= o) mincl = fmaxf(mincl, tq); }
        float mexcl = SHUP(mincl, 1, lane); if (lane == 0) mexcl = -INFINITY;
        const float pm0 = fmaxf(mexcl, gv0), pm1 = mincl;
        const float mloc = blast + RDL(mincl, 63);
        WAVE_SYNC();
        wts[i0] = fexp(blast + gv0 - mloc); wts[i1] = fexp(blast + gv1 - mloc);
        GVT[g0] = gv0; GVT[g1] = gv1; PMX[g0] = pm0; PMX[g1] = pm1; BCT[g0] = bc0; BCT[g1] = bc1;
        if (lane == 0) { ML[u] = mloc; BL[u] = blast; }
        WAVE_SYNC();
        const bf16_t* vbase = VT + ((size_t)(b * MH + h) * 64) * S + (size_t)tc * CH;
        const bf16_t* kbase = KT + ((size_t)(b * MH + h) * 64) * S + (size_t)tc * CH;
        const unsigned loff = (unsigned)(col * S + 8 * g);
        f32x4 acc[4][4];
#pragma unroll
        for (int a_ = 0; a_ < 4; ++a_)
#pragma unroll
            for (int b_ = 0; b_ < 4; ++b_) acc[a_][b_] = (f32x4){0.f, 0.f, 0.f, 0.f};
        float nsum[4] = {0.f, 0.f, 0.f, 0.f};
#pragma unroll 1
        for (int ks = 0; ks < 4; ++ks) {
            const int ii = ks * 32 + 8 * g;
            const f32x4 w0 = *(const f32x4*)(wts + ii), w1 = *(const f32x4*)(wts + ii + 4);
            bf16x8 af[4], bfk[4];
#pragma unroll
            for (int q = 0; q < 4; ++q) af[q] = *(const bf16x8*)(vbase + ((size_t)q * 16 * S + ks * 32) + loff);
#pragma unroll
            for (int q = 0; q < 4; ++q) {
                const u32x4 kr = *(const u32x4*)(kbase + ((size_t)q * 16 * S + ks * 32) + loff);
                f32x4 k0, k1;
                k0.x = bf_lo(kr.x) * w0.x; k0.y = bf_hi(kr.x) * w0.y; k0.z = bf_lo(kr.y) * w0.z; k0.w = bf_hi(kr.y) * w0.w;
                k1.x = bf_lo(kr.z) * w1.x; k1.y = bf_hi(kr.z) * w1.y; k1.z = bf_lo(kr.w) * w1.z; k1.w = bf_hi(kr.w) * w1.w;
                nsum[q] += (k0.x + k0.y) + (k0.z + k0.w) + (k1.x + k1.y) + (k1.z + k1.w);
                bfk[q] = cvt8(k0, k1);
            }
#pragma unroll
            for (int a_ = 0; a_ < 4; ++a_)
#pragma unroll
                for (int b_ = 0; b_ < 4; ++b_) acc[a_][b_] = MFMA16(af[a_], bfk[b_], acc[a_][b_]);
        }
        float* cbase = CL + (size_t)u * 4096;
        const unsigned coff = (unsigned)(4 * g * 64 + col);
#pragma unroll
        for (int b_ = 0; b_ < 4; ++b_) {
#pragma unroll
            for (int a_ = 0; a_ < 4; ++a_)
#pragma unroll
                for (int r = 0; r < 4; ++r) cbase[(a_ * 16 * 64 + r * 64 + b_ * 16) + coff] = acc[a_][b_][r];
            float ns = nsum[b_]; ns += SHX(ns, 16, lane); ns += SHX(ns, 32, lane);
            if (g == 0) NLb[(size_t)u * 64 + b_ * 16 + col] = ns;
        }
    }
    __syncthreads();
}

__device__ __forceinline__ void phase_mlstm_carry(const Params& P, int l, unsigned char* smem, int wv, int bidx, int gdim) {
    ParamsPtr pp = PARAMS_PTR(P); PIN_S(pp); unsigned char* ws = pp->ws; PIN_S(bidx); PIN_S(gdim);
    float* CL = (float*)(ws + O_CL); float* NLb = (float*)(ws + O_NL); const float* ML = (const float*)(ws + O_ML); const float* BL = (const float*)(ws + O_BL);
    float* MIN = (float*)(ws + O_MIN);
    const int total = 2 * NB * MH * 4160;
    const int tid = phase_tid(wv);
    for (int gi = bidx * NTHREADS + tid; gi < total; gi += gdim * NTHREADS) {
        const int ph = gi / 4160, e = gi % 4160;
        float* base_ = e < 4096 ? CL + (size_t)ph * NCH * 4096 + e : NLb + (size_t)ph * NCH * 64 + (e - 4096);
        const int stride = e < 4096 ? 4096 : 64;
        static_assert(NCH <= 32, "carry scan keeps one chunk value per register");
        float loc[NCH], bl[NCH], ml[NCH];
#pragma unroll
        for (int c = 0; c < NCH; ++c) { loc[c] = base_[(size_t)c * stride]; bl[c] = BL[ph * NCH + c]; ml[c] = ML[ph * NCH + c]; }
        float m = 0.f, val = 0.f;
#pragma unroll
        for (int c = 0; c < NCH; ++c) {
            base_[(size_t)c * stride] = val;
            if (e == 0) MIN[ph * NCH + c] = m;
            const float mn = fmaxf(bl[c] + m, ml[c]);
            val = fexp(bl[c] + m - mn) * val + fexp(ml[c] - mn) * loc[c];
            m = mn;
        }
    }
}

__device__ __forceinline__ void phase_mlstm_out(const Params& P, int l, unsigned char* smem, int wv) {
    ParamsPtr pp = PARAMS_PTR(P); PIN_S(pp); unsigned char* ws = pp->ws; int bidx = (int)blockIdx.x, gdim = (int)gridDim.x; PIN_S(bidx); PIN_S(gdim);
    const bf16_t* proj = (const bf16_t*)(ws + O_PROJ);
    const bf16_t* MQB = (const bf16_t*)(ws + O_MQB); const bf16_t* MKB = (const bf16_t*)(ws + O_MKB); const bf16_t* VT = (const bf16_t*)(ws + O_VT);
    const float* GVT = (const float*)(ws + O_GVT); const float* PMX = (const float*)(ws + O_PMX); const float* BCT = (const float*)(ws + O_BCT);
    const float* CL = (const float*)(ws + O_CL); const float* NLb = (const float*)(ws + O_NL); const float* MIN = (const float*)(ws + O_MIN);
    bf16_t* GRP = (bf16_t*)(ws + O_GRP);
    const float* mln_g = pp->in[20] + (size_t)l * MW;
    const int tid = phase_tid(wv), lane = tid & 63, wave = tid >> 6, col = lane & 15, g = lane >> 4;
    constexpr int KP = 72, VP = 136;
    bf16_t* Ks = (bf16_t*)smem;
    bf16_t* Vs = Ks + 128 * KP;
    float* gvs_ = (float*)(Vs + 64 * VP);
    for (int u = bidx; u < NB * MH * NCH; u += gdim) {
        const int tc = u % NCH, h = (u / NCH) % MH, b = u / (NCH * MH);
        const int tok0 = b * S + tc * CH, it = wave * 16 + col;
        __syncthreads();
        {
            u32x4 kb_[2], vb_[2];
#pragma unroll
            for (int q = 0; q < 2; ++q) {
                const int idx = tid + q * NTHREADS;
                kb_[q] = *(const u32x4*)(MKB + (size_t)(tok0 + (idx >> 3)) * MW + h * 64 + (idx & 7) * 8);
                vb_[q] = *(const u32x4*)(VT + ((size_t)(b * MH + h) * 64 + (idx >> 4)) * S + (size_t)tc * CH + (idx & 15) * 8);
            }
            float gq_ = 0.f;
            if (tid < 256) gq_ = GVT[((size_t)(tid >> 7) * T + tok0 + (tid & 127)) * MH + h];
#pragma unroll
            for (int q = 0; q < 2; ++q) {
                const int idx = tid + q * NTHREADS;
                *(u32x4*)(Ks + (idx >> 3) * KP + (idx & 7) * 8) = kb_[q];
                *(u32x4*)(Vs + (idx >> 4) * VP + (idx & 15) * 8) = vb_[q];
            }
            if (tid < 256) gvs_[tid] = gq_;
        }
        __syncthreads();
        const size_t trow = (size_t)(tok0 + it);
        bf16x8 bq[2];
#pragma unroll
        for (int ks = 0; ks < 2; ++ks) bq[ks] = *(const bf16x8*)(MQB + trow * MW + h * 64 + ks * 32 + 8 * g);
        f32x4 hs[4];
#pragma unroll
        for (int et = 0; et < 4; ++et) hs[et] = (f32x4){0.f, 0.f, 0.f, 0.f};
#pragma unroll
        for (int d = 0; d < 2; ++d) {
            const int cd = d ? NCH - 1 - tc : tc;
            const int su = ((d * NB + b) * MH + h) * NCH + cd;
            const size_t gt = ((size_t)d * T + trow) * MH + h;
            const float mst = MIN[su];
            const float mxt = fmaxf(PMX[gt], mst), mt = BCT[gt] + mxt, wint = fexp(mst - mxt);
            f32x4 num[4];
#pragma unroll
            for (int et = 0; et < 4; ++et) num[et] = (f32x4){0.f, 0.f, 0.f, 0.f};
            float den = 0.f;
            for (int sp = 0; sp < 4; ++sp) {
                if (d == 0 ? (2 * sp > wave) : (2 * sp + 1 < wave)) continue;
                float pw[8];
#pragma unroll
                for (int hf = 0; hf < 2; ++hf) {
                    const int st = 2 * sp + hf;
                    f32x4 sacc = (f32x4){0.f, 0.f, 0.f, 0.f};
#pragma unroll
                    for (int ks = 0; ks < 2; ++ks) sacc = MFMA16(*(const bf16x8*)(Ks + (st * 16 + col) * KP + ks * 32 + 8 * g), bq[ks], sacc);
                    const f32x4 g4 = *(const f32x4*)(gvs_ + d * 128 + st * 16 + 4 * g);
#pragma unroll
                    for (int r = 0; r < 4; ++r) {
                        const int is = st * 16 + 4 * g + r;
                        const bool ok = d == 0 ? (is <= it) : (is >= it);
                        const float pr = ok ? sacc[r] * fexp(g4[r] - mxt) : 0.f;
                        den += pr; pw[hf * 4 + r] = pr;
                    }
                }
                u32x4 pb; pb.x = pk2(pw[0], pw[1]); pb.y = pk2(pw[2], pw[3]); pb.z = pk2(pw[4], pw[5]); pb.w = pk2(pw[6], pw[7]);
                const bf16x8 bp = __builtin_bit_cast(bf16x8, pb);
#pragma unroll
                for (int et = 0; et < 4; ++et) {
                    const bf16_t* vp = Vs + (et * 16 + col) * VP + sp * 32 + 4 * g;
                    const u32x2 v0 = *(const u32x2*)vp, v1 = *(const u32x2*)(vp + 16);
                    u32x4 va; va.x = v0.x; va.y = v0.y; va.z = v1.x; va.w = v1.y;
                    num[et] = MFMA16(__builtin_bit_cast(bf16x8, va), bp, num[et]);
                }
            }
            den += SHX(den, 16, lane); den += SHX(den, 32, lane);
            f32x4 qc[4]; float qn = 0.f;
#pragma unroll
            for (int ks = 0; ks < 2; ++ks) {
                const float* np = NLb + (size_t)su * 64 + ks * 32 + 8 * g;
                const f32x4 n0 = *(const f32x4*)np, n1 = *(const f32x4*)(np + 4);
                const u32x4 qb = __builtin_bit_cast(u32x4, bq[ks]);
                qn += (bf_lo(qb.x) * n0.x + bf_hi(qb.x) * n0.y) + (bf_lo(qb.y) * n0.z + bf_hi(qb.y) * n0.w) + (bf_lo(qb.z) * n1.x + bf_hi(qb.z) * n1.y) + (bf_lo(qb.w) * n1.z + bf_hi(qb.w) * n1.w);
            }
            qn += SHX(qn, 16, lane); qn += SHX(qn, 32, lane);
#pragma unroll
            for (int et = 0; et < 4; ++et) {
                qc[et] = (f32x4){0.f, 0.f, 0.f, 0.f};
#pragma unroll
                for (int ks = 0; ks < 2; ++ks) {
                    const float* cp = CL + (size_t)su * 4096 + (size_t)(et * 16 + col) * 64 + ks * 32 + 8 * g;
                    qc[et] = MFMA16(cvt8(*(const f32x4*)cp, *(const f32x4*)(cp + 4)), bq[ks], qc[et]);
                }
            }
            const float dd = frcp(fmaxf(fabsf(den + wint * qn), fexp(-mt)));
#pragma unroll
            for (int et = 0; et < 4; ++et) hs[et] += (num[et] + wint * qc[et]) * dd;
        }
        float sm = 0.f;
#pragma unroll
        for (int et = 0; et < 4; ++et) sm += (hs[et].x + hs[et].y) + (hs[et].z + hs[et].w);
        sm += SHX(sm, 16, lane); sm += SHX(sm, 32, lane);
        const float mean = sm * (1.0f / 64.0f); float q = 0.f;
#pragma unroll
        for (int et = 0; et < 4; ++et) { const f32x4 dl = hs[et] - mean; q += (dl.x * dl.x + dl.y * dl.y) + (dl.z * dl.z + dl.w * dl.w); }
        q += SHX(q, 16, lane); q += SHX(q, 32, lane);
        const float rstd = 1.0f / sqrtf(q * (1.0f / 64.0f) + LN_EPS);
#pragma unroll
        for (int et = 0; et < 4; ++et) {
            const int c = h * 64 + et * 16 + 4 * g;
            const u32x2 ob_ = *(const u32x2*)(proj + trow * PLD + C_MW + 3 * MW + c); const f32x4 o4 = (f32x4){bf_lo(ob_.x), bf_hi(ob_.x), bf_lo(ob_.y), bf_hi(ob_.y)}, g4 = *(const f32x4*)(mln_g + c);
            const f32x4 y = (hs[et] - mean) * rstd * g4;
            u32x2 ob; ob.x = pk2(sigmoidf_(o4.x) * y.x, sigmoidf_(o4.y) * y.y); ob.y = pk2(sigmoidf_(o4.z) * y.z, sigmoidf_(o4.w) * y.w);
            *(u32x2*)(GRP + trow * D + GW + RW + c) = ob;
        }
    }
    __syncthreads();
}

__device__ __forceinline__ void phase_rwkv_post(const Params& P, int l, unsigned char* smem, int wv) {
    ParamsPtr pp = PARAMS_PTR(P); PIN_S(pp); unsigned char* ws = pp->ws; int bidx = (int)blockIdx.x, gdim = (int)gridDim.x; PIN_S(bidx); PIN_S(gdim);
    const float* SCAN = (const float*)(ws + O_SCAN); const float* VV = (const float*)(ws + O_VV); const float* GATE = (const float*)(ws + O_GATE);
    const float* BONUS = (const float*)(ws + O_BONUS); bf16_t* GRP = (bf16_t*)(ws + O_GRP);
    const float* rln_g = pp->in[15] + (size_t)l * RW; const float* rln_b = pp->in[16] + (size_t)l * RW;
    const int tid = phase_tid(wv), lane = tid & 63, wave = tid >> 6;
    const int gw = bidx * NWAVES + wave, ngw = NWAVES * gdim;
    for (int it = gw; it < T * RH; it += ngw) {
        const int t = it / RH, h = it % RH, c = h * 64 + lane;
        const size_t o = (size_t)t * RW + c;
        const float x = SCAN[o] + SCAN[(size_t)T * RW + o];
        const float mean = wave_sum(x, lane) * (1.0f / 64.0f);
        const float dl = x - mean;
        const float var = wave_sum(dl * dl, lane) * (1.0f / 64.0f);
        float y = dl / sqrtf(var + GN_EPS) * rln_g[c] + rln_b[c];
        y += BONUS[(size_t)t * RH + h] * VV[o];
        GRP[(size_t)t * D + GW + c] = (bf16_t)f2bf(y * GATE[o]);
    }
}

__device__ __forceinline__ void phase_ln1_router(const Params& P, int l, unsigned char* smem, int wv) {
    ParamsPtr pp = PARAMS_PTR(P); PIN_S(pp); unsigned char* ws = pp->ws; int bidx = (int)blockIdx.x, gdim = (int)gridDim.x; PIN_S(bidx); PIN_S(gdim);
    const float* xin = l == 0 ? pp->in[0] : (const float*)(ws + O_XA);
    const bf16_t* MIX = (const bf16_t*)(ws + O_MIX); float* X1 = (float*)(ws + O_X1);
    int* TOPI = (int*)(ws + O_TOPI); float* TOPG = (float*)(ws + O_TOPG); int* RANK = (int*)(ws + O_RANK); bf16_t* X1B = (bf16_t*)(ws + O_X1B);
    int* BCNT = (int*)(ws + O_BCNT);
    const float* g1 = pp->in[22] + (size_t)l * D; const float* b1 = pp->in[23] + (size_t)l * D;
    const float* rw = pp->in[24] + (size_t)l * D * NE; const float* rb = pp->in[25] + (size_t)l * NE;
    const bf16_t* RWT = (const bf16_t*)(ws + O_RWT) + (size_t)l * 2 * NE * D;
    const int tid = phase_tid(wv), lane = tid & 63, wave = tid >> 6, col = lane & 15, g = lane >> 4;
    float* lgs = (float*)smem;
    int* stopi = (int*)(smem + 8192);
    for (int tile = bidx; tile < T / 64; tile += gdim) {
        __syncthreads();
        {
            f32x4 xa[4]; u32x2 xm[4];
#define LN1_LOAD(tt_) do { _Pragma("unroll") for (int j = 0; j < 4; ++j) { const int c = j * 256 + lane * 4; xa[j] = *(const f32x4*)(xin + (size_t)(tt_) * D + c); xm[j] = *(const u32x2*)(MIX + (size_t)(tt_) * D + c); } } while (0)
            LN1_LOAD(tile * 64 + wave * 8);
#pragma unroll 1
            for (int ti8 = 0; ti8 < 8; ++ti8) {
                const int t = tile * 64 + wave * 8 + ti8;
                float v[16]; float sm = 0.f;
#pragma unroll
                for (int j = 0; j < 4; ++j) {
                    v[j * 4 + 0] = ALPHA * xa[j].x + bf_lo(xm[j].x); v[j * 4 + 1] = ALPHA * xa[j].y + bf_hi(xm[j].x); v[j * 4 + 2] = ALPHA * xa[j].z + bf_lo(xm[j].y); v[j * 4 + 3] = ALPHA * xa[j].w + bf_hi(xm[j].y);
                    sm += (v[j * 4] + v[j * 4 + 1]) + (v[j * 4 + 2] + v[j * 4 + 3]);
                }
                if (ti8 < 7) LN1_LOAD(t + 1);
                const float mean = wave_sum_fast(sm, lane) * (1.0f / D); float q = 0.f;
#pragma unroll
                for (int j = 0; j < 16; ++j) { const float dl = v[j] - mean; q += dl * dl; }
                const float rstd = 1.0f / sqrtf(wave_sum_fast(q, lane) * (1.0f / D) + LN_EPS);
#pragma unroll
                for (int j = 0; j < 4; ++j) {
                    const int c = j * 256 + lane * 4;
                    const f32x4 gg = *(const f32x4*)(g1 + c), bb = *(const f32x4*)(b1 + c);
                    f32x4 o;
                    o.x = (v[j * 4 + 0] - mean) * rstd * gg.x + bb.x; o.y = (v[j * 4 + 1] - mean) * rstd * gg.y + bb.y;
                    o.z = (v[j * 4 + 2] - mean) * rstd * gg.z + bb.z; o.w = (v[j * 4 + 3] - mean) * rstd * gg.w + bb.w;
                    *(f32x4*)(X1 + (size_t)t * D + c) = o;
                    u32x2 ob; ob.x = pk2(o.x, o.y); ob.y = pk2(o.z, o.w); *(u32x2*)(X1B + (size_t)t * D + c) = ob;
                }
            }
#undef LN1_LOAD
        }
        __syncthreads();
        {
            const float* xr = X1 + (size_t)(tile * 64 + (wave >> 1) * 16 + col) * D + 8 * g;
            const bf16_t* wh = RWT + (size_t)((wave & 1) * 16 + col) * D + 8 * g; const bf16_t* wl = wh + (size_t)NE * D;
            f32x4 acc = (f32x4){0.f, 0.f, 0.f, 0.f};
#pragma unroll 4
            for (int ks = 0; ks < 32; ++ks) {
                const f32x4 x0 = *(const f32x4*)(xr + ks * 32), x1 = *(const f32x4*)(xr + ks * 32 + 4);
                const bf16x8 bh = *(const bf16x8*)(wh + ks * 32), bl = *(const bf16x8*)(wl + ks * 32);
                const bf16x8 ah = cvt8(x0, x1);
                const u32x4 ahu = __builtin_bit_cast(u32x4, ah);
                f32x4 r0, r1;
                r0.x = x0.x - bf_lo(ahu.x); r0.y = x0.y - bf_hi(ahu.x); r0.z = x0.z - bf_lo(ahu.y); r0.w = x0.w - bf_hi(ahu.y);
                r1.x = x1.x - bf_lo(ahu.z); r1.y = x1.y - bf_hi(ahu.z); r1.z = x1.z - bf_lo(ahu.w); r1.w = x1.w - bf_hi(ahu.w);
                const bf16x8 al = cvt8(r0, r1);
                acc = MFMA16(ah, bh, acc); acc = MFMA16(ah, bl, acc); acc = MFMA16(al, bh, acc);
            }
            const float rbv = rb[(wave & 1) * 16 + col];
#pragma unroll
            for (int r = 0; r < 4; ++r) lgs[((wave >> 1) * 16 + 4 * g + r) * NE + (wave & 1) * 16 + col] = acc[r] + rbv;
        }
        __syncthreads();
        if (tid < 64) {
            const float* lp = lgs + tid * NE; const int t = tile * 64 + tid;
            float tv[4]; int ti[4];
#pragma unroll
            for (int k = 0; k < 4; ++k) { tv[k] = -INFINITY; ti[k] = 0; }
            for (int e = 0; e < NE; ++e) {
                const float x = lp[e];
                if (x > tv[3]) {
                    if (x > tv[0]) { tv[3] = tv[2]; ti[3] = ti[2]; tv[2] = tv[1]; ti[2] = ti[1]; tv[1] = tv[0]; ti[1] = ti[0]; tv[0] = x; ti[0] = e; }
                    else if (x > tv[1]) { tv[3] = tv[2]; ti[3] = ti[2]; tv[2] = tv[1]; ti[2] = ti[1]; tv[1] = x; ti[1] = e; }
                    else if (x > tv[2]) { tv[3] = tv[2]; ti[3] = ti[2]; tv[2] = x; ti[2] = e; }
                    else { tv[3] = x; ti[3] = e; }
                }
            }
            const float e1 = expf(tv[1] - tv[0]), e2 = expf(tv[2] - tv[0]), e3 = expf(tv[3] - tv[0]);
            const float inv = 1.0f / (1.0f + e1 + e2 + e3);
            *(f32x4*)(TOPG + (size_t)t * 4) = (f32x4){inv, e1 * inv, e2 * inv, e3 * inv};
#pragma unroll
            for (int k = 0; k < 4; ++k) { TOPI[(size_t)t * 4 + k] = ti[k]; stopi[tid * 4 + k] = ti[k]; }
        }
        __syncthreads();
        if (tid < 256) { const int e = stopi[tid]; int r = 0; for (int a2 = 0; a2 < tid; ++a2) r += (stopi[a2] == e) ? 1 : 0; RANK[(size_t)tile * 256 + tid] = r; }
        else if (tid < 256 + NE) { const int e = tid - 256; int cnt = 0; for (int a2 = 0; a2 < 256; ++a2) cnt += (stopi[a2] == e) ? 1 : 0; BCNT[tile * NE + e] = cnt; }
    }
    __syncthreads();
}

__device__ __forceinline__ void moe_offsets(int* sh, const int* CNT, int tid) {
    if (tid == 0) {
        int acc = 0;
        for (int e = 0; e < NE; ++e) { const int c = (int)CNT[e]; sh[e] = c; sh[32 + e] = acc; acc += (c + MOEB - 1) / MOEB * MOEB; sh[64 + e] = acc; }
    }
    __syncthreads();
}
__device__ __forceinline__ int moe_expert_of_row(const int* sh, int r) {
    int e = -1;
    for (int i = 0; i < NE; ++i) if (r >= sh[32 + i] && r < sh[64 + i]) e = i;
    return e;
}

__device__ __forceinline__ void phase_scatter(const Params& P, int l, unsigned char* smem, int wv) {
    ParamsPtr pp = PARAMS_PTR(P); PIN_S(pp); unsigned char* ws = pp->ws; int bidx = (int)blockIdx.x, gdim = (int)gridDim.x; PIN_S(bidx); PIN_S(gdim);
    const int tid = phase_tid(wv);
    const int* TOPI = (const int*)(ws + O_TOPI); const int* RANK = (const int*)(ws + O_RANK); int* SLOT = (int*)(ws + O_SLOT); int* ROWT = (int*)(ws + O_ROWT);
    const int* BCNT = (const int*)(ws + O_BCNT); int* CNTF = (int*)(ws + O_CNTF);
    int* sh = (int*)smem;
    int* part = sh + 96;
    int* tot = part + 512;
    int* base = tot + 32;
    constexpr int NT = T / 64;
    const int e = tid & 31, pt = tid >> 5;
    { int sacc = 0; for (int tl = pt; tl < NT; tl += 16) sacc += BCNT[tl * NE + e]; part[pt * 32 + e] = sacc; }
    __syncthreads();
    if (tid < 32) { int sacc = 0; for (int q = 0; q < 16; ++q) sacc += part[q * 32 + tid]; tot[tid] = sacc; if (bidx == 0) CNTF[tid] = sacc; }
    __syncthreads();
    moe_offsets(sh, tot, tid);
    for (int ee = bidx; ee < NE; ee += gdim)
        for (int r = sh[32 + ee] + sh[ee] + tid; r < sh[64 + ee]; r += NTHREADS) ROWT[r] = 0;
    for (int tile = bidx; tile < NT; tile += gdim) {
        __syncthreads();
        { int sacc = 0; for (int tl = pt; tl < tile; tl += 16) sacc += BCNT[tl * NE + e]; part[pt * 32 + e] = sacc; }
        __syncthreads();
        if (tid < 32) { int sacc = sh[32 + tid]; for (int q = 0; q < 16; ++q) sacc += part[q * 32 + tid]; base[tid] = sacc; }
        __syncthreads();
        if (tid < 256) { const int a = tile * 256 + tid, dest = base[TOPI[a]] + RANK[a]; SLOT[a] = dest; ROWT[dest] = a >> 2; }
    }
    __syncthreads();
}

template <int WHICH>
__device__ __forceinline__ void phase_moe_gemm(const Params& P, int l, unsigned char* smem, int wv) {
    ParamsPtr pp = PARAMS_PTR(P); PIN_S(pp); unsigned char* ws = pp->ws; int bidx = (int)blockIdx.x, gdim = (int)gridDim.x; PIN_S(bidx); PIN_S(gdim);
    const int tid = phase_tid(wv);
    const int* CNT = (const int*)(ws + O_CNTF);
    int* sh = (int*)(smem + 131072);
    int* rbe = sh + 96;
    moe_offsets(sh, CNT, tid);
    const int nrb = sh[64 + NE - 1] / MOEB;
    for (int rb = tid; rb < nrb; rb += NTHREADS) rbe[rb] = moe_expert_of_row(sh, rb * MOEB);
    __syncthreads();
    pg8::MoeOrderT<WHICH == 1> S;
    S.K = 1024; S.G_ = gdim; S.c = bidx; S.rbe = rbe; S.rowmap = (const int*)(ws + O_ROWT);
    if (WHICH == 1) {
        S.A = (const char*)(ws + O_X1B); S.Wt = (const char*)(ws + O_W1) + (size_t)l * NE * 2 * DFF * D * 2; S.estride = (size_t)2 * DFF * D * 2; S.nN = 2 * DFF / 256; S.nwg = nrb * S.nN;
        pg8::EpiSwiglu E{(bf16_t*)(ws + O_ACT), pp->in[27] + (size_t)l * NE * 2 * DFF};
        pg8::gemm_phase<pg8::EpiSwiglu, pg8::MoeOrderT<WHICH == 1>>((LAS unsigned char*)smem, 1024, S, E, tid);
    } else {
        S.A = (const char*)(ws + O_ACT); S.Wt = (const char*)(ws + O_W2) + (size_t)l * NE * D * DFF * 2; S.estride = (size_t)D * DFF * 2; S.nN = D / 256; S.nwg = nrb * S.nN;
        pg8::EpiBf16Bias E{(bf16_t*)(ws + O_YS), D, pp->in[29] + (size_t)l * NE * D, D};
        pg8::gemm_phase<pg8::EpiBf16Bias, pg8::MoeOrderT<WHICH == 1>>((LAS unsigned char*)smem, 1024, S, E, tid);
    }
    __syncthreads();
}

__device__ __forceinline__ void phase_combine_ln2(const Params& P, int l, unsigned char* smem, int wv) {
    ParamsPtr pp = PARAMS_PTR(P); PIN_S(pp); unsigned char* ws = pp->ws; int bidx = (int)blockIdx.x, gdim = (int)gridDim.x; PIN_S(bidx); PIN_S(gdim);
    const float* X1 = (const float*)(ws + O_X1); const bf16_t* YS = (const bf16_t*)(ws + O_YS); bf16_t* XB = (bf16_t*)(ws + O_XB);
    const int* SLOT = (const int*)(ws + O_SLOT); const float* TOPG = (const float*)(ws + O_TOPG);
    float* xo = l == NL - 1 ? pp->out : (float*)(ws + O_XA);
    const float* g2 = pp->in[30] + (size_t)l * D; const float* b2 = pp->in[31] + (size_t)l * D;
    const int tid = phase_tid(wv), lane = tid & 63, wave = tid >> 6;
    const int gw = bidx * NWAVES + wave, ngw = NWAVES * gdim;
    u32x4 sl_n = (u32x4){0u, 0u, 0u, 0u}; f32x4 gg_n = (f32x4){0.f, 0.f, 0.f, 0.f};
    f32x4 xa_n[4]; u32x2 ys_n[4][4]; f32x4 gg_c = (f32x4){0.f, 0.f, 0.f, 0.f};
    const f32x4 lg[4] = {*(const f32x4*)(g2 + lane * 4), *(const f32x4*)(g2 + 256 + lane * 4), *(const f32x4*)(g2 + 512 + lane * 4), *(const f32x4*)(g2 + 768 + lane * 4)};
    const f32x4 lb[4] = {*(const f32x4*)(b2 + lane * 4), *(const f32x4*)(b2 + 256 + lane * 4), *(const f32x4*)(b2 + 512 + lane * 4), *(const f32x4*)(b2 + 768 + lane * 4)};
#define CB_META(tt_) do { sl_n = *(const u32x4*)(SLOT + (size_t)(tt_) * 4); gg_n = *(const f32x4*)(TOPG + (size_t)(tt_) * 4); } while (0)
#define CB_ROWS(tt_) do { _Pragma("unroll") for (int j = 0; j < 4; ++j) { const int c = j * 256 + lane * 4; xa_n[j] = *(const f32x4*)(X1 + (size_t)(tt_) * D + c); \
        ys_n[0][j] = *(const u32x2*)(YS + (size_t)sl_n.x * D + c); ys_n[1][j] = *(const u32x2*)(YS + (size_t)sl_n.y * D + c); ys_n[2][j] = *(const u32x2*)(YS + (size_t)sl_n.z * D + c); ys_n[3][j] = *(const u32x2*)(YS + (size_t)sl_n.w * D + c); } gg_c = gg_n; } while (0)
    if (gw < T) { CB_META(gw); CB_ROWS(gw); if (gw + ngw < T) CB_META(gw + ngw); }
    for (int t = gw; t < T; t += ngw) {
        float v[16]; float sm = 0.f;
        const float gk[4] = {gg_c.x, gg_c.y, gg_c.z, gg_c.w};
#pragma unroll
        for (int j = 0; j < 4; ++j) {
            const f32x4 a = xa_n[j];
            f32x4 y = (f32x4){0.f, 0.f, 0.f, 0.f};
#pragma unroll
            for (int k = 0; k < 4; ++k) { const u32x2 yk = ys_n[k][j]; y.x += gk[k] * bf_lo(yk.x); y.y += gk[k] * bf_hi(yk.x); y.z += gk[k] * bf_lo(yk.y); y.w += gk[k] * bf_hi(yk.y); }
            v[j * 4 + 0] = ALPHA * a.x + y.x; v[j * 4 + 1] = ALPHA * a.y + y.y; v[j * 4 + 2] = ALPHA * a.z + y.z; v[j * 4 + 3] = ALPHA * a.w + y.w;
            sm += (v[j * 4] + v[j * 4 + 1]) + (v[j * 4 + 2] + v[j * 4 + 3]);
        }
        if (t + ngw < T) { CB_ROWS(t + ngw); if (t + 2 * ngw < T) CB_META(t + 2 * ngw); }
        const float mean = wave_sum_fast(sm, lane) * (1.0f / D); float q = 0.f;
#pragma unroll
        for (int j = 0; j < 16; ++j) { const float dl = v[j] - mean; q += dl * dl; }
        const float rstd = 1.0f / sqrtf(wave_sum_fast(q, lane) * (1.0f / D) + LN_EPS);
#pragma unroll
        for (int j = 0; j < 4; ++j) {
            const int c = j * 256 + lane * 4;
            f32x4 o;
            o.x = (v[j * 4 + 0] - mean) * rstd * lg[j].x + lb[j].x; o.y = (v[j * 4 + 1] - mean) * rstd * lg[j].y + lb[j].y;
            o.z = (v[j * 4 + 2] - mean) * rstd * lg[j].z + lb[j].z; o.w = (v[j * 4 + 3] - mean) * rstd * lg[j].w + lb[j].w;
            *(f32x4*)(xo + (size_t)t * D + c) = o;
            if (l != NL - 1) { u32x2 ob; ob.x = pk2(o.x, o.y); ob.y = pk2(o.z, o.w); *(u32x2*)(XB + (size_t)t * D + c) = ob; }
        }
    }
#undef CB_META
#undef CB_ROWS
}

__device__ __forceinline__ void phase_inproj(const Params& P, int l, unsigned char* smem, int wv) {
    ParamsPtr pp = PARAMS_PTR(P); PIN_S(pp); unsigned char* ws = pp->ws; int bidx = (int)blockIdx.x, gdim = (int)gridDim.x; PIN_S(bidx); PIN_S(gdim);
    const int tid = phase_tid(wv);
    pg8::DenseOrder S; S.init(ws + O_XB, (const bf16_t*)(ws + O_WIN) + (size_t)l * PLD * D, T, PLD, D, gdim, bidx);
    pg8::EpiProj E{(bf16_t*)(ws + O_PROJ), PLD, (float*)(ws + O_PROJG), PLD / 256 - 1};
    pg8::gemm_phase<pg8::EpiProj, pg8::DenseOrder>((LAS unsigned char*)smem, D, S, E, tid);
    __syncthreads();
}
__device__ __forceinline__ void phase_outproj(const Params& P, int l, unsigned char* smem, int wv) {
    ParamsPtr pp = PARAMS_PTR(P); PIN_S(pp); unsigned char* ws = pp->ws; int bidx = (int)blockIdx.x, gdim = (int)gridDim.x; PIN_S(bidx); PIN_S(gdim);
    const int tid = phase_tid(wv);
    pg8::DenseOrder S; S.init(ws + O_GRP, (const bf16_t*)(ws + O_WOUT) + (size_t)l * D * D, T, D, D, gdim, bidx);
    pg8::EpiProj E{(bf16_t*)(ws + O_MIX), D, nullptr, -1};
    pg8::gemm_phase<pg8::EpiProj, pg8::DenseOrder>((LAS unsigned char*)smem, D, S, E, tid);
    __syncthreads();
}

#ifndef EMU
#define XB_TMO      128
#define XB_XCNT(j)  (256  + 64 * (j))
#define XB_XSUB(j)  (1280 + 64 * (j))
#define XB_XGEN(j)  (2304 + 64 * (j))
#define XB_TOP      3328
#define XB_TOPGEN   3392
#define XCD_BAR_WORDS 3456
#define XB_SPIN_CAP (1u << 25)
__device__ __forceinline__ unsigned xb_ld(unsigned* p)              { return __hip_atomic_load(p, __ATOMIC_RELAXED, __HIP_MEMORY_SCOPE_AGENT); }
__device__ __forceinline__ unsigned xb_add(unsigned* p, unsigned v) { return __hip_atomic_fetch_add(p, v, __ATOMIC_RELAXED, __HIP_MEMORY_SCOPE_AGENT); }
__device__ __forceinline__ unsigned xb_xcc_id() { return (unsigned)__builtin_amdgcn_s_getreg((3 << 11) | 20) & 0xFu; }
#define XB_SPIN(cond, bar) do { unsigned _sp = 0; while (cond) { __builtin_amdgcn_s_sleep(1); \
    if ((++_sp & 255u) == 0u) { if (xb_ld(&(bar)[XB_TMO])) break; if (_sp > XB_SPIN_CAP) { atomicAdd(&(bar)[XB_TMO], 1u); break; } } } } while (0)
struct XcdBarrier { unsigned* bar; unsigned x; volatile LAS unsigned* st; };
__device__ __forceinline__ XcdBarrier xcd_barrier_post(unsigned* bar, volatile LAS unsigned* st) {
    XcdBarrier b; b.bar = bar; b.x = xb_xcc_id(); b.st = st;
    if (threadIdx.x == 0) (void)xb_add(&bar[XB_XCNT(b.x)], 1u);
    return b;
}
__device__ __forceinline__ void xcd_barrier_complete(unsigned* bar, unsigned x, unsigned& nloc, unsigned& nx) {
    const unsigned G = gridDim.x * gridDim.y * gridDim.z;
    unsigned sum, cnt, mine, sp = 0u;
    for (;;) {
        sum = 0u; cnt = 0u; mine = 0u;
#pragma unroll
        for (unsigned j = 0; j < 16; ++j) { const unsigned c = xb_ld(&bar[XB_XCNT(j)]); sum += c; cnt += (c > 0u) ? 1u : 0u; mine = (j == x) ? c : mine; }
        if (sum == G) break;
        __builtin_amdgcn_s_sleep(1);
        if ((++sp & 255u) == 0u) { if (xb_ld(&bar[XB_TMO])) break; if (sp > XB_SPIN_CAP) { atomicAdd(&bar[XB_TMO], 1u); break; } }
    }
    nloc = mine > 0u ? mine : 1u; nx = cnt > 0u ? cnt : 1u;
}
__device__ __forceinline__ void xcd_barrier(const XcdBarrier& b) {
    asm volatile("s_waitcnt vmcnt(0)" ::: "memory");
    __syncthreads();
    if (threadIdx.x == 0) {
        unsigned* bar = b.bar;
        __builtin_amdgcn_s_waitcnt(0);
        unsigned nloc = b.st[0], nx = b.st[1];
        if (nloc == 0u) { xcd_barrier_complete(bar, b.x, nloc, nx); b.st[0] = nloc; b.st[1] = nx; }
        const unsigned old = xb_add(&bar[XB_XSUB(b.x)], 1u);
        const unsigned gen = old / nloc;
        if (old + 1u == (gen + 1u) * nloc) {
            __builtin_amdgcn_fence(__ATOMIC_RELEASE, "agent");
            asm volatile("s_waitcnt vmcnt(0)" ::: "memory");
            const unsigned og = xb_add(&bar[XB_TOP], 1u);
            const unsigned tg = og / nx;
            if (og + 1u == (tg + 1u) * nx) xb_add(&bar[XB_TOPGEN], 1u);
            else XB_SPIN(xb_ld(&bar[XB_TOPGEN]) == tg, bar);
            __builtin_amdgcn_fence(__ATOMIC_ACQUIRE, "agent");
            xb_add(&bar[XB_XGEN(b.x)], 1u);
            asm volatile("s_waitcnt vmcnt(0)" ::: "memory");
        } else {
            XB_SPIN(xb_ld(&bar[XB_XGEN(b.x)]) == gen, bar);
            __builtin_amdgcn_fence(__ATOMIC_ACQUIRE, "agent");
            asm volatile("s_waitcnt vmcnt(0)" ::: "memory");
        }
    }
    __syncthreads();
}
#endif

__global__ void __launch_bounds__(512, 2) mk_fwd(Params P) {
#ifdef EMU
    unsigned char* smem = g_blk->lds;
#else
    extern __shared__ __attribute__((aligned(16))) unsigned char smem[];
    volatile LAS unsigned* bst = (volatile LAS unsigned*)(smem + LDS_BYTES - 16);
    if (threadIdx.x == 0) { bst[0] = 0u; bst[1] = 0u; bst[2] = 0u; bst[3] = 0u; }
    __syncthreads();
    XcdBarrier bar; bar.bar = (unsigned*)P.ws + CW_BAR; bar.x = 0; bar.st = bst;
    if (P.ph_hi - P.ph_lo > 1) bar = xcd_barrier_post((unsigned*)P.ws + CW_BAR, bst);
#endif
    const int lo = P.ph_lo, hi = P.ph_hi;
#ifdef EMU
    const int wv = (int)threadIdx.x >> 6;
#else
    const int wv = RFL((int)threadIdx.x >> 6);
#endif
#ifdef EMU
#define SEAM(id) do {} while (0)
#else
#define SEAM(id) do { if ((id) + 1 < hi) xcd_barrier(bar); } while (0)
#endif
#ifndef MK_ONLY_PHASE
#define MK_ONLY_PHASE -1
#endif
#ifndef MK_DUP_MASK
#define MK_DUP_MASK 0
#endif
#define PHG(kc, id, ...) do { if (MK_ONLY_PHASE < 0 || MK_ONLY_PHASE == (kc)) { const int id_ = (id); if (id_ >= lo && id_ < hi) { if ((MK_DUP_MASK >> (kc)) & 1) { __VA_ARGS__; SEAM(id_ - 1); } __VA_ARGS__; SEAM(id_); } } } while (0)
#define PH(k, ...) PHG(1 + (k), 1 + l * NPH + (k), __VA_ARGS__)
    PHG(0, 0, phase_prologue(P, smem, wv));
    for (int l = 0; l < NL; ++l) {
        PH(0, phase_inproj(P, l, smem, wv));
#if MK_RWKV_CHUNKED
        PH(1, phase_prep32(P, l, smem, wv));
#else
        PH(1, phase_prep(P, l, smem, wv));
#endif
#if MK_RWKV_CHUNKED
        PH(2, { phase_rwkv_pre(P, l, smem, wv); phase_mlstm_local(P, l, smem, wv, (int)blockIdx.x, (int)gridDim.x); });
        PH(3, { const int G_ = (int)gridDim.x;
                if (G_ >= 2 * RSEQ_WGS) { if ((int)blockIdx.x < RSEQ_WGS) phase_rwkv_seq(P, l, smem, wv);
                                           else { phase_mlstm_carry(P, l, smem, wv, (int)blockIdx.x - RSEQ_WGS, G_ - RSEQ_WGS); phase_gmlp_mix(P, l, smem, wv, (int)blockIdx.x - RSEQ_WGS, G_ - RSEQ_WGS); } }
                else { phase_rwkv_seq(P, l, smem, wv); phase_mlstm_carry(P, l, smem, wv, (int)blockIdx.x, G_); } });
        PH(4, { phase_rwkv_out(P, l, smem, wv); phase_mlstm_out(P, l, smem, wv); if ((int)gridDim.x < 2 * RSEQ_WGS) phase_gmlp_mix(P, l, smem, wv, (int)blockIdx.x, (int)gridDim.x); });
#else
        PH(2, { const int G_ = (int)gridDim.x, NSC = 2 * NB * RH * 4;
                if (G_ >= NSC + 32) { if ((int)blockIdx.x < NSC) phase_rwkv_scan(P, l, smem, wv, (int)blockIdx.x, NSC);
                                      else phase_mlstm_local(P, l, smem, wv, (int)blockIdx.x - NSC, G_ - NSC); }
                else { phase_rwkv_scan(P, l, smem, wv, (int)blockIdx.x, G_); phase_mlstm_local(P, l, smem, wv, (int)blockIdx.x, G_); } });
        PH(3, phase_mlstm_carry(P, l, smem, wv, (int)blockIdx.x, (int)gridDim.x));
        PH(4, { phase_mlstm_out(P, l, smem, wv); phase_gmlp_mix(P, l, smem, wv, (int)blockIdx.x, (int)gridDim.x); phase_rwkv_post(P, l, smem, wv); });
#endif
        PH(5, phase_outproj(P, l, smem, wv));
        PH(6, phase_ln1_router(P, l, smem, wv));
        PH(7, phase_scatter(P, l, smem, wv));
        PH(8, phase_moe_gemm<1>(P, l, smem, wv));
        PH(9, phase_moe_gemm<2>(P, l, smem, wv));
        PH(10, phase_combine_ln2(P, l, smem, wv));
    }
#undef PHG
#undef PH
#undef SEAM
}

}

#ifndef EMU
extern "C" void kernel_launch(void* const* d_in, const int* in_sizes, int n_in, void* d_out, int out_size, void* d_ws, size_t ws_size, hipStream_t stream) {
    using namespace mk;
    static int grid = 0;
    if (grid == 0) {
        if (n_in != 32 || out_size != T * D || ws_size < WS_END) { fprintf(stderr, "kernel_launch: unexpected shapes (n_in %d out %d ws %zu need %zu)\n", n_in, out_size, ws_size, (size_t)WS_END); grid = -1; return; }
        int dev = 0, cus = 0;
        if (hipGetDevice(&dev) != hipSuccess || hipDeviceGetAttribute(&cus, hipDeviceAttributeMultiprocessorCount, dev) != hipSuccess) { grid = -1; return; }
        if (hipFuncSetAttribute((const void*)mk_fwd, hipFuncAttributeMaxDynamicSharedMemorySize, LDS_BYTES) != hipSuccess) { fprintf(stderr, "kernel_launch: hipFuncSetAttribute failed\n"); grid = -1; return; }
        int per_cu = 0;
        (void)hipOccupancyMaxActiveBlocksPerMultiprocessor(&per_cu, (const void*)mk_fwd, NTHREADS, LDS_BYTES);
        (void)hipGetLastError();
        grid = cus;
    }
    if (grid < 0) return;
    (void)hipMemsetAsync(d_ws, 0, CTL_BYTES, stream);
    Params p{};
    for (int i = 0; i < 32; ++i) p.in[i] = (const float*)d_in[i];
    p.out = (float*)d_out; p.ws = (unsigned char*)d_ws;
#if MK_ONE_LAUNCH
    p.ph_lo = 0; p.ph_hi = 1 + NL * NPH;
    hipLaunchKernelGGL(mk_fwd, dim3(grid), dim3(NTHREADS), LDS_BYTES, stream, p);
#else
    for (int id = 0; id < 1 + NL * NPH; ++id) {
        p.ph_lo = id; p.ph_hi = id + 1;
        hipLaunchKernelGGL(mk_fwd, dim3(grid), dim3(NTHREADS), LDS_BYTES, stream, p);
    }
#endif
}
#endif
```

```cpp
#ifndef EMU
#include <hip/hip_runtime.h>
#endif
#include <cstdio>
#include <cstdint>
#include <cmath>

#ifndef CFG_BATCH
#define CFG_BATCH 4
#endif
#ifndef CFG_SEQ
#define CFG_SEQ 4096
#endif
#ifndef CFG_LAYERS
#define CFG_LAYERS 4
#endif
#ifndef MK_RWKV_CHUNKED
#define MK_RWKV_CHUNKED 1
#endif
#ifndef MK_PROBE
#define MK_PROBE 0
#endif
#ifndef MK_SP2
#define MK_SP2 1
#endif
#ifndef MK_ONE_LAUNCH
#define MK_ONE_LAUNCH 1
#endif

namespace mk {
constexpr int NB = CFG_BATCH, S = CFG_SEQ, T = NB * S, NL = CFG_LAYERS, D = 1024;
constexpr int GW = 256, RW = 384, MW = 384, HD = 64, GH = 4, RH = 6, MH = 6, CH = 128, NCH = S / CH;
constexpr int PIN = 3480, PLD = 3584, RPROJ = 1408;
constexpr int C_RW = 512, C_MW = 1920;
constexpr int NE = 32, TOPK = 4, DFF = 1024, MOEB = 256;
constexpr int NROWS = (T * TOPK / MOEB + NE) * MOEB;
constexpr float LN_EPS = 1e-5f, GN_EPS = 64e-5f;
constexpr float ALPHA = 1.6817928305074290f;
constexpr int NTHREADS = 512, NWAVES = 8;
constexpr int LDS_BYTES = 160 * 1024;
constexpr int NPH = 11;

typedef float f32x4 __attribute__((ext_vector_type(4)));
typedef unsigned u32x4 __attribute__((ext_vector_type(4)));
typedef unsigned u32x2 __attribute__((ext_vector_type(2)));
typedef short bf16x8 __attribute__((ext_vector_type(8)));
typedef unsigned short bf16_t;

constexpr size_t al(size_t x) { return (x + 255) & ~(size_t)255; }
constexpr size_t CTL_BYTES = 1u << 20;
constexpr size_t O_XA = CTL_BYTES;
constexpr size_t O_XB = O_XA + al((size_t)T * D * 4);
constexpr size_t O_X1 = O_XB + al((size_t)T * D * 2);
constexpr size_t O_X1B = O_X1 + al((size_t)T * D * 4);
constexpr size_t O_PROJ = O_X1B + al((size_t)T * D * 2);
constexpr size_t O_PROJG = O_PROJ + al((size_t)T * PLD * 2);
constexpr size_t O_MIX = O_PROJ + al((size_t)T * PLD * 4);
constexpr size_t O_GRP = O_MIX + al((size_t)T * D * 4);
constexpr size_t O_UG = O_GRP + al((size_t)T * D * 2);
constexpr size_t O_VN = O_UG + al((size_t)T * GW * 4);
constexpr size_t O_RR = O_VN + al((size_t)T * GW * 4);
constexpr size_t O_VV = O_RR + al((size_t)T * RW * 4);
constexpr size_t O_KK = O_VV + al((size_t)T * RW * 4);
constexpr size_t O_DEC = O_KK + al((size_t)T * RW * 4);
constexpr size_t O_KD = O_DEC + al((size_t)2 * T * RW * 4);
constexpr size_t O_ICLR = O_KD + al((size_t)2 * T * RW * 4);
constexpr size_t O_GATE = O_ICLR + al((size_t)2 * T * RW * 4);
constexpr size_t O_BONUS = O_GATE + al((size_t)T * RW * 4);
constexpr size_t O_SCAN = O_BONUS + al((size_t)T * RH * 4);
constexpr size_t O_MQ = O_SCAN + al((size_t)2 * T * RW * 4);
constexpr size_t O_MK = O_MQ + al((size_t)T * MW * 4);
constexpr size_t O_IG = O_MK + al((size_t)T * MW * 4);
constexpr size_t O_LF = O_IG + al((size_t)2 * T * MH * 4);
constexpr size_t O_CL = O_LF + al((size_t)2 * T * MH * 4);
constexpr size_t O_NL = O_CL + al((size_t)2 * NB * MH * NCH * 4096 * 4);
constexpr size_t O_ML = O_NL + al((size_t)2 * NB * MH * NCH * 64 * 4);
constexpr size_t O_BL = O_ML + al((size_t)2 * NB * MH * NCH * 4);
constexpr size_t O_MIN = O_BL + al((size_t)2 * NB * MH * NCH * 4);
constexpr size_t O_TOPI = O_MIN + al((size_t)2 * NB * MH * NCH * 4);
constexpr size_t O_TOPG = O_TOPI + al((size_t)T * 4 * 4);
constexpr size_t O_RANK = O_TOPG + al((size_t)T * 4 * 4);
constexpr size_t O_SLOT = O_RANK + al((size_t)T * 4 * 4);
constexpr size_t O_MQB = O_SLOT + al((size_t)T * 4 * 4);
constexpr size_t O_MKB = O_MQB + al((size_t)T * MW * 2);
constexpr size_t O_KT = O_MKB + al((size_t)T * MW * 2);
constexpr size_t O_VT = O_KT + al((size_t)T * MW * 2);
constexpr size_t O_GVT = O_VT + al((size_t)T * MW * 2);
constexpr size_t O_PMX = O_GVT + al((size_t)2 * T * MH * 4);
constexpr size_t O_BCT = O_PMX + al((size_t)2 * T * MH * 4);
constexpr size_t O_BRKR = O_BCT + al((size_t)2 * T * MH * 4);
constexpr int RC = 64, RNC = S / RC, RUN = 2 * NB * RH * RNC;
constexpr size_t O_LW = O_BRKR + al((size_t)2 * T * RH * 2 * 4);
constexpr size_t O_RQ = O_LW + al((size_t)2 * T * RW * 4);
constexpr size_t O_RA = O_RQ + al((size_t)RUN * 4096 * 2);
constexpr size_t O_RS = O_RA + al((size_t)RUN * 4096 * 2);
constexpr size_t O_RH = O_RS + al((size_t)RUN * 4096 * 2);
constexpr size_t O_RG = O_RH + al((size_t)RUN * 4096 * 4);
constexpr size_t O_RB = O_RG + al((size_t)RUN * 4096 * 4);
constexpr size_t O_VB = O_RB + al((size_t)T * RW * 2);
constexpr size_t O_KKB = O_VB + al((size_t)T * RW * 2);
constexpr size_t O_BBB = O_KKB + al((size_t)T * RW * 2);
constexpr size_t O_KDB = O_BBB + al((size_t)2 * T * RW * 2);
constexpr size_t O_RK7 = O_KDB + al((size_t)2 * T * RW * 2);
constexpr size_t O_VNT = O_RK7 + al((size_t)T * RW * 16);
constexpr size_t O_WSB = O_VNT + al((size_t)T * GW * 2);
constexpr size_t O_LWT = O_WSB + al((size_t)NL * GH * CH * CH * 2);
constexpr size_t O_RWT = O_LWT + al((size_t)NL * 1920 * 128 * 2);
constexpr size_t O_BCNT = O_RWT + al((size_t)NL * 2 * NE * D * 2);
constexpr size_t O_CNTF = O_BCNT + al((size_t)(T / 64) * NE * 4);
constexpr size_t O_ROWT = O_CNTF + al((size_t)NE * 4);
constexpr size_t O_XS = O_ROWT + al((size_t)NROWS * 4);
constexpr size_t O_ACT = O_XS + al((size_t)NROWS * D * 2);
constexpr size_t O_YS = O_ACT + al((size_t)NROWS * DFF * 2);
constexpr size_t O_WIN = O_YS + al((size_t)NROWS * D * 2);
constexpr size_t O_WOUT = O_WIN + al((size_t)NL * PLD * D * 2);
constexpr size_t O_W1 = O_WOUT + al((size_t)NL * D * D * 2);
constexpr size_t O_W2 = O_W1 + al((size_t)NL * NE * 2 * DFF * D * 2);
constexpr size_t WS_END = O_W2 + al((size_t)NL * NE * D * DFF * 2);

constexpr int CW_BAR = 4096;
constexpr int CW_CNT = 16384;

struct Params { const float* in[32]; float* out; unsigned char* ws; int ph_lo, ph_hi; };
#ifdef EMU
typedef const Params* ParamsPtr;
#define PARAMS_PTR(P) (&(P))
#else
typedef const __attribute__((address_space(4))) Params* ParamsPtr;
#define PARAMS_PTR(P) ((ParamsPtr)__builtin_amdgcn_kernarg_segment_ptr())
#endif

#ifdef EMU
#define WAVE_SYNC() emu_wave_barrier()
#define PIN_V(x) do {} while (0)
#define PIN_S(x) do {} while (0)
#else
#define WAVE_SYNC() __builtin_amdgcn_wave_barrier()
#define PIN_V(x) asm volatile("" : "+v"(x))
#define PIN_S(x) asm volatile("" : "+s"(x))
#endif
#ifdef EMU
__device__ __forceinline__ int phase_tid(int wv) { (void)wv; return threadIdx.x; }
#else
__device__ __forceinline__ int phase_tid(int wv) { int t; asm volatile("v_mbcnt_lo_u32_b32 %0, -1, 0\n\tv_mbcnt_hi_u32_b32 %0, -1, %0" : "=v"(t)); return (wv << 6) + t; }
#endif

#ifdef EMU
#define SHX(v, m, lane) __shfl_xor(v, m)
#else
__device__ __forceinline__ float shx_(float v, int m, int lane) { return __builtin_bit_cast(float, __builtin_amdgcn_ds_bpermute((lane ^ m) << 2, __builtin_bit_cast(int, v))); }
__device__ __forceinline__ int shx_(int v, int m, int lane) { return __builtin_amdgcn_ds_bpermute((lane ^ m) << 2, v); }
#define SHX(v, m, lane) shx_(v, m, lane)
#endif
#ifdef EMU
#define SHUP(v, o, lane) __shfl(v, ((lane) - (o)) & 63)
#define RDL(v, src) __shfl(v, src)
#define SHL(v, src) __shfl(v, src)
#else
#define SHL(v, src) __builtin_bit_cast(float, __builtin_amdgcn_ds_bpermute((src) << 2, __builtin_bit_cast(int, (float)(v))))
#define SHUP(v, o, lane) __builtin_bit_cast(float, __builtin_amdgcn_ds_bpermute((((lane) - (o)) & 63) << 2, __builtin_bit_cast(int, (float)(v))))
#define RDL(v, src) __builtin_bit_cast(float, __builtin_amdgcn_readlane(__builtin_bit_cast(int, (float)(v)), src))
#endif
__device__ __forceinline__ float wave_sum(float v, int lane) {
#pragma unroll
    for (int o = 32; o >= 1; o >>= 1) v += SHX(v, o, lane);
    return v;
}
#ifdef EMU
__device__ __forceinline__ float fexp(float x) { return expf(x); }
__device__ __forceinline__ float flog(float x) { return logf(x); }
__device__ __forceinline__ float frcp(float x) { return 1.0f / x; }
#else
__device__ __forceinline__ float fexp(float x) { return __builtin_amdgcn_exp2f(x * 1.4426950408889634f); }
__device__ __forceinline__ float flog(float x) { return __builtin_amdgcn_logf(x) * 0.6931471805599453f; }
__device__ __forceinline__ float frcp(float x) { return __builtin_amdgcn_rcpf(x); }
#endif
__device__ __forceinline__ float sigmoidf_(float x) { return frcp(1.0f + fexp(-x)); }
__device__ __forceinline__ float softplusf_(float x) { return fmaxf(x, 0.f) + flog(1.0f + fexp(-fabsf(x))); }
__device__ __forceinline__ float ftanh(float x) { return 1.0f - 2.0f * frcp(1.0f + fexp(2.0f * x)); }
__device__ __forceinline__ float geluf_(float v) {
    const float av = fabsf(v), t = frcp(1.0f + 0.2316418882f * av);
    float q = t * 0.5307027145f + (-0.7265760135f); q = q * t + 0.7107068705f; q = q * t + (-0.142248368f); q = q * t + 0.127414796f; q = q * t;
    const float m = v * (q * fexp(-0.5f * v * v));
    return v < 0.f ? m : v - m;
}

#ifdef EMU
#define LAS
#define WAIT_V(n) do {} while (0)
#define WAIT_L(n) do {} while (0)
#define S_BARRIER() __syncthreads()
#define SETPRIO(x) do {} while (0)
#define SCHED_BAR() do {} while (0)
#define RFL(x) (x)
static inline void emu_glds16(const void* g, void* l) { memcpy((char*)l + (g_blk->cur & 63) * 16, g, 16); }
#define GLDS16(gptr, ldsptr) emu_glds16((const void*)(gptr), (void*)(ldsptr))
static inline float emu_bf2f(unsigned short b) { unsigned u = (unsigned)b << 16; float f; memcpy(&f, &u, 4); return f; }
static inline f32x4 emu_mfma16(bf16x8 a, bf16x8 b, f32x4 c) {
    EmuBlock* blk = g_blk; const int cur = blk->cur, lane = cur & 63, wbase = cur & ~63;
    static thread_local unsigned short Ash[32][64][8], Bsh[32][64][8];
    const int w = cur >> 6;
    for (int j = 0; j < 8; ++j) { Ash[w][lane][j] = (unsigned short)a[j]; Bsh[w][lane][j] = (unsigned short)b[j]; }
    emu_wave_barrier();
    const int col = lane & 15;
    for (int r = 0; r < 4; ++r) { const int row = 4 * (lane >> 4) + r; float sum = c[r];
        for (int k = 0; k < 32; ++k) sum += emu_bf2f(Ash[w][row + 16 * (k >> 3)][k & 7]) * emu_bf2f(Bsh[w][col + 16 * (k >> 3)][k & 7]);
        c[r] = sum; }
    emu_wave_barrier(); (void)wbase;
    return c;
}
#define MFMA16(a, b, c) emu_mfma16(a, b, c)
#else
#define LAS __attribute__((address_space(3)))
#define WAIT_V(n) asm volatile("s_waitcnt vmcnt(" #n ")" ::: "memory")
#define WAIT_L(n) asm volatile("s_waitcnt lgkmcnt(" #n ")" ::: "memory")
#define S_BARRIER() __builtin_amdgcn_s_barrier()
#define SETPRIO(x) __builtin_amdgcn_s_setprio(x)
#define SCHED_BAR() __builtin_amdgcn_sched_barrier(0)
#define RFL(x) __builtin_amdgcn_readfirstlane(x)
#define GLDS16(gptr, ldsptr) __builtin_amdgcn_global_load_lds((const unsigned*)(gptr), (LAS unsigned*)(ldsptr), 16, 0, 0)
#define MFMA16(a, b, c) __builtin_amdgcn_mfma_f32_16x16x32_bf16(a, b, c, 0, 0, 0)
#endif

#ifdef EMU
__device__ __forceinline__ unsigned f2bf(float f) { unsigned u = __builtin_bit_cast(unsigned, f); return (u + 0x7fffu + ((u >> 16) & 1u)) >> 16; }
#else
__device__ __forceinline__ unsigned f2bf(float f) { return (unsigned)__builtin_bit_cast(unsigned short, (__bf16)f); }
#endif
#ifdef EMU
__device__ __forceinline__ unsigned pk2(float lo, float hi) { return f2bf(lo) | (f2bf(hi) << 16); }
#else
typedef float f32x2c __attribute__((ext_vector_type(2)));
typedef __bf16 bf16x2c __attribute__((ext_vector_type(2)));
__device__ __forceinline__ unsigned pk2(float lo, float hi) { const f32x2c v = {lo, hi}; return __builtin_bit_cast(unsigned, __builtin_convertvector(v, bf16x2c)); }
#endif
__device__ __forceinline__ bf16x8 cvt8(const f32x4 a, const f32x4 b) {
    u32x4 w; w.x = pk2(a.x, a.y); w.y = pk2(a.z, a.w); w.z = pk2(b.x, b.y); w.w = pk2(b.z, b.w); return __builtin_bit_cast(bf16x8, w);
}
__device__ __forceinline__ float bf_lo(unsigned u) { return __builtin_bit_cast(float, u << 16); }
__device__ __forceinline__ float bf_hi(unsigned u) { return __builtin_bit_cast(float, u & 0xffff0000u); }

namespace pg8 {
constexpr int BM = 256, BK = 64, HALF = 128, HTB = HALF * BK * 2, STAGE_BYTES = 8 * HTB, NXCD = 8, WGM = 8;
__host__ __device__ __forceinline__ int lds_byte(int r, int c) { const int st = (r >> 4) * 2 + (c >> 5), rr = r & 15, cc = c & 31, ob = rr * 64 + cc * 2; return st * 1024 + (ob ^ (((ob >> 9) & 1) << 5)); }
__host__ __device__ __forceinline__ void stage_rc(int b, int& R, int& C) { const int st = b / 1024, sb = b % 1024, swz = sb ^ (((sb >> 9) & 1) << 5); R = (st >> 1) * 16 + swz / 64; C = (st & 1) * 32 + (swz % 64) / 2; }
__host__ __device__ __forceinline__ int perm32(int rho) { const int n = rho >> 4, i = rho & 15; return 8 * (i >> 2) + 4 * n + (i & 3); }
struct Unit { int pm, pn, e; };

struct DenseOrder {
    static constexpr bool GATHER = false;
    const char* A; const char* Bt; int K; int nM, nN, nwg, G, c;
    __device__ __forceinline__ void init(const void* A_, const void* Bt_, int M, int N, int K_, int G_, int c_) { A = (const char*)A_; Bt = (const char*)Bt_; K = K_; nM = M / BM; nN = N / BM; nwg = nM * nN; G = G_; c = c_; }
    __device__ __forceinline__ bool next(int i, Unit& u) const {
        const long L = (long)i * G + c; if (L >= nwg) return false;
        int wgid = (int)L; { const int q = nwg / NXCD, r = nwg % NXCD, xcd = wgid % NXCD, off = wgid / NXCD; wgid = (xcd < r ? xcd * (q + 1) : r * (q + 1) + (xcd - r) * q) + off; }
        const int nig = WGM * nN, gid = wgid / nig, fm = gid * WGM, gsz = (nM - fm) < WGM ? (nM - fm) : WGM;
        u.pm = fm + ((wgid % nig) % gsz); u.pn = (wgid % nig) / gsz; u.e = 0; return true;
    }
    __device__ __forceinline__ const char* abase(const Unit& u) const { return A + (size_t)u.pm * BM * K * 2; }
    __device__ __forceinline__ const char* bbase(const Unit& u) const { return Bt + (size_t)u.pn * BM * K * 2; }
};
template <bool G>
struct MoeOrderT {
    static constexpr bool GATHER = G;
    const char* A; const char* Wt; int K; int nN, nwg, G_, c; size_t estride; const int* rbe; const int* rowmap;
    __device__ __forceinline__ bool next(int i, Unit& u) const {
        const long L = (long)i * G_ + c; if (L >= nwg) return false;
        u.pm = (int)(L / nN); u.pn = (int)(L % nN); u.e = rbe[u.pm]; return true;
    }
    __device__ __forceinline__ const char* abase(const Unit& u) const { return G ? A : A + (size_t)u.pm * BM * K * 2; }
    __device__ __forceinline__ const char* bbase(const Unit& u) const { return Wt + (size_t)u.e * estride + (size_t)u.pn * BM * K * 2; }
};
struct EpiF32 {
    static constexpr bool PERM = false;
    float* C; int ldc;
    __device__ __forceinline__ void operator()(const f32x4 (&acc)[2][2][4][2], const Unit& u, int wr, int wc, int fr, int fq) const {
        const int row0 = u.pm * BM + wr * 64 + fr, col0 = u.pn * BM + wc * 32 + 4 * fq;
#pragma unroll
        for (int ai = 0; ai < 2; ++ai)
#pragma unroll
            for (int m = 0; m < 4; ++m) { float* rowp = C + (size_t)(row0 + ai * HALF + m * 16) * ldc + col0;
#pragma unroll
                for (int bj = 0; bj < 2; ++bj)
#pragma unroll
                    for (int n = 0; n < 2; ++n) *(f32x4*)(rowp + bj * HALF + n * 16) = acc[ai][bj][m][n]; }
    }
};
struct EpiProj {
    static constexpr bool PERM = true;
    bf16_t* O; int ldc; float* G; int lastt;
    __device__ __forceinline__ void operator()(const f32x4 (&acc)[2][2][4][2], const Unit& u, int wr, int wc, int fr, int fq) const {
        const int row0 = u.pm * BM + wr * 64 + fr, col0 = u.pn * BM + wc * 32 + 8 * fq;
#pragma unroll
        for (int ai = 0; ai < 2; ++ai)
#pragma unroll
            for (int m = 0; m < 4; ++m) { bf16_t* rowp = O + (size_t)(row0 + ai * HALF + m * 16) * ldc + col0;
#pragma unroll
                for (int bj = 0; bj < 2; ++bj) { const f32x4 v0 = acc[ai][bj][m][0], v1 = acc[ai][bj][m][1];
                    u32x4 w; w.x = pk2(v0[0], v0[1]); w.y = pk2(v0[2], v0[3]); w.z = pk2(v1[0], v1[1]); w.w = pk2(v1[2], v1[3]);
                    *(u32x4*)(rowp + bj * HALF) = w; } }
        if (u.pn == lastt) {
#pragma unroll
            for (int ai = 0; ai < 2; ++ai)
#pragma unroll
                for (int m = 0; m < 4; ++m) { float* rowp = G + (size_t)(row0 + ai * HALF + m * 16) * BM + wc * 32 + 8 * fq;
#pragma unroll
                    for (int bj = 0; bj < 2; ++bj) { *(f32x4*)(rowp + bj * HALF) = acc[ai][bj][m][0]; *(f32x4*)(rowp + bj * HALF + 4) = acc[ai][bj][m][1]; } }
        }
    }
};
struct EpiBf16Bias {
    static constexpr bool PERM = true;
    bf16_t* O; int ldc; const float* bias; int bias_estride;
    __device__ __forceinline__ void operator()(const f32x4 (&acc)[2][2][4][2], const Unit& u, int wr, int wc, int fr, int fq) const {
        const int row0 = u.pm * BM + wr * 64 + fr, col0 = u.pn * BM + wc * 32 + 8 * fq;
        const float* bp = bias + (size_t)u.e * bias_estride + col0;
        f32x4 bv[2][2];
#pragma unroll
        for (int bj = 0; bj < 2; ++bj)
#pragma unroll
            for (int n = 0; n < 2; ++n) bv[bj][n] = *(const f32x4*)(bp + bj * HALF + 4 * n);
#pragma unroll
        for (int ai = 0; ai < 2; ++ai)
#pragma unroll
            for (int m = 0; m < 4; ++m) { bf16_t* rowp = O + (size_t)(row0 + ai * HALF + m * 16) * ldc + col0;
#pragma unroll
                for (int bj = 0; bj < 2; ++bj) { const f32x4 v0 = acc[ai][bj][m][0] + bv[bj][0], v1 = acc[ai][bj][m][1] + bv[bj][1];
                    u32x4 w; w.x = pk2(v0[0], v0[1]); w.y = pk2(v0[2], v0[3]); w.z = pk2(v1[0], v1[1]); w.w = pk2(v1[2], v1[3]);
                    *(u32x4*)(rowp + bj * HALF) = w; } }
    }
};
__device__ __forceinline__ float swiglu1(float g, float uu) { g = fminf(g, 7.0f); uu = fminf(fmaxf(uu, -7.0f), 7.0f); return (uu + 1.0f) * (g * frcp(1.0f + fexp(-1.702f * g))); }
struct EpiSwiglu {
    static constexpr bool PERM = true;
    bf16_t* O; const float* b1;
    __device__ __forceinline__ void operator()(const f32x4 (&acc)[2][2][4][2], const Unit& u, int wr, int wc, int fr, int fq) const {
        const int row0 = u.pm * BM + wr * 64 + fr, j0 = u.pn * HALF + wc * 32 + 8 * fq;
        const float* bg = b1 + (size_t)u.e * 2 * DFF + j0; const float* bu = bg + DFF;
        f32x4 g4[2], u4[2];
#pragma unroll
        for (int n = 0; n < 2; ++n) { g4[n] = *(const f32x4*)(bg + 4 * n); u4[n] = *(const f32x4*)(bu + 4 * n); }
#pragma unroll
        for (int ai = 0; ai < 2; ++ai)
#pragma unroll
            for (int m = 0; m < 4; ++m) {
                float o[8];
#pragma unroll
                for (int n = 0; n < 2; ++n)
#pragma unroll
                    for (int q = 0; q < 4; ++q) o[n * 4 + q] = swiglu1(acc[ai][0][m][n][q] + g4[n][q], acc[ai][1][m][n][q] + u4[n][q]);
                u32x4 w; w.x = pk2(o[0], o[1]); w.y = pk2(o[2], o[3]); w.z = pk2(o[4], o[5]); w.w = pk2(o[6], o[7]);
                *(u32x4*)(O + (size_t)(row0 + ai * HALF + m * 16) * DFF + j0) = w;
            }
    }
};

template <class Epi, class Sched, bool SP2 = (MK_SP2 != 0)>
__device__ __forceinline__ void gemm_phase(LAS unsigned char* lds, const int K, const Sched& S, const Epi& E, const int tid) {
    const int wid = RFL(tid >> 6), lane = tid & 63, wr = wid >> 2, wc = wid & 3, fr = lane & 15, fq = lane >> 4;
    const int nt = K / BK;
    unsigned voffA[2], voffB[2]; int gR[2]; unsigned gC[2];
#pragma unroll
    for (int i = 0; i < 2; ++i) { int R, C; stage_rc(tid * 16 + i * 8192, R, C); const int Rb = Epi::PERM ? ((R & ~31) + perm32(R & 31)) : R;
        voffA[i] = (unsigned)(R * K + C) * 2u; voffB[i] = (unsigned)(Rb * K + C) * 2u; gR[i] = R; gC[i] = (unsigned)C * 2u; }
    unsigned va[2][2], vn[2][2];
#define PG8_GOFF(dst, unit) do { if constexpr (Sched::GATHER) { _Pragma("unroll") for (int h_ = 0; h_ < 2; ++h_) _Pragma("unroll") for (int i_ = 0; i_ < 2; ++i_) \
        dst[h_][i_] = (unsigned)S.rowmap[(unit).pm * BM + h_ * HALF + gR[i_]] * (unsigned)(K * 2) + gC[i_]; } } while (0)
#define PG8_STAGE_A(bufoff, bp, kb, h, nx) do { if constexpr (Sched::GATHER) { const char* gb_ = S.A + (kb); _Pragma("unroll") for (int _i = 0; _i < 2; ++_i) \
        GLDS16(gb_ + ((nx) ? vn[h][_i] : va[h][_i]), lds + (bufoff) + ldsw + _i * 8192); } else { PG8_STAGE(bufoff, bp, voffA); } } while (0)
    const size_t kstep = (size_t)(BK * 2);
    const size_t hstep = (size_t)HALF * K * 2;
    const unsigned ldsw = (unsigned)wid * 1024u;
    const int aoff = lds_byte(wr * 64 + fr, fq * 8), boff = lds_byte(wc * 32 + fr, fq * 8);
#define PG8_SA(b, h) (((b) * 2 + (h)) * HTB)
#define PG8_SB(b, h) ((4 + (b) * 2 + (h)) * HTB)
#define PG8_STAGE(bufoff, gbase, voff) do { _Pragma("unroll") for (int _i = 0; _i < 2; ++_i) \
        GLDS16((const char*)(gbase) + (voff)[_i], lds + (bufoff) + ldsw + _i * 8192); } while (0)
#define PG8_LDA(dst, b, h) do { _Pragma("unroll") for (int m = 0; m < 4; ++m) _Pragma("unroll") for (int k = 0; k < 2; ++k) dst[m][k] = *(const LAS bf16x8*)(lds + PG8_SA(b, h) + aoff + m * 2048 + k * 1024); } while (0)
#define PG8_LDB(dst, b, h) do { _Pragma("unroll") for (int n = 0; n < 2; ++n) _Pragma("unroll") for (int k = 0; k < 2; ++k) dst[n][k] = *(const LAS bf16x8*)(lds + PG8_SB(b, h) + boff + n * 2048 + k * 1024); } while (0)
#define PG8_MMA(ai, bj, At, Bt) do { SETPRIO(1); _Pragma("unroll") for (int m = 0; m < 4; ++m) _Pragma("unroll") for (int n = 0; n < 2; ++n) _Pragma("unroll") for (int k = 0; k < 2; ++k) \
        acc[ai][bj][m][n] = MFMA16(Bt[n][k], At[m][k], acc[ai][bj][m][n]); SETPRIO(0); } while (0)
    Unit cur, nxt; int ui = 0;
    if (!S.next(0, cur)) return;
    f32x4 acc[2][2][4][2];
#pragma unroll
    for (int a = 0; a < 2; ++a)
#pragma unroll
        for (int b = 0; b < 2; ++b)
#pragma unroll
            for (int m = 0; m < 4; ++m)
#pragma unroll
                for (int n = 0; n < 2; ++n) acc[a][b][m][n] = (f32x4){0.f, 0.f, 0.f, 0.f};
    bf16x8 At[4][2], B0[2][2], B1[2][2];
    const char* cA = S.abase(cur); const char* cB = S.bbase(cur);
    PG8_GOFF(va, cur);
    if constexpr (SP2) {
        PG8_STAGE(PG8_SB(0, 0), cB, voffB); PG8_STAGE(PG8_SB(0, 1), cB + hstep, voffB); PG8_STAGE_A(PG8_SA(0, 0), cA, 0, 0, false); PG8_STAGE_A(PG8_SA(0, 1), cA + hstep, 0, 1, false);
        if (wr == 1) S_BARRIER();
        WAIT_V(2); S_BARRIER();
        PG8_STAGE(PG8_SB(1, 0), cB + kstep, voffB); PG8_STAGE_A(PG8_SA(1, 0), cA + kstep, kstep, 0, false); PG8_STAGE(PG8_SB(1, 1), cB + hstep + kstep, voffB);
        WAIT_V(6); S_BARRIER();
    } else {
    PG8_STAGE(PG8_SB(0, 0), cB, voffB); PG8_STAGE_A(PG8_SA(0, 0), cA, 0, 0, false); PG8_STAGE(PG8_SB(0, 1), cB + hstep, voffB); PG8_STAGE_A(PG8_SA(0, 1), cA + hstep, 0, 1, false);
    if (wr == 1) S_BARRIER();
    WAIT_V(4); S_BARRIER();
    PG8_STAGE(PG8_SB(1, 0), cB + kstep, voffB); PG8_STAGE_A(PG8_SA(1, 0), cA + kstep, kstep, 0, false); PG8_STAGE(PG8_SB(1, 1), cB + hstep + kstep, voffB);
    WAIT_V(6); S_BARRIER();
    }
    for (;;) {
        const bool has_next = S.next(ui + 1, nxt);
        const char* nA = has_next ? S.abase(nxt) : cA; const char* nB = has_next ? S.bbase(nxt) : cB;
        if constexpr (Sched::GATHER) { if (has_next) { PG8_GOFF(vn, nxt); } else {
#pragma unroll
            for (int h_ = 0; h_ < 2; ++h_) { vn[h_][0] = va[h_][0]; vn[h_][1] = va[h_][1]; } } }
        for (int t = 0; t < nt; t += 2) {
            const bool last = (t == nt - 2);
            const char* a1 = cA + (size_t)(t + 1) * kstep;
            const char* a2 = last ? nA : cA + (size_t)(t + 2) * kstep; const char* b2 = last ? nB : cB + (size_t)(t + 2) * kstep;
            const char* a3 = a2 + kstep; const char* b3 = b2 + kstep;
            if constexpr (SP2) {
            PG8_LDB(B0, 0, 0); PG8_LDB(B1, 0, 1); SCHED_BAR(); PG8_LDA(At, 0, 0); PG8_STAGE_A(PG8_SA(1, 1), a1 + hstep, (size_t)(t + 1) * kstep, 1, false);
            WAIT_V(8); WAIT_L(0); S_BARRIER(); PG8_MMA(0, 0, At, B0); PG8_MMA(0, 1, At, B1); S_BARRIER(); SCHED_BAR();
            PG8_LDA(At, 0, 1); PG8_STAGE(PG8_SB(0, 0), b2, voffB); PG8_STAGE(PG8_SB(0, 1), b2 + hstep, voffB); PG8_STAGE_A(PG8_SA(0, 0), a2, (last ? (size_t)0 : (size_t)(t + 2) * kstep), 0, last);
            WAIT_V(8); WAIT_L(0); S_BARRIER(); PG8_MMA(1, 0, At, B0); PG8_MMA(1, 1, At, B1); S_BARRIER(); SCHED_BAR();
            PG8_LDB(B0, 1, 0); PG8_LDB(B1, 1, 1); SCHED_BAR(); PG8_LDA(At, 1, 0); PG8_STAGE_A(PG8_SA(0, 1), a2 + hstep, (last ? (size_t)0 : (size_t)(t + 2) * kstep), 1, last);
            WAIT_V(8); WAIT_L(0); S_BARRIER(); PG8_MMA(0, 0, At, B0); PG8_MMA(0, 1, At, B1); S_BARRIER(); SCHED_BAR();
            PG8_LDA(At, 1, 1); PG8_STAGE(PG8_SB(1, 0), b3, voffB); PG8_STAGE(PG8_SB(1, 1), b3 + hstep, voffB); PG8_STAGE_A(PG8_SA(1, 0), a3, (last ? kstep : (size_t)(t + 3) * kstep), 0, last);
            WAIT_V(8); WAIT_L(0); S_BARRIER(); PG8_MMA(1, 0, At, B0); PG8_MMA(1, 1, At, B1); S_BARRIER(); SCHED_BAR();
            } else {
            PG8_LDB(B0, 0, 0); SCHED_BAR(); PG8_LDA(At, 0, 0); PG8_STAGE_A(PG8_SA(1, 1), a1 + hstep, (size_t)(t + 1) * kstep, 1, false);
            WAIT_L(8); S_BARRIER(); WAIT_L(0); PG8_MMA(0, 0, At, B0); S_BARRIER(); SCHED_BAR();
            PG8_LDB(B1, 0, 1); PG8_STAGE(PG8_SB(0, 0), b2, voffB);
            S_BARRIER(); WAIT_L(0); PG8_MMA(0, 1, At, B1); S_BARRIER();
            PG8_LDA(At, 0, 1); PG8_STAGE_A(PG8_SA(0, 0), a2, (last ? (size_t)0 : (size_t)(t + 2) * kstep), 0, last);
            S_BARRIER(); WAIT_L(0); PG8_MMA(1, 0, At, B0); S_BARRIER(); SCHED_BAR();
            PG8_STAGE(PG8_SB(0, 1), b2 + hstep, voffB);
            WAIT_V(6); S_BARRIER(); PG8_MMA(1, 1, At, B1); S_BARRIER();
            PG8_LDB(B0, 1, 0); SCHED_BAR(); PG8_LDA(At, 1, 0); PG8_STAGE_A(PG8_SA(0, 1), a2 + hstep, (last ? (size_t)0 : (size_t)(t + 2) * kstep), 1, last);
            WAIT_L(8); S_BARRIER(); WAIT_L(0); PG8_MMA(0, 0, At, B0); S_BARRIER(); SCHED_BAR();
            PG8_LDB(B1, 1, 1); PG8_STAGE(PG8_SB(1, 0), b3, voffB);
            S_BARRIER(); WAIT_L(0); PG8_MMA(0, 1, At, B1); S_BARRIER();
            PG8_LDA(At, 1, 1); PG8_STAGE_A(PG8_SA(1, 0), a3, (last ? kstep : (size_t)(t + 3) * kstep), 0, last);
            S_BARRIER(); WAIT_L(0); PG8_MMA(1, 0, At, B0); S_BARRIER(); SCHED_BAR();
            PG8_STAGE(PG8_SB(1, 1), b3 + hstep, voffB);
            WAIT_V(6); S_BARRIER(); PG8_MMA(1, 1, At, B1); S_BARRIER();
            }
        }
        if (wr == 0) S_BARRIER();
        E(acc, cur, wr, wc, fr, fq);
        if (!has_next) break;
#pragma unroll
        for (int a = 0; a < 2; ++a)
#pragma unroll
            for (int b = 0; b < 2; ++b)
#pragma unroll
                for (int m = 0; m < 4; ++m)
#pragma unroll
                    for (int n = 0; n < 2; ++n) acc[a][b][m][n] = (f32x4){0.f, 0.f, 0.f, 0.f};
        cur = nxt; cA = nA; cB = nB; ++ui;
        if constexpr (Sched::GATHER) {
#pragma unroll
            for (int h_ = 0; h_ < 2; ++h_) { va[h_][0] = vn[h_][0]; va[h_][1] = vn[h_][1]; } }
        if (wr == 1) S_BARRIER();
    }
    WAIT_V(0);
    S_BARRIER();
#undef PG8_SA
#undef PG8_SB
#undef PG8_STAGE
#undef PG8_STAGE_A
#undef PG8_GOFF
#undef PG8_LDA
#undef PG8_LDB
#undef PG8_MMA
}
}

__device__ __forceinline__ float row16_sum(float x) {
#ifdef EMU
    x += __shfl_xor(x, 1); x += __shfl_xor(x, 2); x += __shfl_xor(x, 4); x += __shfl_xor(x, 8); return x;
#else
#define DPPF(v, ctrl) __builtin_bit_cast(float, __builtin_amdgcn_update_dpp(0, __builtin_bit_cast(int, (v)), (ctrl), 0xF, 0xF, false))
    x += DPPF(x, 0xB1); x += DPPF(x, 0x4E); x += DPPF(x, 0x141); x += DPPF(x, 0x140); return x;
#undef DPPF
#endif
}
__device__ __forceinline__ float row32_sum(float x) {
    x = row16_sum(x);
#ifdef EMU
    x += __shfl_xor(x, 32); return x;
#else
    float a = x, b = x;
    asm volatile("s_nop 1\n\tv_permlane32_swap_b32 %0, %1" : "+v"(a), "+v"(b));
    return a + b;
#endif
}
__device__ __forceinline__ float wave_sum_fast(float x, int lane) {
    x = row32_sum(x);
    x += SHX(x, 16, lane);
    return x;
}
__device__ __forceinline__ void transpose_item(const float* W, int K, int N, bf16_t* WT, int k0, int n0, int dst_row0, float* scr, int lane) {
    const int n4 = (lane & 15) * 4, kr = lane >> 4;
#pragma unroll 8
    for (int i = 0; i < 16; ++i) {
        const int kk = 4 * i + kr;
        f32x4 v = (f32x4){0.f, 0.f, 0.f, 0.f};
        if (n0 + n4 < N) v = *(const f32x4*)(W + (size_t)(k0 + kk) * N + n0 + n4);
        float* d = scr + kk * 65 + n4; d[0] = v.x; d[1] = v.y; d[2] = v.z; d[3] = v.w;
    }
    WAVE_SYNC();
    const int c = lane & 7;
#pragma unroll
    for (int j = 0; j < 8; ++j) { const int n = (lane >> 3) + 8 * j; const float* sp = scr + (8 * c) * 65 + n;
        u32x4 o; o.x = pk2(sp[0 * 65], sp[1 * 65]); o.y = pk2(sp[2 * 65], sp[3 * 65]); o.z = pk2(sp[4 * 65], sp[5 * 65]); o.w = pk2(sp[6 * 65], sp[7 * 65]);
        *(u32x4*)(WT + (size_t)(dst_row0 + n) * K + k0 + 8 * c) = o; }
    WAVE_SYNC();
}
__device__ __forceinline__ void phase_prologue(const Params& P, unsigned char* smem, int wv) {
    ParamsPtr pp = PARAMS_PTR(P); PIN_S(pp); unsigned char* ws = pp->ws; int bidx = (int)blockIdx.x, gdim = (int)gridDim.x; PIN_S(bidx); PIN_S(gdim);
    const int tid = phase_tid(wv), lane = tid & 63, wave = tid >> 6;
    float* scr = (float*)smem + wave * (64 * 65);
    const int gw = bidx * NWAVES + wave, ngw = NWAVES * gdim;
    constexpr int I_IN = 16 * (PLD / 64), I_OUT = 16 * 16, I_W1 = NE * 16 * 32, I_W2 = NE * 16 * 16, I_L = I_IN + I_OUT + I_W1 + I_W2;
    for (int it = gw; it < NL * I_L; it += ngw) {
        const int l = it / I_L; int r = it % I_L;
        if (r < I_IN) { const int kb = r / (PLD / 64), nb = r % (PLD / 64);
            transpose_item(pp->in[1] + (size_t)l * D * PIN, D, PIN, (bf16_t*)(ws + O_WIN) + (size_t)l * PLD * D, kb * 64, nb * 64, nb * 64, scr, lane); continue; }
        r -= I_IN;
        if (r < I_OUT) { const int kb = r / 16, nb = r % 16;
            transpose_item(pp->in[21] + (size_t)l * D * D, D, D, (bf16_t*)(ws + O_WOUT) + (size_t)l * D * D, kb * 64, nb * 64, nb * 64, scr, lane); continue; }
        r -= I_OUT;
        if (r < I_W1) { const int e = r / (16 * 32), q = r % (16 * 32), kb = q / 32, nb = q % 32, n0 = nb * 64;
            const int dst = n0 < DFF ? (n0 / 128) * 256 + (n0 % 128) : ((n0 - DFF) / 128) * 256 + 128 + ((n0 - DFF) % 128);
            transpose_item(pp->in[26] + ((size_t)l * NE + e) * D * 2 * DFF, D, 2 * DFF, (bf16_t*)(ws + O_W1) + ((size_t)l * NE + e) * 2 * DFF * D, kb * 64, n0, dst, scr, lane); continue; }
        r -= I_W1;
        { const int e = r / (16 * 16), q = r % (16 * 16), kb = q / 16, nb = q % 16;
            transpose_item(pp->in[28] + ((size_t)l * NE + e) * DFF * D, DFF, D, (bf16_t*)(ws + O_W2) + ((size_t)l * NE + e) * D * DFF, kb * 64, nb * 64, nb * 64, scr, lane); }
    }
    {
        const float* gw_ = pp->in[4]; bf16_t* WSB = (bf16_t*)(ws + O_WSB);
        for (size_t i = ((size_t)bidx * NTHREADS + tid) * 4; i < (size_t)NL * GH * CH * CH; i += (size_t)gdim * NTHREADS * 4) {
            const f32x4 v = *(const f32x4*)(gw_ + i); u32x2 o; o.x = pk2(v.x, v.y); o.y = pk2(v.z, v.w); *(u32x2*)(WSB + i) = o;
        }
    }
    {
        bf16_t* LWT = (bf16_t*)(ws + O_LWT);
        for (int i = bidx * NTHREADS + tid; i < NL * 1920 * 128; i += gdim * NTHREADS) {
            const int k = i & 127, n = (i >> 7) % 1920, ll = i / (1920 * 128);
            float v = 0.f;
            if (n < 1536) { if (k < 64) { const int grp = n / 768, d = (n / 384) & 1, c = n % 384; v = (grp == 0 ? pp->in[8] : pp->in[10])[(((size_t)ll * 2 + d) * 64 + k) * RW + c]; } }
            else v = pp->in[11][((size_t)ll * 128 + k) * RW + (n - 1536)];
            LWT[i] = (bf16_t)f2bf(v);
        }
    }
    {
        bf16_t* RWT = (bf16_t*)(ws + O_RWT);
        for (int i = bidx * NTHREADS + tid; i < NL * NE * D; i += gdim * NTHREADS) {
            const int k = i % D, e = (i / D) % NE, ll = i / (D * NE);
            const float v = pp->in[24][((size_t)ll * D + k) * NE + e];
            const unsigned hi = f2bf(v); const float lo = v - bf_lo(hi);
            RWT[((size_t)(ll * 2 + 0) * NE + e) * D + k] = (bf16_t)hi; RWT[((size_t)(ll * 2 + 1) * NE + e) * D + k] = (bf16_t)f2bf(lo);
        }
    }
    const float* x = pp->in[0]; bf16_t* XB = (bf16_t*)(ws + O_XB);
    for (size_t i = ((size_t)bidx * NTHREADS + tid) * 4; i < (size_t)T * D; i += (size_t)gdim * NTHREADS * 4) {
        const f32x4 v = *(const f32x4*)(x + i); u32x2 o; o.x = pk2(v.x, v.y); o.y = pk2(v.z, v.w); *(u32x2*)(XB + i) = o;
    }
}

__device__ __forceinline__ float tshift(const float* P, int t, int s, int col, const float* mu0, const float* mu1, int rc) {
    const float cur = P[(size_t)t * PLD + col];
    const float prv = s > 0 ? P[(size_t)(t - 1) * PLD + col] : 0.f;
    const float nxt = s < S - 1 ? P[(size_t)(t + 1) * PLD + col] : 0.f;
    return cur + mu0[rc] * (prv - cur) + mu1[rc] * (nxt - cur);
}

__device__ __forceinline__ void phase_prep(const Params& P, int l, unsigned char* smem, int wv) {
    ParamsPtr pp = PARAMS_PTR(P); PIN_S(pp); unsigned char* ws = pp->ws; int bidx = (int)blockIdx.x, gdim = (int)gridDim.x; PIN_S(bidx); PIN_S(gdim);
    const bf16_t* proj = (const bf16_t*)(ws + O_PROJ); const float* projg = (const float*)(ws + O_PROJG);
    float* UG = (float*)(ws + O_UG); bf16_t* VNT = (bf16_t*)(ws + O_VNT);
    float* RR = (float*)(ws + O_RR); float* VV = (float*)(ws + O_VV); float* KK = (float*)(ws + O_KK);
    float* KD = (float*)(ws + O_KD); float* ICLR = (float*)(ws + O_ICLR);
    float* GATE = (float*)(ws + O_GATE); float* BONUS = (float*)(ws + O_BONUS); float* LWG = (float*)(ws + O_LW);
    bf16_t* RB = (bf16_t*)(ws + O_RB); bf16_t* VB = (bf16_t*)(ws + O_VB); bf16_t* KKB = (bf16_t*)(ws + O_KKB); bf16_t* BBB = (bf16_t*)(ws + O_BBB); bf16_t* KDB = (bf16_t*)(ws + O_KDB);
#if !MK_RWKV_CHUNKED
    float* DEC = (float*)(ws + O_DEC); float* BRKR = (float*)(ws + O_BRKR);
#endif
    bf16_t* MQB = (bf16_t*)(ws + O_MQB); bf16_t* MKB = (bf16_t*)(ws + O_MKB); bf16_t* KT = (bf16_t*)(ws + O_KT); bf16_t* VT = (bf16_t*)(ws + O_VT);
    float* IG = (float*)(ws + O_IG); float* LF = (float*)(ws + O_LF);
    const bf16_t* LWT = (const bf16_t*)(ws + O_LWT) + (size_t)l * 1920 * 128;
    const float* gln_g = pp->in[2] + (size_t)l * GW; const float* gln_b = pp->in[3] + (size_t)l * GW;
    const float* mu0 = pp->in[6] + (size_t)l * 2 * RPROJ; const float* mu1 = mu0 + RPROJ;
    const float* w0 = pp->in[7] + (size_t)l * 2 * RW; const float* a0 = pp->in[9] + (size_t)l * 2 * RW;
    const float* k_k = pp->in[12] + (size_t)l * RW; const float* k_a = pp->in[13] + (size_t)l * RW; const float* r_k = pp->in[14] + (size_t)l * RW;
    const float* conv_w = pp->in[17] + (size_t)l * 3 * 768; const float* conv_b = pp->in[18] + (size_t)l * 768; const float* gate_b = pp->in[19] + (size_t)l * 24;
    float* win = (float*)smem;
    bf16_t* lin = (bf16_t*)(smem + 101376);
    bf16_t* tvn = (bf16_t*)(smem + 110592);
    bf16_t* tk = (bf16_t*)(smem + 118784);
    bf16_t* tv = (bf16_t*)(smem + 131072);
    constexpr int LIN = 264;
    const int tid = phase_tid(wv), lane = tid & 63, wave = tid >> 6, col = lane & 15, g = lane >> 4;
    for (int u = bidx; u < T / 16; u += gdim) {
        const int t0 = u * 16, s0 = t0 % S, bb = t0 / S;
        __syncthreads();
        {
            u32x2 wb[18];
#pragma unroll
            for (int row = 0; row < 18; ++row) {
                const int sq = s0 - 1 + row;
                wb[row] = (u32x2){0u, 0u};
                if (sq >= 0 && sq < S && tid < 352) wb[row] = *(const u32x2*)(proj + (size_t)(t0 - 1 + row) * PLD + C_RW + tid * 4);
            }
            if (tid < 352) {
#pragma unroll
                for (int row = 0; row < 18; ++row) *(f32x4*)(win + row * RPROJ + tid * 4) = (f32x4){bf_lo(wb[row].x), bf_hi(wb[row].x), bf_lo(wb[row].y), bf_hi(wb[row].y)};
            }
        }
        for (int rep_ = 0; rep_ < (MK_PROBE == 3 ? 2 : 1); ++rep_) {
            const int i = tid >> 5, l32 = tid & 31, t = t0 + i;
            float v[8], ug[8]; float sum = 0.f;
#pragma unroll
            for (int j = 0; j < 8; ++j) { const int c = j * 32 + l32; ug[j] = bf_lo((unsigned)proj[(size_t)t * PLD + c]); v[j] = bf_lo((unsigned)proj[(size_t)t * PLD + GW + c]); }
#pragma unroll
            for (int j = 0; j < 8; ++j) { const int c = j * 32 + l32; UG[(size_t)t * GW + c] = geluf_(ug[j]); v[j] = geluf_(v[j]); sum += v[j]; }
#pragma unroll
            for (int o = 16; o >= 1; o >>= 1) sum += SHX(sum, o, lane);
            const float mean = sum * (1.0f / GW); float q = 0.f;
#pragma unroll
            for (int j = 0; j < 8; ++j) { const float d = v[j] - mean; q += d * d; }
#pragma unroll
            for (int o = 16; o >= 1; o >>= 1) q += SHX(q, o, lane);
            const float rstd = 1.0f / sqrtf(q * (1.0f / GW) + LN_EPS);
#pragma unroll
            for (int j = 0; j < 8; ++j) { const int c = j * 32 + l32; tvn[c * 16 + i] = (bf16_t)f2bf((v[j] - mean) * rstd * gln_g[c] + gln_b[c]); }
        }
        __syncthreads();
        {
            const int hf = tid & 1, c = tid >> 1;
            *(u32x4*)(VNT + ((size_t)bb * GW + c) * S + s0 + hf * 8) = *(const u32x4*)(tvn + c * 16 + hf * 8);
        }
        for (int idx = tid; idx < 16 * 256; idx += NTHREADS) {
            const int i = idx >> 8, j = idx & 255, rc = 1152 + j;
            const float pv = win[i * RPROJ + rc], cv = win[(i + 1) * RPROJ + rc], nv = win[(i + 2) * RPROJ + rc];
            const float x = cv + mu0[rc] * (pv - cv) + mu1[rc] * (nv - cv);
            lin[i * LIN + j] = (bf16_t)f2bf(j < 64 ? ftanh(x) : (j < 128 ? x : sigmoidf_(x)));
        }
        __syncthreads();
        for (int rep_ = 0; rep_ < (MK_PROBE == 1 ? 2 : 1); ++rep_) {
#pragma unroll 1
            for (int qg = 0; qg < 3; ++qg) {
                bf16x8 bw_[5][4]; float bias_[5];
#pragma unroll
                for (int q5 = 0; q5 < 5; ++q5) {
                    const int nt = wave * 15 + qg * 5 + q5, grp = nt / 24, c = (nt % 24) * 16 + col;
                    const bf16_t* bw = LWT + (size_t)(nt * 16 + col) * 128 + 8 * g;
#pragma unroll
                    for (int ks = 0; ks < 2; ++ks) bw_[q5][ks] = *(const bf16x8*)(bw + ks * 32);
                    if (grp == 4) {
#pragma unroll
                        for (int ks = 2; ks < 4; ++ks) bw_[q5][ks] = *(const bf16x8*)(bw + ks * 32);
                    }
                    bias_[q5] = grp < 2 ? w0[grp * RW + c] : (grp < 4 ? a0[(grp - 2) * RW + c] : 0.f);
                }
#pragma unroll
                for (int q5 = 0; q5 < 5; ++q5) {
                    const int nt = wave * 15 + qg * 5 + q5, grp = nt / 24, c = (nt % 24) * 16 + col;
                    const int kcol = grp < 2 ? 0 : (grp < 4 ? 64 : 128);
                    f32x4 acc = (f32x4){0.f, 0.f, 0.f, 0.f};
#pragma unroll
                    for (int ks = 0; ks < 2; ++ks) acc = MFMA16(*(const bf16x8*)(lin + col * LIN + kcol + ks * 32 + 8 * g), bw_[q5][ks], acc);
                    if (grp == 4) {
#pragma unroll
                        for (int ks = 2; ks < 4; ++ks) acc = MFMA16(*(const bf16x8*)(lin + col * LIN + kcol + ks * 32 + 8 * g), bw_[q5][ks], acc);
                    }
                    if (grp < 2) {
#pragma unroll
                        for (int r = 0; r < 4; ++r) { const float lw = -fexp(-softplusf_(-(acc[r] + bias_[q5])) - 0.5f); const size_t o = (size_t)grp * T * RW + (size_t)(t0 + 4 * g + r) * RW + c; LWG[o] = lw;
#if !MK_RWKV_CHUNKED
                            DEC[o] = expf(lw);
#endif
                        }
                    } else if (grp < 4) {
#pragma unroll
                        for (int r = 0; r < 4; ++r) ICLR[(size_t)(grp - 2) * T * RW + (size_t)(t0 + 4 * g + r) * RW + c] = sigmoidf_(acc[r] + bias_[q5]);
                    } else {
#pragma unroll
                        for (int r = 0; r < 4; ++r) GATE[(size_t)(t0 + 4 * g + r) * RW + c] = acc[r];
                    }
                }
            }
        }
        __syncthreads();
        for (int rep_ = 0; rep_ < (MK_PROBE == 2 ? 2 : 1); ++rep_) if (wave < 6) {
            const int c = tid, h = wave;
            const float kkc = k_k[c], kac = k_a[c], rkc = r_k[c];
            const float m0r = mu0[c], m1r = mu1[c], m0k = mu0[RW + c], m1k = mu1[RW + c], m0v = mu0[2 * RW + c], m1v = mu1[2 * RW + c];
            float ic0[16], ic1[16];
#pragma unroll
            for (int i = 0; i < 16; ++i) { const size_t o = (size_t)(t0 + i) * RW + c; ic0[i] = ICLR[o]; ic1[i] = ICLR[(size_t)T * RW + o]; }
#pragma unroll
            for (int i = 0; i < 16; ++i) {
                const int t = t0 + i;
                const float* w_ = win + i * RPROJ + c;
                const float rp = w_[0], rc_ = w_[RPROJ], rn = w_[2 * RPROJ];
                const float kp = w_[RW], kc_ = w_[RPROJ + RW], kn = w_[2 * RPROJ + RW];
                const float vp = w_[2 * RW], vc_ = w_[RPROJ + 2 * RW], vn = w_[2 * RPROJ + 2 * RW];
                const float r = rc_ + m0r * (rp - rc_) + m1r * (rn - rc_);
                const float k = kc_ + m0k * (kp - kc_) + m1k * (kn - kc_);
                const float v = vc_ + m0v * (vp - vc_) + m1v * (vn - vc_);
                const size_t o = (size_t)t * RW + c;
                const float kq = k * kkc;
                const float n2 = wave_sum_fast(kq * kq, lane);
                const float kk = kq / fmaxf(sqrtf(n2), 1e-12f);
                const float kd0 = k * (1.0f + (ic0[i] - 1.0f) * kac), kd1 = k * (1.0f + (ic1[i] - 1.0f) * kac);
                const float bon = wave_sum_fast(r * (kd0 + kd1) * rkc, lane);
#if MK_RWKV_CHUNKED
                RB[o] = (bf16_t)f2bf(r); VB[o] = (bf16_t)f2bf(v); KKB[o] = (bf16_t)f2bf(kk);
                BBB[o] = (bf16_t)f2bf(kk * ic0[i]); BBB[(size_t)T * RW + o] = (bf16_t)f2bf(kk * ic1[i]);
                KDB[o] = (bf16_t)f2bf(kd0); KDB[(size_t)T * RW + o] = (bf16_t)f2bf(kd1);
#else
                RR[o] = r; VV[o] = v; KK[o] = kk;
                KD[o] = kd0; KD[(size_t)T * RW + o] = kd1;
#endif
                if (lane == 0) BONUS[(size_t)t * RH + h] = bon;
#if !MK_RWKV_CHUNKED
                { const float br0 = wave_sum(kk * ic0[i] * r, lane), br1 = wave_sum(kk * ic1[i] * r, lane), kr0 = wave_sum(kd0 * r, lane), kr1 = wave_sum(kd1 * r, lane);
                  if (lane == 0) { BRKR[((size_t)t * RH + h) * 2] = br0; BRKR[((size_t)t * RH + h) * 2 + 1] = kr0; BRKR[((size_t)(T + t) * RH + h) * 2] = br1; BRKR[((size_t)(T + t) * RH + h) * 2 + 1] = kr1; } }
#endif
            }
        }
        __syncthreads();
        {
            u32x2 wb[9], vb[3];
            const int rsel = tid >= 192 ? 1 : 0, c4 = tid - rsel * 192;
#pragma unroll
            for (int it = 0; it < 9; ++it) {
                const int row = 2 * it + rsel, sq = s0 - 1 + row;
                wb[it] = (u32x2){0u, 0u};
                if (tid < 384 && sq >= 0 && sq < S) wb[it] = *(const u32x2*)(proj + (size_t)(t0 - 1 + row) * PLD + C_MW + c4 * 4);
            }
#pragma unroll
            for (int it = 0; it < 3; ++it) { const int idx = tid + it * NTHREADS, i = idx / 96, cc = (idx % 96) * 4; vb[it] = *(const u32x2*)(proj + (size_t)(t0 + i) * PLD + C_MW + 2 * MW + cc); }
            if (tid < 384) {
#pragma unroll
                for (int it = 0; it < 9; ++it) *(f32x4*)(win + (2 * it + rsel) * 768 + c4 * 4) = (f32x4){bf_lo(wb[it].x), bf_hi(wb[it].x), bf_lo(wb[it].y), bf_hi(wb[it].y)};
            }
#pragma unroll
            for (int it = 0; it < 3; ++it) { const int idx = tid + it * NTHREADS, i = idx / 96, cc = (idx % 96) * 4; const u32x2 v = vb[it];
                tv[(cc + 0) * 16 + i] = (bf16_t)(v.x & 0xffffu); tv[(cc + 1) * 16 + i] = (bf16_t)(v.x >> 16); tv[(cc + 2) * 16 + i] = (bf16_t)(v.y & 0xffffu); tv[(cc + 3) * 16 + i] = (bf16_t)(v.y >> 16); }
        }
        for (int idx = tid; idx < 16 * 24; idx += NTHREADS) {
            const int i = idx / 24, gi = idx % 24, t = t0 + i;
            const int isf = gi / 12, dir = (gi / 6) & 1, h = gi % 6;
            const float gg = projg[(size_t)t * 256 + (3456 - (PLD - 256)) + gi] + gate_b[gi];
            if (isf) LF[((size_t)dir * T + t) * MH + h] = -softplusf_(-gg); else IG[((size_t)dir * T + t) * MH + h] = gg;
        }
        __syncthreads();
        for (int rep_ = 0; rep_ < (MK_PROBE == 4 ? 2 : 1); ++rep_)
        for (int idx = tid; idx < 16 * 768; idx += NTHREADS) {
            const int i = idx / 768, c = idx % 768, t = t0 + i;
            const float* w_ = win + i * 768 + c;
            float y = conv_b[c] + w_[0] * conv_w[c] + w_[768] * conv_w[768 + c] + w_[1536] * conv_w[2 * 768 + c];
            y = y * sigmoidf_(y);
            if (c < MW) MQB[(size_t)t * MW + c] = (bf16_t)f2bf(y);
            else { const bf16_t kb = (bf16_t)f2bf(y * 0.125f); MKB[(size_t)t * MW + (c - MW)] = kb; tk[(c - MW) * 16 + i] = kb; }
        }
        __syncthreads();
        for (int idx = tid; idx < 2 * MW * 2; idx += NTHREADS) {
            const int hf = idx & 1, c = (idx >> 1) % MW, which = idx / (2 * MW);
            const u32x4 val = *(const u32x4*)((which ? tv : tk) + c * 16 + hf * 8);
            bf16_t* dst = (which ? VT : KT) + ((size_t)(bb * MH) * 64 + c) * S + s0 + hf * 8;
            *(u32x4*)dst = val;
        }
    }
    __syncthreads();
}

__device__ __forceinline__ void phase_prep32(const Params& P, int l, unsigned char* smem, int wv) {
    ParamsPtr pp = PARAMS_PTR(P); PIN_S(pp); unsigned char* ws = pp->ws; int bidx = (int)blockIdx.x, gdim = (int)gridDim.x; PIN_S(bidx); PIN_S(gdim);
    const bf16_t* proj = (const bf16_t*)(ws + O_PROJ); const float* projg = (const float*)(ws + O_PROJG);
    float* UG = (float*)(ws + O_UG); bf16_t* VNT = (bf16_t*)(ws + O_VNT);
    u32x4* RK7 = (u32x4*)(ws + O_RK7);
    float* GATE = (float*)(ws + O_GATE); float* BONUS = (float*)(ws + O_BONUS); float* LWG = (float*)(ws + O_LW);
    bf16_t* VB = (bf16_t*)(ws + O_VB);
    bf16_t* MQB = (bf16_t*)(ws + O_MQB); bf16_t* MKB = (bf16_t*)(ws + O_MKB); bf16_t* KT = (bf16_t*)(ws + O_KT); bf16_t* VT = (bf16_t*)(ws + O_VT);
    float* IG = (float*)(ws + O_IG); float* LF = (float*)(ws + O_LF);
    const bf16_t* LWT = (const bf16_t*)(ws + O_LWT) + (size_t)l * 1920 * 128;
    const float* gln_g = pp->in[2] + (size_t)l * GW; const float* gln_b = pp->in[3] + (size_t)l * GW;
    const float* mu0 = pp->in[6] + (size_t)l * 2 * RPROJ; const float* mu1 = mu0 + RPROJ;
    const float* w0 = pp->in[7] + (size_t)l * 2 * RW; const float* a0 = pp->in[9] + (size_t)l * 2 * RW;
    const float* k_k = pp->in[12] + (size_t)l * RW; const float* k_a = pp->in[13] + (size_t)l * RW; const float* r_k = pp->in[14] + (size_t)l * RW;
    const float* conv_w = pp->in[17] + (size_t)l * 3 * 768; const float* conv_b = pp->in[18] + (size_t)l * 768; const float* gate_b = pp->in[19] + (size_t)l * 24;
    constexpr int TOK = 32, WR = TOK + 2, LIN = 264;
    bf16_t* winb = (bf16_t*)smem;
    bf16_t* lin = (bf16_t*)(smem + 95744);
    bf16_t* tk = (bf16_t*)(smem + 112640);
    bf16_t* tv = (bf16_t*)(smem + 137216);
    bf16_t* tvn = tk;
    bf16_t* icl = tk;
    const int tid = phase_tid(wv), lane = tid & 63, wave = tid >> 6, col = lane & 15, g = lane >> 4;
    for (int u = bidx; u < T / TOK; u += gdim) {
        const int t0 = u * TOK, s0 = t0 % S, bb = t0 / S;
        __syncthreads();
#pragma unroll 1
        for (int hb = 0; hb < 2; ++hb) {
            u32x2 wb[17];
#pragma unroll
            for (int q = 0; q < 17; ++q) {
                const int row = hb * 17 + q, sq = s0 - 1 + row;
                wb[q] = (u32x2){0u, 0u};
                if (sq >= 0 && sq < S && tid < 352) wb[q] = *(const u32x2*)(proj + (size_t)(t0 - 1 + row) * PLD + C_RW + tid * 4);
            }
            if (tid < 352) {
#pragma unroll
                for (int q = 0; q < 17; ++q) *(u32x2*)(winb + (hb * 17 + q) * RPROJ + tid * 4) = wb[q];
            }
        }
#pragma unroll 1
        for (int ps = 0; ps < 2; ++ps) {
            const int i = ps * 16 + (tid >> 5), l32 = tid & 31, t = t0 + i;
            float v[8], ug[8]; float sum = 0.f;
#pragma unroll
            for (int j = 0; j < 8; ++j) { const int c = j * 32 + l32; ug[j] = bf_lo((unsigned)proj[(size_t)t * PLD + c]); v[j] = bf_lo((unsigned)proj[(size_t)t * PLD + GW + c]); }
#pragma unroll
            for (int j = 0; j < 8; ++j) { const int c = j * 32 + l32; UG[(size_t)t * GW + c] = geluf_(ug[j]); v[j] = geluf_(v[j]); sum += v[j]; }
#pragma unroll
            for (int o = 16; o >= 1; o >>= 1) sum += SHX(sum, o, lane);
            const float mean = sum * (1.0f / GW); float q = 0.f;
#pragma unroll
            for (int j = 0; j < 8; ++j) { const float d = v[j] - mean; q += d * d; }
#pragma unroll
            for (int o = 16; o >= 1; o >>= 1) q += SHX(q, o, lane);
            const float rstd = 1.0f / sqrtf(q * (1.0f / GW) + LN_EPS);
#pragma unroll
            for (int j = 0; j < 8; ++j) { const int c = j * 32 + l32; tvn[c * TOK + i] = (bf16_t)f2bf((v[j] - mean) * rstd * gln_g[c] + gln_b[c]); }
        }
        __syncthreads();
#pragma unroll
        for (int q = 0; q < 2; ++q) {
            const int idx = tid + q * NTHREADS, c = idx >> 2, pc = idx & 3;
            *(u32x4*)(VNT + ((size_t)bb * GW + c) * S + s0 + pc * 8) = *(const u32x4*)(tvn + c * TOK + pc * 8);
        }
        int tb2 = tid; PIN_V(tb2);
#pragma unroll 4
        for (int q = 0; q < 16; ++q) {
            const int idx = tb2 + q * NTHREADS, i = idx >> 8, j = idx & 255, rc = 1152 + j;
            const float pv = bf_lo((unsigned)winb[i * RPROJ + rc]), cv = bf_lo((unsigned)winb[(i + 1) * RPROJ + rc]), nv = bf_lo((unsigned)winb[(i + 2) * RPROJ + rc]);
            const float x = cv + mu0[rc] * (pv - cv) + mu1[rc] * (nv - cv);
            lin[i * LIN + j] = (bf16_t)f2bf(j < 64 ? ftanh(x) : (j < 128 ? x : sigmoidf_(x)));
        }
        __syncthreads();
#pragma unroll 1
        for (int qg = 0; qg < 3; ++qg) {
            bf16x8 bw_[5][4]; float bias_[5];
#pragma unroll
            for (int q5 = 0; q5 < 5; ++q5) {
                const int nt = wave * 15 + qg * 5 + q5, grp = nt / 24, c = (nt % 24) * 16 + col;
                const bf16_t* bw = LWT + (size_t)(nt * 16 + col) * 128 + 8 * g;
#pragma unroll
                for (int ks = 0; ks < 2; ++ks) bw_[q5][ks] = *(const bf16x8*)(bw + ks * 32);
                if (grp == 4) {
#pragma unroll
                    for (int ks = 2; ks < 4; ++ks) bw_[q5][ks] = *(const bf16x8*)(bw + ks * 32);
                }
                bias_[q5] = grp < 2 ? w0[grp * RW + c] : (grp < 4 ? a0[(grp - 2) * RW + c] : 0.f);
            }
#pragma unroll
            for (int q5 = 0; q5 < 5; ++q5) {
                const int nt = wave * 15 + qg * 5 + q5, grp = nt / 24, c = (nt % 24) * 16 + col;
                const int kcol = grp < 2 ? 0 : (grp < 4 ? 64 : 128);
#pragma unroll
                for (int mt = 0; mt < 2; ++mt) {
                    f32x4 acc = (f32x4){0.f, 0.f, 0.f, 0.f};
                    const bf16_t* la = lin + (mt * 16 + col) * LIN + kcol + 8 * g;
#pragma unroll
                    for (int ks = 0; ks < 2; ++ks) acc = MFMA16(*(const bf16x8*)(la + ks * 32), bw_[q5][ks], acc);
                    if (grp == 4) {
#pragma unroll
                        for (int ks = 2; ks < 4; ++ks) acc = MFMA16(*(const bf16x8*)(la + ks * 32), bw_[q5][ks], acc);
                    }
                    const size_t tb = (size_t)(t0 + mt * 16 + 4 * g);
                    if (grp < 2) {
#pragma unroll
                        for (int r = 0; r < 4; ++r) LWG[(size_t)grp * T * RW + (tb + r) * RW + c] = -fexp(-softplusf_(-(acc[r] + bias_[q5])) - 0.5f);
                    } else if (grp < 4) {
#pragma unroll
                        for (int r = 0; r < 4; ++r) icl[((grp - 2) * TOK + mt * 16 + 4 * g + r) * RW + c] = (bf16_t)f2bf(sigmoidf_(acc[r] + bias_[q5]));
                    } else {
#pragma unroll
                        for (int r = 0; r < 4; ++r) GATE[(tb + r) * RW + c] = acc[r];
                    }
                }
            }
        }
        __syncthreads();
        if (wave < 6) {
            int c = tid; PIN_V(c); const int h = wave;
            const float kkc = k_k[c], kac = k_a[c], rkc = r_k[c];
            const float m0r = mu0[c], m1r = mu1[c], m0k = mu0[RW + c], m1k = mu1[RW + c], m0v = mu0[2 * RW + c], m1v = mu1[2 * RW + c];
#pragma unroll 1
            for (int hb = 0; hb < 2; ++hb) {
                float ic0[16], ic1[16];
#pragma unroll
                for (int i = 0; i < 16; ++i) { ic0[i] = bf_lo((unsigned)icl[(hb * 16 + i) * RW + c]); ic1[i] = bf_lo((unsigned)icl[(TOK + hb * 16 + i) * RW + c]); }
#pragma unroll
                for (int i = 0; i < 16; ++i) {
                    const int it = hb * 16 + i, t = t0 + it;
                    const bf16_t* w_ = winb + it * RPROJ + c;
                    const float rp = bf_lo((unsigned)w_[0]), rc_ = bf_lo((unsigned)w_[RPROJ]), rn = bf_lo((unsigned)w_[2 * RPROJ]);
                    const float kp = bf_lo((unsigned)w_[RW]), kc_ = bf_lo((unsigned)w_[RPROJ + RW]), kn = bf_lo((unsigned)w_[2 * RPROJ + RW]);
                    const float vp = bf_lo((unsigned)w_[2 * RW]), vc_ = bf_lo((unsigned)w_[RPROJ + 2 * RW]), vn = bf_lo((unsigned)w_[2 * RPROJ + 2 * RW]);
                    const float r = rc_ + m0r * (rp - rc_) + m1r * (rn - rc_);
                    const float k = kc_ + m0k * (kp - kc_) + m1k * (kn - kc_);
                    const float v = vc_ + m0v * (vp - vc_) + m1v * (vn - vc_);
                    const size_t o = (size_t)t * RW + c;
                    const float kq = k * kkc;
                    const float n2 = wave_sum_fast(kq * kq, lane);
                    const float kk = kq / fmaxf(sqrtf(n2), 1e-12f);
                    const float kd0 = k * (1.0f + (ic0[i] - 1.0f) * kac), kd1 = k * (1.0f + (ic1[i] - 1.0f) * kac);
                    const float bon = wave_sum_fast(r * (kd0 + kd1) * rkc, lane);
                    u32x4 rec; rec.x = pk2(r, v); rec.y = pk2(kk, 0.f); rec.z = pk2(kk * ic0[i], kk * ic1[i]); rec.w = pk2(kd0, kd1);
                    RK7[o] = rec;
                    VB[o] = (bf16_t)(rec.x >> 16);
                    if (lane == 0) BONUS[(size_t)t * RH + h] = bon;
                }
            }
        }
        __syncthreads();
        {
            u32x2 wb[17], vb[6];
            const int rsel = tid >= 192 ? 1 : 0, c4 = tid - rsel * 192;
#pragma unroll
            for (int q = 0; q < 17; ++q) {
                const int row = 2 * q + rsel, sq = s0 - 1 + row;
                wb[q] = (u32x2){0u, 0u};
                if (tid < 384 && sq >= 0 && sq < S) wb[q] = *(const u32x2*)(proj + (size_t)(t0 - 1 + row) * PLD + C_MW + c4 * 4);
            }
#pragma unroll
            for (int q = 0; q < 6; ++q) { const int idx = tid + q * NTHREADS, i = idx / 96, cc = (idx % 96) * 4; vb[q] = *(const u32x2*)(proj + (size_t)(t0 + i) * PLD + C_MW + 2 * MW + cc); }
            if (tid < 384) {
#pragma unroll
                for (int q = 0; q < 17; ++q) *(u32x2*)(winb + (2 * q + rsel) * 768 + c4 * 4) = wb[q];
            }
#pragma unroll
            for (int q = 0; q < 6; ++q) { const int idx = tid + q * NTHREADS, i = idx / 96, cc = (idx % 96) * 4; const u32x2 v = vb[q];
                tv[(cc + 0) * TOK + i] = (bf16_t)(v.x & 0xffffu); tv[(cc + 1) * TOK + i] = (bf16_t)(v.x >> 16); tv[(cc + 2) * TOK + i] = (bf16_t)(v.y & 0xffffu); tv[(cc + 3) * TOK + i] = (bf16_t)(v.y >> 16); }
        }
        for (int idx = tid; idx < TOK * 24; idx += NTHREADS) {
            const int i = idx / 24, gi = idx % 24, t = t0 + i;
            const int isf = gi / 12, dir = (gi / 6) & 1, h = gi % 6;
            const float gg = projg[(size_t)t * 256 + (3456 - (PLD - 256)) + gi] + gate_b[gi];
            if (isf) LF[((size_t)dir * T + t) * MH + h] = -softplusf_(-gg); else IG[((size_t)dir * T + t) * MH + h] = gg;
        }
        __syncthreads();
        int tcv = tid; PIN_V(tcv);
#pragma unroll 4
        for (int q = 0; q < 48; ++q) {
            const int idx = tcv + q * NTHREADS, i = idx / 768, c = idx % 768, t = t0 + i;
            const bf16_t* w_ = winb + i * 768 + c;
            float y = conv_b[c] + bf_lo((unsigned)w_[0]) * conv_w[c] + bf_lo((unsigned)w_[768]) * conv_w[768 + c] + bf_lo((unsigned)w_[1536]) * conv_w[2 * 768 + c];
            y = y * sigmoidf_(y);
            if (c < MW) MQB[(size_t)t * MW + c] = (bf16_t)f2bf(y);
            else { const bf16_t kb = (bf16_t)f2bf(y * 0.125f); MKB[(size_t)t * MW + (c - MW)] = kb; tk[(c - MW) * TOK + i] = kb; }
        }
        __syncthreads();
#pragma unroll
        for (int q = 0; q < 6; ++q) {
            const int idx = tid + q * NTHREADS, pc = idx & 3, c = (idx >> 2) % MW, which = idx / (4 * MW);
            const u32x4 val = *(const u32x4*)((which ? tv : tk) + c * TOK + pc * 8);
            bf16_t* dst = (which ? VT : KT) + ((size_t)(bb * MH) * 64 + c) * S + s0 + pc * 8;
            *(u32x4*)dst = val;
        }
    }
    __syncthreads();
}

__device__ __forceinline__ void phase_gmlp_mix(const Params& P, int l, unsigned char* smem, int wv, int bid, int nb) {
    PIN_S(bid); PIN_S(nb);
    ParamsPtr pp = PARAMS_PTR(P); PIN_S(pp); unsigned char* ws = pp->ws;
    const float* UG = (const float*)(ws + O_UG); const bf16_t* VNT = (const bf16_t*)(ws + O_VNT); bf16_t* GRP = (bf16_t*)(ws + O_GRP);
    const bf16_t* WSB = (const bf16_t*)(ws + O_WSB) + (size_t)l * GH * CH * CH; const float* gbs = pp->in[5] + (size_t)l * GH * CH;
    const int tid = phase_tid(wv), lane = tid & 63, wave = tid >> 6, col = lane & 15, g = lane >> 4;
    constexpr int NU = NB * NCH * GH;
    bf16x8 wA[4], vA[4][4], wB[4], vB[4][4]; f32x4 uA[4], uB[4]; float bA, bB;
#define GM_LOAD(u_, W_, V_, U_, B_) do { const int h_ = (u_) % GH, c_ = ((u_) / GH) % NCH, b_ = (u_) / (GH * NCH); \
        const bf16_t* wb_ = WSB + (size_t)h_ * CH * CH + (size_t)(wave * 16 + col) * CH + 8 * g; \
        const bf16_t* vb_ = VNT + ((size_t)b_ * GW + h_ * 64 + col) * S + (size_t)c_ * CH + 8 * g; \
        _Pragma("unroll") for (int ks = 0; ks < 4; ++ks) { W_[ks] = *(const bf16x8*)(wb_ + ks * 32); \
            _Pragma("unroll") for (int et = 0; et < 4; ++et) V_[et][ks] = *(const bf16x8*)(vb_ + (size_t)et * 16 * S + ks * 32); } \
        const size_t t_ = (size_t)(b_ * S + c_ * CH + wave * 16 + col); \
        _Pragma("unroll") for (int et = 0; et < 4; ++et) U_[et] = *(const f32x4*)(UG + t_ * GW + h_ * 64 + et * 16 + 4 * g); \
        B_ = gbs[h_ * CH + wave * 16 + col]; } while (0)
#define GM_COMP(u_, W_, V_, U_, B_) do { const int h_ = (u_) % GH, c_ = ((u_) / GH) % NCH, b_ = (u_) / (GH * NCH); \
        const size_t t_ = (size_t)(b_ * S + c_ * CH + wave * 16 + col); \
        _Pragma("unroll") for (int et = 0; et < 4; ++et) { f32x4 acc = (f32x4){0.f, 0.f, 0.f, 0.f}; \
            _Pragma("unroll") for (int ks = 0; ks < 4; ++ks) acc = MFMA16(V_[et][ks], W_[ks], acc); \
            u32x2 o_; o_.x = pk2(U_[et][0] * (acc[0] + B_), U_[et][1] * (acc[1] + B_)); o_.y = pk2(U_[et][2] * (acc[2] + B_), U_[et][3] * (acc[3] + B_)); \
            *(u32x2*)(GRP + t_ * D + h_ * 64 + et * 16 + 4 * g) = o_; } } while (0)
    int u = bid;
    if (u < NU) GM_LOAD(u, wA, vA, uA, bA);
    while (u < NU) {
        const int u1 = u + nb;
        if (u1 < NU) GM_LOAD(u1, wB, vB, uB, bB);
        GM_COMP(u, wA, vA, uA, bA);
        if (u1 >= NU) break;
        const int u2 = u1 + nb;
        if (u2 < NU) GM_LOAD(u2, wA, vA, uA, bA);
        GM_COMP(u1, wB, vB, uB, bB);
        u = u2;
    }
#undef GM_LOAD
#undef GM_COMP
}

constexpr int SC_STEPS = 16;
constexpr int SC_BUF = SC_STEPS * 6 * 64;
__device__ __forceinline__ void phase_rwkv_scan(const Params& P, int l, unsigned char* smem, int wv, int bid, int nb) {
    PIN_S(bid); PIN_S(nb);
    ParamsPtr pp = PARAMS_PTR(P); PIN_S(pp); unsigned char* ws = pp->ws;
    const float* RR = (const float*)(ws + O_RR); const float* VV = (const float*)(ws + O_VV); const float* KK = (const float*)(ws + O_KK);
    const float* DEC = (const float*)(ws + O_DEC); const float* KD = (const float*)(ws + O_KD); const float* ICLR = (const float*)(ws + O_ICLR);
    float* SCAN = (float*)(ws + O_SCAN); const float* BRKR = (const float*)(ws + O_BRKR);
    const int tid = phase_tid(wv), lane = tid & 63, wave = tid >> 6, rl = (lane >> 4) & 1, kq = (lane & 15) | ((lane >> 5) << 4);
    float* buf = (float*)smem;
    float* scal = buf + 2 * SC_BUF;
    float* outb = scal + 2 * SC_STEPS * 2;
    typedef float f32x2 __attribute__((ext_vector_type(2)));
    for (int u = bid; u < 2 * NB * RH * 4; u += nb) {
        const int qt = u & 3, h = (u >> 2) % RH, b = (u / (4 * RH)) % NB, d = u / (4 * RH * NB);
        const size_t doff = (size_t)d * T * RW;
        float s0 = 0.f, s1 = 0.f;
        float pw[2], pa[2], pb[2], pk[2], pr[2], pv[2], psc = 0.f;
#define SC_LOAD(c) do { _Pragma("unroll") for (int i = 0; i < 2; ++i) { const int idx = tid + NTHREADS * i, st = idx >> 6, k = idx & 63; const int tau = (c) * SC_STEPS + st, sq = d ? S - 1 - tau : tau; \
            const size_t o = (size_t)(b * S + sq) * RW + h * 64 + k; \
            pw[i] = DEC[doff + o]; pa[i] = KK[o]; pb[i] = ICLR[doff + o]; pk[i] = KD[doff + o]; pr[i] = RR[o]; pv[i] = VV[o]; }     \
            if (tid < 2 * SC_STEPS) { const int tau = (c) * SC_STEPS + (tid >> 1), sq = d ? S - 1 - tau : tau; psc = BRKR[((size_t)(d * T + b * S + sq) * RH + h) * 2 + (tid & 1)]; } } while (0)
#define SC_WRITE(c) do { float* B_ = buf + ((c) & 1) * SC_BUF; _Pragma("unroll") for (int i = 0; i < 2; ++i) { const int idx = tid + NTHREADS * i, st = idx >> 6, k = idx & 63; \
            float* q_ = B_ + st * 384 + k; q_[0] = pw[i]; q_[64] = -pa[i]; q_[128] = pa[i] * pb[i]; q_[192] = pk[i]; q_[256] = pw[i] * pr[i]; q_[320] = pv[i]; } \
            if (tid < 2 * SC_STEPS) scal[((c) & 1) * SC_STEPS * 2 + tid] = psc; } while (0)
        __syncthreads();
        SC_LOAD(0); SC_WRITE(0);
        __syncthreads();
        const int row = qt * 16 + wave * 2 + rl;
        for (int c = 0; c < S / SC_STEPS; ++c) {
            const bool more = (c + 1) < S / SC_STEPS;
            if (more) SC_LOAD(c + 1);
            const float* B = buf + (c & 1) * SC_BUF; const float* sc = scal + (c & 1) * SC_STEPS * 2; float* ob = outb + (c & 1) * SC_STEPS * 16;
            float outs[SC_STEPS];
            f32x2 w2 = *(const f32x2*)(B + 2 * kq), a2 = *(const f32x2*)(B + 64 + 2 * kq), b2 = *(const f32x2*)(B + 128 + 2 * kq);
            f32x2 k2 = *(const f32x2*)(B + 192 + 2 * kq), wr2 = *(const f32x2*)(B + 256 + 2 * kq);
            float v = B[320 + row]; float br = sc[0], kr = sc[1];
#pragma unroll
            for (int st = 0; st < SC_STEPS; ++st) {
                const int sn = st + 1 < SC_STEPS ? st + 1 : st;
                const float* q = B + sn * 384;
                const f32x2 nw2 = *(const f32x2*)(q + 2 * kq), na2 = *(const f32x2*)(q + 64 + 2 * kq), nb2 = *(const f32x2*)(q + 128 + 2 * kq);
                const f32x2 nk2 = *(const f32x2*)(q + 192 + 2 * kq), nwr2 = *(const f32x2*)(q + 256 + 2 * kq);
                const float nv = q[320 + row], nbr = sc[sn * 2], nkr = sc[sn * 2 + 1];
                SCHED_BAR();
                float sa = s0 * a2.x + s1 * a2.y;
                float po = s0 * wr2.x + s1 * wr2.y;
                sa = row32_sum(sa); po = row32_sum(po);
                outs[st] = po + sa * br + v * kr;
                s0 = s0 * w2.x + (sa * b2.x + v * k2.x); s1 = s1 * w2.y + (sa * b2.y + v * k2.y);
                SCHED_BAR();
                w2 = nw2; a2 = na2; b2 = nb2; k2 = nk2; wr2 = nwr2; v = nv; br = nbr; kr = nkr;
            }
            if (kq == 0) {
#pragma unroll
                for (int st = 0; st < SC_STEPS; ++st) ob[st * 16 + wave * 2 + rl] = outs[st];
            }
            if (more) SC_WRITE(c + 1);
            __syncthreads();
            if (tid < 16 * SC_STEPS) {
                const int st = tid >> 4, r = tid & 15, tau = c * SC_STEPS + st, sq = d ? S - 1 - tau : tau;
                SCAN[doff + (size_t)(b * S + sq) * RW + h * 64 + qt * 16 + r] = ob[st * 16 + r];
            }
        }
#undef SC_LOAD
#undef SC_WRITE
    }
    __syncthreads();
}

constexpr int RST = 72;
constexpr int RARR = 64 * RST;
__device__ __forceinline__ f32x4 tile_nt(const bf16_t* Aa, int ta, const bf16_t* Ba, int tb, f32x4 acc, int col, int g) {
#pragma unroll
    for (int ks = 0; ks < 2; ++ks) {
        const bf16x8 af = *(const bf16x8*)(Aa + (ta * 16 + col) * RST + ks * 32 + 8 * g);
        const bf16x8 bfr = *(const bf16x8*)(Ba + (tb * 16 + col) * RST + ks * 32 + 8 * g);
        acc = MFMA16(af, bfr, acc);
    }
    return acc;
}
__device__ __forceinline__ void phase_rwkv_pre(const Params& P, int l, unsigned char* smem, int wv) {
    ParamsPtr pp = PARAMS_PTR(P); PIN_S(pp); unsigned char* ws = pp->ws; int bidx = (int)blockIdx.x, gdim = (int)gridDim.x; PIN_S(bidx); PIN_S(gdim);
    const u32x4* RK7 = (const u32x4*)(ws + O_RK7);
    const float* LWG = (const float*)(ws + O_LW);
    bf16_t* Qg = (bf16_t*)(ws + O_RQ); bf16_t* Ag = (bf16_t*)(ws + O_RA); bf16_t* Hg = (bf16_t*)(ws + O_RH); bf16_t* Gg = (bf16_t*)(ws + O_RG);
    const int tid0 = phase_tid(wv);
#define RW_STAGE_VARS int tid = tid0; PIN_V(tid); const int lane = tid & 63, wave = tid >> 6, col = lane & 15, g = lane >> 4; (void)lane; (void)wave; (void)col; (void)g;
    bf16_t* At = (bf16_t*)smem; bf16_t* Bt = At + RARR; bf16_t* Kt = Bt + RARR; bf16_t* Rt = Kt + RARR;
    bf16_t* BtT = Rt + RARR; bf16_t* KtT = BtT + RARR; bf16_t* VT = KtT + RARR;
    bf16_t* Lak = VT + RARR; bf16_t* Mrb = Lak + RARR; bf16_t* Mrk = Mrb + RARR; bf16_t* YT = Mrk + RARR; bf16_t* W2T = YT + RARR;
    bf16_t* Lbo = W2T + RARR;
    float* LabT = (float*)(Lbo + RARR);
    float* Xs = LabT + 4096;
    float* Pb = Xs + 4096;
    float* segs = Pb + 2048;
    float* PC = segs + 512;
    float plw[8]; u32x4 prec[8];
#define RW_LOAD(uu) do { const int c_ = (uu) % RNC, h_ = ((uu) / RNC) % RH, b_ = ((uu) / (RNC * RH)) % NB, d_ = (uu) / (RNC * RH * NB); const size_t doff_ = (size_t)d_ * T * RW; \
        const int ch_ = tid0 & 63, sg_ = tid0 >> 6; _Pragma("unroll") for (int j = 0; j < 8; ++j) { const int tau = c_ * RC + sg_ * 8 + j, sq = d_ ? S - 1 - tau : tau; const size_t o = (size_t)(b_ * S + sq) * RW + h_ * 64 + ch_; \
        plw[j] = LWG[doff_ + o]; prec[j] = RK7[o]; } } while (0)
    if (bidx < RUN) RW_LOAD(bidx);
    for (int u = bidx; u < RUN; u += gdim) {
        const int c = u % RNC, h = (u / RNC) % RH, b = (u / (RNC * RH)) % NB, d = u / (RNC * RH * NB);
        (void)c; (void)h; (void)b; (void)d;
        __syncthreads();
        {
            RW_STAGE_VARS
            const int ch = tid & 63, sg = tid >> 6;
            float lw[8]; unsigned kk[8], bq_[8], kd[8], rr[8], vv[8];
#pragma unroll
            for (int j = 0; j < 8; ++j) { lw[j] = plw[j]; kk[j] = prec[j].y & 0xffffu; bq_[j] = d ? (prec[j].z >> 16) : (prec[j].z & 0xffffu); kd[j] = d ? (prec[j].w >> 16) : (prec[j].w & 0xffffu); rr[j] = prec[j].x & 0xffffu; vv[j] = prec[j].x >> 16; }
            if (u + gdim < RUN) RW_LOAD(u + gdim);
            float run = 0.f;
#pragma unroll
            for (int j = 0; j < 8; ++j) { run += lw[j]; lw[j] = run; }
            segs[sg * 64 + ch] = run;
            __syncthreads();
            float off = 0.f;
            for (int q = 0; q < sg; ++q) off += segs[q * 64 + ch];
            u32x4 pbt, pkt, pvt; unsigned tb[8], tk[8], tvv[8];
            float prev = off;
#pragma unroll
            for (int j = 0; j < 8; ++j) {
                const int t = sg * 8 + j; const float cl = off + lw[j];
                const float ep = fexp(prev), en = fexp(-cl), epc = fexp(cl);
                const unsigned a_ = f2bf(-bf_lo(kk[j]) * ep), b_ = f2bf(bf_lo(bq_[j]) * en), k_ = f2bf(bf_lo(kd[j]) * en), r_ = f2bf(bf_lo(rr[j]) * epc), v_ = vv[j];
                At[t * RST + ch] = (bf16_t)a_; Bt[t * RST + ch] = (bf16_t)b_; Kt[t * RST + ch] = (bf16_t)k_; Rt[t * RST + ch] = (bf16_t)r_;
                tb[j] = b_; tk[j] = k_; tvv[j] = v_;
                prev = cl;
            }
            if (sg == 7) PC[ch] = fexp(prev);
            pbt.x = tb[0] | (tb[1] << 16); pbt.y = tb[2] | (tb[3] << 16); pbt.z = tb[4] | (tb[5] << 16); pbt.w = tb[6] | (tb[7] << 16);
            pkt.x = tk[0] | (tk[1] << 16); pkt.y = tk[2] | (tk[3] << 16); pkt.z = tk[4] | (tk[5] << 16); pkt.w = tk[6] | (tk[7] << 16);
            pvt.x = tvv[0] | (tvv[1] << 16); pvt.y = tvv[2] | (tvv[3] << 16); pvt.z = tvv[4] | (tvv[5] << 16); pvt.w = tvv[6] | (tvv[7] << 16);
            *(u32x4*)(BtT + ch * RST + sg * 8) = pbt; *(u32x4*)(KtT + ch * RST + sg * 8) = pkt; *(u32x4*)(VT + ch * RST + sg * 8) = pvt;
            for (int z_ = tid; z_ < 2 * RARR / 8; z_ += NTHREADS) ((u32x4*)YT)[z_] = (u32x4){0u, 0u, 0u, 0u};
        }
        __syncthreads();
        {
            RW_STAGE_VARS
            const int m = wave >> 1;
            const bf16_t* Ym = (m == 0 || m == 2) ? Bt : Kt; const bf16_t* Xm = (m < 2) ? At : Rt;
#pragma unroll 1
            for (int q = 0; q < 8; ++q) {
                const int tix = (wave & 1) * 8 + q, it = tix >> 2, tt = tix & 3;
                f32x4 acc = (f32x4){0.f, 0.f, 0.f, 0.f};
                if (it <= tt) acc = tile_nt(Ym, it, Xm, tt, acc, col, g);
                const int t = tt * 16 + col, i0 = it * 16 + 4 * g;
                float o4[4];
#pragma unroll
                for (int r = 0; r < 4; ++r) { const int i = i0 + r; const bool ok = m < 2 ? (i < t) : (i <= t); o4[r] = ok ? acc[r] : 0.f; }
                if (m == 0) {
#pragma unroll
                    for (int r = 0; r < 4; ++r) LabT[(i0 + r) * 64 + t] = o4[r];
                    const bool offd = it < tt;
                    u32x2 w2; w2.x = offd ? pk2(o4[0], o4[1]) : 0u; w2.y = offd ? pk2(o4[2], o4[3]) : 0u; *(u32x2*)(Lbo + t * RST + i0) = w2;
                }
                else { bf16_t* dst = (m == 1 ? Lak : (m == 2 ? Mrb : Mrk)) + t * RST + i0; u32x2 w2; w2.x = pk2(o4[0], o4[1]); w2.y = pk2(o4[2], o4[3]); *(u32x2*)dst = w2; }
            }
        }
        __syncthreads();
        {
            RW_STAGE_VARS
#pragma unroll
            for (int q = 0; q < 2; ++q) {
                const int tix = wave * 2 + q, tt = tix >> 2, et = tix & 3;
                f32x4 acc = (f32x4){0.f, 0.f, 0.f, 0.f};
                acc = tile_nt(Lak, tt, VT, et, acc, col, g);
#pragma unroll
                for (int r = 0; r < 4; ++r) Xs[(tt * 16 + 4 * g + r) * 64 + et * 16 + col] = acc[r];
            }
        }
        __syncthreads();
        {
            RW_STAGE_VARS
#pragma unroll 1
            for (int bb = 0; bb < 4; ++bb) {
                if (bb > 0) {
                    const bf16_t* Zt = (wave < 4 ? YT : W2T) + ((wave & 3) * 16 + col) * RST + 8 * g;
                    const bf16_t* La = Lbo + (16 * bb + col) * RST + 8 * g;
                    f32x4 acc = (f32x4){0.f, 0.f, 0.f, 0.f};
                    acc = MFMA16(*(const bf16x8*)La, *(const bf16x8*)Zt, acc);
                    if (bb > 2) acc = MFMA16(*(const bf16x8*)(La + 32), *(const bf16x8*)(Zt + 32), acc);
#pragma unroll
                    for (int r = 0; r < 4; ++r) Pb[(4 * g + r) * 128 + wave * 16 + col] = acc[r];
                }
                __syncthreads();
                if (wave < 2) {
                    float acc[16];
                    if (wave == 0) {
#pragma unroll
                        for (int r = 0; r < 16; ++r) acc[r] = bf_lo((unsigned)At[(16 * bb + r) * RST + lane]);
                    } else {
#pragma unroll
                        for (int r = 0; r < 16; ++r) acc[r] = Xs[(16 * bb + r) * 64 + lane];
                    }
                    if (bb > 0) {
#pragma unroll
                        for (int r = 0; r < 16; ++r) acc[r] += Pb[r * 128 + wave * 64 + lane];
                    }
                    const float* dp = LabT + (16 * bb) * 64 + 16 * bb;
#pragma unroll
                    for (int r = 1; r < 16; ++r)
#pragma unroll
                        for (int r2 = 0; r2 < r; ++r2) acc[r] += dp[r2 * 64 + r] * acc[r2];
                    bf16_t* dst = (wave == 0 ? YT : W2T) + lane * RST;
                    u32x4 w0, w1;
                    w0.x = pk2(acc[0], acc[1]); w0.y = pk2(acc[2], acc[3]); w0.z = pk2(acc[4], acc[5]); w0.w = pk2(acc[6], acc[7]);
                    w1.x = pk2(acc[8], acc[9]); w1.y = pk2(acc[10], acc[11]); w1.z = pk2(acc[12], acc[13]); w1.w = pk2(acc[14], acc[15]);
                    *(u32x4*)(dst + 16 * bb) = w0; *(u32x4*)(dst + 16 * bb + 8) = w1;
                }
                __syncthreads();
            }
        }
        __syncthreads();
        {
            RW_STAGE_VARS
            const int ty = wave >> 1;
#pragma unroll 1
            for (int q = 0; q < 8; ++q) {
                const int tix = (wave & 1) * 8 + q, ra = tix >> 2, cb = tix & 3;
                f32x4 acc = (f32x4){0.f, 0.f, 0.f, 0.f};
                if (ty == 0) {
                    acc = tile_nt(YT, ra, Mrb, cb, acc, col, g);
                    const u32x2 rt2 = *(const u32x2*)(Rt + (cb * 16 + col) * RST + ra * 16 + 4 * g);
                    u32x2 qb2; qb2.x = pk2(acc[0] + bf_lo(rt2.x), acc[1] + bf_hi(rt2.x)); qb2.y = pk2(acc[2] + bf_lo(rt2.y), acc[3] + bf_hi(rt2.y));
                    *(u32x2*)(Qg + (size_t)u * 4096 + ((((ra >> 1) * 4 + cb) * 64 + lane) * 8 + (ra & 1) * 4)) = qb2;
                } else if (ty == 1) {
                    acc = tile_nt(Mrb, ra, W2T, cb, acc, col, g); acc = tile_nt(Mrk, ra, VT, cb, acc, col, g);
                    { u32x2 hb; hb.x = pk2(acc[0], acc[1]); hb.y = pk2(acc[2], acc[3]); *(u32x2*)(Hg + (size_t)u * 4096 + (tix * 64 + lane) * 4) = hb; }
                } else if (ty == 2) {
                    acc = tile_nt(YT, ra, BtT, cb, acc, col, g);
                    const float pc = PC[cb * 16 + col]; const int k1 = cb * 16 + col;
                    float a4[4];
#pragma unroll
                    for (int r = 0; r < 4; ++r) a4[r] = pc * (acc[r] + ((ra * 16 + 4 * g + r) == k1 ? 1.0f : 0.f));
                    u32x2 ab2; ab2.x = pk2(a4[0], a4[1]); ab2.y = pk2(a4[2], a4[3]);
                    *(u32x2*)(Ag + (size_t)u * 4096 + ((((ra >> 1) * 4 + cb) * 64 + lane) * 8 + (ra & 1) * 4)) = ab2;
                } else {
                    acc = tile_nt(BtT, ra, W2T, cb, acc, col, g); acc = tile_nt(KtT, ra, VT, cb, acc, col, g);
#pragma unroll
                    for (int r = 0; r < 4; ++r) acc[r] *= PC[ra * 16 + 4 * g + r];
                    { u32x2 gb2; gb2.x = pk2(acc[0], acc[1]); gb2.y = pk2(acc[2], acc[3]); *(u32x2*)(Gg + (size_t)u * 4096 + (tix * 64 + lane) * 4) = gb2; }
                }
            }
        }
    }
    __syncthreads();
#undef RW_STAGE_VARS
#undef RW_LOAD
}
constexpr int RSEQ_WGS = 2 * NB * RH * 2;
template <int MODE = 0>
__device__ __forceinline__ void phase_rwkv_seq(const Params& P, int l, unsigned char* smem, int wv) {
    ParamsPtr pp = PARAMS_PTR(P); PIN_S(pp); unsigned char* ws = pp->ws; int bidx = (int)blockIdx.x, gdim = (int)gridDim.x; PIN_S(bidx); PIN_S(gdim);
    const bf16_t* Ag = (const bf16_t*)(ws + O_RA); const bf16_t* Gg = (const bf16_t*)(ws + O_RG); bf16_t* Sg = (bf16_t*)(ws + ((MODE & 4) ? O_XS : O_RS));
    const int tid = phase_tid(wv), lane = tid & 63, wave = tid >> 6, col = lane & 15, g = lane >> 4;
    if (wave >= 2) return;
    const int nwg = gdim < RSEQ_WGS ? gdim : RSEQ_WGS;
    if (bidx >= nwg) return;
    for (int un = wave * nwg + bidx; un < 2 * NB * RH * 4; un += 2 * nwg) {
        const int ch = un >> 2, eq = un & 3;
        f32x4 acc[4];
#pragma unroll
        for (int a_ = 0; a_ < 4; ++a_) acc[a_] = (f32x4){0.f, 0.f, 0.f, 0.f};
        u32x4 a0[4][2], a1[4][2], a2[4][2], a3[4][2]; u32x2 g0[4], g1[4], g2[4], g3[4];
        const unsigned aoff = (unsigned)(col * 64 + 16 * g), goff = (unsigned)(lane * 4), aoff8 = (unsigned)(lane * 8);
#define RS_LOAD(cc, AF, GQ) do { const int c_ = (cc) < RNC ? (cc) : RNC - 1; const bf16_t* ab_ = Ag + (size_t)(ch * RNC + c_) * 4096; const bf16_t* gb_ = Gg + (size_t)(ch * RNC + c_) * 4096 + eq * 256; \
            _Pragma("unroll") for (int ra = 0; ra < 4; ++ra) _Pragma("unroll") for (int p = 0; p < 2; ++p) AF[ra][p] = *(const u32x4*)(ab_ + ((p * 4 + ra) * 512) + aoff8); \
            _Pragma("unroll") for (int ra = 0; ra < 4; ++ra) GQ[ra] = *(const u32x2*)(gb_ + (ra * 1024) + goff); } while (0)
#define RS_STEP(c, AF, GQ) do { if (RNC % 4 == 0 || (c) < RNC) { SCHED_BAR(); bf16_t* sb_ = Sg + (size_t)(ch * RNC + (c)) * 4096 + eq * 1024; \
            bf16x8 bq[2]; _Pragma("unroll") for (int p = 0; p < 2; ++p) bq[p] = cvt8(acc[2 * p], acc[2 * p + 1]); \
            if (!(MODE & 1) || (c) == RNC - 1) { _Pragma("unroll") for (int p = 0; p < 2; ++p) *(bf16x8*)(sb_ + (p * 8) + aoff) = bq[p]; } \
            _Pragma("unroll") for (int ra = 0; ra < 4; ++ra) acc[ra] = (f32x4){bf_lo(GQ[ra].x), bf_hi(GQ[ra].x), bf_lo(GQ[ra].y), bf_hi(GQ[ra].y)}; \
            _Pragma("unroll") for (int ra = 0; ra < 4; ++ra) _Pragma("unroll") for (int p = 0; p < 2; ++p) acc[ra] = MFMA16(__builtin_bit_cast(bf16x8, AF[ra][p]), bq[p], acc[ra]); \
            if (!(MODE & 2)) RS_LOAD((c) + 4, AF, GQ); SCHED_BAR(); } } while (0)
        RS_LOAD(0, a0, g0); RS_LOAD(1, a1, g1); RS_LOAD(2, a2, g2); RS_LOAD(3, a3, g3);
#pragma unroll 1
        for (int c = 0; c < RNC; c += 4) { RS_STEP(c, a0, g0); RS_STEP(c + 1, a1, g1); RS_STEP(c + 2, a2, g2); RS_STEP(c + 3, a3, g3); }
#undef RS_LOAD
#undef RS_STEP
    }
}
__device__ __forceinline__ void phase_rwkv_out(const Params& P, int l, unsigned char* smem, int wv) {
    ParamsPtr pp = PARAMS_PTR(P); PIN_S(pp); unsigned char* ws = pp->ws; int bidx = (int)blockIdx.x, gdim = (int)gridDim.x; PIN_S(bidx); PIN_S(gdim);
    const bf16_t* Qg = (const bf16_t*)(ws + O_RQ); const bf16_t* Sg = (const bf16_t*)(ws + O_RS); const bf16_t* Hg = (const bf16_t*)(ws + O_RH);
    const bf16_t* VB = (const bf16_t*)(ws + O_VB); const float* GATE = (const float*)(ws + O_GATE); const float* BONUS = (const float*)(ws + O_BONUS);
    bf16_t* GRP = (bf16_t*)(ws + O_GRP);
    const float* rln_g = pp->in[15] + (size_t)l * RW; const float* rln_b = pp->in[16] + (size_t)l * RW;
    const int tid = phase_tid(wv), lane = tid & 63, wave = tid >> 6, col = lane & 15, g = lane >> 4;
    for (int pu = bidx * NWAVES + wave; pu < NB * RH * RNC; pu += gdim * NWAVES) {
        const int c = pu % RNC, h = (pu / RNC) % RH, b = pu / (RNC * RH);
        f32x4 o[2][4][4];
#pragma unroll
        for (int d = 0; d < 2; ++d) {
            const int u = ((d * NB + b) * RH + h) * RNC + (d ? RNC - 1 - c : c);
            const size_t ub = (size_t)u * 4096;
            bf16x8 qa[4][2], sb[4][2];
#pragma unroll
            for (int q = 0; q < 4; ++q)
#pragma unroll
                for (int ks = 0; ks < 2; ++ks) {
                    qa[q][ks] = *(const bf16x8*)(Qg + ub + ((ks * 4 + q) * 64 + lane) * 8);
                    sb[q][ks] = *(const bf16x8*)(Sg + ub + (q * 16 + col) * 64 + 16 * g + 8 * ks);
                }
#pragma unroll
            for (int tt = 0; tt < 4; ++tt)
#pragma unroll
                for (int et = 0; et < 4; ++et) {
                    const u32x2 hb = *(const u32x2*)(Hg + ub + ((tt * 4 + et) * 64 + lane) * 4);
                    f32x4 acc = (f32x4){bf_lo(hb.x), bf_hi(hb.x), bf_lo(hb.y), bf_hi(hb.y)};
#pragma unroll
                    for (int ks = 0; ks < 2; ++ks) acc = MFMA16(qa[tt][ks], sb[et][ks], acc);
                    o[d][tt][et] = acc;
                }
        }
        const int src = (3 - g) * 16 + col;
#pragma unroll
        for (int tt = 0; tt < 4; ++tt)
#pragma unroll
            for (int et = 0; et < 4; ++et)
#pragma unroll
                for (int r = 0; r < 4; ++r) o[0][tt][et][r] += SHL(o[1][3 - tt][et][3 - r], src);
        float* tile = (float*)smem + wave * (64 * 68);
        WAVE_SYNC();
#pragma unroll
        for (int tt = 0; tt < 4; ++tt)
#pragma unroll
            for (int et = 0; et < 4; ++et)
#pragma unroll
                for (int r = 0; r < 4; ++r) tile[(tt * 16 + 4 * g + r) * 68 + et * 16 + col] = o[0][tt][et][r];
        WAVE_SYNC();
        {
            const int c4 = (lane & 15) * 4, ch = h * 64 + c4;
            const f32x4 lg = *(const f32x4*)(rln_g + ch), lb = *(const f32x4*)(rln_b + ch);
#pragma unroll 1
            for (int qb = 0; qb < 2; ++qb) {
                f32x4 gt_[8]; u32x2 vb_[8]; float bo_[8];
#pragma unroll
                for (int q8 = 0; q8 < 8; ++q8) {
                    const size_t t = (size_t)(b * S + c * RC + (qb * 8 + q8) * 4 + (lane >> 4));
                    gt_[q8] = *(const f32x4*)(GATE + t * RW + ch); vb_[q8] = *(const u32x2*)(VB + t * RW + ch); bo_[q8] = BONUS[t * RH + h];
                }
#pragma unroll
                for (int q8 = 0; q8 < 8; ++q8) {
                    const int tl = (qb * 8 + q8) * 4 + (lane >> 4);
                    const size_t t = (size_t)(b * S + c * RC + tl);
                    const f32x4 x = *(const f32x4*)(tile + tl * 68 + c4);
                    const float mean = row16_sum((x.x + x.y) + (x.z + x.w)) * (1.0f / 64.0f);
                    const f32x4 dl = x - mean;
                    const float var = row16_sum((dl.x * dl.x + dl.y * dl.y) + (dl.z * dl.z + dl.w * dl.w)) * (1.0f / 64.0f);
                    const float rstd = 1.0f / sqrtf(var + GN_EPS);
                    f32x4 y = dl * rstd * lg + lb;
                    y.x += bo_[q8] * bf_lo(vb_[q8].x); y.y += bo_[q8] * bf_hi(vb_[q8].x); y.z += bo_[q8] * bf_lo(vb_[q8].y); y.w += bo_[q8] * bf_hi(vb_[q8].y);
                    y = y * gt_[q8];
                    u32x2 ob; ob.x = pk2(y.x, y.y); ob.y = pk2(y.z, y.w);
                    *(u32x2*)(GRP + t * D + GW + ch) = ob;
                }
            }
        }
    }
    __syncthreads();
}

__device__ __forceinline__ void phase_mlstm_local(const Params& P, int l, unsigned char* smem, int wv, int bid, int nb) {
    PIN_S(bid); PIN_S(nb);
    ParamsPtr pp = PARAMS_PTR(P); PIN_S(pp); unsigned char* ws = pp->ws;
    const bf16_t* KT = (const bf16_t*)(ws + O_KT); const bf16_t* VT = (const bf16_t*)(ws + O_VT);
    const float* IG = (const float*)(ws + O_IG); const float* LF = (const float*)(ws + O_LF);
    float* CL = (float*)(ws + O_CL); float* NLb = (float*)(ws + O_NL); float* ML = (float*)(ws + O_ML); float* BL = (float*)(ws + O_BL);
    float* GVT = (float*)(ws + O_GVT); float* PMX = (float*)(ws + O_PMX); float* BCT = (float*)(ws + O_BCT);
    const int tid = phase_tid(wv), lane = tid & 63, wave = tid >> 6, col = lane & 15, g = lane >> 4;
    float* wts = (float*)smem + wave * 128;
    for (int u = bid * NWAVES + wave; u < 2 * NB * MH * NCH; u += nb * NWAVES) {
        const int c = u % NCH, h = (u / NCH) % MH, p = u / (NCH * MH), d = p / NB, b = p % NB;
        const int tc = d ? NCH - 1 - c : c, tok0 = b * S + tc * CH;
        const int i0 = d ? 127 - 2 * lane : 2 * lane, i1 = d ? i0 - 1 : i0 + 1;
        const size_t g0 = ((size_t)d * T + tok0 + i0) * MH + h, g1 = ((size_t)d * T + tok0 + i1) * MH + h;
        const float lf0 = LF[g0], lf1 = LF[g1], ig0 = IG[g0], ig1 = IG[g1];
        const float c1 = lf0 + lf1;
        float incl = c1;
#pragma unroll
        for (int o = 1; o < 64; o <<= 1) { const float tq = SHUP(incl, o, lane); if (lane >= o) incl += tq; }
        const float excl = incl - c1, bc0 = excl + lf0, bc1 = incl;
        const float blast = RDL(incl, 63);
        const float gv0 = ig0 - bc0, gv1 = ig1 - bc1, pl1 = fmaxf(gv0, gv1);
        float mincl = pl1;
#pragma unroll
        for (int o = 1; o < 64; o <<= 1) { const float tq = SHUP(mincl, o, lane); if (lane >= o) mincl = fmaxf(mincl, tq); }
        float mexcl = SHUP(mincl, 1, lane); if (lane == 0) mexcl = -INFINITY;
        const float pm0 = fmaxf(mexcl, gv0), pm1 = mincl;
        const float mloc = blast + RDL(mincl, 63);
        WAVE_SYNC();
        wts[i0] = fexp(blast + gv0 - mloc); wts[i1] = fexp(blast + gv1 - mloc);
        GVT[g0] = gv0; GVT[g1] = gv1; PMX[g0] = pm0; PMX[g1] = pm1; BCT[g0] = bc0; BCT[g1] = bc1;
        if (lane == 0) { ML[u] = mloc; BL[u] = blast; }
        WAVE_SYNC();
        const bf16_t* vbase = VT + ((size_t)(b * MH + h) * 64) * S + (size_t)tc * CH;
        const bf16_t* kbase = KT + ((size_t)(b * MH + h) * 64) * S + (size_t)tc * CH;
        const unsigned loff = (unsigned)(col * S + 8 * g);
        f32x4 acc[4][4];
#pragma unroll
        for (int a_ = 0; a_ < 4; ++a_)
#pragma unroll
            for (int b_ = 0; b_ < 4; ++b_) acc[a_][b_] = (f32x4){0.f, 0.f, 0.f, 0.f};
        float nsum[4] = {0.f, 0.f, 0.f, 0.f};
#pragma unroll 1
        for (int ks = 0; ks < 4; ++ks) {
            const int ii = ks * 32 + 8 * g;
            const f32x4 w0 = *(const f32x4*)(wts + ii), w1 = *(const f32x4*)(wts + ii + 4);
            bf16x8 af[4], bfk[4];
#pragma unroll
            for (int q = 0; q < 4; ++q) af[q] = *(const bf16x8*)(vbase + ((size_t)q * 16 * S + ks * 32) + loff);
#pragma unroll
            for (int q = 0; q < 4; ++q) {
                const u32x4 kr = *(const u32x4*)(kbase + ((size_t)q * 16 * S + ks * 32) + loff);
                f32x4 k0, k1;
                k0.x = bf_lo(kr.x) * w0.x; k0.y = bf_hi(kr.x) * w0.y; k0.z = bf_lo(kr.y) * w0.z; k0.w = bf_hi(kr.y) * w0.w;
                k1.x = bf_lo(kr.z) * w1.x; k1.y = bf_hi(kr.z) * w1.y; k1.z = bf_lo(kr.w) * w1.z; k1.w = bf_hi(kr.w) * w1.w;
                nsum[q] += (k0.x + k0.y) + (k0.z + k0.w) + (k1.x + k1.y) + (k1.z + k1.w);
                bfk[q] = cvt8(k0, k1);
            }
#pragma unroll
            for (int a_ = 0; a_ < 4; ++a_)
#pragma unroll
                for (int b_ = 0; b_ < 4; ++b_) acc[a_][b_] = MFMA16(af[a_], bfk[b_], acc[a_][b_]);
        }
        float* cbase = CL + (size_t)u * 4096;
        const unsigned coff = (unsigned)(4 * g * 64 + col);
#pragma unroll
        for (int b_ = 0; b_ < 4; ++b_) {
#pragma unroll
            for (int a_ = 0; a_ < 4; ++a_)
#pragma unroll
                for (int r = 0; r < 4; ++r) cbase[(a_ * 16 * 64 + r * 64 + b_ * 16) + coff] = acc[a_][b_][r];
            float ns = nsum[b_]; ns += SHX(ns, 16, lane); ns += SHX(ns, 32, lane);
            if (g == 0) NLb[(size_t)u * 64 + b_ * 16 + col] = ns;
        }
    }
    __syncthreads();
}

__device__ __forceinline__ void phase_mlstm_carry(const Params& P, int l, unsigned char* smem, int wv, int bidx, int gdim) {
    ParamsPtr pp = PARAMS_PTR(P); PIN_S(pp); unsigned char* ws = pp->ws; PIN_S(bidx); PIN_S(gdim);
    float* CL = (float*)(ws + O_CL); float* NLb = (float*)(ws + O_NL); const float* ML = (const float*)(ws + O_ML); const float* BL = (const float*)(ws + O_BL);
    float* MIN = (float*)(ws + O_MIN);
    const int total = 2 * NB * MH * 4160;
    const int tid = phase_tid(wv);
    for (int gi = bidx * NTHREADS + tid; gi < total; gi += gdim * NTHREADS) {
        const int ph = gi / 4160, e = gi % 4160;
        float* base_ = e < 4096 ? CL + (size_t)ph * NCH * 4096 + e : NLb + (size_t)ph * NCH * 64 + (e - 4096);
        const int stride = e < 4096 ? 4096 : 64;
        static_assert(NCH <= 32, "carry scan keeps one chunk value per register");
        float loc[NCH], bl[NCH], ml[NCH];
#pragma unroll
        for (int c = 0; c < NCH; ++c) { loc[c] = base_[(size_t)c * stride]; bl[c] = BL[ph * NCH + c]; ml[c] = ML[ph * NCH + c]; }
        float m = 0.f, val = 0.f;
#pragma unroll
        for (int c = 0; c < NCH; ++c) {
            base_[(size_t)c * stride] = val;
            if (e == 0) MIN[ph * NCH + c] = m;
            const float mn = fmaxf(bl[c] + m, ml[c]);
            val = fexp(bl[c] + m - mn) * val + fexp(ml[c] - mn) * loc[c];
            m = mn;
        }
    }
}

__device__ __forceinline__ void phase_mlstm_out(const Params& P, int l, unsigned char* smem, int wv) {
    ParamsPtr pp = PARAMS_PTR(P); PIN_S(pp); unsigned char* ws = pp->ws; int bidx = (int)blockIdx.x, gdim = (int)gridDim.x; PIN_S(bidx); PIN_S(gdim);
    const bf16_t* proj = (const bf16_t*)(ws + O_PROJ);
    const bf16_t* MQB = (const bf16_t*)(ws + O_MQB); const bf16_t* MKB = (const bf16_t*)(ws + O_MKB); const bf16_t* VT = (const bf16_t*)(ws + O_VT);
    const float* GVT = (const float*)(ws + O_GVT); const float* PMX = (const float*)(ws + O_PMX); const float* BCT = (const float*)(ws + O_BCT);
    const float* CL = (const float*)(ws + O_CL); const float* NLb = (const float*)(ws + O_NL); const float* MIN = (const float*)(ws + O_MIN);
    bf16_t* GRP = (bf16_t*)(ws + O_GRP);
    const float* mln_g = pp->in[20] + (size_t)l * MW;
    const int tid = phase_tid(wv), lane = tid & 63, wave = tid >> 6, col = lane & 15, g = lane >> 4;
    constexpr int KP = 72, VP = 136;
    bf16_t* Ks = (bf16_t*)smem;
    bf16_t* Vs = Ks + 128 * KP;
    float* gvs_ = (float*)(Vs + 64 * VP);
    for (int u = bidx; u < NB * MH * NCH; u += gdim) {
        const int tc = u % NCH, h = (u / NCH) % MH, b = u / (NCH * MH);
        const int tok0 = b * S + tc * CH, it = wave * 16 + col;
        __syncthreads();
        {
            u32x4 kb_[2], vb_[2];
#pragma unroll
            for (int q = 0; q < 2; ++q) {
                const int idx = tid + q * NTHREADS;
                kb_[q] = *(const u32x4*)(MKB + (size_t)(tok0 + (idx >> 3)) * MW + h * 64 + (idx & 7) * 8);
                vb_[q] = *(const u32x4*)(VT + ((size_t)(b * MH + h) * 64 + (idx >> 4)) * S + (size_t)tc * CH + (idx & 15) * 8);
            }
            float gq_ = 0.f;
            if (tid < 256) gq_ = GVT[((size_t)(tid >> 7) * T + tok0 + (tid & 127)) * MH + h];
#pragma unroll
            for (int q = 0; q < 2; ++q) {
                const int idx = tid + q * NTHREADS;
                *(u32x4*)(Ks + (idx >> 3) * KP + (idx & 7) * 8) = kb_[q];
                *(u32x4*)(Vs + (idx >> 4) * VP + (idx & 15) * 8) = vb_[q];
            }
            if (tid < 256) gvs_[tid] = gq_;
        }
        __syncthreads();
        const size_t trow = (size_t)(tok0 + it);
        bf16x8 bq[2];
#pragma unroll
        for (int ks = 0; ks < 2; ++ks) bq[ks] = *(const bf16x8*)(MQB + trow * MW + h * 64 + ks * 32 + 8 * g);
        f32x4 hs[4];
#pragma unroll
        for (int et = 0; et < 4; ++et) hs[et] = (f32x4){0.f, 0.f, 0.f, 0.f};
#pragma unroll
        for (int d = 0; d < 2; ++d) {
            const int cd = d ? NCH - 1 - tc : tc;
            const int su = ((d * NB + b) * MH + h) * NCH + cd;
            const size_t gt = ((size_t)d * T + trow) * MH + h;
            const float mst = MIN[su];
            const float mxt = fmaxf(PMX[gt], mst), mt = BCT[gt] + mxt, wint = fexp(mst - mxt);
            f32x4 num[4];
#pragma unroll
            for (int et = 0; et < 4; ++et) num[et] = (f32x4){0.f, 0.f, 0.f, 0.f};
            float den = 0.f;
            for (int sp = 0; sp < 4; ++sp) {
                if (d == 0 ? (2 * sp > wave) : (2 * sp + 1 < wave)) continue;
                float pw[8];
#pragma unroll
                for (int hf = 0; hf < 2; ++hf) {
                    const int st = 2 * sp + hf;
                    f32x4 sacc = (f32x4){0.f, 0.f, 0.f, 0.f};
#pragma unroll
                    for (int ks = 0; ks < 2; ++ks) sacc = MFMA16(*(const bf16x8*)(Ks + (st * 16 + col) * KP + ks * 32 + 8 * g), bq[ks], sacc);
                    const f32x4 g4 = *(const f32x4*)(gvs_ + d * 128 + st * 16 + 4 * g);
#pragma unroll
                    for (int r = 0; r < 4; ++r) {
                        const int is = st * 16 + 4 * g + r;
                        const bool ok = d == 0 ? (is <= it) : (is >= it);
                        const float pr = ok ? sacc[r] * fexp(g4[r] - mxt) : 0.f;
                        den += pr; pw[hf * 4 + r] = pr;
                    }
                }
                u32x4 pb; pb.x = pk2(pw[0], pw[1]); pb.y = pk2(pw[2], pw[3]); pb.z = pk2(pw[4], pw[5]); pb.w = pk2(pw[6], pw[7]);
                const bf16x8 bp = __builtin_bit_cast(bf16x8, pb);
#pragma unroll
                for (int et = 0; et < 4; ++et) {
                    const bf16_t* vp = Vs + (et * 16 + col) * VP + sp * 32 + 4 * g;
                    const u32x2 v0 = *(const u32x2*)vp, v1 = *(const u32x2*)(vp + 16);
                    u32x4 va; va.x = v0.x; va.y = v0.y; va.z = v1.x; va.w = v1.y;
                    num[et] = MFMA16(__builtin_bit_cast(bf16x8, va), bp, num[et]);
                }
            }
            den += SHX(den, 16, lane); den += SHX(den, 32, lane);
            f32x4 qc[4]; float qn = 0.f;
#pragma unroll
            for (int ks = 0; ks < 2; ++ks) {
                const float* np = NLb + (size_t)su * 64 + ks * 32 + 8 * g;
                const f32x4 n0 = *(const f32x4*)np, n1 = *(const f32x4*)(np + 4);
                const u32x4 qb = __builtin_bit_cast(u32x4, bq[ks]);
                qn += (bf_lo(qb.x) * n0.x + bf_hi(qb.x) * n0.y) + (bf_lo(qb.y) * n0.z + bf_hi(qb.y) * n0.w) + (bf_lo(qb.z) * n1.x + bf_hi(qb.z) * n1.y) + (bf_lo(qb.w) * n1.z + bf_hi(qb.w) * n1.w);
            }
            qn += SHX(qn, 16, lane); qn += SHX(qn, 32, lane);
#pragma unroll
            for (int et = 0; et < 4; ++et) {
                qc[et] = (f32x4){0.f, 0.f, 0.f, 0.f};
#pragma unroll
                for (int ks = 0; ks < 2; ++ks) {
                    const float* cp = CL + (size_t)su * 4096 + (size_t)(et * 16 + col) * 64 + ks * 32 + 8 * g;
                    qc[et] = MFMA16(cvt8(*(const f32x4*)cp, *(const f32x4*)(cp + 4)), bq[ks], qc[et]);
                }
            }
            const float dd = frcp(fmaxf(fabsf(den + wint * qn), fexp(-mt)));
#pragma unroll
            for (int et = 0; et < 4; ++et) hs[et] += (num[et] + wint * qc[et]) * dd;
        }
        float sm = 0.f;
#pragma unroll
        for (int et = 0; et < 4; ++et) sm += (hs[et].x + hs[et].y) + (hs[et].z + hs[et].w);
        sm += SHX(sm, 16, lane); sm += SHX(sm, 32, lane);
        const float mean = sm * (1.0f / 64.0f); float q = 0.f;
#pragma unroll
        for (int et = 0; et < 4; ++et) { const f32x4 dl = hs[et] - mean; q += (dl.x * dl.x + dl.y * dl.y) + (dl.z * dl.z + dl.w * dl.w); }
        q += SHX(q, 16, lane); q += SHX(q, 32, lane);
        const float rstd = 1.0f / sqrtf(q * (1.0f / 64.0f) + LN_EPS);
#pragma unroll
        for (int et = 0; et < 4; ++et) {
            const int c = h * 64 + et * 16 + 4 * g;
            const u32x2 ob_ = *(const u32x2*)(proj + trow * PLD + C_MW + 3 * MW + c); const f32x4 o4 = (f32x4){bf_lo(ob_.x), bf_hi(ob_.x), bf_lo(ob_.y), bf_hi(ob_.y)}, g4 = *(const f32x4*)(mln_g + c);
            const f32x4 y = (hs[et] - mean) * rstd * g4;
            u32x2 ob; ob.x = pk2(sigmoidf_(o4.x) * y.x, sigmoidf_(o4.y) * y.y); ob.y = pk2(sigmoidf_(o4.z) * y.z, sigmoidf_(o4.w) * y.w);
            *(u32x2*)(GRP + trow * D + GW + RW + c) = ob;
        }
    }
    __syncthreads();
}

__device__ __forceinline__ void phase_rwkv_post(const Params& P, int l, unsigned char* smem, int wv) {
    ParamsPtr pp = PARAMS_PTR(P); PIN_S(pp); unsigned char* ws = pp->ws; int bidx = (int)blockIdx.x, gdim = (int)gridDim.x; PIN_S(bidx); PIN_S(gdim);
    const float* SCAN = (const float*)(ws + O_SCAN); const float* VV = (const float*)(ws + O_VV); const float* GATE = (const float*)(ws + O_GATE);
    const float* BONUS = (const float*)(ws + O_BONUS); bf16_t* GRP = (bf16_t*)(ws + O_GRP);
    const float* rln_g = pp->in[15] + (size_t)l * RW; const float* rln_b = pp->in[16] + (size_t)l * RW;
    const int tid = phase_tid(wv), lane = tid & 63, wave = tid >> 6;
    const int gw = bidx * NWAVES + wave, ngw = NWAVES * gdim;
    for (int it = gw; it < T * RH; it += ngw) {
        const int t = it / RH, h = it % RH, c = h * 64 + lane;
        const size_t o = (size_t)t * RW + c;
        const float x = SCAN[o] + SCAN[(size_t)T * RW + o];
        const float mean = wave_sum(x, lane) * (1.0f / 64.0f);
        const float dl = x - mean;
        const float var = wave_sum(dl * dl, lane) * (1.0f / 64.0f);
        float y = dl / sqrtf(var + GN_EPS) * rln_g[c] + rln_b[c];
        y += BONUS[(size_t)t * RH + h] * VV[o];
        GRP[(size_t)t * D + GW + c] = (bf16_t)f2bf(y * GATE[o]);
    }
}

__device__ __forceinline__ void phase_ln1_router(const Params& P, int l, unsigned char* smem, int wv) {
    ParamsPtr pp = PARAMS_PTR(P); PIN_S(pp); unsigned char* ws = pp->ws; int bidx = (int)blockIdx.x, gdim = (int)gridDim.x; PIN_S(bidx); PIN_S(gdim);
    const float* xin = l == 0 ? pp->in[0] : (const float*)(ws + O_XA);
    const bf16_t* MIX = (const bf16_t*)(ws + O_MIX); float* X1 = (float*)(ws + O_X1);
    int* TOPI = (int*)(ws + O_TOPI); float* TOPG = (float*)(ws + O_TOPG); int* RANK = (int*)(ws + O_RANK); bf16_t* X1B = (bf16_t*)(ws + O_X1B);
    int* BCNT = (int*)(ws + O_BCNT);
    const float* g1 = pp->in[22] + (size_t)l * D; const float* b1 = pp->in[23] + (size_t)l * D;
    const float* rw = pp->in[24] + (size_t)l * D * NE; const float* rb = pp->in[25] + (size_t)l * NE;
    const bf16_t* RWT = (const bf16_t*)(ws + O_RWT) + (size_t)l * 2 * NE * D;
    const int tid = phase_tid(wv), lane = tid & 63, wave = tid >> 6, col = lane & 15, g = lane >> 4;
    float* lgs = (float*)smem;
    int* stopi = (int*)(smem + 8192);
    for (int tile = bidx; tile < T / 64; tile += gdim) {
        __syncthreads();
        {
            f32x4 xa[4]; u32x2 xm[4];
#define LN1_LOAD(tt_) do { _Pragma("unroll") for (int j = 0; j < 4; ++j) { const int c = j * 256 + lane * 4; xa[j] = *(const f32x4*)(xin + (size_t)(tt_) * D + c); xm[j] = *(const u32x2*)(MIX + (size_t)(tt_) * D + c); } } while (0)
            LN1_LOAD(tile * 64 + wave * 8);
#pragma unroll 1
            for (int ti8 = 0; ti8 < 8; ++ti8) {
                const int t = tile * 64 + wave * 8 + ti8;
                float v[16]; float sm = 0.f;
#pragma unroll
                for (int j = 0; j < 4; ++j) {
                    v[j * 4 + 0] = ALPHA * xa[j].x + bf_lo(xm[j].x); v[j * 4 + 1] = ALPHA * xa[j].y + bf_hi(xm[j].x); v[j * 4 + 2] = ALPHA * xa[j].z + bf_lo(xm[j].y); v[j * 4 + 3] = ALPHA * xa[j].w + bf_hi(xm[j].y);
                    sm += (v[j * 4] + v[j * 4 + 1]) + (v[j * 4 + 2] + v[j * 4 + 3]);
                }
                if (ti8 < 7) LN1_LOAD(t + 1);
                const float mean = wave_sum_fast(sm, lane) * (1.0f / D); float q = 0.f;
#pragma unroll
                for (int j = 0; j < 16; ++j) { const float dl = v[j] - mean; q += dl * dl; }
                const float rstd = 1.0f / sqrtf(wave_sum_fast(q, lane) * (1.0f / D) + LN_EPS);
#pragma unroll
                for (int j = 0; j < 4; ++j) {
                    const int c = j * 256 + lane * 4;
                    const f32x4 gg = *(const f32x4*)(g1 + c), bb = *(const f32x4*)(b1 + c);
                    f32x4 o;
                    o.x = (v[j * 4 + 0] - mean) * rstd * gg.x + bb.x; o.y = (v[j * 4 + 1] - mean) * rstd * gg.y + bb.y;
                    o.z = (v[j * 4 + 2] - mean) * rstd * gg.z + bb.z; o.w = (v[j * 4 + 3] - mean) * rstd * gg.w + bb.w;
                    *(f32x4*)(X1 + (size_t)t * D + c) = o;
                    u32x2 ob; ob.x = pk2(o.x, o.y); ob.y = pk2(o.z, o.w); *(u32x2*)(X1B + (size_t)t * D + c) = ob;
                }
            }
#undef LN1_LOAD
        }
        __syncthreads();
        {
            const float* xr = X1 + (size_t)(tile * 64 + (wave >> 1) * 16 + col) * D + 8 * g;
            const bf16_t* wh = RWT + (size_t)((wave & 1) * 16 + col) * D + 8 * g; const bf16_t* wl = wh + (size_t)NE * D;
            f32x4 acc = (f32x4){0.f, 0.f, 0.f, 0.f};
#pragma unroll 4
            for (int ks = 0; ks < 32; ++ks) {
                const f32x4 x0 = *(const f32x4*)(xr + ks * 32), x1 = *(const f32x4*)(xr + ks * 32 + 4);
                const bf16x8 bh = *(const bf16x8*)(wh + ks * 32), bl = *(const bf16x8*)(wl + ks * 32);
                const bf16x8 ah = cvt8(x0, x1);
                const u32x4 ahu = __builtin_bit_cast(u32x4, ah);
                f32x4 r0, r1;
                r0.x = x0.x - bf_lo(ahu.x); r0.y = x0.y - bf_hi(ahu.x); r0.z = x0.z - bf_lo(ahu.y); r0.w = x0.w - bf_hi(ahu.y);
                r1.x = x1.x - bf_lo(ahu.z); r1.y = x1.y - bf_hi(ahu.z); r1.z = x1.z - bf_lo(ahu.w); r1.w = x1.w - bf_hi(ahu.w);
                const bf16x8 al = cvt8(r0, r1);
                acc = MFMA16(ah, bh, acc); acc = MFMA16(ah, bl, acc); acc = MFMA16(al, bh, acc);
            }
            const float rbv = rb[(wave & 1) * 16 + col];
#pragma unroll
            for (int r = 0; r < 4; ++r) lgs[((wave >> 1) * 16 + 4 * g + r) * NE + (wave & 1) * 16 + col] = acc[r] + rbv;
        }
        __syncthreads();
        if (tid < 64) {
            const float* lp = lgs + tid * NE; const int t = tile * 64 + tid;
            float tv[4]; int ti[4];
#pragma unroll
            for (int k = 0; k < 4; ++k) { tv[k] = -INFINITY; ti[k] = 0; }
            for (int e = 0; e < NE; ++e) {
                const float x = lp[e];
                if (x > tv[3]) {
                    if (x > tv[0]) { tv[3] = tv[2]; ti[3] = ti[2]; tv[2] = tv[1]; ti[2] = ti[1]; tv[1] = tv[0]; ti[1] = ti[0]; tv[0] = x; ti[0] = e; }
                    else if (x > tv[1]) { tv[3] = tv[2]; ti[3] = ti[2]; tv[2] = tv[1]; ti[2] = ti[1]; tv[1] = x; ti[1] = e; }
                    else if (x > tv[2]) { tv[3] = tv[2]; ti[3] = ti[2]; tv[2] = x; ti[2] = e; }
                    else { tv[3] = x; ti[3] = e; }
                }
            }
            const float e1 = expf(tv[1] - tv[0]), e2 = expf(tv[2] - tv[0]), e3 = expf(tv[3] - tv[0]);
            const float inv = 1.0f / (1.0f + e1 + e2 + e3);
            *(f32x4*)(TOPG + (size_t)t * 4) = (f32x4){inv, e1 * inv, e2 * inv, e3 * inv};
#pragma unroll
            for (int k = 0; k < 4; ++k) { TOPI[(size_t)t * 4 + k] = ti[k]; stopi[tid * 4 + k] = ti[k]; }
        }
        __syncthreads();
        if (tid < 256) { const int e = stopi[tid]; int r = 0; for (int a2 = 0; a2 < tid; ++a2) r += (stopi[a2] == e) ? 1 : 0; RANK[(size_t)tile * 256 + tid] = r; }
        else if (tid < 256 + NE) { const int e = tid - 256; int cnt = 0; for (int a2 = 0; a2 < 256; ++a2) cnt += (stopi[a2] == e) ? 1 : 0; BCNT[tile * NE + e] = cnt; }
    }
    __syncthreads();
}

__device__ __forceinline__ void moe_offsets(int* sh, const int* CNT, int tid) {
    if (tid == 0) {
        int acc = 0;
        for (int e = 0; e < NE; ++e) { const int c = (int)CNT[e]; sh[e] = c; sh[32 + e] = acc; acc += (c + MOEB - 1) / MOEB * MOEB; sh[64 + e] = acc; }
    }
    __syncthreads();
}
__device__ __forceinline__ int moe_expert_of_row(const int* sh, int r) {
    int e = -1;
    for (int i = 0; i < NE; ++i) if (r >= sh[32 + i] && r < sh[64 + i]) e = i;
    return e;
}

__device__ __forceinline__ void phase_scatter(const Params& P, int l, unsigned char* smem, int wv) {
    ParamsPtr pp = PARAMS_PTR(P); PIN_S(pp); unsigned char* ws = pp->ws; int bidx = (int)blockIdx.x, gdim = (int)gridDim.x; PIN_S(bidx); PIN_S(gdim);
    const int tid = phase_tid(wv);
    const int* TOPI = (const int*)(ws + O_TOPI); const int* RANK = (const int*)(ws + O_RANK); int* SLOT = (int*)(ws + O_SLOT); int* ROWT = (int*)(ws + O_ROWT);
    const int* BCNT = (const int*)(ws + O_BCNT); int* CNTF = (int*)(ws + O_CNTF);
    int* sh = (int*)smem;
    int* part = sh + 96;
    int* tot = part + 512;
    int* base = tot + 32;
    constexpr int NT = T / 64;
    const int e = tid & 31, pt = tid >> 5;
    { int sacc = 0; for (int tl = pt; tl < NT; tl += 16) sacc += BCNT[tl * NE + e]; part[pt * 32 + e] = sacc; }
    __syncthreads();
    if (tid < 32) { int sacc = 0; for (int q = 0; q < 16; ++q) sacc += part[q * 32 + tid]; tot[tid] = sacc; if (bidx == 0) CNTF[tid] = sacc; }
    __syncthreads();
    moe_offsets(sh, tot, tid);
    for (int ee = bidx; ee < NE; ee += gdim)
        for (int r = sh[32 + ee] + sh[ee] + tid; r < sh[64 + ee]; r += NTHREADS) ROWT[r] = 0;
    for (int tile = bidx; tile < NT; tile += gdim) {
        __syncthreads();
        { int sacc = 0; for (int tl = pt; tl < tile; tl += 16) sacc += BCNT[tl * NE + e]; part[pt * 32 + e] = sacc; }
        __syncthreads();
        if (tid < 32) { int sacc = sh[32 + tid]; for (int q = 0; q < 16; ++q) sacc += part[q * 32 + tid]; base[tid] = sacc; }
        __syncthreads();
        if (tid < 256) { const int a = tile * 256 + tid, dest = base[TOPI[a]] + RANK[a]; SLOT[a] = dest; ROWT[dest] = a >> 2; }
    }
    __syncthreads();
}

template <int WHICH>
__device__ __forceinline__ void phase_moe_gemm(const Params& P, int l, unsigned char* smem, int wv) {
    ParamsPtr pp = PARAMS_PTR(P); PIN_S(pp); unsigned char* ws = pp->ws; int bidx = (int)blockIdx.x, gdim = (int)gridDim.x; PIN_S(bidx); PIN_S(gdim);
    const int tid = phase_tid(wv);
    const int* CNT = (const int*)(ws + O_CNTF);
    int* sh = (int*)(smem + 131072);
    int* rbe = sh + 96;
    moe_offsets(sh, CNT, tid);
    const int nrb = sh[64 + NE - 1] / MOEB;
    for (int rb = tid; rb < nrb; rb += NTHREADS) rbe[rb] = moe_expert_of_row(sh, rb * MOEB);
    __syncthreads();
    pg8::MoeOrderT<WHICH == 1> S;
    S.K = 1024; S.G_ = gdim; S.c = bidx; S.rbe = rbe; S.rowmap = (const int*)(ws + O_ROWT);
    if (WHICH == 1) {
        S.A = (const char*)(ws + O_X1B); S.Wt = (const char*)(ws + O_W1) + (size_t)l * NE * 2 * DFF * D * 2; S.estride = (size_t)2 * DFF * D * 2; S.nN = 2 * DFF / 256; S.nwg = nrb * S.nN;
        pg8::EpiSwiglu E{(bf16_t*)(ws + O_ACT), pp->in[27] + (size_t)l * NE * 2 * DFF};
        pg8::gemm_phase<pg8::EpiSwiglu, pg8::MoeOrderT<WHICH == 1>>((LAS unsigned char*)smem, 1024, S, E, tid);
    } else {
        S.A = (const char*)(ws + O_ACT); S.Wt = (const char*)(ws + O_W2) + (size_t)l * NE * D * DFF * 2; S.estride = (size_t)D * DFF * 2; S.nN = D / 256; S.nwg = nrb * S.nN;
        pg8::EpiBf16Bias E{(bf16_t*)(ws + O_YS), D, pp->in[29] + (size_t)l * NE * D, D};
        pg8::gemm_phase<pg8::EpiBf16Bias, pg8::MoeOrderT<WHICH == 1>>((LAS unsigned char*)smem, 1024, S, E, tid);
    }
    __syncthreads();
}

__device__ __forceinline__ void phase_combine_ln2(const Params& P, int l, unsigned char* smem, int wv) {
    ParamsPtr pp = PARAMS_PTR(P); PIN_S(pp); unsigned char* ws = pp->ws; int bidx = (int)blockIdx.x, gdim = (int)gridDim.x; PIN_S(bidx); PIN_S(gdim);
    const float* X1 = (const float*)(ws + O_X1); const bf16_t* YS = (const bf16_t*)(ws + O_YS); bf16_t* XB = (bf16_t*)(ws + O_XB);
    const int* SLOT = (const int*)(ws + O_SLOT); const float* TOPG = (const float*)(ws + O_TOPG);
    float* xo = l == NL - 1 ? pp->out : (float*)(ws + O_XA);
    const float* g2 = pp->in[30] + (size_t)l * D; const float* b2 = pp->in[31] + (size_t)l * D;
    const int tid = phase_tid(wv), lane = tid & 63, wave = tid >> 6;
    const int gw = bidx * NWAVES + wave, ngw = NWAVES * gdim;
    u32x4 sl_n = (u32x4){0u, 0u, 0u, 0u}; f32x4 gg_n = (f32x4){0.f, 0.f, 0.f, 0.f};
    f32x4 xa_n[4]; u32x2 ys_n[4][4]; f32x4 gg_c = (f32x4){0.f, 0.f, 0.f, 0.f};
    const f32x4 lg[4] = {*(const f32x4*)(g2 + lane * 4), *(const f32x4*)(g2 + 256 + lane * 4), *(const f32x4*)(g2 + 512 + lane * 4), *(const f32x4*)(g2 + 768 + lane * 4)};
    const f32x4 lb[4] = {*(const f32x4*)(b2 + lane * 4), *(const f32x4*)(b2 + 256 + lane * 4), *(const f32x4*)(b2 + 512 + lane * 4), *(const f32x4*)(b2 + 768 + lane * 4)};
#define CB_META(tt_) do { sl_n = *(const u32x4*)(SLOT + (size_t)(tt_) * 4); gg_n = *(const f32x4*)(TOPG + (size_t)(tt_) * 4); } while (0)
#define CB_ROWS(tt_) do { _Pragma("unroll") for (int j = 0; j < 4; ++j) { const int c = j * 256 + lane * 4; xa_n[j] = *(const f32x4*)(X1 + (size_t)(tt_) * D + c); \
        ys_n[0][j] = *(const u32x2*)(YS + (size_t)sl_n.x * D + c); ys_n[1][j] = *(const u32x2*)(YS + (size_t)sl_n.y * D + c); ys_n[2][j] = *(const u32x2*)(YS + (size_t)sl_n.z * D + c); ys_n[3][j] = *(const u32x2*)(YS + (size_t)sl_n.w * D + c); } gg_c = gg_n; } while (0)
    if (gw < T) { CB_META(gw); CB_ROWS(gw); if (gw + ngw < T) CB_META(gw + ngw); }
    for (int t = gw; t < T; t += ngw) {
        float v[16]; float sm = 0.f;
        const float gk[4] = {gg_c.x, gg_c.y, gg_c.z, gg_c.w};
#pragma unroll
        for (int j = 0; j < 4; ++j) {
            const f32x4 a = xa_n[j];
            f32x4 y = (f32x4){0.f, 0.f, 0.f, 0.f};
#pragma unroll
            for (int k = 0; k < 4; ++k) { const u32x2 yk = ys_n[k][j]; y.x += gk[k] * bf_lo(yk.x); y.y += gk[k] * bf_hi(yk.x); y.z += gk[k] * bf_lo(yk.y); y.w += gk[k] * bf_hi(yk.y); }
            v[j * 4 + 0] = ALPHA * a.x + y.x; v[j * 4 + 1] = ALPHA * a.y + y.y; v[j * 4 + 2] = ALPHA * a.z + y.z; v[j * 4 + 3] = ALPHA * a.w + y.w;
            sm += (v[j * 4] + v[j * 4 + 1]) + (v[j * 4 + 2] + v[j * 4 + 3]);
        }
        if (t + ngw < T) { CB_ROWS(t + ngw); if (t + 2 * ngw < T) CB_META(t + 2 * ngw); }
        const float mean = wave_sum_fast(sm, lane) * (1.0f / D); float q = 0.f;
#pragma unroll
        for (int j = 0; j < 16; ++j) { const float dl = v[j] - mean; q += dl * dl; }
        const float rstd = 1.0f / sqrtf(wave_sum_fast(q, lane) * (1.0f / D) + LN_EPS);
#pragma unroll
        for (int j = 0; j < 4; ++j) {
            const int c = j * 256 + lane * 4;
            f32x4 o;
            o.x = (v[j * 4 + 0] - mean) * rstd * lg[j].x + lb[j].x; o.y = (v[j * 4 + 1] - mean) * rstd * lg[j].y + lb[j].y;
            o.z = (v[j * 4 + 2] - mean) * rstd * lg[j].z + lb[j].z; o.w = (v[j * 4 + 3] - mean) * rstd * lg[j].w + lb[j].w;
            *(f32x4*)(xo + (size_t)t * D + c) = o;
            if (l != NL - 1) { u32x2 ob; ob.x = pk2(o.x, o.y); ob.y = pk2(o.z, o.w); *(u32x2*)(XB + (size_t)t * D + c) = ob; }
        }
    }
#undef CB_META
#undef CB_ROWS
}

__device__ __forceinline__ void phase_inproj(const Params& P, int l, unsigned char* smem, int wv) {
    ParamsPtr pp = PARAMS_PTR(P); PIN_S(pp); unsigned char* ws = pp->ws; int bidx = (int)blockIdx.x, gdim = (int)gridDim.x; PIN_S(bidx); PIN_S(gdim);
    const int tid = phase_tid(wv);
    pg8::DenseOrder S; S.init(ws + O_XB, (const bf16_t*)(ws + O_WIN) + (size_t)l * PLD * D, T, PLD, D, gdim, bidx);
    pg8::EpiProj E{(bf16_t*)(ws + O_PROJ), PLD, (float*)(ws + O_PROJG), PLD / 256 - 1};
    pg8::gemm_phase<pg8::EpiProj, pg8::DenseOrder>((LAS unsigned char*)smem, D, S, E, tid);
    __syncthreads();
}
__device__ __forceinline__ void phase_outproj(const Params& P, int l, unsigned char* smem, int wv) {
    ParamsPtr pp = PARAMS_PTR(P); PIN_S(pp); unsigned char* ws = pp->ws; int bidx = (int)blockIdx.x, gdim = (int)gridDim.x; PIN_S(bidx); PIN_S(gdim);
    const int tid = phase_tid(wv);
    pg8::DenseOrder S; S.init(ws + O_GRP, (const bf16_t*)(ws + O_WOUT) + (size_t)l * D * D, T, D, D, gdim, bidx);
    pg8::EpiProj E{(bf16_t*)(ws + O_MIX), D, nullptr, -1};
    pg8::gemm_phase<pg8::EpiProj, pg8::DenseOrder>((LAS unsigned char*)smem, D, S, E, tid);
    __syncthreads();
}

#ifndef EMU
#define XB_TMO      128
#define XB_XCNT(j)  (256  + 64 * (j))
#define XB_XSUB(j)  (1280 + 64 * (j))
#define XB_XGEN(j)  (2304 + 64 * (j))
#define XB_TOP      3328
#define XB_TOPGEN   3392
#define XCD_BAR_WORDS 3456
#define XB_SPIN_CAP (1u << 25)
__device__ __forceinline__ unsigned xb_ld(unsigned* p)              { return __hip_atomic_load(p, __ATOMIC_RELAXED, __HIP_MEMORY_SCOPE_AGENT); }
__device__ __forceinline__ unsigned xb_add(unsigned* p, unsigned v) { return __hip_atomic_fetch_add(p, v, __ATOMIC_RELAXED, __HIP_MEMORY_SCOPE_AGENT); }
__device__ __forceinline__ unsigned xb_xcc_id() { return (unsigned)__builtin_amdgcn_s_getreg((3 << 11) | 20) & 0xFu; }
#define XB_SPIN(cond, bar) do { unsigned _sp = 0; while (cond) { __builtin_amdgcn_s_sleep(1); \
    if ((++_sp & 255u) == 0u) { if (xb_ld(&(bar)[XB_TMO])) break; if (_sp > XB_SPIN_CAP) { atomicAdd(&(bar)[XB_TMO], 1u); break; } } } } while (0)
struct XcdBarrier { unsigned* bar; unsigned x; volatile LAS unsigned* st; };
__device__ __forceinline__ XcdBarrier xcd_barrier_post(unsigned* bar, volatile LAS unsigned* st) {
    XcdBarrier b; b.bar = bar; b.x = xb_xcc_id(); b.st = st;
    if (threadIdx.x == 0) (void)xb_add(&bar[XB_XCNT(b.x)], 1u);
    return b;
}
__device__ __forceinline__ void xcd_barrier_complete(unsigned* bar, unsigned x, unsigned& nloc, unsigned& nx) {
    const unsigned G = gridDim.x * gridDim.y * gridDim.z;
    unsigned sum, cnt, mine, sp = 0u;
    for (;;) {
        sum = 0u; cnt = 0u; mine = 0u;
#pragma unroll
        for (unsigned j = 0; j < 16; ++j) { const unsigned c = xb_ld(&bar[XB_XCNT(j)]); sum += c; cnt += (c > 0u) ? 1u : 0u; mine = (j == x) ? c : mine; }
        if (sum == G) break;
        __builtin_amdgcn_s_sleep(1);
        if ((++sp & 255u) == 0u) { if (xb_ld(&bar[XB_TMO])) break; if (sp > XB_SPIN_CAP) { atomicAdd(&bar[XB_TMO], 1u); break; } }
    }
    nloc = mine > 0u ? mine : 1u; nx = cnt > 0u ? cnt : 1u;
}
__device__ __forceinline__ void xcd_barrier(const XcdBarrier& b) {
    asm volatile("s_waitcnt vmcnt(0)" ::: "memory");
    __syncthreads();
    if (threadIdx.x == 0) {
        unsigned* bar = b.bar;
        __builtin_amdgcn_s_waitcnt(0);
        unsigned nloc = b.st[0], nx = b.st[1];
        if (nloc == 0u) { xcd_barrier_complete(bar, b.x, nloc, nx); b.st[0] = nloc; b.st[1] = nx; }
        const unsigned old = xb_add(&bar[XB_XSUB(b.x)], 1u);
        const unsigned gen = old / nloc;
        if (old + 1u == (gen + 1u) * nloc) {
            __builtin_amdgcn_fence(__ATOMIC_RELEASE, "agent");
            asm volatile("s_waitcnt vmcnt(0)" ::: "memory");
            const unsigned og = xb_add(&bar[XB_TOP], 1u);
            const unsigned tg = og / nx;
            if (og + 1u == (tg + 1u) * nx) xb_add(&bar[XB_TOPGEN], 1u);
            else XB_SPIN(xb_ld(&bar[XB_TOPGEN]) == tg, bar);
            __builtin_amdgcn_fence(__ATOMIC_ACQUIRE, "agent");
            xb_add(&bar[XB_XGEN(b.x)], 1u);
            asm volatile("s_waitcnt vmcnt(0)" ::: "memory");
        } else {
            XB_SPIN(xb_ld(&bar[XB_XGEN(b.x)]) == gen, bar);
            __builtin_amdgcn_fence(__ATOMIC_ACQUIRE, "agent");
            asm volatile("s_waitcnt vmcnt(0)" ::: "memory");
        }
    }
    __syncthreads();
}
#endif

__global__ void __launch_bounds__(512, 2) mk_fwd(Params P) {
#ifdef EMU
    unsigned char* smem = g_blk->lds;
#else
    extern __shared__ __attribute__((aligned(16))) unsigned char smem[];
    volatile LAS unsigned* bst = (volatile LAS unsigned*)(smem + LDS_BYTES - 16);
    if (threadIdx.x == 0) { bst[0] = 0u; bst[1] = 0u; bst[2] = 0u; bst[3] = 0u; }
    __syncthreads();
    XcdBarrier bar; bar.bar = (unsigned*)P.ws + CW_BAR; bar.x = 0; bar.st = bst;
    if (P.ph_hi - P.ph_lo > 1) bar = xcd_barrier_post((unsigned*)P.ws + CW_BAR, bst);
#endif
    const int lo = P.ph_lo, hi = P.ph_hi;
#ifdef EMU
    const int wv = (int)threadIdx.x >> 6;
#else
    const int wv = RFL((int)threadIdx.x >> 6);
#endif
#ifdef EMU
#define SEAM(id) do {} while (0)
#else
#define SEAM(id) do { if ((id) + 1 < hi) xcd_barrier(bar); } while (0)
#endif
#ifndef MK_ONLY_PHASE
#define MK_ONLY_PHASE -1
#endif
#ifndef MK_DUP_MASK
#define MK_DUP_MASK 0
#endif
#define PHG(kc, id, ...) do { if (MK_ONLY_PHASE < 0 || MK_ONLY_PHASE == (kc)) { const int id_ = (id); if (id_ >= lo && id_ < hi) { if ((MK_DUP_MASK >> (kc)) & 1) { __VA_ARGS__; SEAM(id_ - 1); } __VA_ARGS__; SEAM(id_); } } } while (0)
#define PH(k, ...) PHG(1 + (k), 1 + l * NPH + (k), __VA_ARGS__)
    PHG(0, 0, phase_prologue(P, smem, wv));
    for (int l = 0; l < NL; ++l) {
        PH(0, phase_inproj(P, l, smem, wv));
#if MK_RWKV_CHUNKED
        PH(1, phase_prep32(P, l, smem, wv));
#else
        PH(1, phase_prep(P, l, smem, wv));
#endif
#if MK_RWKV_CHUNKED
        PH(2, { phase_rwkv_pre(P, l, smem, wv); phase_mlstm_local(P, l, smem, wv, (int)blockIdx.x, (int)gridDim.x); });
        PH(3, { const int G_ = (int)gridDim.x;
                if (G_ >= 2 * RSEQ_WGS) { if ((int)blockIdx.x < RSEQ_WGS) { phase_rwkv_seq(P, l, smem, wv); if (MK_PROBE >= 30 && MK_PROBE < 38) phase_rwkv_seq<MK_PROBE >= 30 && MK_PROBE < 38 ? MK_PROBE - 30 : 0>(P, l, smem, wv); }
                                           else { phase_mlstm_carry(P, l, smem, wv, (int)blockIdx.x - RSEQ_WGS, G_ - RSEQ_WGS); phase_gmlp_mix(P, l, smem, wv, (int)blockIdx.x - RSEQ_WGS, G_ - RSEQ_WGS);
                                                  if (MK_PROBE == 39) phase_gmlp_mix(P, l, smem, wv, (int)blockIdx.x - RSEQ_WGS, G_ - RSEQ_WGS); } }
                else { phase_rwkv_seq(P, l, smem, wv); phase_mlstm_carry(P, l, smem, wv, (int)blockIdx.x, G_); } });
        PH(4, { phase_rwkv_out(P, l, smem, wv); phase_mlstm_out(P, l, smem, wv); if ((int)gridDim.x < 2 * RSEQ_WGS) phase_gmlp_mix(P, l, smem, wv, (int)blockIdx.x, (int)gridDim.x); });
#else
        PH(2, { const int G_ = (int)gridDim.x, NSC = 2 * NB * RH * 4;
                if (G_ >= NSC + 32) { if ((int)blockIdx.x < NSC) phase_rwkv_scan(P, l, smem, wv, (int)blockIdx.x, NSC);
                                      else phase_mlstm_local(P, l, smem, wv, (int)blockIdx.x - NSC, G_ - NSC); }
                else { phase_rwkv_scan(P, l, smem, wv, (int)blockIdx.x, G_); phase_mlstm_local(P, l, smem, wv, (int)blockIdx.x, G_); } });
        PH(3, phase_mlstm_carry(P, l, smem, wv, (int)blockIdx.x, (int)gridDim.x));
        PH(4, { phase_mlstm_out(P, l, smem, wv); phase_gmlp_mix(P, l, smem, wv, (int)blockIdx.x, (int)gridDim.x); phase_rwkv_post(P, l, smem, wv); });
#endif
        PH(5, phase_outproj(P, l, smem, wv));
        PH(6, phase_ln1_router(P, l, smem, wv));
        PH(7, phase_scatter(P, l, smem, wv));
        PH(8, phase_moe_gemm<1>(P, l, smem, wv));
        PH(9, phase_moe_gemm<2>(P, l, smem, wv));
        PH(10, phase_combine_ln2(P, l, smem, wv));
    }
#undef PHG
#undef PH
#undef SEAM
}

}

#ifndef EMU
extern "C" void kernel_launch(void* const* d_in, const int* in_sizes, int n_in, void* d_out, int out_size, void* d_ws, size_t ws_size, hipStream_t stream) {
    using namespace mk;
    static int grid = 0;
    if (grid == 0) {
        if (n_in != 32 || out_size != T * D || ws_size < WS_END) { fprintf(stderr, "kernel_launch: unexpected shapes (n_in %d out %d ws %zu need %zu)\n", n_in, out_size, ws_size, (size_t)WS_END); grid = -1; return; }
        int dev = 0, cus = 0;
        if (hipGetDevice(&dev) != hipSuccess || hipDeviceGetAttribute(&cus, hipDeviceAttributeMultiprocessorCount, dev) != hipSuccess) { grid = -1; return; }
        if (hipFuncSetAttribute((const void*)mk_fwd, hipFuncAttributeMaxDynamicSharedMemorySize, LDS_BYTES) != hipSuccess) { fprintf(stderr, "kernel_launch: hipFuncSetAttribute failed\n"); grid = -1; return; }
        int per_cu = 0;
        (void)hipOccupancyMaxActiveBlocksPerMultiprocessor(&per_cu, (const void*)mk_fwd, NTHREADS, LDS_BYTES);
        (void)hipGetLastError();
        grid = cus;
    }
    if (grid < 0) return;
    (void)hipMemsetAsync(d_ws, 0, CTL_BYTES, stream);
    Params p{};
    for (int i = 0; i < 32; ++i) p.in[i] = (const float*)d_in[i];
    p.out = (float*)d_out; p.ws = (unsigned char*)d_ws;
#if MK_ONE_LAUNCH
    p.ph_lo = 0; p.ph_hi = 1 + NL * NPH;
    hipLaunchKernelGGL(mk_fwd, dim3(grid), dim3(NTHREADS), LDS_BYTES, stream, p);
#else
    for (int id = 0; id < 1 + NL * NPH; ++id) {
        p.ph_lo = id; p.ph_hi = id + 1;
        hipLaunchKernelGGL(mk_fwd, dim3(grid), dim3(NTHREADS), LDS_BYTES, stream, p);
    }
#endif
}
#endif
```

```cpp
#ifndef EMU
#include <hip/hip_runtime.h>
#endif
#include <cstdio>
#include <cstdint>
#include <cmath>

#ifndef CFG_BATCH
#define CFG_BATCH 4
#endif
#ifndef CFG_SEQ
#define CFG_SEQ 4096
#endif
#ifndef CFG_LAYERS
#define CFG_LAYERS 4
#endif
#ifndef MK_RWKV_CHUNKED
#define MK_RWKV_CHUNKED 1
#endif
#ifndef MK_PROBE
#define MK_PROBE 0
#endif
#ifndef MK_SP2
#define MK_SP2 1
#endif
#ifndef MK_ONE_LAUNCH
#define MK_ONE_LAUNCH 1
#endif

namespace mk {
constexpr int NB = CFG_BATCH, S = CFG_SEQ, T = NB * S, NL = CFG_LAYERS, D = 1024;
constexpr int GW = 256, RW = 384, MW = 384, HD = 64, GH = 4, RH = 6, MH = 6, CH = 128, NCH = S / CH;
constexpr int PIN = 3480, PLD = 3584, RPROJ = 1408;
constexpr int C_RW = 512, C_MW = 1920;
constexpr int NE = 32, TOPK = 4, DFF = 1024, MOEB = 256;
constexpr int NROWS = (T * TOPK / MOEB + NE) * MOEB;
constexpr float LN_EPS = 1e-5f, GN_EPS = 64e-5f;
constexpr float ALPHA = 1.6817928305074290f;
constexpr int NTHREADS = 512, NWAVES = 8;
constexpr int LDS_BYTES = 160 * 1024;
constexpr int NPH = 11;

typedef float f32x4 __attribute__((ext_vector_type(4)));
typedef unsigned u32x4 __attribute__((ext_vector_type(4)));
typedef unsigned u32x2 __attribute__((ext_vector_type(2)));
typedef short bf16x8 __attribute__((ext_vector_type(8)));
typedef unsigned short bf16_t;

constexpr size_t al(size_t x) { return (x + 255) & ~(size_t)255; }
constexpr size_t CTL_BYTES = 1u << 20;
constexpr size_t O_XA = CTL_BYTES;
constexpr size_t O_XB = O_XA + al((size_t)T * D * 4);
constexpr size_t O_X1 = O_XB + al((size_t)T * D * 2);
constexpr size_t O_X1B = O_X1 + al((size_t)T * D * 4);
constexpr size_t O_PROJ = O_X1B + al((size_t)T * D * 2);
constexpr size_t O_PROJG = O_PROJ + al((size_t)T * PLD * 2);
constexpr size_t O_MIX = O_PROJ + al((size_t)T * PLD * 4);
constexpr size_t O_GRP = O_MIX + al((size_t)T * D * 4);
constexpr size_t O_UG = O_GRP + al((size_t)T * D * 2);
constexpr size_t O_VN = O_UG + al((size_t)T * GW * 4);
constexpr size_t O_RR = O_VN + al((size_t)T * GW * 4);
constexpr size_t O_VV = O_RR + al((size_t)T * RW * 4);
constexpr size_t O_KK = O_VV + al((size_t)T * RW * 4);
constexpr size_t O_DEC = O_KK + al((size_t)T * RW * 4);
constexpr size_t O_KD = O_DEC + al((size_t)2 * T * RW * 4);
constexpr size_t O_ICLR = O_KD + al((size_t)2 * T * RW * 4);
constexpr size_t O_GATE = O_ICLR + al((size_t)2 * T * RW * 4);
constexpr size_t O_BONUS = O_GATE + al((size_t)T * RW * 4);
constexpr size_t O_SCAN = O_BONUS + al((size_t)T * RH * 4);
constexpr size_t O_MQ = O_SCAN + al((size_t)2 * T * RW * 4);
constexpr size_t O_MK = O_MQ + al((size_t)T * MW * 4);
constexpr size_t O_IG = O_MK + al((size_t)T * MW * 4);
constexpr size_t O_LF = O_IG + al((size_t)2 * T * MH * 4);
constexpr size_t O_CL = O_LF + al((size_t)2 * T * MH * 4);
constexpr size_t O_NL = O_CL + al((size_t)2 * NB * MH * NCH * 4096 * 4);
constexpr size_t O_ML = O_NL + al((size_t)2 * NB * MH * NCH * 64 * 4);
constexpr size_t O_BL = O_ML + al((size_t)2 * NB * MH * NCH * 4);
constexpr size_t O_MIN = O_BL + al((size_t)2 * NB * MH * NCH * 4);
constexpr size_t O_TOPI = O_MIN + al((size_t)2 * NB * MH * NCH * 4);
constexpr size_t O_TOPG = O_TOPI + al((size_t)T * 4 * 4);
constexpr size_t O_RANK = O_TOPG + al((size_t)T * 4 * 4);
constexpr size_t O_SLOT = O_RANK + al((size_t)T * 4 * 4);
constexpr size_t O_MQB = O_SLOT + al((size_t)T * 4 * 4);
constexpr size_t O_MKB = O_MQB + al((size_t)T * MW * 2);
constexpr size_t O_KT = O_MKB + al((size_t)T * MW * 2);
constexpr size_t O_VT = O_KT + al((size_t)T * MW * 2);
constexpr size_t O_GVT = O_VT + al((size_t)T * MW * 2);
constexpr size_t O_PMX = O_GVT + al((size_t)2 * T * MH * 4);
constexpr size_t O_BCT = O_PMX + al((size_t)2 * T * MH * 4);
constexpr size_t O_BRKR = O_BCT + al((size_t)2 * T * MH * 4);
constexpr int RC = 64, RNC = S / RC, RUN = 2 * NB * RH * RNC;
constexpr size_t O_LW = O_BRKR + al((size_t)2 * T * RH * 2 * 4);
constexpr size_t O_RQ = O_LW + al((size_t)2 * T * RW * 4);
constexpr size_t O_RA = O_RQ + al((size_t)RUN * 4096 * 2);
constexpr size_t O_RS = O_RA + al((size_t)RUN * 4096 * 2);
constexpr size_t O_RH = O_RS + al((size_t)RUN * 4096 * 2);
constexpr size_t O_RG = O_RH + al((size_t)RUN * 4096 * 4);
constexpr size_t O_RB = O_RG + al((size_t)RUN * 4096 * 4);
constexpr size_t O_VB = O_RB + al((size_t)T * RW * 2);
constexpr size_t O_KKB = O_VB + al((size_t)T * RW * 2);
constexpr size_t O_BBB = O_KKB + al((size_t)T * RW * 2);
constexpr size_t O_KDB = O_BBB + al((size_t)2 * T * RW * 2);
constexpr size_t O_RK7 = O_KDB + al((size_t)2 * T * RW * 2);
constexpr size_t O_VNT = O_RK7 + al((size_t)T * RW * 16);
constexpr size_t O_WSB = O_VNT + al((size_t)T * GW * 2);
constexpr size_t O_LWT = O_WSB + al((size_t)NL * GH * CH * CH * 2);
constexpr size_t O_RWT = O_LWT + al((size_t)NL * 1920 * 128 * 2);
constexpr size_t O_BCNT = O_RWT + al((size_t)NL * 2 * NE * D * 2);
constexpr size_t O_CNTF = O_BCNT + al((size_t)(T / 64) * NE * 4);
constexpr size_t O_ROWT = O_CNTF + al((size_t)NE * 4);
constexpr size_t O_XS = O_ROWT + al((size_t)NROWS * 4);
constexpr size_t O_ACT = O_XS + al((size_t)NROWS * D * 2);
constexpr size_t O_YS = O_ACT + al((size_t)NROWS * DFF * 2);
constexpr size_t O_WIN = O_YS + al((size_t)NROWS * D * 2);
constexpr size_t O_WOUT = O_WIN + al((size_t)NL * PLD * D * 2);
constexpr size_t O_W1 = O_WOUT + al((size_t)NL * D * D * 2);
constexpr size_t O_W2 = O_W1 + al((size_t)NL * NE * 2 * DFF * D * 2);
constexpr size_t WS_END = O_W2 + al((size_t)NL * NE * D * DFF * 2);

constexpr int CW_BAR = 4096;
constexpr int CW_CNT = 16384;

struct Params { const float* in[32]; float* out; unsigned char* ws; int ph_lo, ph_hi; };
#ifdef EMU
typedef const Params* ParamsPtr;
#define PARAMS_PTR(P) (&(P))
#else
typedef const __attribute__((address_space(4))) Params* ParamsPtr;
#define PARAMS_PTR(P) ((ParamsPtr)__builtin_amdgcn_kernarg_segment_ptr())
#endif

#ifdef EMU
#define WAVE_SYNC() emu_wave_barrier()
#define PIN_V(x) do {} while (0)
#define PIN_S(x) do {} while (0)
#else
#define WAVE_SYNC() __builtin_amdgcn_wave_barrier()
#define PIN_V(x) asm volatile("" : "+v"(x))
#define PIN_S(x) asm volatile("" : "+s"(x))
#endif
#ifdef EMU
__device__ __forceinline__ int phase_tid(int wv) { (void)wv; return threadIdx.x; }
#else
__device__ __forceinline__ int phase_tid(int wv) { int t; asm volatile("v_mbcnt_lo_u32_b32 %0, -1, 0\n\tv_mbcnt_hi_u32_b32 %0, -1, %0" : "=v"(t)); return (wv << 6) + t; }
#endif

#ifdef EMU
#define SHX(v, m, lane) __shfl_xor(v, m)
#else
__device__ __forceinline__ float shx_(float v, int m, int lane) { return __builtin_bit_cast(float, __builtin_amdgcn_ds_bpermute((lane ^ m) << 2, __builtin_bit_cast(int, v))); }
__device__ __forceinline__ int shx_(int v, int m, int lane) { return __builtin_amdgcn_ds_bpermute((lane ^ m) << 2, v); }
#define SHX(v, m, lane) shx_(v, m, lane)
#endif
#ifdef EMU
#define SHUP(v, o, lane) __shfl(v, ((lane) - (o)) & 63)
#define RDL(v, src) __shfl(v, src)
#define SHL(v, src) __shfl(v, src)
#else
#define SHL(v, src) __builtin_bit_cast(float, __builtin_amdgcn_ds_bpermute((src) << 2, __builtin_bit_cast(int, (float)(v))))
#define SHUP(v, o, lane) __builtin_bit_cast(float, __builtin_amdgcn_ds_bpermute((((lane) - (o)) & 63) << 2, __builtin_bit_cast(int, (float)(v))))
#define RDL(v, src) __builtin_bit_cast(float, __builtin_amdgcn_readlane(__builtin_bit_cast(int, (float)(v)), src))
#endif
__device__ __forceinline__ float wave_sum(float v, int lane) {
#pragma unroll
    for (int o = 32; o >= 1; o >>= 1) v += SHX(v, o, lane);
    return v;
}
#ifdef EMU
__device__ __forceinline__ float fexp(float x) { return expf(x); }
__device__ __forceinline__ float flog(float x) { return logf(x); }
__device__ __forceinline__ float frcp(float x) { return 1.0f / x; }
#else
__device__ __forceinline__ float fexp(float x) { return __builtin_amdgcn_exp2f(x * 1.4426950408889634f); }
__device__ __forceinline__ float flog(float x) { return __builtin_amdgcn_logf(x) * 0.6931471805599453f; }
__device__ __forceinline__ float frcp(float x) { return __builtin_amdgcn_rcpf(x); }
#endif
__device__ __forceinline__ float sigmoidf_(float x) { return frcp(1.0f + fexp(-x)); }
__device__ __forceinline__ float softplusf_(float x) { return fmaxf(x, 0.f) + flog(1.0f + fexp(-fabsf(x))); }
__device__ __forceinline__ float ftanh(float x) { return 1.0f - 2.0f * frcp(1.0f + fexp(2.0f * x)); }
__device__ __forceinline__ float geluf_(float v) {
    const float av = fabsf(v), t = frcp(1.0f + 0.2316418882f * av);
    float q = t * 0.5307027145f + (-0.7265760135f); q = q * t + 0.7107068705f; q = q * t + (-0.142248368f); q = q * t + 0.127414796f; q = q * t;
    const float m = v * (q * fexp(-0.5f * v * v));
    return v < 0.f ? m : v - m;
}

#ifdef EMU
#define LAS
#define WAIT_V(n) do {} while (0)
#define WAIT_L(n) do {} while (0)
#define S_BARRIER() __syncthreads()
#define SETPRIO(x) do {} while (0)
#define SCHED_BAR() do {} while (0)
#define RFL(x) (x)
static inline void emu_glds16(const void* g, void* l) { memcpy((char*)l + (g_blk->cur & 63) * 16, g, 16); }
#define GLDS16(gptr, ldsptr) emu_glds16((const void*)(gptr), (void*)(ldsptr))
static inline float emu_bf2f(unsigned short b) { unsigned u = (unsigned)b << 16; float f; memcpy(&f, &u, 4); return f; }
static inline f32x4 emu_mfma16(bf16x8 a, bf16x8 b, f32x4 c) {
    EmuBlock* blk = g_blk; const int cur = blk->cur, lane = cur & 63, wbase = cur & ~63;
    static thread_local unsigned short Ash[32][64][8], Bsh[32][64][8];
    const int w = cur >> 6;
    for (int j = 0; j < 8; ++j) { Ash[w][lane][j] = (unsigned short)a[j]; Bsh[w][lane][j] = (unsigned short)b[j]; }
    emu_wave_barrier();
    const int col = lane & 15;
    for (int r = 0; r < 4; ++r) { const int row = 4 * (lane >> 4) + r; float sum = c[r];
        for (int k = 0; k < 32; ++k) sum += emu_bf2f(Ash[w][row + 16 * (k >> 3)][k & 7]) * emu_bf2f(Bsh[w][col + 16 * (k >> 3)][k & 7]);
        c[r] = sum; }
    emu_wave_barrier(); (void)wbase;
    return c;
}
#define MFMA16(a, b, c) emu_mfma16(a, b, c)
#else
#define LAS __attribute__((address_space(3)))
#define WAIT_V(n) asm volatile("s_waitcnt vmcnt(" #n ")" ::: "memory")
#define WAIT_L(n) asm volatile("s_waitcnt lgkmcnt(" #n ")" ::: "memory")
#define S_BARRIER() __builtin_amdgcn_s_barrier()
#define SETPRIO(x) __builtin_amdgcn_s_setprio(x)
#define SCHED_BAR() __builtin_amdgcn_sched_barrier(0)
#define RFL(x) __builtin_amdgcn_readfirstlane(x)
#define GLDS16(gptr, ldsptr) __builtin_amdgcn_global_load_lds((const unsigned*)(gptr), (LAS unsigned*)(ldsptr), 16, 0, 0)
#define MFMA16(a, b, c) __builtin_amdgcn_mfma_f32_16x16x32_bf16(a, b, c, 0, 0, 0)
#endif

#ifdef EMU
__device__ __forceinline__ unsigned f2bf(float f) { unsigned u = __builtin_bit_cast(unsigned, f); return (u + 0x7fffu + ((u >> 16) & 1u)) >> 16; }
#else
__device__ __forceinline__ unsigned f2bf(float f) { return (unsigned)__builtin_bit_cast(unsigned short, (__bf16)f); }
#endif
#ifdef EMU
__device__ __forceinline__ unsigned pk2(float lo, float hi) { return f2bf(lo) | (f2bf(hi) << 16); }
#else
typedef float f32x2c __attribute__((ext_vector_type(2)));
typedef __bf16 bf16x2c __attribute__((ext_vector_type(2)));
__device__ __forceinline__ unsigned pk2(float lo, float hi) { const f32x2c v = {lo, hi}; return __builtin_bit_cast(unsigned, __builtin_convertvector(v, bf16x2c)); }
#endif
__device__ __forceinline__ bf16x8 cvt8(const f32x4 a, const f32x4 b) {
    u32x4 w; w.x = pk2(a.x, a.y); w.y = pk2(a.z, a.w); w.z = pk2(b.x, b.y); w.w = pk2(b.z, b.w); return __builtin_bit_cast(bf16x8, w);
}
__device__ __forceinline__ float bf_lo(unsigned u) { return __builtin_bit_cast(float, u << 16); }
__device__ __forceinline__ float bf_hi(unsigned u) { return __builtin_bit_cast(float, u & 0xffff0000u); }

namespace pg8 {
constexpr int BM = 256, BK = 64, HALF = 128, HTB = HALF * BK * 2, STAGE_BYTES = 8 * HTB, NXCD = 8, WGM = 8;
__host__ __device__ __forceinline__ int lds_byte(int r, int c) { const int st = (r >> 4) * 2 + (c >> 5), rr = r & 15, cc = c & 31, ob = rr * 64 + cc * 2; return st * 1024 + (ob ^ (((ob >> 9) & 1) << 5)); }
__host__ __device__ __forceinline__ void stage_rc(int b, int& R, int& C) { const int st = b / 1024, sb = b % 1024, swz = sb ^ (((sb >> 9) & 1) << 5); R = (st >> 1) * 16 + swz / 64; C = (st & 1) * 32 + (swz % 64) / 2; }
__host__ __device__ __forceinline__ int perm32(int rho) { const int n = rho >> 4, i = rho & 15; return 8 * (i >> 2) + 4 * n + (i & 3); }
struct Unit { int pm, pn, e; };

struct DenseOrder {
    static constexpr bool GATHER = false;
    const char* A; const char* Bt; int K; int nM, nN, nwg, G, c;
    __device__ __forceinline__ void init(const void* A_, const void* Bt_, int M, int N, int K_, int G_, int c_) { A = (const char*)A_; Bt = (const char*)Bt_; K = K_; nM = M / BM; nN = N / BM; nwg = nM * nN; G = G_; c = c_; }
    __device__ __forceinline__ bool next(int i, Unit& u) const {
        const long L = (long)i * G + c; if (L >= nwg) return false;
        int wgid = (int)L; { const int q = nwg / NXCD, r = nwg % NXCD, xcd = wgid % NXCD, off = wgid / NXCD; wgid = (xcd < r ? xcd * (q + 1) : r * (q + 1) + (xcd - r) * q) + off; }
        const int nig = WGM * nN, gid = wgid / nig, fm = gid * WGM, gsz = (nM - fm) < WGM ? (nM - fm) : WGM;
        u.pm = fm + ((wgid % nig) % gsz); u.pn = (wgid % nig) / gsz; u.e = 0; return true;
    }
    __device__ __forceinline__ const char* abase(const Unit& u) const { return A + (size_t)u.pm * BM * K * 2; }
    __device__ __forceinline__ const char* bbase(const Unit& u) const { return Bt + (size_t)u.pn * BM * K * 2; }
};
template <bool G>
struct MoeOrderT {
    static constexpr bool GATHER = G;
    const char* A; const char* Wt; int K; int nN, nwg, G_, c; size_t estride; const int* rbe; const int* rowmap;
    __device__ __forceinline__ bool next(int i, Unit& u) const {
        const long L = (long)i * G_ + c; if (L >= nwg) return false;
        u.pm = (int)(L / nN); u.pn = (int)(L % nN); u.e = rbe[u.pm]; return true;
    }
    __device__ __forceinline__ const char* abase(const Unit& u) const { return G ? A : A + (size_t)u.pm * BM * K * 2; }
    __device__ __forceinline__ const char* bbase(const Unit& u) const { return Wt + (size_t)u.e * estride + (size_t)u.pn * BM * K * 2; }
};
struct EpiF32 {
    static constexpr bool PERM = false;
    float* C; int ldc;
    __device__ __forceinline__ void operator()(const f32x4 (&acc)[2][2][4][2], const Unit& u, int wr, int wc, int fr, int fq) const {
        const int row0 = u.pm * BM + wr * 64 + fr, col0 = u.pn * BM + wc * 32 + 4 * fq;
#pragma unroll
        for (int ai = 0; ai < 2; ++ai)
#pragma unroll
            for (int m = 0; m < 4; ++m) { float* rowp = C + (size_t)(row0 + ai * HALF + m * 16) * ldc + col0;
#pragma unroll
                for (int bj = 0; bj < 2; ++bj)
#pragma unroll
                    for (int n = 0; n < 2; ++n) *(f32x4*)(rowp + bj * HALF + n * 16) = acc[ai][bj][m][n]; }
    }
};
struct EpiProj {
    static constexpr bool PERM = true;
    bf16_t* O; int ldc; float* G; int lastt;
    __device__ __forceinline__ void operator()(const f32x4 (&acc)[2][2][4][2], const Unit& u, int wr, int wc, int fr, int fq) const {
        const int row0 = u.pm * BM + wr * 64 + fr, col0 = u.pn * BM + wc * 32 + 8 * fq;
#pragma unroll
        for (int ai = 0; ai < 2; ++ai)
#pragma unroll
            for (int m = 0; m < 4; ++m) { bf16_t* rowp = O + (size_t)(row0 + ai * HALF + m * 16) * ldc + col0;
#pragma unroll
                for (int bj = 0; bj < 2; ++bj) { const f32x4 v0 = acc[ai][bj][m][0], v1 = acc[ai][bj][m][1];
                    u32x4 w; w.x = pk2(v0[0], v0[1]); w.y = pk2(v0[2], v0[3]); w.z = pk2(v1[0], v1[1]); w.w = pk2(v1[2], v1[3]);
                    *(u32x4*)(rowp + bj * HALF) = w; } }
        if (u.pn == lastt) {
#pragma unroll
            for (int ai = 0; ai < 2; ++ai)
#pragma unroll
                for (int m = 0; m < 4; ++m) { float* rowp = G + (size_t)(row0 + ai * HALF + m * 16) * BM + wc * 32 + 8 * fq;
#pragma unroll
                    for (int bj = 0; bj < 2; ++bj) { *(f32x4*)(rowp + bj * HALF) = acc[ai][bj][m][0]; *(f32x4*)(rowp + bj * HALF + 4) = acc[ai][bj][m][1]; } }
        }
    }
};
struct EpiBf16Bias {
    static constexpr bool PERM = true;
    bf16_t* O; int ldc; const float* bias; int bias_estride;
    __device__ __forceinline__ void operator()(const f32x4 (&acc)[2][2][4][2], const Unit& u, int wr, int wc, int fr, int fq) const {
        const int row0 = u.pm * BM + wr * 64 + fr, col0 = u.pn * BM + wc * 32 + 8 * fq;
        const float* bp = bias + (size_t)u.e * bias_estride + col0;
        f32x4 bv[2][2];
#pragma unroll
        for (int bj = 0; bj < 2; ++bj)
#pragma unroll
            for (int n = 0; n < 2; ++n) bv[bj][n] = *(const f32x4*)(bp + bj * HALF + 4 * n);
#pragma unroll
        for (int ai = 0; ai < 2; ++ai)
#pragma unroll
            for (int m = 0; m < 4; ++m) { bf16_t* rowp = O + (size_t)(row0 + ai * HALF + m * 16) * ldc + col0;
#pragma unroll
                for (int bj = 0; bj < 2; ++bj) { const f32x4 v0 = acc[ai][bj][m][0] + bv[bj][0], v1 = acc[ai][bj][m][1] + bv[bj][1];
                    u32x4 w; w.x = pk2(v0[0], v0[1]); w.y = pk2(v0[2], v0[3]); w.z = pk2(v1[0], v1[1]); w.w = pk2(v1[2], v1[3]);
                    *(u32x4*)(rowp + bj * HALF) = w; } }
    }
};
__device__ __forceinline__ float swiglu1(float g, float uu) { g = fminf(g, 7.0f); uu = fminf(fmaxf(uu, -7.0f), 7.0f); return (uu + 1.0f) * (g * frcp(1.0f + fexp(-1.702f * g))); }
struct EpiSwiglu {
    static constexpr bool PERM = true;
    bf16_t* O; const float* b1;
    __device__ __forceinline__ void operator()(const f32x4 (&acc)[2][2][4][2], const Unit& u, int wr, int wc, int fr, int fq) const {
        const int row0 = u.pm * BM + wr * 64 + fr, j0 = u.pn * HALF + wc * 32 + 8 * fq;
        const float* bg = b1 + (size_t)u.e * 2 * DFF + j0; const float* bu = bg + DFF;
        f32x4 g4[2], u4[2];
#pragma unroll
        for (int n = 0; n < 2; ++n) { g4[n] = *(const f32x4*)(bg + 4 * n); u4[n] = *(const f32x4*)(bu + 4 * n); }
#pragma unroll
        for (int ai = 0; ai < 2; ++ai)
#pragma unroll
            for (int m = 0; m < 4; ++m) {
                float o[8];
#pragma unroll
                for (int n = 0; n < 2; ++n)
#pragma unroll
                    for (int q = 0; q < 4; ++q) o[n * 4 + q] = swiglu1(acc[ai][0][m][n][q] + g4[n][q], acc[ai][1][m][n][q] + u4[n][q]);
                u32x4 w; w.x = pk2(o[0], o[1]); w.y = pk2(o[2], o[3]); w.z = pk2(o[4], o[5]); w.w = pk2(o[6], o[7]);
                *(u32x4*)(O + (size_t)(row0 + ai * HALF + m * 16) * DFF + j0) = w;
            }
    }
};

template <class Epi, class Sched, bool SP2 = (MK_SP2 != 0)>
__device__ __forceinline__ void gemm_phase(LAS unsigned char* lds, const int K, const Sched& S, const Epi& E, const int tid) {
    const int wid = RFL(tid >> 6), lane = tid & 63, wr = wid >> 2, wc = wid & 3, fr = lane & 15, fq = lane >> 4;
    const int nt = K / BK;
    unsigned voffA[2], voffB[2]; int gR[2]; unsigned gC[2];
#pragma unroll
    for (int i = 0; i < 2; ++i) { int R, C; stage_rc(tid * 16 + i * 8192, R, C); const int Rb = Epi::PERM ? ((R & ~31) + perm32(R & 31)) : R;
        voffA[i] = (unsigned)(R * K + C) * 2u; voffB[i] = (unsigned)(Rb * K + C) * 2u; gR[i] = R; gC[i] = (unsigned)C * 2u; }
    unsigned va[2][2], vn[2][2];
#define PG8_GOFF(dst, unit) do { if constexpr (Sched::GATHER) { _Pragma("unroll") for (int h_ = 0; h_ < 2; ++h_) _Pragma("unroll") for (int i_ = 0; i_ < 2; ++i_) \
        dst[h_][i_] = (unsigned)S.rowmap[(unit).pm * BM + h_ * HALF + gR[i_]] * (unsigned)(K * 2) + gC[i_]; } } while (0)
#define PG8_STAGE_A(bufoff, bp, kb, h, nx) do { if constexpr (Sched::GATHER) { const char* gb_ = S.A + (kb); _Pragma("unroll") for (int _i = 0; _i < 2; ++_i) \
        GLDS16(gb_ + ((nx) ? vn[h][_i] : va[h][_i]), lds + (bufoff) + ldsw + _i * 8192); } else { PG8_STAGE(bufoff, bp, voffA); } } while (0)
    const size_t kstep = (size_t)(BK * 2);
    const size_t hstep = (size_t)HALF * K * 2;
    const unsigned ldsw = (unsigned)wid * 1024u;
    const int aoff = lds_byte(wr * 64 + fr, fq * 8), boff = lds_byte(wc * 32 + fr, fq * 8);
#define PG8_SA(b, h) (((b) * 2 + (h)) * HTB)
#define PG8_SB(b, h) ((4 + (b) * 2 + (h)) * HTB)
#define PG8_STAGE(bufoff, gbase, voff) do { _Pragma("unroll") for (int _i = 0; _i < 2; ++_i) \
        GLDS16((const char*)(gbase) + (voff)[_i], lds + (bufoff) + ldsw + _i * 8192); } while (0)
#define PG8_LDA(dst, b, h) do { _Pragma("unroll") for (int m = 0; m < 4; ++m) _Pragma("unroll") for (int k = 0; k < 2; ++k) dst[m][k] = *(const LAS bf16x8*)(lds + PG8_SA(b, h) + aoff + m * 2048 + k * 1024); } while (0)
#define PG8_LDB(dst, b, h) do { _Pragma("unroll") for (int n = 0; n < 2; ++n) _Pragma("unroll") for (int k = 0; k < 2; ++k) dst[n][k] = *(const LAS bf16x8*)(lds + PG8_SB(b, h) + boff + n * 2048 + k * 1024); } while (0)
#define PG8_MMA(ai, bj, At, Bt) do { SETPRIO(1); _Pragma("unroll") for (int m = 0; m < 4; ++m) _Pragma("unroll") for (int n = 0; n < 2; ++n) _Pragma("unroll") for (int k = 0; k < 2; ++k) \
        acc[ai][bj][m][n] = MFMA16(Bt[n][k], At[m][k], acc[ai][bj][m][n]); SETPRIO(0); } while (0)
    Unit cur, nxt; int ui = 0;
    if (!S.next(0, cur)) return;
    f32x4 acc[2][2][4][2];
#pragma unroll
    for (int a = 0; a < 2; ++a)
#pragma unroll
        for (int b = 0; b < 2; ++b)
#pragma unroll
            for (int m = 0; m < 4; ++m)
#pragma unroll
                for (int n = 0; n < 2; ++n) acc[a][b][m][n] = (f32x4){0.f, 0.f, 0.f, 0.f};
    bf16x8 At[4][2], B0[2][2], B1[2][2];
    const char* cA = S.abase(cur); const char* cB = S.bbase(cur);
    PG8_GOFF(va, cur);
    if constexpr (SP2) {
        PG8_STAGE(PG8_SB(0, 0), cB, voffB); PG8_STAGE(PG8_SB(0, 1), cB + hstep, voffB); PG8_STAGE_A(PG8_SA(0, 0), cA, 0, 0, false); PG8_STAGE_A(PG8_SA(0, 1), cA + hstep, 0, 1, false);
        if (wr == 1) S_BARRIER();
        WAIT_V(2); S_BARRIER();
        PG8_STAGE(PG8_SB(1, 0), cB + kstep, voffB); PG8_STAGE_A(PG8_SA(1, 0), cA + kstep, kstep, 0, false); PG8_STAGE(PG8_SB(1, 1), cB + hstep + kstep, voffB);
        WAIT_V(6); S_BARRIER();
    } else {
    PG8_STAGE(PG8_SB(0, 0), cB, voffB); PG8_STAGE_A(PG8_SA(0, 0), cA, 0, 0, false); PG8_STAGE(PG8_SB(0, 1), cB + hstep, voffB); PG8_STAGE_A(PG8_SA(0, 1), cA + hstep, 0, 1, false);
    if (wr == 1) S_BARRIER();
    WAIT_V(4); S_BARRIER();
    PG8_STAGE(PG8_SB(1, 0), cB + kstep, voffB); PG8_STAGE_A(PG8_SA(1, 0), cA + kstep, kstep, 0, false); PG8_STAGE(PG8_SB(1, 1), cB + hstep + kstep, voffB);
    WAIT_V(6); S_BARRIER();
    }
    for (;;) {
        const bool has_next = S.next(ui + 1, nxt);
        const char* nA = has_next ? S.abase(nxt) : cA; const char* nB = has_next ? S.bbase(nxt) : cB;
        if constexpr (Sched::GATHER) { if (has_next) { PG8_GOFF(vn, nxt); } else {
#pragma unroll
            for (int h_ = 0; h_ < 2; ++h_) { vn[h_][0] = va[h_][0]; vn[h_][1] = va[h_][1]; } } }
        for (int t = 0; t < nt; t += 2) {
            const bool last = (t == nt - 2);
            const char* a1 = cA + (size_t)(t + 1) * kstep;
            const char* a2 = last ? nA : cA + (size_t)(t + 2) * kstep; const char* b2 = last ? nB : cB + (size_t)(t + 2) * kstep;
            const char* a3 = a2 + kstep; const char* b3 = b2 + kstep;
            if constexpr (SP2) {
            PG8_LDB(B0, 0, 0); PG8_LDB(B1, 0, 1); SCHED_BAR(); PG8_LDA(At, 0, 0); PG8_STAGE_A(PG8_SA(1, 1), a1 + hstep, (size_t)(t + 1) * kstep, 1, false);
            WAIT_V(8); WAIT_L(0); S_BARRIER(); PG8_MMA(0, 0, At, B0); PG8_MMA(0, 1, At, B1); S_BARRIER(); SCHED_BAR();
            PG8_LDA(At, 0, 1); PG8_STAGE(PG8_SB(0, 0), b2, voffB); PG8_STAGE(PG8_SB(0, 1), b2 + hstep, voffB); PG8_STAGE_A(PG8_SA(0, 0), a2, (last ? (size_t)0 : (size_t)(t + 2) * kstep), 0, last);
            WAIT_V(8); WAIT_L(0); S_BARRIER(); PG8_MMA(1, 0, At, B0); PG8_MMA(1, 1, At, B1); S_BARRIER(); SCHED_BAR();
            PG8_LDB(B0, 1, 0); PG8_LDB(B1, 1, 1); SCHED_BAR(); PG8_LDA(At, 1, 0); PG8_STAGE_A(PG8_SA(0, 1), a2 + hstep, (last ? (size_t)0 : (size_t)(t + 2) * kstep), 1, last);
            WAIT_V(8); WAIT_L(0); S_BARRIER(); PG8_MMA(0, 0, At, B0); PG8_MMA(0, 1, At, B1); S_BARRIER(); SCHED_BAR();
            PG8_LDA(At, 1, 1); PG8_STAGE(PG8_SB(1, 0), b3, voffB); PG8_STAGE(PG8_SB(1, 1), b3 + hstep, voffB); PG8_STAGE_A(PG8_SA(1, 0), a3, (last ? kstep : (size_t)(t + 3) * kstep), 0, last);
            WAIT_V(8); WAIT_L(0); S_BARRIER(); PG8_MMA(1, 0, At, B0); PG8_MMA(1, 1, At, B1); S_BARRIER(); SCHED_BAR();
            } else {
            PG8_LDB(B0, 0, 0); SCHED_BAR(); PG8_LDA(At, 0, 0); PG8_STAGE_A(PG8_SA(1, 1), a1 + hstep, (size_t)(t + 1) * kstep, 1, false);
            WAIT_L(8); S_BARRIER(); WAIT_L(0); PG8_MMA(0, 0, At, B0); S_BARRIER(); SCHED_BAR();
            PG8_LDB(B1, 0, 1); PG8_STAGE(PG8_SB(0, 0), b2, voffB);
            S_BARRIER(); WAIT_L(0); PG8_MMA(0, 1, At, B1); S_BARRIER();
            PG8_LDA(At, 0, 1); PG8_STAGE_A(PG8_SA(0, 0), a2, (last ? (size_t)0 : (size_t)(t + 2) * kstep), 0, last);
            S_BARRIER(); WAIT_L(0); PG8_MMA(1, 0, At, B0); S_BARRIER(); SCHED_BAR();
            PG8_STAGE(PG8_SB(0, 1), b2 + hstep, voffB);
            WAIT_V(6); S_BARRIER(); PG8_MMA(1, 1, At, B1); S_BARRIER();
            PG8_LDB(B0, 1, 0); SCHED_BAR(); PG8_LDA(At, 1, 0); PG8_STAGE_A(PG8_SA(0, 1), a2 + hstep, (last ? (size_t)0 : (size_t)(t + 2) * kstep), 1, last);
            WAIT_L(8); S_BARRIER(); WAIT_L(0); PG8_MMA(0, 0, At, B0); S_BARRIER(); SCHED_BAR();
            PG8_LDB(B1, 1, 1); PG8_STAGE(PG8_SB(1, 0), b3, voffB);
            S_BARRIER(); WAIT_L(0); PG8_MMA(0, 1, At, B1); S_BARRIER();
            PG8_LDA(At, 1, 1); PG8_STAGE_A(PG8_SA(1, 0), a3, (last ? kstep : (size_t)(t + 3) * kstep), 0, last);
            S_BARRIER(); WAIT_L(0); PG8_MMA(1, 0, At, B0); S_BARRIER(); SCHED_BAR();
            PG8_STAGE(PG8_SB(1, 1), b3 + hstep, voffB);
            WAIT_V(6); S_BARRIER(); PG8_MMA(1, 1, At, B1); S_BARRIER();
            }
        }
        if (wr == 0) S_BARRIER();
        E(acc, cur, wr, wc, fr, fq);
        if (!has_next) break;
#pragma unroll
        for (int a = 0; a < 2; ++a)
#pragma unroll
            for (int b = 0; b < 2; ++b)
#pragma unroll
                for (int m = 0; m < 4; ++m)
#pragma unroll
                    for (int n = 0; n < 2; ++n) acc[a][b][m][n] = (f32x4){0.f, 0.f, 0.f, 0.f};
        cur = nxt; cA = nA; cB = nB; ++ui;
        if constexpr (Sched::GATHER) {
#pragma unroll
            for (int h_ = 0; h_ < 2; ++h_) { va[h_][0] = vn[h_][0]; va[h_][1] = vn[h_][1]; } }
        if (wr == 1) S_BARRIER();
    }
    WAIT_V(0);
    S_BARRIER();
#undef PG8_SA
#undef PG8_SB
#undef PG8_STAGE
#undef PG8_STAGE_A
#undef PG8_GOFF
#undef PG8_LDA
#undef PG8_LDB
#undef PG8_MMA
}
}

__device__ __forceinline__ float row16_sum(float x) {
#ifdef EMU
    x += __shfl_xor(x, 1); x += __shfl_xor(x, 2); x += __shfl_xor(x, 4); x += __shfl_xor(x, 8); return x;
#else
#define DPPF(v, ctrl) __builtin_bit_cast(float, __builtin_amdgcn_update_dpp(0, __builtin_bit_cast(int, (v)), (ctrl), 0xF, 0xF, false))
    x += DPPF(x, 0xB1); x += DPPF(x, 0x4E); x += DPPF(x, 0x141); x += DPPF(x, 0x140); return x;
#undef DPPF
#endif
}
__device__ __forceinline__ float row32_sum(float x) {
    x = row16_sum(x);
#ifdef EMU
    x += __shfl_xor(x, 32); return x;
#else
    float a = x, b = x;
    asm volatile("s_nop 1\n\tv_permlane32_swap_b32 %0, %1" : "+v"(a), "+v"(b));
    return a + b;
#endif
}
__device__ __forceinline__ float wave_sum_fast(float x, int lane) {
    x = row32_sum(x);
    x += SHX(x, 16, lane);
    return x;
}
__device__ __forceinline__ void transpose_item(const float* W, int K, int N, bf16_t* WT, int k0, int n0, int dst_row0, float* scr, int lane) {
    const int n4 = (lane & 15) * 4, kr = lane >> 4;
#pragma unroll 8
    for (int i = 0; i < 16; ++i) {
        const int kk = 4 * i + kr;
        f32x4 v = (f32x4){0.f, 0.f, 0.f, 0.f};
        if (n0 + n4 < N) v = *(const f32x4*)(W + (size_t)(k0 + kk) * N + n0 + n4);
        float* d = scr + kk * 65 + n4; d[0] = v.x; d[1] = v.y; d[2] = v.z; d[3] = v.w;
    }
    WAVE_SYNC();
    const int c = lane & 7;
#pragma unroll
    for (int j = 0; j < 8; ++j) { const int n = (lane >> 3) + 8 * j; const float* sp = scr + (8 * c) * 65 + n;
        u32x4 o; o.x = pk2(sp[0 * 65], sp[1 * 65]); o.y = pk2(sp[2 * 65], sp[3 * 65]); o.z = pk2(sp[4 * 65], sp[5 * 65]); o.w = pk2(sp[6 * 65], sp[7 * 65]);
        *(u32x4*)(WT + (size_t)(dst_row0 + n) * K + k0 + 8 * c) = o; }
    WAVE_SYNC();
}
__device__ __forceinline__ void phase_prologue(const Params& P, unsigned char* smem, int wv) {
    ParamsPtr pp = PARAMS_PTR(P); PIN_S(pp); unsigned char* ws = pp->ws; int bidx = (int)blockIdx.x, gdim = (int)gridDim.x; PIN_S(bidx); PIN_S(gdim);
    const int tid = phase_tid(wv), lane = tid & 63, wave = tid >> 6;
    float* scr = (float*)smem + wave * (64 * 65);
    const int gw = bidx * NWAVES + wave, ngw = NWAVES * gdim;
    constexpr int I_IN = 16 * (PLD / 64), I_OUT = 16 * 16, I_W1 = NE * 16 * 32, I_W2 = NE * 16 * 16, I_L = I_IN + I_OUT + I_W1 + I_W2;
    for (int it = gw; it < NL * I_L; it += ngw) {
        const int l = it / I_L; int r = it % I_L;
        if (r < I_IN) { const int kb = r / (PLD / 64), nb = r % (PLD / 64);
            transpose_item(pp->in[1] + (size_t)l * D * PIN, D, PIN, (bf16_t*)(ws + O_WIN) + (size_t)l * PLD * D, kb * 64, nb * 64, nb * 64, scr, lane); continue; }
        r -= I_IN;
        if (r < I_OUT) { const int kb = r / 16, nb = r % 16;
            transpose_item(pp->in[21] + (size_t)l * D * D, D, D, (bf16_t*)(ws + O_WOUT) + (size_t)l * D * D, kb * 64, nb * 64, nb * 64, scr, lane); continue; }
        r -= I_OUT;
        if (r < I_W1) { const int e = r / (16 * 32), q = r % (16 * 32), kb = q / 32, nb = q % 32, n0 = nb * 64;
            const int dst = n0 < DFF ? (n0 / 128) * 256 + (n0 % 128) : ((n0 - DFF) / 128) * 256 + 128 + ((n0 - DFF) % 128);
            transpose_item(pp->in[26] + ((size_t)l * NE + e) * D * 2 * DFF, D, 2 * DFF, (bf16_t*)(ws + O_W1) + ((size_t)l * NE + e) * 2 * DFF * D, kb * 64, n0, dst, scr, lane); continue; }
        r -= I_W1;
        { const int e = r / (16 * 16), q = r % (16 * 16), kb = q / 16, nb = q % 16;
            transpose_item(pp->in[28] + ((size_t)l * NE + e) * DFF * D, DFF, D, (bf16_t*)(ws + O_W2) + ((size_t)l * NE + e) * D * DFF, kb * 64, nb * 64, nb * 64, scr, lane); }
    }
    {
        const float* gw_ = pp->in[4]; bf16_t* WSB = (bf16_t*)(ws + O_WSB);
        for (size_t i = ((size_t)bidx * NTHREADS + tid) * 4; i < (size_t)NL * GH * CH * CH; i += (size_t)gdim * NTHREADS * 4) {
            const f32x4 v = *(const f32x4*)(gw_ + i); u32x2 o; o.x = pk2(v.x, v.y); o.y = pk2(v.z, v.w); *(u32x2*)(WSB + i) = o;
        }
    }
    {
        bf16_t* LWT = (bf16_t*)(ws + O_LWT);
        for (int i = bidx * NTHREADS + tid; i < NL * 1920 * 128; i += gdim * NTHREADS) {
            const int k = i & 127, n = (i >> 7) % 1920, ll = i / (1920 * 128);
            float v = 0.f;
            if (n < 1536) { if (k < 64) { const int grp = n / 768, d = (n / 384) & 1, c = n % 384; v = (grp == 0 ? pp->in[8] : pp->in[10])[(((size_t)ll * 2 + d) * 64 + k) * RW + c]; } }
            else v = pp->in[11][((size_t)ll * 128 + k) * RW + (n - 1536)];
            LWT[i] = (bf16_t)f2bf(v);
        }
    }
    {
        bf16_t* RWT = (bf16_t*)(ws + O_RWT);
        for (int i = bidx * NTHREADS + tid; i < NL * NE * D; i += gdim * NTHREADS) {
            const int k = i % D, e = (i / D) % NE, ll = i / (D * NE);
            const float v = pp->in[24][((size_t)ll * D + k) * NE + e];
            const unsigned hi = f2bf(v); const float lo = v - bf_lo(hi);
            RWT[((size_t)(ll * 2 + 0) * NE + e) * D + k] = (bf16_t)hi; RWT[((size_t)(ll * 2 + 1) * NE + e) * D + k] = (bf16_t)f2bf(lo);
        }
    }
    const float* x = pp->in[0]; bf16_t* XB = (bf16_t*)(ws + O_XB);
    for (size_t i = ((size_t)bidx * NTHREADS + tid) * 4; i < (size_t)T * D; i += (size_t)gdim * NTHREADS * 4) {
        const f32x4 v = *(const f32x4*)(x + i); u32x2 o; o.x = pk2(v.x, v.y); o.y = pk2(v.z, v.w); *(u32x2*)(XB + i) = o;
    }
}

__device__ __forceinline__ float tshift(const float* P, int t, int s, int col, const float* mu0, const float* mu1, int rc) {
    const float cur = P[(size_t)t * PLD + col];
    const float prv = s > 0 ? P[(size_t)(t - 1) * PLD + col] : 0.f;
    const float nxt = s < S - 1 ? P[(size_t)(t + 1) * PLD + col] : 0.f;
    return cur + mu0[rc] * (prv - cur) + mu1[rc] * (nxt - cur);
}

__device__ __forceinline__ void phase_prep(const Params& P, int l, unsigned char* smem, int wv) {
    ParamsPtr pp = PARAMS_PTR(P); PIN_S(pp); unsigned char* ws = pp->ws; int bidx = (int)blockIdx.x, gdim = (int)gridDim.x; PIN_S(bidx); PIN_S(gdim);
    const bf16_t* proj = (const bf16_t*)(ws + O_PROJ); const float* projg = (const float*)(ws + O_PROJG);
    float* UG = (float*)(ws + O_UG); bf16_t* VNT = (bf16_t*)(ws + O_VNT);
    float* RR = (float*)(ws + O_RR); float* VV = (float*)(ws + O_VV); float* KK = (float*)(ws + O_KK);
    float* KD = (float*)(ws + O_KD); float* ICLR = (float*)(ws + O_ICLR);
    float* GATE = (float*)(ws + O_GATE); float* BONUS = (float*)(ws + O_BONUS); float* LWG = (float*)(ws + O_LW);
    bf16_t* RB = (bf16_t*)(ws + O_RB); bf16_t* VB = (bf16_t*)(ws + O_VB); bf16_t* KKB = (bf16_t*)(ws + O_KKB); bf16_t* BBB = (bf16_t*)(ws + O_BBB); bf16_t* KDB = (bf16_t*)(ws + O_KDB);
#if !MK_RWKV_CHUNKED
    float* DEC = (float*)(ws + O_DEC); float* BRKR = (float*)(ws + O_BRKR);
#endif
    bf16_t* MQB = (bf16_t*)(ws + O_MQB); bf16_t* MKB = (bf16_t*)(ws + O_MKB); bf16_t* KT = (bf16_t*)(ws + O_KT); bf16_t* VT = (bf16_t*)(ws + O_VT);
    float* IG = (float*)(ws + O_IG); float* LF = (float*)(ws + O_LF);
    const bf16_t* LWT = (const bf16_t*)(ws + O_LWT) + (size_t)l * 1920 * 128;
    const float* gln_g = pp->in[2] + (size_t)l * GW; const float* gln_b = pp->in[3] + (size_t)l * GW;
    const float* mu0 = pp->in[6] + (size_t)l * 2 * RPROJ; const float* mu1 = mu0 + RPROJ;
    const float* w0 = pp->in[7] + (size_t)l * 2 * RW; const float* a0 = pp->in[9] + (size_t)l * 2 * RW;
    const float* k_k = pp->in[12] + (size_t)l * RW; const float* k_a = pp->in[13] + (size_t)l * RW; const float* r_k = pp->in[14] + (size_t)l * RW;
    const float* conv_w = pp->in[17] + (size_t)l * 3 * 768; const float* conv_b = pp->in[18] + (size_t)l * 768; const float* gate_b = pp->in[19] + (size_t)l * 24;
    float* win = (float*)smem;
    bf16_t* lin = (bf16_t*)(smem + 101376);
    bf16_t* tvn = (bf16_t*)(smem + 110592);
    bf16_t* tk = (bf16_t*)(smem + 118784);
    bf16_t* tv = (bf16_t*)(smem + 131072);
    constexpr int LIN = 264;
    const int tid = phase_tid(wv), lane = tid & 63, wave = tid >> 6, col = lane & 15, g = lane >> 4;
    for (int u = bidx; u < T / 16; u += gdim) {
        const int t0 = u * 16, s0 = t0 % S, bb = t0 / S;
        __syncthreads();
        {
            u32x2 wb[18];
#pragma unroll
            for (int row = 0; row < 18; ++row) {
                const int sq = s0 - 1 + row;
                wb[row] = (u32x2){0u, 0u};
                if (sq >= 0 && sq < S && tid < 352) wb[row] = *(const u32x2*)(proj + (size_t)(t0 - 1 + row) * PLD + C_RW + tid * 4);
            }
            if (tid < 352) {
#pragma unroll
                for (int row = 0; row < 18; ++row) *(f32x4*)(win + row * RPROJ + tid * 4) = (f32x4){bf_lo(wb[row].x), bf_hi(wb[row].x), bf_lo(wb[row].y), bf_hi(wb[row].y)};
            }
        }
        for (int rep_ = 0; rep_ < (MK_PROBE == 3 ? 2 : 1); ++rep_) {
            const int i = tid >> 5, l32 = tid & 31, t = t0 + i;
            float v[8], ug[8]; float sum = 0.f;
#pragma unroll
            for (int j = 0; j < 8; ++j) { const int c = j * 32 + l32; ug[j] = bf_lo((unsigned)proj[(size_t)t * PLD + c]); v[j] = bf_lo((unsigned)proj[(size_t)t * PLD + GW + c]); }
#pragma unroll
            for (int j = 0; j < 8; ++j) { const int c = j * 32 + l32; UG[(size_t)t * GW + c] = geluf_(ug[j]); v[j] = geluf_(v[j]); sum += v[j]; }
#pragma unroll
            for (int o = 16; o >= 1; o >>= 1) sum += SHX(sum, o, lane);
            const float mean = sum * (1.0f / GW); float q = 0.f;
#pragma unroll
            for (int j = 0; j < 8; ++j) { const float d = v[j] - mean; q += d * d; }
#pragma unroll
            for (int o = 16; o >= 1; o >>= 1) q += SHX(q, o, lane);
            const float rstd = 1.0f / sqrtf(q * (1.0f / GW) + LN_EPS);
#pragma unroll
            for (int j = 0; j < 8; ++j) { const int c = j * 32 + l32; tvn[c * 16 + i] = (bf16_t)f2bf((v[j] - mean) * rstd * gln_g[c] + gln_b[c]); }
        }
        __syncthreads();
        {
            const int hf = tid & 1, c = tid >> 1;
            *(u32x4*)(VNT + ((size_t)bb * GW + c) * S + s0 + hf * 8) = *(const u32x4*)(tvn + c * 16 + hf * 8);
        }
        for (int idx = tid; idx < 16 * 256; idx += NTHREADS) {
            const int i = idx >> 8, j = idx & 255, rc = 1152 + j;
            const float pv = win[i * RPROJ + rc], cv = win[(i + 1) * RPROJ + rc], nv = win[(i + 2) * RPROJ + rc];
            const float x = cv + mu0[rc] * (pv - cv) + mu1[rc] * (nv - cv);
            lin[i * LIN + j] = (bf16_t)f2bf(j < 64 ? ftanh(x) : (j < 128 ? x : sigmoidf_(x)));
        }
        __syncthreads();
        for (int rep_ = 0; rep_ < (MK_PROBE == 1 ? 2 : 1); ++rep_) {
#pragma unroll 1
            for (int qg = 0; qg < 3; ++qg) {
                bf16x8 bw_[5][4]; float bias_[5];
#pragma unroll
                for (int q5 = 0; q5 < 5; ++q5) {
                    const int nt = wave * 15 + qg * 5 + q5, grp = nt / 24, c = (nt % 24) * 16 + col;
                    const bf16_t* bw = LWT + (size_t)(nt * 16 + col) * 128 + 8 * g;
#pragma unroll
                    for (int ks = 0; ks < 2; ++ks) bw_[q5][ks] = *(const bf16x8*)(bw + ks * 32);
                    if (grp == 4) {
#pragma unroll
                        for (int ks = 2; ks < 4; ++ks) bw_[q5][ks] = *(const bf16x8*)(bw + ks * 32);
                    }
                    bias_[q5] = grp < 2 ? w0[grp * RW + c] : (grp < 4 ? a0[(grp - 2) * RW + c] : 0.f);
                }
#pragma unroll
                for (int q5 = 0; q5 < 5; ++q5) {
                    const int nt = wave * 15 + qg * 5 + q5, grp = nt / 24, c = (nt % 24) * 16 + col;
                    const int kcol = grp < 2 ? 0 : (grp < 4 ? 64 : 128);
                    f32x4 acc = (f32x4){0.f, 0.f, 0.f, 0.f};
#pragma unroll
                    for (int ks = 0; ks < 2; ++ks) acc = MFMA16(*(const bf16x8*)(lin + col * LIN + kcol + ks * 32 + 8 * g), bw_[q5][ks], acc);
                    if (grp == 4) {
#pragma unroll
                        for (int ks = 2; ks < 4; ++ks) acc = MFMA16(*(const bf16x8*)(lin + col * LIN + kcol + ks * 32 + 8 * g), bw_[q5][ks], acc);
                    }
                    if (grp < 2) {
#pragma unroll
                        for (int r = 0; r < 4; ++r) { const float lw = -fexp(-softplusf_(-(acc[r] + bias_[q5])) - 0.5f); const size_t o = (size_t)grp * T * RW + (size_t)(t0 + 4 * g + r) * RW + c; LWG[o] = lw;
#if !MK_RWKV_CHUNKED
                            DEC[o] = expf(lw);
#endif
                        }
                    } else if (grp < 4) {
#pragma unroll
                        for (int r = 0; r < 4; ++r) ICLR[(size_t)(grp - 2) * T * RW + (size_t)(t0 + 4 * g + r) * RW + c] = sigmoidf_(acc[r] + bias_[q5]);
                    } else {
#pragma unroll
                        for (int r = 0; r < 4; ++r) GATE[(size_t)(t0 + 4 * g + r) * RW + c] = acc[r];
                    }
                }
            }
        }
        __syncthreads();
        for (int rep_ = 0; rep_ < (MK_PROBE == 2 ? 2 : 1); ++rep_) if (wave < 6) {
            const int c = tid, h = wave;
            const float kkc = k_k[c], kac = k_a[c], rkc = r_k[c];
            const float m0r = mu0[c], m1r = mu1[c], m0k = mu0[RW + c], m1k = mu1[RW + c], m0v = mu0[2 * RW + c], m1v = mu1[2 * RW + c];
            float ic0[16], ic1[16];
#pragma unroll
            for (int i = 0; i < 16; ++i) { const size_t o = (size_t)(t0 + i) * RW + c; ic0[i] = ICLR[o]; ic1[i] = ICLR[(size_t)T * RW + o]; }
#pragma unroll
            for (int i = 0; i < 16; ++i) {
                const int t = t0 + i;
                const float* w_ = win + i * RPROJ + c;
                const float rp = w_[0], rc_ = w_[RPROJ], rn = w_[2 * RPROJ];
                const float kp = w_[RW], kc_ = w_[RPROJ + RW], kn = w_[2 * RPROJ + RW];
                const float vp = w_[2 * RW], vc_ = w_[RPROJ + 2 * RW], vn = w_[2 * RPROJ + 2 * RW];
                const float r = rc_ + m0r * (rp - rc_) + m1r * (rn - rc_);
                const float k = kc_ + m0k * (kp - kc_) + m1k * (kn - kc_);
                const float v = vc_ + m0v * (vp - vc_) + m1v * (vn - vc_);
                const size_t o = (size_t)t * RW + c;
                const float kq = k * kkc;
                const float n2 = wave_sum_fast(kq * kq, lane);
                const float kk = kq / fmaxf(sqrtf(n2), 1e-12f);
                const float kd0 = k * (1.0f + (ic0[i] - 1.0f) * kac), kd1 = k * (1.0f + (ic1[i] - 1.0f) * kac);
                const float bon = wave_sum_fast(r * (kd0 + kd1) * rkc, lane);
#if MK_RWKV_CHUNKED
                RB[o] = (bf16_t)f2bf(r); VB[o] = (bf16_t)f2bf(v); KKB[o] = (bf16_t)f2bf(kk);
                BBB[o] = (bf16_t)f2bf(kk * ic0[i]); BBB[(size_t)T * RW + o] = (bf16_t)f2bf(kk * ic1[i]);
                KDB[o] = (bf16_t)f2bf(kd0); KDB[(size_t)T * RW + o] = (bf16_t)f2bf(kd1);
#else
                RR[o] = r; VV[o] = v; KK[o] = kk;
                KD[o] = kd0; KD[(size_t)T * RW + o] = kd1;
#endif
                if (lane == 0) BONUS[(size_t)t * RH + h] = bon;
#if !MK_RWKV_CHUNKED
                { const float br0 = wave_sum(kk * ic0[i] * r, lane), br1 = wave_sum(kk * ic1[i] * r, lane), kr0 = wave_sum(kd0 * r, lane), kr1 = wave_sum(kd1 * r, lane);
                  if (lane == 0) { BRKR[((size_t)t * RH + h) * 2] = br0; BRKR[((size_t)t * RH + h) * 2 + 1] = kr0; BRKR[((size_t)(T + t) * RH + h) * 2] = br1; BRKR[((size_t)(T + t) * RH + h) * 2 + 1] = kr1; } }
#endif
            }
        }
        __syncthreads();
        {
            u32x2 wb[9], vb[3];
            const int rsel = tid >= 192 ? 1 : 0, c4 = tid - rsel * 192;
#pragma unroll
            for (int it = 0; it < 9; ++it) {
                const int row = 2 * it + rsel, sq = s0 - 1 + row;
                wb[it] = (u32x2){0u, 0u};
                if (tid < 384 && sq >= 0 && sq < S) wb[it] = *(const u32x2*)(proj + (size_t)(t0 - 1 + row) * PLD + C_MW + c4 * 4);
            }
#pragma unroll
            for (int it = 0; it < 3; ++it) { const int idx = tid + it * NTHREADS, i = idx / 96, cc = (idx % 96) * 4; vb[it] = *(const u32x2*)(proj + (size_t)(t0 + i) * PLD + C_MW + 2 * MW + cc); }
            if (tid < 384) {
#pragma unroll
                for (int it = 0; it < 9; ++it) *(f32x4*)(win + (2 * it + rsel) * 768 + c4 * 4) = (f32x4){bf_lo(wb[it].x), bf_hi(wb[it].x), bf_lo(wb[it].y), bf_hi(wb[it].y)};
            }
#pragma unroll
            for (int it = 0; it < 3; ++it) { const int idx = tid + it * NTHREADS, i = idx / 96, cc = (idx % 96) * 4; const u32x2 v = vb[it];
                tv[(cc + 0) * 16 + i] = (bf16_t)(v.x & 0xffffu); tv[(cc + 1) * 16 + i] = (bf16_t)(v.x >> 16); tv[(cc + 2) * 16 + i] = (bf16_t)(v.y & 0xffffu); tv[(cc + 3) * 16 + i] = (bf16_t)(v.y >> 16); }
        }
        for (int idx = tid; idx < 16 * 24; idx += NTHREADS) {
            const int i = idx / 24, gi = idx % 24, t = t0 + i;
            const int isf = gi / 12, dir = (gi / 6) & 1, h = gi % 6;
            const float gg = projg[(size_t)t * 256 + (3456 - (PLD - 256)) + gi] + gate_b[gi];
            if (isf) LF[((size_t)dir * T + t) * MH + h] = -softplusf_(-gg); else IG[((size_t)dir * T + t) * MH + h] = gg;
        }
        __syncthreads();
        for (int rep_ = 0; rep_ < (MK_PROBE == 4 ? 2 : 1); ++rep_)
        for (int idx = tid; idx < 16 * 768; idx += NTHREADS) {
            const int i = idx / 768, c = idx % 768, t = t0 + i;
            const float* w_ = win + i * 768 + c;
            float y = conv_b[c] + w_[0] * conv_w[c] + w_[768] * conv_w[768 + c] + w_[1536] * conv_w[2 * 768 + c];
            y = y * sigmoidf_(y);
            if (c < MW) MQB[(size_t)t * MW + c] = (bf16_t)f2bf(y);
            else { const bf16_t kb = (bf16_t)f2bf(y * 0.125f); MKB[(size_t)t * MW + (c - MW)] = kb; tk[(c - MW) * 16 + i] = kb; }
        }
        __syncthreads();
        for (int idx = tid; idx < 2 * MW * 2; idx += NTHREADS) {
            const int hf = idx & 1, c = (idx >> 1) % MW, which = idx / (2 * MW);
            const u32x4 val = *(const u32x4*)((which ? tv : tk) + c * 16 + hf * 8);
            bf16_t* dst = (which ? VT : KT) + ((size_t)(bb * MH) * 64 + c) * S + s0 + hf * 8;
            *(u32x4*)dst = val;
        }
    }
    __syncthreads();
}

__device__ __forceinline__ void phase_prep32(const Params& P, int l, unsigned char* smem, int wv) {
    ParamsPtr pp = PARAMS_PTR(P); PIN_S(pp); unsigned char* ws = pp->ws; int bidx = (int)blockIdx.x, gdim = (int)gridDim.x; PIN_S(bidx); PIN_S(gdim);
    const bf16_t* proj = (const bf16_t*)(ws + O_PROJ); const float* projg = (const float*)(ws + O_PROJG);
    float* UG = (float*)(ws + O_UG); bf16_t* VNT = (bf16_t*)(ws + O_VNT);
    u32x4* RK7 = (u32x4*)(ws + O_RK7);
    float* GATE = (float*)(ws + O_GATE); float* BONUS = (float*)(ws + O_BONUS); float* LWG = (float*)(ws + O_LW);
    bf16_t* VB = (bf16_t*)(ws + O_VB);
    bf16_t* MQB = (bf16_t*)(ws + O_MQB); bf16_t* MKB = (bf16_t*)(ws + O_MKB); bf16_t* KT = (bf16_t*)(ws + O_KT); bf16_t* VT = (bf16_t*)(ws + O_VT);
    float* IG = (float*)(ws + O_IG); float* LF = (float*)(ws + O_LF);
    const bf16_t* LWT = (const bf16_t*)(ws + O_LWT) + (size_t)l * 1920 * 128;
    const float* gln_g = pp->in[2] + (size_t)l * GW; const float* gln_b = pp->in[3] + (size_t)l * GW;
    const float* mu0 = pp->in[6] + (size_t)l * 2 * RPROJ; const float* mu1 = mu0 + RPROJ;
    const float* w0 = pp->in[7] + (size_t)l * 2 * RW; const float* a0 = pp->in[9] + (size_t)l * 2 * RW;
    const float* k_k = pp->in[12] + (size_t)l * RW; const float* k_a = pp->in[13] + (size_t)l * RW; const float* r_k = pp->in[14] + (size_t)l * RW;
    const float* conv_w = pp->in[17] + (size_t)l * 3 * 768; const float* conv_b = pp->in[18] + (size_t)l * 768; const float* gate_b = pp->in[19] + (size_t)l * 24;
    constexpr int TOK = 32, WR = TOK + 2, LIN = 264;
    bf16_t* winb = (bf16_t*)smem;
    bf16_t* lin = (bf16_t*)(smem + 95744);
    bf16_t* tk = (bf16_t*)(smem + 112640);
    bf16_t* tv = (bf16_t*)(smem + 137216);
    bf16_t* tvn = tk;
    bf16_t* icl = tk;
    const int tid = phase_tid(wv), lane = tid & 63, wave = tid >> 6, col = lane & 15, g = lane >> 4;
    for (int u = bidx; u < T / TOK; u += gdim) {
        const int t0 = u * TOK, s0 = t0 % S, bb = t0 / S;
        __syncthreads();
#pragma unroll 1
        for (int hb = 0; hb < 2; ++hb) {
            u32x2 wb[17];
#pragma unroll
            for (int q = 0; q < 17; ++q) {
                const int row = hb * 17 + q, sq = s0 - 1 + row;
                wb[q] = (u32x2){0u, 0u};
                if (sq >= 0 && sq < S && tid < 352) wb[q] = *(const u32x2*)(proj + (size_t)(t0 - 1 + row) * PLD + C_RW + tid * 4);
            }
            if (tid < 352) {
#pragma unroll
                for (int q = 0; q < 17; ++q) *(u32x2*)(winb + (hb * 17 + q) * RPROJ + tid * 4) = wb[q];
            }
        }
#pragma unroll 1
        for (int ps = 0; ps < 2; ++ps) {
            const int i = ps * 16 + (tid >> 5), l32 = tid & 31, t = t0 + i;
            float v[8], ug[8]; float sum = 0.f;
#pragma unroll
            for (int j = 0; j < 8; ++j) { const int c = j * 32 + l32; ug[j] = bf_lo((unsigned)proj[(size_t)t * PLD + c]); v[j] = bf_lo((unsigned)proj[(size_t)t * PLD + GW + c]); }
#pragma unroll
            for (int j = 0; j < 8; ++j) { const int c = j * 32 + l32; UG[(size_t)t * GW + c] = geluf_(ug[j]); v[j] = geluf_(v[j]); sum += v[j]; }
#pragma unroll
            for (int o = 16; o >= 1; o >>= 1) sum += SHX(sum, o, lane);
            const float mean = sum * (1.0f / GW); float q = 0.f;
#pragma unroll
            for (int j = 0; j < 8; ++j) { const float d = v[j] - mean; q += d * d; }
#pragma unroll
            for (int o = 16; o >= 1; o >>= 1) q += SHX(q, o, lane);
            const float rstd = 1.0f / sqrtf(q * (1.0f / GW) + LN_EPS);
#pragma unroll
            for (int j = 0; j < 8; ++j) { const int c = j * 32 + l32; tvn[c * TOK + i] = (bf16_t)f2bf((v[j] - mean) * rstd * gln_g[c] + gln_b[c]); }
        }
        __syncthreads();
#pragma unroll
        for (int q = 0; q < 2; ++q) {
            const int idx = tid + q * NTHREADS, c = idx >> 2, pc = idx & 3;
            *(u32x4*)(VNT + ((size_t)bb * GW + c) * S + s0 + pc * 8) = *(const u32x4*)(tvn + c * TOK + pc * 8);
        }
        int tb2 = tid; PIN_V(tb2);
#pragma unroll 4
        for (int q = 0; q < 16; ++q) {
            const int idx = tb2 + q * NTHREADS, i = idx >> 8, j = idx & 255, rc = 1152 + j;
            const float pv = bf_lo((unsigned)winb[i * RPROJ + rc]), cv = bf_lo((unsigned)winb[(i + 1) * RPROJ + rc]), nv = bf_lo((unsigned)winb[(i + 2) * RPROJ + rc]);
            const float x = cv + mu0[rc] * (pv - cv) + mu1[rc] * (nv - cv);
            lin[i * LIN + j] = (bf16_t)f2bf(j < 64 ? ftanh(x) : (j < 128 ? x : sigmoidf_(x)));
        }
        __syncthreads();
#pragma unroll 1
        for (int qg = 0; qg < 3; ++qg) {
            bf16x8 bw_[5][4]; float bias_[5];
#pragma unroll
            for (int q5 = 0; q5 < 5; ++q5) {
                const int nt = wave * 15 + qg * 5 + q5, grp = nt / 24, c = (nt % 24) * 16 + col;
                const bf16_t* bw = LWT + (size_t)(nt * 16 + col) * 128 + 8 * g;
#pragma unroll
                for (int ks = 0; ks < 2; ++ks) bw_[q5][ks] = *(const bf16x8*)(bw + ks * 32);
                if (grp == 4) {
#pragma unroll
                    for (int ks = 2; ks < 4; ++ks) bw_[q5][ks] = *(const bf16x8*)(bw + ks * 32);
                }
                bias_[q5] = grp < 2 ? w0[grp * RW + c] : (grp < 4 ? a0[(grp - 2) * RW + c] : 0.f);
            }
#pragma unroll
            for (int q5 = 0; q5 < 5; ++q5) {
                const int nt = wave * 15 + qg * 5 + q5, grp = nt / 24, c = (nt % 24) * 16 + col;
                const int kcol = grp < 2 ? 0 : (grp < 4 ? 64 : 128);
#pragma unroll
                for (int mt = 0; mt < 2; ++mt) {
                    f32x4 acc = (f32x4){0.f, 0.f, 0.f, 0.f};
                    const bf16_t* la = lin + (mt * 16 + col) * LIN + kcol + 8 * g;
#pragma unroll
                    for (int ks = 0; ks < 2; ++ks) acc = MFMA16(*(const bf16x8*)(la + ks * 32), bw_[q5][ks], acc);
                    if (grp == 4) {
#pragma unroll
                        for (int ks = 2; ks < 4; ++ks) acc = MFMA16(*(const bf16x8*)(la + ks * 32), bw_[q5][ks], acc);
                    }
                    const size_t tb = (size_t)(t0 + mt * 16 + 4 * g);
                    if (grp < 2) {
#pragma unroll
                        for (int r = 0; r < 4; ++r) LWG[(size_t)grp * T * RW + (tb + r) * RW + c] = -fexp(-softplusf_(-(acc[r] + bias_[q5])) - 0.5f);
                    } else if (grp < 4) {
#pragma unroll
                        for (int r = 0; r < 4; ++r) icl[((grp - 2) * TOK + mt * 16 + 4 * g + r) * RW + c] = (bf16_t)f2bf(sigmoidf_(acc[r] + bias_[q5]));
                    } else {
#pragma unroll
                        for (int r = 0; r < 4; ++r) GATE[(tb + r) * RW + c] = acc[r];
                    }
                }
            }
        }
        __syncthreads();
        if (wave < 6) {
            int c = tid; PIN_V(c); const int h = wave;
            const float kkc = k_k[c], kac = k_a[c], rkc = r_k[c];
            const float m0r = mu0[c], m1r = mu1[c], m0k = mu0[RW + c], m1k = mu1[RW + c], m0v = mu0[2 * RW + c], m1v = mu1[2 * RW + c];
#pragma unroll 1
            for (int hb = 0; hb < 2; ++hb) {
                float ic0[16], ic1[16];
#pragma unroll
                for (int i = 0; i < 16; ++i) { ic0[i] = bf_lo((unsigned)icl[(hb * 16 + i) * RW + c]); ic1[i] = bf_lo((unsigned)icl[(TOK + hb * 16 + i) * RW + c]); }
#pragma unroll
                for (int i = 0; i < 16; ++i) {
                    const int it = hb * 16 + i, t = t0 + it;
                    const bf16_t* w_ = winb + it * RPROJ + c;
                    const float rp = bf_lo((unsigned)w_[0]), rc_ = bf_lo((unsigned)w_[RPROJ]), rn = bf_lo((unsigned)w_[2 * RPROJ]);
                    const float kp = bf_lo((unsigned)w_[RW]), kc_ = bf_lo((unsigned)w_[RPROJ + RW]), kn = bf_lo((unsigned)w_[2 * RPROJ + RW]);
                    const float vp = bf_lo((unsigned)w_[2 * RW]), vc_ = bf_lo((unsigned)w_[RPROJ + 2 * RW]), vn = bf_lo((unsigned)w_[2 * RPROJ + 2 * RW]);
                    const float r = rc_ + m0r * (rp - rc_) + m1r * (rn - rc_);
                    const float k = kc_ + m0k * (kp - kc_) + m1k * (kn - kc_);
                    const float v = vc_ + m0v * (vp - vc_) + m1v * (vn - vc_);
                    const size_t o = (size_t)t * RW + c;
                    const float kq = k * kkc;
                    const float n2 = wave_sum_fast(kq * kq, lane);
                    const float kk = kq / fmaxf(sqrtf(n2), 1e-12f);
                    const float kd0 = k * (1.0f + (ic0[i] - 1.0f) * kac), kd1 = k * (1.0f + (ic1[i] - 1.0f) * kac);
                    const float bon = wave_sum_fast(r * (kd0 + kd1) * rkc, lane);
                    u32x4 rec; rec.x = pk2(r, v); rec.y = pk2(kk, 0.f); rec.z = pk2(kk * ic0[i], kk * ic1[i]); rec.w = pk2(kd0, kd1);
                    RK7[o] = rec;
                    VB[o] = (bf16_t)(rec.x >> 16);
                    if (lane == 0) BONUS[(size_t)t * RH + h] = bon;
                }
            }
        }
        __syncthreads();
        {
            u32x2 wb[17], vb[6];
            const int rsel = tid >= 192 ? 1 : 0, c4 = tid - rsel * 192;
#pragma unroll
            for (int q = 0; q < 17; ++q) {
                const int row = 2 * q + rsel, sq = s0 - 1 + row;
                wb[q] = (u32x2){0u, 0u};
                if (tid < 384 && sq >= 0 && sq < S) wb[q] = *(const u32x2*)(proj + (size_t)(t0 - 1 + row) * PLD + C_MW + c4 * 4);
            }
#pragma unroll
            for (int q = 0; q < 6; ++q) { const int idx = tid + q * NTHREADS, i = idx / 96, cc = (idx % 96) * 4; vb[q] = *(const u32x2*)(proj + (size_t)(t0 + i) * PLD + C_MW + 2 * MW + cc); }
            if (tid < 384) {
#pragma unroll
                for (int q = 0; q < 17; ++q) *(u32x2*)(winb + (2 * q + rsel) * 768 + c4 * 4) = wb[q];
            }
#pragma unroll
            for (int q = 0; q < 6; ++q) { const int idx = tid + q * NTHREADS, i = idx / 96, cc = (idx % 96) * 4; const u32x2 v = vb[q];
                tv[(cc + 0) * TOK + i] = (bf16_t)(v.x & 0xffffu); tv[(cc + 1) * TOK + i] = (bf16_t)(v.x >> 16); tv[(cc + 2) * TOK + i] = (bf16_t)(v.y & 0xffffu); tv[(cc + 3) * TOK + i] = (bf16_t)(v.y >> 16); }
        }
        for (int idx = tid; idx < TOK * 24; idx += NTHREADS) {
            const int i = idx / 24, gi = idx % 24, t = t0 + i;
            const int isf = gi / 12, dir = (gi / 6) & 1, h = gi % 6;
            const float gg = projg[(size_t)t * 256 + (3456 - (PLD - 256)) + gi] + gate_b[gi];
            if (isf) LF[((size_t)dir * T + t) * MH + h] = -softplusf_(-gg); else IG[((size_t)dir * T + t) * MH + h] = gg;
        }
        __syncthreads();
        int tcv = tid; PIN_V(tcv);
#pragma unroll 4
        for (int q = 0; q < 48; ++q) {
            const int idx = tcv + q * NTHREADS, i = idx / 768, c = idx % 768, t = t0 + i;
            const bf16_t* w_ = winb + i * 768 + c;
            float y = conv_b[c] + bf_lo((unsigned)w_[0]) * conv_w[c] + bf_lo((unsigned)w_[768]) * conv_w[768 + c] + bf_lo((unsigned)w_[1536]) * conv_w[2 * 768 + c];
            y = y * sigmoidf_(y);
            if (c < MW) MQB[(size_t)t * MW + c] = (bf16_t)f2bf(y);
            else { const bf16_t kb = (bf16_t)f2bf(y * 0.125f); MKB[(size_t)t * MW + (c - MW)] = kb; tk[(c - MW) * TOK + i] = kb; }
        }
        __syncthreads();
#pragma unroll
        for (int q = 0; q < 6; ++q) {
            const int idx = tid + q * NTHREADS, pc = idx & 3, c = (idx >> 2) % MW, which = idx / (4 * MW);
            const u32x4 val = *(const u32x4*)((which ? tv : tk) + c * TOK + pc * 8);
            bf16_t* dst = (which ? VT : KT) + ((size_t)(bb * MH) * 64 + c) * S + s0 + pc * 8;
            *(u32x4*)dst = val;
        }
    }
    __syncthreads();
}

__device__ __forceinline__ void phase_gmlp_mix(const Params& P, int l, unsigned char* smem, int wv, int bid, int nb) {
    PIN_S(bid); PIN_S(nb);
    ParamsPtr pp = PARAMS_PTR(P); PIN_S(pp); unsigned char* ws = pp->ws;
    const float* UG = (const float*)(ws + O_UG); const bf16_t* VNT = (const bf16_t*)(ws + O_VNT); bf16_t* GRP = (bf16_t*)(ws + O_GRP);
    const bf16_t* WSB = (const bf16_t*)(ws + O_WSB) + (size_t)l * GH * CH * CH; const float* gbs = pp->in[5] + (size_t)l * GH * CH;
    const int tid = phase_tid(wv), lane = tid & 63, wave = tid >> 6, col = lane & 15, g = lane >> 4;
    constexpr int NU = NB * NCH * GH;
    bf16x8 wA[4], vA[4][4], wB[4], vB[4][4]; f32x4 uA[4], uB[4]; float bA, bB;
#define GM_LOAD(u_, W_, V_, U_, B_) do { const int h_ = (u_) % GH, c_ = ((u_) / GH) % NCH, b_ = (u_) / (GH * NCH); \
        const bf16_t* wb_ = WSB + (size_t)h_ * CH * CH + (size_t)(wave * 16 + col) * CH + 8 * g; \
        const bf16_t* vb_ = VNT + ((size_t)b_ * GW + h_ * 64 + col) * S + (size_t)c_ * CH + 8 * g; \
        _Pragma("unroll") for (int ks = 0; ks < 4; ++ks) { W_[ks] = *(const bf16x8*)(wb_ + ks * 32); \
            _Pragma("unroll") for (int et = 0; et < 4; ++et) V_[et][ks] = *(const bf16x8*)(vb_ + (size_t)et * 16 * S + ks * 32); } \
        const size_t t_ = (size_t)(b_ * S + c_ * CH + wave * 16 + col); \
        _Pragma("unroll") for (int et = 0; et < 4; ++et) U_[et] = *(const f32x4*)(UG + t_ * GW + h_ * 64 + et * 16 + 4 * g); \
        B_ = gbs[h_ * CH + wave * 16 + col]; } while (0)
#define GM_COMP(u_, W_, V_, U_, B_) do { const int h_ = (u_) % GH, c_ = ((u_) / GH) % NCH, b_ = (u_) / (GH * NCH); \
        const size_t t_ = (size_t)(b_ * S + c_ * CH + wave * 16 + col); \
        _Pragma("unroll") for (int et = 0; et < 4; ++et) { f32x4 acc = (f32x4){0.f, 0.f, 0.f, 0.f}; \
            _Pragma("unroll") for (int ks = 0; ks < 4; ++ks) acc = MFMA16(V_[et][ks], W_[ks], acc); \
            u32x2 o_; o_.x = pk2(U_[et][0] * (acc[0] + B_), U_[et][1] * (acc[1] + B_)); o_.y = pk2(U_[et][2] * (acc[2] + B_), U_[et][3] * (acc[3] + B_)); \
            *(u32x2*)(GRP + t_ * D + h_ * 64 + et * 16 + 4 * g) = o_; } } while (0)
    int u = bid;
    if (u < NU) GM_LOAD(u, wA, vA, uA, bA);
    while (u < NU) {
        const int u1 = u + nb;
        if (u1 < NU) GM_LOAD(u1, wB, vB, uB, bB);
        GM_COMP(u, wA, vA, uA, bA);
        if (u1 >= NU) break;
        const int u2 = u1 + nb;
        if (u2 < NU) GM_LOAD(u2, wA, vA, uA, bA);
        GM_COMP(u1, wB, vB, uB, bB);
        u = u2;
    }
#undef GM_LOAD
#undef GM_COMP
}

constexpr int SC_STEPS = 16;
constexpr int SC_BUF = SC_STEPS * 6 * 64;
__device__ __forceinline__ void phase_rwkv_scan(const Params& P, int l, unsigned char* smem, int wv, int bid, int nb) {
    PIN_S(bid); PIN_S(nb);
    ParamsPtr pp = PARAMS_PTR(P); PIN_S(pp); unsigned char* ws = pp->ws;
    const float* RR = (const float*)(ws + O_RR); const float* VV = (const float*)(ws + O_VV); const float* KK = (const float*)(ws + O_KK);
    const float* DEC = (const float*)(ws + O_DEC); const float* KD = (const float*)(ws + O_KD); const float* ICLR = (const float*)(ws + O_ICLR);
    float* SCAN = (float*)(ws + O_SCAN); const float* BRKR = (const float*)(ws + O_BRKR);
    const int tid = phase_tid(wv), lane = tid & 63, wave = tid >> 6, rl = (lane >> 4) & 1, kq = (lane & 15) | ((lane >> 5) << 4);
    float* buf = (float*)smem;
    float* scal = buf + 2 * SC_BUF;
    float* outb = scal + 2 * SC_STEPS * 2;
    typedef float f32x2 __attribute__((ext_vector_type(2)));
    for (int u = bid; u < 2 * NB * RH * 4; u += nb) {
        const int qt = u & 3, h = (u >> 2) % RH, b = (u / (4 * RH)) % NB, d = u / (4 * RH * NB);
        const size_t doff = (size_t)d * T * RW;
        float s0 = 0.f, s1 = 0.f;
        float pw[2], pa[2], pb[2], pk[2], pr[2], pv[2], psc = 0.f;
#define SC_LOAD(c) do { _Pragma("unroll") for (int i = 0; i < 2; ++i) { const int idx = tid + NTHREADS * i, st = idx >> 6, k = idx & 63; const int tau = (c) * SC_STEPS + st, sq = d ? S - 1 - tau : tau; \
            const size_t o = (size_t)(b * S + sq) * RW + h * 64 + k; \
            pw[i] = DEC[doff + o]; pa[i] = KK[o]; pb[i] = ICLR[doff + o]; pk[i] = KD[doff + o]; pr[i] = RR[o]; pv[i] = VV[o]; }     \
            if (tid < 2 * SC_STEPS) { const int tau = (c) * SC_STEPS + (tid >> 1), sq = d ? S - 1 - tau : tau; psc = BRKR[((size_t)(d * T + b * S + sq) * RH + h) * 2 + (tid & 1)]; } } while (0)
#define SC_WRITE(c) do { float* B_ = buf + ((c) & 1) * SC_BUF; _Pragma("unroll") for (int i = 0; i < 2; ++i) { const int idx = tid + NTHREADS * i, st = idx >> 6, k = idx & 63; \
            float* q_ = B_ + st * 384 + k; q_[0] = pw[i]; q_[64] = -pa[i]; q_[128] = pa[i] * pb[i]; q_[192] = pk[i]; q_[256] = pw[i] * pr[i]; q_[320] = pv[i]; } \
            if (tid < 2 * SC_STEPS) scal[((c) & 1) * SC_STEPS * 2 + tid] = psc; } while (0)
        __syncthreads();
        SC_LOAD(0); SC_WRITE(0);
        __syncthreads();
        const int row = qt * 16 + wave * 2 + rl;
        for (int c = 0; c < S / SC_STEPS; ++c) {
            const bool more = (c + 1) < S / SC_STEPS;
            if (more) SC_LOAD(c + 1);
            const float* B = buf + (c & 1) * SC_BUF; const float* sc = scal + (c & 1) * SC_STEPS * 2; float* ob = outb + (c & 1) * SC_STEPS * 16;
            float outs[SC_STEPS];
            f32x2 w2 = *(const f32x2*)(B + 2 * kq), a2 = *(const f32x2*)(B + 64 + 2 * kq), b2 = *(const f32x2*)(B + 128 + 2 * kq);
            f32x2 k2 = *(const f32x2*)(B + 192 + 2 * kq), wr2 = *(const f32x2*)(B + 256 + 2 * kq);
            float v = B[320 + row]; float br = sc[0], kr = sc[1];
#pragma unroll
            for (int st = 0; st < SC_STEPS; ++st) {
                const int sn = st + 1 < SC_STEPS ? st + 1 : st;
                const float* q = B + sn * 384;
                const f32x2 nw2 = *(const f32x2*)(q + 2 * kq), na2 = *(const f32x2*)(q + 64 + 2 * kq), nb2 = *(const f32x2*)(q + 128 + 2 * kq);
                const f32x2 nk2 = *(const f32x2*)(q + 192 + 2 * kq), nwr2 = *(const f32x2*)(q + 256 + 2 * kq);
                const float nv = q[320 + row], nbr = sc[sn * 2], nkr = sc[sn * 2 + 1];
                SCHED_BAR();
                float sa = s0 * a2.x + s1 * a2.y;
                float po = s0 * wr2.x + s1 * wr2.y;
                sa = row32_sum(sa); po = row32_sum(po);
                outs[st] = po + sa * br + v * kr;
                s0 = s0 * w2.x + (sa * b2.x + v * k2.x); s1 = s1 * w2.y + (sa * b2.y + v * k2.y);
                SCHED_BAR();
                w2 = nw2; a2 = na2; b2 = nb2; k2 = nk2; wr2 = nwr2; v = nv; br = nbr; kr = nkr;
            }
            if (kq == 0) {
#pragma unroll
                for (int st = 0; st < SC_STEPS; ++st) ob[st * 16 + wave * 2 + rl] = outs[st];
            }
            if (more) SC_WRITE(c + 1);
            __syncthreads();
            if (tid < 16 * SC_STEPS) {
                const int st = tid >> 4, r = tid & 15, tau = c * SC_STEPS + st, sq = d ? S - 1 - tau : tau;
                SCAN[doff + (size_t)(b * S + sq) * RW + h * 64 + qt * 16 + r] = ob[st * 16 + r];
            }
        }
#undef SC_LOAD
#undef SC_WRITE
    }
    __syncthreads();
}

constexpr int RST = 72;
constexpr int RARR = 64 * RST;
__device__ __forceinline__ f32x4 tile_nt(const bf16_t* Aa, int ta, const bf16_t* Ba, int tb, f32x4 acc, int col, int g) {
#pragma unroll
    for (int ks = 0; ks < 2; ++ks) {
        const bf16x8 af = *(const bf16x8*)(Aa + (ta * 16 + col) * RST + ks * 32 + 8 * g);
        const bf16x8 bfr = *(const bf16x8*)(Ba + (tb * 16 + col) * RST + ks * 32 + 8 * g);
        acc = MFMA16(af, bfr, acc);
    }
    return acc;
}
__device__ __forceinline__ void phase_rwkv_pre(const Params& P, int l, unsigned char* smem, int wv) {
    ParamsPtr pp = PARAMS_PTR(P); PIN_S(pp); unsigned char* ws = pp->ws; int bidx = (int)blockIdx.x, gdim = (int)gridDim.x; PIN_S(bidx); PIN_S(gdim);
    const u32x4* RK7 = (const u32x4*)(ws + O_RK7);
    const float* LWG = (const float*)(ws + O_LW);
    bf16_t* Qg = (bf16_t*)(ws + O_RQ); bf16_t* Ag = (bf16_t*)(ws + O_RA); bf16_t* Hg = (bf16_t*)(ws + O_RH); bf16_t* Gg = (bf16_t*)(ws + O_RG);
    const int tid0 = phase_tid(wv);
#define RW_STAGE_VARS int tid = tid0; PIN_V(tid); const int lane = tid & 63, wave = tid >> 6, col = lane & 15, g = lane >> 4; (void)lane; (void)wave; (void)col; (void)g;
    bf16_t* At = (bf16_t*)smem; bf16_t* Bt = At + RARR; bf16_t* Kt = Bt + RARR; bf16_t* Rt = Kt + RARR;
    bf16_t* BtT = Rt + RARR; bf16_t* KtT = BtT + RARR; bf16_t* VT = KtT + RARR;
    bf16_t* Lak = VT + RARR; bf16_t* Mrb = Lak + RARR; bf16_t* Mrk = Mrb + RARR; bf16_t* YT = Mrk + RARR; bf16_t* W2T = YT + RARR;
    bf16_t* Lbo = W2T + RARR;
    float* LabT = (float*)(Lbo + RARR);
    float* Xs = LabT + 4096;
    float* Pb = Xs + 4096;
    float* segs = Pb + 2048;
    float* PC = segs + 512;
    float plw[8]; u32x4 prec[8];
#define RW_LOAD(uu) do { const int c_ = (uu) % RNC, h_ = ((uu) / RNC) % RH, b_ = ((uu) / (RNC * RH)) % NB, d_ = (uu) / (RNC * RH * NB); const size_t doff_ = (size_t)d_ * T * RW; \
        const int ch_ = tid0 & 63, sg_ = tid0 >> 6; _Pragma("unroll") for (int j = 0; j < 8; ++j) { const int tau = c_ * RC + sg_ * 8 + j, sq = d_ ? S - 1 - tau : tau; const size_t o = (size_t)(b_ * S + sq) * RW + h_ * 64 + ch_; \
        plw[j] = LWG[doff_ + o]; prec[j] = RK7[o]; } } while (0)
    if (bidx < RUN) RW_LOAD(bidx);
    for (int u = bidx; u < RUN; u += gdim) {
        const int c = u % RNC, h = (u / RNC) % RH, b = (u / (RNC * RH)) % NB, d = u / (RNC * RH * NB);
        (void)c; (void)h; (void)b; (void)d;
        __syncthreads();
        {
            RW_STAGE_VARS
            const int ch = tid & 63, sg = tid >> 6;
            float lw[8]; unsigned kk[8], bq_[8], kd[8], rr[8], vv[8];
#pragma unroll
            for (int j = 0; j < 8; ++j) { lw[j] = plw[j]; kk[j] = prec[j].y & 0xffffu; bq_[j] = d ? (prec[j].z >> 16) : (prec[j].z & 0xffffu); kd[j] = d ? (prec[j].w >> 16) : (prec[j].w & 0xffffu); rr[j] = prec[j].x & 0xffffu; vv[j] = prec[j].x >> 16; }
            if (u + gdim < RUN) RW_LOAD(u + gdim);
            float run = 0.f;
#pragma unroll
            for (int j = 0; j < 8; ++j) { run += lw[j]; lw[j] = run; }
            segs[sg * 64 + ch] = run;
            __syncthreads();
            float off = 0.f;
            for (int q = 0; q < sg; ++q) off += segs[q * 64 + ch];
            u32x4 pbt, pkt, pvt; unsigned tb[8], tk[8], tvv[8];
            float prev = off;
#pragma unroll
            for (int j = 0; j < 8; ++j) {
                const int t = sg * 8 + j; const float cl = off + lw[j];
                const float ep = fexp(prev), en = fexp(-cl), epc = fexp(cl);
                const unsigned a_ = f2bf(-bf_lo(kk[j]) * ep), b_ = f2bf(bf_lo(bq_[j]) * en), k_ = f2bf(bf_lo(kd[j]) * en), r_ = f2bf(bf_lo(rr[j]) * epc), v_ = vv[j];
                At[t * RST + ch] = (bf16_t)a_; Bt[t * RST + ch] = (bf16_t)b_; Kt[t * RST + ch] = (bf16_t)k_; Rt[t * RST + ch] = (bf16_t)r_;
                tb[j] = b_; tk[j] = k_; tvv[j] = v_;
                prev = cl;
            }
            if (sg == 7) PC[ch] = fexp(prev);
            pbt.x = tb[0] | (tb[1] << 16); pbt.y = tb[2] | (tb[3] << 16); pbt.z = tb[4] | (tb[5] << 16); pbt.w = tb[6] | (tb[7] << 16);
            pkt.x = tk[0] | (tk[1] << 16); pkt.y = tk[2] | (tk[3] << 16); pkt.z = tk[4] | (tk[5] << 16); pkt.w = tk[6] | (tk[7] << 16);
            pvt.x = tvv[0] | (tvv[1] << 16); pvt.y = tvv[2] | (tvv[3] << 16); pvt.z = tvv[4] | (tvv[5] << 16); pvt.w = tvv[6] | (tvv[7] << 16);
            *(u32x4*)(BtT + ch * RST + sg * 8) = pbt; *(u32x4*)(KtT + ch * RST + sg * 8) = pkt; *(u32x4*)(VT + ch * RST + sg * 8) = pvt;
            for (int z_ = tid; z_ < 2 * RARR / 8; z_ += NTHREADS) ((u32x4*)YT)[z_] = (u32x4){0u, 0u, 0u, 0u};
        }
        __syncthreads();
        {
            RW_STAGE_VARS
            const int m = wave >> 1;
            const bf16_t* Ym = (m == 0 || m == 2) ? Bt : Kt; const bf16_t* Xm = (m < 2) ? At : Rt;
#pragma unroll 1
            for (int q = 0; q < 8; ++q) {
                const int tix = (wave & 1) * 8 + q, it = tix >> 2, tt = tix & 3;
                f32x4 acc = (f32x4){0.f, 0.f, 0.f, 0.f};
                if (it <= tt) acc = tile_nt(Ym, it, Xm, tt, acc, col, g);
                const int t = tt * 16 + col, i0 = it * 16 + 4 * g;
                float o4[4];
#pragma unroll
                for (int r = 0; r < 4; ++r) { const int i = i0 + r; const bool ok = m < 2 ? (i < t) : (i <= t); o4[r] = ok ? acc[r] : 0.f; }
                if (m == 0) {
#pragma unroll
                    for (int r = 0; r < 4; ++r) LabT[(i0 + r) * 64 + t] = o4[r];
                    const bool offd = it < tt;
                    u32x2 w2; w2.x = offd ? pk2(o4[0], o4[1]) : 0u; w2.y = offd ? pk2(o4[2], o4[3]) : 0u; *(u32x2*)(Lbo + t * RST + i0) = w2;
                }
                else { bf16_t* dst = (m == 1 ? Lak : (m == 2 ? Mrb : Mrk)) + t * RST + i0; u32x2 w2; w2.x = pk2(o4[0], o4[1]); w2.y = pk2(o4[2], o4[3]); *(u32x2*)dst = w2; }
            }
        }
        __syncthreads();
        {
            RW_STAGE_VARS
#pragma unroll
            for (int q = 0; q < 2; ++q) {
                const int tix = wave * 2 + q, tt = tix >> 2, et = tix & 3;
                f32x4 acc = (f32x4){0.f, 0.f, 0.f, 0.f};
                acc = tile_nt(Lak, tt, VT, et, acc, col, g);
#pragma unroll
                for (int r = 0; r < 4; ++r) Xs[(tt * 16 + 4 * g + r) * 64 + et * 16 + col] = acc[r];
            }
        }
        __syncthreads();
        {
            RW_STAGE_VARS
#pragma unroll 1
            for (int bb = 0; bb < 4; ++bb) {
                if (bb > 0) {
                    const bf16_t* Zt = (wave < 4 ? YT : W2T) + ((wave & 3) * 16 + col) * RST + 8 * g;
                    const bf16_t* La = Lbo + (16 * bb + col) * RST + 8 * g;
                    f32x4 acc = (f32x4){0.f, 0.f, 0.f, 0.f};
                    acc = MFMA16(*(const bf16x8*)La, *(const bf16x8*)Zt, acc);
                    if (bb > 2) acc = MFMA16(*(const bf16x8*)(La + 32), *(const bf16x8*)(Zt + 32), acc);
#pragma unroll
                    for (int r = 0; r < 4; ++r) Pb[(4 * g + r) * 128 + wave * 16 + col] = acc[r];
                }
                __syncthreads();
                if (wave < 2) {
                    float acc[16];
                    if (wave == 0) {
#pragma unroll
                        for (int r = 0; r < 16; ++r) acc[r] = bf_lo((unsigned)At[(16 * bb + r) * RST + lane]);
                    } else {
#pragma unroll
                        for (int r = 0; r < 16; ++r) acc[r] = Xs[(16 * bb + r) * 64 + lane];
                    }
                    if (bb > 0) {
#pragma unroll
                        for (int r = 0; r < 16; ++r) acc[r] += Pb[r * 128 + wave * 64 + lane];
                    }
                    const float* dp = LabT + (16 * bb) * 64 + 16 * bb;
#pragma unroll
                    for (int r = 1; r < 16; ++r)
#pragma unroll
                        for (int r2 = 0; r2 < r; ++r2) acc[r] += dp[r2 * 64 + r] * acc[r2];
                    bf16_t* dst = (wave == 0 ? YT : W2T) + lane * RST;
                    u32x4 w0, w1;
                    w0.x = pk2(acc[0], acc[1]); w0.y = pk2(acc[2], acc[3]); w0.z = pk2(acc[4], acc[5]); w0.w = pk2(acc[6], acc[7]);
                    w1.x = pk2(acc[8], acc[9]); w1.y = pk2(acc[10], acc[11]); w1.z = pk2(acc[12], acc[13]); w1.w = pk2(acc[14], acc[15]);
                    *(u32x4*)(dst + 16 * bb) = w0; *(u32x4*)(dst + 16 * bb + 8) = w1;
                }
                __syncthreads();
            }
        }
        __syncthreads();
        {
            RW_STAGE_VARS
            const int ty = wave >> 1;
#pragma unroll 1
            for (int q = 0; q < 8; ++q) {
                const int tix = (wave & 1) * 8 + q, ra = tix >> 2, cb = tix & 3;
                f32x4 acc = (f32x4){0.f, 0.f, 0.f, 0.f};
                if (ty == 0) {
                    acc = tile_nt(YT, ra, Mrb, cb, acc, col, g);
                    const u32x2 rt2 = *(const u32x2*)(Rt + (cb * 16 + col) * RST + ra * 16 + 4 * g);
                    u32x2 qb2; qb2.x = pk2(acc[0] + bf_lo(rt2.x), acc[1] + bf_hi(rt2.x)); qb2.y = pk2(acc[2] + bf_lo(rt2.y), acc[3] + bf_hi(rt2.y));
                    *(u32x2*)(Qg + (size_t)u * 4096 + ((((ra >> 1) * 4 + cb) * 64 + lane) * 8 + (ra & 1) * 4)) = qb2;
                } else if (ty == 1) {
                    acc = tile_nt(Mrb, ra, W2T, cb, acc, col, g); acc = tile_nt(Mrk, ra, VT, cb, acc, col, g);
                    { u32x2 hb; hb.x = pk2(acc[0], acc[1]); hb.y = pk2(acc[2], acc[3]); *(u32x2*)(Hg + (size_t)u * 4096 + (tix * 64 + lane) * 4) = hb; }
                } else if (ty == 2) {
                    acc = tile_nt(YT, ra, BtT, cb, acc, col, g);
                    const float pc = PC[cb * 16 + col]; const int k1 = cb * 16 + col;
                    float a4[4];
#pragma unroll
                    for (int r = 0; r < 4; ++r) a4[r] = pc * (acc[r] + ((ra * 16 + 4 * g + r) == k1 ? 1.0f : 0.f));
                    u32x2 ab2; ab2.x = pk2(a4[0], a4[1]); ab2.y = pk2(a4[2], a4[3]);
                    *(u32x2*)(Ag + (size_t)u * 4096 + ((((ra >> 1) * 4 + cb) * 64 + lane) * 8 + (ra & 1) * 4)) = ab2;
                } else {
                    acc = tile_nt(BtT, ra, W2T, cb, acc, col, g); acc = tile_nt(KtT, ra, VT, cb, acc, col, g);
#pragma unroll
                    for (int r = 0; r < 4; ++r) acc[r] *= PC[ra * 16 + 4 * g + r];
                    { u32x2 gb2; gb2.x = pk2(acc[0], acc[1]); gb2.y = pk2(acc[2], acc[3]); *(u32x2*)(Gg + (size_t)u * 4096 + (tix * 64 + lane) * 4) = gb2; }
                }
            }
        }
    }
    __syncthreads();
#undef RW_STAGE_VARS
#undef RW_LOAD
}
constexpr int RSEQ_WGS = 2 * NB * RH * 2;
template <int MODE = 0>
__device__ __forceinline__ void phase_rwkv_seq(const Params& P, int l, unsigned char* smem, int wv) {
    ParamsPtr pp = PARAMS_PTR(P); PIN_S(pp); unsigned char* ws = pp->ws; int bidx = (int)blockIdx.x, gdim = (int)gridDim.x; PIN_S(bidx); PIN_S(gdim);
    const bf16_t* Ag = (const bf16_t*)(ws + O_RA); const bf16_t* Gg = (const bf16_t*)(ws + O_RG); bf16_t* Sg = (bf16_t*)(ws + ((MODE & 4) ? O_XS : O_RS));
    const int tid = phase_tid(wv), lane = tid & 63, wave = tid >> 6, col = lane & 15, g = lane >> 4;
    if (wave >= 2) return;
    const int nwg = gdim < RSEQ_WGS ? gdim : RSEQ_WGS;
    if (bidx >= nwg) return;
    for (int un = wave * nwg + bidx; un < 2 * NB * RH * 4; un += 2 * nwg) {
        const int ch = un >> 2, eq = un & 3;
        f32x4 acc[4];
#pragma unroll
        for (int a_ = 0; a_ < 4; ++a_) acc[a_] = (f32x4){0.f, 0.f, 0.f, 0.f};
        u32x4 a0[4][2], a1[4][2], a2[4][2], a3[4][2]; u32x2 g0[4], g1[4], g2[4], g3[4];
        const unsigned aoff = (unsigned)(col * 64 + 16 * g), goff = (unsigned)(lane * 4), aoff8 = (unsigned)(lane * 8);
#define RS_LOAD(cc, AF, GQ) do { const int c_ = (cc) < RNC ? (cc) : RNC - 1; const bf16_t* ab_ = Ag + (size_t)(ch * RNC + c_) * 4096; const bf16_t* gb_ = Gg + (size_t)(ch * RNC + c_) * 4096 + eq * 256; \
            _Pragma("unroll") for (int ra = 0; ra < 4; ++ra) _Pragma("unroll") for (int p = 0; p < 2; ++p) AF[ra][p] = *(const u32x4*)(ab_ + ((p * 4 + ra) * 512) + aoff8); \
            _Pragma("unroll") for (int ra = 0; ra < 4; ++ra) GQ[ra] = *(const u32x2*)(gb_ + (ra * 1024) + goff); } while (0)
#define RS_STEP(c, AF, GQ) do { if (RNC % 4 == 0 || (c) < RNC) { SCHED_BAR(); bf16_t* sb_ = Sg + (size_t)(ch * RNC + (c)) * 4096 + eq * 1024; \
            bf16x8 bq[2]; _Pragma("unroll") for (int p = 0; p < 2; ++p) bq[p] = cvt8(acc[2 * p], acc[2 * p + 1]); \
            if (!(MODE & 1) || (c) == RNC - 1) { _Pragma("unroll") for (int p = 0; p < 2; ++p) *(bf16x8*)(sb_ + (p * 8) + aoff) = bq[p]; } \
            _Pragma("unroll") for (int ra = 0; ra < 4; ++ra) acc[ra] = (f32x4){bf_lo(GQ[ra].x), bf_hi(GQ[ra].x), bf_lo(GQ[ra].y), bf_hi(GQ[ra].y)}; \
            _Pragma("unroll") for (int ra = 0; ra < 4; ++ra) _Pragma("unroll") for (int p = 0; p < 2; ++p) acc[ra] = MFMA16(__builtin_bit_cast(bf16x8, AF[ra][p]), bq[p], acc[ra]); \
            if (!(MODE & 2)) RS_LOAD((c) + 4, AF, GQ); SCHED_BAR(); } } while (0)
        RS_LOAD(0, a0, g0); RS_LOAD(1, a1, g1); RS_LOAD(2, a2, g2); RS_LOAD(3, a3, g3);
#pragma unroll 1
        for (int c = 0; c < RNC; c += 4) { RS_STEP(c, a0, g0); RS_STEP(c + 1, a1, g1); RS_STEP(c + 2, a2, g2); RS_STEP(c + 3, a3, g3); }
#undef RS_LOAD
#undef RS_STEP
    }
}
__device__ __forceinline__ void phase_rwkv_out(const Params& P, int l, unsigned char* smem, int wv) {
    ParamsPtr pp = PARAMS_PTR(P); PIN_S(pp); unsigned char* ws = pp->ws; int bidx = (int)blockIdx.x, gdim = (int)gridDim.x; PIN_S(bidx); PIN_S(gdim);
    const bf16_t* Qg = (const bf16_t*)(ws + O_RQ); const bf16_t* Sg = (const bf16_t*)(ws + O_RS); const bf16_t* Hg = (const bf16_t*)(ws + O_RH);
    const bf16_t* VB = (const bf16_t*)(ws + O_VB); const float* GATE = (const float*)(ws + O_GATE); const float* BONUS = (const float*)(ws + O_BONUS);
    bf16_t* GRP = (bf16_t*)(ws + O_GRP);
    const float* rln_g = pp->in[15] + (size_t)l * RW; const float* rln_b = pp->in[16] + (size_t)l * RW;
    const int tid = phase_tid(wv), lane = tid & 63, wave = tid >> 6, col = lane & 15, g = lane >> 4;
    for (int pu = bidx * NWAVES + wave; pu < NB * RH * RNC; pu += gdim * NWAVES) {
        const int c = pu % RNC, h = (pu / RNC) % RH, b = pu / (RNC * RH);
        f32x4 o[2][4][4];
#pragma unroll
        for (int d = 0; d < 2; ++d) {
            const int u = ((d * NB + b) * RH + h) * RNC + (d ? RNC - 1 - c : c);
            const size_t ub = (size_t)u * 4096;
            bf16x8 qa[4][2], sb[4][2];
#pragma unroll
            for (int q = 0; q < 4; ++q)
#pragma unroll
                for (int ks = 0; ks < 2; ++ks) {
                    qa[q][ks] = *(const bf16x8*)(Qg + ub + ((ks * 4 + q) * 64 + lane) * 8);
                    sb[q][ks] = *(const bf16x8*)(Sg + ub + (q * 16 + col) * 64 + 16 * g + 8 * ks);
                }
#pragma unroll
            for (int tt = 0; tt < 4; ++tt)
#pragma unroll
                for (int et = 0; et < 4; ++et) {
                    const u32x2 hb = *(const u32x2*)(Hg + ub + ((tt * 4 + et) * 64 + lane) * 4);
                    f32x4 acc = (f32x4){bf_lo(hb.x), bf_hi(hb.x), bf_lo(hb.y), bf_hi(hb.y)};
#pragma unroll
                    for (int ks = 0; ks < 2; ++ks) acc = MFMA16(qa[tt][ks], sb[et][ks], acc);
                    o[d][tt][et] = acc;
                }
        }
        const int src = (3 - g) * 16 + col;
#pragma unroll
        for (int tt = 0; tt < 4; ++tt)
#pragma unroll
            for (int et = 0; et < 4; ++et)
#pragma unroll
                for (int r = 0; r < 4; ++r) o[0][tt][et][r] += SHL(o[1][3 - tt][et][3 - r], src);
        float* tile = (float*)smem + wave * (64 * 68);
        WAVE_SYNC();
#pragma unroll
        for (int tt = 0; tt < 4; ++tt)
#pragma unroll
            for (int et = 0; et < 4; ++et)
#pragma unroll
                for (int r = 0; r < 4; ++r) tile[(tt * 16 + 4 * g + r) * 68 + et * 16 + col] = o[0][tt][et][r];
        WAVE_SYNC();
        {
            const int c4 = (lane & 15) * 4, ch = h * 64 + c4;
            const f32x4 lg = *(const f32x4*)(rln_g + ch), lb = *(const f32x4*)(rln_b + ch);
#pragma unroll 1
            for (int qb = 0; qb < 2; ++qb) {
                f32x4 gt_[8]; u32x2 vb_[8]; float bo_[8];
#pragma unroll
                for (int q8 = 0; q8 < 8; ++q8) {
                    const size_t t = (size_t)(b * S + c * RC + (qb * 8 + q8) * 4 + (lane >> 4));
                    gt_[q8] = *(const f32x4*)(GATE + t * RW + ch); vb_[q8] = *(const u32x2*)(VB + t * RW + ch); bo_[q8] = BONUS[t * RH + h];
                }
#pragma unroll
                for (int q8 = 0; q8 < 8; ++q8) {
                    const int tl = (qb * 8 + q8) * 4 + (lane >> 4);
                    const size_t t = (size_t)(b * S + c * RC + tl);
                    const f32x4 x = *(const f32x4*)(tile + tl * 68 + c4);
                    const float mean = row16_sum((x.x + x.y) + (x.z + x.w)) * (1.0f / 64.0f);
                    const f32x4 dl = x - mean;
                    const float var = row16_sum((dl.x * dl.x + dl.y * dl.y) + (dl.z * dl.z + dl.w * dl.w)) * (1.0f / 64.0f);
                    const float rstd = 1.0f / sqrtf(var + GN_EPS);
                    f32x4 y = dl * rstd * lg + lb;
                    y.x += bo_[q8] * bf_lo(vb_[q8].x); y.y += bo_[q8] * bf_hi(vb_[q8].x); y.z += bo_[q8] * bf_lo(vb_[q8].y); y.w += bo_[q8] * bf_hi(vb_[q8].y);
                    y = y * gt_[q8];
                    u32x2 ob; ob.x = pk2(y.x, y.y); ob.y = pk2(y.z, y.w);
                    *(u32x2*)(GRP + t * D + GW + ch) = ob;
                }
            }
        }
    }
    __syncthreads();
}

__device__ __forceinline__ void phase_mlstm_local(const Params& P, int l, unsigned char* smem, int wv, int bid, int nb) {
    PIN_S(bid); PIN_S(nb);
    ParamsPtr pp = PARAMS_PTR(P); PIN_S(pp); unsigned char* ws = pp->ws;
    const bf16_t* KT = (const bf16_t*)(ws + O_KT); const bf16_t* VT = (const bf16_t*)(ws + O_VT);
    const float* IG = (const float*)(ws + O_IG); const float* LF = (const float*)(ws + O_LF);
    float* CL = (float*)(ws + O_CL); float* NLb = (float*)(ws + O_NL); float* ML = (float*)(ws + O_ML); float* BL = (float*)(ws + O_BL);
    float* GVT = (float*)(ws + O_GVT); float* PMX = (float*)(ws + O_PMX); float* BCT = (float*)(ws + O_BCT);
    const int tid = phase_tid(wv), lane = tid & 63, wave = tid >> 6, col = lane & 15, g = lane >> 4;
    float* wts = (float*)smem + wave * 128;
    for (int u = bid * NWAVES + wave; u < 2 * NB * MH * NCH; u += nb * NWAVES) {
        const int c = u % NCH, h = (u / NCH) % MH, p = u / (NCH * MH), d = p / NB, b = p % NB;
        const int tc = d ? NCH - 1 - c : c, tok0 = b * S + tc * CH;
        const int i0 = d ? 127 - 2 * lane : 2 * lane, i1 = d ? i0 - 1 : i0 + 1;
        const size_t g0 = ((size_t)d * T + tok0 + i0) * MH + h, g1 = ((size_t)d * T + tok0 + i1) * MH + h;
        const float lf0 = LF[g0], lf1 = LF[g1], ig0 = IG[g0], ig1 = IG[g1];
        const float c1 = lf0 + lf1;
        float incl = c1;
#pragma unroll
        for (int o = 1; o < 64; o <<= 1) { const float tq = SHUP(incl, o, lane); if (lane >= o) incl += tq; }
        const float excl = incl - c1, bc0 = excl + lf0, bc1 = incl;
        const float blast = RDL(incl, 63);
        const float gv0 = ig0 - bc0, gv1 = ig1 - bc1, pl1 = fmaxf(gv0, gv1);
        float mincl = pl1;
#pragma unroll
        for (int o = 1; o < 64; o <<= 1) { const float tq = SHUP(mincl, o, lane); if (lane >= o) mincl = fmaxf(mincl, tq); }
        float mexcl = SHUP(mincl, 1, lane); if (lane == 0) mexcl = -INFINITY;
        const float pm0 = fmaxf(mexcl, gv0), pm1 = mincl;
        const float mloc = blast + RDL(mincl, 63);
        WAVE_SYNC();
        wts[i0] = fexp(blast + gv0 - mloc); wts[i1] = fexp(blast + gv1 - mloc);
        GVT[g0] = gv0; GVT[g1] = gv1; PMX[g0] = pm0; PMX[g1] = pm1; BCT[g0] = bc0; BCT[g1] = bc1;
        if (lane == 0) { ML[u] = mloc; BL[u] = blast; }
        WAVE_SYNC();
        const bf16_t* vbase = VT + ((size_t)(b * MH + h) * 64) * S + (size_t)tc * CH;
        const bf16_t* kbase = KT + ((size_t)(b * MH + h) * 64) * S + (size_t)tc * CH;
        const unsigned loff = (unsigned)(col * S + 8 * g);
        f32x4 acc[4][4];
#pragma unroll
        for (int a_ = 0; a_ < 4; ++a_)
#pragma unroll
            for (int b_ = 0; b_ < 4; ++b_) acc[a_][b_] = (f32x4){0.f, 0.f, 0.f, 0.f};
        float nsum[4] = {0.f, 0.f, 0.f, 0.f};
#pragma unroll 1
        for (int ks = 0; ks < 4; ++ks) {
            const int ii = ks * 32 + 8 * g;
            const f32x4 w0 = *(const f32x4*)(wts + ii), w1 = *(const f32x4*)(wts + ii + 4);
            bf16x8 af[4], bfk[4];
#pragma unroll
            for (int q = 0; q < 4; ++q) af[q] = *(const bf16x8*)(vbase + ((size_t)q * 16 * S + ks * 32) + loff);
#pragma unroll
            for (int q = 0; q < 4; ++q) {
                const u32x4 kr = *(const u32x4*)(kbase + ((size_t)q * 16 * S + ks * 32) + loff);
                f32x4 k0, k1;
                k0.x = bf_lo(kr.x) * w0.x; k0.y = bf_hi(kr.x) * w0.y; k0.z = bf_lo(kr.y) * w0.z; k0.w = bf_hi(kr.y) * w0.w;
                k1.x = bf_lo(kr.z) * w1.x; k1.y = bf_hi(kr.z) * w1.y; k1.z = bf_lo(kr.w) * w1.z; k1.w = bf_hi(kr.w) * w1.w;
                nsum[q] += (k0.x + k0.y) + (k0.z + k0.w) + (k1.x + k1.y) + (k1.z + k1.w);
                bfk[q] = cvt8(k0, k1);
            }
#pragma unroll
            for (int a_ = 0; a_ < 4; ++a_)
#pragma unroll
                for (int b_ = 0; b_ < 4; ++b_) acc[a_][b_] = MFMA16(af[a_], bfk[b_], acc[a_][b_]);
        }
        float* cbase = CL + (size_t)u * 4096;
        const unsigned coff = (unsigned)(4 * g * 64 + col);
#pragma unroll
        for (int b_ = 0; b_ < 4; ++b_) {
#pragma unroll
            for (int a_ = 0; a_ < 4; ++a_)
#pragma unroll
                for (int r = 0; r < 4; ++r) cbase[(a_ * 16 * 64 + r * 64 + b_ * 16) + coff] = acc[a_][b_][r];
            float ns = nsum[b_]; ns += SHX(ns, 16, lane); ns += SHX(ns, 32, lane);
            if (g == 0) NLb[(size_t)u * 64 + b_ * 16 + col] = ns;
        }
    }
    __syncthreads();
}

__device__ __forceinline__ void phase_mlstm_carry(const Params& P, int l, unsigned char* smem, int wv, int bidx, int gdim) {
    ParamsPtr pp = PARAMS_PTR(P); PIN_S(pp); unsigned char* ws = pp->ws; PIN_S(bidx); PIN_S(gdim);
    float* CL = (float*)(ws + O_CL); float* NLb = (float*)(ws + O_NL); const float* ML = (const float*)(ws + O_ML); const float* BL = (const float*)(ws + O_BL);
    float* MIN = (float*)(ws + O_MIN);
    const int total = 2 * NB * MH * 4160;
    const int tid = phase_tid(wv);
    for (int gi = bidx * NTHREADS + tid; gi < total; gi += gdim * NTHREADS) {
        const int ph = gi / 4160, e = gi % 4160;
        float* base_ = e < 4096 ? CL + (size_t)ph * NCH * 4096 + e : NLb + (size_t)ph * NCH * 64 + (e - 4096);
        const int stride = e < 4096 ? 4096 : 64;
        static_assert(NCH <= 32, "carry scan keeps one chunk value per register");
        float loc[NCH], bl[NCH], ml[NCH];
#pragma unroll
        for (int c = 0; c < NCH; ++c) { loc[c] = base_[(size_t)c * stride]; bl[c] = BL[ph * NCH + c]; ml[c] = ML[ph * NCH + c]; }
        float m = 0.f, val = 0.f;
#pragma unroll
        for (int c = 0; c < NCH; ++c) {
            base_[(size_t)c * stride] = val;
            if (e == 0) MIN[ph * NCH + c] = m;
            const float mn = fmaxf(bl[c] + m, ml[c]);
            val = fexp(bl[c] + m - mn) * val + fexp(ml[c] - mn) * loc[c];
            m = mn;
        }
    }
}

__device__ __forceinline__ void phase_mlstm_out(const Params& P, int l, unsigned char* smem, int wv) {
    ParamsPtr pp = PARAMS_PTR(P); PIN_S(pp); unsigned char* ws = pp->ws; int bidx = (int)blockIdx.x, gdim = (int)gridDim.x; PIN_S(bidx); PIN_S(gdim);
    const bf16_t* proj = (const bf16_t*)(ws + O_PROJ);
    const bf16_t* MQB = (const bf16_t*)(ws + O_MQB); const bf16_t* MKB = (const bf16_t*)(ws + O_MKB); const bf16_t* VT = (const bf16_t*)(ws + O_VT);
    const float* GVT = (const float*)(ws + O_GVT); const float* PMX = (const float*)(ws + O_PMX); const float* BCT = (const float*)(ws + O_BCT);
    const float* CL = (const float*)(ws + O_CL); const float* NLb = (const float*)(ws + O_NL); const float* MIN = (const float*)(ws + O_MIN);
    bf16_t* GRP = (bf16_t*)(ws + O_GRP);
    const float* mln_g = pp->in[20] + (size_t)l * MW;
    const int tid = phase_tid(wv), lane = tid & 63, wave = tid >> 6, col = lane & 15, g = lane >> 4;
    constexpr int KP = 72, VP = 136;
    bf16_t* Ks = (bf16_t*)smem;
    bf16_t* Vs = Ks + 128 * KP;
    float* gvs_ = (float*)(Vs + 64 * VP);
    for (int u = bidx; u < NB * MH * NCH; u += gdim) {
        const int tc = u % NCH, h = (u / NCH) % MH, b = u / (NCH * MH);
        const int tok0 = b * S + tc * CH, it = wave * 16 + col;
        __syncthreads();
        {
            u32x4 kb_[2], vb_[2];
#pragma unroll
            for (int q = 0; q < 2; ++q) {
                const int idx = tid + q * NTHREADS;
                kb_[q] = *(const u32x4*)(MKB + (size_t)(tok0 + (idx >> 3)) * MW + h * 64 + (idx & 7) * 8);
                vb_[q] = *(const u32x4*)(VT + ((size_t)(b * MH + h) * 64 + (idx >> 4)) * S + (size_t)tc * CH + (idx & 15) * 8);
            }
            float gq_ = 0.f;
            if (tid < 256) gq_ = GVT[((size_t)(tid >> 7) * T + tok0 + (tid & 127)) * MH + h];
#pragma unroll
            for (int q = 0; q < 2; ++q) {
                const int idx = tid + q * NTHREADS;
                *(u32x4*)(Ks + (idx >> 3) * KP + (idx & 7) * 8) = kb_[q];
                *(u32x4*)(Vs + (idx >> 4) * VP + (idx & 15) * 8) = vb_[q];
            }
            if (tid < 256) gvs_[tid] = gq_;
        }
        __syncthreads();
        const size_t trow = (size_t)(tok0 + it);
        bf16x8 bq[2];
#pragma unroll
        for (int ks = 0; ks < 2; ++ks) bq[ks] = *(const bf16x8*)(MQB + trow * MW + h * 64 + ks * 32 + 8 * g);
        f32x4 hs[4];
#pragma unroll
        for (int et = 0; et < 4; ++et) hs[et] = (f32x4){0.f, 0.f, 0.f, 0.f};
#pragma unroll
        for (int d = 0; d < 2; ++d) {
            const int cd = d ? NCH - 1 - tc : tc;
            const int su = ((d * NB + b) * MH + h) * NCH + cd;
            const size_t gt = ((size_t)d * T + trow) * MH + h;
            const float mst = MIN[su];
            const float mxt = fmaxf(PMX[gt], mst), mt = BCT[gt] + mxt, wint = fexp(mst - mxt);
            f32x4 num[4];
#pragma unroll
            for (int et = 0; et < 4; ++et) num[et] = (f32x4){0.f, 0.f, 0.f, 0.f};
            float den = 0.f;
            for (int sp = 0; sp < 4; ++sp) {
                if (d == 0 ? (2 * sp > wave) : (2 * sp + 1 < wave)) continue;
                float pw[8];
#pragma unroll
                for (int hf = 0; hf < 2; ++hf) {
                    const int st = 2 * sp + hf;
                    f32x4 sacc = (f32x4){0.f, 0.f, 0.f, 0.f};
#pragma unroll
                    for (int ks = 0; ks < 2; ++ks) sacc = MFMA16(*(const bf16x8*)(Ks + (st * 16 + col) * KP + ks * 32 + 8 * g), bq[ks], sacc);
                    const f32x4 g4 = *(const f32x4*)(gvs_ + d * 128 + st * 16 + 4 * g);
#pragma unroll
                    for (int r = 0; r < 4; ++r) {
                        const int is = st * 16 + 4 * g + r;
                        const bool ok = d == 0 ? (is <= it) : (is >= it);
                        const float pr = ok ? sacc[r] * fexp(g4[r] - mxt) : 0.f;
                        den += pr; pw[hf * 4 + r] = pr;
                    }
                }
                u32x4 pb; pb.x = pk2(pw[0], pw[1]); pb.y = pk2(pw[2], pw[3]); pb.z = pk2(pw[4], pw[5]); pb.w = pk2(pw[6], pw[7]);
                const bf16x8 bp = __builtin_bit_cast(bf16x8, pb);
#pragma unroll
                for (int et = 0; et < 4; ++et) {
                    const bf16_t* vp = Vs + (et * 16 + col) * VP + sp * 32 + 4 * g;
                    const u32x2 v0 = *(const u32x2*)vp, v1 = *(const u32x2*)(vp + 16);
                    u32x4 va; va.x = v0.x; va.y = v0.y; va.z = v1.x; va.w = v1.y;
                    num[et] = MFMA16(__builtin_bit_cast(bf16x8, va), bp, num[et]);
                }
            }
            den += SHX(den, 16, lane); den += SHX(den, 32, lane);
            f32x4 qc[4]; float qn = 0.f;
#pragma unroll
            for (int ks = 0; ks < 2; ++ks) {
                const float* np = NLb + (size_t)su * 64 + ks * 32 + 8 * g;
                const f32x4 n0 = *(const f32x4*)np, n1 = *(const f32x4*)(np + 4);
                const u32x4 qb = __builtin_bit_cast(u32x4, bq[ks]);
                qn += (bf_lo(qb.x) * n0.x + bf_hi(qb.x) * n0.y) + (bf_lo(qb.y) * n0.z + bf_hi(qb.y) * n0.w) + (bf_lo(qb.z) * n1.x + bf_hi(qb.z) * n1.y) + (bf_lo(qb.w) * n1.z + bf_hi(qb.w) * n1.w);
            }
            qn += SHX(qn, 16, lane); qn += SHX(qn, 32, lane);
#pragma unroll
            for (int et = 0; et < 4; ++et) {
                qc[et] = (f32x4){0.f, 0.f, 0.f, 0.f};
#pragma unroll
                for (int ks = 0; ks < 2; ++ks) {
                    const float* cp = CL + (size_t)su * 4096 + (size_t)(et * 16 + col) * 64 + ks * 32 + 8 * g;
                    qc[et] = MFMA16(cvt8(*(const f32x4*)cp, *(const f32x4*)(cp + 4)), bq[ks], qc[et]);
                }
            }
            const float dd = frcp(fmaxf(fabsf(den + wint * qn), fexp(-mt)));
#pragma unroll
            for (int et = 0; et < 4; ++et) hs[et] += (num[et] + wint * qc[et]) * dd;
        }
        float sm = 0.f;
#pragma unroll
        for (int et = 0; et < 4; ++et) sm += (hs[et].x + hs[et].y) + (hs[et].z + hs[et].w);
        sm += SHX(sm, 16, lane); sm += SHX(sm, 32, lane);
        const float mean = sm * (1.0f / 64.0f); float q = 0.f;
#pragma unroll
        for (int et = 0; et < 4; ++et) { const f32x4 dl = hs[et] - mean; q += (dl.x * dl.x + dl.y * dl.y) + (dl.z * dl.z + dl.w * dl.w); }
        q += SHX(q, 16, lane); q += SHX(q, 32, lane);
        const float rstd = 1.0f / sqrtf(q * (1.0f / 64.0f) + LN_EPS);
#pragma unroll
        for (int et = 0; et < 4; ++et) {
            const int c = h * 64 + et * 16 + 4 * g;
            const u32x2 ob_ = *(const u32x2*)(proj + trow * PLD + C_MW + 3 * MW + c); const f32x4 o4 = (f32x4){bf_lo(ob_.x), bf_hi(ob_.x), bf_lo(ob_.y), bf_hi(ob_.y)}, g4 = *(const f32x4*)(mln_g + c);
            const f32x4 y = (hs[et] - mean) * rstd * g4;
            u32x2 ob; ob.x = pk2(sigmoidf_(o4.x) * y.x, sigmoidf_(o4.y) * y.y); ob.y = pk2(sigmoidf_(o4.z) * y.z, sigmoidf_(o4.w) * y.w);
            *(u32x2*)(GRP + trow * D + GW + RW + c) = ob;
        }
    }
    __syncthreads();
}

__device__ __forceinline__ void phase_rwkv_post(const Params& P, int l, unsigned char* smem, int wv) {
    ParamsPtr pp = PARAMS_PTR(P); PIN_S(pp); unsigned char* ws = pp->ws; int bidx = (int)blockIdx.x, gdim = (int)gridDim.x; PIN_S(bidx); PIN_S(gdim);
    const float* SCAN = (const float*)(ws + O_SCAN); const float* VV = (const float*)(ws + O_VV); const float* GATE = (const float*)(ws + O_GATE);
    const float* BONUS = (const float*)(ws + O_BONUS); bf16_t* GRP = (bf16_t*)(ws + O_GRP);
    const float* rln_g = pp->in[15] + (size_t)l * RW; const float* rln_b = pp->in[16] + (size_t)l * RW;
    const int tid = phase_tid(wv), lane = tid & 63, wave = tid >> 6;
    const int gw = bidx * NWAVES + wave, ngw = NWAVES * gdim;
    for (int it = gw; it < T * RH; it += ngw) {
        const int t = it / RH, h = it % RH, c = h * 64 + lane;
        const size_t o = (size_t)t * RW + c;
        const float x = SCAN[o] + SCAN[(size_t)T * RW + o];
        const float mean = wave_sum(x, lane) * (1.0f / 64.0f);
        const float dl = x - mean;
        const float var = wave_sum(dl * dl, lane) * (1.0f / 64.0f);
        float y = dl / sqrtf(var + GN_EPS) * rln_g[c] + rln_b[c];
        y += BONUS[(size_t)t * RH + h] * VV[o];
        GRP[(size_t)t * D + GW + c] = (bf16_t)f2bf(y * GATE[o]);
    }
}

__device__ __forceinline__ void phase_ln1_router(const Params& P, int l, unsigned char* smem, int wv) {
    ParamsPtr pp = PARAMS_PTR(P); PIN_S(pp); unsigned char* ws = pp->ws; int bidx = (int)blockIdx.x, gdim = (int)gridDim.x; PIN_S(bidx); PIN_S(gdim);
    const bf16_t* xin = (const bf16_t*)(ws + O_XB);
    const bf16_t* MIX = (const bf16_t*)(ws + O_MIX);
    int* TOPI = (int*)(ws + O_TOPI); float* TOPG = (float*)(ws + O_TOPG); int* RANK = (int*)(ws + O_RANK); bf16_t* X1B = (bf16_t*)(ws + O_X1B);
    int* BCNT = (int*)(ws + O_BCNT);
    const float* g1 = pp->in[22] + (size_t)l * D; const float* b1 = pp->in[23] + (size_t)l * D;
    const float* rw = pp->in[24] + (size_t)l * D * NE; const float* rb = pp->in[25] + (size_t)l * NE;
    const bf16_t* RWT = (const bf16_t*)(ws + O_RWT) + (size_t)l * 2 * NE * D;
    const int tid = phase_tid(wv), lane = tid & 63, wave = tid >> 6, col = lane & 15, g = lane >> 4;
    float* lgs = (float*)smem;
    int* stopi = (int*)(smem + 8192);
    for (int tile = bidx; tile < T / 64; tile += gdim) {
        __syncthreads();
        {
            u32x2 xa[4]; u32x2 xm[4];
#define LN1_LOAD(tt_) do { _Pragma("unroll") for (int j = 0; j < 4; ++j) { const int c = j * 256 + lane * 4; xa[j] = *(const u32x2*)(xin + (size_t)(tt_) * D + c); xm[j] = *(const u32x2*)(MIX + (size_t)(tt_) * D + c); } } while (0)
            LN1_LOAD(tile * 64 + wave * 8);
#pragma unroll 1
            for (int ti8 = 0; ti8 < 8; ++ti8) {
                const int t = tile * 64 + wave * 8 + ti8;
                float v[16]; float sm = 0.f;
#pragma unroll
                for (int j = 0; j < 4; ++j) {
                    v[j * 4 + 0] = ALPHA * bf_lo(xa[j].x) + bf_lo(xm[j].x); v[j * 4 + 1] = ALPHA * bf_hi(xa[j].x) + bf_hi(xm[j].x); v[j * 4 + 2] = ALPHA * bf_lo(xa[j].y) + bf_lo(xm[j].y); v[j * 4 + 3] = ALPHA * bf_hi(xa[j].y) + bf_hi(xm[j].y);
                    sm += (v[j * 4] + v[j * 4 + 1]) + (v[j * 4 + 2] + v[j * 4 + 3]);
                }
                if (ti8 < 7) LN1_LOAD(t + 1);
                const float mean = wave_sum_fast(sm, lane) * (1.0f / D); float q = 0.f;
#pragma unroll
                for (int j = 0; j < 16; ++j) { const float dl = v[j] - mean; q += dl * dl; }
                const float rstd = 1.0f / sqrtf(wave_sum_fast(q, lane) * (1.0f / D) + LN_EPS);
#pragma unroll
                for (int j = 0; j < 4; ++j) {
                    const int c = j * 256 + lane * 4;
                    const f32x4 gg = *(const f32x4*)(g1 + c), bb = *(const f32x4*)(b1 + c);
                    f32x4 o;
                    o.x = (v[j * 4 + 0] - mean) * rstd * gg.x + bb.x; o.y = (v[j * 4 + 1] - mean) * rstd * gg.y + bb.y;
                    o.z = (v[j * 4 + 2] - mean) * rstd * gg.z + bb.z; o.w = (v[j * 4 + 3] - mean) * rstd * gg.w + bb.w;
                    u32x2 ob; ob.x = pk2(o.x, o.y); ob.y = pk2(o.z, o.w); *(u32x2*)(X1B + (size_t)t * D + c) = ob;
                }
            }
#undef LN1_LOAD
        }
        __syncthreads();
        {
            const bf16_t* xr = X1B + (size_t)(tile * 64 + (wave >> 1) * 16 + col) * D + 8 * g;
            const bf16_t* wh = RWT + (size_t)((wave & 1) * 16 + col) * D + 8 * g; const bf16_t* wl = wh + (size_t)NE * D;
            f32x4 acc = (f32x4){0.f, 0.f, 0.f, 0.f};
#pragma unroll 4
            for (int ks = 0; ks < 32; ++ks) {
                const bf16x8 ah = *(const bf16x8*)(xr + ks * 32);
                const bf16x8 bh = *(const bf16x8*)(wh + ks * 32), bl = *(const bf16x8*)(wl + ks * 32);
                acc = MFMA16(ah, bh, acc); acc = MFMA16(ah, bl, acc);
            }
            const float rbv = rb[(wave & 1) * 16 + col];
#pragma unroll
            for (int r = 0; r < 4; ++r) lgs[((wave >> 1) * 16 + 4 * g + r) * NE + (wave & 1) * 16 + col] = acc[r] + rbv;
        }
        __syncthreads();
        if (tid < 64) {
            const float* lp = lgs + tid * NE; const int t = tile * 64 + tid;
            float tv[4]; int ti[4];
#pragma unroll
            for (int k = 0; k < 4; ++k) { tv[k] = -INFINITY; ti[k] = 0; }
            for (int e = 0; e < NE; ++e) {
                const float x = lp[e];
                if (x > tv[3]) {
                    if (x > tv[0]) { tv[3] = tv[2]; ti[3] = ti[2]; tv[2] = tv[1]; ti[2] = ti[1]; tv[1] = tv[0]; ti[1] = ti[0]; tv[0] = x; ti[0] = e; }
                    else if (x > tv[1]) { tv[3] = tv[2]; ti[3] = ti[2]; tv[2] = tv[1]; ti[2] = ti[1]; tv[1] = x; ti[1] = e; }
                    else if (x > tv[2]) { tv[3] = tv[2]; ti[3] = ti[2]; tv[2] = x; ti[2] = e; }
                    else { tv[3] = x; ti[3] = e; }
                }
            }
            const float e1 = expf(tv[1] - tv[0]), e2 = expf(tv[2] - tv[0]), e3 = expf(tv[3] - tv[0]);
            const float inv = 1.0f / (1.0f + e1 + e2 + e3);
            *(f32x4*)(TOPG + (size_t)t * 4) = (f32x4){inv, e1 * inv, e2 * inv, e3 * inv};
#pragma unroll
            for (int k = 0; k < 4; ++k) { TOPI[(size_t)t * 4 + k] = ti[k]; stopi[tid * 4 + k] = ti[k]; }
        }
        __syncthreads();
        if (tid < 256) { const int e = stopi[tid]; int r = 0; for (int a2 = 0; a2 < tid; ++a2) r += (stopi[a2] == e) ? 1 : 0; RANK[(size_t)tile * 256 + tid] = r; }
        else if (tid < 256 + NE) { const int e = tid - 256; int cnt = 0; for (int a2 = 0; a2 < 256; ++a2) cnt += (stopi[a2] == e) ? 1 : 0; BCNT[tile * NE + e] = cnt; }
    }
    __syncthreads();
}

__device__ __forceinline__ void moe_offsets(int* sh, const int* CNT, int tid) {
    if (tid == 0) {
        int acc = 0;
        for (int e = 0; e < NE; ++e) { const int c = (int)CNT[e]; sh[e] = c; sh[32 + e] = acc; acc += (c + MOEB - 1) / MOEB * MOEB; sh[64 + e] = acc; }
    }
    __syncthreads();
}
__device__ __forceinline__ int moe_expert_of_row(const int* sh, int r) {
    int e = -1;
    for (int i = 0; i < NE; ++i) if (r >= sh[32 + i] && r < sh[64 + i]) e = i;
    return e;
}

__device__ __forceinline__ void phase_scatter(const Params& P, int l, unsigned char* smem, int wv) {
    ParamsPtr pp = PARAMS_PTR(P); PIN_S(pp); unsigned char* ws = pp->ws; int bidx = (int)blockIdx.x, gdim = (int)gridDim.x; PIN_S(bidx); PIN_S(gdim);
    const int tid = phase_tid(wv);
    const int* TOPI = (const int*)(ws + O_TOPI); const int* RANK = (const int*)(ws + O_RANK); int* SLOT = (int*)(ws + O_SLOT); int* ROWT = (int*)(ws + O_ROWT);
    const int* BCNT = (const int*)(ws + O_BCNT); int* CNTF = (int*)(ws + O_CNTF);
    int* sh = (int*)smem;
    int* part = sh + 96;
    int* tot = part + 512;
    int* base = tot + 32;
    constexpr int NT = T / 64;
    const int e = tid & 31, pt = tid >> 5;
    { int sacc = 0; for (int tl = pt; tl < NT; tl += 16) sacc += BCNT[tl * NE + e]; part[pt * 32 + e] = sacc; }
    __syncthreads();
    if (tid < 32) { int sacc = 0; for (int q = 0; q < 16; ++q) sacc += part[q * 32 + tid]; tot[tid] = sacc; if (bidx == 0) CNTF[tid] = sacc; }
    __syncthreads();
    moe_offsets(sh, tot, tid);
    for (int ee = bidx; ee < NE; ee += gdim)
        for (int r = sh[32 + ee] + sh[ee] + tid; r < sh[64 + ee]; r += NTHREADS) ROWT[r] = 0;
    for (int tile = bidx; tile < NT; tile += gdim) {
        __syncthreads();
        { int sacc = 0; for (int tl = pt; tl < tile; tl += 16) sacc += BCNT[tl * NE + e]; part[pt * 32 + e] = sacc; }
        __syncthreads();
        if (tid < 32) { int sacc = sh[32 + tid]; for (int q = 0; q < 16; ++q) sacc += part[q * 32 + tid]; base[tid] = sacc; }
        __syncthreads();
        if (tid < 256) { const int a = tile * 256 + tid, dest = base[TOPI[a]] + RANK[a]; SLOT[a] = dest; ROWT[dest] = a >> 2; }
    }
    __syncthreads();
}

template <int WHICH>
__device__ __forceinline__ void phase_moe_gemm(const Params& P, int l, unsigned char* smem, int wv) {
    ParamsPtr pp = PARAMS_PTR(P); PIN_S(pp); unsigned char* ws = pp->ws; int bidx = (int)blockIdx.x, gdim = (int)gridDim.x; PIN_S(bidx); PIN_S(gdim);
    const int tid = phase_tid(wv);
    const int* CNT = (const int*)(ws + O_CNTF);
    int* sh = (int*)(smem + 131072);
    int* rbe = sh + 96;
    moe_offsets(sh, CNT, tid);
    const int nrb = sh[64 + NE - 1] / MOEB;
    for (int rb = tid; rb < nrb; rb += NTHREADS) rbe[rb] = moe_expert_of_row(sh, rb * MOEB);
    __syncthreads();
    pg8::MoeOrderT<WHICH == 1> S;
    S.K = 1024; S.G_ = gdim; S.c = bidx; S.rbe = rbe; S.rowmap = (const int*)(ws + O_ROWT);
    if (WHICH == 1) {
        S.A = (const char*)(ws + O_X1B); S.Wt = (const char*)(ws + O_W1) + (size_t)l * NE * 2 * DFF * D * 2; S.estride = (size_t)2 * DFF * D * 2; S.nN = 2 * DFF / 256; S.nwg = nrb * S.nN;
        pg8::EpiSwiglu E{(bf16_t*)(ws + O_ACT), pp->in[27] + (size_t)l * NE * 2 * DFF};
        pg8::gemm_phase<pg8::EpiSwiglu, pg8::MoeOrderT<WHICH == 1>>((LAS unsigned char*)smem, 1024, S, E, tid);
    } else {
        S.A = (const char*)(ws + O_ACT); S.Wt = (const char*)(ws + O_W2) + (size_t)l * NE * D * DFF * 2; S.estride = (size_t)D * DFF * 2; S.nN = D / 256; S.nwg = nrb * S.nN;
        pg8::EpiBf16Bias E{(bf16_t*)(ws + O_YS), D, pp->in[29] + (size_t)l * NE * D, D};
        pg8::gemm_phase<pg8::EpiBf16Bias, pg8::MoeOrderT<WHICH == 1>>((LAS unsigned char*)smem, 1024, S, E, tid);
    }
    __syncthreads();
}

__device__ __forceinline__ void phase_combine_ln2(const Params& P, int l, unsigned char* smem, int wv) {
    ParamsPtr pp = PARAMS_PTR(P); PIN_S(pp); unsigned char* ws = pp->ws; int bidx = (int)blockIdx.x, gdim = (int)gridDim.x; PIN_S(bidx); PIN_S(gdim);
    const bf16_t* X1 = (const bf16_t*)(ws + O_X1B); const bf16_t* YS = (const bf16_t*)(ws + O_YS); bf16_t* XB = (bf16_t*)(ws + O_XB);
    const int* SLOT = (const int*)(ws + O_SLOT); const float* TOPG = (const float*)(ws + O_TOPG);
    float* xo = pp->out;
    const float* g2 = pp->in[30] + (size_t)l * D; const float* b2 = pp->in[31] + (size_t)l * D;
    const int tid = phase_tid(wv), lane = tid & 63, wave = tid >> 6;
    const int gw = bidx * NWAVES + wave, ngw = NWAVES * gdim;
    u32x4 sl_n = (u32x4){0u, 0u, 0u, 0u}; f32x4 gg_n = (f32x4){0.f, 0.f, 0.f, 0.f};
    u32x2 xa_n[4]; u32x2 ys_n[4][4]; f32x4 gg_c = (f32x4){0.f, 0.f, 0.f, 0.f};
    const f32x4 lg[4] = {*(const f32x4*)(g2 + lane * 4), *(const f32x4*)(g2 + 256 + lane * 4), *(const f32x4*)(g2 + 512 + lane * 4), *(const f32x4*)(g2 + 768 + lane * 4)};
    const f32x4 lb[4] = {*(const f32x4*)(b2 + lane * 4), *(const f32x4*)(b2 + 256 + lane * 4), *(const f32x4*)(b2 + 512 + lane * 4), *(const f32x4*)(b2 + 768 + lane * 4)};
#define CB_META(tt_) do { sl_n = *(const u32x4*)(SLOT + (size_t)(tt_) * 4); gg_n = *(const f32x4*)(TOPG + (size_t)(tt_) * 4); } while (0)
#define CB_ROWS(tt_) do { _Pragma("unroll") for (int j = 0; j < 4; ++j) { const int c = j * 256 + lane * 4; xa_n[j] = *(const u32x2*)(X1 + (size_t)(tt_) * D + c); \
        ys_n[0][j] = *(const u32x2*)(YS + (size_t)sl_n.x * D + c); ys_n[1][j] = *(const u32x2*)(YS + (size_t)sl_n.y * D + c); ys_n[2][j] = *(const u32x2*)(YS + (size_t)sl_n.z * D + c); ys_n[3][j] = *(const u32x2*)(YS + (size_t)sl_n.w * D + c); } gg_c = gg_n; } while (0)
    if (gw < T) { CB_META(gw); CB_ROWS(gw); if (gw + ngw < T) CB_META(gw + ngw); }
    for (int t = gw; t < T; t += ngw) {
        float v[16]; float sm = 0.f;
        const float gk[4] = {gg_c.x, gg_c.y, gg_c.z, gg_c.w};
#pragma unroll
        for (int j = 0; j < 4; ++j) {
            const f32x4 a = (f32x4){bf_lo(xa_n[j].x), bf_hi(xa_n[j].x), bf_lo(xa_n[j].y), bf_hi(xa_n[j].y)};
            f32x4 y = (f32x4){0.f, 0.f, 0.f, 0.f};
#pragma unroll
            for (int k = 0; k < 4; ++k) { const u32x2 yk = ys_n[k][j]; y.x += gk[k] * bf_lo(yk.x); y.y += gk[k] * bf_hi(yk.x); y.z += gk[k] * bf_lo(yk.y); y.w += gk[k] * bf_hi(yk.y); }
            v[j * 4 + 0] = ALPHA * a.x + y.x; v[j * 4 + 1] = ALPHA * a.y + y.y; v[j * 4 + 2] = ALPHA * a.z + y.z; v[j * 4 + 3] = ALPHA * a.w + y.w;
            sm += (v[j * 4] + v[j * 4 + 1]) + (v[j * 4 + 2] + v[j * 4 + 3]);
        }
        if (t + ngw < T) { CB_ROWS(t + ngw); if (t + 2 * ngw < T) CB_META(t + 2 * ngw); }
        const float mean = wave_sum_fast(sm, lane) * (1.0f / D); float q = 0.f;
#pragma unroll
        for (int j = 0; j < 16; ++j) { const float dl = v[j] - mean; q += dl * dl; }
        const float rstd = 1.0f / sqrtf(wave_sum_fast(q, lane) * (1.0f / D) + LN_EPS);
#pragma unroll
        for (int j = 0; j < 4; ++j) {
            const int c = j * 256 + lane * 4;
            f32x4 o;
            o.x = (v[j * 4 + 0] - mean) * rstd * lg[j].x + lb[j].x; o.y = (v[j * 4 + 1] - mean) * rstd * lg[j].y + lb[j].y;
            o.z = (v[j * 4 + 2] - mean) * rstd * lg[j].z + lb[j].z; o.w = (v[j * 4 + 3] - mean) * rstd * lg[j].w + lb[j].w;
            if (l == NL - 1) *(f32x4*)(xo + (size_t)t * D + c) = o;
            else { u32x2 ob; ob.x = pk2(o.x, o.y); ob.y = pk2(o.z, o.w); *(u32x2*)(XB + (size_t)t * D + c) = ob; }
        }
    }
#undef CB_META
#undef CB_ROWS
}

__device__ __forceinline__ void phase_inproj(const Params& P, int l, unsigned char* smem, int wv) {
    ParamsPtr pp = PARAMS_PTR(P); PIN_S(pp); unsigned char* ws = pp->ws; int bidx = (int)blockIdx.x, gdim = (int)gridDim.x; PIN_S(bidx); PIN_S(gdim);
    const int tid = phase_tid(wv);
    pg8::DenseOrder S; S.init(ws + O_XB, (const bf16_t*)(ws + O_WIN) + (size_t)l * PLD * D, T, PLD, D, gdim, bidx);
    pg8::EpiProj E{(bf16_t*)(ws + O_PROJ), PLD, (float*)(ws + O_PROJG), PLD / 256 - 1};
    pg8::gemm_phase<pg8::EpiProj, pg8::DenseOrder>((LAS unsigned char*)smem, D, S, E, tid);
    __syncthreads();
}
__device__ __forceinline__ void phase_outproj(const Params& P, int l, unsigned char* smem, int wv) {
    ParamsPtr pp = PARAMS_PTR(P); PIN_S(pp); unsigned char* ws = pp->ws; int bidx = (int)blockIdx.x, gdim = (int)gridDim.x; PIN_S(bidx); PIN_S(gdim);
    const int tid = phase_tid(wv);
    pg8::DenseOrder S; S.init(ws + O_GRP, (const bf16_t*)(ws + O_WOUT) + (size_t)l * D * D, T, D, D, gdim, bidx);
    pg8::EpiProj E{(bf16_t*)(ws + O_MIX), D, nullptr, -1};
    pg8::gemm_phase<pg8::EpiProj, pg8::DenseOrder>((LAS unsigned char*)smem, D, S, E, tid);
    __syncthreads();
}

#ifndef EMU
#define XB_TMO      128
#define XB_XCNT(j)  (256  + 64 * (j))
#define XB_XSUB(j)  (1280 + 64 * (j))
#define XB_XGEN(j)  (2304 + 64 * (j))
#define XB_TOP      3328
#define XB_TOPGEN   3392
#define XCD_BAR_WORDS 3456
#define XB_SPIN_CAP (1u << 25)
__device__ __forceinline__ unsigned xb_ld(unsigned* p)              { return __hip_atomic_load(p, __ATOMIC_RELAXED, __HIP_MEMORY_SCOPE_AGENT); }
__device__ __forceinline__ unsigned xb_add(unsigned* p, unsigned v) { return __hip_atomic_fetch_add(p, v, __ATOMIC_RELAXED, __HIP_MEMORY_SCOPE_AGENT); }
__device__ __forceinline__ unsigned xb_xcc_id() { return (unsigned)__builtin_amdgcn_s_getreg((3 << 11) | 20) & 0xFu; }
#define XB_SPIN(cond, bar) do { unsigned _sp = 0; while (cond) { __builtin_amdgcn_s_sleep(1); \
    if ((++_sp & 255u) == 0u) { if (xb_ld(&(bar)[XB_TMO])) break; if (_sp > XB_SPIN_CAP) { atomicAdd(&(bar)[XB_TMO], 1u); break; } } } } while (0)
struct XcdBarrier { unsigned* bar; unsigned x; volatile LAS unsigned* st; };
__device__ __forceinline__ XcdBarrier xcd_barrier_post(unsigned* bar, volatile LAS unsigned* st) {
    XcdBarrier b; b.bar = bar; b.x = xb_xcc_id(); b.st = st;
    if (threadIdx.x == 0) (void)xb_add(&bar[XB_XCNT(b.x)], 1u);
    return b;
}
__device__ __forceinline__ void xcd_barrier_complete(unsigned* bar, unsigned x, unsigned& nloc, unsigned& nx) {
    const unsigned G = gridDim.x * gridDim.y * gridDim.z;
    unsigned sum, cnt, mine, sp = 0u;
    for (;;) {
        sum = 0u; cnt = 0u; mine = 0u;
#pragma unroll
        for (unsigned j = 0; j < 16; ++j) { const unsigned c = xb_ld(&bar[XB_XCNT(j)]); sum += c; cnt += (c > 0u) ? 1u : 0u; mine = (j == x) ? c : mine; }
        if (sum == G) break;
        __builtin_amdgcn_s_sleep(1);
        if ((++sp & 255u) == 0u) { if (xb_ld(&bar[XB_TMO])) break; if (sp > XB_SPIN_CAP) { atomicAdd(&bar[XB_TMO], 1u); break; } }
    }
    nloc = mine > 0u ? mine : 1u; nx = cnt > 0u ? cnt : 1u;
}
__device__ __forceinline__ void xcd_barrier(const XcdBarrier& b) {
    asm volatile("s_waitcnt vmcnt(0)" ::: "memory");
    __syncthreads();
    if (threadIdx.x == 0) {
        unsigned* bar = b.bar;
        __builtin_amdgcn_s_waitcnt(0);
        unsigned nloc = b.st[0], nx = b.st[1];
        if (nloc == 0u) { xcd_barrier_complete(bar, b.x, nloc, nx); b.st[0] = nloc; b.st[1] = nx; }
        const unsigned old = xb_add(&bar[XB_XSUB(b.x)], 1u);
        const unsigned gen = old / nloc;
        if (old + 1u == (gen + 1u) * nloc) {
            __builtin_amdgcn_fence(__ATOMIC_RELEASE, "agent");
            asm volatile("s_waitcnt vmcnt(0)" ::: "memory");
            const unsigned og = xb_add(&bar[XB_TOP], 1u);
            const unsigned tg = og / nx;
            if (og + 1u == (tg + 1u) * nx) xb_add(&bar[XB_TOPGEN], 1u);
            else XB_SPIN(xb_ld(&bar[XB_TOPGEN]) == tg, bar);
            __builtin_amdgcn_fence(__ATOMIC_ACQUIRE, "agent");
            xb_add(&bar[XB_XGEN(b.x)], 1u);
            asm volatile("s_waitcnt vmcnt(0)" ::: "memory");
        } else {
            XB_SPIN(xb_ld(&bar[XB_XGEN(b.x)]) == gen, bar);
            __builtin_amdgcn_fence(__ATOMIC_ACQUIRE, "agent");
            asm volatile("s_waitcnt vmcnt(0)" ::: "memory");
        }
    }
    __syncthreads();
}
#endif

__global__ void __launch_bounds__(512, 2) mk_fwd(Params P) {
#ifdef EMU
    unsigned char* smem = g_blk->lds;
#else
    extern __shared__ __attribute__((aligned(16))) unsigned char smem[];
    volatile LAS unsigned* bst = (volatile LAS unsigned*)(smem + LDS_BYTES - 16);
    if (threadIdx.x == 0) { bst[0] = 0u; bst[1] = 0u; bst[2] = 0u; bst[3] = 0u; }
    __syncthreads();
    XcdBarrier bar; bar.bar = (unsigned*)P.ws + CW_BAR; bar.x = 0; bar.st = bst;
    if (P.ph_hi - P.ph_lo > 1) bar = xcd_barrier_post((unsigned*)P.ws + CW_BAR, bst);
#endif
    const int lo = P.ph_lo, hi = P.ph_hi;
#ifdef EMU
    const int wv = (int)threadIdx.x >> 6;
#else
    const int wv = RFL((int)threadIdx.x >> 6);
#endif
#ifdef EMU
#define SEAM(id) do {} while (0)
#else
#define SEAM(id) do { if ((id) + 1 < hi) xcd_barrier(bar); } while (0)
#endif
#ifndef MK_ONLY_PHASE
#define MK_ONLY_PHASE -1
#endif
#ifndef MK_DUP_MASK
#define MK_DUP_MASK 0
#endif
#define PHG(kc, id, ...) do { if (MK_ONLY_PHASE < 0 || MK_ONLY_PHASE == (kc)) { const int id_ = (id); if (id_ >= lo && id_ < hi) { if ((MK_DUP_MASK >> (kc)) & 1) { __VA_ARGS__; SEAM(id_ - 1); } __VA_ARGS__; SEAM(id_); } } } while (0)
#define PH(k, ...) PHG(1 + (k), 1 + l * NPH + (k), __VA_ARGS__)
    PHG(0, 0, phase_prologue(P, smem, wv));
    for (int l = 0; l < NL; ++l) {
        PH(0, phase_inproj(P, l, smem, wv));
#if MK_RWKV_CHUNKED
        PH(1, phase_prep32(P, l, smem, wv));
#else
        PH(1, phase_prep(P, l, smem, wv));
#endif
#if MK_RWKV_CHUNKED
        PH(2, { phase_rwkv_pre(P, l, smem, wv); phase_mlstm_local(P, l, smem, wv, (int)blockIdx.x, (int)gridDim.x); });
        PH(3, { const int G_ = (int)gridDim.x;
                if (G_ >= 2 * RSEQ_WGS) { if ((int)blockIdx.x < RSEQ_WGS) { phase_rwkv_seq(P, l, smem, wv); if (MK_PROBE >= 30 && MK_PROBE < 38) phase_rwkv_seq<MK_PROBE >= 30 && MK_PROBE < 38 ? MK_PROBE - 30 : 0>(P, l, smem, wv); }
                                           else { phase_mlstm_carry(P, l, smem, wv, (int)blockIdx.x - RSEQ_WGS, G_ - RSEQ_WGS); phase_gmlp_mix(P, l, smem, wv, (int)blockIdx.x - RSEQ_WGS, G_ - RSEQ_WGS);
                                                  if (MK_PROBE == 39) phase_gmlp_mix(P, l, smem, wv, (int)blockIdx.x - RSEQ_WGS, G_ - RSEQ_WGS); } }
                else { phase_rwkv_seq(P, l, smem, wv); phase_mlstm_carry(P, l, smem, wv, (int)blockIdx.x, G_); } });
        PH(4, { phase_rwkv_out(P, l, smem, wv); phase_mlstm_out(P, l, smem, wv); if ((int)gridDim.x < 2 * RSEQ_WGS) phase_gmlp_mix(P, l, smem, wv, (int)blockIdx.x, (int)gridDim.x); });
#else
        PH(2, { const int G_ = (int)gridDim.x, NSC = 2 * NB * RH * 4;
                if (G_ >= NSC + 32) { if ((int)blockIdx.x < NSC) phase_rwkv_scan(P, l, smem, wv, (int)blockIdx.x, NSC);
                                      else phase_mlstm_local(P, l, smem, wv, (int)blockIdx.x - NSC, G_ - NSC); }
                else { phase_rwkv_scan(P, l, smem, wv, (int)blockIdx.x, G_); phase_mlstm_local(P, l, smem, wv, (int)blockIdx.x, G_); } });
        PH(3, phase_mlstm_carry(P, l, smem, wv, (int)blockIdx.x, (int)gridDim.x));
        PH(4, { phase_mlstm_out(P, l, smem, wv); phase_gmlp_mix(P, l, smem, wv, (int)blockIdx.x, (int)gridDim.x); phase_rwkv_post(P, l, smem, wv); });
#endif
        PH(5, phase_outproj(P, l, smem, wv));
        PH(6, phase_ln1_router(P, l, smem, wv));
        PH(7, phase_scatter(P, l, smem, wv));
        PH(8, phase_moe_gemm<1>(P, l, smem, wv));
        PH(9, phase_moe_gemm<2>(P, l, smem, wv));
        PH(10, phase_combine_ln2(P, l, smem, wv));
    }
#undef PHG
#undef PH
#undef SEAM
}

}

#ifndef EMU
extern "C" void kernel_launch(void* const* d_in, const int* in_sizes, int n_in, void* d_out, int out_size, void* d_ws, size_t ws_size, hipStream_t stream) {
    using namespace mk;
    static int grid = 0;
    if (grid == 0) {
        if (n_in != 32 || out_size != T * D || ws_size < WS_END) { fprintf(stderr, "kernel_launch: unexpected shapes (n_in %d out %d ws %zu need %zu)\n", n_in, out_size, ws_size, (size_t)WS_END); grid = -1; return; }
        int dev = 0, cus = 0;
        if (hipGetDevice(&dev) != hipSuccess || hipDeviceGetAttribute(&cus, hipDeviceAttributeMultiprocessorCount, dev) != hipSuccess) { grid = -1; return; }
        if (hipFuncSetAttribute((const void*)mk_fwd, hipFuncAttributeMaxDynamicSharedMemorySize, LDS_BYTES) != hipSuccess) { fprintf(stderr, "kernel_launch: hipFuncSetAttribute failed\n"); grid = -1; return; }
        int per_cu = 0;
        (void)hipOccupancyMaxActiveBlocksPerMultiprocessor(&per_cu, (const void*)mk_fwd, NTHREADS, LDS_BYTES);
        (void)hipGetLastError();
        grid = cus;
    }
    if (grid < 0) return;
    (void)hipMemsetAsync(d_ws, 0, CTL_BYTES, stream);
    Params p{};
    for (int i = 0; i < 32; ++i) p.in[i] = (const float*)d_in[i];
    p.out = (float*)d_out; p.ws = (unsigned char*)d_ws;
#if MK_ONE_LAUNCH
    p.ph_lo = 0; p.ph_hi = 1 + NL * NPH;
    hipLaunchKernelGGL(mk_fwd, dim3(grid), dim3(NTHREADS), LDS_BYTES, stream, p);
#else
    for (int id = 0; id < 1 + NL * NPH; ++id) {
        p.ph_lo = id; p.ph_hi = id + 1;
        hipLaunchKernelGGL(mk_fwd, dim3(grid), dim3(NTHREADS), LDS_BYTES, stream, p);
    }
#endif
}
#endif
```

```cpp
#ifndef EMU
#include <hip/hip_runtime.h>
#endif
#include <cstdio>
#include <cstdint>
#include <cmath>

#ifndef CFG_BATCH
#define CFG_BATCH 4
#endif
#ifndef CFG_SEQ
#define CFG_SEQ 4096
#endif
#ifndef CFG_LAYERS
#define CFG_LAYERS 4
#endif
#ifndef MK_RWKV_CHUNKED
#define MK_RWKV_CHUNKED 1
#endif
#ifndef MK_PROBE
#define MK_PROBE 0
#endif
#ifndef MK_SP2
#define MK_SP2 1
#endif
#ifndef MK_ONE_LAUNCH
#define MK_ONE_LAUNCH 1
#endif

namespace mk {
constexpr int NB = CFG_BATCH, S = CFG_SEQ, T = NB * S, NL = CFG_LAYERS, D = 1024;
constexpr int GW = 256, RW = 384, MW = 384, HD = 64, GH = 4, RH = 6, MH = 6, CH = 128, NCH = S / CH;
constexpr int PIN = 3480, PLD = 3584, RPROJ = 1408;
constexpr int C_RW = 512, C_MW = 1920;
constexpr int NE = 32, TOPK = 4, DFF = 1024, MOEB = 256;
constexpr int NROWS = (T * TOPK / MOEB + NE) * MOEB;
constexpr float LN_EPS = 1e-5f, GN_EPS = 64e-5f;
constexpr float ALPHA = 1.6817928305074290f;
constexpr int NTHREADS = 512, NWAVES = 8;
constexpr int LDS_BYTES = 160 * 1024;
constexpr int NPH = 11;

typedef float f32x4 __attribute__((ext_vector_type(4)));
typedef unsigned u32x4 __attribute__((ext_vector_type(4)));
typedef unsigned u32x2 __attribute__((ext_vector_type(2)));
typedef short bf16x8 __attribute__((ext_vector_type(8)));
typedef unsigned short bf16_t;

constexpr size_t al(size_t x) { return (x + 255) & ~(size_t)255; }
constexpr size_t CTL_BYTES = 1u << 20;
constexpr size_t O_XA = CTL_BYTES;
constexpr size_t O_CLB = O_XA;
constexpr size_t O_XB = O_XA + al((size_t)T * D * 4);
constexpr size_t O_X1 = O_XB + al((size_t)T * D * 2);
constexpr size_t O_X1B = O_X1 + al((size_t)T * D * 4);
constexpr size_t O_PROJ = O_X1B + al((size_t)T * D * 2);
constexpr size_t O_PROJG = O_PROJ + al((size_t)T * PLD * 2);
constexpr size_t O_MIX = O_PROJ + al((size_t)T * PLD * 4);
constexpr size_t O_GRP = O_MIX + al((size_t)T * D * 4);
constexpr size_t O_UG = O_GRP + al((size_t)T * D * 2);
constexpr size_t O_VN = O_UG + al((size_t)T * GW * 4);
constexpr size_t O_RR = O_VN + al((size_t)T * GW * 4);
constexpr size_t O_VV = O_RR + al((size_t)T * RW * 4);
constexpr size_t O_KK = O_VV + al((size_t)T * RW * 4);
constexpr size_t O_DEC = O_KK + al((size_t)T * RW * 4);
constexpr size_t O_KD = O_DEC + al((size_t)2 * T * RW * 4);
constexpr size_t O_ICLR = O_KD + al((size_t)2 * T * RW * 4);
constexpr size_t O_GATE = O_ICLR + al((size_t)2 * T * RW * 4);
constexpr size_t O_BONUS = O_GATE + al((size_t)T * RW * 4);
constexpr size_t O_SCAN = O_BONUS + al((size_t)T * RH * 4);
constexpr size_t O_MQ = O_SCAN + al((size_t)2 * T * RW * 4);
constexpr size_t O_MK = O_MQ + al((size_t)T * MW * 4);
constexpr size_t O_IG = O_MK + al((size_t)T * MW * 4);
constexpr size_t O_LF = O_IG + al((size_t)2 * T * MH * 4);
constexpr size_t O_CL = O_LF + al((size_t)2 * T * MH * 4);
constexpr size_t O_NL = O_CL + al((size_t)2 * NB * MH * NCH * 4096 * 4);
constexpr size_t O_ML = O_NL + al((size_t)2 * NB * MH * NCH * 64 * 4);
constexpr size_t O_BL = O_ML + al((size_t)2 * NB * MH * NCH * 4);
constexpr size_t O_MIN = O_BL + al((size_t)2 * NB * MH * NCH * 4);
constexpr size_t O_TOPI = O_MIN + al((size_t)2 * NB * MH * NCH * 4);
constexpr size_t O_TOPG = O_TOPI + al((size_t)T * 4 * 4);
constexpr size_t O_RANK = O_TOPG + al((size_t)T * 4 * 4);
constexpr size_t O_SLOT = O_RANK + al((size_t)T * 4 * 4);
constexpr size_t O_MQB = O_SLOT + al((size_t)T * 4 * 4);
constexpr size_t O_MKB = O_MQB + al((size_t)T * MW * 2);
constexpr size_t O_KT = O_MKB + al((size_t)T * MW * 2);
constexpr size_t O_VT = O_KT + al((size_t)T * MW * 2);
constexpr size_t O_GVT = O_VT + al((size_t)T * MW * 2);
constexpr size_t O_PMX = O_GVT + al((size_t)2 * T * MH * 4);
constexpr size_t O_BCT = O_PMX + al((size_t)2 * T * MH * 4);
constexpr size_t O_BRKR = O_BCT + al((size_t)2 * T * MH * 4);
constexpr int RC = 64, RNC = S / RC, RUN = 2 * NB * RH * RNC;
constexpr size_t O_LW = O_BRKR + al((size_t)2 * T * RH * 2 * 4);
constexpr size_t O_RQ = O_LW + al((size_t)2 * T * RW * 4);
constexpr size_t O_RA = O_RQ + al((size_t)RUN * 4096 * 2);
constexpr size_t O_RS = O_RA + al((size_t)RUN * 4096 * 2);
constexpr size_t O_RH = O_RS + al((size_t)RUN * 4096 * 2);
constexpr size_t O_RG = O_RH + al((size_t)RUN * 4096 * 4);
constexpr size_t O_RB = O_RG + al((size_t)RUN * 4096 * 4);
constexpr size_t O_VB = O_RB + al((size_t)T * RW * 2);
constexpr size_t O_KKB = O_VB + al((size_t)T * RW * 2);
constexpr size_t O_BBB = O_KKB + al((size_t)T * RW * 2);
constexpr size_t O_KDB = O_BBB + al((size_t)2 * T * RW * 2);
constexpr size_t O_RK7 = O_KDB + al((size_t)2 * T * RW * 2);
constexpr size_t O_VNT = O_RK7 + al((size_t)T * RW * 16);
constexpr size_t O_WSB = O_VNT + al((size_t)T * GW * 2);
constexpr size_t O_LWT = O_WSB + al((size_t)NL * GH * CH * CH * 2);
constexpr size_t O_RWT = O_LWT + al((size_t)NL * 1920 * 128 * 2);
constexpr size_t O_BCNT = O_RWT + al((size_t)NL * 2 * NE * D * 2);
constexpr size_t O_CNTF = O_BCNT + al((size_t)(T / 64) * NE * 4);
constexpr size_t O_ROWT = O_CNTF + al((size_t)NE * 4);
constexpr size_t O_XS = O_ROWT + al((size_t)NROWS * 4);
constexpr size_t O_ACT = O_XS + al((size_t)NROWS * D * 2);
constexpr size_t O_YS = O_ACT + al((size_t)NROWS * DFF * 2);
constexpr size_t O_WIN = O_YS + al((size_t)NROWS * D * 2);
constexpr size_t O_WOUT = O_WIN + al((size_t)NL * PLD * D * 2);
constexpr size_t O_W1 = O_WOUT + al((size_t)NL * D * D * 2);
constexpr size_t O_W2 = O_W1 + al((size_t)NL * NE * 2 * DFF * D * 2);
constexpr size_t WS_END = O_W2 + al((size_t)NL * NE * D * DFF * 2);

constexpr int CW_BAR = 4096;
constexpr int CW_CNT = 16384;

struct Params { const float* in[32]; float* out; unsigned char* ws; int ph_lo, ph_hi; };
#ifdef EMU
typedef const Params* ParamsPtr;
#define PARAMS_PTR(P) (&(P))
#else
typedef const __attribute__((address_space(4))) Params* ParamsPtr;
#define PARAMS_PTR(P) ((ParamsPtr)__builtin_amdgcn_kernarg_segment_ptr())
#endif

#ifdef EMU
#define WAVE_SYNC() emu_wave_barrier()
#define PIN_V(x) do {} while (0)
#define PIN_S(x) do {} while (0)
#else
#define WAVE_SYNC() __builtin_amdgcn_wave_barrier()
#define PIN_V(x) asm volatile("" : "+v"(x))
#define PIN_S(x) asm volatile("" : "+s"(x))
#endif
#ifdef EMU
__device__ __forceinline__ int phase_tid(int wv) { (void)wv; return threadIdx.x; }
#else
__device__ __forceinline__ int phase_tid(int wv) { int t; asm volatile("v_mbcnt_lo_u32_b32 %0, -1, 0\n\tv_mbcnt_hi_u32_b32 %0, -1, %0" : "=v"(t)); return (wv << 6) + t; }
#endif

#ifdef EMU
#define SHX(v, m, lane) __shfl_xor(v, m)
#else
__device__ __forceinline__ float shx_(float v, int m, int lane) { return __builtin_bit_cast(float, __builtin_amdgcn_ds_bpermute((lane ^ m) << 2, __builtin_bit_cast(int, v))); }
__device__ __forceinline__ int shx_(int v, int m, int lane) { return __builtin_amdgcn_ds_bpermute((lane ^ m) << 2, v); }
#define SHX(v, m, lane) shx_(v, m, lane)
#endif
#ifdef EMU
#define SHUP(v, o, lane) __shfl(v, ((lane) - (o)) & 63)
#define RDL(v, src) __shfl(v, src)
#define SHL(v, src) __shfl(v, src)
#else
#define SHL(v, src) __builtin_bit_cast(float, __builtin_amdgcn_ds_bpermute((src) << 2, __builtin_bit_cast(int, (float)(v))))
#define SHUP(v, o, lane) __builtin_bit_cast(float, __builtin_amdgcn_ds_bpermute((((lane) - (o)) & 63) << 2, __builtin_bit_cast(int, (float)(v))))
#define RDL(v, src) __builtin_bit_cast(float, __builtin_amdgcn_readlane(__builtin_bit_cast(int, (float)(v)), src))
#endif
__device__ __forceinline__ float wave_sum(float v, int lane) {
#pragma unroll
    for (int o = 32; o >= 1; o >>= 1) v += SHX(v, o, lane);
    return v;
}
#ifdef EMU
__device__ __forceinline__ float fexp(float x) { return expf(x); }
__device__ __forceinline__ float flog(float x) { return logf(x); }
__device__ __forceinline__ float frcp(float x) { return 1.0f / x; }
#else
__device__ __forceinline__ float fexp(float x) { return __builtin_amdgcn_exp2f(x * 1.4426950408889634f); }
__device__ __forceinline__ float flog(float x) { return __builtin_amdgcn_logf(x) * 0.6931471805599453f; }
__device__ __forceinline__ float frcp(float x) { return __builtin_amdgcn_rcpf(x); }
#endif
__device__ __forceinline__ float sigmoidf_(float x) { return frcp(1.0f + fexp(-x)); }
__device__ __forceinline__ float softplusf_(float x) { return fmaxf(x, 0.f) + flog(1.0f + fexp(-fabsf(x))); }
__device__ __forceinline__ float ftanh(float x) { return 1.0f - 2.0f * frcp(1.0f + fexp(2.0f * x)); }
__device__ __forceinline__ float geluf_(float v) {
    const float av = fabsf(v), t = frcp(1.0f + 0.2316418882f * av);
    float q = t * 0.5307027145f + (-0.7265760135f); q = q * t + 0.7107068705f; q = q * t + (-0.142248368f); q = q * t + 0.127414796f; q = q * t;
    const float m = v * (q * fexp(-0.5f * v * v));
    return v < 0.f ? m : v - m;
}

#ifdef EMU
#define LAS
#define WAIT_V(n) do {} while (0)
#define WAIT_L(n) do {} while (0)
#define S_BARRIER() __syncthreads()
#define SETPRIO(x) do {} while (0)
#define SCHED_BAR() do {} while (0)
#define RFL(x) (x)
static inline void emu_glds16(const void* g, void* l) { memcpy((char*)l + (g_blk->cur & 63) * 16, g, 16); }
#define GLDS16(gptr, ldsptr) emu_glds16((const void*)(gptr), (void*)(ldsptr))
static inline float emu_bf2f(unsigned short b) { unsigned u = (unsigned)b << 16; float f; memcpy(&f, &u, 4); return f; }
static inline f32x4 emu_mfma16(bf16x8 a, bf16x8 b, f32x4 c) {
    EmuBlock* blk = g_blk; const int cur = blk->cur, lane = cur & 63, wbase = cur & ~63;
    static thread_local unsigned short Ash[32][64][8], Bsh[32][64][8];
    const int w = cur >> 6;
    for (int j = 0; j < 8; ++j) { Ash[w][lane][j] = (unsigned short)a[j]; Bsh[w][lane][j] = (unsigned short)b[j]; }
    emu_wave_barrier();
    const int col = lane & 15;
    for (int r = 0; r < 4; ++r) { const int row = 4 * (lane >> 4) + r; float sum = c[r];
        for (int k = 0; k < 32; ++k) sum += emu_bf2f(Ash[w][row + 16 * (k >> 3)][k & 7]) * emu_bf2f(Bsh[w][col + 16 * (k >> 3)][k & 7]);
        c[r] = sum; }
    emu_wave_barrier(); (void)wbase;
    return c;
}
#define MFMA16(a, b, c) emu_mfma16(a, b, c)
#else
#define LAS __attribute__((address_space(3)))
#define WAIT_V(n) asm volatile("s_waitcnt vmcnt(" #n ")" ::: "memory")
#define WAIT_L(n) asm volatile("s_waitcnt lgkmcnt(" #n ")" ::: "memory")
#define S_BARRIER() __builtin_amdgcn_s_barrier()
#define SETPRIO(x) __builtin_amdgcn_s_setprio(x)
#define SCHED_BAR() __builtin_amdgcn_sched_barrier(0)
#define RFL(x) __builtin_amdgcn_readfirstlane(x)
#define GLDS16(gptr, ldsptr) __builtin_amdgcn_global_load_lds((const unsigned*)(gptr), (LAS unsigned*)(ldsptr), 16, 0, 0)
#define MFMA16(a, b, c) __builtin_amdgcn_mfma_f32_16x16x32_bf16(a, b, c, 0, 0, 0)
#endif

#ifdef EMU
__device__ __forceinline__ unsigned f2bf(float f) { unsigned u = __builtin_bit_cast(unsigned, f); return (u + 0x7fffu + ((u >> 16) & 1u)) >> 16; }
#else
__device__ __forceinline__ unsigned f2bf(float f) { return (unsigned)__builtin_bit_cast(unsigned short, (__bf16)f); }
#endif
#ifdef EMU
__device__ __forceinline__ unsigned pk2(float lo, float hi) { return f2bf(lo) | (f2bf(hi) << 16); }
#else
typedef float f32x2c __attribute__((ext_vector_type(2)));
typedef __bf16 bf16x2c __attribute__((ext_vector_type(2)));
__device__ __forceinline__ unsigned pk2(float lo, float hi) { const f32x2c v = {lo, hi}; return __builtin_bit_cast(unsigned, __builtin_convertvector(v, bf16x2c)); }
#endif
__device__ __forceinline__ bf16x8 cvt8(const f32x4 a, const f32x4 b) {
    u32x4 w; w.x = pk2(a.x, a.y); w.y = pk2(a.z, a.w); w.z = pk2(b.x, b.y); w.w = pk2(b.z, b.w); return __builtin_bit_cast(bf16x8, w);
}
__device__ __forceinline__ float bf_lo(unsigned u) { return __builtin_bit_cast(float, u << 16); }
__device__ __forceinline__ float bf_hi(unsigned u) { return __builtin_bit_cast(float, u & 0xffff0000u); }

namespace pg8 {
constexpr int BM = 256, BK = 64, HALF = 128, HTB = HALF * BK * 2, STAGE_BYTES = 8 * HTB, NXCD = 8, WGM = 8;
__host__ __device__ __forceinline__ int lds_byte(int r, int c) { const int st = (r >> 4) * 2 + (c >> 5), rr = r & 15, cc = c & 31, ob = rr * 64 + cc * 2; return st * 1024 + (ob ^ (((ob >> 9) & 1) << 5)); }
__host__ __device__ __forceinline__ void stage_rc(int b, int& R, int& C) { const int st = b / 1024, sb = b % 1024, swz = sb ^ (((sb >> 9) & 1) << 5); R = (st >> 1) * 16 + swz / 64; C = (st & 1) * 32 + (swz % 64) / 2; }
__host__ __device__ __forceinline__ int perm32(int rho) { const int n = rho >> 4, i = rho & 15; return 8 * (i >> 2) + 4 * n + (i & 3); }
struct Unit { int pm, pn, e; };

struct DenseOrder {
    static constexpr bool GATHER = false;
    const char* A; const char* Bt; int K; int nM, nN, nwg, G, c;
    __device__ __forceinline__ void init(const void* A_, const void* Bt_, int M, int N, int K_, int G_, int c_) { A = (const char*)A_; Bt = (const char*)Bt_; K = K_; nM = M / BM; nN = N / BM; nwg = nM * nN; G = G_; c = c_; }
    __device__ __forceinline__ bool next(int i, Unit& u) const {
        const long L = (long)i * G + c; if (L >= nwg) return false;
        int wgid = (int)L; { const int q = nwg / NXCD, r = nwg % NXCD, xcd = wgid % NXCD, off = wgid / NXCD; wgid = (xcd < r ? xcd * (q + 1) : r * (q + 1) + (xcd - r) * q) + off; }
        const int nig = WGM * nN, gid = wgid / nig, fm = gid * WGM, gsz = (nM - fm) < WGM ? (nM - fm) : WGM;
        u.pm = fm + ((wgid % nig) % gsz); u.pn = (wgid % nig) / gsz; u.e = 0; return true;
    }
    __device__ __forceinline__ const char* abase(const Unit& u) const { return A + (size_t)u.pm * BM * K * 2; }
    __device__ __forceinline__ const char* bbase(const Unit& u) const { return Bt + (size_t)u.pn * BM * K * 2; }
};
template <bool G>
struct MoeOrderT {
    static constexpr bool GATHER = G;
    const char* A; const char* Wt; int K; int nN, nwg, G_, c; size_t estride; const int* rbe; const int* rowmap;
    __device__ __forceinline__ bool next(int i, Unit& u) const {
        const long L = (long)i * G_ + c; if (L >= nwg) return false;
        u.pm = (int)(L / nN); u.pn = (int)(L % nN); u.e = rbe[u.pm]; return true;
    }
    __device__ __forceinline__ const char* abase(const Unit& u) const { return G ? A : A + (size_t)u.pm * BM * K * 2; }
    __device__ __forceinline__ const char* bbase(const Unit& u) const { return Wt + (size_t)u.e * estride + (size_t)u.pn * BM * K * 2; }
};
struct EpiF32 {
    static constexpr bool PERM = false;
    float* C; int ldc;
    __device__ __forceinline__ void operator()(const f32x4 (&acc)[2][2][4][2], const Unit& u, int wr, int wc, int fr, int fq) const {
        const int row0 = u.pm * BM + wr * 64 + fr, col0 = u.pn * BM + wc * 32 + 4 * fq;
#pragma unroll
        for (int ai = 0; ai < 2; ++ai)
#pragma unroll
            for (int m = 0; m < 4; ++m) { float* rowp = C + (size_t)(row0 + ai * HALF + m * 16) * ldc + col0;
#pragma unroll
                for (int bj = 0; bj < 2; ++bj)
#pragma unroll
                    for (int n = 0; n < 2; ++n) *(f32x4*)(rowp + bj * HALF + n * 16) = acc[ai][bj][m][n]; }
    }
};
struct EpiProj {
    static constexpr bool PERM = true;
    bf16_t* O; int ldc; float* G; int lastt;
    __device__ __forceinline__ void operator()(const f32x4 (&acc)[2][2][4][2], const Unit& u, int wr, int wc, int fr, int fq) const {
        const int row0 = u.pm * BM + wr * 64 + fr, col0 = u.pn * BM + wc * 32 + 8 * fq;
#pragma unroll
        for (int ai = 0; ai < 2; ++ai)
#pragma unroll
            for (int m = 0; m < 4; ++m) { bf16_t* rowp = O + (size_t)(row0 + ai * HALF + m * 16) * ldc + col0;
#pragma unroll
                for (int bj = 0; bj < 2; ++bj) { const f32x4 v0 = acc[ai][bj][m][0], v1 = acc[ai][bj][m][1];
                    u32x4 w; w.x = pk2(v0[0], v0[1]); w.y = pk2(v0[2], v0[3]); w.z = pk2(v1[0], v1[1]); w.w = pk2(v1[2], v1[3]);
                    *(u32x4*)(rowp + bj * HALF) = w; } }
        if (u.pn == lastt) {
#pragma unroll
            for (int ai = 0; ai < 2; ++ai)
#pragma unroll
                for (int m = 0; m < 4; ++m) { float* rowp = G + (size_t)(row0 + ai * HALF + m * 16) * BM + wc * 32 + 8 * fq;
#pragma unroll
                    for (int bj = 0; bj < 2; ++bj) { *(f32x4*)(rowp + bj * HALF) = acc[ai][bj][m][0]; *(f32x4*)(rowp + bj * HALF + 4) = acc[ai][bj][m][1]; } }
        }
    }
};
struct EpiBf16Bias {
    static constexpr bool PERM = true;
    bf16_t* O; int ldc; const float* bias; int bias_estride;
    __device__ __forceinline__ void operator()(const f32x4 (&acc)[2][2][4][2], const Unit& u, int wr, int wc, int fr, int fq) const {
        const int row0 = u.pm * BM + wr * 64 + fr, col0 = u.pn * BM + wc * 32 + 8 * fq;
        const float* bp = bias + (size_t)u.e * bias_estride + col0;
        f32x4 bv[2][2];
#pragma unroll
        for (int bj = 0; bj < 2; ++bj)
#pragma unroll
            for (int n = 0; n < 2; ++n) bv[bj][n] = *(const f32x4*)(bp + bj * HALF + 4 * n);
#pragma unroll
        for (int ai = 0; ai < 2; ++ai)
#pragma unroll
            for (int m = 0; m < 4; ++m) { bf16_t* rowp = O + (size_t)(row0 + ai * HALF + m * 16) * ldc + col0;
#pragma unroll
                for (int bj = 0; bj < 2; ++bj) { const f32x4 v0 = acc[ai][bj][m][0] + bv[bj][0], v1 = acc[ai][bj][m][1] + bv[bj][1];
                    u32x4 w; w.x = pk2(v0[0], v0[1]); w.y = pk2(v0[2], v0[3]); w.z = pk2(v1[0], v1[1]); w.w = pk2(v1[2], v1[3]);
                    *(u32x4*)(rowp + bj * HALF) = w; } }
    }
};
__device__ __forceinline__ float swiglu1(float g, float uu) { g = fminf(g, 7.0f); uu = fminf(fmaxf(uu, -7.0f), 7.0f); return (uu + 1.0f) * (g * frcp(1.0f + fexp(-1.702f * g))); }
struct EpiSwiglu {
    static constexpr bool PERM = true;
    bf16_t* O; const float* b1;
    __device__ __forceinline__ void operator()(const f32x4 (&acc)[2][2][4][2], const Unit& u, int wr, int wc, int fr, int fq) const {
        const int row0 = u.pm * BM + wr * 64 + fr, j0 = u.pn * HALF + wc * 32 + 8 * fq;
        const float* bg = b1 + (size_t)u.e * 2 * DFF + j0; const float* bu = bg + DFF;
        f32x4 g4[2], u4[2];
#pragma unroll
        for (int n = 0; n < 2; ++n) { g4[n] = *(const f32x4*)(bg + 4 * n); u4[n] = *(const f32x4*)(bu + 4 * n); }
#pragma unroll
        for (int ai = 0; ai < 2; ++ai)
#pragma unroll
            for (int m = 0; m < 4; ++m) {
                float o[8];
#pragma unroll
                for (int n = 0; n < 2; ++n)
#pragma unroll
                    for (int q = 0; q < 4; ++q) o[n * 4 + q] = swiglu1(acc[ai][0][m][n][q] + g4[n][q], acc[ai][1][m][n][q] + u4[n][q]);
                u32x4 w; w.x = pk2(o[0], o[1]); w.y = pk2(o[2], o[3]); w.z = pk2(o[4], o[5]); w.w = pk2(o[6], o[7]);
                *(u32x4*)(O + (size_t)(row0 + ai * HALF + m * 16) * DFF + j0) = w;
            }
    }
};

template <class Epi, class Sched, bool SP2 = (MK_SP2 != 0)>
__device__ __forceinline__ void gemm_phase(LAS unsigned char* lds, const int K, const Sched& S, const Epi& E, const int tid) {
    const int wid = RFL(tid >> 6), lane = tid & 63, wr = wid >> 2, wc = wid & 3, fr = lane & 15, fq = lane >> 4;
    const int nt = K / BK;
    unsigned voffA[2], voffB[2]; int gR[2]; unsigned gC[2];
#pragma unroll
    for (int i = 0; i < 2; ++i) { int R, C; stage_rc(tid * 16 + i * 8192, R, C); const int Rb = Epi::PERM ? ((R & ~31) + perm32(R & 31)) : R;
        voffA[i] = (unsigned)(R * K + C) * 2u; voffB[i] = (unsigned)(Rb * K + C) * 2u; gR[i] = R; gC[i] = (unsigned)C * 2u; }
    unsigned va[2][2], vn[2][2];
#define PG8_GOFF(dst, unit) do { if constexpr (Sched::GATHER) { _Pragma("unroll") for (int h_ = 0; h_ < 2; ++h_) _Pragma("unroll") for (int i_ = 0; i_ < 2; ++i_) \
        dst[h_][i_] = (unsigned)S.rowmap[(unit).pm * BM + h_ * HALF + gR[i_]] * (unsigned)(K * 2) + gC[i_]; } } while (0)
#define PG8_STAGE_A(bufoff, bp, kb, h, nx) do { if constexpr (Sched::GATHER) { const char* gb_ = S.A + (kb); _Pragma("unroll") for (int _i = 0; _i < 2; ++_i) \
        GLDS16(gb_ + ((nx) ? vn[h][_i] : va[h][_i]), lds + (bufoff) + ldsw + _i * 8192); } else { PG8_STAGE(bufoff, bp, voffA); } } while (0)
    const size_t kstep = (size_t)(BK * 2);
    const size_t hstep = (size_t)HALF * K * 2;
    const unsigned ldsw = (unsigned)wid * 1024u;
    const int aoff = lds_byte(wr * 64 + fr, fq * 8), boff = lds_byte(wc * 32 + fr, fq * 8);
#define PG8_SA(b, h) (((b) * 2 + (h)) * HTB)
#define PG8_SB(b, h) ((4 + (b) * 2 + (h)) * HTB)
#define PG8_STAGE(bufoff, gbase, voff) do { _Pragma("unroll") for (int _i = 0; _i < 2; ++_i) \
        GLDS16((const char*)(gbase) + (voff)[_i], lds + (bufoff) + ldsw + _i * 8192); } while (0)
#define PG8_LDA(dst, b, h) do { _Pragma("unroll") for (int m = 0; m < 4; ++m) _Pragma("unroll") for (int k = 0; k < 2; ++k) dst[m][k] = *(const LAS bf16x8*)(lds + PG8_SA(b, h) + aoff + m * 2048 + k * 1024); } while (0)
#define PG8_LDB(dst, b, h) do { _Pragma("unroll") for (int n = 0; n < 2; ++n) _Pragma("unroll") for (int k = 0; k < 2; ++k) dst[n][k] = *(const LAS bf16x8*)(lds + PG8_SB(b, h) + boff + n * 2048 + k * 1024); } while (0)
#define PG8_MMA(ai, bj, At, Bt) do { SETPRIO(1); _Pragma("unroll") for (int m = 0; m < 4; ++m) _Pragma("unroll") for (int n = 0; n < 2; ++n) _Pragma("unroll") for (int k = 0; k < 2; ++k) \
        acc[ai][bj][m][n] = MFMA16(Bt[n][k], At[m][k], acc[ai][bj][m][n]); SETPRIO(0); } while (0)
    Unit cur, nxt; int ui = 0;
    if (!S.next(0, cur)) return;
    f32x4 acc[2][2][4][2];
#pragma unroll
    for (int a = 0; a < 2; ++a)
#pragma unroll
        for (int b = 0; b < 2; ++b)
#pragma unroll
            for (int m = 0; m < 4; ++m)
#pragma unroll
                for (int n = 0; n < 2; ++n) acc[a][b][m][n] = (f32x4){0.f, 0.f, 0.f, 0.f};
    bf16x8 At[4][2], B0[2][2], B1[2][2];
    const char* cA = S.abase(cur); const char* cB = S.bbase(cur);
    PG8_GOFF(va, cur);
    if constexpr (SP2) {
        PG8_STAGE(PG8_SB(0, 0), cB, voffB); PG8_STAGE(PG8_SB(0, 1), cB + hstep, voffB); PG8_STAGE_A(PG8_SA(0, 0), cA, 0, 0, false); PG8_STAGE_A(PG8_SA(0, 1), cA + hstep, 0, 1, false);
        if (wr == 1) S_BARRIER();
        WAIT_V(2); S_BARRIER();
        PG8_STAGE(PG8_SB(1, 0), cB + kstep, voffB); PG8_STAGE_A(PG8_SA(1, 0), cA + kstep, kstep, 0, false); PG8_STAGE(PG8_SB(1, 1), cB + hstep + kstep, voffB);
        WAIT_V(6); S_BARRIER();
    } else {
    PG8_STAGE(PG8_SB(0, 0), cB, voffB); PG8_STAGE_A(PG8_SA(0, 0), cA, 0, 0, false); PG8_STAGE(PG8_SB(0, 1), cB + hstep, voffB); PG8_STAGE_A(PG8_SA(0, 1), cA + hstep, 0, 1, false);
    if (wr == 1) S_BARRIER();
    WAIT_V(4); S_BARRIER();
    PG8_STAGE(PG8_SB(1, 0), cB + kstep, voffB); PG8_STAGE_A(PG8_SA(1, 0), cA + kstep, kstep, 0, false); PG8_STAGE(PG8_SB(1, 1), cB + hstep + kstep, voffB);
    WAIT_V(6); S_BARRIER();
    }
    for (;;) {
        const bool has_next = S.next(ui + 1, nxt);
        const char* nA = has_next ? S.abase(nxt) : cA; const char* nB = has_next ? S.bbase(nxt) : cB;
        if constexpr (Sched::GATHER) { if (has_next) { PG8_GOFF(vn, nxt); } else {
#pragma unroll
            for (int h_ = 0; h_ < 2; ++h_) { vn[h_][0] = va[h_][0]; vn[h_][1] = va[h_][1]; } } }
        for (int t = 0; t < nt; t += 2) {
            const bool last = (t == nt - 2);
            const char* a1 = cA + (size_t)(t + 1) * kstep;
            const char* a2 = last ? nA : cA + (size_t)(t + 2) * kstep; const char* b2 = last ? nB : cB + (size_t)(t + 2) * kstep;
            const char* a3 = a2 + kstep; const char* b3 = b2 + kstep;
            if constexpr (SP2) {
            PG8_LDB(B0, 0, 0); PG8_LDB(B1, 0, 1); SCHED_BAR(); PG8_LDA(At, 0, 0); PG8_STAGE_A(PG8_SA(1, 1), a1 + hstep, (size_t)(t + 1) * kstep, 1, false);
            WAIT_V(8); WAIT_L(0); S_BARRIER(); PG8_MMA(0, 0, At, B0); PG8_MMA(0, 1, At, B1); S_BARRIER(); SCHED_BAR();
            PG8_LDA(At, 0, 1); PG8_STAGE(PG8_SB(0, 0), b2, voffB); PG8_STAGE(PG8_SB(0, 1), b2 + hstep, voffB); PG8_STAGE_A(PG8_SA(0, 0), a2, (last ? (size_t)0 : (size_t)(t + 2) * kstep), 0, last);
            WAIT_V(8); WAIT_L(0); S_BARRIER(); PG8_MMA(1, 0, At, B0); PG8_MMA(1, 1, At, B1); S_BARRIER(); SCHED_BAR();
            PG8_LDB(B0, 1, 0); PG8_LDB(B1, 1, 1); SCHED_BAR(); PG8_LDA(At, 1, 0); PG8_STAGE_A(PG8_SA(0, 1), a2 + hstep, (last ? (size_t)0 : (size_t)(t + 2) * kstep), 1, last);
            WAIT_V(8); WAIT_L(0); S_BARRIER(); PG8_MMA(0, 0, At, B0); PG8_MMA(0, 1, At, B1); S_BARRIER(); SCHED_BAR();
            PG8_LDA(At, 1, 1); PG8_STAGE(PG8_SB(1, 0), b3, voffB); PG8_STAGE(PG8_SB(1, 1), b3 + hstep, voffB); PG8_STAGE_A(PG8_SA(1, 0), a3, (last ? kstep : (size_t)(t + 3) * kstep), 0, last);
            WAIT_V(8); WAIT_L(0); S_BARRIER(); PG8_MMA(1, 0, At, B0); PG8_MMA(1, 1, At, B1); S_BARRIER(); SCHED_BAR();
            } else {
            PG8_LDB(B0, 0, 0); SCHED_BAR(); PG8_LDA(At, 0, 0); PG8_STAGE_A(PG8_SA(1, 1), a1 + hstep, (size_t)(t + 1) * kstep, 1, false);
            WAIT_L(8); S_BARRIER(); WAIT_L(0); PG8_MMA(0, 0, At, B0); S_BARRIER(); SCHED_BAR();
            PG8_LDB(B1, 0, 1); PG8_STAGE(PG8_SB(0, 0), b2, voffB);
            S_BARRIER(); WAIT_L(0); PG8_MMA(0, 1, At, B1); S_BARRIER();
            PG8_LDA(At, 0, 1); PG8_STAGE_A(PG8_SA(0, 0), a2, (last ? (size_t)0 : (size_t)(t + 2) * kstep), 0, last);
            S_BARRIER(); WAIT_L(0); PG8_MMA(1, 0, At, B0); S_BARRIER(); SCHED_BAR();
            PG8_STAGE(PG8_SB(0, 1), b2 + hstep, voffB);
            WAIT_V(6); S_BARRIER(); PG8_MMA(1, 1, At, B1); S_BARRIER();
            PG8_LDB(B0, 1, 0); SCHED_BAR(); PG8_LDA(At, 1, 0); PG8_STAGE_A(PG8_SA(0, 1), a2 + hstep, (last ? (size_t)0 : (size_t)(t + 2) * kstep), 1, last);
            WAIT_L(8); S_BARRIER(); WAIT_L(0); PG8_MMA(0, 0, At, B0); S_BARRIER(); SCHED_BAR();
            PG8_LDB(B1, 1, 1); PG8_STAGE(PG8_SB(1, 0), b3, voffB);
            S_BARRIER(); WAIT_L(0); PG8_MMA(0, 1, At, B1); S_BARRIER();
            PG8_LDA(At, 1, 1); PG8_STAGE_A(PG8_SA(1, 0), a3, (last ? kstep : (size_t)(t + 3) * kstep), 0, last);
            S_BARRIER(); WAIT_L(0); PG8_MMA(1, 0, At, B0); S_BARRIER(); SCHED_BAR();
            PG8_STAGE(PG8_SB(1, 1), b3 + hstep, voffB);
            WAIT_V(6); S_BARRIER(); PG8_MMA(1, 1, At, B1); S_BARRIER();
            }
        }
        if (wr == 0) S_BARRIER();
        E(acc, cur, wr, wc, fr, fq);
        if (!has_next) break;
#pragma unroll
        for (int a = 0; a < 2; ++a)
#pragma unroll
            for (int b = 0; b < 2; ++b)
#pragma unroll
                for (int m = 0; m < 4; ++m)
#pragma unroll
                    for (int n = 0; n < 2; ++n) acc[a][b][m][n] = (f32x4){0.f, 0.f, 0.f, 0.f};
        cur = nxt; cA = nA; cB = nB; ++ui;
        if constexpr (Sched::GATHER) {
#pragma unroll
            for (int h_ = 0; h_ < 2; ++h_) { va[h_][0] = vn[h_][0]; va[h_][1] = vn[h_][1]; } }
        if (wr == 1) S_BARRIER();
    }
    WAIT_V(0);
    S_BARRIER();
#undef PG8_SA
#undef PG8_SB
#undef PG8_STAGE
#undef PG8_STAGE_A
#undef PG8_GOFF
#undef PG8_LDA
#undef PG8_LDB
#undef PG8_MMA
}
}

__device__ __forceinline__ float row16_sum(float x) {
#ifdef EMU
    x += __shfl_xor(x, 1); x += __shfl_xor(x, 2); x += __shfl_xor(x, 4); x += __shfl_xor(x, 8); return x;
#else
#define DPPF(v, ctrl) __builtin_bit_cast(float, __builtin_amdgcn_update_dpp(0, __builtin_bit_cast(int, (v)), (ctrl), 0xF, 0xF, false))
    x += DPPF(x, 0xB1); x += DPPF(x, 0x4E); x += DPPF(x, 0x141); x += DPPF(x, 0x140); return x;
#undef DPPF
#endif
}
__device__ __forceinline__ float row32_sum(float x) {
    x = row16_sum(x);
#ifdef EMU
    x += __shfl_xor(x, 32); return x;
#else
    float a = x, b = x;
    asm volatile("s_nop 1\n\tv_permlane32_swap_b32 %0, %1" : "+v"(a), "+v"(b));
    return a + b;
#endif
}
__device__ __forceinline__ float wave_sum_fast(float x, int lane) {
    x = row32_sum(x);
    x += SHX(x, 16, lane);
    return x;
}
__device__ __forceinline__ void transpose_item(const float* W, int K, int N, bf16_t* WT, int k0, int n0, int dst_row0, float* scr, int lane) {
    const int n4 = (lane & 15) * 4, kr = lane >> 4;
#pragma unroll 8
    for (int i = 0; i < 16; ++i) {
        const int kk = 4 * i + kr;
        f32x4 v = (f32x4){0.f, 0.f, 0.f, 0.f};
        if (n0 + n4 < N) v = *(const f32x4*)(W + (size_t)(k0 + kk) * N + n0 + n4);
        float* d = scr + kk * 65 + n4; d[0] = v.x; d[1] = v.y; d[2] = v.z; d[3] = v.w;
    }
    WAVE_SYNC();
    const int c = lane & 7;
#pragma unroll
    for (int j = 0; j < 8; ++j) { const int n = (lane >> 3) + 8 * j; const float* sp = scr + (8 * c) * 65 + n;
        u32x4 o; o.x = pk2(sp[0 * 65], sp[1 * 65]); o.y = pk2(sp[2 * 65], sp[3 * 65]); o.z = pk2(sp[4 * 65], sp[5 * 65]); o.w = pk2(sp[6 * 65], sp[7 * 65]);
        *(u32x4*)(WT + (size_t)(dst_row0 + n) * K + k0 + 8 * c) = o; }
    WAVE_SYNC();
}
__device__ __forceinline__ void phase_prologue(const Params& P, unsigned char* smem, int wv) {
    ParamsPtr pp = PARAMS_PTR(P); PIN_S(pp); unsigned char* ws = pp->ws; int bidx = (int)blockIdx.x, gdim = (int)gridDim.x; PIN_S(bidx); PIN_S(gdim);
    const int tid = phase_tid(wv), lane = tid & 63, wave = tid >> 6;
    float* scr = (float*)smem + wave * (64 * 65);
    const int gw = bidx * NWAVES + wave, ngw = NWAVES * gdim;
    constexpr int I_IN = 16 * (PLD / 64), I_OUT = 16 * 16, I_W1 = NE * 16 * 32, I_W2 = NE * 16 * 16, I_L = I_IN + I_OUT + I_W1 + I_W2;
    for (int it = gw; it < NL * I_L; it += ngw) {
        const int l = it / I_L; int r = it % I_L;
        if (r < I_IN) { const int kb = r / (PLD / 64), nb = r % (PLD / 64);
            transpose_item(pp->in[1] + (size_t)l * D * PIN, D, PIN, (bf16_t*)(ws + O_WIN) + (size_t)l * PLD * D, kb * 64, nb * 64, nb * 64, scr, lane); continue; }
        r -= I_IN;
        if (r < I_OUT) { const int kb = r / 16, nb = r % 16;
            transpose_item(pp->in[21] + (size_t)l * D * D, D, D, (bf16_t*)(ws + O_WOUT) + (size_t)l * D * D, kb * 64, nb * 64, nb * 64, scr, lane); continue; }
        r -= I_OUT;
        if (r < I_W1) { const int e = r / (16 * 32), q = r % (16 * 32), kb = q / 32, nb = q % 32, n0 = nb * 64;
            const int dst = n0 < DFF ? (n0 / 128) * 256 + (n0 % 128) : ((n0 - DFF) / 128) * 256 + 128 + ((n0 - DFF) % 128);
            transpose_item(pp->in[26] + ((size_t)l * NE + e) * D * 2 * DFF, D, 2 * DFF, (bf16_t*)(ws + O_W1) + ((size_t)l * NE + e) * 2 * DFF * D, kb * 64, n0, dst, scr, lane); continue; }
        r -= I_W1;
        { const int e = r / (16 * 16), q = r % (16 * 16), kb = q / 16, nb = q % 16;
            transpose_item(pp->in[28] + ((size_t)l * NE + e) * DFF * D, DFF, D, (bf16_t*)(ws + O_W2) + ((size_t)l * NE + e) * D * DFF, kb * 64, nb * 64, nb * 64, scr, lane); }
    }
    {
        const float* gw_ = pp->in[4]; bf16_t* WSB = (bf16_t*)(ws + O_WSB);
        for (size_t i = ((size_t)bidx * NTHREADS + tid) * 4; i < (size_t)NL * GH * CH * CH; i += (size_t)gdim * NTHREADS * 4) {
            const f32x4 v = *(const f32x4*)(gw_ + i); u32x2 o; o.x = pk2(v.x, v.y); o.y = pk2(v.z, v.w); *(u32x2*)(WSB + i) = o;
        }
    }
    {
        bf16_t* LWT = (bf16_t*)(ws + O_LWT);
        for (int i = bidx * NTHREADS + tid; i < NL * 1920 * 128; i += gdim * NTHREADS) {
            const int k = i & 127, n = (i >> 7) % 1920, ll = i / (1920 * 128);
            float v = 0.f;
            if (n < 1536) { if (k < 64) { const int grp = n / 768, d = (n / 384) & 1, c = n % 384; v = (grp == 0 ? pp->in[8] : pp->in[10])[(((size_t)ll * 2 + d) * 64 + k) * RW + c]; } }
            else v = pp->in[11][((size_t)ll * 128 + k) * RW + (n - 1536)];
            LWT[i] = (bf16_t)f2bf(v);
        }
    }
    {
        bf16_t* RWT = (bf16_t*)(ws + O_RWT);
        for (int i = bidx * NTHREADS + tid; i < NL * NE * D; i += gdim * NTHREADS) {
            const int k = i % D, e = (i / D) % NE, ll = i / (D * NE);
            const float v = pp->in[24][((size_t)ll * D + k) * NE + e];
            const unsigned hi = f2bf(v); const float lo = v - bf_lo(hi);
            RWT[((size_t)(ll * 2 + 0) * NE + e) * D + k] = (bf16_t)hi; RWT[((size_t)(ll * 2 + 1) * NE + e) * D + k] = (bf16_t)f2bf(lo);
        }
    }
    const float* x = pp->in[0]; bf16_t* XB = (bf16_t*)(ws + O_XB);
    for (size_t i = ((size_t)bidx * NTHREADS + tid) * 4; i < (size_t)T * D; i += (size_t)gdim * NTHREADS * 4) {
        const f32x4 v = *(const f32x4*)(x + i); u32x2 o; o.x = pk2(v.x, v.y); o.y = pk2(v.z, v.w); *(u32x2*)(XB + i) = o;
    }
}

__device__ __forceinline__ float tshift(const float* P, int t, int s, int col, const float* mu0, const float* mu1, int rc) {
    const float cur = P[(size_t)t * PLD + col];
    const float prv = s > 0 ? P[(size_t)(t - 1) * PLD + col] : 0.f;
    const float nxt = s < S - 1 ? P[(size_t)(t + 1) * PLD + col] : 0.f;
    return cur + mu0[rc] * (prv - cur) + mu1[rc] * (nxt - cur);
}

__device__ __forceinline__ void phase_prep(const Params& P, int l, unsigned char* smem, int wv) {
    ParamsPtr pp = PARAMS_PTR(P); PIN_S(pp); unsigned char* ws = pp->ws; int bidx = (int)blockIdx.x, gdim = (int)gridDim.x; PIN_S(bidx); PIN_S(gdim);
    const bf16_t* proj = (const bf16_t*)(ws + O_PROJ); const float* projg = (const float*)(ws + O_PROJG);
    float* UG = (float*)(ws + O_UG); bf16_t* VNT = (bf16_t*)(ws + O_VNT);
    float* RR = (float*)(ws + O_RR); float* VV = (float*)(ws + O_VV); float* KK = (float*)(ws + O_KK);
    float* KD = (float*)(ws + O_KD); float* ICLR = (float*)(ws + O_ICLR);
    float* GATE = (float*)(ws + O_GATE); float* BONUS = (float*)(ws + O_BONUS); float* LWG = (float*)(ws + O_LW);
    bf16_t* RB = (bf16_t*)(ws + O_RB); bf16_t* VB = (bf16_t*)(ws + O_VB); bf16_t* KKB = (bf16_t*)(ws + O_KKB); bf16_t* BBB = (bf16_t*)(ws + O_BBB); bf16_t* KDB = (bf16_t*)(ws + O_KDB);
#if !MK_RWKV_CHUNKED
    float* DEC = (float*)(ws + O_DEC); float* BRKR = (float*)(ws + O_BRKR);
#endif
    bf16_t* MQB = (bf16_t*)(ws + O_MQB); bf16_t* MKB = (bf16_t*)(ws + O_MKB); bf16_t* KT = (bf16_t*)(ws + O_KT); bf16_t* VT = (bf16_t*)(ws + O_VT);
    float* IG = (float*)(ws + O_IG); float* LF = (float*)(ws + O_LF);
    const bf16_t* LWT = (const bf16_t*)(ws + O_LWT) + (size_t)l * 1920 * 128;
    const float* gln_g = pp->in[2] + (size_t)l * GW; const float* gln_b = pp->in[3] + (size_t)l * GW;
    const float* mu0 = pp->in[6] + (size_t)l * 2 * RPROJ; const float* mu1 = mu0 + RPROJ;
    const float* w0 = pp->in[7] + (size_t)l * 2 * RW; const float* a0 = pp->in[9] + (size_t)l * 2 * RW;
    const float* k_k = pp->in[12] + (size_t)l * RW; const float* k_a = pp->in[13] + (size_t)l * RW; const float* r_k = pp->in[14] + (size_t)l * RW;
    const float* conv_w = pp->in[17] + (size_t)l * 3 * 768; const float* conv_b = pp->in[18] + (size_t)l * 768; const float* gate_b = pp->in[19] + (size_t)l * 24;
    float* win = (float*)smem;
    bf16_t* lin = (bf16_t*)(smem + 101376);
    bf16_t* tvn = (bf16_t*)(smem + 110592);
    bf16_t* tk = (bf16_t*)(smem + 118784);
    bf16_t* tv = (bf16_t*)(smem + 131072);
    constexpr int LIN = 264;
    const int tid = phase_tid(wv), lane = tid & 63, wave = tid >> 6, col = lane & 15, g = lane >> 4;
    for (int u = bidx; u < T / 16; u += gdim) {
        const int t0 = u * 16, s0 = t0 % S, bb = t0 / S;
        __syncthreads();
        {
            u32x2 wb[18];
#pragma unroll
            for (int row = 0; row < 18; ++row) {
                const int sq = s0 - 1 + row;
                wb[row] = (u32x2){0u, 0u};
                if (sq >= 0 && sq < S && tid < 352) wb[row] = *(const u32x2*)(proj + (size_t)(t0 - 1 + row) * PLD + C_RW + tid * 4);
            }
            if (tid < 352) {
#pragma unroll
                for (int row = 0; row < 18; ++row) *(f32x4*)(win + row * RPROJ + tid * 4) = (f32x4){bf_lo(wb[row].x), bf_hi(wb[row].x), bf_lo(wb[row].y), bf_hi(wb[row].y)};
            }
        }
        for (int rep_ = 0; rep_ < (MK_PROBE == 3 ? 2 : 1); ++rep_) {
            const int i = tid >> 5, l32 = tid & 31, t = t0 + i;
            float v[8], ug[8]; float sum = 0.f;
#pragma unroll
            for (int j = 0; j < 8; ++j) { const int c = j * 32 + l32; ug[j] = bf_lo((unsigned)proj[(size_t)t * PLD + c]); v[j] = bf_lo((unsigned)proj[(size_t)t * PLD + GW + c]); }
#pragma unroll
            for (int j = 0; j < 8; ++j) { const int c = j * 32 + l32; UG[(size_t)t * GW + c] = geluf_(ug[j]); v[j] = geluf_(v[j]); sum += v[j]; }
#pragma unroll
            for (int o = 16; o >= 1; o >>= 1) sum += SHX(sum, o, lane);
            const float mean = sum * (1.0f / GW); float q = 0.f;
#pragma unroll
            for (int j = 0; j < 8; ++j) { const float d = v[j] - mean; q += d * d; }
#pragma unroll
            for (int o = 16; o >= 1; o >>= 1) q += SHX(q, o, lane);
            const float rstd = 1.0f / sqrtf(q * (1.0f / GW) + LN_EPS);
#pragma unroll
            for (int j = 0; j < 8; ++j) { const int c = j * 32 + l32; tvn[c * 16 + i] = (bf16_t)f2bf((v[j] - mean) * rstd * gln_g[c] + gln_b[c]); }
        }
        __syncthreads();
        {
            const int hf = tid & 1, c = tid >> 1;
            *(u32x4*)(VNT + ((size_t)bb * GW + c) * S + s0 + hf * 8) = *(const u32x4*)(tvn + c * 16 + hf * 8);
        }
        for (int idx = tid; idx < 16 * 256; idx += NTHREADS) {
            const int i = idx >> 8, j = idx & 255, rc = 1152 + j;
            const float pv = win[i * RPROJ + rc], cv = win[(i + 1) * RPROJ + rc], nv = win[(i + 2) * RPROJ + rc];
            const float x = cv + mu0[rc] * (pv - cv) + mu1[rc] * (nv - cv);
            lin[i * LIN + j] = (bf16_t)f2bf(j < 64 ? ftanh(x) : (j < 128 ? x : sigmoidf_(x)));
        }
        __syncthreads();
        for (int rep_ = 0; rep_ < (MK_PROBE == 1 ? 2 : 1); ++rep_) {
#pragma unroll 1
            for (int qg = 0; qg < 3; ++qg) {
                bf16x8 bw_[5][4]; float bias_[5];
#pragma unroll
                for (int q5 = 0; q5 < 5; ++q5) {
                    const int nt = wave * 15 + qg * 5 + q5, grp = nt / 24, c = (nt % 24) * 16 + col;
                    const bf16_t* bw = LWT + (size_t)(nt * 16 + col) * 128 + 8 * g;
#pragma unroll
                    for (int ks = 0; ks < 2; ++ks) bw_[q5][ks] = *(const bf16x8*)(bw + ks * 32);
                    if (grp == 4) {
#pragma unroll
                        for (int ks = 2; ks < 4; ++ks) bw_[q5][ks] = *(const bf16x8*)(bw + ks * 32);
                    }
                    bias_[q5] = grp < 2 ? w0[grp * RW + c] : (grp < 4 ? a0[(grp - 2) * RW + c] : 0.f);
                }
#pragma unroll
                for (int q5 = 0; q5 < 5; ++q5) {
                    const int nt = wave * 15 + qg * 5 + q5, grp = nt / 24, c = (nt % 24) * 16 + col;
                    const int kcol = grp < 2 ? 0 : (grp < 4 ? 64 : 128);
                    f32x4 acc = (f32x4){0.f, 0.f, 0.f, 0.f};
#pragma unroll
                    for (int ks = 0; ks < 2; ++ks) acc = MFMA16(*(const bf16x8*)(lin + col * LIN + kcol + ks * 32 + 8 * g), bw_[q5][ks], acc);
                    if (grp == 4) {
#pragma unroll
                        for (int ks = 2; ks < 4; ++ks) acc = MFMA16(*(const bf16x8*)(lin + col * LIN + kcol + ks * 32 + 8 * g), bw_[q5][ks], acc);
                    }
                    if (grp < 2) {
#pragma unroll
                        for (int r = 0; r < 4; ++r) { const float lw = -fexp(-softplusf_(-(acc[r] + bias_[q5])) - 0.5f); const size_t o = (size_t)grp * T * RW + (size_t)(t0 + 4 * g + r) * RW + c; LWG[o] = lw;
#if !MK_RWKV_CHUNKED
                            DEC[o] = expf(lw);
#endif
                        }
                    } else if (grp < 4) {
#pragma unroll
                        for (int r = 0; r < 4; ++r) ICLR[(size_t)(grp - 2) * T * RW + (size_t)(t0 + 4 * g + r) * RW + c] = sigmoidf_(acc[r] + bias_[q5]);
                    } else {
#pragma unroll
                        for (int r = 0; r < 4; ++r) GATE[(size_t)(t0 + 4 * g + r) * RW + c] = acc[r];
                    }
                }
            }
        }
        __syncthreads();
        for (int rep_ = 0; rep_ < (MK_PROBE == 2 ? 2 : 1); ++rep_) if (wave < 6) {
            const int c = tid, h = wave;
            const float kkc = k_k[c], kac = k_a[c], rkc = r_k[c];
            const float m0r = mu0[c], m1r = mu1[c], m0k = mu0[RW + c], m1k = mu1[RW + c], m0v = mu0[2 * RW + c], m1v = mu1[2 * RW + c];
            float ic0[16], ic1[16];
#pragma unroll
            for (int i = 0; i < 16; ++i) { const size_t o = (size_t)(t0 + i) * RW + c; ic0[i] = ICLR[o]; ic1[i] = ICLR[(size_t)T * RW + o]; }
#pragma unroll
            for (int i = 0; i < 16; ++i) {
                const int t = t0 + i;
                const float* w_ = win + i * RPROJ + c;
                const float rp = w_[0], rc_ = w_[RPROJ], rn = w_[2 * RPROJ];
                const float kp = w_[RW], kc_ = w_[RPROJ + RW], kn = w_[2 * RPROJ + RW];
                const float vp = w_[2 * RW], vc_ = w_[RPROJ + 2 * RW], vn = w_[2 * RPROJ + 2 * RW];
                const float r = rc_ + m0r * (rp - rc_) + m1r * (rn - rc_);
                const float k = kc_ + m0k * (kp - kc_) + m1k * (kn - kc_);
                const float v = vc_ + m0v * (vp - vc_) + m1v * (vn - vc_);
                const size_t o = (size_t)t * RW + c;
                const float kq = k * kkc;
                const float n2 = wave_sum_fast(kq * kq, lane);
                const float kk = kq / fmaxf(sqrtf(n2), 1e-12f);
                const float kd0 = k * (1.0f + (ic0[i] - 1.0f) * kac), kd1 = k * (1.0f + (ic1[i] - 1.0f) * kac);
                const float bon = wave_sum_fast(r * (kd0 + kd1) * rkc, lane);
#if MK_RWKV_CHUNKED
                RB[o] = (bf16_t)f2bf(r); VB[o] = (bf16_t)f2bf(v); KKB[o] = (bf16_t)f2bf(kk);
                BBB[o] = (bf16_t)f2bf(kk * ic0[i]); BBB[(size_t)T * RW + o] = (bf16_t)f2bf(kk * ic1[i]);
                KDB[o] = (bf16_t)f2bf(kd0); KDB[(size_t)T * RW + o] = (bf16_t)f2bf(kd1);
#else
                RR[o] = r; VV[o] = v; KK[o] = kk;
                KD[o] = kd0; KD[(size_t)T * RW + o] = kd1;
#endif
                if (lane == 0) BONUS[(size_t)t * RH + h] = bon;
#if !MK_RWKV_CHUNKED
                { const float br0 = wave_sum(kk * ic0[i] * r, lane), br1 = wave_sum(kk * ic1[i] * r, lane), kr0 = wave_sum(kd0 * r, lane), kr1 = wave_sum(kd1 * r, lane);
                  if (lane == 0) { BRKR[((size_t)t * RH + h) * 2] = br0; BRKR[((size_t)t * RH + h) * 2 + 1] = kr0; BRKR[((size_t)(T + t) * RH + h) * 2] = br1; BRKR[((size_t)(T + t) * RH + h) * 2 + 1] = kr1; } }
#endif
            }
        }
        __syncthreads();
        {
            u32x2 wb[9], vb[3];
            const int rsel = tid >= 192 ? 1 : 0, c4 = tid - rsel * 192;
#pragma unroll
            for (int it = 0; it < 9; ++it) {
                const int row = 2 * it + rsel, sq = s0 - 1 + row;
                wb[it] = (u32x2){0u, 0u};
                if (tid < 384 && sq >= 0 && sq < S) wb[it] = *(const u32x2*)(proj + (size_t)(t0 - 1 + row) * PLD + C_MW + c4 * 4);
            }
#pragma unroll
            for (int it = 0; it < 3; ++it) { const int idx = tid + it * NTHREADS, i = idx / 96, cc = (idx % 96) * 4; vb[it] = *(const u32x2*)(proj + (size_t)(t0 + i) * PLD + C_MW + 2 * MW + cc); }
            if (tid < 384) {
#pragma unroll
                for (int it = 0; it < 9; ++it) *(f32x4*)(win + (2 * it + rsel) * 768 + c4 * 4) = (f32x4){bf_lo(wb[it].x), bf_hi(wb[it].x), bf_lo(wb[it].y), bf_hi(wb[it].y)};
            }
#pragma unroll
            for (int it = 0; it < 3; ++it) { const int idx = tid + it * NTHREADS, i = idx / 96, cc = (idx % 96) * 4; const u32x2 v = vb[it];
                tv[(cc + 0) * 16 + i] = (bf16_t)(v.x & 0xffffu); tv[(cc + 1) * 16 + i] = (bf16_t)(v.x >> 16); tv[(cc + 2) * 16 + i] = (bf16_t)(v.y & 0xffffu); tv[(cc + 3) * 16 + i] = (bf16_t)(v.y >> 16); }
        }
        for (int idx = tid; idx < 16 * 24; idx += NTHREADS) {
            const int i = idx / 24, gi = idx % 24, t = t0 + i;
            const int isf = gi / 12, dir = (gi / 6) & 1, h = gi % 6;
            const float gg = projg[(size_t)t * 256 + (3456 - (PLD - 256)) + gi] + gate_b[gi];
            if (isf) LF[((size_t)dir * T + t) * MH + h] = -softplusf_(-gg); else IG[((size_t)dir * T + t) * MH + h] = gg;
        }
        __syncthreads();
        for (int rep_ = 0; rep_ < (MK_PROBE == 4 ? 2 : 1); ++rep_)
        for (int idx = tid; idx < 16 * 768; idx += NTHREADS) {
            const int i = idx / 768, c = idx % 768, t = t0 + i;
            const float* w_ = win + i * 768 + c;
            float y = conv_b[c] + w_[0] * conv_w[c] + w_[768] * conv_w[768 + c] + w_[1536] * conv_w[2 * 768 + c];
            y = y * sigmoidf_(y);
            if (c < MW) MQB[(size_t)t * MW + c] = (bf16_t)f2bf(y);
            else { const bf16_t kb = (bf16_t)f2bf(y * 0.125f); MKB[(size_t)t * MW + (c - MW)] = kb; tk[(c - MW) * 16 + i] = kb; }
        }
        __syncthreads();
        for (int idx = tid; idx < 2 * MW * 2; idx += NTHREADS) {
            const int hf = idx & 1, c = (idx >> 1) % MW, which = idx / (2 * MW);
            const u32x4 val = *(const u32x4*)((which ? tv : tk) + c * 16 + hf * 8);
            bf16_t* dst = (which ? VT : KT) + ((size_t)(bb * MH) * 64 + c) * S + s0 + hf * 8;
            *(u32x4*)dst = val;
        }
    }
    __syncthreads();
}

__device__ __forceinline__ void phase_prep32(const Params& P, int l, unsigned char* smem, int wv) {
    ParamsPtr pp = PARAMS_PTR(P); PIN_S(pp); unsigned char* ws = pp->ws; int bidx = (int)blockIdx.x, gdim = (int)gridDim.x; PIN_S(bidx); PIN_S(gdim);
    const bf16_t* proj = (const bf16_t*)(ws + O_PROJ); const float* projg = (const float*)(ws + O_PROJG);
    float* UG = (float*)(ws + O_UG); bf16_t* VNT = (bf16_t*)(ws + O_VNT);
    u32x4* RK7 = (u32x4*)(ws + O_RK7);
    float* GATE = (float*)(ws + O_GATE); float* BONUS = (float*)(ws + O_BONUS); float* LWG = (float*)(ws + O_LW);
    bf16_t* VB = (bf16_t*)(ws + O_VB);
    bf16_t* MQB = (bf16_t*)(ws + O_MQB); bf16_t* MKB = (bf16_t*)(ws + O_MKB); bf16_t* KT = (bf16_t*)(ws + O_KT); bf16_t* VT = (bf16_t*)(ws + O_VT);
    float* IG = (float*)(ws + O_IG); float* LF = (float*)(ws + O_LF);
    const bf16_t* LWT = (const bf16_t*)(ws + O_LWT) + (size_t)l * 1920 * 128;
    const float* gln_g = pp->in[2] + (size_t)l * GW; const float* gln_b = pp->in[3] + (size_t)l * GW;
    const float* mu0 = pp->in[6] + (size_t)l * 2 * RPROJ; const float* mu1 = mu0 + RPROJ;
    const float* w0 = pp->in[7] + (size_t)l * 2 * RW; const float* a0 = pp->in[9] + (size_t)l * 2 * RW;
    const float* k_k = pp->in[12] + (size_t)l * RW; const float* k_a = pp->in[13] + (size_t)l * RW; const float* r_k = pp->in[14] + (size_t)l * RW;
    const float* conv_w = pp->in[17] + (size_t)l * 3 * 768; const float* conv_b = pp->in[18] + (size_t)l * 768; const float* gate_b = pp->in[19] + (size_t)l * 24;
    constexpr int TOK = 32, WR = TOK + 2, LIN = 264;
    bf16_t* winb = (bf16_t*)smem;
    bf16_t* lin = (bf16_t*)(smem + 95744);
    bf16_t* tk = (bf16_t*)(smem + 112640);
    bf16_t* tv = (bf16_t*)(smem + 137216);
    bf16_t* tvn = tk;
    bf16_t* icl = tk;
    const int tid = phase_tid(wv), lane = tid & 63, wave = tid >> 6, col = lane & 15, g = lane >> 4;
    for (int u = bidx; u < T / TOK; u += gdim) {
        const int t0 = u * TOK, s0 = t0 % S, bb = t0 / S;
        __syncthreads();
#pragma unroll 1
        for (int hb = 0; hb < 2; ++hb) {
            u32x2 wb[17];
#pragma unroll
            for (int q = 0; q < 17; ++q) {
                const int row = hb * 17 + q, sq = s0 - 1 + row;
                wb[q] = (u32x2){0u, 0u};
                if (sq >= 0 && sq < S && tid < 352) wb[q] = *(const u32x2*)(proj + (size_t)(t0 - 1 + row) * PLD + C_RW + tid * 4);
            }
            if (tid < 352) {
#pragma unroll
                for (int q = 0; q < 17; ++q) *(u32x2*)(winb + (hb * 17 + q) * RPROJ + tid * 4) = wb[q];
            }
        }
#pragma unroll 1
        for (int ps = 0; ps < 2; ++ps) {
            const int i = ps * 16 + (tid >> 5), l32 = tid & 31, t = t0 + i;
            float v[8], ug[8]; float sum = 0.f;
#pragma unroll
            for (int j = 0; j < 8; ++j) { const int c = j * 32 + l32; ug[j] = bf_lo((unsigned)proj[(size_t)t * PLD + c]); v[j] = bf_lo((unsigned)proj[(size_t)t * PLD + GW + c]); }
#pragma unroll
            for (int j = 0; j < 8; ++j) { const int c = j * 32 + l32; UG[(size_t)t * GW + c] = geluf_(ug[j]); v[j] = geluf_(v[j]); sum += v[j]; }
#pragma unroll
            for (int o = 16; o >= 1; o >>= 1) sum += SHX(sum, o, lane);
            const float mean = sum * (1.0f / GW); float q = 0.f;
#pragma unroll
            for (int j = 0; j < 8; ++j) { const float d = v[j] - mean; q += d * d; }
#pragma unroll
            for (int o = 16; o >= 1; o >>= 1) q += SHX(q, o, lane);
            const float rstd = 1.0f / sqrtf(q * (1.0f / GW) + LN_EPS);
#pragma unroll
            for (int j = 0; j < 8; ++j) { const int c = j * 32 + l32; tvn[c * TOK + i] = (bf16_t)f2bf((v[j] - mean) * rstd * gln_g[c] + gln_b[c]); }
        }
        __syncthreads();
#pragma unroll
        for (int q = 0; q < 2; ++q) {
            const int idx = tid + q * NTHREADS, c = idx >> 2, pc = idx & 3;
            *(u32x4*)(VNT + ((size_t)bb * GW + c) * S + s0 + pc * 8) = *(const u32x4*)(tvn + c * TOK + pc * 8);
        }
        int tb2 = tid; PIN_V(tb2);
#pragma unroll 4
        for (int q = 0; q < 16; ++q) {
            const int idx = tb2 + q * NTHREADS, i = idx >> 8, j = idx & 255, rc = 1152 + j;
            const float pv = bf_lo((unsigned)winb[i * RPROJ + rc]), cv = bf_lo((unsigned)winb[(i + 1) * RPROJ + rc]), nv = bf_lo((unsigned)winb[(i + 2) * RPROJ + rc]);
            const float x = cv + mu0[rc] * (pv - cv) + mu1[rc] * (nv - cv);
            lin[i * LIN + j] = (bf16_t)f2bf(j < 64 ? ftanh(x) : (j < 128 ? x : sigmoidf_(x)));
        }
        __syncthreads();
#pragma unroll 1
        for (int qg = 0; qg < 3; ++qg) {
            bf16x8 bw_[5][4]; float bias_[5];
#pragma unroll
            for (int q5 = 0; q5 < 5; ++q5) {
                const int nt = wave * 15 + qg * 5 + q5, grp = nt / 24, c = (nt % 24) * 16 + col;
                const bf16_t* bw = LWT + (size_t)(nt * 16 + col) * 128 + 8 * g;
#pragma unroll
                for (int ks = 0; ks < 2; ++ks) bw_[q5][ks] = *(const bf16x8*)(bw + ks * 32);
                if (grp == 4) {
#pragma unroll
                    for (int ks = 2; ks < 4; ++ks) bw_[q5][ks] = *(const bf16x8*)(bw + ks * 32);
                }
                bias_[q5] = grp < 2 ? w0[grp * RW + c] : (grp < 4 ? a0[(grp - 2) * RW + c] : 0.f);
            }
#pragma unroll
            for (int q5 = 0; q5 < 5; ++q5) {
                const int nt = wave * 15 + qg * 5 + q5, grp = nt / 24, c = (nt % 24) * 16 + col;
                const int kcol = grp < 2 ? 0 : (grp < 4 ? 64 : 128);
#pragma unroll
                for (int mt = 0; mt < 2; ++mt) {
                    f32x4 acc = (f32x4){0.f, 0.f, 0.f, 0.f};
                    const bf16_t* la = lin + (mt * 16 + col) * LIN + kcol + 8 * g;
#pragma unroll
                    for (int ks = 0; ks < 2; ++ks) acc = MFMA16(*(const bf16x8*)(la + ks * 32), bw_[q5][ks], acc);
                    if (grp == 4) {
#pragma unroll
                        for (int ks = 2; ks < 4; ++ks) acc = MFMA16(*(const bf16x8*)(la + ks * 32), bw_[q5][ks], acc);
                    }
                    const size_t tb = (size_t)(t0 + mt * 16 + 4 * g);
                    if (grp < 2) {
#pragma unroll
                        for (int r = 0; r < 4; ++r) LWG[(size_t)grp * T * RW + (tb + r) * RW + c] = -fexp(-softplusf_(-(acc[r] + bias_[q5])) - 0.5f);
                    } else if (grp < 4) {
#pragma unroll
                        for (int r = 0; r < 4; ++r) icl[((grp - 2) * TOK + mt * 16 + 4 * g + r) * RW + c] = (bf16_t)f2bf(sigmoidf_(acc[r] + bias_[q5]));
                    } else {
#pragma unroll
                        for (int r = 0; r < 4; ++r) GATE[(tb + r) * RW + c] = acc[r];
                    }
                }
            }
        }
        __syncthreads();
        if (wave < 6) {
            int c = tid; PIN_V(c); const int h = wave;
            const float kkc = k_k[c], kac = k_a[c], rkc = r_k[c];
            const float m0r = mu0[c], m1r = mu1[c], m0k = mu0[RW + c], m1k = mu1[RW + c], m0v = mu0[2 * RW + c], m1v = mu1[2 * RW + c];
#pragma unroll 1
            for (int hb = 0; hb < 2; ++hb) {
                float ic0[16], ic1[16];
#pragma unroll
                for (int i = 0; i < 16; ++i) { ic0[i] = bf_lo((unsigned)icl[(hb * 16 + i) * RW + c]); ic1[i] = bf_lo((unsigned)icl[(TOK + hb * 16 + i) * RW + c]); }
#pragma unroll
                for (int i = 0; i < 16; ++i) {
                    const int it = hb * 16 + i, t = t0 + it;
                    const bf16_t* w_ = winb + it * RPROJ + c;
                    const float rp = bf_lo((unsigned)w_[0]), rc_ = bf_lo((unsigned)w_[RPROJ]), rn = bf_lo((unsigned)w_[2 * RPROJ]);
                    const float kp = bf_lo((unsigned)w_[RW]), kc_ = bf_lo((unsigned)w_[RPROJ + RW]), kn = bf_lo((unsigned)w_[2 * RPROJ + RW]);
                    const float vp = bf_lo((unsigned)w_[2 * RW]), vc_ = bf_lo((unsigned)w_[RPROJ + 2 * RW]), vn = bf_lo((unsigned)w_[2 * RPROJ + 2 * RW]);
                    const float r = rc_ + m0r * (rp - rc_) + m1r * (rn - rc_);
                    const float k = kc_ + m0k * (kp - kc_) + m1k * (kn - kc_);
                    const float v = vc_ + m0v * (vp - vc_) + m1v * (vn - vc_);
                    const size_t o = (size_t)t * RW + c;
                    const float kq = k * kkc;
                    const float n2 = wave_sum_fast(kq * kq, lane);
                    const float kk = kq / fmaxf(sqrtf(n2), 1e-12f);
                    const float kd0 = k * (1.0f + (ic0[i] - 1.0f) * kac), kd1 = k * (1.0f + (ic1[i] - 1.0f) * kac);
                    const float bon = wave_sum_fast(r * (kd0 + kd1) * rkc, lane);
                    u32x4 rec; rec.x = pk2(r, v); rec.y = pk2(kk, 0.f); rec.z = pk2(kk * ic0[i], kk * ic1[i]); rec.w = pk2(kd0, kd1);
                    RK7[o] = rec;
                    VB[o] = (bf16_t)(rec.x >> 16);
                    if (lane == 0) BONUS[(size_t)t * RH + h] = bon;
                }
            }
        }
        __syncthreads();
        {
            u32x2 wb[17], vb[6];
            const int rsel = tid >= 192 ? 1 : 0, c4 = tid - rsel * 192;
#pragma unroll
            for (int q = 0; q < 17; ++q) {
                const int row = 2 * q + rsel, sq = s0 - 1 + row;
                wb[q] = (u32x2){0u, 0u};
                if (tid < 384 && sq >= 0 && sq < S) wb[q] = *(const u32x2*)(proj + (size_t)(t0 - 1 + row) * PLD + C_MW + c4 * 4);
            }
#pragma unroll
            for (int q = 0; q < 6; ++q) { const int idx = tid + q * NTHREADS, i = idx / 96, cc = (idx % 96) * 4; vb[q] = *(const u32x2*)(proj + (size_t)(t0 + i) * PLD + C_MW + 2 * MW + cc); }
            if (tid < 384) {
#pragma unroll
                for (int q = 0; q < 17; ++q) *(u32x2*)(winb + (2 * q + rsel) * 768 + c4 * 4) = wb[q];
            }
#pragma unroll
            for (int q = 0; q < 6; ++q) { const int idx = tid + q * NTHREADS, i = idx / 96, cc = (idx % 96) * 4; const u32x2 v = vb[q];
                tv[(cc + 0) * TOK + i] = (bf16_t)(v.x & 0xffffu); tv[(cc + 1) * TOK + i] = (bf16_t)(v.x >> 16); tv[(cc + 2) * TOK + i] = (bf16_t)(v.y & 0xffffu); tv[(cc + 3) * TOK + i] = (bf16_t)(v.y >> 16); }
        }
        for (int idx = tid; idx < TOK * 24; idx += NTHREADS) {
            const int i = idx / 24, gi = idx % 24, t = t0 + i;
            const int isf = gi / 12, dir = (gi / 6) & 1, h = gi % 6;
            const float gg = projg[(size_t)t * 256 + (3456 - (PLD - 256)) + gi] + gate_b[gi];
            if (isf) LF[((size_t)dir * T + t) * MH + h] = -softplusf_(-gg); else IG[((size_t)dir * T + t) * MH + h] = gg;
        }
        __syncthreads();
        int tcv = tid; PIN_V(tcv);
#pragma unroll 4
        for (int q = 0; q < 48; ++q) {
            const int idx = tcv + q * NTHREADS, i = idx / 768, c = idx % 768, t = t0 + i;
            const bf16_t* w_ = winb + i * 768 + c;
            float y = conv_b[c] + bf_lo((unsigned)w_[0]) * conv_w[c] + bf_lo((unsigned)w_[768]) * conv_w[768 + c] + bf_lo((unsigned)w_[1536]) * conv_w[2 * 768 + c];
            y = y * sigmoidf_(y);
            if (c < MW) MQB[(size_t)t * MW + c] = (bf16_t)f2bf(y);
            else { const bf16_t kb = (bf16_t)f2bf(y * 0.125f); MKB[(size_t)t * MW + (c - MW)] = kb; tk[(c - MW) * TOK + i] = kb; }
        }
        __syncthreads();
#pragma unroll
        for (int q = 0; q < 6; ++q) {
            const int idx = tid + q * NTHREADS, pc = idx & 3, c = (idx >> 2) % MW, which = idx / (4 * MW);
            const u32x4 val = *(const u32x4*)((which ? tv : tk) + c * TOK + pc * 8);
            bf16_t* dst = (which ? VT : KT) + ((size_t)(bb * MH) * 64 + c) * S + s0 + pc * 8;
            *(u32x4*)dst = val;
        }
    }
    __syncthreads();
}

__device__ __forceinline__ void phase_gmlp_mix(const Params& P, int l, unsigned char* smem, int wv, int bid, int nb) {
    PIN_S(bid); PIN_S(nb);
    ParamsPtr pp = PARAMS_PTR(P); PIN_S(pp); unsigned char* ws = pp->ws;
    const float* UG = (const float*)(ws + O_UG); const bf16_t* VNT = (const bf16_t*)(ws + O_VNT); bf16_t* GRP = (bf16_t*)(ws + O_GRP);
    const bf16_t* WSB = (const bf16_t*)(ws + O_WSB) + (size_t)l * GH * CH * CH; const float* gbs = pp->in[5] + (size_t)l * GH * CH;
    const int tid = phase_tid(wv), lane = tid & 63, wave = tid >> 6, col = lane & 15, g = lane >> 4;
    constexpr int NU = NB * NCH * GH;
    bf16x8 wA[4], vA[4][4], wB[4], vB[4][4]; f32x4 uA[4], uB[4]; float bA, bB;
#define GM_LOAD(u_, W_, V_, U_, B_) do { const int h_ = (u_) % GH, c_ = ((u_) / GH) % NCH, b_ = (u_) / (GH * NCH); \
        const bf16_t* wb_ = WSB + (size_t)h_ * CH * CH + (size_t)(wave * 16 + col) * CH + 8 * g; \
        const bf16_t* vb_ = VNT + ((size_t)b_ * GW + h_ * 64 + col) * S + (size_t)c_ * CH + 8 * g; \
        _Pragma("unroll") for (int ks = 0; ks < 4; ++ks) { W_[ks] = *(const bf16x8*)(wb_ + ks * 32); \
            _Pragma("unroll") for (int et = 0; et < 4; ++et) V_[et][ks] = *(const bf16x8*)(vb_ + (size_t)et * 16 * S + ks * 32); } \
        const size_t t_ = (size_t)(b_ * S + c_ * CH + wave * 16 + col); \
        _Pragma("unroll") for (int et = 0; et < 4; ++et) U_[et] = *(const f32x4*)(UG + t_ * GW + h_ * 64 + et * 16 + 4 * g); \
        B_ = gbs[h_ * CH + wave * 16 + col]; } while (0)
#define GM_COMP(u_, W_, V_, U_, B_) do { const int h_ = (u_) % GH, c_ = ((u_) / GH) % NCH, b_ = (u_) / (GH * NCH); \
        const size_t t_ = (size_t)(b_ * S + c_ * CH + wave * 16 + col); \
        _Pragma("unroll") for (int et = 0; et < 4; ++et) { f32x4 acc = (f32x4){0.f, 0.f, 0.f, 0.f}; \
            _Pragma("unroll") for (int ks = 0; ks < 4; ++ks) acc = MFMA16(V_[et][ks], W_[ks], acc); \
            u32x2 o_; o_.x = pk2(U_[et][0] * (acc[0] + B_), U_[et][1] * (acc[1] + B_)); o_.y = pk2(U_[et][2] * (acc[2] + B_), U_[et][3] * (acc[3] + B_)); \
            *(u32x2*)(GRP + t_ * D + h_ * 64 + et * 16 + 4 * g) = o_; } } while (0)
    int u = bid;
    if (u < NU) GM_LOAD(u, wA, vA, uA, bA);
    while (u < NU) {
        const int u1 = u + nb;
        if (u1 < NU) GM_LOAD(u1, wB, vB, uB, bB);
        GM_COMP(u, wA, vA, uA, bA);
        if (u1 >= NU) break;
        const int u2 = u1 + nb;
        if (u2 < NU) GM_LOAD(u2, wA, vA, uA, bA);
        GM_COMP(u1, wB, vB, uB, bB);
        u = u2;
    }
#undef GM_LOAD
#undef GM_COMP
}

constexpr int SC_STEPS = 16;
constexpr int SC_BUF = SC_STEPS * 6 * 64;
__device__ __forceinline__ void phase_rwkv_scan(const Params& P, int l, unsigned char* smem, int wv, int bid, int nb) {
    PIN_S(bid); PIN_S(nb);
    ParamsPtr pp = PARAMS_PTR(P); PIN_S(pp); unsigned char* ws = pp->ws;
    const float* RR = (const float*)(ws + O_RR); const float* VV = (const float*)(ws + O_VV); const float* KK = (const float*)(ws + O_KK);
    const float* DEC = (const float*)(ws + O_DEC); const float* KD = (const float*)(ws + O_KD); const float* ICLR = (const float*)(ws + O_ICLR);
    float* SCAN = (float*)(ws + O_SCAN); const float* BRKR = (const float*)(ws + O_BRKR);
    const int tid = phase_tid(wv), lane = tid & 63, wave = tid >> 6, rl = (lane >> 4) & 1, kq = (lane & 15) | ((lane >> 5) << 4);
    float* buf = (float*)smem;
    float* scal = buf + 2 * SC_BUF;
    float* outb = scal + 2 * SC_STEPS * 2;
    typedef float f32x2 __attribute__((ext_vector_type(2)));
    for (int u = bid; u < 2 * NB * RH * 4; u += nb) {
        const int qt = u & 3, h = (u >> 2) % RH, b = (u / (4 * RH)) % NB, d = u / (4 * RH * NB);
        const size_t doff = (size_t)d * T * RW;
        float s0 = 0.f, s1 = 0.f;
        float pw[2], pa[2], pb[2], pk[2], pr[2], pv[2], psc = 0.f;
#define SC_LOAD(c) do { _Pragma("unroll") for (int i = 0; i < 2; ++i) { const int idx = tid + NTHREADS * i, st = idx >> 6, k = idx & 63; const int tau = (c) * SC_STEPS + st, sq = d ? S - 1 - tau : tau; \
            const size_t o = (size_t)(b * S + sq) * RW + h * 64 + k; \
            pw[i] = DEC[doff + o]; pa[i] = KK[o]; pb[i] = ICLR[doff + o]; pk[i] = KD[doff + o]; pr[i] = RR[o]; pv[i] = VV[o]; }     \
            if (tid < 2 * SC_STEPS) { const int tau = (c) * SC_STEPS + (tid >> 1), sq = d ? S - 1 - tau : tau; psc = BRKR[((size_t)(d * T + b * S + sq) * RH + h) * 2 + (tid & 1)]; } } while (0)
#define SC_WRITE(c) do { float* B_ = buf + ((c) & 1) * SC_BUF; _Pragma("unroll") for (int i = 0; i < 2; ++i) { const int idx = tid + NTHREADS * i, st = idx >> 6, k = idx & 63; \
            float* q_ = B_ + st * 384 + k; q_[0] = pw[i]; q_[64] = -pa[i]; q_[128] = pa[i] * pb[i]; q_[192] = pk[i]; q_[256] = pw[i] * pr[i]; q_[320] = pv[i]; } \
            if (tid < 2 * SC_STEPS) scal[((c) & 1) * SC_STEPS * 2 + tid] = psc; } while (0)
        __syncthreads();
        SC_LOAD(0); SC_WRITE(0);
        __syncthreads();
        const int row = qt * 16 + wave * 2 + rl;
        for (int c = 0; c < S / SC_STEPS; ++c) {
            const bool more = (c + 1) < S / SC_STEPS;
            if (more) SC_LOAD(c + 1);
            const float* B = buf + (c & 1) * SC_BUF; const float* sc = scal + (c & 1) * SC_STEPS * 2; float* ob = outb + (c & 1) * SC_STEPS * 16;
            float outs[SC_STEPS];
            f32x2 w2 = *(const f32x2*)(B + 2 * kq), a2 = *(const f32x2*)(B + 64 + 2 * kq), b2 = *(const f32x2*)(B + 128 + 2 * kq);
            f32x2 k2 = *(const f32x2*)(B + 192 + 2 * kq), wr2 = *(const f32x2*)(B + 256 + 2 * kq);
            float v = B[320 + row]; float br = sc[0], kr = sc[1];
#pragma unroll
            for (int st = 0; st < SC_STEPS; ++st) {
                const int sn = st + 1 < SC_STEPS ? st + 1 : st;
                const float* q = B + sn * 384;
                const f32x2 nw2 = *(const f32x2*)(q + 2 * kq), na2 = *(const f32x2*)(q + 64 + 2 * kq), nb2 = *(const f32x2*)(q + 128 + 2 * kq);
                const f32x2 nk2 = *(const f32x2*)(q + 192 + 2 * kq), nwr2 = *(const f32x2*)(q + 256 + 2 * kq);
                const float nv = q[320 + row], nbr = sc[sn * 2], nkr = sc[sn * 2 + 1];
                SCHED_BAR();
                float sa = s0 * a2.x + s1 * a2.y;
                float po = s0 * wr2.x + s1 * wr2.y;
                sa = row32_sum(sa); po = row32_sum(po);
                outs[st] = po + sa * br + v * kr;
                s0 = s0 * w2.x + (sa * b2.x + v * k2.x); s1 = s1 * w2.y + (sa * b2.y + v * k2.y);
                SCHED_BAR();
                w2 = nw2; a2 = na2; b2 = nb2; k2 = nk2; wr2 = nwr2; v = nv; br = nbr; kr = nkr;
            }
            if (kq == 0) {
#pragma unroll
                for (int st = 0; st < SC_STEPS; ++st) ob[st * 16 + wave * 2 + rl] = outs[st];
            }
            if (more) SC_WRITE(c + 1);
            __syncthreads();
            if (tid < 16 * SC_STEPS) {
                const int st = tid >> 4, r = tid & 15, tau = c * SC_STEPS + st, sq = d ? S - 1 - tau : tau;
                SCAN[doff + (size_t)(b * S + sq) * RW + h * 64 + qt * 16 + r] = ob[st * 16 + r];
            }
        }
#undef SC_LOAD
#undef SC_WRITE
    }
    __syncthreads();
}

constexpr int RST = 72;
constexpr int RARR = 64 * RST;
__device__ __forceinline__ f32x4 tile_nt(const bf16_t* Aa, int ta, const bf16_t* Ba, int tb, f32x4 acc, int col, int g) {
#pragma unroll
    for (int ks = 0; ks < 2; ++ks) {
        const bf16x8 af = *(const bf16x8*)(Aa + (ta * 16 + col) * RST + ks * 32 + 8 * g);
        const bf16x8 bfr = *(const bf16x8*)(Ba + (tb * 16 + col) * RST + ks * 32 + 8 * g);
        acc = MFMA16(af, bfr, acc);
    }
    return acc;
}
__device__ __forceinline__ void phase_rwkv_pre(const Params& P, int l, unsigned char* smem, int wv) {
    ParamsPtr pp = PARAMS_PTR(P); PIN_S(pp); unsigned char* ws = pp->ws; int bidx = (int)blockIdx.x, gdim = (int)gridDim.x; PIN_S(bidx); PIN_S(gdim);
    const u32x4* RK7 = (const u32x4*)(ws + O_RK7);
    const float* LWG = (const float*)(ws + O_LW);
    bf16_t* Qg = (bf16_t*)(ws + O_RQ); bf16_t* Ag = (bf16_t*)(ws + O_RA); bf16_t* Hg = (bf16_t*)(ws + O_RH); bf16_t* Gg = (bf16_t*)(ws + O_RG);
    const int tid0 = phase_tid(wv);
#define RW_STAGE_VARS int tid = tid0; PIN_V(tid); const int lane = tid & 63, wave = tid >> 6, col = lane & 15, g = lane >> 4; (void)lane; (void)wave; (void)col; (void)g;
    bf16_t* At = (bf16_t*)smem; bf16_t* Bt = At + RARR; bf16_t* Kt = Bt + RARR; bf16_t* Rt = Kt + RARR;
    bf16_t* BtT = Rt + RARR; bf16_t* KtT = BtT + RARR; bf16_t* VT = KtT + RARR;
    bf16_t* Lak = VT + RARR; bf16_t* Mrb = Lak + RARR; bf16_t* Mrk = Mrb + RARR; bf16_t* YT = Mrk + RARR; bf16_t* W2T = YT + RARR;
    bf16_t* Lbo = W2T + RARR;
    float* LabT = (float*)(Lbo + RARR);
    float* Xs = LabT + 4096;
    float* Pb = Xs + 4096;
    float* segs = Pb + 2048;
    float* PC = segs + 512;
    float plw[8]; u32x4 prec[8];
#define RW_LOAD(uu) do { const int c_ = (uu) % RNC, h_ = ((uu) / RNC) % RH, b_ = ((uu) / (RNC * RH)) % NB, d_ = (uu) / (RNC * RH * NB); const size_t doff_ = (size_t)d_ * T * RW; \
        const int ch_ = tid0 & 63, sg_ = tid0 >> 6; _Pragma("unroll") for (int j = 0; j < 8; ++j) { const int tau = c_ * RC + sg_ * 8 + j, sq = d_ ? S - 1 - tau : tau; const size_t o = (size_t)(b_ * S + sq) * RW + h_ * 64 + ch_; \
        plw[j] = LWG[doff_ + o]; prec[j] = RK7[o]; } } while (0)
    if (bidx < RUN) RW_LOAD(bidx);
    for (int u = bidx; u < RUN; u += gdim) {
        const int c = u % RNC, h = (u / RNC) % RH, b = (u / (RNC * RH)) % NB, d = u / (RNC * RH * NB);
        (void)c; (void)h; (void)b; (void)d;
        __syncthreads();
        {
            RW_STAGE_VARS
            const int ch = tid & 63, sg = tid >> 6;
            float lw[8]; unsigned kk[8], bq_[8], kd[8], rr[8], vv[8];
#pragma unroll
            for (int j = 0; j < 8; ++j) { lw[j] = plw[j]; kk[j] = prec[j].y & 0xffffu; bq_[j] = d ? (prec[j].z >> 16) : (prec[j].z & 0xffffu); kd[j] = d ? (prec[j].w >> 16) : (prec[j].w & 0xffffu); rr[j] = prec[j].x & 0xffffu; vv[j] = prec[j].x >> 16; }
            if (u + gdim < RUN) RW_LOAD(u + gdim);
            float run = 0.f;
#pragma unroll
            for (int j = 0; j < 8; ++j) { run += lw[j]; lw[j] = run; }
            segs[sg * 64 + ch] = run;
            __syncthreads();
            float off = 0.f;
            for (int q = 0; q < sg; ++q) off += segs[q * 64 + ch];
            u32x4 pbt, pkt, pvt; unsigned tb[8], tk[8], tvv[8];
            float prev = off;
#pragma unroll
            for (int j = 0; j < 8; ++j) {
                const int t = sg * 8 + j; const float cl = off + lw[j];
                const float ep = fexp(prev), en = fexp(-cl), epc = fexp(cl);
                const unsigned a_ = f2bf(-bf_lo(kk[j]) * ep), b_ = f2bf(bf_lo(bq_[j]) * en), k_ = f2bf(bf_lo(kd[j]) * en), r_ = f2bf(bf_lo(rr[j]) * epc), v_ = vv[j];
                At[t * RST + ch] = (bf16_t)a_; Bt[t * RST + ch] = (bf16_t)b_; Kt[t * RST + ch] = (bf16_t)k_; Rt[t * RST + ch] = (bf16_t)r_;
                tb[j] = b_; tk[j] = k_; tvv[j] = v_;
                prev = cl;
            }
            if (sg == 7) PC[ch] = fexp(prev);
            pbt.x = tb[0] | (tb[1] << 16); pbt.y = tb[2] | (tb[3] << 16); pbt.z = tb[4] | (tb[5] << 16); pbt.w = tb[6] | (tb[7] << 16);
            pkt.x = tk[0] | (tk[1] << 16); pkt.y = tk[2] | (tk[3] << 16); pkt.z = tk[4] | (tk[5] << 16); pkt.w = tk[6] | (tk[7] << 16);
            pvt.x = tvv[0] | (tvv[1] << 16); pvt.y = tvv[2] | (tvv[3] << 16); pvt.z = tvv[4] | (tvv[5] << 16); pvt.w = tvv[6] | (tvv[7] << 16);
            *(u32x4*)(BtT + ch * RST + sg * 8) = pbt; *(u32x4*)(KtT + ch * RST + sg * 8) = pkt; *(u32x4*)(VT + ch * RST + sg * 8) = pvt;
            for (int z_ = tid; z_ < 2 * RARR / 8; z_ += NTHREADS) ((u32x4*)YT)[z_] = (u32x4){0u, 0u, 0u, 0u};
        }
        __syncthreads();
        {
            RW_STAGE_VARS
            const int m = wave >> 1;
            const bf16_t* Ym = (m == 0 || m == 2) ? Bt : Kt; const bf16_t* Xm = (m < 2) ? At : Rt;
#pragma unroll 1
            for (int q = 0; q < 8; ++q) {
                const int tix = (wave & 1) * 8 + q, it = tix >> 2, tt = tix & 3;
                f32x4 acc = (f32x4){0.f, 0.f, 0.f, 0.f};
                if (it <= tt) acc = tile_nt(Ym, it, Xm, tt, acc, col, g);
                const int t = tt * 16 + col, i0 = it * 16 + 4 * g;
                float o4[4];
#pragma unroll
                for (int r = 0; r < 4; ++r) { const int i = i0 + r; const bool ok = m < 2 ? (i < t) : (i <= t); o4[r] = ok ? acc[r] : 0.f; }
                if (m == 0) {
#pragma unroll
                    for (int r = 0; r < 4; ++r) LabT[(i0 + r) * 64 + t] = o4[r];
                    const bool offd = it < tt;
                    u32x2 w2; w2.x = offd ? pk2(o4[0], o4[1]) : 0u; w2.y = offd ? pk2(o4[2], o4[3]) : 0u; *(u32x2*)(Lbo + t * RST + i0) = w2;
                }
                else { bf16_t* dst = (m == 1 ? Lak : (m == 2 ? Mrb : Mrk)) + t * RST + i0; u32x2 w2; w2.x = pk2(o4[0], o4[1]); w2.y = pk2(o4[2], o4[3]); *(u32x2*)dst = w2; }
            }
        }
        __syncthreads();
        {
            RW_STAGE_VARS
#pragma unroll
            for (int q = 0; q < 2; ++q) {
                const int tix = wave * 2 + q, tt = tix >> 2, et = tix & 3;
                f32x4 acc = (f32x4){0.f, 0.f, 0.f, 0.f};
                acc = tile_nt(Lak, tt, VT, et, acc, col, g);
#pragma unroll
                for (int r = 0; r < 4; ++r) Xs[(tt * 16 + 4 * g + r) * 64 + et * 16 + col] = acc[r];
            }
        }
        __syncthreads();
        {
            RW_STAGE_VARS
#pragma unroll 1
            for (int bb = 0; bb < 4; ++bb) {
                if (bb > 0) {
                    const bf16_t* Zt = (wave < 4 ? YT : W2T) + ((wave & 3) * 16 + col) * RST + 8 * g;
                    const bf16_t* La = Lbo + (16 * bb + col) * RST + 8 * g;
                    f32x4 acc = (f32x4){0.f, 0.f, 0.f, 0.f};
                    acc = MFMA16(*(const bf16x8*)La, *(const bf16x8*)Zt, acc);
                    if (bb > 2) acc = MFMA16(*(const bf16x8*)(La + 32), *(const bf16x8*)(Zt + 32), acc);
#pragma unroll
                    for (int r = 0; r < 4; ++r) Pb[(4 * g + r) * 128 + wave * 16 + col] = acc[r];
                }
                __syncthreads();
                if (wave < 2) {
                    float acc[16];
                    if (wave == 0) {
#pragma unroll
                        for (int r = 0; r < 16; ++r) acc[r] = bf_lo((unsigned)At[(16 * bb + r) * RST + lane]);
                    } else {
#pragma unroll
                        for (int r = 0; r < 16; ++r) acc[r] = Xs[(16 * bb + r) * 64 + lane];
                    }
                    if (bb > 0) {
#pragma unroll
                        for (int r = 0; r < 16; ++r) acc[r] += Pb[r * 128 + wave * 64 + lane];
                    }
                    const float* dp = LabT + (16 * bb) * 64 + 16 * bb;
#pragma unroll
                    for (int r = 1; r < 16; ++r)
#pragma unroll
                        for (int r2 = 0; r2 < r; ++r2) acc[r] += dp[r2 * 64 + r] * acc[r2];
                    bf16_t* dst = (wave == 0 ? YT : W2T) + lane * RST;
                    u32x4 w0, w1;
                    w0.x = pk2(acc[0], acc[1]); w0.y = pk2(acc[2], acc[3]); w0.z = pk2(acc[4], acc[5]); w0.w = pk2(acc[6], acc[7]);
                    w1.x = pk2(acc[8], acc[9]); w1.y = pk2(acc[10], acc[11]); w1.z = pk2(acc[12], acc[13]); w1.w = pk2(acc[14], acc[15]);
                    *(u32x4*)(dst + 16 * bb) = w0; *(u32x4*)(dst + 16 * bb + 8) = w1;
                }
                __syncthreads();
            }
        }
        __syncthreads();
        {
            RW_STAGE_VARS
            const int ty = wave >> 1;
#pragma unroll 1
            for (int q = 0; q < 8; ++q) {
                const int tix = (wave & 1) * 8 + q, ra = tix >> 2, cb = tix & 3;
                f32x4 acc = (f32x4){0.f, 0.f, 0.f, 0.f};
                if (ty == 0) {
                    acc = tile_nt(YT, ra, Mrb, cb, acc, col, g);
                    const u32x2 rt2 = *(const u32x2*)(Rt + (cb * 16 + col) * RST + ra * 16 + 4 * g);
                    u32x2 qb2; qb2.x = pk2(acc[0] + bf_lo(rt2.x), acc[1] + bf_hi(rt2.x)); qb2.y = pk2(acc[2] + bf_lo(rt2.y), acc[3] + bf_hi(rt2.y));
                    *(u32x2*)(Qg + (size_t)u * 4096 + ((((ra >> 1) * 4 + cb) * 64 + lane) * 8 + (ra & 1) * 4)) = qb2;
                } else if (ty == 1) {
                    acc = tile_nt(Mrb, ra, W2T, cb, acc, col, g); acc = tile_nt(Mrk, ra, VT, cb, acc, col, g);
                    { u32x2 hb; hb.x = pk2(acc[0], acc[1]); hb.y = pk2(acc[2], acc[3]); *(u32x2*)(Hg + (size_t)u * 4096 + (tix * 64 + lane) * 4) = hb; }
                } else if (ty == 2) {
                    acc = tile_nt(YT, ra, BtT, cb, acc, col, g);
                    const float pc = PC[cb * 16 + col]; const int k1 = cb * 16 + col;
                    float a4[4];
#pragma unroll
                    for (int r = 0; r < 4; ++r) a4[r] = pc * (acc[r] + ((ra * 16 + 4 * g + r) == k1 ? 1.0f : 0.f));
                    u32x2 ab2; ab2.x = pk2(a4[0], a4[1]); ab2.y = pk2(a4[2], a4[3]);
                    *(u32x2*)(Ag + (size_t)u * 4096 + ((((ra >> 1) * 4 + cb) * 64 + lane) * 8 + (ra & 1) * 4)) = ab2;
                } else {
                    acc = tile_nt(BtT, ra, W2T, cb, acc, col, g); acc = tile_nt(KtT, ra, VT, cb, acc, col, g);
#pragma unroll
                    for (int r = 0; r < 4; ++r) acc[r] *= PC[ra * 16 + 4 * g + r];
                    { u32x2 gb2; gb2.x = pk2(acc[0], acc[1]); gb2.y = pk2(acc[2], acc[3]); *(u32x2*)(Gg + (size_t)u * 4096 + (tix * 64 + lane) * 4) = gb2; }
                }
            }
        }
    }
    __syncthreads();
#undef RW_STAGE_VARS
#undef RW_LOAD
}
constexpr int RSEQ_WGS = 2 * NB * RH * 2;
template <int MODE = 0>
__device__ __forceinline__ void phase_rwkv_seq(const Params& P, int l, unsigned char* smem, int wv) {
    ParamsPtr pp = PARAMS_PTR(P); PIN_S(pp); unsigned char* ws = pp->ws; int bidx = (int)blockIdx.x, gdim = (int)gridDim.x; PIN_S(bidx); PIN_S(gdim);
    const bf16_t* Ag = (const bf16_t*)(ws + O_RA); const bf16_t* Gg = (const bf16_t*)(ws + O_RG); bf16_t* Sg = (bf16_t*)(ws + ((MODE & 4) ? O_XS : O_RS));
    const int tid = phase_tid(wv), lane = tid & 63, wave = tid >> 6, col = lane & 15, g = lane >> 4;
    if (wave >= 2) return;
    const int nwg = gdim < RSEQ_WGS ? gdim : RSEQ_WGS;
    if (bidx >= nwg) return;
    for (int un = wave * nwg + bidx; un < 2 * NB * RH * 4; un += 2 * nwg) {
        const int ch = un >> 2, eq = un & 3;
        f32x4 acc[4];
#pragma unroll
        for (int a_ = 0; a_ < 4; ++a_) acc[a_] = (f32x4){0.f, 0.f, 0.f, 0.f};
        u32x4 a0[4][2], a1[4][2], a2[4][2], a3[4][2]; u32x2 g0[4], g1[4], g2[4], g3[4];
        const unsigned aoff = (unsigned)(col * 64 + 16 * g), goff = (unsigned)(lane * 4), aoff8 = (unsigned)(lane * 8);
#define RS_LOAD(cc, AF, GQ) do { const int c_ = (cc) < RNC ? (cc) : RNC - 1; const bf16_t* ab_ = Ag + (size_t)(ch * RNC + c_) * 4096; const bf16_t* gb_ = Gg + (size_t)(ch * RNC + c_) * 4096 + eq * 256; \
            _Pragma("unroll") for (int ra = 0; ra < 4; ++ra) _Pragma("unroll") for (int p = 0; p < 2; ++p) AF[ra][p] = *(const u32x4*)(ab_ + ((p * 4 + ra) * 512) + aoff8); \
            _Pragma("unroll") for (int ra = 0; ra < 4; ++ra) GQ[ra] = *(const u32x2*)(gb_ + (ra * 1024) + goff); } while (0)
#define RS_STEP(c, AF, GQ) do { if (RNC % 4 == 0 || (c) < RNC) { SCHED_BAR(); bf16_t* sb_ = Sg + (size_t)(ch * RNC + (c)) * 4096 + eq * 1024; \
            bf16x8 bq[2]; _Pragma("unroll") for (int p = 0; p < 2; ++p) bq[p] = cvt8(acc[2 * p], acc[2 * p + 1]); \
            if (!(MODE & 1) || (c) == RNC - 1) { _Pragma("unroll") for (int p = 0; p < 2; ++p) *(bf16x8*)(sb_ + (p * 8) + aoff) = bq[p]; } \
            _Pragma("unroll") for (int ra = 0; ra < 4; ++ra) acc[ra] = (f32x4){bf_lo(GQ[ra].x), bf_hi(GQ[ra].x), bf_lo(GQ[ra].y), bf_hi(GQ[ra].y)}; \
            _Pragma("unroll") for (int ra = 0; ra < 4; ++ra) _Pragma("unroll") for (int p = 0; p < 2; ++p) acc[ra] = MFMA16(__builtin_bit_cast(bf16x8, AF[ra][p]), bq[p], acc[ra]); \
            if (!(MODE & 2)) RS_LOAD((c) + 4, AF, GQ); SCHED_BAR(); } } while (0)
        RS_LOAD(0, a0, g0); RS_LOAD(1, a1, g1); RS_LOAD(2, a2, g2); RS_LOAD(3, a3, g3);
#pragma unroll 1
        for (int c = 0; c < RNC; c += 4) { RS_STEP(c, a0, g0); RS_STEP(c + 1, a1, g1); RS_STEP(c + 2, a2, g2); RS_STEP(c + 3, a3, g3); }
#undef RS_LOAD
#undef RS_STEP
    }
}
__device__ __forceinline__ void phase_rwkv_out(const Params& P, int l, unsigned char* smem, int wv) {
    ParamsPtr pp = PARAMS_PTR(P); PIN_S(pp); unsigned char* ws = pp->ws; int bidx = (int)blockIdx.x, gdim = (int)gridDim.x; PIN_S(bidx); PIN_S(gdim);
    const bf16_t* Qg = (const bf16_t*)(ws + O_RQ); const bf16_t* Sg = (const bf16_t*)(ws + O_RS); const bf16_t* Hg = (const bf16_t*)(ws + O_RH);
    const bf16_t* VB = (const bf16_t*)(ws + O_VB); const float* GATE = (const float*)(ws + O_GATE); const float* BONUS = (const float*)(ws + O_BONUS);
    bf16_t* GRP = (bf16_t*)(ws + O_GRP);
    const float* rln_g = pp->in[15] + (size_t)l * RW; const float* rln_b = pp->in[16] + (size_t)l * RW;
    const int tid = phase_tid(wv), lane = tid & 63, wave = tid >> 6, col = lane & 15, g = lane >> 4;
    for (int pu = bidx * NWAVES + wave; pu < NB * RH * RNC; pu += gdim * NWAVES) {
        const int c = pu % RNC, h = (pu / RNC) % RH, b = pu / (RNC * RH);
        f32x4 o[2][4][4];
#pragma unroll
        for (int d = 0; d < 2; ++d) {
            const int u = ((d * NB + b) * RH + h) * RNC + (d ? RNC - 1 - c : c);
            const size_t ub = (size_t)u * 4096;
            bf16x8 qa[4][2], sb[4][2];
#pragma unroll
            for (int q = 0; q < 4; ++q)
#pragma unroll
                for (int ks = 0; ks < 2; ++ks) {
                    qa[q][ks] = *(const bf16x8*)(Qg + ub + ((ks * 4 + q) * 64 + lane) * 8);
                    sb[q][ks] = *(const bf16x8*)(Sg + ub + (q * 16 + col) * 64 + 16 * g + 8 * ks);
                }
#pragma unroll
            for (int tt = 0; tt < 4; ++tt)
#pragma unroll
                for (int et = 0; et < 4; ++et) {
                    const u32x2 hb = *(const u32x2*)(Hg + ub + ((tt * 4 + et) * 64 + lane) * 4);
                    f32x4 acc = (f32x4){bf_lo(hb.x), bf_hi(hb.x), bf_lo(hb.y), bf_hi(hb.y)};
#pragma unroll
                    for (int ks = 0; ks < 2; ++ks) acc = MFMA16(qa[tt][ks], sb[et][ks], acc);
                    o[d][tt][et] = acc;
                }
        }
        const int src = (3 - g) * 16 + col;
#pragma unroll
        for (int tt = 0; tt < 4; ++tt)
#pragma unroll
            for (int et = 0; et < 4; ++et)
#pragma unroll
                for (int r = 0; r < 4; ++r) o[0][tt][et][r] += SHL(o[1][3 - tt][et][3 - r], src);
        float* tile = (float*)smem + wave * (64 * 68);
        WAVE_SYNC();
#pragma unroll
        for (int tt = 0; tt < 4; ++tt)
#pragma unroll
            for (int et = 0; et < 4; ++et)
#pragma unroll
                for (int r = 0; r < 4; ++r) tile[(tt * 16 + 4 * g + r) * 68 + et * 16 + col] = o[0][tt][et][r];
        WAVE_SYNC();
        {
            const int c4 = (lane & 15) * 4, ch = h * 64 + c4;
            const f32x4 lg = *(const f32x4*)(rln_g + ch), lb = *(const f32x4*)(rln_b + ch);
#pragma unroll 1
            for (int qb = 0; qb < 2; ++qb) {
                f32x4 gt_[8]; u32x2 vb_[8]; float bo_[8];
#pragma unroll
                for (int q8 = 0; q8 < 8; ++q8) {
                    const size_t t = (size_t)(b * S + c * RC + (qb * 8 + q8) * 4 + (lane >> 4));
                    gt_[q8] = *(const f32x4*)(GATE + t * RW + ch); vb_[q8] = *(const u32x2*)(VB + t * RW + ch); bo_[q8] = BONUS[t * RH + h];
                }
#pragma unroll
                for (int q8 = 0; q8 < 8; ++q8) {
                    const int tl = (qb * 8 + q8) * 4 + (lane >> 4);
                    const size_t t = (size_t)(b * S + c * RC + tl);
                    const f32x4 x = *(const f32x4*)(tile + tl * 68 + c4);
                    const float mean = row16_sum((x.x + x.y) + (x.z + x.w)) * (1.0f / 64.0f);
                    const f32x4 dl = x - mean;
                    const float var = row16_sum((dl.x * dl.x + dl.y * dl.y) + (dl.z * dl.z + dl.w * dl.w)) * (1.0f / 64.0f);
                    const float rstd = 1.0f / sqrtf(var + GN_EPS);
                    f32x4 y = dl * rstd * lg + lb;
                    y.x += bo_[q8] * bf_lo(vb_[q8].x); y.y += bo_[q8] * bf_hi(vb_[q8].x); y.z += bo_[q8] * bf_lo(vb_[q8].y); y.w += bo_[q8] * bf_hi(vb_[q8].y);
                    y = y * gt_[q8];
                    u32x2 ob; ob.x = pk2(y.x, y.y); ob.y = pk2(y.z, y.w);
                    *(u32x2*)(GRP + t * D + GW + ch) = ob;
                }
            }
        }
    }
    __syncthreads();
}

__device__ __forceinline__ void phase_mlstm_local(const Params& P, int l, unsigned char* smem, int wv, int bid, int nb) {
    PIN_S(bid); PIN_S(nb);
    ParamsPtr pp = PARAMS_PTR(P); PIN_S(pp); unsigned char* ws = pp->ws;
    const bf16_t* KT = (const bf16_t*)(ws + O_KT); const bf16_t* VT = (const bf16_t*)(ws + O_VT);
    const float* IG = (const float*)(ws + O_IG); const float* LF = (const float*)(ws + O_LF);
    float* CL = (float*)(ws + O_CL); float* NLb = (float*)(ws + O_NL); float* ML = (float*)(ws + O_ML); float* BL = (float*)(ws + O_BL);
    float* GVT = (float*)(ws + O_GVT); float* PMX = (float*)(ws + O_PMX); float* BCT = (float*)(ws + O_BCT);
    const int tid = phase_tid(wv), lane = tid & 63, wave = tid >> 6, col = lane & 15, g = lane >> 4;
    float* wts = (float*)smem + wave * 128;
    for (int u = bid * NWAVES + wave; u < 2 * NB * MH * NCH; u += nb * NWAVES) {
        const int c = u % NCH, h = (u / NCH) % MH, p = u / (NCH * MH), d = p / NB, b = p % NB;
        const int tc = d ? NCH - 1 - c : c, tok0 = b * S + tc * CH;
        const int i0 = d ? 127 - 2 * lane : 2 * lane, i1 = d ? i0 - 1 : i0 + 1;
        const size_t g0 = ((size_t)d * T + tok0 + i0) * MH + h, g1 = ((size_t)d * T + tok0 + i1) * MH + h;
        const float lf0 = LF[g0], lf1 = LF[g1], ig0 = IG[g0], ig1 = IG[g1];
        const float c1 = lf0 + lf1;
        float incl = c1;
#pragma unroll
        for (int o = 1; o < 64; o <<= 1) { const float tq = SHUP(incl, o, lane); if (lane >= o) incl += tq; }
        const float excl = incl - c1, bc0 = excl + lf0, bc1 = incl;
        const float blast = RDL(incl, 63);
        const float gv0 = ig0 - bc0, gv1 = ig1 - bc1, pl1 = fmaxf(gv0, gv1);
        float mincl = pl1;
#pragma unroll
        for (int o = 1; o < 64; o <<= 1) { const float tq = SHUP(mincl, o, lane); if (lane >= o) mincl = fmaxf(mincl, tq); }
        float mexcl = SHUP(mincl, 1, lane); if (lane == 0) mexcl = -INFINITY;
        const float pm0 = fmaxf(mexcl, gv0), pm1 = mincl;
        const float mloc = blast + RDL(mincl, 63);
        WAVE_SYNC();
        wts[i0] = fexp(blast + gv0 - mloc); wts[i1] = fexp(blast + gv1 - mloc);
        GVT[g0] = gv0; GVT[g1] = gv1; PMX[g0] = pm0; PMX[g1] = pm1; BCT[g0] = bc0; BCT[g1] = bc1;
        if (lane == 0) { ML[u] = mloc; BL[u] = blast; }
        WAVE_SYNC();
        const bf16_t* vbase = VT + ((size_t)(b * MH + h) * 64) * S + (size_t)tc * CH;
        const bf16_t* kbase = KT + ((size_t)(b * MH + h) * 64) * S + (size_t)tc * CH;
        const unsigned loff = (unsigned)(col * S + 8 * g);
        f32x4 acc[4][4];
#pragma unroll
        for (int a_ = 0; a_ < 4; ++a_)
#pragma unroll
            for (int b_ = 0; b_ < 4; ++b_) acc[a_][b_] = (f32x4){0.f, 0.f, 0.f, 0.f};
        float nsum[4] = {0.f, 0.f, 0.f, 0.f};
#pragma unroll 1
        for (int ks = 0; ks < 4; ++ks) {
            const int ii = ks * 32 + 8 * g;
            const f32x4 w0 = *(const f32x4*)(wts + ii), w1 = *(const f32x4*)(wts + ii + 4);
            bf16x8 af[4], bfk[4];
#pragma unroll
            for (int q = 0; q < 4; ++q) af[q] = *(const bf16x8*)(vbase + ((size_t)q * 16 * S + ks * 32) + loff);
#pragma unroll
            for (int q = 0; q < 4; ++q) {
                const u32x4 kr = *(const u32x4*)(kbase + ((size_t)q * 16 * S + ks * 32) + loff);
                f32x4 k0, k1;
                k0.x = bf_lo(kr.x) * w0.x; k0.y = bf_hi(kr.x) * w0.y; k0.z = bf_lo(kr.y) * w0.z; k0.w = bf_hi(kr.y) * w0.w;
                k1.x = bf_lo(kr.z) * w1.x; k1.y = bf_hi(kr.z) * w1.y; k1.z = bf_lo(kr.w) * w1.z; k1.w = bf_hi(kr.w) * w1.w;
                nsum[q] += (k0.x + k0.y) + (k0.z + k0.w) + (k1.x + k1.y) + (k1.z + k1.w);
                bfk[q] = cvt8(k0, k1);
            }
#pragma unroll
            for (int a_ = 0; a_ < 4; ++a_)
#pragma unroll
                for (int b_ = 0; b_ < 4; ++b_) acc[a_][b_] = MFMA16(af[a_], bfk[b_], acc[a_][b_]);
        }
        float* cbase = CL + (size_t)u * 4096;
        const unsigned coff = (unsigned)(4 * g * 64 + col);
#pragma unroll
        for (int b_ = 0; b_ < 4; ++b_) {
#pragma unroll
            for (int a_ = 0; a_ < 4; ++a_)
#pragma unroll
                for (int r = 0; r < 4; ++r) cbase[(a_ * 16 * 64 + r * 64 + b_ * 16) + coff] = acc[a_][b_][r];
            float ns = nsum[b_]; ns += SHX(ns, 16, lane); ns += SHX(ns, 32, lane);
            if (g == 0) NLb[(size_t)u * 64 + b_ * 16 + col] = ns;
        }
    }
    __syncthreads();
}

__device__ __forceinline__ void phase_mlstm_carry(const Params& P, int l, unsigned char* smem, int wv, int bidx, int gdim) {
    ParamsPtr pp = PARAMS_PTR(P); PIN_S(pp); unsigned char* ws = pp->ws; PIN_S(bidx); PIN_S(gdim);
    float* CL = (float*)(ws + O_CL); float* NLb = (float*)(ws + O_NL); const float* ML = (const float*)(ws + O_ML); const float* BL = (const float*)(ws + O_BL);
    float* MIN = (float*)(ws + O_MIN);
    const int total = 2 * NB * MH * 4160;
    const int tid = phase_tid(wv);
    for (int gi = bidx * NTHREADS + tid; gi < total; gi += gdim * NTHREADS) {
        const int ph = gi / 4160, e = gi % 4160;
        float* base_ = e < 4096 ? CL + (size_t)ph * NCH * 4096 + e : NLb + (size_t)ph * NCH * 64 + (e - 4096);
        bf16_t* cb_ = (bf16_t*)(ws + O_CLB) + (size_t)ph * NCH * 4096 + e;
        const int stride = e < 4096 ? 4096 : 64;
        static_assert(NCH <= 32, "carry scan keeps one chunk value per register");
        float loc[NCH], bl[NCH], ml[NCH];
#pragma unroll
        for (int c = 0; c < NCH; ++c) { loc[c] = base_[(size_t)c * stride]; bl[c] = BL[ph * NCH + c]; ml[c] = ML[ph * NCH + c]; }
        float m = 0.f, val = 0.f;
#pragma unroll
        for (int c = 0; c < NCH; ++c) {
            if (e < 4096) cb_[(size_t)c * 4096] = (bf16_t)f2bf(val); else base_[(size_t)c * stride] = val;
            if (e == 0) MIN[ph * NCH + c] = m;
            const float mn = fmaxf(bl[c] + m, ml[c]);
            val = fexp(bl[c] + m - mn) * val + fexp(ml[c] - mn) * loc[c];
            m = mn;
        }
    }
}

__device__ __forceinline__ void phase_mlstm_out(const Params& P, int l, unsigned char* smem, int wv) {
    ParamsPtr pp = PARAMS_PTR(P); PIN_S(pp); unsigned char* ws = pp->ws; int bidx = (int)blockIdx.x, gdim = (int)gridDim.x; PIN_S(bidx); PIN_S(gdim);
    const bf16_t* proj = (const bf16_t*)(ws + O_PROJ);
    const bf16_t* MQB = (const bf16_t*)(ws + O_MQB); const bf16_t* MKB = (const bf16_t*)(ws + O_MKB); const bf16_t* VT = (const bf16_t*)(ws + O_VT);
    const float* GVT = (const float*)(ws + O_GVT); const float* PMX = (const float*)(ws + O_PMX); const float* BCT = (const float*)(ws + O_BCT);
    const bf16_t* CLB = (const bf16_t*)(ws + O_CLB); const float* NLb = (const float*)(ws + O_NL); const float* MIN = (const float*)(ws + O_MIN);
    bf16_t* GRP = (bf16_t*)(ws + O_GRP);
    const float* mln_g = pp->in[20] + (size_t)l * MW;
    const int tid = phase_tid(wv), lane = tid & 63, wave = tid >> 6, col = lane & 15, g = lane >> 4;
    constexpr int KP = 72, VP = 136, STG = 128 * KP * 2 + 64 * VP * 2 + 2 * 128 * 4;
    constexpr int NUm = NB * MH * NCH;
    const int it = wave * 16 + col;
    u32x4 kb_[2], vb_[2]; float gq_ = 0.f; bf16x8 bqn[2]; float minn[2], pmxn[2], bctn[2];
#define MO_EARLY(u_) do { const int tc_ = (u_) % NCH, h_ = ((u_) / NCH) % MH, b_ = (u_) / (NCH * MH); const int tok0_ = b_ * S + tc_ * CH; \
        _Pragma("unroll") for (int q = 0; q < 2; ++q) { const int idx = tid + q * NTHREADS; \
            kb_[q] = *(const u32x4*)(MKB + (size_t)(tok0_ + (idx >> 3)) * MW + h_ * 64 + (idx & 7) * 8); \
            vb_[q] = *(const u32x4*)(VT + ((size_t)(b_ * MH + h_) * 64 + (idx >> 4)) * S + (size_t)tc_ * CH + (idx & 15) * 8); } \
        if (tid < 256) gq_ = GVT[((size_t)(tid >> 7) * T + tok0_ + (tid & 127)) * MH + h_]; \
        const size_t trow_ = (size_t)(tok0_ + it); \
        _Pragma("unroll") for (int ks = 0; ks < 2; ++ks) bqn[ks] = *(const bf16x8*)(MQB + trow_ * MW + h_ * 64 + ks * 32 + 8 * g); \
        _Pragma("unroll") for (int d = 0; d < 2; ++d) { const int su_ = ((d * NB + b_) * MH + h_) * NCH + (d ? NCH - 1 - tc_ : tc_); const size_t gt_ = ((size_t)d * T + trow_) * MH + h_; \
            minn[d] = MIN[su_]; pmxn[d] = PMX[gt_]; bctn[d] = BCT[gt_]; } } while (0)
    int u = bidx, ui = 0;
    if (u < NUm) MO_EARLY(u);
    for (; u < NUm; u += gdim, ++ui) {
        const int tc = u % NCH, h = (u / NCH) % MH, b = u / (NCH * MH);
        const int tok0 = b * S + tc * CH;
        bf16_t* Ks = (bf16_t*)(smem + (ui & 1) * STG);
        bf16_t* Vs = Ks + 128 * KP;
        float* gvs_ = (float*)(Vs + 64 * VP);
#pragma unroll
        for (int q = 0; q < 2; ++q) {
            const int idx = tid + q * NTHREADS;
            *(u32x4*)(Ks + (idx >> 3) * KP + (idx & 7) * 8) = kb_[q];
            *(u32x4*)(Vs + (idx >> 4) * VP + (idx & 15) * 8) = vb_[q];
        }
        if (tid < 256) gvs_[tid] = gq_;
        bf16x8 bq[2] = {bqn[0], bqn[1]};
        const float mst_[2] = {minn[0], minn[1]}, pmx_[2] = {pmxn[0], pmxn[1]}, bct_[2] = {bctn[0], bctn[1]};
        const size_t trow = (size_t)(tok0 + it);
        bf16x8 cq[2][4][2]; f32x4 nl[2][2][2]; u32x2 og[4];
#define MO_LATE(d) do { const int su = (((d) * NB + b) * MH + h) * NCH + ((d) ? NCH - 1 - tc : tc); \
            _Pragma("unroll") for (int ks = 0; ks < 2; ++ks) { const float* np = NLb + (size_t)su * 64 + ks * 32 + 8 * g; \
                nl[d][ks][0] = *(const f32x4*)np; nl[d][ks][1] = *(const f32x4*)(np + 4); \
                _Pragma("unroll") for (int et = 0; et < 4; ++et) cq[d][et][ks] = *(const bf16x8*)(CLB + (size_t)su * 4096 + (size_t)(et * 16 + col) * 64 + ks * 32 + 8 * g); } } while (0)
        MO_LATE(0);
#pragma unroll
        for (int et = 0; et < 4; ++et) og[et] = *(const u32x2*)(proj + trow * PLD + C_MW + 3 * MW + h * 64 + et * 16 + 4 * g);
        __syncthreads();
        if (u + gdim < NUm) MO_EARLY(u + gdim);
        f32x4 hs[4];
#pragma unroll
        for (int et = 0; et < 4; ++et) hs[et] = (f32x4){0.f, 0.f, 0.f, 0.f};
#pragma unroll
        for (int d = 0; d < 2; ++d) {
            if (d == 1) MO_LATE(1);
            const float mst = mst_[d];
            const float mxt = fmaxf(pmx_[d], mst), mt = bct_[d] + mxt, wint = fexp(mst - mxt);
            f32x4 num[4];
#pragma unroll
            for (int et = 0; et < 4; ++et) num[et] = (f32x4){0.f, 0.f, 0.f, 0.f};
            float den = 0.f;
            for (int sp = 0; sp < 4; ++sp) {
                if (d == 0 ? (2 * sp > wave) : (2 * sp + 1 < wave)) continue;
                float pw[8];
#pragma unroll
                for (int hf = 0; hf < 2; ++hf) {
                    const int st = 2 * sp + hf;
                    f32x4 sacc = (f32x4){0.f, 0.f, 0.f, 0.f};
#pragma unroll
                    for (int ks = 0; ks < 2; ++ks) sacc = MFMA16(*(const bf16x8*)(Ks + (st * 16 + col) * KP + ks * 32 + 8 * g), bq[ks], sacc);
                    const f32x4 g4 = *(const f32x4*)(gvs_ + d * 128 + st * 16 + 4 * g);
#pragma unroll
                    for (int r = 0; r < 4; ++r) {
                        const int is = st * 16 + 4 * g + r;
                        const bool ok = d == 0 ? (is <= it) : (is >= it);
                        const float pr = ok ? sacc[r] * fexp(g4[r] - mxt) : 0.f;
                        den += pr; pw[hf * 4 + r] = pr;
                    }
                }
                u32x4 pb; pb.x = pk2(pw[0], pw[1]); pb.y = pk2(pw[2], pw[3]); pb.z = pk2(pw[4], pw[5]); pb.w = pk2(pw[6], pw[7]);
                const bf16x8 bp = __builtin_bit_cast(bf16x8, pb);
#pragma unroll
                for (int et = 0; et < 4; ++et) {
                    const bf16_t* vp = Vs + (et * 16 + col) * VP + sp * 32 + 4 * g;
                    const u32x2 v0 = *(const u32x2*)vp, v1 = *(const u32x2*)(vp + 16);
                    u32x4 va; va.x = v0.x; va.y = v0.y; va.z = v1.x; va.w = v1.y;
                    num[et] = MFMA16(__builtin_bit_cast(bf16x8, va), bp, num[et]);
                }
            }
            den += SHX(den, 16, lane); den += SHX(den, 32, lane);
            f32x4 qc[4]; float qn = 0.f;
#pragma unroll
            for (int ks = 0; ks < 2; ++ks) {
                const f32x4 n0 = nl[d][ks][0], n1 = nl[d][ks][1];
                const u32x4 qb = __builtin_bit_cast(u32x4, bq[ks]);
                qn += (bf_lo(qb.x) * n0.x + bf_hi(qb.x) * n0.y) + (bf_lo(qb.y) * n0.z + bf_hi(qb.y) * n0.w) + (bf_lo(qb.z) * n1.x + bf_hi(qb.z) * n1.y) + (bf_lo(qb.w) * n1.z + bf_hi(qb.w) * n1.w);
            }
            qn += SHX(qn, 16, lane); qn += SHX(qn, 32, lane);
#pragma unroll
            for (int et = 0; et < 4; ++et) {
                qc[et] = (f32x4){0.f, 0.f, 0.f, 0.f};
#pragma unroll
                for (int ks = 0; ks < 2; ++ks) qc[et] = MFMA16(cq[d][et][ks], bq[ks], qc[et]);
            }
            const float dd = frcp(fmaxf(fabsf(den + wint * qn), fexp(-mt)));
#pragma unroll
            for (int et = 0; et < 4; ++et) hs[et] += (num[et] + wint * qc[et]) * dd;
        }
        float sm = 0.f;
#pragma unroll
        for (int et = 0; et < 4; ++et) sm += (hs[et].x + hs[et].y) + (hs[et].z + hs[et].w);
        sm += SHX(sm, 16, lane); sm += SHX(sm, 32, lane);
        const float mean = sm * (1.0f / 64.0f); float q = 0.f;
#pragma unroll
        for (int et = 0; et < 4; ++et) { const f32x4 dl = hs[et] - mean; q += (dl.x * dl.x + dl.y * dl.y) + (dl.z * dl.z + dl.w * dl.w); }
        q += SHX(q, 16, lane); q += SHX(q, 32, lane);
        const float rstd = 1.0f / sqrtf(q * (1.0f / 64.0f) + LN_EPS);
#pragma unroll
        for (int et = 0; et < 4; ++et) {
            const int c = h * 64 + et * 16 + 4 * g;
            const u32x2 ob_ = og[et]; const f32x4 o4 = (f32x4){bf_lo(ob_.x), bf_hi(ob_.x), bf_lo(ob_.y), bf_hi(ob_.y)}, g4 = *(const f32x4*)(mln_g + c);
            const f32x4 y = (hs[et] - mean) * rstd * g4;
            u32x2 ob; ob.x = pk2(sigmoidf_(o4.x) * y.x, sigmoidf_(o4.y) * y.y); ob.y = pk2(sigmoidf_(o4.z) * y.z, sigmoidf_(o4.w) * y.w);
            *(u32x2*)(GRP + trow * D + GW + RW + c) = ob;
        }
    }
#undef MO_EARLY
#undef MO_LATE
    __syncthreads();
}

__device__ __forceinline__ void phase_rwkv_post(const Params& P, int l, unsigned char* smem, int wv) {
    ParamsPtr pp = PARAMS_PTR(P); PIN_S(pp); unsigned char* ws = pp->ws; int bidx = (int)blockIdx.x, gdim = (int)gridDim.x; PIN_S(bidx); PIN_S(gdim);
    const float* SCAN = (const float*)(ws + O_SCAN); const float* VV = (const float*)(ws + O_VV); const float* GATE = (const float*)(ws + O_GATE);
    const float* BONUS = (const float*)(ws + O_BONUS); bf16_t* GRP = (bf16_t*)(ws + O_GRP);
    const float* rln_g = pp->in[15] + (size_t)l * RW; const float* rln_b = pp->in[16] + (size_t)l * RW;
    const int tid = phase_tid(wv), lane = tid & 63, wave = tid >> 6;
    const int gw = bidx * NWAVES + wave, ngw = NWAVES * gdim;
    for (int it = gw; it < T * RH; it += ngw) {
        const int t = it / RH, h = it % RH, c = h * 64 + lane;
        const size_t o = (size_t)t * RW + c;
        const float x = SCAN[o] + SCAN[(size_t)T * RW + o];
        const float mean = wave_sum(x, lane) * (1.0f / 64.0f);
        const float dl = x - mean;
        const float var = wave_sum(dl * dl, lane) * (1.0f / 64.0f);
        float y = dl / sqrtf(var + GN_EPS) * rln_g[c] + rln_b[c];
        y += BONUS[(size_t)t * RH + h] * VV[o];
        GRP[(size_t)t * D + GW + c] = (bf16_t)f2bf(y * GATE[o]);
    }
}

__device__ __forceinline__ void phase_ln1_router(const Params& P, int l, unsigned char* smem, int wv) {
    ParamsPtr pp = PARAMS_PTR(P); PIN_S(pp); unsigned char* ws = pp->ws; int bidx = (int)blockIdx.x, gdim = (int)gridDim.x; PIN_S(bidx); PIN_S(gdim);
    const bf16_t* xin = (const bf16_t*)(ws + O_XB);
    const bf16_t* MIX = (const bf16_t*)(ws + O_MIX);
    int* TOPI = (int*)(ws + O_TOPI); float* TOPG = (float*)(ws + O_TOPG); int* RANK = (int*)(ws + O_RANK); bf16_t* X1B = (bf16_t*)(ws + O_X1B);
    int* BCNT = (int*)(ws + O_BCNT);
    const float* g1 = pp->in[22] + (size_t)l * D; const float* b1 = pp->in[23] + (size_t)l * D;
    const float* rw = pp->in[24] + (size_t)l * D * NE; const float* rb = pp->in[25] + (size_t)l * NE;
    const bf16_t* RWT = (const bf16_t*)(ws + O_RWT) + (size_t)l * 2 * NE * D;
    const int tid = phase_tid(wv), lane = tid & 63, wave = tid >> 6, col = lane & 15, g = lane >> 4;
    float* lgs = (float*)smem;
    int* stopi = (int*)(smem + 8192);
    for (int tile = bidx; tile < T / 64; tile += gdim) {
        __syncthreads();
        {
            u32x2 xa[4]; u32x2 xm[4];
#define LN1_LOAD(tt_) do { _Pragma("unroll") for (int j = 0; j < 4; ++j) { const int c = j * 256 + lane * 4; xa[j] = *(const u32x2*)(xin + (size_t)(tt_) * D + c); xm[j] = *(const u32x2*)(MIX + (size_t)(tt_) * D + c); } } while (0)
            LN1_LOAD(tile * 64 + wave * 8);
#pragma unroll 1
            for (int ti8 = 0; ti8 < 8; ++ti8) {
                const int t = tile * 64 + wave * 8 + ti8;
                float v[16]; float sm = 0.f;
#pragma unroll
                for (int j = 0; j < 4; ++j) {
                    v[j * 4 + 0] = ALPHA * bf_lo(xa[j].x) + bf_lo(xm[j].x); v[j * 4 + 1] = ALPHA * bf_hi(xa[j].x) + bf_hi(xm[j].x); v[j * 4 + 2] = ALPHA * bf_lo(xa[j].y) + bf_lo(xm[j].y); v[j * 4 + 3] = ALPHA * bf_hi(xa[j].y) + bf_hi(xm[j].y);
                    sm += (v[j * 4] + v[j * 4 + 1]) + (v[j * 4 + 2] + v[j * 4 + 3]);
                }
                if (ti8 < 7) LN1_LOAD(t + 1);
                const float mean = wave_sum_fast(sm, lane) * (1.0f / D); float q = 0.f;
#pragma unroll
                for (int j = 0; j < 16; ++j) { const float dl = v[j] - mean; q += dl * dl; }
                const float rstd = 1.0f / sqrtf(wave_sum_fast(q, lane) * (1.0f / D) + LN_EPS);
#pragma unroll
                for (int j = 0; j < 4; ++j) {
                    const int c = j * 256 + lane * 4;
                    const f32x4 gg = *(const f32x4*)(g1 + c), bb = *(const f32x4*)(b1 + c);
                    f32x4 o;
                    o.x = (v[j * 4 + 0] - mean) * rstd * gg.x + bb.x; o.y = (v[j * 4 + 1] - mean) * rstd * gg.y + bb.y;
                    o.z = (v[j * 4 + 2] - mean) * rstd * gg.z + bb.z; o.w = (v[j * 4 + 3] - mean) * rstd * gg.w + bb.w;
                    u32x2 ob; ob.x = pk2(o.x, o.y); ob.y = pk2(o.z, o.w); *(u32x2*)(X1B + (size_t)t * D + c) = ob;
                }
            }
#undef LN1_LOAD
        }
        __syncthreads();
        {
            const bf16_t* xr = X1B + (size_t)(tile * 64 + (wave >> 1) * 16 + col) * D + 8 * g;
            const bf16_t* wh = RWT + (size_t)((wave & 1) * 16 + col) * D + 8 * g; const bf16_t* wl = wh + (size_t)NE * D;
            f32x4 acc = (f32x4){0.f, 0.f, 0.f, 0.f};
#pragma unroll 4
            for (int ks = 0; ks < 32; ++ks) {
                const bf16x8 ah = *(const bf16x8*)(xr + ks * 32);
                const bf16x8 bh = *(const bf16x8*)(wh + ks * 32), bl = *(const bf16x8*)(wl + ks * 32);
                acc = MFMA16(ah, bh, acc); acc = MFMA16(ah, bl, acc);
            }
            const float rbv = rb[(wave & 1) * 16 + col];
#pragma unroll
            for (int r = 0; r < 4; ++r) lgs[((wave >> 1) * 16 + 4 * g + r) * NE + (wave & 1) * 16 + col] = acc[r] + rbv;
        }
        __syncthreads();
        if (tid < 64) {
            const float* lp = lgs + tid * NE; const int t = tile * 64 + tid;
            float tv[4]; int ti[4];
#pragma unroll
            for (int k = 0; k < 4; ++k) { tv[k] = -INFINITY; ti[k] = 0; }
            for (int e = 0; e < NE; ++e) {
                const float x = lp[e];
                if (x > tv[3]) {
                    if (x > tv[0]) { tv[3] = tv[2]; ti[3] = ti[2]; tv[2] = tv[1]; ti[2] = ti[1]; tv[1] = tv[0]; ti[1] = ti[0]; tv[0] = x; ti[0] = e; }
                    else if (x > tv[1]) { tv[3] = tv[2]; ti[3] = ti[2]; tv[2] = tv[1]; ti[2] = ti[1]; tv[1] = x; ti[1] = e; }
                    else if (x > tv[2]) { tv[3] = tv[2]; ti[3] = ti[2]; tv[2] = x; ti[2] = e; }
                    else { tv[3] = x; ti[3] = e; }
                }
            }
            const float e1 = expf(tv[1] - tv[0]), e2 = expf(tv[2] - tv[0]), e3 = expf(tv[3] - tv[0]);
            const float inv = 1.0f / (1.0f + e1 + e2 + e3);
            *(f32x4*)(TOPG + (size_t)t * 4) = (f32x4){inv, e1 * inv, e2 * inv, e3 * inv};
#pragma unroll
            for (int k = 0; k < 4; ++k) { TOPI[(size_t)t * 4 + k] = ti[k]; stopi[tid * 4 + k] = ti[k]; }
        }
        __syncthreads();
        if (tid < 256) { const int e = stopi[tid]; int r = 0; for (int a2 = 0; a2 < tid; ++a2) r += (stopi[a2] == e) ? 1 : 0; RANK[(size_t)tile * 256 + tid] = r; }
        else if (tid < 256 + NE) { const int e = tid - 256; int cnt = 0; for (int a2 = 0; a2 < 256; ++a2) cnt += (stopi[a2] == e) ? 1 : 0; BCNT[tile * NE + e] = cnt; }
    }
    __syncthreads();
}

__device__ __forceinline__ void moe_offsets(int* sh, const int* CNT, int tid) {
    if (tid == 0) {
        int acc = 0;
        for (int e = 0; e < NE; ++e) { const int c = (int)CNT[e]; sh[e] = c; sh[32 + e] = acc; acc += (c + MOEB - 1) / MOEB * MOEB; sh[64 + e] = acc; }
    }
    __syncthreads();
}
__device__ __forceinline__ int moe_expert_of_row(const int* sh, int r) {
    int e = -1;
    for (int i = 0; i < NE; ++i) if (r >= sh[32 + i] && r < sh[64 + i]) e = i;
    return e;
}

__device__ __forceinline__ void phase_scatter(const Params& P, int l, unsigned char* smem, int wv) {
    ParamsPtr pp = PARAMS_PTR(P); PIN_S(pp); unsigned char* ws = pp->ws; int bidx = (int)blockIdx.x, gdim = (int)gridDim.x; PIN_S(bidx); PIN_S(gdim);
    const int tid = phase_tid(wv);
    const int* TOPI = (const int*)(ws + O_TOPI); const int* RANK = (const int*)(ws + O_RANK); int* SLOT = (int*)(ws + O_SLOT); int* ROWT = (int*)(ws + O_ROWT);
    const int* BCNT = (const int*)(ws + O_BCNT); int* CNTF = (int*)(ws + O_CNTF);
    int* sh = (int*)smem;
    int* part = sh + 96;
    int* tot = part + 512;
    int* base = tot + 32;
    constexpr int NT = T / 64;
    const int e = tid & 31, pt = tid >> 5;
    { int sacc = 0; for (int tl = pt; tl < NT; tl += 16) sacc += BCNT[tl * NE + e]; part[pt * 32 + e] = sacc; }
    __syncthreads();
    if (tid < 32) { int sacc = 0; for (int q = 0; q < 16; ++q) sacc += part[q * 32 + tid]; tot[tid] = sacc; if (bidx == 0) CNTF[tid] = sacc; }
    __syncthreads();
    moe_offsets(sh, tot, tid);
    for (int ee = bidx; ee < NE; ee += gdim)
        for (int r = sh[32 + ee] + sh[ee] + tid; r < sh[64 + ee]; r += NTHREADS) ROWT[r] = 0;
    for (int tile = bidx; tile < NT; tile += gdim) {
        __syncthreads();
        { int sacc = 0; for (int tl = pt; tl < tile; tl += 16) sacc += BCNT[tl * NE + e]; part[pt * 32 + e] = sacc; }
        __syncthreads();
        if (tid < 32) { int sacc = sh[32 + tid]; for (int q = 0; q < 16; ++q) sacc += part[q * 32 + tid]; base[tid] = sacc; }
        __syncthreads();
        if (tid < 256) { const int a = tile * 256 + tid, dest = base[TOPI[a]] + RANK[a]; SLOT[a] = dest; ROWT[dest] = a >> 2; }
    }
    __syncthreads();
}

template <int WHICH>
__device__ __forceinline__ void phase_moe_gemm(const Params& P, int l, unsigned char* smem, int wv) {
    ParamsPtr pp = PARAMS_PTR(P); PIN_S(pp); unsigned char* ws = pp->ws; int bidx = (int)blockIdx.x, gdim = (int)gridDim.x; PIN_S(bidx); PIN_S(gdim);
    const int tid = phase_tid(wv);
    const int* CNT = (const int*)(ws + O_CNTF);
    int* sh = (int*)(smem + 131072);
    int* rbe = sh + 96;
    moe_offsets(sh, CNT, tid);
    const int nrb = sh[64 + NE - 1] / MOEB;
    for (int rb = tid; rb < nrb; rb += NTHREADS) rbe[rb] = moe_expert_of_row(sh, rb * MOEB);
    __syncthreads();
    pg8::MoeOrderT<WHICH == 1> S;
    S.K = 1024; S.G_ = gdim; S.c = bidx; S.rbe = rbe; S.rowmap = (const int*)(ws + O_ROWT);
    if (WHICH == 1) {
        S.A = (const char*)(ws + O_X1B); S.Wt = (const char*)(ws + O_W1) + (size_t)l * NE * 2 * DFF * D * 2; S.estride = (size_t)2 * DFF * D * 2; S.nN = 2 * DFF / 256; S.nwg = nrb * S.nN;
        pg8::EpiSwiglu E{(bf16_t*)(ws + O_ACT), pp->in[27] + (size_t)l * NE * 2 * DFF};
        pg8::gemm_phase<pg8::EpiSwiglu, pg8::MoeOrderT<WHICH == 1>>((LAS unsigned char*)smem, 1024, S, E, tid);
    } else {
        S.A = (const char*)(ws + O_ACT); S.Wt = (const char*)(ws + O_W2) + (size_t)l * NE * D * DFF * 2; S.estride = (size_t)D * DFF * 2; S.nN = D / 256; S.nwg = nrb * S.nN;
        pg8::EpiBf16Bias E{(bf16_t*)(ws + O_YS), D, pp->in[29] + (size_t)l * NE * D, D};
        pg8::gemm_phase<pg8::EpiBf16Bias, pg8::MoeOrderT<WHICH == 1>>((LAS unsigned char*)smem, 1024, S, E, tid);
    }
    __syncthreads();
}

__device__ __forceinline__ void phase_combine_ln2(const Params& P, int l, unsigned char* smem, int wv) {
    ParamsPtr pp = PARAMS_PTR(P); PIN_S(pp); unsigned char* ws = pp->ws; int bidx = (int)blockIdx.x, gdim = (int)gridDim.x; PIN_S(bidx); PIN_S(gdim);
    const bf16_t* X1 = (const bf16_t*)(ws + O_X1B); const bf16_t* YS = (const bf16_t*)(ws + O_YS); bf16_t* XB = (bf16_t*)(ws + O_XB);
    const int* SLOT = (const int*)(ws + O_SLOT); const float* TOPG = (const float*)(ws + O_TOPG);
    float* xo = pp->out;
    const float* g2 = pp->in[30] + (size_t)l * D; const float* b2 = pp->in[31] + (size_t)l * D;
    const int tid = phase_tid(wv), lane = tid & 63, wave = tid >> 6;
    const int gw = bidx * NWAVES + wave, ngw = NWAVES * gdim;
    u32x4 sl_n = (u32x4){0u, 0u, 0u, 0u}; f32x4 gg_n = (f32x4){0.f, 0.f, 0.f, 0.f};
    u32x2 xa_n[4]; u32x2 ys_n[4][4]; f32x4 gg_c = (f32x4){0.f, 0.f, 0.f, 0.f};
    const f32x4 lg[4] = {*(const f32x4*)(g2 + lane * 4), *(const f32x4*)(g2 + 256 + lane * 4), *(const f32x4*)(g2 + 512 + lane * 4), *(const f32x4*)(g2 + 768 + lane * 4)};
    const f32x4 lb[4] = {*(const f32x4*)(b2 + lane * 4), *(const f32x4*)(b2 + 256 + lane * 4), *(const f32x4*)(b2 + 512 + lane * 4), *(const f32x4*)(b2 + 768 + lane * 4)};
#define CB_META(tt_) do { sl_n = *(const u32x4*)(SLOT + (size_t)(tt_) * 4); gg_n = *(const f32x4*)(TOPG + (size_t)(tt_) * 4); } while (0)
#define CB_ROWS(tt_) do { _Pragma("unroll") for (int j = 0; j < 4; ++j) { const int c = j * 256 + lane * 4; xa_n[j] = *(const u32x2*)(X1 + (size_t)(tt_) * D + c); \
        ys_n[0][j] = *(const u32x2*)(YS + (size_t)sl_n.x * D + c); ys_n[1][j] = *(const u32x2*)(YS + (size_t)sl_n.y * D + c); ys_n[2][j] = *(const u32x2*)(YS + (size_t)sl_n.z * D + c); ys_n[3][j] = *(const u32x2*)(YS + (size_t)sl_n.w * D + c); } gg_c = gg_n; } while (0)
    if (gw < T) { CB_META(gw); CB_ROWS(gw); if (gw + ngw < T) CB_META(gw + ngw); }
    for (int t = gw; t < T; t += ngw) {
        float v[16]; float sm = 0.f;
        const float gk[4] = {gg_c.x, gg_c.y, gg_c.z, gg_c.w};
#pragma unroll
        for (int j = 0; j < 4; ++j) {
            const f32x4 a = (f32x4){bf_lo(xa_n[j].x), bf_hi(xa_n[j].x), bf_lo(xa_n[j].y), bf_hi(xa_n[j].y)};
            f32x4 y = (f32x4){0.f, 0.f, 0.f, 0.f};
#pragma unroll
            for (int k = 0; k < 4; ++k) { const u32x2 yk = ys_n[k][j]; y.x += gk[k] * bf_lo(yk.x); y.y += gk[k] * bf_hi(yk.x); y.z += gk[k] * bf_lo(yk.y); y.w += gk[k] * bf_hi(yk.y); }
            v[j * 4 + 0] = ALPHA * a.x + y.x; v[j * 4 + 1] = ALPHA * a.y + y.y; v[j * 4 + 2] = ALPHA * a.z + y.z; v[j * 4 + 3] = ALPHA * a.w + y.w;
            sm += (v[j * 4] + v[j * 4 + 1]) + (v[j * 4 + 2] + v[j * 4 + 3]);
        }
        if (t + ngw < T) { CB_ROWS(t + ngw); if (t + 2 * ngw < T) CB_META(t + 2 * ngw); }
        const float mean = wave_sum_fast(sm, lane) * (1.0f / D); float q = 0.f;
#pragma unroll
        for (int j = 0; j < 16; ++j) { const float dl = v[j] - mean; q += dl * dl; }
        const float rstd = 1.0f / sqrtf(wave_sum_fast(q, lane) * (1.0f / D) + LN_EPS);
#pragma unroll
        for (int j = 0; j < 4; ++j) {
            const int c = j * 256 + lane * 4;
            f32x4 o;
            o.x = (v[j * 4 + 0] - mean) * rstd * lg[j].x + lb[j].x; o.y = (v[j * 4 + 1] - mean) * rstd * lg[j].y + lb[j].y;
            o.z = (v[j * 4 + 2] - mean) * rstd * lg[j].z + lb[j].z; o.w = (v[j * 4 + 3] - mean) * rstd * lg[j].w + lb[j].w;
            if (l == NL - 1) *(f32x4*)(xo + (size_t)t * D + c) = o;
            else { u32x2 ob; ob.x = pk2(o.x, o.y); ob.y = pk2(o.z, o.w); *(u32x2*)(XB + (size_t)t * D + c) = ob; }
        }
    }
#undef CB_META
#undef CB_ROWS
}

__device__ __forceinline__ void phase_inproj(const Params& P, int l, unsigned char* smem, int wv) {
    ParamsPtr pp = PARAMS_PTR(P); PIN_S(pp); unsigned char* ws = pp->ws; int bidx = (int)blockIdx.x, gdim = (int)gridDim.x; PIN_S(bidx); PIN_S(gdim);
    const int tid = phase_tid(wv);
    pg8::DenseOrder S; S.init(ws + O_XB, (const bf16_t*)(ws + O_WIN) + (size_t)l * PLD * D, T, PLD, D, gdim, bidx);
    pg8::EpiProj E{(bf16_t*)(ws + O_PROJ), PLD, (float*)(ws + O_PROJG), PLD / 256 - 1};
    pg8::gemm_phase<pg8::EpiProj, pg8::DenseOrder>((LAS unsigned char*)smem, D, S, E, tid);
    __syncthreads();
}
__device__ __forceinline__ void phase_outproj(const Params& P, int l, unsigned char* smem, int wv) {
    ParamsPtr pp = PARAMS_PTR(P); PIN_S(pp); unsigned char* ws = pp->ws; int bidx = (int)blockIdx.x, gdim = (int)gridDim.x; PIN_S(bidx); PIN_S(gdim);
    const int tid = phase_tid(wv);
    pg8::DenseOrder S; S.init(ws + O_GRP, (const bf16_t*)(ws + O_WOUT) + (size_t)l * D * D, T, D, D, gdim, bidx);
    pg8::EpiProj E{(bf16_t*)(ws + O_MIX), D, nullptr, -1};
    pg8::gemm_phase<pg8::EpiProj, pg8::DenseOrder>((LAS unsigned char*)smem, D, S, E, tid);
    __syncthreads();
}

#ifndef EMU
#define XB_TMO      128
#define XB_XCNT(j)  (256  + 64 * (j))
#define XB_XSUB(j)  (1280 + 64 * (j))
#define XB_XGEN(j)  (2304 + 64 * (j))
#define XB_TOP      3328
#define XB_TOPGEN   3392
#define XCD_BAR_WORDS 3456
#define XB_SPIN_CAP (1u << 25)
__device__ __forceinline__ unsigned xb_ld(unsigned* p)              { return __hip_atomic_load(p, __ATOMIC_RELAXED, __HIP_MEMORY_SCOPE_AGENT); }
__device__ __forceinline__ unsigned xb_add(unsigned* p, unsigned v) { return __hip_atomic_fetch_add(p, v, __ATOMIC_RELAXED, __HIP_MEMORY_SCOPE_AGENT); }
__device__ __forceinline__ unsigned xb_xcc_id() { return (unsigned)__builtin_amdgcn_s_getreg((3 << 11) | 20) & 0xFu; }
#define XB_SPIN(cond, bar) do { unsigned _sp = 0; while (cond) { __builtin_amdgcn_s_sleep(1); \
    if ((++_sp & 255u) == 0u) { if (xb_ld(&(bar)[XB_TMO])) break; if (_sp > XB_SPIN_CAP) { atomicAdd(&(bar)[XB_TMO], 1u); break; } } } } while (0)
struct XcdBarrier { unsigned* bar; unsigned x; volatile LAS unsigned* st; };
__device__ __forceinline__ XcdBarrier xcd_barrier_post(unsigned* bar, volatile LAS unsigned* st) {
    XcdBarrier b; b.bar = bar; b.x = xb_xcc_id(); b.st = st;
    if (threadIdx.x == 0) (void)xb_add(&bar[XB_XCNT(b.x)], 1u);
    return b;
}
__device__ __forceinline__ void xcd_barrier_complete(unsigned* bar, unsigned x, unsigned& nloc, unsigned& nx) {
    const unsigned G = gridDim.x * gridDim.y * gridDim.z;
    unsigned sum, cnt, mine, sp = 0u;
    for (;;) {
        sum = 0u; cnt = 0u; mine = 0u;
#pragma unroll
        for (unsigned j = 0; j < 16; ++j) { const unsigned c = xb_ld(&bar[XB_XCNT(j)]); sum += c; cnt += (c > 0u) ? 1u : 0u; mine = (j == x) ? c : mine; }
        if (sum == G) break;
        __builtin_amdgcn_s_sleep(1);
        if ((++sp & 255u) == 0u) { if (xb_ld(&bar[XB_TMO])) break; if (sp > XB_SPIN_CAP) { atomicAdd(&bar[XB_TMO], 1u); break; } }
    }
    nloc = mine > 0u ? mine : 1u; nx = cnt > 0u ? cnt : 1u;
}
__device__ __forceinline__ void xcd_barrier(const XcdBarrier& b) {
    asm volatile("s_waitcnt vmcnt(0)" ::: "memory");
    __syncthreads();
    if (threadIdx.x == 0) {
        unsigned* bar = b.bar;
        __builtin_amdgcn_s_waitcnt(0);
        unsigned nloc = b.st[0], nx = b.st[1];
        if (nloc == 0u) { xcd_barrier_complete(bar, b.x, nloc, nx); b.st[0] = nloc; b.st[1] = nx; }
        const unsigned old = xb_add(&bar[XB_XSUB(b.x)], 1u);
        const unsigned gen = old / nloc;
        if (old + 1u == (gen + 1u) * nloc) {
            __builtin_amdgcn_fence(__ATOMIC_RELEASE, "agent");
            asm volatile("s_waitcnt vmcnt(0)" ::: "memory");
            const unsigned og = xb_add(&bar[XB_TOP], 1u);
            const unsigned tg = og / nx;
            if (og + 1u == (tg + 1u) * nx) xb_add(&bar[XB_TOPGEN], 1u);
            else XB_SPIN(xb_ld(&bar[XB_TOPGEN]) == tg, bar);
            __builtin_amdgcn_fence(__ATOMIC_ACQUIRE, "agent");
            xb_add(&bar[XB_XGEN(b.x)], 1u);
            asm volatile("s_waitcnt vmcnt(0)" ::: "memory");
        } else {
            XB_SPIN(xb_ld(&bar[XB_XGEN(b.x)]) == gen, bar);
            __builtin_amdgcn_fence(__ATOMIC_ACQUIRE, "agent");
            asm volatile("s_waitcnt vmcnt(0)" ::: "memory");
        }
    }
    __syncthreads();
}
#endif

__global__ void __launch_bounds__(512, 2) mk_fwd(Params P) {
#ifdef EMU
    unsigned char* smem = g_blk->lds;
#else
    extern __shared__ __attribute__((aligned(16))) unsigned char smem[];
    volatile LAS unsigned* bst = (volatile LAS unsigned*)(smem + LDS_BYTES - 16);
    if (threadIdx.x == 0) { bst[0] = 0u; bst[1] = 0u; bst[2] = 0u; bst[3] = 0u; }
    __syncthreads();
    XcdBarrier bar; bar.bar = (unsigned*)P.ws + CW_BAR; bar.x = 0; bar.st = bst;
    if (P.ph_hi - P.ph_lo > 1) bar = xcd_barrier_post((unsigned*)P.ws + CW_BAR, bst);
#endif
    const int lo = P.ph_lo, hi = P.ph_hi;
#ifdef EMU
    const int wv = (int)threadIdx.x >> 6;
#else
    const int wv = RFL((int)threadIdx.x >> 6);
#endif
#ifdef EMU
#define SEAM(id) do {} while (0)
#else
#define SEAM(id) do { if ((id) + 1 < hi) xcd_barrier(bar); } while (0)
#endif
#ifndef MK_ONLY_PHASE
#define MK_ONLY_PHASE -1
#endif
#ifndef MK_DUP_MASK
#define MK_DUP_MASK 0
#endif
#define PHG(kc, id, ...) do { if (MK_ONLY_PHASE < 0 || MK_ONLY_PHASE == (kc)) { const int id_ = (id); if (id_ >= lo && id_ < hi) { if ((MK_DUP_MASK >> (kc)) & 1) { __VA_ARGS__; SEAM(id_ - 1); } __VA_ARGS__; SEAM(id_); } } } while (0)
#define PH(k, ...) PHG(1 + (k), 1 + l * NPH + (k), __VA_ARGS__)
    PHG(0, 0, phase_prologue(P, smem, wv));
    for (int l = 0; l < NL; ++l) {
        PH(0, phase_inproj(P, l, smem, wv));
#if MK_RWKV_CHUNKED
        PH(1, phase_prep32(P, l, smem, wv));
#else
        PH(1, phase_prep(P, l, smem, wv));
#endif
#if MK_RWKV_CHUNKED
        PH(2, { phase_rwkv_pre(P, l, smem, wv); phase_mlstm_local(P, l, smem, wv, (int)blockIdx.x, (int)gridDim.x); if (MK_PROBE == 42) phase_mlstm_local(P, l, smem, wv, (int)blockIdx.x, (int)gridDim.x); });
        PH(3, { const int G_ = (int)gridDim.x;
                if (G_ >= 2 * RSEQ_WGS) { if ((int)blockIdx.x < RSEQ_WGS) { phase_rwkv_seq(P, l, smem, wv); if (MK_PROBE >= 30 && MK_PROBE < 38) phase_rwkv_seq<MK_PROBE >= 30 && MK_PROBE < 38 ? MK_PROBE - 30 : 0>(P, l, smem, wv); }
                                           else { phase_mlstm_carry(P, l, smem, wv, (int)blockIdx.x - RSEQ_WGS, G_ - RSEQ_WGS); phase_gmlp_mix(P, l, smem, wv, (int)blockIdx.x - RSEQ_WGS, G_ - RSEQ_WGS);
                                                  if (MK_PROBE == 39) phase_gmlp_mix(P, l, smem, wv, (int)blockIdx.x - RSEQ_WGS, G_ - RSEQ_WGS); } }
                else { phase_rwkv_seq(P, l, smem, wv); phase_mlstm_carry(P, l, smem, wv, (int)blockIdx.x, G_); } });
        PH(4, { phase_rwkv_out(P, l, smem, wv); if (MK_PROBE == 40) phase_rwkv_out(P, l, smem, wv); phase_mlstm_out(P, l, smem, wv); if (MK_PROBE == 41) phase_mlstm_out(P, l, smem, wv); if ((int)gridDim.x < 2 * RSEQ_WGS) phase_gmlp_mix(P, l, smem, wv, (int)blockIdx.x, (int)gridDim.x); });
#else
        PH(2, { const int G_ = (int)gridDim.x, NSC = 2 * NB * RH * 4;
                if (G_ >= NSC + 32) { if ((int)blockIdx.x < NSC) phase_rwkv_scan(P, l, smem, wv, (int)blockIdx.x, NSC);
                                      else phase_mlstm_local(P, l, smem, wv, (int)blockIdx.x - NSC, G_ - NSC); }
                else { phase_rwkv_scan(P, l, smem, wv, (int)blockIdx.x, G_); phase_mlstm_local(P, l, smem, wv, (int)blockIdx.x, G_); } });
        PH(3, phase_mlstm_carry(P, l, smem, wv, (int)blockIdx.x, (int)gridDim.x));
        PH(4, { phase_mlstm_out(P, l, smem, wv); phase_gmlp_mix(P, l, smem, wv, (int)blockIdx.x, (int)gridDim.x); phase_rwkv_post(P, l, smem, wv); });
#endif
        PH(5, phase_outproj(P, l, smem, wv));
        PH(6, phase_ln1_router(P, l, smem, wv));
        PH(7, phase_scatter(P, l, smem, wv));
        PH(8, phase_moe_gemm<1>(P, l, smem, wv));
        PH(9, phase_moe_gemm<2>(P, l, smem, wv));
        PH(10, phase_combine_ln2(P, l, smem, wv));
    }
#undef PHG
#undef PH
#undef SEAM
}

}

#ifndef EMU
extern "C" void kernel_launch(void* const* d_in, const int* in_sizes, int n_in, void* d_out, int out_size, void* d_ws, size_t ws_size, hipStream_t stream) {
    using namespace mk;
    static int grid = 0;
    if (grid == 0) {
        if (n_in != 32 || out_size != T * D || ws_size < WS_END) { fprintf(stderr, "kernel_launch: unexpected shapes (n_in %d out %d ws %zu need %zu)\n", n_in, out_size, ws_size, (size_t)WS_END); grid = -1; return; }
        int dev = 0, cus = 0;
        if (hipGetDevice(&dev) != hipSuccess || hipDeviceGetAttribute(&cus, hipDeviceAttributeMultiprocessorCount, dev) != hipSuccess) { grid = -1; return; }
        if (hipFuncSetAttribute((const void*)mk_fwd, hipFuncAttributeMaxDynamicSharedMemorySize, LDS_BYTES) != hipSuccess) { fprintf(stderr, "kernel_launch: hipFuncSetAttribute failed\n"); grid = -1; return; }
        int per_cu = 0;
        (void)hipOccupancyMaxActiveBlocksPerMultiprocessor(&per_cu, (const void*)mk_fwd, NTHREADS, LDS_BYTES);
        (void)hipGetLastError();
        grid = cus;
    }
    if (grid < 0) return;
    (void)hipMemsetAsync(d_ws, 0, CTL_BYTES, stream);
    Params p{};
    for (int i = 0; i < 32; ++i) p.in[i] = (const float*)d_in[i];
    p.out = (float*)d_out; p.ws = (unsigned char*)d_ws;
#if MK_ONE_LAUNCH
    p.ph_lo = 0; p.ph_hi = 1 + NL * NPH;
    hipLaunchKernelGGL(mk_fwd, dim3(grid), dim3(NTHREADS), LDS_BYTES, stream, p);
#else
    for (int id = 0; id < 1 + NL * NPH; ++id) {
        p.ph_lo = id; p.ph_hi = id + 1;
        hipLaunchKernelGGL(mk_fwd, dim3(grid), dim3(NTHREADS), LDS_BYTES, stream, p);
    }
#endif
}
#endif
```

```cpp
#ifndef EMU
#include <hip/hip_runtime.h>
#endif
#include <cstdio>
#include <cstdint>
#include <cmath>

#ifndef CFG_BATCH
#define CFG_BATCH 4
#endif
#ifndef CFG_SEQ
#define CFG_SEQ 4096
#endif
#ifndef CFG_LAYERS
#define CFG_LAYERS 4
#endif
#ifndef MK_RWKV_CHUNKED
#define MK_RWKV_CHUNKED 1
#endif
#ifndef MK_PROBE
#define MK_PROBE 0
#endif
#ifndef MK_SP2
#define MK_SP2 1
#endif
#ifndef MK_ONE_LAUNCH
#define MK_ONE_LAUNCH 1
#endif

namespace mk {
constexpr int NB = CFG_BATCH, S = CFG_SEQ, T = NB * S, NL = CFG_LAYERS, D = 1024;
constexpr int GW = 256, RW = 384, MW = 384, HD = 64, GH = 4, RH = 6, MH = 6, CH = 128, NCH = S / CH;
constexpr int PIN = 3480, PLD = 3584, RPROJ = 1408;
constexpr int C_RW = 512, C_MW = 1920;
constexpr int NE = 32, TOPK = 4, DFF = 1024, MOEB = 256;
constexpr int NROWS = (T * TOPK / MOEB + NE) * MOEB;
constexpr float LN_EPS = 1e-5f, GN_EPS = 64e-5f;
constexpr float ALPHA = 1.6817928305074290f;
constexpr int NTHREADS = 512, NWAVES = 8;
constexpr int LDS_BYTES = 160 * 1024;
constexpr int NPH = 11;

typedef float f32x4 __attribute__((ext_vector_type(4)));
typedef unsigned u32x4 __attribute__((ext_vector_type(4)));
typedef unsigned u32x2 __attribute__((ext_vector_type(2)));
typedef short bf16x8 __attribute__((ext_vector_type(8)));
typedef unsigned short bf16_t;

constexpr size_t al(size_t x) { return (x + 255) & ~(size_t)255; }
constexpr size_t CTL_BYTES = 1u << 20;
constexpr size_t O_XA = CTL_BYTES;
constexpr size_t O_CLB = O_XA;
constexpr size_t O_XB = O_XA + al((size_t)T * D * 4);
constexpr size_t O_X1 = O_XB + al((size_t)T * D * 2);
constexpr size_t O_X1B = O_X1 + al((size_t)T * D * 4);
constexpr size_t O_PROJ = O_X1B + al((size_t)T * D * 2);
constexpr size_t O_PROJG = O_PROJ + al((size_t)T * PLD * 2);
constexpr size_t O_MIX = O_PROJ + al((size_t)T * PLD * 4);
constexpr size_t O_GRP = O_MIX + al((size_t)T * D * 4);
constexpr size_t O_UG = O_GRP + al((size_t)T * D * 2);
constexpr size_t O_VN = O_UG + al((size_t)T * GW * 4);
constexpr size_t O_RR = O_VN + al((size_t)T * GW * 4);
constexpr size_t O_VV = O_RR + al((size_t)T * RW * 4);
constexpr size_t O_KK = O_VV + al((size_t)T * RW * 4);
constexpr size_t O_DEC = O_KK + al((size_t)T * RW * 4);
constexpr size_t O_KD = O_DEC + al((size_t)2 * T * RW * 4);
constexpr size_t O_ICLR = O_KD + al((size_t)2 * T * RW * 4);
constexpr size_t O_GATE = O_ICLR + al((size_t)2 * T * RW * 4);
constexpr size_t O_BONUS = O_GATE + al((size_t)T * RW * 4);
constexpr size_t O_SCAN = O_BONUS + al((size_t)T * RH * 4);
constexpr size_t O_MQ = O_SCAN + al((size_t)2 * T * RW * 4);
constexpr size_t O_MK = O_MQ + al((size_t)T * MW * 4);
constexpr size_t O_IG = O_MK + al((size_t)T * MW * 4);
constexpr size_t O_LF = O_IG + al((size_t)2 * T * MH * 4);
constexpr size_t O_CL = O_LF + al((size_t)2 * T * MH * 4);
constexpr size_t O_NL = O_CL + al((size_t)2 * NB * MH * NCH * 4096 * 4);
constexpr size_t O_ML = O_NL + al((size_t)2 * NB * MH * NCH * 64 * 4);
constexpr size_t O_BL = O_ML + al((size_t)2 * NB * MH * NCH * 4);
constexpr size_t O_MIN = O_BL + al((size_t)2 * NB * MH * NCH * 4);
constexpr size_t O_TOPI = O_MIN + al((size_t)2 * NB * MH * NCH * 4);
constexpr size_t O_TOPG = O_TOPI + al((size_t)T * 4 * 4);
constexpr size_t O_RANK = O_TOPG + al((size_t)T * 4 * 4);
constexpr size_t O_SLOT = O_RANK + al((size_t)T * 4 * 4);
constexpr size_t O_MQB = O_SLOT + al((size_t)T * 4 * 4);
constexpr size_t O_MKB = O_MQB + al((size_t)T * MW * 2);
constexpr size_t O_KT = O_MKB + al((size_t)T * MW * 2);
constexpr size_t O_VT = O_KT + al((size_t)T * MW * 2);
constexpr size_t O_GVT = O_VT + al((size_t)T * MW * 2);
constexpr size_t O_PMX = O_GVT + al((size_t)2 * T * MH * 4);
constexpr size_t O_BCT = O_PMX + al((size_t)2 * T * MH * 4);
constexpr size_t O_BRKR = O_BCT + al((size_t)2 * T * MH * 4);
constexpr int RC = 64, RNC = S / RC, RUN = 2 * NB * RH * RNC;
constexpr size_t O_LW = O_BRKR + al((size_t)2 * T * RH * 2 * 4);
constexpr size_t O_RQ = O_LW + al((size_t)2 * T * RW * 4);
constexpr size_t O_RA = O_RQ + al((size_t)RUN * 4096 * 2);
constexpr size_t O_RS = O_RA + al((size_t)RUN * 4096 * 2);
constexpr size_t O_RH = O_RS + al((size_t)RUN * 4096 * 2);
constexpr size_t O_RG = O_RH + al((size_t)RUN * 4096 * 4);
constexpr size_t O_RB = O_RG + al((size_t)RUN * 4096 * 4);
constexpr size_t O_VB = O_RB + al((size_t)T * RW * 2);
constexpr size_t O_KKB = O_VB + al((size_t)T * RW * 2);
constexpr size_t O_BBB = O_KKB + al((size_t)T * RW * 2);
constexpr size_t O_KDB = O_BBB + al((size_t)2 * T * RW * 2);
constexpr size_t O_RK7 = O_KDB + al((size_t)2 * T * RW * 2);
constexpr size_t O_VNT = O_RK7 + al((size_t)T * RW * 16);
constexpr size_t O_WSB = O_VNT + al((size_t)T * GW * 2);
constexpr size_t O_LWT = O_WSB + al((size_t)NL * GH * CH * CH * 2);
constexpr size_t O_RWT = O_LWT + al((size_t)NL * 1920 * 128 * 2);
constexpr size_t O_BCNT = O_RWT + al((size_t)NL * 2 * NE * D * 2);
constexpr size_t O_CNTF = O_BCNT + al((size_t)(T / 64) * NE * 4);
constexpr size_t O_ROWT = O_CNTF + al((size_t)NE * 4);
constexpr size_t O_XS = O_ROWT + al((size_t)NROWS * 4);
constexpr size_t O_ACT = O_XS + al((size_t)NROWS * D * 2);
constexpr size_t O_YS = O_ACT + al((size_t)NROWS * DFF * 2);
constexpr size_t O_WIN = O_YS + al((size_t)NROWS * D * 2);
constexpr size_t O_WOUT = O_WIN + al((size_t)NL * PLD * D * 2);
constexpr size_t O_W1 = O_WOUT + al((size_t)NL * D * D * 2);
constexpr size_t O_W2 = O_W1 + al((size_t)NL * NE * 2 * DFF * D * 2);
constexpr size_t WS_END = O_W2 + al((size_t)NL * NE * D * DFF * 2);

constexpr int CW_BAR = 4096;
constexpr int CW_CNT = 16384;

struct Params { const float* in[32]; float* out; unsigned char* ws; int ph_lo, ph_hi; };
#ifdef EMU
typedef const Params* ParamsPtr;
#define PARAMS_PTR(P) (&(P))
#else
typedef const __attribute__((address_space(4))) Params* ParamsPtr;
#define PARAMS_PTR(P) ((ParamsPtr)__builtin_amdgcn_kernarg_segment_ptr())
#endif

#ifdef EMU
#define WAVE_SYNC() emu_wave_barrier()
#define PIN_V(x) do {} while (0)
#define PIN_S(x) do {} while (0)
#else
#define WAVE_SYNC() __builtin_amdgcn_wave_barrier()
#define PIN_V(x) asm volatile("" : "+v"(x))
#define PIN_S(x) asm volatile("" : "+s"(x))
#endif
#ifdef EMU
__device__ __forceinline__ int phase_tid(int wv) { (void)wv; return threadIdx.x; }
#else
__device__ __forceinline__ int phase_tid(int wv) { int t; asm volatile("v_mbcnt_lo_u32_b32 %0, -1, 0\n\tv_mbcnt_hi_u32_b32 %0, -1, %0" : "=v"(t)); return (wv << 6) + t; }
#endif

#ifdef EMU
#define SHX(v, m, lane) __shfl_xor(v, m)
#else
__device__ __forceinline__ float shx_(float v, int m, int lane) { return __builtin_bit_cast(float, __builtin_amdgcn_ds_bpermute((lane ^ m) << 2, __builtin_bit_cast(int, v))); }
__device__ __forceinline__ int shx_(int v, int m, int lane) { return __builtin_amdgcn_ds_bpermute((lane ^ m) << 2, v); }
#define SHX(v, m, lane) shx_(v, m, lane)
#endif
#ifdef EMU
#define SHUP(v, o, lane) __shfl(v, ((lane) - (o)) & 63)
#define RDL(v, src) __shfl(v, src)
#define SHL(v, src) __shfl(v, src)
#else
#define SHL(v, src) __builtin_bit_cast(float, __builtin_amdgcn_ds_bpermute((src) << 2, __builtin_bit_cast(int, (float)(v))))
#define SHUP(v, o, lane) __builtin_bit_cast(float, __builtin_amdgcn_ds_bpermute((((lane) - (o)) & 63) << 2, __builtin_bit_cast(int, (float)(v))))
#define RDL(v, src) __builtin_bit_cast(float, __builtin_amdgcn_readlane(__builtin_bit_cast(int, (float)(v)), src))
#endif
__device__ __forceinline__ float wave_sum(float v, int lane) {
#pragma unroll
    for (int o = 32; o >= 1; o >>= 1) v += SHX(v, o, lane);
    return v;
}
#ifdef EMU
__device__ __forceinline__ float fexp(float x) { return expf(x); }
__device__ __forceinline__ float flog(float x) { return logf(x); }
__device__ __forceinline__ float frcp(float x) { return 1.0f / x; }
#else
__device__ __forceinline__ float fexp(float x) { return __builtin_amdgcn_exp2f(x * 1.4426950408889634f); }
__device__ __forceinline__ float flog(float x) { return __builtin_amdgcn_logf(x) * 0.6931471805599453f; }
__device__ __forceinline__ float frcp(float x) { return __builtin_amdgcn_rcpf(x); }
#endif
__device__ __forceinline__ float sigmoidf_(float x) { return frcp(1.0f + fexp(-x)); }
__device__ __forceinline__ float softplusf_(float x) { return fmaxf(x, 0.f) + flog(1.0f + fexp(-fabsf(x))); }
__device__ __forceinline__ float ftanh(float x) { return 1.0f - 2.0f * frcp(1.0f + fexp(2.0f * x)); }
__device__ __forceinline__ float geluf_(float v) {
    const float av = fabsf(v), t = frcp(1.0f + 0.2316418882f * av);
    float q = t * 0.5307027145f + (-0.7265760135f); q = q * t + 0.7107068705f; q = q * t + (-0.142248368f); q = q * t + 0.127414796f; q = q * t;
    const float m = v * (q * fexp(-0.5f * v * v));
    return v < 0.f ? m : v - m;
}

#ifdef EMU
#define LAS
#define WAIT_V(n) do {} while (0)
#define WAIT_L(n) do {} while (0)
#define S_BARRIER() __syncthreads()
#define SETPRIO(x) do {} while (0)
#define SCHED_BAR() do {} while (0)
#define RFL(x) (x)
static inline void emu_glds16(const void* g, void* l) { memcpy((char*)l + (g_blk->cur & 63) * 16, g, 16); }
#define GLDS16(gptr, ldsptr) emu_glds16((const void*)(gptr), (void*)(ldsptr))
static inline float emu_bf2f(unsigned short b) { unsigned u = (unsigned)b << 16; float f; memcpy(&f, &u, 4); return f; }
static inline f32x4 emu_mfma16(bf16x8 a, bf16x8 b, f32x4 c) {
    EmuBlock* blk = g_blk; const int cur = blk->cur, lane = cur & 63, wbase = cur & ~63;
    static thread_local unsigned short Ash[32][64][8], Bsh[32][64][8];
    const int w = cur >> 6;
    for (int j = 0; j < 8; ++j) { Ash[w][lane][j] = (unsigned short)a[j]; Bsh[w][lane][j] = (unsigned short)b[j]; }
    emu_wave_barrier();
    const int col = lane & 15;
    for (int r = 0; r < 4; ++r) { const int row = 4 * (lane >> 4) + r; float sum = c[r];
        for (int k = 0; k < 32; ++k) sum += emu_bf2f(Ash[w][row + 16 * (k >> 3)][k & 7]) * emu_bf2f(Bsh[w][col + 16 * (k >> 3)][k & 7]);
        c[r] = sum; }
    emu_wave_barrier(); (void)wbase;
    return c;
}
#define MFMA16(a, b, c) emu_mfma16(a, b, c)
#else
#define LAS __attribute__((address_space(3)))
#define WAIT_V(n) asm volatile("s_waitcnt vmcnt(" #n ")" ::: "memory")
#define WAIT_L(n) asm volatile("s_waitcnt lgkmcnt(" #n ")" ::: "memory")
#define S_BARRIER() __builtin_amdgcn_s_barrier()
#define SETPRIO(x) __builtin_amdgcn_s_setprio(x)
#define SCHED_BAR() __builtin_amdgcn_sched_barrier(0)
#define RFL(x) __builtin_amdgcn_readfirstlane(x)
#define GLDS16(gptr, ldsptr) __builtin_amdgcn_global_load_lds((const unsigned*)(gptr), (LAS unsigned*)(ldsptr), 16, 0, 0)
#define MFMA16(a, b, c) __builtin_amdgcn_mfma_f32_16x16x32_bf16(a, b, c, 0, 0, 0)
#endif

#ifdef EMU
__device__ __forceinline__ unsigned f2bf(float f) { unsigned u = __builtin_bit_cast(unsigned, f); return (u + 0x7fffu + ((u >> 16) & 1u)) >> 16; }
#else
__device__ __forceinline__ unsigned f2bf(float f) { return (unsigned)__builtin_bit_cast(unsigned short, (__bf16)f); }
#endif
#ifdef EMU
__device__ __forceinline__ unsigned pk2(float lo, float hi) { return f2bf(lo) | (f2bf(hi) << 16); }
#else
typedef float f32x2c __attribute__((ext_vector_type(2)));
typedef __bf16 bf16x2c __attribute__((ext_vector_type(2)));
__device__ __forceinline__ unsigned pk2(float lo, float hi) { const f32x2c v = {lo, hi}; return __builtin_bit_cast(unsigned, __builtin_convertvector(v, bf16x2c)); }
#endif
__device__ __forceinline__ bf16x8 cvt8(const f32x4 a, const f32x4 b) {
    u32x4 w; w.x = pk2(a.x, a.y); w.y = pk2(a.z, a.w); w.z = pk2(b.x, b.y); w.w = pk2(b.z, b.w); return __builtin_bit_cast(bf16x8, w);
}
__device__ __forceinline__ float bf_lo(unsigned u) { return __builtin_bit_cast(float, u << 16); }
__device__ __forceinline__ float bf_hi(unsigned u) { return __builtin_bit_cast(float, u & 0xffff0000u); }

namespace pg8 {
constexpr int BM = 256, BK = 64, HALF = 128, HTB = HALF * BK * 2, STAGE_BYTES = 8 * HTB, NXCD = 8, WGM = 8;
__host__ __device__ __forceinline__ int lds_byte(int r, int c) { const int st = (r >> 4) * 2 + (c >> 5), rr = r & 15, cc = c & 31, ob = rr * 64 + cc * 2; return st * 1024 + (ob ^ (((ob >> 9) & 1) << 5)); }
__host__ __device__ __forceinline__ void stage_rc(int b, int& R, int& C) { const int st = b / 1024, sb = b % 1024, swz = sb ^ (((sb >> 9) & 1) << 5); R = (st >> 1) * 16 + swz / 64; C = (st & 1) * 32 + (swz % 64) / 2; }
__host__ __device__ __forceinline__ int perm32(int rho) { const int n = rho >> 4, i = rho & 15; return 8 * (i >> 2) + 4 * n + (i & 3); }
struct Unit { int pm, pn, e; };

struct DenseOrder {
    static constexpr bool GATHER = false;
    const char* A; const char* Bt; int K; int nM, nN, nwg, G, c;
    __device__ __forceinline__ void init(const void* A_, const void* Bt_, int M, int N, int K_, int G_, int c_) { A = (const char*)A_; Bt = (const char*)Bt_; K = K_; nM = M / BM; nN = N / BM; nwg = nM * nN; G = G_; c = c_; }
    __device__ __forceinline__ bool next(int i, Unit& u) const {
        const long L = (long)i * G + c; if (L >= nwg) return false;
        int wgid = (int)L; { const int q = nwg / NXCD, r = nwg % NXCD, xcd = wgid % NXCD, off = wgid / NXCD; wgid = (xcd < r ? xcd * (q + 1) : r * (q + 1) + (xcd - r) * q) + off; }
        const int nig = WGM * nN, gid = wgid / nig, fm = gid * WGM, gsz = (nM - fm) < WGM ? (nM - fm) : WGM;
        u.pm = fm + ((wgid % nig) % gsz); u.pn = (wgid % nig) / gsz; u.e = 0; return true;
    }
    __device__ __forceinline__ const char* abase(const Unit& u) const { return A + (size_t)u.pm * BM * K * 2; }
    __device__ __forceinline__ const char* bbase(const Unit& u) const { return Bt + (size_t)u.pn * BM * K * 2; }
};
template <bool G>
struct MoeOrderT {
    static constexpr bool GATHER = G;
    const char* A; const char* Wt; int K; int nN, nwg, G_, c; size_t estride; const int* rbe; const int* rowmap;
    __device__ __forceinline__ bool next(int i, Unit& u) const {
        const long L = (long)i * G_ + c; if (L >= nwg) return false;
        u.pm = (int)(L / nN); u.pn = (int)(L % nN); u.e = rbe[u.pm]; return true;
    }
    __device__ __forceinline__ const char* abase(const Unit& u) const { return G ? A : A + (size_t)u.pm * BM * K * 2; }
    __device__ __forceinline__ const char* bbase(const Unit& u) const { return Wt + (size_t)u.e * estride + (size_t)u.pn * BM * K * 2; }
};
struct EpiF32 {
    static constexpr bool PERM = false;
    float* C; int ldc;
    __device__ __forceinline__ void operator()(const f32x4 (&acc)[2][2][4][2], const Unit& u, int wr, int wc, int fr, int fq) const {
        const int row0 = u.pm * BM + wr * 64 + fr, col0 = u.pn * BM + wc * 32 + 4 * fq;
#pragma unroll
        for (int ai = 0; ai < 2; ++ai)
#pragma unroll
            for (int m = 0; m < 4; ++m) { float* rowp = C + (size_t)(row0 + ai * HALF + m * 16) * ldc + col0;
#pragma unroll
                for (int bj = 0; bj < 2; ++bj)
#pragma unroll
                    for (int n = 0; n < 2; ++n) *(f32x4*)(rowp + bj * HALF + n * 16) = acc[ai][bj][m][n]; }
    }
};
struct EpiProj {
    static constexpr bool PERM = true;
    bf16_t* O; int ldc; float* G; int lastt;
    __device__ __forceinline__ void operator()(const f32x4 (&acc)[2][2][4][2], const Unit& u, int wr, int wc, int fr, int fq) const {
        const int row0 = u.pm * BM + wr * 64 + fr, col0 = u.pn * BM + wc * 32 + 8 * fq;
#pragma unroll
        for (int ai = 0; ai < 2; ++ai)
#pragma unroll
            for (int m = 0; m < 4; ++m) { bf16_t* rowp = O + (size_t)(row0 + ai * HALF + m * 16) * ldc + col0;
#pragma unroll
                for (int bj = 0; bj < 2; ++bj) { const f32x4 v0 = acc[ai][bj][m][0], v1 = acc[ai][bj][m][1];
                    u32x4 w; w.x = pk2(v0[0], v0[1]); w.y = pk2(v0[2], v0[3]); w.z = pk2(v1[0], v1[1]); w.w = pk2(v1[2], v1[3]);
                    *(u32x4*)(rowp + bj * HALF) = w; } }
        if (u.pn == lastt) {
#pragma unroll
            for (int ai = 0; ai < 2; ++ai)
#pragma unroll
                for (int m = 0; m < 4; ++m) { float* rowp = G + (size_t)(row0 + ai * HALF + m * 16) * BM + wc * 32 + 8 * fq;
#pragma unroll
                    for (int bj = 0; bj < 2; ++bj) { *(f32x4*)(rowp + bj * HALF) = acc[ai][bj][m][0]; *(f32x4*)(rowp + bj * HALF + 4) = acc[ai][bj][m][1]; } }
        }
    }
};
struct EpiBf16Bias {
    static constexpr bool PERM = true;
    bf16_t* O; int ldc; const float* bias; int bias_estride;
    __device__ __forceinline__ void operator()(const f32x4 (&acc)[2][2][4][2], const Unit& u, int wr, int wc, int fr, int fq) const {
        const int row0 = u.pm * BM + wr * 64 + fr, col0 = u.pn * BM + wc * 32 + 8 * fq;
        const float* bp = bias + (size_t)u.e * bias_estride + col0;
        f32x4 bv[2][2];
#pragma unroll
        for (int bj = 0; bj < 2; ++bj)
#pragma unroll
            for (int n = 0; n < 2; ++n) bv[bj][n] = *(const f32x4*)(bp + bj * HALF + 4 * n);
#pragma unroll
        for (int ai = 0; ai < 2; ++ai)
#pragma unroll
            for (int m = 0; m < 4; ++m) { bf16_t* rowp = O + (size_t)(row0 + ai * HALF + m * 16) * ldc + col0;
#pragma unroll
                for (int bj = 0; bj < 2; ++bj) { const f32x4 v0 = acc[ai][bj][m][0] + bv[bj][0], v1 = acc[ai][bj][m][1] + bv[bj][1];
                    u32x4 w; w.x = pk2(v0[0], v0[1]); w.y = pk2(v0[2], v0[3]); w.z = pk2(v1[0], v1[1]); w.w = pk2(v1[2], v1[3]);
                    *(u32x4*)(rowp + bj * HALF) = w; } }
    }
};
__device__ __forceinline__ float swiglu1(float g, float uu) { g = fminf(g, 7.0f); uu = fminf(fmaxf(uu, -7.0f), 7.0f); return (uu + 1.0f) * (g * frcp(1.0f + fexp(-1.702f * g))); }
struct EpiSwiglu {
    static constexpr bool PERM = true;
    bf16_t* O; const float* b1;
    __device__ __forceinline__ void operator()(const f32x4 (&acc)[2][2][4][2], const Unit& u, int wr, int wc, int fr, int fq) const {
        const int row0 = u.pm * BM + wr * 64 + fr, j0 = u.pn * HALF + wc * 32 + 8 * fq;
        const float* bg = b1 + (size_t)u.e * 2 * DFF + j0; const float* bu = bg + DFF;
        f32x4 g4[2], u4[2];
#pragma unroll
        for (int n = 0; n < 2; ++n) { g4[n] = *(const f32x4*)(bg + 4 * n); u4[n] = *(const f32x4*)(bu + 4 * n); }
#pragma unroll
        for (int ai = 0; ai < 2; ++ai)
#pragma unroll
            for (int m = 0; m < 4; ++m) {
                float o[8];
#pragma unroll
                for (int n = 0; n < 2; ++n)
#pragma unroll
                    for (int q = 0; q < 4; ++q) o[n * 4 + q] = swiglu1(acc[ai][0][m][n][q] + g4[n][q], acc[ai][1][m][n][q] + u4[n][q]);
                u32x4 w; w.x = pk2(o[0], o[1]); w.y = pk2(o[2], o[3]); w.z = pk2(o[4], o[5]); w.w = pk2(o[6], o[7]);
                *(u32x4*)(O + (size_t)(row0 + ai * HALF + m * 16) * DFF + j0) = w;
            }
    }
};

template <class Epi, class Sched, bool SP2 = (MK_SP2 != 0)>
__device__ __forceinline__ void gemm_phase(LAS unsigned char* lds, const int K, const Sched& S, const Epi& E, const int tid) {
    const int wid = RFL(tid >> 6), lane = tid & 63, wr = wid >> 2, wc = wid & 3, fr = lane & 15, fq = lane >> 4;
    const int nt = K / BK;
    unsigned voffA[2], voffB[2]; int gR[2]; unsigned gC[2];
#pragma unroll
    for (int i = 0; i < 2; ++i) { int R, C; stage_rc(tid * 16 + i * 8192, R, C); const int Rb = Epi::PERM ? ((R & ~31) + perm32(R & 31)) : R;
        voffA[i] = (unsigned)(R * K + C) * 2u; voffB[i] = (unsigned)(Rb * K + C) * 2u; gR[i] = R; gC[i] = (unsigned)C * 2u; }
    unsigned va[2][2], vn[2][2];
#define PG8_GOFF(dst, unit) do { if constexpr (Sched::GATHER) { _Pragma("unroll") for (int h_ = 0; h_ < 2; ++h_) _Pragma("unroll") for (int i_ = 0; i_ < 2; ++i_) \
        dst[h_][i_] = (unsigned)S.rowmap[(unit).pm * BM + h_ * HALF + gR[i_]] * (unsigned)(K * 2) + gC[i_]; } } while (0)
#define PG8_STAGE_A(bufoff, bp, kb, h, nx) do { if constexpr (Sched::GATHER) { const char* gb_ = S.A + (kb); _Pragma("unroll") for (int _i = 0; _i < 2; ++_i) \
        GLDS16(gb_ + ((nx) ? vn[h][_i] : va[h][_i]), lds + (bufoff) + ldsw + _i * 8192); } else { PG8_STAGE(bufoff, bp, voffA); } } while (0)
    const size_t kstep = (size_t)(BK * 2);
    const size_t hstep = (size_t)HALF * K * 2;
    const unsigned ldsw = (unsigned)wid * 1024u;
    const int aoff = lds_byte(wr * 64 + fr, fq * 8), boff = lds_byte(wc * 32 + fr, fq * 8);
#define PG8_SA(b, h) (((b) * 2 + (h)) * HTB)
#define PG8_SB(b, h) ((4 + (b) * 2 + (h)) * HTB)
#define PG8_STAGE(bufoff, gbase, voff) do { _Pragma("unroll") for (int _i = 0; _i < 2; ++_i) \
        GLDS16((const char*)(gbase) + (voff)[_i], lds + (bufoff) + ldsw + _i * 8192); } while (0)
#define PG8_LDA(dst, b, h) do { _Pragma("unroll") for (int m = 0; m < 4; ++m) _Pragma("unroll") for (int k = 0; k < 2; ++k) dst[m][k] = *(const LAS bf16x8*)(lds + PG8_SA(b, h) + aoff + m * 2048 + k * 1024); } while (0)
#define PG8_LDB(dst, b, h) do { _Pragma("unroll") for (int n = 0; n < 2; ++n) _Pragma("unroll") for (int k = 0; k < 2; ++k) dst[n][k] = *(const LAS bf16x8*)(lds + PG8_SB(b, h) + boff + n * 2048 + k * 1024); } while (0)
#define PG8_MMA(ai, bj, At, Bt) do { SETPRIO(1); _Pragma("unroll") for (int m = 0; m < 4; ++m) _Pragma("unroll") for (int n = 0; n < 2; ++n) _Pragma("unroll") for (int k = 0; k < 2; ++k) \
        acc[ai][bj][m][n] = MFMA16(Bt[n][k], At[m][k], acc[ai][bj][m][n]); SETPRIO(0); } while (0)
    Unit cur, nxt; int ui = 0;
    if (!S.next(0, cur)) return;
    f32x4 acc[2][2][4][2];
#pragma unroll
    for (int a = 0; a < 2; ++a)
#pragma unroll
        for (int b = 0; b < 2; ++b)
#pragma unroll
            for (int m = 0; m < 4; ++m)
#pragma unroll
                for (int n = 0; n < 2; ++n) acc[a][b][m][n] = (f32x4){0.f, 0.f, 0.f, 0.f};
    bf16x8 At[4][2], B0[2][2], B1[2][2];
    const char* cA = S.abase(cur); const char* cB = S.bbase(cur);
    PG8_GOFF(va, cur);
    if constexpr (SP2) {
        PG8_STAGE(PG8_SB(0, 0), cB, voffB); PG8_STAGE(PG8_SB(0, 1), cB + hstep, voffB); PG8_STAGE_A(PG8_SA(0, 0), cA, 0, 0, false); PG8_STAGE_A(PG8_SA(0, 1), cA + hstep, 0, 1, false);
        if (wr == 1) S_BARRIER();
        WAIT_V(2); S_BARRIER();
        PG8_STAGE(PG8_SB(1, 0), cB + kstep, voffB); PG8_STAGE_A(PG8_SA(1, 0), cA + kstep, kstep, 0, false); PG8_STAGE(PG8_SB(1, 1), cB + hstep + kstep, voffB);
        WAIT_V(6); S_BARRIER();
    } else {
    PG8_STAGE(PG8_SB(0, 0), cB, voffB); PG8_STAGE_A(PG8_SA(0, 0), cA, 0, 0, false); PG8_STAGE(PG8_SB(0, 1), cB + hstep, voffB); PG8_STAGE_A(PG8_SA(0, 1), cA + hstep, 0, 1, false);
    if (wr == 1) S_BARRIER();
    WAIT_V(4); S_BARRIER();
    PG8_STAGE(PG8_SB(1, 0), cB + kstep, voffB); PG8_STAGE_A(PG8_SA(1, 0), cA + kstep, kstep, 0, false); PG8_STAGE(PG8_SB(1, 1), cB + hstep + kstep, voffB);
    WAIT_V(6); S_BARRIER();
    }
    for (;;) {
        const bool has_next = S.next(ui + 1, nxt);
        const char* nA = has_next ? S.abase(nxt) : cA; const char* nB = has_next ? S.bbase(nxt) : cB;
        if constexpr (Sched::GATHER) { if (has_next) { PG8_GOFF(vn, nxt); } else {
#pragma unroll
            for (int h_ = 0; h_ < 2; ++h_) { vn[h_][0] = va[h_][0]; vn[h_][1] = va[h_][1]; } } }
        for (int t = 0; t < nt; t += 2) {
            const bool last = (t == nt - 2);
            const char* a1 = cA + (size_t)(t + 1) * kstep;
            const char* a2 = last ? nA : cA + (size_t)(t + 2) * kstep; const char* b2 = last ? nB : cB + (size_t)(t + 2) * kstep;
            const char* a3 = a2 + kstep; const char* b3 = b2 + kstep;
            if constexpr (SP2) {
            PG8_LDB(B0, 0, 0); PG8_LDB(B1, 0, 1); SCHED_BAR(); PG8_LDA(At, 0, 0); PG8_STAGE_A(PG8_SA(1, 1), a1 + hstep, (size_t)(t + 1) * kstep, 1, false);
            WAIT_V(8); WAIT_L(0); S_BARRIER(); PG8_MMA(0, 0, At, B0); PG8_MMA(0, 1, At, B1); S_BARRIER(); SCHED_BAR();
            PG8_LDA(At, 0, 1); PG8_STAGE(PG8_SB(0, 0), b2, voffB); PG8_STAGE(PG8_SB(0, 1), b2 + hstep, voffB); PG8_STAGE_A(PG8_SA(0, 0), a2, (last ? (size_t)0 : (size_t)(t + 2) * kstep), 0, last);
            WAIT_V(8); WAIT_L(0); S_BARRIER(); PG8_MMA(1, 0, At, B0); PG8_MMA(1, 1, At, B1); S_BARRIER(); SCHED_BAR();
            PG8_LDB(B0, 1, 0); PG8_LDB(B1, 1, 1); SCHED_BAR(); PG8_LDA(At, 1, 0); PG8_STAGE_A(PG8_SA(0, 1), a2 + hstep, (last ? (size_t)0 : (size_t)(t + 2) * kstep), 1, last);
            WAIT_V(8); WAIT_L(0); S_BARRIER(); PG8_MMA(0, 0, At, B0); PG8_MMA(0, 1, At, B1); S_BARRIER(); SCHED_BAR();
            PG8_LDA(At, 1, 1); PG8_STAGE(PG8_SB(1, 0), b3, voffB); PG8_STAGE(PG8_SB(1, 1), b3 + hstep, voffB); PG8_STAGE_A(PG8_SA(1, 0), a3, (last ? kstep : (size_t)(t + 3) * kstep), 0, last);
            WAIT_V(8); WAIT_L(0); S_BARRIER(); PG8_MMA(1, 0, At, B0); PG8_MMA(1, 1, At, B1); S_BARRIER(); SCHED_BAR();
            } else {
            PG8_LDB(B0, 0, 0); SCHED_BAR(); PG8_LDA(At, 0, 0); PG8_STAGE_A(PG8_SA(1, 1), a1 + hstep, (size_t)(t + 1) * kstep, 1, false);
            WAIT_L(8); S_BARRIER(); WAIT_L(0); PG8_MMA(0, 0, At, B0); S_BARRIER(); SCHED_BAR();
            PG8_LDB(B1, 0, 1); PG8_STAGE(PG8_SB(0, 0), b2, voffB);
            S_BARRIER(); WAIT_L(0); PG8_MMA(0, 1, At, B1); S_BARRIER();
            PG8_LDA(At, 0, 1); PG8_STAGE_A(PG8_SA(0, 0), a2, (last ? (size_t)0 : (size_t)(t + 2) * kstep), 0, last);
            S_BARRIER(); WAIT_L(0); PG8_MMA(1, 0, At, B0); S_BARRIER(); SCHED_BAR();
            PG8_STAGE(PG8_SB(0, 1), b2 + hstep, voffB);
            WAIT_V(6); S_BARRIER(); PG8_MMA(1, 1, At, B1); S_BARRIER();
            PG8_LDB(B0, 1, 0); SCHED_BAR(); PG8_LDA(At, 1, 0); PG8_STAGE_A(PG8_SA(0, 1), a2 + hstep, (last ? (size_t)0 : (size_t)(t + 2) * kstep), 1, last);
            WAIT_L(8); S_BARRIER(); WAIT_L(0); PG8_MMA(0, 0, At, B0); S_BARRIER(); SCHED_BAR();
            PG8_LDB(B1, 1, 1); PG8_STAGE(PG8_SB(1, 0), b3, voffB);
            S_BARRIER(); WAIT_L(0); PG8_MMA(0, 1, At, B1); S_BARRIER();
            PG8_LDA(At, 1, 1); PG8_STAGE_A(PG8_SA(1, 0), a3, (last ? kstep : (size_t)(t + 3) * kstep), 0, last);
            S_BARRIER(); WAIT_L(0); PG8_MMA(1, 0, At, B0); S_BARRIER(); SCHED_BAR();
            PG8_STAGE(PG8_SB(1, 1), b3 + hstep, voffB);
            WAIT_V(6); S_BARRIER(); PG8_MMA(1, 1, At, B1); S_BARRIER();
            }
        }
        if (wr == 0) S_BARRIER();
        E(acc, cur, wr, wc, fr, fq);
        if (!has_next) break;
#pragma unroll
        for (int a = 0; a < 2; ++a)
#pragma unroll
            for (int b = 0; b < 2; ++b)
#pragma unroll
                for (int m = 0; m < 4; ++m)
#pragma unroll
                    for (int n = 0; n < 2; ++n) acc[a][b][m][n] = (f32x4){0.f, 0.f, 0.f, 0.f};
        cur = nxt; cA = nA; cB = nB; ++ui;
        if constexpr (Sched::GATHER) {
#pragma unroll
            for (int h_ = 0; h_ < 2; ++h_) { va[h_][0] = vn[h_][0]; va[h_][1] = vn[h_][1]; } }
        if (wr == 1) S_BARRIER();
    }
    WAIT_V(0);
    S_BARRIER();
#undef PG8_SA
#undef PG8_SB
#undef PG8_STAGE
#undef PG8_STAGE_A
#undef PG8_GOFF
#undef PG8_LDA
#undef PG8_LDB
#undef PG8_MMA
}
}

__device__ __forceinline__ float row16_sum(float x) {
#ifdef EMU
    x += __shfl_xor(x, 1); x += __shfl_xor(x, 2); x += __shfl_xor(x, 4); x += __shfl_xor(x, 8); return x;
#else
#define DPPF(v, ctrl) __builtin_bit_cast(float, __builtin_amdgcn_update_dpp(0, __builtin_bit_cast(int, (v)), (ctrl), 0xF, 0xF, false))
    x += DPPF(x, 0xB1); x += DPPF(x, 0x4E); x += DPPF(x, 0x141); x += DPPF(x, 0x140); return x;
#undef DPPF
#endif
}
__device__ __forceinline__ float row32_sum(float x) {
    x = row16_sum(x);
#ifdef EMU
    x += __shfl_xor(x, 32); return x;
#else
    float a = x, b = x;
    asm volatile("s_nop 1\n\tv_permlane32_swap_b32 %0, %1" : "+v"(a), "+v"(b));
    return a + b;
#endif
}
__device__ __forceinline__ float wave_sum_fast(float x, int lane) {
    x = row32_sum(x);
    x += SHX(x, 16, lane);
    return x;
}
__device__ __forceinline__ void transpose_item(const float* W, int K, int N, bf16_t* WT, int k0, int n0, int dst_row0, float* scr, int lane) {
    const int n4 = (lane & 15) * 4, kr = lane >> 4;
#pragma unroll 8
    for (int i = 0; i < 16; ++i) {
        const int kk = 4 * i + kr;
        f32x4 v = (f32x4){0.f, 0.f, 0.f, 0.f};
        if (n0 + n4 < N) v = *(const f32x4*)(W + (size_t)(k0 + kk) * N + n0 + n4);
        float* d = scr + kk * 65 + n4; d[0] = v.x; d[1] = v.y; d[2] = v.z; d[3] = v.w;
    }
    WAVE_SYNC();
    const int c = lane & 7;
#pragma unroll
    for (int j = 0; j < 8; ++j) { const int n = (lane >> 3) + 8 * j; const float* sp = scr + (8 * c) * 65 + n;
        u32x4 o; o.x = pk2(sp[0 * 65], sp[1 * 65]); o.y = pk2(sp[2 * 65], sp[3 * 65]); o.z = pk2(sp[4 * 65], sp[5 * 65]); o.w = pk2(sp[6 * 65], sp[7 * 65]);
        *(u32x4*)(WT + (size_t)(dst_row0 + n) * K + k0 + 8 * c) = o; }
    WAVE_SYNC();
}
__device__ __forceinline__ void phase_prologue(const Params& P, unsigned char* smem, int wv) {
    ParamsPtr pp = PARAMS_PTR(P); PIN_S(pp); unsigned char* ws = pp->ws; int bidx = (int)blockIdx.x, gdim = (int)gridDim.x; PIN_S(bidx); PIN_S(gdim);
    const int tid = phase_tid(wv), lane = tid & 63, wave = tid >> 6;
    float* scr = (float*)smem + wave * (64 * 65);
    const int gw = bidx * NWAVES + wave, ngw = NWAVES * gdim;
    constexpr int I_IN = 16 * (PLD / 64), I_OUT = 16 * 16, I_W1 = NE * 16 * 32, I_W2 = NE * 16 * 16, I_L = I_IN + I_OUT + I_W1 + I_W2;
    for (int it = gw; it < NL * I_L; it += ngw) {
        const int l = it / I_L; int r = it % I_L;
        if (r < I_IN) { const int kb = r / (PLD / 64), nb = r % (PLD / 64);
            transpose_item(pp->in[1] + (size_t)l * D * PIN, D, PIN, (bf16_t*)(ws + O_WIN) + (size_t)l * PLD * D, kb * 64, nb * 64, nb * 64, scr, lane); continue; }
        r -= I_IN;
        if (r < I_OUT) { const int kb = r / 16, nb = r % 16;
            transpose_item(pp->in[21] + (size_t)l * D * D, D, D, (bf16_t*)(ws + O_WOUT) + (size_t)l * D * D, kb * 64, nb * 64, nb * 64, scr, lane); continue; }
        r -= I_OUT;
        if (r < I_W1) { const int e = r / (16 * 32), q = r % (16 * 32), kb = q / 32, nb = q % 32, n0 = nb * 64;
            const int dst = n0 < DFF ? (n0 / 128) * 256 + (n0 % 128) : ((n0 - DFF) / 128) * 256 + 128 + ((n0 - DFF) % 128);
            transpose_item(pp->in[26] + ((size_t)l * NE + e) * D * 2 * DFF, D, 2 * DFF, (bf16_t*)(ws + O_W1) + ((size_t)l * NE + e) * 2 * DFF * D, kb * 64, n0, dst, scr, lane); continue; }
        r -= I_W1;
        { const int e = r / (16 * 16), q = r % (16 * 16), kb = q / 16, nb = q % 16;
            transpose_item(pp->in[28] + ((size_t)l * NE + e) * DFF * D, DFF, D, (bf16_t*)(ws + O_W2) + ((size_t)l * NE + e) * D * DFF, kb * 64, nb * 64, nb * 64, scr, lane); }
    }
    {
        const float* gw_ = pp->in[4]; bf16_t* WSB = (bf16_t*)(ws + O_WSB);
        for (size_t i = ((size_t)bidx * NTHREADS + tid) * 4; i < (size_t)NL * GH * CH * CH; i += (size_t)gdim * NTHREADS * 4) {
            const f32x4 v = *(const f32x4*)(gw_ + i); u32x2 o; o.x = pk2(v.x, v.y); o.y = pk2(v.z, v.w); *(u32x2*)(WSB + i) = o;
        }
    }
    {
        bf16_t* LWT = (bf16_t*)(ws + O_LWT);
        for (int i = bidx * NTHREADS + tid; i < NL * 1920 * 128; i += gdim * NTHREADS) {
            const int k = i & 127, n = (i >> 7) % 1920, ll = i / (1920 * 128);
            float v = 0.f;
            if (n < 1536) { if (k < 64) { const int grp = n / 768, d = (n / 384) & 1, c = n % 384; v = (grp == 0 ? pp->in[8] : pp->in[10])[(((size_t)ll * 2 + d) * 64 + k) * RW + c]; } }
            else v = pp->in[11][((size_t)ll * 128 + k) * RW + (n - 1536)];
            LWT[i] = (bf16_t)f2bf(v);
        }
    }
    {
        bf16_t* RWT = (bf16_t*)(ws + O_RWT);
        for (int i = bidx * NTHREADS + tid; i < NL * NE * D; i += gdim * NTHREADS) {
            const int k = i % D, e = (i / D) % NE, ll = i / (D * NE);
            const float v = pp->in[24][((size_t)ll * D + k) * NE + e];
            const unsigned hi = f2bf(v); const float lo = v - bf_lo(hi);
            RWT[((size_t)(ll * 2 + 0) * NE + e) * D + k] = (bf16_t)hi; RWT[((size_t)(ll * 2 + 1) * NE + e) * D + k] = (bf16_t)f2bf(lo);
        }
    }
    const float* x = pp->in[0]; bf16_t* XB = (bf16_t*)(ws + O_XB);
    for (size_t i = ((size_t)bidx * NTHREADS + tid) * 4; i < (size_t)T * D; i += (size_t)gdim * NTHREADS * 4) {
        const f32x4 v = *(const f32x4*)(x + i); u32x2 o; o.x = pk2(v.x, v.y); o.y = pk2(v.z, v.w); *(u32x2*)(XB + i) = o;
    }
}

__device__ __forceinline__ float tshift(const float* P, int t, int s, int col, const float* mu0, const float* mu1, int rc) {
    const float cur = P[(size_t)t * PLD + col];
    const float prv = s > 0 ? P[(size_t)(t - 1) * PLD + col] : 0.f;
    const float nxt = s < S - 1 ? P[(size_t)(t + 1) * PLD + col] : 0.f;
    return cur + mu0[rc] * (prv - cur) + mu1[rc] * (nxt - cur);
}

__device__ __forceinline__ void phase_prep(const Params& P, int l, unsigned char* smem, int wv) {
    ParamsPtr pp = PARAMS_PTR(P); PIN_S(pp); unsigned char* ws = pp->ws; int bidx = (int)blockIdx.x, gdim = (int)gridDim.x; PIN_S(bidx); PIN_S(gdim);
    const bf16_t* proj = (const bf16_t*)(ws + O_PROJ); const float* projg = (const float*)(ws + O_PROJG);
    float* UG = (float*)(ws + O_UG); bf16_t* VNT = (bf16_t*)(ws + O_VNT);
    float* RR = (float*)(ws + O_RR); float* VV = (float*)(ws + O_VV); float* KK = (float*)(ws + O_KK);
    float* KD = (float*)(ws + O_KD); float* ICLR = (float*)(ws + O_ICLR);
    float* GATE = (float*)(ws + O_GATE); float* BONUS = (float*)(ws + O_BONUS); float* LWG = (float*)(ws + O_LW);
    bf16_t* RB = (bf16_t*)(ws + O_RB); bf16_t* VB = (bf16_t*)(ws + O_VB); bf16_t* KKB = (bf16_t*)(ws + O_KKB); bf16_t* BBB = (bf16_t*)(ws + O_BBB); bf16_t* KDB = (bf16_t*)(ws + O_KDB);
#if !MK_RWKV_CHUNKED
    float* DEC = (float*)(ws + O_DEC); float* BRKR = (float*)(ws + O_BRKR);
#endif
    bf16_t* MQB = (bf16_t*)(ws + O_MQB); bf16_t* MKB = (bf16_t*)(ws + O_MKB); bf16_t* KT = (bf16_t*)(ws + O_KT); bf16_t* VT = (bf16_t*)(ws + O_VT);
    float* IG = (float*)(ws + O_IG); float* LF = (float*)(ws + O_LF);
    const bf16_t* LWT = (const bf16_t*)(ws + O_LWT) + (size_t)l * 1920 * 128;
    const float* gln_g = pp->in[2] + (size_t)l * GW; const float* gln_b = pp->in[3] + (size_t)l * GW;
    const float* mu0 = pp->in[6] + (size_t)l * 2 * RPROJ; const float* mu1 = mu0 + RPROJ;
    const float* w0 = pp->in[7] + (size_t)l * 2 * RW; const float* a0 = pp->in[9] + (size_t)l * 2 * RW;
    const float* k_k = pp->in[12] + (size_t)l * RW; const float* k_a = pp->in[13] + (size_t)l * RW; const float* r_k = pp->in[14] + (size_t)l * RW;
    const float* conv_w = pp->in[17] + (size_t)l * 3 * 768; const float* conv_b = pp->in[18] + (size_t)l * 768; const float* gate_b = pp->in[19] + (size_t)l * 24;
    float* win = (float*)smem;
    bf16_t* lin = (bf16_t*)(smem + 101376);
    bf16_t* tvn = (bf16_t*)(smem + 110592);
    bf16_t* tk = (bf16_t*)(smem + 118784);
    bf16_t* tv = (bf16_t*)(smem + 131072);
    constexpr int LIN = 264;
    const int tid = phase_tid(wv), lane = tid & 63, wave = tid >> 6, col = lane & 15, g = lane >> 4;
    for (int u = bidx; u < T / 16; u += gdim) {
        const int t0 = u * 16, s0 = t0 % S, bb = t0 / S;
        __syncthreads();
        {
            u32x2 wb[18];
#pragma unroll
            for (int row = 0; row < 18; ++row) {
                const int sq = s0 - 1 + row;
                wb[row] = (u32x2){0u, 0u};
                if (sq >= 0 && sq < S && tid < 352) wb[row] = *(const u32x2*)(proj + (size_t)(t0 - 1 + row) * PLD + C_RW + tid * 4);
            }
            if (tid < 352) {
#pragma unroll
                for (int row = 0; row < 18; ++row) *(f32x4*)(win + row * RPROJ + tid * 4) = (f32x4){bf_lo(wb[row].x), bf_hi(wb[row].x), bf_lo(wb[row].y), bf_hi(wb[row].y)};
            }
        }
        for (int rep_ = 0; rep_ < (MK_PROBE == 3 ? 2 : 1); ++rep_) {
            const int i = tid >> 5, l32 = tid & 31, t = t0 + i;
            float v[8], ug[8]; float sum = 0.f;
#pragma unroll
            for (int j = 0; j < 8; ++j) { const int c = j * 32 + l32; ug[j] = bf_lo((unsigned)proj[(size_t)t * PLD + c]); v[j] = bf_lo((unsigned)proj[(size_t)t * PLD + GW + c]); }
#pragma unroll
            for (int j = 0; j < 8; ++j) { const int c = j * 32 + l32; UG[(size_t)t * GW + c] = geluf_(ug[j]); v[j] = geluf_(v[j]); sum += v[j]; }
#pragma unroll
            for (int o = 16; o >= 1; o >>= 1) sum += SHX(sum, o, lane);
            const float mean = sum * (1.0f / GW); float q = 0.f;
#pragma unroll
            for (int j = 0; j < 8; ++j) { const float d = v[j] - mean; q += d * d; }
#pragma unroll
            for (int o = 16; o >= 1; o >>= 1) q += SHX(q, o, lane);
            const float rstd = 1.0f / sqrtf(q * (1.0f / GW) + LN_EPS);
#pragma unroll
            for (int j = 0; j < 8; ++j) { const int c = j * 32 + l32; tvn[c * 16 + i] = (bf16_t)f2bf((v[j] - mean) * rstd * gln_g[c] + gln_b[c]); }
        }
        __syncthreads();
        {
            const int hf = tid & 1, c = tid >> 1;
            *(u32x4*)(VNT + ((size_t)bb * GW + c) * S + s0 + hf * 8) = *(const u32x4*)(tvn + c * 16 + hf * 8);
        }
        for (int idx = tid; idx < 16 * 256; idx += NTHREADS) {
            const int i = idx >> 8, j = idx & 255, rc = 1152 + j;
            const float pv = win[i * RPROJ + rc], cv = win[(i + 1) * RPROJ + rc], nv = win[(i + 2) * RPROJ + rc];
            const float x = cv + mu0[rc] * (pv - cv) + mu1[rc] * (nv - cv);
            lin[i * LIN + j] = (bf16_t)f2bf(j < 64 ? ftanh(x) : (j < 128 ? x : sigmoidf_(x)));
        }
        __syncthreads();
        for (int rep_ = 0; rep_ < (MK_PROBE == 1 ? 2 : 1); ++rep_) {
#pragma unroll 1
            for (int qg = 0; qg < 3; ++qg) {
                bf16x8 bw_[5][4]; float bias_[5];
#pragma unroll
                for (int q5 = 0; q5 < 5; ++q5) {
                    const int nt = wave * 15 + qg * 5 + q5, grp = nt / 24, c = (nt % 24) * 16 + col;
                    const bf16_t* bw = LWT + (size_t)(nt * 16 + col) * 128 + 8 * g;
#pragma unroll
                    for (int ks = 0; ks < 2; ++ks) bw_[q5][ks] = *(const bf16x8*)(bw + ks * 32);
                    if (grp == 4) {
#pragma unroll
                        for (int ks = 2; ks < 4; ++ks) bw_[q5][ks] = *(const bf16x8*)(bw + ks * 32);
                    }
                    bias_[q5] = grp < 2 ? w0[grp * RW + c] : (grp < 4 ? a0[(grp - 2) * RW + c] : 0.f);
                }
#pragma unroll
                for (int q5 = 0; q5 < 5; ++q5) {
                    const int nt = wave * 15 + qg * 5 + q5, grp = nt / 24, c = (nt % 24) * 16 + col;
                    const int kcol = grp < 2 ? 0 : (grp < 4 ? 64 : 128);
                    f32x4 acc = (f32x4){0.f, 0.f, 0.f, 0.f};
#pragma unroll
                    for (int ks = 0; ks < 2; ++ks) acc = MFMA16(*(const bf16x8*)(lin + col * LIN + kcol + ks * 32 + 8 * g), bw_[q5][ks], acc);
                    if (grp == 4) {
#pragma unroll
                        for (int ks = 2; ks < 4; ++ks) acc = MFMA16(*(const bf16x8*)(lin + col * LIN + kcol + ks * 32 + 8 * g), bw_[q5][ks], acc);
                    }
                    if (grp < 2) {
#pragma unroll
                        for (int r = 0; r < 4; ++r) { const float lw = -fexp(-softplusf_(-(acc[r] + bias_[q5])) - 0.5f); const size_t o = (size_t)grp * T * RW + (size_t)(t0 + 4 * g + r) * RW + c; LWG[o] = lw;
#if !MK_RWKV_CHUNKED
                            DEC[o] = expf(lw);
#endif
                        }
                    } else if (grp < 4) {
#pragma unroll
                        for (int r = 0; r < 4; ++r) ICLR[(size_t)(grp - 2) * T * RW + (size_t)(t0 + 4 * g + r) * RW + c] = sigmoidf_(acc[r] + bias_[q5]);
                    } else {
#pragma unroll
                        for (int r = 0; r < 4; ++r) GATE[(size_t)(t0 + 4 * g + r) * RW + c] = acc[r];
                    }
                }
            }
        }
        __syncthreads();
        for (int rep_ = 0; rep_ < (MK_PROBE == 2 ? 2 : 1); ++rep_) if (wave < 6) {
            const int c = tid, h = wave;
            const float kkc = k_k[c], kac = k_a[c], rkc = r_k[c];
            const float m0r = mu0[c], m1r = mu1[c], m0k = mu0[RW + c], m1k = mu1[RW + c], m0v = mu0[2 * RW + c], m1v = mu1[2 * RW + c];
            float ic0[16], ic1[16];
#pragma unroll
            for (int i = 0; i < 16; ++i) { const size_t o = (size_t)(t0 + i) * RW + c; ic0[i] = ICLR[o]; ic1[i] = ICLR[(size_t)T * RW + o]; }
#pragma unroll
            for (int i = 0; i < 16; ++i) {
                const int t = t0 + i;
                const float* w_ = win + i * RPROJ + c;
                const float rp = w_[0], rc_ = w_[RPROJ], rn = w_[2 * RPROJ];
                const float kp = w_[RW], kc_ = w_[RPROJ + RW], kn = w_[2 * RPROJ + RW];
                const float vp = w_[2 * RW], vc_ = w_[RPROJ + 2 * RW], vn = w_[2 * RPROJ + 2 * RW];
                const float r = rc_ + m0r * (rp - rc_) + m1r * (rn - rc_);
                const float k = kc_ + m0k * (kp - kc_) + m1k * (kn - kc_);
                const float v = vc_ + m0v * (vp - vc_) + m1v * (vn - vc_);
                const size_t o = (size_t)t * RW + c;
                const float kq = k * kkc;
                const float n2 = wave_sum_fast(kq * kq, lane);
                const float kk = kq / fmaxf(sqrtf(n2), 1e-12f);
                const float kd0 = k * (1.0f + (ic0[i] - 1.0f) * kac), kd1 = k * (1.0f + (ic1[i] - 1.0f) * kac);
                const float bon = wave_sum_fast(r * (kd0 + kd1) * rkc, lane);
#if MK_RWKV_CHUNKED
                RB[o] = (bf16_t)f2bf(r); VB[o] = (bf16_t)f2bf(v); KKB[o] = (bf16_t)f2bf(kk);
                BBB[o] = (bf16_t)f2bf(kk * ic0[i]); BBB[(size_t)T * RW + o] = (bf16_t)f2bf(kk * ic1[i]);
                KDB[o] = (bf16_t)f2bf(kd0); KDB[(size_t)T * RW + o] = (bf16_t)f2bf(kd1);
#else
                RR[o] = r; VV[o] = v; KK[o] = kk;
                KD[o] = kd0; KD[(size_t)T * RW + o] = kd1;
#endif
                if (lane == 0) BONUS[(size_t)t * RH + h] = bon;
#if !MK_RWKV_CHUNKED
                { const float br0 = wave_sum(kk * ic0[i] * r, lane), br1 = wave_sum(kk * ic1[i] * r, lane), kr0 = wave_sum(kd0 * r, lane), kr1 = wave_sum(kd1 * r, lane);
                  if (lane == 0) { BRKR[((size_t)t * RH + h) * 2] = br0; BRKR[((size_t)t * RH + h) * 2 + 1] = kr0; BRKR[((size_t)(T + t) * RH + h) * 2] = br1; BRKR[((size_t)(T + t) * RH + h) * 2 + 1] = kr1; } }
#endif
            }
        }
        __syncthreads();
        {
            u32x2 wb[9], vb[3];
            const int rsel = tid >= 192 ? 1 : 0, c4 = tid - rsel * 192;
#pragma unroll
            for (int it = 0; it < 9; ++it) {
                const int row = 2 * it + rsel, sq = s0 - 1 + row;
                wb[it] = (u32x2){0u, 0u};
                if (tid < 384 && sq >= 0 && sq < S) wb[it] = *(const u32x2*)(proj + (size_t)(t0 - 1 + row) * PLD + C_MW + c4 * 4);
            }
#pragma unroll
            for (int it = 0; it < 3; ++it) { const int idx = tid + it * NTHREADS, i = idx / 96, cc = (idx % 96) * 4; vb[it] = *(const u32x2*)(proj + (size_t)(t0 + i) * PLD + C_MW + 2 * MW + cc); }
            if (tid < 384) {
#pragma unroll
                for (int it = 0; it < 9; ++it) *(f32x4*)(win + (2 * it + rsel) * 768 + c4 * 4) = (f32x4){bf_lo(wb[it].x), bf_hi(wb[it].x), bf_lo(wb[it].y), bf_hi(wb[it].y)};
            }
#pragma unroll
            for (int it = 0; it < 3; ++it) { const int idx = tid + it * NTHREADS, i = idx / 96, cc = (idx % 96) * 4; const u32x2 v = vb[it];
                tv[(cc + 0) * 16 + i] = (bf16_t)(v.x & 0xffffu); tv[(cc + 1) * 16 + i] = (bf16_t)(v.x >> 16); tv[(cc + 2) * 16 + i] = (bf16_t)(v.y & 0xffffu); tv[(cc + 3) * 16 + i] = (bf16_t)(v.y >> 16); }
        }
        for (int idx = tid; idx < 16 * 24; idx += NTHREADS) {
            const int i = idx / 24, gi = idx % 24, t = t0 + i;
            const int isf = gi / 12, dir = (gi / 6) & 1, h = gi % 6;
            const float gg = projg[(size_t)t * 256 + (3456 - (PLD - 256)) + gi] + gate_b[gi];
            if (isf) LF[((size_t)dir * T + t) * MH + h] = -softplusf_(-gg); else IG[((size_t)dir * T + t) * MH + h] = gg;
        }
        __syncthreads();
        for (int rep_ = 0; rep_ < (MK_PROBE == 4 ? 2 : 1); ++rep_)
        for (int idx = tid; idx < 16 * 768; idx += NTHREADS) {
            const int i = idx / 768, c = idx % 768, t = t0 + i;
            const float* w_ = win + i * 768 + c;
            float y = conv_b[c] + w_[0] * conv_w[c] + w_[768] * conv_w[768 + c] + w_[1536] * conv_w[2 * 768 + c];
            y = y * sigmoidf_(y);
            if (c < MW) MQB[(size_t)t * MW + c] = (bf16_t)f2bf(y);
            else { const bf16_t kb = (bf16_t)f2bf(y * 0.125f); MKB[(size_t)t * MW + (c - MW)] = kb; tk[(c - MW) * 16 + i] = kb; }
        }
        __syncthreads();
        for (int idx = tid; idx < 2 * MW * 2; idx += NTHREADS) {
            const int hf = idx & 1, c = (idx >> 1) % MW, which = idx / (2 * MW);
            const u32x4 val = *(const u32x4*)((which ? tv : tk) + c * 16 + hf * 8);
            bf16_t* dst = (which ? VT : KT) + ((size_t)(bb * MH) * 64 + c) * S + s0 + hf * 8;
            *(u32x4*)dst = val;
        }
    }
    __syncthreads();
}

__device__ __forceinline__ void phase_prep32(const Params& P, int l, unsigned char* smem, int wv) {
    ParamsPtr pp = PARAMS_PTR(P); PIN_S(pp); unsigned char* ws = pp->ws; int bidx = (int)blockIdx.x, gdim = (int)gridDim.x; PIN_S(bidx); PIN_S(gdim);
    const bf16_t* proj = (const bf16_t*)(ws + O_PROJ); const float* projg = (const float*)(ws + O_PROJG);
    float* UG = (float*)(ws + O_UG); bf16_t* VNT = (bf16_t*)(ws + O_VNT);
    u32x4* RK7 = (u32x4*)(ws + O_RK7);
    float* GATE = (float*)(ws + O_GATE); float* BONUS = (float*)(ws + O_BONUS); float* LWG = (float*)(ws + O_LW);
    bf16_t* VB = (bf16_t*)(ws + O_VB);
    bf16_t* MQB = (bf16_t*)(ws + O_MQB); bf16_t* MKB = (bf16_t*)(ws + O_MKB); bf16_t* KT = (bf16_t*)(ws + O_KT); bf16_t* VT = (bf16_t*)(ws + O_VT);
    float* IG = (float*)(ws + O_IG); float* LF = (float*)(ws + O_LF);
    const bf16_t* LWT = (const bf16_t*)(ws + O_LWT) + (size_t)l * 1920 * 128;
    const float* gln_g = pp->in[2] + (size_t)l * GW; const float* gln_b = pp->in[3] + (size_t)l * GW;
    const float* mu0 = pp->in[6] + (size_t)l * 2 * RPROJ; const float* mu1 = mu0 + RPROJ;
    const float* w0 = pp->in[7] + (size_t)l * 2 * RW; const float* a0 = pp->in[9] + (size_t)l * 2 * RW;
    const float* k_k = pp->in[12] + (size_t)l * RW; const float* k_a = pp->in[13] + (size_t)l * RW; const float* r_k = pp->in[14] + (size_t)l * RW;
    const float* conv_w = pp->in[17] + (size_t)l * 3 * 768; const float* conv_b = pp->in[18] + (size_t)l * 768; const float* gate_b = pp->in[19] + (size_t)l * 24;
    constexpr int TOK = 32, WR = TOK + 2, LIN = 264;
    bf16_t* winb = (bf16_t*)smem;
    bf16_t* lin = (bf16_t*)(smem + 95744);
    bf16_t* tk = (bf16_t*)(smem + 112640);
    bf16_t* tv = (bf16_t*)(smem + 137216);
    bf16_t* tvn = tk;
    bf16_t* icl = tk;
    const int tid = phase_tid(wv), lane = tid & 63, wave = tid >> 6, col = lane & 15, g = lane >> 4;
    for (int u = bidx; u < T / TOK; u += gdim) {
        const int t0 = u * TOK, s0 = t0 % S, bb = t0 / S;
        __syncthreads();
#pragma unroll 1
        for (int hb = 0; hb < 2; ++hb) {
            u32x2 wb[17];
#pragma unroll
            for (int q = 0; q < 17; ++q) {
                const int row = hb * 17 + q, sq = s0 - 1 + row;
                wb[q] = (u32x2){0u, 0u};
                if (sq >= 0 && sq < S && tid < 352) wb[q] = *(const u32x2*)(proj + (size_t)(t0 - 1 + row) * PLD + C_RW + tid * 4);
            }
            if (tid < 352) {
#pragma unroll
                for (int q = 0; q < 17; ++q) *(u32x2*)(winb + (hb * 17 + q) * RPROJ + tid * 4) = wb[q];
            }
        }
#pragma unroll 1
        for (int ps = 0; ps < 2; ++ps) {
            const int i = ps * 16 + (tid >> 5), l32 = tid & 31, t = t0 + i;
            float v[8], ug[8]; float sum = 0.f;
#pragma unroll
            for (int j = 0; j < 8; ++j) { const int c = j * 32 + l32; ug[j] = bf_lo((unsigned)proj[(size_t)t * PLD + c]); v[j] = bf_lo((unsigned)proj[(size_t)t * PLD + GW + c]); }
#pragma unroll
            for (int j = 0; j < 8; ++j) { const int c = j * 32 + l32; UG[(size_t)t * GW + c] = geluf_(ug[j]); v[j] = geluf_(v[j]); sum += v[j]; }
#pragma unroll
            for (int o = 16; o >= 1; o >>= 1) sum += SHX(sum, o, lane);
            const float mean = sum * (1.0f / GW); float q = 0.f;
#pragma unroll
            for (int j = 0; j < 8; ++j) { const float d = v[j] - mean; q += d * d; }
#pragma unroll
            for (int o = 16; o >= 1; o >>= 1) q += SHX(q, o, lane);
            const float rstd = 1.0f / sqrtf(q * (1.0f / GW) + LN_EPS);
#pragma unroll
            for (int j = 0; j < 8; ++j) { const int c = j * 32 + l32; tvn[c * TOK + i] = (bf16_t)f2bf((v[j] - mean) * rstd * gln_g[c] + gln_b[c]); }
        }
        __syncthreads();
#pragma unroll
        for (int q = 0; q < 2; ++q) {
            const int idx = tid + q * NTHREADS, c = idx >> 2, pc = idx & 3;
            *(u32x4*)(VNT + ((size_t)bb * GW + c) * S + s0 + pc * 8) = *(const u32x4*)(tvn + c * TOK + pc * 8);
        }
        int tb2 = tid; PIN_V(tb2);
#pragma unroll 4
        for (int q = 0; q < 16; ++q) {
            const int idx = tb2 + q * NTHREADS, i = idx >> 8, j = idx & 255, rc = 1152 + j;
            const float pv = bf_lo((unsigned)winb[i * RPROJ + rc]), cv = bf_lo((unsigned)winb[(i + 1) * RPROJ + rc]), nv = bf_lo((unsigned)winb[(i + 2) * RPROJ + rc]);
            const float x = cv + mu0[rc] * (pv - cv) + mu1[rc] * (nv - cv);
            lin[i * LIN + j] = (bf16_t)f2bf(j < 64 ? ftanh(x) : (j < 128 ? x : sigmoidf_(x)));
        }
        __syncthreads();
#pragma unroll 1
        for (int qg = 0; qg < 3; ++qg) {
            bf16x8 bw_[5][4]; float bias_[5];
#pragma unroll
            for (int q5 = 0; q5 < 5; ++q5) {
                const int nt = wave * 15 + qg * 5 + q5, grp = nt / 24, c = (nt % 24) * 16 + col;
                const bf16_t* bw = LWT + (size_t)(nt * 16 + col) * 128 + 8 * g;
#pragma unroll
                for (int ks = 0; ks < 2; ++ks) bw_[q5][ks] = *(const bf16x8*)(bw + ks * 32);
                if (grp == 4) {
#pragma unroll
                    for (int ks = 2; ks < 4; ++ks) bw_[q5][ks] = *(const bf16x8*)(bw + ks * 32);
                }
                bias_[q5] = grp < 2 ? w0[grp * RW + c] : (grp < 4 ? a0[(grp - 2) * RW + c] : 0.f);
            }
#pragma unroll
            for (int q5 = 0; q5 < 5; ++q5) {
                const int nt = wave * 15 + qg * 5 + q5, grp = nt / 24, c = (nt % 24) * 16 + col;
                const int kcol = grp < 2 ? 0 : (grp < 4 ? 64 : 128);
#pragma unroll
                for (int mt = 0; mt < 2; ++mt) {
                    f32x4 acc = (f32x4){0.f, 0.f, 0.f, 0.f};
                    const bf16_t* la = lin + (mt * 16 + col) * LIN + kcol + 8 * g;
#pragma unroll
                    for (int ks = 0; ks < 2; ++ks) acc = MFMA16(*(const bf16x8*)(la + ks * 32), bw_[q5][ks], acc);
                    if (grp == 4) {
#pragma unroll
                        for (int ks = 2; ks < 4; ++ks) acc = MFMA16(*(const bf16x8*)(la + ks * 32), bw_[q5][ks], acc);
                    }
                    const size_t tb = (size_t)(t0 + mt * 16 + 4 * g);
                    if (grp < 2) {
#pragma unroll
                        for (int r = 0; r < 4; ++r) LWG[(size_t)grp * T * RW + (tb + r) * RW + c] = -fexp(-softplusf_(-(acc[r] + bias_[q5])) - 0.5f);
                    } else if (grp < 4) {
#pragma unroll
                        for (int r = 0; r < 4; ++r) icl[((grp - 2) * TOK + mt * 16 + 4 * g + r) * RW + c] = (bf16_t)f2bf(sigmoidf_(acc[r] + bias_[q5]));
                    } else {
#pragma unroll
                        for (int r = 0; r < 4; ++r) GATE[(tb + r) * RW + c] = acc[r];
                    }
                }
            }
        }
        __syncthreads();
        if (wave < 6) {
            int c = tid; PIN_V(c); const int h = wave;
            const float kkc = k_k[c], kac = k_a[c], rkc = r_k[c];
            const float m0r = mu0[c], m1r = mu1[c], m0k = mu0[RW + c], m1k = mu1[RW + c], m0v = mu0[2 * RW + c], m1v = mu1[2 * RW + c];
#pragma unroll 1
            for (int hb = 0; hb < 2; ++hb) {
                float ic0[16], ic1[16];
#pragma unroll
                for (int i = 0; i < 16; ++i) { ic0[i] = bf_lo((unsigned)icl[(hb * 16 + i) * RW + c]); ic1[i] = bf_lo((unsigned)icl[(TOK + hb * 16 + i) * RW + c]); }
#pragma unroll
                for (int i = 0; i < 16; ++i) {
                    const int it = hb * 16 + i, t = t0 + it;
                    const bf16_t* w_ = winb + it * RPROJ + c;
                    const float rp = bf_lo((unsigned)w_[0]), rc_ = bf_lo((unsigned)w_[RPROJ]), rn = bf_lo((unsigned)w_[2 * RPROJ]);
                    const float kp = bf_lo((unsigned)w_[RW]), kc_ = bf_lo((unsigned)w_[RPROJ + RW]), kn = bf_lo((unsigned)w_[2 * RPROJ + RW]);
                    const float vp = bf_lo((unsigned)w_[2 * RW]), vc_ = bf_lo((unsigned)w_[RPROJ + 2 * RW]), vn = bf_lo((unsigned)w_[2 * RPROJ + 2 * RW]);
                    const float r = rc_ + m0r * (rp - rc_) + m1r * (rn - rc_);
                    const float k = kc_ + m0k * (kp - kc_) + m1k * (kn - kc_);
                    const float v = vc_ + m0v * (vp - vc_) + m1v * (vn - vc_);
                    const size_t o = (size_t)t * RW + c;
                    const float kq = k * kkc;
                    const float n2 = wave_sum_fast(kq * kq, lane);
                    const float kk = kq / fmaxf(sqrtf(n2), 1e-12f);
                    const float kd0 = k * (1.0f + (ic0[i] - 1.0f) * kac), kd1 = k * (1.0f + (ic1[i] - 1.0f) * kac);
                    const float bon = wave_sum_fast(r * (kd0 + kd1) * rkc, lane);
                    u32x4 rec; rec.x = pk2(r, v); rec.y = pk2(kk, 0.f); rec.z = pk2(kk * ic0[i], kk * ic1[i]); rec.w = pk2(kd0, kd1);
                    RK7[o] = rec;
                    VB[o] = (bf16_t)(rec.x >> 16);
                    if (lane == 0) BONUS[(size_t)t * RH + h] = bon;
                }
            }
        }
        __syncthreads();
        {
            u32x2 wb[17], vb[6];
            const int rsel = tid >= 192 ? 1 : 0, c4 = tid - rsel * 192;
#pragma unroll
            for (int q = 0; q < 17; ++q) {
                const int row = 2 * q + rsel, sq = s0 - 1 + row;
                wb[q] = (u32x2){0u, 0u};
                if (tid < 384 && sq >= 0 && sq < S) wb[q] = *(const u32x2*)(proj + (size_t)(t0 - 1 + row) * PLD + C_MW + c4 * 4);
            }
#pragma unroll
            for (int q = 0; q < 6; ++q) { const int idx = tid + q * NTHREADS, i = idx / 96, cc = (idx % 96) * 4; vb[q] = *(const u32x2*)(proj + (size_t)(t0 + i) * PLD + C_MW + 2 * MW + cc); }
            if (tid < 384) {
#pragma unroll
                for (int q = 0; q < 17; ++q) *(u32x2*)(winb + (2 * q + rsel) * 768 + c4 * 4) = wb[q];
            }
#pragma unroll
            for (int q = 0; q < 6; ++q) { const int idx = tid + q * NTHREADS, i = idx / 96, cc = (idx % 96) * 4; const u32x2 v = vb[q];
                tv[(cc + 0) * TOK + i] = (bf16_t)(v.x & 0xffffu); tv[(cc + 1) * TOK + i] = (bf16_t)(v.x >> 16); tv[(cc + 2) * TOK + i] = (bf16_t)(v.y & 0xffffu); tv[(cc + 3) * TOK + i] = (bf16_t)(v.y >> 16); }
        }
        for (int idx = tid; idx < TOK * 24; idx += NTHREADS) {
            const int i = idx / 24, gi = idx % 24, t = t0 + i;
            const int isf = gi / 12, dir = (gi / 6) & 1, h = gi % 6;
            const float gg = projg[(size_t)t * 256 + (3456 - (PLD - 256)) + gi] + gate_b[gi];
            if (isf) LF[((size_t)dir * T + t) * MH + h] = -softplusf_(-gg); else IG[((size_t)dir * T + t) * MH + h] = gg;
        }
        __syncthreads();
        int tcv = tid; PIN_V(tcv);
#pragma unroll 4
        for (int q = 0; q < 48; ++q) {
            const int idx = tcv + q * NTHREADS, i = idx / 768, c = idx % 768, t = t0 + i;
            const bf16_t* w_ = winb + i * 768 + c;
            float y = conv_b[c] + bf_lo((unsigned)w_[0]) * conv_w[c] + bf_lo((unsigned)w_[768]) * conv_w[768 + c] + bf_lo((unsigned)w_[1536]) * conv_w[2 * 768 + c];
            y = y * sigmoidf_(y);
            if (c < MW) MQB[(size_t)t * MW + c] = (bf16_t)f2bf(y);
            else { const bf16_t kb = (bf16_t)f2bf(y * 0.125f); MKB[(size_t)t * MW + (c - MW)] = kb; tk[(c - MW) * TOK + i] = kb; }
        }
        __syncthreads();
#pragma unroll
        for (int q = 0; q < 6; ++q) {
            const int idx = tid + q * NTHREADS, pc = idx & 3, c = (idx >> 2) % MW, which = idx / (4 * MW);
            const u32x4 val = *(const u32x4*)((which ? tv : tk) + c * TOK + pc * 8);
            bf16_t* dst = (which ? VT : KT) + ((size_t)(bb * MH) * 64 + c) * S + s0 + pc * 8;
            *(u32x4*)dst = val;
        }
    }
    __syncthreads();
}

__device__ __forceinline__ void phase_gmlp_mix(const Params& P, int l, unsigned char* smem, int wv, int bid, int nb) {
    PIN_S(bid); PIN_S(nb);
    ParamsPtr pp = PARAMS_PTR(P); PIN_S(pp); unsigned char* ws = pp->ws;
    const float* UG = (const float*)(ws + O_UG); const bf16_t* VNT = (const bf16_t*)(ws + O_VNT); bf16_t* GRP = (bf16_t*)(ws + O_GRP);
    const bf16_t* WSB = (const bf16_t*)(ws + O_WSB) + (size_t)l * GH * CH * CH; const float* gbs = pp->in[5] + (size_t)l * GH * CH;
    const int tid = phase_tid(wv), lane = tid & 63, wave = tid >> 6, col = lane & 15, g = lane >> 4;
    constexpr int NU = NB * NCH * GH;
    bf16x8 wA[4], vA[4][4], wB[4], vB[4][4]; f32x4 uA[4], uB[4]; float bA, bB;
#define GM_LOAD(u_, W_, V_, U_, B_) do { const int h_ = (u_) % GH, c_ = ((u_) / GH) % NCH, b_ = (u_) / (GH * NCH); \
        const bf16_t* wb_ = WSB + (size_t)h_ * CH * CH + (size_t)(wave * 16 + col) * CH + 8 * g; \
        const bf16_t* vb_ = VNT + ((size_t)b_ * GW + h_ * 64 + col) * S + (size_t)c_ * CH + 8 * g; \
        _Pragma("unroll") for (int ks = 0; ks < 4; ++ks) { W_[ks] = *(const bf16x8*)(wb_ + ks * 32); \
            _Pragma("unroll") for (int et = 0; et < 4; ++et) V_[et][ks] = *(const bf16x8*)(vb_ + (size_t)et * 16 * S + ks * 32); } \
        const size_t t_ = (size_t)(b_ * S + c_ * CH + wave * 16 + col); \
        _Pragma("unroll") for (int et = 0; et < 4; ++et) U_[et] = *(const f32x4*)(UG + t_ * GW + h_ * 64 + et * 16 + 4 * g); \
        B_ = gbs[h_ * CH + wave * 16 + col]; } while (0)
#define GM_COMP(u_, W_, V_, U_, B_) do { const int h_ = (u_) % GH, c_ = ((u_) / GH) % NCH, b_ = (u_) / (GH * NCH); \
        const size_t t_ = (size_t)(b_ * S + c_ * CH + wave * 16 + col); \
        _Pragma("unroll") for (int et = 0; et < 4; ++et) { f32x4 acc = (f32x4){0.f, 0.f, 0.f, 0.f}; \
            _Pragma("unroll") for (int ks = 0; ks < 4; ++ks) acc = MFMA16(V_[et][ks], W_[ks], acc); \
            u32x2 o_; o_.x = pk2(U_[et][0] * (acc[0] + B_), U_[et][1] * (acc[1] + B_)); o_.y = pk2(U_[et][2] * (acc[2] + B_), U_[et][3] * (acc[3] + B_)); \
            *(u32x2*)(GRP + t_ * D + h_ * 64 + et * 16 + 4 * g) = o_; } } while (0)
    int u = bid;
    if (u < NU) GM_LOAD(u, wA, vA, uA, bA);
    while (u < NU) {
        const int u1 = u + nb;
        if (u1 < NU) GM_LOAD(u1, wB, vB, uB, bB);
        GM_COMP(u, wA, vA, uA, bA);
        if (u1 >= NU) break;
        const int u2 = u1 + nb;
        if (u2 < NU) GM_LOAD(u2, wA, vA, uA, bA);
        GM_COMP(u1, wB, vB, uB, bB);
        u = u2;
    }
#undef GM_LOAD
#undef GM_COMP
}

constexpr int SC_STEPS = 16;
constexpr int SC_BUF = SC_STEPS * 6 * 64;
__device__ __forceinline__ void phase_rwkv_scan(const Params& P, int l, unsigned char* smem, int wv, int bid, int nb) {
    PIN_S(bid); PIN_S(nb);
    ParamsPtr pp = PARAMS_PTR(P); PIN_S(pp); unsigned char* ws = pp->ws;
    const float* RR = (const float*)(ws + O_RR); const float* VV = (const float*)(ws + O_VV); const float* KK = (const float*)(ws + O_KK);
    const float* DEC = (const float*)(ws + O_DEC); const float* KD = (const float*)(ws + O_KD); const float* ICLR = (const float*)(ws + O_ICLR);
    float* SCAN = (float*)(ws + O_SCAN); const float* BRKR = (const float*)(ws + O_BRKR);
    const int tid = phase_tid(wv), lane = tid & 63, wave = tid >> 6, rl = (lane >> 4) & 1, kq = (lane & 15) | ((lane >> 5) << 4);
    float* buf = (float*)smem;
    float* scal = buf + 2 * SC_BUF;
    float* outb = scal + 2 * SC_STEPS * 2;
    typedef float f32x2 __attribute__((ext_vector_type(2)));
    for (int u = bid; u < 2 * NB * RH * 4; u += nb) {
        const int qt = u & 3, h = (u >> 2) % RH, b = (u / (4 * RH)) % NB, d = u / (4 * RH * NB);
        const size_t doff = (size_t)d * T * RW;
        float s0 = 0.f, s1 = 0.f;
        float pw[2], pa[2], pb[2], pk[2], pr[2], pv[2], psc = 0.f;
#define SC_LOAD(c) do { _Pragma("unroll") for (int i = 0; i < 2; ++i) { const int idx = tid + NTHREADS * i, st = idx >> 6, k = idx & 63; const int tau = (c) * SC_STEPS + st, sq = d ? S - 1 - tau : tau; \
            const size_t o = (size_t)(b * S + sq) * RW + h * 64 + k; \
            pw[i] = DEC[doff + o]; pa[i] = KK[o]; pb[i] = ICLR[doff + o]; pk[i] = KD[doff + o]; pr[i] = RR[o]; pv[i] = VV[o]; }     \
            if (tid < 2 * SC_STEPS) { const int tau = (c) * SC_STEPS + (tid >> 1), sq = d ? S - 1 - tau : tau; psc = BRKR[((size_t)(d * T + b * S + sq) * RH + h) * 2 + (tid & 1)]; } } while (0)
#define SC_WRITE(c) do { float* B_ = buf + ((c) & 1) * SC_BUF; _Pragma("unroll") for (int i = 0; i < 2; ++i) { const int idx = tid + NTHREADS * i, st = idx >> 6, k = idx & 63; \
            float* q_ = B_ + st * 384 + k; q_[0] = pw[i]; q_[64] = -pa[i]; q_[128] = pa[i] * pb[i]; q_[192] = pk[i]; q_[256] = pw[i] * pr[i]; q_[320] = pv[i]; } \
            if (tid < 2 * SC_STEPS) scal[((c) & 1) * SC_STEPS * 2 + tid] = psc; } while (0)
        __syncthreads();
        SC_LOAD(0); SC_WRITE(0);
        __syncthreads();
        const int row = qt * 16 + wave * 2 + rl;
        for (int c = 0; c < S / SC_STEPS; ++c) {
            const bool more = (c + 1) < S / SC_STEPS;
            if (more) SC_LOAD(c + 1);
            const float* B = buf + (c & 1) * SC_BUF; const float* sc = scal + (c & 1) * SC_STEPS * 2; float* ob = outb + (c & 1) * SC_STEPS * 16;
            float outs[SC_STEPS];
            f32x2 w2 = *(const f32x2*)(B + 2 * kq), a2 = *(const f32x2*)(B + 64 + 2 * kq), b2 = *(const f32x2*)(B + 128 + 2 * kq);
            f32x2 k2 = *(const f32x2*)(B + 192 + 2 * kq), wr2 = *(const f32x2*)(B + 256 + 2 * kq);
            float v = B[320 + row]; float br = sc[0], kr = sc[1];
#pragma unroll
            for (int st = 0; st < SC_STEPS; ++st) {
                const int sn = st + 1 < SC_STEPS ? st + 1 : st;
                const float* q = B + sn * 384;
                const f32x2 nw2 = *(const f32x2*)(q + 2 * kq), na2 = *(const f32x2*)(q + 64 + 2 * kq), nb2 = *(const f32x2*)(q + 128 + 2 * kq);
                const f32x2 nk2 = *(const f32x2*)(q + 192 + 2 * kq), nwr2 = *(const f32x2*)(q + 256 + 2 * kq);
                const float nv = q[320 + row], nbr = sc[sn * 2], nkr = sc[sn * 2 + 1];
                SCHED_BAR();
                float sa = s0 * a2.x + s1 * a2.y;
                float po = s0 * wr2.x + s1 * wr2.y;
                sa = row32_sum(sa); po = row32_sum(po);
                outs[st] = po + sa * br + v * kr;
                s0 = s0 * w2.x + (sa * b2.x + v * k2.x); s1 = s1 * w2.y + (sa * b2.y + v * k2.y);
                SCHED_BAR();
                w2 = nw2; a2 = na2; b2 = nb2; k2 = nk2; wr2 = nwr2; v = nv; br = nbr; kr = nkr;
            }
            if (kq == 0) {
#pragma unroll
                for (int st = 0; st < SC_STEPS; ++st) ob[st * 16 + wave * 2 + rl] = outs[st];
            }
            if (more) SC_WRITE(c + 1);
            __syncthreads();
            if (tid < 16 * SC_STEPS) {
                const int st = tid >> 4, r = tid & 15, tau = c * SC_STEPS + st, sq = d ? S - 1 - tau : tau;
                SCAN[doff + (size_t)(b * S + sq) * RW + h * 64 + qt * 16 + r] = ob[st * 16 + r];
            }
        }
#undef SC_LOAD
#undef SC_WRITE
    }
    __syncthreads();
}

constexpr int RST = 72;
constexpr int RARR = 64 * RST;
__device__ __forceinline__ f32x4 tile_nt(const bf16_t* Aa, int ta, const bf16_t* Ba, int tb, f32x4 acc, int col, int g) {
#pragma unroll
    for (int ks = 0; ks < 2; ++ks) {
        const bf16x8 af = *(const bf16x8*)(Aa + (ta * 16 + col) * RST + ks * 32 + 8 * g);
        const bf16x8 bfr = *(const bf16x8*)(Ba + (tb * 16 + col) * RST + ks * 32 + 8 * g);
        acc = MFMA16(af, bfr, acc);
    }
    return acc;
}
__device__ __forceinline__ void phase_rwkv_pre(const Params& P, int l, unsigned char* smem, int wv) {
    ParamsPtr pp = PARAMS_PTR(P); PIN_S(pp); unsigned char* ws = pp->ws; int bidx = (int)blockIdx.x, gdim = (int)gridDim.x; PIN_S(bidx); PIN_S(gdim);
    const u32x4* RK7 = (const u32x4*)(ws + O_RK7);
    const float* LWG = (const float*)(ws + O_LW);
    bf16_t* Qg = (bf16_t*)(ws + O_RQ); bf16_t* Ag = (bf16_t*)(ws + O_RA); bf16_t* Hg = (bf16_t*)(ws + O_RH); bf16_t* Gg = (bf16_t*)(ws + O_RG);
    const int tid0 = phase_tid(wv);
#define RW_STAGE_VARS int tid = tid0; PIN_V(tid); const int lane = tid & 63, wave = tid >> 6, col = lane & 15, g = lane >> 4; (void)lane; (void)wave; (void)col; (void)g;
    bf16_t* At = (bf16_t*)smem; bf16_t* Bt = At + RARR; bf16_t* Kt = Bt + RARR; bf16_t* Rt = Kt + RARR;
    bf16_t* BtT = Rt + RARR; bf16_t* KtT = BtT + RARR; bf16_t* VT = KtT + RARR;
    bf16_t* Lak = VT + RARR; bf16_t* Mrb = Lak + RARR; bf16_t* Mrk = Mrb + RARR; bf16_t* YT = Mrk + RARR; bf16_t* W2T = YT + RARR;
    bf16_t* Lbo = W2T + RARR;
    float* LabT = (float*)(Lbo + RARR);
    float* Xs = LabT + 4096;
    float* Pb = Xs + 4096;
    float* segs = Pb + 2048;
    float* PC = segs + 512;
    float plw[8]; u32x4 prec[8];
#define RW_LOAD(uu) do { const int c_ = (uu) % RNC, h_ = ((uu) / RNC) % RH, b_ = ((uu) / (RNC * RH)) % NB, d_ = (uu) / (RNC * RH * NB); const size_t doff_ = (size_t)d_ * T * RW; \
        const int ch_ = tid0 & 63, sg_ = tid0 >> 6; _Pragma("unroll") for (int j = 0; j < 8; ++j) { const int tau = c_ * RC + sg_ * 8 + j, sq = d_ ? S - 1 - tau : tau; const size_t o = (size_t)(b_ * S + sq) * RW + h_ * 64 + ch_; \
        plw[j] = LWG[doff_ + o]; prec[j] = RK7[o]; } } while (0)
    if (bidx < RUN) RW_LOAD(bidx);
    for (int u = bidx; u < RUN; u += gdim) {
        const int c = u % RNC, h = (u / RNC) % RH, b = (u / (RNC * RH)) % NB, d = u / (RNC * RH * NB);
        (void)c; (void)h; (void)b; (void)d;
        __syncthreads();
        {
            RW_STAGE_VARS
            const int ch = tid & 63, sg = tid >> 6;
            float lw[8]; unsigned kk[8], bq_[8], kd[8], rr[8], vv[8];
#pragma unroll
            for (int j = 0; j < 8; ++j) { lw[j] = plw[j]; kk[j] = prec[j].y & 0xffffu; bq_[j] = d ? (prec[j].z >> 16) : (prec[j].z & 0xffffu); kd[j] = d ? (prec[j].w >> 16) : (prec[j].w & 0xffffu); rr[j] = prec[j].x & 0xffffu; vv[j] = prec[j].x >> 16; }
            if (u + gdim < RUN) RW_LOAD(u + gdim);
            float run = 0.f;
#pragma unroll
            for (int j = 0; j < 8; ++j) { run += lw[j]; lw[j] = run; }
            segs[sg * 64 + ch] = run;
            __syncthreads();
            float off = 0.f;
            for (int q = 0; q < sg; ++q) off += segs[q * 64 + ch];
            u32x4 pbt, pkt, pvt; unsigned tb[8], tk[8], tvv[8];
            float prev = off;
#pragma unroll
            for (int j = 0; j < 8; ++j) {
                const int t = sg * 8 + j; const float cl = off + lw[j];
                const float ep = fexp(prev), en = fexp(-cl), epc = fexp(cl);
                const unsigned a_ = f2bf(-bf_lo(kk[j]) * ep), b_ = f2bf(bf_lo(bq_[j]) * en), k_ = f2bf(bf_lo(kd[j]) * en), r_ = f2bf(bf_lo(rr[j]) * epc), v_ = vv[j];
                At[t * RST + ch] = (bf16_t)a_; Bt[t * RST + ch] = (bf16_t)b_; Kt[t * RST + ch] = (bf16_t)k_; Rt[t * RST + ch] = (bf16_t)r_;
                tb[j] = b_; tk[j] = k_; tvv[j] = v_;
                prev = cl;
            }
            if (sg == 7) PC[ch] = fexp(prev);
            pbt.x = tb[0] | (tb[1] << 16); pbt.y = tb[2] | (tb[3] << 16); pbt.z = tb[4] | (tb[5] << 16); pbt.w = tb[6] | (tb[7] << 16);
            pkt.x = tk[0] | (tk[1] << 16); pkt.y = tk[2] | (tk[3] << 16); pkt.z = tk[4] | (tk[5] << 16); pkt.w = tk[6] | (tk[7] << 16);
            pvt.x = tvv[0] | (tvv[1] << 16); pvt.y = tvv[2] | (tvv[3] << 16); pvt.z = tvv[4] | (tvv[5] << 16); pvt.w = tvv[6] | (tvv[7] << 16);
            *(u32x4*)(BtT + ch * RST + sg * 8) = pbt; *(u32x4*)(KtT + ch * RST + sg * 8) = pkt; *(u32x4*)(VT + ch * RST + sg * 8) = pvt;
            for (int z_ = tid; z_ < 2 * RARR / 8; z_ += NTHREADS) ((u32x4*)YT)[z_] = (u32x4){0u, 0u, 0u, 0u};
        }
        __syncthreads();
        {
            RW_STAGE_VARS
            const int m = wave >> 1;
            const bf16_t* Ym = (m == 0 || m == 2) ? Bt : Kt; const bf16_t* Xm = (m < 2) ? At : Rt;
#pragma unroll 1
            for (int q = 0; q < 8; ++q) {
                const int tix = (wave & 1) * 8 + q, it = tix >> 2, tt = tix & 3;
                f32x4 acc = (f32x4){0.f, 0.f, 0.f, 0.f};
                if (it <= tt) acc = tile_nt(Ym, it, Xm, tt, acc, col, g);
                const int t = tt * 16 + col, i0 = it * 16 + 4 * g;
                float o4[4];
#pragma unroll
                for (int r = 0; r < 4; ++r) { const int i = i0 + r; const bool ok = m < 2 ? (i < t) : (i <= t); o4[r] = ok ? acc[r] : 0.f; }
                if (m == 0) {
#pragma unroll
                    for (int r = 0; r < 4; ++r) LabT[(i0 + r) * 64 + t] = o4[r];
                    const bool offd = it < tt;
                    u32x2 w2; w2.x = offd ? pk2(o4[0], o4[1]) : 0u; w2.y = offd ? pk2(o4[2], o4[3]) : 0u; *(u32x2*)(Lbo + t * RST + i0) = w2;
                }
                else { bf16_t* dst = (m == 1 ? Lak : (m == 2 ? Mrb : Mrk)) + t * RST + i0; u32x2 w2; w2.x = pk2(o4[0], o4[1]); w2.y = pk2(o4[2], o4[3]); *(u32x2*)dst = w2; }
            }
        }
        __syncthreads();
        {
            RW_STAGE_VARS
#pragma unroll
            for (int q = 0; q < 2; ++q) {
                const int tix = wave * 2 + q, tt = tix >> 2, et = tix & 3;
                f32x4 acc = (f32x4){0.f, 0.f, 0.f, 0.f};
                acc = tile_nt(Lak, tt, VT, et, acc, col, g);
#pragma unroll
                for (int r = 0; r < 4; ++r) Xs[(tt * 16 + 4 * g + r) * 64 + et * 16 + col] = acc[r];
            }
        }
        __syncthreads();
        {
            RW_STAGE_VARS
#pragma unroll 1
            for (int bb = 0; bb < 4; ++bb) {
                if (bb > 0) {
                    const bf16_t* Zt = (wave < 4 ? YT : W2T) + ((wave & 3) * 16 + col) * RST + 8 * g;
                    const bf16_t* La = Lbo + (16 * bb + col) * RST + 8 * g;
                    f32x4 acc = (f32x4){0.f, 0.f, 0.f, 0.f};
                    acc = MFMA16(*(const bf16x8*)La, *(const bf16x8*)Zt, acc);
                    if (bb > 2) acc = MFMA16(*(const bf16x8*)(La + 32), *(const bf16x8*)(Zt + 32), acc);
#pragma unroll
                    for (int r = 0; r < 4; ++r) Pb[(4 * g + r) * 128 + wave * 16 + col] = acc[r];
                }
                __syncthreads();
                if (wave < 2) {
                    float acc[16];
                    if (wave == 0) {
#pragma unroll
                        for (int r = 0; r < 16; ++r) acc[r] = bf_lo((unsigned)At[(16 * bb + r) * RST + lane]);
                    } else {
#pragma unroll
                        for (int r = 0; r < 16; ++r) acc[r] = Xs[(16 * bb + r) * 64 + lane];
                    }
                    if (bb > 0) {
#pragma unroll
                        for (int r = 0; r < 16; ++r) acc[r] += Pb[r * 128 + wave * 64 + lane];
                    }
                    const float* dp = LabT + (16 * bb) * 64 + 16 * bb;
#pragma unroll
                    for (int r = 1; r < 16; ++r)
#pragma unroll
                        for (int r2 = 0; r2 < r; ++r2) acc[r] += dp[r2 * 64 + r] * acc[r2];
                    bf16_t* dst = (wave == 0 ? YT : W2T) + lane * RST;
                    u32x4 w0, w1;
                    w0.x = pk2(acc[0], acc[1]); w0.y = pk2(acc[2], acc[3]); w0.z = pk2(acc[4], acc[5]); w0.w = pk2(acc[6], acc[7]);
                    w1.x = pk2(acc[8], acc[9]); w1.y = pk2(acc[10], acc[11]); w1.z = pk2(acc[12], acc[13]); w1.w = pk2(acc[14], acc[15]);
                    *(u32x4*)(dst + 16 * bb) = w0; *(u32x4*)(dst + 16 * bb + 8) = w1;
                }
                __syncthreads();
            }
        }
        __syncthreads();
        {
            RW_STAGE_VARS
            const int ty = wave >> 1;
#pragma unroll 1
            for (int q = 0; q < 8; ++q) {
                const int tix = (wave & 1) * 8 + q, ra = tix >> 2, cb = tix & 3;
                f32x4 acc = (f32x4){0.f, 0.f, 0.f, 0.f};
                if (ty == 0) {
                    acc = tile_nt(YT, ra, Mrb, cb, acc, col, g);
                    const u32x2 rt2 = *(const u32x2*)(Rt + (cb * 16 + col) * RST + ra * 16 + 4 * g);
                    u32x2 qb2; qb2.x = pk2(acc[0] + bf_lo(rt2.x), acc[1] + bf_hi(rt2.x)); qb2.y = pk2(acc[2] + bf_lo(rt2.y), acc[3] + bf_hi(rt2.y));
                    *(u32x2*)(Qg + (size_t)u * 4096 + ((((ra >> 1) * 4 + cb) * 64 + lane) * 8 + (ra & 1) * 4)) = qb2;
                } else if (ty == 1) {
                    acc = tile_nt(Mrb, ra, W2T, cb, acc, col, g); acc = tile_nt(Mrk, ra, VT, cb, acc, col, g);
                    { u32x2 hb; hb.x = pk2(acc[0], acc[1]); hb.y = pk2(acc[2], acc[3]); *(u32x2*)(Hg + (size_t)u * 4096 + (tix * 64 + lane) * 4) = hb; }
                } else if (ty == 2) {
                    acc = tile_nt(YT, ra, BtT, cb, acc, col, g);
                    const float pc = PC[cb * 16 + col]; const int k1 = cb * 16 + col;
                    float a4[4];
#pragma unroll
                    for (int r = 0; r < 4; ++r) a4[r] = pc * (acc[r] + ((ra * 16 + 4 * g + r) == k1 ? 1.0f : 0.f));
                    u32x2 ab2; ab2.x = pk2(a4[0], a4[1]); ab2.y = pk2(a4[2], a4[3]);
                    *(u32x2*)(Ag + (size_t)u * 4096 + ((((ra >> 1) * 4 + cb) * 64 + lane) * 8 + (ra & 1) * 4)) = ab2;
                } else {
                    acc = tile_nt(BtT, ra, W2T, cb, acc, col, g); acc = tile_nt(KtT, ra, VT, cb, acc, col, g);
#pragma unroll
                    for (int r = 0; r < 4; ++r) acc[r] *= PC[ra * 16 + 4 * g + r];
                    { u32x2 gb2; gb2.x = pk2(acc[0], acc[1]); gb2.y = pk2(acc[2], acc[3]); *(u32x2*)(Gg + (size_t)u * 4096 + (tix * 64 + lane) * 4) = gb2; }
                }
            }
        }
    }
    __syncthreads();
#undef RW_STAGE_VARS
#undef RW_LOAD
}
constexpr int RSEQ_WGS = 2 * NB * RH * 2;
template <int MODE = 0>
__device__ __forceinline__ void phase_rwkv_seq(const Params& P, int l, unsigned char* smem, int wv) {
    ParamsPtr pp = PARAMS_PTR(P); PIN_S(pp); unsigned char* ws = pp->ws; int bidx = (int)blockIdx.x, gdim = (int)gridDim.x; PIN_S(bidx); PIN_S(gdim);
    const bf16_t* Ag = (const bf16_t*)(ws + O_RA); const bf16_t* Gg = (const bf16_t*)(ws + O_RG); bf16_t* Sg = (bf16_t*)(ws + ((MODE & 4) ? O_XS : O_RS));
    const int tid = phase_tid(wv), lane = tid & 63, wave = tid >> 6, col = lane & 15, g = lane >> 4;
    if (wave >= 2) return;
    const int nwg = gdim < RSEQ_WGS ? gdim : RSEQ_WGS;
    if (bidx >= nwg) return;
    for (int un = wave * nwg + bidx; un < 2 * NB * RH * 4; un += 2 * nwg) {
        const int ch = un >> 2, eq = un & 3;
        f32x4 acc[4];
#pragma unroll
        for (int a_ = 0; a_ < 4; ++a_) acc[a_] = (f32x4){0.f, 0.f, 0.f, 0.f};
        u32x4 a0[4][2], a1[4][2], a2[4][2], a3[4][2]; u32x2 g0[4], g1[4], g2[4], g3[4];
        const unsigned aoff = (unsigned)(col * 64 + 16 * g), goff = (unsigned)(lane * 4), aoff8 = (unsigned)(lane * 8);
#define RS_LOAD(cc, AF, GQ) do { const int c_ = (cc) < RNC ? (cc) : RNC - 1; const bf16_t* ab_ = Ag + (size_t)(ch * RNC + c_) * 4096; const bf16_t* gb_ = Gg + (size_t)(ch * RNC + c_) * 4096 + eq * 256; \
            _Pragma("unroll") for (int ra = 0; ra < 4; ++ra) _Pragma("unroll") for (int p = 0; p < 2; ++p) AF[ra][p] = *(const u32x4*)(ab_ + ((p * 4 + ra) * 512) + aoff8); \
            _Pragma("unroll") for (int ra = 0; ra < 4; ++ra) GQ[ra] = *(const u32x2*)(gb_ + (ra * 1024) + goff); } while (0)
#define RS_STEP(c, AF, GQ) do { if (RNC % 4 == 0 || (c) < RNC) { SCHED_BAR(); bf16_t* sb_ = Sg + (size_t)(ch * RNC + (c)) * 4096 + eq * 1024; \
            bf16x8 bq[2]; _Pragma("unroll") for (int p = 0; p < 2; ++p) bq[p] = cvt8(acc[2 * p], acc[2 * p + 1]); \
            if (!(MODE & 1) || (c) == RNC - 1) { _Pragma("unroll") for (int p = 0; p < 2; ++p) *(bf16x8*)(sb_ + (p * 8) + aoff) = bq[p]; } \
            _Pragma("unroll") for (int ra = 0; ra < 4; ++ra) acc[ra] = (f32x4){bf_lo(GQ[ra].x), bf_hi(GQ[ra].x), bf_lo(GQ[ra].y), bf_hi(GQ[ra].y)}; \
            _Pragma("unroll") for (int ra = 0; ra < 4; ++ra) _Pragma("unroll") for (int p = 0; p < 2; ++p) acc[ra] = MFMA16(__builtin_bit_cast(bf16x8, AF[ra][p]), bq[p], acc[ra]); \
            if (!(MODE & 2)) RS_LOAD((c) + 4, AF, GQ); SCHED_BAR(); } } while (0)
        RS_LOAD(0, a0, g0); RS_LOAD(1, a1, g1); RS_LOAD(2, a2, g2); RS_LOAD(3, a3, g3);
#pragma unroll 1
        for (int c = 0; c < RNC; c += 4) { RS_STEP(c, a0, g0); RS_STEP(c + 1, a1, g1); RS_STEP(c + 2, a2, g2); RS_STEP(c + 3, a3, g3); }
#undef RS_LOAD
#undef RS_STEP
    }
}
__device__ __forceinline__ void phase_rwkv_out(const Params& P, int l, unsigned char* smem, int wv) {
    ParamsPtr pp = PARAMS_PTR(P); PIN_S(pp); unsigned char* ws = pp->ws; int bidx = (int)blockIdx.x, gdim = (int)gridDim.x; PIN_S(bidx); PIN_S(gdim);
    const bf16_t* Qg = (const bf16_t*)(ws + O_RQ); const bf16_t* Sg = (const bf16_t*)(ws + O_RS); const bf16_t* Hg = (const bf16_t*)(ws + O_RH);
    const bf16_t* VB = (const bf16_t*)(ws + O_VB); const float* GATE = (const float*)(ws + O_GATE); const float* BONUS = (const float*)(ws + O_BONUS);
    bf16_t* GRP = (bf16_t*)(ws + O_GRP);
    const float* rln_g = pp->in[15] + (size_t)l * RW; const float* rln_b = pp->in[16] + (size_t)l * RW;
    const int tid = phase_tid(wv), lane = tid & 63, wave = tid >> 6, col = lane & 15, g = lane >> 4;
    for (int pu = bidx * NWAVES + wave; pu < NB * RH * RNC; pu += gdim * NWAVES) {
        const int c = pu % RNC, h = (pu / RNC) % RH, b = pu / (RNC * RH);
        f32x4 o[2][4][4];
#pragma unroll
        for (int d = 0; d < 2; ++d) {
            const int u = ((d * NB + b) * RH + h) * RNC + (d ? RNC - 1 - c : c);
            const size_t ub = (size_t)u * 4096;
            bf16x8 qa[4][2], sb[4][2];
#pragma unroll
            for (int q = 0; q < 4; ++q)
#pragma unroll
                for (int ks = 0; ks < 2; ++ks) {
                    qa[q][ks] = *(const bf16x8*)(Qg + ub + ((ks * 4 + q) * 64 + lane) * 8);
                    sb[q][ks] = *(const bf16x8*)(Sg + ub + (q * 16 + col) * 64 + 16 * g + 8 * ks);
                }
#pragma unroll
            for (int tt = 0; tt < 4; ++tt)
#pragma unroll
                for (int et = 0; et < 4; ++et) {
                    const u32x2 hb = *(const u32x2*)(Hg + ub + ((tt * 4 + et) * 64 + lane) * 4);
                    f32x4 acc = (f32x4){bf_lo(hb.x), bf_hi(hb.x), bf_lo(hb.y), bf_hi(hb.y)};
#pragma unroll
                    for (int ks = 0; ks < 2; ++ks) acc = MFMA16(qa[tt][ks], sb[et][ks], acc);
                    o[d][tt][et] = acc;
                }
        }
        const int src = (3 - g) * 16 + col;
#pragma unroll
        for (int tt = 0; tt < 4; ++tt)
#pragma unroll
            for (int et = 0; et < 4; ++et)
#pragma unroll
                for (int r = 0; r < 4; ++r) o[0][tt][et][r] += SHL(o[1][3 - tt][et][3 - r], src);
        float* tile = (float*)smem + wave * (64 * 68);
        WAVE_SYNC();
#pragma unroll
        for (int tt = 0; tt < 4; ++tt)
#pragma unroll
            for (int et = 0; et < 4; ++et)
#pragma unroll
                for (int r = 0; r < 4; ++r) tile[(tt * 16 + 4 * g + r) * 68 + et * 16 + col] = o[0][tt][et][r];
        WAVE_SYNC();
        {
            const int c4 = (lane & 15) * 4, ch = h * 64 + c4;
            const f32x4 lg = *(const f32x4*)(rln_g + ch), lb = *(const f32x4*)(rln_b + ch);
#pragma unroll 1
            for (int qb = 0; qb < 2; ++qb) {
                f32x4 gt_[8]; u32x2 vb_[8]; float bo_[8];
#pragma unroll
                for (int q8 = 0; q8 < 8; ++q8) {
                    const size_t t = (size_t)(b * S + c * RC + (qb * 8 + q8) * 4 + (lane >> 4));
                    gt_[q8] = *(const f32x4*)(GATE + t * RW + ch); vb_[q8] = *(const u32x2*)(VB + t * RW + ch); bo_[q8] = BONUS[t * RH + h];
                }
#pragma unroll
                for (int q8 = 0; q8 < 8; ++q8) {
                    const int tl = (qb * 8 + q8) * 4 + (lane >> 4);
                    const size_t t = (size_t)(b * S + c * RC + tl);
                    const f32x4 x = *(const f32x4*)(tile + tl * 68 + c4);
                    const float mean = row16_sum((x.x + x.y) + (x.z + x.w)) * (1.0f / 64.0f);
                    const f32x4 dl = x - mean;
                    const float var = row16_sum((dl.x * dl.x + dl.y * dl.y) + (dl.z * dl.z + dl.w * dl.w)) * (1.0f / 64.0f);
                    const float rstd = 1.0f / sqrtf(var + GN_EPS);
                    f32x4 y = dl * rstd * lg + lb;
                    y.x += bo_[q8] * bf_lo(vb_[q8].x); y.y += bo_[q8] * bf_hi(vb_[q8].x); y.z += bo_[q8] * bf_lo(vb_[q8].y); y.w += bo_[q8] * bf_hi(vb_[q8].y);
                    y = y * gt_[q8];
                    u32x2 ob; ob.x = pk2(y.x, y.y); ob.y = pk2(y.z, y.w);
                    *(u32x2*)(GRP + t * D + GW + ch) = ob;
                }
            }
        }
    }
    __syncthreads();
}

__device__ __forceinline__ void phase_mlstm_local(const Params& P, int l, unsigned char* smem, int wv, int bid, int nb) {
    PIN_S(bid); PIN_S(nb);
    ParamsPtr pp = PARAMS_PTR(P); PIN_S(pp); unsigned char* ws = pp->ws;
    const bf16_t* KT = (const bf16_t*)(ws + O_KT); const bf16_t* VT = (const bf16_t*)(ws + O_VT);
    const float* IG = (const float*)(ws + O_IG); const float* LF = (const float*)(ws + O_LF);
    float* CL = (float*)(ws + O_CL); float* NLb = (float*)(ws + O_NL); float* ML = (float*)(ws + O_ML); float* BL = (float*)(ws + O_BL);
    float* GVT = (float*)(ws + O_GVT); float* PMX = (float*)(ws + O_PMX); float* BCT = (float*)(ws + O_BCT);
    const int tid = phase_tid(wv), lane = tid & 63, wave = tid >> 6, col = lane & 15, g = lane >> 4;
    float* wts = (float*)smem + wave * 128;
    for (int u = bid * NWAVES + wave; u < 2 * NB * MH * NCH; u += nb * NWAVES) {
        const int c = u % NCH, h = (u / NCH) % MH, p = u / (NCH * MH), d = p / NB, b = p % NB;
        const int tc = d ? NCH - 1 - c : c, tok0 = b * S + tc * CH;
        const int i0 = d ? 127 - 2 * lane : 2 * lane, i1 = d ? i0 - 1 : i0 + 1;
        const size_t g0 = ((size_t)d * T + tok0 + i0) * MH + h, g1 = ((size_t)d * T + tok0 + i1) * MH + h;
        const float lf0 = LF[g0], lf1 = LF[g1], ig0 = IG[g0], ig1 = IG[g1];
        const float c1 = lf0 + lf1;
        float incl = c1;
#pragma unroll
        for (int o = 1; o < 64; o <<= 1) { const float tq = SHUP(incl, o, lane); if (lane >= o) incl += tq; }
        const float excl = incl - c1, bc0 = excl + lf0, bc1 = incl;
        const float blast = RDL(incl, 63);
        const float gv0 = ig0 - bc0, gv1 = ig1 - bc1, pl1 = fmaxf(gv0, gv1);
        float mincl = pl1;
#pragma unroll
        for (int o = 1; o < 64; o <<= 1) { const float tq = SHUP(mincl, o, lane); if (lane >= o) mincl = fmaxf(mincl, tq); }
        float mexcl = SHUP(mincl, 1, lane); if (lane == 0) mexcl = -INFINITY;
        const float pm0 = fmaxf(mexcl, gv0), pm1 = mincl;
        const float mloc = blast + RDL(mincl, 63);
        WAVE_SYNC();
        wts[i0] = fexp(blast + gv0 - mloc); wts[i1] = fexp(blast + gv1 - mloc);
        GVT[g0] = gv0; GVT[g1] = gv1; PMX[g0] = pm0; PMX[g1] = pm1; BCT[g0] = bc0; BCT[g1] = bc1;
        if (lane == 0) { ML[u] = mloc; BL[u] = blast; }
        WAVE_SYNC();
        const bf16_t* vbase = VT + ((size_t)(b * MH + h) * 64) * S + (size_t)tc * CH;
        const bf16_t* kbase = KT + ((size_t)(b * MH + h) * 64) * S + (size_t)tc * CH;
        const unsigned loff = (unsigned)(col * S + 8 * g);
        f32x4 acc[4][4];
#pragma unroll
        for (int a_ = 0; a_ < 4; ++a_)
#pragma unroll
            for (int b_ = 0; b_ < 4; ++b_) acc[a_][b_] = (f32x4){0.f, 0.f, 0.f, 0.f};
        float nsum[4] = {0.f, 0.f, 0.f, 0.f};
#pragma unroll 1
        for (int ks = 0; ks < 4; ++ks) {
            const int ii = ks * 32 + 8 * g;
            const f32x4 w0 = *(const f32x4*)(wts + ii), w1 = *(const f32x4*)(wts + ii + 4);
            bf16x8 af[4], bfk[4];
#pragma unroll
            for (int q = 0; q < 4; ++q) af[q] = *(const bf16x8*)(vbase + ((size_t)q * 16 * S + ks * 32) + loff);
#pragma unroll
            for (int q = 0; q < 4; ++q) {
                const u32x4 kr = *(const u32x4*)(kbase + ((size_t)q * 16 * S + ks * 32) + loff);
                f32x4 k0, k1;
                k0.x = bf_lo(kr.x) * w0.x; k0.y = bf_hi(kr.x) * w0.y; k0.z = bf_lo(kr.y) * w0.z; k0.w = bf_hi(kr.y) * w0.w;
                k1.x = bf_lo(kr.z) * w1.x; k1.y = bf_hi(kr.z) * w1.y; k1.z = bf_lo(kr.w) * w1.z; k1.w = bf_hi(kr.w) * w1.w;
                nsum[q] += (k0.x + k0.y) + (k0.z + k0.w) + (k1.x + k1.y) + (k1.z + k1.w);
                bfk[q] = cvt8(k0, k1);
            }
#pragma unroll
            for (int a_ = 0; a_ < 4; ++a_)
#pragma unroll
                for (int b_ = 0; b_ < 4; ++b_) acc[a_][b_] = MFMA16(af[a_], bfk[b_], acc[a_][b_]);
        }
        float* cbase = CL + (size_t)u * 4096;
        const unsigned coff = (unsigned)(4 * g * 64 + col);
#pragma unroll
        for (int b_ = 0; b_ < 4; ++b_) {
#pragma unroll
            for (int a_ = 0; a_ < 4; ++a_)
#pragma unroll
                for (int r = 0; r < 4; ++r) cbase[(a_ * 16 * 64 + r * 64 + b_ * 16) + coff] = acc[a_][b_][r];
            float ns = nsum[b_]; ns += SHX(ns, 16, lane); ns += SHX(ns, 32, lane);
            if (g == 0) NLb[(size_t)u * 64 + b_ * 16 + col] = ns;
        }
    }
    __syncthreads();
}

__device__ __forceinline__ void phase_mlstm_carry(const Params& P, int l, unsigned char* smem, int wv, int bidx, int gdim) {
    ParamsPtr pp = PARAMS_PTR(P); PIN_S(pp); unsigned char* ws = pp->ws; PIN_S(bidx); PIN_S(gdim);
    float* CL = (float*)(ws + O_CL); float* NLb = (float*)(ws + O_NL); const float* ML = (const float*)(ws + O_ML); const float* BL = (const float*)(ws + O_BL);
    float* MIN = (float*)(ws + O_MIN);
    const int total = 2 * NB * MH * 4160;
    const int tid = phase_tid(wv);
    for (int gi = bidx * NTHREADS + tid; gi < total; gi += gdim * NTHREADS) {
        const int ph = gi / 4160, e = gi % 4160;
        float* base_ = e < 4096 ? CL + (size_t)ph * NCH * 4096 + e : NLb + (size_t)ph * NCH * 64 + (e - 4096);
        bf16_t* cb_ = (bf16_t*)(ws + O_CLB) + (size_t)ph * NCH * 4096 + e;
        const int stride = e < 4096 ? 4096 : 64;
        static_assert(NCH <= 32, "carry scan keeps one chunk value per register");
        float loc[NCH], bl[NCH], ml[NCH];
#pragma unroll
        for (int c = 0; c < NCH; ++c) { loc[c] = base_[(size_t)c * stride]; bl[c] = BL[ph * NCH + c]; ml[c] = ML[ph * NCH + c]; }
        float m = 0.f, val = 0.f;
#pragma unroll
        for (int c = 0; c < NCH; ++c) {
            if (e < 4096) cb_[(size_t)c * 4096] = (bf16_t)f2bf(val); else base_[(size_t)c * stride] = val;
            if (e == 0) MIN[ph * NCH + c] = m;
            const float mn = fmaxf(bl[c] + m, ml[c]);
            val = fexp(bl[c] + m - mn) * val + fexp(ml[c] - mn) * loc[c];
            m = mn;
        }
    }
}

__device__ __forceinline__ void phase_mlstm_out(const Params& P, int l, unsigned char* smem, int wv) {
    ParamsPtr pp = PARAMS_PTR(P); PIN_S(pp); unsigned char* ws = pp->ws; int bidx = (int)blockIdx.x, gdim = (int)gridDim.x; PIN_S(bidx); PIN_S(gdim);
    const bf16_t* proj = (const bf16_t*)(ws + O_PROJ);
    const bf16_t* MQB = (const bf16_t*)(ws + O_MQB); const bf16_t* MKB = (const bf16_t*)(ws + O_MKB); const bf16_t* VT = (const bf16_t*)(ws + O_VT);
    const float* GVT = (const float*)(ws + O_GVT); const float* PMX = (const float*)(ws + O_PMX); const float* BCT = (const float*)(ws + O_BCT);
    const bf16_t* CLB = (const bf16_t*)(ws + O_CLB); const float* NLb = (const float*)(ws + O_NL); const float* MIN = (const float*)(ws + O_MIN);
    bf16_t* GRP = (bf16_t*)(ws + O_GRP);
    const float* mln_g = pp->in[20] + (size_t)l * MW;
    const int tid = phase_tid(wv), lane = tid & 63, wave = tid >> 6, col = lane & 15, g = lane >> 4;
    constexpr int KP = 72, VP = 136, STG = 128 * KP * 2 + 64 * VP * 2 + 2 * 128 * 4;
    constexpr int NUm = NB * MH * NCH;
    const int it = wave * 16 + col;
    u32x4 kb_[2], vb_[2]; float gq_ = 0.f; bf16x8 bqn[2]; float minn[2], pmxn[2], bctn[2];
#define MO_EARLY(u_) do { const int tc_ = (u_) % NCH, h_ = ((u_) / NCH) % MH, b_ = (u_) / (NCH * MH); const int tok0_ = b_ * S + tc_ * CH; \
        _Pragma("unroll") for (int q = 0; q < 2; ++q) { const int idx = tid + q * NTHREADS; \
            kb_[q] = *(const u32x4*)(MKB + (size_t)(tok0_ + (idx >> 3)) * MW + h_ * 64 + (idx & 7) * 8); \
            vb_[q] = *(const u32x4*)(VT + ((size_t)(b_ * MH + h_) * 64 + (idx >> 4)) * S + (size_t)tc_ * CH + (idx & 15) * 8); } \
        if (tid < 256) gq_ = GVT[((size_t)(tid >> 7) * T + tok0_ + (tid & 127)) * MH + h_]; \
        const size_t trow_ = (size_t)(tok0_ + it); \
        _Pragma("unroll") for (int ks = 0; ks < 2; ++ks) bqn[ks] = *(const bf16x8*)(MQB + trow_ * MW + h_ * 64 + ks * 32 + 8 * g); \
        _Pragma("unroll") for (int d = 0; d < 2; ++d) { const int su_ = ((d * NB + b_) * MH + h_) * NCH + (d ? NCH - 1 - tc_ : tc_); const size_t gt_ = ((size_t)d * T + trow_) * MH + h_; \
            minn[d] = MIN[su_]; pmxn[d] = PMX[gt_]; bctn[d] = BCT[gt_]; } } while (0)
    int u = bidx, ui = 0;
    if (u < NUm) MO_EARLY(u);
    for (; u < NUm; u += gdim, ++ui) {
        const int tc = u % NCH, h = (u / NCH) % MH, b = u / (NCH * MH);
        const int tok0 = b * S + tc * CH;
        bf16_t* Ks = (bf16_t*)(smem + (ui & 1) * STG);
        bf16_t* Vs = Ks + 128 * KP;
        float* gvs_ = (float*)(Vs + 64 * VP);
#pragma unroll
        for (int q = 0; q < 2; ++q) {
            const int idx = tid + q * NTHREADS;
            *(u32x4*)(Ks + (idx >> 3) * KP + (idx & 7) * 8) = kb_[q];
            *(u32x4*)(Vs + (idx >> 4) * VP + (idx & 15) * 8) = vb_[q];
        }
        if (tid < 256) gvs_[tid] = gq_;
        bf16x8 bq[2] = {bqn[0], bqn[1]};
        const float mst_[2] = {minn[0], minn[1]}, pmx_[2] = {pmxn[0], pmxn[1]}, bct_[2] = {bctn[0], bctn[1]};
        const size_t trow = (size_t)(tok0 + it);
        bf16x8 cq[2][4][2]; f32x4 nl[2][2][2]; u32x2 og[4];
#define MO_LATE(d) do { const int su = (((d) * NB + b) * MH + h) * NCH + ((d) ? NCH - 1 - tc : tc); \
            _Pragma("unroll") for (int ks = 0; ks < 2; ++ks) { const float* np = NLb + (size_t)su * 64 + ks * 32 + 8 * g; \
                nl[d][ks][0] = *(const f32x4*)np; nl[d][ks][1] = *(const f32x4*)(np + 4); \
                _Pragma("unroll") for (int et = 0; et < 4; ++et) cq[d][et][ks] = *(const bf16x8*)(CLB + (size_t)su * 4096 + (size_t)(et * 16 + col) * 64 + ks * 32 + 8 * g); } } while (0)
        MO_LATE(0);
#pragma unroll
        for (int et = 0; et < 4; ++et) og[et] = *(const u32x2*)(proj + trow * PLD + C_MW + 3 * MW + h * 64 + et * 16 + 4 * g);
        __syncthreads();
        if (u + gdim < NUm) MO_EARLY(u + gdim);
        f32x4 hs[4];
#pragma unroll
        for (int et = 0; et < 4; ++et) hs[et] = (f32x4){0.f, 0.f, 0.f, 0.f};
#pragma unroll
        for (int d = 0; d < 2; ++d) {
            if (d == 1) MO_LATE(1);
            const float mst = mst_[d];
            const float mxt = fmaxf(pmx_[d], mst), mt = bct_[d] + mxt, wint = fexp(mst - mxt);
            f32x4 num[4];
#pragma unroll
            for (int et = 0; et < 4; ++et) num[et] = (f32x4){0.f, 0.f, 0.f, 0.f};
            float den = 0.f;
            for (int sp = 0; sp < 4; ++sp) {
                if (d == 0 ? (2 * sp > wave) : (2 * sp + 1 < wave)) continue;
                float pw[8];
#pragma unroll
                for (int hf = 0; hf < 2; ++hf) {
                    const int st = 2 * sp + hf;
                    f32x4 sacc = (f32x4){0.f, 0.f, 0.f, 0.f};
#pragma unroll
                    for (int ks = 0; ks < 2; ++ks) sacc = MFMA16(*(const bf16x8*)(Ks + (st * 16 + col) * KP + ks * 32 + 8 * g), bq[ks], sacc);
                    const f32x4 g4 = *(const f32x4*)(gvs_ + d * 128 + st * 16 + 4 * g);
#pragma unroll
                    for (int r = 0; r < 4; ++r) {
                        const int is = st * 16 + 4 * g + r;
                        const bool ok = d == 0 ? (is <= it) : (is >= it);
                        const float pr = ok ? sacc[r] * fexp(g4[r] - mxt) : 0.f;
                        den += pr; pw[hf * 4 + r] = pr;
                    }
                }
                u32x4 pb; pb.x = pk2(pw[0], pw[1]); pb.y = pk2(pw[2], pw[3]); pb.z = pk2(pw[4], pw[5]); pb.w = pk2(pw[6], pw[7]);
                const bf16x8 bp = __builtin_bit_cast(bf16x8, pb);
#pragma unroll
                for (int et = 0; et < 4; ++et) {
                    const bf16_t* vp = Vs + (et * 16 + col) * VP + sp * 32 + 4 * g;
                    const u32x2 v0 = *(const u32x2*)vp, v1 = *(const u32x2*)(vp + 16);
                    u32x4 va; va.x = v0.x; va.y = v0.y; va.z = v1.x; va.w = v1.y;
                    num[et] = MFMA16(__builtin_bit_cast(bf16x8, va), bp, num[et]);
                }
            }
            den += SHX(den, 16, lane); den += SHX(den, 32, lane);
            f32x4 qc[4]; float qn = 0.f;
#pragma unroll
            for (int ks = 0; ks < 2; ++ks) {
                const f32x4 n0 = nl[d][ks][0], n1 = nl[d][ks][1];
                const u32x4 qb = __builtin_bit_cast(u32x4, bq[ks]);
                qn += (bf_lo(qb.x) * n0.x + bf_hi(qb.x) * n0.y) + (bf_lo(qb.y) * n0.z + bf_hi(qb.y) * n0.w) + (bf_lo(qb.z) * n1.x + bf_hi(qb.z) * n1.y) + (bf_lo(qb.w) * n1.z + bf_hi(qb.w) * n1.w);
            }
            qn += SHX(qn, 16, lane); qn += SHX(qn, 32, lane);
#pragma unroll
            for (int et = 0; et < 4; ++et) {
                qc[et] = (f32x4){0.f, 0.f, 0.f, 0.f};
#pragma unroll
                for (int ks = 0; ks < 2; ++ks) qc[et] = MFMA16(cq[d][et][ks], bq[ks], qc[et]);
            }
            const float dd = frcp(fmaxf(fabsf(den + wint * qn), fexp(-mt)));
#pragma unroll
            for (int et = 0; et < 4; ++et) hs[et] += (num[et] + wint * qc[et]) * dd;
        }
        float sm = 0.f;
#pragma unroll
        for (int et = 0; et < 4; ++et) sm += (hs[et].x + hs[et].y) + (hs[et].z + hs[et].w);
        sm += SHX(sm, 16, lane); sm += SHX(sm, 32, lane);
        const float mean = sm * (1.0f / 64.0f); float q = 0.f;
#pragma unroll
        for (int et = 0; et < 4; ++et) { const f32x4 dl = hs[et] - mean; q += (dl.x * dl.x + dl.y * dl.y) + (dl.z * dl.z + dl.w * dl.w); }
        q += SHX(q, 16, lane); q += SHX(q, 32, lane);
        const float rstd = 1.0f / sqrtf(q * (1.0f / 64.0f) + LN_EPS);
#pragma unroll
        for (int et = 0; et < 4; ++et) {
            const int c = h * 64 + et * 16 + 4 * g;
            const u32x2 ob_ = og[et]; const f32x4 o4 = (f32x4){bf_lo(ob_.x), bf_hi(ob_.x), bf_lo(ob_.y), bf_hi(ob_.y)}, g4 = *(const f32x4*)(mln_g + c);
            const f32x4 y = (hs[et] - mean) * rstd * g4;
            u32x2 ob; ob.x = pk2(sigmoidf_(o4.x) * y.x, sigmoidf_(o4.y) * y.y); ob.y = pk2(sigmoidf_(o4.z) * y.z, sigmoidf_(o4.w) * y.w);
            *(u32x2*)(GRP + trow * D + GW + RW + c) = ob;
        }
    }
#undef MO_EARLY
#undef MO_LATE
    __syncthreads();
}

__device__ __forceinline__ void phase_rwkv_post(const Params& P, int l, unsigned char* smem, int wv) {
    ParamsPtr pp = PARAMS_PTR(P); PIN_S(pp); unsigned char* ws = pp->ws; int bidx = (int)blockIdx.x, gdim = (int)gridDim.x; PIN_S(bidx); PIN_S(gdim);
    const float* SCAN = (const float*)(ws + O_SCAN); const float* VV = (const float*)(ws + O_VV); const float* GATE = (const float*)(ws + O_GATE);
    const float* BONUS = (const float*)(ws + O_BONUS); bf16_t* GRP = (bf16_t*)(ws + O_GRP);
    const float* rln_g = pp->in[15] + (size_t)l * RW; const float* rln_b = pp->in[16] + (size_t)l * RW;
    const int tid = phase_tid(wv), lane = tid & 63, wave = tid >> 6;
    const int gw = bidx * NWAVES + wave, ngw = NWAVES * gdim;
    for (int it = gw; it < T * RH; it += ngw) {
        const int t = it / RH, h = it % RH, c = h * 64 + lane;
        const size_t o = (size_t)t * RW + c;
        const float x = SCAN[o] + SCAN[(size_t)T * RW + o];
        const float mean = wave_sum(x, lane) * (1.0f / 64.0f);
        const float dl = x - mean;
        const float var = wave_sum(dl * dl, lane) * (1.0f / 64.0f);
        float y = dl / sqrtf(var + GN_EPS) * rln_g[c] + rln_b[c];
        y += BONUS[(size_t)t * RH + h] * VV[o];
        GRP[(size_t)t * D + GW + c] = (bf16_t)f2bf(y * GATE[o]);
    }
}

__device__ __forceinline__ void phase_ln1_router(const Params& P, int l, unsigned char* smem, int wv) {
    ParamsPtr pp = PARAMS_PTR(P); PIN_S(pp); unsigned char* ws = pp->ws; int bidx = (int)blockIdx.x, gdim = (int)gridDim.x; PIN_S(bidx); PIN_S(gdim);
    const bf16_t* xin = (const bf16_t*)(ws + O_XB);
    const bf16_t* MIX = (const bf16_t*)(ws + O_MIX);
    int* TOPI = (int*)(ws + O_TOPI); float* TOPG = (float*)(ws + O_TOPG); int* RANK = (int*)(ws + O_RANK); bf16_t* X1B = (bf16_t*)(ws + O_X1B);
    int* BCNT = (int*)(ws + O_BCNT);
    const float* g1 = pp->in[22] + (size_t)l * D; const float* b1 = pp->in[23] + (size_t)l * D;
    const float* rw = pp->in[24] + (size_t)l * D * NE; const float* rb = pp->in[25] + (size_t)l * NE;
    const bf16_t* RWT = (const bf16_t*)(ws + O_RWT) + (size_t)l * 2 * NE * D;
    const int tid = phase_tid(wv), lane = tid & 63, wave = tid >> 6, col = lane & 15, g = lane >> 4;
    float* lgs = (float*)smem;
    int* stopi = (int*)(smem + 8704);
    constexpr int XHP = D + 8;
    bf16_t* XH = (bf16_t*)(smem + 16384);
    for (int tile = bidx; tile < T / 64; tile += gdim) {
        __syncthreads();
        {
            u32x2 xa[8][4], xm[8][4];
#pragma unroll
            for (int ti8 = 0; ti8 < 8; ++ti8) {
                const size_t tt_ = (size_t)(tile * 64 + wave * 8 + ti8);
#pragma unroll
                for (int j = 0; j < 4; ++j) { const int c = j * 256 + lane * 4; xa[ti8][j] = *(const u32x2*)(xin + tt_ * D + c); xm[ti8][j] = *(const u32x2*)(MIX + tt_ * D + c); }
            }
            f32x4 gg[4], bb[4];
#pragma unroll
            for (int j = 0; j < 4; ++j) { const int c = j * 256 + lane * 4; gg[j] = *(const f32x4*)(g1 + c); bb[j] = *(const f32x4*)(b1 + c); }
#pragma unroll
            for (int ti8 = 0; ti8 < 8; ++ti8) {
                const int t = tile * 64 + wave * 8 + ti8;
                float v[16]; float sm = 0.f;
#pragma unroll
                for (int j = 0; j < 4; ++j) {
                    v[j * 4 + 0] = ALPHA * bf_lo(xa[ti8][j].x) + bf_lo(xm[ti8][j].x); v[j * 4 + 1] = ALPHA * bf_hi(xa[ti8][j].x) + bf_hi(xm[ti8][j].x);
                    v[j * 4 + 2] = ALPHA * bf_lo(xa[ti8][j].y) + bf_lo(xm[ti8][j].y); v[j * 4 + 3] = ALPHA * bf_hi(xa[ti8][j].y) + bf_hi(xm[ti8][j].y);
                    sm += (v[j * 4] + v[j * 4 + 1]) + (v[j * 4 + 2] + v[j * 4 + 3]);
                }
                const float mean = wave_sum_fast(sm, lane) * (1.0f / D); float q = 0.f;
#pragma unroll
                for (int j = 0; j < 16; ++j) { const float dl = v[j] - mean; q += dl * dl; }
                const float rstd = 1.0f / sqrtf(wave_sum_fast(q, lane) * (1.0f / D) + LN_EPS);
#pragma unroll
                for (int j = 0; j < 4; ++j) {
                    const int c = j * 256 + lane * 4;
                    f32x4 o;
                    o.x = (v[j * 4 + 0] - mean) * rstd * gg[j].x + bb[j].x; o.y = (v[j * 4 + 1] - mean) * rstd * gg[j].y + bb[j].y;
                    o.z = (v[j * 4 + 2] - mean) * rstd * gg[j].z + bb[j].z; o.w = (v[j * 4 + 3] - mean) * rstd * gg[j].w + bb[j].w;
                    u32x2 ob; ob.x = pk2(o.x, o.y); ob.y = pk2(o.z, o.w); *(u32x2*)(X1B + (size_t)t * D + c) = ob;
                    *(u32x2*)(XH + (wave * 8 + ti8) * XHP + c) = ob;
                }
            }
        }
        __syncthreads();
        {
            const bf16_t* xr = XH + ((wave >> 1) * 16 + col) * XHP + 8 * g;
            const bf16_t* wh = RWT + (size_t)((wave & 1) * 16 + col) * D + 8 * g; const bf16_t* wl = wh + (size_t)NE * D;
            f32x4 acc = (f32x4){0.f, 0.f, 0.f, 0.f};
#pragma unroll 8
            for (int ks = 0; ks < 32; ++ks) {
                const bf16x8 ah = *(const bf16x8*)(xr + ks * 32);
                const bf16x8 bh = *(const bf16x8*)(wh + ks * 32), bl = *(const bf16x8*)(wl + ks * 32);
                acc = MFMA16(ah, bh, acc); acc = MFMA16(ah, bl, acc);
            }
            const float rbv = rb[(wave & 1) * 16 + col];
#pragma unroll
            for (int r = 0; r < 4; ++r) lgs[((wave >> 1) * 16 + 4 * g + r) * (NE + 1) + (wave & 1) * 16 + col] = acc[r] + rbv;
        }
        __syncthreads();
        if (tid < 64) {
            const float* lp = lgs + tid * (NE + 1); const int t = tile * 64 + tid;
            float tv[4]; int ti[4];
#pragma unroll
            for (int k = 0; k < 4; ++k) { tv[k] = -INFINITY; ti[k] = 0; }
            for (int e = 0; e < NE; ++e) {
                const float x = lp[e];
                if (x > tv[3]) {
                    if (x > tv[0]) { tv[3] = tv[2]; ti[3] = ti[2]; tv[2] = tv[1]; ti[2] = ti[1]; tv[1] = tv[0]; ti[1] = ti[0]; tv[0] = x; ti[0] = e; }
                    else if (x > tv[1]) { tv[3] = tv[2]; ti[3] = ti[2]; tv[2] = tv[1]; ti[2] = ti[1]; tv[1] = x; ti[1] = e; }
                    else if (x > tv[2]) { tv[3] = tv[2]; ti[3] = ti[2]; tv[2] = x; ti[2] = e; }
                    else { tv[3] = x; ti[3] = e; }
                }
            }
            const float e1 = expf(tv[1] - tv[0]), e2 = expf(tv[2] - tv[0]), e3 = expf(tv[3] - tv[0]);
            const float inv = 1.0f / (1.0f + e1 + e2 + e3);
            *(f32x4*)(TOPG + (size_t)t * 4) = (f32x4){inv, e1 * inv, e2 * inv, e3 * inv};
#pragma unroll
            for (int k = 0; k < 4; ++k) { TOPI[(size_t)t * 4 + k] = ti[k]; stopi[tid * 4 + k] = ti[k]; }
        }
        __syncthreads();
        int* wcnt = stopi + 256;
        int rk = 0, ex = 0;
        if (wave < 4) {
            ex = stopi[tid]; int mycnt = 0;
            for (int x = 0; x < NE; ++x) { const unsigned long long m = __ballot(ex == x); if (ex == x) rk = __popcll(m & ((1ull << lane) - 1ull)); if (lane == x) mycnt = __popcll(m); }
            if (lane < NE) wcnt[wave * NE + lane] = mycnt;
        }
        __syncthreads();
        if (wave < 4) { for (int w2 = 0; w2 < wave; ++w2) rk += wcnt[w2 * NE + ex]; RANK[(size_t)tile * 256 + tid] = rk; }
        else if (tid < 256 + NE) { const int e = tid - 256; BCNT[tile * NE + e] = (wcnt[e] + wcnt[NE + e]) + (wcnt[2 * NE + e] + wcnt[3 * NE + e]); }
    }
    __syncthreads();
}

__device__ __forceinline__ void moe_offsets(int* sh, const int* CNT, int tid) {
    if (tid == 0) {
        int acc = 0;
        for (int e = 0; e < NE; ++e) { const int c = (int)CNT[e]; sh[e] = c; sh[32 + e] = acc; acc += (c + MOEB - 1) / MOEB * MOEB; sh[64 + e] = acc; }
    }
    __syncthreads();
}
__device__ __forceinline__ int moe_expert_of_row(const int* sh, int r) {
    int e = -1;
    for (int i = 0; i < NE; ++i) if (r >= sh[32 + i] && r < sh[64 + i]) e = i;
    return e;
}

__device__ __forceinline__ void phase_scatter(const Params& P, int l, unsigned char* smem, int wv) {
    ParamsPtr pp = PARAMS_PTR(P); PIN_S(pp); unsigned char* ws = pp->ws; int bidx = (int)blockIdx.x, gdim = (int)gridDim.x; PIN_S(bidx); PIN_S(gdim);
    const int tid = phase_tid(wv);
    const int* TOPI = (const int*)(ws + O_TOPI); const int* RANK = (const int*)(ws + O_RANK); int* SLOT = (int*)(ws + O_SLOT); int* ROWT = (int*)(ws + O_ROWT);
    const int* BCNT = (const int*)(ws + O_BCNT); int* CNTF = (int*)(ws + O_CNTF);
    int* sh = (int*)smem;
    int* part = sh + 96;
    int* tot = part + 512;
    int* base = tot + 32;
    constexpr int NT = T / 64;
    const int e = tid & 31, pt = tid >> 5;
    { int sacc = 0; for (int tl = pt; tl < NT; tl += 16) sacc += BCNT[tl * NE + e]; part[pt * 32 + e] = sacc; }
    __syncthreads();
    if (tid < 32) { int sacc = 0; for (int q = 0; q < 16; ++q) sacc += part[q * 32 + tid]; tot[tid] = sacc; if (bidx == 0) CNTF[tid] = sacc; }
    __syncthreads();
    moe_offsets(sh, tot, tid);
    for (int ee = bidx; ee < NE; ee += gdim)
        for (int r = sh[32 + ee] + sh[ee] + tid; r < sh[64 + ee]; r += NTHREADS) ROWT[r] = 0;
    for (int tile = bidx; tile < NT; tile += gdim) {
        __syncthreads();
        { int sacc = 0; for (int tl = pt; tl < tile; tl += 16) sacc += BCNT[tl * NE + e]; part[pt * 32 + e] = sacc; }
        __syncthreads();
        if (tid < 32) { int sacc = sh[32 + tid]; for (int q = 0; q < 16; ++q) sacc += part[q * 32 + tid]; base[tid] = sacc; }
        __syncthreads();
        if (tid < 256) { const int a = tile * 256 + tid, dest = base[TOPI[a]] + RANK[a]; SLOT[a] = dest; ROWT[dest] = a >> 2; }
    }
    __syncthreads();
}

template <int WHICH>
__device__ __forceinline__ void phase_moe_gemm(const Params& P, int l, unsigned char* smem, int wv) {
    ParamsPtr pp = PARAMS_PTR(P); PIN_S(pp); unsigned char* ws = pp->ws; int bidx = (int)blockIdx.x, gdim = (int)gridDim.x; PIN_S(bidx); PIN_S(gdim);
    const int tid = phase_tid(wv);
    const int* CNT = (const int*)(ws + O_CNTF);
    int* sh = (int*)(smem + 131072);
    int* rbe = sh + 96;
    moe_offsets(sh, CNT, tid);
    const int nrb = sh[64 + NE - 1] / MOEB;
    for (int rb = tid; rb < nrb; rb += NTHREADS) rbe[rb] = moe_expert_of_row(sh, rb * MOEB);
    __syncthreads();
    pg8::MoeOrderT<WHICH == 1> S;
    S.K = 1024; S.G_ = gdim; S.c = bidx; S.rbe = rbe; S.rowmap = (const int*)(ws + O_ROWT);
    if (WHICH == 1) {
        S.A = (const char*)(ws + O_X1B); S.Wt = (const char*)(ws + O_W1) + (size_t)l * NE * 2 * DFF * D * 2; S.estride = (size_t)2 * DFF * D * 2; S.nN = 2 * DFF / 256; S.nwg = nrb * S.nN;
        pg8::EpiSwiglu E{(bf16_t*)(ws + O_ACT), pp->in[27] + (size_t)l * NE * 2 * DFF};
        pg8::gemm_phase<pg8::EpiSwiglu, pg8::MoeOrderT<WHICH == 1>>((LAS unsigned char*)smem, 1024, S, E, tid);
    } else {
        S.A = (const char*)(ws + O_ACT); S.Wt = (const char*)(ws + O_W2) + (size_t)l * NE * D * DFF * 2; S.estride = (size_t)D * DFF * 2; S.nN = D / 256; S.nwg = nrb * S.nN;
        pg8::EpiBf16Bias E{(bf16_t*)(ws + O_YS), D, pp->in[29] + (size_t)l * NE * D, D};
        pg8::gemm_phase<pg8::EpiBf16Bias, pg8::MoeOrderT<WHICH == 1>>((LAS unsigned char*)smem, 1024, S, E, tid);
    }
    __syncthreads();
}

__device__ __forceinline__ void phase_combine_ln2(const Params& P, int l, unsigned char* smem, int wv) {
    ParamsPtr pp = PARAMS_PTR(P); PIN_S(pp); unsigned char* ws = pp->ws; int bidx = (int)blockIdx.x, gdim = (int)gridDim.x; PIN_S(bidx); PIN_S(gdim);
    const bf16_t* X1 = (const bf16_t*)(ws + O_X1B); const bf16_t* YS = (const bf16_t*)(ws + O_YS); bf16_t* XB = (bf16_t*)(ws + O_XB);
    const int* SLOT = (const int*)(ws + O_SLOT); const float* TOPG = (const float*)(ws + O_TOPG);
    float* xo = pp->out;
    const float* g2 = pp->in[30] + (size_t)l * D; const float* b2 = pp->in[31] + (size_t)l * D;
    const int tid = phase_tid(wv), lane = tid & 63, wave = tid >> 6;
    const int gw = bidx * NWAVES + wave, ngw = NWAVES * gdim;
    u32x4 sl_n = (u32x4){0u, 0u, 0u, 0u}; f32x4 gg_n = (f32x4){0.f, 0.f, 0.f, 0.f};
    u32x2 xa_n[4]; u32x2 ys_n[4][4]; f32x4 gg_c = (f32x4){0.f, 0.f, 0.f, 0.f};
    const f32x4 lg[4] = {*(const f32x4*)(g2 + lane * 4), *(const f32x4*)(g2 + 256 + lane * 4), *(const f32x4*)(g2 + 512 + lane * 4), *(const f32x4*)(g2 + 768 + lane * 4)};
    const f32x4 lb[4] = {*(const f32x4*)(b2 + lane * 4), *(const f32x4*)(b2 + 256 + lane * 4), *(const f32x4*)(b2 + 512 + lane * 4), *(const f32x4*)(b2 + 768 + lane * 4)};
#define CB_META(tt_) do { sl_n = *(const u32x4*)(SLOT + (size_t)(tt_) * 4); gg_n = *(const f32x4*)(TOPG + (size_t)(tt_) * 4); } while (0)
#define CB_ROWS(tt_) do { _Pragma("unroll") for (int j = 0; j < 4; ++j) { const int c = j * 256 + lane * 4; xa_n[j] = *(const u32x2*)(X1 + (size_t)(tt_) * D + c); \
        ys_n[0][j] = *(const u32x2*)(YS + (size_t)sl_n.x * D + c); ys_n[1][j] = *(const u32x2*)(YS + (size_t)sl_n.y * D + c); ys_n[2][j] = *(const u32x2*)(YS + (size_t)sl_n.z * D + c); ys_n[3][j] = *(const u32x2*)(YS + (size_t)sl_n.w * D + c); } gg_c = gg_n; } while (0)
    if (gw < T) { CB_META(gw); CB_ROWS(gw); if (gw + ngw < T) CB_META(gw + ngw); }
    for (int t = gw; t < T; t += ngw) {
        float v[16]; float sm = 0.f;
        const float gk[4] = {gg_c.x, gg_c.y, gg_c.z, gg_c.w};
#pragma unroll
        for (int j = 0; j < 4; ++j) {
            const f32x4 a = (f32x4){bf_lo(xa_n[j].x), bf_hi(xa_n[j].x), bf_lo(xa_n[j].y), bf_hi(xa_n[j].y)};
            f32x4 y = (f32x4){0.f, 0.f, 0.f, 0.f};
#pragma unroll
            for (int k = 0; k < 4; ++k) { const u32x2 yk = ys_n[k][j]; y.x += gk[k] * bf_lo(yk.x); y.y += gk[k] * bf_hi(yk.x); y.z += gk[k] * bf_lo(yk.y); y.w += gk[k] * bf_hi(yk.y); }
            v[j * 4 + 0] = ALPHA * a.x + y.x; v[j * 4 + 1] = ALPHA * a.y + y.y; v[j * 4 + 2] = ALPHA * a.z + y.z; v[j * 4 + 3] = ALPHA * a.w + y.w;
            sm += (v[j * 4] + v[j * 4 + 1]) + (v[j * 4 + 2] + v[j * 4 + 3]);
        }
        if (t + ngw < T) { CB_ROWS(t + ngw); if (t + 2 * ngw < T) CB_META(t + 2 * ngw); }
        const float mean = wave_sum_fast(sm, lane) * (1.0f / D); float q = 0.f;
#pragma unroll
        for (int j = 0; j < 16; ++j) { const float dl = v[j] - mean; q += dl * dl; }
        const float rstd = 1.0f / sqrtf(wave_sum_fast(q, lane) * (1.0f / D) + LN_EPS);
#pragma unroll
        for (int j = 0; j < 4; ++j) {
            const int c = j * 256 + lane * 4;
            f32x4 o;
            o.x = (v[j * 4 + 0] - mean) * rstd * lg[j].x + lb[j].x; o.y = (v[j * 4 + 1] - mean) * rstd * lg[j].y + lb[j].y;
            o.z = (v[j * 4 + 2] - mean) * rstd * lg[j].z + lb[j].z; o.w = (v[j * 4 + 3] - mean) * rstd * lg[j].w + lb[j].w;
            if (l == NL - 1) *(f32x4*)(xo + (size_t)t * D + c) = o;
            else { u32x2 ob; ob.x = pk2(o.x, o.y); ob.y = pk2(o.z, o.w); *(u32x2*)(XB + (size_t)t * D + c) = ob; }
        }
    }
#undef CB_META
#undef CB_ROWS
}

__device__ __forceinline__ void phase_inproj(const Params& P, int l, unsigned char* smem, int wv) {
    ParamsPtr pp = PARAMS_PTR(P); PIN_S(pp); unsigned char* ws = pp->ws; int bidx = (int)blockIdx.x, gdim = (int)gridDim.x; PIN_S(bidx); PIN_S(gdim);
    const int tid = phase_tid(wv);
    pg8::DenseOrder S; S.init(ws + O_XB, (const bf16_t*)(ws + O_WIN) + (size_t)l * PLD * D, T, PLD, D, gdim, bidx);
    pg8::EpiProj E{(bf16_t*)(ws + O_PROJ), PLD, (float*)(ws + O_PROJG), PLD / 256 - 1};
    pg8::gemm_phase<pg8::EpiProj, pg8::DenseOrder>((LAS unsigned char*)smem, D, S, E, tid);
    __syncthreads();
}
__device__ __forceinline__ void phase_outproj(const Params& P, int l, unsigned char* smem, int wv) {
    ParamsPtr pp = PARAMS_PTR(P); PIN_S(pp); unsigned char* ws = pp->ws; int bidx = (int)blockIdx.x, gdim = (int)gridDim.x; PIN_S(bidx); PIN_S(gdim);
    const int tid = phase_tid(wv);
    pg8::DenseOrder S; S.init(ws + O_GRP, (const bf16_t*)(ws + O_WOUT) + (size_t)l * D * D, T, D, D, gdim, bidx);
    pg8::EpiProj E{(bf16_t*)(ws + O_MIX), D, nullptr, -1};
    pg8::gemm_phase<pg8::EpiProj, pg8::DenseOrder>((LAS unsigned char*)smem, D, S, E, tid);
    __syncthreads();
}

#ifndef EMU
#define XB_TMO      128
#define XB_XCNT(j)  (256  + 64 * (j))
#define XB_XSUB(j)  (1280 + 64 * (j))
#define XB_XGEN(j)  (2304 + 64 * (j))
#define XB_TOP      3328
#define XB_TOPGEN   3392
#define XCD_BAR_WORDS 3456
#define XB_SPIN_CAP (1u << 25)
__device__ __forceinline__ unsigned xb_ld(unsigned* p)              { return __hip_atomic_load(p, __ATOMIC_RELAXED, __HIP_MEMORY_SCOPE_AGENT); }
__device__ __forceinline__ unsigned xb_add(unsigned* p, unsigned v) { return __hip_atomic_fetch_add(p, v, __ATOMIC_RELAXED, __HIP_MEMORY_SCOPE_AGENT); }
__device__ __forceinline__ unsigned xb_xcc_id() { return (unsigned)__builtin_amdgcn_s_getreg((3 << 11) | 20) & 0xFu; }
#define XB_SPIN(cond, bar) do { unsigned _sp = 0; while (cond) { __builtin_amdgcn_s_sleep(1); \
    if ((++_sp & 255u) == 0u) { if (xb_ld(&(bar)[XB_TMO])) break; if (_sp > XB_SPIN_CAP) { atomicAdd(&(bar)[XB_TMO], 1u); break; } } } } while (0)
struct XcdBarrier { unsigned* bar; unsigned x; volatile LAS unsigned* st; };
__device__ __forceinline__ XcdBarrier xcd_barrier_post(unsigned* bar, volatile LAS unsigned* st) {
    XcdBarrier b; b.bar = bar; b.x = xb_xcc_id(); b.st = st;
    if (threadIdx.x == 0) (void)xb_add(&bar[XB_XCNT(b.x)], 1u);
    return b;
}
__device__ __forceinline__ void xcd_barrier_complete(unsigned* bar, unsigned x, unsigned& nloc, unsigned& nx) {
    const unsigned G = gridDim.x * gridDim.y * gridDim.z;
    unsigned sum, cnt, mine, sp = 0u;
    for (;;) {
        sum = 0u; cnt = 0u; mine = 0u;
#pragma unroll
        for (unsigned j = 0; j < 16; ++j) { const unsigned c = xb_ld(&bar[XB_XCNT(j)]); sum += c; cnt += (c > 0u) ? 1u : 0u; mine = (j == x) ? c : mine; }
        if (sum == G) break;
        __builtin_amdgcn_s_sleep(1);
        if ((++sp & 255u) == 0u) { if (xb_ld(&bar[XB_TMO])) break; if (sp > XB_SPIN_CAP) { atomicAdd(&bar[XB_TMO], 1u); break; } }
    }
    nloc = mine > 0u ? mine : 1u; nx = cnt > 0u ? cnt : 1u;
}
__device__ __forceinline__ void xcd_barrier(const XcdBarrier& b) {
    asm volatile("s_waitcnt vmcnt(0)" ::: "memory");
    __syncthreads();
    if (threadIdx.x == 0) {
        unsigned* bar = b.bar;
        __builtin_amdgcn_s_waitcnt(0);
        unsigned nloc = b.st[0], nx = b.st[1];
        if (nloc == 0u) { xcd_barrier_complete(bar, b.x, nloc, nx); b.st[0] = nloc; b.st[1] = nx; }
        const unsigned old = xb_add(&bar[XB_XSUB(b.x)], 1u);
        const unsigned gen = old / nloc;
        if (old + 1u == (gen + 1u) * nloc) {
            __builtin_amdgcn_fence(__ATOMIC_RELEASE, "agent");
            asm volatile("s_waitcnt vmcnt(0)" ::: "memory");
            const unsigned og = xb_add(&bar[XB_TOP], 1u);
            const unsigned tg = og / nx;
            if (og + 1u == (tg + 1u) * nx) xb_add(&bar[XB_TOPGEN], 1u);
            else XB_SPIN(xb_ld(&bar[XB_TOPGEN]) == tg, bar);
            __builtin_amdgcn_fence(__ATOMIC_ACQUIRE, "agent");
            xb_add(&bar[XB_XGEN(b.x)], 1u);
            asm volatile("s_waitcnt vmcnt(0)" ::: "memory");
        } else {
            XB_SPIN(xb_ld(&bar[XB_XGEN(b.x)]) == gen, bar);
            __builtin_amdgcn_fence(__ATOMIC_ACQUIRE, "agent");
            asm volatile("s_waitcnt vmcnt(0)" ::: "memory");
        }
    }
    __syncthreads();
}
#endif

__global__ void __launch_bounds__(512, 2) mk_fwd(Params P) {
#ifdef EMU
    unsigned char* smem = g_blk->lds;
#else
    extern __shared__ __attribute__((aligned(16))) unsigned char smem[];
    volatile LAS unsigned* bst = (volatile LAS unsigned*)(smem + LDS_BYTES - 16);
    if (threadIdx.x == 0) { bst[0] = 0u; bst[1] = 0u; bst[2] = 0u; bst[3] = 0u; }
    __syncthreads();
    XcdBarrier bar; bar.bar = (unsigned*)P.ws + CW_BAR; bar.x = 0; bar.st = bst;
    if (P.ph_hi - P.ph_lo > 1) bar = xcd_barrier_post((unsigned*)P.ws + CW_BAR, bst);
#endif
    const int lo = P.ph_lo, hi = P.ph_hi;
#ifdef EMU
    const int wv = (int)threadIdx.x >> 6;
#else
    const int wv = RFL((int)threadIdx.x >> 6);
#endif
#ifdef EMU
#define SEAM(id) do {} while (0)
#else
#define SEAM(id) do { if ((id) + 1 < hi) xcd_barrier(bar); } while (0)
#endif
#ifndef MK_ONLY_PHASE
#define MK_ONLY_PHASE -1
#endif
#ifndef MK_DUP_MASK
#define MK_DUP_MASK 0
#endif
#define PHG(kc, id, ...) do { if (MK_ONLY_PHASE < 0 || MK_ONLY_PHASE == (kc)) { const int id_ = (id); if (id_ >= lo && id_ < hi) { if ((MK_DUP_MASK >> (kc)) & 1) { __VA_ARGS__; SEAM(id_ - 1); } __VA_ARGS__; SEAM(id_); } } } while (0)
#define PH(k, ...) PHG(1 + (k), 1 + l * NPH + (k), __VA_ARGS__)
    PHG(0, 0, phase_prologue(P, smem, wv));
    for (int l = 0; l < NL; ++l) {
        PH(0, phase_inproj(P, l, smem, wv));
#if MK_RWKV_CHUNKED
        PH(1, phase_prep32(P, l, smem, wv));
#else
        PH(1, phase_prep(P, l, smem, wv));
#endif
#if MK_RWKV_CHUNKED
        PH(2, { phase_rwkv_pre(P, l, smem, wv); phase_mlstm_local(P, l, smem, wv, (int)blockIdx.x, (int)gridDim.x); if (MK_PROBE == 42) phase_mlstm_local(P, l, smem, wv, (int)blockIdx.x, (int)gridDim.x); });
        PH(3, { const int G_ = (int)gridDim.x;
                if (G_ >= 2 * RSEQ_WGS) { if ((int)blockIdx.x < RSEQ_WGS) { phase_rwkv_seq(P, l, smem, wv); if (MK_PROBE >= 30 && MK_PROBE < 38) phase_rwkv_seq<MK_PROBE >= 30 && MK_PROBE < 38 ? MK_PROBE - 30 : 0>(P, l, smem, wv); }
                                           else { phase_mlstm_carry(P, l, smem, wv, (int)blockIdx.x - RSEQ_WGS, G_ - RSEQ_WGS); phase_gmlp_mix(P, l, smem, wv, (int)blockIdx.x - RSEQ_WGS, G_ - RSEQ_WGS);
                                                  if (MK_PROBE == 39) phase_gmlp_mix(P, l, smem, wv, (int)blockIdx.x - RSEQ_WGS, G_ - RSEQ_WGS); } }
                else { phase_rwkv_seq(P, l, smem, wv); phase_mlstm_carry(P, l, smem, wv, (int)blockIdx.x, G_); } });
        PH(4, { phase_rwkv_out(P, l, smem, wv); if (MK_PROBE == 40) phase_rwkv_out(P, l, smem, wv); phase_mlstm_out(P, l, smem, wv); if (MK_PROBE == 41) phase_mlstm_out(P, l, smem, wv); if ((int)gridDim.x < 2 * RSEQ_WGS) phase_gmlp_mix(P, l, smem, wv, (int)blockIdx.x, (int)gridDim.x); });
#else
        PH(2, { const int G_ = (int)gridDim.x, NSC = 2 * NB * RH * 4;
                if (G_ >= NSC + 32) { if ((int)blockIdx.x < NSC) phase_rwkv_scan(P, l, smem, wv, (int)blockIdx.x, NSC);
                                      else phase_mlstm_local(P, l, smem, wv, (int)blockIdx.x - NSC, G_ - NSC); }
                else { phase_rwkv_scan(P, l, smem, wv, (int)blockIdx.x, G_); phase_mlstm_local(P, l, smem, wv, (int)blockIdx.x, G_); } });
        PH(3, phase_mlstm_carry(P, l, smem, wv, (int)blockIdx.x, (int)gridDim.x));
        PH(4, { phase_mlstm_out(P, l, smem, wv); phase_gmlp_mix(P, l, smem, wv, (int)blockIdx.x, (int)gridDim.x); phase_rwkv_post(P, l, smem, wv); });
#endif
        PH(5, phase_outproj(P, l, smem, wv));
        PH(6, phase_ln1_router(P, l, smem, wv));
        PH(7, phase_scatter(P, l, smem, wv));
        PH(8, phase_moe_gemm<1>(P, l, smem, wv));
        PH(9, phase_moe_gemm<2>(P, l, smem, wv));
        PH(10, phase_combine_ln2(P, l, smem, wv));
    }
#undef PHG
#undef PH
#undef SEAM
}

}

#ifndef EMU
extern "C" void kernel_launch(void* const* d_in, const int* in_sizes, int n_in, void* d_out, int out_size, void* d_ws, size_t ws_size, hipStream_t stream) {
    using namespace mk;
    static int grid = 0;
    if (grid == 0) {
        if (n_in != 32 || out_size != T * D || ws_size < WS_END) { fprintf(stderr, "kernel_launch: unexpected shapes (n_in %d out %d ws %zu need %zu)\n", n_in, out_size, ws_size, (size_t)WS_END); grid = -1; return; }
        int dev = 0, cus = 0;
        if (hipGetDevice(&dev) != hipSuccess || hipDeviceGetAttribute(&cus, hipDeviceAttributeMultiprocessorCount, dev) != hipSuccess) { grid = -1; return; }
        if (hipFuncSetAttribute((const void*)mk_fwd, hipFuncAttributeMaxDynamicSharedMemorySize, LDS_BYTES) != hipSuccess) { fprintf(stderr, "kernel_launch: hipFuncSetAttribute failed\n"); grid = -1; return; }
        int per_cu = 0;
        (void)hipOccupancyMaxActiveBlocksPerMultiprocessor(&per_cu, (const void*)mk_fwd, NTHREADS, LDS_BYTES);
        (void)hipGetLastError();
        grid = cus;
    }
    if (grid < 0) return;
    (void)hipMemsetAsync(d_ws, 0, CTL_BYTES, stream);
    Params p{};
    for (int i = 0; i < 32; ++i) p.in[i] = (const float*)d_in[i];
    p.out = (float*)d_out; p.ws = (unsigned char*)d_ws;
#if MK_ONE_LAUNCH
    p.ph_lo = 0; p.ph_hi = 1 + NL * NPH;
    hipLaunchKernelGGL(mk_fwd, dim3(grid), dim3(NTHREADS), LDS_BYTES, stream, p);
#else
    for (int id = 0; id < 1 + NL * NPH; ++id) {
        p.ph_lo = id; p.ph_hi = id + 1;
        hipLaunchKernelGGL(mk_fwd, dim3(grid), dim3(NTHREADS), LDS_BYTES, stream, p);
    }
#endif
}
#endif
```

```cpp
#ifndef EMU
#include <hip/hip_runtime.h>
#endif
#include <cstdio>
#include <cstdint>
#include <cmath>

#ifndef CFG_BATCH
#define CFG_BATCH 4
#endif
#ifndef CFG_SEQ
#define CFG_SEQ 4096
#endif
#ifndef CFG_LAYERS
#define CFG_LAYERS 4
#endif
#ifndef MK_RWKV_CHUNKED
#define MK_RWKV_CHUNKED 1
#endif
#ifndef MK_PROBE
#define MK_PROBE 0
#endif
#ifndef MK_SP2
#define MK_SP2 1
#endif
#ifndef MK_ONE_LAUNCH
#define MK_ONE_LAUNCH 1
#endif

namespace mk {
constexpr int NB = CFG_BATCH, S = CFG_SEQ, T = NB * S, NL = CFG_LAYERS, D = 1024;
constexpr int GW = 256, RW = 384, MW = 384, HD = 64, GH = 4, RH = 6, MH = 6, CH = 128, NCH = S / CH;
constexpr int PIN = 3480, PLD = 3584, RPROJ = 1408;
constexpr int C_RW = 512, C_MW = 1920;
constexpr int NE = 32, TOPK = 4, DFF = 1024, MOEB = 256;
constexpr int NROWS = (T * TOPK / MOEB + NE) * MOEB;
constexpr float LN_EPS = 1e-5f, GN_EPS = 64e-5f;
constexpr float ALPHA = 1.6817928305074290f;
constexpr int NTHREADS = 512, NWAVES = 8;
constexpr int LDS_BYTES = 160 * 1024;
constexpr int NPH = 11;

typedef float f32x4 __attribute__((ext_vector_type(4)));
typedef unsigned u32x4 __attribute__((ext_vector_type(4)));
typedef unsigned u32x2 __attribute__((ext_vector_type(2)));
typedef short bf16x8 __attribute__((ext_vector_type(8)));
typedef unsigned short bf16_t;

constexpr size_t al(size_t x) { return (x + 255) & ~(size_t)255; }
constexpr size_t CTL_BYTES = 1u << 20;
constexpr size_t O_XA = CTL_BYTES;
constexpr size_t O_CLB = O_XA;
constexpr size_t O_XB = O_XA + al((size_t)T * D * 4);
constexpr size_t O_X1 = O_XB + al((size_t)T * D * 2);
constexpr size_t O_X1B = O_X1 + al((size_t)T * D * 4);
constexpr size_t O_PROJ = O_X1B + al((size_t)T * D * 2);
constexpr size_t O_PROJG = O_PROJ + al((size_t)T * PLD * 2);
constexpr size_t O_MIX = O_PROJ + al((size_t)T * PLD * 4);
constexpr size_t O_GRP = O_MIX + al((size_t)T * D * 4);
constexpr size_t O_UG = O_GRP + al((size_t)T * D * 2);
constexpr size_t O_VN = O_UG + al((size_t)T * GW * 4);
constexpr size_t O_RR = O_VN + al((size_t)T * GW * 4);
constexpr size_t O_VV = O_RR + al((size_t)T * RW * 4);
constexpr size_t O_KK = O_VV + al((size_t)T * RW * 4);
constexpr size_t O_DEC = O_KK + al((size_t)T * RW * 4);
constexpr size_t O_KD = O_DEC + al((size_t)2 * T * RW * 4);
constexpr size_t O_ICLR = O_KD + al((size_t)2 * T * RW * 4);
constexpr size_t O_GATE = O_ICLR + al((size_t)2 * T * RW * 4);
constexpr size_t O_BONUS = O_GATE + al((size_t)T * RW * 4);
constexpr size_t O_SCAN = O_BONUS + al((size_t)T * RH * 4);
constexpr size_t O_MQ = O_SCAN + al((size_t)2 * T * RW * 4);
constexpr size_t O_MK = O_MQ + al((size_t)T * MW * 4);
constexpr size_t O_IG = O_MK + al((size_t)T * MW * 4);
constexpr size_t O_LF = O_IG + al((size_t)2 * T * MH * 4);
constexpr size_t O_CL = O_LF + al((size_t)2 * T * MH * 4);
constexpr size_t O_NL = O_CL + al((size_t)2 * NB * MH * NCH * 4096 * 4);
constexpr size_t O_ML = O_NL + al((size_t)2 * NB * MH * NCH * 64 * 4);
constexpr size_t O_BL = O_ML + al((size_t)2 * NB * MH * NCH * 4);
constexpr size_t O_MIN = O_BL + al((size_t)2 * NB * MH * NCH * 4);
constexpr size_t O_TOPI = O_MIN + al((size_t)2 * NB * MH * NCH * 4);
constexpr size_t O_TOPG = O_TOPI + al((size_t)T * 4 * 4);
constexpr size_t O_RANK = O_TOPG + al((size_t)T * 4 * 4);
constexpr size_t O_SLOT = O_RANK + al((size_t)T * 4 * 4);
constexpr size_t O_MQB = O_SLOT + al((size_t)T * 4 * 4);
constexpr size_t O_MKB = O_MQB + al((size_t)T * MW * 2);
constexpr size_t O_KT = O_MKB + al((size_t)T * MW * 2);
constexpr size_t O_VT = O_KT + al((size_t)T * MW * 2);
constexpr size_t O_GVT = O_VT + al((size_t)T * MW * 2);
constexpr size_t O_PMX = O_GVT + al((size_t)2 * T * MH * 4);
constexpr size_t O_BCT = O_PMX + al((size_t)2 * T * MH * 4);
constexpr size_t O_BRKR = O_BCT + al((size_t)2 * T * MH * 4);
constexpr int RC = 64, RNC = S / RC, RUN = 2 * NB * RH * RNC;
constexpr size_t O_LW = O_BRKR + al((size_t)2 * T * RH * 2 * 4);
constexpr size_t O_RQ = O_LW + al((size_t)2 * T * RW * 4);
constexpr size_t O_RA = O_RQ + al((size_t)RUN * 4096 * 2);
constexpr size_t O_RS = O_RA + al((size_t)RUN * 4096 * 2);
constexpr size_t O_RH = O_RS + al((size_t)RUN * 4096 * 2);
constexpr size_t O_RG = O_RH + al((size_t)RUN * 4096 * 4);
constexpr size_t O_RB = O_RG + al((size_t)RUN * 4096 * 4);
constexpr size_t O_VB = O_RB + al((size_t)T * RW * 2);
constexpr size_t O_KKB = O_VB + al((size_t)T * RW * 2);
constexpr size_t O_BBB = O_KKB + al((size_t)T * RW * 2);
constexpr size_t O_KDB = O_BBB + al((size_t)2 * T * RW * 2);
constexpr size_t O_RK7 = O_KDB + al((size_t)2 * T * RW * 2);
constexpr size_t O_VNT = O_RK7 + al((size_t)T * RW * 16);
constexpr size_t O_WSB = O_VNT + al((size_t)T * GW * 2);
constexpr size_t O_LWT = O_WSB + al((size_t)NL * GH * CH * CH * 2);
constexpr size_t O_RWT = O_LWT + al((size_t)NL * 1920 * 128 * 2);
constexpr size_t O_BCNT = O_RWT + al((size_t)NL * 2 * NE * D * 2);
constexpr size_t O_CNTF = O_BCNT + al((size_t)(T / 64) * NE * 4);
constexpr size_t O_ROWT = O_CNTF + al((size_t)NE * 4);
constexpr size_t O_XS = O_ROWT + al((size_t)NROWS * 4);
constexpr size_t O_ACT = O_XS + al((size_t)NROWS * D * 2);
constexpr size_t O_YS = O_ACT + al((size_t)NROWS * DFF * 2);
constexpr size_t O_WIN = O_YS + al((size_t)NROWS * D * 2);
constexpr size_t O_WOUT = O_WIN + al((size_t)NL * PLD * D * 2);
constexpr size_t O_W1 = O_WOUT + al((size_t)NL * D * D * 2);
constexpr size_t O_W2 = O_W1 + al((size_t)NL * NE * 2 * DFF * D * 2);
constexpr size_t WS_END = O_W2 + al((size_t)NL * NE * D * DFF * 2);

constexpr int CW_BAR = 4096;
constexpr int CW_CNT = 16384;

struct Params { const float* in[32]; float* out; unsigned char* ws; int ph_lo, ph_hi; };
#ifdef EMU
typedef const Params* ParamsPtr;
#define PARAMS_PTR(P) (&(P))
#else
typedef const __attribute__((address_space(4))) Params* ParamsPtr;
#define PARAMS_PTR(P) ((ParamsPtr)__builtin_amdgcn_kernarg_segment_ptr())
#endif

#ifdef EMU
#define WAVE_SYNC() emu_wave_barrier()
#define PIN_V(x) do {} while (0)
#define PIN_S(x) do {} while (0)
#else
#define WAVE_SYNC() __builtin_amdgcn_wave_barrier()
#define PIN_V(x) asm volatile("" : "+v"(x))
#define PIN_S(x) asm volatile("" : "+s"(x))
#endif
#ifdef EMU
__device__ __forceinline__ int phase_tid(int wv) { (void)wv; return threadIdx.x; }
#else
__device__ __forceinline__ int phase_tid(int wv) { int t; asm volatile("v_mbcnt_lo_u32_b32 %0, -1, 0\n\tv_mbcnt_hi_u32_b32 %0, -1, %0" : "=v"(t)); return (wv << 6) + t; }
#endif

#ifdef EMU
#define SHX(v, m, lane) __shfl_xor(v, m)
#else
__device__ __forceinline__ float shx_(float v, int m, int lane) { return __builtin_bit_cast(float, __builtin_amdgcn_ds_bpermute((lane ^ m) << 2, __builtin_bit_cast(int, v))); }
__device__ __forceinline__ int shx_(int v, int m, int lane) { return __builtin_amdgcn_ds_bpermute((lane ^ m) << 2, v); }
#define SHX(v, m, lane) shx_(v, m, lane)
#endif
#ifdef EMU
#define SHUP(v, o, lane) __shfl(v, ((lane) - (o)) & 63)
#define RDL(v, src) __shfl(v, src)
#define SHL(v, src) __shfl(v, src)
#else
#define SHL(v, src) __builtin_bit_cast(float, __builtin_amdgcn_ds_bpermute((src) << 2, __builtin_bit_cast(int, (float)(v))))
#define SHUP(v, o, lane) __builtin_bit_cast(float, __builtin_amdgcn_ds_bpermute((((lane) - (o)) & 63) << 2, __builtin_bit_cast(int, (float)(v))))
#define RDL(v, src) __builtin_bit_cast(float, __builtin_amdgcn_readlane(__builtin_bit_cast(int, (float)(v)), src))
#endif
__device__ __forceinline__ float wave_sum(float v, int lane) {
#pragma unroll
    for (int o = 32; o >= 1; o >>= 1) v += SHX(v, o, lane);
    return v;
}
#ifdef EMU
__device__ __forceinline__ float fexp(float x) { return expf(x); }
__device__ __forceinline__ float flog(float x) { return logf(x); }
__device__ __forceinline__ float frcp(float x) { return 1.0f / x; }
#else
__device__ __forceinline__ float fexp(float x) { return __builtin_amdgcn_exp2f(x * 1.4426950408889634f); }
__device__ __forceinline__ float flog(float x) { return __builtin_amdgcn_logf(x) * 0.6931471805599453f; }
__device__ __forceinline__ float frcp(float x) { return __builtin_amdgcn_rcpf(x); }
#endif
__device__ __forceinline__ float sigmoidf_(float x) { return frcp(1.0f + fexp(-x)); }
__device__ __forceinline__ float softplusf_(float x) { return fmaxf(x, 0.f) + flog(1.0f + fexp(-fabsf(x))); }
__device__ __forceinline__ float ftanh(float x) { return 1.0f - 2.0f * frcp(1.0f + fexp(2.0f * x)); }
__device__ __forceinline__ float geluf_(float v) {
    const float av = fabsf(v), t = frcp(1.0f + 0.2316418882f * av);
    float q = t * 0.5307027145f + (-0.7265760135f); q = q * t + 0.7107068705f; q = q * t + (-0.142248368f); q = q * t + 0.127414796f; q = q * t;
    const float m = v * (q * fexp(-0.5f * v * v));
    return v < 0.f ? m : v - m;
}

#ifdef EMU
#define LAS
#define WAIT_V(n) do {} while (0)
#define WAIT_L(n) do {} while (0)
#define S_BARRIER() __syncthreads()
#define SETPRIO(x) do {} while (0)
#define SCHED_BAR() do {} while (0)
#define RFL(x) (x)
static inline void emu_glds16(const void* g, void* l) { memcpy((char*)l + (g_blk->cur & 63) * 16, g, 16); }
#define GLDS16(gptr, ldsptr) emu_glds16((const void*)(gptr), (void*)(ldsptr))
static inline float emu_bf2f(unsigned short b) { unsigned u = (unsigned)b << 16; float f; memcpy(&f, &u, 4); return f; }
static inline f32x4 emu_mfma16(bf16x8 a, bf16x8 b, f32x4 c) {
    EmuBlock* blk = g_blk; const int cur = blk->cur, lane = cur & 63, wbase = cur & ~63;
    static thread_local unsigned short Ash[32][64][8], Bsh[32][64][8];
    const int w = cur >> 6;
    for (int j = 0; j < 8; ++j) { Ash[w][lane][j] = (unsigned short)a[j]; Bsh[w][lane][j] = (unsigned short)b[j]; }
    emu_wave_barrier();
    const int col = lane & 15;
    for (int r = 0; r < 4; ++r) { const int row = 4 * (lane >> 4) + r; float sum = c[r];
        for (int k = 0; k < 32; ++k) sum += emu_bf2f(Ash[w][row + 16 * (k >> 3)][k & 7]) * emu_bf2f(Bsh[w][col + 16 * (k >> 3)][k & 7]);
        c[r] = sum; }
    emu_wave_barrier(); (void)wbase;
    return c;
}
#define MFMA16(a, b, c) emu_mfma16(a, b, c)
#else
#define LAS __attribute__((address_space(3)))
#define WAIT_V(n) asm volatile("s_waitcnt vmcnt(" #n ")" ::: "memory")
#define WAIT_L(n) asm volatile("s_waitcnt lgkmcnt(" #n ")" ::: "memory")
#define S_BARRIER() __builtin_amdgcn_s_barrier()
#define SETPRIO(x) __builtin_amdgcn_s_setprio(x)
#define SCHED_BAR() __builtin_amdgcn_sched_barrier(0)
#define RFL(x) __builtin_amdgcn_readfirstlane(x)
#define GLDS16(gptr, ldsptr) __builtin_amdgcn_global_load_lds((const unsigned*)(gptr), (LAS unsigned*)(ldsptr), 16, 0, 0)
#define MFMA16(a, b, c) __builtin_amdgcn_mfma_f32_16x16x32_bf16(a, b, c, 0, 0, 0)
#endif

#ifdef EMU
__device__ __forceinline__ unsigned f2bf(float f) { unsigned u = __builtin_bit_cast(unsigned, f); return (u + 0x7fffu + ((u >> 16) & 1u)) >> 16; }
#else
__device__ __forceinline__ unsigned f2bf(float f) { return (unsigned)__builtin_bit_cast(unsigned short, (__bf16)f); }
#endif
#ifdef EMU
__device__ __forceinline__ unsigned pk2(float lo, float hi) { return f2bf(lo) | (f2bf(hi) << 16); }
#else
typedef float f32x2c __attribute__((ext_vector_type(2)));
typedef __bf16 bf16x2c __attribute__((ext_vector_type(2)));
__device__ __forceinline__ unsigned pk2(float lo, float hi) { const f32x2c v = {lo, hi}; return __builtin_bit_cast(unsigned, __builtin_convertvector(v, bf16x2c)); }
#endif
__device__ __forceinline__ bf16x8 cvt8(const f32x4 a, const f32x4 b) {
    u32x4 w; w.x = pk2(a.x, a.y); w.y = pk2(a.z, a.w); w.z = pk2(b.x, b.y); w.w = pk2(b.z, b.w); return __builtin_bit_cast(bf16x8, w);
}
__device__ __forceinline__ float bf_lo(unsigned u) { return __builtin_bit_cast(float, u << 16); }
__device__ __forceinline__ float bf_hi(unsigned u) { return __builtin_bit_cast(float, u & 0xffff0000u); }

namespace pg8 {
constexpr int BM = 256, BK = 64, HALF = 128, HTB = HALF * BK * 2, STAGE_BYTES = 8 * HTB, NXCD = 8, WGM = 8;
__host__ __device__ __forceinline__ int lds_byte(int r, int c) { const int st = (r >> 4) * 2 + (c >> 5), rr = r & 15, cc = c & 31, ob = rr * 64 + cc * 2; return st * 1024 + (ob ^ (((ob >> 9) & 1) << 5)); }
__host__ __device__ __forceinline__ void stage_rc(int b, int& R, int& C) { const int st = b / 1024, sb = b % 1024, swz = sb ^ (((sb >> 9) & 1) << 5); R = (st >> 1) * 16 + swz / 64; C = (st & 1) * 32 + (swz % 64) / 2; }
__host__ __device__ __forceinline__ int perm32(int rho) { const int n = rho >> 4, i = rho & 15; return 8 * (i >> 2) + 4 * n + (i & 3); }
struct Unit { int pm, pn, e; };

struct DenseOrder {
    static constexpr bool GATHER = false;
    const char* A; const char* Bt; int K; int nM, nN, nwg, G, c;
    __device__ __forceinline__ void init(const void* A_, const void* Bt_, int M, int N, int K_, int G_, int c_) { A = (const char*)A_; Bt = (const char*)Bt_; K = K_; nM = M / BM; nN = N / BM; nwg = nM * nN; G = G_; c = c_; }
    __device__ __forceinline__ bool next(int i, Unit& u) const {
        const long L = (long)i * G + c; if (L >= nwg) return false;
        int wgid = (int)L; { const int q = nwg / NXCD, r = nwg % NXCD, xcd = wgid % NXCD, off = wgid / NXCD; wgid = (xcd < r ? xcd * (q + 1) : r * (q + 1) + (xcd - r) * q) + off; }
        const int nig = WGM * nN, gid = wgid / nig, fm = gid * WGM, gsz = (nM - fm) < WGM ? (nM - fm) : WGM;
        u.pm = fm + ((wgid % nig) % gsz); u.pn = (wgid % nig) / gsz; u.e = 0; return true;
    }
    __device__ __forceinline__ const char* abase(const Unit& u) const { return A + (size_t)u.pm * BM * K * 2; }
    __device__ __forceinline__ const char* bbase(const Unit& u) const { return Bt + (size_t)u.pn * BM * K * 2; }
};
template <bool G>
struct MoeOrderT {
    static constexpr bool GATHER = G;
    const char* A; const char* Wt; int K; int nN, nwg, G_, c; size_t estride; const int* rbe; const int* rowmap;
    __device__ __forceinline__ bool next(int i, Unit& u) const {
        const long L = (long)i * G_ + c; if (L >= nwg) return false;
        u.pm = (int)(L / nN); u.pn = (int)(L % nN); u.e = rbe[u.pm]; return true;
    }
    __device__ __forceinline__ const char* abase(const Unit& u) const { return G ? A : A + (size_t)u.pm * BM * K * 2; }
    __device__ __forceinline__ const char* bbase(const Unit& u) const { return Wt + (size_t)u.e * estride + (size_t)u.pn * BM * K * 2; }
};
struct EpiF32 {
    static constexpr bool PERM = false;
    float* C; int ldc;
    __device__ __forceinline__ void operator()(const f32x4 (&acc)[2][2][4][2], const Unit& u, int wr, int wc, int fr, int fq) const {
        const int row0 = u.pm * BM + wr * 64 + fr, col0 = u.pn * BM + wc * 32 + 4 * fq;
#pragma unroll
        for (int ai = 0; ai < 2; ++ai)
#pragma unroll
            for (int m = 0; m < 4; ++m) { float* rowp = C + (size_t)(row0 + ai * HALF + m * 16) * ldc + col0;
#pragma unroll
                for (int bj = 0; bj < 2; ++bj)
#pragma unroll
                    for (int n = 0; n < 2; ++n) *(f32x4*)(rowp + bj * HALF + n * 16) = acc[ai][bj][m][n]; }
    }
};
struct EpiProj {
    static constexpr bool PERM = true;
    bf16_t* O; int ldc; float* G; int lastt;
    __device__ __forceinline__ void operator()(const f32x4 (&acc)[2][2][4][2], const Unit& u, int wr, int wc, int fr, int fq) const {
        const int row0 = u.pm * BM + wr * 64 + fr, col0 = u.pn * BM + wc * 32 + 8 * fq;
#pragma unroll
        for (int ai = 0; ai < 2; ++ai)
#pragma unroll
            for (int m = 0; m < 4; ++m) { bf16_t* rowp = O + (size_t)(row0 + ai * HALF + m * 16) * ldc + col0;
#pragma unroll
                for (int bj = 0; bj < 2; ++bj) { const f32x4 v0 = acc[ai][bj][m][0], v1 = acc[ai][bj][m][1];
                    u32x4 w; w.x = pk2(v0[0], v0[1]); w.y = pk2(v0[2], v0[3]); w.z = pk2(v1[0], v1[1]); w.w = pk2(v1[2], v1[3]);
                    *(u32x4*)(rowp + bj * HALF) = w; } }
        if (u.pn == lastt) {
#pragma unroll
            for (int ai = 0; ai < 2; ++ai)
#pragma unroll
                for (int m = 0; m < 4; ++m) { float* rowp = G + (size_t)(row0 + ai * HALF + m * 16) * BM + wc * 32 + 8 * fq;
#pragma unroll
                    for (int bj = 0; bj < 2; ++bj) { *(f32x4*)(rowp + bj * HALF) = acc[ai][bj][m][0]; *(f32x4*)(rowp + bj * HALF + 4) = acc[ai][bj][m][1]; } }
        }
    }
};
struct EpiBf16Bias {
    static constexpr bool PERM = true;
    bf16_t* O; int ldc; const float* bias; int bias_estride;
    __device__ __forceinline__ void operator()(const f32x4 (&acc)[2][2][4][2], const Unit& u, int wr, int wc, int fr, int fq) const {
        const int row0 = u.pm * BM + wr * 64 + fr, col0 = u.pn * BM + wc * 32 + 8 * fq;
        const float* bp = bias + (size_t)u.e * bias_estride + col0;
        f32x4 bv[2][2];
#pragma unroll
        for (int bj = 0; bj < 2; ++bj)
#pragma unroll
            for (int n = 0; n < 2; ++n) bv[bj][n] = *(const f32x4*)(bp + bj * HALF + 4 * n);
#pragma unroll
        for (int ai = 0; ai < 2; ++ai)
#pragma unroll
            for (int m = 0; m < 4; ++m) { bf16_t* rowp = O + (size_t)(row0 + ai * HALF + m * 16) * ldc + col0;
#pragma unroll
                for (int bj = 0; bj < 2; ++bj) { const f32x4 v0 = acc[ai][bj][m][0] + bv[bj][0], v1 = acc[ai][bj][m][1] + bv[bj][1];
                    u32x4 w; w.x = pk2(v0[0], v0[1]); w.y = pk2(v0[2], v0[3]); w.z = pk2(v1[0], v1[1]); w.w = pk2(v1[2], v1[3]);
                    *(u32x4*)(rowp + bj * HALF) = w; } }
    }
};
__device__ __forceinline__ float swiglu1(float g, float uu) { g = fminf(g, 7.0f); uu = fminf(fmaxf(uu, -7.0f), 7.0f); return (uu + 1.0f) * (g * frcp(1.0f + fexp(-1.702f * g))); }
struct EpiSwiglu {
    static constexpr bool PERM = true;
    bf16_t* O; const float* b1;
    __device__ __forceinline__ void operator()(const f32x4 (&acc)[2][2][4][2], const Unit& u, int wr, int wc, int fr, int fq) const {
        const int row0 = u.pm * BM + wr * 64 + fr, j0 = u.pn * HALF + wc * 32 + 8 * fq;
        const float* bg = b1 + (size_t)u.e * 2 * DFF + j0; const float* bu = bg + DFF;
        f32x4 g4[2], u4[2];
#pragma unroll
        for (int n = 0; n < 2; ++n) { g4[n] = *(const f32x4*)(bg + 4 * n); u4[n] = *(const f32x4*)(bu + 4 * n); }
#pragma unroll
        for (int ai = 0; ai < 2; ++ai)
#pragma unroll
            for (int m = 0; m < 4; ++m) {
                float o[8];
#pragma unroll
                for (int n = 0; n < 2; ++n)
#pragma unroll
                    for (int q = 0; q < 4; ++q) o[n * 4 + q] = swiglu1(acc[ai][0][m][n][q] + g4[n][q], acc[ai][1][m][n][q] + u4[n][q]);
                u32x4 w; w.x = pk2(o[0], o[1]); w.y = pk2(o[2], o[3]); w.z = pk2(o[4], o[5]); w.w = pk2(o[6], o[7]);
                *(u32x4*)(O + (size_t)(row0 + ai * HALF + m * 16) * DFF + j0) = w;
            }
    }
};

template <class Epi, class Sched, bool SP2 = (MK_SP2 != 0)>
__device__ __forceinline__ void gemm_phase(LAS unsigned char* lds, const int K, const Sched& S, const Epi& E, const int tid) {
    const int wid = RFL(tid >> 6), lane = tid & 63, wr = wid >> 2, wc = wid & 3, fr = lane & 15, fq = lane >> 4;
    const int nt = K / BK;
    unsigned voffA[2], voffB[2]; int gR[2]; unsigned gC[2];
#pragma unroll
    for (int i = 0; i < 2; ++i) { int R, C; stage_rc(tid * 16 + i * 8192, R, C); const int Rb = Epi::PERM ? ((R & ~31) + perm32(R & 31)) : R;
        voffA[i] = (unsigned)(R * K + C) * 2u; voffB[i] = (unsigned)(Rb * K + C) * 2u; gR[i] = R; gC[i] = (unsigned)C * 2u; }
    unsigned va[2][2], vn[2][2];
#define PG8_GOFF(dst, unit) do { if constexpr (Sched::GATHER) { _Pragma("unroll") for (int h_ = 0; h_ < 2; ++h_) _Pragma("unroll") for (int i_ = 0; i_ < 2; ++i_) \
        dst[h_][i_] = (unsigned)S.rowmap[(unit).pm * BM + h_ * HALF + gR[i_]] * (unsigned)(K * 2) + gC[i_]; } } while (0)
#define PG8_STAGE_A(bufoff, bp, kb, h, nx) do { if constexpr (Sched::GATHER) { const char* gb_ = S.A + (kb); _Pragma("unroll") for (int _i = 0; _i < 2; ++_i) \
        GLDS16(gb_ + ((nx) ? vn[h][_i] : va[h][_i]), lds + (bufoff) + ldsw + _i * 8192); } else { PG8_STAGE(bufoff, bp, voffA); } } while (0)
    const size_t kstep = (size_t)(BK * 2);
    const size_t hstep = (size_t)HALF * K * 2;
    const unsigned ldsw = (unsigned)wid * 1024u;
    const int aoff = lds_byte(wr * 64 + fr, fq * 8), boff = lds_byte(wc * 32 + fr, fq * 8);
#define PG8_SA(b, h) (((b) * 2 + (h)) * HTB)
#define PG8_SB(b, h) ((4 + (b) * 2 + (h)) * HTB)
#define PG8_STAGE(bufoff, gbase, voff) do { _Pragma("unroll") for (int _i = 0; _i < 2; ++_i) \
        GLDS16((const char*)(gbase) + (voff)[_i], lds + (bufoff) + ldsw + _i * 8192); } while (0)
#define PG8_LDA(dst, b, h) do { _Pragma("unroll") for (int m = 0; m < 4; ++m) _Pragma("unroll") for (int k = 0; k < 2; ++k) dst[m][k] = *(const LAS bf16x8*)(lds + PG8_SA(b, h) + aoff + m * 2048 + k * 1024); } while (0)
#define PG8_LDB(dst, b, h) do { _Pragma("unroll") for (int n = 0; n < 2; ++n) _Pragma("unroll") for (int k = 0; k < 2; ++k) dst[n][k] = *(const LAS bf16x8*)(lds + PG8_SB(b, h) + boff + n * 2048 + k * 1024); } while (0)
#define PG8_MMA(ai, bj, At, Bt) do { SETPRIO(1); _Pragma("unroll") for (int m = 0; m < 4; ++m) _Pragma("unroll") for (int n = 0; n < 2; ++n) _Pragma("unroll") for (int k = 0; k < 2; ++k) \
        acc[ai][bj][m][n] = MFMA16(Bt[n][k], At[m][k], acc[ai][bj][m][n]); SETPRIO(0); } while (0)
    Unit cur, nxt; int ui = 0;
    if (!S.next(0, cur)) return;
    f32x4 acc[2][2][4][2];
#pragma unroll
    for (int a = 0; a < 2; ++a)
#pragma unroll
        for (int b = 0; b < 2; ++b)
#pragma unroll
            for (int m = 0; m < 4; ++m)
#pragma unroll
                for (int n = 0; n < 2; ++n) acc[a][b][m][n] = (f32x4){0.f, 0.f, 0.f, 0.f};
    bf16x8 At[4][2], B0[2][2], B1[2][2];
    const char* cA = S.abase(cur); const char* cB = S.bbase(cur);
    PG8_GOFF(va, cur);
    if constexpr (SP2) {
        PG8_STAGE(PG8_SB(0, 0), cB, voffB); PG8_STAGE(PG8_SB(0, 1), cB + hstep, voffB); PG8_STAGE_A(PG8_SA(0, 0), cA, 0, 0, false); PG8_STAGE_A(PG8_SA(0, 1), cA + hstep, 0, 1, false);
        if (wr == 1) S_BARRIER();
        WAIT_V(2); S_BARRIER();
        PG8_STAGE(PG8_SB(1, 0), cB + kstep, voffB); PG8_STAGE_A(PG8_SA(1, 0), cA + kstep, kstep, 0, false); PG8_STAGE(PG8_SB(1, 1), cB + hstep + kstep, voffB);
        WAIT_V(6); S_BARRIER();
    } else {
    PG8_STAGE(PG8_SB(0, 0), cB, voffB); PG8_STAGE_A(PG8_SA(0, 0), cA, 0, 0, false); PG8_STAGE(PG8_SB(0, 1), cB + hstep, voffB); PG8_STAGE_A(PG8_SA(0, 1), cA + hstep, 0, 1, false);
    if (wr == 1) S_BARRIER();
    WAIT_V(4); S_BARRIER();
    PG8_STAGE(PG8_SB(1, 0), cB + kstep, voffB); PG8_STAGE_A(PG8_SA(1, 0), cA + kstep, kstep, 0, false); PG8_STAGE(PG8_SB(1, 1), cB + hstep + kstep, voffB);
    WAIT_V(6); S_BARRIER();
    }
    for (;;) {
        const bool has_next = S.next(ui + 1, nxt);
        const char* nA = has_next ? S.abase(nxt) : cA; const char* nB = has_next ? S.bbase(nxt) : cB;
        if constexpr (Sched::GATHER) { if (has_next) { PG8_GOFF(vn, nxt); } else {
#pragma unroll
            for (int h_ = 0; h_ < 2; ++h_) { vn[h_][0] = va[h_][0]; vn[h_][1] = va[h_][1]; } } }
        for (int t = 0; t < nt; t += 2) {
            const bool last = (t == nt - 2);
            const char* a1 = cA + (size_t)(t + 1) * kstep;
            const char* a2 = last ? nA : cA + (size_t)(t + 2) * kstep; const char* b2 = last ? nB : cB + (size_t)(t + 2) * kstep;
            const char* a3 = a2 + kstep; const char* b3 = b2 + kstep;
            if constexpr (SP2) {
            PG8_LDB(B0, 0, 0); PG8_LDB(B1, 0, 1); SCHED_BAR(); PG8_LDA(At, 0, 0); PG8_STAGE_A(PG8_SA(1, 1), a1 + hstep, (size_t)(t + 1) * kstep, 1, false);
            WAIT_V(8); WAIT_L(0); S_BARRIER(); PG8_MMA(0, 0, At, B0); PG8_MMA(0, 1, At, B1); S_BARRIER(); SCHED_BAR();
            PG8_LDA(At, 0, 1); PG8_STAGE(PG8_SB(0, 0), b2, voffB); PG8_STAGE(PG8_SB(0, 1), b2 + hstep, voffB); PG8_STAGE_A(PG8_SA(0, 0), a2, (last ? (size_t)0 : (size_t)(t + 2) * kstep), 0, last);
            WAIT_V(8); WAIT_L(0); S_BARRIER(); PG8_MMA(1, 0, At, B0); PG8_MMA(1, 1, At, B1); S_BARRIER(); SCHED_BAR();
            PG8_LDB(B0, 1, 0); PG8_LDB(B1, 1, 1); SCHED_BAR(); PG8_LDA(At, 1, 0); PG8_STAGE_A(PG8_SA(0, 1), a2 + hstep, (last ? (size_t)0 : (size_t)(t + 2) * kstep), 1, last);
            WAIT_V(8); WAIT_L(0); S_BARRIER(); PG8_MMA(0, 0, At, B0); PG8_MMA(0, 1, At, B1); S_BARRIER(); SCHED_BAR();
            PG8_LDA(At, 1, 1); PG8_STAGE(PG8_SB(1, 0), b3, voffB); PG8_STAGE(PG8_SB(1, 1), b3 + hstep, voffB); PG8_STAGE_A(PG8_SA(1, 0), a3, (last ? kstep : (size_t)(t + 3) * kstep), 0, last);
            WAIT_V(8); WAIT_L(0); S_BARRIER(); PG8_MMA(1, 0, At, B0); PG8_MMA(1, 1, At, B1); S_BARRIER(); SCHED_BAR();
            } else {
            PG8_LDB(B0, 0, 0); SCHED_BAR(); PG8_LDA(At, 0, 0); PG8_STAGE_A(PG8_SA(1, 1), a1 + hstep, (size_t)(t + 1) * kstep, 1, false);
            WAIT_L(8); S_BARRIER(); WAIT_L(0); PG8_MMA(0, 0, At, B0); S_BARRIER(); SCHED_BAR();
            PG8_LDB(B1, 0, 1); PG8_STAGE(PG8_SB(0, 0), b2, voffB);
            S_BARRIER(); WAIT_L(0); PG8_MMA(0, 1, At, B1); S_BARRIER();
            PG8_LDA(At, 0, 1); PG8_STAGE_A(PG8_SA(0, 0), a2, (last ? (size_t)0 : (size_t)(t + 2) * kstep), 0, last);
            S_BARRIER(); WAIT_L(0); PG8_MMA(1, 0, At, B0); S_BARRIER(); SCHED_BAR();
            PG8_STAGE(PG8_SB(0, 1), b2 + hstep, voffB);
            WAIT_V(6); S_BARRIER(); PG8_MMA(1, 1, At, B1); S_BARRIER();
            PG8_LDB(B0, 1, 0); SCHED_BAR(); PG8_LDA(At, 1, 0); PG8_STAGE_A(PG8_SA(0, 1), a2 + hstep, (last ? (size_t)0 : (size_t)(t + 2) * kstep), 1, last);
            WAIT_L(8); S_BARRIER(); WAIT_L(0); PG8_MMA(0, 0, At, B0); S_BARRIER(); SCHED_BAR();
            PG8_LDB(B1, 1, 1); PG8_STAGE(PG8_SB(1, 0), b3, voffB);
            S_BARRIER(); WAIT_L(0); PG8_MMA(0, 1, At, B1); S_BARRIER();
            PG8_LDA(At, 1, 1); PG8_STAGE_A(PG8_SA(1, 0), a3, (last ? kstep : (size_t)(t + 3) * kstep), 0, last);
            S_BARRIER(); WAIT_L(0); PG8_MMA(1, 0, At, B0); S_BARRIER(); SCHED_BAR();
            PG8_STAGE(PG8_SB(1, 1), b3 + hstep, voffB);
            WAIT_V(6); S_BARRIER(); PG8_MMA(1, 1, At, B1); S_BARRIER();
            }
        }
        if (wr == 0) S_BARRIER();
        E(acc, cur, wr, wc, fr, fq);
        if (!has_next) break;
#pragma unroll
        for (int a = 0; a < 2; ++a)
#pragma unroll
            for (int b = 0; b < 2; ++b)
#pragma unroll
                for (int m = 0; m < 4; ++m)
#pragma unroll
                    for (int n = 0; n < 2; ++n) acc[a][b][m][n] = (f32x4){0.f, 0.f, 0.f, 0.f};
        cur = nxt; cA = nA; cB = nB; ++ui;
        if constexpr (Sched::GATHER) {
#pragma unroll
            for (int h_ = 0; h_ < 2; ++h_) { va[h_][0] = vn[h_][0]; va[h_][1] = vn[h_][1]; } }
        if (wr == 1) S_BARRIER();
    }
    WAIT_V(0);
    S_BARRIER();
#undef PG8_SA
#undef PG8_SB
#undef PG8_STAGE
#undef PG8_STAGE_A
#undef PG8_GOFF
#undef PG8_LDA
#undef PG8_LDB
#undef PG8_MMA
}
}

__device__ __forceinline__ float row16_sum(float x) {
#ifdef EMU
    x += __shfl_xor(x, 1); x += __shfl_xor(x, 2); x += __shfl_xor(x, 4); x += __shfl_xor(x, 8); return x;
#else
#define DPPF(v, ctrl) __builtin_bit_cast(float, __builtin_amdgcn_update_dpp(0, __builtin_bit_cast(int, (v)), (ctrl), 0xF, 0xF, false))
    x += DPPF(x, 0xB1); x += DPPF(x, 0x4E); x += DPPF(x, 0x141); x += DPPF(x, 0x140); return x;
#undef DPPF
#endif
}
__device__ __forceinline__ float row32_sum(float x) {
    x = row16_sum(x);
#ifdef EMU
    x += __shfl_xor(x, 32); return x;
#else
    float a = x, b = x;
    asm volatile("s_nop 1\n\tv_permlane32_swap_b32 %0, %1" : "+v"(a), "+v"(b));
    return a + b;
#endif
}
__device__ __forceinline__ float wave_sum_fast(float x, int lane) {
    x = row32_sum(x);
    x += SHX(x, 16, lane);
    return x;
}
__device__ __forceinline__ void transpose_item(const float* W, int K, int N, bf16_t* WT, int k0, int n0, int dst_row0, float* scr, int lane) {
    const int n4 = (lane & 15) * 4, kr = lane >> 4;
#pragma unroll 8
    for (int i = 0; i < 16; ++i) {
        const int kk = 4 * i + kr;
        f32x4 v = (f32x4){0.f, 0.f, 0.f, 0.f};
        if (n0 + n4 < N) v = *(const f32x4*)(W + (size_t)(k0 + kk) * N + n0 + n4);
        float* d = scr + kk * 65 + n4; d[0] = v.x; d[1] = v.y; d[2] = v.z; d[3] = v.w;
    }
    WAVE_SYNC();
    const int c = lane & 7;
#pragma unroll
    for (int j = 0; j < 8; ++j) { const int n = (lane >> 3) + 8 * j; const float* sp = scr + (8 * c) * 65 + n;
        u32x4 o; o.x = pk2(sp[0 * 65], sp[1 * 65]); o.y = pk2(sp[2 * 65], sp[3 * 65]); o.z = pk2(sp[4 * 65], sp[5 * 65]); o.w = pk2(sp[6 * 65], sp[7 * 65]);
        *(u32x4*)(WT + (size_t)(dst_row0 + n) * K + k0 + 8 * c) = o; }
    WAVE_SYNC();
}
__device__ __forceinline__ void phase_prologue(const Params& P, unsigned char* smem, int wv) {
    ParamsPtr pp = PARAMS_PTR(P); PIN_S(pp); unsigned char* ws = pp->ws; int bidx = (int)blockIdx.x, gdim = (int)gridDim.x; PIN_S(bidx); PIN_S(gdim);
    const int tid = phase_tid(wv), lane = tid & 63, wave = tid >> 6;
    float* scr = (float*)smem + wave * (64 * 65);
    const int gw = bidx * NWAVES + wave, ngw = NWAVES * gdim;
    constexpr int I_IN = 16 * (PLD / 64), I_OUT = 16 * 16, I_W1 = NE * 16 * 32, I_W2 = NE * 16 * 16, I_L = I_IN + I_OUT + I_W1 + I_W2;
    for (int it = gw; it < NL * I_L; it += ngw) {
        const int l = it / I_L; int r = it % I_L;
        if (r < I_IN) { const int kb = r / (PLD / 64), nb = r % (PLD / 64);
            transpose_item(pp->in[1] + (size_t)l * D * PIN, D, PIN, (bf16_t*)(ws + O_WIN) + (size_t)l * PLD * D, kb * 64, nb * 64, nb * 64, scr, lane); continue; }
        r -= I_IN;
        if (r < I_OUT) { const int kb = r / 16, nb = r % 16;
            transpose_item(pp->in[21] + (size_t)l * D * D, D, D, (bf16_t*)(ws + O_WOUT) + (size_t)l * D * D, kb * 64, nb * 64, nb * 64, scr, lane); continue; }
        r -= I_OUT;
        if (r < I_W1) { const int e = r / (16 * 32), q = r % (16 * 32), kb = q / 32, nb = q % 32, n0 = nb * 64;
            const int dst = n0 < DFF ? (n0 / 128) * 256 + (n0 % 128) : ((n0 - DFF) / 128) * 256 + 128 + ((n0 - DFF) % 128);
            transpose_item(pp->in[26] + ((size_t)l * NE + e) * D * 2 * DFF, D, 2 * DFF, (bf16_t*)(ws + O_W1) + ((size_t)l * NE + e) * 2 * DFF * D, kb * 64, n0, dst, scr, lane); continue; }
        r -= I_W1;
        { const int e = r / (16 * 16), q = r % (16 * 16), kb = q / 16, nb = q % 16;
            transpose_item(pp->in[28] + ((size_t)l * NE + e) * DFF * D, DFF, D, (bf16_t*)(ws + O_W2) + ((size_t)l * NE + e) * D * DFF, kb * 64, nb * 64, nb * 64, scr, lane); }
    }
    {
        const float* gw_ = pp->in[4]; bf16_t* WSB = (bf16_t*)(ws + O_WSB);
        for (size_t i = ((size_t)bidx * NTHREADS + tid) * 4; i < (size_t)NL * GH * CH * CH; i += (size_t)gdim * NTHREADS * 4) {
            const f32x4 v = *(const f32x4*)(gw_ + i); u32x2 o; o.x = pk2(v.x, v.y); o.y = pk2(v.z, v.w); *(u32x2*)(WSB + i) = o;
        }
    }
    {
        bf16_t* LWT = (bf16_t*)(ws + O_LWT);
        for (int i = bidx * NTHREADS + tid; i < NL * 1920 * 128; i += gdim * NTHREADS) {
            const int k = i & 127, n = (i >> 7) % 1920, ll = i / (1920 * 128);
            float v = 0.f;
            if (n < 1536) { if (k < 64) { const int grp = n / 768, d = (n / 384) & 1, c = n % 384; v = (grp == 0 ? pp->in[8] : pp->in[10])[(((size_t)ll * 2 + d) * 64 + k) * RW + c]; } }
            else v = pp->in[11][((size_t)ll * 128 + k) * RW + (n - 1536)];
            LWT[i] = (bf16_t)f2bf(v);
        }
    }
    {
        bf16_t* RWT = (bf16_t*)(ws + O_RWT);
        for (int i = bidx * NTHREADS + tid; i < NL * NE * D; i += gdim * NTHREADS) {
            const int k = i % D, e = (i / D) % NE, ll = i / (D * NE);
            const float v = pp->in[24][((size_t)ll * D + k) * NE + e];
            const unsigned hi = f2bf(v); const float lo = v - bf_lo(hi);
            RWT[((size_t)(ll * 2 + 0) * NE + e) * D + k] = (bf16_t)hi; RWT[((size_t)(ll * 2 + 1) * NE + e) * D + k] = (bf16_t)f2bf(lo);
        }
    }
    const float* x = pp->in[0]; bf16_t* XB = (bf16_t*)(ws + O_XB);
    for (size_t i = ((size_t)bidx * NTHREADS + tid) * 4; i < (size_t)T * D; i += (size_t)gdim * NTHREADS * 4) {
        const f32x4 v = *(const f32x4*)(x + i); u32x2 o; o.x = pk2(v.x, v.y); o.y = pk2(v.z, v.w); *(u32x2*)(XB + i) = o;
    }
}

__device__ __forceinline__ float tshift(const float* P, int t, int s, int col, const float* mu0, const float* mu1, int rc) {
    const float cur = P[(size_t)t * PLD + col];
    const float prv = s > 0 ? P[(size_t)(t - 1) * PLD + col] : 0.f;
    const float nxt = s < S - 1 ? P[(size_t)(t + 1) * PLD + col] : 0.f;
    return cur + mu0[rc] * (prv - cur) + mu1[rc] * (nxt - cur);
}

__device__ __forceinline__ void phase_prep(const Params& P, int l, unsigned char* smem, int wv) {
    ParamsPtr pp = PARAMS_PTR(P); PIN_S(pp); unsigned char* ws = pp->ws; int bidx = (int)blockIdx.x, gdim = (int)gridDim.x; PIN_S(bidx); PIN_S(gdim);
    const bf16_t* proj = (const bf16_t*)(ws + O_PROJ); const float* projg = (const float*)(ws + O_PROJG);
    float* UG = (float*)(ws + O_UG); bf16_t* VNT = (bf16_t*)(ws + O_VNT);
    float* RR = (float*)(ws + O_RR); float* VV = (float*)(ws + O_VV); float* KK = (float*)(ws + O_KK);
    float* KD = (float*)(ws + O_KD); float* ICLR = (float*)(ws + O_ICLR);
    float* GATE = (float*)(ws + O_GATE); float* BONUS = (float*)(ws + O_BONUS); float* LWG = (float*)(ws + O_LW);
    bf16_t* RB = (bf16_t*)(ws + O_RB); bf16_t* VB = (bf16_t*)(ws + O_VB); bf16_t* KKB = (bf16_t*)(ws + O_KKB); bf16_t* BBB = (bf16_t*)(ws + O_BBB); bf16_t* KDB = (bf16_t*)(ws + O_KDB);
#if !MK_RWKV_CHUNKED
    float* DEC = (float*)(ws + O_DEC); float* BRKR = (float*)(ws + O_BRKR);
#endif
    bf16_t* MQB = (bf16_t*)(ws + O_MQB); bf16_t* MKB = (bf16_t*)(ws + O_MKB); bf16_t* KT = (bf16_t*)(ws + O_KT); bf16_t* VT = (bf16_t*)(ws + O_VT);
    float* IG = (float*)(ws + O_IG); float* LF = (float*)(ws + O_LF);
    const bf16_t* LWT = (const bf16_t*)(ws + O_LWT) + (size_t)l * 1920 * 128;
    const float* gln_g = pp->in[2] + (size_t)l * GW; const float* gln_b = pp->in[3] + (size_t)l * GW;
    const float* mu0 = pp->in[6] + (size_t)l * 2 * RPROJ; const float* mu1 = mu0 + RPROJ;
    const float* w0 = pp->in[7] + (size_t)l * 2 * RW; const float* a0 = pp->in[9] + (size_t)l * 2 * RW;
    const float* k_k = pp->in[12] + (size_t)l * RW; const float* k_a = pp->in[13] + (size_t)l * RW; const float* r_k = pp->in[14] + (size_t)l * RW;
    const float* conv_w = pp->in[17] + (size_t)l * 3 * 768; const float* conv_b = pp->in[18] + (size_t)l * 768; const float* gate_b = pp->in[19] + (size_t)l * 24;
    float* win = (float*)smem;
    bf16_t* lin = (bf16_t*)(smem + 101376);
    bf16_t* tvn = (bf16_t*)(smem + 110592);
    bf16_t* tk = (bf16_t*)(smem + 118784);
    bf16_t* tv = (bf16_t*)(smem + 131072);
    constexpr int LIN = 264;
    const int tid = phase_tid(wv), lane = tid & 63, wave = tid >> 6, col = lane & 15, g = lane >> 4;
    for (int u = bidx; u < T / 16; u += gdim) {
        const int t0 = u * 16, s0 = t0 % S, bb = t0 / S;
        __syncthreads();
        {
            u32x2 wb[18];
#pragma unroll
            for (int row = 0; row < 18; ++row) {
                const int sq = s0 - 1 + row;
                wb[row] = (u32x2){0u, 0u};
                if (sq >= 0 && sq < S && tid < 352) wb[row] = *(const u32x2*)(proj + (size_t)(t0 - 1 + row) * PLD + C_RW + tid * 4);
            }
            if (tid < 352) {
#pragma unroll
                for (int row = 0; row < 18; ++row) *(f32x4*)(win + row * RPROJ + tid * 4) = (f32x4){bf_lo(wb[row].x), bf_hi(wb[row].x), bf_lo(wb[row].y), bf_hi(wb[row].y)};
            }
        }
        for (int rep_ = 0; rep_ < (MK_PROBE == 3 ? 2 : 1); ++rep_) {
            const int i = tid >> 5, l32 = tid & 31, t = t0 + i;
            float v[8], ug[8]; float sum = 0.f;
#pragma unroll
            for (int j = 0; j < 8; ++j) { const int c = j * 32 + l32; ug[j] = bf_lo((unsigned)proj[(size_t)t * PLD + c]); v[j] = bf_lo((unsigned)proj[(size_t)t * PLD + GW + c]); }
#pragma unroll
            for (int j = 0; j < 8; ++j) { const int c = j * 32 + l32; UG[(size_t)t * GW + c] = geluf_(ug[j]); v[j] = geluf_(v[j]); sum += v[j]; }
#pragma unroll
            for (int o = 16; o >= 1; o >>= 1) sum += SHX(sum, o, lane);
            const float mean = sum * (1.0f / GW); float q = 0.f;
#pragma unroll
            for (int j = 0; j < 8; ++j) { const float d = v[j] - mean; q += d * d; }
#pragma unroll
            for (int o = 16; o >= 1; o >>= 1) q += SHX(q, o, lane);
            const float rstd = 1.0f / sqrtf(q * (1.0f / GW) + LN_EPS);
#pragma unroll
            for (int j = 0; j < 8; ++j) { const int c = j * 32 + l32; tvn[c * 16 + i] = (bf16_t)f2bf((v[j] - mean) * rstd * gln_g[c] + gln_b[c]); }
        }
        __syncthreads();
        {
            const int hf = tid & 1, c = tid >> 1;
            *(u32x4*)(VNT + ((size_t)bb * GW + c) * S + s0 + hf * 8) = *(const u32x4*)(tvn + c * 16 + hf * 8);
        }
        for (int idx = tid; idx < 16 * 256; idx += NTHREADS) {
            const int i = idx >> 8, j = idx & 255, rc = 1152 + j;
            const float pv = win[i * RPROJ + rc], cv = win[(i + 1) * RPROJ + rc], nv = win[(i + 2) * RPROJ + rc];
            const float x = cv + mu0[rc] * (pv - cv) + mu1[rc] * (nv - cv);
            lin[i * LIN + j] = (bf16_t)f2bf(j < 64 ? ftanh(x) : (j < 128 ? x : sigmoidf_(x)));
        }
        __syncthreads();
        for (int rep_ = 0; rep_ < (MK_PROBE == 1 ? 2 : 1); ++rep_) {
#pragma unroll 1
            for (int qg = 0; qg < 3; ++qg) {
                bf16x8 bw_[5][4]; float bias_[5];
#pragma unroll
                for (int q5 = 0; q5 < 5; ++q5) {
                    const int nt = wave * 15 + qg * 5 + q5, grp = nt / 24, c = (nt % 24) * 16 + col;
                    const bf16_t* bw = LWT + (size_t)(nt * 16 + col) * 128 + 8 * g;
#pragma unroll
                    for (int ks = 0; ks < 2; ++ks) bw_[q5][ks] = *(const bf16x8*)(bw + ks * 32);
                    if (grp == 4) {
#pragma unroll
                        for (int ks = 2; ks < 4; ++ks) bw_[q5][ks] = *(const bf16x8*)(bw + ks * 32);
                    }
                    bias_[q5] = grp < 2 ? w0[grp * RW + c] : (grp < 4 ? a0[(grp - 2) * RW + c] : 0.f);
                }
#pragma unroll
                for (int q5 = 0; q5 < 5; ++q5) {
                    const int nt = wave * 15 + qg * 5 + q5, grp = nt / 24, c = (nt % 24) * 16 + col;
                    const int kcol = grp < 2 ? 0 : (grp < 4 ? 64 : 128);
                    f32x4 acc = (f32x4){0.f, 0.f, 0.f, 0.f};
#pragma unroll
                    for (int ks = 0; ks < 2; ++ks) acc = MFMA16(*(const bf16x8*)(lin + col * LIN + kcol + ks * 32 + 8 * g), bw_[q5][ks], acc);
                    if (grp == 4) {
#pragma unroll
                        for (int ks = 2; ks < 4; ++ks) acc = MFMA16(*(const bf16x8*)(lin + col * LIN + kcol + ks * 32 + 8 * g), bw_[q5][ks], acc);
                    }
                    if (grp < 2) {
#pragma unroll
                        for (int r = 0; r < 4; ++r) { const float lw = -fexp(-softplusf_(-(acc[r] + bias_[q5])) - 0.5f); const size_t o = (size_t)grp * T * RW + (size_t)(t0 + 4 * g + r) * RW + c; LWG[o] = lw;
#if !MK_RWKV_CHUNKED
                            DEC[o] = expf(lw);
#endif
                        }
                    } else if (grp < 4) {
#pragma unroll
                        for (int r = 0; r < 4; ++r) ICLR[(size_t)(grp - 2) * T * RW + (size_t)(t0 + 4 * g + r) * RW + c] = sigmoidf_(acc[r] + bias_[q5]);
                    } else {
#pragma unroll
                        for (int r = 0; r < 4; ++r) GATE[(size_t)(t0 + 4 * g + r) * RW + c] = acc[r];
                    }
                }
            }
        }
        __syncthreads();
        for (int rep_ = 0; rep_ < (MK_PROBE == 2 ? 2 : 1); ++rep_) if (wave < 6) {
            const int c = tid, h = wave;
            const float kkc = k_k[c], kac = k_a[c], rkc = r_k[c];
            const float m0r = mu0[c], m1r = mu1[c], m0k = mu0[RW + c], m1k = mu1[RW + c], m0v = mu0[2 * RW + c], m1v = mu1[2 * RW + c];
            float ic0[16], ic1[16];
#pragma unroll
            for (int i = 0; i < 16; ++i) { const size_t o = (size_t)(t0 + i) * RW + c; ic0[i] = ICLR[o]; ic1[i] = ICLR[(size_t)T * RW + o]; }
#pragma unroll
            for (int i = 0; i < 16; ++i) {
                const int t = t0 + i;
                const float* w_ = win + i * RPROJ + c;
                const float rp = w_[0], rc_ = w_[RPROJ], rn = w_[2 * RPROJ];
                const float kp = w_[RW], kc_ = w_[RPROJ + RW], kn = w_[2 * RPROJ + RW];
                const float vp = w_[2 * RW], vc_ = w_[RPROJ + 2 * RW], vn = w_[2 * RPROJ + 2 * RW];
                const float r = rc_ + m0r * (rp - rc_) + m1r * (rn - rc_);
                const float k = kc_ + m0k * (kp - kc_) + m1k * (kn - kc_);
                const float v = vc_ + m0v * (vp - vc_) + m1v * (vn - vc_);
                const size_t o = (size_t)t * RW + c;
                const float kq = k * kkc;
                const float n2 = wave_sum_fast(kq * kq, lane);
                const float kk = kq / fmaxf(sqrtf(n2), 1e-12f);
                const float kd0 = k * (1.0f + (ic0[i] - 1.0f) * kac), kd1 = k * (1.0f + (ic1[i] - 1.0f) * kac);
                const float bon = wave_sum_fast(r * (kd0 + kd1) * rkc, lane);
#if MK_RWKV_CHUNKED
                RB[o] = (bf16_t)f2bf(r); VB[o] = (bf16_t)f2bf(v); KKB[o] = (bf16_t)f2bf(kk);
                BBB[o] = (bf16_t)f2bf(kk * ic0[i]); BBB[(size_t)T * RW + o] = (bf16_t)f2bf(kk * ic1[i]);
                KDB[o] = (bf16_t)f2bf(kd0); KDB[(size_t)T * RW + o] = (bf16_t)f2bf(kd1);
#else
                RR[o] = r; VV[o] = v; KK[o] = kk;
                KD[o] = kd0; KD[(size_t)T * RW + o] = kd1;
#endif
                if (lane == 0) BONUS[(size_t)t * RH + h] = bon;
#if !MK_RWKV_CHUNKED
                { const float br0 = wave_sum(kk * ic0[i] * r, lane), br1 = wave_sum(kk * ic1[i] * r, lane), kr0 = wave_sum(kd0 * r, lane), kr1 = wave_sum(kd1 * r, lane);
                  if (lane == 0) { BRKR[((size_t)t * RH + h) * 2] = br0; BRKR[((size_t)t * RH + h) * 2 + 1] = kr0; BRKR[((size_t)(T + t) * RH + h) * 2] = br1; BRKR[((size_t)(T + t) * RH + h) * 2 + 1] = kr1; } }
#endif
            }
        }
        __syncthreads();
        {
            u32x2 wb[9], vb[3];
            const int rsel = tid >= 192 ? 1 : 0, c4 = tid - rsel * 192;
#pragma unroll
            for (int it = 0; it < 9; ++it) {
                const int row = 2 * it + rsel, sq = s0 - 1 + row;
                wb[it] = (u32x2){0u, 0u};
                if (tid < 384 && sq >= 0 && sq < S) wb[it] = *(const u32x2*)(proj + (size_t)(t0 - 1 + row) * PLD + C_MW + c4 * 4);
            }
#pragma unroll
            for (int it = 0; it < 3; ++it) { const int idx = tid + it * NTHREADS, i = idx / 96, cc = (idx % 96) * 4; vb[it] = *(const u32x2*)(proj + (size_t)(t0 + i) * PLD + C_MW + 2 * MW + cc); }
            if (tid < 384) {
#pragma unroll
                for (int it = 0; it < 9; ++it) *(f32x4*)(win + (2 * it + rsel) * 768 + c4 * 4) = (f32x4){bf_lo(wb[it].x), bf_hi(wb[it].x), bf_lo(wb[it].y), bf_hi(wb[it].y)};
            }
#pragma unroll
            for (int it = 0; it < 3; ++it) { const int idx = tid + it * NTHREADS, i = idx / 96, cc = (idx % 96) * 4; const u32x2 v = vb[it];
                tv[(cc + 0) * 16 + i] = (bf16_t)(v.x & 0xffffu); tv[(cc + 1) * 16 + i] = (bf16_t)(v.x >> 16); tv[(cc + 2) * 16 + i] = (bf16_t)(v.y & 0xffffu); tv[(cc + 3) * 16 + i] = (bf16_t)(v.y >> 16); }
        }
        for (int idx = tid; idx < 16 * 24; idx += NTHREADS) {
            const int i = idx / 24, gi = idx % 24, t = t0 + i;
            const int isf = gi / 12, dir = (gi / 6) & 1, h = gi % 6;
            const float gg = projg[(size_t)t * 256 + (3456 - (PLD - 256)) + gi] + gate_b[gi];
            if (isf) LF[((size_t)dir * T + t) * MH + h] = -softplusf_(-gg); else IG[((size_t)dir * T + t) * MH + h] = gg;
        }
        __syncthreads();
        for (int rep_ = 0; rep_ < (MK_PROBE == 4 ? 2 : 1); ++rep_)
        for (int idx = tid; idx < 16 * 768; idx += NTHREADS) {
            const int i = idx / 768, c = idx % 768, t = t0 + i;
            const float* w_ = win + i * 768 + c;
            float y = conv_b[c] + w_[0] * conv_w[c] + w_[768] * conv_w[768 + c] + w_[1536] * conv_w[2 * 768 + c];
            y = y * sigmoidf_(y);
            if (c < MW) MQB[(size_t)t * MW + c] = (bf16_t)f2bf(y);
            else { const bf16_t kb = (bf16_t)f2bf(y * 0.125f); MKB[(size_t)t * MW + (c - MW)] = kb; tk[(c - MW) * 16 + i] = kb; }
        }
        __syncthreads();
        for (int idx = tid; idx < 2 * MW * 2; idx += NTHREADS) {
            const int hf = idx & 1, c = (idx >> 1) % MW, which = idx / (2 * MW);
            const u32x4 val = *(const u32x4*)((which ? tv : tk) + c * 16 + hf * 8);
            bf16_t* dst = (which ? VT : KT) + ((size_t)(bb * MH) * 64 + c) * S + s0 + hf * 8;
            *(u32x4*)dst = val;
        }
    }
    __syncthreads();
}

__device__ __forceinline__ void phase_prep32(const Params& P, int l, unsigned char* smem, int wv) {
    ParamsPtr pp = PARAMS_PTR(P); PIN_S(pp); unsigned char* ws = pp->ws; int bidx = (int)blockIdx.x, gdim = (int)gridDim.x; PIN_S(bidx); PIN_S(gdim);
    const bf16_t* proj = (const bf16_t*)(ws + O_PROJ); const float* projg = (const float*)(ws + O_PROJG);
    bf16_t* UG = (bf16_t*)(ws + O_UG); bf16_t* VNT = (bf16_t*)(ws + O_VNT);
    u32x4* RK7 = (u32x4*)(ws + O_RK7);
    bf16_t* GATE = (bf16_t*)(ws + O_GATE); float* BONUS = (float*)(ws + O_BONUS); float* LWG = (float*)(ws + O_LW);
    bf16_t* VB = (bf16_t*)(ws + O_VB);
    bf16_t* MQB = (bf16_t*)(ws + O_MQB); bf16_t* MKB = (bf16_t*)(ws + O_MKB); bf16_t* KT = (bf16_t*)(ws + O_KT); bf16_t* VT = (bf16_t*)(ws + O_VT);
    float* IG = (float*)(ws + O_IG); float* LF = (float*)(ws + O_LF);
    const bf16_t* LWT = (const bf16_t*)(ws + O_LWT) + (size_t)l * 1920 * 128;
    const float* gln_g = pp->in[2] + (size_t)l * GW; const float* gln_b = pp->in[3] + (size_t)l * GW;
    const float* mu0 = pp->in[6] + (size_t)l * 2 * RPROJ; const float* mu1 = mu0 + RPROJ;
    const float* w0 = pp->in[7] + (size_t)l * 2 * RW; const float* a0 = pp->in[9] + (size_t)l * 2 * RW;
    const float* k_k = pp->in[12] + (size_t)l * RW; const float* k_a = pp->in[13] + (size_t)l * RW; const float* r_k = pp->in[14] + (size_t)l * RW;
    const float* conv_w = pp->in[17] + (size_t)l * 3 * 768; const float* conv_b = pp->in[18] + (size_t)l * 768; const float* gate_b = pp->in[19] + (size_t)l * 24;
    constexpr int TOK = 32, WR = TOK + 2, LIN = 264;
    bf16_t* winb = (bf16_t*)smem;
    bf16_t* lin = (bf16_t*)(smem + 95744);
    bf16_t* tk = (bf16_t*)(smem + 112640);
    bf16_t* tv = (bf16_t*)(smem + 137216);
    bf16_t* tvn = tk;
    bf16_t* icl = tk;
    const int tid = phase_tid(wv), lane = tid & 63, wave = tid >> 6, col = lane & 15, g = lane >> 4;
    for (int u = bidx; u < T / TOK; u += gdim) {
        const int t0 = u * TOK, s0 = t0 % S, bb = t0 / S;
        __syncthreads();
#pragma unroll 1
        for (int hb = 0; hb < 2; ++hb) {
            u32x2 wb[17];
#pragma unroll
            for (int q = 0; q < 17; ++q) {
                const int row = hb * 17 + q, sq = s0 - 1 + row;
                wb[q] = (u32x2){0u, 0u};
                if (sq >= 0 && sq < S && tid < 352) wb[q] = *(const u32x2*)(proj + (size_t)(t0 - 1 + row) * PLD + C_RW + tid * 4);
            }
            if (tid < 352) {
#pragma unroll
                for (int q = 0; q < 17; ++q) *(u32x2*)(winb + (hb * 17 + q) * RPROJ + tid * 4) = wb[q];
            }
        }
#pragma unroll 1
        for (int ps = 0; ps < 2; ++ps) {
            const int i = ps * 16 + (tid >> 5), l32 = tid & 31, t = t0 + i;
            float v[8], ug[8]; float sum = 0.f;
            {
                const u32x4 uq = *(const u32x4*)(proj + (size_t)t * PLD + l32 * 8), vq = *(const u32x4*)(proj + (size_t)t * PLD + GW + l32 * 8);
                ug[0] = bf_lo(uq.x); ug[1] = bf_hi(uq.x); ug[2] = bf_lo(uq.y); ug[3] = bf_hi(uq.y); ug[4] = bf_lo(uq.z); ug[5] = bf_hi(uq.z); ug[6] = bf_lo(uq.w); ug[7] = bf_hi(uq.w);
                v[0] = bf_lo(vq.x); v[1] = bf_hi(vq.x); v[2] = bf_lo(vq.y); v[3] = bf_hi(vq.y); v[4] = bf_lo(vq.z); v[5] = bf_hi(vq.z); v[6] = bf_lo(vq.w); v[7] = bf_hi(vq.w);
            }
#pragma unroll
            for (int j = 0; j < 8; ++j) { ug[j] = geluf_(ug[j]); v[j] = geluf_(v[j]); sum += v[j]; }
            { u32x4 uo; uo.x = pk2(ug[0], ug[1]); uo.y = pk2(ug[2], ug[3]); uo.z = pk2(ug[4], ug[5]); uo.w = pk2(ug[6], ug[7]); *(u32x4*)(UG + (size_t)t * GW + l32 * 8) = uo; }
#pragma unroll
            for (int o = 16; o >= 1; o >>= 1) sum += SHX(sum, o, lane);
            const float mean = sum * (1.0f / GW); float q = 0.f;
#pragma unroll
            for (int j = 0; j < 8; ++j) { const float d = v[j] - mean; q += d * d; }
#pragma unroll
            for (int o = 16; o >= 1; o >>= 1) q += SHX(q, o, lane);
            const float rstd = 1.0f / sqrtf(q * (1.0f / GW) + LN_EPS);
#pragma unroll
            for (int j = 0; j < 8; ++j) { const int c = l32 * 8 + j; tvn[c * TOK + i] = (bf16_t)f2bf((v[j] - mean) * rstd * gln_g[c] + gln_b[c]); }
        }
        __syncthreads();
#pragma unroll
        for (int q = 0; q < 2; ++q) {
            const int idx = tid + q * NTHREADS, c = idx >> 2, pc = idx & 3;
            *(u32x4*)(VNT + ((size_t)bb * GW + c) * S + s0 + pc * 8) = *(const u32x4*)(tvn + c * TOK + pc * 8);
        }
        int tb2 = tid; PIN_V(tb2);
#pragma unroll 4
        for (int q = 0; q < 16; ++q) {
            const int idx = tb2 + q * NTHREADS, i = idx >> 8, j = idx & 255, rc = 1152 + j;
            const float pv = bf_lo((unsigned)winb[i * RPROJ + rc]), cv = bf_lo((unsigned)winb[(i + 1) * RPROJ + rc]), nv = bf_lo((unsigned)winb[(i + 2) * RPROJ + rc]);
            const float x = cv + mu0[rc] * (pv - cv) + mu1[rc] * (nv - cv);
            lin[i * LIN + j] = (bf16_t)f2bf(j < 64 ? ftanh(x) : (j < 128 ? x : sigmoidf_(x)));
        }
        __syncthreads();
#pragma unroll 1
        for (int qg = 0; qg < 3; ++qg) {
            bf16x8 bw_[5][4]; f32x4 bias_[5];
#pragma unroll
            for (int q5 = 0; q5 < 5; ++q5) {
                const int nt = wave * 15 + qg * 5 + q5, grp = nt / 24, c = (nt % 24) * 16 + col;
                const bf16_t* bw = LWT + (size_t)(nt * 16 + col) * 128 + 8 * g;
#pragma unroll
                for (int ks = 0; ks < 2; ++ks) bw_[q5][ks] = *(const bf16x8*)(bw + ks * 32);
                if (grp == 4) {
#pragma unroll
                    for (int ks = 2; ks < 4; ++ks) bw_[q5][ks] = *(const bf16x8*)(bw + ks * 32);
                }
                const int c4 = (nt % 24) * 16 + 4 * g;
                bias_[q5] = grp < 2 ? *(const f32x4*)(w0 + grp * RW + c4) : (grp < 4 ? *(const f32x4*)(a0 + (grp - 2) * RW + c4) : (f32x4){0.f, 0.f, 0.f, 0.f});
            }
#pragma unroll
            for (int q5 = 0; q5 < 5; ++q5) {
                const int nt = wave * 15 + qg * 5 + q5, grp = nt / 24, c4 = (nt % 24) * 16 + 4 * g;
                const int kcol = grp < 2 ? 0 : (grp < 4 ? 64 : 128);
#pragma unroll
                for (int mt = 0; mt < 2; ++mt) {
                    f32x4 acc = (f32x4){0.f, 0.f, 0.f, 0.f};
                    const bf16_t* la = lin + (mt * 16 + col) * LIN + kcol + 8 * g;
#pragma unroll
                    for (int ks = 0; ks < 2; ++ks) acc = MFMA16(bw_[q5][ks], *(const bf16x8*)(la + ks * 32), acc);
                    if (grp == 4) {
#pragma unroll
                        for (int ks = 2; ks < 4; ++ks) acc = MFMA16(bw_[q5][ks], *(const bf16x8*)(la + ks * 32), acc);
                    }
                    const size_t tb = (size_t)(t0 + mt * 16 + col);
                    acc = acc + bias_[q5];
                    if (grp < 2) {
                        f32x4 lw; lw.x = -0.60653065971263342f * sigmoidf_(acc.x); lw.y = -0.60653065971263342f * sigmoidf_(acc.y); lw.z = -0.60653065971263342f * sigmoidf_(acc.z); lw.w = -0.60653065971263342f * sigmoidf_(acc.w);
                        *(f32x4*)(LWG + (size_t)grp * T * RW + tb * RW + c4) = lw;
                    } else if (grp < 4) {
                        u32x2 ic; ic.x = pk2(sigmoidf_(acc.x), sigmoidf_(acc.y)); ic.y = pk2(sigmoidf_(acc.z), sigmoidf_(acc.w));
                        *(u32x2*)(icl + ((grp - 2) * TOK + mt * 16 + col) * RW + c4) = ic;
                    } else {
                        u32x2 gt; gt.x = pk2(acc.x, acc.y); gt.y = pk2(acc.z, acc.w);
                        *(u32x2*)(GATE + tb * RW + c4) = gt;
                    }
                }
            }
        }
        __syncthreads();
        if (wave < 6) {
            int c = tid; PIN_V(c); const int h = wave;
            const float kkc = k_k[c], kac = k_a[c], rkc = r_k[c];
            const float m0r = mu0[c], m1r = mu1[c], m0k = mu0[RW + c], m1k = mu1[RW + c], m0v = mu0[2 * RW + c], m1v = mu1[2 * RW + c];
#pragma unroll 1
            for (int hb = 0; hb < 2; ++hb) {
                float ic0[16], ic1[16];
#pragma unroll
                for (int i = 0; i < 16; ++i) { ic0[i] = bf_lo((unsigned)icl[(hb * 16 + i) * RW + c]); ic1[i] = bf_lo((unsigned)icl[(TOK + hb * 16 + i) * RW + c]); }
#pragma unroll
                for (int i = 0; i < 16; ++i) {
                    const int it = hb * 16 + i, t = t0 + it;
                    const bf16_t* w_ = winb + it * RPROJ + c;
                    const float rp = bf_lo((unsigned)w_[0]), rc_ = bf_lo((unsigned)w_[RPROJ]), rn = bf_lo((unsigned)w_[2 * RPROJ]);
                    const float kp = bf_lo((unsigned)w_[RW]), kc_ = bf_lo((unsigned)w_[RPROJ + RW]), kn = bf_lo((unsigned)w_[2 * RPROJ + RW]);
                    const float vp = bf_lo((unsigned)w_[2 * RW]), vc_ = bf_lo((unsigned)w_[RPROJ + 2 * RW]), vn = bf_lo((unsigned)w_[2 * RPROJ + 2 * RW]);
                    const float r = rc_ + m0r * (rp - rc_) + m1r * (rn - rc_);
                    const float k = kc_ + m0k * (kp - kc_) + m1k * (kn - kc_);
                    const float v = vc_ + m0v * (vp - vc_) + m1v * (vn - vc_);
                    const size_t o = (size_t)t * RW + c;
                    const float kq = k * kkc;
                    const float n2 = wave_sum_fast(kq * kq, lane);
                    const float kk = kq / fmaxf(sqrtf(n2), 1e-12f);
                    const float kd0 = k * (1.0f + (ic0[i] - 1.0f) * kac), kd1 = k * (1.0f + (ic1[i] - 1.0f) * kac);
                    const float bon = wave_sum_fast(r * (kd0 + kd1) * rkc, lane);
                    u32x4 rec; rec.x = pk2(r, v); rec.y = pk2(kk, 0.f); rec.z = pk2(kk * ic0[i], kk * ic1[i]); rec.w = pk2(kd0, kd1);
                    RK7[o] = rec;
                    VB[o] = (bf16_t)(rec.x >> 16);
                    if (lane == 0) BONUS[(size_t)t * RH + h] = bon;
                }
            }
        }
        __syncthreads();
        {
            u32x2 wb[17], vb[6];
            int tC = tid; PIN_V(tC);
            const int rsel = tC >= 192 ? 1 : 0, c4 = tC - rsel * 192;
#pragma unroll
            for (int q = 0; q < 17; ++q) {
                const int row = 2 * q + rsel, sq = s0 - 1 + row;
                wb[q] = (u32x2){0u, 0u};
                if (tC < 384 && sq >= 0 && sq < S) wb[q] = *(const u32x2*)(proj + (size_t)(t0 - 1 + row) * PLD + C_MW + c4 * 4);
            }
#pragma unroll
            for (int q = 0; q < 6; ++q) { const int idx = tC + q * NTHREADS, i = idx / 96, cc = (idx % 96) * 4; vb[q] = *(const u32x2*)(proj + (size_t)(t0 + i) * PLD + C_MW + 2 * MW + cc); }
            if (tC < 384) {
#pragma unroll
                for (int q = 0; q < 17; ++q) *(u32x2*)(winb + (2 * q + rsel) * 768 + c4 * 4) = wb[q];
            }
#pragma unroll
            for (int q = 0; q < 6; ++q) { const int idx = tC + q * NTHREADS, i = idx / 96, cc = (idx % 96) * 4; const u32x2 v = vb[q];
                tv[(cc + 0) * TOK + i] = (bf16_t)(v.x & 0xffffu); tv[(cc + 1) * TOK + i] = (bf16_t)(v.x >> 16); tv[(cc + 2) * TOK + i] = (bf16_t)(v.y & 0xffffu); tv[(cc + 3) * TOK + i] = (bf16_t)(v.y >> 16); }
        }
        for (int idx = tid; idx < TOK * 24; idx += NTHREADS) {
            const int i = idx / 24, gi = idx % 24, t = t0 + i;
            const int isf = gi / 12, dir = (gi / 6) & 1, h = gi % 6;
            const float gg = projg[(size_t)t * 256 + (3456 - (PLD - 256)) + gi] + gate_b[gi];
            if (isf) LF[((size_t)dir * T + t) * MH + h] = -softplusf_(-gg); else IG[((size_t)dir * T + t) * MH + h] = gg;
        }
        __syncthreads();
        int tcv = tid; PIN_V(tcv);
#pragma unroll 4
        for (int q = 0; q < 48; ++q) {
            const int idx = tcv + q * NTHREADS, i = idx / 768, c = idx % 768, t = t0 + i;
            const bf16_t* w_ = winb + i * 768 + c;
            float y = conv_b[c] + bf_lo((unsigned)w_[0]) * conv_w[c] + bf_lo((unsigned)w_[768]) * conv_w[768 + c] + bf_lo((unsigned)w_[1536]) * conv_w[2 * 768 + c];
            y = y * sigmoidf_(y);
            if (c < MW) MQB[(size_t)t * MW + c] = (bf16_t)f2bf(y);
            else { const bf16_t kb = (bf16_t)f2bf(y * 0.125f); MKB[(size_t)t * MW + (c - MW)] = kb; tk[(c - MW) * TOK + i] = kb; }
        }
        __syncthreads();
#pragma unroll
        for (int q = 0; q < 6; ++q) {
            const int idx = tid + q * NTHREADS, pc = idx & 3, c = (idx >> 2) % MW, which = idx / (4 * MW);
            const u32x4 val = *(const u32x4*)((which ? tv : tk) + c * TOK + pc * 8);
            bf16_t* dst = (which ? VT : KT) + ((size_t)(bb * MH) * 64 + c) * S + s0 + pc * 8;
            *(u32x4*)dst = val;
        }
    }
    __syncthreads();
}

__device__ __forceinline__ void phase_gmlp_mix(const Params& P, int l, unsigned char* smem, int wv, int bid, int nb) {
    PIN_S(bid); PIN_S(nb);
    ParamsPtr pp = PARAMS_PTR(P); PIN_S(pp); unsigned char* ws = pp->ws;
    const bf16_t* UG = (const bf16_t*)(ws + O_UG); const bf16_t* VNT = (const bf16_t*)(ws + O_VNT); bf16_t* GRP = (bf16_t*)(ws + O_GRP);
    const bf16_t* WSB = (const bf16_t*)(ws + O_WSB) + (size_t)l * GH * CH * CH; const float* gbs = pp->in[5] + (size_t)l * GH * CH;
    const int tid = phase_tid(wv), lane = tid & 63, wave = tid >> 6, col = lane & 15, g = lane >> 4;
    constexpr int NU = NB * NCH * GH;
    bf16x8 wA[4], vA[4][4], wB[4], vB[4][4]; u32x2 uA[4], uB[4]; float bA, bB;
#define GM_LOAD(u_, W_, V_, U_, B_) do { const int h_ = (u_) % GH, c_ = ((u_) / GH) % NCH, b_ = (u_) / (GH * NCH); \
        const bf16_t* wb_ = WSB + (size_t)h_ * CH * CH + (size_t)(wave * 16 + col) * CH + 8 * g; \
        const bf16_t* vb_ = VNT + ((size_t)b_ * GW + h_ * 64 + col) * S + (size_t)c_ * CH + 8 * g; \
        _Pragma("unroll") for (int ks = 0; ks < 4; ++ks) { W_[ks] = *(const bf16x8*)(wb_ + ks * 32); \
            _Pragma("unroll") for (int et = 0; et < 4; ++et) V_[et][ks] = *(const bf16x8*)(vb_ + (size_t)et * 16 * S + ks * 32); } \
        const size_t t_ = (size_t)(b_ * S + c_ * CH + wave * 16 + col); \
        _Pragma("unroll") for (int et = 0; et < 4; ++et) U_[et] = *(const u32x2*)(UG + t_ * GW + h_ * 64 + et * 16 + 4 * g); \
        B_ = gbs[h_ * CH + wave * 16 + col]; } while (0)
#define GM_COMP(u_, W_, V_, U_, B_) do { const int h_ = (u_) % GH, c_ = ((u_) / GH) % NCH, b_ = (u_) / (GH * NCH); \
        const size_t t_ = (size_t)(b_ * S + c_ * CH + wave * 16 + col); \
        _Pragma("unroll") for (int et = 0; et < 4; ++et) { f32x4 acc = (f32x4){0.f, 0.f, 0.f, 0.f}; \
            _Pragma("unroll") for (int ks = 0; ks < 4; ++ks) acc = MFMA16(V_[et][ks], W_[ks], acc); \
            u32x2 o_; o_.x = pk2(bf_lo(U_[et].x) * (acc[0] + B_), bf_hi(U_[et].x) * (acc[1] + B_)); o_.y = pk2(bf_lo(U_[et].y) * (acc[2] + B_), bf_hi(U_[et].y) * (acc[3] + B_)); \
            *(u32x2*)(GRP + t_ * D + h_ * 64 + et * 16 + 4 * g) = o_; } } while (0)
    int u = bid;
    if (u < NU) GM_LOAD(u, wA, vA, uA, bA);
    while (u < NU) {
        const int u1 = u + nb;
        if (u1 < NU) GM_LOAD(u1, wB, vB, uB, bB);
        GM_COMP(u, wA, vA, uA, bA);
        if (u1 >= NU) break;
        const int u2 = u1 + nb;
        if (u2 < NU) GM_LOAD(u2, wA, vA, uA, bA);
        GM_COMP(u1, wB, vB, uB, bB);
        u = u2;
    }
#undef GM_LOAD
#undef GM_COMP
}

constexpr int SC_STEPS = 16;
constexpr int SC_BUF = SC_STEPS * 6 * 64;
__device__ __forceinline__ void phase_rwkv_scan(const Params& P, int l, unsigned char* smem, int wv, int bid, int nb) {
    PIN_S(bid); PIN_S(nb);
    ParamsPtr pp = PARAMS_PTR(P); PIN_S(pp); unsigned char* ws = pp->ws;
    const float* RR = (const float*)(ws + O_RR); const float* VV = (const float*)(ws + O_VV); const float* KK = (const float*)(ws + O_KK);
    const float* DEC = (const float*)(ws + O_DEC); const float* KD = (const float*)(ws + O_KD); const float* ICLR = (const float*)(ws + O_ICLR);
    float* SCAN = (float*)(ws + O_SCAN); const float* BRKR = (const float*)(ws + O_BRKR);
    const int tid = phase_tid(wv), lane = tid & 63, wave = tid >> 6, rl = (lane >> 4) & 1, kq = (lane & 15) | ((lane >> 5) << 4);
    float* buf = (float*)smem;
    float* scal = buf + 2 * SC_BUF;
    float* outb = scal + 2 * SC_STEPS * 2;
    typedef float f32x2 __attribute__((ext_vector_type(2)));
    for (int u = bid; u < 2 * NB * RH * 4; u += nb) {
        const int qt = u & 3, h = (u >> 2) % RH, b = (u / (4 * RH)) % NB, d = u / (4 * RH * NB);
        const size_t doff = (size_t)d * T * RW;
        float s0 = 0.f, s1 = 0.f;
        float pw[2], pa[2], pb[2], pk[2], pr[2], pv[2], psc = 0.f;
#define SC_LOAD(c) do { _Pragma("unroll") for (int i = 0; i < 2; ++i) { const int idx = tid + NTHREADS * i, st = idx >> 6, k = idx & 63; const int tau = (c) * SC_STEPS + st, sq = d ? S - 1 - tau : tau; \
            const size_t o = (size_t)(b * S + sq) * RW + h * 64 + k; \
            pw[i] = DEC[doff + o]; pa[i] = KK[o]; pb[i] = ICLR[doff + o]; pk[i] = KD[doff + o]; pr[i] = RR[o]; pv[i] = VV[o]; }     \
            if (tid < 2 * SC_STEPS) { const int tau = (c) * SC_STEPS + (tid >> 1), sq = d ? S - 1 - tau : tau; psc = BRKR[((size_t)(d * T + b * S + sq) * RH + h) * 2 + (tid & 1)]; } } while (0)
#define SC_WRITE(c) do { float* B_ = buf + ((c) & 1) * SC_BUF; _Pragma("unroll") for (int i = 0; i < 2; ++i) { const int idx = tid + NTHREADS * i, st = idx >> 6, k = idx & 63; \
            float* q_ = B_ + st * 384 + k; q_[0] = pw[i]; q_[64] = -pa[i]; q_[128] = pa[i] * pb[i]; q_[192] = pk[i]; q_[256] = pw[i] * pr[i]; q_[320] = pv[i]; } \
            if (tid < 2 * SC_STEPS) scal[((c) & 1) * SC_STEPS * 2 + tid] = psc; } while (0)
        __syncthreads();
        SC_LOAD(0); SC_WRITE(0);
        __syncthreads();
        const int row = qt * 16 + wave * 2 + rl;
        for (int c = 0; c < S / SC_STEPS; ++c) {
            const bool more = (c + 1) < S / SC_STEPS;
            if (more) SC_LOAD(c + 1);
            const float* B = buf + (c & 1) * SC_BUF; const float* sc = scal + (c & 1) * SC_STEPS * 2; float* ob = outb + (c & 1) * SC_STEPS * 16;
            float outs[SC_STEPS];
            f32x2 w2 = *(const f32x2*)(B + 2 * kq), a2 = *(const f32x2*)(B + 64 + 2 * kq), b2 = *(const f32x2*)(B + 128 + 2 * kq);
            f32x2 k2 = *(const f32x2*)(B + 192 + 2 * kq), wr2 = *(const f32x2*)(B + 256 + 2 * kq);
            float v = B[320 + row]; float br = sc[0], kr = sc[1];
#pragma unroll
            for (int st = 0; st < SC_STEPS; ++st) {
                const int sn = st + 1 < SC_STEPS ? st + 1 : st;
                const float* q = B + sn * 384;
                const f32x2 nw2 = *(const f32x2*)(q + 2 * kq), na2 = *(const f32x2*)(q + 64 + 2 * kq), nb2 = *(const f32x2*)(q + 128 + 2 * kq);
                const f32x2 nk2 = *(const f32x2*)(q + 192 + 2 * kq), nwr2 = *(const f32x2*)(q + 256 + 2 * kq);
                const float nv = q[320 + row], nbr = sc[sn * 2], nkr = sc[sn * 2 + 1];
                SCHED_BAR();
                float sa = s0 * a2.x + s1 * a2.y;
                float po = s0 * wr2.x + s1 * wr2.y;
                sa = row32_sum(sa); po = row32_sum(po);
                outs[st] = po + sa * br + v * kr;
                s0 = s0 * w2.x + (sa * b2.x + v * k2.x); s1 = s1 * w2.y + (sa * b2.y + v * k2.y);
                SCHED_BAR();
                w2 = nw2; a2 = na2; b2 = nb2; k2 = nk2; wr2 = nwr2; v = nv; br = nbr; kr = nkr;
            }
            if (kq == 0) {
#pragma unroll
                for (int st = 0; st < SC_STEPS; ++st) ob[st * 16 + wave * 2 + rl] = outs[st];
            }
            if (more) SC_WRITE(c + 1);
            __syncthreads();
            if (tid < 16 * SC_STEPS) {
                const int st = tid >> 4, r = tid & 15, tau = c * SC_STEPS + st, sq = d ? S - 1 - tau : tau;
                SCAN[doff + (size_t)(b * S + sq) * RW + h * 64 + qt * 16 + r] = ob[st * 16 + r];
            }
        }
#undef SC_LOAD
#undef SC_WRITE
    }
    __syncthreads();
}

constexpr int RST = 72;
constexpr int RARR = 64 * RST;
__device__ __forceinline__ f32x4 tile_nt(const bf16_t* Aa, int ta, const bf16_t* Ba, int tb, f32x4 acc, int col, int g) {
#pragma unroll
    for (int ks = 0; ks < 2; ++ks) {
        const bf16x8 af = *(const bf16x8*)(Aa + (ta * 16 + col) * RST + ks * 32 + 8 * g);
        const bf16x8 bfr = *(const bf16x8*)(Ba + (tb * 16 + col) * RST + ks * 32 + 8 * g);
        acc = MFMA16(af, bfr, acc);
    }
    return acc;
}
__device__ __forceinline__ void phase_rwkv_pre(const Params& P, int l, unsigned char* smem, int wv) {
    ParamsPtr pp = PARAMS_PTR(P); PIN_S(pp); unsigned char* ws = pp->ws; int bidx = (int)blockIdx.x, gdim = (int)gridDim.x; PIN_S(bidx); PIN_S(gdim);
    const u32x4* RK7 = (const u32x4*)(ws + O_RK7);
    const float* LWG = (const float*)(ws + O_LW);
    bf16_t* Qg = (bf16_t*)(ws + O_RQ); bf16_t* Ag = (bf16_t*)(ws + O_RA); bf16_t* Hg = (bf16_t*)(ws + O_RH); bf16_t* Gg = (bf16_t*)(ws + O_RG);
    const int tid0 = phase_tid(wv);
#define RW_STAGE_VARS int tid = tid0; PIN_V(tid); const int lane = tid & 63, wave = tid >> 6, col = lane & 15, g = lane >> 4; (void)lane; (void)wave; (void)col; (void)g;
    bf16_t* At = (bf16_t*)smem; bf16_t* Bt = At + RARR; bf16_t* Kt = Bt + RARR; bf16_t* Rt = Kt + RARR;
    bf16_t* BtT = Rt + RARR; bf16_t* KtT = BtT + RARR; bf16_t* VT = KtT + RARR;
    bf16_t* Lak = VT + RARR; bf16_t* Mrb = Lak + RARR; bf16_t* Mrk = Mrb + RARR; bf16_t* YT = Mrk + RARR; bf16_t* W2T = YT + RARR;
    bf16_t* Lbo = W2T + RARR;
    float* LabT = (float*)(Lbo + RARR);
    float* Xs = LabT + 4096;
    float* Pb = Xs + 4096;
    float* segs = Pb + 2048;
    float* PC = segs + 512;
    float plw[8]; u32x4 prec[8];
#define RW_LOAD(uu) do { const int c_ = (uu) % RNC, h_ = ((uu) / RNC) % RH, b_ = ((uu) / (RNC * RH)) % NB, d_ = (uu) / (RNC * RH * NB); const size_t doff_ = (size_t)d_ * T * RW; \
        const int ch_ = tid0 & 63, sg_ = tid0 >> 6; _Pragma("unroll") for (int j = 0; j < 8; ++j) { const int tau = c_ * RC + sg_ * 8 + j, sq = d_ ? S - 1 - tau : tau; const size_t o = (size_t)(b_ * S + sq) * RW + h_ * 64 + ch_; \
        plw[j] = LWG[doff_ + o]; prec[j] = RK7[o]; } } while (0)
    if (bidx < RUN) RW_LOAD(bidx);
    for (int u = bidx; u < RUN; u += gdim) {
        const int c = u % RNC, h = (u / RNC) % RH, b = (u / (RNC * RH)) % NB, d = u / (RNC * RH * NB);
        (void)c; (void)h; (void)b; (void)d;
        __syncthreads();
        {
            RW_STAGE_VARS
            const int ch = tid & 63, sg = tid >> 6;
            float lw[8]; unsigned kk[8], bq_[8], kd[8], rr[8], vv[8];
#pragma unroll
            for (int j = 0; j < 8; ++j) { lw[j] = plw[j]; kk[j] = prec[j].y & 0xffffu; bq_[j] = d ? (prec[j].z >> 16) : (prec[j].z & 0xffffu); kd[j] = d ? (prec[j].w >> 16) : (prec[j].w & 0xffffu); rr[j] = prec[j].x & 0xffffu; vv[j] = prec[j].x >> 16; }
            if (u + gdim < RUN) RW_LOAD(u + gdim);
            float run = 0.f;
#pragma unroll
            for (int j = 0; j < 8; ++j) { run += lw[j]; lw[j] = run; }
            segs[sg * 64 + ch] = run;
            __syncthreads();
            float off = 0.f;
            for (int q = 0; q < sg; ++q) off += segs[q * 64 + ch];
            u32x4 pbt, pkt, pvt; unsigned tb[8], tk[8], tvv[8];
            float prev = off;
#pragma unroll
            for (int j = 0; j < 8; ++j) {
                const int t = sg * 8 + j; const float cl = off + lw[j];
                const float ep = fexp(prev), en = fexp(-cl), epc = fexp(cl);
                const unsigned a_ = f2bf(-bf_lo(kk[j]) * ep), b_ = f2bf(bf_lo(bq_[j]) * en), k_ = f2bf(bf_lo(kd[j]) * en), r_ = f2bf(bf_lo(rr[j]) * epc), v_ = vv[j];
                At[t * RST + ch] = (bf16_t)a_; Bt[t * RST + ch] = (bf16_t)b_; Kt[t * RST + ch] = (bf16_t)k_; Rt[t * RST + ch] = (bf16_t)r_;
                tb[j] = b_; tk[j] = k_; tvv[j] = v_;
                prev = cl;
            }
            if (sg == 7) PC[ch] = fexp(prev);
            pbt.x = tb[0] | (tb[1] << 16); pbt.y = tb[2] | (tb[3] << 16); pbt.z = tb[4] | (tb[5] << 16); pbt.w = tb[6] | (tb[7] << 16);
            pkt.x = tk[0] | (tk[1] << 16); pkt.y = tk[2] | (tk[3] << 16); pkt.z = tk[4] | (tk[5] << 16); pkt.w = tk[6] | (tk[7] << 16);
            pvt.x = tvv[0] | (tvv[1] << 16); pvt.y = tvv[2] | (tvv[3] << 16); pvt.z = tvv[4] | (tvv[5] << 16); pvt.w = tvv[6] | (tvv[7] << 16);
            *(u32x4*)(BtT + ch * RST + sg * 8) = pbt; *(u32x4*)(KtT + ch * RST + sg * 8) = pkt; *(u32x4*)(VT + ch * RST + sg * 8) = pvt;
            for (int z_ = tid; z_ < 2 * RARR / 8; z_ += NTHREADS) ((u32x4*)YT)[z_] = (u32x4){0u, 0u, 0u, 0u};
        }
        __syncthreads();
        {
            RW_STAGE_VARS
            const int m = wave >> 1;
            const bf16_t* Ym = (m == 0 || m == 2) ? Bt : Kt; const bf16_t* Xm = (m < 2) ? At : Rt;
#pragma unroll 1
            for (int q = 0; q < 8; ++q) {
                const int tix = (wave & 1) * 8 + q, it = tix >> 2, tt = tix & 3;
                f32x4 acc = (f32x4){0.f, 0.f, 0.f, 0.f};
                if (it <= tt) acc = tile_nt(Ym, it, Xm, tt, acc, col, g);
                const int t = tt * 16 + col, i0 = it * 16 + 4 * g;
                float o4[4];
#pragma unroll
                for (int r = 0; r < 4; ++r) { const int i = i0 + r; const bool ok = m < 2 ? (i < t) : (i <= t); o4[r] = ok ? acc[r] : 0.f; }
                if (m == 0) {
#pragma unroll
                    for (int r = 0; r < 4; ++r) LabT[(i0 + r) * 64 + t] = o4[r];
                    const bool offd = it < tt;
                    u32x2 w2; w2.x = offd ? pk2(o4[0], o4[1]) : 0u; w2.y = offd ? pk2(o4[2], o4[3]) : 0u; *(u32x2*)(Lbo + t * RST + i0) = w2;
                }
                else { bf16_t* dst = (m == 1 ? Lak : (m == 2 ? Mrb : Mrk)) + t * RST + i0; u32x2 w2; w2.x = pk2(o4[0], o4[1]); w2.y = pk2(o4[2], o4[3]); *(u32x2*)dst = w2; }
            }
        }
        __syncthreads();
        {
            RW_STAGE_VARS
#pragma unroll
            for (int q = 0; q < 2; ++q) {
                const int tix = wave * 2 + q, tt = tix >> 2, et = tix & 3;
                f32x4 acc = (f32x4){0.f, 0.f, 0.f, 0.f};
                acc = tile_nt(Lak, tt, VT, et, acc, col, g);
#pragma unroll
                for (int r = 0; r < 4; ++r) Xs[(tt * 16 + 4 * g + r) * 64 + et * 16 + col] = acc[r];
            }
        }
        __syncthreads();
        {
            RW_STAGE_VARS
#pragma unroll 1
            for (int bb = 0; bb < 4; ++bb) {
                if (bb > 0) {
                    const bf16_t* Zt = (wave < 4 ? YT : W2T) + ((wave & 3) * 16 + col) * RST + 8 * g;
                    const bf16_t* La = Lbo + (16 * bb + col) * RST + 8 * g;
                    f32x4 acc = (f32x4){0.f, 0.f, 0.f, 0.f};
                    acc = MFMA16(*(const bf16x8*)La, *(const bf16x8*)Zt, acc);
                    if (bb > 2) acc = MFMA16(*(const bf16x8*)(La + 32), *(const bf16x8*)(Zt + 32), acc);
#pragma unroll
                    for (int r = 0; r < 4; ++r) Pb[(4 * g + r) * 128 + wave * 16 + col] = acc[r];
                }
                __syncthreads();
                if (wave < 2) {
                    float acc[16];
                    if (wave == 0) {
#pragma unroll
                        for (int r = 0; r < 16; ++r) acc[r] = bf_lo((unsigned)At[(16 * bb + r) * RST + lane]);
                    } else {
#pragma unroll
                        for (int r = 0; r < 16; ++r) acc[r] = Xs[(16 * bb + r) * 64 + lane];
                    }
                    if (bb > 0) {
#pragma unroll
                        for (int r = 0; r < 16; ++r) acc[r] += Pb[r * 128 + wave * 64 + lane];
                    }
                    const float* dp = LabT + (16 * bb) * 64 + 16 * bb;
#pragma unroll
                    for (int r = 1; r < 16; ++r)
#pragma unroll
                        for (int r2 = 0; r2 < r; ++r2) acc[r] += dp[r2 * 64 + r] * acc[r2];
                    bf16_t* dst = (wave == 0 ? YT : W2T) + lane * RST;
                    u32x4 w0, w1;
                    w0.x = pk2(acc[0], acc[1]); w0.y = pk2(acc[2], acc[3]); w0.z = pk2(acc[4], acc[5]); w0.w = pk2(acc[6], acc[7]);
                    w1.x = pk2(acc[8], acc[9]); w1.y = pk2(acc[10], acc[11]); w1.z = pk2(acc[12], acc[13]); w1.w = pk2(acc[14], acc[15]);
                    *(u32x4*)(dst + 16 * bb) = w0; *(u32x4*)(dst + 16 * bb + 8) = w1;
                }
                __syncthreads();
            }
        }
        __syncthreads();
        {
            RW_STAGE_VARS
            const int ty = wave >> 1;
#pragma unroll 1
            for (int q = 0; q < 8; ++q) {
                const int tix = (wave & 1) * 8 + q, ra = tix >> 2, cb = tix & 3;
                f32x4 acc = (f32x4){0.f, 0.f, 0.f, 0.f};
                if (ty == 0) {
                    acc = tile_nt(YT, ra, Mrb, cb, acc, col, g);
                    const u32x2 rt2 = *(const u32x2*)(Rt + (cb * 16 + col) * RST + ra * 16 + 4 * g);
                    u32x2 qb2; qb2.x = pk2(acc[0] + bf_lo(rt2.x), acc[1] + bf_hi(rt2.x)); qb2.y = pk2(acc[2] + bf_lo(rt2.y), acc[3] + bf_hi(rt2.y));
                    *(u32x2*)(Qg + (size_t)u * 4096 + ((((ra >> 1) * 4 + cb) * 64 + lane) * 8 + (ra & 1) * 4)) = qb2;
                } else if (ty == 1) {
                    acc = tile_nt(Mrb, ra, W2T, cb, acc, col, g); acc = tile_nt(Mrk, ra, VT, cb, acc, col, g);
                    { u32x2 hb; hb.x = pk2(acc[0], acc[1]); hb.y = pk2(acc[2], acc[3]); *(u32x2*)(Hg + (size_t)u * 4096 + (tix * 64 + lane) * 4) = hb; }
                } else if (ty == 2) {
                    acc = tile_nt(YT, ra, BtT, cb, acc, col, g);
                    const float pc = PC[cb * 16 + col]; const int k1 = cb * 16 + col;
                    float a4[4];
#pragma unroll
                    for (int r = 0; r < 4; ++r) a4[r] = pc * (acc[r] + ((ra * 16 + 4 * g + r) == k1 ? 1.0f : 0.f));
                    u32x2 ab2; ab2.x = pk2(a4[0], a4[1]); ab2.y = pk2(a4[2], a4[3]);
                    *(u32x2*)(Ag + (size_t)u * 4096 + ((((ra >> 1) * 4 + cb) * 64 + lane) * 8 + (ra & 1) * 4)) = ab2;
                } else {
                    acc = tile_nt(BtT, ra, W2T, cb, acc, col, g); acc = tile_nt(KtT, ra, VT, cb, acc, col, g);
#pragma unroll
                    for (int r = 0; r < 4; ++r) acc[r] *= PC[ra * 16 + 4 * g + r];
                    { u32x2 gb2; gb2.x = pk2(acc[0], acc[1]); gb2.y = pk2(acc[2], acc[3]); *(u32x2*)(Gg + (size_t)u * 4096 + (tix * 64 + lane) * 4) = gb2; }
                }
            }
        }
    }
    __syncthreads();
#undef RW_STAGE_VARS
#undef RW_LOAD
}
constexpr int RSEQ_WGS = 2 * NB * RH * 2;
template <int MODE = 0>
__device__ __forceinline__ void phase_rwkv_seq(const Params& P, int l, unsigned char* smem, int wv) {
    ParamsPtr pp = PARAMS_PTR(P); PIN_S(pp); unsigned char* ws = pp->ws; int bidx = (int)blockIdx.x, gdim = (int)gridDim.x; PIN_S(bidx); PIN_S(gdim);
    const bf16_t* Ag = (const bf16_t*)(ws + O_RA); const bf16_t* Gg = (const bf16_t*)(ws + O_RG); bf16_t* Sg = (bf16_t*)(ws + ((MODE & 4) ? O_XS : O_RS));
    const int tid = phase_tid(wv), lane = tid & 63, wave = tid >> 6, col = lane & 15, g = lane >> 4;
    if (wave >= 2) return;
    const int nwg = gdim < RSEQ_WGS ? gdim : RSEQ_WGS;
    if (bidx >= nwg) return;
    for (int un = wave * nwg + bidx; un < 2 * NB * RH * 4; un += 2 * nwg) {
        const int ch = un >> 2, eq = un & 3;
        f32x4 acc[4];
#pragma unroll
        for (int a_ = 0; a_ < 4; ++a_) acc[a_] = (f32x4){0.f, 0.f, 0.f, 0.f};
        u32x4 a0[4][2], a1[4][2], a2[4][2], a3[4][2]; u32x2 g0[4], g1[4], g2[4], g3[4];
        const unsigned aoff = (unsigned)(col * 64 + 16 * g), goff = (unsigned)(lane * 4), aoff8 = (unsigned)(lane * 8);
#define RS_LOAD(cc, AF, GQ) do { const int c_ = (cc) < RNC ? (cc) : RNC - 1; const bf16_t* ab_ = Ag + (size_t)(ch * RNC + c_) * 4096; const bf16_t* gb_ = Gg + (size_t)(ch * RNC + c_) * 4096 + eq * 256; \
            _Pragma("unroll") for (int ra = 0; ra < 4; ++ra) _Pragma("unroll") for (int p = 0; p < 2; ++p) AF[ra][p] = *(const u32x4*)(ab_ + ((p * 4 + ra) * 512) + aoff8); \
            _Pragma("unroll") for (int ra = 0; ra < 4; ++ra) GQ[ra] = *(const u32x2*)(gb_ + (ra * 1024) + goff); } while (0)
#define RS_STEP(c, AF, GQ) do { if (RNC % 4 == 0 || (c) < RNC) { SCHED_BAR(); bf16_t* sb_ = Sg + (size_t)(ch * RNC + (c)) * 4096 + eq * 1024; \
            bf16x8 bq[2]; _Pragma("unroll") for (int p = 0; p < 2; ++p) bq[p] = cvt8(acc[2 * p], acc[2 * p + 1]); \
            if (!(MODE & 1) || (c) == RNC - 1) { _Pragma("unroll") for (int p = 0; p < 2; ++p) *(bf16x8*)(sb_ + (p * 8) + aoff) = bq[p]; } \
            _Pragma("unroll") for (int ra = 0; ra < 4; ++ra) acc[ra] = (f32x4){bf_lo(GQ[ra].x), bf_hi(GQ[ra].x), bf_lo(GQ[ra].y), bf_hi(GQ[ra].y)}; \
            _Pragma("unroll") for (int ra = 0; ra < 4; ++ra) _Pragma("unroll") for (int p = 0; p < 2; ++p) acc[ra] = MFMA16(__builtin_bit_cast(bf16x8, AF[ra][p]), bq[p], acc[ra]); \
            if (!(MODE & 2)) RS_LOAD((c) + 4, AF, GQ); SCHED_BAR(); } } while (0)
        RS_LOAD(0, a0, g0); RS_LOAD(1, a1, g1); RS_LOAD(2, a2, g2); RS_LOAD(3, a3, g3);
#pragma unroll 1
        for (int c = 0; c < RNC; c += 4) { RS_STEP(c, a0, g0); RS_STEP(c + 1, a1, g1); RS_STEP(c + 2, a2, g2); RS_STEP(c + 3, a3, g3); }
#undef RS_LOAD
#undef RS_STEP
    }
}
__device__ __forceinline__ void phase_rwkv_out(const Params& P, int l, unsigned char* smem, int wv) {
    ParamsPtr pp = PARAMS_PTR(P); PIN_S(pp); unsigned char* ws = pp->ws; int bidx = (int)blockIdx.x, gdim = (int)gridDim.x; PIN_S(bidx); PIN_S(gdim);
    const bf16_t* Qg = (const bf16_t*)(ws + O_RQ); const bf16_t* Sg = (const bf16_t*)(ws + O_RS); const bf16_t* Hg = (const bf16_t*)(ws + O_RH);
    const bf16_t* VB = (const bf16_t*)(ws + O_VB); const bf16_t* GATE = (const bf16_t*)(ws + O_GATE); const float* BONUS = (const float*)(ws + O_BONUS);
    bf16_t* GRP = (bf16_t*)(ws + O_GRP);
    const float* rln_g = pp->in[15] + (size_t)l * RW; const float* rln_b = pp->in[16] + (size_t)l * RW;
    const int tid = phase_tid(wv), lane = tid & 63, wave = tid >> 6, col = lane & 15, g = lane >> 4;
    for (int pu = bidx * NWAVES + wave; pu < NB * RH * RNC; pu += gdim * NWAVES) {
        const int c = pu % RNC, h = (pu / RNC) % RH, b = pu / (RNC * RH);
        f32x4 o[2][4][4];
#pragma unroll
        for (int d = 0; d < 2; ++d) {
            const int u = ((d * NB + b) * RH + h) * RNC + (d ? RNC - 1 - c : c);
            const size_t ub = (size_t)u * 4096;
            bf16x8 qa[4][2], sb[4][2];
#pragma unroll
            for (int q = 0; q < 4; ++q)
#pragma unroll
                for (int ks = 0; ks < 2; ++ks) {
                    qa[q][ks] = *(const bf16x8*)(Qg + ub + ((ks * 4 + q) * 64 + lane) * 8);
                    sb[q][ks] = *(const bf16x8*)(Sg + ub + (q * 16 + col) * 64 + 16 * g + 8 * ks);
                }
#pragma unroll
            for (int tt = 0; tt < 4; ++tt)
#pragma unroll
                for (int et = 0; et < 4; ++et) {
                    const u32x2 hb = *(const u32x2*)(Hg + ub + ((tt * 4 + et) * 64 + lane) * 4);
                    f32x4 acc = (f32x4){bf_lo(hb.x), bf_hi(hb.x), bf_lo(hb.y), bf_hi(hb.y)};
#pragma unroll
                    for (int ks = 0; ks < 2; ++ks) acc = MFMA16(qa[tt][ks], sb[et][ks], acc);
                    o[d][tt][et] = acc;
                }
        }
        const int src = (3 - g) * 16 + col;
#pragma unroll
        for (int tt = 0; tt < 4; ++tt)
#pragma unroll
            for (int et = 0; et < 4; ++et)
#pragma unroll
                for (int r = 0; r < 4; ++r) o[0][tt][et][r] += SHL(o[1][3 - tt][et][3 - r], src);
        float* tile = (float*)smem + wave * (64 * 68);
        WAVE_SYNC();
#pragma unroll
        for (int tt = 0; tt < 4; ++tt)
#pragma unroll
            for (int et = 0; et < 4; ++et)
#pragma unroll
                for (int r = 0; r < 4; ++r) tile[(tt * 16 + 4 * g + r) * 68 + et * 16 + col] = o[0][tt][et][r];
        WAVE_SYNC();
        {
            const int c4 = (lane & 15) * 4, ch = h * 64 + c4;
            const f32x4 lg = *(const f32x4*)(rln_g + ch), lb = *(const f32x4*)(rln_b + ch);
#pragma unroll 1
            for (int qb = 0; qb < 2; ++qb) {
                u32x2 gt_[8]; u32x2 vb_[8]; float bo_[8];
#pragma unroll
                for (int q8 = 0; q8 < 8; ++q8) {
                    const size_t t = (size_t)(b * S + c * RC + (qb * 8 + q8) * 4 + (lane >> 4));
                    gt_[q8] = *(const u32x2*)(GATE + t * RW + ch); vb_[q8] = *(const u32x2*)(VB + t * RW + ch); bo_[q8] = BONUS[t * RH + h];
                }
#pragma unroll
                for (int q8 = 0; q8 < 8; ++q8) {
                    const int tl = (qb * 8 + q8) * 4 + (lane >> 4);
                    const size_t t = (size_t)(b * S + c * RC + tl);
                    const f32x4 x = *(const f32x4*)(tile + tl * 68 + c4);
                    const float mean = row16_sum((x.x + x.y) + (x.z + x.w)) * (1.0f / 64.0f);
                    const f32x4 dl = x - mean;
                    const float var = row16_sum((dl.x * dl.x + dl.y * dl.y) + (dl.z * dl.z + dl.w * dl.w)) * (1.0f / 64.0f);
                    const float rstd = 1.0f / sqrtf(var + GN_EPS);
                    f32x4 y = dl * rstd * lg + lb;
                    y.x += bo_[q8] * bf_lo(vb_[q8].x); y.y += bo_[q8] * bf_hi(vb_[q8].x); y.z += bo_[q8] * bf_lo(vb_[q8].y); y.w += bo_[q8] * bf_hi(vb_[q8].y);
                    y = y * (f32x4){bf_lo(gt_[q8].x), bf_hi(gt_[q8].x), bf_lo(gt_[q8].y), bf_hi(gt_[q8].y)};
                    u32x2 ob; ob.x = pk2(y.x, y.y); ob.y = pk2(y.z, y.w);
                    *(u32x2*)(GRP + t * D + GW + ch) = ob;
                }
            }
        }
    }
    __syncthreads();
}

__device__ __forceinline__ void phase_mlstm_local(const Params& P, int l, unsigned char* smem, int wv, int bid, int nb) {
    PIN_S(bid); PIN_S(nb);
    ParamsPtr pp = PARAMS_PTR(P); PIN_S(pp); unsigned char* ws = pp->ws;
    const bf16_t* KT = (const bf16_t*)(ws + O_KT); const bf16_t* VT = (const bf16_t*)(ws + O_VT);
    const float* IG = (const float*)(ws + O_IG); const float* LF = (const float*)(ws + O_LF);
    float* CL = (float*)(ws + O_CL); float* NLb = (float*)(ws + O_NL); float* ML = (float*)(ws + O_ML); float* BL = (float*)(ws + O_BL);
    float* GVT = (float*)(ws + O_GVT); float* PMX = (float*)(ws + O_PMX); float* BCT = (float*)(ws + O_BCT);
    const int tid = phase_tid(wv), lane = tid & 63, wave = tid >> 6, col = lane & 15, g = lane >> 4;
    float* wts = (float*)smem + wave * 128;
    for (int u = bid * NWAVES + wave; u < 2 * NB * MH * NCH; u += nb * NWAVES) {
        const int c = u % NCH, h = (u / NCH) % MH, p = u / (NCH * MH), d = p / NB, b = p % NB;
        const int tc = d ? NCH - 1 - c : c, tok0 = b * S + tc * CH;
        const int i0 = d ? 127 - 2 * lane : 2 * lane, i1 = d ? i0 - 1 : i0 + 1;
        const size_t g0 = ((size_t)d * T + tok0 + i0) * MH + h, g1 = ((size_t)d * T + tok0 + i1) * MH + h;
        const float lf0 = LF[g0], lf1 = LF[g1], ig0 = IG[g0], ig1 = IG[g1];
        const float c1 = lf0 + lf1;
        float incl = c1;
#pragma unroll
        for (int o = 1; o < 64; o <<= 1) { const float tq = SHUP(incl, o, lane); if (lane >= o) incl += tq; }
        const float excl = incl - c1, bc0 = excl + lf0, bc1 = incl;
        const float blast = RDL(incl, 63);
        const float gv0 = ig0 - bc0, gv1 = ig1 - bc1, pl1 = fmaxf(gv0, gv1);
        float mincl = pl1;
#pragma unroll
        for (int o = 1; o < 64; o <<= 1) { const float tq = SHUP(mincl, o, lane); if (lane >= o) mincl = fmaxf(mincl, tq); }
        float mexcl = SHUP(mincl, 1, lane); if (lane == 0) mexcl = -INFINITY;
        const float pm0 = fmaxf(mexcl, gv0), pm1 = mincl;
        const float mloc = blast + RDL(mincl, 63);
        WAVE_SYNC();
        wts[i0] = fexp(blast + gv0 - mloc); wts[i1] = fexp(blast + gv1 - mloc);
        GVT[g0] = gv0; GVT[g1] = gv1; PMX[g0] = pm0; PMX[g1] = pm1; BCT[g0] = bc0; BCT[g1] = bc1;
        if (lane == 0) { ML[u] = mloc; BL[u] = blast; }
        WAVE_SYNC();
        const bf16_t* vbase = VT + ((size_t)(b * MH + h) * 64) * S + (size_t)tc * CH;
        const bf16_t* kbase = KT + ((size_t)(b * MH + h) * 64) * S + (size_t)tc * CH;
        const unsigned loff = (unsigned)(col * S + 8 * g);
        f32x4 acc[4][4];
#pragma unroll
        for (int a_ = 0; a_ < 4; ++a_)
#pragma unroll
            for (int b_ = 0; b_ < 4; ++b_) acc[a_][b_] = (f32x4){0.f, 0.f, 0.f, 0.f};
        float nsum[4] = {0.f, 0.f, 0.f, 0.f};
#pragma unroll 1
        for (int ks = 0; ks < 4; ++ks) {
            const int ii = ks * 32 + 8 * g;
            const f32x4 w0 = *(const f32x4*)(wts + ii), w1 = *(const f32x4*)(wts + ii + 4);
            bf16x8 af[4], bfk[4];
#pragma unroll
            for (int q = 0; q < 4; ++q) af[q] = *(const bf16x8*)(vbase + ((size_t)q * 16 * S + ks * 32) + loff);
#pragma unroll
            for (int q = 0; q < 4; ++q) {
                const u32x4 kr = *(const u32x4*)(kbase + ((size_t)q * 16 * S + ks * 32) + loff);
                f32x4 k0, k1;
                k0.x = bf_lo(kr.x) * w0.x; k0.y = bf_hi(kr.x) * w0.y; k0.z = bf_lo(kr.y) * w0.z; k0.w = bf_hi(kr.y) * w0.w;
                k1.x = bf_lo(kr.z) * w1.x; k1.y = bf_hi(kr.z) * w1.y; k1.z = bf_lo(kr.w) * w1.z; k1.w = bf_hi(kr.w) * w1.w;
                nsum[q] += (k0.x + k0.y) + (k0.z + k0.w) + (k1.x + k1.y) + (k1.z + k1.w);
                bfk[q] = cvt8(k0, k1);
            }
#pragma unroll
            for (int a_ = 0; a_ < 4; ++a_)
#pragma unroll
                for (int b_ = 0; b_ < 4; ++b_) acc[a_][b_] = MFMA16(af[a_], bfk[b_], acc[a_][b_]);
        }
        float* cbase = CL + (size_t)u * 4096;
        const unsigned coff = (unsigned)(4 * g * 64 + col);
#pragma unroll
        for (int b_ = 0; b_ < 4; ++b_) {
#pragma unroll
            for (int a_ = 0; a_ < 4; ++a_)
#pragma unroll
                for (int r = 0; r < 4; ++r) cbase[(a_ * 16 * 64 + r * 64 + b_ * 16) + coff] = acc[a_][b_][r];
            float ns = nsum[b_]; ns += SHX(ns, 16, lane); ns += SHX(ns, 32, lane);
            if (g == 0) NLb[(size_t)u * 64 + b_ * 16 + col] = ns;
        }
    }
    __syncthreads();
}

__device__ __forceinline__ void phase_mlstm_carry(const Params& P, int l, unsigned char* smem, int wv, int bidx, int gdim) {
    ParamsPtr pp = PARAMS_PTR(P); PIN_S(pp); unsigned char* ws = pp->ws; PIN_S(bidx); PIN_S(gdim);
    float* CL = (float*)(ws + O_CL); float* NLb = (float*)(ws + O_NL); const float* ML = (const float*)(ws + O_ML); const float* BL = (const float*)(ws + O_BL);
    float* MIN = (float*)(ws + O_MIN);
    const int total = 2 * NB * MH * 4160;
    const int tid = phase_tid(wv);
    for (int gi = bidx * NTHREADS + tid; gi < total; gi += gdim * NTHREADS) {
        const int ph = gi / 4160, e = gi % 4160;
        float* base_ = e < 4096 ? CL + (size_t)ph * NCH * 4096 + e : NLb + (size_t)ph * NCH * 64 + (e - 4096);
        bf16_t* cb_ = (bf16_t*)(ws + O_CLB) + (size_t)ph * NCH * 4096 + e;
        const int stride = e < 4096 ? 4096 : 64;
        static_assert(NCH <= 32, "carry scan keeps one chunk value per register");
        float loc[NCH], bl[NCH], ml[NCH];
#pragma unroll
        for (int c = 0; c < NCH; ++c) { loc[c] = base_[(size_t)c * stride]; bl[c] = BL[ph * NCH + c]; ml[c] = ML[ph * NCH + c]; }
        float m = 0.f, val = 0.f;
#pragma unroll
        for (int c = 0; c < NCH; ++c) {
            if (e < 4096) cb_[(size_t)c * 4096] = (bf16_t)f2bf(val); else base_[(size_t)c * stride] = val;
            if (e == 0) MIN[ph * NCH + c] = m;
            const float mn = fmaxf(bl[c] + m, ml[c]);
            val = fexp(bl[c] + m - mn) * val + fexp(ml[c] - mn) * loc[c];
            m = mn;
        }
    }
}

__device__ __forceinline__ void phase_mlstm_out(const Params& P, int l, unsigned char* smem, int wv) {
    ParamsPtr pp = PARAMS_PTR(P); PIN_S(pp); unsigned char* ws = pp->ws; int bidx = (int)blockIdx.x, gdim = (int)gridDim.x; PIN_S(bidx); PIN_S(gdim);
    const bf16_t* proj = (const bf16_t*)(ws + O_PROJ);
    const bf16_t* MQB = (const bf16_t*)(ws + O_MQB); const bf16_t* MKB = (const bf16_t*)(ws + O_MKB); const bf16_t* VT = (const bf16_t*)(ws + O_VT);
    const float* GVT = (const float*)(ws + O_GVT); const float* PMX = (const float*)(ws + O_PMX); const float* BCT = (const float*)(ws + O_BCT);
    const bf16_t* CLB = (const bf16_t*)(ws + O_CLB); const float* NLb = (const float*)(ws + O_NL); const float* MIN = (const float*)(ws + O_MIN);
    bf16_t* GRP = (bf16_t*)(ws + O_GRP);
    const float* mln_g = pp->in[20] + (size_t)l * MW;
    const int tid = phase_tid(wv), lane = tid & 63, wave = tid >> 6, col = lane & 15, g = lane >> 4;
    constexpr int KP = 72, VP = 136, STG = 128 * KP * 2 + 64 * VP * 2 + 2 * 128 * 4;
    constexpr int NUm = NB * MH * NCH;
    const int it = wave * 16 + col;
    u32x4 kb_[2], vb_[2]; float gq_ = 0.f; bf16x8 bqn[2]; float minn[2], pmxn[2], bctn[2];
#define MO_EARLY(u_) do { const int tc_ = (u_) % NCH, h_ = ((u_) / NCH) % MH, b_ = (u_) / (NCH * MH); const int tok0_ = b_ * S + tc_ * CH; \
        _Pragma("unroll") for (int q = 0; q < 2; ++q) { const int idx = tid + q * NTHREADS; \
            kb_[q] = *(const u32x4*)(MKB + (size_t)(tok0_ + (idx >> 3)) * MW + h_ * 64 + (idx & 7) * 8); \
            vb_[q] = *(const u32x4*)(VT + ((size_t)(b_ * MH + h_) * 64 + (idx >> 4)) * S + (size_t)tc_ * CH + (idx & 15) * 8); } \
        if (tid < 256) gq_ = GVT[((size_t)(tid >> 7) * T + tok0_ + (tid & 127)) * MH + h_]; \
        const size_t trow_ = (size_t)(tok0_ + it); \
        _Pragma("unroll") for (int ks = 0; ks < 2; ++ks) bqn[ks] = *(const bf16x8*)(MQB + trow_ * MW + h_ * 64 + ks * 32 + 8 * g); \
        _Pragma("unroll") for (int d = 0; d < 2; ++d) { const int su_ = ((d * NB + b_) * MH + h_) * NCH + (d ? NCH - 1 - tc_ : tc_); const size_t gt_ = ((size_t)d * T + trow_) * MH + h_; \
            minn[d] = MIN[su_]; pmxn[d] = PMX[gt_]; bctn[d] = BCT[gt_]; } } while (0)
    int u = bidx, ui = 0;
    if (u < NUm) MO_EARLY(u);
    for (; u < NUm; u += gdim, ++ui) {
        const int tc = u % NCH, h = (u / NCH) % MH, b = u / (NCH * MH);
        const int tok0 = b * S + tc * CH;
        bf16_t* Ks = (bf16_t*)(smem + (ui & 1) * STG);
        bf16_t* Vs = Ks + 128 * KP;
        float* gvs_ = (float*)(Vs + 64 * VP);
#pragma unroll
        for (int q = 0; q < 2; ++q) {
            const int idx = tid + q * NTHREADS;
            *(u32x4*)(Ks + (idx >> 3) * KP + (idx & 7) * 8) = kb_[q];
            *(u32x4*)(Vs + (idx >> 4) * VP + (idx & 15) * 8) = vb_[q];
        }
        if (tid < 256) gvs_[tid] = gq_;
        bf16x8 bq[2] = {bqn[0], bqn[1]};
        const float mst_[2] = {minn[0], minn[1]}, pmx_[2] = {pmxn[0], pmxn[1]}, bct_[2] = {bctn[0], bctn[1]};
        const size_t trow = (size_t)(tok0 + it);
        bf16x8 cq[2][4][2]; f32x4 nl[2][2][2]; u32x2 og[4];
#define MO_LATE(d) do { const int su = (((d) * NB + b) * MH + h) * NCH + ((d) ? NCH - 1 - tc : tc); \
            _Pragma("unroll") for (int ks = 0; ks < 2; ++ks) { const float* np = NLb + (size_t)su * 64 + ks * 32 + 8 * g; \
                nl[d][ks][0] = *(const f32x4*)np; nl[d][ks][1] = *(const f32x4*)(np + 4); \
                _Pragma("unroll") for (int et = 0; et < 4; ++et) cq[d][et][ks] = *(const bf16x8*)(CLB + (size_t)su * 4096 + (size_t)(et * 16 + col) * 64 + ks * 32 + 8 * g); } } while (0)
        MO_LATE(0);
#pragma unroll
        for (int et = 0; et < 4; ++et) og[et] = *(const u32x2*)(proj + trow * PLD + C_MW + 3 * MW + h * 64 + et * 16 + 4 * g);
        __syncthreads();
        if (u + gdim < NUm) MO_EARLY(u + gdim);
        f32x4 hs[4];
#pragma unroll
        for (int et = 0; et < 4; ++et) hs[et] = (f32x4){0.f, 0.f, 0.f, 0.f};
#pragma unroll
        for (int d = 0; d < 2; ++d) {
            if (d == 1) MO_LATE(1);
            const float mst = mst_[d];
            const float mxt = fmaxf(pmx_[d], mst), mt = bct_[d] + mxt, wint = fexp(mst - mxt);
            f32x4 num[4];
#pragma unroll
            for (int et = 0; et < 4; ++et) num[et] = (f32x4){0.f, 0.f, 0.f, 0.f};
            float den = 0.f;
            for (int sp = 0; sp < 4; ++sp) {
                if (d == 0 ? (2 * sp > wave) : (2 * sp + 1 < wave)) continue;
                float pw[8];
#pragma unroll
                for (int hf = 0; hf < 2; ++hf) {
                    const int st = 2 * sp + hf;
                    f32x4 sacc = (f32x4){0.f, 0.f, 0.f, 0.f};
#pragma unroll
                    for (int ks = 0; ks < 2; ++ks) sacc = MFMA16(*(const bf16x8*)(Ks + (st * 16 + col) * KP + ks * 32 + 8 * g), bq[ks], sacc);
                    const f32x4 g4 = *(const f32x4*)(gvs_ + d * 128 + st * 16 + 4 * g);
#pragma unroll
                    for (int r = 0; r < 4; ++r) {
                        const int is = st * 16 + 4 * g + r;
                        const bool ok = d == 0 ? (is <= it) : (is >= it);
                        const float pr = ok ? sacc[r] * fexp(g4[r] - mxt) : 0.f;
                        den += pr; pw[hf * 4 + r] = pr;
                    }
                }
                u32x4 pb; pb.x = pk2(pw[0], pw[1]); pb.y = pk2(pw[2], pw[3]); pb.z = pk2(pw[4], pw[5]); pb.w = pk2(pw[6], pw[7]);
                const bf16x8 bp = __builtin_bit_cast(bf16x8, pb);
#pragma unroll
                for (int et = 0; et < 4; ++et) {
                    const bf16_t* vp = Vs + (et * 16 + col) * VP + sp * 32 + 4 * g;
                    const u32x2 v0 = *(const u32x2*)vp, v1 = *(const u32x2*)(vp + 16);
                    u32x4 va; va.x = v0.x; va.y = v0.y; va.z = v1.x; va.w = v1.y;
                    num[et] = MFMA16(__builtin_bit_cast(bf16x8, va), bp, num[et]);
                }
            }
            den += SHX(den, 16, lane); den += SHX(den, 32, lane);
            f32x4 qc[4]; float qn = 0.f;
#pragma unroll
            for (int ks = 0; ks < 2; ++ks) {
                const f32x4 n0 = nl[d][ks][0], n1 = nl[d][ks][1];
                const u32x4 qb = __builtin_bit_cast(u32x4, bq[ks]);
                qn += (bf_lo(qb.x) * n0.x + bf_hi(qb.x) * n0.y) + (bf_lo(qb.y) * n0.z + bf_hi(qb.y) * n0.w) + (bf_lo(qb.z) * n1.x + bf_hi(qb.z) * n1.y) + (bf_lo(qb.w) * n1.z + bf_hi(qb.w) * n1.w);
            }
            qn += SHX(qn, 16, lane); qn += SHX(qn, 32, lane);
#pragma unroll
            for (int et = 0; et < 4; ++et) {
                qc[et] = (f32x4){0.f, 0.f, 0.f, 0.f};
#pragma unroll
                for (int ks = 0; ks < 2; ++ks) qc[et] = MFMA16(cq[d][et][ks], bq[ks], qc[et]);
            }
            const float dd = frcp(fmaxf(fabsf(den + wint * qn), fexp(-mt)));
#pragma unroll
            for (int et = 0; et < 4; ++et) hs[et] += (num[et] + wint * qc[et]) * dd;
        }
        float sm = 0.f;
#pragma unroll
        for (int et = 0; et < 4; ++et) sm += (hs[et].x + hs[et].y) + (hs[et].z + hs[et].w);
        sm += SHX(sm, 16, lane); sm += SHX(sm, 32, lane);
        const float mean = sm * (1.0f / 64.0f); float q = 0.f;
#pragma unroll
        for (int et = 0; et < 4; ++et) { const f32x4 dl = hs[et] - mean; q += (dl.x * dl.x + dl.y * dl.y) + (dl.z * dl.z + dl.w * dl.w); }
        q += SHX(q, 16, lane); q += SHX(q, 32, lane);
        const float rstd = 1.0f / sqrtf(q * (1.0f / 64.0f) + LN_EPS);
#pragma unroll
        for (int et = 0; et < 4; ++et) {
            const int c = h * 64 + et * 16 + 4 * g;
            const u32x2 ob_ = og[et]; const f32x4 o4 = (f32x4){bf_lo(ob_.x), bf_hi(ob_.x), bf_lo(ob_.y), bf_hi(ob_.y)}, g4 = *(const f32x4*)(mln_g + c);
            const f32x4 y = (hs[et] - mean) * rstd * g4;
            u32x2 ob; ob.x = pk2(sigmoidf_(o4.x) * y.x, sigmoidf_(o4.y) * y.y); ob.y = pk2(sigmoidf_(o4.z) * y.z, sigmoidf_(o4.w) * y.w);
            *(u32x2*)(GRP + trow * D + GW + RW + c) = ob;
        }
    }
#undef MO_EARLY
#undef MO_LATE
    __syncthreads();
}

__device__ __forceinline__ void phase_rwkv_post(const Params& P, int l, unsigned char* smem, int wv) {
    ParamsPtr pp = PARAMS_PTR(P); PIN_S(pp); unsigned char* ws = pp->ws; int bidx = (int)blockIdx.x, gdim = (int)gridDim.x; PIN_S(bidx); PIN_S(gdim);
    const float* SCAN = (const float*)(ws + O_SCAN); const float* VV = (const float*)(ws + O_VV); const float* GATE = (const float*)(ws + O_GATE);
    const float* BONUS = (const float*)(ws + O_BONUS); bf16_t* GRP = (bf16_t*)(ws + O_GRP);
    const float* rln_g = pp->in[15] + (size_t)l * RW; const float* rln_b = pp->in[16] + (size_t)l * RW;
    const int tid = phase_tid(wv), lane = tid & 63, wave = tid >> 6;
    const int gw = bidx * NWAVES + wave, ngw = NWAVES * gdim;
    for (int it = gw; it < T * RH; it += ngw) {
        const int t = it / RH, h = it % RH, c = h * 64 + lane;
        const size_t o = (size_t)t * RW + c;
        const float x = SCAN[o] + SCAN[(size_t)T * RW + o];
        const float mean = wave_sum(x, lane) * (1.0f / 64.0f);
        const float dl = x - mean;
        const float var = wave_sum(dl * dl, lane) * (1.0f / 64.0f);
        float y = dl / sqrtf(var + GN_EPS) * rln_g[c] + rln_b[c];
        y += BONUS[(size_t)t * RH + h] * VV[o];
        GRP[(size_t)t * D + GW + c] = (bf16_t)f2bf(y * GATE[o]);
    }
}

__device__ __forceinline__ void phase_ln1_router(const Params& P, int l, unsigned char* smem, int wv) {
    ParamsPtr pp = PARAMS_PTR(P); PIN_S(pp); unsigned char* ws = pp->ws; int bidx = (int)blockIdx.x, gdim = (int)gridDim.x; PIN_S(bidx); PIN_S(gdim);
    const bf16_t* xin = (const bf16_t*)(ws + O_XB);
    const bf16_t* MIX = (const bf16_t*)(ws + O_MIX);
    int* TOPI = (int*)(ws + O_TOPI); float* TOPG = (float*)(ws + O_TOPG); int* RANK = (int*)(ws + O_RANK); bf16_t* X1B = (bf16_t*)(ws + O_X1B);
    int* BCNT = (int*)(ws + O_BCNT);
    const float* g1 = pp->in[22] + (size_t)l * D; const float* b1 = pp->in[23] + (size_t)l * D;
    const float* rw = pp->in[24] + (size_t)l * D * NE; const float* rb = pp->in[25] + (size_t)l * NE;
    const bf16_t* RWT = (const bf16_t*)(ws + O_RWT) + (size_t)l * 2 * NE * D;
    const int tid = phase_tid(wv), lane = tid & 63, wave = tid >> 6, col = lane & 15, g = lane >> 4;
    float* lgs = (float*)smem;
    int* stopi = (int*)(smem + 8704);
    constexpr int XHP = D + 8;
    bf16_t* XH = (bf16_t*)(smem + 16384);
    for (int tile = bidx; tile < T / 64; tile += gdim) {
        __syncthreads();
        {
            u32x2 xa[8][4], xm[8][4];
#pragma unroll
            for (int ti8 = 0; ti8 < 8; ++ti8) {
                const size_t tt_ = (size_t)(tile * 64 + wave * 8 + ti8);
#pragma unroll
                for (int j = 0; j < 4; ++j) { const int c = j * 256 + lane * 4; xa[ti8][j] = *(const u32x2*)(xin + tt_ * D + c); xm[ti8][j] = *(const u32x2*)(MIX + tt_ * D + c); }
            }
            f32x4 gg[4], bb[4];
#pragma unroll
            for (int j = 0; j < 4; ++j) { const int c = j * 256 + lane * 4; gg[j] = *(const f32x4*)(g1 + c); bb[j] = *(const f32x4*)(b1 + c); }
#pragma unroll
            for (int ti8 = 0; ti8 < 8; ++ti8) {
                const int t = tile * 64 + wave * 8 + ti8;
                float v[16]; float sm = 0.f;
#pragma unroll
                for (int j = 0; j < 4; ++j) {
                    v[j * 4 + 0] = ALPHA * bf_lo(xa[ti8][j].x) + bf_lo(xm[ti8][j].x); v[j * 4 + 1] = ALPHA * bf_hi(xa[ti8][j].x) + bf_hi(xm[ti8][j].x);
                    v[j * 4 + 2] = ALPHA * bf_lo(xa[ti8][j].y) + bf_lo(xm[ti8][j].y); v[j * 4 + 3] = ALPHA * bf_hi(xa[ti8][j].y) + bf_hi(xm[ti8][j].y);
                    sm += (v[j * 4] + v[j * 4 + 1]) + (v[j * 4 + 2] + v[j * 4 + 3]);
                }
                const float mean = wave_sum_fast(sm, lane) * (1.0f / D); float q = 0.f;
#pragma unroll
                for (int j = 0; j < 16; ++j) { const float dl = v[j] - mean; q += dl * dl; }
                const float rstd = 1.0f / sqrtf(wave_sum_fast(q, lane) * (1.0f / D) + LN_EPS);
#pragma unroll
                for (int j = 0; j < 4; ++j) {
                    const int c = j * 256 + lane * 4;
                    f32x4 o;
                    o.x = (v[j * 4 + 0] - mean) * rstd * gg[j].x + bb[j].x; o.y = (v[j * 4 + 1] - mean) * rstd * gg[j].y + bb[j].y;
                    o.z = (v[j * 4 + 2] - mean) * rstd * gg[j].z + bb[j].z; o.w = (v[j * 4 + 3] - mean) * rstd * gg[j].w + bb[j].w;
                    u32x2 ob; ob.x = pk2(o.x, o.y); ob.y = pk2(o.z, o.w); *(u32x2*)(X1B + (size_t)t * D + c) = ob;
                    *(u32x2*)(XH + (wave * 8 + ti8) * XHP + c) = ob;
                }
            }
        }
        __syncthreads();
        {
            const bf16_t* xr = XH + ((wave >> 1) * 16 + col) * XHP + 8 * g;
            const bf16_t* wh = RWT + (size_t)((wave & 1) * 16 + col) * D + 8 * g; const bf16_t* wl = wh + (size_t)NE * D;
            f32x4 acc = (f32x4){0.f, 0.f, 0.f, 0.f};
#pragma unroll 8
            for (int ks = 0; ks < 32; ++ks) {
                const bf16x8 ah = *(const bf16x8*)(xr + ks * 32);
                const bf16x8 bh = *(const bf16x8*)(wh + ks * 32), bl = *(const bf16x8*)(wl + ks * 32);
                acc = MFMA16(ah, bh, acc); acc = MFMA16(ah, bl, acc);
            }
            const float rbv = rb[(wave & 1) * 16 + col];
#pragma unroll
            for (int r = 0; r < 4; ++r) lgs[((wave >> 1) * 16 + 4 * g + r) * (NE + 1) + (wave & 1) * 16 + col] = acc[r] + rbv;
        }
        __syncthreads();
        if (tid < 64) {
            const float* lp = lgs + tid * (NE + 1); const int t = tile * 64 + tid;
            float tv[4]; int ti[4];
#pragma unroll
            for (int k = 0; k < 4; ++k) { tv[k] = -INFINITY; ti[k] = 0; }
            for (int e = 0; e < NE; ++e) {
                const float x = lp[e];
                if (x > tv[3]) {
                    if (x > tv[0]) { tv[3] = tv[2]; ti[3] = ti[2]; tv[2] = tv[1]; ti[2] = ti[1]; tv[1] = tv[0]; ti[1] = ti[0]; tv[0] = x; ti[0] = e; }
                    else if (x > tv[1]) { tv[3] = tv[2]; ti[3] = ti[2]; tv[2] = tv[1]; ti[2] = ti[1]; tv[1] = x; ti[1] = e; }
                    else if (x > tv[2]) { tv[3] = tv[2]; ti[3] = ti[2]; tv[2] = x; ti[2] = e; }
                    else { tv[3] = x; ti[3] = e; }
                }
            }
            const float e1 = expf(tv[1] - tv[0]), e2 = expf(tv[2] - tv[0]), e3 = expf(tv[3] - tv[0]);
            const float inv = 1.0f / (1.0f + e1 + e2 + e3);
            *(f32x4*)(TOPG + (size_t)t * 4) = (f32x4){inv, e1 * inv, e2 * inv, e3 * inv};
#pragma unroll
            for (int k = 0; k < 4; ++k) { TOPI[(size_t)t * 4 + k] = ti[k]; stopi[tid * 4 + k] = ti[k]; }
        }
        __syncthreads();
        int* wcnt = stopi + 256;
        int rk = 0, ex = 0;
        if (wave < 4) {
            ex = stopi[tid]; int mycnt = 0;
            for (int x = 0; x < NE; ++x) { const unsigned long long m = __ballot(ex == x); if (ex == x) rk = __popcll(m & ((1ull << lane) - 1ull)); if (lane == x) mycnt = __popcll(m); }
            if (lane < NE) wcnt[wave * NE + lane] = mycnt;
        }
        __syncthreads();
        if (wave < 4) { for (int w2 = 0; w2 < wave; ++w2) rk += wcnt[w2 * NE + ex]; RANK[(size_t)tile * 256 + tid] = rk; }
        else if (tid < 256 + NE) { const int e = tid - 256; BCNT[tile * NE + e] = (wcnt[e] + wcnt[NE + e]) + (wcnt[2 * NE + e] + wcnt[3 * NE + e]); }
    }
    __syncthreads();
}

__device__ __forceinline__ void moe_offsets(int* sh, const int* CNT, int tid) {
    if (tid == 0) {
        int acc = 0;
        for (int e = 0; e < NE; ++e) { const int c = (int)CNT[e]; sh[e] = c; sh[32 + e] = acc; acc += (c + MOEB - 1) / MOEB * MOEB; sh[64 + e] = acc; }
    }
    __syncthreads();
}
__device__ __forceinline__ int moe_expert_of_row(const int* sh, int r) {
    int e = -1;
    for (int i = 0; i < NE; ++i) if (r >= sh[32 + i] && r < sh[64 + i]) e = i;
    return e;
}

__device__ __forceinline__ void phase_scatter(const Params& P, int l, unsigned char* smem, int wv) {
    ParamsPtr pp = PARAMS_PTR(P); PIN_S(pp); unsigned char* ws = pp->ws; int bidx = (int)blockIdx.x, gdim = (int)gridDim.x; PIN_S(bidx); PIN_S(gdim);
    const int tid = phase_tid(wv);
    const int* TOPI = (const int*)(ws + O_TOPI); const int* RANK = (const int*)(ws + O_RANK); int* SLOT = (int*)(ws + O_SLOT); int* ROWT = (int*)(ws + O_ROWT);
    const int* BCNT = (const int*)(ws + O_BCNT); int* CNTF = (int*)(ws + O_CNTF);
    int* sh = (int*)smem;
    int* part = sh + 96;
    int* tot = part + 512;
    int* base = tot + 32;
    constexpr int NT = T / 64;
    const int e = tid & 31, pt = tid >> 5;
    { int sacc = 0; for (int tl = pt; tl < NT; tl += 16) sacc += BCNT[tl * NE + e]; part[pt * 32 + e] = sacc; }
    __syncthreads();
    if (tid < 32) { int sacc = 0; for (int q = 0; q < 16; ++q) sacc += part[q * 32 + tid]; tot[tid] = sacc; if (bidx == 0) CNTF[tid] = sacc; }
    __syncthreads();
    moe_offsets(sh, tot, tid);
    for (int ee = bidx; ee < NE; ee += gdim)
        for (int r = sh[32 + ee] + sh[ee] + tid; r < sh[64 + ee]; r += NTHREADS) ROWT[r] = 0;
    for (int tile = bidx; tile < NT; tile += gdim) {
        __syncthreads();
        { int sacc = 0; for (int tl = pt; tl < tile; tl += 16) sacc += BCNT[tl * NE + e]; part[pt * 32 + e] = sacc; }
        __syncthreads();
        if (tid < 32) { int sacc = sh[32 + tid]; for (int q = 0; q < 16; ++q) sacc += part[q * 32 + tid]; base[tid] = sacc; }
        __syncthreads();
        if (tid < 256) { const int a = tile * 256 + tid, dest = base[TOPI[a]] + RANK[a]; SLOT[a] = dest; ROWT[dest] = a >> 2; }
    }
    __syncthreads();
}

template <int WHICH>
__device__ __forceinline__ void phase_moe_gemm(const Params& P, int l, unsigned char* smem, int wv) {
    ParamsPtr pp = PARAMS_PTR(P); PIN_S(pp); unsigned char* ws = pp->ws; int bidx = (int)blockIdx.x, gdim = (int)gridDim.x; PIN_S(bidx); PIN_S(gdim);
    const int tid = phase_tid(wv);
    const int* CNT = (const int*)(ws + O_CNTF);
    int* sh = (int*)(smem + 131072);
    int* rbe = sh + 96;
    moe_offsets(sh, CNT, tid);
    const int nrb = sh[64 + NE - 1] / MOEB;
    for (int rb = tid; rb < nrb; rb += NTHREADS) rbe[rb] = moe_expert_of_row(sh, rb * MOEB);
    __syncthreads();
    pg8::MoeOrderT<WHICH == 1> S;
    S.K = 1024; S.G_ = gdim; S.c = bidx; S.rbe = rbe; S.rowmap = (const int*)(ws + O_ROWT);
    if (WHICH == 1) {
        S.A = (const char*)(ws + O_X1B); S.Wt = (const char*)(ws + O_W1) + (size_t)l * NE * 2 * DFF * D * 2; S.estride = (size_t)2 * DFF * D * 2; S.nN = 2 * DFF / 256; S.nwg = nrb * S.nN;
        pg8::EpiSwiglu E{(bf16_t*)(ws + O_ACT), pp->in[27] + (size_t)l * NE * 2 * DFF};
        pg8::gemm_phase<pg8::EpiSwiglu, pg8::MoeOrderT<WHICH == 1>>((LAS unsigned char*)smem, 1024, S, E, tid);
    } else {
        S.A = (const char*)(ws + O_ACT); S.Wt = (const char*)(ws + O_W2) + (size_t)l * NE * D * DFF * 2; S.estride = (size_t)D * DFF * 2; S.nN = D / 256; S.nwg = nrb * S.nN;
        pg8::EpiBf16Bias E{(bf16_t*)(ws + O_YS), D, pp->in[29] + (size_t)l * NE * D, D};
        pg8::gemm_phase<pg8::EpiBf16Bias, pg8::MoeOrderT<WHICH == 1>>((LAS unsigned char*)smem, 1024, S, E, tid);
    }
    __syncthreads();
}

__device__ __forceinline__ void phase_combine_ln2(const Params& P, int l, unsigned char* smem, int wv) {
    ParamsPtr pp = PARAMS_PTR(P); PIN_S(pp); unsigned char* ws = pp->ws; int bidx = (int)blockIdx.x, gdim = (int)gridDim.x; PIN_S(bidx); PIN_S(gdim);
    const bf16_t* X1 = (const bf16_t*)(ws + O_X1B); const bf16_t* YS = (const bf16_t*)(ws + O_YS); bf16_t* XB = (bf16_t*)(ws + O_XB);
    const int* SLOT = (const int*)(ws + O_SLOT); const float* TOPG = (const float*)(ws + O_TOPG);
    float* xo = pp->out;
    const float* g2 = pp->in[30] + (size_t)l * D; const float* b2 = pp->in[31] + (size_t)l * D;
    const int tid = phase_tid(wv), lane = tid & 63, wave = tid >> 6;
    const int gw = bidx * NWAVES + wave, ngw = NWAVES * gdim;
    u32x4 sl_n = (u32x4){0u, 0u, 0u, 0u}; f32x4 gg_n = (f32x4){0.f, 0.f, 0.f, 0.f};
    u32x2 xa_n[4]; u32x2 ys_n[4][4]; f32x4 gg_c = (f32x4){0.f, 0.f, 0.f, 0.f};
    const f32x4 lg[4] = {*(const f32x4*)(g2 + lane * 4), *(const f32x4*)(g2 + 256 + lane * 4), *(const f32x4*)(g2 + 512 + lane * 4), *(const f32x4*)(g2 + 768 + lane * 4)};
    const f32x4 lb[4] = {*(const f32x4*)(b2 + lane * 4), *(const f32x4*)(b2 + 256 + lane * 4), *(const f32x4*)(b2 + 512 + lane * 4), *(const f32x4*)(b2 + 768 + lane * 4)};
#define CB_META(tt_) do { sl_n = *(const u32x4*)(SLOT + (size_t)(tt_) * 4); gg_n = *(const f32x4*)(TOPG + (size_t)(tt_) * 4); } while (0)
#define CB_ROWS(tt_) do { _Pragma("unroll") for (int j = 0; j < 4; ++j) { const int c = j * 256 + lane * 4; xa_n[j] = *(const u32x2*)(X1 + (size_t)(tt_) * D + c); \
        ys_n[0][j] = *(const u32x2*)(YS + (size_t)sl_n.x * D + c); ys_n[1][j] = *(const u32x2*)(YS + (size_t)sl_n.y * D + c); ys_n[2][j] = *(const u32x2*)(YS + (size_t)sl_n.z * D + c); ys_n[3][j] = *(const u32x2*)(YS + (size_t)sl_n.w * D + c); } gg_c = gg_n; } while (0)
    if (gw < T) { CB_META(gw); CB_ROWS(gw); if (gw + ngw < T) CB_META(gw + ngw); }
    for (int t = gw; t < T; t += ngw) {
        float v[16]; float sm = 0.f;
        const float gk[4] = {gg_c.x, gg_c.y, gg_c.z, gg_c.w};
#pragma unroll
        for (int j = 0; j < 4; ++j) {
            const f32x4 a = (f32x4){bf_lo(xa_n[j].x), bf_hi(xa_n[j].x), bf_lo(xa_n[j].y), bf_hi(xa_n[j].y)};
            f32x4 y = (f32x4){0.f, 0.f, 0.f, 0.f};
#pragma unroll
            for (int k = 0; k < 4; ++k) { const u32x2 yk = ys_n[k][j]; y.x += gk[k] * bf_lo(yk.x); y.y += gk[k] * bf_hi(yk.x); y.z += gk[k] * bf_lo(yk.y); y.w += gk[k] * bf_hi(yk.y); }
            v[j * 4 + 0] = ALPHA * a.x + y.x; v[j * 4 + 1] = ALPHA * a.y + y.y; v[j * 4 + 2] = ALPHA * a.z + y.z; v[j * 4 + 3] = ALPHA * a.w + y.w;
            sm += (v[j * 4] + v[j * 4 + 1]) + (v[j * 4 + 2] + v[j * 4 + 3]);
        }
        if (t + ngw < T) { CB_ROWS(t + ngw); if (t + 2 * ngw < T) CB_META(t + 2 * ngw); }
        const float mean = wave_sum_fast(sm, lane) * (1.0f / D); float q = 0.f;
#pragma unroll
        for (int j = 0; j < 16; ++j) { const float dl = v[j] - mean; q += dl * dl; }
        const float rstd = 1.0f / sqrtf(wave_sum_fast(q, lane) * (1.0f / D) + LN_EPS);
#pragma unroll
        for (int j = 0; j < 4; ++j) {
            const int c = j * 256 + lane * 4;
            f32x4 o;
            o.x = (v[j * 4 + 0] - mean) * rstd * lg[j].x + lb[j].x; o.y = (v[j * 4 + 1] - mean) * rstd * lg[j].y + lb[j].y;
            o.z = (v[j * 4 + 2] - mean) * rstd * lg[j].z + lb[j].z; o.w = (v[j * 4 + 3] - mean) * rstd * lg[j].w + lb[j].w;
            if (l == NL - 1) *(f32x4*)(xo + (size_t)t * D + c) = o;
            else { u32x2 ob; ob.x = pk2(o.x, o.y); ob.y = pk2(o.z, o.w); *(u32x2*)(XB + (size_t)t * D + c) = ob; }
        }
    }
#undef CB_META
#undef CB_ROWS
}

__device__ __forceinline__ void phase_inproj(const Params& P, int l, unsigned char* smem, int wv) {
    ParamsPtr pp = PARAMS_PTR(P); PIN_S(pp); unsigned char* ws = pp->ws; int bidx = (int)blockIdx.x, gdim = (int)gridDim.x; PIN_S(bidx); PIN_S(gdim);
    const int tid = phase_tid(wv);
    pg8::DenseOrder S; S.init(ws + O_XB, (const bf16_t*)(ws + O_WIN) + (size_t)l * PLD * D, T, PLD, D, gdim, bidx);
    pg8::EpiProj E{(bf16_t*)(ws + O_PROJ), PLD, (float*)(ws + O_PROJG), PLD / 256 - 1};
    pg8::gemm_phase<pg8::EpiProj, pg8::DenseOrder>((LAS unsigned char*)smem, D, S, E, tid);
    __syncthreads();
}
__device__ __forceinline__ void phase_outproj(const Params& P, int l, unsigned char* smem, int wv) {
    ParamsPtr pp = PARAMS_PTR(P); PIN_S(pp); unsigned char* ws = pp->ws; int bidx = (int)blockIdx.x, gdim = (int)gridDim.x; PIN_S(bidx); PIN_S(gdim);
    const int tid = phase_tid(wv);
    pg8::DenseOrder S; S.init(ws + O_GRP, (const bf16_t*)(ws + O_WOUT) + (size_t)l * D * D, T, D, D, gdim, bidx);
    pg8::EpiProj E{(bf16_t*)(ws + O_MIX), D, nullptr, -1};
    pg8::gemm_phase<pg8::EpiProj, pg8::DenseOrder>((LAS unsigned char*)smem, D, S, E, tid);
    __syncthreads();
}

#ifndef EMU
#define XB_TMO      128
#define XB_XCNT(j)  (256  + 64 * (j))
#define XB_XSUB(j)  (1280 + 64 * (j))
#define XB_XGEN(j)  (2304 + 64 * (j))
#define XB_TOP      3328
#define XB_TOPGEN   3392
#define XCD_BAR_WORDS 3456
#define XB_SPIN_CAP (1u << 25)
__device__ __forceinline__ unsigned xb_ld(unsigned* p)              { return __hip_atomic_load(p, __ATOMIC_RELAXED, __HIP_MEMORY_SCOPE_AGENT); }
__device__ __forceinline__ unsigned xb_add(unsigned* p, unsigned v) { return __hip_atomic_fetch_add(p, v, __ATOMIC_RELAXED, __HIP_MEMORY_SCOPE_AGENT); }
__device__ __forceinline__ unsigned xb_xcc_id() { return (unsigned)__builtin_amdgcn_s_getreg((3 << 11) | 20) & 0xFu; }
#define XB_SPIN(cond, bar) do { unsigned _sp = 0; while (cond) { __builtin_amdgcn_s_sleep(1); \
    if ((++_sp & 255u) == 0u) { if (xb_ld(&(bar)[XB_TMO])) break; if (_sp > XB_SPIN_CAP) { atomicAdd(&(bar)[XB_TMO], 1u); break; } } } } while (0)
struct XcdBarrier { unsigned* bar; unsigned x; volatile LAS unsigned* st; };
__device__ __forceinline__ XcdBarrier xcd_barrier_post(unsigned* bar, volatile LAS unsigned* st) {
    XcdBarrier b; b.bar = bar; b.x = xb_xcc_id(); b.st = st;
    if (threadIdx.x == 0) (void)xb_add(&bar[XB_XCNT(b.x)], 1u);
    return b;
}
__device__ __forceinline__ void xcd_barrier_complete(unsigned* bar, unsigned x, unsigned& nloc, unsigned& nx) {
    const unsigned G = gridDim.x * gridDim.y * gridDim.z;
    unsigned sum, cnt, mine, sp = 0u;
    for (;;) {
        sum = 0u; cnt = 0u; mine = 0u;
#pragma unroll
        for (unsigned j = 0; j < 16; ++j) { const unsigned c = xb_ld(&bar[XB_XCNT(j)]); sum += c; cnt += (c > 0u) ? 1u : 0u; mine = (j == x) ? c : mine; }
        if (sum == G) break;
        __builtin_amdgcn_s_sleep(1);
        if ((++sp & 255u) == 0u) { if (xb_ld(&bar[XB_TMO])) break; if (sp > XB_SPIN_CAP) { atomicAdd(&bar[XB_TMO], 1u); break; } }
    }
    nloc = mine > 0u ? mine : 1u; nx = cnt > 0u ? cnt : 1u;
}
__device__ __forceinline__ void xcd_barrier(const XcdBarrier& b) {
    asm volatile("s_waitcnt vmcnt(0)" ::: "memory");
    __syncthreads();
    if (threadIdx.x == 0) {
        unsigned* bar = b.bar;
        __builtin_amdgcn_s_waitcnt(0);
        unsigned nloc = b.st[0], nx = b.st[1];
        if (nloc == 0u) { xcd_barrier_complete(bar, b.x, nloc, nx); b.st[0] = nloc; b.st[1] = nx; }
        const unsigned old = xb_add(&bar[XB_XSUB(b.x)], 1u);
        const unsigned gen = old / nloc;
        if (old + 1u == (gen + 1u) * nloc) {
            __builtin_amdgcn_fence(__ATOMIC_RELEASE, "agent");
            asm volatile("s_waitcnt vmcnt(0)" ::: "memory");
            const unsigned og = xb_add(&bar[XB_TOP], 1u);
            const unsigned tg = og / nx;
            if (og + 1u == (tg + 1u) * nx) xb_add(&bar[XB_TOPGEN], 1u);
            else XB_SPIN(xb_ld(&bar[XB_TOPGEN]) == tg, bar);
            __builtin_amdgcn_fence(__ATOMIC_ACQUIRE, "agent");
            xb_add(&bar[XB_XGEN(b.x)], 1u);
            asm volatile("s_waitcnt vmcnt(0)" ::: "memory");
        } else {
            XB_SPIN(xb_ld(&bar[XB_XGEN(b.x)]) == gen, bar);
            __builtin_amdgcn_fence(__ATOMIC_ACQUIRE, "agent");
            asm volatile("s_waitcnt vmcnt(0)" ::: "memory");
        }
    }
    __syncthreads();
}
#endif

__global__ void __launch_bounds__(512, 2) mk_fwd(Params P) {
#ifdef EMU
    unsigned char* smem = g_blk->lds;
#else
    extern __shared__ __attribute__((aligned(16))) unsigned char smem[];
    volatile LAS unsigned* bst = (volatile LAS unsigned*)(smem + LDS_BYTES - 16);
    if (threadIdx.x == 0) { bst[0] = 0u; bst[1] = 0u; bst[2] = 0u; bst[3] = 0u; }
    __syncthreads();
    XcdBarrier bar; bar.bar = (unsigned*)P.ws + CW_BAR; bar.x = 0; bar.st = bst;
    if (P.ph_hi - P.ph_lo > 1) bar = xcd_barrier_post((unsigned*)P.ws + CW_BAR, bst);
#endif
    const int lo = P.ph_lo, hi = P.ph_hi;
#ifdef EMU
    const int wv = (int)threadIdx.x >> 6;
#else
    const int wv = RFL((int)threadIdx.x >> 6);
#endif
#ifdef EMU
#define SEAM(id) do {} while (0)
#else
#define SEAM(id) do { if ((id) + 1 < hi) xcd_barrier(bar); } while (0)
#endif
#ifndef MK_ONLY_PHASE
#define MK_ONLY_PHASE -1
#endif
#ifndef MK_DUP_MASK
#define MK_DUP_MASK 0
#endif
#define PHG(kc, id, ...) do { if (MK_ONLY_PHASE < 0 || MK_ONLY_PHASE == (kc)) { const int id_ = (id); if (id_ >= lo && id_ < hi) { if ((MK_DUP_MASK >> (kc)) & 1) { __VA_ARGS__; SEAM(id_ - 1); } __VA_ARGS__; SEAM(id_); } } } while (0)
#define PH(k, ...) PHG(1 + (k), 1 + l * NPH + (k), __VA_ARGS__)
    PHG(0, 0, phase_prologue(P, smem, wv));
    for (int l = 0; l < NL; ++l) {
        PH(0, phase_inproj(P, l, smem, wv));
#if MK_RWKV_CHUNKED
        PH(1, phase_prep32(P, l, smem, wv));
#else
        PH(1, phase_prep(P, l, smem, wv));
#endif
#if MK_RWKV_CHUNKED
        PH(2, { phase_rwkv_pre(P, l, smem, wv); phase_mlstm_local(P, l, smem, wv, (int)blockIdx.x, (int)gridDim.x); if (MK_PROBE == 42) phase_mlstm_local(P, l, smem, wv, (int)blockIdx.x, (int)gridDim.x); });
        PH(3, { const int G_ = (int)gridDim.x;
                if (G_ >= 2 * RSEQ_WGS) { if ((int)blockIdx.x < RSEQ_WGS) { phase_rwkv_seq(P, l, smem, wv); if (MK_PROBE >= 30 && MK_PROBE < 38) phase_rwkv_seq<MK_PROBE >= 30 && MK_PROBE < 38 ? MK_PROBE - 30 : 0>(P, l, smem, wv); }
                                           else { phase_mlstm_carry(P, l, smem, wv, (int)blockIdx.x - RSEQ_WGS, G_ - RSEQ_WGS); phase_gmlp_mix(P, l, smem, wv, (int)blockIdx.x - RSEQ_WGS, G_ - RSEQ_WGS);
                                                  if (MK_PROBE == 39) phase_gmlp_mix(P, l, smem, wv, (int)blockIdx.x - RSEQ_WGS, G_ - RSEQ_WGS); } }
                else { phase_rwkv_seq(P, l, smem, wv); phase_mlstm_carry(P, l, smem, wv, (int)blockIdx.x, G_); } });
        PH(4, { phase_rwkv_out(P, l, smem, wv); if (MK_PROBE == 40) phase_rwkv_out(P, l, smem, wv); phase_mlstm_out(P, l, smem, wv); if (MK_PROBE == 41) phase_mlstm_out(P, l, smem, wv); if ((int)gridDim.x < 2 * RSEQ_WGS) phase_gmlp_mix(P, l, smem, wv, (int)blockIdx.x, (int)gridDim.x); });
#else
        PH(2, { const int G_ = (int)gridDim.x, NSC = 2 * NB * RH * 4;
                if (G_ >= NSC + 32) { if ((int)blockIdx.x < NSC) phase_rwkv_scan(P, l, smem, wv, (int)blockIdx.x, NSC);
                                      else phase_mlstm_local(P, l, smem, wv, (int)blockIdx.x - NSC, G_ - NSC); }
                else { phase_rwkv_scan(P, l, smem, wv, (int)blockIdx.x, G_); phase_mlstm_local(P, l, smem, wv, (int)blockIdx.x, G_); } });
        PH(3, phase_mlstm_carry(P, l, smem, wv, (int)blockIdx.x, (int)gridDim.x));
        PH(4, { phase_mlstm_out(P, l, smem, wv); phase_gmlp_mix(P, l, smem, wv, (int)blockIdx.x, (int)gridDim.x); phase_rwkv_post(P, l, smem, wv); });
#endif
        PH(5, phase_outproj(P, l, smem, wv));
        PH(6, phase_ln1_router(P, l, smem, wv));
        PH(7, phase_scatter(P, l, smem, wv));
        PH(8, phase_moe_gemm<1>(P, l, smem, wv));
        PH(9, phase_moe_gemm<2>(P, l, smem, wv));
        PH(10, phase_combine_ln2(P, l, smem, wv));
    }
#undef PHG
#undef PH
#undef SEAM
}

}

#ifndef EMU
extern "C" void kernel_launch(void* const* d_in, const int* in_sizes, int n_in, void* d_out, int out_size, void* d_ws, size_t ws_size, hipStream_t stream) {
    using namespace mk;
    static int grid = 0;
    if (grid == 0) {
        if (n_in != 32 || out_size != T * D || ws_size < WS_END) { fprintf(stderr, "kernel_launch: unexpected shapes (n_in %d out %d ws %zu need %zu)\n", n_in, out_size, ws_size, (size_t)WS_END); grid = -1; return; }
        int dev = 0, cus = 0;
        if (hipGetDevice(&dev) != hipSuccess || hipDeviceGetAttribute(&cus, hipDeviceAttributeMultiprocessorCount, dev) != hipSuccess) { grid = -1; return; }
        if (hipFuncSetAttribute((const void*)mk_fwd, hipFuncAttributeMaxDynamicSharedMemorySize, LDS_BYTES) != hipSuccess) { fprintf(stderr, "kernel_launch: hipFuncSetAttribute failed\n"); grid = -1; return; }
        int per_cu = 0;
        (void)hipOccupancyMaxActiveBlocksPerMultiprocessor(&per_cu, (const void*)mk_fwd, NTHREADS, LDS_BYTES);
        (void)hipGetLastError();
        grid = cus;
    }
    if (grid < 0) return;
    (void)hipMemsetAsync(d_ws, 0, CTL_BYTES, stream);
    Params p{};
    for (int i = 0; i < 32; ++i) p.in[i] = (const float*)d_in[i];
    p.out = (float*)d_out; p.ws = (unsigned char*)d_ws;
#if MK_ONE_LAUNCH
    p.ph_lo = 0; p.ph_hi = 1 + NL * NPH;
    hipLaunchKernelGGL(mk_fwd, dim3(grid), dim3(NTHREADS), LDS_BYTES, stream, p);
#else
    for (int id = 0; id < 1 + NL * NPH; ++id) {
        p.ph_lo = id; p.ph_hi = id + 1;
        hipLaunchKernelGGL(mk_fwd, dim3(grid), dim3(NTHREADS), LDS_BYTES, stream, p);
    }
#endif
}
#endif
```

```cpp
#ifndef EMU
#include <hip/hip_runtime.h>
#endif
#include <cstdio>
#include <cstdint>
#include <cmath>

#ifndef CFG_BATCH
#define CFG_BATCH 4
#endif
#ifndef CFG_SEQ
#define CFG_SEQ 4096
#endif
#ifndef CFG_LAYERS
#define CFG_LAYERS 4
#endif
#ifndef MK_RWKV_CHUNKED
#define MK_RWKV_CHUNKED 1
#endif
#ifndef MK_PROBE
#define MK_PROBE 0
#endif
#ifndef MK_SP2
#define MK_SP2 1
#endif
#ifndef MK_ONE_LAUNCH
#define MK_ONE_LAUNCH 1
#endif

namespace mk {
constexpr int NB = CFG_BATCH, S = CFG_SEQ, T = NB * S, NL = CFG_LAYERS, D = 1024;
constexpr int GW = 256, RW = 384, MW = 384, HD = 64, GH = 4, RH = 6, MH = 6, CH = 128, NCH = S / CH;
constexpr int PIN = 3480, PLD = 3584, RPROJ = 1408;
constexpr int C_RW = 512, C_MW = 1920;
constexpr int NE = 32, TOPK = 4, DFF = 1024, MOEB = 256;
constexpr int NROWS = (T * TOPK / MOEB + NE) * MOEB;
constexpr float LN_EPS = 1e-5f, GN_EPS = 64e-5f;
constexpr float ALPHA = 1.6817928305074290f;
constexpr int NTHREADS = 512, NWAVES = 8;
constexpr int LDS_BYTES = 160 * 1024;
#ifndef MK_MOE_MERGED
#define MK_MOE_MERGED 1
#endif
constexpr int NPH = MK_MOE_MERGED ? 10 : 11;

typedef float f32x4 __attribute__((ext_vector_type(4)));
typedef unsigned u32x4 __attribute__((ext_vector_type(4)));
typedef unsigned u32x2 __attribute__((ext_vector_type(2)));
typedef short bf16x8 __attribute__((ext_vector_type(8)));
typedef unsigned short bf16_t;

constexpr size_t al(size_t x) { return (x + 255) & ~(size_t)255; }
constexpr size_t CTL_BYTES = 1u << 20;
constexpr size_t O_XA = CTL_BYTES;
constexpr size_t O_CLB = O_XA;
constexpr size_t O_XB = O_XA + al((size_t)T * D * 4);
constexpr size_t O_X1 = O_XB + al((size_t)T * D * 2);
constexpr size_t O_X1B = O_X1 + al((size_t)T * D * 4);
constexpr size_t O_PROJ = O_X1B + al((size_t)T * D * 2);
constexpr size_t O_PROJG = O_PROJ + al((size_t)T * PLD * 2);
constexpr size_t O_MIX = O_PROJ + al((size_t)T * PLD * 4);
constexpr size_t O_GRP = O_MIX + al((size_t)T * D * 4);
constexpr size_t O_UG = O_GRP + al((size_t)T * D * 2);
constexpr size_t O_VN = O_UG + al((size_t)T * GW * 4);
constexpr size_t O_RR = O_VN + al((size_t)T * GW * 4);
constexpr size_t O_VV = O_RR + al((size_t)T * RW * 4);
constexpr size_t O_KK = O_VV + al((size_t)T * RW * 4);
constexpr size_t O_DEC = O_KK + al((size_t)T * RW * 4);
constexpr size_t O_KD = O_DEC + al((size_t)2 * T * RW * 4);
constexpr size_t O_ICLR = O_KD + al((size_t)2 * T * RW * 4);
constexpr size_t O_GATE = O_ICLR + al((size_t)2 * T * RW * 4);
constexpr size_t O_BONUS = O_GATE + al((size_t)T * RW * 4);
constexpr size_t O_SCAN = O_BONUS + al((size_t)T * RH * 4);
constexpr size_t O_MQ = O_SCAN + al((size_t)2 * T * RW * 4);
constexpr size_t O_MK = O_MQ + al((size_t)T * MW * 4);
constexpr size_t O_IG = O_MK + al((size_t)T * MW * 4);
constexpr size_t O_LF = O_IG + al((size_t)2 * T * MH * 4);
constexpr size_t O_CL = O_LF + al((size_t)2 * T * MH * 4);
constexpr size_t O_NL = O_CL + al((size_t)2 * NB * MH * NCH * 4096 * 4);
constexpr size_t O_ML = O_NL + al((size_t)2 * NB * MH * NCH * 64 * 4);
constexpr size_t O_BL = O_ML + al((size_t)2 * NB * MH * NCH * 4);
constexpr size_t O_MIN = O_BL + al((size_t)2 * NB * MH * NCH * 4);
constexpr size_t O_TOPI = O_MIN + al((size_t)2 * NB * MH * NCH * 4);
constexpr size_t O_TOPG = O_TOPI + al((size_t)T * 4 * 4);
constexpr size_t O_RANK = O_TOPG + al((size_t)T * 4 * 4);
constexpr size_t O_SLOT = O_RANK + al((size_t)T * 4 * 4);
constexpr size_t O_MQB = O_SLOT + al((size_t)T * 4 * 4);
constexpr size_t O_MKB = O_MQB + al((size_t)T * MW * 2);
constexpr size_t O_KT = O_MKB + al((size_t)T * MW * 2);
constexpr size_t O_VT = O_KT + al((size_t)T * MW * 2);
constexpr size_t O_GVT = O_VT + al((size_t)T * MW * 2);
constexpr size_t O_PMX = O_GVT + al((size_t)2 * T * MH * 4);
constexpr size_t O_BCT = O_PMX + al((size_t)2 * T * MH * 4);
constexpr size_t O_BRKR = O_BCT + al((size_t)2 * T * MH * 4);
constexpr int RC = 64, RNC = S / RC, RUN = 2 * NB * RH * RNC;
constexpr size_t O_LW = O_BRKR + al((size_t)2 * T * RH * 2 * 4);
constexpr size_t O_RQ = O_LW + al((size_t)2 * T * RW * 4);
constexpr size_t O_RA = O_RQ + al((size_t)RUN * 4096 * 2);
constexpr size_t O_RS = O_RA + al((size_t)RUN * 4096 * 2);
constexpr size_t O_RH = O_RS + al((size_t)RUN * 4096 * 2);
constexpr size_t O_RG = O_RH + al((size_t)RUN * 4096 * 4);
constexpr size_t O_RB = O_RG + al((size_t)RUN * 4096 * 4);
constexpr size_t O_VB = O_RB + al((size_t)T * RW * 2);
constexpr size_t O_KKB = O_VB + al((size_t)T * RW * 2);
constexpr size_t O_BBB = O_KKB + al((size_t)T * RW * 2);
constexpr size_t O_KDB = O_BBB + al((size_t)2 * T * RW * 2);
constexpr size_t O_RK7 = O_KDB + al((size_t)2 * T * RW * 2);
constexpr size_t O_VNT = O_RK7 + al((size_t)T * RW * 16);
constexpr size_t O_WSB = O_VNT + al((size_t)T * GW * 2);
constexpr size_t O_LWT = O_WSB + al((size_t)NL * GH * CH * CH * 2);
constexpr size_t O_RWT = O_LWT + al((size_t)NL * 1920 * 128 * 2);
constexpr size_t O_BCNT = O_RWT + al((size_t)NL * 2 * NE * D * 2);
constexpr size_t O_CNTF = O_BCNT + al((size_t)(T / 64) * NE * 4);
constexpr size_t O_ROWT = O_CNTF + al((size_t)NE * 4);
constexpr size_t O_XS = O_ROWT + al((size_t)NROWS * 4);
constexpr size_t O_ACT = O_XS + al((size_t)NROWS * D * 2);
constexpr size_t O_YS = O_ACT + al((size_t)NROWS * DFF * 2);
constexpr size_t O_WIN = O_YS + al((size_t)NROWS * D * 2);
constexpr size_t O_WOUT = O_WIN + al((size_t)NL * PLD * D * 2);
constexpr size_t O_W1 = O_WOUT + al((size_t)NL * D * D * 2);
constexpr size_t O_W2 = O_W1 + al((size_t)NL * NE * 2 * DFF * D * 2);
constexpr size_t WS_END = O_W2 + al((size_t)NL * NE * D * DFF * 2);

constexpr int CW_BAR = 4096;
constexpr int CW_CNT = 16384;

struct Params { const float* in[32]; float* out; unsigned char* ws; int ph_lo, ph_hi; };
#ifdef EMU
typedef const Params* ParamsPtr;
#define PARAMS_PTR(P) (&(P))
#else
typedef const __attribute__((address_space(4))) Params* ParamsPtr;
#define PARAMS_PTR(P) ((ParamsPtr)__builtin_amdgcn_kernarg_segment_ptr())
#endif

#ifdef EMU
#define WAVE_SYNC() emu_wave_barrier()
#define PIN_V(x) do {} while (0)
#define PIN_S(x) do {} while (0)
#else
#define WAVE_SYNC() __builtin_amdgcn_wave_barrier()
#define PIN_V(x) asm volatile("" : "+v"(x))
#define PIN_S(x) asm volatile("" : "+s"(x))
#endif
#ifdef EMU
__device__ __forceinline__ int phase_tid(int wv) { (void)wv; return threadIdx.x; }
#else
__device__ __forceinline__ int phase_tid(int wv) { int t; asm volatile("v_mbcnt_lo_u32_b32 %0, -1, 0\n\tv_mbcnt_hi_u32_b32 %0, -1, %0" : "=v"(t)); return (wv << 6) + t; }
#endif

#ifdef EMU
#define SHX(v, m, lane) __shfl_xor(v, m)
#else
__device__ __forceinline__ float shx_(float v, int m, int lane) { return __builtin_bit_cast(float, __builtin_amdgcn_ds_bpermute((lane ^ m) << 2, __builtin_bit_cast(int, v))); }
__device__ __forceinline__ int shx_(int v, int m, int lane) { return __builtin_amdgcn_ds_bpermute((lane ^ m) << 2, v); }
#define SHX(v, m, lane) shx_(v, m, lane)
#endif
#ifdef EMU
#define SHUP(v, o, lane) __shfl(v, ((lane) - (o)) & 63)
#define RDL(v, src) __shfl(v, src)
#define SHL(v, src) __shfl(v, src)
#else
#define SHL(v, src) __builtin_bit_cast(float, __builtin_amdgcn_ds_bpermute((src) << 2, __builtin_bit_cast(int, (float)(v))))
#define SHUP(v, o, lane) __builtin_bit_cast(float, __builtin_amdgcn_ds_bpermute((((lane) - (o)) & 63) << 2, __builtin_bit_cast(int, (float)(v))))
#define RDL(v, src) __builtin_bit_cast(float, __builtin_amdgcn_readlane(__builtin_bit_cast(int, (float)(v)), src))
#endif
__device__ __forceinline__ float wave_sum(float v, int lane) {
#pragma unroll
    for (int o = 32; o >= 1; o >>= 1) v += SHX(v, o, lane);
    return v;
}
#ifdef EMU
__device__ __forceinline__ float fexp(float x) { return expf(x); }
__device__ __forceinline__ float flog(float x) { return logf(x); }
__device__ __forceinline__ float frcp(float x) { return 1.0f / x; }
#else
__device__ __forceinline__ float fexp(float x) { return __builtin_amdgcn_exp2f(x * 1.4426950408889634f); }
__device__ __forceinline__ float flog(float x) { return __builtin_amdgcn_logf(x) * 0.6931471805599453f; }
__device__ __forceinline__ float frcp(float x) { return __builtin_amdgcn_rcpf(x); }
#endif
__device__ __forceinline__ float sigmoidf_(float x) { return frcp(1.0f + fexp(-x)); }
__device__ __forceinline__ float softplusf_(float x) { return fmaxf(x, 0.f) + flog(1.0f + fexp(-fabsf(x))); }
__device__ __forceinline__ float ftanh(float x) { return 1.0f - 2.0f * frcp(1.0f + fexp(2.0f * x)); }
__device__ __forceinline__ float geluf_(float v) {
    const float av = fabsf(v), t = frcp(1.0f + 0.2316418882f * av);
    float q = t * 0.5307027145f + (-0.7265760135f); q = q * t + 0.7107068705f; q = q * t + (-0.142248368f); q = q * t + 0.127414796f; q = q * t;
    const float m = v * (q * fexp(-0.5f * v * v));
    return v < 0.f ? m : v - m;
}

#ifdef EMU
#define LAS
#define WAIT_V(n) do {} while (0)
#define WAIT_L(n) do {} while (0)
#define S_BARRIER() __syncthreads()
#define SETPRIO(x) do {} while (0)
#define SCHED_BAR() do {} while (0)
#define RFL(x) (x)
static inline void emu_glds16(const void* g, void* l) { memcpy((char*)l + (g_blk->cur & 63) * 16, g, 16); }
#define GLDS16(gptr, ldsptr) emu_glds16((const void*)(gptr), (void*)(ldsptr))
static inline float emu_bf2f(unsigned short b) { unsigned u = (unsigned)b << 16; float f; memcpy(&f, &u, 4); return f; }
static inline f32x4 emu_mfma16(bf16x8 a, bf16x8 b, f32x4 c) {
    EmuBlock* blk = g_blk; const int cur = blk->cur, lane = cur & 63, wbase = cur & ~63;
    static thread_local unsigned short Ash[32][64][8], Bsh[32][64][8];
    const int w = cur >> 6;
    for (int j = 0; j < 8; ++j) { Ash[w][lane][j] = (unsigned short)a[j]; Bsh[w][lane][j] = (unsigned short)b[j]; }
    emu_wave_barrier();
    const int col = lane & 15;
    for (int r = 0; r < 4; ++r) { const int row = 4 * (lane >> 4) + r; float sum = c[r];
        for (int k = 0; k < 32; ++k) sum += emu_bf2f(Ash[w][row + 16 * (k >> 3)][k & 7]) * emu_bf2f(Bsh[w][col + 16 * (k >> 3)][k & 7]);
        c[r] = sum; }
    emu_wave_barrier(); (void)wbase;
    return c;
}
#define MFMA16(a, b, c) emu_mfma16(a, b, c)
#else
#define LAS __attribute__((address_space(3)))
#define WAIT_V(n) asm volatile("s_waitcnt vmcnt(" #n ")" ::: "memory")
#define WAIT_L(n) asm volatile("s_waitcnt lgkmcnt(" #n ")" ::: "memory")
#define S_BARRIER() __builtin_amdgcn_s_barrier()
#define SETPRIO(x) __builtin_amdgcn_s_setprio(x)
#define SCHED_BAR() __builtin_amdgcn_sched_barrier(0)
#define RFL(x) __builtin_amdgcn_readfirstlane(x)
#define GLDS16(gptr, ldsptr) __builtin_amdgcn_global_load_lds((const unsigned*)(gptr), (LAS unsigned*)(ldsptr), 16, 0, 0)
#define MFMA16(a, b, c) __builtin_amdgcn_mfma_f32_16x16x32_bf16(a, b, c, 0, 0, 0)
#endif

#ifdef EMU
__device__ __forceinline__ unsigned f2bf(float f) { unsigned u = __builtin_bit_cast(unsigned, f); return (u + 0x7fffu + ((u >> 16) & 1u)) >> 16; }
#else
__device__ __forceinline__ unsigned f2bf(float f) { return (unsigned)__builtin_bit_cast(unsigned short, (__bf16)f); }
#endif
#ifdef EMU
__device__ __forceinline__ unsigned pk2(float lo, float hi) { return f2bf(lo) | (f2bf(hi) << 16); }
#else
typedef float f32x2c __attribute__((ext_vector_type(2)));
typedef __bf16 bf16x2c __attribute__((ext_vector_type(2)));
__device__ __forceinline__ unsigned pk2(float lo, float hi) { const f32x2c v = {lo, hi}; return __builtin_bit_cast(unsigned, __builtin_convertvector(v, bf16x2c)); }
#endif
__device__ __forceinline__ bf16x8 cvt8(const f32x4 a, const f32x4 b) {
    u32x4 w; w.x = pk2(a.x, a.y); w.y = pk2(a.z, a.w); w.z = pk2(b.x, b.y); w.w = pk2(b.z, b.w); return __builtin_bit_cast(bf16x8, w);
}
__device__ __forceinline__ float bf_lo(unsigned u) { return __builtin_bit_cast(float, u << 16); }
__device__ __forceinline__ float bf_hi(unsigned u) { return __builtin_bit_cast(float, u & 0xffff0000u); }

namespace pg8 {
constexpr int BM = 256, BK = 64, HALF = 128, HTB = HALF * BK * 2, STAGE_BYTES = 8 * HTB, NXCD = 8, WGM = 8;
__host__ __device__ __forceinline__ int lds_byte(int r, int c) { const int st = (r >> 4) * 2 + (c >> 5), rr = r & 15, cc = c & 31, ob = rr * 64 + cc * 2; return st * 1024 + (ob ^ (((ob >> 9) & 1) << 5)); }
__host__ __device__ __forceinline__ void stage_rc(int b, int& R, int& C) { const int st = b / 1024, sb = b % 1024, swz = sb ^ (((sb >> 9) & 1) << 5); R = (st >> 1) * 16 + swz / 64; C = (st & 1) * 32 + (swz % 64) / 2; }
__host__ __device__ __forceinline__ int perm32(int rho) { const int n = rho >> 4, i = rho & 15; return 8 * (i >> 2) + 4 * n + (i & 3); }
struct Unit { int pm, pn, e; };

struct DenseOrder {
    static constexpr bool GATHER = false;
    const char* A; const char* Bt; int K; int nM, nN, nwg, G, c;
    __device__ __forceinline__ void init(const void* A_, const void* Bt_, int M, int N, int K_, int G_, int c_) { A = (const char*)A_; Bt = (const char*)Bt_; K = K_; nM = M / BM; nN = N / BM; nwg = nM * nN; G = G_; c = c_; }
    __device__ __forceinline__ bool next(int i, Unit& u) const {
        const long L = (long)i * G + c; if (L >= nwg) return false;
        int wgid = (int)L; { const int q = nwg / NXCD, r = nwg % NXCD, xcd = wgid % NXCD, off = wgid / NXCD; wgid = (xcd < r ? xcd * (q + 1) : r * (q + 1) + (xcd - r) * q) + off; }
        const int nig = WGM * nN, gid = wgid / nig, fm = gid * WGM, gsz = (nM - fm) < WGM ? (nM - fm) : WGM;
        u.pm = fm + ((wgid % nig) % gsz); u.pn = (wgid % nig) / gsz; u.e = 0; return true;
    }
    __device__ __forceinline__ const char* abase(const Unit& u) const { return A + (size_t)u.pm * BM * K * 2; }
    __device__ __forceinline__ const char* bbase(const Unit& u) const { return Bt + (size_t)u.pn * BM * K * 2; }
};
template <bool G>
struct MoeOrderT {
    static constexpr bool GATHER = G;
    const char* A; const char* Wt; int K; int nN, nwg, G_, c; size_t estride; const int* rbe; const int* rowmap;
    __device__ __forceinline__ bool next(int i, Unit& u) const {
        const long L = (long)i * G_ + c; if (L >= nwg) return false;
        u.pm = (int)(L / nN); u.pn = (int)(L % nN); u.e = rbe[u.pm]; return true;
    }
    __device__ __forceinline__ const char* abase(const Unit& u) const { return G ? A : A + (size_t)u.pm * BM * K * 2; }
    __device__ __forceinline__ const char* bbase(const Unit& u) const { return Wt + (size_t)u.e * estride + (size_t)u.pn * BM * K * 2; }
};
struct EpiF32 {
    static constexpr bool PERM = false;
    float* C; int ldc;
    __device__ __forceinline__ void operator()(const f32x4 (&acc)[2][2][4][2], const Unit& u, int wr, int wc, int fr, int fq) const {
        const int row0 = u.pm * BM + wr * 64 + fr, col0 = u.pn * BM + wc * 32 + 4 * fq;
#pragma unroll
        for (int ai = 0; ai < 2; ++ai)
#pragma unroll
            for (int m = 0; m < 4; ++m) { float* rowp = C + (size_t)(row0 + ai * HALF + m * 16) * ldc + col0;
#pragma unroll
                for (int bj = 0; bj < 2; ++bj)
#pragma unroll
                    for (int n = 0; n < 2; ++n) *(f32x4*)(rowp + bj * HALF + n * 16) = acc[ai][bj][m][n]; }
    }
};
struct EpiProj {
    static constexpr bool PERM = true;
    bf16_t* O; int ldc; float* G; int lastt;
    __device__ __forceinline__ void operator()(const f32x4 (&acc)[2][2][4][2], const Unit& u, int wr, int wc, int fr, int fq) const {
        const int row0 = u.pm * BM + wr * 64 + fr, col0 = u.pn * BM + wc * 32 + 8 * fq;
#pragma unroll
        for (int ai = 0; ai < 2; ++ai)
#pragma unroll
            for (int m = 0; m < 4; ++m) { bf16_t* rowp = O + (size_t)(row0 + ai * HALF + m * 16) * ldc + col0;
#pragma unroll
                for (int bj = 0; bj < 2; ++bj) { const f32x4 v0 = acc[ai][bj][m][0], v1 = acc[ai][bj][m][1];
                    u32x4 w; w.x = pk2(v0[0], v0[1]); w.y = pk2(v0[2], v0[3]); w.z = pk2(v1[0], v1[1]); w.w = pk2(v1[2], v1[3]);
                    *(u32x4*)(rowp + bj * HALF) = w; } }
        if (u.pn == lastt) {
#pragma unroll
            for (int ai = 0; ai < 2; ++ai)
#pragma unroll
                for (int m = 0; m < 4; ++m) { float* rowp = G + (size_t)(row0 + ai * HALF + m * 16) * BM + wc * 32 + 8 * fq;
#pragma unroll
                    for (int bj = 0; bj < 2; ++bj) { *(f32x4*)(rowp + bj * HALF) = acc[ai][bj][m][0]; *(f32x4*)(rowp + bj * HALF + 4) = acc[ai][bj][m][1]; } }
        }
    }
};
struct EpiBf16Bias {
    static constexpr bool PERM = true;
    bf16_t* O; int ldc; const float* bias; int bias_estride;
    __device__ __forceinline__ void operator()(const f32x4 (&acc)[2][2][4][2], const Unit& u, int wr, int wc, int fr, int fq) const {
        const int row0 = u.pm * BM + wr * 64 + fr, col0 = u.pn * BM + wc * 32 + 8 * fq;
        const float* bp = bias + (size_t)u.e * bias_estride + col0;
        f32x4 bv[2][2];
#pragma unroll
        for (int bj = 0; bj < 2; ++bj)
#pragma unroll
            for (int n = 0; n < 2; ++n) bv[bj][n] = *(const f32x4*)(bp + bj * HALF + 4 * n);
#pragma unroll
        for (int ai = 0; ai < 2; ++ai)
#pragma unroll
            for (int m = 0; m < 4; ++m) { bf16_t* rowp = O + (size_t)(row0 + ai * HALF + m * 16) * ldc + col0;
#pragma unroll
                for (int bj = 0; bj < 2; ++bj) { const f32x4 v0 = acc[ai][bj][m][0] + bv[bj][0], v1 = acc[ai][bj][m][1] + bv[bj][1];
                    u32x4 w; w.x = pk2(v0[0], v0[1]); w.y = pk2(v0[2], v0[3]); w.z = pk2(v1[0], v1[1]); w.w = pk2(v1[2], v1[3]);
                    *(u32x4*)(rowp + bj * HALF) = w; } }
    }
};
__device__ __forceinline__ float swiglu1(float g, float uu) { g = fminf(g, 7.0f); uu = fminf(fmaxf(uu, -7.0f), 7.0f); return (uu + 1.0f) * (g * frcp(1.0f + fexp(-1.702f * g))); }
struct EpiSwiglu {
    static constexpr bool PERM = true;
    bf16_t* O; const float* b1;
    __device__ __forceinline__ void operator()(const f32x4 (&acc)[2][2][4][2], const Unit& u, int wr, int wc, int fr, int fq) const {
        const int row0 = u.pm * BM + wr * 64 + fr, j0 = u.pn * HALF + wc * 32 + 8 * fq;
        const float* bg = b1 + (size_t)u.e * 2 * DFF + j0; const float* bu = bg + DFF;
        f32x4 g4[2], u4[2];
#pragma unroll
        for (int n = 0; n < 2; ++n) { g4[n] = *(const f32x4*)(bg + 4 * n); u4[n] = *(const f32x4*)(bu + 4 * n); }
#pragma unroll
        for (int ai = 0; ai < 2; ++ai)
#pragma unroll
            for (int m = 0; m < 4; ++m) {
                float o[8];
#pragma unroll
                for (int n = 0; n < 2; ++n)
#pragma unroll
                    for (int q = 0; q < 4; ++q) o[n * 4 + q] = swiglu1(acc[ai][0][m][n][q] + g4[n][q], acc[ai][1][m][n][q] + u4[n][q]);
                u32x4 w; w.x = pk2(o[0], o[1]); w.y = pk2(o[2], o[3]); w.z = pk2(o[4], o[5]); w.w = pk2(o[6], o[7]);
                *(u32x4*)(O + (size_t)(row0 + ai * HALF + m * 16) * DFF + j0) = w;
            }
    }
};

struct MoeMerged {
    static constexpr bool GATHER = true;
    const char* A1; const char* A2; const char* W1t; const char* W2t; int K; int nrb, G_, c; size_t es1, es2; const int* rbe; const int* rowmap; unsigned* cnt;
    __device__ __forceinline__ bool next(int i, Unit& u) const {
        const long L = (long)i * G_ + c; const long n1 = (long)nrb * 8;
        if (L < n1) { u.pm = (int)(L >> 3); u.pn = (int)(L & 7); }
        else { const long L2 = L - n1; if (L2 >= (long)nrb * 4) return false; u.pm = (int)(L2 >> 2); u.pn = 8 + (int)(L2 & 3); }
        u.e = rbe[u.pm]; return true;
    }
    __device__ __forceinline__ const char* abase(const Unit& u) const { return u.pn < 8 ? A1 : A2; }
    __device__ __forceinline__ const char* bbase(const Unit& u) const { return u.pn < 8 ? W1t + (size_t)u.e * es1 + (size_t)u.pn * BM * K * 2 : W2t + (size_t)u.e * es2 + (size_t)(u.pn - 8) * BM * K * 2; }
    __device__ __forceinline__ unsigned arow(const Unit& u, int r) const { return u.pn < 8 ? (unsigned)rowmap[u.pm * BM + r] : (unsigned)(u.pm * BM + r); }
    __device__ __forceinline__ void a_ready_wg(const Unit& u, int wid) const {
        if (u.pn < 8) return;
#ifdef EMU
        while (__atomic_load_n(&cnt[u.pm], __ATOMIC_ACQUIRE) < 8u) emu_yield_os();
        __syncthreads();
#else
        if (wid == 0) {
            unsigned sp = 0;
            while ((unsigned)__builtin_amdgcn_readfirstlane(__hip_atomic_load(&cnt[u.pm], __ATOMIC_RELAXED, __HIP_MEMORY_SCOPE_AGENT)) < 8u) { __builtin_amdgcn_s_sleep(1); if (++sp > (1u << 24)) break; }
            __builtin_amdgcn_fence(__ATOMIC_ACQUIRE, "agent");
            asm volatile("s_waitcnt vmcnt(0)" ::: "memory");
        }
        __builtin_amdgcn_s_barrier();
#endif
    }
    __device__ __forceinline__ void publish(int pm) const {
#ifdef EMU
        __atomic_fetch_add(&cnt[pm], 1u, __ATOMIC_RELEASE);
#else
        __hip_atomic_fetch_add(&cnt[pm], 1u, __ATOMIC_RELAXED, __HIP_MEMORY_SCOPE_AGENT);
#endif
    }
};
struct EpiMoe {
    static constexpr bool PERM = true;
    bf16_t* ACT; const float* b1; bf16_t* YS; const float* b2; unsigned act_bytes;
    __device__ __forceinline__ void operator()(const f32x4 (&acc)[2][2][4][2], const Unit& u, int wr, int wc, int fr, int fq) const {
        if (u.pn < 8) {
            const int row0 = u.pm * BM + wr * 64 + fr, j0 = u.pn * HALF + wc * 32 + 8 * fq;
            const float* bg = b1 + (size_t)u.e * 2 * DFF + j0; const float* bu = bg + DFF;
            f32x4 g4[2], u4[2];
#pragma unroll
            for (int n = 0; n < 2; ++n) { g4[n] = *(const f32x4*)(bg + 4 * n); u4[n] = *(const f32x4*)(bu + 4 * n); }
#ifndef EMU
            const __amdgpu_buffer_rsrc_t rs = __builtin_amdgcn_make_buffer_rsrc((void*)ACT, 0, (int)act_bytes, 0x00020000);
#endif
#pragma unroll
            for (int ai = 0; ai < 2; ++ai)
#pragma unroll
                for (int m = 0; m < 4; ++m) {
                    float o[8];
#pragma unroll
                    for (int n = 0; n < 2; ++n)
#pragma unroll
                        for (int q = 0; q < 4; ++q) o[n * 4 + q] = swiglu1(acc[ai][0][m][n][q] + g4[n][q], acc[ai][1][m][n][q] + u4[n][q]);
                    u32x4 w; w.x = pk2(o[0], o[1]); w.y = pk2(o[2], o[3]); w.z = pk2(o[4], o[5]); w.w = pk2(o[6], o[7]);
                    const unsigned eo = (unsigned)(row0 + ai * HALF + m * 16) * (unsigned)DFF + (unsigned)j0;
#ifdef EMU
                    *(u32x4*)(ACT + eo) = w;
#else
                    __builtin_amdgcn_raw_buffer_store_b128(w, rs, eo * 2u, 0,   16);
#endif
                }
        } else {
            const int row0 = u.pm * BM + wr * 64 + fr, col0 = (u.pn - 8) * BM + wc * 32 + 8 * fq;
            const float* bp = b2 + (size_t)u.e * D + col0;
            f32x4 bv[2][2];
#pragma unroll
            for (int bj = 0; bj < 2; ++bj)
#pragma unroll
                for (int n = 0; n < 2; ++n) bv[bj][n] = *(const f32x4*)(bp + bj * HALF + 4 * n);
#pragma unroll
            for (int ai = 0; ai < 2; ++ai)
#pragma unroll
                for (int m = 0; m < 4; ++m) { bf16_t* rowp = YS + (size_t)(row0 + ai * HALF + m * 16) * D + col0;
#pragma unroll
                    for (int bj = 0; bj < 2; ++bj) { const f32x4 v0 = acc[ai][bj][m][0] + bv[bj][0], v1 = acc[ai][bj][m][1] + bv[bj][1];
                        u32x4 w; w.x = pk2(v0[0], v0[1]); w.y = pk2(v0[2], v0[3]); w.z = pk2(v1[0], v1[1]); w.w = pk2(v1[2], v1[3]);
                        *(u32x4*)(rowp + bj * HALF) = w; } }
        }
    }
};
template <class S_> struct has_handoff { static constexpr bool value = false; };
template <> struct has_handoff<MoeMerged> { static constexpr bool value = true; };

template <class Epi, class Sched, bool SP2 = (MK_SP2 != 0)>
__device__ __forceinline__ void gemm_phase(LAS unsigned char* lds, const int K, const Sched& S, const Epi& E, const int tid) {
    const int wid = RFL(tid >> 6), lane = tid & 63, wr = wid >> 2, wc = wid & 3, fr = lane & 15, fq = lane >> 4;
    const int nt = K / BK;
    unsigned voffA[2], voffB[2]; int gR[2]; unsigned gC[2];
#pragma unroll
    for (int i = 0; i < 2; ++i) { int R, C; stage_rc(tid * 16 + i * 8192, R, C); const int Rb = Epi::PERM ? ((R & ~31) + perm32(R & 31)) : R;
        voffA[i] = (unsigned)(R * K + C) * 2u; voffB[i] = (unsigned)(Rb * K + C) * 2u; gR[i] = R; gC[i] = (unsigned)C * 2u; }
    unsigned va[2][2], vn[2][2];
#define PG8_GOFF(dst, unit) do { if constexpr (Sched::GATHER) { _Pragma("unroll") for (int h_ = 0; h_ < 2; ++h_) _Pragma("unroll") for (int i_ = 0; i_ < 2; ++i_) { \
        if constexpr (has_handoff<Sched>::value) dst[h_][i_] = S.arow(unit, h_ * HALF + gR[i_]) * (unsigned)(K * 2) + gC[i_]; \
        else dst[h_][i_] = (unsigned)S.rowmap[(unit).pm * BM + h_ * HALF + gR[i_]] * (unsigned)(K * 2) + gC[i_]; } } } while (0)
#define PG8_STAGE_A(bufoff, bp, kb, h, nx) do { if constexpr (Sched::GATHER) { const char* gb_ = ((nx) ? nA : cA) + (kb); _Pragma("unroll") for (int _i = 0; _i < 2; ++_i) \
        GLDS16(gb_ + ((nx) ? vn[h][_i] : va[h][_i]), lds + (bufoff) + ldsw + _i * 8192); } else { PG8_STAGE(bufoff, bp, voffA); } } while (0)
    const size_t kstep = (size_t)(BK * 2);
    const size_t hstep = (size_t)HALF * K * 2;
    const unsigned ldsw = (unsigned)wid * 1024u;
    const int aoff = lds_byte(wr * 64 + fr, fq * 8), boff = lds_byte(wc * 32 + fr, fq * 8);
#define PG8_SA(b, h) (((b) * 2 + (h)) * HTB)
#define PG8_SB(b, h) ((4 + (b) * 2 + (h)) * HTB)
#define PG8_STAGE(bufoff, gbase, voff) do { _Pragma("unroll") for (int _i = 0; _i < 2; ++_i) \
        GLDS16((const char*)(gbase) + (voff)[_i], lds + (bufoff) + ldsw + _i * 8192); } while (0)
#define PG8_LDA(dst, b, h) do { _Pragma("unroll") for (int m = 0; m < 4; ++m) _Pragma("unroll") for (int k = 0; k < 2; ++k) dst[m][k] = *(const LAS bf16x8*)(lds + PG8_SA(b, h) + aoff + m * 2048 + k * 1024); } while (0)
#define PG8_LDB(dst, b, h) do { _Pragma("unroll") for (int n = 0; n < 2; ++n) _Pragma("unroll") for (int k = 0; k < 2; ++k) dst[n][k] = *(const LAS bf16x8*)(lds + PG8_SB(b, h) + boff + n * 2048 + k * 1024); } while (0)
#define PG8_MMA(ai, bj, At, Bt) do { SETPRIO(1); _Pragma("unroll") for (int m = 0; m < 4; ++m) _Pragma("unroll") for (int n = 0; n < 2; ++n) _Pragma("unroll") for (int k = 0; k < 2; ++k) \
        acc[ai][bj][m][n] = MFMA16(Bt[n][k], At[m][k], acc[ai][bj][m][n]); SETPRIO(0); } while (0)
    Unit cur, nxt; int ui = 0;
    if (!S.next(0, cur)) return;
    f32x4 acc[2][2][4][2];
#pragma unroll
    for (int a = 0; a < 2; ++a)
#pragma unroll
        for (int b = 0; b < 2; ++b)
#pragma unroll
            for (int m = 0; m < 4; ++m)
#pragma unroll
                for (int n = 0; n < 2; ++n) acc[a][b][m][n] = (f32x4){0.f, 0.f, 0.f, 0.f};
    bf16x8 At[4][2], B0[2][2], B1[2][2];
    const char* cA = S.abase(cur); const char* cB = S.bbase(cur);
    const char* nA = cA;
    int pub_pm = -1;
    if constexpr (has_handoff<Sched>::value) S.a_ready_wg(cur, wid);
    PG8_GOFF(va, cur);
    if constexpr (SP2) {
        PG8_STAGE(PG8_SB(0, 0), cB, voffB); PG8_STAGE(PG8_SB(0, 1), cB + hstep, voffB); PG8_STAGE_A(PG8_SA(0, 0), cA, 0, 0, false); PG8_STAGE_A(PG8_SA(0, 1), cA + hstep, 0, 1, false);
        if (wr == 1) S_BARRIER();
        WAIT_V(2); S_BARRIER();
        PG8_STAGE(PG8_SB(1, 0), cB + kstep, voffB); PG8_STAGE_A(PG8_SA(1, 0), cA + kstep, kstep, 0, false); PG8_STAGE(PG8_SB(1, 1), cB + hstep + kstep, voffB);
        WAIT_V(6); S_BARRIER();
    } else {
    PG8_STAGE(PG8_SB(0, 0), cB, voffB); PG8_STAGE_A(PG8_SA(0, 0), cA, 0, 0, false); PG8_STAGE(PG8_SB(0, 1), cB + hstep, voffB); PG8_STAGE_A(PG8_SA(0, 1), cA + hstep, 0, 1, false);
    if (wr == 1) S_BARRIER();
    WAIT_V(4); S_BARRIER();
    PG8_STAGE(PG8_SB(1, 0), cB + kstep, voffB); PG8_STAGE_A(PG8_SA(1, 0), cA + kstep, kstep, 0, false); PG8_STAGE(PG8_SB(1, 1), cB + hstep + kstep, voffB);
    WAIT_V(6); S_BARRIER();
    }
    for (;;) {
        const bool has_next = S.next(ui + 1, nxt);
        const char* nA = has_next ? S.abase(nxt) : cA; const char* nB = has_next ? S.bbase(nxt) : cB;
        if constexpr (has_handoff<Sched>::value) { if (has_next) S.a_ready_wg(nxt, wid); }
        if constexpr (Sched::GATHER) { if (has_next) { PG8_GOFF(vn, nxt); } else {
#pragma unroll
            for (int h_ = 0; h_ < 2; ++h_) { vn[h_][0] = va[h_][0]; vn[h_][1] = va[h_][1]; } } }
        for (int t = 0; t < nt; t += 2) {
            const bool last = (t == nt - 2);
            if constexpr (has_handoff<Sched>::value) {
                if (t == 4 && pub_pm >= 0) { if (tid == 0) S.publish(pub_pm); pub_pm = -1; } }
            const char* a1 = cA + (size_t)(t + 1) * kstep;
            const char* a2 = last ? nA : cA + (size_t)(t + 2) * kstep; const char* b2 = last ? nB : cB + (size_t)(t + 2) * kstep;
            const char* a3 = a2 + kstep; const char* b3 = b2 + kstep;
            if constexpr (SP2) {
            PG8_LDB(B0, 0, 0); PG8_LDB(B1, 0, 1); SCHED_BAR(); PG8_LDA(At, 0, 0); PG8_STAGE_A(PG8_SA(1, 1), a1 + hstep, (size_t)(t + 1) * kstep, 1, false);
            WAIT_V(8); WAIT_L(0); S_BARRIER(); PG8_MMA(0, 0, At, B0); PG8_MMA(0, 1, At, B1); S_BARRIER(); SCHED_BAR();
            PG8_LDA(At, 0, 1); PG8_STAGE(PG8_SB(0, 0), b2, voffB); PG8_STAGE(PG8_SB(0, 1), b2 + hstep, voffB); PG8_STAGE_A(PG8_SA(0, 0), a2, (last ? (size_t)0 : (size_t)(t + 2) * kstep), 0, last);
            WAIT_V(8); WAIT_L(0); S_BARRIER(); PG8_MMA(1, 0, At, B0); PG8_MMA(1, 1, At, B1); S_BARRIER(); SCHED_BAR();
            PG8_LDB(B0, 1, 0); PG8_LDB(B1, 1, 1); SCHED_BAR(); PG8_LDA(At, 1, 0); PG8_STAGE_A(PG8_SA(0, 1), a2 + hstep, (last ? (size_t)0 : (size_t)(t + 2) * kstep), 1, last);
            WAIT_V(8); WAIT_L(0); S_BARRIER(); PG8_MMA(0, 0, At, B0); PG8_MMA(0, 1, At, B1); S_BARRIER(); SCHED_BAR();
            PG8_LDA(At, 1, 1); PG8_STAGE(PG8_SB(1, 0), b3, voffB); PG8_STAGE(PG8_SB(1, 1), b3 + hstep, voffB); PG8_STAGE_A(PG8_SA(1, 0), a3, (last ? kstep : (size_t)(t + 3) * kstep), 0, last);
            WAIT_V(8); WAIT_L(0); S_BARRIER(); PG8_MMA(1, 0, At, B0); PG8_MMA(1, 1, At, B1); S_BARRIER(); SCHED_BAR();
            } else {
            PG8_LDB(B0, 0, 0); SCHED_BAR(); PG8_LDA(At, 0, 0); PG8_STAGE_A(PG8_SA(1, 1), a1 + hstep, (size_t)(t + 1) * kstep, 1, false);
            WAIT_L(8); S_BARRIER(); WAIT_L(0); PG8_MMA(0, 0, At, B0); S_BARRIER(); SCHED_BAR();
            PG8_LDB(B1, 0, 1); PG8_STAGE(PG8_SB(0, 0), b2, voffB);
            S_BARRIER(); WAIT_L(0); PG8_MMA(0, 1, At, B1); S_BARRIER();
            PG8_LDA(At, 0, 1); PG8_STAGE_A(PG8_SA(0, 0), a2, (last ? (size_t)0 : (size_t)(t + 2) * kstep), 0, last);
            S_BARRIER(); WAIT_L(0); PG8_MMA(1, 0, At, B0); S_BARRIER(); SCHED_BAR();
            PG8_STAGE(PG8_SB(0, 1), b2 + hstep, voffB);
            WAIT_V(6); S_BARRIER(); PG8_MMA(1, 1, At, B1); S_BARRIER();
            PG8_LDB(B0, 1, 0); SCHED_BAR(); PG8_LDA(At, 1, 0); PG8_STAGE_A(PG8_SA(0, 1), a2 + hstep, (last ? (size_t)0 : (size_t)(t + 2) * kstep), 1, last);
            WAIT_L(8); S_BARRIER(); WAIT_L(0); PG8_MMA(0, 0, At, B0); S_BARRIER(); SCHED_BAR();
            PG8_LDB(B1, 1, 1); PG8_STAGE(PG8_SB(1, 0), b3, voffB);
            S_BARRIER(); WAIT_L(0); PG8_MMA(0, 1, At, B1); S_BARRIER();
            PG8_LDA(At, 1, 1); PG8_STAGE_A(PG8_SA(1, 0), a3, (last ? kstep : (size_t)(t + 3) * kstep), 0, last);
            S_BARRIER(); WAIT_L(0); PG8_MMA(1, 0, At, B0); S_BARRIER(); SCHED_BAR();
            PG8_STAGE(PG8_SB(1, 1), b3 + hstep, voffB);
            WAIT_V(6); S_BARRIER(); PG8_MMA(1, 1, At, B1); S_BARRIER();
            }
        }
        if (wr == 0) S_BARRIER();
        E(acc, cur, wr, wc, fr, fq);
        if constexpr (has_handoff<Sched>::value) pub_pm = cur.pn < 8 ? cur.pm : -1;
        if (!has_next) break;
#pragma unroll
        for (int a = 0; a < 2; ++a)
#pragma unroll
            for (int b = 0; b < 2; ++b)
#pragma unroll
                for (int m = 0; m < 4; ++m)
#pragma unroll
                    for (int n = 0; n < 2; ++n) acc[a][b][m][n] = (f32x4){0.f, 0.f, 0.f, 0.f};
        cur = nxt; cA = nA; cB = nB; ++ui;
        if constexpr (Sched::GATHER) {
#pragma unroll
            for (int h_ = 0; h_ < 2; ++h_) { va[h_][0] = vn[h_][0]; va[h_][1] = vn[h_][1]; } }
        if (wr == 1) S_BARRIER();
    }
    WAIT_V(0);
    S_BARRIER();
    if constexpr (has_handoff<Sched>::value) { if (pub_pm >= 0 && tid == 0) S.publish(pub_pm); }
#undef PG8_SA
#undef PG8_SB
#undef PG8_STAGE
#undef PG8_STAGE_A
#undef PG8_GOFF
#undef PG8_LDA
#undef PG8_LDB
#undef PG8_MMA
}
}

__device__ __forceinline__ float row16_sum(float x) {
#ifdef EMU
    x += __shfl_xor(x, 1); x += __shfl_xor(x, 2); x += __shfl_xor(x, 4); x += __shfl_xor(x, 8); return x;
#else
#define DPPF(v, ctrl) __builtin_bit_cast(float, __builtin_amdgcn_update_dpp(0, __builtin_bit_cast(int, (v)), (ctrl), 0xF, 0xF, false))
    x += DPPF(x, 0xB1); x += DPPF(x, 0x4E); x += DPPF(x, 0x141); x += DPPF(x, 0x140); return x;
#undef DPPF
#endif
}
__device__ __forceinline__ float row32_sum(float x) {
    x = row16_sum(x);
#ifdef EMU
    x += __shfl_xor(x, 32); return x;
#else
    float a = x, b = x;
    asm volatile("s_nop 1\n\tv_permlane32_swap_b32 %0, %1" : "+v"(a), "+v"(b));
    return a + b;
#endif
}
__device__ __forceinline__ float wave_sum_fast(float x, int lane) {
    x = row32_sum(x);
    x += SHX(x, 16, lane);
    return x;
}
__device__ __forceinline__ void transpose_item(const float* W, int K, int N, bf16_t* WT, int k0, int n0, int dst_row0, float* scr, int lane) {
    const int n4 = (lane & 15) * 4, kr = lane >> 4;
#pragma unroll 8
    for (int i = 0; i < 16; ++i) {
        const int kk = 4 * i + kr;
        f32x4 v = (f32x4){0.f, 0.f, 0.f, 0.f};
        if (n0 + n4 < N) v = *(const f32x4*)(W + (size_t)(k0 + kk) * N + n0 + n4);
        float* d = scr + kk * 65 + n4; d[0] = v.x; d[1] = v.y; d[2] = v.z; d[3] = v.w;
    }
    WAVE_SYNC();
    const int c = lane & 7;
#pragma unroll
    for (int j = 0; j < 8; ++j) { const int n = (lane >> 3) + 8 * j; const float* sp = scr + (8 * c) * 65 + n;
        u32x4 o; o.x = pk2(sp[0 * 65], sp[1 * 65]); o.y = pk2(sp[2 * 65], sp[3 * 65]); o.z = pk2(sp[4 * 65], sp[5 * 65]); o.w = pk2(sp[6 * 65], sp[7 * 65]);
        *(u32x4*)(WT + (size_t)(dst_row0 + n) * K + k0 + 8 * c) = o; }
    WAVE_SYNC();
}
__device__ __forceinline__ void phase_prologue(const Params& P, unsigned char* smem, int wv) {
    ParamsPtr pp = PARAMS_PTR(P); PIN_S(pp); unsigned char* ws = pp->ws; int bidx = (int)blockIdx.x, gdim = (int)gridDim.x; PIN_S(bidx); PIN_S(gdim);
    const int tid = phase_tid(wv), lane = tid & 63, wave = tid >> 6;
    float* scr = (float*)smem + wave * (64 * 65);
    const int gw = bidx * NWAVES + wave, ngw = NWAVES * gdim;
    constexpr int I_IN = 16 * (PLD / 64), I_OUT = 16 * 16, I_W1 = NE * 16 * 32, I_W2 = NE * 16 * 16, I_L = I_IN + I_OUT + I_W1 + I_W2;
    for (int it = gw; it < NL * I_L; it += ngw) {
        const int l = it / I_L; int r = it % I_L;
        if (r < I_IN) { const int kb = r / (PLD / 64), nb = r % (PLD / 64);
            transpose_item(pp->in[1] + (size_t)l * D * PIN, D, PIN, (bf16_t*)(ws + O_WIN) + (size_t)l * PLD * D, kb * 64, nb * 64, nb * 64, scr, lane); continue; }
        r -= I_IN;
        if (r < I_OUT) { const int kb = r / 16, nb = r % 16;
            transpose_item(pp->in[21] + (size_t)l * D * D, D, D, (bf16_t*)(ws + O_WOUT) + (size_t)l * D * D, kb * 64, nb * 64, nb * 64, scr, lane); continue; }
        r -= I_OUT;
        if (r < I_W1) { const int e = r / (16 * 32), q = r % (16 * 32), kb = q / 32, nb = q % 32, n0 = nb * 64;
            const int dst = n0 < DFF ? (n0 / 128) * 256 + (n0 % 128) : ((n0 - DFF) / 128) * 256 + 128 + ((n0 - DFF) % 128);
            transpose_item(pp->in[26] + ((size_t)l * NE + e) * D * 2 * DFF, D, 2 * DFF, (bf16_t*)(ws + O_W1) + ((size_t)l * NE + e) * 2 * DFF * D, kb * 64, n0, dst, scr, lane); continue; }
        r -= I_W1;
        { const int e = r / (16 * 16), q = r % (16 * 16), kb = q / 16, nb = q % 16;
            transpose_item(pp->in[28] + ((size_t)l * NE + e) * DFF * D, DFF, D, (bf16_t*)(ws + O_W2) + ((size_t)l * NE + e) * D * DFF, kb * 64, nb * 64, nb * 64, scr, lane); }
    }
    {
        const float* gw_ = pp->in[4]; bf16_t* WSB = (bf16_t*)(ws + O_WSB);
        for (size_t i = ((size_t)bidx * NTHREADS + tid) * 4; i < (size_t)NL * GH * CH * CH; i += (size_t)gdim * NTHREADS * 4) {
            const f32x4 v = *(const f32x4*)(gw_ + i); u32x2 o; o.x = pk2(v.x, v.y); o.y = pk2(v.z, v.w); *(u32x2*)(WSB + i) = o;
        }
    }
    {
        bf16_t* LWT = (bf16_t*)(ws + O_LWT);
        for (int i = bidx * NTHREADS + tid; i < NL * 1920 * 128; i += gdim * NTHREADS) {
            const int k = i & 127, n = (i >> 7) % 1920, ll = i / (1920 * 128);
            float v = 0.f;
            if (n < 1536) { if (k < 64) { const int grp = n / 768, d = (n / 384) & 1, c = n % 384; v = (grp == 0 ? pp->in[8] : pp->in[10])[(((size_t)ll * 2 + d) * 64 + k) * RW + c]; } }
            else v = pp->in[11][((size_t)ll * 128 + k) * RW + (n - 1536)];
            LWT[i] = (bf16_t)f2bf(v);
        }
    }
    {
        bf16_t* RWT = (bf16_t*)(ws + O_RWT);
        for (int i = bidx * NTHREADS + tid; i < NL * NE * D; i += gdim * NTHREADS) {
            const int k = i % D, e = (i / D) % NE, ll = i / (D * NE);
            const float v = pp->in[24][((size_t)ll * D + k) * NE + e];
            const unsigned hi = f2bf(v); const float lo = v - bf_lo(hi);
            RWT[((size_t)(ll * 2 + 0) * NE + e) * D + k] = (bf16_t)hi; RWT[((size_t)(ll * 2 + 1) * NE + e) * D + k] = (bf16_t)f2bf(lo);
        }
    }
    const float* x = pp->in[0]; bf16_t* XB = (bf16_t*)(ws + O_XB);
    for (size_t i = ((size_t)bidx * NTHREADS + tid) * 4; i < (size_t)T * D; i += (size_t)gdim * NTHREADS * 4) {
        const f32x4 v = *(const f32x4*)(x + i); u32x2 o; o.x = pk2(v.x, v.y); o.y = pk2(v.z, v.w); *(u32x2*)(XB + i) = o;
    }
}

__device__ __forceinline__ float tshift(const float* P, int t, int s, int col, const float* mu0, const float* mu1, int rc) {
    const float cur = P[(size_t)t * PLD + col];
    const float prv = s > 0 ? P[(size_t)(t - 1) * PLD + col] : 0.f;
    const float nxt = s < S - 1 ? P[(size_t)(t + 1) * PLD + col] : 0.f;
    return cur + mu0[rc] * (prv - cur) + mu1[rc] * (nxt - cur);
}

__device__ __forceinline__ void phase_prep(const Params& P, int l, unsigned char* smem, int wv) {
    ParamsPtr pp = PARAMS_PTR(P); PIN_S(pp); unsigned char* ws = pp->ws; int bidx = (int)blockIdx.x, gdim = (int)gridDim.x; PIN_S(bidx); PIN_S(gdim);
    const bf16_t* proj = (const bf16_t*)(ws + O_PROJ); const float* projg = (const float*)(ws + O_PROJG);
    float* UG = (float*)(ws + O_UG); bf16_t* VNT = (bf16_t*)(ws + O_VNT);
    float* RR = (float*)(ws + O_RR); float* VV = (float*)(ws + O_VV); float* KK = (float*)(ws + O_KK);
    float* KD = (float*)(ws + O_KD); float* ICLR = (float*)(ws + O_ICLR);
    float* GATE = (float*)(ws + O_GATE); float* BONUS = (float*)(ws + O_BONUS); float* LWG = (float*)(ws + O_LW);
    bf16_t* RB = (bf16_t*)(ws + O_RB); bf16_t* VB = (bf16_t*)(ws + O_VB); bf16_t* KKB = (bf16_t*)(ws + O_KKB); bf16_t* BBB = (bf16_t*)(ws + O_BBB); bf16_t* KDB = (bf16_t*)(ws + O_KDB);
#if !MK_RWKV_CHUNKED
    float* DEC = (float*)(ws + O_DEC); float* BRKR = (float*)(ws + O_BRKR);
#endif
    bf16_t* MQB = (bf16_t*)(ws + O_MQB); bf16_t* MKB = (bf16_t*)(ws + O_MKB); bf16_t* KT = (bf16_t*)(ws + O_KT); bf16_t* VT = (bf16_t*)(ws + O_VT);
    float* IG = (float*)(ws + O_IG); float* LF = (float*)(ws + O_LF);
    const bf16_t* LWT = (const bf16_t*)(ws + O_LWT) + (size_t)l * 1920 * 128;
    const float* gln_g = pp->in[2] + (size_t)l * GW; const float* gln_b = pp->in[3] + (size_t)l * GW;
    const float* mu0 = pp->in[6] + (size_t)l * 2 * RPROJ; const float* mu1 = mu0 + RPROJ;
    const float* w0 = pp->in[7] + (size_t)l * 2 * RW; const float* a0 = pp->in[9] + (size_t)l * 2 * RW;
    const float* k_k = pp->in[12] + (size_t)l * RW; const float* k_a = pp->in[13] + (size_t)l * RW; const float* r_k = pp->in[14] + (size_t)l * RW;
    const float* conv_w = pp->in[17] + (size_t)l * 3 * 768; const float* conv_b = pp->in[18] + (size_t)l * 768; const float* gate_b = pp->in[19] + (size_t)l * 24;
    float* win = (float*)smem;
    bf16_t* lin = (bf16_t*)(smem + 101376);
    bf16_t* tvn = (bf16_t*)(smem + 110592);
    bf16_t* tk = (bf16_t*)(smem + 118784);
    bf16_t* tv = (bf16_t*)(smem + 131072);
    constexpr int LIN = 264;
    const int tid = phase_tid(wv), lane = tid & 63, wave = tid >> 6, col = lane & 15, g = lane >> 4;
    for (int u = bidx; u < T / 16; u += gdim) {
        const int t0 = u * 16, s0 = t0 % S, bb = t0 / S;
        __syncthreads();
        {
            u32x2 wb[18];
#pragma unroll
            for (int row = 0; row < 18; ++row) {
                const int sq = s0 - 1 + row;
                wb[row] = (u32x2){0u, 0u};
                if (sq >= 0 && sq < S && tid < 352) wb[row] = *(const u32x2*)(proj + (size_t)(t0 - 1 + row) * PLD + C_RW + tid * 4);
            }
            if (tid < 352) {
#pragma unroll
                for (int row = 0; row < 18; ++row) *(f32x4*)(win + row * RPROJ + tid * 4) = (f32x4){bf_lo(wb[row].x), bf_hi(wb[row].x), bf_lo(wb[row].y), bf_hi(wb[row].y)};
            }
        }
        for (int rep_ = 0; rep_ < (MK_PROBE == 3 ? 2 : 1); ++rep_) {
            const int i = tid >> 5, l32 = tid & 31, t = t0 + i;
            float v[8], ug[8]; float sum = 0.f;
#pragma unroll
            for (int j = 0; j < 8; ++j) { const int c = j * 32 + l32; ug[j] = bf_lo((unsigned)proj[(size_t)t * PLD + c]); v[j] = bf_lo((unsigned)proj[(size_t)t * PLD + GW + c]); }
#pragma unroll
            for (int j = 0; j < 8; ++j) { const int c = j * 32 + l32; UG[(size_t)t * GW + c] = geluf_(ug[j]); v[j] = geluf_(v[j]); sum += v[j]; }
#pragma unroll
            for (int o = 16; o >= 1; o >>= 1) sum += SHX(sum, o, lane);
            const float mean = sum * (1.0f / GW); float q = 0.f;
#pragma unroll
            for (int j = 0; j < 8; ++j) { const float d = v[j] - mean; q += d * d; }
#pragma unroll
            for (int o = 16; o >= 1; o >>= 1) q += SHX(q, o, lane);
            const float rstd = 1.0f / sqrtf(q * (1.0f / GW) + LN_EPS);
#pragma unroll
            for (int j = 0; j < 8; ++j) { const int c = j * 32 + l32; tvn[c * 16 + i] = (bf16_t)f2bf((v[j] - mean) * rstd * gln_g[c] + gln_b[c]); }
        }
        __syncthreads();
        {
            const int hf = tid & 1, c = tid >> 1;
            *(u32x4*)(VNT + ((size_t)bb * GW + c) * S + s0 + hf * 8) = *(const u32x4*)(tvn + c * 16 + hf * 8);
        }
        for (int idx = tid; idx < 16 * 256; idx += NTHREADS) {
            const int i = idx >> 8, j = idx & 255, rc = 1152 + j;
            const float pv = win[i * RPROJ + rc], cv = win[(i + 1) * RPROJ + rc], nv = win[(i + 2) * RPROJ + rc];
            const float x = cv + mu0[rc] * (pv - cv) + mu1[rc] * (nv - cv);
            lin[i * LIN + j] = (bf16_t)f2bf(j < 64 ? ftanh(x) : (j < 128 ? x : sigmoidf_(x)));
        }
        __syncthreads();
        for (int rep_ = 0; rep_ < (MK_PROBE == 1 ? 2 : 1); ++rep_) {
#pragma unroll 1
            for (int qg = 0; qg < 3; ++qg) {
                bf16x8 bw_[5][4]; float bias_[5];
#pragma unroll
                for (int q5 = 0; q5 < 5; ++q5) {
                    const int nt = wave * 15 + qg * 5 + q5, grp = nt / 24, c = (nt % 24) * 16 + col;
                    const bf16_t* bw = LWT + (size_t)(nt * 16 + col) * 128 + 8 * g;
#pragma unroll
                    for (int ks = 0; ks < 2; ++ks) bw_[q5][ks] = *(const bf16x8*)(bw + ks * 32);
                    if (grp == 4) {
#pragma unroll
                        for (int ks = 2; ks < 4; ++ks) bw_[q5][ks] = *(const bf16x8*)(bw + ks * 32);
                    }
                    bias_[q5] = grp < 2 ? w0[grp * RW + c] : (grp < 4 ? a0[(grp - 2) * RW + c] : 0.f);
                }
#pragma unroll
                for (int q5 = 0; q5 < 5; ++q5) {
                    const int nt = wave * 15 + qg * 5 + q5, grp = nt / 24, c = (nt % 24) * 16 + col;
                    const int kcol = grp < 2 ? 0 : (grp < 4 ? 64 : 128);
                    f32x4 acc = (f32x4){0.f, 0.f, 0.f, 0.f};
#pragma unroll
                    for (int ks = 0; ks < 2; ++ks) acc = MFMA16(*(const bf16x8*)(lin + col * LIN + kcol + ks * 32 + 8 * g), bw_[q5][ks], acc);
                    if (grp == 4) {
#pragma unroll
                        for (int ks = 2; ks < 4; ++ks) acc = MFMA16(*(const bf16x8*)(lin + col * LIN + kcol + ks * 32 + 8 * g), bw_[q5][ks], acc);
                    }
                    if (grp < 2) {
#pragma unroll
                        for (int r = 0; r < 4; ++r) { const float lw = -fexp(-softplusf_(-(acc[r] + bias_[q5])) - 0.5f); const size_t o = (size_t)grp * T * RW + (size_t)(t0 + 4 * g + r) * RW + c; LWG[o] = lw;
#if !MK_RWKV_CHUNKED
                            DEC[o] = expf(lw);
#endif
                        }
                    } else if (grp < 4) {
#pragma unroll
                        for (int r = 0; r < 4; ++r) ICLR[(size_t)(grp - 2) * T * RW + (size_t)(t0 + 4 * g + r) * RW + c] = sigmoidf_(acc[r] + bias_[q5]);
                    } else {
#pragma unroll
                        for (int r = 0; r < 4; ++r) GATE[(size_t)(t0 + 4 * g + r) * RW + c] = acc[r];
                    }
                }
            }
        }
        __syncthreads();
        for (int rep_ = 0; rep_ < (MK_PROBE == 2 ? 2 : 1); ++rep_) if (wave < 6) {
            const int c = tid, h = wave;
            const float kkc = k_k[c], kac = k_a[c], rkc = r_k[c];
            const float m0r = mu0[c], m1r = mu1[c], m0k = mu0[RW + c], m1k = mu1[RW + c], m0v = mu0[2 * RW + c], m1v = mu1[2 * RW + c];
            float ic0[16], ic1[16];
#pragma unroll
            for (int i = 0; i < 16; ++i) { const size_t o = (size_t)(t0 + i) * RW + c; ic0[i] = ICLR[o]; ic1[i] = ICLR[(size_t)T * RW + o]; }
#pragma unroll
            for (int i = 0; i < 16; ++i) {
                const int t = t0 + i;
                const float* w_ = win + i * RPROJ + c;
                const float rp = w_[0], rc_ = w_[RPROJ], rn = w_[2 * RPROJ];
                const float kp = w_[RW], kc_ = w_[RPROJ + RW], kn = w_[2 * RPROJ + RW];
                const float vp = w_[2 * RW], vc_ = w_[RPROJ + 2 * RW], vn = w_[2 * RPROJ + 2 * RW];
                const float r = rc_ + m0r * (rp - rc_) + m1r * (rn - rc_);
                const float k = kc_ + m0k * (kp - kc_) + m1k * (kn - kc_);
                const float v = vc_ + m0v * (vp - vc_) + m1v * (vn - vc_);
                const size_t o = (size_t)t * RW + c;
                const float kq = k * kkc;
                const float n2 = wave_sum_fast(kq * kq, lane);
                const float kk = kq / fmaxf(sqrtf(n2), 1e-12f);
                const float kd0 = k * (1.0f + (ic0[i] - 1.0f) * kac), kd1 = k * (1.0f + (ic1[i] - 1.0f) * kac);
                const float bon = wave_sum_fast(r * (kd0 + kd1) * rkc, lane);
#if MK_RWKV_CHUNKED
                RB[o] = (bf16_t)f2bf(r); VB[o] = (bf16_t)f2bf(v); KKB[o] = (bf16_t)f2bf(kk);
                BBB[o] = (bf16_t)f2bf(kk * ic0[i]); BBB[(size_t)T * RW + o] = (bf16_t)f2bf(kk * ic1[i]);
                KDB[o] = (bf16_t)f2bf(kd0); KDB[(size_t)T * RW + o] = (bf16_t)f2bf(kd1);
#else
                RR[o] = r; VV[o] = v; KK[o] = kk;
                KD[o] = kd0; KD[(size_t)T * RW + o] = kd1;
#endif
                if (lane == 0) BONUS[(size_t)t * RH + h] = bon;
#if !MK_RWKV_CHUNKED
                { const float br0 = wave_sum(kk * ic0[i] * r, lane), br1 = wave_sum(kk * ic1[i] * r, lane), kr0 = wave_sum(kd0 * r, lane), kr1 = wave_sum(kd1 * r, lane);
                  if (lane == 0) { BRKR[((size_t)t * RH + h) * 2] = br0; BRKR[((size_t)t * RH + h) * 2 + 1] = kr0; BRKR[((size_t)(T + t) * RH + h) * 2] = br1; BRKR[((size_t)(T + t) * RH + h) * 2 + 1] = kr1; } }
#endif
            }
        }
        __syncthreads();
        {
            u32x2 wb[9], vb[3];
            const int rsel = tid >= 192 ? 1 : 0, c4 = tid - rsel * 192;
#pragma unroll
            for (int it = 0; it < 9; ++it) {
                const int row = 2 * it + rsel, sq = s0 - 1 + row;
                wb[it] = (u32x2){0u, 0u};
                if (tid < 384 && sq >= 0 && sq < S) wb[it] = *(const u32x2*)(proj + (size_t)(t0 - 1 + row) * PLD + C_MW + c4 * 4);
            }
#pragma unroll
            for (int it = 0; it < 3; ++it) { const int idx = tid + it * NTHREADS, i = idx / 96, cc = (idx % 96) * 4; vb[it] = *(const u32x2*)(proj + (size_t)(t0 + i) * PLD + C_MW + 2 * MW + cc); }
            if (tid < 384) {
#pragma unroll
                for (int it = 0; it < 9; ++it) *(f32x4*)(win + (2 * it + rsel) * 768 + c4 * 4) = (f32x4){bf_lo(wb[it].x), bf_hi(wb[it].x), bf_lo(wb[it].y), bf_hi(wb[it].y)};
            }
#pragma unroll
            for (int it = 0; it < 3; ++it) { const int idx = tid + it * NTHREADS, i = idx / 96, cc = (idx % 96) * 4; const u32x2 v = vb[it];
                tv[(cc + 0) * 16 + i] = (bf16_t)(v.x & 0xffffu); tv[(cc + 1) * 16 + i] = (bf16_t)(v.x >> 16); tv[(cc + 2) * 16 + i] = (bf16_t)(v.y & 0xffffu); tv[(cc + 3) * 16 + i] = (bf16_t)(v.y >> 16); }
        }
        for (int idx = tid; idx < 16 * 24; idx += NTHREADS) {
            const int i = idx / 24, gi = idx % 24, t = t0 + i;
            const int isf = gi / 12, dir = (gi / 6) & 1, h = gi % 6;
            const float gg = projg[(size_t)t * 256 + (3456 - (PLD - 256)) + gi] + gate_b[gi];
            if (isf) LF[((size_t)dir * T + t) * MH + h] = -softplusf_(-gg); else IG[((size_t)dir * T + t) * MH + h] = gg;
        }
        __syncthreads();
        for (int rep_ = 0; rep_ < (MK_PROBE == 4 ? 2 : 1); ++rep_)
        for (int idx = tid; idx < 16 * 768; idx += NTHREADS) {
            const int i = idx / 768, c = idx % 768, t = t0 + i;
            const float* w_ = win + i * 768 + c;
            float y = conv_b[c] + w_[0] * conv_w[c] + w_[768] * conv_w[768 + c] + w_[1536] * conv_w[2 * 768 + c];
            y = y * sigmoidf_(y);
            if (c < MW) MQB[(size_t)t * MW + c] = (bf16_t)f2bf(y);
            else { const bf16_t kb = (bf16_t)f2bf(y * 0.125f); MKB[(size_t)t * MW + (c - MW)] = kb; tk[(c - MW) * 16 + i] = kb; }
        }
        __syncthreads();
        for (int idx = tid; idx < 2 * MW * 2; idx += NTHREADS) {
            const int hf = idx & 1, c = (idx >> 1) % MW, which = idx / (2 * MW);
            const u32x4 val = *(const u32x4*)((which ? tv : tk) + c * 16 + hf * 8);
            bf16_t* dst = (which ? VT : KT) + ((size_t)(bb * MH) * 64 + c) * S + s0 + hf * 8;
            *(u32x4*)dst = val;
        }
    }
    __syncthreads();
}

__device__ __forceinline__ void phase_prep32(const Params& P, int l, unsigned char* smem, int wv) {
    ParamsPtr pp = PARAMS_PTR(P); PIN_S(pp); unsigned char* ws = pp->ws; int bidx = (int)blockIdx.x, gdim = (int)gridDim.x; PIN_S(bidx); PIN_S(gdim);
    const bf16_t* proj = (const bf16_t*)(ws + O_PROJ); const float* projg = (const float*)(ws + O_PROJG);
    bf16_t* UG = (bf16_t*)(ws + O_UG); bf16_t* VNT = (bf16_t*)(ws + O_VNT);
    u32x4* RK7 = (u32x4*)(ws + O_RK7);
    bf16_t* GATE = (bf16_t*)(ws + O_GATE); float* BONUS = (float*)(ws + O_BONUS); float* LWG = (float*)(ws + O_LW);
    bf16_t* VB = (bf16_t*)(ws + O_VB);
    bf16_t* MQB = (bf16_t*)(ws + O_MQB); bf16_t* MKB = (bf16_t*)(ws + O_MKB); bf16_t* KT = (bf16_t*)(ws + O_KT); bf16_t* VT = (bf16_t*)(ws + O_VT);
    float* IG = (float*)(ws + O_IG); float* LF = (float*)(ws + O_LF);
    const bf16_t* LWT = (const bf16_t*)(ws + O_LWT) + (size_t)l * 1920 * 128;
    const float* gln_g = pp->in[2] + (size_t)l * GW; const float* gln_b = pp->in[3] + (size_t)l * GW;
    const float* mu0 = pp->in[6] + (size_t)l * 2 * RPROJ; const float* mu1 = mu0 + RPROJ;
    const float* w0 = pp->in[7] + (size_t)l * 2 * RW; const float* a0 = pp->in[9] + (size_t)l * 2 * RW;
    const float* k_k = pp->in[12] + (size_t)l * RW; const float* k_a = pp->in[13] + (size_t)l * RW; const float* r_k = pp->in[14] + (size_t)l * RW;
    const float* conv_w = pp->in[17] + (size_t)l * 3 * 768; const float* conv_b = pp->in[18] + (size_t)l * 768; const float* gate_b = pp->in[19] + (size_t)l * 24;
    constexpr int TOK = 32, WR = TOK + 2, LIN = 264;
    bf16_t* winb = (bf16_t*)smem;
    bf16_t* lin = (bf16_t*)(smem + 95744);
    bf16_t* tk = (bf16_t*)(smem + 112640);
    bf16_t* tv = (bf16_t*)(smem + 137216);
    bf16_t* tvn = tk;
    bf16_t* icl = tk;
    const int tid = phase_tid(wv), lane = tid & 63, wave = tid >> 6, col = lane & 15, g = lane >> 4;
    for (int u = bidx; u < T / TOK; u += gdim) {
        const int t0 = u * TOK, s0 = t0 % S, bb = t0 / S;
        __syncthreads();
#pragma unroll 1
        for (int hb = 0; hb < 2; ++hb) {
            u32x2 wb[17];
#pragma unroll
            for (int q = 0; q < 17; ++q) {
                const int row = hb * 17 + q, sq = s0 - 1 + row;
                wb[q] = (u32x2){0u, 0u};
                if (sq >= 0 && sq < S && tid < 352) wb[q] = *(const u32x2*)(proj + (size_t)(t0 - 1 + row) * PLD + C_RW + tid * 4);
            }
            if (tid < 352) {
#pragma unroll
                for (int q = 0; q < 17; ++q) *(u32x2*)(winb + (hb * 17 + q) * RPROJ + tid * 4) = wb[q];
            }
        }
#pragma unroll 1
        for (int ps = 0; ps < 2; ++ps) {
            const int i = ps * 16 + (tid >> 5), l32 = tid & 31, t = t0 + i;
            float v[8], ug[8]; float sum = 0.f;
            {
                const u32x4 uq = *(const u32x4*)(proj + (size_t)t * PLD + l32 * 8), vq = *(const u32x4*)(proj + (size_t)t * PLD + GW + l32 * 8);
                ug[0] = bf_lo(uq.x); ug[1] = bf_hi(uq.x); ug[2] = bf_lo(uq.y); ug[3] = bf_hi(uq.y); ug[4] = bf_lo(uq.z); ug[5] = bf_hi(uq.z); ug[6] = bf_lo(uq.w); ug[7] = bf_hi(uq.w);
                v[0] = bf_lo(vq.x); v[1] = bf_hi(vq.x); v[2] = bf_lo(vq.y); v[3] = bf_hi(vq.y); v[4] = bf_lo(vq.z); v[5] = bf_hi(vq.z); v[6] = bf_lo(vq.w); v[7] = bf_hi(vq.w);
            }
#pragma unroll
            for (int j = 0; j < 8; ++j) { ug[j] = geluf_(ug[j]); v[j] = geluf_(v[j]); sum += v[j]; }
            { u32x4 uo; uo.x = pk2(ug[0], ug[1]); uo.y = pk2(ug[2], ug[3]); uo.z = pk2(ug[4], ug[5]); uo.w = pk2(ug[6], ug[7]); *(u32x4*)(UG + (size_t)t * GW + l32 * 8) = uo; }
#pragma unroll
            for (int o = 16; o >= 1; o >>= 1) sum += SHX(sum, o, lane);
            const float mean = sum * (1.0f / GW); float q = 0.f;
#pragma unroll
            for (int j = 0; j < 8; ++j) { const float d = v[j] - mean; q += d * d; }
#pragma unroll
            for (int o = 16; o >= 1; o >>= 1) q += SHX(q, o, lane);
            const float rstd = 1.0f / sqrtf(q * (1.0f / GW) + LN_EPS);
#pragma unroll
            for (int j = 0; j < 8; ++j) { const int c = l32 * 8 + j; tvn[c * TOK + i] = (bf16_t)f2bf((v[j] - mean) * rstd * gln_g[c] + gln_b[c]); }
        }
        __syncthreads();
#pragma unroll
        for (int q = 0; q < 2; ++q) {
            const int idx = tid + q * NTHREADS, c = idx >> 2, pc = idx & 3;
            *(u32x4*)(VNT + ((size_t)bb * GW + c) * S + s0 + pc * 8) = *(const u32x4*)(tvn + c * TOK + pc * 8);
        }
        int tb2 = tid; PIN_V(tb2);
#pragma unroll 4
        for (int q = 0; q < 16; ++q) {
            const int idx = tb2 + q * NTHREADS, i = idx >> 8, j = idx & 255, rc = 1152 + j;
            const float pv = bf_lo((unsigned)winb[i * RPROJ + rc]), cv = bf_lo((unsigned)winb[(i + 1) * RPROJ + rc]), nv = bf_lo((unsigned)winb[(i + 2) * RPROJ + rc]);
            const float x = cv + mu0[rc] * (pv - cv) + mu1[rc] * (nv - cv);
            lin[i * LIN + j] = (bf16_t)f2bf(j < 64 ? ftanh(x) : (j < 128 ? x : sigmoidf_(x)));
        }
        __syncthreads();
#pragma unroll 1
        for (int qg = 0; qg < 3; ++qg) {
            bf16x8 bw_[5][4]; f32x4 bias_[5];
#pragma unroll
            for (int q5 = 0; q5 < 5; ++q5) {
                const int nt = wave * 15 + qg * 5 + q5, grp = nt / 24, c = (nt % 24) * 16 + col;
                const bf16_t* bw = LWT + (size_t)(nt * 16 + col) * 128 + 8 * g;
#pragma unroll
                for (int ks = 0; ks < 2; ++ks) bw_[q5][ks] = *(const bf16x8*)(bw + ks * 32);
                if (grp == 4) {
#pragma unroll
                    for (int ks = 2; ks < 4; ++ks) bw_[q5][ks] = *(const bf16x8*)(bw + ks * 32);
                }
                const int c4 = (nt % 24) * 16 + 4 * g;
                bias_[q5] = grp < 2 ? *(const f32x4*)(w0 + grp * RW + c4) : (grp < 4 ? *(const f32x4*)(a0 + (grp - 2) * RW + c4) : (f32x4){0.f, 0.f, 0.f, 0.f});
            }
#pragma unroll
            for (int q5 = 0; q5 < 5; ++q5) {
                const int nt = wave * 15 + qg * 5 + q5, grp = nt / 24, c4 = (nt % 24) * 16 + 4 * g;
                const int kcol = grp < 2 ? 0 : (grp < 4 ? 64 : 128);
#pragma unroll
                for (int mt = 0; mt < 2; ++mt) {
                    f32x4 acc = (f32x4){0.f, 0.f, 0.f, 0.f};
                    const bf16_t* la = lin + (mt * 16 + col) * LIN + kcol + 8 * g;
#pragma unroll
                    for (int ks = 0; ks < 2; ++ks) acc = MFMA16(bw_[q5][ks], *(const bf16x8*)(la + ks * 32), acc);
                    if (grp == 4) {
#pragma unroll
                        for (int ks = 2; ks < 4; ++ks) acc = MFMA16(bw_[q5][ks], *(const bf16x8*)(la + ks * 32), acc);
                    }
                    const size_t tb = (size_t)(t0 + mt * 16 + col);
                    acc = acc + bias_[q5];
                    if (grp < 2) {
                        f32x4 lw; lw.x = -0.60653065971263342f * sigmoidf_(acc.x); lw.y = -0.60653065971263342f * sigmoidf_(acc.y); lw.z = -0.60653065971263342f * sigmoidf_(acc.z); lw.w = -0.60653065971263342f * sigmoidf_(acc.w);
                        *(f32x4*)(LWG + (size_t)grp * T * RW + tb * RW + c4) = lw;
                    } else if (grp < 4) {
                        u32x2 ic; ic.x = pk2(sigmoidf_(acc.x), sigmoidf_(acc.y)); ic.y = pk2(sigmoidf_(acc.z), sigmoidf_(acc.w));
                        *(u32x2*)(icl + ((grp - 2) * TOK + mt * 16 + col) * RW + c4) = ic;
                    } else {
                        u32x2 gt; gt.x = pk2(acc.x, acc.y); gt.y = pk2(acc.z, acc.w);
                        *(u32x2*)(GATE + tb * RW + c4) = gt;
                    }
                }
            }
        }
        __syncthreads();
        if (wave < 6) {
            int c = tid; PIN_V(c); const int h = wave;
            const float kkc = k_k[c], kac = k_a[c], rkc = r_k[c];
            const float m0r = mu0[c], m1r = mu1[c], m0k = mu0[RW + c], m1k = mu1[RW + c], m0v = mu0[2 * RW + c], m1v = mu1[2 * RW + c];
#pragma unroll 1
            for (int hb = 0; hb < 2; ++hb) {
                float ic0[16], ic1[16];
#pragma unroll
                for (int i = 0; i < 16; ++i) { ic0[i] = bf_lo((unsigned)icl[(hb * 16 + i) * RW + c]); ic1[i] = bf_lo((unsigned)icl[(TOK + hb * 16 + i) * RW + c]); }
#pragma unroll
                for (int i = 0; i < 16; ++i) {
                    const int it = hb * 16 + i, t = t0 + it;
                    const bf16_t* w_ = winb + it * RPROJ + c;
                    const float rp = bf_lo((unsigned)w_[0]), rc_ = bf_lo((unsigned)w_[RPROJ]), rn = bf_lo((unsigned)w_[2 * RPROJ]);
                    const float kp = bf_lo((unsigned)w_[RW]), kc_ = bf_lo((unsigned)w_[RPROJ + RW]), kn = bf_lo((unsigned)w_[2 * RPROJ + RW]);
                    const float vp = bf_lo((unsigned)w_[2 * RW]), vc_ = bf_lo((unsigned)w_[RPROJ + 2 * RW]), vn = bf_lo((unsigned)w_[2 * RPROJ + 2 * RW]);
                    const float r = rc_ + m0r * (rp - rc_) + m1r * (rn - rc_);
                    const float k = kc_ + m0k * (kp - kc_) + m1k * (kn - kc_);
                    const float v = vc_ + m0v * (vp - vc_) + m1v * (vn - vc_);
                    const size_t o = (size_t)t * RW + c;
                    const float kq = k * kkc;
                    const float n2 = wave_sum_fast(kq * kq, lane);
                    const float kk = kq / fmaxf(sqrtf(n2), 1e-12f);
                    const float kd0 = k * (1.0f + (ic0[i] - 1.0f) * kac), kd1 = k * (1.0f + (ic1[i] - 1.0f) * kac);
                    const float bon = wave_sum_fast(r * (kd0 + kd1) * rkc, lane);
                    u32x4 rec; rec.x = pk2(r, v); rec.y = pk2(kk, 0.f); rec.z = pk2(kk * ic0[i], kk * ic1[i]); rec.w = pk2(kd0, kd1);
                    RK7[o] = rec;
                    VB[o] = (bf16_t)(rec.x >> 16);
                    if (lane == 0) BONUS[(size_t)t * RH + h] = bon;
                }
            }
        }
        __syncthreads();
        {
            u32x2 wb[17], vb[6];
            int tC = tid; PIN_V(tC);
            const int rsel = tC >= 192 ? 1 : 0, c4 = tC - rsel * 192;
#pragma unroll
            for (int q = 0; q < 17; ++q) {
                const int row = 2 * q + rsel, sq = s0 - 1 + row;
                wb[q] = (u32x2){0u, 0u};
                if (tC < 384 && sq >= 0 && sq < S) wb[q] = *(const u32x2*)(proj + (size_t)(t0 - 1 + row) * PLD + C_MW + c4 * 4);
            }
#pragma unroll
            for (int q = 0; q < 6; ++q) { const int idx = tC + q * NTHREADS, i = idx / 96, cc = (idx % 96) * 4; vb[q] = *(const u32x2*)(proj + (size_t)(t0 + i) * PLD + C_MW + 2 * MW + cc); }
            if (tC < 384) {
#pragma unroll
                for (int q = 0; q < 17; ++q) *(u32x2*)(winb + (2 * q + rsel) * 768 + c4 * 4) = wb[q];
            }
#pragma unroll
            for (int q = 0; q < 6; ++q) { const int idx = tC + q * NTHREADS, i = idx / 96, cc = (idx % 96) * 4; const u32x2 v = vb[q];
                tv[(cc + 0) * TOK + i] = (bf16_t)(v.x & 0xffffu); tv[(cc + 1) * TOK + i] = (bf16_t)(v.x >> 16); tv[(cc + 2) * TOK + i] = (bf16_t)(v.y & 0xffffu); tv[(cc + 3) * TOK + i] = (bf16_t)(v.y >> 16); }
        }
        for (int idx = tid; idx < TOK * 24; idx += NTHREADS) {
            const int i = idx / 24, gi = idx % 24, t = t0 + i;
            const int isf = gi / 12, dir = (gi / 6) & 1, h = gi % 6;
            const float gg = projg[(size_t)t * 256 + (3456 - (PLD - 256)) + gi] + gate_b[gi];
            if (isf) LF[((size_t)dir * T + t) * MH + h] = -softplusf_(-gg); else IG[((size_t)dir * T + t) * MH + h] = gg;
        }
        __syncthreads();
        int tcv = tid; PIN_V(tcv);
#pragma unroll 4
        for (int q = 0; q < 48; ++q) {
            const int idx = tcv + q * NTHREADS, i = idx / 768, c = idx % 768, t = t0 + i;
            const bf16_t* w_ = winb + i * 768 + c;
            float y = conv_b[c] + bf_lo((unsigned)w_[0]) * conv_w[c] + bf_lo((unsigned)w_[768]) * conv_w[768 + c] + bf_lo((unsigned)w_[1536]) * conv_w[2 * 768 + c];
            y = y * sigmoidf_(y);
            if (c < MW) MQB[(size_t)t * MW + c] = (bf16_t)f2bf(y);
            else { const bf16_t kb = (bf16_t)f2bf(y * 0.125f); MKB[(size_t)t * MW + (c - MW)] = kb; tk[(c - MW) * TOK + i] = kb; }
        }
        __syncthreads();
#pragma unroll
        for (int q = 0; q < 6; ++q) {
            const int idx = tid + q * NTHREADS, pc = idx & 3, c = (idx >> 2) % MW, which = idx / (4 * MW);
            const u32x4 val = *(const u32x4*)((which ? tv : tk) + c * TOK + pc * 8);
            bf16_t* dst = (which ? VT : KT) + ((size_t)(bb * MH) * 64 + c) * S + s0 + pc * 8;
            *(u32x4*)dst = val;
        }
    }
    __syncthreads();
}

__device__ __forceinline__ void phase_gmlp_mix(const Params& P, int l, unsigned char* smem, int wv, int bid, int nb) {
    PIN_S(bid); PIN_S(nb);
    ParamsPtr pp = PARAMS_PTR(P); PIN_S(pp); unsigned char* ws = pp->ws;
    const bf16_t* UG = (const bf16_t*)(ws + O_UG); const bf16_t* VNT = (const bf16_t*)(ws + O_VNT); bf16_t* GRP = (bf16_t*)(ws + O_GRP);
    const bf16_t* WSB = (const bf16_t*)(ws + O_WSB) + (size_t)l * GH * CH * CH; const float* gbs = pp->in[5] + (size_t)l * GH * CH;
    const int tid = phase_tid(wv), lane = tid & 63, wave = tid >> 6, col = lane & 15, g = lane >> 4;
    constexpr int NU = NB * NCH * GH;
    bf16x8 wA[4], vA[4][4], wB[4], vB[4][4]; u32x2 uA[4], uB[4]; float bA, bB;
#define GM_LOAD(u_, W_, V_, U_, B_) do { const int h_ = (u_) % GH, c_ = ((u_) / GH) % NCH, b_ = (u_) / (GH * NCH); \
        const bf16_t* wb_ = WSB + (size_t)h_ * CH * CH + (size_t)(wave * 16 + col) * CH + 8 * g; \
        const bf16_t* vb_ = VNT + ((size_t)b_ * GW + h_ * 64 + col) * S + (size_t)c_ * CH + 8 * g; \
        _Pragma("unroll") for (int ks = 0; ks < 4; ++ks) { W_[ks] = *(const bf16x8*)(wb_ + ks * 32); \
            _Pragma("unroll") for (int et = 0; et < 4; ++et) V_[et][ks] = *(const bf16x8*)(vb_ + (size_t)et * 16 * S + ks * 32); } \
        const size_t t_ = (size_t)(b_ * S + c_ * CH + wave * 16 + col); \
        _Pragma("unroll") for (int et = 0; et < 4; ++et) U_[et] = *(const u32x2*)(UG + t_ * GW + h_ * 64 + et * 16 + 4 * g); \
        B_ = gbs[h_ * CH + wave * 16 + col]; } while (0)
#define GM_COMP(u_, W_, V_, U_, B_) do { const int h_ = (u_) % GH, c_ = ((u_) / GH) % NCH, b_ = (u_) / (GH * NCH); \
        const size_t t_ = (size_t)(b_ * S + c_ * CH + wave * 16 + col); \
        _Pragma("unroll") for (int et = 0; et < 4; ++et) { f32x4 acc = (f32x4){0.f, 0.f, 0.f, 0.f}; \
            _Pragma("unroll") for (int ks = 0; ks < 4; ++ks) acc = MFMA16(V_[et][ks], W_[ks], acc); \
            u32x2 o_; o_.x = pk2(bf_lo(U_[et].x) * (acc[0] + B_), bf_hi(U_[et].x) * (acc[1] + B_)); o_.y = pk2(bf_lo(U_[et].y) * (acc[2] + B_), bf_hi(U_[et].y) * (acc[3] + B_)); \
            *(u32x2*)(GRP + t_ * D + h_ * 64 + et * 16 + 4 * g) = o_; } } while (0)
    int u = bid;
    if (u < NU) GM_LOAD(u, wA, vA, uA, bA);
    while (u < NU) {
        const int u1 = u + nb;
        if (u1 < NU) GM_LOAD(u1, wB, vB, uB, bB);
        GM_COMP(u, wA, vA, uA, bA);
        if (u1 >= NU) break;
        const int u2 = u1 + nb;
        if (u2 < NU) GM_LOAD(u2, wA, vA, uA, bA);
        GM_COMP(u1, wB, vB, uB, bB);
        u = u2;
    }
#undef GM_LOAD
#undef GM_COMP
}

constexpr int SC_STEPS = 16;
constexpr int SC_BUF = SC_STEPS * 6 * 64;
__device__ __forceinline__ void phase_rwkv_scan(const Params& P, int l, unsigned char* smem, int wv, int bid, int nb) {
    PIN_S(bid); PIN_S(nb);
    ParamsPtr pp = PARAMS_PTR(P); PIN_S(pp); unsigned char* ws = pp->ws;
    const float* RR = (const float*)(ws + O_RR); const float* VV = (const float*)(ws + O_VV); const float* KK = (const float*)(ws + O_KK);
    const float* DEC = (const float*)(ws + O_DEC); const float* KD = (const float*)(ws + O_KD); const float* ICLR = (const float*)(ws + O_ICLR);
    float* SCAN = (float*)(ws + O_SCAN); const float* BRKR = (const float*)(ws + O_BRKR);
    const int tid = phase_tid(wv), lane = tid & 63, wave = tid >> 6, rl = (lane >> 4) & 1, kq = (lane & 15) | ((lane >> 5) << 4);
    float* buf = (float*)smem;
    float* scal = buf + 2 * SC_BUF;
    float* outb = scal + 2 * SC_STEPS * 2;
    typedef float f32x2 __attribute__((ext_vector_type(2)));
    for (int u = bid; u < 2 * NB * RH * 4; u += nb) {
        const int qt = u & 3, h = (u >> 2) % RH, b = (u / (4 * RH)) % NB, d = u / (4 * RH * NB);
        const size_t doff = (size_t)d * T * RW;
        float s0 = 0.f, s1 = 0.f;
        float pw[2], pa[2], pb[2], pk[2], pr[2], pv[2], psc = 0.f;
#define SC_LOAD(c) do { _Pragma("unroll") for (int i = 0; i < 2; ++i) { const int idx = tid + NTHREADS * i, st = idx >> 6, k = idx & 63; const int tau = (c) * SC_STEPS + st, sq = d ? S - 1 - tau : tau; \
            const size_t o = (size_t)(b * S + sq) * RW + h * 64 + k; \
            pw[i] = DEC[doff + o]; pa[i] = KK[o]; pb[i] = ICLR[doff + o]; pk[i] = KD[doff + o]; pr[i] = RR[o]; pv[i] = VV[o]; }     \
            if (tid < 2 * SC_STEPS) { const int tau = (c) * SC_STEPS + (tid >> 1), sq = d ? S - 1 - tau : tau; psc = BRKR[((size_t)(d * T + b * S + sq) * RH + h) * 2 + (tid & 1)]; } } while (0)
#define SC_WRITE(c) do { float* B_ = buf + ((c) & 1) * SC_BUF; _Pragma("unroll") for (int i = 0; i < 2; ++i) { const int idx = tid + NTHREADS * i, st = idx >> 6, k = idx & 63; \
            float* q_ = B_ + st * 384 + k; q_[0] = pw[i]; q_[64] = -pa[i]; q_[128] = pa[i] * pb[i]; q_[192] = pk[i]; q_[256] = pw[i] * pr[i]; q_[320] = pv[i]; } \
            if (tid < 2 * SC_STEPS) scal[((c) & 1) * SC_STEPS * 2 + tid] = psc; } while (0)
        __syncthreads();
        SC_LOAD(0); SC_WRITE(0);
        __syncthreads();
        const int row = qt * 16 + wave * 2 + rl;
        for (int c = 0; c < S / SC_STEPS; ++c) {
            const bool more = (c + 1) < S / SC_STEPS;
            if (more) SC_LOAD(c + 1);
            const float* B = buf + (c & 1) * SC_BUF; const float* sc = scal + (c & 1) * SC_STEPS * 2; float* ob = outb + (c & 1) * SC_STEPS * 16;
            float outs[SC_STEPS];
            f32x2 w2 = *(const f32x2*)(B + 2 * kq), a2 = *(const f32x2*)(B + 64 + 2 * kq), b2 = *(const f32x2*)(B + 128 + 2 * kq);
            f32x2 k2 = *(const f32x2*)(B + 192 + 2 * kq), wr2 = *(const f32x2*)(B + 256 + 2 * kq);
            float v = B[320 + row]; float br = sc[0], kr = sc[1];
#pragma unroll
            for (int st = 0; st < SC_STEPS; ++st) {
                const int sn = st + 1 < SC_STEPS ? st + 1 : st;
                const float* q = B + sn * 384;
                const f32x2 nw2 = *(const f32x2*)(q + 2 * kq), na2 = *(const f32x2*)(q + 64 + 2 * kq), nb2 = *(const f32x2*)(q + 128 + 2 * kq);
                const f32x2 nk2 = *(const f32x2*)(q + 192 + 2 * kq), nwr2 = *(const f32x2*)(q + 256 + 2 * kq);
                const float nv = q[320 + row], nbr = sc[sn * 2], nkr = sc[sn * 2 + 1];
                SCHED_BAR();
                float sa = s0 * a2.x + s1 * a2.y;
                float po = s0 * wr2.x + s1 * wr2.y;
                sa = row32_sum(sa); po = row32_sum(po);
                outs[st] = po + sa * br + v * kr;
                s0 = s0 * w2.x + (sa * b2.x + v * k2.x); s1 = s1 * w2.y + (sa * b2.y + v * k2.y);
                SCHED_BAR();
                w2 = nw2; a2 = na2; b2 = nb2; k2 = nk2; wr2 = nwr2; v = nv; br = nbr; kr = nkr;
            }
            if (kq == 0) {
#pragma unroll
                for (int st = 0; st < SC_STEPS; ++st) ob[st * 16 + wave * 2 + rl] = outs[st];
            }
            if (more) SC_WRITE(c + 1);
            __syncthreads();
            if (tid < 16 * SC_STEPS) {
                const int st = tid >> 4, r = tid & 15, tau = c * SC_STEPS + st, sq = d ? S - 1 - tau : tau;
                SCAN[doff + (size_t)(b * S + sq) * RW + h * 64 + qt * 16 + r] = ob[st * 16 + r];
            }
        }
#undef SC_LOAD
#undef SC_WRITE
    }
    __syncthreads();
}

constexpr int RST = 72;
constexpr int RARR = 64 * RST;
__device__ __forceinline__ f32x4 tile_nt(const bf16_t* Aa, int ta, const bf16_t* Ba, int tb, f32x4 acc, int col, int g) {
#pragma unroll
    for (int ks = 0; ks < 2; ++ks) {
        const bf16x8 af = *(const bf16x8*)(Aa + (ta * 16 + col) * RST + ks * 32 + 8 * g);
        const bf16x8 bfr = *(const bf16x8*)(Ba + (tb * 16 + col) * RST + ks * 32 + 8 * g);
        acc = MFMA16(af, bfr, acc);
    }
    return acc;
}
__device__ __forceinline__ void phase_rwkv_pre(const Params& P, int l, unsigned char* smem, int wv) {
    ParamsPtr pp = PARAMS_PTR(P); PIN_S(pp); unsigned char* ws = pp->ws; int bidx = (int)blockIdx.x, gdim = (int)gridDim.x; PIN_S(bidx); PIN_S(gdim);
    const u32x4* RK7 = (const u32x4*)(ws + O_RK7);
    const float* LWG = (const float*)(ws + O_LW);
    bf16_t* Qg = (bf16_t*)(ws + O_RQ); bf16_t* Ag = (bf16_t*)(ws + O_RA); bf16_t* Hg = (bf16_t*)(ws + O_RH); bf16_t* Gg = (bf16_t*)(ws + O_RG);
    const int tid0 = phase_tid(wv);
#define RW_STAGE_VARS int tid = tid0; PIN_V(tid); const int lane = tid & 63, wave = tid >> 6, col = lane & 15, g = lane >> 4; (void)lane; (void)wave; (void)col; (void)g;
    bf16_t* At = (bf16_t*)smem; bf16_t* Bt = At + RARR; bf16_t* Kt = Bt + RARR; bf16_t* Rt = Kt + RARR;
    bf16_t* BtT = Rt + RARR; bf16_t* KtT = BtT + RARR; bf16_t* VT = KtT + RARR;
    bf16_t* Lak = VT + RARR; bf16_t* Mrb = Lak + RARR; bf16_t* Mrk = Mrb + RARR; bf16_t* YT = Mrk + RARR; bf16_t* W2T = YT + RARR;
    bf16_t* Lbo = W2T + RARR;
    float* LabT = (float*)(Lbo + RARR);
    float* Xs = LabT + 4096;
    float* Pb = Xs + 4096;
    float* segs = Pb + 2048;
    float* PC = segs + 512;
    float plw[8]; u32x4 prec[8];
#define RW_LOAD(uu) do { const int c_ = (uu) % RNC, h_ = ((uu) / RNC) % RH, b_ = ((uu) / (RNC * RH)) % NB, d_ = (uu) / (RNC * RH * NB); const size_t doff_ = (size_t)d_ * T * RW; \
        const int ch_ = tid0 & 63, sg_ = tid0 >> 6; _Pragma("unroll") for (int j = 0; j < 8; ++j) { const int tau = c_ * RC + sg_ * 8 + j, sq = d_ ? S - 1 - tau : tau; const size_t o = (size_t)(b_ * S + sq) * RW + h_ * 64 + ch_; \
        plw[j] = LWG[doff_ + o]; prec[j] = RK7[o]; } } while (0)
    if (bidx < RUN) RW_LOAD(bidx);
    for (int u = bidx; u < RUN; u += gdim) {
        const int c = u % RNC, h = (u / RNC) % RH, b = (u / (RNC * RH)) % NB, d = u / (RNC * RH * NB);
        (void)c; (void)h; (void)b; (void)d;
        __syncthreads();
        {
            RW_STAGE_VARS
            const int ch = tid & 63, sg = tid >> 6;
            float lw[8]; unsigned kk[8], bq_[8], kd[8], rr[8], vv[8];
#pragma unroll
            for (int j = 0; j < 8; ++j) { lw[j] = plw[j]; kk[j] = prec[j].y & 0xffffu; bq_[j] = d ? (prec[j].z >> 16) : (prec[j].z & 0xffffu); kd[j] = d ? (prec[j].w >> 16) : (prec[j].w & 0xffffu); rr[j] = prec[j].x & 0xffffu; vv[j] = prec[j].x >> 16; }
            if (u + gdim < RUN) RW_LOAD(u + gdim);
            float run = 0.f;
#pragma unroll
            for (int j = 0; j < 8; ++j) { run += lw[j]; lw[j] = run; }
            segs[sg * 64 + ch] = run;
            __syncthreads();
            float off = 0.f;
            for (int q = 0; q < sg; ++q) off += segs[q * 64 + ch];
            u32x4 pbt, pkt, pvt; unsigned tb[8], tk[8], tvv[8];
            float prev = off;
#pragma unroll
            for (int j = 0; j < 8; ++j) {
                const int t = sg * 8 + j; const float cl = off + lw[j];
                const float ep = fexp(prev), en = fexp(-cl), epc = fexp(cl);
                const unsigned a_ = f2bf(-bf_lo(kk[j]) * ep), b_ = f2bf(bf_lo(bq_[j]) * en), k_ = f2bf(bf_lo(kd[j]) * en), r_ = f2bf(bf_lo(rr[j]) * epc), v_ = vv[j];
                At[t * RST + ch] = (bf16_t)a_; Bt[t * RST + ch] = (bf16_t)b_; Kt[t * RST + ch] = (bf16_t)k_; Rt[t * RST + ch] = (bf16_t)r_;
                tb[j] = b_; tk[j] = k_; tvv[j] = v_;
                prev = cl;
            }
            if (sg == 7) PC[ch] = fexp(prev);
            pbt.x = tb[0] | (tb[1] << 16); pbt.y = tb[2] | (tb[3] << 16); pbt.z = tb[4] | (tb[5] << 16); pbt.w = tb[6] | (tb[7] << 16);
            pkt.x = tk[0] | (tk[1] << 16); pkt.y = tk[2] | (tk[3] << 16); pkt.z = tk[4] | (tk[5] << 16); pkt.w = tk[6] | (tk[7] << 16);
            pvt.x = tvv[0] | (tvv[1] << 16); pvt.y = tvv[2] | (tvv[3] << 16); pvt.z = tvv[4] | (tvv[5] << 16); pvt.w = tvv[6] | (tvv[7] << 16);
            *(u32x4*)(BtT + ch * RST + sg * 8) = pbt; *(u32x4*)(KtT + ch * RST + sg * 8) = pkt; *(u32x4*)(VT + ch * RST + sg * 8) = pvt;
            for (int z_ = tid; z_ < 2 * RARR / 8; z_ += NTHREADS) ((u32x4*)YT)[z_] = (u32x4){0u, 0u, 0u, 0u};
        }
        __syncthreads();
        {
            RW_STAGE_VARS
            const int m = wave >> 1;
            const bf16_t* Ym = (m == 0 || m == 2) ? Bt : Kt; const bf16_t* Xm = (m < 2) ? At : Rt;
#pragma unroll 1
            for (int q = 0; q < 8; ++q) {
                const int tix = (wave & 1) * 8 + q, it = tix >> 2, tt = tix & 3;
                f32x4 acc = (f32x4){0.f, 0.f, 0.f, 0.f};
                if (it <= tt) acc = tile_nt(Ym, it, Xm, tt, acc, col, g);
                const int t = tt * 16 + col, i0 = it * 16 + 4 * g;
                float o4[4];
#pragma unroll
                for (int r = 0; r < 4; ++r) { const int i = i0 + r; const bool ok = m < 2 ? (i < t) : (i <= t); o4[r] = ok ? acc[r] : 0.f; }
                if (m == 0) {
#pragma unroll
                    for (int r = 0; r < 4; ++r) LabT[(i0 + r) * 64 + t] = o4[r];
                    const bool offd = it < tt;
                    u32x2 w2; w2.x = offd ? pk2(o4[0], o4[1]) : 0u; w2.y = offd ? pk2(o4[2], o4[3]) : 0u; *(u32x2*)(Lbo + t * RST + i0) = w2;
                }
                else { bf16_t* dst = (m == 1 ? Lak : (m == 2 ? Mrb : Mrk)) + t * RST + i0; u32x2 w2; w2.x = pk2(o4[0], o4[1]); w2.y = pk2(o4[2], o4[3]); *(u32x2*)dst = w2; }
            }
        }
        __syncthreads();
        {
            RW_STAGE_VARS
#pragma unroll
            for (int q = 0; q < 2; ++q) {
                const int tix = wave * 2 + q, tt = tix >> 2, et = tix & 3;
                f32x4 acc = (f32x4){0.f, 0.f, 0.f, 0.f};
                acc = tile_nt(Lak, tt, VT, et, acc, col, g);
#pragma unroll
                for (int r = 0; r < 4; ++r) Xs[(tt * 16 + 4 * g + r) * 64 + et * 16 + col] = acc[r];
            }
        }
        __syncthreads();
        {
            RW_STAGE_VARS
#pragma unroll 1
            for (int bb = 0; bb < 4; ++bb) {
                if (bb > 0) {
                    const bf16_t* Zt = (wave < 4 ? YT : W2T) + ((wave & 3) * 16 + col) * RST + 8 * g;
                    const bf16_t* La = Lbo + (16 * bb + col) * RST + 8 * g;
                    f32x4 acc = (f32x4){0.f, 0.f, 0.f, 0.f};
                    acc = MFMA16(*(const bf16x8*)La, *(const bf16x8*)Zt, acc);
                    if (bb > 2) acc = MFMA16(*(const bf16x8*)(La + 32), *(const bf16x8*)(Zt + 32), acc);
#pragma unroll
                    for (int r = 0; r < 4; ++r) Pb[(4 * g + r) * 128 + wave * 16 + col] = acc[r];
                }
                __syncthreads();
                if (wave < 2) {
                    float acc[16];
                    if (wave == 0) {
#pragma unroll
                        for (int r = 0; r < 16; ++r) acc[r] = bf_lo((unsigned)At[(16 * bb + r) * RST + lane]);
                    } else {
#pragma unroll
                        for (int r = 0; r < 16; ++r) acc[r] = Xs[(16 * bb + r) * 64 + lane];
                    }
                    if (bb > 0) {
#pragma unroll
                        for (int r = 0; r < 16; ++r) acc[r] += Pb[r * 128 + wave * 64 + lane];
                    }
                    const float* dp = LabT + (16 * bb) * 64 + 16 * bb;
#pragma unroll
                    for (int r = 1; r < 16; ++r)
#pragma unroll
                        for (int r2 = 0; r2 < r; ++r2) acc[r] += dp[r2 * 64 + r] * acc[r2];
                    bf16_t* dst = (wave == 0 ? YT : W2T) + lane * RST;
                    u32x4 w0, w1;
                    w0.x = pk2(acc[0], acc[1]); w0.y = pk2(acc[2], acc[3]); w0.z = pk2(acc[4], acc[5]); w0.w = pk2(acc[6], acc[7]);
                    w1.x = pk2(acc[8], acc[9]); w1.y = pk2(acc[10], acc[11]); w1.z = pk2(acc[12], acc[13]); w1.w = pk2(acc[14], acc[15]);
                    *(u32x4*)(dst + 16 * bb) = w0; *(u32x4*)(dst + 16 * bb + 8) = w1;
                }
                __syncthreads();
            }
        }
        __syncthreads();
        {
            RW_STAGE_VARS
            const int ty = wave >> 1;
#pragma unroll 1
            for (int q = 0; q < 8; ++q) {
                const int tix = (wave & 1) * 8 + q, ra = tix >> 2, cb = tix & 3;
                f32x4 acc = (f32x4){0.f, 0.f, 0.f, 0.f};
                if (ty == 0) {
                    acc = tile_nt(YT, ra, Mrb, cb, acc, col, g);
                    const u32x2 rt2 = *(const u32x2*)(Rt + (cb * 16 + col) * RST + ra * 16 + 4 * g);
                    u32x2 qb2; qb2.x = pk2(acc[0] + bf_lo(rt2.x), acc[1] + bf_hi(rt2.x)); qb2.y = pk2(acc[2] + bf_lo(rt2.y), acc[3] + bf_hi(rt2.y));
                    *(u32x2*)(Qg + (size_t)u * 4096 + ((((ra >> 1) * 4 + cb) * 64 + lane) * 8 + (ra & 1) * 4)) = qb2;
                } else if (ty == 1) {
                    acc = tile_nt(Mrb, ra, W2T, cb, acc, col, g); acc = tile_nt(Mrk, ra, VT, cb, acc, col, g);
                    { u32x2 hb; hb.x = pk2(acc[0], acc[1]); hb.y = pk2(acc[2], acc[3]); *(u32x2*)(Hg + (size_t)u * 4096 + (tix * 64 + lane) * 4) = hb; }
                } else if (ty == 2) {
                    acc = tile_nt(YT, ra, BtT, cb, acc, col, g);
                    const float pc = PC[cb * 16 + col]; const int k1 = cb * 16 + col;
                    float a4[4];
#pragma unroll
                    for (int r = 0; r < 4; ++r) a4[r] = pc * (acc[r] + ((ra * 16 + 4 * g + r) == k1 ? 1.0f : 0.f));
                    u32x2 ab2; ab2.x = pk2(a4[0], a4[1]); ab2.y = pk2(a4[2], a4[3]);
                    *(u32x2*)(Ag + (size_t)u * 4096 + ((((ra >> 1) * 4 + cb) * 64 + lane) * 8 + (ra & 1) * 4)) = ab2;
                } else {
                    acc = tile_nt(BtT, ra, W2T, cb, acc, col, g); acc = tile_nt(KtT, ra, VT, cb, acc, col, g);
#pragma unroll
                    for (int r = 0; r < 4; ++r) acc[r] *= PC[ra * 16 + 4 * g + r];
                    { u32x2 gb2; gb2.x = pk2(acc[0], acc[1]); gb2.y = pk2(acc[2], acc[3]); *(u32x2*)(Gg + (size_t)u * 4096 + (tix * 64 + lane) * 4) = gb2; }
                }
            }
        }
    }
    __syncthreads();
#undef RW_STAGE_VARS
#undef RW_LOAD
}
constexpr int RSEQ_WGS = 2 * NB * RH * 2;
template <int MODE = 0>
__device__ __forceinline__ void phase_rwkv_seq(const Params& P, int l, unsigned char* smem, int wv) {
    ParamsPtr pp = PARAMS_PTR(P); PIN_S(pp); unsigned char* ws = pp->ws; int bidx = (int)blockIdx.x, gdim = (int)gridDim.x; PIN_S(bidx); PIN_S(gdim);
    const bf16_t* Ag = (const bf16_t*)(ws + O_RA); const bf16_t* Gg = (const bf16_t*)(ws + O_RG); bf16_t* Sg = (bf16_t*)(ws + ((MODE & 4) ? O_XS : O_RS));
    const int tid = phase_tid(wv), lane = tid & 63, wave = tid >> 6, col = lane & 15, g = lane >> 4;
    if (wave >= 2) return;
    const int nwg = gdim < RSEQ_WGS ? gdim : RSEQ_WGS;
    if (bidx >= nwg) return;
    for (int un = wave * nwg + bidx; un < 2 * NB * RH * 4; un += 2 * nwg) {
        const int ch = un >> 2, eq = un & 3;
        f32x4 acc[4];
#pragma unroll
        for (int a_ = 0; a_ < 4; ++a_) acc[a_] = (f32x4){0.f, 0.f, 0.f, 0.f};
        u32x4 a0[4][2], a1[4][2], a2[4][2], a3[4][2]; u32x2 g0[4], g1[4], g2[4], g3[4];
        const unsigned aoff = (unsigned)(col * 64 + 16 * g), goff = (unsigned)(lane * 4), aoff8 = (unsigned)(lane * 8);
#define RS_LOAD(cc, AF, GQ) do { const int c_ = (cc) < RNC ? (cc) : RNC - 1; const bf16_t* ab_ = Ag + (size_t)(ch * RNC + c_) * 4096; const bf16_t* gb_ = Gg + (size_t)(ch * RNC + c_) * 4096 + eq * 256; \
            _Pragma("unroll") for (int ra = 0; ra < 4; ++ra) _Pragma("unroll") for (int p = 0; p < 2; ++p) AF[ra][p] = *(const u32x4*)(ab_ + ((p * 4 + ra) * 512) + aoff8); \
            _Pragma("unroll") for (int ra = 0; ra < 4; ++ra) GQ[ra] = *(const u32x2*)(gb_ + (ra * 1024) + goff); } while (0)
#define RS_STEP(c, AF, GQ) do { if (RNC % 4 == 0 || (c) < RNC) { SCHED_BAR(); bf16_t* sb_ = Sg + (size_t)(ch * RNC + (c)) * 4096 + eq * 1024; \
            bf16x8 bq[2]; _Pragma("unroll") for (int p = 0; p < 2; ++p) bq[p] = cvt8(acc[2 * p], acc[2 * p + 1]); \
            if (!(MODE & 1) || (c) == RNC - 1) { _Pragma("unroll") for (int p = 0; p < 2; ++p) *(bf16x8*)(sb_ + (p * 8) + aoff) = bq[p]; } \
            _Pragma("unroll") for (int ra = 0; ra < 4; ++ra) acc[ra] = (f32x4){bf_lo(GQ[ra].x), bf_hi(GQ[ra].x), bf_lo(GQ[ra].y), bf_hi(GQ[ra].y)}; \
            _Pragma("unroll") for (int ra = 0; ra < 4; ++ra) _Pragma("unroll") for (int p = 0; p < 2; ++p) acc[ra] = MFMA16(__builtin_bit_cast(bf16x8, AF[ra][p]), bq[p], acc[ra]); \
            if (!(MODE & 2)) RS_LOAD((c) + 4, AF, GQ); SCHED_BAR(); } } while (0)
        RS_LOAD(0, a0, g0); RS_LOAD(1, a1, g1); RS_LOAD(2, a2, g2); RS_LOAD(3, a3, g3);
#pragma unroll 1
        for (int c = 0; c < RNC; c += 4) { RS_STEP(c, a0, g0); RS_STEP(c + 1, a1, g1); RS_STEP(c + 2, a2, g2); RS_STEP(c + 3, a3, g3); }
#undef RS_LOAD
#undef RS_STEP
    }
}
__device__ __forceinline__ void phase_rwkv_out(const Params& P, int l, unsigned char* smem, int wv) {
    ParamsPtr pp = PARAMS_PTR(P); PIN_S(pp); unsigned char* ws = pp->ws; int bidx = (int)blockIdx.x, gdim = (int)gridDim.x; PIN_S(bidx); PIN_S(gdim);
    const bf16_t* Qg = (const bf16_t*)(ws + O_RQ); const bf16_t* Sg = (const bf16_t*)(ws + O_RS); const bf16_t* Hg = (const bf16_t*)(ws + O_RH);
    const bf16_t* VB = (const bf16_t*)(ws + O_VB); const bf16_t* GATE = (const bf16_t*)(ws + O_GATE); const float* BONUS = (const float*)(ws + O_BONUS);
    bf16_t* GRP = (bf16_t*)(ws + O_GRP);
    const float* rln_g = pp->in[15] + (size_t)l * RW; const float* rln_b = pp->in[16] + (size_t)l * RW;
    const int tid = phase_tid(wv), lane = tid & 63, wave = tid >> 6, col = lane & 15, g = lane >> 4;
    for (int pu = bidx * NWAVES + wave; pu < NB * RH * RNC; pu += gdim * NWAVES) {
        const int c = pu % RNC, h = (pu / RNC) % RH, b = pu / (RNC * RH);
        f32x4 o[2][4][4];
#pragma unroll
        for (int d = 0; d < 2; ++d) {
            const int u = ((d * NB + b) * RH + h) * RNC + (d ? RNC - 1 - c : c);
            const size_t ub = (size_t)u * 4096;
            bf16x8 qa[4][2], sb[4][2];
#pragma unroll
            for (int q = 0; q < 4; ++q)
#pragma unroll
                for (int ks = 0; ks < 2; ++ks) {
                    qa[q][ks] = *(const bf16x8*)(Qg + ub + ((ks * 4 + q) * 64 + lane) * 8);
                    sb[q][ks] = *(const bf16x8*)(Sg + ub + (q * 16 + col) * 64 + 16 * g + 8 * ks);
                }
#pragma unroll
            for (int tt = 0; tt < 4; ++tt)
#pragma unroll
                for (int et = 0; et < 4; ++et) {
                    const u32x2 hb = *(const u32x2*)(Hg + ub + ((tt * 4 + et) * 64 + lane) * 4);
                    f32x4 acc = (f32x4){bf_lo(hb.x), bf_hi(hb.x), bf_lo(hb.y), bf_hi(hb.y)};
#pragma unroll
                    for (int ks = 0; ks < 2; ++ks) acc = MFMA16(qa[tt][ks], sb[et][ks], acc);
                    o[d][tt][et] = acc;
                }
        }
        const int src = (3 - g) * 16 + col;
#pragma unroll
        for (int tt = 0; tt < 4; ++tt)
#pragma unroll
            for (int et = 0; et < 4; ++et)
#pragma unroll
                for (int r = 0; r < 4; ++r) o[0][tt][et][r] += SHL(o[1][3 - tt][et][3 - r], src);
        float* tile = (float*)smem + wave * (64 * 68);
        WAVE_SYNC();
#pragma unroll
        for (int tt = 0; tt < 4; ++tt)
#pragma unroll
            for (int et = 0; et < 4; ++et)
#pragma unroll
                for (int r = 0; r < 4; ++r) tile[(tt * 16 + 4 * g + r) * 68 + et * 16 + col] = o[0][tt][et][r];
        WAVE_SYNC();
        {
            const int c4 = (lane & 15) * 4, ch = h * 64 + c4;
            const f32x4 lg = *(const f32x4*)(rln_g + ch), lb = *(const f32x4*)(rln_b + ch);
#pragma unroll 1
            for (int qb = 0; qb < 2; ++qb) {
                u32x2 gt_[8]; u32x2 vb_[8]; float bo_[8];
#pragma unroll
                for (int q8 = 0; q8 < 8; ++q8) {
                    const size_t t = (size_t)(b * S + c * RC + (qb * 8 + q8) * 4 + (lane >> 4));
                    gt_[q8] = *(const u32x2*)(GATE + t * RW + ch); vb_[q8] = *(const u32x2*)(VB + t * RW + ch); bo_[q8] = BONUS[t * RH + h];
                }
#pragma unroll
                for (int q8 = 0; q8 < 8; ++q8) {
                    const int tl = (qb * 8 + q8) * 4 + (lane >> 4);
                    const size_t t = (size_t)(b * S + c * RC + tl);
                    const f32x4 x = *(const f32x4*)(tile + tl * 68 + c4);
                    const float mean = row16_sum((x.x + x.y) + (x.z + x.w)) * (1.0f / 64.0f);
                    const f32x4 dl = x - mean;
                    const float var = row16_sum((dl.x * dl.x + dl.y * dl.y) + (dl.z * dl.z + dl.w * dl.w)) * (1.0f / 64.0f);
                    const float rstd = 1.0f / sqrtf(var + GN_EPS);
                    f32x4 y = dl * rstd * lg + lb;
                    y.x += bo_[q8] * bf_lo(vb_[q8].x); y.y += bo_[q8] * bf_hi(vb_[q8].x); y.z += bo_[q8] * bf_lo(vb_[q8].y); y.w += bo_[q8] * bf_hi(vb_[q8].y);
                    y = y * (f32x4){bf_lo(gt_[q8].x), bf_hi(gt_[q8].x), bf_lo(gt_[q8].y), bf_hi(gt_[q8].y)};
                    u32x2 ob; ob.x = pk2(y.x, y.y); ob.y = pk2(y.z, y.w);
                    *(u32x2*)(GRP + t * D + GW + ch) = ob;
                }
            }
        }
    }
    __syncthreads();
}

__device__ __forceinline__ void phase_mlstm_local(const Params& P, int l, unsigned char* smem, int wv, int bid, int nb) {
    PIN_S(bid); PIN_S(nb);
    ParamsPtr pp = PARAMS_PTR(P); PIN_S(pp); unsigned char* ws = pp->ws;
    const bf16_t* KT = (const bf16_t*)(ws + O_KT); const bf16_t* VT = (const bf16_t*)(ws + O_VT);
    const float* IG = (const float*)(ws + O_IG); const float* LF = (const float*)(ws + O_LF);
    float* CL = (float*)(ws + O_CL); float* NLb = (float*)(ws + O_NL); float* ML = (float*)(ws + O_ML); float* BL = (float*)(ws + O_BL);
    float* GVT = (float*)(ws + O_GVT); float* PMX = (float*)(ws + O_PMX); float* BCT = (float*)(ws + O_BCT);
    const int tid = phase_tid(wv), lane = tid & 63, wave = tid >> 6, col = lane & 15, g = lane >> 4;
    float* wts = (float*)smem + wave * 128;
    for (int u = bid * NWAVES + wave; u < 2 * NB * MH * NCH; u += nb * NWAVES) {
        const int c = u % NCH, h = (u / NCH) % MH, p = u / (NCH * MH), d = p / NB, b = p % NB;
        const int tc = d ? NCH - 1 - c : c, tok0 = b * S + tc * CH;
        const int i0 = d ? 127 - 2 * lane : 2 * lane, i1 = d ? i0 - 1 : i0 + 1;
        const size_t g0 = ((size_t)d * T + tok0 + i0) * MH + h, g1 = ((size_t)d * T + tok0 + i1) * MH + h;
        const float lf0 = LF[g0], lf1 = LF[g1], ig0 = IG[g0], ig1 = IG[g1];
        const float c1 = lf0 + lf1;
        float incl = c1;
#pragma unroll
        for (int o = 1; o < 64; o <<= 1) { const float tq = SHUP(incl, o, lane); if (lane >= o) incl += tq; }
        const float excl = incl - c1, bc0 = excl + lf0, bc1 = incl;
        const float blast = RDL(incl, 63);
        const float gv0 = ig0 - bc0, gv1 = ig1 - bc1, pl1 = fmaxf(gv0, gv1);
        float mincl = pl1;
#pragma unroll
        for (int o = 1; o < 64; o <<= 1) { const float tq = SHUP(mincl, o, lane); if (lane >= o) mincl = fmaxf(mincl, tq); }
        float mexcl = SHUP(mincl, 1, lane); if (lane == 0) mexcl = -INFINITY;
        const float pm0 = fmaxf(mexcl, gv0), pm1 = mincl;
        const float mloc = blast + RDL(mincl, 63);
        WAVE_SYNC();
        wts[i0] = fexp(blast + gv0 - mloc); wts[i1] = fexp(blast + gv1 - mloc);
        GVT[g0] = gv0; GVT[g1] = gv1; PMX[g0] = pm0; PMX[g1] = pm1; BCT[g0] = bc0; BCT[g1] = bc1;
        if (lane == 0) { ML[u] = mloc; BL[u] = blast; }
        WAVE_SYNC();
        const bf16_t* vbase = VT + ((size_t)(b * MH + h) * 64) * S + (size_t)tc * CH;
        const bf16_t* kbase = KT + ((size_t)(b * MH + h) * 64) * S + (size_t)tc * CH;
        const unsigned loff = (unsigned)(col * S + 8 * g);
        f32x4 acc[4][4];
#pragma unroll
        for (int a_ = 0; a_ < 4; ++a_)
#pragma unroll
            for (int b_ = 0; b_ < 4; ++b_) acc[a_][b_] = (f32x4){0.f, 0.f, 0.f, 0.f};
        float nsum[4] = {0.f, 0.f, 0.f, 0.f};
#pragma unroll 1
        for (int ks = 0; ks < 4; ++ks) {
            const int ii = ks * 32 + 8 * g;
            const f32x4 w0 = *(const f32x4*)(wts + ii), w1 = *(const f32x4*)(wts + ii + 4);
            bf16x8 af[4], bfk[4];
#pragma unroll
            for (int q = 0; q < 4; ++q) af[q] = *(const bf16x8*)(vbase + ((size_t)q * 16 * S + ks * 32) + loff);
#pragma unroll
            for (int q = 0; q < 4; ++q) {
                const u32x4 kr = *(const u32x4*)(kbase + ((size_t)q * 16 * S + ks * 32) + loff);
                f32x4 k0, k1;
                k0.x = bf_lo(kr.x) * w0.x; k0.y = bf_hi(kr.x) * w0.y; k0.z = bf_lo(kr.y) * w0.z; k0.w = bf_hi(kr.y) * w0.w;
                k1.x = bf_lo(kr.z) * w1.x; k1.y = bf_hi(kr.z) * w1.y; k1.z = bf_lo(kr.w) * w1.z; k1.w = bf_hi(kr.w) * w1.w;
                nsum[q] += (k0.x + k0.y) + (k0.z + k0.w) + (k1.x + k1.y) + (k1.z + k1.w);
                bfk[q] = cvt8(k0, k1);
            }
#pragma unroll
            for (int a_ = 0; a_ < 4; ++a_)
#pragma unroll
                for (int b_ = 0; b_ < 4; ++b_) acc[a_][b_] = MFMA16(af[a_], bfk[b_], acc[a_][b_]);
        }
        float* cbase = CL + (size_t)u * 4096;
        const unsigned coff = (unsigned)(4 * g * 64 + col);
#pragma unroll
        for (int b_ = 0; b_ < 4; ++b_) {
#pragma unroll
            for (int a_ = 0; a_ < 4; ++a_)
#pragma unroll
                for (int r = 0; r < 4; ++r) cbase[(a_ * 16 * 64 + r * 64 + b_ * 16) + coff] = acc[a_][b_][r];
            float ns = nsum[b_]; ns += SHX(ns, 16, lane); ns += SHX(ns, 32, lane);
            if (g == 0) NLb[(size_t)u * 64 + b_ * 16 + col] = ns;
        }
    }
    __syncthreads();
}

__device__ __forceinline__ void phase_mlstm_carry(const Params& P, int l, unsigned char* smem, int wv, int bidx, int gdim) {
    ParamsPtr pp = PARAMS_PTR(P); PIN_S(pp); unsigned char* ws = pp->ws; PIN_S(bidx); PIN_S(gdim);
    float* CL = (float*)(ws + O_CL); float* NLb = (float*)(ws + O_NL); const float* ML = (const float*)(ws + O_ML); const float* BL = (const float*)(ws + O_BL);
    float* MIN = (float*)(ws + O_MIN);
    const int total = 2 * NB * MH * 4160;
    const int tid = phase_tid(wv);
    for (int gi = bidx * NTHREADS + tid; gi < total; gi += gdim * NTHREADS) {
        const int ph = gi / 4160, e = gi % 4160;
        float* base_ = e < 4096 ? CL + (size_t)ph * NCH * 4096 + e : NLb + (size_t)ph * NCH * 64 + (e - 4096);
        bf16_t* cb_ = (bf16_t*)(ws + O_CLB) + (size_t)ph * NCH * 4096 + e;
        const int stride = e < 4096 ? 4096 : 64;
        static_assert(NCH <= 32, "carry scan keeps one chunk value per register");
        float loc[NCH], bl[NCH], ml[NCH];
#pragma unroll
        for (int c = 0; c < NCH; ++c) { loc[c] = base_[(size_t)c * stride]; bl[c] = BL[ph * NCH + c]; ml[c] = ML[ph * NCH + c]; }
        float m = 0.f, val = 0.f;
#pragma unroll
        for (int c = 0; c < NCH; ++c) {
            if (e < 4096) cb_[(size_t)c * 4096] = (bf16_t)f2bf(val); else base_[(size_t)c * stride] = val;
            if (e == 0) MIN[ph * NCH + c] = m;
            const float mn = fmaxf(bl[c] + m, ml[c]);
            val = fexp(bl[c] + m - mn) * val + fexp(ml[c] - mn) * loc[c];
            m = mn;
        }
    }
}

__device__ __forceinline__ void phase_mlstm_out(const Params& P, int l, unsigned char* smem, int wv) {
    ParamsPtr pp = PARAMS_PTR(P); PIN_S(pp); unsigned char* ws = pp->ws; int bidx = (int)blockIdx.x, gdim = (int)gridDim.x; PIN_S(bidx); PIN_S(gdim);
    const bf16_t* proj = (const bf16_t*)(ws + O_PROJ);
    const bf16_t* MQB = (const bf16_t*)(ws + O_MQB); const bf16_t* MKB = (const bf16_t*)(ws + O_MKB); const bf16_t* VT = (const bf16_t*)(ws + O_VT);
    const float* GVT = (const float*)(ws + O_GVT); const float* PMX = (const float*)(ws + O_PMX); const float* BCT = (const float*)(ws + O_BCT);
    const bf16_t* CLB = (const bf16_t*)(ws + O_CLB); const float* NLb = (const float*)(ws + O_NL); const float* MIN = (const float*)(ws + O_MIN);
    bf16_t* GRP = (bf16_t*)(ws + O_GRP);
    const float* mln_g = pp->in[20] + (size_t)l * MW;
    const int tid = phase_tid(wv), lane = tid & 63, wave = tid >> 6, col = lane & 15, g = lane >> 4;
    constexpr int KP = 72, VP = 136, STG = 128 * KP * 2 + 64 * VP * 2 + 2 * 128 * 4;
    constexpr int NUm = NB * MH * NCH;
    const int it = wave * 16 + col;
    u32x4 kb_[2], vb_[2]; float gq_ = 0.f; bf16x8 bqn[2]; float minn[2], pmxn[2], bctn[2];
#define MO_EARLY(u_) do { const int tc_ = (u_) % NCH, h_ = ((u_) / NCH) % MH, b_ = (u_) / (NCH * MH); const int tok0_ = b_ * S + tc_ * CH; \
        _Pragma("unroll") for (int q = 0; q < 2; ++q) { const int idx = tid + q * NTHREADS; \
            kb_[q] = *(const u32x4*)(MKB + (size_t)(tok0_ + (idx >> 3)) * MW + h_ * 64 + (idx & 7) * 8); \
            vb_[q] = *(const u32x4*)(VT + ((size_t)(b_ * MH + h_) * 64 + (idx >> 4)) * S + (size_t)tc_ * CH + (idx & 15) * 8); } \
        if (tid < 256) gq_ = GVT[((size_t)(tid >> 7) * T + tok0_ + (tid & 127)) * MH + h_]; \
        const size_t trow_ = (size_t)(tok0_ + it); \
        _Pragma("unroll") for (int ks = 0; ks < 2; ++ks) bqn[ks] = *(const bf16x8*)(MQB + trow_ * MW + h_ * 64 + ks * 32 + 8 * g); \
        _Pragma("unroll") for (int d = 0; d < 2; ++d) { const int su_ = ((d * NB + b_) * MH + h_) * NCH + (d ? NCH - 1 - tc_ : tc_); const size_t gt_ = ((size_t)d * T + trow_) * MH + h_; \
            minn[d] = MIN[su_]; pmxn[d] = PMX[gt_]; bctn[d] = BCT[gt_]; } } while (0)
    int u = bidx, ui = 0;
    if (u < NUm) MO_EARLY(u);
    for (; u < NUm; u += gdim, ++ui) {
        const int tc = u % NCH, h = (u / NCH) % MH, b = u / (NCH * MH);
        const int tok0 = b * S + tc * CH;
        bf16_t* Ks = (bf16_t*)(smem + (ui & 1) * STG);
        bf16_t* Vs = Ks + 128 * KP;
        float* gvs_ = (float*)(Vs + 64 * VP);
#pragma unroll
        for (int q = 0; q < 2; ++q) {
            const int idx = tid + q * NTHREADS;
            *(u32x4*)(Ks + (idx >> 3) * KP + (idx & 7) * 8) = kb_[q];
            *(u32x4*)(Vs + (idx >> 4) * VP + (idx & 15) * 8) = vb_[q];
        }
        if (tid < 256) gvs_[tid] = gq_;
        bf16x8 bq[2] = {bqn[0], bqn[1]};
        const float mst_[2] = {minn[0], minn[1]}, pmx_[2] = {pmxn[0], pmxn[1]}, bct_[2] = {bctn[0], bctn[1]};
        const size_t trow = (size_t)(tok0 + it);
        bf16x8 cq[2][4][2]; f32x4 nl[2][2][2]; u32x2 og[4];
#define MO_LATE(d) do { const int su = (((d) * NB + b) * MH + h) * NCH + ((d) ? NCH - 1 - tc : tc); \
            _Pragma("unroll") for (int ks = 0; ks < 2; ++ks) { const float* np = NLb + (size_t)su * 64 + ks * 32 + 8 * g; \
                nl[d][ks][0] = *(const f32x4*)np; nl[d][ks][1] = *(const f32x4*)(np + 4); \
                _Pragma("unroll") for (int et = 0; et < 4; ++et) cq[d][et][ks] = *(const bf16x8*)(CLB + (size_t)su * 4096 + (size_t)(et * 16 + col) * 64 + ks * 32 + 8 * g); } } while (0)
        MO_LATE(0);
#pragma unroll
        for (int et = 0; et < 4; ++et) og[et] = *(const u32x2*)(proj + trow * PLD + C_MW + 3 * MW + h * 64 + et * 16 + 4 * g);
        __syncthreads();
        if (u + gdim < NUm) MO_EARLY(u + gdim);
        f32x4 hs[4];
#pragma unroll
        for (int et = 0; et < 4; ++et) hs[et] = (f32x4){0.f, 0.f, 0.f, 0.f};
#pragma unroll
        for (int d = 0; d < 2; ++d) {
            if (d == 1) MO_LATE(1);
            const float mst = mst_[d];
            const float mxt = fmaxf(pmx_[d], mst), mt = bct_[d] + mxt, wint = fexp(mst - mxt);
            f32x4 num[4];
#pragma unroll
            for (int et = 0; et < 4; ++et) num[et] = (f32x4){0.f, 0.f, 0.f, 0.f};
            float den = 0.f;
            for (int sp = 0; sp < 4; ++sp) {
                if (d == 0 ? (2 * sp > wave) : (2 * sp + 1 < wave)) continue;
                float pw[8];
#pragma unroll
                for (int hf = 0; hf < 2; ++hf) {
                    const int st = 2 * sp + hf;
                    f32x4 sacc = (f32x4){0.f, 0.f, 0.f, 0.f};
#pragma unroll
                    for (int ks = 0; ks < 2; ++ks) sacc = MFMA16(*(const bf16x8*)(Ks + (st * 16 + col) * KP + ks * 32 + 8 * g), bq[ks], sacc);
                    const f32x4 g4 = *(const f32x4*)(gvs_ + d * 128 + st * 16 + 4 * g);
#pragma unroll
                    for (int r = 0; r < 4; ++r) {
                        const int is = st * 16 + 4 * g + r;
                        const bool ok = d == 0 ? (is <= it) : (is >= it);
                        const float pr = ok ? sacc[r] * fexp(g4[r] - mxt) : 0.f;
                        den += pr; pw[hf * 4 + r] = pr;
                    }
                }
                u32x4 pb; pb.x = pk2(pw[0], pw[1]); pb.y = pk2(pw[2], pw[3]); pb.z = pk2(pw[4], pw[5]); pb.w = pk2(pw[6], pw[7]);
                const bf16x8 bp = __builtin_bit_cast(bf16x8, pb);
#pragma unroll
                for (int et = 0; et < 4; ++et) {
                    const bf16_t* vp = Vs + (et * 16 + col) * VP + sp * 32 + 4 * g;
                    const u32x2 v0 = *(const u32x2*)vp, v1 = *(const u32x2*)(vp + 16);
                    u32x4 va; va.x = v0.x; va.y = v0.y; va.z = v1.x; va.w = v1.y;
                    num[et] = MFMA16(__builtin_bit_cast(bf16x8, va), bp, num[et]);
                }
            }
            den += SHX(den, 16, lane); den += SHX(den, 32, lane);
            f32x4 qc[4]; float qn = 0.f;
#pragma unroll
            for (int ks = 0; ks < 2; ++ks) {
                const f32x4 n0 = nl[d][ks][0], n1 = nl[d][ks][1];
                const u32x4 qb = __builtin_bit_cast(u32x4, bq[ks]);
                qn += (bf_lo(qb.x) * n0.x + bf_hi(qb.x) * n0.y) + (bf_lo(qb.y) * n0.z + bf_hi(qb.y) * n0.w) + (bf_lo(qb.z) * n1.x + bf_hi(qb.z) * n1.y) + (bf_lo(qb.w) * n1.z + bf_hi(qb.w) * n1.w);
            }
            qn += SHX(qn, 16, lane); qn += SHX(qn, 32, lane);
#pragma unroll
            for (int et = 0; et < 4; ++et) {
                qc[et] = (f32x4){0.f, 0.f, 0.f, 0.f};
#pragma unroll
                for (int ks = 0; ks < 2; ++ks) qc[et] = MFMA16(cq[d][et][ks], bq[ks], qc[et]);
            }
            const float dd = frcp(fmaxf(fabsf(den + wint * qn), fexp(-mt)));
#pragma unroll
            for (int et = 0; et < 4; ++et) hs[et] += (num[et] + wint * qc[et]) * dd;
        }
        float sm = 0.f;
#pragma unroll
        for (int et = 0; et < 4; ++et) sm += (hs[et].x + hs[et].y) + (hs[et].z + hs[et].w);
        sm += SHX(sm, 16, lane); sm += SHX(sm, 32, lane);
        const float mean = sm * (1.0f / 64.0f); float q = 0.f;
#pragma unroll
        for (int et = 0; et < 4; ++et) { const f32x4 dl = hs[et] - mean; q += (dl.x * dl.x + dl.y * dl.y) + (dl.z * dl.z + dl.w * dl.w); }
        q += SHX(q, 16, lane); q += SHX(q, 32, lane);
        const float rstd = 1.0f / sqrtf(q * (1.0f / 64.0f) + LN_EPS);
#pragma unroll
        for (int et = 0; et < 4; ++et) {
            const int c = h * 64 + et * 16 + 4 * g;
            const u32x2 ob_ = og[et]; const f32x4 o4 = (f32x4){bf_lo(ob_.x), bf_hi(ob_.x), bf_lo(ob_.y), bf_hi(ob_.y)}, g4 = *(const f32x4*)(mln_g + c);
            const f32x4 y = (hs[et] - mean) * rstd * g4;
            u32x2 ob; ob.x = pk2(sigmoidf_(o4.x) * y.x, sigmoidf_(o4.y) * y.y); ob.y = pk2(sigmoidf_(o4.z) * y.z, sigmoidf_(o4.w) * y.w);
            *(u32x2*)(GRP + trow * D + GW + RW + c) = ob;
        }
    }
#undef MO_EARLY
#undef MO_LATE
    __syncthreads();
}

__device__ __forceinline__ void phase_rwkv_post(const Params& P, int l, unsigned char* smem, int wv) {
    ParamsPtr pp = PARAMS_PTR(P); PIN_S(pp); unsigned char* ws = pp->ws; int bidx = (int)blockIdx.x, gdim = (int)gridDim.x; PIN_S(bidx); PIN_S(gdim);
    const float* SCAN = (const float*)(ws + O_SCAN); const float* VV = (const float*)(ws + O_VV); const float* GATE = (const float*)(ws + O_GATE);
    const float* BONUS = (const float*)(ws + O_BONUS); bf16_t* GRP = (bf16_t*)(ws + O_GRP);
    const float* rln_g = pp->in[15] + (size_t)l * RW; const float* rln_b = pp->in[16] + (size_t)l * RW;
    const int tid = phase_tid(wv), lane = tid & 63, wave = tid >> 6;
    const int gw = bidx * NWAVES + wave, ngw = NWAVES * gdim;
    for (int it = gw; it < T * RH; it += ngw) {
        const int t = it / RH, h = it % RH, c = h * 64 + lane;
        const size_t o = (size_t)t * RW + c;
        const float x = SCAN[o] + SCAN[(size_t)T * RW + o];
        const float mean = wave_sum(x, lane) * (1.0f / 64.0f);
        const float dl = x - mean;
        const float var = wave_sum(dl * dl, lane) * (1.0f / 64.0f);
        float y = dl / sqrtf(var + GN_EPS) * rln_g[c] + rln_b[c];
        y += BONUS[(size_t)t * RH + h] * VV[o];
        GRP[(size_t)t * D + GW + c] = (bf16_t)f2bf(y * GATE[o]);
    }
}

__device__ __forceinline__ void phase_ln1_router(const Params& P, int l, unsigned char* smem, int wv) {
    ParamsPtr pp = PARAMS_PTR(P); PIN_S(pp); unsigned char* ws = pp->ws; int bidx = (int)blockIdx.x, gdim = (int)gridDim.x; PIN_S(bidx); PIN_S(gdim);
    const bf16_t* xin = (const bf16_t*)(ws + O_XB);
    const bf16_t* MIX = (const bf16_t*)(ws + O_MIX);
    int* TOPI = (int*)(ws + O_TOPI); float* TOPG = (float*)(ws + O_TOPG); int* RANK = (int*)(ws + O_RANK); bf16_t* X1B = (bf16_t*)(ws + O_X1B);
    int* BCNT = (int*)(ws + O_BCNT);
    const float* g1 = pp->in[22] + (size_t)l * D; const float* b1 = pp->in[23] + (size_t)l * D;
    const float* rw = pp->in[24] + (size_t)l * D * NE; const float* rb = pp->in[25] + (size_t)l * NE;
    const bf16_t* RWT = (const bf16_t*)(ws + O_RWT) + (size_t)l * 2 * NE * D;
    const int tid = phase_tid(wv), lane = tid & 63, wave = tid >> 6, col = lane & 15, g = lane >> 4;
    float* lgs = (float*)smem;
    int* stopi = (int*)(smem + 8704);
    constexpr int XHP = D + 8;
    bf16_t* XH = (bf16_t*)(smem + 16384);
    for (int tile = bidx; tile < T / 64; tile += gdim) {
        __syncthreads();
        {
            u32x2 xa[8][4], xm[8][4];
#pragma unroll
            for (int ti8 = 0; ti8 < 8; ++ti8) {
                const size_t tt_ = (size_t)(tile * 64 + wave * 8 + ti8);
#pragma unroll
                for (int j = 0; j < 4; ++j) { const int c = j * 256 + lane * 4; xa[ti8][j] = *(const u32x2*)(xin + tt_ * D + c); xm[ti8][j] = *(const u32x2*)(MIX + tt_ * D + c); }
            }
            f32x4 gg[4], bb[4];
#pragma unroll
            for (int j = 0; j < 4; ++j) { const int c = j * 256 + lane * 4; gg[j] = *(const f32x4*)(g1 + c); bb[j] = *(const f32x4*)(b1 + c); }
#pragma unroll
            for (int ti8 = 0; ti8 < 8; ++ti8) {
                const int t = tile * 64 + wave * 8 + ti8;
                float v[16]; float sm = 0.f;
#pragma unroll
                for (int j = 0; j < 4; ++j) {
                    v[j * 4 + 0] = ALPHA * bf_lo(xa[ti8][j].x) + bf_lo(xm[ti8][j].x); v[j * 4 + 1] = ALPHA * bf_hi(xa[ti8][j].x) + bf_hi(xm[ti8][j].x);
                    v[j * 4 + 2] = ALPHA * bf_lo(xa[ti8][j].y) + bf_lo(xm[ti8][j].y); v[j * 4 + 3] = ALPHA * bf_hi(xa[ti8][j].y) + bf_hi(xm[ti8][j].y);
                    sm += (v[j * 4] + v[j * 4 + 1]) + (v[j * 4 + 2] + v[j * 4 + 3]);
                }
                const float mean = wave_sum_fast(sm, lane) * (1.0f / D); float q = 0.f;
#pragma unroll
                for (int j = 0; j < 16; ++j) { const float dl = v[j] - mean; q += dl * dl; }
                const float rstd = 1.0f / sqrtf(wave_sum_fast(q, lane) * (1.0f / D) + LN_EPS);
#pragma unroll
                for (int j = 0; j < 4; ++j) {
                    const int c = j * 256 + lane * 4;
                    f32x4 o;
                    o.x = (v[j * 4 + 0] - mean) * rstd * gg[j].x + bb[j].x; o.y = (v[j * 4 + 1] - mean) * rstd * gg[j].y + bb[j].y;
                    o.z = (v[j * 4 + 2] - mean) * rstd * gg[j].z + bb[j].z; o.w = (v[j * 4 + 3] - mean) * rstd * gg[j].w + bb[j].w;
                    u32x2 ob; ob.x = pk2(o.x, o.y); ob.y = pk2(o.z, o.w); *(u32x2*)(X1B + (size_t)t * D + c) = ob;
                    *(u32x2*)(XH + (wave * 8 + ti8) * XHP + c) = ob;
                }
            }
        }
        __syncthreads();
        {
            const bf16_t* xr = XH + ((wave >> 1) * 16 + col) * XHP + 8 * g;
            const bf16_t* wh = RWT + (size_t)((wave & 1) * 16 + col) * D + 8 * g; const bf16_t* wl = wh + (size_t)NE * D;
            f32x4 acc = (f32x4){0.f, 0.f, 0.f, 0.f};
#pragma unroll 8
            for (int ks = 0; ks < 32; ++ks) {
                const bf16x8 ah = *(const bf16x8*)(xr + ks * 32);
                const bf16x8 bh = *(const bf16x8*)(wh + ks * 32), bl = *(const bf16x8*)(wl + ks * 32);
                acc = MFMA16(ah, bh, acc); acc = MFMA16(ah, bl, acc);
            }
            const float rbv = rb[(wave & 1) * 16 + col];
#pragma unroll
            for (int r = 0; r < 4; ++r) lgs[((wave >> 1) * 16 + 4 * g + r) * (NE + 1) + (wave & 1) * 16 + col] = acc[r] + rbv;
        }
        __syncthreads();
        if (tid < 64) {
            const float* lp = lgs + tid * (NE + 1); const int t = tile * 64 + tid;
            float tv[4]; int ti[4];
#pragma unroll
            for (int k = 0; k < 4; ++k) { tv[k] = -INFINITY; ti[k] = 0; }
            for (int e = 0; e < NE; ++e) {
                const float x = lp[e];
                if (x > tv[3]) {
                    if (x > tv[0]) { tv[3] = tv[2]; ti[3] = ti[2]; tv[2] = tv[1]; ti[2] = ti[1]; tv[1] = tv[0]; ti[1] = ti[0]; tv[0] = x; ti[0] = e; }
                    else if (x > tv[1]) { tv[3] = tv[2]; ti[3] = ti[2]; tv[2] = tv[1]; ti[2] = ti[1]; tv[1] = x; ti[1] = e; }
                    else if (x > tv[2]) { tv[3] = tv[2]; ti[3] = ti[2]; tv[2] = x; ti[2] = e; }
                    else { tv[3] = x; ti[3] = e; }
                }
            }
            const float e1 = expf(tv[1] - tv[0]), e2 = expf(tv[2] - tv[0]), e3 = expf(tv[3] - tv[0]);
            const float inv = 1.0f / (1.0f + e1 + e2 + e3);
            *(f32x4*)(TOPG + (size_t)t * 4) = (f32x4){inv, e1 * inv, e2 * inv, e3 * inv};
#pragma unroll
            for (int k = 0; k < 4; ++k) { TOPI[(size_t)t * 4 + k] = ti[k]; stopi[tid * 4 + k] = ti[k]; }
        }
        __syncthreads();
        int* wcnt = stopi + 256;
        int rk = 0, ex = 0;
        if (wave < 4) {
            ex = stopi[tid]; int mycnt = 0;
            for (int x = 0; x < NE; ++x) { const unsigned long long m = __ballot(ex == x); if (ex == x) rk = __popcll(m & ((1ull << lane) - 1ull)); if (lane == x) mycnt = __popcll(m); }
            if (lane < NE) wcnt[wave * NE + lane] = mycnt;
        }
        __syncthreads();
        if (wave < 4) { for (int w2 = 0; w2 < wave; ++w2) rk += wcnt[w2 * NE + ex]; RANK[(size_t)tile * 256 + tid] = rk; }
        else if (tid < 256 + NE) { const int e = tid - 256; BCNT[tile * NE + e] = (wcnt[e] + wcnt[NE + e]) + (wcnt[2 * NE + e] + wcnt[3 * NE + e]); }
    }
    __syncthreads();
}

__device__ __forceinline__ void moe_offsets(int* sh, const int* CNT, int tid) {
    if (tid == 0) {
        int acc = 0;
        for (int e = 0; e < NE; ++e) { const int c = (int)CNT[e]; sh[e] = c; sh[32 + e] = acc; acc += (c + MOEB - 1) / MOEB * MOEB; sh[64 + e] = acc; }
    }
    __syncthreads();
}
__device__ __forceinline__ int moe_expert_of_row(const int* sh, int r) {
    int e = -1;
    for (int i = 0; i < NE; ++i) if (r >= sh[32 + i] && r < sh[64 + i]) e = i;
    return e;
}

__device__ __forceinline__ void phase_scatter(const Params& P, int l, unsigned char* smem, int wv) {
    ParamsPtr pp = PARAMS_PTR(P); PIN_S(pp); unsigned char* ws = pp->ws; int bidx = (int)blockIdx.x, gdim = (int)gridDim.x; PIN_S(bidx); PIN_S(gdim);
    const int tid = phase_tid(wv);
    const int* TOPI = (const int*)(ws + O_TOPI); const int* RANK = (const int*)(ws + O_RANK); int* SLOT = (int*)(ws + O_SLOT); int* ROWT = (int*)(ws + O_ROWT);
    const int* BCNT = (const int*)(ws + O_BCNT); int* CNTF = (int*)(ws + O_CNTF);
    int* sh = (int*)smem;
    int* part = sh + 96;
    int* tot = part + 512;
    int* base = tot + 32;
    constexpr int NT = T / 64;
    const int e = tid & 31, pt = tid >> 5;
    { int sacc = 0; for (int tl = pt; tl < NT; tl += 16) sacc += BCNT[tl * NE + e]; part[pt * 32 + e] = sacc; }
    __syncthreads();
    if (tid < 32) { int sacc = 0; for (int q = 0; q < 16; ++q) sacc += part[q * 32 + tid]; tot[tid] = sacc; if (bidx == 0) CNTF[tid] = sacc; }
    __syncthreads();
    moe_offsets(sh, tot, tid);
    for (int ee = bidx; ee < NE; ee += gdim)
        for (int r = sh[32 + ee] + sh[ee] + tid; r < sh[64 + ee]; r += NTHREADS) ROWT[r] = 0;
    for (int tile = bidx; tile < NT; tile += gdim) {
        __syncthreads();
        { int sacc = 0; for (int tl = pt; tl < tile; tl += 16) sacc += BCNT[tl * NE + e]; part[pt * 32 + e] = sacc; }
        __syncthreads();
        if (tid < 32) { int sacc = sh[32 + tid]; for (int q = 0; q < 16; ++q) sacc += part[q * 32 + tid]; base[tid] = sacc; }
        __syncthreads();
        if (tid < 256) { const int a = tile * 256 + tid, dest = base[TOPI[a]] + RANK[a]; SLOT[a] = dest; ROWT[dest] = a >> 2; }
    }
    __syncthreads();
}

template <int WHICH>
__device__ __forceinline__ void phase_moe_gemm(const Params& P, int l, unsigned char* smem, int wv) {
    ParamsPtr pp = PARAMS_PTR(P); PIN_S(pp); unsigned char* ws = pp->ws; int bidx = (int)blockIdx.x, gdim = (int)gridDim.x; PIN_S(bidx); PIN_S(gdim);
    const int tid = phase_tid(wv);
    const int* CNT = (const int*)(ws + O_CNTF);
    int* sh = (int*)(smem + 131072);
    int* rbe = sh + 96;
    moe_offsets(sh, CNT, tid);
    const int nrb = sh[64 + NE - 1] / MOEB;
    for (int rb = tid; rb < nrb; rb += NTHREADS) rbe[rb] = moe_expert_of_row(sh, rb * MOEB);
    __syncthreads();
    pg8::MoeOrderT<WHICH == 1> S;
    S.K = 1024; S.G_ = gdim; S.c = bidx; S.rbe = rbe; S.rowmap = (const int*)(ws + O_ROWT);
    if (WHICH == 1) {
        S.A = (const char*)(ws + O_X1B); S.Wt = (const char*)(ws + O_W1) + (size_t)l * NE * 2 * DFF * D * 2; S.estride = (size_t)2 * DFF * D * 2; S.nN = 2 * DFF / 256; S.nwg = nrb * S.nN;
        pg8::EpiSwiglu E{(bf16_t*)(ws + O_ACT), pp->in[27] + (size_t)l * NE * 2 * DFF};
        pg8::gemm_phase<pg8::EpiSwiglu, pg8::MoeOrderT<WHICH == 1>>((LAS unsigned char*)smem, 1024, S, E, tid);
    } else {
        S.A = (const char*)(ws + O_ACT); S.Wt = (const char*)(ws + O_W2) + (size_t)l * NE * D * DFF * 2; S.estride = (size_t)D * DFF * 2; S.nN = D / 256; S.nwg = nrb * S.nN;
        pg8::EpiBf16Bias E{(bf16_t*)(ws + O_YS), D, pp->in[29] + (size_t)l * NE * D, D};
        pg8::gemm_phase<pg8::EpiBf16Bias, pg8::MoeOrderT<WHICH == 1>>((LAS unsigned char*)smem, 1024, S, E, tid);
    }
    __syncthreads();
}

constexpr size_t CTL_RBC = 65536;
__device__ __forceinline__ void phase_moe_merged(const Params& P, int l, unsigned char* smem, int wv) {
    ParamsPtr pp = PARAMS_PTR(P); PIN_S(pp); unsigned char* ws = pp->ws; int bidx = (int)blockIdx.x, gdim = (int)gridDim.x; PIN_S(bidx); PIN_S(gdim);
    const int tid = phase_tid(wv);
    const int* CNT = (const int*)(ws + O_CNTF);
    int* sh = (int*)(smem + 131072);
    int* rbe = sh + 96;
    moe_offsets(sh, CNT, tid);
    const int nrb = sh[64 + NE - 1] / MOEB;
    for (int rb = tid; rb < nrb; rb += NTHREADS) rbe[rb] = moe_expert_of_row(sh, rb * MOEB);
    __syncthreads();
    static_assert(NROWS / 256 <= 512 && DFF == 1024 && D == 1024, "merged expert GEMMs: both K = 1024, at most 512 row blocks");
    pg8::MoeMerged S;
    S.K = 1024; S.G_ = gdim; S.c = bidx; S.rbe = rbe; S.rowmap = (const int*)(ws + O_ROWT); S.nrb = nrb;
    S.A1 = (const char*)(ws + O_X1B); S.A2 = (const char*)(ws + O_ACT);
    S.W1t = (const char*)(ws + O_W1) + (size_t)l * NE * 2 * DFF * D * 2; S.es1 = (size_t)2 * DFF * D * 2;
    S.W2t = (const char*)(ws + O_W2) + (size_t)l * NE * D * DFF * 2; S.es2 = (size_t)D * DFF * 2;
    S.cnt = (unsigned*)(ws + CTL_RBC) + l * 512;
    pg8::EpiMoe E{(bf16_t*)(ws + O_ACT), pp->in[27] + (size_t)l * NE * 2 * DFF, (bf16_t*)(ws + O_YS), pp->in[29] + (size_t)l * NE * D, (unsigned)((size_t)NROWS * DFF * 2)};
    pg8::gemm_phase<pg8::EpiMoe, pg8::MoeMerged>((LAS unsigned char*)smem, 1024, S, E, tid);
    __syncthreads();
}

__device__ __forceinline__ void phase_combine_ln2(const Params& P, int l, unsigned char* smem, int wv) {
    ParamsPtr pp = PARAMS_PTR(P); PIN_S(pp); unsigned char* ws = pp->ws; int bidx = (int)blockIdx.x, gdim = (int)gridDim.x; PIN_S(bidx); PIN_S(gdim);
    const bf16_t* X1 = (const bf16_t*)(ws + O_X1B); const bf16_t* YS = (const bf16_t*)(ws + O_YS); bf16_t* XB = (bf16_t*)(ws + O_XB);
    const int* SLOT = (const int*)(ws + O_SLOT); const float* TOPG = (const float*)(ws + O_TOPG);
    float* xo = pp->out;
    const float* g2 = pp->in[30] + (size_t)l * D; const float* b2 = pp->in[31] + (size_t)l * D;
    const int tid = phase_tid(wv), lane = tid & 63, wave = tid >> 6;
    const int gw = bidx * NWAVES + wave, ngw = NWAVES * gdim;
    u32x4 sl_n = (u32x4){0u, 0u, 0u, 0u}; f32x4 gg_n = (f32x4){0.f, 0.f, 0.f, 0.f};
    u32x2 xa_n[4]; u32x2 ys_n[4][4]; f32x4 gg_c = (f32x4){0.f, 0.f, 0.f, 0.f};
    const f32x4 lg[4] = {*(const f32x4*)(g2 + lane * 4), *(const f32x4*)(g2 + 256 + lane * 4), *(const f32x4*)(g2 + 512 + lane * 4), *(const f32x4*)(g2 + 768 + lane * 4)};
    const f32x4 lb[4] = {*(const f32x4*)(b2 + lane * 4), *(const f32x4*)(b2 + 256 + lane * 4), *(const f32x4*)(b2 + 512 + lane * 4), *(const f32x4*)(b2 + 768 + lane * 4)};
#define CB_META(tt_) do { sl_n = *(const u32x4*)(SLOT + (size_t)(tt_) * 4); gg_n = *(const f32x4*)(TOPG + (size_t)(tt_) * 4); } while (0)
#define CB_ROWS(tt_) do { _Pragma("unroll") for (int j = 0; j < 4; ++j) { const int c = j * 256 + lane * 4; xa_n[j] = *(const u32x2*)(X1 + (size_t)(tt_) * D + c); \
        ys_n[0][j] = *(const u32x2*)(YS + (size_t)sl_n.x * D + c); ys_n[1][j] = *(const u32x2*)(YS + (size_t)sl_n.y * D + c); ys_n[2][j] = *(const u32x2*)(YS + (size_t)sl_n.z * D + c); ys_n[3][j] = *(const u32x2*)(YS + (size_t)sl_n.w * D + c); } gg_c = gg_n; } while (0)
    if (gw < T) { CB_META(gw); CB_ROWS(gw); if (gw + ngw < T) CB_META(gw + ngw); }
    for (int t = gw; t < T; t += ngw) {
        float v[16]; float sm = 0.f;
        const float gk[4] = {gg_c.x, gg_c.y, gg_c.z, gg_c.w};
#pragma unroll
        for (int j = 0; j < 4; ++j) {
            const f32x4 a = (f32x4){bf_lo(xa_n[j].x), bf_hi(xa_n[j].x), bf_lo(xa_n[j].y), bf_hi(xa_n[j].y)};
            f32x4 y = (f32x4){0.f, 0.f, 0.f, 0.f};
#pragma unroll
            for (int k = 0; k < 4; ++k) { const u32x2 yk = ys_n[k][j]; y.x += gk[k] * bf_lo(yk.x); y.y += gk[k] * bf_hi(yk.x); y.z += gk[k] * bf_lo(yk.y); y.w += gk[k] * bf_hi(yk.y); }
            v[j * 4 + 0] = ALPHA * a.x + y.x; v[j * 4 + 1] = ALPHA * a.y + y.y; v[j * 4 + 2] = ALPHA * a.z + y.z; v[j * 4 + 3] = ALPHA * a.w + y.w;
            sm += (v[j * 4] + v[j * 4 + 1]) + (v[j * 4 + 2] + v[j * 4 + 3]);
        }
        if (t + ngw < T) { CB_ROWS(t + ngw); if (t + 2 * ngw < T) CB_META(t + 2 * ngw); }
        const float mean = wave_sum_fast(sm, lane) * (1.0f / D); float q = 0.f;
#pragma unroll
        for (int j = 0; j < 16; ++j) { const float dl = v[j] - mean; q += dl * dl; }
        const float rstd = 1.0f / sqrtf(wave_sum_fast(q, lane) * (1.0f / D) + LN_EPS);
#pragma unroll
        for (int j = 0; j < 4; ++j) {
            const int c = j * 256 + lane * 4;
            f32x4 o;
            o.x = (v[j * 4 + 0] - mean) * rstd * lg[j].x + lb[j].x; o.y = (v[j * 4 + 1] - mean) * rstd * lg[j].y + lb[j].y;
            o.z = (v[j * 4 + 2] - mean) * rstd * lg[j].z + lb[j].z; o.w = (v[j * 4 + 3] - mean) * rstd * lg[j].w + lb[j].w;
            if (l == NL - 1) *(f32x4*)(xo + (size_t)t * D + c) = o;
            else { u32x2 ob; ob.x = pk2(o.x, o.y); ob.y = pk2(o.z, o.w); *(u32x2*)(XB + (size_t)t * D + c) = ob; }
        }
    }
#undef CB_META
#undef CB_ROWS
}

__device__ __forceinline__ void phase_inproj(const Params& P, int l, unsigned char* smem, int wv) {
    ParamsPtr pp = PARAMS_PTR(P); PIN_S(pp); unsigned char* ws = pp->ws; int bidx = (int)blockIdx.x, gdim = (int)gridDim.x; PIN_S(bidx); PIN_S(gdim);
    const int tid = phase_tid(wv);
    pg8::DenseOrder S; S.init(ws + O_XB, (const bf16_t*)(ws + O_WIN) + (size_t)l * PLD * D, T, PLD, D, gdim, bidx);
    pg8::EpiProj E{(bf16_t*)(ws + O_PROJ), PLD, (float*)(ws + O_PROJG), PLD / 256 - 1};
    pg8::gemm_phase<pg8::EpiProj, pg8::DenseOrder>((LAS unsigned char*)smem, D, S, E, tid);
    __syncthreads();
}
__device__ __forceinline__ void phase_outproj(const Params& P, int l, unsigned char* smem, int wv) {
    ParamsPtr pp = PARAMS_PTR(P); PIN_S(pp); unsigned char* ws = pp->ws; int bidx = (int)blockIdx.x, gdim = (int)gridDim.x; PIN_S(bidx); PIN_S(gdim);
    const int tid = phase_tid(wv);
    pg8::DenseOrder S; S.init(ws + O_GRP, (const bf16_t*)(ws + O_WOUT) + (size_t)l * D * D, T, D, D, gdim, bidx);
    pg8::EpiProj E{(bf16_t*)(ws + O_MIX), D, nullptr, -1};
    pg8::gemm_phase<pg8::EpiProj, pg8::DenseOrder>((LAS unsigned char*)smem, D, S, E, tid);
    __syncthreads();
}

#ifndef EMU
#define XB_TMO      128
#define XB_XCNT(j)  (256  + 64 * (j))
#define XB_XSUB(j)  (1280 + 64 * (j))
#define XB_XGEN(j)  (2304 + 64 * (j))
#define XB_TOP      3328
#define XB_TOPGEN   3392
#define XCD_BAR_WORDS 3456
#define XB_SPIN_CAP (1u << 25)
__device__ __forceinline__ unsigned xb_ld(unsigned* p)              { return __hip_atomic_load(p, __ATOMIC_RELAXED, __HIP_MEMORY_SCOPE_AGENT); }
__device__ __forceinline__ unsigned xb_add(unsigned* p, unsigned v) { return __hip_atomic_fetch_add(p, v, __ATOMIC_RELAXED, __HIP_MEMORY_SCOPE_AGENT); }
__device__ __forceinline__ unsigned xb_xcc_id() { return (unsigned)__builtin_amdgcn_s_getreg((3 << 11) | 20) & 0xFu; }
#define XB_SPIN(cond, bar) do { unsigned _sp = 0; while (cond) { __builtin_amdgcn_s_sleep(1); \
    if ((++_sp & 255u) == 0u) { if (xb_ld(&(bar)[XB_TMO])) break; if (_sp > XB_SPIN_CAP) { atomicAdd(&(bar)[XB_TMO], 1u); break; } } } } while (0)
struct XcdBarrier { unsigned* bar; unsigned x; volatile LAS unsigned* st; };
__device__ __forceinline__ XcdBarrier xcd_barrier_post(unsigned* bar, volatile LAS unsigned* st) {
    XcdBarrier b; b.bar = bar; b.x = xb_xcc_id(); b.st = st;
    if (threadIdx.x == 0) (void)xb_add(&bar[XB_XCNT(b.x)], 1u);
    return b;
}
__device__ __forceinline__ void xcd_barrier_complete(unsigned* bar, unsigned x, unsigned& nloc, unsigned& nx) {
    const unsigned G = gridDim.x * gridDim.y * gridDim.z;
    unsigned sum, cnt, mine, sp = 0u;
    for (;;) {
        sum = 0u; cnt = 0u; mine = 0u;
#pragma unroll
        for (unsigned j = 0; j < 16; ++j) { const unsigned c = xb_ld(&bar[XB_XCNT(j)]); sum += c; cnt += (c > 0u) ? 1u : 0u; mine = (j == x) ? c : mine; }
        if (sum == G) break;
        __builtin_amdgcn_s_sleep(1);
        if ((++sp & 255u) == 0u) { if (xb_ld(&bar[XB_TMO])) break; if (sp > XB_SPIN_CAP) { atomicAdd(&bar[XB_TMO], 1u); break; } }
    }
    nloc = mine > 0u ? mine : 1u; nx = cnt > 0u ? cnt : 1u;
}
__device__ __forceinline__ void xcd_barrier(const XcdBarrier& b) {
    asm volatile("s_waitcnt vmcnt(0)" ::: "memory");
    __syncthreads();
    if (threadIdx.x == 0) {
        unsigned* bar = b.bar;
        __builtin_amdgcn_s_waitcnt(0);
        unsigned nloc = b.st[0], nx = b.st[1];
        if (nloc == 0u) { xcd_barrier_complete(bar, b.x, nloc, nx); b.st[0] = nloc; b.st[1] = nx; }
        const unsigned old = xb_add(&bar[XB_XSUB(b.x)], 1u);
        const unsigned gen = old / nloc;
        if (old + 1u == (gen + 1u) * nloc) {
            __builtin_amdgcn_fence(__ATOMIC_RELEASE, "agent");
            asm volatile("s_waitcnt vmcnt(0)" ::: "memory");
            const unsigned og = xb_add(&bar[XB_TOP], 1u);
            const unsigned tg = og / nx;
            if (og + 1u == (tg + 1u) * nx) xb_add(&bar[XB_TOPGEN], 1u);
            else XB_SPIN(xb_ld(&bar[XB_TOPGEN]) == tg, bar);
            __builtin_amdgcn_fence(__ATOMIC_ACQUIRE, "agent");
            xb_add(&bar[XB_XGEN(b.x)], 1u);
            asm volatile("s_waitcnt vmcnt(0)" ::: "memory");
        } else {
            XB_SPIN(xb_ld(&bar[XB_XGEN(b.x)]) == gen, bar);
            __builtin_amdgcn_fence(__ATOMIC_ACQUIRE, "agent");
            asm volatile("s_waitcnt vmcnt(0)" ::: "memory");
        }
    }
    __syncthreads();
}
#endif

__global__ void __launch_bounds__(512, 2) mk_fwd(Params P) {
#ifdef EMU
    unsigned char* smem = g_blk->lds;
#else
    extern __shared__ __attribute__((aligned(16))) unsigned char smem[];
    volatile LAS unsigned* bst = (volatile LAS unsigned*)(smem + LDS_BYTES - 16);
    if (threadIdx.x == 0) { bst[0] = 0u; bst[1] = 0u; bst[2] = 0u; bst[3] = 0u; }
    __syncthreads();
    XcdBarrier bar; bar.bar = (unsigned*)P.ws + CW_BAR; bar.x = 0; bar.st = bst;
    if (P.ph_hi - P.ph_lo > 1) bar = xcd_barrier_post((unsigned*)P.ws + CW_BAR, bst);
#endif
    const int lo = P.ph_lo, hi = P.ph_hi;
#ifdef EMU
    const int wv = (int)threadIdx.x >> 6;
#else
    const int wv = RFL((int)threadIdx.x >> 6);
#endif
#ifdef EMU
#define SEAM(id) do {} while (0)
#else
#define SEAM(id) do { if ((id) + 1 < hi) xcd_barrier(bar); } while (0)
#endif
#ifndef MK_ONLY_PHASE
#define MK_ONLY_PHASE -1
#endif
#ifndef MK_DUP_MASK
#define MK_DUP_MASK 0
#endif
#define PHG(kc, id, ...) do { if (MK_ONLY_PHASE < 0 || MK_ONLY_PHASE == (kc)) { const int id_ = (id); if (id_ >= lo && id_ < hi) { if ((MK_DUP_MASK >> (kc)) & 1) { __VA_ARGS__; SEAM(id_ - 1); } __VA_ARGS__; SEAM(id_); } } } while (0)
#define PH(k, ...) PHG(1 + (k), 1 + l * NPH + (k), __VA_ARGS__)
    PHG(0, 0, phase_prologue(P, smem, wv));
    for (int l = 0; l < NL; ++l) {
        PH(0, phase_inproj(P, l, smem, wv));
#if MK_RWKV_CHUNKED
        PH(1, phase_prep32(P, l, smem, wv));
#else
        PH(1, phase_prep(P, l, smem, wv));
#endif
#if MK_RWKV_CHUNKED
        PH(2, { phase_rwkv_pre(P, l, smem, wv); phase_mlstm_local(P, l, smem, wv, (int)blockIdx.x, (int)gridDim.x); if (MK_PROBE == 42) phase_mlstm_local(P, l, smem, wv, (int)blockIdx.x, (int)gridDim.x); });
        PH(3, { const int G_ = (int)gridDim.x;
                if (G_ >= 2 * RSEQ_WGS) { if ((int)blockIdx.x < RSEQ_WGS) { phase_rwkv_seq(P, l, smem, wv); if (MK_PROBE >= 30 && MK_PROBE < 38) phase_rwkv_seq<MK_PROBE >= 30 && MK_PROBE < 38 ? MK_PROBE - 30 : 0>(P, l, smem, wv); }
                                           else { phase_mlstm_carry(P, l, smem, wv, (int)blockIdx.x - RSEQ_WGS, G_ - RSEQ_WGS); phase_gmlp_mix(P, l, smem, wv, (int)blockIdx.x - RSEQ_WGS, G_ - RSEQ_WGS);
                                                  if (MK_PROBE == 39) phase_gmlp_mix(P, l, smem, wv, (int)blockIdx.x - RSEQ_WGS, G_ - RSEQ_WGS); } }
                else { phase_rwkv_seq(P, l, smem, wv); phase_mlstm_carry(P, l, smem, wv, (int)blockIdx.x, G_); } });
        PH(4, { phase_rwkv_out(P, l, smem, wv); if (MK_PROBE == 40) phase_rwkv_out(P, l, smem, wv); phase_mlstm_out(P, l, smem, wv); if (MK_PROBE == 41) phase_mlstm_out(P, l, smem, wv); if ((int)gridDim.x < 2 * RSEQ_WGS) phase_gmlp_mix(P, l, smem, wv, (int)blockIdx.x, (int)gridDim.x); });
#else
        PH(2, { const int G_ = (int)gridDim.x, NSC = 2 * NB * RH * 4;
                if (G_ >= NSC + 32) { if ((int)blockIdx.x < NSC) phase_rwkv_scan(P, l, smem, wv, (int)blockIdx.x, NSC);
                                      else phase_mlstm_local(P, l, smem, wv, (int)blockIdx.x - NSC, G_ - NSC); }
                else { phase_rwkv_scan(P, l, smem, wv, (int)blockIdx.x, G_); phase_mlstm_local(P, l, smem, wv, (int)blockIdx.x, G_); } });
        PH(3, phase_mlstm_carry(P, l, smem, wv, (int)blockIdx.x, (int)gridDim.x));
        PH(4, { phase_mlstm_out(P, l, smem, wv); phase_gmlp_mix(P, l, smem, wv, (int)blockIdx.x, (int)gridDim.x); phase_rwkv_post(P, l, smem, wv); });
#endif
        PH(5, phase_outproj(P, l, smem, wv));
        PH(6, phase_ln1_router(P, l, smem, wv));
        PH(7, phase_scatter(P, l, smem, wv));
#if MK_MOE_MERGED
        PH(8, phase_moe_merged(P, l, smem, wv));
        PH(9, phase_combine_ln2(P, l, smem, wv));
#else
        PH(8, phase_moe_gemm<1>(P, l, smem, wv));
        PH(9, phase_moe_gemm<2>(P, l, smem, wv));
        PH(10, phase_combine_ln2(P, l, smem, wv));
#endif
    }
#undef PHG
#undef PH
#undef SEAM
}

}

#ifndef EMU
extern "C" void kernel_launch(void* const* d_in, const int* in_sizes, int n_in, void* d_out, int out_size, void* d_ws, size_t ws_size, hipStream_t stream) {
    using namespace mk;
    static int grid = 0;
    if (grid == 0) {
        if (n_in != 32 || out_size != T * D || ws_size < WS_END) { fprintf(stderr, "kernel_launch: unexpected shapes (n_in %d out %d ws %zu need %zu)\n", n_in, out_size, ws_size, (size_t)WS_END); grid = -1; return; }
        int dev = 0, cus = 0;
        if (hipGetDevice(&dev) != hipSuccess || hipDeviceGetAttribute(&cus, hipDeviceAttributeMultiprocessorCount, dev) != hipSuccess) { grid = -1; return; }
        if (hipFuncSetAttribute((const void*)mk_fwd, hipFuncAttributeMaxDynamicSharedMemorySize, LDS_BYTES) != hipSuccess) { fprintf(stderr, "kernel_launch: hipFuncSetAttribute failed\n"); grid = -1; return; }
        int per_cu = 0;
        (void)hipOccupancyMaxActiveBlocksPerMultiprocessor(&per_cu, (const void*)mk_fwd, NTHREADS, LDS_BYTES);
        (void)hipGetLastError();
        grid = cus;
    }
    if (grid < 0) return;
    (void)hipMemsetAsync(d_ws, 0, CTL_BYTES, stream);
    Params p{};
    for (int i = 0; i < 32; ++i) p.in[i] = (const float*)d_in[i];
    p.out = (float*)d_out; p.ws = (unsigned char*)d_ws;
#if MK_ONE_LAUNCH
    p.ph_lo = 0; p.ph_hi = 1 + NL * NPH;
    hipLaunchKernelGGL(mk_fwd, dim3(grid), dim3(NTHREADS), LDS_BYTES, stream, p);
#else
    for (int id = 0; id < 1 + NL * NPH; ++id) {
        p.ph_lo = id; p.ph_hi = id + 1;
        hipLaunchKernelGGL(mk_fwd, dim3(grid), dim3(NTHREADS), LDS_BYTES, stream, p);
    }
#endif
}
#endif
```

```cpp
#ifndef EMU
#include <hip/hip_runtime.h>
#endif
#include <cstdio>
#include <cstdint>
#include <cmath>

#ifndef CFG_BATCH
#define CFG_BATCH 4
#endif
#ifndef CFG_SEQ
#define CFG_SEQ 4096
#endif
#ifndef CFG_LAYERS
#define CFG_LAYERS 4
#endif
#ifndef MK_RWKV_CHUNKED
#define MK_RWKV_CHUNKED 1
#endif
#ifndef MK_PROBE
#define MK_PROBE 0
#endif
#ifndef MK_SP2
#define MK_SP2 1
#endif
#ifndef MK_ONE_LAUNCH
#define MK_ONE_LAUNCH 1
#endif

namespace mk {
constexpr int NB = CFG_BATCH, S = CFG_SEQ, T = NB * S, NL = CFG_LAYERS, D = 1024;
constexpr int GW = 256, RW = 384, MW = 384, HD = 64, GH = 4, RH = 6, MH = 6, CH = 128, NCH = S / CH;
constexpr int PIN = 3480, PLD = 3584, RPROJ = 1408;
constexpr int C_RW = 512, C_MW = 1920;
constexpr int NE = 32, TOPK = 4, DFF = 1024, MOEB = 256;
constexpr int NROWS = (T * TOPK / MOEB + NE) * MOEB;
constexpr float LN_EPS = 1e-5f, GN_EPS = 64e-5f;
constexpr float ALPHA = 1.6817928305074290f;
constexpr int NTHREADS = 512, NWAVES = 8;
constexpr int LDS_BYTES = 160 * 1024;
#ifndef MK_MOE_MERGED
#define MK_MOE_MERGED 1
#endif
constexpr int NPH = MK_MOE_MERGED ? 10 : 11;

typedef float f32x4 __attribute__((ext_vector_type(4)));
typedef unsigned u32x4 __attribute__((ext_vector_type(4)));
typedef unsigned u32x2 __attribute__((ext_vector_type(2)));
typedef short bf16x8 __attribute__((ext_vector_type(8)));
typedef unsigned short bf16_t;

constexpr size_t al(size_t x) { return (x + 255) & ~(size_t)255; }
constexpr size_t CTL_BYTES = 1u << 20;
constexpr size_t O_XA = CTL_BYTES;
constexpr size_t O_CLB = O_XA;
constexpr size_t O_XB = O_XA + al((size_t)T * D * 4);
constexpr size_t O_X1 = O_XB + al((size_t)T * D * 2);
constexpr size_t O_X1B = O_X1 + al((size_t)T * D * 4);
constexpr size_t O_PROJ = O_X1B + al((size_t)T * D * 2);
constexpr size_t O_PROJG = O_PROJ + al((size_t)T * PLD * 2);
constexpr size_t O_MIX = O_PROJ + al((size_t)T * PLD * 4);
constexpr size_t O_GRP = O_MIX + al((size_t)T * D * 4);
constexpr size_t O_UG = O_GRP + al((size_t)T * D * 2);
constexpr size_t O_VN = O_UG + al((size_t)T * GW * 4);
constexpr size_t O_RR = O_VN + al((size_t)T * GW * 4);
constexpr size_t O_VV = O_RR + al((size_t)T * RW * 4);
constexpr size_t O_KK = O_VV + al((size_t)T * RW * 4);
constexpr size_t O_DEC = O_KK + al((size_t)T * RW * 4);
constexpr size_t O_KD = O_DEC + al((size_t)2 * T * RW * 4);
constexpr size_t O_ICLR = O_KD + al((size_t)2 * T * RW * 4);
constexpr size_t O_GATE = O_ICLR + al((size_t)2 * T * RW * 4);
constexpr size_t O_BONUS = O_GATE + al((size_t)T * RW * 4);
constexpr size_t O_SCAN = O_BONUS + al((size_t)T * RH * 4);
constexpr size_t O_MQ = O_SCAN + al((size_t)2 * T * RW * 4);
constexpr size_t O_MK = O_MQ + al((size_t)T * MW * 4);
constexpr size_t O_IG = O_MK + al((size_t)T * MW * 4);
constexpr size_t O_LF = O_IG + al((size_t)2 * T * MH * 4);
constexpr size_t O_CL = O_LF + al((size_t)2 * T * MH * 4);
constexpr size_t O_NL = O_CL + al((size_t)2 * NB * MH * NCH * 4096 * 4);
constexpr size_t O_ML = O_NL + al((size_t)2 * NB * MH * NCH * 64 * 4);
constexpr size_t O_BL = O_ML + al((size_t)2 * NB * MH * NCH * 4);
constexpr size_t O_MIN = O_BL + al((size_t)2 * NB * MH * NCH * 4);
constexpr size_t O_TOPI = O_MIN + al((size_t)2 * NB * MH * NCH * 4);
constexpr size_t O_TOPG = O_TOPI + al((size_t)T * 4 * 4);
constexpr size_t O_RANK = O_TOPG + al((size_t)T * 4 * 4);
constexpr size_t O_SLOT = O_RANK + al((size_t)T * 4 * 4);
constexpr size_t O_MQB = O_SLOT + al((size_t)T * 4 * 4);
constexpr size_t O_MKB = O_MQB + al((size_t)T * MW * 2);
constexpr size_t O_KT = O_MKB + al((size_t)T * MW * 2);
constexpr size_t O_VT = O_KT + al((size_t)T * MW * 2);
constexpr size_t O_GVT = O_VT + al((size_t)T * MW * 2);
constexpr size_t O_PMX = O_GVT + al((size_t)2 * T * MH * 4);
constexpr size_t O_BCT = O_PMX + al((size_t)2 * T * MH * 4);
constexpr size_t O_BRKR = O_BCT + al((size_t)2 * T * MH * 4);
constexpr int RC = 64, RNC = S / RC, RUN = 2 * NB * RH * RNC;
constexpr size_t O_LW = O_BRKR + al((size_t)2 * T * RH * 2 * 4);
constexpr size_t O_RQ = O_LW + al((size_t)2 * T * RW * 4);
constexpr size_t O_RA = O_RQ + al((size_t)RUN * 4096 * 2);
constexpr size_t O_RS = O_RA + al((size_t)RUN * 4096 * 2);
constexpr size_t O_RH = O_RS + al((size_t)RUN * 4096 * 2);
constexpr size_t O_RG = O_RH + al((size_t)RUN * 4096 * 4);
constexpr size_t O_RB = O_RG + al((size_t)RUN * 4096 * 4);
constexpr size_t O_VB = O_RB + al((size_t)T * RW * 2);
constexpr size_t O_KKB = O_VB + al((size_t)T * RW * 2);
constexpr size_t O_BBB = O_KKB + al((size_t)T * RW * 2);
constexpr size_t O_KDB = O_BBB + al((size_t)2 * T * RW * 2);
constexpr size_t O_RK7 = O_KDB + al((size_t)2 * T * RW * 2);
constexpr size_t O_VNT = O_RK7 + al((size_t)T * RW * 16);
constexpr size_t O_WSB = O_VNT + al((size_t)T * GW * 2);
constexpr size_t O_LWT = O_WSB + al((size_t)NL * GH * CH * CH * 2);
constexpr size_t O_RWT = O_LWT + al((size_t)NL * 1920 * 128 * 2);
constexpr size_t O_BCNT = O_RWT + al((size_t)NL * 2 * NE * D * 2);
constexpr size_t O_CNTF = O_BCNT + al((size_t)(T / 64) * NE * 4);
constexpr size_t O_ROWT = O_CNTF + al((size_t)NE * 4);
constexpr size_t O_XS = O_ROWT + al((size_t)NROWS * 4);
constexpr size_t O_ACT = O_XS + al((size_t)NROWS * D * 2);
constexpr size_t O_YS = O_ACT + al((size_t)NROWS * DFF * 2);
constexpr size_t O_WIN = O_YS + al((size_t)NROWS * D * 2);
constexpr size_t O_WOUT = O_WIN + al((size_t)NL * PLD * D * 2);
constexpr size_t O_W1 = O_WOUT + al((size_t)NL * D * D * 2);
constexpr size_t O_W2 = O_W1 + al((size_t)NL * NE * 2 * DFF * D * 2);
constexpr size_t WS_END = O_W2 + al((size_t)NL * NE * D * DFF * 2);

constexpr int CW_BAR = 4096;
constexpr int CW_CNT = 16384;

struct Params { const float* in[32]; float* out; unsigned char* ws; int ph_lo, ph_hi; };
#ifdef EMU
typedef const Params* ParamsPtr;
#define PARAMS_PTR(P) (&(P))
#else
typedef const __attribute__((address_space(4))) Params* ParamsPtr;
#define PARAMS_PTR(P) ((ParamsPtr)__builtin_amdgcn_kernarg_segment_ptr())
#endif

#ifdef EMU
#define WAVE_SYNC() emu_wave_barrier()
#define PIN_V(x) do {} while (0)
#define PIN_S(x) do {} while (0)
#else
#define WAVE_SYNC() __builtin_amdgcn_wave_barrier()
#define PIN_V(x) asm volatile("" : "+v"(x))
#define PIN_S(x) asm volatile("" : "+s"(x))
#endif
#ifdef EMU
__device__ __forceinline__ int phase_tid(int wv) { (void)wv; return threadIdx.x; }
#else
__device__ __forceinline__ int phase_tid(int wv) { int t; asm volatile("v_mbcnt_lo_u32_b32 %0, -1, 0\n\tv_mbcnt_hi_u32_b32 %0, -1, %0" : "=v"(t)); return (wv << 6) + t; }
#endif

#ifdef EMU
#define SHX(v, m, lane) __shfl_xor(v, m)
#else
__device__ __forceinline__ float shx_(float v, int m, int lane) { return __builtin_bit_cast(float, __builtin_amdgcn_ds_bpermute((lane ^ m) << 2, __builtin_bit_cast(int, v))); }
__device__ __forceinline__ int shx_(int v, int m, int lane) { return __builtin_amdgcn_ds_bpermute((lane ^ m) << 2, v); }
#define SHX(v, m, lane) shx_(v, m, lane)
#endif
#ifdef EMU
#define SHUP(v, o, lane) __shfl(v, ((lane) - (o)) & 63)
#define RDL(v, src) __shfl(v, src)
#define SHL(v, src) __shfl(v, src)
#else
#define SHL(v, src) __builtin_bit_cast(float, __builtin_amdgcn_ds_bpermute((src) << 2, __builtin_bit_cast(int, (float)(v))))
#define SHUP(v, o, lane) __builtin_bit_cast(float, __builtin_amdgcn_ds_bpermute((((lane) - (o)) & 63) << 2, __builtin_bit_cast(int, (float)(v))))
#define RDL(v, src) __builtin_bit_cast(float, __builtin_amdgcn_readlane(__builtin_bit_cast(int, (float)(v)), src))
#endif
__device__ __forceinline__ float wave_sum(float v, int lane) {
#pragma unroll
    for (int o = 32; o >= 1; o >>= 1) v += SHX(v, o, lane);
    return v;
}
#ifdef EMU
__device__ __forceinline__ float fexp(float x) { return expf(x); }
__device__ __forceinline__ float flog(float x) { return logf(x); }
__device__ __forceinline__ float frcp(float x) { return 1.0f / x; }
#else
__device__ __forceinline__ float fexp(float x) { return __builtin_amdgcn_exp2f(x * 1.4426950408889634f); }
__device__ __forceinline__ float flog(float x) { return __builtin_amdgcn_logf(x) * 0.6931471805599453f; }
__device__ __forceinline__ float frcp(float x) { return __builtin_amdgcn_rcpf(x); }
#endif
__device__ __forceinline__ float sigmoidf_(float x) { return frcp(1.0f + fexp(-x)); }
__device__ __forceinline__ float softplusf_(float x) { return fmaxf(x, 0.f) + flog(1.0f + fexp(-fabsf(x))); }
__device__ __forceinline__ float ftanh(float x) { return 1.0f - 2.0f * frcp(1.0f + fexp(2.0f * x)); }
__device__ __forceinline__ float geluf_(float v) {
    const float av = fabsf(v), t = frcp(1.0f + 0.2316418882f * av);
    float q = t * 0.5307027145f + (-0.7265760135f); q = q * t + 0.7107068705f; q = q * t + (-0.142248368f); q = q * t + 0.127414796f; q = q * t;
    const float m = v * (q * fexp(-0.5f * v * v));
    return v < 0.f ? m : v - m;
}

#ifdef EMU
#define LAS
#define WAIT_V(n) do {} while (0)
#define WAIT_L(n) do {} while (0)
#define S_BARRIER() __syncthreads()
#define SETPRIO(x) do {} while (0)
#define SCHED_BAR() do {} while (0)
#define RFL(x) (x)
static inline void emu_glds16(const void* g, void* l) { memcpy((char*)l + (g_blk->cur & 63) * 16, g, 16); }
#define GLDS16(gptr, ldsptr) emu_glds16((const void*)(gptr), (void*)(ldsptr))
static inline float emu_bf2f(unsigned short b) { unsigned u = (unsigned)b << 16; float f; memcpy(&f, &u, 4); return f; }
static inline f32x4 emu_mfma16(bf16x8 a, bf16x8 b, f32x4 c) {
    EmuBlock* blk = g_blk; const int cur = blk->cur, lane = cur & 63, wbase = cur & ~63;
    static thread_local unsigned short Ash[32][64][8], Bsh[32][64][8];
    const int w = cur >> 6;
    for (int j = 0; j < 8; ++j) { Ash[w][lane][j] = (unsigned short)a[j]; Bsh[w][lane][j] = (unsigned short)b[j]; }
    emu_wave_barrier();
    const int col = lane & 15;
    for (int r = 0; r < 4; ++r) { const int row = 4 * (lane >> 4) + r; float sum = c[r];
        for (int k = 0; k < 32; ++k) sum += emu_bf2f(Ash[w][row + 16 * (k >> 3)][k & 7]) * emu_bf2f(Bsh[w][col + 16 * (k >> 3)][k & 7]);
        c[r] = sum; }
    emu_wave_barrier(); (void)wbase;
    return c;
}
#define MFMA16(a, b, c) emu_mfma16(a, b, c)
#else
#define LAS __attribute__((address_space(3)))
#define WAIT_V(n) asm volatile("s_waitcnt vmcnt(" #n ")" ::: "memory")
#define WAIT_L(n) asm volatile("s_waitcnt lgkmcnt(" #n ")" ::: "memory")
#define S_BARRIER() __builtin_amdgcn_s_barrier()
#define SETPRIO(x) __builtin_amdgcn_s_setprio(x)
#define SCHED_BAR() __builtin_amdgcn_sched_barrier(0)
#define RFL(x) __builtin_amdgcn_readfirstlane(x)
#define GLDS16(gptr, ldsptr) __builtin_amdgcn_global_load_lds((const unsigned*)(gptr), (LAS unsigned*)(ldsptr), 16, 0, 0)
#define MFMA16(a, b, c) __builtin_amdgcn_mfma_f32_16x16x32_bf16(a, b, c, 0, 0, 0)
#endif

#ifdef EMU
__device__ __forceinline__ unsigned f2bf(float f) { unsigned u = __builtin_bit_cast(unsigned, f); return (u + 0x7fffu + ((u >> 16) & 1u)) >> 16; }
#else
__device__ __forceinline__ unsigned f2bf(float f) { return (unsigned)__builtin_bit_cast(unsigned short, (__bf16)f); }
#endif
#ifdef EMU
__device__ __forceinline__ unsigned pk2(float lo, float hi) { return f2bf(lo) | (f2bf(hi) << 16); }
#else
typedef float f32x2c __attribute__((ext_vector_type(2)));
typedef __bf16 bf16x2c __attribute__((ext_vector_type(2)));
__device__ __forceinline__ unsigned pk2(float lo, float hi) { const f32x2c v = {lo, hi}; return __builtin_bit_cast(unsigned, __builtin_convertvector(v, bf16x2c)); }
#endif
__device__ __forceinline__ bf16x8 cvt8(const f32x4 a, const f32x4 b) {
    u32x4 w; w.x = pk2(a.x, a.y); w.y = pk2(a.z, a.w); w.z = pk2(b.x, b.y); w.w = pk2(b.z, b.w); return __builtin_bit_cast(bf16x8, w);
}
__device__ __forceinline__ float bf_lo(unsigned u) { return __builtin_bit_cast(float, u << 16); }
__device__ __forceinline__ float bf_hi(unsigned u) { return __builtin_bit_cast(float, u & 0xffff0000u); }

namespace pg8 {
constexpr int BM = 256, BK = 64, HALF = 128, HTB = HALF * BK * 2, STAGE_BYTES = 8 * HTB, NXCD = 8, WGM = 8;
__host__ __device__ __forceinline__ int lds_byte(int r, int c) { const int st = (r >> 4) * 2 + (c >> 5), rr = r & 15, cc = c & 31, ob = rr * 64 + cc * 2; return st * 1024 + (ob ^ (((ob >> 9) & 1) << 5)); }
__host__ __device__ __forceinline__ void stage_rc(int b, int& R, int& C) { const int st = b / 1024, sb = b % 1024, swz = sb ^ (((sb >> 9) & 1) << 5); R = (st >> 1) * 16 + swz / 64; C = (st & 1) * 32 + (swz % 64) / 2; }
__host__ __device__ __forceinline__ int perm32(int rho) { const int n = rho >> 4, i = rho & 15; return 8 * (i >> 2) + 4 * n + (i & 3); }
struct Unit { int pm, pn, e; };

struct DenseOrder {
    static constexpr bool GATHER = false;
    const char* A; const char* Bt; int K; int nM, nN, nwg, G, c;
    __device__ __forceinline__ void init(const void* A_, const void* Bt_, int M, int N, int K_, int G_, int c_) { A = (const char*)A_; Bt = (const char*)Bt_; K = K_; nM = M / BM; nN = N / BM; nwg = nM * nN; G = G_; c = c_; }
    __device__ __forceinline__ bool next(int i, Unit& u) const {
        const long L = (long)i * G + c; if (L >= nwg) return false;
        int wgid = (int)L; { const int q = nwg / NXCD, r = nwg % NXCD, xcd = wgid % NXCD, off = wgid / NXCD; wgid = (xcd < r ? xcd * (q + 1) : r * (q + 1) + (xcd - r) * q) + off; }
        const int nig = WGM * nN, gid = wgid / nig, fm = gid * WGM, gsz = (nM - fm) < WGM ? (nM - fm) : WGM;
        u.pm = fm + ((wgid % nig) % gsz); u.pn = (wgid % nig) / gsz; u.e = 0; return true;
    }
    __device__ __forceinline__ const char* abase(const Unit& u) const { return A + (size_t)u.pm * BM * K * 2; }
    __device__ __forceinline__ const char* bbase(const Unit& u) const { return Bt + (size_t)u.pn * BM * K * 2; }
};
template <bool G>
struct MoeOrderT {
    static constexpr bool GATHER = G;
    const char* A; const char* Wt; int K; int nN, nwg, G_, c; size_t estride; const int* rbe; const int* rowmap;
    __device__ __forceinline__ bool next(int i, Unit& u) const {
        const long L = (long)i * G_ + c; if (L >= nwg) return false;
        u.pm = (int)(L / nN); u.pn = (int)(L % nN); u.e = rbe[u.pm]; return true;
    }
    __device__ __forceinline__ const char* abase(const Unit& u) const { return G ? A : A + (size_t)u.pm * BM * K * 2; }
    __device__ __forceinline__ const char* bbase(const Unit& u) const { return Wt + (size_t)u.e * estride + (size_t)u.pn * BM * K * 2; }
};
struct EpiF32 {
    static constexpr bool PERM = false;
    float* C; int ldc;
    __device__ __forceinline__ void operator()(const f32x4 (&acc)[2][2][4][2], const Unit& u, int wr, int wc, int fr, int fq) const {
        const int row0 = u.pm * BM + wr * 64 + fr, col0 = u.pn * BM + wc * 32 + 4 * fq;
#pragma unroll
        for (int ai = 0; ai < 2; ++ai)
#pragma unroll
            for (int m = 0; m < 4; ++m) { float* rowp = C + (size_t)(row0 + ai * HALF + m * 16) * ldc + col0;
#pragma unroll
                for (int bj = 0; bj < 2; ++bj)
#pragma unroll
                    for (int n = 0; n < 2; ++n) *(f32x4*)(rowp + bj * HALF + n * 16) = acc[ai][bj][m][n]; }
    }
};
struct EpiProj {
    static constexpr bool PERM = true;
    bf16_t* O; int ldc; float* G; int lastt;
    __device__ __forceinline__ void operator()(const f32x4 (&acc)[2][2][4][2], const Unit& u, int wr, int wc, int fr, int fq) const {
        const int row0 = u.pm * BM + wr * 64 + fr, col0 = u.pn * BM + wc * 32 + 8 * fq;
#pragma unroll
        for (int ai = 0; ai < 2; ++ai)
#pragma unroll
            for (int m = 0; m < 4; ++m) { bf16_t* rowp = O + (size_t)(row0 + ai * HALF + m * 16) * ldc + col0;
#pragma unroll
                for (int bj = 0; bj < 2; ++bj) { const f32x4 v0 = acc[ai][bj][m][0], v1 = acc[ai][bj][m][1];
                    u32x4 w; w.x = pk2(v0[0], v0[1]); w.y = pk2(v0[2], v0[3]); w.z = pk2(v1[0], v1[1]); w.w = pk2(v1[2], v1[3]);
                    *(u32x4*)(rowp + bj * HALF) = w; } }
        if (u.pn == lastt) {
#pragma unroll
            for (int ai = 0; ai < 2; ++ai)
#pragma unroll
                for (int m = 0; m < 4; ++m) { float* rowp = G + (size_t)(row0 + ai * HALF + m * 16) * BM + wc * 32 + 8 * fq;
#pragma unroll
                    for (int bj = 0; bj < 2; ++bj) { *(f32x4*)(rowp + bj * HALF) = acc[ai][bj][m][0]; *(f32x4*)(rowp + bj * HALF + 4) = acc[ai][bj][m][1]; } }
        }
    }
};
struct EpiBf16Bias {
    static constexpr bool PERM = true;
    bf16_t* O; int ldc; const float* bias; int bias_estride;
    __device__ __forceinline__ void operator()(const f32x4 (&acc)[2][2][4][2], const Unit& u, int wr, int wc, int fr, int fq) const {
        const int row0 = u.pm * BM + wr * 64 + fr, col0 = u.pn * BM + wc * 32 + 8 * fq;
        const float* bp = bias + (size_t)u.e * bias_estride + col0;
        f32x4 bv[2][2];
#pragma unroll
        for (int bj = 0; bj < 2; ++bj)
#pragma unroll
            for (int n = 0; n < 2; ++n) bv[bj][n] = *(const f32x4*)(bp + bj * HALF + 4 * n);
#pragma unroll
        for (int ai = 0; ai < 2; ++ai)
#pragma unroll
            for (int m = 0; m < 4; ++m) { bf16_t* rowp = O + (size_t)(row0 + ai * HALF + m * 16) * ldc + col0;
#pragma unroll
                for (int bj = 0; bj < 2; ++bj) { const f32x4 v0 = acc[ai][bj][m][0] + bv[bj][0], v1 = acc[ai][bj][m][1] + bv[bj][1];
                    u32x4 w; w.x = pk2(v0[0], v0[1]); w.y = pk2(v0[2], v0[3]); w.z = pk2(v1[0], v1[1]); w.w = pk2(v1[2], v1[3]);
                    *(u32x4*)(rowp + bj * HALF) = w; } }
    }
};
__device__ __forceinline__ float swiglu1(float g, float uu) { g = fminf(g, 7.0f); uu = fminf(fmaxf(uu, -7.0f), 7.0f); return (uu + 1.0f) * (g * frcp(1.0f + fexp(-1.702f * g))); }
struct EpiSwiglu {
    static constexpr bool PERM = true;
    bf16_t* O; const float* b1;
    __device__ __forceinline__ void operator()(const f32x4 (&acc)[2][2][4][2], const Unit& u, int wr, int wc, int fr, int fq) const {
        const int row0 = u.pm * BM + wr * 64 + fr, j0 = u.pn * HALF + wc * 32 + 8 * fq;
        const float* bg = b1 + (size_t)u.e * 2 * DFF + j0; const float* bu = bg + DFF;
        f32x4 g4[2], u4[2];
#pragma unroll
        for (int n = 0; n < 2; ++n) { g4[n] = *(const f32x4*)(bg + 4 * n); u4[n] = *(const f32x4*)(bu + 4 * n); }
#pragma unroll
        for (int ai = 0; ai < 2; ++ai)
#pragma unroll
            for (int m = 0; m < 4; ++m) {
                float o[8];
#pragma unroll
                for (int n = 0; n < 2; ++n)
#pragma unroll
                    for (int q = 0; q < 4; ++q) o[n * 4 + q] = swiglu1(acc[ai][0][m][n][q] + g4[n][q], acc[ai][1][m][n][q] + u4[n][q]);
                u32x4 w; w.x = pk2(o[0], o[1]); w.y = pk2(o[2], o[3]); w.z = pk2(o[4], o[5]); w.w = pk2(o[6], o[7]);
                *(u32x4*)(O + (size_t)(row0 + ai * HALF + m * 16) * DFF + j0) = w;
            }
    }
};

struct MoeMerged {
    static constexpr bool GATHER = true;
    const char* A1; const char* A2; const char* W1t; const char* W2t; int K; int nrb, G_, c; size_t es1, es2; const int* rbe; const int* rowmap; unsigned* cnt;
    __device__ __forceinline__ bool next(int i, Unit& u) const {
        const int pc = (G_ & 7) == 0 ? (c & 7) * (G_ >> 3) + (c >> 3) : c;
        const long L = (long)i * G_ + pc; const long n1 = (long)nrb * 8;
        if (L < n1) { u.pm = (int)(L >> 3); u.pn = (int)(L & 7); }
        else { const long L2 = L - n1; if (L2 >= (long)nrb * 4) return false; u.pm = (int)(L2 >> 2); u.pn = 8 + (int)(L2 & 3); }
        u.e = rbe[u.pm]; return true;
    }
    __device__ __forceinline__ const char* abase(const Unit& u) const { return u.pn < 8 ? A1 : A2; }
    __device__ __forceinline__ const char* bbase(const Unit& u) const { return u.pn < 8 ? W1t + (size_t)u.e * es1 + (size_t)u.pn * BM * K * 2 : W2t + (size_t)u.e * es2 + (size_t)(u.pn - 8) * BM * K * 2; }
    __device__ __forceinline__ unsigned arow(const Unit& u, int r) const { return u.pn < 8 ? (unsigned)rowmap[u.pm * BM + r] : (unsigned)(u.pm * BM + r); }
    __device__ __forceinline__ void a_ready_wg(const Unit& u, int wid) const {
        if (u.pn < 8) return;
#ifdef EMU
        while (__atomic_load_n(&cnt[u.pm], __ATOMIC_ACQUIRE) < 8u) emu_yield_os();
        __syncthreads();
#else
        if (wid == 0) {
            unsigned sp = 0;
            while ((unsigned)__builtin_amdgcn_readfirstlane(__hip_atomic_load(&cnt[u.pm], __ATOMIC_RELAXED, __HIP_MEMORY_SCOPE_AGENT)) < 8u) { __builtin_amdgcn_s_sleep(1); if (++sp > (1u << 24)) break; }
            __builtin_amdgcn_fence(__ATOMIC_ACQUIRE, "agent");
            asm volatile("s_waitcnt vmcnt(0)" ::: "memory");
        }
        __builtin_amdgcn_s_barrier();
#endif
    }
    __device__ __forceinline__ void publish(int pm) const {
#ifdef EMU
        __atomic_fetch_add(&cnt[pm], 1u, __ATOMIC_RELEASE);
#else
        __hip_atomic_fetch_add(&cnt[pm], 1u, __ATOMIC_RELAXED, __HIP_MEMORY_SCOPE_AGENT);
#endif
    }
};
struct EpiMoe {
    static constexpr bool PERM = true;
    bf16_t* ACT; const float* b1; bf16_t* YS; const float* b2; unsigned act_bytes;
    __device__ __forceinline__ void operator()(const f32x4 (&acc)[2][2][4][2], const Unit& u, int wr, int wc, int fr, int fq) const {
        if (u.pn < 8) {
            const int row0 = u.pm * BM + wr * 64 + fr, j0 = u.pn * HALF + wc * 32 + 8 * fq;
            const float* bg = b1 + (size_t)u.e * 2 * DFF + j0; const float* bu = bg + DFF;
            f32x4 g4[2], u4[2];
#pragma unroll
            for (int n = 0; n < 2; ++n) { g4[n] = *(const f32x4*)(bg + 4 * n); u4[n] = *(const f32x4*)(bu + 4 * n); }
#ifndef EMU
            const __amdgpu_buffer_rsrc_t rs = __builtin_amdgcn_make_buffer_rsrc((void*)ACT, 0, (int)act_bytes, 0x00020000);
#endif
#pragma unroll
            for (int ai = 0; ai < 2; ++ai)
#pragma unroll
                for (int m = 0; m < 4; ++m) {
                    float o[8];
#pragma unroll
                    for (int n = 0; n < 2; ++n)
#pragma unroll
                        for (int q = 0; q < 4; ++q) o[n * 4 + q] = swiglu1(acc[ai][0][m][n][q] + g4[n][q], acc[ai][1][m][n][q] + u4[n][q]);
                    u32x4 w; w.x = pk2(o[0], o[1]); w.y = pk2(o[2], o[3]); w.z = pk2(o[4], o[5]); w.w = pk2(o[6], o[7]);
                    const unsigned eo = (unsigned)(row0 + ai * HALF + m * 16) * (unsigned)DFF + (unsigned)j0;
#ifdef EMU
                    *(u32x4*)(ACT + eo) = w;
#else
                    __builtin_amdgcn_raw_buffer_store_b128(w, rs, eo * 2u, 0,   16);
#endif
                }
        } else {
            const int row0 = u.pm * BM + wr * 64 + fr, col0 = (u.pn - 8) * BM + wc * 32 + 8 * fq;
            const float* bp = b2 + (size_t)u.e * D + col0;
            f32x4 bv[2][2];
#pragma unroll
            for (int bj = 0; bj < 2; ++bj)
#pragma unroll
                for (int n = 0; n < 2; ++n) bv[bj][n] = *(const f32x4*)(bp + bj * HALF + 4 * n);
#pragma unroll
            for (int ai = 0; ai < 2; ++ai)
#pragma unroll
                for (int m = 0; m < 4; ++m) { bf16_t* rowp = YS + (size_t)(row0 + ai * HALF + m * 16) * D + col0;
#pragma unroll
                    for (int bj = 0; bj < 2; ++bj) { const f32x4 v0 = acc[ai][bj][m][0] + bv[bj][0], v1 = acc[ai][bj][m][1] + bv[bj][1];
                        u32x4 w; w.x = pk2(v0[0], v0[1]); w.y = pk2(v0[2], v0[3]); w.z = pk2(v1[0], v1[1]); w.w = pk2(v1[2], v1[3]);
                        *(u32x4*)(rowp + bj * HALF) = w; } }
        }
    }
};
template <class S_> struct has_handoff { static constexpr bool value = false; };
template <> struct has_handoff<MoeMerged> { static constexpr bool value = true; };

template <class Epi, class Sched, bool SP2 = (MK_SP2 != 0)>
__device__ __forceinline__ void gemm_phase(LAS unsigned char* lds, const int K, const Sched& S, const Epi& E, const int tid) {
    const int wid = RFL(tid >> 6), lane = tid & 63, wr = wid >> 2, wc = wid & 3, fr = lane & 15, fq = lane >> 4;
    const int nt = K / BK;
    unsigned voffA[2], voffB[2]; int gR[2]; unsigned gC[2];
#pragma unroll
    for (int i = 0; i < 2; ++i) { int R, C; stage_rc(tid * 16 + i * 8192, R, C); const int Rb = Epi::PERM ? ((R & ~31) + perm32(R & 31)) : R;
        voffA[i] = (unsigned)(R * K + C) * 2u; voffB[i] = (unsigned)(Rb * K + C) * 2u; gR[i] = R; gC[i] = (unsigned)C * 2u; }
    unsigned va[2][2], vn[2][2];
#define PG8_GOFF(dst, unit) do { if constexpr (Sched::GATHER) { _Pragma("unroll") for (int h_ = 0; h_ < 2; ++h_) _Pragma("unroll") for (int i_ = 0; i_ < 2; ++i_) { \
        if constexpr (has_handoff<Sched>::value) dst[h_][i_] = S.arow(unit, h_ * HALF + gR[i_]) * (unsigned)(K * 2) + gC[i_]; \
        else dst[h_][i_] = (unsigned)S.rowmap[(unit).pm * BM + h_ * HALF + gR[i_]] * (unsigned)(K * 2) + gC[i_]; } } } while (0)
#define PG8_STAGE_A(bufoff, bp, kb, h, nx) do { if constexpr (Sched::GATHER) { const char* gb_ = ((nx) ? nA : cA) + (kb); _Pragma("unroll") for (int _i = 0; _i < 2; ++_i) \
        GLDS16(gb_ + ((nx) ? vn[h][_i] : va[h][_i]), lds + (bufoff) + ldsw + _i * 8192); } else { PG8_STAGE(bufoff, bp, voffA); } } while (0)
    const size_t kstep = (size_t)(BK * 2);
    const size_t hstep = (size_t)HALF * K * 2;
    const unsigned ldsw = (unsigned)wid * 1024u;
    const int aoff = lds_byte(wr * 64 + fr, fq * 8), boff = lds_byte(wc * 32 + fr, fq * 8);
#define PG8_SA(b, h) (((b) * 2 + (h)) * HTB)
#define PG8_SB(b, h) ((4 + (b) * 2 + (h)) * HTB)
#define PG8_STAGE(bufoff, gbase, voff) do { _Pragma("unroll") for (int _i = 0; _i < 2; ++_i) \
        GLDS16((const char*)(gbase) + (voff)[_i], lds + (bufoff) + ldsw + _i * 8192); } while (0)
#define PG8_LDA(dst, b, h) do { _Pragma("unroll") for (int m = 0; m < 4; ++m) _Pragma("unroll") for (int k = 0; k < 2; ++k) dst[m][k] = *(const LAS bf16x8*)(lds + PG8_SA(b, h) + aoff + m * 2048 + k * 1024); } while (0)
#define PG8_LDB(dst, b, h) do { _Pragma("unroll") for (int n = 0; n < 2; ++n) _Pragma("unroll") for (int k = 0; k < 2; ++k) dst[n][k] = *(const LAS bf16x8*)(lds + PG8_SB(b, h) + boff + n * 2048 + k * 1024); } while (0)
#define PG8_MMA(ai, bj, At, Bt) do { SETPRIO(1); _Pragma("unroll") for (int m = 0; m < 4; ++m) _Pragma("unroll") for (int n = 0; n < 2; ++n) _Pragma("unroll") for (int k = 0; k < 2; ++k) \
        acc[ai][bj][m][n] = MFMA16(Bt[n][k], At[m][k], acc[ai][bj][m][n]); SETPRIO(0); } while (0)
    Unit cur, nxt; int ui = 0;
    if (!S.next(0, cur)) return;
    f32x4 acc[2][2][4][2];
#pragma unroll
    for (int a = 0; a < 2; ++a)
#pragma unroll
        for (int b = 0; b < 2; ++b)
#pragma unroll
            for (int m = 0; m < 4; ++m)
#pragma unroll
                for (int n = 0; n < 2; ++n) acc[a][b][m][n] = (f32x4){0.f, 0.f, 0.f, 0.f};
    bf16x8 At[4][2], B0[2][2], B1[2][2];
    const char* cA = S.abase(cur); const char* cB = S.bbase(cur);
    const char* nA = cA;
    int pub_pm = -1;
    if constexpr (has_handoff<Sched>::value) S.a_ready_wg(cur, wid);
    PG8_GOFF(va, cur);
    if constexpr (SP2) {
        PG8_STAGE(PG8_SB(0, 0), cB, voffB); PG8_STAGE(PG8_SB(0, 1), cB + hstep, voffB); PG8_STAGE_A(PG8_SA(0, 0), cA, 0, 0, false); PG8_STAGE_A(PG8_SA(0, 1), cA + hstep, 0, 1, false);
        if (wr == 1) S_BARRIER();
        WAIT_V(2); S_BARRIER();
        PG8_STAGE(PG8_SB(1, 0), cB + kstep, voffB); PG8_STAGE_A(PG8_SA(1, 0), cA + kstep, kstep, 0, false); PG8_STAGE(PG8_SB(1, 1), cB + hstep + kstep, voffB);
        WAIT_V(6); S_BARRIER();
    } else {
    PG8_STAGE(PG8_SB(0, 0), cB, voffB); PG8_STAGE_A(PG8_SA(0, 0), cA, 0, 0, false); PG8_STAGE(PG8_SB(0, 1), cB + hstep, voffB); PG8_STAGE_A(PG8_SA(0, 1), cA + hstep, 0, 1, false);
    if (wr == 1) S_BARRIER();
    WAIT_V(4); S_BARRIER();
    PG8_STAGE(PG8_SB(1, 0), cB + kstep, voffB); PG8_STAGE_A(PG8_SA(1, 0), cA + kstep, kstep, 0, false); PG8_STAGE(PG8_SB(1, 1), cB + hstep + kstep, voffB);
    WAIT_V(6); S_BARRIER();
    }
    for (;;) {
        const bool has_next = S.next(ui + 1, nxt);
        const char* nA = has_next ? S.abase(nxt) : cA; const char* nB = has_next ? S.bbase(nxt) : cB;
        if constexpr (has_handoff<Sched>::value) { if (has_next) S.a_ready_wg(nxt, wid); }
        if constexpr (Sched::GATHER) { if (has_next) { PG8_GOFF(vn, nxt); } else {
#pragma unroll
            for (int h_ = 0; h_ < 2; ++h_) { vn[h_][0] = va[h_][0]; vn[h_][1] = va[h_][1]; } } }
        for (int t = 0; t < nt; t += 2) {
            const bool last = (t == nt - 2);
            if constexpr (has_handoff<Sched>::value) {
                if (t == 4 && pub_pm >= 0) { if (tid == 0) S.publish(pub_pm); pub_pm = -1; } }
            const char* a1 = cA + (size_t)(t + 1) * kstep;
            const char* a2 = last ? nA : cA + (size_t)(t + 2) * kstep; const char* b2 = last ? nB : cB + (size_t)(t + 2) * kstep;
            const char* a3 = a2 + kstep; const char* b3 = b2 + kstep;
            if constexpr (SP2) {
            PG8_LDB(B0, 0, 0); PG8_LDB(B1, 0, 1); SCHED_BAR(); PG8_LDA(At, 0, 0); PG8_STAGE_A(PG8_SA(1, 1), a1 + hstep, (size_t)(t + 1) * kstep, 1, false);
            WAIT_V(8); WAIT_L(0); S_BARRIER(); PG8_MMA(0, 0, At, B0); PG8_MMA(0, 1, At, B1); S_BARRIER(); SCHED_BAR();
            PG8_LDA(At, 0, 1); PG8_STAGE(PG8_SB(0, 0), b2, voffB); PG8_STAGE(PG8_SB(0, 1), b2 + hstep, voffB); PG8_STAGE_A(PG8_SA(0, 0), a2, (last ? (size_t)0 : (size_t)(t + 2) * kstep), 0, last);
            WAIT_V(8); WAIT_L(0); S_BARRIER(); PG8_MMA(1, 0, At, B0); PG8_MMA(1, 1, At, B1); S_BARRIER(); SCHED_BAR();
            PG8_LDB(B0, 1, 0); PG8_LDB(B1, 1, 1); SCHED_BAR(); PG8_LDA(At, 1, 0); PG8_STAGE_A(PG8_SA(0, 1), a2 + hstep, (last ? (size_t)0 : (size_t)(t + 2) * kstep), 1, last);
            WAIT_V(8); WAIT_L(0); S_BARRIER(); PG8_MMA(0, 0, At, B0); PG8_MMA(0, 1, At, B1); S_BARRIER(); SCHED_BAR();
            PG8_LDA(At, 1, 1); PG8_STAGE(PG8_SB(1, 0), b3, voffB); PG8_STAGE(PG8_SB(1, 1), b3 + hstep, voffB); PG8_STAGE_A(PG8_SA(1, 0), a3, (last ? kstep : (size_t)(t + 3) * kstep), 0, last);
            WAIT_V(8); WAIT_L(0); S_BARRIER(); PG8_MMA(1, 0, At, B0); PG8_MMA(1, 1, At, B1); S_BARRIER(); SCHED_BAR();
            } else {
            PG8_LDB(B0, 0, 0); SCHED_BAR(); PG8_LDA(At, 0, 0); PG8_STAGE_A(PG8_SA(1, 1), a1 + hstep, (size_t)(t + 1) * kstep, 1, false);
            WAIT_L(8); S_BARRIER(); WAIT_L(0); PG8_MMA(0, 0, At, B0); S_BARRIER(); SCHED_BAR();
            PG8_LDB(B1, 0, 1); PG8_STAGE(PG8_SB(0, 0), b2, voffB);
            S_BARRIER(); WAIT_L(0); PG8_MMA(0, 1, At, B1); S_BARRIER();
            PG8_LDA(At, 0, 1); PG8_STAGE_A(PG8_SA(0, 0), a2, (last ? (size_t)0 : (size_t)(t + 2) * kstep), 0, last);
            S_BARRIER(); WAIT_L(0); PG8_MMA(1, 0, At, B0); S_BARRIER(); SCHED_BAR();
            PG8_STAGE(PG8_SB(0, 1), b2 + hstep, voffB);
            WAIT_V(6); S_BARRIER(); PG8_MMA(1, 1, At, B1); S_BARRIER();
            PG8_LDB(B0, 1, 0); SCHED_BAR(); PG8_LDA(At, 1, 0); PG8_STAGE_A(PG8_SA(0, 1), a2 + hstep, (last ? (size_t)0 : (size_t)(t + 2) * kstep), 1, last);
            WAIT_L(8); S_BARRIER(); WAIT_L(0); PG8_MMA(0, 0, At, B0); S_BARRIER(); SCHED_BAR();
            PG8_LDB(B1, 1, 1); PG8_STAGE(PG8_SB(1, 0), b3, voffB);
            S_BARRIER(); WAIT_L(0); PG8_MMA(0, 1, At, B1); S_BARRIER();
            PG8_LDA(At, 1, 1); PG8_STAGE_A(PG8_SA(1, 0), a3, (last ? kstep : (size_t)(t + 3) * kstep), 0, last);
            S_BARRIER(); WAIT_L(0); PG8_MMA(1, 0, At, B0); S_BARRIER(); SCHED_BAR();
            PG8_STAGE(PG8_SB(1, 1), b3 + hstep, voffB);
            WAIT_V(6); S_BARRIER(); PG8_MMA(1, 1, At, B1); S_BARRIER();
            }
        }
        if (wr == 0) S_BARRIER();
        E(acc, cur, wr, wc, fr, fq);
        if constexpr (has_handoff<Sched>::value) pub_pm = cur.pn < 8 ? cur.pm : -1;
        if (!has_next) break;
#pragma unroll
        for (int a = 0; a < 2; ++a)
#pragma unroll
            for (int b = 0; b < 2; ++b)
#pragma unroll
                for (int m = 0; m < 4; ++m)
#pragma unroll
                    for (int n = 0; n < 2; ++n) acc[a][b][m][n] = (f32x4){0.f, 0.f, 0.f, 0.f};
        cur = nxt; cA = nA; cB = nB; ++ui;
        if constexpr (Sched::GATHER) {
#pragma unroll
            for (int h_ = 0; h_ < 2; ++h_) { va[h_][0] = vn[h_][0]; va[h_][1] = vn[h_][1]; } }
        if (wr == 1) S_BARRIER();
    }
    WAIT_V(0);
    S_BARRIER();
    if constexpr (has_handoff<Sched>::value) { if (pub_pm >= 0 && tid == 0) S.publish(pub_pm); }
#undef PG8_SA
#undef PG8_SB
#undef PG8_STAGE
#undef PG8_STAGE_A
#undef PG8_GOFF
#undef PG8_LDA
#undef PG8_LDB
#undef PG8_MMA
}
}

__device__ __forceinline__ float row16_sum(float x) {
#ifdef EMU
    x += __shfl_xor(x, 1); x += __shfl_xor(x, 2); x += __shfl_xor(x, 4); x += __shfl_xor(x, 8); return x;
#else
#define DPPF(v, ctrl) __builtin_bit_cast(float, __builtin_amdgcn_update_dpp(0, __builtin_bit_cast(int, (v)), (ctrl), 0xF, 0xF, false))
    x += DPPF(x, 0xB1); x += DPPF(x, 0x4E); x += DPPF(x, 0x141); x += DPPF(x, 0x140); return x;
#undef DPPF
#endif
}
__device__ __forceinline__ float row32_sum(float x) {
    x = row16_sum(x);
#ifdef EMU
    x += __shfl_xor(x, 32); return x;
#else
    float a = x, b = x;
    asm volatile("s_nop 1\n\tv_permlane32_swap_b32 %0, %1" : "+v"(a), "+v"(b));
    return a + b;
#endif
}
__device__ __forceinline__ float wave_sum_fast(float x, int lane) {
    x = row32_sum(x);
    x += SHX(x, 16, lane);
    return x;
}
__device__ __forceinline__ void transpose_item(const float* W, int K, int N, bf16_t* WT, int k0, int n0, int dst_row0, float* scr, int lane) {
    const int n4 = (lane & 15) * 4, kr = lane >> 4;
#pragma unroll 8
    for (int i = 0; i < 16; ++i) {
        const int kk = 4 * i + kr;
        f32x4 v = (f32x4){0.f, 0.f, 0.f, 0.f};
        if (n0 + n4 < N) v = *(const f32x4*)(W + (size_t)(k0 + kk) * N + n0 + n4);
        float* d = scr + kk * 65 + n4; d[0] = v.x; d[1] = v.y; d[2] = v.z; d[3] = v.w;
    }
    WAVE_SYNC();
    const int c = lane & 7;
#pragma unroll
    for (int j = 0; j < 8; ++j) { const int n = (lane >> 3) + 8 * j; const float* sp = scr + (8 * c) * 65 + n;
        u32x4 o; o.x = pk2(sp[0 * 65], sp[1 * 65]); o.y = pk2(sp[2 * 65], sp[3 * 65]); o.z = pk2(sp[4 * 65], sp[5 * 65]); o.w = pk2(sp[6 * 65], sp[7 * 65]);
        *(u32x4*)(WT + (size_t)(dst_row0 + n) * K + k0 + 8 * c) = o; }
    WAVE_SYNC();
}
__device__ __forceinline__ void phase_prologue(const Params& P, unsigned char* smem, int wv) {
    ParamsPtr pp = PARAMS_PTR(P); PIN_S(pp); unsigned char* ws = pp->ws; int bidx = (int)blockIdx.x, gdim = (int)gridDim.x; PIN_S(bidx); PIN_S(gdim);
    const int tid = phase_tid(wv), lane = tid & 63, wave = tid >> 6;
    float* scr = (float*)smem + wave * (64 * 65);
    const int gw = bidx * NWAVES + wave, ngw = NWAVES * gdim;
    constexpr int I_IN = 16 * (PLD / 64), I_OUT = 16 * 16, I_W1 = NE * 16 * 32, I_W2 = NE * 16 * 16, I_L = I_IN + I_OUT + I_W1 + I_W2;
    for (int it = gw; it < NL * I_L; it += ngw) {
        const int l = it / I_L; int r = it % I_L;
        if (r < I_IN) { const int kb = r / (PLD / 64), nb = r % (PLD / 64);
            transpose_item(pp->in[1] + (size_t)l * D * PIN, D, PIN, (bf16_t*)(ws + O_WIN) + (size_t)l * PLD * D, kb * 64, nb * 64, nb * 64, scr, lane); continue; }
        r -= I_IN;
        if (r < I_OUT) { const int kb = r / 16, nb = r % 16;
            transpose_item(pp->in[21] + (size_t)l * D * D, D, D, (bf16_t*)(ws + O_WOUT) + (size_t)l * D * D, kb * 64, nb * 64, nb * 64, scr, lane); continue; }
        r -= I_OUT;
        if (r < I_W1) { const int e = r / (16 * 32), q = r % (16 * 32), kb = q / 32, nb = q % 32, n0 = nb * 64;
            const int dst = n0 < DFF ? (n0 / 128) * 256 + (n0 % 128) : ((n0 - DFF) / 128) * 256 + 128 + ((n0 - DFF) % 128);
            transpose_item(pp->in[26] + ((size_t)l * NE + e) * D * 2 * DFF, D, 2 * DFF, (bf16_t*)(ws + O_W1) + ((size_t)l * NE + e) * 2 * DFF * D, kb * 64, n0, dst, scr, lane); continue; }
        r -= I_W1;
        { const int e = r / (16 * 16), q = r % (16 * 16), kb = q / 16, nb = q % 16;
            transpose_item(pp->in[28] + ((size_t)l * NE + e) * DFF * D, DFF, D, (bf16_t*)(ws + O_W2) + ((size_t)l * NE + e) * D * DFF, kb * 64, nb * 64, nb * 64, scr, lane); }
    }
    {
        const float* gw_ = pp->in[4]; bf16_t* WSB = (bf16_t*)(ws + O_WSB);
        for (size_t i = ((size_t)bidx * NTHREADS + tid) * 4; i < (size_t)NL * GH * CH * CH; i += (size_t)gdim * NTHREADS * 4) {
            const f32x4 v = *(const f32x4*)(gw_ + i); u32x2 o; o.x = pk2(v.x, v.y); o.y = pk2(v.z, v.w); *(u32x2*)(WSB + i) = o;
        }
    }
    {
        bf16_t* LWT = (bf16_t*)(ws + O_LWT);
        for (int i = bidx * NTHREADS + tid; i < NL * 1920 * 128; i += gdim * NTHREADS) {
            const int k = i & 127, n = (i >> 7) % 1920, ll = i / (1920 * 128);
            float v = 0.f;
            if (n < 1536) { if (k < 64) { const int grp = n / 768, d = (n / 384) & 1, c = n % 384; v = (grp == 0 ? pp->in[8] : pp->in[10])[(((size_t)ll * 2 + d) * 64 + k) * RW + c]; } }
            else v = pp->in[11][((size_t)ll * 128 + k) * RW + (n - 1536)];
            LWT[i] = (bf16_t)f2bf(v);
        }
    }
    {
        bf16_t* RWT = (bf16_t*)(ws + O_RWT);
        for (int i = bidx * NTHREADS + tid; i < NL * NE * D; i += gdim * NTHREADS) {
            const int k = i % D, e = (i / D) % NE, ll = i / (D * NE);
            const float v = pp->in[24][((size_t)ll * D + k) * NE + e];
            const unsigned hi = f2bf(v); const float lo = v - bf_lo(hi);
            RWT[((size_t)(ll * 2 + 0) * NE + e) * D + k] = (bf16_t)hi; RWT[((size_t)(ll * 2 + 1) * NE + e) * D + k] = (bf16_t)f2bf(lo);
        }
    }
    const float* x = pp->in[0]; bf16_t* XB = (bf16_t*)(ws + O_XB);
    for (size_t i = ((size_t)bidx * NTHREADS + tid) * 4; i < (size_t)T * D; i += (size_t)gdim * NTHREADS * 4) {
        const f32x4 v = *(const f32x4*)(x + i); u32x2 o; o.x = pk2(v.x, v.y); o.y = pk2(v.z, v.w); *(u32x2*)(XB + i) = o;
    }
}

__device__ __forceinline__ float tshift(const float* P, int t, int s, int col, const float* mu0, const float* mu1, int rc) {
    const float cur = P[(size_t)t * PLD + col];
    const float prv = s > 0 ? P[(size_t)(t - 1) * PLD + col] : 0.f;
    const float nxt = s < S - 1 ? P[(size_t)(t + 1) * PLD + col] : 0.f;
    return cur + mu0[rc] * (prv - cur) + mu1[rc] * (nxt - cur);
}

__device__ __forceinline__ void phase_prep(const Params& P, int l, unsigned char* smem, int wv) {
    ParamsPtr pp = PARAMS_PTR(P); PIN_S(pp); unsigned char* ws = pp->ws; int bidx = (int)blockIdx.x, gdim = (int)gridDim.x; PIN_S(bidx); PIN_S(gdim);
    const bf16_t* proj = (const bf16_t*)(ws + O_PROJ); const float* projg = (const float*)(ws + O_PROJG);
    float* UG = (float*)(ws + O_UG); bf16_t* VNT = (bf16_t*)(ws + O_VNT);
    float* RR = (float*)(ws + O_RR); float* VV = (float*)(ws + O_VV); float* KK = (float*)(ws + O_KK);
    float* KD = (float*)(ws + O_KD); float* ICLR = (float*)(ws + O_ICLR);
    float* GATE = (float*)(ws + O_GATE); float* BONUS = (float*)(ws + O_BONUS); float* LWG = (float*)(ws + O_LW);
    bf16_t* RB = (bf16_t*)(ws + O_RB); bf16_t* VB = (bf16_t*)(ws + O_VB); bf16_t* KKB = (bf16_t*)(ws + O_KKB); bf16_t* BBB = (bf16_t*)(ws + O_BBB); bf16_t* KDB = (bf16_t*)(ws + O_KDB);
#if !MK_RWKV_CHUNKED
    float* DEC = (float*)(ws + O_DEC); float* BRKR = (float*)(ws + O_BRKR);
#endif
    bf16_t* MQB = (bf16_t*)(ws + O_MQB); bf16_t* MKB = (bf16_t*)(ws + O_MKB); bf16_t* KT = (bf16_t*)(ws + O_KT); bf16_t* VT = (bf16_t*)(ws + O_VT);
    float* IG = (float*)(ws + O_IG); float* LF = (float*)(ws + O_LF);
    const bf16_t* LWT = (const bf16_t*)(ws + O_LWT) + (size_t)l * 1920 * 128;
    const float* gln_g = pp->in[2] + (size_t)l * GW; const float* gln_b = pp->in[3] + (size_t)l * GW;
    const float* mu0 = pp->in[6] + (size_t)l * 2 * RPROJ; const float* mu1 = mu0 + RPROJ;
    const float* w0 = pp->in[7] + (size_t)l * 2 * RW; const float* a0 = pp->in[9] + (size_t)l * 2 * RW;
    const float* k_k = pp->in[12] + (size_t)l * RW; const float* k_a = pp->in[13] + (size_t)l * RW; const float* r_k = pp->in[14] + (size_t)l * RW;
    const float* conv_w = pp->in[17] + (size_t)l * 3 * 768; const float* conv_b = pp->in[18] + (size_t)l * 768; const float* gate_b = pp->in[19] + (size_t)l * 24;
    float* win = (float*)smem;
    bf16_t* lin = (bf16_t*)(smem + 101376);
    bf16_t* tvn = (bf16_t*)(smem + 110592);
    bf16_t* tk = (bf16_t*)(smem + 118784);
    bf16_t* tv = (bf16_t*)(smem + 131072);
    constexpr int LIN = 264;
    const int tid = phase_tid(wv), lane = tid & 63, wave = tid >> 6, col = lane & 15, g = lane >> 4;
    for (int u = bidx; u < T / 16; u += gdim) {
        const int t0 = u * 16, s0 = t0 % S, bb = t0 / S;
        __syncthreads();
        {
            u32x2 wb[18];
#pragma unroll
            for (int row = 0; row < 18; ++row) {
                const int sq = s0 - 1 + row;
                wb[row] = (u32x2){0u, 0u};
                if (sq >= 0 && sq < S && tid < 352) wb[row] = *(const u32x2*)(proj + (size_t)(t0 - 1 + row) * PLD + C_RW + tid * 4);
            }
            if (tid < 352) {
#pragma unroll
                for (int row = 0; row < 18; ++row) *(f32x4*)(win + row * RPROJ + tid * 4) = (f32x4){bf_lo(wb[row].x), bf_hi(wb[row].x), bf_lo(wb[row].y), bf_hi(wb[row].y)};
            }
        }
        for (int rep_ = 0; rep_ < (MK_PROBE == 3 ? 2 : 1); ++rep_) {
            const int i = tid >> 5, l32 = tid & 31, t = t0 + i;
            float v[8], ug[8]; float sum = 0.f;
#pragma unroll
            for (int j = 0; j < 8; ++j) { const int c = j * 32 + l32; ug[j] = bf_lo((unsigned)proj[(size_t)t * PLD + c]); v[j] = bf_lo((unsigned)proj[(size_t)t * PLD + GW + c]); }
#pragma unroll
            for (int j = 0; j < 8; ++j) { const int c = j * 32 + l32; UG[(size_t)t * GW + c] = geluf_(ug[j]); v[j] = geluf_(v[j]); sum += v[j]; }
#pragma unroll
            for (int o = 16; o >= 1; o >>= 1) sum += SHX(sum, o, lane);
            const float mean = sum * (1.0f / GW); float q = 0.f;
#pragma unroll
            for (int j = 0; j < 8; ++j) { const float d = v[j] - mean; q += d * d; }
#pragma unroll
            for (int o = 16; o >= 1; o >>= 1) q += SHX(q, o, lane);
            const float rstd = 1.0f / sqrtf(q * (1.0f / GW) + LN_EPS);
#pragma unroll
            for (int j = 0; j < 8; ++j) { const int c = j * 32 + l32; tvn[c * 16 + i] = (bf16_t)f2bf((v[j] - mean) * rstd * gln_g[c] + gln_b[c]); }
        }
        __syncthreads();
        {
            const int hf = tid & 1, c = tid >> 1;
            *(u32x4*)(VNT + ((size_t)bb * GW + c) * S + s0 + hf * 8) = *(const u32x4*)(tvn + c * 16 + hf * 8);
        }
        for (int idx = tid; idx < 16 * 256; idx += NTHREADS) {
            const int i = idx >> 8, j = idx & 255, rc = 1152 + j;
            const float pv = win[i * RPROJ + rc], cv = win[(i + 1) * RPROJ + rc], nv = win[(i + 2) * RPROJ + rc];
            const float x = cv + mu0[rc] * (pv - cv) + mu1[rc] * (nv - cv);
            lin[i * LIN + j] = (bf16_t)f2bf(j < 64 ? ftanh(x) : (j < 128 ? x : sigmoidf_(x)));
        }
        __syncthreads();
        for (int rep_ = 0; rep_ < (MK_PROBE == 1 ? 2 : 1); ++rep_) {
#pragma unroll 1
            for (int qg = 0; qg < 3; ++qg) {
                bf16x8 bw_[5][4]; float bias_[5];
#pragma unroll
                for (int q5 = 0; q5 < 5; ++q5) {
                    const int nt = wave * 15 + qg * 5 + q5, grp = nt / 24, c = (nt % 24) * 16 + col;
                    const bf16_t* bw = LWT + (size_t)(nt * 16 + col) * 128 + 8 * g;
#pragma unroll
                    for (int ks = 0; ks < 2; ++ks) bw_[q5][ks] = *(const bf16x8*)(bw + ks * 32);
                    if (grp == 4) {
#pragma unroll
                        for (int ks = 2; ks < 4; ++ks) bw_[q5][ks] = *(const bf16x8*)(bw + ks * 32);
                    }
                    bias_[q5] = grp < 2 ? w0[grp * RW + c] : (grp < 4 ? a0[(grp - 2) * RW + c] : 0.f);
                }
#pragma unroll
                for (int q5 = 0; q5 < 5; ++q5) {
                    const int nt = wave * 15 + qg * 5 + q5, grp = nt / 24, c = (nt % 24) * 16 + col;
                    const int kcol = grp < 2 ? 0 : (grp < 4 ? 64 : 128);
                    f32x4 acc = (f32x4){0.f, 0.f, 0.f, 0.f};
#pragma unroll
                    for (int ks = 0; ks < 2; ++ks) acc = MFMA16(*(const bf16x8*)(lin + col * LIN + kcol + ks * 32 + 8 * g), bw_[q5][ks], acc);
                    if (grp == 4) {
#pragma unroll
                        for (int ks = 2; ks < 4; ++ks) acc = MFMA16(*(const bf16x8*)(lin + col * LIN + kcol + ks * 32 + 8 * g), bw_[q5][ks], acc);
                    }
                    if (grp < 2) {
#pragma unroll
                        for (int r = 0; r < 4; ++r) { const float lw = -fexp(-softplusf_(-(acc[r] + bias_[q5])) - 0.5f); const size_t o = (size_t)grp * T * RW + (size_t)(t0 + 4 * g + r) * RW + c; LWG[o] = lw;
#if !MK_RWKV_CHUNKED
                            DEC[o] = expf(lw);
#endif
                        }
                    } else if (grp < 4) {
#pragma unroll
                        for (int r = 0; r < 4; ++r) ICLR[(size_t)(grp - 2) * T * RW + (size_t)(t0 + 4 * g + r) * RW + c] = sigmoidf_(acc[r] + bias_[q5]);
                    } else {
#pragma unroll
                        for (int r = 0; r < 4; ++r) GATE[(size_t)(t0 + 4 * g + r) * RW + c] = acc[r];
                    }
                }
            }
        }
        __syncthreads();
        for (int rep_ = 0; rep_ < (MK_PROBE == 2 ? 2 : 1); ++rep_) if (wave < 6) {
            const int c = tid, h = wave;
            const float kkc = k_k[c], kac = k_a[c], rkc = r_k[c];
            const float m0r = mu0[c], m1r = mu1[c], m0k = mu0[RW + c], m1k = mu1[RW + c], m0v = mu0[2 * RW + c], m1v = mu1[2 * RW + c];
            float ic0[16], ic1[16];
#pragma unroll
            for (int i = 0; i < 16; ++i) { const size_t o = (size_t)(t0 + i) * RW + c; ic0[i] = ICLR[o]; ic1[i] = ICLR[(size_t)T * RW + o]; }
#pragma unroll
            for (int i = 0; i < 16; ++i) {
                const int t = t0 + i;
                const float* w_ = win + i * RPROJ + c;
                const float rp = w_[0], rc_ = w_[RPROJ], rn = w_[2 * RPROJ];
                const float kp = w_[RW], kc_ = w_[RPROJ + RW], kn = w_[2 * RPROJ + RW];
                const float vp = w_[2 * RW], vc_ = w_[RPROJ + 2 * RW], vn = w_[2 * RPROJ + 2 * RW];
                const float r = rc_ + m0r * (rp - rc_) + m1r * (rn - rc_);
                const float k = kc_ + m0k * (kp - kc_) + m1k * (kn - kc_);
                const float v = vc_ + m0v * (vp - vc_) + m1v * (vn - vc_);
                const size_t o = (size_t)t * RW + c;
                const float kq = k * kkc;
                const float n2 = wave_sum_fast(kq * kq, lane);
                const float kk = kq / fmaxf(sqrtf(n2), 1e-12f);
                const float kd0 = k * (1.0f + (ic0[i] - 1.0f) * kac), kd1 = k * (1.0f + (ic1[i] - 1.0f) * kac);
                const float bon = wave_sum_fast(r * (kd0 + kd1) * rkc, lane);
#if MK_RWKV_CHUNKED
                RB[o] = (bf16_t)f2bf(r); VB[o] = (bf16_t)f2bf(v); KKB[o] = (bf16_t)f2bf(kk);
                BBB[o] = (bf16_t)f2bf(kk * ic0[i]); BBB[(size_t)T * RW + o] = (bf16_t)f2bf(kk * ic1[i]);
                KDB[o] = (bf16_t)f2bf(kd0); KDB[(size_t)T * RW + o] = (bf16_t)f2bf(kd1);
#else
                RR[o] = r; VV[o] = v; KK[o] = kk;
                KD[o] = kd0; KD[(size_t)T * RW + o] = kd1;
#endif
                if (lane == 0) BONUS[(size_t)t * RH + h] = bon;
#if !MK_RWKV_CHUNKED
                { const float br0 = wave_sum(kk * ic0[i] * r, lane), br1 = wave_sum(kk * ic1[i] * r, lane), kr0 = wave_sum(kd0 * r, lane), kr1 = wave_sum(kd1 * r, lane);
                  if (lane == 0) { BRKR[((size_t)t * RH + h) * 2] = br0; BRKR[((size_t)t * RH + h) * 2 + 1] = kr0; BRKR[((size_t)(T + t) * RH + h) * 2] = br1; BRKR[((size_t)(T + t) * RH + h) * 2 + 1] = kr1; } }
#endif
            }
        }
        __syncthreads();
        {
            u32x2 wb[9], vb[3];
            const int rsel = tid >= 192 ? 1 : 0, c4 = tid - rsel * 192;
#pragma unroll
            for (int it = 0; it < 9; ++it) {
                const int row = 2 * it + rsel, sq = s0 - 1 + row;
                wb[it] = (u32x2){0u, 0u};
                if (tid < 384 && sq >= 0 && sq < S) wb[it] = *(const u32x2*)(proj + (size_t)(t0 - 1 + row) * PLD + C_MW + c4 * 4);
            }
#pragma unroll
            for (int it = 0; it < 3; ++it) { const int idx = tid + it * NTHREADS, i = idx / 96, cc = (idx % 96) * 4; vb[it] = *(const u32x2*)(proj + (size_t)(t0 + i) * PLD + C_MW + 2 * MW + cc); }
            if (tid < 384) {
#pragma unroll
                for (int it = 0; it < 9; ++it) *(f32x4*)(win + (2 * it + rsel) * 768 + c4 * 4) = (f32x4){bf_lo(wb[it].x), bf_hi(wb[it].x), bf_lo(wb[it].y), bf_hi(wb[it].y)};
            }
#pragma unroll
            for (int it = 0; it < 3; ++it) { const int idx = tid + it * NTHREADS, i = idx / 96, cc = (idx % 96) * 4; const u32x2 v = vb[it];
                tv[(cc + 0) * 16 + i] = (bf16_t)(v.x & 0xffffu); tv[(cc + 1) * 16 + i] = (bf16_t)(v.x >> 16); tv[(cc + 2) * 16 + i] = (bf16_t)(v.y & 0xffffu); tv[(cc + 3) * 16 + i] = (bf16_t)(v.y >> 16); }
        }
        for (int idx = tid; idx < 16 * 24; idx += NTHREADS) {
            const int i = idx / 24, gi = idx % 24, t = t0 + i;
            const int isf = gi / 12, dir = (gi / 6) & 1, h = gi % 6;
            const float gg = projg[(size_t)t * 256 + (3456 - (PLD - 256)) + gi] + gate_b[gi];
            if (isf) LF[((size_t)dir * T + t) * MH + h] = -softplusf_(-gg); else IG[((size_t)dir * T + t) * MH + h] = gg;
        }
        __syncthreads();
        for (int rep_ = 0; rep_ < (MK_PROBE == 4 ? 2 : 1); ++rep_)
        for (int idx = tid; idx < 16 * 768; idx += NTHREADS) {
            const int i = idx / 768, c = idx % 768, t = t0 + i;
            const float* w_ = win + i * 768 + c;
            float y = conv_b[c] + w_[0] * conv_w[c] + w_[768] * conv_w[768 + c] + w_[1536] * conv_w[2 * 768 + c];
            y = y * sigmoidf_(y);
            if (c < MW) MQB[(size_t)t * MW + c] = (bf16_t)f2bf(y);
            else { const bf16_t kb = (bf16_t)f2bf(y * 0.125f); MKB[(size_t)t * MW + (c - MW)] = kb; tk[(c - MW) * 16 + i] = kb; }
        }
        __syncthreads();
        for (int idx = tid; idx < 2 * MW * 2; idx += NTHREADS) {
            const int hf = idx & 1, c = (idx >> 1) % MW, which = idx / (2 * MW);
            const u32x4 val = *(const u32x4*)((which ? tv : tk) + c * 16 + hf * 8);
            bf16_t* dst = (which ? VT : KT) + ((size_t)(bb * MH) * 64 + c) * S + s0 + hf * 8;
            *(u32x4*)dst = val;
        }
    }
    __syncthreads();
}

#define TSWZ(c, i) ((c) * TOK + (((((i) >> 3) ^ (((c) >> 1) ^ ((c) >> 3))) & 3) << 3) + ((i) & 7))
__device__ __forceinline__ void phase_prep32(const Params& P, int l, unsigned char* smem, int wv) {
    ParamsPtr pp = PARAMS_PTR(P); PIN_S(pp); unsigned char* ws = pp->ws; int bidx = (int)blockIdx.x, gdim = (int)gridDim.x; PIN_S(bidx); PIN_S(gdim);
    const bf16_t* proj = (const bf16_t*)(ws + O_PROJ); const float* projg = (const float*)(ws + O_PROJG);
    bf16_t* UG = (bf16_t*)(ws + O_UG); bf16_t* VNT = (bf16_t*)(ws + O_VNT);
    u32x4* RK7 = (u32x4*)(ws + O_RK7);
    bf16_t* GATE = (bf16_t*)(ws + O_GATE); float* BONUS = (float*)(ws + O_BONUS); float* LWG = (float*)(ws + O_LW);
    bf16_t* VB = (bf16_t*)(ws + O_VB);
    bf16_t* MQB = (bf16_t*)(ws + O_MQB); bf16_t* MKB = (bf16_t*)(ws + O_MKB); bf16_t* KT = (bf16_t*)(ws + O_KT); bf16_t* VT = (bf16_t*)(ws + O_VT);
    float* IG = (float*)(ws + O_IG); float* LF = (float*)(ws + O_LF);
    const bf16_t* LWT = (const bf16_t*)(ws + O_LWT) + (size_t)l * 1920 * 128;
    const float* gln_g = pp->in[2] + (size_t)l * GW; const float* gln_b = pp->in[3] + (size_t)l * GW;
    const float* mu0 = pp->in[6] + (size_t)l * 2 * RPROJ; const float* mu1 = mu0 + RPROJ;
    const float* w0 = pp->in[7] + (size_t)l * 2 * RW; const float* a0 = pp->in[9] + (size_t)l * 2 * RW;
    const float* k_k = pp->in[12] + (size_t)l * RW; const float* k_a = pp->in[13] + (size_t)l * RW; const float* r_k = pp->in[14] + (size_t)l * RW;
    const float* conv_w = pp->in[17] + (size_t)l * 3 * 768; const float* conv_b = pp->in[18] + (size_t)l * 768; const float* gate_b = pp->in[19] + (size_t)l * 24;
    constexpr int TOK = 32, WR = TOK + 2, LIN = 264;
    bf16_t* winb = (bf16_t*)smem;
    bf16_t* lin = (bf16_t*)(smem + 95744);
    bf16_t* tk = (bf16_t*)(smem + 112640);
    bf16_t* tv = (bf16_t*)(smem + 137216);
    bf16_t* tvn = tk;
    bf16_t* icl = tk;
    const int tid = phase_tid(wv), lane = tid & 63, wave = tid >> 6, col = lane & 15, g = lane >> 4;
    for (int u = bidx; u < T / TOK; u += gdim) {
        const int t0 = u * TOK, s0 = t0 % S, bb = t0 / S;
        __syncthreads();
#pragma unroll 1
        for (int hb = 0; hb < 2; ++hb) {
            u32x2 wb[17];
#pragma unroll
            for (int q = 0; q < 17; ++q) {
                const int row = hb * 17 + q, sq = s0 - 1 + row;
                wb[q] = (u32x2){0u, 0u};
                if (sq >= 0 && sq < S && tid < 352) wb[q] = *(const u32x2*)(proj + (size_t)(t0 - 1 + row) * PLD + C_RW + tid * 4);
            }
            if (tid < 352) {
#pragma unroll
                for (int q = 0; q < 17; ++q) *(u32x2*)(winb + (hb * 17 + q) * RPROJ + tid * 4) = wb[q];
            }
        }
#pragma unroll 1
        for (int ps = 0; ps < 2; ++ps) {
            const int i = ps * 16 + (tid >> 5), l32 = tid & 31, t = t0 + i;
            float v[8], ug[8]; float sum = 0.f;
            {
                const u32x4 uq = *(const u32x4*)(proj + (size_t)t * PLD + l32 * 8), vq = *(const u32x4*)(proj + (size_t)t * PLD + GW + l32 * 8);
                ug[0] = bf_lo(uq.x); ug[1] = bf_hi(uq.x); ug[2] = bf_lo(uq.y); ug[3] = bf_hi(uq.y); ug[4] = bf_lo(uq.z); ug[5] = bf_hi(uq.z); ug[6] = bf_lo(uq.w); ug[7] = bf_hi(uq.w);
                v[0] = bf_lo(vq.x); v[1] = bf_hi(vq.x); v[2] = bf_lo(vq.y); v[3] = bf_hi(vq.y); v[4] = bf_lo(vq.z); v[5] = bf_hi(vq.z); v[6] = bf_lo(vq.w); v[7] = bf_hi(vq.w);
            }
#pragma unroll
            for (int j = 0; j < 8; ++j) { ug[j] = geluf_(ug[j]); v[j] = geluf_(v[j]); sum += v[j]; }
            { u32x4 uo; uo.x = pk2(ug[0], ug[1]); uo.y = pk2(ug[2], ug[3]); uo.z = pk2(ug[4], ug[5]); uo.w = pk2(ug[6], ug[7]); *(u32x4*)(UG + (size_t)t * GW + l32 * 8) = uo; }
#pragma unroll
            for (int o = 16; o >= 1; o >>= 1) sum += SHX(sum, o, lane);
            const float mean = sum * (1.0f / GW); float q = 0.f;
#pragma unroll
            for (int j = 0; j < 8; ++j) { const float d = v[j] - mean; q += d * d; }
#pragma unroll
            for (int o = 16; o >= 1; o >>= 1) q += SHX(q, o, lane);
            const float rstd = 1.0f / sqrtf(q * (1.0f / GW) + LN_EPS);
#pragma unroll
            for (int j = 0; j < 8; ++j) { const int c = l32 * 8 + j; tvn[TSWZ(c, i)] = (bf16_t)f2bf((v[j] - mean) * rstd * gln_g[c] + gln_b[c]); }
        }
        __syncthreads();
#pragma unroll
        for (int q = 0; q < 2; ++q) {
            const int idx = tid + q * NTHREADS, c = idx >> 2, pc = idx & 3;
            *(u32x4*)(VNT + ((size_t)bb * GW + c) * S + s0 + pc * 8) = *(const u32x4*)(tvn + TSWZ(c, pc * 8));
        }
        int tb2 = tid; PIN_V(tb2);
#pragma unroll 4
        for (int q = 0; q < 16; ++q) {
            const int idx = tb2 + q * NTHREADS, i = idx >> 8, j = idx & 255, rc = 1152 + j;
            const float pv = bf_lo((unsigned)winb[i * RPROJ + rc]), cv = bf_lo((unsigned)winb[(i + 1) * RPROJ + rc]), nv = bf_lo((unsigned)winb[(i + 2) * RPROJ + rc]);
            const float x = cv + mu0[rc] * (pv - cv) + mu1[rc] * (nv - cv);
            lin[i * LIN + j] = (bf16_t)f2bf(j < 64 ? ftanh(x) : (j < 128 ? x : sigmoidf_(x)));
        }
        __syncthreads();
#pragma unroll 1
        for (int qg = 0; qg < 3; ++qg) {
            bf16x8 bw_[5][4]; f32x4 bias_[5];
#pragma unroll
            for (int q5 = 0; q5 < 5; ++q5) {
                const int nt = wave * 15 + qg * 5 + q5, grp = nt / 24, c = (nt % 24) * 16 + col;
                const bf16_t* bw = LWT + (size_t)(nt * 16 + col) * 128 + 8 * g;
#pragma unroll
                for (int ks = 0; ks < 2; ++ks) bw_[q5][ks] = *(const bf16x8*)(bw + ks * 32);
                if (grp == 4) {
#pragma unroll
                    for (int ks = 2; ks < 4; ++ks) bw_[q5][ks] = *(const bf16x8*)(bw + ks * 32);
                }
                const int c4 = (nt % 24) * 16 + 4 * g;
                bias_[q5] = grp < 2 ? *(const f32x4*)(w0 + grp * RW + c4) : (grp < 4 ? *(const f32x4*)(a0 + (grp - 2) * RW + c4) : (f32x4){0.f, 0.f, 0.f, 0.f});
            }
#pragma unroll
            for (int q5 = 0; q5 < 5; ++q5) {
                const int nt = wave * 15 + qg * 5 + q5, grp = nt / 24, c4 = (nt % 24) * 16 + 4 * g;
                const int kcol = grp < 2 ? 0 : (grp < 4 ? 64 : 128);
#pragma unroll
                for (int mt = 0; mt < 2; ++mt) {
                    f32x4 acc = (f32x4){0.f, 0.f, 0.f, 0.f};
                    const bf16_t* la = lin + (mt * 16 + col) * LIN + kcol + 8 * g;
#pragma unroll
                    for (int ks = 0; ks < 2; ++ks) acc = MFMA16(bw_[q5][ks], *(const bf16x8*)(la + ks * 32), acc);
                    if (grp == 4) {
#pragma unroll
                        for (int ks = 2; ks < 4; ++ks) acc = MFMA16(bw_[q5][ks], *(const bf16x8*)(la + ks * 32), acc);
                    }
                    const size_t tb = (size_t)(t0 + mt * 16 + col);
                    acc = acc + bias_[q5];
                    if (grp < 2) {
                        f32x4 lw; lw.x = -0.60653065971263342f * sigmoidf_(acc.x); lw.y = -0.60653065971263342f * sigmoidf_(acc.y); lw.z = -0.60653065971263342f * sigmoidf_(acc.z); lw.w = -0.60653065971263342f * sigmoidf_(acc.w);
                        *(f32x4*)(LWG + (size_t)grp * T * RW + tb * RW + c4) = lw;
                    } else if (grp < 4) {
                        u32x2 ic; ic.x = pk2(sigmoidf_(acc.x), sigmoidf_(acc.y)); ic.y = pk2(sigmoidf_(acc.z), sigmoidf_(acc.w));
                        *(u32x2*)(icl + ((grp - 2) * TOK + mt * 16 + col) * RW + c4) = ic;
                    } else {
                        u32x2 gt; gt.x = pk2(acc.x, acc.y); gt.y = pk2(acc.z, acc.w);
                        *(u32x2*)(GATE + tb * RW + c4) = gt;
                    }
                }
            }
        }
        __syncthreads();
        if (wave < 6) {
            int c = tid; PIN_V(c); const int h = wave;
            const float kkc = k_k[c], kac = k_a[c], rkc = r_k[c];
            const float m0r = mu0[c], m1r = mu1[c], m0k = mu0[RW + c], m1k = mu1[RW + c], m0v = mu0[2 * RW + c], m1v = mu1[2 * RW + c];
#pragma unroll 1
            for (int hb = 0; hb < 2; ++hb) {
                float ic0[16], ic1[16];
#pragma unroll
                for (int i = 0; i < 16; ++i) { ic0[i] = bf_lo((unsigned)icl[(hb * 16 + i) * RW + c]); ic1[i] = bf_lo((unsigned)icl[(TOK + hb * 16 + i) * RW + c]); }
#pragma unroll
                for (int i = 0; i < 16; ++i) {
                    const int it = hb * 16 + i, t = t0 + it;
                    const bf16_t* w_ = winb + it * RPROJ + c;
                    const float rp = bf_lo((unsigned)w_[0]), rc_ = bf_lo((unsigned)w_[RPROJ]), rn = bf_lo((unsigned)w_[2 * RPROJ]);
                    const float kp = bf_lo((unsigned)w_[RW]), kc_ = bf_lo((unsigned)w_[RPROJ + RW]), kn = bf_lo((unsigned)w_[2 * RPROJ + RW]);
                    const float vp = bf_lo((unsigned)w_[2 * RW]), vc_ = bf_lo((unsigned)w_[RPROJ + 2 * RW]), vn = bf_lo((unsigned)w_[2 * RPROJ + 2 * RW]);
                    const float r = rc_ + m0r * (rp - rc_) + m1r * (rn - rc_);
                    const float k = kc_ + m0k * (kp - kc_) + m1k * (kn - kc_);
                    const float v = vc_ + m0v * (vp - vc_) + m1v * (vn - vc_);
                    const size_t o = (size_t)t * RW + c;
                    const float kq = k * kkc;
                    const float n2 = wave_sum_fast(kq * kq, lane);
                    const float kk = kq / fmaxf(sqrtf(n2), 1e-12f);
                    const float kd0 = k * (1.0f + (ic0[i] - 1.0f) * kac), kd1 = k * (1.0f + (ic1[i] - 1.0f) * kac);
                    const float bon = wave_sum_fast(r * (kd0 + kd1) * rkc, lane);
                    u32x4 rec; rec.x = pk2(r, v); rec.y = pk2(kk, 0.f); rec.z = pk2(kk * ic0[i], kk * ic1[i]); rec.w = pk2(kd0, kd1);
                    RK7[o] = rec;
                    VB[o] = (bf16_t)(rec.x >> 16);
                    if (lane == 0) BONUS[(size_t)t * RH + h] = bon;
                }
            }
        }
        __syncthreads();
        {
            u32x2 wb[17], vb[6];
            int tC = tid; PIN_V(tC);
            const int rsel = tC >= 192 ? 1 : 0, c4 = tC - rsel * 192;
#pragma unroll
            for (int q = 0; q < 17; ++q) {
                const int row = 2 * q + rsel, sq = s0 - 1 + row;
                wb[q] = (u32x2){0u, 0u};
                if (tC < 384 && sq >= 0 && sq < S) wb[q] = *(const u32x2*)(proj + (size_t)(t0 - 1 + row) * PLD + C_MW + c4 * 4);
            }
#pragma unroll
            for (int q = 0; q < 6; ++q) { const int idx = tC + q * NTHREADS, i = idx / 96, cc = (idx % 96) * 4; vb[q] = *(const u32x2*)(proj + (size_t)(t0 + i) * PLD + C_MW + 2 * MW + cc); }
            if (tC < 384) {
#pragma unroll
                for (int q = 0; q < 17; ++q) *(u32x2*)(winb + (2 * q + rsel) * 768 + c4 * 4) = wb[q];
            }
#pragma unroll
            for (int q = 0; q < 6; ++q) { const int idx = tC + q * NTHREADS, i = idx / 96, cc = (idx % 96) * 4; const u32x2 v = vb[q];
                tv[TSWZ(cc + 0, i)] = (bf16_t)(v.x & 0xffffu); tv[TSWZ(cc + 1, i)] = (bf16_t)(v.x >> 16); tv[TSWZ(cc + 2, i)] = (bf16_t)(v.y & 0xffffu); tv[TSWZ(cc + 3, i)] = (bf16_t)(v.y >> 16); }
        }
        for (int idx = tid; idx < TOK * 24; idx += NTHREADS) {
            const int i = idx / 24, gi = idx % 24, t = t0 + i;
            const int isf = gi / 12, dir = (gi / 6) & 1, h = gi % 6;
            const float gg = projg[(size_t)t * 256 + (3456 - (PLD - 256)) + gi] + gate_b[gi];
            if (isf) LF[((size_t)dir * T + t) * MH + h] = -softplusf_(-gg); else IG[((size_t)dir * T + t) * MH + h] = gg;
        }
        __syncthreads();
        {
            int tcv = tid; PIN_V(tcv);
#pragma unroll 1
            for (int k3 = 0; k3 < 3; ++k3) {
                const int item = tcv + k3 * NTHREADS, hb = item / 768, c = item - hb * 768;
                const float cb = conv_b[c], cw0 = conv_w[c], cw1 = conv_w[768 + c], cw2 = conv_w[2 * 768 + c];
                const bf16_t* w_ = winb + (hb * 16) * 768 + c;
                float x0 = bf_lo((unsigned)w_[0]), x1 = bf_lo((unsigned)w_[768]);
#pragma unroll
                for (int i = 0; i < 16; ++i) {
                    const float x2 = bf_lo((unsigned)w_[(i + 2) * 768]);
                    float y = cb + x0 * cw0 + x1 * cw1 + x2 * cw2;
                    y = y * sigmoidf_(y);
                    const int it = hb * 16 + i, t = t0 + it;
                    if (c < MW) MQB[(size_t)t * MW + c] = (bf16_t)f2bf(y);
                    else { const bf16_t kb = (bf16_t)f2bf(y * 0.125f); MKB[(size_t)t * MW + (c - MW)] = kb; tk[TSWZ(c - MW, it)] = kb; }
                    x0 = x1; x1 = x2;
                }
            }
        }
        __syncthreads();
#pragma unroll
        for (int q = 0; q < 6; ++q) {
            const int idx = tid + q * NTHREADS, pc = idx & 3, c = (idx >> 2) % MW, which = idx / (4 * MW);
            const u32x4 val = *(const u32x4*)((which ? tv : tk) + TSWZ(c, pc * 8));
            bf16_t* dst = (which ? VT : KT) + ((size_t)(bb * MH) * 64 + c) * S + s0 + pc * 8;
            *(u32x4*)dst = val;
        }
    }
    __syncthreads();
}

#undef TSWZ
__device__ __forceinline__ void phase_gmlp_mix(const Params& P, int l, unsigned char* smem, int wv, int bid, int nb) {
    PIN_S(bid); PIN_S(nb);
    ParamsPtr pp = PARAMS_PTR(P); PIN_S(pp); unsigned char* ws = pp->ws;
    const bf16_t* UG = (const bf16_t*)(ws + O_UG); const bf16_t* VNT = (const bf16_t*)(ws + O_VNT); bf16_t* GRP = (bf16_t*)(ws + O_GRP);
    const bf16_t* WSB = (const bf16_t*)(ws + O_WSB) + (size_t)l * GH * CH * CH; const float* gbs = pp->in[5] + (size_t)l * GH * CH;
    const int tid = phase_tid(wv), lane = tid & 63, wave = tid >> 6, col = lane & 15, g = lane >> 4;
    constexpr int NU = NB * NCH * GH;
    bf16x8 wA[4], vA[4][4], wB[4], vB[4][4]; u32x2 uA[4], uB[4]; float bA, bB;
#define GM_LOAD(u_, W_, V_, U_, B_) do { const int h_ = (u_) % GH, c_ = ((u_) / GH) % NCH, b_ = (u_) / (GH * NCH); \
        const bf16_t* wb_ = WSB + (size_t)h_ * CH * CH + (size_t)(wave * 16 + col) * CH + 8 * g; \
        const bf16_t* vb_ = VNT + ((size_t)b_ * GW + h_ * 64 + col) * S + (size_t)c_ * CH + 8 * g; \
        _Pragma("unroll") for (int ks = 0; ks < 4; ++ks) { W_[ks] = *(const bf16x8*)(wb_ + ks * 32); \
            _Pragma("unroll") for (int et = 0; et < 4; ++et) V_[et][ks] = *(const bf16x8*)(vb_ + (size_t)et * 16 * S + ks * 32); } \
        const size_t t_ = (size_t)(b_ * S + c_ * CH + wave * 16 + col); \
        _Pragma("unroll") for (int et = 0; et < 4; ++et) U_[et] = *(const u32x2*)(UG + t_ * GW + h_ * 64 + et * 16 + 4 * g); \
        B_ = gbs[h_ * CH + wave * 16 + col]; } while (0)
#define GM_COMP(u_, W_, V_, U_, B_) do { const int h_ = (u_) % GH, c_ = ((u_) / GH) % NCH, b_ = (u_) / (GH * NCH); \
        const size_t t_ = (size_t)(b_ * S + c_ * CH + wave * 16 + col); \
        _Pragma("unroll") for (int et = 0; et < 4; ++et) { f32x4 acc = (f32x4){0.f, 0.f, 0.f, 0.f}; \
            _Pragma("unroll") for (int ks = 0; ks < 4; ++ks) acc = MFMA16(V_[et][ks], W_[ks], acc); \
            u32x2 o_; o_.x = pk2(bf_lo(U_[et].x) * (acc[0] + B_), bf_hi(U_[et].x) * (acc[1] + B_)); o_.y = pk2(bf_lo(U_[et].y) * (acc[2] + B_), bf_hi(U_[et].y) * (acc[3] + B_)); \
            *(u32x2*)(GRP + t_ * D + h_ * 64 + et * 16 + 4 * g) = o_; } } while (0)
    int u = bid;
    if (u < NU) GM_LOAD(u, wA, vA, uA, bA);
    while (u < NU) {
        const int u1 = u + nb;
        if (u1 < NU) GM_LOAD(u1, wB, vB, uB, bB);
        GM_COMP(u, wA, vA, uA, bA);
        if (u1 >= NU) break;
        const int u2 = u1 + nb;
        if (u2 < NU) GM_LOAD(u2, wA, vA, uA, bA);
        GM_COMP(u1, wB, vB, uB, bB);
        u = u2;
    }
#undef GM_LOAD
#undef GM_COMP
}

constexpr int SC_STEPS = 16;
constexpr int SC_BUF = SC_STEPS * 6 * 64;
__device__ __forceinline__ void phase_rwkv_scan(const Params& P, int l, unsigned char* smem, int wv, int bid, int nb) {
    PIN_S(bid); PIN_S(nb);
    ParamsPtr pp = PARAMS_PTR(P); PIN_S(pp); unsigned char* ws = pp->ws;
    const float* RR = (const float*)(ws + O_RR); const float* VV = (const float*)(ws + O_VV); const float* KK = (const float*)(ws + O_KK);
    const float* DEC = (const float*)(ws + O_DEC); const float* KD = (const float*)(ws + O_KD); const float* ICLR = (const float*)(ws + O_ICLR);
    float* SCAN = (float*)(ws + O_SCAN); const float* BRKR = (const float*)(ws + O_BRKR);
    const int tid = phase_tid(wv), lane = tid & 63, wave = tid >> 6, rl = (lane >> 4) & 1, kq = (lane & 15) | ((lane >> 5) << 4);
    float* buf = (float*)smem;
    float* scal = buf + 2 * SC_BUF;
    float* outb = scal + 2 * SC_STEPS * 2;
    typedef float f32x2 __attribute__((ext_vector_type(2)));
    for (int u = bid; u < 2 * NB * RH * 4; u += nb) {
        const int qt = u & 3, h = (u >> 2) % RH, b = (u / (4 * RH)) % NB, d = u / (4 * RH * NB);
        const size_t doff = (size_t)d * T * RW;
        float s0 = 0.f, s1 = 0.f;
        float pw[2], pa[2], pb[2], pk[2], pr[2], pv[2], psc = 0.f;
#define SC_LOAD(c) do { _Pragma("unroll") for (int i = 0; i < 2; ++i) { const int idx = tid + NTHREADS * i, st = idx >> 6, k = idx & 63; const int tau = (c) * SC_STEPS + st, sq = d ? S - 1 - tau : tau; \
            const size_t o = (size_t)(b * S + sq) * RW + h * 64 + k; \
            pw[i] = DEC[doff + o]; pa[i] = KK[o]; pb[i] = ICLR[doff + o]; pk[i] = KD[doff + o]; pr[i] = RR[o]; pv[i] = VV[o]; }     \
            if (tid < 2 * SC_STEPS) { const int tau = (c) * SC_STEPS + (tid >> 1), sq = d ? S - 1 - tau : tau; psc = BRKR[((size_t)(d * T + b * S + sq) * RH + h) * 2 + (tid & 1)]; } } while (0)
#define SC_WRITE(c) do { float* B_ = buf + ((c) & 1) * SC_BUF; _Pragma("unroll") for (int i = 0; i < 2; ++i) { const int idx = tid + NTHREADS * i, st = idx >> 6, k = idx & 63; \
            float* q_ = B_ + st * 384 + k; q_[0] = pw[i]; q_[64] = -pa[i]; q_[128] = pa[i] * pb[i]; q_[192] = pk[i]; q_[256] = pw[i] * pr[i]; q_[320] = pv[i]; } \
            if (tid < 2 * SC_STEPS) scal[((c) & 1) * SC_STEPS * 2 + tid] = psc; } while (0)
        __syncthreads();
        SC_LOAD(0); SC_WRITE(0);
        __syncthreads();
        const int row = qt * 16 + wave * 2 + rl;
        for (int c = 0; c < S / SC_STEPS; ++c) {
            const bool more = (c + 1) < S / SC_STEPS;
            if (more) SC_LOAD(c + 1);
            const float* B = buf + (c & 1) * SC_BUF; const float* sc = scal + (c & 1) * SC_STEPS * 2; float* ob = outb + (c & 1) * SC_STEPS * 16;
            float outs[SC_STEPS];
            f32x2 w2 = *(const f32x2*)(B + 2 * kq), a2 = *(const f32x2*)(B + 64 + 2 * kq), b2 = *(const f32x2*)(B + 128 + 2 * kq);
            f32x2 k2 = *(const f32x2*)(B + 192 + 2 * kq), wr2 = *(const f32x2*)(B + 256 + 2 * kq);
            float v = B[320 + row]; float br = sc[0], kr = sc[1];
#pragma unroll
            for (int st = 0; st < SC_STEPS; ++st) {
                const int sn = st + 1 < SC_STEPS ? st + 1 : st;
                const float* q = B + sn * 384;
                const f32x2 nw2 = *(const f32x2*)(q + 2 * kq), na2 = *(const f32x2*)(q + 64 + 2 * kq), nb2 = *(const f32x2*)(q + 128 + 2 * kq);
                const f32x2 nk2 = *(const f32x2*)(q + 192 + 2 * kq), nwr2 = *(const f32x2*)(q + 256 + 2 * kq);
                const float nv = q[320 + row], nbr = sc[sn * 2], nkr = sc[sn * 2 + 1];
                SCHED_BAR();
                float sa = s0 * a2.x + s1 * a2.y;
                float po = s0 * wr2.x + s1 * wr2.y;
                sa = row32_sum(sa); po = row32_sum(po);
                outs[st] = po + sa * br + v * kr;
                s0 = s0 * w2.x + (sa * b2.x + v * k2.x); s1 = s1 * w2.y + (sa * b2.y + v * k2.y);
                SCHED_BAR();
                w2 = nw2; a2 = na2; b2 = nb2; k2 = nk2; wr2 = nwr2; v = nv; br = nbr; kr = nkr;
            }
            if (kq == 0) {
#pragma unroll
                for (int st = 0; st < SC_STEPS; ++st) ob[st * 16 + wave * 2 + rl] = outs[st];
            }
            if (more) SC_WRITE(c + 1);
            __syncthreads();
            if (tid < 16 * SC_STEPS) {
                const int st = tid >> 4, r = tid & 15, tau = c * SC_STEPS + st, sq = d ? S - 1 - tau : tau;
                SCAN[doff + (size_t)(b * S + sq) * RW + h * 64 + qt * 16 + r] = ob[st * 16 + r];
            }
        }
#undef SC_LOAD
#undef SC_WRITE
    }
    __syncthreads();
}

constexpr int RST = 72;
constexpr int RARR = 64 * RST;
__device__ __forceinline__ f32x4 tile_nt(const bf16_t* Aa, int ta, const bf16_t* Ba, int tb, f32x4 acc, int col, int g) {
#pragma unroll
    for (int ks = 0; ks < 2; ++ks) {
        const bf16x8 af = *(const bf16x8*)(Aa + (ta * 16 + col) * RST + ks * 32 + 8 * g);
        const bf16x8 bfr = *(const bf16x8*)(Ba + (tb * 16 + col) * RST + ks * 32 + 8 * g);
        acc = MFMA16(af, bfr, acc);
    }
    return acc;
}
__device__ __forceinline__ void phase_rwkv_pre(const Params& P, int l, unsigned char* smem, int wv) {
    ParamsPtr pp = PARAMS_PTR(P); PIN_S(pp); unsigned char* ws = pp->ws; int bidx = (int)blockIdx.x, gdim = (int)gridDim.x; PIN_S(bidx); PIN_S(gdim);
    const u32x4* RK7 = (const u32x4*)(ws + O_RK7);
    const float* LWG = (const float*)(ws + O_LW);
    bf16_t* Qg = (bf16_t*)(ws + O_RQ); bf16_t* Ag = (bf16_t*)(ws + O_RA); bf16_t* Hg = (bf16_t*)(ws + O_RH); bf16_t* Gg = (bf16_t*)(ws + O_RG);
    const int tid0 = phase_tid(wv);
#define RW_STAGE_VARS int tid = tid0; PIN_V(tid); const int lane = tid & 63, wave = tid >> 6, col = lane & 15, g = lane >> 4; (void)lane; (void)wave; (void)col; (void)g;
    bf16_t* At = (bf16_t*)smem; bf16_t* Bt = At + RARR; bf16_t* Kt = Bt + RARR; bf16_t* Rt = Kt + RARR;
    bf16_t* BtT = Rt + RARR; bf16_t* KtT = BtT + RARR; bf16_t* VT = KtT + RARR;
    bf16_t* Lak = VT + RARR; bf16_t* Mrb = Lak + RARR; bf16_t* Mrk = Mrb + RARR; bf16_t* YT = Mrk + RARR; bf16_t* W2T = YT + RARR;
    bf16_t* Lbo = W2T + RARR;
    float* LabT = (float*)(Lbo + RARR);
    float* Xs = LabT + 4096;
    float* Pb = Xs + 4096;
    float* segs = Pb + 2048;
    float* PC = segs + 512;
    float plw[8]; u32x4 prec[8];
#define RW_LOAD(uu) do { const int c_ = (uu) % RNC, h_ = ((uu) / RNC) % RH, b_ = ((uu) / (RNC * RH)) % NB, d_ = (uu) / (RNC * RH * NB); const size_t doff_ = (size_t)d_ * T * RW; \
        const int ch_ = tid0 & 63, sg_ = tid0 >> 6; _Pragma("unroll") for (int j = 0; j < 8; ++j) { const int tau = c_ * RC + sg_ * 8 + j, sq = d_ ? S - 1 - tau : tau; const size_t o = (size_t)(b_ * S + sq) * RW + h_ * 64 + ch_; \
        plw[j] = LWG[doff_ + o]; prec[j] = RK7[o]; } } while (0)
    if (bidx < RUN) RW_LOAD(bidx);
    for (int u = bidx; u < RUN; u += gdim) {
        const int c = u % RNC, h = (u / RNC) % RH, b = (u / (RNC * RH)) % NB, d = u / (RNC * RH * NB);
        (void)c; (void)h; (void)b; (void)d;
        __syncthreads();
        {
            RW_STAGE_VARS
            const int ch = tid & 63, sg = tid >> 6;
            float lw[8]; unsigned kk[8], bq_[8], kd[8], rr[8], vv[8];
#pragma unroll
            for (int j = 0; j < 8; ++j) { lw[j] = plw[j]; kk[j] = prec[j].y & 0xffffu; bq_[j] = d ? (prec[j].z >> 16) : (prec[j].z & 0xffffu); kd[j] = d ? (prec[j].w >> 16) : (prec[j].w & 0xffffu); rr[j] = prec[j].x & 0xffffu; vv[j] = prec[j].x >> 16; }
            if (u + gdim < RUN) RW_LOAD(u + gdim);
            float run = 0.f;
#pragma unroll
            for (int j = 0; j < 8; ++j) { run += lw[j]; lw[j] = run; }
            segs[sg * 64 + ch] = run;
            __syncthreads();
            float off = 0.f;
            for (int q = 0; q < sg; ++q) off += segs[q * 64 + ch];
            u32x4 pbt, pkt, pvt; unsigned tb[8], tk[8], tvv[8];
            float prev = off;
#pragma unroll
            for (int j = 0; j < 8; ++j) {
                const int t = sg * 8 + j; const float cl = off + lw[j];
                const float ep = fexp(prev), en = fexp(-cl), epc = fexp(cl);
                const unsigned a_ = f2bf(-bf_lo(kk[j]) * ep), b_ = f2bf(bf_lo(bq_[j]) * en), k_ = f2bf(bf_lo(kd[j]) * en), r_ = f2bf(bf_lo(rr[j]) * epc), v_ = vv[j];
                At[t * RST + ch] = (bf16_t)a_; Bt[t * RST + ch] = (bf16_t)b_; Kt[t * RST + ch] = (bf16_t)k_; Rt[t * RST + ch] = (bf16_t)r_;
                tb[j] = b_; tk[j] = k_; tvv[j] = v_;
                prev = cl;
            }
            if (sg == 7) PC[ch] = fexp(prev);
            pbt.x = tb[0] | (tb[1] << 16); pbt.y = tb[2] | (tb[3] << 16); pbt.z = tb[4] | (tb[5] << 16); pbt.w = tb[6] | (tb[7] << 16);
            pkt.x = tk[0] | (tk[1] << 16); pkt.y = tk[2] | (tk[3] << 16); pkt.z = tk[4] | (tk[5] << 16); pkt.w = tk[6] | (tk[7] << 16);
            pvt.x = tvv[0] | (tvv[1] << 16); pvt.y = tvv[2] | (tvv[3] << 16); pvt.z = tvv[4] | (tvv[5] << 16); pvt.w = tvv[6] | (tvv[7] << 16);
            *(u32x4*)(BtT + ch * RST + sg * 8) = pbt; *(u32x4*)(KtT + ch * RST + sg * 8) = pkt; *(u32x4*)(VT + ch * RST + sg * 8) = pvt;
            for (int z_ = tid; z_ < 2 * RARR / 8; z_ += NTHREADS) ((u32x4*)YT)[z_] = (u32x4){0u, 0u, 0u, 0u};
        }
        __syncthreads();
        {
            RW_STAGE_VARS
            const int m = wave >> 1;
            const bf16_t* Ym = (m == 0 || m == 2) ? Bt : Kt; const bf16_t* Xm = (m < 2) ? At : Rt;
#pragma unroll 1
            for (int q = 0; q < 8; ++q) {
                const int tix = (wave & 1) * 8 + q, it = tix >> 2, tt = tix & 3;
                f32x4 acc = (f32x4){0.f, 0.f, 0.f, 0.f};
                if (it <= tt) acc = tile_nt(Ym, it, Xm, tt, acc, col, g);
                const int t = tt * 16 + col, i0 = it * 16 + 4 * g;
                float o4[4];
#pragma unroll
                for (int r = 0; r < 4; ++r) { const int i = i0 + r; const bool ok = m < 2 ? (i < t) : (i <= t); o4[r] = ok ? acc[r] : 0.f; }
                if (m == 0) {
#pragma unroll
                    for (int r = 0; r < 4; ++r) LabT[(i0 + r) * 64 + t] = o4[r];
                    const bool offd = it < tt;
                    u32x2 w2; w2.x = offd ? pk2(o4[0], o4[1]) : 0u; w2.y = offd ? pk2(o4[2], o4[3]) : 0u; *(u32x2*)(Lbo + t * RST + i0) = w2;
                }
                else { bf16_t* dst = (m == 1 ? Lak : (m == 2 ? Mrb : Mrk)) + t * RST + i0; u32x2 w2; w2.x = pk2(o4[0], o4[1]); w2.y = pk2(o4[2], o4[3]); *(u32x2*)dst = w2; }
            }
        }
        __syncthreads();
        {
            RW_STAGE_VARS
#pragma unroll
            for (int q = 0; q < 2; ++q) {
                const int tix = wave * 2 + q, tt = tix >> 2, et = tix & 3;
                f32x4 acc = (f32x4){0.f, 0.f, 0.f, 0.f};
                acc = tile_nt(Lak, tt, VT, et, acc, col, g);
#pragma unroll
                for (int r = 0; r < 4; ++r) Xs[(tt * 16 + 4 * g + r) * 64 + et * 16 + col] = acc[r];
            }
        }
        __syncthreads();
        {
            RW_STAGE_VARS
#pragma unroll 1
            for (int bb = 0; bb < 4; ++bb) {
                if (bb > 0) {
                    const bf16_t* Zt = (wave < 4 ? YT : W2T) + ((wave & 3) * 16 + col) * RST + 8 * g;
                    const bf16_t* La = Lbo + (16 * bb + col) * RST + 8 * g;
                    f32x4 acc = (f32x4){0.f, 0.f, 0.f, 0.f};
                    acc = MFMA16(*(const bf16x8*)La, *(const bf16x8*)Zt, acc);
                    if (bb > 2) acc = MFMA16(*(const bf16x8*)(La + 32), *(const bf16x8*)(Zt + 32), acc);
#pragma unroll
                    for (int r = 0; r < 4; ++r) Pb[(4 * g + r) * 128 + wave * 16 + col] = acc[r];
                }
                float acc[16], dq[120];
                if (wave < 2) {
                    if (wave == 0) {
#pragma unroll
                        for (int r = 0; r < 16; ++r) acc[r] = bf_lo((unsigned)At[(16 * bb + r) * RST + lane]);
                    } else {
#pragma unroll
                        for (int r = 0; r < 16; ++r) acc[r] = Xs[(16 * bb + r) * 64 + lane];
                    }
                    const float* dp = LabT + (16 * bb) * 64 + 16 * bb;
#pragma unroll
                    for (int r = 1; r < 16; ++r)
#pragma unroll
                        for (int r2 = 0; r2 < r; ++r2) dq[r * (r - 1) / 2 + r2] = dp[r2 * 64 + r];
                }
                __syncthreads();
                if (wave < 2) {
                    if (bb > 0) {
#pragma unroll
                        for (int r = 0; r < 16; ++r) acc[r] += Pb[r * 128 + wave * 64 + lane];
                    }
#pragma unroll
                    for (int r = 1; r < 16; ++r)
#pragma unroll
                        for (int r2 = 0; r2 < r; ++r2) acc[r] += dq[r * (r - 1) / 2 + r2] * acc[r2];
                    bf16_t* dst = (wave == 0 ? YT : W2T) + lane * RST;
                    u32x4 w0, w1;
                    w0.x = pk2(acc[0], acc[1]); w0.y = pk2(acc[2], acc[3]); w0.z = pk2(acc[4], acc[5]); w0.w = pk2(acc[6], acc[7]);
                    w1.x = pk2(acc[8], acc[9]); w1.y = pk2(acc[10], acc[11]); w1.z = pk2(acc[12], acc[13]); w1.w = pk2(acc[14], acc[15]);
                    *(u32x4*)(dst + 16 * bb) = w0; *(u32x4*)(dst + 16 * bb + 8) = w1;
                }
                __syncthreads();
            }
        }
        __syncthreads();
        {
            RW_STAGE_VARS
            const int ty = wave >> 1;
#pragma unroll 1
            for (int q = 0; q < 8; ++q) {
                const int tix = (wave & 1) * 8 + q, ra = tix >> 2, cb = tix & 3;
                f32x4 acc = (f32x4){0.f, 0.f, 0.f, 0.f};
                if (ty == 0) {
                    acc = tile_nt(YT, ra, Mrb, cb, acc, col, g);
                    const u32x2 rt2 = *(const u32x2*)(Rt + (cb * 16 + col) * RST + ra * 16 + 4 * g);
                    u32x2 qb2; qb2.x = pk2(acc[0] + bf_lo(rt2.x), acc[1] + bf_hi(rt2.x)); qb2.y = pk2(acc[2] + bf_lo(rt2.y), acc[3] + bf_hi(rt2.y));
                    *(u32x2*)(Qg + (size_t)u * 4096 + ((((ra >> 1) * 4 + cb) * 64 + lane) * 8 + (ra & 1) * 4)) = qb2;
                } else if (ty == 1) {
                    acc = tile_nt(Mrb, ra, W2T, cb, acc, col, g); acc = tile_nt(Mrk, ra, VT, cb, acc, col, g);
                    { u32x2 hb; hb.x = pk2(acc[0], acc[1]); hb.y = pk2(acc[2], acc[3]); *(u32x2*)(Hg + (size_t)u * 4096 + (tix * 64 + lane) * 4) = hb; }
                } else if (ty == 2) {
                    acc = tile_nt(YT, ra, BtT, cb, acc, col, g);
                    const float pc = PC[cb * 16 + col]; const int k1 = cb * 16 + col;
                    float a4[4];
#pragma unroll
                    for (int r = 0; r < 4; ++r) a4[r] = pc * (acc[r] + ((ra * 16 + 4 * g + r) == k1 ? 1.0f : 0.f));
                    u32x2 ab2; ab2.x = pk2(a4[0], a4[1]); ab2.y = pk2(a4[2], a4[3]);
                    *(u32x2*)(Ag + (size_t)u * 4096 + ((((ra >> 1) * 4 + cb) * 64 + lane) * 8 + (ra & 1) * 4)) = ab2;
                } else {
                    acc = tile_nt(BtT, ra, W2T, cb, acc, col, g); acc = tile_nt(KtT, ra, VT, cb, acc, col, g);
#pragma unroll
                    for (int r = 0; r < 4; ++r) acc[r] *= PC[ra * 16 + 4 * g + r];
                    { u32x2 gb2; gb2.x = pk2(acc[0], acc[1]); gb2.y = pk2(acc[2], acc[3]); *(u32x2*)(Gg + (size_t)u * 4096 + (tix * 64 + lane) * 4) = gb2; }
                }
            }
        }
    }
    __syncthreads();
#undef RW_STAGE_VARS
#undef RW_LOAD
}
constexpr int RSEQ_WGS = 2 * NB * RH * 2;
template <int MODE = 0>
__device__ __forceinline__ void phase_rwkv_seq(const Params& P, int l, unsigned char* smem, int wv) {
    ParamsPtr pp = PARAMS_PTR(P); PIN_S(pp); unsigned char* ws = pp->ws; int bidx = (int)blockIdx.x, gdim = (int)gridDim.x; PIN_S(bidx); PIN_S(gdim);
    const bf16_t* Ag = (const bf16_t*)(ws + O_RA); const bf16_t* Gg = (const bf16_t*)(ws + O_RG); bf16_t* Sg = (bf16_t*)(ws + ((MODE & 4) ? O_XS : O_RS));
    const int tid = phase_tid(wv), lane = tid & 63, wave = tid >> 6, col = lane & 15, g = lane >> 4;
    if (wave >= 2) return;
    const int nwg = gdim < RSEQ_WGS ? gdim : RSEQ_WGS;
    if (bidx >= nwg) return;
    for (int un = bidx * 2 + wave; un < 2 * NB * RH * 4; un += 2 * nwg) {
        const int ch = un >> 2, eq = un & 3;
        f32x4 acc[4];
#pragma unroll
        for (int a_ = 0; a_ < 4; ++a_) acc[a_] = (f32x4){0.f, 0.f, 0.f, 0.f};
        u32x4 a0[4][2], a1[4][2], a2[4][2], a3[4][2]; u32x2 g0[4], g1[4], g2[4], g3[4];
        const unsigned aoff = (unsigned)(col * 64 + 16 * g), goff = (unsigned)(lane * 4), aoff8 = (unsigned)(lane * 8);
#define RS_LOAD(cc, AF, GQ) do { const int c_ = (cc) < RNC ? (cc) : RNC - 1; const bf16_t* ab_ = Ag + (size_t)(ch * RNC + c_) * 4096; const bf16_t* gb_ = Gg + (size_t)(ch * RNC + c_) * 4096 + eq * 256; \
            _Pragma("unroll") for (int ra = 0; ra < 4; ++ra) _Pragma("unroll") for (int p = 0; p < 2; ++p) AF[ra][p] = *(const u32x4*)(ab_ + ((p * 4 + ra) * 512) + aoff8); \
            _Pragma("unroll") for (int ra = 0; ra < 4; ++ra) GQ[ra] = *(const u32x2*)(gb_ + (ra * 1024) + goff); } while (0)
#define RS_STEP(c, AF, GQ) do { if (RNC % 4 == 0 || (c) < RNC) { SCHED_BAR(); bf16_t* sb_ = Sg + (size_t)(ch * RNC + (c)) * 4096 + eq * 1024; \
            bf16x8 bq[2]; _Pragma("unroll") for (int p = 0; p < 2; ++p) bq[p] = cvt8(acc[2 * p], acc[2 * p + 1]); \
            if (!(MODE & 1) || (c) == RNC - 1) { _Pragma("unroll") for (int p = 0; p < 2; ++p) *(bf16x8*)(sb_ + (p * 8) + aoff) = bq[p]; } \
            _Pragma("unroll") for (int ra = 0; ra < 4; ++ra) acc[ra] = (f32x4){bf_lo(GQ[ra].x), bf_hi(GQ[ra].x), bf_lo(GQ[ra].y), bf_hi(GQ[ra].y)}; \
            _Pragma("unroll") for (int ra = 0; ra < 4; ++ra) _Pragma("unroll") for (int p = 0; p < 2; ++p) acc[ra] = MFMA16(__builtin_bit_cast(bf16x8, AF[ra][p]), bq[p], acc[ra]); \
            if (!(MODE & 2)) RS_LOAD((c) + 4, AF, GQ); SCHED_BAR(); } } while (0)
        RS_LOAD(0, a0, g0); RS_LOAD(1, a1, g1); RS_LOAD(2, a2, g2); RS_LOAD(3, a3, g3);
#pragma unroll 1
        for (int c = 0; c < RNC; c += 4) { RS_STEP(c, a0, g0); RS_STEP(c + 1, a1, g1); RS_STEP(c + 2, a2, g2); RS_STEP(c + 3, a3, g3); }
#undef RS_LOAD
#undef RS_STEP
    }
}
__device__ __forceinline__ void phase_rwkv_out(const Params& P, int l, unsigned char* smem, int wv) {
    ParamsPtr pp = PARAMS_PTR(P); PIN_S(pp); unsigned char* ws = pp->ws; int bidx = (int)blockIdx.x, gdim = (int)gridDim.x; PIN_S(bidx); PIN_S(gdim);
    const bf16_t* Qg = (const bf16_t*)(ws + O_RQ); const bf16_t* Sg = (const bf16_t*)(ws + O_RS); const bf16_t* Hg = (const bf16_t*)(ws + O_RH);
    const bf16_t* VB = (const bf16_t*)(ws + O_VB); const bf16_t* GATE = (const bf16_t*)(ws + O_GATE); const float* BONUS = (const float*)(ws + O_BONUS);
    bf16_t* GRP = (bf16_t*)(ws + O_GRP);
    const float* rln_g = pp->in[15] + (size_t)l * RW; const float* rln_b = pp->in[16] + (size_t)l * RW;
    const int tid = phase_tid(wv), lane = tid & 63, wave = tid >> 6, col = lane & 15, g = lane >> 4;
    for (int pu = bidx * NWAVES + wave; pu < NB * RH * RNC; pu += gdim * NWAVES) {
        const int c = pu % RNC, h = (pu / RNC) % RH, b = pu / (RNC * RH);
        f32x4 o[2][4][4];
#pragma unroll
        for (int d = 0; d < 2; ++d) {
            const int u = ((d * NB + b) * RH + h) * RNC + (d ? RNC - 1 - c : c);
            const size_t ub = (size_t)u * 4096;
            bf16x8 qa[4][2], sb[4][2];
#pragma unroll
            for (int q = 0; q < 4; ++q)
#pragma unroll
                for (int ks = 0; ks < 2; ++ks) {
                    qa[q][ks] = *(const bf16x8*)(Qg + ub + ((ks * 4 + q) * 64 + lane) * 8);
                    sb[q][ks] = *(const bf16x8*)(Sg + ub + (q * 16 + col) * 64 + 16 * g + 8 * ks);
                }
#pragma unroll
            for (int tt = 0; tt < 4; ++tt)
#pragma unroll
                for (int et = 0; et < 4; ++et) {
                    const u32x2 hb = *(const u32x2*)(Hg + ub + ((tt * 4 + et) * 64 + lane) * 4);
                    f32x4 acc = (f32x4){bf_lo(hb.x), bf_hi(hb.x), bf_lo(hb.y), bf_hi(hb.y)};
#pragma unroll
                    for (int ks = 0; ks < 2; ++ks) acc = MFMA16(qa[tt][ks], sb[et][ks], acc);
                    o[d][tt][et] = acc;
                }
        }
        const int src = (3 - g) * 16 + col;
#pragma unroll
        for (int tt = 0; tt < 4; ++tt)
#pragma unroll
            for (int et = 0; et < 4; ++et)
#pragma unroll
                for (int r = 0; r < 4; ++r) o[0][tt][et][r] += SHL(o[1][3 - tt][et][3 - r], src);
        float* tile = (float*)smem + wave * (64 * 68);
        WAVE_SYNC();
#pragma unroll
        for (int tt = 0; tt < 4; ++tt)
#pragma unroll
            for (int et = 0; et < 4; ++et)
#pragma unroll
                for (int r = 0; r < 4; ++r) tile[(tt * 16 + 4 * g + r) * 68 + et * 16 + col] = o[0][tt][et][r];
        WAVE_SYNC();
        {
            const int c4 = (lane & 15) * 4, ch = h * 64 + c4;
            const f32x4 lg = *(const f32x4*)(rln_g + ch), lb = *(const f32x4*)(rln_b + ch);
#pragma unroll 1
            for (int qb = 0; qb < 2; ++qb) {
                u32x2 gt_[8]; u32x2 vb_[8]; float bo_[8];
#pragma unroll
                for (int q8 = 0; q8 < 8; ++q8) {
                    const size_t t = (size_t)(b * S + c * RC + (qb * 8 + q8) * 4 + (lane >> 4));
                    gt_[q8] = *(const u32x2*)(GATE + t * RW + ch); vb_[q8] = *(const u32x2*)(VB + t * RW + ch); bo_[q8] = BONUS[t * RH + h];
                }
#pragma unroll
                for (int q8 = 0; q8 < 8; ++q8) {
                    const int tl = (qb * 8 + q8) * 4 + (lane >> 4);
                    const size_t t = (size_t)(b * S + c * RC + tl);
                    const f32x4 x = *(const f32x4*)(tile + tl * 68 + c4);
                    const float mean = row16_sum((x.x + x.y) + (x.z + x.w)) * (1.0f / 64.0f);
                    const f32x4 dl = x - mean;
                    const float var = row16_sum((dl.x * dl.x + dl.y * dl.y) + (dl.z * dl.z + dl.w * dl.w)) * (1.0f / 64.0f);
                    const float rstd = 1.0f / sqrtf(var + GN_EPS);
                    f32x4 y = dl * rstd * lg + lb;
                    y.x += bo_[q8] * bf_lo(vb_[q8].x); y.y += bo_[q8] * bf_hi(vb_[q8].x); y.z += bo_[q8] * bf_lo(vb_[q8].y); y.w += bo_[q8] * bf_hi(vb_[q8].y);
                    y = y * (f32x4){bf_lo(gt_[q8].x), bf_hi(gt_[q8].x), bf_lo(gt_[q8].y), bf_hi(gt_[q8].y)};
                    u32x2 ob; ob.x = pk2(y.x, y.y); ob.y = pk2(y.z, y.w);
                    *(u32x2*)(GRP + t * D + GW + ch) = ob;
                }
            }
        }
    }
    __syncthreads();
}

__device__ __forceinline__ void phase_mlstm_local(const Params& P, int l, unsigned char* smem, int wv, int bid, int nb) {
    PIN_S(bid); PIN_S(nb);
    ParamsPtr pp = PARAMS_PTR(P); PIN_S(pp); unsigned char* ws = pp->ws;
    const bf16_t* KT = (const bf16_t*)(ws + O_KT); const bf16_t* VT = (const bf16_t*)(ws + O_VT);
    const float* IG = (const float*)(ws + O_IG); const float* LF = (const float*)(ws + O_LF);
    float* CL = (float*)(ws + O_CL); float* NLb = (float*)(ws + O_NL); float* ML = (float*)(ws + O_ML); float* BL = (float*)(ws + O_BL);
    float* GVT = (float*)(ws + O_GVT); float* PMX = (float*)(ws + O_PMX); float* BCT = (float*)(ws + O_BCT);
    const int tid = phase_tid(wv), lane = tid & 63, wave = tid >> 6, col = lane & 15, g = lane >> 4;
    float* wts = (float*)smem + wave * 128;
    for (int u = bid * NWAVES + wave; u < 2 * NB * MH * NCH; u += nb * NWAVES) {
        const int c = u % NCH, h = (u / NCH) % MH, p = u / (NCH * MH), d = p / NB, b = p % NB;
        const int tc = d ? NCH - 1 - c : c, tok0 = b * S + tc * CH;
        const int i0 = d ? 127 - 2 * lane : 2 * lane, i1 = d ? i0 - 1 : i0 + 1;
        const size_t g0 = ((size_t)d * T + tok0 + i0) * MH + h, g1 = ((size_t)d * T + tok0 + i1) * MH + h;
        const float lf0 = LF[g0], lf1 = LF[g1], ig0 = IG[g0], ig1 = IG[g1];
        const float c1 = lf0 + lf1;
        float incl = c1;
#pragma unroll
        for (int o = 1; o < 64; o <<= 1) { const float tq = SHUP(incl, o, lane); if (lane >= o) incl += tq; }
        const float excl = incl - c1, bc0 = excl + lf0, bc1 = incl;
        const float blast = RDL(incl, 63);
        const float gv0 = ig0 - bc0, gv1 = ig1 - bc1, pl1 = fmaxf(gv0, gv1);
        float mincl = pl1;
#pragma unroll
        for (int o = 1; o < 64; o <<= 1) { const float tq = SHUP(mincl, o, lane); if (lane >= o) mincl = fmaxf(mincl, tq); }
        float mexcl = SHUP(mincl, 1, lane); if (lane == 0) mexcl = -INFINITY;
        const float pm0 = fmaxf(mexcl, gv0), pm1 = mincl;
        const float mloc = blast + RDL(mincl, 63);
        WAVE_SYNC();
        wts[i0] = fexp(blast + gv0 - mloc); wts[i1] = fexp(blast + gv1 - mloc);
        GVT[g0] = gv0; GVT[g1] = gv1; PMX[g0] = pm0; PMX[g1] = pm1; BCT[g0] = bc0; BCT[g1] = bc1;
        if (lane == 0) { ML[u] = mloc; BL[u] = blast; }
        WAVE_SYNC();
        const bf16_t* vbase = VT + ((size_t)(b * MH + h) * 64) * S + (size_t)tc * CH;
        const bf16_t* kbase = KT + ((size_t)(b * MH + h) * 64) * S + (size_t)tc * CH;
        const unsigned loff = (unsigned)(col * S + 8 * g);
        f32x4 acc[4][4];
#pragma unroll
        for (int a_ = 0; a_ < 4; ++a_)
#pragma unroll
            for (int b_ = 0; b_ < 4; ++b_) acc[a_][b_] = (f32x4){0.f, 0.f, 0.f, 0.f};
        float nsum[4] = {0.f, 0.f, 0.f, 0.f};
#pragma unroll 1
        for (int ks = 0; ks < 4; ++ks) {
            const int ii = ks * 32 + 8 * g;
            const f32x4 w0 = *(const f32x4*)(wts + ii), w1 = *(const f32x4*)(wts + ii + 4);
            bf16x8 af[4], bfk[4];
#pragma unroll
            for (int q = 0; q < 4; ++q) af[q] = *(const bf16x8*)(vbase + ((size_t)q * 16 * S + ks * 32) + loff);
#pragma unroll
            for (int q = 0; q < 4; ++q) {
                const u32x4 kr = *(const u32x4*)(kbase + ((size_t)q * 16 * S + ks * 32) + loff);
                f32x4 k0, k1;
                k0.x = bf_lo(kr.x) * w0.x; k0.y = bf_hi(kr.x) * w0.y; k0.z = bf_lo(kr.y) * w0.z; k0.w = bf_hi(kr.y) * w0.w;
                k1.x = bf_lo(kr.z) * w1.x; k1.y = bf_hi(kr.z) * w1.y; k1.z = bf_lo(kr.w) * w1.z; k1.w = bf_hi(kr.w) * w1.w;
                nsum[q] += (k0.x + k0.y) + (k0.z + k0.w) + (k1.x + k1.y) + (k1.z + k1.w);
                bfk[q] = cvt8(k0, k1);
            }
#pragma unroll
            for (int a_ = 0; a_ < 4; ++a_)
#pragma unroll
                for (int b_ = 0; b_ < 4; ++b_) acc[a_][b_] = MFMA16(af[a_], bfk[b_], acc[a_][b_]);
        }
        float* cbase = CL + (size_t)u * 4096;
        const unsigned coff = (unsigned)(4 * g * 64 + col);
#pragma unroll
        for (int b_ = 0; b_ < 4; ++b_) {
#pragma unroll
            for (int a_ = 0; a_ < 4; ++a_)
#pragma unroll
                for (int r = 0; r < 4; ++r) cbase[(a_ * 16 * 64 + r * 64 + b_ * 16) + coff] = acc[a_][b_][r];
            float ns = nsum[b_]; ns += SHX(ns, 16, lane); ns += SHX(ns, 32, lane);
            if (g == 0) NLb[(size_t)u * 64 + b_ * 16 + col] = ns;
        }
    }
    __syncthreads();
}

__device__ __forceinline__ void phase_mlstm_carry(const Params& P, int l, unsigned char* smem, int wv, int bidx, int gdim) {
    ParamsPtr pp = PARAMS_PTR(P); PIN_S(pp); unsigned char* ws = pp->ws; PIN_S(bidx); PIN_S(gdim);
    float* CL = (float*)(ws + O_CL); float* NLb = (float*)(ws + O_NL); const float* ML = (const float*)(ws + O_ML); const float* BL = (const float*)(ws + O_BL);
    float* MIN = (float*)(ws + O_MIN);
    const int total = 2 * NB * MH * 4160;
    const int tid = phase_tid(wv);
    for (int gi = bidx * NTHREADS + tid; gi < total; gi += gdim * NTHREADS) {
        const int ph = gi / 4160, e = gi % 4160;
        float* base_ = e < 4096 ? CL + (size_t)ph * NCH * 4096 + e : NLb + (size_t)ph * NCH * 64 + (e - 4096);
        bf16_t* cb_ = (bf16_t*)(ws + O_CLB) + (size_t)ph * NCH * 4096 + e;
        const int stride = e < 4096 ? 4096 : 64;
        static_assert(NCH <= 32, "carry scan keeps one chunk value per register");
        float loc[NCH], bl[NCH], ml[NCH];
#pragma unroll
        for (int c = 0; c < NCH; ++c) { loc[c] = base_[(size_t)c * stride]; bl[c] = BL[ph * NCH + c]; ml[c] = ML[ph * NCH + c]; }
        float m = 0.f, val = 0.f;
#pragma unroll
        for (int c = 0; c < NCH; ++c) {
            if (e < 4096) cb_[(size_t)c * 4096] = (bf16_t)f2bf(val); else base_[(size_t)c * stride] = val;
            if (e == 0) MIN[ph * NCH + c] = m;
            const float mn = fmaxf(bl[c] + m, ml[c]);
            val = fexp(bl[c] + m - mn) * val + fexp(ml[c] - mn) * loc[c];
            m = mn;
        }
    }
}

__device__ __forceinline__ void phase_mlstm_out(const Params& P, int l, unsigned char* smem, int wv) {
    ParamsPtr pp = PARAMS_PTR(P); PIN_S(pp); unsigned char* ws = pp->ws; int bidx = (int)blockIdx.x, gdim = (int)gridDim.x; PIN_S(bidx); PIN_S(gdim);
    const bf16_t* proj = (const bf16_t*)(ws + O_PROJ);
    const bf16_t* MQB = (const bf16_t*)(ws + O_MQB); const bf16_t* MKB = (const bf16_t*)(ws + O_MKB); const bf16_t* VT = (const bf16_t*)(ws + O_VT);
    const float* GVT = (const float*)(ws + O_GVT); const float* PMX = (const float*)(ws + O_PMX); const float* BCT = (const float*)(ws + O_BCT);
    const bf16_t* CLB = (const bf16_t*)(ws + O_CLB); const float* NLb = (const float*)(ws + O_NL); const float* MIN = (const float*)(ws + O_MIN);
    bf16_t* GRP = (bf16_t*)(ws + O_GRP);
    const float* mln_g = pp->in[20] + (size_t)l * MW;
    const int tid = phase_tid(wv), lane = tid & 63, wave = tid >> 6, col = lane & 15, g = lane >> 4;
    constexpr int KP = 72, VP = 136, STG = 128 * KP * 2 + 64 * VP * 2 + 2 * 128 * 4;
    constexpr int NUm = NB * MH * NCH;
    const int it = wave * 16 + col;
    u32x4 kb_[2], vb_[2]; float gq_ = 0.f; bf16x8 bqn[2]; float minn[2], pmxn[2], bctn[2];
#define MO_EARLY(u_) do { const int tc_ = (u_) % NCH, h_ = ((u_) / NCH) % MH, b_ = (u_) / (NCH * MH); const int tok0_ = b_ * S + tc_ * CH; \
        _Pragma("unroll") for (int q = 0; q < 2; ++q) { const int idx = tid + q * NTHREADS; \
            kb_[q] = *(const u32x4*)(MKB + (size_t)(tok0_ + (idx >> 3)) * MW + h_ * 64 + (idx & 7) * 8); \
            vb_[q] = *(const u32x4*)(VT + ((size_t)(b_ * MH + h_) * 64 + (idx >> 4)) * S + (size_t)tc_ * CH + (idx & 15) * 8); } \
        if (tid < 256) gq_ = GVT[((size_t)(tid >> 7) * T + tok0_ + (tid & 127)) * MH + h_]; \
        const size_t trow_ = (size_t)(tok0_ + it); \
        _Pragma("unroll") for (int ks = 0; ks < 2; ++ks) bqn[ks] = *(const bf16x8*)(MQB + trow_ * MW + h_ * 64 + ks * 32 + 8 * g); \
        _Pragma("unroll") for (int d = 0; d < 2; ++d) { const int su_ = ((d * NB + b_) * MH + h_) * NCH + (d ? NCH - 1 - tc_ : tc_); const size_t gt_ = ((size_t)d * T + trow_) * MH + h_; \
            minn[d] = MIN[su_]; pmxn[d] = PMX[gt_]; bctn[d] = BCT[gt_]; } } while (0)
    int u = bidx, ui = 0;
    if (u < NUm) MO_EARLY(u);
    for (; u < NUm; u += gdim, ++ui) {
        const int tc = u % NCH, h = (u / NCH) % MH, b = u / (NCH * MH);
        const int tok0 = b * S + tc * CH;
        bf16_t* Ks = (bf16_t*)(smem + (ui & 1) * STG);
        bf16_t* Vs = Ks + 128 * KP;
        float* gvs_ = (float*)(Vs + 64 * VP);
#pragma unroll
        for (int q = 0; q < 2; ++q) {
            const int idx = tid + q * NTHREADS;
            *(u32x4*)(Ks + (idx >> 3) * KP + (idx & 7) * 8) = kb_[q];
            *(u32x4*)(Vs + (idx >> 4) * VP + (idx & 15) * 8) = vb_[q];
        }
        if (tid < 256) gvs_[tid] = gq_;
        bf16x8 bq[2] = {bqn[0], bqn[1]};
        const float mst_[2] = {minn[0], minn[1]}, pmx_[2] = {pmxn[0], pmxn[1]}, bct_[2] = {bctn[0], bctn[1]};
        const size_t trow = (size_t)(tok0 + it);
        bf16x8 cq[2][4][2]; f32x4 nl[2][2][2]; u32x2 og[4];
#define MO_LATE(d) do { const int su = (((d) * NB + b) * MH + h) * NCH + ((d) ? NCH - 1 - tc : tc); \
            _Pragma("unroll") for (int ks = 0; ks < 2; ++ks) { const float* np = NLb + (size_t)su * 64 + ks * 32 + 8 * g; \
                nl[d][ks][0] = *(const f32x4*)np; nl[d][ks][1] = *(const f32x4*)(np + 4); \
                _Pragma("unroll") for (int et = 0; et < 4; ++et) cq[d][et][ks] = *(const bf16x8*)(CLB + (size_t)su * 4096 + (size_t)(et * 16 + col) * 64 + ks * 32 + 8 * g); } } while (0)
        MO_LATE(0);
#pragma unroll
        for (int et = 0; et < 4; ++et) og[et] = *(const u32x2*)(proj + trow * PLD + C_MW + 3 * MW + h * 64 + et * 16 + 4 * g);
        __syncthreads();
        if (u + gdim < NUm) MO_EARLY(u + gdim);
        f32x4 hs[4];
#pragma unroll
        for (int et = 0; et < 4; ++et) hs[et] = (f32x4){0.f, 0.f, 0.f, 0.f};
#pragma unroll
        for (int d = 0; d < 2; ++d) {
            if (d == 1) MO_LATE(1);
            const float mst = mst_[d];
            const float mxt = fmaxf(pmx_[d], mst), mt = bct_[d] + mxt, wint = fexp(mst - mxt);
            f32x4 num[4];
#pragma unroll
            for (int et = 0; et < 4; ++et) num[et] = (f32x4){0.f, 0.f, 0.f, 0.f};
            float den = 0.f;
            for (int sp = 0; sp < 4; ++sp) {
                if (d == 0 ? (2 * sp > wave) : (2 * sp + 1 < wave)) continue;
                float pw[8];
#pragma unroll
                for (int hf = 0; hf < 2; ++hf) {
                    const int st = 2 * sp + hf;
                    f32x4 sacc = (f32x4){0.f, 0.f, 0.f, 0.f};
#pragma unroll
                    for (int ks = 0; ks < 2; ++ks) sacc = MFMA16(*(const bf16x8*)(Ks + (st * 16 + col) * KP + ks * 32 + 8 * g), bq[ks], sacc);
                    const f32x4 g4 = *(const f32x4*)(gvs_ + d * 128 + st * 16 + 4 * g);
#pragma unroll
                    for (int r = 0; r < 4; ++r) {
                        const int is = st * 16 + 4 * g + r;
                        const bool ok = d == 0 ? (is <= it) : (is >= it);
                        const float pr = ok ? sacc[r] * fexp(g4[r] - mxt) : 0.f;
                        den += pr; pw[hf * 4 + r] = pr;
                    }
                }
                u32x4 pb; pb.x = pk2(pw[0], pw[1]); pb.y = pk2(pw[2], pw[3]); pb.z = pk2(pw[4], pw[5]); pb.w = pk2(pw[6], pw[7]);
                const bf16x8 bp = __builtin_bit_cast(bf16x8, pb);
#pragma unroll
                for (int et = 0; et < 4; ++et) {
                    const bf16_t* vp = Vs + (et * 16 + col) * VP + sp * 32 + 4 * g;
                    const u32x2 v0 = *(const u32x2*)vp, v1 = *(const u32x2*)(vp + 16);
                    u32x4 va; va.x = v0.x; va.y = v0.y; va.z = v1.x; va.w = v1.y;
                    num[et] = MFMA16(__builtin_bit_cast(bf16x8, va), bp, num[et]);
                }
            }
            den += SHX(den, 16, lane); den += SHX(den, 32, lane);
            f32x4 qc[4]; float qn = 0.f;
#pragma unroll
            for (int ks = 0; ks < 2; ++ks) {
                const f32x4 n0 = nl[d][ks][0], n1 = nl[d][ks][1];
                const u32x4 qb = __builtin_bit_cast(u32x4, bq[ks]);
                qn += (bf_lo(qb.x) * n0.x + bf_hi(qb.x) * n0.y) + (bf_lo(qb.y) * n0.z + bf_hi(qb.y) * n0.w) + (bf_lo(qb.z) * n1.x + bf_hi(qb.z) * n1.y) + (bf_lo(qb.w) * n1.z + bf_hi(qb.w) * n1.w);
            }
            qn += SHX(qn, 16, lane); qn += SHX(qn, 32, lane);
#pragma unroll
            for (int et = 0; et < 4; ++et) {
                qc[et] = (f32x4){0.f, 0.f, 0.f, 0.f};
#pragma unroll
                for (int ks = 0; ks < 2; ++ks) qc[et] = MFMA16(cq[d][et][ks], bq[ks], qc[et]);
            }
            const float dd = frcp(fmaxf(fabsf(den + wint * qn), fexp(-mt)));
#pragma unroll
            for (int et = 0; et < 4; ++et) hs[et] += (num[et] + wint * qc[et]) * dd;
        }
        float sm = 0.f;
#pragma unroll
        for (int et = 0; et < 4; ++et) sm += (hs[et].x + hs[et].y) + (hs[et].z + hs[et].w);
        sm += SHX(sm, 16, lane); sm += SHX(sm, 32, lane);
        const float mean = sm * (1.0f / 64.0f); float q = 0.f;
#pragma unroll
        for (int et = 0; et < 4; ++et) { const f32x4 dl = hs[et] - mean; q += (dl.x * dl.x + dl.y * dl.y) + (dl.z * dl.z + dl.w * dl.w); }
        q += SHX(q, 16, lane); q += SHX(q, 32, lane);
        const float rstd = 1.0f / sqrtf(q * (1.0f / 64.0f) + LN_EPS);
#pragma unroll
        for (int et = 0; et < 4; ++et) {
            const int c = h * 64 + et * 16 + 4 * g;
            const u32x2 ob_ = og[et]; const f32x4 o4 = (f32x4){bf_lo(ob_.x), bf_hi(ob_.x), bf_lo(ob_.y), bf_hi(ob_.y)}, g4 = *(const f32x4*)(mln_g + c);
            const f32x4 y = (hs[et] - mean) * rstd * g4;
            u32x2 ob; ob.x = pk2(sigmoidf_(o4.x) * y.x, sigmoidf_(o4.y) * y.y); ob.y = pk2(sigmoidf_(o4.z) * y.z, sigmoidf_(o4.w) * y.w);
            *(u32x2*)(GRP + trow * D + GW + RW + c) = ob;
        }
    }
#undef MO_EARLY
#undef MO_LATE
    __syncthreads();
}

__device__ __forceinline__ void phase_rwkv_post(const Params& P, int l, unsigned char* smem, int wv) {
    ParamsPtr pp = PARAMS_PTR(P); PIN_S(pp); unsigned char* ws = pp->ws; int bidx = (int)blockIdx.x, gdim = (int)gridDim.x; PIN_S(bidx); PIN_S(gdim);
    const float* SCAN = (const float*)(ws + O_SCAN); const float* VV = (const float*)(ws + O_VV); const float* GATE = (const float*)(ws + O_GATE);
    const float* BONUS = (const float*)(ws + O_BONUS); bf16_t* GRP = (bf16_t*)(ws + O_GRP);
    const float* rln_g = pp->in[15] + (size_t)l * RW; const float* rln_b = pp->in[16] + (size_t)l * RW;
    const int tid = phase_tid(wv), lane = tid & 63, wave = tid >> 6;
    const int gw = bidx * NWAVES + wave, ngw = NWAVES * gdim;
    for (int it = gw; it < T * RH; it += ngw) {
        const int t = it / RH, h = it % RH, c = h * 64 + lane;
        const size_t o = (size_t)t * RW + c;
        const float x = SCAN[o] + SCAN[(size_t)T * RW + o];
        const float mean = wave_sum(x, lane) * (1.0f / 64.0f);
        const float dl = x - mean;
        const float var = wave_sum(dl * dl, lane) * (1.0f / 64.0f);
        float y = dl / sqrtf(var + GN_EPS) * rln_g[c] + rln_b[c];
        y += BONUS[(size_t)t * RH + h] * VV[o];
        GRP[(size_t)t * D + GW + c] = (bf16_t)f2bf(y * GATE[o]);
    }
}

__device__ __forceinline__ void phase_ln1_router(const Params& P, int l, unsigned char* smem, int wv) {
    ParamsPtr pp = PARAMS_PTR(P); PIN_S(pp); unsigned char* ws = pp->ws; int bidx = (int)blockIdx.x, gdim = (int)gridDim.x; PIN_S(bidx); PIN_S(gdim);
    const bf16_t* xin = (const bf16_t*)(ws + O_XB);
    const bf16_t* MIX = (const bf16_t*)(ws + O_MIX);
    int* TOPI = (int*)(ws + O_TOPI); float* TOPG = (float*)(ws + O_TOPG); int* RANK = (int*)(ws + O_RANK); bf16_t* X1B = (bf16_t*)(ws + O_X1B);
    int* BCNT = (int*)(ws + O_BCNT);
    const float* g1 = pp->in[22] + (size_t)l * D; const float* b1 = pp->in[23] + (size_t)l * D;
    const float* rw = pp->in[24] + (size_t)l * D * NE; const float* rb = pp->in[25] + (size_t)l * NE;
    const bf16_t* RWT = (const bf16_t*)(ws + O_RWT) + (size_t)l * 2 * NE * D;
    const int tid = phase_tid(wv), lane = tid & 63, wave = tid >> 6, col = lane & 15, g = lane >> 4;
    float* lgs = (float*)smem;
    int* stopi = (int*)(smem + 8704);
    constexpr int XHP = D + 8;
    bf16_t* XH = (bf16_t*)(smem + 16384);
    for (int tile = bidx; tile < T / 64; tile += gdim) {
        __syncthreads();
        {
            u32x2 xa[8][4], xm[8][4];
#pragma unroll
            for (int ti8 = 0; ti8 < 8; ++ti8) {
                const size_t tt_ = (size_t)(tile * 64 + wave * 8 + ti8);
#pragma unroll
                for (int j = 0; j < 4; ++j) { const int c = j * 256 + lane * 4; xa[ti8][j] = *(const u32x2*)(xin + tt_ * D + c); xm[ti8][j] = *(const u32x2*)(MIX + tt_ * D + c); }
            }
            f32x4 gg[4], bb[4];
#pragma unroll
            for (int j = 0; j < 4; ++j) { const int c = j * 256 + lane * 4; gg[j] = *(const f32x4*)(g1 + c); bb[j] = *(const f32x4*)(b1 + c); }
#pragma unroll
            for (int ti8 = 0; ti8 < 8; ++ti8) {
                const int t = tile * 64 + wave * 8 + ti8;
                float v[16]; float sm = 0.f;
#pragma unroll
                for (int j = 0; j < 4; ++j) {
                    v[j * 4 + 0] = ALPHA * bf_lo(xa[ti8][j].x) + bf_lo(xm[ti8][j].x); v[j * 4 + 1] = ALPHA * bf_hi(xa[ti8][j].x) + bf_hi(xm[ti8][j].x);
                    v[j * 4 + 2] = ALPHA * bf_lo(xa[ti8][j].y) + bf_lo(xm[ti8][j].y); v[j * 4 + 3] = ALPHA * bf_hi(xa[ti8][j].y) + bf_hi(xm[ti8][j].y);
                    sm += (v[j * 4] + v[j * 4 + 1]) + (v[j * 4 + 2] + v[j * 4 + 3]);
                }
                const float mean = wave_sum_fast(sm, lane) * (1.0f / D); float q = 0.f;
#pragma unroll
                for (int j = 0; j < 16; ++j) { const float dl = v[j] - mean; q += dl * dl; }
                const float rstd = 1.0f / sqrtf(wave_sum_fast(q, lane) * (1.0f / D) + LN_EPS);
#pragma unroll
                for (int j = 0; j < 4; ++j) {
                    const int c = j * 256 + lane * 4;
                    f32x4 o;
                    o.x = (v[j * 4 + 0] - mean) * rstd * gg[j].x + bb[j].x; o.y = (v[j * 4 + 1] - mean) * rstd * gg[j].y + bb[j].y;
                    o.z = (v[j * 4 + 2] - mean) * rstd * gg[j].z + bb[j].z; o.w = (v[j * 4 + 3] - mean) * rstd * gg[j].w + bb[j].w;
                    u32x2 ob; ob.x = pk2(o.x, o.y); ob.y = pk2(o.z, o.w); *(u32x2*)(X1B + (size_t)t * D + c) = ob;
                    *(u32x2*)(XH + (wave * 8 + ti8) * XHP + c) = ob;
                }
            }
        }
        __syncthreads();
        {
            const bf16_t* xr = XH + ((wave >> 1) * 16 + col) * XHP + 8 * g;
            const bf16_t* wh = RWT + (size_t)((wave & 1) * 16 + col) * D + 8 * g; const bf16_t* wl = wh + (size_t)NE * D;
            f32x4 acc = (f32x4){0.f, 0.f, 0.f, 0.f};
#pragma unroll 8
            for (int ks = 0; ks < 32; ++ks) {
                const bf16x8 ah = *(const bf16x8*)(xr + ks * 32);
                const bf16x8 bh = *(const bf16x8*)(wh + ks * 32), bl = *(const bf16x8*)(wl + ks * 32);
                acc = MFMA16(ah, bh, acc); acc = MFMA16(ah, bl, acc);
            }
            const float rbv = rb[(wave & 1) * 16 + col];
#pragma unroll
            for (int r = 0; r < 4; ++r) lgs[((wave >> 1) * 16 + 4 * g + r) * (NE + 1) + (wave & 1) * 16 + col] = acc[r] + rbv;
        }
        __syncthreads();
        if (tid < 64) {
            const float* lp = lgs + tid * (NE + 1); const int t = tile * 64 + tid;
            float tv[4]; int ti[4];
#pragma unroll
            for (int k = 0; k < 4; ++k) { tv[k] = -INFINITY; ti[k] = 0; }
            for (int e = 0; e < NE; ++e) {
                const float x = lp[e];
                if (x > tv[3]) {
                    if (x > tv[0]) { tv[3] = tv[2]; ti[3] = ti[2]; tv[2] = tv[1]; ti[2] = ti[1]; tv[1] = tv[0]; ti[1] = ti[0]; tv[0] = x; ti[0] = e; }
                    else if (x > tv[1]) { tv[3] = tv[2]; ti[3] = ti[2]; tv[2] = tv[1]; ti[2] = ti[1]; tv[1] = x; ti[1] = e; }
                    else if (x > tv[2]) { tv[3] = tv[2]; ti[3] = ti[2]; tv[2] = x; ti[2] = e; }
                    else { tv[3] = x; ti[3] = e; }
                }
            }
            const float e1 = expf(tv[1] - tv[0]), e2 = expf(tv[2] - tv[0]), e3 = expf(tv[3] - tv[0]);
            const float inv = 1.0f / (1.0f + e1 + e2 + e3);
            *(f32x4*)(TOPG + (size_t)t * 4) = (f32x4){inv, e1 * inv, e2 * inv, e3 * inv};
#pragma unroll
            for (int k = 0; k < 4; ++k) { TOPI[(size_t)t * 4 + k] = ti[k]; stopi[tid * 4 + k] = ti[k]; }
        }
        __syncthreads();
        int* wcnt = stopi + 256;
        int rk = 0, ex = 0;
        if (wave < 4) {
            ex = stopi[tid]; int mycnt = 0;
            for (int x = 0; x < NE; ++x) { const unsigned long long m = __ballot(ex == x); if (ex == x) rk = __popcll(m & ((1ull << lane) - 1ull)); if (lane == x) mycnt = __popcll(m); }
            if (lane < NE) wcnt[wave * NE + lane] = mycnt;
        }
        __syncthreads();
        if (wave < 4) { for (int w2 = 0; w2 < wave; ++w2) rk += wcnt[w2 * NE + ex]; RANK[(size_t)tile * 256 + tid] = rk; }
        else if (tid < 256 + NE) { const int e = tid - 256; BCNT[tile * NE + e] = (wcnt[e] + wcnt[NE + e]) + (wcnt[2 * NE + e] + wcnt[3 * NE + e]); }
    }
    __syncthreads();
}

__device__ __forceinline__ void moe_offsets(int* sh, const int* CNT, int tid) {
    if (tid == 0) {
        int acc = 0;
        for (int e = 0; e < NE; ++e) { const int c = (int)CNT[e]; sh[e] = c; sh[32 + e] = acc; acc += (c + MOEB - 1) / MOEB * MOEB; sh[64 + e] = acc; }
    }
    __syncthreads();
}
__device__ __forceinline__ int moe_expert_of_row(const int* sh, int r) {
    int e = -1;
    for (int i = 0; i < NE; ++i) if (r >= sh[32 + i] && r < sh[64 + i]) e = i;
    return e;
}

__device__ __forceinline__ void phase_scatter(const Params& P, int l, unsigned char* smem, int wv) {
    ParamsPtr pp = PARAMS_PTR(P); PIN_S(pp); unsigned char* ws = pp->ws; int bidx = (int)blockIdx.x, gdim = (int)gridDim.x; PIN_S(bidx); PIN_S(gdim);
    const int tid = phase_tid(wv);
    const int* TOPI = (const int*)(ws + O_TOPI); const int* RANK = (const int*)(ws + O_RANK); int* SLOT = (int*)(ws + O_SLOT); int* ROWT = (int*)(ws + O_ROWT);
    const int* BCNT = (const int*)(ws + O_BCNT); int* CNTF = (int*)(ws + O_CNTF);
    int* sh = (int*)smem;
    int* part = sh + 96;
    int* tot = part + 512;
    int* base = tot + 32;
    constexpr int NT = T / 64;
    const int e = tid & 31, pt = tid >> 5;
    { int sacc = 0; for (int tl = pt; tl < NT; tl += 16) sacc += BCNT[tl * NE + e]; part[pt * 32 + e] = sacc; }
    __syncthreads();
    if (tid < 32) { int sacc = 0; for (int q = 0; q < 16; ++q) sacc += part[q * 32 + tid]; tot[tid] = sacc; if (bidx == 0) CNTF[tid] = sacc; }
    __syncthreads();
    moe_offsets(sh, tot, tid);
    for (int ee = bidx; ee < NE; ee += gdim)
        for (int r = sh[32 + ee] + sh[ee] + tid; r < sh[64 + ee]; r += NTHREADS) ROWT[r] = 0;
    for (int tile = bidx; tile < NT; tile += gdim) {
        __syncthreads();
        { int sacc = 0; for (int tl = pt; tl < tile; tl += 16) sacc += BCNT[tl * NE + e]; part[pt * 32 + e] = sacc; }
        __syncthreads();
        if (tid < 32) { int sacc = sh[32 + tid]; for (int q = 0; q < 16; ++q) sacc += part[q * 32 + tid]; base[tid] = sacc; }
        __syncthreads();
        if (tid < 256) { const int a = tile * 256 + tid, dest = base[TOPI[a]] + RANK[a]; SLOT[a] = dest; ROWT[dest] = a >> 2; }
    }
    __syncthreads();
}

template <int WHICH>
__device__ __forceinline__ void phase_moe_gemm(const Params& P, int l, unsigned char* smem, int wv) {
    ParamsPtr pp = PARAMS_PTR(P); PIN_S(pp); unsigned char* ws = pp->ws; int bidx = (int)blockIdx.x, gdim = (int)gridDim.x; PIN_S(bidx); PIN_S(gdim);
    const int tid = phase_tid(wv);
    const int* CNT = (const int*)(ws + O_CNTF);
    int* sh = (int*)(smem + 131072);
    int* rbe = sh + 96;
    moe_offsets(sh, CNT, tid);
    const int nrb = sh[64 + NE - 1] / MOEB;
    for (int rb = tid; rb < nrb; rb += NTHREADS) rbe[rb] = moe_expert_of_row(sh, rb * MOEB);
    __syncthreads();
    pg8::MoeOrderT<WHICH == 1> S;
    S.K = 1024; S.G_ = gdim; S.c = bidx; S.rbe = rbe; S.rowmap = (const int*)(ws + O_ROWT);
    if (WHICH == 1) {
        S.A = (const char*)(ws + O_X1B); S.Wt = (const char*)(ws + O_W1) + (size_t)l * NE * 2 * DFF * D * 2; S.estride = (size_t)2 * DFF * D * 2; S.nN = 2 * DFF / 256; S.nwg = nrb * S.nN;
        pg8::EpiSwiglu E{(bf16_t*)(ws + O_ACT), pp->in[27] + (size_t)l * NE * 2 * DFF};
        pg8::gemm_phase<pg8::EpiSwiglu, pg8::MoeOrderT<WHICH == 1>>((LAS unsigned char*)smem, 1024, S, E, tid);
    } else {
        S.A = (const char*)(ws + O_ACT); S.Wt = (const char*)(ws + O_W2) + (size_t)l * NE * D * DFF * 2; S.estride = (size_t)D * DFF * 2; S.nN = D / 256; S.nwg = nrb * S.nN;
        pg8::EpiBf16Bias E{(bf16_t*)(ws + O_YS), D, pp->in[29] + (size_t)l * NE * D, D};
        pg8::gemm_phase<pg8::EpiBf16Bias, pg8::MoeOrderT<WHICH == 1>>((LAS unsigned char*)smem, 1024, S, E, tid);
    }
    __syncthreads();
}

constexpr size_t CTL_RBC = 65536;
__device__ __forceinline__ void phase_moe_merged(const Params& P, int l, unsigned char* smem, int wv) {
    ParamsPtr pp = PARAMS_PTR(P); PIN_S(pp); unsigned char* ws = pp->ws; int bidx = (int)blockIdx.x, gdim = (int)gridDim.x; PIN_S(bidx); PIN_S(gdim);
    const int tid = phase_tid(wv);
    const int* CNT = (const int*)(ws + O_CNTF);
    int* sh = (int*)(smem + 131072);
    int* rbe = sh + 96;
    moe_offsets(sh, CNT, tid);
    const int nrb = sh[64 + NE - 1] / MOEB;
    for (int rb = tid; rb < nrb; rb += NTHREADS) rbe[rb] = moe_expert_of_row(sh, rb * MOEB);
    __syncthreads();
    static_assert(NROWS / 256 <= 512 && DFF == 1024 && D == 1024, "merged expert GEMMs: both K = 1024, at most 512 row blocks");
    pg8::MoeMerged S;
    S.K = 1024; S.G_ = gdim; S.c = bidx; S.rbe = rbe; S.rowmap = (const int*)(ws + O_ROWT); S.nrb = nrb;
    S.A1 = (const char*)(ws + O_X1B); S.A2 = (const char*)(ws + O_ACT);
    S.W1t = (const char*)(ws + O_W1) + (size_t)l * NE * 2 * DFF * D * 2; S.es1 = (size_t)2 * DFF * D * 2;
    S.W2t = (const char*)(ws + O_W2) + (size_t)l * NE * D * DFF * 2; S.es2 = (size_t)D * DFF * 2;
    S.cnt = (unsigned*)(ws + CTL_RBC) + l * 512;
    pg8::EpiMoe E{(bf16_t*)(ws + O_ACT), pp->in[27] + (size_t)l * NE * 2 * DFF, (bf16_t*)(ws + O_YS), pp->in[29] + (size_t)l * NE * D, (unsigned)((size_t)NROWS * DFF * 2)};
    pg8::gemm_phase<pg8::EpiMoe, pg8::MoeMerged>((LAS unsigned char*)smem, 1024, S, E, tid);
    __syncthreads();
}

__device__ __forceinline__ void phase_combine_ln2(const Params& P, int l, unsigned char* smem, int wv) {
    ParamsPtr pp = PARAMS_PTR(P); PIN_S(pp); unsigned char* ws = pp->ws; int bidx = (int)blockIdx.x, gdim = (int)gridDim.x; PIN_S(bidx); PIN_S(gdim);
    const bf16_t* X1 = (const bf16_t*)(ws + O_X1B); const bf16_t* YS = (const bf16_t*)(ws + O_YS); bf16_t* XB = (bf16_t*)(ws + O_XB);
    const int* SLOT = (const int*)(ws + O_SLOT); const float* TOPG = (const float*)(ws + O_TOPG);
    float* xo = pp->out;
    const float* g2 = pp->in[30] + (size_t)l * D; const float* b2 = pp->in[31] + (size_t)l * D;
    const int tid = phase_tid(wv), lane = tid & 63, wave = tid >> 6;
    const int gw = bidx * NWAVES + wave, ngw = NWAVES * gdim;
    u32x4 sl_n = (u32x4){0u, 0u, 0u, 0u}; f32x4 gg_n = (f32x4){0.f, 0.f, 0.f, 0.f};
    u32x2 xa_n[4]; u32x2 ys_n[4][4]; f32x4 gg_c = (f32x4){0.f, 0.f, 0.f, 0.f};
    const f32x4 lg[4] = {*(const f32x4*)(g2 + lane * 4), *(const f32x4*)(g2 + 256 + lane * 4), *(const f32x4*)(g2 + 512 + lane * 4), *(const f32x4*)(g2 + 768 + lane * 4)};
    const f32x4 lb[4] = {*(const f32x4*)(b2 + lane * 4), *(const f32x4*)(b2 + 256 + lane * 4), *(const f32x4*)(b2 + 512 + lane * 4), *(const f32x4*)(b2 + 768 + lane * 4)};
#define CB_META(tt_) do { sl_n = *(const u32x4*)(SLOT + (size_t)(tt_) * 4); gg_n = *(const f32x4*)(TOPG + (size_t)(tt_) * 4); } while (0)
#define CB_ROWS(tt_) do { _Pragma("unroll") for (int j = 0; j < 4; ++j) { const int c = j * 256 + lane * 4; xa_n[j] = *(const u32x2*)(X1 + (size_t)(tt_) * D + c); \
        ys_n[0][j] = *(const u32x2*)(YS + (size_t)sl_n.x * D + c); ys_n[1][j] = *(const u32x2*)(YS + (size_t)sl_n.y * D + c); ys_n[2][j] = *(const u32x2*)(YS + (size_t)sl_n.z * D + c); ys_n[3][j] = *(const u32x2*)(YS + (size_t)sl_n.w * D + c); } gg_c = gg_n; } while (0)
    if (gw < T) { CB_META(gw); CB_ROWS(gw); if (gw + ngw < T) CB_META(gw + ngw); }
    for (int t = gw; t < T; t += ngw) {
        float v[16]; float sm = 0.f;
        const float gk[4] = {gg_c.x, gg_c.y, gg_c.z, gg_c.w};
#pragma unroll
        for (int j = 0; j < 4; ++j) {
            const f32x4 a = (f32x4){bf_lo(xa_n[j].x), bf_hi(xa_n[j].x), bf_lo(xa_n[j].y), bf_hi(xa_n[j].y)};
            f32x4 y = (f32x4){0.f, 0.f, 0.f, 0.f};
#pragma unroll
            for (int k = 0; k < 4; ++k) { const u32x2 yk = ys_n[k][j]; y.x += gk[k] * bf_lo(yk.x); y.y += gk[k] * bf_hi(yk.x); y.z += gk[k] * bf_lo(yk.y); y.w += gk[k] * bf_hi(yk.y); }
            v[j * 4 + 0] = ALPHA * a.x + y.x; v[j * 4 + 1] = ALPHA * a.y + y.y; v[j * 4 + 2] = ALPHA * a.z + y.z; v[j * 4 + 3] = ALPHA * a.w + y.w;
            sm += (v[j * 4] + v[j * 4 + 1]) + (v[j * 4 + 2] + v[j * 4 + 3]);
        }
        if (t + ngw < T) { CB_ROWS(t + ngw); if (t + 2 * ngw < T) CB_META(t + 2 * ngw); }
        const float mean = wave_sum_fast(sm, lane) * (1.0f / D); float q = 0.f;
#pragma unroll
        for (int j = 0; j < 16; ++j) { const float dl = v[j] - mean; q += dl * dl; }
        const float rstd = 1.0f / sqrtf(wave_sum_fast(q, lane) * (1.0f / D) + LN_EPS);
#pragma unroll
        for (int j = 0; j < 4; ++j) {
            const int c = j * 256 + lane * 4;
            f32x4 o;
            o.x = (v[j * 4 + 0] - mean) * rstd * lg[j].x + lb[j].x; o.y = (v[j * 4 + 1] - mean) * rstd * lg[j].y + lb[j].y;
            o.z = (v[j * 4 + 2] - mean) * rstd * lg[j].z + lb[j].z; o.w = (v[j * 4 + 3] - mean) * rstd * lg[j].w + lb[j].w;
            if (l == NL - 1) *(f32x4*)(xo + (size_t)t * D + c) = o;
            else { u32x2 ob; ob.x = pk2(o.x, o.y); ob.y = pk2(o.z, o.w); *(u32x2*)(XB + (size_t)t * D + c) = ob; }
        }
    }
#undef CB_META
#undef CB_ROWS
}

__device__ __forceinline__ void phase_inproj(const Params& P, int l, unsigned char* smem, int wv) {
    ParamsPtr pp = PARAMS_PTR(P); PIN_S(pp); unsigned char* ws = pp->ws; int bidx = (int)blockIdx.x, gdim = (int)gridDim.x; PIN_S(bidx); PIN_S(gdim);
    const int tid = phase_tid(wv);
    pg8::DenseOrder S; S.init(ws + O_XB, (const bf16_t*)(ws + O_WIN) + (size_t)l * PLD * D, T, PLD, D, gdim, bidx);
    pg8::EpiProj E{(bf16_t*)(ws + O_PROJ), PLD, (float*)(ws + O_PROJG), PLD / 256 - 1};
    pg8::gemm_phase<pg8::EpiProj, pg8::DenseOrder>((LAS unsigned char*)smem, D, S, E, tid);
    __syncthreads();
}
__device__ __forceinline__ void phase_outproj(const Params& P, int l, unsigned char* smem, int wv) {
    ParamsPtr pp = PARAMS_PTR(P); PIN_S(pp); unsigned char* ws = pp->ws; int bidx = (int)blockIdx.x, gdim = (int)gridDim.x; PIN_S(bidx); PIN_S(gdim);
    const int tid = phase_tid(wv);
    pg8::DenseOrder S; S.init(ws + O_GRP, (const bf16_t*)(ws + O_WOUT) + (size_t)l * D * D, T, D, D, gdim, bidx);
    pg8::EpiProj E{(bf16_t*)(ws + O_MIX), D, nullptr, -1};
    pg8::gemm_phase<pg8::EpiProj, pg8::DenseOrder>((LAS unsigned char*)smem, D, S, E, tid);
    __syncthreads();
}

#ifndef EMU
#define XB_TMO      128
#define XB_XCNT(j)  (256  + 64 * (j))
#define XB_XSUB(j)  (1280 + 64 * (j))
#define XB_XGEN(j)  (2304 + 64 * (j))
#define XB_TOP      3328
#define XB_TOPGEN   3392
#define XCD_BAR_WORDS 3456
#define XB_SPIN_CAP (1u << 25)
__device__ __forceinline__ unsigned xb_ld(unsigned* p)              { return __hip_atomic_load(p, __ATOMIC_RELAXED, __HIP_MEMORY_SCOPE_AGENT); }
__device__ __forceinline__ unsigned xb_add(unsigned* p, unsigned v) { return __hip_atomic_fetch_add(p, v, __ATOMIC_RELAXED, __HIP_MEMORY_SCOPE_AGENT); }
__device__ __forceinline__ unsigned xb_xcc_id() { return (unsigned)__builtin_amdgcn_s_getreg((3 << 11) | 20) & 0xFu; }
#define XB_SPIN(cond, bar) do { unsigned _sp = 0; while (cond) { __builtin_amdgcn_s_sleep(1); \
    if ((++_sp & 255u) == 0u) { if (xb_ld(&(bar)[XB_TMO])) break; if (_sp > XB_SPIN_CAP) { atomicAdd(&(bar)[XB_TMO], 1u); break; } } } } while (0)
struct XcdBarrier { unsigned* bar; unsigned x; volatile LAS unsigned* st; };
__device__ __forceinline__ XcdBarrier xcd_barrier_post(unsigned* bar, volatile LAS unsigned* st) {
    XcdBarrier b; b.bar = bar; b.x = xb_xcc_id(); b.st = st;
    if (threadIdx.x == 0) (void)xb_add(&bar[XB_XCNT(b.x)], 1u);
    return b;
}
__device__ __forceinline__ void xcd_barrier_complete(unsigned* bar, unsigned x, unsigned& nloc, unsigned& nx) {
    const unsigned G = gridDim.x * gridDim.y * gridDim.z;
    unsigned sum, cnt, mine, sp = 0u;
    for (;;) {
        sum = 0u; cnt = 0u; mine = 0u;
#pragma unroll
        for (unsigned j = 0; j < 16; ++j) { const unsigned c = xb_ld(&bar[XB_XCNT(j)]); sum += c; cnt += (c > 0u) ? 1u : 0u; mine = (j == x) ? c : mine; }
        if (sum == G) break;
        __builtin_amdgcn_s_sleep(1);
        if ((++sp & 255u) == 0u) { if (xb_ld(&bar[XB_TMO])) break; if (sp > XB_SPIN_CAP) { atomicAdd(&bar[XB_TMO], 1u); break; } }
    }
    nloc = mine > 0u ? mine : 1u; nx = cnt > 0u ? cnt : 1u;
}
__device__ __forceinline__ void xcd_barrier(const XcdBarrier& b) {
    asm volatile("s_waitcnt vmcnt(0)" ::: "memory");
    __syncthreads();
    if (threadIdx.x == 0) {
        unsigned* bar = b.bar;
        __builtin_amdgcn_s_waitcnt(0);
        unsigned nloc = b.st[0], nx = b.st[1];
        if (nloc == 0u) { xcd_barrier_complete(bar, b.x, nloc, nx); b.st[0] = nloc; b.st[1] = nx; }
        const unsigned old = xb_add(&bar[XB_XSUB(b.x)], 1u);
        const unsigned gen = old / nloc;
        if (old + 1u == (gen + 1u) * nloc) {
            __builtin_amdgcn_fence(__ATOMIC_RELEASE, "agent");
            asm volatile("s_waitcnt vmcnt(0)" ::: "memory");
            const unsigned og = xb_add(&bar[XB_TOP], 1u);
            const unsigned tg = og / nx;
            if (og + 1u == (tg + 1u) * nx) xb_add(&bar[XB_TOPGEN], 1u);
            else XB_SPIN(xb_ld(&bar[XB_TOPGEN]) == tg, bar);
            __builtin_amdgcn_fence(__ATOMIC_ACQUIRE, "agent");
            xb_add(&bar[XB_XGEN(b.x)], 1u);
            asm volatile("s_waitcnt vmcnt(0)" ::: "memory");
        } else {
            XB_SPIN(xb_ld(&bar[XB_XGEN(b.x)]) == gen, bar);
            __builtin_amdgcn_fence(__ATOMIC_ACQUIRE, "agent");
            asm volatile("s_waitcnt vmcnt(0)" ::: "memory");
        }
    }
    __syncthreads();
}
#endif

__global__ void __launch_bounds__(512, 2) mk_fwd(Params P) {
#ifdef EMU
    unsigned char* smem = g_blk->lds;
#else
    extern __shared__ __attribute__((aligned(16))) unsigned char smem[];
    volatile LAS unsigned* bst = (volatile LAS unsigned*)(smem + LDS_BYTES - 16);
    if (threadIdx.x == 0) { bst[0] = 0u; bst[1] = 0u; bst[2] = 0u; bst[3] = 0u; }
    __syncthreads();
    XcdBarrier bar; bar.bar = (unsigned*)P.ws + CW_BAR; bar.x = 0; bar.st = bst;
    if (P.ph_hi - P.ph_lo > 1) bar = xcd_barrier_post((unsigned*)P.ws + CW_BAR, bst);
#endif
    const int lo = P.ph_lo, hi = P.ph_hi;
#ifdef EMU
    const int wv = (int)threadIdx.x >> 6;
#else
    const int wv = RFL((int)threadIdx.x >> 6);
#endif
#ifdef EMU
#define SEAM(id) do {} while (0)
#else
#define SEAM(id) do { if ((id) + 1 < hi) xcd_barrier(bar); } while (0)
#endif
#ifndef MK_ONLY_PHASE
#define MK_ONLY_PHASE -1
#endif
#ifndef MK_DUP_MASK
#define MK_DUP_MASK 0
#endif
#define PHG(kc, id, ...) do { if (MK_ONLY_PHASE < 0 || MK_ONLY_PHASE == (kc)) { const int id_ = (id); if (id_ >= lo && id_ < hi) { if ((MK_DUP_MASK >> (kc)) & 1) { __VA_ARGS__; SEAM(id_ - 1); } __VA_ARGS__; SEAM(id_); } } } while (0)
#define PH(k, ...) PHG(1 + (k), 1 + l * NPH + (k), __VA_ARGS__)
    PHG(0, 0, phase_prologue(P, smem, wv));
    for (int l = 0; l < NL; ++l) {
        PH(0, phase_inproj(P, l, smem, wv));
#if MK_RWKV_CHUNKED
        PH(1, phase_prep32(P, l, smem, wv));
#else
        PH(1, phase_prep(P, l, smem, wv));
#endif
#if MK_RWKV_CHUNKED
        PH(2, { phase_rwkv_pre(P, l, smem, wv); phase_mlstm_local(P, l, smem, wv, (int)blockIdx.x, (int)gridDim.x); if (MK_PROBE == 42) phase_mlstm_local(P, l, smem, wv, (int)blockIdx.x, (int)gridDim.x); });
        PH(3, { const int G_ = (int)gridDim.x;
                if (G_ >= 2 * RSEQ_WGS) { if ((int)blockIdx.x < RSEQ_WGS) { phase_rwkv_seq(P, l, smem, wv); if (MK_PROBE >= 30 && MK_PROBE < 38) phase_rwkv_seq<MK_PROBE >= 30 && MK_PROBE < 38 ? MK_PROBE - 30 : 0>(P, l, smem, wv); }
                                           else { phase_mlstm_carry(P, l, smem, wv, (int)blockIdx.x - RSEQ_WGS, G_ - RSEQ_WGS); phase_gmlp_mix(P, l, smem, wv, (int)blockIdx.x - RSEQ_WGS, G_ - RSEQ_WGS);
                                                  if (MK_PROBE == 39) phase_gmlp_mix(P, l, smem, wv, (int)blockIdx.x - RSEQ_WGS, G_ - RSEQ_WGS); } }
                else { phase_rwkv_seq(P, l, smem, wv); phase_mlstm_carry(P, l, smem, wv, (int)blockIdx.x, G_); } });
        PH(4, { phase_rwkv_out(P, l, smem, wv); if (MK_PROBE == 40) phase_rwkv_out(P, l, smem, wv); phase_mlstm_out(P, l, smem, wv); if (MK_PROBE == 41) phase_mlstm_out(P, l, smem, wv); if ((int)gridDim.x < 2 * RSEQ_WGS) phase_gmlp_mix(P, l, smem, wv, (int)blockIdx.x, (int)gridDim.x); });
#else
        PH(2, { const int G_ = (int)gridDim.x, NSC = 2 * NB * RH * 4;
                if (G_ >= NSC + 32) { if ((int)blockIdx.x < NSC) phase_rwkv_scan(P, l, smem, wv, (int)blockIdx.x, NSC);
                                      else phase_mlstm_local(P, l, smem, wv, (int)blockIdx.x - NSC, G_ - NSC); }
                else { phase_rwkv_scan(P, l, smem, wv, (int)blockIdx.x, G_); phase_mlstm_local(P, l, smem, wv, (int)blockIdx.x, G_); } });
        PH(3, phase_mlstm_carry(P, l, smem, wv, (int)blockIdx.x, (int)gridDim.x));
        PH(4, { phase_mlstm_out(P, l, smem, wv); phase_gmlp_mix(P, l, smem, wv, (int)blockIdx.x, (int)gridDim.x); phase_rwkv_post(P, l, smem, wv); });
#endif
        PH(5, phase_outproj(P, l, smem, wv));
        PH(6, phase_ln1_router(P, l, smem, wv));
        PH(7, phase_scatter(P, l, smem, wv));
#if MK_MOE_MERGED
        PH(8, phase_moe_merged(P, l, smem, wv));
        PH(9, phase_combine_ln2(P, l, smem, wv));
#else
        PH(8, phase_moe_gemm<1>(P, l, smem, wv));
        PH(9, phase_moe_gemm<2>(P, l, smem, wv));
        PH(10, phase_combine_ln2(P, l, smem, wv));
#endif
    }
#undef PHG
#undef PH
#undef SEAM
}

}

#ifndef EMU
extern "C" void kernel_launch(void* const* d_in, const int* in_sizes, int n_in, void* d_out, int out_size, void* d_ws, size_t ws_size, hipStream_t stream) {
    using namespace mk;
    static int grid = 0;
    if (grid == 0) {
        if (n_in != 32 || out_size != T * D || ws_size < WS_END) { fprintf(stderr, "kernel_launch: unexpected shapes (n_in %d out %d ws %zu need %zu)\n", n_in, out_size, ws_size, (size_t)WS_END); grid = -1; return; }
        int dev = 0, cus = 0;
        if (hipGetDevice(&dev) != hipSuccess || hipDeviceGetAttribute(&cus, hipDeviceAttributeMultiprocessorCount, dev) != hipSuccess) { grid = -1; return; }
        if (hipFuncSetAttribute((const void*)mk_fwd, hipFuncAttributeMaxDynamicSharedMemorySize, LDS_BYTES) != hipSuccess) { fprintf(stderr, "kernel_launch: hipFuncSetAttribute failed\n"); grid = -1; return; }
        int per_cu = 0;
        (void)hipOccupancyMaxActiveBlocksPerMultiprocessor(&per_cu, (const void*)mk_fwd, NTHREADS, LDS_BYTES);
        (void)hipGetLastError();
        grid = cus;
    }
    if (grid < 0) return;
    (void)hipMemsetAsync(d_ws, 0, CTL_BYTES, stream);
    Params p{};
    for (int i = 0; i < 32; ++i) p.in[i] = (const float*)d_in[i];
    p.out = (float*)d_out; p.ws = (unsigned char*)d_ws;
#if MK_ONE_LAUNCH
    p.ph_lo = 0; p.ph_hi = 1 + NL * NPH;
    hipLaunchKernelGGL(mk_fwd, dim3(grid), dim3(NTHREADS), LDS_BYTES, stream, p);
#else
    for (int id = 0; id < 1 + NL * NPH; ++id) {
        p.ph_lo = id; p.ph_hi = id + 1;
        hipLaunchKernelGGL(mk_fwd, dim3(grid), dim3(NTHREADS), LDS_BYTES, stream, p);
    }
#endif
}
#endif
```
